# Optimizing an MI355X kernel written in HIP

```python
import jax
import jax.numpy as jnp
from jax import lax
import numpy as np

D_MODEL = 1024
BATCH = 2
SEQ = 8192
DEPTH = 4

N_EVEN = (DEPTH + 1) // 2
N_ODD = DEPTH // 2

NSA_HEADS = 8
NSA_KV_GROUPS = 2
NSA_QPG = NSA_HEADS // NSA_KV_GROUPS
NSA_HD = 64
NSA_W = NSA_HEADS * NSA_HD
NSA_KV_W = NSA_KV_GROUPS * NSA_HD
CMP_BLOCK = 32
CMP_STRIDE = 16
SLC_BLOCK = 64
N_SELECT = 16
WINDOW = 512
Q_BLOCK = 128
CMP_RATIO = CMP_BLOCK // CMP_STRIDE
SEL_RATIO = SLC_BLOCK // CMP_STRIDE
SEL_AGG_W = tuple(float(w) for w in np.convolve(np.ones(SEL_RATIO), np.ones(CMP_RATIO)))

HG_HEADS = 4
HG_DK = 128
HG_DV = 128
HG_W = HG_HEADS * HG_DV
HG_CHUNK = 64

MIX_W = NSA_W + HG_W
IN_SIZES = (NSA_W,) + (NSA_KV_W,) * 6 + (NSA_HEADS * 3, HG_HEADS * HG_DK, HG_HEADS * HG_DK, HG_W, HG_W)
N_IN = sum(IN_SIZES)
IN_OFFSETS = tuple(int(v) for v in np.cumsum(IN_SIZES)[:-1])

CONV_W = 31
D_CONV = D_MODEL

MOE_GROUPS = 4
MOE_EPG = 8
MOE_EXPERTS = MOE_GROUPS * MOE_EPG
MOE_TOPK = 2
EXPERT_FF = 512
MOE_BLOCK = 128

EPS = 1e-6
NEG = -1e30
FORCE = 1e4

kernel_name = 'hybrid_nsa_hgrn2_conformer_hmoe'


def rms_norm(x, g):
    xf = x.astype(jnp.float32)
    y = xf * lax.rsqrt(jnp.mean(xf * xf, axis=-1, keepdims=True) + EPS)
    return (y * g.astype(jnp.float32)).astype(x.dtype)


def layer_norm(x, g, b):
    xf = x.astype(jnp.float32)
    mu = jnp.mean(xf, axis=-1, keepdims=True)
    var = jnp.mean(jnp.square(xf - mu), axis=-1, keepdims=True)
    y = (xf - mu) * lax.rsqrt(var + EPS) * g.astype(jnp.float32) + b.astype(jnp.float32)
    return y.astype(x.dtype)


def masked_softmax(s, valid):
    p = jax.nn.softmax(jnp.where(valid, s, NEG), axis=-1)
    return p * valid


def nsa_mixer(q, k_cmp, v_cmp, k_slc, v_slc, k_win, v_win, gate_logits, w_ck, w_cv, cmp_pe, q_gain, k_gain):
    B, S = q.shape[0], q.shape[1]
    G, J, HD = NSA_KV_GROUPS, NSA_QPG, NSA_HD
    scale = HD ** -0.5
    out_dtype = q.dtype
    qn = rms_norm(q.reshape(B, S, G, J, HD), q_gain)
    gates = jax.nn.sigmoid(gate_logits.astype(jnp.float32)).reshape(B, S, G, J, 3)

    def kv(t):
        return t.reshape(B, S, G, HD)

    def compress(t, w):
        c = kv(t).reshape(B, S // CMP_STRIDE, CMP_STRIDE, G, HD)
        n = S // CMP_STRIDE - CMP_RATIO + 1
        blocks = jnp.concatenate([c[:, r:r + n] for r in range(CMP_RATIO)], axis=2) + cmp_pe[:, None, :]
        return jnp.einsum('bnlgd,lde->bnge', blocks, w.reshape(CMP_BLOCK, HD, HD))

    kc = rms_norm(compress(k_cmp, w_ck), k_gain[0])
    vc = compress(v_cmp, w_cv)
    n_cmp = kc.shape[1]
    cmp_end = jnp.arange(n_cmp) * CMP_STRIDE + CMP_BLOCK - 1
    n_slc = S // SLC_BLOCK
    n_sel = min(N_SELECT, n_slc)
    ks_blocks = rms_norm(kv(k_slc), k_gain[1]).reshape(B, n_slc, SLC_BLOCK, G, HD).transpose(0, 3, 1, 2, 4)
    vs_blocks = kv(v_slc).reshape(B, n_slc, SLC_BLOCK, G, HD).transpose(0, 3, 1, 2, 4)
    pad_w = ((0, 0), (WINDOW, 0), (0, 0), (0, 0))
    kw_pad = jnp.pad(rms_norm(kv(k_win), k_gain[2]), pad_w)
    vw_pad = jnp.pad(kv(v_win), pad_w)
    b_idx = jnp.arange(B)[:, None, None, None]
    g_idx = jnp.arange(G)[None, :, None, None]
    slc_ids = jnp.arange(n_slc)[None, :]

    def block_fn(i):
        t0 = i * Q_BLOCK
        pos = t0 + jnp.arange(Q_BLOCK)
        qb = lax.dynamic_slice_in_dim(qn, t0, Q_BLOCK, axis=1)
        gb = lax.dynamic_slice_in_dim(gates, t0, Q_BLOCK, axis=1)
        s_c = jnp.einsum('bqgjd,bngd->bgjqn', qb, kc).astype(jnp.float32) * scale
        p_c = masked_softmax(s_c, cmp_end[None, :] <= pos[:, None])
        o_c = jnp.einsum('bgjqn,bngd->bqgjd', p_c.astype(vc.dtype), vc)
        imp = p_c.sum(axis=2)
        imp_pad = jnp.pad(imp, ((0, 0), (0, 0), (0, 0), (CMP_RATIO - 1, SEL_RATIO)))
        imp_s = sum(w * imp_pad[..., o:o + SEL_RATIO * n_slc:SEL_RATIO] for o, w in enumerate(SEL_AGG_W))
        q_blk = (pos // SLC_BLOCK)[:, None]
        forced = (slc_ids == 0) | (slc_ids == q_blk) | (slc_ids == q_blk - 1)
        score = jnp.where(slc_ids > q_blk, NEG, jnp.where(forced, FORCE, imp_s))
        top_val, top_idx = lax.top_k(score, n_sel)
        k_sel = ks_blocks[b_idx, g_idx, top_idx]
        v_sel = vs_blocks[b_idx, g_idx, top_idx]
        key_pos = top_idx[..., None] * SLC_BLOCK + jnp.arange(SLC_BLOCK)
        valid_s = (top_val[..., None] > NEG / 2) & (key_pos <= pos[None, None, :, None, None])
        s_s = jnp.einsum('bqgjd,bgqnld->bgjqnl', qb, k_sel).astype(jnp.float32) * scale
        n_keys = n_sel * SLC_BLOCK
        p_s = masked_softmax(s_s.reshape(B, G, J, Q_BLOCK, n_keys), valid_s.reshape(B, G, 1, Q_BLOCK, n_keys))
        o_s = jnp.einsum('bgjqk,bgqkd->bqgjd', p_s.astype(v_sel.dtype), v_sel.reshape(B, G, Q_BLOCK, n_keys, HD))
        kwb = lax.dynamic_slice_in_dim(kw_pad, t0, Q_BLOCK + WINDOW, axis=1)
        vwb = lax.dynamic_slice_in_dim(vw_pad, t0, Q_BLOCK + WINDOW, axis=1)
        kpos = (t0 - WINDOW + jnp.arange(Q_BLOCK + WINDOW))[None, :]
        valid_w = (kpos >= 0) & (kpos <= pos[:, None]) & (kpos > pos[:, None] - WINDOW)
        s_w = jnp.einsum('bqgjd,bkgd->bgjqk', qb, kwb).astype(jnp.float32) * scale
        p_w = masked_softmax(s_w, valid_w)
        o_w = jnp.einsum('bgjqk,bkgd->bqgjd', p_w.astype(vwb.dtype), vwb)
        return (gb[..., 0:1] * o_c + gb[..., 1:2] * o_s + gb[..., 2:3] * o_w).astype(out_dtype)

    o = lax.map(block_fn, jnp.arange(S // Q_BLOCK))
    return o.transpose(1, 0, 2, 3, 4, 5).reshape(B, S, NSA_W)


def hgrn2_mixer(hq, hf, hi, hg, lb, o_gain):
    B, S = hq.shape[0], hq.shape[1]
    H, DK, DV, C = HG_HEADS, HG_DK, HG_DV, HG_CHUNK
    nc = S // C
    f32 = jnp.float32
    lbh = lb.astype(f32).reshape(H, DK)
    q = jax.nn.silu(hq.astype(f32)).reshape(B, S, H, DK)
    f = lbh + (1.0 - lbh) * jax.nn.sigmoid(hf.astype(f32).reshape(B, S, H, DK))
    log_f = jnp.log(f)
    k = 1.0 - f
    v = hi.astype(f32).reshape(B, S, H, DV)

    def to_chunks(t):
        return t.reshape(B, nc, C, H, t.shape[-1]).transpose(1, 0, 3, 2, 4)

    causal = jnp.tril(jnp.ones((C, C), bool))[:, :, None]

    def chunk_step(state, inp):
        qc, kc, vc, lfc = inp
        b = jnp.cumsum(lfc, axis=2)
        decay = jnp.exp(jnp.where(causal, b[:, :, :, None, :] - b[:, :, None, :, :], -jnp.inf))
        attn = jnp.einsum('bhtd,bhsd,bhtsd->bhts', qc, kc, decay)
        o = attn @ vc + jnp.einsum('bhtd,bhde->bhte', qc * jnp.exp(b), state)
        b_end = b[:, :, -1]
        state = jnp.exp(b_end)[..., None] * state + jnp.einsum('bhsd,bhse->bhde', kc * jnp.exp(b_end[:, :, None] - b), vc)
        return state, o

    state0 = jnp.zeros((B, H, DK, DV), f32)
    _, o = lax.scan(chunk_step, state0, (to_chunks(q), to_chunks(k), to_chunks(v), to_chunks(log_f)))
    o = o.transpose(1, 0, 3, 2, 4).reshape(B, S, H, DV)
    o = rms_norm(o, o_gain) * jax.nn.silu(hg.astype(f32).reshape(B, S, H, DV))
    return o.reshape(B, S, HG_W).astype(hq.dtype)


def even_mixer(h, w_in, w_out, w_ck, w_cv, cmp_pe, q_gain, k_gain, lb, o_gain):
    z = h @ w_in
    q, k_c, v_c, k_s, v_s, k_w, v_w, g_nsa, hq, hf, hi, hg = jnp.split(z, IN_OFFSETS, axis=-1)
    a = nsa_mixer(q, k_c, v_c, k_s, v_s, k_w, v_w, g_nsa, w_ck, w_cv, cmp_pe, q_gain, k_gain)
    r = hgrn2_mixer(hq, hf, hi, hg, lb, o_gain)
    return jnp.concatenate([a, r], axis=-1) @ w_out


def conformer_conv(h, w_pw1, dw, dw_b, ln_g, ln_b, w_pw2):
    u = h @ w_pw1
    a, g = jnp.split(u, 2, axis=-1)
    u = a * jax.nn.sigmoid(g)
    u = lax.conv_general_dilated(u, dw[:, None, :], window_strides=(1,), padding=((CONV_W - 1, 0),),
                                 dimension_numbers=('NWC', 'WIO', 'NWC'), feature_group_count=D_CONV) + dw_b
    u = jax.nn.silu(layer_norm(u, ln_g, ln_b))
    return u @ w_pw2


def hier_moe(h, w_group, w_expert, w1, w3, w2):
    B, S, D = h.shape
    T = B * S
    x = h.reshape(T, D)
    f32 = jnp.float32
    g_logits = (x @ w_group).astype(f32)
    g_sel = jnp.argmax(g_logits, axis=-1)
    g_gate = jnp.take_along_axis(jax.nn.softmax(g_logits, axis=-1), g_sel[:, None], axis=1)
    e_logits = (x @ w_expert).astype(f32).reshape(T, MOE_GROUPS, MOE_EPG)
    e_logits = jnp.take_along_axis(e_logits, g_sel[:, None, None], axis=1)[:, 0]
    e_val, e_loc = lax.top_k(jax.nn.softmax(e_logits, axis=-1), MOE_TOPK)
    gate = g_gate * e_val / jnp.sum(e_val, axis=-1, keepdims=True)
    expert = g_sel[:, None] * MOE_EPG + e_loc
    A = T * MOE_TOPK
    e_flat = expert.reshape(A)
    w_flat = gate.reshape(A)
    tok_flat = jnp.repeat(jnp.arange(T, dtype=jnp.int32), MOE_TOPK)
    order = jnp.argsort(e_flat)
    e_sorted = e_flat[order]
    counts = jnp.bincount(e_flat, length=MOE_EXPERTS)
    starts = jnp.cumsum(counts) - counts
    padded = (counts + MOE_BLOCK - 1) // MOE_BLOCK * MOE_BLOCK
    pends = jnp.cumsum(padded)
    pstarts = pends - padded
    dest = pstarts[e_sorted] + jnp.arange(A) - starts[e_sorted]
    n_rows = A + MOE_EXPERTS * MOE_BLOCK
    n_blocks = n_rows // MOE_BLOCK
    row_tok = jnp.full((n_rows,), T, jnp.int32).at[dest].set(tok_flat[order])
    row_w = jnp.zeros((n_rows,), f32).at[dest].set(w_flat[order])
    blk_exp = jnp.minimum(jnp.searchsorted(pends, jnp.arange(n_blocks) * MOE_BLOCK, side='right'), MOE_EXPERTS - 1)
    x_pad = jnp.concatenate([x, jnp.zeros((1, D), x.dtype)], axis=0)

    def expert_block(args):
        tok, e = args
        xb = x_pad[tok]
        return (jax.nn.silu(xb @ w1[e]) * (xb @ w3[e])) @ w2[e]

    y = lax.map(expert_block, (row_tok.reshape(n_blocks, MOE_BLOCK), blk_exp))
    y = y.reshape(n_rows, D) * row_w[:, None].astype(y.dtype)
    out = jnp.zeros((T + 1, D), y.dtype).at[row_tok].add(y)[:T]
    return out.reshape(B, S, D).astype(h.dtype)


def setup_inputs(seed: int = 0) -> dict:
    key = jax.random.key(seed)
    ks = jax.random.split(key, 26)
    D = D_MODEL

    def nrm(k, shape, scale):
        return jax.random.normal(k, shape, jnp.float32) * scale

    return {
        'x': nrm(ks[0], (BATCH, SEQ, D), 1.0),
        'c': nrm(ks[1], (BATCH, D), 1.0),
        'ada_w': nrm(ks[2], (DEPTH, D, 6 * D), 0.5 * D ** -0.5),
        'ada_b': nrm(ks[3], (DEPTH, 6 * D), 0.02),
        'norm_mix': 1.0 + nrm(ks[4], (DEPTH, D), 0.05),
        'norm_ffn': 1.0 + nrm(ks[5], (DEPTH, D), 0.05),
        'mix_w_in': nrm(ks[6], (N_EVEN, D, N_IN), D ** -0.5),
        'mix_w_out': nrm(ks[7], (N_EVEN, MIX_W, D), MIX_W ** -0.5),
        'nsa_cmp_wk': nrm(ks[8], (N_EVEN, CMP_BLOCK * NSA_HD, NSA_HD), (CMP_BLOCK * NSA_HD) ** -0.5),
        'nsa_cmp_wv': nrm(ks[9], (N_EVEN, CMP_BLOCK * NSA_HD, NSA_HD), (CMP_BLOCK * NSA_HD) ** -0.5),
        'nsa_cmp_pe': nrm(ks[10], (N_EVEN, CMP_BLOCK, NSA_HD), 0.1),
        'nsa_q_gain': 1.0 + nrm(ks[11], (N_EVEN, NSA_HD), 0.05),
        'nsa_k_gain': 1.0 + nrm(ks[12], (N_EVEN, 3, NSA_HD), 0.05),
        'hgrn_lb_logits': nrm(ks[13], (N_EVEN, HG_HEADS * HG_DK), 1.0),
        'hgrn_o_gain': 1.0 + nrm(ks[14], (N_EVEN, HG_DV), 0.05),
        'conv_w_pw1': nrm(ks[15], (N_ODD, D, 2 * D_CONV), D ** -0.5),
        'conv_dw': nrm(ks[16], (N_ODD, CONV_W, D_CONV), CONV_W ** -0.5),
        'conv_dw_b': nrm(ks[17], (N_ODD, D_CONV), 0.02),
        'conv_ln_g': 1.0 + nrm(ks[18], (N_ODD, D_CONV), 0.05),
        'conv_ln_b': nrm(ks[19], (N_ODD, D_CONV), 0.02),
        'conv_w_pw2': nrm(ks[20], (N_ODD, D_CONV, D), D_CONV ** -0.5),
        'moe_w_group': nrm(ks[21], (DEPTH, D, MOE_GROUPS), D ** -0.5),
        'moe_w_expert': nrm(ks[22], (DEPTH, D, MOE_EXPERTS), D ** -0.5),
        'moe_w1': nrm(ks[23], (DEPTH, MOE_EXPERTS, D, EXPERT_FF), D ** -0.5),
        'moe_w3': nrm(ks[24], (DEPTH, MOE_EXPERTS, D, EXPERT_FF), D ** -0.5),
        'moe_w2': nrm(ks[25], (DEPTH, MOE_EXPERTS, EXPERT_FF, D), EXPERT_FF ** -0.5),
    }


def reference(x, c, ada_w, ada_b, norm_mix, norm_ffn, mix_w_in, mix_w_out, nsa_cmp_wk, nsa_cmp_wv, nsa_cmp_pe,
              nsa_q_gain, nsa_k_gain, hgrn_lb_logits, hgrn_o_gain, conv_w_pw1, conv_dw, conv_dw_b, conv_ln_g,
              conv_ln_b, conv_w_pw2, moe_w_group, moe_w_expert, moe_w1, moe_w3, moe_w2):
    lb_p = jax.nn.softmax(hgrn_lb_logits.astype(jnp.float32), axis=0)
    lower_bounds = jnp.cumsum(lb_p, axis=0) - lb_p[0]
    c_act = jax.nn.silu(c)
    for layer in range(DEPTH):
        mod = (c_act @ ada_w[layer] + ada_b[layer])[:, None, :]
        sh_m, sc_m, g_m, sh_f, sc_f, g_f = jnp.split(mod, 6, axis=-1)
        h = rms_norm(x, norm_mix[layer]) * (1.0 + sc_m) + sh_m
        i = layer // 2
        if layer % 2 == 0:
            y = even_mixer(h, mix_w_in[i], mix_w_out[i], nsa_cmp_wk[i], nsa_cmp_wv[i], nsa_cmp_pe[i],
                           nsa_q_gain[i], nsa_k_gain[i], lower_bounds[i], hgrn_o_gain[i])
        else:
            y = conformer_conv(h, conv_w_pw1[i], conv_dw[i], conv_dw_b[i], conv_ln_g[i], conv_ln_b[i], conv_w_pw2[i])
        x = x + g_m * y
        h = rms_norm(x, norm_ffn[layer]) * (1.0 + sc_f) + sh_f
        x = x + g_f * hier_moe(h, moe_w_group[layer], moe_w_expert[layer], moe_w1[layer], moe_w3[layer], moe_w2[layer])
    return x
```

```cpp
#ifdef EMU
#include "emu.h"
#define DEV static inline
#define MDEV inline
#define OPAQUE(p)
#define TID emu_tid()
#define BID (EB->bid)
#define NBLK (EB->nblk)
#define SYNC() emu_sync_block()
#define WSYNC() emu_sync_wave()
#define mfma16(a, b, c) emu_mfma16(a, b, c)
DEV float shflx(float v, int m) { return emu_shfl_f(v, (emu_tid() & 63) ^ m); }
DEV int shflxi(int v, int m) { return (int)emu_shfl_u((unsigned)v, (emu_tid() & 63) ^ m); }
DEV float shfl(float v, int s) { return emu_shfl_f(v, s); }
DEV int atomic_add_i(int* p, int v) { return __atomic_fetch_add(p, v, __ATOMIC_RELAXED); }
DEV float fexp2(float x) { return exp2f(x); }
DEV float frcp(float x) { return 1.0f / x; }
DEV float frsq(float x) { return 1.0f / sqrtf(x); }
#else
#include <hip/hip_runtime.h>
#include <cstdio>
#include <cstdint>
typedef short bf16x8 __attribute__((ext_vector_type(8)));
typedef float f32x4 __attribute__((ext_vector_type(4)));
typedef unsigned u32x4 __attribute__((ext_vector_type(4)));
typedef unsigned u32x2 __attribute__((ext_vector_type(2)));
#define DEV __device__ __forceinline__
#define MDEV __device__ __forceinline__
#define OPAQUE(p) asm volatile("" : "+v"(p))
DEV int tid_opaque() { int t = (int)threadIdx.x; asm volatile("" : "+v"(t)); return t; }
#define TID tid_opaque()
#define BID ((int)blockIdx.x)
#define NBLK ((int)gridDim.x)
#define SYNC() __syncthreads()
#define WSYNC() __builtin_amdgcn_wave_barrier()
#define mfma16(a, b, c) __builtin_amdgcn_mfma_f32_16x16x32_bf16(a, b, c, 0, 0, 0)
DEV float shflx(float v, int m) { return __shfl_xor(v, m); }
DEV int shflxi(int v, int m) { return __shfl_xor(v, m); }
DEV float shfl(float v, int s) { return __shfl(v, s); }
DEV int atomic_add_i(int* p, int v) { return atomicAdd(p, v); }
DEV float fexp2(float x) { return exp2f(x); }
DEV float frcp(float x) { return 1.0f / x; }
DEV float frsq(float x) { return rsqrtf(x); }
#endif

typedef unsigned short bf16;

#ifndef DM
#define DM 1024
#endif
#ifndef SEQ
#define SEQ 8192
#endif
#ifndef FF
#define FF 512
#endif
constexpr int NBATCH = 2, T = NBATCH * SEQ, DEPTH = 4;
constexpr int NIN = 3352, NINP = 3456;
constexpr int NT = 512;
constexpr int NCH = SEQ / 64;
constexpr int NCP = SEQ / 16;
constexpr int NCMP = NCP - 1;
constexpr int MOE_ROWS = 2 * T + 32 * 256;
constexpr float EPS = 1e-6f, NEGV = -1e30f, FORCEV = 1e4f, LOG2E = 1.4426950408889634f;

constexpr size_t al(size_t x) { return (x + 255) & ~(size_t)255; }
constexpr size_t WS_BAR = 0;
constexpr size_t WS_CNT = 16384;
constexpr size_t WS_MOD = WS_CNT + 1024;
constexpr size_t WS_LB = al(WS_MOD + (size_t)DEPTH * 2 * 6 * DM * 4);
constexpr size_t WS_CB = al(WS_LB + 2 * 512 * 4);
constexpr size_t WS_CS = al(WS_CB + 2 * 2 * 64 * 4);
constexpr size_t WS_WIN = al(WS_CS + 64);
constexpr size_t WS_WOUT = al(WS_WIN + (size_t)2 * NINP * DM * 2);
constexpr size_t WS_PW1 = al(WS_WOUT + (size_t)2 * DM * 1024 * 2);
constexpr size_t WS_PW2 = al(WS_PW1 + (size_t)2 * 2 * DM * DM * 2);
constexpr size_t WS_WC = al(WS_PW2 + (size_t)2 * DM * DM * 2);
constexpr size_t WS_W13 = al(WS_WC + (size_t)2 * 2 * 64 * 2048 * 2);
constexpr size_t WS_W2 = al(WS_W13 + (size_t)DEPTH * 32 * 2 * FF * DM * 2);
constexpr size_t WS_H = al(WS_W2 + (size_t)DEPTH * 32 * DM * FF * 2);
constexpr size_t WS_QN = al(WS_H + (size_t)T * DM * 2);
constexpr size_t WS_KCG = al(WS_QN + (size_t)T * 512 * 2);
constexpr size_t WS_VCG = al(WS_KCG + (size_t)T * 128 * 2);
constexpr size_t WS_KS = al(WS_VCG + (size_t)T * 128 * 2);
constexpr size_t WS_KW = al(WS_KS + (size_t)T * 128 * 2);
constexpr size_t WS_VST = al(WS_KW + (size_t)T * 128 * 2);
constexpr size_t WS_VWT = al(WS_VST + (size_t)T * 128 * 2);
constexpr size_t WS_KC = al(WS_VWT + (size_t)T * 128 * 2);
constexpr size_t WS_VCT = al(WS_KC + (size_t)4 * NCP * 64 * 2);
constexpr size_t WS_GATE = al(WS_VCT + (size_t)4 * NCP * 64 * 2);
constexpr size_t WS_HQ = al(WS_GATE + (size_t)T * 24 * 4);
constexpr size_t WS_HF = al(WS_HQ + (size_t)T * 512 * 2);
constexpr size_t WS_HV = al(WS_HF + (size_t)T * 512 * 4);
constexpr size_t WS_HGS = al(WS_HV + (size_t)T * 512 * 2);
constexpr size_t WS_UT = al(WS_HGS + (size_t)T * 512 * 2);
constexpr size_t WS_ST = al(WS_UT + (size_t)8 * NCH * 128 * 128 * 4);
constexpr size_t WS_GD = al(WS_ST + (size_t)8 * NCH * 128 * 128 * 2);
constexpr size_t WS_CAT = al(WS_GD + (size_t)8 * NCH * 128 * 4);
constexpr size_t WS_GLU = al(WS_CAT + (size_t)T * 1024 * 2);
constexpr size_t WS_TIE = al(WS_GLU + (size_t)T * DM * 2);
constexpr size_t WS_TIW = al(WS_TIE + (size_t)T * 2 * 4);
constexpr size_t WS_LIST = al(WS_TIW + (size_t)T * 2 * 4);
constexpr size_t WS_ACT = al(WS_LIST + (size_t)32 * T * 4);
constexpr size_t WS_YK = al(WS_ACT + (size_t)MOE_ROWS * FF * 2);
constexpr size_t WS_END = al(WS_YK + (size_t)MOE_ROWS * DM * 2);

struct Args { const float* in[26]; float* out; unsigned char* ws; };
enum { I_X = 0, I_C, I_ADAW, I_ADAB, I_NMIX, I_NFFN, I_WIN, I_WOUT, I_CWK, I_CWV, I_CPE, I_QG, I_KG, I_LBL, I_OG,
       I_PW1, I_DW, I_DWB, I_LNG, I_LNB, I_PW2, I_WG, I_WE, I_W1, I_W3, I_W2 };

#ifdef EMU
DEV unsigned char* wsp(const Args& a) { return a.ws; }
DEV float* outp(const Args& a) { return a.out; }
#else
DEV unsigned char* wsp(const Args& a) { int z = 0; asm volatile("" : "+s"(z)); return a.ws + z; }
DEV float* outp(const Args& a) { int z = 0; asm volatile("" : "+s"(z)); return a.out + z; }
#endif

DEV unsigned f2bf(float f) { unsigned u = __builtin_bit_cast(unsigned, f); return (u + 0x7fffu + ((u >> 16) & 1u)) >> 16; }
DEV float bf2f(unsigned h) { return __builtin_bit_cast(float, h << 16); }
DEV unsigned pk2(float lo, float hi) { return f2bf(lo) | (f2bf(hi) << 16); }
DEV float sigm(float x) { return frcp(1.0f + fexp2(-x * LOG2E)); }
DEV float siluf(float x) { return x * sigm(x); }
DEV f32x4 f4zero() { f32x4 z = {0.f, 0.f, 0.f, 0.f}; return z; }
DEV bf16x8 pack8(f32x4 a, f32x4 b) {
    u32x4 w; w[0] = pk2(a[0], a[1]); w[1] = pk2(a[2], a[3]); w[2] = pk2(b[0], b[1]); w[3] = pk2(b[2], b[3]);
    return __builtin_bit_cast(bf16x8, w);
}
DEV void st_bf4(bf16* p, f32x4 v) { u32x2 w; w[0] = pk2(v[0], v[1]); w[1] = pk2(v[2], v[3]); *(u32x2*)p = w; }

constexpr int LDT = 72;
constexpr int GEMM_AS = 256 * LDT, GEMM_BS = 128 * LDT;
constexpr int GEMM_LDS = 2 * (GEMM_AS + GEMM_BS) * 2;

template <class AF, class EPI>
DEV void gemm_tile(unsigned char* smem, AF af, const bf16* Bt, int ldb, int nvalid, int K, EPI& epi) {
    const int tid = TID, w = tid >> 6, l = tid & 63, h = l >> 4, c = l & 15, wm = w >> 1, wn = w & 1;
    bf16* As = (bf16*)smem; bf16* Bs = As + 2 * GEMM_AS;
    const bf16* ap[4]; const bf16* bp[2];
    const int col8 = (tid & 7) * 8, r0 = tid >> 3;
#pragma unroll
    for (int i = 0; i < 4; ++i) ap[i] = af(r0 + 64 * i) + col8;
#pragma unroll
    for (int i = 0; i < 2; ++i) { int rn = r0 + 64 * i; if (rn >= nvalid) rn = nvalid - 1; bp[i] = Bt + (size_t)rn * ldb + col8; }
    f32x4 acc[4][4];
#pragma unroll
    for (int i = 0; i < 4; ++i)
#pragma unroll
        for (int j = 0; j < 4; ++j) acc[i][j] = f4zero();
    bf16x8 ra[4], rb[2];
#pragma unroll
    for (int i = 0; i < 4; ++i) ra[i] = *(const bf16x8*)(ap[i]);
#pragma unroll
    for (int i = 0; i < 2; ++i) rb[i] = *(const bf16x8*)(bp[i]);
    SYNC();
#pragma unroll
    for (int i = 0; i < 4; ++i) *(bf16x8*)(As + (r0 + 64 * i) * LDT + col8) = ra[i];
#pragma unroll
    for (int i = 0; i < 2; ++i) *(bf16x8*)(Bs + (r0 + 64 * i) * LDT + col8) = rb[i];
    SYNC();
    const int nk = K / 64;
    for (int kt = 0; kt < nk; ++kt) {
        const int cur = kt & 1;
        if (kt + 1 < nk) {
#pragma unroll
            for (int i = 0; i < 4; ++i) ra[i] = *(const bf16x8*)(ap[i] + (kt + 1) * 64);
#pragma unroll
            for (int i = 0; i < 2; ++i) rb[i] = *(const bf16x8*)(bp[i] + (kt + 1) * 64);
        }
        const bf16* Ac = As + cur * GEMM_AS + (wm * 64 + c) * LDT + 8 * h;
        const bf16* Bc = Bs + cur * GEMM_BS + (wn * 64 + c) * LDT + 8 * h;
#pragma unroll
        for (int kk = 0; kk < 2; ++kk) {
            bf16x8 fa[4], fb[4];
#pragma unroll
            for (int i = 0; i < 4; ++i) { fa[i] = *(const bf16x8*)(Ac + i * 16 * LDT + kk * 32); fb[i] = *(const bf16x8*)(Bc + i * 16 * LDT + kk * 32); }
#pragma unroll
            for (int ni = 0; ni < 4; ++ni)
#pragma unroll
                for (int mi = 0; mi < 4; ++mi) acc[ni][mi] = mfma16(fb[ni], fa[mi], acc[ni][mi]);
        }
        if (kt + 1 < nk) {
            const int nx = cur ^ 1;
#pragma unroll
            for (int i = 0; i < 4; ++i) *(bf16x8*)(As + nx * GEMM_AS + (r0 + 64 * i) * LDT + col8) = ra[i];
#pragma unroll
            for (int i = 0; i < 2; ++i) *(bf16x8*)(Bs + nx * GEMM_BS + (r0 + 64 * i) * LDT + col8) = rb[i];
        }
        SYNC();
    }
    epi(acc, wm * 64, wn * 64, h, c);
}

struct ARows { const bf16* base; size_t ld; MDEV const bf16* operator()(int r) const { return base + (size_t)r * ld; } };

struct EpiInProj {
    const Args* a; int m0, n0, li;
    MDEV void operator()(f32x4 (&acc)[4][4], int mw, int nw, int h, int c) const {
        unsigned char* ws = wsp(*a);
        const int nb = n0 + nw;
        const int tokb = m0 + mw + c;
        if (nb < 512 || (nb >= 768 && nb < 896) || (nb >= 1024 && nb < 1152)) {
            const float* gain; float mul = 1.f; bf16* dst; int kind;
            if (nb < 512) { gain = a->in[I_QG] + li * 64; mul = 0.125f; kind = 0; dst = (bf16*)(ws + WS_QN); }
            else if (nb < 896) { gain = a->in[I_KG] + (li * 3 + 1) * 64; kind = 1; dst = (bf16*)(ws + WS_KS); }
            else { gain = a->in[I_KG] + (li * 3 + 2) * 64; kind = 1; dst = (bf16*)(ws + WS_KW); }
            const int g = (nb >> 6) & 1;
#pragma unroll
            for (int mi = 0; mi < 4; ++mi) {
                float ss = 0.f;
#pragma unroll
                for (int ni = 0; ni < 4; ++ni) { f32x4 v = acc[ni][mi]; ss += v[0] * v[0] + v[1] * v[1] + v[2] * v[2] + v[3] * v[3]; }
                ss += shflx(ss, 16); ss += shflx(ss, 32);
                const float rs = frsq(ss * (1.0f / 64.0f) + EPS) * mul;
                const int tok = tokb + 16 * mi;
#pragma unroll
                for (int ni = 0; ni < 4; ++ni) {
                    const int d = 16 * ni + 4 * h; f32x4 v = acc[ni][mi], o;
#pragma unroll
                    for (int r = 0; r < 4; ++r) o[r] = v[r] * rs * gain[d + r];
                    if (kind == 0) st_bf4(dst + (size_t)tok * 512 + nb + d, o);
                    else { const int b = tok / SEQ, s = tok % SEQ; st_bf4(dst + ((size_t)(b * 2 + g) * SEQ + s) * 64 + d, o); }
                }
            }
        } else if (nb < 768) {
            bf16* dst = (bf16*)(ws + (nb < 640 ? WS_KCG : WS_VCG)); const int g = (nb >> 6) & 1;
#pragma unroll
            for (int mi = 0; mi < 4; ++mi) { const int tok = tokb + 16 * mi, b = tok / SEQ, s = tok % SEQ;
#pragma unroll
                for (int ni = 0; ni < 4; ++ni) st_bf4(dst + ((size_t)(b * 2 + g) * SEQ + s) * 64 + 16 * ni + 4 * h, acc[ni][mi]); }
        } else if (nb < 1280) {
            bf16* dst = (bf16*)(ws + (nb < 1024 ? WS_VST : WS_VWT)); const int g = (nb >> 6) & 1;
#pragma unroll
            for (int mi = 0; mi < 4; ++mi) { const int tok = tokb + 16 * mi, b = tok / SEQ, s = tok % SEQ;
                bf16* p = dst + ((size_t)(b * 2 + g) * NCH + (s >> 6)) * 4096 + (s & 63);
#pragma unroll
                for (int ni = 0; ni < 4; ++ni)
#pragma unroll
                    for (int r = 0; r < 4; ++r) p[(16 * ni + 4 * h + r) * 64] = (bf16)f2bf(acc[ni][mi][r]); }
        } else if (nb < 3328) {
            const int sec = (nb - 1280) >> 9, cc = (nb - 1280) & 511, hh = cc >> 7, d0 = cc & 127;
#pragma unroll
            for (int mi = 0; mi < 4; ++mi) { const int tok = tokb + 16 * mi, b = tok / SEQ, s = tok % SEQ;
                const size_t hrow = ((size_t)(b * 4 + hh) * SEQ + s) * 128 + d0;
#pragma unroll
                for (int ni = 0; ni < 4; ++ni) { const int d = 16 * ni + 4 * h; f32x4 v = acc[ni][mi], o;
                    if (sec == 0) { for (int r = 0; r < 4; ++r) o[r] = siluf(v[r]); st_bf4((bf16*)(ws + WS_HQ) + hrow + d, o); }
                    else if (sec == 1) { const float* lb = (const float*)(ws + WS_LB) + li * 512 + cc + d;
                        for (int r = 0; r < 4; ++r) o[r] = lb[r] + (1.0f - lb[r]) * sigm(v[r]);
                        *(f32x4*)((float*)(ws + WS_HF) + hrow + d) = o; }
                    else if (sec == 2) st_bf4((bf16*)(ws + WS_HV) + hrow + d, v);
                    else { for (int r = 0; r < 4; ++r) o[r] = siluf(v[r]); st_bf4((bf16*)(ws + WS_HGS) + (size_t)tok * 512 + cc + d, o); }
                } }
        } else if (nb == 3328) {
            float* dst = (float*)(ws + WS_GATE);
#pragma unroll
            for (int mi = 0; mi < 4; ++mi) { const int tok = tokb + 16 * mi;
#pragma unroll
                for (int ni = 0; ni < 2; ++ni)
#pragma unroll
                    for (int r = 0; r < 4; ++r) { const int n = 16 * ni + 4 * h + r; if (n < 24) dst[(size_t)tok * 24 + n] = sigm(acc[ni][mi][r]); } }
        }
    }
};

struct EpiResid {
    float* x; const float* gate; int m0, n0;
    MDEV void operator()(f32x4 (&acc)[4][4], int mw, int nw, int h, int c) const {
#pragma unroll
        for (int mi = 0; mi < 4; ++mi) { const int tok = m0 + mw + 16 * mi + c, b = tok / SEQ;
#pragma unroll
            for (int ni = 0; ni < 4; ++ni) { const int n = n0 + nw + 16 * ni + 4 * h;
                f32x4 g = *(const f32x4*)(gate + (size_t)b * 6 * DM + n); f32x4* p = (f32x4*)(x + (size_t)tok * DM + n); f32x4 v = *p;
#pragma unroll
                for (int r = 0; r < 4; ++r) v[r] += g[r] * acc[ni][mi][r];
                *p = v; } }
    }
};
template <int MODE> struct EpiGated {
    bf16* dst; size_t ld; int m0, n0, mvalid;
    MDEV void operator()(f32x4 (&acc)[4][4], int mw, int nw, int h, int c) const {
        const int cb = (n0 + nw) / 2;
#pragma unroll
        for (int mi = 0; mi < 4; ++mi) { const int m = mw + 16 * mi + c; if (m >= mvalid) continue;
#pragma unroll
            for (int ni = 0; ni < 2; ++ni) { f32x4 o;
#pragma unroll
                for (int r = 0; r < 4; ++r) { const float av = acc[ni][mi][r], bv = acc[ni + 2][mi][r]; o[r] = MODE == 0 ? av * sigm(bv) : siluf(av) * bv; }
                st_bf4(dst + (size_t)(m0 + m) * ld + cb + 16 * ni + 4 * h, o); } }
    }
};
struct EpiStoreBf {
    bf16* dst; size_t ld; int m0, n0, mvalid;
    MDEV void operator()(f32x4 (&acc)[4][4], int mw, int nw, int h, int c) const {
#pragma unroll
        for (int mi = 0; mi < 4; ++mi) { const int m = mw + 16 * mi + c; if (m >= mvalid) continue;
#pragma unroll
            for (int ni = 0; ni < 4; ++ni) st_bf4(dst + (size_t)(m0 + m) * ld + n0 + nw + 16 * ni + 4 * h, acc[ni][mi]); }
    }
};
struct EpiCmp {
    const Args* a; int kv, bg, m0, li;
    MDEV void operator()(f32x4 (&acc)[4][4], int mw, int nw, int h, int c) const {
        if (nw != 0) return;
        unsigned char* ws = wsp(*a);
        const float* bias = (const float*)(ws + WS_CB) + (li * 2 + kv) * 64;
        const float* gain = a->in[I_KG] + (li * 3 + 0) * 64;
#pragma unroll
        for (int mi = 0; mi < 4; ++mi) { const int n = m0 + mw + 16 * mi + c; const bool ok = n < NCMP;
            f32x4 v[4]; float ss = 0.f;
#pragma unroll
            for (int ni = 0; ni < 4; ++ni) { v[ni] = acc[ni][mi];
#pragma unroll
                for (int r = 0; r < 4; ++r) { v[ni][r] += bias[16 * ni + 4 * h + r]; ss += v[ni][r] * v[ni][r]; } }
            ss += shflx(ss, 16); ss += shflx(ss, 32);
            if (n >= NCP) continue;
            if (kv == 0) { const float rs = frsq(ss * (1.0f / 64.0f) + EPS); bf16* p = (bf16*)(ws + WS_KC) + ((size_t)bg * NCP + n) * 64;
#pragma unroll
                for (int ni = 0; ni < 4; ++ni) { f32x4 o;
#pragma unroll
                    for (int r = 0; r < 4; ++r) o[r] = ok ? v[ni][r] * rs * gain[16 * ni + 4 * h + r] : 0.f;
                    st_bf4(p + 16 * ni + 4 * h, o); }
            } else { bf16* p = (bf16*)(ws + WS_VCT) + (size_t)bg * 64 * NCP + n;
#pragma unroll
                for (int ni = 0; ni < 4; ++ni)
#pragma unroll
                    for (int r = 0; r < 4; ++r) p[(size_t)(16 * ni + 4 * h + r) * NCP] = (bf16)f2bf(ok ? v[ni][r] : 0.f); }
        }
    }
};

DEV void tr_tile(unsigned char* smem, const float* src0, const float* src1, int ld, int K, int mode, bf16* dst, int n0, int k0) {
    bf16* tl = (bf16*)smem;
    const int tid = TID;
    SYNC();
#pragma unroll
    for (int i = 0; i < 8; ++i) {
        const int e = tid + 512 * i, kk = e >> 6, nn = e & 63, n = n0 + nn; float v = 0.f;
        if (mode == 0) v = src0[(size_t)(k0 + kk) * ld + n];
        else if (mode == 1) { int sc = n < 1280 ? n : (n < 3328 ? n + 24 : (n < 3352 ? 1280 + (n - 3328) : -1)); if (sc >= 0) v = src0[(size_t)(k0 + kk) * ld + sc]; }
        else { const int g = n >> 6, w = n & 63; v = (w < 32) ? src0[(size_t)(k0 + kk) * ld + g * 32 + w] : src1[(size_t)(k0 + kk) * ld + g * 32 + w - 32]; }
        tl[nn * LDT + kk] = (bf16)f2bf(v);
    }
    SYNC();
    const int nn = tid >> 3, k8 = (tid & 7) * 8;
    *(bf16x8*)(dst + (size_t)(n0 + nn) * K + k0 + k8) = *(const bf16x8*)(tl + nn * LDT + k8);
}

struct TrJob { const float* s0; const float* s1; int ld, K, N, mode; bf16* dst; };
DEV void p0_phase(const Args& a, unsigned char* smem) {
    unsigned char* ws = wsp(a); const int tid = TID;
    constexpr int NJ_SMALL = 12, NJOBS = NJ_SMALL + 2 * DEPTH * 32;
    int item = BID;
    auto job = [&](int j) -> TrJob {
        TrJob J;
        if (j < 2) { J = {a.in[I_WIN] + (size_t)j * DM * NIN, nullptr, NIN, DM, NINP, 1, (bf16*)(ws + WS_WIN) + (size_t)j * NINP * DM}; }
        else if (j < 4) { int i = j - 2; J = {a.in[I_WOUT] + (size_t)i * 1024 * DM, nullptr, DM, 1024, DM, 0, (bf16*)(ws + WS_WOUT) + (size_t)i * DM * 1024}; }
        else if (j < 6) { int i = j - 4; const float* s = a.in[I_PW1] + (size_t)i * DM * 2 * DM; J = {s, s + DM, 2 * DM, DM, 2 * DM, 2, (bf16*)(ws + WS_PW1) + (size_t)i * 2 * DM * DM}; }
        else if (j < 8) { int i = j - 6; J = {a.in[I_PW2] + (size_t)i * DM * DM, nullptr, DM, DM, DM, 0, (bf16*)(ws + WS_PW2) + (size_t)i * DM * DM}; }
        else if (j < 12) { int i = (j - 8) >> 1, kv = (j - 8) & 1; J = {a.in[kv ? I_CWV : I_CWK] + (size_t)i * 2048 * 64, nullptr, 64, 2048, 64, 0, (bf16*)(ws + WS_WC) + (size_t)(i * 2 + kv) * 64 * 2048}; }
        else if (j < 12 + DEPTH * 32) { int le = j - 12; J = {a.in[I_W1] + (size_t)le * DM * FF, a.in[I_W3] + (size_t)le * DM * FF, FF, DM, 2 * FF, 2, (bf16*)(ws + WS_W13) + (size_t)le * 2 * FF * DM}; }
        else { int le = j - 12 - DEPTH * 32; J = {a.in[I_W2] + (size_t)le * FF * DM, nullptr, DM, FF, DM, 0, (bf16*)(ws + WS_W2) + (size_t)le * DM * FF}; }
        return J;
    };
    int base = 0;
    for (int j = 0; j < NJOBS; ++j) {
        TrJob J = job(j);
        const int tn = J.N / 64, tk = J.K / 64, nt = tn * tk;
        while (item < base + nt) { const int it = item - base; tr_tile(smem, J.s0, J.s1, J.ld, J.K, J.mode, J.dst, (it % tn) * 64, (it / tn) * 64); item += NBLK; }
        base += nt;
    }
    {
        float* red = (float*)smem;
        const int ntask = DEPTH * (6 * DM / 64);
        for (int t = BID; t < ntask; t += NBLK) {
            const int l = t / (6 * DM / 64), j0 = (t % (6 * DM / 64)) * 64, col = tid & 63, ks = tid >> 6;
            const float* w = a.in[I_ADAW] + (size_t)l * DM * 6 * DM + j0 + col; const float* cc = a.in[I_C];
            float a0 = 0.f, a1 = 0.f;
            for (int k = ks * (DM / 8); k < (ks + 1) * (DM / 8); ++k) { const float wv = w[(size_t)k * 6 * DM]; a0 += siluf(cc[k]) * wv; a1 += siluf(cc[DM + k]) * wv; }
            SYNC();
            red[(ks * 2 + 0) * 64 + col] = a0; red[(ks * 2 + 1) * 64 + col] = a1;
            SYNC();
            if (tid < 128) { const int b = tid >> 6; float s = a.in[I_ADAB][(size_t)l * 6 * DM + j0 + col];
                for (int q = 0; q < 8; ++q) s += red[(q * 2 + b) * 64 + col];
                ((float*)(ws + WS_MOD))[((size_t)l * 2 + b) * 6 * DM + j0 + col] = s; }
        }
    }
    if (BID == 0) {
        for (int i = tid; i < DEPTH * 32; i += NT) ((int*)(ws + WS_CNT))[i] = 0;
        for (int n = tid; n < 512; n += NT) { const float l0 = a.in[I_LBL][n], l1 = a.in[I_LBL][512 + n]; const float m = fmaxf(l0, l1);
            const float e0 = fexp2((l0 - m) * LOG2E), e1 = fexp2((l1 - m) * LOG2E);
            ((float*)(ws + WS_LB))[n] = 0.f; ((float*)(ws + WS_LB))[512 + n] = e1 / (e0 + e1); }
        if (tid < 2) { const int i = tid; float mq = 0.f; for (int d = 0; d < 64; ++d) mq = fmaxf(mq, fabsf(a.in[I_QG][i * 64 + d]));
            for (int br = 0; br < 3; ++br) { float mk = 0.f; for (int d = 0; d < 64; ++d) mk = fmaxf(mk, fabsf(a.in[I_KG][(i * 3 + br) * 64 + d]));
                ((float*)(ws + WS_CS))[i * 4 + br] = 8.0f * mq * mk * LOG2E; } }
    }
    if (BID == 1 % NBLK && tid < 256) {
        const int i = tid >> 7, kv = (tid >> 6) & 1, e = tid & 63; const float* W = a.in[kv ? I_CWV : I_CWK] + (size_t)i * 2048 * 64; const float* pe = a.in[I_CPE] + (size_t)i * 2048;
        float s = 0.f; for (int k = 0; k < 2048; ++k) s += pe[k] * W[(size_t)k * 64 + e];
        ((float*)(ws + WS_CB))[(i * 2 + kv) * 64 + e] = s;
    }
}

constexpr int NJV = DM / 256;
DEV void moe_bases(const int* cnt, int* rb  ) {
    if (TID == 0) { int acc = 0; for (int e = 0; e < 32; ++e) { rb[e] = acc; acc += ((cnt[e] + 255) >> 8) << 8; } rb[32] = acc; }
    SYNC();
}
DEV void norm_phase(const Args& a, unsigned char* smem, int l) {
    unsigned char* ws = wsp(a); const int tid = TID, w = tid >> 6, lane = tid & 63;
    int* rb = (int*)smem;
    if (l > 0) moe_bases((const int*)(ws + WS_CNT) + (l - 1) * 32, rb);
    const float* mod = (const float*)(ws + WS_MOD);
    const bf16* yk = (const bf16*)(ws + WS_YK);
    for (int row = BID * 8 + w; row < T; row += NBLK * 8) {
        const int b = row / SEQ;
        f32x4 v[NJV];
        const float* xin = (l == 0) ? a.in[I_X] : outp(a);
#pragma unroll
        for (int j = 0; j < NJV; ++j) v[j] = *(const f32x4*)(xin + (size_t)row * DM + 4 * lane + 256 * j);
        if (l > 0) {
            const int* tie = (const int*)(ws + WS_TIE) + (size_t)row * 2; const float* tiw = (const float*)(ws + WS_TIW) + (size_t)row * 2;
            const int e0 = tie[0] >> 14, p0 = tie[0] & 16383, e1 = tie[1] >> 14, p1 = tie[1] & 16383;
            const float w0 = tiw[0], w1 = tiw[1];
            const bf16* y0 = yk + (size_t)(rb[e0] + p0) * DM; const bf16* y1 = yk + (size_t)(rb[e1] + p1) * DM;
            const float* gf = mod + ((size_t)(l - 1) * 2 + b) * 6 * DM + 5 * DM;
#pragma unroll
            for (int j = 0; j < NJV; ++j) { const int cidx = 4 * lane + 256 * j; u32x2 q0 = *(const u32x2*)(y0 + cidx), q1 = *(const u32x2*)(y1 + cidx);
                f32x4 g = *(const f32x4*)(gf + cidx);
                v[j][0] += g[0] * (w0 * bf2f(q0[0] & 0xffff) + w1 * bf2f(q1[0] & 0xffff));
                v[j][1] += g[1] * (w0 * bf2f(q0[0] >> 16) + w1 * bf2f(q1[0] >> 16));
                v[j][2] += g[2] * (w0 * bf2f(q0[1] & 0xffff) + w1 * bf2f(q1[1] & 0xffff));
                v[j][3] += g[3] * (w0 * bf2f(q0[1] >> 16) + w1 * bf2f(q1[1] >> 16)); }
        }
#pragma unroll
        for (int j = 0; j < NJV; ++j) *(f32x4*)(outp(a) + (size_t)row * DM + 4 * lane + 256 * j) = v[j];
        if (l == DEPTH) continue;
        float ss = 0.f;
#pragma unroll
        for (int j = 0; j < NJV; ++j) ss += v[j][0] * v[j][0] + v[j][1] * v[j][1] + v[j][2] * v[j][2] + v[j][3] * v[j][3];
#pragma unroll
        for (int o = 1; o < 64; o <<= 1) ss += shflx(ss, o);
        const float rs = frsq(ss * (1.0f / DM) + EPS);
        const float* mm = mod + ((size_t)l * 2 + b) * 6 * DM; const float* nm = a.in[I_NMIX] + (size_t)l * DM;
        bf16* hb = (bf16*)(ws + WS_H) + (size_t)row * DM;
#pragma unroll
        for (int j = 0; j < NJV; ++j) { const int cidx = 4 * lane + 256 * j; f32x4 g = *(const f32x4*)(nm + cidx), sh = *(const f32x4*)(mm + cidx), sc = *(const f32x4*)(mm + DM + cidx), o;
#pragma unroll
            for (int r = 0; r < 4; ++r) o[r] = v[j][r] * rs * g[r] * (1.0f + sc[r]) + sh[r];
            st_bf4(hb + cidx, o); }
    }
}

DEV void route_phase(const Args& a, unsigned char* smem, int l) {
    unsigned char* ws = wsp(a); const int tid = TID;
    float* W = (float*)smem;
    SYNC();
    for (int i = tid; i < DM * 36; i += NT) { const int k = i / 36, n = i % 36;
        W[i] = (n < 4) ? a.in[I_WG][((size_t)l * DM + k) * 4 + n] : a.in[I_WE][((size_t)l * DM + k) * 32 + n - 4]; }
    SYNC();
    const float* mod = (const float*)(ws + WS_MOD); const float* nf = a.in[I_NFFN] + (size_t)l * DM;
    int* cnt = (int*)(ws + WS_CNT) + l * 32;
    constexpr int NI = DM / 32;
    for (int pass = BID; pass < T / 16; pass += NBLK) {
        const int tok = pass * 16 + (tid >> 5), part = tid & 31, b = tok / SEQ;
        const float* xr = outp(a) + (size_t)tok * DM; float xv[NI]; float ss = 0.f;
#pragma unroll
        for (int i = 0; i < NI; ++i) { xv[i] = xr[part + 32 * i]; ss += xv[i] * xv[i]; }
#pragma unroll
        for (int o = 1; o < 32; o <<= 1) ss += shflx(ss, o);
        const float rs = frsq(ss * (1.0f / DM) + EPS);
        const float* mm = mod + ((size_t)l * 2 + b) * 6 * DM; bf16* hb = (bf16*)(ws + WS_H) + (size_t)tok * DM;
        float acc[36];
#pragma unroll
        for (int n = 0; n < 36; ++n) acc[n] = 0.f;
#pragma unroll 4
        for (int i = 0; i < NI; ++i) { const int k = part + 32 * i; const float hn = xv[i] * rs * nf[k] * (1.0f + mm[4 * DM + k]) + mm[3 * DM + k];
            hb[k] = (bf16)f2bf(hn); const float* wr = W + k * 36;
#pragma unroll
            for (int n = 0; n < 36; ++n) acc[n] += hn * wr[n]; }
#pragma unroll
        for (int n = 0; n < 36; ++n) {
#pragma unroll
            for (int o = 1; o < 32; o <<= 1) acc[n] += shflx(acc[n], o); }
        if (part == 0) {
            int gs = 0; float gm = acc[0];
#pragma unroll
            for (int g = 1; g < 4; ++g) if (acc[g] > gm) { gm = acc[g]; gs = g; }
            float den = 0.f;
#pragma unroll
            for (int g = 0; g < 4; ++g) den += fexp2((acc[g] - gm) * LOG2E);
            const float ggate = 1.0f / den;
            float el[8];
#pragma unroll
            for (int j = 0; j < 8; ++j) { el[j] = acc[4 + j];
#pragma unroll
                for (int g = 1; g < 4; ++g) if (gs == g) el[j] = acc[4 + 8 * g + j]; }
            int ia = 0; float va = el[0];
#pragma unroll
            for (int j = 1; j < 8; ++j) if (el[j] > va) { va = el[j]; ia = j; }
            int ib = -1; float vb = -3e38f;
#pragma unroll
            for (int j = 0; j < 8; ++j) if (j != ia && el[j] > vb) { vb = el[j]; ib = j; }
            const float wa = 1.0f / (1.0f + fexp2((vb - va) * LOG2E)), wb = 1.0f - wa;
            const int e0 = gs * 8 + ia, e1 = gs * 8 + ib;
            const int p0 = atomic_add_i(cnt + e0, 1), p1 = atomic_add_i(cnt + e1, 1);
            int* list = (int*)(ws + WS_LIST); list[(size_t)e0 * T + p0] = tok; list[(size_t)e1 * T + p1] = tok;
            int* tie = (int*)(ws + WS_TIE) + (size_t)tok * 2; float* tiw = (float*)(ws + WS_TIW) + (size_t)tok * 2;
            tie[0] = (e0 << 14) | p0; tie[1] = (e1 << 14) | p1; tiw[0] = ggate * wa; tiw[1] = ggate * wb;
        }
    }
}

DEV void inproj_phase(const Args& a, unsigned char* smem, int li) {
    constexpr int TN = NINP / 128, TM = T / 256;
    const bf16* A = (const bf16*)(wsp(a) + WS_H); const bf16* Bt = (const bf16*)(wsp(a) + WS_WIN) + (size_t)li * NINP * DM;
    for (int it = BID; it < TN * TM; it += NBLK) { const int tm = it / TN, tn = it % TN;
        EpiInProj E{&a, tm * 256, tn * 128, li}; ARows af{A + (size_t)tm * 256 * DM, (size_t)DM};
        gemm_tile(smem, af, Bt + (size_t)tn * 128 * DM, DM, 128, DM, E); }
}
DEV void resid_gemm_phase(const Args& a, unsigned char* smem, const bf16* A, int K, const bf16* Bt, int l) {
    constexpr int TN = DM / 128, TM = T / 256;
    const float* gate = (const float*)(wsp(a) + WS_MOD) + (size_t)l * 2 * 6 * DM + 2 * DM;
    for (int it = BID; it < TN * TM; it += NBLK) { const int tm = it / TN, tn = it % TN;
        EpiResid E{outp(a), gate, tm * 256, tn * 128}; ARows af{A + (size_t)tm * 256 * K, (size_t)K};
        gemm_tile(smem, af, Bt + (size_t)tn * 128 * K, K, 128, K, E); }
}
DEV void pw1_phase(const Args& a, unsigned char* smem, int li) {
    constexpr int TN = 2 * DM / 128, TM = T / 256;
    const bf16* A = (const bf16*)(wsp(a) + WS_H); const bf16* Bt = (const bf16*)(wsp(a) + WS_PW1) + (size_t)li * 2 * DM * DM;
    for (int it = BID; it < TN * TM; it += NBLK) { const int tm = it / TN, tn = it % TN;
        EpiGated<0> E{(bf16*)(wsp(a) + WS_GLU), (size_t)DM, tm * 256, tn * 128, 256}; ARows af{A + (size_t)tm * 256 * DM, (size_t)DM};
        gemm_tile(smem, af, Bt + (size_t)tn * 128 * DM, DM, 128, DM, E); }
}
DEV void cmp_phase_items(const Args& a, unsigned char* smem, int li, int it) {
    constexpr int TMC = (NCP + 255) / 256;
    const int kv = it / (4 * TMC), bg = (it / TMC) % 4, tm = it % TMC;
    const bf16* src = (const bf16*)(wsp(a) + (kv ? WS_VCG : WS_KCG)) + (size_t)bg * SEQ * 64;
    struct AF { const bf16* s; int m0; MDEV const bf16* operator()(int r) const { int n = m0 + r; if (n > NCMP - 1) n = NCMP - 1; return s + (size_t)n * 1024; } } af{src, tm * 256};
    EpiCmp E{&a, kv, bg, tm * 256, li};
    gemm_tile(smem, af, (const bf16*)(wsp(a) + WS_WC) + (size_t)(li * 2 + kv) * 64 * 2048, 2048, 64, 2048, E);
}
DEV void moe_gemm_phase(const Args& a, unsigned char* smem, int l, int mode) {
    unsigned char* ws = wsp(a); const int* cnt = (const int*)(ws + WS_CNT) + l * 32;
    int* rb = (int*)(smem + GEMM_LDS);
    moe_bases(cnt, rb);
    const int ntile = rb[32] >> 8;
    constexpr int TN1 = 2 * FF / 128, TN2 = DM / 128;
    const int TN = mode == 0 ? TN1 : TN2;
    const int* list = (const int*)(ws + WS_LIST);
    for (int it = BID; it < ntile * TN; it += NBLK) {
        const int rt = it / TN, tn = it % TN; int e = 0;
#pragma unroll 1
        for (int q = 1; q < 32; ++q) if ((rb[q] >> 8) <= rt) e = q;
        const int rloc = (rt << 8) - rb[e], nvalid = (cnt[e] - rloc) < 256 ? (cnt[e] - rloc) : 256;
        if (mode == 0) {
            struct AF { const bf16* hb; const int* lst; int nv; MDEV const bf16* operator()(int r) const { const int rr = r < nv ? r : nv - 1; return hb + (size_t)lst[rr] * DM; } }
                af{(const bf16*)(ws + WS_H), list + (size_t)e * T + rloc, nvalid};
            EpiGated<1> E{(bf16*)(ws + WS_ACT), (size_t)FF, rt << 8, tn * 128, nvalid};
            gemm_tile(smem, af, (const bf16*)(ws + WS_W13) + ((size_t)(l * 32 + e) * 2 * FF + tn * 128) * DM, DM, 128, DM, E);
        } else {
            ARows af{(const bf16*)(ws + WS_ACT) + (size_t)(rt << 8) * FF, (size_t)FF};
            EpiStoreBf E{(bf16*)(ws + WS_YK), (size_t)DM, rt << 8, tn * 128, nvalid};
            gemm_tile(smem, af, (const bf16*)(ws + WS_W2) + ((size_t)(l * 32 + e) * DM + tn * 128) * FF, FF, 128, FF, E);
        }
    }
}

constexpr int AT_K = 0, AT_V = 2 * 64 * LDT * 2, AT_IMP = 2 * AT_V, AT_SEL = AT_IMP + 8 * 4 * 128 * 4, AT_END = AT_SEL + 8 * 4 * 4 * 4;

template <int MASK, bool WITH_PV>
DEV void attn_block(const bf16* Kp, const bf16* Vp, const bf16x8 (&qf)[2], int j, int s, bool selbit, float C2, int h, int c,
                    f32x4 (&O)[4], float& lsum, f32x4 (&pout)[2][2]) {
    f32x4 st[2][2];
#pragma unroll
    for (int sp = 0; sp < 2; ++sp)
#pragma unroll
        for (int u = 0; u < 2; ++u) { st[sp][u] = f4zero(); const int krow = 32 * sp + 8 * (c >> 2) + 4 * u + (c & 3);
#pragma unroll
            for (int ks = 0; ks < 2; ++ks) st[sp][u] = mfma16(*(const bf16x8*)(Kp + krow * LDT + 32 * ks + 8 * h), qf[ks], st[sp][u]); }
#pragma unroll
    for (int sp = 0; sp < 2; ++sp)
#pragma unroll
        for (int u = 0; u < 2; ++u)
#pragma unroll
            for (int r = 0; r < 4; ++r) { const int key = 64 * j + 32 * sp + 8 * h + 4 * u + r; bool ok;
                if (MASK == 0) ok = 16 * key + 31 <= s; else if (MASK == 1) ok = selbit && key <= s; else ok = key <= s && key > s - 512;
                const float p = ok ? fexp2(st[sp][u][r] * LOG2E - C2) : 0.f; lsum += p; pout[sp][u][r] = p; }
    if (WITH_PV) {
        bf16x8 pb[2];
#pragma unroll
        for (int sp = 0; sp < 2; ++sp) pb[sp] = pack8(pout[sp][0], pout[sp][1]);
#pragma unroll
        for (int et = 0; et < 4; ++et)
#pragma unroll
            for (int sp = 0; sp < 2; ++sp) O[et] = mfma16(*(const bf16x8*)(Vp + (16 * et + c) * LDT + 32 * sp + 8 * h), pb[sp], O[et]);
    }
}

DEV void attn_task(const Args& a, unsigned char* smem, int li, int item) {
    unsigned char* ws = wsp(a); const int tid = TID, w = tid >> 6, l = tid & 63, h = l >> 4, c = l & 15, tl = c >> 2, hd = c & 3;
    const int bg = item & 3, b = bg >> 1, g = bg & 1, tq = (SEQ / 32 - 1) - (item >> 2), s0 = tq * 32, qblk = s0 >> 6;
    const int s = s0 + 4 * w + tl, row = b * SEQ + s;
    bf16* Kl = (bf16*)(smem + AT_K); bf16* Vl = (bf16*)(smem + AT_V); float* imps = (float*)(smem + AT_IMP) + w * 512; unsigned* selm = (unsigned*)(smem + AT_SEL) + w * 16;
    bf16x8 qf[2];
    { const bf16* qp = (const bf16*)(ws + WS_QN) + (size_t)row * 512 + (g * 4 + hd) * 64 + 8 * h; qf[0] = *(const bf16x8*)qp; qf[1] = *(const bf16x8*)(qp + 32); }
    const float* gp = (const float*)(ws + WS_GATE) + (size_t)row * 24 + (g * 4 + hd) * 3;
    const float gatec = gp[0], gates = gp[1], gatew = gp[2];
    const float* cs = (const float*)(ws + WS_CS) + li * 4;
    f32x4 outv[4];
#pragma unroll
    for (int et = 0; et < 4; ++et) outv[et] = f4zero();
    const int srow = tid >> 3, scol = (tid & 7) * 8;
    for (int i = l; i < 512; i += 64) imps[i] = 0.f;
    SYNC();

    const int ncv = s0 / 16 + 1, ncb = (ncv + 63) >> 6;
    const bf16* kcb = (const bf16*)(ws + WS_KC) + (size_t)bg * NCP * 64;
    const bf16* vcb = (const bf16*)(ws + WS_VCT) + (size_t)bg * 64 * NCP;
    float invl_c = 0.f;
    {
        f32x4 O[4]; float lsum = 0.f; f32x4 pt[2][2];
#pragma unroll
        for (int et = 0; et < 4; ++et) O[et] = f4zero();
        const float C2 = cs[0];
        bf16x8 rk = *(const bf16x8*)(kcb + (size_t)(0 * 64 + srow) * 64 + scol), rv = *(const bf16x8*)(vcb + (size_t)srow * NCP + 0 * 64 + scol);
        *(bf16x8*)(Kl + srow * LDT + scol) = rk; *(bf16x8*)(Vl + srow * LDT + scol) = rv;
        SYNC();
        for (int j = 0; j < ncb; ++j) { const int cur = j & 1;
            if (j + 1 < ncb) { rk = *(const bf16x8*)(kcb + (size_t)((j + 1) * 64 + srow) * 64 + scol); rv = *(const bf16x8*)(vcb + (size_t)srow * NCP + (j + 1) * 64 + scol); }
            attn_block<0, true>(Kl + cur * 64 * LDT, Vl + cur * 64 * LDT, qf, j, s, true, C2, h, c, O, lsum, pt);
            if (j + 1 < ncb) { *(bf16x8*)(Kl + (cur ^ 1) * 64 * LDT + srow * LDT + scol) = rk; *(bf16x8*)(Vl + (cur ^ 1) * 64 * LDT + srow * LDT + scol) = rv; }
            SYNC(); }
        lsum += shflx(lsum, 16); lsum += shflx(lsum, 32);
        invl_c = lsum > 0.f ? 1.0f / lsum : 0.f;
#pragma unroll
        for (int et = 0; et < 4; ++et)
#pragma unroll
            for (int r = 0; r < 4; ++r) outv[et][r] += gatec * invl_c * O[et][r];
        float carry = 0.f; f32x4 Od[4]; float ld = 0.f;
        rk = *(const bf16x8*)(kcb + (size_t)(0 * 64 + srow) * 64 + scol);
        *(bf16x8*)(Kl + srow * LDT + scol) = rk;
        SYNC();
        for (int j = 0; j < ncb; ++j) { const int cur = j & 1;
            if (j + 1 < ncb) rk = *(const bf16x8*)(kcb + (size_t)((j + 1) * 64 + srow) * 64 + scol);
            attn_block<0, false>(Kl + cur * 64 * LDT, Vl, qf, j, s, true, C2, h, c, Od, ld, pt);
#pragma unroll
            for (int sp = 0; sp < 2; ++sp)
#pragma unroll
                for (int u = 0; u < 2; ++u)
#pragma unroll
                    for (int r = 0; r < 4; ++r) { float p = pt[sp][u][r] * invl_c; p += shflx(p, 1); p += shflx(p, 2); pt[sp][u][r] = p; }
            const float r0 = shfl(pt[0][1][3], (l - 16) & 63), r1 = shfl(pt[1][1][3], (l - 16) & 63);
#pragma unroll
            for (int sp = 0; sp < 2; ++sp)
#pragma unroll
                for (int u = 0; u < 2; ++u) { const int m = 16 * j + 8 * sp + 2 * h + u;
                    float prev; if (u == 1) prev = pt[sp][0][3]; else if (h > 0) prev = sp == 0 ? r0 : r1; else prev = sp == 0 ? carry : r0;
                    const float val = 2.0f * (pt[sp][u][0] + pt[sp][u][1] + pt[sp][u][2]) + pt[sp][u][3] + prev;
                    if (hd == 0 && m < 128) imps[tl * 128 + m] = val; }
            carry = r1;
            if (j + 1 < ncb) *(bf16x8*)(Kl + (cur ^ 1) * 64 * LDT + srow * LDT + scol) = rk;
            SYNC(); }
    }
    unsigned mysel[4], wsel[4];
    {
        WSYNC();
        const int tk = l >> 4, i = l & 15; float vals[8];
#pragma unroll
        for (int mm = 0; mm < 8; ++mm) { const int jj = i + 16 * mm; vals[mm] = jj > qblk ? NEGV : ((jj == 0 || jj == qblk || jj == qblk - 1) ? FORCEV : imps[tk * 128 + jj]); }
        unsigned mk[4] = {0u, 0u, 0u, 0u};
#pragma unroll 1
        for (int rnd = 0; rnd < 16; ++rnd) {
            float best = vals[0]; int bj = i;
#pragma unroll
            for (int mm = 1; mm < 8; ++mm) if (vals[mm] > best) { best = vals[mm]; bj = i + 16 * mm; }
#pragma unroll
            for (int o = 1; o < 16; o <<= 1) { const float ov = shflx(best, o); const int oj = shflxi(bj, o); if (ov > best || (ov == best && oj < bj)) { best = ov; bj = oj; } }
            if (best > NEGV * 0.5f) {
#pragma unroll
                for (int q = 0; q < 4; ++q) if ((bj >> 5) == q) mk[q] |= 1u << (bj & 31); }
            if ((bj & 15) == i) {
#pragma unroll
                for (int mm = 0; mm < 8; ++mm) if ((bj >> 4) == mm) vals[mm] = -3e38f; }
        }
        if (i == 0) {
#pragma unroll
            for (int q = 0; q < 4; ++q) selm[tk * 4 + q] = mk[q]; }
        WSYNC();
#pragma unroll
        for (int q = 0; q < 4; ++q) { mysel[q] = selm[tl * 4 + q]; wsel[q] = selm[q] | selm[4 + q] | selm[8 + q] | selm[12 + q]; }
    }
#pragma unroll 1
    for (int br = 1; br <= 2; ++br) {
        const bf16* kb = (const bf16*)(ws + (br == 1 ? WS_KS : WS_KW)) + (size_t)bg * SEQ * 64;
        const bf16* vb = (const bf16*)(ws + (br == 1 ? WS_VST : WS_VWT)) + (size_t)bg * NCH * 4096;
        const int jlo = br == 1 ? 0 : (s0 >= 511 ? (s0 - 511) >> 6 : 0), jhi = qblk;
        const float C2 = cs[br];
        f32x4 O[4]; float lsum = 0.f; f32x4 pt[2][2];
#pragma unroll
        for (int et = 0; et < 4; ++et) O[et] = f4zero();
        bf16x8 rk = *(const bf16x8*)(kb + (size_t)jlo * 4096 + tid * 8), rv = *(const bf16x8*)(vb + (size_t)jlo * 4096 + tid * 8);
        *(bf16x8*)(Kl + srow * LDT + scol) = rk; *(bf16x8*)(Vl + srow * LDT + scol) = rv;
        SYNC();
        for (int j = jlo; j <= jhi; ++j) { const int cur = (j - jlo) & 1;
            if (j + 1 <= jhi) { rk = *(const bf16x8*)(kb + (size_t)(j + 1) * 4096 + tid * 8); rv = *(const bf16x8*)(vb + (size_t)(j + 1) * 4096 + tid * 8); }
            bool need = true, sb = true;
            if (br == 1) { unsigned wq = 0, mq = 0;
#pragma unroll
                for (int q = 0; q < 4; ++q) if ((j >> 5) == q) { wq = wsel[q]; mq = mysel[q]; }
                need = (wq >> (j & 31)) & 1u; sb = (mq >> (j & 31)) & 1u; }
            if (need) { if (br == 1) attn_block<1, true>(Kl + cur * 64 * LDT, Vl + cur * 64 * LDT, qf, j, s, sb, C2, h, c, O, lsum, pt);
                        else attn_block<2, true>(Kl + cur * 64 * LDT, Vl + cur * 64 * LDT, qf, j, s, sb, C2, h, c, O, lsum, pt); }
            if (j + 1 <= jhi) { *(bf16x8*)(Kl + (cur ^ 1) * 64 * LDT + srow * LDT + scol) = rk; *(bf16x8*)(Vl + (cur ^ 1) * 64 * LDT + srow * LDT + scol) = rv; }
            SYNC(); }
        lsum += shflx(lsum, 16); lsum += shflx(lsum, 32);
        const float sc = (br == 1 ? gates : gatew) * (lsum > 0.f ? 1.0f / lsum : 0.f);
#pragma unroll
        for (int et = 0; et < 4; ++et)
#pragma unroll
            for (int r = 0; r < 4; ++r) outv[et][r] += sc * O[et][r];
    }
    bf16* dst = (bf16*)(ws + WS_CAT) + (size_t)row * 1024 + (g * 4 + hd) * 64 + 4 * h;
#pragma unroll
    for (int et = 0; et < 4; ++et) st_bf4(dst + 16 * et, outv[et]);
}

constexpr int LDH = 136;
DEV void hg_cumsum(const float* fsrc  , float* segs  , int d, int seg, float (&f)[16], float (&bc)[16], float& bend, float& bmid) {
    float run = 0.f;
#pragma unroll
    for (int i = 0; i < 16; ++i) { f[i] = fsrc[(size_t)(16 * seg + i) * 128 + d]; run += log2f(f[i]); bc[i] = run; }
    SYNC();
    segs[seg * 128 + d] = run;
    SYNC();
    const float s0 = segs[d], s1 = segs[128 + d], s2 = segs[256 + d], s3 = segs[384 + d];
    const float off = seg == 0 ? 0.f : (seg == 1 ? s0 : (seg == 2 ? s0 + s1 : s0 + s1 + s2));
#pragma unroll
    for (int i = 0; i < 16; ++i) bc[i] += off;
    bend = s0 + s1 + s2 + s3; bmid = s0 + s1;
}
DEV void hg_write16(bf16* dstrow  , const float (&v)[16]) {
    u32x4 w0, w1;
#pragma unroll
    for (int q = 0; q < 4; ++q) { w0[q] = pk2(v[2 * q], v[2 * q + 1]); w1[q] = pk2(v[8 + 2 * q], v[8 + 2 * q + 1]); }
    *(u32x4*)dstrow = w0; *(u32x4*)(dstrow + 8) = w1;
}
DEV void hg_h1_task(const Args& a, unsigned char* smem, int task) {
    unsigned char* ws = wsp(a); const int tid = TID, w = tid >> 6, l = tid & 63, h = l >> 4, c = l & 15, d = tid & 127, seg = tid >> 7;
    const int bh = task / NCH, ch = task % NCH;
    bf16* kT = (bf16*)smem; bf16* vT = kT + 128 * LDT; float* segs = (float*)(vT + 128 * LDT);
    const size_t tokb = (size_t)bh * SEQ + ch * 64;
    float f[16], bc[16], bend, bmid;
    hg_cumsum((const float*)(ws + WS_HF) + tokb * 128, segs, d, seg, f, bc, bend, bmid);
    float kv[16];
#pragma unroll
    for (int i = 0; i < 16; ++i) kv[i] = (1.0f - f[i]) * fexp2(bend - bc[i]);
    hg_write16(kT + d * LDT + 16 * seg, kv);
    const bf16* vs = (const bf16*)(ws + WS_HV) + tokb * 128;
#pragma unroll
    for (int i = 0; i < 16; ++i) kv[i] = bf2f(vs[(size_t)(16 * seg + i) * 128 + d]);
    hg_write16(vT + d * LDT + 16 * seg, kv);
    if (seg == 0) ((float*)(ws + WS_GD))[((size_t)bh * NCH + ch) * 128 + d] = fexp2(bend);
    SYNC();
    f32x4 acc[8];
#pragma unroll
    for (int et = 0; et < 8; ++et) acc[et] = f4zero();
#pragma unroll
    for (int ks = 0; ks < 2; ++ks) { const bf16x8 fa = *(const bf16x8*)(kT + (16 * w + c) * LDT + 32 * ks + 8 * h);
#pragma unroll
        for (int et = 0; et < 8; ++et) acc[et] = mfma16(fa, *(const bf16x8*)(vT + (16 * et + c) * LDT + 32 * ks + 8 * h), acc[et]); }
    float* ut = (float*)(ws + WS_UT) + ((size_t)bh * NCH + ch) * 16384;
#pragma unroll
    for (int et = 0; et < 8; ++et) *(f32x4*)(ut + (size_t)(16 * et + c) * 128 + 16 * w + 4 * h) = acc[et];
    SYNC();
}
DEV void hg_scan_task(const Args& a, int sc) {
    unsigned char* ws = wsp(a); const int bh = sc >> 3, q = (sc & 7) * 512 + TID, e = q >> 5, d0 = (q & 31) * 4;
    const float* ut = (const float*)(ws + WS_UT) + (size_t)bh * NCH * 16384 + (size_t)e * 128 + d0;
    const float* gd = (const float*)(ws + WS_GD) + (size_t)bh * NCH * 128 + d0;
    bf16* st = (bf16*)(ws + WS_ST) + (size_t)bh * NCH * 16384 + (size_t)e * 128 + d0;
    f32x4 S = f4zero();
#pragma unroll 4
    for (int ch = 0; ch < NCH; ++ch) { st_bf4(st + (size_t)ch * 16384, S);
        const f32x4 g = *(const f32x4*)(gd + (size_t)ch * 128), u = *(const f32x4*)(ut + (size_t)ch * 16384);
#pragma unroll
        for (int r = 0; r < 4; ++r) S[r] = g[r] * S[r] + u[r]; }
}
DEV void hg_h3_task(const Args& a, unsigned char* smem, int li, int task) {
    unsigned char* ws = wsp(a); const int tid = TID, w = tid >> 6, l = tid & 63, h = l >> 4, c = l & 15, d = tid & 127, seg = tid >> 7;
    const int bh = task / NCH, ch = task % NCH, b = bh >> 2, hh = bh & 3;
    bf16* At = (bf16*)smem; bf16* Bt = At + 64 * LDH; bf16* Qt = Bt + 64 * LDH; bf16* vT = Qt + 64 * LDH; float* segs = (float*)(vT + 128 * LDT); float* part = segs + 512;
    const size_t tokb = (size_t)bh * SEQ + ch * 64;
    float f[16], bc[16], bend, bmid;
    hg_cumsum((const float*)(ws + WS_HF) + tokb * 128, segs, d, seg, f, bc, bend, bmid);
    const bf16* qs = (const bf16*)(ws + WS_HQ) + tokb * 128; const bf16* vs = (const bf16*)(ws + WS_HV) + tokb * 128;
    float vv[16];
#pragma unroll
    for (int i = 0; i < 16; ++i) { const int t = 16 * seg + i; const float q = bf2f(qs[(size_t)t * 128 + d]);
        At[t * LDH + d] = (bf16)f2bf(q * fexp2(bc[i] - bmid)); Bt[t * LDH + d] = (bf16)f2bf((1.0f - f[i]) * fexp2(bmid - bc[i])); Qt[t * LDH + d] = (bf16)f2bf(q * fexp2(bc[i]));
        vv[i] = bf2f(vs[(size_t)t * 128 + d]); }
    hg_write16(vT + d * LDT + 16 * seg, vv);
    SYNC();
    const int tt = w & 3, eh = w >> 2;
    f32x4 O[4];
#pragma unroll
    for (int et = 0; et < 4; ++et) O[et] = f4zero();
#pragma unroll
    for (int sp = 0; sp < 2; ++sp) {
        if (32 * sp > 16 * tt + 15) continue;
        f32x4 st[2];
#pragma unroll
        for (int u = 0; u < 2; ++u) { st[u] = f4zero(); const int krow = 32 * sp + 8 * (c >> 2) + 4 * u + (c & 3);
#pragma unroll
            for (int ks = 0; ks < 4; ++ks) st[u] = mfma16(*(const bf16x8*)(Bt + krow * LDH + 32 * ks + 8 * h), *(const bf16x8*)(At + (16 * tt + c) * LDH + 32 * ks + 8 * h), st[u]);
#pragma unroll
            for (int r = 0; r < 4; ++r) { const int sk = 32 * sp + 8 * h + 4 * u + r; if (sk > 16 * tt + c) st[u][r] = 0.f; } }
        const bf16x8 pb = pack8(st[0], st[1]);
#pragma unroll
        for (int et = 0; et < 4; ++et) O[et] = mfma16(*(const bf16x8*)(vT + (64 * eh + 16 * et + c) * LDT + 32 * sp + 8 * h), pb, O[et]);
    }
    const bf16* stp = (const bf16*)(ws + WS_ST) + ((size_t)bh * NCH + ch) * 16384;
#pragma unroll
    for (int ks = 0; ks < 4; ++ks) { const bf16x8 fq = *(const bf16x8*)(Qt + (16 * tt + c) * LDH + 32 * ks + 8 * h);
#pragma unroll
        for (int et = 0; et < 4; ++et) O[et] = mfma16(*(const bf16x8*)(stp + (size_t)(64 * eh + 16 * et + c) * 128 + 32 * ks + 8 * h), fq, O[et]); }
    float ss = 0.f;
#pragma unroll
    for (int et = 0; et < 4; ++et)
#pragma unroll
        for (int r = 0; r < 4; ++r) ss += O[et][r] * O[et][r];
    ss += shflx(ss, 16); ss += shflx(ss, 32);
    if (h == 0) part[eh * 64 + 16 * tt + c] = ss;
    SYNC();
    const float rs = frsq((part[16 * tt + c] + part[64 + 16 * tt + c]) * (1.0f / 128.0f) + EPS);
    const int tok = b * SEQ + ch * 64 + 16 * tt + c;
    const float* og = a.in[I_OG] + li * 128; const bf16* hg = (const bf16*)(ws + WS_HGS) + (size_t)tok * 512 + hh * 128;
    bf16* dst = (bf16*)(ws + WS_CAT) + (size_t)tok * 1024 + 512 + hh * 128;
#pragma unroll
    for (int et = 0; et < 4; ++et) { const int e = 64 * eh + 16 * et + 4 * h; f32x4 o;
#pragma unroll
        for (int r = 0; r < 4; ++r) o[r] = O[et][r] * rs * og[e + r] * bf2f(hg[e + r]);
        st_bf4(dst + e, o); }
    SYNC();
}

DEV void conv_task(const Args& a, unsigned char* smem, int li, int task) {
    unsigned char* ws = wsp(a); const int tid = TID, w = tid >> 6, lane = tid & 63;
    const bool act = tid < DM / 2; const int c0 = act ? 2 * tid : 0;
    const int t0 = task * 16, b = t0 / SEQ, s0 = t0 % SEQ;
    float* red = (float*)smem;
    const float* dw = a.in[I_DW] + (size_t)li * 31 * DM + c0;
    float acc[16][2];
    const float b0 = a.in[I_DWB][li * DM + c0], b1 = a.in[I_DWB][li * DM + c0 + 1];
#pragma unroll
    for (int t = 0; t < 16; ++t) { acc[t][0] = b0; acc[t][1] = b1; }
    const bf16* glu = (const bf16*)(ws + WS_GLU) + (size_t)b * SEQ * DM + c0;
    unsigned uu[46];
    { const bf16* gp = glu + (size_t)(s0 - 30) * DM;
#pragma unroll
    for (int r = 0; r < 46; ++r) { const int si = s0 + r - 30; uu[r] = si >= 0 ? *(const unsigned*)gp : 0u; gp += DM; OPAQUE(gp); } }
    const float* dwp = dw;
#pragma unroll
    for (int j = 0; j < 31; ++j) { const float w0 = dwp[0], w1 = dwp[1]; dwp += DM; OPAQUE(dwp);
#pragma unroll
        for (int t = 0; t < 16; ++t) { const unsigned q = uu[t + j]; acc[t][0] += w0 * bf2f(q & 0xffff); acc[t][1] += w1 * bf2f(q >> 16); } }
    float mean[16], rstd[16];
    SYNC();
#pragma unroll
    for (int t = 0; t < 16; ++t) { float s = act ? acc[t][0] + acc[t][1] : 0.f;
#pragma unroll
        for (int o = 1; o < 64; o <<= 1) s += shflx(s, o);
        if (lane == 0) red[w * 16 + t] = s; }
    SYNC();
#pragma unroll
    for (int t = 0; t < 16; ++t) { float s = 0.f;
#pragma unroll
        for (int q = 0; q < 8; ++q) s += red[q * 16 + t];
        mean[t] = s * (1.0f / DM); }
    SYNC();
#pragma unroll
    for (int t = 0; t < 16; ++t) { const float d0 = acc[t][0] - mean[t], d1 = acc[t][1] - mean[t]; float s = act ? d0 * d0 + d1 * d1 : 0.f;
#pragma unroll
        for (int o = 1; o < 64; o <<= 1) s += shflx(s, o);
        if (lane == 0) red[w * 16 + t] = s; }
    SYNC();
#pragma unroll
    for (int t = 0; t < 16; ++t) { float s = 0.f;
#pragma unroll
        for (int q = 0; q < 8; ++q) s += red[q * 16 + t];
        rstd[t] = frsq(s * (1.0f / DM) + EPS); }
    if (act) {
        const float g0 = a.in[I_LNG][li * DM + c0], g1 = a.in[I_LNG][li * DM + c0 + 1], e0 = a.in[I_LNB][li * DM + c0], e1 = a.in[I_LNB][li * DM + c0 + 1];
        bf16* dst = (bf16*)(ws + WS_CAT) + (size_t)t0 * DM + c0;
#pragma unroll
        for (int t = 0; t < 16; ++t) { const float y0 = (acc[t][0] - mean[t]) * rstd[t] * g0 + e0, y1 = (acc[t][1] - mean[t]) * rstd[t] * g1 + e1;
            *(unsigned*)(dst + (size_t)t * DM) = pk2(siluf(y0), siluf(y1)); }
    }
}

constexpr int PH_PER_LAYER = 9, N_PHASES = 1 + PH_PER_LAYER * DEPTH + 1;
constexpr int LDS_BYTES = 150 * 1024;

DEV void run_phase(const Args& a, unsigned char* smem, int ph) {
#ifndef ONLY
#define ONLY -1
#endif
#define EN(k) (ONLY < 0 || ONLY == (k))
    if (ph == 0) { if (EN(100)) p0_phase(a, smem); return; }
    if (ph == N_PHASES - 1) { if (EN(0)) norm_phase(a, smem, DEPTH); return; }
    const int l = (ph - 1) / PH_PER_LAYER, sub = (ph - 1) % PH_PER_LAYER, li = l >> 1; const bool even = (l & 1) == 0;
    unsigned char* ws = wsp(a);
    switch (sub) {
    case 0: if (EN(0)) norm_phase(a, smem, l); break;
    case 1: if (even) { if (EN(1)) inproj_phase(a, smem, li); } else { if (EN(11)) pw1_phase(a, smem, li); } break;
    case 2:
        if (even) { constexpr int NCI = 8 * ((NCP + 255) / 256); constexpr int NH1 = 8 * NCH;
            for (int it = BID; it < NCI + NH1; it += NBLK) { if (it < NCI) { if (EN(2)) cmp_phase_items(a, smem, li, it); } else { if (EN(12)) hg_h1_task(a, smem, it - NCI); } } }
        else { for (int it = BID; it < T / 16; it += NBLK) if (EN(13)) conv_task(a, smem, li, it); }
        break;
    case 3:
        if (even) { constexpr int NA = 4 * (SEQ / 32); const int G = NBLK;
            for (int r = 0; r * G < NA; ++r) { const int it = r * G + ((r & 1) ? (G - 1 - BID) : BID); if (it < NA) { if (EN(3)) attn_task(a, smem, li, it); } }
            for (int it = BID; it < 64; it += NBLK) if (EN(14)) hg_scan_task(a, it); }
        break;
    case 4: if (even) { for (int it = BID; it < 8 * NCH; it += NBLK) if (EN(4)) hg_h3_task(a, smem, li, it); } break;
    case 5:
        if (!EN(5)) break;
        if (even) resid_gemm_phase(a, smem, (const bf16*)(ws + WS_CAT), 1024, (const bf16*)(ws + WS_WOUT) + (size_t)li * DM * 1024, l);
        else resid_gemm_phase(a, smem, (const bf16*)(ws + WS_CAT), DM, (const bf16*)(ws + WS_PW2) + (size_t)li * DM * DM, l);
        break;
    case 6: if (EN(6)) route_phase(a, smem, l); break;
    case 7: if (EN(7)) moe_gemm_phase(a, smem, l, 0); break;
    case 8: if (EN(8)) moe_gemm_phase(a, smem, l, 1); break;
    }
}

#ifndef EMU
#define LAS __attribute__((address_space(3)))
#define XB_TMO      128
#define XB_XCNT(j)  (256  + 64 * (j))
#define XB_XSUB(j)  (1280 + 64 * (j))
#define XB_XGEN(j)  (2304 + 64 * (j))
#define XB_TOP      3328
#define XB_TOPGEN   3392
#define XCD_BAR_WORDS 3456
#define XB_SPIN_CAP (1u << 22)
__device__ __forceinline__ unsigned xb_ld(unsigned* p)              { return __hip_atomic_load(p, __ATOMIC_RELAXED, __HIP_MEMORY_SCOPE_AGENT); }
__device__ __forceinline__ unsigned xb_add(unsigned* p, unsigned v) { return __hip_atomic_fetch_add(p, v, __ATOMIC_RELAXED, __HIP_MEMORY_SCOPE_AGENT); }
__device__ __forceinline__ unsigned xb_xcc_id() { return (unsigned)__builtin_amdgcn_s_getreg((3 << 11) | 20) & 0xFu; }
#define XB_SPIN(cond, bar) do { unsigned _sp = 0; while (cond) { __builtin_amdgcn_s_sleep(1); \
    if ((++_sp & 255u) == 0u) { if (xb_ld(&(bar)[XB_TMO])) break; if (_sp > XB_SPIN_CAP) { atomicAdd(&(bar)[XB_TMO], 1u); break; } } } } while (0)
struct XcdBarrier { unsigned* bar; unsigned x; volatile LAS unsigned* st; };
__device__ __forceinline__ XcdBarrier xcd_barrier_post(unsigned* bar, volatile LAS unsigned* st) {
    XcdBarrier b; b.bar = bar; b.x = xb_xcc_id(); b.st = st;
    if (threadIdx.x == 0) (void)xb_add(&bar[XB_XCNT(b.x)], 1u);
    return b;
}
__device__ __forceinline__ void xcd_barrier_complete(unsigned* bar, unsigned x, unsigned& nloc, unsigned& nx) {
    const unsigned G = gridDim.x * gridDim.y * gridDim.z;
    unsigned sum, cnt, mine, sp = 0u;
    for (;;) {
        sum = 0u; cnt = 0u; mine = 0u;
#pragma unroll
        for (unsigned j = 0; j < 16; ++j) { const unsigned c = xb_ld(&bar[XB_XCNT(j)]); sum += c; cnt += (c > 0u) ? 1u : 0u; mine = (j == x) ? c : mine; }
        if (sum == G) break;
        __builtin_amdgcn_s_sleep(1);
        if ((++sp & 255u) == 0u) { if (xb_ld(&bar[XB_TMO])) break; if (sp > XB_SPIN_CAP) { atomicAdd(&bar[XB_TMO], 1u); break; } }
    }
    nloc = mine > 0u ? mine : 1u; nx = cnt > 0u ? cnt : 1u;
}
__device__ __forceinline__ void xcd_barrier(const XcdBarrier& b) {
    asm volatile("s_waitcnt vmcnt(0)" ::: "memory");
    __syncthreads();
    if (threadIdx.x == 0) {
        unsigned* bar = b.bar;
        __builtin_amdgcn_s_waitcnt(0);
        unsigned nloc = b.st[0], nx = b.st[1];
        if (nloc == 0u) { xcd_barrier_complete(bar, b.x, nloc, nx); b.st[0] = nloc; b.st[1] = nx; }
        const unsigned old = xb_add(&bar[XB_XSUB(b.x)], 1u);
        const unsigned gen = old / nloc;
        if (old + 1u == (gen + 1u) * nloc) {
            __builtin_amdgcn_fence(__ATOMIC_RELEASE, "agent");
            asm volatile("s_waitcnt vmcnt(0)" ::: "memory");
            const unsigned og = xb_add(&bar[XB_TOP], 1u);
            const unsigned tg = og / nx;
            if (og + 1u == (tg + 1u) * nx) xb_add(&bar[XB_TOPGEN], 1u);
            else XB_SPIN(xb_ld(&bar[XB_TOPGEN]) == tg, bar);
            __builtin_amdgcn_fence(__ATOMIC_ACQUIRE, "agent");
            xb_add(&bar[XB_XGEN(b.x)], 1u);
            asm volatile("s_waitcnt vmcnt(0)" ::: "memory");
        } else {
            XB_SPIN(xb_ld(&bar[XB_XGEN(b.x)]) == gen, bar);
            __builtin_amdgcn_fence(__ATOMIC_ACQUIRE, "agent");
            asm volatile("s_waitcnt vmcnt(0)" ::: "memory");
        }
    }
    __syncthreads();
}

__global__ void __launch_bounds__(NT, 2) mega(Args a) {
    extern __shared__ __attribute__((aligned(16))) unsigned char lds[];
    volatile LAS unsigned* st = (volatile LAS unsigned*)(LAS unsigned char*)(lds + LDS_BYTES - 16);
    if (threadIdx.x < 4) st[threadIdx.x] = 0u;
    __syncthreads();
    unsigned* barw = (unsigned*)(a.ws + WS_BAR);
    XcdBarrier bar = xcd_barrier_post(barw, st);
#pragma unroll 1
    for (int ph = 0; ph < N_PHASES; ++ph) {
        run_phase(a, lds, ph);
        if (ph + 1 < N_PHASES) xcd_barrier(bar);
    }
    if (xb_ld(&barw[XB_TMO]) != 0u) {
        const size_t gt = (size_t)blockIdx.x * NT + threadIdx.x, gs = (size_t)gridDim.x * NT;
        for (size_t i = gt; i < (size_t)T * DM; i += gs) a.out[i] = __builtin_nanf("");
    }
}

extern "C" void kernel_launch(void* const* d_in, const int* in_sizes, int n_in, void* d_out, int out_size,
                              void* d_ws, size_t ws_size, hipStream_t stream) {
    static int grid = 0;
    if (grid == 0) {
        int dev = 0, cus = 0;
        if (hipGetDevice(&dev) != hipSuccess || hipDeviceGetAttribute(&cus, hipDeviceAttributeMultiprocessorCount, dev) != hipSuccess) { grid = -1; return; }
        if (hipFuncSetAttribute((const void*)mega, hipFuncAttributeMaxDynamicSharedMemorySize, LDS_BYTES) != hipSuccess) { grid = -1; return; }
        (void)hipGetLastError();
        grid = cus;
        if (n_in != 26 || out_size != T * DM || ws_size < WS_END) { fprintf(stderr, "kernel_launch: unexpected sizes n_in %d out %d ws %zu (need %zu)\n", n_in, out_size, ws_size, (size_t)WS_END); grid = -1; return; }
    }
    if (grid < 0) return;
    (void)hipMemsetAsync((unsigned char*)d_ws + WS_BAR, 0, XCD_BAR_WORDS * 4, stream);
    Args a{};
    for (int i = 0; i < 26; ++i) a.in[i] = (const float*)d_in[i];
    a.out = (float*)d_out; a.ws = (unsigned char*)d_ws;
    hipLaunchKernelGGL(mega, dim3(grid), dim3(NT), LDS_BYTES, stream, a);
}
#endif
```

```cpp
#ifdef EMU
#include "emu.h"
#define DEV static inline
#define MDEV inline
#define OPAQUE(p)
#define TID emu_tid()
#define BID (EB->bid)
#define NBLK (EB->nblk)
#define SYNC() emu_sync_block()
#define WSYNC() emu_sync_wave()
#define mfma16(a, b, c) emu_mfma16(a, b, c)
DEV float shflx(float v, int m) { return emu_shfl_f(v, (emu_tid() & 63) ^ m); }
DEV int shflxi(int v, int m) { return (int)emu_shfl_u((unsigned)v, (emu_tid() & 63) ^ m); }
DEV float shfl(float v, int s) { return emu_shfl_f(v, s); }
DEV int atomic_add_i(int* p, int v) { return __atomic_fetch_add(p, v, __ATOMIC_RELAXED); }
DEV float fexp2(float x) { return exp2f(x); }
DEV float frcp(float x) { return 1.0f / x; }
DEV float frsq(float x) { return 1.0f / sqrtf(x); }
typedef short s16x4 __attribute__((vector_size(8)));
static inline s16x4 emu_tr4(const unsigned short* p) {
    EmuWave& w = EB->wave[emu_tid() >> 6]; int l = emu_tid() & 63;
    const unsigned short** tab = (const unsigned short**)w.a;
    tab[l] = p; emu_sync_wave();
    s16x4 r; int g = l & 48, i = l & 15;
    for (int q = 0; q < 4; ++q) r[q] = (short)tab[g + 4 * q + (i >> 2)][i & 3];
    emu_sync_wave(); return r;
}
#define tr4(p) emu_tr4(p)
#else
#include <hip/hip_runtime.h>
#include <cstdio>
#include <cstdint>
typedef short bf16x8 __attribute__((ext_vector_type(8)));
typedef float f32x4 __attribute__((ext_vector_type(4)));
typedef unsigned u32x4 __attribute__((ext_vector_type(4)));
typedef unsigned u32x2 __attribute__((ext_vector_type(2)));
#define DEV __device__ __forceinline__
#define MDEV __device__ __forceinline__
#define OPAQUE(p) asm volatile("" : "+v"(p))
DEV int tid_opaque() { int t = (int)threadIdx.x; asm volatile("" : "+v"(t)); return t; }
#define TID tid_opaque()
#define BID ((int)blockIdx.x)
#define NBLK ((int)gridDim.x)
#define SYNC() __syncthreads()
#define WSYNC() __builtin_amdgcn_wave_barrier()
#define mfma16(a, b, c) __builtin_amdgcn_mfma_f32_16x16x32_bf16(a, b, c, 0, 0, 0)
DEV float shflx(float v, int m) { return __shfl_xor(v, m); }
DEV int shflxi(int v, int m) { return __shfl_xor(v, m); }
DEV float shfl(float v, int s) { return __shfl(v, s); }
DEV int atomic_add_i(int* p, int v) { return atomicAdd(p, v); }
DEV float fexp2(float x) { return exp2f(x); }
DEV float frcp(float x) { return 1.0f / x; }
DEV float frsq(float x) { return rsqrtf(x); }
typedef short s16x4 __attribute__((ext_vector_type(4)));
#define tr4(p) __builtin_amdgcn_ds_read_tr16_b64_v4i16((__attribute__((address_space(3))) s16x4*)(p))
#endif

typedef unsigned short bf16;

#ifndef DM
#define DM 1024
#endif
#ifndef SEQ
#define SEQ 8192
#endif
#ifndef FF
#define FF 512
#endif
constexpr int NBATCH = 2, T = NBATCH * SEQ, DEPTH = 4;
constexpr int NIN = 3352, NINP = 3456;
constexpr int NT = 512;
constexpr int NCH = SEQ / 64;
constexpr int NCP = SEQ / 16;
constexpr int NCMP = NCP - 1;
constexpr int MOE_ROWS = 2 * T + 32 * 256;
constexpr float EPS = 1e-6f, NEGV = -1e30f, FORCEV = 1e4f, LOG2E = 1.4426950408889634f;

constexpr size_t al(size_t x) { return (x + 255) & ~(size_t)255; }
constexpr size_t WS_BAR = 0;
constexpr size_t WS_CNT = 16384;
constexpr size_t WS_MOD = WS_CNT + 1024;
constexpr size_t WS_LB = al(WS_MOD + (size_t)DEPTH * 2 * 6 * DM * 4);
constexpr size_t WS_CB = al(WS_LB + 2 * 512 * 4);
constexpr size_t WS_CS = al(WS_CB + 2 * 2 * 64 * 4);
constexpr size_t WS_WIN = al(WS_CS + 64);
constexpr size_t WS_WOUT = al(WS_WIN + (size_t)2 * NINP * DM * 2);
constexpr size_t WS_PW1 = al(WS_WOUT + (size_t)2 * DM * 1024 * 2);
constexpr size_t WS_PW2 = al(WS_PW1 + (size_t)2 * 2 * DM * DM * 2);
constexpr size_t WS_WC = al(WS_PW2 + (size_t)2 * DM * DM * 2);
constexpr size_t WS_W13 = al(WS_WC + (size_t)2 * 2 * 64 * 2048 * 2);
constexpr size_t WS_W2 = al(WS_W13 + (size_t)DEPTH * 32 * 2 * FF * DM * 2);
constexpr size_t WS_H = al(WS_W2 + (size_t)DEPTH * 32 * DM * FF * 2);
constexpr size_t WS_QN = al(WS_H + (size_t)T * DM * 2);
constexpr size_t WS_KCG = al(WS_QN + (size_t)T * 512 * 2);
constexpr size_t WS_VCG = al(WS_KCG + (size_t)T * 128 * 2);
constexpr size_t WS_KS = al(WS_VCG + (size_t)T * 128 * 2);
constexpr size_t WS_KW = al(WS_KS + (size_t)T * 128 * 2);
constexpr size_t WS_VST = al(WS_KW + (size_t)T * 128 * 2);
constexpr size_t WS_VWT = al(WS_VST + (size_t)T * 128 * 2);
constexpr size_t WS_KC = al(WS_VWT + (size_t)T * 128 * 2);
constexpr size_t WS_VCT = al(WS_KC + (size_t)4 * NCP * 64 * 2);
constexpr size_t WS_GATE = al(WS_VCT + (size_t)4 * NCP * 64 * 2);
constexpr size_t WS_HQ = al(WS_GATE + (size_t)T * 24 * 4);
constexpr size_t WS_HF = al(WS_HQ + (size_t)T * 512 * 2);
constexpr size_t WS_HV = al(WS_HF + (size_t)T * 512 * 4);
constexpr size_t WS_HGS = al(WS_HV + (size_t)T * 512 * 2);
constexpr size_t WS_UT = al(WS_HGS + (size_t)T * 512 * 2);
constexpr size_t WS_ST = al(WS_UT + (size_t)8 * NCH * 128 * 128 * 4);
constexpr size_t WS_GD = al(WS_ST + (size_t)8 * NCH * 128 * 128 * 2);
constexpr size_t WS_CAT = al(WS_GD + (size_t)8 * NCH * 128 * 4);
constexpr size_t WS_GLU = al(WS_CAT + (size_t)T * 1024 * 2);
constexpr size_t WS_TIE = al(WS_GLU + (size_t)T * DM * 2);
constexpr size_t WS_TIW = al(WS_TIE + (size_t)T * 2 * 4);
constexpr size_t WS_LIST = al(WS_TIW + (size_t)T * 2 * 4);
constexpr size_t WS_ACT = al(WS_LIST + (size_t)32 * T * 4);
constexpr size_t WS_YK = al(WS_ACT + (size_t)MOE_ROWS * FF * 2);
constexpr size_t WS_END = al(WS_YK + (size_t)MOE_ROWS * DM * 2);

struct Args { const float* in[26]; float* out; unsigned char* ws; };
enum { I_X = 0, I_C, I_ADAW, I_ADAB, I_NMIX, I_NFFN, I_WIN, I_WOUT, I_CWK, I_CWV, I_CPE, I_QG, I_KG, I_LBL, I_OG,
       I_PW1, I_DW, I_DWB, I_LNG, I_LNB, I_PW2, I_WG, I_WE, I_W1, I_W3, I_W2 };

#ifdef EMU
DEV unsigned char* wsp(const Args& a) { return a.ws; }
DEV float* outp(const Args& a) { return a.out; }
#else
DEV unsigned char* wsp(const Args& a) { int z = 0; asm volatile("" : "+s"(z)); return a.ws + z; }
DEV float* outp(const Args& a) { int z = 0; asm volatile("" : "+s"(z)); return a.out + z; }
#endif

#ifdef EMU
#define INP(a, X) ((a).in[X])
#else
DEV int zero_opaque() { int z = 0; asm volatile("" : "+s"(z)); return z; }
#define INP(a, X) ((a).in[(X) + zero_opaque()])
#endif

DEV unsigned f2bf(float f) { unsigned u = __builtin_bit_cast(unsigned, f); return (u + 0x7fffu + ((u >> 16) & 1u)) >> 16; }
DEV float bf2f(unsigned h) { return __builtin_bit_cast(float, h << 16); }
#ifdef EMU
DEV unsigned pk2(float lo, float hi) { return f2bf(lo) | (f2bf(hi) << 16); }
#else
typedef float f32x2_t __attribute__((ext_vector_type(2)));
typedef __bf16 bf16x2_t __attribute__((ext_vector_type(2)));
DEV unsigned pk2(float lo, float hi) { f32x2_t v = {lo, hi}; bf16x2_t b = __builtin_convertvector(v, bf16x2_t); return __builtin_bit_cast(unsigned, b); }
#endif
DEV float sigm(float x) { return frcp(1.0f + fexp2(-x * LOG2E)); }
DEV float siluf(float x) { return x * sigm(x); }
DEV f32x4 f4zero() { f32x4 z = {0.f, 0.f, 0.f, 0.f}; return z; }
DEV bf16x8 pack8(f32x4 a, f32x4 b) {
    u32x4 w; w[0] = pk2(a[0], a[1]); w[1] = pk2(a[2], a[3]); w[2] = pk2(b[0], b[1]); w[3] = pk2(b[2], b[3]);
    return __builtin_bit_cast(bf16x8, w);
}
DEV void st_bf4(bf16* p, f32x4 v) { u32x2 w; w[0] = pk2(v[0], v[1]); w[1] = pk2(v[2], v[3]); *(u32x2*)p = w; }

constexpr int LDT = 72;
constexpr int GEMM_AS = 256 * LDT, GEMM_BS = 128 * LDT;
constexpr int GEMM_LDS = 2 * (GEMM_AS + GEMM_BS) * 2;

template <class AF, class EPI>
DEV void gemm_tile(unsigned char* smem, AF af, const bf16* Bt, int ldb, int nvalid, int K, EPI& epi) {
    const int tid = TID, w = tid >> 6, l = tid & 63, h = l >> 4, c = l & 15, wm = w >> 1, wn = w & 1;
    bf16* As = (bf16*)smem; bf16* Bs = As + 2 * GEMM_AS;
    const bf16* ap[4]; const bf16* bp[2];
    const int col8 = (tid & 7) * 8, r0 = tid >> 3;
#pragma unroll
    for (int i = 0; i < 4; ++i) ap[i] = af(r0 + 64 * i) + col8;
#pragma unroll
    for (int i = 0; i < 2; ++i) { int rn = r0 + 64 * i; if (rn >= nvalid) rn = nvalid - 1; bp[i] = Bt + (size_t)rn * ldb + col8; }
    f32x4 acc[4][4];
#pragma unroll
    for (int i = 0; i < 4; ++i)
#pragma unroll
        for (int j = 0; j < 4; ++j) acc[i][j] = f4zero();
    bf16x8 ra[4], rb[2];
#pragma unroll
    for (int i = 0; i < 4; ++i) ra[i] = *(const bf16x8*)(ap[i]);
#pragma unroll
    for (int i = 0; i < 2; ++i) rb[i] = *(const bf16x8*)(bp[i]);
    SYNC();
#pragma unroll
    for (int i = 0; i < 4; ++i) *(bf16x8*)(As + (r0 + 64 * i) * LDT + col8) = ra[i];
#pragma unroll
    for (int i = 0; i < 2; ++i) *(bf16x8*)(Bs + (r0 + 64 * i) * LDT + col8) = rb[i];
    SYNC();
    const int nk = K / 64;
    for (int kt = 0; kt < nk; ++kt) {
        const int cur = kt & 1;
        if (kt + 1 < nk) {
#pragma unroll
            for (int i = 0; i < 4; ++i) ra[i] = *(const bf16x8*)(ap[i] + (kt + 1) * 64);
#pragma unroll
            for (int i = 0; i < 2; ++i) rb[i] = *(const bf16x8*)(bp[i] + (kt + 1) * 64);
        }
        const bf16* Ac = As + cur * GEMM_AS + (wm * 64 + c) * LDT + 8 * h;
        const bf16* Bc = Bs + cur * GEMM_BS + (wn * 64 + c) * LDT + 8 * h;
#pragma unroll
        for (int kk = 0; kk < 2; ++kk) {
            bf16x8 fa[4], fb[4];
#pragma unroll
            for (int i = 0; i < 4; ++i) { fa[i] = *(const bf16x8*)(Ac + i * 16 * LDT + kk * 32); fb[i] = *(const bf16x8*)(Bc + i * 16 * LDT + kk * 32); }
#pragma unroll
            for (int ni = 0; ni < 4; ++ni)
#pragma unroll
                for (int mi = 0; mi < 4; ++mi) acc[ni][mi] = mfma16(fb[ni], fa[mi], acc[ni][mi]);
        }
        if (kt + 1 < nk) {
            const int nx = cur ^ 1;
#pragma unroll
            for (int i = 0; i < 4; ++i) *(bf16x8*)(As + nx * GEMM_AS + (r0 + 64 * i) * LDT + col8) = ra[i];
#pragma unroll
            for (int i = 0; i < 2; ++i) *(bf16x8*)(Bs + nx * GEMM_BS + (r0 + 64 * i) * LDT + col8) = rb[i];
        }
        SYNC();
    }
    epi(acc, wm * 64, wn * 64, h, c);
}

struct ARows { const bf16* base; size_t ld; MDEV const bf16* operator()(int r) const { return base + (size_t)r * ld; } };

constexpr int LDB = 136;
constexpr int GEMM_BS2 = 64 * LDB;
constexpr int GEMM2_LDS = (2 * GEMM_AS + 2 * GEMM_BS2) * 2;
DEV bf16x8 tr_read8(const bf16* p0, const bf16* p1) {
    const s16x4 x = tr4(p0), y = tr4(p1); bf16x8 r;
    r[0] = x[0]; r[1] = x[1]; r[2] = x[2]; r[3] = x[3]; r[4] = y[0]; r[5] = y[1]; r[6] = y[2]; r[7] = y[3]; return r;
}
template <class AF, class BF, class EPI>
DEV void gemm_tile2(unsigned char* smem, AF af, BF bf, int ldb, int K, EPI& epi) {
    const int tid = TID, w = tid >> 6, l = tid & 63, h = l >> 4, c = l & 15, wm = w >> 1, wn = w & 1;
    bf16* As = (bf16*)smem; bf16* Bs = As + 2 * GEMM_AS;
    const bf16* ap[4];
    const int col8 = (tid & 7) * 8, r0 = tid >> 3;
#pragma unroll
    for (int i = 0; i < 4; ++i) ap[i] = af(r0 + 64 * i) + col8;
    const int bn4 = (tid & 31) * 4, bk = tid >> 5;
    const float* bp = bf(bn4); const bool bok = bp != nullptr;
    if (bok) bp += (size_t)bk * ldb;
    const size_t bstep = (size_t)16 * ldb;
    f32x4 acc[4][4];
#pragma unroll
    for (int i = 0; i < 4; ++i)
#pragma unroll
        for (int j = 0; j < 4; ++j) acc[i][j] = f4zero();
    bf16x8 ra[4]; f32x4 rb[4];
#pragma unroll
    for (int i = 0; i < 4; ++i) { ra[i] = *(const bf16x8*)(ap[i]); rb[i] = bok ? *(const f32x4*)(bp + i * bstep) : f4zero(); }
    SYNC();
#pragma unroll
    for (int i = 0; i < 4; ++i) { *(bf16x8*)(As + (r0 + 64 * i) * LDT + col8) = ra[i]; st_bf4(Bs + (bk + 16 * i) * LDB + bn4, rb[i]); }
    SYNC();
    const int nk = K / 64;
    for (int kt = 0; kt < nk; ++kt) {
        const int cur = kt & 1;
        if (kt + 1 < nk) {
#pragma unroll
            for (int i = 0; i < 4; ++i) { ra[i] = *(const bf16x8*)(ap[i] + (kt + 1) * 64); rb[i] = bok ? *(const f32x4*)(bp + (size_t)(kt + 1) * 64 * ldb + i * bstep) : f4zero(); }
        }
        const bf16* Ac = As + cur * GEMM_AS + (wm * 64 + c) * LDT + 8 * h;
        const bf16* Bc = Bs + cur * GEMM_BS2 + (8 * h + (c >> 2)) * LDB + wn * 64 + 4 * (c & 3);
#pragma unroll
        for (int kk = 0; kk < 2; ++kk) {
            bf16x8 fa[4], fb[4];
#pragma unroll
            for (int i = 0; i < 4; ++i) { fa[i] = *(const bf16x8*)(Ac + i * 16 * LDT + kk * 32); fb[i] = tr_read8(Bc + (32 * kk) * LDB + 16 * i, Bc + (32 * kk + 4) * LDB + 16 * i); }
#pragma unroll
            for (int ni = 0; ni < 4; ++ni)
#pragma unroll
                for (int mi = 0; mi < 4; ++mi) acc[ni][mi] = mfma16(fb[ni], fa[mi], acc[ni][mi]);
        }
        if (kt + 1 < nk) {
            const int nx = cur ^ 1;
#pragma unroll
            for (int i = 0; i < 4; ++i) { *(bf16x8*)(As + nx * GEMM_AS + (r0 + 64 * i) * LDT + col8) = ra[i]; st_bf4(Bs + nx * GEMM_BS2 + (bk + 16 * i) * LDB + bn4, rb[i]); }
        }
        SYNC();
    }
    epi(acc, wm * 64, wn * 64, h, c);
}
struct BPlain { const float* base; MDEV const float* operator()(int nt) const { return base + nt; } };
struct BInProjMap { const float* base; int n0; MDEV const float* operator()(int nt) const { const int n = n0 + nt; const int sc = n < 1280 ? n : (n < 3328 ? n + 24 : (n < 3352 ? 1280 + (n - 3328) : -1)); return sc < 0 ? nullptr : base + sc; } };
struct BInter { const float* s0; const float* s1; int n0; MDEV const float* operator()(int nt) const { const int n = n0 + nt, g = n >> 6, w = n & 63; return w < 32 ? s0 + g * 32 + w : s1 + g * 32 + w - 32; } };
struct BClamp64 { const float* base; MDEV const float* operator()(int nt) const { return base + (nt & 63); } };

struct EpiInProj {
    const Args* a; int m0, n0, li;
    MDEV void operator()(f32x4 (&acc)[4][4], int mw, int nw, int h, int c) const {
        unsigned char* ws = wsp(*a);
        const int nb = n0 + nw;
        const int tokb = m0 + mw + c;
        if (nb < 512 || (nb >= 768 && nb < 896) || (nb >= 1024 && nb < 1152)) {
            const float* gain; float mul = 1.f; bf16* dst; int kind;
            if (nb < 512) { gain = INP(*a, I_QG) + li * 64; mul = 0.125f; kind = 0; dst = (bf16*)(ws + WS_QN); }
            else if (nb < 896) { gain = INP(*a, I_KG) + (li * 3 + 1) * 64; kind = 1; dst = (bf16*)(ws + WS_KS); }
            else { gain = INP(*a, I_KG) + (li * 3 + 2) * 64; kind = 1; dst = (bf16*)(ws + WS_KW); }
            const int g = (nb >> 6) & 1;
#pragma unroll
            for (int mi = 0; mi < 4; ++mi) {
                float ss = 0.f;
#pragma unroll
                for (int ni = 0; ni < 4; ++ni) { f32x4 v = acc[ni][mi]; ss += v[0] * v[0] + v[1] * v[1] + v[2] * v[2] + v[3] * v[3]; }
                ss += shflx(ss, 16); ss += shflx(ss, 32);
                const float rs = frsq(ss * (1.0f / 64.0f) + EPS) * mul;
                const int tok = tokb + 16 * mi;
#pragma unroll
                for (int ni = 0; ni < 4; ++ni) {
                    const int d = 16 * ni + 4 * h; f32x4 v = acc[ni][mi], o;
#pragma unroll
                    for (int r = 0; r < 4; ++r) o[r] = v[r] * rs * gain[d + r];
                    if (kind == 0) st_bf4(dst + (size_t)tok * 512 + nb + d, o);
                    else { const int b = tok / SEQ, s = tok % SEQ; st_bf4(dst + ((size_t)(b * 2 + g) * SEQ + s) * 64 + d, o); }
                }
            }
        } else if (nb < 768) {
            bf16* dst = (bf16*)(ws + (nb < 640 ? WS_KCG : WS_VCG)); const int g = (nb >> 6) & 1;
#pragma unroll
            for (int mi = 0; mi < 4; ++mi) { const int tok = tokb + 16 * mi, b = tok / SEQ, s = tok % SEQ;
#pragma unroll
                for (int ni = 0; ni < 4; ++ni) st_bf4(dst + ((size_t)(b * 2 + g) * SEQ + s) * 64 + 16 * ni + 4 * h, acc[ni][mi]); }
        } else if (nb < 1280) {
            bf16* dst = (bf16*)(ws + (nb < 1024 ? WS_VST : WS_VWT)); const int g = (nb >> 6) & 1;
#pragma unroll
            for (int mi = 0; mi < 4; ++mi) { const int tok = tokb + 16 * mi, b = tok / SEQ, s = tok % SEQ;
                bf16* p = dst + ((size_t)(b * 2 + g) * NCH + (s >> 6)) * 4096 + (s & 63);
#pragma unroll
                for (int ni = 0; ni < 4; ++ni)
#pragma unroll
                    for (int r = 0; r < 4; ++r) p[(16 * ni + 4 * h + r) * 64] = (bf16)f2bf(acc[ni][mi][r]); }
        } else if (nb < 3328) {
            const int sec = (nb - 1280) >> 9, cc = (nb - 1280) & 511, hh = cc >> 7, d0 = cc & 127;
#pragma unroll
            for (int mi = 0; mi < 4; ++mi) { const int tok = tokb + 16 * mi, b = tok / SEQ, s = tok % SEQ;
                const size_t hrow = ((size_t)(b * 4 + hh) * SEQ + s) * 128 + d0;
#pragma unroll
                for (int ni = 0; ni < 4; ++ni) { const int d = 16 * ni + 4 * h; f32x4 v = acc[ni][mi], o;
                    if (sec == 0) { for (int r = 0; r < 4; ++r) o[r] = siluf(v[r]); st_bf4((bf16*)(ws + WS_HQ) + hrow + d, o); }
                    else if (sec == 1) { const float* lb = (const float*)(ws + WS_LB) + li * 512 + cc + d;
                        for (int r = 0; r < 4; ++r) o[r] = lb[r] + (1.0f - lb[r]) * sigm(v[r]);
                        *(f32x4*)((float*)(ws + WS_HF) + hrow + d) = o; }
                    else if (sec == 2) st_bf4((bf16*)(ws + WS_HV) + hrow + d, v);
                    else { for (int r = 0; r < 4; ++r) o[r] = siluf(v[r]); st_bf4((bf16*)(ws + WS_HGS) + (size_t)tok * 512 + cc + d, o); }
                } }
        } else if (nb == 3328) {
            float* dst = (float*)(ws + WS_GATE);
#pragma unroll
            for (int mi = 0; mi < 4; ++mi) { const int tok = tokb + 16 * mi;
#pragma unroll
                for (int ni = 0; ni < 2; ++ni)
#pragma unroll
                    for (int r = 0; r < 4; ++r) { const int n = 16 * ni + 4 * h + r; if (n < 24) dst[(size_t)tok * 24 + n] = sigm(acc[ni][mi][r]); } }
        }
    }
};

struct EpiResid {
    float* x; const float* gate; int m0, n0;
    MDEV void operator()(f32x4 (&acc)[4][4], int mw, int nw, int h, int c) const {
#pragma unroll
        for (int mi = 0; mi < 4; ++mi) { const int tok = m0 + mw + 16 * mi + c, b = tok / SEQ;
#pragma unroll
            for (int ni = 0; ni < 4; ++ni) { const int n = n0 + nw + 16 * ni + 4 * h;
                f32x4 g = *(const f32x4*)(gate + (size_t)b * 6 * DM + n); f32x4* p = (f32x4*)(x + (size_t)tok * DM + n); f32x4 v = *p;
#pragma unroll
                for (int r = 0; r < 4; ++r) v[r] += g[r] * acc[ni][mi][r];
                *p = v; } }
    }
};
template <int MODE> struct EpiGated {
    bf16* dst; size_t ld; int m0, n0, mvalid;
    MDEV void operator()(f32x4 (&acc)[4][4], int mw, int nw, int h, int c) const {
        const int cb = (n0 + nw) / 2;
#pragma unroll
        for (int mi = 0; mi < 4; ++mi) { const int m = mw + 16 * mi + c; if (m >= mvalid) continue;
#pragma unroll
            for (int ni = 0; ni < 2; ++ni) { f32x4 o;
#pragma unroll
                for (int r = 0; r < 4; ++r) { const float av = acc[ni][mi][r], bv = acc[ni + 2][mi][r]; o[r] = MODE == 0 ? av * sigm(bv) : siluf(av) * bv; }
                st_bf4(dst + (size_t)(m0 + m) * ld + cb + 16 * ni + 4 * h, o); } }
    }
};
struct EpiStoreBf {
    bf16* dst; size_t ld; int m0, n0, mvalid;
    MDEV void operator()(f32x4 (&acc)[4][4], int mw, int nw, int h, int c) const {
#pragma unroll
        for (int mi = 0; mi < 4; ++mi) { const int m = mw + 16 * mi + c; if (m >= mvalid) continue;
#pragma unroll
            for (int ni = 0; ni < 4; ++ni) st_bf4(dst + (size_t)(m0 + m) * ld + n0 + nw + 16 * ni + 4 * h, acc[ni][mi]); }
    }
};
struct EpiCmp {
    const Args* a; int kv, bg, m0, li;
    MDEV void operator()(f32x4 (&acc)[4][4], int mw, int nw, int h, int c) const {
        if (nw != 0) return;
        unsigned char* ws = wsp(*a);
        const float* bias = (const float*)(ws + WS_CB) + (li * 2 + kv) * 64;
        const float* gain = INP(*a, I_KG) + (li * 3 + 0) * 64;
#pragma unroll
        for (int mi = 0; mi < 4; ++mi) { const int n = m0 + mw + 16 * mi + c; const bool ok = n < NCMP;
            f32x4 v[4]; float ss = 0.f;
#pragma unroll
            for (int ni = 0; ni < 4; ++ni) { v[ni] = acc[ni][mi];
#pragma unroll
                for (int r = 0; r < 4; ++r) { v[ni][r] += bias[16 * ni + 4 * h + r]; ss += v[ni][r] * v[ni][r]; } }
            ss += shflx(ss, 16); ss += shflx(ss, 32);
            if (n >= NCP) continue;
            if (kv == 0) { const float rs = frsq(ss * (1.0f / 64.0f) + EPS); bf16* p = (bf16*)(ws + WS_KC) + ((size_t)bg * NCP + n) * 64;
#pragma unroll
                for (int ni = 0; ni < 4; ++ni) { f32x4 o;
#pragma unroll
                    for (int r = 0; r < 4; ++r) o[r] = ok ? v[ni][r] * rs * gain[16 * ni + 4 * h + r] : 0.f;
                    st_bf4(p + 16 * ni + 4 * h, o); }
            } else { bf16* p = (bf16*)(ws + WS_VCT) + (size_t)bg * 64 * NCP + n;
#pragma unroll
                for (int ni = 0; ni < 4; ++ni)
#pragma unroll
                    for (int r = 0; r < 4; ++r) p[(size_t)(16 * ni + 4 * h + r) * NCP] = (bf16)f2bf(ok ? v[ni][r] : 0.f); }
        }
    }
};

DEV void tr_tile(unsigned char* smem, const float* src0, const float* src1, int ld, int K, int mode, bf16* dst, int n0, int k0) {
    bf16* tl = (bf16*)smem;
    const int tid = TID;
    SYNC();
#pragma unroll
    for (int i = 0; i < 8; ++i) {
        const int e = tid + 512 * i, kk = e >> 6, nn = e & 63, n = n0 + nn; float v = 0.f;
        if (mode == 0) v = src0[(size_t)(k0 + kk) * ld + n];
        else if (mode == 1) { int sc = n < 1280 ? n : (n < 3328 ? n + 24 : (n < 3352 ? 1280 + (n - 3328) : -1)); if (sc >= 0) v = src0[(size_t)(k0 + kk) * ld + sc]; }
        else { const int g = n >> 6, w = n & 63; v = (w < 32) ? src0[(size_t)(k0 + kk) * ld + g * 32 + w] : src1[(size_t)(k0 + kk) * ld + g * 32 + w - 32]; }
        tl[nn * LDT + kk] = (bf16)f2bf(v);
    }
    SYNC();
    const int nn = tid >> 3, k8 = (tid & 7) * 8;
    *(bf16x8*)(dst + (size_t)(n0 + nn) * K + k0 + k8) = *(const bf16x8*)(tl + nn * LDT + k8);
}

struct TrJob { const float* s0; const float* s1; int ld, K, N, mode; bf16* dst; };
DEV void p0_phase(const Args& a, unsigned char* smem) {
    unsigned char* ws = wsp(a); const int tid = TID;
    {
        float* red = (float*)smem;
        const int ntask = DEPTH * (6 * DM / 64);
        for (int t = BID; t < ntask; t += NBLK) {
            const int l = t / (6 * DM / 64), j0 = (t % (6 * DM / 64)) * 64, col = tid & 63, ks = tid >> 6;
            const float* w = INP(a, I_ADAW) + (size_t)l * DM * 6 * DM + j0 + col; const float* cc = INP(a, I_C);
            float a0 = 0.f, a1 = 0.f;
            for (int k = ks * (DM / 8); k < (ks + 1) * (DM / 8); ++k) { const float wv = w[(size_t)k * 6 * DM]; a0 += siluf(cc[k]) * wv; a1 += siluf(cc[DM + k]) * wv; }
            SYNC();
            red[(ks * 2 + 0) * 64 + col] = a0; red[(ks * 2 + 1) * 64 + col] = a1;
            SYNC();
            if (tid < 128) { const int b = tid >> 6; float s = INP(a, I_ADAB)[(size_t)l * 6 * DM + j0 + col];
                for (int q = 0; q < 8; ++q) s += red[(q * 2 + b) * 64 + col];
                ((float*)(ws + WS_MOD))[((size_t)l * 2 + b) * 6 * DM + j0 + col] = s; }
        }
    }
    if (BID == 0) {
        for (int i = tid; i < DEPTH * 32; i += NT) ((int*)(ws + WS_CNT))[i] = 0;
        for (int n = tid; n < 512; n += NT) { const float l0 = INP(a, I_LBL)[n], l1 = INP(a, I_LBL)[512 + n]; const float m = fmaxf(l0, l1);
            const float e0 = fexp2((l0 - m) * LOG2E), e1 = fexp2((l1 - m) * LOG2E);
            ((float*)(ws + WS_LB))[n] = 0.f; ((float*)(ws + WS_LB))[512 + n] = e1 / (e0 + e1); }
        if (tid < 2) { const int i = tid; float mq = 0.f; for (int d = 0; d < 64; ++d) mq = fmaxf(mq, fabsf(INP(a, I_QG)[i * 64 + d]));
            for (int br = 0; br < 3; ++br) { float mk = 0.f; for (int d = 0; d < 64; ++d) mk = fmaxf(mk, fabsf(INP(a, I_KG)[(i * 3 + br) * 64 + d]));
                ((float*)(ws + WS_CS))[i * 4 + br] = 8.0f * mq * mk * LOG2E; } }
    }
    if (BID == 1 % NBLK && tid < 256) {
        const int i = tid >> 7, kv = (tid >> 6) & 1, e = tid & 63; const float* W = INP(a, kv ? I_CWV : I_CWK) + (size_t)i * 2048 * 64; const float* pe = INP(a, I_CPE) + (size_t)i * 2048;
        float s = 0.f; for (int k = 0; k < 2048; ++k) s += pe[k] * W[(size_t)k * 64 + e];
        ((float*)(ws + WS_CB))[(i * 2 + kv) * 64 + e] = s;
    }
}

constexpr int NJV = DM / 256;
DEV void moe_bases(const int* cnt, int* rb  ) {
    if (TID == 0) { int acc = 0; for (int e = 0; e < 32; ++e) { rb[e] = acc; acc += ((cnt[e] + 255) >> 8) << 8; } rb[32] = acc; }
    SYNC();
}
DEV void norm_phase(const Args& a, unsigned char* smem, int l) {
    unsigned char* ws = wsp(a); const int tid = TID, w = tid >> 6, lane = tid & 63;
    int* rb = (int*)smem;
    if (l > 0) moe_bases((const int*)(ws + WS_CNT) + (l - 1) * 32, rb);
    const float* mod = (const float*)(ws + WS_MOD);
    const bf16* yk = (const bf16*)(ws + WS_YK);
    for (int row = BID * 8 + w; row < T; row += NBLK * 8) {
        const int b = row / SEQ;
        f32x4 v[NJV];
        const float* xin = (l == 0) ? INP(a, I_X) : outp(a);
#pragma unroll
        for (int j = 0; j < NJV; ++j) v[j] = *(const f32x4*)(xin + (size_t)row * DM + 4 * lane + 256 * j);
        if (l > 0) {
            const int* tie = (const int*)(ws + WS_TIE) + (size_t)row * 2; const float* tiw = (const float*)(ws + WS_TIW) + (size_t)row * 2;
            const int e0 = tie[0] >> 14, p0 = tie[0] & 16383, e1 = tie[1] >> 14, p1 = tie[1] & 16383;
            const float w0 = tiw[0], w1 = tiw[1];
            const bf16* y0 = yk + (size_t)(rb[e0] + p0) * DM; const bf16* y1 = yk + (size_t)(rb[e1] + p1) * DM;
            const float* gf = mod + ((size_t)(l - 1) * 2 + b) * 6 * DM + 5 * DM;
#pragma unroll
            for (int j = 0; j < NJV; ++j) { const int cidx = 4 * lane + 256 * j; u32x2 q0 = *(const u32x2*)(y0 + cidx), q1 = *(const u32x2*)(y1 + cidx);
                f32x4 g = *(const f32x4*)(gf + cidx);
                v[j][0] += g[0] * (w0 * bf2f(q0[0] & 0xffff) + w1 * bf2f(q1[0] & 0xffff));
                v[j][1] += g[1] * (w0 * bf2f(q0[0] >> 16) + w1 * bf2f(q1[0] >> 16));
                v[j][2] += g[2] * (w0 * bf2f(q0[1] & 0xffff) + w1 * bf2f(q1[1] & 0xffff));
                v[j][3] += g[3] * (w0 * bf2f(q0[1] >> 16) + w1 * bf2f(q1[1] >> 16)); }
        }
#pragma unroll
        for (int j = 0; j < NJV; ++j) *(f32x4*)(outp(a) + (size_t)row * DM + 4 * lane + 256 * j) = v[j];
        if (l == DEPTH) continue;
        float ss = 0.f;
#pragma unroll
        for (int j = 0; j < NJV; ++j) ss += v[j][0] * v[j][0] + v[j][1] * v[j][1] + v[j][2] * v[j][2] + v[j][3] * v[j][3];
#pragma unroll
        for (int o = 1; o < 64; o <<= 1) ss += shflx(ss, o);
        const float rs = frsq(ss * (1.0f / DM) + EPS);
        const float* mm = mod + ((size_t)l * 2 + b) * 6 * DM; const float* nm = INP(a, I_NMIX) + (size_t)l * DM;
        bf16* hb = (bf16*)(ws + WS_H) + (size_t)row * DM;
#pragma unroll
        for (int j = 0; j < NJV; ++j) { const int cidx = 4 * lane + 256 * j; f32x4 g = *(const f32x4*)(nm + cidx), sh = *(const f32x4*)(mm + cidx), sc = *(const f32x4*)(mm + DM + cidx), o;
#pragma unroll
            for (int r = 0; r < 4; ++r) o[r] = v[j][r] * rs * g[r] * (1.0f + sc[r]) + sh[r];
            st_bf4(hb + cidx, o); }
    }
}

DEV void route_phase(const Args& a, unsigned char* smem, int l) {
    unsigned char* ws = wsp(a); const int tid = TID;
    float* W = (float*)smem;
    SYNC();
    for (int i = tid; i < DM * 36; i += NT) { const int k = i / 36, n = i % 36;
        W[i] = (n < 4) ? INP(a, I_WG)[((size_t)l * DM + k) * 4 + n] : INP(a, I_WE)[((size_t)l * DM + k) * 32 + n - 4]; }
    SYNC();
    const float* mod = (const float*)(ws + WS_MOD); const float* nf = INP(a, I_NFFN) + (size_t)l * DM;
    int* cnt = (int*)(ws + WS_CNT) + l * 32;
    constexpr int NI = DM / 32;
    for (int pass = BID; pass < T / 16; pass += NBLK) {
        const int tok = pass * 16 + (tid >> 5), part = tid & 31, b = tok / SEQ;
        const float* xr = outp(a) + (size_t)tok * DM; float xv[NI]; float ss = 0.f;
#pragma unroll
        for (int i = 0; i < NI; ++i) { xv[i] = xr[part + 32 * i]; ss += xv[i] * xv[i]; }
#pragma unroll
        for (int o = 1; o < 32; o <<= 1) ss += shflx(ss, o);
        const float rs = frsq(ss * (1.0f / DM) + EPS);
        const float* mm = mod + ((size_t)l * 2 + b) * 6 * DM; bf16* hb = (bf16*)(ws + WS_H) + (size_t)tok * DM;
        float acc[36];
#pragma unroll
        for (int n = 0; n < 36; ++n) acc[n] = 0.f;
#pragma unroll 4
        for (int i = 0; i < NI; ++i) { const int k = part + 32 * i; const float hn = xv[i] * rs * nf[k] * (1.0f + mm[4 * DM + k]) + mm[3 * DM + k];
            hb[k] = (bf16)f2bf(hn); const float* wr = W + k * 36;
#pragma unroll
            for (int n = 0; n < 36; ++n) acc[n] += hn * wr[n]; }
#pragma unroll
        for (int n = 0; n < 36; ++n) {
#pragma unroll
            for (int o = 1; o < 32; o <<= 1) acc[n] += shflx(acc[n], o); }
        if (part == 0) {
            int gs = 0; float gm = acc[0];
#pragma unroll
            for (int g = 1; g < 4; ++g) if (acc[g] > gm) { gm = acc[g]; gs = g; }
            float den = 0.f;
#pragma unroll
            for (int g = 0; g < 4; ++g) den += fexp2((acc[g] - gm) * LOG2E);
            const float ggate = 1.0f / den;
            float el[8];
#pragma unroll
            for (int j = 0; j < 8; ++j) { el[j] = acc[4 + j];
#pragma unroll
                for (int g = 1; g < 4; ++g) if (gs == g) el[j] = acc[4 + 8 * g + j]; }
            int ia = 0; float va = el[0];
#pragma unroll
            for (int j = 1; j < 8; ++j) if (el[j] > va) { va = el[j]; ia = j; }
            int ib = -1; float vb = -3e38f;
#pragma unroll
            for (int j = 0; j < 8; ++j) if (j != ia && el[j] > vb) { vb = el[j]; ib = j; }
            const float wa = 1.0f / (1.0f + fexp2((vb - va) * LOG2E)), wb = 1.0f - wa;
            const int e0 = gs * 8 + ia, e1 = gs * 8 + ib;
            const int p0 = atomic_add_i(cnt + e0, 1), p1 = atomic_add_i(cnt + e1, 1);
            int* list = (int*)(ws + WS_LIST); list[(size_t)e0 * T + p0] = tok; list[(size_t)e1 * T + p1] = tok;
            int* tie = (int*)(ws + WS_TIE) + (size_t)tok * 2; float* tiw = (float*)(ws + WS_TIW) + (size_t)tok * 2;
            tie[0] = (e0 << 14) | p0; tie[1] = (e1 << 14) | p1; tiw[0] = ggate * wa; tiw[1] = ggate * wb;
        }
    }
}

DEV void inproj_phase(const Args& a, unsigned char* smem, int li) {
    constexpr int TN = NINP / 128, TM = T / 256;
    const bf16* A = (const bf16*)(wsp(a) + WS_H); const float* Bw = INP(a, I_WIN) + (size_t)li * DM * NIN;
    for (int it = BID; it < TN * TM; it += NBLK) { const int tm = it / TN, tn = it % TN;
        EpiInProj E{&a, tm * 256, tn * 128, li}; ARows af{A + (size_t)tm * 256 * DM, (size_t)DM}; BInProjMap bf{Bw, tn * 128};
        gemm_tile2(smem, af, bf, NIN, DM, E); }
}
DEV void resid_gemm_phase(const Args& a, unsigned char* smem, const bf16* A, int K, const float* Bw, int l) {
    constexpr int TN = DM / 128, TM = T / 256;
    const float* gate = (const float*)(wsp(a) + WS_MOD) + (size_t)l * 2 * 6 * DM + 2 * DM;
    for (int it = BID; it < TN * TM; it += NBLK) { const int tm = it / TN, tn = it % TN;
        EpiResid E{outp(a), gate, tm * 256, tn * 128}; ARows af{A + (size_t)tm * 256 * K, (size_t)K}; BPlain bf{Bw + tn * 128};
        gemm_tile2(smem, af, bf, DM, K, E); }
}
DEV void pw1_phase(const Args& a, unsigned char* smem, int li) {
    constexpr int TN = 2 * DM / 128, TM = T / 256;
    const bf16* A = (const bf16*)(wsp(a) + WS_H); const float* Bw = INP(a, I_PW1) + (size_t)li * DM * 2 * DM;
    for (int it = BID; it < TN * TM; it += NBLK) { const int tm = it / TN, tn = it % TN;
        EpiGated<0> E{(bf16*)(wsp(a) + WS_GLU), (size_t)DM, tm * 256, tn * 128, 256}; ARows af{A + (size_t)tm * 256 * DM, (size_t)DM}; BInter bf{Bw, Bw + DM, tn * 128};
        gemm_tile2(smem, af, bf, 2 * DM, DM, E); }
}
DEV void cmp_phase_items(const Args& a, unsigned char* smem, int li, int it) {
    constexpr int TMC = (NCP + 255) / 256;
    const int kv = it / (4 * TMC), bg = (it / TMC) % 4, tm = it % TMC;
    const bf16* src = (const bf16*)(wsp(a) + (kv ? WS_VCG : WS_KCG)) + (size_t)bg * SEQ * 64;
    struct AF { const bf16* s; int m0; MDEV const bf16* operator()(int r) const { int n = m0 + r; if (n > NCMP - 1) n = NCMP - 1; return s + (size_t)n * 1024; } } af{src, tm * 256};
    EpiCmp E{&a, kv, bg, tm * 256, li};
    BClamp64 bf{INP(a, kv ? I_CWV : I_CWK) + (size_t)li * 2048 * 64};
    gemm_tile2(smem, af, bf, 64, 2048, E);
}
DEV void moe_gemm_phase(const Args& a, unsigned char* smem, int l, int mode) {
    unsigned char* ws = wsp(a); const int* cnt = (const int*)(ws + WS_CNT) + l * 32;
    int* rb = (int*)(smem + GEMM2_LDS);
    moe_bases(cnt, rb);
    const int ntile = rb[32] >> 8;
    constexpr int TN1 = 2 * FF / 128, TN2 = DM / 128;
    const int TN = mode == 0 ? TN1 : TN2;
    const int* list = (const int*)(ws + WS_LIST);
    for (int it = BID; it < ntile * TN; it += NBLK) {
        const int rt = it / TN, tn = it % TN; int e = 0;
#pragma unroll 1
        for (int q = 1; q < 32; ++q) if ((rb[q] >> 8) <= rt) e = q;
        const int rloc = (rt << 8) - rb[e], nvalid = (cnt[e] - rloc) < 256 ? (cnt[e] - rloc) : 256;
        if (mode == 0) {
            struct AF { const bf16* hb; const int* lst; int nv; MDEV const bf16* operator()(int r) const { const int rr = r < nv ? r : nv - 1; return hb + (size_t)lst[rr] * DM; } }
                af{(const bf16*)(ws + WS_H), list + (size_t)e * T + rloc, nvalid};
            EpiGated<1> E{(bf16*)(ws + WS_ACT), (size_t)FF, rt << 8, tn * 128, nvalid};
            BInter bf{INP(a, I_W1) + (size_t)(l * 32 + e) * DM * FF, INP(a, I_W3) + (size_t)(l * 32 + e) * DM * FF, tn * 128};
            gemm_tile2(smem, af, bf, FF, DM, E);
        } else {
            ARows af{(const bf16*)(ws + WS_ACT) + (size_t)(rt << 8) * FF, (size_t)FF};
            EpiStoreBf E{(bf16*)(ws + WS_YK), (size_t)DM, rt << 8, tn * 128, nvalid};
            BPlain bf{INP(a, I_W2) + (size_t)(l * 32 + e) * FF * DM + tn * 128};
            gemm_tile2(smem, af, bf, DM, FF, E);
        }
    }
}

constexpr int AT_K = 0, AT_V = 2 * 64 * LDT * 2, AT_IMP = 2 * AT_V, AT_SEL = AT_IMP + 8 * 4 * 128 * 4, AT_END = AT_SEL + 8 * 4 * 4 * 4;

template <int MASK, bool WITH_PV>
DEV void attn_block(const bf16* Kp, const bf16* Vp, const bf16x8 (&qf)[2], int j, int s, bool selbit, float C2, int h, int c,
                    f32x4 (&O)[4], float& lsum, f32x4 (&pout)[2][2]) {
    f32x4 st[2][2];
#pragma unroll
    for (int sp = 0; sp < 2; ++sp)
#pragma unroll
        for (int u = 0; u < 2; ++u) { st[sp][u] = f4zero(); const int krow = 32 * sp + 8 * (c >> 2) + 4 * u + (c & 3);
#pragma unroll
            for (int ks = 0; ks < 2; ++ks) st[sp][u] = mfma16(*(const bf16x8*)(Kp + krow * LDT + 32 * ks + 8 * h), qf[ks], st[sp][u]); }
#pragma unroll
    for (int sp = 0; sp < 2; ++sp)
#pragma unroll
        for (int u = 0; u < 2; ++u)
#pragma unroll
            for (int r = 0; r < 4; ++r) { const int key = 64 * j + 32 * sp + 8 * h + 4 * u + r; bool ok;
                if (MASK == 0) ok = 16 * key + 31 <= s; else if (MASK == 1) ok = selbit && key <= s; else ok = key <= s && key > s - 512;
                const float p = ok ? fexp2(st[sp][u][r] * LOG2E - C2) : 0.f; lsum += p; pout[sp][u][r] = p; }
    if (WITH_PV) {
        bf16x8 pb[2];
#pragma unroll
        for (int sp = 0; sp < 2; ++sp) pb[sp] = pack8(pout[sp][0], pout[sp][1]);
#pragma unroll
        for (int et = 0; et < 4; ++et)
#pragma unroll
            for (int sp = 0; sp < 2; ++sp) O[et] = mfma16(*(const bf16x8*)(Vp + (16 * et + c) * LDT + 32 * sp + 8 * h), pb[sp], O[et]);
    }
}

DEV void attn_task(const Args& a, unsigned char* smem, int li, int item) {
    unsigned char* ws = wsp(a); const int tid = TID, w = tid >> 6, l = tid & 63, h = l >> 4, c = l & 15, tl = c >> 2, hd = c & 3;
    const int bg = item & 3, b = bg >> 1, g = bg & 1, tq = (SEQ / 32 - 1) - (item >> 2), s0 = tq * 32, qblk = s0 >> 6;
    const int s = s0 + 4 * w + tl, row = b * SEQ + s;
    bf16* Kl = (bf16*)(smem + AT_K); bf16* Vl = (bf16*)(smem + AT_V); float* imps = (float*)(smem + AT_IMP) + w * 512; unsigned* selm = (unsigned*)(smem + AT_SEL) + w * 16;
    bf16x8 qf[2];
    { const bf16* qp = (const bf16*)(ws + WS_QN) + (size_t)row * 512 + (g * 4 + hd) * 64 + 8 * h; qf[0] = *(const bf16x8*)qp; qf[1] = *(const bf16x8*)(qp + 32); }
    const float* gp = (const float*)(ws + WS_GATE) + (size_t)row * 24 + (g * 4 + hd) * 3;
    const float gatec = gp[0], gates = gp[1], gatew = gp[2];
    const float* cs = (const float*)(ws + WS_CS) + li * 4;
    f32x4 outv[4];
#pragma unroll
    for (int et = 0; et < 4; ++et) outv[et] = f4zero();
    const int srow = tid >> 3, scol = (tid & 7) * 8;
    for (int i = l; i < 512; i += 64) imps[i] = 0.f;
    SYNC();

    const int ncv = s0 / 16 + 1, ncb = (ncv + 63) >> 6;
    const bf16* kcb = (const bf16*)(ws + WS_KC) + (size_t)bg * NCP * 64;
    const bf16* vcb = (const bf16*)(ws + WS_VCT) + (size_t)bg * 64 * NCP;
    float invl_c = 0.f;
    {
        f32x4 O[4]; float lsum = 0.f; f32x4 pt[2][2];
#pragma unroll
        for (int et = 0; et < 4; ++et) O[et] = f4zero();
        const float C2 = cs[0];
        bf16x8 rk = *(const bf16x8*)(kcb + (size_t)(0 * 64 + srow) * 64 + scol), rv = *(const bf16x8*)(vcb + (size_t)srow * NCP + 0 * 64 + scol);
        *(bf16x8*)(Kl + srow * LDT + scol) = rk; *(bf16x8*)(Vl + srow * LDT + scol) = rv;
        SYNC();
        for (int j = 0; j < ncb; ++j) { const int cur = j & 1;
            if (j + 1 < ncb) { rk = *(const bf16x8*)(kcb + (size_t)((j + 1) * 64 + srow) * 64 + scol); rv = *(const bf16x8*)(vcb + (size_t)srow * NCP + (j + 1) * 64 + scol); }
            attn_block<0, true>(Kl + cur * 64 * LDT, Vl + cur * 64 * LDT, qf, j, s, true, C2, h, c, O, lsum, pt);
            if (j + 1 < ncb) { *(bf16x8*)(Kl + (cur ^ 1) * 64 * LDT + srow * LDT + scol) = rk; *(bf16x8*)(Vl + (cur ^ 1) * 64 * LDT + srow * LDT + scol) = rv; }
            SYNC(); }
        lsum += shflx(lsum, 16); lsum += shflx(lsum, 32);
        invl_c = lsum > 0.f ? 1.0f / lsum : 0.f;
#pragma unroll
        for (int et = 0; et < 4; ++et)
#pragma unroll
            for (int r = 0; r < 4; ++r) outv[et][r] += gatec * invl_c * O[et][r];
        float carry = 0.f; f32x4 Od[4]; float ld = 0.f;
        rk = *(const bf16x8*)(kcb + (size_t)(0 * 64 + srow) * 64 + scol);
        *(bf16x8*)(Kl + srow * LDT + scol) = rk;
        SYNC();
        for (int j = 0; j < ncb; ++j) { const int cur = j & 1;
            if (j + 1 < ncb) rk = *(const bf16x8*)(kcb + (size_t)((j + 1) * 64 + srow) * 64 + scol);
            attn_block<0, false>(Kl + cur * 64 * LDT, Vl, qf, j, s, true, C2, h, c, Od, ld, pt);
#pragma unroll
            for (int sp = 0; sp < 2; ++sp)
#pragma unroll
                for (int u = 0; u < 2; ++u)
#pragma unroll
                    for (int r = 0; r < 4; ++r) { float p = pt[sp][u][r] * invl_c; p += shflx(p, 1); p += shflx(p, 2); pt[sp][u][r] = p; }
            const float r0 = shfl(pt[0][1][3], (l - 16) & 63), r1 = shfl(pt[1][1][3], (l - 16) & 63);
#pragma unroll
            for (int sp = 0; sp < 2; ++sp)
#pragma unroll
                for (int u = 0; u < 2; ++u) { const int m = 16 * j + 8 * sp + 2 * h + u;
                    float prev; if (u == 1) prev = pt[sp][0][3]; else if (h > 0) prev = sp == 0 ? r0 : r1; else prev = sp == 0 ? carry : r0;
                    const float val = 2.0f * (pt[sp][u][0] + pt[sp][u][1] + pt[sp][u][2]) + pt[sp][u][3] + prev;
                    if (hd == 0 && m < 128) imps[tl * 128 + m] = val; }
            carry = r1;
            if (j + 1 < ncb) *(bf16x8*)(Kl + (cur ^ 1) * 64 * LDT + srow * LDT + scol) = rk;
            SYNC(); }
    }
    unsigned mysel[4], wsel[4];
    {
        WSYNC();
        const int tk = l >> 4, i = l & 15; float vals[8];
#pragma unroll
        for (int mm = 0; mm < 8; ++mm) { const int jj = i + 16 * mm; vals[mm] = jj > qblk ? NEGV : ((jj == 0 || jj == qblk || jj == qblk - 1) ? FORCEV : imps[tk * 128 + jj]); }
        unsigned mk[4] = {0u, 0u, 0u, 0u};
#pragma unroll 1
        for (int rnd = 0; rnd < 16; ++rnd) {
            float best = vals[0]; int bj = i;
#pragma unroll
            for (int mm = 1; mm < 8; ++mm) if (vals[mm] > best) { best = vals[mm]; bj = i + 16 * mm; }
#pragma unroll
            for (int o = 1; o < 16; o <<= 1) { const float ov = shflx(best, o); const int oj = shflxi(bj, o); if (ov > best || (ov == best && oj < bj)) { best = ov; bj = oj; } }
            if (best > NEGV * 0.5f) {
#pragma unroll
                for (int q = 0; q < 4; ++q) if ((bj >> 5) == q) mk[q] |= 1u << (bj & 31); }
            if ((bj & 15) == i) {
#pragma unroll
                for (int mm = 0; mm < 8; ++mm) if ((bj >> 4) == mm) vals[mm] = -3e38f; }
        }
        if (i == 0) {
#pragma unroll
            for (int q = 0; q < 4; ++q) selm[tk * 4 + q] = mk[q]; }
        WSYNC();
#pragma unroll
        for (int q = 0; q < 4; ++q) { mysel[q] = selm[tl * 4 + q]; wsel[q] = selm[q] | selm[4 + q] | selm[8 + q] | selm[12 + q]; }
    }
#pragma unroll 1
    for (int br = 1; br <= 2; ++br) {
        const bf16* kb = (const bf16*)(ws + (br == 1 ? WS_KS : WS_KW)) + (size_t)bg * SEQ * 64;
        const bf16* vb = (const bf16*)(ws + (br == 1 ? WS_VST : WS_VWT)) + (size_t)bg * NCH * 4096;
        const int jlo = br == 1 ? 0 : (s0 >= 511 ? (s0 - 511) >> 6 : 0), jhi = qblk;
        const float C2 = cs[br];
        f32x4 O[4]; float lsum = 0.f; f32x4 pt[2][2];
#pragma unroll
        for (int et = 0; et < 4; ++et) O[et] = f4zero();
        bf16x8 rk = *(const bf16x8*)(kb + (size_t)jlo * 4096 + tid * 8), rv = *(const bf16x8*)(vb + (size_t)jlo * 4096 + tid * 8);
        *(bf16x8*)(Kl + srow * LDT + scol) = rk; *(bf16x8*)(Vl + srow * LDT + scol) = rv;
        SYNC();
        for (int j = jlo; j <= jhi; ++j) { const int cur = (j - jlo) & 1;
            if (j + 1 <= jhi) { rk = *(const bf16x8*)(kb + (size_t)(j + 1) * 4096 + tid * 8); rv = *(const bf16x8*)(vb + (size_t)(j + 1) * 4096 + tid * 8); }
            bool need = true, sb = true;
            if (br == 1) { unsigned wq = 0, mq = 0;
#pragma unroll
                for (int q = 0; q < 4; ++q) if ((j >> 5) == q) { wq = wsel[q]; mq = mysel[q]; }
                need = (wq >> (j & 31)) & 1u; sb = (mq >> (j & 31)) & 1u; }
            if (need) { if (br == 1) attn_block<1, true>(Kl + cur * 64 * LDT, Vl + cur * 64 * LDT, qf, j, s, sb, C2, h, c, O, lsum, pt);
                        else attn_block<2, true>(Kl + cur * 64 * LDT, Vl + cur * 64 * LDT, qf, j, s, sb, C2, h, c, O, lsum, pt); }
            if (j + 1 <= jhi) { *(bf16x8*)(Kl + (cur ^ 1) * 64 * LDT + srow * LDT + scol) = rk; *(bf16x8*)(Vl + (cur ^ 1) * 64 * LDT + srow * LDT + scol) = rv; }
            SYNC(); }
        lsum += shflx(lsum, 16); lsum += shflx(lsum, 32);
        const float sc = (br == 1 ? gates : gatew) * (lsum > 0.f ? 1.0f / lsum : 0.f);
#pragma unroll
        for (int et = 0; et < 4; ++et)
#pragma unroll
            for (int r = 0; r < 4; ++r) outv[et][r] += sc * O[et][r];
    }
    bf16* dst = (bf16*)(ws + WS_CAT) + (size_t)row * 1024 + (g * 4 + hd) * 64 + 4 * h;
#pragma unroll
    for (int et = 0; et < 4; ++et) st_bf4(dst + 16 * et, outv[et]);
}

constexpr int LDH = 136;
DEV void hg_cumsum(const float* fsrc  , float* segs  , int d, int seg, float (&f)[16], float (&bc)[16], float& bend, float& bmid) {
    float run = 0.f;
#pragma unroll
    for (int i = 0; i < 16; ++i) { f[i] = fsrc[(size_t)(16 * seg + i) * 128 + d]; run += log2f(f[i]); bc[i] = run; }
    SYNC();
    segs[seg * 128 + d] = run;
    SYNC();
    const float s0 = segs[d], s1 = segs[128 + d], s2 = segs[256 + d], s3 = segs[384 + d];
    const float off = seg == 0 ? 0.f : (seg == 1 ? s0 : (seg == 2 ? s0 + s1 : s0 + s1 + s2));
#pragma unroll
    for (int i = 0; i < 16; ++i) bc[i] += off;
    bend = s0 + s1 + s2 + s3; bmid = s0 + s1;
}
DEV void hg_write16(bf16* dstrow  , const float (&v)[16]) {
    u32x4 w0, w1;
#pragma unroll
    for (int q = 0; q < 4; ++q) { w0[q] = pk2(v[2 * q], v[2 * q + 1]); w1[q] = pk2(v[8 + 2 * q], v[8 + 2 * q + 1]); }
    *(u32x4*)dstrow = w0; *(u32x4*)(dstrow + 8) = w1;
}
DEV void hg_h1_task(const Args& a, unsigned char* smem, int task) {
    unsigned char* ws = wsp(a); const int tid = TID, w = tid >> 6, l = tid & 63, h = l >> 4, c = l & 15, d = tid & 127, seg = tid >> 7;
    const int bh = task / NCH, ch = task % NCH;
    bf16* kT = (bf16*)smem; bf16* vT = kT + 128 * LDT; float* segs = (float*)(vT + 128 * LDT);
    const size_t tokb = (size_t)bh * SEQ + ch * 64;
    float f[16], bc[16], bend, bmid;
    hg_cumsum((const float*)(ws + WS_HF) + tokb * 128, segs, d, seg, f, bc, bend, bmid);
    float kv[16];
#pragma unroll
    for (int i = 0; i < 16; ++i) kv[i] = (1.0f - f[i]) * fexp2(bend - bc[i]);
    hg_write16(kT + d * LDT + 16 * seg, kv);
    const bf16* vs = (const bf16*)(ws + WS_HV) + tokb * 128;
#pragma unroll
    for (int i = 0; i < 16; ++i) kv[i] = bf2f(vs[(size_t)(16 * seg + i) * 128 + d]);
    hg_write16(vT + d * LDT + 16 * seg, kv);
    if (seg == 0) ((float*)(ws + WS_GD))[((size_t)bh * NCH + ch) * 128 + d] = fexp2(bend);
    SYNC();
    f32x4 acc[8];
#pragma unroll
    for (int et = 0; et < 8; ++et) acc[et] = f4zero();
#pragma unroll
    for (int ks = 0; ks < 2; ++ks) { const bf16x8 fa = *(const bf16x8*)(kT + (16 * w + c) * LDT + 32 * ks + 8 * h);
#pragma unroll
        for (int et = 0; et < 8; ++et) acc[et] = mfma16(fa, *(const bf16x8*)(vT + (16 * et + c) * LDT + 32 * ks + 8 * h), acc[et]); }
    float* ut = (float*)(ws + WS_UT) + ((size_t)bh * NCH + ch) * 16384;
#pragma unroll
    for (int et = 0; et < 8; ++et) *(f32x4*)(ut + (size_t)(16 * et + c) * 128 + 16 * w + 4 * h) = acc[et];
    SYNC();
}
DEV void hg_scan_task(const Args& a, int sc) {
    unsigned char* ws = wsp(a); const int bh = sc >> 3, q = (sc & 7) * 512 + TID, e = q >> 5, d0 = (q & 31) * 4;
    const float* ut = (const float*)(ws + WS_UT) + (size_t)bh * NCH * 16384 + (size_t)e * 128 + d0;
    const float* gd = (const float*)(ws + WS_GD) + (size_t)bh * NCH * 128 + d0;
    bf16* st = (bf16*)(ws + WS_ST) + (size_t)bh * NCH * 16384 + (size_t)e * 128 + d0;
    f32x4 S = f4zero();
#pragma unroll 4
    for (int ch = 0; ch < NCH; ++ch) { st_bf4(st + (size_t)ch * 16384, S);
        const f32x4 g = *(const f32x4*)(gd + (size_t)ch * 128), u = *(const f32x4*)(ut + (size_t)ch * 16384);
#pragma unroll
        for (int r = 0; r < 4; ++r) S[r] = g[r] * S[r] + u[r]; }
}
DEV void hg_h3_task(const Args& a, unsigned char* smem, int li, int task) {
    unsigned char* ws = wsp(a); const int tid = TID, w = tid >> 6, l = tid & 63, h = l >> 4, c = l & 15, d = tid & 127, seg = tid >> 7;
    const int bh = task / NCH, ch = task % NCH, b = bh >> 2, hh = bh & 3;
    bf16* At = (bf16*)smem; bf16* Bt = At + 64 * LDH; bf16* Qt = Bt + 64 * LDH; bf16* vT = Qt + 64 * LDH; float* segs = (float*)(vT + 128 * LDT); float* part = segs + 512;
    const size_t tokb = (size_t)bh * SEQ + ch * 64;
    float f[16], bc[16], bend, bmid;
    hg_cumsum((const float*)(ws + WS_HF) + tokb * 128, segs, d, seg, f, bc, bend, bmid);
    const bf16* qs = (const bf16*)(ws + WS_HQ) + tokb * 128; const bf16* vs = (const bf16*)(ws + WS_HV) + tokb * 128;
    float vv[16];
#pragma unroll
    for (int i = 0; i < 16; ++i) { const int t = 16 * seg + i; const float q = bf2f(qs[(size_t)t * 128 + d]);
        At[t * LDH + d] = (bf16)f2bf(q * fexp2(bc[i] - bmid)); Bt[t * LDH + d] = (bf16)f2bf((1.0f - f[i]) * fexp2(bmid - bc[i])); Qt[t * LDH + d] = (bf16)f2bf(q * fexp2(bc[i]));
        vv[i] = bf2f(vs[(size_t)t * 128 + d]); }
    hg_write16(vT + d * LDT + 16 * seg, vv);
    SYNC();
    const int tt = w & 3, eh = w >> 2;
    f32x4 O[4];
#pragma unroll
    for (int et = 0; et < 4; ++et) O[et] = f4zero();
#pragma unroll
    for (int sp = 0; sp < 2; ++sp) {
        if (32 * sp > 16 * tt + 15) continue;
        f32x4 st[2];
#pragma unroll
        for (int u = 0; u < 2; ++u) { st[u] = f4zero(); const int krow = 32 * sp + 8 * (c >> 2) + 4 * u + (c & 3);
#pragma unroll
            for (int ks = 0; ks < 4; ++ks) st[u] = mfma16(*(const bf16x8*)(Bt + krow * LDH + 32 * ks + 8 * h), *(const bf16x8*)(At + (16 * tt + c) * LDH + 32 * ks + 8 * h), st[u]);
#pragma unroll
            for (int r = 0; r < 4; ++r) { const int sk = 32 * sp + 8 * h + 4 * u + r; if (sk > 16 * tt + c) st[u][r] = 0.f; } }
        const bf16x8 pb = pack8(st[0], st[1]);
#pragma unroll
        for (int et = 0; et < 4; ++et) O[et] = mfma16(*(const bf16x8*)(vT + (64 * eh + 16 * et + c) * LDT + 32 * sp + 8 * h), pb, O[et]);
    }
    const bf16* stp = (const bf16*)(ws + WS_ST) + ((size_t)bh * NCH + ch) * 16384;
#pragma unroll
    for (int ks = 0; ks < 4; ++ks) { const bf16x8 fq = *(const bf16x8*)(Qt + (16 * tt + c) * LDH + 32 * ks + 8 * h);
#pragma unroll
        for (int et = 0; et < 4; ++et) O[et] = mfma16(*(const bf16x8*)(stp + (size_t)(64 * eh + 16 * et + c) * 128 + 32 * ks + 8 * h), fq, O[et]); }
    float ss = 0.f;
#pragma unroll
    for (int et = 0; et < 4; ++et)
#pragma unroll
        for (int r = 0; r < 4; ++r) ss += O[et][r] * O[et][r];
    ss += shflx(ss, 16); ss += shflx(ss, 32);
    if (h == 0) part[eh * 64 + 16 * tt + c] = ss;
    SYNC();
    const float rs = frsq((part[16 * tt + c] + part[64 + 16 * tt + c]) * (1.0f / 128.0f) + EPS);
    const int tok = b * SEQ + ch * 64 + 16 * tt + c;
    const float* og = INP(a, I_OG) + li * 128; const bf16* hg = (const bf16*)(ws + WS_HGS) + (size_t)tok * 512 + hh * 128;
    bf16* dst = (bf16*)(ws + WS_CAT) + (size_t)tok * 1024 + 512 + hh * 128;
#pragma unroll
    for (int et = 0; et < 4; ++et) { const int e = 64 * eh + 16 * et + 4 * h; f32x4 o;
#pragma unroll
        for (int r = 0; r < 4; ++r) o[r] = O[et][r] * rs * og[e + r] * bf2f(hg[e + r]);
        st_bf4(dst + e, o); }
    SYNC();
}

DEV void conv_task(const Args& a, unsigned char* smem, int li, int task) {
    unsigned char* ws = wsp(a); const int tid = TID, w = tid >> 6, lane = tid & 63;
    const bool act = tid < DM / 2; const int c0 = act ? 2 * tid : 0;
    const int t0 = task * 16, b = t0 / SEQ, s0 = t0 % SEQ;
    float* red = (float*)smem;
    const float* dw = INP(a, I_DW) + (size_t)li * 31 * DM + c0;
    float acc[16][2];
    const float b0 = INP(a, I_DWB)[li * DM + c0], b1 = INP(a, I_DWB)[li * DM + c0 + 1];
#pragma unroll
    for (int t = 0; t < 16; ++t) { acc[t][0] = b0; acc[t][1] = b1; }
    const bf16* glu = (const bf16*)(ws + WS_GLU) + (size_t)b * SEQ * DM + c0;
    unsigned uu[46];
    { const bf16* gp = glu + (size_t)(s0 - 30) * DM;
#pragma unroll
    for (int r = 0; r < 46; ++r) { const int si = s0 + r - 30; uu[r] = si >= 0 ? *(const unsigned*)gp : 0u; gp += DM; OPAQUE(gp); } }
    const float* dwp = dw;
#pragma unroll
    for (int j = 0; j < 31; ++j) { const float w0 = dwp[0], w1 = dwp[1]; dwp += DM; OPAQUE(dwp);
#pragma unroll
        for (int t = 0; t < 16; ++t) { const unsigned q = uu[t + j]; acc[t][0] += w0 * bf2f(q & 0xffff); acc[t][1] += w1 * bf2f(q >> 16); } }
    float mean[16], rstd[16];
    SYNC();
#pragma unroll
    for (int t = 0; t < 16; ++t) { float s = act ? acc[t][0] + acc[t][1] : 0.f;
#pragma unroll
        for (int o = 1; o < 64; o <<= 1) s += shflx(s, o);
        if (lane == 0) red[w * 16 + t] = s; }
    SYNC();
#pragma unroll
    for (int t = 0; t < 16; ++t) { float s = 0.f;
#pragma unroll
        for (int q = 0; q < 8; ++q) s += red[q * 16 + t];
        mean[t] = s * (1.0f / DM); }
    SYNC();
#pragma unroll
    for (int t = 0; t < 16; ++t) { const float d0 = acc[t][0] - mean[t], d1 = acc[t][1] - mean[t]; float s = act ? d0 * d0 + d1 * d1 : 0.f;
#pragma unroll
        for (int o = 1; o < 64; o <<= 1) s += shflx(s, o);
        if (lane == 0) red[w * 16 + t] = s; }
    SYNC();
#pragma unroll
    for (int t = 0; t < 16; ++t) { float s = 0.f;
#pragma unroll
        for (int q = 0; q < 8; ++q) s += red[q * 16 + t];
        rstd[t] = frsq(s * (1.0f / DM) + EPS); }
    if (act) {
        const float g0 = INP(a, I_LNG)[li * DM + c0], g1 = INP(a, I_LNG)[li * DM + c0 + 1], e0 = INP(a, I_LNB)[li * DM + c0], e1 = INP(a, I_LNB)[li * DM + c0 + 1];
        bf16* dst = (bf16*)(ws + WS_CAT) + (size_t)t0 * DM + c0;
#pragma unroll
        for (int t = 0; t < 16; ++t) { const float y0 = (acc[t][0] - mean[t]) * rstd[t] * g0 + e0, y1 = (acc[t][1] - mean[t]) * rstd[t] * g1 + e1;
            *(unsigned*)(dst + (size_t)t * DM) = pk2(siluf(y0), siluf(y1)); }
    }
}

constexpr int PH_PER_LAYER = 9, N_PHASES = 1 + PH_PER_LAYER * DEPTH + 1;
constexpr int LDS_BYTES = 150 * 1024;

DEV void run_phase(const Args& a, unsigned char* smem, int ph) {
#ifndef ONLY
#define ONLY -1
#endif
#define EN(k) (ONLY < 0 || ONLY == (k))
    if (ph == 0) { if (EN(100)) p0_phase(a, smem); return; }
    if (ph == N_PHASES - 1) { if (EN(0)) norm_phase(a, smem, DEPTH); return; }
    const int l = (ph - 1) / PH_PER_LAYER, sub = (ph - 1) % PH_PER_LAYER, li = l >> 1; const bool even = (l & 1) == 0;
    unsigned char* ws = wsp(a);
    switch (sub) {
    case 0: if (EN(0)) norm_phase(a, smem, l); break;
    case 1: if (even) { if (EN(1)) inproj_phase(a, smem, li); } else { if (EN(11)) pw1_phase(a, smem, li); } break;
    case 2:
        if (even) { constexpr int NCI = 8 * ((NCP + 255) / 256); constexpr int NH1 = 8 * NCH;
            for (int it = BID; it < NCI + NH1; it += NBLK) { if (it < NCI) { if (EN(2)) cmp_phase_items(a, smem, li, it); } else { if (EN(12)) hg_h1_task(a, smem, it - NCI); } } }
        else { for (int it = BID; it < T / 16; it += NBLK) if (EN(13)) conv_task(a, smem, li, it); }
        break;
    case 3:
        if (even) { constexpr int NA = 4 * (SEQ / 32); const int G = NBLK;
            for (int r = 0; r * G < NA; ++r) { const int it = r * G + ((r & 1) ? (G - 1 - BID) : BID); if (it < NA) { if (EN(3)) attn_task(a, smem, li, it); } }
            for (int it = BID; it < 64; it += NBLK) if (EN(14)) hg_scan_task(a, it); }
        break;
    case 4: if (even) { for (int it = BID; it < 8 * NCH; it += NBLK) if (EN(4)) hg_h3_task(a, smem, li, it); } break;
    case 5:
        if (!EN(5)) break;
        if (even) resid_gemm_phase(a, smem, (const bf16*)(ws + WS_CAT), 1024, INP(a, I_WOUT) + (size_t)li * 1024 * DM, l);
        else resid_gemm_phase(a, smem, (const bf16*)(ws + WS_CAT), DM, INP(a, I_PW2) + (size_t)li * DM * DM, l);
        break;
    case 6: if (EN(6)) route_phase(a, smem, l); break;
    case 7: if (EN(7)) moe_gemm_phase(a, smem, l, 0); break;
    case 8: if (EN(8)) moe_gemm_phase(a, smem, l, 1); break;
    }
}

#ifndef EMU
#define LAS __attribute__((address_space(3)))
#define XB_TMO      128
#define XB_XCNT(j)  (256  + 64 * (j))
#define XB_XSUB(j)  (1280 + 64 * (j))
#define XB_XGEN(j)  (2304 + 64 * (j))
#define XB_TOP      3328
#define XB_TOPGEN   3392
#define XCD_BAR_WORDS 3456
#define XB_SPIN_CAP (1u << 22)
__device__ __forceinline__ unsigned xb_ld(unsigned* p)              { return __hip_atomic_load(p, __ATOMIC_RELAXED, __HIP_MEMORY_SCOPE_AGENT); }
__device__ __forceinline__ unsigned xb_add(unsigned* p, unsigned v) { return __hip_atomic_fetch_add(p, v, __ATOMIC_RELAXED, __HIP_MEMORY_SCOPE_AGENT); }
__device__ __forceinline__ unsigned xb_xcc_id() { return (unsigned)__builtin_amdgcn_s_getreg((3 << 11) | 20) & 0xFu; }
#define XB_SPIN(cond, bar) do { unsigned _sp = 0; while (cond) { __builtin_amdgcn_s_sleep(1); \
    if ((++_sp & 255u) == 0u) { if (xb_ld(&(bar)[XB_TMO])) break; if (_sp > XB_SPIN_CAP) { atomicAdd(&(bar)[XB_TMO], 1u); break; } } } } while (0)
struct XcdBarrier { unsigned* bar; unsigned x; volatile LAS unsigned* st; };
__device__ __forceinline__ XcdBarrier xcd_barrier_post(unsigned* bar, volatile LAS unsigned* st) {
    XcdBarrier b; b.bar = bar; b.x = xb_xcc_id(); b.st = st;
    if (threadIdx.x == 0) (void)xb_add(&bar[XB_XCNT(b.x)], 1u);
    return b;
}
__device__ __forceinline__ void xcd_barrier_complete(unsigned* bar, unsigned x, unsigned& nloc, unsigned& nx) {
    const unsigned G = gridDim.x * gridDim.y * gridDim.z;
    unsigned sum, cnt, mine, sp = 0u;
    for (;;) {
        sum = 0u; cnt = 0u; mine = 0u;
#pragma unroll
        for (unsigned j = 0; j < 16; ++j) { const unsigned c = xb_ld(&bar[XB_XCNT(j)]); sum += c; cnt += (c > 0u) ? 1u : 0u; mine = (j == x) ? c : mine; }
        if (sum == G) break;
        __builtin_amdgcn_s_sleep(1);
        if ((++sp & 255u) == 0u) { if (xb_ld(&bar[XB_TMO])) break; if (sp > XB_SPIN_CAP) { atomicAdd(&bar[XB_TMO], 1u); break; } }
    }
    nloc = mine > 0u ? mine : 1u; nx = cnt > 0u ? cnt : 1u;
}
__device__ __forceinline__ void xcd_barrier(const XcdBarrier& b) {
    asm volatile("s_waitcnt vmcnt(0)" ::: "memory");
    __syncthreads();
    if (threadIdx.x == 0) {
        unsigned* bar = b.bar;
        __builtin_amdgcn_s_waitcnt(0);
        unsigned nloc = b.st[0], nx = b.st[1];
        if (nloc == 0u) { xcd_barrier_complete(bar, b.x, nloc, nx); b.st[0] = nloc; b.st[1] = nx; }
        const unsigned old = xb_add(&bar[XB_XSUB(b.x)], 1u);
        const unsigned gen = old / nloc;
        if (old + 1u == (gen + 1u) * nloc) {
            __builtin_amdgcn_fence(__ATOMIC_RELEASE, "agent");
            asm volatile("s_waitcnt vmcnt(0)" ::: "memory");
            const unsigned og = xb_add(&bar[XB_TOP], 1u);
            const unsigned tg = og / nx;
            if (og + 1u == (tg + 1u) * nx) xb_add(&bar[XB_TOPGEN], 1u);
            else XB_SPIN(xb_ld(&bar[XB_TOPGEN]) == tg, bar);
            __builtin_amdgcn_fence(__ATOMIC_ACQUIRE, "agent");
            xb_add(&bar[XB_XGEN(b.x)], 1u);
            asm volatile("s_waitcnt vmcnt(0)" ::: "memory");
        } else {
            XB_SPIN(xb_ld(&bar[XB_XGEN(b.x)]) == gen, bar);
            __builtin_amdgcn_fence(__ATOMIC_ACQUIRE, "agent");
            asm volatile("s_waitcnt vmcnt(0)" ::: "memory");
        }
    }
    __syncthreads();
}

__global__ void __launch_bounds__(NT, 2) mega(Args a) {
    extern __shared__ __attribute__((aligned(16))) unsigned char lds[];
    volatile LAS unsigned* st = (volatile LAS unsigned*)(LAS unsigned char*)(lds + LDS_BYTES - 16);
    if (threadIdx.x < 4) st[threadIdx.x] = 0u;
    __syncthreads();
    unsigned* barw = (unsigned*)(a.ws + WS_BAR);
    XcdBarrier bar = xcd_barrier_post(barw, st);
#pragma unroll 1
    for (int ph = 0; ph < N_PHASES; ++ph) {
        run_phase(a, lds, ph);
#ifdef DUP
        { const int sub = ph == 0 ? 100 : (ph - 1) % PH_PER_LAYER, lyr = (ph - 1) / PH_PER_LAYER;
          if (sub == (DUP % 1000) && (ph == 0 || lyr == DUP / 1000)) { xcd_barrier(bar); run_phase(a, lds, ph); } }
#endif
        if (ph + 1 < N_PHASES) xcd_barrier(bar);
    }
    if (xb_ld(&barw[XB_TMO]) != 0u) {
        const size_t gt = (size_t)blockIdx.x * NT + threadIdx.x, gs = (size_t)gridDim.x * NT;
        for (size_t i = gt; i < (size_t)T * DM; i += gs) a.out[i] = __builtin_nanf("");
    }
}

extern "C" void kernel_launch(void* const* d_in, const int* in_sizes, int n_in, void* d_out, int out_size,
                              void* d_ws, size_t ws_size, hipStream_t stream) {
    static int grid = 0;
    if (grid == 0) {
        int dev = 0, cus = 0;
        if (hipGetDevice(&dev) != hipSuccess || hipDeviceGetAttribute(&cus, hipDeviceAttributeMultiprocessorCount, dev) != hipSuccess) { grid = -1; return; }
        if (hipFuncSetAttribute((const void*)mega, hipFuncAttributeMaxDynamicSharedMemorySize, LDS_BYTES) != hipSuccess) { grid = -1; return; }
        (void)hipGetLastError();
        grid = cus;
        if (n_in != 26 || out_size != T * DM || ws_size < WS_END) { fprintf(stderr, "kernel_launch: unexpected sizes n_in %d out %d ws %zu (need %zu)\n", n_in, out_size, ws_size, (size_t)WS_END); grid = -1; return; }
    }
    if (grid < 0) return;
    (void)hipMemsetAsync((unsigned char*)d_ws + WS_BAR, 0, XCD_BAR_WORDS * 4, stream);
    Args a{};
    for (int i = 0; i < 26; ++i) a.in[i] = (const float*)d_in[i];
    a.out = (float*)d_out; a.ws = (unsigned char*)d_ws;
    hipLaunchKernelGGL(mega, dim3(grid), dim3(NT), LDS_BYTES, stream, a);
}
#endif
```

```cpp
#ifdef EMU
#include "emu.h"
#define DEV static inline
#define MDEV inline
#define OPAQUE(p)
#define TID emu_tid()
#define BID (EB->bid)
#define NBLK (EB->nblk)
#define SYNC() emu_sync_block()
#define WSYNC() emu_sync_wave()
#define mfma16(a, b, c) emu_mfma16(a, b, c)
DEV float shflx(float v, int m) { return emu_shfl_f(v, (emu_tid() & 63) ^ m); }
DEV int shflxi(int v, int m) { return (int)emu_shfl_u((unsigned)v, (emu_tid() & 63) ^ m); }
DEV float shfl(float v, int s) { return emu_shfl_f(v, s); }
DEV int atomic_add_i(int* p, int v) { return __atomic_fetch_add(p, v, __ATOMIC_RELAXED); }
DEV float fexp2(float x) { return exp2f(x); }
DEV float frcp(float x) { return 1.0f / x; }
DEV float frsq(float x) { return 1.0f / sqrtf(x); }
typedef short s16x4 __attribute__((vector_size(8)));
static inline s16x4 emu_tr4(const unsigned short* p) {
    EmuWave& w = EB->wave[emu_tid() >> 6]; int l = emu_tid() & 63;
    const unsigned short** tab = (const unsigned short**)w.a;
    tab[l] = p; emu_sync_wave();
    s16x4 r; int g = l & 48, i = l & 15;
    for (int q = 0; q < 4; ++q) r[q] = (short)tab[g + 4 * q + (i >> 2)][i & 3];
    emu_sync_wave(); return r;
}
#define tr4(p) emu_tr4(p)
#else
#include <hip/hip_runtime.h>
#include <cstdio>
#include <cstdint>
typedef short bf16x8 __attribute__((ext_vector_type(8)));
typedef float f32x4 __attribute__((ext_vector_type(4)));
typedef unsigned u32x4 __attribute__((ext_vector_type(4)));
typedef unsigned u32x2 __attribute__((ext_vector_type(2)));
#define DEV __device__ __forceinline__
#define MDEV __device__ __forceinline__
#define OPAQUE(p) asm volatile("" : "+v"(p))
DEV int tid_opaque() { int t = (int)threadIdx.x; asm volatile("" : "+v"(t)); return t; }
#define TID tid_opaque()
#define BID ((int)blockIdx.x)
#define NBLK ((int)gridDim.x)
#define SYNC() __syncthreads()
#define WSYNC() __builtin_amdgcn_wave_barrier()
#define mfma16(a, b, c) __builtin_amdgcn_mfma_f32_16x16x32_bf16(a, b, c, 0, 0, 0)
DEV float shflx(float v, int m) { return __shfl_xor(v, m); }
DEV int shflxi(int v, int m) { return __shfl_xor(v, m); }
DEV float shfl(float v, int s) { return __shfl(v, s); }
DEV int atomic_add_i(int* p, int v) { return atomicAdd(p, v); }
DEV float fexp2(float x) { return exp2f(x); }
DEV float frcp(float x) { return 1.0f / x; }
DEV float frsq(float x) { return rsqrtf(x); }
typedef short s16x4 __attribute__((ext_vector_type(4)));
#define tr4(p) __builtin_amdgcn_ds_read_tr16_b64_v4i16((__attribute__((address_space(3))) s16x4*)(p))
#endif

typedef unsigned short bf16;

#ifndef DM
#define DM 1024
#endif
#ifndef SEQ
#define SEQ 8192
#endif
#ifndef FF
#define FF 512
#endif
constexpr int NBATCH = 2, T = NBATCH * SEQ, DEPTH = 4;
constexpr int NIN = 3352, NINP = 3456;
constexpr int NT = 512;
constexpr int NCH = SEQ / 64;
constexpr int NCP = SEQ / 16;
constexpr int NCMP = NCP - 1;
constexpr int MOE_ROWS = 2 * T + 32 * 256;
constexpr float EPS = 1e-6f, NEGV = -1e30f, FORCEV = 1e4f, LOG2E = 1.4426950408889634f;

constexpr size_t al(size_t x) { return (x + 255) & ~(size_t)255; }
constexpr size_t WS_BAR = 0;
constexpr size_t WS_CNT = 16384;
constexpr size_t WS_MOD = WS_CNT + 1024;
constexpr size_t WS_LB = al(WS_MOD + (size_t)DEPTH * 2 * 6 * DM * 4);
constexpr size_t WS_CB = al(WS_LB + 2 * 512 * 4);
constexpr size_t WS_CS = al(WS_CB + 2 * 2 * 8 * 64 * 4);
constexpr size_t WS_WIN = al(WS_CS + 64);
constexpr size_t WS_WOUT = al(WS_WIN + (size_t)2 * NINP * DM * 2);
constexpr size_t WS_PW1 = al(WS_WOUT + (size_t)2 * DM * 1024 * 2);
constexpr size_t WS_PW2 = al(WS_PW1 + (size_t)2 * 2 * DM * DM * 2);
constexpr size_t WS_WC = al(WS_PW2 + (size_t)2 * DM * DM * 2);
constexpr size_t WS_W13 = al(WS_WC + (size_t)2 * 2 * 64 * 2048 * 2);
constexpr size_t WS_W2 = al(WS_W13 + (size_t)DEPTH * 32 * 2 * FF * DM * 2);
constexpr size_t WS_H = al(WS_W2 + (size_t)DEPTH * 32 * DM * FF * 2);
constexpr size_t WS_QN = al(WS_H + (size_t)T * DM * 2);
constexpr size_t WS_KCG = al(WS_QN + (size_t)T * 512 * 2);
constexpr size_t WS_VCG = al(WS_KCG + (size_t)T * 128 * 2);
constexpr size_t WS_KS = al(WS_VCG + (size_t)T * 128 * 2);
constexpr size_t WS_KW = al(WS_KS + (size_t)T * 128 * 2);
constexpr size_t WS_VST = al(WS_KW + (size_t)T * 128 * 2);
constexpr size_t WS_VWT = al(WS_VST + (size_t)T * 128 * 2);
constexpr size_t WS_KC = al(WS_VWT + (size_t)T * 128 * 2);
constexpr size_t WS_VCT = al(WS_KC + (size_t)4 * NCP * 64 * 2);
constexpr size_t WS_GATE = al(WS_VCT + (size_t)4 * NCP * 64 * 2);
constexpr size_t WS_HQ = al(WS_GATE + (size_t)T * 24 * 4);
constexpr size_t WS_HF = al(WS_HQ + (size_t)T * 512 * 2);
constexpr size_t WS_HV = al(WS_HF + (size_t)T * 512 * 4);
constexpr size_t WS_HGS = al(WS_HV + (size_t)T * 512 * 2);
constexpr size_t WS_UT = al(WS_HGS + (size_t)T * 512 * 2);
constexpr size_t WS_ST = al(WS_UT + (size_t)8 * NCH * 128 * 128 * 4);
constexpr size_t WS_GD = al(WS_ST + (size_t)8 * NCH * 128 * 128 * 2);
constexpr size_t WS_CAT = al(WS_GD + (size_t)8 * NCH * 128 * 4);
constexpr size_t WS_GLU = al(WS_CAT + (size_t)T * 1024 * 2);
constexpr size_t WS_TIE = al(WS_GLU + (size_t)T * DM * 2);
constexpr size_t WS_TIW = al(WS_TIE + (size_t)T * 2 * 4);
constexpr size_t WS_LIST = al(WS_TIW + (size_t)T * 2 * 4);
constexpr size_t WS_ACT = al(WS_LIST + (size_t)32 * T * 4);
constexpr size_t WS_YK = al(WS_ACT + (size_t)MOE_ROWS * FF * 2);
constexpr size_t WS_END = al(WS_YK + (size_t)MOE_ROWS * DM * 2);

struct Args { const float* in[26]; float* out; unsigned char* ws; };
enum { I_X = 0, I_C, I_ADAW, I_ADAB, I_NMIX, I_NFFN, I_WIN, I_WOUT, I_CWK, I_CWV, I_CPE, I_QG, I_KG, I_LBL, I_OG,
       I_PW1, I_DW, I_DWB, I_LNG, I_LNB, I_PW2, I_WG, I_WE, I_W1, I_W3, I_W2 };

#ifdef EMU
DEV unsigned char* wsp(const Args& a) { return a.ws; }
DEV float* outp(const Args& a) { return a.out; }
#else
DEV unsigned char* wsp(const Args& a) { int z = 0; asm volatile("" : "+s"(z)); return a.ws + z; }
DEV float* outp(const Args& a) { int z = 0; asm volatile("" : "+s"(z)); return a.out + z; }
#endif

#ifdef EMU
#define INP(a, X) ((a).in[X])
#else
DEV int zero_opaque() { int z = 0; asm volatile("" : "+s"(z)); return z; }
#define INP(a, X) ((a).in[(X) + zero_opaque()])
#endif

DEV unsigned f2bf(float f) { unsigned u = __builtin_bit_cast(unsigned, f); return (u + 0x7fffu + ((u >> 16) & 1u)) >> 16; }
DEV float bf2f(unsigned h) { return __builtin_bit_cast(float, h << 16); }
#ifdef EMU
DEV unsigned pk2(float lo, float hi) { return f2bf(lo) | (f2bf(hi) << 16); }
#else
typedef float f32x2_t __attribute__((ext_vector_type(2)));
typedef __bf16 bf16x2_t __attribute__((ext_vector_type(2)));
DEV unsigned pk2(float lo, float hi) { f32x2_t v = {lo, hi}; bf16x2_t b = __builtin_convertvector(v, bf16x2_t); return __builtin_bit_cast(unsigned, b); }
#endif
DEV float sigm(float x) { return frcp(1.0f + fexp2(-x * LOG2E)); }
DEV float siluf(float x) { return x * sigm(x); }
DEV f32x4 f4zero() { f32x4 z = {0.f, 0.f, 0.f, 0.f}; return z; }
DEV bf16x8 pack8(f32x4 a, f32x4 b) {
    u32x4 w; w[0] = pk2(a[0], a[1]); w[1] = pk2(a[2], a[3]); w[2] = pk2(b[0], b[1]); w[3] = pk2(b[2], b[3]);
    return __builtin_bit_cast(bf16x8, w);
}
DEV void st_bf4(bf16* p, f32x4 v) { u32x2 w; w[0] = pk2(v[0], v[1]); w[1] = pk2(v[2], v[3]); *(u32x2*)p = w; }

constexpr int LDT = 72;
constexpr int GEMM_AS = 256 * LDT, GEMM_BS = 128 * LDT;
constexpr int GEMM_LDS = 2 * (GEMM_AS + GEMM_BS) * 2;

template <class AF, class EPI>
DEV void gemm_tile(unsigned char* smem, AF af, const bf16* Bt, int ldb, int nvalid, int K, EPI& epi) {
    const int tid = TID, w = tid >> 6, l = tid & 63, h = l >> 4, c = l & 15, wm = w >> 1, wn = w & 1;
    bf16* As = (bf16*)smem; bf16* Bs = As + 2 * GEMM_AS;
    const bf16* ap[4]; const bf16* bp[2];
    const int col8 = (tid & 7) * 8, r0 = tid >> 3;
#pragma unroll
    for (int i = 0; i < 4; ++i) ap[i] = af(r0 + 64 * i) + col8;
#pragma unroll
    for (int i = 0; i < 2; ++i) { int rn = r0 + 64 * i; if (rn >= nvalid) rn = nvalid - 1; bp[i] = Bt + (size_t)rn * ldb + col8; }
    f32x4 acc[4][4];
#pragma unroll
    for (int i = 0; i < 4; ++i)
#pragma unroll
        for (int j = 0; j < 4; ++j) acc[i][j] = f4zero();
    bf16x8 ra[4], rb[2];
#pragma unroll
    for (int i = 0; i < 4; ++i) ra[i] = *(const bf16x8*)(ap[i]);
#pragma unroll
    for (int i = 0; i < 2; ++i) rb[i] = *(const bf16x8*)(bp[i]);
    SYNC();
#pragma unroll
    for (int i = 0; i < 4; ++i) *(bf16x8*)(As + (r0 + 64 * i) * LDT + col8) = ra[i];
#pragma unroll
    for (int i = 0; i < 2; ++i) *(bf16x8*)(Bs + (r0 + 64 * i) * LDT + col8) = rb[i];
    SYNC();
    const int nk = K / 64;
    for (int kt = 0; kt < nk; ++kt) {
        const int cur = kt & 1;
        if (kt + 1 < nk) {
#pragma unroll
            for (int i = 0; i < 4; ++i) ra[i] = *(const bf16x8*)(ap[i] + (kt + 1) * 64);
#pragma unroll
            for (int i = 0; i < 2; ++i) rb[i] = *(const bf16x8*)(bp[i] + (kt + 1) * 64);
        }
        const bf16* Ac = As + cur * GEMM_AS + (wm * 64 + c) * LDT + 8 * h;
        const bf16* Bc = Bs + cur * GEMM_BS + (wn * 64 + c) * LDT + 8 * h;
#pragma unroll
        for (int kk = 0; kk < 2; ++kk) {
            bf16x8 fa[4], fb[4];
#pragma unroll
            for (int i = 0; i < 4; ++i) { fa[i] = *(const bf16x8*)(Ac + i * 16 * LDT + kk * 32); fb[i] = *(const bf16x8*)(Bc + i * 16 * LDT + kk * 32); }
#pragma unroll
            for (int ni = 0; ni < 4; ++ni)
#pragma unroll
                for (int mi = 0; mi < 4; ++mi) acc[ni][mi] = mfma16(fb[ni], fa[mi], acc[ni][mi]);
        }
        if (kt + 1 < nk) {
            const int nx = cur ^ 1;
#pragma unroll
            for (int i = 0; i < 4; ++i) *(bf16x8*)(As + nx * GEMM_AS + (r0 + 64 * i) * LDT + col8) = ra[i];
#pragma unroll
            for (int i = 0; i < 2; ++i) *(bf16x8*)(Bs + nx * GEMM_BS + (r0 + 64 * i) * LDT + col8) = rb[i];
        }
        SYNC();
    }
    epi(acc, wm * 64, wn * 64, h, c);
}

struct ARows { const bf16* base; size_t ld; MDEV const bf16* operator()(int r) const { return base + (size_t)r * ld; } };

constexpr int LDB = 136;
constexpr int GEMM_BS2 = 64 * LDB;
constexpr int GEMM2_LDS = (2 * GEMM_AS + 2 * GEMM_BS2) * 2;
DEV bf16x8 tr_read8(const bf16* p0, const bf16* p1) {
    const s16x4 x = tr4(p0), y = tr4(p1); bf16x8 r;
    r[0] = x[0]; r[1] = x[1]; r[2] = x[2]; r[3] = x[3]; r[4] = y[0]; r[5] = y[1]; r[6] = y[2]; r[7] = y[3]; return r;
}
template <class AF, class BF, class EPI>
DEV void gemm_tile2(unsigned char* smem, AF af, BF bf, int ldb, int K, EPI& epi) {
    const int tid = TID, w = tid >> 6, l = tid & 63, h = l >> 4, c = l & 15, wm = w >> 1, wn = w & 1;
    bf16* As = (bf16*)smem; bf16* Bs = As + 2 * GEMM_AS;
    const bf16* ap[4];
    const int col8 = (tid & 7) * 8, r0 = tid >> 3;
#pragma unroll
    for (int i = 0; i < 4; ++i) ap[i] = af(r0 + 64 * i) + col8;
    const int bn4 = (tid & 31) * 4, bk = tid >> 5;
    const float* bp = bf(bn4); const bool bok = bp != nullptr;
    if (bok) bp += (size_t)bk * ldb;
    const size_t bstep = (size_t)16 * ldb;
    f32x4 acc[4][4];
#pragma unroll
    for (int i = 0; i < 4; ++i)
#pragma unroll
        for (int j = 0; j < 4; ++j) acc[i][j] = f4zero();
    bf16x8 ra[4]; f32x4 rb[4];
#pragma unroll
    for (int i = 0; i < 4; ++i) { ra[i] = *(const bf16x8*)(ap[i]); rb[i] = bok ? *(const f32x4*)(bp + i * bstep) : f4zero(); }
    SYNC();
#pragma unroll
    for (int i = 0; i < 4; ++i) { *(bf16x8*)(As + (r0 + 64 * i) * LDT + col8) = ra[i]; st_bf4(Bs + (bk + 16 * i) * LDB + bn4, rb[i]); }
    SYNC();
    const int nk = K / 64;
    for (int kt = 0; kt < nk; ++kt) {
        const int cur = kt & 1;
        if (kt + 1 < nk) {
#pragma unroll
            for (int i = 0; i < 4; ++i) { ra[i] = *(const bf16x8*)(ap[i] + (kt + 1) * 64); rb[i] = bok ? *(const f32x4*)(bp + (size_t)(kt + 1) * 64 * ldb + i * bstep) : f4zero(); }
        }
        const bf16* Ac = As + cur * GEMM_AS + (wm * 64 + c) * LDT + 8 * h;
        const bf16* Bc = Bs + cur * GEMM_BS2 + (8 * h + (c >> 2)) * LDB + wn * 64 + 4 * (c & 3);
#pragma unroll
        for (int kk = 0; kk < 2; ++kk) {
            bf16x8 fa[4], fb[4];
#pragma unroll
            for (int i = 0; i < 4; ++i) { fa[i] = *(const bf16x8*)(Ac + i * 16 * LDT + kk * 32); fb[i] = tr_read8(Bc + (32 * kk) * LDB + 16 * i, Bc + (32 * kk + 4) * LDB + 16 * i); }
#pragma unroll
            for (int ni = 0; ni < 4; ++ni)
#pragma unroll
                for (int mi = 0; mi < 4; ++mi) acc[ni][mi] = mfma16(fb[ni], fa[mi], acc[ni][mi]);
        }
        if (kt + 1 < nk) {
            const int nx = cur ^ 1;
#pragma unroll
            for (int i = 0; i < 4; ++i) { *(bf16x8*)(As + nx * GEMM_AS + (r0 + 64 * i) * LDT + col8) = ra[i]; st_bf4(Bs + nx * GEMM_BS2 + (bk + 16 * i) * LDB + bn4, rb[i]); }
        }
        SYNC();
    }
    epi(acc, wm * 64, wn * 64, h, c);
}
struct BPlain { const float* base; MDEV const float* operator()(int nt) const { return base + nt; } };
struct BInProjMap { const float* base; int n0; MDEV const float* operator()(int nt) const { const int n = n0 + nt; const int sc = n < 1280 ? n : (n < 3328 ? n + 24 : (n < 3352 ? 1280 + (n - 3328) : -1)); return sc < 0 ? nullptr : base + sc; } };
struct BInter { const float* s0; const float* s1; int n0; MDEV const float* operator()(int nt) const { const int n = n0 + nt, g = n >> 6, w = n & 63; return w < 32 ? s0 + g * 32 + w : s1 + g * 32 + w - 32; } };
struct BClamp64 { const float* base; MDEV const float* operator()(int nt) const { return base + (nt & 63); } };

struct EpiInProj {
    const Args* a; int m0, n0, li;
    MDEV void operator()(f32x4 (&acc)[4][4], int mw, int nw, int h, int c) const {
        unsigned char* ws = wsp(*a);
        const int nb = n0 + nw;
        const int tokb = m0 + mw + c;
        if (nb < 512 || (nb >= 768 && nb < 896) || (nb >= 1024 && nb < 1152)) {
            const float* gain; float mul = 1.f; bf16* dst; int kind;
            if (nb < 512) { gain = INP(*a, I_QG) + li * 64; mul = 0.125f; kind = 0; dst = (bf16*)(ws + WS_QN); }
            else if (nb < 896) { gain = INP(*a, I_KG) + (li * 3 + 1) * 64; kind = 1; dst = (bf16*)(ws + WS_KS); }
            else { gain = INP(*a, I_KG) + (li * 3 + 2) * 64; kind = 1; dst = (bf16*)(ws + WS_KW); }
            const int g = (nb >> 6) & 1;
#pragma unroll
            for (int mi = 0; mi < 4; ++mi) {
                float ss = 0.f;
#pragma unroll
                for (int ni = 0; ni < 4; ++ni) { f32x4 v = acc[ni][mi]; ss += v[0] * v[0] + v[1] * v[1] + v[2] * v[2] + v[3] * v[3]; }
                ss += shflx(ss, 16); ss += shflx(ss, 32);
                const float rs = frsq(ss * (1.0f / 64.0f) + EPS) * mul;
                const int tok = tokb + 16 * mi;
#pragma unroll
                for (int ni = 0; ni < 4; ++ni) {
                    const int d = 16 * ni + 4 * h; f32x4 v = acc[ni][mi], o;
#pragma unroll
                    for (int r = 0; r < 4; ++r) o[r] = v[r] * rs * gain[d + r];
                    if (kind == 0) st_bf4(dst + (size_t)tok * 512 + nb + d, o);
                    else { const int b = tok / SEQ, s = tok % SEQ; st_bf4(dst + ((size_t)(b * 2 + g) * SEQ + s) * 64 + d, o); }
                }
            }
        } else if (nb < 768) {
            bf16* dst = (bf16*)(ws + (nb < 640 ? WS_KCG : WS_VCG)); const int g = (nb >> 6) & 1;
#pragma unroll
            for (int mi = 0; mi < 4; ++mi) { const int tok = tokb + 16 * mi, b = tok / SEQ, s = tok % SEQ;
#pragma unroll
                for (int ni = 0; ni < 4; ++ni) st_bf4(dst + ((size_t)(b * 2 + g) * SEQ + s) * 64 + 16 * ni + 4 * h, acc[ni][mi]); }
        } else if (nb < 1280) {
            bf16* dst = (bf16*)(ws + (nb < 1024 ? WS_VST : WS_VWT)); const int g = (nb >> 6) & 1;
#pragma unroll
            for (int mi = 0; mi < 4; ++mi) { const int tok = tokb + 16 * mi, b = tok / SEQ, s = tok % SEQ;
                bf16* p = dst + ((size_t)(b * 2 + g) * NCH + (s >> 6)) * 4096 + (s & 63);
#pragma unroll
                for (int ni = 0; ni < 4; ++ni)
#pragma unroll
                    for (int r = 0; r < 4; ++r) p[(16 * ni + 4 * h + r) * 64] = (bf16)f2bf(acc[ni][mi][r]); }
        } else if (nb < 3328) {
            const int sec = (nb - 1280) >> 9, cc = (nb - 1280) & 511, hh = cc >> 7, d0 = cc & 127;
#pragma unroll
            for (int mi = 0; mi < 4; ++mi) { const int tok = tokb + 16 * mi, b = tok / SEQ, s = tok % SEQ;
                const size_t hrow = ((size_t)(b * 4 + hh) * SEQ + s) * 128 + d0;
#pragma unroll
                for (int ni = 0; ni < 4; ++ni) { const int d = 16 * ni + 4 * h; f32x4 v = acc[ni][mi], o;
                    if (sec == 0) { for (int r = 0; r < 4; ++r) o[r] = siluf(v[r]); st_bf4((bf16*)(ws + WS_HQ) + hrow + d, o); }
                    else if (sec == 1) { const float* lb = (const float*)(ws + WS_LB) + li * 512 + cc + d;
                        for (int r = 0; r < 4; ++r) o[r] = lb[r] + (1.0f - lb[r]) * sigm(v[r]);
                        *(f32x4*)((float*)(ws + WS_HF) + hrow + d) = o; }
                    else if (sec == 2) st_bf4((bf16*)(ws + WS_HV) + hrow + d, v);
                    else { for (int r = 0; r < 4; ++r) o[r] = siluf(v[r]); st_bf4((bf16*)(ws + WS_HGS) + (size_t)tok * 512 + cc + d, o); }
                } }
        } else if (nb == 3328) {
            float* dst = (float*)(ws + WS_GATE);
#pragma unroll
            for (int mi = 0; mi < 4; ++mi) { const int tok = tokb + 16 * mi;
#pragma unroll
                for (int ni = 0; ni < 2; ++ni)
#pragma unroll
                    for (int r = 0; r < 4; ++r) { const int n = 16 * ni + 4 * h + r; if (n < 24) dst[(size_t)tok * 24 + n] = sigm(acc[ni][mi][r]); } }
        }
    }
};

struct EpiResid {
    float* x; const float* gate; int m0, n0;
    MDEV void operator()(f32x4 (&acc)[4][4], int mw, int nw, int h, int c) const {
#pragma unroll
        for (int mi = 0; mi < 4; ++mi) { const int tok = m0 + mw + 16 * mi + c, b = tok / SEQ;
#pragma unroll
            for (int ni = 0; ni < 4; ++ni) { const int n = n0 + nw + 16 * ni + 4 * h;
                f32x4 g = *(const f32x4*)(gate + (size_t)b * 6 * DM + n); f32x4* p = (f32x4*)(x + (size_t)tok * DM + n); f32x4 v = *p;
#pragma unroll
                for (int r = 0; r < 4; ++r) v[r] += g[r] * acc[ni][mi][r];
                *p = v; } }
    }
};
template <int MODE> struct EpiGated {
    bf16* dst; size_t ld; int m0, n0, mvalid;
    MDEV void operator()(f32x4 (&acc)[4][4], int mw, int nw, int h, int c) const {
        const int cb = (n0 + nw) / 2;
#pragma unroll
        for (int mi = 0; mi < 4; ++mi) { const int m = mw + 16 * mi + c; if (m >= mvalid) continue;
#pragma unroll
            for (int ni = 0; ni < 2; ++ni) { f32x4 o;
#pragma unroll
                for (int r = 0; r < 4; ++r) { const float av = acc[ni][mi][r], bv = acc[ni + 2][mi][r]; o[r] = MODE == 0 ? av * sigm(bv) : siluf(av) * bv; }
                st_bf4(dst + (size_t)(m0 + m) * ld + cb + 16 * ni + 4 * h, o); } }
    }
};
struct EpiStoreBf {
    bf16* dst; size_t ld; int m0, n0, mvalid;
    MDEV void operator()(f32x4 (&acc)[4][4], int mw, int nw, int h, int c) const {
#pragma unroll
        for (int mi = 0; mi < 4; ++mi) { const int m = mw + 16 * mi + c; if (m >= mvalid) continue;
#pragma unroll
            for (int ni = 0; ni < 4; ++ni) st_bf4(dst + (size_t)(m0 + m) * ld + n0 + nw + 16 * ni + 4 * h, acc[ni][mi]); }
    }
};
struct EpiCmp {
    const Args* a; int kv, bg, m0, li;
    MDEV void operator()(f32x4 (&acc)[4][4], int mw, int nw, int h, int c) const {
        if (nw != 0) return;
        unsigned char* ws = wsp(*a);
        const float* bp8 = (const float*)(ws + WS_CB) + (li * 2 + kv) * 8 * 64;
        float bias[16];
#pragma unroll
        for (int q = 0; q < 16; ++q) { const int e = 16 * (q >> 2) + 4 * h + (q & 3); float v = 0.f;
#pragma unroll
            for (int kp = 0; kp < 8; ++kp) v += bp8[kp * 64 + e];
            bias[q] = v; }
        const float* gain = INP(*a, I_KG) + (li * 3 + 0) * 64;
#pragma unroll
        for (int mi = 0; mi < 4; ++mi) { const int n = m0 + mw + 16 * mi + c; const bool ok = n < NCMP;
            f32x4 v[4]; float ss = 0.f;
#pragma unroll
            for (int ni = 0; ni < 4; ++ni) { v[ni] = acc[ni][mi];
#pragma unroll
                for (int r = 0; r < 4; ++r) { v[ni][r] += bias[4 * ni + r]; ss += v[ni][r] * v[ni][r]; } }
            ss += shflx(ss, 16); ss += shflx(ss, 32);
            if (n >= NCP) continue;
            if (kv == 0) { const float rs = frsq(ss * (1.0f / 64.0f) + EPS); bf16* p = (bf16*)(ws + WS_KC) + ((size_t)bg * NCP + n) * 64;
#pragma unroll
                for (int ni = 0; ni < 4; ++ni) { f32x4 o;
#pragma unroll
                    for (int r = 0; r < 4; ++r) o[r] = ok ? v[ni][r] * rs * gain[16 * ni + 4 * h + r] : 0.f;
                    st_bf4(p + 16 * ni + 4 * h, o); }
            } else { bf16* p = (bf16*)(ws + WS_VCT) + (size_t)bg * 64 * NCP + n;
#pragma unroll
                for (int ni = 0; ni < 4; ++ni)
#pragma unroll
                    for (int r = 0; r < 4; ++r) p[(size_t)(16 * ni + 4 * h + r) * NCP] = (bf16)f2bf(ok ? v[ni][r] : 0.f); }
        }
    }
};

DEV void tr_tile(unsigned char* smem, const float* src0, const float* src1, int ld, int K, int mode, bf16* dst, int n0, int k0) {
    bf16* tl = (bf16*)smem;
    const int tid = TID;
    SYNC();
#pragma unroll
    for (int i = 0; i < 8; ++i) {
        const int e = tid + 512 * i, kk = e >> 6, nn = e & 63, n = n0 + nn; float v = 0.f;
        if (mode == 0) v = src0[(size_t)(k0 + kk) * ld + n];
        else if (mode == 1) { int sc = n < 1280 ? n : (n < 3328 ? n + 24 : (n < 3352 ? 1280 + (n - 3328) : -1)); if (sc >= 0) v = src0[(size_t)(k0 + kk) * ld + sc]; }
        else { const int g = n >> 6, w = n & 63; v = (w < 32) ? src0[(size_t)(k0 + kk) * ld + g * 32 + w] : src1[(size_t)(k0 + kk) * ld + g * 32 + w - 32]; }
        tl[nn * LDT + kk] = (bf16)f2bf(v);
    }
    SYNC();
    const int nn = tid >> 3, k8 = (tid & 7) * 8;
    *(bf16x8*)(dst + (size_t)(n0 + nn) * K + k0 + k8) = *(const bf16x8*)(tl + nn * LDT + k8);
}

struct TrJob { const float* s0; const float* s1; int ld, K, N, mode; bf16* dst; };
DEV void p0_phase(const Args& a, unsigned char* smem) {
    unsigned char* ws = wsp(a); const int tid = TID;
    {
        float* red = (float*)smem;
        constexpr int NG = 6 * DM / 128; const int ntask = DEPTH * NG;
        for (int t = BID; t < ntask; t += NBLK) {
            const int l = t / NG, j0 = (t % NG) * 128, cq = tid & 31, kr = tid >> 5;
            const float* w = INP(a, I_ADAW) + (size_t)l * DM * 6 * DM + j0 + 4 * cq; const float* cc = INP(a, I_C);
            f32x4 a0 = f4zero(), a1 = f4zero();
#pragma unroll 8
            for (int i = 0; i < DM / 16; ++i) { const int k = kr + 16 * i; const f32x4 wv = *(const f32x4*)(w + (size_t)k * 6 * DM); const float s0 = siluf(cc[k]), s1 = siluf(cc[DM + k]);
#pragma unroll
                for (int r = 0; r < 4; ++r) { a0[r] += s0 * wv[r]; a1[r] += s1 * wv[r]; } }
            SYNC();
            *(f32x4*)(red + (kr * 2 + 0) * 128 + 4 * cq) = a0; *(f32x4*)(red + (kr * 2 + 1) * 128 + 4 * cq) = a1;
            SYNC();
            if (tid < 256) { const int b = tid >> 7, col = tid & 127; float sum = INP(a, I_ADAB)[(size_t)l * 6 * DM + j0 + col];
#pragma unroll
                for (int q = 0; q < 16; ++q) sum += red[(q * 2 + b) * 128 + col];
                ((float*)(ws + WS_MOD))[((size_t)l * 2 + b) * 6 * DM + j0 + col] = sum; }
        }
    }
    for (int t = BID; t < 32; t += NBLK) {
        float* red = (float*)smem; const int ikv = t >> 3, kp = t & 7, i = ikv >> 1, kv = ikv & 1, e = tid & 63, ks = tid >> 6;
        const float* W = INP(a, kv ? I_CWV : I_CWK) + (size_t)i * 2048 * 64 + e; const float* pe = INP(a, I_CPE) + (size_t)i * 2048;
        float sum = 0.f;
#pragma unroll 8
        for (int q = 0; q < 32; ++q) { const int k = kp * 256 + ks * 32 + q; sum += pe[k] * W[(size_t)k * 64]; }
        SYNC(); red[ks * 64 + e] = sum; SYNC();
        if (tid < 64) { float v = 0.f; for (int q = 0; q < 8; ++q) v += red[q * 64 + tid]; ((float*)(ws + WS_CB))[(ikv * 8 + kp) * 64 + tid] = v; }
    }
    if (BID == 0) {
        for (int i = tid; i < DEPTH * 32; i += NT) ((int*)(ws + WS_CNT))[i] = 0;
        for (int n = tid; n < 512; n += NT) { const float l0 = INP(a, I_LBL)[n], l1 = INP(a, I_LBL)[512 + n]; const float m = fmaxf(l0, l1);
            const float e0 = fexp2((l0 - m) * LOG2E), e1 = fexp2((l1 - m) * LOG2E);
            ((float*)(ws + WS_LB))[n] = 0.f; ((float*)(ws + WS_LB))[512 + n] = e1 / (e0 + e1); }
        if (tid < 2) { const int i = tid; float mq = 0.f; for (int d = 0; d < 64; ++d) mq = fmaxf(mq, fabsf(INP(a, I_QG)[i * 64 + d]));
            for (int br = 0; br < 3; ++br) { float mk = 0.f; for (int d = 0; d < 64; ++d) mk = fmaxf(mk, fabsf(INP(a, I_KG)[(i * 3 + br) * 64 + d]));
                ((float*)(ws + WS_CS))[i * 4 + br] = 8.0f * mq * mk * LOG2E; } }
    }
}

constexpr int NJV = DM / 256;
DEV void moe_bases(const int* cnt, int* rb  ) {
    if (TID == 0) { int acc = 0; for (int e = 0; e < 32; ++e) { rb[e] = acc; acc += ((cnt[e] + 255) >> 8) << 8; } rb[32] = acc; }
    SYNC();
}
DEV void norm_phase(const Args& a, unsigned char* smem, int l) {
    unsigned char* ws = wsp(a); const int tid = TID, w = tid >> 6, lane = tid & 63;
    int* rb = (int*)smem;
    if (l > 0) moe_bases((const int*)(ws + WS_CNT) + (l - 1) * 32, rb);
    const float* mod = (const float*)(ws + WS_MOD);
    const bf16* yk = (const bf16*)(ws + WS_YK);
    for (int row = BID * 8 + w; row < T; row += NBLK * 8) {
        const int b = row / SEQ;
        f32x4 v[NJV];
        const float* xin = (l == 0) ? INP(a, I_X) : outp(a);
#pragma unroll
        for (int j = 0; j < NJV; ++j) v[j] = *(const f32x4*)(xin + (size_t)row * DM + 4 * lane + 256 * j);
        if (l > 0) {
            const int* tie = (const int*)(ws + WS_TIE) + (size_t)row * 2; const float* tiw = (const float*)(ws + WS_TIW) + (size_t)row * 2;
            const int e0 = tie[0] >> 14, p0 = tie[0] & 16383, e1 = tie[1] >> 14, p1 = tie[1] & 16383;
            const float w0 = tiw[0], w1 = tiw[1];
            const bf16* y0 = yk + (size_t)(rb[e0] + p0) * DM; const bf16* y1 = yk + (size_t)(rb[e1] + p1) * DM;
            const float* gf = mod + ((size_t)(l - 1) * 2 + b) * 6 * DM + 5 * DM;
#pragma unroll
            for (int j = 0; j < NJV; ++j) { const int cidx = 4 * lane + 256 * j; u32x2 q0 = *(const u32x2*)(y0 + cidx), q1 = *(const u32x2*)(y1 + cidx);
                f32x4 g = *(const f32x4*)(gf + cidx);
                v[j][0] += g[0] * (w0 * bf2f(q0[0] & 0xffff) + w1 * bf2f(q1[0] & 0xffff));
                v[j][1] += g[1] * (w0 * bf2f(q0[0] >> 16) + w1 * bf2f(q1[0] >> 16));
                v[j][2] += g[2] * (w0 * bf2f(q0[1] & 0xffff) + w1 * bf2f(q1[1] & 0xffff));
                v[j][3] += g[3] * (w0 * bf2f(q0[1] >> 16) + w1 * bf2f(q1[1] >> 16)); }
        }
#pragma unroll
        for (int j = 0; j < NJV; ++j) *(f32x4*)(outp(a) + (size_t)row * DM + 4 * lane + 256 * j) = v[j];
        if (l == DEPTH) continue;
        float ss = 0.f;
#pragma unroll
        for (int j = 0; j < NJV; ++j) ss += v[j][0] * v[j][0] + v[j][1] * v[j][1] + v[j][2] * v[j][2] + v[j][3] * v[j][3];
#pragma unroll
        for (int o = 1; o < 64; o <<= 1) ss += shflx(ss, o);
        const float rs = frsq(ss * (1.0f / DM) + EPS);
        const float* mm = mod + ((size_t)l * 2 + b) * 6 * DM; const float* nm = INP(a, I_NMIX) + (size_t)l * DM;
        bf16* hb = (bf16*)(ws + WS_H) + (size_t)row * DM;
#pragma unroll
        for (int j = 0; j < NJV; ++j) { const int cidx = 4 * lane + 256 * j; f32x4 g = *(const f32x4*)(nm + cidx), sh = *(const f32x4*)(mm + cidx), sc = *(const f32x4*)(mm + DM + cidx), o;
#pragma unroll
            for (int r = 0; r < 4; ++r) o[r] = v[j][r] * rs * g[r] * (1.0f + sc[r]) + sh[r];
            st_bf4(hb + cidx, o); }
    }
}

DEV void route_phase(const Args& a, unsigned char* smem, int l) {
    unsigned char* ws = wsp(a); const int tid = TID;
    float* W = (float*)smem;
    SYNC();
    { const f32x4* wg4 = (const f32x4*)(INP(a, I_WG) + (size_t)l * DM * 4); const f32x4* we4 = (const f32x4*)(INP(a, I_WE) + (size_t)l * DM * 32);
      for (int i = tid; i < DM; i += NT) *(f32x4*)(W + i * 36) = wg4[i];
#pragma unroll 4
      for (int i = tid; i < DM * 8; i += NT) *(f32x4*)(W + (i >> 3) * 36 + 4 + 4 * (i & 7)) = we4[i]; }
    SYNC();
    const float* mod = (const float*)(ws + WS_MOD); const float* nf = INP(a, I_NFFN) + (size_t)l * DM;
    int* cnt = (int*)(ws + WS_CNT) + l * 32;
    constexpr int NI = DM / 32;
    for (int pass = BID; pass < T / 16; pass += NBLK) {
        const int tok = pass * 16 + (tid >> 5), part = tid & 31, b = tok / SEQ;
        const float* xr = outp(a) + (size_t)tok * DM; float xv[NI]; float ss = 0.f;
#pragma unroll
        for (int i = 0; i < NI; ++i) { xv[i] = xr[part + 32 * i]; ss += xv[i] * xv[i]; }
#pragma unroll
        for (int o = 1; o < 32; o <<= 1) ss += shflx(ss, o);
        const float rs = frsq(ss * (1.0f / DM) + EPS);
        const float* mm = mod + ((size_t)l * 2 + b) * 6 * DM; bf16* hb = (bf16*)(ws + WS_H) + (size_t)tok * DM;
        float acc[36];
#pragma unroll
        for (int n = 0; n < 36; ++n) acc[n] = 0.f;
#pragma unroll 4
        for (int i = 0; i < NI; ++i) { const int k = part + 32 * i; const float hn = xv[i] * rs * nf[k] * (1.0f + mm[4 * DM + k]) + mm[3 * DM + k];
            hb[k] = (bf16)f2bf(hn); const float* wr = W + k * 36;
#pragma unroll
            for (int n = 0; n < 36; ++n) acc[n] += hn * wr[n]; }
#pragma unroll
        for (int n = 0; n < 36; ++n) {
#pragma unroll
            for (int o = 1; o < 32; o <<= 1) acc[n] += shflx(acc[n], o); }
        if (part == 0) {
            int gs = 0; float gm = acc[0];
#pragma unroll
            for (int g = 1; g < 4; ++g) if (acc[g] > gm) { gm = acc[g]; gs = g; }
            float den = 0.f;
#pragma unroll
            for (int g = 0; g < 4; ++g) den += fexp2((acc[g] - gm) * LOG2E);
            const float ggate = 1.0f / den;
            float el[8];
#pragma unroll
            for (int j = 0; j < 8; ++j) { el[j] = acc[4 + j];
#pragma unroll
                for (int g = 1; g < 4; ++g) if (gs == g) el[j] = acc[4 + 8 * g + j]; }
            int ia = 0; float va = el[0];
#pragma unroll
            for (int j = 1; j < 8; ++j) if (el[j] > va) { va = el[j]; ia = j; }
            int ib = -1; float vb = -3e38f;
#pragma unroll
            for (int j = 0; j < 8; ++j) if (j != ia && el[j] > vb) { vb = el[j]; ib = j; }
            const float wa = 1.0f / (1.0f + fexp2((vb - va) * LOG2E)), wb = 1.0f - wa;
            const int e0 = gs * 8 + ia, e1 = gs * 8 + ib;
            const int p0 = atomic_add_i(cnt + e0, 1), p1 = atomic_add_i(cnt + e1, 1);
            int* list = (int*)(ws + WS_LIST); list[(size_t)e0 * T + p0] = tok; list[(size_t)e1 * T + p1] = tok;
            int* tie = (int*)(ws + WS_TIE) + (size_t)tok * 2; float* tiw = (float*)(ws + WS_TIW) + (size_t)tok * 2;
            tie[0] = (e0 << 14) | p0; tie[1] = (e1 << 14) | p1; tiw[0] = ggate * wa; tiw[1] = ggate * wb;
        }
    }
}

DEV void inproj_phase(const Args& a, unsigned char* smem, int li) {
    constexpr int TN = NINP / 128, TM = T / 256;
    const bf16* A = (const bf16*)(wsp(a) + WS_H); const float* Bw = INP(a, I_WIN) + (size_t)li * DM * NIN;
    for (int it = BID; it < TN * TM; it += NBLK) { const int tm = it / TN, tn = it % TN;
        EpiInProj E{&a, tm * 256, tn * 128, li}; ARows af{A + (size_t)tm * 256 * DM, (size_t)DM}; BInProjMap bf{Bw, tn * 128};
        gemm_tile2(smem, af, bf, NIN, DM, E); }
}
DEV void resid_gemm_phase(const Args& a, unsigned char* smem, const bf16* A, int K, const float* Bw, int l) {
    constexpr int TN = DM / 128, TM = T / 256;
    const float* gate = (const float*)(wsp(a) + WS_MOD) + (size_t)l * 2 * 6 * DM + 2 * DM;
    for (int it = BID; it < TN * TM; it += NBLK) { const int tm = it / TN, tn = it % TN;
        EpiResid E{outp(a), gate, tm * 256, tn * 128}; ARows af{A + (size_t)tm * 256 * K, (size_t)K}; BPlain bf{Bw + tn * 128};
        gemm_tile2(smem, af, bf, DM, K, E); }
}
DEV void pw1_phase(const Args& a, unsigned char* smem, int li) {
    constexpr int TN = 2 * DM / 128, TM = T / 256;
    const bf16* A = (const bf16*)(wsp(a) + WS_H); const float* Bw = INP(a, I_PW1) + (size_t)li * DM * 2 * DM;
    for (int it = BID; it < TN * TM; it += NBLK) { const int tm = it / TN, tn = it % TN;
        EpiGated<0> E{(bf16*)(wsp(a) + WS_GLU), (size_t)DM, tm * 256, tn * 128, 256}; ARows af{A + (size_t)tm * 256 * DM, (size_t)DM}; BInter bf{Bw, Bw + DM, tn * 128};
        gemm_tile2(smem, af, bf, 2 * DM, DM, E); }
}
DEV void cmp_phase_items(const Args& a, unsigned char* smem, int li, int it) {
    constexpr int TMC = (NCP + 255) / 256;
    const int kv = it / (4 * TMC), bg = (it / TMC) % 4, tm = it % TMC;
    const bf16* src = (const bf16*)(wsp(a) + (kv ? WS_VCG : WS_KCG)) + (size_t)bg * SEQ * 64;
    struct AF { const bf16* s; int m0; MDEV const bf16* operator()(int r) const { int n = m0 + r; if (n > NCMP - 1) n = NCMP - 1; return s + (size_t)n * 1024; } } af{src, tm * 256};
    EpiCmp E{&a, kv, bg, tm * 256, li};
    BClamp64 bf{INP(a, kv ? I_CWV : I_CWK) + (size_t)li * 2048 * 64};
    gemm_tile2(smem, af, bf, 64, 2048, E);
}
DEV void moe_gemm_phase(const Args& a, unsigned char* smem, int l, int mode) {
    unsigned char* ws = wsp(a); const int* cnt = (const int*)(ws + WS_CNT) + l * 32;
    int* rb = (int*)(smem + GEMM2_LDS);
    moe_bases(cnt, rb);
    const int ntile = rb[32] >> 8;
    constexpr int TN1 = 2 * FF / 128, TN2 = DM / 128;
    const int TN = mode == 0 ? TN1 : TN2;
    const int* list = (const int*)(ws + WS_LIST);
    for (int it = BID; it < ntile * TN; it += NBLK) {
        const int rt = it / TN, tn = it % TN; int e = 0;
#pragma unroll 1
        for (int q = 1; q < 32; ++q) if ((rb[q] >> 8) <= rt) e = q;
        const int rloc = (rt << 8) - rb[e], nvalid = (cnt[e] - rloc) < 256 ? (cnt[e] - rloc) : 256;
        if (mode == 0) {
            struct AF { const bf16* hb; const int* lst; int nv; MDEV const bf16* operator()(int r) const { const int rr = r < nv ? r : nv - 1; return hb + (size_t)lst[rr] * DM; } }
                af{(const bf16*)(ws + WS_H), list + (size_t)e * T + rloc, nvalid};
            EpiGated<1> E{(bf16*)(ws + WS_ACT), (size_t)FF, rt << 8, tn * 128, nvalid};
            BInter bf{INP(a, I_W1) + (size_t)(l * 32 + e) * DM * FF, INP(a, I_W3) + (size_t)(l * 32 + e) * DM * FF, tn * 128};
            gemm_tile2(smem, af, bf, FF, DM, E);
        } else {
            ARows af{(const bf16*)(ws + WS_ACT) + (size_t)(rt << 8) * FF, (size_t)FF};
            EpiStoreBf E{(bf16*)(ws + WS_YK), (size_t)DM, rt << 8, tn * 128, nvalid};
            BPlain bf{INP(a, I_W2) + (size_t)(l * 32 + e) * FF * DM + tn * 128};
            gemm_tile2(smem, af, bf, DM, FF, E);
        }
    }
}

constexpr int AT_K = 0, AT_V = 2 * 64 * LDT * 2, AT_IMP = 2 * AT_V, AT_SEL = AT_IMP + 8 * 4 * 128 * 4, AT_END = AT_SEL + 8 * 4 * 4 * 4;

template <int MASK, bool WITH_PV>
DEV void attn_block(const bf16* Kp, const bf16* Vp, const bf16x8 (&qf)[2], int j, int s, bool selbit, float C2, int h, int c,
                    f32x4 (&O)[4], float& lsum, f32x4 (&pout)[2][2]) {
    f32x4 st[2][2];
#pragma unroll
    for (int sp = 0; sp < 2; ++sp)
#pragma unroll
        for (int u = 0; u < 2; ++u) { st[sp][u] = f4zero(); const int krow = 32 * sp + 8 * (c >> 2) + 4 * u + (c & 3);
#pragma unroll
            for (int ks = 0; ks < 2; ++ks) st[sp][u] = mfma16(*(const bf16x8*)(Kp + krow * LDT + 32 * ks + 8 * h), qf[ks], st[sp][u]); }
#pragma unroll
    for (int sp = 0; sp < 2; ++sp)
#pragma unroll
        for (int u = 0; u < 2; ++u)
#pragma unroll
            for (int r = 0; r < 4; ++r) { const int key = 64 * j + 32 * sp + 8 * h + 4 * u + r; bool ok;
                if (MASK == 0) ok = 16 * key + 31 <= s; else if (MASK == 1) ok = selbit && key <= s; else ok = key <= s && key > s - 512;
                const float p = ok ? fexp2(st[sp][u][r] * LOG2E - C2) : 0.f; lsum += p; pout[sp][u][r] = p; }
    if (WITH_PV) {
        bf16x8 pb[2];
#pragma unroll
        for (int sp = 0; sp < 2; ++sp) pb[sp] = pack8(pout[sp][0], pout[sp][1]);
#pragma unroll
        for (int et = 0; et < 4; ++et)
#pragma unroll
            for (int sp = 0; sp < 2; ++sp) O[et] = mfma16(*(const bf16x8*)(Vp + (16 * et + c) * LDT + 32 * sp + 8 * h), pb[sp], O[et]);
    }
}

struct ImpState { float invl; float carry; float* imps; int tl, hd, l; };
template <int MODE>
DEV void attn_branch(bf16* Kl, bf16* Vl, const bf16* kbase, int kstride, const bf16* vbase, int vstride, int jlo, int jhi,
                     const bf16x8 (&qf)[2], int s, const unsigned (&mysel)[4], const unsigned (&wsel)[4], float C2, int h, int c, int srow, int scol,
                     f32x4 (&O)[4], float& lsum, ImpState& im) {
    constexpr bool PV = MODE != 1; constexpr int MASK = MODE <= 1 ? 0 : MODE - 1;
    bf16x8 rk[3], rv[3]; f32x4 pt[2][2];
    { const bf16x8 k0 = *(const bf16x8*)(kbase + (size_t)jlo * kstride); *(bf16x8*)(Kl + srow * LDT + scol) = k0;
      if (PV) { const bf16x8 v0 = *(const bf16x8*)(vbase + (size_t)jlo * vstride); *(bf16x8*)(Vl + srow * LDT + scol) = v0; } }
#pragma unroll
    for (int u = 0; u < 3; ++u) { int jj = jlo + 1 + u; if (jj > jhi) jj = jhi; rk[(1 + u) % 3] = *(const bf16x8*)(kbase + (size_t)jj * kstride); if (PV) rv[(1 + u) % 3] = *(const bf16x8*)(vbase + (size_t)jj * vstride); }
    SYNC();
    for (int jb = jlo; jb <= jhi; jb += 3) {
#pragma unroll
        for (int u = 0; u < 3; ++u) { const int j = jb + u;
            if (j <= jhi) {
                const int cur = (j - jlo) & 1;
                bool need = true, sb = true;
                if (MODE == 2) { unsigned wq = 0, mq = 0;
#pragma unroll
                    for (int q = 0; q < 4; ++q) if ((j >> 5) == q) { wq = wsel[q]; mq = mysel[q]; }
                    need = (wq >> (j & 31)) & 1u; sb = (mq >> (j & 31)) & 1u; }
                if (need) attn_block<MASK, PV>(Kl + cur * 64 * LDT, Vl + cur * 64 * LDT, qf, j, s, sb, C2, h, c, O, lsum, pt);
                if (MODE == 1) {
#pragma unroll
                    for (int sp = 0; sp < 2; ++sp)
#pragma unroll
                        for (int uu = 0; uu < 2; ++uu)
#pragma unroll
                            for (int r = 0; r < 4; ++r) { float p = pt[sp][uu][r] * im.invl; p += shflx(p, 1); p += shflx(p, 2); pt[sp][uu][r] = p; }
                    const float r0 = shfl(pt[0][1][3], (im.l - 16) & 63), r1 = shfl(pt[1][1][3], (im.l - 16) & 63);
#pragma unroll
                    for (int sp = 0; sp < 2; ++sp)
#pragma unroll
                        for (int uu = 0; uu < 2; ++uu) { const int m = 16 * j + 8 * sp + 2 * h + uu;
                            float prev; if (uu == 1) prev = pt[sp][0][3]; else if (h > 0) prev = sp == 0 ? r0 : r1; else prev = sp == 0 ? im.carry : r0;
                            const float val = 2.0f * (pt[sp][uu][0] + pt[sp][uu][1] + pt[sp][uu][2]) + pt[sp][uu][3] + prev;
                            if (im.hd == 0 && m < 128) im.imps[im.tl * 128 + m] = val; }
                    im.carry = r1;
                }
                if (j + 1 <= jhi) {
                    *(bf16x8*)(Kl + (cur ^ 1) * 64 * LDT + srow * LDT + scol) = rk[(u + 1) % 3]; if (PV) *(bf16x8*)(Vl + (cur ^ 1) * 64 * LDT + srow * LDT + scol) = rv[(u + 1) % 3];
                    int jj = j + 4; if (jj > jhi) jj = jhi;
                    rk[(u + 1) % 3] = *(const bf16x8*)(kbase + (size_t)jj * kstride); if (PV) rv[(u + 1) % 3] = *(const bf16x8*)(vbase + (size_t)jj * vstride);
                }
                SYNC();
            }
        }
    }
}

DEV void attn_task(const Args& a, unsigned char* smem, int li, int item) {
    unsigned char* ws = wsp(a); const int tid = TID, w = tid >> 6, l = tid & 63, h = l >> 4, c = l & 15, tl = c >> 2, hd = c & 3;
    const int bg = item & 3, b = bg >> 1, g = bg & 1, tq = (SEQ / 32 - 1) - (item >> 2), s0 = tq * 32, qblk = s0 >> 6;
    const int s = s0 + 4 * w + tl, row = b * SEQ + s;
    bf16* Kl = (bf16*)(smem + AT_K); bf16* Vl = (bf16*)(smem + AT_V); float* imps = (float*)(smem + AT_IMP) + w * 512; unsigned* selm = (unsigned*)(smem + AT_SEL) + w * 16;
    bf16x8 qf[2];
    { const bf16* qp = (const bf16*)(ws + WS_QN) + (size_t)row * 512 + (g * 4 + hd) * 64 + 8 * h; qf[0] = *(const bf16x8*)qp; qf[1] = *(const bf16x8*)(qp + 32); }
    const float* gp = (const float*)(ws + WS_GATE) + (size_t)row * 24 + (g * 4 + hd) * 3;
    const float gatec = gp[0], gates = gp[1], gatew = gp[2];
    const float* cs = (const float*)(ws + WS_CS) + li * 4;
    f32x4 outv[4];
#pragma unroll
    for (int et = 0; et < 4; ++et) outv[et] = f4zero();
    const int srow = tid >> 3, scol = (tid & 7) * 8;
    for (int i = l; i < 512; i += 64) imps[i] = 0.f;
    SYNC();
    unsigned mysel[4] = {0u, 0u, 0u, 0u}, wsel[4] = {0u, 0u, 0u, 0u};
    ImpState im{0.f, 0.f, imps, tl, hd, l};
    {
        const int ncv = s0 / 16 + 1, ncb = (ncv + 63) >> 6;
        const bf16* kcb = (const bf16*)(ws + WS_KC) + (size_t)bg * NCP * 64 + srow * 64 + scol;
        const bf16* vcb = (const bf16*)(ws + WS_VCT) + (size_t)bg * 64 * NCP + (size_t)srow * NCP + scol;
        f32x4 O[4]; float lsum = 0.f;
#pragma unroll
        for (int et = 0; et < 4; ++et) O[et] = f4zero();
        attn_branch<0>(Kl, Vl, kcb, 4096, vcb, 64, 0, ncb - 1, qf, s, mysel, wsel, cs[0], h, c, srow, scol, O, lsum, im);
        lsum += shflx(lsum, 16); lsum += shflx(lsum, 32);
        im.invl = lsum > 0.f ? 1.0f / lsum : 0.f;
#pragma unroll
        for (int et = 0; et < 4; ++et)
#pragma unroll
            for (int r = 0; r < 4; ++r) outv[et][r] += gatec * im.invl * O[et][r];
        float ld = 0.f;
        attn_branch<1>(Kl, Vl, kcb, 4096, vcb, 64, 0, ncb - 1, qf, s, mysel, wsel, cs[0], h, c, srow, scol, O, ld, im);
    }
    {
        WSYNC();
        const int tk = l >> 4, i = l & 15; float vals[8];
#pragma unroll
        for (int mm = 0; mm < 8; ++mm) { const int jj = i + 16 * mm; vals[mm] = jj > qblk ? NEGV : ((jj == 0 || jj == qblk || jj == qblk - 1) ? FORCEV : imps[tk * 128 + jj]); }
        unsigned mk[4] = {0u, 0u, 0u, 0u};
#pragma unroll 1
        for (int rnd = 0; rnd < 16; ++rnd) {
            float best = vals[0]; int bj = i;
#pragma unroll
            for (int mm = 1; mm < 8; ++mm) if (vals[mm] > best) { best = vals[mm]; bj = i + 16 * mm; }
#pragma unroll
            for (int o = 1; o < 16; o <<= 1) { const float ov = shflx(best, o); const int oj = shflxi(bj, o); if (ov > best || (ov == best && oj < bj)) { best = ov; bj = oj; } }
            if (best > NEGV * 0.5f) {
#pragma unroll
                for (int q = 0; q < 4; ++q) if ((bj >> 5) == q) mk[q] |= 1u << (bj & 31); }
            if ((bj & 15) == i) {
#pragma unroll
                for (int mm = 0; mm < 8; ++mm) if ((bj >> 4) == mm) vals[mm] = -3e38f; }
        }
        if (i == 0) {
#pragma unroll
            for (int q = 0; q < 4; ++q) selm[tk * 4 + q] = mk[q]; }
        WSYNC();
#pragma unroll
        for (int q = 0; q < 4; ++q) { mysel[q] = selm[tl * 4 + q]; wsel[q] = selm[q] | selm[4 + q] | selm[8 + q] | selm[12 + q]; }
    }
    {
        const bf16* kb = (const bf16*)(ws + WS_KS) + (size_t)bg * SEQ * 64 + tid * 8; const bf16* vb = (const bf16*)(ws + WS_VST) + (size_t)bg * NCH * 4096 + tid * 8;
        f32x4 O[4]; float lsum = 0.f;
#pragma unroll
        for (int et = 0; et < 4; ++et) O[et] = f4zero();
        attn_branch<2>(Kl, Vl, kb, 4096, vb, 4096, 0, qblk, qf, s, mysel, wsel, cs[1], h, c, srow, scol, O, lsum, im);
        lsum += shflx(lsum, 16); lsum += shflx(lsum, 32);
        const float sc = gates * (lsum > 0.f ? 1.0f / lsum : 0.f);
#pragma unroll
        for (int et = 0; et < 4; ++et)
#pragma unroll
            for (int r = 0; r < 4; ++r) outv[et][r] += sc * O[et][r];
    }
    {
        const bf16* kb = (const bf16*)(ws + WS_KW) + (size_t)bg * SEQ * 64 + tid * 8; const bf16* vb = (const bf16*)(ws + WS_VWT) + (size_t)bg * NCH * 4096 + tid * 8;
        f32x4 O[4]; float lsum = 0.f;
#pragma unroll
        for (int et = 0; et < 4; ++et) O[et] = f4zero();
        attn_branch<3>(Kl, Vl, kb, 4096, vb, 4096, s0 >= 511 ? (s0 - 511) >> 6 : 0, qblk, qf, s, mysel, wsel, cs[2], h, c, srow, scol, O, lsum, im);
        lsum += shflx(lsum, 16); lsum += shflx(lsum, 32);
        const float sc = gatew * (lsum > 0.f ? 1.0f / lsum : 0.f);
#pragma unroll
        for (int et = 0; et < 4; ++et)
#pragma unroll
            for (int r = 0; r < 4; ++r) outv[et][r] += sc * O[et][r];
    }
    bf16* dst = (bf16*)(ws + WS_CAT) + (size_t)row * 1024 + (g * 4 + hd) * 64 + 4 * h;
#pragma unroll
    for (int et = 0; et < 4; ++et) st_bf4(dst + 16 * et, outv[et]);
}

constexpr int LDH = 136;
DEV void hg_cumsum(const float* fsrc  , float* segs  , int d, int seg, float (&f)[16], float (&bc)[16], float& bend, float& bmid) {
    float run = 0.f;
#pragma unroll
    for (int i = 0; i < 16; ++i) { f[i] = fsrc[(size_t)(16 * seg + i) * 128 + d]; run += log2f(f[i]); bc[i] = run; }
    SYNC();
    segs[seg * 128 + d] = run;
    SYNC();
    const float s0 = segs[d], s1 = segs[128 + d], s2 = segs[256 + d], s3 = segs[384 + d];
    const float off = seg == 0 ? 0.f : (seg == 1 ? s0 : (seg == 2 ? s0 + s1 : s0 + s1 + s2));
#pragma unroll
    for (int i = 0; i < 16; ++i) bc[i] += off;
    bend = s0 + s1 + s2 + s3; bmid = s0 + s1;
}
DEV void hg_write16(bf16* dstrow  , const float (&v)[16]) {
    u32x4 w0, w1;
#pragma unroll
    for (int q = 0; q < 4; ++q) { w0[q] = pk2(v[2 * q], v[2 * q + 1]); w1[q] = pk2(v[8 + 2 * q], v[8 + 2 * q + 1]); }
    *(u32x4*)dstrow = w0; *(u32x4*)(dstrow + 8) = w1;
}
DEV void hg_h1_task(const Args& a, unsigned char* smem, int task) {
    unsigned char* ws = wsp(a); const int tid = TID, w = tid >> 6, l = tid & 63, h = l >> 4, c = l & 15, d = tid & 127, seg = tid >> 7;
    const int bh = task / NCH, ch = task % NCH;
    bf16* kT = (bf16*)smem; bf16* vT = kT + 128 * LDT; float* segs = (float*)(vT + 128 * LDT);
    const size_t tokb = (size_t)bh * SEQ + ch * 64;
    float f[16], bc[16], bend, bmid;
    hg_cumsum((const float*)(ws + WS_HF) + tokb * 128, segs, d, seg, f, bc, bend, bmid);
    float kv[16];
#pragma unroll
    for (int i = 0; i < 16; ++i) kv[i] = (1.0f - f[i]) * fexp2(bend - bc[i]);
    hg_write16(kT + d * LDT + 16 * seg, kv);
    const bf16* vs = (const bf16*)(ws + WS_HV) + tokb * 128;
#pragma unroll
    for (int i = 0; i < 16; ++i) kv[i] = bf2f(vs[(size_t)(16 * seg + i) * 128 + d]);
    hg_write16(vT + d * LDT + 16 * seg, kv);
    if (seg == 0) ((float*)(ws + WS_GD))[((size_t)bh * NCH + ch) * 128 + d] = fexp2(bend);
    SYNC();
    f32x4 acc[8];
#pragma unroll
    for (int et = 0; et < 8; ++et) acc[et] = f4zero();
#pragma unroll
    for (int ks = 0; ks < 2; ++ks) { const bf16x8 fa = *(const bf16x8*)(kT + (16 * w + c) * LDT + 32 * ks + 8 * h);
#pragma unroll
        for (int et = 0; et < 8; ++et) acc[et] = mfma16(fa, *(const bf16x8*)(vT + (16 * et + c) * LDT + 32 * ks + 8 * h), acc[et]); }
    float* ut = (float*)(ws + WS_UT) + ((size_t)bh * NCH + ch) * 16384;
#pragma unroll
    for (int et = 0; et < 8; ++et) *(f32x4*)(ut + (size_t)(16 * et + c) * 128 + 16 * w + 4 * h) = acc[et];
    SYNC();
}
DEV void hg_scan_task(const Args& a, int sc) {
    unsigned char* ws = wsp(a); const int bh = sc >> 3, q = (sc & 7) * 512 + TID, e = q >> 5, d0 = (q & 31) * 4;
    const float* ut = (const float*)(ws + WS_UT) + (size_t)bh * NCH * 16384 + (size_t)e * 128 + d0;
    const float* gd = (const float*)(ws + WS_GD) + (size_t)bh * NCH * 128 + d0;
    bf16* st = (bf16*)(ws + WS_ST) + (size_t)bh * NCH * 16384 + (size_t)e * 128 + d0;
    f32x4 S = f4zero();
#pragma unroll 4
    for (int ch = 0; ch < NCH; ++ch) { st_bf4(st + (size_t)ch * 16384, S);
        const f32x4 g = *(const f32x4*)(gd + (size_t)ch * 128), u = *(const f32x4*)(ut + (size_t)ch * 16384);
#pragma unroll
        for (int r = 0; r < 4; ++r) S[r] = g[r] * S[r] + u[r]; }
}
DEV void hg_h3_task(const Args& a, unsigned char* smem, int li, int task) {
    unsigned char* ws = wsp(a); const int tid = TID, w = tid >> 6, l = tid & 63, h = l >> 4, c = l & 15, d = tid & 127, seg = tid >> 7;
    const int bh = task / NCH, ch = task % NCH, b = bh >> 2, hh = bh & 3;
    bf16* At = (bf16*)smem; bf16* Bt = At + 64 * LDH; bf16* Qt = Bt + 64 * LDH; bf16* vT = Qt + 64 * LDH; float* segs = (float*)(vT + 128 * LDT); float* part = segs + 512;
    const size_t tokb = (size_t)bh * SEQ + ch * 64;
    float f[16], bc[16], bend, bmid;
    hg_cumsum((const float*)(ws + WS_HF) + tokb * 128, segs, d, seg, f, bc, bend, bmid);
    const bf16* qs = (const bf16*)(ws + WS_HQ) + tokb * 128; const bf16* vs = (const bf16*)(ws + WS_HV) + tokb * 128;
    float vv[16];
#pragma unroll
    for (int i = 0; i < 16; ++i) { const int t = 16 * seg + i; const float q = bf2f(qs[(size_t)t * 128 + d]);
        At[t * LDH + d] = (bf16)f2bf(q * fexp2(bc[i] - bmid)); Bt[t * LDH + d] = (bf16)f2bf((1.0f - f[i]) * fexp2(bmid - bc[i])); Qt[t * LDH + d] = (bf16)f2bf(q * fexp2(bc[i]));
        vv[i] = bf2f(vs[(size_t)t * 128 + d]); }
    hg_write16(vT + d * LDT + 16 * seg, vv);
    SYNC();
    const int tt = w & 3, eh = w >> 2;
    f32x4 O[4];
#pragma unroll
    for (int et = 0; et < 4; ++et) O[et] = f4zero();
#pragma unroll
    for (int sp = 0; sp < 2; ++sp) {
        if (32 * sp > 16 * tt + 15) continue;
        f32x4 st[2];
#pragma unroll
        for (int u = 0; u < 2; ++u) { st[u] = f4zero(); const int krow = 32 * sp + 8 * (c >> 2) + 4 * u + (c & 3);
#pragma unroll
            for (int ks = 0; ks < 4; ++ks) st[u] = mfma16(*(const bf16x8*)(Bt + krow * LDH + 32 * ks + 8 * h), *(const bf16x8*)(At + (16 * tt + c) * LDH + 32 * ks + 8 * h), st[u]);
#pragma unroll
            for (int r = 0; r < 4; ++r) { const int sk = 32 * sp + 8 * h + 4 * u + r; if (sk > 16 * tt + c) st[u][r] = 0.f; } }
        const bf16x8 pb = pack8(st[0], st[1]);
#pragma unroll
        for (int et = 0; et < 4; ++et) O[et] = mfma16(*(const bf16x8*)(vT + (64 * eh + 16 * et + c) * LDT + 32 * sp + 8 * h), pb, O[et]);
    }
    const bf16* stp = (const bf16*)(ws + WS_ST) + ((size_t)bh * NCH + ch) * 16384;
#pragma unroll
    for (int ks = 0; ks < 4; ++ks) { const bf16x8 fq = *(const bf16x8*)(Qt + (16 * tt + c) * LDH + 32 * ks + 8 * h);
#pragma unroll
        for (int et = 0; et < 4; ++et) O[et] = mfma16(*(const bf16x8*)(stp + (size_t)(64 * eh + 16 * et + c) * 128 + 32 * ks + 8 * h), fq, O[et]); }
    float ss = 0.f;
#pragma unroll
    for (int et = 0; et < 4; ++et)
#pragma unroll
        for (int r = 0; r < 4; ++r) ss += O[et][r] * O[et][r];
    ss += shflx(ss, 16); ss += shflx(ss, 32);
    if (h == 0) part[eh * 64 + 16 * tt + c] = ss;
    SYNC();
    const float rs = frsq((part[16 * tt + c] + part[64 + 16 * tt + c]) * (1.0f / 128.0f) + EPS);
    const int tok = b * SEQ + ch * 64 + 16 * tt + c;
    const float* og = INP(a, I_OG) + li * 128; const bf16* hg = (const bf16*)(ws + WS_HGS) + (size_t)tok * 512 + hh * 128;
    bf16* dst = (bf16*)(ws + WS_CAT) + (size_t)tok * 1024 + 512 + hh * 128;
#pragma unroll
    for (int et = 0; et < 4; ++et) { const int e = 64 * eh + 16 * et + 4 * h; f32x4 o;
#pragma unroll
        for (int r = 0; r < 4; ++r) o[r] = O[et][r] * rs * og[e + r] * bf2f(hg[e + r]);
        st_bf4(dst + e, o); }
    SYNC();
}

DEV void conv_task(const Args& a, unsigned char* smem, int li, int task) {
    unsigned char* ws = wsp(a); const int tid = TID, w = tid >> 6, lane = tid & 63;
    const bool act = tid < DM / 2; const int c0 = act ? 2 * tid : 0;
    const int t0 = task * 16, b = t0 / SEQ, s0 = t0 % SEQ;
    float* red = (float*)smem;
    const float* dw = INP(a, I_DW) + (size_t)li * 31 * DM + c0;
    float acc[16][2];
    const float b0 = INP(a, I_DWB)[li * DM + c0], b1 = INP(a, I_DWB)[li * DM + c0 + 1];
#pragma unroll
    for (int t = 0; t < 16; ++t) { acc[t][0] = b0; acc[t][1] = b1; }
    const bf16* glu = (const bf16*)(ws + WS_GLU) + (size_t)b * SEQ * DM + c0;
    unsigned uu[46];
    { const bf16* gp = glu + (size_t)(s0 - 30) * DM;
#pragma unroll
    for (int r = 0; r < 46; ++r) { const int si = s0 + r - 30; uu[r] = si >= 0 ? *(const unsigned*)gp : 0u; gp += DM; OPAQUE(gp); } }
    const float* dwp = dw;
#pragma unroll
    for (int j = 0; j < 31; ++j) { const float w0 = dwp[0], w1 = dwp[1]; dwp += DM; OPAQUE(dwp);
#pragma unroll
        for (int t = 0; t < 16; ++t) { const unsigned q = uu[t + j]; acc[t][0] += w0 * bf2f(q & 0xffff); acc[t][1] += w1 * bf2f(q >> 16); } }
    float mean[16], rstd[16];
    SYNC();
#pragma unroll
    for (int t = 0; t < 16; ++t) { float s = act ? acc[t][0] + acc[t][1] : 0.f;
#pragma unroll
        for (int o = 1; o < 64; o <<= 1) s += shflx(s, o);
        if (lane == 0) red[w * 16 + t] = s; }
    SYNC();
#pragma unroll
    for (int t = 0; t < 16; ++t) { float s = 0.f;
#pragma unroll
        for (int q = 0; q < 8; ++q) s += red[q * 16 + t];
        mean[t] = s * (1.0f / DM); }
    SYNC();
#pragma unroll
    for (int t = 0; t < 16; ++t) { const float d0 = acc[t][0] - mean[t], d1 = acc[t][1] - mean[t]; float s = act ? d0 * d0 + d1 * d1 : 0.f;
#pragma unroll
        for (int o = 1; o < 64; o <<= 1) s += shflx(s, o);
        if (lane == 0) red[w * 16 + t] = s; }
    SYNC();
#pragma unroll
    for (int t = 0; t < 16; ++t) { float s = 0.f;
#pragma unroll
        for (int q = 0; q < 8; ++q) s += red[q * 16 + t];
        rstd[t] = frsq(s * (1.0f / DM) + EPS); }
    if (act) {
        const float g0 = INP(a, I_LNG)[li * DM + c0], g1 = INP(a, I_LNG)[li * DM + c0 + 1], e0 = INP(a, I_LNB)[li * DM + c0], e1 = INP(a, I_LNB)[li * DM + c0 + 1];
        bf16* dst = (bf16*)(ws + WS_CAT) + (size_t)t0 * DM + c0;
#pragma unroll
        for (int t = 0; t < 16; ++t) { const float y0 = (acc[t][0] - mean[t]) * rstd[t] * g0 + e0, y1 = (acc[t][1] - mean[t]) * rstd[t] * g1 + e1;
            *(unsigned*)(dst + (size_t)t * DM) = pk2(siluf(y0), siluf(y1)); }
    }
}

constexpr int N_PHASES = 1 + 16 * (DEPTH / 2) + 1;
DEV void phase_decode(int ph, int& l, int& sub) {
    const int q = ph - 1, pair = q >> 4, r = q & 15;
    if (r < 9) { l = 2 * pair; sub = r; } else { l = 2 * pair + 1; const int rr = r - 9; sub = rr < 3 ? rr : rr + 2; }
}
constexpr int LDS_BYTES = 150 * 1024;

DEV void run_phase(const Args& a, unsigned char* smem, int ph) {
#ifndef ONLY
#define ONLY -1
#endif
#define EN(k) (ONLY < 0 || ONLY == (k))
    if (ph == 0) { if (EN(100)) p0_phase(a, smem); return; }
    if (ph == N_PHASES - 1) { if (EN(0)) norm_phase(a, smem, DEPTH); return; }
    int l, sub; phase_decode(ph, l, sub); const int li = l >> 1; const bool even = (l & 1) == 0;
    unsigned char* ws = wsp(a);
    switch (sub) {
    case 0: if (EN(0)) norm_phase(a, smem, l); break;
    case 1: if (even) { if (EN(1)) inproj_phase(a, smem, li); } else { if (EN(11)) pw1_phase(a, smem, li); } break;
    case 2:
        if (even) { constexpr int NCI = 8 * ((NCP + 255) / 256); constexpr int NH1 = 8 * NCH;
            for (int it = BID; it < NCI + NH1; it += NBLK) { if (it < NCI) { if (EN(2)) cmp_phase_items(a, smem, li, it); } else { if (EN(12)) hg_h1_task(a, smem, it - NCI); } } }
        else { for (int it = BID; it < T / 16; it += NBLK) if (EN(13)) conv_task(a, smem, li, it); }
        break;
    case 3:
        if (even) { constexpr int NA = 4 * (SEQ / 32); const int G = NBLK;
            for (int r = 0; r * G < NA; ++r) { const int it = r * G + ((r & 1) ? (G - 1 - BID) : BID); if (it < NA) { if (EN(3)) attn_task(a, smem, li, it); } }
            for (int it = BID; it < 64; it += NBLK) if (EN(14)) hg_scan_task(a, it); }
        break;
    case 4: if (even) { for (int it = BID; it < 8 * NCH; it += NBLK) if (EN(4)) hg_h3_task(a, smem, li, it); } break;
    case 5:
        if (!EN(5)) break;
        if (even) resid_gemm_phase(a, smem, (const bf16*)(ws + WS_CAT), 1024, INP(a, I_WOUT) + (size_t)li * 1024 * DM, l);
        else resid_gemm_phase(a, smem, (const bf16*)(ws + WS_CAT), DM, INP(a, I_PW2) + (size_t)li * DM * DM, l);
        break;
    case 6: if (EN(6)) route_phase(a, smem, l); break;
    case 7: if (EN(7)) moe_gemm_phase(a, smem, l, 0); break;
    case 8: if (EN(8)) moe_gemm_phase(a, smem, l, 1); break;
    }
}

#ifndef EMU
#define LAS __attribute__((address_space(3)))
#define XB_TMO      128
#define XB_XCNT(j)  (256  + 64 * (j))
#define XB_XSUB(j)  (1280 + 64 * (j))
#define XB_XGEN(j)  (2304 + 64 * (j))
#define XB_TOP      3328
#define XB_TOPGEN   3392
#define XCD_BAR_WORDS 3456
#define XB_SPIN_CAP (1u << 22)
__device__ __forceinline__ unsigned xb_ld(unsigned* p)              { return __hip_atomic_load(p, __ATOMIC_RELAXED, __HIP_MEMORY_SCOPE_AGENT); }
__device__ __forceinline__ unsigned xb_add(unsigned* p, unsigned v) { return __hip_atomic_fetch_add(p, v, __ATOMIC_RELAXED, __HIP_MEMORY_SCOPE_AGENT); }
__device__ __forceinline__ unsigned xb_xcc_id() { return (unsigned)__builtin_amdgcn_s_getreg((3 << 11) | 20) & 0xFu; }
#define XB_SPIN(cond, bar) do { unsigned _sp = 0; while (cond) { __builtin_amdgcn_s_sleep(1); \
    if ((++_sp & 255u) == 0u) { if (xb_ld(&(bar)[XB_TMO])) break; if (_sp > XB_SPIN_CAP) { atomicAdd(&(bar)[XB_TMO], 1u); break; } } } } while (0)
struct XcdBarrier { unsigned* bar; unsigned x; volatile LAS unsigned* st; };
__device__ __forceinline__ XcdBarrier xcd_barrier_post(unsigned* bar, volatile LAS unsigned* st) {
    XcdBarrier b; b.bar = bar; b.x = xb_xcc_id(); b.st = st;
    if (threadIdx.x == 0) (void)xb_add(&bar[XB_XCNT(b.x)], 1u);
    return b;
}
__device__ __forceinline__ void xcd_barrier_complete(unsigned* bar, unsigned x, unsigned& nloc, unsigned& nx) {
    const unsigned G = gridDim.x * gridDim.y * gridDim.z;
    unsigned sum, cnt, mine, sp = 0u;
    for (;;) {
        sum = 0u; cnt = 0u; mine = 0u;
#pragma unroll
        for (unsigned j = 0; j < 16; ++j) { const unsigned c = xb_ld(&bar[XB_XCNT(j)]); sum += c; cnt += (c > 0u) ? 1u : 0u; mine = (j == x) ? c : mine; }
        if (sum == G) break;
        __builtin_amdgcn_s_sleep(1);
        if ((++sp & 255u) == 0u) { if (xb_ld(&bar[XB_TMO])) break; if (sp > XB_SPIN_CAP) { atomicAdd(&bar[XB_TMO], 1u); break; } }
    }
    nloc = mine > 0u ? mine : 1u; nx = cnt > 0u ? cnt : 1u;
}
__device__ __forceinline__ void xcd_barrier(const XcdBarrier& b) {
    asm volatile("s_waitcnt vmcnt(0)" ::: "memory");
    __syncthreads();
    if (threadIdx.x == 0) {
        unsigned* bar = b.bar;
        __builtin_amdgcn_s_waitcnt(0);
        unsigned nloc = b.st[0], nx = b.st[1];
        if (nloc == 0u) { xcd_barrier_complete(bar, b.x, nloc, nx); b.st[0] = nloc; b.st[1] = nx; }
        const unsigned old = xb_add(&bar[XB_XSUB(b.x)], 1u);
        const unsigned gen = old / nloc;
        if (old + 1u == (gen + 1u) * nloc) {
            __builtin_amdgcn_fence(__ATOMIC_RELEASE, "agent");
            asm volatile("s_waitcnt vmcnt(0)" ::: "memory");
            const unsigned og = xb_add(&bar[XB_TOP], 1u);
            const unsigned tg = og / nx;
            if (og + 1u == (tg + 1u) * nx) xb_add(&bar[XB_TOPGEN], 1u);
            else XB_SPIN(xb_ld(&bar[XB_TOPGEN]) == tg, bar);
            __builtin_amdgcn_fence(__ATOMIC_ACQUIRE, "agent");
            xb_add(&bar[XB_XGEN(b.x)], 1u);
            asm volatile("s_waitcnt vmcnt(0)" ::: "memory");
        } else {
            XB_SPIN(xb_ld(&bar[XB_XGEN(b.x)]) == gen, bar);
            __builtin_amdgcn_fence(__ATOMIC_ACQUIRE, "agent");
            asm volatile("s_waitcnt vmcnt(0)" ::: "memory");
        }
    }
    __syncthreads();
}

__global__ void __launch_bounds__(NT, 2) mega(Args a) {
    extern __shared__ __attribute__((aligned(16))) unsigned char lds[];
    volatile LAS unsigned* st = (volatile LAS unsigned*)(LAS unsigned char*)(lds + LDS_BYTES - 16);
    if (threadIdx.x < 4) st[threadIdx.x] = 0u;
    __syncthreads();
    unsigned* barw = (unsigned*)(a.ws + WS_BAR);
    XcdBarrier bar = xcd_barrier_post(barw, st);
#pragma unroll 1
    for (int ph = 0; ph < N_PHASES; ++ph) {
        run_phase(a, lds, ph);
#ifdef DUP
        { int lyr = 0, sub = 100; if (ph > 0 && ph < N_PHASES - 1) phase_decode(ph, lyr, sub);
          if (sub == (DUP % 1000) && (ph == 0 || lyr == DUP / 1000) && ph < N_PHASES - 1) { xcd_barrier(bar); run_phase(a, lds, ph); } }
#endif
        if (ph + 1 < N_PHASES) xcd_barrier(bar);
    }
    if (xb_ld(&barw[XB_TMO]) != 0u) {
        const size_t gt = (size_t)blockIdx.x * NT + threadIdx.x, gs = (size_t)gridDim.x * NT;
        for (size_t i = gt; i < (size_t)T * DM; i += gs) a.out[i] = __builtin_nanf("");
    }
}

extern "C" void kernel_launch(void* const* d_in, const int* in_sizes, int n_in, void* d_out, int out_size,
                              void* d_ws, size_t ws_size, hipStream_t stream) {
    static int grid = 0;
    if (grid == 0) {
        int dev = 0, cus = 0;
        if (hipGetDevice(&dev) != hipSuccess || hipDeviceGetAttribute(&cus, hipDeviceAttributeMultiprocessorCount, dev) != hipSuccess) { grid = -1; return; }
        if (hipFuncSetAttribute((const void*)mega, hipFuncAttributeMaxDynamicSharedMemorySize, LDS_BYTES) != hipSuccess) { grid = -1; return; }
        (void)hipGetLastError();
        grid = cus;
        if (n_in != 26 || out_size != T * DM || ws_size < WS_END) { fprintf(stderr, "kernel_launch: unexpected sizes n_in %d out %d ws %zu (need %zu)\n", n_in, out_size, ws_size, (size_t)WS_END); grid = -1; return; }
    }
    if (grid < 0) return;
    (void)hipMemsetAsync((unsigned char*)d_ws + WS_BAR, 0, XCD_BAR_WORDS * 4, stream);
    Args a{};
    for (int i = 0; i < 26; ++i) a.in[i] = (const float*)d_in[i];
    a.out = (float*)d_out; a.ws = (unsigned char*)d_ws;
    hipLaunchKernelGGL(mega, dim3(grid), dim3(NT), LDS_BYTES, stream, a);
}
#endif
```

```cpp
#ifdef EMU
#include "emu.h"
#define DEV static inline
#define MDEV inline
#define OPAQUE(p)
#define TID emu_tid()
#define BID (EB->bid)
#define NBLK (EB->nblk)
#define SYNC() emu_sync_block()
#define WSYNC() emu_sync_wave()
#define mfma16(a, b, c) emu_mfma16(a, b, c)
DEV float shflx(float v, int m) { return emu_shfl_f(v, (emu_tid() & 63) ^ m); }
DEV int shflxi(int v, int m) { return (int)emu_shfl_u((unsigned)v, (emu_tid() & 63) ^ m); }
DEV float shfl(float v, int s) { return emu_shfl_f(v, s); }
DEV int atomic_add_i(int* p, int v) { return __atomic_fetch_add(p, v, __ATOMIC_RELAXED); }
DEV float fexp2(float x) { return exp2f(x); }
DEV float frcp(float x) { return 1.0f / x; }
DEV float frsq(float x) { return 1.0f / sqrtf(x); }
typedef short s16x4 __attribute__((vector_size(8)));
static inline s16x4 emu_tr4(const unsigned short* p) {
    EmuWave& w = EB->wave[emu_tid() >> 6]; int l = emu_tid() & 63;
    const unsigned short** tab = (const unsigned short**)w.a;
    tab[l] = p; emu_sync_wave();
    s16x4 r; int g = l & 48, i = l & 15;
    for (int q = 0; q < 4; ++q) r[q] = (short)tab[g + 4 * q + (i >> 2)][i & 3];
    emu_sync_wave(); return r;
}
#define tr4(p) emu_tr4(p)
#else
#include <hip/hip_runtime.h>
#include <cstdio>
#include <cstdint>
typedef short bf16x8 __attribute__((ext_vector_type(8)));
typedef float f32x4 __attribute__((ext_vector_type(4)));
typedef unsigned u32x4 __attribute__((ext_vector_type(4)));
typedef unsigned u32x2 __attribute__((ext_vector_type(2)));
#define DEV __device__ __forceinline__
#define MDEV __device__ __forceinline__
#define OPAQUE(p) asm volatile("" : "+v"(p))
DEV int tid_opaque() { int t = (int)threadIdx.x; asm volatile("" : "+v"(t)); return t; }
#define TID tid_opaque()
#define BID ((int)blockIdx.x)
#define NBLK ((int)gridDim.x)
#define SYNC() __syncthreads()
#define WSYNC() __builtin_amdgcn_wave_barrier()
#define mfma16(a, b, c) __builtin_amdgcn_mfma_f32_16x16x32_bf16(a, b, c, 0, 0, 0)
DEV float shflx(float v, int m) { return __shfl_xor(v, m); }
DEV int shflxi(int v, int m) { return __shfl_xor(v, m); }
DEV float shfl(float v, int s) { return __shfl(v, s); }
DEV int atomic_add_i(int* p, int v) { return atomicAdd(p, v); }
DEV float fexp2(float x) { return exp2f(x); }
DEV float frcp(float x) { return 1.0f / x; }
DEV float frsq(float x) { return rsqrtf(x); }
typedef short s16x4 __attribute__((ext_vector_type(4)));
#define tr4(p) __builtin_amdgcn_ds_read_tr16_b64_v4i16((__attribute__((address_space(3))) s16x4*)(p))
#endif

typedef unsigned short bf16;

#ifndef DM
#define DM 1024
#endif
#ifndef SEQ
#define SEQ 8192
#endif
#ifndef FF
#define FF 512
#endif
constexpr int NBATCH = 2, T = NBATCH * SEQ, DEPTH = 4;
constexpr int NIN = 3352, NINP = 3456;
constexpr int NT = 512;
constexpr int NCH = SEQ / 64;
constexpr int NCP = SEQ / 16;
constexpr int NCMP = NCP - 1;
constexpr int MOE_ROWS = 2 * T + 32 * 256;
constexpr float EPS = 1e-6f, NEGV = -1e30f, FORCEV = 1e4f, LOG2E = 1.4426950408889634f;

constexpr size_t al(size_t x) { return (x + 255) & ~(size_t)255; }
constexpr size_t WS_BAR = 0;
constexpr size_t WS_CNT = 16384;
constexpr size_t WS_MOD = WS_CNT + (size_t)DEPTH * 32 * 256;
constexpr size_t WS_LB = al(WS_MOD + (size_t)DEPTH * 2 * 6 * DM * 4);
constexpr size_t WS_CB = al(WS_LB + 2 * 512 * 4);
constexpr size_t WS_CS = al(WS_CB + 2 * 2 * 8 * 64 * 4);
constexpr size_t WS_WIN = al(WS_CS + 64);
constexpr size_t WS_WOUT = al(WS_WIN + (size_t)2 * NINP * DM * 2);
constexpr size_t WS_PW1 = al(WS_WOUT + (size_t)2 * DM * 1024 * 2);
constexpr size_t WS_PW2 = al(WS_PW1 + (size_t)2 * 2 * DM * DM * 2);
constexpr size_t WS_WC = al(WS_PW2 + (size_t)2 * DM * DM * 2);
constexpr size_t WS_W13 = al(WS_WC + (size_t)2 * 2 * 64 * 2048 * 2);
constexpr size_t WS_W2 = al(WS_W13 + (size_t)DEPTH * 32 * 2 * FF * DM * 2);
constexpr size_t WS_H = al(WS_W2 + (size_t)DEPTH * 32 * DM * FF * 2);
constexpr size_t WS_QN = al(WS_H + (size_t)T * DM * 2);
constexpr size_t WS_KCG = al(WS_QN + (size_t)T * 512 * 2);
constexpr size_t WS_VCG = al(WS_KCG + (size_t)T * 128 * 2);
constexpr size_t WS_KS = al(WS_VCG + (size_t)T * 128 * 2);
constexpr size_t WS_KW = al(WS_KS + (size_t)T * 128 * 2);
constexpr size_t WS_VST = al(WS_KW + (size_t)T * 128 * 2);
constexpr size_t WS_VWT = al(WS_VST + (size_t)T * 128 * 2);
constexpr size_t WS_KC = al(WS_VWT + (size_t)T * 128 * 2);
constexpr size_t WS_VCT = al(WS_KC + (size_t)4 * NCP * 64 * 2);
constexpr size_t WS_GATE = al(WS_VCT + (size_t)4 * NCP * 64 * 2);
constexpr size_t WS_HQ = al(WS_GATE + (size_t)T * 24 * 4);
constexpr size_t WS_HF = al(WS_HQ + (size_t)T * 512 * 2);
constexpr size_t WS_HV = al(WS_HF + (size_t)T * 512 * 4);
constexpr size_t WS_HGS = al(WS_HV + (size_t)T * 512 * 2);
constexpr size_t WS_UT = al(WS_HGS + (size_t)T * 512 * 2);
constexpr size_t WS_ST = al(WS_UT + (size_t)8 * NCH * 128 * 128 * 4);
constexpr size_t WS_GD = al(WS_ST + (size_t)8 * NCH * 128 * 128 * 2);
constexpr size_t WS_CAT = al(WS_GD + (size_t)8 * NCH * 128 * 4);
constexpr size_t WS_GLU = al(WS_CAT + (size_t)T * 1024 * 2);
constexpr size_t WS_TIE = al(WS_GLU + (size_t)T * DM * 2);
constexpr size_t WS_TIW = al(WS_TIE + (size_t)T * 2 * 4);
constexpr size_t WS_LIST = al(WS_TIW + (size_t)T * 2 * 4);
constexpr size_t WS_ACT = al(WS_LIST + (size_t)32 * T * 4);
constexpr size_t WS_YK = al(WS_ACT + (size_t)MOE_ROWS * FF * 2);
constexpr size_t WS_END = al(WS_YK + (size_t)MOE_ROWS * DM * 2);

struct Args { const float* in[26]; float* out; unsigned char* ws; };
enum { I_X = 0, I_C, I_ADAW, I_ADAB, I_NMIX, I_NFFN, I_WIN, I_WOUT, I_CWK, I_CWV, I_CPE, I_QG, I_KG, I_LBL, I_OG,
       I_PW1, I_DW, I_DWB, I_LNG, I_LNB, I_PW2, I_WG, I_WE, I_W1, I_W3, I_W2 };

#ifdef EMU
DEV unsigned char* wsp(const Args& a) { return a.ws; }
DEV float* outp(const Args& a) { return a.out; }
#else
DEV unsigned char* wsp(const Args& a) { int z = 0; asm volatile("" : "+s"(z)); return a.ws + z; }
DEV float* outp(const Args& a) { int z = 0; asm volatile("" : "+s"(z)); return a.out + z; }
#endif

#ifdef EMU
#define INP(a, X) ((a).in[X])
#else
DEV int zero_opaque() { int z = 0; asm volatile("" : "+s"(z)); return z; }
#define INP(a, X) ((a).in[(X) + zero_opaque()])
#endif

DEV unsigned f2bf(float f) { unsigned u = __builtin_bit_cast(unsigned, f); return (u + 0x7fffu + ((u >> 16) & 1u)) >> 16; }
DEV float bf2f(unsigned h) { return __builtin_bit_cast(float, h << 16); }
#ifdef EMU
DEV unsigned pk2(float lo, float hi) { return f2bf(lo) | (f2bf(hi) << 16); }
#else
typedef float f32x2_t __attribute__((ext_vector_type(2)));
typedef __bf16 bf16x2_t __attribute__((ext_vector_type(2)));
DEV unsigned pk2(float lo, float hi) { f32x2_t v = {lo, hi}; bf16x2_t b = __builtin_convertvector(v, bf16x2_t); return __builtin_bit_cast(unsigned, b); }
#endif
DEV float sigm(float x) { return frcp(1.0f + fexp2(-x * LOG2E)); }
DEV float siluf(float x) { return x * sigm(x); }
DEV f32x4 f4zero() { f32x4 z = {0.f, 0.f, 0.f, 0.f}; return z; }
DEV bf16x8 pack8(f32x4 a, f32x4 b) {
    u32x4 w; w[0] = pk2(a[0], a[1]); w[1] = pk2(a[2], a[3]); w[2] = pk2(b[0], b[1]); w[3] = pk2(b[2], b[3]);
    return __builtin_bit_cast(bf16x8, w);
}
DEV void st_bf4(bf16* p, f32x4 v) { u32x2 w; w[0] = pk2(v[0], v[1]); w[1] = pk2(v[2], v[3]); *(u32x2*)p = w; }

constexpr int LDT = 72;
constexpr int GEMM_AS = 256 * LDT, GEMM_BS = 128 * LDT;
constexpr int GEMM_LDS = 2 * (GEMM_AS + GEMM_BS) * 2;

template <class AF, class EPI>
DEV void gemm_tile(unsigned char* smem, AF af, const bf16* Bt, int ldb, int nvalid, int K, EPI& epi) {
    const int tid = TID, w = tid >> 6, l = tid & 63, h = l >> 4, c = l & 15, wm = w >> 1, wn = w & 1;
    bf16* As = (bf16*)smem; bf16* Bs = As + 2 * GEMM_AS;
    const bf16* ap[4]; const bf16* bp[2];
    const int col8 = (tid & 7) * 8, r0 = tid >> 3;
#pragma unroll
    for (int i = 0; i < 4; ++i) ap[i] = af(r0 + 64 * i) + col8;
#pragma unroll
    for (int i = 0; i < 2; ++i) { int rn = r0 + 64 * i; if (rn >= nvalid) rn = nvalid - 1; bp[i] = Bt + (size_t)rn * ldb + col8; }
    f32x4 acc[4][4];
#pragma unroll
    for (int i = 0; i < 4; ++i)
#pragma unroll
        for (int j = 0; j < 4; ++j) acc[i][j] = f4zero();
    bf16x8 ra[4], rb[2];
#pragma unroll
    for (int i = 0; i < 4; ++i) ra[i] = *(const bf16x8*)(ap[i]);
#pragma unroll
    for (int i = 0; i < 2; ++i) rb[i] = *(const bf16x8*)(bp[i]);
    SYNC();
#pragma unroll
    for (int i = 0; i < 4; ++i) *(bf16x8*)(As + (r0 + 64 * i) * LDT + col8) = ra[i];
#pragma unroll
    for (int i = 0; i < 2; ++i) *(bf16x8*)(Bs + (r0 + 64 * i) * LDT + col8) = rb[i];
    SYNC();
    const int nk = K / 64;
    for (int kt = 0; kt < nk; ++kt) {
        const int cur = kt & 1;
        if (kt + 1 < nk) {
#pragma unroll
            for (int i = 0; i < 4; ++i) ra[i] = *(const bf16x8*)(ap[i] + (kt + 1) * 64);
#pragma unroll
            for (int i = 0; i < 2; ++i) rb[i] = *(const bf16x8*)(bp[i] + (kt + 1) * 64);
        }
        const bf16* Ac = As + cur * GEMM_AS + (wm * 64 + c) * LDT + 8 * h;
        const bf16* Bc = Bs + cur * GEMM_BS + (wn * 64 + c) * LDT + 8 * h;
#pragma unroll
        for (int kk = 0; kk < 2; ++kk) {
            bf16x8 fa[4], fb[4];
#pragma unroll
            for (int i = 0; i < 4; ++i) { fa[i] = *(const bf16x8*)(Ac + i * 16 * LDT + kk * 32); fb[i] = *(const bf16x8*)(Bc + i * 16 * LDT + kk * 32); }
#pragma unroll
            for (int ni = 0; ni < 4; ++ni)
#pragma unroll
                for (int mi = 0; mi < 4; ++mi) acc[ni][mi] = mfma16(fb[ni], fa[mi], acc[ni][mi]);
        }
        if (kt + 1 < nk) {
            const int nx = cur ^ 1;
#pragma unroll
            for (int i = 0; i < 4; ++i) *(bf16x8*)(As + nx * GEMM_AS + (r0 + 64 * i) * LDT + col8) = ra[i];
#pragma unroll
            for (int i = 0; i < 2; ++i) *(bf16x8*)(Bs + nx * GEMM_BS + (r0 + 64 * i) * LDT + col8) = rb[i];
        }
        SYNC();
    }
    epi(acc, wm * 64, wn * 64, h, c);
}

struct ARows { const bf16* base; size_t ld; MDEV const bf16* operator()(int r) const { return base + (size_t)r * ld; } };

constexpr int LDB = 136;
constexpr int GEMM_BS2 = 64 * LDB;
constexpr int GEMM2_LDS = (2 * GEMM_AS + 2 * GEMM_BS2) * 2;
DEV bf16x8 tr_read8(const bf16* p0, const bf16* p1) {
    const s16x4 x = tr4(p0), y = tr4(p1); bf16x8 r;
    r[0] = x[0]; r[1] = x[1]; r[2] = x[2]; r[3] = x[3]; r[4] = y[0]; r[5] = y[1]; r[6] = y[2]; r[7] = y[3]; return r;
}
template <class AF, class BF, class EPI>
DEV void gemm_tile2(unsigned char* smem, AF af, BF bf, int ldb, int K, EPI& epi) {
    const int tid = TID, w = tid >> 6, l = tid & 63, h = l >> 4, c = l & 15, wm = w >> 1, wn = w & 1;
    bf16* As = (bf16*)smem; bf16* Bs = As + 2 * GEMM_AS;
    const bf16* ap[4];
    const int col8 = (tid & 7) * 8, r0 = tid >> 3;
#pragma unroll
    for (int i = 0; i < 4; ++i) ap[i] = af(r0 + 64 * i) + col8;
    const int bn4 = (tid & 31) * 4, bk = tid >> 5;
    const float* bp = bf(bn4); const bool bok = bp != nullptr;
    if (bok) bp += (size_t)bk * ldb;
    const size_t bstep = (size_t)16 * ldb;
    f32x4 acc[4][4];
#pragma unroll
    for (int i = 0; i < 4; ++i)
#pragma unroll
        for (int j = 0; j < 4; ++j) acc[i][j] = f4zero();
    bf16x8 ra[4]; f32x4 rb[4];
#pragma unroll
    for (int i = 0; i < 4; ++i) { ra[i] = *(const bf16x8*)(ap[i]); rb[i] = bok ? *(const f32x4*)(bp + i * bstep) : f4zero(); }
    SYNC();
#pragma unroll
    for (int i = 0; i < 4; ++i) { *(bf16x8*)(As + (r0 + 64 * i) * LDT + col8) = ra[i]; st_bf4(Bs + (bk + 16 * i) * LDB + bn4, rb[i]); }
    SYNC();
    const int nk = K / 64;
    for (int kt = 0; kt < nk; ++kt) {
        const int cur = kt & 1;
        if (kt + 1 < nk) {
#pragma unroll
            for (int i = 0; i < 4; ++i) { ra[i] = *(const bf16x8*)(ap[i] + (kt + 1) * 64); rb[i] = bok ? *(const f32x4*)(bp + (size_t)(kt + 1) * 64 * ldb + i * bstep) : f4zero(); }
        }
        const bf16* Ac = As + cur * GEMM_AS + (wm * 64 + c) * LDT + 8 * h;
        const bf16* Bc = Bs + cur * GEMM_BS2 + (8 * h + (c >> 2)) * LDB + wn * 64 + 4 * (c & 3);
#pragma unroll
        for (int kk = 0; kk < 2; ++kk) {
            bf16x8 fa[4], fb[4];
#pragma unroll
            for (int i = 0; i < 4; ++i) { fa[i] = *(const bf16x8*)(Ac + i * 16 * LDT + kk * 32); fb[i] = tr_read8(Bc + (32 * kk) * LDB + 16 * i, Bc + (32 * kk + 4) * LDB + 16 * i); }
#pragma unroll
            for (int ni = 0; ni < 4; ++ni)
#pragma unroll
                for (int mi = 0; mi < 4; ++mi) acc[ni][mi] = mfma16(fb[ni], fa[mi], acc[ni][mi]);
        }
        if (kt + 1 < nk) {
            const int nx = cur ^ 1;
#pragma unroll
            for (int i = 0; i < 4; ++i) { *(bf16x8*)(As + nx * GEMM_AS + (r0 + 64 * i) * LDT + col8) = ra[i]; st_bf4(Bs + nx * GEMM_BS2 + (bk + 16 * i) * LDB + bn4, rb[i]); }
        }
        SYNC();
    }
    epi(acc, wm * 64, wn * 64, h, c);
}
struct BPlain { const float* base; MDEV const float* operator()(int nt) const { return base + nt; } };
struct BInProjMap { const float* base; int n0; MDEV const float* operator()(int nt) const { const int n = n0 + nt; const int sc = n < 1280 ? n : (n < 3328 ? n + 24 : (n < 3352 ? 1280 + (n - 3328) : -1)); return sc < 0 ? nullptr : base + sc; } };
struct BInter { const float* s0; const float* s1; int n0; MDEV const float* operator()(int nt) const { const int n = n0 + nt, g = n >> 6, w = n & 63; return w < 32 ? s0 + g * 32 + w : s1 + g * 32 + w - 32; } };
struct BClamp64 { const float* base; MDEV const float* operator()(int nt) const { return base + (nt & 63); } };

struct EpiInProj {
    const Args* a; int m0, n0, li;
    MDEV void operator()(f32x4 (&acc)[4][4], int mw, int nw, int h, int c) const {
        unsigned char* ws = wsp(*a);
        const int nb = n0 + nw;
        const int tokb = m0 + mw + c;
        if (nb < 512 || (nb >= 768 && nb < 896) || (nb >= 1024 && nb < 1152)) {
            const float* gain; float mul = 1.f; bf16* dst; int kind;
            if (nb < 512) { gain = INP(*a, I_QG) + li * 64; mul = 0.125f * LOG2E; kind = 0; dst = (bf16*)(ws + WS_QN); }
            else if (nb < 896) { gain = INP(*a, I_KG) + (li * 3 + 1) * 64; kind = 1; dst = (bf16*)(ws + WS_KS); }
            else { gain = INP(*a, I_KG) + (li * 3 + 2) * 64; kind = 1; dst = (bf16*)(ws + WS_KW); }
            const int g = (nb >> 6) & 1;
#pragma unroll
            for (int mi = 0; mi < 4; ++mi) {
                float ss = 0.f;
#pragma unroll
                for (int ni = 0; ni < 4; ++ni) { f32x4 v = acc[ni][mi]; ss += v[0] * v[0] + v[1] * v[1] + v[2] * v[2] + v[3] * v[3]; }
                ss += shflx(ss, 16); ss += shflx(ss, 32);
                const float rs = frsq(ss * (1.0f / 64.0f) + EPS) * mul;
                const int tok = tokb + 16 * mi;
#pragma unroll
                for (int ni = 0; ni < 4; ++ni) {
                    const int d = 16 * ni + 4 * h; f32x4 v = acc[ni][mi], o;
#pragma unroll
                    for (int r = 0; r < 4; ++r) o[r] = v[r] * rs * gain[d + r];
                    if (kind == 0) st_bf4(dst + (size_t)tok * 512 + nb + d, o);
                    else { const int b = tok / SEQ, s = tok % SEQ; st_bf4(dst + ((size_t)(b * 2 + g) * SEQ + s) * 64 + d, o); }
                }
            }
        } else if (nb < 768) {
            bf16* dst = (bf16*)(ws + (nb < 640 ? WS_KCG : WS_VCG)); const int g = (nb >> 6) & 1;
#pragma unroll
            for (int mi = 0; mi < 4; ++mi) { const int tok = tokb + 16 * mi, b = tok / SEQ, s = tok % SEQ;
#pragma unroll
                for (int ni = 0; ni < 4; ++ni) st_bf4(dst + ((size_t)(b * 2 + g) * SEQ + s) * 64 + 16 * ni + 4 * h, acc[ni][mi]); }
        } else if (nb < 1280) {
            bf16* dst = (bf16*)(ws + (nb < 1024 ? WS_VST : WS_VWT)); const int g = (nb >> 6) & 1;
#pragma unroll
            for (int mi = 0; mi < 4; ++mi) { const int tok = tokb + 16 * mi, b = tok / SEQ, s = tok % SEQ;
                bf16* p = dst + ((size_t)(b * 2 + g) * NCH + (s >> 6)) * 4096 + (s & 63);
#pragma unroll
                for (int ni = 0; ni < 4; ++ni)
#pragma unroll
                    for (int r = 0; r < 4; ++r) p[(16 * ni + 4 * h + r) * 64] = (bf16)f2bf(acc[ni][mi][r]); }
        } else if (nb < 3328) {
            const int sec = (nb - 1280) >> 9, cc = (nb - 1280) & 511, hh = cc >> 7, d0 = cc & 127;
#pragma unroll
            for (int mi = 0; mi < 4; ++mi) { const int tok = tokb + 16 * mi, b = tok / SEQ, s = tok % SEQ;
                const size_t hrow = ((size_t)(b * 4 + hh) * SEQ + s) * 128 + d0;
#pragma unroll
                for (int ni = 0; ni < 4; ++ni) { const int d = 16 * ni + 4 * h; f32x4 v = acc[ni][mi], o;
                    if (sec == 0) { for (int r = 0; r < 4; ++r) o[r] = siluf(v[r]); st_bf4((bf16*)(ws + WS_HQ) + hrow + d, o); }
                    else if (sec == 1) { const float* lb = (const float*)(ws + WS_LB) + li * 512 + cc + d;
                        for (int r = 0; r < 4; ++r) o[r] = lb[r] + (1.0f - lb[r]) * sigm(v[r]);
                        *(f32x4*)((float*)(ws + WS_HF) + hrow + d) = o; }
                    else if (sec == 2) st_bf4((bf16*)(ws + WS_HV) + hrow + d, v);
                    else { for (int r = 0; r < 4; ++r) o[r] = siluf(v[r]); st_bf4((bf16*)(ws + WS_HGS) + (size_t)tok * 512 + cc + d, o); }
                } }
        } else if (nb == 3328) {
            float* dst = (float*)(ws + WS_GATE);
#pragma unroll
            for (int mi = 0; mi < 4; ++mi) { const int tok = tokb + 16 * mi;
#pragma unroll
                for (int ni = 0; ni < 2; ++ni)
#pragma unroll
                    for (int r = 0; r < 4; ++r) { const int n = 16 * ni + 4 * h + r; if (n < 24) dst[(size_t)tok * 24 + n] = sigm(acc[ni][mi][r]); } }
        }
    }
};

struct EpiResid {
    float* x; const float* gate; int m0, n0;
    MDEV void operator()(f32x4 (&acc)[4][4], int mw, int nw, int h, int c) const {
#pragma unroll
        for (int mi = 0; mi < 4; ++mi) { const int tok = m0 + mw + 16 * mi + c, b = tok / SEQ;
#pragma unroll
            for (int ni = 0; ni < 4; ++ni) { const int n = n0 + nw + 16 * ni + 4 * h;
                f32x4 g = *(const f32x4*)(gate + (size_t)b * 6 * DM + n); f32x4* p = (f32x4*)(x + (size_t)tok * DM + n); f32x4 v = *p;
#pragma unroll
                for (int r = 0; r < 4; ++r) v[r] += g[r] * acc[ni][mi][r];
                *p = v; } }
    }
};
template <int MODE> struct EpiGated {
    bf16* dst; size_t ld; int m0, n0, mvalid;
    MDEV void operator()(f32x4 (&acc)[4][4], int mw, int nw, int h, int c) const {
        const int cb = (n0 + nw) / 2;
#pragma unroll
        for (int mi = 0; mi < 4; ++mi) { const int m = mw + 16 * mi + c; if (m >= mvalid) continue;
#pragma unroll
            for (int ni = 0; ni < 2; ++ni) { f32x4 o;
#pragma unroll
                for (int r = 0; r < 4; ++r) { const float av = acc[ni][mi][r], bv = acc[ni + 2][mi][r]; o[r] = MODE == 0 ? av * sigm(bv) : siluf(av) * bv; }
                st_bf4(dst + (size_t)(m0 + m) * ld + cb + 16 * ni + 4 * h, o); } }
    }
};
struct EpiStoreBf {
    bf16* dst; size_t ld; int m0, n0, mvalid;
    MDEV void operator()(f32x4 (&acc)[4][4], int mw, int nw, int h, int c) const {
#pragma unroll
        for (int mi = 0; mi < 4; ++mi) { const int m = mw + 16 * mi + c; if (m >= mvalid) continue;
#pragma unroll
            for (int ni = 0; ni < 4; ++ni) st_bf4(dst + (size_t)(m0 + m) * ld + n0 + nw + 16 * ni + 4 * h, acc[ni][mi]); }
    }
};
struct EpiCmp {
    const Args* a; int kv, bg, m0, li;
    MDEV void operator()(f32x4 (&acc)[4][4], int mw, int nw, int h, int c) const {
        if (nw != 0) return;
        unsigned char* ws = wsp(*a);
        const float* bp8 = (const float*)(ws + WS_CB) + (li * 2 + kv) * 8 * 64;
        float bias[16];
#pragma unroll
        for (int q = 0; q < 16; ++q) { const int e = 16 * (q >> 2) + 4 * h + (q & 3); float v = 0.f;
#pragma unroll
            for (int kp = 0; kp < 8; ++kp) v += bp8[kp * 64 + e];
            bias[q] = v; }
        const float* gain = INP(*a, I_KG) + (li * 3 + 0) * 64;
#pragma unroll
        for (int mi = 0; mi < 4; ++mi) { const int n = m0 + mw + 16 * mi + c; const bool ok = n < NCMP;
            f32x4 v[4]; float ss = 0.f;
#pragma unroll
            for (int ni = 0; ni < 4; ++ni) { v[ni] = acc[ni][mi];
#pragma unroll
                for (int r = 0; r < 4; ++r) { v[ni][r] += bias[4 * ni + r]; ss += v[ni][r] * v[ni][r]; } }
            ss += shflx(ss, 16); ss += shflx(ss, 32);
            if (n >= NCP) continue;
            if (kv == 0) { const float rs = frsq(ss * (1.0f / 64.0f) + EPS); bf16* p = (bf16*)(ws + WS_KC) + ((size_t)bg * NCP + n) * 64;
#pragma unroll
                for (int ni = 0; ni < 4; ++ni) { f32x4 o;
#pragma unroll
                    for (int r = 0; r < 4; ++r) o[r] = ok ? v[ni][r] * rs * gain[16 * ni + 4 * h + r] : 0.f;
                    st_bf4(p + 16 * ni + 4 * h, o); }
            } else { bf16* p = (bf16*)(ws + WS_VCT) + (size_t)bg * 64 * NCP + n;
#pragma unroll
                for (int ni = 0; ni < 4; ++ni)
#pragma unroll
                    for (int r = 0; r < 4; ++r) p[(size_t)(16 * ni + 4 * h + r) * NCP] = (bf16)f2bf(ok ? v[ni][r] : 0.f); }
        }
    }
};

DEV void tr_tile(unsigned char* smem, const float* src0, const float* src1, int ld, int K, int mode, bf16* dst, int n0, int k0) {
    bf16* tl = (bf16*)smem;
    const int tid = TID;
    SYNC();
#pragma unroll
    for (int i = 0; i < 8; ++i) {
        const int e = tid + 512 * i, kk = e >> 6, nn = e & 63, n = n0 + nn; float v = 0.f;
        if (mode == 0) v = src0[(size_t)(k0 + kk) * ld + n];
        else if (mode == 1) { int sc = n < 1280 ? n : (n < 3328 ? n + 24 : (n < 3352 ? 1280 + (n - 3328) : -1)); if (sc >= 0) v = src0[(size_t)(k0 + kk) * ld + sc]; }
        else { const int g = n >> 6, w = n & 63; v = (w < 32) ? src0[(size_t)(k0 + kk) * ld + g * 32 + w] : src1[(size_t)(k0 + kk) * ld + g * 32 + w - 32]; }
        tl[nn * LDT + kk] = (bf16)f2bf(v);
    }
    SYNC();
    const int nn = tid >> 3, k8 = (tid & 7) * 8;
    *(bf16x8*)(dst + (size_t)(n0 + nn) * K + k0 + k8) = *(const bf16x8*)(tl + nn * LDT + k8);
}

struct TrJob { const float* s0; const float* s1; int ld, K, N, mode; bf16* dst; };
DEV void p0_phase(const Args& a, unsigned char* smem) {
    unsigned char* ws = wsp(a); const int tid = TID;
    {
        float* red = (float*)smem;
        constexpr int NG = 6 * DM / 128; const int ntask = DEPTH * NG;
        for (int t = BID; t < ntask; t += NBLK) {
            const int l = t / NG, j0 = (t % NG) * 128, cq = tid & 31, kr = tid >> 5;
            const float* w = INP(a, I_ADAW) + (size_t)l * DM * 6 * DM + j0 + 4 * cq; const float* cc = INP(a, I_C);
            f32x4 a0 = f4zero(), a1 = f4zero();
#pragma unroll 8
            for (int i = 0; i < DM / 16; ++i) { const int k = kr + 16 * i; const f32x4 wv = *(const f32x4*)(w + (size_t)k * 6 * DM); const float s0 = siluf(cc[k]), s1 = siluf(cc[DM + k]);
#pragma unroll
                for (int r = 0; r < 4; ++r) { a0[r] += s0 * wv[r]; a1[r] += s1 * wv[r]; } }
            SYNC();
            *(f32x4*)(red + (kr * 2 + 0) * 128 + 4 * cq) = a0; *(f32x4*)(red + (kr * 2 + 1) * 128 + 4 * cq) = a1;
            SYNC();
            if (tid < 256) { const int b = tid >> 7, col = tid & 127; float sum = INP(a, I_ADAB)[(size_t)l * 6 * DM + j0 + col];
#pragma unroll
                for (int q = 0; q < 16; ++q) sum += red[(q * 2 + b) * 128 + col];
                ((float*)(ws + WS_MOD))[((size_t)l * 2 + b) * 6 * DM + j0 + col] = sum; }
        }
    }
    for (int t = BID; t < 32; t += NBLK) {
        float* red = (float*)smem; const int ikv = t >> 3, kp = t & 7, i = ikv >> 1, kv = ikv & 1, e = tid & 63, ks = tid >> 6;
        const float* W = INP(a, kv ? I_CWV : I_CWK) + (size_t)i * 2048 * 64 + e; const float* pe = INP(a, I_CPE) + (size_t)i * 2048;
        float sum = 0.f;
#pragma unroll 8
        for (int q = 0; q < 32; ++q) { const int k = kp * 256 + ks * 32 + q; sum += pe[k] * W[(size_t)k * 64]; }
        SYNC(); red[ks * 64 + e] = sum; SYNC();
        if (tid < 64) { float v = 0.f; for (int q = 0; q < 8; ++q) v += red[q * 64 + tid]; ((float*)(ws + WS_CB))[(ikv * 8 + kp) * 64 + tid] = v; }
    }
    if (BID == 0) {
        for (int i = tid; i < DEPTH * 32; i += NT) ((int*)(ws + WS_CNT))[i * 64] = 0;
        for (int n = tid; n < 512; n += NT) { const float l0 = INP(a, I_LBL)[n], l1 = INP(a, I_LBL)[512 + n]; const float m = fmaxf(l0, l1);
            const float e0 = fexp2((l0 - m) * LOG2E), e1 = fexp2((l1 - m) * LOG2E);
            ((float*)(ws + WS_LB))[n] = 0.f; ((float*)(ws + WS_LB))[512 + n] = e1 / (e0 + e1); }
        if (tid < 2) { const int i = tid; float mq = 0.f; for (int d = 0; d < 64; ++d) mq = fmaxf(mq, fabsf(INP(a, I_QG)[i * 64 + d]));
            for (int br = 0; br < 3; ++br) { float mk = 0.f; for (int d = 0; d < 64; ++d) mk = fmaxf(mk, fabsf(INP(a, I_KG)[(i * 3 + br) * 64 + d]));
                ((float*)(ws + WS_CS))[i * 4 + br] = 8.0f * mq * mk * LOG2E; } }
    }
}

constexpr int NJV = DM / 256;
DEV void moe_bases(const int* cnt, int* rb  ) {
    if (TID == 0) { int acc = 0; for (int e = 0; e < 32; ++e) { rb[e] = acc; acc += ((cnt[e * 64] + 255) >> 8) << 8; } rb[32] = acc; }
    SYNC();
}
DEV void norm_phase(const Args& a, unsigned char* smem, int l) {
    unsigned char* ws = wsp(a); const int tid = TID, w = tid >> 6, lane = tid & 63;
    int* rb = (int*)smem;
    if (l > 0) moe_bases((const int*)(ws + WS_CNT) + (l - 1) * 32 * 64, rb);
    const float* mod = (const float*)(ws + WS_MOD);
    const bf16* yk = (const bf16*)(ws + WS_YK);
    for (int row = BID * 8 + w; row < T; row += NBLK * 8) {
        const int b = row / SEQ;
        f32x4 v[NJV];
        const float* xin = (l == 0) ? INP(a, I_X) : outp(a);
#pragma unroll
        for (int j = 0; j < NJV; ++j) v[j] = *(const f32x4*)(xin + (size_t)row * DM + 4 * lane + 256 * j);
        if (l > 0) {
            const int* tie = (const int*)(ws + WS_TIE) + (size_t)row * 2; const float* tiw = (const float*)(ws + WS_TIW) + (size_t)row * 2;
            const int e0 = tie[0] >> 14, p0 = tie[0] & 16383, e1 = tie[1] >> 14, p1 = tie[1] & 16383;
            const float w0 = tiw[0], w1 = tiw[1];
            const bf16* y0 = yk + (size_t)(rb[e0] + p0) * DM; const bf16* y1 = yk + (size_t)(rb[e1] + p1) * DM;
            const float* gf = mod + ((size_t)(l - 1) * 2 + b) * 6 * DM + 5 * DM;
#pragma unroll
            for (int j = 0; j < NJV; ++j) { const int cidx = 4 * lane + 256 * j; u32x2 q0 = *(const u32x2*)(y0 + cidx), q1 = *(const u32x2*)(y1 + cidx);
                f32x4 g = *(const f32x4*)(gf + cidx);
                v[j][0] += g[0] * (w0 * bf2f(q0[0] & 0xffff) + w1 * bf2f(q1[0] & 0xffff));
                v[j][1] += g[1] * (w0 * bf2f(q0[0] >> 16) + w1 * bf2f(q1[0] >> 16));
                v[j][2] += g[2] * (w0 * bf2f(q0[1] & 0xffff) + w1 * bf2f(q1[1] & 0xffff));
                v[j][3] += g[3] * (w0 * bf2f(q0[1] >> 16) + w1 * bf2f(q1[1] >> 16)); }
        }
#pragma unroll
        for (int j = 0; j < NJV; ++j) *(f32x4*)(outp(a) + (size_t)row * DM + 4 * lane + 256 * j) = v[j];
        if (l == DEPTH) continue;
        float ss = 0.f;
#pragma unroll
        for (int j = 0; j < NJV; ++j) ss += v[j][0] * v[j][0] + v[j][1] * v[j][1] + v[j][2] * v[j][2] + v[j][3] * v[j][3];
#pragma unroll
        for (int o = 1; o < 64; o <<= 1) ss += shflx(ss, o);
        const float rs = frsq(ss * (1.0f / DM) + EPS);
        const float* mm = mod + ((size_t)l * 2 + b) * 6 * DM; const float* nm = INP(a, I_NMIX) + (size_t)l * DM;
        bf16* hb = (bf16*)(ws + WS_H) + (size_t)row * DM;
#pragma unroll
        for (int j = 0; j < NJV; ++j) { const int cidx = 4 * lane + 256 * j; f32x4 g = *(const f32x4*)(nm + cidx), sh = *(const f32x4*)(mm + cidx), sc = *(const f32x4*)(mm + DM + cidx), o;
#pragma unroll
            for (int r = 0; r < 4; ++r) o[r] = v[j][r] * rs * g[r] * (1.0f + sc[r]) + sh[r];
            st_bf4(hb + cidx, o); }
    }
}

DEV void route_phase(const Args& a, unsigned char* smem, int l) {
    unsigned char* ws = wsp(a); const int tid = TID;
    float* W = (float*)smem;
    int* lcnt = (int*)(smem + DM * 36 * 4); int* lbase = lcnt + 32; int* tinfo = lbase + 32;
    SYNC();
    { const f32x4* wg4 = (const f32x4*)(INP(a, I_WG) + (size_t)l * DM * 4); const f32x4* we4 = (const f32x4*)(INP(a, I_WE) + (size_t)l * DM * 32);
      for (int i = tid; i < DM; i += NT) *(f32x4*)(W + i * 36) = wg4[i];
#pragma unroll 4
      for (int i = tid; i < DM * 8; i += NT) *(f32x4*)(W + (i >> 3) * 36 + 4 + 4 * (i & 7)) = we4[i]; }
    if (tid < 32) lcnt[tid] = 0;
    SYNC();
    const float* mod = (const float*)(ws + WS_MOD); const float* nf = INP(a, I_NFFN) + (size_t)l * DM;
    int* cnt = (int*)(ws + WS_CNT) + l * 32 * 64;
    constexpr int NI = DM / 32;
    for (int pass0 = BID; pass0 < T / 16; pass0 += 4 * NBLK) {
#pragma unroll 1
        for (int pi = 0; pi < 4; ++pi) {
            const int pass = pass0 + pi * NBLK; if (pass >= T / 16) break;
            const int tok = pass * 16 + (tid >> 5), part = tid & 31, b = tok / SEQ;
            const float* xr = outp(a) + (size_t)tok * DM; float xv[NI]; float ss = 0.f;
#pragma unroll
            for (int i = 0; i < NI; ++i) { xv[i] = xr[part + 32 * i]; ss += xv[i] * xv[i]; }
#pragma unroll
            for (int o = 1; o < 32; o <<= 1) ss += shflx(ss, o);
            const float rs = frsq(ss * (1.0f / DM) + EPS);
            const float* mm = mod + ((size_t)l * 2 + b) * 6 * DM; bf16* hb = (bf16*)(ws + WS_H) + (size_t)tok * DM;
            float acc[36];
#pragma unroll
            for (int n = 0; n < 36; ++n) acc[n] = 0.f;
#pragma unroll 4
            for (int i = 0; i < NI; ++i) { const int k = part + 32 * i; const float hn = xv[i] * rs * nf[k] * (1.0f + mm[4 * DM + k]) + mm[3 * DM + k];
                hb[k] = (bf16)f2bf(hn); const f32x4* wr = (const f32x4*)(W + k * 36);
#pragma unroll
                for (int n4 = 0; n4 < 9; ++n4) { const f32x4 wv = wr[n4];
#pragma unroll
                    for (int r = 0; r < 4; ++r) acc[4 * n4 + r] += hn * wv[r]; } }
#pragma unroll
            for (int n = 0; n < 36; ++n) {
#pragma unroll
                for (int o = 1; o < 32; o <<= 1) acc[n] += shflx(acc[n], o); }
            if (part == 0) {
                int gs = 0; float gm = acc[0];
#pragma unroll
                for (int g = 1; g < 4; ++g) if (acc[g] > gm) { gm = acc[g]; gs = g; }
                float den = 0.f;
#pragma unroll
                for (int g = 0; g < 4; ++g) den += fexp2((acc[g] - gm) * LOG2E);
                const float ggate = 1.0f / den;
                float el[8];
#pragma unroll
                for (int j = 0; j < 8; ++j) { el[j] = acc[4 + j];
#pragma unroll
                    for (int g = 1; g < 4; ++g) if (gs == g) el[j] = acc[4 + 8 * g + j]; }
                int ia = 0; float va = el[0];
#pragma unroll
                for (int j = 1; j < 8; ++j) if (el[j] > va) { va = el[j]; ia = j; }
                int ib = -1; float vb = -3e38f;
#pragma unroll
                for (int j = 0; j < 8; ++j) if (j != ia && el[j] > vb) { vb = el[j]; ib = j; }
                const float wa = 1.0f / (1.0f + fexp2((vb - va) * LOG2E)), wb = 1.0f - wa;
                const int e0 = gs * 8 + ia, e1 = gs * 8 + ib;
                const int p0 = atomic_add_i(lcnt + e0, 1), p1 = atomic_add_i(lcnt + e1, 1);
                int* ti = tinfo + (pi * 16 + (tid >> 5)) * 4;
                ti[0] = (e0 << 14) | p0; ti[1] = (e1 << 14) | p1; ti[2] = __builtin_bit_cast(int, ggate * wa); ti[3] = __builtin_bit_cast(int, ggate * wb);
            }
        }
        SYNC();
        if (tid < 32) { const int n = lcnt[tid]; lbase[tid] = n > 0 ? atomic_add_i(cnt + tid * 64, n) : 0; lcnt[tid] = 0; }
        SYNC();
        if (tid < 64) { const int pi = tid >> 4, pass = pass0 + pi * NBLK;
            if (pass < T / 16) { const int tok = pass * 16 + (tid & 15); const int* ti = tinfo + tid * 4;
                const int e0 = ti[0] >> 14, e1 = ti[1] >> 14, p0 = lbase[e0] + (ti[0] & 16383), p1 = lbase[e1] + (ti[1] & 16383);
                int* list = (int*)(ws + WS_LIST); list[(size_t)e0 * T + p0] = tok; list[(size_t)e1 * T + p1] = tok;
                int* tie = (int*)(ws + WS_TIE) + (size_t)tok * 2; int* tiw = (int*)(ws + WS_TIW) + (size_t)tok * 2;
                tie[0] = (e0 << 14) | p0; tie[1] = (e1 << 14) | p1; tiw[0] = ti[2]; tiw[1] = ti[3]; } }
        SYNC();
    }
}

DEV void inproj_phase(const Args& a, unsigned char* smem, int li) {
    constexpr int TN = NINP / 128, TM = T / 256;
    const bf16* A = (const bf16*)(wsp(a) + WS_H); const float* Bw = INP(a, I_WIN) + (size_t)li * DM * NIN;
    for (int it = BID; it < TN * TM; it += NBLK) { const int tm = it / TN, tn = it % TN;
        EpiInProj E{&a, tm * 256, tn * 128, li}; ARows af{A + (size_t)tm * 256 * DM, (size_t)DM}; BInProjMap bf{Bw, tn * 128};
        gemm_tile2(smem, af, bf, NIN, DM, E); }
}
DEV void resid_gemm_phase(const Args& a, unsigned char* smem, const bf16* A, int K, const float* Bw, int l) {
    constexpr int TN = DM / 128, TM = T / 256;
    const float* gate = (const float*)(wsp(a) + WS_MOD) + (size_t)l * 2 * 6 * DM + 2 * DM;
    for (int it = BID; it < TN * TM; it += NBLK) { const int tm = it / TN, tn = it % TN;
        EpiResid E{outp(a), gate, tm * 256, tn * 128}; ARows af{A + (size_t)tm * 256 * K, (size_t)K}; BPlain bf{Bw + tn * 128};
        gemm_tile2(smem, af, bf, DM, K, E); }
}
DEV void pw1_phase(const Args& a, unsigned char* smem, int li) {
    constexpr int TN = 2 * DM / 128, TM = T / 256;
    const bf16* A = (const bf16*)(wsp(a) + WS_H); const float* Bw = INP(a, I_PW1) + (size_t)li * DM * 2 * DM;
    for (int it = BID; it < TN * TM; it += NBLK) { const int tm = it / TN, tn = it % TN;
        EpiGated<0> E{(bf16*)(wsp(a) + WS_GLU), (size_t)DM, tm * 256, tn * 128, 256}; ARows af{A + (size_t)tm * 256 * DM, (size_t)DM}; BInter bf{Bw, Bw + DM, tn * 128};
        gemm_tile2(smem, af, bf, 2 * DM, DM, E); }
}
DEV void cmp_phase_items(const Args& a, unsigned char* smem, int li, int it) {
    constexpr int TMC = (NCP + 255) / 256;
    const int kv = it / (4 * TMC), bg = (it / TMC) % 4, tm = it % TMC;
    const bf16* src = (const bf16*)(wsp(a) + (kv ? WS_VCG : WS_KCG)) + (size_t)bg * SEQ * 64;
    struct AF { const bf16* s; int m0; MDEV const bf16* operator()(int r) const { int n = m0 + r; if (n > NCMP - 1) n = NCMP - 1; return s + (size_t)n * 1024; } } af{src, tm * 256};
    EpiCmp E{&a, kv, bg, tm * 256, li};
    BClamp64 bf{INP(a, kv ? I_CWV : I_CWK) + (size_t)li * 2048 * 64};
    gemm_tile2(smem, af, bf, 64, 2048, E);
}
DEV void moe_gemm_phase(const Args& a, unsigned char* smem, int l, int mode) {
    unsigned char* ws = wsp(a); const int* cnt = (const int*)(ws + WS_CNT) + l * 32 * 64;
    int* rb = (int*)(smem + GEMM2_LDS);
    moe_bases(cnt, rb);
    const int ntile = rb[32] >> 8;
    constexpr int TN1 = 2 * FF / 128, TN2 = DM / 128;
    const int TN = mode == 0 ? TN1 : TN2;
    const int* list = (const int*)(ws + WS_LIST);
    for (int it = BID; it < ntile * TN; it += NBLK) {
        const int rt = it / TN, tn = it % TN; int e = 0;
#pragma unroll 1
        for (int q = 1; q < 32; ++q) if ((rb[q] >> 8) <= rt) e = q;
        const int rloc = (rt << 8) - rb[e], ce = cnt[e * 64], nvalid = (ce - rloc) < 256 ? (ce - rloc) : 256;
        if (mode == 0) {
            struct AF { const bf16* hb; const int* lst; int nv; MDEV const bf16* operator()(int r) const { const int rr = r < nv ? r : nv - 1; return hb + (size_t)lst[rr] * DM; } }
                af{(const bf16*)(ws + WS_H), list + (size_t)e * T + rloc, nvalid};
            EpiGated<1> E{(bf16*)(ws + WS_ACT), (size_t)FF, rt << 8, tn * 128, nvalid};
            BInter bf{INP(a, I_W1) + (size_t)(l * 32 + e) * DM * FF, INP(a, I_W3) + (size_t)(l * 32 + e) * DM * FF, tn * 128};
            gemm_tile2(smem, af, bf, FF, DM, E);
        } else {
            ARows af{(const bf16*)(ws + WS_ACT) + (size_t)(rt << 8) * FF, (size_t)FF};
            EpiStoreBf E{(bf16*)(ws + WS_YK), (size_t)DM, rt << 8, tn * 128, nvalid};
            BPlain bf{INP(a, I_W2) + (size_t)(l * 32 + e) * FF * DM + tn * 128};
            gemm_tile2(smem, af, bf, DM, FF, E);
        }
    }
}

constexpr int AT_K = 0, AT_V = 2 * 64 * LDT * 2, AT_IMP = 2 * AT_V, AT_SEL = AT_IMP + 8 * 4 * 128 * 4, AT_END = AT_SEL + 8 * 4 * 4 * 4;

#ifdef EMU
DEV float rexp2(float x) { return exp2f(x); }
#else
DEV float rexp2(float x) { return __builtin_amdgcn_exp2f(x); }
#endif
template <int MASK, bool WITH_PV, bool FULL>
DEV void attn_block(const bf16* Kp, const bf16* Vp, const bf16x8 (&qf)[2], int j, int s, bool selbit, float C2, int h, int c,
                    f32x4 (&O)[4], f32x4& Ol, f32x4 (&pout)[2][2]) {
    f32x4 st[2][2];
#pragma unroll
    for (int sp = 0; sp < 2; ++sp)
#pragma unroll
        for (int u = 0; u < 2; ++u) { st[sp][u][0] = -C2; st[sp][u][1] = -C2; st[sp][u][2] = -C2; st[sp][u][3] = -C2; const int krow = 32 * sp + 8 * (c >> 2) + 4 * u + (c & 3);
#pragma unroll
            for (int ks = 0; ks < 2; ++ks) st[sp][u] = mfma16(*(const bf16x8*)(Kp + krow * LDT + 32 * ks + 8 * h), qf[ks], st[sp][u]); }
#pragma unroll
    for (int sp = 0; sp < 2; ++sp)
#pragma unroll
        for (int u = 0; u < 2; ++u)
#pragma unroll
            for (int r = 0; r < 4; ++r) { bool ok = selbit;
                if (!FULL) { const int key = 64 * j + 32 * sp + 8 * h + 4 * u + r;
                    if (MASK == 0) ok = 16 * key + 31 <= s; else if (MASK == 1) ok = selbit && key <= s; else ok = key <= s && key > s - 512; }
                pout[sp][u][r] = ok ? rexp2(st[sp][u][r]) : 0.f; }
    if (WITH_PV) {
        bf16x8 pb[2], ones;
#pragma unroll
        for (int q = 0; q < 8; ++q) ones[q] = (short)0x3F80;
#pragma unroll
        for (int sp = 0; sp < 2; ++sp) { pb[sp] = pack8(pout[sp][0], pout[sp][1]); Ol = mfma16(ones, pb[sp], Ol); }
#pragma unroll
        for (int et = 0; et < 4; ++et)
#pragma unroll
            for (int sp = 0; sp < 2; ++sp) O[et] = mfma16(*(const bf16x8*)(Vp + (16 * et + c) * LDT + 32 * sp + 8 * h), pb[sp], O[et]);
    }
}

struct ImpState { float invl; float carry; float* imps; int tl, hd, l, s0, qblk; };
template <int MODE>
DEV void attn_branch(bf16* Kl, bf16* Vl, const bf16* kbase, int kstride, const bf16* vbase, int vstride, int jlo, int jhi,
                     const bf16x8 (&qf)[2], int s, const unsigned (&mysel)[4], const unsigned (&wsel)[4], float C2, int h, int c, int srow, int scol,
                     f32x4 (&O)[4], f32x4& Ol, ImpState& im) {
    constexpr bool PV = MODE != 1; constexpr int MASK = MODE <= 1 ? 0 : MODE - 1;
    bf16x8 rk[3], rv[3]; f32x4 pt[2][2];
    { const bf16x8 k0 = *(const bf16x8*)(kbase + (size_t)jlo * kstride); *(bf16x8*)(Kl + srow * LDT + scol) = k0;
      if (PV) { const bf16x8 v0 = *(const bf16x8*)(vbase + (size_t)jlo * vstride); *(bf16x8*)(Vl + srow * LDT + scol) = v0; } }
#pragma unroll
    for (int u = 0; u < 3; ++u) { int jj = jlo + 1 + u; if (jj > jhi) jj = jhi; rk[(1 + u) % 3] = *(const bf16x8*)(kbase + (size_t)jj * kstride); if (PV) rv[(1 + u) % 3] = *(const bf16x8*)(vbase + (size_t)jj * vstride); }
    SYNC();
    for (int jb = jlo; jb <= jhi; jb += 3) {
#pragma unroll
        for (int u = 0; u < 3; ++u) { const int j = jb + u;
            if (j <= jhi) {
                const int cur = (j - jlo) & 1;
                bool need = true, sb = true;
                if (MODE == 2) { unsigned wq = 0, mq = 0;
#pragma unroll
                    for (int q = 0; q < 4; ++q) if ((j >> 5) == q) { wq = wsel[q]; mq = mysel[q]; }
                    need = (wq >> (j & 31)) & 1u; sb = (mq >> (j & 31)) & 1u; }
                bool full;
                if (MODE <= 1) full = 1024 * j + 1039 <= im.s0; else if (MODE == 2) full = j < im.qblk; else full = (j < im.qblk) && (64 * j > im.s0 + 31 - 512);
                if (need) { if (full) attn_block<MASK, PV, true>(Kl + cur * 64 * LDT, Vl + cur * 64 * LDT, qf, j, s, sb, C2, h, c, O, Ol, pt);
                            else attn_block<MASK, PV, false>(Kl + cur * 64 * LDT, Vl + cur * 64 * LDT, qf, j, s, sb, C2, h, c, O, Ol, pt); }
                if (MODE == 1) {
#pragma unroll
                    for (int sp = 0; sp < 2; ++sp)
#pragma unroll
                        for (int uu = 0; uu < 2; ++uu)
#pragma unroll
                            for (int r = 0; r < 4; ++r) { float p = pt[sp][uu][r] * im.invl; p += shflx(p, 1); p += shflx(p, 2); pt[sp][uu][r] = p; }
                    const float r0 = shfl(pt[0][1][3], (im.l - 16) & 63), r1 = shfl(pt[1][1][3], (im.l - 16) & 63);
#pragma unroll
                    for (int sp = 0; sp < 2; ++sp)
#pragma unroll
                        for (int uu = 0; uu < 2; ++uu) { const int m = 16 * j + 8 * sp + 2 * h + uu;
                            float prev; if (uu == 1) prev = pt[sp][0][3]; else if (h > 0) prev = sp == 0 ? r0 : r1; else prev = sp == 0 ? im.carry : r0;
                            const float val = 2.0f * (pt[sp][uu][0] + pt[sp][uu][1] + pt[sp][uu][2]) + pt[sp][uu][3] + prev;
                            if (im.hd == 0 && m < 128) im.imps[im.tl * 128 + m] = val; }
                    im.carry = r1;
                }
                if (j + 1 <= jhi) {
                    *(bf16x8*)(Kl + (cur ^ 1) * 64 * LDT + srow * LDT + scol) = rk[(u + 1) % 3]; if (PV) *(bf16x8*)(Vl + (cur ^ 1) * 64 * LDT + srow * LDT + scol) = rv[(u + 1) % 3];
                    int jj = j + 4; if (jj > jhi) jj = jhi;
                    rk[(u + 1) % 3] = *(const bf16x8*)(kbase + (size_t)jj * kstride); if (PV) rv[(u + 1) % 3] = *(const bf16x8*)(vbase + (size_t)jj * vstride);
                }
                SYNC();
            }
        }
    }
}

DEV void attn_task(const Args& a, unsigned char* smem, int li, int item) {
    unsigned char* ws = wsp(a); const int tid = TID, w = tid >> 6, l = tid & 63, h = l >> 4, c = l & 15, tl = c >> 2, hd = c & 3;
    const int bg = item & 3, b = bg >> 1, g = bg & 1, tq = (SEQ / 32 - 1) - (item >> 2), s0 = tq * 32, qblk = s0 >> 6;
    const int s = s0 + 4 * w + tl, row = b * SEQ + s;
    bf16* Kl = (bf16*)(smem + AT_K); bf16* Vl = (bf16*)(smem + AT_V); float* imps = (float*)(smem + AT_IMP) + w * 512; unsigned* selm = (unsigned*)(smem + AT_SEL) + w * 16;
    bf16x8 qf[2];
    { const bf16* qp = (const bf16*)(ws + WS_QN) + (size_t)row * 512 + (g * 4 + hd) * 64 + 8 * h; qf[0] = *(const bf16x8*)qp; qf[1] = *(const bf16x8*)(qp + 32); }
    const float* gp = (const float*)(ws + WS_GATE) + (size_t)row * 24 + (g * 4 + hd) * 3;
    const float gatec = gp[0], gates = gp[1], gatew = gp[2];
    const float* cs = (const float*)(ws + WS_CS) + li * 4;
    f32x4 outv[4];
#pragma unroll
    for (int et = 0; et < 4; ++et) outv[et] = f4zero();
    const int srow = tid >> 3, scol = (tid & 7) * 8;
    for (int i = l; i < 512; i += 64) imps[i] = 0.f;
    SYNC();
    unsigned mysel[4] = {0u, 0u, 0u, 0u}, wsel[4] = {0u, 0u, 0u, 0u};
    ImpState im{0.f, 0.f, imps, tl, hd, l, s0, qblk};
    {
        const int ncv = s0 / 16 + 1, ncb = (ncv + 63) >> 6;
        const bf16* kcb = (const bf16*)(ws + WS_KC) + (size_t)bg * NCP * 64 + srow * 64 + scol;
        const bf16* vcb = (const bf16*)(ws + WS_VCT) + (size_t)bg * 64 * NCP + (size_t)srow * NCP + scol;
        f32x4 O[4]; f32x4 Ol = f4zero();
#pragma unroll
        for (int et = 0; et < 4; ++et) O[et] = f4zero();
        attn_branch<0>(Kl, Vl, kcb, 4096, vcb, 64, 0, ncb - 1, qf, s, mysel, wsel, cs[0], h, c, srow, scol, O, Ol, im);
        const float lsum = Ol[0];
        im.invl = lsum > 0.f ? 1.0f / lsum : 0.f;
#pragma unroll
        for (int et = 0; et < 4; ++et)
#pragma unroll
            for (int r = 0; r < 4; ++r) outv[et][r] += gatec * im.invl * O[et][r];
        f32x4 ld = f4zero();
        attn_branch<1>(Kl, Vl, kcb, 4096, vcb, 64, 0, ncb - 1, qf, s, mysel, wsel, cs[0], h, c, srow, scol, O, ld, im);
    }
    {
        WSYNC();
        const int tk = l >> 4, i = l & 15; float vals[8];
#pragma unroll
        for (int mm = 0; mm < 8; ++mm) { const int jj = i + 16 * mm; vals[mm] = jj > qblk ? NEGV : ((jj == 0 || jj == qblk || jj == qblk - 1) ? FORCEV : imps[tk * 128 + jj]); }
        unsigned mk[4] = {0u, 0u, 0u, 0u};
#pragma unroll 1
        for (int rnd = 0; rnd < 16; ++rnd) {
            float best = vals[0]; int bj = i;
#pragma unroll
            for (int mm = 1; mm < 8; ++mm) if (vals[mm] > best) { best = vals[mm]; bj = i + 16 * mm; }
#pragma unroll
            for (int o = 1; o < 16; o <<= 1) { const float ov = shflx(best, o); const int oj = shflxi(bj, o); if (ov > best || (ov == best && oj < bj)) { best = ov; bj = oj; } }
            if (best > NEGV * 0.5f) {
#pragma unroll
                for (int q = 0; q < 4; ++q) if ((bj >> 5) == q) mk[q] |= 1u << (bj & 31); }
            if ((bj & 15) == i) {
#pragma unroll
                for (int mm = 0; mm < 8; ++mm) if ((bj >> 4) == mm) vals[mm] = -3e38f; }
        }
        if (i == 0) {
#pragma unroll
            for (int q = 0; q < 4; ++q) selm[tk * 4 + q] = mk[q]; }
        WSYNC();
#pragma unroll
        for (int q = 0; q < 4; ++q) { mysel[q] = selm[tl * 4 + q]; wsel[q] = selm[q] | selm[4 + q] | selm[8 + q] | selm[12 + q]; }
    }
    {
        const bf16* kb = (const bf16*)(ws + WS_KS) + (size_t)bg * SEQ * 64 + tid * 8; const bf16* vb = (const bf16*)(ws + WS_VST) + (size_t)bg * NCH * 4096 + tid * 8;
        f32x4 O[4]; f32x4 Ol = f4zero();
#pragma unroll
        for (int et = 0; et < 4; ++et) O[et] = f4zero();
        attn_branch<2>(Kl, Vl, kb, 4096, vb, 4096, 0, qblk, qf, s, mysel, wsel, cs[1], h, c, srow, scol, O, Ol, im);
        const float lsum = Ol[0];
        const float sc = gates * (lsum > 0.f ? 1.0f / lsum : 0.f);
#pragma unroll
        for (int et = 0; et < 4; ++et)
#pragma unroll
            for (int r = 0; r < 4; ++r) outv[et][r] += sc * O[et][r];
    }
    {
        const bf16* kb = (const bf16*)(ws + WS_KW) + (size_t)bg * SEQ * 64 + tid * 8; const bf16* vb = (const bf16*)(ws + WS_VWT) + (size_t)bg * NCH * 4096 + tid * 8;
        f32x4 O[4]; f32x4 Ol = f4zero();
#pragma unroll
        for (int et = 0; et < 4; ++et) O[et] = f4zero();
        attn_branch<3>(Kl, Vl, kb, 4096, vb, 4096, s0 >= 511 ? (s0 - 511) >> 6 : 0, qblk, qf, s, mysel, wsel, cs[2], h, c, srow, scol, O, Ol, im);
        const float lsum = Ol[0];
        const float sc = gatew * (lsum > 0.f ? 1.0f / lsum : 0.f);
#pragma unroll
        for (int et = 0; et < 4; ++et)
#pragma unroll
            for (int r = 0; r < 4; ++r) outv[et][r] += sc * O[et][r];
    }
    bf16* dst = (bf16*)(ws + WS_CAT) + (size_t)row * 1024 + (g * 4 + hd) * 64 + 4 * h;
#pragma unroll
    for (int et = 0; et < 4; ++et) st_bf4(dst + 16 * et, outv[et]);
}

constexpr int LDH = 136;
DEV void hg_cumsum(const float* fsrc  , float* segs  , int d, int seg, float (&f)[16], float (&bc)[16], float& bend, float& bmid) {
    float run = 0.f;
#pragma unroll
    for (int i = 0; i < 16; ++i) { f[i] = fsrc[(size_t)(16 * seg + i) * 128 + d]; run += log2f(f[i]); bc[i] = run; }
    SYNC();
    segs[seg * 128 + d] = run;
    SYNC();
    const float s0 = segs[d], s1 = segs[128 + d], s2 = segs[256 + d], s3 = segs[384 + d];
    const float off = seg == 0 ? 0.f : (seg == 1 ? s0 : (seg == 2 ? s0 + s1 : s0 + s1 + s2));
#pragma unroll
    for (int i = 0; i < 16; ++i) bc[i] += off;
    bend = s0 + s1 + s2 + s3; bmid = s0 + s1;
}
DEV void hg_write16(bf16* dstrow  , const float (&v)[16]) {
    u32x4 w0, w1;
#pragma unroll
    for (int q = 0; q < 4; ++q) { w0[q] = pk2(v[2 * q], v[2 * q + 1]); w1[q] = pk2(v[8 + 2 * q], v[8 + 2 * q + 1]); }
    *(u32x4*)dstrow = w0; *(u32x4*)(dstrow + 8) = w1;
}
DEV void hg_h1_task(const Args& a, unsigned char* smem, int task) {
    unsigned char* ws = wsp(a); const int tid = TID, w = tid >> 6, l = tid & 63, h = l >> 4, c = l & 15, d = tid & 127, seg = tid >> 7;
    const int bh = task / NCH, ch = task % NCH;
    bf16* kT = (bf16*)smem; bf16* vT = kT + 128 * LDT; float* segs = (float*)(vT + 128 * LDT);
    const size_t tokb = (size_t)bh * SEQ + ch * 64;
    float f[16], bc[16], bend, bmid;
    hg_cumsum((const float*)(ws + WS_HF) + tokb * 128, segs, d, seg, f, bc, bend, bmid);
    float kv[16];
#pragma unroll
    for (int i = 0; i < 16; ++i) kv[i] = (1.0f - f[i]) * fexp2(bend - bc[i]);
    hg_write16(kT + d * LDT + 16 * seg, kv);
    const bf16* vs = (const bf16*)(ws + WS_HV) + tokb * 128;
#pragma unroll
    for (int i = 0; i < 16; ++i) kv[i] = bf2f(vs[(size_t)(16 * seg + i) * 128 + d]);
    hg_write16(vT + d * LDT + 16 * seg, kv);
    if (seg == 0) ((float*)(ws + WS_GD))[((size_t)bh * NCH + ch) * 128 + d] = fexp2(bend);
    SYNC();
    f32x4 acc[8];
#pragma unroll
    for (int et = 0; et < 8; ++et) acc[et] = f4zero();
#pragma unroll
    for (int ks = 0; ks < 2; ++ks) { const bf16x8 fa = *(const bf16x8*)(kT + (16 * w + c) * LDT + 32 * ks + 8 * h);
#pragma unroll
        for (int et = 0; et < 8; ++et) acc[et] = mfma16(fa, *(const bf16x8*)(vT + (16 * et + c) * LDT + 32 * ks + 8 * h), acc[et]); }
    float* ut = (float*)(ws + WS_UT) + ((size_t)bh * NCH + ch) * 16384;
#pragma unroll
    for (int et = 0; et < 8; ++et) *(f32x4*)(ut + (size_t)(16 * et + c) * 128 + 16 * w + 4 * h) = acc[et];
    SYNC();
}
DEV void hg_scan_task(const Args& a, int sc) {
    unsigned char* ws = wsp(a); const int bh = sc >> 3, q = (sc & 7) * 512 + TID, e = q >> 5, d0 = (q & 31) * 4;
    const float* ut = (const float*)(ws + WS_UT) + (size_t)bh * NCH * 16384 + (size_t)e * 128 + d0;
    const float* gd = (const float*)(ws + WS_GD) + (size_t)bh * NCH * 128 + d0;
    bf16* st = (bf16*)(ws + WS_ST) + (size_t)bh * NCH * 16384 + (size_t)e * 128 + d0;
    f32x4 S = f4zero();
#pragma unroll 4
    for (int ch = 0; ch < NCH; ++ch) { st_bf4(st + (size_t)ch * 16384, S);
        const f32x4 g = *(const f32x4*)(gd + (size_t)ch * 128), u = *(const f32x4*)(ut + (size_t)ch * 16384);
#pragma unroll
        for (int r = 0; r < 4; ++r) S[r] = g[r] * S[r] + u[r]; }
}
DEV void hg_h3_task(const Args& a, unsigned char* smem, int li, int task) {
    unsigned char* ws = wsp(a); const int tid = TID, w = tid >> 6, l = tid & 63, h = l >> 4, c = l & 15, d = tid & 127, seg = tid >> 7;
    const int bh = task / NCH, ch = task % NCH, b = bh >> 2, hh = bh & 3;
    bf16* At = (bf16*)smem; bf16* Bt = At + 64 * LDH; bf16* Qt = Bt + 64 * LDH; bf16* vT = Qt + 64 * LDH; float* segs = (float*)(vT + 128 * LDT); float* part = segs + 512;
    const size_t tokb = (size_t)bh * SEQ + ch * 64;
    float f[16], bc[16], bend, bmid;
    hg_cumsum((const float*)(ws + WS_HF) + tokb * 128, segs, d, seg, f, bc, bend, bmid);
    const bf16* qs = (const bf16*)(ws + WS_HQ) + tokb * 128; const bf16* vs = (const bf16*)(ws + WS_HV) + tokb * 128;
    float vv[16];
#pragma unroll
    for (int i = 0; i < 16; ++i) { const int t = 16 * seg + i; const float q = bf2f(qs[(size_t)t * 128 + d]);
        At[t * LDH + d] = (bf16)f2bf(q * fexp2(bc[i] - bmid)); Bt[t * LDH + d] = (bf16)f2bf((1.0f - f[i]) * fexp2(bmid - bc[i])); Qt[t * LDH + d] = (bf16)f2bf(q * fexp2(bc[i]));
        vv[i] = bf2f(vs[(size_t)t * 128 + d]); }
    hg_write16(vT + d * LDT + 16 * seg, vv);
    SYNC();
    const int tt = w & 3, eh = w >> 2;
    f32x4 O[4];
#pragma unroll
    for (int et = 0; et < 4; ++et) O[et] = f4zero();
#pragma unroll
    for (int sp = 0; sp < 2; ++sp) {
        if (32 * sp > 16 * tt + 15) continue;
        f32x4 st[2];
#pragma unroll
        for (int u = 0; u < 2; ++u) { st[u] = f4zero(); const int krow = 32 * sp + 8 * (c >> 2) + 4 * u + (c & 3);
#pragma unroll
            for (int ks = 0; ks < 4; ++ks) st[u] = mfma16(*(const bf16x8*)(Bt + krow * LDH + 32 * ks + 8 * h), *(const bf16x8*)(At + (16 * tt + c) * LDH + 32 * ks + 8 * h), st[u]);
#pragma unroll
            for (int r = 0; r < 4; ++r) { const int sk = 32 * sp + 8 * h + 4 * u + r; if (sk > 16 * tt + c) st[u][r] = 0.f; } }
        const bf16x8 pb = pack8(st[0], st[1]);
#pragma unroll
        for (int et = 0; et < 4; ++et) O[et] = mfma16(*(const bf16x8*)(vT + (64 * eh + 16 * et + c) * LDT + 32 * sp + 8 * h), pb, O[et]);
    }
    const bf16* stp = (const bf16*)(ws + WS_ST) + ((size_t)bh * NCH + ch) * 16384;
#pragma unroll
    for (int ks = 0; ks < 4; ++ks) { const bf16x8 fq = *(const bf16x8*)(Qt + (16 * tt + c) * LDH + 32 * ks + 8 * h);
#pragma unroll
        for (int et = 0; et < 4; ++et) O[et] = mfma16(*(const bf16x8*)(stp + (size_t)(64 * eh + 16 * et + c) * 128 + 32 * ks + 8 * h), fq, O[et]); }
    float ss = 0.f;
#pragma unroll
    for (int et = 0; et < 4; ++et)
#pragma unroll
        for (int r = 0; r < 4; ++r) ss += O[et][r] * O[et][r];
    ss += shflx(ss, 16); ss += shflx(ss, 32);
    if (h == 0) part[eh * 64 + 16 * tt + c] = ss;
    SYNC();
    const float rs = frsq((part[16 * tt + c] + part[64 + 16 * tt + c]) * (1.0f / 128.0f) + EPS);
    const int tok = b * SEQ + ch * 64 + 16 * tt + c;
    const float* og = INP(a, I_OG) + li * 128; const bf16* hg = (const bf16*)(ws + WS_HGS) + (size_t)tok * 512 + hh * 128;
    bf16* dst = (bf16*)(ws + WS_CAT) + (size_t)tok * 1024 + 512 + hh * 128;
#pragma unroll
    for (int et = 0; et < 4; ++et) { const int e = 64 * eh + 16 * et + 4 * h; f32x4 o;
#pragma unroll
        for (int r = 0; r < 4; ++r) o[r] = O[et][r] * rs * og[e + r] * bf2f(hg[e + r]);
        st_bf4(dst + e, o); }
    SYNC();
}

DEV void conv_task(const Args& a, unsigned char* smem, int li, int task) {
    unsigned char* ws = wsp(a); const int tid = TID, w = tid >> 6, lane = tid & 63;
    const bool act = tid < DM / 2; const int c0 = act ? 2 * tid : 0;
    const int t0 = task * 16, b = t0 / SEQ, s0 = t0 % SEQ;
    float* red = (float*)smem;
    const float* dw = INP(a, I_DW) + (size_t)li * 31 * DM + c0;
    float acc[16][2];
    const float b0 = INP(a, I_DWB)[li * DM + c0], b1 = INP(a, I_DWB)[li * DM + c0 + 1];
#pragma unroll
    for (int t = 0; t < 16; ++t) { acc[t][0] = b0; acc[t][1] = b1; }
    const bf16* glu = (const bf16*)(ws + WS_GLU) + (size_t)b * SEQ * DM + c0;
    unsigned uu[46];
    { const bf16* gp = glu + (size_t)(s0 - 30) * DM;
#pragma unroll
    for (int r = 0; r < 46; ++r) { const int si = s0 + r - 30; uu[r] = si >= 0 ? *(const unsigned*)gp : 0u; gp += DM; OPAQUE(gp); } }
    const float* dwp = dw;
#pragma unroll
    for (int j = 0; j < 31; ++j) { const float w0 = dwp[0], w1 = dwp[1]; dwp += DM; OPAQUE(dwp);
#pragma unroll
        for (int t = 0; t < 16; ++t) { const unsigned q = uu[t + j]; acc[t][0] += w0 * bf2f(q & 0xffff); acc[t][1] += w1 * bf2f(q >> 16); } }
    float mean[16], rstd[16];
    SYNC();
#pragma unroll
    for (int t = 0; t < 16; ++t) { float s = act ? acc[t][0] + acc[t][1] : 0.f;
#pragma unroll
        for (int o = 1; o < 64; o <<= 1) s += shflx(s, o);
        if (lane == 0) red[w * 16 + t] = s; }
    SYNC();
#pragma unroll
    for (int t = 0; t < 16; ++t) { float s = 0.f;
#pragma unroll
        for (int q = 0; q < 8; ++q) s += red[q * 16 + t];
        mean[t] = s * (1.0f / DM); }
    SYNC();
#pragma unroll
    for (int t = 0; t < 16; ++t) { const float d0 = acc[t][0] - mean[t], d1 = acc[t][1] - mean[t]; float s = act ? d0 * d0 + d1 * d1 : 0.f;
#pragma unroll
        for (int o = 1; o < 64; o <<= 1) s += shflx(s, o);
        if (lane == 0) red[w * 16 + t] = s; }
    SYNC();
#pragma unroll
    for (int t = 0; t < 16; ++t) { float s = 0.f;
#pragma unroll
        for (int q = 0; q < 8; ++q) s += red[q * 16 + t];
        rstd[t] = frsq(s * (1.0f / DM) + EPS); }
    if (act) {
        const float g0 = INP(a, I_LNG)[li * DM + c0], g1 = INP(a, I_LNG)[li * DM + c0 + 1], e0 = INP(a, I_LNB)[li * DM + c0], e1 = INP(a, I_LNB)[li * DM + c0 + 1];
        bf16* dst = (bf16*)(ws + WS_CAT) + (size_t)t0 * DM + c0;
#pragma unroll
        for (int t = 0; t < 16; ++t) { const float y0 = (acc[t][0] - mean[t]) * rstd[t] * g0 + e0, y1 = (acc[t][1] - mean[t]) * rstd[t] * g1 + e1;
            *(unsigned*)(dst + (size_t)t * DM) = pk2(siluf(y0), siluf(y1)); }
    }
}

constexpr int N_PHASES = 1 + 16 * (DEPTH / 2) + 1;
DEV void phase_decode(int ph, int& l, int& sub) {
    const int q = ph - 1, pair = q >> 4, r = q & 15;
    if (r < 9) { l = 2 * pair; sub = r; } else { l = 2 * pair + 1; const int rr = r - 9; sub = rr < 3 ? rr : rr + 2; }
}
constexpr int LDS_BYTES = 150 * 1024;

DEV void run_phase(const Args& a, unsigned char* smem, int ph) {
#ifndef ONLY
#define ONLY -1
#endif
#define EN(k) (ONLY < 0 || ONLY == (k))
    if (ph == 0) { if (EN(100)) p0_phase(a, smem); return; }
    if (ph == N_PHASES - 1) { if (EN(0)) norm_phase(a, smem, DEPTH); return; }
    int l, sub; phase_decode(ph, l, sub); const int li = l >> 1; const bool even = (l & 1) == 0;
    unsigned char* ws = wsp(a);
    switch (sub) {
    case 0: if (EN(0)) norm_phase(a, smem, l); break;
    case 1: if (even) { if (EN(1)) inproj_phase(a, smem, li); } else { if (EN(11)) pw1_phase(a, smem, li); } break;
    case 2:
        if (even) { constexpr int NCI = 8 * ((NCP + 255) / 256); constexpr int NH1 = 8 * NCH;
            for (int it = BID; it < NCI + NH1; it += NBLK) { if (it < NCI) { if (EN(2)) cmp_phase_items(a, smem, li, it); } else { if (EN(12)) hg_h1_task(a, smem, it - NCI); } } }
        else { for (int it = BID; it < T / 16; it += NBLK) if (EN(13)) conv_task(a, smem, li, it); }
        break;
    case 3:
        if (even) { constexpr int NA = 4 * (SEQ / 32); const int G = NBLK;
            for (int r = 0; r * G < NA; ++r) { const int it = r * G + ((r & 1) ? (G - 1 - BID) : BID); if (it < NA) { if (EN(3)) attn_task(a, smem, li, it); } }
            for (int it = BID; it < 64; it += NBLK) if (EN(14)) hg_scan_task(a, it); }
        break;
    case 4: if (even) { for (int it = BID; it < 8 * NCH; it += NBLK) if (EN(4)) hg_h3_task(a, smem, li, it); } break;
    case 5:
        if (!EN(5)) break;
        if (even) resid_gemm_phase(a, smem, (const bf16*)(ws + WS_CAT), 1024, INP(a, I_WOUT) + (size_t)li * 1024 * DM, l);
        else resid_gemm_phase(a, smem, (const bf16*)(ws + WS_CAT), DM, INP(a, I_PW2) + (size_t)li * DM * DM, l);
        break;
    case 6: if (EN(6)) route_phase(a, smem, l); break;
    case 7: if (EN(7)) moe_gemm_phase(a, smem, l, 0); break;
    case 8: if (EN(8)) moe_gemm_phase(a, smem, l, 1); break;
    }
}

#ifndef EMU
#define LAS __attribute__((address_space(3)))
#define XB_TMO      128
#define XB_XCNT(j)  (256  + 64 * (j))
#define XB_XSUB(j)  (1280 + 64 * (j))
#define XB_XGEN(j)  (2304 + 64 * (j))
#define XB_TOP      3328
#define XB_TOPGEN   3392
#define XCD_BAR_WORDS 3456
#define XB_SPIN_CAP (1u << 22)
__device__ __forceinline__ unsigned xb_ld(unsigned* p)              { return __hip_atomic_load(p, __ATOMIC_RELAXED, __HIP_MEMORY_SCOPE_AGENT); }
__device__ __forceinline__ unsigned xb_add(unsigned* p, unsigned v) { return __hip_atomic_fetch_add(p, v, __ATOMIC_RELAXED, __HIP_MEMORY_SCOPE_AGENT); }
__device__ __forceinline__ unsigned xb_xcc_id() { return (unsigned)__builtin_amdgcn_s_getreg((3 << 11) | 20) & 0xFu; }
#define XB_SPIN(cond, bar) do { unsigned _sp = 0; while (cond) { __builtin_amdgcn_s_sleep(1); \
    if ((++_sp & 255u) == 0u) { if (xb_ld(&(bar)[XB_TMO])) break; if (_sp > XB_SPIN_CAP) { atomicAdd(&(bar)[XB_TMO], 1u); break; } } } } while (0)
struct XcdBarrier { unsigned* bar; unsigned x; volatile LAS unsigned* st; };
__device__ __forceinline__ XcdBarrier xcd_barrier_post(unsigned* bar, volatile LAS unsigned* st) {
    XcdBarrier b; b.bar = bar; b.x = xb_xcc_id(); b.st = st;
    if (threadIdx.x == 0) (void)xb_add(&bar[XB_XCNT(b.x)], 1u);
    return b;
}
__device__ __forceinline__ void xcd_barrier_complete(unsigned* bar, unsigned x, unsigned& nloc, unsigned& nx) {
    const unsigned G = gridDim.x * gridDim.y * gridDim.z;
    unsigned sum, cnt, mine, sp = 0u;
    for (;;) {
        sum = 0u; cnt = 0u; mine = 0u;
#pragma unroll
        for (unsigned j = 0; j < 16; ++j) { const unsigned c = xb_ld(&bar[XB_XCNT(j)]); sum += c; cnt += (c > 0u) ? 1u : 0u; mine = (j == x) ? c : mine; }
        if (sum == G) break;
        __builtin_amdgcn_s_sleep(1);
        if ((++sp & 255u) == 0u) { if (xb_ld(&bar[XB_TMO])) break; if (sp > XB_SPIN_CAP) { atomicAdd(&bar[XB_TMO], 1u); break; } }
    }
    nloc = mine > 0u ? mine : 1u; nx = cnt > 0u ? cnt : 1u;
}
__device__ __forceinline__ void xcd_barrier(const XcdBarrier& b) {
    asm volatile("s_waitcnt vmcnt(0)" ::: "memory");
    __syncthreads();
    if (threadIdx.x == 0) {
        unsigned* bar = b.bar;
        __builtin_amdgcn_s_waitcnt(0);
        unsigned nloc = b.st[0], nx = b.st[1];
        if (nloc == 0u) { xcd_barrier_complete(bar, b.x, nloc, nx); b.st[0] = nloc; b.st[1] = nx; }
        const unsigned old = xb_add(&bar[XB_XSUB(b.x)], 1u);
        const unsigned gen = old / nloc;
        if (old + 1u == (gen + 1u) * nloc) {
            __builtin_amdgcn_fence(__ATOMIC_RELEASE, "agent");
            asm volatile("s_waitcnt vmcnt(0)" ::: "memory");
            const unsigned og = xb_add(&bar[XB_TOP], 1u);
            const unsigned tg = og / nx;
            if (og + 1u == (tg + 1u) * nx) xb_add(&bar[XB_TOPGEN], 1u);
            else XB_SPIN(xb_ld(&bar[XB_TOPGEN]) == tg, bar);
            __builtin_amdgcn_fence(__ATOMIC_ACQUIRE, "agent");
            xb_add(&bar[XB_XGEN(b.x)], 1u);
            asm volatile("s_waitcnt vmcnt(0)" ::: "memory");
        } else {
            XB_SPIN(xb_ld(&bar[XB_XGEN(b.x)]) == gen, bar);
            __builtin_amdgcn_fence(__ATOMIC_ACQUIRE, "agent");
            asm volatile("s_waitcnt vmcnt(0)" ::: "memory");
        }
    }
    __syncthreads();
}

__global__ void __launch_bounds__(NT, 2) mega(Args a) {
    extern __shared__ __attribute__((aligned(16))) unsigned char lds[];
    volatile LAS unsigned* st = (volatile LAS unsigned*)(LAS unsigned char*)(lds + LDS_BYTES - 16);
    if (threadIdx.x < 4) st[threadIdx.x] = 0u;
    __syncthreads();
    unsigned* barw = (unsigned*)(a.ws + WS_BAR);
    XcdBarrier bar = xcd_barrier_post(barw, st);
#pragma unroll 1
    for (int ph = 0; ph < N_PHASES; ++ph) {
        run_phase(a, lds, ph);
#ifdef DUP
        { int lyr = 0, sub = 100; if (ph > 0 && ph < N_PHASES - 1) phase_decode(ph, lyr, sub);
          if (sub == (DUP % 1000) && (ph == 0 || lyr == DUP / 1000) && ph < N_PHASES - 1) { xcd_barrier(bar); run_phase(a, lds, ph); } }
#endif
        if (ph + 1 < N_PHASES) xcd_barrier(bar);
    }
    if (xb_ld(&barw[XB_TMO]) != 0u) {
        const size_t gt = (size_t)blockIdx.x * NT + threadIdx.x, gs = (size_t)gridDim.x * NT;
        for (size_t i = gt; i < (size_t)T * DM; i += gs) a.out[i] = __builtin_nanf("");
    }
}

extern "C" void kernel_launch(void* const* d_in, const int* in_sizes, int n_in, void* d_out, int out_size,
                              void* d_ws, size_t ws_size, hipStream_t stream) {
    static int grid = 0;
    if (grid == 0) {
        int dev = 0, cus = 0;
        if (hipGetDevice(&dev) != hipSuccess || hipDeviceGetAttribute(&cus, hipDeviceAttributeMultiprocessorCount, dev) != hipSuccess) { grid = -1; return; }
        if (hipFuncSetAttribute((const void*)mega, hipFuncAttributeMaxDynamicSharedMemorySize, LDS_BYTES) != hipSuccess) { grid = -1; return; }
        (void)hipGetLastError();
        grid = cus;
        if (n_in != 26 || out_size != T * DM || ws_size < WS_END) { fprintf(stderr, "kernel_launch: unexpected sizes n_in %d out %d ws %zu (need %zu)\n", n_in, out_size, ws_size, (size_t)WS_END); grid = -1; return; }
    }
    if (grid < 0) return;
    (void)hipMemsetAsync((unsigned char*)d_ws + WS_BAR, 0, XCD_BAR_WORDS * 4, stream);
    Args a{};
    for (int i = 0; i < 26; ++i) a.in[i] = (const float*)d_in[i];
    a.out = (float*)d_out; a.ws = (unsigned char*)d_ws;
    hipLaunchKernelGGL(mega, dim3(grid), dim3(NT), LDS_BYTES, stream, a);
}
#endif
```

```cpp
#ifdef EMU
#include "emu.h"
#define DEV static inline
#define MDEV inline
#define OPAQUE(p)
#define TID emu_tid()
#define BID (EB->bid)
#define NBLK (EB->nblk)
#define SYNC() emu_sync_block()
#define WSYNC() emu_sync_wave()
#define mfma16(a, b, c) emu_mfma16(a, b, c)
DEV float shflx(float v, int m) { return emu_shfl_f(v, (emu_tid() & 63) ^ m); }
DEV int shflxi(int v, int m) { return (int)emu_shfl_u((unsigned)v, (emu_tid() & 63) ^ m); }
DEV float shfl(float v, int s) { return emu_shfl_f(v, s); }
DEV int atomic_add_i(int* p, int v) { return __atomic_fetch_add(p, v, __ATOMIC_RELAXED); }
DEV float fexp2(float x) { return exp2f(x); }
DEV float frcp(float x) { return 1.0f / x; }
DEV float frsq(float x) { return 1.0f / sqrtf(x); }
typedef short s16x4 __attribute__((vector_size(8)));
static inline s16x4 emu_tr4(const unsigned short* p) {
    EmuWave& w = EB->wave[emu_tid() >> 6]; int l = emu_tid() & 63;
    const unsigned short** tab = (const unsigned short**)w.a;
    tab[l] = p; emu_sync_wave();
    s16x4 r; int g = l & 48, i = l & 15;
    for (int q = 0; q < 4; ++q) r[q] = (short)tab[g + 4 * q + (i >> 2)][i & 3];
    emu_sync_wave(); return r;
}
#define tr4(p) emu_tr4(p)
#else
#include <hip/hip_runtime.h>
#include <cstdio>
#include <cstdint>
typedef short bf16x8 __attribute__((ext_vector_type(8)));
typedef float f32x4 __attribute__((ext_vector_type(4)));
typedef unsigned u32x4 __attribute__((ext_vector_type(4)));
typedef unsigned u32x2 __attribute__((ext_vector_type(2)));
#define DEV __device__ __forceinline__
#define MDEV __device__ __forceinline__
#define OPAQUE(p) asm volatile("" : "+v"(p))
DEV int tid_opaque() { int t = (int)threadIdx.x; asm volatile("" : "+v"(t)); return t; }
#define TID tid_opaque()
#define BID ((int)blockIdx.x)
#define NBLK ((int)gridDim.x)
#define SYNC() __syncthreads()
#define WSYNC() __builtin_amdgcn_wave_barrier()
#define mfma16(a, b, c) __builtin_amdgcn_mfma_f32_16x16x32_bf16(a, b, c, 0, 0, 0)
DEV float shflx(float v, int m) { return __shfl_xor(v, m); }
DEV int shflxi(int v, int m) { return __shfl_xor(v, m); }
DEV float shfl(float v, int s) { return __shfl(v, s); }
DEV int atomic_add_i(int* p, int v) { return atomicAdd(p, v); }
DEV float fexp2(float x) { return exp2f(x); }
DEV float frcp(float x) { return 1.0f / x; }
DEV float frsq(float x) { return rsqrtf(x); }
typedef short s16x4 __attribute__((ext_vector_type(4)));
#define tr4(p) __builtin_amdgcn_ds_read_tr16_b64_v4i16((__attribute__((address_space(3))) s16x4*)(p))
#endif

typedef unsigned short bf16;

#ifndef DM
#define DM 1024
#endif
#ifndef SEQ
#define SEQ 8192
#endif
#ifndef FF
#define FF 512
#endif
constexpr int NBATCH = 2, T = NBATCH * SEQ, DEPTH = 4;
constexpr int NIN = 3352, NINP = 3456;
constexpr int NT = 512;
constexpr int NCH = SEQ / 64;
constexpr int NCP = SEQ / 16;
constexpr int NCMP = NCP - 1;
constexpr int MOE_ROWS = 2 * T + 32 * 256;
constexpr float EPS = 1e-6f, NEGV = -1e30f, FORCEV = 1e4f, LOG2E = 1.4426950408889634f;

constexpr size_t al(size_t x) { return (x + 255) & ~(size_t)255; }
constexpr size_t WS_BAR = 0;
constexpr size_t WS_CNT = 16384;
constexpr size_t WS_MOD = WS_CNT + (size_t)DEPTH * 32 * 256;
constexpr size_t WS_LB = al(WS_MOD + (size_t)DEPTH * 2 * 6 * DM * 4);
constexpr size_t WS_CB = al(WS_LB + 2 * 512 * 4);
constexpr size_t WS_CS = al(WS_CB + 2 * 2 * 8 * 64 * 4);
constexpr size_t WS_WIN = al(WS_CS + 64);
constexpr size_t WS_WOUT = al(WS_WIN + (size_t)2 * NINP * DM * 2);
constexpr size_t WS_PW1 = al(WS_WOUT + (size_t)2 * DM * 1024 * 2);
constexpr size_t WS_PW2 = al(WS_PW1 + (size_t)2 * 2 * DM * DM * 2);
constexpr size_t WS_WC = al(WS_PW2 + (size_t)2 * DM * DM * 2);
constexpr size_t WS_W13 = al(WS_WC + (size_t)2 * 2 * 64 * 2048 * 2);
constexpr size_t WS_W2 = al(WS_W13 + (size_t)DEPTH * 32 * 2 * FF * DM * 2);
constexpr size_t WS_H = al(WS_W2 + (size_t)DEPTH * 32 * DM * FF * 2);
constexpr size_t WS_QN = al(WS_H + (size_t)T * DM * 2);
constexpr size_t WS_KCG = al(WS_QN + (size_t)T * 512 * 2);
constexpr size_t WS_VCG = al(WS_KCG + (size_t)T * 128 * 2);
constexpr size_t WS_KS = al(WS_VCG + (size_t)T * 128 * 2);
constexpr size_t WS_KW = al(WS_KS + (size_t)T * 128 * 2);
constexpr size_t WS_VST = al(WS_KW + (size_t)T * 128 * 2);
constexpr size_t WS_VWT = al(WS_VST + (size_t)T * 128 * 2);
constexpr size_t WS_KC = al(WS_VWT + (size_t)T * 128 * 2);
constexpr size_t WS_VCT = al(WS_KC + (size_t)4 * NCP * 64 * 2);
constexpr size_t WS_GATE = al(WS_VCT + (size_t)4 * NCP * 64 * 2);
constexpr size_t WS_HQ = al(WS_GATE + (size_t)T * 24 * 4);
constexpr size_t WS_HF = al(WS_HQ + (size_t)T * 512 * 2);
constexpr size_t WS_HV = al(WS_HF + (size_t)T * 512 * 4);
constexpr size_t WS_HGS = al(WS_HV + (size_t)T * 512 * 2);
constexpr size_t WS_UT = al(WS_HGS + (size_t)T * 512 * 2);
constexpr size_t WS_ST = al(WS_UT + (size_t)8 * NCH * 128 * 128 * 4);
constexpr size_t WS_GD = al(WS_ST + (size_t)8 * NCH * 128 * 128 * 2);
constexpr size_t WS_CAT = al(WS_GD + (size_t)8 * NCH * 128 * 4);
constexpr size_t WS_GLU = al(WS_CAT + (size_t)T * 1024 * 2);
constexpr size_t WS_TIE = al(WS_GLU + (size_t)T * DM * 2);
constexpr size_t WS_TIW = al(WS_TIE + (size_t)T * 2 * 4);
constexpr size_t WS_LIST = al(WS_TIW + (size_t)T * 2 * 4);
constexpr size_t WS_ACT = al(WS_LIST + (size_t)32 * T * 4);
constexpr size_t WS_YK = al(WS_ACT + (size_t)MOE_ROWS * FF * 2);
constexpr size_t WS_END = al(WS_YK + (size_t)MOE_ROWS * DM * 2);

struct Args { const float* in[26]; float* out; unsigned char* ws; };
enum { I_X = 0, I_C, I_ADAW, I_ADAB, I_NMIX, I_NFFN, I_WIN, I_WOUT, I_CWK, I_CWV, I_CPE, I_QG, I_KG, I_LBL, I_OG,
       I_PW1, I_DW, I_DWB, I_LNG, I_LNB, I_PW2, I_WG, I_WE, I_W1, I_W3, I_W2 };

#ifdef EMU
DEV unsigned char* wsp(const Args& a) { return a.ws; }
DEV float* outp(const Args& a) { return a.out; }
#else
DEV unsigned char* wsp(const Args& a) { int z = 0; asm volatile("" : "+s"(z)); return a.ws + z; }
DEV float* outp(const Args& a) { int z = 0; asm volatile("" : "+s"(z)); return a.out + z; }
#endif

#ifdef EMU
#define INP(a, X) ((a).in[X])
#else
DEV int zero_opaque() { int z = 0; asm volatile("" : "+s"(z)); return z; }
#define INP(a, X) ((a).in[(X) + zero_opaque()])
#endif

DEV unsigned f2bf(float f) { unsigned u = __builtin_bit_cast(unsigned, f); return (u + 0x7fffu + ((u >> 16) & 1u)) >> 16; }
DEV float bf2f(unsigned h) { return __builtin_bit_cast(float, h << 16); }
#ifdef EMU
DEV unsigned pk2(float lo, float hi) { return f2bf(lo) | (f2bf(hi) << 16); }
#else
typedef float f32x2_t __attribute__((ext_vector_type(2)));
typedef __bf16 bf16x2_t __attribute__((ext_vector_type(2)));
DEV unsigned pk2(float lo, float hi) { f32x2_t v = {lo, hi}; bf16x2_t b = __builtin_convertvector(v, bf16x2_t); return __builtin_bit_cast(unsigned, b); }
#endif
DEV float sigm(float x) { return frcp(1.0f + fexp2(-x * LOG2E)); }
DEV float siluf(float x) { return x * sigm(x); }
DEV f32x4 f4zero() { f32x4 z = {0.f, 0.f, 0.f, 0.f}; return z; }
DEV bf16x8 pack8(f32x4 a, f32x4 b) {
    u32x4 w; w[0] = pk2(a[0], a[1]); w[1] = pk2(a[2], a[3]); w[2] = pk2(b[0], b[1]); w[3] = pk2(b[2], b[3]);
    return __builtin_bit_cast(bf16x8, w);
}
DEV void st_bf4(bf16* p, f32x4 v) { u32x2 w; w[0] = pk2(v[0], v[1]); w[1] = pk2(v[2], v[3]); *(u32x2*)p = w; }

constexpr int LDT = 72;
constexpr int GEMM_AS = 256 * LDT, GEMM_BS = 128 * LDT;
constexpr int GEMM_LDS = 2 * (GEMM_AS + GEMM_BS) * 2;

template <class AF, class EPI>
DEV void gemm_tile(unsigned char* smem, AF af, const bf16* Bt, int ldb, int nvalid, int K, EPI& epi) {
    const int tid = TID, w = tid >> 6, l = tid & 63, h = l >> 4, c = l & 15, wm = w >> 1, wn = w & 1;
    bf16* As = (bf16*)smem; bf16* Bs = As + 2 * GEMM_AS;
    const bf16* ap[4]; const bf16* bp[2];
    const int col8 = (tid & 7) * 8, r0 = tid >> 3;
#pragma unroll
    for (int i = 0; i < 4; ++i) ap[i] = af(r0 + 64 * i) + col8;
#pragma unroll
    for (int i = 0; i < 2; ++i) { int rn = r0 + 64 * i; if (rn >= nvalid) rn = nvalid - 1; bp[i] = Bt + (size_t)rn * ldb + col8; }
    f32x4 acc[4][4];
#pragma unroll
    for (int i = 0; i < 4; ++i)
#pragma unroll
        for (int j = 0; j < 4; ++j) acc[i][j] = f4zero();
    bf16x8 ra[4], rb[2];
#pragma unroll
    for (int i = 0; i < 4; ++i) ra[i] = *(const bf16x8*)(ap[i]);
#pragma unroll
    for (int i = 0; i < 2; ++i) rb[i] = *(const bf16x8*)(bp[i]);
    SYNC();
#pragma unroll
    for (int i = 0; i < 4; ++i) *(bf16x8*)(As + (r0 + 64 * i) * LDT + col8) = ra[i];
#pragma unroll
    for (int i = 0; i < 2; ++i) *(bf16x8*)(Bs + (r0 + 64 * i) * LDT + col8) = rb[i];
    SYNC();
    const int nk = K / 64;
    for (int kt = 0; kt < nk; ++kt) {
        const int cur = kt & 1;
        if (kt + 1 < nk) {
#pragma unroll
            for (int i = 0; i < 4; ++i) ra[i] = *(const bf16x8*)(ap[i] + (kt + 1) * 64);
#pragma unroll
            for (int i = 0; i < 2; ++i) rb[i] = *(const bf16x8*)(bp[i] + (kt + 1) * 64);
        }
        const bf16* Ac = As + cur * GEMM_AS + (wm * 64 + c) * LDT + 8 * h;
        const bf16* Bc = Bs + cur * GEMM_BS + (wn * 64 + c) * LDT + 8 * h;
#pragma unroll
        for (int kk = 0; kk < 2; ++kk) {
            bf16x8 fa[4], fb[4];
#pragma unroll
            for (int i = 0; i < 4; ++i) { fa[i] = *(const bf16x8*)(Ac + i * 16 * LDT + kk * 32); fb[i] = *(const bf16x8*)(Bc + i * 16 * LDT + kk * 32); }
#pragma unroll
            for (int ni = 0; ni < 4; ++ni)
#pragma unroll
                for (int mi = 0; mi < 4; ++mi) acc[ni][mi] = mfma16(fb[ni], fa[mi], acc[ni][mi]);
        }
        if (kt + 1 < nk) {
            const int nx = cur ^ 1;
#pragma unroll
            for (int i = 0; i < 4; ++i) *(bf16x8*)(As + nx * GEMM_AS + (r0 + 64 * i) * LDT + col8) = ra[i];
#pragma unroll
            for (int i = 0; i < 2; ++i) *(bf16x8*)(Bs + nx * GEMM_BS + (r0 + 64 * i) * LDT + col8) = rb[i];
        }
        SYNC();
    }
    epi(acc, wm * 64, wn * 64, h, c);
}

struct ARows { const bf16* base; size_t ld; MDEV const bf16* operator()(int r) const { return base + (size_t)r * ld; } };

constexpr int LDB = 136;
constexpr int GEMM_BS2 = 64 * LDB;
constexpr int GEMM2_LDS = (2 * GEMM_AS + 2 * GEMM_BS2) * 2;
DEV bf16x8 tr_read8(const bf16* p0, const bf16* p1) {
    const s16x4 x = tr4(p0), y = tr4(p1); bf16x8 r;
    r[0] = x[0]; r[1] = x[1]; r[2] = x[2]; r[3] = x[3]; r[4] = y[0]; r[5] = y[1]; r[6] = y[2]; r[7] = y[3]; return r;
}
template <class AF, class BF, class EPI>
DEV void gemm_tile2(unsigned char* smem, AF af, BF bf, int ldb, int K, EPI& epi) {
    const int tid = TID, w = tid >> 6, l = tid & 63, h = l >> 4, c = l & 15, wm = w >> 1, wn = w & 1;
    bf16* As = (bf16*)smem; bf16* Bs = As + 2 * GEMM_AS;
    const bf16* ap[4];
    const int col8 = (tid & 7) * 8, r0 = tid >> 3;
#pragma unroll
    for (int i = 0; i < 4; ++i) ap[i] = af(r0 + 64 * i) + col8;
    const int bn4 = (tid & 31) * 4, bk = tid >> 5;
    const float* bp = bf(bn4); const bool bok = bp != nullptr;
    if (bok) bp += (size_t)bk * ldb;
    const size_t bstep = (size_t)16 * ldb;
    f32x4 acc[4][4];
#pragma unroll
    for (int i = 0; i < 4; ++i)
#pragma unroll
        for (int j = 0; j < 4; ++j) acc[i][j] = f4zero();
    bf16x8 ra[2][4]; f32x4 rb[2][4];
    const int nk = K / 64;
#pragma unroll
    for (int i = 0; i < 4; ++i) { ra[0][i] = *(const bf16x8*)(ap[i]); rb[0][i] = bok ? *(const f32x4*)(bp + i * bstep) : f4zero(); }
    if (nk > 1) {
#pragma unroll
        for (int i = 0; i < 4; ++i) { ra[1][i] = *(const bf16x8*)(ap[i] + 64); rb[1][i] = bok ? *(const f32x4*)(bp + (size_t)64 * ldb + i * bstep) : f4zero(); } }
    SYNC();
#pragma unroll
    for (int i = 0; i < 4; ++i) { *(bf16x8*)(As + (r0 + 64 * i) * LDT + col8) = ra[0][i]; st_bf4(Bs + (bk + 16 * i) * LDB + bn4, rb[0][i]); }
    if (nk > 2) {
#pragma unroll
        for (int i = 0; i < 4; ++i) { ra[0][i] = *(const bf16x8*)(ap[i] + 128); rb[0][i] = bok ? *(const f32x4*)(bp + (size_t)128 * ldb + i * bstep) : f4zero(); } }
    SYNC();
    for (int kb = 0; kb < nk; kb += 2) {
#pragma unroll
        for (int u = 0; u < 2; ++u) { const int kt = kb + u;
            if (kt < nk) {
                const bf16* Ac = As + u * GEMM_AS + (wm * 64 + c) * LDT + 8 * h;
                const bf16* Bc = Bs + u * GEMM_BS2 + (8 * h + (c >> 2)) * LDB + wn * 64 + 4 * (c & 3);
#pragma unroll
                for (int kk = 0; kk < 2; ++kk) {
                    bf16x8 fa[4], fb[4];
#pragma unroll
                    for (int i = 0; i < 4; ++i) { fa[i] = *(const bf16x8*)(Ac + i * 16 * LDT + kk * 32); fb[i] = tr_read8(Bc + (32 * kk) * LDB + 16 * i, Bc + (32 * kk + 4) * LDB + 16 * i); }
#pragma unroll
                    for (int ni = 0; ni < 4; ++ni)
#pragma unroll
                        for (int mi = 0; mi < 4; ++mi) acc[ni][mi] = mfma16(fb[ni], fa[mi], acc[ni][mi]);
                }
                if (kt + 1 < nk) {
                    const int nx = u ^ 1;
#pragma unroll
                    for (int i = 0; i < 4; ++i) { *(bf16x8*)(As + nx * GEMM_AS + (r0 + 64 * i) * LDT + col8) = ra[nx][i]; st_bf4(Bs + nx * GEMM_BS2 + (bk + 16 * i) * LDB + bn4, rb[nx][i]); }
                    if (kt + 3 < nk) {
#pragma unroll
                        for (int i = 0; i < 4; ++i) { ra[nx][i] = *(const bf16x8*)(ap[i] + (kt + 3) * 64); rb[nx][i] = bok ? *(const f32x4*)(bp + (size_t)(kt + 3) * 64 * ldb + i * bstep) : f4zero(); } }
                }
                SYNC();
            }
        }
    }
    epi(acc, wm * 64, wn * 64, h, c);
}
struct BPlain { const float* base; MDEV const float* operator()(int nt) const { return base + nt; } };
struct BInProjMap { const float* base; int n0; MDEV const float* operator()(int nt) const { const int n = n0 + nt; const int sc = n < 1280 ? n : (n < 3328 ? n + 24 : (n < 3352 ? 1280 + (n - 3328) : -1)); return sc < 0 ? nullptr : base + sc; } };
struct BInter { const float* s0; const float* s1; int n0; MDEV const float* operator()(int nt) const { const int n = n0 + nt, g = n >> 6, w = n & 63; return w < 32 ? s0 + g * 32 + w : s1 + g * 32 + w - 32; } };
struct BClamp64 { const float* base; MDEV const float* operator()(int nt) const { return base + (nt & 63); } };

struct EpiInProj {
    const Args* a; int m0, n0, li;
    MDEV void operator()(f32x4 (&acc)[4][4], int mw, int nw, int h, int c) const {
        unsigned char* ws = wsp(*a);
        const int nb = n0 + nw;
        const int tokb = m0 + mw + c;
        if (nb < 512 || (nb >= 768 && nb < 896) || (nb >= 1024 && nb < 1152)) {
            const float* gain; float mul = 1.f; bf16* dst; int kind;
            if (nb < 512) { gain = INP(*a, I_QG) + li * 64; mul = 0.125f * LOG2E; kind = 0; dst = (bf16*)(ws + WS_QN); }
            else if (nb < 896) { gain = INP(*a, I_KG) + (li * 3 + 1) * 64; kind = 1; dst = (bf16*)(ws + WS_KS); }
            else { gain = INP(*a, I_KG) + (li * 3 + 2) * 64; kind = 1; dst = (bf16*)(ws + WS_KW); }
            const int g = (nb >> 6) & 1;
#pragma unroll
            for (int mi = 0; mi < 4; ++mi) {
                float ss = 0.f;
#pragma unroll
                for (int ni = 0; ni < 4; ++ni) { f32x4 v = acc[ni][mi]; ss += v[0] * v[0] + v[1] * v[1] + v[2] * v[2] + v[3] * v[3]; }
                ss += shflx(ss, 16); ss += shflx(ss, 32);
                const float rs = frsq(ss * (1.0f / 64.0f) + EPS) * mul;
                const int tok = tokb + 16 * mi;
#pragma unroll
                for (int ni = 0; ni < 4; ++ni) {
                    const int d = 16 * ni + 4 * h; f32x4 v = acc[ni][mi], o;
#pragma unroll
                    for (int r = 0; r < 4; ++r) o[r] = v[r] * rs * gain[d + r];
                    if (kind == 0) st_bf4(dst + (size_t)tok * 512 + nb + d, o);
                    else { const int b = tok / SEQ, s = tok % SEQ; st_bf4(dst + ((size_t)(b * 2 + g) * SEQ + s) * 64 + d, o); }
                }
            }
        } else if (nb < 768) {
            bf16* dst = (bf16*)(ws + (nb < 640 ? WS_KCG : WS_VCG)); const int g = (nb >> 6) & 1;
#pragma unroll
            for (int mi = 0; mi < 4; ++mi) { const int tok = tokb + 16 * mi, b = tok / SEQ, s = tok % SEQ;
#pragma unroll
                for (int ni = 0; ni < 4; ++ni) st_bf4(dst + ((size_t)(b * 2 + g) * SEQ + s) * 64 + 16 * ni + 4 * h, acc[ni][mi]); }
        } else if (nb < 1280) {
            bf16* dst = (bf16*)(ws + (nb < 1024 ? WS_VST : WS_VWT)); const int g = (nb >> 6) & 1;
#pragma unroll
            for (int mi = 0; mi < 4; ++mi) { const int tok = tokb + 16 * mi, b = tok / SEQ, s = tok % SEQ;
                bf16* p = dst + ((size_t)(b * 2 + g) * NCH + (s >> 6)) * 4096 + (s & 63);
#pragma unroll
                for (int ni = 0; ni < 4; ++ni)
#pragma unroll
                    for (int r = 0; r < 4; ++r) p[(16 * ni + 4 * h + r) * 64] = (bf16)f2bf(acc[ni][mi][r]); }
        } else if (nb < 3328) {
            const int sec = (nb - 1280) >> 9, cc = (nb - 1280) & 511, hh = cc >> 7, d0 = cc & 127;
#pragma unroll
            for (int mi = 0; mi < 4; ++mi) { const int tok = tokb + 16 * mi, b = tok / SEQ, s = tok % SEQ;
                const size_t hrow = ((size_t)(b * 4 + hh) * SEQ + s) * 128 + d0;
#pragma unroll
                for (int ni = 0; ni < 4; ++ni) { const int d = 16 * ni + 4 * h; f32x4 v = acc[ni][mi], o;
                    if (sec == 0) { for (int r = 0; r < 4; ++r) o[r] = siluf(v[r]); st_bf4((bf16*)(ws + WS_HQ) + hrow + d, o); }
                    else if (sec == 1) { const float* lb = (const float*)(ws + WS_LB) + li * 512 + cc + d;
                        for (int r = 0; r < 4; ++r) o[r] = lb[r] + (1.0f - lb[r]) * sigm(v[r]);
                        *(f32x4*)((float*)(ws + WS_HF) + hrow + d) = o; }
                    else if (sec == 2) st_bf4((bf16*)(ws + WS_HV) + hrow + d, v);
                    else { for (int r = 0; r < 4; ++r) o[r] = siluf(v[r]); st_bf4((bf16*)(ws + WS_HGS) + (size_t)tok * 512 + cc + d, o); }
                } }
        } else if (nb == 3328) {
            float* dst = (float*)(ws + WS_GATE);
#pragma unroll
            for (int mi = 0; mi < 4; ++mi) { const int tok = tokb + 16 * mi;
#pragma unroll
                for (int ni = 0; ni < 2; ++ni)
#pragma unroll
                    for (int r = 0; r < 4; ++r) { const int n = 16 * ni + 4 * h + r; if (n < 24) dst[(size_t)tok * 24 + n] = sigm(acc[ni][mi][r]); } }
        }
    }
};

struct EpiResid {
    float* x; const float* gate; int m0, n0;
    MDEV void operator()(f32x4 (&acc)[4][4], int mw, int nw, int h, int c) const {
#pragma unroll
        for (int mi = 0; mi < 4; ++mi) { const int tok = m0 + mw + 16 * mi + c, b = tok / SEQ;
#pragma unroll
            for (int ni = 0; ni < 4; ++ni) { const int n = n0 + nw + 16 * ni + 4 * h;
                f32x4 g = *(const f32x4*)(gate + (size_t)b * 6 * DM + n); f32x4* p = (f32x4*)(x + (size_t)tok * DM + n); f32x4 v = *p;
#pragma unroll
                for (int r = 0; r < 4; ++r) v[r] += g[r] * acc[ni][mi][r];
                *p = v; } }
    }
};
template <int MODE> struct EpiGated {
    bf16* dst; size_t ld; int m0, n0, mvalid;
    MDEV void operator()(f32x4 (&acc)[4][4], int mw, int nw, int h, int c) const {
        const int cb = (n0 + nw) / 2;
#pragma unroll
        for (int mi = 0; mi < 4; ++mi) { const int m = mw + 16 * mi + c; if (m >= mvalid) continue;
#pragma unroll
            for (int ni = 0; ni < 2; ++ni) { f32x4 o;
#pragma unroll
                for (int r = 0; r < 4; ++r) { const float av = acc[ni][mi][r], bv = acc[ni + 2][mi][r]; o[r] = MODE == 0 ? av * sigm(bv) : siluf(av) * bv; }
                st_bf4(dst + (size_t)(m0 + m) * ld + cb + 16 * ni + 4 * h, o); } }
    }
};
struct EpiStoreBf {
    bf16* dst; size_t ld; int m0, n0, mvalid;
    MDEV void operator()(f32x4 (&acc)[4][4], int mw, int nw, int h, int c) const {
#pragma unroll
        for (int mi = 0; mi < 4; ++mi) { const int m = mw + 16 * mi + c; if (m >= mvalid) continue;
#pragma unroll
            for (int ni = 0; ni < 4; ++ni) st_bf4(dst + (size_t)(m0 + m) * ld + n0 + nw + 16 * ni + 4 * h, acc[ni][mi]); }
    }
};
struct EpiCmp {
    const Args* a; int kv, bg, m0, li;
    MDEV void operator()(f32x4 (&acc)[4][4], int mw, int nw, int h, int c) const {
        if (nw != 0) return;
        unsigned char* ws = wsp(*a);
        const float* bp8 = (const float*)(ws + WS_CB) + (li * 2 + kv) * 8 * 64;
        float bias[16];
#pragma unroll
        for (int q = 0; q < 16; ++q) { const int e = 16 * (q >> 2) + 4 * h + (q & 3); float v = 0.f;
#pragma unroll
            for (int kp = 0; kp < 8; ++kp) v += bp8[kp * 64 + e];
            bias[q] = v; }
        const float* gain = INP(*a, I_KG) + (li * 3 + 0) * 64;
#pragma unroll
        for (int mi = 0; mi < 4; ++mi) { const int n = m0 + mw + 16 * mi + c; const bool ok = n < NCMP;
            f32x4 v[4]; float ss = 0.f;
#pragma unroll
            for (int ni = 0; ni < 4; ++ni) { v[ni] = acc[ni][mi];
#pragma unroll
                for (int r = 0; r < 4; ++r) { v[ni][r] += bias[4 * ni + r]; ss += v[ni][r] * v[ni][r]; } }
            ss += shflx(ss, 16); ss += shflx(ss, 32);
            if (n >= NCP) continue;
            if (kv == 0) { const float rs = frsq(ss * (1.0f / 64.0f) + EPS); bf16* p = (bf16*)(ws + WS_KC) + ((size_t)bg * NCP + n) * 64;
#pragma unroll
                for (int ni = 0; ni < 4; ++ni) { f32x4 o;
#pragma unroll
                    for (int r = 0; r < 4; ++r) o[r] = ok ? v[ni][r] * rs * gain[16 * ni + 4 * h + r] : 0.f;
                    st_bf4(p + 16 * ni + 4 * h, o); }
            } else { bf16* p = (bf16*)(ws + WS_VCT) + (size_t)bg * 64 * NCP + n;
#pragma unroll
                for (int ni = 0; ni < 4; ++ni)
#pragma unroll
                    for (int r = 0; r < 4; ++r) p[(size_t)(16 * ni + 4 * h + r) * NCP] = (bf16)f2bf(ok ? v[ni][r] : 0.f); }
        }
    }
};

DEV void tr_tile(unsigned char* smem, const float* src0, const float* src1, int ld, int K, int mode, bf16* dst, int n0, int k0) {
    bf16* tl = (bf16*)smem;
    const int tid = TID;
    SYNC();
#pragma unroll
    for (int i = 0; i < 8; ++i) {
        const int e = tid + 512 * i, kk = e >> 6, nn = e & 63, n = n0 + nn; float v = 0.f;
        if (mode == 0) v = src0[(size_t)(k0 + kk) * ld + n];
        else if (mode == 1) { int sc = n < 1280 ? n : (n < 3328 ? n + 24 : (n < 3352 ? 1280 + (n - 3328) : -1)); if (sc >= 0) v = src0[(size_t)(k0 + kk) * ld + sc]; }
        else { const int g = n >> 6, w = n & 63; v = (w < 32) ? src0[(size_t)(k0 + kk) * ld + g * 32 + w] : src1[(size_t)(k0 + kk) * ld + g * 32 + w - 32]; }
        tl[nn * LDT + kk] = (bf16)f2bf(v);
    }
    SYNC();
    const int nn = tid >> 3, k8 = (tid & 7) * 8;
    *(bf16x8*)(dst + (size_t)(n0 + nn) * K + k0 + k8) = *(const bf16x8*)(tl + nn * LDT + k8);
}

struct TrJob { const float* s0; const float* s1; int ld, K, N, mode; bf16* dst; };
DEV void p0_phase(const Args& a, unsigned char* smem) {
    unsigned char* ws = wsp(a); const int tid = TID;
    {
        float* red = (float*)smem;
        constexpr int NG = 6 * DM / 128; const int ntask = DEPTH * NG;
        for (int t = BID; t < ntask; t += NBLK) {
            const int l = t / NG, j0 = (t % NG) * 128, cq = tid & 31, kr = tid >> 5;
            const float* w = INP(a, I_ADAW) + (size_t)l * DM * 6 * DM + j0 + 4 * cq; const float* cc = INP(a, I_C);
            f32x4 a0 = f4zero(), a1 = f4zero();
#pragma unroll 8
            for (int i = 0; i < DM / 16; ++i) { const int k = kr + 16 * i; const f32x4 wv = *(const f32x4*)(w + (size_t)k * 6 * DM); const float s0 = siluf(cc[k]), s1 = siluf(cc[DM + k]);
#pragma unroll
                for (int r = 0; r < 4; ++r) { a0[r] += s0 * wv[r]; a1[r] += s1 * wv[r]; } }
            SYNC();
            *(f32x4*)(red + (kr * 2 + 0) * 128 + 4 * cq) = a0; *(f32x4*)(red + (kr * 2 + 1) * 128 + 4 * cq) = a1;
            SYNC();
            if (tid < 256) { const int b = tid >> 7, col = tid & 127; float sum = INP(a, I_ADAB)[(size_t)l * 6 * DM + j0 + col];
#pragma unroll
                for (int q = 0; q < 16; ++q) sum += red[(q * 2 + b) * 128 + col];
                ((float*)(ws + WS_MOD))[((size_t)l * 2 + b) * 6 * DM + j0 + col] = sum; }
        }
    }
    for (int t = BID; t < 32; t += NBLK) {
        float* red = (float*)smem; const int ikv = t >> 3, kp = t & 7, i = ikv >> 1, kv = ikv & 1, e = tid & 63, ks = tid >> 6;
        const float* W = INP(a, kv ? I_CWV : I_CWK) + (size_t)i * 2048 * 64 + e; const float* pe = INP(a, I_CPE) + (size_t)i * 2048;
        float sum = 0.f;
#pragma unroll 8
        for (int q = 0; q < 32; ++q) { const int k = kp * 256 + ks * 32 + q; sum += pe[k] * W[(size_t)k * 64]; }
        SYNC(); red[ks * 64 + e] = sum; SYNC();
        if (tid < 64) { float v = 0.f; for (int q = 0; q < 8; ++q) v += red[q * 64 + tid]; ((float*)(ws + WS_CB))[(ikv * 8 + kp) * 64 + tid] = v; }
    }
    if (BID == 0) {
        for (int i = tid; i < DEPTH * 32; i += NT) ((int*)(ws + WS_CNT))[i * 64] = 0;
        for (int n = tid; n < 512; n += NT) { const float l0 = INP(a, I_LBL)[n], l1 = INP(a, I_LBL)[512 + n]; const float m = fmaxf(l0, l1);
            const float e0 = fexp2((l0 - m) * LOG2E), e1 = fexp2((l1 - m) * LOG2E);
            ((float*)(ws + WS_LB))[n] = 0.f; ((float*)(ws + WS_LB))[512 + n] = e1 / (e0 + e1); }
        if (tid < 2) { const int i = tid; float mq = 0.f; for (int d = 0; d < 64; ++d) mq = fmaxf(mq, fabsf(INP(a, I_QG)[i * 64 + d]));
            for (int br = 0; br < 3; ++br) { float mk = 0.f; for (int d = 0; d < 64; ++d) mk = fmaxf(mk, fabsf(INP(a, I_KG)[(i * 3 + br) * 64 + d]));
                ((float*)(ws + WS_CS))[i * 4 + br] = 8.0f * mq * mk * LOG2E; } }
    }
}

constexpr int NJV = DM / 256;
DEV void moe_bases(const int* cnt, int* rb  ) {
    if (TID == 0) { int acc = 0; for (int e = 0; e < 32; ++e) { rb[e] = acc; acc += ((cnt[e * 64] + 255) >> 8) << 8; } rb[32] = acc; }
    SYNC();
}
DEV void norm_phase(const Args& a, unsigned char* smem, int l) {
    unsigned char* ws = wsp(a); const int tid = TID, w = tid >> 6, lane = tid & 63;
    int* rb = (int*)smem;
    if (l > 0) moe_bases((const int*)(ws + WS_CNT) + (l - 1) * 32 * 64, rb);
    const float* mod = (const float*)(ws + WS_MOD);
    const bf16* yk = (const bf16*)(ws + WS_YK);
    for (int row = BID * 8 + w; row < T; row += NBLK * 8) {
        const int b = row / SEQ;
        f32x4 v[NJV];
        const float* xin = (l == 0) ? INP(a, I_X) : outp(a);
#pragma unroll
        for (int j = 0; j < NJV; ++j) v[j] = *(const f32x4*)(xin + (size_t)row * DM + 4 * lane + 256 * j);
        if (l > 0) {
            const int* tie = (const int*)(ws + WS_TIE) + (size_t)row * 2; const float* tiw = (const float*)(ws + WS_TIW) + (size_t)row * 2;
            const int e0 = tie[0] >> 14, p0 = tie[0] & 16383, e1 = tie[1] >> 14, p1 = tie[1] & 16383;
            const float w0 = tiw[0], w1 = tiw[1];
            const bf16* y0 = yk + (size_t)(rb[e0] + p0) * DM; const bf16* y1 = yk + (size_t)(rb[e1] + p1) * DM;
            const float* gf = mod + ((size_t)(l - 1) * 2 + b) * 6 * DM + 5 * DM;
#pragma unroll
            for (int j = 0; j < NJV; ++j) { const int cidx = 4 * lane + 256 * j; u32x2 q0 = *(const u32x2*)(y0 + cidx), q1 = *(const u32x2*)(y1 + cidx);
                f32x4 g = *(const f32x4*)(gf + cidx);
                v[j][0] += g[0] * (w0 * bf2f(q0[0] & 0xffff) + w1 * bf2f(q1[0] & 0xffff));
                v[j][1] += g[1] * (w0 * bf2f(q0[0] >> 16) + w1 * bf2f(q1[0] >> 16));
                v[j][2] += g[2] * (w0 * bf2f(q0[1] & 0xffff) + w1 * bf2f(q1[1] & 0xffff));
                v[j][3] += g[3] * (w0 * bf2f(q0[1] >> 16) + w1 * bf2f(q1[1] >> 16)); }
        }
#pragma unroll
        for (int j = 0; j < NJV; ++j) *(f32x4*)(outp(a) + (size_t)row * DM + 4 * lane + 256 * j) = v[j];
        if (l == DEPTH) continue;
        float ss = 0.f;
#pragma unroll
        for (int j = 0; j < NJV; ++j) ss += v[j][0] * v[j][0] + v[j][1] * v[j][1] + v[j][2] * v[j][2] + v[j][3] * v[j][3];
#pragma unroll
        for (int o = 1; o < 64; o <<= 1) ss += shflx(ss, o);
        const float rs = frsq(ss * (1.0f / DM) + EPS);
        const float* mm = mod + ((size_t)l * 2 + b) * 6 * DM; const float* nm = INP(a, I_NMIX) + (size_t)l * DM;
        bf16* hb = (bf16*)(ws + WS_H) + (size_t)row * DM;
#pragma unroll
        for (int j = 0; j < NJV; ++j) { const int cidx = 4 * lane + 256 * j; f32x4 g = *(const f32x4*)(nm + cidx), sh = *(const f32x4*)(mm + cidx), sc = *(const f32x4*)(mm + DM + cidx), o;
#pragma unroll
            for (int r = 0; r < 4; ++r) o[r] = v[j][r] * rs * g[r] * (1.0f + sc[r]) + sh[r];
            st_bf4(hb + cidx, o); }
    }
}

DEV void route_phase(const Args& a, unsigned char* smem, int l) {
    unsigned char* ws = wsp(a); const int tid = TID;
    float* W = (float*)smem;
    int* lcnt = (int*)(smem + DM * 36 * 4); int* lbase = lcnt + 32; int* tinfo = lbase + 32;
    SYNC();
    { const f32x4* wg4 = (const f32x4*)(INP(a, I_WG) + (size_t)l * DM * 4); const f32x4* we4 = (const f32x4*)(INP(a, I_WE) + (size_t)l * DM * 32);
      for (int i = tid; i < DM; i += NT) *(f32x4*)(W + i * 36) = wg4[i];
#pragma unroll 4
      for (int i = tid; i < DM * 8; i += NT) *(f32x4*)(W + (i >> 3) * 36 + 4 + 4 * (i & 7)) = we4[i]; }
    if (tid < 32) lcnt[tid] = 0;
    SYNC();
    const float* mod = (const float*)(ws + WS_MOD); const float* nf = INP(a, I_NFFN) + (size_t)l * DM;
    int* cnt = (int*)(ws + WS_CNT) + l * 32 * 64;
    constexpr int NI = DM / 32;
    for (int pass0 = BID; pass0 < T / 16; pass0 += 4 * NBLK) {
#pragma unroll 1
        for (int pi = 0; pi < 4; ++pi) {
            const int pass = pass0 + pi * NBLK; if (pass >= T / 16) break;
            const int tok = pass * 16 + (tid >> 5), part = tid & 31, b = tok / SEQ;
            const float* xr = outp(a) + (size_t)tok * DM; float xv[NI]; float ss = 0.f;
#pragma unroll
            for (int i = 0; i < NI; ++i) { xv[i] = xr[part + 32 * i]; ss += xv[i] * xv[i]; }
#pragma unroll
            for (int o = 1; o < 32; o <<= 1) ss += shflx(ss, o);
            const float rs = frsq(ss * (1.0f / DM) + EPS);
            const float* mm = mod + ((size_t)l * 2 + b) * 6 * DM; bf16* hb = (bf16*)(ws + WS_H) + (size_t)tok * DM;
            float acc[36];
#pragma unroll
            for (int n = 0; n < 36; ++n) acc[n] = 0.f;
            { float av[NI], cv[NI];
#pragma unroll
              for (int i = 0; i < NI; ++i) { const int k = part + 32 * i; av[i] = nf[k] * (1.0f + mm[4 * DM + k]); cv[i] = mm[3 * DM + k]; }
#pragma unroll
              for (int i = 0; i < NI; ++i) { xv[i] = xv[i] * rs * av[i] + cv[i]; hb[part + 32 * i] = (bf16)f2bf(xv[i]); } }
#pragma unroll 4
            for (int i = 0; i < NI; ++i) { const int k = part + 32 * i; const float hn = xv[i];
                const f32x4* wr = (const f32x4*)(W + k * 36);
#pragma unroll
                for (int n4 = 0; n4 < 9; ++n4) { const f32x4 wv = wr[n4];
#pragma unroll
                    for (int r = 0; r < 4; ++r) acc[4 * n4 + r] += hn * wv[r]; } }
#pragma unroll
            for (int n = 0; n < 36; ++n) {
#pragma unroll
                for (int o = 1; o < 32; o <<= 1) acc[n] += shflx(acc[n], o); }
            if (part == 0) {
                int gs = 0; float gm = acc[0];
#pragma unroll
                for (int g = 1; g < 4; ++g) if (acc[g] > gm) { gm = acc[g]; gs = g; }
                float den = 0.f;
#pragma unroll
                for (int g = 0; g < 4; ++g) den += fexp2((acc[g] - gm) * LOG2E);
                const float ggate = 1.0f / den;
                float el[8];
#pragma unroll
                for (int j = 0; j < 8; ++j) { el[j] = acc[4 + j];
#pragma unroll
                    for (int g = 1; g < 4; ++g) if (gs == g) el[j] = acc[4 + 8 * g + j]; }
                int ia = 0; float va = el[0];
#pragma unroll
                for (int j = 1; j < 8; ++j) if (el[j] > va) { va = el[j]; ia = j; }
                int ib = -1; float vb = -3e38f;
#pragma unroll
                for (int j = 0; j < 8; ++j) if (j != ia && el[j] > vb) { vb = el[j]; ib = j; }
                const float wa = 1.0f / (1.0f + fexp2((vb - va) * LOG2E)), wb = 1.0f - wa;
                const int e0 = gs * 8 + ia, e1 = gs * 8 + ib;
                const int p0 = atomic_add_i(lcnt + e0, 1), p1 = atomic_add_i(lcnt + e1, 1);
                int* ti = tinfo + (pi * 16 + (tid >> 5)) * 4;
                ti[0] = (e0 << 14) | p0; ti[1] = (e1 << 14) | p1; ti[2] = __builtin_bit_cast(int, ggate * wa); ti[3] = __builtin_bit_cast(int, ggate * wb);
            }
        }
        SYNC();
        if (tid < 32) { const int n = lcnt[tid]; lbase[tid] = n > 0 ? atomic_add_i(cnt + tid * 64, n) : 0; lcnt[tid] = 0; }
        SYNC();
        if (tid < 64) { const int pi = tid >> 4, pass = pass0 + pi * NBLK;
            if (pass < T / 16) { const int tok = pass * 16 + (tid & 15); const int* ti = tinfo + tid * 4;
                const int e0 = ti[0] >> 14, e1 = ti[1] >> 14, p0 = lbase[e0] + (ti[0] & 16383), p1 = lbase[e1] + (ti[1] & 16383);
                int* list = (int*)(ws + WS_LIST); list[(size_t)e0 * T + p0] = tok; list[(size_t)e1 * T + p1] = tok;
                int* tie = (int*)(ws + WS_TIE) + (size_t)tok * 2; int* tiw = (int*)(ws + WS_TIW) + (size_t)tok * 2;
                tie[0] = (e0 << 14) | p0; tie[1] = (e1 << 14) | p1; tiw[0] = ti[2]; tiw[1] = ti[3]; } }
        SYNC();
    }
}

DEV void inproj_phase(const Args& a, unsigned char* smem, int li) {
    constexpr int TN = NINP / 128, TM = T / 256;
    const bf16* A = (const bf16*)(wsp(a) + WS_H); const float* Bw = INP(a, I_WIN) + (size_t)li * DM * NIN;
    for (int it = BID; it < TN * TM; it += NBLK) { const int tm = it / TN, tn = it % TN;
        EpiInProj E{&a, tm * 256, tn * 128, li}; ARows af{A + (size_t)tm * 256 * DM, (size_t)DM}; BInProjMap bf{Bw, tn * 128};
        gemm_tile2(smem, af, bf, NIN, DM, E); }
}
DEV void resid_gemm_phase(const Args& a, unsigned char* smem, const bf16* A, int K, const float* Bw, int l) {
    constexpr int TN = DM / 128, TM = T / 256;
    const float* gate = (const float*)(wsp(a) + WS_MOD) + (size_t)l * 2 * 6 * DM + 2 * DM;
    for (int it = BID; it < TN * TM; it += NBLK) { const int tm = it / TN, tn = it % TN;
        EpiResid E{outp(a), gate, tm * 256, tn * 128}; ARows af{A + (size_t)tm * 256 * K, (size_t)K}; BPlain bf{Bw + tn * 128};
        gemm_tile2(smem, af, bf, DM, K, E); }
}
DEV void pw1_phase(const Args& a, unsigned char* smem, int li) {
    constexpr int TN = 2 * DM / 128, TM = T / 256;
    const bf16* A = (const bf16*)(wsp(a) + WS_H); const float* Bw = INP(a, I_PW1) + (size_t)li * DM * 2 * DM;
    for (int it = BID; it < TN * TM; it += NBLK) { const int tm = it / TN, tn = it % TN;
        EpiGated<0> E{(bf16*)(wsp(a) + WS_GLU), (size_t)DM, tm * 256, tn * 128, 256}; ARows af{A + (size_t)tm * 256 * DM, (size_t)DM}; BInter bf{Bw, Bw + DM, tn * 128};
        gemm_tile2(smem, af, bf, 2 * DM, DM, E); }
}
DEV void cmp_phase_items(const Args& a, unsigned char* smem, int li, int it) {
    constexpr int TMC = (NCP + 255) / 256;
    const int kv = it / (4 * TMC), bg = (it / TMC) % 4, tm = it % TMC;
    const bf16* src = (const bf16*)(wsp(a) + (kv ? WS_VCG : WS_KCG)) + (size_t)bg * SEQ * 64;
    struct AF { const bf16* s; int m0; MDEV const bf16* operator()(int r) const { int n = m0 + r; if (n > NCMP - 1) n = NCMP - 1; return s + (size_t)n * 1024; } } af{src, tm * 256};
    EpiCmp E{&a, kv, bg, tm * 256, li};
    BClamp64 bf{INP(a, kv ? I_CWV : I_CWK) + (size_t)li * 2048 * 64};
    gemm_tile2(smem, af, bf, 64, 2048, E);
}
DEV void moe_gemm_phase(const Args& a, unsigned char* smem, int l, int mode) {
    unsigned char* ws = wsp(a); const int* cnt = (const int*)(ws + WS_CNT) + l * 32 * 64;
    int* rb = (int*)(smem + GEMM2_LDS);
    moe_bases(cnt, rb);
    const int ntile = rb[32] >> 8;
    constexpr int TN1 = 2 * FF / 128, TN2 = DM / 128;
    const int TN = mode == 0 ? TN1 : TN2;
    const int* list = (const int*)(ws + WS_LIST);
    for (int it = BID; it < ntile * TN; it += NBLK) {
        const int rt = it / TN, tn = it % TN; int e = 0;
#pragma unroll 1
        for (int q = 1; q < 32; ++q) if ((rb[q] >> 8) <= rt) e = q;
        const int rloc = (rt << 8) - rb[e], ce = cnt[e * 64], nvalid = (ce - rloc) < 256 ? (ce - rloc) : 256;
        if (mode == 0) {
            struct AF { const bf16* hb; const int* lst; int nv; MDEV const bf16* operator()(int r) const { const int rr = r < nv ? r : nv - 1; return hb + (size_t)lst[rr] * DM; } }
                af{(const bf16*)(ws + WS_H), list + (size_t)e * T + rloc, nvalid};
            EpiGated<1> E{(bf16*)(ws + WS_ACT), (size_t)FF, rt << 8, tn * 128, nvalid};
            BInter bf{INP(a, I_W1) + (size_t)(l * 32 + e) * DM * FF, INP(a, I_W3) + (size_t)(l * 32 + e) * DM * FF, tn * 128};
            gemm_tile2(smem, af, bf, FF, DM, E);
        } else {
            ARows af{(const bf16*)(ws + WS_ACT) + (size_t)(rt << 8) * FF, (size_t)FF};
            EpiStoreBf E{(bf16*)(ws + WS_YK), (size_t)DM, rt << 8, tn * 128, nvalid};
            BPlain bf{INP(a, I_W2) + (size_t)(l * 32 + e) * FF * DM + tn * 128};
            gemm_tile2(smem, af, bf, DM, FF, E);
        }
    }
}

constexpr int AT_K = 0, AT_V = 2 * 64 * LDT * 2, AT_IMP = 2 * AT_V, AT_SEL = AT_IMP + 8 * 4 * 128 * 4, AT_END = AT_SEL + 8 * 4 * 4 * 4;

#ifdef EMU
DEV float rexp2(float x) { return exp2f(x); }
#else
DEV float rexp2(float x) { return __builtin_amdgcn_exp2f(x); }
#endif
template <int MASK, bool WITH_PV, bool FULL>
DEV void attn_block(const bf16* Kp, const bf16* Vp, const bf16x8 (&qf)[2], int j, int s, bool selbit, float C2, int h, int c,
                    f32x4 (&O)[4], f32x4& Ol, f32x4 (&pout)[2][2]) {
    f32x4 st[2][2];
#pragma unroll
    for (int sp = 0; sp < 2; ++sp)
#pragma unroll
        for (int u = 0; u < 2; ++u) { st[sp][u][0] = -C2; st[sp][u][1] = -C2; st[sp][u][2] = -C2; st[sp][u][3] = -C2; const int krow = 32 * sp + 8 * (c >> 2) + 4 * u + (c & 3);
#pragma unroll
            for (int ks = 0; ks < 2; ++ks) st[sp][u] = mfma16(*(const bf16x8*)(Kp + krow * LDT + 32 * ks + 8 * h), qf[ks], st[sp][u]); }
#pragma unroll
    for (int sp = 0; sp < 2; ++sp)
#pragma unroll
        for (int u = 0; u < 2; ++u)
#pragma unroll
            for (int r = 0; r < 4; ++r) { bool ok = selbit;
                if (!FULL) { const int key = 64 * j + 32 * sp + 8 * h + 4 * u + r;
                    if (MASK == 0) ok = 16 * key + 31 <= s; else if (MASK == 1) ok = selbit && key <= s; else ok = key <= s && key > s - 512; }
                pout[sp][u][r] = ok ? rexp2(st[sp][u][r]) : 0.f; }
    if (WITH_PV) {
        bf16x8 pb[2], ones;
#pragma unroll
        for (int q = 0; q < 8; ++q) ones[q] = (short)0x3F80;
#pragma unroll
        for (int sp = 0; sp < 2; ++sp) { pb[sp] = pack8(pout[sp][0], pout[sp][1]); Ol = mfma16(ones, pb[sp], Ol); }
#pragma unroll
        for (int et = 0; et < 4; ++et)
#pragma unroll
            for (int sp = 0; sp < 2; ++sp) O[et] = mfma16(*(const bf16x8*)(Vp + (16 * et + c) * LDT + 32 * sp + 8 * h), pb[sp], O[et]);
    }
}

struct ImpState { float invl; float carry; float* imps; int tl, hd, l, s0, qblk; };
template <int MODE>
DEV void attn_branch(bf16* Kl, bf16* Vl, const bf16* kbase, int kstride, const bf16* vbase, int vstride, int jlo, int jhi,
                     const bf16x8 (&qf)[2], int s, const unsigned (&mysel)[4], const unsigned (&wsel)[4], float C2, int h, int c, int srow, int scol,
                     f32x4 (&O)[4], f32x4& Ol, ImpState& im) {
    constexpr bool PV = MODE != 1; constexpr int MASK = MODE <= 1 ? 0 : MODE - 1;
    bf16x8 rk[3], rv[3]; f32x4 pt[2][2];
    { const bf16x8 k0 = *(const bf16x8*)(kbase + (size_t)jlo * kstride); *(bf16x8*)(Kl + srow * LDT + scol) = k0;
      if (PV) { const bf16x8 v0 = *(const bf16x8*)(vbase + (size_t)jlo * vstride); *(bf16x8*)(Vl + srow * LDT + scol) = v0; } }
#pragma unroll
    for (int u = 0; u < 3; ++u) { int jj = jlo + 1 + u; if (jj > jhi) jj = jhi; rk[(1 + u) % 3] = *(const bf16x8*)(kbase + (size_t)jj * kstride); if (PV) rv[(1 + u) % 3] = *(const bf16x8*)(vbase + (size_t)jj * vstride); }
    SYNC();
    for (int jb = jlo; jb <= jhi; jb += 3) {
#pragma unroll
        for (int u = 0; u < 3; ++u) { const int j = jb + u;
            if (j <= jhi) {
                const int cur = (j - jlo) & 1;
                bool need = true, sb = true;
                if (MODE == 2) { unsigned wq = 0, mq = 0;
#pragma unroll
                    for (int q = 0; q < 4; ++q) if ((j >> 5) == q) { wq = wsel[q]; mq = mysel[q]; }
                    need = (wq >> (j & 31)) & 1u; sb = (mq >> (j & 31)) & 1u; }
                bool full;
                if (MODE <= 1) full = 1024 * j + 1039 <= im.s0; else if (MODE == 2) full = j < im.qblk; else full = (j < im.qblk) && (64 * j > im.s0 + 31 - 512);
                if (need) { if (full) attn_block<MASK, PV, true>(Kl + cur * 64 * LDT, Vl + cur * 64 * LDT, qf, j, s, sb, C2, h, c, O, Ol, pt);
                            else attn_block<MASK, PV, false>(Kl + cur * 64 * LDT, Vl + cur * 64 * LDT, qf, j, s, sb, C2, h, c, O, Ol, pt); }
                if (MODE == 1) {
#pragma unroll
                    for (int sp = 0; sp < 2; ++sp)
#pragma unroll
                        for (int uu = 0; uu < 2; ++uu)
#pragma unroll
                            for (int r = 0; r < 4; ++r) { float p = pt[sp][uu][r] * im.invl; p += shflx(p, 1); p += shflx(p, 2); pt[sp][uu][r] = p; }
                    const float r0 = shfl(pt[0][1][3], (im.l - 16) & 63), r1 = shfl(pt[1][1][3], (im.l - 16) & 63);
#pragma unroll
                    for (int sp = 0; sp < 2; ++sp)
#pragma unroll
                        for (int uu = 0; uu < 2; ++uu) { const int m = 16 * j + 8 * sp + 2 * h + uu;
                            float prev; if (uu == 1) prev = pt[sp][0][3]; else if (h > 0) prev = sp == 0 ? r0 : r1; else prev = sp == 0 ? im.carry : r0;
                            const float val = 2.0f * (pt[sp][uu][0] + pt[sp][uu][1] + pt[sp][uu][2]) + pt[sp][uu][3] + prev;
                            if (im.hd == 0 && m < 128) im.imps[im.tl * 128 + m] = val; }
                    im.carry = r1;
                }
                if (j + 1 <= jhi) {
                    *(bf16x8*)(Kl + (cur ^ 1) * 64 * LDT + srow * LDT + scol) = rk[(u + 1) % 3]; if (PV) *(bf16x8*)(Vl + (cur ^ 1) * 64 * LDT + srow * LDT + scol) = rv[(u + 1) % 3];
                    int jj = j + 4; if (jj > jhi) jj = jhi;
                    rk[(u + 1) % 3] = *(const bf16x8*)(kbase + (size_t)jj * kstride); if (PV) rv[(u + 1) % 3] = *(const bf16x8*)(vbase + (size_t)jj * vstride);
                }
                SYNC();
            }
        }
    }
}

DEV void attn_task(const Args& a, unsigned char* smem, int li, int item) {
    unsigned char* ws = wsp(a); const int tid = TID, w = tid >> 6, l = tid & 63, h = l >> 4, c = l & 15, tl = c >> 2, hd = c & 3;
    const int bg = item & 3, b = bg >> 1, g = bg & 1, tq = (SEQ / 32 - 1) - (item >> 2), s0 = tq * 32, qblk = s0 >> 6;
    const int s = s0 + 4 * w + tl, row = b * SEQ + s;
    bf16* Kl = (bf16*)(smem + AT_K); bf16* Vl = (bf16*)(smem + AT_V); float* imps = (float*)(smem + AT_IMP) + w * 512; unsigned* selm = (unsigned*)(smem + AT_SEL) + w * 16;
    bf16x8 qf[2];
    { const bf16* qp = (const bf16*)(ws + WS_QN) + (size_t)row * 512 + (g * 4 + hd) * 64 + 8 * h; qf[0] = *(const bf16x8*)qp; qf[1] = *(const bf16x8*)(qp + 32); }
    const float* gp = (const float*)(ws + WS_GATE) + (size_t)row * 24 + (g * 4 + hd) * 3;
    const float gatec = gp[0], gates = gp[1], gatew = gp[2];
    const float* cs = (const float*)(ws + WS_CS) + li * 4;
    f32x4 outv[4];
#pragma unroll
    for (int et = 0; et < 4; ++et) outv[et] = f4zero();
    const int srow = tid >> 3, scol = (tid & 7) * 8;
    for (int i = l; i < 512; i += 64) imps[i] = 0.f;
    SYNC();
    unsigned mysel[4] = {0u, 0u, 0u, 0u}, wsel[4] = {0u, 0u, 0u, 0u};
    ImpState im{0.f, 0.f, imps, tl, hd, l, s0, qblk};
    {
        const int ncv = s0 / 16 + 1, ncb = (ncv + 63) >> 6;
        const bf16* kcb = (const bf16*)(ws + WS_KC) + (size_t)bg * NCP * 64 + srow * 64 + scol;
        const bf16* vcb = (const bf16*)(ws + WS_VCT) + (size_t)bg * 64 * NCP + (size_t)srow * NCP + scol;
        f32x4 O[4]; f32x4 Ol = f4zero();
#pragma unroll
        for (int et = 0; et < 4; ++et) O[et] = f4zero();
        attn_branch<0>(Kl, Vl, kcb, 4096, vcb, 64, 0, ncb - 1, qf, s, mysel, wsel, cs[0], h, c, srow, scol, O, Ol, im);
        const float lsum = Ol[0];
        im.invl = lsum > 0.f ? 1.0f / lsum : 0.f;
#pragma unroll
        for (int et = 0; et < 4; ++et)
#pragma unroll
            for (int r = 0; r < 4; ++r) outv[et][r] += gatec * im.invl * O[et][r];
        f32x4 ld = f4zero();
        attn_branch<1>(Kl, Vl, kcb, 4096, vcb, 64, 0, ncb - 1, qf, s, mysel, wsel, cs[0], h, c, srow, scol, O, ld, im);
    }
    {
        WSYNC();
        const int tk = l >> 4, i = l & 15; float vals[8];
#pragma unroll
        for (int mm = 0; mm < 8; ++mm) { const int jj = i + 16 * mm; vals[mm] = jj > qblk ? NEGV : ((jj == 0 || jj == qblk || jj == qblk - 1) ? FORCEV : imps[tk * 128 + jj]); }
        unsigned mk[4] = {0u, 0u, 0u, 0u};
#pragma unroll 1
        for (int rnd = 0; rnd < 16; ++rnd) {
            float best = vals[0]; int bj = i;
#pragma unroll
            for (int mm = 1; mm < 8; ++mm) if (vals[mm] > best) { best = vals[mm]; bj = i + 16 * mm; }
#pragma unroll
            for (int o = 1; o < 16; o <<= 1) { const float ov = shflx(best, o); const int oj = shflxi(bj, o); if (ov > best || (ov == best && oj < bj)) { best = ov; bj = oj; } }
            if (best > NEGV * 0.5f) {
#pragma unroll
                for (int q = 0; q < 4; ++q) if ((bj >> 5) == q) mk[q] |= 1u << (bj & 31); }
            if ((bj & 15) == i) {
#pragma unroll
                for (int mm = 0; mm < 8; ++mm) if ((bj >> 4) == mm) vals[mm] = -3e38f; }
        }
        if (i == 0) {
#pragma unroll
            for (int q = 0; q < 4; ++q) selm[tk * 4 + q] = mk[q]; }
        WSYNC();
#pragma unroll
        for (int q = 0; q < 4; ++q) { mysel[q] = selm[tl * 4 + q]; wsel[q] = selm[q] | selm[4 + q] | selm[8 + q] | selm[12 + q]; }
    }
    {
        const bf16* kb = (const bf16*)(ws + WS_KS) + (size_t)bg * SEQ * 64 + tid * 8; const bf16* vb = (const bf16*)(ws + WS_VST) + (size_t)bg * NCH * 4096 + tid * 8;
        f32x4 O[4]; f32x4 Ol = f4zero();
#pragma unroll
        for (int et = 0; et < 4; ++et) O[et] = f4zero();
        attn_branch<2>(Kl, Vl, kb, 4096, vb, 4096, 0, qblk, qf, s, mysel, wsel, cs[1], h, c, srow, scol, O, Ol, im);
        const float lsum = Ol[0];
        const float sc = gates * (lsum > 0.f ? 1.0f / lsum : 0.f);
#pragma unroll
        for (int et = 0; et < 4; ++et)
#pragma unroll
            for (int r = 0; r < 4; ++r) outv[et][r] += sc * O[et][r];
    }
    {
        const bf16* kb = (const bf16*)(ws + WS_KW) + (size_t)bg * SEQ * 64 + tid * 8; const bf16* vb = (const bf16*)(ws + WS_VWT) + (size_t)bg * NCH * 4096 + tid * 8;
        f32x4 O[4]; f32x4 Ol = f4zero();
#pragma unroll
        for (int et = 0; et < 4; ++et) O[et] = f4zero();
        attn_branch<3>(Kl, Vl, kb, 4096, vb, 4096, s0 >= 511 ? (s0 - 511) >> 6 : 0, qblk, qf, s, mysel, wsel, cs[2], h, c, srow, scol, O, Ol, im);
        const float lsum = Ol[0];
        const float sc = gatew * (lsum > 0.f ? 1.0f / lsum : 0.f);
#pragma unroll
        for (int et = 0; et < 4; ++et)
#pragma unroll
            for (int r = 0; r < 4; ++r) outv[et][r] += sc * O[et][r];
    }
    bf16* dst = (bf16*)(ws + WS_CAT) + (size_t)row * 1024 + (g * 4 + hd) * 64 + 4 * h;
#pragma unroll
    for (int et = 0; et < 4; ++et) st_bf4(dst + 16 * et, outv[et]);
}

constexpr int LDH = 136;
DEV void hg_cumsum(const float* fsrc  , float* segs  , int d, int seg, float (&f)[16], float (&bc)[16], float& bend, float& bmid) {
    float run = 0.f;
#pragma unroll
    for (int i = 0; i < 16; ++i) { f[i] = fsrc[(size_t)(16 * seg + i) * 128 + d]; run += log2f(f[i]); bc[i] = run; }
    SYNC();
    segs[seg * 128 + d] = run;
    SYNC();
    const float s0 = segs[d], s1 = segs[128 + d], s2 = segs[256 + d], s3 = segs[384 + d];
    const float off = seg == 0 ? 0.f : (seg == 1 ? s0 : (seg == 2 ? s0 + s1 : s0 + s1 + s2));
#pragma unroll
    for (int i = 0; i < 16; ++i) bc[i] += off;
    bend = s0 + s1 + s2 + s3; bmid = s0 + s1;
}
DEV void hg_write16(bf16* dstrow  , const float (&v)[16]) {
    u32x4 w0, w1;
#pragma unroll
    for (int q = 0; q < 4; ++q) { w0[q] = pk2(v[2 * q], v[2 * q + 1]); w1[q] = pk2(v[8 + 2 * q], v[8 + 2 * q + 1]); }
    *(u32x4*)dstrow = w0; *(u32x4*)(dstrow + 8) = w1;
}
DEV void hg_h1_task(const Args& a, unsigned char* smem, int task) {
    unsigned char* ws = wsp(a); const int tid = TID, w = tid >> 6, l = tid & 63, h = l >> 4, c = l & 15, d = tid & 127, seg = tid >> 7;
    const int bh = task / NCH, ch = task % NCH;
    bf16* kT = (bf16*)smem; bf16* vT = kT + 128 * LDT; float* segs = (float*)(vT + 128 * LDT);
    const size_t tokb = (size_t)bh * SEQ + ch * 64;
    float f[16], bc[16], bend, bmid;
    hg_cumsum((const float*)(ws + WS_HF) + tokb * 128, segs, d, seg, f, bc, bend, bmid);
    float kv[16];
#pragma unroll
    for (int i = 0; i < 16; ++i) kv[i] = (1.0f - f[i]) * fexp2(bend - bc[i]);
    hg_write16(kT + d * LDT + 16 * seg, kv);
    const bf16* vs = (const bf16*)(ws + WS_HV) + tokb * 128;
#pragma unroll
    for (int i = 0; i < 16; ++i) kv[i] = bf2f(vs[(size_t)(16 * seg + i) * 128 + d]);
    hg_write16(vT + d * LDT + 16 * seg, kv);
    if (seg == 0) ((float*)(ws + WS_GD))[((size_t)bh * NCH + ch) * 128 + d] = fexp2(bend);
    SYNC();
    f32x4 acc[8];
#pragma unroll
    for (int et = 0; et < 8; ++et) acc[et] = f4zero();
#pragma unroll
    for (int ks = 0; ks < 2; ++ks) { const bf16x8 fa = *(const bf16x8*)(kT + (16 * w + c) * LDT + 32 * ks + 8 * h);
#pragma unroll
        for (int et = 0; et < 8; ++et) acc[et] = mfma16(fa, *(const bf16x8*)(vT + (16 * et + c) * LDT + 32 * ks + 8 * h), acc[et]); }
    float* ut = (float*)(ws + WS_UT) + ((size_t)bh * NCH + ch) * 16384;
#pragma unroll
    for (int et = 0; et < 8; ++et) *(f32x4*)(ut + (size_t)(16 * et + c) * 128 + 16 * w + 4 * h) = acc[et];
    SYNC();
}
DEV void hg_scan_task(const Args& a, int sc) {
    unsigned char* ws = wsp(a); const int bh = sc >> 3, q = (sc & 7) * 512 + TID, e = q >> 5, d0 = (q & 31) * 4;
    const float* ut = (const float*)(ws + WS_UT) + (size_t)bh * NCH * 16384 + (size_t)e * 128 + d0;
    const float* gd = (const float*)(ws + WS_GD) + (size_t)bh * NCH * 128 + d0;
    bf16* st = (bf16*)(ws + WS_ST) + (size_t)bh * NCH * 16384 + (size_t)e * 128 + d0;
    f32x4 S = f4zero();
#pragma unroll 4
    for (int ch = 0; ch < NCH; ++ch) { st_bf4(st + (size_t)ch * 16384, S);
        const f32x4 g = *(const f32x4*)(gd + (size_t)ch * 128), u = *(const f32x4*)(ut + (size_t)ch * 16384);
#pragma unroll
        for (int r = 0; r < 4; ++r) S[r] = g[r] * S[r] + u[r]; }
}
DEV void hg_h3_task(const Args& a, unsigned char* smem, int li, int task) {
    unsigned char* ws = wsp(a); const int tid = TID, w = tid >> 6, l = tid & 63, h = l >> 4, c = l & 15, d = tid & 127, seg = tid >> 7;
    const int bh = task / NCH, ch = task % NCH, b = bh >> 2, hh = bh & 3;
    bf16* At = (bf16*)smem; bf16* Bt = At + 64 * LDH; bf16* Qt = Bt + 64 * LDH; bf16* vT = Qt + 64 * LDH; float* segs = (float*)(vT + 128 * LDT); float* part = segs + 512;
    const size_t tokb = (size_t)bh * SEQ + ch * 64;
    float f[16], bc[16], bend, bmid;
    hg_cumsum((const float*)(ws + WS_HF) + tokb * 128, segs, d, seg, f, bc, bend, bmid);
    const bf16* qs = (const bf16*)(ws + WS_HQ) + tokb * 128; const bf16* vs = (const bf16*)(ws + WS_HV) + tokb * 128;
    float vv[16];
#pragma unroll
    for (int i = 0; i < 16; ++i) { const int t = 16 * seg + i; const float q = bf2f(qs[(size_t)t * 128 + d]);
        At[t * LDH + d] = (bf16)f2bf(q * fexp2(bc[i] - bmid)); Bt[t * LDH + d] = (bf16)f2bf((1.0f - f[i]) * fexp2(bmid - bc[i])); Qt[t * LDH + d] = (bf16)f2bf(q * fexp2(bc[i]));
        vv[i] = bf2f(vs[(size_t)t * 128 + d]); }
    hg_write16(vT + d * LDT + 16 * seg, vv);
    SYNC();
    const int tt = w & 3, eh = w >> 2;
    f32x4 O[4];
#pragma unroll
    for (int et = 0; et < 4; ++et) O[et] = f4zero();
#pragma unroll
    for (int sp = 0; sp < 2; ++sp) {
        if (32 * sp > 16 * tt + 15) continue;
        f32x4 st[2];
#pragma unroll
        for (int u = 0; u < 2; ++u) { st[u] = f4zero(); const int krow = 32 * sp + 8 * (c >> 2) + 4 * u + (c & 3);
#pragma unroll
            for (int ks = 0; ks < 4; ++ks) st[u] = mfma16(*(const bf16x8*)(Bt + krow * LDH + 32 * ks + 8 * h), *(const bf16x8*)(At + (16 * tt + c) * LDH + 32 * ks + 8 * h), st[u]);
#pragma unroll
            for (int r = 0; r < 4; ++r) { const int sk = 32 * sp + 8 * h + 4 * u + r; if (sk > 16 * tt + c) st[u][r] = 0.f; } }
        const bf16x8 pb = pack8(st[0], st[1]);
#pragma unroll
        for (int et = 0; et < 4; ++et) O[et] = mfma16(*(const bf16x8*)(vT + (64 * eh + 16 * et + c) * LDT + 32 * sp + 8 * h), pb, O[et]);
    }
    const bf16* stp = (const bf16*)(ws + WS_ST) + ((size_t)bh * NCH + ch) * 16384;
#pragma unroll
    for (int ks = 0; ks < 4; ++ks) { const bf16x8 fq = *(const bf16x8*)(Qt + (16 * tt + c) * LDH + 32 * ks + 8 * h);
#pragma unroll
        for (int et = 0; et < 4; ++et) O[et] = mfma16(*(const bf16x8*)(stp + (size_t)(64 * eh + 16 * et + c) * 128 + 32 * ks + 8 * h), fq, O[et]); }
    float ss = 0.f;
#pragma unroll
    for (int et = 0; et < 4; ++et)
#pragma unroll
        for (int r = 0; r < 4; ++r) ss += O[et][r] * O[et][r];
    ss += shflx(ss, 16); ss += shflx(ss, 32);
    if (h == 0) part[eh * 64 + 16 * tt + c] = ss;
    SYNC();
    const float rs = frsq((part[16 * tt + c] + part[64 + 16 * tt + c]) * (1.0f / 128.0f) + EPS);
    const int tok = b * SEQ + ch * 64 + 16 * tt + c;
    const float* og = INP(a, I_OG) + li * 128; const bf16* hg = (const bf16*)(ws + WS_HGS) + (size_t)tok * 512 + hh * 128;
    bf16* dst = (bf16*)(ws + WS_CAT) + (size_t)tok * 1024 + 512 + hh * 128;
#pragma unroll
    for (int et = 0; et < 4; ++et) { const int e = 64 * eh + 16 * et + 4 * h; f32x4 o;
#pragma unroll
        for (int r = 0; r < 4; ++r) o[r] = O[et][r] * rs * og[e + r] * bf2f(hg[e + r]);
        st_bf4(dst + e, o); }
    SYNC();
}

DEV void conv_task(const Args& a, unsigned char* smem, int li, int task) {
    unsigned char* ws = wsp(a); const int tid = TID, w = tid >> 6, lane = tid & 63;
    const bool act = tid < DM / 2; const int c0 = act ? 2 * tid : 0;
    const int t0 = task * 16, b = t0 / SEQ, s0 = t0 % SEQ;
    float* red = (float*)smem;
    const float* dw = INP(a, I_DW) + (size_t)li * 31 * DM + c0;
    float acc[16][2];
    const float b0 = INP(a, I_DWB)[li * DM + c0], b1 = INP(a, I_DWB)[li * DM + c0 + 1];
#pragma unroll
    for (int t = 0; t < 16; ++t) { acc[t][0] = b0; acc[t][1] = b1; }
    const bf16* glu = (const bf16*)(ws + WS_GLU) + (size_t)b * SEQ * DM + c0;
    unsigned uu[46];
    { const bf16* gp = glu + (size_t)(s0 - 30) * DM;
#pragma unroll
    for (int r = 0; r < 46; ++r) { const int si = s0 + r - 30; uu[r] = si >= 0 ? *(const unsigned*)gp : 0u; gp += DM; OPAQUE(gp); } }
    const float* dwp = dw;
#pragma unroll
    for (int j = 0; j < 31; ++j) { const float w0 = dwp[0], w1 = dwp[1]; dwp += DM; OPAQUE(dwp);
#pragma unroll
        for (int t = 0; t < 16; ++t) { const unsigned q = uu[t + j]; acc[t][0] += w0 * bf2f(q & 0xffff); acc[t][1] += w1 * bf2f(q >> 16); } }
    float mean[16], rstd[16];
    SYNC();
#pragma unroll
    for (int t = 0; t < 16; ++t) { float s = act ? acc[t][0] + acc[t][1] : 0.f;
#pragma unroll
        for (int o = 1; o < 64; o <<= 1) s += shflx(s, o);
        if (lane == 0) red[w * 16 + t] = s; }
    SYNC();
#pragma unroll
    for (int t = 0; t < 16; ++t) { float s = 0.f;
#pragma unroll
        for (int q = 0; q < 8; ++q) s += red[q * 16 + t];
        mean[t] = s * (1.0f / DM); }
    SYNC();
#pragma unroll
    for (int t = 0; t < 16; ++t) { const float d0 = acc[t][0] - mean[t], d1 = acc[t][1] - mean[t]; float s = act ? d0 * d0 + d1 * d1 : 0.f;
#pragma unroll
        for (int o = 1; o < 64; o <<= 1) s += shflx(s, o);
        if (lane == 0) red[w * 16 + t] = s; }
    SYNC();
#pragma unroll
    for (int t = 0; t < 16; ++t) { float s = 0.f;
#pragma unroll
        for (int q = 0; q < 8; ++q) s += red[q * 16 + t];
        rstd[t] = frsq(s * (1.0f / DM) + EPS); }
    if (act) {
        const float g0 = INP(a, I_LNG)[li * DM + c0], g1 = INP(a, I_LNG)[li * DM + c0 + 1], e0 = INP(a, I_LNB)[li * DM + c0], e1 = INP(a, I_LNB)[li * DM + c0 + 1];
        bf16* dst = (bf16*)(ws + WS_CAT) + (size_t)t0 * DM + c0;
#pragma unroll
        for (int t = 0; t < 16; ++t) { const float y0 = (acc[t][0] - mean[t]) * rstd[t] * g0 + e0, y1 = (acc[t][1] - mean[t]) * rstd[t] * g1 + e1;
            *(unsigned*)(dst + (size_t)t * DM) = pk2(siluf(y0), siluf(y1)); }
    }
}

constexpr int N_PHASES = 1 + 16 * (DEPTH / 2) + 1;
DEV void phase_decode(int ph, int& l, int& sub) {
    const int q = ph - 1, pair = q >> 4, r = q & 15;
    if (r < 9) { l = 2 * pair; sub = r; } else { l = 2 * pair + 1; const int rr = r - 9; sub = rr < 3 ? rr : rr + 2; }
}
constexpr int LDS_BYTES = 150 * 1024;

DEV void run_phase(const Args& a, unsigned char* smem, int ph) {
#ifndef ONLY
#define ONLY -1
#endif
#define EN(k) (ONLY < 0 || ONLY == (k))
    if (ph == 0) { if (EN(100)) p0_phase(a, smem); return; }
    if (ph == N_PHASES - 1) { if (EN(0)) norm_phase(a, smem, DEPTH); return; }
    int l, sub; phase_decode(ph, l, sub); const int li = l >> 1; const bool even = (l & 1) == 0;
    unsigned char* ws = wsp(a);
    switch (sub) {
    case 0: if (EN(0)) norm_phase(a, smem, l); break;
    case 1: if (even) { if (EN(1)) inproj_phase(a, smem, li); } else { if (EN(11)) pw1_phase(a, smem, li); } break;
    case 2:
        if (even) { constexpr int NCI = 8 * ((NCP + 255) / 256); constexpr int NH1 = 8 * NCH;
            for (int it = BID; it < NCI + NH1; it += NBLK) { if (it < NCI) { if (EN(2)) cmp_phase_items(a, smem, li, it); } else { if (EN(12)) hg_h1_task(a, smem, it - NCI); } } }
        else { for (int it = BID; it < T / 16; it += NBLK) if (EN(13)) conv_task(a, smem, li, it); }
        break;
    case 3:
        if (even) { constexpr int NA = 4 * (SEQ / 32); const int G = NBLK;
            for (int r = 0; r * G < NA; ++r) { const int it = r * G + ((r & 1) ? (G - 1 - BID) : BID); if (it < NA) { if (EN(3)) attn_task(a, smem, li, it); } }
            for (int it = BID; it < 64; it += NBLK) if (EN(14)) hg_scan_task(a, it); }
        break;
    case 4: if (even) { for (int it = BID; it < 8 * NCH; it += NBLK) if (EN(4)) hg_h3_task(a, smem, li, it); } break;
    case 5:
        if (!EN(5)) break;
        if (even) resid_gemm_phase(a, smem, (const bf16*)(ws + WS_CAT), 1024, INP(a, I_WOUT) + (size_t)li * 1024 * DM, l);
        else resid_gemm_phase(a, smem, (const bf16*)(ws + WS_CAT), DM, INP(a, I_PW2) + (size_t)li * DM * DM, l);
        break;
    case 6: if (EN(6)) route_phase(a, smem, l); break;
    case 7: if (EN(7)) moe_gemm_phase(a, smem, l, 0); break;
    case 8: if (EN(8)) moe_gemm_phase(a, smem, l, 1); break;
    }
}

#ifndef EMU
#define LAS __attribute__((address_space(3)))
#define XB_TMO      128
#define XB_XCNT(j)  (256  + 64 * (j))
#define XB_XSUB(j)  (1280 + 64 * (j))
#define XB_XGEN(j)  (2304 + 64 * (j))
#define XB_TOP      3328
#define XB_TOPGEN   3392
#define XCD_BAR_WORDS 3456
#define XB_SPIN_CAP (1u << 22)
__device__ __forceinline__ unsigned xb_ld(unsigned* p)              { return __hip_atomic_load(p, __ATOMIC_RELAXED, __HIP_MEMORY_SCOPE_AGENT); }
__device__ __forceinline__ unsigned xb_add(unsigned* p, unsigned v) { return __hip_atomic_fetch_add(p, v, __ATOMIC_RELAXED, __HIP_MEMORY_SCOPE_AGENT); }
__device__ __forceinline__ unsigned xb_xcc_id() { return (unsigned)__builtin_amdgcn_s_getreg((3 << 11) | 20) & 0xFu; }
#define XB_SPIN(cond, bar) do { unsigned _sp = 0; while (cond) { __builtin_amdgcn_s_sleep(1); \
    if ((++_sp & 255u) == 0u) { if (xb_ld(&(bar)[XB_TMO])) break; if (_sp > XB_SPIN_CAP) { atomicAdd(&(bar)[XB_TMO], 1u); break; } } } } while (0)
struct XcdBarrier { unsigned* bar; unsigned x; volatile LAS unsigned* st; };
__device__ __forceinline__ XcdBarrier xcd_barrier_post(unsigned* bar, volatile LAS unsigned* st) {
    XcdBarrier b; b.bar = bar; b.x = xb_xcc_id(); b.st = st;
    if (threadIdx.x == 0) (void)xb_add(&bar[XB_XCNT(b.x)], 1u);
    return b;
}
__device__ __forceinline__ void xcd_barrier_complete(unsigned* bar, unsigned x, unsigned& nloc, unsigned& nx) {
    const unsigned G = gridDim.x * gridDim.y * gridDim.z;
    unsigned sum, cnt, mine, sp = 0u;
    for (;;) {
        sum = 0u; cnt = 0u; mine = 0u;
#pragma unroll
        for (unsigned j = 0; j < 16; ++j) { const unsigned c = xb_ld(&bar[XB_XCNT(j)]); sum += c; cnt += (c > 0u) ? 1u : 0u; mine = (j == x) ? c : mine; }
        if (sum == G) break;
        __builtin_amdgcn_s_sleep(1);
        if ((++sp & 255u) == 0u) { if (xb_ld(&bar[XB_TMO])) break; if (sp > XB_SPIN_CAP) { atomicAdd(&bar[XB_TMO], 1u); break; } }
    }
    nloc = mine > 0u ? mine : 1u; nx = cnt > 0u ? cnt : 1u;
}
__device__ __forceinline__ void xcd_barrier(const XcdBarrier& b) {
    asm volatile("s_waitcnt vmcnt(0)" ::: "memory");
    __syncthreads();
    if (threadIdx.x == 0) {
        unsigned* bar = b.bar;
        __builtin_amdgcn_s_waitcnt(0);
        unsigned nloc = b.st[0], nx = b.st[1];
        if (nloc == 0u) { xcd_barrier_complete(bar, b.x, nloc, nx); b.st[0] = nloc; b.st[1] = nx; }
        const unsigned old = xb_add(&bar[XB_XSUB(b.x)], 1u);
        const unsigned gen = old / nloc;
        if (old + 1u == (gen + 1u) * nloc) {
            __builtin_amdgcn_fence(__ATOMIC_RELEASE, "agent");
            asm volatile("s_waitcnt vmcnt(0)" ::: "memory");
            const unsigned og = xb_add(&bar[XB_TOP], 1u);
            const unsigned tg = og / nx;
            if (og + 1u == (tg + 1u) * nx) xb_add(&bar[XB_TOPGEN], 1u);
            else XB_SPIN(xb_ld(&bar[XB_TOPGEN]) == tg, bar);
            __builtin_amdgcn_fence(__ATOMIC_ACQUIRE, "agent");
            xb_add(&bar[XB_XGEN(b.x)], 1u);
            asm volatile("s_waitcnt vmcnt(0)" ::: "memory");
        } else {
            XB_SPIN(xb_ld(&bar[XB_XGEN(b.x)]) == gen, bar);
            __builtin_amdgcn_fence(__ATOMIC_ACQUIRE, "agent");
            asm volatile("s_waitcnt vmcnt(0)" ::: "memory");
        }
    }
    __syncthreads();
}

__global__ void __launch_bounds__(NT, 2) mega(Args a) {
    extern __shared__ __attribute__((aligned(16))) unsigned char lds[];
    volatile LAS unsigned* st = (volatile LAS unsigned*)(LAS unsigned char*)(lds + LDS_BYTES - 16);
    if (threadIdx.x < 4) st[threadIdx.x] = 0u;
    __syncthreads();
    unsigned* barw = (unsigned*)(a.ws + WS_BAR);
    XcdBarrier bar = xcd_barrier_post(barw, st);
#pragma unroll 1
    for (int ph = 0; ph < N_PHASES; ++ph) {
        run_phase(a, lds, ph);
#ifdef DUP
        { int lyr = 0, sub = 100; if (ph > 0 && ph < N_PHASES - 1) phase_decode(ph, lyr, sub);
          if (sub == (DUP % 1000) && (ph == 0 || lyr == DUP / 1000) && ph < N_PHASES - 1) { xcd_barrier(bar); run_phase(a, lds, ph); } }
#endif
        if (ph + 1 < N_PHASES) xcd_barrier(bar);
    }
    if (xb_ld(&barw[XB_TMO]) != 0u) {
        const size_t gt = (size_t)blockIdx.x * NT + threadIdx.x, gs = (size_t)gridDim.x * NT;
        for (size_t i = gt; i < (size_t)T * DM; i += gs) a.out[i] = __builtin_nanf("");
    }
}

extern "C" void kernel_launch(void* const* d_in, const int* in_sizes, int n_in, void* d_out, int out_size,
                              void* d_ws, size_t ws_size, hipStream_t stream) {
    static int grid = 0;
    if (grid == 0) {
        int dev = 0, cus = 0;
        if (hipGetDevice(&dev) != hipSuccess || hipDeviceGetAttribute(&cus, hipDeviceAttributeMultiprocessorCount, dev) != hipSuccess) { grid = -1; return; }
        if (hipFuncSetAttribute((const void*)mega, hipFuncAttributeMaxDynamicSharedMemorySize, LDS_BYTES) != hipSuccess) { grid = -1; return; }
        (void)hipGetLastError();
        grid = cus;
        if (n_in != 26 || out_size != T * DM || ws_size < WS_END) { fprintf(stderr, "kernel_launch: unexpected sizes n_in %d out %d ws %zu (need %zu)\n", n_in, out_size, ws_size, (size_t)WS_END); grid = -1; return; }
    }
    if (grid < 0) return;
    (void)hipMemsetAsync((unsigned char*)d_ws + WS_BAR, 0, XCD_BAR_WORDS * 4, stream);
    Args a{};
    for (int i = 0; i < 26; ++i) a.in[i] = (const float*)d_in[i];
    a.out = (float*)d_out; a.ws = (unsigned char*)d_ws;
    hipLaunchKernelGGL(mega, dim3(grid), dim3(NT), LDS_BYTES, stream, a);
}
#endif
```

```cpp
#ifdef EMU
#include "emu.h"
#define DEV static inline
#define MDEV inline
#define OPAQUE(p)
#define TID emu_tid()
#define BID (EB->bid)
#define NBLK (EB->nblk)
#define SYNC() emu_sync_block()
#define WSYNC() emu_sync_wave()
#define mfma16(a, b, c) emu_mfma16(a, b, c)
DEV float shflx(float v, int m) { return emu_shfl_f(v, (emu_tid() & 63) ^ m); }
DEV int shflxi(int v, int m) { return (int)emu_shfl_u((unsigned)v, (emu_tid() & 63) ^ m); }
DEV float shfl(float v, int s) { return emu_shfl_f(v, s); }
DEV int atomic_add_i(int* p, int v) { return __atomic_fetch_add(p, v, __ATOMIC_RELAXED); }
DEV float fexp2(float x) { return exp2f(x); }
DEV float frcp(float x) { return 1.0f / x; }
DEV float frsq(float x) { return 1.0f / sqrtf(x); }
typedef short s16x4 __attribute__((vector_size(8)));
static inline s16x4 emu_tr4(const unsigned short* p) {
    EmuWave& w = EB->wave[emu_tid() >> 6]; int l = emu_tid() & 63;
    const unsigned short** tab = (const unsigned short**)w.a;
    tab[l] = p; emu_sync_wave();
    s16x4 r; int g = l & 48, i = l & 15;
    for (int q = 0; q < 4; ++q) r[q] = (short)tab[g + 4 * q + (i >> 2)][i & 3];
    emu_sync_wave(); return r;
}
#define tr4(p) emu_tr4(p)
#else
#include <hip/hip_runtime.h>
#include <cstdio>
#include <cstdint>
typedef short bf16x8 __attribute__((ext_vector_type(8)));
typedef float f32x4 __attribute__((ext_vector_type(4)));
typedef unsigned u32x4 __attribute__((ext_vector_type(4)));
typedef unsigned u32x2 __attribute__((ext_vector_type(2)));
#define DEV __device__ __forceinline__
#define MDEV __device__ __forceinline__
#define OPAQUE(p) asm volatile("" : "+v"(p))
DEV int tid_opaque() { int t = (int)threadIdx.x; asm volatile("" : "+v"(t)); return t; }
#define TID tid_opaque()
#define BID ((int)blockIdx.x)
#define NBLK ((int)gridDim.x)
#define SYNC() __syncthreads()
#define WSYNC() __builtin_amdgcn_wave_barrier()
#define mfma16(a, b, c) __builtin_amdgcn_mfma_f32_16x16x32_bf16(a, b, c, 0, 0, 0)
DEV float shflx(float v, int m) { return __shfl_xor(v, m); }
DEV int shflxi(int v, int m) { return __shfl_xor(v, m); }
DEV float shfl(float v, int s) { return __shfl(v, s); }
DEV int atomic_add_i(int* p, int v) { return atomicAdd(p, v); }
DEV float fexp2(float x) { return exp2f(x); }
DEV float frcp(float x) { return 1.0f / x; }
DEV float frsq(float x) { return rsqrtf(x); }
typedef short s16x4 __attribute__((ext_vector_type(4)));
#define tr4(p) __builtin_amdgcn_ds_read_tr16_b64_v4i16((__attribute__((address_space(3))) s16x4*)(p))
#endif

typedef unsigned short bf16;

#ifndef DM
#define DM 1024
#endif
#ifndef SEQ
#define SEQ 8192
#endif
#ifndef FF
#define FF 512
#endif
constexpr int NBATCH = 2, T = NBATCH * SEQ, DEPTH = 4;
constexpr int NIN = 3352, NINP = 3456;
constexpr int NT = 512;
constexpr int NCH = SEQ / 64;
constexpr int NCP = SEQ / 16;
constexpr int NCMP = NCP - 1;
constexpr int MOE_ROWS = 2 * T + 32 * 256;
constexpr float EPS = 1e-6f, NEGV = -1e30f, FORCEV = 1e4f, LOG2E = 1.4426950408889634f;

constexpr size_t al(size_t x) { return (x + 255) & ~(size_t)255; }
constexpr size_t WS_BAR = 0;
constexpr size_t WS_CNT = 16384;
constexpr size_t WS_MOD = WS_CNT + (size_t)DEPTH * 32 * 256;
constexpr size_t WS_LB = al(WS_MOD + (size_t)DEPTH * 2 * 6 * DM * 4);
constexpr size_t WS_CB = al(WS_LB + 2 * 512 * 4);
constexpr size_t WS_CS = al(WS_CB + 2 * 2 * 8 * 64 * 4);
constexpr size_t WS_WIN = al(WS_CS + 64);
constexpr size_t WS_WOUT = al(WS_WIN + (size_t)2 * NINP * DM * 2);
constexpr size_t WS_PW1 = al(WS_WOUT + (size_t)2 * DM * 1024 * 2);
constexpr size_t WS_PW2 = al(WS_PW1 + (size_t)2 * 2 * DM * DM * 2);
constexpr size_t WS_WC = al(WS_PW2 + (size_t)2 * DM * DM * 2);
constexpr size_t WS_W13 = al(WS_WC + (size_t)2 * 2 * 64 * 2048 * 2);
constexpr size_t WS_W2 = al(WS_W13 + (size_t)DEPTH * 32 * 2 * FF * DM * 2);
constexpr size_t WS_H = al(WS_W2 + (size_t)DEPTH * 32 * DM * FF * 2);
constexpr size_t WS_QN = al(WS_H + (size_t)T * DM * 2);
constexpr size_t WS_KCG = al(WS_QN + (size_t)T * 512 * 2);
constexpr size_t WS_VCG = al(WS_KCG + (size_t)T * 128 * 2);
constexpr size_t WS_KS = al(WS_VCG + (size_t)T * 128 * 2);
constexpr size_t WS_KW = al(WS_KS + (size_t)T * 128 * 2);
constexpr size_t WS_VST = al(WS_KW + (size_t)T * 128 * 2);
constexpr size_t WS_VWT = al(WS_VST + (size_t)T * 128 * 2);
constexpr size_t WS_KC = al(WS_VWT + (size_t)T * 128 * 2);
constexpr size_t WS_VCT = al(WS_KC + (size_t)4 * NCP * 64 * 2);
constexpr size_t WS_GATE = al(WS_VCT + (size_t)4 * NCP * 64 * 2);
constexpr size_t WS_HQ = al(WS_GATE + (size_t)T * 24 * 4);
constexpr size_t WS_HF = al(WS_HQ + (size_t)T * 512 * 2);
constexpr size_t WS_HV = al(WS_HF + (size_t)T * 512 * 4);
constexpr size_t WS_HGS = al(WS_HV + (size_t)T * 512 * 2);
constexpr size_t WS_UT = al(WS_HGS + (size_t)T * 512 * 2);
constexpr size_t WS_ST = al(WS_UT + (size_t)8 * NCH * 128 * 128 * 4);
constexpr size_t WS_GD = al(WS_ST + (size_t)8 * NCH * 128 * 128 * 2);
constexpr size_t WS_CAT = al(WS_GD + (size_t)8 * NCH * 128 * 4);
constexpr size_t WS_GLU = al(WS_CAT + (size_t)T * 1024 * 2);
constexpr size_t WS_TIE = al(WS_GLU + (size_t)T * DM * 2);
constexpr size_t WS_TIW = al(WS_TIE + (size_t)T * 2 * 4);
constexpr size_t WS_LIST = al(WS_TIW + (size_t)T * 2 * 4);
constexpr size_t WS_ACT = al(WS_LIST + (size_t)32 * T * 4);
constexpr size_t WS_YK = al(WS_ACT + (size_t)MOE_ROWS * FF * 2);
constexpr size_t WS_END = al(WS_YK + (size_t)MOE_ROWS * DM * 2);

struct Args { const float* in[26]; float* out; unsigned char* ws; };
enum { I_X = 0, I_C, I_ADAW, I_ADAB, I_NMIX, I_NFFN, I_WIN, I_WOUT, I_CWK, I_CWV, I_CPE, I_QG, I_KG, I_LBL, I_OG,
       I_PW1, I_DW, I_DWB, I_LNG, I_LNB, I_PW2, I_WG, I_WE, I_W1, I_W3, I_W2 };

#ifdef EMU
DEV unsigned char* wsp(const Args& a) { return a.ws; }
DEV float* outp(const Args& a) { return a.out; }
#else
DEV unsigned char* wsp(const Args& a) { int z = 0; asm volatile("" : "+s"(z)); return a.ws + z; }
DEV float* outp(const Args& a) { int z = 0; asm volatile("" : "+s"(z)); return a.out + z; }
#endif

#ifdef EMU
#define INP(a, X) ((a).in[X])
#else
DEV int zero_opaque() { int z = 0; asm volatile("" : "+s"(z)); return z; }
#define INP(a, X) ((a).in[(X) + zero_opaque()])
#endif

DEV unsigned f2bf(float f) { unsigned u = __builtin_bit_cast(unsigned, f); return (u + 0x7fffu + ((u >> 16) & 1u)) >> 16; }
DEV float bf2f(unsigned h) { return __builtin_bit_cast(float, h << 16); }
#ifdef EMU
DEV unsigned pk2(float lo, float hi) { return f2bf(lo) | (f2bf(hi) << 16); }
#else
typedef float f32x2_t __attribute__((ext_vector_type(2)));
typedef __bf16 bf16x2_t __attribute__((ext_vector_type(2)));
DEV unsigned pk2(float lo, float hi) { f32x2_t v = {lo, hi}; bf16x2_t b = __builtin_convertvector(v, bf16x2_t); return __builtin_bit_cast(unsigned, b); }
#endif
DEV float sigm(float x) { return frcp(1.0f + fexp2(-x * LOG2E)); }
DEV float siluf(float x) { return x * sigm(x); }
DEV f32x4 f4zero() { f32x4 z = {0.f, 0.f, 0.f, 0.f}; return z; }
DEV bf16x8 pack8(f32x4 a, f32x4 b) {
    u32x4 w; w[0] = pk2(a[0], a[1]); w[1] = pk2(a[2], a[3]); w[2] = pk2(b[0], b[1]); w[3] = pk2(b[2], b[3]);
    return __builtin_bit_cast(bf16x8, w);
}
DEV void st_bf4(bf16* p, f32x4 v) { u32x2 w; w[0] = pk2(v[0], v[1]); w[1] = pk2(v[2], v[3]); *(u32x2*)p = w; }

constexpr int LDT = 72;
constexpr int GEMM_AS = 256 * LDT, GEMM_BS = 128 * LDT;
constexpr int GEMM_LDS = 2 * (GEMM_AS + GEMM_BS) * 2;

template <class AF, class EPI>
DEV void gemm_tile(unsigned char* smem, AF af, const bf16* Bt, int ldb, int nvalid, int K, EPI& epi) {
    const int tid = TID, w = tid >> 6, l = tid & 63, h = l >> 4, c = l & 15, wm = w >> 1, wn = w & 1;
    bf16* As = (bf16*)smem; bf16* Bs = As + 2 * GEMM_AS;
    const bf16* ap[4]; const bf16* bp[2];
    const int col8 = (tid & 7) * 8, r0 = tid >> 3;
#pragma unroll
    for (int i = 0; i < 4; ++i) ap[i] = af(r0 + 64 * i) + col8;
#pragma unroll
    for (int i = 0; i < 2; ++i) { int rn = r0 + 64 * i; if (rn >= nvalid) rn = nvalid - 1; bp[i] = Bt + (size_t)rn * ldb + col8; }
    f32x4 acc[4][4];
#pragma unroll
    for (int i = 0; i < 4; ++i)
#pragma unroll
        for (int j = 0; j < 4; ++j) acc[i][j] = f4zero();
    bf16x8 ra[4], rb[2];
#pragma unroll
    for (int i = 0; i < 4; ++i) ra[i] = *(const bf16x8*)(ap[i]);
#pragma unroll
    for (int i = 0; i < 2; ++i) rb[i] = *(const bf16x8*)(bp[i]);
    SYNC();
#pragma unroll
    for (int i = 0; i < 4; ++i) *(bf16x8*)(As + (r0 + 64 * i) * LDT + col8) = ra[i];
#pragma unroll
    for (int i = 0; i < 2; ++i) *(bf16x8*)(Bs + (r0 + 64 * i) * LDT + col8) = rb[i];
    SYNC();
    const int nk = K / 64;
    for (int kt = 0; kt < nk; ++kt) {
        const int cur = kt & 1;
        if (kt + 1 < nk) {
#pragma unroll
            for (int i = 0; i < 4; ++i) ra[i] = *(const bf16x8*)(ap[i] + (kt + 1) * 64);
#pragma unroll
            for (int i = 0; i < 2; ++i) rb[i] = *(const bf16x8*)(bp[i] + (kt + 1) * 64);
        }
        const bf16* Ac = As + cur * GEMM_AS + (wm * 64 + c) * LDT + 8 * h;
        const bf16* Bc = Bs + cur * GEMM_BS + (wn * 64 + c) * LDT + 8 * h;
#pragma unroll
        for (int kk = 0; kk < 2; ++kk) {
            bf16x8 fa[4], fb[4];
#pragma unroll
            for (int i = 0; i < 4; ++i) { fa[i] = *(const bf16x8*)(Ac + i * 16 * LDT + kk * 32); fb[i] = *(const bf16x8*)(Bc + i * 16 * LDT + kk * 32); }
#pragma unroll
            for (int ni = 0; ni < 4; ++ni)
#pragma unroll
                for (int mi = 0; mi < 4; ++mi) acc[ni][mi] = mfma16(fb[ni], fa[mi], acc[ni][mi]);
        }
        if (kt + 1 < nk) {
            const int nx = cur ^ 1;
#pragma unroll
            for (int i = 0; i < 4; ++i) *(bf16x8*)(As + nx * GEMM_AS + (r0 + 64 * i) * LDT + col8) = ra[i];
#pragma unroll
            for (int i = 0; i < 2; ++i) *(bf16x8*)(Bs + nx * GEMM_BS + (r0 + 64 * i) * LDT + col8) = rb[i];
        }
        SYNC();
    }
    epi(acc, wm * 64, wn * 64, h, c);
}

struct ARows { const bf16* base; size_t ld; MDEV const bf16* operator()(int r) const { return base + (size_t)r * ld; } MDEV unsigned off(int r) const { return (unsigned)r * (unsigned)ld; } };

constexpr int LDB = 144;
constexpr int GEMM_BS2 = 64 * LDB;
constexpr int GEMM2_LDS = (2 * GEMM_AS + 2 * GEMM_BS2) * 2;
DEV bf16x8 tr_read8(const bf16* p0, const bf16* p1) {
    const s16x4 x = tr4(p0), y = tr4(p1); bf16x8 r;
    r[0] = x[0]; r[1] = x[1]; r[2] = x[2]; r[3] = x[3]; r[4] = y[0]; r[5] = y[1]; r[6] = y[2]; r[7] = y[3]; return r;
}
DEV int bperm(int r) { return (r & ~12) | ((r & 4) << 1) | ((r & 8) >> 1); }
template <class AF, class BF, class EPI>
DEV void gemm_tile2(unsigned char* smem, AF af, BF bf, int ldb, int K, EPI& epi) {
    const int tid = TID, w = tid >> 6, l = tid & 63, h = l >> 4, c = l & 15, wm = w >> 1, wn = w & 1, grp = w >> 2;
    bf16* As = (bf16*)smem; bf16* Bs = As + 2 * GEMM_AS;
    const bf16* abase = af.base; unsigned ao[4];
    const int col8 = (tid & 7) * 8, r0 = tid >> 3;
#pragma unroll
    for (int i = 0; i < 4; ++i) ao[i] = af.off(r0 + 64 * i) + col8;
    const int bn4 = (tid & 31) * 4, bk = tid >> 5, bkp = bperm(bk);
    const float* bp = bf(bn4); const bool bok = bp != nullptr;
    if (bok) bp += (size_t)bk * ldb;
    const size_t bstep = (size_t)16 * ldb;
    f32x4 acc[4][4];
#pragma unroll
    for (int i = 0; i < 4; ++i)
#pragma unroll
        for (int j = 0; j < 4; ++j) acc[i][j] = f4zero();
    bf16x8 ra[2][4]; f32x4 rb[2][4];
    const int nk = K / 64;
#pragma unroll
    for (int i = 0; i < 4; ++i) { ra[0][i] = *(const bf16x8*)(abase + ao[i]); rb[0][i] = bok ? *(const f32x4*)(bp + i * bstep) : f4zero(); }
    if (nk > 1) {
#pragma unroll
        for (int i = 0; i < 4; ++i) { ra[1][i] = *(const bf16x8*)(abase + (ao[i] + 64)); rb[1][i] = bok ? *(const f32x4*)(bp + (size_t)64 * ldb + i * bstep) : f4zero(); } }
    SYNC();
#pragma unroll
    for (int i = 0; i < 4; ++i) { *(bf16x8*)(As + (r0 + 64 * i) * LDT + col8) = ra[0][i]; st_bf4(Bs + (bkp + 16 * i) * LDB + bn4, rb[0][i]); }
    if (nk > 2) {
#pragma unroll
        for (int i = 0; i < 4; ++i) { ra[0][i] = *(const bf16x8*)(abase + (ao[i] + 128)); rb[0][i] = bok ? *(const f32x4*)(bp + (size_t)128 * ldb + i * bstep) : f4zero(); } }
    SYNC();
    for (int kb = 0; kb < nk; kb += 2) {
#pragma unroll
        for (int u = 0; u < 2; ++u) { const int kt = kb + u;
            if (kt < nk) {
#pragma unroll
                for (int p = 0; p < 2; ++p) {
                    if (grp == p) {
                        const bf16* Ac = As + u * GEMM_AS + (wm * 64 + c) * LDT + 8 * h;
                        const bf16* Bc = Bs + u * GEMM_BS2 + bperm(8 * h + (c >> 2)) * LDB + wn * 64 + 4 * (c & 3);
#pragma unroll
                        for (int kk = 0; kk < 2; ++kk) {
                            bf16x8 fa[4], fb[4];
#pragma unroll
                            for (int i = 0; i < 4; ++i) { fa[i] = *(const bf16x8*)(Ac + i * 16 * LDT + kk * 32); fb[i] = tr_read8(Bc + (32 * kk) * LDB + 16 * i, Bc + (32 * kk + 8) * LDB + 16 * i); }
#pragma unroll
                            for (int ni = 0; ni < 4; ++ni)
#pragma unroll
                                for (int mi = 0; mi < 4; ++mi) acc[ni][mi] = mfma16(fb[ni], fa[mi], acc[ni][mi]);
                        }
                    } else if (kt + 1 < nk) {
                        const int nx = u ^ 1;
#pragma unroll
                        for (int i = 0; i < 4; ++i) { *(bf16x8*)(As + nx * GEMM_AS + (r0 + 64 * i) * LDT + col8) = ra[nx][i]; st_bf4(Bs + nx * GEMM_BS2 + (bkp + 16 * i) * LDB + bn4, rb[nx][i]); }
                        if (kt + 3 < nk) {
#pragma unroll
                            for (int i = 0; i < 4; ++i) { ra[nx][i] = *(const bf16x8*)(abase + (ao[i] + (kt + 3) * 64)); rb[nx][i] = bok ? *(const f32x4*)(bp + (size_t)(kt + 3) * 64 * ldb + i * bstep) : f4zero(); } }
                    }
                    SYNC();
                }
            }
        }
    }
    epi(acc, wm * 64, wn * 64, h, c);
}
struct BPlain { const float* base; MDEV const float* operator()(int nt) const { return base + nt; } };
struct BInProjMap { const float* base; int n0; MDEV const float* operator()(int nt) const { const int n = n0 + nt; const int sc = n < 1280 ? n : (n < 3328 ? n + 24 : (n < 3352 ? 1280 + (n - 3328) : -1)); return sc < 0 ? nullptr : base + sc; } };
struct BInter { const float* s0; const float* s1; int n0; MDEV const float* operator()(int nt) const { const int n = n0 + nt, g = n >> 6, w = n & 63; return w < 32 ? s0 + g * 32 + w : s1 + g * 32 + w - 32; } };
struct BClamp64 { const float* base; MDEV const float* operator()(int nt) const { return base + (nt & 63); } };

struct EpiInProj {
    const Args* a; int m0, n0, li;
    MDEV void operator()(f32x4 (&acc)[4][4], int mw, int nw, int h, int c) const {
        unsigned char* ws = wsp(*a);
        const int nb = n0 + nw;
        const int tokb = m0 + mw + c;
        if (nb < 512 || (nb >= 768 && nb < 896) || (nb >= 1024 && nb < 1152)) {
            const float* gain; float mul = 1.f; bf16* dst; int kind;
            if (nb < 512) { gain = INP(*a, I_QG) + li * 64; mul = 0.125f * LOG2E; kind = 0; dst = (bf16*)(ws + WS_QN); }
            else if (nb < 896) { gain = INP(*a, I_KG) + (li * 3 + 1) * 64; kind = 1; dst = (bf16*)(ws + WS_KS); }
            else { gain = INP(*a, I_KG) + (li * 3 + 2) * 64; kind = 1; dst = (bf16*)(ws + WS_KW); }
            const int g = (nb >> 6) & 1;
#pragma unroll
            for (int mi = 0; mi < 4; ++mi) {
                float ss = 0.f;
#pragma unroll
                for (int ni = 0; ni < 4; ++ni) { f32x4 v = acc[ni][mi]; ss += v[0] * v[0] + v[1] * v[1] + v[2] * v[2] + v[3] * v[3]; }
                ss += shflx(ss, 16); ss += shflx(ss, 32);
                const float rs = frsq(ss * (1.0f / 64.0f) + EPS) * mul;
                const int tok = tokb + 16 * mi;
#pragma unroll
                for (int ni = 0; ni < 4; ++ni) {
                    const int d = 16 * ni + 4 * h; f32x4 v = acc[ni][mi], o;
#pragma unroll
                    for (int r = 0; r < 4; ++r) o[r] = v[r] * rs * gain[d + r];
                    if (kind == 0) st_bf4(dst + (size_t)tok * 512 + nb + d, o);
                    else { const int b = tok / SEQ, s = tok % SEQ; st_bf4(dst + ((size_t)(b * 2 + g) * SEQ + s) * 64 + d, o); }
                }
            }
        } else if (nb < 768) {
            bf16* dst = (bf16*)(ws + (nb < 640 ? WS_KCG : WS_VCG)); const int g = (nb >> 6) & 1;
#pragma unroll
            for (int mi = 0; mi < 4; ++mi) { const int tok = tokb + 16 * mi, b = tok / SEQ, s = tok % SEQ;
#pragma unroll
                for (int ni = 0; ni < 4; ++ni) st_bf4(dst + ((size_t)(b * 2 + g) * SEQ + s) * 64 + 16 * ni + 4 * h, acc[ni][mi]); }
        } else if (nb < 1280) {
            bf16* dst = (bf16*)(ws + (nb < 1024 ? WS_VST : WS_VWT)); const int g = (nb >> 6) & 1;
#pragma unroll
            for (int mi = 0; mi < 4; ++mi) { const int tok = tokb + 16 * mi, b = tok / SEQ, s = tok % SEQ;
                bf16* p = dst + ((size_t)(b * 2 + g) * NCH + (s >> 6)) * 4096 + (s & 63);
#pragma unroll
                for (int ni = 0; ni < 4; ++ni)
#pragma unroll
                    for (int r = 0; r < 4; ++r) p[(16 * ni + 4 * h + r) * 64] = (bf16)f2bf(acc[ni][mi][r]); }
        } else if (nb < 3328) {
            const int sec = (nb - 1280) >> 9, cc = (nb - 1280) & 511, hh = cc >> 7, d0 = cc & 127;
#pragma unroll
            for (int mi = 0; mi < 4; ++mi) { const int tok = tokb + 16 * mi, b = tok / SEQ, s = tok % SEQ;
                const size_t hrow = ((size_t)(b * 4 + hh) * SEQ + s) * 128 + d0;
#pragma unroll
                for (int ni = 0; ni < 4; ++ni) { const int d = 16 * ni + 4 * h; f32x4 v = acc[ni][mi], o;
                    if (sec == 0) { for (int r = 0; r < 4; ++r) o[r] = siluf(v[r]); st_bf4((bf16*)(ws + WS_HQ) + hrow + d, o); }
                    else if (sec == 1) { const float* lb = (const float*)(ws + WS_LB) + li * 512 + cc + d;
                        for (int r = 0; r < 4; ++r) o[r] = lb[r] + (1.0f - lb[r]) * sigm(v[r]);
                        *(f32x4*)((float*)(ws + WS_HF) + hrow + d) = o; }
                    else if (sec == 2) st_bf4((bf16*)(ws + WS_HV) + hrow + d, v);
                    else { for (int r = 0; r < 4; ++r) o[r] = siluf(v[r]); st_bf4((bf16*)(ws + WS_HGS) + (size_t)tok * 512 + cc + d, o); }
                } }
        } else if (nb == 3328) {
            float* dst = (float*)(ws + WS_GATE);
#pragma unroll
            for (int mi = 0; mi < 4; ++mi) { const int tok = tokb + 16 * mi;
#pragma unroll
                for (int ni = 0; ni < 2; ++ni)
#pragma unroll
                    for (int r = 0; r < 4; ++r) { const int n = 16 * ni + 4 * h + r; if (n < 24) dst[(size_t)tok * 24 + n] = sigm(acc[ni][mi][r]); } }
        }
    }
};

struct EpiResid {
    float* x; const float* gate; int m0, n0;
    MDEV void operator()(f32x4 (&acc)[4][4], int mw, int nw, int h, int c) const {
#pragma unroll
        for (int mi = 0; mi < 4; ++mi) { const int tok = m0 + mw + 16 * mi + c, b = tok / SEQ;
#pragma unroll
            for (int ni = 0; ni < 4; ++ni) { const int n = n0 + nw + 16 * ni + 4 * h;
                f32x4 g = *(const f32x4*)(gate + (size_t)b * 6 * DM + n); f32x4* p = (f32x4*)(x + (size_t)tok * DM + n); f32x4 v = *p;
#pragma unroll
                for (int r = 0; r < 4; ++r) v[r] += g[r] * acc[ni][mi][r];
                *p = v; } }
    }
};
template <int MODE> struct EpiGated {
    bf16* dst; size_t ld; int m0, n0, mvalid;
    MDEV void operator()(f32x4 (&acc)[4][4], int mw, int nw, int h, int c) const {
        const int cb = (n0 + nw) / 2;
#pragma unroll
        for (int mi = 0; mi < 4; ++mi) { const int m = mw + 16 * mi + c; if (m >= mvalid) continue;
#pragma unroll
            for (int ni = 0; ni < 2; ++ni) { f32x4 o;
#pragma unroll
                for (int r = 0; r < 4; ++r) { const float av = acc[ni][mi][r], bv = acc[ni + 2][mi][r]; o[r] = MODE == 0 ? av * sigm(bv) : siluf(av) * bv; }
                st_bf4(dst + (size_t)(m0 + m) * ld + cb + 16 * ni + 4 * h, o); } }
    }
};
struct EpiStoreBf {
    bf16* dst; size_t ld; int m0, n0, mvalid;
    MDEV void operator()(f32x4 (&acc)[4][4], int mw, int nw, int h, int c) const {
#pragma unroll
        for (int mi = 0; mi < 4; ++mi) { const int m = mw + 16 * mi + c; if (m >= mvalid) continue;
#pragma unroll
            for (int ni = 0; ni < 4; ++ni) st_bf4(dst + (size_t)(m0 + m) * ld + n0 + nw + 16 * ni + 4 * h, acc[ni][mi]); }
    }
};
struct EpiCmp {
    const Args* a; int kv, bg, m0, li;
    MDEV void operator()(f32x4 (&acc)[4][4], int mw, int nw, int h, int c) const {
        if (nw != 0) return;
        unsigned char* ws = wsp(*a);
        const float* bp8 = (const float*)(ws + WS_CB) + (li * 2 + kv) * 8 * 64;
        float bias[16];
#pragma unroll
        for (int q = 0; q < 16; ++q) { const int e = 16 * (q >> 2) + 4 * h + (q & 3); float v = 0.f;
#pragma unroll
            for (int kp = 0; kp < 8; ++kp) v += bp8[kp * 64 + e];
            bias[q] = v; }
        const float* gain = INP(*a, I_KG) + (li * 3 + 0) * 64;
#pragma unroll
        for (int mi = 0; mi < 4; ++mi) { const int n = m0 + mw + 16 * mi + c; const bool ok = n < NCMP;
            f32x4 v[4]; float ss = 0.f;
#pragma unroll
            for (int ni = 0; ni < 4; ++ni) { v[ni] = acc[ni][mi];
#pragma unroll
                for (int r = 0; r < 4; ++r) { v[ni][r] += bias[4 * ni + r]; ss += v[ni][r] * v[ni][r]; } }
            ss += shflx(ss, 16); ss += shflx(ss, 32);
            if (n >= NCP) continue;
            if (kv == 0) { const float rs = frsq(ss * (1.0f / 64.0f) + EPS); bf16* p = (bf16*)(ws + WS_KC) + ((size_t)bg * NCP + n) * 64;
#pragma unroll
                for (int ni = 0; ni < 4; ++ni) { f32x4 o;
#pragma unroll
                    for (int r = 0; r < 4; ++r) o[r] = ok ? v[ni][r] * rs * gain[16 * ni + 4 * h + r] : 0.f;
                    st_bf4(p + 16 * ni + 4 * h, o); }
            } else { bf16* p = (bf16*)(ws + WS_VCT) + (size_t)bg * 64 * NCP + n;
#pragma unroll
                for (int ni = 0; ni < 4; ++ni)
#pragma unroll
                    for (int r = 0; r < 4; ++r) p[(size_t)(16 * ni + 4 * h + r) * NCP] = (bf16)f2bf(ok ? v[ni][r] : 0.f); }
        }
    }
};

DEV void tr_tile(unsigned char* smem, const float* src0, const float* src1, int ld, int K, int mode, bf16* dst, int n0, int k0) {
    bf16* tl = (bf16*)smem;
    const int tid = TID;
    SYNC();
#pragma unroll
    for (int i = 0; i < 8; ++i) {
        const int e = tid + 512 * i, kk = e >> 6, nn = e & 63, n = n0 + nn; float v = 0.f;
        if (mode == 0) v = src0[(size_t)(k0 + kk) * ld + n];
        else if (mode == 1) { int sc = n < 1280 ? n : (n < 3328 ? n + 24 : (n < 3352 ? 1280 + (n - 3328) : -1)); if (sc >= 0) v = src0[(size_t)(k0 + kk) * ld + sc]; }
        else { const int g = n >> 6, w = n & 63; v = (w < 32) ? src0[(size_t)(k0 + kk) * ld + g * 32 + w] : src1[(size_t)(k0 + kk) * ld + g * 32 + w - 32]; }
        tl[nn * LDT + kk] = (bf16)f2bf(v);
    }
    SYNC();
    const int nn = tid >> 3, k8 = (tid & 7) * 8;
    *(bf16x8*)(dst + (size_t)(n0 + nn) * K + k0 + k8) = *(const bf16x8*)(tl + nn * LDT + k8);
}

struct TrJob { const float* s0; const float* s1; int ld, K, N, mode; bf16* dst; };
DEV void p0_phase(const Args& a, unsigned char* smem) {
    unsigned char* ws = wsp(a); const int tid = TID;
    {
        float* red = (float*)smem;
        constexpr int NG = 6 * DM / 128; const int ntask = DEPTH * NG;
        for (int t = BID; t < ntask; t += NBLK) {
            const int l = t / NG, j0 = (t % NG) * 128, cq = tid & 31, kr = tid >> 5;
            const float* w = INP(a, I_ADAW) + (size_t)l * DM * 6 * DM + j0 + 4 * cq; const float* cc = INP(a, I_C);
            f32x4 a0 = f4zero(), a1 = f4zero();
#pragma unroll 8
            for (int i = 0; i < DM / 16; ++i) { const int k = kr + 16 * i; const f32x4 wv = *(const f32x4*)(w + (size_t)k * 6 * DM); const float s0 = siluf(cc[k]), s1 = siluf(cc[DM + k]);
#pragma unroll
                for (int r = 0; r < 4; ++r) { a0[r] += s0 * wv[r]; a1[r] += s1 * wv[r]; } }
            SYNC();
            *(f32x4*)(red + (kr * 2 + 0) * 128 + 4 * cq) = a0; *(f32x4*)(red + (kr * 2 + 1) * 128 + 4 * cq) = a1;
            SYNC();
            if (tid < 256) { const int b = tid >> 7, col = tid & 127; float sum = INP(a, I_ADAB)[(size_t)l * 6 * DM + j0 + col];
#pragma unroll
                for (int q = 0; q < 16; ++q) sum += red[(q * 2 + b) * 128 + col];
                ((float*)(ws + WS_MOD))[((size_t)l * 2 + b) * 6 * DM + j0 + col] = sum; }
        }
    }
    for (int t = BID; t < 32; t += NBLK) {
        float* red = (float*)smem; const int ikv = t >> 3, kp = t & 7, i = ikv >> 1, kv = ikv & 1, e = tid & 63, ks = tid >> 6;
        const float* W = INP(a, kv ? I_CWV : I_CWK) + (size_t)i * 2048 * 64 + e; const float* pe = INP(a, I_CPE) + (size_t)i * 2048;
        float sum = 0.f;
#pragma unroll 8
        for (int q = 0; q < 32; ++q) { const int k = kp * 256 + ks * 32 + q; sum += pe[k] * W[(size_t)k * 64]; }
        SYNC(); red[ks * 64 + e] = sum; SYNC();
        if (tid < 64) { float v = 0.f; for (int q = 0; q < 8; ++q) v += red[q * 64 + tid]; ((float*)(ws + WS_CB))[(ikv * 8 + kp) * 64 + tid] = v; }
    }
    if (BID == 0) {
        for (int i = tid; i < DEPTH * 32; i += NT) ((int*)(ws + WS_CNT))[i * 64] = 0;
        for (int n = tid; n < 512; n += NT) { const float l0 = INP(a, I_LBL)[n], l1 = INP(a, I_LBL)[512 + n]; const float m = fmaxf(l0, l1);
            const float e0 = fexp2((l0 - m) * LOG2E), e1 = fexp2((l1 - m) * LOG2E);
            ((float*)(ws + WS_LB))[n] = 0.f; ((float*)(ws + WS_LB))[512 + n] = e1 / (e0 + e1); }
        if (tid < 2) { const int i = tid; float mq = 0.f; for (int d = 0; d < 64; ++d) mq = fmaxf(mq, fabsf(INP(a, I_QG)[i * 64 + d]));
            for (int br = 0; br < 3; ++br) { float mk = 0.f; for (int d = 0; d < 64; ++d) mk = fmaxf(mk, fabsf(INP(a, I_KG)[(i * 3 + br) * 64 + d]));
                ((float*)(ws + WS_CS))[i * 4 + br] = 8.0f * mq * mk * LOG2E; } }
    }
}

constexpr int NJV = DM / 256;
DEV void moe_bases(const int* cnt, int* rb  ) {
    if (TID == 0) { int acc = 0; for (int e = 0; e < 32; ++e) { rb[e] = acc; acc += ((cnt[e * 64] + 255) >> 8) << 8; } rb[32] = acc; }
    SYNC();
}
DEV void norm_phase(const Args& a, unsigned char* smem, int l) {
    unsigned char* ws = wsp(a); const int tid = TID, w = tid >> 6, lane = tid & 63;
    int* rb = (int*)smem;
    if (l > 0) moe_bases((const int*)(ws + WS_CNT) + (l - 1) * 32 * 64, rb);
    const float* mod = (const float*)(ws + WS_MOD);
    const bf16* yk = (const bf16*)(ws + WS_YK);
    for (int row = BID * 8 + w; row < T; row += NBLK * 8) {
        const int b = row / SEQ;
        f32x4 v[NJV];
        const float* xin = (l == 0) ? INP(a, I_X) : outp(a);
#pragma unroll
        for (int j = 0; j < NJV; ++j) v[j] = *(const f32x4*)(xin + (size_t)row * DM + 4 * lane + 256 * j);
        if (l > 0) {
            const int* tie = (const int*)(ws + WS_TIE) + (size_t)row * 2; const float* tiw = (const float*)(ws + WS_TIW) + (size_t)row * 2;
            const int e0 = tie[0] >> 14, p0 = tie[0] & 16383, e1 = tie[1] >> 14, p1 = tie[1] & 16383;
            const float w0 = tiw[0], w1 = tiw[1];
            const bf16* y0 = yk + (size_t)(rb[e0] + p0) * DM; const bf16* y1 = yk + (size_t)(rb[e1] + p1) * DM;
            const float* gf = mod + ((size_t)(l - 1) * 2 + b) * 6 * DM + 5 * DM;
#pragma unroll
            for (int j = 0; j < NJV; ++j) { const int cidx = 4 * lane + 256 * j; u32x2 q0 = *(const u32x2*)(y0 + cidx), q1 = *(const u32x2*)(y1 + cidx);
                f32x4 g = *(const f32x4*)(gf + cidx);
                v[j][0] += g[0] * (w0 * bf2f(q0[0] & 0xffff) + w1 * bf2f(q1[0] & 0xffff));
                v[j][1] += g[1] * (w0 * bf2f(q0[0] >> 16) + w1 * bf2f(q1[0] >> 16));
                v[j][2] += g[2] * (w0 * bf2f(q0[1] & 0xffff) + w1 * bf2f(q1[1] & 0xffff));
                v[j][3] += g[3] * (w0 * bf2f(q0[1] >> 16) + w1 * bf2f(q1[1] >> 16)); }
        }
#pragma unroll
        for (int j = 0; j < NJV; ++j) *(f32x4*)(outp(a) + (size_t)row * DM + 4 * lane + 256 * j) = v[j];
        if (l == DEPTH) continue;
        float ss = 0.f;
#pragma unroll
        for (int j = 0; j < NJV; ++j) ss += v[j][0] * v[j][0] + v[j][1] * v[j][1] + v[j][2] * v[j][2] + v[j][3] * v[j][3];
#pragma unroll
        for (int o = 1; o < 64; o <<= 1) ss += shflx(ss, o);
        const float rs = frsq(ss * (1.0f / DM) + EPS);
        const float* mm = mod + ((size_t)l * 2 + b) * 6 * DM; const float* nm = INP(a, I_NMIX) + (size_t)l * DM;
        bf16* hb = (bf16*)(ws + WS_H) + (size_t)row * DM;
#pragma unroll
        for (int j = 0; j < NJV; ++j) { const int cidx = 4 * lane + 256 * j; f32x4 g = *(const f32x4*)(nm + cidx), sh = *(const f32x4*)(mm + cidx), sc = *(const f32x4*)(mm + DM + cidx), o;
#pragma unroll
            for (int r = 0; r < 4; ++r) o[r] = v[j][r] * rs * g[r] * (1.0f + sc[r]) + sh[r];
            st_bf4(hb + cidx, o); }
    }
}

DEV void route_phase(const Args& a, unsigned char* smem, int l) {
    unsigned char* ws = wsp(a); const int tid = TID;
    float* W = (float*)smem;
    int* lcnt = (int*)(smem + DM * 36 * 4); int* lbase = lcnt + 32; int* tinfo = lbase + 32;
    SYNC();
    { const f32x4* wg4 = (const f32x4*)(INP(a, I_WG) + (size_t)l * DM * 4); const f32x4* we4 = (const f32x4*)(INP(a, I_WE) + (size_t)l * DM * 32);
      for (int i = tid; i < DM; i += NT) *(f32x4*)(W + i * 36) = wg4[i];
#pragma unroll 4
      for (int i = tid; i < DM * 8; i += NT) *(f32x4*)(W + (i >> 3) * 36 + 4 + 4 * (i & 7)) = we4[i]; }
    if (tid < 32) lcnt[tid] = 0;
    SYNC();
    const float* mod = (const float*)(ws + WS_MOD); const float* nf = INP(a, I_NFFN) + (size_t)l * DM;
    int* cnt = (int*)(ws + WS_CNT) + l * 32 * 64;
    constexpr int NI = DM / 32;
    for (int pass0 = BID; pass0 < T / 16; pass0 += 4 * NBLK) {
#pragma unroll 1
        for (int pi = 0; pi < 4; ++pi) {
            const int pass = pass0 + pi * NBLK; if (pass >= T / 16) break;
            const int tok = pass * 16 + (tid >> 5), part = tid & 31, b = tok / SEQ;
            const float* xr = outp(a) + (size_t)tok * DM; float xv[NI]; float ss = 0.f;
#pragma unroll
            for (int i = 0; i < NI; ++i) { xv[i] = xr[part + 32 * i]; ss += xv[i] * xv[i]; }
#pragma unroll
            for (int o = 1; o < 32; o <<= 1) ss += shflx(ss, o);
            const float rs = frsq(ss * (1.0f / DM) + EPS);
            const float* mm = mod + ((size_t)l * 2 + b) * 6 * DM; bf16* hb = (bf16*)(ws + WS_H) + (size_t)tok * DM;
            float acc[36];
#pragma unroll
            for (int n = 0; n < 36; ++n) acc[n] = 0.f;
            { float av[NI], cv[NI];
#pragma unroll
              for (int i = 0; i < NI; ++i) { const int k = part + 32 * i; av[i] = nf[k] * (1.0f + mm[4 * DM + k]); cv[i] = mm[3 * DM + k]; }
#pragma unroll
              for (int i = 0; i < NI; ++i) { xv[i] = xv[i] * rs * av[i] + cv[i]; hb[part + 32 * i] = (bf16)f2bf(xv[i]); } }
#pragma unroll 4
            for (int i = 0; i < NI; ++i) { const int k = part + 32 * i; const float hn = xv[i];
                const f32x4* wr = (const f32x4*)(W + k * 36);
#pragma unroll
                for (int n4 = 0; n4 < 9; ++n4) { const f32x4 wv = wr[n4];
#pragma unroll
                    for (int r = 0; r < 4; ++r) acc[4 * n4 + r] += hn * wv[r]; } }
#pragma unroll
            for (int n = 0; n < 36; ++n) {
#pragma unroll
                for (int o = 1; o < 32; o <<= 1) acc[n] += shflx(acc[n], o); }
            if (part == 0) {
                int gs = 0; float gm = acc[0];
#pragma unroll
                for (int g = 1; g < 4; ++g) if (acc[g] > gm) { gm = acc[g]; gs = g; }
                float den = 0.f;
#pragma unroll
                for (int g = 0; g < 4; ++g) den += fexp2((acc[g] - gm) * LOG2E);
                const float ggate = 1.0f / den;
                float el[8];
#pragma unroll
                for (int j = 0; j < 8; ++j) { el[j] = acc[4 + j];
#pragma unroll
                    for (int g = 1; g < 4; ++g) if (gs == g) el[j] = acc[4 + 8 * g + j]; }
                int ia = 0; float va = el[0];
#pragma unroll
                for (int j = 1; j < 8; ++j) if (el[j] > va) { va = el[j]; ia = j; }
                int ib = -1; float vb = -3e38f;
#pragma unroll
                for (int j = 0; j < 8; ++j) if (j != ia && el[j] > vb) { vb = el[j]; ib = j; }
                const float wa = 1.0f / (1.0f + fexp2((vb - va) * LOG2E)), wb = 1.0f - wa;
                const int e0 = gs * 8 + ia, e1 = gs * 8 + ib;
                const int p0 = atomic_add_i(lcnt + e0, 1), p1 = atomic_add_i(lcnt + e1, 1);
                int* ti = tinfo + (pi * 16 + (tid >> 5)) * 4;
                ti[0] = (e0 << 14) | p0; ti[1] = (e1 << 14) | p1; ti[2] = __builtin_bit_cast(int, ggate * wa); ti[3] = __builtin_bit_cast(int, ggate * wb);
            }
        }
        SYNC();
        if (tid < 32) { const int n = lcnt[tid]; lbase[tid] = n > 0 ? atomic_add_i(cnt + tid * 64, n) : 0; lcnt[tid] = 0; }
        SYNC();
        if (tid < 64) { const int pi = tid >> 4, pass = pass0 + pi * NBLK;
            if (pass < T / 16) { const int tok = pass * 16 + (tid & 15); const int* ti = tinfo + tid * 4;
                const int e0 = ti[0] >> 14, e1 = ti[1] >> 14, p0 = lbase[e0] + (ti[0] & 16383), p1 = lbase[e1] + (ti[1] & 16383);
                int* list = (int*)(ws + WS_LIST); list[(size_t)e0 * T + p0] = tok; list[(size_t)e1 * T + p1] = tok;
                int* tie = (int*)(ws + WS_TIE) + (size_t)tok * 2; int* tiw = (int*)(ws + WS_TIW) + (size_t)tok * 2;
                tie[0] = (e0 << 14) | p0; tie[1] = (e1 << 14) | p1; tiw[0] = ti[2]; tiw[1] = ti[3]; } }
        SYNC();
    }
}

DEV int vbid() { const int g = NBLK; return (g % 8 == 0) ? (BID % 8) * (g / 8) + BID / 8 : BID; }
DEV void inproj_phase(const Args& a, unsigned char* smem, int li) {
    constexpr int TN = NINP / 128, TM = T / 256;
    const bf16* A = (const bf16*)(wsp(a) + WS_H); const float* Bw = INP(a, I_WIN) + (size_t)li * DM * NIN;
    for (int it = vbid(); it < TN * TM; it += NBLK) { const int tm = it / TN, tn = it % TN;
        EpiInProj E{&a, tm * 256, tn * 128, li}; ARows af{A + (size_t)tm * 256 * DM, (size_t)DM}; BInProjMap bf{Bw, tn * 128};
        gemm_tile2(smem, af, bf, NIN, DM, E); }
}
DEV void resid_gemm_phase(const Args& a, unsigned char* smem, const bf16* A, int K, const float* Bw, int l) {
    constexpr int TN = DM / 128, TM = T / 256;
    const float* gate = (const float*)(wsp(a) + WS_MOD) + (size_t)l * 2 * 6 * DM + 2 * DM;
    for (int it = vbid(); it < TN * TM; it += NBLK) { const int tm = it / TN, tn = it % TN;
        EpiResid E{outp(a), gate, tm * 256, tn * 128}; ARows af{A + (size_t)tm * 256 * K, (size_t)K}; BPlain bf{Bw + tn * 128};
        gemm_tile2(smem, af, bf, DM, K, E); }
}
DEV void pw1_phase(const Args& a, unsigned char* smem, int li) {
    constexpr int TN = 2 * DM / 128, TM = T / 256;
    const bf16* A = (const bf16*)(wsp(a) + WS_H); const float* Bw = INP(a, I_PW1) + (size_t)li * DM * 2 * DM;
    for (int it = vbid(); it < TN * TM; it += NBLK) { const int tm = it / TN, tn = it % TN;
        EpiGated<0> E{(bf16*)(wsp(a) + WS_GLU), (size_t)DM, tm * 256, tn * 128, 256}; ARows af{A + (size_t)tm * 256 * DM, (size_t)DM}; BInter bf{Bw, Bw + DM, tn * 128};
        gemm_tile2(smem, af, bf, 2 * DM, DM, E); }
}
DEV void cmp_phase_items(const Args& a, unsigned char* smem, int li, int it) {
    constexpr int TMC = (NCP + 255) / 256;
    const int kv = it / (4 * TMC), bg = (it / TMC) % 4, tm = it % TMC;
    const bf16* src = (const bf16*)(wsp(a) + (kv ? WS_VCG : WS_KCG)) + (size_t)bg * SEQ * 64;
    struct AF { const bf16* base; int m0; MDEV unsigned off(int r) const { int n = m0 + r; if (n > NCMP - 1) n = NCMP - 1; return (unsigned)n * 1024u; } } af{src, tm * 256};
    EpiCmp E{&a, kv, bg, tm * 256, li};
    BClamp64 bf{INP(a, kv ? I_CWV : I_CWK) + (size_t)li * 2048 * 64};
    gemm_tile2(smem, af, bf, 64, 2048, E);
}
DEV void moe_gemm_phase(const Args& a, unsigned char* smem, int l, int mode) {
    unsigned char* ws = wsp(a); const int* cnt = (const int*)(ws + WS_CNT) + l * 32 * 64;
    int* rb = (int*)(smem + GEMM2_LDS);
    moe_bases(cnt, rb);
    const int ntile = rb[32] >> 8;
    constexpr int TN1 = 2 * FF / 128, TN2 = DM / 128;
    const int TN = mode == 0 ? TN1 : TN2;
    const int* list = (const int*)(ws + WS_LIST);
    for (int it = vbid(); it < ntile * TN; it += NBLK) {
        const int rt = it / TN, tn = it % TN; int e = 0;
#pragma unroll 1
        for (int q = 1; q < 32; ++q) if ((rb[q] >> 8) <= rt) e = q;
        const int rloc = (rt << 8) - rb[e], ce = cnt[e * 64], nvalid = (ce - rloc) < 256 ? (ce - rloc) : 256;
        if (mode == 0) {
            struct AF { const bf16* base; const int* lst; int nv; MDEV unsigned off(int r) const { const int rr = r < nv ? r : nv - 1; return (unsigned)lst[rr] * (unsigned)DM; } }
                af{(const bf16*)(ws + WS_H), list + (size_t)e * T + rloc, nvalid};
            EpiGated<1> E{(bf16*)(ws + WS_ACT), (size_t)FF, rt << 8, tn * 128, nvalid};
            BInter bf{INP(a, I_W1) + (size_t)(l * 32 + e) * DM * FF, INP(a, I_W3) + (size_t)(l * 32 + e) * DM * FF, tn * 128};
            gemm_tile2(smem, af, bf, FF, DM, E);
        } else {
            ARows af{(const bf16*)(ws + WS_ACT) + (size_t)(rt << 8) * FF, (size_t)FF};
            EpiStoreBf E{(bf16*)(ws + WS_YK), (size_t)DM, rt << 8, tn * 128, nvalid};
            BPlain bf{INP(a, I_W2) + (size_t)(l * 32 + e) * FF * DM + tn * 128};
            gemm_tile2(smem, af, bf, DM, FF, E);
        }
    }
}

constexpr int AT_K = 0, AT_V = 2 * 64 * LDT * 2, AT_IMP = 2 * AT_V, AT_SEL = AT_IMP + 8 * 8 * 128 * 4, AT_GSEL = AT_SEL + 8 * 8 * 4 * 4, AT_OUT = AT_GSEL + 8 * 2 * 4 * 4, AT_END = AT_OUT + 8 * 32 * 64 * 4;
#ifdef EMU
DEV float rexp2(float x) { return exp2f(x); }
DEV unsigned uni(unsigned x) { return x; }
#else
DEV float rexp2(float x) { return __builtin_amdgcn_exp2f(x); }
DEV unsigned uni(unsigned x) { return (unsigned)__builtin_amdgcn_readfirstlane((int)x); }
#endif
template <int MASK, bool WITH_PV, bool FULL, int GM>
DEV void attn_block(const bf16* Kp, const bf16* Vp, const bf16x8 (&qf)[2][2], int j, const int (&s)[2], const bool (&selbit)[2], float C2, int h, int c,
                    f32x4 (&O)[2][4], f32x4 (&Ol)[2], f32x4 (&pout)[2][2][2]) {
    f32x4 st[2][2][2];
#pragma unroll
    for (int sp = 0; sp < 2; ++sp)
#pragma unroll
        for (int u = 0; u < 2; ++u) { const int krow = 32 * sp + 8 * (c >> 2) + 4 * u + (c & 3);
#pragma unroll
            for (int G = 0; G < 2; ++G) { st[G][sp][u][0] = -C2; st[G][sp][u][1] = -C2; st[G][sp][u][2] = -C2; st[G][sp][u][3] = -C2; }
#pragma unroll
            for (int ks = 0; ks < 2; ++ks) { const bf16x8 kf = *(const bf16x8*)(Kp + krow * LDT + 32 * ks + 8 * h);
#pragma unroll
                for (int G = 0; G < 2; ++G) if (GM & (1 << G)) st[G][sp][u] = mfma16(kf, qf[G][ks], st[G][sp][u]); } }
#pragma unroll
    for (int G = 0; G < 2; ++G) if (GM & (1 << G))
#pragma unroll
        for (int sp = 0; sp < 2; ++sp)
#pragma unroll
            for (int u = 0; u < 2; ++u)
#pragma unroll
                for (int r = 0; r < 4; ++r) { bool ok = selbit[G];
                    if (!FULL) { const int key = 64 * j + 32 * sp + 8 * h + 4 * u + r;
                        if (MASK == 0) ok = 16 * key + 31 <= s[G]; else if (MASK == 1) ok = selbit[G] && key <= s[G]; else ok = key <= s[G] && key > s[G] - 512; }
                    pout[G][sp][u][r] = ok ? rexp2(st[G][sp][u][r]) : 0.f; }
    if (WITH_PV) {
        bf16x8 pb[2][2], ones;
#pragma unroll
        for (int q = 0; q < 8; ++q) ones[q] = (short)0x3F80;
#pragma unroll
        for (int G = 0; G < 2; ++G) if (GM & (1 << G))
#pragma unroll
            for (int sp = 0; sp < 2; ++sp) { pb[G][sp] = pack8(pout[G][sp][0], pout[G][sp][1]); Ol[G] = mfma16(ones, pb[G][sp], Ol[G]); }
#pragma unroll
        for (int et = 0; et < 4; ++et)
#pragma unroll
            for (int sp = 0; sp < 2; ++sp) { const bf16x8 vf = *(const bf16x8*)(Vp + (16 * et + c) * LDT + 32 * sp + 8 * h);
#pragma unroll
                for (int G = 0; G < 2; ++G) if (GM & (1 << G)) O[G][et] = mfma16(vf, pb[G][sp], O[G][et]); }
    }
}

struct ImpState { float invl[2]; float carry[2]; float* imps; int tl, hd, l, s0, qblk; };
template <int MODE>
DEV void attn_branch(bf16* Kl, bf16* Vl, const bf16* kbase, int kstride, const bf16* vbase, int vstride, int jlo, int jhi,
                     const bf16x8 (&qf)[2][2], const int (&s)[2], const unsigned* selm, const unsigned* gselm, float C2, int h, int c, int srow, int scol,
                     f32x4 (&O)[2][4], f32x4 (&Ol)[2], ImpState& im) {
    constexpr bool PV = MODE != 1; constexpr int MASK = MODE <= 1 ? 0 : MODE - 1;
    bf16x8 rk[3], rv[3]; f32x4 pt[2][2][2];
    { const bf16x8 k0 = *(const bf16x8*)(kbase + (size_t)jlo * kstride); *(bf16x8*)(Kl + srow * LDT + scol) = k0;
      if (PV) { const bf16x8 v0 = *(const bf16x8*)(vbase + (size_t)jlo * vstride); *(bf16x8*)(Vl + srow * LDT + scol) = v0; } }
#pragma unroll
    for (int u = 0; u < 3; ++u) { int jj = jlo + 1 + u; if (jj > jhi) jj = jhi; rk[(1 + u) % 3] = *(const bf16x8*)(kbase + (size_t)jj * kstride); if (PV) rv[(1 + u) % 3] = *(const bf16x8*)(vbase + (size_t)jj * vstride); }
    SYNC();
    for (int jb = jlo; jb <= jhi; jb += 3) {
#pragma unroll
        for (int u = 0; u < 3; ++u) { const int j = jb + u;
            if (j <= jhi) {
                const int cur = (j - jlo) & 1;
                bool sb[2] = {true, true}; unsigned gm = 3u;
                if (MODE == 2) { gm = 0u;
#pragma unroll
                    for (int G = 0; G < 2; ++G) { const unsigned wq = uni(gselm[G * 4 + (j >> 5)]), mq = selm[(G * 4 + im.tl) * 4 + (j >> 5)];
                        gm |= ((wq >> (j & 31)) & 1u) << G; sb[G] = (mq >> (j & 31)) & 1u; } }
                bool full;
                if (MODE <= 1) full = 1024 * j + 1039 <= im.s0; else if (MODE == 2) full = j < im.qblk; else full = (j < im.qblk) && (64 * j > im.s0 + 63 - 512);
                const bf16* Kc = Kl + cur * 64 * LDT; const bf16* Vc = Vl + cur * 64 * LDT;
                if (MODE == 2) {
                    if (full) { if (gm == 3u) attn_block<MASK, PV, true, 3>(Kc, Vc, qf, j, s, sb, C2, h, c, O, Ol, pt); else if (gm == 1u) attn_block<MASK, PV, true, 1>(Kc, Vc, qf, j, s, sb, C2, h, c, O, Ol, pt); else if (gm == 2u) attn_block<MASK, PV, true, 2>(Kc, Vc, qf, j, s, sb, C2, h, c, O, Ol, pt); }
                    else { if (gm == 3u) attn_block<MASK, PV, false, 3>(Kc, Vc, qf, j, s, sb, C2, h, c, O, Ol, pt); else if (gm == 1u) attn_block<MASK, PV, false, 1>(Kc, Vc, qf, j, s, sb, C2, h, c, O, Ol, pt); else if (gm == 2u) attn_block<MASK, PV, false, 2>(Kc, Vc, qf, j, s, sb, C2, h, c, O, Ol, pt); }
                } else { if (full) attn_block<MASK, PV, true, 3>(Kc, Vc, qf, j, s, sb, C2, h, c, O, Ol, pt); else attn_block<MASK, PV, false, 3>(Kc, Vc, qf, j, s, sb, C2, h, c, O, Ol, pt); }
                if (MODE == 1) {
#pragma unroll
                    for (int G = 0; G < 2; ++G) {
#pragma unroll
                        for (int sp = 0; sp < 2; ++sp)
#pragma unroll
                            for (int uu = 0; uu < 2; ++uu)
#pragma unroll
                                for (int r = 0; r < 4; ++r) { float p = pt[G][sp][uu][r] * im.invl[G]; p += shflx(p, 1); p += shflx(p, 2); pt[G][sp][uu][r] = p; }
                        const float r0 = shfl(pt[G][0][1][3], (im.l - 16) & 63), r1 = shfl(pt[G][1][1][3], (im.l - 16) & 63);
#pragma unroll
                        for (int sp = 0; sp < 2; ++sp)
#pragma unroll
                            for (int uu = 0; uu < 2; ++uu) { const int m = 16 * j + 8 * sp + 2 * h + uu;
                                float prev; if (uu == 1) prev = pt[G][sp][0][3]; else if (h > 0) prev = sp == 0 ? r0 : r1; else prev = sp == 0 ? im.carry[G] : r0;
                                const float val = 2.0f * (pt[G][sp][uu][0] + pt[G][sp][uu][1] + pt[G][sp][uu][2]) + pt[G][sp][uu][3] + prev;
                                if (im.hd == 0 && m < 128) im.imps[(G * 4 + im.tl) * 128 + m] = val; }
                        im.carry[G] = r1;
                    }
                }
                if (j + 1 <= jhi) {
                    *(bf16x8*)(Kl + (cur ^ 1) * 64 * LDT + srow * LDT + scol) = rk[(u + 1) % 3]; if (PV) *(bf16x8*)(Vl + (cur ^ 1) * 64 * LDT + srow * LDT + scol) = rv[(u + 1) % 3];
                    int jj = j + 4; if (jj > jhi) jj = jhi;
                    rk[(u + 1) % 3] = *(const bf16x8*)(kbase + (size_t)jj * kstride); if (PV) rv[(u + 1) % 3] = *(const bf16x8*)(vbase + (size_t)jj * vstride);
                }
                SYNC();
            }
        }
    }
}

DEV void attn_task(const Args& a, unsigned char* smem, int li, int item) {
    unsigned char* ws = wsp(a); const int tid = TID, w = tid >> 6, l = tid & 63, h = l >> 4, c = l & 15, tl = c >> 2, hd = c & 3;
    const int bg = item & 3, b = bg >> 1, g = bg & 1, tq = (SEQ / 64 - 1) - (item >> 2), s0 = tq * 64, qblk = tq;
    int s[2], row[2];
#pragma unroll
    for (int G = 0; G < 2; ++G) { s[G] = s0 + 8 * w + 4 * G + tl; row[G] = b * SEQ + s[G]; }
    bf16* Kl = (bf16*)(smem + AT_K); bf16* Vl = (bf16*)(smem + AT_V); float* imps = (float*)(smem + AT_IMP) + w * 1024; unsigned* selm = (unsigned*)(smem + AT_SEL) + w * 32;
    bf16x8 qf[2][2]; float gatec[2], gates[2], gatew[2];
#pragma unroll
    for (int G = 0; G < 2; ++G) { const bf16* qp = (const bf16*)(ws + WS_QN) + (size_t)row[G] * 512 + (g * 4 + hd) * 64 + 8 * h; qf[G][0] = *(const bf16x8*)qp; qf[G][1] = *(const bf16x8*)(qp + 32);
        const float* gp = (const float*)(ws + WS_GATE) + (size_t)row[G] * 24 + (g * 4 + hd) * 3; gatec[G] = gp[0]; gates[G] = gp[1]; gatew[G] = gp[2]; }
    const float* cs = (const float*)(ws + WS_CS) + li * 4;
    const int srow = tid >> 3, scol = (tid & 7) * 8;
    for (int i = l; i < 1024; i += 64) imps[i] = 0.f;
    SYNC();
    unsigned* gselm = (unsigned*)(smem + AT_GSEL) + w * 8; float* outl = (float*)(smem + AT_OUT) + w * 2048 + l;
    ImpState im{{0.f, 0.f}, {0.f, 0.f}, imps, tl, hd, l, s0, qblk};
    {
        const int ncv = s0 / 16 + 3, ncb0 = (ncv + 63) >> 6, ncb = ncb0 > NCP / 64 ? NCP / 64 : ncb0;
        const bf16* kcb = (const bf16*)(ws + WS_KC) + (size_t)bg * NCP * 64 + srow * 64 + scol;
        const bf16* vcb = (const bf16*)(ws + WS_VCT) + (size_t)bg * 64 * NCP + (size_t)srow * NCP + scol;
        f32x4 O[2][4], Ol[2] = {f4zero(), f4zero()};
#pragma unroll
        for (int G = 0; G < 2; ++G)
#pragma unroll
            for (int et = 0; et < 4; ++et) O[G][et] = f4zero();
        attn_branch<0>(Kl, Vl, kcb, 4096, vcb, 64, 0, ncb - 1, qf, s, selm, gselm, cs[0], h, c, srow, scol, O, Ol, im);
#pragma unroll
        for (int G = 0; G < 2; ++G) { const float lsum = Ol[G][0]; im.invl[G] = lsum > 0.f ? 1.0f / lsum : 0.f;
#pragma unroll
            for (int et = 0; et < 4; ++et)
#pragma unroll
                for (int r = 0; r < 4; ++r) outl[((G * 4 + et) * 4 + r) * 64] = gatec[G] * im.invl[G] * O[G][et][r]; }
        f32x4 ld[2] = {f4zero(), f4zero()};
        attn_branch<1>(Kl, Vl, kcb, 4096, vcb, 64, 0, ncb - 1, qf, s, selm, gselm, cs[0], h, c, srow, scol, O, ld, im);
    }
    WSYNC();
#pragma unroll 1
    for (int G = 0; G < 2; ++G) {
        const int tk = l >> 4, i = l & 15; float vals[8];
#pragma unroll
        for (int mm = 0; mm < 8; ++mm) { const int jj = i + 16 * mm; vals[mm] = jj > qblk ? NEGV : ((jj == 0 || jj == qblk || jj == qblk - 1) ? FORCEV : imps[(G * 4 + tk) * 128 + jj]); }
        unsigned mk[4] = {0u, 0u, 0u, 0u};
#pragma unroll 1
        for (int rnd = 0; rnd < 16; ++rnd) {
            float best = vals[0]; int bj = i;
#pragma unroll
            for (int mm = 1; mm < 8; ++mm) if (vals[mm] > best) { best = vals[mm]; bj = i + 16 * mm; }
#pragma unroll
            for (int o = 1; o < 16; o <<= 1) { const float ov = shflx(best, o); const int oj = shflxi(bj, o); if (ov > best || (ov == best && oj < bj)) { best = ov; bj = oj; } }
            if (best > NEGV * 0.5f) {
#pragma unroll
                for (int q = 0; q < 4; ++q) if ((bj >> 5) == q) mk[q] |= 1u << (bj & 31); }
            if ((bj & 15) == i) {
#pragma unroll
                for (int mm = 0; mm < 8; ++mm) if ((bj >> 4) == mm) vals[mm] = -3e38f; }
        }
        if (i == 0) {
#pragma unroll
            for (int q = 0; q < 4; ++q) selm[(G * 4 + tk) * 4 + q] = mk[q]; }
    }
    WSYNC();
    if (l < 8) { const int G = l >> 2, q = l & 3; gselm[l] = selm[(G * 4 + 0) * 4 + q] | selm[(G * 4 + 1) * 4 + q] | selm[(G * 4 + 2) * 4 + q] | selm[(G * 4 + 3) * 4 + q]; }
    WSYNC();
#pragma unroll
    for (int br = 0; br < 2; ++br) {
        const bf16* kb = (const bf16*)(ws + (br == 0 ? WS_KS : WS_KW)) + (size_t)bg * SEQ * 64 + tid * 8; const bf16* vb = (const bf16*)(ws + (br == 0 ? WS_VST : WS_VWT)) + (size_t)bg * NCH * 4096 + tid * 8;
        f32x4 O[2][4], Ol[2] = {f4zero(), f4zero()};
#pragma unroll
        for (int G = 0; G < 2; ++G)
#pragma unroll
            for (int et = 0; et < 4; ++et) O[G][et] = f4zero();
        if (br == 0) attn_branch<2>(Kl, Vl, kb, 4096, vb, 4096, 0, qblk, qf, s, selm, gselm, cs[1], h, c, srow, scol, O, Ol, im);
        else attn_branch<3>(Kl, Vl, kb, 4096, vb, 4096, s0 >= 511 ? (s0 - 511) >> 6 : 0, qblk, qf, s, selm, gselm, cs[2], h, c, srow, scol, O, Ol, im);
#pragma unroll
        for (int G = 0; G < 2; ++G) { const float lsum = Ol[G][0]; const float sc = (br == 0 ? gates[G] : gatew[G]) * (lsum > 0.f ? 1.0f / lsum : 0.f);
#pragma unroll
            for (int et = 0; et < 4; ++et)
#pragma unroll
                for (int r = 0; r < 4; ++r) outl[((G * 4 + et) * 4 + r) * 64] += sc * O[G][et][r]; }
    }
#pragma unroll
    for (int G = 0; G < 2; ++G) { bf16* dst = (bf16*)(ws + WS_CAT) + (size_t)row[G] * 1024 + (g * 4 + hd) * 64 + 4 * h;
#pragma unroll
        for (int et = 0; et < 4; ++et) { f32x4 o;
#pragma unroll
            for (int r = 0; r < 4; ++r) o[r] = outl[((G * 4 + et) * 4 + r) * 64];
            st_bf4(dst + 16 * et, o); } }
}

constexpr int LDH = 136;
DEV void hg_cumsum(const float* fsrc  , float* segs  , int d, int seg, float (&f)[16], float (&bc)[16], float& bend, float& bmid) {
    float run = 0.f;
#pragma unroll
    for (int i = 0; i < 16; ++i) { f[i] = fsrc[(size_t)(16 * seg + i) * 128 + d]; run += log2f(f[i]); bc[i] = run; }
    SYNC();
    segs[seg * 128 + d] = run;
    SYNC();
    const float s0 = segs[d], s1 = segs[128 + d], s2 = segs[256 + d], s3 = segs[384 + d];
    const float off = seg == 0 ? 0.f : (seg == 1 ? s0 : (seg == 2 ? s0 + s1 : s0 + s1 + s2));
#pragma unroll
    for (int i = 0; i < 16; ++i) bc[i] += off;
    bend = s0 + s1 + s2 + s3; bmid = s0 + s1;
}
DEV void hg_write16(bf16* dstrow  , const float (&v)[16]) {
    u32x4 w0, w1;
#pragma unroll
    for (int q = 0; q < 4; ++q) { w0[q] = pk2(v[2 * q], v[2 * q + 1]); w1[q] = pk2(v[8 + 2 * q], v[8 + 2 * q + 1]); }
    *(u32x4*)dstrow = w0; *(u32x4*)(dstrow + 8) = w1;
}
DEV void hg_h1_task(const Args& a, unsigned char* smem, int task) {
    unsigned char* ws = wsp(a); const int tid = TID, w = tid >> 6, l = tid & 63, h = l >> 4, c = l & 15, d = tid & 127, seg = tid >> 7;
    const int bh = task / NCH, ch = task % NCH;
    bf16* kT = (bf16*)smem; bf16* vT = kT + 128 * LDT; float* segs = (float*)(vT + 128 * LDT);
    const size_t tokb = (size_t)bh * SEQ + ch * 64;
    float f[16], bc[16], bend, bmid;
    hg_cumsum((const float*)(ws + WS_HF) + tokb * 128, segs, d, seg, f, bc, bend, bmid);
    float kv[16];
#pragma unroll
    for (int i = 0; i < 16; ++i) kv[i] = (1.0f - f[i]) * fexp2(bend - bc[i]);
    hg_write16(kT + d * LDT + 16 * seg, kv);
    const bf16* vs = (const bf16*)(ws + WS_HV) + tokb * 128;
#pragma unroll
    for (int i = 0; i < 16; ++i) kv[i] = bf2f(vs[(size_t)(16 * seg + i) * 128 + d]);
    hg_write16(vT + d * LDT + 16 * seg, kv);
    if (seg == 0) ((float*)(ws + WS_GD))[((size_t)bh * NCH + ch) * 128 + d] = fexp2(bend);
    SYNC();
    f32x4 acc[8];
#pragma unroll
    for (int et = 0; et < 8; ++et) acc[et] = f4zero();
#pragma unroll
    for (int ks = 0; ks < 2; ++ks) { const bf16x8 fa = *(const bf16x8*)(kT + (16 * w + c) * LDT + 32 * ks + 8 * h);
#pragma unroll
        for (int et = 0; et < 8; ++et) acc[et] = mfma16(fa, *(const bf16x8*)(vT + (16 * et + c) * LDT + 32 * ks + 8 * h), acc[et]); }
    float* ut = (float*)(ws + WS_UT) + ((size_t)bh * NCH + ch) * 16384;
#pragma unroll
    for (int et = 0; et < 8; ++et) *(f32x4*)(ut + (size_t)(16 * et + c) * 128 + 16 * w + 4 * h) = acc[et];
    SYNC();
}
DEV void hg_scan_task(const Args& a, int sc) {
    unsigned char* ws = wsp(a); const int bh = sc >> 3, q = (sc & 7) * 512 + TID, e = q >> 5, d0 = (q & 31) * 4;
    const float* ut = (const float*)(ws + WS_UT) + (size_t)bh * NCH * 16384 + (size_t)e * 128 + d0;
    const float* gd = (const float*)(ws + WS_GD) + (size_t)bh * NCH * 128 + d0;
    bf16* st = (bf16*)(ws + WS_ST) + (size_t)bh * NCH * 16384 + (size_t)e * 128 + d0;
    f32x4 S = f4zero();
#pragma unroll 4
    for (int ch = 0; ch < NCH; ++ch) { st_bf4(st + (size_t)ch * 16384, S);
        const f32x4 g = *(const f32x4*)(gd + (size_t)ch * 128), u = *(const f32x4*)(ut + (size_t)ch * 16384);
#pragma unroll
        for (int r = 0; r < 4; ++r) S[r] = g[r] * S[r] + u[r]; }
}
DEV void hg_h3_task(const Args& a, unsigned char* smem, int li, int task) {
    unsigned char* ws = wsp(a); const int tid = TID, w = tid >> 6, l = tid & 63, h = l >> 4, c = l & 15, d = tid & 127, seg = tid >> 7;
    const int bh = task / NCH, ch = task % NCH, b = bh >> 2, hh = bh & 3;
    bf16* At = (bf16*)smem; bf16* Bt = At + 64 * LDH; bf16* Qt = Bt + 64 * LDH; bf16* vT = Qt + 64 * LDH; float* segs = (float*)(vT + 128 * LDT); float* part = segs + 512;
    const size_t tokb = (size_t)bh * SEQ + ch * 64;
    float f[16], bc[16], bend, bmid;
    hg_cumsum((const float*)(ws + WS_HF) + tokb * 128, segs, d, seg, f, bc, bend, bmid);
    const bf16* qs = (const bf16*)(ws + WS_HQ) + tokb * 128; const bf16* vs = (const bf16*)(ws + WS_HV) + tokb * 128;
    float vv[16];
#pragma unroll
    for (int i = 0; i < 16; ++i) { const int t = 16 * seg + i; const float q = bf2f(qs[(size_t)t * 128 + d]);
        At[t * LDH + d] = (bf16)f2bf(q * fexp2(bc[i] - bmid)); Bt[t * LDH + d] = (bf16)f2bf((1.0f - f[i]) * fexp2(bmid - bc[i])); Qt[t * LDH + d] = (bf16)f2bf(q * fexp2(bc[i]));
        vv[i] = bf2f(vs[(size_t)t * 128 + d]); }
    hg_write16(vT + d * LDT + 16 * seg, vv);
    SYNC();
    const int tt = w & 3, eh = w >> 2;
    f32x4 O[4];
#pragma unroll
    for (int et = 0; et < 4; ++et) O[et] = f4zero();
#pragma unroll
    for (int sp = 0; sp < 2; ++sp) {
        if (32 * sp > 16 * tt + 15) continue;
        f32x4 st[2];
#pragma unroll
        for (int u = 0; u < 2; ++u) { st[u] = f4zero(); const int krow = 32 * sp + 8 * (c >> 2) + 4 * u + (c & 3);
#pragma unroll
            for (int ks = 0; ks < 4; ++ks) st[u] = mfma16(*(const bf16x8*)(Bt + krow * LDH + 32 * ks + 8 * h), *(const bf16x8*)(At + (16 * tt + c) * LDH + 32 * ks + 8 * h), st[u]);
#pragma unroll
            for (int r = 0; r < 4; ++r) { const int sk = 32 * sp + 8 * h + 4 * u + r; if (sk > 16 * tt + c) st[u][r] = 0.f; } }
        const bf16x8 pb = pack8(st[0], st[1]);
#pragma unroll
        for (int et = 0; et < 4; ++et) O[et] = mfma16(*(const bf16x8*)(vT + (64 * eh + 16 * et + c) * LDT + 32 * sp + 8 * h), pb, O[et]);
    }
    const bf16* stp = (const bf16*)(ws + WS_ST) + ((size_t)bh * NCH + ch) * 16384;
#pragma unroll
    for (int ks = 0; ks < 4; ++ks) { const bf16x8 fq = *(const bf16x8*)(Qt + (16 * tt + c) * LDH + 32 * ks + 8 * h);
#pragma unroll
        for (int et = 0; et < 4; ++et) O[et] = mfma16(*(const bf16x8*)(stp + (size_t)(64 * eh + 16 * et + c) * 128 + 32 * ks + 8 * h), fq, O[et]); }
    float ss = 0.f;
#pragma unroll
    for (int et = 0; et < 4; ++et)
#pragma unroll
        for (int r = 0; r < 4; ++r) ss += O[et][r] * O[et][r];
    ss += shflx(ss, 16); ss += shflx(ss, 32);
    if (h == 0) part[eh * 64 + 16 * tt + c] = ss;
    SYNC();
    const float rs = frsq((part[16 * tt + c] + part[64 + 16 * tt + c]) * (1.0f / 128.0f) + EPS);
    const int tok = b * SEQ + ch * 64 + 16 * tt + c;
    const float* og = INP(a, I_OG) + li * 128; const bf16* hg = (const bf16*)(ws + WS_HGS) + (size_t)tok * 512 + hh * 128;
    bf16* dst = (bf16*)(ws + WS_CAT) + (size_t)tok * 1024 + 512 + hh * 128;
#pragma unroll
    for (int et = 0; et < 4; ++et) { const int e = 64 * eh + 16 * et + 4 * h; f32x4 o;
#pragma unroll
        for (int r = 0; r < 4; ++r) o[r] = O[et][r] * rs * og[e + r] * bf2f(hg[e + r]);
        st_bf4(dst + e, o); }
    SYNC();
}

DEV void conv_task(const Args& a, unsigned char* smem, int li, int task) {
    unsigned char* ws = wsp(a); const int tid = TID, w = tid >> 6, lane = tid & 63;
    const bool act = tid < DM / 2; const int c0 = act ? 2 * tid : 0;
    const int t0 = task * 16, b = t0 / SEQ, s0 = t0 % SEQ;
    float* red = (float*)smem;
    const float* dw = INP(a, I_DW) + (size_t)li * 31 * DM + c0;
    float acc[16][2];
    const float b0 = INP(a, I_DWB)[li * DM + c0], b1 = INP(a, I_DWB)[li * DM + c0 + 1];
#pragma unroll
    for (int t = 0; t < 16; ++t) { acc[t][0] = b0; acc[t][1] = b1; }
    const bf16* glu = (const bf16*)(ws + WS_GLU) + (size_t)b * SEQ * DM + c0;
    unsigned uu[46];
    { const bf16* gp = glu + (size_t)(s0 - 30) * DM;
#pragma unroll
    for (int r = 0; r < 46; ++r) { const int si = s0 + r - 30; uu[r] = si >= 0 ? *(const unsigned*)gp : 0u; gp += DM; OPAQUE(gp); } }
    const float* dwp = dw;
#pragma unroll
    for (int j = 0; j < 31; ++j) { const float w0 = dwp[0], w1 = dwp[1]; dwp += DM; OPAQUE(dwp);
#pragma unroll
        for (int t = 0; t < 16; ++t) { const unsigned q = uu[t + j]; acc[t][0] += w0 * bf2f(q & 0xffff); acc[t][1] += w1 * bf2f(q >> 16); } }
    float mean[16], rstd[16];
    SYNC();
#pragma unroll
    for (int t = 0; t < 16; ++t) { float s = act ? acc[t][0] + acc[t][1] : 0.f;
#pragma unroll
        for (int o = 1; o < 64; o <<= 1) s += shflx(s, o);
        if (lane == 0) red[w * 16 + t] = s; }
    SYNC();
#pragma unroll
    for (int t = 0; t < 16; ++t) { float s = 0.f;
#pragma unroll
        for (int q = 0; q < 8; ++q) s += red[q * 16 + t];
        mean[t] = s * (1.0f / DM); }
    SYNC();
#pragma unroll
    for (int t = 0; t < 16; ++t) { const float d0 = acc[t][0] - mean[t], d1 = acc[t][1] - mean[t]; float s = act ? d0 * d0 + d1 * d1 : 0.f;
#pragma unroll
        for (int o = 1; o < 64; o <<= 1) s += shflx(s, o);
        if (lane == 0) red[w * 16 + t] = s; }
    SYNC();
#pragma unroll
    for (int t = 0; t < 16; ++t) { float s = 0.f;
#pragma unroll
        for (int q = 0; q < 8; ++q) s += red[q * 16 + t];
        rstd[t] = frsq(s * (1.0f / DM) + EPS); }
    if (act) {
        const float g0 = INP(a, I_LNG)[li * DM + c0], g1 = INP(a, I_LNG)[li * DM + c0 + 1], e0 = INP(a, I_LNB)[li * DM + c0], e1 = INP(a, I_LNB)[li * DM + c0 + 1];
        bf16* dst = (bf16*)(ws + WS_CAT) + (size_t)t0 * DM + c0;
#pragma unroll
        for (int t = 0; t < 16; ++t) { const float y0 = (acc[t][0] - mean[t]) * rstd[t] * g0 + e0, y1 = (acc[t][1] - mean[t]) * rstd[t] * g1 + e1;
            *(unsigned*)(dst + (size_t)t * DM) = pk2(siluf(y0), siluf(y1)); }
    }
}

constexpr int N_PHASES = 1 + 16 * (DEPTH / 2) + 1;
DEV void phase_decode(int ph, int& l, int& sub) {
    const int q = ph - 1, pair = q >> 4, r = q & 15;
    if (r < 9) { l = 2 * pair; sub = r; } else { l = 2 * pair + 1; const int rr = r - 9; sub = rr < 3 ? rr : rr + 2; }
}
constexpr int LDS_BYTES = 150 * 1024;

DEV void run_phase(const Args& a, unsigned char* smem, int ph) {
#ifndef ONLY
#define ONLY -1
#endif
#define EN(k) (ONLY < 0 || ONLY == (k))
    if (ph == 0) { if (EN(100)) p0_phase(a, smem); return; }
    if (ph == N_PHASES - 1) { if (EN(0)) norm_phase(a, smem, DEPTH); return; }
    int l, sub; phase_decode(ph, l, sub); const int li = l >> 1; const bool even = (l & 1) == 0;
    unsigned char* ws = wsp(a);
    switch (sub) {
    case 0: if (EN(0)) norm_phase(a, smem, l); break;
    case 1: if (even) { if (EN(1)) inproj_phase(a, smem, li); } else { if (EN(11)) pw1_phase(a, smem, li); } break;
    case 2:
        if (even) { constexpr int NCI = 8 * ((NCP + 255) / 256); constexpr int NH1 = 8 * NCH;
            for (int it = BID; it < NCI + NH1; it += NBLK) { if (it < NCI) { if (EN(2)) cmp_phase_items(a, smem, li, it); } else { if (EN(12)) hg_h1_task(a, smem, it - NCI); } } }
        else { for (int it = BID; it < T / 16; it += NBLK) if (EN(13)) conv_task(a, smem, li, it); }
        break;
    case 3:
        if (even) { constexpr int NA = 4 * (SEQ / 64); const int G = NBLK;
            for (int r = 0; r * G < NA; ++r) { const int it = r * G + ((r & 1) ? (G - 1 - BID) : BID); if (it < NA) { if (EN(3)) attn_task(a, smem, li, it); } }
            for (int it = BID; it < 64; it += NBLK) if (EN(14)) hg_scan_task(a, it); }
        break;
    case 4: if (even) { for (int it = BID; it < 8 * NCH; it += NBLK) if (EN(4)) hg_h3_task(a, smem, li, it); } break;
    case 5:
        if (!EN(5)) break;
        if (even) resid_gemm_phase(a, smem, (const bf16*)(ws + WS_CAT), 1024, INP(a, I_WOUT) + (size_t)li * 1024 * DM, l);
        else resid_gemm_phase(a, smem, (const bf16*)(ws + WS_CAT), DM, INP(a, I_PW2) + (size_t)li * DM * DM, l);
        break;
    case 6: if (EN(6)) route_phase(a, smem, l); break;
    case 7: if (EN(7)) moe_gemm_phase(a, smem, l, 0); break;
    case 8: if (EN(8)) moe_gemm_phase(a, smem, l, 1); break;
    }
}

#ifndef EMU
#define LAS __attribute__((address_space(3)))
#define XB_TMO      128
#define XB_XCNT(j)  (256  + 64 * (j))
#define XB_XSUB(j)  (1280 + 64 * (j))
#define XB_XGEN(j)  (2304 + 64 * (j))
#define XB_TOP      3328
#define XB_TOPGEN   3392
#define XCD_BAR_WORDS 3456
#define XB_SPIN_CAP (1u << 22)
__device__ __forceinline__ unsigned xb_ld(unsigned* p)              { return __hip_atomic_load(p, __ATOMIC_RELAXED, __HIP_MEMORY_SCOPE_AGENT); }
__device__ __forceinline__ unsigned xb_add(unsigned* p, unsigned v) { return __hip_atomic_fetch_add(p, v, __ATOMIC_RELAXED, __HIP_MEMORY_SCOPE_AGENT); }
__device__ __forceinline__ unsigned xb_xcc_id() { return (unsigned)__builtin_amdgcn_s_getreg((3 << 11) | 20) & 0xFu; }
#define XB_SPIN(cond, bar) do { unsigned _sp = 0; while (cond) { __builtin_amdgcn_s_sleep(1); \
    if ((++_sp & 255u) == 0u) { if (xb_ld(&(bar)[XB_TMO])) break; if (_sp > XB_SPIN_CAP) { atomicAdd(&(bar)[XB_TMO], 1u); break; } } } } while (0)
struct XcdBarrier { unsigned* bar; unsigned x; volatile LAS unsigned* st; };
__device__ __forceinline__ XcdBarrier xcd_barrier_post(unsigned* bar, volatile LAS unsigned* st) {
    XcdBarrier b; b.bar = bar; b.x = xb_xcc_id(); b.st = st;
    if (threadIdx.x == 0) (void)xb_add(&bar[XB_XCNT(b.x)], 1u);
    return b;
}
__device__ __forceinline__ void xcd_barrier_complete(unsigned* bar, unsigned x, unsigned& nloc, unsigned& nx) {
    const unsigned G = gridDim.x * gridDim.y * gridDim.z;
    unsigned sum, cnt, mine, sp = 0u;
    for (;;) {
        sum = 0u; cnt = 0u; mine = 0u;
#pragma unroll
        for (unsigned j = 0; j < 16; ++j) { const unsigned c = xb_ld(&bar[XB_XCNT(j)]); sum += c; cnt += (c > 0u) ? 1u : 0u; mine = (j == x) ? c : mine; }
        if (sum == G) break;
        __builtin_amdgcn_s_sleep(1);
        if ((++sp & 255u) == 0u) { if (xb_ld(&bar[XB_TMO])) break; if (sp > XB_SPIN_CAP) { atomicAdd(&bar[XB_TMO], 1u); break; } }
    }
    nloc = mine > 0u ? mine : 1u; nx = cnt > 0u ? cnt : 1u;
}
__device__ __forceinline__ void xcd_barrier(const XcdBarrier& b) {
    asm volatile("s_waitcnt vmcnt(0)" ::: "memory");
    __syncthreads();
    if (threadIdx.x == 0) {
        unsigned* bar = b.bar;
        __builtin_amdgcn_s_waitcnt(0);
        unsigned nloc = b.st[0], nx = b.st[1];
        if (nloc == 0u) { xcd_barrier_complete(bar, b.x, nloc, nx); b.st[0] = nloc; b.st[1] = nx; }
        const unsigned old = xb_add(&bar[XB_XSUB(b.x)], 1u);
        const unsigned gen = old / nloc;
        if (old + 1u == (gen + 1u) * nloc) {
            __builtin_amdgcn_fence(__ATOMIC_RELEASE, "agent");
            asm volatile("s_waitcnt vmcnt(0)" ::: "memory");
            const unsigned og = xb_add(&bar[XB_TOP], 1u);
            const unsigned tg = og / nx;
            if (og + 1u == (tg + 1u) * nx) xb_add(&bar[XB_TOPGEN], 1u);
            else XB_SPIN(xb_ld(&bar[XB_TOPGEN]) == tg, bar);
            __builtin_amdgcn_fence(__ATOMIC_ACQUIRE, "agent");
            xb_add(&bar[XB_XGEN(b.x)], 1u);
            asm volatile("s_waitcnt vmcnt(0)" ::: "memory");
        } else {
            XB_SPIN(xb_ld(&bar[XB_XGEN(b.x)]) == gen, bar);
            __builtin_amdgcn_fence(__ATOMIC_ACQUIRE, "agent");
            asm volatile("s_waitcnt vmcnt(0)" ::: "memory");
        }
    }
    __syncthreads();
}

__global__ void __launch_bounds__(NT, 2) mega(Args a) {
    extern __shared__ __attribute__((aligned(16))) unsigned char lds[];
    volatile LAS unsigned* st = (volatile LAS unsigned*)(LAS unsigned char*)(lds + LDS_BYTES - 16);
    if (threadIdx.x < 4) st[threadIdx.x] = 0u;
    __syncthreads();
    unsigned* barw = (unsigned*)(a.ws + WS_BAR);
    XcdBarrier bar = xcd_barrier_post(barw, st);
#pragma unroll 1
    for (int ph = 0; ph < N_PHASES; ++ph) {
        run_phase(a, lds, ph);
#ifdef DUP
        { int lyr = 0, sub = 100; if (ph > 0 && ph < N_PHASES - 1) phase_decode(ph, lyr, sub);
          if (sub == (DUP % 1000) && (ph == 0 || lyr == DUP / 1000) && ph < N_PHASES - 1) { xcd_barrier(bar); run_phase(a, lds, ph); } }
#endif
        if (ph + 1 < N_PHASES) xcd_barrier(bar);
    }
    if (xb_ld(&barw[XB_TMO]) != 0u) {
        const size_t gt = (size_t)blockIdx.x * NT + threadIdx.x, gs = (size_t)gridDim.x * NT;
        for (size_t i = gt; i < (size_t)T * DM; i += gs) a.out[i] = __builtin_nanf("");
    }
}

extern "C" void kernel_launch(void* const* d_in, const int* in_sizes, int n_in, void* d_out, int out_size,
                              void* d_ws, size_t ws_size, hipStream_t stream) {
    static int grid = 0;
    if (grid == 0) {
        int dev = 0, cus = 0;
        if (hipGetDevice(&dev) != hipSuccess || hipDeviceGetAttribute(&cus, hipDeviceAttributeMultiprocessorCount, dev) != hipSuccess) { grid = -1; return; }
        if (hipFuncSetAttribute((const void*)mega, hipFuncAttributeMaxDynamicSharedMemorySize, LDS_BYTES) != hipSuccess) { grid = -1; return; }
        (void)hipGetLastError();
        grid = cus;
        if (n_in != 26 || out_size != T * DM || ws_size < WS_END) { fprintf(stderr, "kernel_launch: unexpected sizes n_in %d out %d ws %zu (need %zu)\n", n_in, out_size, ws_size, (size_t)WS_END); grid = -1; return; }
    }
    if (grid < 0) return;
    (void)hipMemsetAsync((unsigned char*)d_ws + WS_BAR, 0, XCD_BAR_WORDS * 4, stream);
    Args a{};
    for (int i = 0; i < 26; ++i) a.in[i] = (const float*)d_in[i];
    a.out = (float*)d_out; a.ws = (unsigned char*)d_ws;
    hipLaunchKernelGGL(mega, dim3(grid), dim3(NT), LDS_BYTES, stream, a);
}
#endif
```

```cpp
#ifdef EMU
#include "emu.h"
#define DEV static inline
#define MDEV inline
#define OPAQUE(p)
#define TID emu_tid()
#define BID (EB->bid)
#define NBLK (EB->nblk)
#define SYNC() emu_sync_block()
#define WSYNC() emu_sync_wave()
#define mfma16(a, b, c) emu_mfma16(a, b, c)
DEV float shflx(float v, int m) { return emu_shfl_f(v, (emu_tid() & 63) ^ m); }
DEV int shflxi(int v, int m) { return (int)emu_shfl_u((unsigned)v, (emu_tid() & 63) ^ m); }
DEV float shfl(float v, int s) { return emu_shfl_f(v, s); }
DEV int atomic_add_i(int* p, int v) { return __atomic_fetch_add(p, v, __ATOMIC_RELAXED); }
DEV float fexp2(float x) { return exp2f(x); }
DEV float frcp(float x) { return 1.0f / x; }
DEV float frsq(float x) { return 1.0f / sqrtf(x); }
typedef short s16x4 __attribute__((vector_size(8)));
static inline s16x4 emu_tr4(const unsigned short* p) {
    EmuWave& w = EB->wave[emu_tid() >> 6]; int l = emu_tid() & 63;
    const unsigned short** tab = (const unsigned short**)w.a;
    tab[l] = p; emu_sync_wave();
    s16x4 r; int g = l & 48, i = l & 15;
    for (int q = 0; q < 4; ++q) r[q] = (short)tab[g + 4 * q + (i >> 2)][i & 3];
    emu_sync_wave(); return r;
}
#define tr4(p) emu_tr4(p)
#else
#include <hip/hip_runtime.h>
#include <cstdio>
#include <cstdint>
typedef short bf16x8 __attribute__((ext_vector_type(8)));
typedef float f32x4 __attribute__((ext_vector_type(4)));
typedef unsigned u32x4 __attribute__((ext_vector_type(4)));
typedef unsigned u32x2 __attribute__((ext_vector_type(2)));
#define DEV __device__ __forceinline__
#define MDEV __device__ __forceinline__
#define OPAQUE(p) asm volatile("" : "+v"(p))
DEV int tid_opaque() { int t = (int)threadIdx.x; asm volatile("" : "+v"(t)); return t; }
#define TID tid_opaque()
DEV int bid_opaque() { int b = (int)blockIdx.x; asm volatile("" : "+s"(b)); return b; }
#define BID bid_opaque()
#define NBLK ((int)gridDim.x)
#define SYNC() __syncthreads()
#define WSYNC() __builtin_amdgcn_wave_barrier()
#define mfma16(a, b, c) __builtin_amdgcn_mfma_f32_16x16x32_bf16(a, b, c, 0, 0, 0)
DEV float shflx(float v, int m) { return __shfl_xor(v, m); }
DEV int shflxi(int v, int m) { return __shfl_xor(v, m); }
DEV float shfl(float v, int s) { return __shfl(v, s); }
DEV int atomic_add_i(int* p, int v) { return atomicAdd(p, v); }
DEV float fexp2(float x) { return exp2f(x); }
DEV float frcp(float x) { return 1.0f / x; }
DEV float frsq(float x) { return rsqrtf(x); }
typedef short s16x4 __attribute__((ext_vector_type(4)));
#define tr4(p) __builtin_amdgcn_ds_read_tr16_b64_v4i16((__attribute__((address_space(3))) s16x4*)(p))
#endif

typedef unsigned short bf16;

#ifndef DM
#define DM 1024
#endif
#ifndef SEQ
#define SEQ 8192
#endif
#ifndef FF
#define FF 512
#endif
constexpr int NBATCH = 2, T = NBATCH * SEQ, DEPTH = 4;
constexpr int NIN = 3352, NINP = 3456, NIN8 = 3584;
constexpr int NT = 512;
constexpr int NCH = SEQ / 64;
constexpr int NCP = SEQ / 16;
constexpr int NCMP = NCP - 1;
constexpr int MOE_ROWS = 2 * T + 32 * 256;
constexpr float EPS = 1e-6f, NEGV = -1e30f, FORCEV = 1e4f, LOG2E = 1.4426950408889634f;

constexpr size_t al(size_t x) { return (x + 255) & ~(size_t)255; }
constexpr size_t WS_BAR = 0;
constexpr size_t WS_CNT = 16384;
constexpr size_t WS_MOD = WS_CNT + (size_t)DEPTH * 32 * 256;
constexpr size_t WS_LB = al(WS_MOD + (size_t)DEPTH * 2 * 6 * DM * 4);
constexpr size_t WS_CB = al(WS_LB + 2 * 512 * 4);
constexpr size_t WS_CS = al(WS_CB + 2 * 2 * 8 * 64 * 4);
constexpr size_t WS_WIN = al(WS_CS + 64);
constexpr size_t WS_WOUT = al(WS_WIN + (size_t)2 * NIN8 * DM * 2);
constexpr size_t WS_PW1 = al(WS_WOUT + (size_t)2 * DM * 1024 * 2);
constexpr size_t WS_PW2 = al(WS_PW1 + (size_t)2 * 2 * DM * DM * 2);
constexpr size_t WS_WC = al(WS_PW2 + (size_t)2 * DM * DM * 2);
constexpr size_t WS_W13 = al(WS_WC + (size_t)2 * 2 * 64 * 2048 * 2);
constexpr size_t WS_W2 = al(WS_W13 + 256);
constexpr size_t WS_H = al(WS_W2 + 256);
constexpr size_t WS_QN = al(WS_H + (size_t)T * DM * 2);
constexpr size_t WS_KCG = al(WS_QN + (size_t)T * 512 * 2);
constexpr size_t WS_VCG = al(WS_KCG + (size_t)T * 128 * 2);
constexpr size_t WS_KS = al(WS_VCG + (size_t)T * 128 * 2);
constexpr size_t WS_KW = al(WS_KS + (size_t)T * 128 * 2);
constexpr size_t WS_VST = al(WS_KW + (size_t)T * 128 * 2);
constexpr size_t WS_VWT = al(WS_VST + (size_t)T * 128 * 2);
constexpr size_t WS_KC = al(WS_VWT + (size_t)T * 128 * 2);
constexpr size_t WS_VCT = al(WS_KC + (size_t)4 * NCP * 64 * 2);
constexpr size_t WS_GATE = al(WS_VCT + (size_t)4 * NCP * 64 * 2);
constexpr size_t WS_HQ = al(WS_GATE + (size_t)T * 24 * 4);
constexpr size_t WS_HF = al(WS_HQ + (size_t)T * 512 * 2);
constexpr size_t WS_HV = al(WS_HF + (size_t)T * 512 * 4);
constexpr size_t WS_HGS = al(WS_HV + (size_t)T * 512 * 2);
constexpr size_t WS_UT = al(WS_HGS + (size_t)T * 512 * 2);
constexpr size_t WS_ST = al(WS_UT + (size_t)8 * NCH * 128 * 128 * 4);
constexpr size_t WS_GD = al(WS_ST + (size_t)8 * NCH * 128 * 128 * 2);
constexpr size_t WS_CAT = al(WS_GD + (size_t)8 * NCH * 128 * 4);
constexpr size_t WS_GLU = al(WS_CAT + (size_t)T * 1024 * 2);
constexpr size_t WS_TIE = al(WS_GLU + (size_t)T * DM * 2);
constexpr size_t WS_TIW = al(WS_TIE + (size_t)T * 2 * 4);
constexpr size_t WS_LIST = al(WS_TIW + (size_t)T * 2 * 4);
constexpr size_t WS_ACT = al(WS_LIST + (size_t)32 * T * 4);
constexpr size_t WS_YK = al(WS_ACT + (size_t)MOE_ROWS * FF * 2);
constexpr size_t WS_END = al(WS_YK + (size_t)MOE_ROWS * DM * 2);

struct Args { const float* in[26]; float* out; unsigned char* ws; };
enum { I_X = 0, I_C, I_ADAW, I_ADAB, I_NMIX, I_NFFN, I_WIN, I_WOUT, I_CWK, I_CWV, I_CPE, I_QG, I_KG, I_LBL, I_OG,
       I_PW1, I_DW, I_DWB, I_LNG, I_LNB, I_PW2, I_WG, I_WE, I_W1, I_W3, I_W2 };

#ifdef EMU
DEV unsigned char* wsp(const Args& a) { return a.ws; }
DEV float* outp(const Args& a) { return a.out; }
#else
DEV unsigned char* launder_ptr(const void* p) { unsigned long long v = (unsigned long long)p; unsigned lo = (unsigned)v, hi = (unsigned)(v >> 32);
    lo = (unsigned)__builtin_amdgcn_readfirstlane((int)lo); hi = (unsigned)__builtin_amdgcn_readfirstlane((int)hi); asm volatile("" : "+s"(lo), "+s"(hi)); return (unsigned char*)(((unsigned long long)hi << 32) | lo); }
DEV unsigned char* wsp(const Args& a) { return launder_ptr(a.ws); }
DEV float* outp(const Args& a) { return (float*)launder_ptr(a.out); }
#endif

#ifdef EMU
#define INP(a, X) ((a).in[X])
#else
DEV int zero_opaque() { int z = 0; asm volatile("" : "+s"(z)); return z; }
#define INP(a, X) ((a).in[(X) + zero_opaque()])
#endif

DEV unsigned f2bf(float f) { unsigned u = __builtin_bit_cast(unsigned, f); return (u + 0x7fffu + ((u >> 16) & 1u)) >> 16; }
DEV float bf2f(unsigned h) { return __builtin_bit_cast(float, h << 16); }
#ifdef EMU
DEV unsigned pk2(float lo, float hi) { return f2bf(lo) | (f2bf(hi) << 16); }
#else
typedef float f32x2_t __attribute__((ext_vector_type(2)));
typedef __bf16 bf16x2_t __attribute__((ext_vector_type(2)));
DEV unsigned pk2(float lo, float hi) { f32x2_t v = {lo, hi}; bf16x2_t b = __builtin_convertvector(v, bf16x2_t); return __builtin_bit_cast(unsigned, b); }
#endif
DEV float sigm(float x) { return frcp(1.0f + fexp2(-x * LOG2E)); }
DEV float siluf(float x) { return x * sigm(x); }
DEV f32x4 f4zero() { f32x4 z = {0.f, 0.f, 0.f, 0.f}; return z; }
DEV bf16x8 pack8(f32x4 a, f32x4 b) {
    u32x4 w; w[0] = pk2(a[0], a[1]); w[1] = pk2(a[2], a[3]); w[2] = pk2(b[0], b[1]); w[3] = pk2(b[2], b[3]);
    return __builtin_bit_cast(bf16x8, w);
}
DEV void st_bf4(bf16* p, f32x4 v) { u32x2 w; w[0] = pk2(v[0], v[1]); w[1] = pk2(v[2], v[3]); *(u32x2*)p = w; }


#ifdef EMU
namespace pg8 {
constexpr int BM = 256, BK = 64, HALF = 128, NXCD = 8, WGM = 8;
typedef unsigned short bf16_t;
struct Unit { int pm, pn; };
struct Gemm { const bf16_t* A; const bf16_t* Bt; int M, N, K; };
struct StaticOrder {
    int nM, nN, nwg, G, c;
    void init(int M, int N, int G_, int c_) { nM = M / BM; nN = N / BM; nwg = nM * nN; G = G_; c = c_; }
    bool next(int i, Unit& u) const {
        const long L = (long)i * G + c; if (L >= nwg) return false;
        int wgid = (int)L; { const int q = nwg / NXCD, r = nwg % NXCD, xcd = wgid % NXCD, off = wgid / NXCD; wgid = (xcd < r ? xcd * (q + 1) : r * (q + 1) + (xcd - r) * q) + off; }
        const int nig = WGM * nN, gid = wgid / nig, fm = gid * WGM, gsz = (nM - fm) < WGM ? (nM - fm) : WGM;
        u.pm = fm + ((wgid % nig) % gsz); u.pn = (wgid % nig) / gsz; return true;
    }
};
template <class Epi, class Sched, bool ALIGN_EPI = false, bool SP2 = false>
static inline void gemm_phase(unsigned char*, const Gemm g, const Sched& S, const Epi& E) {
    static_assert(!Epi::PERM, "stand-in implements PERM = false only");
    const int tid = emu_tid(), wid = tid >> 6, lane = tid & 63, wr = wid >> 2, wc = wid & 3, fr = lane & 15, fq = lane >> 4;
    Unit u;
    for (int ui = 0; S.next(ui, u); ++ui) {
        f32x4 acc[2][2][4][2];
        for (int ai = 0; ai < 2; ++ai) for (int bj = 0; bj < 2; ++bj) for (int m = 0; m < 4; ++m) for (int n = 0; n < 2; ++n) for (int r = 0; r < 4; ++r) {
            const int row = 256 * u.pm + 128 * ai + 64 * wr + 16 * m + fr, col = 256 * u.pn + 128 * bj + 32 * wc + 16 * n + 4 * fq + r; float sum = 0.f;
            const bf16_t* ap = g.A + (size_t)row * g.K; const bf16_t* bp = g.Bt + (size_t)col * g.K;
            for (int k = 0; k < g.K; ++k) sum += bf2f(ap[k]) * bf2f(bp[k]);
            acc[ai][bj][m][n][r] = sum; }
        E(acc, u, wr, wc, fr, fq);
    }
    emu_sync_block();
}
}
#else
namespace pg8 {
#define PG8_LAS __attribute__((address_space(3)))
typedef unsigned short bf16_t;
typedef short bf16x8 __attribute__((ext_vector_type(8)));
typedef float f32x4 __attribute__((ext_vector_type(4)));
typedef unsigned u32x4 __attribute__((ext_vector_type(4)));
constexpr int BM = 256, BK = 64, HALF = 128, HTB = HALF * BK * 2  , STAGE_BYTES = 8 * HTB, NXCD = 8, WGM = 8;

__host__ __device__ __forceinline__ int lds_byte(int r, int c) { const int st = (r >> 4) * 2 + (c >> 5), rr = r & 15, cc = c & 31, ob = rr * 64 + cc * 2; return st * 1024 + (ob ^ (((ob >> 9) & 1) << 5)); }
__host__ __device__ __forceinline__ void stage_rc(int b, int& R, int& C) { const int st = b / 1024, sb = b % 1024, swz = sb ^ (((sb >> 9) & 1) << 5); R = (st >> 1) * 16 + swz / 64; C = (st & 1) * 32 + (swz % 64) / 2; }
__host__ __device__ __forceinline__ int perm32(int rho) { const int n = rho >> 4, i = rho & 15; return 8 * (i >> 2) + 4 * n + (i & 3); }

struct Unit { int pm, pn; };
struct Gemm { const bf16_t* A; const bf16_t* Bt; int M, N, K; };

struct StaticOrder {
    int nM, nN, nwg, G, c;
    __host__ __device__ void init(int M, int N, int G_, int c_) { nM = M / BM; nN = N / BM; nwg = nM * nN; G = G_; c = c_; }
    __host__ __device__ bool next(int i, Unit& u) const {
        const long L = (long)i * G + c; if (L >= nwg) return false;
        int wgid = (int)L; { const int q = nwg / NXCD, r = nwg % NXCD, xcd = wgid % NXCD, off = wgid / NXCD; wgid = (xcd < r ? xcd * (q + 1) : r * (q + 1) + (xcd - r) * q) + off; }
        const int nig = WGM * nN, gid = wgid / nig, fm = gid * WGM, gsz = (nM - fm) < WGM ? (nM - fm) : WGM;
        u.pm = fm + ((wgid % nig) % gsz); u.pn = (wgid % nig) / gsz; return true;
    }
    __device__ __forceinline__ void a_ready(const Unit&) const {}
    __device__ __forceinline__ void done(const Unit&) const {}
};

__device__ __forceinline__ unsigned cvt_pk_bf16(float lo, float hi) { unsigned r; asm volatile("v_cvt_pk_bf16_f32 %0, %1, %2" : "=v"(r) : "v"(lo), "v"(hi)); return r; }
template <class Epi, class Sched, bool ALIGN_EPI = false, bool SP2 = false>
__device__ __forceinline__ void gemm_phase(PG8_LAS unsigned char* lds, const Gemm g, const Sched& S, const Epi& E) {
    const int tid = TID, wid = __builtin_amdgcn_readfirstlane(tid >> 6), lane = tid & 63, wr = wid >> 2, wc = wid & 3, fr = lane & 15, fq = lane >> 4;
    const int K = g.K, nt = K / BK;
    unsigned voffA[2], voffB[2];
#pragma unroll
    for (int i = 0; i < 2; ++i) { int R, C; stage_rc(tid * 16 + i * 8192, R, C); const int Rb = Epi::PERM ? ((R & ~31) + perm32(R & 31)) : R;
        voffA[i] = (unsigned)(R * K + C) * 2u; voffB[i] = (unsigned)(Rb * K + C) * 2u; }
    const size_t kstep = (size_t)(BK * 2);
    const size_t hstep = (size_t)HALF * K * 2;
    const size_t tstep = 2 * hstep;
    const unsigned ldsw = (unsigned)wid * 1024u;
    const int aoff = lds_byte(wr * 64 + fr, fq * 8), boff = lds_byte(wc * 32 + fr, fq * 8);
#define PG8_SA(b, h) (((b) * 2 + (h)) * HTB)
#define PG8_SB(b, h) ((4 + (b) * 2 + (h)) * HTB)
#define PG8_STAGE(bufoff, gbase, voff) do { _Pragma("unroll") for (int _i = 0; _i < 2; ++_i) \
        __builtin_amdgcn_global_load_lds((const unsigned*)((const char*)(gbase) + (voff)[_i]), (PG8_LAS unsigned*)(lds + (bufoff) + ldsw + _i * 8192), 16, 0, 0); } while (0)
#define PG8_LDA(dst, b, h) do { _Pragma("unroll") for (int m = 0; m < 4; ++m) _Pragma("unroll") for (int k = 0; k < 2; ++k) dst[m][k] = *(const PG8_LAS bf16x8*)(lds + PG8_SA(b, h) + aoff + m * 2048 + k * 1024); } while (0)
#define PG8_LDB(dst, b, h) do { _Pragma("unroll") for (int n = 0; n < 2; ++n) _Pragma("unroll") for (int k = 0; k < 2; ++k) dst[n][k] = *(const PG8_LAS bf16x8*)(lds + PG8_SB(b, h) + boff + n * 2048 + k * 1024); } while (0)
#define PG8_MMA(ai, bj, At, Bt) do { __builtin_amdgcn_s_setprio(1); _Pragma("unroll") for (int m = 0; m < 4; ++m) _Pragma("unroll") for (int n = 0; n < 2; ++n) _Pragma("unroll") for (int k = 0; k < 2; ++k) \
        acc[ai][bj][m][n] = __builtin_amdgcn_mfma_f32_16x16x32_bf16(Bt[n][k], At[m][k], acc[ai][bj][m][n], 0, 0, 0); __builtin_amdgcn_s_setprio(0); } while (0)
#define PG8_WAIT_V(n) asm volatile("s_waitcnt vmcnt(" #n ")" ::: "memory")
#define PG8_WAIT_L(n) asm volatile("s_waitcnt lgkmcnt(" #n ")" ::: "memory")
#define PG8_BAR __builtin_amdgcn_s_barrier()
#define PG8_SCHED __builtin_amdgcn_sched_barrier(0)
    Unit cur, nxt; int ui = 0;
    if (!S.next(0, cur)) return;
    f32x4 acc[2][2][4][2];
#pragma unroll
    for (int a = 0; a < 2; ++a)
#pragma unroll
        for (int b = 0; b < 2; ++b)
#pragma unroll
            for (int m = 0; m < 4; ++m)
#pragma unroll
                for (int n = 0; n < 2; ++n) acc[a][b][m][n] = (f32x4){0.f, 0.f, 0.f, 0.f};
    bf16x8 At[4][2], B0[2][2], B1[2][2];
    const char* cA = (const char*)g.A + (size_t)cur.pm * tstep; const char* cB = (const char*)g.Bt + (size_t)cur.pn * tstep;
    S.a_ready(cur);
    if constexpr (SP2) {
        PG8_STAGE(PG8_SB(0, 0), cB, voffB); PG8_STAGE(PG8_SB(0, 1), cB + hstep, voffB); PG8_STAGE(PG8_SA(0, 0), cA, voffA); PG8_STAGE(PG8_SA(0, 1), cA + hstep, voffA);
        if (wr == 1) PG8_BAR;
        PG8_WAIT_V(2); PG8_BAR;
        PG8_STAGE(PG8_SB(1, 0), cB + kstep, voffB); PG8_STAGE(PG8_SA(1, 0), cA + kstep, voffA); PG8_STAGE(PG8_SB(1, 1), cB + hstep + kstep, voffB);
        PG8_WAIT_V(6); PG8_BAR;
    } else {
        PG8_STAGE(PG8_SB(0, 0), cB, voffB); PG8_STAGE(PG8_SA(0, 0), cA, voffA); PG8_STAGE(PG8_SB(0, 1), cB + hstep, voffB); PG8_STAGE(PG8_SA(0, 1), cA + hstep, voffA);
        if (wr == 1) PG8_BAR;
        PG8_WAIT_V(4); PG8_BAR;
        PG8_STAGE(PG8_SB(1, 0), cB + kstep, voffB); PG8_STAGE(PG8_SA(1, 0), cA + kstep, voffA); PG8_STAGE(PG8_SB(1, 1), cB + hstep + kstep, voffB);
        PG8_WAIT_V(6); PG8_BAR;
    }
    for (;;) {
        const bool has_next = S.next(ui + 1, nxt);
        const char* nA = has_next ? (const char*)g.A + (size_t)nxt.pm * tstep : cA; const char* nB = has_next ? (const char*)g.Bt + (size_t)nxt.pn * tstep : cB;
        for (int t = 0; t < nt; t += 2) {
            const bool last = (t == nt - 2);
            const char* a1 = cA + (size_t)(t + 1) * kstep;
            const char* a2 = last ? nA : cA + (size_t)(t + 2) * kstep; const char* b2 = last ? nB : cB + (size_t)(t + 2) * kstep;
            const char* a3 = a2 + kstep; const char* b3 = b2 + kstep;
            if (last && has_next) S.a_ready(nxt);
            if constexpr (SP2) {
            PG8_LDB(B0, 0, 0); PG8_LDB(B1, 0, 1); PG8_SCHED; PG8_LDA(At, 0, 0); PG8_STAGE(PG8_SA(1, 1), a1 + hstep, voffA);
            PG8_WAIT_V(8); PG8_WAIT_L(0); PG8_BAR; PG8_MMA(0, 0, At, B0); PG8_MMA(0, 1, At, B1); PG8_BAR; PG8_SCHED;
            PG8_LDA(At, 0, 1); PG8_STAGE(PG8_SB(0, 0), b2, voffB); PG8_STAGE(PG8_SB(0, 1), b2 + hstep, voffB); PG8_STAGE(PG8_SA(0, 0), a2, voffA);
            PG8_WAIT_V(8); PG8_WAIT_L(0); PG8_BAR; PG8_MMA(1, 0, At, B0); PG8_MMA(1, 1, At, B1); PG8_BAR; PG8_SCHED;
            PG8_LDB(B0, 1, 0); PG8_LDB(B1, 1, 1); PG8_SCHED; PG8_LDA(At, 1, 0); PG8_STAGE(PG8_SA(0, 1), a2 + hstep, voffA);
            PG8_WAIT_V(8); PG8_WAIT_L(0); PG8_BAR; PG8_MMA(0, 0, At, B0); PG8_MMA(0, 1, At, B1); PG8_BAR; PG8_SCHED;
            PG8_LDA(At, 1, 1); PG8_STAGE(PG8_SB(1, 0), b3, voffB); PG8_STAGE(PG8_SB(1, 1), b3 + hstep, voffB); PG8_STAGE(PG8_SA(1, 0), a3, voffA);
            PG8_WAIT_V(8); PG8_WAIT_L(0); PG8_BAR; PG8_MMA(1, 0, At, B0); PG8_MMA(1, 1, At, B1); PG8_BAR; PG8_SCHED;
            } else {
            PG8_LDB(B0, 0, 0); PG8_SCHED; PG8_LDA(At, 0, 0); PG8_STAGE(PG8_SA(1, 1), a1 + hstep, voffA);
            PG8_WAIT_L(8); PG8_BAR; PG8_WAIT_L(0); PG8_MMA(0, 0, At, B0); PG8_BAR; PG8_SCHED;
            PG8_LDB(B1, 0, 1); PG8_STAGE(PG8_SB(0, 0), b2, voffB);
            PG8_BAR; PG8_WAIT_L(0); PG8_MMA(0, 1, At, B1); PG8_BAR;
            PG8_LDA(At, 0, 1); PG8_STAGE(PG8_SA(0, 0), a2, voffA);
            PG8_BAR; PG8_WAIT_L(0); PG8_MMA(1, 0, At, B0); PG8_BAR; PG8_SCHED;
            PG8_STAGE(PG8_SB(0, 1), b2 + hstep, voffB);
            PG8_WAIT_V(6); PG8_BAR; PG8_MMA(1, 1, At, B1); PG8_BAR;
            PG8_LDB(B0, 1, 0); PG8_SCHED; PG8_LDA(At, 1, 0); PG8_STAGE(PG8_SA(0, 1), a2 + hstep, voffA);
            PG8_WAIT_L(8); PG8_BAR; PG8_WAIT_L(0); PG8_MMA(0, 0, At, B0); PG8_BAR; PG8_SCHED;
            PG8_LDB(B1, 1, 1); PG8_STAGE(PG8_SB(1, 0), b3, voffB);
            PG8_BAR; PG8_WAIT_L(0); PG8_MMA(0, 1, At, B1); PG8_BAR;
            PG8_LDA(At, 1, 1); PG8_STAGE(PG8_SA(1, 0), a3, voffA);
            PG8_BAR; PG8_WAIT_L(0); PG8_MMA(1, 0, At, B0); PG8_BAR; PG8_SCHED;
            PG8_STAGE(PG8_SB(1, 1), b3 + hstep, voffB);
            PG8_WAIT_V(6); PG8_BAR; PG8_MMA(1, 1, At, B1); PG8_BAR;
            }
        }
        if constexpr (ALIGN_EPI) { if (wr == 0) PG8_BAR; }
        if constexpr (!Epi::AFTER_DRAIN) { E(acc, cur, wr, wc, fr, fq); S.done(cur); }
        if (!has_next) break;
#pragma unroll
        for (int a = 0; a < 2; ++a)
#pragma unroll
            for (int b = 0; b < 2; ++b)
#pragma unroll
                for (int m = 0; m < 4; ++m)
#pragma unroll
                    for (int n = 0; n < 2; ++n) acc[a][b][m][n] = (f32x4){0.f, 0.f, 0.f, 0.f};
        cur = nxt; cA = nA; cB = nB; ++ui;
        if constexpr (ALIGN_EPI) { if (wr == 1) PG8_BAR; }
    }
    PG8_WAIT_V(0);
    if constexpr (!ALIGN_EPI) { if (wr == 0) PG8_BAR; }
    PG8_BAR;
    if constexpr (Epi::AFTER_DRAIN) { E.fused(acc, cur, wr, wc, fr, fq, lds, wid, lane); S.done(cur); }
#undef PG8_SA
#undef PG8_SB
#undef PG8_STAGE
#undef PG8_LDA
#undef PG8_LDB
#undef PG8_MMA
#undef PG8_WAIT_V
#undef PG8_WAIT_L
#undef PG8_BAR
#undef PG8_SCHED
}
}
#endif

constexpr int LDT = 72;
constexpr int GEMM_AS = 256 * LDT, GEMM_BS = 128 * LDT;
constexpr int GEMM_LDS = 2 * (GEMM_AS + GEMM_BS) * 2;

template <class AF, class EPI>
DEV void gemm_tile(unsigned char* smem, AF af, const bf16* Bt, int ldb, int nvalid, int K, EPI& epi) {
    const int tid = TID, w = tid >> 6, l = tid & 63, h = l >> 4, c = l & 15, wm = w >> 1, wn = w & 1;
    bf16* As = (bf16*)smem; bf16* Bs = As + 2 * GEMM_AS;
    const bf16* ap[4]; const bf16* bp[2];
    const int col8 = (tid & 7) * 8, r0 = tid >> 3;
#pragma unroll
    for (int i = 0; i < 4; ++i) ap[i] = af(r0 + 64 * i) + col8;
#pragma unroll
    for (int i = 0; i < 2; ++i) { int rn = r0 + 64 * i; if (rn >= nvalid) rn = nvalid - 1; bp[i] = Bt + (size_t)rn * ldb + col8; }
    f32x4 acc[4][4];
#pragma unroll
    for (int i = 0; i < 4; ++i)
#pragma unroll
        for (int j = 0; j < 4; ++j) acc[i][j] = f4zero();
    bf16x8 ra[4], rb[2];
#pragma unroll
    for (int i = 0; i < 4; ++i) ra[i] = *(const bf16x8*)(ap[i]);
#pragma unroll
    for (int i = 0; i < 2; ++i) rb[i] = *(const bf16x8*)(bp[i]);
    SYNC();
#pragma unroll
    for (int i = 0; i < 4; ++i) *(bf16x8*)(As + (r0 + 64 * i) * LDT + col8) = ra[i];
#pragma unroll
    for (int i = 0; i < 2; ++i) *(bf16x8*)(Bs + (r0 + 64 * i) * LDT + col8) = rb[i];
    SYNC();
    const int nk = K / 64;
    for (int kt = 0; kt < nk; ++kt) {
        const int cur = kt & 1;
        if (kt + 1 < nk) {
#pragma unroll
            for (int i = 0; i < 4; ++i) ra[i] = *(const bf16x8*)(ap[i] + (kt + 1) * 64);
#pragma unroll
            for (int i = 0; i < 2; ++i) rb[i] = *(const bf16x8*)(bp[i] + (kt + 1) * 64);
        }
        const bf16* Ac = As + cur * GEMM_AS + (wm * 64 + c) * LDT + 8 * h;
        const bf16* Bc = Bs + cur * GEMM_BS + (wn * 64 + c) * LDT + 8 * h;
#pragma unroll
        for (int kk = 0; kk < 2; ++kk) {
            bf16x8 fa[4], fb[4];
#pragma unroll
            for (int i = 0; i < 4; ++i) { fa[i] = *(const bf16x8*)(Ac + i * 16 * LDT + kk * 32); fb[i] = *(const bf16x8*)(Bc + i * 16 * LDT + kk * 32); }
#pragma unroll
            for (int ni = 0; ni < 4; ++ni)
#pragma unroll
                for (int mi = 0; mi < 4; ++mi) acc[ni][mi] = mfma16(fb[ni], fa[mi], acc[ni][mi]);
        }
        if (kt + 1 < nk) {
            const int nx = cur ^ 1;
#pragma unroll
            for (int i = 0; i < 4; ++i) *(bf16x8*)(As + nx * GEMM_AS + (r0 + 64 * i) * LDT + col8) = ra[i];
#pragma unroll
            for (int i = 0; i < 2; ++i) *(bf16x8*)(Bs + nx * GEMM_BS + (r0 + 64 * i) * LDT + col8) = rb[i];
        }
        SYNC();
    }
    epi(acc, wm * 64, wn * 64, h, c);
}

struct ARows { const bf16* base; size_t ld; MDEV const bf16* operator()(int r) const { return base + (size_t)r * ld; } MDEV unsigned off(int r) const { return (unsigned)r * (unsigned)ld; } };

constexpr int LDB = 144;
constexpr int GEMM_BS2 = 64 * LDB;
constexpr int GEMM2_LDS = (2 * GEMM_AS + 2 * GEMM_BS2) * 2;
DEV bf16x8 tr_read8(const bf16* p0, const bf16* p1) {
    const s16x4 x = tr4(p0), y = tr4(p1); bf16x8 r;
    r[0] = x[0]; r[1] = x[1]; r[2] = x[2]; r[3] = x[3]; r[4] = y[0]; r[5] = y[1]; r[6] = y[2]; r[7] = y[3]; return r;
}
DEV int bperm(int r) { return (r & ~12) | ((r & 4) << 1) | ((r & 8) >> 1); }
template <class AF, class BF, class EPI>
DEV void gemm_tile2(unsigned char* smem, AF af, BF bf, int ldb, int K, EPI& epi) {
    const int tid = TID, w = tid >> 6, l = tid & 63, h = l >> 4, c = l & 15, wm = w >> 1, wn = w & 1, grp = w >> 2;
    bf16* As = (bf16*)smem; bf16* Bs = As + 2 * GEMM_AS;
    const bf16* abase = af.base; unsigned ao[4];
    const int col8 = (tid & 7) * 8, r0 = tid >> 3;
#pragma unroll
    for (int i = 0; i < 4; ++i) ao[i] = af.off(r0 + 64 * i) + col8;
    const int bn4 = (tid & 31) * 4, bk = tid >> 5, bkp = bperm(bk);
    const float* bp = bf(bn4); const bool bok = bp != nullptr;
    if (bok) bp += (size_t)bk * ldb;
    const size_t bstep = (size_t)16 * ldb;
    f32x4 acc[4][4];
#pragma unroll
    for (int i = 0; i < 4; ++i)
#pragma unroll
        for (int j = 0; j < 4; ++j) acc[i][j] = f4zero();
    bf16x8 ra[2][4]; f32x4 rb[2][4];
    const int nk = K / 64;
#pragma unroll
    for (int i = 0; i < 4; ++i) { ra[0][i] = *(const bf16x8*)(abase + ao[i]); rb[0][i] = bok ? *(const f32x4*)(bp + i * bstep) : f4zero(); }
    if (nk > 1) {
#pragma unroll
        for (int i = 0; i < 4; ++i) { ra[1][i] = *(const bf16x8*)(abase + (ao[i] + 64)); rb[1][i] = bok ? *(const f32x4*)(bp + (size_t)64 * ldb + i * bstep) : f4zero(); } }
    SYNC();
#pragma unroll
    for (int i = 0; i < 4; ++i) { *(bf16x8*)(As + (r0 + 64 * i) * LDT + col8) = ra[0][i]; st_bf4(Bs + (bkp + 16 * i) * LDB + bn4, rb[0][i]); }
    if (nk > 2) {
#pragma unroll
        for (int i = 0; i < 4; ++i) { ra[0][i] = *(const bf16x8*)(abase + (ao[i] + 128)); rb[0][i] = bok ? *(const f32x4*)(bp + (size_t)128 * ldb + i * bstep) : f4zero(); } }
    SYNC();
    for (int kb = 0; kb < nk; kb += 2) {
#pragma unroll
        for (int u = 0; u < 2; ++u) { const int kt = kb + u;
            if (kt < nk) {
#pragma unroll
                for (int p = 0; p < 2; ++p) {
                    if (grp == p) {
                        const bf16* Ac = As + u * GEMM_AS + (wm * 64 + c) * LDT + 8 * h;
                        const bf16* Bc = Bs + u * GEMM_BS2 + bperm(8 * h + (c >> 2)) * LDB + wn * 64 + 4 * (c & 3);
#pragma unroll
                        for (int kk = 0; kk < 2; ++kk) {
                            bf16x8 fa[4], fb[4];
#pragma unroll
                            for (int i = 0; i < 4; ++i) { fa[i] = *(const bf16x8*)(Ac + i * 16 * LDT + kk * 32); fb[i] = tr_read8(Bc + (32 * kk) * LDB + 16 * i, Bc + (32 * kk + 8) * LDB + 16 * i); }
#pragma unroll
                            for (int ni = 0; ni < 4; ++ni)
#pragma unroll
                                for (int mi = 0; mi < 4; ++mi) acc[ni][mi] = mfma16(fb[ni], fa[mi], acc[ni][mi]);
                        }
                    } else if (kt + 1 < nk) {
                        const int nx = u ^ 1;
#pragma unroll
                        for (int i = 0; i < 4; ++i) { *(bf16x8*)(As + nx * GEMM_AS + (r0 + 64 * i) * LDT + col8) = ra[nx][i]; st_bf4(Bs + nx * GEMM_BS2 + (bkp + 16 * i) * LDB + bn4, rb[nx][i]); }
                        if (kt + 3 < nk) {
#pragma unroll
                            for (int i = 0; i < 4; ++i) { ra[nx][i] = *(const bf16x8*)(abase + (ao[i] + (kt + 3) * 64)); rb[nx][i] = bok ? *(const f32x4*)(bp + (size_t)(kt + 3) * 64 * ldb + i * bstep) : f4zero(); } }
                    }
                    SYNC();
                }
            }
        }
    }
    epi(acc, wm * 64, wn * 64, h, c);
}
struct BPlain { const float* base; MDEV const float* operator()(int nt) const { return base + nt; } };
struct BInProjMap { const float* base; int n0; MDEV const float* operator()(int nt) const { const int n = n0 + nt; const int sc = n < 1280 ? n : (n < 3328 ? n + 24 : (n < 3352 ? 1280 + (n - 3328) : -1)); return sc < 0 ? nullptr : base + sc; } };
struct BInter { const float* s0; const float* s1; int n0; MDEV const float* operator()(int nt) const { const int n = n0 + nt, g = n >> 6, w = n & 63; return w < 32 ? s0 + g * 32 + w : s1 + g * 32 + w - 32; } };
struct BClamp64 { const float* base; MDEV const float* operator()(int nt) const { return base + (nt & 63); } };

struct EpiInProj {
    const Args* a; int m0, n0, li;
    MDEV void operator()(f32x4 (&acc)[4][4], int mw, int nw, int h, int c) const {
        unsigned char* ws = wsp(*a);
        const int nb = n0 + nw;
        const int tokb = m0 + mw + c;
        if (nb < 512 || (nb >= 768 && nb < 896) || (nb >= 1024 && nb < 1152)) {
            const float* gain; float mul = 1.f; bf16* dst; int kind;
            if (nb < 512) { gain = INP(*a, I_QG) + li * 64; mul = 0.125f * LOG2E; kind = 0; dst = (bf16*)(ws + WS_QN); }
            else if (nb < 896) { gain = INP(*a, I_KG) + (li * 3 + 1) * 64; kind = 1; dst = (bf16*)(ws + WS_KS); }
            else { gain = INP(*a, I_KG) + (li * 3 + 2) * 64; kind = 1; dst = (bf16*)(ws + WS_KW); }
            const int g = (nb >> 6) & 1;
#pragma unroll
            for (int mi = 0; mi < 4; ++mi) {
                float ss = 0.f;
#pragma unroll
                for (int ni = 0; ni < 4; ++ni) { f32x4 v = acc[ni][mi]; ss += v[0] * v[0] + v[1] * v[1] + v[2] * v[2] + v[3] * v[3]; }
                ss += shflx(ss, 16); ss += shflx(ss, 32);
                const float rs = frsq(ss * (1.0f / 64.0f) + EPS) * mul;
                const int tok = tokb + 16 * mi;
#pragma unroll
                for (int ni = 0; ni < 4; ++ni) {
                    const int d = 16 * ni + 4 * h; f32x4 v = acc[ni][mi], o;
#pragma unroll
                    for (int r = 0; r < 4; ++r) o[r] = v[r] * rs * gain[d + r];
                    if (kind == 0) st_bf4(dst + (size_t)tok * 512 + nb + d, o);
                    else { const int b = tok / SEQ, s = tok % SEQ; st_bf4(dst + ((size_t)(b * 2 + g) * SEQ + s) * 64 + d, o); }
                }
            }
        } else if (nb < 768) {
            bf16* dst = (bf16*)(ws + (nb < 640 ? WS_KCG : WS_VCG)); const int g = (nb >> 6) & 1;
#pragma unroll
            for (int mi = 0; mi < 4; ++mi) { const int tok = tokb + 16 * mi, b = tok / SEQ, s = tok % SEQ;
#pragma unroll
                for (int ni = 0; ni < 4; ++ni) st_bf4(dst + ((size_t)(b * 2 + g) * SEQ + s) * 64 + 16 * ni + 4 * h, acc[ni][mi]); }
        } else if (nb < 1280) {
            bf16* dst = (bf16*)(ws + (nb < 1024 ? WS_VST : WS_VWT)); const int g = (nb >> 6) & 1;
#pragma unroll
            for (int mi = 0; mi < 4; ++mi) { const int tok = tokb + 16 * mi, b = tok / SEQ, s = tok % SEQ;
                bf16* p = dst + ((size_t)(b * 2 + g) * NCH + (s >> 6)) * 4096 + (s & 63);
#pragma unroll
                for (int ni = 0; ni < 4; ++ni)
#pragma unroll
                    for (int r = 0; r < 4; ++r) p[(16 * ni + 4 * h + r) * 64] = (bf16)f2bf(acc[ni][mi][r]); }
        } else if (nb < 3328) {
            const int sec = (nb - 1280) >> 9, cc = (nb - 1280) & 511, hh = cc >> 7, d0 = cc & 127;
#pragma unroll
            for (int mi = 0; mi < 4; ++mi) { const int tok = tokb + 16 * mi, b = tok / SEQ, s = tok % SEQ;
                const size_t hrow = ((size_t)(b * 4 + hh) * SEQ + s) * 128 + d0;
#pragma unroll
                for (int ni = 0; ni < 4; ++ni) { const int d = 16 * ni + 4 * h; f32x4 v = acc[ni][mi], o;
                    if (sec == 0) { for (int r = 0; r < 4; ++r) o[r] = siluf(v[r]); st_bf4((bf16*)(ws + WS_HQ) + hrow + d, o); }
                    else if (sec == 1) { const float* lb = (const float*)(ws + WS_LB) + li * 512 + cc + d;
                        for (int r = 0; r < 4; ++r) o[r] = lb[r] + (1.0f - lb[r]) * sigm(v[r]);
                        *(f32x4*)((float*)(ws + WS_HF) + hrow + d) = o; }
                    else if (sec == 2) st_bf4((bf16*)(ws + WS_HV) + hrow + d, v);
                    else { for (int r = 0; r < 4; ++r) o[r] = siluf(v[r]); st_bf4((bf16*)(ws + WS_HGS) + (size_t)tok * 512 + cc + d, o); }
                } }
        } else if (nb == 3328) {
            float* dst = (float*)(ws + WS_GATE);
#pragma unroll
            for (int mi = 0; mi < 4; ++mi) { const int tok = tokb + 16 * mi;
#pragma unroll
                for (int ni = 0; ni < 2; ++ni)
#pragma unroll
                    for (int r = 0; r < 4; ++r) { const int n = 16 * ni + 4 * h + r; if (n < 24) dst[(size_t)tok * 24 + n] = sigm(acc[ni][mi][r]); } }
        }
    }
};

struct EpiResid {
    float* x; const float* gate; int m0, n0;
    MDEV void operator()(f32x4 (&acc)[4][4], int mw, int nw, int h, int c) const {
#pragma unroll
        for (int mi = 0; mi < 4; ++mi) { const int tok = m0 + mw + 16 * mi + c, b = tok / SEQ;
#pragma unroll
            for (int ni = 0; ni < 4; ++ni) { const int n = n0 + nw + 16 * ni + 4 * h;
                f32x4 g = *(const f32x4*)(gate + (size_t)b * 6 * DM + n); f32x4* p = (f32x4*)(x + (size_t)tok * DM + n); f32x4 v = *p;
#pragma unroll
                for (int r = 0; r < 4; ++r) v[r] += g[r] * acc[ni][mi][r];
                *p = v; } }
    }
};
template <int MODE> struct EpiGated {
    bf16* dst; size_t ld; int m0, n0, mvalid;
    MDEV void operator()(f32x4 (&acc)[4][4], int mw, int nw, int h, int c) const {
        const int cb = (n0 + nw) / 2;
#pragma unroll
        for (int mi = 0; mi < 4; ++mi) { const int m = mw + 16 * mi + c; if (m >= mvalid) continue;
#pragma unroll
            for (int ni = 0; ni < 2; ++ni) { f32x4 o;
#pragma unroll
                for (int r = 0; r < 4; ++r) { const float av = acc[ni][mi][r], bv = acc[ni + 2][mi][r]; o[r] = MODE == 0 ? av * sigm(bv) : siluf(av) * bv; }
                st_bf4(dst + (size_t)(m0 + m) * ld + cb + 16 * ni + 4 * h, o); } }
    }
};
struct EpiStoreBf {
    bf16* dst; size_t ld; int m0, n0, mvalid;
    MDEV void operator()(f32x4 (&acc)[4][4], int mw, int nw, int h, int c) const {
#pragma unroll
        for (int mi = 0; mi < 4; ++mi) { const int m = mw + 16 * mi + c; if (m >= mvalid) continue;
#pragma unroll
            for (int ni = 0; ni < 4; ++ni) st_bf4(dst + (size_t)(m0 + m) * ld + n0 + nw + 16 * ni + 4 * h, acc[ni][mi]); }
    }
};
struct EpiCmp {
    const Args* a; int kv, bg, m0, li;
    MDEV void operator()(f32x4 (&acc)[4][4], int mw, int nw, int h, int c) const {
        if (nw != 0) return;
        unsigned char* ws = wsp(*a);
        const float* bp8 = (const float*)(ws + WS_CB) + (li * 2 + kv) * 8 * 64;
        float bias[16];
#pragma unroll
        for (int q = 0; q < 16; ++q) { const int e = 16 * (q >> 2) + 4 * h + (q & 3); float v = 0.f;
#pragma unroll
            for (int kp = 0; kp < 8; ++kp) v += bp8[kp * 64 + e];
            bias[q] = v; }
        const float* gain = INP(*a, I_KG) + (li * 3 + 0) * 64;
#pragma unroll
        for (int mi = 0; mi < 4; ++mi) { const int n = m0 + mw + 16 * mi + c; const bool ok = n < NCMP;
            f32x4 v[4]; float ss = 0.f;
#pragma unroll
            for (int ni = 0; ni < 4; ++ni) { v[ni] = acc[ni][mi];
#pragma unroll
                for (int r = 0; r < 4; ++r) { v[ni][r] += bias[4 * ni + r]; ss += v[ni][r] * v[ni][r]; } }
            ss += shflx(ss, 16); ss += shflx(ss, 32);
            if (n >= NCP) continue;
            if (kv == 0) { const float rs = frsq(ss * (1.0f / 64.0f) + EPS); bf16* p = (bf16*)(ws + WS_KC) + ((size_t)bg * NCP + n) * 64;
#pragma unroll
                for (int ni = 0; ni < 4; ++ni) { f32x4 o;
#pragma unroll
                    for (int r = 0; r < 4; ++r) o[r] = ok ? v[ni][r] * rs * gain[16 * ni + 4 * h + r] : 0.f;
                    st_bf4(p + 16 * ni + 4 * h, o); }
            } else { bf16* p = (bf16*)(ws + WS_VCT) + (size_t)bg * 64 * NCP + n;
#pragma unroll
                for (int ni = 0; ni < 4; ++ni)
#pragma unroll
                    for (int r = 0; r < 4; ++r) p[(size_t)(16 * ni + 4 * h + r) * NCP] = (bf16)f2bf(ok ? v[ni][r] : 0.f); }
        }
    }
};


struct EpiResid8 {
    static constexpr bool PERM = false, AFTER_DRAIN = false;
    float* x; const float* gate;
    MDEV void operator()(const f32x4 (&acc)[2][2][4][2], const pg8::Unit& u, int wr, int wc, int fr, int fq) const {
#pragma unroll
        for (int ai = 0; ai < 2; ++ai)
#pragma unroll
            for (int m = 0; m < 4; ++m) { const int row = 256 * u.pm + 128 * ai + 64 * wr + 16 * m + fr, b = row / SEQ;
#pragma unroll
                for (int bj = 0; bj < 2; ++bj)
#pragma unroll
                    for (int n = 0; n < 2; ++n) { const int col = 256 * u.pn + 128 * bj + 32 * wc + 16 * n + 4 * fq;
                        const f32x4 g = *(const f32x4*)(gate + (size_t)b * 6 * DM + col); f32x4* p = (f32x4*)(x + (size_t)row * DM + col); f32x4 v = *p;
#pragma unroll
                        for (int r = 0; r < 4; ++r) v[r] += g[r] * acc[ai][bj][m][n][r];
                        *p = v; } }
    }
};
struct EpiGlu8 {
    static constexpr bool PERM = false, AFTER_DRAIN = false;
    bf16* dst;
    MDEV void operator()(const f32x4 (&acc)[2][2][4][2], const pg8::Unit& u, int wr, int wc, int fr, int fq) const {
#pragma unroll
        for (int ai = 0; ai < 2; ++ai)
#pragma unroll
            for (int m = 0; m < 4; ++m) { const int row = 256 * u.pm + 128 * ai + 64 * wr + 16 * m + fr;
#pragma unroll
                for (int bj = 0; bj < 2; ++bj) { const int col = 128 * u.pn + 64 * bj + 16 * wc + 4 * fq; f32x4 o;
#pragma unroll
                    for (int r = 0; r < 4; ++r) o[r] = acc[ai][bj][m][0][r] * sigm(acc[ai][bj][m][1][r]);
                    st_bf4(dst + (size_t)row * DM + col, o); } }
    }
};
struct EpiInProj8 {
    static constexpr bool PERM = false, AFTER_DRAIN = false;
    const Args* a; int li;
    MDEV void operator()(const f32x4 (&acc)[2][2][4][2], const pg8::Unit& u, int wr, int wc, int fr, int fq) const {
        unsigned char* ws = wsp(*a);
        const int nb = 256 * u.pn + 64 * wc;
        if (nb >= 3392) return;
#pragma unroll
        for (int ai = 0; ai < 2; ++ai)
#pragma unroll
            for (int m = 0; m < 4; ++m) {
                const int tok = 256 * u.pm + 128 * ai + 64 * wr + 16 * m + fr, b = tok / SEQ, sq = tok % SEQ;
                if (nb < 512 || (nb >= 768 && nb < 896) || (nb >= 1024 && nb < 1152)) {
                    const float* gain; float mul = 1.f; int kind;
                    if (nb < 512) { gain = INP(*a, I_QG) + li * 64; mul = 0.125f * LOG2E; kind = 0; }
                    else if (nb < 896) { gain = INP(*a, I_KG) + (li * 3 + 1) * 64; kind = 1; }
                    else { gain = INP(*a, I_KG) + (li * 3 + 2) * 64; kind = 2; }
                    const int g = (nb >> 6) & 1;
                    float ss = 0.f;
#pragma unroll
                    for (int bj = 0; bj < 2; ++bj)
#pragma unroll
                        for (int n = 0; n < 2; ++n) { const f32x4 v = acc[ai][bj][m][n]; ss += v[0] * v[0] + v[1] * v[1] + v[2] * v[2] + v[3] * v[3]; }
                    ss += shflx(ss, 16); ss += shflx(ss, 32);
                    const float rs = frsq(ss * (1.0f / 64.0f) + EPS) * mul;
#pragma unroll
                    for (int bj = 0; bj < 2; ++bj)
#pragma unroll
                        for (int n = 0; n < 2; ++n) { const int d = 32 * bj + 16 * n + 4 * fq; const f32x4 v = acc[ai][bj][m][n]; f32x4 o;
#pragma unroll
                            for (int r = 0; r < 4; ++r) o[r] = v[r] * rs * gain[d + r];
                            if (kind == 0) st_bf4((bf16*)(ws + WS_QN) + (size_t)tok * 512 + nb + d, o);
                            else st_bf4((bf16*)(ws + (kind == 1 ? WS_KS : WS_KW)) + ((size_t)(b * 2 + g) * SEQ + sq) * 64 + d, o); }
                } else if (nb < 768) {
                    bf16* dst = (bf16*)(ws + (nb < 640 ? WS_KCG : WS_VCG)); const int g = (nb >> 6) & 1;
#pragma unroll
                    for (int bj = 0; bj < 2; ++bj)
#pragma unroll
                        for (int n = 0; n < 2; ++n) st_bf4(dst + ((size_t)(b * 2 + g) * SEQ + sq) * 64 + 32 * bj + 16 * n + 4 * fq, acc[ai][bj][m][n]);
                } else if (nb < 1280) {
                    bf16* dst = (bf16*)(ws + (nb < 1024 ? WS_VST : WS_VWT)); const int g = (nb >> 6) & 1;
                    bf16* p = dst + ((size_t)(b * 2 + g) * NCH + (sq >> 6)) * 4096 + (sq & 63);
#pragma unroll
                    for (int bj = 0; bj < 2; ++bj)
#pragma unroll
                        for (int n = 0; n < 2; ++n)
#pragma unroll
                            for (int r = 0; r < 4; ++r) p[(32 * bj + 16 * n + 4 * fq + r) * 64] = (bf16)f2bf(acc[ai][bj][m][n][r]);
                } else if (nb < 3328) {
                    const int sec = (nb - 1280) >> 9, cc = (nb - 1280) & 511, hh = cc >> 7, d0 = cc & 127;
                    const size_t hrow = ((size_t)(b * 4 + hh) * SEQ + sq) * 128 + d0;
#pragma unroll
                    for (int bj = 0; bj < 2; ++bj)
#pragma unroll
                        for (int n = 0; n < 2; ++n) { const int d = 32 * bj + 16 * n + 4 * fq; const f32x4 v = acc[ai][bj][m][n]; f32x4 o;
                            if (sec == 0) {
#pragma unroll
                                for (int r = 0; r < 4; ++r) o[r] = siluf(v[r]);
                                st_bf4((bf16*)(ws + WS_HQ) + hrow + d, o); }
                            else if (sec == 1) { const float* lb = (const float*)(ws + WS_LB) + li * 512 + cc + d;
#pragma unroll
                                for (int r = 0; r < 4; ++r) o[r] = lb[r] + (1.0f - lb[r]) * sigm(v[r]);
                                *(f32x4*)((float*)(ws + WS_HF) + hrow + d) = o; }
                            else if (sec == 2) st_bf4((bf16*)(ws + WS_HV) + hrow + d, v);
                            else {
#pragma unroll
                                for (int r = 0; r < 4; ++r) o[r] = siluf(v[r]);
                                st_bf4((bf16*)(ws + WS_HGS) + (size_t)tok * 512 + cc + d, o); } }
                } else {
                    float* dst = (float*)(ws + WS_GATE);
#pragma unroll
                    for (int n = 0; n < 2; ++n)
#pragma unroll
                        for (int r = 0; r < 4; ++r) { const int d = 16 * n + 4 * fq + r; if (d < 24) dst[(size_t)tok * 24 + d] = sigm(acc[ai][0][m][n][r]); }
                }
            }
    }
};

DEV void tr_tile(unsigned char* smem, const float* src0, const float* src1, int ld, int K, int mode, bf16* dst, int n0, int k0) {
    bf16* tl = (bf16*)smem;
    const int tid = TID;
    SYNC();
#pragma unroll
    for (int i = 0; i < 8; ++i) {
        const int e = tid + 512 * i, kk = e >> 6, nn = e & 63, n = n0 + nn; float v = 0.f;
        if (mode == 0) v = src0[(size_t)(k0 + kk) * ld + n];
        else if (mode == 1) { int sc = n < 1280 ? n : (n < 3328 ? n + 24 : (n < 3352 ? 1280 + (n - 3328) : -1)); if (sc >= 0) v = src0[(size_t)(k0 + kk) * ld + sc]; }
        else { const int g = n >> 6, w = n & 63; v = (w < 32) ? src0[(size_t)(k0 + kk) * ld + g * 32 + w] : src1[(size_t)(k0 + kk) * ld + g * 32 + w - 32]; }
        tl[nn * LDT + kk] = (bf16)f2bf(v);
    }
    SYNC();
    const int nn = tid >> 3, k8 = (tid & 7) * 8;
    *(bf16x8*)(dst + (size_t)(n0 + nn) * K + k0 + k8) = *(const bf16x8*)(tl + nn * LDT + k8);
}

DEV int tr_col(int mode, int n) {
    if (mode == 0) return n;
    const int pn = n >> 8, ct = n & 255;
    if (mode == 5) { const int bj = ct >> 7, wc = (ct >> 5) & 3, j = ct & 31, L = 256 * pn + 64 * wc + 32 * bj + j; return L < 1280 ? L : (L < 3328 ? L + 24 : (L < 3352 ? 1280 + (L - 3328) : -1)); }
    { const int bj = ct >> 7, wc = (ct >> 5) & 3, nn = (ct >> 4) & 1, j = ct & 15, Lc = 128 * pn + 64 * bj + 16 * wc + j; return nn == 0 ? Lc : DM + Lc; }
}
DEV void tr_tile(unsigned char* smem, const float* src, int ld, int K, int mode, bf16* dst, int n0, int k0) {
    bf16* tl = (bf16*)smem;
    const int tid = TID;
    SYNC();
    { const int nn = tid & 63, n = n0 + nn, sc = tr_col(mode, n);
#pragma unroll
      for (int i = 0; i < 8; ++i) { const int kk = (tid >> 6) + 8 * i; const float v = sc >= 0 ? src[(size_t)(k0 + kk) * ld + sc] : 0.f; tl[nn * LDT + kk] = (bf16)f2bf(v); } }
    SYNC();
    const int nn = tid >> 3, k8 = (tid & 7) * 8;
    *(bf16x8*)(dst + (size_t)(n0 + nn) * K + k0 + k8) = *(const bf16x8*)(tl + nn * LDT + k8);
}
struct TrJob { const float* s; int ld, K, N, mode; bf16* dst; };
DEV void p0_phase(const Args& a, unsigned char* smem) {
    unsigned char* ws = wsp(a); const int tid = TID;
    { int item = BID, base = 0;
      for (int j = 0; j < 8; ++j) { TrJob J; const int i = j & 1;
        if (j < 2) J = {INP(a, I_WIN) + (size_t)i * DM * NIN, NIN, DM, NIN8, 5, (bf16*)(ws + WS_WIN) + (size_t)i * NIN8 * DM};
        else if (j < 4) J = {INP(a, I_WOUT) + (size_t)i * 1024 * DM, DM, 1024, DM, 0, (bf16*)(ws + WS_WOUT) + (size_t)i * DM * 1024};
        else if (j < 6) J = {INP(a, I_PW1) + (size_t)i * DM * 2 * DM, 2 * DM, DM, 2 * DM, 6, (bf16*)(ws + WS_PW1) + (size_t)i * 2 * DM * DM};
        else J = {INP(a, I_PW2) + (size_t)i * DM * DM, DM, DM, DM, 0, (bf16*)(ws + WS_PW2) + (size_t)i * DM * DM};
        const int tn = J.N / 64, tk = J.K / 64, nt = tn * tk;
        while (item < base + nt) { const int it = item - base; tr_tile(smem, J.s, J.ld, J.K, J.mode, J.dst, (it % tn) * 64, (it / tn) * 64); item += NBLK; }
        base += nt; }
      SYNC(); }
    {
        float* red = (float*)smem;
        constexpr int NG = 6 * DM / 128; const int ntask = DEPTH * NG;
        for (int t = BID; t < ntask; t += NBLK) {
            const int l = t / NG, j0 = (t % NG) * 128, cq = tid & 31, kr = tid >> 5;
            const float* w = INP(a, I_ADAW) + (size_t)l * DM * 6 * DM + j0 + 4 * cq; const float* cc = INP(a, I_C);
            f32x4 a0 = f4zero(), a1 = f4zero();
#pragma unroll 8
            for (int i = 0; i < DM / 16; ++i) { const int k = kr + 16 * i; const f32x4 wv = *(const f32x4*)(w + (size_t)k * 6 * DM); const float s0 = siluf(cc[k]), s1 = siluf(cc[DM + k]);
#pragma unroll
                for (int r = 0; r < 4; ++r) { a0[r] += s0 * wv[r]; a1[r] += s1 * wv[r]; } }
            SYNC();
            *(f32x4*)(red + (kr * 2 + 0) * 128 + 4 * cq) = a0; *(f32x4*)(red + (kr * 2 + 1) * 128 + 4 * cq) = a1;
            SYNC();
            if (tid < 256) { const int b = tid >> 7, col = tid & 127; float sum = INP(a, I_ADAB)[(size_t)l * 6 * DM + j0 + col];
#pragma unroll
                for (int q = 0; q < 16; ++q) sum += red[(q * 2 + b) * 128 + col];
                ((float*)(ws + WS_MOD))[((size_t)l * 2 + b) * 6 * DM + j0 + col] = sum; }
        }
    }
    for (int t = BID; t < 32; t += NBLK) {
        float* red = (float*)smem; const int ikv = t >> 3, kp = t & 7, i = ikv >> 1, kv = ikv & 1, e = tid & 63, ks = tid >> 6;
        const float* W = INP(a, kv ? I_CWV : I_CWK) + (size_t)i * 2048 * 64 + e; const float* pe = INP(a, I_CPE) + (size_t)i * 2048;
        float sum = 0.f;
#pragma unroll 8
        for (int q = 0; q < 32; ++q) { const int k = kp * 256 + ks * 32 + q; sum += pe[k] * W[(size_t)k * 64]; }
        SYNC(); red[ks * 64 + e] = sum; SYNC();
        if (tid < 64) { float v = 0.f; for (int q = 0; q < 8; ++q) v += red[q * 64 + tid]; ((float*)(ws + WS_CB))[(ikv * 8 + kp) * 64 + tid] = v; }
    }
    if (BID == 0) {
        for (int i = tid; i < DEPTH * 32; i += NT) ((int*)(ws + WS_CNT))[i * 64] = 0;
        for (int n = tid; n < 512; n += NT) { const float l0 = INP(a, I_LBL)[n], l1 = INP(a, I_LBL)[512 + n]; const float m = fmaxf(l0, l1);
            const float e0 = fexp2((l0 - m) * LOG2E), e1 = fexp2((l1 - m) * LOG2E);
            ((float*)(ws + WS_LB))[n] = 0.f; ((float*)(ws + WS_LB))[512 + n] = e1 / (e0 + e1); }
        if (tid < 2) { const int i = tid; float mq = 0.f; for (int d = 0; d < 64; ++d) mq = fmaxf(mq, fabsf(INP(a, I_QG)[i * 64 + d]));
            for (int br = 0; br < 3; ++br) { float mk = 0.f; for (int d = 0; d < 64; ++d) mk = fmaxf(mk, fabsf(INP(a, I_KG)[(i * 3 + br) * 64 + d]));
                ((float*)(ws + WS_CS))[i * 4 + br] = 8.0f * mq * mk * LOG2E; } }
    }
}

constexpr int NJV = DM / 256;
DEV void moe_bases(const int* cnt, int* rb  ) {
    if (TID == 0) { int acc = 0; for (int e = 0; e < 32; ++e) { rb[e] = acc; acc += ((cnt[e * 64] + 255) >> 8) << 8; } rb[32] = acc; }
    SYNC();
}
DEV void norm_phase(const Args& a, unsigned char* smem, int l) {
    unsigned char* ws = wsp(a); const int tid = TID, w = tid >> 6, lane = tid & 63;
    int* rb = (int*)smem;
    if (l > 0) moe_bases((const int*)(ws + WS_CNT) + (l - 1) * 32 * 64, rb);
    const float* mod = (const float*)(ws + WS_MOD);
    const bf16* yk = (const bf16*)(ws + WS_YK);
    for (int row = BID * 8 + w; row < T; row += NBLK * 8) {
        const int b = row / SEQ;
        f32x4 v[NJV];
        const float* xin = (l == 0) ? INP(a, I_X) : outp(a);
#pragma unroll
        for (int j = 0; j < NJV; ++j) v[j] = *(const f32x4*)(xin + (size_t)row * DM + 4 * lane + 256 * j);
        if (l > 0) {
            const int* tie = (const int*)(ws + WS_TIE) + (size_t)row * 2; const float* tiw = (const float*)(ws + WS_TIW) + (size_t)row * 2;
            const int e0 = tie[0] >> 14, p0 = tie[0] & 16383, e1 = tie[1] >> 14, p1 = tie[1] & 16383;
            const float w0 = tiw[0], w1 = tiw[1];
            const bf16* y0 = yk + (size_t)(rb[e0] + p0) * DM; const bf16* y1 = yk + (size_t)(rb[e1] + p1) * DM;
            const float* gf = mod + ((size_t)(l - 1) * 2 + b) * 6 * DM + 5 * DM;
#pragma unroll
            for (int j = 0; j < NJV; ++j) { const int cidx = 4 * lane + 256 * j; u32x2 q0 = *(const u32x2*)(y0 + cidx), q1 = *(const u32x2*)(y1 + cidx);
                f32x4 g = *(const f32x4*)(gf + cidx);
                v[j][0] += g[0] * (w0 * bf2f(q0[0] & 0xffff) + w1 * bf2f(q1[0] & 0xffff));
                v[j][1] += g[1] * (w0 * bf2f(q0[0] >> 16) + w1 * bf2f(q1[0] >> 16));
                v[j][2] += g[2] * (w0 * bf2f(q0[1] & 0xffff) + w1 * bf2f(q1[1] & 0xffff));
                v[j][3] += g[3] * (w0 * bf2f(q0[1] >> 16) + w1 * bf2f(q1[1] >> 16)); }
        }
#pragma unroll
        for (int j = 0; j < NJV; ++j) *(f32x4*)(outp(a) + (size_t)row * DM + 4 * lane + 256 * j) = v[j];
        if (l == DEPTH) continue;
        float ss = 0.f;
#pragma unroll
        for (int j = 0; j < NJV; ++j) ss += v[j][0] * v[j][0] + v[j][1] * v[j][1] + v[j][2] * v[j][2] + v[j][3] * v[j][3];
#pragma unroll
        for (int o = 1; o < 64; o <<= 1) ss += shflx(ss, o);
        const float rs = frsq(ss * (1.0f / DM) + EPS);
        const float* mm = mod + ((size_t)l * 2 + b) * 6 * DM; const float* nm = INP(a, I_NMIX) + (size_t)l * DM;
        bf16* hb = (bf16*)(ws + WS_H) + (size_t)row * DM;
#pragma unroll
        for (int j = 0; j < NJV; ++j) { const int cidx = 4 * lane + 256 * j; f32x4 g = *(const f32x4*)(nm + cidx), sh = *(const f32x4*)(mm + cidx), sc = *(const f32x4*)(mm + DM + cidx), o;
#pragma unroll
            for (int r = 0; r < 4; ++r) o[r] = v[j][r] * rs * g[r] * (1.0f + sc[r]) + sh[r];
            st_bf4(hb + cidx, o); }
    }
}

DEV void route_phase(const Args& a, unsigned char* smem, int l) {
    unsigned char* ws = wsp(a); const int tid = TID;
    float* W = (float*)smem;
    int* lcnt = (int*)(smem + DM * 36 * 4); int* lbase = lcnt + 32; int* tinfo = lbase + 32;
    SYNC();
    { const f32x4* wg4 = (const f32x4*)(INP(a, I_WG) + (size_t)l * DM * 4); const f32x4* we4 = (const f32x4*)(INP(a, I_WE) + (size_t)l * DM * 32);
      for (int i = tid; i < DM; i += NT) *(f32x4*)(W + i * 36) = wg4[i];
#pragma unroll 4
      for (int i = tid; i < DM * 8; i += NT) *(f32x4*)(W + (i >> 3) * 36 + 4 + 4 * (i & 7)) = we4[i]; }
    if (tid < 32) lcnt[tid] = 0;
    SYNC();
    const float* mod = (const float*)(ws + WS_MOD); const float* nf = INP(a, I_NFFN) + (size_t)l * DM;
    int* cnt = (int*)(ws + WS_CNT) + l * 32 * 64;
    constexpr int NI = DM / 32;
    for (int pass0 = BID; pass0 < T / 16; pass0 += 4 * NBLK) {
#pragma unroll 1
        for (int pi = 0; pi < 4; ++pi) {
            const int pass = pass0 + pi * NBLK; if (pass >= T / 16) break;
            const int tok = pass * 16 + (tid >> 5), part = tid & 31, b = tok / SEQ;
            const float* xr = outp(a) + (size_t)tok * DM; float xv[NI]; float ss = 0.f;
#pragma unroll
            for (int i = 0; i < NI; ++i) { xv[i] = xr[part + 32 * i]; ss += xv[i] * xv[i]; }
#pragma unroll
            for (int o = 1; o < 32; o <<= 1) ss += shflx(ss, o);
            const float rs = frsq(ss * (1.0f / DM) + EPS);
            const float* mm = mod + ((size_t)l * 2 + b) * 6 * DM; bf16* hb = (bf16*)(ws + WS_H) + (size_t)tok * DM;
            float acc[36];
#pragma unroll
            for (int n = 0; n < 36; ++n) acc[n] = 0.f;
            { float av[NI], cv[NI];
#pragma unroll
              for (int i = 0; i < NI; ++i) { const int k = part + 32 * i; av[i] = nf[k] * (1.0f + mm[4 * DM + k]); cv[i] = mm[3 * DM + k]; }
#pragma unroll
              for (int i = 0; i < NI; ++i) { xv[i] = xv[i] * rs * av[i] + cv[i]; hb[part + 32 * i] = (bf16)f2bf(xv[i]); } }
#pragma unroll 4
            for (int i = 0; i < NI; ++i) { const int k = part + 32 * i; const float hn = xv[i];
                const f32x4* wr = (const f32x4*)(W + k * 36);
#pragma unroll
                for (int n4 = 0; n4 < 9; ++n4) { const f32x4 wv = wr[n4];
#pragma unroll
                    for (int r = 0; r < 4; ++r) acc[4 * n4 + r] += hn * wv[r]; } }
#pragma unroll
            for (int n = 0; n < 36; ++n) {
#pragma unroll
                for (int o = 1; o < 32; o <<= 1) acc[n] += shflx(acc[n], o); }
            if (part == 0) {
                int gs = 0; float gm = acc[0];
#pragma unroll
                for (int g = 1; g < 4; ++g) if (acc[g] > gm) { gm = acc[g]; gs = g; }
                float den = 0.f;
#pragma unroll
                for (int g = 0; g < 4; ++g) den += fexp2((acc[g] - gm) * LOG2E);
                const float ggate = 1.0f / den;
                float el[8];
#pragma unroll
                for (int j = 0; j < 8; ++j) { el[j] = acc[4 + j];
#pragma unroll
                    for (int g = 1; g < 4; ++g) if (gs == g) el[j] = acc[4 + 8 * g + j]; }
                int ia = 0; float va = el[0];
#pragma unroll
                for (int j = 1; j < 8; ++j) if (el[j] > va) { va = el[j]; ia = j; }
                int ib = -1; float vb = -3e38f;
#pragma unroll
                for (int j = 0; j < 8; ++j) if (j != ia && el[j] > vb) { vb = el[j]; ib = j; }
                const float wa = 1.0f / (1.0f + fexp2((vb - va) * LOG2E)), wb = 1.0f - wa;
                const int e0 = gs * 8 + ia, e1 = gs * 8 + ib;
                const int p0 = atomic_add_i(lcnt + e0, 1), p1 = atomic_add_i(lcnt + e1, 1);
                int* ti = tinfo + (pi * 16 + (tid >> 5)) * 4;
                ti[0] = (e0 << 14) | p0; ti[1] = (e1 << 14) | p1; ti[2] = __builtin_bit_cast(int, ggate * wa); ti[3] = __builtin_bit_cast(int, ggate * wb);
            }
        }
        SYNC();
        if (tid < 32) { const int n = lcnt[tid]; lbase[tid] = n > 0 ? atomic_add_i(cnt + tid * 64, n) : 0; lcnt[tid] = 0; }
        SYNC();
        if (tid < 64) { const int pi = tid >> 4, pass = pass0 + pi * NBLK;
            if (pass < T / 16) { const int tok = pass * 16 + (tid & 15); const int* ti = tinfo + tid * 4;
                const int e0 = ti[0] >> 14, e1 = ti[1] >> 14, p0 = lbase[e0] + (ti[0] & 16383), p1 = lbase[e1] + (ti[1] & 16383);
                int* list = (int*)(ws + WS_LIST); list[(size_t)e0 * T + p0] = tok; list[(size_t)e1 * T + p1] = tok;
                int* tie = (int*)(ws + WS_TIE) + (size_t)tok * 2; int* tiw = (int*)(ws + WS_TIW) + (size_t)tok * 2;
                tie[0] = (e0 << 14) | p0; tie[1] = (e1 << 14) | p1; tiw[0] = ti[2]; tiw[1] = ti[3]; } }
        SYNC();
    }
}

DEV int vbid() { const int g = NBLK; return (g % 8 == 0) ? (BID % 8) * (g / 8) + BID / 8 : BID; }
#ifdef EMU
#define PG8_LDS(p) (p)
#else
#define PG8_LDS(p) ((PG8_LAS unsigned char*)(p))
#endif
DEV void inproj_phase(const Args& a, unsigned char* smem, int li) {
    pg8::Gemm g{(const bf16*)(wsp(a) + WS_H), (const bf16*)(wsp(a) + WS_WIN) + (size_t)li * NIN8 * DM, T, NIN8, DM}; pg8::StaticOrder S; S.init(T, NIN8, NBLK, BID);
    EpiInProj8 E{&a, li};
    SYNC(); pg8::gemm_phase<EpiInProj8, pg8::StaticOrder, true, true>(PG8_LDS(smem), g, S, E); SYNC();
}
DEV void resid_gemm_phase(const Args& a, unsigned char* smem, const bf16* A, int K, const bf16* Bt, int l) {
    pg8::Gemm g{A, Bt, T, DM, K}; pg8::StaticOrder S; S.init(T, DM, NBLK, BID);
    EpiResid8 E{outp(a), (const float*)(wsp(a) + WS_MOD) + (size_t)l * 2 * 6 * DM + 2 * DM};
    SYNC(); pg8::gemm_phase<EpiResid8, pg8::StaticOrder, true, true>(PG8_LDS(smem), g, S, E); SYNC();
}
DEV void pw1_phase(const Args& a, unsigned char* smem, int li) {
    pg8::Gemm g{(const bf16*)(wsp(a) + WS_H), (const bf16*)(wsp(a) + WS_PW1) + (size_t)li * 2 * DM * DM, T, 2 * DM, DM}; pg8::StaticOrder S; S.init(T, 2 * DM, NBLK, BID);
    EpiGlu8 E{(bf16*)(wsp(a) + WS_GLU)};
    SYNC(); pg8::gemm_phase<EpiGlu8, pg8::StaticOrder, true, true>(PG8_LDS(smem), g, S, E); SYNC();
}
DEV void cmp_phase_items(const Args& a, unsigned char* smem, int li, int it) {
    constexpr int TMC = (NCP + 255) / 256;
    const int kv = it / (4 * TMC), bg = (it / TMC) % 4, tm = it % TMC;
    const bf16* src = (const bf16*)(wsp(a) + (kv ? WS_VCG : WS_KCG)) + (size_t)bg * SEQ * 64;
    struct AF { const bf16* base; int m0; MDEV unsigned off(int r) const { int n = m0 + r; if (n > NCMP - 1) n = NCMP - 1; return (unsigned)n * 1024u; } } af{src, tm * 256};
    EpiCmp E{&a, kv, bg, tm * 256, li};
    BClamp64 bf{INP(a, kv ? I_CWV : I_CWK) + (size_t)li * 2048 * 64};
    gemm_tile2(smem, af, bf, 64, 2048, E);
}
DEV void moe_gemm_phase(const Args& a, unsigned char* smem, int l, int mode) {
    unsigned char* ws = wsp(a); const int* cnt = (const int*)(ws + WS_CNT) + l * 32 * 64;
    int* rb = (int*)(smem + GEMM2_LDS);
    moe_bases(cnt, rb);
    const int ntile = rb[32] >> 8;
    constexpr int TN1 = 2 * FF / 128, TN2 = DM / 128;
    const int TN = mode == 0 ? TN1 : TN2;
    const int* list = (const int*)(ws + WS_LIST);
    for (int it = vbid(); it < ntile * TN; it += NBLK) {
        const int rt = it / TN, tn = it % TN; int e = 0;
#pragma unroll 1
        for (int q = 1; q < 32; ++q) if ((rb[q] >> 8) <= rt) e = q;
        const int rloc = (rt << 8) - rb[e], ce = cnt[e * 64], nvalid = (ce - rloc) < 256 ? (ce - rloc) : 256;
        if (mode == 0) {
            struct AF { const bf16* base; const int* lst; int nv; MDEV unsigned off(int r) const { const int rr = r < nv ? r : nv - 1; return (unsigned)lst[rr] * (unsigned)DM; } }
                af{(const bf16*)(ws + WS_H), list + (size_t)e * T + rloc, nvalid};
            EpiGated<1> E{(bf16*)(ws + WS_ACT), (size_t)FF, rt << 8, tn * 128, nvalid};
            BInter bf{INP(a, I_W1) + (size_t)(l * 32 + e) * DM * FF, INP(a, I_W3) + (size_t)(l * 32 + e) * DM * FF, tn * 128};
            gemm_tile2(smem, af, bf, FF, DM, E);
        } else {
            ARows af{(const bf16*)(ws + WS_ACT) + (size_t)(rt << 8) * FF, (size_t)FF};
            EpiStoreBf E{(bf16*)(ws + WS_YK), (size_t)DM, rt << 8, tn * 128, nvalid};
            BPlain bf{INP(a, I_W2) + (size_t)(l * 32 + e) * FF * DM + tn * 128};
            gemm_tile2(smem, af, bf, DM, FF, E);
        }
    }
}

constexpr int AT_K = 0, AT_V = 2 * 64 * LDT * 2, AT_IMP = 2 * AT_V, AT_SEL = AT_IMP + 8 * 8 * 128 * 4, AT_GSEL = AT_SEL + 8 * 8 * 4 * 4, AT_OUT = AT_GSEL + 8 * 2 * 4 * 4, AT_END = AT_OUT + 8 * 32 * 64 * 4;
#ifdef EMU
DEV float rexp2(float x) { return exp2f(x); }
DEV unsigned uni(unsigned x) { return x; }
#else
DEV float rexp2(float x) { return __builtin_amdgcn_exp2f(x); }
DEV unsigned uni(unsigned x) { return (unsigned)__builtin_amdgcn_readfirstlane((int)x); }
#endif
template <int MASK, bool WITH_PV, bool FULL, int GM>
DEV void attn_block(const bf16* Kp, const bf16* Vp, const bf16x8 (&qf)[2][2], int j, const int (&s)[2], const bool (&selbit)[2], float C2, int h, int c,
                    f32x4 (&O)[2][4], f32x4 (&Ol)[2], f32x4 (&pout)[2][2][2]) {
    f32x4 st[2][2][2];
#pragma unroll
    for (int sp = 0; sp < 2; ++sp)
#pragma unroll
        for (int u = 0; u < 2; ++u) { const int krow = 32 * sp + 8 * (c >> 2) + 4 * u + (c & 3);
#pragma unroll
            for (int G = 0; G < 2; ++G) { st[G][sp][u][0] = -C2; st[G][sp][u][1] = -C2; st[G][sp][u][2] = -C2; st[G][sp][u][3] = -C2; }
#pragma unroll
            for (int ks = 0; ks < 2; ++ks) { const bf16x8 kf = *(const bf16x8*)(Kp + krow * LDT + 32 * ks + 8 * h);
#pragma unroll
                for (int G = 0; G < 2; ++G) if (GM & (1 << G)) st[G][sp][u] = mfma16(kf, qf[G][ks], st[G][sp][u]); } }
#pragma unroll
    for (int G = 0; G < 2; ++G) if (GM & (1 << G))
#pragma unroll
        for (int sp = 0; sp < 2; ++sp)
#pragma unroll
            for (int u = 0; u < 2; ++u)
#pragma unroll
                for (int r = 0; r < 4; ++r) { bool ok = selbit[G];
                    if (!FULL) { const int key = 64 * j + 32 * sp + 8 * h + 4 * u + r;
                        if (MASK == 0) ok = 16 * key + 31 <= s[G]; else if (MASK == 1) ok = selbit[G] && key <= s[G]; else ok = key <= s[G] && key > s[G] - 512; }
                    pout[G][sp][u][r] = ok ? rexp2(st[G][sp][u][r]) : 0.f; }
    if (WITH_PV) {
        bf16x8 pb[2][2], ones;
#pragma unroll
        for (int q = 0; q < 8; ++q) ones[q] = (short)0x3F80;
#pragma unroll
        for (int G = 0; G < 2; ++G) if (GM & (1 << G))
#pragma unroll
            for (int sp = 0; sp < 2; ++sp) { pb[G][sp] = pack8(pout[G][sp][0], pout[G][sp][1]); Ol[G] = mfma16(ones, pb[G][sp], Ol[G]); }
#pragma unroll
        for (int et = 0; et < 4; ++et)
#pragma unroll
            for (int sp = 0; sp < 2; ++sp) { const bf16x8 vf = *(const bf16x8*)(Vp + (16 * et + c) * LDT + 32 * sp + 8 * h);
#pragma unroll
                for (int G = 0; G < 2; ++G) if (GM & (1 << G)) O[G][et] = mfma16(vf, pb[G][sp], O[G][et]); }
    }
}

struct ImpState { float invl[2]; float carry[2]; float* imps; int tl, hd, l, s0, qblk; };
template <int MODE>
DEV void attn_branch(bf16* Kl, bf16* Vl, const bf16* kbase, int kstride, const bf16* vbase, int vstride, int jlo, int jhi,
                     const bf16x8 (&qf)[2][2], const int (&s)[2], const unsigned* selm, const unsigned* gselm, float C2, int h, int c, int srow, int scol,
                     f32x4 (&O)[2][4], f32x4 (&Ol)[2], ImpState& im) {
    constexpr bool PV = MODE != 1; constexpr int MASK = MODE <= 1 ? 0 : MODE - 1;
    bf16x8 rk[3], rv[3]; f32x4 pt[2][2][2];
    { const bf16x8 k0 = *(const bf16x8*)(kbase + (size_t)jlo * kstride); *(bf16x8*)(Kl + srow * LDT + scol) = k0;
      if (PV) { const bf16x8 v0 = *(const bf16x8*)(vbase + (size_t)jlo * vstride); *(bf16x8*)(Vl + srow * LDT + scol) = v0; } }
#pragma unroll
    for (int u = 0; u < 3; ++u) { int jj = jlo + 1 + u; if (jj > jhi) jj = jhi; rk[(1 + u) % 3] = *(const bf16x8*)(kbase + (size_t)jj * kstride); if (PV) rv[(1 + u) % 3] = *(const bf16x8*)(vbase + (size_t)jj * vstride); }
    SYNC();
    for (int jb = jlo; jb <= jhi; jb += 3) {
#pragma unroll
        for (int u = 0; u < 3; ++u) { const int j = jb + u;
            if (j <= jhi) {
                const int cur = (j - jlo) & 1;
                bool sb[2] = {true, true}; unsigned gm = 3u;
                if (MODE == 2) { gm = 0u;
#pragma unroll
                    for (int G = 0; G < 2; ++G) { const unsigned wq = uni(gselm[G * 4 + (j >> 5)]), mq = selm[(G * 4 + im.tl) * 4 + (j >> 5)];
                        gm |= ((wq >> (j & 31)) & 1u) << G; sb[G] = (mq >> (j & 31)) & 1u; } }
                bool full;
                if (MODE <= 1) full = 1024 * j + 1039 <= im.s0; else if (MODE == 2) full = j < im.qblk; else full = (j < im.qblk) && (64 * j > im.s0 + 63 - 512);
                const bf16* Kc = Kl + cur * 64 * LDT; const bf16* Vc = Vl + cur * 64 * LDT;
                if (MODE == 2) {
                    if (full) { if (gm == 3u) attn_block<MASK, PV, true, 3>(Kc, Vc, qf, j, s, sb, C2, h, c, O, Ol, pt); else if (gm == 1u) attn_block<MASK, PV, true, 1>(Kc, Vc, qf, j, s, sb, C2, h, c, O, Ol, pt); else if (gm == 2u) attn_block<MASK, PV, true, 2>(Kc, Vc, qf, j, s, sb, C2, h, c, O, Ol, pt); }
                    else { if (gm == 3u) attn_block<MASK, PV, false, 3>(Kc, Vc, qf, j, s, sb, C2, h, c, O, Ol, pt); else if (gm == 1u) attn_block<MASK, PV, false, 1>(Kc, Vc, qf, j, s, sb, C2, h, c, O, Ol, pt); else if (gm == 2u) attn_block<MASK, PV, false, 2>(Kc, Vc, qf, j, s, sb, C2, h, c, O, Ol, pt); }
                } else { if (full) attn_block<MASK, PV, true, 3>(Kc, Vc, qf, j, s, sb, C2, h, c, O, Ol, pt); else attn_block<MASK, PV, false, 3>(Kc, Vc, qf, j, s, sb, C2, h, c, O, Ol, pt); }
                if (MODE == 1) {
#pragma unroll
                    for (int G = 0; G < 2; ++G) {
#pragma unroll
                        for (int sp = 0; sp < 2; ++sp)
#pragma unroll
                            for (int uu = 0; uu < 2; ++uu)
#pragma unroll
                                for (int r = 0; r < 4; ++r) { float p = pt[G][sp][uu][r] * im.invl[G]; p += shflx(p, 1); p += shflx(p, 2); pt[G][sp][uu][r] = p; }
                        const float r0 = shfl(pt[G][0][1][3], (im.l - 16) & 63), r1 = shfl(pt[G][1][1][3], (im.l - 16) & 63);
#pragma unroll
                        for (int sp = 0; sp < 2; ++sp)
#pragma unroll
                            for (int uu = 0; uu < 2; ++uu) { const int m = 16 * j + 8 * sp + 2 * h + uu;
                                float prev; if (uu == 1) prev = pt[G][sp][0][3]; else if (h > 0) prev = sp == 0 ? r0 : r1; else prev = sp == 0 ? im.carry[G] : r0;
                                const float val = 2.0f * (pt[G][sp][uu][0] + pt[G][sp][uu][1] + pt[G][sp][uu][2]) + pt[G][sp][uu][3] + prev;
                                if (im.hd == 0 && m < 128) im.imps[(G * 4 + im.tl) * 128 + m] = val; }
                        im.carry[G] = r1;
                    }
                }
                if (j + 1 <= jhi) {
                    *(bf16x8*)(Kl + (cur ^ 1) * 64 * LDT + srow * LDT + scol) = rk[(u + 1) % 3]; if (PV) *(bf16x8*)(Vl + (cur ^ 1) * 64 * LDT + srow * LDT + scol) = rv[(u + 1) % 3];
                    int jj = j + 4; if (jj > jhi) jj = jhi;
                    rk[(u + 1) % 3] = *(const bf16x8*)(kbase + (size_t)jj * kstride); if (PV) rv[(u + 1) % 3] = *(const bf16x8*)(vbase + (size_t)jj * vstride);
                }
                SYNC();
            }
        }
    }
}

DEV void attn_task(const Args& a, unsigned char* smem, int li, int item) {
    unsigned char* ws = wsp(a); const int tid = TID, w = tid >> 6, l = tid & 63, h = l >> 4, c = l & 15, tl = c >> 2, hd = c & 3;
    const int bg = item & 3, b = bg >> 1, g = bg & 1, tq = (SEQ / 64 - 1) - (item >> 2), s0 = tq * 64, qblk = tq;
    int s[2], row[2];
#pragma unroll
    for (int G = 0; G < 2; ++G) { s[G] = s0 + 8 * w + 4 * G + tl; row[G] = b * SEQ + s[G]; }
    bf16* Kl = (bf16*)(smem + AT_K); bf16* Vl = (bf16*)(smem + AT_V); float* imps = (float*)(smem + AT_IMP) + w * 1024; unsigned* selm = (unsigned*)(smem + AT_SEL) + w * 32;
    bf16x8 qf[2][2]; float gatec[2], gates[2], gatew[2];
#pragma unroll
    for (int G = 0; G < 2; ++G) { const bf16* qp = (const bf16*)(ws + WS_QN) + (size_t)row[G] * 512 + (g * 4 + hd) * 64 + 8 * h; qf[G][0] = *(const bf16x8*)qp; qf[G][1] = *(const bf16x8*)(qp + 32);
        const float* gp = (const float*)(ws + WS_GATE) + (size_t)row[G] * 24 + (g * 4 + hd) * 3; gatec[G] = gp[0]; gates[G] = gp[1]; gatew[G] = gp[2]; }
    const float* cs = (const float*)(ws + WS_CS) + li * 4;
    const int srow = tid >> 3, scol = (tid & 7) * 8;
    for (int i = l; i < 1024; i += 64) imps[i] = 0.f;
    SYNC();
    unsigned* gselm = (unsigned*)(smem + AT_GSEL) + w * 8; float* outl = (float*)(smem + AT_OUT) + w * 2048 + l;
    ImpState im{{0.f, 0.f}, {0.f, 0.f}, imps, tl, hd, l, s0, qblk};
    {
        const int ncv = s0 / 16 + 3, ncb0 = (ncv + 63) >> 6, ncb = ncb0 > NCP / 64 ? NCP / 64 : ncb0;
        const bf16* kcb = (const bf16*)(ws + WS_KC) + (size_t)bg * NCP * 64 + srow * 64 + scol;
        const bf16* vcb = (const bf16*)(ws + WS_VCT) + (size_t)bg * 64 * NCP + (size_t)srow * NCP + scol;
        f32x4 O[2][4], Ol[2] = {f4zero(), f4zero()};
#pragma unroll
        for (int G = 0; G < 2; ++G)
#pragma unroll
            for (int et = 0; et < 4; ++et) O[G][et] = f4zero();
        attn_branch<0>(Kl, Vl, kcb, 4096, vcb, 64, 0, ncb - 1, qf, s, selm, gselm, cs[0], h, c, srow, scol, O, Ol, im);
#pragma unroll
        for (int G = 0; G < 2; ++G) { const float lsum = Ol[G][0]; im.invl[G] = lsum > 0.f ? 1.0f / lsum : 0.f;
#pragma unroll
            for (int et = 0; et < 4; ++et)
#pragma unroll
                for (int r = 0; r < 4; ++r) outl[((G * 4 + et) * 4 + r) * 64] = gatec[G] * im.invl[G] * O[G][et][r]; }
        f32x4 ld[2] = {f4zero(), f4zero()};
        attn_branch<1>(Kl, Vl, kcb, 4096, vcb, 64, 0, ncb - 1, qf, s, selm, gselm, cs[0], h, c, srow, scol, O, ld, im);
    }
    WSYNC();
#pragma unroll 1
    for (int G = 0; G < 2; ++G) {
        const int tk = l >> 4, i = l & 15; float vals[8];
#pragma unroll
        for (int mm = 0; mm < 8; ++mm) { const int jj = i + 16 * mm; vals[mm] = jj > qblk ? NEGV : ((jj == 0 || jj == qblk || jj == qblk - 1) ? FORCEV : imps[(G * 4 + tk) * 128 + jj]); }
        unsigned mk[4] = {0u, 0u, 0u, 0u};
#pragma unroll 1
        for (int rnd = 0; rnd < 16; ++rnd) {
            float best = vals[0]; int bj = i;
#pragma unroll
            for (int mm = 1; mm < 8; ++mm) if (vals[mm] > best) { best = vals[mm]; bj = i + 16 * mm; }
#pragma unroll
            for (int o = 1; o < 16; o <<= 1) { const float ov = shflx(best, o); const int oj = shflxi(bj, o); if (ov > best || (ov == best && oj < bj)) { best = ov; bj = oj; } }
            if (best > NEGV * 0.5f) {
#pragma unroll
                for (int q = 0; q < 4; ++q) if ((bj >> 5) == q) mk[q] |= 1u << (bj & 31); }
            if ((bj & 15) == i) {
#pragma unroll
                for (int mm = 0; mm < 8; ++mm) if ((bj >> 4) == mm) vals[mm] = -3e38f; }
        }
        if (i == 0) {
#pragma unroll
            for (int q = 0; q < 4; ++q) selm[(G * 4 + tk) * 4 + q] = mk[q]; }
    }
    WSYNC();
    if (l < 8) { const int G = l >> 2, q = l & 3; gselm[l] = selm[(G * 4 + 0) * 4 + q] | selm[(G * 4 + 1) * 4 + q] | selm[(G * 4 + 2) * 4 + q] | selm[(G * 4 + 3) * 4 + q]; }
    WSYNC();
#pragma unroll
    for (int br = 0; br < 2; ++br) {
        const bf16* kb = (const bf16*)(ws + (br == 0 ? WS_KS : WS_KW)) + (size_t)bg * SEQ * 64 + tid * 8; const bf16* vb = (const bf16*)(ws + (br == 0 ? WS_VST : WS_VWT)) + (size_t)bg * NCH * 4096 + tid * 8;
        f32x4 O[2][4], Ol[2] = {f4zero(), f4zero()};
#pragma unroll
        for (int G = 0; G < 2; ++G)
#pragma unroll
            for (int et = 0; et < 4; ++et) O[G][et] = f4zero();
        if (br == 0) attn_branch<2>(Kl, Vl, kb, 4096, vb, 4096, 0, qblk, qf, s, selm, gselm, cs[1], h, c, srow, scol, O, Ol, im);
        else attn_branch<3>(Kl, Vl, kb, 4096, vb, 4096, s0 >= 511 ? (s0 - 511) >> 6 : 0, qblk, qf, s, selm, gselm, cs[2], h, c, srow, scol, O, Ol, im);
#pragma unroll
        for (int G = 0; G < 2; ++G) { const float lsum = Ol[G][0]; const float sc = (br == 0 ? gates[G] : gatew[G]) * (lsum > 0.f ? 1.0f / lsum : 0.f);
#pragma unroll
            for (int et = 0; et < 4; ++et)
#pragma unroll
                for (int r = 0; r < 4; ++r) outl[((G * 4 + et) * 4 + r) * 64] += sc * O[G][et][r]; }
    }
#pragma unroll
    for (int G = 0; G < 2; ++G) { bf16* dst = (bf16*)(ws + WS_CAT) + (size_t)row[G] * 1024 + (g * 4 + hd) * 64 + 4 * h;
#pragma unroll
        for (int et = 0; et < 4; ++et) { f32x4 o;
#pragma unroll
            for (int r = 0; r < 4; ++r) o[r] = outl[((G * 4 + et) * 4 + r) * 64];
            st_bf4(dst + 16 * et, o); } }
}

constexpr int LDH = 136;
DEV void hg_cumsum(const float* fsrc  , float* segs  , int d, int seg, float (&f)[16], float (&bc)[16], float& bend, float& bmid) {
    float run = 0.f;
#pragma unroll
    for (int i = 0; i < 16; ++i) { f[i] = fsrc[(size_t)(16 * seg + i) * 128 + d]; run += log2f(f[i]); bc[i] = run; }
    SYNC();
    segs[seg * 128 + d] = run;
    SYNC();
    const float s0 = segs[d], s1 = segs[128 + d], s2 = segs[256 + d], s3 = segs[384 + d];
    const float off = seg == 0 ? 0.f : (seg == 1 ? s0 : (seg == 2 ? s0 + s1 : s0 + s1 + s2));
#pragma unroll
    for (int i = 0; i < 16; ++i) bc[i] += off;
    bend = s0 + s1 + s2 + s3; bmid = s0 + s1;
}
DEV void hg_write16(bf16* dstrow  , const float (&v)[16]) {
    u32x4 w0, w1;
#pragma unroll
    for (int q = 0; q < 4; ++q) { w0[q] = pk2(v[2 * q], v[2 * q + 1]); w1[q] = pk2(v[8 + 2 * q], v[8 + 2 * q + 1]); }
    *(u32x4*)dstrow = w0; *(u32x4*)(dstrow + 8) = w1;
}
DEV void hg_h1_task(const Args& a, unsigned char* smem, int task) {
    unsigned char* ws = wsp(a); const int tid = TID, w = tid >> 6, l = tid & 63, h = l >> 4, c = l & 15, d = tid & 127, seg = tid >> 7;
    const int bh = task / NCH, ch = task % NCH;
    bf16* kT = (bf16*)smem; bf16* vT = kT + 128 * LDT; float* segs = (float*)(vT + 128 * LDT);
    const size_t tokb = (size_t)bh * SEQ + ch * 64;
    float f[16], bc[16], bend, bmid;
    hg_cumsum((const float*)(ws + WS_HF) + tokb * 128, segs, d, seg, f, bc, bend, bmid);
    float kv[16];
#pragma unroll
    for (int i = 0; i < 16; ++i) kv[i] = (1.0f - f[i]) * fexp2(bend - bc[i]);
    hg_write16(kT + d * LDT + 16 * seg, kv);
    const bf16* vs = (const bf16*)(ws + WS_HV) + tokb * 128;
#pragma unroll
    for (int i = 0; i < 16; ++i) kv[i] = bf2f(vs[(size_t)(16 * seg + i) * 128 + d]);
    hg_write16(vT + d * LDT + 16 * seg, kv);
    if (seg == 0) ((float*)(ws + WS_GD))[((size_t)bh * NCH + ch) * 128 + d] = fexp2(bend);
    SYNC();
    f32x4 acc[8];
#pragma unroll
    for (int et = 0; et < 8; ++et) acc[et] = f4zero();
#pragma unroll
    for (int ks = 0; ks < 2; ++ks) { const bf16x8 fa = *(const bf16x8*)(kT + (16 * w + c) * LDT + 32 * ks + 8 * h);
#pragma unroll
        for (int et = 0; et < 8; ++et) acc[et] = mfma16(fa, *(const bf16x8*)(vT + (16 * et + c) * LDT + 32 * ks + 8 * h), acc[et]); }
    float* ut = (float*)(ws + WS_UT) + ((size_t)bh * NCH + ch) * 16384;
#pragma unroll
    for (int et = 0; et < 8; ++et) *(f32x4*)(ut + (size_t)(16 * et + c) * 128 + 16 * w + 4 * h) = acc[et];
    SYNC();
}
DEV void hg_scan_task(const Args& a, int sc) {
    unsigned char* ws = wsp(a); const int bh = sc >> 3, q = (sc & 7) * 512 + TID, e = q >> 5, d0 = (q & 31) * 4;
    const float* ut = (const float*)(ws + WS_UT) + (size_t)bh * NCH * 16384 + (size_t)e * 128 + d0;
    const float* gd = (const float*)(ws + WS_GD) + (size_t)bh * NCH * 128 + d0;
    bf16* st = (bf16*)(ws + WS_ST) + (size_t)bh * NCH * 16384 + (size_t)e * 128 + d0;
    f32x4 S = f4zero();
#pragma unroll 4
    for (int ch = 0; ch < NCH; ++ch) { st_bf4(st + (size_t)ch * 16384, S);
        const f32x4 g = *(const f32x4*)(gd + (size_t)ch * 128), u = *(const f32x4*)(ut + (size_t)ch * 16384);
#pragma unroll
        for (int r = 0; r < 4; ++r) S[r] = g[r] * S[r] + u[r]; }
}
DEV void hg_h3_task(const Args& a, unsigned char* smem, int li, int task) {
    unsigned char* ws = wsp(a); const int tid = TID, w = tid >> 6, l = tid & 63, h = l >> 4, c = l & 15, d = tid & 127, seg = tid >> 7;
    const int bh = task / NCH, ch = task % NCH, b = bh >> 2, hh = bh & 3;
    bf16* At = (bf16*)smem; bf16* Bt = At + 64 * LDH; bf16* Qt = Bt + 64 * LDH; bf16* vT = Qt + 64 * LDH; float* segs = (float*)(vT + 128 * LDT); float* part = segs + 512;
    const size_t tokb = (size_t)bh * SEQ + ch * 64;
    float f[16], bc[16], bend, bmid;
    hg_cumsum((const float*)(ws + WS_HF) + tokb * 128, segs, d, seg, f, bc, bend, bmid);
    const bf16* qs = (const bf16*)(ws + WS_HQ) + tokb * 128; const bf16* vs = (const bf16*)(ws + WS_HV) + tokb * 128;
    float vv[16];
#pragma unroll
    for (int i = 0; i < 16; ++i) { const int t = 16 * seg + i; const float q = bf2f(qs[(size_t)t * 128 + d]);
        At[t * LDH + d] = (bf16)f2bf(q * fexp2(bc[i] - bmid)); Bt[t * LDH + d] = (bf16)f2bf((1.0f - f[i]) * fexp2(bmid - bc[i])); Qt[t * LDH + d] = (bf16)f2bf(q * fexp2(bc[i]));
        vv[i] = bf2f(vs[(size_t)t * 128 + d]); }
    hg_write16(vT + d * LDT + 16 * seg, vv);
    SYNC();
    const int tt = w & 3, eh = w >> 2;
    f32x4 O[4];
#pragma unroll
    for (int et = 0; et < 4; ++et) O[et] = f4zero();
#pragma unroll
    for (int sp = 0; sp < 2; ++sp) {
        if (32 * sp > 16 * tt + 15) continue;
        f32x4 st[2];
#pragma unroll
        for (int u = 0; u < 2; ++u) { st[u] = f4zero(); const int krow = 32 * sp + 8 * (c >> 2) + 4 * u + (c & 3);
#pragma unroll
            for (int ks = 0; ks < 4; ++ks) st[u] = mfma16(*(const bf16x8*)(Bt + krow * LDH + 32 * ks + 8 * h), *(const bf16x8*)(At + (16 * tt + c) * LDH + 32 * ks + 8 * h), st[u]);
#pragma unroll
            for (int r = 0; r < 4; ++r) { const int sk = 32 * sp + 8 * h + 4 * u + r; if (sk > 16 * tt + c) st[u][r] = 0.f; } }
        const bf16x8 pb = pack8(st[0], st[1]);
#pragma unroll
        for (int et = 0; et < 4; ++et) O[et] = mfma16(*(const bf16x8*)(vT + (64 * eh + 16 * et + c) * LDT + 32 * sp + 8 * h), pb, O[et]);
    }
    const bf16* stp = (const bf16*)(ws + WS_ST) + ((size_t)bh * NCH + ch) * 16384;
#pragma unroll
    for (int ks = 0; ks < 4; ++ks) { const bf16x8 fq = *(const bf16x8*)(Qt + (16 * tt + c) * LDH + 32 * ks + 8 * h);
#pragma unroll
        for (int et = 0; et < 4; ++et) O[et] = mfma16(*(const bf16x8*)(stp + (size_t)(64 * eh + 16 * et + c) * 128 + 32 * ks + 8 * h), fq, O[et]); }
    float ss = 0.f;
#pragma unroll
    for (int et = 0; et < 4; ++et)
#pragma unroll
        for (int r = 0; r < 4; ++r) ss += O[et][r] * O[et][r];
    ss += shflx(ss, 16); ss += shflx(ss, 32);
    if (h == 0) part[eh * 64 + 16 * tt + c] = ss;
    SYNC();
    const float rs = frsq((part[16 * tt + c] + part[64 + 16 * tt + c]) * (1.0f / 128.0f) + EPS);
    const int tok = b * SEQ + ch * 64 + 16 * tt + c;
    const float* og = INP(a, I_OG) + li * 128; const bf16* hg = (const bf16*)(ws + WS_HGS) + (size_t)tok * 512 + hh * 128;
    bf16* dst = (bf16*)(ws + WS_CAT) + (size_t)tok * 1024 + 512 + hh * 128;
#pragma unroll
    for (int et = 0; et < 4; ++et) { const int e = 64 * eh + 16 * et + 4 * h; f32x4 o;
#pragma unroll
        for (int r = 0; r < 4; ++r) o[r] = O[et][r] * rs * og[e + r] * bf2f(hg[e + r]);
        st_bf4(dst + e, o); }
    SYNC();
}

DEV void conv_task(const Args& a, unsigned char* smem, int li, int task) {
    unsigned char* ws = wsp(a); const int tid = TID, w = tid >> 6, lane = tid & 63;
    const bool act = tid < DM / 2; const int c0 = act ? 2 * tid : 0;
    const int t0 = task * 16, b = t0 / SEQ, s0 = t0 % SEQ;
    float* red = (float*)smem;
    const float* dw = INP(a, I_DW) + (size_t)li * 31 * DM + c0;
    float acc[16][2];
    const float b0 = INP(a, I_DWB)[li * DM + c0], b1 = INP(a, I_DWB)[li * DM + c0 + 1];
#pragma unroll
    for (int t = 0; t < 16; ++t) { acc[t][0] = b0; acc[t][1] = b1; }
    const bf16* glu = (const bf16*)(ws + WS_GLU) + (size_t)b * SEQ * DM + c0;
    unsigned uu[46];
    { const bf16* gp = glu + (size_t)(s0 - 30) * DM;
#pragma unroll
    for (int r = 0; r < 46; ++r) { const int si = s0 + r - 30; uu[r] = si >= 0 ? *(const unsigned*)gp : 0u; gp += DM; OPAQUE(gp); } }
    const float* dwp = dw;
#pragma unroll
    for (int j = 0; j < 31; ++j) { const float w0 = dwp[0], w1 = dwp[1]; dwp += DM; OPAQUE(dwp);
#pragma unroll
        for (int t = 0; t < 16; ++t) { const unsigned q = uu[t + j]; acc[t][0] += w0 * bf2f(q & 0xffff); acc[t][1] += w1 * bf2f(q >> 16); } }
    float mean[16], rstd[16];
    SYNC();
#pragma unroll
    for (int t = 0; t < 16; ++t) { float s = act ? acc[t][0] + acc[t][1] : 0.f;
#pragma unroll
        for (int o = 1; o < 64; o <<= 1) s += shflx(s, o);
        if (lane == 0) red[w * 16 + t] = s; }
    SYNC();
#pragma unroll
    for (int t = 0; t < 16; ++t) { float s = 0.f;
#pragma unroll
        for (int q = 0; q < 8; ++q) s += red[q * 16 + t];
        mean[t] = s * (1.0f / DM); }
    SYNC();
#pragma unroll
    for (int t = 0; t < 16; ++t) { const float d0 = acc[t][0] - mean[t], d1 = acc[t][1] - mean[t]; float s = act ? d0 * d0 + d1 * d1 : 0.f;
#pragma unroll
        for (int o = 1; o < 64; o <<= 1) s += shflx(s, o);
        if (lane == 0) red[w * 16 + t] = s; }
    SYNC();
#pragma unroll
    for (int t = 0; t < 16; ++t) { float s = 0.f;
#pragma unroll
        for (int q = 0; q < 8; ++q) s += red[q * 16 + t];
        rstd[t] = frsq(s * (1.0f / DM) + EPS); }
    if (act) {
        const float g0 = INP(a, I_LNG)[li * DM + c0], g1 = INP(a, I_LNG)[li * DM + c0 + 1], e0 = INP(a, I_LNB)[li * DM + c0], e1 = INP(a, I_LNB)[li * DM + c0 + 1];
        bf16* dst = (bf16*)(ws + WS_CAT) + (size_t)t0 * DM + c0;
#pragma unroll
        for (int t = 0; t < 16; ++t) { const float y0 = (acc[t][0] - mean[t]) * rstd[t] * g0 + e0, y1 = (acc[t][1] - mean[t]) * rstd[t] * g1 + e1;
            *(unsigned*)(dst + (size_t)t * DM) = pk2(siluf(y0), siluf(y1)); }
    }
}

constexpr int N_PHASES = 1 + 16 * (DEPTH / 2) + 1;
DEV void phase_decode(int ph, int& l, int& sub) {
    const int q = ph - 1, pair = q >> 4, r = q & 15;
    if (r < 9) { l = 2 * pair; sub = r; } else { l = 2 * pair + 1; const int rr = r - 9; sub = rr < 3 ? rr : rr + 2; }
}
constexpr int LDS_BYTES = 150 * 1024;

DEV void run_phase(const Args& a, unsigned char* smem, int ph) {
#ifndef ONLY
#define ONLY -1
#endif
#define EN(k) (ONLY < 0 || ONLY == (k))
    if (ph == 0) { if (EN(100)) p0_phase(a, smem); return; }
    if (ph == N_PHASES - 1) { if (EN(0)) norm_phase(a, smem, DEPTH); return; }
    int l, sub; phase_decode(ph, l, sub); const int li = l >> 1; const bool even = (l & 1) == 0;
    unsigned char* ws = wsp(a);
    switch (sub) {
    case 0: if (EN(0)) norm_phase(a, smem, l); break;
    case 1: if (even) { if (EN(1)) inproj_phase(a, smem, li); } else { if (EN(11)) pw1_phase(a, smem, li); } break;
    case 2:
        if (even) { constexpr int NCI = 8 * ((NCP + 255) / 256); constexpr int NH1 = 8 * NCH;
            for (int it = BID; it < NCI + NH1; it += NBLK) { if (it < NCI) { if (EN(2)) cmp_phase_items(a, smem, li, it); } else { if (EN(12)) hg_h1_task(a, smem, it - NCI); } } }
        else { for (int it = BID; it < T / 16; it += NBLK) if (EN(13)) conv_task(a, smem, li, it); }
        break;
    case 3:
        if (even) { constexpr int NA = 4 * (SEQ / 64); const int G = NBLK;
            for (int r = 0; r * G < NA; ++r) { const int it = r * G + ((r & 1) ? (G - 1 - BID) : BID); if (it < NA) { if (EN(3)) attn_task(a, smem, li, it); } }
            for (int it = BID; it < 64; it += NBLK) if (EN(14)) hg_scan_task(a, it); }
        break;
    case 4: if (even) { for (int it = BID; it < 8 * NCH; it += NBLK) if (EN(4)) hg_h3_task(a, smem, li, it); } break;
    case 5:
        if (!EN(5)) break;
        if (even) resid_gemm_phase(a, smem, (const bf16*)(ws + WS_CAT), 1024, (const bf16*)(ws + WS_WOUT) + (size_t)li * DM * 1024, l);
        else resid_gemm_phase(a, smem, (const bf16*)(ws + WS_CAT), DM, (const bf16*)(ws + WS_PW2) + (size_t)li * DM * DM, l);
        break;
    case 6: if (EN(6)) route_phase(a, smem, l); break;
    case 7: if (EN(7)) moe_gemm_phase(a, smem, l, 0); break;
    case 8: if (EN(8)) moe_gemm_phase(a, smem, l, 1); break;
    }
}

#ifndef EMU
#define LAS __attribute__((address_space(3)))
#define XB_TMO      128
#define XB_XCNT(j)  (256  + 64 * (j))
#define XB_XSUB(j)  (1280 + 64 * (j))
#define XB_XGEN(j)  (2304 + 64 * (j))
#define XB_TOP      3328
#define XB_TOPGEN   3392
#define XCD_BAR_WORDS 3456
#define XB_SPIN_CAP (1u << 22)
__device__ __forceinline__ unsigned xb_ld(unsigned* p)              { return __hip_atomic_load(p, __ATOMIC_RELAXED, __HIP_MEMORY_SCOPE_AGENT); }
__device__ __forceinline__ unsigned xb_add(unsigned* p, unsigned v) { return __hip_atomic_fetch_add(p, v, __ATOMIC_RELAXED, __HIP_MEMORY_SCOPE_AGENT); }
__device__ __forceinline__ unsigned xb_xcc_id() { return (unsigned)__builtin_amdgcn_s_getreg((3 << 11) | 20) & 0xFu; }
#define XB_SPIN(cond, bar) do { unsigned _sp = 0; while (cond) { __builtin_amdgcn_s_sleep(1); \
    if ((++_sp & 255u) == 0u) { if (xb_ld(&(bar)[XB_TMO])) break; if (_sp > XB_SPIN_CAP) { atomicAdd(&(bar)[XB_TMO], 1u); break; } } } } while (0)
struct XcdBarrier { unsigned* bar; unsigned x; volatile LAS unsigned* st; };
__device__ __forceinline__ XcdBarrier xcd_barrier_post(unsigned* bar, volatile LAS unsigned* st) {
    XcdBarrier b; b.bar = bar; b.x = xb_xcc_id(); b.st = st;
    if (threadIdx.x == 0) (void)xb_add(&bar[XB_XCNT(b.x)], 1u);
    return b;
}
__device__ __forceinline__ void xcd_barrier_complete(unsigned* bar, unsigned x, unsigned& nloc, unsigned& nx) {
    const unsigned G = gridDim.x * gridDim.y * gridDim.z;
    unsigned sum, cnt, mine, sp = 0u;
    for (;;) {
        sum = 0u; cnt = 0u; mine = 0u;
#pragma unroll
        for (unsigned j = 0; j < 16; ++j) { const unsigned c = xb_ld(&bar[XB_XCNT(j)]); sum += c; cnt += (c > 0u) ? 1u : 0u; mine = (j == x) ? c : mine; }
        if (sum == G) break;
        __builtin_amdgcn_s_sleep(1);
        if ((++sp & 255u) == 0u) { if (xb_ld(&bar[XB_TMO])) break; if (sp > XB_SPIN_CAP) { atomicAdd(&bar[XB_TMO], 1u); break; } }
    }
    nloc = mine > 0u ? mine : 1u; nx = cnt > 0u ? cnt : 1u;
}
__device__ __forceinline__ void xcd_barrier(const XcdBarrier& b) {
    asm volatile("s_waitcnt vmcnt(0)" ::: "memory");
    __syncthreads();
    if (threadIdx.x == 0) {
        unsigned* bar = b.bar;
        __builtin_amdgcn_s_waitcnt(0);
        unsigned nloc = b.st[0], nx = b.st[1];
        if (nloc == 0u) { xcd_barrier_complete(bar, b.x, nloc, nx); b.st[0] = nloc; b.st[1] = nx; }
        const unsigned old = xb_add(&bar[XB_XSUB(b.x)], 1u);
        const unsigned gen = old / nloc;
        if (old + 1u == (gen + 1u) * nloc) {
            __builtin_amdgcn_fence(__ATOMIC_RELEASE, "agent");
            asm volatile("s_waitcnt vmcnt(0)" ::: "memory");
            const unsigned og = xb_add(&bar[XB_TOP], 1u);
            const unsigned tg = og / nx;
            if (og + 1u == (tg + 1u) * nx) xb_add(&bar[XB_TOPGEN], 1u);
            else XB_SPIN(xb_ld(&bar[XB_TOPGEN]) == tg, bar);
            __builtin_amdgcn_fence(__ATOMIC_ACQUIRE, "agent");
            xb_add(&bar[XB_XGEN(b.x)], 1u);
            asm volatile("s_waitcnt vmcnt(0)" ::: "memory");
        } else {
            XB_SPIN(xb_ld(&bar[XB_XGEN(b.x)]) == gen, bar);
            __builtin_amdgcn_fence(__ATOMIC_ACQUIRE, "agent");
            asm volatile("s_waitcnt vmcnt(0)" ::: "memory");
        }
    }
    __syncthreads();
}

__global__ void __launch_bounds__(NT, 2) mega(Args a) {
    extern __shared__ __attribute__((aligned(16))) unsigned char lds[];
    volatile LAS unsigned* st = (volatile LAS unsigned*)(LAS unsigned char*)(lds + LDS_BYTES - 16);
    if (threadIdx.x < 4) st[threadIdx.x] = 0u;
    __syncthreads();
    unsigned* barw = (unsigned*)(a.ws + WS_BAR);
    XcdBarrier bar = xcd_barrier_post(barw, st);
#pragma unroll 1
    for (int ph = 0; ph < N_PHASES; ++ph) {
        run_phase(a, lds, ph);
#ifdef DUP
        { int lyr = 0, sub = 100; if (ph > 0 && ph < N_PHASES - 1) phase_decode(ph, lyr, sub);
          if (sub == (DUP % 1000) && (ph == 0 || lyr == DUP / 1000) && ph < N_PHASES - 1) { xcd_barrier(bar); run_phase(a, lds, ph); } }
#endif
        if (ph + 1 < N_PHASES) xcd_barrier(bar);
    }
    if (xb_ld(&barw[XB_TMO]) != 0u) {
        const size_t gt = (size_t)blockIdx.x * NT + threadIdx.x, gs = (size_t)gridDim.x * NT;
        for (size_t i = gt; i < (size_t)T * DM; i += gs) a.out[i] = __builtin_nanf("");
    }
}

extern "C" void kernel_launch(void* const* d_in, const int* in_sizes, int n_in, void* d_out, int out_size,
                              void* d_ws, size_t ws_size, hipStream_t stream) {
    static int grid = 0;
    if (grid == 0) {
        int dev = 0, cus = 0;
        if (hipGetDevice(&dev) != hipSuccess || hipDeviceGetAttribute(&cus, hipDeviceAttributeMultiprocessorCount, dev) != hipSuccess) { grid = -1; return; }
        if (hipFuncSetAttribute((const void*)mega, hipFuncAttributeMaxDynamicSharedMemorySize, LDS_BYTES) != hipSuccess) { grid = -1; return; }
        (void)hipGetLastError();
        grid = cus;
        if (n_in != 26 || out_size != T * DM || ws_size < WS_END) { fprintf(stderr, "kernel_launch: unexpected sizes n_in %d out %d ws %zu (need %zu)\n", n_in, out_size, ws_size, (size_t)WS_END); grid = -1; return; }
    }
    if (grid < 0) return;
    (void)hipMemsetAsync((unsigned char*)d_ws + WS_BAR, 0, XCD_BAR_WORDS * 4, stream);
    Args a{};
    for (int i = 0; i < 26; ++i) a.in[i] = (const float*)d_in[i];
    a.out = (float*)d_out; a.ws = (unsigned char*)d_ws;
    hipLaunchKernelGGL(mega, dim3(grid), dim3(NT), LDS_BYTES, stream, a);
}
#endif
```

```cpp
#ifdef EMU
#include "emu.h"
#define DEV static inline
#define MDEV inline
#define OPAQUE(p)
#define OPAQUE2(a, b)
#define TID emu_tid()
#define BID (EB->bid)
#define NBLK (EB->nblk)
#define SYNC() emu_sync_block()
#define WSYNC() emu_sync_wave()
#define mfma16(a, b, c) emu_mfma16(a, b, c)
DEV float shflx(float v, int m) { return emu_shfl_f(v, (emu_tid() & 63) ^ m); }
DEV int shflxi(int v, int m) { return (int)emu_shfl_u((unsigned)v, (emu_tid() & 63) ^ m); }
DEV float shfl(float v, int s) { return emu_shfl_f(v, s); }
DEV int atomic_add_i(int* p, int v) { return __atomic_fetch_add(p, v, __ATOMIC_RELAXED); }
DEV float fexp2(float x) { return exp2f(x); }
DEV float frcp(float x) { return 1.0f / x; }
DEV float frsq(float x) { return 1.0f / sqrtf(x); }
typedef short s16x4 __attribute__((vector_size(8)));
static inline s16x4 emu_tr4(const unsigned short* p) {
    EmuWave& w = EB->wave[emu_tid() >> 6]; int l = emu_tid() & 63;
    const unsigned short** tab = (const unsigned short**)w.a;
    tab[l] = p; emu_sync_wave();
    s16x4 r; int g = l & 48, i = l & 15;
    for (int q = 0; q < 4; ++q) r[q] = (short)tab[g + 4 * q + (i >> 2)][i & 3];
    emu_sync_wave(); return r;
}
#define tr4(p) emu_tr4(p)
#else
#include <hip/hip_runtime.h>
#include <cstdio>
#include <cstdint>
typedef short bf16x8 __attribute__((ext_vector_type(8)));
typedef float f32x4 __attribute__((ext_vector_type(4)));
typedef unsigned u32x4 __attribute__((ext_vector_type(4)));
typedef unsigned u32x2 __attribute__((ext_vector_type(2)));
#define DEV __device__ __forceinline__
#define MDEV __device__ __forceinline__
#define OPAQUE(p) asm volatile("" : "+v"(p))
#define OPAQUE2(a, b) asm volatile("" : "+v"(a), "+v"(b))
DEV int tid_opaque() { int t = (int)threadIdx.x; asm volatile("" : "+v"(t)); return t; }
#define TID tid_opaque()
DEV int bid_opaque() { int b = (int)blockIdx.x; asm volatile("" : "+s"(b)); return b; }
#define BID bid_opaque()
#define NBLK ((int)gridDim.x)
#define SYNC() __syncthreads()
#define WSYNC() __builtin_amdgcn_wave_barrier()
#define mfma16(a, b, c) __builtin_amdgcn_mfma_f32_16x16x32_bf16(a, b, c, 0, 0, 0)
DEV float shflx(float v, int m) { return __shfl_xor(v, m); }
DEV int shflxi(int v, int m) { return __shfl_xor(v, m); }
DEV float shfl(float v, int s) { return __shfl(v, s); }
DEV int atomic_add_i(int* p, int v) { return atomicAdd(p, v); }
DEV float fexp2(float x) { return __builtin_amdgcn_exp2f(x); }
DEV float frcp(float x) { return __builtin_amdgcn_rcpf(x); }
DEV float frsq(float x) { return __builtin_amdgcn_rsqf(x); }
typedef short s16x4 __attribute__((ext_vector_type(4)));
#define tr4(p) __builtin_amdgcn_ds_read_tr16_b64_v4i16((__attribute__((address_space(3))) s16x4*)(p))
#endif

typedef unsigned short bf16;

#ifndef DM
#define DM 1024
#endif
#ifndef SEQ
#define SEQ 8192
#endif
#ifndef FF
#define FF 512
#endif
constexpr int NBATCH = 2, T = NBATCH * SEQ, DEPTH = 4;
constexpr int NIN = 3352, NINP = 3456, NIN8 = 3584;
constexpr int NT = 512;
constexpr int NCH = SEQ / 64;
constexpr int NCP = SEQ / 16;
constexpr int NCMP = NCP - 1;
constexpr int MOE_ROWS = 2 * T + 32 * 256;
constexpr float EPS = 1e-6f, NEGV = -1e30f, FORCEV = 1e4f, LOG2E = 1.4426950408889634f;

constexpr size_t al(size_t x) { return (x + 255) & ~(size_t)255; }
constexpr size_t WS_BAR = 0;
constexpr size_t WS_CNT = 16384;
constexpr size_t WS_MOD = WS_CNT + (size_t)DEPTH * 32 * 256;
constexpr size_t WS_LB = al(WS_MOD + (size_t)DEPTH * 2 * 6 * DM * 4);
constexpr size_t WS_CB = al(WS_LB + 2 * 512 * 4);
constexpr size_t WS_CS = al(WS_CB + 2 * 2 * 8 * 64 * 4);
constexpr size_t WS_WIN = al(WS_CS + 64);
constexpr size_t WS_WOUT = al(WS_WIN + (size_t)2 * NIN8 * DM * 2);
constexpr size_t WS_PW1 = al(WS_WOUT + (size_t)2 * DM * 1024 * 2);
constexpr size_t WS_PW2 = al(WS_PW1 + (size_t)2 * 2 * DM * DM * 2);
constexpr size_t WS_WC = al(WS_PW2 + (size_t)2 * DM * DM * 2);
constexpr size_t WS_W13 = al(WS_WC + (size_t)2 * 2 * 64 * 2048 * 2);
constexpr size_t WS_W2 = al(WS_W13 + 256);
constexpr size_t WS_H = al(WS_W2 + 256);
constexpr size_t WS_QN = al(WS_H + (size_t)T * DM * 2);
constexpr size_t WS_KCG = al(WS_QN + (size_t)T * 512 * 2);
constexpr size_t WS_VCG = al(WS_KCG + (size_t)T * 128 * 2);
constexpr size_t WS_KS = al(WS_VCG + (size_t)T * 128 * 2);
constexpr size_t WS_KW = al(WS_KS + (size_t)T * 128 * 2);
constexpr size_t WS_VST = al(WS_KW + (size_t)T * 128 * 2);
constexpr size_t WS_VWT = al(WS_VST + (size_t)T * 128 * 2);
constexpr size_t WS_KC = al(WS_VWT + (size_t)T * 128 * 2);
constexpr size_t WS_VCT = al(WS_KC + (size_t)4 * NCP * 64 * 2);
constexpr size_t WS_GATE = al(WS_VCT + (size_t)4 * NCP * 64 * 2);
constexpr size_t WS_HQ = al(WS_GATE + (size_t)T * 24 * 4);
constexpr size_t WS_HF = al(WS_HQ + (size_t)T * 512 * 2);
constexpr size_t WS_HV = al(WS_HF + (size_t)T * 512 * 4);
constexpr size_t WS_HGS = al(WS_HV + (size_t)T * 512 * 2);
constexpr size_t WS_UT = al(WS_HGS + (size_t)T * 512 * 2);
constexpr size_t WS_ST = al(WS_UT + (size_t)8 * NCH * 128 * 128 * 4);
constexpr size_t WS_GD = al(WS_ST + (size_t)8 * NCH * 128 * 128 * 2);
constexpr size_t WS_CAT = al(WS_GD + (size_t)8 * NCH * 128 * 4);
constexpr size_t WS_GLU = al(WS_CAT + (size_t)T * 1024 * 2);
constexpr size_t WS_TIE = al(WS_GLU + (size_t)T * DM * 2);
constexpr size_t WS_TIW = al(WS_TIE + (size_t)T * 2 * 4);
constexpr size_t WS_LIST = al(WS_TIW + (size_t)T * 2 * 4);
constexpr size_t WS_ACT = al(WS_LIST + (size_t)32 * T * 4);
constexpr size_t WS_YK = al(WS_ACT + (size_t)MOE_ROWS * FF * 2);
constexpr size_t WS_END = al(WS_YK + (size_t)MOE_ROWS * DM * 2);

struct Args { const float* in[26]; float* out; unsigned char* ws; };
enum { I_X = 0, I_C, I_ADAW, I_ADAB, I_NMIX, I_NFFN, I_WIN, I_WOUT, I_CWK, I_CWV, I_CPE, I_QG, I_KG, I_LBL, I_OG,
       I_PW1, I_DW, I_DWB, I_LNG, I_LNB, I_PW2, I_WG, I_WE, I_W1, I_W3, I_W2 };

#ifdef EMU
DEV unsigned char* wsp(const Args& a) { return a.ws; }
DEV float* outp(const Args& a) { return a.out; }
#else
DEV unsigned char* launder_ptr(const void* p) { unsigned long long v = (unsigned long long)p; unsigned lo = (unsigned)v, hi = (unsigned)(v >> 32);
    lo = (unsigned)__builtin_amdgcn_readfirstlane((int)lo); hi = (unsigned)__builtin_amdgcn_readfirstlane((int)hi); asm volatile("" : "+s"(lo), "+s"(hi)); typedef __attribute__((address_space(1))) unsigned char* gptr_t; return (unsigned char*)(gptr_t)(((unsigned long long)hi << 32) | lo); }
DEV unsigned char* wsp(const Args& a) { return launder_ptr(a.ws); }
DEV float* outp(const Args& a) { return (float*)launder_ptr(a.out); }
#endif

#ifdef EMU
#define INP(a, X) ((a).in[X])
#else
DEV int zero_opaque() { int z = 0; asm volatile("" : "+s"(z)); return z; }
#define INP(a, X) ((a).in[(X) + zero_opaque()])
#endif

DEV unsigned f2bf(float f) { unsigned u = __builtin_bit_cast(unsigned, f); return (u + 0x7fffu + ((u >> 16) & 1u)) >> 16; }
DEV float bf2f(unsigned h) { return __builtin_bit_cast(float, h << 16); }
#ifdef EMU
DEV unsigned pk2(float lo, float hi) { return f2bf(lo) | (f2bf(hi) << 16); }
#else
typedef float f32x2_t __attribute__((ext_vector_type(2)));
typedef __bf16 bf16x2_t __attribute__((ext_vector_type(2)));
DEV unsigned pk2(float lo, float hi) { f32x2_t v = {lo, hi}; bf16x2_t b = __builtin_convertvector(v, bf16x2_t); return __builtin_bit_cast(unsigned, b); }
#endif
DEV float sigm(float x) { return frcp(1.0f + fexp2(-x * LOG2E)); }
DEV float siluf(float x) { return x * sigm(x); }
DEV f32x4 f4zero() { f32x4 z = {0.f, 0.f, 0.f, 0.f}; return z; }
DEV bf16x8 pack8(f32x4 a, f32x4 b) {
    u32x4 w; w[0] = pk2(a[0], a[1]); w[1] = pk2(a[2], a[3]); w[2] = pk2(b[0], b[1]); w[3] = pk2(b[2], b[3]);
    return __builtin_bit_cast(bf16x8, w);
}
DEV void st_bf4(bf16* p, f32x4 v) { u32x2 w; w[0] = pk2(v[0], v[1]); w[1] = pk2(v[2], v[3]); *(u32x2*)p = w; }


#ifdef EMU
namespace pg8 {
constexpr int BM = 256, BK = 64, HALF = 128, NXCD = 8, WGM = 8;
typedef unsigned short bf16_t;
struct Unit { int pm, pn; };
struct Gemm { const bf16_t* A; const bf16_t* Bt; int M, N, K; };
struct StaticOrder {
    int nM, nN, nwg, G, c;
    void init(int M, int N, int G_, int c_) { nM = M / BM; nN = N / BM; nwg = nM * nN; G = G_; c = c_; }
    bool next(int i, Unit& u) const {
        const long L = (long)i * G + c; if (L >= nwg) return false;
        int wgid = (int)L; { const int q = nwg / NXCD, r = nwg % NXCD, xcd = wgid % NXCD, off = wgid / NXCD; wgid = (xcd < r ? xcd * (q + 1) : r * (q + 1) + (xcd - r) * q) + off; }
        const int nig = WGM * nN, gid = wgid / nig, fm = gid * WGM, gsz = (nM - fm) < WGM ? (nM - fm) : WGM;
        u.pm = fm + ((wgid % nig) % gsz); u.pn = (wgid % nig) / gsz; return true;
    }
};
template <class Epi, class Sched, bool ALIGN_EPI = false, bool SP2 = false>
static inline void gemm_phase(unsigned char*, const Gemm g, const Sched& S, const Epi& E) {
    const int tid = emu_tid(), wid = tid >> 6, lane = tid & 63, wr = wid >> 2, wc = wid & 3, fr = lane & 15, fq = lane >> 4;
    Unit u;
    for (int ui = 0; S.next(ui, u); ++ui) {
        f32x4 acc[2][2][4][2];
        for (int ai = 0; ai < 2; ++ai) for (int bj = 0; bj < 2; ++bj) for (int m = 0; m < 4; ++m) for (int n = 0; n < 2; ++n) for (int r = 0; r < 4; ++r) {
            const int row = 256 * u.pm + 128 * ai + 64 * wr + 16 * m + fr, col = 256 * u.pn + 128 * bj + 32 * wc + (Epi::PERM ? 8 * fq + 4 * n + r : 16 * n + 4 * fq + r); float sum = 0.f;
            const bf16_t* ap = g.A + (size_t)row * g.K; const bf16_t* bp = g.Bt + (size_t)col * g.K;
            for (int k = 0; k < g.K; ++k) sum += bf2f(ap[k]) * bf2f(bp[k]);
            acc[ai][bj][m][n][r] = sum; }
        E(acc, u, wr, wc, fr, fq);
    }
    emu_sync_block();
}
}
#else
namespace pg8 {
#define PG8_LAS __attribute__((address_space(3)))
typedef unsigned short bf16_t;
typedef short bf16x8 __attribute__((ext_vector_type(8)));
typedef float f32x4 __attribute__((ext_vector_type(4)));
typedef unsigned u32x4 __attribute__((ext_vector_type(4)));
constexpr int BM = 256, BK = 64, HALF = 128, HTB = HALF * BK * 2  , STAGE_BYTES = 8 * HTB, NXCD = 8, WGM = 8;

__host__ __device__ __forceinline__ int lds_byte(int r, int c) { const int st = (r >> 4) * 2 + (c >> 5), rr = r & 15, cc = c & 31, ob = rr * 64 + cc * 2; return st * 1024 + (ob ^ (((ob >> 9) & 1) << 5)); }
__host__ __device__ __forceinline__ void stage_rc(int b, int& R, int& C) { const int st = b / 1024, sb = b % 1024, swz = sb ^ (((sb >> 9) & 1) << 5); R = (st >> 1) * 16 + swz / 64; C = (st & 1) * 32 + (swz % 64) / 2; }
__host__ __device__ __forceinline__ int perm32(int rho) { const int n = rho >> 4, i = rho & 15; return 8 * (i >> 2) + 4 * n + (i & 3); }

struct Unit { int pm, pn; };
struct Gemm { const bf16_t* A; const bf16_t* Bt; int M, N, K; };

struct StaticOrder {
    int nM, nN, nwg, G, c;
    __host__ __device__ void init(int M, int N, int G_, int c_) { nM = M / BM; nN = N / BM; nwg = nM * nN; G = G_; c = c_; }
    __host__ __device__ bool next(int i, Unit& u) const {
        const long L = (long)i * G + c; if (L >= nwg) return false;
        int wgid = (int)L; { const int q = nwg / NXCD, r = nwg % NXCD, xcd = wgid % NXCD, off = wgid / NXCD; wgid = (xcd < r ? xcd * (q + 1) : r * (q + 1) + (xcd - r) * q) + off; }
        const int nig = WGM * nN, gid = wgid / nig, fm = gid * WGM, gsz = (nM - fm) < WGM ? (nM - fm) : WGM;
        u.pm = fm + ((wgid % nig) % gsz); u.pn = (wgid % nig) / gsz; return true;
    }
    __device__ __forceinline__ void a_ready(const Unit&) const {}
    __device__ __forceinline__ void done(const Unit&) const {}
};

__device__ __forceinline__ unsigned cvt_pk_bf16(float lo, float hi) { unsigned r; asm volatile("v_cvt_pk_bf16_f32 %0, %1, %2" : "=v"(r) : "v"(lo), "v"(hi)); return r; }
template <class Epi, class Sched, bool ALIGN_EPI = false, bool SP2 = false>
__device__ __forceinline__ void gemm_phase(PG8_LAS unsigned char* lds, const Gemm g, const Sched& S, const Epi& E) {
    const int tid = TID, wid = __builtin_amdgcn_readfirstlane(tid >> 6), lane = tid & 63, wr = wid >> 2, wc = wid & 3, fr = lane & 15, fq = lane >> 4;
    const int K = g.K, nt = K / BK;
    unsigned voffA[2], voffB[2];
#pragma unroll
    for (int i = 0; i < 2; ++i) { int R, C; stage_rc(tid * 16 + i * 8192, R, C); const int Rb = Epi::PERM ? ((R & ~31) + perm32(R & 31)) : R;
        voffA[i] = (unsigned)(R * K + C) * 2u; voffB[i] = (unsigned)(Rb * K + C) * 2u; }
    const size_t kstep = (size_t)(BK * 2);
    const size_t hstep = (size_t)HALF * K * 2;
    const size_t tstep = 2 * hstep;
    const unsigned ldsw = (unsigned)wid * 1024u;
    const int aoff = lds_byte(wr * 64 + fr, fq * 8), boff = lds_byte(wc * 32 + fr, fq * 8);
#define PG8_SA(b, h) (((b) * 2 + (h)) * HTB)
#define PG8_SB(b, h) ((4 + (b) * 2 + (h)) * HTB)
#define PG8_STAGE(bufoff, gbase, voff) do { _Pragma("unroll") for (int _i = 0; _i < 2; ++_i) \
        __builtin_amdgcn_global_load_lds((const unsigned*)((const char*)(gbase) + (voff)[_i]), (PG8_LAS unsigned*)(lds + (bufoff) + ldsw + _i * 8192), 16, 0, 0); } while (0)
#define PG8_LDA(dst, b, h) do { _Pragma("unroll") for (int m = 0; m < 4; ++m) _Pragma("unroll") for (int k = 0; k < 2; ++k) dst[m][k] = *(const PG8_LAS bf16x8*)(lds + PG8_SA(b, h) + aoff + m * 2048 + k * 1024); } while (0)
#define PG8_LDB(dst, b, h) do { _Pragma("unroll") for (int n = 0; n < 2; ++n) _Pragma("unroll") for (int k = 0; k < 2; ++k) dst[n][k] = *(const PG8_LAS bf16x8*)(lds + PG8_SB(b, h) + boff + n * 2048 + k * 1024); } while (0)
#define PG8_MMA(ai, bj, At, Bt) do { __builtin_amdgcn_s_setprio(1); _Pragma("unroll") for (int m = 0; m < 4; ++m) _Pragma("unroll") for (int n = 0; n < 2; ++n) _Pragma("unroll") for (int k = 0; k < 2; ++k) \
        acc[ai][bj][m][n] = __builtin_amdgcn_mfma_f32_16x16x32_bf16(Bt[n][k], At[m][k], acc[ai][bj][m][n], 0, 0, 0); __builtin_amdgcn_s_setprio(0); } while (0)
#define PG8_WAIT_V(n) asm volatile("s_waitcnt vmcnt(" #n ")" ::: "memory")
#define PG8_WAIT_L(n) asm volatile("s_waitcnt lgkmcnt(" #n ")" ::: "memory")
#define PG8_BAR __builtin_amdgcn_s_barrier()
#define PG8_SCHED __builtin_amdgcn_sched_barrier(0)
    Unit cur, nxt; int ui = 0;
    if (!S.next(0, cur)) return;
    f32x4 acc[2][2][4][2];
#pragma unroll
    for (int a = 0; a < 2; ++a)
#pragma unroll
        for (int b = 0; b < 2; ++b)
#pragma unroll
            for (int m = 0; m < 4; ++m)
#pragma unroll
                for (int n = 0; n < 2; ++n) acc[a][b][m][n] = (f32x4){0.f, 0.f, 0.f, 0.f};
    bf16x8 At[4][2], B0[2][2], B1[2][2];
    const char* cA = (const char*)g.A + (size_t)cur.pm * tstep; const char* cB = (const char*)g.Bt + (size_t)cur.pn * tstep;
    S.a_ready(cur);
    if constexpr (SP2) {
        PG8_STAGE(PG8_SB(0, 0), cB, voffB); PG8_STAGE(PG8_SB(0, 1), cB + hstep, voffB); PG8_STAGE(PG8_SA(0, 0), cA, voffA); PG8_STAGE(PG8_SA(0, 1), cA + hstep, voffA);
        if (wr == 1) PG8_BAR;
        PG8_WAIT_V(2); PG8_BAR;
        PG8_STAGE(PG8_SB(1, 0), cB + kstep, voffB); PG8_STAGE(PG8_SA(1, 0), cA + kstep, voffA); PG8_STAGE(PG8_SB(1, 1), cB + hstep + kstep, voffB);
        PG8_WAIT_V(6); PG8_BAR;
    } else {
        PG8_STAGE(PG8_SB(0, 0), cB, voffB); PG8_STAGE(PG8_SA(0, 0), cA, voffA); PG8_STAGE(PG8_SB(0, 1), cB + hstep, voffB); PG8_STAGE(PG8_SA(0, 1), cA + hstep, voffA);
        if (wr == 1) PG8_BAR;
        PG8_WAIT_V(4); PG8_BAR;
        PG8_STAGE(PG8_SB(1, 0), cB + kstep, voffB); PG8_STAGE(PG8_SA(1, 0), cA + kstep, voffA); PG8_STAGE(PG8_SB(1, 1), cB + hstep + kstep, voffB);
        PG8_WAIT_V(6); PG8_BAR;
    }
    for (;;) {
        const bool has_next = S.next(ui + 1, nxt);
        const char* nA = has_next ? (const char*)g.A + (size_t)nxt.pm * tstep : cA; const char* nB = has_next ? (const char*)g.Bt + (size_t)nxt.pn * tstep : cB;
        for (int t = 0; t < nt; t += 2) {
            const bool last = (t == nt - 2);
            const char* a1 = cA + (size_t)(t + 1) * kstep;
            const char* a2 = last ? nA : cA + (size_t)(t + 2) * kstep; const char* b2 = last ? nB : cB + (size_t)(t + 2) * kstep;
            const char* a3 = a2 + kstep; const char* b3 = b2 + kstep;
            if (last && has_next) S.a_ready(nxt);
            if constexpr (SP2) {
            PG8_LDB(B0, 0, 0); PG8_LDB(B1, 0, 1); PG8_SCHED; PG8_LDA(At, 0, 0); PG8_STAGE(PG8_SA(1, 1), a1 + hstep, voffA);
            PG8_WAIT_V(8); PG8_WAIT_L(0); PG8_BAR; PG8_MMA(0, 0, At, B0); PG8_MMA(0, 1, At, B1); PG8_BAR; PG8_SCHED;
            PG8_LDA(At, 0, 1); PG8_STAGE(PG8_SB(0, 0), b2, voffB); PG8_STAGE(PG8_SB(0, 1), b2 + hstep, voffB); PG8_STAGE(PG8_SA(0, 0), a2, voffA);
            PG8_WAIT_V(8); PG8_WAIT_L(0); PG8_BAR; PG8_MMA(1, 0, At, B0); PG8_MMA(1, 1, At, B1); PG8_BAR; PG8_SCHED;
            PG8_LDB(B0, 1, 0); PG8_LDB(B1, 1, 1); PG8_SCHED; PG8_LDA(At, 1, 0); PG8_STAGE(PG8_SA(0, 1), a2 + hstep, voffA);
            PG8_WAIT_V(8); PG8_WAIT_L(0); PG8_BAR; PG8_MMA(0, 0, At, B0); PG8_MMA(0, 1, At, B1); PG8_BAR; PG8_SCHED;
            PG8_LDA(At, 1, 1); PG8_STAGE(PG8_SB(1, 0), b3, voffB); PG8_STAGE(PG8_SB(1, 1), b3 + hstep, voffB); PG8_STAGE(PG8_SA(1, 0), a3, voffA);
            PG8_WAIT_V(8); PG8_WAIT_L(0); PG8_BAR; PG8_MMA(1, 0, At, B0); PG8_MMA(1, 1, At, B1); PG8_BAR; PG8_SCHED;
            } else {
            PG8_LDB(B0, 0, 0); PG8_SCHED; PG8_LDA(At, 0, 0); PG8_STAGE(PG8_SA(1, 1), a1 + hstep, voffA);
            PG8_WAIT_L(8); PG8_BAR; PG8_WAIT_L(0); PG8_MMA(0, 0, At, B0); PG8_BAR; PG8_SCHED;
            PG8_LDB(B1, 0, 1); PG8_STAGE(PG8_SB(0, 0), b2, voffB);
            PG8_BAR; PG8_WAIT_L(0); PG8_MMA(0, 1, At, B1); PG8_BAR;
            PG8_LDA(At, 0, 1); PG8_STAGE(PG8_SA(0, 0), a2, voffA);
            PG8_BAR; PG8_WAIT_L(0); PG8_MMA(1, 0, At, B0); PG8_BAR; PG8_SCHED;
            PG8_STAGE(PG8_SB(0, 1), b2 + hstep, voffB);
            PG8_WAIT_V(6); PG8_BAR; PG8_MMA(1, 1, At, B1); PG8_BAR;
            PG8_LDB(B0, 1, 0); PG8_SCHED; PG8_LDA(At, 1, 0); PG8_STAGE(PG8_SA(0, 1), a2 + hstep, voffA);
            PG8_WAIT_L(8); PG8_BAR; PG8_WAIT_L(0); PG8_MMA(0, 0, At, B0); PG8_BAR; PG8_SCHED;
            PG8_LDB(B1, 1, 1); PG8_STAGE(PG8_SB(1, 0), b3, voffB);
            PG8_BAR; PG8_WAIT_L(0); PG8_MMA(0, 1, At, B1); PG8_BAR;
            PG8_LDA(At, 1, 1); PG8_STAGE(PG8_SA(1, 0), a3, voffA);
            PG8_BAR; PG8_WAIT_L(0); PG8_MMA(1, 0, At, B0); PG8_BAR; PG8_SCHED;
            PG8_STAGE(PG8_SB(1, 1), b3 + hstep, voffB);
            PG8_WAIT_V(6); PG8_BAR; PG8_MMA(1, 1, At, B1); PG8_BAR;
            }
        }
        if constexpr (ALIGN_EPI) { if (wr == 0) PG8_BAR; }
        if constexpr (!Epi::AFTER_DRAIN) { E(acc, cur, wr, wc, fr, fq); S.done(cur); }
        if (!has_next) break;
#pragma unroll
        for (int a = 0; a < 2; ++a)
#pragma unroll
            for (int b = 0; b < 2; ++b)
#pragma unroll
                for (int m = 0; m < 4; ++m)
#pragma unroll
                    for (int n = 0; n < 2; ++n) acc[a][b][m][n] = (f32x4){0.f, 0.f, 0.f, 0.f};
        cur = nxt; cA = nA; cB = nB; ++ui;
        if constexpr (ALIGN_EPI) { if (wr == 1) PG8_BAR; }
    }
    PG8_WAIT_V(0);
    if constexpr (!ALIGN_EPI) { if (wr == 0) PG8_BAR; }
    PG8_BAR;
    if constexpr (Epi::AFTER_DRAIN) { E.fused(acc, cur, wr, wc, fr, fq, lds, wid, lane); S.done(cur); }
#undef PG8_SA
#undef PG8_SB
#undef PG8_STAGE
#undef PG8_LDA
#undef PG8_LDB
#undef PG8_MMA
#undef PG8_WAIT_V
#undef PG8_WAIT_L
#undef PG8_BAR
#undef PG8_SCHED
}
}
#endif

constexpr int LDT = 72;
constexpr int GEMM_AS = 256 * LDT, GEMM_BS = 128 * LDT;
constexpr int GEMM_LDS = 2 * (GEMM_AS + GEMM_BS) * 2;

template <class AF, class EPI>
DEV void gemm_tile(unsigned char* smem, AF af, const bf16* Bt, int ldb, int nvalid, int K, EPI& epi) {
    const int tid = TID, w = tid >> 6, l = tid & 63, h = l >> 4, c = l & 15, wm = w >> 1, wn = w & 1;
    bf16* As = (bf16*)smem; bf16* Bs = As + 2 * GEMM_AS;
    const bf16* ap[4]; const bf16* bp[2];
    const int col8 = (tid & 7) * 8, r0 = tid >> 3;
#pragma unroll
    for (int i = 0; i < 4; ++i) ap[i] = af(r0 + 64 * i) + col8;
#pragma unroll
    for (int i = 0; i < 2; ++i) { int rn = r0 + 64 * i; if (rn >= nvalid) rn = nvalid - 1; bp[i] = Bt + (size_t)rn * ldb + col8; }
    f32x4 acc[4][4];
#pragma unroll
    for (int i = 0; i < 4; ++i)
#pragma unroll
        for (int j = 0; j < 4; ++j) acc[i][j] = f4zero();
    bf16x8 ra[4], rb[2];
#pragma unroll
    for (int i = 0; i < 4; ++i) ra[i] = *(const bf16x8*)(ap[i]);
#pragma unroll
    for (int i = 0; i < 2; ++i) rb[i] = *(const bf16x8*)(bp[i]);
    SYNC();
#pragma unroll
    for (int i = 0; i < 4; ++i) *(bf16x8*)(As + (r0 + 64 * i) * LDT + col8) = ra[i];
#pragma unroll
    for (int i = 0; i < 2; ++i) *(bf16x8*)(Bs + (r0 + 64 * i) * LDT + col8) = rb[i];
    SYNC();
    const int nk = K / 64;
    for (int kt = 0; kt < nk; ++kt) {
        const int cur = kt & 1;
        if (kt + 1 < nk) {
#pragma unroll
            for (int i = 0; i < 4; ++i) ra[i] = *(const bf16x8*)(ap[i] + (kt + 1) * 64);
#pragma unroll
            for (int i = 0; i < 2; ++i) rb[i] = *(const bf16x8*)(bp[i] + (kt + 1) * 64);
        }
        const bf16* Ac = As + cur * GEMM_AS + (wm * 64 + c) * LDT + 8 * h;
        const bf16* Bc = Bs + cur * GEMM_BS + (wn * 64 + c) * LDT + 8 * h;
#pragma unroll
        for (int kk = 0; kk < 2; ++kk) {
            bf16x8 fa[4], fb[4];
#pragma unroll
            for (int i = 0; i < 4; ++i) { fa[i] = *(const bf16x8*)(Ac + i * 16 * LDT + kk * 32); fb[i] = *(const bf16x8*)(Bc + i * 16 * LDT + kk * 32); }
#pragma unroll
            for (int ni = 0; ni < 4; ++ni)
#pragma unroll
                for (int mi = 0; mi < 4; ++mi) acc[ni][mi] = mfma16(fb[ni], fa[mi], acc[ni][mi]);
        }
        if (kt + 1 < nk) {
            const int nx = cur ^ 1;
#pragma unroll
            for (int i = 0; i < 4; ++i) *(bf16x8*)(As + nx * GEMM_AS + (r0 + 64 * i) * LDT + col8) = ra[i];
#pragma unroll
            for (int i = 0; i < 2; ++i) *(bf16x8*)(Bs + nx * GEMM_BS + (r0 + 64 * i) * LDT + col8) = rb[i];
        }
        SYNC();
    }
    epi(acc, wm * 64, wn * 64, h, c);
}

struct ARows { const bf16* base; size_t ld; MDEV const bf16* operator()(int r) const { return base + (size_t)r * ld; } MDEV unsigned off(int r) const { return (unsigned)r * (unsigned)ld; } };

constexpr int LDB = 144;
constexpr int GEMM_BS2 = 64 * LDB;
constexpr int GEMM2_LDS = (2 * GEMM_AS + 2 * GEMM_BS2) * 2;
DEV bf16x8 tr_read8(const bf16* p0, const bf16* p1) {
    const s16x4 x = tr4(p0), y = tr4(p1); bf16x8 r;
    r[0] = x[0]; r[1] = x[1]; r[2] = x[2]; r[3] = x[3]; r[4] = y[0]; r[5] = y[1]; r[6] = y[2]; r[7] = y[3]; return r;
}
DEV int bperm(int r) { return (r & ~12) | ((r & 4) << 1) | ((r & 8) >> 1); }
template <class AF, class BF, class EPI>
DEV void gemm_tile2(unsigned char* smem, AF af, BF bf, int ldb, int K, EPI& epi) {
    const int tid = TID, w = tid >> 6, l = tid & 63, h = l >> 4, c = l & 15, wm = w >> 1, wn = w & 1, grp = w >> 2;
    bf16* As = (bf16*)smem; bf16* Bs = As + 2 * GEMM_AS;
    const bf16* abase = af.base; unsigned ao[4];
    const int col8 = (tid & 7) * 8, r0 = tid >> 3;
#pragma unroll
    for (int i = 0; i < 4; ++i) ao[i] = af.off(r0 + 64 * i) + col8;
    const int bn4 = (tid & 31) * 4, bk = tid >> 5, bkp = bperm(bk);
    const float* bp = bf(bn4); const bool bok = bp != nullptr;
    if (bok) bp += (size_t)bk * ldb;
    const size_t bstep = (size_t)16 * ldb;
    f32x4 acc[4][4];
#pragma unroll
    for (int i = 0; i < 4; ++i)
#pragma unroll
        for (int j = 0; j < 4; ++j) acc[i][j] = f4zero();
    bf16x8 ra[4]; f32x4 rb[4];
    const int nk = K / 64;
#pragma unroll
    for (int i = 0; i < 4; ++i) { ra[i] = *(const bf16x8*)(abase + ao[i]); rb[i] = bok ? *(const f32x4*)(bp + i * bstep) : f4zero(); }
    SYNC();
#pragma unroll
    for (int i = 0; i < 4; ++i) { *(bf16x8*)(As + (r0 + 64 * i) * LDT + col8) = ra[i]; st_bf4(Bs + (bkp + 16 * i) * LDB + bn4, rb[i]); }
    if (nk > 1) {
#pragma unroll
        for (int i = 0; i < 4; ++i) { ra[i] = *(const bf16x8*)(abase + (ao[i] + 64)); rb[i] = bok ? *(const f32x4*)(bp + (size_t)64 * ldb + i * bstep) : f4zero(); } }
    SYNC();
    for (int kt = 0; kt < nk; ++kt) {
        const int cur = kt & 1;
#pragma unroll
        for (int p = 0; p < 2; ++p) {
            if (grp == p) {
                const bf16* Ac = As + cur * GEMM_AS + (wm * 64 + c) * LDT + 8 * h;
                const bf16* Bc = Bs + cur * GEMM_BS2 + bperm(8 * h + (c >> 2)) * LDB + wn * 64 + 4 * (c & 3);
#pragma unroll
                for (int kk = 0; kk < 2; ++kk) {
                    bf16x8 fa[4], fb[4];
#pragma unroll
                    for (int i = 0; i < 4; ++i) { fa[i] = *(const bf16x8*)(Ac + i * 16 * LDT + kk * 32); fb[i] = tr_read8(Bc + (32 * kk) * LDB + 16 * i, Bc + (32 * kk + 8) * LDB + 16 * i); }
#pragma unroll
                    for (int ni = 0; ni < 4; ++ni)
#pragma unroll
                        for (int mi = 0; mi < 4; ++mi) acc[ni][mi] = mfma16(fb[ni], fa[mi], acc[ni][mi]);
                }
            } else if (kt + 1 < nk) {
                const int nx = cur ^ 1;
#pragma unroll
                for (int i = 0; i < 4; ++i) { *(bf16x8*)(As + nx * GEMM_AS + (r0 + 64 * i) * LDT + col8) = ra[i]; st_bf4(Bs + nx * GEMM_BS2 + (bkp + 16 * i) * LDB + bn4, rb[i]); }
                if (kt + 2 < nk) {
#pragma unroll
                    for (int i = 0; i < 4; ++i) { ra[i] = *(const bf16x8*)(abase + (ao[i] + (kt + 2) * 64)); rb[i] = bok ? *(const f32x4*)(bp + (size_t)(kt + 2) * 64 * ldb + i * bstep) : f4zero(); } }
            }
            SYNC();
        }
    }
    epi(acc, wm * 64, wn * 64, h, c);
}
struct BPlain { const float* base; MDEV const float* operator()(int nt) const { return base + nt; } };
struct BInProjMap { const float* base; int n0; MDEV const float* operator()(int nt) const { const int n = n0 + nt; const int sc = n < 1280 ? n : (n < 3328 ? n + 24 : (n < 3352 ? 1280 + (n - 3328) : -1)); return sc < 0 ? nullptr : base + sc; } };
struct BInter { const float* s0; const float* s1; int n0; MDEV const float* operator()(int nt) const { const int n = n0 + nt, g = n >> 6, w = n & 63; return w < 32 ? s0 + g * 32 + w : s1 + g * 32 + w - 32; } };
struct BClamp64 { const float* base; MDEV const float* operator()(int nt) const { return base + (nt & 63); } };

struct EpiInProj {
    const Args* a; int m0, n0, li;
    MDEV void operator()(f32x4 (&acc)[4][4], int mw, int nw, int h, int c) const {
        unsigned char* ws = wsp(*a);
        const int nb = n0 + nw;
        const int tokb = m0 + mw + c;
        if (nb < 512 || (nb >= 768 && nb < 896) || (nb >= 1024 && nb < 1152)) {
            const float* gain; float mul = 1.f; bf16* dst; int kind;
            if (nb < 512) { gain = INP(*a, I_QG) + li * 64; mul = 0.125f * LOG2E; kind = 0; dst = (bf16*)(ws + WS_QN); }
            else if (nb < 896) { gain = INP(*a, I_KG) + (li * 3 + 1) * 64; kind = 1; dst = (bf16*)(ws + WS_KS); }
            else { gain = INP(*a, I_KG) + (li * 3 + 2) * 64; kind = 1; dst = (bf16*)(ws + WS_KW); }
            const int g = (nb >> 6) & 1;
#pragma unroll
            for (int mi = 0; mi < 4; ++mi) {
                float ss = 0.f;
#pragma unroll
                for (int ni = 0; ni < 4; ++ni) { f32x4 v = acc[ni][mi]; ss += v[0] * v[0] + v[1] * v[1] + v[2] * v[2] + v[3] * v[3]; }
                ss += shflx(ss, 16); ss += shflx(ss, 32);
                const float rs = frsq(ss * (1.0f / 64.0f) + EPS) * mul;
                const int tok = tokb + 16 * mi;
#pragma unroll
                for (int ni = 0; ni < 4; ++ni) {
                    const int d = 16 * ni + 4 * h; f32x4 v = acc[ni][mi], o;
#pragma unroll
                    for (int r = 0; r < 4; ++r) o[r] = v[r] * rs * gain[d + r];
                    if (kind == 0) st_bf4(dst + (size_t)tok * 512 + nb + d, o);
                    else { const int b = tok / SEQ, s = tok % SEQ; st_bf4(dst + ((size_t)(b * 2 + g) * SEQ + s) * 64 + d, o); }
                }
            }
        } else if (nb < 768) {
            bf16* dst = (bf16*)(ws + (nb < 640 ? WS_KCG : WS_VCG)); const int g = (nb >> 6) & 1;
#pragma unroll
            for (int mi = 0; mi < 4; ++mi) { const int tok = tokb + 16 * mi, b = tok / SEQ, s = tok % SEQ;
#pragma unroll
                for (int ni = 0; ni < 4; ++ni) st_bf4(dst + ((size_t)(b * 2 + g) * SEQ + s) * 64 + 16 * ni + 4 * h, acc[ni][mi]); }
        } else if (nb < 1280) {
            bf16* dst = (bf16*)(ws + (nb < 1024 ? WS_VST : WS_VWT)); const int g = (nb >> 6) & 1;
#pragma unroll
            for (int mi = 0; mi < 4; ++mi) { const int tok = tokb + 16 * mi, b = tok / SEQ, s = tok % SEQ;
                bf16* p = dst + ((size_t)(b * 2 + g) * NCH + (s >> 6)) * 4096 + (s & 63);
#pragma unroll
                for (int ni = 0; ni < 4; ++ni)
#pragma unroll
                    for (int r = 0; r < 4; ++r) p[(16 * ni + 4 * h + r) * 64] = (bf16)f2bf(acc[ni][mi][r]); }
        } else if (nb < 3328) {
            const int sec = (nb - 1280) >> 9, cc = (nb - 1280) & 511, hh = cc >> 7, d0 = cc & 127;
#pragma unroll
            for (int mi = 0; mi < 4; ++mi) { const int tok = tokb + 16 * mi, b = tok / SEQ, s = tok % SEQ;
                const size_t hrow = ((size_t)(b * 4 + hh) * SEQ + s) * 128 + d0;
#pragma unroll
                for (int ni = 0; ni < 4; ++ni) { const int d = 16 * ni + 4 * h; f32x4 v = acc[ni][mi], o;
                    if (sec == 0) { for (int r = 0; r < 4; ++r) o[r] = siluf(v[r]); st_bf4((bf16*)(ws + WS_HQ) + hrow + d, o); }
                    else if (sec == 1) { const float* lb = (const float*)(ws + WS_LB) + li * 512 + cc + d;
                        for (int r = 0; r < 4; ++r) o[r] = lb[r] + (1.0f - lb[r]) * sigm(v[r]);
                        *(f32x4*)((float*)(ws + WS_HF) + hrow + d) = o; }
                    else if (sec == 2) st_bf4((bf16*)(ws + WS_HV) + hrow + d, v);
                    else { for (int r = 0; r < 4; ++r) o[r] = siluf(v[r]); st_bf4((bf16*)(ws + WS_HGS) + (size_t)tok * 512 + cc + d, o); }
                } }
        } else if (nb == 3328) {
            float* dst = (float*)(ws + WS_GATE);
#pragma unroll
            for (int mi = 0; mi < 4; ++mi) { const int tok = tokb + 16 * mi;
#pragma unroll
                for (int ni = 0; ni < 2; ++ni)
#pragma unroll
                    for (int r = 0; r < 4; ++r) { const int n = 16 * ni + 4 * h + r; if (n < 24) dst[(size_t)tok * 24 + n] = sigm(acc[ni][mi][r]); } }
        }
    }
};

struct EpiResid {
    float* x; const float* gate; int m0, n0;
    MDEV void operator()(f32x4 (&acc)[4][4], int mw, int nw, int h, int c) const {
#pragma unroll
        for (int mi = 0; mi < 4; ++mi) { const int tok = m0 + mw + 16 * mi + c, b = tok / SEQ;
#pragma unroll
            for (int ni = 0; ni < 4; ++ni) { const int n = n0 + nw + 16 * ni + 4 * h;
                f32x4 g = *(const f32x4*)(gate + (size_t)b * 6 * DM + n); f32x4* p = (f32x4*)(x + (size_t)tok * DM + n); f32x4 v = *p;
#pragma unroll
                for (int r = 0; r < 4; ++r) v[r] += g[r] * acc[ni][mi][r];
                *p = v; } }
    }
};
template <int MODE> struct EpiGated {
    bf16* dst; size_t ld; int m0, n0, mvalid;
    MDEV void operator()(f32x4 (&acc)[4][4], int mw, int nw, int h, int c) const {
        const int cb = (n0 + nw) / 2;
#pragma unroll
        for (int mi = 0; mi < 4; ++mi) { const int m = mw + 16 * mi + c; if (m >= mvalid) continue;
#pragma unroll
            for (int ni = 0; ni < 2; ++ni) { f32x4 o;
#pragma unroll
                for (int r = 0; r < 4; ++r) { const float av = acc[ni][mi][r], bv = acc[ni + 2][mi][r]; o[r] = MODE == 0 ? av * sigm(bv) : siluf(av) * bv; }
                st_bf4(dst + (size_t)(m0 + m) * ld + cb + 16 * ni + 4 * h, o); } }
    }
};
struct EpiStoreBf {
    bf16* dst; size_t ld; int m0, n0, mvalid;
    MDEV void operator()(f32x4 (&acc)[4][4], int mw, int nw, int h, int c) const {
#pragma unroll
        for (int mi = 0; mi < 4; ++mi) { const int m = mw + 16 * mi + c; if (m >= mvalid) continue;
#pragma unroll
            for (int ni = 0; ni < 4; ++ni) st_bf4(dst + (size_t)(m0 + m) * ld + n0 + nw + 16 * ni + 4 * h, acc[ni][mi]); }
    }
};
struct EpiCmp {
    const Args* a; int kv, bg, m0, li;
    MDEV void operator()(f32x4 (&acc)[4][4], int mw, int nw, int h, int c) const {
        if (nw != 0) return;
        unsigned char* ws = wsp(*a);
        const float* bp8 = (const float*)(ws + WS_CB) + (li * 2 + kv) * 8 * 64;
        float bias[16];
#pragma unroll
        for (int q = 0; q < 16; ++q) { const int e = 16 * (q >> 2) + 4 * h + (q & 3); float v = 0.f;
#pragma unroll
            for (int kp = 0; kp < 8; ++kp) v += bp8[kp * 64 + e];
            bias[q] = v; }
        const float* gain = INP(*a, I_KG) + (li * 3 + 0) * 64;
#pragma unroll
        for (int mi = 0; mi < 4; ++mi) { const int n = m0 + mw + 16 * mi + c; const bool ok = n < NCMP;
            f32x4 v[4]; float ss = 0.f;
#pragma unroll
            for (int ni = 0; ni < 4; ++ni) { v[ni] = acc[ni][mi];
#pragma unroll
                for (int r = 0; r < 4; ++r) { v[ni][r] += bias[4 * ni + r]; ss += v[ni][r] * v[ni][r]; } }
            ss += shflx(ss, 16); ss += shflx(ss, 32);
            if (n >= NCP) continue;
            if (kv == 0) { const float rs = frsq(ss * (1.0f / 64.0f) + EPS); bf16* p = (bf16*)(ws + WS_KC) + ((size_t)bg * NCP + n) * 64;
#pragma unroll
                for (int ni = 0; ni < 4; ++ni) { f32x4 o;
#pragma unroll
                    for (int r = 0; r < 4; ++r) o[r] = ok ? v[ni][r] * rs * gain[16 * ni + 4 * h + r] : 0.f;
                    st_bf4(p + 16 * ni + 4 * h, o); }
            } else { bf16* p = (bf16*)(ws + WS_VCT) + (size_t)bg * 64 * NCP + n;
#pragma unroll
                for (int ni = 0; ni < 4; ++ni)
#pragma unroll
                    for (int r = 0; r < 4; ++r) p[(size_t)(16 * ni + 4 * h + r) * NCP] = (bf16)f2bf(ok ? v[ni][r] : 0.f); }
        }
    }
};


DEV void st_bf8(bf16* p, f32x4 a, f32x4 b) { u32x4 w; w[0] = pk2(a[0], a[1]); w[1] = pk2(a[2], a[3]); w[2] = pk2(b[0], b[1]); w[3] = pk2(b[2], b[3]); *(u32x4*)p = w; }
struct EpiResid8 {
    static constexpr bool PERM = true, AFTER_DRAIN = false;
    float* x; const float* gate;
    MDEV void operator()(const f32x4 (&acc)[2][2][4][2], const pg8::Unit& u, int wr, int wc, int fr, int fq) const {
        OPAQUE2(fr, fq);
#pragma unroll
        for (int ai = 0; ai < 2; ++ai)
#pragma unroll
            for (int m = 0; m < 4; ++m) { const int row = 256 * u.pm + 128 * ai + 64 * wr + 16 * m + fr, b = row / SEQ;
#pragma unroll
                for (int bj = 0; bj < 2; ++bj)
#pragma unroll
                    for (int n = 0; n < 2; ++n) { const int col = 256 * u.pn + 128 * bj + 32 * wc + 8 * fq + 4 * n;
                        const f32x4 g = *(const f32x4*)(gate + (size_t)b * 6 * DM + col); f32x4* p = (f32x4*)(x + (size_t)row * DM + col); f32x4 v = *p;
#pragma unroll
                        for (int r = 0; r < 4; ++r) v[r] += g[r] * acc[ai][bj][m][n][r];
                        *p = v; } }
    }
};
struct EpiGlu8 {
    static constexpr bool PERM = true, AFTER_DRAIN = false;
    bf16* dst;
    MDEV void operator()(const f32x4 (&acc)[2][2][4][2], const pg8::Unit& u, int wr, int wc, int fr, int fq) const {
        OPAQUE2(fr, fq);
#pragma unroll
        for (int ai = 0; ai < 2; ++ai)
#pragma unroll
            for (int m = 0; m < 4; ++m) { const int row = 256 * u.pm + 128 * ai + 64 * wr + 16 * m + fr;
#pragma unroll
                for (int bj = 0; bj < 2; ++bj) { const int col = 128 * u.pn + 64 * bj + 16 * wc + 4 * fq; f32x4 o;
#pragma unroll
                    for (int r = 0; r < 4; ++r) o[r] = acc[ai][bj][m][0][r] * sigm(acc[ai][bj][m][1][r]);
                    st_bf4(dst + (size_t)row * DM + col, o); } }
    }
};
struct EpiInProj8 {
    static constexpr bool PERM = true, AFTER_DRAIN = false;
    const Args* a; int li;
    MDEV void operator()(const f32x4 (&acc)[2][2][4][2], const pg8::Unit& u, int wr, int wc, int fr, int fq) const {
        OPAQUE2(fr, fq);
        unsigned char* ws = wsp(*a);
        const int nb = 256 * u.pn + 64 * wc;
        if (nb >= 3392) return;
        if (nb < 512 || (nb >= 768 && nb < 896) || (nb >= 1024 && nb < 1152)) {
            const float* gain; float mul = 1.f; int kind;
            if (nb < 512) { gain = INP(*a, I_QG) + li * 64; mul = 0.125f * LOG2E; kind = 0; }
            else if (nb < 896) { gain = INP(*a, I_KG) + (li * 3 + 1) * 64; kind = 1; }
            else { gain = INP(*a, I_KG) + (li * 3 + 2) * 64; kind = 2; }
            const int g = (nb >> 6) & 1;
            f32x4 gv[2][2];
#pragma unroll
            for (int bj = 0; bj < 2; ++bj)
#pragma unroll
                for (int n = 0; n < 2; ++n) gv[bj][n] = *(const f32x4*)(gain + 32 * bj + 8 * fq + 4 * n);
#pragma unroll
            for (int ai = 0; ai < 2; ++ai)
#pragma unroll
                for (int m = 0; m < 4; ++m) { const int tok = 256 * u.pm + 128 * ai + 64 * wr + 16 * m + fr;
                    float ss = 0.f;
#pragma unroll
                    for (int bj = 0; bj < 2; ++bj)
#pragma unroll
                        for (int n = 0; n < 2; ++n) { const f32x4 v = acc[ai][bj][m][n]; ss += v[0] * v[0] + v[1] * v[1] + v[2] * v[2] + v[3] * v[3]; }
                    ss += shflx(ss, 16); ss += shflx(ss, 32);
                    const float rs = frsq(ss * (1.0f / 64.0f) + EPS) * mul;
                    bf16* dst; if (kind == 0) dst = (bf16*)(ws + WS_QN) + (size_t)tok * 512 + nb; else { const int b = tok / SEQ, sq = tok % SEQ; dst = (bf16*)(ws + (kind == 1 ? WS_KS : WS_KW)) + ((size_t)(b * 2 + g) * SEQ + sq) * 64; }
#pragma unroll
                    for (int bj = 0; bj < 2; ++bj) { f32x4 o0, o1;
#pragma unroll
                        for (int r = 0; r < 4; ++r) { o0[r] = acc[ai][bj][m][0][r] * rs * gv[bj][0][r]; o1[r] = acc[ai][bj][m][1][r] * rs * gv[bj][1][r]; }
                        st_bf8(dst + 32 * bj + 8 * fq, o0, o1); } }
        } else if (nb < 768) {
            bf16* base = (bf16*)(ws + (nb < 640 ? WS_KCG : WS_VCG)); const int g = (nb >> 6) & 1;
#pragma unroll
            for (int ai = 0; ai < 2; ++ai)
#pragma unroll
                for (int m = 0; m < 4; ++m) { const int tok = 256 * u.pm + 128 * ai + 64 * wr + 16 * m + fr, b = tok / SEQ, sq = tok % SEQ;
#pragma unroll
                    for (int bj = 0; bj < 2; ++bj) st_bf8(base + ((size_t)(b * 2 + g) * SEQ + sq) * 64 + 32 * bj + 8 * fq, acc[ai][bj][m][0], acc[ai][bj][m][1]); }
        } else if (nb < 1280) {
            bf16* base = (bf16*)(ws + (nb < 1024 ? WS_VST : WS_VWT)); const int g = (nb >> 6) & 1;
#pragma unroll
            for (int ai = 0; ai < 2; ++ai)
#pragma unroll
                for (int m = 0; m < 4; ++m) { const int tok = 256 * u.pm + 128 * ai + 64 * wr + 16 * m + fr, b = tok / SEQ, sq = tok % SEQ;
                    bf16* p = base + ((size_t)(b * 2 + g) * NCH + (sq >> 6)) * 4096 + (sq & 63);
#pragma unroll
                    for (int bj = 0; bj < 2; ++bj)
#pragma unroll
                        for (int n = 0; n < 2; ++n)
#pragma unroll
                            for (int r = 0; r < 4; ++r) p[(32 * bj + 8 * fq + 4 * n + r) * 64] = (bf16)f2bf(acc[ai][bj][m][n][r]); }
        } else if (nb < 3328) {
            const int sec = (nb - 1280) >> 9, cc = (nb - 1280) & 511, hh = cc >> 7, d0 = cc & 127;
            f32x4 lbv[2][2];
            if (sec == 1) {
#pragma unroll
                for (int bj = 0; bj < 2; ++bj)
#pragma unroll
                    for (int n = 0; n < 2; ++n) lbv[bj][n] = *(const f32x4*)((const float*)(ws + WS_LB) + li * 512 + cc + 32 * bj + 8 * fq + 4 * n); }
#pragma unroll
            for (int ai = 0; ai < 2; ++ai)
#pragma unroll
                for (int m = 0; m < 4; ++m) { const int tok = 256 * u.pm + 128 * ai + 64 * wr + 16 * m + fr, b = tok / SEQ, sq = tok % SEQ;
                    const size_t hrow = ((size_t)(b * 4 + hh) * SEQ + sq) * 128 + d0;
#pragma unroll
                    for (int bj = 0; bj < 2; ++bj) { const int d = 32 * bj + 8 * fq; f32x4 o0, o1;
                        if (sec == 0) {
#pragma unroll
                            for (int r = 0; r < 4; ++r) { o0[r] = siluf(acc[ai][bj][m][0][r]); o1[r] = siluf(acc[ai][bj][m][1][r]); }
                            st_bf8((bf16*)(ws + WS_HQ) + hrow + d, o0, o1); }
                        else if (sec == 1) {
#pragma unroll
                            for (int r = 0; r < 4; ++r) { o0[r] = lbv[bj][0][r] + (1.0f - lbv[bj][0][r]) * sigm(acc[ai][bj][m][0][r]); o1[r] = lbv[bj][1][r] + (1.0f - lbv[bj][1][r]) * sigm(acc[ai][bj][m][1][r]); }
                            float* pf = (float*)(ws + WS_HF) + hrow + d; *(f32x4*)pf = o0; *(f32x4*)(pf + 4) = o1; }
                        else if (sec == 2) st_bf8((bf16*)(ws + WS_HV) + hrow + d, acc[ai][bj][m][0], acc[ai][bj][m][1]);
                        else {
#pragma unroll
                            for (int r = 0; r < 4; ++r) { o0[r] = siluf(acc[ai][bj][m][0][r]); o1[r] = siluf(acc[ai][bj][m][1][r]); }
                            st_bf8((bf16*)(ws + WS_HGS) + (size_t)tok * 512 + cc + d, o0, o1); } } }
        } else {
            float* dst = (float*)(ws + WS_GATE);
            if (fq < 3) {
#pragma unroll
                for (int ai = 0; ai < 2; ++ai)
#pragma unroll
                    for (int m = 0; m < 4; ++m) { const int tok = 256 * u.pm + 128 * ai + 64 * wr + 16 * m + fr; f32x4 o0, o1;
#pragma unroll
                        for (int r = 0; r < 4; ++r) { o0[r] = sigm(acc[ai][0][m][0][r]); o1[r] = sigm(acc[ai][0][m][1][r]); }
                        float* pf = dst + (size_t)tok * 24 + 8 * fq; *(f32x4*)pf = o0; *(f32x4*)(pf + 4) = o1; } }
        }
    }
};

DEV void tr_tile(unsigned char* smem, const float* src0, const float* src1, int ld, int K, int mode, bf16* dst, int n0, int k0) {
    bf16* tl = (bf16*)smem;
    const int tid = TID;
    SYNC();
#pragma unroll
    for (int i = 0; i < 8; ++i) {
        const int e = tid + 512 * i, kk = e >> 6, nn = e & 63, n = n0 + nn; float v = 0.f;
        if (mode == 0) v = src0[(size_t)(k0 + kk) * ld + n];
        else if (mode == 1) { int sc = n < 1280 ? n : (n < 3328 ? n + 24 : (n < 3352 ? 1280 + (n - 3328) : -1)); if (sc >= 0) v = src0[(size_t)(k0 + kk) * ld + sc]; }
        else { const int g = n >> 6, w = n & 63; v = (w < 32) ? src0[(size_t)(k0 + kk) * ld + g * 32 + w] : src1[(size_t)(k0 + kk) * ld + g * 32 + w - 32]; }
        tl[nn * LDT + kk] = (bf16)f2bf(v);
    }
    SYNC();
    const int nn = tid >> 3, k8 = (tid & 7) * 8;
    *(bf16x8*)(dst + (size_t)(n0 + nn) * K + k0 + k8) = *(const bf16x8*)(tl + nn * LDT + k8);
}

DEV int tr_col(int mode, int n) {
    if (mode == 0) return n;
    const int pn = n >> 8, ct = n & 255;
    if (mode == 5) { const int bj = ct >> 7, wc = (ct >> 5) & 3, j = ct & 31, L = 256 * pn + 64 * wc + 32 * bj + j; return L < 1280 ? L : (L < 3328 ? L + 24 : (L < 3352 ? 1280 + (L - 3328) : -1)); }
    { const int bj = ct >> 7, wc = (ct >> 5) & 3, j = ct & 31, nn = (j >> 2) & 1, Lc = 128 * pn + 64 * bj + 16 * wc + 4 * (j >> 3) + (j & 3); return nn == 0 ? Lc : DM + Lc; }
}
DEV void tr_tile(unsigned char* smem, const float* src, int ld, int K, int mode, bf16* dst, int n0, int k0) {
    bf16* tl = (bf16*)smem;
    const int tid = TID;
    SYNC();
    { const int nn = tid & 63, n = n0 + nn, sc = tr_col(mode, n);
#pragma unroll
      for (int i = 0; i < 8; ++i) { const int kk = (tid >> 6) + 8 * i; const float v = sc >= 0 ? src[(size_t)(k0 + kk) * ld + sc] : 0.f; tl[nn * LDT + kk] = (bf16)f2bf(v); } }
    SYNC();
    const int nn = tid >> 3, k8 = (tid & 7) * 8;
    *(bf16x8*)(dst + (size_t)(n0 + nn) * K + k0 + k8) = *(const bf16x8*)(tl + nn * LDT + k8);
}
struct TrJob { const float* s; int ld, K, N, mode; bf16* dst; };
DEV void p0_phase(const Args& a, unsigned char* smem) {
    unsigned char* ws = wsp(a); const int tid = TID;
    { int item = BID, base = 0;
      for (int j = 0; j < 8; ++j) { TrJob J; const int i = j & 1;
        if (j < 2) J = {INP(a, I_WIN) + (size_t)i * DM * NIN, NIN, DM, NIN8, 5, (bf16*)(ws + WS_WIN) + (size_t)i * NIN8 * DM};
        else if (j < 4) J = {INP(a, I_WOUT) + (size_t)i * 1024 * DM, DM, 1024, DM, 0, (bf16*)(ws + WS_WOUT) + (size_t)i * DM * 1024};
        else if (j < 6) J = {INP(a, I_PW1) + (size_t)i * DM * 2 * DM, 2 * DM, DM, 2 * DM, 6, (bf16*)(ws + WS_PW1) + (size_t)i * 2 * DM * DM};
        else J = {INP(a, I_PW2) + (size_t)i * DM * DM, DM, DM, DM, 0, (bf16*)(ws + WS_PW2) + (size_t)i * DM * DM};
        const int tn = J.N / 64, tk = J.K / 64, nt = tn * tk;
        while (item < base + nt) { const int it = item - base; tr_tile(smem, J.s, J.ld, J.K, J.mode, J.dst, (it % tn) * 64, (it / tn) * 64); item += NBLK; }
        base += nt; }
      SYNC(); }
    {
        float* red = (float*)smem;
        constexpr int NG = 6 * DM / 128; const int ntask = DEPTH * NG;
        for (int t = BID; t < ntask; t += NBLK) {
            const int l = t / NG, j0 = (t % NG) * 128, cq = tid & 31, kr = tid >> 5;
            const float* w = INP(a, I_ADAW) + (size_t)l * DM * 6 * DM + j0 + 4 * cq; const float* cc = INP(a, I_C);
            f32x4 a0 = f4zero(), a1 = f4zero();
#pragma unroll 8
            for (int i = 0; i < DM / 16; ++i) { const int k = kr + 16 * i; const f32x4 wv = *(const f32x4*)(w + (size_t)k * 6 * DM); const float s0 = siluf(cc[k]), s1 = siluf(cc[DM + k]);
#pragma unroll
                for (int r = 0; r < 4; ++r) { a0[r] += s0 * wv[r]; a1[r] += s1 * wv[r]; } }
            SYNC();
            *(f32x4*)(red + (kr * 2 + 0) * 128 + 4 * cq) = a0; *(f32x4*)(red + (kr * 2 + 1) * 128 + 4 * cq) = a1;
            SYNC();
            if (tid < 256) { const int b = tid >> 7, col = tid & 127; float sum = INP(a, I_ADAB)[(size_t)l * 6 * DM + j0 + col];
#pragma unroll
                for (int q = 0; q < 16; ++q) sum += red[(q * 2 + b) * 128 + col];
                ((float*)(ws + WS_MOD))[((size_t)l * 2 + b) * 6 * DM + j0 + col] = sum; }
        }
    }
    for (int t = BID; t < 32; t += NBLK) {
        float* red = (float*)smem; const int ikv = t >> 3, kp = t & 7, i = ikv >> 1, kv = ikv & 1, e = tid & 63, ks = tid >> 6;
        const float* W = INP(a, kv ? I_CWV : I_CWK) + (size_t)i * 2048 * 64 + e; const float* pe = INP(a, I_CPE) + (size_t)i * 2048;
        float sum = 0.f;
#pragma unroll 8
        for (int q = 0; q < 32; ++q) { const int k = kp * 256 + ks * 32 + q; sum += pe[k] * W[(size_t)k * 64]; }
        SYNC(); red[ks * 64 + e] = sum; SYNC();
        if (tid < 64) { float v = 0.f; for (int q = 0; q < 8; ++q) v += red[q * 64 + tid]; ((float*)(ws + WS_CB))[(ikv * 8 + kp) * 64 + tid] = v; }
    }
    if (BID == 0) {
        for (int i = tid; i < DEPTH * 32; i += NT) ((int*)(ws + WS_CNT))[i * 64] = 0;
        for (int n = tid; n < 512; n += NT) { const float l0 = INP(a, I_LBL)[n], l1 = INP(a, I_LBL)[512 + n]; const float m = fmaxf(l0, l1);
            const float e0 = fexp2((l0 - m) * LOG2E), e1 = fexp2((l1 - m) * LOG2E);
            ((float*)(ws + WS_LB))[n] = 0.f; ((float*)(ws + WS_LB))[512 + n] = e1 / (e0 + e1); }
        if (tid < 2) { const int i = tid; float mq = 0.f; for (int d = 0; d < 64; ++d) mq = fmaxf(mq, fabsf(INP(a, I_QG)[i * 64 + d]));
            for (int br = 0; br < 3; ++br) { float mk = 0.f; for (int d = 0; d < 64; ++d) mk = fmaxf(mk, fabsf(INP(a, I_KG)[(i * 3 + br) * 64 + d]));
                ((float*)(ws + WS_CS))[i * 4 + br] = 8.0f * mq * mk * LOG2E; } }
    }
}

constexpr int NJV = DM / 256;
DEV void moe_bases(const int* cnt, int* rb  ) {
    if (TID == 0) { int acc = 0; for (int e = 0; e < 32; ++e) { rb[e] = acc; acc += ((cnt[e * 64] + 255) >> 8) << 8; } rb[32] = acc; }
    SYNC();
}
DEV void norm_phase(const Args& a, unsigned char* smem, int l) {
    unsigned char* ws = wsp(a); const int tid = TID, w = tid >> 6, lane = tid & 63;
    int* rb = (int*)smem;
    if (l > 0) moe_bases((const int*)(ws + WS_CNT) + (l - 1) * 32 * 64, rb);
    const float* mod = (const float*)(ws + WS_MOD);
    const bf16* yk = (const bf16*)(ws + WS_YK);
    for (int row = BID * 8 + w; row < T; row += NBLK * 8) {
        const int b = row / SEQ;
        f32x4 v[NJV];
        const float* xin = (l == 0) ? INP(a, I_X) : outp(a);
#pragma unroll
        for (int j = 0; j < NJV; ++j) v[j] = *(const f32x4*)(xin + (size_t)row * DM + 4 * lane + 256 * j);
        if (l > 0) {
            const int* tie = (const int*)(ws + WS_TIE) + (size_t)row * 2; const float* tiw = (const float*)(ws + WS_TIW) + (size_t)row * 2;
            const int e0 = tie[0] >> 14, p0 = tie[0] & 16383, e1 = tie[1] >> 14, p1 = tie[1] & 16383;
            const float w0 = tiw[0], w1 = tiw[1];
            const bf16* y0 = yk + (size_t)(rb[e0] + p0) * DM; const bf16* y1 = yk + (size_t)(rb[e1] + p1) * DM;
            const float* gf = mod + ((size_t)(l - 1) * 2 + b) * 6 * DM + 5 * DM;
#pragma unroll
            for (int j = 0; j < NJV; ++j) { const int cidx = 4 * lane + 256 * j; u32x2 q0 = *(const u32x2*)(y0 + cidx), q1 = *(const u32x2*)(y1 + cidx);
                f32x4 g = *(const f32x4*)(gf + cidx);
                v[j][0] += g[0] * (w0 * bf2f(q0[0] & 0xffff) + w1 * bf2f(q1[0] & 0xffff));
                v[j][1] += g[1] * (w0 * bf2f(q0[0] >> 16) + w1 * bf2f(q1[0] >> 16));
                v[j][2] += g[2] * (w0 * bf2f(q0[1] & 0xffff) + w1 * bf2f(q1[1] & 0xffff));
                v[j][3] += g[3] * (w0 * bf2f(q0[1] >> 16) + w1 * bf2f(q1[1] >> 16)); }
        }
#pragma unroll
        for (int j = 0; j < NJV; ++j) *(f32x4*)(outp(a) + (size_t)row * DM + 4 * lane + 256 * j) = v[j];
        if (l == DEPTH) continue;
        float ss = 0.f;
#pragma unroll
        for (int j = 0; j < NJV; ++j) ss += v[j][0] * v[j][0] + v[j][1] * v[j][1] + v[j][2] * v[j][2] + v[j][3] * v[j][3];
#pragma unroll
        for (int o = 1; o < 64; o <<= 1) ss += shflx(ss, o);
        const float rs = frsq(ss * (1.0f / DM) + EPS);
        const float* mm = mod + ((size_t)l * 2 + b) * 6 * DM; const float* nm = INP(a, I_NMIX) + (size_t)l * DM;
        bf16* hb = (bf16*)(ws + WS_H) + (size_t)row * DM;
#pragma unroll
        for (int j = 0; j < NJV; ++j) { const int cidx = 4 * lane + 256 * j; f32x4 g = *(const f32x4*)(nm + cidx), sh = *(const f32x4*)(mm + cidx), sc = *(const f32x4*)(mm + DM + cidx), o;
#pragma unroll
            for (int r = 0; r < 4; ++r) o[r] = v[j][r] * rs * g[r] * (1.0f + sc[r]) + sh[r];
            st_bf4(hb + cidx, o); }
    }
}

DEV void route_phase(const Args& a, unsigned char* smem, int l) {
    unsigned char* ws = wsp(a); const int tid = TID;
    float* W = (float*)smem;
    int* lcnt = (int*)(smem + DM * 36 * 4); int* lbase = lcnt + 32; int* tinfo = lbase + 32;
    SYNC();
    { const f32x4* wg4 = (const f32x4*)(INP(a, I_WG) + (size_t)l * DM * 4); const f32x4* we4 = (const f32x4*)(INP(a, I_WE) + (size_t)l * DM * 32);
      for (int i = tid; i < DM; i += NT) *(f32x4*)(W + i * 36) = wg4[i];
#pragma unroll 4
      for (int i = tid; i < DM * 8; i += NT) *(f32x4*)(W + (i >> 3) * 36 + 4 + 4 * (i & 7)) = we4[i]; }
    if (tid < 32) lcnt[tid] = 0;
    SYNC();
    const float* mod = (const float*)(ws + WS_MOD); const float* nf = INP(a, I_NFFN) + (size_t)l * DM;
    int* cnt = (int*)(ws + WS_CNT) + l * 32 * 64;
    constexpr int NI = DM / 32;
    for (int pass0 = BID; pass0 < T / 16; pass0 += 4 * NBLK) {
#pragma unroll 1
        for (int pi = 0; pi < 4; ++pi) {
            const int pass = pass0 + pi * NBLK; if (pass >= T / 16) break;
            const int tok = pass * 16 + (tid >> 5), part = tid & 31, b = tok / SEQ;
            const float* xr = outp(a) + (size_t)tok * DM; float xv[NI]; float ss = 0.f;
#pragma unroll
            for (int i = 0; i < NI; ++i) { xv[i] = xr[part + 32 * i]; ss += xv[i] * xv[i]; }
#pragma unroll
            for (int o = 1; o < 32; o <<= 1) ss += shflx(ss, o);
            const float rs = frsq(ss * (1.0f / DM) + EPS);
            const float* mm = mod + ((size_t)l * 2 + b) * 6 * DM; bf16* hb = (bf16*)(ws + WS_H) + (size_t)tok * DM;
            float acc[36];
#pragma unroll
            for (int n = 0; n < 36; ++n) acc[n] = 0.f;
            { float av[NI], cv[NI];
#pragma unroll
              for (int i = 0; i < NI; ++i) { const int k = part + 32 * i; av[i] = nf[k] * (1.0f + mm[4 * DM + k]); cv[i] = mm[3 * DM + k]; }
#pragma unroll
              for (int i = 0; i < NI; ++i) { xv[i] = xv[i] * rs * av[i] + cv[i]; hb[part + 32 * i] = (bf16)f2bf(xv[i]); } }
#pragma unroll 4
            for (int i = 0; i < NI; ++i) { const int k = part + 32 * i; const float hn = xv[i];
                const f32x4* wr = (const f32x4*)(W + k * 36);
#pragma unroll
                for (int n4 = 0; n4 < 9; ++n4) { const f32x4 wv = wr[n4];
#pragma unroll
                    for (int r = 0; r < 4; ++r) acc[4 * n4 + r] += hn * wv[r]; } }
#pragma unroll
            for (int n = 0; n < 36; ++n) {
#pragma unroll
                for (int o = 1; o < 32; o <<= 1) acc[n] += shflx(acc[n], o); }
            if (part == 0) {
                int gs = 0; float gm = acc[0];
#pragma unroll
                for (int g = 1; g < 4; ++g) if (acc[g] > gm) { gm = acc[g]; gs = g; }
                float den = 0.f;
#pragma unroll
                for (int g = 0; g < 4; ++g) den += fexp2((acc[g] - gm) * LOG2E);
                const float ggate = 1.0f / den;
                float el[8];
#pragma unroll
                for (int j = 0; j < 8; ++j) { el[j] = acc[4 + j];
#pragma unroll
                    for (int g = 1; g < 4; ++g) if (gs == g) el[j] = acc[4 + 8 * g + j]; }
                int ia = 0; float va = el[0];
#pragma unroll
                for (int j = 1; j < 8; ++j) if (el[j] > va) { va = el[j]; ia = j; }
                int ib = -1; float vb = -3e38f;
#pragma unroll
                for (int j = 0; j < 8; ++j) if (j != ia && el[j] > vb) { vb = el[j]; ib = j; }
                const float wa = 1.0f / (1.0f + fexp2((vb - va) * LOG2E)), wb = 1.0f - wa;
                const int e0 = gs * 8 + ia, e1 = gs * 8 + ib;
                const int p0 = atomic_add_i(lcnt + e0, 1), p1 = atomic_add_i(lcnt + e1, 1);
                int* ti = tinfo + (pi * 16 + (tid >> 5)) * 4;
                ti[0] = (e0 << 14) | p0; ti[1] = (e1 << 14) | p1; ti[2] = __builtin_bit_cast(int, ggate * wa); ti[3] = __builtin_bit_cast(int, ggate * wb);
            }
        }
        SYNC();
        if (tid < 32) { const int n = lcnt[tid]; lbase[tid] = n > 0 ? atomic_add_i(cnt + tid * 64, n) : 0; lcnt[tid] = 0; }
        SYNC();
        if (tid < 64) { const int pi = tid >> 4, pass = pass0 + pi * NBLK;
            if (pass < T / 16) { const int tok = pass * 16 + (tid & 15); const int* ti = tinfo + tid * 4;
                const int e0 = ti[0] >> 14, e1 = ti[1] >> 14, p0 = lbase[e0] + (ti[0] & 16383), p1 = lbase[e1] + (ti[1] & 16383);
                int* list = (int*)(ws + WS_LIST); list[(size_t)e0 * T + p0] = tok; list[(size_t)e1 * T + p1] = tok;
                int* tie = (int*)(ws + WS_TIE) + (size_t)tok * 2; int* tiw = (int*)(ws + WS_TIW) + (size_t)tok * 2;
                tie[0] = (e0 << 14) | p0; tie[1] = (e1 << 14) | p1; tiw[0] = ti[2]; tiw[1] = ti[3]; } }
        SYNC();
    }
}

DEV int vbid() { const int g = NBLK; return (g % 8 == 0) ? (BID % 8) * (g / 8) + BID / 8 : BID; }
#ifdef EMU
#define PG8_LDS(p) (p)
#else
#define PG8_LDS(p) ((PG8_LAS unsigned char*)(p))
#endif
DEV void inproj_phase(const Args& a, unsigned char* smem, int li) {
    pg8::Gemm g{(const bf16*)(wsp(a) + WS_H), (const bf16*)(wsp(a) + WS_WIN) + (size_t)li * NIN8 * DM, T, NIN8, DM}; pg8::StaticOrder S; S.init(T, NIN8, NBLK, BID);
    EpiInProj8 E{&a, li};
    SYNC(); pg8::gemm_phase<EpiInProj8, pg8::StaticOrder, true, true>(PG8_LDS(smem), g, S, E); SYNC();
}
DEV void resid_gemm_phase(const Args& a, unsigned char* smem, const bf16* A, int K, const bf16* Bt, int l) {
    pg8::Gemm g{A, Bt, T, DM, K}; pg8::StaticOrder S; S.init(T, DM, NBLK, BID);
    EpiResid8 E{outp(a), (const float*)(wsp(a) + WS_MOD) + (size_t)l * 2 * 6 * DM + 2 * DM};
    SYNC(); pg8::gemm_phase<EpiResid8, pg8::StaticOrder, true, true>(PG8_LDS(smem), g, S, E); SYNC();
}
DEV void pw1_phase(const Args& a, unsigned char* smem, int li) {
    pg8::Gemm g{(const bf16*)(wsp(a) + WS_H), (const bf16*)(wsp(a) + WS_PW1) + (size_t)li * 2 * DM * DM, T, 2 * DM, DM}; pg8::StaticOrder S; S.init(T, 2 * DM, NBLK, BID);
    EpiGlu8 E{(bf16*)(wsp(a) + WS_GLU)};
    SYNC(); pg8::gemm_phase<EpiGlu8, pg8::StaticOrder, true, true>(PG8_LDS(smem), g, S, E); SYNC();
}
DEV void cmp_phase_items(const Args& a, unsigned char* smem, int li, int it) {
    constexpr int TMC = (NCP + 255) / 256;
    const int kv = it / (4 * TMC), bg = (it / TMC) % 4, tm = it % TMC;
    const bf16* src = (const bf16*)(wsp(a) + (kv ? WS_VCG : WS_KCG)) + (size_t)bg * SEQ * 64;
    struct AF { const bf16* base; int m0; MDEV unsigned off(int r) const { int n = m0 + r; if (n > NCMP - 1) n = NCMP - 1; return (unsigned)n * 1024u; } } af{src, tm * 256};
    EpiCmp E{&a, kv, bg, tm * 256, li};
    BClamp64 bf{INP(a, kv ? I_CWV : I_CWK) + (size_t)li * 2048 * 64};
    gemm_tile2(smem, af, bf, 64, 2048, E);
}
DEV void moe_gemm_phase(const Args& a, unsigned char* smem, int l, int mode) {
    unsigned char* ws = wsp(a); const int* cnt = (const int*)(ws + WS_CNT) + l * 32 * 64;
    int* rb = (int*)(smem + GEMM2_LDS);
    moe_bases(cnt, rb);
    const int ntile = rb[32] >> 8;
    constexpr int TN1 = 2 * FF / 128, TN2 = DM / 128;
    const int TN = mode == 0 ? TN1 : TN2;
    const int* list = (const int*)(ws + WS_LIST);
    for (int it = vbid(); it < ntile * TN; it += NBLK) {
        const int rt = it / TN, tn = it % TN; int e = 0;
#pragma unroll 1
        for (int q = 1; q < 32; ++q) if ((rb[q] >> 8) <= rt) e = q;
        const int rloc = (rt << 8) - rb[e], ce = cnt[e * 64], nvalid = (ce - rloc) < 256 ? (ce - rloc) : 256;
        if (mode == 0) {
            struct AF { const bf16* base; const int* lst; int nv; MDEV unsigned off(int r) const { const int rr = r < nv ? r : nv - 1; return (unsigned)lst[rr] * (unsigned)DM; } }
                af{(const bf16*)(ws + WS_H), list + (size_t)e * T + rloc, nvalid};
            EpiGated<1> E{(bf16*)(ws + WS_ACT), (size_t)FF, rt << 8, tn * 128, nvalid};
            BInter bf{INP(a, I_W1) + (size_t)(l * 32 + e) * DM * FF, INP(a, I_W3) + (size_t)(l * 32 + e) * DM * FF, tn * 128};
            gemm_tile2(smem, af, bf, FF, DM, E);
        } else {
            ARows af{(const bf16*)(ws + WS_ACT) + (size_t)(rt << 8) * FF, (size_t)FF};
            EpiStoreBf E{(bf16*)(ws + WS_YK), (size_t)DM, rt << 8, tn * 128, nvalid};
            BPlain bf{INP(a, I_W2) + (size_t)(l * 32 + e) * FF * DM + tn * 128};
            gemm_tile2(smem, af, bf, DM, FF, E);
        }
    }
}

constexpr int AT_K = 0, AT_V = 2 * 64 * LDT * 2, AT_IMP = 2 * AT_V, AT_SEL = AT_IMP + 8 * 8 * 128 * 4, AT_GSEL = AT_SEL + 8 * 8 * 4 * 4, AT_OUT = AT_GSEL + 8 * 2 * 4 * 4, AT_END = AT_OUT + 8 * 32 * 64 * 4;
#ifdef EMU
DEV float rexp2(float x) { return exp2f(x); }
DEV unsigned uni(unsigned x) { return x; }
#else
DEV float rexp2(float x) { return __builtin_amdgcn_exp2f(x); }
DEV unsigned uni(unsigned x) { return (unsigned)__builtin_amdgcn_readfirstlane((int)x); }
#endif
template <int MASK, bool WITH_PV, bool FULL, int GM>
DEV void attn_block(const bf16* Kp, const bf16* Vp, const bf16x8 (&qf)[2][2], int j, const int (&s)[2], const bool (&selbit)[2], float C2, int h, int c,
                    f32x4 (&O)[2][4], f32x4 (&Ol)[2], f32x4 (&pout)[2][2][2]) {
    f32x4 st[2][2][2];
#pragma unroll
    for (int sp = 0; sp < 2; ++sp)
#pragma unroll
        for (int u = 0; u < 2; ++u) { const int krow = 32 * sp + 8 * (c >> 2) + 4 * u + (c & 3);
#pragma unroll
            for (int G = 0; G < 2; ++G) { st[G][sp][u][0] = -C2; st[G][sp][u][1] = -C2; st[G][sp][u][2] = -C2; st[G][sp][u][3] = -C2; }
#pragma unroll
            for (int ks = 0; ks < 2; ++ks) { const bf16x8 kf = *(const bf16x8*)(Kp + krow * LDT + 32 * ks + 8 * h);
#pragma unroll
                for (int G = 0; G < 2; ++G) if (GM & (1 << G)) st[G][sp][u] = mfma16(kf, qf[G][ks], st[G][sp][u]); } }
#pragma unroll
    for (int G = 0; G < 2; ++G) if (GM & (1 << G))
#pragma unroll
        for (int sp = 0; sp < 2; ++sp)
#pragma unroll
            for (int u = 0; u < 2; ++u)
#pragma unroll
                for (int r = 0; r < 4; ++r) { bool ok = selbit[G];
                    if (!FULL) { const int key = 64 * j + 32 * sp + 8 * h + 4 * u + r;
                        if (MASK == 0) ok = 16 * key + 31 <= s[G]; else if (MASK == 1) ok = selbit[G] && key <= s[G]; else ok = key <= s[G] && key > s[G] - 512; }
                    pout[G][sp][u][r] = ok ? rexp2(st[G][sp][u][r]) : 0.f; }
    if (WITH_PV) {
        bf16x8 pb[2][2], ones;
#pragma unroll
        for (int q = 0; q < 8; ++q) ones[q] = (short)0x3F80;
#pragma unroll
        for (int G = 0; G < 2; ++G) if (GM & (1 << G))
#pragma unroll
            for (int sp = 0; sp < 2; ++sp) { pb[G][sp] = pack8(pout[G][sp][0], pout[G][sp][1]); Ol[G] = mfma16(ones, pb[G][sp], Ol[G]); }
#pragma unroll
        for (int et = 0; et < 4; ++et)
#pragma unroll
            for (int sp = 0; sp < 2; ++sp) { const bf16x8 vf = *(const bf16x8*)(Vp + (16 * et + c) * LDT + 32 * sp + 8 * h);
#pragma unroll
                for (int G = 0; G < 2; ++G) if (GM & (1 << G)) O[G][et] = mfma16(vf, pb[G][sp], O[G][et]); }
    }
}

struct ImpState { float invl[2]; float carry[2]; float* imps; int tl, hd, l, s0, qblk; };
template <int MODE>
DEV void attn_branch(bf16* Kl, bf16* Vl, const bf16* kbase, int kstride, const bf16* vbase, int vstride, int jlo, int jhi,
                     const bf16x8 (&qf)[2][2], const int (&s)[2], const unsigned* selm, const unsigned* gselm, float C2, int h, int c, int srow, int scol,
                     f32x4 (&O)[2][4], f32x4 (&Ol)[2], ImpState& im) {
    constexpr bool PV = MODE != 1; constexpr int MASK = MODE <= 1 ? 0 : MODE - 1;
    bf16x8 rk[3], rv[3]; f32x4 pt[2][2][2];
    { const bf16x8 k0 = *(const bf16x8*)(kbase + (size_t)jlo * kstride); *(bf16x8*)(Kl + srow * LDT + scol) = k0;
      if (PV) { const bf16x8 v0 = *(const bf16x8*)(vbase + (size_t)jlo * vstride); *(bf16x8*)(Vl + srow * LDT + scol) = v0; } }
#pragma unroll
    for (int u = 0; u < 3; ++u) { int jj = jlo + 1 + u; if (jj > jhi) jj = jhi; rk[(1 + u) % 3] = *(const bf16x8*)(kbase + (size_t)jj * kstride); if (PV) rv[(1 + u) % 3] = *(const bf16x8*)(vbase + (size_t)jj * vstride); }
    SYNC();
    for (int jb = jlo; jb <= jhi; jb += 3) {
#pragma unroll
        for (int u = 0; u < 3; ++u) { const int j = jb + u;
            if (j <= jhi) {
                const int cur = (j - jlo) & 1;
                bool sb[2] = {true, true}; unsigned gm = 3u;
                if (MODE == 2) { gm = 0u;
#pragma unroll
                    for (int G = 0; G < 2; ++G) { const unsigned wq = uni(gselm[G * 4 + (j >> 5)]), mq = selm[(G * 4 + im.tl) * 4 + (j >> 5)];
                        gm |= ((wq >> (j & 31)) & 1u) << G; sb[G] = (mq >> (j & 31)) & 1u; } }
                bool full;
                if (MODE <= 1) full = 1024 * j + 1039 <= im.s0; else if (MODE == 2) full = j < im.qblk; else full = (j < im.qblk) && (64 * j > im.s0 + 63 - 512);
                const bf16* Kc = Kl + cur * 64 * LDT; const bf16* Vc = Vl + cur * 64 * LDT;
                if (MODE == 2) {
                    if (full) { if (gm == 3u) attn_block<MASK, PV, true, 3>(Kc, Vc, qf, j, s, sb, C2, h, c, O, Ol, pt); else if (gm == 1u) attn_block<MASK, PV, true, 1>(Kc, Vc, qf, j, s, sb, C2, h, c, O, Ol, pt); else if (gm == 2u) attn_block<MASK, PV, true, 2>(Kc, Vc, qf, j, s, sb, C2, h, c, O, Ol, pt); }
                    else { if (gm == 3u) attn_block<MASK, PV, false, 3>(Kc, Vc, qf, j, s, sb, C2, h, c, O, Ol, pt); else if (gm == 1u) attn_block<MASK, PV, false, 1>(Kc, Vc, qf, j, s, sb, C2, h, c, O, Ol, pt); else if (gm == 2u) attn_block<MASK, PV, false, 2>(Kc, Vc, qf, j, s, sb, C2, h, c, O, Ol, pt); }
                } else { if (full) attn_block<MASK, PV, true, 3>(Kc, Vc, qf, j, s, sb, C2, h, c, O, Ol, pt); else attn_block<MASK, PV, false, 3>(Kc, Vc, qf, j, s, sb, C2, h, c, O, Ol, pt); }
                if (MODE == 1) {
#pragma unroll
                    for (int G = 0; G < 2; ++G) {
#pragma unroll
                        for (int sp = 0; sp < 2; ++sp)
#pragma unroll
                            for (int uu = 0; uu < 2; ++uu)
#pragma unroll
                                for (int r = 0; r < 4; ++r) { float p = pt[G][sp][uu][r] * im.invl[G]; p += shflx(p, 1); p += shflx(p, 2); pt[G][sp][uu][r] = p; }
                        const float r0 = shfl(pt[G][0][1][3], (im.l - 16) & 63), r1 = shfl(pt[G][1][1][3], (im.l - 16) & 63);
#pragma unroll
                        for (int sp = 0; sp < 2; ++sp)
#pragma unroll
                            for (int uu = 0; uu < 2; ++uu) { const int m = 16 * j + 8 * sp + 2 * h + uu;
                                float prev; if (uu == 1) prev = pt[G][sp][0][3]; else if (h > 0) prev = sp == 0 ? r0 : r1; else prev = sp == 0 ? im.carry[G] : r0;
                                const float val = 2.0f * (pt[G][sp][uu][0] + pt[G][sp][uu][1] + pt[G][sp][uu][2]) + pt[G][sp][uu][3] + prev;
                                if (im.hd == 0 && m < 128) im.imps[(G * 4 + im.tl) * 128 + m] = val; }
                        im.carry[G] = r1;
                    }
                }
                if (j + 1 <= jhi) {
                    *(bf16x8*)(Kl + (cur ^ 1) * 64 * LDT + srow * LDT + scol) = rk[(u + 1) % 3]; if (PV) *(bf16x8*)(Vl + (cur ^ 1) * 64 * LDT + srow * LDT + scol) = rv[(u + 1) % 3];
                    int jj = j + 4; if (jj > jhi) jj = jhi;
                    rk[(u + 1) % 3] = *(const bf16x8*)(kbase + (size_t)jj * kstride); if (PV) rv[(u + 1) % 3] = *(const bf16x8*)(vbase + (size_t)jj * vstride);
                }
                SYNC();
            }
        }
    }
}

DEV void attn_task(const Args& a, unsigned char* smem, int li, int item) {
    unsigned char* ws = wsp(a); const int tid = TID, w = tid >> 6, l = tid & 63, h = l >> 4, c = l & 15, tl = c >> 2, hd = c & 3;
    const int bg = item & 3, b = bg >> 1, g = bg & 1, tq = (SEQ / 64 - 1) - (item >> 2), s0 = tq * 64, qblk = tq;
    int s[2], row[2];
#pragma unroll
    for (int G = 0; G < 2; ++G) { s[G] = s0 + 8 * w + 4 * G + tl; row[G] = b * SEQ + s[G]; }
    bf16* Kl = (bf16*)(smem + AT_K); bf16* Vl = (bf16*)(smem + AT_V); float* imps = (float*)(smem + AT_IMP) + w * 1024; unsigned* selm = (unsigned*)(smem + AT_SEL) + w * 32;
    bf16x8 qf[2][2]; float gatec[2], gates[2], gatew[2];
#pragma unroll
    for (int G = 0; G < 2; ++G) { const bf16* qp = (const bf16*)(ws + WS_QN) + (size_t)row[G] * 512 + (g * 4 + hd) * 64 + 8 * h; qf[G][0] = *(const bf16x8*)qp; qf[G][1] = *(const bf16x8*)(qp + 32);
        const float* gp = (const float*)(ws + WS_GATE) + (size_t)row[G] * 24 + (g * 4 + hd) * 3; gatec[G] = gp[0]; gates[G] = gp[1]; gatew[G] = gp[2]; }
    const float* cs = (const float*)(ws + WS_CS) + li * 4;
    const int srow = tid >> 3, scol = (tid & 7) * 8;
    for (int i = l; i < 1024; i += 64) imps[i] = 0.f;
    SYNC();
    unsigned* gselm = (unsigned*)(smem + AT_GSEL) + w * 8; float* outl = (float*)(smem + AT_OUT) + w * 2048 + l;
    ImpState im{{0.f, 0.f}, {0.f, 0.f}, imps, tl, hd, l, s0, qblk};
    {
        const int ncv = s0 / 16 + 3, ncb0 = (ncv + 63) >> 6, ncb = ncb0 > NCP / 64 ? NCP / 64 : ncb0;
        const bf16* kcb = (const bf16*)(ws + WS_KC) + (size_t)bg * NCP * 64 + srow * 64 + scol;
        const bf16* vcb = (const bf16*)(ws + WS_VCT) + (size_t)bg * 64 * NCP + (size_t)srow * NCP + scol;
        f32x4 O[2][4], Ol[2] = {f4zero(), f4zero()};
#pragma unroll
        for (int G = 0; G < 2; ++G)
#pragma unroll
            for (int et = 0; et < 4; ++et) O[G][et] = f4zero();
        attn_branch<0>(Kl, Vl, kcb, 4096, vcb, 64, 0, ncb - 1, qf, s, selm, gselm, cs[0], h, c, srow, scol, O, Ol, im);
#pragma unroll
        for (int G = 0; G < 2; ++G) { const float lsum = Ol[G][0]; im.invl[G] = lsum > 0.f ? 1.0f / lsum : 0.f;
#pragma unroll
            for (int et = 0; et < 4; ++et)
#pragma unroll
                for (int r = 0; r < 4; ++r) outl[((G * 4 + et) * 4 + r) * 64] = gatec[G] * im.invl[G] * O[G][et][r]; }
        f32x4 ld[2] = {f4zero(), f4zero()};
        attn_branch<1>(Kl, Vl, kcb, 4096, vcb, 64, 0, ncb - 1, qf, s, selm, gselm, cs[0], h, c, srow, scol, O, ld, im);
    }
    WSYNC();
#pragma unroll 1
    for (int G = 0; G < 2; ++G) {
        const int tk = l >> 4, i = l & 15; float vals[8];
#pragma unroll
        for (int mm = 0; mm < 8; ++mm) { const int jj = i + 16 * mm; vals[mm] = jj > qblk ? NEGV : ((jj == 0 || jj == qblk || jj == qblk - 1) ? FORCEV : imps[(G * 4 + tk) * 128 + jj]); }
        unsigned mk[4] = {0u, 0u, 0u, 0u};
#pragma unroll 1
        for (int rnd = 0; rnd < 16; ++rnd) {
            float best = vals[0]; int bj = i;
#pragma unroll
            for (int mm = 1; mm < 8; ++mm) if (vals[mm] > best) { best = vals[mm]; bj = i + 16 * mm; }
#pragma unroll
            for (int o = 1; o < 16; o <<= 1) { const float ov = shflx(best, o); const int oj = shflxi(bj, o); if (ov > best || (ov == best && oj < bj)) { best = ov; bj = oj; } }
            if (best > NEGV * 0.5f) {
#pragma unroll
                for (int q = 0; q < 4; ++q) if ((bj >> 5) == q) mk[q] |= 1u << (bj & 31); }
            if ((bj & 15) == i) {
#pragma unroll
                for (int mm = 0; mm < 8; ++mm) if ((bj >> 4) == mm) vals[mm] = -3e38f; }
        }
        if (i == 0) {
#pragma unroll
            for (int q = 0; q < 4; ++q) selm[(G * 4 + tk) * 4 + q] = mk[q]; }
    }
    WSYNC();
    if (l < 8) { const int G = l >> 2, q = l & 3; gselm[l] = selm[(G * 4 + 0) * 4 + q] | selm[(G * 4 + 1) * 4 + q] | selm[(G * 4 + 2) * 4 + q] | selm[(G * 4 + 3) * 4 + q]; }
    WSYNC();
#pragma unroll
    for (int br = 0; br < 2; ++br) {
        const bf16* kb = (const bf16*)(ws + (br == 0 ? WS_KS : WS_KW)) + (size_t)bg * SEQ * 64 + tid * 8; const bf16* vb = (const bf16*)(ws + (br == 0 ? WS_VST : WS_VWT)) + (size_t)bg * NCH * 4096 + tid * 8;
        f32x4 O[2][4], Ol[2] = {f4zero(), f4zero()};
#pragma unroll
        for (int G = 0; G < 2; ++G)
#pragma unroll
            for (int et = 0; et < 4; ++et) O[G][et] = f4zero();
        if (br == 0) attn_branch<2>(Kl, Vl, kb, 4096, vb, 4096, 0, qblk, qf, s, selm, gselm, cs[1], h, c, srow, scol, O, Ol, im);
        else attn_branch<3>(Kl, Vl, kb, 4096, vb, 4096, s0 >= 511 ? (s0 - 511) >> 6 : 0, qblk, qf, s, selm, gselm, cs[2], h, c, srow, scol, O, Ol, im);
#pragma unroll
        for (int G = 0; G < 2; ++G) { const float lsum = Ol[G][0]; const float sc = (br == 0 ? gates[G] : gatew[G]) * (lsum > 0.f ? 1.0f / lsum : 0.f);
#pragma unroll
            for (int et = 0; et < 4; ++et)
#pragma unroll
                for (int r = 0; r < 4; ++r) outl[((G * 4 + et) * 4 + r) * 64] += sc * O[G][et][r]; }
    }
#pragma unroll
    for (int G = 0; G < 2; ++G) { bf16* dst = (bf16*)(ws + WS_CAT) + (size_t)row[G] * 1024 + (g * 4 + hd) * 64 + 4 * h;
#pragma unroll
        for (int et = 0; et < 4; ++et) { f32x4 o;
#pragma unroll
            for (int r = 0; r < 4; ++r) o[r] = outl[((G * 4 + et) * 4 + r) * 64];
            st_bf4(dst + 16 * et, o); } }
}

constexpr int LDH = 136;
DEV void hg_cumsum(const float* fsrc  , float* segs  , int d, int seg, float (&f)[16], float (&bc)[16], float& bend, float& bmid) {
    float run = 0.f;
#pragma unroll
    for (int i = 0; i < 16; ++i) { f[i] = fsrc[(size_t)(16 * seg + i) * 128 + d]; run += log2f(f[i]); bc[i] = run; }
    SYNC();
    segs[seg * 128 + d] = run;
    SYNC();
    const float s0 = segs[d], s1 = segs[128 + d], s2 = segs[256 + d], s3 = segs[384 + d];
    const float off = seg == 0 ? 0.f : (seg == 1 ? s0 : (seg == 2 ? s0 + s1 : s0 + s1 + s2));
#pragma unroll
    for (int i = 0; i < 16; ++i) bc[i] += off;
    bend = s0 + s1 + s2 + s3; bmid = s0 + s1;
}
DEV void hg_write16(bf16* dstrow  , const float (&v)[16]) {
    u32x4 w0, w1;
#pragma unroll
    for (int q = 0; q < 4; ++q) { w0[q] = pk2(v[2 * q], v[2 * q + 1]); w1[q] = pk2(v[8 + 2 * q], v[8 + 2 * q + 1]); }
    *(u32x4*)dstrow = w0; *(u32x4*)(dstrow + 8) = w1;
}
DEV void hg_h1_task(const Args& a, unsigned char* smem, int task) {
    unsigned char* ws = wsp(a); const int tid = TID, w = tid >> 6, l = tid & 63, h = l >> 4, c = l & 15, d = tid & 127, seg = tid >> 7;
    const int bh = task / NCH, ch = task % NCH;
    bf16* kT = (bf16*)smem; bf16* vT = kT + 128 * LDT; float* segs = (float*)(vT + 128 * LDT);
    const size_t tokb = (size_t)bh * SEQ + ch * 64;
    float f[16], bc[16], bend, bmid;
    hg_cumsum((const float*)(ws + WS_HF) + tokb * 128, segs, d, seg, f, bc, bend, bmid);
    float kv[16];
#pragma unroll
    for (int i = 0; i < 16; ++i) kv[i] = (1.0f - f[i]) * fexp2(bend - bc[i]);
    hg_write16(kT + d * LDT + 16 * seg, kv);
    const bf16* vs = (const bf16*)(ws + WS_HV) + tokb * 128;
#pragma unroll
    for (int i = 0; i < 16; ++i) kv[i] = bf2f(vs[(size_t)(16 * seg + i) * 128 + d]);
    hg_write16(vT + d * LDT + 16 * seg, kv);
    if (seg == 0) ((float*)(ws + WS_GD))[((size_t)bh * NCH + ch) * 128 + d] = fexp2(bend);
    SYNC();
    f32x4 acc[8];
#pragma unroll
    for (int et = 0; et < 8; ++et) acc[et] = f4zero();
#pragma unroll
    for (int ks = 0; ks < 2; ++ks) { const bf16x8 fa = *(const bf16x8*)(kT + (16 * w + c) * LDT + 32 * ks + 8 * h);
#pragma unroll
        for (int et = 0; et < 8; ++et) acc[et] = mfma16(fa, *(const bf16x8*)(vT + (16 * et + c) * LDT + 32 * ks + 8 * h), acc[et]); }
    float* ut = (float*)(ws + WS_UT) + ((size_t)bh * NCH + ch) * 16384;
#pragma unroll
    for (int et = 0; et < 8; ++et) *(f32x4*)(ut + (size_t)(16 * et + c) * 128 + 16 * w + 4 * h) = acc[et];
    SYNC();
}
DEV void hg_scan_task(const Args& a, int sc) {
    unsigned char* ws = wsp(a); const int bh = sc >> 3, q = (sc & 7) * 512 + TID, e = q >> 5, d0 = (q & 31) * 4;
    const float* ut = (const float*)(ws + WS_UT) + (size_t)bh * NCH * 16384 + (size_t)e * 128 + d0;
    const float* gd = (const float*)(ws + WS_GD) + (size_t)bh * NCH * 128 + d0;
    bf16* st = (bf16*)(ws + WS_ST) + (size_t)bh * NCH * 16384 + (size_t)e * 128 + d0;
    f32x4 S = f4zero();
#pragma unroll 4
    for (int ch = 0; ch < NCH; ++ch) { st_bf4(st + (size_t)ch * 16384, S);
        const f32x4 g = *(const f32x4*)(gd + (size_t)ch * 128), u = *(const f32x4*)(ut + (size_t)ch * 16384);
#pragma unroll
        for (int r = 0; r < 4; ++r) S[r] = g[r] * S[r] + u[r]; }
}
DEV void hg_h3_task(const Args& a, unsigned char* smem, int li, int task) {
    unsigned char* ws = wsp(a); const int tid = TID, w = tid >> 6, l = tid & 63, h = l >> 4, c = l & 15, d = tid & 127, seg = tid >> 7;
    const int bh = task / NCH, ch = task % NCH, b = bh >> 2, hh = bh & 3;
    bf16* At = (bf16*)smem; bf16* Bt = At + 64 * LDH; bf16* Qt = Bt + 64 * LDH; bf16* vT = Qt + 64 * LDH; float* segs = (float*)(vT + 128 * LDT); float* part = segs + 512;
    const size_t tokb = (size_t)bh * SEQ + ch * 64;
    float f[16], bc[16], bend, bmid;
    hg_cumsum((const float*)(ws + WS_HF) + tokb * 128, segs, d, seg, f, bc, bend, bmid);
    const bf16* qs = (const bf16*)(ws + WS_HQ) + tokb * 128; const bf16* vs = (const bf16*)(ws + WS_HV) + tokb * 128;
    float vv[16];
#pragma unroll
    for (int i = 0; i < 16; ++i) { const int t = 16 * seg + i; const float q = bf2f(qs[(size_t)t * 128 + d]);
        At[t * LDH + d] = (bf16)f2bf(q * fexp2(bc[i] - bmid)); Bt[t * LDH + d] = (bf16)f2bf((1.0f - f[i]) * fexp2(bmid - bc[i])); Qt[t * LDH + d] = (bf16)f2bf(q * fexp2(bc[i]));
        vv[i] = bf2f(vs[(size_t)t * 128 + d]); }
    hg_write16(vT + d * LDT + 16 * seg, vv);
    SYNC();
    const int tt = w & 3, eh = w >> 2;
    f32x4 O[4];
#pragma unroll
    for (int et = 0; et < 4; ++et) O[et] = f4zero();
#pragma unroll
    for (int sp = 0; sp < 2; ++sp) {
        if (32 * sp > 16 * tt + 15) continue;
        f32x4 st[2];
#pragma unroll
        for (int u = 0; u < 2; ++u) { st[u] = f4zero(); const int krow = 32 * sp + 8 * (c >> 2) + 4 * u + (c & 3);
#pragma unroll
            for (int ks = 0; ks < 4; ++ks) st[u] = mfma16(*(const bf16x8*)(Bt + krow * LDH + 32 * ks + 8 * h), *(const bf16x8*)(At + (16 * tt + c) * LDH + 32 * ks + 8 * h), st[u]);
#pragma unroll
            for (int r = 0; r < 4; ++r) { const int sk = 32 * sp + 8 * h + 4 * u + r; if (sk > 16 * tt + c) st[u][r] = 0.f; } }
        const bf16x8 pb = pack8(st[0], st[1]);
#pragma unroll
        for (int et = 0; et < 4; ++et) O[et] = mfma16(*(const bf16x8*)(vT + (64 * eh + 16 * et + c) * LDT + 32 * sp + 8 * h), pb, O[et]);
    }
    const bf16* stp = (const bf16*)(ws + WS_ST) + ((size_t)bh * NCH + ch) * 16384;
#pragma unroll
    for (int ks = 0; ks < 4; ++ks) { const bf16x8 fq = *(const bf16x8*)(Qt + (16 * tt + c) * LDH + 32 * ks + 8 * h);
#pragma unroll
        for (int et = 0; et < 4; ++et) O[et] = mfma16(*(const bf16x8*)(stp + (size_t)(64 * eh + 16 * et + c) * 128 + 32 * ks + 8 * h), fq, O[et]); }
    float ss = 0.f;
#pragma unroll
    for (int et = 0; et < 4; ++et)
#pragma unroll
        for (int r = 0; r < 4; ++r) ss += O[et][r] * O[et][r];
    ss += shflx(ss, 16); ss += shflx(ss, 32);
    if (h == 0) part[eh * 64 + 16 * tt + c] = ss;
    SYNC();
    const float rs = frsq((part[16 * tt + c] + part[64 + 16 * tt + c]) * (1.0f / 128.0f) + EPS);
    const int tok = b * SEQ + ch * 64 + 16 * tt + c;
    const float* og = INP(a, I_OG) + li * 128; const bf16* hg = (const bf16*)(ws + WS_HGS) + (size_t)tok * 512 + hh * 128;
    bf16* dst = (bf16*)(ws + WS_CAT) + (size_t)tok * 1024 + 512 + hh * 128;
#pragma unroll
    for (int et = 0; et < 4; ++et) { const int e = 64 * eh + 16 * et + 4 * h; f32x4 o;
#pragma unroll
        for (int r = 0; r < 4; ++r) o[r] = O[et][r] * rs * og[e + r] * bf2f(hg[e + r]);
        st_bf4(dst + e, o); }
    SYNC();
}

DEV void conv_task(const Args& a, unsigned char* smem, int li, int task) {
    unsigned char* ws = wsp(a); const int tid = TID, w = tid >> 6, lane = tid & 63;
    const bool act = tid < DM / 2; const int c0 = act ? 2 * tid : 0;
    const int t0 = task * 16, b = t0 / SEQ, s0 = t0 % SEQ;
    float* red = (float*)smem;
    const float* dw = INP(a, I_DW) + (size_t)li * 31 * DM + c0;
    float acc[16][2];
    const float b0 = INP(a, I_DWB)[li * DM + c0], b1 = INP(a, I_DWB)[li * DM + c0 + 1];
#pragma unroll
    for (int t = 0; t < 16; ++t) { acc[t][0] = b0; acc[t][1] = b1; }
    const bf16* glu = (const bf16*)(ws + WS_GLU) + (size_t)b * SEQ * DM + c0;
    unsigned uu[46];
    { const bf16* gp = glu + (size_t)(s0 - 30) * DM;
#pragma unroll
    for (int r = 0; r < 46; ++r) { const int si = s0 + r - 30; uu[r] = si >= 0 ? *(const unsigned*)gp : 0u; gp += DM; OPAQUE(gp); } }
    const float* dwp = dw;
#pragma unroll
    for (int j = 0; j < 31; ++j) { const float w0 = dwp[0], w1 = dwp[1]; dwp += DM; OPAQUE(dwp);
#pragma unroll
        for (int t = 0; t < 16; ++t) { const unsigned q = uu[t + j]; acc[t][0] += w0 * bf2f(q & 0xffff); acc[t][1] += w1 * bf2f(q >> 16); } }
    float mean[16], rstd[16];
    SYNC();
#pragma unroll
    for (int t = 0; t < 16; ++t) { float s = act ? acc[t][0] + acc[t][1] : 0.f;
#pragma unroll
        for (int o = 1; o < 64; o <<= 1) s += shflx(s, o);
        if (lane == 0) red[w * 16 + t] = s; }
    SYNC();
#pragma unroll
    for (int t = 0; t < 16; ++t) { float s = 0.f;
#pragma unroll
        for (int q = 0; q < 8; ++q) s += red[q * 16 + t];
        mean[t] = s * (1.0f / DM); }
    SYNC();
#pragma unroll
    for (int t = 0; t < 16; ++t) { const float d0 = acc[t][0] - mean[t], d1 = acc[t][1] - mean[t]; float s = act ? d0 * d0 + d1 * d1 : 0.f;
#pragma unroll
        for (int o = 1; o < 64; o <<= 1) s += shflx(s, o);
        if (lane == 0) red[w * 16 + t] = s; }
    SYNC();
#pragma unroll
    for (int t = 0; t < 16; ++t) { float s = 0.f;
#pragma unroll
        for (int q = 0; q < 8; ++q) s += red[q * 16 + t];
        rstd[t] = frsq(s * (1.0f / DM) + EPS); }
    if (act) {
        const float g0 = INP(a, I_LNG)[li * DM + c0], g1 = INP(a, I_LNG)[li * DM + c0 + 1], e0 = INP(a, I_LNB)[li * DM + c0], e1 = INP(a, I_LNB)[li * DM + c0 + 1];
        bf16* dst = (bf16*)(ws + WS_CAT) + (size_t)t0 * DM + c0;
#pragma unroll
        for (int t = 0; t < 16; ++t) { const float y0 = (acc[t][0] - mean[t]) * rstd[t] * g0 + e0, y1 = (acc[t][1] - mean[t]) * rstd[t] * g1 + e1;
            *(unsigned*)(dst + (size_t)t * DM) = pk2(siluf(y0), siluf(y1)); }
    }
}

constexpr int N_PHASES = 1 + 16 * (DEPTH / 2) + 1;
DEV void phase_decode(int ph, int& l, int& sub) {
    const int q = ph - 1, pair = q >> 4, r = q & 15;
    if (r < 9) { l = 2 * pair; sub = r; } else { l = 2 * pair + 1; const int rr = r - 9; sub = rr < 3 ? rr : rr + 2; }
}
constexpr int LDS_BYTES = 150 * 1024;

DEV void run_phase(const Args& a, unsigned char* smem, int ph) {
#ifndef ONLY
#define ONLY -1
#endif
#define EN(k) (ONLY < 0 || ONLY == (k))
    if (ph == 0) { if (EN(100)) p0_phase(a, smem); return; }
    if (ph == N_PHASES - 1) { if (EN(0)) norm_phase(a, smem, DEPTH); return; }
    int l, sub; phase_decode(ph, l, sub); const int li = l >> 1; const bool even = (l & 1) == 0;
    unsigned char* ws = wsp(a);
    switch (sub) {
    case 0: if (EN(0)) norm_phase(a, smem, l); break;
    case 1: if (even) { if (EN(1)) inproj_phase(a, smem, li); } else { if (EN(11)) pw1_phase(a, smem, li); } break;
    case 2:
        if (even) { constexpr int NCI = 8 * ((NCP + 255) / 256); constexpr int NH1 = 8 * NCH;
            for (int it = BID; it < NCI + NH1; it += NBLK) { if (it < NCI) { if (EN(2)) cmp_phase_items(a, smem, li, it); } else { if (EN(12)) hg_h1_task(a, smem, it - NCI); } } }
        else { for (int it = BID; it < T / 16; it += NBLK) if (EN(13)) conv_task(a, smem, li, it); }
        break;
    case 3:
        if (even) { constexpr int NA = 4 * (SEQ / 64); const int G = NBLK;
            for (int r = 0; r * G < NA; ++r) { const int it = r * G + ((r & 1) ? (G - 1 - BID) : BID); if (it < NA) { if (EN(3)) attn_task(a, smem, li, it); } }
            for (int it = BID; it < 64; it += NBLK) if (EN(14)) hg_scan_task(a, it); }
        break;
    case 4: if (even) { for (int it = BID; it < 8 * NCH; it += NBLK) if (EN(4)) hg_h3_task(a, smem, li, it); } break;
    case 5:
        if (!EN(5)) break;
        if (even) resid_gemm_phase(a, smem, (const bf16*)(ws + WS_CAT), 1024, (const bf16*)(ws + WS_WOUT) + (size_t)li * DM * 1024, l);
        else resid_gemm_phase(a, smem, (const bf16*)(ws + WS_CAT), DM, (const bf16*)(ws + WS_PW2) + (size_t)li * DM * DM, l);
        break;
    case 6: if (EN(6)) route_phase(a, smem, l); break;
    case 7: if (EN(7)) moe_gemm_phase(a, smem, l, 0); break;
    case 8: if (EN(8)) moe_gemm_phase(a, smem, l, 1); break;
    }
}

#ifndef EMU
#define LAS __attribute__((address_space(3)))
#define XB_TMO      128
#define XB_XCNT(j)  (256  + 64 * (j))
#define XB_XSUB(j)  (1280 + 64 * (j))
#define XB_XGEN(j)  (2304 + 64 * (j))
#define XB_TOP      3328
#define XB_TOPGEN   3392
#define XCD_BAR_WORDS 3456
#define XB_SPIN_CAP (1u << 22)
__device__ __forceinline__ unsigned xb_ld(unsigned* p)              { return __hip_atomic_load(p, __ATOMIC_RELAXED, __HIP_MEMORY_SCOPE_AGENT); }
__device__ __forceinline__ unsigned xb_add(unsigned* p, unsigned v) { return __hip_atomic_fetch_add(p, v, __ATOMIC_RELAXED, __HIP_MEMORY_SCOPE_AGENT); }
__device__ __forceinline__ unsigned xb_xcc_id() { return (unsigned)__builtin_amdgcn_s_getreg((3 << 11) | 20) & 0xFu; }
#define XB_SPIN(cond, bar) do { unsigned _sp = 0; while (cond) { __builtin_amdgcn_s_sleep(1); \
    if ((++_sp & 255u) == 0u) { if (xb_ld(&(bar)[XB_TMO])) break; if (_sp > XB_SPIN_CAP) { atomicAdd(&(bar)[XB_TMO], 1u); break; } } } } while (0)
struct XcdBarrier { unsigned* bar; unsigned x; volatile LAS unsigned* st; };
__device__ __forceinline__ XcdBarrier xcd_barrier_post(unsigned* bar, volatile LAS unsigned* st) {
    XcdBarrier b; b.bar = bar; b.x = xb_xcc_id(); b.st = st;
    if (threadIdx.x == 0) (void)xb_add(&bar[XB_XCNT(b.x)], 1u);
    return b;
}
__device__ __forceinline__ void xcd_barrier_complete(unsigned* bar, unsigned x, unsigned& nloc, unsigned& nx) {
    const unsigned G = gridDim.x * gridDim.y * gridDim.z;
    unsigned sum, cnt, mine, sp = 0u;
    for (;;) {
        sum = 0u; cnt = 0u; mine = 0u;
#pragma unroll
        for (unsigned j = 0; j < 16; ++j) { const unsigned c = xb_ld(&bar[XB_XCNT(j)]); sum += c; cnt += (c > 0u) ? 1u : 0u; mine = (j == x) ? c : mine; }
        if (sum == G) break;
        __builtin_amdgcn_s_sleep(1);
        if ((++sp & 255u) == 0u) { if (xb_ld(&bar[XB_TMO])) break; if (sp > XB_SPIN_CAP) { atomicAdd(&bar[XB_TMO], 1u); break; } }
    }
    nloc = mine > 0u ? mine : 1u; nx = cnt > 0u ? cnt : 1u;
}
__device__ __forceinline__ void xcd_barrier(const XcdBarrier& b) {
    asm volatile("s_waitcnt vmcnt(0)" ::: "memory");
    __syncthreads();
    if (threadIdx.x == 0) {
        unsigned* bar = b.bar;
        __builtin_amdgcn_s_waitcnt(0);
        unsigned nloc = b.st[0], nx = b.st[1];
        if (nloc == 0u) { xcd_barrier_complete(bar, b.x, nloc, nx); b.st[0] = nloc; b.st[1] = nx; }
        const unsigned old = xb_add(&bar[XB_XSUB(b.x)], 1u);
        const unsigned gen = old / nloc;
        if (old + 1u == (gen + 1u) * nloc) {
            __builtin_amdgcn_fence(__ATOMIC_RELEASE, "agent");
            asm volatile("s_waitcnt vmcnt(0)" ::: "memory");
            const unsigned og = xb_add(&bar[XB_TOP], 1u);
            const unsigned tg = og / nx;
            if (og + 1u == (tg + 1u) * nx) xb_add(&bar[XB_TOPGEN], 1u);
            else XB_SPIN(xb_ld(&bar[XB_TOPGEN]) == tg, bar);
            __builtin_amdgcn_fence(__ATOMIC_ACQUIRE, "agent");
            xb_add(&bar[XB_XGEN(b.x)], 1u);
            asm volatile("s_waitcnt vmcnt(0)" ::: "memory");
        } else {
            XB_SPIN(xb_ld(&bar[XB_XGEN(b.x)]) == gen, bar);
            __builtin_amdgcn_fence(__ATOMIC_ACQUIRE, "agent");
            asm volatile("s_waitcnt vmcnt(0)" ::: "memory");
        }
    }
    __syncthreads();
}

__global__ void __launch_bounds__(NT, 2) mega(Args a) {
    extern __shared__ __attribute__((aligned(16))) unsigned char lds[];
    volatile LAS unsigned* st = (volatile LAS unsigned*)(LAS unsigned char*)(lds + LDS_BYTES - 16);
    if (threadIdx.x < 4) st[threadIdx.x] = 0u;
    __syncthreads();
    unsigned* barw = (unsigned*)(a.ws + WS_BAR);
    XcdBarrier bar = xcd_barrier_post(barw, st);
#pragma unroll 1
    for (int ph = 0; ph < N_PHASES; ++ph) {
        run_phase(a, lds, ph);
#ifdef DUP
        { int lyr = 0, sub = 100; if (ph > 0 && ph < N_PHASES - 1) phase_decode(ph, lyr, sub);
          if (sub == (DUP % 1000) && (ph == 0 || lyr == DUP / 1000) && ph < N_PHASES - 1) { xcd_barrier(bar); run_phase(a, lds, ph); } }
#endif
        if (ph + 1 < N_PHASES) xcd_barrier(bar);
    }
    if (xb_ld(&barw[XB_TMO]) != 0u) {
        const size_t gt = (size_t)blockIdx.x * NT + threadIdx.x, gs = (size_t)gridDim.x * NT;
        for (size_t i = gt; i < (size_t)T * DM; i += gs) a.out[i] = __builtin_nanf("");
    }
}

extern "C" void kernel_launch(void* const* d_in, const int* in_sizes, int n_in, void* d_out, int out_size,
                              void* d_ws, size_t ws_size, hipStream_t stream) {
    static int grid = 0;
    if (grid == 0) {
        int dev = 0, cus = 0;
        if (hipGetDevice(&dev) != hipSuccess || hipDeviceGetAttribute(&cus, hipDeviceAttributeMultiprocessorCount, dev) != hipSuccess) { grid = -1; return; }
        if (hipFuncSetAttribute((const void*)mega, hipFuncAttributeMaxDynamicSharedMemorySize, LDS_BYTES) != hipSuccess) { grid = -1; return; }
        (void)hipGetLastError();
        grid = cus;
        if (n_in != 26 || out_size != T * DM || ws_size < WS_END) { fprintf(stderr, "kernel_launch: unexpected sizes n_in %d out %d ws %zu (need %zu)\n", n_in, out_size, ws_size, (size_t)WS_END); grid = -1; return; }
    }
    if (grid < 0) return;
    (void)hipMemsetAsync((unsigned char*)d_ws + WS_BAR, 0, XCD_BAR_WORDS * 4, stream);
    Args a{};
    for (int i = 0; i < 26; ++i) a.in[i] = (const float*)d_in[i];
    a.out = (float*)d_out; a.ws = (unsigned char*)d_ws;
    hipLaunchKernelGGL(mega, dim3(grid), dim3(NT), LDS_BYTES, stream, a);
}
#endif
```

```cpp
#ifdef EMU
#include "emu.h"
#define DEV static inline
#define MDEV inline
#define OPAQUE(p)
#define OPAQUE2(a, b)
#define TID emu_tid()
#define BID (EB->bid)
#define NBLK (EB->nblk)
#define SYNC() emu_sync_block()
#define WSYNC() emu_sync_wave()
#define mfma16(a, b, c) emu_mfma16(a, b, c)
DEV float shflx(float v, int m) { return emu_shfl_f(v, (emu_tid() & 63) ^ m); }
DEV int shflxi(int v, int m) { return (int)emu_shfl_u((unsigned)v, (emu_tid() & 63) ^ m); }
DEV float shfl(float v, int s) { return emu_shfl_f(v, s); }
DEV int atomic_add_i(int* p, int v) { return __atomic_fetch_add(p, v, __ATOMIC_RELAXED); }
DEV float fexp2(float x) { return exp2f(x); }
DEV float frcp(float x) { return 1.0f / x; }
DEV float frsq(float x) { return 1.0f / sqrtf(x); }
typedef short s16x4 __attribute__((vector_size(8)));
static inline s16x4 emu_tr4(const unsigned short* p) {
    EmuWave& w = EB->wave[emu_tid() >> 6]; int l = emu_tid() & 63;
    const unsigned short** tab = (const unsigned short**)w.a;
    tab[l] = p; emu_sync_wave();
    s16x4 r; int g = l & 48, i = l & 15;
    for (int q = 0; q < 4; ++q) r[q] = (short)tab[g + 4 * q + (i >> 2)][i & 3];
    emu_sync_wave(); return r;
}
#define tr4(p) emu_tr4(p)
#else
#include <hip/hip_runtime.h>
#include <cstdio>
#include <cstdint>
typedef short bf16x8 __attribute__((ext_vector_type(8)));
typedef float f32x4 __attribute__((ext_vector_type(4)));
typedef unsigned u32x4 __attribute__((ext_vector_type(4)));
typedef unsigned u32x2 __attribute__((ext_vector_type(2)));
#define DEV __device__ __forceinline__
#define MDEV __device__ __forceinline__
#define OPAQUE(p) asm volatile("" : "+v"(p))
#define OPAQUE2(a, b) asm volatile("" : "+v"(a), "+v"(b))
DEV int tid_opaque() { int t = (int)threadIdx.x; asm volatile("" : "+v"(t)); return t; }
#define TID tid_opaque()
DEV int bid_opaque() { int b = (int)blockIdx.x; asm volatile("" : "+s"(b)); return b; }
#define BID bid_opaque()
#define NBLK ((int)gridDim.x)
#define SYNC() __syncthreads()
#define WSYNC() __builtin_amdgcn_wave_barrier()
#define mfma16(a, b, c) __builtin_amdgcn_mfma_f32_16x16x32_bf16(a, b, c, 0, 0, 0)
DEV float shflx(float v, int m) { return __shfl_xor(v, m); }
DEV int shflxi(int v, int m) { return __shfl_xor(v, m); }
DEV float shfl(float v, int s) { return __shfl(v, s); }
DEV int atomic_add_i(int* p, int v) { return atomicAdd(p, v); }
DEV float fexp2(float x) { return __builtin_amdgcn_exp2f(x); }
DEV float frcp(float x) { return __builtin_amdgcn_rcpf(x); }
DEV float frsq(float x) { return __builtin_amdgcn_rsqf(x); }
typedef short s16x4 __attribute__((ext_vector_type(4)));
#define tr4(p) __builtin_amdgcn_ds_read_tr16_b64_v4i16((__attribute__((address_space(3))) s16x4*)(p))
#endif

typedef unsigned short bf16;

#ifndef DM
#define DM 1024
#endif
#ifndef SEQ
#define SEQ 8192
#endif
#ifndef FF
#define FF 512
#endif
constexpr int NBATCH = 2, T = NBATCH * SEQ, DEPTH = 4;
constexpr int NIN = 3352, NINP = 3456, NIN8 = 3584;
constexpr int NT = 512;
constexpr int NCH = SEQ / 64;
constexpr int NCP = SEQ / 16;
constexpr int NCMP = NCP - 1;
constexpr int MOE_ROWS = 2 * T + 32 * 256;
constexpr float EPS = 1e-6f, NEGV = -1e30f, FORCEV = 1e4f, LOG2E = 1.4426950408889634f;

constexpr size_t al(size_t x) { return (x + 255) & ~(size_t)255; }
constexpr size_t WS_BAR = 0;
constexpr size_t WS_CNT = 16384;
constexpr size_t WS_MOD = WS_CNT + (size_t)DEPTH * 32 * 256;
constexpr size_t WS_LB = al(WS_MOD + (size_t)DEPTH * 2 * 6 * DM * 4);
constexpr size_t WS_CB = al(WS_LB + 2 * 512 * 4);
constexpr size_t WS_CS = al(WS_CB + 2 * 2 * 8 * 64 * 4);
constexpr size_t WS_WIN = al(WS_CS + 64);
constexpr size_t WS_WOUT = al(WS_WIN + (size_t)2 * NIN8 * DM * 2);
constexpr size_t WS_PW1 = al(WS_WOUT + (size_t)2 * DM * 1024 * 2);
constexpr size_t WS_PW2 = al(WS_PW1 + (size_t)2 * 2 * DM * DM * 2);
constexpr size_t WS_WC = al(WS_PW2 + (size_t)2 * DM * DM * 2);
constexpr size_t WS_W13 = al(WS_WC + (size_t)2 * 2 * 64 * 2048 * 2);
constexpr size_t WS_W2 = al(WS_W13 + 256);
constexpr size_t WS_H = al(WS_W2 + 256);
constexpr size_t WS_QN = al(WS_H + (size_t)T * DM * 2);
constexpr size_t WS_KCG = al(WS_QN + (size_t)T * 512 * 2);
constexpr size_t WS_VCG = al(WS_KCG + (size_t)T * 128 * 2);
constexpr size_t WS_KS = al(WS_VCG + (size_t)T * 128 * 2);
constexpr size_t WS_KW = al(WS_KS + (size_t)T * 128 * 2);
constexpr size_t WS_VST = al(WS_KW + (size_t)T * 128 * 2);
constexpr size_t WS_VWT = al(WS_VST + (size_t)T * 128 * 2);
constexpr size_t WS_KC = al(WS_VWT + (size_t)T * 128 * 2);
constexpr size_t WS_VCT = al(WS_KC + (size_t)4 * NCP * 64 * 2);
constexpr size_t WS_GATE = al(WS_VCT + (size_t)4 * NCP * 64 * 2);
constexpr size_t WS_HQ = al(WS_GATE + (size_t)T * 24 * 4);
constexpr size_t WS_HF = al(WS_HQ + (size_t)T * 512 * 2);
constexpr size_t WS_HV = al(WS_HF + (size_t)T * 512 * 4);
constexpr size_t WS_HGS = al(WS_HV + (size_t)T * 512 * 2);
constexpr size_t WS_UT = al(WS_HGS + (size_t)T * 512 * 2);
constexpr size_t WS_ST = al(WS_UT + (size_t)8 * NCH * 128 * 128 * 4);
constexpr size_t WS_GD = al(WS_ST + (size_t)8 * NCH * 128 * 128 * 2);
constexpr size_t WS_CAT = al(WS_GD + (size_t)8 * NCH * 128 * 4);
constexpr size_t WS_GLU = al(WS_CAT + (size_t)T * 1024 * 2);
constexpr size_t WS_TIE = al(WS_GLU + (size_t)T * DM * 2);
constexpr size_t WS_TIW = al(WS_TIE + (size_t)T * 2 * 4);
constexpr size_t WS_LIST = al(WS_TIW + (size_t)T * 2 * 4);
constexpr size_t WS_ACT = al(WS_LIST + (size_t)32 * T * 4);
constexpr size_t WS_YK = al(WS_ACT + (size_t)MOE_ROWS * FF * 2);
constexpr size_t WS_WTH = al(WS_YK + (size_t)MOE_ROWS * DM * 2);
constexpr size_t WS_WTL = al(WS_WTH + (size_t)DEPTH * 48 * DM * 2);
constexpr size_t WS_AVEC = al(WS_WTL + (size_t)DEPTH * 48 * DM * 2);
constexpr size_t WS_RBIAS = al(WS_AVEC + (size_t)DEPTH * 2 * DM * 4);
constexpr size_t WS_END = al(WS_RBIAS + (size_t)DEPTH * 2 * 48 * 4);

struct Args { const float* in[26]; float* out; unsigned char* ws; };
enum { I_X = 0, I_C, I_ADAW, I_ADAB, I_NMIX, I_NFFN, I_WIN, I_WOUT, I_CWK, I_CWV, I_CPE, I_QG, I_KG, I_LBL, I_OG,
       I_PW1, I_DW, I_DWB, I_LNG, I_LNB, I_PW2, I_WG, I_WE, I_W1, I_W3, I_W2 };

#ifdef EMU
DEV unsigned char* wsp(const Args& a) { return a.ws; }
DEV float* outp(const Args& a) { return a.out; }
#else
DEV unsigned char* launder_ptr(const void* p) { unsigned long long v = (unsigned long long)p; unsigned lo = (unsigned)v, hi = (unsigned)(v >> 32);
    lo = (unsigned)__builtin_amdgcn_readfirstlane((int)lo); hi = (unsigned)__builtin_amdgcn_readfirstlane((int)hi); asm volatile("" : "+s"(lo), "+s"(hi)); typedef __attribute__((address_space(1))) unsigned char* gptr_t; return (unsigned char*)(gptr_t)(((unsigned long long)hi << 32) | lo); }
DEV unsigned char* wsp(const Args& a) { return launder_ptr(a.ws); }
DEV float* outp(const Args& a) { return (float*)launder_ptr(a.out); }
#endif

#ifdef EMU
#define INP(a, X) ((a).in[X])
#else
DEV int zero_opaque() { int z = 0; asm volatile("" : "+s"(z)); return z; }
#define INP(a, X) ((a).in[(X) + zero_opaque()])
#endif

DEV unsigned f2bf(float f) { unsigned u = __builtin_bit_cast(unsigned, f); return (u + 0x7fffu + ((u >> 16) & 1u)) >> 16; }
DEV float bf2f(unsigned h) { return __builtin_bit_cast(float, h << 16); }
#ifdef EMU
DEV unsigned pk2(float lo, float hi) { return f2bf(lo) | (f2bf(hi) << 16); }
#else
typedef float f32x2_t __attribute__((ext_vector_type(2)));
typedef __bf16 bf16x2_t __attribute__((ext_vector_type(2)));
DEV unsigned pk2(float lo, float hi) { f32x2_t v = {lo, hi}; bf16x2_t b = __builtin_convertvector(v, bf16x2_t); return __builtin_bit_cast(unsigned, b); }
#endif
DEV float sigm(float x) { return frcp(1.0f + fexp2(-x * LOG2E)); }
DEV float siluf(float x) { return x * sigm(x); }
DEV f32x4 f4zero() { f32x4 z = {0.f, 0.f, 0.f, 0.f}; return z; }
DEV bf16x8 pack8(f32x4 a, f32x4 b) {
    u32x4 w; w[0] = pk2(a[0], a[1]); w[1] = pk2(a[2], a[3]); w[2] = pk2(b[0], b[1]); w[3] = pk2(b[2], b[3]);
    return __builtin_bit_cast(bf16x8, w);
}
DEV void st_bf8(bf16* p, f32x4 a, f32x4 b) { u32x4 w; w[0] = pk2(a[0], a[1]); w[1] = pk2(a[2], a[3]); w[2] = pk2(b[0], b[1]); w[3] = pk2(b[2], b[3]); *(u32x4*)p = w; }
DEV void st_bf4(bf16* p, f32x4 v) { u32x2 w; w[0] = pk2(v[0], v[1]); w[1] = pk2(v[2], v[3]); *(u32x2*)p = w; }


#ifdef EMU
namespace pg8 {
constexpr int BM = 256, BK = 64, HALF = 128, NXCD = 8, WGM = 8;
typedef unsigned short bf16_t;
struct Unit { int pm, pn; };
struct Gemm { const bf16_t* A; const bf16_t* Bt; int M, N, K; };
struct StaticOrder {
    int nM, nN, nwg, G, c;
    void init(int M, int N, int G_, int c_) { nM = M / BM; nN = N / BM; nwg = nM * nN; G = G_; c = c_; }
    bool next(int i, Unit& u) const {
        const long L = (long)i * G + c; if (L >= nwg) return false;
        int wgid = (int)L; { const int q = nwg / NXCD, r = nwg % NXCD, xcd = wgid % NXCD, off = wgid / NXCD; wgid = (xcd < r ? xcd * (q + 1) : r * (q + 1) + (xcd - r) * q) + off; }
        const int nig = WGM * nN, gid = wgid / nig, fm = gid * WGM, gsz = (nM - fm) < WGM ? (nM - fm) : WGM;
        u.pm = fm + ((wgid % nig) % gsz); u.pn = (wgid % nig) / gsz; return true;
    }
};
template <class Epi, class Sched, bool ALIGN_EPI = false, bool SP2 = false>
static inline void gemm_phase(unsigned char*, const Gemm g, const Sched& S, const Epi& E) {
    const int tid = emu_tid(), wid = tid >> 6, lane = tid & 63, wr = wid >> 2, wc = wid & 3, fr = lane & 15, fq = lane >> 4;
    Unit u;
    for (int ui = 0; S.next(ui, u); ++ui) {
        f32x4 acc[2][2][4][2];
        for (int ai = 0; ai < 2; ++ai) for (int bj = 0; bj < 2; ++bj) for (int m = 0; m < 4; ++m) for (int n = 0; n < 2; ++n) for (int r = 0; r < 4; ++r) {
            const int row = 256 * u.pm + 128 * ai + 64 * wr + 16 * m + fr, col = 256 * u.pn + 128 * bj + 32 * wc + (Epi::PERM ? 8 * fq + 4 * n + r : 16 * n + 4 * fq + r); float sum = 0.f;
            const bf16_t* ap = g.A + (size_t)row * g.K; const bf16_t* bp = g.Bt + (size_t)col * g.K;
            for (int k = 0; k < g.K; ++k) sum += bf2f(ap[k]) * bf2f(bp[k]);
            acc[ai][bj][m][n][r] = sum; }
        E(acc, u, wr, wc, fr, fq);
    }
    emu_sync_block();
}
}
#else
namespace pg8 {
#define PG8_LAS __attribute__((address_space(3)))
typedef unsigned short bf16_t;
typedef short bf16x8 __attribute__((ext_vector_type(8)));
typedef float f32x4 __attribute__((ext_vector_type(4)));
typedef unsigned u32x4 __attribute__((ext_vector_type(4)));
constexpr int BM = 256, BK = 64, HALF = 128, HTB = HALF * BK * 2  , STAGE_BYTES = 8 * HTB, NXCD = 8, WGM = 8;

__host__ __device__ __forceinline__ int lds_byte(int r, int c) { const int st = (r >> 4) * 2 + (c >> 5), rr = r & 15, cc = c & 31, ob = rr * 64 + cc * 2; return st * 1024 + (ob ^ (((ob >> 9) & 1) << 5)); }
__host__ __device__ __forceinline__ void stage_rc(int b, int& R, int& C) { const int st = b / 1024, sb = b % 1024, swz = sb ^ (((sb >> 9) & 1) << 5); R = (st >> 1) * 16 + swz / 64; C = (st & 1) * 32 + (swz % 64) / 2; }
__host__ __device__ __forceinline__ int perm32(int rho) { const int n = rho >> 4, i = rho & 15; return 8 * (i >> 2) + 4 * n + (i & 3); }

struct Unit { int pm, pn; };
struct Gemm { const bf16_t* A; const bf16_t* Bt; int M, N, K; };

struct StaticOrder {
    int nM, nN, nwg, G, c;
    __host__ __device__ void init(int M, int N, int G_, int c_) { nM = M / BM; nN = N / BM; nwg = nM * nN; G = G_; c = c_; }
    __host__ __device__ bool next(int i, Unit& u) const {
        const long L = (long)i * G + c; if (L >= nwg) return false;
        int wgid = (int)L; { const int q = nwg / NXCD, r = nwg % NXCD, xcd = wgid % NXCD, off = wgid / NXCD; wgid = (xcd < r ? xcd * (q + 1) : r * (q + 1) + (xcd - r) * q) + off; }
        const int nig = WGM * nN, gid = wgid / nig, fm = gid * WGM, gsz = (nM - fm) < WGM ? (nM - fm) : WGM;
        u.pm = fm + ((wgid % nig) % gsz); u.pn = (wgid % nig) / gsz; return true;
    }
    __device__ __forceinline__ void a_ready(const Unit&) const {}
    __device__ __forceinline__ void done(const Unit&) const {}
};

__device__ __forceinline__ unsigned cvt_pk_bf16(float lo, float hi) { unsigned r; asm volatile("v_cvt_pk_bf16_f32 %0, %1, %2" : "=v"(r) : "v"(lo), "v"(hi)); return r; }
template <class Epi, class Sched, bool ALIGN_EPI = false, bool SP2 = false>
__device__ __forceinline__ void gemm_phase(PG8_LAS unsigned char* lds, const Gemm g, const Sched& S, const Epi& E) {
    const int tid = TID, wid = __builtin_amdgcn_readfirstlane(tid >> 6), lane = tid & 63, wr = wid >> 2, wc = wid & 3, fr = lane & 15, fq = lane >> 4;
    const int K = g.K, nt = K / BK;
    unsigned voffA[2], voffB[2];
#pragma unroll
    for (int i = 0; i < 2; ++i) { int R, C; stage_rc(tid * 16 + i * 8192, R, C); const int Rb = Epi::PERM ? ((R & ~31) + perm32(R & 31)) : R;
        voffA[i] = (unsigned)(R * K + C) * 2u; voffB[i] = (unsigned)(Rb * K + C) * 2u; }
    const size_t kstep = (size_t)(BK * 2);
    const size_t hstep = (size_t)HALF * K * 2;
    const size_t tstep = 2 * hstep;
    const unsigned ldsw = (unsigned)wid * 1024u;
    const int aoff = lds_byte(wr * 64 + fr, fq * 8), boff = lds_byte(wc * 32 + fr, fq * 8);
#define PG8_SA(b, h) (((b) * 2 + (h)) * HTB)
#define PG8_SB(b, h) ((4 + (b) * 2 + (h)) * HTB)
#define PG8_STAGE(bufoff, gbase, voff) do { _Pragma("unroll") for (int _i = 0; _i < 2; ++_i) \
        __builtin_amdgcn_global_load_lds((const unsigned*)((const char*)(gbase) + (voff)[_i]), (PG8_LAS unsigned*)(lds + (bufoff) + ldsw + _i * 8192), 16, 0, 0); } while (0)
#define PG8_LDA(dst, b, h) do { _Pragma("unroll") for (int m = 0; m < 4; ++m) _Pragma("unroll") for (int k = 0; k < 2; ++k) dst[m][k] = *(const PG8_LAS bf16x8*)(lds + PG8_SA(b, h) + aoff + m * 2048 + k * 1024); } while (0)
#define PG8_LDB(dst, b, h) do { _Pragma("unroll") for (int n = 0; n < 2; ++n) _Pragma("unroll") for (int k = 0; k < 2; ++k) dst[n][k] = *(const PG8_LAS bf16x8*)(lds + PG8_SB(b, h) + boff + n * 2048 + k * 1024); } while (0)
#define PG8_MMA(ai, bj, At, Bt) do { __builtin_amdgcn_s_setprio(1); _Pragma("unroll") for (int m = 0; m < 4; ++m) _Pragma("unroll") for (int n = 0; n < 2; ++n) _Pragma("unroll") for (int k = 0; k < 2; ++k) \
        acc[ai][bj][m][n] = __builtin_amdgcn_mfma_f32_16x16x32_bf16(Bt[n][k], At[m][k], acc[ai][bj][m][n], 0, 0, 0); __builtin_amdgcn_s_setprio(0); } while (0)
#define PG8_WAIT_V(n) asm volatile("s_waitcnt vmcnt(" #n ")" ::: "memory")
#define PG8_WAIT_L(n) asm volatile("s_waitcnt lgkmcnt(" #n ")" ::: "memory")
#define PG8_BAR __builtin_amdgcn_s_barrier()
#define PG8_SCHED __builtin_amdgcn_sched_barrier(0)
    Unit cur, nxt; int ui = 0;
    if (!S.next(0, cur)) return;
    f32x4 acc[2][2][4][2];
#pragma unroll
    for (int a = 0; a < 2; ++a)
#pragma unroll
        for (int b = 0; b < 2; ++b)
#pragma unroll
            for (int m = 0; m < 4; ++m)
#pragma unroll
                for (int n = 0; n < 2; ++n) acc[a][b][m][n] = (f32x4){0.f, 0.f, 0.f, 0.f};
    bf16x8 At[4][2], B0[2][2], B1[2][2];
    const char* cA = (const char*)g.A + (size_t)cur.pm * tstep; const char* cB = (const char*)g.Bt + (size_t)cur.pn * tstep;
    S.a_ready(cur);
    if constexpr (SP2) {
        PG8_STAGE(PG8_SB(0, 0), cB, voffB); PG8_STAGE(PG8_SB(0, 1), cB + hstep, voffB); PG8_STAGE(PG8_SA(0, 0), cA, voffA); PG8_STAGE(PG8_SA(0, 1), cA + hstep, voffA);
        if (wr == 1) PG8_BAR;
        PG8_WAIT_V(2); PG8_BAR;
        PG8_STAGE(PG8_SB(1, 0), cB + kstep, voffB); PG8_STAGE(PG8_SA(1, 0), cA + kstep, voffA); PG8_STAGE(PG8_SB(1, 1), cB + hstep + kstep, voffB);
        PG8_WAIT_V(6); PG8_BAR;
    } else {
        PG8_STAGE(PG8_SB(0, 0), cB, voffB); PG8_STAGE(PG8_SA(0, 0), cA, voffA); PG8_STAGE(PG8_SB(0, 1), cB + hstep, voffB); PG8_STAGE(PG8_SA(0, 1), cA + hstep, voffA);
        if (wr == 1) PG8_BAR;
        PG8_WAIT_V(4); PG8_BAR;
        PG8_STAGE(PG8_SB(1, 0), cB + kstep, voffB); PG8_STAGE(PG8_SA(1, 0), cA + kstep, voffA); PG8_STAGE(PG8_SB(1, 1), cB + hstep + kstep, voffB);
        PG8_WAIT_V(6); PG8_BAR;
    }
    for (;;) {
        const bool has_next = S.next(ui + 1, nxt);
        const char* nA = has_next ? (const char*)g.A + (size_t)nxt.pm * tstep : cA; const char* nB = has_next ? (const char*)g.Bt + (size_t)nxt.pn * tstep : cB;
        for (int t = 0; t < nt; t += 2) {
            const bool last = (t == nt - 2);
            const char* a1 = cA + (size_t)(t + 1) * kstep;
            const char* a2 = last ? nA : cA + (size_t)(t + 2) * kstep; const char* b2 = last ? nB : cB + (size_t)(t + 2) * kstep;
            const char* a3 = a2 + kstep; const char* b3 = b2 + kstep;
            if (last && has_next) S.a_ready(nxt);
            if constexpr (SP2) {
            PG8_LDB(B0, 0, 0); PG8_LDB(B1, 0, 1); PG8_SCHED; PG8_LDA(At, 0, 0); PG8_STAGE(PG8_SA(1, 1), a1 + hstep, voffA);
            PG8_WAIT_V(8); PG8_WAIT_L(0); PG8_BAR; PG8_MMA(0, 0, At, B0); PG8_MMA(0, 1, At, B1); PG8_BAR; PG8_SCHED;
            PG8_LDA(At, 0, 1); PG8_STAGE(PG8_SB(0, 0), b2, voffB); PG8_STAGE(PG8_SB(0, 1), b2 + hstep, voffB); PG8_STAGE(PG8_SA(0, 0), a2, voffA);
            PG8_WAIT_V(8); PG8_WAIT_L(0); PG8_BAR; PG8_MMA(1, 0, At, B0); PG8_MMA(1, 1, At, B1); PG8_BAR; PG8_SCHED;
            PG8_LDB(B0, 1, 0); PG8_LDB(B1, 1, 1); PG8_SCHED; PG8_LDA(At, 1, 0); PG8_STAGE(PG8_SA(0, 1), a2 + hstep, voffA);
            PG8_WAIT_V(8); PG8_WAIT_L(0); PG8_BAR; PG8_MMA(0, 0, At, B0); PG8_MMA(0, 1, At, B1); PG8_BAR; PG8_SCHED;
            PG8_LDA(At, 1, 1); PG8_STAGE(PG8_SB(1, 0), b3, voffB); PG8_STAGE(PG8_SB(1, 1), b3 + hstep, voffB); PG8_STAGE(PG8_SA(1, 0), a3, voffA);
            PG8_WAIT_V(8); PG8_WAIT_L(0); PG8_BAR; PG8_MMA(1, 0, At, B0); PG8_MMA(1, 1, At, B1); PG8_BAR; PG8_SCHED;
            } else {
            PG8_LDB(B0, 0, 0); PG8_SCHED; PG8_LDA(At, 0, 0); PG8_STAGE(PG8_SA(1, 1), a1 + hstep, voffA);
            PG8_WAIT_L(8); PG8_BAR; PG8_WAIT_L(0); PG8_MMA(0, 0, At, B0); PG8_BAR; PG8_SCHED;
            PG8_LDB(B1, 0, 1); PG8_STAGE(PG8_SB(0, 0), b2, voffB);
            PG8_BAR; PG8_WAIT_L(0); PG8_MMA(0, 1, At, B1); PG8_BAR;
            PG8_LDA(At, 0, 1); PG8_STAGE(PG8_SA(0, 0), a2, voffA);
            PG8_BAR; PG8_WAIT_L(0); PG8_MMA(1, 0, At, B0); PG8_BAR; PG8_SCHED;
            PG8_STAGE(PG8_SB(0, 1), b2 + hstep, voffB);
            PG8_WAIT_V(6); PG8_BAR; PG8_MMA(1, 1, At, B1); PG8_BAR;
            PG8_LDB(B0, 1, 0); PG8_SCHED; PG8_LDA(At, 1, 0); PG8_STAGE(PG8_SA(0, 1), a2 + hstep, voffA);
            PG8_WAIT_L(8); PG8_BAR; PG8_WAIT_L(0); PG8_MMA(0, 0, At, B0); PG8_BAR; PG8_SCHED;
            PG8_LDB(B1, 1, 1); PG8_STAGE(PG8_SB(1, 0), b3, voffB);
            PG8_BAR; PG8_WAIT_L(0); PG8_MMA(0, 1, At, B1); PG8_BAR;
            PG8_LDA(At, 1, 1); PG8_STAGE(PG8_SA(1, 0), a3, voffA);
            PG8_BAR; PG8_WAIT_L(0); PG8_MMA(1, 0, At, B0); PG8_BAR; PG8_SCHED;
            PG8_STAGE(PG8_SB(1, 1), b3 + hstep, voffB);
            PG8_WAIT_V(6); PG8_BAR; PG8_MMA(1, 1, At, B1); PG8_BAR;
            }
        }
        if constexpr (ALIGN_EPI) { if (wr == 0) PG8_BAR; }
        if constexpr (!Epi::AFTER_DRAIN) { E(acc, cur, wr, wc, fr, fq); S.done(cur); }
        if (!has_next) break;
#pragma unroll
        for (int a = 0; a < 2; ++a)
#pragma unroll
            for (int b = 0; b < 2; ++b)
#pragma unroll
                for (int m = 0; m < 4; ++m)
#pragma unroll
                    for (int n = 0; n < 2; ++n) acc[a][b][m][n] = (f32x4){0.f, 0.f, 0.f, 0.f};
        cur = nxt; cA = nA; cB = nB; ++ui;
        if constexpr (ALIGN_EPI) { if (wr == 1) PG8_BAR; }
    }
    PG8_WAIT_V(0);
    if constexpr (!ALIGN_EPI) { if (wr == 0) PG8_BAR; }
    PG8_BAR;
    if constexpr (Epi::AFTER_DRAIN) { E.fused(acc, cur, wr, wc, fr, fq, lds, wid, lane); S.done(cur); }
#undef PG8_SA
#undef PG8_SB
#undef PG8_STAGE
#undef PG8_LDA
#undef PG8_LDB
#undef PG8_MMA
#undef PG8_WAIT_V
#undef PG8_WAIT_L
#undef PG8_BAR
#undef PG8_SCHED
}
}
#endif

constexpr int LDT = 72;
constexpr int GEMM_AS = 256 * LDT, GEMM_BS = 128 * LDT;
constexpr int GEMM_LDS = 2 * (GEMM_AS + GEMM_BS) * 2;

template <class AF, class EPI>
DEV void gemm_tile(unsigned char* smem, AF af, const bf16* Bt, int ldb, int nvalid, int K, EPI& epi) {
    const int tid = TID, w = tid >> 6, l = tid & 63, h = l >> 4, c = l & 15, wm = w >> 1, wn = w & 1;
    bf16* As = (bf16*)smem; bf16* Bs = As + 2 * GEMM_AS;
    const bf16* ap[4]; const bf16* bp[2];
    const int col8 = (tid & 7) * 8, r0 = tid >> 3;
#pragma unroll
    for (int i = 0; i < 4; ++i) ap[i] = af(r0 + 64 * i) + col8;
#pragma unroll
    for (int i = 0; i < 2; ++i) { int rn = r0 + 64 * i; if (rn >= nvalid) rn = nvalid - 1; bp[i] = Bt + (size_t)rn * ldb + col8; }
    f32x4 acc[4][4];
#pragma unroll
    for (int i = 0; i < 4; ++i)
#pragma unroll
        for (int j = 0; j < 4; ++j) acc[i][j] = f4zero();
    bf16x8 ra[4], rb[2];
#pragma unroll
    for (int i = 0; i < 4; ++i) ra[i] = *(const bf16x8*)(ap[i]);
#pragma unroll
    for (int i = 0; i < 2; ++i) rb[i] = *(const bf16x8*)(bp[i]);
    SYNC();
#pragma unroll
    for (int i = 0; i < 4; ++i) *(bf16x8*)(As + (r0 + 64 * i) * LDT + col8) = ra[i];
#pragma unroll
    for (int i = 0; i < 2; ++i) *(bf16x8*)(Bs + (r0 + 64 * i) * LDT + col8) = rb[i];
    SYNC();
    const int nk = K / 64;
    for (int kt = 0; kt < nk; ++kt) {
        const int cur = kt & 1;
        if (kt + 1 < nk) {
#pragma unroll
            for (int i = 0; i < 4; ++i) ra[i] = *(const bf16x8*)(ap[i] + (kt + 1) * 64);
#pragma unroll
            for (int i = 0; i < 2; ++i) rb[i] = *(const bf16x8*)(bp[i] + (kt + 1) * 64);
        }
        const bf16* Ac = As + cur * GEMM_AS + (wm * 64 + c) * LDT + 8 * h;
        const bf16* Bc = Bs + cur * GEMM_BS + (wn * 64 + c) * LDT + 8 * h;
#pragma unroll
        for (int kk = 0; kk < 2; ++kk) {
            bf16x8 fa[4], fb[4];
#pragma unroll
            for (int i = 0; i < 4; ++i) { fa[i] = *(const bf16x8*)(Ac + i * 16 * LDT + kk * 32); fb[i] = *(const bf16x8*)(Bc + i * 16 * LDT + kk * 32); }
#pragma unroll
            for (int ni = 0; ni < 4; ++ni)
#pragma unroll
                for (int mi = 0; mi < 4; ++mi) acc[ni][mi] = mfma16(fb[ni], fa[mi], acc[ni][mi]);
        }
        if (kt + 1 < nk) {
            const int nx = cur ^ 1;
#pragma unroll
            for (int i = 0; i < 4; ++i) *(bf16x8*)(As + nx * GEMM_AS + (r0 + 64 * i) * LDT + col8) = ra[i];
#pragma unroll
            for (int i = 0; i < 2; ++i) *(bf16x8*)(Bs + nx * GEMM_BS + (r0 + 64 * i) * LDT + col8) = rb[i];
        }
        SYNC();
    }
    epi(acc, wm * 64, wn * 64, h, c);
}

struct ARows { const bf16* base; size_t ld; MDEV const bf16* operator()(int r) const { return base + (size_t)r * ld; } MDEV unsigned off(int r) const { return (unsigned)r * (unsigned)ld; } };

constexpr int LDB = 144;
constexpr int GEMM_BS2 = 64 * LDB;
constexpr int GEMM2_LDS = (2 * GEMM_AS + 2 * GEMM_BS2) * 2;
DEV bf16x8 tr_read8(const bf16* p0, const bf16* p1) {
    const s16x4 x = tr4(p0), y = tr4(p1); bf16x8 r;
    r[0] = x[0]; r[1] = x[1]; r[2] = x[2]; r[3] = x[3]; r[4] = y[0]; r[5] = y[1]; r[6] = y[2]; r[7] = y[3]; return r;
}
DEV int bperm(int r) { return (r & ~12) | ((r & 4) << 1) | ((r & 8) >> 1); }
template <class AF, class BF, class EPI>
DEV void gemm_tile2(unsigned char* smem, AF af, BF bf, int ldb, int K, EPI& epi) {
    const int tid = TID, w = tid >> 6, l = tid & 63, h = l >> 4, c = l & 15, wm = w >> 1, wn = w & 1, grp = w >> 2;
    bf16* As = (bf16*)smem; bf16* Bs = As + 2 * GEMM_AS;
    const bf16* abase = af.base; unsigned ao[4];
    const int col8 = (tid & 7) * 8, r0 = tid >> 3;
#pragma unroll
    for (int i = 0; i < 4; ++i) ao[i] = af.off(r0 + 64 * i) + col8;
    const int bn4 = (tid & 31) * 4, bk = tid >> 5, bkp = bperm(bk);
    const float* bp = bf(bn4); const bool bok = bp != nullptr;
    if (bok) bp += (size_t)bk * ldb;
    const size_t bstep = (size_t)16 * ldb;
    f32x4 acc[4][4];
#pragma unroll
    for (int i = 0; i < 4; ++i)
#pragma unroll
        for (int j = 0; j < 4; ++j) acc[i][j] = f4zero();
    bf16x8 ra[4]; f32x4 rb[4];
    const int nk = K / 64;
#pragma unroll
    for (int i = 0; i < 4; ++i) { ra[i] = *(const bf16x8*)(abase + ao[i]); rb[i] = bok ? *(const f32x4*)(bp + i * bstep) : f4zero(); }
    SYNC();
#pragma unroll
    for (int i = 0; i < 4; ++i) { *(bf16x8*)(As + (r0 + 64 * i) * LDT + col8) = ra[i]; st_bf4(Bs + (bkp + 16 * i) * LDB + bn4, rb[i]); }
    if (nk > 1) {
#pragma unroll
        for (int i = 0; i < 4; ++i) { ra[i] = *(const bf16x8*)(abase + (ao[i] + 64)); rb[i] = bok ? *(const f32x4*)(bp + (size_t)64 * ldb + i * bstep) : f4zero(); } }
    SYNC();
    for (int kt = 0; kt < nk; ++kt) {
        const int cur = kt & 1;
#pragma unroll
        for (int p = 0; p < 2; ++p) {
            if (grp == p) {
                const bf16* Ac = As + cur * GEMM_AS + (wm * 64 + c) * LDT + 8 * h;
                const bf16* Bc = Bs + cur * GEMM_BS2 + bperm(8 * h + (c >> 2)) * LDB + wn * 64 + 4 * (c & 3);
#pragma unroll
                for (int kk = 0; kk < 2; ++kk) {
                    bf16x8 fa[4], fb[4];
#pragma unroll
                    for (int i = 0; i < 4; ++i) { fa[i] = *(const bf16x8*)(Ac + i * 16 * LDT + kk * 32); fb[i] = tr_read8(Bc + (32 * kk) * LDB + 16 * i, Bc + (32 * kk + 8) * LDB + 16 * i); }
#pragma unroll
                    for (int ni = 0; ni < 4; ++ni)
#pragma unroll
                        for (int mi = 0; mi < 4; ++mi) acc[ni][mi] = mfma16(fb[ni], fa[mi], acc[ni][mi]);
                }
            } else if (kt + 1 < nk) {
                const int nx = cur ^ 1;
#pragma unroll
                for (int i = 0; i < 4; ++i) { *(bf16x8*)(As + nx * GEMM_AS + (r0 + 64 * i) * LDT + col8) = ra[i]; st_bf4(Bs + nx * GEMM_BS2 + (bkp + 16 * i) * LDB + bn4, rb[i]); }
                if (kt + 2 < nk) {
#pragma unroll
                    for (int i = 0; i < 4; ++i) { ra[i] = *(const bf16x8*)(abase + (ao[i] + (kt + 2) * 64)); rb[i] = bok ? *(const f32x4*)(bp + (size_t)(kt + 2) * 64 * ldb + i * bstep) : f4zero(); } }
            }
            SYNC();
        }
    }
    epi(acc, wm * 64, wn * 64, h, c);
}
struct BPlain { const float* base; MDEV const float* operator()(int nt) const { return base + nt; } };
struct BInProjMap { const float* base; int n0; MDEV const float* operator()(int nt) const { const int n = n0 + nt; const int sc = n < 1280 ? n : (n < 3328 ? n + 24 : (n < 3352 ? 1280 + (n - 3328) : -1)); return sc < 0 ? nullptr : base + sc; } };
struct BInter { const float* s0; const float* s1; int n0; MDEV const float* operator()(int nt) const { const int n = n0 + nt, g = n >> 6, w = n & 63; return w < 32 ? s0 + g * 32 + w : s1 + g * 32 + w - 32; } };
struct BClamp64 { const float* base; MDEV const float* operator()(int nt) const { return base + (nt & 63); } };

struct EpiInProj {
    const Args* a; int m0, n0, li;
    MDEV void operator()(f32x4 (&acc)[4][4], int mw, int nw, int h, int c) const {
        unsigned char* ws = wsp(*a);
        const int nb = n0 + nw;
        const int tokb = m0 + mw + c;
        if (nb < 512 || (nb >= 768 && nb < 896) || (nb >= 1024 && nb < 1152)) {
            const float* gain; float mul = 1.f; bf16* dst; int kind;
            if (nb < 512) { gain = INP(*a, I_QG) + li * 64; mul = 0.125f * LOG2E; kind = 0; dst = (bf16*)(ws + WS_QN); }
            else if (nb < 896) { gain = INP(*a, I_KG) + (li * 3 + 1) * 64; kind = 1; dst = (bf16*)(ws + WS_KS); }
            else { gain = INP(*a, I_KG) + (li * 3 + 2) * 64; kind = 1; dst = (bf16*)(ws + WS_KW); }
            const int g = (nb >> 6) & 1;
#pragma unroll
            for (int mi = 0; mi < 4; ++mi) {
                float ss = 0.f;
#pragma unroll
                for (int ni = 0; ni < 4; ++ni) { f32x4 v = acc[ni][mi]; ss += v[0] * v[0] + v[1] * v[1] + v[2] * v[2] + v[3] * v[3]; }
                ss += shflx(ss, 16); ss += shflx(ss, 32);
                const float rs = frsq(ss * (1.0f / 64.0f) + EPS) * mul;
                const int tok = tokb + 16 * mi;
#pragma unroll
                for (int ni = 0; ni < 4; ++ni) {
                    const int d = 16 * ni + 4 * h; f32x4 v = acc[ni][mi], o;
#pragma unroll
                    for (int r = 0; r < 4; ++r) o[r] = v[r] * rs * gain[d + r];
                    if (kind == 0) st_bf4(dst + (size_t)tok * 512 + nb + d, o);
                    else { const int b = tok / SEQ, s = tok % SEQ; st_bf4(dst + ((size_t)(b * 2 + g) * SEQ + s) * 64 + d, o); }
                }
            }
        } else if (nb < 768) {
            bf16* dst = (bf16*)(ws + (nb < 640 ? WS_KCG : WS_VCG)); const int g = (nb >> 6) & 1;
#pragma unroll
            for (int mi = 0; mi < 4; ++mi) { const int tok = tokb + 16 * mi, b = tok / SEQ, s = tok % SEQ;
#pragma unroll
                for (int ni = 0; ni < 4; ++ni) st_bf4(dst + ((size_t)(b * 2 + g) * SEQ + s) * 64 + 16 * ni + 4 * h, acc[ni][mi]); }
        } else if (nb < 1280) {
            bf16* dst = (bf16*)(ws + (nb < 1024 ? WS_VST : WS_VWT)); const int g = (nb >> 6) & 1;
#pragma unroll
            for (int mi = 0; mi < 4; ++mi) { const int tok = tokb + 16 * mi, b = tok / SEQ, s = tok % SEQ;
                bf16* p = dst + ((size_t)(b * 2 + g) * NCH + (s >> 6)) * 4096 + (s & 63);
#pragma unroll
                for (int ni = 0; ni < 4; ++ni)
#pragma unroll
                    for (int r = 0; r < 4; ++r) p[(16 * ni + 4 * h + r) * 64] = (bf16)f2bf(acc[ni][mi][r]); }
        } else if (nb < 3328) {
            const int sec = (nb - 1280) >> 9, cc = (nb - 1280) & 511, hh = cc >> 7, d0 = cc & 127;
#pragma unroll
            for (int mi = 0; mi < 4; ++mi) { const int tok = tokb + 16 * mi, b = tok / SEQ, s = tok % SEQ;
                const size_t hrow = ((size_t)(b * 4 + hh) * SEQ + s) * 128 + d0;
#pragma unroll
                for (int ni = 0; ni < 4; ++ni) { const int d = 16 * ni + 4 * h; f32x4 v = acc[ni][mi], o;
                    if (sec == 0) { for (int r = 0; r < 4; ++r) o[r] = siluf(v[r]); st_bf4((bf16*)(ws + WS_HQ) + hrow + d, o); }
                    else if (sec == 1) { const float* lb = (const float*)(ws + WS_LB) + li * 512 + cc + d;
                        for (int r = 0; r < 4; ++r) o[r] = lb[r] + (1.0f - lb[r]) * sigm(v[r]);
                        *(f32x4*)((float*)(ws + WS_HF) + hrow + d) = o; }
                    else if (sec == 2) st_bf4((bf16*)(ws + WS_HV) + hrow + d, v);
                    else { for (int r = 0; r < 4; ++r) o[r] = siluf(v[r]); st_bf4((bf16*)(ws + WS_HGS) + (size_t)tok * 512 + cc + d, o); }
                } }
        } else if (nb == 3328) {
            float* dst = (float*)(ws + WS_GATE);
#pragma unroll
            for (int mi = 0; mi < 4; ++mi) { const int tok = tokb + 16 * mi;
#pragma unroll
                for (int ni = 0; ni < 2; ++ni)
#pragma unroll
                    for (int r = 0; r < 4; ++r) { const int n = 16 * ni + 4 * h + r; if (n < 24) dst[(size_t)tok * 24 + n] = sigm(acc[ni][mi][r]); } }
        }
    }
};

struct EpiResid {
    float* x; const float* gate; int m0, n0;
    MDEV void operator()(f32x4 (&acc)[4][4], int mw, int nw, int h, int c) const {
#pragma unroll
        for (int mi = 0; mi < 4; ++mi) { const int tok = m0 + mw + 16 * mi + c, b = tok / SEQ;
#pragma unroll
            for (int ni = 0; ni < 4; ++ni) { const int n = n0 + nw + 16 * ni + 4 * h;
                f32x4 g = *(const f32x4*)(gate + (size_t)b * 6 * DM + n); f32x4* p = (f32x4*)(x + (size_t)tok * DM + n); f32x4 v = *p;
#pragma unroll
                for (int r = 0; r < 4; ++r) v[r] += g[r] * acc[ni][mi][r];
                *p = v; } }
    }
};
template <int MODE> struct EpiGated {
    bf16* dst; size_t ld; int m0, n0, mvalid;
    MDEV void operator()(f32x4 (&acc)[4][4], int mw, int nw, int h, int c) const {
        const int cb = (n0 + nw) / 2;
#pragma unroll
        for (int mi = 0; mi < 4; ++mi) { const int m = mw + 16 * mi + c; if (m >= mvalid) continue;
#pragma unroll
            for (int ni = 0; ni < 2; ++ni) { f32x4 o;
#pragma unroll
                for (int r = 0; r < 4; ++r) { const float av = acc[ni][mi][r], bv = acc[ni + 2][mi][r]; o[r] = MODE == 0 ? av * sigm(bv) : siluf(av) * bv; }
                st_bf4(dst + (size_t)(m0 + m) * ld + cb + 16 * ni + 4 * h, o); } }
    }
};
struct EpiStoreBf {
    bf16* dst; size_t ld; int m0, n0, mvalid;
    MDEV void operator()(f32x4 (&acc)[4][4], int mw, int nw, int h, int c) const {
#pragma unroll
        for (int mi = 0; mi < 4; ++mi) { const int m = mw + 16 * mi + c; if (m >= mvalid) continue;
#pragma unroll
            for (int ni = 0; ni < 4; ++ni) st_bf4(dst + (size_t)(m0 + m) * ld + n0 + nw + 16 * ni + 4 * h, acc[ni][mi]); }
    }
};
struct EpiCmp {
    const Args* a; int kv, bg, m0, li;
    MDEV void operator()(f32x4 (&acc)[4][4], int mw, int nw, int h, int c) const {
        if (nw != 0) return;
        unsigned char* ws = wsp(*a);
        const float* bp8 = (const float*)(ws + WS_CB) + (li * 2 + kv) * 8 * 64;
        float bias[16];
#pragma unroll
        for (int q = 0; q < 16; ++q) { const int e = 16 * (q >> 2) + 4 * h + (q & 3); float v = 0.f;
#pragma unroll
            for (int kp = 0; kp < 8; ++kp) v += bp8[kp * 64 + e];
            bias[q] = v; }
        const float* gain = INP(*a, I_KG) + (li * 3 + 0) * 64;
#pragma unroll
        for (int mi = 0; mi < 4; ++mi) { const int n = m0 + mw + 16 * mi + c; const bool ok = n < NCMP;
            f32x4 v[4]; float ss = 0.f;
#pragma unroll
            for (int ni = 0; ni < 4; ++ni) { v[ni] = acc[ni][mi];
#pragma unroll
                for (int r = 0; r < 4; ++r) { v[ni][r] += bias[4 * ni + r]; ss += v[ni][r] * v[ni][r]; } }
            ss += shflx(ss, 16); ss += shflx(ss, 32);
            if (n >= NCP) continue;
            if (kv == 0) { const float rs = frsq(ss * (1.0f / 64.0f) + EPS); bf16* p = (bf16*)(ws + WS_KC) + ((size_t)bg * NCP + n) * 64;
#pragma unroll
                for (int ni = 0; ni < 4; ++ni) { f32x4 o;
#pragma unroll
                    for (int r = 0; r < 4; ++r) o[r] = ok ? v[ni][r] * rs * gain[16 * ni + 4 * h + r] : 0.f;
                    st_bf4(p + 16 * ni + 4 * h, o); }
            } else { bf16* p = (bf16*)(ws + WS_VCT) + (size_t)bg * 64 * NCP + n;
#pragma unroll
                for (int ni = 0; ni < 4; ++ni)
#pragma unroll
                    for (int r = 0; r < 4; ++r) p[(size_t)(16 * ni + 4 * h + r) * NCP] = (bf16)f2bf(ok ? v[ni][r] : 0.f); }
        }
    }
};


struct EpiResid8 {
    static constexpr bool PERM = true, AFTER_DRAIN = false;
    float* x; const float* gate;
    MDEV void operator()(const f32x4 (&acc)[2][2][4][2], const pg8::Unit& u, int wr, int wc, int fr, int fq) const {
        OPAQUE2(fr, fq);
#pragma unroll
        for (int ai = 0; ai < 2; ++ai)
#pragma unroll
            for (int m = 0; m < 4; ++m) { const int row = 256 * u.pm + 128 * ai + 64 * wr + 16 * m + fr, b = row / SEQ;
#pragma unroll
                for (int bj = 0; bj < 2; ++bj)
#pragma unroll
                    for (int n = 0; n < 2; ++n) { const int col = 256 * u.pn + 128 * bj + 32 * wc + 8 * fq + 4 * n;
                        const f32x4 g = *(const f32x4*)(gate + (size_t)b * 6 * DM + col); f32x4* p = (f32x4*)(x + (size_t)row * DM + col); f32x4 v = *p;
#pragma unroll
                        for (int r = 0; r < 4; ++r) v[r] += g[r] * acc[ai][bj][m][n][r];
                        *p = v; } }
    }
};
struct EpiGlu8 {
    static constexpr bool PERM = true, AFTER_DRAIN = false;
    bf16* dst;
    MDEV void operator()(const f32x4 (&acc)[2][2][4][2], const pg8::Unit& u, int wr, int wc, int fr, int fq) const {
        OPAQUE2(fr, fq);
#pragma unroll
        for (int ai = 0; ai < 2; ++ai)
#pragma unroll
            for (int m = 0; m < 4; ++m) { const int row = 256 * u.pm + 128 * ai + 64 * wr + 16 * m + fr;
#pragma unroll
                for (int bj = 0; bj < 2; ++bj) { const int col = 128 * u.pn + 64 * bj + 16 * wc + 4 * fq; f32x4 o;
#pragma unroll
                    for (int r = 0; r < 4; ++r) o[r] = acc[ai][bj][m][0][r] * sigm(acc[ai][bj][m][1][r]);
                    st_bf4(dst + (size_t)row * DM + col, o); } }
    }
};
struct EpiInProj8 {
    static constexpr bool PERM = true, AFTER_DRAIN = false;
    const Args* a; int li;
    MDEV void operator()(const f32x4 (&acc)[2][2][4][2], const pg8::Unit& u, int wr, int wc, int fr, int fq) const {
        OPAQUE2(fr, fq);
        unsigned char* ws = wsp(*a);
        const int nb = 256 * u.pn + 64 * wc;
        if (nb >= 3392) return;
        if (nb < 512 || (nb >= 768 && nb < 896) || (nb >= 1024 && nb < 1152)) {
            const float* gain; float mul = 1.f; int kind;
            if (nb < 512) { gain = INP(*a, I_QG) + li * 64; mul = 0.125f * LOG2E; kind = 0; }
            else if (nb < 896) { gain = INP(*a, I_KG) + (li * 3 + 1) * 64; kind = 1; }
            else { gain = INP(*a, I_KG) + (li * 3 + 2) * 64; kind = 2; }
            const int g = (nb >> 6) & 1;
            f32x4 gv[2][2];
#pragma unroll
            for (int bj = 0; bj < 2; ++bj)
#pragma unroll
                for (int n = 0; n < 2; ++n) gv[bj][n] = *(const f32x4*)(gain + 32 * bj + 8 * fq + 4 * n);
#pragma unroll
            for (int ai = 0; ai < 2; ++ai)
#pragma unroll
                for (int m = 0; m < 4; ++m) { const int tok = 256 * u.pm + 128 * ai + 64 * wr + 16 * m + fr;
                    float ss = 0.f;
#pragma unroll
                    for (int bj = 0; bj < 2; ++bj)
#pragma unroll
                        for (int n = 0; n < 2; ++n) { const f32x4 v = acc[ai][bj][m][n]; ss += v[0] * v[0] + v[1] * v[1] + v[2] * v[2] + v[3] * v[3]; }
                    ss += shflx(ss, 16); ss += shflx(ss, 32);
                    const float rs = frsq(ss * (1.0f / 64.0f) + EPS) * mul;
                    bf16* dst; if (kind == 0) dst = (bf16*)(ws + WS_QN) + (size_t)tok * 512 + nb; else { const int b = tok / SEQ, sq = tok % SEQ; dst = (bf16*)(ws + (kind == 1 ? WS_KS : WS_KW)) + ((size_t)(b * 2 + g) * SEQ + sq) * 64; }
#pragma unroll
                    for (int bj = 0; bj < 2; ++bj) { f32x4 o0, o1;
#pragma unroll
                        for (int r = 0; r < 4; ++r) { o0[r] = acc[ai][bj][m][0][r] * rs * gv[bj][0][r]; o1[r] = acc[ai][bj][m][1][r] * rs * gv[bj][1][r]; }
                        st_bf8(dst + 32 * bj + 8 * fq, o0, o1); } }
        } else if (nb < 768) {
            bf16* base = (bf16*)(ws + (nb < 640 ? WS_KCG : WS_VCG)); const int g = (nb >> 6) & 1;
#pragma unroll
            for (int ai = 0; ai < 2; ++ai)
#pragma unroll
                for (int m = 0; m < 4; ++m) { const int tok = 256 * u.pm + 128 * ai + 64 * wr + 16 * m + fr, b = tok / SEQ, sq = tok % SEQ;
#pragma unroll
                    for (int bj = 0; bj < 2; ++bj) st_bf8(base + ((size_t)(b * 2 + g) * SEQ + sq) * 64 + 32 * bj + 8 * fq, acc[ai][bj][m][0], acc[ai][bj][m][1]); }
        } else if (nb < 1280) {
            bf16* base = (bf16*)(ws + (nb < 1024 ? WS_VST : WS_VWT)); const int g = (nb >> 6) & 1;
#pragma unroll
            for (int ai = 0; ai < 2; ++ai)
#pragma unroll
                for (int m = 0; m < 4; ++m) { const int tok = 256 * u.pm + 128 * ai + 64 * wr + 16 * m + fr, b = tok / SEQ, sq = tok % SEQ;
                    bf16* p = base + ((size_t)(b * 2 + g) * NCH + (sq >> 6)) * 4096 + (sq & 63);
#pragma unroll
                    for (int bj = 0; bj < 2; ++bj)
#pragma unroll
                        for (int n = 0; n < 2; ++n)
#pragma unroll
                            for (int r = 0; r < 4; ++r) p[(32 * bj + 8 * fq + 4 * n + r) * 64] = (bf16)f2bf(acc[ai][bj][m][n][r]); }
        } else if (nb < 3328) {
            const int sec = (nb - 1280) >> 9, cc = (nb - 1280) & 511, hh = cc >> 7, d0 = cc & 127;
            f32x4 lbv[2][2];
            if (sec == 1) {
#pragma unroll
                for (int bj = 0; bj < 2; ++bj)
#pragma unroll
                    for (int n = 0; n < 2; ++n) lbv[bj][n] = *(const f32x4*)((const float*)(ws + WS_LB) + li * 512 + cc + 32 * bj + 8 * fq + 4 * n); }
#pragma unroll
            for (int ai = 0; ai < 2; ++ai)
#pragma unroll
                for (int m = 0; m < 4; ++m) { const int tok = 256 * u.pm + 128 * ai + 64 * wr + 16 * m + fr, b = tok / SEQ, sq = tok % SEQ;
                    const size_t hrow = ((size_t)(b * 4 + hh) * SEQ + sq) * 128 + d0;
#pragma unroll
                    for (int bj = 0; bj < 2; ++bj) { const int d = 32 * bj + 8 * fq; f32x4 o0, o1;
                        if (sec == 0) {
#pragma unroll
                            for (int r = 0; r < 4; ++r) { o0[r] = siluf(acc[ai][bj][m][0][r]); o1[r] = siluf(acc[ai][bj][m][1][r]); }
                            st_bf8((bf16*)(ws + WS_HQ) + hrow + d, o0, o1); }
                        else if (sec == 1) {
#pragma unroll
                            for (int r = 0; r < 4; ++r) { o0[r] = lbv[bj][0][r] + (1.0f - lbv[bj][0][r]) * sigm(acc[ai][bj][m][0][r]); o1[r] = lbv[bj][1][r] + (1.0f - lbv[bj][1][r]) * sigm(acc[ai][bj][m][1][r]); }
                            float* pf = (float*)(ws + WS_HF) + hrow + d; *(f32x4*)pf = o0; *(f32x4*)(pf + 4) = o1; }
                        else if (sec == 2) st_bf8((bf16*)(ws + WS_HV) + hrow + d, acc[ai][bj][m][0], acc[ai][bj][m][1]);
                        else {
#pragma unroll
                            for (int r = 0; r < 4; ++r) { o0[r] = siluf(acc[ai][bj][m][0][r]); o1[r] = siluf(acc[ai][bj][m][1][r]); }
                            st_bf8((bf16*)(ws + WS_HGS) + (size_t)tok * 512 + cc + d, o0, o1); } } }
        } else {
            float* dst = (float*)(ws + WS_GATE);
            if (fq < 3) {
#pragma unroll
                for (int ai = 0; ai < 2; ++ai)
#pragma unroll
                    for (int m = 0; m < 4; ++m) { const int tok = 256 * u.pm + 128 * ai + 64 * wr + 16 * m + fr; f32x4 o0, o1;
#pragma unroll
                        for (int r = 0; r < 4; ++r) { o0[r] = sigm(acc[ai][0][m][0][r]); o1[r] = sigm(acc[ai][0][m][1][r]); }
                        float* pf = dst + (size_t)tok * 24 + 8 * fq; *(f32x4*)pf = o0; *(f32x4*)(pf + 4) = o1; } }
        }
    }
};

DEV void tr_tile(unsigned char* smem, const float* src0, const float* src1, int ld, int K, int mode, bf16* dst, int n0, int k0) {
    bf16* tl = (bf16*)smem;
    const int tid = TID;
    SYNC();
#pragma unroll
    for (int i = 0; i < 8; ++i) {
        const int e = tid + 512 * i, kk = e >> 6, nn = e & 63, n = n0 + nn; float v = 0.f;
        if (mode == 0) v = src0[(size_t)(k0 + kk) * ld + n];
        else if (mode == 1) { int sc = n < 1280 ? n : (n < 3328 ? n + 24 : (n < 3352 ? 1280 + (n - 3328) : -1)); if (sc >= 0) v = src0[(size_t)(k0 + kk) * ld + sc]; }
        else { const int g = n >> 6, w = n & 63; v = (w < 32) ? src0[(size_t)(k0 + kk) * ld + g * 32 + w] : src1[(size_t)(k0 + kk) * ld + g * 32 + w - 32]; }
        tl[nn * LDT + kk] = (bf16)f2bf(v);
    }
    SYNC();
    const int nn = tid >> 3, k8 = (tid & 7) * 8;
    *(bf16x8*)(dst + (size_t)(n0 + nn) * K + k0 + k8) = *(const bf16x8*)(tl + nn * LDT + k8);
}

DEV int tr_col(int mode, int n) {
    if (mode == 0) return n;
    const int pn = n >> 8, ct = n & 255;
    if (mode == 5) { const int bj = ct >> 7, wc = (ct >> 5) & 3, j = ct & 31, L = 256 * pn + 64 * wc + 32 * bj + j; return L < 1280 ? L : (L < 3328 ? L + 24 : (L < 3352 ? 1280 + (L - 3328) : -1)); }
    { const int bj = ct >> 7, wc = (ct >> 5) & 3, j = ct & 31, nn = (j >> 2) & 1, Lc = 128 * pn + 64 * bj + 16 * wc + 4 * (j >> 3) + (j & 3); return nn == 0 ? Lc : DM + Lc; }
}
DEV void tr_tile(unsigned char* smem, const float* src, int ld, int K, int mode, bf16* dst, int n0, int k0) {
    bf16* tl = (bf16*)smem;
    const int tid = TID;
    SYNC();
    { const int nn = tid & 63, n = n0 + nn, sc = tr_col(mode, n);
#pragma unroll
      for (int i = 0; i < 8; ++i) { const int kk = (tid >> 6) + 8 * i; const float v = sc >= 0 ? src[(size_t)(k0 + kk) * ld + sc] : 0.f; tl[nn * LDT + kk] = (bf16)f2bf(v); } }
    SYNC();
    const int nn = tid >> 3, k8 = (tid & 7) * 8;
    *(bf16x8*)(dst + (size_t)(n0 + nn) * K + k0 + k8) = *(const bf16x8*)(tl + nn * LDT + k8);
}
struct TrJob { const float* s; int ld, K, N, mode; bf16* dst; };
DEV void p0_phase(const Args& a, unsigned char* smem) {
    unsigned char* ws = wsp(a); const int tid = TID;
    { int item = BID, base = 0;
      for (int j = 0; j < 8; ++j) { TrJob J; const int i = j & 1;
        if (j < 2) J = {INP(a, I_WIN) + (size_t)i * DM * NIN, NIN, DM, NIN8, 5, (bf16*)(ws + WS_WIN) + (size_t)i * NIN8 * DM};
        else if (j < 4) J = {INP(a, I_WOUT) + (size_t)i * 1024 * DM, DM, 1024, DM, 0, (bf16*)(ws + WS_WOUT) + (size_t)i * DM * 1024};
        else if (j < 6) J = {INP(a, I_PW1) + (size_t)i * DM * 2 * DM, 2 * DM, DM, 2 * DM, 6, (bf16*)(ws + WS_PW1) + (size_t)i * 2 * DM * DM};
        else J = {INP(a, I_PW2) + (size_t)i * DM * DM, DM, DM, DM, 0, (bf16*)(ws + WS_PW2) + (size_t)i * DM * DM};
        const int tn = J.N / 64, tk = J.K / 64, nt = tn * tk;
        while (item < base + nt) { const int it = item - base; tr_tile(smem, J.s, J.ld, J.K, J.mode, J.dst, (it % tn) * 64, (it / tn) * 64); item += NBLK; }
        base += nt; }
      SYNC(); }
    {
        float* red = (float*)smem;
        constexpr int NG = 6 * DM / 128; const int ntask = DEPTH * NG;
        for (int t = BID; t < ntask; t += NBLK) {
            const int l = t / NG, j0 = (t % NG) * 128, cq = tid & 31, kr = tid >> 5;
            const float* w = INP(a, I_ADAW) + (size_t)l * DM * 6 * DM + j0 + 4 * cq; const float* cc = INP(a, I_C);
            f32x4 a0 = f4zero(), a1 = f4zero();
#pragma unroll 8
            for (int i = 0; i < DM / 16; ++i) { const int k = kr + 16 * i; const f32x4 wv = *(const f32x4*)(w + (size_t)k * 6 * DM); const float s0 = siluf(cc[k]), s1 = siluf(cc[DM + k]);
#pragma unroll
                for (int r = 0; r < 4; ++r) { a0[r] += s0 * wv[r]; a1[r] += s1 * wv[r]; } }
            SYNC();
            *(f32x4*)(red + (kr * 2 + 0) * 128 + 4 * cq) = a0; *(f32x4*)(red + (kr * 2 + 1) * 128 + 4 * cq) = a1;
            SYNC();
            if (tid < 256) { const int b = tid >> 7, col = tid & 127; float sum = INP(a, I_ADAB)[(size_t)l * 6 * DM + j0 + col];
#pragma unroll
                for (int q = 0; q < 16; ++q) sum += red[(q * 2 + b) * 128 + col];
                ((float*)(ws + WS_MOD))[((size_t)l * 2 + b) * 6 * DM + j0 + col] = sum; }
        }
    }
    for (int t = BID; t < 32; t += NBLK) {
        float* red = (float*)smem; const int ikv = t >> 3, kp = t & 7, i = ikv >> 1, kv = ikv & 1, e = tid & 63, ks = tid >> 6;
        const float* W = INP(a, kv ? I_CWV : I_CWK) + (size_t)i * 2048 * 64 + e; const float* pe = INP(a, I_CPE) + (size_t)i * 2048;
        float sum = 0.f;
#pragma unroll 8
        for (int q = 0; q < 32; ++q) { const int k = kp * 256 + ks * 32 + q; sum += pe[k] * W[(size_t)k * 64]; }
        SYNC(); red[ks * 64 + e] = sum; SYNC();
        if (tid < 64) { float v = 0.f; for (int q = 0; q < 8; ++q) v += red[q * 64 + tid]; ((float*)(ws + WS_CB))[(ikv * 8 + kp) * 64 + tid] = v; }
    }
    for (int i = BID * NT + tid; i < DEPTH * 48 * DM; i += NBLK * NT) { const int k = i % DM, n = (i / DM) % 48, ll = i / (48 * DM);
        const float wv = n < 4 ? INP(a, I_WG)[((size_t)ll * DM + k) * 4 + n] : (n < 36 ? INP(a, I_WE)[((size_t)ll * DM + k) * 32 + n - 4] : 0.f);
        const unsigned hi = f2bf(wv); ((bf16*)(ws + WS_WTH))[i] = (bf16)hi; ((bf16*)(ws + WS_WTL))[i] = (bf16)f2bf(wv - bf2f(hi)); }
    if (BID == 0) {
        for (int i = tid; i < DEPTH * 32; i += NT) ((int*)(ws + WS_CNT))[i * 64] = 0;
        for (int n = tid; n < 512; n += NT) { const float l0 = INP(a, I_LBL)[n], l1 = INP(a, I_LBL)[512 + n]; const float m = fmaxf(l0, l1);
            const float e0 = fexp2((l0 - m) * LOG2E), e1 = fexp2((l1 - m) * LOG2E);
            ((float*)(ws + WS_LB))[n] = 0.f; ((float*)(ws + WS_LB))[512 + n] = e1 / (e0 + e1); }
        if (tid < 2) { const int i = tid; float mq = 0.f; for (int d = 0; d < 64; ++d) mq = fmaxf(mq, fabsf(INP(a, I_QG)[i * 64 + d]));
            for (int br = 0; br < 3; ++br) { float mk = 0.f; for (int d = 0; d < 64; ++d) mk = fmaxf(mk, fabsf(INP(a, I_KG)[(i * 3 + br) * 64 + d]));
                ((float*)(ws + WS_CS))[i * 4 + br] = 8.0f * mq * mk * LOG2E; } }
    }
}

constexpr int NJV = DM / 256;
DEV void moe_bases(const int* cnt, int* rb  ) {
    if (TID == 0) { int acc = 0; for (int e = 0; e < 32; ++e) { rb[e] = acc; acc += ((cnt[e * 64] + 255) >> 8) << 8; } rb[32] = acc; }
    SYNC();
}
DEV void norm_phase(const Args& a, unsigned char* smem, int l) {
    unsigned char* ws = wsp(a); const int tid = TID, w = tid >> 6, lane = tid & 63;
    int* rb = (int*)smem;
    if (l > 0) moe_bases((const int*)(ws + WS_CNT) + (l - 1) * 32 * 64, rb);
    const float* mod = (const float*)(ws + WS_MOD);
    const bf16* yk = (const bf16*)(ws + WS_YK);
    if (l < DEPTH) {
        const int bid = BID % 76 == BID ? BID : -1;
        for (int job = BID; job < 76; job += NBLK) {
            if (job < 72) { const int b = job / 36, n = job % 36; float sum = 0.f;
                for (int k = tid; k < DM; k += NT) { const float wv = n < 4 ? INP(a, I_WG)[((size_t)l * DM + k) * 4 + n] : INP(a, I_WE)[((size_t)l * DM + k) * 32 + n - 4]; sum += mod[((size_t)l * 2 + b) * 6 * DM + 3 * DM + k] * wv; }
#pragma unroll
                for (int q = 1; q < 64; q <<= 1) sum += shflx(sum, q);
                float* red = (float*)(smem + 1024);
                SYNC(); if (lane == 0) red[w] = sum; SYNC();
                if (tid == 0) { float t = 0.f; for (int q = 0; q < 8; ++q) t += red[q]; ((float*)(ws + WS_RBIAS))[((size_t)l * 2 + b) * 48 + n] = t; }
            } else { const float* nf = INP(a, I_NFFN) + (size_t)l * DM; const int part = job - 72;
                for (int i = part * (2 * DM / 4) + tid; i < (part + 1) * (2 * DM / 4); i += NT) { const int b = i / DM, k = i % DM; ((float*)(ws + WS_AVEC))[((size_t)l * 2 + b) * DM + k] = nf[k] * (1.0f + mod[((size_t)l * 2 + b) * 6 * DM + 4 * DM + k]); } }
        }
        (void)bid;
    }
    for (int row = BID * 8 + w; row < T; row += NBLK * 8) {
        const int b = row / SEQ;
        f32x4 v[NJV];
        const float* xin = (l == 0) ? INP(a, I_X) : outp(a);
#pragma unroll
        for (int j = 0; j < NJV; ++j) v[j] = *(const f32x4*)(xin + (size_t)row * DM + 4 * lane + 256 * j);
        if (l > 0) {
            const int* tie = (const int*)(ws + WS_TIE) + (size_t)row * 2; const float* tiw = (const float*)(ws + WS_TIW) + (size_t)row * 2;
            const int e0 = tie[0] >> 14, p0 = tie[0] & 16383, e1 = tie[1] >> 14, p1 = tie[1] & 16383;
            const float w0 = tiw[0], w1 = tiw[1];
            const bf16* y0 = yk + (size_t)(rb[e0] + p0) * DM; const bf16* y1 = yk + (size_t)(rb[e1] + p1) * DM;
            const float* gf = mod + ((size_t)(l - 1) * 2 + b) * 6 * DM + 5 * DM;
#pragma unroll
            for (int j = 0; j < NJV; ++j) { const int cidx = 4 * lane + 256 * j; u32x2 q0 = *(const u32x2*)(y0 + cidx), q1 = *(const u32x2*)(y1 + cidx);
                f32x4 g = *(const f32x4*)(gf + cidx);
                v[j][0] += g[0] * (w0 * bf2f(q0[0] & 0xffff) + w1 * bf2f(q1[0] & 0xffff));
                v[j][1] += g[1] * (w0 * bf2f(q0[0] >> 16) + w1 * bf2f(q1[0] >> 16));
                v[j][2] += g[2] * (w0 * bf2f(q0[1] & 0xffff) + w1 * bf2f(q1[1] & 0xffff));
                v[j][3] += g[3] * (w0 * bf2f(q0[1] >> 16) + w1 * bf2f(q1[1] >> 16)); }
        }
#pragma unroll
        for (int j = 0; j < NJV; ++j) *(f32x4*)(outp(a) + (size_t)row * DM + 4 * lane + 256 * j) = v[j];
        if (l == DEPTH) continue;
        float ss = 0.f;
#pragma unroll
        for (int j = 0; j < NJV; ++j) ss += v[j][0] * v[j][0] + v[j][1] * v[j][1] + v[j][2] * v[j][2] + v[j][3] * v[j][3];
#pragma unroll
        for (int o = 1; o < 64; o <<= 1) ss += shflx(ss, o);
        const float rs = frsq(ss * (1.0f / DM) + EPS);
        const float* mm = mod + ((size_t)l * 2 + b) * 6 * DM; const float* nm = INP(a, I_NMIX) + (size_t)l * DM;
        bf16* hb = (bf16*)(ws + WS_H) + (size_t)row * DM;
#pragma unroll
        for (int j = 0; j < NJV; ++j) { const int cidx = 4 * lane + 256 * j; f32x4 g = *(const f32x4*)(nm + cidx), sh = *(const f32x4*)(mm + cidx), sc = *(const f32x4*)(mm + DM + cidx), o;
#pragma unroll
            for (int r = 0; r < 4; ++r) o[r] = v[j][r] * rs * g[r] * (1.0f + sc[r]) + sh[r];
            st_bf4(hb + cidx, o); }
    }
}

DEV void route_phase(const Args& a, unsigned char* smem, int l) {
    unsigned char* ws = wsp(a); const int tid = TID, w = tid >> 6, lane = tid & 63, h = lane >> 4, c = lane & 15, pi = w >> 1, kh = w & 1;
    constexpr int CH = DM / 2, WLD = CH + 8, NKS = CH / 2 / 32;
    bf16* WHl = (bf16*)smem; bf16* WLl = WHl + 48 * WLD;
    float* lg = (float*)(WLl + 48 * WLD);
    float* ssb = lg + 4 * 2 * 16 * 48;
    float* rsb = ssb + 4 * 2 * 16;
    int* lcnt = (int*)(rsb + 64); int* lbase = lcnt + 32; int* tinfo = lbase + 32;
    SYNC();
    if (tid < 32) lcnt[tid] = 0;
    SYNC();
    const float* mod = (const float*)(ws + WS_MOD);
    const bf16* WH = (const bf16*)(ws + WS_WTH) + (size_t)l * 48 * DM; const bf16* WL = (const bf16*)(ws + WS_WTL) + (size_t)l * 48 * DM;
    int* cnt = (int*)(ws + WS_CNT) + l * 32 * 64;
    constexpr int KH = DM / 2;
    for (int pass0 = BID; pass0 < T / 16; pass0 += 4 * NBLK) {
        const int pass = pass0 + pi * NBLK; const bool valid = pass < T / 16;
        const int tok = valid ? pass * 16 + c : 0, b = tok / SEQ;
        const float* xr = outp(a) + (size_t)tok * DM + kh * KH + 8 * h;
        const float* av = (const float*)(ws + WS_AVEC) + ((size_t)l * 2 + b) * DM + kh * KH + 8 * h;
        const float* cv = mod + ((size_t)l * 2 + b) * 6 * DM + 3 * DM + kh * KH + 8 * h;
        f32x4 acc[3] = {f4zero(), f4zero(), f4zero()}; float ss = 0.f;
#pragma unroll 1
        for (int chn = 0; chn < 2; ++chn) {
            const float* xq = outp(a) + (size_t)tok * DM + chn * CH + kh * (CH / 2) + 8 * h;
            const float* aq = (const float*)(ws + WS_AVEC) + ((size_t)l * 2 + b) * DM + chn * CH + kh * (CH / 2) + 8 * h;
            f32x4 xv[NKS][2], avv[NKS][2];
#pragma unroll
            for (int ks = 0; ks < NKS; ++ks) { xv[ks][0] = *(const f32x4*)(xq + 32 * ks); xv[ks][1] = *(const f32x4*)(xq + 32 * ks + 4); avv[ks][0] = *(const f32x4*)(aq + 32 * ks); avv[ks][1] = *(const f32x4*)(aq + 32 * ks + 4); }
            SYNC();
            for (int i = tid; i < 48 * (CH / 8); i += NT) { const int n = i / (CH / 8), k8 = (i % (CH / 8)) * 8;
                *(bf16x8*)(WHl + n * WLD + k8) = *(const bf16x8*)(WH + (size_t)n * DM + chn * CH + k8); *(bf16x8*)(WLl + n * WLD + k8) = *(const bf16x8*)(WL + (size_t)n * DM + chn * CH + k8); }
            SYNC();
            if (valid) {
                const bf16* whp = WHl + c * WLD + kh * (CH / 2) + 8 * h; const bf16* wlp = WLl + c * WLD + kh * (CH / 2) + 8 * h;
#pragma unroll
                for (int ks = 0; ks < NKS; ++ks) {
                    f32x4 u0, u1, r0, r1;
#pragma unroll
                    for (int r = 0; r < 4; ++r) { u0[r] = xv[ks][0][r] * avv[ks][0][r]; u1[r] = xv[ks][1][r] * avv[ks][1][r]; ss += xv[ks][0][r] * xv[ks][0][r] + xv[ks][1][r] * xv[ks][1][r]; }
                    const bf16x8 uh = pack8(u0, u1);
#pragma unroll
                    for (int r = 0; r < 4; ++r) { r0[r] = u0[r] - bf2f((unsigned short)uh[r]); r1[r] = u1[r] - bf2f((unsigned short)uh[4 + r]); }
                    const bf16x8 ul = pack8(r0, r1);
#pragma unroll
                    for (int nt = 0; nt < 3; ++nt) { const bf16x8 wh = *(const bf16x8*)(whp + nt * 16 * WLD + 32 * ks), wl = *(const bf16x8*)(wlp + nt * 16 * WLD + 32 * ks);
                        acc[nt] = mfma16(wh, uh, acc[nt]); acc[nt] = mfma16(wl, uh, acc[nt]); acc[nt] = mfma16(wh, ul, acc[nt]); }
                }
            }
        }
        if (valid) {
            ss += shflx(ss, 16); ss += shflx(ss, 32);
            float* lgp = lg + ((pi * 2 + kh) * 16 + c) * 48 + 4 * h;
#pragma unroll
            for (int nt = 0; nt < 3; ++nt) *(f32x4*)(lgp + 16 * nt) = acc[nt];
            if (h == 0) ssb[(pi * 2 + kh) * 16 + c] = ss;
        }
        SYNC();
        if (tid < 64) { const int p2 = tid >> 4, tk = tid & 15, pass2 = pass0 + p2 * NBLK;
            if (pass2 < T / 16) { const int tok2 = pass2 * 16 + tk, b2 = tok2 / SEQ;
                const float rs = frsq((ssb[(p2 * 2 + 0) * 16 + tk] + ssb[(p2 * 2 + 1) * 16 + tk]) * (1.0f / DM) + EPS); rsb[p2 * 16 + tk] = rs;
                const float* l0 = lg + ((p2 * 2 + 0) * 16 + tk) * 48; const float* l1 = lg + ((p2 * 2 + 1) * 16 + tk) * 48; const float* rbp = (const float*)(ws + WS_RBIAS) + ((size_t)l * 2 + b2) * 48;
                float acc[36];
#pragma unroll
                for (int n = 0; n < 36; ++n) acc[n] = rs * (l0[n] + l1[n]) + rbp[n];
                int gs = 0; float gm = acc[0];
#pragma unroll
                for (int g = 1; g < 4; ++g) if (acc[g] > gm) { gm = acc[g]; gs = g; }
                float den = 0.f;
#pragma unroll
                for (int g = 0; g < 4; ++g) den += fexp2((acc[g] - gm) * LOG2E);
                const float ggate = 1.0f / den;
                float el[8];
#pragma unroll
                for (int j = 0; j < 8; ++j) { el[j] = acc[4 + j];
#pragma unroll
                    for (int g = 1; g < 4; ++g) if (gs == g) el[j] = acc[4 + 8 * g + j]; }
                int ia = 0; float va = el[0];
#pragma unroll
                for (int j = 1; j < 8; ++j) if (el[j] > va) { va = el[j]; ia = j; }
                int ib = -1; float vb = -3e38f;
#pragma unroll
                for (int j = 0; j < 8; ++j) if (j != ia && el[j] > vb) { vb = el[j]; ib = j; }
                const float wa = 1.0f / (1.0f + fexp2((vb - va) * LOG2E)), wb = 1.0f - wa;
                const int e0 = gs * 8 + ia, e1 = gs * 8 + ib;
                const int p0 = atomic_add_i(lcnt + e0, 1), p1 = atomic_add_i(lcnt + e1, 1);
                int* ti = tinfo + tid * 4;
                ti[0] = (e0 << 14) | p0; ti[1] = (e1 << 14) | p1; ti[2] = __builtin_bit_cast(int, ggate * wa); ti[3] = __builtin_bit_cast(int, ggate * wb);
            } }
        SYNC();
        if (valid) { const float rs = rsb[pi * 16 + c]; bf16* hb = (bf16*)(ws + WS_H) + (size_t)tok * DM + kh * KH + 8 * h;
#pragma unroll 4
            for (int ks = 0; ks < KH / 32; ++ks) {
                const f32x4 x0 = *(const f32x4*)(xr + 32 * ks), x1 = *(const f32x4*)(xr + 32 * ks + 4), a0 = *(const f32x4*)(av + 32 * ks), a1 = *(const f32x4*)(av + 32 * ks + 4), c0 = *(const f32x4*)(cv + 32 * ks), c1 = *(const f32x4*)(cv + 32 * ks + 4);
                f32x4 o0, o1;
#pragma unroll
                for (int r = 0; r < 4; ++r) { o0[r] = x0[r] * rs * a0[r] + c0[r]; o1[r] = x1[r] * rs * a1[r] + c1[r]; }
                st_bf8(hb + 32 * ks, o0, o1); } }
        if (tid < 32) { const int n = lcnt[tid]; lbase[tid] = n > 0 ? atomic_add_i(cnt + tid * 64, n) : 0; lcnt[tid] = 0; }
        SYNC();
        if (tid < 64) { const int p2 = tid >> 4, pass2 = pass0 + p2 * NBLK;
            if (pass2 < T / 16) { const int tok2 = pass2 * 16 + (tid & 15); const int* ti = tinfo + tid * 4;
                const int e0 = ti[0] >> 14, e1 = ti[1] >> 14, p0 = lbase[e0] + (ti[0] & 16383), p1 = lbase[e1] + (ti[1] & 16383);
                int* list = (int*)(ws + WS_LIST); list[(size_t)e0 * T + p0] = tok2; list[(size_t)e1 * T + p1] = tok2;
                int* tie = (int*)(ws + WS_TIE) + (size_t)tok2 * 2; int* tiw = (int*)(ws + WS_TIW) + (size_t)tok2 * 2;
                tie[0] = (e0 << 14) | p0; tie[1] = (e1 << 14) | p1; tiw[0] = ti[2]; tiw[1] = ti[3]; } }
        SYNC();
    }
}

DEV int vbid() { const int g = NBLK; return (g % 8 == 0) ? (BID % 8) * (g / 8) + BID / 8 : BID; }
#ifdef EMU
#define PG8_LDS(p) (p)
#else
#define PG8_LDS(p) ((PG8_LAS unsigned char*)(p))
#endif
DEV void inproj_phase(const Args& a, unsigned char* smem, int li) {
    pg8::Gemm g{(const bf16*)(wsp(a) + WS_H), (const bf16*)(wsp(a) + WS_WIN) + (size_t)li * NIN8 * DM, T, NIN8, DM}; pg8::StaticOrder S; S.init(T, NIN8, NBLK, BID);
    EpiInProj8 E{&a, li};
    SYNC(); pg8::gemm_phase<EpiInProj8, pg8::StaticOrder, true, true>(PG8_LDS(smem), g, S, E); SYNC();
}
DEV void resid_gemm_phase(const Args& a, unsigned char* smem, const bf16* A, int K, const bf16* Bt, int l) {
    pg8::Gemm g{A, Bt, T, DM, K}; pg8::StaticOrder S; S.init(T, DM, NBLK, BID);
    EpiResid8 E{outp(a), (const float*)(wsp(a) + WS_MOD) + (size_t)l * 2 * 6 * DM + 2 * DM};
    SYNC(); pg8::gemm_phase<EpiResid8, pg8::StaticOrder, true, true>(PG8_LDS(smem), g, S, E); SYNC();
}
DEV void pw1_phase(const Args& a, unsigned char* smem, int li) {
    pg8::Gemm g{(const bf16*)(wsp(a) + WS_H), (const bf16*)(wsp(a) + WS_PW1) + (size_t)li * 2 * DM * DM, T, 2 * DM, DM}; pg8::StaticOrder S; S.init(T, 2 * DM, NBLK, BID);
    EpiGlu8 E{(bf16*)(wsp(a) + WS_GLU)};
    SYNC(); pg8::gemm_phase<EpiGlu8, pg8::StaticOrder, true, true>(PG8_LDS(smem), g, S, E); SYNC();
}
DEV void cmp_phase_items(const Args& a, unsigned char* smem, int li, int it) {
    constexpr int TMC = (NCP + 255) / 256;
    const int kv = it / (4 * TMC), bg = (it / TMC) % 4, tm = it % TMC;
    const bf16* src = (const bf16*)(wsp(a) + (kv ? WS_VCG : WS_KCG)) + (size_t)bg * SEQ * 64;
    struct AF { const bf16* base; int m0; MDEV unsigned off(int r) const { int n = m0 + r; if (n > NCMP - 1) n = NCMP - 1; return (unsigned)n * 1024u; } } af{src, tm * 256};
    EpiCmp E{&a, kv, bg, tm * 256, li};
    BClamp64 bf{INP(a, kv ? I_CWV : I_CWK) + (size_t)li * 2048 * 64};
    gemm_tile2(smem, af, bf, 64, 2048, E);
}
DEV void moe_gemm_phase(const Args& a, unsigned char* smem, int l, int mode) {
    unsigned char* ws = wsp(a); const int* cnt = (const int*)(ws + WS_CNT) + l * 32 * 64;
    int* rb = (int*)(smem + GEMM2_LDS);
    moe_bases(cnt, rb);
    const int ntile = rb[32] >> 8;
    constexpr int TN1 = 2 * FF / 128, TN2 = DM / 128;
    const int TN = mode == 0 ? TN1 : TN2;
    const int* list = (const int*)(ws + WS_LIST);
    for (int it = vbid(); it < ntile * TN; it += NBLK) {
        const int rt = it / TN, tn = it % TN; int e = 0;
#pragma unroll 1
        for (int q = 1; q < 32; ++q) if ((rb[q] >> 8) <= rt) e = q;
        const int rloc = (rt << 8) - rb[e], ce = cnt[e * 64], nvalid = (ce - rloc) < 256 ? (ce - rloc) : 256;
        if (mode == 0) {
            struct AF { const bf16* base; const int* lst; int nv; MDEV unsigned off(int r) const { const int rr = r < nv ? r : nv - 1; return (unsigned)lst[rr] * (unsigned)DM; } }
                af{(const bf16*)(ws + WS_H), list + (size_t)e * T + rloc, nvalid};
            EpiGated<1> E{(bf16*)(ws + WS_ACT), (size_t)FF, rt << 8, tn * 128, nvalid};
            BInter bf{INP(a, I_W1) + (size_t)(l * 32 + e) * DM * FF, INP(a, I_W3) + (size_t)(l * 32 + e) * DM * FF, tn * 128};
            gemm_tile2(smem, af, bf, FF, DM, E);
        } else {
            ARows af{(const bf16*)(ws + WS_ACT) + (size_t)(rt << 8) * FF, (size_t)FF};
            EpiStoreBf E{(bf16*)(ws + WS_YK), (size_t)DM, rt << 8, tn * 128, nvalid};
            BPlain bf{INP(a, I_W2) + (size_t)(l * 32 + e) * FF * DM + tn * 128};
            gemm_tile2(smem, af, bf, DM, FF, E);
        }
    }
}

constexpr int AT_K = 0, AT_V = 2 * 64 * LDT * 2, AT_IMP = 2 * AT_V, AT_SEL = AT_IMP + 8 * 8 * 128 * 4, AT_GSEL = AT_SEL + 8 * 8 * 4 * 4, AT_OUT = AT_GSEL + 8 * 2 * 4 * 4, AT_END = AT_OUT + 8 * 32 * 64 * 4;
#ifdef EMU
DEV float rexp2(float x) { return exp2f(x); }
DEV unsigned uni(unsigned x) { return x; }
#else
DEV float rexp2(float x) { return __builtin_amdgcn_exp2f(x); }
DEV unsigned uni(unsigned x) { return (unsigned)__builtin_amdgcn_readfirstlane((int)x); }
#endif
template <int MASK, bool WITH_PV, bool FULL, int GM>
DEV void attn_block(const bf16* Kp, const bf16* Vp, const bf16x8 (&qf)[2][2], int j, const int (&s)[2], const bool (&selbit)[2], float C2, int h, int c,
                    f32x4 (&O)[2][4], f32x4 (&Ol)[2], f32x4 (&pout)[2][2][2]) {
    f32x4 st[2][2][2];
#pragma unroll
    for (int sp = 0; sp < 2; ++sp)
#pragma unroll
        for (int u = 0; u < 2; ++u) { const int krow = 32 * sp + 8 * (c >> 2) + 4 * u + (c & 3);
#pragma unroll
            for (int G = 0; G < 2; ++G) { st[G][sp][u][0] = -C2; st[G][sp][u][1] = -C2; st[G][sp][u][2] = -C2; st[G][sp][u][3] = -C2; }
#pragma unroll
            for (int ks = 0; ks < 2; ++ks) { const bf16x8 kf = *(const bf16x8*)(Kp + krow * LDT + 32 * ks + 8 * h);
#pragma unroll
                for (int G = 0; G < 2; ++G) if (GM & (1 << G)) st[G][sp][u] = mfma16(kf, qf[G][ks], st[G][sp][u]); } }
#pragma unroll
    for (int G = 0; G < 2; ++G) if (GM & (1 << G))
#pragma unroll
        for (int sp = 0; sp < 2; ++sp)
#pragma unroll
            for (int u = 0; u < 2; ++u)
#pragma unroll
                for (int r = 0; r < 4; ++r) { bool ok = selbit[G];
                    if (!FULL) { const int key = 64 * j + 32 * sp + 8 * h + 4 * u + r;
                        if (MASK == 0) ok = 16 * key + 31 <= s[G]; else if (MASK == 1) ok = selbit[G] && key <= s[G]; else ok = key <= s[G] && key > s[G] - 512; }
                    pout[G][sp][u][r] = ok ? rexp2(st[G][sp][u][r]) : 0.f; }
    if (WITH_PV) {
        bf16x8 pb[2][2], ones;
#pragma unroll
        for (int q = 0; q < 8; ++q) ones[q] = (short)0x3F80;
#pragma unroll
        for (int G = 0; G < 2; ++G) if (GM & (1 << G))
#pragma unroll
            for (int sp = 0; sp < 2; ++sp) { pb[G][sp] = pack8(pout[G][sp][0], pout[G][sp][1]); Ol[G] = mfma16(ones, pb[G][sp], Ol[G]); }
#pragma unroll
        for (int et = 0; et < 4; ++et)
#pragma unroll
            for (int sp = 0; sp < 2; ++sp) { const bf16x8 vf = *(const bf16x8*)(Vp + (16 * et + c) * LDT + 32 * sp + 8 * h);
#pragma unroll
                for (int G = 0; G < 2; ++G) if (GM & (1 << G)) O[G][et] = mfma16(vf, pb[G][sp], O[G][et]); }
    }
}

struct ImpState { float invl[2]; float carry[2]; float* imps; int tl, hd, l, s0, qblk; };
template <int MODE>
DEV void attn_branch(bf16* Kl, bf16* Vl, const bf16* kbase, int kstride, const bf16* vbase, int vstride, int jlo, int jhi,
                     const bf16x8 (&qf)[2][2], const int (&s)[2], const unsigned* selm, const unsigned* gselm, float C2, int h, int c, int srow, int scol,
                     f32x4 (&O)[2][4], f32x4 (&Ol)[2], ImpState& im) {
    constexpr bool PV = MODE != 1; constexpr int MASK = MODE <= 1 ? 0 : MODE - 1;
    bf16x8 rk[3], rv[3]; f32x4 pt[2][2][2];
    { const bf16x8 k0 = *(const bf16x8*)(kbase + (size_t)jlo * kstride); *(bf16x8*)(Kl + srow * LDT + scol) = k0;
      if (PV) { const bf16x8 v0 = *(const bf16x8*)(vbase + (size_t)jlo * vstride); *(bf16x8*)(Vl + srow * LDT + scol) = v0; } }
#pragma unroll
    for (int u = 0; u < 3; ++u) { int jj = jlo + 1 + u; if (jj > jhi) jj = jhi; rk[(1 + u) % 3] = *(const bf16x8*)(kbase + (size_t)jj * kstride); if (PV) rv[(1 + u) % 3] = *(const bf16x8*)(vbase + (size_t)jj * vstride); }
    SYNC();
    for (int jb = jlo; jb <= jhi; jb += 3) {
#pragma unroll
        for (int u = 0; u < 3; ++u) { const int j = jb + u;
            if (j <= jhi) {
                const int cur = (j - jlo) & 1;
                bool sb[2] = {true, true}; unsigned gm = 3u;
                if (MODE == 2) { gm = 0u;
#pragma unroll
                    for (int G = 0; G < 2; ++G) { const unsigned wq = uni(gselm[G * 4 + (j >> 5)]), mq = selm[(G * 4 + im.tl) * 4 + (j >> 5)];
                        gm |= ((wq >> (j & 31)) & 1u) << G; sb[G] = (mq >> (j & 31)) & 1u; } }
                bool full;
                if (MODE <= 1) full = 1024 * j + 1039 <= im.s0; else if (MODE == 2) full = j < im.qblk; else full = (j < im.qblk) && (64 * j > im.s0 + 63 - 512);
                const bf16* Kc = Kl + cur * 64 * LDT; const bf16* Vc = Vl + cur * 64 * LDT;
                if (MODE == 2) {
                    if (full) { if (gm == 3u) attn_block<MASK, PV, true, 3>(Kc, Vc, qf, j, s, sb, C2, h, c, O, Ol, pt); else if (gm == 1u) attn_block<MASK, PV, true, 1>(Kc, Vc, qf, j, s, sb, C2, h, c, O, Ol, pt); else if (gm == 2u) attn_block<MASK, PV, true, 2>(Kc, Vc, qf, j, s, sb, C2, h, c, O, Ol, pt); }
                    else { if (gm == 3u) attn_block<MASK, PV, false, 3>(Kc, Vc, qf, j, s, sb, C2, h, c, O, Ol, pt); else if (gm == 1u) attn_block<MASK, PV, false, 1>(Kc, Vc, qf, j, s, sb, C2, h, c, O, Ol, pt); else if (gm == 2u) attn_block<MASK, PV, false, 2>(Kc, Vc, qf, j, s, sb, C2, h, c, O, Ol, pt); }
                } else { if (full) attn_block<MASK, PV, true, 3>(Kc, Vc, qf, j, s, sb, C2, h, c, O, Ol, pt); else attn_block<MASK, PV, false, 3>(Kc, Vc, qf, j, s, sb, C2, h, c, O, Ol, pt); }
                if (MODE == 1) {
#pragma unroll
                    for (int G = 0; G < 2; ++G) {
#pragma unroll
                        for (int sp = 0; sp < 2; ++sp)
#pragma unroll
                            for (int uu = 0; uu < 2; ++uu)
#pragma unroll
                                for (int r = 0; r < 4; ++r) { float p = pt[G][sp][uu][r] * im.invl[G]; p += shflx(p, 1); p += shflx(p, 2); pt[G][sp][uu][r] = p; }
                        const float r0 = shfl(pt[G][0][1][3], (im.l - 16) & 63), r1 = shfl(pt[G][1][1][3], (im.l - 16) & 63);
#pragma unroll
                        for (int sp = 0; sp < 2; ++sp)
#pragma unroll
                            for (int uu = 0; uu < 2; ++uu) { const int m = 16 * j + 8 * sp + 2 * h + uu;
                                float prev; if (uu == 1) prev = pt[G][sp][0][3]; else if (h > 0) prev = sp == 0 ? r0 : r1; else prev = sp == 0 ? im.carry[G] : r0;
                                const float val = 2.0f * (pt[G][sp][uu][0] + pt[G][sp][uu][1] + pt[G][sp][uu][2]) + pt[G][sp][uu][3] + prev;
                                if (im.hd == 0 && m < 128) im.imps[(G * 4 + im.tl) * 128 + m] = val; }
                        im.carry[G] = r1;
                    }
                }
                if (j + 1 <= jhi) {
                    *(bf16x8*)(Kl + (cur ^ 1) * 64 * LDT + srow * LDT + scol) = rk[(u + 1) % 3]; if (PV) *(bf16x8*)(Vl + (cur ^ 1) * 64 * LDT + srow * LDT + scol) = rv[(u + 1) % 3];
                    int jj = j + 4; if (jj > jhi) jj = jhi;
                    rk[(u + 1) % 3] = *(const bf16x8*)(kbase + (size_t)jj * kstride); if (PV) rv[(u + 1) % 3] = *(const bf16x8*)(vbase + (size_t)jj * vstride);
                }
                SYNC();
            }
        }
    }
}

DEV void attn_task(const Args& a, unsigned char* smem, int li, int item) {
    unsigned char* ws = wsp(a); const int tid = TID, w = tid >> 6, l = tid & 63, h = l >> 4, c = l & 15, tl = c >> 2, hd = c & 3;
    const int bg = item & 3, b = bg >> 1, g = bg & 1, tq = (SEQ / 64 - 1) - (item >> 2), s0 = tq * 64, qblk = tq;
    int s[2], row[2];
#pragma unroll
    for (int G = 0; G < 2; ++G) { s[G] = s0 + 8 * w + 4 * G + tl; row[G] = b * SEQ + s[G]; }
    bf16* Kl = (bf16*)(smem + AT_K); bf16* Vl = (bf16*)(smem + AT_V); float* imps = (float*)(smem + AT_IMP) + w * 1024; unsigned* selm = (unsigned*)(smem + AT_SEL) + w * 32;
    bf16x8 qf[2][2]; float gatec[2], gates[2], gatew[2];
#pragma unroll
    for (int G = 0; G < 2; ++G) { const bf16* qp = (const bf16*)(ws + WS_QN) + (size_t)row[G] * 512 + (g * 4 + hd) * 64 + 8 * h; qf[G][0] = *(const bf16x8*)qp; qf[G][1] = *(const bf16x8*)(qp + 32);
        const float* gp = (const float*)(ws + WS_GATE) + (size_t)row[G] * 24 + (g * 4 + hd) * 3; gatec[G] = gp[0]; gates[G] = gp[1]; gatew[G] = gp[2]; }
    const float* cs = (const float*)(ws + WS_CS) + li * 4;
    const int srow = tid >> 3, scol = (tid & 7) * 8;
    for (int i = l; i < 1024; i += 64) imps[i] = 0.f;
    SYNC();
    unsigned* gselm = (unsigned*)(smem + AT_GSEL) + w * 8; float* outl = (float*)(smem + AT_OUT) + w * 2048 + l;
    ImpState im{{0.f, 0.f}, {0.f, 0.f}, imps, tl, hd, l, s0, qblk};
    {
        const int ncv = s0 / 16 + 3, ncb0 = (ncv + 63) >> 6, ncb = ncb0 > NCP / 64 ? NCP / 64 : ncb0;
        const bf16* kcb = (const bf16*)(ws + WS_KC) + (size_t)bg * NCP * 64 + srow * 64 + scol;
        const bf16* vcb = (const bf16*)(ws + WS_VCT) + (size_t)bg * 64 * NCP + (size_t)srow * NCP + scol;
        f32x4 O[2][4], Ol[2] = {f4zero(), f4zero()};
#pragma unroll
        for (int G = 0; G < 2; ++G)
#pragma unroll
            for (int et = 0; et < 4; ++et) O[G][et] = f4zero();
        attn_branch<0>(Kl, Vl, kcb, 4096, vcb, 64, 0, ncb - 1, qf, s, selm, gselm, cs[0], h, c, srow, scol, O, Ol, im);
#pragma unroll
        for (int G = 0; G < 2; ++G) { const float lsum = Ol[G][0]; im.invl[G] = lsum > 0.f ? 1.0f / lsum : 0.f;
#pragma unroll
            for (int et = 0; et < 4; ++et)
#pragma unroll
                for (int r = 0; r < 4; ++r) outl[((G * 4 + et) * 4 + r) * 64] = gatec[G] * im.invl[G] * O[G][et][r]; }
        f32x4 ld[2] = {f4zero(), f4zero()};
        attn_branch<1>(Kl, Vl, kcb, 4096, vcb, 64, 0, ncb - 1, qf, s, selm, gselm, cs[0], h, c, srow, scol, O, ld, im);
    }
    WSYNC();
#pragma unroll 1
    for (int G = 0; G < 2; ++G) {
        const int tk = l >> 4, i = l & 15; float vals[8];
#pragma unroll
        for (int mm = 0; mm < 8; ++mm) { const int jj = i + 16 * mm; vals[mm] = jj > qblk ? NEGV : ((jj == 0 || jj == qblk || jj == qblk - 1) ? FORCEV : imps[(G * 4 + tk) * 128 + jj]); }
        unsigned mk[4] = {0u, 0u, 0u, 0u};
#pragma unroll 1
        for (int rnd = 0; rnd < 16; ++rnd) {
            float best = vals[0]; int bj = i;
#pragma unroll
            for (int mm = 1; mm < 8; ++mm) if (vals[mm] > best) { best = vals[mm]; bj = i + 16 * mm; }
#pragma unroll
            for (int o = 1; o < 16; o <<= 1) { const float ov = shflx(best, o); const int oj = shflxi(bj, o); if (ov > best || (ov == best && oj < bj)) { best = ov; bj = oj; } }
            if (best > NEGV * 0.5f) {
#pragma unroll
                for (int q = 0; q < 4; ++q) if ((bj >> 5) == q) mk[q] |= 1u << (bj & 31); }
            if ((bj & 15) == i) {
#pragma unroll
                for (int mm = 0; mm < 8; ++mm) if ((bj >> 4) == mm) vals[mm] = -3e38f; }
        }
        if (i == 0) {
#pragma unroll
            for (int q = 0; q < 4; ++q) selm[(G * 4 + tk) * 4 + q] = mk[q]; }
    }
    WSYNC();
    if (l < 8) { const int G = l >> 2, q = l & 3; gselm[l] = selm[(G * 4 + 0) * 4 + q] | selm[(G * 4 + 1) * 4 + q] | selm[(G * 4 + 2) * 4 + q] | selm[(G * 4 + 3) * 4 + q]; }
    WSYNC();
#pragma unroll
    for (int br = 0; br < 2; ++br) {
        const bf16* kb = (const bf16*)(ws + (br == 0 ? WS_KS : WS_KW)) + (size_t)bg * SEQ * 64 + tid * 8; const bf16* vb = (const bf16*)(ws + (br == 0 ? WS_VST : WS_VWT)) + (size_t)bg * NCH * 4096 + tid * 8;
        f32x4 O[2][4], Ol[2] = {f4zero(), f4zero()};
#pragma unroll
        for (int G = 0; G < 2; ++G)
#pragma unroll
            for (int et = 0; et < 4; ++et) O[G][et] = f4zero();
        if (br == 0) attn_branch<2>(Kl, Vl, kb, 4096, vb, 4096, 0, qblk, qf, s, selm, gselm, cs[1], h, c, srow, scol, O, Ol, im);
        else attn_branch<3>(Kl, Vl, kb, 4096, vb, 4096, s0 >= 511 ? (s0 - 511) >> 6 : 0, qblk, qf, s, selm, gselm, cs[2], h, c, srow, scol, O, Ol, im);
#pragma unroll
        for (int G = 0; G < 2; ++G) { const float lsum = Ol[G][0]; const float sc = (br == 0 ? gates[G] : gatew[G]) * (lsum > 0.f ? 1.0f / lsum : 0.f);
#pragma unroll
            for (int et = 0; et < 4; ++et)
#pragma unroll
                for (int r = 0; r < 4; ++r) outl[((G * 4 + et) * 4 + r) * 64] += sc * O[G][et][r]; }
    }
#pragma unroll
    for (int G = 0; G < 2; ++G) { bf16* dst = (bf16*)(ws + WS_CAT) + (size_t)row[G] * 1024 + (g * 4 + hd) * 64 + 4 * h;
#pragma unroll
        for (int et = 0; et < 4; ++et) { f32x4 o;
#pragma unroll
            for (int r = 0; r < 4; ++r) o[r] = outl[((G * 4 + et) * 4 + r) * 64];
            st_bf4(dst + 16 * et, o); } }
}

constexpr int LDH = 136;
DEV void hg_cumsum(const float* fsrc  , float* segs  , int d, int seg, float (&f)[16], float (&bc)[16], float& bend, float& bmid) {
    float run = 0.f;
#pragma unroll
    for (int i = 0; i < 16; ++i) { f[i] = fsrc[(size_t)(16 * seg + i) * 128 + d]; run += log2f(f[i]); bc[i] = run; }
    SYNC();
    segs[seg * 128 + d] = run;
    SYNC();
    const float s0 = segs[d], s1 = segs[128 + d], s2 = segs[256 + d], s3 = segs[384 + d];
    const float off = seg == 0 ? 0.f : (seg == 1 ? s0 : (seg == 2 ? s0 + s1 : s0 + s1 + s2));
#pragma unroll
    for (int i = 0; i < 16; ++i) bc[i] += off;
    bend = s0 + s1 + s2 + s3; bmid = s0 + s1;
}
DEV void hg_write16(bf16* dstrow  , const float (&v)[16]) {
    u32x4 w0, w1;
#pragma unroll
    for (int q = 0; q < 4; ++q) { w0[q] = pk2(v[2 * q], v[2 * q + 1]); w1[q] = pk2(v[8 + 2 * q], v[8 + 2 * q + 1]); }
    *(u32x4*)dstrow = w0; *(u32x4*)(dstrow + 8) = w1;
}
DEV void hg_h1_task(const Args& a, unsigned char* smem, int task) {
    unsigned char* ws = wsp(a); const int tid = TID, w = tid >> 6, l = tid & 63, h = l >> 4, c = l & 15, d = tid & 127, seg = tid >> 7;
    const int bh = task / NCH, ch = task % NCH;
    bf16* kT = (bf16*)smem; bf16* vT = kT + 128 * LDT; float* segs = (float*)(vT + 128 * LDT);
    const size_t tokb = (size_t)bh * SEQ + ch * 64;
    float f[16], bc[16], bend, bmid;
    hg_cumsum((const float*)(ws + WS_HF) + tokb * 128, segs, d, seg, f, bc, bend, bmid);
    float kv[16];
#pragma unroll
    for (int i = 0; i < 16; ++i) kv[i] = (1.0f - f[i]) * fexp2(bend - bc[i]);
    hg_write16(kT + d * LDT + 16 * seg, kv);
    const bf16* vs = (const bf16*)(ws + WS_HV) + tokb * 128;
#pragma unroll
    for (int i = 0; i < 16; ++i) kv[i] = bf2f(vs[(size_t)(16 * seg + i) * 128 + d]);
    hg_write16(vT + d * LDT + 16 * seg, kv);
    if (seg == 0) ((float*)(ws + WS_GD))[((size_t)bh * NCH + ch) * 128 + d] = fexp2(bend);
    SYNC();
    f32x4 acc[8];
#pragma unroll
    for (int et = 0; et < 8; ++et) acc[et] = f4zero();
#pragma unroll
    for (int ks = 0; ks < 2; ++ks) { const bf16x8 fa = *(const bf16x8*)(kT + (16 * w + c) * LDT + 32 * ks + 8 * h);
#pragma unroll
        for (int et = 0; et < 8; ++et) acc[et] = mfma16(fa, *(const bf16x8*)(vT + (16 * et + c) * LDT + 32 * ks + 8 * h), acc[et]); }
    float* ut = (float*)(ws + WS_UT) + ((size_t)bh * NCH + ch) * 16384;
#pragma unroll
    for (int et = 0; et < 8; ++et) *(f32x4*)(ut + (size_t)(16 * et + c) * 128 + 16 * w + 4 * h) = acc[et];
    SYNC();
}
DEV void hg_scan_task(const Args& a, int sc) {
    unsigned char* ws = wsp(a); const int bh = sc >> 3, q = (sc & 7) * 512 + TID, e = q >> 5, d0 = (q & 31) * 4;
    const float* ut = (const float*)(ws + WS_UT) + (size_t)bh * NCH * 16384 + (size_t)e * 128 + d0;
    const float* gd = (const float*)(ws + WS_GD) + (size_t)bh * NCH * 128 + d0;
    bf16* st = (bf16*)(ws + WS_ST) + (size_t)bh * NCH * 16384 + (size_t)e * 128 + d0;
    f32x4 S = f4zero();
#pragma unroll 4
    for (int ch = 0; ch < NCH; ++ch) { st_bf4(st + (size_t)ch * 16384, S);
        const f32x4 g = *(const f32x4*)(gd + (size_t)ch * 128), u = *(const f32x4*)(ut + (size_t)ch * 16384);
#pragma unroll
        for (int r = 0; r < 4; ++r) S[r] = g[r] * S[r] + u[r]; }
}
DEV void hg_h3_task(const Args& a, unsigned char* smem, int li, int task) {
    unsigned char* ws = wsp(a); const int tid = TID, w = tid >> 6, l = tid & 63, h = l >> 4, c = l & 15, d = tid & 127, seg = tid >> 7;
    const int bh = task / NCH, ch = task % NCH, b = bh >> 2, hh = bh & 3;
    bf16* At = (bf16*)smem; bf16* Bt = At + 64 * LDH; bf16* Qt = Bt + 64 * LDH; bf16* vT = Qt + 64 * LDH; float* segs = (float*)(vT + 128 * LDT); float* part = segs + 512;
    const size_t tokb = (size_t)bh * SEQ + ch * 64;
    float f[16], bc[16], bend, bmid;
    hg_cumsum((const float*)(ws + WS_HF) + tokb * 128, segs, d, seg, f, bc, bend, bmid);
    const bf16* qs = (const bf16*)(ws + WS_HQ) + tokb * 128; const bf16* vs = (const bf16*)(ws + WS_HV) + tokb * 128;
    float vv[16];
#pragma unroll
    for (int i = 0; i < 16; ++i) { const int t = 16 * seg + i; const float q = bf2f(qs[(size_t)t * 128 + d]);
        At[t * LDH + d] = (bf16)f2bf(q * fexp2(bc[i] - bmid)); Bt[t * LDH + d] = (bf16)f2bf((1.0f - f[i]) * fexp2(bmid - bc[i])); Qt[t * LDH + d] = (bf16)f2bf(q * fexp2(bc[i]));
        vv[i] = bf2f(vs[(size_t)t * 128 + d]); }
    hg_write16(vT + d * LDT + 16 * seg, vv);
    SYNC();
    const int tt = w & 3, eh = w >> 2;
    f32x4 O[4];
#pragma unroll
    for (int et = 0; et < 4; ++et) O[et] = f4zero();
#pragma unroll
    for (int sp = 0; sp < 2; ++sp) {
        if (32 * sp > 16 * tt + 15) continue;
        f32x4 st[2];
#pragma unroll
        for (int u = 0; u < 2; ++u) { st[u] = f4zero(); const int krow = 32 * sp + 8 * (c >> 2) + 4 * u + (c & 3);
#pragma unroll
            for (int ks = 0; ks < 4; ++ks) st[u] = mfma16(*(const bf16x8*)(Bt + krow * LDH + 32 * ks + 8 * h), *(const bf16x8*)(At + (16 * tt + c) * LDH + 32 * ks + 8 * h), st[u]);
#pragma unroll
            for (int r = 0; r < 4; ++r) { const int sk = 32 * sp + 8 * h + 4 * u + r; if (sk > 16 * tt + c) st[u][r] = 0.f; } }
        const bf16x8 pb = pack8(st[0], st[1]);
#pragma unroll
        for (int et = 0; et < 4; ++et) O[et] = mfma16(*(const bf16x8*)(vT + (64 * eh + 16 * et + c) * LDT + 32 * sp + 8 * h), pb, O[et]);
    }
    const bf16* stp = (const bf16*)(ws + WS_ST) + ((size_t)bh * NCH + ch) * 16384;
#pragma unroll
    for (int ks = 0; ks < 4; ++ks) { const bf16x8 fq = *(const bf16x8*)(Qt + (16 * tt + c) * LDH + 32 * ks + 8 * h);
#pragma unroll
        for (int et = 0; et < 4; ++et) O[et] = mfma16(*(const bf16x8*)(stp + (size_t)(64 * eh + 16 * et + c) * 128 + 32 * ks + 8 * h), fq, O[et]); }
    float ss = 0.f;
#pragma unroll
    for (int et = 0; et < 4; ++et)
#pragma unroll
        for (int r = 0; r < 4; ++r) ss += O[et][r] * O[et][r];
    ss += shflx(ss, 16); ss += shflx(ss, 32);
    if (h == 0) part[eh * 64 + 16 * tt + c] = ss;
    SYNC();
    const float rs = frsq((part[16 * tt + c] + part[64 + 16 * tt + c]) * (1.0f / 128.0f) + EPS);
    const int tok = b * SEQ + ch * 64 + 16 * tt + c;
    const float* og = INP(a, I_OG) + li * 128; const bf16* hg = (const bf16*)(ws + WS_HGS) + (size_t)tok * 512 + hh * 128;
    bf16* dst = (bf16*)(ws + WS_CAT) + (size_t)tok * 1024 + 512 + hh * 128;
#pragma unroll
    for (int et = 0; et < 4; ++et) { const int e = 64 * eh + 16 * et + 4 * h; f32x4 o;
#pragma unroll
        for (int r = 0; r < 4; ++r) o[r] = O[et][r] * rs * og[e + r] * bf2f(hg[e + r]);
        st_bf4(dst + e, o); }
    SYNC();
}

DEV void conv_task(const Args& a, unsigned char* smem, int li, int task) {
    unsigned char* ws = wsp(a); const int tid = TID, w = tid >> 6, lane = tid & 63;
    const bool act = tid < DM / 2; const int c0 = act ? 2 * tid : 0;
    const int t0 = task * 16, b = t0 / SEQ, s0 = t0 % SEQ;
    float* red = (float*)smem;
    const float* dw = INP(a, I_DW) + (size_t)li * 31 * DM + c0;
    float acc[16][2];
    const float b0 = INP(a, I_DWB)[li * DM + c0], b1 = INP(a, I_DWB)[li * DM + c0 + 1];
#pragma unroll
    for (int t = 0; t < 16; ++t) { acc[t][0] = b0; acc[t][1] = b1; }
    const bf16* glu = (const bf16*)(ws + WS_GLU) + (size_t)b * SEQ * DM + c0;
    unsigned uu[46];
    { const bf16* gp = glu + (size_t)(s0 - 30) * DM;
#pragma unroll
    for (int r = 0; r < 46; ++r) { const int si = s0 + r - 30; uu[r] = si >= 0 ? *(const unsigned*)gp : 0u; gp += DM; OPAQUE(gp); } }
    const float* dwp = dw;
#pragma unroll
    for (int j = 0; j < 31; ++j) { const float w0 = dwp[0], w1 = dwp[1]; dwp += DM; OPAQUE(dwp);
#pragma unroll
        for (int t = 0; t < 16; ++t) { const unsigned q = uu[t + j]; acc[t][0] += w0 * bf2f(q & 0xffff); acc[t][1] += w1 * bf2f(q >> 16); } }
    float mean[16], rstd[16];
    SYNC();
#pragma unroll
    for (int t = 0; t < 16; ++t) { float s = act ? acc[t][0] + acc[t][1] : 0.f;
#pragma unroll
        for (int o = 1; o < 64; o <<= 1) s += shflx(s, o);
        if (lane == 0) red[w * 16 + t] = s; }
    SYNC();
#pragma unroll
    for (int t = 0; t < 16; ++t) { float s = 0.f;
#pragma unroll
        for (int q = 0; q < 8; ++q) s += red[q * 16 + t];
        mean[t] = s * (1.0f / DM); }
    SYNC();
#pragma unroll
    for (int t = 0; t < 16; ++t) { const float d0 = acc[t][0] - mean[t], d1 = acc[t][1] - mean[t]; float s = act ? d0 * d0 + d1 * d1 : 0.f;
#pragma unroll
        for (int o = 1; o < 64; o <<= 1) s += shflx(s, o);
        if (lane == 0) red[w * 16 + t] = s; }
    SYNC();
#pragma unroll
    for (int t = 0; t < 16; ++t) { float s = 0.f;
#pragma unroll
        for (int q = 0; q < 8; ++q) s += red[q * 16 + t];
        rstd[t] = frsq(s * (1.0f / DM) + EPS); }
    if (act) {
        const float g0 = INP(a, I_LNG)[li * DM + c0], g1 = INP(a, I_LNG)[li * DM + c0 + 1], e0 = INP(a, I_LNB)[li * DM + c0], e1 = INP(a, I_LNB)[li * DM + c0 + 1];
        bf16* dst = (bf16*)(ws + WS_CAT) + (size_t)t0 * DM + c0;
#pragma unroll
        for (int t = 0; t < 16; ++t) { const float y0 = (acc[t][0] - mean[t]) * rstd[t] * g0 + e0, y1 = (acc[t][1] - mean[t]) * rstd[t] * g1 + e1;
            *(unsigned*)(dst + (size_t)t * DM) = pk2(siluf(y0), siluf(y1)); }
    }
}

constexpr int N_PHASES = 1 + 16 * (DEPTH / 2) + 1;
DEV void phase_decode(int ph, int& l, int& sub) {
    const int q = ph - 1, pair = q >> 4, r = q & 15;
    if (r < 9) { l = 2 * pair; sub = r; } else { l = 2 * pair + 1; const int rr = r - 9; sub = rr < 3 ? rr : rr + 2; }
}
constexpr int LDS_BYTES = 150 * 1024;

DEV void run_phase(const Args& a, unsigned char* smem, int ph) {
#ifndef ONLY
#define ONLY -1
#endif
#define EN(k) (ONLY < 0 || ONLY == (k))
    if (ph == 0) { if (EN(100)) p0_phase(a, smem); return; }
    if (ph == N_PHASES - 1) { if (EN(0)) norm_phase(a, smem, DEPTH); return; }
    int l, sub; phase_decode(ph, l, sub); const int li = l >> 1; const bool even = (l & 1) == 0;
    unsigned char* ws = wsp(a);
    switch (sub) {
    case 0: if (EN(0)) norm_phase(a, smem, l); break;
    case 1: if (even) { if (EN(1)) inproj_phase(a, smem, li); } else { if (EN(11)) pw1_phase(a, smem, li); } break;
    case 2:
        if (even) { constexpr int NCI = 8 * ((NCP + 255) / 256); constexpr int NH1 = 8 * NCH;
            for (int it = BID; it < NCI + NH1; it += NBLK) { if (it < NCI) { if (EN(2)) cmp_phase_items(a, smem, li, it); } else { if (EN(12)) hg_h1_task(a, smem, it - NCI); } } }
        else { for (int it = BID; it < T / 16; it += NBLK) if (EN(13)) conv_task(a, smem, li, it); }
        break;
    case 3:
        if (even) { constexpr int NA = 4 * (SEQ / 64); const int G = NBLK;
            for (int r = 0; r * G < NA; ++r) { const int it = r * G + ((r & 1) ? (G - 1 - BID) : BID); if (it < NA) { if (EN(3)) attn_task(a, smem, li, it); } }
            for (int it = BID; it < 64; it += NBLK) if (EN(14)) hg_scan_task(a, it); }
        break;
    case 4: if (even) { for (int it = BID; it < 8 * NCH; it += NBLK) if (EN(4)) hg_h3_task(a, smem, li, it); } break;
    case 5:
        if (!EN(5)) break;
        if (even) resid_gemm_phase(a, smem, (const bf16*)(ws + WS_CAT), 1024, (const bf16*)(ws + WS_WOUT) + (size_t)li * DM * 1024, l);
        else resid_gemm_phase(a, smem, (const bf16*)(ws + WS_CAT), DM, (const bf16*)(ws + WS_PW2) + (size_t)li * DM * DM, l);
        break;
    case 6: if (EN(6)) route_phase(a, smem, l); break;
    case 7: if (EN(7)) moe_gemm_phase(a, smem, l, 0); break;
    case 8: if (EN(8)) moe_gemm_phase(a, smem, l, 1); break;
    }
}

#ifndef EMU
#define LAS __attribute__((address_space(3)))
#define XB_TMO      128
#define XB_XCNT(j)  (256  + 64 * (j))
#define XB_XSUB(j)  (1280 + 64 * (j))
#define XB_XGEN(j)  (2304 + 64 * (j))
#define XB_TOP      3328
#define XB_TOPGEN   3392
#define XCD_BAR_WORDS 3456
#define XB_SPIN_CAP (1u << 22)
__device__ __forceinline__ unsigned xb_ld(unsigned* p)              { return __hip_atomic_load(p, __ATOMIC_RELAXED, __HIP_MEMORY_SCOPE_AGENT); }
__device__ __forceinline__ unsigned xb_add(unsigned* p, unsigned v) { return __hip_atomic_fetch_add(p, v, __ATOMIC_RELAXED, __HIP_MEMORY_SCOPE_AGENT); }
__device__ __forceinline__ unsigned xb_xcc_id() { return (unsigned)__builtin_amdgcn_s_getreg((3 << 11) | 20) & 0xFu; }
#define XB_SPIN(cond, bar) do { unsigned _sp = 0; while (cond) { __builtin_amdgcn_s_sleep(1); \
    if ((++_sp & 255u) == 0u) { if (xb_ld(&(bar)[XB_TMO])) break; if (_sp > XB_SPIN_CAP) { atomicAdd(&(bar)[XB_TMO], 1u); break; } } } } while (0)
struct XcdBarrier { unsigned* bar; unsigned x; volatile LAS unsigned* st; };
__device__ __forceinline__ XcdBarrier xcd_barrier_post(unsigned* bar, volatile LAS unsigned* st) {
    XcdBarrier b; b.bar = bar; b.x = xb_xcc_id(); b.st = st;
    if (threadIdx.x == 0) (void)xb_add(&bar[XB_XCNT(b.x)], 1u);
    return b;
}
__device__ __forceinline__ void xcd_barrier_complete(unsigned* bar, unsigned x, unsigned& nloc, unsigned& nx) {
    const unsigned G = gridDim.x * gridDim.y * gridDim.z;
    unsigned sum, cnt, mine, sp = 0u;
    for (;;) {
        sum = 0u; cnt = 0u; mine = 0u;
#pragma unroll
        for (unsigned j = 0; j < 16; ++j) { const unsigned c = xb_ld(&bar[XB_XCNT(j)]); sum += c; cnt += (c > 0u) ? 1u : 0u; mine = (j == x) ? c : mine; }
        if (sum == G) break;
        __builtin_amdgcn_s_sleep(1);
        if ((++sp & 255u) == 0u) { if (xb_ld(&bar[XB_TMO])) break; if (sp > XB_SPIN_CAP) { atomicAdd(&bar[XB_TMO], 1u); break; } }
    }
    nloc = mine > 0u ? mine : 1u; nx = cnt > 0u ? cnt : 1u;
}
__device__ __forceinline__ void xcd_barrier(const XcdBarrier& b) {
    asm volatile("s_waitcnt vmcnt(0)" ::: "memory");
    __syncthreads();
    if (threadIdx.x == 0) {
        unsigned* bar = b.bar;
        __builtin_amdgcn_s_waitcnt(0);
        unsigned nloc = b.st[0], nx = b.st[1];
        if (nloc == 0u) { xcd_barrier_complete(bar, b.x, nloc, nx); b.st[0] = nloc; b.st[1] = nx; }
        const unsigned old = xb_add(&bar[XB_XSUB(b.x)], 1u);
        const unsigned gen = old / nloc;
        if (old + 1u == (gen + 1u) * nloc) {
            __builtin_amdgcn_fence(__ATOMIC_RELEASE, "agent");
            asm volatile("s_waitcnt vmcnt(0)" ::: "memory");
            const unsigned og = xb_add(&bar[XB_TOP], 1u);
            const unsigned tg = og / nx;
            if (og + 1u == (tg + 1u) * nx) xb_add(&bar[XB_TOPGEN], 1u);
            else XB_SPIN(xb_ld(&bar[XB_TOPGEN]) == tg, bar);
            __builtin_amdgcn_fence(__ATOMIC_ACQUIRE, "agent");
            xb_add(&bar[XB_XGEN(b.x)], 1u);
            asm volatile("s_waitcnt vmcnt(0)" ::: "memory");
        } else {
            XB_SPIN(xb_ld(&bar[XB_XGEN(b.x)]) == gen, bar);
            __builtin_amdgcn_fence(__ATOMIC_ACQUIRE, "agent");
            asm volatile("s_waitcnt vmcnt(0)" ::: "memory");
        }
    }
    __syncthreads();
}

__global__ void __launch_bounds__(NT, 2) mega(Args a) {
    extern __shared__ __attribute__((aligned(16))) unsigned char lds[];
    volatile LAS unsigned* st = (volatile LAS unsigned*)(LAS unsigned char*)(lds + LDS_BYTES - 16);
    if (threadIdx.x < 4) st[threadIdx.x] = 0u;
    __syncthreads();
    unsigned* barw = (unsigned*)(a.ws + WS_BAR);
    XcdBarrier bar = xcd_barrier_post(barw, st);
#pragma unroll 1
    for (int ph = 0; ph < N_PHASES; ++ph) {
        run_phase(a, lds, ph);
#ifdef DUP
        { int lyr = 0, sub = 100; if (ph > 0 && ph < N_PHASES - 1) phase_decode(ph, lyr, sub);
          if (sub == (DUP % 1000) && (ph == 0 || lyr == DUP / 1000) && ph < N_PHASES - 1) { xcd_barrier(bar); run_phase(a, lds, ph); } }
#endif
        if (ph + 1 < N_PHASES) xcd_barrier(bar);
    }
    if (xb_ld(&barw[XB_TMO]) != 0u) {
        const size_t gt = (size_t)blockIdx.x * NT + threadIdx.x, gs = (size_t)gridDim.x * NT;
        for (size_t i = gt; i < (size_t)T * DM; i += gs) a.out[i] = __builtin_nanf("");
    }
}

extern "C" void kernel_launch(void* const* d_in, const int* in_sizes, int n_in, void* d_out, int out_size,
                              void* d_ws, size_t ws_size, hipStream_t stream) {
    static int grid = 0;
    if (grid == 0) {
        int dev = 0, cus = 0;
        if (hipGetDevice(&dev) != hipSuccess || hipDeviceGetAttribute(&cus, hipDeviceAttributeMultiprocessorCount, dev) != hipSuccess) { grid = -1; return; }
        if (hipFuncSetAttribute((const void*)mega, hipFuncAttributeMaxDynamicSharedMemorySize, LDS_BYTES) != hipSuccess) { grid = -1; return; }
        (void)hipGetLastError();
        grid = cus;
        if (n_in != 26 || out_size != T * DM || ws_size < WS_END) { fprintf(stderr, "kernel_launch: unexpected sizes n_in %d out %d ws %zu (need %zu)\n", n_in, out_size, ws_size, (size_t)WS_END); grid = -1; return; }
    }
    if (grid < 0) return;
    (void)hipMemsetAsync((unsigned char*)d_ws + WS_BAR, 0, XCD_BAR_WORDS * 4, stream);
    Args a{};
    for (int i = 0; i < 26; ++i) a.in[i] = (const float*)d_in[i];
    a.out = (float*)d_out; a.ws = (unsigned char*)d_ws;
    hipLaunchKernelGGL(mega, dim3(grid), dim3(NT), LDS_BYTES, stream, a);
}
#endif
```

```cpp
#ifdef EMU
#include "emu.h"
#define DEV static inline
#define MDEV inline
#define OPAQUE(p)
#define OPAQUE2(a, b)
#define TID emu_tid()
#define BID (EB->bid)
#define NBLK (EB->nblk)
#define SYNC() emu_sync_block()
#define WSYNC() emu_sync_wave()
#define mfma16(a, b, c) emu_mfma16(a, b, c)
DEV float shflx(float v, int m) { return emu_shfl_f(v, (emu_tid() & 63) ^ m); }
DEV int shflxi(int v, int m) { return (int)emu_shfl_u((unsigned)v, (emu_tid() & 63) ^ m); }
DEV float shfl(float v, int s) { return emu_shfl_f(v, s); }
DEV int atomic_add_i(int* p, int v) { return __atomic_fetch_add(p, v, __ATOMIC_RELAXED); }
DEV float fexp2(float x) { return exp2f(x); }
DEV float frcp(float x) { return 1.0f / x; }
DEV float frsq(float x) { return 1.0f / sqrtf(x); }
typedef short s16x4 __attribute__((vector_size(8)));
static inline s16x4 emu_tr4(const unsigned short* p) {
    EmuWave& w = EB->wave[emu_tid() >> 6]; int l = emu_tid() & 63;
    const unsigned short** tab = (const unsigned short**)w.a;
    tab[l] = p; emu_sync_wave();
    s16x4 r; int g = l & 48, i = l & 15;
    for (int q = 0; q < 4; ++q) r[q] = (short)tab[g + 4 * q + (i >> 2)][i & 3];
    emu_sync_wave(); return r;
}
#define tr4(p) emu_tr4(p)
#else
#include <hip/hip_runtime.h>
#include <cstdio>
#include <cstdint>
typedef short bf16x8 __attribute__((ext_vector_type(8)));
typedef float f32x4 __attribute__((ext_vector_type(4)));
typedef unsigned u32x4 __attribute__((ext_vector_type(4)));
typedef unsigned u32x2 __attribute__((ext_vector_type(2)));
#define DEV __device__ __forceinline__
#define MDEV __device__ __forceinline__
#define OPAQUE(p) asm volatile("" : "+v"(p))
#define OPAQUE2(a, b) asm volatile("" : "+v"(a), "+v"(b))
DEV int tid_opaque() { int t = (int)threadIdx.x; asm volatile("" : "+v"(t)); return t; }
#define TID tid_opaque()
DEV int bid_opaque() { int b = (int)blockIdx.x; asm volatile("" : "+s"(b)); return b; }
#define BID bid_opaque()
#define NBLK ((int)gridDim.x)
#define SYNC() __syncthreads()
#define WSYNC() __builtin_amdgcn_wave_barrier()
#define mfma16(a, b, c) __builtin_amdgcn_mfma_f32_16x16x32_bf16(a, b, c, 0, 0, 0)
DEV int shflxi(int x, int m) {
    if (m == 1) return __builtin_amdgcn_update_dpp(x, x, 0xB1, 0xf, 0xf, true);
    if (m == 2) return __builtin_amdgcn_update_dpp(x, x, 0x4E, 0xf, 0xf, true);
    if (m == 4) return __builtin_amdgcn_ds_swizzle(x, (4 << 10) | 0x1F);
    if (m == 8) return __builtin_amdgcn_ds_swizzle(x, (8 << 10) | 0x1F);
    if (m == 16) return __builtin_amdgcn_ds_swizzle(x, (16 << 10) | 0x1F);
    if (m == 32) { const auto r = __builtin_amdgcn_permlane32_swap((unsigned)x, (unsigned)x, false, false); return (int)((threadIdx.x & 32) ? r[0] : r[1]); }
    return __shfl_xor(x, m);
}
DEV float shflx(float v, int m) { return __builtin_bit_cast(float, shflxi(__builtin_bit_cast(int, v), m)); }
DEV float shfl(float v, int s) { return __shfl(v, s); }
DEV int atomic_add_i(int* p, int v) { return atomicAdd(p, v); }
DEV float fexp2(float x) { return __builtin_amdgcn_exp2f(x); }
DEV float frcp(float x) { return __builtin_amdgcn_rcpf(x); }
DEV float frsq(float x) { return __builtin_amdgcn_rsqf(x); }
typedef short s16x4 __attribute__((ext_vector_type(4)));
#define tr4(p) __builtin_amdgcn_ds_read_tr16_b64_v4i16((__attribute__((address_space(3))) s16x4*)(p))
#endif

typedef unsigned short bf16;

#ifndef DM
#define DM 1024
#endif
#ifndef SEQ
#define SEQ 8192
#endif
#ifndef FF
#define FF 512
#endif
constexpr int NBATCH = 2, T = NBATCH * SEQ, DEPTH = 4;
constexpr int NIN = 3352, NINP = 3456, NIN8 = 3584;
constexpr int NT = 512;
constexpr int NCH = SEQ / 64;
constexpr int NCP = SEQ / 16;
constexpr int NCMP = NCP - 1;
constexpr int MOE_ROWS = 2 * T + 32 * 256;
constexpr float EPS = 1e-6f, NEGV = -1e30f, FORCEV = 1e4f, LOG2E = 1.4426950408889634f;

constexpr size_t al(size_t x) { return (x + 255) & ~(size_t)255; }
constexpr size_t WS_BAR = 0;
constexpr size_t WS_CNT = 16384;
constexpr size_t WS_MOD = WS_CNT + (size_t)DEPTH * 32 * 256;
constexpr size_t WS_LB = al(WS_MOD + (size_t)DEPTH * 2 * 6 * DM * 4);
constexpr size_t WS_CB = al(WS_LB + 2 * 512 * 4);
constexpr size_t WS_CS = al(WS_CB + 2 * 2 * 8 * 64 * 4);
constexpr size_t WS_WIN = al(WS_CS + 64);
constexpr size_t WS_WOUT = al(WS_WIN + (size_t)2 * NIN8 * DM * 2);
constexpr size_t WS_PW1 = al(WS_WOUT + (size_t)2 * DM * 1024 * 2);
constexpr size_t WS_PW2 = al(WS_PW1 + (size_t)2 * 2 * DM * DM * 2);
constexpr size_t WS_WC = al(WS_PW2 + (size_t)2 * DM * DM * 2);
constexpr size_t WS_W13 = al(WS_WC + (size_t)2 * 2 * 64 * 2048 * 2);
constexpr size_t WS_W2 = al(WS_W13 + 256);
constexpr size_t WS_H = al(WS_W2 + 256);
constexpr size_t WS_QN = al(WS_H + (size_t)T * DM * 2);
constexpr size_t WS_KCG = al(WS_QN + (size_t)T * 512 * 2);
constexpr size_t WS_VCG = al(WS_KCG + (size_t)T * 128 * 2);
constexpr size_t WS_KS = al(WS_VCG + (size_t)T * 128 * 2);
constexpr size_t WS_KW = al(WS_KS + (size_t)T * 128 * 2);
constexpr size_t WS_VST = al(WS_KW + (size_t)T * 128 * 2);
constexpr size_t WS_VWT = al(WS_VST + (size_t)T * 128 * 2);
constexpr size_t WS_KC = al(WS_VWT + (size_t)T * 128 * 2);
constexpr size_t WS_VCT = al(WS_KC + (size_t)4 * NCP * 64 * 2);
constexpr size_t WS_GATE = al(WS_VCT + (size_t)4 * NCP * 64 * 2);
constexpr size_t WS_HQ = al(WS_GATE + (size_t)T * 24 * 4);
constexpr size_t WS_HF = al(WS_HQ + (size_t)T * 512 * 2);
constexpr size_t WS_HV = al(WS_HF + (size_t)T * 512 * 4);
constexpr size_t WS_HGS = al(WS_HV + (size_t)T * 512 * 2);
constexpr size_t WS_UT = al(WS_HGS + (size_t)T * 512 * 2);
constexpr size_t WS_ST = al(WS_UT + (size_t)8 * NCH * 128 * 128 * 4);
constexpr size_t WS_GD = al(WS_ST + (size_t)8 * NCH * 128 * 128 * 2);
constexpr size_t WS_CAT = al(WS_GD + (size_t)8 * NCH * 128 * 4);
constexpr size_t WS_GLU = al(WS_CAT + (size_t)T * 1024 * 2);
constexpr size_t WS_TIE = al(WS_GLU + (size_t)T * DM * 2);
constexpr size_t WS_TIW = al(WS_TIE + (size_t)T * 2 * 4);
constexpr size_t WS_LIST = al(WS_TIW + (size_t)T * 2 * 4);
constexpr size_t WS_ACT = al(WS_LIST + (size_t)32 * T * 4);
constexpr size_t WS_YK = al(WS_ACT + (size_t)MOE_ROWS * FF * 2);
constexpr size_t WS_WTH = al(WS_YK + (size_t)MOE_ROWS * DM * 2);
constexpr size_t WS_WTL = al(WS_WTH + (size_t)DEPTH * 48 * DM * 2);
constexpr size_t WS_AVEC = al(WS_WTL + (size_t)DEPTH * 48 * DM * 2);
constexpr size_t WS_RBIAS = al(WS_AVEC + (size_t)DEPTH * 2 * DM * 4);
constexpr size_t WS_END = al(WS_RBIAS + (size_t)DEPTH * 2 * 48 * 4);

struct Args { const float* in[26]; float* out; unsigned char* ws; };
enum { I_X = 0, I_C, I_ADAW, I_ADAB, I_NMIX, I_NFFN, I_WIN, I_WOUT, I_CWK, I_CWV, I_CPE, I_QG, I_KG, I_LBL, I_OG,
       I_PW1, I_DW, I_DWB, I_LNG, I_LNB, I_PW2, I_WG, I_WE, I_W1, I_W3, I_W2 };

#ifdef EMU
DEV unsigned char* wsp(const Args& a) { return a.ws; }
DEV float* outp(const Args& a) { return a.out; }
#else
DEV unsigned char* launder_ptr(const void* p) { unsigned long long v = (unsigned long long)p; unsigned lo = (unsigned)v, hi = (unsigned)(v >> 32);
    lo = (unsigned)__builtin_amdgcn_readfirstlane((int)lo); hi = (unsigned)__builtin_amdgcn_readfirstlane((int)hi); asm volatile("" : "+s"(lo), "+s"(hi)); typedef __attribute__((address_space(1))) unsigned char* gptr_t; return (unsigned char*)(gptr_t)(((unsigned long long)hi << 32) | lo); }
DEV unsigned char* wsp(const Args& a) { return launder_ptr(a.ws); }
DEV float* outp(const Args& a) { return (float*)launder_ptr(a.out); }
#endif

#ifdef EMU
#define INP(a, X) ((a).in[X])
#else
DEV int zero_opaque() { int z = 0; asm volatile("" : "+s"(z)); return z; }
#define INP(a, X) ((a).in[(X) + zero_opaque()])
#endif

DEV unsigned f2bf(float f) { unsigned u = __builtin_bit_cast(unsigned, f); return (u + 0x7fffu + ((u >> 16) & 1u)) >> 16; }
DEV float bf2f(unsigned h) { return __builtin_bit_cast(float, h << 16); }
#ifdef EMU
DEV unsigned pk2(float lo, float hi) { return f2bf(lo) | (f2bf(hi) << 16); }
#else
typedef float f32x2_t __attribute__((ext_vector_type(2)));
typedef __bf16 bf16x2_t __attribute__((ext_vector_type(2)));
DEV unsigned pk2(float lo, float hi) { f32x2_t v = {lo, hi}; bf16x2_t b = __builtin_convertvector(v, bf16x2_t); return __builtin_bit_cast(unsigned, b); }
#endif
DEV float sigm(float x) { return frcp(1.0f + fexp2(-x * LOG2E)); }
DEV float siluf(float x) { return x * sigm(x); }
DEV f32x4 f4zero() { f32x4 z = {0.f, 0.f, 0.f, 0.f}; return z; }
DEV bf16x8 pack8(f32x4 a, f32x4 b) {
    u32x4 w; w[0] = pk2(a[0], a[1]); w[1] = pk2(a[2], a[3]); w[2] = pk2(b[0], b[1]); w[3] = pk2(b[2], b[3]);
    return __builtin_bit_cast(bf16x8, w);
}
DEV void st_bf8(bf16* p, f32x4 a, f32x4 b) { u32x4 w; w[0] = pk2(a[0], a[1]); w[1] = pk2(a[2], a[3]); w[2] = pk2(b[0], b[1]); w[3] = pk2(b[2], b[3]); *(u32x4*)p = w; }
DEV void st_bf4(bf16* p, f32x4 v) { u32x2 w; w[0] = pk2(v[0], v[1]); w[1] = pk2(v[2], v[3]); *(u32x2*)p = w; }


#ifdef EMU
namespace pg8 {
constexpr int BM = 256, BK = 64, HALF = 128, NXCD = 8, WGM = 8;
typedef unsigned short bf16_t;
struct Unit { int pm, pn; };
struct Gemm { const bf16_t* A; const bf16_t* Bt; int M, N, K; };
struct StaticOrder {
    int nM, nN, nwg, G, c;
    void init(int M, int N, int G_, int c_) { nM = M / BM; nN = N / BM; nwg = nM * nN; G = G_; c = c_; }
    bool next(int i, Unit& u) const {
        const long L = (long)i * G + c; if (L >= nwg) return false;
        int wgid = (int)L; { const int q = nwg / NXCD, r = nwg % NXCD, xcd = wgid % NXCD, off = wgid / NXCD; wgid = (xcd < r ? xcd * (q + 1) : r * (q + 1) + (xcd - r) * q) + off; }
        const int nig = WGM * nN, gid = wgid / nig, fm = gid * WGM, gsz = (nM - fm) < WGM ? (nM - fm) : WGM;
        u.pm = fm + ((wgid % nig) % gsz); u.pn = (wgid % nig) / gsz; return true;
    }
};
template <class Epi, class Sched, bool ALIGN_EPI = false, bool SP2 = false>
static inline void gemm_phase(unsigned char*, const Gemm g, const Sched& S, const Epi& E) {
    const int tid = emu_tid(), wid = tid >> 6, lane = tid & 63, wr = wid >> 2, wc = wid & 3, fr = lane & 15, fq = lane >> 4;
    Unit u;
    for (int ui = 0; S.next(ui, u); ++ui) {
        f32x4 acc[2][2][4][2];
        for (int ai = 0; ai < 2; ++ai) for (int bj = 0; bj < 2; ++bj) for (int m = 0; m < 4; ++m) for (int n = 0; n < 2; ++n) for (int r = 0; r < 4; ++r) {
            const int row = 256 * u.pm + 128 * ai + 64 * wr + 16 * m + fr, col = 256 * u.pn + 128 * bj + 32 * wc + (Epi::PERM ? 8 * fq + 4 * n + r : 16 * n + 4 * fq + r); float sum = 0.f;
            const bf16_t* ap = g.A + (size_t)row * g.K; const bf16_t* bp = g.Bt + (size_t)col * g.K;
            for (int k = 0; k < g.K; ++k) sum += bf2f(ap[k]) * bf2f(bp[k]);
            acc[ai][bj][m][n][r] = sum; }
        E(acc, u, wr, wc, fr, fq);
    }
    emu_sync_block();
}
}
#else
namespace pg8 {
#define PG8_LAS __attribute__((address_space(3)))
typedef unsigned short bf16_t;
typedef short bf16x8 __attribute__((ext_vector_type(8)));
typedef float f32x4 __attribute__((ext_vector_type(4)));
typedef unsigned u32x4 __attribute__((ext_vector_type(4)));
constexpr int BM = 256, BK = 64, HALF = 128, HTB = HALF * BK * 2  , STAGE_BYTES = 8 * HTB, NXCD = 8, WGM = 8;

__host__ __device__ __forceinline__ int lds_byte(int r, int c) { const int st = (r >> 4) * 2 + (c >> 5), rr = r & 15, cc = c & 31, ob = rr * 64 + cc * 2; return st * 1024 + (ob ^ (((ob >> 9) & 1) << 5)); }
__host__ __device__ __forceinline__ void stage_rc(int b, int& R, int& C) { const int st = b / 1024, sb = b % 1024, swz = sb ^ (((sb >> 9) & 1) << 5); R = (st >> 1) * 16 + swz / 64; C = (st & 1) * 32 + (swz % 64) / 2; }
__host__ __device__ __forceinline__ int perm32(int rho) { const int n = rho >> 4, i = rho & 15; return 8 * (i >> 2) + 4 * n + (i & 3); }

struct Unit { int pm, pn; };
struct Gemm { const bf16_t* A; const bf16_t* Bt; int M, N, K; };

struct StaticOrder {
    int nM, nN, nwg, G, c;
    __host__ __device__ void init(int M, int N, int G_, int c_) { nM = M / BM; nN = N / BM; nwg = nM * nN; G = G_; c = c_; }
    __host__ __device__ bool next(int i, Unit& u) const {
        const long L = (long)i * G + c; if (L >= nwg) return false;
        int wgid = (int)L; { const int q = nwg / NXCD, r = nwg % NXCD, xcd = wgid % NXCD, off = wgid / NXCD; wgid = (xcd < r ? xcd * (q + 1) : r * (q + 1) + (xcd - r) * q) + off; }
        const int nig = WGM * nN, gid = wgid / nig, fm = gid * WGM, gsz = (nM - fm) < WGM ? (nM - fm) : WGM;
        u.pm = fm + ((wgid % nig) % gsz); u.pn = (wgid % nig) / gsz; return true;
    }
    __device__ __forceinline__ void a_ready(const Unit&) const {}
    __device__ __forceinline__ void done(const Unit&) const {}
};

__device__ __forceinline__ unsigned cvt_pk_bf16(float lo, float hi) { unsigned r; asm volatile("v_cvt_pk_bf16_f32 %0, %1, %2" : "=v"(r) : "v"(lo), "v"(hi)); return r; }
template <class Epi, class Sched, bool ALIGN_EPI = false, bool SP2 = false>
__device__ __forceinline__ void gemm_phase(PG8_LAS unsigned char* lds, const Gemm g, const Sched& S, const Epi& E) {
    const int tid = TID, wid = __builtin_amdgcn_readfirstlane(tid >> 6), lane = tid & 63, wr = wid >> 2, wc = wid & 3, fr = lane & 15, fq = lane >> 4;
    const int K = g.K, nt = K / BK;
    unsigned voffA[2], voffB[2];
#pragma unroll
    for (int i = 0; i < 2; ++i) { int R, C; stage_rc(tid * 16 + i * 8192, R, C); const int Rb = Epi::PERM ? ((R & ~31) + perm32(R & 31)) : R;
        voffA[i] = (unsigned)(R * K + C) * 2u; voffB[i] = (unsigned)(Rb * K + C) * 2u; }
    const size_t kstep = (size_t)(BK * 2);
    const size_t hstep = (size_t)HALF * K * 2;
    const size_t tstep = 2 * hstep;
    const unsigned ldsw = (unsigned)wid * 1024u;
    const int aoff = lds_byte(wr * 64 + fr, fq * 8), boff = lds_byte(wc * 32 + fr, fq * 8);
#define PG8_SA(b, h) (((b) * 2 + (h)) * HTB)
#define PG8_SB(b, h) ((4 + (b) * 2 + (h)) * HTB)
#define PG8_STAGE(bufoff, gbase, voff) do { _Pragma("unroll") for (int _i = 0; _i < 2; ++_i) \
        __builtin_amdgcn_global_load_lds((const unsigned*)((const char*)(gbase) + (voff)[_i]), (PG8_LAS unsigned*)(lds + (bufoff) + ldsw + _i * 8192), 16, 0, 0); } while (0)
#define PG8_LDA(dst, b, h) do { _Pragma("unroll") for (int m = 0; m < 4; ++m) _Pragma("unroll") for (int k = 0; k < 2; ++k) dst[m][k] = *(const PG8_LAS bf16x8*)(lds + PG8_SA(b, h) + aoff + m * 2048 + k * 1024); } while (0)
#define PG8_LDB(dst, b, h) do { _Pragma("unroll") for (int n = 0; n < 2; ++n) _Pragma("unroll") for (int k = 0; k < 2; ++k) dst[n][k] = *(const PG8_LAS bf16x8*)(lds + PG8_SB(b, h) + boff + n * 2048 + k * 1024); } while (0)
#define PG8_MMA(ai, bj, At, Bt) do { __builtin_amdgcn_s_setprio(1); _Pragma("unroll") for (int m = 0; m < 4; ++m) _Pragma("unroll") for (int n = 0; n < 2; ++n) _Pragma("unroll") for (int k = 0; k < 2; ++k) \
        acc[ai][bj][m][n] = __builtin_amdgcn_mfma_f32_16x16x32_bf16(Bt[n][k], At[m][k], acc[ai][bj][m][n], 0, 0, 0); __builtin_amdgcn_s_setprio(0); } while (0)
#define PG8_WAIT_V(n) asm volatile("s_waitcnt vmcnt(" #n ")" ::: "memory")
#define PG8_WAIT_L(n) asm volatile("s_waitcnt lgkmcnt(" #n ")" ::: "memory")
#define PG8_BAR __builtin_amdgcn_s_barrier()
#define PG8_SCHED __builtin_amdgcn_sched_barrier(0)
    Unit cur, nxt; int ui = 0;
    if (!S.next(0, cur)) return;
    f32x4 acc[2][2][4][2];
#pragma unroll
    for (int a = 0; a < 2; ++a)
#pragma unroll
        for (int b = 0; b < 2; ++b)
#pragma unroll
            for (int m = 0; m < 4; ++m)
#pragma unroll
                for (int n = 0; n < 2; ++n) acc[a][b][m][n] = (f32x4){0.f, 0.f, 0.f, 0.f};
    bf16x8 At[4][2], B0[2][2], B1[2][2];
    const char* cA = (const char*)g.A + (size_t)cur.pm * tstep; const char* cB = (const char*)g.Bt + (size_t)cur.pn * tstep;
    S.a_ready(cur);
    if constexpr (SP2) {
        PG8_STAGE(PG8_SB(0, 0), cB, voffB); PG8_STAGE(PG8_SB(0, 1), cB + hstep, voffB); PG8_STAGE(PG8_SA(0, 0), cA, voffA); PG8_STAGE(PG8_SA(0, 1), cA + hstep, voffA);
        if (wr == 1) PG8_BAR;
        PG8_WAIT_V(2); PG8_BAR;
        PG8_STAGE(PG8_SB(1, 0), cB + kstep, voffB); PG8_STAGE(PG8_SA(1, 0), cA + kstep, voffA); PG8_STAGE(PG8_SB(1, 1), cB + hstep + kstep, voffB);
        PG8_WAIT_V(6); PG8_BAR;
    } else {
        PG8_STAGE(PG8_SB(0, 0), cB, voffB); PG8_STAGE(PG8_SA(0, 0), cA, voffA); PG8_STAGE(PG8_SB(0, 1), cB + hstep, voffB); PG8_STAGE(PG8_SA(0, 1), cA + hstep, voffA);
        if (wr == 1) PG8_BAR;
        PG8_WAIT_V(4); PG8_BAR;
        PG8_STAGE(PG8_SB(1, 0), cB + kstep, voffB); PG8_STAGE(PG8_SA(1, 0), cA + kstep, voffA); PG8_STAGE(PG8_SB(1, 1), cB + hstep + kstep, voffB);
        PG8_WAIT_V(6); PG8_BAR;
    }
    for (;;) {
        const bool has_next = S.next(ui + 1, nxt);
        const char* nA = has_next ? (const char*)g.A + (size_t)nxt.pm * tstep : cA; const char* nB = has_next ? (const char*)g.Bt + (size_t)nxt.pn * tstep : cB;
        for (int t = 0; t < nt; t += 2) {
            const bool last = (t == nt - 2);
            const char* a1 = cA + (size_t)(t + 1) * kstep;
            const char* a2 = last ? nA : cA + (size_t)(t + 2) * kstep; const char* b2 = last ? nB : cB + (size_t)(t + 2) * kstep;
            const char* a3 = a2 + kstep; const char* b3 = b2 + kstep;
            if (last && has_next) S.a_ready(nxt);
            if constexpr (SP2) {
            PG8_LDB(B0, 0, 0); PG8_LDB(B1, 0, 1); PG8_SCHED; PG8_LDA(At, 0, 0); PG8_STAGE(PG8_SA(1, 1), a1 + hstep, voffA);
            PG8_WAIT_V(8); PG8_WAIT_L(0); PG8_BAR; PG8_MMA(0, 0, At, B0); PG8_MMA(0, 1, At, B1); PG8_BAR; PG8_SCHED;
            PG8_LDA(At, 0, 1); PG8_STAGE(PG8_SB(0, 0), b2, voffB); PG8_STAGE(PG8_SB(0, 1), b2 + hstep, voffB); PG8_STAGE(PG8_SA(0, 0), a2, voffA);
            PG8_WAIT_V(8); PG8_WAIT_L(0); PG8_BAR; PG8_MMA(1, 0, At, B0); PG8_MMA(1, 1, At, B1); PG8_BAR; PG8_SCHED;
            PG8_LDB(B0, 1, 0); PG8_LDB(B1, 1, 1); PG8_SCHED; PG8_LDA(At, 1, 0); PG8_STAGE(PG8_SA(0, 1), a2 + hstep, voffA);
            PG8_WAIT_V(8); PG8_WAIT_L(0); PG8_BAR; PG8_MMA(0, 0, At, B0); PG8_MMA(0, 1, At, B1); PG8_BAR; PG8_SCHED;
            PG8_LDA(At, 1, 1); PG8_STAGE(PG8_SB(1, 0), b3, voffB); PG8_STAGE(PG8_SB(1, 1), b3 + hstep, voffB); PG8_STAGE(PG8_SA(1, 0), a3, voffA);
            PG8_WAIT_V(8); PG8_WAIT_L(0); PG8_BAR; PG8_MMA(1, 0, At, B0); PG8_MMA(1, 1, At, B1); PG8_BAR; PG8_SCHED;
            } else {
            PG8_LDB(B0, 0, 0); PG8_SCHED; PG8_LDA(At, 0, 0); PG8_STAGE(PG8_SA(1, 1), a1 + hstep, voffA);
            PG8_WAIT_L(8); PG8_BAR; PG8_WAIT_L(0); PG8_MMA(0, 0, At, B0); PG8_BAR; PG8_SCHED;
            PG8_LDB(B1, 0, 1); PG8_STAGE(PG8_SB(0, 0), b2, voffB);
            PG8_BAR; PG8_WAIT_L(0); PG8_MMA(0, 1, At, B1); PG8_BAR;
            PG8_LDA(At, 0, 1); PG8_STAGE(PG8_SA(0, 0), a2, voffA);
            PG8_BAR; PG8_WAIT_L(0); PG8_MMA(1, 0, At, B0); PG8_BAR; PG8_SCHED;
            PG8_STAGE(PG8_SB(0, 1), b2 + hstep, voffB);
            PG8_WAIT_V(6); PG8_BAR; PG8_MMA(1, 1, At, B1); PG8_BAR;
            PG8_LDB(B0, 1, 0); PG8_SCHED; PG8_LDA(At, 1, 0); PG8_STAGE(PG8_SA(0, 1), a2 + hstep, voffA);
            PG8_WAIT_L(8); PG8_BAR; PG8_WAIT_L(0); PG8_MMA(0, 0, At, B0); PG8_BAR; PG8_SCHED;
            PG8_LDB(B1, 1, 1); PG8_STAGE(PG8_SB(1, 0), b3, voffB);
            PG8_BAR; PG8_WAIT_L(0); PG8_MMA(0, 1, At, B1); PG8_BAR;
            PG8_LDA(At, 1, 1); PG8_STAGE(PG8_SA(1, 0), a3, voffA);
            PG8_BAR; PG8_WAIT_L(0); PG8_MMA(1, 0, At, B0); PG8_BAR; PG8_SCHED;
            PG8_STAGE(PG8_SB(1, 1), b3 + hstep, voffB);
            PG8_WAIT_V(6); PG8_BAR; PG8_MMA(1, 1, At, B1); PG8_BAR;
            }
        }
        if constexpr (ALIGN_EPI) { if (wr == 0) PG8_BAR; }
        if constexpr (!Epi::AFTER_DRAIN) { E(acc, cur, wr, wc, fr, fq); S.done(cur); }
        if (!has_next) break;
#pragma unroll
        for (int a = 0; a < 2; ++a)
#pragma unroll
            for (int b = 0; b < 2; ++b)
#pragma unroll
                for (int m = 0; m < 4; ++m)
#pragma unroll
                    for (int n = 0; n < 2; ++n) acc[a][b][m][n] = (f32x4){0.f, 0.f, 0.f, 0.f};
        cur = nxt; cA = nA; cB = nB; ++ui;
        if constexpr (ALIGN_EPI) { if (wr == 1) PG8_BAR; }
    }
    PG8_WAIT_V(0);
    if constexpr (!ALIGN_EPI) { if (wr == 0) PG8_BAR; }
    PG8_BAR;
    if constexpr (Epi::AFTER_DRAIN) { E.fused(acc, cur, wr, wc, fr, fq, lds, wid, lane); S.done(cur); }
#undef PG8_SA
#undef PG8_SB
#undef PG8_STAGE
#undef PG8_LDA
#undef PG8_LDB
#undef PG8_MMA
#undef PG8_WAIT_V
#undef PG8_WAIT_L
#undef PG8_BAR
#undef PG8_SCHED
}
}
#endif

constexpr int LDT = 72;
constexpr int GEMM_AS = 256 * LDT, GEMM_BS = 128 * LDT;
constexpr int GEMM_LDS = 2 * (GEMM_AS + GEMM_BS) * 2;

template <class AF, class EPI>
DEV void gemm_tile(unsigned char* smem, AF af, const bf16* Bt, int ldb, int nvalid, int K, EPI& epi) {
    const int tid = TID, w = tid >> 6, l = tid & 63, h = l >> 4, c = l & 15, wm = w >> 1, wn = w & 1;
    bf16* As = (bf16*)smem; bf16* Bs = As + 2 * GEMM_AS;
    const bf16* ap[4]; const bf16* bp[2];
    const int col8 = (tid & 7) * 8, r0 = tid >> 3;
#pragma unroll
    for (int i = 0; i < 4; ++i) ap[i] = af(r0 + 64 * i) + col8;
#pragma unroll
    for (int i = 0; i < 2; ++i) { int rn = r0 + 64 * i; if (rn >= nvalid) rn = nvalid - 1; bp[i] = Bt + (size_t)rn * ldb + col8; }
    f32x4 acc[4][4];
#pragma unroll
    for (int i = 0; i < 4; ++i)
#pragma unroll
        for (int j = 0; j < 4; ++j) acc[i][j] = f4zero();
    bf16x8 ra[4], rb[2];
#pragma unroll
    for (int i = 0; i < 4; ++i) ra[i] = *(const bf16x8*)(ap[i]);
#pragma unroll
    for (int i = 0; i < 2; ++i) rb[i] = *(const bf16x8*)(bp[i]);
    SYNC();
#pragma unroll
    for (int i = 0; i < 4; ++i) *(bf16x8*)(As + (r0 + 64 * i) * LDT + col8) = ra[i];
#pragma unroll
    for (int i = 0; i < 2; ++i) *(bf16x8*)(Bs + (r0 + 64 * i) * LDT + col8) = rb[i];
    SYNC();
    const int nk = K / 64;
    for (int kt = 0; kt < nk; ++kt) {
        const int cur = kt & 1;
        if (kt + 1 < nk) {
#pragma unroll
            for (int i = 0; i < 4; ++i) ra[i] = *(const bf16x8*)(ap[i] + (kt + 1) * 64);
#pragma unroll
            for (int i = 0; i < 2; ++i) rb[i] = *(const bf16x8*)(bp[i] + (kt + 1) * 64);
        }
        const bf16* Ac = As + cur * GEMM_AS + (wm * 64 + c) * LDT + 8 * h;
        const bf16* Bc = Bs + cur * GEMM_BS + (wn * 64 + c) * LDT + 8 * h;
#pragma unroll
        for (int kk = 0; kk < 2; ++kk) {
            bf16x8 fa[4], fb[4];
#pragma unroll
            for (int i = 0; i < 4; ++i) { fa[i] = *(const bf16x8*)(Ac + i * 16 * LDT + kk * 32); fb[i] = *(const bf16x8*)(Bc + i * 16 * LDT + kk * 32); }
#pragma unroll
            for (int ni = 0; ni < 4; ++ni)
#pragma unroll
                for (int mi = 0; mi < 4; ++mi) acc[ni][mi] = mfma16(fb[ni], fa[mi], acc[ni][mi]);
        }
        if (kt + 1 < nk) {
            const int nx = cur ^ 1;
#pragma unroll
            for (int i = 0; i < 4; ++i) *(bf16x8*)(As + nx * GEMM_AS + (r0 + 64 * i) * LDT + col8) = ra[i];
#pragma unroll
            for (int i = 0; i < 2; ++i) *(bf16x8*)(Bs + nx * GEMM_BS + (r0 + 64 * i) * LDT + col8) = rb[i];
        }
        SYNC();
    }
    epi(acc, wm * 64, wn * 64, h, c);
}

struct ARows { const bf16* base; size_t ld; MDEV const bf16* operator()(int r) const { return base + (size_t)r * ld; } MDEV unsigned off(int r) const { return (unsigned)r * (unsigned)ld; } };

constexpr int LDB = 144;
constexpr int GEMM_BS2 = 64 * LDB;
constexpr int GEMM2_LDS = (2 * GEMM_AS + 2 * GEMM_BS2) * 2;
DEV bf16x8 tr_read8(const bf16* p0, const bf16* p1) {
    const s16x4 x = tr4(p0), y = tr4(p1); bf16x8 r;
    r[0] = x[0]; r[1] = x[1]; r[2] = x[2]; r[3] = x[3]; r[4] = y[0]; r[5] = y[1]; r[6] = y[2]; r[7] = y[3]; return r;
}
DEV int bperm(int r) { return (r & ~12) | ((r & 4) << 1) | ((r & 8) >> 1); }
template <class AF, class BF, class EPI>
DEV void gemm_tile2(unsigned char* smem, AF af, BF bf, int ldb, int K, EPI& epi) {
    const int tid = TID, w = tid >> 6, l = tid & 63, h = l >> 4, c = l & 15, wm = w >> 1, wn = w & 1, grp = w >> 2;
    bf16* As = (bf16*)smem; bf16* Bs = As + 2 * GEMM_AS;
    const bf16* abase = af.base; unsigned ao[4];
    const int col8 = (tid & 7) * 8, r0 = tid >> 3;
#pragma unroll
    for (int i = 0; i < 4; ++i) ao[i] = af.off(r0 + 64 * i) + col8;
    const int bn4 = (tid & 31) * 4, bk = tid >> 5, bkp = bperm(bk);
    const float* bp = bf(bn4); const bool bok = bp != nullptr;
    if (bok) bp += (size_t)bk * ldb;
    const size_t bstep = (size_t)16 * ldb;
    f32x4 acc[4][4];
#pragma unroll
    for (int i = 0; i < 4; ++i)
#pragma unroll
        for (int j = 0; j < 4; ++j) acc[i][j] = f4zero();
    bf16x8 ra[4]; f32x4 rb[4];
    const int nk = K / 64;
#pragma unroll
    for (int i = 0; i < 4; ++i) { ra[i] = *(const bf16x8*)(abase + ao[i]); rb[i] = bok ? *(const f32x4*)(bp + i * bstep) : f4zero(); }
    SYNC();
#pragma unroll
    for (int i = 0; i < 4; ++i) { *(bf16x8*)(As + (r0 + 64 * i) * LDT + col8) = ra[i]; st_bf4(Bs + (bkp + 16 * i) * LDB + bn4, rb[i]); }
    if (nk > 1) {
#pragma unroll
        for (int i = 0; i < 4; ++i) { ra[i] = *(const bf16x8*)(abase + (ao[i] + 64)); rb[i] = bok ? *(const f32x4*)(bp + (size_t)64 * ldb + i * bstep) : f4zero(); } }
    SYNC();
    for (int kt = 0; kt < nk; ++kt) {
        const int cur = kt & 1;
#pragma unroll
        for (int p = 0; p < 2; ++p) {
            if (grp == p) {
                const bf16* Ac = As + cur * GEMM_AS + (wm * 64 + c) * LDT + 8 * h;
                const bf16* Bc = Bs + cur * GEMM_BS2 + bperm(8 * h + (c >> 2)) * LDB + wn * 64 + 4 * (c & 3);
#pragma unroll
                for (int kk = 0; kk < 2; ++kk) {
                    bf16x8 fa[4], fb[4];
#pragma unroll
                    for (int i = 0; i < 4; ++i) { fa[i] = *(const bf16x8*)(Ac + i * 16 * LDT + kk * 32); fb[i] = tr_read8(Bc + (32 * kk) * LDB + 16 * i, Bc + (32 * kk + 8) * LDB + 16 * i); }
#pragma unroll
                    for (int ni = 0; ni < 4; ++ni)
#pragma unroll
                        for (int mi = 0; mi < 4; ++mi) acc[ni][mi] = mfma16(fb[ni], fa[mi], acc[ni][mi]);
                }
            } else if (kt + 1 < nk) {
                const int nx = cur ^ 1;
#pragma unroll
                for (int i = 0; i < 4; ++i) { *(bf16x8*)(As + nx * GEMM_AS + (r0 + 64 * i) * LDT + col8) = ra[i]; st_bf4(Bs + nx * GEMM_BS2 + (bkp + 16 * i) * LDB + bn4, rb[i]); }
                if (kt + 2 < nk) {
#pragma unroll
                    for (int i = 0; i < 4; ++i) { ra[i] = *(const bf16x8*)(abase + (ao[i] + (kt + 2) * 64)); rb[i] = bok ? *(const f32x4*)(bp + (size_t)(kt + 2) * 64 * ldb + i * bstep) : f4zero(); } }
            }
            SYNC();
        }
    }
    epi(acc, wm * 64, wn * 64, h, c);
}
struct BPlain { const float* base; MDEV const float* operator()(int nt) const { return base + nt; } };
struct BInProjMap { const float* base; int n0; MDEV const float* operator()(int nt) const { const int n = n0 + nt; const int sc = n < 1280 ? n : (n < 3328 ? n + 24 : (n < 3352 ? 1280 + (n - 3328) : -1)); return sc < 0 ? nullptr : base + sc; } };
struct BInter { const float* s0; const float* s1; int n0; MDEV const float* operator()(int nt) const { const int n = n0 + nt, g = n >> 6, w = n & 63; return w < 32 ? s0 + g * 32 + w : s1 + g * 32 + w - 32; } };
struct BClamp64 { const float* base; MDEV const float* operator()(int nt) const { return base + (nt & 63); } };

struct EpiInProj {
    const Args* a; int m0, n0, li;
    MDEV void operator()(f32x4 (&acc)[4][4], int mw, int nw, int h, int c) const {
        unsigned char* ws = wsp(*a);
        const int nb = n0 + nw;
        const int tokb = m0 + mw + c;
        if (nb < 512 || (nb >= 768 && nb < 896) || (nb >= 1024 && nb < 1152)) {
            const float* gain; float mul = 1.f; bf16* dst; int kind;
            if (nb < 512) { gain = INP(*a, I_QG) + li * 64; mul = 0.125f * LOG2E; kind = 0; dst = (bf16*)(ws + WS_QN); }
            else if (nb < 896) { gain = INP(*a, I_KG) + (li * 3 + 1) * 64; kind = 1; dst = (bf16*)(ws + WS_KS); }
            else { gain = INP(*a, I_KG) + (li * 3 + 2) * 64; kind = 1; dst = (bf16*)(ws + WS_KW); }
            const int g = (nb >> 6) & 1;
#pragma unroll
            for (int mi = 0; mi < 4; ++mi) {
                float ss = 0.f;
#pragma unroll
                for (int ni = 0; ni < 4; ++ni) { f32x4 v = acc[ni][mi]; ss += v[0] * v[0] + v[1] * v[1] + v[2] * v[2] + v[3] * v[3]; }
                ss += shflx(ss, 16); ss += shflx(ss, 32);
                const float rs = frsq(ss * (1.0f / 64.0f) + EPS) * mul;
                const int tok = tokb + 16 * mi;
#pragma unroll
                for (int ni = 0; ni < 4; ++ni) {
                    const int d = 16 * ni + 4 * h; f32x4 v = acc[ni][mi], o;
#pragma unroll
                    for (int r = 0; r < 4; ++r) o[r] = v[r] * rs * gain[d + r];
                    if (kind == 0) st_bf4(dst + (size_t)tok * 512 + nb + d, o);
                    else { const int b = tok / SEQ, s = tok % SEQ; st_bf4(dst + ((size_t)(b * 2 + g) * SEQ + s) * 64 + d, o); }
                }
            }
        } else if (nb < 768) {
            bf16* dst = (bf16*)(ws + (nb < 640 ? WS_KCG : WS_VCG)); const int g = (nb >> 6) & 1;
#pragma unroll
            for (int mi = 0; mi < 4; ++mi) { const int tok = tokb + 16 * mi, b = tok / SEQ, s = tok % SEQ;
#pragma unroll
                for (int ni = 0; ni < 4; ++ni) st_bf4(dst + ((size_t)(b * 2 + g) * SEQ + s) * 64 + 16 * ni + 4 * h, acc[ni][mi]); }
        } else if (nb < 1280) {
            bf16* dst = (bf16*)(ws + (nb < 1024 ? WS_VST : WS_VWT)); const int g = (nb >> 6) & 1;
#pragma unroll
            for (int mi = 0; mi < 4; ++mi) { const int tok = tokb + 16 * mi, b = tok / SEQ, s = tok % SEQ;
                bf16* p = dst + ((size_t)(b * 2 + g) * NCH + (s >> 6)) * 4096 + (s & 63);
#pragma unroll
                for (int ni = 0; ni < 4; ++ni)
#pragma unroll
                    for (int r = 0; r < 4; ++r) p[(16 * ni + 4 * h + r) * 64] = (bf16)f2bf(acc[ni][mi][r]); }
        } else if (nb < 3328) {
            const int sec = (nb - 1280) >> 9, cc = (nb - 1280) & 511, hh = cc >> 7, d0 = cc & 127;
#pragma unroll
            for (int mi = 0; mi < 4; ++mi) { const int tok = tokb + 16 * mi, b = tok / SEQ, s = tok % SEQ;
                const size_t hrow = ((size_t)(b * 4 + hh) * SEQ + s) * 128 + d0;
#pragma unroll
                for (int ni = 0; ni < 4; ++ni) { const int d = 16 * ni + 4 * h; f32x4 v = acc[ni][mi], o;
                    if (sec == 0) { for (int r = 0; r < 4; ++r) o[r] = siluf(v[r]); st_bf4((bf16*)(ws + WS_HQ) + hrow + d, o); }
                    else if (sec == 1) { const float* lb = (const float*)(ws + WS_LB) + li * 512 + cc + d;
                        for (int r = 0; r < 4; ++r) o[r] = lb[r] + (1.0f - lb[r]) * sigm(v[r]);
                        *(f32x4*)((float*)(ws + WS_HF) + hrow + d) = o; }
                    else if (sec == 2) st_bf4((bf16*)(ws + WS_HV) + hrow + d, v);
                    else { for (int r = 0; r < 4; ++r) o[r] = siluf(v[r]); st_bf4((bf16*)(ws + WS_HGS) + (size_t)tok * 512 + cc + d, o); }
                } }
        } else if (nb == 3328) {
            float* dst = (float*)(ws + WS_GATE);
#pragma unroll
            for (int mi = 0; mi < 4; ++mi) { const int tok = tokb + 16 * mi;
#pragma unroll
                for (int ni = 0; ni < 2; ++ni)
#pragma unroll
                    for (int r = 0; r < 4; ++r) { const int n = 16 * ni + 4 * h + r; if (n < 24) dst[(size_t)tok * 24 + n] = sigm(acc[ni][mi][r]); } }
        }
    }
};

struct EpiResid {
    float* x; const float* gate; int m0, n0;
    MDEV void operator()(f32x4 (&acc)[4][4], int mw, int nw, int h, int c) const {
#pragma unroll
        for (int mi = 0; mi < 4; ++mi) { const int tok = m0 + mw + 16 * mi + c, b = tok / SEQ;
#pragma unroll
            for (int ni = 0; ni < 4; ++ni) { const int n = n0 + nw + 16 * ni + 4 * h;
                f32x4 g = *(const f32x4*)(gate + (size_t)b * 6 * DM + n); f32x4* p = (f32x4*)(x + (size_t)tok * DM + n); f32x4 v = *p;
#pragma unroll
                for (int r = 0; r < 4; ++r) v[r] += g[r] * acc[ni][mi][r];
                *p = v; } }
    }
};
template <int MODE> struct EpiGated {
    bf16* dst; size_t ld; int m0, n0, mvalid;
    MDEV void operator()(f32x4 (&acc)[4][4], int mw, int nw, int h, int c) const {
        const int cb = (n0 + nw) / 2;
#pragma unroll
        for (int mi = 0; mi < 4; ++mi) { const int m = mw + 16 * mi + c; if (m >= mvalid) continue;
#pragma unroll
            for (int ni = 0; ni < 2; ++ni) { f32x4 o;
#pragma unroll
                for (int r = 0; r < 4; ++r) { const float av = acc[ni][mi][r], bv = acc[ni + 2][mi][r]; o[r] = MODE == 0 ? av * sigm(bv) : siluf(av) * bv; }
                st_bf4(dst + (size_t)(m0 + m) * ld + cb + 16 * ni + 4 * h, o); } }
    }
};
struct EpiStoreBf {
    bf16* dst; size_t ld; int m0, n0, mvalid;
    MDEV void operator()(f32x4 (&acc)[4][4], int mw, int nw, int h, int c) const {
#pragma unroll
        for (int mi = 0; mi < 4; ++mi) { const int m = mw + 16 * mi + c; if (m >= mvalid) continue;
#pragma unroll
            for (int ni = 0; ni < 4; ++ni) st_bf4(dst + (size_t)(m0 + m) * ld + n0 + nw + 16 * ni + 4 * h, acc[ni][mi]); }
    }
};
struct EpiCmp {
    const Args* a; int kv, bg, m0, li;
    MDEV void operator()(f32x4 (&acc)[4][4], int mw, int nw, int h, int c) const {
        if (nw != 0) return;
        unsigned char* ws = wsp(*a);
        const float* bp8 = (const float*)(ws + WS_CB) + (li * 2 + kv) * 8 * 64;
        float bias[16];
#pragma unroll
        for (int q = 0; q < 16; ++q) { const int e = 16 * (q >> 2) + 4 * h + (q & 3); float v = 0.f;
#pragma unroll
            for (int kp = 0; kp < 8; ++kp) v += bp8[kp * 64 + e];
            bias[q] = v; }
        const float* gain = INP(*a, I_KG) + (li * 3 + 0) * 64;
#pragma unroll
        for (int mi = 0; mi < 4; ++mi) { const int n = m0 + mw + 16 * mi + c; const bool ok = n < NCMP;
            f32x4 v[4]; float ss = 0.f;
#pragma unroll
            for (int ni = 0; ni < 4; ++ni) { v[ni] = acc[ni][mi];
#pragma unroll
                for (int r = 0; r < 4; ++r) { v[ni][r] += bias[4 * ni + r]; ss += v[ni][r] * v[ni][r]; } }
            ss += shflx(ss, 16); ss += shflx(ss, 32);
            if (n >= NCP) continue;
            if (kv == 0) { const float rs = frsq(ss * (1.0f / 64.0f) + EPS); bf16* p = (bf16*)(ws + WS_KC) + ((size_t)bg * NCP + n) * 64;
#pragma unroll
                for (int ni = 0; ni < 4; ++ni) { f32x4 o;
#pragma unroll
                    for (int r = 0; r < 4; ++r) o[r] = ok ? v[ni][r] * rs * gain[16 * ni + 4 * h + r] : 0.f;
                    st_bf4(p + 16 * ni + 4 * h, o); }
            } else { bf16* p = (bf16*)(ws + WS_VCT) + (size_t)bg * 64 * NCP + n;
#pragma unroll
                for (int ni = 0; ni < 4; ++ni)
#pragma unroll
                    for (int r = 0; r < 4; ++r) p[(size_t)(16 * ni + 4 * h + r) * NCP] = (bf16)f2bf(ok ? v[ni][r] : 0.f); }
        }
    }
};


struct EpiResid8 {
    static constexpr bool PERM = true, AFTER_DRAIN = false;
    float* x; const float* gate;
    MDEV void operator()(const f32x4 (&acc)[2][2][4][2], const pg8::Unit& u, int wr, int wc, int fr, int fq) const {
        OPAQUE2(fr, fq);
#pragma unroll
        for (int ai = 0; ai < 2; ++ai)
#pragma unroll
            for (int m = 0; m < 4; ++m) { const int row = 256 * u.pm + 128 * ai + 64 * wr + 16 * m + fr, b = row / SEQ;
#pragma unroll
                for (int bj = 0; bj < 2; ++bj)
#pragma unroll
                    for (int n = 0; n < 2; ++n) { const int col = 256 * u.pn + 128 * bj + 32 * wc + 8 * fq + 4 * n;
                        const f32x4 g = *(const f32x4*)(gate + (size_t)b * 6 * DM + col); f32x4* p = (f32x4*)(x + (size_t)row * DM + col); f32x4 v = *p;
#pragma unroll
                        for (int r = 0; r < 4; ++r) v[r] += g[r] * acc[ai][bj][m][n][r];
                        *p = v; } }
    }
};
struct EpiGlu8 {
    static constexpr bool PERM = true, AFTER_DRAIN = false;
    bf16* dst;
    MDEV void operator()(const f32x4 (&acc)[2][2][4][2], const pg8::Unit& u, int wr, int wc, int fr, int fq) const {
        OPAQUE2(fr, fq);
#pragma unroll
        for (int ai = 0; ai < 2; ++ai)
#pragma unroll
            for (int m = 0; m < 4; ++m) { const int row = 256 * u.pm + 128 * ai + 64 * wr + 16 * m + fr;
#pragma unroll
                for (int bj = 0; bj < 2; ++bj) { const int col = 128 * u.pn + 64 * bj + 16 * wc + 4 * fq; f32x4 o;
#pragma unroll
                    for (int r = 0; r < 4; ++r) o[r] = acc[ai][bj][m][0][r] * sigm(acc[ai][bj][m][1][r]);
                    st_bf4(dst + (size_t)row * DM + col, o); } }
    }
};
struct EpiInProj8 {
    static constexpr bool PERM = true, AFTER_DRAIN = false;
    const Args* a; int li;
    MDEV void operator()(const f32x4 (&acc)[2][2][4][2], const pg8::Unit& u, int wr, int wc, int fr, int fq) const {
        OPAQUE2(fr, fq);
        unsigned char* ws = wsp(*a);
        const int nb = 256 * u.pn + 64 * wc;
        if (nb >= 3392) return;
        if (nb < 512 || (nb >= 768 && nb < 896) || (nb >= 1024 && nb < 1152)) {
            const float* gain; float mul = 1.f; int kind;
            if (nb < 512) { gain = INP(*a, I_QG) + li * 64; mul = 0.125f * LOG2E; kind = 0; }
            else if (nb < 896) { gain = INP(*a, I_KG) + (li * 3 + 1) * 64; kind = 1; }
            else { gain = INP(*a, I_KG) + (li * 3 + 2) * 64; kind = 2; }
            const int g = (nb >> 6) & 1;
            f32x4 gv[2][2];
#pragma unroll
            for (int bj = 0; bj < 2; ++bj)
#pragma unroll
                for (int n = 0; n < 2; ++n) gv[bj][n] = *(const f32x4*)(gain + 32 * bj + 8 * fq + 4 * n);
#pragma unroll
            for (int ai = 0; ai < 2; ++ai)
#pragma unroll
                for (int m = 0; m < 4; ++m) { const int tok = 256 * u.pm + 128 * ai + 64 * wr + 16 * m + fr;
                    float ss = 0.f;
#pragma unroll
                    for (int bj = 0; bj < 2; ++bj)
#pragma unroll
                        for (int n = 0; n < 2; ++n) { const f32x4 v = acc[ai][bj][m][n]; ss += v[0] * v[0] + v[1] * v[1] + v[2] * v[2] + v[3] * v[3]; }
                    ss += shflx(ss, 16); ss += shflx(ss, 32);
                    const float rs = frsq(ss * (1.0f / 64.0f) + EPS) * mul;
                    bf16* dst; if (kind == 0) dst = (bf16*)(ws + WS_QN) + (size_t)tok * 512 + nb; else { const int b = tok / SEQ, sq = tok % SEQ; dst = (bf16*)(ws + (kind == 1 ? WS_KS : WS_KW)) + ((size_t)(b * 2 + g) * SEQ + sq) * 64; }
#pragma unroll
                    for (int bj = 0; bj < 2; ++bj) { f32x4 o0, o1;
#pragma unroll
                        for (int r = 0; r < 4; ++r) { o0[r] = acc[ai][bj][m][0][r] * rs * gv[bj][0][r]; o1[r] = acc[ai][bj][m][1][r] * rs * gv[bj][1][r]; }
                        st_bf8(dst + 32 * bj + 8 * fq, o0, o1); } }
        } else if (nb < 768) {
            bf16* base = (bf16*)(ws + (nb < 640 ? WS_KCG : WS_VCG)); const int g = (nb >> 6) & 1;
#pragma unroll
            for (int ai = 0; ai < 2; ++ai)
#pragma unroll
                for (int m = 0; m < 4; ++m) { const int tok = 256 * u.pm + 128 * ai + 64 * wr + 16 * m + fr, b = tok / SEQ, sq = tok % SEQ;
#pragma unroll
                    for (int bj = 0; bj < 2; ++bj) st_bf8(base + ((size_t)(b * 2 + g) * SEQ + sq) * 64 + 32 * bj + 8 * fq, acc[ai][bj][m][0], acc[ai][bj][m][1]); }
        } else if (nb < 1280) {
            bf16* base = (bf16*)(ws + (nb < 1024 ? WS_VST : WS_VWT)); const int g = (nb >> 6) & 1;
#pragma unroll
            for (int ai = 0; ai < 2; ++ai)
#pragma unroll
                for (int m = 0; m < 4; ++m) { const int tok = 256 * u.pm + 128 * ai + 64 * wr + 16 * m + fr, b = tok / SEQ, sq = tok % SEQ;
                    bf16* p = base + ((size_t)(b * 2 + g) * NCH + (sq >> 6)) * 4096 + (sq & 63);
#pragma unroll
                    for (int bj = 0; bj < 2; ++bj)
#pragma unroll
                        for (int n = 0; n < 2; ++n)
#pragma unroll
                            for (int r = 0; r < 4; ++r) p[(32 * bj + 8 * fq + 4 * n + r) * 64] = (bf16)f2bf(acc[ai][bj][m][n][r]); }
        } else if (nb < 3328) {
            const int sec = (nb - 1280) >> 9, cc = (nb - 1280) & 511, hh = cc >> 7, d0 = cc & 127;
            f32x4 lbv[2][2];
            if (sec == 1) {
#pragma unroll
                for (int bj = 0; bj < 2; ++bj)
#pragma unroll
                    for (int n = 0; n < 2; ++n) lbv[bj][n] = *(const f32x4*)((const float*)(ws + WS_LB) + li * 512 + cc + 32 * bj + 8 * fq + 4 * n); }
#pragma unroll
            for (int ai = 0; ai < 2; ++ai)
#pragma unroll
                for (int m = 0; m < 4; ++m) { const int tok = 256 * u.pm + 128 * ai + 64 * wr + 16 * m + fr, b = tok / SEQ, sq = tok % SEQ;
                    const size_t hrow = ((size_t)(b * 4 + hh) * SEQ + sq) * 128 + d0;
#pragma unroll
                    for (int bj = 0; bj < 2; ++bj) { const int d = 32 * bj + 8 * fq; f32x4 o0, o1;
                        if (sec == 0) {
#pragma unroll
                            for (int r = 0; r < 4; ++r) { o0[r] = siluf(acc[ai][bj][m][0][r]); o1[r] = siluf(acc[ai][bj][m][1][r]); }
                            st_bf8((bf16*)(ws + WS_HQ) + hrow + d, o0, o1); }
                        else if (sec == 1) {
#pragma unroll
                            for (int r = 0; r < 4; ++r) { o0[r] = lbv[bj][0][r] + (1.0f - lbv[bj][0][r]) * sigm(acc[ai][bj][m][0][r]); o1[r] = lbv[bj][1][r] + (1.0f - lbv[bj][1][r]) * sigm(acc[ai][bj][m][1][r]); }
                            float* pf = (float*)(ws + WS_HF) + hrow + d; *(f32x4*)pf = o0; *(f32x4*)(pf + 4) = o1; }
                        else if (sec == 2) st_bf8((bf16*)(ws + WS_HV) + hrow + d, acc[ai][bj][m][0], acc[ai][bj][m][1]);
                        else {
#pragma unroll
                            for (int r = 0; r < 4; ++r) { o0[r] = siluf(acc[ai][bj][m][0][r]); o1[r] = siluf(acc[ai][bj][m][1][r]); }
                            st_bf8((bf16*)(ws + WS_HGS) + (size_t)tok * 512 + cc + d, o0, o1); } } }
        } else {
            float* dst = (float*)(ws + WS_GATE);
            if (fq < 3) {
#pragma unroll
                for (int ai = 0; ai < 2; ++ai)
#pragma unroll
                    for (int m = 0; m < 4; ++m) { const int tok = 256 * u.pm + 128 * ai + 64 * wr + 16 * m + fr; f32x4 o0, o1;
#pragma unroll
                        for (int r = 0; r < 4; ++r) { o0[r] = sigm(acc[ai][0][m][0][r]); o1[r] = sigm(acc[ai][0][m][1][r]); }
                        float* pf = dst + (size_t)tok * 24 + 8 * fq; *(f32x4*)pf = o0; *(f32x4*)(pf + 4) = o1; } }
        }
    }
};

DEV void tr_tile(unsigned char* smem, const float* src0, const float* src1, int ld, int K, int mode, bf16* dst, int n0, int k0) {
    bf16* tl = (bf16*)smem;
    const int tid = TID;
    SYNC();
#pragma unroll
    for (int i = 0; i < 8; ++i) {
        const int e = tid + 512 * i, kk = e >> 6, nn = e & 63, n = n0 + nn; float v = 0.f;
        if (mode == 0) v = src0[(size_t)(k0 + kk) * ld + n];
        else if (mode == 1) { int sc = n < 1280 ? n : (n < 3328 ? n + 24 : (n < 3352 ? 1280 + (n - 3328) : -1)); if (sc >= 0) v = src0[(size_t)(k0 + kk) * ld + sc]; }
        else { const int g = n >> 6, w = n & 63; v = (w < 32) ? src0[(size_t)(k0 + kk) * ld + g * 32 + w] : src1[(size_t)(k0 + kk) * ld + g * 32 + w - 32]; }
        tl[nn * LDT + kk] = (bf16)f2bf(v);
    }
    SYNC();
    const int nn = tid >> 3, k8 = (tid & 7) * 8;
    *(bf16x8*)(dst + (size_t)(n0 + nn) * K + k0 + k8) = *(const bf16x8*)(tl + nn * LDT + k8);
}

DEV int tr_col(int mode, int n) {
    if (mode == 0) return n;
    const int pn = n >> 8, ct = n & 255;
    if (mode == 5) { const int bj = ct >> 7, wc = (ct >> 5) & 3, j = ct & 31, L = 256 * pn + 64 * wc + 32 * bj + j; return L < 1280 ? L : (L < 3328 ? L + 24 : (L < 3352 ? 1280 + (L - 3328) : -1)); }
    { const int bj = ct >> 7, wc = (ct >> 5) & 3, j = ct & 31, nn = (j >> 2) & 1, Lc = 128 * pn + 64 * bj + 16 * wc + 4 * (j >> 3) + (j & 3); return nn == 0 ? Lc : DM + Lc; }
}
DEV void tr_tile(unsigned char* smem, const float* src, int ld, int K, int mode, bf16* dst, int n0, int k0) {
    bf16* tl = (bf16*)smem;
    const int tid = TID;
    SYNC();
    { const int nn = tid & 63, n = n0 + nn, sc = tr_col(mode, n);
#pragma unroll
      for (int i = 0; i < 8; ++i) { const int kk = (tid >> 6) + 8 * i; const float v = sc >= 0 ? src[(size_t)(k0 + kk) * ld + sc] : 0.f; tl[nn * LDT + kk] = (bf16)f2bf(v); } }
    SYNC();
    const int nn = tid >> 3, k8 = (tid & 7) * 8;
    *(bf16x8*)(dst + (size_t)(n0 + nn) * K + k0 + k8) = *(const bf16x8*)(tl + nn * LDT + k8);
}
struct TrJob { const float* s; int ld, K, N, mode; bf16* dst; };
DEV void p0_phase(const Args& a, unsigned char* smem) {
    unsigned char* ws = wsp(a); const int tid = TID;
    { int item = BID, base = 0;
      for (int j = 0; j < 8; ++j) { TrJob J; const int i = j & 1;
        if (j < 2) J = {INP(a, I_WIN) + (size_t)i * DM * NIN, NIN, DM, NIN8, 5, (bf16*)(ws + WS_WIN) + (size_t)i * NIN8 * DM};
        else if (j < 4) J = {INP(a, I_WOUT) + (size_t)i * 1024 * DM, DM, 1024, DM, 0, (bf16*)(ws + WS_WOUT) + (size_t)i * DM * 1024};
        else if (j < 6) J = {INP(a, I_PW1) + (size_t)i * DM * 2 * DM, 2 * DM, DM, 2 * DM, 6, (bf16*)(ws + WS_PW1) + (size_t)i * 2 * DM * DM};
        else J = {INP(a, I_PW2) + (size_t)i * DM * DM, DM, DM, DM, 0, (bf16*)(ws + WS_PW2) + (size_t)i * DM * DM};
        const int tn = J.N / 64, tk = J.K / 64, nt = tn * tk;
        while (item < base + nt) { const int it = item - base; tr_tile(smem, J.s, J.ld, J.K, J.mode, J.dst, (it % tn) * 64, (it / tn) * 64); item += NBLK; }
        base += nt; }
      SYNC(); }
    {
        float* red = (float*)smem;
        constexpr int NG = 6 * DM / 128; const int ntask = DEPTH * NG;
        for (int t = BID; t < ntask; t += NBLK) {
            const int l = t / NG, j0 = (t % NG) * 128, cq = tid & 31, kr = tid >> 5;
            const float* w = INP(a, I_ADAW) + (size_t)l * DM * 6 * DM + j0 + 4 * cq; const float* cc = INP(a, I_C);
            f32x4 a0 = f4zero(), a1 = f4zero();
#pragma unroll 8
            for (int i = 0; i < DM / 16; ++i) { const int k = kr + 16 * i; const f32x4 wv = *(const f32x4*)(w + (size_t)k * 6 * DM); const float s0 = siluf(cc[k]), s1 = siluf(cc[DM + k]);
#pragma unroll
                for (int r = 0; r < 4; ++r) { a0[r] += s0 * wv[r]; a1[r] += s1 * wv[r]; } }
            SYNC();
            *(f32x4*)(red + (kr * 2 + 0) * 128 + 4 * cq) = a0; *(f32x4*)(red + (kr * 2 + 1) * 128 + 4 * cq) = a1;
            SYNC();
            if (tid < 256) { const int b = tid >> 7, col = tid & 127; float sum = INP(a, I_ADAB)[(size_t)l * 6 * DM + j0 + col];
#pragma unroll
                for (int q = 0; q < 16; ++q) sum += red[(q * 2 + b) * 128 + col];
                ((float*)(ws + WS_MOD))[((size_t)l * 2 + b) * 6 * DM + j0 + col] = sum; }
        }
    }
    for (int t = BID; t < 32; t += NBLK) {
        float* red = (float*)smem; const int ikv = t >> 3, kp = t & 7, i = ikv >> 1, kv = ikv & 1, e = tid & 63, ks = tid >> 6;
        const float* W = INP(a, kv ? I_CWV : I_CWK) + (size_t)i * 2048 * 64 + e; const float* pe = INP(a, I_CPE) + (size_t)i * 2048;
        float sum = 0.f;
#pragma unroll 8
        for (int q = 0; q < 32; ++q) { const int k = kp * 256 + ks * 32 + q; sum += pe[k] * W[(size_t)k * 64]; }
        SYNC(); red[ks * 64 + e] = sum; SYNC();
        if (tid < 64) { float v = 0.f; for (int q = 0; q < 8; ++q) v += red[q * 64 + tid]; ((float*)(ws + WS_CB))[(ikv * 8 + kp) * 64 + tid] = v; }
    }
    for (int i = BID * NT + tid; i < DEPTH * 48 * DM; i += NBLK * NT) { const int k = i % DM, n = (i / DM) % 48, ll = i / (48 * DM);
        const float wv = n < 4 ? INP(a, I_WG)[((size_t)ll * DM + k) * 4 + n] : (n < 36 ? INP(a, I_WE)[((size_t)ll * DM + k) * 32 + n - 4] : 0.f);
        const unsigned hi = f2bf(wv); ((bf16*)(ws + WS_WTH))[i] = (bf16)hi; ((bf16*)(ws + WS_WTL))[i] = (bf16)f2bf(wv - bf2f(hi)); }
    if (BID == 0) {
        for (int i = tid; i < DEPTH * 32; i += NT) ((int*)(ws + WS_CNT))[i * 64] = 0;
        for (int n = tid; n < 512; n += NT) { const float l0 = INP(a, I_LBL)[n], l1 = INP(a, I_LBL)[512 + n]; const float m = fmaxf(l0, l1);
            const float e0 = fexp2((l0 - m) * LOG2E), e1 = fexp2((l1 - m) * LOG2E);
            ((float*)(ws + WS_LB))[n] = 0.f; ((float*)(ws + WS_LB))[512 + n] = e1 / (e0 + e1); }
        if (tid < 2) { const int i = tid; float mq = 0.f; for (int d = 0; d < 64; ++d) mq = fmaxf(mq, fabsf(INP(a, I_QG)[i * 64 + d]));
            for (int br = 0; br < 3; ++br) { float mk = 0.f; for (int d = 0; d < 64; ++d) mk = fmaxf(mk, fabsf(INP(a, I_KG)[(i * 3 + br) * 64 + d]));
                ((float*)(ws + WS_CS))[i * 4 + br] = 8.0f * mq * mk * LOG2E; } }
    }
}

constexpr int NJV = DM / 256;
DEV void moe_bases(const int* cnt, int* rb  ) {
    if (TID == 0) { int acc = 0; for (int e = 0; e < 32; ++e) { rb[e] = acc; acc += ((cnt[e * 64] + 255) >> 8) << 8; } rb[32] = acc; }
    SYNC();
}
DEV void norm_phase(const Args& a, unsigned char* smem, int l) {
    unsigned char* ws = wsp(a); const int tid = TID, w = tid >> 6, lane = tid & 63;
    int* rb = (int*)smem;
    if (l > 0) moe_bases((const int*)(ws + WS_CNT) + (l - 1) * 32 * 64, rb);
    const float* mod = (const float*)(ws + WS_MOD);
    const bf16* yk = (const bf16*)(ws + WS_YK);
    if (l < DEPTH) {
        const int bid = BID % 76 == BID ? BID : -1;
        for (int job = BID; job < 76; job += NBLK) {
            if (job < 72) { const int b = job / 36, n = job % 36; float sum = 0.f;
                for (int k = tid; k < DM; k += NT) { const float wv = n < 4 ? INP(a, I_WG)[((size_t)l * DM + k) * 4 + n] : INP(a, I_WE)[((size_t)l * DM + k) * 32 + n - 4]; sum += mod[((size_t)l * 2 + b) * 6 * DM + 3 * DM + k] * wv; }
#pragma unroll
                for (int q = 1; q < 64; q <<= 1) sum += shflx(sum, q);
                float* red = (float*)(smem + 1024);
                SYNC(); if (lane == 0) red[w] = sum; SYNC();
                if (tid == 0) { float t = 0.f; for (int q = 0; q < 8; ++q) t += red[q]; ((float*)(ws + WS_RBIAS))[((size_t)l * 2 + b) * 48 + n] = t; }
            } else { const float* nf = INP(a, I_NFFN) + (size_t)l * DM; const int part = job - 72;
                for (int i = part * (2 * DM / 4) + tid; i < (part + 1) * (2 * DM / 4); i += NT) { const int b = i / DM, k = i % DM; ((float*)(ws + WS_AVEC))[((size_t)l * 2 + b) * DM + k] = nf[k] * (1.0f + mod[((size_t)l * 2 + b) * 6 * DM + 4 * DM + k]); } }
        }
        (void)bid;
    }
    const int rstride = NBLK * 8;
    for (int rowa = BID * 8 + w; rowa < T; rowa += 2 * rstride) {
        int row[2]; bool ok[2];
        row[0] = rowa; ok[0] = true; row[1] = rowa + rstride; ok[1] = row[1] < T; if (!ok[1]) row[1] = rowa;
        f32x4 v[2][NJV]; int e0[2], p0[2], e1[2], p1[2]; float w0[2], w1[2];
        const float* xin = (l == 0) ? INP(a, I_X) : outp(a);
#pragma unroll
        for (int q = 0; q < 2; ++q) {
#pragma unroll
            for (int j = 0; j < NJV; ++j) v[q][j] = *(const f32x4*)(xin + (size_t)row[q] * DM + 4 * lane + 256 * j);
            if (l > 0) { const int* tie = (const int*)(ws + WS_TIE) + (size_t)row[q] * 2; const float* tiw = (const float*)(ws + WS_TIW) + (size_t)row[q] * 2;
                e0[q] = tie[0] >> 14; p0[q] = tie[0] & 16383; e1[q] = tie[1] >> 14; p1[q] = tie[1] & 16383; w0[q] = tiw[0]; w1[q] = tiw[1]; } }
        if (l > 0) {
            u32x2 q0[2][NJV], q1[2][NJV];
#pragma unroll
            for (int q = 0; q < 2; ++q) { const bf16* y0 = yk + (size_t)(rb[e0[q]] + p0[q]) * DM; const bf16* y1 = yk + (size_t)(rb[e1[q]] + p1[q]) * DM;
#pragma unroll
                for (int j = 0; j < NJV; ++j) { const int cidx = 4 * lane + 256 * j; q0[q][j] = *(const u32x2*)(y0 + cidx); q1[q][j] = *(const u32x2*)(y1 + cidx); } }
#pragma unroll
            for (int q = 0; q < 2; ++q) { const int b = row[q] / SEQ; const float* gf = mod + ((size_t)(l - 1) * 2 + b) * 6 * DM + 5 * DM;
#pragma unroll
                for (int j = 0; j < NJV; ++j) { const int cidx = 4 * lane + 256 * j; const f32x4 g = *(const f32x4*)(gf + cidx);
                    v[q][j][0] += g[0] * (w0[q] * bf2f(q0[q][j][0] & 0xffff) + w1[q] * bf2f(q1[q][j][0] & 0xffff));
                    v[q][j][1] += g[1] * (w0[q] * bf2f(q0[q][j][0] >> 16) + w1[q] * bf2f(q1[q][j][0] >> 16));
                    v[q][j][2] += g[2] * (w0[q] * bf2f(q0[q][j][1] & 0xffff) + w1[q] * bf2f(q1[q][j][1] & 0xffff));
                    v[q][j][3] += g[3] * (w0[q] * bf2f(q0[q][j][1] >> 16) + w1[q] * bf2f(q1[q][j][1] >> 16)); } }
        }
#pragma unroll
        for (int q = 0; q < 2; ++q) { if (!ok[q]) continue;
#pragma unroll
            for (int j = 0; j < NJV; ++j) *(f32x4*)(outp(a) + (size_t)row[q] * DM + 4 * lane + 256 * j) = v[q][j]; }
        if (l == DEPTH) continue;
        float ss[2];
#pragma unroll
        for (int q = 0; q < 2; ++q) { ss[q] = 0.f;
#pragma unroll
            for (int j = 0; j < NJV; ++j) ss[q] += v[q][j][0] * v[q][j][0] + v[q][j][1] * v[q][j][1] + v[q][j][2] * v[q][j][2] + v[q][j][3] * v[q][j][3]; }
#pragma unroll
        for (int o = 1; o < 64; o <<= 1) { ss[0] += shflx(ss[0], o); ss[1] += shflx(ss[1], o); }
        const float* nm = INP(a, I_NMIX) + (size_t)l * DM;
#pragma unroll
        for (int q = 0; q < 2; ++q) { if (!ok[q]) continue;
            const int b = row[q] / SEQ; const float rs = frsq(ss[q] * (1.0f / DM) + EPS);
            const float* mm = mod + ((size_t)l * 2 + b) * 6 * DM; bf16* hb = (bf16*)(ws + WS_H) + (size_t)row[q] * DM;
#pragma unroll
            for (int j = 0; j < NJV; ++j) { const int cidx = 4 * lane + 256 * j; f32x4 g = *(const f32x4*)(nm + cidx), sh = *(const f32x4*)(mm + cidx), sc = *(const f32x4*)(mm + DM + cidx), o;
#pragma unroll
                for (int r = 0; r < 4; ++r) o[r] = v[q][j][r] * rs * g[r] * (1.0f + sc[r]) + sh[r];
                st_bf4(hb + cidx, o); } }
    }
}

DEV void route_phase(const Args& a, unsigned char* smem, int l) {
    unsigned char* ws = wsp(a); const int tid = TID, w = tid >> 6, lane = tid & 63, h = lane >> 4, c = lane & 15, pi = w >> 1, kh = w & 1;
    constexpr int CH = DM / 2, WLD = CH + 8, NKS = CH / 2 / 32;
    bf16* WHl = (bf16*)smem; bf16* WLl = WHl + 48 * WLD;
    float* lg = (float*)(WLl + 48 * WLD);
    float* ssb = lg + 4 * 2 * 16 * 48;
    float* rsb = ssb + 4 * 2 * 16;
    int* lcnt = (int*)(rsb + 64); int* lbase = lcnt + 32; int* tinfo = lbase + 32;
    SYNC();
    if (tid < 32) lcnt[tid] = 0;
    SYNC();
    const float* mod = (const float*)(ws + WS_MOD);
    const bf16* WH = (const bf16*)(ws + WS_WTH) + (size_t)l * 48 * DM; const bf16* WL = (const bf16*)(ws + WS_WTL) + (size_t)l * 48 * DM;
    int* cnt = (int*)(ws + WS_CNT) + l * 32 * 64;
    constexpr int KH = DM / 2;
    for (int pass0 = BID; pass0 < T / 16; pass0 += 4 * NBLK) {
        const int pass = pass0 + pi * NBLK; const bool valid = pass < T / 16;
        const int tok = valid ? pass * 16 + c : 0, b = tok / SEQ;
        const float* xr = outp(a) + (size_t)tok * DM + kh * KH + 8 * h;
        const float* av = (const float*)(ws + WS_AVEC) + ((size_t)l * 2 + b) * DM + kh * KH + 8 * h;
        const float* cv = mod + ((size_t)l * 2 + b) * 6 * DM + 3 * DM + kh * KH + 8 * h;
        f32x4 acc[3] = {f4zero(), f4zero(), f4zero()}; float ss = 0.f;
#pragma unroll 1
        for (int chn = 0; chn < 2; ++chn) {
            const float* xq = outp(a) + (size_t)tok * DM + chn * CH + kh * (CH / 2) + 8 * h;
            const float* aq = (const float*)(ws + WS_AVEC) + ((size_t)l * 2 + b) * DM + chn * CH + kh * (CH / 2) + 8 * h;
            f32x4 xv[NKS][2], avv[NKS][2];
#pragma unroll
            for (int ks = 0; ks < NKS; ++ks) { xv[ks][0] = *(const f32x4*)(xq + 32 * ks); xv[ks][1] = *(const f32x4*)(xq + 32 * ks + 4); avv[ks][0] = *(const f32x4*)(aq + 32 * ks); avv[ks][1] = *(const f32x4*)(aq + 32 * ks + 4); }
            SYNC();
            for (int i = tid; i < 48 * (CH / 8); i += NT) { const int n = i / (CH / 8), k8 = (i % (CH / 8)) * 8;
                *(bf16x8*)(WHl + n * WLD + k8) = *(const bf16x8*)(WH + (size_t)n * DM + chn * CH + k8); *(bf16x8*)(WLl + n * WLD + k8) = *(const bf16x8*)(WL + (size_t)n * DM + chn * CH + k8); }
            SYNC();
            if (valid) {
                const bf16* whp = WHl + c * WLD + kh * (CH / 2) + 8 * h; const bf16* wlp = WLl + c * WLD + kh * (CH / 2) + 8 * h;
#pragma unroll
                for (int ks = 0; ks < NKS; ++ks) {
                    f32x4 u0, u1, r0, r1;
#pragma unroll
                    for (int r = 0; r < 4; ++r) { u0[r] = xv[ks][0][r] * avv[ks][0][r]; u1[r] = xv[ks][1][r] * avv[ks][1][r]; ss += xv[ks][0][r] * xv[ks][0][r] + xv[ks][1][r] * xv[ks][1][r]; }
                    const bf16x8 uh = pack8(u0, u1);
#pragma unroll
                    for (int r = 0; r < 4; ++r) { r0[r] = u0[r] - bf2f((unsigned short)uh[r]); r1[r] = u1[r] - bf2f((unsigned short)uh[4 + r]); }
                    const bf16x8 ul = pack8(r0, r1);
#pragma unroll
                    for (int nt = 0; nt < 3; ++nt) { const bf16x8 wh = *(const bf16x8*)(whp + nt * 16 * WLD + 32 * ks), wl = *(const bf16x8*)(wlp + nt * 16 * WLD + 32 * ks);
                        acc[nt] = mfma16(wh, uh, acc[nt]); acc[nt] = mfma16(wl, uh, acc[nt]); acc[nt] = mfma16(wh, ul, acc[nt]); }
                }
            }
        }
        if (valid) {
            ss += shflx(ss, 16); ss += shflx(ss, 32);
            float* lgp = lg + ((pi * 2 + kh) * 16 + c) * 48 + 4 * h;
#pragma unroll
            for (int nt = 0; nt < 3; ++nt) *(f32x4*)(lgp + 16 * nt) = acc[nt];
            if (h == 0) ssb[(pi * 2 + kh) * 16 + c] = ss;
        }
        SYNC();
        if (tid < 64) { const int p2 = tid >> 4, tk = tid & 15, pass2 = pass0 + p2 * NBLK;
            if (pass2 < T / 16) { const int tok2 = pass2 * 16 + tk, b2 = tok2 / SEQ;
                const float rs = frsq((ssb[(p2 * 2 + 0) * 16 + tk] + ssb[(p2 * 2 + 1) * 16 + tk]) * (1.0f / DM) + EPS); rsb[p2 * 16 + tk] = rs;
                const float* l0 = lg + ((p2 * 2 + 0) * 16 + tk) * 48; const float* l1 = lg + ((p2 * 2 + 1) * 16 + tk) * 48; const float* rbp = (const float*)(ws + WS_RBIAS) + ((size_t)l * 2 + b2) * 48;
                float acc[36];
#pragma unroll
                for (int n = 0; n < 36; ++n) acc[n] = rs * (l0[n] + l1[n]) + rbp[n];
                int gs = 0; float gm = acc[0];
#pragma unroll
                for (int g = 1; g < 4; ++g) if (acc[g] > gm) { gm = acc[g]; gs = g; }
                float den = 0.f;
#pragma unroll
                for (int g = 0; g < 4; ++g) den += fexp2((acc[g] - gm) * LOG2E);
                const float ggate = 1.0f / den;
                float el[8];
#pragma unroll
                for (int j = 0; j < 8; ++j) { el[j] = acc[4 + j];
#pragma unroll
                    for (int g = 1; g < 4; ++g) if (gs == g) el[j] = acc[4 + 8 * g + j]; }
                int ia = 0; float va = el[0];
#pragma unroll
                for (int j = 1; j < 8; ++j) if (el[j] > va) { va = el[j]; ia = j; }
                int ib = -1; float vb = -3e38f;
#pragma unroll
                for (int j = 0; j < 8; ++j) if (j != ia && el[j] > vb) { vb = el[j]; ib = j; }
                const float wa = 1.0f / (1.0f + fexp2((vb - va) * LOG2E)), wb = 1.0f - wa;
                const int e0 = gs * 8 + ia, e1 = gs * 8 + ib;
                const int p0 = atomic_add_i(lcnt + e0, 1), p1 = atomic_add_i(lcnt + e1, 1);
                int* ti = tinfo + tid * 4;
                ti[0] = (e0 << 14) | p0; ti[1] = (e1 << 14) | p1; ti[2] = __builtin_bit_cast(int, ggate * wa); ti[3] = __builtin_bit_cast(int, ggate * wb);
            } }
        SYNC();
        if (valid) { const float rs = rsb[pi * 16 + c]; bf16* hb = (bf16*)(ws + WS_H) + (size_t)tok * DM + kh * KH + 8 * h;
#pragma unroll 4
            for (int ks = 0; ks < KH / 32; ++ks) {
                const f32x4 x0 = *(const f32x4*)(xr + 32 * ks), x1 = *(const f32x4*)(xr + 32 * ks + 4), a0 = *(const f32x4*)(av + 32 * ks), a1 = *(const f32x4*)(av + 32 * ks + 4), c0 = *(const f32x4*)(cv + 32 * ks), c1 = *(const f32x4*)(cv + 32 * ks + 4);
                f32x4 o0, o1;
#pragma unroll
                for (int r = 0; r < 4; ++r) { o0[r] = x0[r] * rs * a0[r] + c0[r]; o1[r] = x1[r] * rs * a1[r] + c1[r]; }
                st_bf8(hb + 32 * ks, o0, o1); } }
        if (tid < 32) { const int n = lcnt[tid]; lbase[tid] = n > 0 ? atomic_add_i(cnt + tid * 64, n) : 0; lcnt[tid] = 0; }
        SYNC();
        if (tid < 64) { const int p2 = tid >> 4, pass2 = pass0 + p2 * NBLK;
            if (pass2 < T / 16) { const int tok2 = pass2 * 16 + (tid & 15); const int* ti = tinfo + tid * 4;
                const int e0 = ti[0] >> 14, e1 = ti[1] >> 14, p0 = lbase[e0] + (ti[0] & 16383), p1 = lbase[e1] + (ti[1] & 16383);
                int* list = (int*)(ws + WS_LIST); list[(size_t)e0 * T + p0] = tok2; list[(size_t)e1 * T + p1] = tok2;
                int* tie = (int*)(ws + WS_TIE) + (size_t)tok2 * 2; int* tiw = (int*)(ws + WS_TIW) + (size_t)tok2 * 2;
                tie[0] = (e0 << 14) | p0; tie[1] = (e1 << 14) | p1; tiw[0] = ti[2]; tiw[1] = ti[3]; } }
        SYNC();
    }
}

DEV int vbid() { const int g = NBLK; return (g % 8 == 0) ? (BID % 8) * (g / 8) + BID / 8 : BID; }
#ifdef EMU
#define PG8_LDS(p) (p)
#else
#define PG8_LDS(p) ((PG8_LAS unsigned char*)(p))
#endif
DEV void inproj_phase(const Args& a, unsigned char* smem, int li) {
    pg8::Gemm g{(const bf16*)(wsp(a) + WS_H), (const bf16*)(wsp(a) + WS_WIN) + (size_t)li * NIN8 * DM, T, NIN8, DM}; pg8::StaticOrder S; S.init(T, NIN8, NBLK, BID);
    EpiInProj8 E{&a, li};
    SYNC(); pg8::gemm_phase<EpiInProj8, pg8::StaticOrder, true, true>(PG8_LDS(smem), g, S, E); SYNC();
}
DEV void resid_gemm_phase(const Args& a, unsigned char* smem, const bf16* A, int K, const bf16* Bt, int l) {
    pg8::Gemm g{A, Bt, T, DM, K}; pg8::StaticOrder S; S.init(T, DM, NBLK, BID);
    EpiResid8 E{outp(a), (const float*)(wsp(a) + WS_MOD) + (size_t)l * 2 * 6 * DM + 2 * DM};
    SYNC(); pg8::gemm_phase<EpiResid8, pg8::StaticOrder, true, true>(PG8_LDS(smem), g, S, E); SYNC();
}
DEV void pw1_phase(const Args& a, unsigned char* smem, int li) {
    pg8::Gemm g{(const bf16*)(wsp(a) + WS_H), (const bf16*)(wsp(a) + WS_PW1) + (size_t)li * 2 * DM * DM, T, 2 * DM, DM}; pg8::StaticOrder S; S.init(T, 2 * DM, NBLK, BID);
    EpiGlu8 E{(bf16*)(wsp(a) + WS_GLU)};
    SYNC(); pg8::gemm_phase<EpiGlu8, pg8::StaticOrder, true, true>(PG8_LDS(smem), g, S, E); SYNC();
}
DEV void cmp_phase_items(const Args& a, unsigned char* smem, int li, int it) {
    constexpr int TMC = (NCP + 255) / 256;
    const int kv = it / (4 * TMC), bg = (it / TMC) % 4, tm = it % TMC;
    const bf16* src = (const bf16*)(wsp(a) + (kv ? WS_VCG : WS_KCG)) + (size_t)bg * SEQ * 64;
    struct AF { const bf16* base; int m0; MDEV unsigned off(int r) const { int n = m0 + r; if (n > NCMP - 1) n = NCMP - 1; return (unsigned)n * 1024u; } } af{src, tm * 256};
    EpiCmp E{&a, kv, bg, tm * 256, li};
    BClamp64 bf{INP(a, kv ? I_CWV : I_CWK) + (size_t)li * 2048 * 64};
    gemm_tile2(smem, af, bf, 64, 2048, E);
}
DEV void moe_gemm_phase(const Args& a, unsigned char* smem, int l, int mode) {
    unsigned char* ws = wsp(a); const int* cnt = (const int*)(ws + WS_CNT) + l * 32 * 64;
    int* rb = (int*)(smem + GEMM2_LDS);
    moe_bases(cnt, rb);
    const int ntile = rb[32] >> 8;
    constexpr int TN1 = 2 * FF / 128, TN2 = DM / 128;
    const int TN = mode == 0 ? TN1 : TN2;
    const int* list = (const int*)(ws + WS_LIST);
    for (int it = vbid(); it < ntile * TN; it += NBLK) {
        const int rt = it / TN, tn = it % TN; int e = 0;
#pragma unroll 1
        for (int q = 1; q < 32; ++q) if ((rb[q] >> 8) <= rt) e = q;
        const int rloc = (rt << 8) - rb[e], ce = cnt[e * 64], nvalid = (ce - rloc) < 256 ? (ce - rloc) : 256;
        if (mode == 0) {
            struct AF { const bf16* base; const int* lst; int nv; MDEV unsigned off(int r) const { const int rr = r < nv ? r : nv - 1; return (unsigned)lst[rr] * (unsigned)DM; } }
                af{(const bf16*)(ws + WS_H), list + (size_t)e * T + rloc, nvalid};
            EpiGated<1> E{(bf16*)(ws + WS_ACT), (size_t)FF, rt << 8, tn * 128, nvalid};
            BInter bf{INP(a, I_W1) + (size_t)(l * 32 + e) * DM * FF, INP(a, I_W3) + (size_t)(l * 32 + e) * DM * FF, tn * 128};
            gemm_tile2(smem, af, bf, FF, DM, E);
        } else {
            ARows af{(const bf16*)(ws + WS_ACT) + (size_t)(rt << 8) * FF, (size_t)FF};
            EpiStoreBf E{(bf16*)(ws + WS_YK), (size_t)DM, rt << 8, tn * 128, nvalid};
            BPlain bf{INP(a, I_W2) + (size_t)(l * 32 + e) * FF * DM + tn * 128};
            gemm_tile2(smem, af, bf, DM, FF, E);
        }
    }
}

constexpr int AT_K = 0, AT_V = 2 * 64 * LDT * 2, AT_IMP = 2 * AT_V, AT_SEL = AT_IMP + 8 * 8 * 128 * 4, AT_GSEL = AT_SEL + 8 * 8 * 4 * 4, AT_OUT = AT_GSEL + 8 * 2 * 4 * 4, AT_END = AT_OUT + 8 * 32 * 64 * 4;
#ifdef EMU
DEV float rexp2(float x) { return exp2f(x); }
DEV unsigned uni(unsigned x) { return x; }
#else
DEV float rexp2(float x) { return __builtin_amdgcn_exp2f(x); }
DEV unsigned uni(unsigned x) { return (unsigned)__builtin_amdgcn_readfirstlane((int)x); }
#endif
template <int MASK, bool WITH_PV, bool FULL, int GM>
DEV void attn_block(const bf16* Kp, const bf16* Vp, const bf16x8 (&qf)[2][2], int j, const int (&s)[2], const bool (&selbit)[2], float C2, int h, int c,
                    f32x4 (&O)[2][4], f32x4 (&Ol)[2], f32x4 (&pout)[2][2][2]) {
    f32x4 st[2][2][2];
#pragma unroll
    for (int sp = 0; sp < 2; ++sp)
#pragma unroll
        for (int u = 0; u < 2; ++u) { const int krow = 32 * sp + 8 * (c >> 2) + 4 * u + (c & 3);
#pragma unroll
            for (int G = 0; G < 2; ++G) { st[G][sp][u][0] = -C2; st[G][sp][u][1] = -C2; st[G][sp][u][2] = -C2; st[G][sp][u][3] = -C2; }
#pragma unroll
            for (int ks = 0; ks < 2; ++ks) { const bf16x8 kf = *(const bf16x8*)(Kp + krow * LDT + 32 * ks + 8 * h);
#pragma unroll
                for (int G = 0; G < 2; ++G) if (GM & (1 << G)) st[G][sp][u] = mfma16(kf, qf[G][ks], st[G][sp][u]); } }
#pragma unroll
    for (int G = 0; G < 2; ++G) if (GM & (1 << G))
#pragma unroll
        for (int sp = 0; sp < 2; ++sp)
#pragma unroll
            for (int u = 0; u < 2; ++u)
#pragma unroll
                for (int r = 0; r < 4; ++r) { bool ok = selbit[G];
                    if (!FULL) { const int key = 64 * j + 32 * sp + 8 * h + 4 * u + r;
                        if (MASK == 0) ok = 16 * key + 31 <= s[G]; else if (MASK == 1) ok = selbit[G] && key <= s[G]; else ok = key <= s[G] && key > s[G] - 512; }
                    pout[G][sp][u][r] = ok ? rexp2(st[G][sp][u][r]) : 0.f; }
    if (WITH_PV) {
        bf16x8 pb[2][2], ones;
#pragma unroll
        for (int q = 0; q < 8; ++q) ones[q] = (short)0x3F80;
#pragma unroll
        for (int G = 0; G < 2; ++G) if (GM & (1 << G))
#pragma unroll
            for (int sp = 0; sp < 2; ++sp) { pb[G][sp] = pack8(pout[G][sp][0], pout[G][sp][1]); Ol[G] = mfma16(ones, pb[G][sp], Ol[G]); }
#pragma unroll
        for (int et = 0; et < 4; ++et)
#pragma unroll
            for (int sp = 0; sp < 2; ++sp) { const bf16x8 vf = *(const bf16x8*)(Vp + (16 * et + c) * LDT + 32 * sp + 8 * h);
#pragma unroll
                for (int G = 0; G < 2; ++G) if (GM & (1 << G)) O[G][et] = mfma16(vf, pb[G][sp], O[G][et]); }
    }
}

struct ImpState { float invl[2]; float carry[2]; float* imps; int tl, hd, l, s0, qblk; };
template <int MODE>
DEV void attn_branch(bf16* Kl, bf16* Vl, const bf16* kbase, int kstride, const bf16* vbase, int vstride, int jlo, int jhi,
                     const bf16x8 (&qf)[2][2], const int (&s)[2], const unsigned* selm, const unsigned* gselm, float C2, int h, int c, int srow, int scol,
                     f32x4 (&O)[2][4], f32x4 (&Ol)[2], ImpState& im) {
    constexpr bool PV = MODE != 1; constexpr int MASK = MODE <= 1 ? 0 : MODE - 1;
    bf16x8 rk[3], rv[3]; f32x4 pt[2][2][2];
    { const bf16x8 k0 = *(const bf16x8*)(kbase + (size_t)jlo * kstride); *(bf16x8*)(Kl + srow * LDT + scol) = k0;
      if (PV) { const bf16x8 v0 = *(const bf16x8*)(vbase + (size_t)jlo * vstride); *(bf16x8*)(Vl + srow * LDT + scol) = v0; } }
#pragma unroll
    for (int u = 0; u < 3; ++u) { int jj = jlo + 1 + u; if (jj > jhi) jj = jhi; rk[(1 + u) % 3] = *(const bf16x8*)(kbase + (size_t)jj * kstride); if (PV) rv[(1 + u) % 3] = *(const bf16x8*)(vbase + (size_t)jj * vstride); }
    SYNC();
    for (int jb = jlo; jb <= jhi; jb += 3) {
#pragma unroll
        for (int u = 0; u < 3; ++u) { const int j = jb + u;
            if (j <= jhi) {
                const int cur = (j - jlo) & 1;
                bool sb[2] = {true, true}; unsigned gm = 3u;
                if (MODE == 2) { gm = 0u;
#pragma unroll
                    for (int G = 0; G < 2; ++G) { const unsigned wq = uni(gselm[G * 4 + (j >> 5)]), mq = selm[(G * 4 + im.tl) * 4 + (j >> 5)];
                        gm |= ((wq >> (j & 31)) & 1u) << G; sb[G] = (mq >> (j & 31)) & 1u; } }
                bool full;
                if (MODE <= 1) full = 1024 * j + 1039 <= im.s0; else if (MODE == 2) full = j < im.qblk; else full = (j < im.qblk) && (64 * j > im.s0 + 63 - 512);
                const bf16* Kc = Kl + cur * 64 * LDT; const bf16* Vc = Vl + cur * 64 * LDT;
                if (MODE == 2) {
                    if (full) { if (gm == 3u) attn_block<MASK, PV, true, 3>(Kc, Vc, qf, j, s, sb, C2, h, c, O, Ol, pt); else if (gm == 1u) attn_block<MASK, PV, true, 1>(Kc, Vc, qf, j, s, sb, C2, h, c, O, Ol, pt); else if (gm == 2u) attn_block<MASK, PV, true, 2>(Kc, Vc, qf, j, s, sb, C2, h, c, O, Ol, pt); }
                    else { if (gm == 3u) attn_block<MASK, PV, false, 3>(Kc, Vc, qf, j, s, sb, C2, h, c, O, Ol, pt); else if (gm == 1u) attn_block<MASK, PV, false, 1>(Kc, Vc, qf, j, s, sb, C2, h, c, O, Ol, pt); else if (gm == 2u) attn_block<MASK, PV, false, 2>(Kc, Vc, qf, j, s, sb, C2, h, c, O, Ol, pt); }
                } else { if (full) attn_block<MASK, PV, true, 3>(Kc, Vc, qf, j, s, sb, C2, h, c, O, Ol, pt); else attn_block<MASK, PV, false, 3>(Kc, Vc, qf, j, s, sb, C2, h, c, O, Ol, pt); }
                if (MODE == 1) {
#pragma unroll
                    for (int G = 0; G < 2; ++G) {
#pragma unroll
                        for (int sp = 0; sp < 2; ++sp)
#pragma unroll
                            for (int uu = 0; uu < 2; ++uu)
#pragma unroll
                                for (int r = 0; r < 4; ++r) { float p = pt[G][sp][uu][r] * im.invl[G]; p += shflx(p, 1); p += shflx(p, 2); pt[G][sp][uu][r] = p; }
                        const float r0 = shfl(pt[G][0][1][3], (im.l - 16) & 63), r1 = shfl(pt[G][1][1][3], (im.l - 16) & 63);
#pragma unroll
                        for (int sp = 0; sp < 2; ++sp)
#pragma unroll
                            for (int uu = 0; uu < 2; ++uu) { const int m = 16 * j + 8 * sp + 2 * h + uu;
                                float prev; if (uu == 1) prev = pt[G][sp][0][3]; else if (h > 0) prev = sp == 0 ? r0 : r1; else prev = sp == 0 ? im.carry[G] : r0;
                                const float val = 2.0f * (pt[G][sp][uu][0] + pt[G][sp][uu][1] + pt[G][sp][uu][2]) + pt[G][sp][uu][3] + prev;
                                if (im.hd == 0 && m < 128) im.imps[(G * 4 + im.tl) * 128 + m] = val; }
                        im.carry[G] = r1;
                    }
                }
                if (j + 1 <= jhi) {
                    *(bf16x8*)(Kl + (cur ^ 1) * 64 * LDT + srow * LDT + scol) = rk[(u + 1) % 3]; if (PV) *(bf16x8*)(Vl + (cur ^ 1) * 64 * LDT + srow * LDT + scol) = rv[(u + 1) % 3];
                    int jj = j + 4; if (jj > jhi) jj = jhi;
                    rk[(u + 1) % 3] = *(const bf16x8*)(kbase + (size_t)jj * kstride); if (PV) rv[(u + 1) % 3] = *(const bf16x8*)(vbase + (size_t)jj * vstride);
                }
                SYNC();
            }
        }
    }
}

DEV void attn_task(const Args& a, unsigned char* smem, int li, int item) {
    unsigned char* ws = wsp(a); const int tid = TID, w = tid >> 6, l = tid & 63, h = l >> 4, c = l & 15, tl = c >> 2, hd = c & 3;
    const int bg = item & 3, b = bg >> 1, g = bg & 1, tq = (SEQ / 64 - 1) - (item >> 2), s0 = tq * 64, qblk = tq;
    int s[2], row[2];
#pragma unroll
    for (int G = 0; G < 2; ++G) { s[G] = s0 + 8 * w + 4 * G + tl; row[G] = b * SEQ + s[G]; }
    bf16* Kl = (bf16*)(smem + AT_K); bf16* Vl = (bf16*)(smem + AT_V); float* imps = (float*)(smem + AT_IMP) + w * 1024; unsigned* selm = (unsigned*)(smem + AT_SEL) + w * 32;
    bf16x8 qf[2][2]; float gatec[2], gates[2], gatew[2];
#pragma unroll
    for (int G = 0; G < 2; ++G) { const bf16* qp = (const bf16*)(ws + WS_QN) + (size_t)row[G] * 512 + (g * 4 + hd) * 64 + 8 * h; qf[G][0] = *(const bf16x8*)qp; qf[G][1] = *(const bf16x8*)(qp + 32);
        const float* gp = (const float*)(ws + WS_GATE) + (size_t)row[G] * 24 + (g * 4 + hd) * 3; gatec[G] = gp[0]; gates[G] = gp[1]; gatew[G] = gp[2]; }
    const float* cs = (const float*)(ws + WS_CS) + li * 4;
    const int srow = tid >> 3, scol = (tid & 7) * 8;
    for (int i = l; i < 1024; i += 64) imps[i] = 0.f;
    SYNC();
    unsigned* gselm = (unsigned*)(smem + AT_GSEL) + w * 8; float* outl = (float*)(smem + AT_OUT) + w * 2048 + l;
    ImpState im{{0.f, 0.f}, {0.f, 0.f}, imps, tl, hd, l, s0, qblk};
    {
        const int ncv = s0 / 16 + 3, ncb0 = (ncv + 63) >> 6, ncb = ncb0 > NCP / 64 ? NCP / 64 : ncb0;
        const bf16* kcb = (const bf16*)(ws + WS_KC) + (size_t)bg * NCP * 64 + srow * 64 + scol;
        const bf16* vcb = (const bf16*)(ws + WS_VCT) + (size_t)bg * 64 * NCP + (size_t)srow * NCP + scol;
        f32x4 O[2][4], Ol[2] = {f4zero(), f4zero()};
#pragma unroll
        for (int G = 0; G < 2; ++G)
#pragma unroll
            for (int et = 0; et < 4; ++et) O[G][et] = f4zero();
        attn_branch<0>(Kl, Vl, kcb, 4096, vcb, 64, 0, ncb - 1, qf, s, selm, gselm, cs[0], h, c, srow, scol, O, Ol, im);
#pragma unroll
        for (int G = 0; G < 2; ++G) { const float lsum = Ol[G][0]; im.invl[G] = lsum > 0.f ? 1.0f / lsum : 0.f;
#pragma unroll
            for (int et = 0; et < 4; ++et)
#pragma unroll
                for (int r = 0; r < 4; ++r) outl[((G * 4 + et) * 4 + r) * 64] = gatec[G] * im.invl[G] * O[G][et][r]; }
        f32x4 ld[2] = {f4zero(), f4zero()};
        attn_branch<1>(Kl, Vl, kcb, 4096, vcb, 64, 0, ncb - 1, qf, s, selm, gselm, cs[0], h, c, srow, scol, O, ld, im);
    }
    WSYNC();
#pragma unroll 1
    for (int G = 0; G < 2; ++G) {
        const int tk = l >> 4, i = l & 15; float vals[8];
#pragma unroll
        for (int mm = 0; mm < 8; ++mm) { const int jj = i + 16 * mm; vals[mm] = jj > qblk ? NEGV : ((jj == 0 || jj == qblk || jj == qblk - 1) ? FORCEV : imps[(G * 4 + tk) * 128 + jj]); }
        unsigned mk[4] = {0u, 0u, 0u, 0u};
#pragma unroll 1
        for (int rnd = 0; rnd < 16; ++rnd) {
            float best = vals[0]; int bj = i;
#pragma unroll
            for (int mm = 1; mm < 8; ++mm) if (vals[mm] > best) { best = vals[mm]; bj = i + 16 * mm; }
#pragma unroll
            for (int o = 1; o < 16; o <<= 1) { const float ov = shflx(best, o); const int oj = shflxi(bj, o); if (ov > best || (ov == best && oj < bj)) { best = ov; bj = oj; } }
            if (best > NEGV * 0.5f) {
#pragma unroll
                for (int q = 0; q < 4; ++q) if ((bj >> 5) == q) mk[q] |= 1u << (bj & 31); }
            if ((bj & 15) == i) {
#pragma unroll
                for (int mm = 0; mm < 8; ++mm) if ((bj >> 4) == mm) vals[mm] = -3e38f; }
        }
        if (i == 0) {
#pragma unroll
            for (int q = 0; q < 4; ++q) selm[(G * 4 + tk) * 4 + q] = mk[q]; }
    }
    WSYNC();
    if (l < 8) { const int G = l >> 2, q = l & 3; gselm[l] = selm[(G * 4 + 0) * 4 + q] | selm[(G * 4 + 1) * 4 + q] | selm[(G * 4 + 2) * 4 + q] | selm[(G * 4 + 3) * 4 + q]; }
    WSYNC();
#pragma unroll
    for (int br = 0; br < 2; ++br) {
        const bf16* kb = (const bf16*)(ws + (br == 0 ? WS_KS : WS_KW)) + (size_t)bg * SEQ * 64 + tid * 8; const bf16* vb = (const bf16*)(ws + (br == 0 ? WS_VST : WS_VWT)) + (size_t)bg * NCH * 4096 + tid * 8;
        f32x4 O[2][4], Ol[2] = {f4zero(), f4zero()};
#pragma unroll
        for (int G = 0; G < 2; ++G)
#pragma unroll
            for (int et = 0; et < 4; ++et) O[G][et] = f4zero();
        if (br == 0) attn_branch<2>(Kl, Vl, kb, 4096, vb, 4096, 0, qblk, qf, s, selm, gselm, cs[1], h, c, srow, scol, O, Ol, im);
        else attn_branch<3>(Kl, Vl, kb, 4096, vb, 4096, s0 >= 511 ? (s0 - 511) >> 6 : 0, qblk, qf, s, selm, gselm, cs[2], h, c, srow, scol, O, Ol, im);
#pragma unroll
        for (int G = 0; G < 2; ++G) { const float lsum = Ol[G][0]; const float sc = (br == 0 ? gates[G] : gatew[G]) * (lsum > 0.f ? 1.0f / lsum : 0.f);
#pragma unroll
            for (int et = 0; et < 4; ++et)
#pragma unroll
                for (int r = 0; r < 4; ++r) outl[((G * 4 + et) * 4 + r) * 64] += sc * O[G][et][r]; }
    }
#pragma unroll
    for (int G = 0; G < 2; ++G) { bf16* dst = (bf16*)(ws + WS_CAT) + (size_t)row[G] * 1024 + (g * 4 + hd) * 64 + 4 * h;
#pragma unroll
        for (int et = 0; et < 4; ++et) { f32x4 o;
#pragma unroll
            for (int r = 0; r < 4; ++r) o[r] = outl[((G * 4 + et) * 4 + r) * 64];
            st_bf4(dst + 16 * et, o); } }
}

constexpr int LDH = 136;
DEV void hg_cumsum(const float* fsrc  , float* segs  , int d, int seg, float (&f)[16], float (&bc)[16], float& bend, float& bmid) {
    float run = 0.f;
#pragma unroll
    for (int i = 0; i < 16; ++i) { f[i] = fsrc[(size_t)(16 * seg + i) * 128 + d]; run += log2f(f[i]); bc[i] = run; }
    SYNC();
    segs[seg * 128 + d] = run;
    SYNC();
    const float s0 = segs[d], s1 = segs[128 + d], s2 = segs[256 + d], s3 = segs[384 + d];
    const float off = seg == 0 ? 0.f : (seg == 1 ? s0 : (seg == 2 ? s0 + s1 : s0 + s1 + s2));
#pragma unroll
    for (int i = 0; i < 16; ++i) bc[i] += off;
    bend = s0 + s1 + s2 + s3; bmid = s0 + s1;
}
DEV void hg_write16(bf16* dstrow  , const float (&v)[16]) {
    u32x4 w0, w1;
#pragma unroll
    for (int q = 0; q < 4; ++q) { w0[q] = pk2(v[2 * q], v[2 * q + 1]); w1[q] = pk2(v[8 + 2 * q], v[8 + 2 * q + 1]); }
    *(u32x4*)dstrow = w0; *(u32x4*)(dstrow + 8) = w1;
}
DEV void hg_h1_task(const Args& a, unsigned char* smem, int task) {
    unsigned char* ws = wsp(a); const int tid = TID, w = tid >> 6, l = tid & 63, h = l >> 4, c = l & 15, d = tid & 127, seg = tid >> 7;
    const int bh = task / NCH, ch = task % NCH;
    bf16* kT = (bf16*)smem; bf16* vT = kT + 128 * LDT; float* segs = (float*)(vT + 128 * LDT);
    const size_t tokb = (size_t)bh * SEQ + ch * 64;
    float f[16], bc[16], bend, bmid;
    hg_cumsum((const float*)(ws + WS_HF) + tokb * 128, segs, d, seg, f, bc, bend, bmid);
    float kv[16];
#pragma unroll
    for (int i = 0; i < 16; ++i) kv[i] = (1.0f - f[i]) * fexp2(bend - bc[i]);
    hg_write16(kT + d * LDT + 16 * seg, kv);
    const bf16* vs = (const bf16*)(ws + WS_HV) + tokb * 128;
#pragma unroll
    for (int i = 0; i < 16; ++i) kv[i] = bf2f(vs[(size_t)(16 * seg + i) * 128 + d]);
    hg_write16(vT + d * LDT + 16 * seg, kv);
    if (seg == 0) ((float*)(ws + WS_GD))[((size_t)bh * NCH + ch) * 128 + d] = fexp2(bend);
    SYNC();
    f32x4 acc[8];
#pragma unroll
    for (int et = 0; et < 8; ++et) acc[et] = f4zero();
#pragma unroll
    for (int ks = 0; ks < 2; ++ks) { const bf16x8 fa = *(const bf16x8*)(kT + (16 * w + c) * LDT + 32 * ks + 8 * h);
#pragma unroll
        for (int et = 0; et < 8; ++et) acc[et] = mfma16(fa, *(const bf16x8*)(vT + (16 * et + c) * LDT + 32 * ks + 8 * h), acc[et]); }
    float* ut = (float*)(ws + WS_UT) + ((size_t)bh * NCH + ch) * 16384;
#pragma unroll
    for (int et = 0; et < 8; ++et) *(f32x4*)(ut + (size_t)(16 * et + c) * 128 + 16 * w + 4 * h) = acc[et];
    SYNC();
}
DEV void hg_scan_task(const Args& a, int sc) {
    unsigned char* ws = wsp(a); const int bh = sc >> 3, q = (sc & 7) * 512 + TID, e = q >> 5, d0 = (q & 31) * 4;
    const float* ut = (const float*)(ws + WS_UT) + (size_t)bh * NCH * 16384 + (size_t)e * 128 + d0;
    const float* gd = (const float*)(ws + WS_GD) + (size_t)bh * NCH * 128 + d0;
    bf16* st = (bf16*)(ws + WS_ST) + (size_t)bh * NCH * 16384 + (size_t)e * 128 + d0;
    f32x4 S = f4zero();
#pragma unroll 4
    for (int ch = 0; ch < NCH; ++ch) { st_bf4(st + (size_t)ch * 16384, S);
        const f32x4 g = *(const f32x4*)(gd + (size_t)ch * 128), u = *(const f32x4*)(ut + (size_t)ch * 16384);
#pragma unroll
        for (int r = 0; r < 4; ++r) S[r] = g[r] * S[r] + u[r]; }
}
DEV void hg_h3_task(const Args& a, unsigned char* smem, int li, int task) {
    unsigned char* ws = wsp(a); const int tid = TID, w = tid >> 6, l = tid & 63, h = l >> 4, c = l & 15, d = tid & 127, seg = tid >> 7;
    const int bh = task / NCH, ch = task % NCH, b = bh >> 2, hh = bh & 3;
    bf16* At = (bf16*)smem; bf16* Bt = At + 64 * LDH; bf16* Qt = Bt + 64 * LDH; bf16* vT = Qt + 64 * LDH; float* segs = (float*)(vT + 128 * LDT); float* part = segs + 512;
    const size_t tokb = (size_t)bh * SEQ + ch * 64;
    float f[16], bc[16], bend, bmid;
    hg_cumsum((const float*)(ws + WS_HF) + tokb * 128, segs, d, seg, f, bc, bend, bmid);
    const bf16* qs = (const bf16*)(ws + WS_HQ) + tokb * 128; const bf16* vs = (const bf16*)(ws + WS_HV) + tokb * 128;
    float vv[16];
#pragma unroll
    for (int i = 0; i < 16; ++i) { const int t = 16 * seg + i; const float q = bf2f(qs[(size_t)t * 128 + d]);
        At[t * LDH + d] = (bf16)f2bf(q * fexp2(bc[i] - bmid)); Bt[t * LDH + d] = (bf16)f2bf((1.0f - f[i]) * fexp2(bmid - bc[i])); Qt[t * LDH + d] = (bf16)f2bf(q * fexp2(bc[i]));
        vv[i] = bf2f(vs[(size_t)t * 128 + d]); }
    hg_write16(vT + d * LDT + 16 * seg, vv);
    SYNC();
    const int tt = w & 3, eh = w >> 2;
    f32x4 O[4];
#pragma unroll
    for (int et = 0; et < 4; ++et) O[et] = f4zero();
#pragma unroll
    for (int sp = 0; sp < 2; ++sp) {
        if (32 * sp > 16 * tt + 15) continue;
        f32x4 st[2];
#pragma unroll
        for (int u = 0; u < 2; ++u) { st[u] = f4zero(); const int krow = 32 * sp + 8 * (c >> 2) + 4 * u + (c & 3);
#pragma unroll
            for (int ks = 0; ks < 4; ++ks) st[u] = mfma16(*(const bf16x8*)(Bt + krow * LDH + 32 * ks + 8 * h), *(const bf16x8*)(At + (16 * tt + c) * LDH + 32 * ks + 8 * h), st[u]);
#pragma unroll
            for (int r = 0; r < 4; ++r) { const int sk = 32 * sp + 8 * h + 4 * u + r; if (sk > 16 * tt + c) st[u][r] = 0.f; } }
        const bf16x8 pb = pack8(st[0], st[1]);
#pragma unroll
        for (int et = 0; et < 4; ++et) O[et] = mfma16(*(const bf16x8*)(vT + (64 * eh + 16 * et + c) * LDT + 32 * sp + 8 * h), pb, O[et]);
    }
    const bf16* stp = (const bf16*)(ws + WS_ST) + ((size_t)bh * NCH + ch) * 16384;
#pragma unroll
    for (int ks = 0; ks < 4; ++ks) { const bf16x8 fq = *(const bf16x8*)(Qt + (16 * tt + c) * LDH + 32 * ks + 8 * h);
#pragma unroll
        for (int et = 0; et < 4; ++et) O[et] = mfma16(*(const bf16x8*)(stp + (size_t)(64 * eh + 16 * et + c) * 128 + 32 * ks + 8 * h), fq, O[et]); }
    float ss = 0.f;
#pragma unroll
    for (int et = 0; et < 4; ++et)
#pragma unroll
        for (int r = 0; r < 4; ++r) ss += O[et][r] * O[et][r];
    ss += shflx(ss, 16); ss += shflx(ss, 32);
    if (h == 0) part[eh * 64 + 16 * tt + c] = ss;
    SYNC();
    const float rs = frsq((part[16 * tt + c] + part[64 + 16 * tt + c]) * (1.0f / 128.0f) + EPS);
    const int tok = b * SEQ + ch * 64 + 16 * tt + c;
    const float* og = INP(a, I_OG) + li * 128; const bf16* hg = (const bf16*)(ws + WS_HGS) + (size_t)tok * 512 + hh * 128;
    bf16* dst = (bf16*)(ws + WS_CAT) + (size_t)tok * 1024 + 512 + hh * 128;
#pragma unroll
    for (int et = 0; et < 4; ++et) { const int e = 64 * eh + 16 * et + 4 * h; f32x4 o;
#pragma unroll
        for (int r = 0; r < 4; ++r) o[r] = O[et][r] * rs * og[e + r] * bf2f(hg[e + r]);
        st_bf4(dst + e, o); }
    SYNC();
}

DEV void conv_task(const Args& a, unsigned char* smem, int li, int task) {
    unsigned char* ws = wsp(a); const int tid = TID, w = tid >> 6, lane = tid & 63;
    const bool act = tid < DM / 2; const int c0 = act ? 2 * tid : 0;
    const int t0 = task * 16, b = t0 / SEQ, s0 = t0 % SEQ;
    float* red = (float*)smem;
    const float* dw = INP(a, I_DW) + (size_t)li * 31 * DM + c0;
    float acc[16][2];
    const float b0 = INP(a, I_DWB)[li * DM + c0], b1 = INP(a, I_DWB)[li * DM + c0 + 1];
#pragma unroll
    for (int t = 0; t < 16; ++t) { acc[t][0] = b0; acc[t][1] = b1; }
    const bf16* glu = (const bf16*)(ws + WS_GLU) + (size_t)b * SEQ * DM + c0;
    unsigned uu[46];
    { const bf16* gp = glu + (size_t)(s0 - 30) * DM;
#pragma unroll
    for (int r = 0; r < 46; ++r) { const int si = s0 + r - 30; uu[r] = si >= 0 ? *(const unsigned*)gp : 0u; gp += DM; OPAQUE(gp); } }
    const float* dwp = dw;
#pragma unroll
    for (int j = 0; j < 31; ++j) { const float w0 = dwp[0], w1 = dwp[1]; dwp += DM; OPAQUE(dwp);
#pragma unroll
        for (int t = 0; t < 16; ++t) { const unsigned q = uu[t + j]; acc[t][0] += w0 * bf2f(q & 0xffff); acc[t][1] += w1 * bf2f(q >> 16); } }
    float mean[16], rstd[16];
    SYNC();
#pragma unroll
    for (int t = 0; t < 16; ++t) { float s = act ? acc[t][0] + acc[t][1] : 0.f;
#pragma unroll
        for (int o = 1; o < 64; o <<= 1) s += shflx(s, o);
        if (lane == 0) red[w * 16 + t] = s; }
    SYNC();
#pragma unroll
    for (int t = 0; t < 16; ++t) { float s = 0.f;
#pragma unroll
        for (int q = 0; q < 8; ++q) s += red[q * 16 + t];
        mean[t] = s * (1.0f / DM); }
    SYNC();
#pragma unroll
    for (int t = 0; t < 16; ++t) { const float d0 = acc[t][0] - mean[t], d1 = acc[t][1] - mean[t]; float s = act ? d0 * d0 + d1 * d1 : 0.f;
#pragma unroll
        for (int o = 1; o < 64; o <<= 1) s += shflx(s, o);
        if (lane == 0) red[w * 16 + t] = s; }
    SYNC();
#pragma unroll
    for (int t = 0; t < 16; ++t) { float s = 0.f;
#pragma unroll
        for (int q = 0; q < 8; ++q) s += red[q * 16 + t];
        rstd[t] = frsq(s * (1.0f / DM) + EPS); }
    if (act) {
        const float g0 = INP(a, I_LNG)[li * DM + c0], g1 = INP(a, I_LNG)[li * DM + c0 + 1], e0 = INP(a, I_LNB)[li * DM + c0], e1 = INP(a, I_LNB)[li * DM + c0 + 1];
        bf16* dst = (bf16*)(ws + WS_CAT) + (size_t)t0 * DM + c0;
#pragma unroll
        for (int t = 0; t < 16; ++t) { const float y0 = (acc[t][0] - mean[t]) * rstd[t] * g0 + e0, y1 = (acc[t][1] - mean[t]) * rstd[t] * g1 + e1;
            *(unsigned*)(dst + (size_t)t * DM) = pk2(siluf(y0), siluf(y1)); }
    }
}

constexpr int N_PHASES = 1 + 16 * (DEPTH / 2) + 1;
DEV void phase_decode(int ph, int& l, int& sub) {
    const int q = ph - 1, pair = q >> 4, r = q & 15;
    if (r < 9) { l = 2 * pair; sub = r; } else { l = 2 * pair + 1; const int rr = r - 9; sub = rr < 3 ? rr : rr + 2; }
}
constexpr int LDS_BYTES = 150 * 1024;

DEV void run_phase(const Args& a, unsigned char* smem, int ph) {
#ifndef ONLY
#define ONLY -1
#endif
#define EN(k) (ONLY < 0 || ONLY == (k))
    if (ph == 0) { if (EN(100)) p0_phase(a, smem); return; }
    if (ph == N_PHASES - 1) { if (EN(0)) norm_phase(a, smem, DEPTH); return; }
    int l, sub; phase_decode(ph, l, sub); const int li = l >> 1; const bool even = (l & 1) == 0;
    unsigned char* ws = wsp(a);
    switch (sub) {
    case 0: if (EN(0)) norm_phase(a, smem, l); break;
    case 1: if (even) { if (EN(1)) inproj_phase(a, smem, li); } else { if (EN(11)) pw1_phase(a, smem, li); } break;
    case 2:
        if (even) { constexpr int NCI = 8 * ((NCP + 255) / 256); constexpr int NH1 = 8 * NCH;
            for (int it = BID; it < NCI + NH1; it += NBLK) { if (it < NCI) { if (EN(2)) cmp_phase_items(a, smem, li, it); } else { if (EN(12)) hg_h1_task(a, smem, it - NCI); } } }
        else { for (int it = BID; it < T / 16; it += NBLK) if (EN(13)) conv_task(a, smem, li, it); }
        break;
    case 3:
        if (even) { constexpr int NA = 4 * (SEQ / 64); const int G = NBLK;
            for (int r = 0; r * G < NA; ++r) { const int it = r * G + ((r & 1) ? (G - 1 - BID) : BID); if (it < NA) { if (EN(3)) attn_task(a, smem, li, it); } }
            for (int it = BID; it < 64; it += NBLK) if (EN(14)) hg_scan_task(a, it); }
        break;
    case 4: if (even) { for (int it = BID; it < 8 * NCH; it += NBLK) if (EN(4)) hg_h3_task(a, smem, li, it); } break;
    case 5:
        if (!EN(5)) break;
        if (even) resid_gemm_phase(a, smem, (const bf16*)(ws + WS_CAT), 1024, (const bf16*)(ws + WS_WOUT) + (size_t)li * DM * 1024, l);
        else resid_gemm_phase(a, smem, (const bf16*)(ws + WS_CAT), DM, (const bf16*)(ws + WS_PW2) + (size_t)li * DM * DM, l);
        break;
    case 6: if (EN(6)) route_phase(a, smem, l); break;
    case 7: if (EN(7)) moe_gemm_phase(a, smem, l, 0); break;
    case 8: if (EN(8)) moe_gemm_phase(a, smem, l, 1); break;
    }
}

#ifndef EMU
#define LAS __attribute__((address_space(3)))
#define XB_TMO      128
#define XB_XCNT(j)  (256  + 64 * (j))
#define XB_XSUB(j)  (1280 + 64 * (j))
#define XB_XGEN(j)  (2304 + 64 * (j))
#define XB_TOP      3328
#define XB_TOPGEN   3392
#define XCD_BAR_WORDS 3456
#define XB_SPIN_CAP (1u << 22)
__device__ __forceinline__ unsigned xb_ld(unsigned* p)              { return __hip_atomic_load(p, __ATOMIC_RELAXED, __HIP_MEMORY_SCOPE_AGENT); }
__device__ __forceinline__ unsigned xb_add(unsigned* p, unsigned v) { return __hip_atomic_fetch_add(p, v, __ATOMIC_RELAXED, __HIP_MEMORY_SCOPE_AGENT); }
__device__ __forceinline__ unsigned xb_xcc_id() { return (unsigned)__builtin_amdgcn_s_getreg((3 << 11) | 20) & 0xFu; }
#define XB_SPIN(cond, bar) do { unsigned _sp = 0; while (cond) { __builtin_amdgcn_s_sleep(1); \
    if ((++_sp & 255u) == 0u) { if (xb_ld(&(bar)[XB_TMO])) break; if (_sp > XB_SPIN_CAP) { atomicAdd(&(bar)[XB_TMO], 1u); break; } } } } while (0)
struct XcdBarrier { unsigned* bar; unsigned x; volatile LAS unsigned* st; };
__device__ __forceinline__ XcdBarrier xcd_barrier_post(unsigned* bar, volatile LAS unsigned* st) {
    XcdBarrier b; b.bar = bar; b.x = xb_xcc_id(); b.st = st;
    if (threadIdx.x == 0) (void)xb_add(&bar[XB_XCNT(b.x)], 1u);
    return b;
}
__device__ __forceinline__ void xcd_barrier_complete(unsigned* bar, unsigned x, unsigned& nloc, unsigned& nx) {
    const unsigned G = gridDim.x * gridDim.y * gridDim.z;
    unsigned sum, cnt, mine, sp = 0u;
    for (;;) {
        sum = 0u; cnt = 0u; mine = 0u;
#pragma unroll
        for (unsigned j = 0; j < 16; ++j) { const unsigned c = xb_ld(&bar[XB_XCNT(j)]); sum += c; cnt += (c > 0u) ? 1u : 0u; mine = (j == x) ? c : mine; }
        if (sum == G) break;
        __builtin_amdgcn_s_sleep(1);
        if ((++sp & 255u) == 0u) { if (xb_ld(&bar[XB_TMO])) break; if (sp > XB_SPIN_CAP) { atomicAdd(&bar[XB_TMO], 1u); break; } }
    }
    nloc = mine > 0u ? mine : 1u; nx = cnt > 0u ? cnt : 1u;
}
__device__ __forceinline__ void xcd_barrier(const XcdBarrier& b) {
    asm volatile("s_waitcnt vmcnt(0)" ::: "memory");
    __syncthreads();
    if (threadIdx.x == 0) {
        unsigned* bar = b.bar;
        __builtin_amdgcn_s_waitcnt(0);
        unsigned nloc = b.st[0], nx = b.st[1];
        if (nloc == 0u) { xcd_barrier_complete(bar, b.x, nloc, nx); b.st[0] = nloc; b.st[1] = nx; }
        const unsigned old = xb_add(&bar[XB_XSUB(b.x)], 1u);
        const unsigned gen = old / nloc;
        if (old + 1u == (gen + 1u) * nloc) {
            __builtin_amdgcn_fence(__ATOMIC_RELEASE, "agent");
            asm volatile("s_waitcnt vmcnt(0)" ::: "memory");
            const unsigned og = xb_add(&bar[XB_TOP], 1u);
            const unsigned tg = og / nx;
            if (og + 1u == (tg + 1u) * nx) xb_add(&bar[XB_TOPGEN], 1u);
            else XB_SPIN(xb_ld(&bar[XB_TOPGEN]) == tg, bar);
            __builtin_amdgcn_fence(__ATOMIC_ACQUIRE, "agent");
            xb_add(&bar[XB_XGEN(b.x)], 1u);
            asm volatile("s_waitcnt vmcnt(0)" ::: "memory");
        } else {
            XB_SPIN(xb_ld(&bar[XB_XGEN(b.x)]) == gen, bar);
            __builtin_amdgcn_fence(__ATOMIC_ACQUIRE, "agent");
            asm volatile("s_waitcnt vmcnt(0)" ::: "memory");
        }
    }
    __syncthreads();
}

__global__ void __launch_bounds__(NT, 2) mega(Args a) {
    extern __shared__ __attribute__((aligned(16))) unsigned char lds[];
    volatile LAS unsigned* st = (volatile LAS unsigned*)(LAS unsigned char*)(lds + LDS_BYTES - 16);
    if (threadIdx.x < 4) st[threadIdx.x] = 0u;
    __syncthreads();
    unsigned* barw = (unsigned*)(a.ws + WS_BAR);
    XcdBarrier bar = xcd_barrier_post(barw, st);
#pragma unroll 1
    for (int ph = 0; ph < N_PHASES; ++ph) {
        run_phase(a, lds, ph);
#ifdef DUP
        { int lyr = 0, sub = 100; if (ph > 0 && ph < N_PHASES - 1) phase_decode(ph, lyr, sub);
          if (sub == (DUP % 1000) && (ph == 0 || lyr == DUP / 1000) && ph < N_PHASES - 1) { xcd_barrier(bar); run_phase(a, lds, ph); } }
#endif
        if (ph + 1 < N_PHASES) xcd_barrier(bar);
    }
    if (xb_ld(&barw[XB_TMO]) != 0u) {
        const size_t gt = (size_t)blockIdx.x * NT + threadIdx.x, gs = (size_t)gridDim.x * NT;
        for (size_t i = gt; i < (size_t)T * DM; i += gs) a.out[i] = __builtin_nanf("");
    }
}

extern "C" void kernel_launch(void* const* d_in, const int* in_sizes, int n_in, void* d_out, int out_size,
                              void* d_ws, size_t ws_size, hipStream_t stream) {
    static int grid = 0;
    if (grid == 0) {
        int dev = 0, cus = 0;
        if (hipGetDevice(&dev) != hipSuccess || hipDeviceGetAttribute(&cus, hipDeviceAttributeMultiprocessorCount, dev) != hipSuccess) { grid = -1; return; }
        if (hipFuncSetAttribute((const void*)mega, hipFuncAttributeMaxDynamicSharedMemorySize, LDS_BYTES) != hipSuccess) { grid = -1; return; }
        (void)hipGetLastError();
        grid = cus;
        if (n_in != 26 || out_size != T * DM || ws_size < WS_END) { fprintf(stderr, "kernel_launch: unexpected sizes n_in %d out %d ws %zu (need %zu)\n", n_in, out_size, ws_size, (size_t)WS_END); grid = -1; return; }
    }
    if (grid < 0) return;
    (void)hipMemsetAsync((unsigned char*)d_ws + WS_BAR, 0, XCD_BAR_WORDS * 4, stream);
    Args a{};
    for (int i = 0; i < 26; ++i) a.in[i] = (const float*)d_in[i];
    a.out = (float*)d_out; a.ws = (unsigned char*)d_ws;
    hipLaunchKernelGGL(mega, dim3(grid), dim3(NT), LDS_BYTES, stream, a);
}
#endif
```

```cpp
#ifdef EMU
#include "emu.h"
#define DEV static inline
#define MDEV inline
#define OPAQUE(p)
#define OPAQUE2(a, b)
#define TID emu_tid()
#define BID (EB->bid)
#define NBLK (EB->nblk)
#define SYNC() emu_sync_block()
#define WSYNC() emu_sync_wave()
#define mfma16(a, b, c) emu_mfma16(a, b, c)
DEV float shflx(float v, int m) { return emu_shfl_f(v, (emu_tid() & 63) ^ m); }
DEV int shflxi(int v, int m) { return (int)emu_shfl_u((unsigned)v, (emu_tid() & 63) ^ m); }
DEV float shfl(float v, int s) { return emu_shfl_f(v, s); }
DEV float dpp_ror1(float v) { const int l = emu_tid() & 63; return emu_shfl_f(v, (l & 48) | ((l - 1) & 15)); }
DEV int atomic_add_i(int* p, int v) { return __atomic_fetch_add(p, v, __ATOMIC_RELAXED); }
DEV float fexp2(float x) { return exp2f(x); }
DEV float frcp(float x) { return 1.0f / x; }
DEV float frsq(float x) { return 1.0f / sqrtf(x); }
typedef short s16x4 __attribute__((vector_size(8)));
static inline s16x4 emu_tr4(const unsigned short* p) {
    EmuWave& w = EB->wave[emu_tid() >> 6]; int l = emu_tid() & 63;
    const unsigned short** tab = (const unsigned short**)w.a;
    tab[l] = p; emu_sync_wave();
    s16x4 r; int g = l & 48, i = l & 15;
    for (int q = 0; q < 4; ++q) r[q] = (short)tab[g + 4 * q + (i >> 2)][i & 3];
    emu_sync_wave(); return r;
}
#define tr4(p) emu_tr4(p)
#else
#include <hip/hip_runtime.h>
#include <cstdio>
#include <cstdint>
typedef short bf16x8 __attribute__((ext_vector_type(8)));
typedef float f32x4 __attribute__((ext_vector_type(4)));
typedef unsigned u32x4 __attribute__((ext_vector_type(4)));
typedef unsigned u32x2 __attribute__((ext_vector_type(2)));
#define DEV __device__ __forceinline__
#define MDEV __device__ __forceinline__
#define OPAQUE(p) asm volatile("" : "+v"(p))
#define OPAQUE2(a, b) asm volatile("" : "+v"(a), "+v"(b))
DEV int tid_opaque() { int t = (int)threadIdx.x; asm volatile("" : "+v"(t)); return t; }
#define TID tid_opaque()
DEV int bid_opaque() { int b = (int)blockIdx.x; asm volatile("" : "+s"(b)); return b; }
#define BID bid_opaque()
#define NBLK ((int)gridDim.x)
#define SYNC() __syncthreads()
#define WSYNC() __builtin_amdgcn_wave_barrier()
#define mfma16(a, b, c) __builtin_amdgcn_mfma_f32_16x16x32_bf16(a, b, c, 0, 0, 0)
DEV int shflxi(int x, int m) {
    if (m == 1) return __builtin_amdgcn_update_dpp(x, x, 0xB1, 0xf, 0xf, true);
    if (m == 2) return __builtin_amdgcn_update_dpp(x, x, 0x4E, 0xf, 0xf, true);
    if (m == 4) return __builtin_amdgcn_ds_swizzle(x, (4 << 10) | 0x1F);
    if (m == 8) return __builtin_amdgcn_ds_swizzle(x, (8 << 10) | 0x1F);
    if (m == 16) return __builtin_amdgcn_ds_swizzle(x, (16 << 10) | 0x1F);
    if (m == 32) { const auto r = __builtin_amdgcn_permlane32_swap((unsigned)x, (unsigned)x, false, false); return (int)((threadIdx.x & 32) ? r[0] : r[1]); }
    return __shfl_xor(x, m);
}
DEV float shflx(float v, int m) { return __builtin_bit_cast(float, shflxi(__builtin_bit_cast(int, v), m)); }
DEV float dpp_ror1(float v) { return __builtin_bit_cast(float, __builtin_amdgcn_update_dpp(0, __builtin_bit_cast(int, v), 0x121, 0xf, 0xf, false)); }
DEV float shfl(float v, int s) { return __shfl(v, s); }
DEV int atomic_add_i(int* p, int v) { return atomicAdd(p, v); }
DEV float fexp2(float x) { return __builtin_amdgcn_exp2f(x); }
DEV float frcp(float x) { return __builtin_amdgcn_rcpf(x); }
DEV float frsq(float x) { return __builtin_amdgcn_rsqf(x); }
typedef short s16x4 __attribute__((ext_vector_type(4)));
#define tr4(p) __builtin_amdgcn_ds_read_tr16_b64_v4i16((__attribute__((address_space(3))) s16x4*)(p))
#endif

typedef unsigned short bf16;

#ifndef DM
#define DM 1024
#endif
#ifndef SEQ
#define SEQ 8192
#endif
#ifndef FF
#define FF 512
#endif
constexpr int NBATCH = 2, T = NBATCH * SEQ, DEPTH = 4;
constexpr int NIN = 3352, NINP = 3456, NIN8 = 3584;
constexpr int NT = 512;
constexpr int NCH = SEQ / 64;
constexpr int NCP = SEQ / 16;
constexpr int NCMP = NCP - 1;
constexpr int MOE_ROWS = 2 * T + 32 * 256;
constexpr float EPS = 1e-6f, NEGV = -1e30f, FORCEV = 1e4f, LOG2E = 1.4426950408889634f;

constexpr size_t al(size_t x) { return (x + 255) & ~(size_t)255; }
constexpr size_t WS_BAR = 0;
constexpr size_t WS_CNT = 16384;
constexpr size_t WS_MOD = WS_CNT + (size_t)DEPTH * 32 * 256;
constexpr size_t WS_LB = al(WS_MOD + (size_t)DEPTH * 2 * 6 * DM * 4);
constexpr size_t WS_CB = al(WS_LB + 2 * 512 * 4);
constexpr size_t WS_CS = al(WS_CB + 2 * 2 * 8 * 64 * 4);
constexpr size_t WS_WIN = al(WS_CS + 64);
constexpr size_t WS_WOUT = al(WS_WIN + (size_t)2 * NIN8 * DM * 2);
constexpr size_t WS_PW1 = al(WS_WOUT + (size_t)2 * DM * 1024 * 2);
constexpr size_t WS_PW2 = al(WS_PW1 + (size_t)2 * 2 * DM * DM * 2);
constexpr size_t WS_WC = al(WS_PW2 + (size_t)2 * DM * DM * 2);
constexpr size_t WS_W13 = al(WS_WC + (size_t)2 * 2 * 64 * 2048 * 2);
constexpr size_t WS_W2 = al(WS_W13 + 256);
constexpr size_t WS_H = al(WS_W2 + 256);
constexpr size_t WS_QN = al(WS_H + (size_t)T * DM * 2);
constexpr size_t WS_KCG = al(WS_QN + (size_t)T * 512 * 2);
constexpr size_t WS_VCG = al(WS_KCG + (size_t)T * 128 * 2);
constexpr size_t WS_KS = al(WS_VCG + (size_t)T * 128 * 2);
constexpr size_t WS_KW = al(WS_KS + (size_t)T * 128 * 2);
constexpr size_t WS_VST = al(WS_KW + (size_t)T * 128 * 2);
constexpr size_t WS_VWT = al(WS_VST + (size_t)T * 128 * 2);
constexpr size_t WS_KC = al(WS_VWT + (size_t)T * 128 * 2);
constexpr size_t WS_VCT = al(WS_KC + (size_t)4 * NCP * 64 * 2);
constexpr size_t WS_GATE = al(WS_VCT + (size_t)4 * NCP * 64 * 2);
constexpr size_t WS_HQ = al(WS_GATE + (size_t)T * 24 * 4);
constexpr size_t WS_HF = al(WS_HQ + (size_t)T * 512 * 2);
constexpr size_t WS_HV = al(WS_HF + (size_t)T * 512 * 4);
constexpr size_t WS_HGS = al(WS_HV + (size_t)T * 512 * 2);
constexpr size_t WS_UT = al(WS_HGS + (size_t)T * 512 * 2);
constexpr size_t WS_ST = al(WS_UT + (size_t)8 * NCH * 128 * 128 * 4);
constexpr size_t WS_GD = al(WS_ST + (size_t)8 * NCH * 128 * 128 * 2);
constexpr size_t WS_CAT = al(WS_GD + (size_t)8 * NCH * 128 * 4);
constexpr size_t WS_GLU = al(WS_CAT + (size_t)T * 1024 * 2);
constexpr size_t WS_TIE = al(WS_GLU + (size_t)T * DM * 2);
constexpr size_t WS_TIW = al(WS_TIE + (size_t)T * 2 * 4);
constexpr size_t WS_LIST = al(WS_TIW + (size_t)T * 2 * 4);
constexpr size_t WS_ACT = al(WS_LIST + (size_t)32 * T * 4);
constexpr size_t WS_YK = al(WS_ACT + (size_t)MOE_ROWS * FF * 2);
constexpr size_t WS_WTH = al(WS_YK + (size_t)MOE_ROWS * DM * 2);
constexpr size_t WS_WTL = al(WS_WTH + (size_t)DEPTH * 48 * DM * 2);
constexpr size_t WS_AVEC = al(WS_WTL + (size_t)DEPTH * 48 * DM * 2);
constexpr size_t WS_RBIAS = al(WS_AVEC + (size_t)DEPTH * 2 * DM * 4);
constexpr size_t WS_END = al(WS_RBIAS + (size_t)DEPTH * 2 * 48 * 4);

struct Args { const float* in[26]; float* out; unsigned char* ws; };
enum { I_X = 0, I_C, I_ADAW, I_ADAB, I_NMIX, I_NFFN, I_WIN, I_WOUT, I_CWK, I_CWV, I_CPE, I_QG, I_KG, I_LBL, I_OG,
       I_PW1, I_DW, I_DWB, I_LNG, I_LNB, I_PW2, I_WG, I_WE, I_W1, I_W3, I_W2 };

#ifdef EMU
DEV unsigned char* wsp(const Args& a) { return a.ws; }
DEV float* outp(const Args& a) { return a.out; }
#else
DEV unsigned char* launder_ptr(const void* p) { unsigned long long v = (unsigned long long)p; unsigned lo = (unsigned)v, hi = (unsigned)(v >> 32);
    lo = (unsigned)__builtin_amdgcn_readfirstlane((int)lo); hi = (unsigned)__builtin_amdgcn_readfirstlane((int)hi); asm volatile("" : "+s"(lo), "+s"(hi)); typedef __attribute__((address_space(1))) unsigned char* gptr_t; return (unsigned char*)(gptr_t)(((unsigned long long)hi << 32) | lo); }
DEV unsigned char* wsp(const Args& a) { return launder_ptr(a.ws); }
DEV float* outp(const Args& a) { return (float*)launder_ptr(a.out); }
#endif

#ifdef EMU
#define INP(a, X) ((a).in[X])
#else
DEV int zero_opaque() { int z = 0; asm volatile("" : "+s"(z)); return z; }
#define INP(a, X) ((a).in[(X) + zero_opaque()])
#endif

DEV unsigned f2bf(float f) { unsigned u = __builtin_bit_cast(unsigned, f); return (u + 0x7fffu + ((u >> 16) & 1u)) >> 16; }
DEV float bf2f(unsigned h) { return __builtin_bit_cast(float, h << 16); }
#ifdef EMU
DEV unsigned pk2(float lo, float hi) { return f2bf(lo) | (f2bf(hi) << 16); }
#else
typedef float f32x2_t __attribute__((ext_vector_type(2)));
typedef __bf16 bf16x2_t __attribute__((ext_vector_type(2)));
DEV unsigned pk2(float lo, float hi) { f32x2_t v = {lo, hi}; bf16x2_t b = __builtin_convertvector(v, bf16x2_t); return __builtin_bit_cast(unsigned, b); }
#endif
DEV float sigm(float x) { return frcp(1.0f + fexp2(-x * LOG2E)); }
DEV float siluf(float x) { return x * sigm(x); }
DEV f32x4 f4zero() { f32x4 z = {0.f, 0.f, 0.f, 0.f}; return z; }
DEV bf16x8 pack8(f32x4 a, f32x4 b) {
    u32x4 w; w[0] = pk2(a[0], a[1]); w[1] = pk2(a[2], a[3]); w[2] = pk2(b[0], b[1]); w[3] = pk2(b[2], b[3]);
    return __builtin_bit_cast(bf16x8, w);
}
DEV void st_bf8(bf16* p, f32x4 a, f32x4 b) { u32x4 w; w[0] = pk2(a[0], a[1]); w[1] = pk2(a[2], a[3]); w[2] = pk2(b[0], b[1]); w[3] = pk2(b[2], b[3]); *(u32x4*)p = w; }
DEV void st_bf4(bf16* p, f32x4 v) { u32x2 w; w[0] = pk2(v[0], v[1]); w[1] = pk2(v[2], v[3]); *(u32x2*)p = w; }


#ifdef EMU
namespace pg8 {
constexpr int BM = 256, BK = 64, HALF = 128, NXCD = 8, WGM = 8;
typedef unsigned short bf16_t;
struct Unit { int pm, pn; };
struct Gemm { const bf16_t* A; const bf16_t* Bt; int M, N, K; };
struct StaticOrder {
    int nM, nN, nwg, G, c;
    void init(int M, int N, int G_, int c_) { nM = M / BM; nN = N / BM; nwg = nM * nN; G = G_; c = c_; }
    bool next(int i, Unit& u) const {
        const long L = (long)i * G + c; if (L >= nwg) return false;
        int wgid = (int)L; { const int q = nwg / NXCD, r = nwg % NXCD, xcd = wgid % NXCD, off = wgid / NXCD; wgid = (xcd < r ? xcd * (q + 1) : r * (q + 1) + (xcd - r) * q) + off; }
        const int nig = WGM * nN, gid = wgid / nig, fm = gid * WGM, gsz = (nM - fm) < WGM ? (nM - fm) : WGM;
        u.pm = fm + ((wgid % nig) % gsz); u.pn = (wgid % nig) / gsz; return true;
    }
};
template <class Epi, class Sched, bool ALIGN_EPI = false, bool SP2 = false>
static inline void gemm_phase(unsigned char*, const Gemm g, const Sched& S, const Epi& E) {
    const int tid = emu_tid(), wid = tid >> 6, lane = tid & 63, wr = wid >> 2, wc = wid & 3, fr = lane & 15, fq = lane >> 4;
    Unit u;
    for (int ui = 0; S.next(ui, u); ++ui) {
        f32x4 acc[2][2][4][2];
        for (int ai = 0; ai < 2; ++ai) for (int bj = 0; bj < 2; ++bj) for (int m = 0; m < 4; ++m) for (int n = 0; n < 2; ++n) for (int r = 0; r < 4; ++r) {
            const int row = 256 * u.pm + 128 * ai + 64 * wr + 16 * m + fr, col = 256 * u.pn + 128 * bj + 32 * wc + (Epi::PERM ? 8 * fq + 4 * n + r : 16 * n + 4 * fq + r); float sum = 0.f;
            const bf16_t* ap = g.A + (size_t)row * g.K; const bf16_t* bp = g.Bt + (size_t)col * g.K;
            for (int k = 0; k < g.K; ++k) sum += bf2f(ap[k]) * bf2f(bp[k]);
            acc[ai][bj][m][n][r] = sum; }
        E(acc, u, wr, wc, fr, fq);
    }
    emu_sync_block();
}
}
#else
namespace pg8 {
#define PG8_LAS __attribute__((address_space(3)))
typedef unsigned short bf16_t;
typedef short bf16x8 __attribute__((ext_vector_type(8)));
typedef float f32x4 __attribute__((ext_vector_type(4)));
typedef unsigned u32x4 __attribute__((ext_vector_type(4)));
constexpr int BM = 256, BK = 64, HALF = 128, HTB = HALF * BK * 2  , STAGE_BYTES = 8 * HTB, NXCD = 8, WGM = 8;

__host__ __device__ __forceinline__ int lds_byte(int r, int c) { const int st = (r >> 4) * 2 + (c >> 5), rr = r & 15, cc = c & 31, ob = rr * 64 + cc * 2; return st * 1024 + (ob ^ (((ob >> 9) & 1) << 5)); }
__host__ __device__ __forceinline__ void stage_rc(int b, int& R, int& C) { const int st = b / 1024, sb = b % 1024, swz = sb ^ (((sb >> 9) & 1) << 5); R = (st >> 1) * 16 + swz / 64; C = (st & 1) * 32 + (swz % 64) / 2; }
__host__ __device__ __forceinline__ int perm32(int rho) { const int n = rho >> 4, i = rho & 15; return 8 * (i >> 2) + 4 * n + (i & 3); }

struct Unit { int pm, pn; };
struct Gemm { const bf16_t* A; const bf16_t* Bt; int M, N, K; };

struct StaticOrder {
    int nM, nN, nwg, G, c;
    __host__ __device__ void init(int M, int N, int G_, int c_) { nM = M / BM; nN = N / BM; nwg = nM * nN; G = G_; c = c_; }
    __host__ __device__ bool next(int i, Unit& u) const {
        const long L = (long)i * G + c; if (L >= nwg) return false;
        int wgid = (int)L; { const int q = nwg / NXCD, r = nwg % NXCD, xcd = wgid % NXCD, off = wgid / NXCD; wgid = (xcd < r ? xcd * (q + 1) : r * (q + 1) + (xcd - r) * q) + off; }
        const int nig = WGM * nN, gid = wgid / nig, fm = gid * WGM, gsz = (nM - fm) < WGM ? (nM - fm) : WGM;
        u.pm = fm + ((wgid % nig) % gsz); u.pn = (wgid % nig) / gsz; return true;
    }
    __device__ __forceinline__ void a_ready(const Unit&) const {}
    __device__ __forceinline__ void done(const Unit&) const {}
};

__device__ __forceinline__ unsigned cvt_pk_bf16(float lo, float hi) { unsigned r; asm volatile("v_cvt_pk_bf16_f32 %0, %1, %2" : "=v"(r) : "v"(lo), "v"(hi)); return r; }
template <class Epi, class Sched, bool ALIGN_EPI = false, bool SP2 = false>
__device__ __forceinline__ void gemm_phase(PG8_LAS unsigned char* lds, const Gemm g, const Sched& S, const Epi& E) {
    const int tid = TID, wid = __builtin_amdgcn_readfirstlane(tid >> 6), lane = tid & 63, wr = wid >> 2, wc = wid & 3, fr = lane & 15, fq = lane >> 4;
    const int K = g.K, nt = K / BK;
    unsigned voffA[2], voffB[2];
#pragma unroll
    for (int i = 0; i < 2; ++i) { int R, C; stage_rc(tid * 16 + i * 8192, R, C); const int Rb = Epi::PERM ? ((R & ~31) + perm32(R & 31)) : R;
        voffA[i] = (unsigned)(R * K + C) * 2u; voffB[i] = (unsigned)(Rb * K + C) * 2u; }
    const size_t kstep = (size_t)(BK * 2);
    const size_t hstep = (size_t)HALF * K * 2;
    const size_t tstep = 2 * hstep;
    const unsigned ldsw = (unsigned)wid * 1024u;
    const int aoff = lds_byte(wr * 64 + fr, fq * 8), boff = lds_byte(wc * 32 + fr, fq * 8);
#define PG8_SA(b, h) (((b) * 2 + (h)) * HTB)
#define PG8_SB(b, h) ((4 + (b) * 2 + (h)) * HTB)
#define PG8_STAGE(bufoff, gbase, voff) do { _Pragma("unroll") for (int _i = 0; _i < 2; ++_i) \
        __builtin_amdgcn_global_load_lds((const unsigned*)((const char*)(gbase) + (voff)[_i]), (PG8_LAS unsigned*)(lds + (bufoff) + ldsw + _i * 8192), 16, 0, 0); } while (0)
#define PG8_LDA(dst, b, h) do { _Pragma("unroll") for (int m = 0; m < 4; ++m) _Pragma("unroll") for (int k = 0; k < 2; ++k) dst[m][k] = *(const PG8_LAS bf16x8*)(lds + PG8_SA(b, h) + aoff + m * 2048 + k * 1024); } while (0)
#define PG8_LDB(dst, b, h) do { _Pragma("unroll") for (int n = 0; n < 2; ++n) _Pragma("unroll") for (int k = 0; k < 2; ++k) dst[n][k] = *(const PG8_LAS bf16x8*)(lds + PG8_SB(b, h) + boff + n * 2048 + k * 1024); } while (0)
#define PG8_MMA(ai, bj, At, Bt) do { __builtin_amdgcn_s_setprio(1); _Pragma("unroll") for (int m = 0; m < 4; ++m) _Pragma("unroll") for (int n = 0; n < 2; ++n) _Pragma("unroll") for (int k = 0; k < 2; ++k) \
        acc[ai][bj][m][n] = __builtin_amdgcn_mfma_f32_16x16x32_bf16(Bt[n][k], At[m][k], acc[ai][bj][m][n], 0, 0, 0); __builtin_amdgcn_s_setprio(0); } while (0)
#define PG8_WAIT_V(n) asm volatile("s_waitcnt vmcnt(" #n ")" ::: "memory")
#define PG8_WAIT_L(n) asm volatile("s_waitcnt lgkmcnt(" #n ")" ::: "memory")
#define PG8_BAR __builtin_amdgcn_s_barrier()
#define PG8_SCHED __builtin_amdgcn_sched_barrier(0)
    Unit cur, nxt; int ui = 0;
    if (!S.next(0, cur)) return;
    f32x4 acc[2][2][4][2];
#pragma unroll
    for (int a = 0; a < 2; ++a)
#pragma unroll
        for (int b = 0; b < 2; ++b)
#pragma unroll
            for (int m = 0; m < 4; ++m)
#pragma unroll
                for (int n = 0; n < 2; ++n) acc[a][b][m][n] = (f32x4){0.f, 0.f, 0.f, 0.f};
    bf16x8 At[4][2], B0[2][2], B1[2][2];
    const char* cA = (const char*)g.A + (size_t)cur.pm * tstep; const char* cB = (const char*)g.Bt + (size_t)cur.pn * tstep;
    S.a_ready(cur);
    if constexpr (SP2) {
        PG8_STAGE(PG8_SB(0, 0), cB, voffB); PG8_STAGE(PG8_SB(0, 1), cB + hstep, voffB); PG8_STAGE(PG8_SA(0, 0), cA, voffA); PG8_STAGE(PG8_SA(0, 1), cA + hstep, voffA);
        if (wr == 1) PG8_BAR;
        PG8_WAIT_V(2); PG8_BAR;
        PG8_STAGE(PG8_SB(1, 0), cB + kstep, voffB); PG8_STAGE(PG8_SA(1, 0), cA + kstep, voffA); PG8_STAGE(PG8_SB(1, 1), cB + hstep + kstep, voffB);
        PG8_WAIT_V(6); PG8_BAR;
    } else {
        PG8_STAGE(PG8_SB(0, 0), cB, voffB); PG8_STAGE(PG8_SA(0, 0), cA, voffA); PG8_STAGE(PG8_SB(0, 1), cB + hstep, voffB); PG8_STAGE(PG8_SA(0, 1), cA + hstep, voffA);
        if (wr == 1) PG8_BAR;
        PG8_WAIT_V(4); PG8_BAR;
        PG8_STAGE(PG8_SB(1, 0), cB + kstep, voffB); PG8_STAGE(PG8_SA(1, 0), cA + kstep, voffA); PG8_STAGE(PG8_SB(1, 1), cB + hstep + kstep, voffB);
        PG8_WAIT_V(6); PG8_BAR;
    }
    for (;;) {
        const bool has_next = S.next(ui + 1, nxt);
        const char* nA = has_next ? (const char*)g.A + (size_t)nxt.pm * tstep : cA; const char* nB = has_next ? (const char*)g.Bt + (size_t)nxt.pn * tstep : cB;
        for (int t = 0; t < nt; t += 2) {
            const bool last = (t == nt - 2);
            const char* a1 = cA + (size_t)(t + 1) * kstep;
            const char* a2 = last ? nA : cA + (size_t)(t + 2) * kstep; const char* b2 = last ? nB : cB + (size_t)(t + 2) * kstep;
            const char* a3 = a2 + kstep; const char* b3 = b2 + kstep;
            if (last && has_next) S.a_ready(nxt);
            if constexpr (SP2) {
            PG8_LDB(B0, 0, 0); PG8_LDB(B1, 0, 1); PG8_SCHED; PG8_LDA(At, 0, 0); PG8_STAGE(PG8_SA(1, 1), a1 + hstep, voffA);
            PG8_WAIT_V(8); PG8_WAIT_L(0); PG8_BAR; PG8_MMA(0, 0, At, B0); PG8_MMA(0, 1, At, B1); PG8_BAR; PG8_SCHED;
            PG8_LDA(At, 0, 1); PG8_STAGE(PG8_SB(0, 0), b2, voffB); PG8_STAGE(PG8_SB(0, 1), b2 + hstep, voffB); PG8_STAGE(PG8_SA(0, 0), a2, voffA);
            PG8_WAIT_V(8); PG8_WAIT_L(0); PG8_BAR; PG8_MMA(1, 0, At, B0); PG8_MMA(1, 1, At, B1); PG8_BAR; PG8_SCHED;
            PG8_LDB(B0, 1, 0); PG8_LDB(B1, 1, 1); PG8_SCHED; PG8_LDA(At, 1, 0); PG8_STAGE(PG8_SA(0, 1), a2 + hstep, voffA);
            PG8_WAIT_V(8); PG8_WAIT_L(0); PG8_BAR; PG8_MMA(0, 0, At, B0); PG8_MMA(0, 1, At, B1); PG8_BAR; PG8_SCHED;
            PG8_LDA(At, 1, 1); PG8_STAGE(PG8_SB(1, 0), b3, voffB); PG8_STAGE(PG8_SB(1, 1), b3 + hstep, voffB); PG8_STAGE(PG8_SA(1, 0), a3, voffA);
            PG8_WAIT_V(8); PG8_WAIT_L(0); PG8_BAR; PG8_MMA(1, 0, At, B0); PG8_MMA(1, 1, At, B1); PG8_BAR; PG8_SCHED;
            } else {
            PG8_LDB(B0, 0, 0); PG8_SCHED; PG8_LDA(At, 0, 0); PG8_STAGE(PG8_SA(1, 1), a1 + hstep, voffA);
            PG8_WAIT_L(8); PG8_BAR; PG8_WAIT_L(0); PG8_MMA(0, 0, At, B0); PG8_BAR; PG8_SCHED;
            PG8_LDB(B1, 0, 1); PG8_STAGE(PG8_SB(0, 0), b2, voffB);
            PG8_BAR; PG8_WAIT_L(0); PG8_MMA(0, 1, At, B1); PG8_BAR;
            PG8_LDA(At, 0, 1); PG8_STAGE(PG8_SA(0, 0), a2, voffA);
            PG8_BAR; PG8_WAIT_L(0); PG8_MMA(1, 0, At, B0); PG8_BAR; PG8_SCHED;
            PG8_STAGE(PG8_SB(0, 1), b2 + hstep, voffB);
            PG8_WAIT_V(6); PG8_BAR; PG8_MMA(1, 1, At, B1); PG8_BAR;
            PG8_LDB(B0, 1, 0); PG8_SCHED; PG8_LDA(At, 1, 0); PG8_STAGE(PG8_SA(0, 1), a2 + hstep, voffA);
            PG8_WAIT_L(8); PG8_BAR; PG8_WAIT_L(0); PG8_MMA(0, 0, At, B0); PG8_BAR; PG8_SCHED;
            PG8_LDB(B1, 1, 1); PG8_STAGE(PG8_SB(1, 0), b3, voffB);
            PG8_BAR; PG8_WAIT_L(0); PG8_MMA(0, 1, At, B1); PG8_BAR;
            PG8_LDA(At, 1, 1); PG8_STAGE(PG8_SA(1, 0), a3, voffA);
            PG8_BAR; PG8_WAIT_L(0); PG8_MMA(1, 0, At, B0); PG8_BAR; PG8_SCHED;
            PG8_STAGE(PG8_SB(1, 1), b3 + hstep, voffB);
            PG8_WAIT_V(6); PG8_BAR; PG8_MMA(1, 1, At, B1); PG8_BAR;
            }
        }
        if constexpr (ALIGN_EPI) { if (wr == 0) PG8_BAR; }
        if constexpr (!Epi::AFTER_DRAIN) { E(acc, cur, wr, wc, fr, fq); S.done(cur); }
        if (!has_next) break;
#pragma unroll
        for (int a = 0; a < 2; ++a)
#pragma unroll
            for (int b = 0; b < 2; ++b)
#pragma unroll
                for (int m = 0; m < 4; ++m)
#pragma unroll
                    for (int n = 0; n < 2; ++n) acc[a][b][m][n] = (f32x4){0.f, 0.f, 0.f, 0.f};
        cur = nxt; cA = nA; cB = nB; ++ui;
        if constexpr (ALIGN_EPI) { if (wr == 1) PG8_BAR; }
    }
    PG8_WAIT_V(0);
    if constexpr (!ALIGN_EPI) { if (wr == 0) PG8_BAR; }
    PG8_BAR;
    if constexpr (Epi::AFTER_DRAIN) { E.fused(acc, cur, wr, wc, fr, fq, lds, wid, lane); S.done(cur); }
#undef PG8_SA
#undef PG8_SB
#undef PG8_STAGE
#undef PG8_LDA
#undef PG8_LDB
#undef PG8_MMA
#undef PG8_WAIT_V
#undef PG8_WAIT_L
#undef PG8_BAR
#undef PG8_SCHED
}
}
#endif

constexpr int LDT = 72;
constexpr int GEMM_AS = 256 * LDT, GEMM_BS = 128 * LDT;
constexpr int GEMM_LDS = 2 * (GEMM_AS + GEMM_BS) * 2;

template <class AF, class EPI>
DEV void gemm_tile(unsigned char* smem, AF af, const bf16* Bt, int ldb, int nvalid, int K, EPI& epi) {
    const int tid = TID, w = tid >> 6, l = tid & 63, h = l >> 4, c = l & 15, wm = w >> 1, wn = w & 1;
    bf16* As = (bf16*)smem; bf16* Bs = As + 2 * GEMM_AS;
    const bf16* ap[4]; const bf16* bp[2];
    const int col8 = (tid & 7) * 8, r0 = tid >> 3;
#pragma unroll
    for (int i = 0; i < 4; ++i) ap[i] = af(r0 + 64 * i) + col8;
#pragma unroll
    for (int i = 0; i < 2; ++i) { int rn = r0 + 64 * i; if (rn >= nvalid) rn = nvalid - 1; bp[i] = Bt + (size_t)rn * ldb + col8; }
    f32x4 acc[4][4];
#pragma unroll
    for (int i = 0; i < 4; ++i)
#pragma unroll
        for (int j = 0; j < 4; ++j) acc[i][j] = f4zero();
    bf16x8 ra[4], rb[2];
#pragma unroll
    for (int i = 0; i < 4; ++i) ra[i] = *(const bf16x8*)(ap[i]);
#pragma unroll
    for (int i = 0; i < 2; ++i) rb[i] = *(const bf16x8*)(bp[i]);
    SYNC();
#pragma unroll
    for (int i = 0; i < 4; ++i) *(bf16x8*)(As + (r0 + 64 * i) * LDT + col8) = ra[i];
#pragma unroll
    for (int i = 0; i < 2; ++i) *(bf16x8*)(Bs + (r0 + 64 * i) * LDT + col8) = rb[i];
    SYNC();
    const int nk = K / 64;
    for (int kt = 0; kt < nk; ++kt) {
        const int cur = kt & 1;
        if (kt + 1 < nk) {
#pragma unroll
            for (int i = 0; i < 4; ++i) ra[i] = *(const bf16x8*)(ap[i] + (kt + 1) * 64);
#pragma unroll
            for (int i = 0; i < 2; ++i) rb[i] = *(const bf16x8*)(bp[i] + (kt + 1) * 64);
        }
        const bf16* Ac = As + cur * GEMM_AS + (wm * 64 + c) * LDT + 8 * h;
        const bf16* Bc = Bs + cur * GEMM_BS + (wn * 64 + c) * LDT + 8 * h;
#pragma unroll
        for (int kk = 0; kk < 2; ++kk) {
            bf16x8 fa[4], fb[4];
#pragma unroll
            for (int i = 0; i < 4; ++i) { fa[i] = *(const bf16x8*)(Ac + i * 16 * LDT + kk * 32); fb[i] = *(const bf16x8*)(Bc + i * 16 * LDT + kk * 32); }
#pragma unroll
            for (int ni = 0; ni < 4; ++ni)
#pragma unroll
                for (int mi = 0; mi < 4; ++mi) acc[ni][mi] = mfma16(fb[ni], fa[mi], acc[ni][mi]);
        }
        if (kt + 1 < nk) {
            const int nx = cur ^ 1;
#pragma unroll
            for (int i = 0; i < 4; ++i) *(bf16x8*)(As + nx * GEMM_AS + (r0 + 64 * i) * LDT + col8) = ra[i];
#pragma unroll
            for (int i = 0; i < 2; ++i) *(bf16x8*)(Bs + nx * GEMM_BS + (r0 + 64 * i) * LDT + col8) = rb[i];
        }
        SYNC();
    }
    epi(acc, wm * 64, wn * 64, h, c);
}

struct ARows { const bf16* base; size_t ld; MDEV const bf16* operator()(int r) const { return base + (size_t)r * ld; } MDEV unsigned off(int r) const { return (unsigned)r * (unsigned)ld; } };

constexpr int LDB = 144;
constexpr int GEMM_BS2 = 64 * LDB;
constexpr int GEMM2_LDS = (2 * GEMM_AS + 2 * GEMM_BS2) * 2;
DEV bf16x8 tr_read8(const bf16* p0, const bf16* p1) {
    const s16x4 x = tr4(p0), y = tr4(p1); bf16x8 r;
    r[0] = x[0]; r[1] = x[1]; r[2] = x[2]; r[3] = x[3]; r[4] = y[0]; r[5] = y[1]; r[6] = y[2]; r[7] = y[3]; return r;
}
DEV int bperm(int r) { return (r & ~12) | ((r & 4) << 1) | ((r & 8) >> 1); }
template <class AF, class BF, class EPI>
DEV void gemm_tile2(unsigned char* smem, AF af, BF bf, int ldb, int K, EPI& epi) {
    const int tid = TID, w = tid >> 6, l = tid & 63, h = l >> 4, c = l & 15, wm = w >> 1, wn = w & 1, grp = w >> 2;
    bf16* As = (bf16*)smem; bf16* Bs = As + 2 * GEMM_AS;
    const bf16* abase = af.base; unsigned ao[4];
    const int col8 = (tid & 7) * 8, r0 = tid >> 3;
#pragma unroll
    for (int i = 0; i < 4; ++i) ao[i] = af.off(r0 + 64 * i) + col8;
    const int bn4 = (tid & 31) * 4, bk = tid >> 5, bkp = bperm(bk);
    const float* bp = bf(bn4); const bool bok = bp != nullptr;
    if (bok) bp += (size_t)bk * ldb;
    const size_t bstep = (size_t)16 * ldb;
    f32x4 acc[4][4];
#pragma unroll
    for (int i = 0; i < 4; ++i)
#pragma unroll
        for (int j = 0; j < 4; ++j) acc[i][j] = f4zero();
    bf16x8 ra[4]; f32x4 rb[4];
    const int nk = K / 64;
#pragma unroll
    for (int i = 0; i < 4; ++i) { ra[i] = *(const bf16x8*)(abase + ao[i]); rb[i] = bok ? *(const f32x4*)(bp + i * bstep) : f4zero(); }
    SYNC();
#pragma unroll
    for (int i = 0; i < 4; ++i) { *(bf16x8*)(As + (r0 + 64 * i) * LDT + col8) = ra[i]; st_bf4(Bs + (bkp + 16 * i) * LDB + bn4, rb[i]); }
    if (nk > 1) {
#pragma unroll
        for (int i = 0; i < 4; ++i) { ra[i] = *(const bf16x8*)(abase + (ao[i] + 64)); rb[i] = bok ? *(const f32x4*)(bp + (size_t)64 * ldb + i * bstep) : f4zero(); } }
    SYNC();
    for (int kt = 0; kt < nk; ++kt) {
        const int cur = kt & 1;
#pragma unroll
        for (int p = 0; p < 2; ++p) {
            if (grp == p) {
                const bf16* Ac = As + cur * GEMM_AS + (wm * 64 + c) * LDT + 8 * h;
                const bf16* Bc = Bs + cur * GEMM_BS2 + bperm(8 * h + (c >> 2)) * LDB + wn * 64 + 4 * (c & 3);
#pragma unroll
                for (int kk = 0; kk < 2; ++kk) {
                    bf16x8 fa[4], fb[4];
#pragma unroll
                    for (int i = 0; i < 4; ++i) { fa[i] = *(const bf16x8*)(Ac + i * 16 * LDT + kk * 32); fb[i] = tr_read8(Bc + (32 * kk) * LDB + 16 * i, Bc + (32 * kk + 8) * LDB + 16 * i); }
#pragma unroll
                    for (int ni = 0; ni < 4; ++ni)
#pragma unroll
                        for (int mi = 0; mi < 4; ++mi) acc[ni][mi] = mfma16(fb[ni], fa[mi], acc[ni][mi]);
                }
            } else if (kt + 1 < nk) {
                const int nx = cur ^ 1;
#pragma unroll
                for (int i = 0; i < 4; ++i) { *(bf16x8*)(As + nx * GEMM_AS + (r0 + 64 * i) * LDT + col8) = ra[i]; st_bf4(Bs + nx * GEMM_BS2 + (bkp + 16 * i) * LDB + bn4, rb[i]); }
                if (kt + 2 < nk) {
#pragma unroll
                    for (int i = 0; i < 4; ++i) { ra[i] = *(const bf16x8*)(abase + (ao[i] + (kt + 2) * 64)); rb[i] = bok ? *(const f32x4*)(bp + (size_t)(kt + 2) * 64 * ldb + i * bstep) : f4zero(); } }
            }
            SYNC();
        }
    }
    epi(acc, wm * 64, wn * 64, h, c);
}
struct BPlain { const float* base; MDEV const float* operator()(int nt) const { return base + nt; } };
struct BInProjMap { const float* base; int n0; MDEV const float* operator()(int nt) const { const int n = n0 + nt; const int sc = n < 1280 ? n : (n < 3328 ? n + 24 : (n < 3352 ? 1280 + (n - 3328) : -1)); return sc < 0 ? nullptr : base + sc; } };
struct BInter { const float* s0; const float* s1; int n0; MDEV const float* operator()(int nt) const { const int n = n0 + nt, g = n >> 6, w = n & 63; return w < 32 ? s0 + g * 32 + w : s1 + g * 32 + w - 32; } };
struct BClamp64 { const float* base; MDEV const float* operator()(int nt) const { return base + (nt & 63); } };

struct EpiInProj {
    const Args* a; int m0, n0, li;
    MDEV void operator()(f32x4 (&acc)[4][4], int mw, int nw, int h, int c) const {
        unsigned char* ws = wsp(*a);
        const int nb = n0 + nw;
        const int tokb = m0 + mw + c;
        if (nb < 512 || (nb >= 768 && nb < 896) || (nb >= 1024 && nb < 1152)) {
            const float* gain; float mul = 1.f; bf16* dst; int kind;
            if (nb < 512) { gain = INP(*a, I_QG) + li * 64; mul = 0.125f * LOG2E; kind = 0; dst = (bf16*)(ws + WS_QN); }
            else if (nb < 896) { gain = INP(*a, I_KG) + (li * 3 + 1) * 64; kind = 1; dst = (bf16*)(ws + WS_KS); }
            else { gain = INP(*a, I_KG) + (li * 3 + 2) * 64; kind = 1; dst = (bf16*)(ws + WS_KW); }
            const int g = (nb >> 6) & 1;
#pragma unroll
            for (int mi = 0; mi < 4; ++mi) {
                float ss = 0.f;
#pragma unroll
                for (int ni = 0; ni < 4; ++ni) { f32x4 v = acc[ni][mi]; ss += v[0] * v[0] + v[1] * v[1] + v[2] * v[2] + v[3] * v[3]; }
                ss += shflx(ss, 16); ss += shflx(ss, 32);
                const float rs = frsq(ss * (1.0f / 64.0f) + EPS) * mul;
                const int tok = tokb + 16 * mi;
#pragma unroll
                for (int ni = 0; ni < 4; ++ni) {
                    const int d = 16 * ni + 4 * h; f32x4 v = acc[ni][mi], o;
#pragma unroll
                    for (int r = 0; r < 4; ++r) o[r] = v[r] * rs * gain[d + r];
                    if (kind == 0) st_bf4(dst + (size_t)tok * 512 + nb + d, o);
                    else { const int b = tok / SEQ, s = tok % SEQ; st_bf4(dst + ((size_t)(b * 2 + g) * SEQ + s) * 64 + d, o); }
                }
            }
        } else if (nb < 768) {
            bf16* dst = (bf16*)(ws + (nb < 640 ? WS_KCG : WS_VCG)); const int g = (nb >> 6) & 1;
#pragma unroll
            for (int mi = 0; mi < 4; ++mi) { const int tok = tokb + 16 * mi, b = tok / SEQ, s = tok % SEQ;
#pragma unroll
                for (int ni = 0; ni < 4; ++ni) st_bf4(dst + ((size_t)(b * 2 + g) * SEQ + s) * 64 + 16 * ni + 4 * h, acc[ni][mi]); }
        } else if (nb < 1280) {
            bf16* dst = (bf16*)(ws + (nb < 1024 ? WS_VST : WS_VWT)); const int g = (nb >> 6) & 1;
#pragma unroll
            for (int mi = 0; mi < 4; ++mi) { const int tok = tokb + 16 * mi, b = tok / SEQ, s = tok % SEQ;
                bf16* p = dst + ((size_t)(b * 2 + g) * NCH + (s >> 6)) * 4096 + (s & 63);
#pragma unroll
                for (int ni = 0; ni < 4; ++ni)
#pragma unroll
                    for (int r = 0; r < 4; ++r) p[(16 * ni + 4 * h + r) * 64] = (bf16)f2bf(acc[ni][mi][r]); }
        } else if (nb < 3328) {
            const int sec = (nb - 1280) >> 9, cc = (nb - 1280) & 511, hh = cc >> 7, d0 = cc & 127;
#pragma unroll
            for (int mi = 0; mi < 4; ++mi) { const int tok = tokb + 16 * mi, b = tok / SEQ, s = tok % SEQ;
                const size_t hrow = ((size_t)(b * 4 + hh) * SEQ + s) * 128 + d0;
#pragma unroll
                for (int ni = 0; ni < 4; ++ni) { const int d = 16 * ni + 4 * h; f32x4 v = acc[ni][mi], o;
                    if (sec == 0) { for (int r = 0; r < 4; ++r) o[r] = siluf(v[r]); st_bf4((bf16*)(ws + WS_HQ) + hrow + d, o); }
                    else if (sec == 1) { const float* lb = (const float*)(ws + WS_LB) + li * 512 + cc + d;
                        for (int r = 0; r < 4; ++r) o[r] = lb[r] + (1.0f - lb[r]) * sigm(v[r]);
                        *(f32x4*)((float*)(ws + WS_HF) + hrow + d) = o; }
                    else if (sec == 2) st_bf4((bf16*)(ws + WS_HV) + hrow + d, v);
                    else { for (int r = 0; r < 4; ++r) o[r] = siluf(v[r]); st_bf4((bf16*)(ws + WS_HGS) + (size_t)tok * 512 + cc + d, o); }
                } }
        } else if (nb == 3328) {
            float* dst = (float*)(ws + WS_GATE);
#pragma unroll
            for (int mi = 0; mi < 4; ++mi) { const int tok = tokb + 16 * mi;
#pragma unroll
                for (int ni = 0; ni < 2; ++ni)
#pragma unroll
                    for (int r = 0; r < 4; ++r) { const int n = 16 * ni + 4 * h + r; if (n < 24) dst[(size_t)tok * 24 + n] = sigm(acc[ni][mi][r]); } }
        }
    }
};

struct EpiResid {
    float* x; const float* gate; int m0, n0;
    MDEV void operator()(f32x4 (&acc)[4][4], int mw, int nw, int h, int c) const {
#pragma unroll
        for (int mi = 0; mi < 4; ++mi) { const int tok = m0 + mw + 16 * mi + c, b = tok / SEQ;
#pragma unroll
            for (int ni = 0; ni < 4; ++ni) { const int n = n0 + nw + 16 * ni + 4 * h;
                f32x4 g = *(const f32x4*)(gate + (size_t)b * 6 * DM + n); f32x4* p = (f32x4*)(x + (size_t)tok * DM + n); f32x4 v = *p;
#pragma unroll
                for (int r = 0; r < 4; ++r) v[r] += g[r] * acc[ni][mi][r];
                *p = v; } }
    }
};
template <int MODE> struct EpiGated {
    bf16* dst; size_t ld; int m0, n0, mvalid;
    MDEV void operator()(f32x4 (&acc)[4][4], int mw, int nw, int h, int c) const {
        const int cb = (n0 + nw) / 2;
#pragma unroll
        for (int mi = 0; mi < 4; ++mi) { const int m = mw + 16 * mi + c; if (m >= mvalid) continue;
#pragma unroll
            for (int ni = 0; ni < 2; ++ni) { f32x4 o;
#pragma unroll
                for (int r = 0; r < 4; ++r) { const float av = acc[ni][mi][r], bv = acc[ni + 2][mi][r]; o[r] = MODE == 0 ? av * sigm(bv) : siluf(av) * bv; }
                st_bf4(dst + (size_t)(m0 + m) * ld + cb + 16 * ni + 4 * h, o); } }
    }
};
struct EpiStoreBf {
    bf16* dst; size_t ld; int m0, n0, mvalid;
    MDEV void operator()(f32x4 (&acc)[4][4], int mw, int nw, int h, int c) const {
#pragma unroll
        for (int mi = 0; mi < 4; ++mi) { const int m = mw + 16 * mi + c; if (m >= mvalid) continue;
#pragma unroll
            for (int ni = 0; ni < 4; ++ni) st_bf4(dst + (size_t)(m0 + m) * ld + n0 + nw + 16 * ni + 4 * h, acc[ni][mi]); }
    }
};
struct EpiCmp {
    const Args* a; int kv, bg, m0, li;
    MDEV void operator()(f32x4 (&acc)[4][4], int mw, int nw, int h, int c) const {
        if (nw != 0) return;
        unsigned char* ws = wsp(*a);
        const float* bp8 = (const float*)(ws + WS_CB) + (li * 2 + kv) * 8 * 64;
        float bias[16];
#pragma unroll
        for (int q = 0; q < 16; ++q) { const int e = 16 * (q >> 2) + 4 * h + (q & 3); float v = 0.f;
#pragma unroll
            for (int kp = 0; kp < 8; ++kp) v += bp8[kp * 64 + e];
            bias[q] = v; }
        const float* gain = INP(*a, I_KG) + (li * 3 + 0) * 64;
#pragma unroll
        for (int mi = 0; mi < 4; ++mi) { const int n = m0 + mw + 16 * mi + c; const bool ok = n < NCMP;
            f32x4 v[4]; float ss = 0.f;
#pragma unroll
            for (int ni = 0; ni < 4; ++ni) { v[ni] = acc[ni][mi];
#pragma unroll
                for (int r = 0; r < 4; ++r) { v[ni][r] += bias[4 * ni + r]; ss += v[ni][r] * v[ni][r]; } }
            ss += shflx(ss, 16); ss += shflx(ss, 32);
            if (n >= NCP) continue;
            if (kv == 0) { const float rs = frsq(ss * (1.0f / 64.0f) + EPS); bf16* p = (bf16*)(ws + WS_KC) + ((size_t)bg * NCP + n) * 64;
#pragma unroll
                for (int ni = 0; ni < 4; ++ni) { f32x4 o;
#pragma unroll
                    for (int r = 0; r < 4; ++r) o[r] = ok ? v[ni][r] * rs * gain[16 * ni + 4 * h + r] : 0.f;
                    st_bf4(p + 16 * ni + 4 * h, o); }
            } else { bf16* p = (bf16*)(ws + WS_VCT) + ((size_t)bg * NCP + n) * 64;
#pragma unroll
                for (int ni = 0; ni < 4; ++ni) { f32x4 o;
#pragma unroll
                    for (int r = 0; r < 4; ++r) o[r] = ok ? v[ni][r] : 0.f;
                    st_bf4(p + 16 * ni + 4 * h, o); } }
        }
    }
};


struct EpiResid8 {
    static constexpr bool PERM = true, AFTER_DRAIN = false;
    float* x; const float* gate;
    MDEV void operator()(const f32x4 (&acc)[2][2][4][2], const pg8::Unit& u, int wr, int wc, int fr, int fq) const {
        OPAQUE2(fr, fq);
#pragma unroll
        for (int ai = 0; ai < 2; ++ai)
#pragma unroll
            for (int m = 0; m < 4; ++m) { const int row = 256 * u.pm + 128 * ai + 64 * wr + 16 * m + fr, b = row / SEQ;
#pragma unroll
                for (int bj = 0; bj < 2; ++bj)
#pragma unroll
                    for (int n = 0; n < 2; ++n) { const int col = 256 * u.pn + 128 * bj + 32 * wc + 8 * fq + 4 * n;
                        const f32x4 g = *(const f32x4*)(gate + (size_t)b * 6 * DM + col); f32x4* p = (f32x4*)(x + (size_t)row * DM + col); f32x4 v = *p;
#pragma unroll
                        for (int r = 0; r < 4; ++r) v[r] += g[r] * acc[ai][bj][m][n][r];
                        *p = v; } }
    }
};
struct EpiGlu8 {
    static constexpr bool PERM = true, AFTER_DRAIN = false;
    bf16* dst;
    MDEV void operator()(const f32x4 (&acc)[2][2][4][2], const pg8::Unit& u, int wr, int wc, int fr, int fq) const {
        OPAQUE2(fr, fq);
#pragma unroll
        for (int ai = 0; ai < 2; ++ai)
#pragma unroll
            for (int m = 0; m < 4; ++m) { const int row = 256 * u.pm + 128 * ai + 64 * wr + 16 * m + fr;
#pragma unroll
                for (int bj = 0; bj < 2; ++bj) { const int col = 128 * u.pn + 64 * bj + 16 * wc + 4 * fq; f32x4 o;
#pragma unroll
                    for (int r = 0; r < 4; ++r) o[r] = acc[ai][bj][m][0][r] * sigm(acc[ai][bj][m][1][r]);
                    st_bf4(dst + (size_t)row * DM + col, o); } }
    }
};
struct EpiInProj8 {
    static constexpr bool PERM = true, AFTER_DRAIN = false;
    const Args* a; int li;
    MDEV void operator()(const f32x4 (&acc)[2][2][4][2], const pg8::Unit& u, int wr, int wc, int fr, int fq) const {
        OPAQUE2(fr, fq);
        unsigned char* ws = wsp(*a);
        const int nb = 256 * u.pn + 64 * wc;
        if (nb >= 3392) return;
        if (nb < 512 || (nb >= 768 && nb < 896) || (nb >= 1024 && nb < 1152)) {
            const float* gain; float mul = 1.f; int kind;
            if (nb < 512) { gain = INP(*a, I_QG) + li * 64; mul = 0.125f * LOG2E; kind = 0; }
            else if (nb < 896) { gain = INP(*a, I_KG) + (li * 3 + 1) * 64; kind = 1; }
            else { gain = INP(*a, I_KG) + (li * 3 + 2) * 64; kind = 2; }
            const int g = (nb >> 6) & 1;
            f32x4 gv[2][2];
#pragma unroll
            for (int bj = 0; bj < 2; ++bj)
#pragma unroll
                for (int n = 0; n < 2; ++n) gv[bj][n] = *(const f32x4*)(gain + 32 * bj + 8 * fq + 4 * n);
#pragma unroll
            for (int ai = 0; ai < 2; ++ai)
#pragma unroll
                for (int m = 0; m < 4; ++m) { const int tok = 256 * u.pm + 128 * ai + 64 * wr + 16 * m + fr;
                    float ss = 0.f;
#pragma unroll
                    for (int bj = 0; bj < 2; ++bj)
#pragma unroll
                        for (int n = 0; n < 2; ++n) { const f32x4 v = acc[ai][bj][m][n]; ss += v[0] * v[0] + v[1] * v[1] + v[2] * v[2] + v[3] * v[3]; }
                    ss += shflx(ss, 16); ss += shflx(ss, 32);
                    const float rs = frsq(ss * (1.0f / 64.0f) + EPS) * mul;
                    bf16* dst; if (kind == 0) dst = (bf16*)(ws + WS_QN) + (size_t)tok * 512 + nb; else { const int b = tok / SEQ, sq = tok % SEQ; dst = (bf16*)(ws + (kind == 1 ? WS_KS : WS_KW)) + ((size_t)(b * 2 + g) * SEQ + sq) * 64; }
#pragma unroll
                    for (int bj = 0; bj < 2; ++bj) { f32x4 o0, o1;
#pragma unroll
                        for (int r = 0; r < 4; ++r) { o0[r] = acc[ai][bj][m][0][r] * rs * gv[bj][0][r]; o1[r] = acc[ai][bj][m][1][r] * rs * gv[bj][1][r]; }
                        st_bf8(dst + 32 * bj + 8 * fq, o0, o1); } }
        } else if (nb < 768) {
            bf16* base = (bf16*)(ws + (nb < 640 ? WS_KCG : WS_VCG)); const int g = (nb >> 6) & 1;
#pragma unroll
            for (int ai = 0; ai < 2; ++ai)
#pragma unroll
                for (int m = 0; m < 4; ++m) { const int tok = 256 * u.pm + 128 * ai + 64 * wr + 16 * m + fr, b = tok / SEQ, sq = tok % SEQ;
#pragma unroll
                    for (int bj = 0; bj < 2; ++bj) st_bf8(base + ((size_t)(b * 2 + g) * SEQ + sq) * 64 + 32 * bj + 8 * fq, acc[ai][bj][m][0], acc[ai][bj][m][1]); }
        } else if (nb < 1280) {
            bf16* base = (bf16*)(ws + (nb < 1024 ? WS_VST : WS_VWT)); const int g = (nb >> 6) & 1;
#pragma unroll
            for (int ai = 0; ai < 2; ++ai)
#pragma unroll
                for (int m = 0; m < 4; ++m) { const int tok = 256 * u.pm + 128 * ai + 64 * wr + 16 * m + fr, b = tok / SEQ, sq = tok % SEQ;
#pragma unroll
                    for (int bj = 0; bj < 2; ++bj) st_bf8(base + ((size_t)(b * 2 + g) * SEQ + sq) * 64 + 32 * bj + 8 * fq, acc[ai][bj][m][0], acc[ai][bj][m][1]); }
        } else if (nb < 3328) {
            const int sec = (nb - 1280) >> 9, cc = (nb - 1280) & 511, hh = cc >> 7, d0 = cc & 127;
            f32x4 lbv[2][2];
            if (sec == 1) {
#pragma unroll
                for (int bj = 0; bj < 2; ++bj)
#pragma unroll
                    for (int n = 0; n < 2; ++n) lbv[bj][n] = *(const f32x4*)((const float*)(ws + WS_LB) + li * 512 + cc + 32 * bj + 8 * fq + 4 * n); }
#pragma unroll
            for (int ai = 0; ai < 2; ++ai)
#pragma unroll
                for (int m = 0; m < 4; ++m) { const int tok = 256 * u.pm + 128 * ai + 64 * wr + 16 * m + fr, b = tok / SEQ, sq = tok % SEQ;
                    const size_t hrow = ((size_t)(b * 4 + hh) * SEQ + sq) * 128 + d0;
#pragma unroll
                    for (int bj = 0; bj < 2; ++bj) { const int d = 32 * bj + 8 * fq; f32x4 o0, o1;
                        if (sec == 0) {
#pragma unroll
                            for (int r = 0; r < 4; ++r) { o0[r] = siluf(acc[ai][bj][m][0][r]); o1[r] = siluf(acc[ai][bj][m][1][r]); }
                            st_bf8((bf16*)(ws + WS_HQ) + hrow + d, o0, o1); }
                        else if (sec == 1) {
#pragma unroll
                            for (int r = 0; r < 4; ++r) { o0[r] = lbv[bj][0][r] + (1.0f - lbv[bj][0][r]) * sigm(acc[ai][bj][m][0][r]); o1[r] = lbv[bj][1][r] + (1.0f - lbv[bj][1][r]) * sigm(acc[ai][bj][m][1][r]); }
                            float* pf = (float*)(ws + WS_HF) + hrow + d; *(f32x4*)pf = o0; *(f32x4*)(pf + 4) = o1; }
                        else if (sec == 2) st_bf8((bf16*)(ws + WS_HV) + hrow + d, acc[ai][bj][m][0], acc[ai][bj][m][1]);
                        else {
#pragma unroll
                            for (int r = 0; r < 4; ++r) { o0[r] = siluf(acc[ai][bj][m][0][r]); o1[r] = siluf(acc[ai][bj][m][1][r]); }
                            st_bf8((bf16*)(ws + WS_HGS) + (size_t)tok * 512 + cc + d, o0, o1); } } }
        } else {
            float* dst = (float*)(ws + WS_GATE);
            if (fq < 3) {
#pragma unroll
                for (int ai = 0; ai < 2; ++ai)
#pragma unroll
                    for (int m = 0; m < 4; ++m) { const int tok = 256 * u.pm + 128 * ai + 64 * wr + 16 * m + fr; f32x4 o0, o1;
#pragma unroll
                        for (int r = 0; r < 4; ++r) { o0[r] = sigm(acc[ai][0][m][0][r]); o1[r] = sigm(acc[ai][0][m][1][r]); }
                        float* pf = dst + (size_t)tok * 24 + 8 * fq; *(f32x4*)pf = o0; *(f32x4*)(pf + 4) = o1; } }
        }
    }
};

DEV void tr_tile(unsigned char* smem, const float* src0, const float* src1, int ld, int K, int mode, bf16* dst, int n0, int k0) {
    bf16* tl = (bf16*)smem;
    const int tid = TID;
    SYNC();
#pragma unroll
    for (int i = 0; i < 8; ++i) {
        const int e = tid + 512 * i, kk = e >> 6, nn = e & 63, n = n0 + nn; float v = 0.f;
        if (mode == 0) v = src0[(size_t)(k0 + kk) * ld + n];
        else if (mode == 1) { int sc = n < 1280 ? n : (n < 3328 ? n + 24 : (n < 3352 ? 1280 + (n - 3328) : -1)); if (sc >= 0) v = src0[(size_t)(k0 + kk) * ld + sc]; }
        else { const int g = n >> 6, w = n & 63; v = (w < 32) ? src0[(size_t)(k0 + kk) * ld + g * 32 + w] : src1[(size_t)(k0 + kk) * ld + g * 32 + w - 32]; }
        tl[nn * LDT + kk] = (bf16)f2bf(v);
    }
    SYNC();
    const int nn = tid >> 3, k8 = (tid & 7) * 8;
    *(bf16x8*)(dst + (size_t)(n0 + nn) * K + k0 + k8) = *(const bf16x8*)(tl + nn * LDT + k8);
}

DEV int tr_col(int mode, int n) {
    if (mode == 0) return n;
    const int pn = n >> 8, ct = n & 255;
    if (mode == 5) { const int bj = ct >> 7, wc = (ct >> 5) & 3, j = ct & 31, L = 256 * pn + 64 * wc + 32 * bj + j; return L < 1280 ? L : (L < 3328 ? L + 24 : (L < 3352 ? 1280 + (L - 3328) : -1)); }
    { const int bj = ct >> 7, wc = (ct >> 5) & 3, j = ct & 31, nn = (j >> 2) & 1, Lc = 128 * pn + 64 * bj + 16 * wc + 4 * (j >> 3) + (j & 3); return nn == 0 ? Lc : DM + Lc; }
}
DEV void tr_tile(unsigned char* smem, const float* src, int ld, int K, int mode, bf16* dst, int n0, int k0) {
    bf16* tl = (bf16*)smem;
    const int tid = TID;
    SYNC();
    { const int nn = tid & 63, n = n0 + nn, sc = tr_col(mode, n);
#pragma unroll
      for (int i = 0; i < 8; ++i) { const int kk = (tid >> 6) + 8 * i; const float v = sc >= 0 ? src[(size_t)(k0 + kk) * ld + sc] : 0.f; tl[nn * LDT + kk] = (bf16)f2bf(v); } }
    SYNC();
    const int nn = tid >> 3, k8 = (tid & 7) * 8;
    *(bf16x8*)(dst + (size_t)(n0 + nn) * K + k0 + k8) = *(const bf16x8*)(tl + nn * LDT + k8);
}
struct TrJob { const float* s; int ld, K, N, mode; bf16* dst; };
DEV void p0_phase(const Args& a, unsigned char* smem) {
    unsigned char* ws = wsp(a); const int tid = TID;
    { int item = BID, base = 0;
      for (int j = 0; j < 8; ++j) { TrJob J; const int i = j & 1;
        if (j < 2) J = {INP(a, I_WIN) + (size_t)i * DM * NIN, NIN, DM, NIN8, 5, (bf16*)(ws + WS_WIN) + (size_t)i * NIN8 * DM};
        else if (j < 4) J = {INP(a, I_WOUT) + (size_t)i * 1024 * DM, DM, 1024, DM, 0, (bf16*)(ws + WS_WOUT) + (size_t)i * DM * 1024};
        else if (j < 6) J = {INP(a, I_PW1) + (size_t)i * DM * 2 * DM, 2 * DM, DM, 2 * DM, 6, (bf16*)(ws + WS_PW1) + (size_t)i * 2 * DM * DM};
        else J = {INP(a, I_PW2) + (size_t)i * DM * DM, DM, DM, DM, 0, (bf16*)(ws + WS_PW2) + (size_t)i * DM * DM};
        const int tn = J.N / 64, tk = J.K / 64, nt = tn * tk;
        while (item < base + nt) { const int it = item - base; tr_tile(smem, J.s, J.ld, J.K, J.mode, J.dst, (it % tn) * 64, (it / tn) * 64); item += NBLK; }
        base += nt; }
      SYNC(); }
    {
        float* red = (float*)smem;
        constexpr int NG = 6 * DM / 128; const int ntask = DEPTH * NG;
        for (int t = BID; t < ntask; t += NBLK) {
            const int l = t / NG, j0 = (t % NG) * 128, cq = tid & 31, kr = tid >> 5;
            const float* w = INP(a, I_ADAW) + (size_t)l * DM * 6 * DM + j0 + 4 * cq; const float* cc = INP(a, I_C);
            f32x4 a0 = f4zero(), a1 = f4zero();
#pragma unroll 8
            for (int i = 0; i < DM / 16; ++i) { const int k = kr + 16 * i; const f32x4 wv = *(const f32x4*)(w + (size_t)k * 6 * DM); const float s0 = siluf(cc[k]), s1 = siluf(cc[DM + k]);
#pragma unroll
                for (int r = 0; r < 4; ++r) { a0[r] += s0 * wv[r]; a1[r] += s1 * wv[r]; } }
            SYNC();
            *(f32x4*)(red + (kr * 2 + 0) * 128 + 4 * cq) = a0; *(f32x4*)(red + (kr * 2 + 1) * 128 + 4 * cq) = a1;
            SYNC();
            if (tid < 256) { const int b = tid >> 7, col = tid & 127; float sum = INP(a, I_ADAB)[(size_t)l * 6 * DM + j0 + col];
#pragma unroll
                for (int q = 0; q < 16; ++q) sum += red[(q * 2 + b) * 128 + col];
                ((float*)(ws + WS_MOD))[((size_t)l * 2 + b) * 6 * DM + j0 + col] = sum; }
        }
    }
    for (int t = BID; t < 32; t += NBLK) {
        float* red = (float*)smem; const int ikv = t >> 3, kp = t & 7, i = ikv >> 1, kv = ikv & 1, e = tid & 63, ks = tid >> 6;
        const float* W = INP(a, kv ? I_CWV : I_CWK) + (size_t)i * 2048 * 64 + e; const float* pe = INP(a, I_CPE) + (size_t)i * 2048;
        float sum = 0.f;
#pragma unroll 8
        for (int q = 0; q < 32; ++q) { const int k = kp * 256 + ks * 32 + q; sum += pe[k] * W[(size_t)k * 64]; }
        SYNC(); red[ks * 64 + e] = sum; SYNC();
        if (tid < 64) { float v = 0.f; for (int q = 0; q < 8; ++q) v += red[q * 64 + tid]; ((float*)(ws + WS_CB))[(ikv * 8 + kp) * 64 + tid] = v; }
    }
    for (int i = BID * NT + tid; i < DEPTH * 48 * DM; i += NBLK * NT) { const int k = i % DM, n = (i / DM) % 48, ll = i / (48 * DM);
        const float wv = n < 4 ? INP(a, I_WG)[((size_t)ll * DM + k) * 4 + n] : (n < 36 ? INP(a, I_WE)[((size_t)ll * DM + k) * 32 + n - 4] : 0.f);
        const unsigned hi = f2bf(wv); ((bf16*)(ws + WS_WTH))[i] = (bf16)hi; ((bf16*)(ws + WS_WTL))[i] = (bf16)f2bf(wv - bf2f(hi)); }
    if (BID == 0) {
        for (int i = tid; i < DEPTH * 32; i += NT) ((int*)(ws + WS_CNT))[i * 64] = 0;
        for (int n = tid; n < 512; n += NT) { const float l0 = INP(a, I_LBL)[n], l1 = INP(a, I_LBL)[512 + n]; const float m = fmaxf(l0, l1);
            const float e0 = fexp2((l0 - m) * LOG2E), e1 = fexp2((l1 - m) * LOG2E);
            ((float*)(ws + WS_LB))[n] = 0.f; ((float*)(ws + WS_LB))[512 + n] = e1 / (e0 + e1); }
        if (tid < 2) { const int i = tid; float mq = 0.f; for (int d = 0; d < 64; ++d) mq = fmaxf(mq, fabsf(INP(a, I_QG)[i * 64 + d]));
            for (int br = 0; br < 3; ++br) { float mk = 0.f; for (int d = 0; d < 64; ++d) mk = fmaxf(mk, fabsf(INP(a, I_KG)[(i * 3 + br) * 64 + d]));
                ((float*)(ws + WS_CS))[i * 4 + br] = 8.0f * mq * mk * LOG2E; } }
    }
}

constexpr int NJV = DM / 256;
DEV void moe_bases(const int* cnt, int* rb  ) {
    if (TID == 0) { int acc = 0; for (int e = 0; e < 32; ++e) { rb[e] = acc; acc += ((cnt[e * 64] + 255) >> 8) << 8; } rb[32] = acc; }
    SYNC();
}
DEV void norm_phase(const Args& a, unsigned char* smem, int l) {
    unsigned char* ws = wsp(a); const int tid = TID, w = tid >> 6, lane = tid & 63;
    int* rb = (int*)smem;
    if (l > 0) moe_bases((const int*)(ws + WS_CNT) + (l - 1) * 32 * 64, rb);
    const float* mod = (const float*)(ws + WS_MOD);
    const bf16* yk = (const bf16*)(ws + WS_YK);
    if (l < DEPTH) {
        const int bid = BID % 76 == BID ? BID : -1;
        for (int job = BID; job < 76; job += NBLK) {
            if (job < 72) { const int b = job / 36, n = job % 36; float sum = 0.f;
                for (int k = tid; k < DM; k += NT) { const float wv = n < 4 ? INP(a, I_WG)[((size_t)l * DM + k) * 4 + n] : INP(a, I_WE)[((size_t)l * DM + k) * 32 + n - 4]; sum += mod[((size_t)l * 2 + b) * 6 * DM + 3 * DM + k] * wv; }
#pragma unroll
                for (int q = 1; q < 64; q <<= 1) sum += shflx(sum, q);
                float* red = (float*)(smem + 1024);
                SYNC(); if (lane == 0) red[w] = sum; SYNC();
                if (tid == 0) { float t = 0.f; for (int q = 0; q < 8; ++q) t += red[q]; ((float*)(ws + WS_RBIAS))[((size_t)l * 2 + b) * 48 + n] = t; }
            } else { const float* nf = INP(a, I_NFFN) + (size_t)l * DM; const int part = job - 72;
                for (int i = part * (2 * DM / 4) + tid; i < (part + 1) * (2 * DM / 4); i += NT) { const int b = i / DM, k = i % DM; ((float*)(ws + WS_AVEC))[((size_t)l * 2 + b) * DM + k] = nf[k] * (1.0f + mod[((size_t)l * 2 + b) * 6 * DM + 4 * DM + k]); } }
        }
        (void)bid;
    }
    const int rstride = NBLK * 8;
    for (int rowa = BID * 8 + w; rowa < T; rowa += 2 * rstride) {
        int row[2]; bool ok[2];
        row[0] = rowa; ok[0] = true; row[1] = rowa + rstride; ok[1] = row[1] < T; if (!ok[1]) row[1] = rowa;
        f32x4 v[2][NJV]; int e0[2], p0[2], e1[2], p1[2]; float w0[2], w1[2];
        const float* xin = (l == 0) ? INP(a, I_X) : outp(a);
#pragma unroll
        for (int q = 0; q < 2; ++q) {
#pragma unroll
            for (int j = 0; j < NJV; ++j) v[q][j] = *(const f32x4*)(xin + (size_t)row[q] * DM + 4 * lane + 256 * j);
            if (l > 0) { const int* tie = (const int*)(ws + WS_TIE) + (size_t)row[q] * 2; const float* tiw = (const float*)(ws + WS_TIW) + (size_t)row[q] * 2;
                e0[q] = tie[0] >> 14; p0[q] = tie[0] & 16383; e1[q] = tie[1] >> 14; p1[q] = tie[1] & 16383; w0[q] = tiw[0]; w1[q] = tiw[1]; } }
        if (l > 0) {
            u32x2 q0[2][NJV], q1[2][NJV];
#pragma unroll
            for (int q = 0; q < 2; ++q) { const bf16* y0 = yk + (size_t)(rb[e0[q]] + p0[q]) * DM; const bf16* y1 = yk + (size_t)(rb[e1[q]] + p1[q]) * DM;
#pragma unroll
                for (int j = 0; j < NJV; ++j) { const int cidx = 4 * lane + 256 * j; q0[q][j] = *(const u32x2*)(y0 + cidx); q1[q][j] = *(const u32x2*)(y1 + cidx); } }
#pragma unroll
            for (int q = 0; q < 2; ++q) { const int b = row[q] / SEQ; const float* gf = mod + ((size_t)(l - 1) * 2 + b) * 6 * DM + 5 * DM;
#pragma unroll
                for (int j = 0; j < NJV; ++j) { const int cidx = 4 * lane + 256 * j; const f32x4 g = *(const f32x4*)(gf + cidx);
                    v[q][j][0] += g[0] * (w0[q] * bf2f(q0[q][j][0] & 0xffff) + w1[q] * bf2f(q1[q][j][0] & 0xffff));
                    v[q][j][1] += g[1] * (w0[q] * bf2f(q0[q][j][0] >> 16) + w1[q] * bf2f(q1[q][j][0] >> 16));
                    v[q][j][2] += g[2] * (w0[q] * bf2f(q0[q][j][1] & 0xffff) + w1[q] * bf2f(q1[q][j][1] & 0xffff));
                    v[q][j][3] += g[3] * (w0[q] * bf2f(q0[q][j][1] >> 16) + w1[q] * bf2f(q1[q][j][1] >> 16)); } }
        }
#pragma unroll
        for (int q = 0; q < 2; ++q) { if (!ok[q]) continue;
#pragma unroll
            for (int j = 0; j < NJV; ++j) *(f32x4*)(outp(a) + (size_t)row[q] * DM + 4 * lane + 256 * j) = v[q][j]; }
        if (l == DEPTH) continue;
        float ss[2];
#pragma unroll
        for (int q = 0; q < 2; ++q) { ss[q] = 0.f;
#pragma unroll
            for (int j = 0; j < NJV; ++j) ss[q] += v[q][j][0] * v[q][j][0] + v[q][j][1] * v[q][j][1] + v[q][j][2] * v[q][j][2] + v[q][j][3] * v[q][j][3]; }
#pragma unroll
        for (int o = 1; o < 64; o <<= 1) { ss[0] += shflx(ss[0], o); ss[1] += shflx(ss[1], o); }
        const float* nm = INP(a, I_NMIX) + (size_t)l * DM;
#pragma unroll
        for (int q = 0; q < 2; ++q) { if (!ok[q]) continue;
            const int b = row[q] / SEQ; const float rs = frsq(ss[q] * (1.0f / DM) + EPS);
            const float* mm = mod + ((size_t)l * 2 + b) * 6 * DM; bf16* hb = (bf16*)(ws + WS_H) + (size_t)row[q] * DM;
#pragma unroll
            for (int j = 0; j < NJV; ++j) { const int cidx = 4 * lane + 256 * j; f32x4 g = *(const f32x4*)(nm + cidx), sh = *(const f32x4*)(mm + cidx), sc = *(const f32x4*)(mm + DM + cidx), o;
#pragma unroll
                for (int r = 0; r < 4; ++r) o[r] = v[q][j][r] * rs * g[r] * (1.0f + sc[r]) + sh[r];
                st_bf4(hb + cidx, o); } }
    }
}

DEV void route_phase(const Args& a, unsigned char* smem, int l) {
    unsigned char* ws = wsp(a); const int tid = TID, w = tid >> 6, lane = tid & 63, h = lane >> 4, c = lane & 15, pi = w >> 1, kh = w & 1;
    constexpr int CH = DM / 2, WLD = CH + 8, NKS = CH / 2 / 32;
    bf16* WHl = (bf16*)smem; bf16* WLl = WHl + 48 * WLD;
    float* lg = (float*)(WLl + 48 * WLD);
    float* ssb = lg + 4 * 2 * 16 * 48;
    float* rsb = ssb + 4 * 2 * 16;
    int* lcnt = (int*)(rsb + 64); int* lbase = lcnt + 32; int* tinfo = lbase + 32;
    SYNC();
    if (tid < 32) lcnt[tid] = 0;
    SYNC();
    const float* mod = (const float*)(ws + WS_MOD);
    const bf16* WH = (const bf16*)(ws + WS_WTH) + (size_t)l * 48 * DM; const bf16* WL = (const bf16*)(ws + WS_WTL) + (size_t)l * 48 * DM;
    int* cnt = (int*)(ws + WS_CNT) + l * 32 * 64;
    constexpr int KH = DM / 2;
    for (int pass0 = BID; pass0 < T / 16; pass0 += 4 * NBLK) {
        const int pass = pass0 + pi * NBLK; const bool valid = pass < T / 16;
        const int tok = valid ? pass * 16 + c : 0, b = tok / SEQ;
        const float* xr = outp(a) + (size_t)tok * DM + kh * KH + 8 * h;
        const float* av = (const float*)(ws + WS_AVEC) + ((size_t)l * 2 + b) * DM + kh * KH + 8 * h;
        const float* cv = mod + ((size_t)l * 2 + b) * 6 * DM + 3 * DM + kh * KH + 8 * h;
        f32x4 acc[3] = {f4zero(), f4zero(), f4zero()}; float ss = 0.f;
#pragma unroll 1
        for (int chn = 0; chn < 2; ++chn) {
            const float* xq = outp(a) + (size_t)tok * DM + chn * CH + kh * (CH / 2) + 8 * h;
            const float* aq = (const float*)(ws + WS_AVEC) + ((size_t)l * 2 + b) * DM + chn * CH + kh * (CH / 2) + 8 * h;
            f32x4 xv[NKS][2], avv[NKS][2];
#pragma unroll
            for (int ks = 0; ks < NKS; ++ks) { xv[ks][0] = *(const f32x4*)(xq + 32 * ks); xv[ks][1] = *(const f32x4*)(xq + 32 * ks + 4); avv[ks][0] = *(const f32x4*)(aq + 32 * ks); avv[ks][1] = *(const f32x4*)(aq + 32 * ks + 4); }
            SYNC();
            for (int i = tid; i < 48 * (CH / 8); i += NT) { const int n = i / (CH / 8), k8 = (i % (CH / 8)) * 8;
                *(bf16x8*)(WHl + n * WLD + k8) = *(const bf16x8*)(WH + (size_t)n * DM + chn * CH + k8); *(bf16x8*)(WLl + n * WLD + k8) = *(const bf16x8*)(WL + (size_t)n * DM + chn * CH + k8); }
            SYNC();
            if (valid) {
                const bf16* whp = WHl + c * WLD + kh * (CH / 2) + 8 * h; const bf16* wlp = WLl + c * WLD + kh * (CH / 2) + 8 * h;
#pragma unroll
                for (int ks = 0; ks < NKS; ++ks) {
                    f32x4 u0, u1, r0, r1;
#pragma unroll
                    for (int r = 0; r < 4; ++r) { u0[r] = xv[ks][0][r] * avv[ks][0][r]; u1[r] = xv[ks][1][r] * avv[ks][1][r]; ss += xv[ks][0][r] * xv[ks][0][r] + xv[ks][1][r] * xv[ks][1][r]; }
                    const bf16x8 uh = pack8(u0, u1);
#pragma unroll
                    for (int r = 0; r < 4; ++r) { r0[r] = u0[r] - bf2f((unsigned short)uh[r]); r1[r] = u1[r] - bf2f((unsigned short)uh[4 + r]); }
                    const bf16x8 ul = pack8(r0, r1);
#pragma unroll
                    for (int nt = 0; nt < 3; ++nt) { const bf16x8 wh = *(const bf16x8*)(whp + nt * 16 * WLD + 32 * ks), wl = *(const bf16x8*)(wlp + nt * 16 * WLD + 32 * ks);
                        acc[nt] = mfma16(wh, uh, acc[nt]); acc[nt] = mfma16(wl, uh, acc[nt]); acc[nt] = mfma16(wh, ul, acc[nt]); }
                }
            }
        }
        if (valid) {
            ss += shflx(ss, 16); ss += shflx(ss, 32);
            float* lgp = lg + ((pi * 2 + kh) * 16 + c) * 48 + 4 * h;
#pragma unroll
            for (int nt = 0; nt < 3; ++nt) *(f32x4*)(lgp + 16 * nt) = acc[nt];
            if (h == 0) ssb[(pi * 2 + kh) * 16 + c] = ss;
        }
        SYNC();
        if (tid < 64) { const int p2 = tid >> 4, tk = tid & 15, pass2 = pass0 + p2 * NBLK;
            if (pass2 < T / 16) { const int tok2 = pass2 * 16 + tk, b2 = tok2 / SEQ;
                const float rs = frsq((ssb[(p2 * 2 + 0) * 16 + tk] + ssb[(p2 * 2 + 1) * 16 + tk]) * (1.0f / DM) + EPS); rsb[p2 * 16 + tk] = rs;
                const float* l0 = lg + ((p2 * 2 + 0) * 16 + tk) * 48; const float* l1 = lg + ((p2 * 2 + 1) * 16 + tk) * 48; const float* rbp = (const float*)(ws + WS_RBIAS) + ((size_t)l * 2 + b2) * 48;
                float acc[36];
#pragma unroll
                for (int n = 0; n < 36; ++n) acc[n] = rs * (l0[n] + l1[n]) + rbp[n];
                int gs = 0; float gm = acc[0];
#pragma unroll
                for (int g = 1; g < 4; ++g) if (acc[g] > gm) { gm = acc[g]; gs = g; }
                float den = 0.f;
#pragma unroll
                for (int g = 0; g < 4; ++g) den += fexp2((acc[g] - gm) * LOG2E);
                const float ggate = 1.0f / den;
                float el[8];
#pragma unroll
                for (int j = 0; j < 8; ++j) { el[j] = acc[4 + j];
#pragma unroll
                    for (int g = 1; g < 4; ++g) if (gs == g) el[j] = acc[4 + 8 * g + j]; }
                int ia = 0; float va = el[0];
#pragma unroll
                for (int j = 1; j < 8; ++j) if (el[j] > va) { va = el[j]; ia = j; }
                int ib = -1; float vb = -3e38f;
#pragma unroll
                for (int j = 0; j < 8; ++j) if (j != ia && el[j] > vb) { vb = el[j]; ib = j; }
                const float wa = 1.0f / (1.0f + fexp2((vb - va) * LOG2E)), wb = 1.0f - wa;
                const int e0 = gs * 8 + ia, e1 = gs * 8 + ib;
                const int p0 = atomic_add_i(lcnt + e0, 1), p1 = atomic_add_i(lcnt + e1, 1);
                int* ti = tinfo + tid * 4;
                ti[0] = (e0 << 14) | p0; ti[1] = (e1 << 14) | p1; ti[2] = __builtin_bit_cast(int, ggate * wa); ti[3] = __builtin_bit_cast(int, ggate * wb);
            } }
        SYNC();
        if (valid) { const float rs = rsb[pi * 16 + c]; bf16* hb = (bf16*)(ws + WS_H) + (size_t)tok * DM + kh * KH + 8 * h;
#pragma unroll 4
            for (int ks = 0; ks < KH / 32; ++ks) {
                const f32x4 x0 = *(const f32x4*)(xr + 32 * ks), x1 = *(const f32x4*)(xr + 32 * ks + 4), a0 = *(const f32x4*)(av + 32 * ks), a1 = *(const f32x4*)(av + 32 * ks + 4), c0 = *(const f32x4*)(cv + 32 * ks), c1 = *(const f32x4*)(cv + 32 * ks + 4);
                f32x4 o0, o1;
#pragma unroll
                for (int r = 0; r < 4; ++r) { o0[r] = x0[r] * rs * a0[r] + c0[r]; o1[r] = x1[r] * rs * a1[r] + c1[r]; }
                st_bf8(hb + 32 * ks, o0, o1); } }
        if (tid < 32) { const int n = lcnt[tid]; lbase[tid] = n > 0 ? atomic_add_i(cnt + tid * 64, n) : 0; lcnt[tid] = 0; }
        SYNC();
        if (tid < 64) { const int p2 = tid >> 4, pass2 = pass0 + p2 * NBLK;
            if (pass2 < T / 16) { const int tok2 = pass2 * 16 + (tid & 15); const int* ti = tinfo + tid * 4;
                const int e0 = ti[0] >> 14, e1 = ti[1] >> 14, p0 = lbase[e0] + (ti[0] & 16383), p1 = lbase[e1] + (ti[1] & 16383);
                int* list = (int*)(ws + WS_LIST); list[(size_t)e0 * T + p0] = tok2; list[(size_t)e1 * T + p1] = tok2;
                int* tie = (int*)(ws + WS_TIE) + (size_t)tok2 * 2; int* tiw = (int*)(ws + WS_TIW) + (size_t)tok2 * 2;
                tie[0] = (e0 << 14) | p0; tie[1] = (e1 << 14) | p1; tiw[0] = ti[2]; tiw[1] = ti[3]; } }
        SYNC();
    }
}

DEV int vbid() { const int g = NBLK; return (g % 8 == 0) ? (BID % 8) * (g / 8) + BID / 8 : BID; }
#ifdef EMU
#define PG8_LDS(p) (p)
#else
#define PG8_LDS(p) ((PG8_LAS unsigned char*)(p))
#endif
DEV void inproj_phase(const Args& a, unsigned char* smem, int li) {
    pg8::Gemm g{(const bf16*)(wsp(a) + WS_H), (const bf16*)(wsp(a) + WS_WIN) + (size_t)li * NIN8 * DM, T, NIN8, DM}; pg8::StaticOrder S; S.init(T, NIN8, NBLK, BID);
    EpiInProj8 E{&a, li};
    SYNC(); pg8::gemm_phase<EpiInProj8, pg8::StaticOrder, true, true>(PG8_LDS(smem), g, S, E); SYNC();
}
DEV void resid_gemm_phase(const Args& a, unsigned char* smem, const bf16* A, int K, const bf16* Bt, int l) {
    pg8::Gemm g{A, Bt, T, DM, K}; pg8::StaticOrder S; S.init(T, DM, NBLK, BID);
    EpiResid8 E{outp(a), (const float*)(wsp(a) + WS_MOD) + (size_t)l * 2 * 6 * DM + 2 * DM};
    SYNC(); pg8::gemm_phase<EpiResid8, pg8::StaticOrder, true, true>(PG8_LDS(smem), g, S, E); SYNC();
}
DEV void pw1_phase(const Args& a, unsigned char* smem, int li) {
    pg8::Gemm g{(const bf16*)(wsp(a) + WS_H), (const bf16*)(wsp(a) + WS_PW1) + (size_t)li * 2 * DM * DM, T, 2 * DM, DM}; pg8::StaticOrder S; S.init(T, 2 * DM, NBLK, BID);
    EpiGlu8 E{(bf16*)(wsp(a) + WS_GLU)};
    SYNC(); pg8::gemm_phase<EpiGlu8, pg8::StaticOrder, true, true>(PG8_LDS(smem), g, S, E); SYNC();
}
DEV void cmp_phase_items(const Args& a, unsigned char* smem, int li, int it) {
    constexpr int TMC = (NCP + 255) / 256;
    const int kv = it / (4 * TMC), bg = (it / TMC) % 4, tm = it % TMC;
    const bf16* src = (const bf16*)(wsp(a) + (kv ? WS_VCG : WS_KCG)) + (size_t)bg * SEQ * 64;
    struct AF { const bf16* base; int m0; MDEV unsigned off(int r) const { int n = m0 + r; if (n > NCMP - 1) n = NCMP - 1; return (unsigned)n * 1024u; } } af{src, tm * 256};
    EpiCmp E{&a, kv, bg, tm * 256, li};
    BClamp64 bf{INP(a, kv ? I_CWV : I_CWK) + (size_t)li * 2048 * 64};
    gemm_tile2(smem, af, bf, 64, 2048, E);
}
DEV void moe_gemm_phase(const Args& a, unsigned char* smem, int l, int mode) {
    unsigned char* ws = wsp(a); const int* cnt = (const int*)(ws + WS_CNT) + l * 32 * 64;
    int* rb = (int*)(smem + GEMM2_LDS);
    moe_bases(cnt, rb);
    const int ntile = rb[32] >> 8;
    constexpr int TN1 = 2 * FF / 128, TN2 = DM / 128;
    const int TN = mode == 0 ? TN1 : TN2;
    const int* list = (const int*)(ws + WS_LIST);
    for (int it = vbid(); it < ntile * TN; it += NBLK) {
        const int rt = it / TN, tn = it % TN; int e = 0;
#pragma unroll 1
        for (int q = 1; q < 32; ++q) if ((rb[q] >> 8) <= rt) e = q;
        const int rloc = (rt << 8) - rb[e], ce = cnt[e * 64], nvalid = (ce - rloc) < 256 ? (ce - rloc) : 256;
        if (mode == 0) {
            struct AF { const bf16* base; const int* lst; int nv; MDEV unsigned off(int r) const { const int rr = r < nv ? r : nv - 1; return (unsigned)lst[rr] * (unsigned)DM; } }
                af{(const bf16*)(ws + WS_H), list + (size_t)e * T + rloc, nvalid};
            EpiGated<1> E{(bf16*)(ws + WS_ACT), (size_t)FF, rt << 8, tn * 128, nvalid};
            BInter bf{INP(a, I_W1) + (size_t)(l * 32 + e) * DM * FF, INP(a, I_W3) + (size_t)(l * 32 + e) * DM * FF, tn * 128};
            gemm_tile2(smem, af, bf, FF, DM, E);
        } else {
            ARows af{(const bf16*)(ws + WS_ACT) + (size_t)(rt << 8) * FF, (size_t)FF};
            EpiStoreBf E{(bf16*)(ws + WS_YK), (size_t)DM, rt << 8, tn * 128, nvalid};
            BPlain bf{INP(a, I_W2) + (size_t)(l * 32 + e) * FF * DM + tn * 128};
            gemm_tile2(smem, af, bf, DM, FF, E);
        }
    }
}

constexpr int LDV = 80;
constexpr int AT_K = 0, AT_V = 2 * 64 * LDT * 2, AT_IMP = AT_V + 2 * 64 * LDV * 2, AT_SEL = AT_IMP + 8 * 8 * 128 * 4, AT_GSEL = AT_SEL + 8 * 8 * 4 * 4, AT_OUT = AT_GSEL + 8 * 2 * 4 * 4, AT_END = AT_OUT + 8 * 32 * 64 * 4;
#ifdef EMU
DEV float rexp2(float x) { return exp2f(x); }
DEV unsigned uni(unsigned x) { return x; }
#else
DEV float rexp2(float x) { return __builtin_amdgcn_exp2f(x); }
DEV unsigned uni(unsigned x) { return (unsigned)__builtin_amdgcn_readfirstlane((int)x); }
#endif
DEV int krow_lds(int kappa) { return 16 * (2 * (kappa >> 5) + ((kappa >> 2) & 1)) + 4 * ((kappa >> 3) & 3) + (kappa & 3); }
template <int MASK, bool FULL, int GM>
DEV void attn_block(const bf16* Kp, const bf16* Vp, const bf16x8 (&qf)[2][2], int j, const int (&s)[2], const bool (&selbit)[2], float C2, int h, int c,
                    f32x4 (&O)[2][4], f32x4 (&Ol)[2]) {
    f32x4 st[2][2][2];
#pragma unroll
    for (int sp = 0; sp < 2; ++sp)
#pragma unroll
        for (int u = 0; u < 2; ++u) {
#pragma unroll
            for (int G = 0; G < 2; ++G) { st[G][sp][u][0] = -C2; st[G][sp][u][1] = -C2; st[G][sp][u][2] = -C2; st[G][sp][u][3] = -C2; }
#pragma unroll
            for (int ks = 0; ks < 2; ++ks) { const bf16x8 kf = *(const bf16x8*)(Kp + (16 * (2 * sp + u) + c) * LDT + 32 * ks + 8 * h);
#pragma unroll
                for (int G = 0; G < 2; ++G) if (GM & (1 << G)) st[G][sp][u] = mfma16(kf, qf[G][ks], st[G][sp][u]); } }
#pragma unroll
    for (int G = 0; G < 2; ++G) if (GM & (1 << G))
#pragma unroll
        for (int sp = 0; sp < 2; ++sp)
#pragma unroll
            for (int u = 0; u < 2; ++u)
#pragma unroll
                for (int r = 0; r < 4; ++r) { bool ok = selbit[G];
                    if (!FULL) { const int key = 64 * j + 32 * sp + 8 * h + 4 * u + r;
                        if (MASK == 0) ok = 16 * key + 31 <= s[G]; else if (MASK == 1) ok = selbit[G] && key <= s[G]; else ok = key <= s[G] && key > s[G] - 512; }
                    st[G][sp][u][r] = ok ? rexp2(st[G][sp][u][r]) : 0.f; }
    bf16x8 pb[2][2], ones;
#pragma unroll
    for (int q = 0; q < 8; ++q) ones[q] = (short)0x3F80;
#pragma unroll
    for (int G = 0; G < 2; ++G) if (GM & (1 << G))
#pragma unroll
        for (int sp = 0; sp < 2; ++sp) { pb[G][sp] = pack8(st[G][sp][0], st[G][sp][1]); Ol[G] = mfma16(ones, pb[G][sp], Ol[G]); }
    const bf16* Vb = Vp + bperm(8 * h + (c >> 2)) * LDV + 4 * (c & 3);
#pragma unroll
    for (int et = 0; et < 4; ++et)
#pragma unroll
        for (int sp = 0; sp < 2; ++sp) { const bf16x8 vf = tr_read8(Vb + (32 * sp) * LDV + 16 * et, Vb + (32 * sp + 8) * LDV + 16 * et);
#pragma unroll
            for (int G = 0; G < 2; ++G) if (GM & (1 << G)) O[G][et] = mfma16(vf, pb[G][sp], O[G][et]); }
}

struct ImpState { float invq[2][4]; float carry[2]; float* imps; int tl, hd, l, s0, qblk; };
DEV void imp_block(const bf16* Kp, const bf16x8 (&qf)[2][2], int j, int s0, int w, float C2, int h, int c, ImpState& im) {
#pragma unroll
    for (int kt = 0; kt < 4; ++kt) {
        const int row = krow_lds(16 * kt + c);
        const bf16x8 k0 = *(const bf16x8*)(Kp + row * LDT + 8 * h), k1 = *(const bf16x8*)(Kp + row * LDT + 32 + 8 * h);
        const int n = 64 * j + 16 * kt + c;
#pragma unroll
        for (int G = 0; G < 2; ++G) {
            f32x4 acc; acc[0] = -C2; acc[1] = -C2; acc[2] = -C2; acc[3] = -C2;
            acc = mfma16(qf[G][0], k0, acc); acc = mfma16(qf[G][1], k1, acc);
            const bool ok = 16 * n + 31 <= s0 + 8 * w + 4 * G + h;
            float imp = 0.f;
#pragma unroll
            for (int r = 0; r < 4; ++r) imp += ok ? rexp2(acc[r]) * im.invq[G][r] : 0.f;
            const float v = ((c & 3) == 3) ? imp : 2.0f * imp;
            float sq = v + shflx(v, 1); sq += shflx(sq, 2);
            const float rr = dpp_ror1(imp);
            const float prev = (c == 0) ? im.carry[G] : rr;
            im.carry[G] = rr;
            const int m = n >> 2;
            if ((c & 3) == 0 && m < 128) im.imps[(G * 4 + h) * 128 + m] = sq + prev;
        }
    }
}

template <int MODE>
DEV void attn_branch(bf16* Kl, bf16* Vl, const bf16* kbase, const bf16* vbase, int jlo, int jhi,
                     const bf16x8 (&qf)[2][2], const int (&s)[2], const unsigned* selm, const unsigned* gselm, float C2, int w, int h, int c, int srow, int scol,
                     f32x4 (&O)[2][4], f32x4 (&Ol)[2], ImpState& im) {
    constexpr bool PV = MODE != 1; constexpr int MASK = MODE <= 1 ? 0 : MODE - 1;
    const int krow = krow_lds(srow) * LDT + scol, vrow = bperm(srow) * LDV + scol;
    bf16x8 rk[3], rv[3];
    { const bf16x8 k0 = *(const bf16x8*)(kbase + (size_t)jlo * 4096); *(bf16x8*)(Kl + krow) = k0;
      if (PV) { const bf16x8 v0 = *(const bf16x8*)(vbase + (size_t)jlo * 4096); *(bf16x8*)(Vl + vrow) = v0; } }
#pragma unroll
    for (int u = 0; u < 3; ++u) { int jj = jlo + 1 + u; if (jj > jhi) jj = jhi; rk[(1 + u) % 3] = *(const bf16x8*)(kbase + (size_t)jj * 4096); if (PV) rv[(1 + u) % 3] = *(const bf16x8*)(vbase + (size_t)jj * 4096); }
    SYNC();
    for (int jb = jlo; jb <= jhi; jb += 3) {
#pragma unroll
        for (int u = 0; u < 3; ++u) { const int j = jb + u;
            if (j <= jhi) {
                const int cur = (j - jlo) & 1;
                const bf16* Kc = Kl + cur * 64 * LDT; const bf16* Vc = Vl + cur * 64 * LDV;
                if (MODE == 1) imp_block(Kc, qf, j, im.s0, w, C2, h, c, im);
                else {
                    bool sb[2] = {true, true}; unsigned gm = 3u;
                    if (MODE == 2) { gm = 0u;
#pragma unroll
                        for (int G = 0; G < 2; ++G) { const unsigned wq = uni(gselm[G * 4 + (j >> 5)]), mq = selm[(G * 4 + im.tl) * 4 + (j >> 5)];
                            gm |= ((wq >> (j & 31)) & 1u) << G; sb[G] = (mq >> (j & 31)) & 1u; } }
                    bool full;
                    if (MODE == 0) full = 1024 * j + 1039 <= im.s0; else if (MODE == 2) full = j < im.qblk; else full = (j < im.qblk) && (64 * j > im.s0 + 63 - 512);
                    if (MODE == 2) {
                        if (full) { if (gm == 3u) attn_block<MASK, true, 3>(Kc, Vc, qf, j, s, sb, C2, h, c, O, Ol); else if (gm == 1u) attn_block<MASK, true, 1>(Kc, Vc, qf, j, s, sb, C2, h, c, O, Ol); else if (gm == 2u) attn_block<MASK, true, 2>(Kc, Vc, qf, j, s, sb, C2, h, c, O, Ol); }
                        else { if (gm == 3u) attn_block<MASK, false, 3>(Kc, Vc, qf, j, s, sb, C2, h, c, O, Ol); else if (gm == 1u) attn_block<MASK, false, 1>(Kc, Vc, qf, j, s, sb, C2, h, c, O, Ol); else if (gm == 2u) attn_block<MASK, false, 2>(Kc, Vc, qf, j, s, sb, C2, h, c, O, Ol); }
                    } else { if (full) attn_block<MASK, true, 3>(Kc, Vc, qf, j, s, sb, C2, h, c, O, Ol); else attn_block<MASK, false, 3>(Kc, Vc, qf, j, s, sb, C2, h, c, O, Ol); }
                }
                if (j + 1 <= jhi) {
                    *(bf16x8*)(Kl + (cur ^ 1) * 64 * LDT + krow) = rk[(u + 1) % 3]; if (PV) *(bf16x8*)(Vl + (cur ^ 1) * 64 * LDV + vrow) = rv[(u + 1) % 3];
                    int jj = j + 4; if (jj > jhi) jj = jhi;
                    rk[(u + 1) % 3] = *(const bf16x8*)(kbase + (size_t)jj * 4096); if (PV) rv[(u + 1) % 3] = *(const bf16x8*)(vbase + (size_t)jj * 4096);
                }
                SYNC();
            }
        }
    }
}

DEV void attn_task(const Args& a, unsigned char* smem, int li, int item) {
    unsigned char* ws = wsp(a); const int tid = TID, w = tid >> 6, l = tid & 63, h = l >> 4, c = l & 15, tl = c >> 2, hd = c & 3;
    const int bg = item & 3, b = bg >> 1, g = bg & 1, tq = (SEQ / 64 - 1) - (item >> 2), s0 = tq * 64, qblk = tq;
    int s[2], row[2];
#pragma unroll
    for (int G = 0; G < 2; ++G) { s[G] = s0 + 8 * w + 4 * G + tl; row[G] = b * SEQ + s[G]; }
    bf16* Kl = (bf16*)(smem + AT_K); bf16* Vl = (bf16*)(smem + AT_V); float* imps = (float*)(smem + AT_IMP) + w * 1024; unsigned* selm = (unsigned*)(smem + AT_SEL) + w * 32;
    bf16x8 qf[2][2]; float gatec[2], gates[2], gatew[2];
#pragma unroll
    for (int G = 0; G < 2; ++G) { const bf16* qp = (const bf16*)(ws + WS_QN) + (size_t)row[G] * 512 + (g * 4 + hd) * 64 + 8 * h; qf[G][0] = *(const bf16x8*)qp; qf[G][1] = *(const bf16x8*)(qp + 32);
        const float* gp = (const float*)(ws + WS_GATE) + (size_t)row[G] * 24 + (g * 4 + hd) * 3; gatec[G] = gp[0]; gates[G] = gp[1]; gatew[G] = gp[2]; }
    const float* cs = (const float*)(ws + WS_CS) + li * 4;
    const int srow = tid >> 3, scol = (tid & 7) * 8;
    for (int i = l; i < 1024; i += 64) imps[i] = 0.f;
    SYNC();
    unsigned* gselm = (unsigned*)(smem + AT_GSEL) + w * 8; float* outl = (float*)(smem + AT_OUT) + w * 2048 + l;
    ImpState im{{{0.f, 0.f, 0.f, 0.f}, {0.f, 0.f, 0.f, 0.f}}, {0.f, 0.f}, imps, tl, hd, l, s0, qblk};
    {
        const int ncv = s0 / 16 + 3, ncb0 = (ncv + 63) >> 6, ncb = ncb0 > NCP / 64 ? NCP / 64 : ncb0;
        const bf16* kcb = (const bf16*)(ws + WS_KC) + (size_t)bg * NCP * 64 + tid * 8;
        const bf16* vcb = (const bf16*)(ws + WS_VCT) + (size_t)bg * NCP * 64 + tid * 8;
        f32x4 O[2][4], Ol[2] = {f4zero(), f4zero()};
#pragma unroll
        for (int G = 0; G < 2; ++G)
#pragma unroll
            for (int et = 0; et < 4; ++et) O[G][et] = f4zero();
        attn_branch<0>(Kl, Vl, kcb, vcb, 0, ncb - 1, qf, s, selm, gselm, cs[0], w, h, c, srow, scol, O, Ol, im);
#pragma unroll
        for (int G = 0; G < 2; ++G) { const float lsum = Ol[G][0]; const float invl = lsum > 0.f ? 1.0f / lsum : 0.f;
#pragma unroll
            for (int r = 0; r < 4; ++r) im.invq[G][r] = shfl(invl, 4 * h + r);
#pragma unroll
            for (int et = 0; et < 4; ++et)
#pragma unroll
                for (int r = 0; r < 4; ++r) outl[((G * 4 + et) * 4 + r) * 64] = gatec[G] * invl * O[G][et][r]; }
        f32x4 ld[2] = {f4zero(), f4zero()};
        attn_branch<1>(Kl, Vl, kcb, vcb, 0, ncb - 1, qf, s, selm, gselm, cs[0], w, h, c, srow, scol, O, ld, im);
    }
    WSYNC();
#pragma unroll 1
    for (int G = 0; G < 2; ++G) {
        const int tk = l >> 4, i = l & 15; float vals[8];
#pragma unroll
        for (int mm = 0; mm < 8; ++mm) { const int jj = i + 16 * mm; vals[mm] = jj > qblk ? NEGV : ((jj == 0 || jj == qblk || jj == qblk - 1) ? FORCEV : imps[(G * 4 + tk) * 128 + jj]); }
        unsigned mk[4] = {0u, 0u, 0u, 0u};
#pragma unroll 1
        for (int rnd = 0; rnd < 16; ++rnd) {
            float best = vals[0]; int bj = i;
#pragma unroll
            for (int mm = 1; mm < 8; ++mm) if (vals[mm] > best) { best = vals[mm]; bj = i + 16 * mm; }
#pragma unroll
            for (int o = 1; o < 16; o <<= 1) { const float ov = shflx(best, o); const int oj = shflxi(bj, o); if (ov > best || (ov == best && oj < bj)) { best = ov; bj = oj; } }
            if (best > NEGV * 0.5f) {
#pragma unroll
                for (int q = 0; q < 4; ++q) if ((bj >> 5) == q) mk[q] |= 1u << (bj & 31); }
            if ((bj & 15) == i) {
#pragma unroll
                for (int mm = 0; mm < 8; ++mm) if ((bj >> 4) == mm) vals[mm] = -3e38f; }
        }
        if (i == 0) {
#pragma unroll
            for (int q = 0; q < 4; ++q) selm[(G * 4 + tk) * 4 + q] = mk[q]; }
    }
    WSYNC();
    if (l < 8) { const int G = l >> 2, q = l & 3; gselm[l] = selm[(G * 4 + 0) * 4 + q] | selm[(G * 4 + 1) * 4 + q] | selm[(G * 4 + 2) * 4 + q] | selm[(G * 4 + 3) * 4 + q]; }
    WSYNC();
#pragma unroll
    for (int br = 0; br < 2; ++br) {
        const bf16* kb = (const bf16*)(ws + (br == 0 ? WS_KS : WS_KW)) + (size_t)bg * SEQ * 64 + tid * 8; const bf16* vb = (const bf16*)(ws + (br == 0 ? WS_VST : WS_VWT)) + (size_t)bg * SEQ * 64 + tid * 8;
        f32x4 O[2][4], Ol[2] = {f4zero(), f4zero()};
#pragma unroll
        for (int G = 0; G < 2; ++G)
#pragma unroll
            for (int et = 0; et < 4; ++et) O[G][et] = f4zero();
        if (br == 0) attn_branch<2>(Kl, Vl, kb, vb, 0, qblk, qf, s, selm, gselm, cs[1], w, h, c, srow, scol, O, Ol, im);
        else attn_branch<3>(Kl, Vl, kb, vb, s0 >= 511 ? (s0 - 511) >> 6 : 0, qblk, qf, s, selm, gselm, cs[2], w, h, c, srow, scol, O, Ol, im);
#pragma unroll
        for (int G = 0; G < 2; ++G) { const float lsum = Ol[G][0]; const float sc = (br == 0 ? gates[G] : gatew[G]) * (lsum > 0.f ? 1.0f / lsum : 0.f);
#pragma unroll
            for (int et = 0; et < 4; ++et)
#pragma unroll
                for (int r = 0; r < 4; ++r) outl[((G * 4 + et) * 4 + r) * 64] += sc * O[G][et][r]; }
    }
#pragma unroll
    for (int G = 0; G < 2; ++G) { bf16* dst = (bf16*)(ws + WS_CAT) + (size_t)row[G] * 1024 + (g * 4 + hd) * 64 + 4 * h;
#pragma unroll
        for (int et = 0; et < 4; ++et) { f32x4 o;
#pragma unroll
            for (int r = 0; r < 4; ++r) o[r] = outl[((G * 4 + et) * 4 + r) * 64];
            st_bf4(dst + 16 * et, o); } }
}

constexpr int LDH = 136;
DEV void hg_cumsum(const float* fsrc  , float* segs  , int d, int seg, float (&f)[16], float (&bc)[16], float& bend, float& bmid) {
    float run = 0.f;
#pragma unroll
    for (int i = 0; i < 16; ++i) { f[i] = fsrc[(size_t)(16 * seg + i) * 128 + d]; run += log2f(f[i]); bc[i] = run; }
    SYNC();
    segs[seg * 128 + d] = run;
    SYNC();
    const float s0 = segs[d], s1 = segs[128 + d], s2 = segs[256 + d], s3 = segs[384 + d];
    const float off = seg == 0 ? 0.f : (seg == 1 ? s0 : (seg == 2 ? s0 + s1 : s0 + s1 + s2));
#pragma unroll
    for (int i = 0; i < 16; ++i) bc[i] += off;
    bend = s0 + s1 + s2 + s3; bmid = s0 + s1;
}
DEV void hg_write16(bf16* dstrow  , const float (&v)[16]) {
    u32x4 w0, w1;
#pragma unroll
    for (int q = 0; q < 4; ++q) { w0[q] = pk2(v[2 * q], v[2 * q + 1]); w1[q] = pk2(v[8 + 2 * q], v[8 + 2 * q + 1]); }
    *(u32x4*)dstrow = w0; *(u32x4*)(dstrow + 8) = w1;
}
DEV void hg_h1_task(const Args& a, unsigned char* smem, int task) {
    unsigned char* ws = wsp(a); const int tid = TID, w = tid >> 6, l = tid & 63, h = l >> 4, c = l & 15, d = tid & 127, seg = tid >> 7;
    const int bh = task / NCH, ch = task % NCH;
    bf16* kT = (bf16*)smem; bf16* vT = kT + 128 * LDT; float* segs = (float*)(vT + 128 * LDT);
    const size_t tokb = (size_t)bh * SEQ + ch * 64;
    float f[16], bc[16], bend, bmid;
    hg_cumsum((const float*)(ws + WS_HF) + tokb * 128, segs, d, seg, f, bc, bend, bmid);
    float kv[16];
#pragma unroll
    for (int i = 0; i < 16; ++i) kv[i] = (1.0f - f[i]) * fexp2(bend - bc[i]);
    hg_write16(kT + d * LDT + 16 * seg, kv);
    const bf16* vs = (const bf16*)(ws + WS_HV) + tokb * 128;
#pragma unroll
    for (int i = 0; i < 16; ++i) kv[i] = bf2f(vs[(size_t)(16 * seg + i) * 128 + d]);
    hg_write16(vT + d * LDT + 16 * seg, kv);
    if (seg == 0) ((float*)(ws + WS_GD))[((size_t)bh * NCH + ch) * 128 + d] = fexp2(bend);
    SYNC();
    f32x4 acc[8];
#pragma unroll
    for (int et = 0; et < 8; ++et) acc[et] = f4zero();
#pragma unroll
    for (int ks = 0; ks < 2; ++ks) { const bf16x8 fa = *(const bf16x8*)(kT + (16 * w + c) * LDT + 32 * ks + 8 * h);
#pragma unroll
        for (int et = 0; et < 8; ++et) acc[et] = mfma16(fa, *(const bf16x8*)(vT + (16 * et + c) * LDT + 32 * ks + 8 * h), acc[et]); }
    float* ut = (float*)(ws + WS_UT) + ((size_t)bh * NCH + ch) * 16384;
#pragma unroll
    for (int et = 0; et < 8; ++et) *(f32x4*)(ut + (size_t)(16 * et + c) * 128 + 16 * w + 4 * h) = acc[et];
    SYNC();
}
DEV void hg_scan_task(const Args& a, int sc) {
    unsigned char* ws = wsp(a); const int bh = sc >> 3, q = (sc & 7) * 512 + TID, e = q >> 5, d0 = (q & 31) * 4;
    const float* ut = (const float*)(ws + WS_UT) + (size_t)bh * NCH * 16384 + (size_t)e * 128 + d0;
    const float* gd = (const float*)(ws + WS_GD) + (size_t)bh * NCH * 128 + d0;
    bf16* st = (bf16*)(ws + WS_ST) + (size_t)bh * NCH * 16384 + (size_t)e * 128 + d0;
    f32x4 S = f4zero();
#pragma unroll 4
    for (int ch = 0; ch < NCH; ++ch) { st_bf4(st + (size_t)ch * 16384, S);
        const f32x4 g = *(const f32x4*)(gd + (size_t)ch * 128), u = *(const f32x4*)(ut + (size_t)ch * 16384);
#pragma unroll
        for (int r = 0; r < 4; ++r) S[r] = g[r] * S[r] + u[r]; }
}
DEV void hg_h3_task(const Args& a, unsigned char* smem, int li, int task) {
    unsigned char* ws = wsp(a); const int tid = TID, w = tid >> 6, l = tid & 63, h = l >> 4, c = l & 15, d = tid & 127, seg = tid >> 7;
    const int bh = task / NCH, ch = task % NCH, b = bh >> 2, hh = bh & 3;
    bf16* At = (bf16*)smem; bf16* Bt = At + 64 * LDH; bf16* Qt = Bt + 64 * LDH; bf16* vT = Qt + 64 * LDH; float* segs = (float*)(vT + 128 * LDT); float* part = segs + 512;
    const size_t tokb = (size_t)bh * SEQ + ch * 64;
    float f[16], bc[16], bend, bmid;
    hg_cumsum((const float*)(ws + WS_HF) + tokb * 128, segs, d, seg, f, bc, bend, bmid);
    const bf16* qs = (const bf16*)(ws + WS_HQ) + tokb * 128; const bf16* vs = (const bf16*)(ws + WS_HV) + tokb * 128;
    float vv[16];
#pragma unroll
    for (int i = 0; i < 16; ++i) { const int t = 16 * seg + i; const float q = bf2f(qs[(size_t)t * 128 + d]);
        At[t * LDH + d] = (bf16)f2bf(q * fexp2(bc[i] - bmid)); Bt[t * LDH + d] = (bf16)f2bf((1.0f - f[i]) * fexp2(bmid - bc[i])); Qt[t * LDH + d] = (bf16)f2bf(q * fexp2(bc[i]));
        vv[i] = bf2f(vs[(size_t)t * 128 + d]); }
    hg_write16(vT + d * LDT + 16 * seg, vv);
    SYNC();
    const int tt = w & 3, eh = w >> 2;
    f32x4 O[4];
#pragma unroll
    for (int et = 0; et < 4; ++et) O[et] = f4zero();
#pragma unroll
    for (int sp = 0; sp < 2; ++sp) {
        if (32 * sp > 16 * tt + 15) continue;
        f32x4 st[2];
#pragma unroll
        for (int u = 0; u < 2; ++u) { st[u] = f4zero(); const int krow = 32 * sp + 8 * (c >> 2) + 4 * u + (c & 3);
#pragma unroll
            for (int ks = 0; ks < 4; ++ks) st[u] = mfma16(*(const bf16x8*)(Bt + krow * LDH + 32 * ks + 8 * h), *(const bf16x8*)(At + (16 * tt + c) * LDH + 32 * ks + 8 * h), st[u]);
#pragma unroll
            for (int r = 0; r < 4; ++r) { const int sk = 32 * sp + 8 * h + 4 * u + r; if (sk > 16 * tt + c) st[u][r] = 0.f; } }
        const bf16x8 pb = pack8(st[0], st[1]);
#pragma unroll
        for (int et = 0; et < 4; ++et) O[et] = mfma16(*(const bf16x8*)(vT + (64 * eh + 16 * et + c) * LDT + 32 * sp + 8 * h), pb, O[et]);
    }
    const bf16* stp = (const bf16*)(ws + WS_ST) + ((size_t)bh * NCH + ch) * 16384;
#pragma unroll
    for (int ks = 0; ks < 4; ++ks) { const bf16x8 fq = *(const bf16x8*)(Qt + (16 * tt + c) * LDH + 32 * ks + 8 * h);
#pragma unroll
        for (int et = 0; et < 4; ++et) O[et] = mfma16(*(const bf16x8*)(stp + (size_t)(64 * eh + 16 * et + c) * 128 + 32 * ks + 8 * h), fq, O[et]); }
    float ss = 0.f;
#pragma unroll
    for (int et = 0; et < 4; ++et)
#pragma unroll
        for (int r = 0; r < 4; ++r) ss += O[et][r] * O[et][r];
    ss += shflx(ss, 16); ss += shflx(ss, 32);
    if (h == 0) part[eh * 64 + 16 * tt + c] = ss;
    SYNC();
    const float rs = frsq((part[16 * tt + c] + part[64 + 16 * tt + c]) * (1.0f / 128.0f) + EPS);
    const int tok = b * SEQ + ch * 64 + 16 * tt + c;
    const float* og = INP(a, I_OG) + li * 128; const bf16* hg = (const bf16*)(ws + WS_HGS) + (size_t)tok * 512 + hh * 128;
    bf16* dst = (bf16*)(ws + WS_CAT) + (size_t)tok * 1024 + 512 + hh * 128;
#pragma unroll
    for (int et = 0; et < 4; ++et) { const int e = 64 * eh + 16 * et + 4 * h; f32x4 o;
#pragma unroll
        for (int r = 0; r < 4; ++r) o[r] = O[et][r] * rs * og[e + r] * bf2f(hg[e + r]);
        st_bf4(dst + e, o); }
    SYNC();
}

DEV void conv_task(const Args& a, unsigned char* smem, int li, int task) {
    unsigned char* ws = wsp(a); const int tid = TID, w = tid >> 6, lane = tid & 63;
    const bool act = tid < DM / 2; const int c0 = act ? 2 * tid : 0;
    const int t0 = task * 16, b = t0 / SEQ, s0 = t0 % SEQ;
    float* red = (float*)smem;
    const float* dw = INP(a, I_DW) + (size_t)li * 31 * DM + c0;
    float acc[16][2];
    const float b0 = INP(a, I_DWB)[li * DM + c0], b1 = INP(a, I_DWB)[li * DM + c0 + 1];
#pragma unroll
    for (int t = 0; t < 16; ++t) { acc[t][0] = b0; acc[t][1] = b1; }
    const bf16* glu = (const bf16*)(ws + WS_GLU) + (size_t)b * SEQ * DM + c0;
    unsigned uu[46];
    { const bf16* gp = glu + (size_t)(s0 - 30) * DM;
#pragma unroll
    for (int r = 0; r < 46; ++r) { const int si = s0 + r - 30; uu[r] = si >= 0 ? *(const unsigned*)gp : 0u; gp += DM; OPAQUE(gp); } }
    const float* dwp = dw;
#pragma unroll
    for (int j = 0; j < 31; ++j) { const float w0 = dwp[0], w1 = dwp[1]; dwp += DM; OPAQUE(dwp);
#pragma unroll
        for (int t = 0; t < 16; ++t) { const unsigned q = uu[t + j]; acc[t][0] += w0 * bf2f(q & 0xffff); acc[t][1] += w1 * bf2f(q >> 16); } }
    float mean[16], rstd[16];
    SYNC();
#pragma unroll
    for (int t = 0; t < 16; ++t) { float s = act ? acc[t][0] + acc[t][1] : 0.f;
#pragma unroll
        for (int o = 1; o < 64; o <<= 1) s += shflx(s, o);
        if (lane == 0) red[w * 16 + t] = s; }
    SYNC();
#pragma unroll
    for (int t = 0; t < 16; ++t) { float s = 0.f;
#pragma unroll
        for (int q = 0; q < 8; ++q) s += red[q * 16 + t];
        mean[t] = s * (1.0f / DM); }
    SYNC();
#pragma unroll
    for (int t = 0; t < 16; ++t) { const float d0 = acc[t][0] - mean[t], d1 = acc[t][1] - mean[t]; float s = act ? d0 * d0 + d1 * d1 : 0.f;
#pragma unroll
        for (int o = 1; o < 64; o <<= 1) s += shflx(s, o);
        if (lane == 0) red[w * 16 + t] = s; }
    SYNC();
#pragma unroll
    for (int t = 0; t < 16; ++t) { float s = 0.f;
#pragma unroll
        for (int q = 0; q < 8; ++q) s += red[q * 16 + t];
        rstd[t] = frsq(s * (1.0f / DM) + EPS); }
    if (act) {
        const float g0 = INP(a, I_LNG)[li * DM + c0], g1 = INP(a, I_LNG)[li * DM + c0 + 1], e0 = INP(a, I_LNB)[li * DM + c0], e1 = INP(a, I_LNB)[li * DM + c0 + 1];
        bf16* dst = (bf16*)(ws + WS_CAT) + (size_t)t0 * DM + c0;
#pragma unroll
        for (int t = 0; t < 16; ++t) { const float y0 = (acc[t][0] - mean[t]) * rstd[t] * g0 + e0, y1 = (acc[t][1] - mean[t]) * rstd[t] * g1 + e1;
            *(unsigned*)(dst + (size_t)t * DM) = pk2(siluf(y0), siluf(y1)); }
    }
}

constexpr int N_PHASES = 1 + 16 * (DEPTH / 2) + 1;
DEV void phase_decode(int ph, int& l, int& sub) {
    const int q = ph - 1, pair = q >> 4, r = q & 15;
    if (r < 9) { l = 2 * pair; sub = r; } else { l = 2 * pair + 1; const int rr = r - 9; sub = rr < 3 ? rr : rr + 2; }
}
constexpr int LDS_BYTES = 150 * 1024;

DEV void run_phase(const Args& a, unsigned char* smem, int ph) {
#ifndef ONLY
#define ONLY -1
#endif
#define EN(k) (ONLY < 0 || ONLY == (k))
    if (ph == 0) { if (EN(100)) p0_phase(a, smem); return; }
    if (ph == N_PHASES - 1) { if (EN(0)) norm_phase(a, smem, DEPTH); return; }
    int l, sub; phase_decode(ph, l, sub); const int li = l >> 1; const bool even = (l & 1) == 0;
    unsigned char* ws = wsp(a);
    switch (sub) {
    case 0: if (EN(0)) norm_phase(a, smem, l); break;
    case 1: if (even) { if (EN(1)) inproj_phase(a, smem, li); } else { if (EN(11)) pw1_phase(a, smem, li); } break;
    case 2:
        if (even) { constexpr int NCI = 8 * ((NCP + 255) / 256); constexpr int NH1 = 8 * NCH;
            for (int it = BID; it < NCI + NH1; it += NBLK) { if (it < NCI) { if (EN(2)) cmp_phase_items(a, smem, li, it); } else { if (EN(12)) hg_h1_task(a, smem, it - NCI); } } }
        else { for (int it = BID; it < T / 16; it += NBLK) if (EN(13)) conv_task(a, smem, li, it); }
        break;
    case 3:
        if (even) { constexpr int NA = 4 * (SEQ / 64); const int G = NBLK;
            for (int r = 0; r * G < NA; ++r) { const int it = r * G + ((r & 1) ? (G - 1 - BID) : BID); if (it < NA) { if (EN(3)) attn_task(a, smem, li, it); } }
            for (int it = BID; it < 64; it += NBLK) if (EN(14)) hg_scan_task(a, it); }
        break;
    case 4: if (even) { for (int it = BID; it < 8 * NCH; it += NBLK) if (EN(4)) hg_h3_task(a, smem, li, it); } break;
    case 5:
        if (!EN(5)) break;
        if (even) resid_gemm_phase(a, smem, (const bf16*)(ws + WS_CAT), 1024, (const bf16*)(ws + WS_WOUT) + (size_t)li * DM * 1024, l);
        else resid_gemm_phase(a, smem, (const bf16*)(ws + WS_CAT), DM, (const bf16*)(ws + WS_PW2) + (size_t)li * DM * DM, l);
        break;
    case 6: if (EN(6)) route_phase(a, smem, l); break;
    case 7: if (EN(7)) moe_gemm_phase(a, smem, l, 0); break;
    case 8: if (EN(8)) moe_gemm_phase(a, smem, l, 1); break;
    }
}

#ifndef EMU
#define LAS __attribute__((address_space(3)))
#define XB_TMO      128
#define XB_XCNT(j)  (256  + 64 * (j))
#define XB_XSUB(j)  (1280 + 64 * (j))
#define XB_XGEN(j)  (2304 + 64 * (j))
#define XB_TOP      3328
#define XB_TOPGEN   3392
#define XCD_BAR_WORDS 3456
#define XB_SPIN_CAP (1u << 22)
__device__ __forceinline__ unsigned xb_ld(unsigned* p)              { return __hip_atomic_load(p, __ATOMIC_RELAXED, __HIP_MEMORY_SCOPE_AGENT); }
__device__ __forceinline__ unsigned xb_add(unsigned* p, unsigned v) { return __hip_atomic_fetch_add(p, v, __ATOMIC_RELAXED, __HIP_MEMORY_SCOPE_AGENT); }
__device__ __forceinline__ unsigned xb_xcc_id() { return (unsigned)__builtin_amdgcn_s_getreg((3 << 11) | 20) & 0xFu; }
#define XB_SPIN(cond, bar) do { unsigned _sp = 0; while (cond) { __builtin_amdgcn_s_sleep(1); \
    if ((++_sp & 255u) == 0u) { if (xb_ld(&(bar)[XB_TMO])) break; if (_sp > XB_SPIN_CAP) { atomicAdd(&(bar)[XB_TMO], 1u); break; } } } } while (0)
struct XcdBarrier { unsigned* bar; unsigned x; volatile LAS unsigned* st; };
__device__ __forceinline__ XcdBarrier xcd_barrier_post(unsigned* bar, volatile LAS unsigned* st) {
    XcdBarrier b; b.bar = bar; b.x = xb_xcc_id(); b.st = st;
    if (threadIdx.x == 0) (void)xb_add(&bar[XB_XCNT(b.x)], 1u);
    return b;
}
__device__ __forceinline__ void xcd_barrier_complete(unsigned* bar, unsigned x, unsigned& nloc, unsigned& nx) {
    const unsigned G = gridDim.x * gridDim.y * gridDim.z;
    unsigned sum, cnt, mine, sp = 0u;
    for (;;) {
        sum = 0u; cnt = 0u; mine = 0u;
#pragma unroll
        for (unsigned j = 0; j < 16; ++j) { const unsigned c = xb_ld(&bar[XB_XCNT(j)]); sum += c; cnt += (c > 0u) ? 1u : 0u; mine = (j == x) ? c : mine; }
        if (sum == G) break;
        __builtin_amdgcn_s_sleep(1);
        if ((++sp & 255u) == 0u) { if (xb_ld(&bar[XB_TMO])) break; if (sp > XB_SPIN_CAP) { atomicAdd(&bar[XB_TMO], 1u); break; } }
    }
    nloc = mine > 0u ? mine : 1u; nx = cnt > 0u ? cnt : 1u;
}
__device__ __forceinline__ void xcd_barrier(const XcdBarrier& b) {
    asm volatile("s_waitcnt vmcnt(0)" ::: "memory");
    __syncthreads();
    if (threadIdx.x == 0) {
        unsigned* bar = b.bar;
        __builtin_amdgcn_s_waitcnt(0);
        unsigned nloc = b.st[0], nx = b.st[1];
        if (nloc == 0u) { xcd_barrier_complete(bar, b.x, nloc, nx); b.st[0] = nloc; b.st[1] = nx; }
        const unsigned old = xb_add(&bar[XB_XSUB(b.x)], 1u);
        const unsigned gen = old / nloc;
        if (old + 1u == (gen + 1u) * nloc) {
            __builtin_amdgcn_fence(__ATOMIC_RELEASE, "agent");
            asm volatile("s_waitcnt vmcnt(0)" ::: "memory");
            const unsigned og = xb_add(&bar[XB_TOP], 1u);
            const unsigned tg = og / nx;
            if (og + 1u == (tg + 1u) * nx) xb_add(&bar[XB_TOPGEN], 1u);
            else XB_SPIN(xb_ld(&bar[XB_TOPGEN]) == tg, bar);
            __builtin_amdgcn_fence(__ATOMIC_ACQUIRE, "agent");
            xb_add(&bar[XB_XGEN(b.x)], 1u);
            asm volatile("s_waitcnt vmcnt(0)" ::: "memory");
        } else {
            XB_SPIN(xb_ld(&bar[XB_XGEN(b.x)]) == gen, bar);
            __builtin_amdgcn_fence(__ATOMIC_ACQUIRE, "agent");
            asm volatile("s_waitcnt vmcnt(0)" ::: "memory");
        }
    }
    __syncthreads();
}

__global__ void __launch_bounds__(NT, 2) mega(Args a) {
    extern __shared__ __attribute__((aligned(16))) unsigned char lds[];
    volatile LAS unsigned* st = (volatile LAS unsigned*)(LAS unsigned char*)(lds + LDS_BYTES - 16);
    if (threadIdx.x < 4) st[threadIdx.x] = 0u;
    __syncthreads();
    unsigned* barw = (unsigned*)(a.ws + WS_BAR);
    XcdBarrier bar = xcd_barrier_post(barw, st);
#pragma unroll 1
    for (int ph = 0; ph < N_PHASES; ++ph) {
        run_phase(a, lds, ph);
#ifdef DUP
        { int lyr = 0, sub = 100; if (ph > 0 && ph < N_PHASES - 1) phase_decode(ph, lyr, sub);
          if (sub == (DUP % 1000) && (ph == 0 || lyr == DUP / 1000) && ph < N_PHASES - 1) { xcd_barrier(bar); run_phase(a, lds, ph); } }
#endif
        if (ph + 1 < N_PHASES) xcd_barrier(bar);
    }
    if (xb_ld(&barw[XB_TMO]) != 0u) {
        const size_t gt = (size_t)blockIdx.x * NT + threadIdx.x, gs = (size_t)gridDim.x * NT;
        for (size_t i = gt; i < (size_t)T * DM; i += gs) a.out[i] = __builtin_nanf("");
    }
}

extern "C" void kernel_launch(void* const* d_in, const int* in_sizes, int n_in, void* d_out, int out_size,
                              void* d_ws, size_t ws_size, hipStream_t stream) {
    static int grid = 0;
    if (grid == 0) {
        int dev = 0, cus = 0;
        if (hipGetDevice(&dev) != hipSuccess || hipDeviceGetAttribute(&cus, hipDeviceAttributeMultiprocessorCount, dev) != hipSuccess) { grid = -1; return; }
        if (hipFuncSetAttribute((const void*)mega, hipFuncAttributeMaxDynamicSharedMemorySize, LDS_BYTES) != hipSuccess) { grid = -1; return; }
        (void)hipGetLastError();
        grid = cus;
        if (n_in != 26 || out_size != T * DM || ws_size < WS_END) { fprintf(stderr, "kernel_launch: unexpected sizes n_in %d out %d ws %zu (need %zu)\n", n_in, out_size, ws_size, (size_t)WS_END); grid = -1; return; }
    }
    if (grid < 0) return;
    (void)hipMemsetAsync((unsigned char*)d_ws + WS_BAR, 0, XCD_BAR_WORDS * 4, stream);
    Args a{};
    for (int i = 0; i < 26; ++i) a.in[i] = (const float*)d_in[i];
    a.out = (float*)d_out; a.ws = (unsigned char*)d_ws;
    hipLaunchKernelGGL(mega, dim3(grid), dim3(NT), LDS_BYTES, stream, a);
}
#endif
```

```cpp
#ifdef EMU
#include "emu.h"
#define DEV static inline
#define MDEV inline
#define OPAQUE(p)
#define OPAQUE2(a, b)
#define TID emu_tid()
#define BID (EB->bid)
#define NBLK (EB->nblk)
#define SYNC() emu_sync_block()
#define WSYNC() emu_sync_wave()
#define mfma16(a, b, c) emu_mfma16(a, b, c)
DEV float shflx(float v, int m) { return emu_shfl_f(v, (emu_tid() & 63) ^ m); }
DEV int shflxi(int v, int m) { return (int)emu_shfl_u((unsigned)v, (emu_tid() & 63) ^ m); }
DEV float shfl(float v, int s) { return emu_shfl_f(v, s); }
DEV float dpp_ror1(float v) { const int l = emu_tid() & 63; return emu_shfl_f(v, (l & 48) | ((l - 1) & 15)); }
DEV int atomic_add_i(int* p, int v) { return __atomic_fetch_add(p, v, __ATOMIC_RELAXED); }
DEV float fexp2(float x) { return exp2f(x); }
DEV float frcp(float x) { return 1.0f / x; }
DEV float frsq(float x) { return 1.0f / sqrtf(x); }
typedef short s16x4 __attribute__((vector_size(8)));
static inline s16x4 emu_tr4(const unsigned short* p) {
    EmuWave& w = EB->wave[emu_tid() >> 6]; int l = emu_tid() & 63;
    const unsigned short** tab = (const unsigned short**)w.a;
    tab[l] = p; emu_sync_wave();
    s16x4 r; int g = l & 48, i = l & 15;
    for (int q = 0; q < 4; ++q) r[q] = (short)tab[g + 4 * q + (i >> 2)][i & 3];
    emu_sync_wave(); return r;
}
#define tr4(p) emu_tr4(p)
#else
#include <hip/hip_runtime.h>
#include <cstdio>
#include <cstdint>
typedef short bf16x8 __attribute__((ext_vector_type(8)));
typedef float f32x4 __attribute__((ext_vector_type(4)));
typedef unsigned u32x4 __attribute__((ext_vector_type(4)));
typedef unsigned u32x2 __attribute__((ext_vector_type(2)));
#define DEV __device__ __forceinline__
#define MDEV __device__ __forceinline__
#define OPAQUE(p) asm volatile("" : "+v"(p))
#define OPAQUE2(a, b) asm volatile("" : "+v"(a), "+v"(b))
DEV int tid_opaque() { int t = (int)threadIdx.x; asm volatile("" : "+v"(t)); return t; }
#define TID tid_opaque()
DEV int bid_opaque() { int b = (int)blockIdx.x; asm volatile("" : "+s"(b)); return b; }
#define BID bid_opaque()
#define NBLK ((int)gridDim.x)
#define SYNC() __syncthreads()
#define WSYNC() __builtin_amdgcn_wave_barrier()
#define mfma16(a, b, c) __builtin_amdgcn_mfma_f32_16x16x32_bf16(a, b, c, 0, 0, 0)
DEV int shflxi(int x, int m) {
    if (m == 1) return __builtin_amdgcn_update_dpp(x, x, 0xB1, 0xf, 0xf, true);
    if (m == 2) return __builtin_amdgcn_update_dpp(x, x, 0x4E, 0xf, 0xf, true);
    if (m == 4) return __builtin_amdgcn_ds_swizzle(x, (4 << 10) | 0x1F);
    if (m == 8) return __builtin_amdgcn_ds_swizzle(x, (8 << 10) | 0x1F);
    if (m == 16) return __builtin_amdgcn_ds_swizzle(x, (16 << 10) | 0x1F);
    if (m == 32) { const auto r = __builtin_amdgcn_permlane32_swap((unsigned)x, (unsigned)x, false, false); return (int)((threadIdx.x & 32) ? r[0] : r[1]); }
    return __shfl_xor(x, m);
}
DEV float shflx(float v, int m) { return __builtin_bit_cast(float, shflxi(__builtin_bit_cast(int, v), m)); }
DEV float dpp_ror1(float v) { return __builtin_bit_cast(float, __builtin_amdgcn_update_dpp(0, __builtin_bit_cast(int, v), 0x121, 0xf, 0xf, false)); }
DEV float shfl(float v, int s) { return __shfl(v, s); }
DEV int atomic_add_i(int* p, int v) { return atomicAdd(p, v); }
DEV float fexp2(float x) { return __builtin_amdgcn_exp2f(x); }
DEV float frcp(float x) { return __builtin_amdgcn_rcpf(x); }
DEV float frsq(float x) { return __builtin_amdgcn_rsqf(x); }
typedef short s16x4 __attribute__((ext_vector_type(4)));
#define tr4(p) __builtin_amdgcn_ds_read_tr16_b64_v4i16((__attribute__((address_space(3))) s16x4*)(p))
#endif

typedef unsigned short bf16;

#ifndef DM
#define DM 1024
#endif
#ifndef SEQ
#define SEQ 8192
#endif
#ifndef FF
#define FF 512
#endif
constexpr int NBATCH = 2, T = NBATCH * SEQ, DEPTH = 4;
constexpr int NIN = 3352, NINP = 3456, NIN8 = 3584;
constexpr int NT = 512;
constexpr int NCH = SEQ / 64;
constexpr int NCP = SEQ / 16;
constexpr int NCMP = NCP - 1;
constexpr int MOE_ROWS = 2 * T + 32 * 256;
constexpr float EPS = 1e-6f, NEGV = -1e30f, FORCEV = 1e4f, LOG2E = 1.4426950408889634f;

constexpr size_t al(size_t x) { return (x + 255) & ~(size_t)255; }
constexpr size_t WS_BAR = 0;
constexpr size_t WS_CNT = 16384;
constexpr size_t WS_MOD = WS_CNT + (size_t)DEPTH * 32 * 256;
constexpr size_t WS_LB = al(WS_MOD + (size_t)DEPTH * 2 * 6 * DM * 4);
constexpr size_t WS_CB = al(WS_LB + 2 * 512 * 4);
constexpr size_t WS_CS = al(WS_CB + 2 * 2 * 8 * 64 * 4);
constexpr size_t WS_WIN = al(WS_CS + 64);
constexpr size_t WS_WOUT = al(WS_WIN + (size_t)2 * NIN8 * DM * 2);
constexpr size_t WS_PW1 = al(WS_WOUT + (size_t)2 * DM * 1024 * 2);
constexpr size_t WS_PW2 = al(WS_PW1 + (size_t)2 * 2 * DM * DM * 2);
constexpr size_t WS_WC = al(WS_PW2 + (size_t)2 * DM * DM * 2);
constexpr size_t WS_W13 = al(WS_WC + (size_t)2 * 2 * 64 * 2048 * 2);
constexpr size_t WS_W2 = al(WS_W13 + 256);
constexpr size_t WS_H = al(WS_W2 + 256);
constexpr size_t WS_QN = al(WS_H + (size_t)T * DM * 2);
constexpr size_t WS_KCG = al(WS_QN + (size_t)T * 512 * 2);
constexpr size_t WS_VCG = al(WS_KCG + (size_t)T * 128 * 2);
constexpr size_t WS_KS = al(WS_VCG + (size_t)T * 128 * 2);
constexpr size_t WS_KW = al(WS_KS + (size_t)T * 128 * 2);
constexpr size_t WS_VST = al(WS_KW + (size_t)T * 128 * 2);
constexpr size_t WS_VWT = al(WS_VST + (size_t)T * 128 * 2);
constexpr size_t WS_KC = al(WS_VWT + (size_t)T * 128 * 2);
constexpr size_t WS_VCT = al(WS_KC + (size_t)4 * NCP * 64 * 2);
constexpr size_t WS_GATE = al(WS_VCT + (size_t)4 * NCP * 64 * 2);
constexpr size_t WS_HQ = al(WS_GATE + (size_t)T * 24 * 4);
constexpr size_t WS_HF = al(WS_HQ + (size_t)T * 512 * 2);
constexpr size_t WS_HV = al(WS_HF + (size_t)T * 512 * 4);
constexpr size_t WS_HGS = al(WS_HV + (size_t)T * 512 * 2);
constexpr size_t WS_UT = al(WS_HGS + (size_t)T * 512 * 2);
constexpr size_t WS_ST = al(WS_UT + (size_t)8 * NCH * 128 * 128 * 4);
constexpr size_t WS_GD = al(WS_ST + (size_t)8 * NCH * 128 * 128 * 2);
constexpr size_t WS_CAT = al(WS_GD + (size_t)8 * NCH * 128 * 4);
constexpr size_t WS_GLU = al(WS_CAT + (size_t)T * 1024 * 2);
constexpr size_t WS_TIE = al(WS_GLU + (size_t)T * DM * 2);
constexpr size_t WS_TIW = al(WS_TIE + (size_t)T * 2 * 4);
constexpr size_t WS_LIST = al(WS_TIW + (size_t)T * 2 * 4);
constexpr size_t WS_ACT = al(WS_LIST + (size_t)32 * T * 4);
constexpr size_t WS_YK = al(WS_ACT + (size_t)MOE_ROWS * FF * 2);
constexpr size_t WS_WTH = al(WS_YK + (size_t)MOE_ROWS * DM * 2);
constexpr size_t WS_WTL = al(WS_WTH + (size_t)DEPTH * 48 * DM * 2);
constexpr size_t WS_AVEC = al(WS_WTL + (size_t)DEPTH * 48 * DM * 2);
constexpr size_t WS_RBIAS = al(WS_AVEC + (size_t)DEPTH * 2 * DM * 4);
constexpr size_t WS_END = al(WS_RBIAS + (size_t)DEPTH * 2 * 48 * 4);

struct Args { const float* in[26]; float* out; unsigned char* ws; };
enum { I_X = 0, I_C, I_ADAW, I_ADAB, I_NMIX, I_NFFN, I_WIN, I_WOUT, I_CWK, I_CWV, I_CPE, I_QG, I_KG, I_LBL, I_OG,
       I_PW1, I_DW, I_DWB, I_LNG, I_LNB, I_PW2, I_WG, I_WE, I_W1, I_W3, I_W2 };

#ifdef EMU
DEV unsigned char* wsp(const Args& a) { return a.ws; }
DEV float* outp(const Args& a) { return a.out; }
#else
DEV unsigned char* launder_ptr(const void* p) { unsigned long long v = (unsigned long long)p; unsigned lo = (unsigned)v, hi = (unsigned)(v >> 32);
    lo = (unsigned)__builtin_amdgcn_readfirstlane((int)lo); hi = (unsigned)__builtin_amdgcn_readfirstlane((int)hi); asm volatile("" : "+s"(lo), "+s"(hi)); typedef __attribute__((address_space(1))) unsigned char* gptr_t; return (unsigned char*)(gptr_t)(((unsigned long long)hi << 32) | lo); }
DEV unsigned char* wsp(const Args& a) { return launder_ptr(a.ws); }
DEV float* outp(const Args& a) { return (float*)launder_ptr(a.out); }
#endif

#ifdef EMU
#define INP(a, X) ((a).in[X])
#else
DEV int zero_opaque() { int z = 0; asm volatile("" : "+s"(z)); return z; }
#define INP(a, X) ((a).in[(X) + zero_opaque()])
#endif

DEV unsigned f2bf(float f) { unsigned u = __builtin_bit_cast(unsigned, f); return (u + 0x7fffu + ((u >> 16) & 1u)) >> 16; }
DEV float bf2f(unsigned h) { return __builtin_bit_cast(float, h << 16); }
#ifdef EMU
DEV unsigned pk2(float lo, float hi) { return f2bf(lo) | (f2bf(hi) << 16); }
#else
typedef float f32x2_t __attribute__((ext_vector_type(2)));
typedef __bf16 bf16x2_t __attribute__((ext_vector_type(2)));
DEV unsigned pk2(float lo, float hi) { f32x2_t v = {lo, hi}; bf16x2_t b = __builtin_convertvector(v, bf16x2_t); return __builtin_bit_cast(unsigned, b); }
#endif
DEV float sigm(float x) { return frcp(1.0f + fexp2(-x * LOG2E)); }
DEV float siluf(float x) { return x * sigm(x); }
DEV f32x4 f4zero() { f32x4 z = {0.f, 0.f, 0.f, 0.f}; return z; }
DEV bf16x8 pack8(f32x4 a, f32x4 b) {
    u32x4 w; w[0] = pk2(a[0], a[1]); w[1] = pk2(a[2], a[3]); w[2] = pk2(b[0], b[1]); w[3] = pk2(b[2], b[3]);
    return __builtin_bit_cast(bf16x8, w);
}
DEV void st_bf8(bf16* p, f32x4 a, f32x4 b) { u32x4 w; w[0] = pk2(a[0], a[1]); w[1] = pk2(a[2], a[3]); w[2] = pk2(b[0], b[1]); w[3] = pk2(b[2], b[3]); *(u32x4*)p = w; }
DEV void st_bf4(bf16* p, f32x4 v) { u32x2 w; w[0] = pk2(v[0], v[1]); w[1] = pk2(v[2], v[3]); *(u32x2*)p = w; }


#ifdef EMU
namespace pg8 {
constexpr int BM = 256, BK = 64, HALF = 128, NXCD = 8, WGM = 8;
typedef unsigned short bf16_t;
struct Unit { int pm, pn; };
struct Gemm { const bf16_t* A; const bf16_t* Bt; int M, N, K; };
struct StaticOrder {
    int nM, nN, nwg, G, c;
    void init(int M, int N, int G_, int c_) { nM = M / BM; nN = N / BM; nwg = nM * nN; G = G_; c = c_; }
    bool next(int i, Unit& u) const {
        const long L = (long)i * G + c; if (L >= nwg) return false;
        int wgid = (int)L; { const int q = nwg / NXCD, r = nwg % NXCD, xcd = wgid % NXCD, off = wgid / NXCD; wgid = (xcd < r ? xcd * (q + 1) : r * (q + 1) + (xcd - r) * q) + off; }
        const int nig = WGM * nN, gid = wgid / nig, fm = gid * WGM, gsz = (nM - fm) < WGM ? (nM - fm) : WGM;
        u.pm = fm + ((wgid % nig) % gsz); u.pn = (wgid % nig) / gsz; return true;
    }
};
template <class Epi, class Sched, bool ALIGN_EPI = false, bool SP2 = false>
static inline void gemm_phase(unsigned char*, const Gemm g, const Sched& S, const Epi& E) {
    const int tid = emu_tid(), wid = tid >> 6, lane = tid & 63, wr = wid >> 2, wc = wid & 3, fr = lane & 15, fq = lane >> 4;
    Unit u;
    for (int ui = 0; S.next(ui, u); ++ui) {
        f32x4 acc[2][2][4][2];
        for (int ai = 0; ai < 2; ++ai) for (int bj = 0; bj < 2; ++bj) for (int m = 0; m < 4; ++m) for (int n = 0; n < 2; ++n) for (int r = 0; r < 4; ++r) {
            const int row = 256 * u.pm + 128 * ai + 64 * wr + 16 * m + fr, col = 256 * u.pn + 128 * bj + 32 * wc + (Epi::PERM ? 8 * fq + 4 * n + r : 16 * n + 4 * fq + r); float sum = 0.f;
            const bf16_t* ap = g.A + (size_t)row * g.K; const bf16_t* bp = g.Bt + (size_t)col * g.K;
            for (int k = 0; k < g.K; ++k) sum += bf2f(ap[k]) * bf2f(bp[k]);
            acc[ai][bj][m][n][r] = sum; }
        E(acc, u, wr, wc, fr, fq);
    }
    emu_sync_block();
}
}
#else
namespace pg8 {
#define PG8_LAS __attribute__((address_space(3)))
typedef unsigned short bf16_t;
typedef short bf16x8 __attribute__((ext_vector_type(8)));
typedef float f32x4 __attribute__((ext_vector_type(4)));
typedef unsigned u32x4 __attribute__((ext_vector_type(4)));
constexpr int BM = 256, BK = 64, HALF = 128, HTB = HALF * BK * 2  , STAGE_BYTES = 8 * HTB, NXCD = 8, WGM = 8;

__host__ __device__ __forceinline__ int lds_byte(int r, int c) { const int st = (r >> 4) * 2 + (c >> 5), rr = r & 15, cc = c & 31, ob = rr * 64 + cc * 2; return st * 1024 + (ob ^ (((ob >> 9) & 1) << 5)); }
__host__ __device__ __forceinline__ void stage_rc(int b, int& R, int& C) { const int st = b / 1024, sb = b % 1024, swz = sb ^ (((sb >> 9) & 1) << 5); R = (st >> 1) * 16 + swz / 64; C = (st & 1) * 32 + (swz % 64) / 2; }
__host__ __device__ __forceinline__ int perm32(int rho) { const int n = rho >> 4, i = rho & 15; return 8 * (i >> 2) + 4 * n + (i & 3); }

struct Unit { int pm, pn; };
struct Gemm { const bf16_t* A; const bf16_t* Bt; int M, N, K; };

struct StaticOrder {
    int nM, nN, nwg, G, c;
    __host__ __device__ void init(int M, int N, int G_, int c_) { nM = M / BM; nN = N / BM; nwg = nM * nN; G = G_; c = c_; }
    __host__ __device__ bool next(int i, Unit& u) const {
        const long L = (long)i * G + c; if (L >= nwg) return false;
        int wgid = (int)L; { const int q = nwg / NXCD, r = nwg % NXCD, xcd = wgid % NXCD, off = wgid / NXCD; wgid = (xcd < r ? xcd * (q + 1) : r * (q + 1) + (xcd - r) * q) + off; }
        const int nig = WGM * nN, gid = wgid / nig, fm = gid * WGM, gsz = (nM - fm) < WGM ? (nM - fm) : WGM;
        u.pm = fm + ((wgid % nig) % gsz); u.pn = (wgid % nig) / gsz; return true;
    }
    __device__ __forceinline__ void a_ready(const Unit&) const {}
    __device__ __forceinline__ void done(const Unit&) const {}
};

__device__ __forceinline__ unsigned cvt_pk_bf16(float lo, float hi) { unsigned r; asm volatile("v_cvt_pk_bf16_f32 %0, %1, %2" : "=v"(r) : "v"(lo), "v"(hi)); return r; }
template <class Epi, class Sched, bool ALIGN_EPI = false, bool SP2 = false>
__device__ __forceinline__ void gemm_phase(PG8_LAS unsigned char* lds, const Gemm g, const Sched& S, const Epi& E) {
    const int tid = TID, wid = __builtin_amdgcn_readfirstlane(tid >> 6), lane = tid & 63, wr = wid >> 2, wc = wid & 3, fr = lane & 15, fq = lane >> 4;
    const int K = g.K, nt = K / BK;
    unsigned voffA[2], voffB[2];
#pragma unroll
    for (int i = 0; i < 2; ++i) { int R, C; stage_rc(tid * 16 + i * 8192, R, C); const int Rb = Epi::PERM ? ((R & ~31) + perm32(R & 31)) : R;
        voffA[i] = (unsigned)(R * K + C) * 2u; voffB[i] = (unsigned)(Rb * K + C) * 2u; }
    const size_t kstep = (size_t)(BK * 2);
    const size_t hstep = (size_t)HALF * K * 2;
    const size_t tstep = 2 * hstep;
    const unsigned ldsw = (unsigned)wid * 1024u;
    const int aoff = lds_byte(wr * 64 + fr, fq * 8), boff = lds_byte(wc * 32 + fr, fq * 8);
#define PG8_SA(b, h) (((b) * 2 + (h)) * HTB)
#define PG8_SB(b, h) ((4 + (b) * 2 + (h)) * HTB)
#define PG8_STAGE(bufoff, gbase, voff) do { _Pragma("unroll") for (int _i = 0; _i < 2; ++_i) \
        __builtin_amdgcn_global_load_lds((const unsigned*)((const char*)(gbase) + (voff)[_i]), (PG8_LAS unsigned*)(lds + (bufoff) + ldsw + _i * 8192), 16, 0, 0); } while (0)
#define PG8_LDA(dst, b, h) do { _Pragma("unroll") for (int m = 0; m < 4; ++m) _Pragma("unroll") for (int k = 0; k < 2; ++k) dst[m][k] = *(const PG8_LAS bf16x8*)(lds + PG8_SA(b, h) + aoff + m * 2048 + k * 1024); } while (0)
#define PG8_LDB(dst, b, h) do { _Pragma("unroll") for (int n = 0; n < 2; ++n) _Pragma("unroll") for (int k = 0; k < 2; ++k) dst[n][k] = *(const PG8_LAS bf16x8*)(lds + PG8_SB(b, h) + boff + n * 2048 + k * 1024); } while (0)
#define PG8_MMA(ai, bj, At, Bt) do { __builtin_amdgcn_s_setprio(1); _Pragma("unroll") for (int m = 0; m < 4; ++m) _Pragma("unroll") for (int n = 0; n < 2; ++n) _Pragma("unroll") for (int k = 0; k < 2; ++k) \
        acc[ai][bj][m][n] = __builtin_amdgcn_mfma_f32_16x16x32_bf16(Bt[n][k], At[m][k], acc[ai][bj][m][n], 0, 0, 0); __builtin_amdgcn_s_setprio(0); } while (0)
#define PG8_WAIT_V(n) asm volatile("s_waitcnt vmcnt(" #n ")" ::: "memory")
#define PG8_WAIT_L(n) asm volatile("s_waitcnt lgkmcnt(" #n ")" ::: "memory")
#define PG8_BAR __builtin_amdgcn_s_barrier()
#define PG8_SCHED __builtin_amdgcn_sched_barrier(0)
    Unit cur, nxt; int ui = 0;
    if (!S.next(0, cur)) return;
    f32x4 acc[2][2][4][2];
#pragma unroll
    for (int a = 0; a < 2; ++a)
#pragma unroll
        for (int b = 0; b < 2; ++b)
#pragma unroll
            for (int m = 0; m < 4; ++m)
#pragma unroll
                for (int n = 0; n < 2; ++n) acc[a][b][m][n] = (f32x4){0.f, 0.f, 0.f, 0.f};
    bf16x8 At[4][2], B0[2][2], B1[2][2];
    const char* cA = (const char*)g.A + (size_t)cur.pm * tstep; const char* cB = (const char*)g.Bt + (size_t)cur.pn * tstep;
    S.a_ready(cur);
    if constexpr (SP2) {
        PG8_STAGE(PG8_SB(0, 0), cB, voffB); PG8_STAGE(PG8_SB(0, 1), cB + hstep, voffB); PG8_STAGE(PG8_SA(0, 0), cA, voffA); PG8_STAGE(PG8_SA(0, 1), cA + hstep, voffA);
        if (wr == 1) PG8_BAR;
        PG8_WAIT_V(2); PG8_BAR;
        PG8_STAGE(PG8_SB(1, 0), cB + kstep, voffB); PG8_STAGE(PG8_SA(1, 0), cA + kstep, voffA); PG8_STAGE(PG8_SB(1, 1), cB + hstep + kstep, voffB);
        PG8_WAIT_V(6); PG8_BAR;
    } else {
        PG8_STAGE(PG8_SB(0, 0), cB, voffB); PG8_STAGE(PG8_SA(0, 0), cA, voffA); PG8_STAGE(PG8_SB(0, 1), cB + hstep, voffB); PG8_STAGE(PG8_SA(0, 1), cA + hstep, voffA);
        if (wr == 1) PG8_BAR;
        PG8_WAIT_V(4); PG8_BAR;
        PG8_STAGE(PG8_SB(1, 0), cB + kstep, voffB); PG8_STAGE(PG8_SA(1, 0), cA + kstep, voffA); PG8_STAGE(PG8_SB(1, 1), cB + hstep + kstep, voffB);
        PG8_WAIT_V(6); PG8_BAR;
    }
    for (;;) {
        const bool has_next = S.next(ui + 1, nxt);
        const char* nA = has_next ? (const char*)g.A + (size_t)nxt.pm * tstep : cA; const char* nB = has_next ? (const char*)g.Bt + (size_t)nxt.pn * tstep : cB;
        for (int t = 0; t < nt; t += 2) {
            const bool last = (t == nt - 2);
            const char* a1 = cA + (size_t)(t + 1) * kstep;
            const char* a2 = last ? nA : cA + (size_t)(t + 2) * kstep; const char* b2 = last ? nB : cB + (size_t)(t + 2) * kstep;
            const char* a3 = a2 + kstep; const char* b3 = b2 + kstep;
            if (last && has_next) S.a_ready(nxt);
            if constexpr (SP2) {
            PG8_LDB(B0, 0, 0); PG8_LDB(B1, 0, 1); PG8_SCHED; PG8_LDA(At, 0, 0); PG8_STAGE(PG8_SA(1, 1), a1 + hstep, voffA);
            PG8_WAIT_V(8); PG8_WAIT_L(0); PG8_BAR; PG8_MMA(0, 0, At, B0); PG8_MMA(0, 1, At, B1); PG8_BAR; PG8_SCHED;
            PG8_LDA(At, 0, 1); PG8_STAGE(PG8_SB(0, 0), b2, voffB); PG8_STAGE(PG8_SB(0, 1), b2 + hstep, voffB); PG8_STAGE(PG8_SA(0, 0), a2, voffA);
            PG8_WAIT_V(8); PG8_WAIT_L(0); PG8_BAR; PG8_MMA(1, 0, At, B0); PG8_MMA(1, 1, At, B1); PG8_BAR; PG8_SCHED;
            PG8_LDB(B0, 1, 0); PG8_LDB(B1, 1, 1); PG8_SCHED; PG8_LDA(At, 1, 0); PG8_STAGE(PG8_SA(0, 1), a2 + hstep, voffA);
            PG8_WAIT_V(8); PG8_WAIT_L(0); PG8_BAR; PG8_MMA(0, 0, At, B0); PG8_MMA(0, 1, At, B1); PG8_BAR; PG8_SCHED;
            PG8_LDA(At, 1, 1); PG8_STAGE(PG8_SB(1, 0), b3, voffB); PG8_STAGE(PG8_SB(1, 1), b3 + hstep, voffB); PG8_STAGE(PG8_SA(1, 0), a3, voffA);
            PG8_WAIT_V(8); PG8_WAIT_L(0); PG8_BAR; PG8_MMA(1, 0, At, B0); PG8_MMA(1, 1, At, B1); PG8_BAR; PG8_SCHED;
            } else {
            PG8_LDB(B0, 0, 0); PG8_SCHED; PG8_LDA(At, 0, 0); PG8_STAGE(PG8_SA(1, 1), a1 + hstep, voffA);
            PG8_WAIT_L(8); PG8_BAR; PG8_WAIT_L(0); PG8_MMA(0, 0, At, B0); PG8_BAR; PG8_SCHED;
            PG8_LDB(B1, 0, 1); PG8_STAGE(PG8_SB(0, 0), b2, voffB);
            PG8_BAR; PG8_WAIT_L(0); PG8_MMA(0, 1, At, B1); PG8_BAR;
            PG8_LDA(At, 0, 1); PG8_STAGE(PG8_SA(0, 0), a2, voffA);
            PG8_BAR; PG8_WAIT_L(0); PG8_MMA(1, 0, At, B0); PG8_BAR; PG8_SCHED;
            PG8_STAGE(PG8_SB(0, 1), b2 + hstep, voffB);
            PG8_WAIT_V(6); PG8_BAR; PG8_MMA(1, 1, At, B1); PG8_BAR;
            PG8_LDB(B0, 1, 0); PG8_SCHED; PG8_LDA(At, 1, 0); PG8_STAGE(PG8_SA(0, 1), a2 + hstep, voffA);
            PG8_WAIT_L(8); PG8_BAR; PG8_WAIT_L(0); PG8_MMA(0, 0, At, B0); PG8_BAR; PG8_SCHED;
            PG8_LDB(B1, 1, 1); PG8_STAGE(PG8_SB(1, 0), b3, voffB);
            PG8_BAR; PG8_WAIT_L(0); PG8_MMA(0, 1, At, B1); PG8_BAR;
            PG8_LDA(At, 1, 1); PG8_STAGE(PG8_SA(1, 0), a3, voffA);
            PG8_BAR; PG8_WAIT_L(0); PG8_MMA(1, 0, At, B0); PG8_BAR; PG8_SCHED;
            PG8_STAGE(PG8_SB(1, 1), b3 + hstep, voffB);
            PG8_WAIT_V(6); PG8_BAR; PG8_MMA(1, 1, At, B1); PG8_BAR;
            }
        }
        if constexpr (ALIGN_EPI) { if (wr == 0) PG8_BAR; }
        if constexpr (!Epi::AFTER_DRAIN) { E(acc, cur, wr, wc, fr, fq); S.done(cur); }
        if (!has_next) break;
#pragma unroll
        for (int a = 0; a < 2; ++a)
#pragma unroll
            for (int b = 0; b < 2; ++b)
#pragma unroll
                for (int m = 0; m < 4; ++m)
#pragma unroll
                    for (int n = 0; n < 2; ++n) acc[a][b][m][n] = (f32x4){0.f, 0.f, 0.f, 0.f};
        cur = nxt; cA = nA; cB = nB; ++ui;
        if constexpr (ALIGN_EPI) { if (wr == 1) PG8_BAR; }
    }
    PG8_WAIT_V(0);
    if constexpr (!ALIGN_EPI) { if (wr == 0) PG8_BAR; }
    PG8_BAR;
    if constexpr (Epi::AFTER_DRAIN) { E.fused(acc, cur, wr, wc, fr, fq, lds, wid, lane); S.done(cur); }
#undef PG8_SA
#undef PG8_SB
#undef PG8_STAGE
#undef PG8_LDA
#undef PG8_LDB
#undef PG8_MMA
#undef PG8_WAIT_V
#undef PG8_WAIT_L
#undef PG8_BAR
#undef PG8_SCHED
}
}
#endif

constexpr int LDT = 72;
constexpr int GEMM_AS = 256 * LDT, GEMM_BS = 128 * LDT;
constexpr int GEMM_LDS = 2 * (GEMM_AS + GEMM_BS) * 2;

template <class AF, class EPI>
DEV void gemm_tile(unsigned char* smem, AF af, const bf16* Bt, int ldb, int nvalid, int K, EPI& epi) {
    const int tid = TID, w = tid >> 6, l = tid & 63, h = l >> 4, c = l & 15, wm = w >> 1, wn = w & 1;
    bf16* As = (bf16*)smem; bf16* Bs = As + 2 * GEMM_AS;
    const bf16* ap[4]; const bf16* bp[2];
    const int col8 = (tid & 7) * 8, r0 = tid >> 3;
#pragma unroll
    for (int i = 0; i < 4; ++i) ap[i] = af(r0 + 64 * i) + col8;
#pragma unroll
    for (int i = 0; i < 2; ++i) { int rn = r0 + 64 * i; if (rn >= nvalid) rn = nvalid - 1; bp[i] = Bt + (size_t)rn * ldb + col8; }
    f32x4 acc[4][4];
#pragma unroll
    for (int i = 0; i < 4; ++i)
#pragma unroll
        for (int j = 0; j < 4; ++j) acc[i][j] = f4zero();
    bf16x8 ra[4], rb[2];
#pragma unroll
    for (int i = 0; i < 4; ++i) ra[i] = *(const bf16x8*)(ap[i]);
#pragma unroll
    for (int i = 0; i < 2; ++i) rb[i] = *(const bf16x8*)(bp[i]);
    SYNC();
#pragma unroll
    for (int i = 0; i < 4; ++i) *(bf16x8*)(As + (r0 + 64 * i) * LDT + col8) = ra[i];
#pragma unroll
    for (int i = 0; i < 2; ++i) *(bf16x8*)(Bs + (r0 + 64 * i) * LDT + col8) = rb[i];
    SYNC();
    const int nk = K / 64;
    for (int kt = 0; kt < nk; ++kt) {
        const int cur = kt & 1;
        if (kt + 1 < nk) {
#pragma unroll
            for (int i = 0; i < 4; ++i) ra[i] = *(const bf16x8*)(ap[i] + (kt + 1) * 64);
#pragma unroll
            for (int i = 0; i < 2; ++i) rb[i] = *(const bf16x8*)(bp[i] + (kt + 1) * 64);
        }
        const bf16* Ac = As + cur * GEMM_AS + (wm * 64 + c) * LDT + 8 * h;
        const bf16* Bc = Bs + cur * GEMM_BS + (wn * 64 + c) * LDT + 8 * h;
#pragma unroll
        for (int kk = 0; kk < 2; ++kk) {
            bf16x8 fa[4], fb[4];
#pragma unroll
            for (int i = 0; i < 4; ++i) { fa[i] = *(const bf16x8*)(Ac + i * 16 * LDT + kk * 32); fb[i] = *(const bf16x8*)(Bc + i * 16 * LDT + kk * 32); }
#pragma unroll
            for (int ni = 0; ni < 4; ++ni)
#pragma unroll
                for (int mi = 0; mi < 4; ++mi) acc[ni][mi] = mfma16(fb[ni], fa[mi], acc[ni][mi]);
        }
        if (kt + 1 < nk) {
            const int nx = cur ^ 1;
#pragma unroll
            for (int i = 0; i < 4; ++i) *(bf16x8*)(As + nx * GEMM_AS + (r0 + 64 * i) * LDT + col8) = ra[i];
#pragma unroll
            for (int i = 0; i < 2; ++i) *(bf16x8*)(Bs + nx * GEMM_BS + (r0 + 64 * i) * LDT + col8) = rb[i];
        }
        SYNC();
    }
    epi(acc, wm * 64, wn * 64, h, c);
}

struct ARows { const bf16* base; size_t ld; MDEV const bf16* operator()(int r) const { return base + (size_t)r * ld; } MDEV unsigned off(int r) const { return (unsigned)r * (unsigned)ld; } };

constexpr int LDB = 144;
constexpr int GEMM_BS2 = 64 * LDB;
constexpr int GEMM2_LDS = (2 * GEMM_AS + 2 * GEMM_BS2) * 2;
DEV bf16x8 tr_read8(const bf16* p0, const bf16* p1) {
    const s16x4 x = tr4(p0), y = tr4(p1); bf16x8 r;
    r[0] = x[0]; r[1] = x[1]; r[2] = x[2]; r[3] = x[3]; r[4] = y[0]; r[5] = y[1]; r[6] = y[2]; r[7] = y[3]; return r;
}
DEV int bperm(int r) { return (r & ~12) | ((r & 4) << 1) | ((r & 8) >> 1); }
template <class AF, class BF, class EPI>
DEV void gemm_tile2(unsigned char* smem, AF af, BF bf, int ldb, int K, EPI& epi) {
    const int tid = TID, w = tid >> 6, l = tid & 63, h = l >> 4, c = l & 15, wm = w >> 1, wn = w & 1, grp = w >> 2;
    bf16* As = (bf16*)smem; bf16* Bs = As + 2 * GEMM_AS;
    const bf16* abase = af.base; unsigned ao[4];
    const int col8 = (tid & 7) * 8, r0 = tid >> 3;
#pragma unroll
    for (int i = 0; i < 4; ++i) ao[i] = af.off(r0 + 64 * i) + col8;
    const int bn4 = (tid & 31) * 4, bk = tid >> 5, bkp = bperm(bk);
    const float* bp = bf(bn4); const bool bok = bp != nullptr;
    if (bok) bp += (size_t)bk * ldb;
    const size_t bstep = (size_t)16 * ldb;
    f32x4 acc[4][4];
#pragma unroll
    for (int i = 0; i < 4; ++i)
#pragma unroll
        for (int j = 0; j < 4; ++j) acc[i][j] = f4zero();
    bf16x8 ra[4]; f32x4 rb[4];
    const int nk = K / 64;
#pragma unroll
    for (int i = 0; i < 4; ++i) { ra[i] = *(const bf16x8*)(abase + ao[i]); rb[i] = bok ? *(const f32x4*)(bp + i * bstep) : f4zero(); }
    SYNC();
#pragma unroll
    for (int i = 0; i < 4; ++i) { *(bf16x8*)(As + (r0 + 64 * i) * LDT + col8) = ra[i]; st_bf4(Bs + (bkp + 16 * i) * LDB + bn4, rb[i]); }
    if (nk > 1) {
#pragma unroll
        for (int i = 0; i < 4; ++i) { ra[i] = *(const bf16x8*)(abase + (ao[i] + 64)); rb[i] = bok ? *(const f32x4*)(bp + (size_t)64 * ldb + i * bstep) : f4zero(); } }
    SYNC();
    for (int kt = 0; kt < nk; ++kt) {
        const int cur = kt & 1;
#pragma unroll
        for (int p = 0; p < 2; ++p) {
            if (grp == p) {
                const bf16* Ac = As + cur * GEMM_AS + (wm * 64 + c) * LDT + 8 * h;
                const bf16* Bc = Bs + cur * GEMM_BS2 + bperm(8 * h + (c >> 2)) * LDB + wn * 64 + 4 * (c & 3);
#pragma unroll
                for (int kk = 0; kk < 2; ++kk) {
                    bf16x8 fa[4], fb[4];
#pragma unroll
                    for (int i = 0; i < 4; ++i) { fa[i] = *(const bf16x8*)(Ac + i * 16 * LDT + kk * 32); fb[i] = tr_read8(Bc + (32 * kk) * LDB + 16 * i, Bc + (32 * kk + 8) * LDB + 16 * i); }
#pragma unroll
                    for (int ni = 0; ni < 4; ++ni)
#pragma unroll
                        for (int mi = 0; mi < 4; ++mi) acc[ni][mi] = mfma16(fb[ni], fa[mi], acc[ni][mi]);
                }
            } else if (kt + 1 < nk) {
                const int nx = cur ^ 1;
#pragma unroll
                for (int i = 0; i < 4; ++i) { *(bf16x8*)(As + nx * GEMM_AS + (r0 + 64 * i) * LDT + col8) = ra[i]; st_bf4(Bs + nx * GEMM_BS2 + (bkp + 16 * i) * LDB + bn4, rb[i]); }
                if (kt + 2 < nk) {
#pragma unroll
                    for (int i = 0; i < 4; ++i) { ra[i] = *(const bf16x8*)(abase + (ao[i] + (kt + 2) * 64)); rb[i] = bok ? *(const f32x4*)(bp + (size_t)(kt + 2) * 64 * ldb + i * bstep) : f4zero(); } }
            }
            SYNC();
        }
    }
    epi(acc, wm * 64, wn * 64, h, c);
}
struct BPlain { const float* base; MDEV const float* operator()(int nt) const { return base + nt; } };
struct BInProjMap { const float* base; int n0; MDEV const float* operator()(int nt) const { const int n = n0 + nt; const int sc = n < 1280 ? n : (n < 3328 ? n + 24 : (n < 3352 ? 1280 + (n - 3328) : -1)); return sc < 0 ? nullptr : base + sc; } };
struct BInter { const float* s0; const float* s1; int n0; MDEV const float* operator()(int nt) const { const int n = n0 + nt, g = n >> 6, w = n & 63; return w < 32 ? s0 + g * 32 + w : s1 + g * 32 + w - 32; } };
struct BClamp64 { const float* base; MDEV const float* operator()(int nt) const { return base + (nt & 63); } };

struct EpiInProj {
    const Args* a; int m0, n0, li;
    MDEV void operator()(f32x4 (&acc)[4][4], int mw, int nw, int h, int c) const {
        unsigned char* ws = wsp(*a);
        const int nb = n0 + nw;
        const int tokb = m0 + mw + c;
        if (nb < 512 || (nb >= 768 && nb < 896) || (nb >= 1024 && nb < 1152)) {
            const float* gain; float mul = 1.f; bf16* dst; int kind;
            if (nb < 512) { gain = INP(*a, I_QG) + li * 64; mul = 0.125f * LOG2E; kind = 0; dst = (bf16*)(ws + WS_QN); }
            else if (nb < 896) { gain = INP(*a, I_KG) + (li * 3 + 1) * 64; kind = 1; dst = (bf16*)(ws + WS_KS); }
            else { gain = INP(*a, I_KG) + (li * 3 + 2) * 64; kind = 1; dst = (bf16*)(ws + WS_KW); }
            const int g = (nb >> 6) & 1;
#pragma unroll
            for (int mi = 0; mi < 4; ++mi) {
                float ss = 0.f;
#pragma unroll
                for (int ni = 0; ni < 4; ++ni) { f32x4 v = acc[ni][mi]; ss += v[0] * v[0] + v[1] * v[1] + v[2] * v[2] + v[3] * v[3]; }
                ss += shflx(ss, 16); ss += shflx(ss, 32);
                const float rs = frsq(ss * (1.0f / 64.0f) + EPS) * mul;
                const int tok = tokb + 16 * mi;
#pragma unroll
                for (int ni = 0; ni < 4; ++ni) {
                    const int d = 16 * ni + 4 * h; f32x4 v = acc[ni][mi], o;
#pragma unroll
                    for (int r = 0; r < 4; ++r) o[r] = v[r] * rs * gain[d + r];
                    if (kind == 0) st_bf4(dst + (size_t)tok * 512 + nb + d, o);
                    else { const int b = tok / SEQ, s = tok % SEQ; st_bf4(dst + ((size_t)(b * 2 + g) * SEQ + s) * 64 + d, o); }
                }
            }
        } else if (nb < 768) {
            bf16* dst = (bf16*)(ws + (nb < 640 ? WS_KCG : WS_VCG)); const int g = (nb >> 6) & 1;
#pragma unroll
            for (int mi = 0; mi < 4; ++mi) { const int tok = tokb + 16 * mi, b = tok / SEQ, s = tok % SEQ;
#pragma unroll
                for (int ni = 0; ni < 4; ++ni) st_bf4(dst + ((size_t)(b * 2 + g) * SEQ + s) * 64 + 16 * ni + 4 * h, acc[ni][mi]); }
        } else if (nb < 1280) {
            bf16* dst = (bf16*)(ws + (nb < 1024 ? WS_VST : WS_VWT)); const int g = (nb >> 6) & 1;
#pragma unroll
            for (int mi = 0; mi < 4; ++mi) { const int tok = tokb + 16 * mi, b = tok / SEQ, s = tok % SEQ;
                bf16* p = dst + ((size_t)(b * 2 + g) * NCH + (s >> 6)) * 4096 + (s & 63);
#pragma unroll
                for (int ni = 0; ni < 4; ++ni)
#pragma unroll
                    for (int r = 0; r < 4; ++r) p[(16 * ni + 4 * h + r) * 64] = (bf16)f2bf(acc[ni][mi][r]); }
        } else if (nb < 3328) {
            const int sec = (nb - 1280) >> 9, cc = (nb - 1280) & 511, hh = cc >> 7, d0 = cc & 127;
#pragma unroll
            for (int mi = 0; mi < 4; ++mi) { const int tok = tokb + 16 * mi, b = tok / SEQ, s = tok % SEQ;
                const size_t hrow = ((size_t)(b * 4 + hh) * SEQ + s) * 128 + d0;
#pragma unroll
                for (int ni = 0; ni < 4; ++ni) { const int d = 16 * ni + 4 * h; f32x4 v = acc[ni][mi], o;
                    if (sec == 0) { for (int r = 0; r < 4; ++r) o[r] = siluf(v[r]); st_bf4((bf16*)(ws + WS_HQ) + hrow + d, o); }
                    else if (sec == 1) { const float* lb = (const float*)(ws + WS_LB) + li * 512 + cc + d;
                        for (int r = 0; r < 4; ++r) o[r] = lb[r] + (1.0f - lb[r]) * sigm(v[r]);
                        *(f32x4*)((float*)(ws + WS_HF) + hrow + d) = o; }
                    else if (sec == 2) st_bf4((bf16*)(ws + WS_HV) + hrow + d, v);
                    else { for (int r = 0; r < 4; ++r) o[r] = siluf(v[r]); st_bf4((bf16*)(ws + WS_HGS) + (size_t)tok * 512 + cc + d, o); }
                } }
        } else if (nb == 3328) {
            float* dst = (float*)(ws + WS_GATE);
#pragma unroll
            for (int mi = 0; mi < 4; ++mi) { const int tok = tokb + 16 * mi;
#pragma unroll
                for (int ni = 0; ni < 2; ++ni)
#pragma unroll
                    for (int r = 0; r < 4; ++r) { const int n = 16 * ni + 4 * h + r; if (n < 24) dst[(size_t)tok * 24 + n] = sigm(acc[ni][mi][r]); } }
        }
    }
};

struct EpiResid {
    float* x; const float* gate; int m0, n0;
    MDEV void operator()(f32x4 (&acc)[4][4], int mw, int nw, int h, int c) const {
#pragma unroll
        for (int mi = 0; mi < 4; ++mi) { const int tok = m0 + mw + 16 * mi + c, b = tok / SEQ;
#pragma unroll
            for (int ni = 0; ni < 4; ++ni) { const int n = n0 + nw + 16 * ni + 4 * h;
                f32x4 g = *(const f32x4*)(gate + (size_t)b * 6 * DM + n); f32x4* p = (f32x4*)(x + (size_t)tok * DM + n); f32x4 v = *p;
#pragma unroll
                for (int r = 0; r < 4; ++r) v[r] += g[r] * acc[ni][mi][r];
                *p = v; } }
    }
};
template <int MODE> struct EpiGated {
    bf16* dst; size_t ld; int m0, n0, mvalid;
    MDEV void operator()(f32x4 (&acc)[4][4], int mw, int nw, int h, int c) const {
        const int cb = (n0 + nw) / 2;
#pragma unroll
        for (int mi = 0; mi < 4; ++mi) { const int m = mw + 16 * mi + c; if (m >= mvalid) continue;
#pragma unroll
            for (int ni = 0; ni < 2; ++ni) { f32x4 o;
#pragma unroll
                for (int r = 0; r < 4; ++r) { const float av = acc[ni][mi][r], bv = acc[ni + 2][mi][r]; o[r] = MODE == 0 ? av * sigm(bv) : siluf(av) * bv; }
                st_bf4(dst + (size_t)(m0 + m) * ld + cb + 16 * ni + 4 * h, o); } }
    }
};
struct EpiStoreBf {
    bf16* dst; size_t ld; int m0, n0, mvalid;
    MDEV void operator()(f32x4 (&acc)[4][4], int mw, int nw, int h, int c) const {
#pragma unroll
        for (int mi = 0; mi < 4; ++mi) { const int m = mw + 16 * mi + c; if (m >= mvalid) continue;
#pragma unroll
            for (int ni = 0; ni < 4; ++ni) st_bf4(dst + (size_t)(m0 + m) * ld + n0 + nw + 16 * ni + 4 * h, acc[ni][mi]); }
    }
};
struct EpiCmp {
    const Args* a; int kv, bg, m0, li;
    MDEV void operator()(f32x4 (&acc)[4][4], int mw, int nw, int h, int c) const {
        if (nw != 0) return;
        unsigned char* ws = wsp(*a);
        const float* bp8 = (const float*)(ws + WS_CB) + (li * 2 + kv) * 8 * 64;
        float bias[16];
#pragma unroll
        for (int q = 0; q < 16; ++q) { const int e = 16 * (q >> 2) + 4 * h + (q & 3); float v = 0.f;
#pragma unroll
            for (int kp = 0; kp < 8; ++kp) v += bp8[kp * 64 + e];
            bias[q] = v; }
        const float* gain = INP(*a, I_KG) + (li * 3 + 0) * 64;
#pragma unroll
        for (int mi = 0; mi < 4; ++mi) { const int n = m0 + mw + 16 * mi + c; const bool ok = n < NCMP;
            f32x4 v[4]; float ss = 0.f;
#pragma unroll
            for (int ni = 0; ni < 4; ++ni) { v[ni] = acc[ni][mi];
#pragma unroll
                for (int r = 0; r < 4; ++r) { v[ni][r] += bias[4 * ni + r]; ss += v[ni][r] * v[ni][r]; } }
            ss += shflx(ss, 16); ss += shflx(ss, 32);
            if (n >= NCP) continue;
            if (kv == 0) { const float rs = frsq(ss * (1.0f / 64.0f) + EPS); bf16* p = (bf16*)(ws + WS_KC) + ((size_t)bg * NCP + n) * 64;
#pragma unroll
                for (int ni = 0; ni < 4; ++ni) { f32x4 o;
#pragma unroll
                    for (int r = 0; r < 4; ++r) o[r] = ok ? v[ni][r] * rs * gain[16 * ni + 4 * h + r] : 0.f;
                    st_bf4(p + 16 * ni + 4 * h, o); }
            } else { bf16* p = (bf16*)(ws + WS_VCT) + ((size_t)bg * NCP + n) * 64;
#pragma unroll
                for (int ni = 0; ni < 4; ++ni) { f32x4 o;
#pragma unroll
                    for (int r = 0; r < 4; ++r) o[r] = ok ? v[ni][r] : 0.f;
                    st_bf4(p + 16 * ni + 4 * h, o); } }
        }
    }
};


struct EpiResid8 {
    static constexpr bool PERM = true, AFTER_DRAIN = false;
    float* x; const float* gate;
    MDEV void operator()(const f32x4 (&acc)[2][2][4][2], const pg8::Unit& u, int wr, int wc, int fr, int fq) const {
        OPAQUE2(fr, fq);
#pragma unroll
        for (int ai = 0; ai < 2; ++ai)
#pragma unroll
            for (int m = 0; m < 4; ++m) { const int row = 256 * u.pm + 128 * ai + 64 * wr + 16 * m + fr, b = row / SEQ;
#pragma unroll
                for (int bj = 0; bj < 2; ++bj)
#pragma unroll
                    for (int n = 0; n < 2; ++n) { const int col = 256 * u.pn + 128 * bj + 32 * wc + 8 * fq + 4 * n;
                        const f32x4 g = *(const f32x4*)(gate + (size_t)b * 6 * DM + col); f32x4* p = (f32x4*)(x + (size_t)row * DM + col); f32x4 v = *p;
#pragma unroll
                        for (int r = 0; r < 4; ++r) v[r] += g[r] * acc[ai][bj][m][n][r];
                        *p = v; } }
    }
};
struct EpiGlu8 {
    static constexpr bool PERM = true, AFTER_DRAIN = false;
    bf16* dst;
    MDEV void operator()(const f32x4 (&acc)[2][2][4][2], const pg8::Unit& u, int wr, int wc, int fr, int fq) const {
        OPAQUE2(fr, fq);
#pragma unroll
        for (int ai = 0; ai < 2; ++ai)
#pragma unroll
            for (int m = 0; m < 4; ++m) { const int row = 256 * u.pm + 128 * ai + 64 * wr + 16 * m + fr;
#pragma unroll
                for (int bj = 0; bj < 2; ++bj) { const int col = 128 * u.pn + 64 * bj + 16 * wc + 4 * fq; f32x4 o;
#pragma unroll
                    for (int r = 0; r < 4; ++r) o[r] = acc[ai][bj][m][0][r] * sigm(acc[ai][bj][m][1][r]);
                    st_bf4(dst + (size_t)row * DM + col, o); } }
    }
};
struct EpiInProj8 {
    static constexpr bool PERM = true, AFTER_DRAIN = false;
    const Args* a; int li;
    MDEV void operator()(const f32x4 (&acc)[2][2][4][2], const pg8::Unit& u, int wr, int wc, int fr, int fq) const {
        OPAQUE2(fr, fq);
        unsigned char* ws = wsp(*a);
        const int nb = 256 * u.pn + 64 * wc;
        if (nb >= 3392) return;
        if (nb < 512 || (nb >= 768 && nb < 896) || (nb >= 1024 && nb < 1152)) {
            const float* gain; float mul = 1.f; int kind;
            if (nb < 512) { gain = INP(*a, I_QG) + li * 64; mul = 0.125f * LOG2E; kind = 0; }
            else if (nb < 896) { gain = INP(*a, I_KG) + (li * 3 + 1) * 64; kind = 1; }
            else { gain = INP(*a, I_KG) + (li * 3 + 2) * 64; kind = 2; }
            const int g = (nb >> 6) & 1;
            f32x4 gv[2][2];
#pragma unroll
            for (int bj = 0; bj < 2; ++bj)
#pragma unroll
                for (int n = 0; n < 2; ++n) gv[bj][n] = *(const f32x4*)(gain + 32 * bj + 8 * fq + 4 * n);
#pragma unroll
            for (int ai = 0; ai < 2; ++ai)
#pragma unroll
                for (int m = 0; m < 4; ++m) { const int tok = 256 * u.pm + 128 * ai + 64 * wr + 16 * m + fr;
                    float ss = 0.f;
#pragma unroll
                    for (int bj = 0; bj < 2; ++bj)
#pragma unroll
                        for (int n = 0; n < 2; ++n) { const f32x4 v = acc[ai][bj][m][n]; ss += v[0] * v[0] + v[1] * v[1] + v[2] * v[2] + v[3] * v[3]; }
                    ss += shflx(ss, 16); ss += shflx(ss, 32);
                    const float rs = frsq(ss * (1.0f / 64.0f) + EPS) * mul;
                    bf16* dst; if (kind == 0) dst = (bf16*)(ws + WS_QN) + (size_t)tok * 512 + nb; else { const int b = tok / SEQ, sq = tok % SEQ; dst = (bf16*)(ws + (kind == 1 ? WS_KS : WS_KW)) + ((size_t)(b * 2 + g) * SEQ + sq) * 64; }
#pragma unroll
                    for (int bj = 0; bj < 2; ++bj) { f32x4 o0, o1;
#pragma unroll
                        for (int r = 0; r < 4; ++r) { o0[r] = acc[ai][bj][m][0][r] * rs * gv[bj][0][r]; o1[r] = acc[ai][bj][m][1][r] * rs * gv[bj][1][r]; }
                        st_bf8(dst + 32 * bj + 8 * fq, o0, o1); } }
        } else if (nb < 768) {
            bf16* base = (bf16*)(ws + (nb < 640 ? WS_KCG : WS_VCG)); const int g = (nb >> 6) & 1;
#pragma unroll
            for (int ai = 0; ai < 2; ++ai)
#pragma unroll
                for (int m = 0; m < 4; ++m) { const int tok = 256 * u.pm + 128 * ai + 64 * wr + 16 * m + fr, b = tok / SEQ, sq = tok % SEQ;
#pragma unroll
                    for (int bj = 0; bj < 2; ++bj) st_bf8(base + ((size_t)(b * 2 + g) * SEQ + sq) * 64 + 32 * bj + 8 * fq, acc[ai][bj][m][0], acc[ai][bj][m][1]); }
        } else if (nb < 1280) {
            bf16* base = (bf16*)(ws + (nb < 1024 ? WS_VST : WS_VWT)); const int g = (nb >> 6) & 1;
#pragma unroll
            for (int ai = 0; ai < 2; ++ai)
#pragma unroll
                for (int m = 0; m < 4; ++m) { const int tok = 256 * u.pm + 128 * ai + 64 * wr + 16 * m + fr, b = tok / SEQ, sq = tok % SEQ;
#pragma unroll
                    for (int bj = 0; bj < 2; ++bj) st_bf8(base + ((size_t)(b * 2 + g) * SEQ + sq) * 64 + 32 * bj + 8 * fq, acc[ai][bj][m][0], acc[ai][bj][m][1]); }
        } else if (nb < 3328) {
            const int sec = (nb - 1280) >> 9, cc = (nb - 1280) & 511, hh = cc >> 7, d0 = cc & 127;
            f32x4 lbv[2][2];
            if (sec == 1) {
#pragma unroll
                for (int bj = 0; bj < 2; ++bj)
#pragma unroll
                    for (int n = 0; n < 2; ++n) lbv[bj][n] = *(const f32x4*)((const float*)(ws + WS_LB) + li * 512 + cc + 32 * bj + 8 * fq + 4 * n); }
#pragma unroll
            for (int ai = 0; ai < 2; ++ai)
#pragma unroll
                for (int m = 0; m < 4; ++m) { const int tok = 256 * u.pm + 128 * ai + 64 * wr + 16 * m + fr, b = tok / SEQ, sq = tok % SEQ;
                    const size_t hrow = ((size_t)(b * 4 + hh) * SEQ + sq) * 128 + d0;
#pragma unroll
                    for (int bj = 0; bj < 2; ++bj) { const int d = 32 * bj + 8 * fq; f32x4 o0, o1;
                        if (sec == 0) {
#pragma unroll
                            for (int r = 0; r < 4; ++r) { o0[r] = siluf(acc[ai][bj][m][0][r]); o1[r] = siluf(acc[ai][bj][m][1][r]); }
                            st_bf8((bf16*)(ws + WS_HQ) + hrow + d, o0, o1); }
                        else if (sec == 1) {
#pragma unroll
                            for (int r = 0; r < 4; ++r) { o0[r] = lbv[bj][0][r] + (1.0f - lbv[bj][0][r]) * sigm(acc[ai][bj][m][0][r]); o1[r] = lbv[bj][1][r] + (1.0f - lbv[bj][1][r]) * sigm(acc[ai][bj][m][1][r]); }
                            float* pf = (float*)(ws + WS_HF) + hrow + d; *(f32x4*)pf = o0; *(f32x4*)(pf + 4) = o1; }
                        else if (sec == 2) st_bf8((bf16*)(ws + WS_HV) + hrow + d, acc[ai][bj][m][0], acc[ai][bj][m][1]);
                        else {
#pragma unroll
                            for (int r = 0; r < 4; ++r) { o0[r] = siluf(acc[ai][bj][m][0][r]); o1[r] = siluf(acc[ai][bj][m][1][r]); }
                            st_bf8((bf16*)(ws + WS_HGS) + (size_t)tok * 512 + cc + d, o0, o1); } } }
        } else {
            float* dst = (float*)(ws + WS_GATE);
            if (fq < 3) {
#pragma unroll
                for (int ai = 0; ai < 2; ++ai)
#pragma unroll
                    for (int m = 0; m < 4; ++m) { const int tok = 256 * u.pm + 128 * ai + 64 * wr + 16 * m + fr; f32x4 o0, o1;
#pragma unroll
                        for (int r = 0; r < 4; ++r) { o0[r] = sigm(acc[ai][0][m][0][r]); o1[r] = sigm(acc[ai][0][m][1][r]); }
                        float* pf = dst + (size_t)tok * 24 + 8 * fq; *(f32x4*)pf = o0; *(f32x4*)(pf + 4) = o1; } }
        }
    }
};

DEV void tr_tile(unsigned char* smem, const float* src0, const float* src1, int ld, int K, int mode, bf16* dst, int n0, int k0) {
    bf16* tl = (bf16*)smem;
    const int tid = TID;
    SYNC();
#pragma unroll
    for (int i = 0; i < 8; ++i) {
        const int e = tid + 512 * i, kk = e >> 6, nn = e & 63, n = n0 + nn; float v = 0.f;
        if (mode == 0) v = src0[(size_t)(k0 + kk) * ld + n];
        else if (mode == 1) { int sc = n < 1280 ? n : (n < 3328 ? n + 24 : (n < 3352 ? 1280 + (n - 3328) : -1)); if (sc >= 0) v = src0[(size_t)(k0 + kk) * ld + sc]; }
        else { const int g = n >> 6, w = n & 63; v = (w < 32) ? src0[(size_t)(k0 + kk) * ld + g * 32 + w] : src1[(size_t)(k0 + kk) * ld + g * 32 + w - 32]; }
        tl[nn * LDT + kk] = (bf16)f2bf(v);
    }
    SYNC();
    const int nn = tid >> 3, k8 = (tid & 7) * 8;
    *(bf16x8*)(dst + (size_t)(n0 + nn) * K + k0 + k8) = *(const bf16x8*)(tl + nn * LDT + k8);
}

DEV int tr_col(int mode, int n) {
    if (mode == 0) return n;
    const int pn = n >> 8, ct = n & 255;
    if (mode == 5) { const int bj = ct >> 7, wc = (ct >> 5) & 3, j = ct & 31, L = 256 * pn + 64 * wc + 32 * bj + j; return L < 1280 ? L : (L < 3328 ? L + 24 : (L < 3352 ? 1280 + (L - 3328) : -1)); }
    { const int bj = ct >> 7, wc = (ct >> 5) & 3, j = ct & 31, nn = (j >> 2) & 1, Lc = 128 * pn + 64 * bj + 16 * wc + 4 * (j >> 3) + (j & 3); return nn == 0 ? Lc : DM + Lc; }
}
DEV void tr_tile(unsigned char* smem, const float* src, int ld, int K, int mode, bf16* dst, int n0, int k0) {
    bf16* tl = (bf16*)smem;
    const int tid = TID, nq = tid & 31, kq = tid >> 5;
    const int sc = tr_col(mode, n0 + 4 * nq);
    f32x4 v[4];
#pragma unroll
    for (int i = 0; i < 4; ++i) v[i] = sc >= 0 ? *(const f32x4*)(src + (size_t)(k0 + 4 * kq + i) * ld + sc) : f4zero();
    SYNC();
#pragma unroll
    for (int j = 0; j < 4; ++j) { u32x2 w; w[0] = pk2(v[0][j], v[1][j]); w[1] = pk2(v[2][j], v[3][j]); *(u32x2*)(tl + (4 * nq + j) * LDT + 4 * kq) = w; }
    SYNC();
#pragma unroll
    for (int t = 0; t < 2; ++t) { const int id = tid + 512 * t, row = id >> 3, ch = id & 7;
        *(bf16x8*)(dst + (size_t)(n0 + row) * K + k0 + 8 * ch) = *(const bf16x8*)(tl + row * LDT + 8 * ch); }
}
struct TrJob { const float* s; int ld, K, N, mode; bf16* dst; };
DEV void p0_phase(const Args& a, unsigned char* smem) {
    unsigned char* ws = wsp(a); const int tid = TID;
    { int item = BID, base = 0;
      for (int j = 0; j < 8; ++j) { TrJob J; const int i = j & 1;
        if (j < 2) J = {INP(a, I_WIN) + (size_t)i * DM * NIN, NIN, DM, NIN8, 5, (bf16*)(ws + WS_WIN) + (size_t)i * NIN8 * DM};
        else if (j < 4) J = {INP(a, I_WOUT) + (size_t)i * 1024 * DM, DM, 1024, DM, 0, (bf16*)(ws + WS_WOUT) + (size_t)i * DM * 1024};
        else if (j < 6) J = {INP(a, I_PW1) + (size_t)i * DM * 2 * DM, 2 * DM, DM, 2 * DM, 6, (bf16*)(ws + WS_PW1) + (size_t)i * 2 * DM * DM};
        else J = {INP(a, I_PW2) + (size_t)i * DM * DM, DM, DM, DM, 0, (bf16*)(ws + WS_PW2) + (size_t)i * DM * DM};
        const int tn = J.N / 128, tk = J.K / 64, nt = tn * tk;
        while (item < base + nt) { const int it = item - base; tr_tile(smem, J.s, J.ld, J.K, J.mode, J.dst, (it % tn) * 128, (it / tn) * 64); item += NBLK; }
        base += nt; }
      SYNC(); }
    {
        float* red = (float*)smem;
        constexpr int NG = 6 * DM / 128; const int ntask = DEPTH * NG;
        for (int t = BID; t < ntask; t += NBLK) {
            const int l = t / NG, j0 = (t % NG) * 128, cq = tid & 31, kr = tid >> 5;
            const float* w = INP(a, I_ADAW) + (size_t)l * DM * 6 * DM + j0 + 4 * cq; const float* cc = INP(a, I_C);
            f32x4 a0 = f4zero(), a1 = f4zero();
#pragma unroll 8
            for (int i = 0; i < DM / 16; ++i) { const int k = kr + 16 * i; const f32x4 wv = *(const f32x4*)(w + (size_t)k * 6 * DM); const float s0 = siluf(cc[k]), s1 = siluf(cc[DM + k]);
#pragma unroll
                for (int r = 0; r < 4; ++r) { a0[r] += s0 * wv[r]; a1[r] += s1 * wv[r]; } }
            SYNC();
            *(f32x4*)(red + (kr * 2 + 0) * 128 + 4 * cq) = a0; *(f32x4*)(red + (kr * 2 + 1) * 128 + 4 * cq) = a1;
            SYNC();
            if (tid < 256) { const int b = tid >> 7, col = tid & 127; float sum = INP(a, I_ADAB)[(size_t)l * 6 * DM + j0 + col];
#pragma unroll
                for (int q = 0; q < 16; ++q) sum += red[(q * 2 + b) * 128 + col];
                ((float*)(ws + WS_MOD))[((size_t)l * 2 + b) * 6 * DM + j0 + col] = sum; }
        }
    }
    for (int t = BID; t < 32; t += NBLK) {
        float* red = (float*)smem; const int ikv = t >> 3, kp = t & 7, i = ikv >> 1, kv = ikv & 1, e = tid & 63, ks = tid >> 6;
        const float* W = INP(a, kv ? I_CWV : I_CWK) + (size_t)i * 2048 * 64 + e; const float* pe = INP(a, I_CPE) + (size_t)i * 2048;
        float sum = 0.f;
#pragma unroll 8
        for (int q = 0; q < 32; ++q) { const int k = kp * 256 + ks * 32 + q; sum += pe[k] * W[(size_t)k * 64]; }
        SYNC(); red[ks * 64 + e] = sum; SYNC();
        if (tid < 64) { float v = 0.f; for (int q = 0; q < 8; ++q) v += red[q * 64 + tid]; ((float*)(ws + WS_CB))[(ikv * 8 + kp) * 64 + tid] = v; }
    }
    for (int i = BID * NT + tid; i < DEPTH * 48 * DM; i += NBLK * NT) { const int k = i % DM, n = (i / DM) % 48, ll = i / (48 * DM);
        const float wv = n < 4 ? INP(a, I_WG)[((size_t)ll * DM + k) * 4 + n] : (n < 36 ? INP(a, I_WE)[((size_t)ll * DM + k) * 32 + n - 4] : 0.f);
        const unsigned hi = f2bf(wv); ((bf16*)(ws + WS_WTH))[i] = (bf16)hi; ((bf16*)(ws + WS_WTL))[i] = (bf16)f2bf(wv - bf2f(hi)); }
    if (BID == 0) {
        for (int i = tid; i < DEPTH * 32; i += NT) ((int*)(ws + WS_CNT))[i * 64] = 0;
        for (int n = tid; n < 512; n += NT) { const float l0 = INP(a, I_LBL)[n], l1 = INP(a, I_LBL)[512 + n]; const float m = fmaxf(l0, l1);
            const float e0 = fexp2((l0 - m) * LOG2E), e1 = fexp2((l1 - m) * LOG2E);
            ((float*)(ws + WS_LB))[n] = 0.f; ((float*)(ws + WS_LB))[512 + n] = e1 / (e0 + e1); }
        if (tid < 2) { const int i = tid; float mq = 0.f; for (int d = 0; d < 64; ++d) mq = fmaxf(mq, fabsf(INP(a, I_QG)[i * 64 + d]));
            for (int br = 0; br < 3; ++br) { float mk = 0.f; for (int d = 0; d < 64; ++d) mk = fmaxf(mk, fabsf(INP(a, I_KG)[(i * 3 + br) * 64 + d]));
                ((float*)(ws + WS_CS))[i * 4 + br] = 8.0f * mq * mk * LOG2E; } }
    }
}

constexpr int NJV = DM / 256;
DEV void moe_bases(const int* cnt, int* rb  ) {
    if (TID == 0) { int acc = 0; for (int e = 0; e < 32; ++e) { rb[e] = acc; acc += ((cnt[e * 64] + 255) >> 8) << 8; } rb[32] = acc; }
    SYNC();
}
DEV void norm_phase(const Args& a, unsigned char* smem, int l) {
    unsigned char* ws = wsp(a); const int tid = TID, w = tid >> 6, lane = tid & 63;
    int* rb = (int*)smem;
    if (l > 0) moe_bases((const int*)(ws + WS_CNT) + (l - 1) * 32 * 64, rb);
    const float* mod = (const float*)(ws + WS_MOD);
    const bf16* yk = (const bf16*)(ws + WS_YK);
    if (l < DEPTH) {
        const int bid = BID % 76 == BID ? BID : -1;
        for (int job = BID; job < 76; job += NBLK) {
            if (job < 72) { const int b = job / 36, n = job % 36; float sum = 0.f;
                for (int k = tid; k < DM; k += NT) { const float wv = n < 4 ? INP(a, I_WG)[((size_t)l * DM + k) * 4 + n] : INP(a, I_WE)[((size_t)l * DM + k) * 32 + n - 4]; sum += mod[((size_t)l * 2 + b) * 6 * DM + 3 * DM + k] * wv; }
#pragma unroll
                for (int q = 1; q < 64; q <<= 1) sum += shflx(sum, q);
                float* red = (float*)(smem + 1024);
                SYNC(); if (lane == 0) red[w] = sum; SYNC();
                if (tid == 0) { float t = 0.f; for (int q = 0; q < 8; ++q) t += red[q]; ((float*)(ws + WS_RBIAS))[((size_t)l * 2 + b) * 48 + n] = t; }
            } else { const float* nf = INP(a, I_NFFN) + (size_t)l * DM; const int part = job - 72;
                for (int i = part * (2 * DM / 4) + tid; i < (part + 1) * (2 * DM / 4); i += NT) { const int b = i / DM, k = i % DM; ((float*)(ws + WS_AVEC))[((size_t)l * 2 + b) * DM + k] = nf[k] * (1.0f + mod[((size_t)l * 2 + b) * 6 * DM + 4 * DM + k]); } }
        }
        (void)bid;
    }
    const int rstride = NBLK * 8;
    for (int rowa = BID * 8 + w; rowa < T; rowa += 2 * rstride) {
        int row[2]; bool ok[2];
        row[0] = rowa; ok[0] = true; row[1] = rowa + rstride; ok[1] = row[1] < T; if (!ok[1]) row[1] = rowa;
        f32x4 v[2][NJV]; int e0[2], p0[2], e1[2], p1[2]; float w0[2], w1[2];
        const float* xin = (l == 0) ? INP(a, I_X) : outp(a);
#pragma unroll
        for (int q = 0; q < 2; ++q) {
#pragma unroll
            for (int j = 0; j < NJV; ++j) v[q][j] = *(const f32x4*)(xin + (size_t)row[q] * DM + 4 * lane + 256 * j);
            if (l > 0) { const int* tie = (const int*)(ws + WS_TIE) + (size_t)row[q] * 2; const float* tiw = (const float*)(ws + WS_TIW) + (size_t)row[q] * 2;
                e0[q] = tie[0] >> 14; p0[q] = tie[0] & 16383; e1[q] = tie[1] >> 14; p1[q] = tie[1] & 16383; w0[q] = tiw[0]; w1[q] = tiw[1]; } }
        if (l > 0) {
            u32x2 q0[2][NJV], q1[2][NJV];
#pragma unroll
            for (int q = 0; q < 2; ++q) { const bf16* y0 = yk + (size_t)(rb[e0[q]] + p0[q]) * DM; const bf16* y1 = yk + (size_t)(rb[e1[q]] + p1[q]) * DM;
#pragma unroll
                for (int j = 0; j < NJV; ++j) { const int cidx = 4 * lane + 256 * j; q0[q][j] = *(const u32x2*)(y0 + cidx); q1[q][j] = *(const u32x2*)(y1 + cidx); } }
#pragma unroll
            for (int q = 0; q < 2; ++q) { const int b = row[q] / SEQ; const float* gf = mod + ((size_t)(l - 1) * 2 + b) * 6 * DM + 5 * DM;
#pragma unroll
                for (int j = 0; j < NJV; ++j) { const int cidx = 4 * lane + 256 * j; const f32x4 g = *(const f32x4*)(gf + cidx);
                    v[q][j][0] += g[0] * (w0[q] * bf2f(q0[q][j][0] & 0xffff) + w1[q] * bf2f(q1[q][j][0] & 0xffff));
                    v[q][j][1] += g[1] * (w0[q] * bf2f(q0[q][j][0] >> 16) + w1[q] * bf2f(q1[q][j][0] >> 16));
                    v[q][j][2] += g[2] * (w0[q] * bf2f(q0[q][j][1] & 0xffff) + w1[q] * bf2f(q1[q][j][1] & 0xffff));
                    v[q][j][3] += g[3] * (w0[q] * bf2f(q0[q][j][1] >> 16) + w1[q] * bf2f(q1[q][j][1] >> 16)); } }
        }
#pragma unroll
        for (int q = 0; q < 2; ++q) { if (!ok[q]) continue;
#pragma unroll
            for (int j = 0; j < NJV; ++j) *(f32x4*)(outp(a) + (size_t)row[q] * DM + 4 * lane + 256 * j) = v[q][j]; }
        if (l == DEPTH) continue;
        float ss[2];
#pragma unroll
        for (int q = 0; q < 2; ++q) { ss[q] = 0.f;
#pragma unroll
            for (int j = 0; j < NJV; ++j) ss[q] += v[q][j][0] * v[q][j][0] + v[q][j][1] * v[q][j][1] + v[q][j][2] * v[q][j][2] + v[q][j][3] * v[q][j][3]; }
#pragma unroll
        for (int o = 1; o < 64; o <<= 1) { ss[0] += shflx(ss[0], o); ss[1] += shflx(ss[1], o); }
        const float* nm = INP(a, I_NMIX) + (size_t)l * DM;
#pragma unroll
        for (int q = 0; q < 2; ++q) { if (!ok[q]) continue;
            const int b = row[q] / SEQ; const float rs = frsq(ss[q] * (1.0f / DM) + EPS);
            const float* mm = mod + ((size_t)l * 2 + b) * 6 * DM; bf16* hb = (bf16*)(ws + WS_H) + (size_t)row[q] * DM;
#pragma unroll
            for (int j = 0; j < NJV; ++j) { const int cidx = 4 * lane + 256 * j; f32x4 g = *(const f32x4*)(nm + cidx), sh = *(const f32x4*)(mm + cidx), sc = *(const f32x4*)(mm + DM + cidx), o;
#pragma unroll
                for (int r = 0; r < 4; ++r) o[r] = v[q][j][r] * rs * g[r] * (1.0f + sc[r]) + sh[r];
                st_bf4(hb + cidx, o); } }
    }
}

DEV void route_phase(const Args& a, unsigned char* smem, int l) {
    unsigned char* ws = wsp(a); const int tid = TID, w = tid >> 6, lane = tid & 63, h = lane >> 4, c = lane & 15, pi = w >> 1, kh = w & 1;
    constexpr int CH = DM / 2, WLD = CH + 8, NKS = CH / 2 / 32;
    bf16* WHl = (bf16*)smem; bf16* WLl = WHl + 48 * WLD;
    float* lg = (float*)(WLl + 48 * WLD);
    float* ssb = lg + 4 * 2 * 16 * 48;
    float* rsb = ssb + 4 * 2 * 16;
    int* lcnt = (int*)(rsb + 64); int* lbase = lcnt + 32; int* tinfo = lbase + 32;
    SYNC();
    if (tid < 32) lcnt[tid] = 0;
    SYNC();
    const float* mod = (const float*)(ws + WS_MOD);
    const bf16* WH = (const bf16*)(ws + WS_WTH) + (size_t)l * 48 * DM; const bf16* WL = (const bf16*)(ws + WS_WTL) + (size_t)l * 48 * DM;
    int* cnt = (int*)(ws + WS_CNT) + l * 32 * 64;
    constexpr int KH = DM / 2;
    for (int pass0 = BID; pass0 < T / 16; pass0 += 4 * NBLK) {
        const int pass = pass0 + pi * NBLK; const bool valid = pass < T / 16;
        const int tok = valid ? pass * 16 + c : 0, b = tok / SEQ;
        const float* xr = outp(a) + (size_t)tok * DM + kh * KH + 8 * h;
        const float* av = (const float*)(ws + WS_AVEC) + ((size_t)l * 2 + b) * DM + kh * KH + 8 * h;
        const float* cv = mod + ((size_t)l * 2 + b) * 6 * DM + 3 * DM + kh * KH + 8 * h;
        f32x4 acc[3] = {f4zero(), f4zero(), f4zero()}; float ss = 0.f;
#pragma unroll 1
        for (int chn = 0; chn < 2; ++chn) {
            const float* xq = outp(a) + (size_t)tok * DM + chn * CH + kh * (CH / 2) + 8 * h;
            const float* aq = (const float*)(ws + WS_AVEC) + ((size_t)l * 2 + b) * DM + chn * CH + kh * (CH / 2) + 8 * h;
            f32x4 xv[NKS][2], avv[NKS][2];
#pragma unroll
            for (int ks = 0; ks < NKS; ++ks) { xv[ks][0] = *(const f32x4*)(xq + 32 * ks); xv[ks][1] = *(const f32x4*)(xq + 32 * ks + 4); avv[ks][0] = *(const f32x4*)(aq + 32 * ks); avv[ks][1] = *(const f32x4*)(aq + 32 * ks + 4); }
            SYNC();
            for (int i = tid; i < 48 * (CH / 8); i += NT) { const int n = i / (CH / 8), k8 = (i % (CH / 8)) * 8;
                *(bf16x8*)(WHl + n * WLD + k8) = *(const bf16x8*)(WH + (size_t)n * DM + chn * CH + k8); *(bf16x8*)(WLl + n * WLD + k8) = *(const bf16x8*)(WL + (size_t)n * DM + chn * CH + k8); }
            SYNC();
            if (valid) {
                const bf16* whp = WHl + c * WLD + kh * (CH / 2) + 8 * h; const bf16* wlp = WLl + c * WLD + kh * (CH / 2) + 8 * h;
#pragma unroll
                for (int ks = 0; ks < NKS; ++ks) {
                    f32x4 u0, u1, r0, r1;
#pragma unroll
                    for (int r = 0; r < 4; ++r) { u0[r] = xv[ks][0][r] * avv[ks][0][r]; u1[r] = xv[ks][1][r] * avv[ks][1][r]; ss += xv[ks][0][r] * xv[ks][0][r] + xv[ks][1][r] * xv[ks][1][r]; }
                    const bf16x8 uh = pack8(u0, u1);
#pragma unroll
                    for (int r = 0; r < 4; ++r) { r0[r] = u0[r] - bf2f((unsigned short)uh[r]); r1[r] = u1[r] - bf2f((unsigned short)uh[4 + r]); }
                    const bf16x8 ul = pack8(r0, r1);
#pragma unroll
                    for (int nt = 0; nt < 3; ++nt) { const bf16x8 wh = *(const bf16x8*)(whp + nt * 16 * WLD + 32 * ks), wl = *(const bf16x8*)(wlp + nt * 16 * WLD + 32 * ks);
                        acc[nt] = mfma16(wh, uh, acc[nt]); acc[nt] = mfma16(wl, uh, acc[nt]); acc[nt] = mfma16(wh, ul, acc[nt]); }
                }
            }
        }
        if (valid) {
            ss += shflx(ss, 16); ss += shflx(ss, 32);
            float* lgp = lg + ((pi * 2 + kh) * 16 + c) * 48 + 4 * h;
#pragma unroll
            for (int nt = 0; nt < 3; ++nt) *(f32x4*)(lgp + 16 * nt) = acc[nt];
            if (h == 0) ssb[(pi * 2 + kh) * 16 + c] = ss;
        }
        SYNC();
        if (tid < 64) { const int p2 = tid >> 4, tk = tid & 15, pass2 = pass0 + p2 * NBLK;
            if (pass2 < T / 16) { const int tok2 = pass2 * 16 + tk, b2 = tok2 / SEQ;
                const float rs = frsq((ssb[(p2 * 2 + 0) * 16 + tk] + ssb[(p2 * 2 + 1) * 16 + tk]) * (1.0f / DM) + EPS); rsb[p2 * 16 + tk] = rs;
                const float* l0 = lg + ((p2 * 2 + 0) * 16 + tk) * 48; const float* l1 = lg + ((p2 * 2 + 1) * 16 + tk) * 48; const float* rbp = (const float*)(ws + WS_RBIAS) + ((size_t)l * 2 + b2) * 48;
                float acc[36];
#pragma unroll
                for (int n = 0; n < 36; ++n) acc[n] = rs * (l0[n] + l1[n]) + rbp[n];
                int gs = 0; float gm = acc[0];
#pragma unroll
                for (int g = 1; g < 4; ++g) if (acc[g] > gm) { gm = acc[g]; gs = g; }
                float den = 0.f;
#pragma unroll
                for (int g = 0; g < 4; ++g) den += fexp2((acc[g] - gm) * LOG2E);
                const float ggate = 1.0f / den;
                float el[8];
#pragma unroll
                for (int j = 0; j < 8; ++j) { el[j] = acc[4 + j];
#pragma unroll
                    for (int g = 1; g < 4; ++g) if (gs == g) el[j] = acc[4 + 8 * g + j]; }
                int ia = 0; float va = el[0];
#pragma unroll
                for (int j = 1; j < 8; ++j) if (el[j] > va) { va = el[j]; ia = j; }
                int ib = -1; float vb = -3e38f;
#pragma unroll
                for (int j = 0; j < 8; ++j) if (j != ia && el[j] > vb) { vb = el[j]; ib = j; }
                const float wa = 1.0f / (1.0f + fexp2((vb - va) * LOG2E)), wb = 1.0f - wa;
                const int e0 = gs * 8 + ia, e1 = gs * 8 + ib;
                const int p0 = atomic_add_i(lcnt + e0, 1), p1 = atomic_add_i(lcnt + e1, 1);
                int* ti = tinfo + tid * 4;
                ti[0] = (e0 << 14) | p0; ti[1] = (e1 << 14) | p1; ti[2] = __builtin_bit_cast(int, ggate * wa); ti[3] = __builtin_bit_cast(int, ggate * wb);
            } }
        SYNC();
        if (valid) { const float rs = rsb[pi * 16 + c]; bf16* hb = (bf16*)(ws + WS_H) + (size_t)tok * DM + kh * KH + 8 * h;
#pragma unroll 4
            for (int ks = 0; ks < KH / 32; ++ks) {
                const f32x4 x0 = *(const f32x4*)(xr + 32 * ks), x1 = *(const f32x4*)(xr + 32 * ks + 4), a0 = *(const f32x4*)(av + 32 * ks), a1 = *(const f32x4*)(av + 32 * ks + 4), c0 = *(const f32x4*)(cv + 32 * ks), c1 = *(const f32x4*)(cv + 32 * ks + 4);
                f32x4 o0, o1;
#pragma unroll
                for (int r = 0; r < 4; ++r) { o0[r] = x0[r] * rs * a0[r] + c0[r]; o1[r] = x1[r] * rs * a1[r] + c1[r]; }
                st_bf8(hb + 32 * ks, o0, o1); } }
        if (tid < 32) { const int n = lcnt[tid]; lbase[tid] = n > 0 ? atomic_add_i(cnt + tid * 64, n) : 0; lcnt[tid] = 0; }
        SYNC();
        if (tid < 64) { const int p2 = tid >> 4, pass2 = pass0 + p2 * NBLK;
            if (pass2 < T / 16) { const int tok2 = pass2 * 16 + (tid & 15); const int* ti = tinfo + tid * 4;
                const int e0 = ti[0] >> 14, e1 = ti[1] >> 14, p0 = lbase[e0] + (ti[0] & 16383), p1 = lbase[e1] + (ti[1] & 16383);
                int* list = (int*)(ws + WS_LIST); list[(size_t)e0 * T + p0] = tok2; list[(size_t)e1 * T + p1] = tok2;
                int* tie = (int*)(ws + WS_TIE) + (size_t)tok2 * 2; int* tiw = (int*)(ws + WS_TIW) + (size_t)tok2 * 2;
                tie[0] = (e0 << 14) | p0; tie[1] = (e1 << 14) | p1; tiw[0] = ti[2]; tiw[1] = ti[3]; } }
        SYNC();
    }
}

DEV int vbid() { const int g = NBLK; return (g % 8 == 0) ? (BID % 8) * (g / 8) + BID / 8 : BID; }
#ifdef EMU
#define PG8_LDS(p) (p)
#else
#define PG8_LDS(p) ((PG8_LAS unsigned char*)(p))
#endif
DEV void inproj_phase(const Args& a, unsigned char* smem, int li) {
    pg8::Gemm g{(const bf16*)(wsp(a) + WS_H), (const bf16*)(wsp(a) + WS_WIN) + (size_t)li * NIN8 * DM, T, NIN8, DM}; pg8::StaticOrder S; S.init(T, NIN8, NBLK, BID);
    EpiInProj8 E{&a, li};
    SYNC(); pg8::gemm_phase<EpiInProj8, pg8::StaticOrder, true, true>(PG8_LDS(smem), g, S, E); SYNC();
}
DEV void resid_gemm_phase(const Args& a, unsigned char* smem, const bf16* A, int K, const bf16* Bt, int l) {
    pg8::Gemm g{A, Bt, T, DM, K}; pg8::StaticOrder S; S.init(T, DM, NBLK, BID);
    EpiResid8 E{outp(a), (const float*)(wsp(a) + WS_MOD) + (size_t)l * 2 * 6 * DM + 2 * DM};
    SYNC(); pg8::gemm_phase<EpiResid8, pg8::StaticOrder, true, true>(PG8_LDS(smem), g, S, E); SYNC();
}
DEV void pw1_phase(const Args& a, unsigned char* smem, int li) {
    pg8::Gemm g{(const bf16*)(wsp(a) + WS_H), (const bf16*)(wsp(a) + WS_PW1) + (size_t)li * 2 * DM * DM, T, 2 * DM, DM}; pg8::StaticOrder S; S.init(T, 2 * DM, NBLK, BID);
    EpiGlu8 E{(bf16*)(wsp(a) + WS_GLU)};
    SYNC(); pg8::gemm_phase<EpiGlu8, pg8::StaticOrder, true, true>(PG8_LDS(smem), g, S, E); SYNC();
}
DEV void cmp_phase_items(const Args& a, unsigned char* smem, int li, int it) {
    constexpr int TMC = (NCP + 255) / 256;
    const int kv = it / (4 * TMC), bg = (it / TMC) % 4, tm = it % TMC;
    const bf16* src = (const bf16*)(wsp(a) + (kv ? WS_VCG : WS_KCG)) + (size_t)bg * SEQ * 64;
    struct AF { const bf16* base; int m0; MDEV unsigned off(int r) const { int n = m0 + r; if (n > NCMP - 1) n = NCMP - 1; return (unsigned)n * 1024u; } } af{src, tm * 256};
    EpiCmp E{&a, kv, bg, tm * 256, li};
    BClamp64 bf{INP(a, kv ? I_CWV : I_CWK) + (size_t)li * 2048 * 64};
    gemm_tile2(smem, af, bf, 64, 2048, E);
}
DEV void moe_gemm_phase(const Args& a, unsigned char* smem, int l, int mode) {
    unsigned char* ws = wsp(a); const int* cnt = (const int*)(ws + WS_CNT) + l * 32 * 64;
    int* rb = (int*)(smem + GEMM2_LDS);
    moe_bases(cnt, rb);
    const int ntile = rb[32] >> 8;
    constexpr int TN1 = 2 * FF / 128, TN2 = DM / 128;
    const int TN = mode == 0 ? TN1 : TN2;
    const int* list = (const int*)(ws + WS_LIST);
    for (int it = vbid(); it < ntile * TN; it += NBLK) {
        const int rt = it / TN, tn = it % TN; int e = 0;
#pragma unroll 1
        for (int q = 1; q < 32; ++q) if ((rb[q] >> 8) <= rt) e = q;
        const int rloc = (rt << 8) - rb[e], ce = cnt[e * 64], nvalid = (ce - rloc) < 256 ? (ce - rloc) : 256;
        if (mode == 0) {
            struct AF { const bf16* base; const int* lst; int nv; MDEV unsigned off(int r) const { const int rr = r < nv ? r : nv - 1; return (unsigned)lst[rr] * (unsigned)DM; } }
                af{(const bf16*)(ws + WS_H), list + (size_t)e * T + rloc, nvalid};
            EpiGated<1> E{(bf16*)(ws + WS_ACT), (size_t)FF, rt << 8, tn * 128, nvalid};
            BInter bf{INP(a, I_W1) + (size_t)(l * 32 + e) * DM * FF, INP(a, I_W3) + (size_t)(l * 32 + e) * DM * FF, tn * 128};
            gemm_tile2(smem, af, bf, FF, DM, E);
        } else {
            ARows af{(const bf16*)(ws + WS_ACT) + (size_t)(rt << 8) * FF, (size_t)FF};
            EpiStoreBf E{(bf16*)(ws + WS_YK), (size_t)DM, rt << 8, tn * 128, nvalid};
            BPlain bf{INP(a, I_W2) + (size_t)(l * 32 + e) * FF * DM + tn * 128};
            gemm_tile2(smem, af, bf, DM, FF, E);
        }
    }
}

constexpr int LDV = 80;
constexpr int AT_K = 0, AT_V = 2 * 64 * LDT * 2, AT_IMP = AT_V + 2 * 64 * LDV * 2, AT_SEL = AT_IMP + 8 * 8 * 128 * 4, AT_GSEL = AT_SEL + 8 * 8 * 4 * 4, AT_OUT = AT_GSEL + 8 * 2 * 4 * 4, AT_END = AT_OUT + 8 * 32 * 64 * 4;
#ifdef EMU
DEV float rexp2(float x) { return exp2f(x); }
DEV unsigned uni(unsigned x) { return x; }
#else
DEV float rexp2(float x) { return __builtin_amdgcn_exp2f(x); }
DEV unsigned uni(unsigned x) { return (unsigned)__builtin_amdgcn_readfirstlane((int)x); }
#endif
DEV int krow_lds(int kappa) { return 16 * (2 * (kappa >> 5) + ((kappa >> 2) & 1)) + 4 * ((kappa >> 3) & 3) + (kappa & 3); }
template <int MASK, bool FULL, int GM>
DEV void attn_block(const bf16* Kp, const bf16* Vp, const bf16x8 (&qf)[2][2], int j, const int (&s)[2], const bool (&selbit)[2], float C2, int h, int c,
                    f32x4 (&O)[2][4], f32x4 (&Ol)[2]) {
    f32x4 st[2][2][2];
#pragma unroll
    for (int sp = 0; sp < 2; ++sp)
#pragma unroll
        for (int u = 0; u < 2; ++u) {
#pragma unroll
            for (int G = 0; G < 2; ++G) { st[G][sp][u][0] = -C2; st[G][sp][u][1] = -C2; st[G][sp][u][2] = -C2; st[G][sp][u][3] = -C2; }
#pragma unroll
            for (int ks = 0; ks < 2; ++ks) { const bf16x8 kf = *(const bf16x8*)(Kp + (16 * (2 * sp + u) + c) * LDT + 32 * ks + 8 * h);
#pragma unroll
                for (int G = 0; G < 2; ++G) if (GM & (1 << G)) st[G][sp][u] = mfma16(kf, qf[G][ks], st[G][sp][u]); } }
#pragma unroll
    for (int G = 0; G < 2; ++G) if (GM & (1 << G))
#pragma unroll
        for (int sp = 0; sp < 2; ++sp)
#pragma unroll
            for (int u = 0; u < 2; ++u)
#pragma unroll
                for (int r = 0; r < 4; ++r) { bool ok = selbit[G];
                    if (!FULL) { const int key = 64 * j + 32 * sp + 8 * h + 4 * u + r;
                        if (MASK == 0) ok = 16 * key + 31 <= s[G]; else if (MASK == 1) ok = selbit[G] && key <= s[G]; else ok = key <= s[G] && key > s[G] - 512; }
                    st[G][sp][u][r] = ok ? rexp2(st[G][sp][u][r]) : 0.f; }
    bf16x8 pb[2][2], ones;
#pragma unroll
    for (int q = 0; q < 8; ++q) ones[q] = (short)0x3F80;
#pragma unroll
    for (int G = 0; G < 2; ++G) if (GM & (1 << G))
#pragma unroll
        for (int sp = 0; sp < 2; ++sp) { pb[G][sp] = pack8(st[G][sp][0], st[G][sp][1]); Ol[G] = mfma16(ones, pb[G][sp], Ol[G]); }
    const bf16* Vb = Vp + bperm(8 * h + (c >> 2)) * LDV + 4 * (c & 3);
#pragma unroll
    for (int et = 0; et < 4; ++et)
#pragma unroll
        for (int sp = 0; sp < 2; ++sp) { const bf16x8 vf = tr_read8(Vb + (32 * sp) * LDV + 16 * et, Vb + (32 * sp + 8) * LDV + 16 * et);
#pragma unroll
            for (int G = 0; G < 2; ++G) if (GM & (1 << G)) O[G][et] = mfma16(vf, pb[G][sp], O[G][et]); }
}

struct ImpState { float invq[2][4]; float carry[2]; float* imps; int tl, hd, l, s0, qblk; };
DEV void imp_block(const bf16* Kp, const bf16x8 (&qf)[2][2], int j, int s0, int w, float C2, int h, int c, ImpState& im) {
#pragma unroll
    for (int kt = 0; kt < 4; ++kt) {
        const int row = krow_lds(16 * kt + c);
        const bf16x8 k0 = *(const bf16x8*)(Kp + row * LDT + 8 * h), k1 = *(const bf16x8*)(Kp + row * LDT + 32 + 8 * h);
        const int n = 64 * j + 16 * kt + c;
#pragma unroll
        for (int G = 0; G < 2; ++G) {
            f32x4 acc; acc[0] = -C2; acc[1] = -C2; acc[2] = -C2; acc[3] = -C2;
            acc = mfma16(qf[G][0], k0, acc); acc = mfma16(qf[G][1], k1, acc);
            const bool ok = 16 * n + 31 <= s0 + 8 * w + 4 * G + h;
            float imp = 0.f;
#pragma unroll
            for (int r = 0; r < 4; ++r) imp += ok ? rexp2(acc[r]) * im.invq[G][r] : 0.f;
            const float v = ((c & 3) == 3) ? imp : 2.0f * imp;
            float sq = v + shflx(v, 1); sq += shflx(sq, 2);
            const float rr = dpp_ror1(imp);
            const float prev = (c == 0) ? im.carry[G] : rr;
            im.carry[G] = rr;
            const int m = n >> 2;
            if ((c & 3) == 0 && m < 128) im.imps[(G * 4 + h) * 128 + m] = sq + prev;
        }
    }
}

template <int MODE>
DEV void attn_branch(bf16* Kl, bf16* Vl, const bf16* kbase, const bf16* vbase, int jlo, int jhi,
                     const bf16x8 (&qf)[2][2], const int (&s)[2], const unsigned* selm, const unsigned* gselm, float C2, int w, int h, int c, int srow, int scol,
                     f32x4 (&O)[2][4], f32x4 (&Ol)[2], ImpState& im) {
    constexpr bool PV = MODE != 1; constexpr int MASK = MODE <= 1 ? 0 : MODE - 1;
    const int krow = krow_lds(srow) * LDT + scol, vrow = bperm(srow) * LDV + scol;
    bf16x8 rk[3], rv[3];
    { const bf16x8 k0 = *(const bf16x8*)(kbase + (size_t)jlo * 4096); *(bf16x8*)(Kl + krow) = k0;
      if (PV) { const bf16x8 v0 = *(const bf16x8*)(vbase + (size_t)jlo * 4096); *(bf16x8*)(Vl + vrow) = v0; } }
#pragma unroll
    for (int u = 0; u < 3; ++u) { int jj = jlo + 1 + u; if (jj > jhi) jj = jhi; rk[(1 + u) % 3] = *(const bf16x8*)(kbase + (size_t)jj * 4096); if (PV) rv[(1 + u) % 3] = *(const bf16x8*)(vbase + (size_t)jj * 4096); }
    SYNC();
    for (int jb = jlo; jb <= jhi; jb += 3) {
#pragma unroll
        for (int u = 0; u < 3; ++u) { const int j = jb + u;
            if (j <= jhi) {
                const int cur = (j - jlo) & 1;
                const bf16* Kc = Kl + cur * 64 * LDT; const bf16* Vc = Vl + cur * 64 * LDV;
                if (MODE == 1) imp_block(Kc, qf, j, im.s0, w, C2, h, c, im);
                else {
                    bool sb[2] = {true, true}; unsigned gm = 3u;
                    if (MODE == 2) { gm = 0u;
#pragma unroll
                        for (int G = 0; G < 2; ++G) { const unsigned wq = uni(gselm[G * 4 + (j >> 5)]), mq = selm[(G * 4 + im.tl) * 4 + (j >> 5)];
                            gm |= ((wq >> (j & 31)) & 1u) << G; sb[G] = (mq >> (j & 31)) & 1u; } }
                    bool full;
                    if (MODE == 0) full = 1024 * j + 1039 <= im.s0; else if (MODE == 2) full = j < im.qblk; else full = (j < im.qblk) && (64 * j > im.s0 + 63 - 512);
                    if (MODE == 2) {
                        if (full) { if (gm == 3u) attn_block<MASK, true, 3>(Kc, Vc, qf, j, s, sb, C2, h, c, O, Ol); else if (gm == 1u) attn_block<MASK, true, 1>(Kc, Vc, qf, j, s, sb, C2, h, c, O, Ol); else if (gm == 2u) attn_block<MASK, true, 2>(Kc, Vc, qf, j, s, sb, C2, h, c, O, Ol); }
                        else { if (gm == 3u) attn_block<MASK, false, 3>(Kc, Vc, qf, j, s, sb, C2, h, c, O, Ol); else if (gm == 1u) attn_block<MASK, false, 1>(Kc, Vc, qf, j, s, sb, C2, h, c, O, Ol); else if (gm == 2u) attn_block<MASK, false, 2>(Kc, Vc, qf, j, s, sb, C2, h, c, O, Ol); }
                    } else { if (full) attn_block<MASK, true, 3>(Kc, Vc, qf, j, s, sb, C2, h, c, O, Ol); else attn_block<MASK, false, 3>(Kc, Vc, qf, j, s, sb, C2, h, c, O, Ol); }
                }
                if (j + 1 <= jhi) {
                    *(bf16x8*)(Kl + (cur ^ 1) * 64 * LDT + krow) = rk[(u + 1) % 3]; if (PV) *(bf16x8*)(Vl + (cur ^ 1) * 64 * LDV + vrow) = rv[(u + 1) % 3];
                    int jj = j + 4; if (jj > jhi) jj = jhi;
                    rk[(u + 1) % 3] = *(const bf16x8*)(kbase + (size_t)jj * 4096); if (PV) rv[(u + 1) % 3] = *(const bf16x8*)(vbase + (size_t)jj * 4096);
                }
                SYNC();
            }
        }
    }
}

DEV void attn_task(const Args& a, unsigned char* smem, int li, int item) {
    unsigned char* ws = wsp(a); const int tid = TID, w = tid >> 6, l = tid & 63, h = l >> 4, c = l & 15, tl = c >> 2, hd = c & 3;
    const int bg = item & 3, b = bg >> 1, g = bg & 1, tq = (SEQ / 64 - 1) - (item >> 2), s0 = tq * 64, qblk = tq;
    int s[2], row[2];
#pragma unroll
    for (int G = 0; G < 2; ++G) { s[G] = s0 + 8 * w + 4 * G + tl; row[G] = b * SEQ + s[G]; }
    bf16* Kl = (bf16*)(smem + AT_K); bf16* Vl = (bf16*)(smem + AT_V); float* imps = (float*)(smem + AT_IMP) + w * 1024; unsigned* selm = (unsigned*)(smem + AT_SEL) + w * 32;
    bf16x8 qf[2][2]; float gatec[2], gates[2], gatew[2];
#pragma unroll
    for (int G = 0; G < 2; ++G) { const bf16* qp = (const bf16*)(ws + WS_QN) + (size_t)row[G] * 512 + (g * 4 + hd) * 64 + 8 * h; qf[G][0] = *(const bf16x8*)qp; qf[G][1] = *(const bf16x8*)(qp + 32);
        const float* gp = (const float*)(ws + WS_GATE) + (size_t)row[G] * 24 + (g * 4 + hd) * 3; gatec[G] = gp[0]; gates[G] = gp[1]; gatew[G] = gp[2]; }
    const float* cs = (const float*)(ws + WS_CS) + li * 4;
    const int srow = tid >> 3, scol = (tid & 7) * 8;
    for (int i = l; i < 1024; i += 64) imps[i] = 0.f;
    SYNC();
    unsigned* gselm = (unsigned*)(smem + AT_GSEL) + w * 8; float* outl = (float*)(smem + AT_OUT) + w * 2048 + l;
    ImpState im{{{0.f, 0.f, 0.f, 0.f}, {0.f, 0.f, 0.f, 0.f}}, {0.f, 0.f}, imps, tl, hd, l, s0, qblk};
    {
        const int ncv = s0 / 16 + 3, ncb0 = (ncv + 63) >> 6, ncb = ncb0 > NCP / 64 ? NCP / 64 : ncb0;
        const bf16* kcb = (const bf16*)(ws + WS_KC) + (size_t)bg * NCP * 64 + tid * 8;
        const bf16* vcb = (const bf16*)(ws + WS_VCT) + (size_t)bg * NCP * 64 + tid * 8;
        f32x4 O[2][4], Ol[2] = {f4zero(), f4zero()};
#pragma unroll
        for (int G = 0; G < 2; ++G)
#pragma unroll
            for (int et = 0; et < 4; ++et) O[G][et] = f4zero();
        attn_branch<0>(Kl, Vl, kcb, vcb, 0, ncb - 1, qf, s, selm, gselm, cs[0], w, h, c, srow, scol, O, Ol, im);
#pragma unroll
        for (int G = 0; G < 2; ++G) { const float lsum = Ol[G][0]; const float invl = lsum > 0.f ? 1.0f / lsum : 0.f;
#pragma unroll
            for (int r = 0; r < 4; ++r) im.invq[G][r] = shfl(invl, 4 * h + r);
#pragma unroll
            for (int et = 0; et < 4; ++et)
#pragma unroll
                for (int r = 0; r < 4; ++r) outl[((G * 4 + et) * 4 + r) * 64] = gatec[G] * invl * O[G][et][r]; }
        f32x4 ld[2] = {f4zero(), f4zero()};
        attn_branch<1>(Kl, Vl, kcb, vcb, 0, ncb - 1, qf, s, selm, gselm, cs[0], w, h, c, srow, scol, O, ld, im);
    }
    WSYNC();
#pragma unroll 1
    for (int G = 0; G < 2; ++G) {
        const int tk = l >> 4, i = l & 15; float vals[8];
#pragma unroll
        for (int mm = 0; mm < 8; ++mm) { const int jj = i + 16 * mm; vals[mm] = jj > qblk ? NEGV : ((jj == 0 || jj == qblk || jj == qblk - 1) ? FORCEV : imps[(G * 4 + tk) * 128 + jj]); }
        unsigned mk[4] = {0u, 0u, 0u, 0u};
#pragma unroll 1
        for (int rnd = 0; rnd < 16; ++rnd) {
            float best = vals[0]; int bj = i;
#pragma unroll
            for (int mm = 1; mm < 8; ++mm) if (vals[mm] > best) { best = vals[mm]; bj = i + 16 * mm; }
#pragma unroll
            for (int o = 1; o < 16; o <<= 1) { const float ov = shflx(best, o); const int oj = shflxi(bj, o); if (ov > best || (ov == best && oj < bj)) { best = ov; bj = oj; } }
            if (best > NEGV * 0.5f) {
#pragma unroll
                for (int q = 0; q < 4; ++q) if ((bj >> 5) == q) mk[q] |= 1u << (bj & 31); }
            if ((bj & 15) == i) {
#pragma unroll
                for (int mm = 0; mm < 8; ++mm) if ((bj >> 4) == mm) vals[mm] = -3e38f; }
        }
        if (i == 0) {
#pragma unroll
            for (int q = 0; q < 4; ++q) selm[(G * 4 + tk) * 4 + q] = mk[q]; }
    }
    WSYNC();
    if (l < 8) { const int G = l >> 2, q = l & 3; gselm[l] = selm[(G * 4 + 0) * 4 + q] | selm[(G * 4 + 1) * 4 + q] | selm[(G * 4 + 2) * 4 + q] | selm[(G * 4 + 3) * 4 + q]; }
    WSYNC();
#pragma unroll
    for (int br = 0; br < 2; ++br) {
        const bf16* kb = (const bf16*)(ws + (br == 0 ? WS_KS : WS_KW)) + (size_t)bg * SEQ * 64 + tid * 8; const bf16* vb = (const bf16*)(ws + (br == 0 ? WS_VST : WS_VWT)) + (size_t)bg * SEQ * 64 + tid * 8;
        f32x4 O[2][4], Ol[2] = {f4zero(), f4zero()};
#pragma unroll
        for (int G = 0; G < 2; ++G)
#pragma unroll
            for (int et = 0; et < 4; ++et) O[G][et] = f4zero();
        if (br == 0) attn_branch<2>(Kl, Vl, kb, vb, 0, qblk, qf, s, selm, gselm, cs[1], w, h, c, srow, scol, O, Ol, im);
        else attn_branch<3>(Kl, Vl, kb, vb, s0 >= 511 ? (s0 - 511) >> 6 : 0, qblk, qf, s, selm, gselm, cs[2], w, h, c, srow, scol, O, Ol, im);
#pragma unroll
        for (int G = 0; G < 2; ++G) { const float lsum = Ol[G][0]; const float sc = (br == 0 ? gates[G] : gatew[G]) * (lsum > 0.f ? 1.0f / lsum : 0.f);
#pragma unroll
            for (int et = 0; et < 4; ++et)
#pragma unroll
                for (int r = 0; r < 4; ++r) outl[((G * 4 + et) * 4 + r) * 64] += sc * O[G][et][r]; }
    }
#pragma unroll
    for (int G = 0; G < 2; ++G) { bf16* dst = (bf16*)(ws + WS_CAT) + (size_t)row[G] * 1024 + (g * 4 + hd) * 64 + 4 * h;
#pragma unroll
        for (int et = 0; et < 4; ++et) { f32x4 o;
#pragma unroll
            for (int r = 0; r < 4; ++r) o[r] = outl[((G * 4 + et) * 4 + r) * 64];
            st_bf4(dst + 16 * et, o); } }
}

constexpr int LDH = 136;
DEV void hg_cumsum(const float* fsrc  , float* segs  , int d, int seg, float (&f)[16], float (&bc)[16], float& bend, float& bmid) {
    float run = 0.f;
#pragma unroll
    for (int i = 0; i < 16; ++i) { f[i] = fsrc[(size_t)(16 * seg + i) * 128 + d]; run += log2f(f[i]); bc[i] = run; }
    SYNC();
    segs[seg * 128 + d] = run;
    SYNC();
    const float s0 = segs[d], s1 = segs[128 + d], s2 = segs[256 + d], s3 = segs[384 + d];
    const float off = seg == 0 ? 0.f : (seg == 1 ? s0 : (seg == 2 ? s0 + s1 : s0 + s1 + s2));
#pragma unroll
    for (int i = 0; i < 16; ++i) bc[i] += off;
    bend = s0 + s1 + s2 + s3; bmid = s0 + s1;
}
DEV void hg_write16(bf16* dstrow  , const float (&v)[16]) {
    u32x4 w0, w1;
#pragma unroll
    for (int q = 0; q < 4; ++q) { w0[q] = pk2(v[2 * q], v[2 * q + 1]); w1[q] = pk2(v[8 + 2 * q], v[8 + 2 * q + 1]); }
    *(u32x4*)dstrow = w0; *(u32x4*)(dstrow + 8) = w1;
}
DEV void hg_h1_task(const Args& a, unsigned char* smem, int task) {
    unsigned char* ws = wsp(a); const int tid = TID, w = tid >> 6, l = tid & 63, h = l >> 4, c = l & 15, d = tid & 127, seg = tid >> 7;
    const int bh = task / NCH, ch = task % NCH;
    bf16* kT = (bf16*)smem; bf16* vT = kT + 128 * LDT; float* segs = (float*)(vT + 128 * LDT);
    const size_t tokb = (size_t)bh * SEQ + ch * 64;
    float f[16], bc[16], bend, bmid;
    hg_cumsum((const float*)(ws + WS_HF) + tokb * 128, segs, d, seg, f, bc, bend, bmid);
    float kv[16];
#pragma unroll
    for (int i = 0; i < 16; ++i) kv[i] = (1.0f - f[i]) * fexp2(bend - bc[i]);
    hg_write16(kT + d * LDT + 16 * seg, kv);
    const bf16* vs = (const bf16*)(ws + WS_HV) + tokb * 128;
#pragma unroll
    for (int i = 0; i < 16; ++i) kv[i] = bf2f(vs[(size_t)(16 * seg + i) * 128 + d]);
    hg_write16(vT + d * LDT + 16 * seg, kv);
    if (seg == 0) ((float*)(ws + WS_GD))[((size_t)bh * NCH + ch) * 128 + d] = fexp2(bend);
    SYNC();
    f32x4 acc[8];
#pragma unroll
    for (int et = 0; et < 8; ++et) acc[et] = f4zero();
#pragma unroll
    for (int ks = 0; ks < 2; ++ks) { const bf16x8 fa = *(const bf16x8*)(kT + (16 * w + c) * LDT + 32 * ks + 8 * h);
#pragma unroll
        for (int et = 0; et < 8; ++et) acc[et] = mfma16(fa, *(const bf16x8*)(vT + (16 * et + c) * LDT + 32 * ks + 8 * h), acc[et]); }
    float* ut = (float*)(ws + WS_UT) + ((size_t)bh * NCH + ch) * 16384;
#pragma unroll
    for (int et = 0; et < 8; ++et) *(f32x4*)(ut + (size_t)(16 * et + c) * 128 + 16 * w + 4 * h) = acc[et];
    SYNC();
}
DEV void hg_scan_task(const Args& a, int sc) {
    unsigned char* ws = wsp(a); const int bh = sc >> 3, q = (sc & 7) * 512 + TID, e = q >> 5, d0 = (q & 31) * 4;
    const float* ut = (const float*)(ws + WS_UT) + (size_t)bh * NCH * 16384 + (size_t)e * 128 + d0;
    const float* gd = (const float*)(ws + WS_GD) + (size_t)bh * NCH * 128 + d0;
    bf16* st = (bf16*)(ws + WS_ST) + (size_t)bh * NCH * 16384 + (size_t)e * 128 + d0;
    f32x4 S = f4zero();
#pragma unroll 4
    for (int ch = 0; ch < NCH; ++ch) { st_bf4(st + (size_t)ch * 16384, S);
        const f32x4 g = *(const f32x4*)(gd + (size_t)ch * 128), u = *(const f32x4*)(ut + (size_t)ch * 16384);
#pragma unroll
        for (int r = 0; r < 4; ++r) S[r] = g[r] * S[r] + u[r]; }
}
DEV void hg_h3_task(const Args& a, unsigned char* smem, int li, int task) {
    unsigned char* ws = wsp(a); const int tid = TID, w = tid >> 6, l = tid & 63, h = l >> 4, c = l & 15, d = tid & 127, seg = tid >> 7;
    const int bh = task / NCH, ch = task % NCH, b = bh >> 2, hh = bh & 3;
    bf16* At = (bf16*)smem; bf16* Bt = At + 64 * LDH; bf16* Qt = Bt + 64 * LDH; bf16* vT = Qt + 64 * LDH; float* segs = (float*)(vT + 128 * LDT); float* part = segs + 512;
    const size_t tokb = (size_t)bh * SEQ + ch * 64;
    float f[16], bc[16], bend, bmid;
    hg_cumsum((const float*)(ws + WS_HF) + tokb * 128, segs, d, seg, f, bc, bend, bmid);
    const bf16* qs = (const bf16*)(ws + WS_HQ) + tokb * 128; const bf16* vs = (const bf16*)(ws + WS_HV) + tokb * 128;
    float vv[16];
#pragma unroll
    for (int i = 0; i < 16; ++i) { const int t = 16 * seg + i; const float q = bf2f(qs[(size_t)t * 128 + d]);
        At[t * LDH + d] = (bf16)f2bf(q * fexp2(bc[i] - bmid)); Bt[t * LDH + d] = (bf16)f2bf((1.0f - f[i]) * fexp2(bmid - bc[i])); Qt[t * LDH + d] = (bf16)f2bf(q * fexp2(bc[i]));
        vv[i] = bf2f(vs[(size_t)t * 128 + d]); }
    hg_write16(vT + d * LDT + 16 * seg, vv);
    SYNC();
    const int tt = w & 3, eh = w >> 2;
    f32x4 O[4];
#pragma unroll
    for (int et = 0; et < 4; ++et) O[et] = f4zero();
#pragma unroll
    for (int sp = 0; sp < 2; ++sp) {
        if (32 * sp > 16 * tt + 15) continue;
        f32x4 st[2];
#pragma unroll
        for (int u = 0; u < 2; ++u) { st[u] = f4zero(); const int krow = 32 * sp + 8 * (c >> 2) + 4 * u + (c & 3);
#pragma unroll
            for (int ks = 0; ks < 4; ++ks) st[u] = mfma16(*(const bf16x8*)(Bt + krow * LDH + 32 * ks + 8 * h), *(const bf16x8*)(At + (16 * tt + c) * LDH + 32 * ks + 8 * h), st[u]);
#pragma unroll
            for (int r = 0; r < 4; ++r) { const int sk = 32 * sp + 8 * h + 4 * u + r; if (sk > 16 * tt + c) st[u][r] = 0.f; } }
        const bf16x8 pb = pack8(st[0], st[1]);
#pragma unroll
        for (int et = 0; et < 4; ++et) O[et] = mfma16(*(const bf16x8*)(vT + (64 * eh + 16 * et + c) * LDT + 32 * sp + 8 * h), pb, O[et]);
    }
    const bf16* stp = (const bf16*)(ws + WS_ST) + ((size_t)bh * NCH + ch) * 16384;
#pragma unroll
    for (int ks = 0; ks < 4; ++ks) { const bf16x8 fq = *(const bf16x8*)(Qt + (16 * tt + c) * LDH + 32 * ks + 8 * h);
#pragma unroll
        for (int et = 0; et < 4; ++et) O[et] = mfma16(*(const bf16x8*)(stp + (size_t)(64 * eh + 16 * et + c) * 128 + 32 * ks + 8 * h), fq, O[et]); }
    float ss = 0.f;
#pragma unroll
    for (int et = 0; et < 4; ++et)
#pragma unroll
        for (int r = 0; r < 4; ++r) ss += O[et][r] * O[et][r];
    ss += shflx(ss, 16); ss += shflx(ss, 32);
    if (h == 0) part[eh * 64 + 16 * tt + c] = ss;
    SYNC();
    const float rs = frsq((part[16 * tt + c] + part[64 + 16 * tt + c]) * (1.0f / 128.0f) + EPS);
    const int tok = b * SEQ + ch * 64 + 16 * tt + c;
    const float* og = INP(a, I_OG) + li * 128; const bf16* hg = (const bf16*)(ws + WS_HGS) + (size_t)tok * 512 + hh * 128;
    bf16* dst = (bf16*)(ws + WS_CAT) + (size_t)tok * 1024 + 512 + hh * 128;
#pragma unroll
    for (int et = 0; et < 4; ++et) { const int e = 64 * eh + 16 * et + 4 * h; f32x4 o;
#pragma unroll
        for (int r = 0; r < 4; ++r) o[r] = O[et][r] * rs * og[e + r] * bf2f(hg[e + r]);
        st_bf4(dst + e, o); }
    SYNC();
}

DEV void conv_task(const Args& a, unsigned char* smem, int li, int task) {
    unsigned char* ws = wsp(a); const int tid = TID, w = tid >> 6, lane = tid & 63;
    const bool act = tid < DM / 2; const int c0 = act ? 2 * tid : 0;
    const int t0 = task * 16, b = t0 / SEQ, s0 = t0 % SEQ;
    float* red = (float*)smem;
    const float* dw = INP(a, I_DW) + (size_t)li * 31 * DM + c0;
    float acc[16][2];
    const float b0 = INP(a, I_DWB)[li * DM + c0], b1 = INP(a, I_DWB)[li * DM + c0 + 1];
#pragma unroll
    for (int t = 0; t < 16; ++t) { acc[t][0] = b0; acc[t][1] = b1; }
    const bf16* glu = (const bf16*)(ws + WS_GLU) + (size_t)b * SEQ * DM + c0;
    unsigned uu[46];
    { const bf16* gp = glu + (size_t)(s0 - 30) * DM;
#pragma unroll
    for (int r = 0; r < 46; ++r) { const int si = s0 + r - 30; uu[r] = si >= 0 ? *(const unsigned*)gp : 0u; gp += DM; OPAQUE(gp); } }
    const float* dwp = dw;
#pragma unroll
    for (int j = 0; j < 31; ++j) { const float w0 = dwp[0], w1 = dwp[1]; dwp += DM; OPAQUE(dwp);
#pragma unroll
        for (int t = 0; t < 16; ++t) { const unsigned q = uu[t + j]; acc[t][0] += w0 * bf2f(q & 0xffff); acc[t][1] += w1 * bf2f(q >> 16); } }
    float mean[16], rstd[16];
    SYNC();
#pragma unroll
    for (int t = 0; t < 16; ++t) { float s = act ? acc[t][0] + acc[t][1] : 0.f;
#pragma unroll
        for (int o = 1; o < 64; o <<= 1) s += shflx(s, o);
        if (lane == 0) red[w * 16 + t] = s; }
    SYNC();
#pragma unroll
    for (int t = 0; t < 16; ++t) { float s = 0.f;
#pragma unroll
        for (int q = 0; q < 8; ++q) s += red[q * 16 + t];
        mean[t] = s * (1.0f / DM); }
    SYNC();
#pragma unroll
    for (int t = 0; t < 16; ++t) { const float d0 = acc[t][0] - mean[t], d1 = acc[t][1] - mean[t]; float s = act ? d0 * d0 + d1 * d1 : 0.f;
#pragma unroll
        for (int o = 1; o < 64; o <<= 1) s += shflx(s, o);
        if (lane == 0) red[w * 16 + t] = s; }
    SYNC();
#pragma unroll
    for (int t = 0; t < 16; ++t) { float s = 0.f;
#pragma unroll
        for (int q = 0; q < 8; ++q) s += red[q * 16 + t];
        rstd[t] = frsq(s * (1.0f / DM) + EPS); }
    if (act) {
        const float g0 = INP(a, I_LNG)[li * DM + c0], g1 = INP(a, I_LNG)[li * DM + c0 + 1], e0 = INP(a, I_LNB)[li * DM + c0], e1 = INP(a, I_LNB)[li * DM + c0 + 1];
        bf16* dst = (bf16*)(ws + WS_CAT) + (size_t)t0 * DM + c0;
#pragma unroll
        for (int t = 0; t < 16; ++t) { const float y0 = (acc[t][0] - mean[t]) * rstd[t] * g0 + e0, y1 = (acc[t][1] - mean[t]) * rstd[t] * g1 + e1;
            *(unsigned*)(dst + (size_t)t * DM) = pk2(siluf(y0), siluf(y1)); }
    }
}

constexpr int N_PHASES = 1 + 16 * (DEPTH / 2) + 1;
DEV void phase_decode(int ph, int& l, int& sub) {
    const int q = ph - 1, pair = q >> 4, r = q & 15;
    if (r < 9) { l = 2 * pair; sub = r; } else { l = 2 * pair + 1; const int rr = r - 9; sub = rr < 3 ? rr : rr + 2; }
}
constexpr int LDS_BYTES = 150 * 1024;

DEV void run_phase(const Args& a, unsigned char* smem, int ph) {
#ifndef ONLY
#define ONLY -1
#endif
#define EN(k) (ONLY < 0 || ONLY == (k))
    if (ph == 0) { if (EN(100)) p0_phase(a, smem); return; }
    if (ph == N_PHASES - 1) { if (EN(0)) norm_phase(a, smem, DEPTH); return; }
    int l, sub; phase_decode(ph, l, sub); const int li = l >> 1; const bool even = (l & 1) == 0;
    unsigned char* ws = wsp(a);
    switch (sub) {
    case 0: if (EN(0)) norm_phase(a, smem, l); break;
    case 1: if (even) { if (EN(1)) inproj_phase(a, smem, li); } else { if (EN(11)) pw1_phase(a, smem, li); } break;
    case 2:
        if (even) { constexpr int NCI = 8 * ((NCP + 255) / 256); constexpr int NH1 = 8 * NCH;
            for (int it = BID; it < NCI + NH1; it += NBLK) { if (it < NCI) { if (EN(2)) cmp_phase_items(a, smem, li, it); } else { if (EN(12)) hg_h1_task(a, smem, it - NCI); } } }
        else { for (int it = BID; it < T / 16; it += NBLK) if (EN(13)) conv_task(a, smem, li, it); }
        break;
    case 3:
        if (even) { constexpr int NA = 4 * (SEQ / 64); const int G = NBLK;
            for (int r = 0; r * G < NA; ++r) { const int it = r * G + ((r & 1) ? (G - 1 - BID) : BID); if (it < NA) { if (EN(3)) attn_task(a, smem, li, it); } }
            for (int it = BID; it < 64; it += NBLK) if (EN(14)) hg_scan_task(a, it); }
        break;
    case 4: if (even) { for (int it = BID; it < 8 * NCH; it += NBLK) if (EN(4)) hg_h3_task(a, smem, li, it); } break;
    case 5:
        if (!EN(5)) break;
        if (even) resid_gemm_phase(a, smem, (const bf16*)(ws + WS_CAT), 1024, (const bf16*)(ws + WS_WOUT) + (size_t)li * DM * 1024, l);
        else resid_gemm_phase(a, smem, (const bf16*)(ws + WS_CAT), DM, (const bf16*)(ws + WS_PW2) + (size_t)li * DM * DM, l);
        break;
    case 6: if (EN(6)) route_phase(a, smem, l); break;
    case 7: if (EN(7)) moe_gemm_phase(a, smem, l, 0); break;
    case 8: if (EN(8)) moe_gemm_phase(a, smem, l, 1); break;
    }
}

#ifndef EMU
#define LAS __attribute__((address_space(3)))
#define XB_TMO      128
#define XB_XCNT(j)  (256  + 64 * (j))
#define XB_XSUB(j)  (1280 + 64 * (j))
#define XB_XGEN(j)  (2304 + 64 * (j))
#define XB_TOP      3328
#define XB_TOPGEN   3392
#define XCD_BAR_WORDS 3456
#define XB_SPIN_CAP (1u << 22)
__device__ __forceinline__ unsigned xb_ld(unsigned* p)              { return __hip_atomic_load(p, __ATOMIC_RELAXED, __HIP_MEMORY_SCOPE_AGENT); }
__device__ __forceinline__ unsigned xb_add(unsigned* p, unsigned v) { return __hip_atomic_fetch_add(p, v, __ATOMIC_RELAXED, __HIP_MEMORY_SCOPE_AGENT); }
__device__ __forceinline__ unsigned xb_xcc_id() { return (unsigned)__builtin_amdgcn_s_getreg((3 << 11) | 20) & 0xFu; }
#define XB_SPIN(cond, bar) do { unsigned _sp = 0; while (cond) { __builtin_amdgcn_s_sleep(1); \
    if ((++_sp & 255u) == 0u) { if (xb_ld(&(bar)[XB_TMO])) break; if (_sp > XB_SPIN_CAP) { atomicAdd(&(bar)[XB_TMO], 1u); break; } } } } while (0)
struct XcdBarrier { unsigned* bar; unsigned x; volatile LAS unsigned* st; };
__device__ __forceinline__ XcdBarrier xcd_barrier_post(unsigned* bar, volatile LAS unsigned* st) {
    XcdBarrier b; b.bar = bar; b.x = xb_xcc_id(); b.st = st;
    if (threadIdx.x == 0) (void)xb_add(&bar[XB_XCNT(b.x)], 1u);
    return b;
}
__device__ __forceinline__ void xcd_barrier_complete(unsigned* bar, unsigned x, unsigned& nloc, unsigned& nx) {
    const unsigned G = gridDim.x * gridDim.y * gridDim.z;
    unsigned sum, cnt, mine, sp = 0u;
    for (;;) {
        sum = 0u; cnt = 0u; mine = 0u;
#pragma unroll
        for (unsigned j = 0; j < 16; ++j) { const unsigned c = xb_ld(&bar[XB_XCNT(j)]); sum += c; cnt += (c > 0u) ? 1u : 0u; mine = (j == x) ? c : mine; }
        if (sum == G) break;
        __builtin_amdgcn_s_sleep(1);
        if ((++sp & 255u) == 0u) { if (xb_ld(&bar[XB_TMO])) break; if (sp > XB_SPIN_CAP) { atomicAdd(&bar[XB_TMO], 1u); break; } }
    }
    nloc = mine > 0u ? mine : 1u; nx = cnt > 0u ? cnt : 1u;
}
__device__ __forceinline__ void xcd_barrier(const XcdBarrier& b) {
    asm volatile("s_waitcnt vmcnt(0)" ::: "memory");
    __syncthreads();
    if (threadIdx.x == 0) {
        unsigned* bar = b.bar;
        __builtin_amdgcn_s_waitcnt(0);
        unsigned nloc = b.st[0], nx = b.st[1];
        if (nloc == 0u) { xcd_barrier_complete(bar, b.x, nloc, nx); b.st[0] = nloc; b.st[1] = nx; }
        const unsigned old = xb_add(&bar[XB_XSUB(b.x)], 1u);
        const unsigned gen = old / nloc;
        if (old + 1u == (gen + 1u) * nloc) {
            __builtin_amdgcn_fence(__ATOMIC_RELEASE, "agent");
            asm volatile("s_waitcnt vmcnt(0)" ::: "memory");
            const unsigned og = xb_add(&bar[XB_TOP], 1u);
            const unsigned tg = og / nx;
            if (og + 1u == (tg + 1u) * nx) xb_add(&bar[XB_TOPGEN], 1u);
            else XB_SPIN(xb_ld(&bar[XB_TOPGEN]) == tg, bar);
            __builtin_amdgcn_fence(__ATOMIC_ACQUIRE, "agent");
            xb_add(&bar[XB_XGEN(b.x)], 1u);
            asm volatile("s_waitcnt vmcnt(0)" ::: "memory");
        } else {
            XB_SPIN(xb_ld(&bar[XB_XGEN(b.x)]) == gen, bar);
            __builtin_amdgcn_fence(__ATOMIC_ACQUIRE, "agent");
            asm volatile("s_waitcnt vmcnt(0)" ::: "memory");
        }
    }
    __syncthreads();
}

__global__ void __launch_bounds__(NT, 2) mega(Args a) {
    extern __shared__ __attribute__((aligned(16))) unsigned char lds[];
    volatile LAS unsigned* st = (volatile LAS unsigned*)(LAS unsigned char*)(lds + LDS_BYTES - 16);
    if (threadIdx.x < 4) st[threadIdx.x] = 0u;
    __syncthreads();
    unsigned* barw = (unsigned*)(a.ws + WS_BAR);
    XcdBarrier bar = xcd_barrier_post(barw, st);
#pragma unroll 1
    for (int ph = 0; ph < N_PHASES; ++ph) {
        run_phase(a, lds, ph);
#ifdef DUP
        { int lyr = 0, sub = 100; if (ph > 0 && ph < N_PHASES - 1) phase_decode(ph, lyr, sub);
          if (sub == (DUP % 1000) && (ph == 0 || lyr == DUP / 1000) && ph < N_PHASES - 1) { xcd_barrier(bar); run_phase(a, lds, ph); } }
#endif
        if (ph + 1 < N_PHASES) xcd_barrier(bar);
    }
    if (xb_ld(&barw[XB_TMO]) != 0u) {
        const size_t gt = (size_t)blockIdx.x * NT + threadIdx.x, gs = (size_t)gridDim.x * NT;
        for (size_t i = gt; i < (size_t)T * DM; i += gs) a.out[i] = __builtin_nanf("");
    }
}

extern "C" void kernel_launch(void* const* d_in, const int* in_sizes, int n_in, void* d_out, int out_size,
                              void* d_ws, size_t ws_size, hipStream_t stream) {
    static int grid = 0;
    if (grid == 0) {
        int dev = 0, cus = 0;
        if (hipGetDevice(&dev) != hipSuccess || hipDeviceGetAttribute(&cus, hipDeviceAttributeMultiprocessorCount, dev) != hipSuccess) { grid = -1; return; }
        if (hipFuncSetAttribute((const void*)mega, hipFuncAttributeMaxDynamicSharedMemorySize, LDS_BYTES) != hipSuccess) { grid = -1; return; }
        (void)hipGetLastError();
        grid = cus;
        if (n_in != 26 || out_size != T * DM || ws_size < WS_END) { fprintf(stderr, "kernel_launch: unexpected sizes n_in %d out %d ws %zu (need %zu)\n", n_in, out_size, ws_size, (size_t)WS_END); grid = -1; return; }
    }
    if (grid < 0) return;
    (void)hipMemsetAsync((unsigned char*)d_ws + WS_BAR, 0, XCD_BAR_WORDS * 4, stream);
    Args a{};
    for (int i = 0; i < 26; ++i) a.in[i] = (const float*)d_in[i];
    a.out = (float*)d_out; a.ws = (unsigned char*)d_ws;
    hipLaunchKernelGGL(mega, dim3(grid), dim3(NT), LDS_BYTES, stream, a);
}
#endif
```

```cpp
#ifdef EMU
#include "emu.h"
#define DEV static inline
#define MDEV inline
#define OPAQUE(p)
#define OPAQUE2(a, b)
#define TID emu_tid()
#define BID (EB->bid)
#define NBLK (EB->nblk)
#define SYNC() emu_sync_block()
#define WSYNC() emu_sync_wave()
#define mfma16(a, b, c) emu_mfma16(a, b, c)
DEV float shflx(float v, int m) { return emu_shfl_f(v, (emu_tid() & 63) ^ m); }
DEV int shflxi(int v, int m) { return (int)emu_shfl_u((unsigned)v, (emu_tid() & 63) ^ m); }
DEV float shfl(float v, int s) { return emu_shfl_f(v, s); }
DEV float dpp_ror1(float v) { const int l = emu_tid() & 63; return emu_shfl_f(v, (l & 48) | ((l - 1) & 15)); }
DEV int atomic_add_i(int* p, int v) { return __atomic_fetch_add(p, v, __ATOMIC_RELAXED); }
DEV float fexp2(float x) { return exp2f(x); }
DEV float frcp(float x) { return 1.0f / x; }
DEV float frsq(float x) { return 1.0f / sqrtf(x); }
typedef short s16x4 __attribute__((vector_size(8)));
static inline s16x4 emu_tr4(const unsigned short* p) {
    EmuWave& w = EB->wave[emu_tid() >> 6]; int l = emu_tid() & 63;
    const unsigned short** tab = (const unsigned short**)w.a;
    tab[l] = p; emu_sync_wave();
    s16x4 r; int g = l & 48, i = l & 15;
    for (int q = 0; q < 4; ++q) r[q] = (short)tab[g + 4 * q + (i >> 2)][i & 3];
    emu_sync_wave(); return r;
}
#define tr4(p) emu_tr4(p)
#else
#include <hip/hip_runtime.h>
#include <cstdio>
#include <cstdint>
typedef short bf16x8 __attribute__((ext_vector_type(8)));
typedef float f32x4 __attribute__((ext_vector_type(4)));
typedef unsigned u32x4 __attribute__((ext_vector_type(4)));
typedef unsigned u32x2 __attribute__((ext_vector_type(2)));
#define DEV __device__ __forceinline__
#define MDEV __device__ __forceinline__
#define OPAQUE(p) asm volatile("" : "+v"(p))
#define OPAQUE2(a, b) asm volatile("" : "+v"(a), "+v"(b))
DEV int tid_opaque() { int t = (int)threadIdx.x; asm volatile("" : "+v"(t)); return t; }
#define TID tid_opaque()
DEV int bid_opaque() { int b = (int)blockIdx.x; asm volatile("" : "+s"(b)); return b; }
#define BID bid_opaque()
#define NBLK ((int)gridDim.x)
#define SYNC() __syncthreads()
#define WSYNC() __builtin_amdgcn_wave_barrier()
#define mfma16(a, b, c) __builtin_amdgcn_mfma_f32_16x16x32_bf16(a, b, c, 0, 0, 0)
DEV int shflxi(int x, int m) {
    if (m == 1) return __builtin_amdgcn_update_dpp(x, x, 0xB1, 0xf, 0xf, true);
    if (m == 2) return __builtin_amdgcn_update_dpp(x, x, 0x4E, 0xf, 0xf, true);
    if (m == 4) return __builtin_amdgcn_ds_swizzle(x, (4 << 10) | 0x1F);
    if (m == 8) return __builtin_amdgcn_ds_swizzle(x, (8 << 10) | 0x1F);
    if (m == 16) return __builtin_amdgcn_ds_swizzle(x, (16 << 10) | 0x1F);
    if (m == 32) { const auto r = __builtin_amdgcn_permlane32_swap((unsigned)x, (unsigned)x, false, false); return (int)((threadIdx.x & 32) ? r[0] : r[1]); }
    return __shfl_xor(x, m);
}
DEV float shflx(float v, int m) { return __builtin_bit_cast(float, shflxi(__builtin_bit_cast(int, v), m)); }
DEV float dpp_ror1(float v) { return __builtin_bit_cast(float, __builtin_amdgcn_update_dpp(0, __builtin_bit_cast(int, v), 0x121, 0xf, 0xf, false)); }
DEV float shfl(float v, int s) { return __shfl(v, s); }
DEV int atomic_add_i(int* p, int v) { return atomicAdd(p, v); }
DEV float fexp2(float x) { return __builtin_amdgcn_exp2f(x); }
DEV float frcp(float x) { return __builtin_amdgcn_rcpf(x); }
DEV float frsq(float x) { return __builtin_amdgcn_rsqf(x); }
typedef short s16x4 __attribute__((ext_vector_type(4)));
#define tr4(p) __builtin_amdgcn_ds_read_tr16_b64_v4i16((__attribute__((address_space(3))) s16x4*)(p))
#endif

typedef unsigned short bf16;

#ifndef DM
#define DM 1024
#endif
#ifndef SEQ
#define SEQ 8192
#endif
#ifndef FF
#define FF 512
#endif
constexpr int NBATCH = 2, T = NBATCH * SEQ, DEPTH = 4;
constexpr int NIN = 3352, NINP = 3456, NIN8 = 3584;
constexpr int NT = 512;
constexpr int NCH = SEQ / 64;
constexpr int NCP = SEQ / 16;
constexpr int NCMP = NCP - 1;
constexpr int MOE_ROWS = 2 * T + 32 * 256;
constexpr float EPS = 1e-6f, NEGV = -1e30f, FORCEV = 1e4f, LOG2E = 1.4426950408889634f;

constexpr size_t al(size_t x) { return (x + 255) & ~(size_t)255; }
constexpr size_t WS_BAR = 0;
constexpr size_t WS_CNT = 16384;
constexpr size_t WS_MOD = WS_CNT + (size_t)DEPTH * 32 * 256;
constexpr size_t WS_LB = al(WS_MOD + (size_t)DEPTH * 2 * 6 * DM * 4);
constexpr size_t WS_CB = al(WS_LB + 2 * 512 * 4);
constexpr size_t WS_CS = al(WS_CB + 2 * 2 * 8 * 64 * 4);
constexpr size_t WS_WIN = al(WS_CS + 64);
constexpr size_t WS_WOUT = al(WS_WIN + (size_t)2 * NIN8 * DM * 2);
constexpr size_t WS_PW1 = al(WS_WOUT + (size_t)2 * DM * 1024 * 2);
constexpr size_t WS_PW2 = al(WS_PW1 + (size_t)2 * 2 * DM * DM * 2);
constexpr size_t WS_WC = al(WS_PW2 + (size_t)2 * DM * DM * 2);
constexpr size_t WS_W13 = al(WS_WC + (size_t)2 * 2 * 64 * 2048 * 2);
constexpr size_t WS_W2 = al(WS_W13 + 256);
constexpr size_t WS_H = al(WS_W2 + 256);
constexpr size_t WS_QN = al(WS_H + (size_t)T * DM * 2);
constexpr size_t WS_KCG = al(WS_QN + (size_t)T * 512 * 2);
constexpr size_t WS_VCG = al(WS_KCG + (size_t)T * 128 * 2);
constexpr size_t WS_KS = al(WS_VCG + (size_t)T * 128 * 2);
constexpr size_t WS_KW = al(WS_KS + (size_t)T * 128 * 2);
constexpr size_t WS_VST = al(WS_KW + (size_t)T * 128 * 2);
constexpr size_t WS_VWT = al(WS_VST + (size_t)T * 128 * 2);
constexpr size_t WS_KC = al(WS_VWT + (size_t)T * 128 * 2);
constexpr size_t WS_VCT = al(WS_KC + (size_t)4 * NCP * 64 * 2);
constexpr size_t WS_GATE = al(WS_VCT + (size_t)4 * NCP * 64 * 2);
constexpr size_t WS_HQ = al(WS_GATE + (size_t)T * 24 * 4);
constexpr size_t WS_HF = al(WS_HQ + (size_t)T * 512 * 2);
constexpr size_t WS_HV = al(WS_HF + (size_t)T * 512 * 4);
constexpr size_t WS_HGS = al(WS_HV + (size_t)T * 512 * 2);
constexpr size_t WS_UT = al(WS_HGS + (size_t)T * 512 * 2);
constexpr size_t WS_ST = al(WS_UT + (size_t)8 * NCH * 128 * 128 * 4);
constexpr size_t WS_GD = al(WS_ST + (size_t)8 * NCH * 128 * 128 * 2);
constexpr size_t WS_CAT = al(WS_GD + (size_t)8 * NCH * 128 * 4);
constexpr size_t WS_GLU = al(WS_CAT + (size_t)T * 1024 * 2);
constexpr size_t WS_TIE = al(WS_GLU + (size_t)T * DM * 2);
constexpr size_t WS_TIW = al(WS_TIE + (size_t)T * 2 * 4);
constexpr size_t WS_LIST = al(WS_TIW + (size_t)T * 2 * 4);
constexpr size_t WS_ACT = al(WS_LIST + (size_t)32 * T * 4);
constexpr size_t WS_YK = al(WS_ACT + (size_t)MOE_ROWS * FF * 2);
constexpr size_t WS_WTH = al(WS_YK + (size_t)MOE_ROWS * DM * 2);
constexpr size_t WS_WTL = al(WS_WTH + (size_t)DEPTH * 48 * DM * 2);
constexpr size_t WS_AVEC = al(WS_WTL + (size_t)DEPTH * 48 * DM * 2);
constexpr size_t WS_RBIAS = al(WS_AVEC + (size_t)DEPTH * 2 * DM * 4);
constexpr size_t WS_END = al(WS_RBIAS + (size_t)DEPTH * 2 * 48 * 4);

struct Args { const float* in[26]; float* out; unsigned char* ws; };
enum { I_X = 0, I_C, I_ADAW, I_ADAB, I_NMIX, I_NFFN, I_WIN, I_WOUT, I_CWK, I_CWV, I_CPE, I_QG, I_KG, I_LBL, I_OG,
       I_PW1, I_DW, I_DWB, I_LNG, I_LNB, I_PW2, I_WG, I_WE, I_W1, I_W3, I_W2 };

#ifdef EMU
DEV unsigned char* wsp(const Args& a) { return a.ws; }
DEV float* outp(const Args& a) { return a.out; }
#else
DEV unsigned char* launder_ptr(const void* p) { unsigned long long v = (unsigned long long)p; unsigned lo = (unsigned)v, hi = (unsigned)(v >> 32);
    lo = (unsigned)__builtin_amdgcn_readfirstlane((int)lo); hi = (unsigned)__builtin_amdgcn_readfirstlane((int)hi); asm volatile("" : "+s"(lo), "+s"(hi)); typedef __attribute__((address_space(1))) unsigned char* gptr_t; return (unsigned char*)(gptr_t)(((unsigned long long)hi << 32) | lo); }
DEV unsigned char* wsp(const Args& a) { return launder_ptr(a.ws); }
DEV float* outp(const Args& a) { return (float*)launder_ptr(a.out); }
#endif

#ifdef EMU
#define INP(a, X) ((a).in[X])
#else
DEV int zero_opaque() { int z = 0; asm volatile("" : "+s"(z)); return z; }
#define INP(a, X) ((a).in[(X) + zero_opaque()])
#endif

DEV unsigned f2bf(float f) { unsigned u = __builtin_bit_cast(unsigned, f); return (u + 0x7fffu + ((u >> 16) & 1u)) >> 16; }
DEV float bf2f(unsigned h) { return __builtin_bit_cast(float, h << 16); }
#ifdef EMU
DEV unsigned pk2(float lo, float hi) { return f2bf(lo) | (f2bf(hi) << 16); }
#else
typedef float f32x2_t __attribute__((ext_vector_type(2)));
typedef __bf16 bf16x2_t __attribute__((ext_vector_type(2)));
DEV unsigned pk2(float lo, float hi) { f32x2_t v = {lo, hi}; bf16x2_t b = __builtin_convertvector(v, bf16x2_t); return __builtin_bit_cast(unsigned, b); }
#endif
DEV float sigm(float x) { return frcp(1.0f + fexp2(-x * LOG2E)); }
DEV float siluf(float x) { return x * sigm(x); }
DEV f32x4 f4zero() { f32x4 z = {0.f, 0.f, 0.f, 0.f}; return z; }
DEV bf16x8 pack8(f32x4 a, f32x4 b) {
    u32x4 w; w[0] = pk2(a[0], a[1]); w[1] = pk2(a[2], a[3]); w[2] = pk2(b[0], b[1]); w[3] = pk2(b[2], b[3]);
    return __builtin_bit_cast(bf16x8, w);
}
DEV void st_bf8(bf16* p, f32x4 a, f32x4 b) { u32x4 w; w[0] = pk2(a[0], a[1]); w[1] = pk2(a[2], a[3]); w[2] = pk2(b[0], b[1]); w[3] = pk2(b[2], b[3]); *(u32x4*)p = w; }
DEV void st_bf4(bf16* p, f32x4 v) { u32x2 w; w[0] = pk2(v[0], v[1]); w[1] = pk2(v[2], v[3]); *(u32x2*)p = w; }


#ifdef EMU
namespace pg8 {
constexpr int BM = 256, BK = 64, HALF = 128, NXCD = 8, WGM = 8;
typedef unsigned short bf16_t;
struct Unit { int pm, pn; };
struct Gemm { const bf16_t* A; const bf16_t* Bt; int M, N, K; };
struct StaticOrder {
    int nM, nN, nwg, G, c;
    void init(int M, int N, int G_, int c_) { nM = M / BM; nN = N / BM; nwg = nM * nN; G = G_; c = c_; }
    bool next(int i, Unit& u) const {
        const long L = (long)i * G + c; if (L >= nwg) return false;
        int wgid = (int)L; { const int q = nwg / NXCD, r = nwg % NXCD, xcd = wgid % NXCD, off = wgid / NXCD; wgid = (xcd < r ? xcd * (q + 1) : r * (q + 1) + (xcd - r) * q) + off; }
        const int nig = WGM * nN, gid = wgid / nig, fm = gid * WGM, gsz = (nM - fm) < WGM ? (nM - fm) : WGM;
        u.pm = fm + ((wgid % nig) % gsz); u.pn = (wgid % nig) / gsz; return true;
    }
};
template <class Epi, class Sched, bool ALIGN_EPI = false, bool SP2 = false>
static inline void gemm_phase(unsigned char*, const Gemm g, const Sched& S, const Epi& E) {
    const int tid = emu_tid(), wid = tid >> 6, lane = tid & 63, wr = wid >> 2, wc = wid & 3, fr = lane & 15, fq = lane >> 4;
    Unit u;
    for (int ui = 0; S.next(ui, u); ++ui) {
        f32x4 acc[2][2][4][2];
        for (int ai = 0; ai < 2; ++ai) for (int bj = 0; bj < 2; ++bj) for (int m = 0; m < 4; ++m) for (int n = 0; n < 2; ++n) for (int r = 0; r < 4; ++r) {
            const int row = 256 * u.pm + 128 * ai + 64 * wr + 16 * m + fr, col = 256 * u.pn + 128 * bj + 32 * wc + (Epi::PERM ? 8 * fq + 4 * n + r : 16 * n + 4 * fq + r); float sum = 0.f;
            const bf16_t* ap = g.A + (size_t)row * g.K; const bf16_t* bp = g.Bt + (size_t)col * g.K;
            for (int k = 0; k < g.K; ++k) sum += bf2f(ap[k]) * bf2f(bp[k]);
            acc[ai][bj][m][n][r] = sum; }
        E(acc, u, wr, wc, fr, fq);
    }
    emu_sync_block();
}
}
#else
namespace pg8 {
#define PG8_LAS __attribute__((address_space(3)))
typedef unsigned short bf16_t;
typedef short bf16x8 __attribute__((ext_vector_type(8)));
typedef float f32x4 __attribute__((ext_vector_type(4)));
typedef unsigned u32x4 __attribute__((ext_vector_type(4)));
constexpr int BM = 256, BK = 64, HALF = 128, HTB = HALF * BK * 2  , STAGE_BYTES = 8 * HTB, NXCD = 8, WGM = 8;

__host__ __device__ __forceinline__ int lds_byte(int r, int c) { const int st = (r >> 4) * 2 + (c >> 5), rr = r & 15, cc = c & 31, ob = rr * 64 + cc * 2; return st * 1024 + (ob ^ (((ob >> 9) & 1) << 5)); }
__host__ __device__ __forceinline__ void stage_rc(int b, int& R, int& C) { const int st = b / 1024, sb = b % 1024, swz = sb ^ (((sb >> 9) & 1) << 5); R = (st >> 1) * 16 + swz / 64; C = (st & 1) * 32 + (swz % 64) / 2; }
__host__ __device__ __forceinline__ int perm32(int rho) { const int n = rho >> 4, i = rho & 15; return 8 * (i >> 2) + 4 * n + (i & 3); }

struct Unit { int pm, pn; };
struct Gemm { const bf16_t* A; const bf16_t* Bt; int M, N, K; };

struct StaticOrder {
    int nM, nN, nwg, G, c;
    __host__ __device__ void init(int M, int N, int G_, int c_) { nM = M / BM; nN = N / BM; nwg = nM * nN; G = G_; c = c_; }
    __host__ __device__ bool next(int i, Unit& u) const {
        const long L = (long)i * G + c; if (L >= nwg) return false;
        int wgid = (int)L; { const int q = nwg / NXCD, r = nwg % NXCD, xcd = wgid % NXCD, off = wgid / NXCD; wgid = (xcd < r ? xcd * (q + 1) : r * (q + 1) + (xcd - r) * q) + off; }
        const int nig = WGM * nN, gid = wgid / nig, fm = gid * WGM, gsz = (nM - fm) < WGM ? (nM - fm) : WGM;
        u.pm = fm + ((wgid % nig) % gsz); u.pn = (wgid % nig) / gsz; return true;
    }
    __device__ __forceinline__ void a_ready(const Unit&) const {}
    __device__ __forceinline__ void done(const Unit&) const {}
};

__device__ __forceinline__ unsigned cvt_pk_bf16(float lo, float hi) { unsigned r; asm volatile("v_cvt_pk_bf16_f32 %0, %1, %2" : "=v"(r) : "v"(lo), "v"(hi)); return r; }
template <class Epi, class Sched, bool ALIGN_EPI = false, bool SP2 = false>
__device__ __forceinline__ void gemm_phase(PG8_LAS unsigned char* lds, const Gemm g, const Sched& S, const Epi& E) {
    const int tid = TID, wid = __builtin_amdgcn_readfirstlane(tid >> 6), lane = tid & 63, wr = wid >> 2, wc = wid & 3, fr = lane & 15, fq = lane >> 4;
    const int K = g.K, nt = K / BK;
    unsigned voffA[2], voffB[2];
#pragma unroll
    for (int i = 0; i < 2; ++i) { int R, C; stage_rc(tid * 16 + i * 8192, R, C); const int Rb = Epi::PERM ? ((R & ~31) + perm32(R & 31)) : R;
        voffA[i] = (unsigned)(R * K + C) * 2u; voffB[i] = (unsigned)(Rb * K + C) * 2u; }
    const size_t kstep = (size_t)(BK * 2);
    const size_t hstep = (size_t)HALF * K * 2;
    const size_t tstep = 2 * hstep;
    const unsigned ldsw = (unsigned)wid * 1024u;
    const int aoff = lds_byte(wr * 64 + fr, fq * 8), boff = lds_byte(wc * 32 + fr, fq * 8);
#define PG8_SA(b, h) (((b) * 2 + (h)) * HTB)
#define PG8_SB(b, h) ((4 + (b) * 2 + (h)) * HTB)
#define PG8_STAGE(bufoff, gbase, voff) do { _Pragma("unroll") for (int _i = 0; _i < 2; ++_i) \
        __builtin_amdgcn_global_load_lds((const unsigned*)((const char*)(gbase) + (voff)[_i]), (PG8_LAS unsigned*)(lds + (bufoff) + ldsw + _i * 8192), 16, 0, 0); } while (0)
#define PG8_LDA(dst, b, h) do { _Pragma("unroll") for (int m = 0; m < 4; ++m) _Pragma("unroll") for (int k = 0; k < 2; ++k) dst[m][k] = *(const PG8_LAS bf16x8*)(lds + PG8_SA(b, h) + aoff + m * 2048 + k * 1024); } while (0)
#define PG8_LDB(dst, b, h) do { _Pragma("unroll") for (int n = 0; n < 2; ++n) _Pragma("unroll") for (int k = 0; k < 2; ++k) dst[n][k] = *(const PG8_LAS bf16x8*)(lds + PG8_SB(b, h) + boff + n * 2048 + k * 1024); } while (0)
#define PG8_MMA(ai, bj, At, Bt) do { __builtin_amdgcn_s_setprio(1); _Pragma("unroll") for (int m = 0; m < 4; ++m) _Pragma("unroll") for (int n = 0; n < 2; ++n) _Pragma("unroll") for (int k = 0; k < 2; ++k) \
        acc[ai][bj][m][n] = __builtin_amdgcn_mfma_f32_16x16x32_bf16(Bt[n][k], At[m][k], acc[ai][bj][m][n], 0, 0, 0); __builtin_amdgcn_s_setprio(0); } while (0)
#define PG8_WAIT_V(n) asm volatile("s_waitcnt vmcnt(" #n ")" ::: "memory")
#define PG8_WAIT_L(n) asm volatile("s_waitcnt lgkmcnt(" #n ")" ::: "memory")
#define PG8_BAR __builtin_amdgcn_s_barrier()
#define PG8_SCHED __builtin_amdgcn_sched_barrier(0)
    Unit cur, nxt; int ui = 0;
    if (!S.next(0, cur)) return;
    f32x4 acc[2][2][4][2];
#pragma unroll
    for (int a = 0; a < 2; ++a)
#pragma unroll
        for (int b = 0; b < 2; ++b)
#pragma unroll
            for (int m = 0; m < 4; ++m)
#pragma unroll
                for (int n = 0; n < 2; ++n) acc[a][b][m][n] = (f32x4){0.f, 0.f, 0.f, 0.f};
    bf16x8 At[4][2], B0[2][2], B1[2][2];
    const char* cA = (const char*)g.A + (size_t)cur.pm * tstep; const char* cB = (const char*)g.Bt + (size_t)cur.pn * tstep;
    S.a_ready(cur);
    if constexpr (SP2) {
        PG8_STAGE(PG8_SB(0, 0), cB, voffB); PG8_STAGE(PG8_SB(0, 1), cB + hstep, voffB); PG8_STAGE(PG8_SA(0, 0), cA, voffA); PG8_STAGE(PG8_SA(0, 1), cA + hstep, voffA);
        if (wr == 1) PG8_BAR;
        PG8_WAIT_V(2); PG8_BAR;
        PG8_STAGE(PG8_SB(1, 0), cB + kstep, voffB); PG8_STAGE(PG8_SA(1, 0), cA + kstep, voffA); PG8_STAGE(PG8_SB(1, 1), cB + hstep + kstep, voffB);
        PG8_WAIT_V(6); PG8_BAR;
    } else {
        PG8_STAGE(PG8_SB(0, 0), cB, voffB); PG8_STAGE(PG8_SA(0, 0), cA, voffA); PG8_STAGE(PG8_SB(0, 1), cB + hstep, voffB); PG8_STAGE(PG8_SA(0, 1), cA + hstep, voffA);
        if (wr == 1) PG8_BAR;
        PG8_WAIT_V(4); PG8_BAR;
        PG8_STAGE(PG8_SB(1, 0), cB + kstep, voffB); PG8_STAGE(PG8_SA(1, 0), cA + kstep, voffA); PG8_STAGE(PG8_SB(1, 1), cB + hstep + kstep, voffB);
        PG8_WAIT_V(6); PG8_BAR;
    }
    for (;;) {
        const bool has_next = S.next(ui + 1, nxt);
        const char* nA = has_next ? (const char*)g.A + (size_t)nxt.pm * tstep : cA; const char* nB = has_next ? (const char*)g.Bt + (size_t)nxt.pn * tstep : cB;
        for (int t = 0; t < nt; t += 2) {
            const bool last = (t == nt - 2);
            const char* a1 = cA + (size_t)(t + 1) * kstep;
            const char* a2 = last ? nA : cA + (size_t)(t + 2) * kstep; const char* b2 = last ? nB : cB + (size_t)(t + 2) * kstep;
            const char* a3 = a2 + kstep; const char* b3 = b2 + kstep;
            if (last && has_next) S.a_ready(nxt);
            if constexpr (SP2) {
            PG8_LDB(B0, 0, 0); PG8_LDB(B1, 0, 1); PG8_SCHED; PG8_LDA(At, 0, 0); PG8_STAGE(PG8_SA(1, 1), a1 + hstep, voffA);
            PG8_WAIT_V(8); PG8_WAIT_L(0); PG8_BAR; PG8_MMA(0, 0, At, B0); PG8_MMA(0, 1, At, B1); PG8_BAR; PG8_SCHED;
            PG8_LDA(At, 0, 1); PG8_STAGE(PG8_SB(0, 0), b2, voffB); PG8_STAGE(PG8_SB(0, 1), b2 + hstep, voffB); PG8_STAGE(PG8_SA(0, 0), a2, voffA);
            PG8_WAIT_V(8); PG8_WAIT_L(0); PG8_BAR; PG8_MMA(1, 0, At, B0); PG8_MMA(1, 1, At, B1); PG8_BAR; PG8_SCHED;
            PG8_LDB(B0, 1, 0); PG8_LDB(B1, 1, 1); PG8_SCHED; PG8_LDA(At, 1, 0); PG8_STAGE(PG8_SA(0, 1), a2 + hstep, voffA);
            PG8_WAIT_V(8); PG8_WAIT_L(0); PG8_BAR; PG8_MMA(0, 0, At, B0); PG8_MMA(0, 1, At, B1); PG8_BAR; PG8_SCHED;
            PG8_LDA(At, 1, 1); PG8_STAGE(PG8_SB(1, 0), b3, voffB); PG8_STAGE(PG8_SB(1, 1), b3 + hstep, voffB); PG8_STAGE(PG8_SA(1, 0), a3, voffA);
            PG8_WAIT_V(8); PG8_WAIT_L(0); PG8_BAR; PG8_MMA(1, 0, At, B0); PG8_MMA(1, 1, At, B1); PG8_BAR; PG8_SCHED;
            } else {
            PG8_LDB(B0, 0, 0); PG8_SCHED; PG8_LDA(At, 0, 0); PG8_STAGE(PG8_SA(1, 1), a1 + hstep, voffA);
            PG8_WAIT_L(8); PG8_BAR; PG8_WAIT_L(0); PG8_MMA(0, 0, At, B0); PG8_BAR; PG8_SCHED;
            PG8_LDB(B1, 0, 1); PG8_STAGE(PG8_SB(0, 0), b2, voffB);
            PG8_BAR; PG8_WAIT_L(0); PG8_MMA(0, 1, At, B1); PG8_BAR;
            PG8_LDA(At, 0, 1); PG8_STAGE(PG8_SA(0, 0), a2, voffA);
            PG8_BAR; PG8_WAIT_L(0); PG8_MMA(1, 0, At, B0); PG8_BAR; PG8_SCHED;
            PG8_STAGE(PG8_SB(0, 1), b2 + hstep, voffB);
            PG8_WAIT_V(6); PG8_BAR; PG8_MMA(1, 1, At, B1); PG8_BAR;
            PG8_LDB(B0, 1, 0); PG8_SCHED; PG8_LDA(At, 1, 0); PG8_STAGE(PG8_SA(0, 1), a2 + hstep, voffA);
            PG8_WAIT_L(8); PG8_BAR; PG8_WAIT_L(0); PG8_MMA(0, 0, At, B0); PG8_BAR; PG8_SCHED;
            PG8_LDB(B1, 1, 1); PG8_STAGE(PG8_SB(1, 0), b3, voffB);
            PG8_BAR; PG8_WAIT_L(0); PG8_MMA(0, 1, At, B1); PG8_BAR;
            PG8_LDA(At, 1, 1); PG8_STAGE(PG8_SA(1, 0), a3, voffA);
            PG8_BAR; PG8_WAIT_L(0); PG8_MMA(1, 0, At, B0); PG8_BAR; PG8_SCHED;
            PG8_STAGE(PG8_SB(1, 1), b3 + hstep, voffB);
            PG8_WAIT_V(6); PG8_BAR; PG8_MMA(1, 1, At, B1); PG8_BAR;
            }
        }
        if constexpr (ALIGN_EPI) { if (wr == 0) PG8_BAR; }
        if constexpr (!Epi::AFTER_DRAIN) { E(acc, cur, wr, wc, fr, fq); S.done(cur); }
        if (!has_next) break;
#pragma unroll
        for (int a = 0; a < 2; ++a)
#pragma unroll
            for (int b = 0; b < 2; ++b)
#pragma unroll
                for (int m = 0; m < 4; ++m)
#pragma unroll
                    for (int n = 0; n < 2; ++n) acc[a][b][m][n] = (f32x4){0.f, 0.f, 0.f, 0.f};
        cur = nxt; cA = nA; cB = nB; ++ui;
        if constexpr (ALIGN_EPI) { if (wr == 1) PG8_BAR; }
    }
    PG8_WAIT_V(0);
    if constexpr (!ALIGN_EPI) { if (wr == 0) PG8_BAR; }
    PG8_BAR;
    if constexpr (Epi::AFTER_DRAIN) { E.fused(acc, cur, wr, wc, fr, fq, lds, wid, lane); S.done(cur); }
#undef PG8_SA
#undef PG8_SB
#undef PG8_STAGE
#undef PG8_LDA
#undef PG8_LDB
#undef PG8_MMA
#undef PG8_WAIT_V
#undef PG8_WAIT_L
#undef PG8_BAR
#undef PG8_SCHED
}
}
#endif

constexpr int LDT = 72;
constexpr int GEMM_AS = 256 * LDT, GEMM_BS = 128 * LDT;
constexpr int GEMM_LDS = 2 * (GEMM_AS + GEMM_BS) * 2;

template <class AF, class EPI>
DEV void gemm_tile(unsigned char* smem, AF af, const bf16* Bt, int ldb, int nvalid, int K, EPI& epi) {
    const int tid = TID, w = tid >> 6, l = tid & 63, h = l >> 4, c = l & 15, wm = w >> 1, wn = w & 1;
    bf16* As = (bf16*)smem; bf16* Bs = As + 2 * GEMM_AS;
    const bf16* ap[4]; const bf16* bp[2];
    const int col8 = (tid & 7) * 8, r0 = tid >> 3;
#pragma unroll
    for (int i = 0; i < 4; ++i) ap[i] = af(r0 + 64 * i) + col8;
#pragma unroll
    for (int i = 0; i < 2; ++i) { int rn = r0 + 64 * i; if (rn >= nvalid) rn = nvalid - 1; bp[i] = Bt + (size_t)rn * ldb + col8; }
    f32x4 acc[4][4];
#pragma unroll
    for (int i = 0; i < 4; ++i)
#pragma unroll
        for (int j = 0; j < 4; ++j) acc[i][j] = f4zero();
    bf16x8 ra[4], rb[2];
#pragma unroll
    for (int i = 0; i < 4; ++i) ra[i] = *(const bf16x8*)(ap[i]);
#pragma unroll
    for (int i = 0; i < 2; ++i) rb[i] = *(const bf16x8*)(bp[i]);
    SYNC();
#pragma unroll
    for (int i = 0; i < 4; ++i) *(bf16x8*)(As + (r0 + 64 * i) * LDT + col8) = ra[i];
#pragma unroll
    for (int i = 0; i < 2; ++i) *(bf16x8*)(Bs + (r0 + 64 * i) * LDT + col8) = rb[i];
    SYNC();
    const int nk = K / 64;
    for (int kt = 0; kt < nk; ++kt) {
        const int cur = kt & 1;
        if (kt + 1 < nk) {
#pragma unroll
            for (int i = 0; i < 4; ++i) ra[i] = *(const bf16x8*)(ap[i] + (kt + 1) * 64);
#pragma unroll
            for (int i = 0; i < 2; ++i) rb[i] = *(const bf16x8*)(bp[i] + (kt + 1) * 64);
        }
        const bf16* Ac = As + cur * GEMM_AS + (wm * 64 + c) * LDT + 8 * h;
        const bf16* Bc = Bs + cur * GEMM_BS + (wn * 64 + c) * LDT + 8 * h;
#pragma unroll
        for (int kk = 0; kk < 2; ++kk) {
            bf16x8 fa[4], fb[4];
#pragma unroll
            for (int i = 0; i < 4; ++i) { fa[i] = *(const bf16x8*)(Ac + i * 16 * LDT + kk * 32); fb[i] = *(const bf16x8*)(Bc + i * 16 * LDT + kk * 32); }
#pragma unroll
            for (int ni = 0; ni < 4; ++ni)
#pragma unroll
                for (int mi = 0; mi < 4; ++mi) acc[ni][mi] = mfma16(fb[ni], fa[mi], acc[ni][mi]);
        }
        if (kt + 1 < nk) {
            const int nx = cur ^ 1;
#pragma unroll
            for (int i = 0; i < 4; ++i) *(bf16x8*)(As + nx * GEMM_AS + (r0 + 64 * i) * LDT + col8) = ra[i];
#pragma unroll
            for (int i = 0; i < 2; ++i) *(bf16x8*)(Bs + nx * GEMM_BS + (r0 + 64 * i) * LDT + col8) = rb[i];
        }
        SYNC();
    }
    epi(acc, wm * 64, wn * 64, h, c);
}

struct ARows { const bf16* base; size_t ld; MDEV const bf16* operator()(int r) const { return base + (size_t)r * ld; } MDEV unsigned off(int r) const { return (unsigned)r * (unsigned)ld; } };

constexpr int LDB = 144;
constexpr int GEMM_BS2 = 64 * LDB;
constexpr int GEMM2_LDS = (2 * GEMM_AS + 2 * GEMM_BS2) * 2;
DEV bf16x8 tr_read8(const bf16* p0, const bf16* p1) {
    const s16x4 x = tr4(p0), y = tr4(p1); bf16x8 r;
    r[0] = x[0]; r[1] = x[1]; r[2] = x[2]; r[3] = x[3]; r[4] = y[0]; r[5] = y[1]; r[6] = y[2]; r[7] = y[3]; return r;
}
DEV int bperm(int r) { return (r & ~12) | ((r & 4) << 1) | ((r & 8) >> 1); }
template <class AF, class BF, class EPI>
DEV void gemm_tile2(unsigned char* smem, AF af, BF bf, int ldb, int K, EPI& epi) {
    const int tid = TID, w = tid >> 6, l = tid & 63, h = l >> 4, c = l & 15, wm = w >> 1, wn = w & 1, grp = w >> 2;
    bf16* As = (bf16*)smem; bf16* Bs = As + 2 * GEMM_AS;
    const bf16* abase = af.base; unsigned ao[4];
    const int col8 = (tid & 7) * 8, r0 = tid >> 3;
#pragma unroll
    for (int i = 0; i < 4; ++i) ao[i] = af.off(r0 + 64 * i) + col8;
    const int bn4 = (tid & 31) * 4, bk = tid >> 5, bkp = bperm(bk);
    const float* bp = bf(bn4); const bool bok = bp != nullptr;
    if (bok) bp += (size_t)bk * ldb;
    const size_t bstep = (size_t)16 * ldb;
    f32x4 acc[4][4];
#pragma unroll
    for (int i = 0; i < 4; ++i)
#pragma unroll
        for (int j = 0; j < 4; ++j) acc[i][j] = f4zero();
    bf16x8 ra[4]; f32x4 rb[4];
    const int nk = K / 64;
#pragma unroll
    for (int i = 0; i < 4; ++i) { ra[i] = *(const bf16x8*)(abase + ao[i]); rb[i] = bok ? *(const f32x4*)(bp + i * bstep) : f4zero(); }
    SYNC();
#pragma unroll
    for (int i = 0; i < 4; ++i) { *(bf16x8*)(As + (r0 + 64 * i) * LDT + col8) = ra[i]; st_bf4(Bs + (bkp + 16 * i) * LDB + bn4, rb[i]); }
    if (nk > 1) {
#pragma unroll
        for (int i = 0; i < 4; ++i) { ra[i] = *(const bf16x8*)(abase + (ao[i] + 64)); rb[i] = bok ? *(const f32x4*)(bp + (size_t)64 * ldb + i * bstep) : f4zero(); } }
    SYNC();
    for (int kt = 0; kt < nk; ++kt) {
        const int cur = kt & 1;
#pragma unroll
        for (int p = 0; p < 2; ++p) {
            if (grp == p) {
                const bf16* Ac = As + cur * GEMM_AS + (wm * 64 + c) * LDT + 8 * h;
                const bf16* Bc = Bs + cur * GEMM_BS2 + bperm(8 * h + (c >> 2)) * LDB + wn * 64 + 4 * (c & 3);
#pragma unroll
                for (int kk = 0; kk < 2; ++kk) {
                    bf16x8 fa[4], fb[4];
#pragma unroll
                    for (int i = 0; i < 4; ++i) { fa[i] = *(const bf16x8*)(Ac + i * 16 * LDT + kk * 32); fb[i] = tr_read8(Bc + (32 * kk) * LDB + 16 * i, Bc + (32 * kk + 8) * LDB + 16 * i); }
#pragma unroll
                    for (int ni = 0; ni < 4; ++ni)
#pragma unroll
                        for (int mi = 0; mi < 4; ++mi) acc[ni][mi] = mfma16(fb[ni], fa[mi], acc[ni][mi]);
                }
            } else if (kt + 1 < nk) {
                const int nx = cur ^ 1;
#pragma unroll
                for (int i = 0; i < 4; ++i) { *(bf16x8*)(As + nx * GEMM_AS + (r0 + 64 * i) * LDT + col8) = ra[i]; st_bf4(Bs + nx * GEMM_BS2 + (bkp + 16 * i) * LDB + bn4, rb[i]); }
                if (kt + 2 < nk) {
#pragma unroll
                    for (int i = 0; i < 4; ++i) { ra[i] = *(const bf16x8*)(abase + (ao[i] + (kt + 2) * 64)); rb[i] = bok ? *(const f32x4*)(bp + (size_t)(kt + 2) * 64 * ldb + i * bstep) : f4zero(); } }
            }
            SYNC();
        }
    }
    epi(acc, wm * 64, wn * 64, h, c);
}
struct BPlain { const float* base; MDEV const float* operator()(int nt) const { return base + nt; } };
struct BInProjMap { const float* base; int n0; MDEV const float* operator()(int nt) const { const int n = n0 + nt; const int sc = n < 1280 ? n : (n < 3328 ? n + 24 : (n < 3352 ? 1280 + (n - 3328) : -1)); return sc < 0 ? nullptr : base + sc; } };
struct BInter { const float* s0; const float* s1; int n0; MDEV const float* operator()(int nt) const { const int n = n0 + nt, g = n >> 6, w = n & 63; return w < 32 ? s0 + g * 32 + w : s1 + g * 32 + w - 32; } };
struct BClamp64 { const float* base; MDEV const float* operator()(int nt) const { return base + (nt & 63); } };

struct EpiInProj {
    const Args* a; int m0, n0, li;
    MDEV void operator()(f32x4 (&acc)[4][4], int mw, int nw, int h, int c) const {
        unsigned char* ws = wsp(*a);
        const int nb = n0 + nw;
        const int tokb = m0 + mw + c;
        if (nb < 512 || (nb >= 768 && nb < 896) || (nb >= 1024 && nb < 1152)) {
            const float* gain; float mul = 1.f; bf16* dst; int kind;
            if (nb < 512) { gain = INP(*a, I_QG) + li * 64; mul = 0.125f * LOG2E; kind = 0; dst = (bf16*)(ws + WS_QN); }
            else if (nb < 896) { gain = INP(*a, I_KG) + (li * 3 + 1) * 64; kind = 1; dst = (bf16*)(ws + WS_KS); }
            else { gain = INP(*a, I_KG) + (li * 3 + 2) * 64; kind = 1; dst = (bf16*)(ws + WS_KW); }
            const int g = (nb >> 6) & 1;
#pragma unroll
            for (int mi = 0; mi < 4; ++mi) {
                float ss = 0.f;
#pragma unroll
                for (int ni = 0; ni < 4; ++ni) { f32x4 v = acc[ni][mi]; ss += v[0] * v[0] + v[1] * v[1] + v[2] * v[2] + v[3] * v[3]; }
                ss += shflx(ss, 16); ss += shflx(ss, 32);
                const float rs = frsq(ss * (1.0f / 64.0f) + EPS) * mul;
                const int tok = tokb + 16 * mi;
#pragma unroll
                for (int ni = 0; ni < 4; ++ni) {
                    const int d = 16 * ni + 4 * h; f32x4 v = acc[ni][mi], o;
#pragma unroll
                    for (int r = 0; r < 4; ++r) o[r] = v[r] * rs * gain[d + r];
                    if (kind == 0) st_bf4(dst + (size_t)tok * 512 + nb + d, o);
                    else { const int b = tok / SEQ, s = tok % SEQ; st_bf4(dst + ((size_t)(b * 2 + g) * SEQ + s) * 64 + d, o); }
                }
            }
        } else if (nb < 768) {
            bf16* dst = (bf16*)(ws + (nb < 640 ? WS_KCG : WS_VCG)); const int g = (nb >> 6) & 1;
#pragma unroll
            for (int mi = 0; mi < 4; ++mi) { const int tok = tokb + 16 * mi, b = tok / SEQ, s = tok % SEQ;
#pragma unroll
                for (int ni = 0; ni < 4; ++ni) st_bf4(dst + ((size_t)(b * 2 + g) * SEQ + s) * 64 + 16 * ni + 4 * h, acc[ni][mi]); }
        } else if (nb < 1280) {
            bf16* dst = (bf16*)(ws + (nb < 1024 ? WS_VST : WS_VWT)); const int g = (nb >> 6) & 1;
#pragma unroll
            for (int mi = 0; mi < 4; ++mi) { const int tok = tokb + 16 * mi, b = tok / SEQ, s = tok % SEQ;
                bf16* p = dst + ((size_t)(b * 2 + g) * NCH + (s >> 6)) * 4096 + (s & 63);
#pragma unroll
                for (int ni = 0; ni < 4; ++ni)
#pragma unroll
                    for (int r = 0; r < 4; ++r) p[(16 * ni + 4 * h + r) * 64] = (bf16)f2bf(acc[ni][mi][r]); }
        } else if (nb < 3328) {
            const int sec = (nb - 1280) >> 9, cc = (nb - 1280) & 511, hh = cc >> 7, d0 = cc & 127;
#pragma unroll
            for (int mi = 0; mi < 4; ++mi) { const int tok = tokb + 16 * mi, b = tok / SEQ, s = tok % SEQ;
                const size_t hrow = ((size_t)(b * 4 + hh) * SEQ + s) * 128 + d0;
#pragma unroll
                for (int ni = 0; ni < 4; ++ni) { const int d = 16 * ni + 4 * h; f32x4 v = acc[ni][mi], o;
                    if (sec == 0) { for (int r = 0; r < 4; ++r) o[r] = siluf(v[r]); st_bf4((bf16*)(ws + WS_HQ) + hrow + d, o); }
                    else if (sec == 1) { const float* lb = (const float*)(ws + WS_LB) + li * 512 + cc + d;
                        for (int r = 0; r < 4; ++r) o[r] = lb[r] + (1.0f - lb[r]) * sigm(v[r]);
                        *(f32x4*)((float*)(ws + WS_HF) + hrow + d) = o; }
                    else if (sec == 2) st_bf4((bf16*)(ws + WS_HV) + hrow + d, v);
                    else { for (int r = 0; r < 4; ++r) o[r] = siluf(v[r]); st_bf4((bf16*)(ws + WS_HGS) + (size_t)tok * 512 + cc + d, o); }
                } }
        } else if (nb == 3328) {
            float* dst = (float*)(ws + WS_GATE);
#pragma unroll
            for (int mi = 0; mi < 4; ++mi) { const int tok = tokb + 16 * mi;
#pragma unroll
                for (int ni = 0; ni < 2; ++ni)
#pragma unroll
                    for (int r = 0; r < 4; ++r) { const int n = 16 * ni + 4 * h + r; if (n < 24) dst[(size_t)tok * 24 + n] = sigm(acc[ni][mi][r]); } }
        }
    }
};

struct EpiResid {
    float* x; const float* gate; int m0, n0;
    MDEV void operator()(f32x4 (&acc)[4][4], int mw, int nw, int h, int c) const {
#pragma unroll
        for (int mi = 0; mi < 4; ++mi) { const int tok = m0 + mw + 16 * mi + c, b = tok / SEQ;
#pragma unroll
            for (int ni = 0; ni < 4; ++ni) { const int n = n0 + nw + 16 * ni + 4 * h;
                f32x4 g = *(const f32x4*)(gate + (size_t)b * 6 * DM + n); f32x4* p = (f32x4*)(x + (size_t)tok * DM + n); f32x4 v = *p;
#pragma unroll
                for (int r = 0; r < 4; ++r) v[r] += g[r] * acc[ni][mi][r];
                *p = v; } }
    }
};
template <int MODE> struct EpiGated {
    bf16* dst; size_t ld; int m0, n0, mvalid;
    MDEV void operator()(f32x4 (&acc)[4][4], int mw, int nw, int h, int c) const {
        const int cb = (n0 + nw) / 2;
#pragma unroll
        for (int mi = 0; mi < 4; ++mi) { const int m = mw + 16 * mi + c; if (m >= mvalid) continue;
#pragma unroll
            for (int ni = 0; ni < 2; ++ni) { f32x4 o;
#pragma unroll
                for (int r = 0; r < 4; ++r) { const float av = acc[ni][mi][r], bv = acc[ni + 2][mi][r]; o[r] = MODE == 0 ? av * sigm(bv) : siluf(av) * bv; }
                st_bf4(dst + (size_t)(m0 + m) * ld + cb + 16 * ni + 4 * h, o); } }
    }
};
struct EpiStoreBf {
    bf16* dst; size_t ld; int m0, n0, mvalid;
    MDEV void operator()(f32x4 (&acc)[4][4], int mw, int nw, int h, int c) const {
#pragma unroll
        for (int mi = 0; mi < 4; ++mi) { const int m = mw + 16 * mi + c; if (m >= mvalid) continue;
#pragma unroll
            for (int ni = 0; ni < 4; ++ni) st_bf4(dst + (size_t)(m0 + m) * ld + n0 + nw + 16 * ni + 4 * h, acc[ni][mi]); }
    }
};
struct EpiCmp {
    const Args* a; int kv, bg, m0, li;
    MDEV void operator()(f32x4 (&acc)[4][4], int mw, int nw, int h, int c) const {
        if (nw != 0) return;
        unsigned char* ws = wsp(*a);
        const float* bp8 = (const float*)(ws + WS_CB) + (li * 2 + kv) * 8 * 64;
        float bias[16];
#pragma unroll
        for (int q = 0; q < 16; ++q) { const int e = 16 * (q >> 2) + 4 * h + (q & 3); float v = 0.f;
#pragma unroll
            for (int kp = 0; kp < 8; ++kp) v += bp8[kp * 64 + e];
            bias[q] = v; }
        const float* gain = INP(*a, I_KG) + (li * 3 + 0) * 64;
#pragma unroll
        for (int mi = 0; mi < 4; ++mi) { const int n = m0 + mw + 16 * mi + c; const bool ok = n < NCMP;
            f32x4 v[4]; float ss = 0.f;
#pragma unroll
            for (int ni = 0; ni < 4; ++ni) { v[ni] = acc[ni][mi];
#pragma unroll
                for (int r = 0; r < 4; ++r) { v[ni][r] += bias[4 * ni + r]; ss += v[ni][r] * v[ni][r]; } }
            ss += shflx(ss, 16); ss += shflx(ss, 32);
            if (n >= NCP) continue;
            if (kv == 0) { const float rs = frsq(ss * (1.0f / 64.0f) + EPS); bf16* p = (bf16*)(ws + WS_KC) + ((size_t)bg * NCP + n) * 64;
#pragma unroll
                for (int ni = 0; ni < 4; ++ni) { f32x4 o;
#pragma unroll
                    for (int r = 0; r < 4; ++r) o[r] = ok ? v[ni][r] * rs * gain[16 * ni + 4 * h + r] : 0.f;
                    st_bf4(p + 16 * ni + 4 * h, o); }
            } else { bf16* p = (bf16*)(ws + WS_VCT) + ((size_t)bg * NCP + n) * 64;
#pragma unroll
                for (int ni = 0; ni < 4; ++ni) { f32x4 o;
#pragma unroll
                    for (int r = 0; r < 4; ++r) o[r] = ok ? v[ni][r] : 0.f;
                    st_bf4(p + 16 * ni + 4 * h, o); } }
        }
    }
};


struct EpiResid8 {
    static constexpr bool PERM = true, AFTER_DRAIN = false;
    float* x; const float* gate;
    MDEV void operator()(const f32x4 (&acc)[2][2][4][2], const pg8::Unit& u, int wr, int wc, int fr, int fq) const {
        OPAQUE2(fr, fq);
#pragma unroll
        for (int ai = 0; ai < 2; ++ai)
#pragma unroll
            for (int m = 0; m < 4; ++m) { const int row = 256 * u.pm + 128 * ai + 64 * wr + 16 * m + fr, b = row / SEQ;
#pragma unroll
                for (int bj = 0; bj < 2; ++bj)
#pragma unroll
                    for (int n = 0; n < 2; ++n) { const int col = 256 * u.pn + 128 * bj + 32 * wc + 8 * fq + 4 * n;
                        const f32x4 g = *(const f32x4*)(gate + (size_t)b * 6 * DM + col); f32x4* p = (f32x4*)(x + (size_t)row * DM + col); f32x4 v = *p;
#pragma unroll
                        for (int r = 0; r < 4; ++r) v[r] += g[r] * acc[ai][bj][m][n][r];
                        *p = v; } }
    }
};
struct EpiGlu8 {
    static constexpr bool PERM = true, AFTER_DRAIN = false;
    bf16* dst;
    MDEV void operator()(const f32x4 (&acc)[2][2][4][2], const pg8::Unit& u, int wr, int wc, int fr, int fq) const {
        OPAQUE2(fr, fq);
#pragma unroll
        for (int ai = 0; ai < 2; ++ai)
#pragma unroll
            for (int m = 0; m < 4; ++m) { const int row = 256 * u.pm + 128 * ai + 64 * wr + 16 * m + fr;
#pragma unroll
                for (int bj = 0; bj < 2; ++bj) { const int col = 128 * u.pn + 64 * bj + 16 * wc + 4 * fq; f32x4 o;
#pragma unroll
                    for (int r = 0; r < 4; ++r) o[r] = acc[ai][bj][m][0][r] * sigm(acc[ai][bj][m][1][r]);
                    st_bf4(dst + (size_t)row * DM + col, o); } }
    }
};
struct EpiInProj8 {
    static constexpr bool PERM = true, AFTER_DRAIN = false;
    const Args* a; int li;
    MDEV void operator()(const f32x4 (&acc)[2][2][4][2], const pg8::Unit& u, int wr, int wc, int fr, int fq) const {
        OPAQUE2(fr, fq);
        unsigned char* ws = wsp(*a);
        const int nb = 256 * u.pn + 64 * wc;
        if (nb >= 3392) return;
        if (nb < 512 || (nb >= 768 && nb < 896) || (nb >= 1024 && nb < 1152)) {
            const float* gain; float mul = 1.f; int kind;
            if (nb < 512) { gain = INP(*a, I_QG) + li * 64; mul = 0.125f * LOG2E; kind = 0; }
            else if (nb < 896) { gain = INP(*a, I_KG) + (li * 3 + 1) * 64; kind = 1; }
            else { gain = INP(*a, I_KG) + (li * 3 + 2) * 64; kind = 2; }
            const int g = (nb >> 6) & 1;
            f32x4 gv[2][2];
#pragma unroll
            for (int bj = 0; bj < 2; ++bj)
#pragma unroll
                for (int n = 0; n < 2; ++n) gv[bj][n] = *(const f32x4*)(gain + 32 * bj + 8 * fq + 4 * n);
#pragma unroll
            for (int ai = 0; ai < 2; ++ai)
#pragma unroll
                for (int m = 0; m < 4; ++m) { const int tok = 256 * u.pm + 128 * ai + 64 * wr + 16 * m + fr;
                    float ss = 0.f;
#pragma unroll
                    for (int bj = 0; bj < 2; ++bj)
#pragma unroll
                        for (int n = 0; n < 2; ++n) { const f32x4 v = acc[ai][bj][m][n]; ss += v[0] * v[0] + v[1] * v[1] + v[2] * v[2] + v[3] * v[3]; }
                    ss += shflx(ss, 16); ss += shflx(ss, 32);
                    const float rs = frsq(ss * (1.0f / 64.0f) + EPS) * mul;
                    bf16* dst; if (kind == 0) dst = (bf16*)(ws + WS_QN) + (size_t)tok * 512 + nb; else { const int b = tok / SEQ, sq = tok % SEQ; dst = (bf16*)(ws + (kind == 1 ? WS_KS : WS_KW)) + ((size_t)(b * 2 + g) * SEQ + sq) * 64; }
#pragma unroll
                    for (int bj = 0; bj < 2; ++bj) { f32x4 o0, o1;
#pragma unroll
                        for (int r = 0; r < 4; ++r) { o0[r] = acc[ai][bj][m][0][r] * rs * gv[bj][0][r]; o1[r] = acc[ai][bj][m][1][r] * rs * gv[bj][1][r]; }
                        st_bf8(dst + 32 * bj + 8 * fq, o0, o1); } }
        } else if (nb < 768) {
            bf16* base = (bf16*)(ws + (nb < 640 ? WS_KCG : WS_VCG)); const int g = (nb >> 6) & 1;
#pragma unroll
            for (int ai = 0; ai < 2; ++ai)
#pragma unroll
                for (int m = 0; m < 4; ++m) { const int tok = 256 * u.pm + 128 * ai + 64 * wr + 16 * m + fr, b = tok / SEQ, sq = tok % SEQ;
#pragma unroll
                    for (int bj = 0; bj < 2; ++bj) st_bf8(base + ((size_t)(b * 2 + g) * SEQ + sq) * 64 + 32 * bj + 8 * fq, acc[ai][bj][m][0], acc[ai][bj][m][1]); }
        } else if (nb < 1280) {
            bf16* base = (bf16*)(ws + (nb < 1024 ? WS_VST : WS_VWT)); const int g = (nb >> 6) & 1;
#pragma unroll
            for (int ai = 0; ai < 2; ++ai)
#pragma unroll
                for (int m = 0; m < 4; ++m) { const int tok = 256 * u.pm + 128 * ai + 64 * wr + 16 * m + fr, b = tok / SEQ, sq = tok % SEQ;
#pragma unroll
                    for (int bj = 0; bj < 2; ++bj) st_bf8(base + ((size_t)(b * 2 + g) * SEQ + sq) * 64 + 32 * bj + 8 * fq, acc[ai][bj][m][0], acc[ai][bj][m][1]); }
        } else if (nb < 3328) {
            const int sec = (nb - 1280) >> 9, cc = (nb - 1280) & 511, hh = cc >> 7, d0 = cc & 127;
            f32x4 lbv[2][2];
            if (sec == 1) {
#pragma unroll
                for (int bj = 0; bj < 2; ++bj)
#pragma unroll
                    for (int n = 0; n < 2; ++n) lbv[bj][n] = *(const f32x4*)((const float*)(ws + WS_LB) + li * 512 + cc + 32 * bj + 8 * fq + 4 * n); }
#pragma unroll
            for (int ai = 0; ai < 2; ++ai)
#pragma unroll
                for (int m = 0; m < 4; ++m) { const int tok = 256 * u.pm + 128 * ai + 64 * wr + 16 * m + fr, b = tok / SEQ, sq = tok % SEQ;
                    const size_t hrow = ((size_t)(b * 4 + hh) * SEQ + sq) * 128 + d0;
#pragma unroll
                    for (int bj = 0; bj < 2; ++bj) { const int d = 32 * bj + 8 * fq; f32x4 o0, o1;
                        if (sec == 0) {
#pragma unroll
                            for (int r = 0; r < 4; ++r) { o0[r] = siluf(acc[ai][bj][m][0][r]); o1[r] = siluf(acc[ai][bj][m][1][r]); }
                            st_bf8((bf16*)(ws + WS_HQ) + hrow + d, o0, o1); }
                        else if (sec == 1) {
#pragma unroll
                            for (int r = 0; r < 4; ++r) { o0[r] = lbv[bj][0][r] + (1.0f - lbv[bj][0][r]) * sigm(acc[ai][bj][m][0][r]); o1[r] = lbv[bj][1][r] + (1.0f - lbv[bj][1][r]) * sigm(acc[ai][bj][m][1][r]); }
                            float* pf = (float*)(ws + WS_HF) + hrow + d; *(f32x4*)pf = o0; *(f32x4*)(pf + 4) = o1; }
                        else if (sec == 2) st_bf8((bf16*)(ws + WS_HV) + hrow + d, acc[ai][bj][m][0], acc[ai][bj][m][1]);
                        else {
#pragma unroll
                            for (int r = 0; r < 4; ++r) { o0[r] = siluf(acc[ai][bj][m][0][r]); o1[r] = siluf(acc[ai][bj][m][1][r]); }
                            st_bf8((bf16*)(ws + WS_HGS) + (size_t)tok * 512 + cc + d, o0, o1); } } }
        } else {
            float* dst = (float*)(ws + WS_GATE);
            if (fq < 3) {
#pragma unroll
                for (int ai = 0; ai < 2; ++ai)
#pragma unroll
                    for (int m = 0; m < 4; ++m) { const int tok = 256 * u.pm + 128 * ai + 64 * wr + 16 * m + fr; f32x4 o0, o1;
#pragma unroll
                        for (int r = 0; r < 4; ++r) { o0[r] = sigm(acc[ai][0][m][0][r]); o1[r] = sigm(acc[ai][0][m][1][r]); }
                        float* pf = dst + (size_t)tok * 24 + 8 * fq; *(f32x4*)pf = o0; *(f32x4*)(pf + 4) = o1; } }
        }
    }
};

DEV void tr_tile(unsigned char* smem, const float* src0, const float* src1, int ld, int K, int mode, bf16* dst, int n0, int k0) {
    bf16* tl = (bf16*)smem;
    const int tid = TID;
    SYNC();
#pragma unroll
    for (int i = 0; i < 8; ++i) {
        const int e = tid + 512 * i, kk = e >> 6, nn = e & 63, n = n0 + nn; float v = 0.f;
        if (mode == 0) v = src0[(size_t)(k0 + kk) * ld + n];
        else if (mode == 1) { int sc = n < 1280 ? n : (n < 3328 ? n + 24 : (n < 3352 ? 1280 + (n - 3328) : -1)); if (sc >= 0) v = src0[(size_t)(k0 + kk) * ld + sc]; }
        else { const int g = n >> 6, w = n & 63; v = (w < 32) ? src0[(size_t)(k0 + kk) * ld + g * 32 + w] : src1[(size_t)(k0 + kk) * ld + g * 32 + w - 32]; }
        tl[nn * LDT + kk] = (bf16)f2bf(v);
    }
    SYNC();
    const int nn = tid >> 3, k8 = (tid & 7) * 8;
    *(bf16x8*)(dst + (size_t)(n0 + nn) * K + k0 + k8) = *(const bf16x8*)(tl + nn * LDT + k8);
}

DEV int tr_col(int mode, int n) {
    if (mode == 0) return n;
    const int pn = n >> 8, ct = n & 255;
    if (mode == 5) { const int bj = ct >> 7, wc = (ct >> 5) & 3, j = ct & 31, L = 256 * pn + 64 * wc + 32 * bj + j; return L < 1280 ? L : (L < 3328 ? L + 24 : (L < 3352 ? 1280 + (L - 3328) : -1)); }
    { const int bj = ct >> 7, wc = (ct >> 5) & 3, j = ct & 31, nn = (j >> 2) & 1, Lc = 128 * pn + 64 * bj + 16 * wc + 4 * (j >> 3) + (j & 3); return nn == 0 ? Lc : DM + Lc; }
}
DEV void tr_tile(unsigned char* smem, const float* src, int ld, int K, int mode, bf16* dst, int n0, int k0) {
    bf16* tl = (bf16*)smem;
    const int tid = TID, nq = tid & 31, kq = tid >> 5;
    const int sc = tr_col(mode, n0 + 4 * nq);
    f32x4 v[4];
#pragma unroll
    for (int i = 0; i < 4; ++i) v[i] = sc >= 0 ? *(const f32x4*)(src + (size_t)(k0 + 4 * kq + i) * ld + sc) : f4zero();
    SYNC();
#pragma unroll
    for (int j = 0; j < 4; ++j) { u32x2 w; w[0] = pk2(v[0][j], v[1][j]); w[1] = pk2(v[2][j], v[3][j]); *(u32x2*)(tl + (4 * nq + j) * LDT + 4 * kq) = w; }
    SYNC();
#pragma unroll
    for (int t = 0; t < 2; ++t) { const int id = tid + 512 * t, row = id >> 3, ch = id & 7;
        *(bf16x8*)(dst + (size_t)(n0 + row) * K + k0 + 8 * ch) = *(const bf16x8*)(tl + row * LDT + 8 * ch); }
}
struct TrJob { const float* s; int ld, K, N, mode; bf16* dst; };
DEV void p0_phase(const Args& a, unsigned char* smem) {
    unsigned char* ws = wsp(a); const int tid = TID;
    { int item = BID, base = 0;
      for (int j = 0; j < 8; ++j) { TrJob J; const int i = j & 1;
        if (j < 2) J = {INP(a, I_WIN) + (size_t)i * DM * NIN, NIN, DM, NIN8, 5, (bf16*)(ws + WS_WIN) + (size_t)i * NIN8 * DM};
        else if (j < 4) J = {INP(a, I_WOUT) + (size_t)i * 1024 * DM, DM, 1024, DM, 0, (bf16*)(ws + WS_WOUT) + (size_t)i * DM * 1024};
        else if (j < 6) J = {INP(a, I_PW1) + (size_t)i * DM * 2 * DM, 2 * DM, DM, 2 * DM, 6, (bf16*)(ws + WS_PW1) + (size_t)i * 2 * DM * DM};
        else J = {INP(a, I_PW2) + (size_t)i * DM * DM, DM, DM, DM, 0, (bf16*)(ws + WS_PW2) + (size_t)i * DM * DM};
        const int tn = J.N / 128, tk = J.K / 64, nt = tn * tk;
        while (item < base + nt) { const int it = item - base; tr_tile(smem, J.s, J.ld, J.K, J.mode, J.dst, (it % tn) * 128, (it / tn) * 64); item += NBLK; }
        base += nt; }
      SYNC(); }
    {
        float* red = (float*)smem;
        constexpr int NG = 6 * DM / 128; const int ntask = DEPTH * NG;
        for (int t = BID; t < ntask; t += NBLK) {
            const int l = t / NG, j0 = (t % NG) * 128, cq = tid & 31, kr = tid >> 5;
            const float* w = INP(a, I_ADAW) + (size_t)l * DM * 6 * DM + j0 + 4 * cq; const float* cc = INP(a, I_C);
            f32x4 a0 = f4zero(), a1 = f4zero();
#pragma unroll 8
            for (int i = 0; i < DM / 16; ++i) { const int k = kr + 16 * i; const f32x4 wv = *(const f32x4*)(w + (size_t)k * 6 * DM); const float s0 = siluf(cc[k]), s1 = siluf(cc[DM + k]);
#pragma unroll
                for (int r = 0; r < 4; ++r) { a0[r] += s0 * wv[r]; a1[r] += s1 * wv[r]; } }
            SYNC();
            *(f32x4*)(red + (kr * 2 + 0) * 128 + 4 * cq) = a0; *(f32x4*)(red + (kr * 2 + 1) * 128 + 4 * cq) = a1;
            SYNC();
            if (tid < 256) { const int b = tid >> 7, col = tid & 127; float sum = INP(a, I_ADAB)[(size_t)l * 6 * DM + j0 + col];
#pragma unroll
                for (int q = 0; q < 16; ++q) sum += red[(q * 2 + b) * 128 + col];
                ((float*)(ws + WS_MOD))[((size_t)l * 2 + b) * 6 * DM + j0 + col] = sum; }
        }
    }
    for (int t = BID; t < 32; t += NBLK) {
        float* red = (float*)smem; const int ikv = t >> 3, kp = t & 7, i = ikv >> 1, kv = ikv & 1, e = tid & 63, ks = tid >> 6;
        const float* W = INP(a, kv ? I_CWV : I_CWK) + (size_t)i * 2048 * 64 + e; const float* pe = INP(a, I_CPE) + (size_t)i * 2048;
        float sum = 0.f;
#pragma unroll 8
        for (int q = 0; q < 32; ++q) { const int k = kp * 256 + ks * 32 + q; sum += pe[k] * W[(size_t)k * 64]; }
        SYNC(); red[ks * 64 + e] = sum; SYNC();
        if (tid < 64) { float v = 0.f; for (int q = 0; q < 8; ++q) v += red[q * 64 + tid]; ((float*)(ws + WS_CB))[(ikv * 8 + kp) * 64 + tid] = v; }
    }
    for (int i = BID * NT + tid; i < DEPTH * 48 * DM; i += NBLK * NT) { const int k = i % DM, n = (i / DM) % 48, ll = i / (48 * DM);
        const float wv = n < 4 ? INP(a, I_WG)[((size_t)ll * DM + k) * 4 + n] : (n < 36 ? INP(a, I_WE)[((size_t)ll * DM + k) * 32 + n - 4] : 0.f);
        const unsigned hi = f2bf(wv); ((bf16*)(ws + WS_WTH))[i] = (bf16)hi; ((bf16*)(ws + WS_WTL))[i] = (bf16)f2bf(wv - bf2f(hi)); }
    if (BID == 0) {
        for (int i = tid; i < DEPTH * 32; i += NT) ((int*)(ws + WS_CNT))[i * 64] = 0;
        for (int n = tid; n < 512; n += NT) { const float l0 = INP(a, I_LBL)[n], l1 = INP(a, I_LBL)[512 + n]; const float m = fmaxf(l0, l1);
            const float e0 = fexp2((l0 - m) * LOG2E), e1 = fexp2((l1 - m) * LOG2E);
            ((float*)(ws + WS_LB))[n] = 0.f; ((float*)(ws + WS_LB))[512 + n] = e1 / (e0 + e1); }
        if (tid < 2) { const int i = tid; float mq = 0.f; for (int d = 0; d < 64; ++d) mq = fmaxf(mq, fabsf(INP(a, I_QG)[i * 64 + d]));
            for (int br = 0; br < 3; ++br) { float mk = 0.f; for (int d = 0; d < 64; ++d) mk = fmaxf(mk, fabsf(INP(a, I_KG)[(i * 3 + br) * 64 + d]));
                ((float*)(ws + WS_CS))[i * 4 + br] = 8.0f * mq * mk * LOG2E; } }
    }
}

constexpr int NJV = DM / 256;
DEV void moe_bases(const int* cnt, int* rb  ) {
    if (TID == 0) { int acc = 0; for (int e = 0; e < 32; ++e) { rb[e] = acc; acc += ((cnt[e * 64] + 255) >> 8) << 8; } rb[32] = acc; }
    SYNC();
}
DEV void norm_phase(const Args& a, unsigned char* smem, int l) {
    unsigned char* ws = wsp(a); const int tid = TID, w = tid >> 6, lane = tid & 63;
    int* rb = (int*)smem;
    if (l > 0) moe_bases((const int*)(ws + WS_CNT) + (l - 1) * 32 * 64, rb);
    const float* mod = (const float*)(ws + WS_MOD);
    const bf16* yk = (const bf16*)(ws + WS_YK);
    if (l < DEPTH) {
        const int bid = BID % 76 == BID ? BID : -1;
        for (int job = BID; job < 76; job += NBLK) {
            if (job < 72) { const int b = job / 36, n = job % 36; float sum = 0.f;
                for (int k = tid; k < DM; k += NT) { const float wv = n < 4 ? INP(a, I_WG)[((size_t)l * DM + k) * 4 + n] : INP(a, I_WE)[((size_t)l * DM + k) * 32 + n - 4]; sum += mod[((size_t)l * 2 + b) * 6 * DM + 3 * DM + k] * wv; }
#pragma unroll
                for (int q = 1; q < 64; q <<= 1) sum += shflx(sum, q);
                float* red = (float*)(smem + 1024);
                SYNC(); if (lane == 0) red[w] = sum; SYNC();
                if (tid == 0) { float t = 0.f; for (int q = 0; q < 8; ++q) t += red[q]; ((float*)(ws + WS_RBIAS))[((size_t)l * 2 + b) * 48 + n] = t; }
            } else { const float* nf = INP(a, I_NFFN) + (size_t)l * DM; const int part = job - 72;
                for (int i = part * (2 * DM / 4) + tid; i < (part + 1) * (2 * DM / 4); i += NT) { const int b = i / DM, k = i % DM; ((float*)(ws + WS_AVEC))[((size_t)l * 2 + b) * DM + k] = nf[k] * (1.0f + mod[((size_t)l * 2 + b) * 6 * DM + 4 * DM + k]); } }
        }
        (void)bid;
    }
    const int rstride = NBLK * 8;
    for (int rowa = BID * 8 + w; rowa < T; rowa += 2 * rstride) {
        int row[2]; bool ok[2];
        row[0] = rowa; ok[0] = true; row[1] = rowa + rstride; ok[1] = row[1] < T; if (!ok[1]) row[1] = rowa;
        f32x4 v[2][NJV]; int e0[2], p0[2], e1[2], p1[2]; float w0[2], w1[2];
        const float* xin = (l == 0) ? INP(a, I_X) : outp(a);
#pragma unroll
        for (int q = 0; q < 2; ++q) {
#pragma unroll
            for (int j = 0; j < NJV; ++j) v[q][j] = *(const f32x4*)(xin + (size_t)row[q] * DM + 4 * lane + 256 * j);
            if (l > 0) { const int* tie = (const int*)(ws + WS_TIE) + (size_t)row[q] * 2; const float* tiw = (const float*)(ws + WS_TIW) + (size_t)row[q] * 2;
                e0[q] = tie[0] >> 14; p0[q] = tie[0] & 16383; e1[q] = tie[1] >> 14; p1[q] = tie[1] & 16383; w0[q] = tiw[0]; w1[q] = tiw[1]; } }
        if (l > 0) {
            u32x2 q0[2][NJV], q1[2][NJV];
#pragma unroll
            for (int q = 0; q < 2; ++q) { const bf16* y0 = yk + (size_t)(rb[e0[q]] + p0[q]) * DM; const bf16* y1 = yk + (size_t)(rb[e1[q]] + p1[q]) * DM;
#pragma unroll
                for (int j = 0; j < NJV; ++j) { const int cidx = 4 * lane + 256 * j; q0[q][j] = *(const u32x2*)(y0 + cidx); q1[q][j] = *(const u32x2*)(y1 + cidx); } }
#pragma unroll
            for (int q = 0; q < 2; ++q) { const int b = row[q] / SEQ; const float* gf = mod + ((size_t)(l - 1) * 2 + b) * 6 * DM + 5 * DM;
#pragma unroll
                for (int j = 0; j < NJV; ++j) { const int cidx = 4 * lane + 256 * j; const f32x4 g = *(const f32x4*)(gf + cidx);
                    v[q][j][0] += g[0] * (w0[q] * bf2f(q0[q][j][0] & 0xffff) + w1[q] * bf2f(q1[q][j][0] & 0xffff));
                    v[q][j][1] += g[1] * (w0[q] * bf2f(q0[q][j][0] >> 16) + w1[q] * bf2f(q1[q][j][0] >> 16));
                    v[q][j][2] += g[2] * (w0[q] * bf2f(q0[q][j][1] & 0xffff) + w1[q] * bf2f(q1[q][j][1] & 0xffff));
                    v[q][j][3] += g[3] * (w0[q] * bf2f(q0[q][j][1] >> 16) + w1[q] * bf2f(q1[q][j][1] >> 16)); } }
        }
#pragma unroll
        for (int q = 0; q < 2; ++q) { if (!ok[q]) continue;
#pragma unroll
            for (int j = 0; j < NJV; ++j) *(f32x4*)(outp(a) + (size_t)row[q] * DM + 4 * lane + 256 * j) = v[q][j]; }
        if (l == DEPTH) continue;
        float ss[2];
#pragma unroll
        for (int q = 0; q < 2; ++q) { ss[q] = 0.f;
#pragma unroll
            for (int j = 0; j < NJV; ++j) ss[q] += v[q][j][0] * v[q][j][0] + v[q][j][1] * v[q][j][1] + v[q][j][2] * v[q][j][2] + v[q][j][3] * v[q][j][3]; }
#pragma unroll
        for (int o = 1; o < 64; o <<= 1) { ss[0] += shflx(ss[0], o); ss[1] += shflx(ss[1], o); }
        const float* nm = INP(a, I_NMIX) + (size_t)l * DM;
#pragma unroll
        for (int q = 0; q < 2; ++q) { if (!ok[q]) continue;
            const int b = row[q] / SEQ; const float rs = frsq(ss[q] * (1.0f / DM) + EPS);
            const float* mm = mod + ((size_t)l * 2 + b) * 6 * DM; bf16* hb = (bf16*)(ws + WS_H) + (size_t)row[q] * DM;
#pragma unroll
            for (int j = 0; j < NJV; ++j) { const int cidx = 4 * lane + 256 * j; f32x4 g = *(const f32x4*)(nm + cidx), sh = *(const f32x4*)(mm + cidx), sc = *(const f32x4*)(mm + DM + cidx), o;
#pragma unroll
                for (int r = 0; r < 4; ++r) o[r] = v[q][j][r] * rs * g[r] * (1.0f + sc[r]) + sh[r];
                st_bf4(hb + cidx, o); } }
    }
}

DEV void route_phase(const Args& a, unsigned char* smem, int l) {
    unsigned char* ws = wsp(a); const int tid = TID, w = tid >> 6, lane = tid & 63, h = lane >> 4, c = lane & 15, pi = w >> 1, kh = w & 1;
    constexpr int CH = DM / 2, WLD = CH + 8, NKS = CH / 2 / 32;
    bf16* WHl = (bf16*)smem; bf16* WLl = WHl + 48 * WLD;
    float* lg = (float*)(WLl + 48 * WLD);
    float* ssb = lg + 4 * 2 * 16 * 48;
    float* rsb = ssb + 4 * 2 * 16;
    int* lcnt = (int*)(rsb + 64); int* lbase = lcnt + 32; int* tinfo = lbase + 32;
    SYNC();
    if (tid < 32) lcnt[tid] = 0;
    SYNC();
    const float* mod = (const float*)(ws + WS_MOD);
    const bf16* WH = (const bf16*)(ws + WS_WTH) + (size_t)l * 48 * DM; const bf16* WL = (const bf16*)(ws + WS_WTL) + (size_t)l * 48 * DM;
    int* cnt = (int*)(ws + WS_CNT) + l * 32 * 64;
    constexpr int KH = DM / 2;
    for (int pass0 = BID; pass0 < T / 16; pass0 += 4 * NBLK) {
        const int pass = pass0 + pi * NBLK; const bool valid = pass < T / 16;
        const int tok = valid ? pass * 16 + c : 0, b = tok / SEQ;
        const float* xr = outp(a) + (size_t)tok * DM + kh * KH + 8 * h;
        const float* av = (const float*)(ws + WS_AVEC) + ((size_t)l * 2 + b) * DM + kh * KH + 8 * h;
        const float* cv = mod + ((size_t)l * 2 + b) * 6 * DM + 3 * DM + kh * KH + 8 * h;
        f32x4 acc[3] = {f4zero(), f4zero(), f4zero()}; float ss = 0.f;
#pragma unroll 1
        for (int chn = 0; chn < 2; ++chn) {
            const float* xq = outp(a) + (size_t)tok * DM + chn * CH + kh * (CH / 2) + 8 * h;
            const float* aq = (const float*)(ws + WS_AVEC) + ((size_t)l * 2 + b) * DM + chn * CH + kh * (CH / 2) + 8 * h;
            f32x4 xv[NKS][2], avv[NKS][2];
#pragma unroll
            for (int ks = 0; ks < NKS; ++ks) { xv[ks][0] = *(const f32x4*)(xq + 32 * ks); xv[ks][1] = *(const f32x4*)(xq + 32 * ks + 4); avv[ks][0] = *(const f32x4*)(aq + 32 * ks); avv[ks][1] = *(const f32x4*)(aq + 32 * ks + 4); }
            SYNC();
            for (int i = tid; i < 48 * (CH / 8); i += NT) { const int n = i / (CH / 8), k8 = (i % (CH / 8)) * 8;
                *(bf16x8*)(WHl + n * WLD + k8) = *(const bf16x8*)(WH + (size_t)n * DM + chn * CH + k8); *(bf16x8*)(WLl + n * WLD + k8) = *(const bf16x8*)(WL + (size_t)n * DM + chn * CH + k8); }
            SYNC();
            if (valid) {
                const bf16* whp = WHl + c * WLD + kh * (CH / 2) + 8 * h; const bf16* wlp = WLl + c * WLD + kh * (CH / 2) + 8 * h;
#pragma unroll
                for (int ks = 0; ks < NKS; ++ks) {
                    f32x4 u0, u1, r0, r1;
#pragma unroll
                    for (int r = 0; r < 4; ++r) { u0[r] = xv[ks][0][r] * avv[ks][0][r]; u1[r] = xv[ks][1][r] * avv[ks][1][r]; ss += xv[ks][0][r] * xv[ks][0][r] + xv[ks][1][r] * xv[ks][1][r]; }
                    const bf16x8 uh = pack8(u0, u1);
#pragma unroll
                    for (int r = 0; r < 4; ++r) { r0[r] = u0[r] - bf2f((unsigned short)uh[r]); r1[r] = u1[r] - bf2f((unsigned short)uh[4 + r]); }
                    const bf16x8 ul = pack8(r0, r1);
#pragma unroll
                    for (int nt = 0; nt < 3; ++nt) { const bf16x8 wh = *(const bf16x8*)(whp + nt * 16 * WLD + 32 * ks), wl = *(const bf16x8*)(wlp + nt * 16 * WLD + 32 * ks);
                        acc[nt] = mfma16(wh, uh, acc[nt]); acc[nt] = mfma16(wl, uh, acc[nt]); acc[nt] = mfma16(wh, ul, acc[nt]); }
                }
            }
        }
        if (valid) {
            ss += shflx(ss, 16); ss += shflx(ss, 32);
            float* lgp = lg + ((pi * 2 + kh) * 16 + c) * 48 + 4 * h;
#pragma unroll
            for (int nt = 0; nt < 3; ++nt) *(f32x4*)(lgp + 16 * nt) = acc[nt];
            if (h == 0) ssb[(pi * 2 + kh) * 16 + c] = ss;
        }
        SYNC();
        if (tid < 64) { const int p2 = tid >> 4, tk = tid & 15, pass2 = pass0 + p2 * NBLK;
            if (pass2 < T / 16) { const int tok2 = pass2 * 16 + tk, b2 = tok2 / SEQ;
                const float rs = frsq((ssb[(p2 * 2 + 0) * 16 + tk] + ssb[(p2 * 2 + 1) * 16 + tk]) * (1.0f / DM) + EPS); rsb[p2 * 16 + tk] = rs;
                const float* l0 = lg + ((p2 * 2 + 0) * 16 + tk) * 48; const float* l1 = lg + ((p2 * 2 + 1) * 16 + tk) * 48; const float* rbp = (const float*)(ws + WS_RBIAS) + ((size_t)l * 2 + b2) * 48;
                float acc[36];
#pragma unroll
                for (int n = 0; n < 36; ++n) acc[n] = rs * (l0[n] + l1[n]) + rbp[n];
                int gs = 0; float gm = acc[0];
#pragma unroll
                for (int g = 1; g < 4; ++g) if (acc[g] > gm) { gm = acc[g]; gs = g; }
                float den = 0.f;
#pragma unroll
                for (int g = 0; g < 4; ++g) den += fexp2((acc[g] - gm) * LOG2E);
                const float ggate = 1.0f / den;
                float el[8];
#pragma unroll
                for (int j = 0; j < 8; ++j) { el[j] = acc[4 + j];
#pragma unroll
                    for (int g = 1; g < 4; ++g) if (gs == g) el[j] = acc[4 + 8 * g + j]; }
                int ia = 0; float va = el[0];
#pragma unroll
                for (int j = 1; j < 8; ++j) if (el[j] > va) { va = el[j]; ia = j; }
                int ib = -1; float vb = -3e38f;
#pragma unroll
                for (int j = 0; j < 8; ++j) if (j != ia && el[j] > vb) { vb = el[j]; ib = j; }
                const float wa = 1.0f / (1.0f + fexp2((vb - va) * LOG2E)), wb = 1.0f - wa;
                const int e0 = gs * 8 + ia, e1 = gs * 8 + ib;
                const int p0 = atomic_add_i(lcnt + e0, 1), p1 = atomic_add_i(lcnt + e1, 1);
                int* ti = tinfo + tid * 4;
                ti[0] = (e0 << 14) | p0; ti[1] = (e1 << 14) | p1; ti[2] = __builtin_bit_cast(int, ggate * wa); ti[3] = __builtin_bit_cast(int, ggate * wb);
            } }
        SYNC();
        if (valid) { const float rs = rsb[pi * 16 + c]; bf16* hb = (bf16*)(ws + WS_H) + (size_t)tok * DM + kh * KH + 8 * h;
#pragma unroll 4
            for (int ks = 0; ks < KH / 32; ++ks) {
                const f32x4 x0 = *(const f32x4*)(xr + 32 * ks), x1 = *(const f32x4*)(xr + 32 * ks + 4), a0 = *(const f32x4*)(av + 32 * ks), a1 = *(const f32x4*)(av + 32 * ks + 4), c0 = *(const f32x4*)(cv + 32 * ks), c1 = *(const f32x4*)(cv + 32 * ks + 4);
                f32x4 o0, o1;
#pragma unroll
                for (int r = 0; r < 4; ++r) { o0[r] = x0[r] * rs * a0[r] + c0[r]; o1[r] = x1[r] * rs * a1[r] + c1[r]; }
                st_bf8(hb + 32 * ks, o0, o1); } }
        if (tid < 32) { const int n = lcnt[tid]; lbase[tid] = n > 0 ? atomic_add_i(cnt + tid * 64, n) : 0; lcnt[tid] = 0; }
        SYNC();
        if (tid < 64) { const int p2 = tid >> 4, pass2 = pass0 + p2 * NBLK;
            if (pass2 < T / 16) { const int tok2 = pass2 * 16 + (tid & 15); const int* ti = tinfo + tid * 4;
                const int e0 = ti[0] >> 14, e1 = ti[1] >> 14, p0 = lbase[e0] + (ti[0] & 16383), p1 = lbase[e1] + (ti[1] & 16383);
                int* list = (int*)(ws + WS_LIST); list[(size_t)e0 * T + p0] = tok2; list[(size_t)e1 * T + p1] = tok2;
                int* tie = (int*)(ws + WS_TIE) + (size_t)tok2 * 2; int* tiw = (int*)(ws + WS_TIW) + (size_t)tok2 * 2;
                tie[0] = (e0 << 14) | p0; tie[1] = (e1 << 14) | p1; tiw[0] = ti[2]; tiw[1] = ti[3]; } }
        SYNC();
    }
}

DEV int vbid() { const int g = NBLK; return (g % 8 == 0) ? (BID % 8) * (g / 8) + BID / 8 : BID; }
#ifdef EMU
#define PG8_LDS(p) (p)
#else
#define PG8_LDS(p) ((PG8_LAS unsigned char*)(p))
#endif
DEV void inproj_phase(const Args& a, unsigned char* smem, int li) {
    pg8::Gemm g{(const bf16*)(wsp(a) + WS_H), (const bf16*)(wsp(a) + WS_WIN) + (size_t)li * NIN8 * DM, T, NIN8, DM}; pg8::StaticOrder S; S.init(T, NIN8, NBLK, BID);
    EpiInProj8 E{&a, li};
    SYNC(); pg8::gemm_phase<EpiInProj8, pg8::StaticOrder, true, true>(PG8_LDS(smem), g, S, E); SYNC();
}
DEV void resid_gemm_phase(const Args& a, unsigned char* smem, const bf16* A, int K, const bf16* Bt, int l) {
    pg8::Gemm g{A, Bt, T, DM, K}; pg8::StaticOrder S; S.init(T, DM, NBLK, BID);
    EpiResid8 E{outp(a), (const float*)(wsp(a) + WS_MOD) + (size_t)l * 2 * 6 * DM + 2 * DM};
    SYNC(); pg8::gemm_phase<EpiResid8, pg8::StaticOrder, true, true>(PG8_LDS(smem), g, S, E); SYNC();
}
DEV void pw1_phase(const Args& a, unsigned char* smem, int li) {
    pg8::Gemm g{(const bf16*)(wsp(a) + WS_H), (const bf16*)(wsp(a) + WS_PW1) + (size_t)li * 2 * DM * DM, T, 2 * DM, DM}; pg8::StaticOrder S; S.init(T, 2 * DM, NBLK, BID);
    EpiGlu8 E{(bf16*)(wsp(a) + WS_GLU)};
    SYNC(); pg8::gemm_phase<EpiGlu8, pg8::StaticOrder, true, true>(PG8_LDS(smem), g, S, E); SYNC();
}
DEV void cmp_phase_items(const Args& a, unsigned char* smem, int li, int it) {
    constexpr int TMC = (NCP + 255) / 256;
    const int kv = it / (4 * TMC), bg = (it / TMC) % 4, tm = it % TMC;
    const bf16* src = (const bf16*)(wsp(a) + (kv ? WS_VCG : WS_KCG)) + (size_t)bg * SEQ * 64;
    struct AF { const bf16* base; int m0; MDEV unsigned off(int r) const { int n = m0 + r; if (n > NCMP - 1) n = NCMP - 1; return (unsigned)n * 1024u; } } af{src, tm * 256};
    EpiCmp E{&a, kv, bg, tm * 256, li};
    BClamp64 bf{INP(a, kv ? I_CWV : I_CWK) + (size_t)li * 2048 * 64};
    gemm_tile2(smem, af, bf, 64, 2048, E);
}
DEV void moe_gemm_phase(const Args& a, unsigned char* smem, int l, int mode) {
    unsigned char* ws = wsp(a); const int* cnt = (const int*)(ws + WS_CNT) + l * 32 * 64;
    int* rb = (int*)(smem + GEMM2_LDS);
    moe_bases(cnt, rb);
    const int ntile = rb[32] >> 8;
    constexpr int TN1 = 2 * FF / 128, TN2 = DM / 128;
    const int TN = mode == 0 ? TN1 : TN2;
    const int* list = (const int*)(ws + WS_LIST);
    for (int it = vbid(); it < ntile * TN; it += NBLK) {
        const int rt = it / TN, tn = it % TN; int e = 0;
#pragma unroll 1
        for (int q = 1; q < 32; ++q) if ((rb[q] >> 8) <= rt) e = q;
        const int rloc = (rt << 8) - rb[e], ce = cnt[e * 64], nvalid = (ce - rloc) < 256 ? (ce - rloc) : 256;
        if (mode == 0) {
            struct AF { const bf16* base; const int* lst; int nv; MDEV unsigned off(int r) const { const int rr = r < nv ? r : nv - 1; return (unsigned)lst[rr] * (unsigned)DM; } }
                af{(const bf16*)(ws + WS_H), list + (size_t)e * T + rloc, nvalid};
            EpiGated<1> E{(bf16*)(ws + WS_ACT), (size_t)FF, rt << 8, tn * 128, nvalid};
            BInter bf{INP(a, I_W1) + (size_t)(l * 32 + e) * DM * FF, INP(a, I_W3) + (size_t)(l * 32 + e) * DM * FF, tn * 128};
            gemm_tile2(smem, af, bf, FF, DM, E);
        } else {
            ARows af{(const bf16*)(ws + WS_ACT) + (size_t)(rt << 8) * FF, (size_t)FF};
            EpiStoreBf E{(bf16*)(ws + WS_YK), (size_t)DM, rt << 8, tn * 128, nvalid};
            BPlain bf{INP(a, I_W2) + (size_t)(l * 32 + e) * FF * DM + tn * 128};
            gemm_tile2(smem, af, bf, DM, FF, E);
        }
    }
}

constexpr int LDV = 80;
constexpr int AT_K = 0, AT_V = 2 * 64 * LDT * 2, AT_IMP = AT_V + 2 * 64 * LDV * 2, AT_SEL = AT_IMP + 8 * 8 * 128 * 4, AT_GSEL = AT_SEL + 8 * 8 * 4 * 4, AT_OUT = AT_GSEL + 8 * 2 * 4 * 4, AT_END = AT_OUT + 8 * 32 * 64 * 4;
#ifdef EMU
DEV float rexp2(float x) { return exp2f(x); }
DEV unsigned uni(unsigned x) { return x; }
#else
DEV float rexp2(float x) { return __builtin_amdgcn_exp2f(x); }
DEV unsigned uni(unsigned x) { return (unsigned)__builtin_amdgcn_readfirstlane((int)x); }
#endif
DEV int krow_lds(int kappa) { return 16 * (2 * (kappa >> 5) + ((kappa >> 2) & 1)) + 4 * ((kappa >> 3) & 3) + (kappa & 3); }
template <int MASK, bool FULL, int GM>
DEV void attn_block(const bf16* Kp, const bf16* Vp, const bf16x8 (&qf)[2][2], int j, const int (&s)[2], const bool (&selbit)[2], float C2, int h, int c,
                    f32x4 (&O)[2][4], f32x4 (&Ol)[2]) {
    f32x4 st[2][2][2];
#pragma unroll
    for (int sp = 0; sp < 2; ++sp)
#pragma unroll
        for (int u = 0; u < 2; ++u) {
#pragma unroll
            for (int G = 0; G < 2; ++G) { st[G][sp][u][0] = -C2; st[G][sp][u][1] = -C2; st[G][sp][u][2] = -C2; st[G][sp][u][3] = -C2; }
#pragma unroll
            for (int ks = 0; ks < 2; ++ks) { const bf16x8 kf = *(const bf16x8*)(Kp + (16 * (2 * sp + u) + c) * LDT + 32 * ks + 8 * h);
#pragma unroll
                for (int G = 0; G < 2; ++G) if (GM & (1 << G)) st[G][sp][u] = mfma16(kf, qf[G][ks], st[G][sp][u]); } }
#pragma unroll
    for (int G = 0; G < 2; ++G) if (GM & (1 << G))
#pragma unroll
        for (int sp = 0; sp < 2; ++sp)
#pragma unroll
            for (int u = 0; u < 2; ++u)
#pragma unroll
                for (int r = 0; r < 4; ++r) { bool ok = selbit[G];
                    if (!FULL) { const int key = 64 * j + 32 * sp + 8 * h + 4 * u + r;
                        if (MASK == 0) ok = 16 * key + 31 <= s[G]; else if (MASK == 1) ok = selbit[G] && key <= s[G]; else ok = key <= s[G] && key > s[G] - 512; }
                    st[G][sp][u][r] = ok ? rexp2(st[G][sp][u][r]) : 0.f; }
    bf16x8 pb[2][2], ones;
#pragma unroll
    for (int q = 0; q < 8; ++q) ones[q] = (short)0x3F80;
#pragma unroll
    for (int G = 0; G < 2; ++G) if (GM & (1 << G))
#pragma unroll
        for (int sp = 0; sp < 2; ++sp) { pb[G][sp] = pack8(st[G][sp][0], st[G][sp][1]); Ol[G] = mfma16(ones, pb[G][sp], Ol[G]); }
    const bf16* Vb = Vp + bperm(8 * h + (c >> 2)) * LDV + 4 * (c & 3);
#pragma unroll
    for (int et = 0; et < 4; ++et)
#pragma unroll
        for (int sp = 0; sp < 2; ++sp) { const bf16x8 vf = tr_read8(Vb + (32 * sp) * LDV + 16 * et, Vb + (32 * sp + 8) * LDV + 16 * et);
#pragma unroll
            for (int G = 0; G < 2; ++G) if (GM & (1 << G)) O[G][et] = mfma16(vf, pb[G][sp], O[G][et]); }
}

struct ImpState { float invq[2][4]; float carry[2]; float* imps; int tl, hd, l, s0, qblk; };
DEV void imp_block(const bf16* Kp, const bf16x8 (&qf)[2][2], int j, int s0, int w, float C2, int h, int c, ImpState& im) {
#pragma unroll
    for (int kt = 0; kt < 4; ++kt) {
        const int row = krow_lds(16 * kt + c);
        const bf16x8 k0 = *(const bf16x8*)(Kp + row * LDT + 8 * h), k1 = *(const bf16x8*)(Kp + row * LDT + 32 + 8 * h);
        const int n = 64 * j + 16 * kt + c;
#pragma unroll
        for (int G = 0; G < 2; ++G) {
            f32x4 acc; acc[0] = -C2; acc[1] = -C2; acc[2] = -C2; acc[3] = -C2;
            acc = mfma16(qf[G][0], k0, acc); acc = mfma16(qf[G][1], k1, acc);
            const bool ok = 16 * n + 31 <= s0 + 8 * w + 4 * G + h;
            float imp = 0.f;
#pragma unroll
            for (int r = 0; r < 4; ++r) imp += ok ? rexp2(acc[r]) * im.invq[G][r] : 0.f;
            const float v = ((c & 3) == 3) ? imp : 2.0f * imp;
            float sq = v + shflx(v, 1); sq += shflx(sq, 2);
            const float rr = dpp_ror1(imp);
            const float prev = (c == 0) ? im.carry[G] : rr;
            im.carry[G] = rr;
            const int m = n >> 2;
            if ((c & 3) == 0 && m < 128) im.imps[(G * 4 + h) * 128 + m] = sq + prev;
        }
    }
}

template <int MODE>
DEV void attn_branch(bf16* Kl, bf16* Vl, const bf16* kbase, const bf16* vbase, int jlo, int jhi,
                     const bf16x8 (&qf)[2][2], const int (&s)[2], const unsigned* selm, const unsigned* gselm, float C2, int w, int h, int c, int srow, int scol,
                     f32x4 (&O)[2][4], f32x4 (&Ol)[2], ImpState& im) {
    constexpr bool PV = MODE != 1; constexpr int MASK = MODE <= 1 ? 0 : MODE - 1;
    const int krow = krow_lds(srow) * LDT + scol, vrow = bperm(srow) * LDV + scol;
    bf16x8 rk[3], rv[3];
    { const bf16x8 k0 = *(const bf16x8*)(kbase + (size_t)jlo * 4096); *(bf16x8*)(Kl + krow) = k0;
      if (PV) { const bf16x8 v0 = *(const bf16x8*)(vbase + (size_t)jlo * 4096); *(bf16x8*)(Vl + vrow) = v0; } }
#pragma unroll
    for (int u = 0; u < 3; ++u) { int jj = jlo + 1 + u; if (jj > jhi) jj = jhi; rk[(1 + u) % 3] = *(const bf16x8*)(kbase + (size_t)jj * 4096); if (PV) rv[(1 + u) % 3] = *(const bf16x8*)(vbase + (size_t)jj * 4096); }
    SYNC();
    for (int jb = jlo; jb <= jhi; jb += 3) {
#pragma unroll
        for (int u = 0; u < 3; ++u) { const int j = jb + u;
            if (j <= jhi) {
                const int cur = (j - jlo) & 1;
                const bf16* Kc = Kl + cur * 64 * LDT; const bf16* Vc = Vl + cur * 64 * LDV;
                if (MODE == 1) imp_block(Kc, qf, j, im.s0, w, C2, h, c, im);
                else {
                    bool sb[2] = {true, true}; unsigned gm = 3u;
                    if (MODE == 2) { gm = 0u;
#pragma unroll
                        for (int G = 0; G < 2; ++G) { const unsigned wq = uni(gselm[G * 4 + (j >> 5)]), mq = selm[(G * 4 + im.tl) * 4 + (j >> 5)];
                            gm |= ((wq >> (j & 31)) & 1u) << G; sb[G] = (mq >> (j & 31)) & 1u; } }
                    bool full;
                    if (MODE == 0) full = 1024 * j + 1039 <= im.s0; else if (MODE == 2) full = j < im.qblk; else full = (j < im.qblk) && (64 * j > im.s0 + 63 - 512);
                    if (MODE == 2) {
                        if (full) { if (gm == 3u) attn_block<MASK, true, 3>(Kc, Vc, qf, j, s, sb, C2, h, c, O, Ol); else if (gm == 1u) attn_block<MASK, true, 1>(Kc, Vc, qf, j, s, sb, C2, h, c, O, Ol); else if (gm == 2u) attn_block<MASK, true, 2>(Kc, Vc, qf, j, s, sb, C2, h, c, O, Ol); }
                        else { if (gm == 3u) attn_block<MASK, false, 3>(Kc, Vc, qf, j, s, sb, C2, h, c, O, Ol); else if (gm == 1u) attn_block<MASK, false, 1>(Kc, Vc, qf, j, s, sb, C2, h, c, O, Ol); else if (gm == 2u) attn_block<MASK, false, 2>(Kc, Vc, qf, j, s, sb, C2, h, c, O, Ol); }
                    } else { if (full) attn_block<MASK, true, 3>(Kc, Vc, qf, j, s, sb, C2, h, c, O, Ol); else attn_block<MASK, false, 3>(Kc, Vc, qf, j, s, sb, C2, h, c, O, Ol); }
                }
                if (j + 1 <= jhi) {
                    *(bf16x8*)(Kl + (cur ^ 1) * 64 * LDT + krow) = rk[(u + 1) % 3]; if (PV) *(bf16x8*)(Vl + (cur ^ 1) * 64 * LDV + vrow) = rv[(u + 1) % 3];
                    int jj = j + 4; if (jj > jhi) jj = jhi;
                    rk[(u + 1) % 3] = *(const bf16x8*)(kbase + (size_t)jj * 4096); if (PV) rv[(u + 1) % 3] = *(const bf16x8*)(vbase + (size_t)jj * 4096);
                }
                SYNC();
            }
        }
    }
}

DEV void attn_task(const Args& a, unsigned char* smem, int li, int item) {
    unsigned char* ws = wsp(a); const int tid = TID, w = tid >> 6, l = tid & 63, h = l >> 4, c = l & 15, tl = c >> 2, hd = c & 3;
    const int bg = item & 3, b = bg >> 1, g = bg & 1, tq = (SEQ / 64 - 1) - (item >> 2), s0 = tq * 64, qblk = tq;
    int s[2], row[2];
#pragma unroll
    for (int G = 0; G < 2; ++G) { s[G] = s0 + 8 * w + 4 * G + tl; row[G] = b * SEQ + s[G]; }
    bf16* Kl = (bf16*)(smem + AT_K); bf16* Vl = (bf16*)(smem + AT_V); float* imps = (float*)(smem + AT_IMP) + w * 1024; unsigned* selm = (unsigned*)(smem + AT_SEL) + w * 32;
    bf16x8 qf[2][2]; float gatec[2], gates[2], gatew[2];
#pragma unroll
    for (int G = 0; G < 2; ++G) { const bf16* qp = (const bf16*)(ws + WS_QN) + (size_t)row[G] * 512 + (g * 4 + hd) * 64 + 8 * h; qf[G][0] = *(const bf16x8*)qp; qf[G][1] = *(const bf16x8*)(qp + 32);
        const float* gp = (const float*)(ws + WS_GATE) + (size_t)row[G] * 24 + (g * 4 + hd) * 3; gatec[G] = gp[0]; gates[G] = gp[1]; gatew[G] = gp[2]; }
    const float* cs = (const float*)(ws + WS_CS) + li * 4;
    const int srow = tid >> 3, scol = (tid & 7) * 8;
    for (int i = l; i < 1024; i += 64) imps[i] = 0.f;
    SYNC();
    unsigned* gselm = (unsigned*)(smem + AT_GSEL) + w * 8; float* outl = (float*)(smem + AT_OUT) + w * 2048 + l;
    ImpState im{{{0.f, 0.f, 0.f, 0.f}, {0.f, 0.f, 0.f, 0.f}}, {0.f, 0.f}, imps, tl, hd, l, s0, qblk};
    {
        const int ncv = s0 / 16 + 3, ncb0 = (ncv + 63) >> 6, ncb = ncb0 > NCP / 64 ? NCP / 64 : ncb0;
        const bf16* kcb = (const bf16*)(ws + WS_KC) + (size_t)bg * NCP * 64 + tid * 8;
        const bf16* vcb = (const bf16*)(ws + WS_VCT) + (size_t)bg * NCP * 64 + tid * 8;
        f32x4 O[2][4], Ol[2] = {f4zero(), f4zero()};
#pragma unroll
        for (int G = 0; G < 2; ++G)
#pragma unroll
            for (int et = 0; et < 4; ++et) O[G][et] = f4zero();
        attn_branch<0>(Kl, Vl, kcb, vcb, 0, ncb - 1, qf, s, selm, gselm, cs[0], w, h, c, srow, scol, O, Ol, im);
#pragma unroll
        for (int G = 0; G < 2; ++G) { const float lsum = Ol[G][0]; const float invl = lsum > 0.f ? 1.0f / lsum : 0.f;
#pragma unroll
            for (int r = 0; r < 4; ++r) im.invq[G][r] = shfl(invl, 4 * h + r);
#pragma unroll
            for (int et = 0; et < 4; ++et)
#pragma unroll
                for (int r = 0; r < 4; ++r) outl[((G * 4 + et) * 4 + r) * 64] = gatec[G] * invl * O[G][et][r]; }
        f32x4 ld[2] = {f4zero(), f4zero()};
        attn_branch<1>(Kl, Vl, kcb, vcb, 0, ncb - 1, qf, s, selm, gselm, cs[0], w, h, c, srow, scol, O, ld, im);
    }
    WSYNC();
#pragma unroll 1
    for (int G = 0; G < 2; ++G) {
        const int tk = l >> 4, i = l & 15; float vals[8];
#pragma unroll
        for (int mm = 0; mm < 8; ++mm) { const int jj = i + 16 * mm; vals[mm] = jj > qblk ? NEGV : ((jj == 0 || jj == qblk || jj == qblk - 1) ? FORCEV : imps[(G * 4 + tk) * 128 + jj]); }
        unsigned mk[4] = {0u, 0u, 0u, 0u};
#pragma unroll 1
        for (int rnd = 0; rnd < 16; ++rnd) {
            float best = vals[0]; int bj = i;
#pragma unroll
            for (int mm = 1; mm < 8; ++mm) if (vals[mm] > best) { best = vals[mm]; bj = i + 16 * mm; }
#pragma unroll
            for (int o = 1; o < 16; o <<= 1) { const float ov = shflx(best, o); const int oj = shflxi(bj, o); if (ov > best || (ov == best && oj < bj)) { best = ov; bj = oj; } }
            if (best > NEGV * 0.5f) {
#pragma unroll
                for (int q = 0; q < 4; ++q) if ((bj >> 5) == q) mk[q] |= 1u << (bj & 31); }
            if ((bj & 15) == i) {
#pragma unroll
                for (int mm = 0; mm < 8; ++mm) if ((bj >> 4) == mm) vals[mm] = -3e38f; }
        }
        if (i == 0) {
#pragma unroll
            for (int q = 0; q < 4; ++q) selm[(G * 4 + tk) * 4 + q] = mk[q]; }
    }
    WSYNC();
    if (l < 8) { const int G = l >> 2, q = l & 3; gselm[l] = selm[(G * 4 + 0) * 4 + q] | selm[(G * 4 + 1) * 4 + q] | selm[(G * 4 + 2) * 4 + q] | selm[(G * 4 + 3) * 4 + q]; }
    WSYNC();
#pragma unroll
    for (int br = 0; br < 2; ++br) {
        const bf16* kb = (const bf16*)(ws + (br == 0 ? WS_KS : WS_KW)) + (size_t)bg * SEQ * 64 + tid * 8; const bf16* vb = (const bf16*)(ws + (br == 0 ? WS_VST : WS_VWT)) + (size_t)bg * SEQ * 64 + tid * 8;
        f32x4 O[2][4], Ol[2] = {f4zero(), f4zero()};
#pragma unroll
        for (int G = 0; G < 2; ++G)
#pragma unroll
            for (int et = 0; et < 4; ++et) O[G][et] = f4zero();
        if (br == 0) attn_branch<2>(Kl, Vl, kb, vb, 0, qblk, qf, s, selm, gselm, cs[1], w, h, c, srow, scol, O, Ol, im);
        else attn_branch<3>(Kl, Vl, kb, vb, s0 >= 511 ? (s0 - 511) >> 6 : 0, qblk, qf, s, selm, gselm, cs[2], w, h, c, srow, scol, O, Ol, im);
#pragma unroll
        for (int G = 0; G < 2; ++G) { const float lsum = Ol[G][0]; const float sc = (br == 0 ? gates[G] : gatew[G]) * (lsum > 0.f ? 1.0f / lsum : 0.f);
#pragma unroll
            for (int et = 0; et < 4; ++et)
#pragma unroll
                for (int r = 0; r < 4; ++r) outl[((G * 4 + et) * 4 + r) * 64] += sc * O[G][et][r]; }
    }
#pragma unroll
    for (int G = 0; G < 2; ++G) { bf16* dst = (bf16*)(ws + WS_CAT) + (size_t)row[G] * 1024 + (g * 4 + hd) * 64 + 4 * h;
#pragma unroll
        for (int et = 0; et < 4; ++et) { f32x4 o;
#pragma unroll
            for (int r = 0; r < 4; ++r) o[r] = outl[((G * 4 + et) * 4 + r) * 64];
            st_bf4(dst + 16 * et, o); } }
}

constexpr int LDH = 136;
DEV void hg_cumsum(const float* fsrc  , float* segs  , int d, int seg, float (&f)[16], float (&bc)[16], float& bend, float& bmid) {
    float run = 0.f;
#pragma unroll
    for (int i = 0; i < 16; ++i) { f[i] = fsrc[(size_t)(16 * seg + i) * 128 + d]; run += log2f(f[i]); bc[i] = run; }
    SYNC();
    segs[seg * 128 + d] = run;
    SYNC();
    const float s0 = segs[d], s1 = segs[128 + d], s2 = segs[256 + d], s3 = segs[384 + d];
    const float off = seg == 0 ? 0.f : (seg == 1 ? s0 : (seg == 2 ? s0 + s1 : s0 + s1 + s2));
#pragma unroll
    for (int i = 0; i < 16; ++i) bc[i] += off;
    bend = s0 + s1 + s2 + s3; bmid = s0 + s1;
}
DEV void hg_write16(bf16* dstrow  , const float (&v)[16]) {
    u32x4 w0, w1;
#pragma unroll
    for (int q = 0; q < 4; ++q) { w0[q] = pk2(v[2 * q], v[2 * q + 1]); w1[q] = pk2(v[8 + 2 * q], v[8 + 2 * q + 1]); }
    *(u32x4*)dstrow = w0; *(u32x4*)(dstrow + 8) = w1;
}
DEV void hg_h1_task(const Args& a, unsigned char* smem, int task) {
    unsigned char* ws = wsp(a); const int tid = TID, w = tid >> 6, l = tid & 63, h = l >> 4, c = l & 15, d = tid & 127, seg = tid >> 7;
    const int bh = task / NCH, ch = task % NCH;
    bf16* kT = (bf16*)smem; bf16* vT = kT + 128 * LDT; float* segs = (float*)(vT + 128 * LDT);
    const size_t tokb = (size_t)bh * SEQ + ch * 64;
    float f[16], bc[16], bend, bmid;
    const bf16* vs = (const bf16*)(ws + WS_HV) + tokb * 128;
    bf16 vraw[16];
#pragma unroll
    for (int i = 0; i < 16; ++i) vraw[i] = vs[(size_t)(16 * seg + i) * 128 + d];
    hg_cumsum((const float*)(ws + WS_HF) + tokb * 128, segs, d, seg, f, bc, bend, bmid);
    float kv[16];
#pragma unroll
    for (int i = 0; i < 16; ++i) kv[i] = (1.0f - f[i]) * fexp2(bend - bc[i]);
    hg_write16(kT + d * LDT + 16 * seg, kv);
#pragma unroll
    for (int i = 0; i < 16; ++i) kv[i] = bf2f(vraw[i]);
    hg_write16(vT + d * LDT + 16 * seg, kv);
    if (seg == 0) ((float*)(ws + WS_GD))[((size_t)bh * NCH + ch) * 128 + d] = fexp2(bend);
    SYNC();
    f32x4 acc[8];
#pragma unroll
    for (int et = 0; et < 8; ++et) acc[et] = f4zero();
#pragma unroll
    for (int ks = 0; ks < 2; ++ks) { const bf16x8 fa = *(const bf16x8*)(kT + (16 * w + c) * LDT + 32 * ks + 8 * h);
#pragma unroll
        for (int et = 0; et < 8; ++et) acc[et] = mfma16(fa, *(const bf16x8*)(vT + (16 * et + c) * LDT + 32 * ks + 8 * h), acc[et]); }
    float* ut = (float*)(ws + WS_UT) + ((size_t)bh * NCH + ch) * 16384;
#pragma unroll
    for (int et = 0; et < 8; ++et) *(f32x4*)(ut + (size_t)(16 * et + c) * 128 + 16 * w + 4 * h) = acc[et];
    SYNC();
}
DEV void hg_scan_task(const Args& a, int sc) {
    unsigned char* ws = wsp(a); const int bh = sc >> 3, q = (sc & 7) * 512 + TID, e = q >> 5, d0 = (q & 31) * 4;
    const float* ut = (const float*)(ws + WS_UT) + (size_t)bh * NCH * 16384 + (size_t)e * 128 + d0;
    const float* gd = (const float*)(ws + WS_GD) + (size_t)bh * NCH * 128 + d0;
    bf16* st = (bf16*)(ws + WS_ST) + (size_t)bh * NCH * 16384 + (size_t)e * 128 + d0;
    f32x4 S = f4zero();
#pragma unroll 4
    for (int ch = 0; ch < NCH; ++ch) { st_bf4(st + (size_t)ch * 16384, S);
        const f32x4 g = *(const f32x4*)(gd + (size_t)ch * 128), u = *(const f32x4*)(ut + (size_t)ch * 16384);
#pragma unroll
        for (int r = 0; r < 4; ++r) S[r] = g[r] * S[r] + u[r]; }
}
DEV void hg_h3_task(const Args& a, unsigned char* smem, int li, int task) {
    unsigned char* ws = wsp(a); const int tid = TID, w = tid >> 6, l = tid & 63, h = l >> 4, c = l & 15, d = tid & 127, seg = tid >> 7;
    const int bh = task / NCH, ch = task % NCH, b = bh >> 2, hh = bh & 3;
    bf16* At = (bf16*)smem; bf16* Bt = At + 64 * LDH; bf16* Qt = Bt + 64 * LDH; bf16* vT = Qt + 64 * LDH; float* segs = (float*)(vT + 128 * LDT); float* part = segs + 512;
    const size_t tokb = (size_t)bh * SEQ + ch * 64;
    float f[16], bc[16], bend, bmid;
    const bf16* qs = (const bf16*)(ws + WS_HQ) + tokb * 128; const bf16* vs = (const bf16*)(ws + WS_HV) + tokb * 128;
    const int tt = w & 3, eh = w >> 2;
    bf16 qraw[16], vraw[16];
#pragma unroll
    for (int i = 0; i < 16; ++i) { const int t = 16 * seg + i; qraw[i] = qs[(size_t)t * 128 + d]; vraw[i] = vs[(size_t)t * 128 + d]; }
    const bf16* stp = (const bf16*)(ws + WS_ST) + ((size_t)bh * NCH + ch) * 16384;
    bf16x8 stf[4][4];
#pragma unroll
    for (int ks = 0; ks < 4; ++ks)
#pragma unroll
        for (int et = 0; et < 4; ++et) stf[ks][et] = *(const bf16x8*)(stp + (size_t)(64 * eh + 16 * et + c) * 128 + 32 * ks + 8 * h);
    const int tok = b * SEQ + ch * 64 + 16 * tt + c;
    const bf16* hg = (const bf16*)(ws + WS_HGS) + (size_t)tok * 512 + hh * 128;
    u32x2 hgv[4];
#pragma unroll
    for (int et = 0; et < 4; ++et) hgv[et] = *(const u32x2*)(hg + 64 * eh + 16 * et + 4 * h);
    hg_cumsum((const float*)(ws + WS_HF) + tokb * 128, segs, d, seg, f, bc, bend, bmid);
    float vv[16];
#pragma unroll
    for (int i = 0; i < 16; ++i) { const int t = 16 * seg + i; const float q = bf2f(qraw[i]);
        At[t * LDH + d] = (bf16)f2bf(q * fexp2(bc[i] - bmid)); Bt[t * LDH + d] = (bf16)f2bf((1.0f - f[i]) * fexp2(bmid - bc[i])); Qt[t * LDH + d] = (bf16)f2bf(q * fexp2(bc[i]));
        vv[i] = bf2f(vraw[i]); }
    hg_write16(vT + d * LDT + 16 * seg, vv);
    SYNC();
    f32x4 O[4];
#pragma unroll
    for (int et = 0; et < 4; ++et) O[et] = f4zero();
#pragma unroll
    for (int sp = 0; sp < 2; ++sp) {
        if (32 * sp > 16 * tt + 15) continue;
        f32x4 st[2];
#pragma unroll
        for (int u = 0; u < 2; ++u) { st[u] = f4zero(); const int krow = 32 * sp + 8 * (c >> 2) + 4 * u + (c & 3);
#pragma unroll
            for (int ks = 0; ks < 4; ++ks) st[u] = mfma16(*(const bf16x8*)(Bt + krow * LDH + 32 * ks + 8 * h), *(const bf16x8*)(At + (16 * tt + c) * LDH + 32 * ks + 8 * h), st[u]);
#pragma unroll
            for (int r = 0; r < 4; ++r) { const int sk = 32 * sp + 8 * h + 4 * u + r; if (sk > 16 * tt + c) st[u][r] = 0.f; } }
        const bf16x8 pb = pack8(st[0], st[1]);
#pragma unroll
        for (int et = 0; et < 4; ++et) O[et] = mfma16(*(const bf16x8*)(vT + (64 * eh + 16 * et + c) * LDT + 32 * sp + 8 * h), pb, O[et]);
    }
#pragma unroll
    for (int ks = 0; ks < 4; ++ks) { const bf16x8 fq = *(const bf16x8*)(Qt + (16 * tt + c) * LDH + 32 * ks + 8 * h);
#pragma unroll
        for (int et = 0; et < 4; ++et) O[et] = mfma16(stf[ks][et], fq, O[et]); }
    float ss = 0.f;
#pragma unroll
    for (int et = 0; et < 4; ++et)
#pragma unroll
        for (int r = 0; r < 4; ++r) ss += O[et][r] * O[et][r];
    ss += shflx(ss, 16); ss += shflx(ss, 32);
    if (h == 0) part[eh * 64 + 16 * tt + c] = ss;
    SYNC();
    const float rs = frsq((part[16 * tt + c] + part[64 + 16 * tt + c]) * (1.0f / 128.0f) + EPS);
    const float* og = INP(a, I_OG) + li * 128;
    bf16* dst = (bf16*)(ws + WS_CAT) + (size_t)tok * 1024 + 512 + hh * 128;
#pragma unroll
    for (int et = 0; et < 4; ++et) { const int e = 64 * eh + 16 * et + 4 * h; f32x4 o; const f32x4 ogv = *(const f32x4*)(og + e);
        o[0] = O[et][0] * rs * ogv[0] * bf2f(hgv[et][0] & 0xffff); o[1] = O[et][1] * rs * ogv[1] * bf2f(hgv[et][0] >> 16);
        o[2] = O[et][2] * rs * ogv[2] * bf2f(hgv[et][1] & 0xffff); o[3] = O[et][3] * rs * ogv[3] * bf2f(hgv[et][1] >> 16);
        st_bf4(dst + e, o); }
    SYNC();
}

DEV void conv_task(const Args& a, unsigned char* smem, int li, int task) {
    unsigned char* ws = wsp(a); const int tid = TID, w = tid >> 6, lane = tid & 63;
    const bool act = tid < DM / 2; const int c0 = act ? 2 * tid : 0;
    const int t0 = task * 16, b = t0 / SEQ, s0 = t0 % SEQ;
    float* red = (float*)smem;
    const float* dw = INP(a, I_DW) + (size_t)li * 31 * DM + c0;
    float acc[16][2];
    const float b0 = INP(a, I_DWB)[li * DM + c0], b1 = INP(a, I_DWB)[li * DM + c0 + 1];
#pragma unroll
    for (int t = 0; t < 16; ++t) { acc[t][0] = b0; acc[t][1] = b1; }
    const bf16* glu = (const bf16*)(ws + WS_GLU) + (size_t)b * SEQ * DM + c0;
    unsigned uu[46];
    { const bf16* gp = glu + (size_t)(s0 - 30) * DM;
#pragma unroll
    for (int r = 0; r < 46; ++r) { const int si = s0 + r - 30; uu[r] = si >= 0 ? *(const unsigned*)gp : 0u; gp += DM; OPAQUE(gp); } }
    const float* dwp = dw;
#pragma unroll
    for (int j = 0; j < 31; ++j) { const float w0 = dwp[0], w1 = dwp[1]; dwp += DM; OPAQUE(dwp);
#pragma unroll
        for (int t = 0; t < 16; ++t) { const unsigned q = uu[t + j]; acc[t][0] += w0 * bf2f(q & 0xffff); acc[t][1] += w1 * bf2f(q >> 16); } }
    float mean[16], rstd[16];
    SYNC();
#pragma unroll
    for (int t = 0; t < 16; ++t) { float s = act ? acc[t][0] + acc[t][1] : 0.f;
#pragma unroll
        for (int o = 1; o < 64; o <<= 1) s += shflx(s, o);
        if (lane == 0) red[w * 16 + t] = s; }
    SYNC();
#pragma unroll
    for (int t = 0; t < 16; ++t) { float s = 0.f;
#pragma unroll
        for (int q = 0; q < 8; ++q) s += red[q * 16 + t];
        mean[t] = s * (1.0f / DM); }
    SYNC();
#pragma unroll
    for (int t = 0; t < 16; ++t) { const float d0 = acc[t][0] - mean[t], d1 = acc[t][1] - mean[t]; float s = act ? d0 * d0 + d1 * d1 : 0.f;
#pragma unroll
        for (int o = 1; o < 64; o <<= 1) s += shflx(s, o);
        if (lane == 0) red[w * 16 + t] = s; }
    SYNC();
#pragma unroll
    for (int t = 0; t < 16; ++t) { float s = 0.f;
#pragma unroll
        for (int q = 0; q < 8; ++q) s += red[q * 16 + t];
        rstd[t] = frsq(s * (1.0f / DM) + EPS); }
    if (act) {
        const float g0 = INP(a, I_LNG)[li * DM + c0], g1 = INP(a, I_LNG)[li * DM + c0 + 1], e0 = INP(a, I_LNB)[li * DM + c0], e1 = INP(a, I_LNB)[li * DM + c0 + 1];
        bf16* dst = (bf16*)(ws + WS_CAT) + (size_t)t0 * DM + c0;
#pragma unroll
        for (int t = 0; t < 16; ++t) { const float y0 = (acc[t][0] - mean[t]) * rstd[t] * g0 + e0, y1 = (acc[t][1] - mean[t]) * rstd[t] * g1 + e1;
            *(unsigned*)(dst + (size_t)t * DM) = pk2(siluf(y0), siluf(y1)); }
    }
}

constexpr int N_PHASES = 1 + 16 * (DEPTH / 2) + 1;
DEV void phase_decode(int ph, int& l, int& sub) {
    const int q = ph - 1, pair = q >> 4, r = q & 15;
    if (r < 9) { l = 2 * pair; sub = r; } else { l = 2 * pair + 1; const int rr = r - 9; sub = rr < 3 ? rr : rr + 2; }
}
constexpr int LDS_BYTES = 150 * 1024;

DEV void run_phase(const Args& a, unsigned char* smem, int ph) {
#ifndef ONLY
#define ONLY -1
#endif
#define EN(k) (ONLY < 0 || ONLY == (k))
    if (ph == 0) { if (EN(100)) p0_phase(a, smem); return; }
    if (ph == N_PHASES - 1) { if (EN(0)) norm_phase(a, smem, DEPTH); return; }
    int l, sub; phase_decode(ph, l, sub); const int li = l >> 1; const bool even = (l & 1) == 0;
    unsigned char* ws = wsp(a);
    switch (sub) {
    case 0: if (EN(0)) norm_phase(a, smem, l); break;
    case 1: if (even) { if (EN(1)) inproj_phase(a, smem, li); } else { if (EN(11)) pw1_phase(a, smem, li); } break;
    case 2:
        if (even) { constexpr int NCI = 8 * ((NCP + 255) / 256); constexpr int NH1 = 8 * NCH;
            if (NBLK > 2 * NCI) { const int bid = BID;
                if (bid < NCI) { if (EN(2)) cmp_phase_items(a, smem, li, bid); }
                else { for (int it = bid - NCI; it < NH1; it += NBLK - NCI) if (EN(12)) hg_h1_task(a, smem, it); } }
            else for (int it = BID; it < NCI + NH1; it += NBLK) { if (it < NCI) { if (EN(2)) cmp_phase_items(a, smem, li, it); } else { if (EN(12)) hg_h1_task(a, smem, it - NCI); } } }
        else { for (int it = BID; it < T / 16; it += NBLK) if (EN(13)) conv_task(a, smem, li, it); }
        break;
    case 3:
        if (even) { constexpr int NA = 4 * (SEQ / 64); const int G = NBLK;
            for (int r = 0; r * G < NA; ++r) { const int it = r * G + ((r & 1) ? (G - 1 - BID) : BID); if (it < NA) { if (EN(3)) attn_task(a, smem, li, it); } }
            for (int it = BID; it < 64; it += NBLK) if (EN(14)) hg_scan_task(a, it); }
        break;
    case 4: if (even) { for (int it = BID; it < 8 * NCH; it += NBLK) if (EN(4)) hg_h3_task(a, smem, li, it); } break;
    case 5:
        if (!EN(5)) break;
        if (even) resid_gemm_phase(a, smem, (const bf16*)(ws + WS_CAT), 1024, (const bf16*)(ws + WS_WOUT) + (size_t)li * DM * 1024, l);
        else resid_gemm_phase(a, smem, (const bf16*)(ws + WS_CAT), DM, (const bf16*)(ws + WS_PW2) + (size_t)li * DM * DM, l);
        break;
    case 6: if (EN(6)) route_phase(a, smem, l); break;
    case 7: if (EN(7)) moe_gemm_phase(a, smem, l, 0); break;
    case 8: if (EN(8)) moe_gemm_phase(a, smem, l, 1); break;
    }
}

#ifndef EMU
#define LAS __attribute__((address_space(3)))
#define XB_TMO      128
#define XB_XCNT(j)  (256  + 64 * (j))
#define XB_XSUB(j)  (1280 + 64 * (j))
#define XB_XGEN(j)  (2304 + 64 * (j))
#define XB_TOP      3328
#define XB_TOPGEN   3392
#define XCD_BAR_WORDS 3456
#define XB_SPIN_CAP (1u << 22)
__device__ __forceinline__ unsigned xb_ld(unsigned* p)              { return __hip_atomic_load(p, __ATOMIC_RELAXED, __HIP_MEMORY_SCOPE_AGENT); }
__device__ __forceinline__ unsigned xb_add(unsigned* p, unsigned v) { return __hip_atomic_fetch_add(p, v, __ATOMIC_RELAXED, __HIP_MEMORY_SCOPE_AGENT); }
__device__ __forceinline__ unsigned xb_xcc_id() { return (unsigned)__builtin_amdgcn_s_getreg((3 << 11) | 20) & 0xFu; }
#define XB_SPIN(cond, bar) do { unsigned _sp = 0; while (cond) { __builtin_amdgcn_s_sleep(1); \
    if ((++_sp & 255u) == 0u) { if (xb_ld(&(bar)[XB_TMO])) break; if (_sp > XB_SPIN_CAP) { atomicAdd(&(bar)[XB_TMO], 1u); break; } } } } while (0)
struct XcdBarrier { unsigned* bar; unsigned x; volatile LAS unsigned* st; };
__device__ __forceinline__ XcdBarrier xcd_barrier_post(unsigned* bar, volatile LAS unsigned* st) {
    XcdBarrier b; b.bar = bar; b.x = xb_xcc_id(); b.st = st;
    if (threadIdx.x == 0) (void)xb_add(&bar[XB_XCNT(b.x)], 1u);
    return b;
}
__device__ __forceinline__ void xcd_barrier_complete(unsigned* bar, unsigned x, unsigned& nloc, unsigned& nx) {
    const unsigned G = gridDim.x * gridDim.y * gridDim.z;
    unsigned sum, cnt, mine, sp = 0u;
    for (;;) {
        sum = 0u; cnt = 0u; mine = 0u;
#pragma unroll
        for (unsigned j = 0; j < 16; ++j) { const unsigned c = xb_ld(&bar[XB_XCNT(j)]); sum += c; cnt += (c > 0u) ? 1u : 0u; mine = (j == x) ? c : mine; }
        if (sum == G) break;
        __builtin_amdgcn_s_sleep(1);
        if ((++sp & 255u) == 0u) { if (xb_ld(&bar[XB_TMO])) break; if (sp > XB_SPIN_CAP) { atomicAdd(&bar[XB_TMO], 1u); break; } }
    }
    nloc = mine > 0u ? mine : 1u; nx = cnt > 0u ? cnt : 1u;
}
__device__ __forceinline__ void xcd_barrier(const XcdBarrier& b) {
    asm volatile("s_waitcnt vmcnt(0)" ::: "memory");
    __syncthreads();
    if (threadIdx.x == 0) {
        unsigned* bar = b.bar;
        __builtin_amdgcn_s_waitcnt(0);
        unsigned nloc = b.st[0], nx = b.st[1];
        if (nloc == 0u) { xcd_barrier_complete(bar, b.x, nloc, nx); b.st[0] = nloc; b.st[1] = nx; }
        const unsigned old = xb_add(&bar[XB_XSUB(b.x)], 1u);
        const unsigned gen = old / nloc;
        if (old + 1u == (gen + 1u) * nloc) {
            __builtin_amdgcn_fence(__ATOMIC_RELEASE, "agent");
            asm volatile("s_waitcnt vmcnt(0)" ::: "memory");
            const unsigned og = xb_add(&bar[XB_TOP], 1u);
            const unsigned tg = og / nx;
            if (og + 1u == (tg + 1u) * nx) xb_add(&bar[XB_TOPGEN], 1u);
            else XB_SPIN(xb_ld(&bar[XB_TOPGEN]) == tg, bar);
            __builtin_amdgcn_fence(__ATOMIC_ACQUIRE, "agent");
            xb_add(&bar[XB_XGEN(b.x)], 1u);
            asm volatile("s_waitcnt vmcnt(0)" ::: "memory");
        } else {
            XB_SPIN(xb_ld(&bar[XB_XGEN(b.x)]) == gen, bar);
            __builtin_amdgcn_fence(__ATOMIC_ACQUIRE, "agent");
            asm volatile("s_waitcnt vmcnt(0)" ::: "memory");
        }
    }
    __syncthreads();
}

__global__ void __launch_bounds__(NT, 2) mega(Args a) {
    extern __shared__ __attribute__((aligned(16))) unsigned char lds[];
    volatile LAS unsigned* st = (volatile LAS unsigned*)(LAS unsigned char*)(lds + LDS_BYTES - 16);
    if (threadIdx.x < 4) st[threadIdx.x] = 0u;
    __syncthreads();
    unsigned* barw = (unsigned*)(a.ws + WS_BAR);
    XcdBarrier bar = xcd_barrier_post(barw, st);
#pragma unroll 1
    for (int ph = 0; ph < N_PHASES; ++ph) {
        run_phase(a, lds, ph);
#ifdef DUP
        { int lyr = 0, sub = 100; if (ph > 0 && ph < N_PHASES - 1) phase_decode(ph, lyr, sub);
          if (sub == (DUP % 1000) && (ph == 0 || lyr == DUP / 1000) && ph < N_PHASES - 1) { xcd_barrier(bar); run_phase(a, lds, ph); } }
#endif
        if (ph + 1 < N_PHASES) xcd_barrier(bar);
    }
    if (xb_ld(&barw[XB_TMO]) != 0u) {
        const size_t gt = (size_t)blockIdx.x * NT + threadIdx.x, gs = (size_t)gridDim.x * NT;
        for (size_t i = gt; i < (size_t)T * DM; i += gs) a.out[i] = __builtin_nanf("");
    }
}

extern "C" void kernel_launch(void* const* d_in, const int* in_sizes, int n_in, void* d_out, int out_size,
                              void* d_ws, size_t ws_size, hipStream_t stream) {
    static int grid = 0;
    if (grid == 0) {
        int dev = 0, cus = 0;
        if (hipGetDevice(&dev) != hipSuccess || hipDeviceGetAttribute(&cus, hipDeviceAttributeMultiprocessorCount, dev) != hipSuccess) { grid = -1; return; }
        if (hipFuncSetAttribute((const void*)mega, hipFuncAttributeMaxDynamicSharedMemorySize, LDS_BYTES) != hipSuccess) { grid = -1; return; }
        (void)hipGetLastError();
        grid = cus;
        if (n_in != 26 || out_size != T * DM || ws_size < WS_END) { fprintf(stderr, "kernel_launch: unexpected sizes n_in %d out %d ws %zu (need %zu)\n", n_in, out_size, ws_size, (size_t)WS_END); grid = -1; return; }
    }
    if (grid < 0) return;
    (void)hipMemsetAsync((unsigned char*)d_ws + WS_BAR, 0, XCD_BAR_WORDS * 4, stream);
    Args a{};
    for (int i = 0; i < 26; ++i) a.in[i] = (const float*)d_in[i];
    a.out = (float*)d_out; a.ws = (unsigned char*)d_ws;
    hipLaunchKernelGGL(mega, dim3(grid), dim3(NT), LDS_BYTES, stream, a);
}
#endif
```

```cpp
#ifdef EMU
#include "emu.h"
#define DEV static inline
#define MDEV inline
#define OPAQUE(p)
#define OPAQUE2(a, b)
#define TID emu_tid()
#define BID (EB->bid)
#define NBLK (EB->nblk)
#define SYNC() emu_sync_block()
#define WSYNC() emu_sync_wave()
#define mfma16(a, b, c) emu_mfma16(a, b, c)
DEV float shflx(float v, int m) { return emu_shfl_f(v, (emu_tid() & 63) ^ m); }
DEV int shflxi(int v, int m) { return (int)emu_shfl_u((unsigned)v, (emu_tid() & 63) ^ m); }
DEV float shfl(float v, int s) { return emu_shfl_f(v, s); }
DEV float dpp_ror1(float v) { const int l = emu_tid() & 63; return emu_shfl_f(v, (l & 48) | ((l - 1) & 15)); }
DEV int atomic_add_i(int* p, int v) { return __atomic_fetch_add(p, v, __ATOMIC_RELAXED); }
DEV float fexp2(float x) { return exp2f(x); }
DEV float frcp(float x) { return 1.0f / x; }
DEV float frsq(float x) { return 1.0f / sqrtf(x); }
typedef short s16x4 __attribute__((vector_size(8)));
static inline s16x4 emu_tr4(const unsigned short* p) {
    EmuWave& w = EB->wave[emu_tid() >> 6]; int l = emu_tid() & 63;
    const unsigned short** tab = (const unsigned short**)w.a;
    tab[l] = p; emu_sync_wave();
    s16x4 r; int g = l & 48, i = l & 15;
    for (int q = 0; q < 4; ++q) r[q] = (short)tab[g + 4 * q + (i >> 2)][i & 3];
    emu_sync_wave(); return r;
}
#define tr4(p) emu_tr4(p)
#else
#include <hip/hip_runtime.h>
#include <cstdio>
#include <cstdint>
typedef short bf16x8 __attribute__((ext_vector_type(8)));
typedef float f32x4 __attribute__((ext_vector_type(4)));
typedef unsigned u32x4 __attribute__((ext_vector_type(4)));
typedef unsigned u32x2 __attribute__((ext_vector_type(2)));
#define DEV __device__ __forceinline__
#define MDEV __device__ __forceinline__
#define OPAQUE(p) asm volatile("" : "+v"(p))
#define OPAQUE2(a, b) asm volatile("" : "+v"(a), "+v"(b))
DEV int tid_opaque() { int t = (int)threadIdx.x; asm volatile("" : "+v"(t)); return t; }
#define TID tid_opaque()
DEV int bid_opaque() { int b = (int)blockIdx.x; asm volatile("" : "+s"(b)); return b; }
#define BID bid_opaque()
#define NBLK ((int)gridDim.x)
#define SYNC() __syncthreads()
#define WSYNC() __builtin_amdgcn_wave_barrier()
#define mfma16(a, b, c) __builtin_amdgcn_mfma_f32_16x16x32_bf16(a, b, c, 0, 0, 0)
DEV int shflxi(int x, int m) {
    if (m == 1) return __builtin_amdgcn_update_dpp(x, x, 0xB1, 0xf, 0xf, true);
    if (m == 2) return __builtin_amdgcn_update_dpp(x, x, 0x4E, 0xf, 0xf, true);
    if (m == 4) return __builtin_amdgcn_ds_swizzle(x, (4 << 10) | 0x1F);
    if (m == 8) return __builtin_amdgcn_ds_swizzle(x, (8 << 10) | 0x1F);
    if (m == 16) return __builtin_amdgcn_ds_swizzle(x, (16 << 10) | 0x1F);
    if (m == 32) { const auto r = __builtin_amdgcn_permlane32_swap((unsigned)x, (unsigned)x, false, false); return (int)((threadIdx.x & 32) ? r[0] : r[1]); }
    return __shfl_xor(x, m);
}
DEV float shflx(float v, int m) { return __builtin_bit_cast(float, shflxi(__builtin_bit_cast(int, v), m)); }
DEV float dpp_ror1(float v) { return __builtin_bit_cast(float, __builtin_amdgcn_update_dpp(0, __builtin_bit_cast(int, v), 0x121, 0xf, 0xf, false)); }
DEV float shfl(float v, int s) { return __shfl(v, s); }
DEV int atomic_add_i(int* p, int v) { return atomicAdd(p, v); }
DEV float fexp2(float x) { return __builtin_amdgcn_exp2f(x); }
DEV float frcp(float x) { return __builtin_amdgcn_rcpf(x); }
DEV float frsq(float x) { return __builtin_amdgcn_rsqf(x); }
typedef short s16x4 __attribute__((ext_vector_type(4)));
#define tr4(p) __builtin_amdgcn_ds_read_tr16_b64_v4i16((__attribute__((address_space(3))) s16x4*)(p))
#endif

typedef unsigned short bf16;

#ifndef DM
#define DM 1024
#endif
#ifndef SEQ
#define SEQ 8192
#endif
#ifndef FF
#define FF 512
#endif
constexpr int NBATCH = 2, T = NBATCH * SEQ, DEPTH = 4;
constexpr int NIN = 3352, NINP = 3456, NIN8 = 3584;
constexpr int NT = 512;
constexpr int NCH = SEQ / 64;
constexpr int NCP = SEQ / 16;
constexpr int NCMP = NCP - 1;
constexpr int MOE_ROWS = 2 * T + 32 * 256;
constexpr float EPS = 1e-6f, NEGV = -1e30f, FORCEV = 1e4f, LOG2E = 1.4426950408889634f;

constexpr size_t al(size_t x) { return (x + 255) & ~(size_t)255; }
constexpr size_t WS_BAR = 0;
constexpr size_t WS_CNT = 16384;
constexpr size_t WS_MOD = WS_CNT + (size_t)DEPTH * 32 * 256;
constexpr size_t WS_LB = al(WS_MOD + (size_t)DEPTH * 2 * 6 * DM * 4);
constexpr size_t WS_CB = al(WS_LB + 2 * 512 * 4);
constexpr size_t WS_CS = al(WS_CB + 2 * 2 * 8 * 64 * 4);
constexpr size_t WS_WIN = al(WS_CS + 64);
constexpr size_t WS_WOUT = al(WS_WIN + (size_t)2 * NIN8 * DM * 2);
constexpr size_t WS_PW1 = al(WS_WOUT + (size_t)2 * DM * 1024 * 2);
constexpr size_t WS_PW2 = al(WS_PW1 + (size_t)2 * 2 * DM * DM * 2);
constexpr size_t WS_WC = al(WS_PW2 + (size_t)2 * DM * DM * 2);
constexpr size_t WS_W13 = al(WS_WC + (size_t)2 * 2 * 64 * 2048 * 2);
constexpr size_t WS_W2 = al(WS_W13 + 256);
constexpr size_t WS_H = al(WS_W2 + 256);
constexpr size_t WS_QN = al(WS_H + (size_t)T * DM * 2);
constexpr size_t WS_KCG = al(WS_QN + (size_t)T * 512 * 2);
constexpr size_t WS_VCG = al(WS_KCG + (size_t)T * 128 * 2);
constexpr size_t WS_KS = al(WS_VCG + (size_t)T * 128 * 2);
constexpr size_t WS_KW = al(WS_KS + (size_t)T * 128 * 2);
constexpr size_t WS_VST = al(WS_KW + (size_t)T * 128 * 2);
constexpr size_t WS_VWT = al(WS_VST + (size_t)T * 128 * 2);
constexpr size_t WS_KC = al(WS_VWT + (size_t)T * 128 * 2);
constexpr size_t WS_VCT = al(WS_KC + (size_t)4 * NCP * 64 * 2);
constexpr size_t WS_GATE = al(WS_VCT + (size_t)4 * NCP * 64 * 2);
constexpr size_t WS_HQ = al(WS_GATE + (size_t)T * 24 * 4);
constexpr size_t WS_HF = al(WS_HQ + (size_t)T * 512 * 2);
constexpr size_t WS_HV = al(WS_HF + (size_t)T * 512 * 4);
constexpr size_t WS_HGS = al(WS_HV + (size_t)T * 512 * 2);
constexpr size_t WS_UT = al(WS_HGS + (size_t)T * 512 * 2);
constexpr size_t WS_ST = al(WS_UT + (size_t)8 * NCH * 128 * 128 * 4);
constexpr size_t WS_GD = al(WS_ST + (size_t)8 * NCH * 128 * 128 * 2);
constexpr size_t WS_CAT = al(WS_GD + (size_t)8 * NCH * 128 * 4);
constexpr size_t WS_GLU = al(WS_CAT + (size_t)T * 1024 * 2);
constexpr size_t WS_TIE = al(WS_GLU + (size_t)T * DM * 2);
constexpr size_t WS_TIW = al(WS_TIE + (size_t)T * 2 * 4);
constexpr size_t WS_LIST = al(WS_TIW + (size_t)T * 2 * 4);
constexpr size_t WS_ACT = al(WS_LIST + (size_t)32 * T * 4);
constexpr size_t WS_YK = al(WS_ACT + (size_t)MOE_ROWS * FF * 2);
constexpr size_t WS_WTH = al(WS_YK + (size_t)MOE_ROWS * DM * 2);
constexpr size_t WS_WTL = al(WS_WTH + (size_t)DEPTH * 48 * DM * 2);
constexpr size_t WS_AVEC = al(WS_WTL + (size_t)DEPTH * 48 * DM * 2);
constexpr size_t WS_RBIAS = al(WS_AVEC + (size_t)DEPTH * 2 * DM * 4);
constexpr size_t WS_END = al(WS_RBIAS + (size_t)DEPTH * 2 * 48 * 4);

struct Args { const float* in[26]; float* out; unsigned char* ws; };
enum { I_X = 0, I_C, I_ADAW, I_ADAB, I_NMIX, I_NFFN, I_WIN, I_WOUT, I_CWK, I_CWV, I_CPE, I_QG, I_KG, I_LBL, I_OG,
       I_PW1, I_DW, I_DWB, I_LNG, I_LNB, I_PW2, I_WG, I_WE, I_W1, I_W3, I_W2 };

#ifdef EMU
DEV unsigned char* wsp(const Args& a) { return a.ws; }
DEV float* outp(const Args& a) { return a.out; }
#else
DEV unsigned char* launder_ptr(const void* p) { unsigned long long v = (unsigned long long)p; unsigned lo = (unsigned)v, hi = (unsigned)(v >> 32);
    lo = (unsigned)__builtin_amdgcn_readfirstlane((int)lo); hi = (unsigned)__builtin_amdgcn_readfirstlane((int)hi); asm volatile("" : "+s"(lo), "+s"(hi)); typedef __attribute__((address_space(1))) unsigned char* gptr_t; return (unsigned char*)(gptr_t)(((unsigned long long)hi << 32) | lo); }
DEV unsigned char* wsp(const Args& a) { return launder_ptr(a.ws); }
DEV float* outp(const Args& a) { return (float*)launder_ptr(a.out); }
#endif

#ifdef EMU
#define INP(a, X) ((a).in[X])
#else
DEV int zero_opaque() { int z = 0; asm volatile("" : "+s"(z)); return z; }
#define INP(a, X) ((a).in[(X) + zero_opaque()])
#endif

DEV unsigned f2bf(float f) { unsigned u = __builtin_bit_cast(unsigned, f); return (u + 0x7fffu + ((u >> 16) & 1u)) >> 16; }
DEV float bf2f(unsigned h) { return __builtin_bit_cast(float, h << 16); }
#ifdef EMU
DEV unsigned pk2(float lo, float hi) { return f2bf(lo) | (f2bf(hi) << 16); }
#else
typedef float f32x2_t __attribute__((ext_vector_type(2)));
typedef __bf16 bf16x2_t __attribute__((ext_vector_type(2)));
DEV unsigned pk2(float lo, float hi) { f32x2_t v = {lo, hi}; bf16x2_t b = __builtin_convertvector(v, bf16x2_t); return __builtin_bit_cast(unsigned, b); }
#endif
DEV float sigm(float x) { return frcp(1.0f + fexp2(-x * LOG2E)); }
DEV float siluf(float x) { return x * sigm(x); }
DEV f32x4 f4zero() { f32x4 z = {0.f, 0.f, 0.f, 0.f}; return z; }
DEV bf16x8 pack8(f32x4 a, f32x4 b) {
    u32x4 w; w[0] = pk2(a[0], a[1]); w[1] = pk2(a[2], a[3]); w[2] = pk2(b[0], b[1]); w[3] = pk2(b[2], b[3]);
    return __builtin_bit_cast(bf16x8, w);
}
DEV void st_bf8(bf16* p, f32x4 a, f32x4 b) { u32x4 w; w[0] = pk2(a[0], a[1]); w[1] = pk2(a[2], a[3]); w[2] = pk2(b[0], b[1]); w[3] = pk2(b[2], b[3]); *(u32x4*)p = w; }
DEV void st_bf4(bf16* p, f32x4 v) { u32x2 w; w[0] = pk2(v[0], v[1]); w[1] = pk2(v[2], v[3]); *(u32x2*)p = w; }


#ifdef EMU
namespace pg8 {
constexpr int BM = 256, BK = 64, HALF = 128, NXCD = 8, WGM = 8;
typedef unsigned short bf16_t;
struct Unit { int pm, pn; };
struct Gemm { const bf16_t* A; const bf16_t* Bt; int M, N, K; };
struct StaticOrder {
    int nM, nN, nwg, G, c;
    void init(int M, int N, int G_, int c_) { nM = M / BM; nN = N / BM; nwg = nM * nN; G = G_; c = c_; }
    bool next(int i, Unit& u) const {
        const long L = (long)i * G + c; if (L >= nwg) return false;
        int wgid = (int)L; { const int q = nwg / NXCD, r = nwg % NXCD, xcd = wgid % NXCD, off = wgid / NXCD; wgid = (xcd < r ? xcd * (q + 1) : r * (q + 1) + (xcd - r) * q) + off; }
        const int nig = WGM * nN, gid = wgid / nig, fm = gid * WGM, gsz = (nM - fm) < WGM ? (nM - fm) : WGM;
        u.pm = fm + ((wgid % nig) % gsz); u.pn = (wgid % nig) / gsz; return true;
    }
};
template <class Epi, class Sched, bool ALIGN_EPI = false, bool SP2 = false>
static inline void gemm_phase(unsigned char*, const Gemm g, const Sched& S, const Epi& E) {
    const int tid = emu_tid(), wid = tid >> 6, lane = tid & 63, wr = wid >> 2, wc = wid & 3, fr = lane & 15, fq = lane >> 4;
    Unit u;
    for (int ui = 0; S.next(ui, u); ++ui) {
        f32x4 acc[2][2][4][2];
        for (int ai = 0; ai < 2; ++ai) for (int bj = 0; bj < 2; ++bj) for (int m = 0; m < 4; ++m) for (int n = 0; n < 2; ++n) for (int r = 0; r < 4; ++r) {
            const int row = 256 * u.pm + 128 * ai + 64 * wr + 16 * m + fr, col = 256 * u.pn + 128 * bj + 32 * wc + (Epi::PERM ? 8 * fq + 4 * n + r : 16 * n + 4 * fq + r); float sum = 0.f;
            const bf16_t* ap = g.A + (size_t)row * g.K; const bf16_t* bp = g.Bt + (size_t)col * g.K;
            for (int k = 0; k < g.K; ++k) sum += bf2f(ap[k]) * bf2f(bp[k]);
            acc[ai][bj][m][n][r] = sum; }
        E(acc, u, wr, wc, fr, fq);
    }
    emu_sync_block();
}
}
#else
namespace pg8 {
#define PG8_LAS __attribute__((address_space(3)))
typedef unsigned short bf16_t;
typedef short bf16x8 __attribute__((ext_vector_type(8)));
typedef float f32x4 __attribute__((ext_vector_type(4)));
typedef unsigned u32x4 __attribute__((ext_vector_type(4)));
constexpr int BM = 256, BK = 64, HALF = 128, HTB = HALF * BK * 2  , STAGE_BYTES = 8 * HTB, NXCD = 8, WGM = 8;

__host__ __device__ __forceinline__ int lds_byte(int r, int c) { const int st = (r >> 4) * 2 + (c >> 5), rr = r & 15, cc = c & 31, ob = rr * 64 + cc * 2; return st * 1024 + (ob ^ (((ob >> 9) & 1) << 5)); }
__host__ __device__ __forceinline__ void stage_rc(int b, int& R, int& C) { const int st = b / 1024, sb = b % 1024, swz = sb ^ (((sb >> 9) & 1) << 5); R = (st >> 1) * 16 + swz / 64; C = (st & 1) * 32 + (swz % 64) / 2; }
__host__ __device__ __forceinline__ int perm32(int rho) { const int n = rho >> 4, i = rho & 15; return 8 * (i >> 2) + 4 * n + (i & 3); }

struct Unit { int pm, pn; };
struct Gemm { const bf16_t* A; const bf16_t* Bt; int M, N, K; };

struct StaticOrder {
    int nM, nN, nwg, G, c;
    __host__ __device__ void init(int M, int N, int G_, int c_) { nM = M / BM; nN = N / BM; nwg = nM * nN; G = G_; c = c_; }
    __host__ __device__ bool next(int i, Unit& u) const {
        const long L = (long)i * G + c; if (L >= nwg) return false;
        int wgid = (int)L; { const int q = nwg / NXCD, r = nwg % NXCD, xcd = wgid % NXCD, off = wgid / NXCD; wgid = (xcd < r ? xcd * (q + 1) : r * (q + 1) + (xcd - r) * q) + off; }
        const int nig = WGM * nN, gid = wgid / nig, fm = gid * WGM, gsz = (nM - fm) < WGM ? (nM - fm) : WGM;
        u.pm = fm + ((wgid % nig) % gsz); u.pn = (wgid % nig) / gsz; return true;
    }
    __device__ __forceinline__ void a_ready(const Unit&) const {}
    __device__ __forceinline__ void done(const Unit&) const {}
};

__device__ __forceinline__ unsigned cvt_pk_bf16(float lo, float hi) { unsigned r; asm volatile("v_cvt_pk_bf16_f32 %0, %1, %2" : "=v"(r) : "v"(lo), "v"(hi)); return r; }
template <class Epi, class Sched, bool ALIGN_EPI = false, bool SP2 = false>
__device__ __forceinline__ void gemm_phase(PG8_LAS unsigned char* lds, const Gemm g, const Sched& S, const Epi& E) {
    const int tid = TID, wid = __builtin_amdgcn_readfirstlane(tid >> 6), lane = tid & 63, wr = wid >> 2, wc = wid & 3, fr = lane & 15, fq = lane >> 4;
    const int K = g.K, nt = K / BK;
    unsigned voffA[2], voffB[2];
#pragma unroll
    for (int i = 0; i < 2; ++i) { int R, C; stage_rc(tid * 16 + i * 8192, R, C); const int Rb = Epi::PERM ? ((R & ~31) + perm32(R & 31)) : R;
        voffA[i] = (unsigned)(R * K + C) * 2u; voffB[i] = (unsigned)(Rb * K + C) * 2u; }
    const size_t kstep = (size_t)(BK * 2);
    const size_t hstep = (size_t)HALF * K * 2;
    const size_t tstep = 2 * hstep;
    const unsigned ldsw = (unsigned)wid * 1024u;
    const int aoff = lds_byte(wr * 64 + fr, fq * 8), boff = lds_byte(wc * 32 + fr, fq * 8);
#define PG8_SA(b, h) (((b) * 2 + (h)) * HTB)
#define PG8_SB(b, h) ((4 + (b) * 2 + (h)) * HTB)
#define PG8_STAGE(bufoff, gbase, voff) do { _Pragma("unroll") for (int _i = 0; _i < 2; ++_i) \
        __builtin_amdgcn_global_load_lds((const unsigned*)((const char*)(gbase) + (voff)[_i]), (PG8_LAS unsigned*)(lds + (bufoff) + ldsw + _i * 8192), 16, 0, 0); } while (0)
#define PG8_LDA(dst, b, h) do { _Pragma("unroll") for (int m = 0; m < 4; ++m) _Pragma("unroll") for (int k = 0; k < 2; ++k) dst[m][k] = *(const PG8_LAS bf16x8*)(lds + PG8_SA(b, h) + aoff + m * 2048 + k * 1024); } while (0)
#define PG8_LDB(dst, b, h) do { _Pragma("unroll") for (int n = 0; n < 2; ++n) _Pragma("unroll") for (int k = 0; k < 2; ++k) dst[n][k] = *(const PG8_LAS bf16x8*)(lds + PG8_SB(b, h) + boff + n * 2048 + k * 1024); } while (0)
#define PG8_MMA(ai, bj, At, Bt) do { __builtin_amdgcn_s_setprio(1); _Pragma("unroll") for (int m = 0; m < 4; ++m) _Pragma("unroll") for (int n = 0; n < 2; ++n) _Pragma("unroll") for (int k = 0; k < 2; ++k) \
        acc[ai][bj][m][n] = __builtin_amdgcn_mfma_f32_16x16x32_bf16(Bt[n][k], At[m][k], acc[ai][bj][m][n], 0, 0, 0); __builtin_amdgcn_s_setprio(0); } while (0)
#define PG8_WAIT_V(n) asm volatile("s_waitcnt vmcnt(" #n ")" ::: "memory")
#define PG8_WAIT_L(n) asm volatile("s_waitcnt lgkmcnt(" #n ")" ::: "memory")
#define PG8_BAR __builtin_amdgcn_s_barrier()
#define PG8_SCHED __builtin_amdgcn_sched_barrier(0)
    Unit cur, nxt; int ui = 0;
    if (!S.next(0, cur)) return;
    f32x4 acc[2][2][4][2];
#pragma unroll
    for (int a = 0; a < 2; ++a)
#pragma unroll
        for (int b = 0; b < 2; ++b)
#pragma unroll
            for (int m = 0; m < 4; ++m)
#pragma unroll
                for (int n = 0; n < 2; ++n) acc[a][b][m][n] = (f32x4){0.f, 0.f, 0.f, 0.f};
    bf16x8 At[4][2], B0[2][2], B1[2][2];
    const char* cA = (const char*)g.A + (size_t)cur.pm * tstep; const char* cB = (const char*)g.Bt + (size_t)cur.pn * tstep;
    S.a_ready(cur);
    if constexpr (SP2) {
        PG8_STAGE(PG8_SB(0, 0), cB, voffB); PG8_STAGE(PG8_SB(0, 1), cB + hstep, voffB); PG8_STAGE(PG8_SA(0, 0), cA, voffA); PG8_STAGE(PG8_SA(0, 1), cA + hstep, voffA);
        if (wr == 1) PG8_BAR;
        PG8_WAIT_V(2); PG8_BAR;
        PG8_STAGE(PG8_SB(1, 0), cB + kstep, voffB); PG8_STAGE(PG8_SA(1, 0), cA + kstep, voffA); PG8_STAGE(PG8_SB(1, 1), cB + hstep + kstep, voffB);
        PG8_WAIT_V(6); PG8_BAR;
    } else {
        PG8_STAGE(PG8_SB(0, 0), cB, voffB); PG8_STAGE(PG8_SA(0, 0), cA, voffA); PG8_STAGE(PG8_SB(0, 1), cB + hstep, voffB); PG8_STAGE(PG8_SA(0, 1), cA + hstep, voffA);
        if (wr == 1) PG8_BAR;
        PG8_WAIT_V(4); PG8_BAR;
        PG8_STAGE(PG8_SB(1, 0), cB + kstep, voffB); PG8_STAGE(PG8_SA(1, 0), cA + kstep, voffA); PG8_STAGE(PG8_SB(1, 1), cB + hstep + kstep, voffB);
        PG8_WAIT_V(6); PG8_BAR;
    }
    for (;;) {
        const bool has_next = S.next(ui + 1, nxt);
        const char* nA = has_next ? (const char*)g.A + (size_t)nxt.pm * tstep : cA; const char* nB = has_next ? (const char*)g.Bt + (size_t)nxt.pn * tstep : cB;
        for (int t = 0; t < nt; t += 2) {
            const bool last = (t == nt - 2);
            const char* a1 = cA + (size_t)(t + 1) * kstep;
            const char* a2 = last ? nA : cA + (size_t)(t + 2) * kstep; const char* b2 = last ? nB : cB + (size_t)(t + 2) * kstep;
            const char* a3 = a2 + kstep; const char* b3 = b2 + kstep;
            if (last && has_next) S.a_ready(nxt);
            if constexpr (SP2) {
            PG8_LDB(B0, 0, 0); PG8_LDB(B1, 0, 1); PG8_SCHED; PG8_LDA(At, 0, 0); PG8_STAGE(PG8_SA(1, 1), a1 + hstep, voffA);
            PG8_WAIT_V(8); PG8_WAIT_L(0); PG8_BAR; PG8_MMA(0, 0, At, B0); PG8_MMA(0, 1, At, B1); PG8_BAR; PG8_SCHED;
            PG8_LDA(At, 0, 1); PG8_STAGE(PG8_SB(0, 0), b2, voffB); PG8_STAGE(PG8_SB(0, 1), b2 + hstep, voffB); PG8_STAGE(PG8_SA(0, 0), a2, voffA);
            PG8_WAIT_V(8); PG8_WAIT_L(0); PG8_BAR; PG8_MMA(1, 0, At, B0); PG8_MMA(1, 1, At, B1); PG8_BAR; PG8_SCHED;
            PG8_LDB(B0, 1, 0); PG8_LDB(B1, 1, 1); PG8_SCHED; PG8_LDA(At, 1, 0); PG8_STAGE(PG8_SA(0, 1), a2 + hstep, voffA);
            PG8_WAIT_V(8); PG8_WAIT_L(0); PG8_BAR; PG8_MMA(0, 0, At, B0); PG8_MMA(0, 1, At, B1); PG8_BAR; PG8_SCHED;
            PG8_LDA(At, 1, 1); PG8_STAGE(PG8_SB(1, 0), b3, voffB); PG8_STAGE(PG8_SB(1, 1), b3 + hstep, voffB); PG8_STAGE(PG8_SA(1, 0), a3, voffA);
            PG8_WAIT_V(8); PG8_WAIT_L(0); PG8_BAR; PG8_MMA(1, 0, At, B0); PG8_MMA(1, 1, At, B1); PG8_BAR; PG8_SCHED;
            } else {
            PG8_LDB(B0, 0, 0); PG8_SCHED; PG8_LDA(At, 0, 0); PG8_STAGE(PG8_SA(1, 1), a1 + hstep, voffA);
            PG8_WAIT_L(8); PG8_BAR; PG8_WAIT_L(0); PG8_MMA(0, 0, At, B0); PG8_BAR; PG8_SCHED;
            PG8_LDB(B1, 0, 1); PG8_STAGE(PG8_SB(0, 0), b2, voffB);
            PG8_BAR; PG8_WAIT_L(0); PG8_MMA(0, 1, At, B1); PG8_BAR;
            PG8_LDA(At, 0, 1); PG8_STAGE(PG8_SA(0, 0), a2, voffA);
            PG8_BAR; PG8_WAIT_L(0); PG8_MMA(1, 0, At, B0); PG8_BAR; PG8_SCHED;
            PG8_STAGE(PG8_SB(0, 1), b2 + hstep, voffB);
            PG8_WAIT_V(6); PG8_BAR; PG8_MMA(1, 1, At, B1); PG8_BAR;
            PG8_LDB(B0, 1, 0); PG8_SCHED; PG8_LDA(At, 1, 0); PG8_STAGE(PG8_SA(0, 1), a2 + hstep, voffA);
            PG8_WAIT_L(8); PG8_BAR; PG8_WAIT_L(0); PG8_MMA(0, 0, At, B0); PG8_BAR; PG8_SCHED;
            PG8_LDB(B1, 1, 1); PG8_STAGE(PG8_SB(1, 0), b3, voffB);
            PG8_BAR; PG8_WAIT_L(0); PG8_MMA(0, 1, At, B1); PG8_BAR;
            PG8_LDA(At, 1, 1); PG8_STAGE(PG8_SA(1, 0), a3, voffA);
            PG8_BAR; PG8_WAIT_L(0); PG8_MMA(1, 0, At, B0); PG8_BAR; PG8_SCHED;
            PG8_STAGE(PG8_SB(1, 1), b3 + hstep, voffB);
            PG8_WAIT_V(6); PG8_BAR; PG8_MMA(1, 1, At, B1); PG8_BAR;
            }
        }
        if constexpr (ALIGN_EPI) { if (wr == 0) PG8_BAR; }
        if constexpr (!Epi::AFTER_DRAIN) { E(acc, cur, wr, wc, fr, fq); S.done(cur); }
        if (!has_next) break;
#pragma unroll
        for (int a = 0; a < 2; ++a)
#pragma unroll
            for (int b = 0; b < 2; ++b)
#pragma unroll
                for (int m = 0; m < 4; ++m)
#pragma unroll
                    for (int n = 0; n < 2; ++n) acc[a][b][m][n] = (f32x4){0.f, 0.f, 0.f, 0.f};
        cur = nxt; cA = nA; cB = nB; ++ui;
        if constexpr (ALIGN_EPI) { if (wr == 1) PG8_BAR; }
    }
    PG8_WAIT_V(0);
    if constexpr (!ALIGN_EPI) { if (wr == 0) PG8_BAR; }
    PG8_BAR;
    if constexpr (Epi::AFTER_DRAIN) { E.fused(acc, cur, wr, wc, fr, fq, lds, wid, lane); S.done(cur); }
#undef PG8_SA
#undef PG8_SB
#undef PG8_STAGE
#undef PG8_LDA
#undef PG8_LDB
#undef PG8_MMA
#undef PG8_WAIT_V
#undef PG8_WAIT_L
#undef PG8_BAR
#undef PG8_SCHED
}
}
#endif

constexpr int LDT = 72;
constexpr int GEMM_AS = 256 * LDT, GEMM_BS = 128 * LDT;
constexpr int GEMM_LDS = 2 * (GEMM_AS + GEMM_BS) * 2;

template <class AF, class EPI>
DEV void gemm_tile(unsigned char* smem, AF af, const bf16* Bt, int ldb, int nvalid, int K, EPI& epi) {
    const int tid = TID, w = tid >> 6, l = tid & 63, h = l >> 4, c = l & 15, wm = w >> 1, wn = w & 1;
    bf16* As = (bf16*)smem; bf16* Bs = As + 2 * GEMM_AS;
    const bf16* ap[4]; const bf16* bp[2];
    const int col8 = (tid & 7) * 8, r0 = tid >> 3;
#pragma unroll
    for (int i = 0; i < 4; ++i) ap[i] = af(r0 + 64 * i) + col8;
#pragma unroll
    for (int i = 0; i < 2; ++i) { int rn = r0 + 64 * i; if (rn >= nvalid) rn = nvalid - 1; bp[i] = Bt + (size_t)rn * ldb + col8; }
    f32x4 acc[4][4];
#pragma unroll
    for (int i = 0; i < 4; ++i)
#pragma unroll
        for (int j = 0; j < 4; ++j) acc[i][j] = f4zero();
    bf16x8 ra[4], rb[2];
#pragma unroll
    for (int i = 0; i < 4; ++i) ra[i] = *(const bf16x8*)(ap[i]);
#pragma unroll
    for (int i = 0; i < 2; ++i) rb[i] = *(const bf16x8*)(bp[i]);
    SYNC();
#pragma unroll
    for (int i = 0; i < 4; ++i) *(bf16x8*)(As + (r0 + 64 * i) * LDT + col8) = ra[i];
#pragma unroll
    for (int i = 0; i < 2; ++i) *(bf16x8*)(Bs + (r0 + 64 * i) * LDT + col8) = rb[i];
    SYNC();
    const int nk = K / 64;
    for (int kt = 0; kt < nk; ++kt) {
        const int cur = kt & 1;
        if (kt + 1 < nk) {
#pragma unroll
            for (int i = 0; i < 4; ++i) ra[i] = *(const bf16x8*)(ap[i] + (kt + 1) * 64);
#pragma unroll
            for (int i = 0; i < 2; ++i) rb[i] = *(const bf16x8*)(bp[i] + (kt + 1) * 64);
        }
        const bf16* Ac = As + cur * GEMM_AS + (wm * 64 + c) * LDT + 8 * h;
        const bf16* Bc = Bs + cur * GEMM_BS + (wn * 64 + c) * LDT + 8 * h;
#pragma unroll
        for (int kk = 0; kk < 2; ++kk) {
            bf16x8 fa[4], fb[4];
#pragma unroll
            for (int i = 0; i < 4; ++i) { fa[i] = *(const bf16x8*)(Ac + i * 16 * LDT + kk * 32); fb[i] = *(const bf16x8*)(Bc + i * 16 * LDT + kk * 32); }
#pragma unroll
            for (int ni = 0; ni < 4; ++ni)
#pragma unroll
                for (int mi = 0; mi < 4; ++mi) acc[ni][mi] = mfma16(fb[ni], fa[mi], acc[ni][mi]);
        }
        if (kt + 1 < nk) {
            const int nx = cur ^ 1;
#pragma unroll
            for (int i = 0; i < 4; ++i) *(bf16x8*)(As + nx * GEMM_AS + (r0 + 64 * i) * LDT + col8) = ra[i];
#pragma unroll
            for (int i = 0; i < 2; ++i) *(bf16x8*)(Bs + nx * GEMM_BS + (r0 + 64 * i) * LDT + col8) = rb[i];
        }
        SYNC();
    }
    epi(acc, wm * 64, wn * 64, h, c);
}

struct ARows { const bf16* base; size_t ld; MDEV const bf16* operator()(int r) const { return base + (size_t)r * ld; } MDEV unsigned off(int r) const { return (unsigned)r * (unsigned)ld; } };

constexpr int LDB = 144;
constexpr int GEMM_BS2 = 64 * LDB;
constexpr int GEMM2_LDS = (2 * GEMM_AS + 2 * GEMM_BS2) * 2;
DEV bf16x8 tr_read8(const bf16* p0, const bf16* p1) {
    const s16x4 x = tr4(p0), y = tr4(p1); bf16x8 r;
    r[0] = x[0]; r[1] = x[1]; r[2] = x[2]; r[3] = x[3]; r[4] = y[0]; r[5] = y[1]; r[6] = y[2]; r[7] = y[3]; return r;
}
DEV int bperm(int r) { return (r & ~12) | ((r & 4) << 1) | ((r & 8) >> 1); }
template <class AF, class BF, class EPI>
DEV void gemm_tile2(unsigned char* smem, AF af, BF bf, int ldb, int K, EPI& epi) {
    const int tid = TID, w = tid >> 6, l = tid & 63, h = l >> 4, c = l & 15, wm = w >> 1, wn = w & 1, grp = w >> 2;
    bf16* As = (bf16*)smem; bf16* Bs = As + 2 * GEMM_AS;
    const bf16* abase = af.base; unsigned ao[4];
    const int col8 = (tid & 7) * 8, r0 = tid >> 3;
#pragma unroll
    for (int i = 0; i < 4; ++i) ao[i] = af.off(r0 + 64 * i) + col8;
    const int bn4 = (tid & 31) * 4, bk = tid >> 5, bkp = bperm(bk);
    const float* bp = bf(bn4); const bool bok = bp != nullptr;
    if (bok) bp += (size_t)bk * ldb;
    const size_t bstep = (size_t)16 * ldb;
    f32x4 acc[4][4];
#pragma unroll
    for (int i = 0; i < 4; ++i)
#pragma unroll
        for (int j = 0; j < 4; ++j) acc[i][j] = f4zero();
    bf16x8 ra[4]; f32x4 rb[4];
    const int nk = K / 64;
#pragma unroll
    for (int i = 0; i < 4; ++i) { ra[i] = *(const bf16x8*)(abase + ao[i]); rb[i] = bok ? *(const f32x4*)(bp + i * bstep) : f4zero(); }
    SYNC();
#pragma unroll
    for (int i = 0; i < 4; ++i) { *(bf16x8*)(As + (r0 + 64 * i) * LDT + col8) = ra[i]; st_bf4(Bs + (bkp + 16 * i) * LDB + bn4, rb[i]); }
    if (nk > 1) {
#pragma unroll
        for (int i = 0; i < 4; ++i) { ra[i] = *(const bf16x8*)(abase + (ao[i] + 64)); rb[i] = bok ? *(const f32x4*)(bp + (size_t)64 * ldb + i * bstep) : f4zero(); } }
    SYNC();
    for (int kt = 0; kt < nk; ++kt) {
        const int cur = kt & 1;
#pragma unroll
        for (int p = 0; p < 2; ++p) {
            if (grp == p) {
                const bf16* Ac = As + cur * GEMM_AS + (wm * 64 + c) * LDT + 8 * h;
                const bf16* Bc = Bs + cur * GEMM_BS2 + bperm(8 * h + (c >> 2)) * LDB + wn * 64 + 4 * (c & 3);
#pragma unroll
                for (int kk = 0; kk < 2; ++kk) {
                    bf16x8 fa[4], fb[4];
#pragma unroll
                    for (int i = 0; i < 4; ++i) { fa[i] = *(const bf16x8*)(Ac + i * 16 * LDT + kk * 32); fb[i] = tr_read8(Bc + (32 * kk) * LDB + 16 * i, Bc + (32 * kk + 8) * LDB + 16 * i); }
#pragma unroll
                    for (int ni = 0; ni < 4; ++ni)
#pragma unroll
                        for (int mi = 0; mi < 4; ++mi) acc[ni][mi] = mfma16(fb[ni], fa[mi], acc[ni][mi]);
                }
            } else if (kt + 1 < nk) {
                const int nx = cur ^ 1;
#pragma unroll
                for (int i = 0; i < 4; ++i) { *(bf16x8*)(As + nx * GEMM_AS + (r0 + 64 * i) * LDT + col8) = ra[i]; st_bf4(Bs + nx * GEMM_BS2 + (bkp + 16 * i) * LDB + bn4, rb[i]); }
                if (kt + 2 < nk) {
#pragma unroll
                    for (int i = 0; i < 4; ++i) { ra[i] = *(const bf16x8*)(abase + (ao[i] + (kt + 2) * 64)); rb[i] = bok ? *(const f32x4*)(bp + (size_t)(kt + 2) * 64 * ldb + i * bstep) : f4zero(); } }
            }
            SYNC();
        }
    }
    epi(acc, wm * 64, wn * 64, h, c);
}
struct BPlain { const float* base; MDEV const float* operator()(int nt) const { return base + nt; } };
struct BInProjMap { const float* base; int n0; MDEV const float* operator()(int nt) const { const int n = n0 + nt; const int sc = n < 1280 ? n : (n < 3328 ? n + 24 : (n < 3352 ? 1280 + (n - 3328) : -1)); return sc < 0 ? nullptr : base + sc; } };
struct BInter { const float* s0; const float* s1; int n0; MDEV const float* operator()(int nt) const { const int n = n0 + nt, g = n >> 6, w = n & 63; return w < 32 ? s0 + g * 32 + w : s1 + g * 32 + w - 32; } };
struct BClamp64 { const float* base; MDEV const float* operator()(int nt) const { return base + (nt & 63); } };

struct EpiInProj {
    const Args* a; int m0, n0, li;
    MDEV void operator()(f32x4 (&acc)[4][4], int mw, int nw, int h, int c) const {
        unsigned char* ws = wsp(*a);
        const int nb = n0 + nw;
        const int tokb = m0 + mw + c;
        if (nb < 512 || (nb >= 768 && nb < 896) || (nb >= 1024 && nb < 1152)) {
            const float* gain; float mul = 1.f; bf16* dst; int kind;
            if (nb < 512) { gain = INP(*a, I_QG) + li * 64; mul = 0.125f * LOG2E; kind = 0; dst = (bf16*)(ws + WS_QN); }
            else if (nb < 896) { gain = INP(*a, I_KG) + (li * 3 + 1) * 64; kind = 1; dst = (bf16*)(ws + WS_KS); }
            else { gain = INP(*a, I_KG) + (li * 3 + 2) * 64; kind = 1; dst = (bf16*)(ws + WS_KW); }
            const int g = (nb >> 6) & 1;
#pragma unroll
            for (int mi = 0; mi < 4; ++mi) {
                float ss = 0.f;
#pragma unroll
                for (int ni = 0; ni < 4; ++ni) { f32x4 v = acc[ni][mi]; ss += v[0] * v[0] + v[1] * v[1] + v[2] * v[2] + v[3] * v[3]; }
                ss += shflx(ss, 16); ss += shflx(ss, 32);
                const float rs = frsq(ss * (1.0f / 64.0f) + EPS) * mul;
                const int tok = tokb + 16 * mi;
#pragma unroll
                for (int ni = 0; ni < 4; ++ni) {
                    const int d = 16 * ni + 4 * h; f32x4 v = acc[ni][mi], o;
#pragma unroll
                    for (int r = 0; r < 4; ++r) o[r] = v[r] * rs * gain[d + r];
                    if (kind == 0) st_bf4(dst + (size_t)tok * 512 + nb + d, o);
                    else { const int b = tok / SEQ, s = tok % SEQ; st_bf4(dst + ((size_t)(b * 2 + g) * SEQ + s) * 64 + d, o); }
                }
            }
        } else if (nb < 768) {
            bf16* dst = (bf16*)(ws + (nb < 640 ? WS_KCG : WS_VCG)); const int g = (nb >> 6) & 1;
#pragma unroll
            for (int mi = 0; mi < 4; ++mi) { const int tok = tokb + 16 * mi, b = tok / SEQ, s = tok % SEQ;
#pragma unroll
                for (int ni = 0; ni < 4; ++ni) st_bf4(dst + ((size_t)(b * 2 + g) * SEQ + s) * 64 + 16 * ni + 4 * h, acc[ni][mi]); }
        } else if (nb < 1280) {
            bf16* dst = (bf16*)(ws + (nb < 1024 ? WS_VST : WS_VWT)); const int g = (nb >> 6) & 1;
#pragma unroll
            for (int mi = 0; mi < 4; ++mi) { const int tok = tokb + 16 * mi, b = tok / SEQ, s = tok % SEQ;
                bf16* p = dst + ((size_t)(b * 2 + g) * NCH + (s >> 6)) * 4096 + (s & 63);
#pragma unroll
                for (int ni = 0; ni < 4; ++ni)
#pragma unroll
                    for (int r = 0; r < 4; ++r) p[(16 * ni + 4 * h + r) * 64] = (bf16)f2bf(acc[ni][mi][r]); }
        } else if (nb < 3328) {
            const int sec = (nb - 1280) >> 9, cc = (nb - 1280) & 511, hh = cc >> 7, d0 = cc & 127;
#pragma unroll
            for (int mi = 0; mi < 4; ++mi) { const int tok = tokb + 16 * mi, b = tok / SEQ, s = tok % SEQ;
                const size_t hrow = ((size_t)(b * 4 + hh) * SEQ + s) * 128 + d0;
#pragma unroll
                for (int ni = 0; ni < 4; ++ni) { const int d = 16 * ni + 4 * h; f32x4 v = acc[ni][mi], o;
                    if (sec == 0) { for (int r = 0; r < 4; ++r) o[r] = siluf(v[r]); st_bf4((bf16*)(ws + WS_HQ) + hrow + d, o); }
                    else if (sec == 1) { const float* lb = (const float*)(ws + WS_LB) + li * 512 + cc + d;
                        for (int r = 0; r < 4; ++r) o[r] = lb[r] + (1.0f - lb[r]) * sigm(v[r]);
                        *(f32x4*)((float*)(ws + WS_HF) + hrow + d) = o; }
                    else if (sec == 2) st_bf4((bf16*)(ws + WS_HV) + hrow + d, v);
                    else { for (int r = 0; r < 4; ++r) o[r] = siluf(v[r]); st_bf4((bf16*)(ws + WS_HGS) + (size_t)tok * 512 + cc + d, o); }
                } }
        } else if (nb == 3328) {
            float* dst = (float*)(ws + WS_GATE);
#pragma unroll
            for (int mi = 0; mi < 4; ++mi) { const int tok = tokb + 16 * mi;
#pragma unroll
                for (int ni = 0; ni < 2; ++ni)
#pragma unroll
                    for (int r = 0; r < 4; ++r) { const int n = 16 * ni + 4 * h + r; if (n < 24) dst[(size_t)tok * 24 + n] = sigm(acc[ni][mi][r]); } }
        }
    }
};

struct EpiResid {
    float* x; const float* gate; int m0, n0;
    MDEV void operator()(f32x4 (&acc)[4][4], int mw, int nw, int h, int c) const {
#pragma unroll
        for (int mi = 0; mi < 4; ++mi) { const int tok = m0 + mw + 16 * mi + c, b = tok / SEQ;
#pragma unroll
            for (int ni = 0; ni < 4; ++ni) { const int n = n0 + nw + 16 * ni + 4 * h;
                f32x4 g = *(const f32x4*)(gate + (size_t)b * 6 * DM + n); f32x4* p = (f32x4*)(x + (size_t)tok * DM + n); f32x4 v = *p;
#pragma unroll
                for (int r = 0; r < 4; ++r) v[r] += g[r] * acc[ni][mi][r];
                *p = v; } }
    }
};
template <int MODE> struct EpiGated {
    bf16* dst; size_t ld; int m0, n0, mvalid;
    MDEV void operator()(f32x4 (&acc)[4][4], int mw, int nw, int h, int c) const {
        const int cb = (n0 + nw) / 2;
#pragma unroll
        for (int mi = 0; mi < 4; ++mi) { const int m = mw + 16 * mi + c; if (m >= mvalid) continue;
#pragma unroll
            for (int ni = 0; ni < 2; ++ni) { f32x4 o;
#pragma unroll
                for (int r = 0; r < 4; ++r) { const float av = acc[ni][mi][r], bv = acc[ni + 2][mi][r]; o[r] = MODE == 0 ? av * sigm(bv) : siluf(av) * bv; }
                st_bf4(dst + (size_t)(m0 + m) * ld + cb + 16 * ni + 4 * h, o); } }
    }
};
struct EpiStoreBf {
    bf16* dst; size_t ld; int m0, n0, mvalid;
    MDEV void operator()(f32x4 (&acc)[4][4], int mw, int nw, int h, int c) const {
#pragma unroll
        for (int mi = 0; mi < 4; ++mi) { const int m = mw + 16 * mi + c; if (m >= mvalid) continue;
#pragma unroll
            for (int ni = 0; ni < 4; ++ni) st_bf4(dst + (size_t)(m0 + m) * ld + n0 + nw + 16 * ni + 4 * h, acc[ni][mi]); }
    }
};
struct EpiCmp {
    const Args* a; int kv, bg, m0, li;
    MDEV void operator()(f32x4 (&acc)[4][4], int mw, int nw, int h, int c) const {
        if (nw != 0) return;
        unsigned char* ws = wsp(*a);
        const float* bp8 = (const float*)(ws + WS_CB) + (li * 2 + kv) * 8 * 64;
        float bias[16];
#pragma unroll
        for (int q = 0; q < 16; ++q) { const int e = 16 * (q >> 2) + 4 * h + (q & 3); float v = 0.f;
#pragma unroll
            for (int kp = 0; kp < 8; ++kp) v += bp8[kp * 64 + e];
            bias[q] = v; }
        const float* gain = INP(*a, I_KG) + (li * 3 + 0) * 64;
#pragma unroll
        for (int mi = 0; mi < 4; ++mi) { const int n = m0 + mw + 16 * mi + c; const bool ok = n < NCMP;
            f32x4 v[4]; float ss = 0.f;
#pragma unroll
            for (int ni = 0; ni < 4; ++ni) { v[ni] = acc[ni][mi];
#pragma unroll
                for (int r = 0; r < 4; ++r) { v[ni][r] += bias[4 * ni + r]; ss += v[ni][r] * v[ni][r]; } }
            ss += shflx(ss, 16); ss += shflx(ss, 32);
            if (n >= NCP) continue;
            if (kv == 0) { const float rs = frsq(ss * (1.0f / 64.0f) + EPS); bf16* p = (bf16*)(ws + WS_KC) + ((size_t)bg * NCP + n) * 64;
#pragma unroll
                for (int ni = 0; ni < 4; ++ni) { f32x4 o;
#pragma unroll
                    for (int r = 0; r < 4; ++r) o[r] = ok ? v[ni][r] * rs * gain[16 * ni + 4 * h + r] : 0.f;
                    st_bf4(p + 16 * ni + 4 * h, o); }
            } else { bf16* p = (bf16*)(ws + WS_VCT) + ((size_t)bg * NCP + n) * 64;
#pragma unroll
                for (int ni = 0; ni < 4; ++ni) { f32x4 o;
#pragma unroll
                    for (int r = 0; r < 4; ++r) o[r] = ok ? v[ni][r] : 0.f;
                    st_bf4(p + 16 * ni + 4 * h, o); } }
        }
    }
};


struct EpiResid8 {
    static constexpr bool PERM = true, AFTER_DRAIN = false;
    float* x; const float* gate;
    MDEV void operator()(const f32x4 (&acc)[2][2][4][2], const pg8::Unit& u, int wr, int wc, int fr, int fq) const {
        OPAQUE2(fr, fq);
#pragma unroll
        for (int ai = 0; ai < 2; ++ai)
#pragma unroll
            for (int m = 0; m < 4; ++m) { const int row = 256 * u.pm + 128 * ai + 64 * wr + 16 * m + fr, b = row / SEQ;
#pragma unroll
                for (int bj = 0; bj < 2; ++bj)
#pragma unroll
                    for (int n = 0; n < 2; ++n) { const int col = 256 * u.pn + 128 * bj + 32 * wc + 8 * fq + 4 * n;
                        const f32x4 g = *(const f32x4*)(gate + (size_t)b * 6 * DM + col); f32x4* p = (f32x4*)(x + (size_t)row * DM + col); f32x4 v = *p;
#pragma unroll
                        for (int r = 0; r < 4; ++r) v[r] += g[r] * acc[ai][bj][m][n][r];
                        *p = v; } }
    }
};
struct EpiGlu8 {
    static constexpr bool PERM = true, AFTER_DRAIN = false;
    bf16* dst;
    MDEV void operator()(const f32x4 (&acc)[2][2][4][2], const pg8::Unit& u, int wr, int wc, int fr, int fq) const {
        OPAQUE2(fr, fq);
#pragma unroll
        for (int ai = 0; ai < 2; ++ai)
#pragma unroll
            for (int m = 0; m < 4; ++m) { const int row = 256 * u.pm + 128 * ai + 64 * wr + 16 * m + fr;
#pragma unroll
                for (int bj = 0; bj < 2; ++bj) { const int col = 128 * u.pn + 64 * bj + 16 * wc + 4 * fq; f32x4 o;
#pragma unroll
                    for (int r = 0; r < 4; ++r) o[r] = acc[ai][bj][m][0][r] * sigm(acc[ai][bj][m][1][r]);
                    st_bf4(dst + (size_t)row * DM + col, o); } }
    }
};
struct EpiInProj8 {
    static constexpr bool PERM = true, AFTER_DRAIN = false;
    const Args* a; int li;
    MDEV void operator()(const f32x4 (&acc)[2][2][4][2], const pg8::Unit& u, int wr, int wc, int fr, int fq) const {
        OPAQUE2(fr, fq);
        unsigned char* ws = wsp(*a);
        const int nb = 256 * u.pn + 64 * wc;
        if (nb >= 3392) return;
        if (nb < 512 || (nb >= 768 && nb < 896) || (nb >= 1024 && nb < 1152)) {
            const float* gain; float mul = 1.f; int kind;
            if (nb < 512) { gain = INP(*a, I_QG) + li * 64; mul = 0.125f * LOG2E; kind = 0; }
            else if (nb < 896) { gain = INP(*a, I_KG) + (li * 3 + 1) * 64; kind = 1; }
            else { gain = INP(*a, I_KG) + (li * 3 + 2) * 64; kind = 2; }
            const int g = (nb >> 6) & 1;
            f32x4 gv[2][2];
#pragma unroll
            for (int bj = 0; bj < 2; ++bj)
#pragma unroll
                for (int n = 0; n < 2; ++n) gv[bj][n] = *(const f32x4*)(gain + 32 * bj + 8 * fq + 4 * n);
#pragma unroll
            for (int ai = 0; ai < 2; ++ai)
#pragma unroll
                for (int m = 0; m < 4; ++m) { const int tok = 256 * u.pm + 128 * ai + 64 * wr + 16 * m + fr;
                    float ss = 0.f;
#pragma unroll
                    for (int bj = 0; bj < 2; ++bj)
#pragma unroll
                        for (int n = 0; n < 2; ++n) { const f32x4 v = acc[ai][bj][m][n]; ss += v[0] * v[0] + v[1] * v[1] + v[2] * v[2] + v[3] * v[3]; }
                    ss += shflx(ss, 16); ss += shflx(ss, 32);
                    const float rs = frsq(ss * (1.0f / 64.0f) + EPS) * mul;
                    bf16* dst; if (kind == 0) dst = (bf16*)(ws + WS_QN) + (size_t)tok * 512 + nb; else { const int b = tok / SEQ, sq = tok % SEQ; dst = (bf16*)(ws + (kind == 1 ? WS_KS : WS_KW)) + ((size_t)(b * 2 + g) * SEQ + sq) * 64; }
#pragma unroll
                    for (int bj = 0; bj < 2; ++bj) { f32x4 o0, o1;
#pragma unroll
                        for (int r = 0; r < 4; ++r) { o0[r] = acc[ai][bj][m][0][r] * rs * gv[bj][0][r]; o1[r] = acc[ai][bj][m][1][r] * rs * gv[bj][1][r]; }
                        st_bf8(dst + 32 * bj + 8 * fq, o0, o1); } }
        } else if (nb < 768) {
            bf16* base = (bf16*)(ws + (nb < 640 ? WS_KCG : WS_VCG)); const int g = (nb >> 6) & 1;
#pragma unroll
            for (int ai = 0; ai < 2; ++ai)
#pragma unroll
                for (int m = 0; m < 4; ++m) { const int tok = 256 * u.pm + 128 * ai + 64 * wr + 16 * m + fr, b = tok / SEQ, sq = tok % SEQ;
#pragma unroll
                    for (int bj = 0; bj < 2; ++bj) st_bf8(base + ((size_t)(b * 2 + g) * SEQ + sq) * 64 + 32 * bj + 8 * fq, acc[ai][bj][m][0], acc[ai][bj][m][1]); }
        } else if (nb < 1280) {
            bf16* base = (bf16*)(ws + (nb < 1024 ? WS_VST : WS_VWT)); const int g = (nb >> 6) & 1;
#pragma unroll
            for (int ai = 0; ai < 2; ++ai)
#pragma unroll
                for (int m = 0; m < 4; ++m) { const int tok = 256 * u.pm + 128 * ai + 64 * wr + 16 * m + fr, b = tok / SEQ, sq = tok % SEQ;
#pragma unroll
                    for (int bj = 0; bj < 2; ++bj) st_bf8(base + ((size_t)(b * 2 + g) * SEQ + sq) * 64 + 32 * bj + 8 * fq, acc[ai][bj][m][0], acc[ai][bj][m][1]); }
        } else if (nb < 3328) {
            const int sec = (nb - 1280) >> 9, cc = (nb - 1280) & 511, hh = cc >> 7, d0 = cc & 127;
            f32x4 lbv[2][2];
            if (sec == 1) {
#pragma unroll
                for (int bj = 0; bj < 2; ++bj)
#pragma unroll
                    for (int n = 0; n < 2; ++n) lbv[bj][n] = *(const f32x4*)((const float*)(ws + WS_LB) + li * 512 + cc + 32 * bj + 8 * fq + 4 * n); }
#pragma unroll
            for (int ai = 0; ai < 2; ++ai)
#pragma unroll
                for (int m = 0; m < 4; ++m) { const int tok = 256 * u.pm + 128 * ai + 64 * wr + 16 * m + fr, b = tok / SEQ, sq = tok % SEQ;
                    const size_t hrow = ((size_t)(b * 4 + hh) * SEQ + sq) * 128 + d0;
#pragma unroll
                    for (int bj = 0; bj < 2; ++bj) { const int d = 32 * bj + 8 * fq; f32x4 o0, o1;
                        if (sec == 0) {
#pragma unroll
                            for (int r = 0; r < 4; ++r) { o0[r] = siluf(acc[ai][bj][m][0][r]); o1[r] = siluf(acc[ai][bj][m][1][r]); }
                            st_bf8((bf16*)(ws + WS_HQ) + hrow + d, o0, o1); }
                        else if (sec == 1) {
#pragma unroll
                            for (int r = 0; r < 4; ++r) { o0[r] = lbv[bj][0][r] + (1.0f - lbv[bj][0][r]) * sigm(acc[ai][bj][m][0][r]); o1[r] = lbv[bj][1][r] + (1.0f - lbv[bj][1][r]) * sigm(acc[ai][bj][m][1][r]); }
                            float* pf = (float*)(ws + WS_HF) + hrow + d; *(f32x4*)pf = o0; *(f32x4*)(pf + 4) = o1; }
                        else if (sec == 2) st_bf8((bf16*)(ws + WS_HV) + hrow + d, acc[ai][bj][m][0], acc[ai][bj][m][1]);
                        else {
#pragma unroll
                            for (int r = 0; r < 4; ++r) { o0[r] = siluf(acc[ai][bj][m][0][r]); o1[r] = siluf(acc[ai][bj][m][1][r]); }
                            st_bf8((bf16*)(ws + WS_HGS) + (size_t)tok * 512 + cc + d, o0, o1); } } }
        } else {
            float* dst = (float*)(ws + WS_GATE);
            if (fq < 3) {
#pragma unroll
                for (int ai = 0; ai < 2; ++ai)
#pragma unroll
                    for (int m = 0; m < 4; ++m) { const int tok = 256 * u.pm + 128 * ai + 64 * wr + 16 * m + fr; f32x4 o0, o1;
#pragma unroll
                        for (int r = 0; r < 4; ++r) { o0[r] = sigm(acc[ai][0][m][0][r]); o1[r] = sigm(acc[ai][0][m][1][r]); }
                        float* pf = dst + (size_t)tok * 24 + 8 * fq; *(f32x4*)pf = o0; *(f32x4*)(pf + 4) = o1; } }
        }
    }
};

DEV void tr_tile(unsigned char* smem, const float* src0, const float* src1, int ld, int K, int mode, bf16* dst, int n0, int k0) {
    bf16* tl = (bf16*)smem;
    const int tid = TID;
    SYNC();
#pragma unroll
    for (int i = 0; i < 8; ++i) {
        const int e = tid + 512 * i, kk = e >> 6, nn = e & 63, n = n0 + nn; float v = 0.f;
        if (mode == 0) v = src0[(size_t)(k0 + kk) * ld + n];
        else if (mode == 1) { int sc = n < 1280 ? n : (n < 3328 ? n + 24 : (n < 3352 ? 1280 + (n - 3328) : -1)); if (sc >= 0) v = src0[(size_t)(k0 + kk) * ld + sc]; }
        else { const int g = n >> 6, w = n & 63; v = (w < 32) ? src0[(size_t)(k0 + kk) * ld + g * 32 + w] : src1[(size_t)(k0 + kk) * ld + g * 32 + w - 32]; }
        tl[nn * LDT + kk] = (bf16)f2bf(v);
    }
    SYNC();
    const int nn = tid >> 3, k8 = (tid & 7) * 8;
    *(bf16x8*)(dst + (size_t)(n0 + nn) * K + k0 + k8) = *(const bf16x8*)(tl + nn * LDT + k8);
}

DEV int tr_col(int mode, int n) {
    if (mode == 0) return n;
    const int pn = n >> 8, ct = n & 255;
    if (mode == 5) { const int bj = ct >> 7, wc = (ct >> 5) & 3, j = ct & 31, L = 256 * pn + 64 * wc + 32 * bj + j; return L < 1280 ? L : (L < 3328 ? L + 24 : (L < 3352 ? 1280 + (L - 3328) : -1)); }
    { const int bj = ct >> 7, wc = (ct >> 5) & 3, j = ct & 31, nn = (j >> 2) & 1, Lc = 128 * pn + 64 * bj + 16 * wc + 4 * (j >> 3) + (j & 3); return nn == 0 ? Lc : DM + Lc; }
}
DEV void tr_tile(unsigned char* smem, const float* src, int ld, int K, int mode, bf16* dst, int n0, int k0) {
    bf16* tl = (bf16*)smem;
    const int tid = TID, nq = tid & 31, kq = tid >> 5;
    const int sc = tr_col(mode, n0 + 4 * nq);
    f32x4 v[4];
#pragma unroll
    for (int i = 0; i < 4; ++i) v[i] = sc >= 0 ? *(const f32x4*)(src + (size_t)(k0 + 4 * kq + i) * ld + sc) : f4zero();
    SYNC();
#pragma unroll
    for (int j = 0; j < 4; ++j) { u32x2 w; w[0] = pk2(v[0][j], v[1][j]); w[1] = pk2(v[2][j], v[3][j]); *(u32x2*)(tl + (4 * nq + j) * LDT + 4 * kq) = w; }
    SYNC();
#pragma unroll
    for (int t = 0; t < 2; ++t) { const int id = tid + 512 * t, row = id >> 3, ch = id & 7;
        *(bf16x8*)(dst + (size_t)(n0 + row) * K + k0 + 8 * ch) = *(const bf16x8*)(tl + row * LDT + 8 * ch); }
}
struct TrJob { const float* s; int ld, K, N, mode; bf16* dst; };
DEV void p0_phase(const Args& a, unsigned char* smem) {
    unsigned char* ws = wsp(a); const int tid = TID;
    { int item = BID, base = 0;
      for (int j = 0; j < 8; ++j) { TrJob J; const int i = j & 1;
        if (j < 2) J = {INP(a, I_WIN) + (size_t)i * DM * NIN, NIN, DM, NIN8, 5, (bf16*)(ws + WS_WIN) + (size_t)i * NIN8 * DM};
        else if (j < 4) J = {INP(a, I_WOUT) + (size_t)i * 1024 * DM, DM, 1024, DM, 0, (bf16*)(ws + WS_WOUT) + (size_t)i * DM * 1024};
        else if (j < 6) J = {INP(a, I_PW1) + (size_t)i * DM * 2 * DM, 2 * DM, DM, 2 * DM, 6, (bf16*)(ws + WS_PW1) + (size_t)i * 2 * DM * DM};
        else J = {INP(a, I_PW2) + (size_t)i * DM * DM, DM, DM, DM, 0, (bf16*)(ws + WS_PW2) + (size_t)i * DM * DM};
        const int tn = J.N / 128, tk = J.K / 64, nt = tn * tk;
        while (item < base + nt) { const int it = item - base; tr_tile(smem, J.s, J.ld, J.K, J.mode, J.dst, (it % tn) * 128, (it / tn) * 64); item += NBLK; }
        base += nt; }
      SYNC(); }
    {
        float* red = (float*)smem;
        constexpr int NG = 6 * DM / 128; const int ntask = DEPTH * NG;
        for (int t = BID; t < ntask; t += NBLK) {
            const int l = t / NG, j0 = (t % NG) * 128, cq = tid & 31, kr = tid >> 5;
            const float* w = INP(a, I_ADAW) + (size_t)l * DM * 6 * DM + j0 + 4 * cq; const float* cc = INP(a, I_C);
            f32x4 a0 = f4zero(), a1 = f4zero();
#pragma unroll 8
            for (int i = 0; i < DM / 16; ++i) { const int k = kr + 16 * i; const f32x4 wv = *(const f32x4*)(w + (size_t)k * 6 * DM); const float s0 = siluf(cc[k]), s1 = siluf(cc[DM + k]);
#pragma unroll
                for (int r = 0; r < 4; ++r) { a0[r] += s0 * wv[r]; a1[r] += s1 * wv[r]; } }
            SYNC();
            *(f32x4*)(red + (kr * 2 + 0) * 128 + 4 * cq) = a0; *(f32x4*)(red + (kr * 2 + 1) * 128 + 4 * cq) = a1;
            SYNC();
            if (tid < 256) { const int b = tid >> 7, col = tid & 127; float sum = INP(a, I_ADAB)[(size_t)l * 6 * DM + j0 + col];
#pragma unroll
                for (int q = 0; q < 16; ++q) sum += red[(q * 2 + b) * 128 + col];
                ((float*)(ws + WS_MOD))[((size_t)l * 2 + b) * 6 * DM + j0 + col] = sum; }
        }
    }
    for (int t = BID; t < 32; t += NBLK) {
        float* red = (float*)smem; const int ikv = t >> 3, kp = t & 7, i = ikv >> 1, kv = ikv & 1, e = tid & 63, ks = tid >> 6;
        const float* W = INP(a, kv ? I_CWV : I_CWK) + (size_t)i * 2048 * 64 + e; const float* pe = INP(a, I_CPE) + (size_t)i * 2048;
        float sum = 0.f;
#pragma unroll 8
        for (int q = 0; q < 32; ++q) { const int k = kp * 256 + ks * 32 + q; sum += pe[k] * W[(size_t)k * 64]; }
        SYNC(); red[ks * 64 + e] = sum; SYNC();
        if (tid < 64) { float v = 0.f; for (int q = 0; q < 8; ++q) v += red[q * 64 + tid]; ((float*)(ws + WS_CB))[(ikv * 8 + kp) * 64 + tid] = v; }
    }
    for (int i = BID * NT + tid; i < DEPTH * 48 * DM; i += NBLK * NT) { const int k = i % DM, n = (i / DM) % 48, ll = i / (48 * DM);
        const float wv = n < 4 ? INP(a, I_WG)[((size_t)ll * DM + k) * 4 + n] : (n < 36 ? INP(a, I_WE)[((size_t)ll * DM + k) * 32 + n - 4] : 0.f);
        const unsigned hi = f2bf(wv); ((bf16*)(ws + WS_WTH))[i] = (bf16)hi; ((bf16*)(ws + WS_WTL))[i] = (bf16)f2bf(wv - bf2f(hi)); }
    if (BID == 0) {
        for (int i = tid; i < DEPTH * 32; i += NT) ((int*)(ws + WS_CNT))[i * 64] = 0;
        for (int n = tid; n < 512; n += NT) { const float l0 = INP(a, I_LBL)[n], l1 = INP(a, I_LBL)[512 + n]; const float m = fmaxf(l0, l1);
            const float e0 = fexp2((l0 - m) * LOG2E), e1 = fexp2((l1 - m) * LOG2E);
            ((float*)(ws + WS_LB))[n] = 0.f; ((float*)(ws + WS_LB))[512 + n] = e1 / (e0 + e1); }
        if (tid < 2) { const int i = tid; float mq = 0.f; for (int d = 0; d < 64; ++d) mq = fmaxf(mq, fabsf(INP(a, I_QG)[i * 64 + d]));
            for (int br = 0; br < 3; ++br) { float mk = 0.f; for (int d = 0; d < 64; ++d) mk = fmaxf(mk, fabsf(INP(a, I_KG)[(i * 3 + br) * 64 + d]));
                ((float*)(ws + WS_CS))[i * 4 + br] = 8.0f * mq * mk * LOG2E; } }
    }
}

constexpr int NJV = DM / 256;
DEV void moe_bases(const int* cnt, int* rb  ) {
    if (TID == 0) { int acc = 0; for (int e = 0; e < 32; ++e) { rb[e] = acc; acc += ((cnt[e * 64] + 255) >> 8) << 8; } rb[32] = acc; }
    SYNC();
}
DEV void norm_phase(const Args& a, unsigned char* smem, int l) {
    unsigned char* ws = wsp(a); const int tid = TID, w = tid >> 6, lane = tid & 63;
    int* rb = (int*)smem;
    if (l > 0) moe_bases((const int*)(ws + WS_CNT) + (l - 1) * 32 * 64, rb);
    const float* mod = (const float*)(ws + WS_MOD);
    const bf16* yk = (const bf16*)(ws + WS_YK);
    if (l < DEPTH) {
        const int bid = BID % 76 == BID ? BID : -1;
        for (int job = BID; job < 76; job += NBLK) {
            if (job < 72) { const int b = job / 36, n = job % 36; float sum = 0.f;
                for (int k = tid; k < DM; k += NT) { const float wv = n < 4 ? INP(a, I_WG)[((size_t)l * DM + k) * 4 + n] : INP(a, I_WE)[((size_t)l * DM + k) * 32 + n - 4]; sum += mod[((size_t)l * 2 + b) * 6 * DM + 3 * DM + k] * wv; }
#pragma unroll
                for (int q = 1; q < 64; q <<= 1) sum += shflx(sum, q);
                float* red = (float*)(smem + 1024);
                SYNC(); if (lane == 0) red[w] = sum; SYNC();
                if (tid == 0) { float t = 0.f; for (int q = 0; q < 8; ++q) t += red[q]; ((float*)(ws + WS_RBIAS))[((size_t)l * 2 + b) * 48 + n] = t; }
            } else { const float* nf = INP(a, I_NFFN) + (size_t)l * DM; const int part = job - 72;
                for (int i = part * (2 * DM / 4) + tid; i < (part + 1) * (2 * DM / 4); i += NT) { const int b = i / DM, k = i % DM; ((float*)(ws + WS_AVEC))[((size_t)l * 2 + b) * DM + k] = nf[k] * (1.0f + mod[((size_t)l * 2 + b) * 6 * DM + 4 * DM + k]); } }
        }
        (void)bid;
    }
    const int rstride = NBLK * 8;
    for (int rowa = BID * 8 + w; rowa < T; rowa += 2 * rstride) {
        int row[2]; bool ok[2];
        row[0] = rowa; ok[0] = true; row[1] = rowa + rstride; ok[1] = row[1] < T; if (!ok[1]) row[1] = rowa;
        f32x4 v[2][NJV]; int e0[2], p0[2], e1[2], p1[2]; float w0[2], w1[2];
        const float* xin = (l == 0) ? INP(a, I_X) : outp(a);
#pragma unroll
        for (int q = 0; q < 2; ++q) {
#pragma unroll
            for (int j = 0; j < NJV; ++j) v[q][j] = *(const f32x4*)(xin + (size_t)row[q] * DM + 4 * lane + 256 * j);
            if (l > 0) { const int* tie = (const int*)(ws + WS_TIE) + (size_t)row[q] * 2; const float* tiw = (const float*)(ws + WS_TIW) + (size_t)row[q] * 2;
                e0[q] = tie[0] >> 14; p0[q] = tie[0] & 16383; e1[q] = tie[1] >> 14; p1[q] = tie[1] & 16383; w0[q] = tiw[0]; w1[q] = tiw[1]; } }
        if (l > 0) {
            u32x2 q0[2][NJV], q1[2][NJV];
#pragma unroll
            for (int q = 0; q < 2; ++q) { const bf16* y0 = yk + (size_t)(rb[e0[q]] + p0[q]) * DM; const bf16* y1 = yk + (size_t)(rb[e1[q]] + p1[q]) * DM;
#pragma unroll
                for (int j = 0; j < NJV; ++j) { const int cidx = 4 * lane + 256 * j; q0[q][j] = *(const u32x2*)(y0 + cidx); q1[q][j] = *(const u32x2*)(y1 + cidx); } }
#pragma unroll
            for (int q = 0; q < 2; ++q) { const int b = row[q] / SEQ; const float* gf = mod + ((size_t)(l - 1) * 2 + b) * 6 * DM + 5 * DM;
#pragma unroll
                for (int j = 0; j < NJV; ++j) { const int cidx = 4 * lane + 256 * j; const f32x4 g = *(const f32x4*)(gf + cidx);
                    v[q][j][0] += g[0] * (w0[q] * bf2f(q0[q][j][0] & 0xffff) + w1[q] * bf2f(q1[q][j][0] & 0xffff));
                    v[q][j][1] += g[1] * (w0[q] * bf2f(q0[q][j][0] >> 16) + w1[q] * bf2f(q1[q][j][0] >> 16));
                    v[q][j][2] += g[2] * (w0[q] * bf2f(q0[q][j][1] & 0xffff) + w1[q] * bf2f(q1[q][j][1] & 0xffff));
                    v[q][j][3] += g[3] * (w0[q] * bf2f(q0[q][j][1] >> 16) + w1[q] * bf2f(q1[q][j][1] >> 16)); } }
        }
#pragma unroll
        for (int q = 0; q < 2; ++q) { if (!ok[q]) continue;
#pragma unroll
            for (int j = 0; j < NJV; ++j) *(f32x4*)(outp(a) + (size_t)row[q] * DM + 4 * lane + 256 * j) = v[q][j]; }
        if (l == DEPTH) continue;
        float ss[2];
#pragma unroll
        for (int q = 0; q < 2; ++q) { ss[q] = 0.f;
#pragma unroll
            for (int j = 0; j < NJV; ++j) ss[q] += v[q][j][0] * v[q][j][0] + v[q][j][1] * v[q][j][1] + v[q][j][2] * v[q][j][2] + v[q][j][3] * v[q][j][3]; }
#pragma unroll
        for (int o = 1; o < 64; o <<= 1) { ss[0] += shflx(ss[0], o); ss[1] += shflx(ss[1], o); }
        const float* nm = INP(a, I_NMIX) + (size_t)l * DM;
#pragma unroll
        for (int q = 0; q < 2; ++q) { if (!ok[q]) continue;
            const int b = row[q] / SEQ; const float rs = frsq(ss[q] * (1.0f / DM) + EPS);
            const float* mm = mod + ((size_t)l * 2 + b) * 6 * DM; bf16* hb = (bf16*)(ws + WS_H) + (size_t)row[q] * DM;
#pragma unroll
            for (int j = 0; j < NJV; ++j) { const int cidx = 4 * lane + 256 * j; f32x4 g = *(const f32x4*)(nm + cidx), sh = *(const f32x4*)(mm + cidx), sc = *(const f32x4*)(mm + DM + cidx), o;
#pragma unroll
                for (int r = 0; r < 4; ++r) o[r] = v[q][j][r] * rs * g[r] * (1.0f + sc[r]) + sh[r];
                st_bf4(hb + cidx, o); } }
    }
}

DEV void route_phase(const Args& a, unsigned char* smem, int l) {
    unsigned char* ws = wsp(a); const int tid = TID, w = tid >> 6, lane = tid & 63, h = lane >> 4, c = lane & 15, pi = w >> 1, kh = w & 1;
    constexpr int NCHK = 4, CH = DM / NCHK, WLD = CH + 8, NKS = CH / 2 / 32;
    constexpr int WTOT = 48 * (CH / 8), WMAX = (WTOT + NT - 1) / NT;
    bf16* WHl = (bf16*)smem; bf16* WLl = WHl + 48 * WLD;
    float* lg = (float*)(WLl + 48 * WLD);
    float* ssb = lg + 4 * 2 * 16 * 48;
    float* rsb = ssb + 4 * 2 * 16;
    int* lcnt = (int*)(rsb + 64); int* lbase = lcnt + 32; int* tinfo = lbase + 32;
    float* avl = (float*)(tinfo + 256); float* cvl = avl + 2 * DM;
    const float* mod = (const float*)(ws + WS_MOD);
    SYNC();
    if (tid < 32) lcnt[tid] = 0;
    for (int i = tid; i < 2 * DM; i += NT) { const int b = i / DM, k = i % DM; avl[i] = ((const float*)(ws + WS_AVEC))[((size_t)l * 2 + b) * DM + k]; cvl[i] = mod[((size_t)l * 2 + b) * 6 * DM + 3 * DM + k]; }
    const bf16* WH = (const bf16*)(ws + WS_WTH) + (size_t)l * 48 * DM; const bf16* WL = (const bf16*)(ws + WS_WTL) + (size_t)l * 48 * DM;
    int* cnt = (int*)(ws + WS_CNT) + l * 32 * 64;
    for (int pass0 = BID; pass0 < T / 16; pass0 += 4 * NBLK) {
        const int pass = pass0 + pi * NBLK; const bool valid = pass < T / 16;
        const int tok = valid ? pass * 16 + c : 0, b = tok / SEQ;
        const float* xrow = outp(a) + (size_t)tok * DM;
        f32x4 xv[2][NKS][2]; bf16x8 wh[WMAX], wl[WMAX];
#pragma unroll
        for (int ks = 0; ks < NKS; ++ks) { const float* xq = xrow + kh * (CH / 2) + 8 * h + 32 * ks; xv[0][ks][0] = *(const f32x4*)xq; xv[0][ks][1] = *(const f32x4*)(xq + 4); }
#pragma unroll
        for (int t = 0; t < WMAX; ++t) { const int i = tid + NT * t; if (i < WTOT) { const int n = i / (CH / 8), k8 = (i % (CH / 8)) * 8; wh[t] = *(const bf16x8*)(WH + (size_t)n * DM + k8); wl[t] = *(const bf16x8*)(WL + (size_t)n * DM + k8); } }
        f32x4 acc[3] = {f4zero(), f4zero(), f4zero()}; float ss = 0.f;
        bf16x8 uhk[NCHK * NKS];
#pragma unroll
        for (int chn = 0; chn < NCHK; ++chn) {
            SYNC();
#pragma unroll
            for (int t = 0; t < WMAX; ++t) { const int i = tid + NT * t; if (i < WTOT) { const int n = i / (CH / 8), k8 = (i % (CH / 8)) * 8; *(bf16x8*)(WHl + n * WLD + k8) = wh[t]; *(bf16x8*)(WLl + n * WLD + k8) = wl[t]; } }
            SYNC();
            if (chn + 1 < NCHK) {
#pragma unroll
                for (int ks = 0; ks < NKS; ++ks) { const float* xq = xrow + (chn + 1) * CH + kh * (CH / 2) + 8 * h + 32 * ks; xv[(chn + 1) & 1][ks][0] = *(const f32x4*)xq; xv[(chn + 1) & 1][ks][1] = *(const f32x4*)(xq + 4); }
#pragma unroll
                for (int t = 0; t < WMAX; ++t) { const int i = tid + NT * t; if (i < WTOT) { const int n = i / (CH / 8), k8 = (i % (CH / 8)) * 8; wh[t] = *(const bf16x8*)(WH + (size_t)n * DM + (chn + 1) * CH + k8); wl[t] = *(const bf16x8*)(WL + (size_t)n * DM + (chn + 1) * CH + k8); } }
            }
            if (valid) {
                const bf16* whp = WHl + c * WLD + kh * (CH / 2) + 8 * h; const bf16* wlp = WLl + c * WLD + kh * (CH / 2) + 8 * h;
                const float* ap = avl + b * DM + chn * CH + kh * (CH / 2) + 8 * h;
#pragma unroll
                for (int ks = 0; ks < NKS; ++ks) {
                    const f32x4 a0 = *(const f32x4*)(ap + 32 * ks), a1 = *(const f32x4*)(ap + 32 * ks + 4);
                    const f32x4 x0 = xv[chn & 1][ks][0], x1 = xv[chn & 1][ks][1];
                    f32x4 u0, u1, r0, r1;
#pragma unroll
                    for (int r = 0; r < 4; ++r) { u0[r] = x0[r] * a0[r]; u1[r] = x1[r] * a1[r]; ss += x0[r] * x0[r] + x1[r] * x1[r]; }
                    const bf16x8 uh = pack8(u0, u1); uhk[chn * NKS + ks] = uh;
#pragma unroll
                    for (int r = 0; r < 4; ++r) { r0[r] = u0[r] - bf2f((unsigned short)uh[r]); r1[r] = u1[r] - bf2f((unsigned short)uh[4 + r]); }
                    const bf16x8 ul = pack8(r0, r1);
#pragma unroll
                    for (int nt = 0; nt < 3; ++nt) { const bf16x8 whf = *(const bf16x8*)(whp + nt * 16 * WLD + 32 * ks), wlf = *(const bf16x8*)(wlp + nt * 16 * WLD + 32 * ks);
                        acc[nt] = mfma16(whf, uh, acc[nt]); acc[nt] = mfma16(wlf, uh, acc[nt]); acc[nt] = mfma16(whf, ul, acc[nt]); }
                }
            }
        }
        if (valid) {
            ss += shflx(ss, 16); ss += shflx(ss, 32);
            float* lgp = lg + ((pi * 2 + kh) * 16 + c) * 48 + 4 * h;
#pragma unroll
            for (int nt = 0; nt < 3; ++nt) *(f32x4*)(lgp + 16 * nt) = acc[nt];
            if (h == 0) ssb[(pi * 2 + kh) * 16 + c] = ss;
        }
        SYNC();
        if (tid < 64) { const int p2 = tid >> 4, tk = tid & 15, pass2 = pass0 + p2 * NBLK;
            if (pass2 < T / 16) { const int tok2 = pass2 * 16 + tk, b2 = tok2 / SEQ;
                const float rs = frsq((ssb[(p2 * 2 + 0) * 16 + tk] + ssb[(p2 * 2 + 1) * 16 + tk]) * (1.0f / DM) + EPS); rsb[p2 * 16 + tk] = rs;
                const float* l0 = lg + ((p2 * 2 + 0) * 16 + tk) * 48; const float* l1 = lg + ((p2 * 2 + 1) * 16 + tk) * 48; const float* rbp = (const float*)(ws + WS_RBIAS) + ((size_t)l * 2 + b2) * 48;
                float acc[36];
#pragma unroll
                for (int n = 0; n < 36; ++n) acc[n] = rs * (l0[n] + l1[n]) + rbp[n];
                int gs = 0; float gm = acc[0];
#pragma unroll
                for (int g = 1; g < 4; ++g) if (acc[g] > gm) { gm = acc[g]; gs = g; }
                float den = 0.f;
#pragma unroll
                for (int g = 0; g < 4; ++g) den += fexp2((acc[g] - gm) * LOG2E);
                const float ggate = 1.0f / den;
                float el[8];
#pragma unroll
                for (int j = 0; j < 8; ++j) { el[j] = acc[4 + j];
#pragma unroll
                    for (int g = 1; g < 4; ++g) if (gs == g) el[j] = acc[4 + 8 * g + j]; }
                int ia = 0; float va = el[0];
#pragma unroll
                for (int j = 1; j < 8; ++j) if (el[j] > va) { va = el[j]; ia = j; }
                int ib = -1; float vb = -3e38f;
#pragma unroll
                for (int j = 0; j < 8; ++j) if (j != ia && el[j] > vb) { vb = el[j]; ib = j; }
                const float wa = 1.0f / (1.0f + fexp2((vb - va) * LOG2E)), wb = 1.0f - wa;
                const int e0 = gs * 8 + ia, e1 = gs * 8 + ib;
                const int p0 = atomic_add_i(lcnt + e0, 1), p1 = atomic_add_i(lcnt + e1, 1);
                int* ti = tinfo + tid * 4;
                ti[0] = (e0 << 14) | p0; ti[1] = (e1 << 14) | p1; ti[2] = __builtin_bit_cast(int, ggate * wa); ti[3] = __builtin_bit_cast(int, ggate * wb);
            } }
        SYNC();
        int gbase = 0;
        if (tid < 32) { const int n = lcnt[tid]; gbase = n > 0 ? atomic_add_i(cnt + tid * 64, n) : 0; }
        if (valid) { const float rs = rsb[pi * 16 + c]; bf16* hb = (bf16*)(ws + WS_H) + (size_t)tok * DM + kh * (CH / 2) + 8 * h;
            const float* cp = cvl + b * DM + kh * (CH / 2) + 8 * h;
#pragma unroll
            for (int chn = 0; chn < NCHK; ++chn)
#pragma unroll
                for (int ks = 0; ks < NKS; ++ks) {
                    const bf16x8 uh = uhk[chn * NKS + ks]; const f32x4 c0 = *(const f32x4*)(cp + chn * CH + 32 * ks), c1 = *(const f32x4*)(cp + chn * CH + 32 * ks + 4);
                    f32x4 o0, o1;
#pragma unroll
                    for (int r = 0; r < 4; ++r) { o0[r] = bf2f((unsigned short)uh[r]) * rs + c0[r]; o1[r] = bf2f((unsigned short)uh[4 + r]) * rs + c1[r]; }
                    st_bf8(hb + chn * CH + 32 * ks, o0, o1); } }
        if (tid < 32) { lbase[tid] = gbase; lcnt[tid] = 0; }
        SYNC();
        if (tid < 64) { const int p2 = tid >> 4, pass2 = pass0 + p2 * NBLK;
            if (pass2 < T / 16) { const int tok2 = pass2 * 16 + (tid & 15); const int* ti = tinfo + tid * 4;
                const int e0 = ti[0] >> 14, e1 = ti[1] >> 14, p0 = lbase[e0] + (ti[0] & 16383), p1 = lbase[e1] + (ti[1] & 16383);
                int* list = (int*)(ws + WS_LIST); list[(size_t)e0 * T + p0] = tok2; list[(size_t)e1 * T + p1] = tok2;
                int* tie = (int*)(ws + WS_TIE) + (size_t)tok2 * 2; int* tiw = (int*)(ws + WS_TIW) + (size_t)tok2 * 2;
                tie[0] = (e0 << 14) | p0; tie[1] = (e1 << 14) | p1; tiw[0] = ti[2]; tiw[1] = ti[3]; } }
        SYNC();
    }
}

DEV int vbid() { const int g = NBLK; return (g % 8 == 0) ? (BID % 8) * (g / 8) + BID / 8 : BID; }
#ifdef EMU
#define PG8_LDS(p) (p)
#else
#define PG8_LDS(p) ((PG8_LAS unsigned char*)(p))
#endif
DEV void inproj_phase(const Args& a, unsigned char* smem, int li) {
    pg8::Gemm g{(const bf16*)(wsp(a) + WS_H), (const bf16*)(wsp(a) + WS_WIN) + (size_t)li * NIN8 * DM, T, NIN8, DM}; pg8::StaticOrder S; S.init(T, NIN8, NBLK, BID);
    EpiInProj8 E{&a, li};
    SYNC(); pg8::gemm_phase<EpiInProj8, pg8::StaticOrder, true, true>(PG8_LDS(smem), g, S, E); SYNC();
}
DEV void resid_gemm_phase(const Args& a, unsigned char* smem, const bf16* A, int K, const bf16* Bt, int l) {
    pg8::Gemm g{A, Bt, T, DM, K}; pg8::StaticOrder S; S.init(T, DM, NBLK, BID);
    EpiResid8 E{outp(a), (const float*)(wsp(a) + WS_MOD) + (size_t)l * 2 * 6 * DM + 2 * DM};
    SYNC(); pg8::gemm_phase<EpiResid8, pg8::StaticOrder, true, true>(PG8_LDS(smem), g, S, E); SYNC();
}
DEV void pw1_phase(const Args& a, unsigned char* smem, int li) {
    pg8::Gemm g{(const bf16*)(wsp(a) + WS_H), (const bf16*)(wsp(a) + WS_PW1) + (size_t)li * 2 * DM * DM, T, 2 * DM, DM}; pg8::StaticOrder S; S.init(T, 2 * DM, NBLK, BID);
    EpiGlu8 E{(bf16*)(wsp(a) + WS_GLU)};
    SYNC(); pg8::gemm_phase<EpiGlu8, pg8::StaticOrder, true, true>(PG8_LDS(smem), g, S, E); SYNC();
}
DEV void cmp_phase_items(const Args& a, unsigned char* smem, int li, int it) {
    constexpr int TMC = (NCP + 255) / 256;
    const int kv = it / (4 * TMC), bg = (it / TMC) % 4, tm = it % TMC;
    const bf16* src = (const bf16*)(wsp(a) + (kv ? WS_VCG : WS_KCG)) + (size_t)bg * SEQ * 64;
    struct AF { const bf16* base; int m0; MDEV unsigned off(int r) const { int n = m0 + r; if (n > NCMP - 1) n = NCMP - 1; return (unsigned)n * 1024u; } } af{src, tm * 256};
    EpiCmp E{&a, kv, bg, tm * 256, li};
    BClamp64 bf{INP(a, kv ? I_CWV : I_CWK) + (size_t)li * 2048 * 64};
    gemm_tile2(smem, af, bf, 64, 2048, E);
}
DEV void moe_gemm_phase(const Args& a, unsigned char* smem, int l, int mode) {
    unsigned char* ws = wsp(a); const int* cnt = (const int*)(ws + WS_CNT) + l * 32 * 64;
    int* rb = (int*)(smem + GEMM2_LDS);
    moe_bases(cnt, rb);
    const int ntile = rb[32] >> 8;
    constexpr int TN1 = 2 * FF / 128, TN2 = DM / 128;
    const int TN = mode == 0 ? TN1 : TN2;
    const int* list = (const int*)(ws + WS_LIST);
    for (int it = vbid(); it < ntile * TN; it += NBLK) {
        const int rt = it / TN, tn = it % TN; int e = 0;
#pragma unroll 1
        for (int q = 1; q < 32; ++q) if ((rb[q] >> 8) <= rt) e = q;
        const int rloc = (rt << 8) - rb[e], ce = cnt[e * 64], nvalid = (ce - rloc) < 256 ? (ce - rloc) : 256;
        if (mode == 0) {
            struct AF { const bf16* base; const int* lst; int nv; MDEV unsigned off(int r) const { const int rr = r < nv ? r : nv - 1; return (unsigned)lst[rr] * (unsigned)DM; } }
                af{(const bf16*)(ws + WS_H), list + (size_t)e * T + rloc, nvalid};
            EpiGated<1> E{(bf16*)(ws + WS_ACT), (size_t)FF, rt << 8, tn * 128, nvalid};
            BInter bf{INP(a, I_W1) + (size_t)(l * 32 + e) * DM * FF, INP(a, I_W3) + (size_t)(l * 32 + e) * DM * FF, tn * 128};
            gemm_tile2(smem, af, bf, FF, DM, E);
        } else {
            ARows af{(const bf16*)(ws + WS_ACT) + (size_t)(rt << 8) * FF, (size_t)FF};
            EpiStoreBf E{(bf16*)(ws + WS_YK), (size_t)DM, rt << 8, tn * 128, nvalid};
            BPlain bf{INP(a, I_W2) + (size_t)(l * 32 + e) * FF * DM + tn * 128};
            gemm_tile2(smem, af, bf, DM, FF, E);
        }
    }
}

constexpr int LDV = 80;
constexpr int AT_K = 0, AT_V = 2 * 64 * LDT * 2, AT_IMP = AT_V + 2 * 64 * LDV * 2, AT_SEL = AT_IMP + 8 * 8 * 128 * 4, AT_GSEL = AT_SEL + 8 * 8 * 4 * 4, AT_OUT = AT_GSEL + 8 * 2 * 4 * 4, AT_END = AT_OUT + 8 * 32 * 64 * 4;
#ifdef EMU
DEV float rexp2(float x) { return exp2f(x); }
DEV unsigned uni(unsigned x) { return x; }
#else
DEV float rexp2(float x) { return __builtin_amdgcn_exp2f(x); }
DEV unsigned uni(unsigned x) { return (unsigned)__builtin_amdgcn_readfirstlane((int)x); }
#endif
DEV int krow_lds(int kappa) { return 16 * (2 * (kappa >> 5) + ((kappa >> 2) & 1)) + 4 * ((kappa >> 3) & 3) + (kappa & 3); }
template <int MASK, bool FULL, int GM>
DEV void attn_block(const bf16* Kp, const bf16* Vp, const bf16x8 (&qf)[2][2], int j, const int (&s)[2], const bool (&selbit)[2], float C2, int h, int c,
                    f32x4 (&O)[2][4], f32x4 (&Ol)[2]) {
    f32x4 st[2][2][2];
#pragma unroll
    for (int sp = 0; sp < 2; ++sp)
#pragma unroll
        for (int u = 0; u < 2; ++u) {
#pragma unroll
            for (int G = 0; G < 2; ++G) { st[G][sp][u][0] = -C2; st[G][sp][u][1] = -C2; st[G][sp][u][2] = -C2; st[G][sp][u][3] = -C2; }
#pragma unroll
            for (int ks = 0; ks < 2; ++ks) { const bf16x8 kf = *(const bf16x8*)(Kp + (16 * (2 * sp + u) + c) * LDT + 32 * ks + 8 * h);
#pragma unroll
                for (int G = 0; G < 2; ++G) if (GM & (1 << G)) st[G][sp][u] = mfma16(kf, qf[G][ks], st[G][sp][u]); } }
#pragma unroll
    for (int G = 0; G < 2; ++G) if (GM & (1 << G))
#pragma unroll
        for (int sp = 0; sp < 2; ++sp)
#pragma unroll
            for (int u = 0; u < 2; ++u)
#pragma unroll
                for (int r = 0; r < 4; ++r) { bool ok = selbit[G];
                    if (!FULL) { const int key = 64 * j + 32 * sp + 8 * h + 4 * u + r;
                        if (MASK == 0) ok = 16 * key + 31 <= s[G]; else if (MASK == 1) ok = selbit[G] && key <= s[G]; else ok = key <= s[G] && key > s[G] - 512; }
                    st[G][sp][u][r] = ok ? rexp2(st[G][sp][u][r]) : 0.f; }
    bf16x8 pb[2][2], ones;
#pragma unroll
    for (int q = 0; q < 8; ++q) ones[q] = (short)0x3F80;
#pragma unroll
    for (int G = 0; G < 2; ++G) if (GM & (1 << G))
#pragma unroll
        for (int sp = 0; sp < 2; ++sp) { pb[G][sp] = pack8(st[G][sp][0], st[G][sp][1]); Ol[G] = mfma16(ones, pb[G][sp], Ol[G]); }
    const bf16* Vb = Vp + bperm(8 * h + (c >> 2)) * LDV + 4 * (c & 3);
#pragma unroll
    for (int et = 0; et < 4; ++et)
#pragma unroll
        for (int sp = 0; sp < 2; ++sp) { const bf16x8 vf = tr_read8(Vb + (32 * sp) * LDV + 16 * et, Vb + (32 * sp + 8) * LDV + 16 * et);
#pragma unroll
            for (int G = 0; G < 2; ++G) if (GM & (1 << G)) O[G][et] = mfma16(vf, pb[G][sp], O[G][et]); }
}

struct ImpState { float invq[2][4]; float carry[2]; float* imps; int tl, hd, l, s0, qblk; };
DEV void imp_block(const bf16* Kp, const bf16x8 (&qf)[2][2], int j, int s0, int w, float C2, int h, int c, ImpState& im) {
#pragma unroll
    for (int kt = 0; kt < 4; ++kt) {
        const int row = krow_lds(16 * kt + c);
        const bf16x8 k0 = *(const bf16x8*)(Kp + row * LDT + 8 * h), k1 = *(const bf16x8*)(Kp + row * LDT + 32 + 8 * h);
        const int n = 64 * j + 16 * kt + c;
#pragma unroll
        for (int G = 0; G < 2; ++G) {
            f32x4 acc; acc[0] = -C2; acc[1] = -C2; acc[2] = -C2; acc[3] = -C2;
            acc = mfma16(qf[G][0], k0, acc); acc = mfma16(qf[G][1], k1, acc);
            const bool ok = 16 * n + 31 <= s0 + 8 * w + 4 * G + h;
            float imp = 0.f;
#pragma unroll
            for (int r = 0; r < 4; ++r) imp += ok ? rexp2(acc[r]) * im.invq[G][r] : 0.f;
            const float v = ((c & 3) == 3) ? imp : 2.0f * imp;
            float sq = v + shflx(v, 1); sq += shflx(sq, 2);
            const float rr = dpp_ror1(imp);
            const float prev = (c == 0) ? im.carry[G] : rr;
            im.carry[G] = rr;
            const int m = n >> 2;
            if ((c & 3) == 0 && m < 128) im.imps[(G * 4 + h) * 128 + m] = sq + prev;
        }
    }
}

template <int MODE>
DEV void attn_branch(bf16* Kl, bf16* Vl, const bf16* kbase, const bf16* vbase, int jlo, int jhi,
                     const bf16x8 (&qf)[2][2], const int (&s)[2], const unsigned* selm, const unsigned* gselm, float C2, int w, int h, int c, int srow, int scol,
                     f32x4 (&O)[2][4], f32x4 (&Ol)[2], ImpState& im) {
    constexpr bool PV = MODE != 1; constexpr int MASK = MODE <= 1 ? 0 : MODE - 1;
    const int krow = krow_lds(srow) * LDT + scol, vrow = bperm(srow) * LDV + scol;
    bf16x8 rk[3], rv[3];
    { const bf16x8 k0 = *(const bf16x8*)(kbase + (size_t)jlo * 4096); *(bf16x8*)(Kl + krow) = k0;
      if (PV) { const bf16x8 v0 = *(const bf16x8*)(vbase + (size_t)jlo * 4096); *(bf16x8*)(Vl + vrow) = v0; } }
#pragma unroll
    for (int u = 0; u < 3; ++u) { int jj = jlo + 1 + u; if (jj > jhi) jj = jhi; rk[(1 + u) % 3] = *(const bf16x8*)(kbase + (size_t)jj * 4096); if (PV) rv[(1 + u) % 3] = *(const bf16x8*)(vbase + (size_t)jj * 4096); }
    SYNC();
    for (int jb = jlo; jb <= jhi; jb += 3) {
#pragma unroll
        for (int u = 0; u < 3; ++u) { const int j = jb + u;
            if (j <= jhi) {
                const int cur = (j - jlo) & 1;
                const bf16* Kc = Kl + cur * 64 * LDT; const bf16* Vc = Vl + cur * 64 * LDV;
                if (MODE == 1) imp_block(Kc, qf, j, im.s0, w, C2, h, c, im);
                else {
                    bool sb[2] = {true, true}; unsigned gm = 3u;
                    if (MODE == 2) { gm = 0u;
#pragma unroll
                        for (int G = 0; G < 2; ++G) { const unsigned wq = uni(gselm[G * 4 + (j >> 5)]), mq = selm[(G * 4 + im.tl) * 4 + (j >> 5)];
                            gm |= ((wq >> (j & 31)) & 1u) << G; sb[G] = (mq >> (j & 31)) & 1u; } }
                    bool full;
                    if (MODE == 0) full = 1024 * j + 1039 <= im.s0; else if (MODE == 2) full = j < im.qblk; else full = (j < im.qblk) && (64 * j > im.s0 + 63 - 512);
                    if (MODE == 2) {
                        if (full) { if (gm == 3u) attn_block<MASK, true, 3>(Kc, Vc, qf, j, s, sb, C2, h, c, O, Ol); else if (gm == 1u) attn_block<MASK, true, 1>(Kc, Vc, qf, j, s, sb, C2, h, c, O, Ol); else if (gm == 2u) attn_block<MASK, true, 2>(Kc, Vc, qf, j, s, sb, C2, h, c, O, Ol); }
                        else { if (gm == 3u) attn_block<MASK, false, 3>(Kc, Vc, qf, j, s, sb, C2, h, c, O, Ol); else if (gm == 1u) attn_block<MASK, false, 1>(Kc, Vc, qf, j, s, sb, C2, h, c, O, Ol); else if (gm == 2u) attn_block<MASK, false, 2>(Kc, Vc, qf, j, s, sb, C2, h, c, O, Ol); }
                    } else { if (full) attn_block<MASK, true, 3>(Kc, Vc, qf, j, s, sb, C2, h, c, O, Ol); else attn_block<MASK, false, 3>(Kc, Vc, qf, j, s, sb, C2, h, c, O, Ol); }
                }
                if (j + 1 <= jhi) {
                    *(bf16x8*)(Kl + (cur ^ 1) * 64 * LDT + krow) = rk[(u + 1) % 3]; if (PV) *(bf16x8*)(Vl + (cur ^ 1) * 64 * LDV + vrow) = rv[(u + 1) % 3];
                    int jj = j + 4; if (jj > jhi) jj = jhi;
                    rk[(u + 1) % 3] = *(const bf16x8*)(kbase + (size_t)jj * 4096); if (PV) rv[(u + 1) % 3] = *(const bf16x8*)(vbase + (size_t)jj * 4096);
                }
                SYNC();
            }
        }
    }
}

DEV void attn_task(const Args& a, unsigned char* smem, int li, int item) {
    unsigned char* ws = wsp(a); const int tid = TID, w = tid >> 6, l = tid & 63, h = l >> 4, c = l & 15, tl = c >> 2, hd = c & 3;
    const int bg = item & 3, b = bg >> 1, g = bg & 1, tq = (SEQ / 64 - 1) - (item >> 2), s0 = tq * 64, qblk = tq;
    int s[2], row[2];
#pragma unroll
    for (int G = 0; G < 2; ++G) { s[G] = s0 + 8 * w + 4 * G + tl; row[G] = b * SEQ + s[G]; }
    bf16* Kl = (bf16*)(smem + AT_K); bf16* Vl = (bf16*)(smem + AT_V); float* imps = (float*)(smem + AT_IMP) + w * 1024; unsigned* selm = (unsigned*)(smem + AT_SEL) + w * 32;
    bf16x8 qf[2][2]; float gatec[2], gates[2], gatew[2];
#pragma unroll
    for (int G = 0; G < 2; ++G) { const bf16* qp = (const bf16*)(ws + WS_QN) + (size_t)row[G] * 512 + (g * 4 + hd) * 64 + 8 * h; qf[G][0] = *(const bf16x8*)qp; qf[G][1] = *(const bf16x8*)(qp + 32);
        const float* gp = (const float*)(ws + WS_GATE) + (size_t)row[G] * 24 + (g * 4 + hd) * 3; gatec[G] = gp[0]; gates[G] = gp[1]; gatew[G] = gp[2]; }
    const float* cs = (const float*)(ws + WS_CS) + li * 4;
    const int srow = tid >> 3, scol = (tid & 7) * 8;
    for (int i = l; i < 1024; i += 64) imps[i] = 0.f;
    SYNC();
    unsigned* gselm = (unsigned*)(smem + AT_GSEL) + w * 8; float* outl = (float*)(smem + AT_OUT) + w * 2048 + l;
    ImpState im{{{0.f, 0.f, 0.f, 0.f}, {0.f, 0.f, 0.f, 0.f}}, {0.f, 0.f}, imps, tl, hd, l, s0, qblk};
    {
        const int ncv = s0 / 16 + 3, ncb0 = (ncv + 63) >> 6, ncb = ncb0 > NCP / 64 ? NCP / 64 : ncb0;
        const bf16* kcb = (const bf16*)(ws + WS_KC) + (size_t)bg * NCP * 64 + tid * 8;
        const bf16* vcb = (const bf16*)(ws + WS_VCT) + (size_t)bg * NCP * 64 + tid * 8;
        f32x4 O[2][4], Ol[2] = {f4zero(), f4zero()};
#pragma unroll
        for (int G = 0; G < 2; ++G)
#pragma unroll
            for (int et = 0; et < 4; ++et) O[G][et] = f4zero();
        attn_branch<0>(Kl, Vl, kcb, vcb, 0, ncb - 1, qf, s, selm, gselm, cs[0], w, h, c, srow, scol, O, Ol, im);
#pragma unroll
        for (int G = 0; G < 2; ++G) { const float lsum = Ol[G][0]; const float invl = lsum > 0.f ? 1.0f / lsum : 0.f;
#pragma unroll
            for (int r = 0; r < 4; ++r) im.invq[G][r] = shfl(invl, 4 * h + r);
#pragma unroll
            for (int et = 0; et < 4; ++et)
#pragma unroll
                for (int r = 0; r < 4; ++r) outl[((G * 4 + et) * 4 + r) * 64] = gatec[G] * invl * O[G][et][r]; }
        f32x4 ld[2] = {f4zero(), f4zero()};
        attn_branch<1>(Kl, Vl, kcb, vcb, 0, ncb - 1, qf, s, selm, gselm, cs[0], w, h, c, srow, scol, O, ld, im);
    }
    WSYNC();
#pragma unroll 1
    for (int G = 0; G < 2; ++G) {
        const int tk = l >> 4, i = l & 15; float vals[8];
#pragma unroll
        for (int mm = 0; mm < 8; ++mm) { const int jj = i + 16 * mm; vals[mm] = jj > qblk ? NEGV : ((jj == 0 || jj == qblk || jj == qblk - 1) ? FORCEV : imps[(G * 4 + tk) * 128 + jj]); }
        unsigned mk[4] = {0u, 0u, 0u, 0u};
#pragma unroll 1
        for (int rnd = 0; rnd < 16; ++rnd) {
            float best = vals[0]; int bj = i;
#pragma unroll
            for (int mm = 1; mm < 8; ++mm) if (vals[mm] > best) { best = vals[mm]; bj = i + 16 * mm; }
#pragma unroll
            for (int o = 1; o < 16; o <<= 1) { const float ov = shflx(best, o); const int oj = shflxi(bj, o); if (ov > best || (ov == best && oj < bj)) { best = ov; bj = oj; } }
            if (best > NEGV * 0.5f) {
#pragma unroll
                for (int q = 0; q < 4; ++q) if ((bj >> 5) == q) mk[q] |= 1u << (bj & 31); }
            if ((bj & 15) == i) {
#pragma unroll
                for (int mm = 0; mm < 8; ++mm) if ((bj >> 4) == mm) vals[mm] = -3e38f; }
        }
        if (i == 0) {
#pragma unroll
            for (int q = 0; q < 4; ++q) selm[(G * 4 + tk) * 4 + q] = mk[q]; }
    }
    WSYNC();
    if (l < 8) { const int G = l >> 2, q = l & 3; gselm[l] = selm[(G * 4 + 0) * 4 + q] | selm[(G * 4 + 1) * 4 + q] | selm[(G * 4 + 2) * 4 + q] | selm[(G * 4 + 3) * 4 + q]; }
    WSYNC();
#pragma unroll
    for (int br = 0; br < 2; ++br) {
        const bf16* kb = (const bf16*)(ws + (br == 0 ? WS_KS : WS_KW)) + (size_t)bg * SEQ * 64 + tid * 8; const bf16* vb = (const bf16*)(ws + (br == 0 ? WS_VST : WS_VWT)) + (size_t)bg * SEQ * 64 + tid * 8;
        f32x4 O[2][4], Ol[2] = {f4zero(), f4zero()};
#pragma unroll
        for (int G = 0; G < 2; ++G)
#pragma unroll
            for (int et = 0; et < 4; ++et) O[G][et] = f4zero();
        if (br == 0) attn_branch<2>(Kl, Vl, kb, vb, 0, qblk, qf, s, selm, gselm, cs[1], w, h, c, srow, scol, O, Ol, im);
        else attn_branch<3>(Kl, Vl, kb, vb, s0 >= 511 ? (s0 - 511) >> 6 : 0, qblk, qf, s, selm, gselm, cs[2], w, h, c, srow, scol, O, Ol, im);
#pragma unroll
        for (int G = 0; G < 2; ++G) { const float lsum = Ol[G][0]; const float sc = (br == 0 ? gates[G] : gatew[G]) * (lsum > 0.f ? 1.0f / lsum : 0.f);
#pragma unroll
            for (int et = 0; et < 4; ++et)
#pragma unroll
                for (int r = 0; r < 4; ++r) outl[((G * 4 + et) * 4 + r) * 64] += sc * O[G][et][r]; }
    }
#pragma unroll
    for (int G = 0; G < 2; ++G) { bf16* dst = (bf16*)(ws + WS_CAT) + (size_t)row[G] * 1024 + (g * 4 + hd) * 64 + 4 * h;
#pragma unroll
        for (int et = 0; et < 4; ++et) { f32x4 o;
#pragma unroll
            for (int r = 0; r < 4; ++r) o[r] = outl[((G * 4 + et) * 4 + r) * 64];
            st_bf4(dst + 16 * et, o); } }
}

constexpr int LDH = 136;
DEV void hg_cumsum(const float* fsrc  , float* segs  , int d, int seg, float (&f)[16], float (&bc)[16], float& bend, float& bmid) {
    float run = 0.f;
#pragma unroll
    for (int i = 0; i < 16; ++i) { f[i] = fsrc[(size_t)(16 * seg + i) * 128 + d]; run += log2f(f[i]); bc[i] = run; }
    SYNC();
    segs[seg * 128 + d] = run;
    SYNC();
    const float s0 = segs[d], s1 = segs[128 + d], s2 = segs[256 + d], s3 = segs[384 + d];
    const float off = seg == 0 ? 0.f : (seg == 1 ? s0 : (seg == 2 ? s0 + s1 : s0 + s1 + s2));
#pragma unroll
    for (int i = 0; i < 16; ++i) bc[i] += off;
    bend = s0 + s1 + s2 + s3; bmid = s0 + s1;
}
DEV void hg_write16(bf16* dstrow  , const float (&v)[16]) {
    u32x4 w0, w1;
#pragma unroll
    for (int q = 0; q < 4; ++q) { w0[q] = pk2(v[2 * q], v[2 * q + 1]); w1[q] = pk2(v[8 + 2 * q], v[8 + 2 * q + 1]); }
    *(u32x4*)dstrow = w0; *(u32x4*)(dstrow + 8) = w1;
}
DEV void hg_h1_task(const Args& a, unsigned char* smem, int task) {
    unsigned char* ws = wsp(a); const int tid = TID, w = tid >> 6, l = tid & 63, h = l >> 4, c = l & 15, d = tid & 127, seg = tid >> 7;
    const int bh = task / NCH, ch = task % NCH;
    bf16* kT = (bf16*)smem; bf16* vT = kT + 128 * LDT; float* segs = (float*)(vT + 128 * LDT);
    const size_t tokb = (size_t)bh * SEQ + ch * 64;
    float f[16], bc[16], bend, bmid;
    const bf16* vs = (const bf16*)(ws + WS_HV) + tokb * 128;
    bf16 vraw[16];
#pragma unroll
    for (int i = 0; i < 16; ++i) vraw[i] = vs[(size_t)(16 * seg + i) * 128 + d];
    hg_cumsum((const float*)(ws + WS_HF) + tokb * 128, segs, d, seg, f, bc, bend, bmid);
    float kv[16];
#pragma unroll
    for (int i = 0; i < 16; ++i) kv[i] = (1.0f - f[i]) * fexp2(bend - bc[i]);
    hg_write16(kT + d * LDT + 16 * seg, kv);
#pragma unroll
    for (int i = 0; i < 16; ++i) kv[i] = bf2f(vraw[i]);
    hg_write16(vT + d * LDT + 16 * seg, kv);
    if (seg == 0) ((float*)(ws + WS_GD))[((size_t)bh * NCH + ch) * 128 + d] = fexp2(bend);
    SYNC();
    f32x4 acc[8];
#pragma unroll
    for (int et = 0; et < 8; ++et) acc[et] = f4zero();
#pragma unroll
    for (int ks = 0; ks < 2; ++ks) { const bf16x8 fa = *(const bf16x8*)(kT + (16 * w + c) * LDT + 32 * ks + 8 * h);
#pragma unroll
        for (int et = 0; et < 8; ++et) acc[et] = mfma16(fa, *(const bf16x8*)(vT + (16 * et + c) * LDT + 32 * ks + 8 * h), acc[et]); }
    float* ut = (float*)(ws + WS_UT) + ((size_t)bh * NCH + ch) * 16384;
#pragma unroll
    for (int et = 0; et < 8; ++et) *(f32x4*)(ut + (size_t)(16 * et + c) * 128 + 16 * w + 4 * h) = acc[et];
    SYNC();
}
DEV void hg_scan_task(const Args& a, int sc) {
    unsigned char* ws = wsp(a); const int bh = sc >> 3, q = (sc & 7) * 512 + TID, e = q >> 5, d0 = (q & 31) * 4;
    const float* ut = (const float*)(ws + WS_UT) + (size_t)bh * NCH * 16384 + (size_t)e * 128 + d0;
    const float* gd = (const float*)(ws + WS_GD) + (size_t)bh * NCH * 128 + d0;
    bf16* st = (bf16*)(ws + WS_ST) + (size_t)bh * NCH * 16384 + (size_t)e * 128 + d0;
    f32x4 S = f4zero();
#pragma unroll 4
    for (int ch = 0; ch < NCH; ++ch) { st_bf4(st + (size_t)ch * 16384, S);
        const f32x4 g = *(const f32x4*)(gd + (size_t)ch * 128), u = *(const f32x4*)(ut + (size_t)ch * 16384);
#pragma unroll
        for (int r = 0; r < 4; ++r) S[r] = g[r] * S[r] + u[r]; }
}
DEV void hg_h3_task(const Args& a, unsigned char* smem, int li, int task) {
    unsigned char* ws = wsp(a); const int tid = TID, w = tid >> 6, l = tid & 63, h = l >> 4, c = l & 15, d = tid & 127, seg = tid >> 7;
    const int bh = task / NCH, ch = task % NCH, b = bh >> 2, hh = bh & 3;
    bf16* At = (bf16*)smem; bf16* Bt = At + 64 * LDH; bf16* Qt = Bt + 64 * LDH; bf16* vT = Qt + 64 * LDH; float* segs = (float*)(vT + 128 * LDT); float* part = segs + 512;
    const size_t tokb = (size_t)bh * SEQ + ch * 64;
    float f[16], bc[16], bend, bmid;
    const bf16* qs = (const bf16*)(ws + WS_HQ) + tokb * 128; const bf16* vs = (const bf16*)(ws + WS_HV) + tokb * 128;
    const int tt = w & 3, eh = w >> 2;
    bf16 qraw[16], vraw[16];
#pragma unroll
    for (int i = 0; i < 16; ++i) { const int t = 16 * seg + i; qraw[i] = qs[(size_t)t * 128 + d]; vraw[i] = vs[(size_t)t * 128 + d]; }
    const bf16* stp = (const bf16*)(ws + WS_ST) + ((size_t)bh * NCH + ch) * 16384;
    bf16x8 stf[4][4];
#pragma unroll
    for (int ks = 0; ks < 4; ++ks)
#pragma unroll
        for (int et = 0; et < 4; ++et) stf[ks][et] = *(const bf16x8*)(stp + (size_t)(64 * eh + 16 * et + c) * 128 + 32 * ks + 8 * h);
    const int tok = b * SEQ + ch * 64 + 16 * tt + c;
    const bf16* hg = (const bf16*)(ws + WS_HGS) + (size_t)tok * 512 + hh * 128;
    u32x2 hgv[4];
#pragma unroll
    for (int et = 0; et < 4; ++et) hgv[et] = *(const u32x2*)(hg + 64 * eh + 16 * et + 4 * h);
    hg_cumsum((const float*)(ws + WS_HF) + tokb * 128, segs, d, seg, f, bc, bend, bmid);
    float vv[16];
#pragma unroll
    for (int i = 0; i < 16; ++i) { const int t = 16 * seg + i; const float q = bf2f(qraw[i]);
        At[t * LDH + d] = (bf16)f2bf(q * fexp2(bc[i] - bmid)); Bt[t * LDH + d] = (bf16)f2bf((1.0f - f[i]) * fexp2(bmid - bc[i])); Qt[t * LDH + d] = (bf16)f2bf(q * fexp2(bc[i]));
        vv[i] = bf2f(vraw[i]); }
    hg_write16(vT + d * LDT + 16 * seg, vv);
    SYNC();
    f32x4 O[4];
#pragma unroll
    for (int et = 0; et < 4; ++et) O[et] = f4zero();
#pragma unroll
    for (int sp = 0; sp < 2; ++sp) {
        if (32 * sp > 16 * tt + 15) continue;
        f32x4 st[2];
#pragma unroll
        for (int u = 0; u < 2; ++u) { st[u] = f4zero(); const int krow = 32 * sp + 8 * (c >> 2) + 4 * u + (c & 3);
#pragma unroll
            for (int ks = 0; ks < 4; ++ks) st[u] = mfma16(*(const bf16x8*)(Bt + krow * LDH + 32 * ks + 8 * h), *(const bf16x8*)(At + (16 * tt + c) * LDH + 32 * ks + 8 * h), st[u]);
#pragma unroll
            for (int r = 0; r < 4; ++r) { const int sk = 32 * sp + 8 * h + 4 * u + r; if (sk > 16 * tt + c) st[u][r] = 0.f; } }
        const bf16x8 pb = pack8(st[0], st[1]);
#pragma unroll
        for (int et = 0; et < 4; ++et) O[et] = mfma16(*(const bf16x8*)(vT + (64 * eh + 16 * et + c) * LDT + 32 * sp + 8 * h), pb, O[et]);
    }
#pragma unroll
    for (int ks = 0; ks < 4; ++ks) { const bf16x8 fq = *(const bf16x8*)(Qt + (16 * tt + c) * LDH + 32 * ks + 8 * h);
#pragma unroll
        for (int et = 0; et < 4; ++et) O[et] = mfma16(stf[ks][et], fq, O[et]); }
    float ss = 0.f;
#pragma unroll
    for (int et = 0; et < 4; ++et)
#pragma unroll
        for (int r = 0; r < 4; ++r) ss += O[et][r] * O[et][r];
    ss += shflx(ss, 16); ss += shflx(ss, 32);
    if (h == 0) part[eh * 64 + 16 * tt + c] = ss;
    SYNC();
    const float rs = frsq((part[16 * tt + c] + part[64 + 16 * tt + c]) * (1.0f / 128.0f) + EPS);
    const float* og = INP(a, I_OG) + li * 128;
    bf16* dst = (bf16*)(ws + WS_CAT) + (size_t)tok * 1024 + 512 + hh * 128;
#pragma unroll
    for (int et = 0; et < 4; ++et) { const int e = 64 * eh + 16 * et + 4 * h; f32x4 o; const f32x4 ogv = *(const f32x4*)(og + e);
        o[0] = O[et][0] * rs * ogv[0] * bf2f(hgv[et][0] & 0xffff); o[1] = O[et][1] * rs * ogv[1] * bf2f(hgv[et][0] >> 16);
        o[2] = O[et][2] * rs * ogv[2] * bf2f(hgv[et][1] & 0xffff); o[3] = O[et][3] * rs * ogv[3] * bf2f(hgv[et][1] >> 16);
        st_bf4(dst + e, o); }
    SYNC();
}

DEV void conv_task(const Args& a, unsigned char* smem, int li, int task) {
    unsigned char* ws = wsp(a); const int tid = TID, w = tid >> 6, lane = tid & 63;
    const bool act = tid < DM / 2; const int c0 = act ? 2 * tid : 0;
    const int t0 = task * 16, b = t0 / SEQ, s0 = t0 % SEQ;
    float* red = (float*)smem;
    const float* dw = INP(a, I_DW) + (size_t)li * 31 * DM + c0;
    float acc[16][2];
    const float b0 = INP(a, I_DWB)[li * DM + c0], b1 = INP(a, I_DWB)[li * DM + c0 + 1];
#pragma unroll
    for (int t = 0; t < 16; ++t) { acc[t][0] = b0; acc[t][1] = b1; }
    const bf16* glu = (const bf16*)(ws + WS_GLU) + (size_t)b * SEQ * DM + c0;
    unsigned uu[46];
    { const bf16* gp = glu + (size_t)(s0 - 30) * DM;
#pragma unroll
    for (int r = 0; r < 46; ++r) { const int si = s0 + r - 30; uu[r] = si >= 0 ? *(const unsigned*)gp : 0u; gp += DM; OPAQUE(gp); } }
    const float* dwp = dw;
#pragma unroll
    for (int j = 0; j < 31; ++j) { const float w0 = dwp[0], w1 = dwp[1]; dwp += DM; OPAQUE(dwp);
#pragma unroll
        for (int t = 0; t < 16; ++t) { const unsigned q = uu[t + j]; acc[t][0] += w0 * bf2f(q & 0xffff); acc[t][1] += w1 * bf2f(q >> 16); } }
    float mean[16], rstd[16];
    SYNC();
#pragma unroll
    for (int t = 0; t < 16; ++t) { float s = act ? acc[t][0] + acc[t][1] : 0.f;
#pragma unroll
        for (int o = 1; o < 64; o <<= 1) s += shflx(s, o);
        if (lane == 0) red[w * 16 + t] = s; }
    SYNC();
#pragma unroll
    for (int t = 0; t < 16; ++t) { float s = 0.f;
#pragma unroll
        for (int q = 0; q < 8; ++q) s += red[q * 16 + t];
        mean[t] = s * (1.0f / DM); }
    SYNC();
#pragma unroll
    for (int t = 0; t < 16; ++t) { const float d0 = acc[t][0] - mean[t], d1 = acc[t][1] - mean[t]; float s = act ? d0 * d0 + d1 * d1 : 0.f;
#pragma unroll
        for (int o = 1; o < 64; o <<= 1) s += shflx(s, o);
        if (lane == 0) red[w * 16 + t] = s; }
    SYNC();
#pragma unroll
    for (int t = 0; t < 16; ++t) { float s = 0.f;
#pragma unroll
        for (int q = 0; q < 8; ++q) s += red[q * 16 + t];
        rstd[t] = frsq(s * (1.0f / DM) + EPS); }
    if (act) {
        const float g0 = INP(a, I_LNG)[li * DM + c0], g1 = INP(a, I_LNG)[li * DM + c0 + 1], e0 = INP(a, I_LNB)[li * DM + c0], e1 = INP(a, I_LNB)[li * DM + c0 + 1];
        bf16* dst = (bf16*)(ws + WS_CAT) + (size_t)t0 * DM + c0;
#pragma unroll
        for (int t = 0; t < 16; ++t) { const float y0 = (acc[t][0] - mean[t]) * rstd[t] * g0 + e0, y1 = (acc[t][1] - mean[t]) * rstd[t] * g1 + e1;
            *(unsigned*)(dst + (size_t)t * DM) = pk2(siluf(y0), siluf(y1)); }
    }
}

constexpr int N_PHASES = 1 + 16 * (DEPTH / 2) + 1;
DEV void phase_decode(int ph, int& l, int& sub) {
    const int q = ph - 1, pair = q >> 4, r = q & 15;
    if (r < 9) { l = 2 * pair; sub = r; } else { l = 2 * pair + 1; const int rr = r - 9; sub = rr < 3 ? rr : rr + 2; }
}
constexpr int LDS_BYTES = 150 * 1024;

DEV void run_phase(const Args& a, unsigned char* smem, int ph) {
#ifndef ONLY
#define ONLY -1
#endif
#define EN(k) (ONLY < 0 || ONLY == (k))
    if (ph == 0) { if (EN(100)) p0_phase(a, smem); return; }
    if (ph == N_PHASES - 1) { if (EN(0)) norm_phase(a, smem, DEPTH); return; }
    int l, sub; phase_decode(ph, l, sub); const int li = l >> 1; const bool even = (l & 1) == 0;
    unsigned char* ws = wsp(a);
    switch (sub) {
    case 0: if (EN(0)) norm_phase(a, smem, l); break;
    case 1: if (even) { if (EN(1)) inproj_phase(a, smem, li); } else { if (EN(11)) pw1_phase(a, smem, li); } break;
    case 2:
        if (even) { constexpr int NCI = 8 * ((NCP + 255) / 256); constexpr int NH1 = 8 * NCH;
            if (NBLK > 2 * NCI) { const int bid = BID;
                if (bid < NCI) { if (EN(2)) cmp_phase_items(a, smem, li, bid); }
                else { for (int it = bid - NCI; it < NH1; it += NBLK - NCI) if (EN(12)) hg_h1_task(a, smem, it); } }
            else for (int it = BID; it < NCI + NH1; it += NBLK) { if (it < NCI) { if (EN(2)) cmp_phase_items(a, smem, li, it); } else { if (EN(12)) hg_h1_task(a, smem, it - NCI); } } }
        else { for (int it = BID; it < T / 16; it += NBLK) if (EN(13)) conv_task(a, smem, li, it); }
        break;
    case 3:
        if (even) { constexpr int NA = 4 * (SEQ / 64); const int G = NBLK;
            for (int r = 0; r * G < NA; ++r) { const int it = r * G + ((r & 1) ? (G - 1 - BID) : BID); if (it < NA) { if (EN(3)) attn_task(a, smem, li, it); } }
            for (int it = BID; it < 64; it += NBLK) if (EN(14)) hg_scan_task(a, it); }
        break;
    case 4: if (even) { for (int it = BID; it < 8 * NCH; it += NBLK) if (EN(4)) hg_h3_task(a, smem, li, it); } break;
    case 5:
        if (!EN(5)) break;
        if (even) resid_gemm_phase(a, smem, (const bf16*)(ws + WS_CAT), 1024, (const bf16*)(ws + WS_WOUT) + (size_t)li * DM * 1024, l);
        else resid_gemm_phase(a, smem, (const bf16*)(ws + WS_CAT), DM, (const bf16*)(ws + WS_PW2) + (size_t)li * DM * DM, l);
        break;
    case 6: if (EN(6)) route_phase(a, smem, l); break;
    case 7: if (EN(7)) moe_gemm_phase(a, smem, l, 0); break;
    case 8: if (EN(8)) moe_gemm_phase(a, smem, l, 1); break;
    }
}

#ifndef EMU
#define LAS __attribute__((address_space(3)))
#define XB_TMO      128
#define XB_XCNT(j)  (256  + 64 * (j))
#define XB_XSUB(j)  (1280 + 64 * (j))
#define XB_XGEN(j)  (2304 + 64 * (j))
#define XB_TOP      3328
#define XB_TOPGEN   3392
#define XCD_BAR_WORDS 3456
#define XB_SPIN_CAP (1u << 22)
__device__ __forceinline__ unsigned xb_ld(unsigned* p)              { return __hip_atomic_load(p, __ATOMIC_RELAXED, __HIP_MEMORY_SCOPE_AGENT); }
__device__ __forceinline__ unsigned xb_add(unsigned* p, unsigned v) { return __hip_atomic_fetch_add(p, v, __ATOMIC_RELAXED, __HIP_MEMORY_SCOPE_AGENT); }
__device__ __forceinline__ unsigned xb_xcc_id() { return (unsigned)__builtin_amdgcn_s_getreg((3 << 11) | 20) & 0xFu; }
#define XB_SPIN(cond, bar) do { unsigned _sp = 0; while (cond) { __builtin_amdgcn_s_sleep(1); \
    if ((++_sp & 255u) == 0u) { if (xb_ld(&(bar)[XB_TMO])) break; if (_sp > XB_SPIN_CAP) { atomicAdd(&(bar)[XB_TMO], 1u); break; } } } } while (0)
struct XcdBarrier { unsigned* bar; unsigned x; volatile LAS unsigned* st; };
__device__ __forceinline__ XcdBarrier xcd_barrier_post(unsigned* bar, volatile LAS unsigned* st) {
    XcdBarrier b; b.bar = bar; b.x = xb_xcc_id(); b.st = st;
    if (threadIdx.x == 0) (void)xb_add(&bar[XB_XCNT(b.x)], 1u);
    return b;
}
__device__ __forceinline__ void xcd_barrier_complete(unsigned* bar, unsigned x, unsigned& nloc, unsigned& nx) {
    const unsigned G = gridDim.x * gridDim.y * gridDim.z;
    unsigned sum, cnt, mine, sp = 0u;
    for (;;) {
        sum = 0u; cnt = 0u; mine = 0u;
#pragma unroll
        for (unsigned j = 0; j < 16; ++j) { const unsigned c = xb_ld(&bar[XB_XCNT(j)]); sum += c; cnt += (c > 0u) ? 1u : 0u; mine = (j == x) ? c : mine; }
        if (sum == G) break;
        __builtin_amdgcn_s_sleep(1);
        if ((++sp & 255u) == 0u) { if (xb_ld(&bar[XB_TMO])) break; if (sp > XB_SPIN_CAP) { atomicAdd(&bar[XB_TMO], 1u); break; } }
    }
    nloc = mine > 0u ? mine : 1u; nx = cnt > 0u ? cnt : 1u;
}
__device__ __forceinline__ void xcd_barrier(const XcdBarrier& b) {
    asm volatile("s_waitcnt vmcnt(0)" ::: "memory");
    __syncthreads();
    if (threadIdx.x == 0) {
        unsigned* bar = b.bar;
        __builtin_amdgcn_s_waitcnt(0);
        unsigned nloc = b.st[0], nx = b.st[1];
        if (nloc == 0u) { xcd_barrier_complete(bar, b.x, nloc, nx); b.st[0] = nloc; b.st[1] = nx; }
        const unsigned old = xb_add(&bar[XB_XSUB(b.x)], 1u);
        const unsigned gen = old / nloc;
        if (old + 1u == (gen + 1u) * nloc) {
            __builtin_amdgcn_fence(__ATOMIC_RELEASE, "agent");
            asm volatile("s_waitcnt vmcnt(0)" ::: "memory");
            const unsigned og = xb_add(&bar[XB_TOP], 1u);
            const unsigned tg = og / nx;
            if (og + 1u == (tg + 1u) * nx) xb_add(&bar[XB_TOPGEN], 1u);
            else XB_SPIN(xb_ld(&bar[XB_TOPGEN]) == tg, bar);
            __builtin_amdgcn_fence(__ATOMIC_ACQUIRE, "agent");
            xb_add(&bar[XB_XGEN(b.x)], 1u);
            asm volatile("s_waitcnt vmcnt(0)" ::: "memory");
        } else {
            XB_SPIN(xb_ld(&bar[XB_XGEN(b.x)]) == gen, bar);
            __builtin_amdgcn_fence(__ATOMIC_ACQUIRE, "agent");
            asm volatile("s_waitcnt vmcnt(0)" ::: "memory");
        }
    }
    __syncthreads();
}

__global__ void __launch_bounds__(NT, 2) mega(Args a) {
    extern __shared__ __attribute__((aligned(16))) unsigned char lds[];
    volatile LAS unsigned* st = (volatile LAS unsigned*)(LAS unsigned char*)(lds + LDS_BYTES - 16);
    if (threadIdx.x < 4) st[threadIdx.x] = 0u;
    __syncthreads();
    unsigned* barw = (unsigned*)(a.ws + WS_BAR);
    XcdBarrier bar = xcd_barrier_post(barw, st);
#pragma unroll 1
    for (int ph = 0; ph < N_PHASES; ++ph) {
        run_phase(a, lds, ph);
#ifdef DUP
        { int lyr = 0, sub = 100; if (ph > 0 && ph < N_PHASES - 1) phase_decode(ph, lyr, sub);
          if (sub == (DUP % 1000) && (ph == 0 || lyr == DUP / 1000) && ph < N_PHASES - 1) { xcd_barrier(bar); run_phase(a, lds, ph); } }
#endif
        if (ph + 1 < N_PHASES) xcd_barrier(bar);
    }
    if (xb_ld(&barw[XB_TMO]) != 0u) {
        const size_t gt = (size_t)blockIdx.x * NT + threadIdx.x, gs = (size_t)gridDim.x * NT;
        for (size_t i = gt; i < (size_t)T * DM; i += gs) a.out[i] = __builtin_nanf("");
    }
}

extern "C" void kernel_launch(void* const* d_in, const int* in_sizes, int n_in, void* d_out, int out_size,
                              void* d_ws, size_t ws_size, hipStream_t stream) {
    static int grid = 0;
    if (grid == 0) {
        int dev = 0, cus = 0;
        if (hipGetDevice(&dev) != hipSuccess || hipDeviceGetAttribute(&cus, hipDeviceAttributeMultiprocessorCount, dev) != hipSuccess) { grid = -1; return; }
        if (hipFuncSetAttribute((const void*)mega, hipFuncAttributeMaxDynamicSharedMemorySize, LDS_BYTES) != hipSuccess) { grid = -1; return; }
        (void)hipGetLastError();
        grid = cus;
        if (n_in != 26 || out_size != T * DM || ws_size < WS_END) { fprintf(stderr, "kernel_launch: unexpected sizes n_in %d out %d ws %zu (need %zu)\n", n_in, out_size, ws_size, (size_t)WS_END); grid = -1; return; }
    }
    if (grid < 0) return;
    (void)hipMemsetAsync((unsigned char*)d_ws + WS_BAR, 0, XCD_BAR_WORDS * 4, stream);
    Args a{};
    for (int i = 0; i < 26; ++i) a.in[i] = (const float*)d_in[i];
    a.out = (float*)d_out; a.ws = (unsigned char*)d_ws;
    hipLaunchKernelGGL(mega, dim3(grid), dim3(NT), LDS_BYTES, stream, a);
}
#endif
```

```cpp
#ifdef EMU
#include "emu.h"
#define DEV static inline
#define MDEV inline
#define OPAQUE(p)
#define OPAQUE2(a, b)
#define TID emu_tid()
#define BID (EB->bid)
#define NBLK (EB->nblk)
#define SYNC() emu_sync_block()
#define WSYNC() emu_sync_wave()
#define mfma16(a, b, c) emu_mfma16(a, b, c)
DEV float shflx(float v, int m) { return emu_shfl_f(v, (emu_tid() & 63) ^ m); }
DEV int shflxi(int v, int m) { return (int)emu_shfl_u((unsigned)v, (emu_tid() & 63) ^ m); }
DEV float shfl(float v, int s) { return emu_shfl_f(v, s); }
DEV float dpp_ror1(float v) { const int l = emu_tid() & 63; return emu_shfl_f(v, (l & 48) | ((l - 1) & 15)); }
DEV int atomic_add_i(int* p, int v) { return __atomic_fetch_add(p, v, __ATOMIC_RELAXED); }
DEV float fexp2(float x) { return exp2f(x); }
DEV float frcp(float x) { return 1.0f / x; }
DEV float frsq(float x) { return 1.0f / sqrtf(x); }
typedef short s16x4 __attribute__((vector_size(8)));
static inline s16x4 emu_tr4(const unsigned short* p) {
    EmuWave& w = EB->wave[emu_tid() >> 6]; int l = emu_tid() & 63;
    const unsigned short** tab = (const unsigned short**)w.a;
    tab[l] = p; emu_sync_wave();
    s16x4 r; int g = l & 48, i = l & 15;
    for (int q = 0; q < 4; ++q) r[q] = (short)tab[g + 4 * q + (i >> 2)][i & 3];
    emu_sync_wave(); return r;
}
#define tr4(p) emu_tr4(p)
#else
#include <hip/hip_runtime.h>
#include <cstdio>
#include <cstdint>
typedef short bf16x8 __attribute__((ext_vector_type(8)));
typedef float f32x4 __attribute__((ext_vector_type(4)));
typedef unsigned u32x4 __attribute__((ext_vector_type(4)));
typedef unsigned u32x2 __attribute__((ext_vector_type(2)));
#define DEV __device__ __forceinline__
#define MDEV __device__ __forceinline__
#define OPAQUE(p) asm volatile("" : "+v"(p))
#define OPAQUE2(a, b) asm volatile("" : "+v"(a), "+v"(b))
DEV int tid_opaque() { int t = (int)threadIdx.x; asm volatile("" : "+v"(t)); return t; }
#define TID tid_opaque()
DEV int bid_opaque() { int b = (int)blockIdx.x; asm volatile("" : "+s"(b)); return b; }
#define BID bid_opaque()
#define NBLK ((int)gridDim.x)
#define SYNC() __syncthreads()
#define WSYNC() __builtin_amdgcn_wave_barrier()
#define mfma16(a, b, c) __builtin_amdgcn_mfma_f32_16x16x32_bf16(a, b, c, 0, 0, 0)
DEV int shflxi(int x, int m) {
    if (m == 1) return __builtin_amdgcn_update_dpp(x, x, 0xB1, 0xf, 0xf, true);
    if (m == 2) return __builtin_amdgcn_update_dpp(x, x, 0x4E, 0xf, 0xf, true);
    if (m == 4) return __builtin_amdgcn_ds_swizzle(x, (4 << 10) | 0x1F);
    if (m == 8) return __builtin_amdgcn_ds_swizzle(x, (8 << 10) | 0x1F);
    if (m == 16) return __builtin_amdgcn_ds_swizzle(x, (16 << 10) | 0x1F);
    if (m == 32) { const auto r = __builtin_amdgcn_permlane32_swap((unsigned)x, (unsigned)x, false, false); return (int)((threadIdx.x & 32) ? r[0] : r[1]); }
    return __shfl_xor(x, m);
}
DEV float shflx(float v, int m) { return __builtin_bit_cast(float, shflxi(__builtin_bit_cast(int, v), m)); }
DEV float dpp_ror1(float v) { return __builtin_bit_cast(float, __builtin_amdgcn_update_dpp(0, __builtin_bit_cast(int, v), 0x121, 0xf, 0xf, false)); }
DEV float shfl(float v, int s) { return __shfl(v, s); }
DEV int atomic_add_i(int* p, int v) { return atomicAdd(p, v); }
DEV float fexp2(float x) { return __builtin_amdgcn_exp2f(x); }
DEV float frcp(float x) { return __builtin_amdgcn_rcpf(x); }
DEV float frsq(float x) { return __builtin_amdgcn_rsqf(x); }
typedef short s16x4 __attribute__((ext_vector_type(4)));
#define tr4(p) __builtin_amdgcn_ds_read_tr16_b64_v4i16((__attribute__((address_space(3))) s16x4*)(p))
#endif

typedef unsigned short bf16;

#ifndef DM
#define DM 1024
#endif
#ifndef SEQ
#define SEQ 8192
#endif
#ifndef FF
#define FF 512
#endif
constexpr int NBATCH = 2, T = NBATCH * SEQ, DEPTH = 4;
constexpr int NIN = 3352, NINP = 3456, NIN8 = 3584;
constexpr int NT = 512;
constexpr int NCH = SEQ / 64;
constexpr int NCP = SEQ / 16;
constexpr int NCMP = NCP - 1;
constexpr int MOE_ROWS = 2 * T + 32 * 256;
constexpr float EPS = 1e-6f, NEGV = -1e30f, FORCEV = 1e4f, LOG2E = 1.4426950408889634f;

constexpr size_t al(size_t x) { return (x + 255) & ~(size_t)255; }
constexpr size_t WS_BAR = 0;
constexpr size_t WS_CNT = 16384;
constexpr size_t WS_MOD = WS_CNT + (size_t)DEPTH * 32 * 256;
constexpr size_t WS_LB = al(WS_MOD + (size_t)DEPTH * 2 * 6 * DM * 4);
constexpr size_t WS_CB = al(WS_LB + 2 * 512 * 4);
constexpr size_t WS_CS = al(WS_CB + 2 * 2 * 8 * 64 * 4);
constexpr size_t WS_WIN = al(WS_CS + 64);
constexpr size_t WS_WOUT = al(WS_WIN + (size_t)2 * NIN8 * DM * 2);
constexpr size_t WS_PW1 = al(WS_WOUT + (size_t)2 * DM * 1024 * 2);
constexpr size_t WS_PW2 = al(WS_PW1 + (size_t)2 * 2 * DM * DM * 2);
constexpr size_t WS_WC = al(WS_PW2 + (size_t)2 * DM * DM * 2);
constexpr size_t WS_W13 = al(WS_WC + (size_t)2 * 2 * 64 * 2048 * 2);
constexpr size_t WS_W2 = al(WS_W13 + (size_t)DEPTH * 32 * 2 * FF * DM * 2);
constexpr size_t WS_H = al(WS_W2 + (size_t)DEPTH * 32 * DM * FF * 2);
constexpr size_t WS_QN = al(WS_H + (size_t)T * DM * 2);
constexpr size_t WS_KCG = al(WS_QN + (size_t)T * 512 * 2);
constexpr size_t WS_VCG = al(WS_KCG + (size_t)T * 128 * 2);
constexpr size_t WS_KS = al(WS_VCG + (size_t)T * 128 * 2);
constexpr size_t WS_KW = al(WS_KS + (size_t)T * 128 * 2);
constexpr size_t WS_VST = al(WS_KW + (size_t)T * 128 * 2);
constexpr size_t WS_VWT = al(WS_VST + (size_t)T * 128 * 2);
constexpr size_t WS_KC = al(WS_VWT + (size_t)T * 128 * 2);
constexpr size_t WS_VCT = al(WS_KC + (size_t)4 * NCP * 64 * 2);
constexpr size_t WS_GATE = al(WS_VCT + (size_t)4 * NCP * 64 * 2);
constexpr size_t WS_HQ = al(WS_GATE + (size_t)T * 24 * 4);
constexpr size_t WS_HF = al(WS_HQ + (size_t)T * 512 * 2);
constexpr size_t WS_HV = al(WS_HF + (size_t)T * 512 * 4);
constexpr size_t WS_HGS = al(WS_HV + (size_t)T * 512 * 2);
constexpr size_t WS_UT = al(WS_HGS + (size_t)T * 512 * 2);
constexpr size_t WS_ST = al(WS_UT + (size_t)8 * NCH * 128 * 128 * 4);
constexpr size_t WS_GD = al(WS_ST + (size_t)8 * NCH * 128 * 128 * 2);
constexpr size_t WS_CAT = al(WS_GD + (size_t)8 * NCH * 128 * 4);
constexpr size_t WS_GLU = al(WS_CAT + (size_t)T * 1024 * 2);
constexpr size_t WS_TIE = al(WS_GLU + (size_t)T * DM * 2);
constexpr size_t WS_TIW = al(WS_TIE + (size_t)T * 2 * 4);
constexpr size_t WS_LIST = al(WS_TIW + (size_t)T * 2 * 4);
constexpr size_t WS_ACT = al(WS_LIST + (size_t)32 * T * 4);
constexpr size_t WS_YK = al(WS_ACT + (size_t)MOE_ROWS * FF * 2);
constexpr size_t WS_WTH = al(WS_YK + (size_t)MOE_ROWS * DM * 2);
constexpr size_t WS_WTL = al(WS_WTH + (size_t)DEPTH * 48 * DM * 2);
constexpr size_t WS_AVEC = al(WS_WTL + (size_t)DEPTH * 48 * DM * 2);
constexpr size_t WS_RBIAS = al(WS_AVEC + (size_t)DEPTH * 2 * DM * 4);
constexpr size_t WS_END = al(WS_RBIAS + (size_t)DEPTH * 2 * 48 * 4);

struct Args { const float* in[26]; float* out; unsigned char* ws; };
enum { I_X = 0, I_C, I_ADAW, I_ADAB, I_NMIX, I_NFFN, I_WIN, I_WOUT, I_CWK, I_CWV, I_CPE, I_QG, I_KG, I_LBL, I_OG,
       I_PW1, I_DW, I_DWB, I_LNG, I_LNB, I_PW2, I_WG, I_WE, I_W1, I_W3, I_W2 };

#ifdef EMU
DEV unsigned char* wsp(const Args& a) { return a.ws; }
DEV float* outp(const Args& a) { return a.out; }
#else
DEV unsigned char* launder_ptr(const void* p) { unsigned long long v = (unsigned long long)p; unsigned lo = (unsigned)v, hi = (unsigned)(v >> 32);
    lo = (unsigned)__builtin_amdgcn_readfirstlane((int)lo); hi = (unsigned)__builtin_amdgcn_readfirstlane((int)hi); asm volatile("" : "+s"(lo), "+s"(hi)); typedef __attribute__((address_space(1))) unsigned char* gptr_t; return (unsigned char*)(gptr_t)(((unsigned long long)hi << 32) | lo); }
DEV unsigned char* wsp(const Args& a) { return launder_ptr(a.ws); }
DEV float* outp(const Args& a) { return (float*)launder_ptr(a.out); }
#endif

#ifdef EMU
#define INP(a, X) ((a).in[X])
#else
DEV int zero_opaque() { int z = 0; asm volatile("" : "+s"(z)); return z; }
#define INP(a, X) ((a).in[(X) + zero_opaque()])
#endif

DEV unsigned f2bf(float f) { unsigned u = __builtin_bit_cast(unsigned, f); return (u + 0x7fffu + ((u >> 16) & 1u)) >> 16; }
DEV float bf2f(unsigned h) { return __builtin_bit_cast(float, h << 16); }
#ifdef EMU
DEV unsigned pk2(float lo, float hi) { return f2bf(lo) | (f2bf(hi) << 16); }
#else
typedef float f32x2_t __attribute__((ext_vector_type(2)));
typedef __bf16 bf16x2_t __attribute__((ext_vector_type(2)));
DEV unsigned pk2(float lo, float hi) { f32x2_t v = {lo, hi}; bf16x2_t b = __builtin_convertvector(v, bf16x2_t); return __builtin_bit_cast(unsigned, b); }
#endif
DEV float sigm(float x) { return frcp(1.0f + fexp2(-x * LOG2E)); }
DEV float siluf(float x) { return x * sigm(x); }
DEV f32x4 f4zero() { f32x4 z = {0.f, 0.f, 0.f, 0.f}; return z; }
DEV bf16x8 pack8(f32x4 a, f32x4 b) {
    u32x4 w; w[0] = pk2(a[0], a[1]); w[1] = pk2(a[2], a[3]); w[2] = pk2(b[0], b[1]); w[3] = pk2(b[2], b[3]);
    return __builtin_bit_cast(bf16x8, w);
}
DEV void st_bf8(bf16* p, f32x4 a, f32x4 b) { u32x4 w; w[0] = pk2(a[0], a[1]); w[1] = pk2(a[2], a[3]); w[2] = pk2(b[0], b[1]); w[3] = pk2(b[2], b[3]); *(u32x4*)p = w; }
DEV void st_bf4(bf16* p, f32x4 v) { u32x2 w; w[0] = pk2(v[0], v[1]); w[1] = pk2(v[2], v[3]); *(u32x2*)p = w; }


#ifdef EMU
namespace pg8 {
constexpr int BM = 256, BK = 64, HALF = 128, NXCD = 8, WGM = 8;
typedef unsigned short bf16_t;
struct Unit { int pm, pn; };
struct Gemm { const bf16_t* A; const bf16_t* Bt; int M, N, K; };
struct StaticOrder {
    int nM, nN, nwg, G, c;
    void init(int M, int N, int G_, int c_) { nM = M / BM; nN = N / BM; nwg = nM * nN; G = G_; c = c_; }
    bool next(int i, Unit& u) const {
        const long L = (long)i * G + c; if (L >= nwg) return false;
        int wgid = (int)L; { const int q = nwg / NXCD, r = nwg % NXCD, xcd = wgid % NXCD, off = wgid / NXCD; wgid = (xcd < r ? xcd * (q + 1) : r * (q + 1) + (xcd - r) * q) + off; }
        const int nig = WGM * nN, gid = wgid / nig, fm = gid * WGM, gsz = (nM - fm) < WGM ? (nM - fm) : WGM;
        u.pm = fm + ((wgid % nig) % gsz); u.pn = (wgid % nig) / gsz; return true;
    }
};
struct SelNone { static constexpr bool GATHER = false; struct Ctx {}; Ctx ctx(const Unit&) const { return Ctx(); } size_t boff(const Ctx&) const { return 0; } unsigned aoff(const Ctx&, int) const { return 0u; } };
template <class Epi, class Sched, bool ALIGN_EPI = false, bool SP2 = false, class Sel = SelNone>
static inline void gemm_phase(unsigned char*, const Gemm g, const Sched& S, const Epi& E, const Sel& X = Sel()) {
    const int tid = emu_tid(), wid = tid >> 6, lane = tid & 63, wr = wid >> 2, wc = wid & 3, fr = lane & 15, fq = lane >> 4;
    Unit u;
    for (int ui = 0; S.next(ui, u); ++ui) {
        f32x4 acc[2][2][4][2]; const auto cx = X.ctx(u);
        for (int ai = 0; ai < 2; ++ai) for (int bj = 0; bj < 2; ++bj) for (int m = 0; m < 4; ++m) for (int n = 0; n < 2; ++n) for (int r = 0; r < 4; ++r) {
            const int row = 256 * u.pm + 128 * ai + 64 * wr + 16 * m + fr, col = 256 * u.pn + 128 * bj + 32 * wc + (Epi::PERM ? 8 * fq + 4 * n + r : 16 * n + 4 * fq + r); float sum = 0.f;
            const bf16_t* ap = Sel::GATHER ? (const bf16_t*)((const char*)g.A + X.aoff(cx, row - 256 * u.pm)) : g.A + (size_t)row * g.K; const bf16_t* bp = (const bf16_t*)((const char*)g.Bt + X.boff(cx)) + (size_t)col * g.K;
            for (int k = 0; k < g.K; ++k) sum += bf2f(ap[k]) * bf2f(bp[k]);
            acc[ai][bj][m][n][r] = sum; }
        E(acc, u, wr, wc, fr, fq);
    }
    emu_sync_block();
}
}
#else
namespace pg8 {
#define PG8_LAS __attribute__((address_space(3)))
typedef unsigned short bf16_t;
typedef short bf16x8 __attribute__((ext_vector_type(8)));
typedef float f32x4 __attribute__((ext_vector_type(4)));
typedef unsigned u32x4 __attribute__((ext_vector_type(4)));
constexpr int BM = 256, BK = 64, HALF = 128, HTB = HALF * BK * 2  , STAGE_BYTES = 8 * HTB, NXCD = 8, WGM = 8;

__host__ __device__ __forceinline__ int lds_byte(int r, int c) { const int st = (r >> 4) * 2 + (c >> 5), rr = r & 15, cc = c & 31, ob = rr * 64 + cc * 2; return st * 1024 + (ob ^ (((ob >> 9) & 1) << 5)); }
__host__ __device__ __forceinline__ void stage_rc(int b, int& R, int& C) { const int st = b / 1024, sb = b % 1024, swz = sb ^ (((sb >> 9) & 1) << 5); R = (st >> 1) * 16 + swz / 64; C = (st & 1) * 32 + (swz % 64) / 2; }
__host__ __device__ __forceinline__ int perm32(int rho) { const int n = rho >> 4, i = rho & 15; return 8 * (i >> 2) + 4 * n + (i & 3); }

struct Unit { int pm, pn; };
struct Gemm { const bf16_t* A; const bf16_t* Bt; int M, N, K; };

struct StaticOrder {
    int nM, nN, nwg, G, c;
    __host__ __device__ void init(int M, int N, int G_, int c_) { nM = M / BM; nN = N / BM; nwg = nM * nN; G = G_; c = c_; }
    __host__ __device__ bool next(int i, Unit& u) const {
        const long L = (long)i * G + c; if (L >= nwg) return false;
        int wgid = (int)L; { const int q = nwg / NXCD, r = nwg % NXCD, xcd = wgid % NXCD, off = wgid / NXCD; wgid = (xcd < r ? xcd * (q + 1) : r * (q + 1) + (xcd - r) * q) + off; }
        const int nig = WGM * nN, gid = wgid / nig, fm = gid * WGM, gsz = (nM - fm) < WGM ? (nM - fm) : WGM;
        u.pm = fm + ((wgid % nig) % gsz); u.pn = (wgid % nig) / gsz; return true;
    }
    __device__ __forceinline__ void a_ready(const Unit&) const {}
    __device__ __forceinline__ void done(const Unit&) const {}
};

__device__ __forceinline__ unsigned cvt_pk_bf16(float lo, float hi) { unsigned r; asm volatile("v_cvt_pk_bf16_f32 %0, %1, %2" : "=v"(r) : "v"(lo), "v"(hi)); return r; }
struct SelNone { static constexpr bool GATHER = false; struct Ctx {}; __device__ __forceinline__ Ctx ctx(const Unit&) const { return Ctx(); } __device__ __forceinline__ size_t boff(const Ctx&) const { return 0; } __device__ __forceinline__ unsigned aoff(const Ctx&, int) const { return 0u; } };
template <class Epi, class Sched, bool ALIGN_EPI = false, bool SP2 = false, class Sel = SelNone>
__device__ __forceinline__ void gemm_phase(PG8_LAS unsigned char* lds, const Gemm g, const Sched& S, const Epi& E, const Sel& X = Sel()) {
    constexpr bool GA = Sel::GATHER;
    const int tid = TID, wid = __builtin_amdgcn_readfirstlane(tid >> 6), lane = tid & 63, wr = wid >> 2, wc = wid & 3, fr = lane & 15, fq = lane >> 4;
    const int K = g.K, nt = K / BK;
    unsigned voffA[2], voffB[2]; int Rl[2]; unsigned Cl2[2];
#pragma unroll
    for (int i = 0; i < 2; ++i) { int R, C; stage_rc(tid * 16 + i * 8192, R, C); const int Rb = Epi::PERM ? ((R & ~31) + perm32(R & 31)) : R;
        voffA[i] = (unsigned)(R * K + C) * 2u; voffB[i] = (unsigned)(Rb * K + C) * 2u; Rl[i] = R; Cl2[i] = (unsigned)C * 2u; }
    unsigned vA[2][2], vAn[2][2];
    const size_t kstep = (size_t)(BK * 2);
    const size_t hstep = (size_t)HALF * K * 2;
    const size_t tstep = 2 * hstep;
    const unsigned ldsw = (unsigned)wid * 1024u;
    const int aoff = lds_byte(wr * 64 + fr, fq * 8), boff = lds_byte(wc * 32 + fr, fq * 8);
#define PG8_SA(b, h) (((b) * 2 + (h)) * HTB)
#define PG8_SB(b, h) ((4 + (b) * 2 + (h)) * HTB)
#define PG8_STAGE(bufoff, gbase, voff) do { _Pragma("unroll") for (int _i = 0; _i < 2; ++_i) \
        __builtin_amdgcn_global_load_lds((const unsigned*)((const char*)(gbase) + (voff)[_i]), (PG8_LAS unsigned*)(lds + (bufoff) + ldsw + _i * 8192), 16, 0, 0); } while (0)
#define PG8_STAGE_A(bufoff, p, h, nx) do { if constexpr (GA) { unsigned _vo[2] = {(nx) ? vAn[h][0] : vA[h][0], (nx) ? vAn[h][1] : vA[h][1]}; PG8_STAGE(bufoff, p, _vo); } else { PG8_STAGE(bufoff, (p) + (h) * hstep, voffA); } } while (0)
#define PG8_GATH(cx, dst) do { _Pragma("unroll") for (int _h = 0; _h < 2; ++_h) _Pragma("unroll") for (int _i = 0; _i < 2; ++_i) dst[_h][_i] = X.aoff(cx, 128 * _h + Rl[_i]) + Cl2[_i]; } while (0)
#define PG8_LDA(dst, b, h) do { _Pragma("unroll") for (int m = 0; m < 4; ++m) _Pragma("unroll") for (int k = 0; k < 2; ++k) dst[m][k] = *(const PG8_LAS bf16x8*)(lds + PG8_SA(b, h) + aoff + m * 2048 + k * 1024); } while (0)
#define PG8_LDB(dst, b, h) do { _Pragma("unroll") for (int n = 0; n < 2; ++n) _Pragma("unroll") for (int k = 0; k < 2; ++k) dst[n][k] = *(const PG8_LAS bf16x8*)(lds + PG8_SB(b, h) + boff + n * 2048 + k * 1024); } while (0)
#define PG8_MMA(ai, bj, At, Bt) do { __builtin_amdgcn_s_setprio(1); _Pragma("unroll") for (int m = 0; m < 4; ++m) _Pragma("unroll") for (int n = 0; n < 2; ++n) _Pragma("unroll") for (int k = 0; k < 2; ++k) \
        acc[ai][bj][m][n] = __builtin_amdgcn_mfma_f32_16x16x32_bf16(Bt[n][k], At[m][k], acc[ai][bj][m][n], 0, 0, 0); __builtin_amdgcn_s_setprio(0); } while (0)
#define PG8_WAIT_V(n) asm volatile("s_waitcnt vmcnt(" #n ")" ::: "memory")
#define PG8_WAIT_L(n) asm volatile("s_waitcnt lgkmcnt(" #n ")" ::: "memory")
#define PG8_BAR __builtin_amdgcn_s_barrier()
#define PG8_SCHED __builtin_amdgcn_sched_barrier(0)
    Unit cur, nxt; int ui = 0;
    if (!S.next(0, cur)) return;
    f32x4 acc[2][2][4][2];
#pragma unroll
    for (int a = 0; a < 2; ++a)
#pragma unroll
        for (int b = 0; b < 2; ++b)
#pragma unroll
            for (int m = 0; m < 4; ++m)
#pragma unroll
                for (int n = 0; n < 2; ++n) acc[a][b][m][n] = (f32x4){0.f, 0.f, 0.f, 0.f};
    bf16x8 At[4][2], B0[2][2], B1[2][2];
    auto ccx = X.ctx(cur);
    const char* cA = GA ? (const char*)g.A : (const char*)g.A + (size_t)cur.pm * tstep; const char* cB = (const char*)g.Bt + X.boff(ccx) + (size_t)cur.pn * tstep;
    if constexpr (GA) { PG8_GATH(ccx, vA); }
    S.a_ready(cur);
    if constexpr (SP2) {
        PG8_STAGE(PG8_SB(0, 0), cB, voffB); PG8_STAGE(PG8_SB(0, 1), cB + hstep, voffB); PG8_STAGE_A(PG8_SA(0, 0), cA, 0, false); PG8_STAGE_A(PG8_SA(0, 1), cA, 1, false);
        if (wr == 1) PG8_BAR;
        PG8_WAIT_V(2); PG8_BAR;
        PG8_STAGE(PG8_SB(1, 0), cB + kstep, voffB); PG8_STAGE_A(PG8_SA(1, 0), cA + kstep, 0, false); PG8_STAGE(PG8_SB(1, 1), cB + hstep + kstep, voffB);
        PG8_WAIT_V(6); PG8_BAR;
    } else {
        PG8_STAGE(PG8_SB(0, 0), cB, voffB); PG8_STAGE_A(PG8_SA(0, 0), cA, 0, false); PG8_STAGE(PG8_SB(0, 1), cB + hstep, voffB); PG8_STAGE_A(PG8_SA(0, 1), cA, 1, false);
        if (wr == 1) PG8_BAR;
        PG8_WAIT_V(4); PG8_BAR;
        PG8_STAGE(PG8_SB(1, 0), cB + kstep, voffB); PG8_STAGE_A(PG8_SA(1, 0), cA + kstep, 0, false); PG8_STAGE(PG8_SB(1, 1), cB + hstep + kstep, voffB);
        PG8_WAIT_V(6); PG8_BAR;
    }
    for (;;) {
        const bool has_next = S.next(ui + 1, nxt);
        const char* nA = cA; const char* nB = cB;
        if (has_next) { const auto ncx = X.ctx(nxt); nA = GA ? (const char*)g.A : (const char*)g.A + (size_t)nxt.pm * tstep; nB = (const char*)g.Bt + X.boff(ncx) + (size_t)nxt.pn * tstep; if constexpr (GA) { PG8_GATH(ncx, vAn); } }
        else if constexpr (GA) {
#pragma unroll
            for (int _h = 0; _h < 2; ++_h) { vAn[_h][0] = vA[_h][0]; vAn[_h][1] = vA[_h][1]; } }
        for (int t = 0; t < nt; t += 2) {
            const bool last = (t == nt - 2);
            const char* a1 = cA + (size_t)(t + 1) * kstep;
            const char* a2 = last ? nA : cA + (size_t)(t + 2) * kstep; const char* b2 = last ? nB : cB + (size_t)(t + 2) * kstep;
            const char* a3 = a2 + kstep; const char* b3 = b2 + kstep;
            if (last && has_next) S.a_ready(nxt);
            if constexpr (SP2) {
            PG8_LDB(B0, 0, 0); PG8_LDB(B1, 0, 1); PG8_SCHED; PG8_LDA(At, 0, 0); PG8_STAGE_A(PG8_SA(1, 1), a1, 1, false);
            PG8_WAIT_V(8); PG8_WAIT_L(0); PG8_BAR; PG8_MMA(0, 0, At, B0); PG8_MMA(0, 1, At, B1); PG8_BAR; PG8_SCHED;
            PG8_LDA(At, 0, 1); PG8_STAGE(PG8_SB(0, 0), b2, voffB); PG8_STAGE(PG8_SB(0, 1), b2 + hstep, voffB); PG8_STAGE_A(PG8_SA(0, 0), a2, 0, last);
            PG8_WAIT_V(8); PG8_WAIT_L(0); PG8_BAR; PG8_MMA(1, 0, At, B0); PG8_MMA(1, 1, At, B1); PG8_BAR; PG8_SCHED;
            PG8_LDB(B0, 1, 0); PG8_LDB(B1, 1, 1); PG8_SCHED; PG8_LDA(At, 1, 0); PG8_STAGE_A(PG8_SA(0, 1), a2, 1, last);
            PG8_WAIT_V(8); PG8_WAIT_L(0); PG8_BAR; PG8_MMA(0, 0, At, B0); PG8_MMA(0, 1, At, B1); PG8_BAR; PG8_SCHED;
            PG8_LDA(At, 1, 1); PG8_STAGE(PG8_SB(1, 0), b3, voffB); PG8_STAGE(PG8_SB(1, 1), b3 + hstep, voffB); PG8_STAGE_A(PG8_SA(1, 0), a3, 0, last);
            PG8_WAIT_V(8); PG8_WAIT_L(0); PG8_BAR; PG8_MMA(1, 0, At, B0); PG8_MMA(1, 1, At, B1); PG8_BAR; PG8_SCHED;
            } else {
            PG8_LDB(B0, 0, 0); PG8_SCHED; PG8_LDA(At, 0, 0); PG8_STAGE_A(PG8_SA(1, 1), a1, 1, false);
            PG8_WAIT_L(8); PG8_BAR; PG8_WAIT_L(0); PG8_MMA(0, 0, At, B0); PG8_BAR; PG8_SCHED;
            PG8_LDB(B1, 0, 1); PG8_STAGE(PG8_SB(0, 0), b2, voffB);
            PG8_BAR; PG8_WAIT_L(0); PG8_MMA(0, 1, At, B1); PG8_BAR;
            PG8_LDA(At, 0, 1); PG8_STAGE_A(PG8_SA(0, 0), a2, 0, last);
            PG8_BAR; PG8_WAIT_L(0); PG8_MMA(1, 0, At, B0); PG8_BAR; PG8_SCHED;
            PG8_STAGE(PG8_SB(0, 1), b2 + hstep, voffB);
            PG8_WAIT_V(6); PG8_BAR; PG8_MMA(1, 1, At, B1); PG8_BAR;
            PG8_LDB(B0, 1, 0); PG8_SCHED; PG8_LDA(At, 1, 0); PG8_STAGE_A(PG8_SA(0, 1), a2, 1, last);
            PG8_WAIT_L(8); PG8_BAR; PG8_WAIT_L(0); PG8_MMA(0, 0, At, B0); PG8_BAR; PG8_SCHED;
            PG8_LDB(B1, 1, 1); PG8_STAGE(PG8_SB(1, 0), b3, voffB);
            PG8_BAR; PG8_WAIT_L(0); PG8_MMA(0, 1, At, B1); PG8_BAR;
            PG8_LDA(At, 1, 1); PG8_STAGE_A(PG8_SA(1, 0), a3, 0, last);
            PG8_BAR; PG8_WAIT_L(0); PG8_MMA(1, 0, At, B0); PG8_BAR; PG8_SCHED;
            PG8_STAGE(PG8_SB(1, 1), b3 + hstep, voffB);
            PG8_WAIT_V(6); PG8_BAR; PG8_MMA(1, 1, At, B1); PG8_BAR;
            }
        }
        if constexpr (ALIGN_EPI) { if (wr == 0) PG8_BAR; }
        if constexpr (!Epi::AFTER_DRAIN) { E(acc, cur, wr, wc, fr, fq); S.done(cur); }
        if (!has_next) break;
#pragma unroll
        for (int a = 0; a < 2; ++a)
#pragma unroll
            for (int b = 0; b < 2; ++b)
#pragma unroll
                for (int m = 0; m < 4; ++m)
#pragma unroll
                    for (int n = 0; n < 2; ++n) acc[a][b][m][n] = (f32x4){0.f, 0.f, 0.f, 0.f};
        cur = nxt; cA = nA; cB = nB; ++ui;
        if constexpr (GA) {
#pragma unroll
            for (int _h = 0; _h < 2; ++_h) { vA[_h][0] = vAn[_h][0]; vA[_h][1] = vAn[_h][1]; } }
        if constexpr (ALIGN_EPI) { if (wr == 1) PG8_BAR; }
    }
    PG8_WAIT_V(0);
    if constexpr (!ALIGN_EPI) { if (wr == 0) PG8_BAR; }
    PG8_BAR;
    if constexpr (Epi::AFTER_DRAIN) { E.fused(acc, cur, wr, wc, fr, fq, lds, wid, lane); S.done(cur); }
#undef PG8_SA
#undef PG8_SB
#undef PG8_STAGE
#undef PG8_STAGE_A
#undef PG8_GATH
#undef PG8_LDA
#undef PG8_LDB
#undef PG8_MMA
#undef PG8_WAIT_V
#undef PG8_WAIT_L
#undef PG8_BAR
#undef PG8_SCHED
}
}
#endif

constexpr int LDT = 72;
constexpr int GEMM_AS = 256 * LDT, GEMM_BS = 128 * LDT;
constexpr int GEMM_LDS = 2 * (GEMM_AS + GEMM_BS) * 2;

template <class AF, class EPI>
DEV void gemm_tile(unsigned char* smem, AF af, const bf16* Bt, int ldb, int nvalid, int K, EPI& epi) {
    const int tid = TID, w = tid >> 6, l = tid & 63, h = l >> 4, c = l & 15, wm = w >> 1, wn = w & 1;
    bf16* As = (bf16*)smem; bf16* Bs = As + 2 * GEMM_AS;
    const bf16* ap[4]; const bf16* bp[2];
    const int col8 = (tid & 7) * 8, r0 = tid >> 3;
#pragma unroll
    for (int i = 0; i < 4; ++i) ap[i] = af(r0 + 64 * i) + col8;
#pragma unroll
    for (int i = 0; i < 2; ++i) { int rn = r0 + 64 * i; if (rn >= nvalid) rn = nvalid - 1; bp[i] = Bt + (size_t)rn * ldb + col8; }
    f32x4 acc[4][4];
#pragma unroll
    for (int i = 0; i < 4; ++i)
#pragma unroll
        for (int j = 0; j < 4; ++j) acc[i][j] = f4zero();
    bf16x8 ra[4], rb[2];
#pragma unroll
    for (int i = 0; i < 4; ++i) ra[i] = *(const bf16x8*)(ap[i]);
#pragma unroll
    for (int i = 0; i < 2; ++i) rb[i] = *(const bf16x8*)(bp[i]);
    SYNC();
#pragma unroll
    for (int i = 0; i < 4; ++i) *(bf16x8*)(As + (r0 + 64 * i) * LDT + col8) = ra[i];
#pragma unroll
    for (int i = 0; i < 2; ++i) *(bf16x8*)(Bs + (r0 + 64 * i) * LDT + col8) = rb[i];
    SYNC();
    const int nk = K / 64;
    for (int kt = 0; kt < nk; ++kt) {
        const int cur = kt & 1;
        if (kt + 1 < nk) {
#pragma unroll
            for (int i = 0; i < 4; ++i) ra[i] = *(const bf16x8*)(ap[i] + (kt + 1) * 64);
#pragma unroll
            for (int i = 0; i < 2; ++i) rb[i] = *(const bf16x8*)(bp[i] + (kt + 1) * 64);
        }
        const bf16* Ac = As + cur * GEMM_AS + (wm * 64 + c) * LDT + 8 * h;
        const bf16* Bc = Bs + cur * GEMM_BS + (wn * 64 + c) * LDT + 8 * h;
#pragma unroll
        for (int kk = 0; kk < 2; ++kk) {
            bf16x8 fa[4], fb[4];
#pragma unroll
            for (int i = 0; i < 4; ++i) { fa[i] = *(const bf16x8*)(Ac + i * 16 * LDT + kk * 32); fb[i] = *(const bf16x8*)(Bc + i * 16 * LDT + kk * 32); }
#pragma unroll
            for (int ni = 0; ni < 4; ++ni)
#pragma unroll
                for (int mi = 0; mi < 4; ++mi) acc[ni][mi] = mfma16(fb[ni], fa[mi], acc[ni][mi]);
        }
        if (kt + 1 < nk) {
            const int nx = cur ^ 1;
#pragma unroll
            for (int i = 0; i < 4; ++i) *(bf16x8*)(As + nx * GEMM_AS + (r0 + 64 * i) * LDT + col8) = ra[i];
#pragma unroll
            for (int i = 0; i < 2; ++i) *(bf16x8*)(Bs + nx * GEMM_BS + (r0 + 64 * i) * LDT + col8) = rb[i];
        }
        SYNC();
    }
    epi(acc, wm * 64, wn * 64, h, c);
}

struct ARows { const bf16* base; size_t ld; MDEV const bf16* operator()(int r) const { return base + (size_t)r * ld; } MDEV unsigned off(int r) const { return (unsigned)r * (unsigned)ld; } };

constexpr int LDB = 144;
constexpr int GEMM_BS2 = 64 * LDB;
constexpr int GEMM2_LDS = (2 * GEMM_AS + 2 * GEMM_BS2) * 2;
DEV bf16x8 tr_read8(const bf16* p0, const bf16* p1) {
    const s16x4 x = tr4(p0), y = tr4(p1); bf16x8 r;
    r[0] = x[0]; r[1] = x[1]; r[2] = x[2]; r[3] = x[3]; r[4] = y[0]; r[5] = y[1]; r[6] = y[2]; r[7] = y[3]; return r;
}
DEV int bperm(int r) { return (r & ~12) | ((r & 4) << 1) | ((r & 8) >> 1); }
template <class AF, class BF, class EPI>
DEV void gemm_tile2(unsigned char* smem, AF af, BF bf, int ldb, int K, EPI& epi) {
    const int tid = TID, w = tid >> 6, l = tid & 63, h = l >> 4, c = l & 15, wm = w >> 1, wn = w & 1, grp = w >> 2;
    bf16* As = (bf16*)smem; bf16* Bs = As + 2 * GEMM_AS;
    const bf16* abase = af.base; unsigned ao[4];
    const int col8 = (tid & 7) * 8, r0 = tid >> 3;
#pragma unroll
    for (int i = 0; i < 4; ++i) ao[i] = af.off(r0 + 64 * i) + col8;
    const int bn4 = (tid & 31) * 4, bk = tid >> 5, bkp = bperm(bk);
    const float* bp = bf(bn4); const bool bok = bp != nullptr;
    if (bok) bp += (size_t)bk * ldb;
    const size_t bstep = (size_t)16 * ldb;
    f32x4 acc[4][4];
#pragma unroll
    for (int i = 0; i < 4; ++i)
#pragma unroll
        for (int j = 0; j < 4; ++j) acc[i][j] = f4zero();
    bf16x8 ra[4]; f32x4 rb[4];
    const int nk = K / 64;
#pragma unroll
    for (int i = 0; i < 4; ++i) { ra[i] = *(const bf16x8*)(abase + ao[i]); rb[i] = bok ? *(const f32x4*)(bp + i * bstep) : f4zero(); }
    SYNC();
#pragma unroll
    for (int i = 0; i < 4; ++i) { *(bf16x8*)(As + (r0 + 64 * i) * LDT + col8) = ra[i]; st_bf4(Bs + (bkp + 16 * i) * LDB + bn4, rb[i]); }
    if (nk > 1) {
#pragma unroll
        for (int i = 0; i < 4; ++i) { ra[i] = *(const bf16x8*)(abase + (ao[i] + 64)); rb[i] = bok ? *(const f32x4*)(bp + (size_t)64 * ldb + i * bstep) : f4zero(); } }
    SYNC();
    for (int kt = 0; kt < nk; ++kt) {
        const int cur = kt & 1;
#pragma unroll
        for (int p = 0; p < 2; ++p) {
            if (grp == p) {
                const bf16* Ac = As + cur * GEMM_AS + (wm * 64 + c) * LDT + 8 * h;
                const bf16* Bc = Bs + cur * GEMM_BS2 + bperm(8 * h + (c >> 2)) * LDB + wn * 64 + 4 * (c & 3);
#pragma unroll
                for (int kk = 0; kk < 2; ++kk) {
                    bf16x8 fa[4], fb[4];
#pragma unroll
                    for (int i = 0; i < 4; ++i) { fa[i] = *(const bf16x8*)(Ac + i * 16 * LDT + kk * 32); fb[i] = tr_read8(Bc + (32 * kk) * LDB + 16 * i, Bc + (32 * kk + 8) * LDB + 16 * i); }
#pragma unroll
                    for (int ni = 0; ni < 4; ++ni)
#pragma unroll
                        for (int mi = 0; mi < 4; ++mi) acc[ni][mi] = mfma16(fb[ni], fa[mi], acc[ni][mi]);
                }
            } else if (kt + 1 < nk) {
                const int nx = cur ^ 1;
#pragma unroll
                for (int i = 0; i < 4; ++i) { *(bf16x8*)(As + nx * GEMM_AS + (r0 + 64 * i) * LDT + col8) = ra[i]; st_bf4(Bs + nx * GEMM_BS2 + (bkp + 16 * i) * LDB + bn4, rb[i]); }
                if (kt + 2 < nk) {
#pragma unroll
                    for (int i = 0; i < 4; ++i) { ra[i] = *(const bf16x8*)(abase + (ao[i] + (kt + 2) * 64)); rb[i] = bok ? *(const f32x4*)(bp + (size_t)(kt + 2) * 64 * ldb + i * bstep) : f4zero(); } }
            }
            SYNC();
        }
    }
    epi(acc, wm * 64, wn * 64, h, c);
}
struct BPlain { const float* base; MDEV const float* operator()(int nt) const { return base + nt; } };
struct BInProjMap { const float* base; int n0; MDEV const float* operator()(int nt) const { const int n = n0 + nt; const int sc = n < 1280 ? n : (n < 3328 ? n + 24 : (n < 3352 ? 1280 + (n - 3328) : -1)); return sc < 0 ? nullptr : base + sc; } };
struct BInter { const float* s0; const float* s1; int n0; MDEV const float* operator()(int nt) const { const int n = n0 + nt, g = n >> 6, w = n & 63; return w < 32 ? s0 + g * 32 + w : s1 + g * 32 + w - 32; } };
struct BClamp64 { const float* base; MDEV const float* operator()(int nt) const { return base + (nt & 63); } };

struct EpiInProj {
    const Args* a; int m0, n0, li;
    MDEV void operator()(f32x4 (&acc)[4][4], int mw, int nw, int h, int c) const {
        unsigned char* ws = wsp(*a);
        const int nb = n0 + nw;
        const int tokb = m0 + mw + c;
        if (nb < 512 || (nb >= 768 && nb < 896) || (nb >= 1024 && nb < 1152)) {
            const float* gain; float mul = 1.f; bf16* dst; int kind;
            if (nb < 512) { gain = INP(*a, I_QG) + li * 64; mul = 0.125f * LOG2E; kind = 0; dst = (bf16*)(ws + WS_QN); }
            else if (nb < 896) { gain = INP(*a, I_KG) + (li * 3 + 1) * 64; kind = 1; dst = (bf16*)(ws + WS_KS); }
            else { gain = INP(*a, I_KG) + (li * 3 + 2) * 64; kind = 1; dst = (bf16*)(ws + WS_KW); }
            const int g = (nb >> 6) & 1;
#pragma unroll
            for (int mi = 0; mi < 4; ++mi) {
                float ss = 0.f;
#pragma unroll
                for (int ni = 0; ni < 4; ++ni) { f32x4 v = acc[ni][mi]; ss += v[0] * v[0] + v[1] * v[1] + v[2] * v[2] + v[3] * v[3]; }
                ss += shflx(ss, 16); ss += shflx(ss, 32);
                const float rs = frsq(ss * (1.0f / 64.0f) + EPS) * mul;
                const int tok = tokb + 16 * mi;
#pragma unroll
                for (int ni = 0; ni < 4; ++ni) {
                    const int d = 16 * ni + 4 * h; f32x4 v = acc[ni][mi], o;
#pragma unroll
                    for (int r = 0; r < 4; ++r) o[r] = v[r] * rs * gain[d + r];
                    if (kind == 0) st_bf4(dst + (size_t)tok * 512 + nb + d, o);
                    else { const int b = tok / SEQ, s = tok % SEQ; st_bf4(dst + ((size_t)(b * 2 + g) * SEQ + s) * 64 + d, o); }
                }
            }
        } else if (nb < 768) {
            bf16* dst = (bf16*)(ws + (nb < 640 ? WS_KCG : WS_VCG)); const int g = (nb >> 6) & 1;
#pragma unroll
            for (int mi = 0; mi < 4; ++mi) { const int tok = tokb + 16 * mi, b = tok / SEQ, s = tok % SEQ;
#pragma unroll
                for (int ni = 0; ni < 4; ++ni) st_bf4(dst + ((size_t)(b * 2 + g) * SEQ + s) * 64 + 16 * ni + 4 * h, acc[ni][mi]); }
        } else if (nb < 1280) {
            bf16* dst = (bf16*)(ws + (nb < 1024 ? WS_VST : WS_VWT)); const int g = (nb >> 6) & 1;
#pragma unroll
            for (int mi = 0; mi < 4; ++mi) { const int tok = tokb + 16 * mi, b = tok / SEQ, s = tok % SEQ;
                bf16* p = dst + ((size_t)(b * 2 + g) * NCH + (s >> 6)) * 4096 + (s & 63);
#pragma unroll
                for (int ni = 0; ni < 4; ++ni)
#pragma unroll
                    for (int r = 0; r < 4; ++r) p[(16 * ni + 4 * h + r) * 64] = (bf16)f2bf(acc[ni][mi][r]); }
        } else if (nb < 3328) {
            const int sec = (nb - 1280) >> 9, cc = (nb - 1280) & 511, hh = cc >> 7, d0 = cc & 127;
#pragma unroll
            for (int mi = 0; mi < 4; ++mi) { const int tok = tokb + 16 * mi, b = tok / SEQ, s = tok % SEQ;
                const size_t hrow = ((size_t)(b * 4 + hh) * SEQ + s) * 128 + d0;
#pragma unroll
                for (int ni = 0; ni < 4; ++ni) { const int d = 16 * ni + 4 * h; f32x4 v = acc[ni][mi], o;
                    if (sec == 0) { for (int r = 0; r < 4; ++r) o[r] = siluf(v[r]); st_bf4((bf16*)(ws + WS_HQ) + hrow + d, o); }
                    else if (sec == 1) { const float* lb = (const float*)(ws + WS_LB) + li * 512 + cc + d;
                        for (int r = 0; r < 4; ++r) o[r] = lb[r] + (1.0f - lb[r]) * sigm(v[r]);
                        *(f32x4*)((float*)(ws + WS_HF) + hrow + d) = o; }
                    else if (sec == 2) st_bf4((bf16*)(ws + WS_HV) + hrow + d, v);
                    else { for (int r = 0; r < 4; ++r) o[r] = siluf(v[r]); st_bf4((bf16*)(ws + WS_HGS) + (size_t)tok * 512 + cc + d, o); }
                } }
        } else if (nb == 3328) {
            float* dst = (float*)(ws + WS_GATE);
#pragma unroll
            for (int mi = 0; mi < 4; ++mi) { const int tok = tokb + 16 * mi;
#pragma unroll
                for (int ni = 0; ni < 2; ++ni)
#pragma unroll
                    for (int r = 0; r < 4; ++r) { const int n = 16 * ni + 4 * h + r; if (n < 24) dst[(size_t)tok * 24 + n] = sigm(acc[ni][mi][r]); } }
        }
    }
};

struct EpiResid {
    float* x; const float* gate; int m0, n0;
    MDEV void operator()(f32x4 (&acc)[4][4], int mw, int nw, int h, int c) const {
#pragma unroll
        for (int mi = 0; mi < 4; ++mi) { const int tok = m0 + mw + 16 * mi + c, b = tok / SEQ;
#pragma unroll
            for (int ni = 0; ni < 4; ++ni) { const int n = n0 + nw + 16 * ni + 4 * h;
                f32x4 g = *(const f32x4*)(gate + (size_t)b * 6 * DM + n); f32x4* p = (f32x4*)(x + (size_t)tok * DM + n); f32x4 v = *p;
#pragma unroll
                for (int r = 0; r < 4; ++r) v[r] += g[r] * acc[ni][mi][r];
                *p = v; } }
    }
};
template <int MODE> struct EpiGated {
    bf16* dst; size_t ld; int m0, n0, mvalid;
    MDEV void operator()(f32x4 (&acc)[4][4], int mw, int nw, int h, int c) const {
        const int cb = (n0 + nw) / 2;
#pragma unroll
        for (int mi = 0; mi < 4; ++mi) { const int m = mw + 16 * mi + c; if (m >= mvalid) continue;
#pragma unroll
            for (int ni = 0; ni < 2; ++ni) { f32x4 o;
#pragma unroll
                for (int r = 0; r < 4; ++r) { const float av = acc[ni][mi][r], bv = acc[ni + 2][mi][r]; o[r] = MODE == 0 ? av * sigm(bv) : siluf(av) * bv; }
                st_bf4(dst + (size_t)(m0 + m) * ld + cb + 16 * ni + 4 * h, o); } }
    }
};
struct EpiStoreBf {
    bf16* dst; size_t ld; int m0, n0, mvalid;
    MDEV void operator()(f32x4 (&acc)[4][4], int mw, int nw, int h, int c) const {
#pragma unroll
        for (int mi = 0; mi < 4; ++mi) { const int m = mw + 16 * mi + c; if (m >= mvalid) continue;
#pragma unroll
            for (int ni = 0; ni < 4; ++ni) st_bf4(dst + (size_t)(m0 + m) * ld + n0 + nw + 16 * ni + 4 * h, acc[ni][mi]); }
    }
};
struct EpiCmp {
    const Args* a; int kv, bg, m0, li;
    MDEV void operator()(f32x4 (&acc)[4][4], int mw, int nw, int h, int c) const {
        if (nw != 0) return;
        unsigned char* ws = wsp(*a);
        const float* bp8 = (const float*)(ws + WS_CB) + (li * 2 + kv) * 8 * 64;
        float bias[16];
#pragma unroll
        for (int q = 0; q < 16; ++q) { const int e = 16 * (q >> 2) + 4 * h + (q & 3); float v = 0.f;
#pragma unroll
            for (int kp = 0; kp < 8; ++kp) v += bp8[kp * 64 + e];
            bias[q] = v; }
        const float* gain = INP(*a, I_KG) + (li * 3 + 0) * 64;
#pragma unroll
        for (int mi = 0; mi < 4; ++mi) { const int n = m0 + mw + 16 * mi + c; const bool ok = n < NCMP;
            f32x4 v[4]; float ss = 0.f;
#pragma unroll
            for (int ni = 0; ni < 4; ++ni) { v[ni] = acc[ni][mi];
#pragma unroll
                for (int r = 0; r < 4; ++r) { v[ni][r] += bias[4 * ni + r]; ss += v[ni][r] * v[ni][r]; } }
            ss += shflx(ss, 16); ss += shflx(ss, 32);
            if (n >= NCP) continue;
            if (kv == 0) { const float rs = frsq(ss * (1.0f / 64.0f) + EPS); bf16* p = (bf16*)(ws + WS_KC) + ((size_t)bg * NCP + n) * 64;
#pragma unroll
                for (int ni = 0; ni < 4; ++ni) { f32x4 o;
#pragma unroll
                    for (int r = 0; r < 4; ++r) o[r] = ok ? v[ni][r] * rs * gain[16 * ni + 4 * h + r] : 0.f;
                    st_bf4(p + 16 * ni + 4 * h, o); }
            } else { bf16* p = (bf16*)(ws + WS_VCT) + ((size_t)bg * NCP + n) * 64;
#pragma unroll
                for (int ni = 0; ni < 4; ++ni) { f32x4 o;
#pragma unroll
                    for (int r = 0; r < 4; ++r) o[r] = ok ? v[ni][r] : 0.f;
                    st_bf4(p + 16 * ni + 4 * h, o); } }
        }
    }
};


struct EpiResid8 {
    static constexpr bool PERM = true, AFTER_DRAIN = false;
    float* x; const float* gate; const float* xin;
    MDEV void operator()(const f32x4 (&acc)[2][2][4][2], const pg8::Unit& u, int wr, int wc, int fr, int fq) const {
        OPAQUE2(fr, fq);
#pragma unroll
        for (int ai = 0; ai < 2; ++ai)
#pragma unroll
            for (int m = 0; m < 4; ++m) { const int row = 256 * u.pm + 128 * ai + 64 * wr + 16 * m + fr, b = row / SEQ;
#pragma unroll
                for (int bj = 0; bj < 2; ++bj)
#pragma unroll
                    for (int n = 0; n < 2; ++n) { const int col = 256 * u.pn + 128 * bj + 32 * wc + 8 * fq + 4 * n;
                        const f32x4 g = *(const f32x4*)(gate + (size_t)b * 6 * DM + col); f32x4* p = (f32x4*)(x + (size_t)row * DM + col); f32x4 v = *(const f32x4*)(xin + (size_t)row * DM + col);
#pragma unroll
                        for (int r = 0; r < 4; ++r) v[r] += g[r] * acc[ai][bj][m][n][r];
                        *p = v; } }
    }
};
struct EpiGlu8 {
    static constexpr bool PERM = true, AFTER_DRAIN = false;
    bf16* dst;
    MDEV void operator()(const f32x4 (&acc)[2][2][4][2], const pg8::Unit& u, int wr, int wc, int fr, int fq) const {
        OPAQUE2(fr, fq);
#pragma unroll
        for (int ai = 0; ai < 2; ++ai)
#pragma unroll
            for (int m = 0; m < 4; ++m) { const int row = 256 * u.pm + 128 * ai + 64 * wr + 16 * m + fr;
#pragma unroll
                for (int bj = 0; bj < 2; ++bj) { const int col = 128 * u.pn + 64 * bj + 16 * wc + 4 * fq; f32x4 o;
#pragma unroll
                    for (int r = 0; r < 4; ++r) o[r] = acc[ai][bj][m][0][r] * sigm(acc[ai][bj][m][1][r]);
                    st_bf4(dst + (size_t)row * DM + col, o); } }
    }
};
struct EpiMoe1_8 {
    static constexpr bool PERM = true, AFTER_DRAIN = false;
    bf16* dst;
    MDEV void operator()(const f32x4 (&acc)[2][2][4][2], const pg8::Unit& u, int wr, int wc, int fr, int fq) const {
        OPAQUE2(fr, fq);
#pragma unroll
        for (int ai = 0; ai < 2; ++ai)
#pragma unroll
            for (int m = 0; m < 4; ++m) { const int row = 256 * u.pm + 128 * ai + 64 * wr + 16 * m + fr;
#pragma unroll
                for (int bj = 0; bj < 2; ++bj) { const int col = 128 * u.pn + 64 * bj + 16 * wc + 4 * fq; f32x4 o;
#pragma unroll
                    for (int r = 0; r < 4; ++r) o[r] = siluf(acc[ai][bj][m][0][r]) * acc[ai][bj][m][1][r];
                    st_bf4(dst + (size_t)row * FF + col, o); } }
    }
};
struct EpiMoe2_8 {
    static constexpr bool PERM = true, AFTER_DRAIN = false;
    bf16* dst;
    MDEV void operator()(const f32x4 (&acc)[2][2][4][2], const pg8::Unit& u, int wr, int wc, int fr, int fq) const {
        OPAQUE2(fr, fq);
#pragma unroll
        for (int ai = 0; ai < 2; ++ai)
#pragma unroll
            for (int m = 0; m < 4; ++m) { const int row = 256 * u.pm + 128 * ai + 64 * wr + 16 * m + fr;
#pragma unroll
                for (int bj = 0; bj < 2; ++bj) { const int col = 256 * u.pn + 128 * bj + 32 * wc + 8 * fq;
                    st_bf8(dst + (size_t)row * DM + col, acc[ai][bj][m][0], acc[ai][bj][m][1]); } }
    }
};
DEV unsigned uni(unsigned x);
template <bool G> struct MoeSel {
    static constexpr bool GATHER = G;
    const int* rb; const int* cnt; const int* list; size_t bstride;
    struct Ctx { int e, rbase, c; };
    MDEV Ctx ctx(const pg8::Unit& u) const { int e = 0;
#pragma unroll 1
        for (int q = 1; q < 32; ++q) if ((rb[q] >> 8) <= u.pm) e = q;
        e = (int)uni((unsigned)e); Ctx x; x.e = e; x.rbase = (int)uni((unsigned)((u.pm << 8) - rb[e])); x.c = G ? (int)uni((unsigned)cnt[e * 64]) : 0; return x; }
    MDEV size_t boff(const Ctx& x) const { return (size_t)x.e * bstride; }
    MDEV unsigned aoff(const Ctx& x, int r) const { int p = x.rbase + r; if (p > x.c - 1) p = x.c - 1; return (unsigned)list[(size_t)x.e * T + p] * (unsigned)(DM * 2); }
};
struct EpiInProj8 {
    static constexpr bool PERM = true, AFTER_DRAIN = false;
    const Args* a; int li;
    MDEV void operator()(const f32x4 (&acc)[2][2][4][2], const pg8::Unit& u, int wr, int wc, int fr, int fq) const {
        OPAQUE2(fr, fq);
        unsigned char* ws = wsp(*a);
        const int nb = 256 * u.pn + 64 * wc;
        if (nb >= 3392) return;
        if (nb < 512 || (nb >= 768 && nb < 896) || (nb >= 1024 && nb < 1152)) {
            const float* gain; float mul = 1.f; int kind;
            if (nb < 512) { gain = INP(*a, I_QG) + li * 64; mul = 0.125f * LOG2E; kind = 0; }
            else if (nb < 896) { gain = INP(*a, I_KG) + (li * 3 + 1) * 64; kind = 1; }
            else { gain = INP(*a, I_KG) + (li * 3 + 2) * 64; kind = 2; }
            const int g = (nb >> 6) & 1;
            f32x4 gv[2][2];
#pragma unroll
            for (int bj = 0; bj < 2; ++bj)
#pragma unroll
                for (int n = 0; n < 2; ++n) gv[bj][n] = *(const f32x4*)(gain + 32 * bj + 8 * fq + 4 * n);
#pragma unroll
            for (int ai = 0; ai < 2; ++ai)
#pragma unroll
                for (int m = 0; m < 4; ++m) { const int tok = 256 * u.pm + 128 * ai + 64 * wr + 16 * m + fr;
                    float ss = 0.f;
#pragma unroll
                    for (int bj = 0; bj < 2; ++bj)
#pragma unroll
                        for (int n = 0; n < 2; ++n) { const f32x4 v = acc[ai][bj][m][n]; ss += v[0] * v[0] + v[1] * v[1] + v[2] * v[2] + v[3] * v[3]; }
                    ss += shflx(ss, 16); ss += shflx(ss, 32);
                    const float rs = frsq(ss * (1.0f / 64.0f) + EPS) * mul;
                    bf16* dst; if (kind == 0) dst = (bf16*)(ws + WS_QN) + (size_t)tok * 512 + nb; else { const int b = tok / SEQ, sq = tok % SEQ; dst = (bf16*)(ws + (kind == 1 ? WS_KS : WS_KW)) + ((size_t)(b * 2 + g) * SEQ + sq) * 64; }
#pragma unroll
                    for (int bj = 0; bj < 2; ++bj) { f32x4 o0, o1;
#pragma unroll
                        for (int r = 0; r < 4; ++r) { o0[r] = acc[ai][bj][m][0][r] * rs * gv[bj][0][r]; o1[r] = acc[ai][bj][m][1][r] * rs * gv[bj][1][r]; }
                        st_bf8(dst + 32 * bj + 8 * fq, o0, o1); } }
        } else if (nb < 768) {
            bf16* base = (bf16*)(ws + (nb < 640 ? WS_KCG : WS_VCG)); const int g = (nb >> 6) & 1;
#pragma unroll
            for (int ai = 0; ai < 2; ++ai)
#pragma unroll
                for (int m = 0; m < 4; ++m) { const int tok = 256 * u.pm + 128 * ai + 64 * wr + 16 * m + fr, b = tok / SEQ, sq = tok % SEQ;
#pragma unroll
                    for (int bj = 0; bj < 2; ++bj) st_bf8(base + ((size_t)(b * 2 + g) * SEQ + sq) * 64 + 32 * bj + 8 * fq, acc[ai][bj][m][0], acc[ai][bj][m][1]); }
        } else if (nb < 1280) {
            bf16* base = (bf16*)(ws + (nb < 1024 ? WS_VST : WS_VWT)); const int g = (nb >> 6) & 1;
#pragma unroll
            for (int ai = 0; ai < 2; ++ai)
#pragma unroll
                for (int m = 0; m < 4; ++m) { const int tok = 256 * u.pm + 128 * ai + 64 * wr + 16 * m + fr, b = tok / SEQ, sq = tok % SEQ;
#pragma unroll
                    for (int bj = 0; bj < 2; ++bj) st_bf8(base + ((size_t)(b * 2 + g) * SEQ + sq) * 64 + 32 * bj + 8 * fq, acc[ai][bj][m][0], acc[ai][bj][m][1]); }
        } else if (nb < 3328) {
            const int sec = (nb - 1280) >> 9, cc = (nb - 1280) & 511, hh = cc >> 7, d0 = cc & 127;
            f32x4 lbv[2][2];
            if (sec == 1) {
#pragma unroll
                for (int bj = 0; bj < 2; ++bj)
#pragma unroll
                    for (int n = 0; n < 2; ++n) lbv[bj][n] = *(const f32x4*)((const float*)(ws + WS_LB) + li * 512 + cc + 32 * bj + 8 * fq + 4 * n); }
#pragma unroll
            for (int ai = 0; ai < 2; ++ai)
#pragma unroll
                for (int m = 0; m < 4; ++m) { const int tok = 256 * u.pm + 128 * ai + 64 * wr + 16 * m + fr, b = tok / SEQ, sq = tok % SEQ;
                    const size_t hrow = ((size_t)(b * 4 + hh) * SEQ + sq) * 128 + d0;
#pragma unroll
                    for (int bj = 0; bj < 2; ++bj) { const int d = 32 * bj + 8 * fq; f32x4 o0, o1;
                        if (sec == 0) {
#pragma unroll
                            for (int r = 0; r < 4; ++r) { o0[r] = siluf(acc[ai][bj][m][0][r]); o1[r] = siluf(acc[ai][bj][m][1][r]); }
                            st_bf8((bf16*)(ws + WS_HQ) + hrow + d, o0, o1); }
                        else if (sec == 1) {
#pragma unroll
                            for (int r = 0; r < 4; ++r) { o0[r] = lbv[bj][0][r] + (1.0f - lbv[bj][0][r]) * sigm(acc[ai][bj][m][0][r]); o1[r] = lbv[bj][1][r] + (1.0f - lbv[bj][1][r]) * sigm(acc[ai][bj][m][1][r]); }
                            float* pf = (float*)(ws + WS_HF) + hrow + d; *(f32x4*)pf = o0; *(f32x4*)(pf + 4) = o1; }
                        else if (sec == 2) st_bf8((bf16*)(ws + WS_HV) + hrow + d, acc[ai][bj][m][0], acc[ai][bj][m][1]);
                        else {
#pragma unroll
                            for (int r = 0; r < 4; ++r) { o0[r] = siluf(acc[ai][bj][m][0][r]); o1[r] = siluf(acc[ai][bj][m][1][r]); }
                            st_bf8((bf16*)(ws + WS_HGS) + (size_t)tok * 512 + cc + d, o0, o1); } } }
        } else {
            float* dst = (float*)(ws + WS_GATE);
            if (fq < 3) {
#pragma unroll
                for (int ai = 0; ai < 2; ++ai)
#pragma unroll
                    for (int m = 0; m < 4; ++m) { const int tok = 256 * u.pm + 128 * ai + 64 * wr + 16 * m + fr; f32x4 o0, o1;
#pragma unroll
                        for (int r = 0; r < 4; ++r) { o0[r] = sigm(acc[ai][0][m][0][r]); o1[r] = sigm(acc[ai][0][m][1][r]); }
                        float* pf = dst + (size_t)tok * 24 + 8 * fq; *(f32x4*)pf = o0; *(f32x4*)(pf + 4) = o1; } }
        }
    }
};

DEV void tr_tile(unsigned char* smem, const float* src0, const float* src1, int ld, int K, int mode, bf16* dst, int n0, int k0) {
    bf16* tl = (bf16*)smem;
    const int tid = TID;
    SYNC();
#pragma unroll
    for (int i = 0; i < 8; ++i) {
        const int e = tid + 512 * i, kk = e >> 6, nn = e & 63, n = n0 + nn; float v = 0.f;
        if (mode == 0) v = src0[(size_t)(k0 + kk) * ld + n];
        else if (mode == 1) { int sc = n < 1280 ? n : (n < 3328 ? n + 24 : (n < 3352 ? 1280 + (n - 3328) : -1)); if (sc >= 0) v = src0[(size_t)(k0 + kk) * ld + sc]; }
        else { const int g = n >> 6, w = n & 63; v = (w < 32) ? src0[(size_t)(k0 + kk) * ld + g * 32 + w] : src1[(size_t)(k0 + kk) * ld + g * 32 + w - 32]; }
        tl[nn * LDT + kk] = (bf16)f2bf(v);
    }
    SYNC();
    const int nn = tid >> 3, k8 = (tid & 7) * 8;
    *(bf16x8*)(dst + (size_t)(n0 + nn) * K + k0 + k8) = *(const bf16x8*)(tl + nn * LDT + k8);
}

DEV int tr_col(int mode, int n) {
    if (mode == 0) return n;
    const int pn = n >> 8, ct = n & 255;
    if (mode == 5) { const int bj = ct >> 7, wc = (ct >> 5) & 3, j = ct & 31, L = 256 * pn + 64 * wc + 32 * bj + j; return L < 1280 ? L : (L < 3328 ? L + 24 : (L < 3352 ? 1280 + (L - 3328) : -1)); }
    { const int bj = ct >> 7, wc = (ct >> 5) & 3, j = ct & 31, nn = (j >> 2) & 1, Lc = 128 * pn + 64 * bj + 16 * wc + 4 * (j >> 3) + (j & 3); return nn == 0 ? Lc : (mode == 7 ? FF : DM) + Lc; }
}
DEV void tr_tile(unsigned char* smem, const float* src, int ld, int K, int mode, bf16* dst, int n0, int k0) {
    bf16* tl = (bf16*)smem;
    const int tid = TID, nq = tid & 31, kq = tid >> 5;
    const int sc = tr_col(mode, n0 + 4 * nq);
    f32x4 v[4];
#pragma unroll
    for (int i = 0; i < 4; ++i) v[i] = sc >= 0 ? *(const f32x4*)(src + (size_t)(k0 + 4 * kq + i) * ld + sc) : f4zero();
    SYNC();
#pragma unroll
    for (int j = 0; j < 4; ++j) { u32x2 w; w[0] = pk2(v[0][j], v[1][j]); w[1] = pk2(v[2][j], v[3][j]); *(u32x2*)(tl + (4 * nq + j) * LDT + 4 * kq) = w; }
    SYNC();
#pragma unroll
    for (int t = 0; t < 2; ++t) { const int id = tid + 512 * t, row = id >> 3, ch = id & 7;
        *(bf16x8*)(dst + (size_t)(n0 + row) * K + k0 + 8 * ch) = *(const bf16x8*)(tl + row * LDT + 8 * ch); }
}
constexpr int KSUP = FF >= 256 ? 256 : FF, NSUP = KSUP / 64;
DEV void tr_super(unsigned char* smem, const float* src0, const float* src1, int ld, int K, int mode, bf16* dst, int n0, int k0) {
    const int tid = TID, nq = tid & 31, kq = tid >> 5;
    int sc = n0 + 4 * nq; const float* src = src0;
    if (mode == 7) { const int cc = tr_col(7, sc); src = cc >= FF ? src1 : src0; sc = cc >= FF ? cc - FF : cc; }
    f32x4 v[NSUP][4];
#pragma unroll
    for (int sb = 0; sb < NSUP; ++sb)
#pragma unroll
        for (int i = 0; i < 4; ++i) v[sb][i] = *(const f32x4*)(src + (size_t)(k0 + 64 * sb + 4 * kq + i) * ld + sc);
    SYNC();
    const int fw = nq & (KSUP / 16 - 1);
#pragma unroll
    for (int j = 0; j < 4; ++j)
#pragma unroll
        for (int sb = 0; sb < NSUP; ++sb) { const int c16 = 8 * sb + (kq >> 1); u32x2 w; w[0] = pk2(v[sb][0][j], v[sb][1][j]); w[1] = pk2(v[sb][2][j], v[sb][3][j]);
            *(u32x2*)(smem + (4 * nq + j) * (KSUP * 2) + ((c16 ^ fw) << 4) + (kq & 1) * 8) = w; }
    SYNC();
#pragma unroll
    for (int t = 0; t < 128 * (KSUP / 8) / NT; ++t) { const int id = tid + NT * t, row = id / (KSUP / 8), ch = id % (KSUP / 8), f = (row >> 2) & (KSUP / 16 - 1);
        *(bf16x8*)(dst + (size_t)(n0 + row) * K + k0 + 8 * (ch ^ f)) = *(const bf16x8*)(smem + row * (KSUP * 2) + ch * 16); }
}
struct TrJob { const float* s; int ld, K, N, mode; bf16* dst; };
DEV void p0_phase(const Args& a, unsigned char* smem) {
    unsigned char* ws = wsp(a); const int tid = TID;
    { int item = BID, base = 0;
      for (int j = 0; j < 8; ++j) { TrJob J; const int i = j & 1;
        if (j < 2) J = {INP(a, I_WIN) + (size_t)i * DM * NIN, NIN, DM, NIN8, 5, (bf16*)(ws + WS_WIN) + (size_t)i * NIN8 * DM};
        else if (j < 4) J = {INP(a, I_WOUT) + (size_t)i * 1024 * DM, DM, 1024, DM, 0, (bf16*)(ws + WS_WOUT) + (size_t)i * DM * 1024};
        else if (j < 6) J = {INP(a, I_PW1) + (size_t)i * DM * 2 * DM, 2 * DM, DM, 2 * DM, 6, (bf16*)(ws + WS_PW1) + (size_t)i * 2 * DM * DM};
        else J = {INP(a, I_PW2) + (size_t)i * DM * DM, DM, DM, DM, 0, (bf16*)(ws + WS_PW2) + (size_t)i * DM * DM};
        const int tn = J.N / 128, tk = J.K / 64, nt = tn * tk;
        while (item < base + nt) { const int it = item - base; tr_tile(smem, J.s, J.ld, J.K, J.mode, J.dst, (it % tn) * 128, (it / tn) * 64); item += NBLK; }
        base += nt; }
      SYNC(); }
    { constexpr int S13 = (2 * FF / 128) * (DM / KSUP), S2 = (DM / 128) * (FF / KSUP), SPE = S13 + S2;
      for (int it = BID; it < DEPTH * 32 * SPE; it += NBLK) { const int le = it / SPE, r = it % SPE;
        if (r < S13) { const int tn = r % (2 * FF / 128), tk = r / (2 * FF / 128);
            tr_super(smem, INP(a, I_W1) + (size_t)le * DM * FF, INP(a, I_W3) + (size_t)le * DM * FF, FF, DM, 7, (bf16*)(ws + WS_W13) + (size_t)le * 2 * FF * DM, tn * 128, tk * KSUP); }
        else { const int r2 = r - S13, tn = r2 % (DM / 128), tk = r2 / (DM / 128);
            tr_super(smem, INP(a, I_W2) + (size_t)le * FF * DM, INP(a, I_W2), DM, FF, 0, (bf16*)(ws + WS_W2) + (size_t)le * DM * FF, tn * 128, tk * KSUP); } }
      SYNC(); }
    {
        float* red = (float*)smem;
        constexpr int NG = 6 * DM / 128; const int ntask = DEPTH * NG;
        for (int t = BID; t < ntask; t += NBLK) {
            const int l = t / NG, j0 = (t % NG) * 128, cq = tid & 31, kr = tid >> 5;
            const float* w = INP(a, I_ADAW) + (size_t)l * DM * 6 * DM + j0 + 4 * cq; const float* cc = INP(a, I_C);
            f32x4 a0 = f4zero(), a1 = f4zero();
#pragma unroll 8
            for (int i = 0; i < DM / 16; ++i) { const int k = kr + 16 * i; const f32x4 wv = *(const f32x4*)(w + (size_t)k * 6 * DM); const float s0 = siluf(cc[k]), s1 = siluf(cc[DM + k]);
#pragma unroll
                for (int r = 0; r < 4; ++r) { a0[r] += s0 * wv[r]; a1[r] += s1 * wv[r]; } }
            SYNC();
            *(f32x4*)(red + (kr * 2 + 0) * 128 + 4 * cq) = a0; *(f32x4*)(red + (kr * 2 + 1) * 128 + 4 * cq) = a1;
            SYNC();
            if (tid < 256) { const int b = tid >> 7, col = tid & 127; float sum = INP(a, I_ADAB)[(size_t)l * 6 * DM + j0 + col];
#pragma unroll
                for (int q = 0; q < 16; ++q) sum += red[(q * 2 + b) * 128 + col];
                ((float*)(ws + WS_MOD))[((size_t)l * 2 + b) * 6 * DM + j0 + col] = sum; }
        }
    }
    for (int t = BID; t < 32; t += NBLK) {
        float* red = (float*)smem; const int ikv = t >> 3, kp = t & 7, i = ikv >> 1, kv = ikv & 1, e = tid & 63, ks = tid >> 6;
        const float* W = INP(a, kv ? I_CWV : I_CWK) + (size_t)i * 2048 * 64 + e; const float* pe = INP(a, I_CPE) + (size_t)i * 2048;
        float sum = 0.f;
#pragma unroll 8
        for (int q = 0; q < 32; ++q) { const int k = kp * 256 + ks * 32 + q; sum += pe[k] * W[(size_t)k * 64]; }
        SYNC(); red[ks * 64 + e] = sum; SYNC();
        if (tid < 64) { float v = 0.f; for (int q = 0; q < 8; ++q) v += red[q * 64 + tid]; ((float*)(ws + WS_CB))[(ikv * 8 + kp) * 64 + tid] = v; }
    }
    for (int i = BID * NT + tid; i < DEPTH * 48 * DM; i += NBLK * NT) { const int k = i % DM, n = (i / DM) % 48, ll = i / (48 * DM);
        const float wv = n < 4 ? INP(a, I_WG)[((size_t)ll * DM + k) * 4 + n] : (n < 36 ? INP(a, I_WE)[((size_t)ll * DM + k) * 32 + n - 4] : 0.f);
        const unsigned hi = f2bf(wv); ((bf16*)(ws + WS_WTH))[i] = (bf16)hi; ((bf16*)(ws + WS_WTL))[i] = (bf16)f2bf(wv - bf2f(hi)); }
    if (BID == 0) {
        for (int i = tid; i < DEPTH * 32; i += NT) ((int*)(ws + WS_CNT))[i * 64] = 0;
        for (int n = tid; n < 512; n += NT) { const float l0 = INP(a, I_LBL)[n], l1 = INP(a, I_LBL)[512 + n]; const float m = fmaxf(l0, l1);
            const float e0 = fexp2((l0 - m) * LOG2E), e1 = fexp2((l1 - m) * LOG2E);
            ((float*)(ws + WS_LB))[n] = 0.f; ((float*)(ws + WS_LB))[512 + n] = e1 / (e0 + e1); }
        if (tid < 2) { const int i = tid; float mq = 0.f; for (int d = 0; d < 64; ++d) mq = fmaxf(mq, fabsf(INP(a, I_QG)[i * 64 + d]));
            for (int br = 0; br < 3; ++br) { float mk = 0.f; for (int d = 0; d < 64; ++d) mk = fmaxf(mk, fabsf(INP(a, I_KG)[(i * 3 + br) * 64 + d]));
                ((float*)(ws + WS_CS))[i * 4 + br] = 8.0f * mq * mk * LOG2E; } }
    }
}

constexpr int NJV = DM / 256;
DEV void moe_bases(const int* cnt, int* rb  ) {
    if (TID == 0) { int acc = 0; for (int e = 0; e < 32; ++e) { rb[e] = acc; acc += ((cnt[e * 64] + 255) >> 8) << 8; } rb[32] = acc; }
    SYNC();
}
DEV void norm_phase(const Args& a, unsigned char* smem, int l) {
    unsigned char* ws = wsp(a); const int tid = TID, w = tid >> 6, lane = tid & 63;
    int* rb = (int*)smem;
    if (l > 0) moe_bases((const int*)(ws + WS_CNT) + (l - 1) * 32 * 64, rb);
    const float* mod = (const float*)(ws + WS_MOD);
    const bf16* yk = (const bf16*)(ws + WS_YK);
    if (l < DEPTH) {
        const int bid = BID % 76 == BID ? BID : -1;
        for (int job = BID; job < 76; job += NBLK) {
            if (job < 72) { const int b = job / 36, n = job % 36; float sum = 0.f;
                for (int k = tid; k < DM; k += NT) { const float wv = n < 4 ? INP(a, I_WG)[((size_t)l * DM + k) * 4 + n] : INP(a, I_WE)[((size_t)l * DM + k) * 32 + n - 4]; sum += mod[((size_t)l * 2 + b) * 6 * DM + 3 * DM + k] * wv; }
#pragma unroll
                for (int q = 1; q < 64; q <<= 1) sum += shflx(sum, q);
                float* red = (float*)(smem + 1024);
                SYNC(); if (lane == 0) red[w] = sum; SYNC();
                if (tid == 0) { float t = 0.f; for (int q = 0; q < 8; ++q) t += red[q]; ((float*)(ws + WS_RBIAS))[((size_t)l * 2 + b) * 48 + n] = t; }
            } else { const float* nf = INP(a, I_NFFN) + (size_t)l * DM; const int part = job - 72;
                for (int i = part * (2 * DM / 4) + tid; i < (part + 1) * (2 * DM / 4); i += NT) { const int b = i / DM, k = i % DM; ((float*)(ws + WS_AVEC))[((size_t)l * 2 + b) * DM + k] = nf[k] * (1.0f + mod[((size_t)l * 2 + b) * 6 * DM + 4 * DM + k]); } }
        }
        (void)bid;
    }
    const int rstride = NBLK * 8;
    for (int rowa = BID * 8 + w; rowa < T; rowa += 2 * rstride) {
        int row[2]; bool ok[2];
        row[0] = rowa; ok[0] = true; row[1] = rowa + rstride; ok[1] = row[1] < T; if (!ok[1]) row[1] = rowa;
        f32x4 v[2][NJV]; int e0[2], p0[2], e1[2], p1[2]; float w0[2], w1[2];
        const float* xin = (l == 0) ? INP(a, I_X) : outp(a);
#pragma unroll
        for (int q = 0; q < 2; ++q) {
#pragma unroll
            for (int j = 0; j < NJV; ++j) v[q][j] = *(const f32x4*)(xin + (size_t)row[q] * DM + 4 * lane + 256 * j);
            if (l > 0) { const int* tie = (const int*)(ws + WS_TIE) + (size_t)row[q] * 2; const float* tiw = (const float*)(ws + WS_TIW) + (size_t)row[q] * 2;
                e0[q] = tie[0] >> 14; p0[q] = tie[0] & 16383; e1[q] = tie[1] >> 14; p1[q] = tie[1] & 16383; w0[q] = tiw[0]; w1[q] = tiw[1]; } }
        if (l > 0) {
            u32x2 q0[2][NJV], q1[2][NJV];
#pragma unroll
            for (int q = 0; q < 2; ++q) { const bf16* y0 = yk + (size_t)(rb[e0[q]] + p0[q]) * DM; const bf16* y1 = yk + (size_t)(rb[e1[q]] + p1[q]) * DM;
#pragma unroll
                for (int j = 0; j < NJV; ++j) { const int cidx = 4 * lane + 256 * j; q0[q][j] = *(const u32x2*)(y0 + cidx); q1[q][j] = *(const u32x2*)(y1 + cidx); } }
#pragma unroll
            for (int q = 0; q < 2; ++q) { const int b = row[q] / SEQ; const float* gf = mod + ((size_t)(l - 1) * 2 + b) * 6 * DM + 5 * DM;
#pragma unroll
                for (int j = 0; j < NJV; ++j) { const int cidx = 4 * lane + 256 * j; const f32x4 g = *(const f32x4*)(gf + cidx);
                    v[q][j][0] += g[0] * (w0[q] * bf2f(q0[q][j][0] & 0xffff) + w1[q] * bf2f(q1[q][j][0] & 0xffff));
                    v[q][j][1] += g[1] * (w0[q] * bf2f(q0[q][j][0] >> 16) + w1[q] * bf2f(q1[q][j][0] >> 16));
                    v[q][j][2] += g[2] * (w0[q] * bf2f(q0[q][j][1] & 0xffff) + w1[q] * bf2f(q1[q][j][1] & 0xffff));
                    v[q][j][3] += g[3] * (w0[q] * bf2f(q0[q][j][1] >> 16) + w1[q] * bf2f(q1[q][j][1] >> 16)); } }
        }
        if (l > 0)
#pragma unroll
        for (int q = 0; q < 2; ++q) { if (!ok[q]) continue;
#pragma unroll
            for (int j = 0; j < NJV; ++j) *(f32x4*)(outp(a) + (size_t)row[q] * DM + 4 * lane + 256 * j) = v[q][j]; }
        if (l == DEPTH) continue;
        float ss[2];
#pragma unroll
        for (int q = 0; q < 2; ++q) { ss[q] = 0.f;
#pragma unroll
            for (int j = 0; j < NJV; ++j) ss[q] += v[q][j][0] * v[q][j][0] + v[q][j][1] * v[q][j][1] + v[q][j][2] * v[q][j][2] + v[q][j][3] * v[q][j][3]; }
#pragma unroll
        for (int o = 1; o < 64; o <<= 1) { ss[0] += shflx(ss[0], o); ss[1] += shflx(ss[1], o); }
        const float* nm = INP(a, I_NMIX) + (size_t)l * DM;
#pragma unroll
        for (int q = 0; q < 2; ++q) { if (!ok[q]) continue;
            const int b = row[q] / SEQ; const float rs = frsq(ss[q] * (1.0f / DM) + EPS);
            const float* mm = mod + ((size_t)l * 2 + b) * 6 * DM; bf16* hb = (bf16*)(ws + WS_H) + (size_t)row[q] * DM;
#pragma unroll
            for (int j = 0; j < NJV; ++j) { const int cidx = 4 * lane + 256 * j; f32x4 g = *(const f32x4*)(nm + cidx), sh = *(const f32x4*)(mm + cidx), sc = *(const f32x4*)(mm + DM + cidx), o;
#pragma unroll
                for (int r = 0; r < 4; ++r) o[r] = v[q][j][r] * rs * g[r] * (1.0f + sc[r]) + sh[r];
                st_bf4(hb + cidx, o); } }
    }
}

DEV void route_phase(const Args& a, unsigned char* smem, int l) {
    unsigned char* ws = wsp(a); const int tid = TID, w = tid >> 6, lane = tid & 63, h = lane >> 4, c = lane & 15, pi = w >> 1, kh = w & 1;
    constexpr int NCHK = 4, CH = DM / NCHK, WLD = CH + 8, NKS = CH / 2 / 32;
    constexpr int WTOT = 48 * (CH / 8), WMAX = (WTOT + NT - 1) / NT;
    bf16* WHl = (bf16*)smem; bf16* WLl = WHl + 48 * WLD;
    float* lg = (float*)(WLl + 48 * WLD);
    float* ssb = lg + 4 * 2 * 16 * 48;
    float* rsb = ssb + 4 * 2 * 16;
    int* lcnt = (int*)(rsb + 64); int* lbase = lcnt + 32; int* tinfo = lbase + 32;
    float* avl = (float*)(tinfo + 256); float* cvl = avl + 2 * DM;
    const float* mod = (const float*)(ws + WS_MOD);
    SYNC();
    if (tid < 32) lcnt[tid] = 0;
    for (int i = tid; i < 2 * DM; i += NT) { const int b = i / DM, k = i % DM; avl[i] = ((const float*)(ws + WS_AVEC))[((size_t)l * 2 + b) * DM + k]; cvl[i] = mod[((size_t)l * 2 + b) * 6 * DM + 3 * DM + k]; }
    const bf16* WH = (const bf16*)(ws + WS_WTH) + (size_t)l * 48 * DM; const bf16* WL = (const bf16*)(ws + WS_WTL) + (size_t)l * 48 * DM;
    int* cnt = (int*)(ws + WS_CNT) + l * 32 * 64;
    for (int pass0 = BID; pass0 < T / 16; pass0 += 4 * NBLK) {
        const int pass = pass0 + pi * NBLK; const bool valid = pass < T / 16;
        const int tok = valid ? pass * 16 + c : 0, b = tok / SEQ;
        const float* xrow = outp(a) + (size_t)tok * DM;
        f32x4 xv[2][NKS][2]; bf16x8 wh[WMAX], wl[WMAX];
#pragma unroll
        for (int ks = 0; ks < NKS; ++ks) { const float* xq = xrow + kh * (CH / 2) + 8 * h + 32 * ks; xv[0][ks][0] = *(const f32x4*)xq; xv[0][ks][1] = *(const f32x4*)(xq + 4); }
#pragma unroll
        for (int t = 0; t < WMAX; ++t) { const int i = tid + NT * t; if (i < WTOT) { const int n = i / (CH / 8), k8 = (i % (CH / 8)) * 8; wh[t] = *(const bf16x8*)(WH + (size_t)n * DM + k8); wl[t] = *(const bf16x8*)(WL + (size_t)n * DM + k8); } }
        f32x4 acc[3] = {f4zero(), f4zero(), f4zero()}; float ss = 0.f;
        bf16x8 uhk[NCHK * NKS];
#pragma unroll
        for (int chn = 0; chn < NCHK; ++chn) {
            SYNC();
#pragma unroll
            for (int t = 0; t < WMAX; ++t) { const int i = tid + NT * t; if (i < WTOT) { const int n = i / (CH / 8), k8 = (i % (CH / 8)) * 8; *(bf16x8*)(WHl + n * WLD + k8) = wh[t]; *(bf16x8*)(WLl + n * WLD + k8) = wl[t]; } }
            SYNC();
            if (chn + 1 < NCHK) {
#pragma unroll
                for (int ks = 0; ks < NKS; ++ks) { const float* xq = xrow + (chn + 1) * CH + kh * (CH / 2) + 8 * h + 32 * ks; xv[(chn + 1) & 1][ks][0] = *(const f32x4*)xq; xv[(chn + 1) & 1][ks][1] = *(const f32x4*)(xq + 4); }
#pragma unroll
                for (int t = 0; t < WMAX; ++t) { const int i = tid + NT * t; if (i < WTOT) { const int n = i / (CH / 8), k8 = (i % (CH / 8)) * 8; wh[t] = *(const bf16x8*)(WH + (size_t)n * DM + (chn + 1) * CH + k8); wl[t] = *(const bf16x8*)(WL + (size_t)n * DM + (chn + 1) * CH + k8); } }
            }
            if (valid) {
                const bf16* whp = WHl + c * WLD + kh * (CH / 2) + 8 * h; const bf16* wlp = WLl + c * WLD + kh * (CH / 2) + 8 * h;
                const float* ap = avl + b * DM + chn * CH + kh * (CH / 2) + 8 * h;
#pragma unroll
                for (int ks = 0; ks < NKS; ++ks) {
                    const f32x4 a0 = *(const f32x4*)(ap + 32 * ks), a1 = *(const f32x4*)(ap + 32 * ks + 4);
                    const f32x4 x0 = xv[chn & 1][ks][0], x1 = xv[chn & 1][ks][1];
                    f32x4 u0, u1, r0, r1;
#pragma unroll
                    for (int r = 0; r < 4; ++r) { u0[r] = x0[r] * a0[r]; u1[r] = x1[r] * a1[r]; ss += x0[r] * x0[r] + x1[r] * x1[r]; }
                    const bf16x8 uh = pack8(u0, u1); uhk[chn * NKS + ks] = uh;
#pragma unroll
                    for (int r = 0; r < 4; ++r) { r0[r] = u0[r] - bf2f((unsigned short)uh[r]); r1[r] = u1[r] - bf2f((unsigned short)uh[4 + r]); }
                    const bf16x8 ul = pack8(r0, r1);
#pragma unroll
                    for (int nt = 0; nt < 3; ++nt) { const bf16x8 whf = *(const bf16x8*)(whp + nt * 16 * WLD + 32 * ks), wlf = *(const bf16x8*)(wlp + nt * 16 * WLD + 32 * ks);
                        acc[nt] = mfma16(whf, uh, acc[nt]); acc[nt] = mfma16(wlf, uh, acc[nt]); acc[nt] = mfma16(whf, ul, acc[nt]); }
                }
            }
        }
        if (valid) {
            ss += shflx(ss, 16); ss += shflx(ss, 32);
            float* lgp = lg + ((pi * 2 + kh) * 16 + c) * 48 + 4 * h;
#pragma unroll
            for (int nt = 0; nt < 3; ++nt) *(f32x4*)(lgp + 16 * nt) = acc[nt];
            if (h == 0) ssb[(pi * 2 + kh) * 16 + c] = ss;
        }
        SYNC();
        if (tid < 64) { const int p2 = tid >> 4, tk = tid & 15, pass2 = pass0 + p2 * NBLK;
            if (pass2 < T / 16) { const int tok2 = pass2 * 16 + tk, b2 = tok2 / SEQ;
                const float rs = frsq((ssb[(p2 * 2 + 0) * 16 + tk] + ssb[(p2 * 2 + 1) * 16 + tk]) * (1.0f / DM) + EPS); rsb[p2 * 16 + tk] = rs;
                const float* l0 = lg + ((p2 * 2 + 0) * 16 + tk) * 48; const float* l1 = lg + ((p2 * 2 + 1) * 16 + tk) * 48; const float* rbp = (const float*)(ws + WS_RBIAS) + ((size_t)l * 2 + b2) * 48;
                float acc[36];
#pragma unroll
                for (int n = 0; n < 36; ++n) acc[n] = rs * (l0[n] + l1[n]) + rbp[n];
                int gs = 0; float gm = acc[0];
#pragma unroll
                for (int g = 1; g < 4; ++g) if (acc[g] > gm) { gm = acc[g]; gs = g; }
                float den = 0.f;
#pragma unroll
                for (int g = 0; g < 4; ++g) den += fexp2((acc[g] - gm) * LOG2E);
                const float ggate = 1.0f / den;
                float el[8];
#pragma unroll
                for (int j = 0; j < 8; ++j) { el[j] = acc[4 + j];
#pragma unroll
                    for (int g = 1; g < 4; ++g) if (gs == g) el[j] = acc[4 + 8 * g + j]; }
                int ia = 0; float va = el[0];
#pragma unroll
                for (int j = 1; j < 8; ++j) if (el[j] > va) { va = el[j]; ia = j; }
                int ib = -1; float vb = -3e38f;
#pragma unroll
                for (int j = 0; j < 8; ++j) if (j != ia && el[j] > vb) { vb = el[j]; ib = j; }
                const float wa = 1.0f / (1.0f + fexp2((vb - va) * LOG2E)), wb = 1.0f - wa;
                const int e0 = gs * 8 + ia, e1 = gs * 8 + ib;
                const int p0 = atomic_add_i(lcnt + e0, 1), p1 = atomic_add_i(lcnt + e1, 1);
                int* ti = tinfo + tid * 4;
                ti[0] = (e0 << 14) | p0; ti[1] = (e1 << 14) | p1; ti[2] = __builtin_bit_cast(int, ggate * wa); ti[3] = __builtin_bit_cast(int, ggate * wb);
            } }
        SYNC();
        int gbase = 0;
        if (tid < 32) { const int n = lcnt[tid]; gbase = n > 0 ? atomic_add_i(cnt + tid * 64, n) : 0; }
        if (valid) { const float rs = rsb[pi * 16 + c]; bf16* hb = (bf16*)(ws + WS_H) + (size_t)tok * DM + kh * (CH / 2) + 8 * h;
            const float* cp = cvl + b * DM + kh * (CH / 2) + 8 * h;
#pragma unroll
            for (int chn = 0; chn < NCHK; ++chn)
#pragma unroll
                for (int ks = 0; ks < NKS; ++ks) {
                    const bf16x8 uh = uhk[chn * NKS + ks]; const f32x4 c0 = *(const f32x4*)(cp + chn * CH + 32 * ks), c1 = *(const f32x4*)(cp + chn * CH + 32 * ks + 4);
                    f32x4 o0, o1;
#pragma unroll
                    for (int r = 0; r < 4; ++r) { o0[r] = bf2f((unsigned short)uh[r]) * rs + c0[r]; o1[r] = bf2f((unsigned short)uh[4 + r]) * rs + c1[r]; }
                    st_bf8(hb + chn * CH + 32 * ks, o0, o1); } }
        if (tid < 32) { lbase[tid] = gbase; lcnt[tid] = 0; }
        SYNC();
        if (tid < 64) { const int p2 = tid >> 4, pass2 = pass0 + p2 * NBLK;
            if (pass2 < T / 16) { const int tok2 = pass2 * 16 + (tid & 15); const int* ti = tinfo + tid * 4;
                const int e0 = ti[0] >> 14, e1 = ti[1] >> 14, p0 = lbase[e0] + (ti[0] & 16383), p1 = lbase[e1] + (ti[1] & 16383);
                int* list = (int*)(ws + WS_LIST); list[(size_t)e0 * T + p0] = tok2; list[(size_t)e1 * T + p1] = tok2;
                int* tie = (int*)(ws + WS_TIE) + (size_t)tok2 * 2; int* tiw = (int*)(ws + WS_TIW) + (size_t)tok2 * 2;
                tie[0] = (e0 << 14) | p0; tie[1] = (e1 << 14) | p1; tiw[0] = ti[2]; tiw[1] = ti[3]; } }
        SYNC();
    }
}

DEV int vbid() { const int g = NBLK; return (g % 8 == 0) ? (BID % 8) * (g / 8) + BID / 8 : BID; }
#ifdef EMU
#define PG8_LDS(p) (p)
#else
#define PG8_LDS(p) ((PG8_LAS unsigned char*)(p))
#endif
DEV void inproj_phase(const Args& a, unsigned char* smem, int li) {
    pg8::Gemm g{(const bf16*)(wsp(a) + WS_H), (const bf16*)(wsp(a) + WS_WIN) + (size_t)li * NIN8 * DM, T, NIN8, DM}; pg8::StaticOrder S; S.init(T, NIN8, NBLK, BID);
    EpiInProj8 E{&a, li};
    SYNC(); pg8::gemm_phase<EpiInProj8, pg8::StaticOrder, true, true>(PG8_LDS(smem), g, S, E); SYNC();
}
DEV void resid_gemm_phase(const Args& a, unsigned char* smem, const bf16* A, int K, const bf16* Bt, int l) {
    pg8::Gemm g{A, Bt, T, DM, K}; pg8::StaticOrder S; S.init(T, DM, NBLK, BID);
    EpiResid8 E{outp(a), (const float*)(wsp(a) + WS_MOD) + (size_t)l * 2 * 6 * DM + 2 * DM, l == 0 ? INP(a, I_X) : (const float*)outp(a)};
    SYNC(); pg8::gemm_phase<EpiResid8, pg8::StaticOrder, true, true>(PG8_LDS(smem), g, S, E); SYNC();
}
DEV void pw1_phase(const Args& a, unsigned char* smem, int li) {
    pg8::Gemm g{(const bf16*)(wsp(a) + WS_H), (const bf16*)(wsp(a) + WS_PW1) + (size_t)li * 2 * DM * DM, T, 2 * DM, DM}; pg8::StaticOrder S; S.init(T, 2 * DM, NBLK, BID);
    EpiGlu8 E{(bf16*)(wsp(a) + WS_GLU)};
    SYNC(); pg8::gemm_phase<EpiGlu8, pg8::StaticOrder, true, true>(PG8_LDS(smem), g, S, E); SYNC();
}
DEV void cmp_phase_items(const Args& a, unsigned char* smem, int li, int it) {
    constexpr int TMC = (NCP + 255) / 256;
    const int kv = it / (4 * TMC), bg = (it / TMC) % 4, tm = it % TMC;
    const bf16* src = (const bf16*)(wsp(a) + (kv ? WS_VCG : WS_KCG)) + (size_t)bg * SEQ * 64;
    struct AF { const bf16* base; int m0; MDEV unsigned off(int r) const { int n = m0 + r; if (n > NCMP - 1) n = NCMP - 1; return (unsigned)n * 1024u; } } af{src, tm * 256};
    EpiCmp E{&a, kv, bg, tm * 256, li};
    BClamp64 bf{INP(a, kv ? I_CWV : I_CWK) + (size_t)li * 2048 * 64};
    gemm_tile2(smem, af, bf, 64, 2048, E);
}
DEV void moe_gemm_phase8(const Args& a, unsigned char* smem, int l, int mode) {
    unsigned char* ws = wsp(a); const int* cnt = (const int*)(ws + WS_CNT) + l * 32 * 64;
    int* rb = (int*)(smem + 140 * 1024);
    moe_bases(cnt, rb);
    const int mrows = rb[32];
    if (mode == 0) {
        pg8::Gemm g{(const bf16*)(ws + WS_H), (const bf16*)(ws + WS_W13) + (size_t)l * 32 * 2 * FF * DM, mrows, 2 * FF, DM}; pg8::StaticOrder S; S.init(mrows, 2 * FF, NBLK, BID);
        EpiMoe1_8 E{(bf16*)(ws + WS_ACT)}; MoeSel<true> X{rb, cnt, (const int*)(ws + WS_LIST), (size_t)2 * FF * DM * 2};
        SYNC(); pg8::gemm_phase<EpiMoe1_8, pg8::StaticOrder, true, true, MoeSel<true>>(PG8_LDS(smem), g, S, E, X); SYNC();
    } else {
        pg8::Gemm g{(const bf16*)(ws + WS_ACT), (const bf16*)(ws + WS_W2) + (size_t)l * 32 * DM * FF, mrows, DM, FF}; pg8::StaticOrder S; S.init(mrows, DM, NBLK, BID);
        EpiMoe2_8 E{(bf16*)(ws + WS_YK)}; MoeSel<false> X{rb, cnt, (const int*)(ws + WS_LIST), (size_t)DM * FF * 2};
        SYNC(); pg8::gemm_phase<EpiMoe2_8, pg8::StaticOrder, true, true, MoeSel<false>>(PG8_LDS(smem), g, S, E, X); SYNC();
    }
}
DEV void moe_gemm_phase(const Args& a, unsigned char* smem, int l, int mode) {
    unsigned char* ws = wsp(a); const int* cnt = (const int*)(ws + WS_CNT) + l * 32 * 64;
    int* rb = (int*)(smem + GEMM2_LDS);
    moe_bases(cnt, rb);
    const int ntile = rb[32] >> 8;
    constexpr int TN1 = 2 * FF / 128, TN2 = DM / 128;
    const int TN = mode == 0 ? TN1 : TN2;
    const int* list = (const int*)(ws + WS_LIST);
    for (int it = vbid(); it < ntile * TN; it += NBLK) {
        const int rt = it / TN, tn = it % TN; int e = 0;
#pragma unroll 1
        for (int q = 1; q < 32; ++q) if ((rb[q] >> 8) <= rt) e = q;
        const int rloc = (rt << 8) - rb[e], ce = cnt[e * 64], nvalid = (ce - rloc) < 256 ? (ce - rloc) : 256;
        if (mode == 0) {
            struct AF { const bf16* base; const int* lst; int nv; MDEV unsigned off(int r) const { const int rr = r < nv ? r : nv - 1; return (unsigned)lst[rr] * (unsigned)DM; } }
                af{(const bf16*)(ws + WS_H), list + (size_t)e * T + rloc, nvalid};
            EpiGated<1> E{(bf16*)(ws + WS_ACT), (size_t)FF, rt << 8, tn * 128, nvalid};
            BInter bf{INP(a, I_W1) + (size_t)(l * 32 + e) * DM * FF, INP(a, I_W3) + (size_t)(l * 32 + e) * DM * FF, tn * 128};
            gemm_tile2(smem, af, bf, FF, DM, E);
        } else {
            ARows af{(const bf16*)(ws + WS_ACT) + (size_t)(rt << 8) * FF, (size_t)FF};
            EpiStoreBf E{(bf16*)(ws + WS_YK), (size_t)DM, rt << 8, tn * 128, nvalid};
            BPlain bf{INP(a, I_W2) + (size_t)(l * 32 + e) * FF * DM + tn * 128};
            gemm_tile2(smem, af, bf, DM, FF, E);
        }
    }
}

constexpr int LDV = 80;
constexpr int AT_K = 0, AT_V = 2 * 64 * LDT * 2, AT_IMP = AT_V + 2 * 64 * LDV * 2, AT_SEL = AT_IMP + 8 * 8 * 128 * 4, AT_GSEL = AT_SEL + 8 * 8 * 4 * 4, AT_OUT = AT_GSEL + 8 * 2 * 4 * 4, AT_END = AT_OUT + 8 * 32 * 64 * 4;
#ifdef EMU
DEV float rexp2(float x) { return exp2f(x); }
DEV unsigned uni(unsigned x) { return x; }
#else
DEV float rexp2(float x) { return __builtin_amdgcn_exp2f(x); }
DEV unsigned uni(unsigned x) { return (unsigned)__builtin_amdgcn_readfirstlane((int)x); }
#endif
DEV int krow_lds(int kappa) { return 16 * (2 * (kappa >> 5) + ((kappa >> 2) & 1)) + 4 * ((kappa >> 3) & 3) + (kappa & 3); }
template <int MASK, bool FULL, int GM>
DEV void attn_block(const bf16* Kp, const bf16* Vp, const bf16x8 (&qf)[2][2], int j, const int (&s)[2], const bool (&selbit)[2], float C2, int h, int c,
                    f32x4 (&O)[2][4], f32x4 (&Ol)[2]) {
    f32x4 st[2][2][2];
#pragma unroll
    for (int sp = 0; sp < 2; ++sp)
#pragma unroll
        for (int u = 0; u < 2; ++u) {
#pragma unroll
            for (int G = 0; G < 2; ++G) { st[G][sp][u][0] = -C2; st[G][sp][u][1] = -C2; st[G][sp][u][2] = -C2; st[G][sp][u][3] = -C2; }
#pragma unroll
            for (int ks = 0; ks < 2; ++ks) { const bf16x8 kf = *(const bf16x8*)(Kp + (16 * (2 * sp + u) + c) * LDT + 32 * ks + 8 * h);
#pragma unroll
                for (int G = 0; G < 2; ++G) if (GM & (1 << G)) st[G][sp][u] = mfma16(kf, qf[G][ks], st[G][sp][u]); } }
#pragma unroll
    for (int G = 0; G < 2; ++G) if (GM & (1 << G))
#pragma unroll
        for (int sp = 0; sp < 2; ++sp)
#pragma unroll
            for (int u = 0; u < 2; ++u)
#pragma unroll
                for (int r = 0; r < 4; ++r) { bool ok = selbit[G];
                    if (!FULL) { const int key = 64 * j + 32 * sp + 8 * h + 4 * u + r;
                        if (MASK == 0) ok = 16 * key + 31 <= s[G]; else if (MASK == 1) ok = selbit[G] && key <= s[G]; else ok = key <= s[G] && key > s[G] - 512; }
                    st[G][sp][u][r] = ok ? rexp2(st[G][sp][u][r]) : 0.f; }
    bf16x8 pb[2][2], ones;
#pragma unroll
    for (int q = 0; q < 8; ++q) ones[q] = (short)0x3F80;
#pragma unroll
    for (int G = 0; G < 2; ++G) if (GM & (1 << G))
#pragma unroll
        for (int sp = 0; sp < 2; ++sp) { pb[G][sp] = pack8(st[G][sp][0], st[G][sp][1]); Ol[G] = mfma16(ones, pb[G][sp], Ol[G]); }
    const bf16* Vb = Vp + bperm(8 * h + (c >> 2)) * LDV + 4 * (c & 3);
#pragma unroll
    for (int et = 0; et < 4; ++et)
#pragma unroll
        for (int sp = 0; sp < 2; ++sp) { const bf16x8 vf = tr_read8(Vb + (32 * sp) * LDV + 16 * et, Vb + (32 * sp + 8) * LDV + 16 * et);
#pragma unroll
            for (int G = 0; G < 2; ++G) if (GM & (1 << G)) O[G][et] = mfma16(vf, pb[G][sp], O[G][et]); }
}

struct ImpState { float invq[2][4]; float carry[2]; float* imps; int tl, hd, l, s0, qblk; };
DEV void imp_block(const bf16* Kp, const bf16x8 (&qf)[2][2], int j, int s0, int w, float C2, int h, int c, ImpState& im) {
#pragma unroll
    for (int kt = 0; kt < 4; ++kt) {
        const int row = krow_lds(16 * kt + c);
        const bf16x8 k0 = *(const bf16x8*)(Kp + row * LDT + 8 * h), k1 = *(const bf16x8*)(Kp + row * LDT + 32 + 8 * h);
        const int n = 64 * j + 16 * kt + c;
#pragma unroll
        for (int G = 0; G < 2; ++G) {
            f32x4 acc; acc[0] = -C2; acc[1] = -C2; acc[2] = -C2; acc[3] = -C2;
            acc = mfma16(qf[G][0], k0, acc); acc = mfma16(qf[G][1], k1, acc);
            const bool ok = 16 * n + 31 <= s0 + 8 * w + 4 * G + h;
            float imp = 0.f;
#pragma unroll
            for (int r = 0; r < 4; ++r) imp += ok ? rexp2(acc[r]) * im.invq[G][r] : 0.f;
            const float v = ((c & 3) == 3) ? imp : 2.0f * imp;
            float sq = v + shflx(v, 1); sq += shflx(sq, 2);
            const float rr = dpp_ror1(imp);
            const float prev = (c == 0) ? im.carry[G] : rr;
            im.carry[G] = rr;
            const int m = n >> 2;
            if ((c & 3) == 0 && m < 128) im.imps[(G * 4 + h) * 128 + m] = sq + prev;
        }
    }
}

template <int MODE>
DEV void attn_branch(bf16* Kl, bf16* Vl, const bf16* kbase, const bf16* vbase, int jlo, int jhi,
                     const bf16x8 (&qf)[2][2], const int (&s)[2], const unsigned* selm, const unsigned* gselm, float C2, int w, int h, int c, int srow, int scol,
                     f32x4 (&O)[2][4], f32x4 (&Ol)[2], ImpState& im) {
    constexpr bool PV = MODE != 1; constexpr int MASK = MODE <= 1 ? 0 : MODE - 1;
    const int krow = krow_lds(srow) * LDT + scol, vrow = bperm(srow) * LDV + scol;
    bf16x8 rk[3], rv[3];
    { const bf16x8 k0 = *(const bf16x8*)(kbase + (size_t)jlo * 4096); *(bf16x8*)(Kl + krow) = k0;
      if (PV) { const bf16x8 v0 = *(const bf16x8*)(vbase + (size_t)jlo * 4096); *(bf16x8*)(Vl + vrow) = v0; } }
#pragma unroll
    for (int u = 0; u < 3; ++u) { int jj = jlo + 1 + u; if (jj > jhi) jj = jhi; rk[(1 + u) % 3] = *(const bf16x8*)(kbase + (size_t)jj * 4096); if (PV) rv[(1 + u) % 3] = *(const bf16x8*)(vbase + (size_t)jj * 4096); }
    SYNC();
    for (int jb = jlo; jb <= jhi; jb += 3) {
#pragma unroll
        for (int u = 0; u < 3; ++u) { const int j = jb + u;
            if (j <= jhi) {
                const int cur = (j - jlo) & 1;
                const bf16* Kc = Kl + cur * 64 * LDT; const bf16* Vc = Vl + cur * 64 * LDV;
                if (MODE == 1) imp_block(Kc, qf, j, im.s0, w, C2, h, c, im);
                else {
                    bool sb[2] = {true, true}; unsigned gm = 3u;
                    if (MODE == 2) { gm = 0u;
#pragma unroll
                        for (int G = 0; G < 2; ++G) { const unsigned wq = uni(gselm[G * 4 + (j >> 5)]), mq = selm[(G * 4 + im.tl) * 4 + (j >> 5)];
                            gm |= ((wq >> (j & 31)) & 1u) << G; sb[G] = (mq >> (j & 31)) & 1u; } }
                    bool full;
                    if (MODE == 0) full = 1024 * j + 1039 <= im.s0; else if (MODE == 2) full = j < im.qblk; else full = (j < im.qblk) && (64 * j > im.s0 + 63 - 512);
                    if (MODE == 2) {
                        if (full) { if (gm == 3u) attn_block<MASK, true, 3>(Kc, Vc, qf, j, s, sb, C2, h, c, O, Ol); else if (gm == 1u) attn_block<MASK, true, 1>(Kc, Vc, qf, j, s, sb, C2, h, c, O, Ol); else if (gm == 2u) attn_block<MASK, true, 2>(Kc, Vc, qf, j, s, sb, C2, h, c, O, Ol); }
                        else { if (gm == 3u) attn_block<MASK, false, 3>(Kc, Vc, qf, j, s, sb, C2, h, c, O, Ol); else if (gm == 1u) attn_block<MASK, false, 1>(Kc, Vc, qf, j, s, sb, C2, h, c, O, Ol); else if (gm == 2u) attn_block<MASK, false, 2>(Kc, Vc, qf, j, s, sb, C2, h, c, O, Ol); }
                    } else { if (full) attn_block<MASK, true, 3>(Kc, Vc, qf, j, s, sb, C2, h, c, O, Ol); else attn_block<MASK, false, 3>(Kc, Vc, qf, j, s, sb, C2, h, c, O, Ol); }
                }
                if (j + 1 <= jhi) {
                    *(bf16x8*)(Kl + (cur ^ 1) * 64 * LDT + krow) = rk[(u + 1) % 3]; if (PV) *(bf16x8*)(Vl + (cur ^ 1) * 64 * LDV + vrow) = rv[(u + 1) % 3];
                    int jj = j + 4; if (jj > jhi) jj = jhi;
                    rk[(u + 1) % 3] = *(const bf16x8*)(kbase + (size_t)jj * 4096); if (PV) rv[(u + 1) % 3] = *(const bf16x8*)(vbase + (size_t)jj * 4096);
                }
                SYNC();
            }
        }
    }
}

DEV void attn_task(const Args& a, unsigned char* smem, int li, int item) {
    unsigned char* ws = wsp(a); const int tid = TID, w = tid >> 6, l = tid & 63, h = l >> 4, c = l & 15, tl = c >> 2, hd = c & 3;
    const int bg = item & 3, b = bg >> 1, g = bg & 1, tq = (SEQ / 64 - 1) - (item >> 2), s0 = tq * 64, qblk = tq;
    int s[2], row[2];
#pragma unroll
    for (int G = 0; G < 2; ++G) { s[G] = s0 + 8 * w + 4 * G + tl; row[G] = b * SEQ + s[G]; }
    bf16* Kl = (bf16*)(smem + AT_K); bf16* Vl = (bf16*)(smem + AT_V); float* imps = (float*)(smem + AT_IMP) + w * 1024; unsigned* selm = (unsigned*)(smem + AT_SEL) + w * 32;
    bf16x8 qf[2][2]; float gatec[2], gates[2], gatew[2];
#pragma unroll
    for (int G = 0; G < 2; ++G) { const bf16* qp = (const bf16*)(ws + WS_QN) + (size_t)row[G] * 512 + (g * 4 + hd) * 64 + 8 * h; qf[G][0] = *(const bf16x8*)qp; qf[G][1] = *(const bf16x8*)(qp + 32);
        const float* gp = (const float*)(ws + WS_GATE) + (size_t)row[G] * 24 + (g * 4 + hd) * 3; gatec[G] = gp[0]; gates[G] = gp[1]; gatew[G] = gp[2]; }
    const float* cs = (const float*)(ws + WS_CS) + li * 4;
    const int srow = tid >> 3, scol = (tid & 7) * 8;
    for (int i = l; i < 1024; i += 64) imps[i] = 0.f;
    SYNC();
    unsigned* gselm = (unsigned*)(smem + AT_GSEL) + w * 8; float* outl = (float*)(smem + AT_OUT) + w * 2048 + l;
    ImpState im{{{0.f, 0.f, 0.f, 0.f}, {0.f, 0.f, 0.f, 0.f}}, {0.f, 0.f}, imps, tl, hd, l, s0, qblk};
    {
        const int ncv = s0 / 16 + 3, ncb0 = (ncv + 63) >> 6, ncb = ncb0 > NCP / 64 ? NCP / 64 : ncb0;
        const bf16* kcb = (const bf16*)(ws + WS_KC) + (size_t)bg * NCP * 64 + tid * 8;
        const bf16* vcb = (const bf16*)(ws + WS_VCT) + (size_t)bg * NCP * 64 + tid * 8;
        f32x4 O[2][4], Ol[2] = {f4zero(), f4zero()};
#pragma unroll
        for (int G = 0; G < 2; ++G)
#pragma unroll
            for (int et = 0; et < 4; ++et) O[G][et] = f4zero();
        attn_branch<0>(Kl, Vl, kcb, vcb, 0, ncb - 1, qf, s, selm, gselm, cs[0], w, h, c, srow, scol, O, Ol, im);
#pragma unroll
        for (int G = 0; G < 2; ++G) { const float lsum = Ol[G][0]; const float invl = lsum > 0.f ? 1.0f / lsum : 0.f;
#pragma unroll
            for (int r = 0; r < 4; ++r) im.invq[G][r] = shfl(invl, 4 * h + r);
#pragma unroll
            for (int et = 0; et < 4; ++et)
#pragma unroll
                for (int r = 0; r < 4; ++r) outl[((G * 4 + et) * 4 + r) * 64] = gatec[G] * invl * O[G][et][r]; }
        f32x4 ld[2] = {f4zero(), f4zero()};
        attn_branch<1>(Kl, Vl, kcb, vcb, 0, ncb - 1, qf, s, selm, gselm, cs[0], w, h, c, srow, scol, O, ld, im);
    }
    WSYNC();
#pragma unroll 1
    for (int G = 0; G < 2; ++G) {
        const int tk = l >> 4, i = l & 15; float vals[8];
#pragma unroll
        for (int mm = 0; mm < 8; ++mm) { const int jj = i + 16 * mm; vals[mm] = jj > qblk ? NEGV : ((jj == 0 || jj == qblk || jj == qblk - 1) ? FORCEV : imps[(G * 4 + tk) * 128 + jj]); }
        unsigned mk[4] = {0u, 0u, 0u, 0u};
#pragma unroll 1
        for (int rnd = 0; rnd < 16; ++rnd) {
            float best = vals[0]; int bj = i;
#pragma unroll
            for (int mm = 1; mm < 8; ++mm) if (vals[mm] > best) { best = vals[mm]; bj = i + 16 * mm; }
#pragma unroll
            for (int o = 1; o < 16; o <<= 1) { const float ov = shflx(best, o); const int oj = shflxi(bj, o); if (ov > best || (ov == best && oj < bj)) { best = ov; bj = oj; } }
            if (best > NEGV * 0.5f) {
#pragma unroll
                for (int q = 0; q < 4; ++q) if ((bj >> 5) == q) mk[q] |= 1u << (bj & 31); }
            if ((bj & 15) == i) {
#pragma unroll
                for (int mm = 0; mm < 8; ++mm) if ((bj >> 4) == mm) vals[mm] = -3e38f; }
        }
        if (i == 0) {
#pragma unroll
            for (int q = 0; q < 4; ++q) selm[(G * 4 + tk) * 4 + q] = mk[q]; }
    }
    WSYNC();
    if (l < 8) { const int G = l >> 2, q = l & 3; gselm[l] = selm[(G * 4 + 0) * 4 + q] | selm[(G * 4 + 1) * 4 + q] | selm[(G * 4 + 2) * 4 + q] | selm[(G * 4 + 3) * 4 + q]; }
    WSYNC();
#pragma unroll
    for (int br = 0; br < 2; ++br) {
        const bf16* kb = (const bf16*)(ws + (br == 0 ? WS_KS : WS_KW)) + (size_t)bg * SEQ * 64 + tid * 8; const bf16* vb = (const bf16*)(ws + (br == 0 ? WS_VST : WS_VWT)) + (size_t)bg * SEQ * 64 + tid * 8;
        f32x4 O[2][4], Ol[2] = {f4zero(), f4zero()};
#pragma unroll
        for (int G = 0; G < 2; ++G)
#pragma unroll
            for (int et = 0; et < 4; ++et) O[G][et] = f4zero();
        if (br == 0) attn_branch<2>(Kl, Vl, kb, vb, 0, qblk, qf, s, selm, gselm, cs[1], w, h, c, srow, scol, O, Ol, im);
        else attn_branch<3>(Kl, Vl, kb, vb, s0 >= 511 ? (s0 - 511) >> 6 : 0, qblk, qf, s, selm, gselm, cs[2], w, h, c, srow, scol, O, Ol, im);
#pragma unroll
        for (int G = 0; G < 2; ++G) { const float lsum = Ol[G][0]; const float sc = (br == 0 ? gates[G] : gatew[G]) * (lsum > 0.f ? 1.0f / lsum : 0.f);
#pragma unroll
            for (int et = 0; et < 4; ++et)
#pragma unroll
                for (int r = 0; r < 4; ++r) outl[((G * 4 + et) * 4 + r) * 64] += sc * O[G][et][r]; }
    }
#pragma unroll
    for (int G = 0; G < 2; ++G) { bf16* dst = (bf16*)(ws + WS_CAT) + (size_t)row[G] * 1024 + (g * 4 + hd) * 64 + 4 * h;
#pragma unroll
        for (int et = 0; et < 4; ++et) { f32x4 o;
#pragma unroll
            for (int r = 0; r < 4; ++r) o[r] = outl[((G * 4 + et) * 4 + r) * 64];
            st_bf4(dst + 16 * et, o); } }
}

constexpr int LDH = 136;
DEV void hg_cumsum(const float* fsrc  , float* segs  , int d, int seg, float (&f)[16], float (&bc)[16], float& bend, float& bmid) {
    float run = 0.f;
#pragma unroll
    for (int i = 0; i < 16; ++i) { f[i] = fsrc[(size_t)(16 * seg + i) * 128 + d]; run += log2f(f[i]); bc[i] = run; }
    SYNC();
    segs[seg * 128 + d] = run;
    SYNC();
    const float s0 = segs[d], s1 = segs[128 + d], s2 = segs[256 + d], s3 = segs[384 + d];
    const float off = seg == 0 ? 0.f : (seg == 1 ? s0 : (seg == 2 ? s0 + s1 : s0 + s1 + s2));
#pragma unroll
    for (int i = 0; i < 16; ++i) bc[i] += off;
    bend = s0 + s1 + s2 + s3; bmid = s0 + s1;
}
DEV void hg_write16(bf16* dstrow  , const float (&v)[16]) {
    u32x4 w0, w1;
#pragma unroll
    for (int q = 0; q < 4; ++q) { w0[q] = pk2(v[2 * q], v[2 * q + 1]); w1[q] = pk2(v[8 + 2 * q], v[8 + 2 * q + 1]); }
    *(u32x4*)dstrow = w0; *(u32x4*)(dstrow + 8) = w1;
}
DEV void hg_h1_task(const Args& a, unsigned char* smem, int task) {
    unsigned char* ws = wsp(a); const int tid = TID, w = tid >> 6, l = tid & 63, h = l >> 4, c = l & 15, d = tid & 127, seg = tid >> 7;
    const int bh = task / NCH, ch = task % NCH;
    bf16* kT = (bf16*)smem; bf16* vT = kT + 128 * LDT; float* segs = (float*)(vT + 128 * LDT);
    const size_t tokb = (size_t)bh * SEQ + ch * 64;
    float f[16], bc[16], bend, bmid;
    const bf16* vs = (const bf16*)(ws + WS_HV) + tokb * 128;
    bf16 vraw[16];
#pragma unroll
    for (int i = 0; i < 16; ++i) vraw[i] = vs[(size_t)(16 * seg + i) * 128 + d];
    hg_cumsum((const float*)(ws + WS_HF) + tokb * 128, segs, d, seg, f, bc, bend, bmid);
    float kv[16];
#pragma unroll
    for (int i = 0; i < 16; ++i) kv[i] = (1.0f - f[i]) * fexp2(bend - bc[i]);
    hg_write16(kT + d * LDT + 16 * seg, kv);
#pragma unroll
    for (int i = 0; i < 16; ++i) kv[i] = bf2f(vraw[i]);
    hg_write16(vT + d * LDT + 16 * seg, kv);
    if (seg == 0) ((float*)(ws + WS_GD))[((size_t)bh * NCH + ch) * 128 + d] = fexp2(bend);
    SYNC();
    f32x4 acc[8];
#pragma unroll
    for (int et = 0; et < 8; ++et) acc[et] = f4zero();
#pragma unroll
    for (int ks = 0; ks < 2; ++ks) { const bf16x8 fa = *(const bf16x8*)(kT + (16 * w + c) * LDT + 32 * ks + 8 * h);
#pragma unroll
        for (int et = 0; et < 8; ++et) acc[et] = mfma16(fa, *(const bf16x8*)(vT + (16 * et + c) * LDT + 32 * ks + 8 * h), acc[et]); }
    float* ut = (float*)(ws + WS_UT) + ((size_t)bh * NCH + ch) * 16384;
#pragma unroll
    for (int et = 0; et < 8; ++et) *(f32x4*)(ut + (size_t)(16 * et + c) * 128 + 16 * w + 4 * h) = acc[et];
    SYNC();
}
DEV void hg_scan_task(const Args& a, int sc) {
    unsigned char* ws = wsp(a); const int bh = sc >> 3, q = (sc & 7) * 512 + TID, e = q >> 5, d0 = (q & 31) * 4;
    const float* ut = (const float*)(ws + WS_UT) + (size_t)bh * NCH * 16384 + (size_t)e * 128 + d0;
    const float* gd = (const float*)(ws + WS_GD) + (size_t)bh * NCH * 128 + d0;
    bf16* st = (bf16*)(ws + WS_ST) + (size_t)bh * NCH * 16384 + (size_t)e * 128 + d0;
    f32x4 S = f4zero();
#pragma unroll 4
    for (int ch = 0; ch < NCH; ++ch) { st_bf4(st + (size_t)ch * 16384, S);
        const f32x4 g = *(const f32x4*)(gd + (size_t)ch * 128), u = *(const f32x4*)(ut + (size_t)ch * 16384);
#pragma unroll
        for (int r = 0; r < 4; ++r) S[r] = g[r] * S[r] + u[r]; }
}
DEV void hg_h3_task(const Args& a, unsigned char* smem, int li, int task) {
    unsigned char* ws = wsp(a); const int tid = TID, w = tid >> 6, l = tid & 63, h = l >> 4, c = l & 15, d = tid & 127, seg = tid >> 7;
    const int bh = task / NCH, ch = task % NCH, b = bh >> 2, hh = bh & 3;
    bf16* At = (bf16*)smem; bf16* Bt = At + 64 * LDH; bf16* Qt = Bt + 64 * LDH; bf16* vT = Qt + 64 * LDH; float* segs = (float*)(vT + 128 * LDT); float* part = segs + 512;
    const size_t tokb = (size_t)bh * SEQ + ch * 64;
    float f[16], bc[16], bend, bmid;
    const bf16* qs = (const bf16*)(ws + WS_HQ) + tokb * 128; const bf16* vs = (const bf16*)(ws + WS_HV) + tokb * 128;
    const int tt = w & 3, eh = w >> 2;
    bf16 qraw[16], vraw[16];
#pragma unroll
    for (int i = 0; i < 16; ++i) { const int t = 16 * seg + i; qraw[i] = qs[(size_t)t * 128 + d]; vraw[i] = vs[(size_t)t * 128 + d]; }
    const bf16* stp = (const bf16*)(ws + WS_ST) + ((size_t)bh * NCH + ch) * 16384;
    bf16x8 stf[4][4];
#pragma unroll
    for (int ks = 0; ks < 4; ++ks)
#pragma unroll
        for (int et = 0; et < 4; ++et) stf[ks][et] = *(const bf16x8*)(stp + (size_t)(64 * eh + 16 * et + c) * 128 + 32 * ks + 8 * h);
    const int tok = b * SEQ + ch * 64 + 16 * tt + c;
    const bf16* hg = (const bf16*)(ws + WS_HGS) + (size_t)tok * 512 + hh * 128;
    u32x2 hgv[4];
#pragma unroll
    for (int et = 0; et < 4; ++et) hgv[et] = *(const u32x2*)(hg + 64 * eh + 16 * et + 4 * h);
    hg_cumsum((const float*)(ws + WS_HF) + tokb * 128, segs, d, seg, f, bc, bend, bmid);
    float vv[16];
#pragma unroll
    for (int i = 0; i < 16; ++i) { const int t = 16 * seg + i; const float q = bf2f(qraw[i]);
        At[t * LDH + d] = (bf16)f2bf(q * fexp2(bc[i] - bmid)); Bt[t * LDH + d] = (bf16)f2bf((1.0f - f[i]) * fexp2(bmid - bc[i])); Qt[t * LDH + d] = (bf16)f2bf(q * fexp2(bc[i]));
        vv[i] = bf2f(vraw[i]); }
    hg_write16(vT + d * LDT + 16 * seg, vv);
    SYNC();
    f32x4 O[4];
#pragma unroll
    for (int et = 0; et < 4; ++et) O[et] = f4zero();
#pragma unroll
    for (int sp = 0; sp < 2; ++sp) {
        if (32 * sp > 16 * tt + 15) continue;
        f32x4 st[2];
#pragma unroll
        for (int u = 0; u < 2; ++u) { st[u] = f4zero(); const int krow = 32 * sp + 8 * (c >> 2) + 4 * u + (c & 3);
#pragma unroll
            for (int ks = 0; ks < 4; ++ks) st[u] = mfma16(*(const bf16x8*)(Bt + krow * LDH + 32 * ks + 8 * h), *(const bf16x8*)(At + (16 * tt + c) * LDH + 32 * ks + 8 * h), st[u]);
#pragma unroll
            for (int r = 0; r < 4; ++r) { const int sk = 32 * sp + 8 * h + 4 * u + r; if (sk > 16 * tt + c) st[u][r] = 0.f; } }
        const bf16x8 pb = pack8(st[0], st[1]);
#pragma unroll
        for (int et = 0; et < 4; ++et) O[et] = mfma16(*(const bf16x8*)(vT + (64 * eh + 16 * et + c) * LDT + 32 * sp + 8 * h), pb, O[et]);
    }
#pragma unroll
    for (int ks = 0; ks < 4; ++ks) { const bf16x8 fq = *(const bf16x8*)(Qt + (16 * tt + c) * LDH + 32 * ks + 8 * h);
#pragma unroll
        for (int et = 0; et < 4; ++et) O[et] = mfma16(stf[ks][et], fq, O[et]); }
    float ss = 0.f;
#pragma unroll
    for (int et = 0; et < 4; ++et)
#pragma unroll
        for (int r = 0; r < 4; ++r) ss += O[et][r] * O[et][r];
    ss += shflx(ss, 16); ss += shflx(ss, 32);
    if (h == 0) part[eh * 64 + 16 * tt + c] = ss;
    SYNC();
    const float rs = frsq((part[16 * tt + c] + part[64 + 16 * tt + c]) * (1.0f / 128.0f) + EPS);
    const float* og = INP(a, I_OG) + li * 128;
    bf16* dst = (bf16*)(ws + WS_CAT) + (size_t)tok * 1024 + 512 + hh * 128;
#pragma unroll
    for (int et = 0; et < 4; ++et) { const int e = 64 * eh + 16 * et + 4 * h; f32x4 o; const f32x4 ogv = *(const f32x4*)(og + e);
        o[0] = O[et][0] * rs * ogv[0] * bf2f(hgv[et][0] & 0xffff); o[1] = O[et][1] * rs * ogv[1] * bf2f(hgv[et][0] >> 16);
        o[2] = O[et][2] * rs * ogv[2] * bf2f(hgv[et][1] & 0xffff); o[3] = O[et][3] * rs * ogv[3] * bf2f(hgv[et][1] >> 16);
        st_bf4(dst + e, o); }
    SYNC();
}

DEV void conv_task(const Args& a, unsigned char* smem, int li, int task) {
    unsigned char* ws = wsp(a); const int tid = TID, w = tid >> 6, lane = tid & 63;
    const bool act = tid < DM / 2; const int c0 = act ? 2 * tid : 0;
    const int t0 = task * 16, b = t0 / SEQ, s0 = t0 % SEQ;
    float* red = (float*)smem;
    const float* dw = INP(a, I_DW) + (size_t)li * 31 * DM + c0;
    float acc[16][2];
    const float b0 = INP(a, I_DWB)[li * DM + c0], b1 = INP(a, I_DWB)[li * DM + c0 + 1];
#pragma unroll
    for (int t = 0; t < 16; ++t) { acc[t][0] = b0; acc[t][1] = b1; }
    const bf16* glu = (const bf16*)(ws + WS_GLU) + (size_t)b * SEQ * DM + c0;
    unsigned uu[46];
    { const bf16* gp = glu + (size_t)(s0 - 30) * DM;
#pragma unroll
    for (int r = 0; r < 46; ++r) { const int si = s0 + r - 30; uu[r] = si >= 0 ? *(const unsigned*)gp : 0u; gp += DM; OPAQUE(gp); } }
    const float* dwp = dw;
#pragma unroll
    for (int j = 0; j < 31; ++j) { const float w0 = dwp[0], w1 = dwp[1]; dwp += DM; OPAQUE(dwp);
#pragma unroll
        for (int t = 0; t < 16; ++t) { const unsigned q = uu[t + j]; acc[t][0] += w0 * bf2f(q & 0xffff); acc[t][1] += w1 * bf2f(q >> 16); } }
    float mean[16], rstd[16];
    SYNC();
#pragma unroll
    for (int t = 0; t < 16; ++t) { float s = act ? acc[t][0] + acc[t][1] : 0.f;
#pragma unroll
        for (int o = 1; o < 64; o <<= 1) s += shflx(s, o);
        if (lane == 0) red[w * 16 + t] = s; }
    SYNC();
#pragma unroll
    for (int t = 0; t < 16; ++t) { float s = 0.f;
#pragma unroll
        for (int q = 0; q < 8; ++q) s += red[q * 16 + t];
        mean[t] = s * (1.0f / DM); }
    SYNC();
#pragma unroll
    for (int t = 0; t < 16; ++t) { const float d0 = acc[t][0] - mean[t], d1 = acc[t][1] - mean[t]; float s = act ? d0 * d0 + d1 * d1 : 0.f;
#pragma unroll
        for (int o = 1; o < 64; o <<= 1) s += shflx(s, o);
        if (lane == 0) red[w * 16 + t] = s; }
    SYNC();
#pragma unroll
    for (int t = 0; t < 16; ++t) { float s = 0.f;
#pragma unroll
        for (int q = 0; q < 8; ++q) s += red[q * 16 + t];
        rstd[t] = frsq(s * (1.0f / DM) + EPS); }
    if (act) {
        const float g0 = INP(a, I_LNG)[li * DM + c0], g1 = INP(a, I_LNG)[li * DM + c0 + 1], e0 = INP(a, I_LNB)[li * DM + c0], e1 = INP(a, I_LNB)[li * DM + c0 + 1];
        bf16* dst = (bf16*)(ws + WS_CAT) + (size_t)t0 * DM + c0;
#pragma unroll
        for (int t = 0; t < 16; ++t) { const float y0 = (acc[t][0] - mean[t]) * rstd[t] * g0 + e0, y1 = (acc[t][1] - mean[t]) * rstd[t] * g1 + e1;
            *(unsigned*)(dst + (size_t)t * DM) = pk2(siluf(y0), siluf(y1)); }
    }
}

constexpr int N_PHASES = 1 + 16 * (DEPTH / 2) + 1;
DEV void phase_decode(int ph, int& l, int& sub) {
    const int q = ph - 1, pair = q >> 4, r = q & 15;
    if (r < 9) { l = 2 * pair; sub = r; } else { l = 2 * pair + 1; const int rr = r - 9; sub = rr < 3 ? rr : rr + 2; }
}
constexpr int LDS_BYTES = 150 * 1024;

DEV void run_phase(const Args& a, unsigned char* smem, int ph) {
#ifndef ONLY
#define ONLY -1
#endif
#define EN(k) (ONLY < 0 || ONLY == (k))
    if (ph == 0) { if (EN(100)) p0_phase(a, smem); return; }
    if (ph == N_PHASES - 1) { if (EN(0)) norm_phase(a, smem, DEPTH); return; }
    int l, sub; phase_decode(ph, l, sub); const int li = l >> 1; const bool even = (l & 1) == 0;
    unsigned char* ws = wsp(a);
    switch (sub) {
    case 0: if (EN(0)) norm_phase(a, smem, l); break;
    case 1: if (even) { if (EN(1)) inproj_phase(a, smem, li); } else { if (EN(11)) pw1_phase(a, smem, li); } break;
    case 2:
        if (even) { constexpr int NCI = 8 * ((NCP + 255) / 256); constexpr int NH1 = 8 * NCH;
            if (NBLK > 2 * NCI) { const int bid = BID;
                if (bid < NCI) { if (EN(2)) cmp_phase_items(a, smem, li, bid); }
                else { for (int it = bid - NCI; it < NH1; it += NBLK - NCI) if (EN(12)) hg_h1_task(a, smem, it); } }
            else for (int it = BID; it < NCI + NH1; it += NBLK) { if (it < NCI) { if (EN(2)) cmp_phase_items(a, smem, li, it); } else { if (EN(12)) hg_h1_task(a, smem, it - NCI); } } }
        else { for (int it = BID; it < T / 16; it += NBLK) if (EN(13)) conv_task(a, smem, li, it); }
        break;
    case 3:
        if (even) { constexpr int NA = 4 * (SEQ / 64); const int G = NBLK;
            for (int r = 0; r * G < NA; ++r) { const int it = r * G + ((r & 1) ? (G - 1 - BID) : BID); if (it < NA) { if (EN(3)) attn_task(a, smem, li, it); } }
            for (int it = BID; it < 64; it += NBLK) if (EN(14)) hg_scan_task(a, it); }
        break;
    case 4: if (even) { for (int it = BID; it < 8 * NCH; it += NBLK) if (EN(4)) hg_h3_task(a, smem, li, it); } break;
    case 5:
        if (!EN(5)) break;
        if (even) resid_gemm_phase(a, smem, (const bf16*)(ws + WS_CAT), 1024, (const bf16*)(ws + WS_WOUT) + (size_t)li * DM * 1024, l);
        else resid_gemm_phase(a, smem, (const bf16*)(ws + WS_CAT), DM, (const bf16*)(ws + WS_PW2) + (size_t)li * DM * DM, l);
        break;
    case 6: if (EN(6)) route_phase(a, smem, l); break;
    case 7: if (EN(7)) moe_gemm_phase8(a, smem, l, 0); break;
    case 8: if (EN(8)) moe_gemm_phase8(a, smem, l, 1); break;
    }
}

#ifndef EMU
#define LAS __attribute__((address_space(3)))
#define XB_TMO      128
#define XB_XCNT(j)  (256  + 64 * (j))
#define XB_XSUB(j)  (1280 + 64 * (j))
#define XB_XGEN(j)  (2304 + 64 * (j))
#define XB_TOP      3328
#define XB_TOPGEN   3392
#define XCD_BAR_WORDS 3456
#define XB_SPIN_CAP (1u << 22)
__device__ __forceinline__ unsigned xb_ld(unsigned* p)              { return __hip_atomic_load(p, __ATOMIC_RELAXED, __HIP_MEMORY_SCOPE_AGENT); }
__device__ __forceinline__ unsigned xb_add(unsigned* p, unsigned v) { return __hip_atomic_fetch_add(p, v, __ATOMIC_RELAXED, __HIP_MEMORY_SCOPE_AGENT); }
__device__ __forceinline__ unsigned xb_xcc_id() { return (unsigned)__builtin_amdgcn_s_getreg((3 << 11) | 20) & 0xFu; }
#define XB_SPIN(cond, bar) do { unsigned _sp = 0; while (cond) { __builtin_amdgcn_s_sleep(1); \
    if ((++_sp & 255u) == 0u) { if (xb_ld(&(bar)[XB_TMO])) break; if (_sp > XB_SPIN_CAP) { atomicAdd(&(bar)[XB_TMO], 1u); break; } } } } while (0)
struct XcdBarrier { unsigned* bar; unsigned x; volatile LAS unsigned* st; };
__device__ __forceinline__ XcdBarrier xcd_barrier_post(unsigned* bar, volatile LAS unsigned* st) {
    XcdBarrier b; b.bar = bar; b.x = xb_xcc_id(); b.st = st;
    if (threadIdx.x == 0) (void)xb_add(&bar[XB_XCNT(b.x)], 1u);
    return b;
}
__device__ __forceinline__ void xcd_barrier_complete(unsigned* bar, unsigned x, unsigned& nloc, unsigned& nx) {
    const unsigned G = gridDim.x * gridDim.y * gridDim.z;
    unsigned sum, cnt, mine, sp = 0u;
    for (;;) {
        sum = 0u; cnt = 0u; mine = 0u;
#pragma unroll
        for (unsigned j = 0; j < 16; ++j) { const unsigned c = xb_ld(&bar[XB_XCNT(j)]); sum += c; cnt += (c > 0u) ? 1u : 0u; mine = (j == x) ? c : mine; }
        if (sum == G) break;
        __builtin_amdgcn_s_sleep(1);
        if ((++sp & 255u) == 0u) { if (xb_ld(&bar[XB_TMO])) break; if (sp > XB_SPIN_CAP) { atomicAdd(&bar[XB_TMO], 1u); break; } }
    }
    nloc = mine > 0u ? mine : 1u; nx = cnt > 0u ? cnt : 1u;
}
__device__ __forceinline__ void xcd_barrier(const XcdBarrier& b) {
    asm volatile("s_waitcnt vmcnt(0)" ::: "memory");
    __syncthreads();
    if (threadIdx.x == 0) {
        unsigned* bar = b.bar;
        __builtin_amdgcn_s_waitcnt(0);
        unsigned nloc = b.st[0], nx = b.st[1];
        if (nloc == 0u) { xcd_barrier_complete(bar, b.x, nloc, nx); b.st[0] = nloc; b.st[1] = nx; }
        const unsigned old = xb_add(&bar[XB_XSUB(b.x)], 1u);
        const unsigned gen = old / nloc;
        if (old + 1u == (gen + 1u) * nloc) {
            __builtin_amdgcn_fence(__ATOMIC_RELEASE, "agent");
            asm volatile("s_waitcnt vmcnt(0)" ::: "memory");
            const unsigned og = xb_add(&bar[XB_TOP], 1u);
            const unsigned tg = og / nx;
            if (og + 1u == (tg + 1u) * nx) xb_add(&bar[XB_TOPGEN], 1u);
            else XB_SPIN(xb_ld(&bar[XB_TOPGEN]) == tg, bar);
            __builtin_amdgcn_fence(__ATOMIC_ACQUIRE, "agent");
            xb_add(&bar[XB_XGEN(b.x)], 1u);
            asm volatile("s_waitcnt vmcnt(0)" ::: "memory");
        } else {
            XB_SPIN(xb_ld(&bar[XB_XGEN(b.x)]) == gen, bar);
            __builtin_amdgcn_fence(__ATOMIC_ACQUIRE, "agent");
            asm volatile("s_waitcnt vmcnt(0)" ::: "memory");
        }
    }
    __syncthreads();
}

__global__ void __launch_bounds__(NT, 2) mega(Args a) {
    extern __shared__ __attribute__((aligned(16))) unsigned char lds[];
    volatile LAS unsigned* st = (volatile LAS unsigned*)(LAS unsigned char*)(lds + LDS_BYTES - 16);
    if (threadIdx.x < 4) st[threadIdx.x] = 0u;
    __syncthreads();
    unsigned* barw = (unsigned*)(a.ws + WS_BAR);
    XcdBarrier bar = xcd_barrier_post(barw, st);
#pragma unroll 1
    for (int ph = 0; ph < N_PHASES; ++ph) {
        run_phase(a, lds, ph);
#ifdef DUP
        { int lyr = 0, sub = 100; if (ph > 0 && ph < N_PHASES - 1) phase_decode(ph, lyr, sub);
          if (sub == (DUP % 1000) && (ph == 0 || lyr == DUP / 1000) && ph < N_PHASES - 1) { xcd_barrier(bar); run_phase(a, lds, ph); } }
#endif
        if (ph + 1 < N_PHASES) xcd_barrier(bar);
    }
    if (xb_ld(&barw[XB_TMO]) != 0u) {
        const size_t gt = (size_t)blockIdx.x * NT + threadIdx.x, gs = (size_t)gridDim.x * NT;
        for (size_t i = gt; i < (size_t)T * DM; i += gs) a.out[i] = __builtin_nanf("");
    }
}

extern "C" void kernel_launch(void* const* d_in, const int* in_sizes, int n_in, void* d_out, int out_size,
                              void* d_ws, size_t ws_size, hipStream_t stream) {
    static int grid = 0;
    if (grid == 0) {
        int dev = 0, cus = 0;
        if (hipGetDevice(&dev) != hipSuccess || hipDeviceGetAttribute(&cus, hipDeviceAttributeMultiprocessorCount, dev) != hipSuccess) { grid = -1; return; }
        if (hipFuncSetAttribute((const void*)mega, hipFuncAttributeMaxDynamicSharedMemorySize, LDS_BYTES) != hipSuccess) { grid = -1; return; }
        (void)hipGetLastError();
        grid = cus;
        if (n_in != 26 || out_size != T * DM || ws_size < WS_END) { fprintf(stderr, "kernel_launch: unexpected sizes n_in %d out %d ws %zu (need %zu)\n", n_in, out_size, ws_size, (size_t)WS_END); grid = -1; return; }
    }
    if (grid < 0) return;
    (void)hipMemsetAsync((unsigned char*)d_ws + WS_BAR, 0, XCD_BAR_WORDS * 4, stream);
    Args a{};
    for (int i = 0; i < 26; ++i) a.in[i] = (const float*)d_in[i];
    a.out = (float*)d_out; a.ws = (unsigned char*)d_ws;
    hipLaunchKernelGGL(mega, dim3(grid), dim3(NT), LDS_BYTES, stream, a);
}
#endif
```

```cpp
#ifdef EMU
#include "emu.h"
#define DEV static inline
#define MDEV inline
#define OPAQUE(p)
#define OPAQUE2(a, b)
#define TID emu_tid()
#define BID (EB->bid)
#define NBLK (EB->nblk)
#define SYNC() emu_sync_block()
#define WSYNC() emu_sync_wave()
#define mfma16(a, b, c) emu_mfma16(a, b, c)
DEV float shflx(float v, int m) { return emu_shfl_f(v, (emu_tid() & 63) ^ m); }
DEV int shflxi(int v, int m) { return (int)emu_shfl_u((unsigned)v, (emu_tid() & 63) ^ m); }
DEV float shfl(float v, int s) { return emu_shfl_f(v, s); }
DEV float dpp_ror1(float v) { const int l = emu_tid() & 63; return emu_shfl_f(v, (l & 48) | ((l - 1) & 15)); }
DEV int atomic_add_i(int* p, int v) { return __atomic_fetch_add(p, v, __ATOMIC_RELAXED); }
DEV float fexp2(float x) { return exp2f(x); }
DEV float frcp(float x) { return 1.0f / x; }
DEV float frsq(float x) { return 1.0f / sqrtf(x); }
typedef short s16x4 __attribute__((vector_size(8)));
static inline s16x4 emu_tr4(const unsigned short* p) {
    EmuWave& w = EB->wave[emu_tid() >> 6]; int l = emu_tid() & 63;
    const unsigned short** tab = (const unsigned short**)w.a;
    tab[l] = p; emu_sync_wave();
    s16x4 r; int g = l & 48, i = l & 15;
    for (int q = 0; q < 4; ++q) r[q] = (short)tab[g + 4 * q + (i >> 2)][i & 3];
    emu_sync_wave(); return r;
}
#define tr4(p) emu_tr4(p)
#else
#include <hip/hip_runtime.h>
#include <cstdio>
#include <cstdint>
typedef short bf16x8 __attribute__((ext_vector_type(8)));
typedef float f32x4 __attribute__((ext_vector_type(4)));
typedef unsigned u32x4 __attribute__((ext_vector_type(4)));
typedef unsigned u32x2 __attribute__((ext_vector_type(2)));
#define DEV __device__ __forceinline__
#define MDEV __device__ __forceinline__
#define OPAQUE(p) asm volatile("" : "+v"(p))
#define OPAQUE2(a, b) asm volatile("" : "+v"(a), "+v"(b))
DEV int tid_opaque() { int t = (int)threadIdx.x; asm volatile("" : "+v"(t)); return t; }
#define TID tid_opaque()
DEV int bid_opaque() { int b = (int)blockIdx.x; asm volatile("" : "+s"(b)); return b; }
#define BID bid_opaque()
#define NBLK ((int)gridDim.x)
#define SYNC() __syncthreads()
#define WSYNC() __builtin_amdgcn_wave_barrier()
#define mfma16(a, b, c) __builtin_amdgcn_mfma_f32_16x16x32_bf16(a, b, c, 0, 0, 0)
DEV int shflxi(int x, int m) {
    if (m == 1) return __builtin_amdgcn_update_dpp(x, x, 0xB1, 0xf, 0xf, true);
    if (m == 2) return __builtin_amdgcn_update_dpp(x, x, 0x4E, 0xf, 0xf, true);
    if (m == 4) return __builtin_amdgcn_ds_swizzle(x, (4 << 10) | 0x1F);
    if (m == 8) return __builtin_amdgcn_ds_swizzle(x, (8 << 10) | 0x1F);
    if (m == 16) return __builtin_amdgcn_ds_swizzle(x, (16 << 10) | 0x1F);
    if (m == 32) { const auto r = __builtin_amdgcn_permlane32_swap((unsigned)x, (unsigned)x, false, false); return (int)((threadIdx.x & 32) ? r[0] : r[1]); }
    return __shfl_xor(x, m);
}
DEV float shflx(float v, int m) { return __builtin_bit_cast(float, shflxi(__builtin_bit_cast(int, v), m)); }
DEV float dpp_ror1(float v) { return __builtin_bit_cast(float, __builtin_amdgcn_update_dpp(0, __builtin_bit_cast(int, v), 0x121, 0xf, 0xf, false)); }
DEV float shfl(float v, int s) { return __shfl(v, s); }
DEV int atomic_add_i(int* p, int v) { return atomicAdd(p, v); }
DEV float fexp2(float x) { return __builtin_amdgcn_exp2f(x); }
DEV float frcp(float x) { return __builtin_amdgcn_rcpf(x); }
DEV float frsq(float x) { return __builtin_amdgcn_rsqf(x); }
typedef short s16x4 __attribute__((ext_vector_type(4)));
#define tr4(p) __builtin_amdgcn_ds_read_tr16_b64_v4i16((__attribute__((address_space(3))) s16x4*)(p))
#endif

typedef unsigned short bf16;

#ifndef DM
#define DM 1024
#endif
#ifndef SEQ
#define SEQ 8192
#endif
#ifndef FF
#define FF 512
#endif
constexpr int NBATCH = 2, T = NBATCH * SEQ, DEPTH = 4;
constexpr int NIN = 3352, NINP = 3456, NIN8 = 3584;
constexpr int NT = 512;
constexpr int NCH = SEQ / 64;
constexpr int NCP = SEQ / 16;
constexpr int NCMP = NCP - 1;
constexpr int MOE_ROWS = 2 * T + 32 * 256;
constexpr float EPS = 1e-6f, NEGV = -1e30f, FORCEV = 1e4f, LOG2E = 1.4426950408889634f;

constexpr size_t al(size_t x) { return (x + 255) & ~(size_t)255; }
constexpr size_t WS_BAR = 0;
constexpr size_t WS_CNT = 16384;
constexpr size_t WS_MOD = WS_CNT + (size_t)DEPTH * 32 * 256;
constexpr size_t WS_LB = al(WS_MOD + (size_t)DEPTH * 2 * 6 * DM * 4);
constexpr size_t WS_CB = al(WS_LB + 2 * 512 * 4);
constexpr size_t WS_CS = al(WS_CB + 2 * 2 * 8 * 64 * 4);
constexpr size_t WS_WIN = al(WS_CS + 64);
constexpr size_t WS_WOUT = al(WS_WIN + (size_t)2 * NIN8 * DM * 2);
constexpr size_t WS_PW1 = al(WS_WOUT + (size_t)2 * DM * 1024 * 2);
constexpr size_t WS_PW2 = al(WS_PW1 + (size_t)2 * 2 * DM * DM * 2);
constexpr size_t WS_WC = al(WS_PW2 + (size_t)2 * DM * DM * 2);
constexpr size_t WS_W13 = al(WS_WC + (size_t)2 * 2 * 64 * 2048 * 2);
constexpr size_t WS_W2 = al(WS_W13 + (size_t)DEPTH * 32 * 2 * FF * DM * 2);
constexpr size_t WS_H = al(WS_W2 + (size_t)DEPTH * 32 * DM * FF * 2);
constexpr size_t WS_QN = al(WS_H + (size_t)T * DM * 2);
constexpr size_t WS_KCG = al(WS_QN + (size_t)T * 512 * 2);
constexpr size_t WS_VCG = al(WS_KCG + (size_t)T * 128 * 2);
constexpr size_t WS_KS = al(WS_VCG + (size_t)T * 128 * 2);
constexpr size_t WS_KW = al(WS_KS + (size_t)T * 128 * 2);
constexpr size_t WS_VST = al(WS_KW + (size_t)T * 128 * 2);
constexpr size_t WS_VWT = al(WS_VST + (size_t)T * 128 * 2);
constexpr size_t WS_KC = al(WS_VWT + (size_t)T * 128 * 2);
constexpr size_t WS_VCT = al(WS_KC + (size_t)4 * NCP * 64 * 2);
constexpr size_t WS_GATE = al(WS_VCT + (size_t)4 * NCP * 64 * 2);
constexpr size_t WS_HQ = al(WS_GATE + (size_t)T * 24 * 4);
constexpr size_t WS_HF = al(WS_HQ + (size_t)T * 512 * 2);
constexpr size_t WS_HV = al(WS_HF + (size_t)T * 512 * 4);
constexpr size_t WS_HGS = al(WS_HV + (size_t)T * 512 * 2);
constexpr size_t WS_UT = al(WS_HGS + (size_t)T * 512 * 2);
constexpr size_t WS_ST = al(WS_UT + (size_t)8 * NCH * 128 * 128 * 4);
constexpr size_t WS_GD = al(WS_ST + (size_t)8 * NCH * 128 * 128 * 2);
constexpr size_t WS_CAT = al(WS_GD + (size_t)8 * NCH * 128 * 4);
constexpr size_t WS_GLU = al(WS_CAT + (size_t)T * 1024 * 2);
constexpr size_t WS_TIE = al(WS_GLU + (size_t)T * DM * 2);
constexpr size_t WS_TIW = al(WS_TIE + (size_t)T * 2 * 4);
constexpr size_t WS_LIST = al(WS_TIW + (size_t)T * 2 * 4);
constexpr size_t WS_ACT = al(WS_LIST + (size_t)32 * T * 4);
constexpr size_t WS_YK = al(WS_ACT + (size_t)MOE_ROWS * FF * 2);
constexpr size_t WS_WTH = al(WS_YK + (size_t)MOE_ROWS * DM * 2);
constexpr size_t WS_WTL = al(WS_WTH + (size_t)DEPTH * 48 * DM * 2);
constexpr size_t WS_AVEC = al(WS_WTL + (size_t)DEPTH * 48 * DM * 2);
constexpr size_t WS_RBIAS = al(WS_AVEC + (size_t)DEPTH * 2 * DM * 4);
constexpr size_t WS_FLG = al(WS_RBIAS + (size_t)DEPTH * 2 * 48 * 4);
constexpr size_t WS_END = al(WS_FLG + (size_t)DEPTH * 256 * 64);

struct Args { const float* in[26]; float* out; unsigned char* ws; };
enum { I_X = 0, I_C, I_ADAW, I_ADAB, I_NMIX, I_NFFN, I_WIN, I_WOUT, I_CWK, I_CWV, I_CPE, I_QG, I_KG, I_LBL, I_OG,
       I_PW1, I_DW, I_DWB, I_LNG, I_LNB, I_PW2, I_WG, I_WE, I_W1, I_W3, I_W2 };

#ifdef EMU
DEV unsigned char* wsp(const Args& a) { return a.ws; }
DEV float* outp(const Args& a) { return a.out; }
#else
DEV unsigned char* launder_ptr(const void* p) { unsigned long long v = (unsigned long long)p; unsigned lo = (unsigned)v, hi = (unsigned)(v >> 32);
    lo = (unsigned)__builtin_amdgcn_readfirstlane((int)lo); hi = (unsigned)__builtin_amdgcn_readfirstlane((int)hi); asm volatile("" : "+s"(lo), "+s"(hi)); typedef __attribute__((address_space(1))) unsigned char* gptr_t; return (unsigned char*)(gptr_t)(((unsigned long long)hi << 32) | lo); }
DEV unsigned char* wsp(const Args& a) { return launder_ptr(a.ws); }
DEV float* outp(const Args& a) { return (float*)launder_ptr(a.out); }
#endif

#ifdef EMU
#define INP(a, X) ((a).in[X])
#else
DEV int zero_opaque() { int z = 0; asm volatile("" : "+s"(z)); return z; }
#define INP(a, X) ((a).in[(X) + zero_opaque()])
#endif

DEV unsigned f2bf(float f) { unsigned u = __builtin_bit_cast(unsigned, f); return (u + 0x7fffu + ((u >> 16) & 1u)) >> 16; }
DEV float bf2f(unsigned h) { return __builtin_bit_cast(float, h << 16); }
#ifdef EMU
DEV unsigned pk2(float lo, float hi) { return f2bf(lo) | (f2bf(hi) << 16); }
#else
typedef float f32x2_t __attribute__((ext_vector_type(2)));
typedef __bf16 bf16x2_t __attribute__((ext_vector_type(2)));
DEV unsigned pk2(float lo, float hi) { f32x2_t v = {lo, hi}; bf16x2_t b = __builtin_convertvector(v, bf16x2_t); return __builtin_bit_cast(unsigned, b); }
#endif
DEV float sigm(float x) { return frcp(1.0f + fexp2(-x * LOG2E)); }
DEV float siluf(float x) { return x * sigm(x); }
DEV f32x4 f4zero() { f32x4 z = {0.f, 0.f, 0.f, 0.f}; return z; }
DEV bf16x8 pack8(f32x4 a, f32x4 b) {
    u32x4 w; w[0] = pk2(a[0], a[1]); w[1] = pk2(a[2], a[3]); w[2] = pk2(b[0], b[1]); w[3] = pk2(b[2], b[3]);
    return __builtin_bit_cast(bf16x8, w);
}
DEV void st_bf8(bf16* p, f32x4 a, f32x4 b) { u32x4 w; w[0] = pk2(a[0], a[1]); w[1] = pk2(a[2], a[3]); w[2] = pk2(b[0], b[1]); w[3] = pk2(b[2], b[3]); *(u32x4*)p = w; }
DEV void st_bf4(bf16* p, f32x4 v) { u32x2 w; w[0] = pk2(v[0], v[1]); w[1] = pk2(v[2], v[3]); *(u32x2*)p = w; }


#ifdef EMU
namespace pg8 {
constexpr int BM = 256, BK = 64, HALF = 128, NXCD = 8, WGM = 8;
typedef unsigned short bf16_t;
struct Unit { int pm, pn; };
struct Gemm { const bf16_t* A; const bf16_t* Bt; int M, N, K; };
struct StaticOrder {
    int nM, nN, nwg, G, c;
    void init(int M, int N, int G_, int c_) { nM = M / BM; nN = N / BM; nwg = nM * nN; G = G_; c = c_; }
    bool next(int i, Unit& u) const {
        const long L = (long)i * G + c; if (L >= nwg) return false;
        int wgid = (int)L; { const int q = nwg / NXCD, r = nwg % NXCD, xcd = wgid % NXCD, off = wgid / NXCD; wgid = (xcd < r ? xcd * (q + 1) : r * (q + 1) + (xcd - r) * q) + off; }
        const int nig = WGM * nN, gid = wgid / nig, fm = gid * WGM, gsz = (nM - fm) < WGM ? (nM - fm) : WGM;
        u.pm = fm + ((wgid % nig) % gsz); u.pn = (wgid % nig) / gsz; return true;
    }
};
struct SelNone { static constexpr bool GATHER = false; struct Ctx {}; Ctx ctx(const Unit&) const { return Ctx(); } size_t boff(const Ctx&) const { return 0; } unsigned aoff(const Ctx&, int) const { return 0u; } };
template <class Epi, class Sched, bool ALIGN_EPI = false, bool SP2 = false, class Sel = SelNone>
static inline void gemm_phase(unsigned char*, const Gemm g, const Sched& S, const Epi& E, const Sel& X = Sel()) {
    const int tid = emu_tid(), wid = tid >> 6, lane = tid & 63, wr = wid >> 2, wc = wid & 3, fr = lane & 15, fq = lane >> 4;
    Unit u;
    for (int ui = 0; S.next(ui, u); ++ui) {
        f32x4 acc[2][2][4][2]; const auto cx = X.ctx(u);
        for (int ai = 0; ai < 2; ++ai) for (int bj = 0; bj < 2; ++bj) for (int m = 0; m < 4; ++m) for (int n = 0; n < 2; ++n) for (int r = 0; r < 4; ++r) {
            const int row = 256 * u.pm + 128 * ai + 64 * wr + 16 * m + fr, col = 256 * u.pn + 128 * bj + 32 * wc + (Epi::PERM ? 8 * fq + 4 * n + r : 16 * n + 4 * fq + r); float sum = 0.f;
            const bf16_t* ap = Sel::GATHER ? (const bf16_t*)((const char*)g.A + X.aoff(cx, row - 256 * u.pm)) : g.A + (size_t)row * g.K; const bf16_t* bp = (const bf16_t*)((const char*)g.Bt + X.boff(cx)) + (size_t)col * g.K;
            for (int k = 0; k < g.K; ++k) sum += bf2f(ap[k]) * bf2f(bp[k]);
            acc[ai][bj][m][n][r] = sum; }
        E(acc, u, wr, wc, fr, fq);
    }
    emu_sync_block();
}
}
#else
namespace pg8 {
#define PG8_LAS __attribute__((address_space(3)))
typedef unsigned short bf16_t;
typedef short bf16x8 __attribute__((ext_vector_type(8)));
typedef float f32x4 __attribute__((ext_vector_type(4)));
typedef unsigned u32x4 __attribute__((ext_vector_type(4)));
constexpr int BM = 256, BK = 64, HALF = 128, HTB = HALF * BK * 2  , STAGE_BYTES = 8 * HTB, NXCD = 8, WGM = 8;

__host__ __device__ __forceinline__ int lds_byte(int r, int c) { const int st = (r >> 4) * 2 + (c >> 5), rr = r & 15, cc = c & 31, ob = rr * 64 + cc * 2; return st * 1024 + (ob ^ (((ob >> 9) & 1) << 5)); }
__host__ __device__ __forceinline__ void stage_rc(int b, int& R, int& C) { const int st = b / 1024, sb = b % 1024, swz = sb ^ (((sb >> 9) & 1) << 5); R = (st >> 1) * 16 + swz / 64; C = (st & 1) * 32 + (swz % 64) / 2; }
__host__ __device__ __forceinline__ int perm32(int rho) { const int n = rho >> 4, i = rho & 15; return 8 * (i >> 2) + 4 * n + (i & 3); }

struct Unit { int pm, pn; };
struct Gemm { const bf16_t* A; const bf16_t* Bt; int M, N, K; };

struct StaticOrder {
    int nM, nN, nwg, G, c;
    __host__ __device__ void init(int M, int N, int G_, int c_) { nM = M / BM; nN = N / BM; nwg = nM * nN; G = G_; c = c_; }
    __host__ __device__ bool next(int i, Unit& u) const {
        const long L = (long)i * G + c; if (L >= nwg) return false;
        int wgid = (int)L; { const int q = nwg / NXCD, r = nwg % NXCD, xcd = wgid % NXCD, off = wgid / NXCD; wgid = (xcd < r ? xcd * (q + 1) : r * (q + 1) + (xcd - r) * q) + off; }
        const int nig = WGM * nN, gid = wgid / nig, fm = gid * WGM, gsz = (nM - fm) < WGM ? (nM - fm) : WGM;
        u.pm = fm + ((wgid % nig) % gsz); u.pn = (wgid % nig) / gsz; return true;
    }
    __device__ __forceinline__ void a_ready(const Unit&) const {}
    __device__ __forceinline__ void done(const Unit&) const {}
};

__device__ __forceinline__ unsigned cvt_pk_bf16(float lo, float hi) { unsigned r; asm volatile("v_cvt_pk_bf16_f32 %0, %1, %2" : "=v"(r) : "v"(lo), "v"(hi)); return r; }
struct SelNone { static constexpr bool GATHER = false; struct Ctx {}; __device__ __forceinline__ Ctx ctx(const Unit&) const { return Ctx(); } __device__ __forceinline__ size_t boff(const Ctx&) const { return 0; } __device__ __forceinline__ unsigned aoff(const Ctx&, int) const { return 0u; } };
template <class Epi, class Sched, bool ALIGN_EPI = false, bool SP2 = false, class Sel = SelNone>
__device__ __forceinline__ void gemm_phase(PG8_LAS unsigned char* lds, const Gemm g, const Sched& S, const Epi& E, const Sel& X = Sel()) {
    constexpr bool GA = Sel::GATHER;
    const int tid = TID, wid = __builtin_amdgcn_readfirstlane(tid >> 6), lane = tid & 63, wr = wid >> 2, wc = wid & 3, fr = lane & 15, fq = lane >> 4;
    const int K = g.K, nt = K / BK;
    unsigned voffA[2], voffB[2]; int Rl[2]; unsigned Cl2[2];
#pragma unroll
    for (int i = 0; i < 2; ++i) { int R, C; stage_rc(tid * 16 + i * 8192, R, C); const int Rb = Epi::PERM ? ((R & ~31) + perm32(R & 31)) : R;
        voffA[i] = (unsigned)(R * K + C) * 2u; voffB[i] = (unsigned)(Rb * K + C) * 2u; Rl[i] = R; Cl2[i] = (unsigned)C * 2u; }
    unsigned vA[2][2], vAn[2][2];
    const size_t kstep = (size_t)(BK * 2);
    const size_t hstep = (size_t)HALF * K * 2;
    const size_t tstep = 2 * hstep;
    const unsigned ldsw = (unsigned)wid * 1024u;
    const int aoff = lds_byte(wr * 64 + fr, fq * 8), boff = lds_byte(wc * 32 + fr, fq * 8);
#define PG8_SA(b, h) (((b) * 2 + (h)) * HTB)
#define PG8_SB(b, h) ((4 + (b) * 2 + (h)) * HTB)
#define PG8_STAGE(bufoff, gbase, voff) do { _Pragma("unroll") for (int _i = 0; _i < 2; ++_i) \
        __builtin_amdgcn_global_load_lds((const unsigned*)((const char*)(gbase) + (voff)[_i]), (PG8_LAS unsigned*)(lds + (bufoff) + ldsw + _i * 8192), 16, 0, 0); } while (0)
#define PG8_STAGE_A(bufoff, p, h, nx) do { if constexpr (GA) { unsigned _vo[2] = {(nx) ? vAn[h][0] : vA[h][0], (nx) ? vAn[h][1] : vA[h][1]}; PG8_STAGE(bufoff, p, _vo); } else { PG8_STAGE(bufoff, (p) + (h) * hstep, voffA); } } while (0)
#define PG8_GATH(cx, dst) do { _Pragma("unroll") for (int _h = 0; _h < 2; ++_h) _Pragma("unroll") for (int _i = 0; _i < 2; ++_i) dst[_h][_i] = X.aoff(cx, 128 * _h + Rl[_i]) + Cl2[_i]; } while (0)
#define PG8_LDA(dst, b, h) do { _Pragma("unroll") for (int m = 0; m < 4; ++m) _Pragma("unroll") for (int k = 0; k < 2; ++k) dst[m][k] = *(const PG8_LAS bf16x8*)(lds + PG8_SA(b, h) + aoff + m * 2048 + k * 1024); } while (0)
#define PG8_LDB(dst, b, h) do { _Pragma("unroll") for (int n = 0; n < 2; ++n) _Pragma("unroll") for (int k = 0; k < 2; ++k) dst[n][k] = *(const PG8_LAS bf16x8*)(lds + PG8_SB(b, h) + boff + n * 2048 + k * 1024); } while (0)
#define PG8_MMA(ai, bj, At, Bt) do { __builtin_amdgcn_s_setprio(1); _Pragma("unroll") for (int m = 0; m < 4; ++m) _Pragma("unroll") for (int n = 0; n < 2; ++n) _Pragma("unroll") for (int k = 0; k < 2; ++k) \
        acc[ai][bj][m][n] = __builtin_amdgcn_mfma_f32_16x16x32_bf16(Bt[n][k], At[m][k], acc[ai][bj][m][n], 0, 0, 0); __builtin_amdgcn_s_setprio(0); } while (0)
#define PG8_WAIT_V(n) asm volatile("s_waitcnt vmcnt(" #n ")" ::: "memory")
#define PG8_WAIT_L(n) asm volatile("s_waitcnt lgkmcnt(" #n ")" ::: "memory")
#define PG8_BAR __builtin_amdgcn_s_barrier()
#define PG8_SCHED __builtin_amdgcn_sched_barrier(0)
    Unit cur, nxt; int ui = 0;
    if (!S.next(0, cur)) return;
    f32x4 acc[2][2][4][2];
#pragma unroll
    for (int a = 0; a < 2; ++a)
#pragma unroll
        for (int b = 0; b < 2; ++b)
#pragma unroll
            for (int m = 0; m < 4; ++m)
#pragma unroll
                for (int n = 0; n < 2; ++n) acc[a][b][m][n] = (f32x4){0.f, 0.f, 0.f, 0.f};
    bf16x8 At[4][2], B0[2][2], B1[2][2];
    auto ccx = X.ctx(cur);
    const char* cA = GA ? (const char*)g.A : (const char*)g.A + (size_t)cur.pm * tstep; const char* cB = (const char*)g.Bt + X.boff(ccx) + (size_t)cur.pn * tstep;
    if constexpr (GA) { PG8_GATH(ccx, vA); }
    S.a_ready(cur);
    if constexpr (SP2) {
        PG8_STAGE(PG8_SB(0, 0), cB, voffB); PG8_STAGE(PG8_SB(0, 1), cB + hstep, voffB); PG8_STAGE_A(PG8_SA(0, 0), cA, 0, false); PG8_STAGE_A(PG8_SA(0, 1), cA, 1, false);
        if (wr == 1) PG8_BAR;
        PG8_WAIT_V(2); PG8_BAR;
        PG8_STAGE(PG8_SB(1, 0), cB + kstep, voffB); PG8_STAGE_A(PG8_SA(1, 0), cA + kstep, 0, false); PG8_STAGE(PG8_SB(1, 1), cB + hstep + kstep, voffB);
        PG8_WAIT_V(6); PG8_BAR;
    } else {
        PG8_STAGE(PG8_SB(0, 0), cB, voffB); PG8_STAGE_A(PG8_SA(0, 0), cA, 0, false); PG8_STAGE(PG8_SB(0, 1), cB + hstep, voffB); PG8_STAGE_A(PG8_SA(0, 1), cA, 1, false);
        if (wr == 1) PG8_BAR;
        PG8_WAIT_V(4); PG8_BAR;
        PG8_STAGE(PG8_SB(1, 0), cB + kstep, voffB); PG8_STAGE_A(PG8_SA(1, 0), cA + kstep, 0, false); PG8_STAGE(PG8_SB(1, 1), cB + hstep + kstep, voffB);
        PG8_WAIT_V(6); PG8_BAR;
    }
    for (;;) {
        const bool has_next = S.next(ui + 1, nxt);
        const char* nA = cA; const char* nB = cB;
        if (has_next) { const auto ncx = X.ctx(nxt); nA = GA ? (const char*)g.A : (const char*)g.A + (size_t)nxt.pm * tstep; nB = (const char*)g.Bt + X.boff(ncx) + (size_t)nxt.pn * tstep; if constexpr (GA) { PG8_GATH(ncx, vAn); } }
        else if constexpr (GA) {
#pragma unroll
            for (int _h = 0; _h < 2; ++_h) { vAn[_h][0] = vA[_h][0]; vAn[_h][1] = vA[_h][1]; } }
        for (int t = 0; t < nt; t += 2) {
            const bool last = (t == nt - 2);
            const char* a1 = cA + (size_t)(t + 1) * kstep;
            const char* a2 = last ? nA : cA + (size_t)(t + 2) * kstep; const char* b2 = last ? nB : cB + (size_t)(t + 2) * kstep;
            const char* a3 = a2 + kstep; const char* b3 = b2 + kstep;
            if (last && has_next) S.a_ready(nxt);
            if constexpr (SP2) {
            PG8_LDB(B0, 0, 0); PG8_LDB(B1, 0, 1); PG8_SCHED; PG8_LDA(At, 0, 0); PG8_STAGE_A(PG8_SA(1, 1), a1, 1, false);
            PG8_WAIT_V(8); PG8_WAIT_L(0); PG8_BAR; PG8_MMA(0, 0, At, B0); PG8_MMA(0, 1, At, B1); PG8_BAR; PG8_SCHED;
            PG8_LDA(At, 0, 1); PG8_STAGE(PG8_SB(0, 0), b2, voffB); PG8_STAGE(PG8_SB(0, 1), b2 + hstep, voffB); PG8_STAGE_A(PG8_SA(0, 0), a2, 0, last);
            PG8_WAIT_V(8); PG8_WAIT_L(0); PG8_BAR; PG8_MMA(1, 0, At, B0); PG8_MMA(1, 1, At, B1); PG8_BAR; PG8_SCHED;
            PG8_LDB(B0, 1, 0); PG8_LDB(B1, 1, 1); PG8_SCHED; PG8_LDA(At, 1, 0); PG8_STAGE_A(PG8_SA(0, 1), a2, 1, last);
            PG8_WAIT_V(8); PG8_WAIT_L(0); PG8_BAR; PG8_MMA(0, 0, At, B0); PG8_MMA(0, 1, At, B1); PG8_BAR; PG8_SCHED;
            PG8_LDA(At, 1, 1); PG8_STAGE(PG8_SB(1, 0), b3, voffB); PG8_STAGE(PG8_SB(1, 1), b3 + hstep, voffB); PG8_STAGE_A(PG8_SA(1, 0), a3, 0, last);
            PG8_WAIT_V(8); PG8_WAIT_L(0); PG8_BAR; PG8_MMA(1, 0, At, B0); PG8_MMA(1, 1, At, B1); PG8_BAR; PG8_SCHED;
            } else {
            PG8_LDB(B0, 0, 0); PG8_SCHED; PG8_LDA(At, 0, 0); PG8_STAGE_A(PG8_SA(1, 1), a1, 1, false);
            PG8_WAIT_L(8); PG8_BAR; PG8_WAIT_L(0); PG8_MMA(0, 0, At, B0); PG8_BAR; PG8_SCHED;
            PG8_LDB(B1, 0, 1); PG8_STAGE(PG8_SB(0, 0), b2, voffB);
            PG8_BAR; PG8_WAIT_L(0); PG8_MMA(0, 1, At, B1); PG8_BAR;
            PG8_LDA(At, 0, 1); PG8_STAGE_A(PG8_SA(0, 0), a2, 0, last);
            PG8_BAR; PG8_WAIT_L(0); PG8_MMA(1, 0, At, B0); PG8_BAR; PG8_SCHED;
            PG8_STAGE(PG8_SB(0, 1), b2 + hstep, voffB);
            PG8_WAIT_V(6); PG8_BAR; PG8_MMA(1, 1, At, B1); PG8_BAR;
            PG8_LDB(B0, 1, 0); PG8_SCHED; PG8_LDA(At, 1, 0); PG8_STAGE_A(PG8_SA(0, 1), a2, 1, last);
            PG8_WAIT_L(8); PG8_BAR; PG8_WAIT_L(0); PG8_MMA(0, 0, At, B0); PG8_BAR; PG8_SCHED;
            PG8_LDB(B1, 1, 1); PG8_STAGE(PG8_SB(1, 0), b3, voffB);
            PG8_BAR; PG8_WAIT_L(0); PG8_MMA(0, 1, At, B1); PG8_BAR;
            PG8_LDA(At, 1, 1); PG8_STAGE_A(PG8_SA(1, 0), a3, 0, last);
            PG8_BAR; PG8_WAIT_L(0); PG8_MMA(1, 0, At, B0); PG8_BAR; PG8_SCHED;
            PG8_STAGE(PG8_SB(1, 1), b3 + hstep, voffB);
            PG8_WAIT_V(6); PG8_BAR; PG8_MMA(1, 1, At, B1); PG8_BAR;
            }
        }
        if constexpr (ALIGN_EPI) { if (wr == 0) PG8_BAR; }
        if constexpr (!Epi::AFTER_DRAIN) { E(acc, cur, wr, wc, fr, fq); S.done(cur); }
        if (!has_next) break;
#pragma unroll
        for (int a = 0; a < 2; ++a)
#pragma unroll
            for (int b = 0; b < 2; ++b)
#pragma unroll
                for (int m = 0; m < 4; ++m)
#pragma unroll
                    for (int n = 0; n < 2; ++n) acc[a][b][m][n] = (f32x4){0.f, 0.f, 0.f, 0.f};
        cur = nxt; cA = nA; cB = nB; ++ui;
        if constexpr (GA) {
#pragma unroll
            for (int _h = 0; _h < 2; ++_h) { vA[_h][0] = vAn[_h][0]; vA[_h][1] = vAn[_h][1]; } }
        if constexpr (ALIGN_EPI) { if (wr == 1) PG8_BAR; }
    }
    PG8_WAIT_V(0);
    if constexpr (!ALIGN_EPI) { if (wr == 0) PG8_BAR; }
    PG8_BAR;
    if constexpr (Epi::AFTER_DRAIN) { E.fused(acc, cur, wr, wc, fr, fq, lds, wid, lane); S.done(cur); }
#undef PG8_SA
#undef PG8_SB
#undef PG8_STAGE
#undef PG8_STAGE_A
#undef PG8_GATH
#undef PG8_LDA
#undef PG8_LDB
#undef PG8_MMA
#undef PG8_WAIT_V
#undef PG8_WAIT_L
#undef PG8_BAR
#undef PG8_SCHED
}
}
#endif

constexpr int LDT = 72;
constexpr int GEMM_AS = 256 * LDT, GEMM_BS = 128 * LDT;
constexpr int GEMM_LDS = 2 * (GEMM_AS + GEMM_BS) * 2;

template <class AF, class EPI>
DEV void gemm_tile(unsigned char* smem, AF af, const bf16* Bt, int ldb, int nvalid, int K, EPI& epi) {
    const int tid = TID, w = tid >> 6, l = tid & 63, h = l >> 4, c = l & 15, wm = w >> 1, wn = w & 1;
    bf16* As = (bf16*)smem; bf16* Bs = As + 2 * GEMM_AS;
    const bf16* ap[4]; const bf16* bp[2];
    const int col8 = (tid & 7) * 8, r0 = tid >> 3;
#pragma unroll
    for (int i = 0; i < 4; ++i) ap[i] = af(r0 + 64 * i) + col8;
#pragma unroll
    for (int i = 0; i < 2; ++i) { int rn = r0 + 64 * i; if (rn >= nvalid) rn = nvalid - 1; bp[i] = Bt + (size_t)rn * ldb + col8; }
    f32x4 acc[4][4];
#pragma unroll
    for (int i = 0; i < 4; ++i)
#pragma unroll
        for (int j = 0; j < 4; ++j) acc[i][j] = f4zero();
    bf16x8 ra[4], rb[2];
#pragma unroll
    for (int i = 0; i < 4; ++i) ra[i] = *(const bf16x8*)(ap[i]);
#pragma unroll
    for (int i = 0; i < 2; ++i) rb[i] = *(const bf16x8*)(bp[i]);
    SYNC();
#pragma unroll
    for (int i = 0; i < 4; ++i) *(bf16x8*)(As + (r0 + 64 * i) * LDT + col8) = ra[i];
#pragma unroll
    for (int i = 0; i < 2; ++i) *(bf16x8*)(Bs + (r0 + 64 * i) * LDT + col8) = rb[i];
    SYNC();
    const int nk = K / 64;
    for (int kt = 0; kt < nk; ++kt) {
        const int cur = kt & 1;
        if (kt + 1 < nk) {
#pragma unroll
            for (int i = 0; i < 4; ++i) ra[i] = *(const bf16x8*)(ap[i] + (kt + 1) * 64);
#pragma unroll
            for (int i = 0; i < 2; ++i) rb[i] = *(const bf16x8*)(bp[i] + (kt + 1) * 64);
        }
        const bf16* Ac = As + cur * GEMM_AS + (wm * 64 + c) * LDT + 8 * h;
        const bf16* Bc = Bs + cur * GEMM_BS + (wn * 64 + c) * LDT + 8 * h;
#pragma unroll
        for (int kk = 0; kk < 2; ++kk) {
            bf16x8 fa[4], fb[4];
#pragma unroll
            for (int i = 0; i < 4; ++i) { fa[i] = *(const bf16x8*)(Ac + i * 16 * LDT + kk * 32); fb[i] = *(const bf16x8*)(Bc + i * 16 * LDT + kk * 32); }
#pragma unroll
            for (int ni = 0; ni < 4; ++ni)
#pragma unroll
                for (int mi = 0; mi < 4; ++mi) acc[ni][mi] = mfma16(fb[ni], fa[mi], acc[ni][mi]);
        }
        if (kt + 1 < nk) {
            const int nx = cur ^ 1;
#pragma unroll
            for (int i = 0; i < 4; ++i) *(bf16x8*)(As + nx * GEMM_AS + (r0 + 64 * i) * LDT + col8) = ra[i];
#pragma unroll
            for (int i = 0; i < 2; ++i) *(bf16x8*)(Bs + nx * GEMM_BS + (r0 + 64 * i) * LDT + col8) = rb[i];
        }
        SYNC();
    }
    epi(acc, wm * 64, wn * 64, h, c);
}

struct ARows { const bf16* base; size_t ld; MDEV const bf16* operator()(int r) const { return base + (size_t)r * ld; } MDEV unsigned off(int r) const { return (unsigned)r * (unsigned)ld; } };

constexpr int LDB = 144;
constexpr int GEMM_BS2 = 64 * LDB;
constexpr int GEMM2_LDS = (2 * GEMM_AS + 2 * GEMM_BS2) * 2;
DEV bf16x8 tr_read8(const bf16* p0, const bf16* p1) {
    const s16x4 x = tr4(p0), y = tr4(p1); bf16x8 r;
    r[0] = x[0]; r[1] = x[1]; r[2] = x[2]; r[3] = x[3]; r[4] = y[0]; r[5] = y[1]; r[6] = y[2]; r[7] = y[3]; return r;
}
DEV int bperm(int r) { return (r & ~12) | ((r & 4) << 1) | ((r & 8) >> 1); }
template <class AF, class BF, class EPI>
DEV void gemm_tile2(unsigned char* smem, AF af, BF bf, int ldb, int K, EPI& epi) {
    const int tid = TID, w = tid >> 6, l = tid & 63, h = l >> 4, c = l & 15, wm = w >> 1, wn = w & 1, grp = w >> 2;
    bf16* As = (bf16*)smem; bf16* Bs = As + 2 * GEMM_AS;
    const bf16* abase = af.base; unsigned ao[4];
    const int col8 = (tid & 7) * 8, r0 = tid >> 3;
#pragma unroll
    for (int i = 0; i < 4; ++i) ao[i] = af.off(r0 + 64 * i) + col8;
    const int bn4 = (tid & 31) * 4, bk = tid >> 5, bkp = bperm(bk);
    const float* bp = bf(bn4); const bool bok = bp != nullptr;
    if (bok) bp += (size_t)bk * ldb;
    const size_t bstep = (size_t)16 * ldb;
    f32x4 acc[4][4];
#pragma unroll
    for (int i = 0; i < 4; ++i)
#pragma unroll
        for (int j = 0; j < 4; ++j) acc[i][j] = f4zero();
    bf16x8 ra[4]; f32x4 rb[4];
    const int nk = K / 64;
#pragma unroll
    for (int i = 0; i < 4; ++i) { ra[i] = *(const bf16x8*)(abase + ao[i]); rb[i] = bok ? *(const f32x4*)(bp + i * bstep) : f4zero(); }
    SYNC();
#pragma unroll
    for (int i = 0; i < 4; ++i) { *(bf16x8*)(As + (r0 + 64 * i) * LDT + col8) = ra[i]; st_bf4(Bs + (bkp + 16 * i) * LDB + bn4, rb[i]); }
    if (nk > 1) {
#pragma unroll
        for (int i = 0; i < 4; ++i) { ra[i] = *(const bf16x8*)(abase + (ao[i] + 64)); rb[i] = bok ? *(const f32x4*)(bp + (size_t)64 * ldb + i * bstep) : f4zero(); } }
    SYNC();
    for (int kt = 0; kt < nk; ++kt) {
        const int cur = kt & 1;
#pragma unroll
        for (int p = 0; p < 2; ++p) {
            if (grp == p) {
                const bf16* Ac = As + cur * GEMM_AS + (wm * 64 + c) * LDT + 8 * h;
                const bf16* Bc = Bs + cur * GEMM_BS2 + bperm(8 * h + (c >> 2)) * LDB + wn * 64 + 4 * (c & 3);
#pragma unroll
                for (int kk = 0; kk < 2; ++kk) {
                    bf16x8 fa[4], fb[4];
#pragma unroll
                    for (int i = 0; i < 4; ++i) { fa[i] = *(const bf16x8*)(Ac + i * 16 * LDT + kk * 32); fb[i] = tr_read8(Bc + (32 * kk) * LDB + 16 * i, Bc + (32 * kk + 8) * LDB + 16 * i); }
#pragma unroll
                    for (int ni = 0; ni < 4; ++ni)
#pragma unroll
                        for (int mi = 0; mi < 4; ++mi) acc[ni][mi] = mfma16(fb[ni], fa[mi], acc[ni][mi]);
                }
            } else if (kt + 1 < nk) {
                const int nx = cur ^ 1;
#pragma unroll
                for (int i = 0; i < 4; ++i) { *(bf16x8*)(As + nx * GEMM_AS + (r0 + 64 * i) * LDT + col8) = ra[i]; st_bf4(Bs + nx * GEMM_BS2 + (bkp + 16 * i) * LDB + bn4, rb[i]); }
                if (kt + 2 < nk) {
#pragma unroll
                    for (int i = 0; i < 4; ++i) { ra[i] = *(const bf16x8*)(abase + (ao[i] + (kt + 2) * 64)); rb[i] = bok ? *(const f32x4*)(bp + (size_t)(kt + 2) * 64 * ldb + i * bstep) : f4zero(); } }
            }
            SYNC();
        }
    }
    epi(acc, wm * 64, wn * 64, h, c);
}
struct BPlain { const float* base; MDEV const float* operator()(int nt) const { return base + nt; } };
struct BInProjMap { const float* base; int n0; MDEV const float* operator()(int nt) const { const int n = n0 + nt; const int sc = n < 1280 ? n : (n < 3328 ? n + 24 : (n < 3352 ? 1280 + (n - 3328) : -1)); return sc < 0 ? nullptr : base + sc; } };
struct BInter { const float* s0; const float* s1; int n0; MDEV const float* operator()(int nt) const { const int n = n0 + nt, g = n >> 6, w = n & 63; return w < 32 ? s0 + g * 32 + w : s1 + g * 32 + w - 32; } };
struct BClamp64 { const float* base; MDEV const float* operator()(int nt) const { return base + (nt & 63); } };

struct EpiInProj {
    const Args* a; int m0, n0, li;
    MDEV void operator()(f32x4 (&acc)[4][4], int mw, int nw, int h, int c) const {
        unsigned char* ws = wsp(*a);
        const int nb = n0 + nw;
        const int tokb = m0 + mw + c;
        if (nb < 512 || (nb >= 768 && nb < 896) || (nb >= 1024 && nb < 1152)) {
            const float* gain; float mul = 1.f; bf16* dst; int kind;
            if (nb < 512) { gain = INP(*a, I_QG) + li * 64; mul = 0.125f * LOG2E; kind = 0; dst = (bf16*)(ws + WS_QN); }
            else if (nb < 896) { gain = INP(*a, I_KG) + (li * 3 + 1) * 64; kind = 1; dst = (bf16*)(ws + WS_KS); }
            else { gain = INP(*a, I_KG) + (li * 3 + 2) * 64; kind = 1; dst = (bf16*)(ws + WS_KW); }
            const int g = (nb >> 6) & 1;
#pragma unroll
            for (int mi = 0; mi < 4; ++mi) {
                float ss = 0.f;
#pragma unroll
                for (int ni = 0; ni < 4; ++ni) { f32x4 v = acc[ni][mi]; ss += v[0] * v[0] + v[1] * v[1] + v[2] * v[2] + v[3] * v[3]; }
                ss += shflx(ss, 16); ss += shflx(ss, 32);
                const float rs = frsq(ss * (1.0f / 64.0f) + EPS) * mul;
                const int tok = tokb + 16 * mi;
#pragma unroll
                for (int ni = 0; ni < 4; ++ni) {
                    const int d = 16 * ni + 4 * h; f32x4 v = acc[ni][mi], o;
#pragma unroll
                    for (int r = 0; r < 4; ++r) o[r] = v[r] * rs * gain[d + r];
                    if (kind == 0) st_bf4(dst + (size_t)tok * 512 + nb + d, o);
                    else { const int b = tok / SEQ, s = tok % SEQ; st_bf4(dst + ((size_t)(b * 2 + g) * SEQ + s) * 64 + d, o); }
                }
            }
        } else if (nb < 768) {
            bf16* dst = (bf16*)(ws + (nb < 640 ? WS_KCG : WS_VCG)); const int g = (nb >> 6) & 1;
#pragma unroll
            for (int mi = 0; mi < 4; ++mi) { const int tok = tokb + 16 * mi, b = tok / SEQ, s = tok % SEQ;
#pragma unroll
                for (int ni = 0; ni < 4; ++ni) st_bf4(dst + ((size_t)(b * 2 + g) * SEQ + s) * 64 + 16 * ni + 4 * h, acc[ni][mi]); }
        } else if (nb < 1280) {
            bf16* dst = (bf16*)(ws + (nb < 1024 ? WS_VST : WS_VWT)); const int g = (nb >> 6) & 1;
#pragma unroll
            for (int mi = 0; mi < 4; ++mi) { const int tok = tokb + 16 * mi, b = tok / SEQ, s = tok % SEQ;
                bf16* p = dst + ((size_t)(b * 2 + g) * NCH + (s >> 6)) * 4096 + (s & 63);
#pragma unroll
                for (int ni = 0; ni < 4; ++ni)
#pragma unroll
                    for (int r = 0; r < 4; ++r) p[(16 * ni + 4 * h + r) * 64] = (bf16)f2bf(acc[ni][mi][r]); }
        } else if (nb < 3328) {
            const int sec = (nb - 1280) >> 9, cc = (nb - 1280) & 511, hh = cc >> 7, d0 = cc & 127;
#pragma unroll
            for (int mi = 0; mi < 4; ++mi) { const int tok = tokb + 16 * mi, b = tok / SEQ, s = tok % SEQ;
                const size_t hrow = ((size_t)(b * 4 + hh) * SEQ + s) * 128 + d0;
#pragma unroll
                for (int ni = 0; ni < 4; ++ni) { const int d = 16 * ni + 4 * h; f32x4 v = acc[ni][mi], o;
                    if (sec == 0) { for (int r = 0; r < 4; ++r) o[r] = siluf(v[r]); st_bf4((bf16*)(ws + WS_HQ) + hrow + d, o); }
                    else if (sec == 1) { const float* lb = (const float*)(ws + WS_LB) + li * 512 + cc + d;
                        for (int r = 0; r < 4; ++r) o[r] = lb[r] + (1.0f - lb[r]) * sigm(v[r]);
                        *(f32x4*)((float*)(ws + WS_HF) + hrow + d) = o; }
                    else if (sec == 2) st_bf4((bf16*)(ws + WS_HV) + hrow + d, v);
                    else { for (int r = 0; r < 4; ++r) o[r] = siluf(v[r]); st_bf4((bf16*)(ws + WS_HGS) + (size_t)tok * 512 + cc + d, o); }
                } }
        } else if (nb == 3328) {
            float* dst = (float*)(ws + WS_GATE);
#pragma unroll
            for (int mi = 0; mi < 4; ++mi) { const int tok = tokb + 16 * mi;
#pragma unroll
                for (int ni = 0; ni < 2; ++ni)
#pragma unroll
                    for (int r = 0; r < 4; ++r) { const int n = 16 * ni + 4 * h + r; if (n < 24) dst[(size_t)tok * 24 + n] = sigm(acc[ni][mi][r]); } }
        }
    }
};

struct EpiResid {
    float* x; const float* gate; int m0, n0;
    MDEV void operator()(f32x4 (&acc)[4][4], int mw, int nw, int h, int c) const {
#pragma unroll
        for (int mi = 0; mi < 4; ++mi) { const int tok = m0 + mw + 16 * mi + c, b = tok / SEQ;
#pragma unroll
            for (int ni = 0; ni < 4; ++ni) { const int n = n0 + nw + 16 * ni + 4 * h;
                f32x4 g = *(const f32x4*)(gate + (size_t)b * 6 * DM + n); f32x4* p = (f32x4*)(x + (size_t)tok * DM + n); f32x4 v = *p;
#pragma unroll
                for (int r = 0; r < 4; ++r) v[r] += g[r] * acc[ni][mi][r];
                *p = v; } }
    }
};
template <int MODE> struct EpiGated {
    bf16* dst; size_t ld; int m0, n0, mvalid;
    MDEV void operator()(f32x4 (&acc)[4][4], int mw, int nw, int h, int c) const {
        const int cb = (n0 + nw) / 2;
#pragma unroll
        for (int mi = 0; mi < 4; ++mi) { const int m = mw + 16 * mi + c; if (m >= mvalid) continue;
#pragma unroll
            for (int ni = 0; ni < 2; ++ni) { f32x4 o;
#pragma unroll
                for (int r = 0; r < 4; ++r) { const float av = acc[ni][mi][r], bv = acc[ni + 2][mi][r]; o[r] = MODE == 0 ? av * sigm(bv) : siluf(av) * bv; }
                st_bf4(dst + (size_t)(m0 + m) * ld + cb + 16 * ni + 4 * h, o); } }
    }
};
struct EpiStoreBf {
    bf16* dst; size_t ld; int m0, n0, mvalid;
    MDEV void operator()(f32x4 (&acc)[4][4], int mw, int nw, int h, int c) const {
#pragma unroll
        for (int mi = 0; mi < 4; ++mi) { const int m = mw + 16 * mi + c; if (m >= mvalid) continue;
#pragma unroll
            for (int ni = 0; ni < 4; ++ni) st_bf4(dst + (size_t)(m0 + m) * ld + n0 + nw + 16 * ni + 4 * h, acc[ni][mi]); }
    }
};
struct EpiCmp {
    const Args* a; int kv, bg, m0, li;
    MDEV void operator()(f32x4 (&acc)[4][4], int mw, int nw, int h, int c) const {
        if (nw != 0) return;
        unsigned char* ws = wsp(*a);
        const float* bp8 = (const float*)(ws + WS_CB) + (li * 2 + kv) * 8 * 64;
        float bias[16];
#pragma unroll
        for (int q = 0; q < 16; ++q) { const int e = 16 * (q >> 2) + 4 * h + (q & 3); float v = 0.f;
#pragma unroll
            for (int kp = 0; kp < 8; ++kp) v += bp8[kp * 64 + e];
            bias[q] = v; }
        const float* gain = INP(*a, I_KG) + (li * 3 + 0) * 64;
#pragma unroll
        for (int mi = 0; mi < 4; ++mi) { const int n = m0 + mw + 16 * mi + c; const bool ok = n < NCMP;
            f32x4 v[4]; float ss = 0.f;
#pragma unroll
            for (int ni = 0; ni < 4; ++ni) { v[ni] = acc[ni][mi];
#pragma unroll
                for (int r = 0; r < 4; ++r) { v[ni][r] += bias[4 * ni + r]; ss += v[ni][r] * v[ni][r]; } }
            ss += shflx(ss, 16); ss += shflx(ss, 32);
            if (n >= NCP) continue;
            if (kv == 0) { const float rs = frsq(ss * (1.0f / 64.0f) + EPS); bf16* p = (bf16*)(ws + WS_KC) + ((size_t)bg * NCP + n) * 64;
#pragma unroll
                for (int ni = 0; ni < 4; ++ni) { f32x4 o;
#pragma unroll
                    for (int r = 0; r < 4; ++r) o[r] = ok ? v[ni][r] * rs * gain[16 * ni + 4 * h + r] : 0.f;
                    st_bf4(p + 16 * ni + 4 * h, o); }
            } else { bf16* p = (bf16*)(ws + WS_VCT) + ((size_t)bg * NCP + n) * 64;
#pragma unroll
                for (int ni = 0; ni < 4; ++ni) { f32x4 o;
#pragma unroll
                    for (int r = 0; r < 4; ++r) o[r] = ok ? v[ni][r] : 0.f;
                    st_bf4(p + 16 * ni + 4 * h, o); } }
        }
    }
};


struct EpiResid8 {
    static constexpr bool PERM = true, AFTER_DRAIN = false;
    float* x; const float* gate; const float* xin;
    MDEV void operator()(const f32x4 (&acc)[2][2][4][2], const pg8::Unit& u, int wr, int wc, int fr, int fq) const {
        OPAQUE2(fr, fq);
#pragma unroll
        for (int ai = 0; ai < 2; ++ai)
#pragma unroll
            for (int m = 0; m < 4; ++m) { const int row = 256 * u.pm + 128 * ai + 64 * wr + 16 * m + fr, b = row / SEQ;
#pragma unroll
                for (int bj = 0; bj < 2; ++bj)
#pragma unroll
                    for (int n = 0; n < 2; ++n) { const int col = 256 * u.pn + 128 * bj + 32 * wc + 8 * fq + 4 * n;
                        const f32x4 g = *(const f32x4*)(gate + (size_t)b * 6 * DM + col); f32x4* p = (f32x4*)(x + (size_t)row * DM + col); f32x4 v = *(const f32x4*)(xin + (size_t)row * DM + col);
#pragma unroll
                        for (int r = 0; r < 4; ++r) v[r] += g[r] * acc[ai][bj][m][n][r];
                        *p = v; } }
    }
};
struct EpiGlu8 {
    static constexpr bool PERM = true, AFTER_DRAIN = false;
    bf16* dst;
    MDEV void operator()(const f32x4 (&acc)[2][2][4][2], const pg8::Unit& u, int wr, int wc, int fr, int fq) const {
        OPAQUE2(fr, fq);
#pragma unroll
        for (int ai = 0; ai < 2; ++ai)
#pragma unroll
            for (int m = 0; m < 4; ++m) { const int row = 256 * u.pm + 128 * ai + 64 * wr + 16 * m + fr;
#pragma unroll
                for (int bj = 0; bj < 2; ++bj) { const int col = 128 * u.pn + 64 * bj + 16 * wc + 4 * fq; f32x4 o;
#pragma unroll
                    for (int r = 0; r < 4; ++r) o[r] = acc[ai][bj][m][0][r] * sigm(acc[ai][bj][m][1][r]);
                    st_bf4(dst + (size_t)row * DM + col, o); } }
    }
};
struct EpiMoe1_8 {
    static constexpr bool PERM = true, AFTER_DRAIN = false;
    bf16* dst;
    MDEV void operator()(const f32x4 (&acc)[2][2][4][2], const pg8::Unit& u, int wr, int wc, int fr, int fq) const {
        OPAQUE2(fr, fq);
#pragma unroll
        for (int ai = 0; ai < 2; ++ai)
#pragma unroll
            for (int m = 0; m < 4; ++m) { const int row = 256 * u.pm + 128 * ai + 64 * wr + 16 * m + fr;
#pragma unroll
                for (int bj = 0; bj < 2; ++bj) { const int col = 128 * u.pn + 64 * bj + 16 * wc + 4 * fq; f32x4 o;
#pragma unroll
                    for (int r = 0; r < 4; ++r) o[r] = siluf(acc[ai][bj][m][0][r]) * acc[ai][bj][m][1][r];
#ifdef EMU
                    st_bf4(dst + (size_t)row * FF + col, o); } }
#else
                    const unsigned long long pk = (unsigned long long)pk2(o[0], o[1]) | ((unsigned long long)pk2(o[2], o[3]) << 32);
                    __hip_atomic_store((__attribute__((address_space(1))) unsigned long long*)(dst + (size_t)row * FF + col), pk, __ATOMIC_RELAXED, __HIP_MEMORY_SCOPE_AGENT); } }
#endif
    }
};
struct EpiMoe2_8 {
    static constexpr bool PERM = true, AFTER_DRAIN = false;
    bf16* dst;
    MDEV void operator()(const f32x4 (&acc)[2][2][4][2], const pg8::Unit& u, int wr, int wc, int fr, int fq) const {
        OPAQUE2(fr, fq);
#pragma unroll
        for (int ai = 0; ai < 2; ++ai)
#pragma unroll
            for (int m = 0; m < 4; ++m) { const int row = 256 * u.pm + 128 * ai + 64 * wr + 16 * m + fr;
#pragma unroll
                for (int bj = 0; bj < 2; ++bj) { const int col = 256 * u.pn + 128 * bj + 32 * wc + 8 * fq;
                    st_bf8(dst + (size_t)row * DM + col, acc[ai][bj][m][0], acc[ai][bj][m][1]); } }
    }
};
DEV unsigned uni(unsigned x);
template <bool G> struct MoeSel {
    static constexpr bool GATHER = G;
    const int* rb; const int* cnt; const int* list; size_t bstride;
    struct Ctx { int e, rbase, c; };
    MDEV Ctx ctx(const pg8::Unit& u) const { int e = 0;
#pragma unroll 1
        for (int q = 1; q < 32; ++q) if ((rb[q] >> 8) <= u.pm) e = q;
        e = (int)uni((unsigned)e); Ctx x; x.e = e; x.rbase = (int)uni((unsigned)((u.pm << 8) - rb[e])); x.c = G ? (int)uni((unsigned)cnt[e * 64]) : 0; return x; }
    MDEV size_t boff(const Ctx& x) const { return (size_t)x.e * bstride; }
    MDEV unsigned aoff(const Ctx& x, int r) const { int p = x.rbase + r; if (p > x.c - 1) p = x.c - 1; return (unsigned)list[(size_t)x.e * T + p] * (unsigned)(DM * 2); }
};
struct EpiInProj8 {
    static constexpr bool PERM = true, AFTER_DRAIN = false;
    const Args* a; int li;
    MDEV void operator()(const f32x4 (&acc)[2][2][4][2], const pg8::Unit& u, int wr, int wc, int fr, int fq) const {
        OPAQUE2(fr, fq);
        unsigned char* ws = wsp(*a);
        const int nb = 256 * u.pn + 64 * wc;
        if (nb >= 3392) return;
        if (nb < 512 || (nb >= 768 && nb < 896) || (nb >= 1024 && nb < 1152)) {
            const float* gain; float mul = 1.f; int kind;
            if (nb < 512) { gain = INP(*a, I_QG) + li * 64; mul = 0.125f * LOG2E; kind = 0; }
            else if (nb < 896) { gain = INP(*a, I_KG) + (li * 3 + 1) * 64; kind = 1; }
            else { gain = INP(*a, I_KG) + (li * 3 + 2) * 64; kind = 2; }
            const int g = (nb >> 6) & 1;
            f32x4 gv[2][2];
#pragma unroll
            for (int bj = 0; bj < 2; ++bj)
#pragma unroll
                for (int n = 0; n < 2; ++n) gv[bj][n] = *(const f32x4*)(gain + 32 * bj + 8 * fq + 4 * n);
#pragma unroll
            for (int ai = 0; ai < 2; ++ai)
#pragma unroll
                for (int m = 0; m < 4; ++m) { const int tok = 256 * u.pm + 128 * ai + 64 * wr + 16 * m + fr;
                    float ss = 0.f;
#pragma unroll
                    for (int bj = 0; bj < 2; ++bj)
#pragma unroll
                        for (int n = 0; n < 2; ++n) { const f32x4 v = acc[ai][bj][m][n]; ss += v[0] * v[0] + v[1] * v[1] + v[2] * v[2] + v[3] * v[3]; }
                    ss += shflx(ss, 16); ss += shflx(ss, 32);
                    const float rs = frsq(ss * (1.0f / 64.0f) + EPS) * mul;
                    bf16* dst; if (kind == 0) dst = (bf16*)(ws + WS_QN) + (size_t)tok * 512 + nb; else { const int b = tok / SEQ, sq = tok % SEQ; dst = (bf16*)(ws + (kind == 1 ? WS_KS : WS_KW)) + ((size_t)(b * 2 + g) * SEQ + sq) * 64; }
#pragma unroll
                    for (int bj = 0; bj < 2; ++bj) { f32x4 o0, o1;
#pragma unroll
                        for (int r = 0; r < 4; ++r) { o0[r] = acc[ai][bj][m][0][r] * rs * gv[bj][0][r]; o1[r] = acc[ai][bj][m][1][r] * rs * gv[bj][1][r]; }
                        st_bf8(dst + 32 * bj + 8 * fq, o0, o1); } }
        } else if (nb < 768) {
            bf16* base = (bf16*)(ws + (nb < 640 ? WS_KCG : WS_VCG)); const int g = (nb >> 6) & 1;
#pragma unroll
            for (int ai = 0; ai < 2; ++ai)
#pragma unroll
                for (int m = 0; m < 4; ++m) { const int tok = 256 * u.pm + 128 * ai + 64 * wr + 16 * m + fr, b = tok / SEQ, sq = tok % SEQ;
#pragma unroll
                    for (int bj = 0; bj < 2; ++bj) st_bf8(base + ((size_t)(b * 2 + g) * SEQ + sq) * 64 + 32 * bj + 8 * fq, acc[ai][bj][m][0], acc[ai][bj][m][1]); }
        } else if (nb < 1280) {
            bf16* base = (bf16*)(ws + (nb < 1024 ? WS_VST : WS_VWT)); const int g = (nb >> 6) & 1;
#pragma unroll
            for (int ai = 0; ai < 2; ++ai)
#pragma unroll
                for (int m = 0; m < 4; ++m) { const int tok = 256 * u.pm + 128 * ai + 64 * wr + 16 * m + fr, b = tok / SEQ, sq = tok % SEQ;
#pragma unroll
                    for (int bj = 0; bj < 2; ++bj) st_bf8(base + ((size_t)(b * 2 + g) * SEQ + sq) * 64 + 32 * bj + 8 * fq, acc[ai][bj][m][0], acc[ai][bj][m][1]); }
        } else if (nb < 3328) {
            const int sec = (nb - 1280) >> 9, cc = (nb - 1280) & 511, hh = cc >> 7, d0 = cc & 127;
            f32x4 lbv[2][2];
            if (sec == 1) {
#pragma unroll
                for (int bj = 0; bj < 2; ++bj)
#pragma unroll
                    for (int n = 0; n < 2; ++n) lbv[bj][n] = *(const f32x4*)((const float*)(ws + WS_LB) + li * 512 + cc + 32 * bj + 8 * fq + 4 * n); }
#pragma unroll
            for (int ai = 0; ai < 2; ++ai)
#pragma unroll
                for (int m = 0; m < 4; ++m) { const int tok = 256 * u.pm + 128 * ai + 64 * wr + 16 * m + fr, b = tok / SEQ, sq = tok % SEQ;
                    const size_t hrow = ((size_t)(b * 4 + hh) * SEQ + sq) * 128 + d0;
#pragma unroll
                    for (int bj = 0; bj < 2; ++bj) { const int d = 32 * bj + 8 * fq; f32x4 o0, o1;
                        if (sec == 0) {
#pragma unroll
                            for (int r = 0; r < 4; ++r) { o0[r] = siluf(acc[ai][bj][m][0][r]); o1[r] = siluf(acc[ai][bj][m][1][r]); }
                            st_bf8((bf16*)(ws + WS_HQ) + hrow + d, o0, o1); }
                        else if (sec == 1) {
#pragma unroll
                            for (int r = 0; r < 4; ++r) { o0[r] = lbv[bj][0][r] + (1.0f - lbv[bj][0][r]) * sigm(acc[ai][bj][m][0][r]); o1[r] = lbv[bj][1][r] + (1.0f - lbv[bj][1][r]) * sigm(acc[ai][bj][m][1][r]); }
                            float* pf = (float*)(ws + WS_HF) + hrow + d; *(f32x4*)pf = o0; *(f32x4*)(pf + 4) = o1; }
                        else if (sec == 2) st_bf8((bf16*)(ws + WS_HV) + hrow + d, acc[ai][bj][m][0], acc[ai][bj][m][1]);
                        else {
#pragma unroll
                            for (int r = 0; r < 4; ++r) { o0[r] = siluf(acc[ai][bj][m][0][r]); o1[r] = siluf(acc[ai][bj][m][1][r]); }
                            st_bf8((bf16*)(ws + WS_HGS) + (size_t)tok * 512 + cc + d, o0, o1); } } }
        } else {
            float* dst = (float*)(ws + WS_GATE);
            if (fq < 3) {
#pragma unroll
                for (int ai = 0; ai < 2; ++ai)
#pragma unroll
                    for (int m = 0; m < 4; ++m) { const int tok = 256 * u.pm + 128 * ai + 64 * wr + 16 * m + fr; f32x4 o0, o1;
#pragma unroll
                        for (int r = 0; r < 4; ++r) { o0[r] = sigm(acc[ai][0][m][0][r]); o1[r] = sigm(acc[ai][0][m][1][r]); }
                        float* pf = dst + (size_t)tok * 24 + 8 * fq; *(f32x4*)pf = o0; *(f32x4*)(pf + 4) = o1; } }
        }
    }
};

DEV void tr_tile(unsigned char* smem, const float* src0, const float* src1, int ld, int K, int mode, bf16* dst, int n0, int k0) {
    bf16* tl = (bf16*)smem;
    const int tid = TID;
    SYNC();
#pragma unroll
    for (int i = 0; i < 8; ++i) {
        const int e = tid + 512 * i, kk = e >> 6, nn = e & 63, n = n0 + nn; float v = 0.f;
        if (mode == 0) v = src0[(size_t)(k0 + kk) * ld + n];
        else if (mode == 1) { int sc = n < 1280 ? n : (n < 3328 ? n + 24 : (n < 3352 ? 1280 + (n - 3328) : -1)); if (sc >= 0) v = src0[(size_t)(k0 + kk) * ld + sc]; }
        else { const int g = n >> 6, w = n & 63; v = (w < 32) ? src0[(size_t)(k0 + kk) * ld + g * 32 + w] : src1[(size_t)(k0 + kk) * ld + g * 32 + w - 32]; }
        tl[nn * LDT + kk] = (bf16)f2bf(v);
    }
    SYNC();
    const int nn = tid >> 3, k8 = (tid & 7) * 8;
    *(bf16x8*)(dst + (size_t)(n0 + nn) * K + k0 + k8) = *(const bf16x8*)(tl + nn * LDT + k8);
}

DEV int tr_col(int mode, int n) {
    if (mode == 0) return n;
    const int pn = n >> 8, ct = n & 255;
    if (mode == 5) { const int bj = ct >> 7, wc = (ct >> 5) & 3, j = ct & 31, L = 256 * pn + 64 * wc + 32 * bj + j; return L < 1280 ? L : (L < 3328 ? L + 24 : (L < 3352 ? 1280 + (L - 3328) : -1)); }
    { const int bj = ct >> 7, wc = (ct >> 5) & 3, j = ct & 31, nn = (j >> 2) & 1, Lc = 128 * pn + 64 * bj + 16 * wc + 4 * (j >> 3) + (j & 3); return nn == 0 ? Lc : (mode == 7 ? FF : DM) + Lc; }
}
DEV void tr_tile(unsigned char* smem, const float* src, int ld, int K, int mode, bf16* dst, int n0, int k0) {
    bf16* tl = (bf16*)smem;
    const int tid = TID, nq = tid & 31, kq = tid >> 5;
    const int sc = tr_col(mode, n0 + 4 * nq);
    f32x4 v[4];
#pragma unroll
    for (int i = 0; i < 4; ++i) v[i] = sc >= 0 ? *(const f32x4*)(src + (size_t)(k0 + 4 * kq + i) * ld + sc) : f4zero();
    SYNC();
#pragma unroll
    for (int j = 0; j < 4; ++j) { u32x2 w; w[0] = pk2(v[0][j], v[1][j]); w[1] = pk2(v[2][j], v[3][j]); *(u32x2*)(tl + (4 * nq + j) * LDT + 4 * kq) = w; }
    SYNC();
#pragma unroll
    for (int t = 0; t < 2; ++t) { const int id = tid + 512 * t, row = id >> 3, ch = id & 7;
        *(bf16x8*)(dst + (size_t)(n0 + row) * K + k0 + 8 * ch) = *(const bf16x8*)(tl + row * LDT + 8 * ch); }
}
constexpr int KSUP = FF >= 256 ? 256 : FF, NSUP = KSUP / 64;
DEV void tr_super(unsigned char* smem, const float* src0, const float* src1, int ld, int K, int mode, bf16* dst, int n0, int k0) {
    const int tid = TID, nq = tid & 31, kq = tid >> 5;
    int sc = n0 + 4 * nq; const float* src = src0;
    if (mode == 7) { const int cc = tr_col(7, sc); src = cc >= FF ? src1 : src0; sc = cc >= FF ? cc - FF : cc; }
    f32x4 v[NSUP][4];
#pragma unroll
    for (int sb = 0; sb < NSUP; ++sb)
#pragma unroll
        for (int i = 0; i < 4; ++i) v[sb][i] = *(const f32x4*)(src + (size_t)(k0 + 64 * sb + 4 * kq + i) * ld + sc);
    SYNC();
    const int fw = nq & (KSUP / 16 - 1);
#pragma unroll
    for (int j = 0; j < 4; ++j)
#pragma unroll
        for (int sb = 0; sb < NSUP; ++sb) { const int c16 = 8 * sb + (kq >> 1); u32x2 w; w[0] = pk2(v[sb][0][j], v[sb][1][j]); w[1] = pk2(v[sb][2][j], v[sb][3][j]);
            *(u32x2*)(smem + (4 * nq + j) * (KSUP * 2) + ((c16 ^ fw) << 4) + (kq & 1) * 8) = w; }
    SYNC();
#pragma unroll
    for (int t = 0; t < 128 * (KSUP / 8) / NT; ++t) { const int id = tid + NT * t, row = id / (KSUP / 8), ch = id % (KSUP / 8), f = (row >> 2) & (KSUP / 16 - 1);
        *(bf16x8*)(dst + (size_t)(n0 + row) * K + k0 + 8 * (ch ^ f)) = *(const bf16x8*)(smem + row * (KSUP * 2) + ch * 16); }
}
struct TrJob { const float* s; int ld, K, N, mode; bf16* dst; };
DEV void p0_phase(const Args& a, unsigned char* smem) {
    unsigned char* ws = wsp(a); const int tid = TID;
    { int item = BID, base = 0;
      for (int j = 0; j < 8; ++j) { TrJob J; const int i = j & 1;
        if (j < 2) J = {INP(a, I_WIN) + (size_t)i * DM * NIN, NIN, DM, NIN8, 5, (bf16*)(ws + WS_WIN) + (size_t)i * NIN8 * DM};
        else if (j < 4) J = {INP(a, I_WOUT) + (size_t)i * 1024 * DM, DM, 1024, DM, 0, (bf16*)(ws + WS_WOUT) + (size_t)i * DM * 1024};
        else if (j < 6) J = {INP(a, I_PW1) + (size_t)i * DM * 2 * DM, 2 * DM, DM, 2 * DM, 6, (bf16*)(ws + WS_PW1) + (size_t)i * 2 * DM * DM};
        else J = {INP(a, I_PW2) + (size_t)i * DM * DM, DM, DM, DM, 0, (bf16*)(ws + WS_PW2) + (size_t)i * DM * DM};
        const int tn = J.N / 128, tk = J.K / 64, nt = tn * tk;
        while (item < base + nt) { const int it = item - base; tr_tile(smem, J.s, J.ld, J.K, J.mode, J.dst, (it % tn) * 128, (it / tn) * 64); item += NBLK; }
        base += nt; }
      SYNC(); }
    { constexpr int S13 = (2 * FF / 128) * (DM / KSUP), S2 = (DM / 128) * (FF / KSUP), SPE = S13 + S2;
      for (int it = BID; it < DEPTH * 32 * SPE; it += NBLK) { const int le = it / SPE, r = it % SPE;
        if (r < S13) { const int tn = r % (2 * FF / 128), tk = r / (2 * FF / 128);
            tr_super(smem, INP(a, I_W1) + (size_t)le * DM * FF, INP(a, I_W3) + (size_t)le * DM * FF, FF, DM, 7, (bf16*)(ws + WS_W13) + (size_t)le * 2 * FF * DM, tn * 128, tk * KSUP); }
        else { const int r2 = r - S13, tn = r2 % (DM / 128), tk = r2 / (DM / 128);
            tr_super(smem, INP(a, I_W2) + (size_t)le * FF * DM, INP(a, I_W2), DM, FF, 0, (bf16*)(ws + WS_W2) + (size_t)le * DM * FF, tn * 128, tk * KSUP); } }
      SYNC(); }
    {
        float* red = (float*)smem;
        constexpr int NG = 6 * DM / 128; const int ntask = DEPTH * NG;
        for (int t = BID; t < ntask; t += NBLK) {
            const int l = t / NG, j0 = (t % NG) * 128, cq = tid & 31, kr = tid >> 5;
            const float* w = INP(a, I_ADAW) + (size_t)l * DM * 6 * DM + j0 + 4 * cq; const float* cc = INP(a, I_C);
            f32x4 a0 = f4zero(), a1 = f4zero();
#pragma unroll 8
            for (int i = 0; i < DM / 16; ++i) { const int k = kr + 16 * i; const f32x4 wv = *(const f32x4*)(w + (size_t)k * 6 * DM); const float s0 = siluf(cc[k]), s1 = siluf(cc[DM + k]);
#pragma unroll
                for (int r = 0; r < 4; ++r) { a0[r] += s0 * wv[r]; a1[r] += s1 * wv[r]; } }
            SYNC();
            *(f32x4*)(red + (kr * 2 + 0) * 128 + 4 * cq) = a0; *(f32x4*)(red + (kr * 2 + 1) * 128 + 4 * cq) = a1;
            SYNC();
            if (tid < 256) { const int b = tid >> 7, col = tid & 127; float sum = INP(a, I_ADAB)[(size_t)l * 6 * DM + j0 + col];
#pragma unroll
                for (int q = 0; q < 16; ++q) sum += red[(q * 2 + b) * 128 + col];
                ((float*)(ws + WS_MOD))[((size_t)l * 2 + b) * 6 * DM + j0 + col] = sum; }
        }
    }
    for (int t = BID; t < 32; t += NBLK) {
        float* red = (float*)smem; const int ikv = t >> 3, kp = t & 7, i = ikv >> 1, kv = ikv & 1, e = tid & 63, ks = tid >> 6;
        const float* W = INP(a, kv ? I_CWV : I_CWK) + (size_t)i * 2048 * 64 + e; const float* pe = INP(a, I_CPE) + (size_t)i * 2048;
        float sum = 0.f;
#pragma unroll 8
        for (int q = 0; q < 32; ++q) { const int k = kp * 256 + ks * 32 + q; sum += pe[k] * W[(size_t)k * 64]; }
        SYNC(); red[ks * 64 + e] = sum; SYNC();
        if (tid < 64) { float v = 0.f; for (int q = 0; q < 8; ++q) v += red[q * 64 + tid]; ((float*)(ws + WS_CB))[(ikv * 8 + kp) * 64 + tid] = v; }
    }
    for (int i = BID * NT + tid; i < DEPTH * 48 * DM; i += NBLK * NT) { const int k = i % DM, n = (i / DM) % 48, ll = i / (48 * DM);
        const float wv = n < 4 ? INP(a, I_WG)[((size_t)ll * DM + k) * 4 + n] : (n < 36 ? INP(a, I_WE)[((size_t)ll * DM + k) * 32 + n - 4] : 0.f);
        const unsigned hi = f2bf(wv); ((bf16*)(ws + WS_WTH))[i] = (bf16)hi; ((bf16*)(ws + WS_WTL))[i] = (bf16)f2bf(wv - bf2f(hi)); }
    if (BID == 0) {
        for (int i = tid; i < DEPTH * 32; i += NT) ((int*)(ws + WS_CNT))[i * 64] = 0;
        for (int i = tid; i < DEPTH * 256; i += NT) ((unsigned*)(ws + WS_FLG))[i * 16] = 0u;
        for (int n = tid; n < 512; n += NT) { const float l0 = INP(a, I_LBL)[n], l1 = INP(a, I_LBL)[512 + n]; const float m = fmaxf(l0, l1);
            const float e0 = fexp2((l0 - m) * LOG2E), e1 = fexp2((l1 - m) * LOG2E);
            ((float*)(ws + WS_LB))[n] = 0.f; ((float*)(ws + WS_LB))[512 + n] = e1 / (e0 + e1); }
        if (tid < 2) { const int i = tid; float mq = 0.f; for (int d = 0; d < 64; ++d) mq = fmaxf(mq, fabsf(INP(a, I_QG)[i * 64 + d]));
            for (int br = 0; br < 3; ++br) { float mk = 0.f; for (int d = 0; d < 64; ++d) mk = fmaxf(mk, fabsf(INP(a, I_KG)[(i * 3 + br) * 64 + d]));
                ((float*)(ws + WS_CS))[i * 4 + br] = 8.0f * mq * mk * LOG2E; } }
    }
}

constexpr int NJV = DM / 256;
DEV void moe_bases(const int* cnt, int* rb  ) {
    if (TID == 0) { int acc = 0; for (int e = 0; e < 32; ++e) { rb[e] = acc; acc += ((cnt[e * 64] + 255) >> 8) << 8; } rb[32] = acc; }
    SYNC();
}
DEV void norm_phase(const Args& a, unsigned char* smem, int l) {
    unsigned char* ws = wsp(a); const int tid = TID, w = tid >> 6, lane = tid & 63;
    int* rb = (int*)smem;
    if (l > 0) moe_bases((const int*)(ws + WS_CNT) + (l - 1) * 32 * 64, rb);
    const float* mod = (const float*)(ws + WS_MOD);
    const bf16* yk = (const bf16*)(ws + WS_YK);
    if (l < DEPTH) {
        const int bid = BID % 76 == BID ? BID : -1;
        for (int job = BID; job < 76; job += NBLK) {
            if (job < 72) { const int b = job / 36, n = job % 36; float sum = 0.f;
                for (int k = tid; k < DM; k += NT) { const float wv = n < 4 ? INP(a, I_WG)[((size_t)l * DM + k) * 4 + n] : INP(a, I_WE)[((size_t)l * DM + k) * 32 + n - 4]; sum += mod[((size_t)l * 2 + b) * 6 * DM + 3 * DM + k] * wv; }
#pragma unroll
                for (int q = 1; q < 64; q <<= 1) sum += shflx(sum, q);
                float* red = (float*)(smem + 1024);
                SYNC(); if (lane == 0) red[w] = sum; SYNC();
                if (tid == 0) { float t = 0.f; for (int q = 0; q < 8; ++q) t += red[q]; ((float*)(ws + WS_RBIAS))[((size_t)l * 2 + b) * 48 + n] = t; }
            } else { const float* nf = INP(a, I_NFFN) + (size_t)l * DM; const int part = job - 72;
                for (int i = part * (2 * DM / 4) + tid; i < (part + 1) * (2 * DM / 4); i += NT) { const int b = i / DM, k = i % DM; ((float*)(ws + WS_AVEC))[((size_t)l * 2 + b) * DM + k] = nf[k] * (1.0f + mod[((size_t)l * 2 + b) * 6 * DM + 4 * DM + k]); } }
        }
        (void)bid;
    }
    const int rstride = NBLK * 8;
    for (int rowa = BID * 8 + w; rowa < T; rowa += 2 * rstride) {
        int row[2]; bool ok[2];
        row[0] = rowa; ok[0] = true; row[1] = rowa + rstride; ok[1] = row[1] < T; if (!ok[1]) row[1] = rowa;
        f32x4 v[2][NJV]; int e0[2], p0[2], e1[2], p1[2]; float w0[2], w1[2];
        const float* xin = (l == 0) ? INP(a, I_X) : outp(a);
#pragma unroll
        for (int q = 0; q < 2; ++q) {
#pragma unroll
            for (int j = 0; j < NJV; ++j) v[q][j] = *(const f32x4*)(xin + (size_t)row[q] * DM + 4 * lane + 256 * j);
            if (l > 0) { const int* tie = (const int*)(ws + WS_TIE) + (size_t)row[q] * 2; const float* tiw = (const float*)(ws + WS_TIW) + (size_t)row[q] * 2;
                e0[q] = tie[0] >> 14; p0[q] = tie[0] & 16383; e1[q] = tie[1] >> 14; p1[q] = tie[1] & 16383; w0[q] = tiw[0]; w1[q] = tiw[1]; } }
        if (l > 0) {
            u32x2 q0[2][NJV], q1[2][NJV];
#pragma unroll
            for (int q = 0; q < 2; ++q) { const bf16* y0 = yk + (size_t)(rb[e0[q]] + p0[q]) * DM; const bf16* y1 = yk + (size_t)(rb[e1[q]] + p1[q]) * DM;
#pragma unroll
                for (int j = 0; j < NJV; ++j) { const int cidx = 4 * lane + 256 * j; q0[q][j] = *(const u32x2*)(y0 + cidx); q1[q][j] = *(const u32x2*)(y1 + cidx); } }
#pragma unroll
            for (int q = 0; q < 2; ++q) { const int b = row[q] / SEQ; const float* gf = mod + ((size_t)(l - 1) * 2 + b) * 6 * DM + 5 * DM;
#pragma unroll
                for (int j = 0; j < NJV; ++j) { const int cidx = 4 * lane + 256 * j; const f32x4 g = *(const f32x4*)(gf + cidx);
                    v[q][j][0] += g[0] * (w0[q] * bf2f(q0[q][j][0] & 0xffff) + w1[q] * bf2f(q1[q][j][0] & 0xffff));
                    v[q][j][1] += g[1] * (w0[q] * bf2f(q0[q][j][0] >> 16) + w1[q] * bf2f(q1[q][j][0] >> 16));
                    v[q][j][2] += g[2] * (w0[q] * bf2f(q0[q][j][1] & 0xffff) + w1[q] * bf2f(q1[q][j][1] & 0xffff));
                    v[q][j][3] += g[3] * (w0[q] * bf2f(q0[q][j][1] >> 16) + w1[q] * bf2f(q1[q][j][1] >> 16)); } }
        }
        if (l > 0)
#pragma unroll
        for (int q = 0; q < 2; ++q) { if (!ok[q]) continue;
#pragma unroll
            for (int j = 0; j < NJV; ++j) *(f32x4*)(outp(a) + (size_t)row[q] * DM + 4 * lane + 256 * j) = v[q][j]; }
        if (l == DEPTH) continue;
        float ss[2];
#pragma unroll
        for (int q = 0; q < 2; ++q) { ss[q] = 0.f;
#pragma unroll
            for (int j = 0; j < NJV; ++j) ss[q] += v[q][j][0] * v[q][j][0] + v[q][j][1] * v[q][j][1] + v[q][j][2] * v[q][j][2] + v[q][j][3] * v[q][j][3]; }
#pragma unroll
        for (int o = 1; o < 64; o <<= 1) { ss[0] += shflx(ss[0], o); ss[1] += shflx(ss[1], o); }
        const float* nm = INP(a, I_NMIX) + (size_t)l * DM;
#pragma unroll
        for (int q = 0; q < 2; ++q) { if (!ok[q]) continue;
            const int b = row[q] / SEQ; const float rs = frsq(ss[q] * (1.0f / DM) + EPS);
            const float* mm = mod + ((size_t)l * 2 + b) * 6 * DM; bf16* hb = (bf16*)(ws + WS_H) + (size_t)row[q] * DM;
#pragma unroll
            for (int j = 0; j < NJV; ++j) { const int cidx = 4 * lane + 256 * j; f32x4 g = *(const f32x4*)(nm + cidx), sh = *(const f32x4*)(mm + cidx), sc = *(const f32x4*)(mm + DM + cidx), o;
#pragma unroll
                for (int r = 0; r < 4; ++r) o[r] = v[q][j][r] * rs * g[r] * (1.0f + sc[r]) + sh[r];
                st_bf4(hb + cidx, o); } }
    }
}

DEV void route_phase(const Args& a, unsigned char* smem, int l) {
    unsigned char* ws = wsp(a); const int tid = TID, w = tid >> 6, lane = tid & 63, h = lane >> 4, c = lane & 15, pi = w >> 1, kh = w & 1;
    constexpr int NCHK = 4, CH = DM / NCHK, WLD = CH + 8, NKS = CH / 2 / 32;
    constexpr int WTOT = 48 * (CH / 8), WMAX = (WTOT + NT - 1) / NT;
    bf16* WHl = (bf16*)smem; bf16* WLl = WHl + 48 * WLD;
    float* lg = (float*)(WLl + 48 * WLD);
    float* ssb = lg + 4 * 2 * 16 * 48;
    float* rsb = ssb + 4 * 2 * 16;
    int* lcnt = (int*)(rsb + 64); int* lbase = lcnt + 32; int* tinfo = lbase + 32;
    float* avl = (float*)(tinfo + 256); float* cvl = avl + 2 * DM;
    const float* mod = (const float*)(ws + WS_MOD);
    SYNC();
    if (tid < 32) lcnt[tid] = 0;
    for (int i = tid; i < 2 * DM; i += NT) { const int b = i / DM, k = i % DM; avl[i] = ((const float*)(ws + WS_AVEC))[((size_t)l * 2 + b) * DM + k]; cvl[i] = mod[((size_t)l * 2 + b) * 6 * DM + 3 * DM + k]; }
    const bf16* WH = (const bf16*)(ws + WS_WTH) + (size_t)l * 48 * DM; const bf16* WL = (const bf16*)(ws + WS_WTL) + (size_t)l * 48 * DM;
    int* cnt = (int*)(ws + WS_CNT) + l * 32 * 64;
    for (int pass0 = BID; pass0 < T / 16; pass0 += 4 * NBLK) {
        const int pass = pass0 + pi * NBLK; const bool valid = pass < T / 16;
        const int tok = valid ? pass * 16 + c : 0, b = tok / SEQ;
        const float* xrow = outp(a) + (size_t)tok * DM;
        f32x4 xv[2][NKS][2]; bf16x8 wh[WMAX], wl[WMAX];
#pragma unroll
        for (int ks = 0; ks < NKS; ++ks) { const float* xq = xrow + kh * (CH / 2) + 8 * h + 32 * ks; xv[0][ks][0] = *(const f32x4*)xq; xv[0][ks][1] = *(const f32x4*)(xq + 4); }
#pragma unroll
        for (int t = 0; t < WMAX; ++t) { const int i = tid + NT * t; if (i < WTOT) { const int n = i / (CH / 8), k8 = (i % (CH / 8)) * 8; wh[t] = *(const bf16x8*)(WH + (size_t)n * DM + k8); wl[t] = *(const bf16x8*)(WL + (size_t)n * DM + k8); } }
        f32x4 acc[3] = {f4zero(), f4zero(), f4zero()}; float ss = 0.f;
        bf16x8 uhk[NCHK * NKS];
#pragma unroll
        for (int chn = 0; chn < NCHK; ++chn) {
            SYNC();
#pragma unroll
            for (int t = 0; t < WMAX; ++t) { const int i = tid + NT * t; if (i < WTOT) { const int n = i / (CH / 8), k8 = (i % (CH / 8)) * 8; *(bf16x8*)(WHl + n * WLD + k8) = wh[t]; *(bf16x8*)(WLl + n * WLD + k8) = wl[t]; } }
            SYNC();
            if (chn + 1 < NCHK) {
#pragma unroll
                for (int ks = 0; ks < NKS; ++ks) { const float* xq = xrow + (chn + 1) * CH + kh * (CH / 2) + 8 * h + 32 * ks; xv[(chn + 1) & 1][ks][0] = *(const f32x4*)xq; xv[(chn + 1) & 1][ks][1] = *(const f32x4*)(xq + 4); }
#pragma unroll
                for (int t = 0; t < WMAX; ++t) { const int i = tid + NT * t; if (i < WTOT) { const int n = i / (CH / 8), k8 = (i % (CH / 8)) * 8; wh[t] = *(const bf16x8*)(WH + (size_t)n * DM + (chn + 1) * CH + k8); wl[t] = *(const bf16x8*)(WL + (size_t)n * DM + (chn + 1) * CH + k8); } }
            }
            if (valid) {
                const bf16* whp = WHl + c * WLD + kh * (CH / 2) + 8 * h; const bf16* wlp = WLl + c * WLD + kh * (CH / 2) + 8 * h;
                const float* ap = avl + b * DM + chn * CH + kh * (CH / 2) + 8 * h;
#pragma unroll
                for (int ks = 0; ks < NKS; ++ks) {
                    const f32x4 a0 = *(const f32x4*)(ap + 32 * ks), a1 = *(const f32x4*)(ap + 32 * ks + 4);
                    const f32x4 x0 = xv[chn & 1][ks][0], x1 = xv[chn & 1][ks][1];
                    f32x4 u0, u1, r0, r1;
#pragma unroll
                    for (int r = 0; r < 4; ++r) { u0[r] = x0[r] * a0[r]; u1[r] = x1[r] * a1[r]; ss += x0[r] * x0[r] + x1[r] * x1[r]; }
                    const bf16x8 uh = pack8(u0, u1); uhk[chn * NKS + ks] = uh;
#pragma unroll
                    for (int r = 0; r < 4; ++r) { r0[r] = u0[r] - bf2f((unsigned short)uh[r]); r1[r] = u1[r] - bf2f((unsigned short)uh[4 + r]); }
                    const bf16x8 ul = pack8(r0, r1);
#pragma unroll
                    for (int nt = 0; nt < 3; ++nt) { const bf16x8 whf = *(const bf16x8*)(whp + nt * 16 * WLD + 32 * ks), wlf = *(const bf16x8*)(wlp + nt * 16 * WLD + 32 * ks);
                        acc[nt] = mfma16(whf, uh, acc[nt]); acc[nt] = mfma16(wlf, uh, acc[nt]); acc[nt] = mfma16(whf, ul, acc[nt]); }
                }
            }
        }
        if (valid) {
            ss += shflx(ss, 16); ss += shflx(ss, 32);
            float* lgp = lg + ((pi * 2 + kh) * 16 + c) * 48 + 4 * h;
#pragma unroll
            for (int nt = 0; nt < 3; ++nt) *(f32x4*)(lgp + 16 * nt) = acc[nt];
            if (h == 0) ssb[(pi * 2 + kh) * 16 + c] = ss;
        }
        SYNC();
        if (tid < 64) { const int p2 = tid >> 4, tk = tid & 15, pass2 = pass0 + p2 * NBLK;
            if (pass2 < T / 16) { const int tok2 = pass2 * 16 + tk, b2 = tok2 / SEQ;
                const float rs = frsq((ssb[(p2 * 2 + 0) * 16 + tk] + ssb[(p2 * 2 + 1) * 16 + tk]) * (1.0f / DM) + EPS); rsb[p2 * 16 + tk] = rs;
                const float* l0 = lg + ((p2 * 2 + 0) * 16 + tk) * 48; const float* l1 = lg + ((p2 * 2 + 1) * 16 + tk) * 48; const float* rbp = (const float*)(ws + WS_RBIAS) + ((size_t)l * 2 + b2) * 48;
                float acc[36];
#pragma unroll
                for (int n = 0; n < 36; ++n) acc[n] = rs * (l0[n] + l1[n]) + rbp[n];
                int gs = 0; float gm = acc[0];
#pragma unroll
                for (int g = 1; g < 4; ++g) if (acc[g] > gm) { gm = acc[g]; gs = g; }
                float den = 0.f;
#pragma unroll
                for (int g = 0; g < 4; ++g) den += fexp2((acc[g] - gm) * LOG2E);
                const float ggate = 1.0f / den;
                float el[8];
#pragma unroll
                for (int j = 0; j < 8; ++j) { el[j] = acc[4 + j];
#pragma unroll
                    for (int g = 1; g < 4; ++g) if (gs == g) el[j] = acc[4 + 8 * g + j]; }
                int ia = 0; float va = el[0];
#pragma unroll
                for (int j = 1; j < 8; ++j) if (el[j] > va) { va = el[j]; ia = j; }
                int ib = -1; float vb = -3e38f;
#pragma unroll
                for (int j = 0; j < 8; ++j) if (j != ia && el[j] > vb) { vb = el[j]; ib = j; }
                const float wa = 1.0f / (1.0f + fexp2((vb - va) * LOG2E)), wb = 1.0f - wa;
                const int e0 = gs * 8 + ia, e1 = gs * 8 + ib;
                const int p0 = atomic_add_i(lcnt + e0, 1), p1 = atomic_add_i(lcnt + e1, 1);
                int* ti = tinfo + tid * 4;
                ti[0] = (e0 << 14) | p0; ti[1] = (e1 << 14) | p1; ti[2] = __builtin_bit_cast(int, ggate * wa); ti[3] = __builtin_bit_cast(int, ggate * wb);
            } }
        SYNC();
        int gbase = 0;
        if (tid < 32) { const int n = lcnt[tid]; gbase = n > 0 ? atomic_add_i(cnt + tid * 64, n) : 0; }
        if (valid) { const float rs = rsb[pi * 16 + c]; bf16* hb = (bf16*)(ws + WS_H) + (size_t)tok * DM + kh * (CH / 2) + 8 * h;
            const float* cp = cvl + b * DM + kh * (CH / 2) + 8 * h;
#pragma unroll
            for (int chn = 0; chn < NCHK; ++chn)
#pragma unroll
                for (int ks = 0; ks < NKS; ++ks) {
                    const bf16x8 uh = uhk[chn * NKS + ks]; const f32x4 c0 = *(const f32x4*)(cp + chn * CH + 32 * ks), c1 = *(const f32x4*)(cp + chn * CH + 32 * ks + 4);
                    f32x4 o0, o1;
#pragma unroll
                    for (int r = 0; r < 4; ++r) { o0[r] = bf2f((unsigned short)uh[r]) * rs + c0[r]; o1[r] = bf2f((unsigned short)uh[4 + r]) * rs + c1[r]; }
                    st_bf8(hb + chn * CH + 32 * ks, o0, o1); } }
        if (tid < 32) { lbase[tid] = gbase; lcnt[tid] = 0; }
        SYNC();
        if (tid < 64) { const int p2 = tid >> 4, pass2 = pass0 + p2 * NBLK;
            if (pass2 < T / 16) { const int tok2 = pass2 * 16 + (tid & 15); const int* ti = tinfo + tid * 4;
                const int e0 = ti[0] >> 14, e1 = ti[1] >> 14, p0 = lbase[e0] + (ti[0] & 16383), p1 = lbase[e1] + (ti[1] & 16383);
                int* list = (int*)(ws + WS_LIST); list[(size_t)e0 * T + p0] = tok2; list[(size_t)e1 * T + p1] = tok2;
                int* tie = (int*)(ws + WS_TIE) + (size_t)tok2 * 2; int* tiw = (int*)(ws + WS_TIW) + (size_t)tok2 * 2;
                tie[0] = (e0 << 14) | p0; tie[1] = (e1 << 14) | p1; tiw[0] = ti[2]; tiw[1] = ti[3]; } }
        SYNC();
    }
}

DEV int vbid() { const int g = NBLK; return (g % 8 == 0) ? (BID % 8) * (g / 8) + BID / 8 : BID; }
#ifdef EMU
#define PG8_LDS(p) (p)
#else
#define PG8_LDS(p) ((PG8_LAS unsigned char*)(p))
#endif
DEV void inproj_phase(const Args& a, unsigned char* smem, int li) {
    pg8::Gemm g{(const bf16*)(wsp(a) + WS_H), (const bf16*)(wsp(a) + WS_WIN) + (size_t)li * NIN8 * DM, T, NIN8, DM}; pg8::StaticOrder S; S.init(T, NIN8, NBLK, BID);
    EpiInProj8 E{&a, li};
    SYNC(); pg8::gemm_phase<EpiInProj8, pg8::StaticOrder, true, true>(PG8_LDS(smem), g, S, E); SYNC();
}
DEV void resid_gemm_phase(const Args& a, unsigned char* smem, const bf16* A, int K, const bf16* Bt, int l) {
    pg8::Gemm g{A, Bt, T, DM, K}; pg8::StaticOrder S; S.init(T, DM, NBLK, BID);
    EpiResid8 E{outp(a), (const float*)(wsp(a) + WS_MOD) + (size_t)l * 2 * 6 * DM + 2 * DM, l == 0 ? INP(a, I_X) : (const float*)outp(a)};
    SYNC(); pg8::gemm_phase<EpiResid8, pg8::StaticOrder, true, true>(PG8_LDS(smem), g, S, E); SYNC();
}
DEV void pw1_phase(const Args& a, unsigned char* smem, int li) {
    pg8::Gemm g{(const bf16*)(wsp(a) + WS_H), (const bf16*)(wsp(a) + WS_PW1) + (size_t)li * 2 * DM * DM, T, 2 * DM, DM}; pg8::StaticOrder S; S.init(T, 2 * DM, NBLK, BID);
    EpiGlu8 E{(bf16*)(wsp(a) + WS_GLU)};
    SYNC(); pg8::gemm_phase<EpiGlu8, pg8::StaticOrder, true, true>(PG8_LDS(smem), g, S, E); SYNC();
}
DEV void cmp_phase_items(const Args& a, unsigned char* smem, int li, int it) {
    constexpr int TMC = (NCP + 255) / 256;
    const int kv = it / (4 * TMC), bg = (it / TMC) % 4, tm = it % TMC;
    const bf16* src = (const bf16*)(wsp(a) + (kv ? WS_VCG : WS_KCG)) + (size_t)bg * SEQ * 64;
    struct AF { const bf16* base; int m0; MDEV unsigned off(int r) const { int n = m0 + r; if (n > NCMP - 1) n = NCMP - 1; return (unsigned)n * 1024u; } } af{src, tm * 256};
    EpiCmp E{&a, kv, bg, tm * 256, li};
    BClamp64 bf{INP(a, kv ? I_CWV : I_CWK) + (size_t)li * 2048 * 64};
    gemm_tile2(smem, af, bf, 64, 2048, E);
}
DEV void moe_gemm_phase8(const Args& a, unsigned char* smem, int l, int mode) {
    unsigned char* ws = wsp(a); const int* cnt = (const int*)(ws + WS_CNT) + l * 32 * 64;
    int* rb = (int*)(smem + 140 * 1024);
    moe_bases(cnt, rb);
    const int mrows = rb[32];
    if (mode == 0) {
        pg8::Gemm g{(const bf16*)(ws + WS_H), (const bf16*)(ws + WS_W13) + (size_t)l * 32 * 2 * FF * DM, mrows, 2 * FF, DM}; pg8::StaticOrder S; S.init(mrows, 2 * FF, NBLK, BID);
        EpiMoe1_8 E{(bf16*)(ws + WS_ACT)}; MoeSel<true> X{rb, cnt, (const int*)(ws + WS_LIST), (size_t)2 * FF * DM * 2};
        SYNC(); pg8::gemm_phase<EpiMoe1_8, pg8::StaticOrder, true, true, MoeSel<true>>(PG8_LDS(smem), g, S, E, X); SYNC();
    } else {
        pg8::Gemm g{(const bf16*)(ws + WS_ACT), (const bf16*)(ws + WS_W2) + (size_t)l * 32 * DM * FF, mrows, DM, FF}; pg8::StaticOrder S; S.init(mrows, DM, NBLK, BID);
        EpiMoe2_8 E{(bf16*)(ws + WS_YK)}; MoeSel<false> X{rb, cnt, (const int*)(ws + WS_LIST), (size_t)DM * FF * 2};
        SYNC(); pg8::gemm_phase<EpiMoe2_8, pg8::StaticOrder, true, true, MoeSel<false>>(PG8_LDS(smem), g, S, E, X); SYNC();
    }
}
#ifndef EMU
constexpr int MOE_TMO_IDX = 128;
struct MoeOrder { int nN, t0, nu, j, nper;
    __device__ __forceinline__ void init(int ntile, int nN_, int nblk, int bid, bool rev) { nN = nN_; nper = nblk / 8; const int x = bid % 8; j = bid / 8; if (rev) j = nper - 1 - j;
        t0 = x * ntile / 8; nu = ((x + 1) * ntile / 8 - t0) * nN; if (bid >= 8 * nper) nu = 0; }
    __device__ __forceinline__ bool next(int i, pg8::Unit& u) const { const int p = i * nper + j; if (p >= nu) return false; u.pm = t0 + p / nN; u.pn = p % nN; return true; }
    __device__ __forceinline__ void a_ready(const pg8::Unit&) const {}
    __device__ __forceinline__ void done(const pg8::Unit&) const {}
};
struct MoeProd : MoeOrder { unsigned* flg;
    __device__ __forceinline__ void done(const pg8::Unit& u) const {
        asm volatile("s_waitcnt vmcnt(0)" ::: "memory"); __builtin_amdgcn_s_barrier(); asm volatile("" ::: "memory");
        if (TID == 0) (void)__hip_atomic_fetch_add((__attribute__((address_space(1))) unsigned*)(flg + u.pm * 16), 1u, __ATOMIC_RELAXED, __HIP_MEMORY_SCOPE_AGENT); } };
struct MoeCons : MoeOrder { unsigned* flg; unsigned* tmo;
    __device__ __forceinline__ void a_ready(const pg8::Unit& u) const {
        if ((TID >> 6) == 0) { unsigned sp = 0u; __attribute__((address_space(1))) unsigned* f = (__attribute__((address_space(1))) unsigned*)(flg + u.pm * 16);
            while ((unsigned)__builtin_amdgcn_readfirstlane((int)__hip_atomic_load(f, __ATOMIC_RELAXED, __HIP_MEMORY_SCOPE_AGENT)) < (unsigned)(2 * FF / 256)) {
                __builtin_amdgcn_s_sleep(1);
                if ((++sp & 255u) == 0u) { if (__hip_atomic_load((__attribute__((address_space(1))) unsigned*)tmo, __ATOMIC_RELAXED, __HIP_MEMORY_SCOPE_AGENT)) break;
                    if (sp > (1u << 22)) { (void)__hip_atomic_fetch_add((__attribute__((address_space(1))) unsigned*)tmo, 1u, __ATOMIC_RELAXED, __HIP_MEMORY_SCOPE_AGENT); break; } } }
            __builtin_amdgcn_fence(__ATOMIC_ACQUIRE, "agent"); }
        asm volatile("" ::: "memory"); __builtin_amdgcn_s_barrier(); asm volatile("" ::: "memory"); } };
DEV void moe_fused_phase(const Args& a, unsigned char* smem, int l) {
    unsigned char* ws = wsp(a); const int* cnt = (const int*)(ws + WS_CNT) + l * 32 * 64;
    int* rb = (int*)(smem + 140 * 1024);
    moe_bases(cnt, rb);
    const int mrows = rb[32]; unsigned* flg = (unsigned*)(ws + WS_FLG) + (size_t)l * 256 * 16;
    { pg8::Gemm g{(const bf16*)(ws + WS_H), (const bf16*)(ws + WS_W13) + (size_t)l * 32 * 2 * FF * DM, mrows, 2 * FF, DM}; MoeProd S; S.init(mrows >> 8, 2 * FF / 256, NBLK, BID, false); S.flg = flg;
      EpiMoe1_8 E{(bf16*)(ws + WS_ACT)}; MoeSel<true> X{rb, cnt, (const int*)(ws + WS_LIST), (size_t)2 * FF * DM * 2};
      SYNC(); pg8::gemm_phase<EpiMoe1_8, MoeProd, true, true, MoeSel<true>>(PG8_LDS(smem), g, S, E, X); }
    { pg8::Gemm g{(const bf16*)(ws + WS_ACT), (const bf16*)(ws + WS_W2) + (size_t)l * 32 * DM * FF, mrows, DM, FF}; MoeCons S; S.init(mrows >> 8, DM / 256, NBLK, BID, true); S.flg = flg; S.tmo = (unsigned*)(ws + WS_BAR) + MOE_TMO_IDX;
      EpiMoe2_8 E{(bf16*)(ws + WS_YK)}; MoeSel<false> X{rb, cnt, (const int*)(ws + WS_LIST), (size_t)DM * FF * 2};
      SYNC(); pg8::gemm_phase<EpiMoe2_8, MoeCons, true, true, MoeSel<false>>(PG8_LDS(smem), g, S, E, X); SYNC(); }
}
#endif
DEV void moe_gemm_phase(const Args& a, unsigned char* smem, int l, int mode) {
    unsigned char* ws = wsp(a); const int* cnt = (const int*)(ws + WS_CNT) + l * 32 * 64;
    int* rb = (int*)(smem + GEMM2_LDS);
    moe_bases(cnt, rb);
    const int ntile = rb[32] >> 8;
    constexpr int TN1 = 2 * FF / 128, TN2 = DM / 128;
    const int TN = mode == 0 ? TN1 : TN2;
    const int* list = (const int*)(ws + WS_LIST);
    for (int it = vbid(); it < ntile * TN; it += NBLK) {
        const int rt = it / TN, tn = it % TN; int e = 0;
#pragma unroll 1
        for (int q = 1; q < 32; ++q) if ((rb[q] >> 8) <= rt) e = q;
        const int rloc = (rt << 8) - rb[e], ce = cnt[e * 64], nvalid = (ce - rloc) < 256 ? (ce - rloc) : 256;
        if (mode == 0) {
            struct AF { const bf16* base; const int* lst; int nv; MDEV unsigned off(int r) const { const int rr = r < nv ? r : nv - 1; return (unsigned)lst[rr] * (unsigned)DM; } }
                af{(const bf16*)(ws + WS_H), list + (size_t)e * T + rloc, nvalid};
            EpiGated<1> E{(bf16*)(ws + WS_ACT), (size_t)FF, rt << 8, tn * 128, nvalid};
            BInter bf{INP(a, I_W1) + (size_t)(l * 32 + e) * DM * FF, INP(a, I_W3) + (size_t)(l * 32 + e) * DM * FF, tn * 128};
            gemm_tile2(smem, af, bf, FF, DM, E);
        } else {
            ARows af{(const bf16*)(ws + WS_ACT) + (size_t)(rt << 8) * FF, (size_t)FF};
            EpiStoreBf E{(bf16*)(ws + WS_YK), (size_t)DM, rt << 8, tn * 128, nvalid};
            BPlain bf{INP(a, I_W2) + (size_t)(l * 32 + e) * FF * DM + tn * 128};
            gemm_tile2(smem, af, bf, DM, FF, E);
        }
    }
}

constexpr int LDV = 80;
constexpr int AT_K = 0, AT_V = 2 * 64 * LDT * 2, AT_IMP = AT_V + 2 * 64 * LDV * 2, AT_SEL = AT_IMP + 8 * 8 * 128 * 4, AT_GSEL = AT_SEL + 8 * 8 * 4 * 4, AT_OUT = AT_GSEL + 8 * 2 * 4 * 4, AT_END = AT_OUT + 8 * 32 * 64 * 4;
#ifdef EMU
DEV float rexp2(float x) { return exp2f(x); }
DEV unsigned uni(unsigned x) { return x; }
#else
DEV float rexp2(float x) { return __builtin_amdgcn_exp2f(x); }
DEV unsigned uni(unsigned x) { return (unsigned)__builtin_amdgcn_readfirstlane((int)x); }
#endif
DEV int krow_lds(int kappa) { return 16 * (2 * (kappa >> 5) + ((kappa >> 2) & 1)) + 4 * ((kappa >> 3) & 3) + (kappa & 3); }
template <int MASK, bool FULL, int GM>
DEV void attn_block(const bf16* Kp, const bf16* Vp, const bf16x8 (&qf)[2][2], int j, const int (&s)[2], const bool (&selbit)[2], float C2, int h, int c,
                    f32x4 (&O)[2][4], f32x4 (&Ol)[2]) {
    f32x4 st[2][2][2];
#pragma unroll
    for (int sp = 0; sp < 2; ++sp)
#pragma unroll
        for (int u = 0; u < 2; ++u) {
#pragma unroll
            for (int G = 0; G < 2; ++G) { st[G][sp][u][0] = -C2; st[G][sp][u][1] = -C2; st[G][sp][u][2] = -C2; st[G][sp][u][3] = -C2; }
#pragma unroll
            for (int ks = 0; ks < 2; ++ks) { const bf16x8 kf = *(const bf16x8*)(Kp + (16 * (2 * sp + u) + c) * LDT + 32 * ks + 8 * h);
#pragma unroll
                for (int G = 0; G < 2; ++G) if (GM & (1 << G)) st[G][sp][u] = mfma16(kf, qf[G][ks], st[G][sp][u]); } }
#pragma unroll
    for (int G = 0; G < 2; ++G) if (GM & (1 << G))
#pragma unroll
        for (int sp = 0; sp < 2; ++sp)
#pragma unroll
            for (int u = 0; u < 2; ++u)
#pragma unroll
                for (int r = 0; r < 4; ++r) { bool ok = selbit[G];
                    if (!FULL) { const int key = 64 * j + 32 * sp + 8 * h + 4 * u + r;
                        if (MASK == 0) ok = 16 * key + 31 <= s[G]; else if (MASK == 1) ok = selbit[G] && key <= s[G]; else ok = key <= s[G] && key > s[G] - 512; }
                    st[G][sp][u][r] = ok ? rexp2(st[G][sp][u][r]) : 0.f; }
    bf16x8 pb[2][2], ones;
#pragma unroll
    for (int q = 0; q < 8; ++q) ones[q] = (short)0x3F80;
#pragma unroll
    for (int G = 0; G < 2; ++G) if (GM & (1 << G))
#pragma unroll
        for (int sp = 0; sp < 2; ++sp) { pb[G][sp] = pack8(st[G][sp][0], st[G][sp][1]); Ol[G] = mfma16(ones, pb[G][sp], Ol[G]); }
    const bf16* Vb = Vp + bperm(8 * h + (c >> 2)) * LDV + 4 * (c & 3);
#pragma unroll
    for (int et = 0; et < 4; ++et)
#pragma unroll
        for (int sp = 0; sp < 2; ++sp) { const bf16x8 vf = tr_read8(Vb + (32 * sp) * LDV + 16 * et, Vb + (32 * sp + 8) * LDV + 16 * et);
#pragma unroll
            for (int G = 0; G < 2; ++G) if (GM & (1 << G)) O[G][et] = mfma16(vf, pb[G][sp], O[G][et]); }
}

struct ImpState { float invq[2][4]; float carry[2]; float* imps; int tl, hd, l, s0, qblk; };
DEV void imp_block(const bf16* Kp, const bf16x8 (&qf)[2][2], int j, int s0, int w, float C2, int h, int c, ImpState& im) {
#pragma unroll
    for (int kt = 0; kt < 4; ++kt) {
        const int row = krow_lds(16 * kt + c);
        const bf16x8 k0 = *(const bf16x8*)(Kp + row * LDT + 8 * h), k1 = *(const bf16x8*)(Kp + row * LDT + 32 + 8 * h);
        const int n = 64 * j + 16 * kt + c;
#pragma unroll
        for (int G = 0; G < 2; ++G) {
            f32x4 acc; acc[0] = -C2; acc[1] = -C2; acc[2] = -C2; acc[3] = -C2;
            acc = mfma16(qf[G][0], k0, acc); acc = mfma16(qf[G][1], k1, acc);
            const bool ok = 16 * n + 31 <= s0 + 8 * w + 4 * G + h;
            float imp = 0.f;
#pragma unroll
            for (int r = 0; r < 4; ++r) imp += ok ? rexp2(acc[r]) * im.invq[G][r] : 0.f;
            const float v = ((c & 3) == 3) ? imp : 2.0f * imp;
            float sq = v + shflx(v, 1); sq += shflx(sq, 2);
            const float rr = dpp_ror1(imp);
            const float prev = (c == 0) ? im.carry[G] : rr;
            im.carry[G] = rr;
            const int m = n >> 2;
            if ((c & 3) == 0 && m < 128) im.imps[(G * 4 + h) * 128 + m] = sq + prev;
        }
    }
}

template <int MODE>
DEV void attn_branch(bf16* Kl, bf16* Vl, const bf16* kbase, const bf16* vbase, int jlo, int jhi,
                     const bf16x8 (&qf)[2][2], const int (&s)[2], const unsigned* selm, const unsigned* gselm, float C2, int w, int h, int c, int srow, int scol,
                     f32x4 (&O)[2][4], f32x4 (&Ol)[2], ImpState& im) {
    constexpr bool PV = MODE != 1; constexpr int MASK = MODE <= 1 ? 0 : MODE - 1;
    const int krow = krow_lds(srow) * LDT + scol, vrow = bperm(srow) * LDV + scol;
    bf16x8 rk[3], rv[3];
    { const bf16x8 k0 = *(const bf16x8*)(kbase + (size_t)jlo * 4096); *(bf16x8*)(Kl + krow) = k0;
      if (PV) { const bf16x8 v0 = *(const bf16x8*)(vbase + (size_t)jlo * 4096); *(bf16x8*)(Vl + vrow) = v0; } }
#pragma unroll
    for (int u = 0; u < 3; ++u) { int jj = jlo + 1 + u; if (jj > jhi) jj = jhi; rk[(1 + u) % 3] = *(const bf16x8*)(kbase + (size_t)jj * 4096); if (PV) rv[(1 + u) % 3] = *(const bf16x8*)(vbase + (size_t)jj * 4096); }
    SYNC();
    for (int jb = jlo; jb <= jhi; jb += 3) {
#pragma unroll
        for (int u = 0; u < 3; ++u) { const int j = jb + u;
            if (j <= jhi) {
                const int cur = (j - jlo) & 1;
                const bf16* Kc = Kl + cur * 64 * LDT; const bf16* Vc = Vl + cur * 64 * LDV;
                if (MODE == 1) imp_block(Kc, qf, j, im.s0, w, C2, h, c, im);
                else {
                    bool sb[2] = {true, true}; unsigned gm = 3u;
                    if (MODE == 2) { gm = 0u;
#pragma unroll
                        for (int G = 0; G < 2; ++G) { const unsigned wq = uni(gselm[G * 4 + (j >> 5)]), mq = selm[(G * 4 + im.tl) * 4 + (j >> 5)];
                            gm |= ((wq >> (j & 31)) & 1u) << G; sb[G] = (mq >> (j & 31)) & 1u; } }
                    bool full;
                    if (MODE == 0) full = 1024 * j + 1039 <= im.s0; else if (MODE == 2) full = j < im.qblk; else full = (j < im.qblk) && (64 * j > im.s0 + 63 - 512);
                    if (MODE == 2) {
                        if (full) { if (gm == 3u) attn_block<MASK, true, 3>(Kc, Vc, qf, j, s, sb, C2, h, c, O, Ol); else if (gm == 1u) attn_block<MASK, true, 1>(Kc, Vc, qf, j, s, sb, C2, h, c, O, Ol); else if (gm == 2u) attn_block<MASK, true, 2>(Kc, Vc, qf, j, s, sb, C2, h, c, O, Ol); }
                        else { if (gm == 3u) attn_block<MASK, false, 3>(Kc, Vc, qf, j, s, sb, C2, h, c, O, Ol); else if (gm == 1u) attn_block<MASK, false, 1>(Kc, Vc, qf, j, s, sb, C2, h, c, O, Ol); else if (gm == 2u) attn_block<MASK, false, 2>(Kc, Vc, qf, j, s, sb, C2, h, c, O, Ol); }
                    } else { if (full) attn_block<MASK, true, 3>(Kc, Vc, qf, j, s, sb, C2, h, c, O, Ol); else attn_block<MASK, false, 3>(Kc, Vc, qf, j, s, sb, C2, h, c, O, Ol); }
                }
                if (j + 1 <= jhi) {
                    *(bf16x8*)(Kl + (cur ^ 1) * 64 * LDT + krow) = rk[(u + 1) % 3]; if (PV) *(bf16x8*)(Vl + (cur ^ 1) * 64 * LDV + vrow) = rv[(u + 1) % 3];
                    int jj = j + 4; if (jj > jhi) jj = jhi;
                    rk[(u + 1) % 3] = *(const bf16x8*)(kbase + (size_t)jj * 4096); if (PV) rv[(u + 1) % 3] = *(const bf16x8*)(vbase + (size_t)jj * 4096);
                }
                SYNC();
            }
        }
    }
}

DEV void attn_task(const Args& a, unsigned char* smem, int li, int item) {
    unsigned char* ws = wsp(a); const int tid = TID, w = tid >> 6, l = tid & 63, h = l >> 4, c = l & 15, tl = c >> 2, hd = c & 3;
    const int bg = item & 3, b = bg >> 1, g = bg & 1, tq = (SEQ / 64 - 1) - (item >> 2), s0 = tq * 64, qblk = tq;
    int s[2], row[2];
#pragma unroll
    for (int G = 0; G < 2; ++G) { s[G] = s0 + 8 * w + 4 * G + tl; row[G] = b * SEQ + s[G]; }
    bf16* Kl = (bf16*)(smem + AT_K); bf16* Vl = (bf16*)(smem + AT_V); float* imps = (float*)(smem + AT_IMP) + w * 1024; unsigned* selm = (unsigned*)(smem + AT_SEL) + w * 32;
    bf16x8 qf[2][2]; float gatec[2], gates[2], gatew[2];
#pragma unroll
    for (int G = 0; G < 2; ++G) { const bf16* qp = (const bf16*)(ws + WS_QN) + (size_t)row[G] * 512 + (g * 4 + hd) * 64 + 8 * h; qf[G][0] = *(const bf16x8*)qp; qf[G][1] = *(const bf16x8*)(qp + 32);
        const float* gp = (const float*)(ws + WS_GATE) + (size_t)row[G] * 24 + (g * 4 + hd) * 3; gatec[G] = gp[0]; gates[G] = gp[1]; gatew[G] = gp[2]; }
    const float* cs = (const float*)(ws + WS_CS) + li * 4;
    const int srow = tid >> 3, scol = (tid & 7) * 8;
    for (int i = l; i < 1024; i += 64) imps[i] = 0.f;
    SYNC();
    unsigned* gselm = (unsigned*)(smem + AT_GSEL) + w * 8; float* outl = (float*)(smem + AT_OUT) + w * 2048 + l;
    ImpState im{{{0.f, 0.f, 0.f, 0.f}, {0.f, 0.f, 0.f, 0.f}}, {0.f, 0.f}, imps, tl, hd, l, s0, qblk};
    {
        const int ncv = s0 / 16 + 3, ncb0 = (ncv + 63) >> 6, ncb = ncb0 > NCP / 64 ? NCP / 64 : ncb0;
        const bf16* kcb = (const bf16*)(ws + WS_KC) + (size_t)bg * NCP * 64 + tid * 8;
        const bf16* vcb = (const bf16*)(ws + WS_VCT) + (size_t)bg * NCP * 64 + tid * 8;
        f32x4 O[2][4], Ol[2] = {f4zero(), f4zero()};
#pragma unroll
        for (int G = 0; G < 2; ++G)
#pragma unroll
            for (int et = 0; et < 4; ++et) O[G][et] = f4zero();
        attn_branch<0>(Kl, Vl, kcb, vcb, 0, ncb - 1, qf, s, selm, gselm, cs[0], w, h, c, srow, scol, O, Ol, im);
#pragma unroll
        for (int G = 0; G < 2; ++G) { const float lsum = Ol[G][0]; const float invl = lsum > 0.f ? 1.0f / lsum : 0.f;
#pragma unroll
            for (int r = 0; r < 4; ++r) im.invq[G][r] = shfl(invl, 4 * h + r);
#pragma unroll
            for (int et = 0; et < 4; ++et)
#pragma unroll
                for (int r = 0; r < 4; ++r) outl[((G * 4 + et) * 4 + r) * 64] = gatec[G] * invl * O[G][et][r]; }
        f32x4 ld[2] = {f4zero(), f4zero()};
        attn_branch<1>(Kl, Vl, kcb, vcb, 0, ncb - 1, qf, s, selm, gselm, cs[0], w, h, c, srow, scol, O, ld, im);
    }
    WSYNC();
#pragma unroll 1
    for (int G = 0; G < 2; ++G) {
        const int tk = l >> 4, i = l & 15; float vals[8];
#pragma unroll
        for (int mm = 0; mm < 8; ++mm) { const int jj = i + 16 * mm; vals[mm] = jj > qblk ? NEGV : ((jj == 0 || jj == qblk || jj == qblk - 1) ? FORCEV : imps[(G * 4 + tk) * 128 + jj]); }
        unsigned mk[4] = {0u, 0u, 0u, 0u};
#pragma unroll 1
        for (int rnd = 0; rnd < 16; ++rnd) {
            float best = vals[0]; int bj = i;
#pragma unroll
            for (int mm = 1; mm < 8; ++mm) if (vals[mm] > best) { best = vals[mm]; bj = i + 16 * mm; }
#pragma unroll
            for (int o = 1; o < 16; o <<= 1) { const float ov = shflx(best, o); const int oj = shflxi(bj, o); if (ov > best || (ov == best && oj < bj)) { best = ov; bj = oj; } }
            if (best > NEGV * 0.5f) {
#pragma unroll
                for (int q = 0; q < 4; ++q) if ((bj >> 5) == q) mk[q] |= 1u << (bj & 31); }
            if ((bj & 15) == i) {
#pragma unroll
                for (int mm = 0; mm < 8; ++mm) if ((bj >> 4) == mm) vals[mm] = -3e38f; }
        }
        if (i == 0) {
#pragma unroll
            for (int q = 0; q < 4; ++q) selm[(G * 4 + tk) * 4 + q] = mk[q]; }
    }
    WSYNC();
    if (l < 8) { const int G = l >> 2, q = l & 3; gselm[l] = selm[(G * 4 + 0) * 4 + q] | selm[(G * 4 + 1) * 4 + q] | selm[(G * 4 + 2) * 4 + q] | selm[(G * 4 + 3) * 4 + q]; }
    WSYNC();
#pragma unroll
    for (int br = 0; br < 2; ++br) {
        const bf16* kb = (const bf16*)(ws + (br == 0 ? WS_KS : WS_KW)) + (size_t)bg * SEQ * 64 + tid * 8; const bf16* vb = (const bf16*)(ws + (br == 0 ? WS_VST : WS_VWT)) + (size_t)bg * SEQ * 64 + tid * 8;
        f32x4 O[2][4], Ol[2] = {f4zero(), f4zero()};
#pragma unroll
        for (int G = 0; G < 2; ++G)
#pragma unroll
            for (int et = 0; et < 4; ++et) O[G][et] = f4zero();
        if (br == 0) attn_branch<2>(Kl, Vl, kb, vb, 0, qblk, qf, s, selm, gselm, cs[1], w, h, c, srow, scol, O, Ol, im);
        else attn_branch<3>(Kl, Vl, kb, vb, s0 >= 511 ? (s0 - 511) >> 6 : 0, qblk, qf, s, selm, gselm, cs[2], w, h, c, srow, scol, O, Ol, im);
#pragma unroll
        for (int G = 0; G < 2; ++G) { const float lsum = Ol[G][0]; const float sc = (br == 0 ? gates[G] : gatew[G]) * (lsum > 0.f ? 1.0f / lsum : 0.f);
#pragma unroll
            for (int et = 0; et < 4; ++et)
#pragma unroll
                for (int r = 0; r < 4; ++r) outl[((G * 4 + et) * 4 + r) * 64] += sc * O[G][et][r]; }
    }
#pragma unroll
    for (int G = 0; G < 2; ++G) { bf16* dst = (bf16*)(ws + WS_CAT) + (size_t)row[G] * 1024 + (g * 4 + hd) * 64 + 4 * h;
#pragma unroll
        for (int et = 0; et < 4; ++et) { f32x4 o;
#pragma unroll
            for (int r = 0; r < 4; ++r) o[r] = outl[((G * 4 + et) * 4 + r) * 64];
            st_bf4(dst + 16 * et, o); } }
}

constexpr int LDH = 136;
DEV void hg_cumsum(const float* fsrc  , float* segs  , int d, int seg, float (&f)[16], float (&bc)[16], float& bend, float& bmid) {
    float run = 0.f;
#pragma unroll
    for (int i = 0; i < 16; ++i) { f[i] = fsrc[(size_t)(16 * seg + i) * 128 + d]; run += log2f(f[i]); bc[i] = run; }
    SYNC();
    segs[seg * 128 + d] = run;
    SYNC();
    const float s0 = segs[d], s1 = segs[128 + d], s2 = segs[256 + d], s3 = segs[384 + d];
    const float off = seg == 0 ? 0.f : (seg == 1 ? s0 : (seg == 2 ? s0 + s1 : s0 + s1 + s2));
#pragma unroll
    for (int i = 0; i < 16; ++i) bc[i] += off;
    bend = s0 + s1 + s2 + s3; bmid = s0 + s1;
}
DEV void hg_write16(bf16* dstrow  , const float (&v)[16]) {
    u32x4 w0, w1;
#pragma unroll
    for (int q = 0; q < 4; ++q) { w0[q] = pk2(v[2 * q], v[2 * q + 1]); w1[q] = pk2(v[8 + 2 * q], v[8 + 2 * q + 1]); }
    *(u32x4*)dstrow = w0; *(u32x4*)(dstrow + 8) = w1;
}
DEV void hg_h1_task(const Args& a, unsigned char* smem, int task) {
    unsigned char* ws = wsp(a); const int tid = TID, w = tid >> 6, l = tid & 63, h = l >> 4, c = l & 15, d = tid & 127, seg = tid >> 7;
    const int bh = task / NCH, ch = task % NCH;
    bf16* kT = (bf16*)smem; bf16* vT = kT + 128 * LDT; float* segs = (float*)(vT + 128 * LDT);
    const size_t tokb = (size_t)bh * SEQ + ch * 64;
    float f[16], bc[16], bend, bmid;
    const bf16* vs = (const bf16*)(ws + WS_HV) + tokb * 128;
    bf16 vraw[16];
#pragma unroll
    for (int i = 0; i < 16; ++i) vraw[i] = vs[(size_t)(16 * seg + i) * 128 + d];
    hg_cumsum((const float*)(ws + WS_HF) + tokb * 128, segs, d, seg, f, bc, bend, bmid);
    float kv[16];
#pragma unroll
    for (int i = 0; i < 16; ++i) kv[i] = (1.0f - f[i]) * fexp2(bend - bc[i]);
    hg_write16(kT + d * LDT + 16 * seg, kv);
#pragma unroll
    for (int i = 0; i < 16; ++i) kv[i] = bf2f(vraw[i]);
    hg_write16(vT + d * LDT + 16 * seg, kv);
    if (seg == 0) ((float*)(ws + WS_GD))[((size_t)bh * NCH + ch) * 128 + d] = fexp2(bend);
    SYNC();
    f32x4 acc[8];
#pragma unroll
    for (int et = 0; et < 8; ++et) acc[et] = f4zero();
#pragma unroll
    for (int ks = 0; ks < 2; ++ks) { const bf16x8 fa = *(const bf16x8*)(kT + (16 * w + c) * LDT + 32 * ks + 8 * h);
#pragma unroll
        for (int et = 0; et < 8; ++et) acc[et] = mfma16(fa, *(const bf16x8*)(vT + (16 * et + c) * LDT + 32 * ks + 8 * h), acc[et]); }
    float* ut = (float*)(ws + WS_UT) + ((size_t)bh * NCH + ch) * 16384;
#pragma unroll
    for (int et = 0; et < 8; ++et) *(f32x4*)(ut + (size_t)(16 * et + c) * 128 + 16 * w + 4 * h) = acc[et];
    SYNC();
}
DEV void hg_scan_task(const Args& a, int sc) {
    unsigned char* ws = wsp(a); const int bh = sc >> 3, q = (sc & 7) * 512 + TID, e = q >> 5, d0 = (q & 31) * 4;
    const float* ut = (const float*)(ws + WS_UT) + (size_t)bh * NCH * 16384 + (size_t)e * 128 + d0;
    const float* gd = (const float*)(ws + WS_GD) + (size_t)bh * NCH * 128 + d0;
    bf16* st = (bf16*)(ws + WS_ST) + (size_t)bh * NCH * 16384 + (size_t)e * 128 + d0;
    f32x4 S = f4zero();
#pragma unroll 4
    for (int ch = 0; ch < NCH; ++ch) { st_bf4(st + (size_t)ch * 16384, S);
        const f32x4 g = *(const f32x4*)(gd + (size_t)ch * 128), u = *(const f32x4*)(ut + (size_t)ch * 16384);
#pragma unroll
        for (int r = 0; r < 4; ++r) S[r] = g[r] * S[r] + u[r]; }
}
DEV void hg_h3_task(const Args& a, unsigned char* smem, int li, int task) {
    unsigned char* ws = wsp(a); const int tid = TID, w = tid >> 6, l = tid & 63, h = l >> 4, c = l & 15, d = tid & 127, seg = tid >> 7;
    const int bh = task / NCH, ch = task % NCH, b = bh >> 2, hh = bh & 3;
    bf16* At = (bf16*)smem; bf16* Bt = At + 64 * LDH; bf16* Qt = Bt + 64 * LDH; bf16* vT = Qt + 64 * LDH; float* segs = (float*)(vT + 128 * LDT); float* part = segs + 512;
    const size_t tokb = (size_t)bh * SEQ + ch * 64;
    float f[16], bc[16], bend, bmid;
    const bf16* qs = (const bf16*)(ws + WS_HQ) + tokb * 128; const bf16* vs = (const bf16*)(ws + WS_HV) + tokb * 128;
    const int tt = w & 3, eh = w >> 2;
    bf16 qraw[16], vraw[16];
#pragma unroll
    for (int i = 0; i < 16; ++i) { const int t = 16 * seg + i; qraw[i] = qs[(size_t)t * 128 + d]; vraw[i] = vs[(size_t)t * 128 + d]; }
    const bf16* stp = (const bf16*)(ws + WS_ST) + ((size_t)bh * NCH + ch) * 16384;
    bf16x8 stf[4][4];
#pragma unroll
    for (int ks = 0; ks < 4; ++ks)
#pragma unroll
        for (int et = 0; et < 4; ++et) stf[ks][et] = *(const bf16x8*)(stp + (size_t)(64 * eh + 16 * et + c) * 128 + 32 * ks + 8 * h);
    const int tok = b * SEQ + ch * 64 + 16 * tt + c;
    const bf16* hg = (const bf16*)(ws + WS_HGS) + (size_t)tok * 512 + hh * 128;
    u32x2 hgv[4];
#pragma unroll
    for (int et = 0; et < 4; ++et) hgv[et] = *(const u32x2*)(hg + 64 * eh + 16 * et + 4 * h);
    hg_cumsum((const float*)(ws + WS_HF) + tokb * 128, segs, d, seg, f, bc, bend, bmid);
    float vv[16];
#pragma unroll
    for (int i = 0; i < 16; ++i) { const int t = 16 * seg + i; const float q = bf2f(qraw[i]);
        At[t * LDH + d] = (bf16)f2bf(q * fexp2(bc[i] - bmid)); Bt[t * LDH + d] = (bf16)f2bf((1.0f - f[i]) * fexp2(bmid - bc[i])); Qt[t * LDH + d] = (bf16)f2bf(q * fexp2(bc[i]));
        vv[i] = bf2f(vraw[i]); }
    hg_write16(vT + d * LDT + 16 * seg, vv);
    SYNC();
    f32x4 O[4];
#pragma unroll
    for (int et = 0; et < 4; ++et) O[et] = f4zero();
#pragma unroll
    for (int sp = 0; sp < 2; ++sp) {
        if (32 * sp > 16 * tt + 15) continue;
        f32x4 st[2];
#pragma unroll
        for (int u = 0; u < 2; ++u) { st[u] = f4zero(); const int krow = 32 * sp + 8 * (c >> 2) + 4 * u + (c & 3);
#pragma unroll
            for (int ks = 0; ks < 4; ++ks) st[u] = mfma16(*(const bf16x8*)(Bt + krow * LDH + 32 * ks + 8 * h), *(const bf16x8*)(At + (16 * tt + c) * LDH + 32 * ks + 8 * h), st[u]);
#pragma unroll
            for (int r = 0; r < 4; ++r) { const int sk = 32 * sp + 8 * h + 4 * u + r; if (sk > 16 * tt + c) st[u][r] = 0.f; } }
        const bf16x8 pb = pack8(st[0], st[1]);
#pragma unroll
        for (int et = 0; et < 4; ++et) O[et] = mfma16(*(const bf16x8*)(vT + (64 * eh + 16 * et + c) * LDT + 32 * sp + 8 * h), pb, O[et]);
    }
#pragma unroll
    for (int ks = 0; ks < 4; ++ks) { const bf16x8 fq = *(const bf16x8*)(Qt + (16 * tt + c) * LDH + 32 * ks + 8 * h);
#pragma unroll
        for (int et = 0; et < 4; ++et) O[et] = mfma16(stf[ks][et], fq, O[et]); }
    float ss = 0.f;
#pragma unroll
    for (int et = 0; et < 4; ++et)
#pragma unroll
        for (int r = 0; r < 4; ++r) ss += O[et][r] * O[et][r];
    ss += shflx(ss, 16); ss += shflx(ss, 32);
    if (h == 0) part[eh * 64 + 16 * tt + c] = ss;
    SYNC();
    const float rs = frsq((part[16 * tt + c] + part[64 + 16 * tt + c]) * (1.0f / 128.0f) + EPS);
    const float* og = INP(a, I_OG) + li * 128;
    bf16* dst = (bf16*)(ws + WS_CAT) + (size_t)tok * 1024 + 512 + hh * 128;
#pragma unroll
    for (int et = 0; et < 4; ++et) { const int e = 64 * eh + 16 * et + 4 * h; f32x4 o; const f32x4 ogv = *(const f32x4*)(og + e);
        o[0] = O[et][0] * rs * ogv[0] * bf2f(hgv[et][0] & 0xffff); o[1] = O[et][1] * rs * ogv[1] * bf2f(hgv[et][0] >> 16);
        o[2] = O[et][2] * rs * ogv[2] * bf2f(hgv[et][1] & 0xffff); o[3] = O[et][3] * rs * ogv[3] * bf2f(hgv[et][1] >> 16);
        st_bf4(dst + e, o); }
    SYNC();
}

DEV void conv_task(const Args& a, unsigned char* smem, int li, int task) {
    unsigned char* ws = wsp(a); const int tid = TID, w = tid >> 6, lane = tid & 63;
    const bool act = tid < DM / 2; const int c0 = act ? 2 * tid : 0;
    const int t0 = task * 16, b = t0 / SEQ, s0 = t0 % SEQ;
    float* red = (float*)smem;
    const float* dw = INP(a, I_DW) + (size_t)li * 31 * DM + c0;
    float acc[16][2];
    const float b0 = INP(a, I_DWB)[li * DM + c0], b1 = INP(a, I_DWB)[li * DM + c0 + 1];
#pragma unroll
    for (int t = 0; t < 16; ++t) { acc[t][0] = b0; acc[t][1] = b1; }
    const bf16* glu = (const bf16*)(ws + WS_GLU) + (size_t)b * SEQ * DM + c0;
    unsigned uu[46];
    { const bf16* gp = glu + (size_t)(s0 - 30) * DM;
#pragma unroll
    for (int r = 0; r < 46; ++r) { const int si = s0 + r - 30; uu[r] = si >= 0 ? *(const unsigned*)gp : 0u; gp += DM; OPAQUE(gp); } }
    const float* dwp = dw;
#pragma unroll
    for (int j = 0; j < 31; ++j) { const float w0 = dwp[0], w1 = dwp[1]; dwp += DM; OPAQUE(dwp);
#pragma unroll
        for (int t = 0; t < 16; ++t) { const unsigned q = uu[t + j]; acc[t][0] += w0 * bf2f(q & 0xffff); acc[t][1] += w1 * bf2f(q >> 16); } }
    float mean[16], rstd[16];
    SYNC();
#pragma unroll
    for (int t = 0; t < 16; ++t) { float s = act ? acc[t][0] + acc[t][1] : 0.f;
#pragma unroll
        for (int o = 1; o < 64; o <<= 1) s += shflx(s, o);
        if (lane == 0) red[w * 16 + t] = s; }
    SYNC();
#pragma unroll
    for (int t = 0; t < 16; ++t) { float s = 0.f;
#pragma unroll
        for (int q = 0; q < 8; ++q) s += red[q * 16 + t];
        mean[t] = s * (1.0f / DM); }
    SYNC();
#pragma unroll
    for (int t = 0; t < 16; ++t) { const float d0 = acc[t][0] - mean[t], d1 = acc[t][1] - mean[t]; float s = act ? d0 * d0 + d1 * d1 : 0.f;
#pragma unroll
        for (int o = 1; o < 64; o <<= 1) s += shflx(s, o);
        if (lane == 0) red[w * 16 + t] = s; }
    SYNC();
#pragma unroll
    for (int t = 0; t < 16; ++t) { float s = 0.f;
#pragma unroll
        for (int q = 0; q < 8; ++q) s += red[q * 16 + t];
        rstd[t] = frsq(s * (1.0f / DM) + EPS); }
    if (act) {
        const float g0 = INP(a, I_LNG)[li * DM + c0], g1 = INP(a, I_LNG)[li * DM + c0 + 1], e0 = INP(a, I_LNB)[li * DM + c0], e1 = INP(a, I_LNB)[li * DM + c0 + 1];
        bf16* dst = (bf16*)(ws + WS_CAT) + (size_t)t0 * DM + c0;
#pragma unroll
        for (int t = 0; t < 16; ++t) { const float y0 = (acc[t][0] - mean[t]) * rstd[t] * g0 + e0, y1 = (acc[t][1] - mean[t]) * rstd[t] * g1 + e1;
            *(unsigned*)(dst + (size_t)t * DM) = pk2(siluf(y0), siluf(y1)); }
    }
}

constexpr int N_PHASES = 1 + 16 * (DEPTH / 2) + 1;
DEV void phase_decode(int ph, int& l, int& sub) {
    const int q = ph - 1, pair = q >> 4, r = q & 15;
    if (r < 9) { l = 2 * pair; sub = r; } else { l = 2 * pair + 1; const int rr = r - 9; sub = rr < 3 ? rr : rr + 2; }
}
constexpr int LDS_BYTES = 150 * 1024;

DEV void run_phase(const Args& a, unsigned char* smem, int ph) {
#ifndef ONLY
#define ONLY -1
#endif
#define EN(k) (ONLY < 0 || ONLY == (k))
    if (ph == 0) { if (EN(100)) p0_phase(a, smem); return; }
    if (ph == N_PHASES - 1) { if (EN(0)) norm_phase(a, smem, DEPTH); return; }
    int l, sub; phase_decode(ph, l, sub); const int li = l >> 1; const bool even = (l & 1) == 0;
    unsigned char* ws = wsp(a);
    switch (sub) {
    case 0: if (EN(0)) norm_phase(a, smem, l); break;
    case 1: if (even) { if (EN(1)) inproj_phase(a, smem, li); } else { if (EN(11)) pw1_phase(a, smem, li); } break;
    case 2:
        if (even) { constexpr int NCI = 8 * ((NCP + 255) / 256); constexpr int NH1 = 8 * NCH;
            if (NBLK > 2 * NCI) { const int bid = BID;
                if (bid < NCI) { if (EN(2)) cmp_phase_items(a, smem, li, bid); }
                else { for (int it = bid - NCI; it < NH1; it += NBLK - NCI) if (EN(12)) hg_h1_task(a, smem, it); } }
            else for (int it = BID; it < NCI + NH1; it += NBLK) { if (it < NCI) { if (EN(2)) cmp_phase_items(a, smem, li, it); } else { if (EN(12)) hg_h1_task(a, smem, it - NCI); } } }
        else { for (int it = BID; it < T / 16; it += NBLK) if (EN(13)) conv_task(a, smem, li, it); }
        break;
    case 3:
        if (even) { constexpr int NA = 4 * (SEQ / 64); const int G = NBLK;
            for (int r = 0; r * G < NA; ++r) { const int it = r * G + ((r & 1) ? (G - 1 - BID) : BID); if (it < NA) { if (EN(3)) attn_task(a, smem, li, it); } }
            for (int it = BID; it < 64; it += NBLK) if (EN(14)) hg_scan_task(a, it); }
        break;
    case 4: if (even) { for (int it = BID; it < 8 * NCH; it += NBLK) if (EN(4)) hg_h3_task(a, smem, li, it); } break;
    case 5:
        if (!EN(5)) break;
        if (even) resid_gemm_phase(a, smem, (const bf16*)(ws + WS_CAT), 1024, (const bf16*)(ws + WS_WOUT) + (size_t)li * DM * 1024, l);
        else resid_gemm_phase(a, smem, (const bf16*)(ws + WS_CAT), DM, (const bf16*)(ws + WS_PW2) + (size_t)li * DM * DM, l);
        break;
    case 6: if (EN(6)) route_phase(a, smem, l); break;
#ifdef EMU
    case 7: if (EN(7)) moe_gemm_phase8(a, smem, l, 0); break;
    case 8: if (EN(8)) moe_gemm_phase8(a, smem, l, 1); break;
#else
    case 7: if (EN(7)) moe_fused_phase(a, smem, l); break;
    case 8: break;
#endif
    }
}

#ifndef EMU
#define LAS __attribute__((address_space(3)))
#define XB_TMO      128
static_assert(XB_TMO == MOE_TMO_IDX, "timeout word");
#define XB_XCNT(j)  (256  + 64 * (j))
#define XB_XSUB(j)  (1280 + 64 * (j))
#define XB_XGEN(j)  (2304 + 64 * (j))
#define XB_TOP      3328
#define XB_TOPGEN   3392
#define XCD_BAR_WORDS 3456
#define XB_SPIN_CAP (1u << 22)
__device__ __forceinline__ unsigned xb_ld(unsigned* p)              { return __hip_atomic_load(p, __ATOMIC_RELAXED, __HIP_MEMORY_SCOPE_AGENT); }
__device__ __forceinline__ unsigned xb_add(unsigned* p, unsigned v) { return __hip_atomic_fetch_add(p, v, __ATOMIC_RELAXED, __HIP_MEMORY_SCOPE_AGENT); }
__device__ __forceinline__ unsigned xb_xcc_id() { return (unsigned)__builtin_amdgcn_s_getreg((3 << 11) | 20) & 0xFu; }
#define XB_SPIN(cond, bar) do { unsigned _sp = 0; while (cond) { __builtin_amdgcn_s_sleep(1); \
    if ((++_sp & 255u) == 0u) { if (xb_ld(&(bar)[XB_TMO])) break; if (_sp > XB_SPIN_CAP) { atomicAdd(&(bar)[XB_TMO], 1u); break; } } } } while (0)
struct XcdBarrier { unsigned* bar; unsigned x; volatile LAS unsigned* st; };
__device__ __forceinline__ XcdBarrier xcd_barrier_post(unsigned* bar, volatile LAS unsigned* st) {
    XcdBarrier b; b.bar = bar; b.x = xb_xcc_id(); b.st = st;
    if (threadIdx.x == 0) (void)xb_add(&bar[XB_XCNT(b.x)], 1u);
    return b;
}
__device__ __forceinline__ void xcd_barrier_complete(unsigned* bar, unsigned x, unsigned& nloc, unsigned& nx) {
    const unsigned G = gridDim.x * gridDim.y * gridDim.z;
    unsigned sum, cnt, mine, sp = 0u;
    for (;;) {
        sum = 0u; cnt = 0u; mine = 0u;
#pragma unroll
        for (unsigned j = 0; j < 16; ++j) { const unsigned c = xb_ld(&bar[XB_XCNT(j)]); sum += c; cnt += (c > 0u) ? 1u : 0u; mine = (j == x) ? c : mine; }
        if (sum == G) break;
        __builtin_amdgcn_s_sleep(1);
        if ((++sp & 255u) == 0u) { if (xb_ld(&bar[XB_TMO])) break; if (sp > XB_SPIN_CAP) { atomicAdd(&bar[XB_TMO], 1u); break; } }
    }
    nloc = mine > 0u ? mine : 1u; nx = cnt > 0u ? cnt : 1u;
}
__device__ __forceinline__ void xcd_barrier(const XcdBarrier& b) {
    asm volatile("s_waitcnt vmcnt(0)" ::: "memory");
    __syncthreads();
    if (threadIdx.x == 0) {
        unsigned* bar = b.bar;
        __builtin_amdgcn_s_waitcnt(0);
        unsigned nloc = b.st[0], nx = b.st[1];
        if (nloc == 0u) { xcd_barrier_complete(bar, b.x, nloc, nx); b.st[0] = nloc; b.st[1] = nx; }
        const unsigned old = xb_add(&bar[XB_XSUB(b.x)], 1u);
        const unsigned gen = old / nloc;
        if (old + 1u == (gen + 1u) * nloc) {
            __builtin_amdgcn_fence(__ATOMIC_RELEASE, "agent");
            asm volatile("s_waitcnt vmcnt(0)" ::: "memory");
            const unsigned og = xb_add(&bar[XB_TOP], 1u);
            const unsigned tg = og / nx;
            if (og + 1u == (tg + 1u) * nx) xb_add(&bar[XB_TOPGEN], 1u);
            else XB_SPIN(xb_ld(&bar[XB_TOPGEN]) == tg, bar);
            __builtin_amdgcn_fence(__ATOMIC_ACQUIRE, "agent");
            xb_add(&bar[XB_XGEN(b.x)], 1u);
            asm volatile("s_waitcnt vmcnt(0)" ::: "memory");
        } else {
            XB_SPIN(xb_ld(&bar[XB_XGEN(b.x)]) == gen, bar);
            __builtin_amdgcn_fence(__ATOMIC_ACQUIRE, "agent");
            asm volatile("s_waitcnt vmcnt(0)" ::: "memory");
        }
    }
    __syncthreads();
}

__global__ void __launch_bounds__(NT, 2) mega(Args a) {
    extern __shared__ __attribute__((aligned(16))) unsigned char lds[];
    volatile LAS unsigned* st = (volatile LAS unsigned*)(LAS unsigned char*)(lds + LDS_BYTES - 16);
    if (threadIdx.x < 4) st[threadIdx.x] = 0u;
    __syncthreads();
    unsigned* barw = (unsigned*)(a.ws + WS_BAR);
    XcdBarrier bar = xcd_barrier_post(barw, st);
#pragma unroll 1
    for (int ph = 0; ph < N_PHASES; ++ph) {
        if (ph > 0 && ph < N_PHASES - 1) { int l_, s_; phase_decode(ph, l_, s_); if (s_ == 8) continue; }
        run_phase(a, lds, ph);
#ifdef DUP
        { int lyr = 0, sub = 100; if (ph > 0 && ph < N_PHASES - 1) phase_decode(ph, lyr, sub);
          if (sub == (DUP % 1000) && (ph == 0 || lyr == DUP / 1000) && ph < N_PHASES - 1) { xcd_barrier(bar); run_phase(a, lds, ph); } }
#endif
        if (ph + 1 < N_PHASES) xcd_barrier(bar);
    }
    if (xb_ld(&barw[XB_TMO]) != 0u) {
        const size_t gt = (size_t)blockIdx.x * NT + threadIdx.x, gs = (size_t)gridDim.x * NT;
        for (size_t i = gt; i < (size_t)T * DM; i += gs) a.out[i] = __builtin_nanf("");
    }
}

extern "C" void kernel_launch(void* const* d_in, const int* in_sizes, int n_in, void* d_out, int out_size,
                              void* d_ws, size_t ws_size, hipStream_t stream) {
    static int grid = 0;
    if (grid == 0) {
        int dev = 0, cus = 0;
        if (hipGetDevice(&dev) != hipSuccess || hipDeviceGetAttribute(&cus, hipDeviceAttributeMultiprocessorCount, dev) != hipSuccess) { grid = -1; return; }
        if (hipFuncSetAttribute((const void*)mega, hipFuncAttributeMaxDynamicSharedMemorySize, LDS_BYTES) != hipSuccess) { grid = -1; return; }
        (void)hipGetLastError();
        grid = cus;
        if (n_in != 26 || out_size != T * DM || ws_size < WS_END) { fprintf(stderr, "kernel_launch: unexpected sizes n_in %d out %d ws %zu (need %zu)\n", n_in, out_size, ws_size, (size_t)WS_END); grid = -1; return; }
    }
    if (grid < 0) return;
    (void)hipMemsetAsync((unsigned char*)d_ws + WS_BAR, 0, XCD_BAR_WORDS * 4, stream);
    Args a{};
    for (int i = 0; i < 26; ++i) a.in[i] = (const float*)d_in[i];
    a.out = (float*)d_out; a.ws = (unsigned char*)d_ws;
    hipLaunchKernelGGL(mega, dim3(grid), dim3(NT), LDS_BYTES, stream, a);
}
#endif
```

```cpp
#ifdef EMU
#include "emu.h"
#define DEV static inline
#define MDEV inline
#define OPAQUE(p)
#define OPAQUE2(a, b)
#define TID emu_tid()
#define BID (EB->bid)
#define NBLK (EB->nblk)
#define SYNC() emu_sync_block()
#define WSYNC() emu_sync_wave()
#define mfma16(a, b, c) emu_mfma16(a, b, c)
DEV float shflx(float v, int m) { return emu_shfl_f(v, (emu_tid() & 63) ^ m); }
DEV int shflxi(int v, int m) { return (int)emu_shfl_u((unsigned)v, (emu_tid() & 63) ^ m); }
DEV float shfl(float v, int s) { return emu_shfl_f(v, s); }
DEV float dpp_ror1(float v) { const int l = emu_tid() & 63; return emu_shfl_f(v, (l & 48) | ((l - 1) & 15)); }
DEV int atomic_add_i(int* p, int v) { return __atomic_fetch_add(p, v, __ATOMIC_RELAXED); }
DEV float fexp2(float x) { return exp2f(x); }
DEV float frcp(float x) { return 1.0f / x; }
DEV float frsq(float x) { return 1.0f / sqrtf(x); }
typedef short s16x4 __attribute__((vector_size(8)));
static inline s16x4 emu_tr4(const unsigned short* p) {
    EmuWave& w = EB->wave[emu_tid() >> 6]; int l = emu_tid() & 63;
    const unsigned short** tab = (const unsigned short**)w.a;
    tab[l] = p; emu_sync_wave();
    s16x4 r; int g = l & 48, i = l & 15;
    for (int q = 0; q < 4; ++q) r[q] = (short)tab[g + 4 * q + (i >> 2)][i & 3];
    emu_sync_wave(); return r;
}
#define tr4(p) emu_tr4(p)
#else
#include <hip/hip_runtime.h>
#include <cstdio>
#include <cstdint>
typedef short bf16x8 __attribute__((ext_vector_type(8)));
typedef float f32x4 __attribute__((ext_vector_type(4)));
typedef unsigned u32x4 __attribute__((ext_vector_type(4)));
typedef unsigned u32x2 __attribute__((ext_vector_type(2)));
#define DEV __device__ __forceinline__
#define MDEV __device__ __forceinline__
#define OPAQUE(p) asm volatile("" : "+v"(p))
#define OPAQUE2(a, b) asm volatile("" : "+v"(a), "+v"(b))
DEV int tid_opaque() { int t = (int)threadIdx.x; asm volatile("" : "+v"(t)); return t; }
#define TID tid_opaque()
DEV int bid_opaque() { int b = (int)blockIdx.x; asm volatile("" : "+s"(b)); return b; }
#define BID bid_opaque()
#define NBLK ((int)gridDim.x)
#define SYNC() __syncthreads()
#define WSYNC() __builtin_amdgcn_wave_barrier()
#define mfma16(a, b, c) __builtin_amdgcn_mfma_f32_16x16x32_bf16(a, b, c, 0, 0, 0)
DEV int shflxi(int x, int m) {
    if (m == 1) return __builtin_amdgcn_update_dpp(x, x, 0xB1, 0xf, 0xf, true);
    if (m == 2) return __builtin_amdgcn_update_dpp(x, x, 0x4E, 0xf, 0xf, true);
    if (m == 4) return __builtin_amdgcn_ds_swizzle(x, (4 << 10) | 0x1F);
    if (m == 8) return __builtin_amdgcn_ds_swizzle(x, (8 << 10) | 0x1F);
    if (m == 16) return __builtin_amdgcn_ds_swizzle(x, (16 << 10) | 0x1F);
    if (m == 32) { const auto r = __builtin_amdgcn_permlane32_swap((unsigned)x, (unsigned)x, false, false); return (int)((threadIdx.x & 32) ? r[0] : r[1]); }
    return __shfl_xor(x, m);
}
DEV float shflx(float v, int m) { return __builtin_bit_cast(float, shflxi(__builtin_bit_cast(int, v), m)); }
DEV float dpp_ror1(float v) { return __builtin_bit_cast(float, __builtin_amdgcn_update_dpp(0, __builtin_bit_cast(int, v), 0x121, 0xf, 0xf, false)); }
DEV float shfl(float v, int s) { return __shfl(v, s); }
DEV int atomic_add_i(int* p, int v) { return atomicAdd(p, v); }
DEV float fexp2(float x) { return __builtin_amdgcn_exp2f(x); }
DEV float frcp(float x) { return __builtin_amdgcn_rcpf(x); }
DEV float frsq(float x) { return __builtin_amdgcn_rsqf(x); }
typedef short s16x4 __attribute__((ext_vector_type(4)));
#define tr4(p) __builtin_amdgcn_ds_read_tr16_b64_v4i16((__attribute__((address_space(3))) s16x4*)(p))
#endif

typedef unsigned short bf16;

#ifndef DM
#define DM 1024
#endif
#ifndef SEQ
#define SEQ 8192
#endif
#ifndef FF
#define FF 512
#endif
constexpr int NBATCH = 2, T = NBATCH * SEQ, DEPTH = 4;
constexpr int NIN = 3352, NINP = 3456, NIN8 = 3584;
constexpr int NT = 512;
constexpr int NCH = SEQ / 64;
constexpr int NCP = SEQ / 16;
constexpr int NCMP = NCP - 1;
constexpr int MOE_ROWS = 2 * T + 32 * 256;
constexpr float EPS = 1e-6f, NEGV = -1e30f, FORCEV = 1e4f, LOG2E = 1.4426950408889634f;

constexpr size_t al(size_t x) { return (x + 255) & ~(size_t)255; }
constexpr int P0_CTR_IDX = 192;
constexpr size_t WS_BAR = 0;
constexpr size_t WS_CNT = 16384;
constexpr size_t WS_MOD = WS_CNT + (size_t)DEPTH * 32 * 256;
constexpr size_t WS_LB = al(WS_MOD + (size_t)DEPTH * 2 * 6 * DM * 4);
constexpr size_t WS_CB = al(WS_LB + 2 * 512 * 4);
constexpr size_t WS_CS = al(WS_CB + 2 * 2 * 8 * 64 * 4);
constexpr size_t WS_WIN = al(WS_CS + 64);
constexpr size_t WS_WOUT = al(WS_WIN + (size_t)2 * NIN8 * DM * 2);
constexpr size_t WS_PW1 = al(WS_WOUT + (size_t)2 * DM * 1024 * 2);
constexpr size_t WS_PW2 = al(WS_PW1 + (size_t)2 * 2 * DM * DM * 2);
constexpr size_t WS_WC = al(WS_PW2 + (size_t)2 * DM * DM * 2);
constexpr size_t WS_W13 = al(WS_WC + (size_t)2 * 2 * 64 * 2048 * 2);
constexpr size_t WS_W2 = al(WS_W13 + (size_t)DEPTH * 32 * 2 * FF * DM * 2);
constexpr size_t WS_H = al(WS_W2 + (size_t)DEPTH * 32 * DM * FF * 2);
constexpr size_t WS_QN = al(WS_H + (size_t)T * DM * 2);
constexpr size_t WS_KCG = al(WS_QN + (size_t)T * 512 * 2);
constexpr size_t WS_VCG = al(WS_KCG + (size_t)T * 128 * 2);
constexpr size_t WS_KS = al(WS_VCG + (size_t)T * 128 * 2);
constexpr size_t WS_KW = al(WS_KS + (size_t)T * 128 * 2);
constexpr size_t WS_VST = al(WS_KW + (size_t)T * 128 * 2);
constexpr size_t WS_VWT = al(WS_VST + (size_t)T * 128 * 2);
constexpr size_t WS_KC = al(WS_VWT + (size_t)T * 128 * 2);
constexpr size_t WS_VCT = al(WS_KC + (size_t)4 * NCP * 64 * 2);
constexpr size_t WS_GATE = al(WS_VCT + (size_t)4 * NCP * 64 * 2);
constexpr size_t WS_HQ = al(WS_GATE + (size_t)T * 24 * 4);
constexpr size_t WS_HF = al(WS_HQ + (size_t)T * 512 * 2);
constexpr size_t WS_HV = al(WS_HF + (size_t)T * 512 * 4);
constexpr size_t WS_HGS = al(WS_HV + (size_t)T * 512 * 2);
constexpr size_t WS_UT = al(WS_HGS + (size_t)T * 512 * 2);
constexpr size_t WS_ST = al(WS_UT + (size_t)8 * NCH * 128 * 128 * 4);
constexpr size_t WS_GD = al(WS_ST + (size_t)8 * NCH * 128 * 128 * 2);
constexpr size_t WS_CAT = al(WS_GD + (size_t)8 * NCH * 128 * 4);
constexpr size_t WS_GLU = al(WS_CAT + (size_t)T * 1024 * 2);
constexpr size_t WS_TIE = al(WS_GLU + (size_t)T * DM * 2);
constexpr size_t WS_TIW = al(WS_TIE + (size_t)T * 2 * 4);
constexpr size_t WS_LIST = al(WS_TIW + (size_t)T * 2 * 4);
constexpr size_t WS_ACT = al(WS_LIST + (size_t)32 * T * 4);
constexpr size_t WS_YK = al(WS_ACT + (size_t)MOE_ROWS * FF * 2);
constexpr size_t WS_WTH = al(WS_YK + (size_t)MOE_ROWS * DM * 2);
constexpr size_t WS_WTL = al(WS_WTH + (size_t)DEPTH * 48 * DM * 2);
constexpr size_t WS_AVEC = al(WS_WTL + (size_t)DEPTH * 48 * DM * 2);
constexpr size_t WS_RBIAS = al(WS_AVEC + (size_t)DEPTH * 2 * DM * 4);
constexpr size_t WS_FLG = al(WS_RBIAS + (size_t)DEPTH * 2 * 48 * 4);
constexpr size_t WS_END = al(WS_FLG + (size_t)DEPTH * 256 * 64);

struct Args { const float* in[26]; float* out; unsigned char* ws; };
enum { I_X = 0, I_C, I_ADAW, I_ADAB, I_NMIX, I_NFFN, I_WIN, I_WOUT, I_CWK, I_CWV, I_CPE, I_QG, I_KG, I_LBL, I_OG,
       I_PW1, I_DW, I_DWB, I_LNG, I_LNB, I_PW2, I_WG, I_WE, I_W1, I_W3, I_W2 };

#ifdef EMU
DEV unsigned char* wsp(const Args& a) { return a.ws; }
DEV float* outp(const Args& a) { return a.out; }
#else
DEV unsigned char* launder_ptr(const void* p) { unsigned long long v = (unsigned long long)p; unsigned lo = (unsigned)v, hi = (unsigned)(v >> 32);
    lo = (unsigned)__builtin_amdgcn_readfirstlane((int)lo); hi = (unsigned)__builtin_amdgcn_readfirstlane((int)hi); asm volatile("" : "+s"(lo), "+s"(hi)); typedef __attribute__((address_space(1))) unsigned char* gptr_t; return (unsigned char*)(gptr_t)(((unsigned long long)hi << 32) | lo); }
DEV unsigned char* wsp(const Args& a) { return launder_ptr(a.ws); }
DEV float* outp(const Args& a) { return (float*)launder_ptr(a.out); }
#endif

#ifdef EMU
#define INP(a, X) ((a).in[X])
#else
DEV int zero_opaque() { int z = 0; asm volatile("" : "+s"(z)); return z; }
#define INP(a, X) ((a).in[(X) + zero_opaque()])
#endif

DEV unsigned f2bf(float f) { unsigned u = __builtin_bit_cast(unsigned, f); return (u + 0x7fffu + ((u >> 16) & 1u)) >> 16; }
DEV float bf2f(unsigned h) { return __builtin_bit_cast(float, h << 16); }
#ifdef EMU
DEV unsigned pk2(float lo, float hi) { return f2bf(lo) | (f2bf(hi) << 16); }
#else
typedef float f32x2_t __attribute__((ext_vector_type(2)));
typedef __bf16 bf16x2_t __attribute__((ext_vector_type(2)));
DEV unsigned pk2(float lo, float hi) { f32x2_t v = {lo, hi}; bf16x2_t b = __builtin_convertvector(v, bf16x2_t); return __builtin_bit_cast(unsigned, b); }
#endif
DEV float sigm(float x) { return frcp(1.0f + fexp2(-x * LOG2E)); }
DEV float siluf(float x) { return x * sigm(x); }
DEV f32x4 f4zero() { f32x4 z = {0.f, 0.f, 0.f, 0.f}; return z; }
DEV bf16x8 pack8(f32x4 a, f32x4 b) {
    u32x4 w; w[0] = pk2(a[0], a[1]); w[1] = pk2(a[2], a[3]); w[2] = pk2(b[0], b[1]); w[3] = pk2(b[2], b[3]);
    return __builtin_bit_cast(bf16x8, w);
}
DEV void st_bf8(bf16* p, f32x4 a, f32x4 b) { u32x4 w; w[0] = pk2(a[0], a[1]); w[1] = pk2(a[2], a[3]); w[2] = pk2(b[0], b[1]); w[3] = pk2(b[2], b[3]); *(u32x4*)p = w; }
DEV void st_bf4(bf16* p, f32x4 v) { u32x2 w; w[0] = pk2(v[0], v[1]); w[1] = pk2(v[2], v[3]); *(u32x2*)p = w; }


#ifdef EMU
namespace pg8 {
constexpr int BM = 256, BK = 64, HALF = 128, NXCD = 8, WGM = 8;
typedef unsigned short bf16_t;
struct Unit { int pm, pn; };
struct Gemm { const bf16_t* A; const bf16_t* Bt; int M, N, K; };
struct StaticOrder {
    int nM, nN, nwg, G, c;
    void init(int M, int N, int G_, int c_) { nM = M / BM; nN = N / BM; nwg = nM * nN; G = G_; c = c_; }
    bool next(int i, Unit& u) const {
        const long L = (long)i * G + c; if (L >= nwg) return false;
        int wgid = (int)L; { const int q = nwg / NXCD, r = nwg % NXCD, xcd = wgid % NXCD, off = wgid / NXCD; wgid = (xcd < r ? xcd * (q + 1) : r * (q + 1) + (xcd - r) * q) + off; }
        const int nig = WGM * nN, gid = wgid / nig, fm = gid * WGM, gsz = (nM - fm) < WGM ? (nM - fm) : WGM;
        u.pm = fm + ((wgid % nig) % gsz); u.pn = (wgid % nig) / gsz; return true;
    }
};
struct SelNone { static constexpr bool GATHER = false; struct Ctx {}; Ctx ctx(const Unit&) const { return Ctx(); } size_t boff(const Ctx&) const { return 0; } unsigned aoff(const Ctx&, int) const { return 0u; } };
template <class Epi, class Sched, bool ALIGN_EPI = false, bool SP2 = false, class Sel = SelNone>
static inline void gemm_phase(unsigned char*, const Gemm g, const Sched& S, const Epi& E, const Sel& X = Sel()) {
    const int tid = emu_tid(), wid = tid >> 6, lane = tid & 63, wr = wid >> 2, wc = wid & 3, fr = lane & 15, fq = lane >> 4;
    Unit u;
    for (int ui = 0; S.next(ui, u); ++ui) {
        f32x4 acc[2][2][4][2]; const auto cx = X.ctx(u);
        for (int ai = 0; ai < 2; ++ai) for (int bj = 0; bj < 2; ++bj) for (int m = 0; m < 4; ++m) for (int n = 0; n < 2; ++n) for (int r = 0; r < 4; ++r) {
            const int row = 256 * u.pm + 128 * ai + 64 * wr + 16 * m + fr, col = 256 * u.pn + 128 * bj + 32 * wc + (Epi::PERM ? 8 * fq + 4 * n + r : 16 * n + 4 * fq + r); float sum = 0.f;
            const bf16_t* ap = Sel::GATHER ? (const bf16_t*)((const char*)g.A + X.aoff(cx, row - 256 * u.pm)) : g.A + (size_t)row * g.K; const bf16_t* bp = (const bf16_t*)((const char*)g.Bt + X.boff(cx)) + (size_t)col * g.K;
            for (int k = 0; k < g.K; ++k) sum += bf2f(ap[k]) * bf2f(bp[k]);
            acc[ai][bj][m][n][r] = sum; }
        E(acc, u, wr, wc, fr, fq);
    }
    emu_sync_block();
}
}
#else
namespace pg8 {
#define PG8_LAS __attribute__((address_space(3)))
typedef unsigned short bf16_t;
typedef short bf16x8 __attribute__((ext_vector_type(8)));
typedef float f32x4 __attribute__((ext_vector_type(4)));
typedef unsigned u32x4 __attribute__((ext_vector_type(4)));
constexpr int BM = 256, BK = 64, HALF = 128, HTB = HALF * BK * 2  , STAGE_BYTES = 8 * HTB, NXCD = 8, WGM = 8;

__host__ __device__ __forceinline__ int lds_byte(int r, int c) { const int st = (r >> 4) * 2 + (c >> 5), rr = r & 15, cc = c & 31, ob = rr * 64 + cc * 2; return st * 1024 + (ob ^ (((ob >> 9) & 1) << 5)); }
__host__ __device__ __forceinline__ void stage_rc(int b, int& R, int& C) { const int st = b / 1024, sb = b % 1024, swz = sb ^ (((sb >> 9) & 1) << 5); R = (st >> 1) * 16 + swz / 64; C = (st & 1) * 32 + (swz % 64) / 2; }
__host__ __device__ __forceinline__ int perm32(int rho) { const int n = rho >> 4, i = rho & 15; return 8 * (i >> 2) + 4 * n + (i & 3); }

struct Unit { int pm, pn; };
struct Gemm { const bf16_t* A; const bf16_t* Bt; int M, N, K; };

struct StaticOrder {
    int nM, nN, nwg, G, c;
    __host__ __device__ void init(int M, int N, int G_, int c_) { nM = M / BM; nN = N / BM; nwg = nM * nN; G = G_; c = c_; }
    __host__ __device__ bool next(int i, Unit& u) const {
        const long L = (long)i * G + c; if (L >= nwg) return false;
        int wgid = (int)L; { const int q = nwg / NXCD, r = nwg % NXCD, xcd = wgid % NXCD, off = wgid / NXCD; wgid = (xcd < r ? xcd * (q + 1) : r * (q + 1) + (xcd - r) * q) + off; }
        const int nig = WGM * nN, gid = wgid / nig, fm = gid * WGM, gsz = (nM - fm) < WGM ? (nM - fm) : WGM;
        u.pm = fm + ((wgid % nig) % gsz); u.pn = (wgid % nig) / gsz; return true;
    }
    __device__ __forceinline__ void a_ready(const Unit&) const {}
    __device__ __forceinline__ void done(const Unit&) const {}
};

__device__ __forceinline__ unsigned cvt_pk_bf16(float lo, float hi) { unsigned r; asm volatile("v_cvt_pk_bf16_f32 %0, %1, %2" : "=v"(r) : "v"(lo), "v"(hi)); return r; }
struct SelNone { static constexpr bool GATHER = false; struct Ctx {}; __device__ __forceinline__ Ctx ctx(const Unit&) const { return Ctx(); } __device__ __forceinline__ size_t boff(const Ctx&) const { return 0; } __device__ __forceinline__ unsigned aoff(const Ctx&, int) const { return 0u; } };
template <class Epi, class Sched, bool ALIGN_EPI = false, bool SP2 = false, class Sel = SelNone>
__device__ __forceinline__ void gemm_phase(PG8_LAS unsigned char* lds, const Gemm g, const Sched& S, const Epi& E, const Sel& X = Sel()) {
    constexpr bool GA = Sel::GATHER;
    const int tid = TID, wid = __builtin_amdgcn_readfirstlane(tid >> 6), lane = tid & 63, wr = wid >> 2, wc = wid & 3, fr = lane & 15, fq = lane >> 4;
    const int K = g.K, nt = K / BK;
    unsigned voffA[2], voffB[2]; int Rl[2]; unsigned Cl2[2];
#pragma unroll
    for (int i = 0; i < 2; ++i) { int R, C; stage_rc(tid * 16 + i * 8192, R, C); const int Rb = Epi::PERM ? ((R & ~31) + perm32(R & 31)) : R;
        voffA[i] = (unsigned)(R * K + C) * 2u; voffB[i] = (unsigned)(Rb * K + C) * 2u; Rl[i] = R; Cl2[i] = (unsigned)C * 2u; }
    unsigned vA[2][2], vAn[2][2];
    const size_t kstep = (size_t)(BK * 2);
    const size_t hstep = (size_t)HALF * K * 2;
    const size_t tstep = 2 * hstep;
    const unsigned ldsw = (unsigned)wid * 1024u;
    const int aoff = lds_byte(wr * 64 + fr, fq * 8), boff = lds_byte(wc * 32 + fr, fq * 8);
#define PG8_SA(b, h) (((b) * 2 + (h)) * HTB)
#define PG8_SB(b, h) ((4 + (b) * 2 + (h)) * HTB)
#define PG8_STAGE(bufoff, gbase, voff) do { _Pragma("unroll") for (int _i = 0; _i < 2; ++_i) \
        __builtin_amdgcn_global_load_lds((const unsigned*)((const char*)(gbase) + (voff)[_i]), (PG8_LAS unsigned*)(lds + (bufoff) + ldsw + _i * 8192), 16, 0, 0); } while (0)
#define PG8_STAGE_A(bufoff, p, h, nx) do { if constexpr (GA) { unsigned _vo[2] = {(nx) ? vAn[h][0] : vA[h][0], (nx) ? vAn[h][1] : vA[h][1]}; PG8_STAGE(bufoff, p, _vo); } else { PG8_STAGE(bufoff, (p) + (h) * hstep, voffA); } } while (0)
#define PG8_GATH(cx, dst) do { _Pragma("unroll") for (int _h = 0; _h < 2; ++_h) _Pragma("unroll") for (int _i = 0; _i < 2; ++_i) dst[_h][_i] = X.aoff(cx, 128 * _h + Rl[_i]) + Cl2[_i]; } while (0)
#define PG8_LDA(dst, b, h) do { _Pragma("unroll") for (int m = 0; m < 4; ++m) _Pragma("unroll") for (int k = 0; k < 2; ++k) dst[m][k] = *(const PG8_LAS bf16x8*)(lds + PG8_SA(b, h) + aoff + m * 2048 + k * 1024); } while (0)
#define PG8_LDB(dst, b, h) do { _Pragma("unroll") for (int n = 0; n < 2; ++n) _Pragma("unroll") for (int k = 0; k < 2; ++k) dst[n][k] = *(const PG8_LAS bf16x8*)(lds + PG8_SB(b, h) + boff + n * 2048 + k * 1024); } while (0)
#define PG8_MMA(ai, bj, At, Bt) do { __builtin_amdgcn_s_setprio(1); _Pragma("unroll") for (int m = 0; m < 4; ++m) _Pragma("unroll") for (int n = 0; n < 2; ++n) _Pragma("unroll") for (int k = 0; k < 2; ++k) \
        acc[ai][bj][m][n] = __builtin_amdgcn_mfma_f32_16x16x32_bf16(Bt[n][k], At[m][k], acc[ai][bj][m][n], 0, 0, 0); __builtin_amdgcn_s_setprio(0); } while (0)
#define PG8_WAIT_V(n) asm volatile("s_waitcnt vmcnt(" #n ")" ::: "memory")
#define PG8_WAIT_L(n) asm volatile("s_waitcnt lgkmcnt(" #n ")" ::: "memory")
#define PG8_BAR __builtin_amdgcn_s_barrier()
#define PG8_SCHED __builtin_amdgcn_sched_barrier(0)
    Unit cur, nxt; int ui = 0;
    if (!S.next(0, cur)) return;
    f32x4 acc[2][2][4][2];
#pragma unroll
    for (int a = 0; a < 2; ++a)
#pragma unroll
        for (int b = 0; b < 2; ++b)
#pragma unroll
            for (int m = 0; m < 4; ++m)
#pragma unroll
                for (int n = 0; n < 2; ++n) acc[a][b][m][n] = (f32x4){0.f, 0.f, 0.f, 0.f};
    bf16x8 At[4][2], B0[2][2], B1[2][2];
    auto ccx = X.ctx(cur);
    const char* cA = GA ? (const char*)g.A : (const char*)g.A + (size_t)cur.pm * tstep; const char* cB = (const char*)g.Bt + X.boff(ccx) + (size_t)cur.pn * tstep;
    if constexpr (GA) { PG8_GATH(ccx, vA); }
    S.a_ready(cur);
    if constexpr (SP2) {
        PG8_STAGE(PG8_SB(0, 0), cB, voffB); PG8_STAGE(PG8_SB(0, 1), cB + hstep, voffB); PG8_STAGE_A(PG8_SA(0, 0), cA, 0, false); PG8_STAGE_A(PG8_SA(0, 1), cA, 1, false);
        if (wr == 1) PG8_BAR;
        PG8_WAIT_V(2); PG8_BAR;
        PG8_STAGE(PG8_SB(1, 0), cB + kstep, voffB); PG8_STAGE_A(PG8_SA(1, 0), cA + kstep, 0, false); PG8_STAGE(PG8_SB(1, 1), cB + hstep + kstep, voffB);
        PG8_WAIT_V(6); PG8_BAR;
    } else {
        PG8_STAGE(PG8_SB(0, 0), cB, voffB); PG8_STAGE_A(PG8_SA(0, 0), cA, 0, false); PG8_STAGE(PG8_SB(0, 1), cB + hstep, voffB); PG8_STAGE_A(PG8_SA(0, 1), cA, 1, false);
        if (wr == 1) PG8_BAR;
        PG8_WAIT_V(4); PG8_BAR;
        PG8_STAGE(PG8_SB(1, 0), cB + kstep, voffB); PG8_STAGE_A(PG8_SA(1, 0), cA + kstep, 0, false); PG8_STAGE(PG8_SB(1, 1), cB + hstep + kstep, voffB);
        PG8_WAIT_V(6); PG8_BAR;
    }
    for (;;) {
        const bool has_next = S.next(ui + 1, nxt);
        const char* nA = cA; const char* nB = cB;
        if (has_next) { const auto ncx = X.ctx(nxt); nA = GA ? (const char*)g.A : (const char*)g.A + (size_t)nxt.pm * tstep; nB = (const char*)g.Bt + X.boff(ncx) + (size_t)nxt.pn * tstep; if constexpr (GA) { PG8_GATH(ncx, vAn); } }
        else if constexpr (GA) {
#pragma unroll
            for (int _h = 0; _h < 2; ++_h) { vAn[_h][0] = vA[_h][0]; vAn[_h][1] = vA[_h][1]; } }
        for (int t = 0; t < nt; t += 2) {
            const bool last = (t == nt - 2);
            const char* a1 = cA + (size_t)(t + 1) * kstep;
            const char* a2 = last ? nA : cA + (size_t)(t + 2) * kstep; const char* b2 = last ? nB : cB + (size_t)(t + 2) * kstep;
            const char* a3 = a2 + kstep; const char* b3 = b2 + kstep;
            if (last && has_next) S.a_ready(nxt);
            if constexpr (SP2) {
            PG8_LDB(B0, 0, 0); PG8_LDB(B1, 0, 1); PG8_SCHED; PG8_LDA(At, 0, 0); PG8_STAGE_A(PG8_SA(1, 1), a1, 1, false);
            PG8_WAIT_V(8); PG8_WAIT_L(0); PG8_BAR; PG8_MMA(0, 0, At, B0); PG8_MMA(0, 1, At, B1); PG8_BAR; PG8_SCHED;
            PG8_LDA(At, 0, 1); PG8_STAGE(PG8_SB(0, 0), b2, voffB); PG8_STAGE(PG8_SB(0, 1), b2 + hstep, voffB); PG8_STAGE_A(PG8_SA(0, 0), a2, 0, last);
            PG8_WAIT_V(8); PG8_WAIT_L(0); PG8_BAR; PG8_MMA(1, 0, At, B0); PG8_MMA(1, 1, At, B1); PG8_BAR; PG8_SCHED;
            PG8_LDB(B0, 1, 0); PG8_LDB(B1, 1, 1); PG8_SCHED; PG8_LDA(At, 1, 0); PG8_STAGE_A(PG8_SA(0, 1), a2, 1, last);
            PG8_WAIT_V(8); PG8_WAIT_L(0); PG8_BAR; PG8_MMA(0, 0, At, B0); PG8_MMA(0, 1, At, B1); PG8_BAR; PG8_SCHED;
            PG8_LDA(At, 1, 1); PG8_STAGE(PG8_SB(1, 0), b3, voffB); PG8_STAGE(PG8_SB(1, 1), b3 + hstep, voffB); PG8_STAGE_A(PG8_SA(1, 0), a3, 0, last);
            PG8_WAIT_V(8); PG8_WAIT_L(0); PG8_BAR; PG8_MMA(1, 0, At, B0); PG8_MMA(1, 1, At, B1); PG8_BAR; PG8_SCHED;
            } else {
            PG8_LDB(B0, 0, 0); PG8_SCHED; PG8_LDA(At, 0, 0); PG8_STAGE_A(PG8_SA(1, 1), a1, 1, false);
            PG8_WAIT_L(8); PG8_BAR; PG8_WAIT_L(0); PG8_MMA(0, 0, At, B0); PG8_BAR; PG8_SCHED;
            PG8_LDB(B1, 0, 1); PG8_STAGE(PG8_SB(0, 0), b2, voffB);
            PG8_BAR; PG8_WAIT_L(0); PG8_MMA(0, 1, At, B1); PG8_BAR;
            PG8_LDA(At, 0, 1); PG8_STAGE_A(PG8_SA(0, 0), a2, 0, last);
            PG8_BAR; PG8_WAIT_L(0); PG8_MMA(1, 0, At, B0); PG8_BAR; PG8_SCHED;
            PG8_STAGE(PG8_SB(0, 1), b2 + hstep, voffB);
            PG8_WAIT_V(6); PG8_BAR; PG8_MMA(1, 1, At, B1); PG8_BAR;
            PG8_LDB(B0, 1, 0); PG8_SCHED; PG8_LDA(At, 1, 0); PG8_STAGE_A(PG8_SA(0, 1), a2, 1, last);
            PG8_WAIT_L(8); PG8_BAR; PG8_WAIT_L(0); PG8_MMA(0, 0, At, B0); PG8_BAR; PG8_SCHED;
            PG8_LDB(B1, 1, 1); PG8_STAGE(PG8_SB(1, 0), b3, voffB);
            PG8_BAR; PG8_WAIT_L(0); PG8_MMA(0, 1, At, B1); PG8_BAR;
            PG8_LDA(At, 1, 1); PG8_STAGE_A(PG8_SA(1, 0), a3, 0, last);
            PG8_BAR; PG8_WAIT_L(0); PG8_MMA(1, 0, At, B0); PG8_BAR; PG8_SCHED;
            PG8_STAGE(PG8_SB(1, 1), b3 + hstep, voffB);
            PG8_WAIT_V(6); PG8_BAR; PG8_MMA(1, 1, At, B1); PG8_BAR;
            }
        }
        if constexpr (ALIGN_EPI) { if (wr == 0) PG8_BAR; }
        if constexpr (!Epi::AFTER_DRAIN) { E(acc, cur, wr, wc, fr, fq); S.done(cur); }
        if (!has_next) break;
#pragma unroll
        for (int a = 0; a < 2; ++a)
#pragma unroll
            for (int b = 0; b < 2; ++b)
#pragma unroll
                for (int m = 0; m < 4; ++m)
#pragma unroll
                    for (int n = 0; n < 2; ++n) acc[a][b][m][n] = (f32x4){0.f, 0.f, 0.f, 0.f};
        cur = nxt; cA = nA; cB = nB; ++ui;
        if constexpr (GA) {
#pragma unroll
            for (int _h = 0; _h < 2; ++_h) { vA[_h][0] = vAn[_h][0]; vA[_h][1] = vAn[_h][1]; } }
        if constexpr (ALIGN_EPI) { if (wr == 1) PG8_BAR; }
    }
    PG8_WAIT_V(0);
    if constexpr (!ALIGN_EPI) { if (wr == 0) PG8_BAR; }
    PG8_BAR;
    if constexpr (Epi::AFTER_DRAIN) { E.fused(acc, cur, wr, wc, fr, fq, lds, wid, lane); S.done(cur); }
#undef PG8_SA
#undef PG8_SB
#undef PG8_STAGE
#undef PG8_STAGE_A
#undef PG8_GATH
#undef PG8_LDA
#undef PG8_LDB
#undef PG8_MMA
#undef PG8_WAIT_V
#undef PG8_WAIT_L
#undef PG8_BAR
#undef PG8_SCHED
}
}
#endif

constexpr int LDT = 72;
constexpr int GEMM_AS = 256 * LDT, GEMM_BS = 128 * LDT;
constexpr int GEMM_LDS = 2 * (GEMM_AS + GEMM_BS) * 2;

template <class AF, class EPI>
DEV void gemm_tile(unsigned char* smem, AF af, const bf16* Bt, int ldb, int nvalid, int K, EPI& epi) {
    const int tid = TID, w = tid >> 6, l = tid & 63, h = l >> 4, c = l & 15, wm = w >> 1, wn = w & 1;
    bf16* As = (bf16*)smem; bf16* Bs = As + 2 * GEMM_AS;
    const bf16* ap[4]; const bf16* bp[2];
    const int col8 = (tid & 7) * 8, r0 = tid >> 3;
#pragma unroll
    for (int i = 0; i < 4; ++i) ap[i] = af(r0 + 64 * i) + col8;
#pragma unroll
    for (int i = 0; i < 2; ++i) { int rn = r0 + 64 * i; if (rn >= nvalid) rn = nvalid - 1; bp[i] = Bt + (size_t)rn * ldb + col8; }
    f32x4 acc[4][4];
#pragma unroll
    for (int i = 0; i < 4; ++i)
#pragma unroll
        for (int j = 0; j < 4; ++j) acc[i][j] = f4zero();
    bf16x8 ra[4], rb[2];
#pragma unroll
    for (int i = 0; i < 4; ++i) ra[i] = *(const bf16x8*)(ap[i]);
#pragma unroll
    for (int i = 0; i < 2; ++i) rb[i] = *(const bf16x8*)(bp[i]);
    SYNC();
#pragma unroll
    for (int i = 0; i < 4; ++i) *(bf16x8*)(As + (r0 + 64 * i) * LDT + col8) = ra[i];
#pragma unroll
    for (int i = 0; i < 2; ++i) *(bf16x8*)(Bs + (r0 + 64 * i) * LDT + col8) = rb[i];
    SYNC();
    const int nk = K / 64;
    for (int kt = 0; kt < nk; ++kt) {
        const int cur = kt & 1;
        if (kt + 1 < nk) {
#pragma unroll
            for (int i = 0; i < 4; ++i) ra[i] = *(const bf16x8*)(ap[i] + (kt + 1) * 64);
#pragma unroll
            for (int i = 0; i < 2; ++i) rb[i] = *(const bf16x8*)(bp[i] + (kt + 1) * 64);
        }
        const bf16* Ac = As + cur * GEMM_AS + (wm * 64 + c) * LDT + 8 * h;
        const bf16* Bc = Bs + cur * GEMM_BS + (wn * 64 + c) * LDT + 8 * h;
#pragma unroll
        for (int kk = 0; kk < 2; ++kk) {
            bf16x8 fa[4], fb[4];
#pragma unroll
            for (int i = 0; i < 4; ++i) { fa[i] = *(const bf16x8*)(Ac + i * 16 * LDT + kk * 32); fb[i] = *(const bf16x8*)(Bc + i * 16 * LDT + kk * 32); }
#pragma unroll
            for (int ni = 0; ni < 4; ++ni)
#pragma unroll
                for (int mi = 0; mi < 4; ++mi) acc[ni][mi] = mfma16(fb[ni], fa[mi], acc[ni][mi]);
        }
        if (kt + 1 < nk) {
            const int nx = cur ^ 1;
#pragma unroll
            for (int i = 0; i < 4; ++i) *(bf16x8*)(As + nx * GEMM_AS + (r0 + 64 * i) * LDT + col8) = ra[i];
#pragma unroll
            for (int i = 0; i < 2; ++i) *(bf16x8*)(Bs + nx * GEMM_BS + (r0 + 64 * i) * LDT + col8) = rb[i];
        }
        SYNC();
    }
    epi(acc, wm * 64, wn * 64, h, c);
}

struct ARows { const bf16* base; size_t ld; MDEV const bf16* operator()(int r) const { return base + (size_t)r * ld; } MDEV unsigned off(int r) const { return (unsigned)r * (unsigned)ld; } };

constexpr int LDB = 144;
constexpr int GEMM_BS2 = 64 * LDB;
constexpr int GEMM2_LDS = (2 * GEMM_AS + 2 * GEMM_BS2) * 2;
DEV bf16x8 tr_read8(const bf16* p0, const bf16* p1) {
    const s16x4 x = tr4(p0), y = tr4(p1); bf16x8 r;
    r[0] = x[0]; r[1] = x[1]; r[2] = x[2]; r[3] = x[3]; r[4] = y[0]; r[5] = y[1]; r[6] = y[2]; r[7] = y[3]; return r;
}
DEV int bperm(int r) { return (r & ~12) | ((r & 4) << 1) | ((r & 8) >> 1); }
template <class AF, class BF, class EPI>
DEV void gemm_tile2(unsigned char* smem, AF af, BF bf, int ldb, int K, EPI& epi) {
    const int tid = TID, w = tid >> 6, l = tid & 63, h = l >> 4, c = l & 15, wm = w >> 1, wn = w & 1, grp = w >> 2;
    bf16* As = (bf16*)smem; bf16* Bs = As + 2 * GEMM_AS;
    const bf16* abase = af.base; unsigned ao[4];
    const int col8 = (tid & 7) * 8, r0 = tid >> 3;
#pragma unroll
    for (int i = 0; i < 4; ++i) ao[i] = af.off(r0 + 64 * i) + col8;
    const int bn4 = (tid & 31) * 4, bk = tid >> 5, bkp = bperm(bk);
    const float* bp = bf(bn4); const bool bok = bp != nullptr;
    if (bok) bp += (size_t)bk * ldb;
    const size_t bstep = (size_t)16 * ldb;
    f32x4 acc[4][4];
#pragma unroll
    for (int i = 0; i < 4; ++i)
#pragma unroll
        for (int j = 0; j < 4; ++j) acc[i][j] = f4zero();
    bf16x8 ra[4]; f32x4 rb[4];
    const int nk = K / 64;
#pragma unroll
    for (int i = 0; i < 4; ++i) { ra[i] = *(const bf16x8*)(abase + ao[i]); rb[i] = bok ? *(const f32x4*)(bp + i * bstep) : f4zero(); }
    SYNC();
#pragma unroll
    for (int i = 0; i < 4; ++i) { *(bf16x8*)(As + (r0 + 64 * i) * LDT + col8) = ra[i]; st_bf4(Bs + (bkp + 16 * i) * LDB + bn4, rb[i]); }
    if (nk > 1) {
#pragma unroll
        for (int i = 0; i < 4; ++i) { ra[i] = *(const bf16x8*)(abase + (ao[i] + 64)); rb[i] = bok ? *(const f32x4*)(bp + (size_t)64 * ldb + i * bstep) : f4zero(); } }
    SYNC();
    for (int kt = 0; kt < nk; ++kt) {
        const int cur = kt & 1;
#pragma unroll
        for (int p = 0; p < 2; ++p) {
            if (grp == p) {
                const bf16* Ac = As + cur * GEMM_AS + (wm * 64 + c) * LDT + 8 * h;
                const bf16* Bc = Bs + cur * GEMM_BS2 + bperm(8 * h + (c >> 2)) * LDB + wn * 64 + 4 * (c & 3);
#pragma unroll
                for (int kk = 0; kk < 2; ++kk) {
                    bf16x8 fa[4], fb[4];
#pragma unroll
                    for (int i = 0; i < 4; ++i) { fa[i] = *(const bf16x8*)(Ac + i * 16 * LDT + kk * 32); fb[i] = tr_read8(Bc + (32 * kk) * LDB + 16 * i, Bc + (32 * kk + 8) * LDB + 16 * i); }
#pragma unroll
                    for (int ni = 0; ni < 4; ++ni)
#pragma unroll
                        for (int mi = 0; mi < 4; ++mi) acc[ni][mi] = mfma16(fb[ni], fa[mi], acc[ni][mi]);
                }
            } else if (kt + 1 < nk) {
                const int nx = cur ^ 1;
#pragma unroll
                for (int i = 0; i < 4; ++i) { *(bf16x8*)(As + nx * GEMM_AS + (r0 + 64 * i) * LDT + col8) = ra[i]; st_bf4(Bs + nx * GEMM_BS2 + (bkp + 16 * i) * LDB + bn4, rb[i]); }
                if (kt + 2 < nk) {
#pragma unroll
                    for (int i = 0; i < 4; ++i) { ra[i] = *(const bf16x8*)(abase + (ao[i] + (kt + 2) * 64)); rb[i] = bok ? *(const f32x4*)(bp + (size_t)(kt + 2) * 64 * ldb + i * bstep) : f4zero(); } }
            }
            SYNC();
        }
    }
    epi(acc, wm * 64, wn * 64, h, c);
}
struct BPlain { const float* base; MDEV const float* operator()(int nt) const { return base + nt; } };
struct BInProjMap { const float* base; int n0; MDEV const float* operator()(int nt) const { const int n = n0 + nt; const int sc = n < 1280 ? n : (n < 3328 ? n + 24 : (n < 3352 ? 1280 + (n - 3328) : -1)); return sc < 0 ? nullptr : base + sc; } };
struct BInter { const float* s0; const float* s1; int n0; MDEV const float* operator()(int nt) const { const int n = n0 + nt, g = n >> 6, w = n & 63; return w < 32 ? s0 + g * 32 + w : s1 + g * 32 + w - 32; } };
struct BClamp64 { const float* base; MDEV const float* operator()(int nt) const { return base + (nt & 63); } };

struct EpiInProj {
    const Args* a; int m0, n0, li;
    MDEV void operator()(f32x4 (&acc)[4][4], int mw, int nw, int h, int c) const {
        unsigned char* ws = wsp(*a);
        const int nb = n0 + nw;
        const int tokb = m0 + mw + c;
        if (nb < 512 || (nb >= 768 && nb < 896) || (nb >= 1024 && nb < 1152)) {
            const float* gain; float mul = 1.f; bf16* dst; int kind;
            if (nb < 512) { gain = INP(*a, I_QG) + li * 64; mul = 0.125f * LOG2E; kind = 0; dst = (bf16*)(ws + WS_QN); }
            else if (nb < 896) { gain = INP(*a, I_KG) + (li * 3 + 1) * 64; kind = 1; dst = (bf16*)(ws + WS_KS); }
            else { gain = INP(*a, I_KG) + (li * 3 + 2) * 64; kind = 1; dst = (bf16*)(ws + WS_KW); }
            const int g = (nb >> 6) & 1;
#pragma unroll
            for (int mi = 0; mi < 4; ++mi) {
                float ss = 0.f;
#pragma unroll
                for (int ni = 0; ni < 4; ++ni) { f32x4 v = acc[ni][mi]; ss += v[0] * v[0] + v[1] * v[1] + v[2] * v[2] + v[3] * v[3]; }
                ss += shflx(ss, 16); ss += shflx(ss, 32);
                const float rs = frsq(ss * (1.0f / 64.0f) + EPS) * mul;
                const int tok = tokb + 16 * mi;
#pragma unroll
                for (int ni = 0; ni < 4; ++ni) {
                    const int d = 16 * ni + 4 * h; f32x4 v = acc[ni][mi], o;
#pragma unroll
                    for (int r = 0; r < 4; ++r) o[r] = v[r] * rs * gain[d + r];
                    if (kind == 0) st_bf4(dst + (size_t)tok * 512 + nb + d, o);
                    else { const int b = tok / SEQ, s = tok % SEQ; st_bf4(dst + ((size_t)(b * 2 + g) * SEQ + s) * 64 + d, o); }
                }
            }
        } else if (nb < 768) {
            bf16* dst = (bf16*)(ws + (nb < 640 ? WS_KCG : WS_VCG)); const int g = (nb >> 6) & 1;
#pragma unroll
            for (int mi = 0; mi < 4; ++mi) { const int tok = tokb + 16 * mi, b = tok / SEQ, s = tok % SEQ;
#pragma unroll
                for (int ni = 0; ni < 4; ++ni) st_bf4(dst + ((size_t)(b * 2 + g) * SEQ + s) * 64 + 16 * ni + 4 * h, acc[ni][mi]); }
        } else if (nb < 1280) {
            bf16* dst = (bf16*)(ws + (nb < 1024 ? WS_VST : WS_VWT)); const int g = (nb >> 6) & 1;
#pragma unroll
            for (int mi = 0; mi < 4; ++mi) { const int tok = tokb + 16 * mi, b = tok / SEQ, s = tok % SEQ;
                bf16* p = dst + ((size_t)(b * 2 + g) * NCH + (s >> 6)) * 4096 + (s & 63);
#pragma unroll
                for (int ni = 0; ni < 4; ++ni)
#pragma unroll
                    for (int r = 0; r < 4; ++r) p[(16 * ni + 4 * h + r) * 64] = (bf16)f2bf(acc[ni][mi][r]); }
        } else if (nb < 3328) {
            const int sec = (nb - 1280) >> 9, cc = (nb - 1280) & 511, hh = cc >> 7, d0 = cc & 127;
#pragma unroll
            for (int mi = 0; mi < 4; ++mi) { const int tok = tokb + 16 * mi, b = tok / SEQ, s = tok % SEQ;
                const size_t hrow = ((size_t)(b * 4 + hh) * SEQ + s) * 128 + d0;
#pragma unroll
                for (int ni = 0; ni < 4; ++ni) { const int d = 16 * ni + 4 * h; f32x4 v = acc[ni][mi], o;
                    if (sec == 0) { for (int r = 0; r < 4; ++r) o[r] = siluf(v[r]); st_bf4((bf16*)(ws + WS_HQ) + hrow + d, o); }
                    else if (sec == 1) { const float* lb = (const float*)(ws + WS_LB) + li * 512 + cc + d;
                        for (int r = 0; r < 4; ++r) o[r] = lb[r] + (1.0f - lb[r]) * sigm(v[r]);
                        *(f32x4*)((float*)(ws + WS_HF) + hrow + d) = o; }
                    else if (sec == 2) st_bf4((bf16*)(ws + WS_HV) + hrow + d, v);
                    else { for (int r = 0; r < 4; ++r) o[r] = siluf(v[r]); st_bf4((bf16*)(ws + WS_HGS) + (size_t)tok * 512 + cc + d, o); }
                } }
        } else if (nb == 3328) {
            float* dst = (float*)(ws + WS_GATE);
#pragma unroll
            for (int mi = 0; mi < 4; ++mi) { const int tok = tokb + 16 * mi;
#pragma unroll
                for (int ni = 0; ni < 2; ++ni)
#pragma unroll
                    for (int r = 0; r < 4; ++r) { const int n = 16 * ni + 4 * h + r; if (n < 24) dst[(size_t)tok * 24 + n] = sigm(acc[ni][mi][r]); } }
        }
    }
};

struct EpiResid {
    float* x; const float* gate; int m0, n0;
    MDEV void operator()(f32x4 (&acc)[4][4], int mw, int nw, int h, int c) const {
#pragma unroll
        for (int mi = 0; mi < 4; ++mi) { const int tok = m0 + mw + 16 * mi + c, b = tok / SEQ;
#pragma unroll
            for (int ni = 0; ni < 4; ++ni) { const int n = n0 + nw + 16 * ni + 4 * h;
                f32x4 g = *(const f32x4*)(gate + (size_t)b * 6 * DM + n); f32x4* p = (f32x4*)(x + (size_t)tok * DM + n); f32x4 v = *p;
#pragma unroll
                for (int r = 0; r < 4; ++r) v[r] += g[r] * acc[ni][mi][r];
                *p = v; } }
    }
};
template <int MODE> struct EpiGated {
    bf16* dst; size_t ld; int m0, n0, mvalid;
    MDEV void operator()(f32x4 (&acc)[4][4], int mw, int nw, int h, int c) const {
        const int cb = (n0 + nw) / 2;
#pragma unroll
        for (int mi = 0; mi < 4; ++mi) { const int m = mw + 16 * mi + c; if (m >= mvalid) continue;
#pragma unroll
            for (int ni = 0; ni < 2; ++ni) { f32x4 o;
#pragma unroll
                for (int r = 0; r < 4; ++r) { const float av = acc[ni][mi][r], bv = acc[ni + 2][mi][r]; o[r] = MODE == 0 ? av * sigm(bv) : siluf(av) * bv; }
                st_bf4(dst + (size_t)(m0 + m) * ld + cb + 16 * ni + 4 * h, o); } }
    }
};
struct EpiStoreBf {
    bf16* dst; size_t ld; int m0, n0, mvalid;
    MDEV void operator()(f32x4 (&acc)[4][4], int mw, int nw, int h, int c) const {
#pragma unroll
        for (int mi = 0; mi < 4; ++mi) { const int m = mw + 16 * mi + c; if (m >= mvalid) continue;
#pragma unroll
            for (int ni = 0; ni < 4; ++ni) st_bf4(dst + (size_t)(m0 + m) * ld + n0 + nw + 16 * ni + 4 * h, acc[ni][mi]); }
    }
};
struct EpiCmp {
    const Args* a; int kv, bg, m0, li;
    MDEV void operator()(f32x4 (&acc)[4][4], int mw, int nw, int h, int c) const {
        if (nw != 0) return;
        unsigned char* ws = wsp(*a);
        const float* bp8 = (const float*)(ws + WS_CB) + (li * 2 + kv) * 8 * 64;
        float bias[16];
#pragma unroll
        for (int q = 0; q < 16; ++q) { const int e = 16 * (q >> 2) + 4 * h + (q & 3); float v = 0.f;
#pragma unroll
            for (int kp = 0; kp < 8; ++kp) v += bp8[kp * 64 + e];
            bias[q] = v; }
        const float* gain = INP(*a, I_KG) + (li * 3 + 0) * 64;
#pragma unroll
        for (int mi = 0; mi < 4; ++mi) { const int n = m0 + mw + 16 * mi + c; const bool ok = n < NCMP;
            f32x4 v[4]; float ss = 0.f;
#pragma unroll
            for (int ni = 0; ni < 4; ++ni) { v[ni] = acc[ni][mi];
#pragma unroll
                for (int r = 0; r < 4; ++r) { v[ni][r] += bias[4 * ni + r]; ss += v[ni][r] * v[ni][r]; } }
            ss += shflx(ss, 16); ss += shflx(ss, 32);
            if (n >= NCP) continue;
            if (kv == 0) { const float rs = frsq(ss * (1.0f / 64.0f) + EPS); bf16* p = (bf16*)(ws + WS_KC) + ((size_t)bg * NCP + n) * 64;
#pragma unroll
                for (int ni = 0; ni < 4; ++ni) { f32x4 o;
#pragma unroll
                    for (int r = 0; r < 4; ++r) o[r] = ok ? v[ni][r] * rs * gain[16 * ni + 4 * h + r] : 0.f;
                    st_bf4(p + 16 * ni + 4 * h, o); }
            } else { bf16* p = (bf16*)(ws + WS_VCT) + ((size_t)bg * NCP + n) * 64;
#pragma unroll
                for (int ni = 0; ni < 4; ++ni) { f32x4 o;
#pragma unroll
                    for (int r = 0; r < 4; ++r) o[r] = ok ? v[ni][r] : 0.f;
                    st_bf4(p + 16 * ni + 4 * h, o); } }
        }
    }
};


struct EpiResid8 {
    static constexpr bool PERM = true, AFTER_DRAIN = false;
    float* x; const float* gate; const float* xin;
    MDEV void operator()(const f32x4 (&acc)[2][2][4][2], const pg8::Unit& u, int wr, int wc, int fr, int fq) const {
        OPAQUE2(fr, fq);
#pragma unroll
        for (int ai = 0; ai < 2; ++ai)
#pragma unroll
            for (int m = 0; m < 4; ++m) { const int row = 256 * u.pm + 128 * ai + 64 * wr + 16 * m + fr, b = row / SEQ;
#pragma unroll
                for (int bj = 0; bj < 2; ++bj)
#pragma unroll
                    for (int n = 0; n < 2; ++n) { const int col = 256 * u.pn + 128 * bj + 32 * wc + 8 * fq + 4 * n;
                        const f32x4 g = *(const f32x4*)(gate + (size_t)b * 6 * DM + col); f32x4* p = (f32x4*)(x + (size_t)row * DM + col); f32x4 v = *(const f32x4*)(xin + (size_t)row * DM + col);
#pragma unroll
                        for (int r = 0; r < 4; ++r) v[r] += g[r] * acc[ai][bj][m][n][r];
                        *p = v; } }
    }
};
struct EpiGlu8 {
    static constexpr bool PERM = true, AFTER_DRAIN = false;
    bf16* dst;
    MDEV void operator()(const f32x4 (&acc)[2][2][4][2], const pg8::Unit& u, int wr, int wc, int fr, int fq) const {
        OPAQUE2(fr, fq);
#pragma unroll
        for (int ai = 0; ai < 2; ++ai)
#pragma unroll
            for (int m = 0; m < 4; ++m) { const int row = 256 * u.pm + 128 * ai + 64 * wr + 16 * m + fr;
#pragma unroll
                for (int bj = 0; bj < 2; ++bj) { const int col = 128 * u.pn + 64 * bj + 16 * wc + 4 * fq; f32x4 o;
#pragma unroll
                    for (int r = 0; r < 4; ++r) o[r] = acc[ai][bj][m][0][r] * sigm(acc[ai][bj][m][1][r]);
                    st_bf4(dst + (size_t)row * DM + col, o); } }
    }
};
struct EpiMoe1_8 {
    static constexpr bool PERM = true, AFTER_DRAIN = false;
    bf16* dst;
    MDEV void operator()(const f32x4 (&acc)[2][2][4][2], const pg8::Unit& u, int wr, int wc, int fr, int fq) const {
        OPAQUE2(fr, fq);
#pragma unroll
        for (int ai = 0; ai < 2; ++ai)
#pragma unroll
            for (int m = 0; m < 4; ++m) { const int row = 256 * u.pm + 128 * ai + 64 * wr + 16 * m + fr;
#pragma unroll
                for (int bj = 0; bj < 2; ++bj) { const int col = 128 * u.pn + 64 * bj + 16 * wc + 4 * fq; f32x4 o;
#pragma unroll
                    for (int r = 0; r < 4; ++r) o[r] = siluf(acc[ai][bj][m][0][r]) * acc[ai][bj][m][1][r];
#ifdef EMU
                    st_bf4(dst + (size_t)row * FF + col, o); } }
#else
                    const unsigned long long pk = (unsigned long long)pk2(o[0], o[1]) | ((unsigned long long)pk2(o[2], o[3]) << 32);
                    __hip_atomic_store((__attribute__((address_space(1))) unsigned long long*)(dst + (size_t)row * FF + col), pk, __ATOMIC_RELAXED, __HIP_MEMORY_SCOPE_AGENT); } }
#endif
    }
};
struct EpiMoe2_8 {
    static constexpr bool PERM = true, AFTER_DRAIN = false;
    bf16* dst;
    MDEV void operator()(const f32x4 (&acc)[2][2][4][2], const pg8::Unit& u, int wr, int wc, int fr, int fq) const {
        OPAQUE2(fr, fq);
#pragma unroll
        for (int ai = 0; ai < 2; ++ai)
#pragma unroll
            for (int m = 0; m < 4; ++m) { const int row = 256 * u.pm + 128 * ai + 64 * wr + 16 * m + fr;
#pragma unroll
                for (int bj = 0; bj < 2; ++bj) { const int col = 256 * u.pn + 128 * bj + 32 * wc + 8 * fq;
                    st_bf8(dst + (size_t)row * DM + col, acc[ai][bj][m][0], acc[ai][bj][m][1]); } }
    }
};
DEV unsigned uni(unsigned x);
template <bool G> struct MoeSel {
    static constexpr bool GATHER = G;
    const int* rb; const int* cnt; const int* list; size_t bstride;
    struct Ctx { int e, rbase, c; };
    MDEV Ctx ctx(const pg8::Unit& u) const { int e = 0;
#pragma unroll 1
        for (int q = 1; q < 32; ++q) if ((rb[q] >> 8) <= u.pm) e = q;
        e = (int)uni((unsigned)e); Ctx x; x.e = e; x.rbase = (int)uni((unsigned)((u.pm << 8) - rb[e])); x.c = G ? (int)uni((unsigned)cnt[e * 64]) : 0; return x; }
    MDEV size_t boff(const Ctx& x) const { return (size_t)x.e * bstride; }
    MDEV unsigned aoff(const Ctx& x, int r) const { int p = x.rbase + r; if (p > x.c - 1) p = x.c - 1; return (unsigned)list[(size_t)x.e * T + p] * (unsigned)(DM * 2); }
};
struct EpiInProj8 {
    static constexpr bool PERM = true, AFTER_DRAIN = false;
    const Args* a; int li;
    MDEV void operator()(const f32x4 (&acc)[2][2][4][2], const pg8::Unit& u, int wr, int wc, int fr, int fq) const {
        OPAQUE2(fr, fq);
        unsigned char* ws = wsp(*a);
        const int nb = 256 * u.pn + 64 * wc;
        if (nb >= 3392) return;
        if (nb < 512 || (nb >= 768 && nb < 896) || (nb >= 1024 && nb < 1152)) {
            const float* gain; float mul = 1.f; int kind;
            if (nb < 512) { gain = INP(*a, I_QG) + li * 64; mul = 0.125f * LOG2E; kind = 0; }
            else if (nb < 896) { gain = INP(*a, I_KG) + (li * 3 + 1) * 64; kind = 1; }
            else { gain = INP(*a, I_KG) + (li * 3 + 2) * 64; kind = 2; }
            const int g = (nb >> 6) & 1;
            f32x4 gv[2][2];
#pragma unroll
            for (int bj = 0; bj < 2; ++bj)
#pragma unroll
                for (int n = 0; n < 2; ++n) gv[bj][n] = *(const f32x4*)(gain + 32 * bj + 8 * fq + 4 * n);
#pragma unroll
            for (int ai = 0; ai < 2; ++ai)
#pragma unroll
                for (int m = 0; m < 4; ++m) { const int tok = 256 * u.pm + 128 * ai + 64 * wr + 16 * m + fr;
                    float ss = 0.f;
#pragma unroll
                    for (int bj = 0; bj < 2; ++bj)
#pragma unroll
                        for (int n = 0; n < 2; ++n) { const f32x4 v = acc[ai][bj][m][n]; ss += v[0] * v[0] + v[1] * v[1] + v[2] * v[2] + v[3] * v[3]; }
                    ss += shflx(ss, 16); ss += shflx(ss, 32);
                    const float rs = frsq(ss * (1.0f / 64.0f) + EPS) * mul;
                    bf16* dst; if (kind == 0) dst = (bf16*)(ws + WS_QN) + (size_t)tok * 512 + nb; else { const int b = tok / SEQ, sq = tok % SEQ; dst = (bf16*)(ws + (kind == 1 ? WS_KS : WS_KW)) + ((size_t)(b * 2 + g) * SEQ + sq) * 64; }
#pragma unroll
                    for (int bj = 0; bj < 2; ++bj) { f32x4 o0, o1;
#pragma unroll
                        for (int r = 0; r < 4; ++r) { o0[r] = acc[ai][bj][m][0][r] * rs * gv[bj][0][r]; o1[r] = acc[ai][bj][m][1][r] * rs * gv[bj][1][r]; }
                        st_bf8(dst + 32 * bj + 8 * fq, o0, o1); } }
        } else if (nb < 768) {
            bf16* base = (bf16*)(ws + (nb < 640 ? WS_KCG : WS_VCG)); const int g = (nb >> 6) & 1;
#pragma unroll
            for (int ai = 0; ai < 2; ++ai)
#pragma unroll
                for (int m = 0; m < 4; ++m) { const int tok = 256 * u.pm + 128 * ai + 64 * wr + 16 * m + fr, b = tok / SEQ, sq = tok % SEQ;
#pragma unroll
                    for (int bj = 0; bj < 2; ++bj) st_bf8(base + ((size_t)(b * 2 + g) * SEQ + sq) * 64 + 32 * bj + 8 * fq, acc[ai][bj][m][0], acc[ai][bj][m][1]); }
        } else if (nb < 1280) {
            bf16* base = (bf16*)(ws + (nb < 1024 ? WS_VST : WS_VWT)); const int g = (nb >> 6) & 1;
#pragma unroll
            for (int ai = 0; ai < 2; ++ai)
#pragma unroll
                for (int m = 0; m < 4; ++m) { const int tok = 256 * u.pm + 128 * ai + 64 * wr + 16 * m + fr, b = tok / SEQ, sq = tok % SEQ;
#pragma unroll
                    for (int bj = 0; bj < 2; ++bj) st_bf8(base + ((size_t)(b * 2 + g) * SEQ + sq) * 64 + 32 * bj + 8 * fq, acc[ai][bj][m][0], acc[ai][bj][m][1]); }
        } else if (nb < 3328) {
            const int sec = (nb - 1280) >> 9, cc = (nb - 1280) & 511, hh = cc >> 7, d0 = cc & 127;
            f32x4 lbv[2][2];
            if (sec == 1) {
#pragma unroll
                for (int bj = 0; bj < 2; ++bj)
#pragma unroll
                    for (int n = 0; n < 2; ++n) lbv[bj][n] = *(const f32x4*)((const float*)(ws + WS_LB) + li * 512 + cc + 32 * bj + 8 * fq + 4 * n); }
#pragma unroll
            for (int ai = 0; ai < 2; ++ai)
#pragma unroll
                for (int m = 0; m < 4; ++m) { const int tok = 256 * u.pm + 128 * ai + 64 * wr + 16 * m + fr, b = tok / SEQ, sq = tok % SEQ;
                    const size_t hrow = ((size_t)(b * 4 + hh) * SEQ + sq) * 128 + d0;
#pragma unroll
                    for (int bj = 0; bj < 2; ++bj) { const int d = 32 * bj + 8 * fq; f32x4 o0, o1;
                        if (sec == 0) {
#pragma unroll
                            for (int r = 0; r < 4; ++r) { o0[r] = siluf(acc[ai][bj][m][0][r]); o1[r] = siluf(acc[ai][bj][m][1][r]); }
                            st_bf8((bf16*)(ws + WS_HQ) + hrow + d, o0, o1); }
                        else if (sec == 1) {
#pragma unroll
                            for (int r = 0; r < 4; ++r) { o0[r] = lbv[bj][0][r] + (1.0f - lbv[bj][0][r]) * sigm(acc[ai][bj][m][0][r]); o1[r] = lbv[bj][1][r] + (1.0f - lbv[bj][1][r]) * sigm(acc[ai][bj][m][1][r]); }
                            float* pf = (float*)(ws + WS_HF) + hrow + d; *(f32x4*)pf = o0; *(f32x4*)(pf + 4) = o1; }
                        else if (sec == 2) st_bf8((bf16*)(ws + WS_HV) + hrow + d, acc[ai][bj][m][0], acc[ai][bj][m][1]);
                        else {
#pragma unroll
                            for (int r = 0; r < 4; ++r) { o0[r] = siluf(acc[ai][bj][m][0][r]); o1[r] = siluf(acc[ai][bj][m][1][r]); }
                            st_bf8((bf16*)(ws + WS_HGS) + (size_t)tok * 512 + cc + d, o0, o1); } } }
        } else {
            float* dst = (float*)(ws + WS_GATE);
            if (fq < 3) {
#pragma unroll
                for (int ai = 0; ai < 2; ++ai)
#pragma unroll
                    for (int m = 0; m < 4; ++m) { const int tok = 256 * u.pm + 128 * ai + 64 * wr + 16 * m + fr; f32x4 o0, o1;
#pragma unroll
                        for (int r = 0; r < 4; ++r) { o0[r] = sigm(acc[ai][0][m][0][r]); o1[r] = sigm(acc[ai][0][m][1][r]); }
                        float* pf = dst + (size_t)tok * 24 + 8 * fq; *(f32x4*)pf = o0; *(f32x4*)(pf + 4) = o1; } }
        }
    }
};

DEV void tr_tile(unsigned char* smem, const float* src0, const float* src1, int ld, int K, int mode, bf16* dst, int n0, int k0) {
    bf16* tl = (bf16*)smem;
    const int tid = TID;
    SYNC();
#pragma unroll
    for (int i = 0; i < 8; ++i) {
        const int e = tid + 512 * i, kk = e >> 6, nn = e & 63, n = n0 + nn; float v = 0.f;
        if (mode == 0) v = src0[(size_t)(k0 + kk) * ld + n];
        else if (mode == 1) { int sc = n < 1280 ? n : (n < 3328 ? n + 24 : (n < 3352 ? 1280 + (n - 3328) : -1)); if (sc >= 0) v = src0[(size_t)(k0 + kk) * ld + sc]; }
        else { const int g = n >> 6, w = n & 63; v = (w < 32) ? src0[(size_t)(k0 + kk) * ld + g * 32 + w] : src1[(size_t)(k0 + kk) * ld + g * 32 + w - 32]; }
        tl[nn * LDT + kk] = (bf16)f2bf(v);
    }
    SYNC();
    const int nn = tid >> 3, k8 = (tid & 7) * 8;
    *(bf16x8*)(dst + (size_t)(n0 + nn) * K + k0 + k8) = *(const bf16x8*)(tl + nn * LDT + k8);
}

DEV int tr_col(int mode, int n) {
    if (mode == 0) return n;
    const int pn = n >> 8, ct = n & 255;
    if (mode == 5) { const int bj = ct >> 7, wc = (ct >> 5) & 3, j = ct & 31, L = 256 * pn + 64 * wc + 32 * bj + j; return L < 1280 ? L : (L < 3328 ? L + 24 : (L < 3352 ? 1280 + (L - 3328) : -1)); }
    { const int bj = ct >> 7, wc = (ct >> 5) & 3, j = ct & 31, nn = (j >> 2) & 1, Lc = 128 * pn + 64 * bj + 16 * wc + 4 * (j >> 3) + (j & 3); return nn == 0 ? Lc : (mode == 7 ? FF : DM) + Lc; }
}
DEV void tr_tile(unsigned char* smem, const float* src, int ld, int K, int mode, bf16* dst, int n0, int k0) {
    bf16* tl = (bf16*)smem;
    const int tid = TID, nq = tid & 31, kq = tid >> 5;
    const int sc = tr_col(mode, n0 + 4 * nq);
    f32x4 v[4];
#pragma unroll
    for (int i = 0; i < 4; ++i) v[i] = sc >= 0 ? *(const f32x4*)(src + (size_t)(k0 + 4 * kq + i) * ld + sc) : f4zero();
    SYNC();
#pragma unroll
    for (int j = 0; j < 4; ++j) { u32x2 w; w[0] = pk2(v[0][j], v[1][j]); w[1] = pk2(v[2][j], v[3][j]); *(u32x2*)(tl + (4 * nq + j) * LDT + 4 * kq) = w; }
    SYNC();
#pragma unroll
    for (int t = 0; t < 2; ++t) { const int id = tid + 512 * t, row = id >> 3, ch = id & 7;
        *(bf16x8*)(dst + (size_t)(n0 + row) * K + k0 + 8 * ch) = *(const bf16x8*)(tl + row * LDT + 8 * ch); }
}
constexpr int KSUP = FF >= 256 ? 256 : FF, NSUP = KSUP / 64;
DEV void tr_super(unsigned char* smem, const float* src0, const float* src1, int ld, int K, int mode, bf16* dst, int n0, int k0) {
    const int tid = TID, nq = tid & 31, kq = tid >> 5;
    int sc = n0 + 4 * nq; const float* src = src0;
    if (mode == 7) { const int cc = tr_col(7, sc); src = cc >= FF ? src1 : src0; sc = cc >= FF ? cc - FF : cc; }
    f32x4 v[NSUP][4];
#pragma unroll
    for (int sb = 0; sb < NSUP; ++sb)
#pragma unroll
        for (int i = 0; i < 4; ++i) v[sb][i] = *(const f32x4*)(src + (size_t)(k0 + 64 * sb + 4 * kq + i) * ld + sc);
    SYNC();
    const int fw = nq & (KSUP / 16 - 1);
#pragma unroll
    for (int j = 0; j < 4; ++j)
#pragma unroll
        for (int sb = 0; sb < NSUP; ++sb) { const int c16 = 8 * sb + (kq >> 1); u32x2 w; w[0] = pk2(v[sb][0][j], v[sb][1][j]); w[1] = pk2(v[sb][2][j], v[sb][3][j]);
            *(u32x2*)(smem + (4 * nq + j) * (KSUP * 2) + ((c16 ^ fw) << 4) + (kq & 1) * 8) = w; }
    SYNC();
#pragma unroll
    for (int t = 0; t < 128 * (KSUP / 8) / NT; ++t) { const int id = tid + NT * t, row = id / (KSUP / 8), ch = id % (KSUP / 8), f = (row >> 2) & (KSUP / 16 - 1);
        *(bf16x8*)(dst + (size_t)(n0 + row) * K + k0 + 8 * (ch ^ f)) = *(const bf16x8*)(smem + row * (KSUP * 2) + ch * 16); }
}
struct TrJob { const float* s; int ld, K, N, mode; bf16* dst; };
DEV void p0_phase(const Args& a, unsigned char* smem) {
    unsigned char* ws = wsp(a); const int tid = TID;
    { int item = BID, base = 0;
      for (int j = 0; j < 8; ++j) { TrJob J; const int i = j & 1;
        if (j < 2) J = {INP(a, I_WIN) + (size_t)i * DM * NIN, NIN, DM, NIN8, 5, (bf16*)(ws + WS_WIN) + (size_t)i * NIN8 * DM};
        else if (j < 4) J = {INP(a, I_WOUT) + (size_t)i * 1024 * DM, DM, 1024, DM, 0, (bf16*)(ws + WS_WOUT) + (size_t)i * DM * 1024};
        else if (j < 6) J = {INP(a, I_PW1) + (size_t)i * DM * 2 * DM, 2 * DM, DM, 2 * DM, 6, (bf16*)(ws + WS_PW1) + (size_t)i * 2 * DM * DM};
        else J = {INP(a, I_PW2) + (size_t)i * DM * DM, DM, DM, DM, 0, (bf16*)(ws + WS_PW2) + (size_t)i * DM * DM};
        const int tn = J.N / 128, tk = J.K / 64, nt = tn * tk;
        while (item < base + nt) { const int it = item - base; tr_tile(smem, J.s, J.ld, J.K, J.mode, J.dst, (it % tn) * 128, (it / tn) * 64); item += NBLK; }
        base += nt; }
      SYNC(); }
    {
        float* red = (float*)smem;
        constexpr int NG = 6 * DM / 128; const int ntask = DEPTH * NG;
        for (int t = BID; t < ntask; t += NBLK) {
            const int l = t / NG, j0 = (t % NG) * 128, cq = tid & 31, kr = tid >> 5;
            const float* w = INP(a, I_ADAW) + (size_t)l * DM * 6 * DM + j0 + 4 * cq; const float* cc = INP(a, I_C);
            f32x4 a0 = f4zero(), a1 = f4zero();
#pragma unroll 8
            for (int i = 0; i < DM / 16; ++i) { const int k = kr + 16 * i; const f32x4 wv = *(const f32x4*)(w + (size_t)k * 6 * DM); const float s0 = siluf(cc[k]), s1 = siluf(cc[DM + k]);
#pragma unroll
                for (int r = 0; r < 4; ++r) { a0[r] += s0 * wv[r]; a1[r] += s1 * wv[r]; } }
            SYNC();
            *(f32x4*)(red + (kr * 2 + 0) * 128 + 4 * cq) = a0; *(f32x4*)(red + (kr * 2 + 1) * 128 + 4 * cq) = a1;
            SYNC();
            if (tid < 256) { const int b = tid >> 7, col = tid & 127; float sum = INP(a, I_ADAB)[(size_t)l * 6 * DM + j0 + col];
#pragma unroll
                for (int q = 0; q < 16; ++q) sum += red[(q * 2 + b) * 128 + col];
                ((float*)(ws + WS_MOD))[((size_t)l * 2 + b) * 6 * DM + j0 + col] = sum; }
        }
    }
    for (int t = BID; t < 32; t += NBLK) {
        float* red = (float*)smem; const int ikv = t >> 3, kp = t & 7, i = ikv >> 1, kv = ikv & 1, e = tid & 63, ks = tid >> 6;
        const float* W = INP(a, kv ? I_CWV : I_CWK) + (size_t)i * 2048 * 64 + e; const float* pe = INP(a, I_CPE) + (size_t)i * 2048;
        float sum = 0.f;
#pragma unroll 8
        for (int q = 0; q < 32; ++q) { const int k = kp * 256 + ks * 32 + q; sum += pe[k] * W[(size_t)k * 64]; }
        SYNC(); red[ks * 64 + e] = sum; SYNC();
        if (tid < 64) { float v = 0.f; for (int q = 0; q < 8; ++q) v += red[q * 64 + tid]; ((float*)(ws + WS_CB))[(ikv * 8 + kp) * 64 + tid] = v; }
    }
    for (int i = BID * NT + tid; i < DEPTH * 48 * DM; i += NBLK * NT) { const int k = i % DM, n = (i / DM) % 48, ll = i / (48 * DM);
        const float wv = n < 4 ? INP(a, I_WG)[((size_t)ll * DM + k) * 4 + n] : (n < 36 ? INP(a, I_WE)[((size_t)ll * DM + k) * 32 + n - 4] : 0.f);
        const unsigned hi = f2bf(wv); ((bf16*)(ws + WS_WTH))[i] = (bf16)hi; ((bf16*)(ws + WS_WTL))[i] = (bf16)f2bf(wv - bf2f(hi)); }
    if (BID == 0) {
        for (int i = tid; i < DEPTH * 32; i += NT) ((int*)(ws + WS_CNT))[i * 64] = 0;
        for (int i = tid; i < DEPTH * 256; i += NT) ((unsigned*)(ws + WS_FLG))[i * 16] = 0u;
        for (int n = tid; n < 512; n += NT) { const float l0 = INP(a, I_LBL)[n], l1 = INP(a, I_LBL)[512 + n]; const float m = fmaxf(l0, l1);
            const float e0 = fexp2((l0 - m) * LOG2E), e1 = fexp2((l1 - m) * LOG2E);
            ((float*)(ws + WS_LB))[n] = 0.f; ((float*)(ws + WS_LB))[512 + n] = e1 / (e0 + e1); }
        if (tid < 2) { const int i = tid; float mq = 0.f; for (int d = 0; d < 64; ++d) mq = fmaxf(mq, fabsf(INP(a, I_QG)[i * 64 + d]));
            for (int br = 0; br < 3; ++br) { float mk = 0.f; for (int d = 0; d < 64; ++d) mk = fmaxf(mk, fabsf(INP(a, I_KG)[(i * 3 + br) * 64 + d]));
                ((float*)(ws + WS_CS))[i * 4 + br] = 8.0f * mq * mk * LOG2E; } }
    }
    SYNC();
    { constexpr int S13 = (2 * FF / 128) * (DM / KSUP), S2 = (DM / 128) * (FF / KSUP), SPE = S13 + S2, NIT = DEPTH * 32 * SPE;
#ifdef EMU
      for (int it = BID; it < NIT; it += NBLK) {
#else
      int* ctr = (int*)(ws + WS_BAR) + P0_CTR_IDX; int* nxl = (int*)(smem + 72 * 1024);
      int my_next = 0; if (tid == 0) my_next = atomic_add_i(ctr, 1);
      for (;;) { if (tid == 0) nxl[0] = my_next; SYNC(); const int it = nxl[0]; if (it >= NIT) break; if (tid == 0) my_next = atomic_add_i(ctr, 1);
#endif
        const int le = it / SPE, r = it % SPE;
        if (r < S13) { const int tn = r % (2 * FF / 128), tk = r / (2 * FF / 128);
            tr_super(smem, INP(a, I_W1) + (size_t)le * DM * FF, INP(a, I_W3) + (size_t)le * DM * FF, FF, DM, 7, (bf16*)(ws + WS_W13) + (size_t)le * 2 * FF * DM, tn * 128, tk * KSUP); }
        else { const int r2 = r - S13, tn = r2 % (DM / 128), tk = r2 / (DM / 128);
            tr_super(smem, INP(a, I_W2) + (size_t)le * FF * DM, INP(a, I_W2), DM, FF, 0, (bf16*)(ws + WS_W2) + (size_t)le * DM * FF, tn * 128, tk * KSUP); } }
      SYNC(); }
}

constexpr int NJV = DM / 256;
DEV void moe_bases(const int* cnt, int* rb  ) {
    if (TID == 0) { int acc = 0; for (int e = 0; e < 32; ++e) { rb[e] = acc; acc += ((cnt[e * 64] + 255) >> 8) << 8; } rb[32] = acc; }
    SYNC();
}
DEV void norm_phase(const Args& a, unsigned char* smem, int l) {
    unsigned char* ws = wsp(a); const int tid = TID, w = tid >> 6, lane = tid & 63;
    int* rb = (int*)smem;
    if (l > 0) moe_bases((const int*)(ws + WS_CNT) + (l - 1) * 32 * 64, rb);
    const float* mod = (const float*)(ws + WS_MOD);
    const bf16* yk = (const bf16*)(ws + WS_YK);
    if (l < DEPTH) {
        const int bid = BID % 76 == BID ? BID : -1;
        for (int job = BID; job < 76; job += NBLK) {
            if (job < 72) { const int b = job / 36, n = job % 36; float sum = 0.f;
                for (int k = tid; k < DM; k += NT) { const float wv = n < 4 ? INP(a, I_WG)[((size_t)l * DM + k) * 4 + n] : INP(a, I_WE)[((size_t)l * DM + k) * 32 + n - 4]; sum += mod[((size_t)l * 2 + b) * 6 * DM + 3 * DM + k] * wv; }
#pragma unroll
                for (int q = 1; q < 64; q <<= 1) sum += shflx(sum, q);
                float* red = (float*)(smem + 1024);
                SYNC(); if (lane == 0) red[w] = sum; SYNC();
                if (tid == 0) { float t = 0.f; for (int q = 0; q < 8; ++q) t += red[q]; ((float*)(ws + WS_RBIAS))[((size_t)l * 2 + b) * 48 + n] = t; }
            } else { const float* nf = INP(a, I_NFFN) + (size_t)l * DM; const int part = job - 72;
                for (int i = part * (2 * DM / 4) + tid; i < (part + 1) * (2 * DM / 4); i += NT) { const int b = i / DM, k = i % DM; ((float*)(ws + WS_AVEC))[((size_t)l * 2 + b) * DM + k] = nf[k] * (1.0f + mod[((size_t)l * 2 + b) * 6 * DM + 4 * DM + k]); } }
        }
        (void)bid;
    }
    const int rstride = NBLK * 8;
    for (int rowa = BID * 8 + w; rowa < T; rowa += 2 * rstride) {
        int row[2]; bool ok[2];
        row[0] = rowa; ok[0] = true; row[1] = rowa + rstride; ok[1] = row[1] < T; if (!ok[1]) row[1] = rowa;
        f32x4 v[2][NJV]; int e0[2], p0[2], e1[2], p1[2]; float w0[2], w1[2];
        const float* xin = (l == 0) ? INP(a, I_X) : outp(a);
#pragma unroll
        for (int q = 0; q < 2; ++q) {
#pragma unroll
            for (int j = 0; j < NJV; ++j) v[q][j] = *(const f32x4*)(xin + (size_t)row[q] * DM + 4 * lane + 256 * j);
            if (l > 0) { const int* tie = (const int*)(ws + WS_TIE) + (size_t)row[q] * 2; const float* tiw = (const float*)(ws + WS_TIW) + (size_t)row[q] * 2;
                e0[q] = tie[0] >> 14; p0[q] = tie[0] & 16383; e1[q] = tie[1] >> 14; p1[q] = tie[1] & 16383; w0[q] = tiw[0]; w1[q] = tiw[1]; } }
        if (l > 0) {
            u32x2 q0[2][NJV], q1[2][NJV];
#pragma unroll
            for (int q = 0; q < 2; ++q) { const bf16* y0 = yk + (size_t)(rb[e0[q]] + p0[q]) * DM; const bf16* y1 = yk + (size_t)(rb[e1[q]] + p1[q]) * DM;
#pragma unroll
                for (int j = 0; j < NJV; ++j) { const int cidx = 4 * lane + 256 * j; q0[q][j] = *(const u32x2*)(y0 + cidx); q1[q][j] = *(const u32x2*)(y1 + cidx); } }
#pragma unroll
            for (int q = 0; q < 2; ++q) { const int b = row[q] / SEQ; const float* gf = mod + ((size_t)(l - 1) * 2 + b) * 6 * DM + 5 * DM;
#pragma unroll
                for (int j = 0; j < NJV; ++j) { const int cidx = 4 * lane + 256 * j; const f32x4 g = *(const f32x4*)(gf + cidx);
                    v[q][j][0] += g[0] * (w0[q] * bf2f(q0[q][j][0] & 0xffff) + w1[q] * bf2f(q1[q][j][0] & 0xffff));
                    v[q][j][1] += g[1] * (w0[q] * bf2f(q0[q][j][0] >> 16) + w1[q] * bf2f(q1[q][j][0] >> 16));
                    v[q][j][2] += g[2] * (w0[q] * bf2f(q0[q][j][1] & 0xffff) + w1[q] * bf2f(q1[q][j][1] & 0xffff));
                    v[q][j][3] += g[3] * (w0[q] * bf2f(q0[q][j][1] >> 16) + w1[q] * bf2f(q1[q][j][1] >> 16)); } }
        }
        if (l > 0)
#pragma unroll
        for (int q = 0; q < 2; ++q) { if (!ok[q]) continue;
#pragma unroll
            for (int j = 0; j < NJV; ++j) *(f32x4*)(outp(a) + (size_t)row[q] * DM + 4 * lane + 256 * j) = v[q][j]; }
        if (l == DEPTH) continue;
        float ss[2];
#pragma unroll
        for (int q = 0; q < 2; ++q) { ss[q] = 0.f;
#pragma unroll
            for (int j = 0; j < NJV; ++j) ss[q] += v[q][j][0] * v[q][j][0] + v[q][j][1] * v[q][j][1] + v[q][j][2] * v[q][j][2] + v[q][j][3] * v[q][j][3]; }
#pragma unroll
        for (int o = 1; o < 64; o <<= 1) { ss[0] += shflx(ss[0], o); ss[1] += shflx(ss[1], o); }
        const float* nm = INP(a, I_NMIX) + (size_t)l * DM;
#pragma unroll
        for (int q = 0; q < 2; ++q) { if (!ok[q]) continue;
            const int b = row[q] / SEQ; const float rs = frsq(ss[q] * (1.0f / DM) + EPS);
            const float* mm = mod + ((size_t)l * 2 + b) * 6 * DM; bf16* hb = (bf16*)(ws + WS_H) + (size_t)row[q] * DM;
#pragma unroll
            for (int j = 0; j < NJV; ++j) { const int cidx = 4 * lane + 256 * j; f32x4 g = *(const f32x4*)(nm + cidx), sh = *(const f32x4*)(mm + cidx), sc = *(const f32x4*)(mm + DM + cidx), o;
#pragma unroll
                for (int r = 0; r < 4; ++r) o[r] = v[q][j][r] * rs * g[r] * (1.0f + sc[r]) + sh[r];
                st_bf4(hb + cidx, o); } }
    }
}

DEV void route_phase(const Args& a, unsigned char* smem, int l) {
    unsigned char* ws = wsp(a); const int tid = TID, w = tid >> 6, lane = tid & 63, h = lane >> 4, c = lane & 15, pi = w >> 1, kh = w & 1;
    constexpr int NCHK = 4, CH = DM / NCHK, WLD = CH + 8, NKS = CH / 2 / 32;
    constexpr int WTOT = 48 * (CH / 8), WMAX = (WTOT + NT - 1) / NT;
    bf16* WHl = (bf16*)smem; bf16* WLl = WHl + 48 * WLD;
    float* lg = (float*)(WLl + 48 * WLD);
    float* ssb = lg + 4 * 2 * 16 * 48;
    float* rsb = ssb + 4 * 2 * 16;
    int* lcnt = (int*)(rsb + 64); int* lbase = lcnt + 32; int* tinfo = lbase + 32;
    float* avl = (float*)(tinfo + 256); float* cvl = avl + 2 * DM;
    const float* mod = (const float*)(ws + WS_MOD);
    SYNC();
    if (tid < 32) lcnt[tid] = 0;
    for (int i = tid; i < 2 * DM; i += NT) { const int b = i / DM, k = i % DM; avl[i] = ((const float*)(ws + WS_AVEC))[((size_t)l * 2 + b) * DM + k]; cvl[i] = mod[((size_t)l * 2 + b) * 6 * DM + 3 * DM + k]; }
    const bf16* WH = (const bf16*)(ws + WS_WTH) + (size_t)l * 48 * DM; const bf16* WL = (const bf16*)(ws + WS_WTL) + (size_t)l * 48 * DM;
    int* cnt = (int*)(ws + WS_CNT) + l * 32 * 64;
    for (int pass0 = BID; pass0 < T / 16; pass0 += 4 * NBLK) {
        const int pass = pass0 + pi * NBLK; const bool valid = pass < T / 16;
        const int tok = valid ? pass * 16 + c : 0, b = tok / SEQ;
        const float* xrow = outp(a) + (size_t)tok * DM;
        f32x4 xv[2][NKS][2]; bf16x8 wh[WMAX], wl[WMAX];
#pragma unroll
        for (int ks = 0; ks < NKS; ++ks) { const float* xq = xrow + kh * (CH / 2) + 8 * h + 32 * ks; xv[0][ks][0] = *(const f32x4*)xq; xv[0][ks][1] = *(const f32x4*)(xq + 4); }
#pragma unroll
        for (int t = 0; t < WMAX; ++t) { const int i = tid + NT * t; if (i < WTOT) { const int n = i / (CH / 8), k8 = (i % (CH / 8)) * 8; wh[t] = *(const bf16x8*)(WH + (size_t)n * DM + k8); wl[t] = *(const bf16x8*)(WL + (size_t)n * DM + k8); } }
        f32x4 acc[3] = {f4zero(), f4zero(), f4zero()}; float ss = 0.f;
        bf16x8 uhk[NCHK * NKS];
#pragma unroll
        for (int chn = 0; chn < NCHK; ++chn) {
            SYNC();
#pragma unroll
            for (int t = 0; t < WMAX; ++t) { const int i = tid + NT * t; if (i < WTOT) { const int n = i / (CH / 8), k8 = (i % (CH / 8)) * 8; *(bf16x8*)(WHl + n * WLD + k8) = wh[t]; *(bf16x8*)(WLl + n * WLD + k8) = wl[t]; } }
            SYNC();
            if (chn + 1 < NCHK) {
#pragma unroll
                for (int ks = 0; ks < NKS; ++ks) { const float* xq = xrow + (chn + 1) * CH + kh * (CH / 2) + 8 * h + 32 * ks; xv[(chn + 1) & 1][ks][0] = *(const f32x4*)xq; xv[(chn + 1) & 1][ks][1] = *(const f32x4*)(xq + 4); }
#pragma unroll
                for (int t = 0; t < WMAX; ++t) { const int i = tid + NT * t; if (i < WTOT) { const int n = i / (CH / 8), k8 = (i % (CH / 8)) * 8; wh[t] = *(const bf16x8*)(WH + (size_t)n * DM + (chn + 1) * CH + k8); wl[t] = *(const bf16x8*)(WL + (size_t)n * DM + (chn + 1) * CH + k8); } }
            }
            if (valid) {
                const bf16* whp = WHl + c * WLD + kh * (CH / 2) + 8 * h; const bf16* wlp = WLl + c * WLD + kh * (CH / 2) + 8 * h;
                const float* ap = avl + b * DM + chn * CH + kh * (CH / 2) + 8 * h;
#pragma unroll
                for (int ks = 0; ks < NKS; ++ks) {
                    const f32x4 a0 = *(const f32x4*)(ap + 32 * ks), a1 = *(const f32x4*)(ap + 32 * ks + 4);
                    const f32x4 x0 = xv[chn & 1][ks][0], x1 = xv[chn & 1][ks][1];
                    f32x4 u0, u1, r0, r1;
#pragma unroll
                    for (int r = 0; r < 4; ++r) { u0[r] = x0[r] * a0[r]; u1[r] = x1[r] * a1[r]; ss += x0[r] * x0[r] + x1[r] * x1[r]; }
                    const bf16x8 uh = pack8(u0, u1); uhk[chn * NKS + ks] = uh;
#pragma unroll
                    for (int r = 0; r < 4; ++r) { r0[r] = u0[r] - bf2f((unsigned short)uh[r]); r1[r] = u1[r] - bf2f((unsigned short)uh[4 + r]); }
                    const bf16x8 ul = pack8(r0, r1);
#pragma unroll
                    for (int nt = 0; nt < 3; ++nt) { const bf16x8 whf = *(const bf16x8*)(whp + nt * 16 * WLD + 32 * ks), wlf = *(const bf16x8*)(wlp + nt * 16 * WLD + 32 * ks);
                        acc[nt] = mfma16(whf, uh, acc[nt]); acc[nt] = mfma16(wlf, uh, acc[nt]); acc[nt] = mfma16(whf, ul, acc[nt]); }
                }
            }
        }
        if (valid) {
            ss += shflx(ss, 16); ss += shflx(ss, 32);
            float* lgp = lg + ((pi * 2 + kh) * 16 + c) * 48 + 4 * h;
#pragma unroll
            for (int nt = 0; nt < 3; ++nt) *(f32x4*)(lgp + 16 * nt) = acc[nt];
            if (h == 0) ssb[(pi * 2 + kh) * 16 + c] = ss;
        }
        SYNC();
        if (tid < 64) { const int p2 = tid >> 4, tk = tid & 15, pass2 = pass0 + p2 * NBLK;
            if (pass2 < T / 16) { const int tok2 = pass2 * 16 + tk, b2 = tok2 / SEQ;
                const float rs = frsq((ssb[(p2 * 2 + 0) * 16 + tk] + ssb[(p2 * 2 + 1) * 16 + tk]) * (1.0f / DM) + EPS); rsb[p2 * 16 + tk] = rs;
                const float* l0 = lg + ((p2 * 2 + 0) * 16 + tk) * 48; const float* l1 = lg + ((p2 * 2 + 1) * 16 + tk) * 48; const float* rbp = (const float*)(ws + WS_RBIAS) + ((size_t)l * 2 + b2) * 48;
                float acc[36];
#pragma unroll
                for (int n = 0; n < 36; ++n) acc[n] = rs * (l0[n] + l1[n]) + rbp[n];
                int gs = 0; float gm = acc[0];
#pragma unroll
                for (int g = 1; g < 4; ++g) if (acc[g] > gm) { gm = acc[g]; gs = g; }
                float den = 0.f;
#pragma unroll
                for (int g = 0; g < 4; ++g) den += fexp2((acc[g] - gm) * LOG2E);
                const float ggate = 1.0f / den;
                float el[8];
#pragma unroll
                for (int j = 0; j < 8; ++j) { el[j] = acc[4 + j];
#pragma unroll
                    for (int g = 1; g < 4; ++g) if (gs == g) el[j] = acc[4 + 8 * g + j]; }
                int ia = 0; float va = el[0];
#pragma unroll
                for (int j = 1; j < 8; ++j) if (el[j] > va) { va = el[j]; ia = j; }
                int ib = -1; float vb = -3e38f;
#pragma unroll
                for (int j = 0; j < 8; ++j) if (j != ia && el[j] > vb) { vb = el[j]; ib = j; }
                const float wa = 1.0f / (1.0f + fexp2((vb - va) * LOG2E)), wb = 1.0f - wa;
                const int e0 = gs * 8 + ia, e1 = gs * 8 + ib;
                const int p0 = atomic_add_i(lcnt + e0, 1), p1 = atomic_add_i(lcnt + e1, 1);
                int* ti = tinfo + tid * 4;
                ti[0] = (e0 << 14) | p0; ti[1] = (e1 << 14) | p1; ti[2] = __builtin_bit_cast(int, ggate * wa); ti[3] = __builtin_bit_cast(int, ggate * wb);
            } }
        SYNC();
        int gbase = 0;
        if (tid < 32) { const int n = lcnt[tid]; gbase = n > 0 ? atomic_add_i(cnt + tid * 64, n) : 0; }
        if (valid) { const float rs = rsb[pi * 16 + c]; bf16* hb = (bf16*)(ws + WS_H) + (size_t)tok * DM + kh * (CH / 2) + 8 * h;
            const float* cp = cvl + b * DM + kh * (CH / 2) + 8 * h;
#pragma unroll
            for (int chn = 0; chn < NCHK; ++chn)
#pragma unroll
                for (int ks = 0; ks < NKS; ++ks) {
                    const bf16x8 uh = uhk[chn * NKS + ks]; const f32x4 c0 = *(const f32x4*)(cp + chn * CH + 32 * ks), c1 = *(const f32x4*)(cp + chn * CH + 32 * ks + 4);
                    f32x4 o0, o1;
#pragma unroll
                    for (int r = 0; r < 4; ++r) { o0[r] = bf2f((unsigned short)uh[r]) * rs + c0[r]; o1[r] = bf2f((unsigned short)uh[4 + r]) * rs + c1[r]; }
                    st_bf8(hb + chn * CH + 32 * ks, o0, o1); } }
        if (tid < 32) { lbase[tid] = gbase; lcnt[tid] = 0; }
        SYNC();
        if (tid < 64) { const int p2 = tid >> 4, pass2 = pass0 + p2 * NBLK;
            if (pass2 < T / 16) { const int tok2 = pass2 * 16 + (tid & 15); const int* ti = tinfo + tid * 4;
                const int e0 = ti[0] >> 14, e1 = ti[1] >> 14, p0 = lbase[e0] + (ti[0] & 16383), p1 = lbase[e1] + (ti[1] & 16383);
                int* list = (int*)(ws + WS_LIST); list[(size_t)e0 * T + p0] = tok2; list[(size_t)e1 * T + p1] = tok2;
                int* tie = (int*)(ws + WS_TIE) + (size_t)tok2 * 2; int* tiw = (int*)(ws + WS_TIW) + (size_t)tok2 * 2;
                tie[0] = (e0 << 14) | p0; tie[1] = (e1 << 14) | p1; tiw[0] = ti[2]; tiw[1] = ti[3]; } }
        SYNC();
    }
}

DEV int vbid() { const int g = NBLK; return (g % 8 == 0) ? (BID % 8) * (g / 8) + BID / 8 : BID; }
#ifdef EMU
#define PG8_LDS(p) (p)
#else
#define PG8_LDS(p) ((PG8_LAS unsigned char*)(p))
#endif
DEV void inproj_phase(const Args& a, unsigned char* smem, int li) {
    pg8::Gemm g{(const bf16*)(wsp(a) + WS_H), (const bf16*)(wsp(a) + WS_WIN) + (size_t)li * NIN8 * DM, T, NIN8, DM}; pg8::StaticOrder S; S.init(T, NIN8, NBLK, BID);
    EpiInProj8 E{&a, li};
    SYNC(); pg8::gemm_phase<EpiInProj8, pg8::StaticOrder, true, true>(PG8_LDS(smem), g, S, E); SYNC();
}
DEV void resid_gemm_phase(const Args& a, unsigned char* smem, const bf16* A, int K, const bf16* Bt, int l) {
    pg8::Gemm g{A, Bt, T, DM, K}; pg8::StaticOrder S; S.init(T, DM, NBLK, BID);
    EpiResid8 E{outp(a), (const float*)(wsp(a) + WS_MOD) + (size_t)l * 2 * 6 * DM + 2 * DM, l == 0 ? INP(a, I_X) : (const float*)outp(a)};
    SYNC(); pg8::gemm_phase<EpiResid8, pg8::StaticOrder, true, true>(PG8_LDS(smem), g, S, E); SYNC();
}
DEV void pw1_phase(const Args& a, unsigned char* smem, int li) {
    pg8::Gemm g{(const bf16*)(wsp(a) + WS_H), (const bf16*)(wsp(a) + WS_PW1) + (size_t)li * 2 * DM * DM, T, 2 * DM, DM}; pg8::StaticOrder S; S.init(T, 2 * DM, NBLK, BID);
    EpiGlu8 E{(bf16*)(wsp(a) + WS_GLU)};
    SYNC(); pg8::gemm_phase<EpiGlu8, pg8::StaticOrder, true, true>(PG8_LDS(smem), g, S, E); SYNC();
}
DEV void cmp_phase_items(const Args& a, unsigned char* smem, int li, int it) {
    constexpr int TMC = (NCP + 255) / 256;
    const int kv = it / (4 * TMC), bg = (it / TMC) % 4, tm = it % TMC;
    const bf16* src = (const bf16*)(wsp(a) + (kv ? WS_VCG : WS_KCG)) + (size_t)bg * SEQ * 64;
    struct AF { const bf16* base; int m0; MDEV unsigned off(int r) const { int n = m0 + r; if (n > NCMP - 1) n = NCMP - 1; return (unsigned)n * 1024u; } } af{src, tm * 256};
    EpiCmp E{&a, kv, bg, tm * 256, li};
    BClamp64 bf{INP(a, kv ? I_CWV : I_CWK) + (size_t)li * 2048 * 64};
    gemm_tile2(smem, af, bf, 64, 2048, E);
}
DEV void moe_gemm_phase8(const Args& a, unsigned char* smem, int l, int mode) {
    unsigned char* ws = wsp(a); const int* cnt = (const int*)(ws + WS_CNT) + l * 32 * 64;
    int* rb = (int*)(smem + 140 * 1024);
    moe_bases(cnt, rb);
    const int mrows = rb[32];
    if (mode == 0) {
        pg8::Gemm g{(const bf16*)(ws + WS_H), (const bf16*)(ws + WS_W13) + (size_t)l * 32 * 2 * FF * DM, mrows, 2 * FF, DM}; pg8::StaticOrder S; S.init(mrows, 2 * FF, NBLK, BID);
        EpiMoe1_8 E{(bf16*)(ws + WS_ACT)}; MoeSel<true> X{rb, cnt, (const int*)(ws + WS_LIST), (size_t)2 * FF * DM * 2};
        SYNC(); pg8::gemm_phase<EpiMoe1_8, pg8::StaticOrder, true, true, MoeSel<true>>(PG8_LDS(smem), g, S, E, X); SYNC();
    } else {
        pg8::Gemm g{(const bf16*)(ws + WS_ACT), (const bf16*)(ws + WS_W2) + (size_t)l * 32 * DM * FF, mrows, DM, FF}; pg8::StaticOrder S; S.init(mrows, DM, NBLK, BID);
        EpiMoe2_8 E{(bf16*)(ws + WS_YK)}; MoeSel<false> X{rb, cnt, (const int*)(ws + WS_LIST), (size_t)DM * FF * 2};
        SYNC(); pg8::gemm_phase<EpiMoe2_8, pg8::StaticOrder, true, true, MoeSel<false>>(PG8_LDS(smem), g, S, E, X); SYNC();
    }
}
#ifndef EMU
constexpr int MOE_TMO_IDX = 128;
struct MoeOrder { int nN, t0, nu, j, nper, nA; bool rev;
    __device__ __forceinline__ void init(int ntile, int nN_, int nblk, int bid, bool rev_) { nN = nN_; nper = nblk / 8; rev = rev_; const int x = bid % 8; j = bid / 8;
        t0 = x * ntile / 8; nu = ((x + 1) * ntile / 8 - t0) * nN; if (bid >= 8 * nper) nu = 0;
        nA = nu - 2 * nper; nA = nA < 0 ? 0 : (nA > nper / 2 ? nper / 2 : nA); }
    __device__ __forceinline__ bool next(int i, pg8::Unit& u) const { int p;
        if (!rev) p = i * nper + j;
        else if (j < nA) { if (i > 0) return false; p = nu - nA + j; }
        else { p = i * (nper - nA) + (j - nA); if (p >= nu - nA) return false; }
        if (p >= nu) return false; u.pm = t0 + p / nN; u.pn = p % nN; return true; }
    __device__ __forceinline__ void a_ready(const pg8::Unit&) const {}
    __device__ __forceinline__ void done(const pg8::Unit&) const {}
};
struct MoeProd : MoeOrder { unsigned* flg;
    __device__ __forceinline__ void done(const pg8::Unit& u) const {
        asm volatile("s_waitcnt vmcnt(0)" ::: "memory"); __builtin_amdgcn_s_barrier(); asm volatile("" ::: "memory");
        if (TID == 0) (void)__hip_atomic_fetch_add((__attribute__((address_space(1))) unsigned*)(flg + u.pm * 16), 1u, __ATOMIC_RELAXED, __HIP_MEMORY_SCOPE_AGENT); } };
struct MoeCons : MoeOrder { unsigned* flg; unsigned* tmo;
    __device__ __forceinline__ void a_ready(const pg8::Unit& u) const {
        if ((TID >> 6) == 0) { unsigned sp = 0u; __attribute__((address_space(1))) unsigned* f = (__attribute__((address_space(1))) unsigned*)(flg + u.pm * 16);
            while ((unsigned)__builtin_amdgcn_readfirstlane((int)__hip_atomic_load(f, __ATOMIC_RELAXED, __HIP_MEMORY_SCOPE_AGENT)) < (unsigned)(2 * FF / 256)) {
                __builtin_amdgcn_s_sleep(1);
                if ((++sp & 255u) == 0u) { if (__hip_atomic_load((__attribute__((address_space(1))) unsigned*)tmo, __ATOMIC_RELAXED, __HIP_MEMORY_SCOPE_AGENT)) break;
                    if (sp > (1u << 22)) { (void)__hip_atomic_fetch_add((__attribute__((address_space(1))) unsigned*)tmo, 1u, __ATOMIC_RELAXED, __HIP_MEMORY_SCOPE_AGENT); break; } } }
            __builtin_amdgcn_fence(__ATOMIC_ACQUIRE, "agent"); }
        asm volatile("" ::: "memory"); __builtin_amdgcn_s_barrier(); asm volatile("" ::: "memory"); } };
DEV void moe_fused_phase(const Args& a, unsigned char* smem, int l) {
    unsigned char* ws = wsp(a); const int* cnt = (const int*)(ws + WS_CNT) + l * 32 * 64;
    int* rb = (int*)(smem + 140 * 1024);
    moe_bases(cnt, rb);
    const int mrows = rb[32]; unsigned* flg = (unsigned*)(ws + WS_FLG) + (size_t)l * 256 * 16;
    { pg8::Gemm g{(const bf16*)(ws + WS_H), (const bf16*)(ws + WS_W13) + (size_t)l * 32 * 2 * FF * DM, mrows, 2 * FF, DM}; MoeProd S; S.init(mrows >> 8, 2 * FF / 256, NBLK, BID, false); S.flg = flg;
      EpiMoe1_8 E{(bf16*)(ws + WS_ACT)}; MoeSel<true> X{rb, cnt, (const int*)(ws + WS_LIST), (size_t)2 * FF * DM * 2};
      SYNC(); pg8::gemm_phase<EpiMoe1_8, MoeProd, true, true, MoeSel<true>>(PG8_LDS(smem), g, S, E, X); }
    { pg8::Gemm g{(const bf16*)(ws + WS_ACT), (const bf16*)(ws + WS_W2) + (size_t)l * 32 * DM * FF, mrows, DM, FF}; MoeCons S; S.init(mrows >> 8, DM / 256, NBLK, BID, true); S.flg = flg; S.tmo = (unsigned*)(ws + WS_BAR) + MOE_TMO_IDX;
      EpiMoe2_8 E{(bf16*)(ws + WS_YK)}; MoeSel<false> X{rb, cnt, (const int*)(ws + WS_LIST), (size_t)DM * FF * 2};
      SYNC(); pg8::gemm_phase<EpiMoe2_8, MoeCons, true, true, MoeSel<false>>(PG8_LDS(smem), g, S, E, X); SYNC(); }
}
#endif
DEV void moe_gemm_phase(const Args& a, unsigned char* smem, int l, int mode) {
    unsigned char* ws = wsp(a); const int* cnt = (const int*)(ws + WS_CNT) + l * 32 * 64;
    int* rb = (int*)(smem + GEMM2_LDS);
    moe_bases(cnt, rb);
    const int ntile = rb[32] >> 8;
    constexpr int TN1 = 2 * FF / 128, TN2 = DM / 128;
    const int TN = mode == 0 ? TN1 : TN2;
    const int* list = (const int*)(ws + WS_LIST);
    for (int it = vbid(); it < ntile * TN; it += NBLK) {
        const int rt = it / TN, tn = it % TN; int e = 0;
#pragma unroll 1
        for (int q = 1; q < 32; ++q) if ((rb[q] >> 8) <= rt) e = q;
        const int rloc = (rt << 8) - rb[e], ce = cnt[e * 64], nvalid = (ce - rloc) < 256 ? (ce - rloc) : 256;
        if (mode == 0) {
            struct AF { const bf16* base; const int* lst; int nv; MDEV unsigned off(int r) const { const int rr = r < nv ? r : nv - 1; return (unsigned)lst[rr] * (unsigned)DM; } }
                af{(const bf16*)(ws + WS_H), list + (size_t)e * T + rloc, nvalid};
            EpiGated<1> E{(bf16*)(ws + WS_ACT), (size_t)FF, rt << 8, tn * 128, nvalid};
            BInter bf{INP(a, I_W1) + (size_t)(l * 32 + e) * DM * FF, INP(a, I_W3) + (size_t)(l * 32 + e) * DM * FF, tn * 128};
            gemm_tile2(smem, af, bf, FF, DM, E);
        } else {
            ARows af{(const bf16*)(ws + WS_ACT) + (size_t)(rt << 8) * FF, (size_t)FF};
            EpiStoreBf E{(bf16*)(ws + WS_YK), (size_t)DM, rt << 8, tn * 128, nvalid};
            BPlain bf{INP(a, I_W2) + (size_t)(l * 32 + e) * FF * DM + tn * 128};
            gemm_tile2(smem, af, bf, DM, FF, E);
        }
    }
}

constexpr int LDV = 80;
constexpr int AT_K = 0, AT_V = 2 * 64 * LDT * 2, AT_IMP = AT_V + 2 * 64 * LDV * 2, AT_SEL = AT_IMP + 8 * 8 * 128 * 4, AT_GSEL = AT_SEL + 8 * 8 * 4 * 4, AT_OUT = AT_GSEL + 8 * 2 * 4 * 4, AT_END = AT_OUT + 8 * 32 * 64 * 4;
#ifdef EMU
DEV float rexp2(float x) { return exp2f(x); }
DEV unsigned uni(unsigned x) { return x; }
#else
DEV float rexp2(float x) { return __builtin_amdgcn_exp2f(x); }
DEV unsigned uni(unsigned x) { return (unsigned)__builtin_amdgcn_readfirstlane((int)x); }
#endif
DEV int krow_lds(int kappa) { return 16 * (2 * (kappa >> 5) + ((kappa >> 2) & 1)) + 4 * ((kappa >> 3) & 3) + (kappa & 3); }
template <int MASK, bool FULL, int GM>
DEV void attn_block(const bf16* Kp, const bf16* Vp, const bf16x8 (&qf)[2][2], int j, const int (&s)[2], const bool (&selbit)[2], float C2, int h, int c,
                    f32x4 (&O)[2][4], f32x4 (&Ol)[2]) {
    f32x4 st[2][2][2];
#pragma unroll
    for (int sp = 0; sp < 2; ++sp)
#pragma unroll
        for (int u = 0; u < 2; ++u) {
#pragma unroll
            for (int G = 0; G < 2; ++G) { st[G][sp][u][0] = -C2; st[G][sp][u][1] = -C2; st[G][sp][u][2] = -C2; st[G][sp][u][3] = -C2; }
#pragma unroll
            for (int ks = 0; ks < 2; ++ks) { const bf16x8 kf = *(const bf16x8*)(Kp + (16 * (2 * sp + u) + c) * LDT + 32 * ks + 8 * h);
#pragma unroll
                for (int G = 0; G < 2; ++G) if (GM & (1 << G)) st[G][sp][u] = mfma16(kf, qf[G][ks], st[G][sp][u]); } }
#pragma unroll
    for (int G = 0; G < 2; ++G) if (GM & (1 << G))
#pragma unroll
        for (int sp = 0; sp < 2; ++sp)
#pragma unroll
            for (int u = 0; u < 2; ++u)
#pragma unroll
                for (int r = 0; r < 4; ++r) { bool ok = selbit[G];
                    if (!FULL) { const int key = 64 * j + 32 * sp + 8 * h + 4 * u + r;
                        if (MASK == 0) ok = 16 * key + 31 <= s[G]; else if (MASK == 1) ok = selbit[G] && key <= s[G]; else ok = key <= s[G] && key > s[G] - 512; }
                    st[G][sp][u][r] = ok ? rexp2(st[G][sp][u][r]) : 0.f; }
    bf16x8 pb[2][2], ones;
#pragma unroll
    for (int q = 0; q < 8; ++q) ones[q] = (short)0x3F80;
#pragma unroll
    for (int G = 0; G < 2; ++G) if (GM & (1 << G))
#pragma unroll
        for (int sp = 0; sp < 2; ++sp) { pb[G][sp] = pack8(st[G][sp][0], st[G][sp][1]); Ol[G] = mfma16(ones, pb[G][sp], Ol[G]); }
    const bf16* Vb = Vp + bperm(8 * h + (c >> 2)) * LDV + 4 * (c & 3);
#pragma unroll
    for (int et = 0; et < 4; ++et)
#pragma unroll
        for (int sp = 0; sp < 2; ++sp) { const bf16x8 vf = tr_read8(Vb + (32 * sp) * LDV + 16 * et, Vb + (32 * sp + 8) * LDV + 16 * et);
#pragma unroll
            for (int G = 0; G < 2; ++G) if (GM & (1 << G)) O[G][et] = mfma16(vf, pb[G][sp], O[G][et]); }
}

struct ImpState { float invq[2][4]; float carry[2]; float* imps; int tl, hd, l, s0, qblk; };
DEV void imp_block(const bf16* Kp, const bf16x8 (&qf)[2][2], int j, int s0, int w, float C2, int h, int c, ImpState& im) {
#pragma unroll
    for (int kt = 0; kt < 4; ++kt) {
        const int row = krow_lds(16 * kt + c);
        const bf16x8 k0 = *(const bf16x8*)(Kp + row * LDT + 8 * h), k1 = *(const bf16x8*)(Kp + row * LDT + 32 + 8 * h);
        const int n = 64 * j + 16 * kt + c;
#pragma unroll
        for (int G = 0; G < 2; ++G) {
            f32x4 acc; acc[0] = -C2; acc[1] = -C2; acc[2] = -C2; acc[3] = -C2;
            acc = mfma16(qf[G][0], k0, acc); acc = mfma16(qf[G][1], k1, acc);
            const bool ok = 16 * n + 31 <= s0 + 8 * w + 4 * G + h;
            float imp = 0.f;
#pragma unroll
            for (int r = 0; r < 4; ++r) imp += ok ? rexp2(acc[r]) * im.invq[G][r] : 0.f;
            const float v = ((c & 3) == 3) ? imp : 2.0f * imp;
            float sq = v + shflx(v, 1); sq += shflx(sq, 2);
            const float rr = dpp_ror1(imp);
            const float prev = (c == 0) ? im.carry[G] : rr;
            im.carry[G] = rr;
            const int m = n >> 2;
            if ((c & 3) == 0 && m < 128) im.imps[(G * 4 + h) * 128 + m] = sq + prev;
        }
    }
}

template <int MODE>
DEV void attn_branch(bf16* Kl, bf16* Vl, const bf16* kbase, const bf16* vbase, int jlo, int jhi,
                     const bf16x8 (&qf)[2][2], const int (&s)[2], const unsigned* selm, const unsigned* gselm, float C2, int w, int h, int c, int srow, int scol,
                     f32x4 (&O)[2][4], f32x4 (&Ol)[2], ImpState& im) {
    constexpr bool PV = MODE != 1; constexpr int MASK = MODE <= 1 ? 0 : MODE - 1;
    const int krow = krow_lds(srow) * LDT + scol, vrow = bperm(srow) * LDV + scol;
    bf16x8 rk[3], rv[3];
    { const bf16x8 k0 = *(const bf16x8*)(kbase + (size_t)jlo * 4096); *(bf16x8*)(Kl + krow) = k0;
      if (PV) { const bf16x8 v0 = *(const bf16x8*)(vbase + (size_t)jlo * 4096); *(bf16x8*)(Vl + vrow) = v0; } }
#pragma unroll
    for (int u = 0; u < 3; ++u) { int jj = jlo + 1 + u; if (jj > jhi) jj = jhi; rk[(1 + u) % 3] = *(const bf16x8*)(kbase + (size_t)jj * 4096); if (PV) rv[(1 + u) % 3] = *(const bf16x8*)(vbase + (size_t)jj * 4096); }
    SYNC();
    for (int jb = jlo; jb <= jhi; jb += 3) {
#pragma unroll
        for (int u = 0; u < 3; ++u) { const int j = jb + u;
            if (j <= jhi) {
                const int cur = (j - jlo) & 1;
                const bf16* Kc = Kl + cur * 64 * LDT; const bf16* Vc = Vl + cur * 64 * LDV;
                if (MODE == 1) imp_block(Kc, qf, j, im.s0, w, C2, h, c, im);
                else {
                    bool sb[2] = {true, true}; unsigned gm = 3u;
                    if (MODE == 2) { gm = 0u;
#pragma unroll
                        for (int G = 0; G < 2; ++G) { const unsigned wq = uni(gselm[G * 4 + (j >> 5)]), mq = selm[(G * 4 + im.tl) * 4 + (j >> 5)];
                            gm |= ((wq >> (j & 31)) & 1u) << G; sb[G] = (mq >> (j & 31)) & 1u; } }
                    bool full;
                    if (MODE == 0) full = 1024 * j + 1039 <= im.s0; else if (MODE == 2) full = j < im.qblk; else full = (j < im.qblk) && (64 * j > im.s0 + 63 - 512);
                    if (MODE == 2) {
                        if (full) { if (gm == 3u) attn_block<MASK, true, 3>(Kc, Vc, qf, j, s, sb, C2, h, c, O, Ol); else if (gm == 1u) attn_block<MASK, true, 1>(Kc, Vc, qf, j, s, sb, C2, h, c, O, Ol); else if (gm == 2u) attn_block<MASK, true, 2>(Kc, Vc, qf, j, s, sb, C2, h, c, O, Ol); }
                        else { if (gm == 3u) attn_block<MASK, false, 3>(Kc, Vc, qf, j, s, sb, C2, h, c, O, Ol); else if (gm == 1u) attn_block<MASK, false, 1>(Kc, Vc, qf, j, s, sb, C2, h, c, O, Ol); else if (gm == 2u) attn_block<MASK, false, 2>(Kc, Vc, qf, j, s, sb, C2, h, c, O, Ol); }
                    } else { if (full) attn_block<MASK, true, 3>(Kc, Vc, qf, j, s, sb, C2, h, c, O, Ol); else attn_block<MASK, false, 3>(Kc, Vc, qf, j, s, sb, C2, h, c, O, Ol); }
                }
                if (j + 1 <= jhi) {
                    *(bf16x8*)(Kl + (cur ^ 1) * 64 * LDT + krow) = rk[(u + 1) % 3]; if (PV) *(bf16x8*)(Vl + (cur ^ 1) * 64 * LDV + vrow) = rv[(u + 1) % 3];
                    int jj = j + 4; if (jj > jhi) jj = jhi;
                    rk[(u + 1) % 3] = *(const bf16x8*)(kbase + (size_t)jj * 4096); if (PV) rv[(u + 1) % 3] = *(const bf16x8*)(vbase + (size_t)jj * 4096);
                }
                SYNC();
            }
        }
    }
}

DEV void attn_task(const Args& a, unsigned char* smem, int li, int item) {
    unsigned char* ws = wsp(a); const int tid = TID, w = tid >> 6, l = tid & 63, h = l >> 4, c = l & 15, tl = c >> 2, hd = c & 3;
    const int bg = item & 3, b = bg >> 1, g = bg & 1, tq = (SEQ / 64 - 1) - (item >> 2), s0 = tq * 64, qblk = tq;
    int s[2], row[2];
#pragma unroll
    for (int G = 0; G < 2; ++G) { s[G] = s0 + 8 * w + 4 * G + tl; row[G] = b * SEQ + s[G]; }
    bf16* Kl = (bf16*)(smem + AT_K); bf16* Vl = (bf16*)(smem + AT_V); float* imps = (float*)(smem + AT_IMP) + w * 1024; unsigned* selm = (unsigned*)(smem + AT_SEL) + w * 32;
    bf16x8 qf[2][2]; float gatec[2], gates[2], gatew[2];
#pragma unroll
    for (int G = 0; G < 2; ++G) { const bf16* qp = (const bf16*)(ws + WS_QN) + (size_t)row[G] * 512 + (g * 4 + hd) * 64 + 8 * h; qf[G][0] = *(const bf16x8*)qp; qf[G][1] = *(const bf16x8*)(qp + 32);
        const float* gp = (const float*)(ws + WS_GATE) + (size_t)row[G] * 24 + (g * 4 + hd) * 3; gatec[G] = gp[0]; gates[G] = gp[1]; gatew[G] = gp[2]; }
    const float* cs = (const float*)(ws + WS_CS) + li * 4;
    const int srow = tid >> 3, scol = (tid & 7) * 8;
    for (int i = l; i < 1024; i += 64) imps[i] = 0.f;
    SYNC();
    unsigned* gselm = (unsigned*)(smem + AT_GSEL) + w * 8; float* outl = (float*)(smem + AT_OUT) + w * 2048 + l;
    ImpState im{{{0.f, 0.f, 0.f, 0.f}, {0.f, 0.f, 0.f, 0.f}}, {0.f, 0.f}, imps, tl, hd, l, s0, qblk};
    {
        const int ncv = s0 / 16 + 3, ncb0 = (ncv + 63) >> 6, ncb = ncb0 > NCP / 64 ? NCP / 64 : ncb0;
        const bf16* kcb = (const bf16*)(ws + WS_KC) + (size_t)bg * NCP * 64 + tid * 8;
        const bf16* vcb = (const bf16*)(ws + WS_VCT) + (size_t)bg * NCP * 64 + tid * 8;
        f32x4 O[2][4], Ol[2] = {f4zero(), f4zero()};
#pragma unroll
        for (int G = 0; G < 2; ++G)
#pragma unroll
            for (int et = 0; et < 4; ++et) O[G][et] = f4zero();
        attn_branch<0>(Kl, Vl, kcb, vcb, 0, ncb - 1, qf, s, selm, gselm, cs[0], w, h, c, srow, scol, O, Ol, im);
#pragma unroll
        for (int G = 0; G < 2; ++G) { const float lsum = Ol[G][0]; const float invl = lsum > 0.f ? 1.0f / lsum : 0.f;
#pragma unroll
            for (int r = 0; r < 4; ++r) im.invq[G][r] = shfl(invl, 4 * h + r);
#pragma unroll
            for (int et = 0; et < 4; ++et)
#pragma unroll
                for (int r = 0; r < 4; ++r) outl[((G * 4 + et) * 4 + r) * 64] = gatec[G] * invl * O[G][et][r]; }
        f32x4 ld[2] = {f4zero(), f4zero()};
        attn_branch<1>(Kl, Vl, kcb, vcb, 0, ncb - 1, qf, s, selm, gselm, cs[0], w, h, c, srow, scol, O, ld, im);
    }
    WSYNC();
#pragma unroll 1
    for (int G = 0; G < 2; ++G) {
        const int tk = l >> 4, i = l & 15; float vals[8];
#pragma unroll
        for (int mm = 0; mm < 8; ++mm) { const int jj = i + 16 * mm; vals[mm] = jj > qblk ? NEGV : ((jj == 0 || jj == qblk || jj == qblk - 1) ? FORCEV : imps[(G * 4 + tk) * 128 + jj]); }
        unsigned mk[4] = {0u, 0u, 0u, 0u};
#pragma unroll 1
        for (int rnd = 0; rnd < 16; ++rnd) {
            float best = vals[0]; int bj = i;
#pragma unroll
            for (int mm = 1; mm < 8; ++mm) if (vals[mm] > best) { best = vals[mm]; bj = i + 16 * mm; }
#pragma unroll
            for (int o = 1; o < 16; o <<= 1) { const float ov = shflx(best, o); const int oj = shflxi(bj, o); if (ov > best || (ov == best && oj < bj)) { best = ov; bj = oj; } }
            if (best > NEGV * 0.5f) {
#pragma unroll
                for (int q = 0; q < 4; ++q) if ((bj >> 5) == q) mk[q] |= 1u << (bj & 31); }
            if ((bj & 15) == i) {
#pragma unroll
                for (int mm = 0; mm < 8; ++mm) if ((bj >> 4) == mm) vals[mm] = -3e38f; }
        }
        if (i == 0) {
#pragma unroll
            for (int q = 0; q < 4; ++q) selm[(G * 4 + tk) * 4 + q] = mk[q]; }
    }
    WSYNC();
    if (l < 8) { const int G = l >> 2, q = l & 3; gselm[l] = selm[(G * 4 + 0) * 4 + q] | selm[(G * 4 + 1) * 4 + q] | selm[(G * 4 + 2) * 4 + q] | selm[(G * 4 + 3) * 4 + q]; }
    WSYNC();
#pragma unroll
    for (int br = 0; br < 2; ++br) {
        const bf16* kb = (const bf16*)(ws + (br == 0 ? WS_KS : WS_KW)) + (size_t)bg * SEQ * 64 + tid * 8; const bf16* vb = (const bf16*)(ws + (br == 0 ? WS_VST : WS_VWT)) + (size_t)bg * SEQ * 64 + tid * 8;
        f32x4 O[2][4], Ol[2] = {f4zero(), f4zero()};
#pragma unroll
        for (int G = 0; G < 2; ++G)
#pragma unroll
            for (int et = 0; et < 4; ++et) O[G][et] = f4zero();
        if (br == 0) attn_branch<2>(Kl, Vl, kb, vb, 0, qblk, qf, s, selm, gselm, cs[1], w, h, c, srow, scol, O, Ol, im);
        else attn_branch<3>(Kl, Vl, kb, vb, s0 >= 511 ? (s0 - 511) >> 6 : 0, qblk, qf, s, selm, gselm, cs[2], w, h, c, srow, scol, O, Ol, im);
#pragma unroll
        for (int G = 0; G < 2; ++G) { const float lsum = Ol[G][0]; const float sc = (br == 0 ? gates[G] : gatew[G]) * (lsum > 0.f ? 1.0f / lsum : 0.f);
#pragma unroll
            for (int et = 0; et < 4; ++et)
#pragma unroll
                for (int r = 0; r < 4; ++r) outl[((G * 4 + et) * 4 + r) * 64] += sc * O[G][et][r]; }
    }
#pragma unroll
    for (int G = 0; G < 2; ++G) { bf16* dst = (bf16*)(ws + WS_CAT) + (size_t)row[G] * 1024 + (g * 4 + hd) * 64 + 4 * h;
#pragma unroll
        for (int et = 0; et < 4; ++et) { f32x4 o;
#pragma unroll
            for (int r = 0; r < 4; ++r) o[r] = outl[((G * 4 + et) * 4 + r) * 64];
            st_bf4(dst + 16 * et, o); } }
}

constexpr int LDH = 136;
DEV void hg_cumsum(const float* fsrc  , float* segs  , int d, int seg, float (&f)[16], float (&bc)[16], float& bend, float& bmid) {
    float run = 0.f;
#pragma unroll
    for (int i = 0; i < 16; ++i) { f[i] = fsrc[(size_t)(16 * seg + i) * 128 + d]; run += log2f(f[i]); bc[i] = run; }
    SYNC();
    segs[seg * 128 + d] = run;
    SYNC();
    const float s0 = segs[d], s1 = segs[128 + d], s2 = segs[256 + d], s3 = segs[384 + d];
    const float off = seg == 0 ? 0.f : (seg == 1 ? s0 : (seg == 2 ? s0 + s1 : s0 + s1 + s2));
#pragma unroll
    for (int i = 0; i < 16; ++i) bc[i] += off;
    bend = s0 + s1 + s2 + s3; bmid = s0 + s1;
}
DEV void hg_write16(bf16* dstrow  , const float (&v)[16]) {
    u32x4 w0, w1;
#pragma unroll
    for (int q = 0; q < 4; ++q) { w0[q] = pk2(v[2 * q], v[2 * q + 1]); w1[q] = pk2(v[8 + 2 * q], v[8 + 2 * q + 1]); }
    *(u32x4*)dstrow = w0; *(u32x4*)(dstrow + 8) = w1;
}
DEV void hg_h1_task(const Args& a, unsigned char* smem, int task) {
    unsigned char* ws = wsp(a); const int tid = TID, w = tid >> 6, l = tid & 63, h = l >> 4, c = l & 15, d = tid & 127, seg = tid >> 7;
    const int bh = task / NCH, ch = task % NCH;
    bf16* kT = (bf16*)smem; bf16* vT = kT + 128 * LDT; float* segs = (float*)(vT + 128 * LDT);
    const size_t tokb = (size_t)bh * SEQ + ch * 64;
    float f[16], bc[16], bend, bmid;
    const bf16* vs = (const bf16*)(ws + WS_HV) + tokb * 128;
    bf16 vraw[16];
#pragma unroll
    for (int i = 0; i < 16; ++i) vraw[i] = vs[(size_t)(16 * seg + i) * 128 + d];
    hg_cumsum((const float*)(ws + WS_HF) + tokb * 128, segs, d, seg, f, bc, bend, bmid);
    float kv[16];
#pragma unroll
    for (int i = 0; i < 16; ++i) kv[i] = (1.0f - f[i]) * fexp2(bend - bc[i]);
    hg_write16(kT + d * LDT + 16 * seg, kv);
#pragma unroll
    for (int i = 0; i < 16; ++i) kv[i] = bf2f(vraw[i]);
    hg_write16(vT + d * LDT + 16 * seg, kv);
    if (seg == 0) ((float*)(ws + WS_GD))[((size_t)bh * NCH + ch) * 128 + d] = fexp2(bend);
    SYNC();
    f32x4 acc[8];
#pragma unroll
    for (int et = 0; et < 8; ++et) acc[et] = f4zero();
#pragma unroll
    for (int ks = 0; ks < 2; ++ks) { const bf16x8 fa = *(const bf16x8*)(kT + (16 * w + c) * LDT + 32 * ks + 8 * h);
#pragma unroll
        for (int et = 0; et < 8; ++et) acc[et] = mfma16(fa, *(const bf16x8*)(vT + (16 * et + c) * LDT + 32 * ks + 8 * h), acc[et]); }
    float* ut = (float*)(ws + WS_UT) + ((size_t)bh * NCH + ch) * 16384;
#pragma unroll
    for (int et = 0; et < 8; ++et) *(f32x4*)(ut + (size_t)(16 * et + c) * 128 + 16 * w + 4 * h) = acc[et];
    SYNC();
}
DEV void hg_scan_task(const Args& a, int sc) {
    unsigned char* ws = wsp(a); const int bh = sc >> 3, q = (sc & 7) * 512 + TID, e = q >> 5, d0 = (q & 31) * 4;
    const float* ut = (const float*)(ws + WS_UT) + (size_t)bh * NCH * 16384 + (size_t)e * 128 + d0;
    const float* gd = (const float*)(ws + WS_GD) + (size_t)bh * NCH * 128 + d0;
    bf16* st = (bf16*)(ws + WS_ST) + (size_t)bh * NCH * 16384 + (size_t)e * 128 + d0;
    f32x4 S = f4zero();
#pragma unroll 4
    for (int ch = 0; ch < NCH; ++ch) { st_bf4(st + (size_t)ch * 16384, S);
        const f32x4 g = *(const f32x4*)(gd + (size_t)ch * 128), u = *(const f32x4*)(ut + (size_t)ch * 16384);
#pragma unroll
        for (int r = 0; r < 4; ++r) S[r] = g[r] * S[r] + u[r]; }
}
DEV void hg_h3_task(const Args& a, unsigned char* smem, int li, int task) {
    unsigned char* ws = wsp(a); const int tid = TID, w = tid >> 6, l = tid & 63, h = l >> 4, c = l & 15, d = tid & 127, seg = tid >> 7;
    const int bh = task / NCH, ch = task % NCH, b = bh >> 2, hh = bh & 3;
    bf16* At = (bf16*)smem; bf16* Bt = At + 64 * LDH; bf16* Qt = Bt + 64 * LDH; bf16* vT = Qt + 64 * LDH; float* segs = (float*)(vT + 128 * LDT); float* part = segs + 512;
    const size_t tokb = (size_t)bh * SEQ + ch * 64;
    float f[16], bc[16], bend, bmid;
    const bf16* qs = (const bf16*)(ws + WS_HQ) + tokb * 128; const bf16* vs = (const bf16*)(ws + WS_HV) + tokb * 128;
    const int tt = w & 3, eh = w >> 2;
    bf16 qraw[16], vraw[16];
#pragma unroll
    for (int i = 0; i < 16; ++i) { const int t = 16 * seg + i; qraw[i] = qs[(size_t)t * 128 + d]; vraw[i] = vs[(size_t)t * 128 + d]; }
    const bf16* stp = (const bf16*)(ws + WS_ST) + ((size_t)bh * NCH + ch) * 16384;
    bf16x8 stf[4][4];
#pragma unroll
    for (int ks = 0; ks < 4; ++ks)
#pragma unroll
        for (int et = 0; et < 4; ++et) stf[ks][et] = *(const bf16x8*)(stp + (size_t)(64 * eh + 16 * et + c) * 128 + 32 * ks + 8 * h);
    const int tok = b * SEQ + ch * 64 + 16 * tt + c;
    const bf16* hg = (const bf16*)(ws + WS_HGS) + (size_t)tok * 512 + hh * 128;
    u32x2 hgv[4];
#pragma unroll
    for (int et = 0; et < 4; ++et) hgv[et] = *(const u32x2*)(hg + 64 * eh + 16 * et + 4 * h);
    hg_cumsum((const float*)(ws + WS_HF) + tokb * 128, segs, d, seg, f, bc, bend, bmid);
    float vv[16];
#pragma unroll
    for (int i = 0; i < 16; ++i) { const int t = 16 * seg + i; const float q = bf2f(qraw[i]);
        At[t * LDH + d] = (bf16)f2bf(q * fexp2(bc[i] - bmid)); Bt[t * LDH + d] = (bf16)f2bf((1.0f - f[i]) * fexp2(bmid - bc[i])); Qt[t * LDH + d] = (bf16)f2bf(q * fexp2(bc[i]));
        vv[i] = bf2f(vraw[i]); }
    hg_write16(vT + d * LDT + 16 * seg, vv);
    SYNC();
    f32x4 O[4];
#pragma unroll
    for (int et = 0; et < 4; ++et) O[et] = f4zero();
#pragma unroll
    for (int sp = 0; sp < 2; ++sp) {
        if (32 * sp > 16 * tt + 15) continue;
        f32x4 st[2];
#pragma unroll
        for (int u = 0; u < 2; ++u) { st[u] = f4zero(); const int krow = 32 * sp + 8 * (c >> 2) + 4 * u + (c & 3);
#pragma unroll
            for (int ks = 0; ks < 4; ++ks) st[u] = mfma16(*(const bf16x8*)(Bt + krow * LDH + 32 * ks + 8 * h), *(const bf16x8*)(At + (16 * tt + c) * LDH + 32 * ks + 8 * h), st[u]);
#pragma unroll
            for (int r = 0; r < 4; ++r) { const int sk = 32 * sp + 8 * h + 4 * u + r; if (sk > 16 * tt + c) st[u][r] = 0.f; } }
        const bf16x8 pb = pack8(st[0], st[1]);
#pragma unroll
        for (int et = 0; et < 4; ++et) O[et] = mfma16(*(const bf16x8*)(vT + (64 * eh + 16 * et + c) * LDT + 32 * sp + 8 * h), pb, O[et]);
    }
#pragma unroll
    for (int ks = 0; ks < 4; ++ks) { const bf16x8 fq = *(const bf16x8*)(Qt + (16 * tt + c) * LDH + 32 * ks + 8 * h);
#pragma unroll
        for (int et = 0; et < 4; ++et) O[et] = mfma16(stf[ks][et], fq, O[et]); }
    float ss = 0.f;
#pragma unroll
    for (int et = 0; et < 4; ++et)
#pragma unroll
        for (int r = 0; r < 4; ++r) ss += O[et][r] * O[et][r];
    ss += shflx(ss, 16); ss += shflx(ss, 32);
    if (h == 0) part[eh * 64 + 16 * tt + c] = ss;
    SYNC();
    const float rs = frsq((part[16 * tt + c] + part[64 + 16 * tt + c]) * (1.0f / 128.0f) + EPS);
    const float* og = INP(a, I_OG) + li * 128;
    bf16* dst = (bf16*)(ws + WS_CAT) + (size_t)tok * 1024 + 512 + hh * 128;
#pragma unroll
    for (int et = 0; et < 4; ++et) { const int e = 64 * eh + 16 * et + 4 * h; f32x4 o; const f32x4 ogv = *(const f32x4*)(og + e);
        o[0] = O[et][0] * rs * ogv[0] * bf2f(hgv[et][0] & 0xffff); o[1] = O[et][1] * rs * ogv[1] * bf2f(hgv[et][0] >> 16);
        o[2] = O[et][2] * rs * ogv[2] * bf2f(hgv[et][1] & 0xffff); o[3] = O[et][3] * rs * ogv[3] * bf2f(hgv[et][1] >> 16);
        st_bf4(dst + e, o); }
    SYNC();
}

DEV void conv_task(const Args& a, unsigned char* smem, int li, int task) {
    unsigned char* ws = wsp(a); const int tid = TID, w = tid >> 6, lane = tid & 63;
    const bool act = tid < DM / 2; const int c0 = act ? 2 * tid : 0;
    const int t0 = task * 16, b = t0 / SEQ, s0 = t0 % SEQ;
    float* red = (float*)smem;
    const float* dw = INP(a, I_DW) + (size_t)li * 31 * DM + c0;
    float acc[16][2];
    const float b0 = INP(a, I_DWB)[li * DM + c0], b1 = INP(a, I_DWB)[li * DM + c0 + 1];
#pragma unroll
    for (int t = 0; t < 16; ++t) { acc[t][0] = b0; acc[t][1] = b1; }
    const bf16* glu = (const bf16*)(ws + WS_GLU) + (size_t)b * SEQ * DM + c0;
    unsigned uu[46];
    { const bf16* gp = glu + (size_t)(s0 - 30) * DM;
#pragma unroll
    for (int r = 0; r < 46; ++r) { const int si = s0 + r - 30; uu[r] = si >= 0 ? *(const unsigned*)gp : 0u; gp += DM; OPAQUE(gp); } }
    const float* dwp = dw;
#pragma unroll
    for (int j = 0; j < 31; ++j) { const float w0 = dwp[0], w1 = dwp[1]; dwp += DM; OPAQUE(dwp);
#pragma unroll
        for (int t = 0; t < 16; ++t) { const unsigned q = uu[t + j]; acc[t][0] += w0 * bf2f(q & 0xffff); acc[t][1] += w1 * bf2f(q >> 16); } }
    float mean[16], rstd[16];
    SYNC();
#pragma unroll
    for (int t = 0; t < 16; ++t) { float s = act ? acc[t][0] + acc[t][1] : 0.f;
#pragma unroll
        for (int o = 1; o < 64; o <<= 1) s += shflx(s, o);
        if (lane == 0) red[w * 16 + t] = s; }
    SYNC();
#pragma unroll
    for (int t = 0; t < 16; ++t) { float s = 0.f;
#pragma unroll
        for (int q = 0; q < 8; ++q) s += red[q * 16 + t];
        mean[t] = s * (1.0f / DM); }
    SYNC();
#pragma unroll
    for (int t = 0; t < 16; ++t) { const float d0 = acc[t][0] - mean[t], d1 = acc[t][1] - mean[t]; float s = act ? d0 * d0 + d1 * d1 : 0.f;
#pragma unroll
        for (int o = 1; o < 64; o <<= 1) s += shflx(s, o);
        if (lane == 0) red[w * 16 + t] = s; }
    SYNC();
#pragma unroll
    for (int t = 0; t < 16; ++t) { float s = 0.f;
#pragma unroll
        for (int q = 0; q < 8; ++q) s += red[q * 16 + t];
        rstd[t] = frsq(s * (1.0f / DM) + EPS); }
    if (act) {
        const float g0 = INP(a, I_LNG)[li * DM + c0], g1 = INP(a, I_LNG)[li * DM + c0 + 1], e0 = INP(a, I_LNB)[li * DM + c0], e1 = INP(a, I_LNB)[li * DM + c0 + 1];
        bf16* dst = (bf16*)(ws + WS_CAT) + (size_t)t0 * DM + c0;
#pragma unroll
        for (int t = 0; t < 16; ++t) { const float y0 = (acc[t][0] - mean[t]) * rstd[t] * g0 + e0, y1 = (acc[t][1] - mean[t]) * rstd[t] * g1 + e1;
            *(unsigned*)(dst + (size_t)t * DM) = pk2(siluf(y0), siluf(y1)); }
    }
}

constexpr int N_PHASES = 1 + 16 * (DEPTH / 2) + 1;
DEV void phase_decode(int ph, int& l, int& sub) {
    const int q = ph - 1, pair = q >> 4, r = q & 15;
    if (r < 9) { l = 2 * pair; sub = r; } else { l = 2 * pair + 1; const int rr = r - 9; sub = rr < 3 ? rr : rr + 2; }
}
constexpr int LDS_BYTES = 150 * 1024;

DEV void run_phase(const Args& a, unsigned char* smem, int ph) {
#ifndef ONLY
#define ONLY -1
#endif
#define EN(k) (ONLY < 0 || ONLY == (k))
    if (ph == 0) { if (EN(100)) p0_phase(a, smem); return; }
    if (ph == N_PHASES - 1) { if (EN(0)) norm_phase(a, smem, DEPTH); return; }
    int l, sub; phase_decode(ph, l, sub); const int li = l >> 1; const bool even = (l & 1) == 0;
    unsigned char* ws = wsp(a);
    switch (sub) {
    case 0: if (EN(0)) norm_phase(a, smem, l); break;
    case 1: if (even) { if (EN(1)) inproj_phase(a, smem, li); } else { if (EN(11)) pw1_phase(a, smem, li); } break;
    case 2:
        if (even) { constexpr int NCI = 8 * ((NCP + 255) / 256); constexpr int NH1 = 8 * NCH;
            if (NBLK > 2 * NCI) { const int bid = BID;
                if (bid < NCI) { if (EN(2)) cmp_phase_items(a, smem, li, bid); }
                else { for (int it = bid - NCI; it < NH1; it += NBLK - NCI) if (EN(12)) hg_h1_task(a, smem, it); } }
            else for (int it = BID; it < NCI + NH1; it += NBLK) { if (it < NCI) { if (EN(2)) cmp_phase_items(a, smem, li, it); } else { if (EN(12)) hg_h1_task(a, smem, it - NCI); } } }
        else { for (int it = BID; it < T / 16; it += NBLK) if (EN(13)) conv_task(a, smem, li, it); }
        break;
    case 3:
        if (even) { constexpr int NA = 4 * (SEQ / 64); const int G = NBLK;
            for (int r = 0; r * G < NA; ++r) { const int it = r * G + ((r & 1) ? (G - 1 - BID) : BID); if (it < NA) { if (EN(3)) attn_task(a, smem, li, it); } }
            for (int it = BID; it < 64; it += NBLK) if (EN(14)) hg_scan_task(a, it); }
        break;
    case 4: if (even) { for (int it = BID; it < 8 * NCH; it += NBLK) if (EN(4)) hg_h3_task(a, smem, li, it); } break;
    case 5:
        if (!EN(5)) break;
        if (even) resid_gemm_phase(a, smem, (const bf16*)(ws + WS_CAT), 1024, (const bf16*)(ws + WS_WOUT) + (size_t)li * DM * 1024, l);
        else resid_gemm_phase(a, smem, (const bf16*)(ws + WS_CAT), DM, (const bf16*)(ws + WS_PW2) + (size_t)li * DM * DM, l);
        break;
    case 6: if (EN(6)) route_phase(a, smem, l); break;
#ifdef EMU
    case 7: if (EN(7)) moe_gemm_phase8(a, smem, l, 0); break;
    case 8: if (EN(8)) moe_gemm_phase8(a, smem, l, 1); break;
#else
    case 7: if (EN(7)) moe_fused_phase(a, smem, l); break;
    case 8: break;
#endif
    }
}

#ifndef EMU
#define LAS __attribute__((address_space(3)))
#define XB_TMO      128
static_assert(XB_TMO == MOE_TMO_IDX && P0_CTR_IDX > XB_TMO && P0_CTR_IDX < 256, "timeout word / free word");
#define XB_XCNT(j)  (256  + 64 * (j))
#define XB_XSUB(j)  (1280 + 64 * (j))
#define XB_XGEN(j)  (2304 + 64 * (j))
#define XB_TOP      3328
#define XB_TOPGEN   3392
#define XCD_BAR_WORDS 3456
#define XB_SPIN_CAP (1u << 22)
__device__ __forceinline__ unsigned xb_ld(unsigned* p)              { return __hip_atomic_load(p, __ATOMIC_RELAXED, __HIP_MEMORY_SCOPE_AGENT); }
__device__ __forceinline__ unsigned xb_add(unsigned* p, unsigned v) { return __hip_atomic_fetch_add(p, v, __ATOMIC_RELAXED, __HIP_MEMORY_SCOPE_AGENT); }
__device__ __forceinline__ unsigned xb_xcc_id() { return (unsigned)__builtin_amdgcn_s_getreg((3 << 11) | 20) & 0xFu; }
#define XB_SPIN(cond, bar) do { unsigned _sp = 0; while (cond) { __builtin_amdgcn_s_sleep(1); \
    if ((++_sp & 255u) == 0u) { if (xb_ld(&(bar)[XB_TMO])) break; if (_sp > XB_SPIN_CAP) { atomicAdd(&(bar)[XB_TMO], 1u); break; } } } } while (0)
struct XcdBarrier { unsigned* bar; unsigned x; volatile LAS unsigned* st; };
__device__ __forceinline__ XcdBarrier xcd_barrier_post(unsigned* bar, volatile LAS unsigned* st) {
    XcdBarrier b; b.bar = bar; b.x = xb_xcc_id(); b.st = st;
    if (threadIdx.x == 0) (void)xb_add(&bar[XB_XCNT(b.x)], 1u);
    return b;
}
__device__ __forceinline__ void xcd_barrier_complete(unsigned* bar, unsigned x, unsigned& nloc, unsigned& nx) {
    const unsigned G = gridDim.x * gridDim.y * gridDim.z;
    unsigned sum, cnt, mine, sp = 0u;
    for (;;) {
        sum = 0u; cnt = 0u; mine = 0u;
#pragma unroll
        for (unsigned j = 0; j < 16; ++j) { const unsigned c = xb_ld(&bar[XB_XCNT(j)]); sum += c; cnt += (c > 0u) ? 1u : 0u; mine = (j == x) ? c : mine; }
        if (sum == G) break;
        __builtin_amdgcn_s_sleep(1);
        if ((++sp & 255u) == 0u) { if (xb_ld(&bar[XB_TMO])) break; if (sp > XB_SPIN_CAP) { atomicAdd(&bar[XB_TMO], 1u); break; } }
    }
    nloc = mine > 0u ? mine : 1u; nx = cnt > 0u ? cnt : 1u;
}
__device__ __forceinline__ void xcd_barrier(const XcdBarrier& b) {
    asm volatile("s_waitcnt vmcnt(0)" ::: "memory");
    __syncthreads();
    if (threadIdx.x == 0) {
        unsigned* bar = b.bar;
        __builtin_amdgcn_s_waitcnt(0);
        unsigned nloc = b.st[0], nx = b.st[1];
        if (nloc == 0u) { xcd_barrier_complete(bar, b.x, nloc, nx); b.st[0] = nloc; b.st[1] = nx; }
        const unsigned old = xb_add(&bar[XB_XSUB(b.x)], 1u);
        const unsigned gen = old / nloc;
        if (old + 1u == (gen + 1u) * nloc) {
            __builtin_amdgcn_fence(__ATOMIC_RELEASE, "agent");
            asm volatile("s_waitcnt vmcnt(0)" ::: "memory");
            const unsigned og = xb_add(&bar[XB_TOP], 1u);
            const unsigned tg = og / nx;
            if (og + 1u == (tg + 1u) * nx) xb_add(&bar[XB_TOPGEN], 1u);
            else XB_SPIN(xb_ld(&bar[XB_TOPGEN]) == tg, bar);
            __builtin_amdgcn_fence(__ATOMIC_ACQUIRE, "agent");
            xb_add(&bar[XB_XGEN(b.x)], 1u);
            asm volatile("s_waitcnt vmcnt(0)" ::: "memory");
        } else {
            XB_SPIN(xb_ld(&bar[XB_XGEN(b.x)]) == gen, bar);
            __builtin_amdgcn_fence(__ATOMIC_ACQUIRE, "agent");
            asm volatile("s_waitcnt vmcnt(0)" ::: "memory");
        }
    }
    __syncthreads();
}

__global__ void __launch_bounds__(NT, 2) mega(Args a) {
    extern __shared__ __attribute__((aligned(16))) unsigned char lds[];
    volatile LAS unsigned* st = (volatile LAS unsigned*)(LAS unsigned char*)(lds + LDS_BYTES - 16);
    if (threadIdx.x < 4) st[threadIdx.x] = 0u;
    __syncthreads();
    unsigned* barw = (unsigned*)(a.ws + WS_BAR);
    XcdBarrier bar = xcd_barrier_post(barw, st);
#pragma unroll 1
    for (int ph = 0; ph < N_PHASES; ++ph) {
        if (ph > 0 && ph < N_PHASES - 1) { int l_, s_; phase_decode(ph, l_, s_); if (s_ == 8) continue; }
        run_phase(a, lds, ph);
#ifdef DUP
        { int lyr = 0, sub = 100; if (ph > 0 && ph < N_PHASES - 1) phase_decode(ph, lyr, sub);
          if (sub == (DUP % 1000) && (ph == 0 || lyr == DUP / 1000) && ph < N_PHASES - 1) { xcd_barrier(bar); run_phase(a, lds, ph); } }
#endif
        if (ph + 1 < N_PHASES) xcd_barrier(bar);
    }
    if (xb_ld(&barw[XB_TMO]) != 0u) {
        const size_t gt = (size_t)blockIdx.x * NT + threadIdx.x, gs = (size_t)gridDim.x * NT;
        for (size_t i = gt; i < (size_t)T * DM; i += gs) a.out[i] = __builtin_nanf("");
    }
}

extern "C" void kernel_launch(void* const* d_in, const int* in_sizes, int n_in, void* d_out, int out_size,
                              void* d_ws, size_t ws_size, hipStream_t stream) {
    static int grid = 0;
    if (grid == 0) {
        int dev = 0, cus = 0;
        if (hipGetDevice(&dev) != hipSuccess || hipDeviceGetAttribute(&cus, hipDeviceAttributeMultiprocessorCount, dev) != hipSuccess) { grid = -1; return; }
        if (hipFuncSetAttribute((const void*)mega, hipFuncAttributeMaxDynamicSharedMemorySize, LDS_BYTES) != hipSuccess) { grid = -1; return; }
        (void)hipGetLastError();
        grid = cus;
        if (n_in != 26 || out_size != T * DM || ws_size < WS_END) { fprintf(stderr, "kernel_launch: unexpected sizes n_in %d out %d ws %zu (need %zu)\n", n_in, out_size, ws_size, (size_t)WS_END); grid = -1; return; }
    }
    if (grid < 0) return;
    (void)hipMemsetAsync((unsigned char*)d_ws + WS_BAR, 0, XCD_BAR_WORDS * 4, stream);
    Args a{};
    for (int i = 0; i < 26; ++i) a.in[i] = (const float*)d_in[i];
    a.out = (float*)d_out; a.ws = (unsigned char*)d_ws;
    hipLaunchKernelGGL(mega, dim3(grid), dim3(NT), LDS_BYTES, stream, a);
}
#endif
```

```cpp
#ifdef EMU
#include "emu.h"
#define DEV static inline
#define MDEV inline
#define OPAQUE(p)
#define OPAQUE2(a, b)
#define TID emu_tid()
#define BID (EB->bid)
#define NBLK (EB->nblk)
#define SYNC() emu_sync_block()
#define WSYNC() emu_sync_wave()
#define mfma16(a, b, c) emu_mfma16(a, b, c)
DEV float shflx(float v, int m) { return emu_shfl_f(v, (emu_tid() & 63) ^ m); }
DEV int shflxi(int v, int m) { return (int)emu_shfl_u((unsigned)v, (emu_tid() & 63) ^ m); }
DEV float shfl(float v, int s) { return emu_shfl_f(v, s); }
DEV float dpp_ror1(float v) { const int l = emu_tid() & 63; return emu_shfl_f(v, (l & 48) | ((l - 1) & 15)); }
DEV int atomic_add_i(int* p, int v) { return __atomic_fetch_add(p, v, __ATOMIC_RELAXED); }
DEV float fexp2(float x) { return exp2f(x); }
DEV float frcp(float x) { return 1.0f / x; }
DEV float frsq(float x) { return 1.0f / sqrtf(x); }
typedef short s16x4 __attribute__((vector_size(8)));
static inline s16x4 emu_tr4(const unsigned short* p) {
    EmuWave& w = EB->wave[emu_tid() >> 6]; int l = emu_tid() & 63;
    const unsigned short** tab = (const unsigned short**)w.a;
    tab[l] = p; emu_sync_wave();
    s16x4 r; int g = l & 48, i = l & 15;
    for (int q = 0; q < 4; ++q) r[q] = (short)tab[g + 4 * q + (i >> 2)][i & 3];
    emu_sync_wave(); return r;
}
#define tr4(p) emu_tr4(p)
#else
#include <hip/hip_runtime.h>
#include <cstdio>
#include <cstdint>
typedef short bf16x8 __attribute__((ext_vector_type(8)));
typedef float f32x4 __attribute__((ext_vector_type(4)));
typedef unsigned u32x4 __attribute__((ext_vector_type(4)));
typedef unsigned u32x2 __attribute__((ext_vector_type(2)));
#define DEV __device__ __forceinline__
#define MDEV __device__ __forceinline__
#define OPAQUE(p) asm volatile("" : "+v"(p))
#define OPAQUE2(a, b) asm volatile("" : "+v"(a), "+v"(b))
DEV int tid_opaque() { int t = (int)threadIdx.x; asm volatile("" : "+v"(t)); return t; }
#define TID tid_opaque()
DEV int bid_opaque() { int b = (int)blockIdx.x; asm volatile("" : "+s"(b)); return b; }
#define BID bid_opaque()
#define NBLK ((int)gridDim.x)
#define SYNC() __syncthreads()
#define WSYNC() __builtin_amdgcn_wave_barrier()
#define mfma16(a, b, c) __builtin_amdgcn_mfma_f32_16x16x32_bf16(a, b, c, 0, 0, 0)
DEV int shflxi(int x, int m) {
    if (m == 1) return __builtin_amdgcn_update_dpp(x, x, 0xB1, 0xf, 0xf, true);
    if (m == 2) return __builtin_amdgcn_update_dpp(x, x, 0x4E, 0xf, 0xf, true);
    if (m == 4) return __builtin_amdgcn_ds_swizzle(x, (4 << 10) | 0x1F);
    if (m == 8) return __builtin_amdgcn_ds_swizzle(x, (8 << 10) | 0x1F);
    if (m == 16) return __builtin_amdgcn_ds_swizzle(x, (16 << 10) | 0x1F);
    if (m == 32) { const auto r = __builtin_amdgcn_permlane32_swap((unsigned)x, (unsigned)x, false, false); return (int)((threadIdx.x & 32) ? r[0] : r[1]); }
    return __shfl_xor(x, m);
}
DEV float shflx(float v, int m) { return __builtin_bit_cast(float, shflxi(__builtin_bit_cast(int, v), m)); }
DEV float dpp_ror1(float v) { return __builtin_bit_cast(float, __builtin_amdgcn_update_dpp(0, __builtin_bit_cast(int, v), 0x121, 0xf, 0xf, false)); }
DEV float shfl(float v, int s) { return __shfl(v, s); }
DEV int atomic_add_i(int* p, int v) { return atomicAdd(p, v); }
DEV float fexp2(float x) { return __builtin_amdgcn_exp2f(x); }
DEV float frcp(float x) { return __builtin_amdgcn_rcpf(x); }
DEV float frsq(float x) { return __builtin_amdgcn_rsqf(x); }
typedef short s16x4 __attribute__((ext_vector_type(4)));
#define tr4(p) __builtin_amdgcn_ds_read_tr16_b64_v4i16((__attribute__((address_space(3))) s16x4*)(p))
#endif

typedef unsigned short bf16;

#ifndef DM
#define DM 1024
#endif
#ifndef SEQ
#define SEQ 8192
#endif
#ifndef FF
#define FF 512
#endif
constexpr int NBATCH = 2, T = NBATCH * SEQ, DEPTH = 4;
constexpr int NIN = 3352, NINP = 3456, NIN8 = 3584;
constexpr int NT = 512;
constexpr int NCH = SEQ / 64;
constexpr int NCP = SEQ / 16;
constexpr int NCMP = NCP - 1;
constexpr int MOE_ROWS = 2 * T + 32 * 256;
constexpr float EPS = 1e-6f, NEGV = -1e30f, FORCEV = 1e4f, LOG2E = 1.4426950408889634f;

constexpr size_t al(size_t x) { return (x + 255) & ~(size_t)255; }
constexpr int P0_CTR_IDX = 192;
constexpr size_t WS_BAR = 0;
constexpr size_t WS_CNT = 16384;
constexpr size_t WS_MOD = WS_CNT + (size_t)DEPTH * 32 * 256;
constexpr size_t WS_LB = al(WS_MOD + (size_t)DEPTH * 2 * 6 * DM * 4);
constexpr size_t WS_CB = al(WS_LB + 2 * 512 * 4);
constexpr size_t WS_CS = al(WS_CB + 2 * 2 * 8 * 64 * 4);
constexpr size_t WS_WIN = al(WS_CS + 64);
constexpr size_t WS_WOUT = al(WS_WIN + (size_t)2 * NIN8 * DM * 2);
constexpr size_t WS_PW1 = al(WS_WOUT + (size_t)2 * DM * 1024 * 2);
constexpr size_t WS_PW2 = al(WS_PW1 + (size_t)2 * 2 * DM * DM * 2);
constexpr size_t WS_WC = al(WS_PW2 + (size_t)2 * DM * DM * 2);
constexpr size_t WS_W13 = al(WS_WC + (size_t)2 * 2 * 64 * 2048 * 2);
constexpr size_t WS_W2 = al(WS_W13 + (size_t)DEPTH * 32 * 2 * FF * DM * 2);
constexpr size_t WS_H = al(WS_W2 + (size_t)DEPTH * 32 * DM * FF * 2);
constexpr size_t WS_QN = al(WS_H + (size_t)T * DM * 2);
constexpr size_t WS_KCG = al(WS_QN + (size_t)T * 512 * 2);
constexpr size_t WS_VCG = al(WS_KCG + (size_t)T * 128 * 2);
constexpr size_t WS_KS = al(WS_VCG + (size_t)T * 128 * 2);
constexpr size_t WS_KW = al(WS_KS + (size_t)T * 128 * 2);
constexpr size_t WS_VST = al(WS_KW + (size_t)T * 128 * 2);
constexpr size_t WS_VWT = al(WS_VST + (size_t)T * 128 * 2);
constexpr size_t WS_KC = al(WS_VWT + (size_t)T * 128 * 2);
constexpr size_t WS_VCT = al(WS_KC + (size_t)4 * NCP * 64 * 2);
constexpr size_t WS_GATE = al(WS_VCT + (size_t)4 * NCP * 64 * 2);
constexpr size_t WS_HQ = al(WS_GATE + (size_t)T * 24 * 4);
constexpr size_t WS_HF = al(WS_HQ + (size_t)T * 512 * 2);
constexpr size_t WS_HV = al(WS_HF + (size_t)T * 512 * 4);
constexpr size_t WS_HGS = al(WS_HV + (size_t)T * 512 * 2);
constexpr size_t WS_UT = al(WS_HGS + (size_t)T * 512 * 2);
constexpr size_t WS_ST = al(WS_UT + (size_t)8 * NCH * 128 * 128 * 4);
constexpr size_t WS_GD = al(WS_ST + (size_t)8 * NCH * 128 * 128 * 2);
constexpr size_t WS_CAT = al(WS_GD + (size_t)8 * NCH * 128 * 4);
constexpr size_t WS_GLU = al(WS_CAT + (size_t)T * 1024 * 2);
constexpr size_t WS_TIE = al(WS_GLU + (size_t)T * DM * 2);
constexpr size_t WS_TIW = al(WS_TIE + (size_t)T * 2 * 4);
constexpr size_t WS_LIST = al(WS_TIW + (size_t)T * 2 * 4);
constexpr size_t WS_ACT = al(WS_LIST + (size_t)32 * T * 4);
constexpr size_t WS_YK = al(WS_ACT + (size_t)MOE_ROWS * FF * 2);
constexpr size_t WS_WTH = al(WS_YK + (size_t)MOE_ROWS * DM * 2);
constexpr size_t WS_WTL = al(WS_WTH + (size_t)DEPTH * 48 * DM * 2);
constexpr size_t WS_AVEC = al(WS_WTL + (size_t)DEPTH * 48 * DM * 2);
constexpr size_t WS_RBIAS = al(WS_AVEC + (size_t)DEPTH * 2 * DM * 4);
constexpr size_t WS_FLG = al(WS_RBIAS + (size_t)DEPTH * 2 * 48 * 4);
constexpr size_t WS_END = al(WS_FLG + (size_t)DEPTH * 256 * 64);

struct Args { const float* in[26]; float* out; unsigned char* ws; };
enum { I_X = 0, I_C, I_ADAW, I_ADAB, I_NMIX, I_NFFN, I_WIN, I_WOUT, I_CWK, I_CWV, I_CPE, I_QG, I_KG, I_LBL, I_OG,
       I_PW1, I_DW, I_DWB, I_LNG, I_LNB, I_PW2, I_WG, I_WE, I_W1, I_W3, I_W2 };

#ifdef EMU
DEV unsigned char* wsp(const Args& a) { return a.ws; }
DEV float* outp(const Args& a) { return a.out; }
#else
DEV unsigned char* launder_ptr(const void* p) { unsigned long long v = (unsigned long long)p; unsigned lo = (unsigned)v, hi = (unsigned)(v >> 32);
    lo = (unsigned)__builtin_amdgcn_readfirstlane((int)lo); hi = (unsigned)__builtin_amdgcn_readfirstlane((int)hi); asm volatile("" : "+s"(lo), "+s"(hi)); typedef __attribute__((address_space(1))) unsigned char* gptr_t; return (unsigned char*)(gptr_t)(((unsigned long long)hi << 32) | lo); }
DEV unsigned char* wsp(const Args& a) { return launder_ptr(a.ws); }
DEV float* outp(const Args& a) { return (float*)launder_ptr(a.out); }
#endif

#ifdef EMU
#define INP(a, X) ((a).in[X])
#else
DEV int zero_opaque() { int z = 0; asm volatile("" : "+s"(z)); return z; }
#define INP(a, X) ((a).in[(X) + zero_opaque()])
#endif

DEV unsigned f2bf(float f) { unsigned u = __builtin_bit_cast(unsigned, f); return (u + 0x7fffu + ((u >> 16) & 1u)) >> 16; }
DEV float bf2f(unsigned h) { return __builtin_bit_cast(float, h << 16); }
#ifdef EMU
DEV unsigned pk2(float lo, float hi) { return f2bf(lo) | (f2bf(hi) << 16); }
#else
typedef float f32x2_t __attribute__((ext_vector_type(2)));
typedef __bf16 bf16x2_t __attribute__((ext_vector_type(2)));
DEV unsigned pk2(float lo, float hi) { f32x2_t v = {lo, hi}; bf16x2_t b = __builtin_convertvector(v, bf16x2_t); return __builtin_bit_cast(unsigned, b); }
#endif
DEV float sigm(float x) { return frcp(1.0f + fexp2(-x * LOG2E)); }
DEV float siluf(float x) { return x * sigm(x); }
DEV f32x4 f4zero() { f32x4 z = {0.f, 0.f, 0.f, 0.f}; return z; }
DEV bf16x8 pack8(f32x4 a, f32x4 b) {
    u32x4 w; w[0] = pk2(a[0], a[1]); w[1] = pk2(a[2], a[3]); w[2] = pk2(b[0], b[1]); w[3] = pk2(b[2], b[3]);
    return __builtin_bit_cast(bf16x8, w);
}
DEV void st_bf8(bf16* p, f32x4 a, f32x4 b) { u32x4 w; w[0] = pk2(a[0], a[1]); w[1] = pk2(a[2], a[3]); w[2] = pk2(b[0], b[1]); w[3] = pk2(b[2], b[3]); *(u32x4*)p = w; }
DEV void st_bf4(bf16* p, f32x4 v) { u32x2 w; w[0] = pk2(v[0], v[1]); w[1] = pk2(v[2], v[3]); *(u32x2*)p = w; }


#ifdef EMU
namespace pg8 {
constexpr int BM = 256, BK = 64, HALF = 128, NXCD = 8, WGM = 8;
typedef unsigned short bf16_t;
struct Unit { int pm, pn; };
struct Gemm { const bf16_t* A; const bf16_t* Bt; int M, N, K; };
struct StaticOrder {
    int nM, nN, nwg, G, c;
    void init(int M, int N, int G_, int c_) { nM = M / BM; nN = N / BM; nwg = nM * nN; G = G_; c = c_; }
    bool next(int i, Unit& u) const {
        const long L = (long)i * G + c; if (L >= nwg) return false;
        int wgid = (int)L; { const int q = nwg / NXCD, r = nwg % NXCD, xcd = wgid % NXCD, off = wgid / NXCD; wgid = (xcd < r ? xcd * (q + 1) : r * (q + 1) + (xcd - r) * q) + off; }
        const int nig = WGM * nN, gid = wgid / nig, fm = gid * WGM, gsz = (nM - fm) < WGM ? (nM - fm) : WGM;
        u.pm = fm + ((wgid % nig) % gsz); u.pn = (wgid % nig) / gsz; return true;
    }
};
struct SelNone { static constexpr bool GATHER = false; struct Ctx {}; Ctx ctx(const Unit&) const { return Ctx(); } size_t boff(const Ctx&) const { return 0; } unsigned aoff(const Ctx&, int) const { return 0u; } };
template <class Epi, class Sched, bool ALIGN_EPI = false, bool SP2 = false, class Sel = SelNone>
static inline void gemm_phase(unsigned char*, const Gemm g, const Sched& S, const Epi& E, const Sel& X = Sel()) {
    const int tid = emu_tid(), wid = tid >> 6, lane = tid & 63, wr = wid >> 2, wc = wid & 3, fr = lane & 15, fq = lane >> 4;
    Unit u;
    for (int ui = 0; S.next(ui, u); ++ui) {
        f32x4 acc[2][2][4][2]; const auto cx = X.ctx(u);
        for (int ai = 0; ai < 2; ++ai) for (int bj = 0; bj < 2; ++bj) for (int m = 0; m < 4; ++m) for (int n = 0; n < 2; ++n) for (int r = 0; r < 4; ++r) {
            const int row = 256 * u.pm + 128 * ai + 64 * wr + 16 * m + fr, col = 256 * u.pn + 128 * bj + 32 * wc + (Epi::PERM ? 8 * fq + 4 * n + r : 16 * n + 4 * fq + r); float sum = 0.f;
            const bf16_t* ap = Sel::GATHER ? (const bf16_t*)((const char*)g.A + X.aoff(cx, row - 256 * u.pm)) : g.A + (size_t)row * g.K; const bf16_t* bp = (const bf16_t*)((const char*)g.Bt + X.boff(cx)) + (size_t)col * g.K;
            for (int k = 0; k < g.K; ++k) sum += bf2f(ap[k]) * bf2f(bp[k]);
            acc[ai][bj][m][n][r] = sum; }
        E(acc, u, wr, wc, fr, fq);
    }
    emu_sync_block();
}
}
#else
namespace pg8 {
#define PG8_LAS __attribute__((address_space(3)))
typedef unsigned short bf16_t;
typedef short bf16x8 __attribute__((ext_vector_type(8)));
typedef float f32x4 __attribute__((ext_vector_type(4)));
typedef unsigned u32x4 __attribute__((ext_vector_type(4)));
constexpr int BM = 256, BK = 64, HALF = 128, HTB = HALF * BK * 2  , STAGE_BYTES = 8 * HTB, NXCD = 8, WGM = 8;

__host__ __device__ __forceinline__ int lds_byte(int r, int c) { const int st = (r >> 4) * 2 + (c >> 5), rr = r & 15, cc = c & 31, ob = rr * 64 + cc * 2; return st * 1024 + (ob ^ (((ob >> 9) & 1) << 5)); }
__host__ __device__ __forceinline__ void stage_rc(int b, int& R, int& C) { const int st = b / 1024, sb = b % 1024, swz = sb ^ (((sb >> 9) & 1) << 5); R = (st >> 1) * 16 + swz / 64; C = (st & 1) * 32 + (swz % 64) / 2; }
__host__ __device__ __forceinline__ int perm32(int rho) { const int n = rho >> 4, i = rho & 15; return 8 * (i >> 2) + 4 * n + (i & 3); }

struct Unit { int pm, pn; };
struct Gemm { const bf16_t* A; const bf16_t* Bt; int M, N, K; };

struct StaticOrder {
    int nM, nN, nwg, G, c;
    __host__ __device__ void init(int M, int N, int G_, int c_) { nM = M / BM; nN = N / BM; nwg = nM * nN; G = G_; c = c_; }
    __host__ __device__ bool next(int i, Unit& u) const {
        const long L = (long)i * G + c; if (L >= nwg) return false;
        int wgid = (int)L; { const int q = nwg / NXCD, r = nwg % NXCD, xcd = wgid % NXCD, off = wgid / NXCD; wgid = (xcd < r ? xcd * (q + 1) : r * (q + 1) + (xcd - r) * q) + off; }
        const int nig = WGM * nN, gid = wgid / nig, fm = gid * WGM, gsz = (nM - fm) < WGM ? (nM - fm) : WGM;
        u.pm = fm + ((wgid % nig) % gsz); u.pn = (wgid % nig) / gsz; return true;
    }
    __device__ __forceinline__ void a_ready(const Unit&) const {}
    __device__ __forceinline__ void done(const Unit&) const {}
};

__device__ __forceinline__ unsigned cvt_pk_bf16(float lo, float hi) { unsigned r; asm volatile("v_cvt_pk_bf16_f32 %0, %1, %2" : "=v"(r) : "v"(lo), "v"(hi)); return r; }
struct SelNone { static constexpr bool GATHER = false; struct Ctx {}; __device__ __forceinline__ Ctx ctx(const Unit&) const { return Ctx(); } __device__ __forceinline__ size_t boff(const Ctx&) const { return 0; } __device__ __forceinline__ unsigned aoff(const Ctx&, int) const { return 0u; } };
template <class Epi, class Sched, bool ALIGN_EPI = false, bool SP2 = false, class Sel = SelNone>
__device__ __forceinline__ void gemm_phase(PG8_LAS unsigned char* lds, const Gemm g, const Sched& S, const Epi& E, const Sel& X = Sel()) {
    constexpr bool GA = Sel::GATHER;
    const int tid = TID, wid = __builtin_amdgcn_readfirstlane(tid >> 6), lane = tid & 63, wr = wid >> 2, wc = wid & 3, fr = lane & 15, fq = lane >> 4;
    const int K = g.K, nt = K / BK;
    unsigned voffA[2], voffB[2]; int Rl[2]; unsigned Cl2[2];
#pragma unroll
    for (int i = 0; i < 2; ++i) { int R, C; stage_rc(tid * 16 + i * 8192, R, C); const int Rb = Epi::PERM ? ((R & ~31) + perm32(R & 31)) : R;
        voffA[i] = (unsigned)(R * K + C) * 2u; voffB[i] = (unsigned)(Rb * K + C) * 2u; Rl[i] = R; Cl2[i] = (unsigned)C * 2u; }
    unsigned vA[2][2], vAn[2][2];
    const size_t kstep = (size_t)(BK * 2);
    const size_t hstep = (size_t)HALF * K * 2;
    const size_t tstep = 2 * hstep;
    const unsigned ldsw = (unsigned)wid * 1024u;
    const int aoff = lds_byte(wr * 64 + fr, fq * 8), boff = lds_byte(wc * 32 + fr, fq * 8);
#define PG8_SA(b, h) (((b) * 2 + (h)) * HTB)
#define PG8_SB(b, h) ((4 + (b) * 2 + (h)) * HTB)
#define PG8_STAGE(bufoff, gbase, voff) do { _Pragma("unroll") for (int _i = 0; _i < 2; ++_i) \
        __builtin_amdgcn_global_load_lds((const unsigned*)((const char*)(gbase) + (voff)[_i]), (PG8_LAS unsigned*)(lds + (bufoff) + ldsw + _i * 8192), 16, 0, 0); } while (0)
#define PG8_STAGE_A(bufoff, p, h, nx) do { if constexpr (GA) { unsigned _vo[2] = {(nx) ? vAn[h][0] : vA[h][0], (nx) ? vAn[h][1] : vA[h][1]}; PG8_STAGE(bufoff, p, _vo); } else { PG8_STAGE(bufoff, (p) + (h) * hstep, voffA); } } while (0)
#define PG8_GATH(cx, dst) do { _Pragma("unroll") for (int _h = 0; _h < 2; ++_h) _Pragma("unroll") for (int _i = 0; _i < 2; ++_i) dst[_h][_i] = X.aoff(cx, 128 * _h + Rl[_i]) + Cl2[_i]; } while (0)
#define PG8_LDA(dst, b, h) do { _Pragma("unroll") for (int m = 0; m < 4; ++m) _Pragma("unroll") for (int k = 0; k < 2; ++k) dst[m][k] = *(const PG8_LAS bf16x8*)(lds + PG8_SA(b, h) + aoff + m * 2048 + k * 1024); } while (0)
#define PG8_LDB(dst, b, h) do { _Pragma("unroll") for (int n = 0; n < 2; ++n) _Pragma("unroll") for (int k = 0; k < 2; ++k) dst[n][k] = *(const PG8_LAS bf16x8*)(lds + PG8_SB(b, h) + boff + n * 2048 + k * 1024); } while (0)
#define PG8_MMA(ai, bj, At, Bt) do { __builtin_amdgcn_s_setprio(1); _Pragma("unroll") for (int m = 0; m < 4; ++m) _Pragma("unroll") for (int n = 0; n < 2; ++n) _Pragma("unroll") for (int k = 0; k < 2; ++k) \
        acc[ai][bj][m][n] = __builtin_amdgcn_mfma_f32_16x16x32_bf16(Bt[n][k], At[m][k], acc[ai][bj][m][n], 0, 0, 0); __builtin_amdgcn_s_setprio(0); } while (0)
#define PG8_WAIT_V(n) asm volatile("s_waitcnt vmcnt(" #n ")" ::: "memory")
#define PG8_WAIT_L(n) asm volatile("s_waitcnt lgkmcnt(" #n ")" ::: "memory")
#define PG8_BAR __builtin_amdgcn_s_barrier()
#define PG8_SCHED __builtin_amdgcn_sched_barrier(0)
    Unit cur, nxt; int ui = 0;
    if (!S.next(0, cur)) return;
    f32x4 acc[2][2][4][2];
#pragma unroll
    for (int a = 0; a < 2; ++a)
#pragma unroll
        for (int b = 0; b < 2; ++b)
#pragma unroll
            for (int m = 0; m < 4; ++m)
#pragma unroll
                for (int n = 0; n < 2; ++n) acc[a][b][m][n] = (f32x4){0.f, 0.f, 0.f, 0.f};
    bf16x8 At[4][2], B0[2][2], B1[2][2];
    auto ccx = X.ctx(cur);
    const char* cA = GA ? (const char*)g.A : (const char*)g.A + (size_t)cur.pm * tstep; const char* cB = (const char*)g.Bt + X.boff(ccx) + (size_t)cur.pn * tstep;
    if constexpr (GA) { PG8_GATH(ccx, vA); }
    S.a_ready(cur);
    if constexpr (SP2) {
        PG8_STAGE(PG8_SB(0, 0), cB, voffB); PG8_STAGE(PG8_SB(0, 1), cB + hstep, voffB); PG8_STAGE_A(PG8_SA(0, 0), cA, 0, false); PG8_STAGE_A(PG8_SA(0, 1), cA, 1, false);
        if (wr == 1) PG8_BAR;
        PG8_WAIT_V(2); PG8_BAR;
        PG8_STAGE(PG8_SB(1, 0), cB + kstep, voffB); PG8_STAGE_A(PG8_SA(1, 0), cA + kstep, 0, false); PG8_STAGE(PG8_SB(1, 1), cB + hstep + kstep, voffB);
        PG8_WAIT_V(6); PG8_BAR;
    } else {
        PG8_STAGE(PG8_SB(0, 0), cB, voffB); PG8_STAGE_A(PG8_SA(0, 0), cA, 0, false); PG8_STAGE(PG8_SB(0, 1), cB + hstep, voffB); PG8_STAGE_A(PG8_SA(0, 1), cA, 1, false);
        if (wr == 1) PG8_BAR;
        PG8_WAIT_V(4); PG8_BAR;
        PG8_STAGE(PG8_SB(1, 0), cB + kstep, voffB); PG8_STAGE_A(PG8_SA(1, 0), cA + kstep, 0, false); PG8_STAGE(PG8_SB(1, 1), cB + hstep + kstep, voffB);
        PG8_WAIT_V(6); PG8_BAR;
    }
    for (;;) {
        const bool has_next = S.next(ui + 1, nxt);
        const char* nA = cA; const char* nB = cB;
        if (has_next) { const auto ncx = X.ctx(nxt); nA = GA ? (const char*)g.A : (const char*)g.A + (size_t)nxt.pm * tstep; nB = (const char*)g.Bt + X.boff(ncx) + (size_t)nxt.pn * tstep; if constexpr (GA) { PG8_GATH(ncx, vAn); } }
        else if constexpr (GA) {
#pragma unroll
            for (int _h = 0; _h < 2; ++_h) { vAn[_h][0] = vA[_h][0]; vAn[_h][1] = vA[_h][1]; } }
        for (int t = 0; t < nt; t += 2) {
            const bool last = (t == nt - 2);
            const char* a1 = cA + (size_t)(t + 1) * kstep;
            const char* a2 = last ? nA : cA + (size_t)(t + 2) * kstep; const char* b2 = last ? nB : cB + (size_t)(t + 2) * kstep;
            const char* a3 = a2 + kstep; const char* b3 = b2 + kstep;
            if (last && has_next) S.a_ready(nxt);
            if constexpr (SP2) {
            PG8_LDB(B0, 0, 0); PG8_LDB(B1, 0, 1); PG8_SCHED; PG8_LDA(At, 0, 0); PG8_STAGE_A(PG8_SA(1, 1), a1, 1, false);
            PG8_WAIT_V(8); PG8_WAIT_L(0); PG8_BAR; PG8_MMA(0, 0, At, B0); PG8_MMA(0, 1, At, B1); PG8_BAR; PG8_SCHED;
            PG8_LDA(At, 0, 1); PG8_STAGE(PG8_SB(0, 0), b2, voffB); PG8_STAGE(PG8_SB(0, 1), b2 + hstep, voffB); PG8_STAGE_A(PG8_SA(0, 0), a2, 0, last);
            PG8_WAIT_V(8); PG8_WAIT_L(0); PG8_BAR; PG8_MMA(1, 0, At, B0); PG8_MMA(1, 1, At, B1); PG8_BAR; PG8_SCHED;
            PG8_LDB(B0, 1, 0); PG8_LDB(B1, 1, 1); PG8_SCHED; PG8_LDA(At, 1, 0); PG8_STAGE_A(PG8_SA(0, 1), a2, 1, last);
            PG8_WAIT_V(8); PG8_WAIT_L(0); PG8_BAR; PG8_MMA(0, 0, At, B0); PG8_MMA(0, 1, At, B1); PG8_BAR; PG8_SCHED;
            PG8_LDA(At, 1, 1); PG8_STAGE(PG8_SB(1, 0), b3, voffB); PG8_STAGE(PG8_SB(1, 1), b3 + hstep, voffB); PG8_STAGE_A(PG8_SA(1, 0), a3, 0, last);
            PG8_WAIT_V(8); PG8_WAIT_L(0); PG8_BAR; PG8_MMA(1, 0, At, B0); PG8_MMA(1, 1, At, B1); PG8_BAR; PG8_SCHED;
            } else {
            PG8_LDB(B0, 0, 0); PG8_SCHED; PG8_LDA(At, 0, 0); PG8_STAGE_A(PG8_SA(1, 1), a1, 1, false);
            PG8_WAIT_L(8); PG8_BAR; PG8_WAIT_L(0); PG8_MMA(0, 0, At, B0); PG8_BAR; PG8_SCHED;
            PG8_LDB(B1, 0, 1); PG8_STAGE(PG8_SB(0, 0), b2, voffB);
            PG8_BAR; PG8_WAIT_L(0); PG8_MMA(0, 1, At, B1); PG8_BAR;
            PG8_LDA(At, 0, 1); PG8_STAGE_A(PG8_SA(0, 0), a2, 0, last);
            PG8_BAR; PG8_WAIT_L(0); PG8_MMA(1, 0, At, B0); PG8_BAR; PG8_SCHED;
            PG8_STAGE(PG8_SB(0, 1), b2 + hstep, voffB);
            PG8_WAIT_V(6); PG8_BAR; PG8_MMA(1, 1, At, B1); PG8_BAR;
            PG8_LDB(B0, 1, 0); PG8_SCHED; PG8_LDA(At, 1, 0); PG8_STAGE_A(PG8_SA(0, 1), a2, 1, last);
            PG8_WAIT_L(8); PG8_BAR; PG8_WAIT_L(0); PG8_MMA(0, 0, At, B0); PG8_BAR; PG8_SCHED;
            PG8_LDB(B1, 1, 1); PG8_STAGE(PG8_SB(1, 0), b3, voffB);
            PG8_BAR; PG8_WAIT_L(0); PG8_MMA(0, 1, At, B1); PG8_BAR;
            PG8_LDA(At, 1, 1); PG8_STAGE_A(PG8_SA(1, 0), a3, 0, last);
            PG8_BAR; PG8_WAIT_L(0); PG8_MMA(1, 0, At, B0); PG8_BAR; PG8_SCHED;
            PG8_STAGE(PG8_SB(1, 1), b3 + hstep, voffB);
            PG8_WAIT_V(6); PG8_BAR; PG8_MMA(1, 1, At, B1); PG8_BAR;
            }
        }
        if constexpr (ALIGN_EPI) { if (wr == 0) PG8_BAR; }
        if constexpr (!Epi::AFTER_DRAIN) { E(acc, cur, wr, wc, fr, fq); S.done(cur); }
        if (!has_next) break;
#pragma unroll
        for (int a = 0; a < 2; ++a)
#pragma unroll
            for (int b = 0; b < 2; ++b)
#pragma unroll
                for (int m = 0; m < 4; ++m)
#pragma unroll
                    for (int n = 0; n < 2; ++n) acc[a][b][m][n] = (f32x4){0.f, 0.f, 0.f, 0.f};
        cur = nxt; cA = nA; cB = nB; ++ui;
        if constexpr (GA) {
#pragma unroll
            for (int _h = 0; _h < 2; ++_h) { vA[_h][0] = vAn[_h][0]; vA[_h][1] = vAn[_h][1]; } }
        if constexpr (ALIGN_EPI) { if (wr == 1) PG8_BAR; }
    }
    PG8_WAIT_V(0);
    if constexpr (!ALIGN_EPI) { if (wr == 0) PG8_BAR; }
    PG8_BAR;
    if constexpr (Epi::AFTER_DRAIN) { E.fused(acc, cur, wr, wc, fr, fq, lds, wid, lane); S.done(cur); }
#undef PG8_SA
#undef PG8_SB
#undef PG8_STAGE
#undef PG8_STAGE_A
#undef PG8_GATH
#undef PG8_LDA
#undef PG8_LDB
#undef PG8_MMA
#undef PG8_WAIT_V
#undef PG8_WAIT_L
#undef PG8_BAR
#undef PG8_SCHED
}
}
#endif

constexpr int LDT = 72;
constexpr int GEMM_AS = 256 * LDT, GEMM_BS = 128 * LDT;
constexpr int GEMM_LDS = 2 * (GEMM_AS + GEMM_BS) * 2;

template <class AF, class EPI>
DEV void gemm_tile(unsigned char* smem, AF af, const bf16* Bt, int ldb, int nvalid, int K, EPI& epi) {
    const int tid = TID, w = tid >> 6, l = tid & 63, h = l >> 4, c = l & 15, wm = w >> 1, wn = w & 1;
    bf16* As = (bf16*)smem; bf16* Bs = As + 2 * GEMM_AS;
    const bf16* ap[4]; const bf16* bp[2];
    const int col8 = (tid & 7) * 8, r0 = tid >> 3;
#pragma unroll
    for (int i = 0; i < 4; ++i) ap[i] = af(r0 + 64 * i) + col8;
#pragma unroll
    for (int i = 0; i < 2; ++i) { int rn = r0 + 64 * i; if (rn >= nvalid) rn = nvalid - 1; bp[i] = Bt + (size_t)rn * ldb + col8; }
    f32x4 acc[4][4];
#pragma unroll
    for (int i = 0; i < 4; ++i)
#pragma unroll
        for (int j = 0; j < 4; ++j) acc[i][j] = f4zero();
    bf16x8 ra[4], rb[2];
#pragma unroll
    for (int i = 0; i < 4; ++i) ra[i] = *(const bf16x8*)(ap[i]);
#pragma unroll
    for (int i = 0; i < 2; ++i) rb[i] = *(const bf16x8*)(bp[i]);
    SYNC();
#pragma unroll
    for (int i = 0; i < 4; ++i) *(bf16x8*)(As + (r0 + 64 * i) * LDT + col8) = ra[i];
#pragma unroll
    for (int i = 0; i < 2; ++i) *(bf16x8*)(Bs + (r0 + 64 * i) * LDT + col8) = rb[i];
    SYNC();
    const int nk = K / 64;
    for (int kt = 0; kt < nk; ++kt) {
        const int cur = kt & 1;
        if (kt + 1 < nk) {
#pragma unroll
            for (int i = 0; i < 4; ++i) ra[i] = *(const bf16x8*)(ap[i] + (kt + 1) * 64);
#pragma unroll
            for (int i = 0; i < 2; ++i) rb[i] = *(const bf16x8*)(bp[i] + (kt + 1) * 64);
        }
        const bf16* Ac = As + cur * GEMM_AS + (wm * 64 + c) * LDT + 8 * h;
        const bf16* Bc = Bs + cur * GEMM_BS + (wn * 64 + c) * LDT + 8 * h;
#pragma unroll
        for (int kk = 0; kk < 2; ++kk) {
            bf16x8 fa[4], fb[4];
#pragma unroll
            for (int i = 0; i < 4; ++i) { fa[i] = *(const bf16x8*)(Ac + i * 16 * LDT + kk * 32); fb[i] = *(const bf16x8*)(Bc + i * 16 * LDT + kk * 32); }
#pragma unroll
            for (int ni = 0; ni < 4; ++ni)
#pragma unroll
                for (int mi = 0; mi < 4; ++mi) acc[ni][mi] = mfma16(fb[ni], fa[mi], acc[ni][mi]);
        }
        if (kt + 1 < nk) {
            const int nx = cur ^ 1;
#pragma unroll
            for (int i = 0; i < 4; ++i) *(bf16x8*)(As + nx * GEMM_AS + (r0 + 64 * i) * LDT + col8) = ra[i];
#pragma unroll
            for (int i = 0; i < 2; ++i) *(bf16x8*)(Bs + nx * GEMM_BS + (r0 + 64 * i) * LDT + col8) = rb[i];
        }
        SYNC();
    }
    epi(acc, wm * 64, wn * 64, h, c);
}

struct ARows { const bf16* base; size_t ld; MDEV const bf16* operator()(int r) const { return base + (size_t)r * ld; } MDEV unsigned off(int r) const { return (unsigned)r * (unsigned)ld; } };

constexpr int LDB = 144;
constexpr int GEMM_BS2 = 64 * LDB;
constexpr int GEMM2_LDS = (2 * GEMM_AS + 2 * GEMM_BS2) * 2;
DEV bf16x8 tr_read8(const bf16* p0, const bf16* p1) {
    const s16x4 x = tr4(p0), y = tr4(p1); bf16x8 r;
    r[0] = x[0]; r[1] = x[1]; r[2] = x[2]; r[3] = x[3]; r[4] = y[0]; r[5] = y[1]; r[6] = y[2]; r[7] = y[3]; return r;
}
DEV int bperm(int r) { return (r & ~12) | ((r & 4) << 1) | ((r & 8) >> 1); }
template <class AF, class BF, class EPI>
DEV void gemm_tile2(unsigned char* smem, AF af, BF bf, int ldb, int K, EPI& epi) {
    const int tid = TID, w = tid >> 6, l = tid & 63, h = l >> 4, c = l & 15, wm = w >> 1, wn = w & 1, grp = w >> 2;
    bf16* As = (bf16*)smem; bf16* Bs = As + 2 * GEMM_AS;
    const bf16* abase = af.base; unsigned ao[4];
    const int col8 = (tid & 7) * 8, r0 = tid >> 3;
#pragma unroll
    for (int i = 0; i < 4; ++i) ao[i] = af.off(r0 + 64 * i) + col8;
    const int bn4 = (tid & 31) * 4, bk = tid >> 5, bkp = bperm(bk);
    const float* bp = bf(bn4); const bool bok = bp != nullptr;
    if (bok) bp += (size_t)bk * ldb;
    const size_t bstep = (size_t)16 * ldb;
    f32x4 acc[4][4];
#pragma unroll
    for (int i = 0; i < 4; ++i)
#pragma unroll
        for (int j = 0; j < 4; ++j) acc[i][j] = f4zero();
    bf16x8 ra[4]; f32x4 rb[4];
    const int nk = K / 64;
#pragma unroll
    for (int i = 0; i < 4; ++i) { ra[i] = *(const bf16x8*)(abase + ao[i]); rb[i] = bok ? *(const f32x4*)(bp + i * bstep) : f4zero(); }
    SYNC();
#pragma unroll
    for (int i = 0; i < 4; ++i) { *(bf16x8*)(As + (r0 + 64 * i) * LDT + col8) = ra[i]; st_bf4(Bs + (bkp + 16 * i) * LDB + bn4, rb[i]); }
    if (nk > 1) {
#pragma unroll
        for (int i = 0; i < 4; ++i) { ra[i] = *(const bf16x8*)(abase + (ao[i] + 64)); rb[i] = bok ? *(const f32x4*)(bp + (size_t)64 * ldb + i * bstep) : f4zero(); } }
    SYNC();
    for (int kt = 0; kt < nk; ++kt) {
        const int cur = kt & 1;
#pragma unroll
        for (int p = 0; p < 2; ++p) {
            if (grp == p) {
                const bf16* Ac = As + cur * GEMM_AS + (wm * 64 + c) * LDT + 8 * h;
                const bf16* Bc = Bs + cur * GEMM_BS2 + bperm(8 * h + (c >> 2)) * LDB + wn * 64 + 4 * (c & 3);
#pragma unroll
                for (int kk = 0; kk < 2; ++kk) {
                    bf16x8 fa[4], fb[4];
#pragma unroll
                    for (int i = 0; i < 4; ++i) { fa[i] = *(const bf16x8*)(Ac + i * 16 * LDT + kk * 32); fb[i] = tr_read8(Bc + (32 * kk) * LDB + 16 * i, Bc + (32 * kk + 8) * LDB + 16 * i); }
#pragma unroll
                    for (int ni = 0; ni < 4; ++ni)
#pragma unroll
                        for (int mi = 0; mi < 4; ++mi) acc[ni][mi] = mfma16(fb[ni], fa[mi], acc[ni][mi]);
                }
            } else if (kt + 1 < nk) {
                const int nx = cur ^ 1;
#pragma unroll
                for (int i = 0; i < 4; ++i) { *(bf16x8*)(As + nx * GEMM_AS + (r0 + 64 * i) * LDT + col8) = ra[i]; st_bf4(Bs + nx * GEMM_BS2 + (bkp + 16 * i) * LDB + bn4, rb[i]); }
                if (kt + 2 < nk) {
#pragma unroll
                    for (int i = 0; i < 4; ++i) { ra[i] = *(const bf16x8*)(abase + (ao[i] + (kt + 2) * 64)); rb[i] = bok ? *(const f32x4*)(bp + (size_t)(kt + 2) * 64 * ldb + i * bstep) : f4zero(); } }
            }
            SYNC();
        }
    }
    epi(acc, wm * 64, wn * 64, h, c);
}
struct BPlain { const float* base; MDEV const float* operator()(int nt) const { return base + nt; } };
struct BInProjMap { const float* base; int n0; MDEV const float* operator()(int nt) const { const int n = n0 + nt; const int sc = n < 1280 ? n : (n < 3328 ? n + 24 : (n < 3352 ? 1280 + (n - 3328) : -1)); return sc < 0 ? nullptr : base + sc; } };
struct BInter { const float* s0; const float* s1; int n0; MDEV const float* operator()(int nt) const { const int n = n0 + nt, g = n >> 6, w = n & 63; return w < 32 ? s0 + g * 32 + w : s1 + g * 32 + w - 32; } };
struct BClamp64 { const float* base; MDEV const float* operator()(int nt) const { return base + (nt & 63); } };

struct EpiInProj {
    const Args* a; int m0, n0, li;
    MDEV void operator()(f32x4 (&acc)[4][4], int mw, int nw, int h, int c) const {
        unsigned char* ws = wsp(*a);
        const int nb = n0 + nw;
        const int tokb = m0 + mw + c;
        if (nb < 512 || (nb >= 768 && nb < 896) || (nb >= 1024 && nb < 1152)) {
            const float* gain; float mul = 1.f; bf16* dst; int kind;
            if (nb < 512) { gain = INP(*a, I_QG) + li * 64; mul = 0.125f * LOG2E; kind = 0; dst = (bf16*)(ws + WS_QN); }
            else if (nb < 896) { gain = INP(*a, I_KG) + (li * 3 + 1) * 64; kind = 1; dst = (bf16*)(ws + WS_KS); }
            else { gain = INP(*a, I_KG) + (li * 3 + 2) * 64; kind = 1; dst = (bf16*)(ws + WS_KW); }
            const int g = (nb >> 6) & 1;
#pragma unroll
            for (int mi = 0; mi < 4; ++mi) {
                float ss = 0.f;
#pragma unroll
                for (int ni = 0; ni < 4; ++ni) { f32x4 v = acc[ni][mi]; ss += v[0] * v[0] + v[1] * v[1] + v[2] * v[2] + v[3] * v[3]; }
                ss += shflx(ss, 16); ss += shflx(ss, 32);
                const float rs = frsq(ss * (1.0f / 64.0f) + EPS) * mul;
                const int tok = tokb + 16 * mi;
#pragma unroll
                for (int ni = 0; ni < 4; ++ni) {
                    const int d = 16 * ni + 4 * h; f32x4 v = acc[ni][mi], o;
#pragma unroll
                    for (int r = 0; r < 4; ++r) o[r] = v[r] * rs * gain[d + r];
                    if (kind == 0) st_bf4(dst + (size_t)tok * 512 + nb + d, o);
                    else { const int b = tok / SEQ, s = tok % SEQ; st_bf4(dst + ((size_t)(b * 2 + g) * SEQ + s) * 64 + d, o); }
                }
            }
        } else if (nb < 768) {
            bf16* dst = (bf16*)(ws + (nb < 640 ? WS_KCG : WS_VCG)); const int g = (nb >> 6) & 1;
#pragma unroll
            for (int mi = 0; mi < 4; ++mi) { const int tok = tokb + 16 * mi, b = tok / SEQ, s = tok % SEQ;
#pragma unroll
                for (int ni = 0; ni < 4; ++ni) st_bf4(dst + ((size_t)(b * 2 + g) * SEQ + s) * 64 + 16 * ni + 4 * h, acc[ni][mi]); }
        } else if (nb < 1280) {
            bf16* dst = (bf16*)(ws + (nb < 1024 ? WS_VST : WS_VWT)); const int g = (nb >> 6) & 1;
#pragma unroll
            for (int mi = 0; mi < 4; ++mi) { const int tok = tokb + 16 * mi, b = tok / SEQ, s = tok % SEQ;
                bf16* p = dst + ((size_t)(b * 2 + g) * NCH + (s >> 6)) * 4096 + (s & 63);
#pragma unroll
                for (int ni = 0; ni < 4; ++ni)
#pragma unroll
                    for (int r = 0; r < 4; ++r) p[(16 * ni + 4 * h + r) * 64] = (bf16)f2bf(acc[ni][mi][r]); }
        } else if (nb < 3328) {
            const int sec = (nb - 1280) >> 9, cc = (nb - 1280) & 511, hh = cc >> 7, d0 = cc & 127;
#pragma unroll
            for (int mi = 0; mi < 4; ++mi) { const int tok = tokb + 16 * mi, b = tok / SEQ, s = tok % SEQ;
                const size_t hrow = ((size_t)(b * 4 + hh) * SEQ + s) * 128 + d0;
#pragma unroll
                for (int ni = 0; ni < 4; ++ni) { const int d = 16 * ni + 4 * h; f32x4 v = acc[ni][mi], o;
                    if (sec == 0) { for (int r = 0; r < 4; ++r) o[r] = siluf(v[r]); st_bf4((bf16*)(ws + WS_HQ) + hrow + d, o); }
                    else if (sec == 1) { const float* lb = (const float*)(ws + WS_LB) + li * 512 + cc + d;
                        for (int r = 0; r < 4; ++r) o[r] = lb[r] + (1.0f - lb[r]) * sigm(v[r]);
                        *(f32x4*)((float*)(ws + WS_HF) + hrow + d) = o; }
                    else if (sec == 2) st_bf4((bf16*)(ws + WS_HV) + hrow + d, v);
                    else { for (int r = 0; r < 4; ++r) o[r] = siluf(v[r]); st_bf4((bf16*)(ws + WS_HGS) + (size_t)tok * 512 + cc + d, o); }
                } }
        } else if (nb == 3328) {
            float* dst = (float*)(ws + WS_GATE);
#pragma unroll
            for (int mi = 0; mi < 4; ++mi) { const int tok = tokb + 16 * mi;
#pragma unroll
                for (int ni = 0; ni < 2; ++ni)
#pragma unroll
                    for (int r = 0; r < 4; ++r) { const int n = 16 * ni + 4 * h + r; if (n < 24) dst[(size_t)tok * 24 + n] = sigm(acc[ni][mi][r]); } }
        }
    }
};

struct EpiResid {
    float* x; const float* gate; int m0, n0;
    MDEV void operator()(f32x4 (&acc)[4][4], int mw, int nw, int h, int c) const {
#pragma unroll
        for (int mi = 0; mi < 4; ++mi) { const int tok = m0 + mw + 16 * mi + c, b = tok / SEQ;
#pragma unroll
            for (int ni = 0; ni < 4; ++ni) { const int n = n0 + nw + 16 * ni + 4 * h;
                f32x4 g = *(const f32x4*)(gate + (size_t)b * 6 * DM + n); f32x4* p = (f32x4*)(x + (size_t)tok * DM + n); f32x4 v = *p;
#pragma unroll
                for (int r = 0; r < 4; ++r) v[r] += g[r] * acc[ni][mi][r];
                *p = v; } }
    }
};
template <int MODE> struct EpiGated {
    bf16* dst; size_t ld; int m0, n0, mvalid;
    MDEV void operator()(f32x4 (&acc)[4][4], int mw, int nw, int h, int c) const {
        const int cb = (n0 + nw) / 2;
#pragma unroll
        for (int mi = 0; mi < 4; ++mi) { const int m = mw + 16 * mi + c; if (m >= mvalid) continue;
#pragma unroll
            for (int ni = 0; ni < 2; ++ni) { f32x4 o;
#pragma unroll
                for (int r = 0; r < 4; ++r) { const float av = acc[ni][mi][r], bv = acc[ni + 2][mi][r]; o[r] = MODE == 0 ? av * sigm(bv) : siluf(av) * bv; }
                st_bf4(dst + (size_t)(m0 + m) * ld + cb + 16 * ni + 4 * h, o); } }
    }
};
struct EpiStoreBf {
    bf16* dst; size_t ld; int m0, n0, mvalid;
    MDEV void operator()(f32x4 (&acc)[4][4], int mw, int nw, int h, int c) const {
#pragma unroll
        for (int mi = 0; mi < 4; ++mi) { const int m = mw + 16 * mi + c; if (m >= mvalid) continue;
#pragma unroll
            for (int ni = 0; ni < 4; ++ni) st_bf4(dst + (size_t)(m0 + m) * ld + n0 + nw + 16 * ni + 4 * h, acc[ni][mi]); }
    }
};
struct EpiCmp {
    const Args* a; int kv, bg, m0, li;
    MDEV void operator()(f32x4 (&acc)[4][4], int mw, int nw, int h, int c) const {
        if (nw != 0) return;
        unsigned char* ws = wsp(*a);
        const float* bp8 = (const float*)(ws + WS_CB) + (li * 2 + kv) * 8 * 64;
        float bias[16];
#pragma unroll
        for (int q = 0; q < 16; ++q) { const int e = 16 * (q >> 2) + 4 * h + (q & 3); float v = 0.f;
#pragma unroll
            for (int kp = 0; kp < 8; ++kp) v += bp8[kp * 64 + e];
            bias[q] = v; }
        const float* gain = INP(*a, I_KG) + (li * 3 + 0) * 64;
#pragma unroll
        for (int mi = 0; mi < 4; ++mi) { const int n = m0 + mw + 16 * mi + c; const bool ok = n < NCMP;
            f32x4 v[4]; float ss = 0.f;
#pragma unroll
            for (int ni = 0; ni < 4; ++ni) { v[ni] = acc[ni][mi];
#pragma unroll
                for (int r = 0; r < 4; ++r) { v[ni][r] += bias[4 * ni + r]; ss += v[ni][r] * v[ni][r]; } }
            ss += shflx(ss, 16); ss += shflx(ss, 32);
            if (n >= NCP) continue;
            if (kv == 0) { const float rs = frsq(ss * (1.0f / 64.0f) + EPS); bf16* p = (bf16*)(ws + WS_KC) + ((size_t)bg * NCP + n) * 64;
#pragma unroll
                for (int ni = 0; ni < 4; ++ni) { f32x4 o;
#pragma unroll
                    for (int r = 0; r < 4; ++r) o[r] = ok ? v[ni][r] * rs * gain[16 * ni + 4 * h + r] : 0.f;
                    st_bf4(p + 16 * ni + 4 * h, o); }
            } else { bf16* p = (bf16*)(ws + WS_VCT) + ((size_t)bg * NCP + n) * 64;
#pragma unroll
                for (int ni = 0; ni < 4; ++ni) { f32x4 o;
#pragma unroll
                    for (int r = 0; r < 4; ++r) o[r] = ok ? v[ni][r] : 0.f;
                    st_bf4(p + 16 * ni + 4 * h, o); } }
        }
    }
};


struct EpiResid8 {
    static constexpr bool PERM = true, AFTER_DRAIN = false;
    float* x; const float* gate; const float* xin;
    MDEV void operator()(const f32x4 (&acc)[2][2][4][2], const pg8::Unit& u, int wr, int wc, int fr, int fq) const {
        OPAQUE2(fr, fq);
#pragma unroll
        for (int ai = 0; ai < 2; ++ai)
#pragma unroll
            for (int m = 0; m < 4; ++m) { const int row = 256 * u.pm + 128 * ai + 64 * wr + 16 * m + fr, b = row / SEQ;
#pragma unroll
                for (int bj = 0; bj < 2; ++bj)
#pragma unroll
                    for (int n = 0; n < 2; ++n) { const int col = 256 * u.pn + 128 * bj + 32 * wc + 8 * fq + 4 * n;
                        const f32x4 g = *(const f32x4*)(gate + (size_t)b * 6 * DM + col); f32x4* p = (f32x4*)(x + (size_t)row * DM + col); f32x4 v = *(const f32x4*)(xin + (size_t)row * DM + col);
#pragma unroll
                        for (int r = 0; r < 4; ++r) v[r] += g[r] * acc[ai][bj][m][n][r];
                        *p = v; } }
    }
};
struct EpiGlu8 {
    static constexpr bool PERM = true, AFTER_DRAIN = false;
    bf16* dst;
    MDEV void operator()(const f32x4 (&acc)[2][2][4][2], const pg8::Unit& u, int wr, int wc, int fr, int fq) const {
        OPAQUE2(fr, fq);
#pragma unroll
        for (int ai = 0; ai < 2; ++ai)
#pragma unroll
            for (int m = 0; m < 4; ++m) { const int row = 256 * u.pm + 128 * ai + 64 * wr + 16 * m + fr;
#pragma unroll
                for (int bj = 0; bj < 2; ++bj) { const int col = 128 * u.pn + 64 * bj + 16 * wc + 4 * fq; f32x4 o;
#pragma unroll
                    for (int r = 0; r < 4; ++r) o[r] = acc[ai][bj][m][0][r] * sigm(acc[ai][bj][m][1][r]);
                    st_bf4(dst + (size_t)row * DM + col, o); } }
    }
};
struct EpiMoe1_8 {
    static constexpr bool PERM = true, AFTER_DRAIN = false;
    bf16* dst;
    MDEV void operator()(const f32x4 (&acc)[2][2][4][2], const pg8::Unit& u, int wr, int wc, int fr, int fq) const {
        OPAQUE2(fr, fq);
#pragma unroll
        for (int ai = 0; ai < 2; ++ai)
#pragma unroll
            for (int m = 0; m < 4; ++m) { const int row = 256 * u.pm + 128 * ai + 64 * wr + 16 * m + fr;
#pragma unroll
                for (int bj = 0; bj < 2; ++bj) { const int col = 128 * u.pn + 64 * bj + 16 * wc + 4 * fq; f32x4 o;
#pragma unroll
                    for (int r = 0; r < 4; ++r) o[r] = siluf(acc[ai][bj][m][0][r]) * acc[ai][bj][m][1][r];
#ifdef EMU
                    st_bf4(dst + (size_t)row * FF + col, o); } }
#else
                    const unsigned long long pk = (unsigned long long)pk2(o[0], o[1]) | ((unsigned long long)pk2(o[2], o[3]) << 32);
                    __hip_atomic_store((__attribute__((address_space(1))) unsigned long long*)(dst + (size_t)row * FF + col), pk, __ATOMIC_RELAXED, __HIP_MEMORY_SCOPE_AGENT); } }
#endif
    }
};
struct EpiMoe2_8 {
    static constexpr bool PERM = true, AFTER_DRAIN = false;
    bf16* dst;
    MDEV void operator()(const f32x4 (&acc)[2][2][4][2], const pg8::Unit& u, int wr, int wc, int fr, int fq) const {
        OPAQUE2(fr, fq);
#pragma unroll
        for (int ai = 0; ai < 2; ++ai)
#pragma unroll
            for (int m = 0; m < 4; ++m) { const int row = 256 * u.pm + 128 * ai + 64 * wr + 16 * m + fr;
#pragma unroll
                for (int bj = 0; bj < 2; ++bj) { const int col = 256 * u.pn + 128 * bj + 32 * wc + 8 * fq;
                    st_bf8(dst + (size_t)row * DM + col, acc[ai][bj][m][0], acc[ai][bj][m][1]); } }
    }
};
DEV unsigned uni(unsigned x);
template <bool G> struct MoeSel {
    static constexpr bool GATHER = G;
    const int* rb; const int* cnt; const int* list; size_t bstride;
    struct Ctx { int e, rbase, c; };
    MDEV Ctx ctx(const pg8::Unit& u) const { int e = 0;
#pragma unroll 1
        for (int q = 1; q < 32; ++q) if ((rb[q] >> 8) <= u.pm) e = q;
        e = (int)uni((unsigned)e); Ctx x; x.e = e; x.rbase = (int)uni((unsigned)((u.pm << 8) - rb[e])); x.c = G ? (int)uni((unsigned)cnt[e * 64]) : 0; return x; }
    MDEV size_t boff(const Ctx& x) const { return (size_t)x.e * bstride; }
    MDEV unsigned aoff(const Ctx& x, int r) const { int p = x.rbase + r; if (p > x.c - 1) p = x.c - 1; return (unsigned)list[(size_t)x.e * T + p] * (unsigned)(DM * 2); }
};
struct EpiInProj8 {
    static constexpr bool PERM = true, AFTER_DRAIN = false;
    const Args* a; int li;
    MDEV void operator()(const f32x4 (&acc)[2][2][4][2], const pg8::Unit& u, int wr, int wc, int fr, int fq) const {
        OPAQUE2(fr, fq);
        unsigned char* ws = wsp(*a);
        const int nb = 256 * u.pn + 64 * wc;
        if (nb >= 3392) return;
        if (nb < 512 || (nb >= 768 && nb < 896) || (nb >= 1024 && nb < 1152)) {
            const float* gain; float mul = 1.f; int kind;
            if (nb < 512) { gain = INP(*a, I_QG) + li * 64; mul = 0.125f * LOG2E; kind = 0; }
            else if (nb < 896) { gain = INP(*a, I_KG) + (li * 3 + 1) * 64; kind = 1; }
            else { gain = INP(*a, I_KG) + (li * 3 + 2) * 64; kind = 2; }
            const int g = (nb >> 6) & 1;
            f32x4 gv[2][2];
#pragma unroll
            for (int bj = 0; bj < 2; ++bj)
#pragma unroll
                for (int n = 0; n < 2; ++n) gv[bj][n] = *(const f32x4*)(gain + 32 * bj + 8 * fq + 4 * n);
#pragma unroll
            for (int ai = 0; ai < 2; ++ai)
#pragma unroll
                for (int m = 0; m < 4; ++m) { const int tok = 256 * u.pm + 128 * ai + 64 * wr + 16 * m + fr;
                    float ss = 0.f;
#pragma unroll
                    for (int bj = 0; bj < 2; ++bj)
#pragma unroll
                        for (int n = 0; n < 2; ++n) { const f32x4 v = acc[ai][bj][m][n]; ss += v[0] * v[0] + v[1] * v[1] + v[2] * v[2] + v[3] * v[3]; }
                    ss += shflx(ss, 16); ss += shflx(ss, 32);
                    const float rs = frsq(ss * (1.0f / 64.0f) + EPS) * mul;
                    bf16* dst; if (kind == 0) dst = (bf16*)(ws + WS_QN) + (size_t)tok * 512 + nb; else { const int b = tok / SEQ, sq = tok % SEQ; dst = (bf16*)(ws + (kind == 1 ? WS_KS : WS_KW)) + ((size_t)(b * 2 + g) * SEQ + sq) * 64; }
#pragma unroll
                    for (int bj = 0; bj < 2; ++bj) { f32x4 o0, o1;
#pragma unroll
                        for (int r = 0; r < 4; ++r) { o0[r] = acc[ai][bj][m][0][r] * rs * gv[bj][0][r]; o1[r] = acc[ai][bj][m][1][r] * rs * gv[bj][1][r]; }
                        st_bf8(dst + 32 * bj + 8 * fq, o0, o1); } }
        } else if (nb < 768) {
            bf16* base = (bf16*)(ws + (nb < 640 ? WS_KCG : WS_VCG)); const int g = (nb >> 6) & 1;
#pragma unroll
            for (int ai = 0; ai < 2; ++ai)
#pragma unroll
                for (int m = 0; m < 4; ++m) { const int tok = 256 * u.pm + 128 * ai + 64 * wr + 16 * m + fr, b = tok / SEQ, sq = tok % SEQ;
#pragma unroll
                    for (int bj = 0; bj < 2; ++bj) st_bf8(base + ((size_t)(b * 2 + g) * SEQ + sq) * 64 + 32 * bj + 8 * fq, acc[ai][bj][m][0], acc[ai][bj][m][1]); }
        } else if (nb < 1280) {
            bf16* base = (bf16*)(ws + (nb < 1024 ? WS_VST : WS_VWT)); const int g = (nb >> 6) & 1;
#pragma unroll
            for (int ai = 0; ai < 2; ++ai)
#pragma unroll
                for (int m = 0; m < 4; ++m) { const int tok = 256 * u.pm + 128 * ai + 64 * wr + 16 * m + fr, b = tok / SEQ, sq = tok % SEQ;
#pragma unroll
                    for (int bj = 0; bj < 2; ++bj) st_bf8(base + ((size_t)(b * 2 + g) * SEQ + sq) * 64 + 32 * bj + 8 * fq, acc[ai][bj][m][0], acc[ai][bj][m][1]); }
        } else if (nb < 3328) {
            const int sec = (nb - 1280) >> 9, cc = (nb - 1280) & 511, hh = cc >> 7, d0 = cc & 127;
            f32x4 lbv[2][2];
            if (sec == 1) {
#pragma unroll
                for (int bj = 0; bj < 2; ++bj)
#pragma unroll
                    for (int n = 0; n < 2; ++n) lbv[bj][n] = *(const f32x4*)((const float*)(ws + WS_LB) + li * 512 + cc + 32 * bj + 8 * fq + 4 * n); }
#pragma unroll
            for (int ai = 0; ai < 2; ++ai)
#pragma unroll
                for (int m = 0; m < 4; ++m) { const int tok = 256 * u.pm + 128 * ai + 64 * wr + 16 * m + fr, b = tok / SEQ, sq = tok % SEQ;
                    const size_t hrow = ((size_t)(b * 4 + hh) * SEQ + sq) * 128 + d0;
#pragma unroll
                    for (int bj = 0; bj < 2; ++bj) { const int d = 32 * bj + 8 * fq; f32x4 o0, o1;
                        if (sec == 0) {
#pragma unroll
                            for (int r = 0; r < 4; ++r) { o0[r] = siluf(acc[ai][bj][m][0][r]); o1[r] = siluf(acc[ai][bj][m][1][r]); }
                            st_bf8((bf16*)(ws + WS_HQ) + hrow + d, o0, o1); }
                        else if (sec == 1) {
#pragma unroll
                            for (int r = 0; r < 4; ++r) { o0[r] = lbv[bj][0][r] + (1.0f - lbv[bj][0][r]) * sigm(acc[ai][bj][m][0][r]); o1[r] = lbv[bj][1][r] + (1.0f - lbv[bj][1][r]) * sigm(acc[ai][bj][m][1][r]); }
                            float* pf = (float*)(ws + WS_HF) + hrow + d; *(f32x4*)pf = o0; *(f32x4*)(pf + 4) = o1; }
                        else if (sec == 2) st_bf8((bf16*)(ws + WS_HV) + hrow + d, acc[ai][bj][m][0], acc[ai][bj][m][1]);
                        else {
#pragma unroll
                            for (int r = 0; r < 4; ++r) { o0[r] = siluf(acc[ai][bj][m][0][r]); o1[r] = siluf(acc[ai][bj][m][1][r]); }
                            st_bf8((bf16*)(ws + WS_HGS) + (size_t)tok * 512 + cc + d, o0, o1); } } }
        } else {
            float* dst = (float*)(ws + WS_GATE);
            if (fq < 3) {
#pragma unroll
                for (int ai = 0; ai < 2; ++ai)
#pragma unroll
                    for (int m = 0; m < 4; ++m) { const int tok = 256 * u.pm + 128 * ai + 64 * wr + 16 * m + fr; f32x4 o0, o1;
#pragma unroll
                        for (int r = 0; r < 4; ++r) { o0[r] = sigm(acc[ai][0][m][0][r]); o1[r] = sigm(acc[ai][0][m][1][r]); }
                        float* pf = dst + (size_t)tok * 24 + 8 * fq; *(f32x4*)pf = o0; *(f32x4*)(pf + 4) = o1; } }
        }
    }
};

DEV void tr_tile(unsigned char* smem, const float* src0, const float* src1, int ld, int K, int mode, bf16* dst, int n0, int k0) {
    bf16* tl = (bf16*)smem;
    const int tid = TID;
    SYNC();
#pragma unroll
    for (int i = 0; i < 8; ++i) {
        const int e = tid + 512 * i, kk = e >> 6, nn = e & 63, n = n0 + nn; float v = 0.f;
        if (mode == 0) v = src0[(size_t)(k0 + kk) * ld + n];
        else if (mode == 1) { int sc = n < 1280 ? n : (n < 3328 ? n + 24 : (n < 3352 ? 1280 + (n - 3328) : -1)); if (sc >= 0) v = src0[(size_t)(k0 + kk) * ld + sc]; }
        else { const int g = n >> 6, w = n & 63; v = (w < 32) ? src0[(size_t)(k0 + kk) * ld + g * 32 + w] : src1[(size_t)(k0 + kk) * ld + g * 32 + w - 32]; }
        tl[nn * LDT + kk] = (bf16)f2bf(v);
    }
    SYNC();
    const int nn = tid >> 3, k8 = (tid & 7) * 8;
    *(bf16x8*)(dst + (size_t)(n0 + nn) * K + k0 + k8) = *(const bf16x8*)(tl + nn * LDT + k8);
}

DEV int tr_col(int mode, int n) {
    if (mode == 0) return n;
    const int pn = n >> 8, ct = n & 255;
    if (mode == 5) { const int bj = ct >> 7, wc = (ct >> 5) & 3, j = ct & 31, L = 256 * pn + 64 * wc + 32 * bj + j; return L < 1280 ? L : (L < 3328 ? L + 24 : (L < 3352 ? 1280 + (L - 3328) : -1)); }
    { const int bj = ct >> 7, wc = (ct >> 5) & 3, j = ct & 31, nn = (j >> 2) & 1, Lc = 128 * pn + 64 * bj + 16 * wc + 4 * (j >> 3) + (j & 3); return nn == 0 ? Lc : (mode == 7 ? FF : DM) + Lc; }
}
DEV void tr_tile(unsigned char* smem, const float* src, int ld, int K, int mode, bf16* dst, int n0, int k0) {
    bf16* tl = (bf16*)smem;
    const int tid = TID, nq = tid & 31, kq = tid >> 5;
    const int sc = tr_col(mode, n0 + 4 * nq);
    f32x4 v[4];
#pragma unroll
    for (int i = 0; i < 4; ++i) v[i] = sc >= 0 ? *(const f32x4*)(src + (size_t)(k0 + 4 * kq + i) * ld + sc) : f4zero();
    SYNC();
#pragma unroll
    for (int j = 0; j < 4; ++j) { u32x2 w; w[0] = pk2(v[0][j], v[1][j]); w[1] = pk2(v[2][j], v[3][j]); *(u32x2*)(tl + (4 * nq + j) * LDT + 4 * kq) = w; }
    SYNC();
#pragma unroll
    for (int t = 0; t < 2; ++t) { const int id = tid + 512 * t, row = id >> 3, ch = id & 7;
        *(bf16x8*)(dst + (size_t)(n0 + row) * K + k0 + 8 * ch) = *(const bf16x8*)(tl + row * LDT + 8 * ch); }
}
constexpr int KSUP = FF >= 256 ? 256 : FF, NSUP = KSUP / 64;
DEV void tr_super(unsigned char* smem, const float* src0, const float* src1, int ld, int K, int mode, bf16* dst, int n0, int k0) {
    const int tid = TID, nq = tid & 31, kq = tid >> 5;
    int sc = n0 + 4 * nq; const float* src = src0;
    if (mode == 7) { const int cc = tr_col(7, sc); src = cc >= FF ? src1 : src0; sc = cc >= FF ? cc - FF : cc; }
    f32x4 v[NSUP][4];
#pragma unroll
    for (int sb = 0; sb < NSUP; ++sb)
#pragma unroll
        for (int i = 0; i < 4; ++i) v[sb][i] = *(const f32x4*)(src + (size_t)(k0 + 64 * sb + 4 * kq + i) * ld + sc);
    SYNC();
    const int fw = nq & (KSUP / 16 - 1);
#pragma unroll
    for (int j = 0; j < 4; ++j)
#pragma unroll
        for (int sb = 0; sb < NSUP; ++sb) { const int c16 = 8 * sb + (kq >> 1); u32x2 w; w[0] = pk2(v[sb][0][j], v[sb][1][j]); w[1] = pk2(v[sb][2][j], v[sb][3][j]);
            *(u32x2*)(smem + (4 * nq + j) * (KSUP * 2) + ((c16 ^ fw) << 4) + (kq & 1) * 8) = w; }
    SYNC();
#pragma unroll
    for (int t = 0; t < 128 * (KSUP / 8) / NT; ++t) { const int id = tid + NT * t, row = id / (KSUP / 8), ch = id % (KSUP / 8), f = (row >> 2) & (KSUP / 16 - 1);
        *(bf16x8*)(dst + (size_t)(n0 + row) * K + k0 + 8 * (ch ^ f)) = *(const bf16x8*)(smem + row * (KSUP * 2) + ch * 16); }
}
struct TrJob { const float* s; int ld, K, N, mode; bf16* dst; };
DEV void p0_phase(const Args& a, unsigned char* smem) {
    unsigned char* ws = wsp(a); const int tid = TID;
    { int item = BID, base = 0;
      for (int j = 0; j < 8; ++j) { TrJob J; const int i = j & 1;
        if (j < 2) J = {INP(a, I_WIN) + (size_t)i * DM * NIN, NIN, DM, NIN8, 5, (bf16*)(ws + WS_WIN) + (size_t)i * NIN8 * DM};
        else if (j < 4) J = {INP(a, I_WOUT) + (size_t)i * 1024 * DM, DM, 1024, DM, 0, (bf16*)(ws + WS_WOUT) + (size_t)i * DM * 1024};
        else if (j < 6) J = {INP(a, I_PW1) + (size_t)i * DM * 2 * DM, 2 * DM, DM, 2 * DM, 6, (bf16*)(ws + WS_PW1) + (size_t)i * 2 * DM * DM};
        else J = {INP(a, I_PW2) + (size_t)i * DM * DM, DM, DM, DM, 0, (bf16*)(ws + WS_PW2) + (size_t)i * DM * DM};
        const int tn = J.N / 128, tk = J.K / 64, nt = tn * tk;
        while (item < base + nt) { const int it = item - base; tr_tile(smem, J.s, J.ld, J.K, J.mode, J.dst, (it % tn) * 128, (it / tn) * 64); item += NBLK; }
        base += nt; }
      SYNC(); }
    {
        float* red = (float*)smem;
        constexpr int NG = 6 * DM / 128; const int ntask = DEPTH * NG;
        for (int t = BID; t < ntask; t += NBLK) {
            const int l = t / NG, j0 = (t % NG) * 128, cq = tid & 31, kr = tid >> 5;
            const float* w = INP(a, I_ADAW) + (size_t)l * DM * 6 * DM + j0 + 4 * cq; const float* cc = INP(a, I_C);
            f32x4 a0 = f4zero(), a1 = f4zero();
#pragma unroll 8
            for (int i = 0; i < DM / 16; ++i) { const int k = kr + 16 * i; const f32x4 wv = *(const f32x4*)(w + (size_t)k * 6 * DM); const float s0 = siluf(cc[k]), s1 = siluf(cc[DM + k]);
#pragma unroll
                for (int r = 0; r < 4; ++r) { a0[r] += s0 * wv[r]; a1[r] += s1 * wv[r]; } }
            SYNC();
            *(f32x4*)(red + (kr * 2 + 0) * 128 + 4 * cq) = a0; *(f32x4*)(red + (kr * 2 + 1) * 128 + 4 * cq) = a1;
            SYNC();
            if (tid < 256) { const int b = tid >> 7, col = tid & 127; float sum = INP(a, I_ADAB)[(size_t)l * 6 * DM + j0 + col];
#pragma unroll
                for (int q = 0; q < 16; ++q) sum += red[(q * 2 + b) * 128 + col];
                ((float*)(ws + WS_MOD))[((size_t)l * 2 + b) * 6 * DM + j0 + col] = sum; }
        }
    }
    for (int t = BID; t < 32; t += NBLK) {
        float* red = (float*)smem; const int ikv = t >> 3, kp = t & 7, i = ikv >> 1, kv = ikv & 1, e = tid & 63, ks = tid >> 6;
        const float* W = INP(a, kv ? I_CWV : I_CWK) + (size_t)i * 2048 * 64 + e; const float* pe = INP(a, I_CPE) + (size_t)i * 2048;
        float sum = 0.f;
#pragma unroll 8
        for (int q = 0; q < 32; ++q) { const int k = kp * 256 + ks * 32 + q; sum += pe[k] * W[(size_t)k * 64]; }
        SYNC(); red[ks * 64 + e] = sum; SYNC();
        if (tid < 64) { float v = 0.f; for (int q = 0; q < 8; ++q) v += red[q * 64 + tid]; ((float*)(ws + WS_CB))[(ikv * 8 + kp) * 64 + tid] = v; }
    }
    for (int i = BID * NT + tid; i < DEPTH * 48 * DM; i += NBLK * NT) { const int k = i % DM, n = (i / DM) % 48, ll = i / (48 * DM);
        const float wv = n < 4 ? INP(a, I_WG)[((size_t)ll * DM + k) * 4 + n] : (n < 36 ? INP(a, I_WE)[((size_t)ll * DM + k) * 32 + n - 4] : 0.f);
        const unsigned hi = f2bf(wv); ((bf16*)(ws + WS_WTH))[i] = (bf16)hi; ((bf16*)(ws + WS_WTL))[i] = (bf16)f2bf(wv - bf2f(hi)); }
    if (BID == 0) {
        for (int i = tid; i < DEPTH * 32; i += NT) ((int*)(ws + WS_CNT))[i * 64] = 0;
        for (int i = tid; i < DEPTH * 256; i += NT) ((unsigned*)(ws + WS_FLG))[i * 16] = 0u;
        for (int n = tid; n < 512; n += NT) { const float l0 = INP(a, I_LBL)[n], l1 = INP(a, I_LBL)[512 + n]; const float m = fmaxf(l0, l1);
            const float e0 = fexp2((l0 - m) * LOG2E), e1 = fexp2((l1 - m) * LOG2E);
            ((float*)(ws + WS_LB))[n] = 0.f; ((float*)(ws + WS_LB))[512 + n] = e1 / (e0 + e1); }
        if (tid < 2) { const int i = tid; float mq = 0.f; for (int d = 0; d < 64; ++d) mq = fmaxf(mq, fabsf(INP(a, I_QG)[i * 64 + d]));
            for (int br = 0; br < 3; ++br) { float mk = 0.f; for (int d = 0; d < 64; ++d) mk = fmaxf(mk, fabsf(INP(a, I_KG)[(i * 3 + br) * 64 + d]));
                ((float*)(ws + WS_CS))[i * 4 + br] = 8.0f * mq * mk * LOG2E; } }
    }
    SYNC();
    { constexpr int S13 = (2 * FF / 128) * (DM / KSUP), S2 = (DM / 128) * (FF / KSUP), SPE = S13 + S2, NIT = DEPTH * 32 * SPE;
#ifdef EMU
      for (int it = BID; it < NIT; it += NBLK) {
#else
      int* ctr = (int*)(ws + WS_BAR) + P0_CTR_IDX; int* nxl = (int*)(smem + 72 * 1024);
      int my_next = 0; if (tid == 0) my_next = atomic_add_i(ctr, 1);
      for (;;) { if (tid == 0) nxl[0] = my_next; SYNC(); const int it = nxl[0]; if (it >= NIT) break; if (tid == 0) my_next = atomic_add_i(ctr, 1);
#endif
        const int le = it / SPE, r = it % SPE;
        if (r < S13) { const int tn = r % (2 * FF / 128), tk = r / (2 * FF / 128);
            tr_super(smem, INP(a, I_W1) + (size_t)le * DM * FF, INP(a, I_W3) + (size_t)le * DM * FF, FF, DM, 7, (bf16*)(ws + WS_W13) + (size_t)le * 2 * FF * DM, tn * 128, tk * KSUP); }
        else { const int r2 = r - S13, tn = r2 % (DM / 128), tk = r2 / (DM / 128);
            tr_super(smem, INP(a, I_W2) + (size_t)le * FF * DM, INP(a, I_W2), DM, FF, 0, (bf16*)(ws + WS_W2) + (size_t)le * DM * FF, tn * 128, tk * KSUP); } }
      SYNC(); }
}

constexpr int NJV = DM / 256;
DEV void moe_bases(const int* cnt, int* rb  ) {
    if (TID == 0) { int acc = 0; for (int e = 0; e < 32; ++e) { rb[e] = acc; acc += ((cnt[e * 64] + 255) >> 8) << 8; } rb[32] = acc; }
    SYNC();
}
DEV void norm_phase(const Args& a, unsigned char* smem, int l) {
    unsigned char* ws = wsp(a); const int tid = TID, w = tid >> 6, lane = tid & 63;
    int* rb = (int*)smem;
    if (l > 0) moe_bases((const int*)(ws + WS_CNT) + (l - 1) * 32 * 64, rb);
    const float* mod = (const float*)(ws + WS_MOD);
    const bf16* yk = (const bf16*)(ws + WS_YK);
    if (l < DEPTH) {
        const int bid = BID % 76 == BID ? BID : -1;
        for (int job = BID; job < 76; job += NBLK) {
            if (job < 72) { const int b = job / 36, n = job % 36; float sum = 0.f;
                for (int k = tid; k < DM; k += NT) { const float wv = n < 4 ? INP(a, I_WG)[((size_t)l * DM + k) * 4 + n] : INP(a, I_WE)[((size_t)l * DM + k) * 32 + n - 4]; sum += mod[((size_t)l * 2 + b) * 6 * DM + 3 * DM + k] * wv; }
#pragma unroll
                for (int q = 1; q < 64; q <<= 1) sum += shflx(sum, q);
                float* red = (float*)(smem + 1024);
                SYNC(); if (lane == 0) red[w] = sum; SYNC();
                if (tid == 0) { float t = 0.f; for (int q = 0; q < 8; ++q) t += red[q]; ((float*)(ws + WS_RBIAS))[((size_t)l * 2 + b) * 48 + n] = t; }
            } else { const float* nf = INP(a, I_NFFN) + (size_t)l * DM; const int part = job - 72;
                for (int i = part * (2 * DM / 4) + tid; i < (part + 1) * (2 * DM / 4); i += NT) { const int b = i / DM, k = i % DM; ((float*)(ws + WS_AVEC))[((size_t)l * 2 + b) * DM + k] = nf[k] * (1.0f + mod[((size_t)l * 2 + b) * 6 * DM + 4 * DM + k]); } }
        }
        (void)bid;
    }
    const int rstride = NBLK * 8;
    for (int rowa = BID * 8 + w; rowa < T; rowa += 2 * rstride) {
        int row[2]; bool ok[2];
        row[0] = rowa; ok[0] = true; row[1] = rowa + rstride; ok[1] = row[1] < T; if (!ok[1]) row[1] = rowa;
        f32x4 v[2][NJV]; int e0[2], p0[2], e1[2], p1[2]; float w0[2], w1[2];
        const float* xin = (l == 0) ? INP(a, I_X) : outp(a);
#pragma unroll
        for (int q = 0; q < 2; ++q) {
#pragma unroll
            for (int j = 0; j < NJV; ++j) v[q][j] = *(const f32x4*)(xin + (size_t)row[q] * DM + 4 * lane + 256 * j);
            if (l > 0) { const int* tie = (const int*)(ws + WS_TIE) + (size_t)row[q] * 2; const float* tiw = (const float*)(ws + WS_TIW) + (size_t)row[q] * 2;
                e0[q] = tie[0] >> 14; p0[q] = tie[0] & 16383; e1[q] = tie[1] >> 14; p1[q] = tie[1] & 16383; w0[q] = tiw[0]; w1[q] = tiw[1]; } }
        if (l > 0) {
            u32x2 q0[2][NJV], q1[2][NJV];
#pragma unroll
            for (int q = 0; q < 2; ++q) { const bf16* y0 = yk + (size_t)(rb[e0[q]] + p0[q]) * DM; const bf16* y1 = yk + (size_t)(rb[e1[q]] + p1[q]) * DM;
#pragma unroll
                for (int j = 0; j < NJV; ++j) { const int cidx = 4 * lane + 256 * j; q0[q][j] = *(const u32x2*)(y0 + cidx); q1[q][j] = *(const u32x2*)(y1 + cidx); } }
#pragma unroll
            for (int q = 0; q < 2; ++q) { const int b = row[q] / SEQ; const float* gf = mod + ((size_t)(l - 1) * 2 + b) * 6 * DM + 5 * DM;
#pragma unroll
                for (int j = 0; j < NJV; ++j) { const int cidx = 4 * lane + 256 * j; const f32x4 g = *(const f32x4*)(gf + cidx);
                    v[q][j][0] += g[0] * (w0[q] * bf2f(q0[q][j][0] & 0xffff) + w1[q] * bf2f(q1[q][j][0] & 0xffff));
                    v[q][j][1] += g[1] * (w0[q] * bf2f(q0[q][j][0] >> 16) + w1[q] * bf2f(q1[q][j][0] >> 16));
                    v[q][j][2] += g[2] * (w0[q] * bf2f(q0[q][j][1] & 0xffff) + w1[q] * bf2f(q1[q][j][1] & 0xffff));
                    v[q][j][3] += g[3] * (w0[q] * bf2f(q0[q][j][1] >> 16) + w1[q] * bf2f(q1[q][j][1] >> 16)); } }
        }
        if (l > 0)
#pragma unroll
        for (int q = 0; q < 2; ++q) { if (!ok[q]) continue;
#pragma unroll
            for (int j = 0; j < NJV; ++j) *(f32x4*)(outp(a) + (size_t)row[q] * DM + 4 * lane + 256 * j) = v[q][j]; }
        if (l == DEPTH) continue;
        float ss[2];
#pragma unroll
        for (int q = 0; q < 2; ++q) { ss[q] = 0.f;
#pragma unroll
            for (int j = 0; j < NJV; ++j) ss[q] += v[q][j][0] * v[q][j][0] + v[q][j][1] * v[q][j][1] + v[q][j][2] * v[q][j][2] + v[q][j][3] * v[q][j][3]; }
#pragma unroll
        for (int o = 1; o < 64; o <<= 1) { ss[0] += shflx(ss[0], o); ss[1] += shflx(ss[1], o); }
        const float* nm = INP(a, I_NMIX) + (size_t)l * DM;
#pragma unroll
        for (int q = 0; q < 2; ++q) { if (!ok[q]) continue;
            const int b = row[q] / SEQ; const float rs = frsq(ss[q] * (1.0f / DM) + EPS);
            const float* mm = mod + ((size_t)l * 2 + b) * 6 * DM; bf16* hb = (bf16*)(ws + WS_H) + (size_t)row[q] * DM;
#pragma unroll
            for (int j = 0; j < NJV; ++j) { const int cidx = 4 * lane + 256 * j; f32x4 g = *(const f32x4*)(nm + cidx), sh = *(const f32x4*)(mm + cidx), sc = *(const f32x4*)(mm + DM + cidx), o;
#pragma unroll
                for (int r = 0; r < 4; ++r) o[r] = v[q][j][r] * rs * g[r] * (1.0f + sc[r]) + sh[r];
                st_bf4(hb + cidx, o); } }
    }
}

DEV void route_phase(const Args& a, unsigned char* smem, int l) {
    unsigned char* ws = wsp(a); const int tid = TID, w = tid >> 6, lane = tid & 63, h = lane >> 4, c = lane & 15, pi = w >> 1, kh = w & 1;
    constexpr int NCHK = 4, CH = DM / NCHK, WLD = CH + 8, NKS = CH / 2 / 32;
    constexpr int WTOT = 48 * (CH / 8), WMAX = (WTOT + NT - 1) / NT;
    bf16* WHl = (bf16*)smem; bf16* WLl = WHl + 48 * WLD;
    float* lg = (float*)(WLl + 48 * WLD);
    float* ssb = lg + 4 * 2 * 16 * 48;
    float* rsb = ssb + 4 * 2 * 16;
    int* lcnt = (int*)(rsb + 64); int* lbase = lcnt + 32; int* tinfo = lbase + 32;
    float* avl = (float*)(tinfo + 256); float* cvl = avl + 2 * DM;
    const float* mod = (const float*)(ws + WS_MOD);
    SYNC();
    if (tid < 32) lcnt[tid] = 0;
    for (int i = tid; i < 2 * DM; i += NT) { const int b = i / DM, k = i % DM; avl[i] = ((const float*)(ws + WS_AVEC))[((size_t)l * 2 + b) * DM + k]; cvl[i] = mod[((size_t)l * 2 + b) * 6 * DM + 3 * DM + k]; }
    const bf16* WH = (const bf16*)(ws + WS_WTH) + (size_t)l * 48 * DM; const bf16* WL = (const bf16*)(ws + WS_WTL) + (size_t)l * 48 * DM;
    int* cnt = (int*)(ws + WS_CNT) + l * 32 * 64;
    for (int pass0 = BID; pass0 < T / 16; pass0 += 4 * NBLK) {
        const int pass = pass0 + pi * NBLK; const bool valid = pass < T / 16;
        const int tok = valid ? pass * 16 + c : 0, b = tok / SEQ;
        const float* xrow = outp(a) + (size_t)tok * DM;
        f32x4 xv[2][NKS][2]; bf16x8 wh[WMAX], wl[WMAX];
#pragma unroll
        for (int ks = 0; ks < NKS; ++ks) { const float* xq = xrow + kh * (CH / 2) + 8 * h + 32 * ks; xv[0][ks][0] = *(const f32x4*)xq; xv[0][ks][1] = *(const f32x4*)(xq + 4); }
#pragma unroll
        for (int t = 0; t < WMAX; ++t) { const int i = tid + NT * t; if (i < WTOT) { const int n = i / (CH / 8), k8 = (i % (CH / 8)) * 8; wh[t] = *(const bf16x8*)(WH + (size_t)n * DM + k8); wl[t] = *(const bf16x8*)(WL + (size_t)n * DM + k8); } }
        f32x4 acc[3] = {f4zero(), f4zero(), f4zero()}; float ss = 0.f;
        bf16x8 uhk[NCHK * NKS];
#pragma unroll
        for (int chn = 0; chn < NCHK; ++chn) {
            SYNC();
#pragma unroll
            for (int t = 0; t < WMAX; ++t) { const int i = tid + NT * t; if (i < WTOT) { const int n = i / (CH / 8), k8 = (i % (CH / 8)) * 8; *(bf16x8*)(WHl + n * WLD + k8) = wh[t]; *(bf16x8*)(WLl + n * WLD + k8) = wl[t]; } }
            SYNC();
            if (chn + 1 < NCHK) {
#pragma unroll
                for (int ks = 0; ks < NKS; ++ks) { const float* xq = xrow + (chn + 1) * CH + kh * (CH / 2) + 8 * h + 32 * ks; xv[(chn + 1) & 1][ks][0] = *(const f32x4*)xq; xv[(chn + 1) & 1][ks][1] = *(const f32x4*)(xq + 4); }
#pragma unroll
                for (int t = 0; t < WMAX; ++t) { const int i = tid + NT * t; if (i < WTOT) { const int n = i / (CH / 8), k8 = (i % (CH / 8)) * 8; wh[t] = *(const bf16x8*)(WH + (size_t)n * DM + (chn + 1) * CH + k8); wl[t] = *(const bf16x8*)(WL + (size_t)n * DM + (chn + 1) * CH + k8); } }
            }
            if (valid) {
                const bf16* whp = WHl + c * WLD + kh * (CH / 2) + 8 * h; const bf16* wlp = WLl + c * WLD + kh * (CH / 2) + 8 * h;
                const float* ap = avl + b * DM + chn * CH + kh * (CH / 2) + 8 * h;
#pragma unroll
                for (int ks = 0; ks < NKS; ++ks) {
                    const f32x4 a0 = *(const f32x4*)(ap + 32 * ks), a1 = *(const f32x4*)(ap + 32 * ks + 4);
                    const f32x4 x0 = xv[chn & 1][ks][0], x1 = xv[chn & 1][ks][1];
                    f32x4 u0, u1, r0, r1;
#pragma unroll
                    for (int r = 0; r < 4; ++r) { u0[r] = x0[r] * a0[r]; u1[r] = x1[r] * a1[r]; ss += x0[r] * x0[r] + x1[r] * x1[r]; }
                    const bf16x8 uh = pack8(u0, u1); uhk[chn * NKS + ks] = uh;
#pragma unroll
                    for (int r = 0; r < 4; ++r) { r0[r] = u0[r] - bf2f((unsigned short)uh[r]); r1[r] = u1[r] - bf2f((unsigned short)uh[4 + r]); }
                    const bf16x8 ul = pack8(r0, r1);
#pragma unroll
                    for (int nt = 0; nt < 3; ++nt) { const bf16x8 whf = *(const bf16x8*)(whp + nt * 16 * WLD + 32 * ks), wlf = *(const bf16x8*)(wlp + nt * 16 * WLD + 32 * ks);
                        acc[nt] = mfma16(whf, uh, acc[nt]); acc[nt] = mfma16(wlf, uh, acc[nt]); acc[nt] = mfma16(whf, ul, acc[nt]); }
                }
            }
        }
        if (valid) {
            ss += shflx(ss, 16); ss += shflx(ss, 32);
            float* lgp = lg + ((pi * 2 + kh) * 16 + c) * 48 + 4 * h;
#pragma unroll
            for (int nt = 0; nt < 3; ++nt) *(f32x4*)(lgp + 16 * nt) = acc[nt];
            if (h == 0) ssb[(pi * 2 + kh) * 16 + c] = ss;
        }
        SYNC();
        if (tid < 64) { const int p2 = tid >> 4, tk = tid & 15, pass2 = pass0 + p2 * NBLK;
            if (pass2 < T / 16) { const int tok2 = pass2 * 16 + tk, b2 = tok2 / SEQ;
                const float rs = frsq((ssb[(p2 * 2 + 0) * 16 + tk] + ssb[(p2 * 2 + 1) * 16 + tk]) * (1.0f / DM) + EPS); rsb[p2 * 16 + tk] = rs;
                const float* l0 = lg + ((p2 * 2 + 0) * 16 + tk) * 48; const float* l1 = lg + ((p2 * 2 + 1) * 16 + tk) * 48; const float* rbp = (const float*)(ws + WS_RBIAS) + ((size_t)l * 2 + b2) * 48;
                float acc[36];
#pragma unroll
                for (int n = 0; n < 36; ++n) acc[n] = rs * (l0[n] + l1[n]) + rbp[n];
                int gs = 0; float gm = acc[0];
#pragma unroll
                for (int g = 1; g < 4; ++g) if (acc[g] > gm) { gm = acc[g]; gs = g; }
                float den = 0.f;
#pragma unroll
                for (int g = 0; g < 4; ++g) den += fexp2((acc[g] - gm) * LOG2E);
                const float ggate = 1.0f / den;
                float el[8];
#pragma unroll
                for (int j = 0; j < 8; ++j) { el[j] = acc[4 + j];
#pragma unroll
                    for (int g = 1; g < 4; ++g) if (gs == g) el[j] = acc[4 + 8 * g + j]; }
                int ia = 0; float va = el[0];
#pragma unroll
                for (int j = 1; j < 8; ++j) if (el[j] > va) { va = el[j]; ia = j; }
                int ib = -1; float vb = -3e38f;
#pragma unroll
                for (int j = 0; j < 8; ++j) if (j != ia && el[j] > vb) { vb = el[j]; ib = j; }
                const float wa = 1.0f / (1.0f + fexp2((vb - va) * LOG2E)), wb = 1.0f - wa;
                const int e0 = gs * 8 + ia, e1 = gs * 8 + ib;
                const int p0 = atomic_add_i(lcnt + e0, 1), p1 = atomic_add_i(lcnt + e1, 1);
                int* ti = tinfo + tid * 4;
                ti[0] = (e0 << 14) | p0; ti[1] = (e1 << 14) | p1; ti[2] = __builtin_bit_cast(int, ggate * wa); ti[3] = __builtin_bit_cast(int, ggate * wb);
            } }
        SYNC();
        int gbase = 0;
        if (tid < 32) { const int n = lcnt[tid]; gbase = n > 0 ? atomic_add_i(cnt + tid * 64, n) : 0; }
        if (valid) { const float rs = rsb[pi * 16 + c]; bf16* hb = (bf16*)(ws + WS_H) + (size_t)tok * DM + kh * (CH / 2) + 8 * h;
            const float* cp = cvl + b * DM + kh * (CH / 2) + 8 * h;
#pragma unroll
            for (int chn = 0; chn < NCHK; ++chn)
#pragma unroll
                for (int ks = 0; ks < NKS; ++ks) {
                    const bf16x8 uh = uhk[chn * NKS + ks]; const f32x4 c0 = *(const f32x4*)(cp + chn * CH + 32 * ks), c1 = *(const f32x4*)(cp + chn * CH + 32 * ks + 4);
                    f32x4 o0, o1;
#pragma unroll
                    for (int r = 0; r < 4; ++r) { o0[r] = bf2f((unsigned short)uh[r]) * rs + c0[r]; o1[r] = bf2f((unsigned short)uh[4 + r]) * rs + c1[r]; }
                    st_bf8(hb + chn * CH + 32 * ks, o0, o1); } }
        if (tid < 32) { lbase[tid] = gbase; lcnt[tid] = 0; }
        SYNC();
        if (tid < 64) { const int p2 = tid >> 4, pass2 = pass0 + p2 * NBLK;
            if (pass2 < T / 16) { const int tok2 = pass2 * 16 + (tid & 15); const int* ti = tinfo + tid * 4;
                const int e0 = ti[0] >> 14, e1 = ti[1] >> 14, p0 = lbase[e0] + (ti[0] & 16383), p1 = lbase[e1] + (ti[1] & 16383);
                int* list = (int*)(ws + WS_LIST); list[(size_t)e0 * T + p0] = tok2; list[(size_t)e1 * T + p1] = tok2;
                int* tie = (int*)(ws + WS_TIE) + (size_t)tok2 * 2; int* tiw = (int*)(ws + WS_TIW) + (size_t)tok2 * 2;
                tie[0] = (e0 << 14) | p0; tie[1] = (e1 << 14) | p1; tiw[0] = ti[2]; tiw[1] = ti[3]; } }
        SYNC();
    }
}

DEV int vbid() { const int g = NBLK; return (g % 8 == 0) ? (BID % 8) * (g / 8) + BID / 8 : BID; }
#ifdef EMU
#define PG8_LDS(p) (p)
#else
#define PG8_LDS(p) ((PG8_LAS unsigned char*)(p))
#endif
DEV void inproj_phase(const Args& a, unsigned char* smem, int li) {
    pg8::Gemm g{(const bf16*)(wsp(a) + WS_H), (const bf16*)(wsp(a) + WS_WIN) + (size_t)li * NIN8 * DM, T, NIN8, DM}; pg8::StaticOrder S; S.init(T, NIN8, NBLK, BID);
    EpiInProj8 E{&a, li};
    SYNC(); pg8::gemm_phase<EpiInProj8, pg8::StaticOrder, true, true>(PG8_LDS(smem), g, S, E); SYNC();
}
DEV void resid_gemm_phase(const Args& a, unsigned char* smem, const bf16* A, int K, const bf16* Bt, int l) {
    pg8::Gemm g{A, Bt, T, DM, K}; pg8::StaticOrder S; S.init(T, DM, NBLK, BID);
    EpiResid8 E{outp(a), (const float*)(wsp(a) + WS_MOD) + (size_t)l * 2 * 6 * DM + 2 * DM, l == 0 ? INP(a, I_X) : (const float*)outp(a)};
    SYNC(); pg8::gemm_phase<EpiResid8, pg8::StaticOrder, true, true>(PG8_LDS(smem), g, S, E); SYNC();
}
DEV void pw1_phase(const Args& a, unsigned char* smem, int li) {
    pg8::Gemm g{(const bf16*)(wsp(a) + WS_H), (const bf16*)(wsp(a) + WS_PW1) + (size_t)li * 2 * DM * DM, T, 2 * DM, DM}; pg8::StaticOrder S; S.init(T, 2 * DM, NBLK, BID);
    EpiGlu8 E{(bf16*)(wsp(a) + WS_GLU)};
    SYNC(); pg8::gemm_phase<EpiGlu8, pg8::StaticOrder, true, true>(PG8_LDS(smem), g, S, E); SYNC();
}
DEV void cmp_phase_items(const Args& a, unsigned char* smem, int li, int it) {
    constexpr int TMC = (NCP + 255) / 256;
    const int kv = it / (4 * TMC), bg = (it / TMC) % 4, tm = it % TMC;
    const bf16* src = (const bf16*)(wsp(a) + (kv ? WS_VCG : WS_KCG)) + (size_t)bg * SEQ * 64;
    struct AF { const bf16* base; int m0; MDEV unsigned off(int r) const { int n = m0 + r; if (n > NCMP - 1) n = NCMP - 1; return (unsigned)n * 1024u; } } af{src, tm * 256};
    EpiCmp E{&a, kv, bg, tm * 256, li};
    BClamp64 bf{INP(a, kv ? I_CWV : I_CWK) + (size_t)li * 2048 * 64};
    gemm_tile2(smem, af, bf, 64, 2048, E);
}
DEV void moe_gemm_phase8(const Args& a, unsigned char* smem, int l, int mode) {
    unsigned char* ws = wsp(a); const int* cnt = (const int*)(ws + WS_CNT) + l * 32 * 64;
    int* rb = (int*)(smem + 140 * 1024);
    moe_bases(cnt, rb);
    const int mrows = rb[32];
    if (mode == 0) {
        pg8::Gemm g{(const bf16*)(ws + WS_H), (const bf16*)(ws + WS_W13) + (size_t)l * 32 * 2 * FF * DM, mrows, 2 * FF, DM}; pg8::StaticOrder S; S.init(mrows, 2 * FF, NBLK, BID);
        EpiMoe1_8 E{(bf16*)(ws + WS_ACT)}; MoeSel<true> X{rb, cnt, (const int*)(ws + WS_LIST), (size_t)2 * FF * DM * 2};
        SYNC(); pg8::gemm_phase<EpiMoe1_8, pg8::StaticOrder, true, true, MoeSel<true>>(PG8_LDS(smem), g, S, E, X); SYNC();
    } else {
        pg8::Gemm g{(const bf16*)(ws + WS_ACT), (const bf16*)(ws + WS_W2) + (size_t)l * 32 * DM * FF, mrows, DM, FF}; pg8::StaticOrder S; S.init(mrows, DM, NBLK, BID);
        EpiMoe2_8 E{(bf16*)(ws + WS_YK)}; MoeSel<false> X{rb, cnt, (const int*)(ws + WS_LIST), (size_t)DM * FF * 2};
        SYNC(); pg8::gemm_phase<EpiMoe2_8, pg8::StaticOrder, true, true, MoeSel<false>>(PG8_LDS(smem), g, S, E, X); SYNC();
    }
}
#ifndef EMU
constexpr int MOE_TMO_IDX = 128;
struct MoeOrder { int nN, t0, nu, j, nper, nA; bool rev;
    __device__ __forceinline__ void init(int ntile, int nN_, int nblk, int bid, bool rev_) { nN = nN_; nper = nblk / 8; rev = rev_; const int x = bid % 8; j = bid / 8;
        t0 = x * ntile / 8; nu = ((x + 1) * ntile / 8 - t0) * nN; if (bid >= 8 * nper) nu = 0;
        nA = nu - 2 * nper; nA = nA < 0 ? 0 : (nA > nper / 2 ? nper / 2 : nA); }
    __device__ __forceinline__ bool next(int i, pg8::Unit& u) const { int p;
        if (!rev) p = i * nper + j;
        else if (j < nA) { if (i > 0) return false; p = nu - nA + j; }
        else { p = i * (nper - nA) + (j - nA); if (p >= nu - nA) return false; }
        if (p >= nu) return false; u.pm = t0 + p / nN; u.pn = p % nN; return true; }
    __device__ __forceinline__ void a_ready(const pg8::Unit&) const {}
    __device__ __forceinline__ void done(const pg8::Unit&) const {}
};
struct MoeProd : MoeOrder { unsigned* flg;
    __device__ __forceinline__ void done(const pg8::Unit& u) const {
        asm volatile("s_waitcnt vmcnt(0)" ::: "memory"); __builtin_amdgcn_s_barrier(); asm volatile("" ::: "memory");
        if (TID == 0) (void)__hip_atomic_fetch_add((__attribute__((address_space(1))) unsigned*)(flg + u.pm * 16), 1u, __ATOMIC_RELAXED, __HIP_MEMORY_SCOPE_AGENT); } };
struct MoeCons : MoeOrder { unsigned* flg; unsigned* tmo;
    __device__ __forceinline__ void a_ready(const pg8::Unit& u) const {
        if ((TID >> 6) == 0) { unsigned sp = 0u; __attribute__((address_space(1))) unsigned* f = (__attribute__((address_space(1))) unsigned*)(flg + u.pm * 16);
            while ((unsigned)__builtin_amdgcn_readfirstlane((int)__hip_atomic_load(f, __ATOMIC_RELAXED, __HIP_MEMORY_SCOPE_AGENT)) < (unsigned)(2 * FF / 256)) {
                __builtin_amdgcn_s_sleep(1);
                if ((++sp & 255u) == 0u) { if (__hip_atomic_load((__attribute__((address_space(1))) unsigned*)tmo, __ATOMIC_RELAXED, __HIP_MEMORY_SCOPE_AGENT)) break;
                    if (sp > (1u << 22)) { (void)__hip_atomic_fetch_add((__attribute__((address_space(1))) unsigned*)tmo, 1u, __ATOMIC_RELAXED, __HIP_MEMORY_SCOPE_AGENT); break; } } }
            __builtin_amdgcn_fence(__ATOMIC_ACQUIRE, "agent"); }
        asm volatile("" ::: "memory"); __builtin_amdgcn_s_barrier(); asm volatile("" ::: "memory"); } };
DEV void moe_fused_phase(const Args& a, unsigned char* smem, int l) {
    unsigned char* ws = wsp(a); const int* cnt = (const int*)(ws + WS_CNT) + l * 32 * 64;
    int* rb = (int*)(smem + 140 * 1024);
    moe_bases(cnt, rb);
    const int mrows = rb[32]; unsigned* flg = (unsigned*)(ws + WS_FLG) + (size_t)l * 256 * 16;
    { pg8::Gemm g{(const bf16*)(ws + WS_H), (const bf16*)(ws + WS_W13) + (size_t)l * 32 * 2 * FF * DM, mrows, 2 * FF, DM}; MoeProd S; S.init(mrows >> 8, 2 * FF / 256, NBLK, BID, false); S.flg = flg;
      EpiMoe1_8 E{(bf16*)(ws + WS_ACT)}; MoeSel<true> X{rb, cnt, (const int*)(ws + WS_LIST), (size_t)2 * FF * DM * 2};
      SYNC(); pg8::gemm_phase<EpiMoe1_8, MoeProd, true, true, MoeSel<true>>(PG8_LDS(smem), g, S, E, X); }
    { pg8::Gemm g{(const bf16*)(ws + WS_ACT), (const bf16*)(ws + WS_W2) + (size_t)l * 32 * DM * FF, mrows, DM, FF}; MoeCons S; S.init(mrows >> 8, DM / 256, NBLK, BID, true); S.flg = flg; S.tmo = (unsigned*)(ws + WS_BAR) + MOE_TMO_IDX;
      EpiMoe2_8 E{(bf16*)(ws + WS_YK)}; MoeSel<false> X{rb, cnt, (const int*)(ws + WS_LIST), (size_t)DM * FF * 2};
      SYNC(); pg8::gemm_phase<EpiMoe2_8, MoeCons, true, true, MoeSel<false>>(PG8_LDS(smem), g, S, E, X); SYNC(); }
}
#endif
DEV void moe_gemm_phase(const Args& a, unsigned char* smem, int l, int mode) {
    unsigned char* ws = wsp(a); const int* cnt = (const int*)(ws + WS_CNT) + l * 32 * 64;
    int* rb = (int*)(smem + GEMM2_LDS);
    moe_bases(cnt, rb);
    const int ntile = rb[32] >> 8;
    constexpr int TN1 = 2 * FF / 128, TN2 = DM / 128;
    const int TN = mode == 0 ? TN1 : TN2;
    const int* list = (const int*)(ws + WS_LIST);
    for (int it = vbid(); it < ntile * TN; it += NBLK) {
        const int rt = it / TN, tn = it % TN; int e = 0;
#pragma unroll 1
        for (int q = 1; q < 32; ++q) if ((rb[q] >> 8) <= rt) e = q;
        const int rloc = (rt << 8) - rb[e], ce = cnt[e * 64], nvalid = (ce - rloc) < 256 ? (ce - rloc) : 256;
        if (mode == 0) {
            struct AF { const bf16* base; const int* lst; int nv; MDEV unsigned off(int r) const { const int rr = r < nv ? r : nv - 1; return (unsigned)lst[rr] * (unsigned)DM; } }
                af{(const bf16*)(ws + WS_H), list + (size_t)e * T + rloc, nvalid};
            EpiGated<1> E{(bf16*)(ws + WS_ACT), (size_t)FF, rt << 8, tn * 128, nvalid};
            BInter bf{INP(a, I_W1) + (size_t)(l * 32 + e) * DM * FF, INP(a, I_W3) + (size_t)(l * 32 + e) * DM * FF, tn * 128};
            gemm_tile2(smem, af, bf, FF, DM, E);
        } else {
            ARows af{(const bf16*)(ws + WS_ACT) + (size_t)(rt << 8) * FF, (size_t)FF};
            EpiStoreBf E{(bf16*)(ws + WS_YK), (size_t)DM, rt << 8, tn * 128, nvalid};
            BPlain bf{INP(a, I_W2) + (size_t)(l * 32 + e) * FF * DM + tn * 128};
            gemm_tile2(smem, af, bf, DM, FF, E);
        }
    }
}

constexpr int LDV = 80;
constexpr int AT_K = 0, AT_V = 2 * 64 * LDT * 2, AT_IMP = AT_V + 2 * 64 * LDV * 2, AT_SEL = AT_IMP + 8 * 8 * 128 * 4, AT_GSEL = AT_SEL + 8 * 8 * 4 * 4, AT_OUT = AT_GSEL + 8 * 2 * 4 * 4, AT_END = AT_OUT + 8 * 32 * 64 * 4;
#ifdef EMU
DEV float rexp2(float x) { return exp2f(x); }
DEV unsigned uni(unsigned x) { return x; }
#else
DEV float rexp2(float x) { return __builtin_amdgcn_exp2f(x); }
DEV unsigned uni(unsigned x) { return (unsigned)__builtin_amdgcn_readfirstlane((int)x); }
#endif
DEV int krow_lds(int kappa) { return 16 * (2 * (kappa >> 5) + ((kappa >> 2) & 1)) + 4 * ((kappa >> 3) & 3) + (kappa & 3); }
template <int MASK, bool FULL, int GM>
DEV void attn_block(const bf16* Kp, const bf16* Vp, const bf16x8 (&qf)[2][2], int j, const int (&s)[2], const bool (&selbit)[2], float C2, int h, int c,
                    f32x4 (&O)[2][4], f32x4 (&Ol)[2]) {
    f32x4 st[2][2][2];
#pragma unroll
    for (int sp = 0; sp < 2; ++sp)
#pragma unroll
        for (int u = 0; u < 2; ++u) {
#pragma unroll
            for (int G = 0; G < 2; ++G) { st[G][sp][u][0] = -C2; st[G][sp][u][1] = -C2; st[G][sp][u][2] = -C2; st[G][sp][u][3] = -C2; }
#pragma unroll
            for (int ks = 0; ks < 2; ++ks) { const bf16x8 kf = *(const bf16x8*)(Kp + (16 * (2 * sp + u) + c) * LDT + 32 * ks + 8 * h);
#pragma unroll
                for (int G = 0; G < 2; ++G) if (GM & (1 << G)) st[G][sp][u] = mfma16(kf, qf[G][ks], st[G][sp][u]); } }
#pragma unroll
    for (int G = 0; G < 2; ++G) if (GM & (1 << G))
#pragma unroll
        for (int sp = 0; sp < 2; ++sp)
#pragma unroll
            for (int u = 0; u < 2; ++u)
#pragma unroll
                for (int r = 0; r < 4; ++r) { bool ok = selbit[G];
                    if (!FULL) { const int key = 64 * j + 32 * sp + 8 * h + 4 * u + r;
                        if (MASK == 0) ok = 16 * key + 31 <= s[G]; else if (MASK == 1) ok = selbit[G] && key <= s[G]; else ok = key <= s[G] && key > s[G] - 512; }
                    st[G][sp][u][r] = ok ? rexp2(st[G][sp][u][r]) : 0.f; }
    bf16x8 pb[2][2], ones;
#pragma unroll
    for (int q = 0; q < 8; ++q) ones[q] = (short)0x3F80;
#pragma unroll
    for (int G = 0; G < 2; ++G) if (GM & (1 << G))
#pragma unroll
        for (int sp = 0; sp < 2; ++sp) { pb[G][sp] = pack8(st[G][sp][0], st[G][sp][1]); Ol[G] = mfma16(ones, pb[G][sp], Ol[G]); }
    const bf16* Vb = Vp + bperm(8 * h + (c >> 2)) * LDV + 4 * (c & 3);
#pragma unroll
    for (int et = 0; et < 4; ++et)
#pragma unroll
        for (int sp = 0; sp < 2; ++sp) { const bf16x8 vf = tr_read8(Vb + (32 * sp) * LDV + 16 * et, Vb + (32 * sp + 8) * LDV + 16 * et);
#pragma unroll
            for (int G = 0; G < 2; ++G) if (GM & (1 << G)) O[G][et] = mfma16(vf, pb[G][sp], O[G][et]); }
}

struct ImpState { float invq[2][4]; float carry[2]; float* imps; int tl, hd, l, s0, qblk; };
DEV void imp_block(const bf16* Kp, const bf16x8 (&qf)[2][2], int j, int s0, int w, float C2, int h, int c, ImpState& im) {
#pragma unroll
    for (int kt = 0; kt < 4; ++kt) {
        const int row = krow_lds(16 * kt + c);
        const bf16x8 k0 = *(const bf16x8*)(Kp + row * LDT + 8 * h), k1 = *(const bf16x8*)(Kp + row * LDT + 32 + 8 * h);
        const int n = 64 * j + 16 * kt + c;
#pragma unroll
        for (int G = 0; G < 2; ++G) {
            f32x4 acc; acc[0] = -C2; acc[1] = -C2; acc[2] = -C2; acc[3] = -C2;
            acc = mfma16(qf[G][0], k0, acc); acc = mfma16(qf[G][1], k1, acc);
            const bool ok = 16 * n + 31 <= s0 + 8 * w + 4 * G + h;
            float imp = 0.f;
#pragma unroll
            for (int r = 0; r < 4; ++r) imp += ok ? rexp2(acc[r]) * im.invq[G][r] : 0.f;
            const float v = ((c & 3) == 3) ? imp : 2.0f * imp;
            float sq = v + shflx(v, 1); sq += shflx(sq, 2);
            const float rr = dpp_ror1(imp);
            const float prev = (c == 0) ? im.carry[G] : rr;
            im.carry[G] = rr;
            const int m = n >> 2;
            if ((c & 3) == 0 && m < 128) im.imps[(G * 4 + h) * 128 + m] = sq + prev;
        }
    }
}

template <int MODE>
DEV void attn_branch(bf16* Kl, bf16* Vl, const bf16* kbase, const bf16* vbase, int jlo, int jhi,
                     const bf16x8 (&qf)[2][2], const int (&s)[2], const unsigned* selm, const unsigned* gselm, float C2, int w, int h, int c, int srow, int scol,
                     f32x4 (&O)[2][4], f32x4 (&Ol)[2], ImpState& im) {
    constexpr bool PV = MODE != 1; constexpr int MASK = MODE <= 1 ? 0 : MODE - 1;
    const int krow = krow_lds(srow) * LDT + scol, vrow = bperm(srow) * LDV + scol;
    bf16x8 rk[3], rv[3];
    { const bf16x8 k0 = *(const bf16x8*)(kbase + (size_t)jlo * 4096); *(bf16x8*)(Kl + krow) = k0;
      if (PV) { const bf16x8 v0 = *(const bf16x8*)(vbase + (size_t)jlo * 4096); *(bf16x8*)(Vl + vrow) = v0; } }
#pragma unroll
    for (int u = 0; u < 3; ++u) { int jj = jlo + 1 + u; if (jj > jhi) jj = jhi; rk[(1 + u) % 3] = *(const bf16x8*)(kbase + (size_t)jj * 4096); if (PV) rv[(1 + u) % 3] = *(const bf16x8*)(vbase + (size_t)jj * 4096); }
    SYNC();
    for (int jb = jlo; jb <= jhi; jb += 3) {
#pragma unroll
        for (int u = 0; u < 3; ++u) { const int j = jb + u;
            if (j <= jhi) {
                const int cur = (j - jlo) & 1;
                const bf16* Kc = Kl + cur * 64 * LDT; const bf16* Vc = Vl + cur * 64 * LDV;
                if (MODE == 1) imp_block(Kc, qf, j, im.s0, w, C2, h, c, im);
                else {
                    bool sb[2] = {true, true}; unsigned gm = 3u;
                    if (MODE == 2) { gm = 0u;
#pragma unroll
                        for (int G = 0; G < 2; ++G) { const unsigned wq = uni(gselm[G * 4 + (j >> 5)]), mq = selm[(G * 4 + im.tl) * 4 + (j >> 5)];
                            gm |= ((wq >> (j & 31)) & 1u) << G; sb[G] = (mq >> (j & 31)) & 1u; } }
                    bool full;
                    if (MODE == 0) full = 1024 * j + 1039 <= im.s0; else if (MODE == 2) full = j < im.qblk; else full = (j < im.qblk) && (64 * j > im.s0 + 63 - 512);
                    if (MODE == 2) {
                        if (full) { if (gm == 3u) attn_block<MASK, true, 3>(Kc, Vc, qf, j, s, sb, C2, h, c, O, Ol); else if (gm == 1u) attn_block<MASK, true, 1>(Kc, Vc, qf, j, s, sb, C2, h, c, O, Ol); else if (gm == 2u) attn_block<MASK, true, 2>(Kc, Vc, qf, j, s, sb, C2, h, c, O, Ol); }
                        else { if (gm == 3u) attn_block<MASK, false, 3>(Kc, Vc, qf, j, s, sb, C2, h, c, O, Ol); else if (gm == 1u) attn_block<MASK, false, 1>(Kc, Vc, qf, j, s, sb, C2, h, c, O, Ol); else if (gm == 2u) attn_block<MASK, false, 2>(Kc, Vc, qf, j, s, sb, C2, h, c, O, Ol); }
                    } else { if (full) attn_block<MASK, true, 3>(Kc, Vc, qf, j, s, sb, C2, h, c, O, Ol); else attn_block<MASK, false, 3>(Kc, Vc, qf, j, s, sb, C2, h, c, O, Ol); }
                }
                if (j + 1 <= jhi) {
                    *(bf16x8*)(Kl + (cur ^ 1) * 64 * LDT + krow) = rk[(u + 1) % 3]; if (PV) *(bf16x8*)(Vl + (cur ^ 1) * 64 * LDV + vrow) = rv[(u + 1) % 3];
                    int jj = j + 4; if (jj > jhi) jj = jhi;
                    rk[(u + 1) % 3] = *(const bf16x8*)(kbase + (size_t)jj * 4096); if (PV) rv[(u + 1) % 3] = *(const bf16x8*)(vbase + (size_t)jj * 4096);
                }
                SYNC();
            }
        }
    }
}

DEV void attn_task(const Args& a, unsigned char* smem, int li, int item) {
    unsigned char* ws = wsp(a); const int tid = TID, w = tid >> 6, l = tid & 63, h = l >> 4, c = l & 15, tl = c >> 2, hd = c & 3;
    const int bg = item & 3, b = bg >> 1, g = bg & 1, tq = (SEQ / 64 - 1) - (item >> 2), s0 = tq * 64, qblk = tq;
    int s[2], row[2];
#pragma unroll
    for (int G = 0; G < 2; ++G) { s[G] = s0 + 8 * w + 4 * G + tl; row[G] = b * SEQ + s[G]; }
    bf16* Kl = (bf16*)(smem + AT_K); bf16* Vl = (bf16*)(smem + AT_V); float* imps = (float*)(smem + AT_IMP) + w * 1024; unsigned* selm = (unsigned*)(smem + AT_SEL) + w * 32;
    bf16x8 qf[2][2]; float gatec[2], gates[2], gatew[2];
#pragma unroll
    for (int G = 0; G < 2; ++G) { const bf16* qp = (const bf16*)(ws + WS_QN) + (size_t)row[G] * 512 + (g * 4 + hd) * 64 + 8 * h; qf[G][0] = *(const bf16x8*)qp; qf[G][1] = *(const bf16x8*)(qp + 32);
        const float* gp = (const float*)(ws + WS_GATE) + (size_t)row[G] * 24 + (g * 4 + hd) * 3; gatec[G] = gp[0]; gates[G] = gp[1]; gatew[G] = gp[2]; }
    const float* cs = (const float*)(ws + WS_CS) + li * 4;
    const int srow = tid >> 3, scol = (tid & 7) * 8;
    for (int i = l; i < 1024; i += 64) imps[i] = 0.f;
    SYNC();
    unsigned* gselm = (unsigned*)(smem + AT_GSEL) + w * 8; float* outl = (float*)(smem + AT_OUT) + w * 2048 + l;
    ImpState im{{{0.f, 0.f, 0.f, 0.f}, {0.f, 0.f, 0.f, 0.f}}, {0.f, 0.f}, imps, tl, hd, l, s0, qblk};
    {
        const int ncv = s0 / 16 + 3, ncb0 = (ncv + 63) >> 6, ncb = ncb0 > NCP / 64 ? NCP / 64 : ncb0;
        const bf16* kcb = (const bf16*)(ws + WS_KC) + (size_t)bg * NCP * 64 + tid * 8;
        const bf16* vcb = (const bf16*)(ws + WS_VCT) + (size_t)bg * NCP * 64 + tid * 8;
        f32x4 O[2][4], Ol[2] = {f4zero(), f4zero()};
#pragma unroll
        for (int G = 0; G < 2; ++G)
#pragma unroll
            for (int et = 0; et < 4; ++et) O[G][et] = f4zero();
        attn_branch<0>(Kl, Vl, kcb, vcb, 0, ncb - 1, qf, s, selm, gselm, cs[0], w, h, c, srow, scol, O, Ol, im);
#pragma unroll
        for (int G = 0; G < 2; ++G) { const float lsum = Ol[G][0]; const float invl = lsum > 0.f ? 1.0f / lsum : 0.f;
#pragma unroll
            for (int r = 0; r < 4; ++r) im.invq[G][r] = shfl(invl, 4 * h + r);
#pragma unroll
            for (int et = 0; et < 4; ++et)
#pragma unroll
                for (int r = 0; r < 4; ++r) outl[((G * 4 + et) * 4 + r) * 64] = gatec[G] * invl * O[G][et][r]; }
        f32x4 ld[2] = {f4zero(), f4zero()};
        attn_branch<1>(Kl, Vl, kcb, vcb, 0, ncb - 1, qf, s, selm, gselm, cs[0], w, h, c, srow, scol, O, ld, im);
    }
    WSYNC();
#pragma unroll 1
    for (int G = 0; G < 2; ++G) {
        const int tk = l >> 4, i = l & 15; float vals[8];
#pragma unroll
        for (int mm = 0; mm < 8; ++mm) { const int jj = i + 16 * mm; vals[mm] = jj > qblk ? NEGV : ((jj == 0 || jj == qblk || jj == qblk - 1) ? FORCEV : imps[(G * 4 + tk) * 128 + jj]); }
        unsigned mk[4] = {0u, 0u, 0u, 0u};
#pragma unroll 1
        for (int rnd = 0; rnd < 16; ++rnd) {
            float best = vals[0]; int bj = i;
#pragma unroll
            for (int mm = 1; mm < 8; ++mm) if (vals[mm] > best) { best = vals[mm]; bj = i + 16 * mm; }
#pragma unroll
            for (int o = 1; o < 16; o <<= 1) { const float ov = shflx(best, o); const int oj = shflxi(bj, o); if (ov > best || (ov == best && oj < bj)) { best = ov; bj = oj; } }
            if (best > NEGV * 0.5f) {
#pragma unroll
                for (int q = 0; q < 4; ++q) if ((bj >> 5) == q) mk[q] |= 1u << (bj & 31); }
            if ((bj & 15) == i) {
#pragma unroll
                for (int mm = 0; mm < 8; ++mm) if ((bj >> 4) == mm) vals[mm] = -3e38f; }
        }
        if (i == 0) {
#pragma unroll
            for (int q = 0; q < 4; ++q) selm[(G * 4 + tk) * 4 + q] = mk[q]; }
    }
    WSYNC();
    if (l < 8) { const int G = l >> 2, q = l & 3; gselm[l] = selm[(G * 4 + 0) * 4 + q] | selm[(G * 4 + 1) * 4 + q] | selm[(G * 4 + 2) * 4 + q] | selm[(G * 4 + 3) * 4 + q]; }
    WSYNC();
#pragma unroll
    for (int br = 0; br < 2; ++br) {
        const bf16* kb = (const bf16*)(ws + (br == 0 ? WS_KS : WS_KW)) + (size_t)bg * SEQ * 64 + tid * 8; const bf16* vb = (const bf16*)(ws + (br == 0 ? WS_VST : WS_VWT)) + (size_t)bg * SEQ * 64 + tid * 8;
        f32x4 O[2][4], Ol[2] = {f4zero(), f4zero()};
#pragma unroll
        for (int G = 0; G < 2; ++G)
#pragma unroll
            for (int et = 0; et < 4; ++et) O[G][et] = f4zero();
        if (br == 0) attn_branch<2>(Kl, Vl, kb, vb, 0, qblk, qf, s, selm, gselm, cs[1], w, h, c, srow, scol, O, Ol, im);
        else attn_branch<3>(Kl, Vl, kb, vb, s0 >= 511 ? (s0 - 511) >> 6 : 0, qblk, qf, s, selm, gselm, cs[2], w, h, c, srow, scol, O, Ol, im);
#pragma unroll
        for (int G = 0; G < 2; ++G) { const float lsum = Ol[G][0]; const float sc = (br == 0 ? gates[G] : gatew[G]) * (lsum > 0.f ? 1.0f / lsum : 0.f);
#pragma unroll
            for (int et = 0; et < 4; ++et)
#pragma unroll
                for (int r = 0; r < 4; ++r) outl[((G * 4 + et) * 4 + r) * 64] += sc * O[G][et][r]; }
    }
#pragma unroll
    for (int G = 0; G < 2; ++G) { bf16* dst = (bf16*)(ws + WS_CAT) + (size_t)row[G] * 1024 + (g * 4 + hd) * 64 + 4 * h;
#pragma unroll
        for (int et = 0; et < 4; ++et) { f32x4 o;
#pragma unroll
            for (int r = 0; r < 4; ++r) o[r] = outl[((G * 4 + et) * 4 + r) * 64];
            st_bf4(dst + 16 * et, o); } }
}

constexpr int LDH = 136;
DEV void hg_cumsum(const float* fsrc  , float* segs  , int d, int seg, float (&f)[16], float (&bc)[16], float& bend, float& bmid) {
    float run = 0.f;
#pragma unroll
    for (int i = 0; i < 16; ++i) { f[i] = fsrc[(size_t)(16 * seg + i) * 128 + d]; run += log2f(f[i]); bc[i] = run; }
    SYNC();
    segs[seg * 128 + d] = run;
    SYNC();
    const float s0 = segs[d], s1 = segs[128 + d], s2 = segs[256 + d], s3 = segs[384 + d];
    const float off = seg == 0 ? 0.f : (seg == 1 ? s0 : (seg == 2 ? s0 + s1 : s0 + s1 + s2));
#pragma unroll
    for (int i = 0; i < 16; ++i) bc[i] += off;
    bend = s0 + s1 + s2 + s3; bmid = s0 + s1;
}
DEV void hg_write16(bf16* dstrow  , const float (&v)[16]) {
    u32x4 w0, w1;
#pragma unroll
    for (int q = 0; q < 4; ++q) { w0[q] = pk2(v[2 * q], v[2 * q + 1]); w1[q] = pk2(v[8 + 2 * q], v[8 + 2 * q + 1]); }
    *(u32x4*)dstrow = w0; *(u32x4*)(dstrow + 8) = w1;
}
DEV void hg_h1_task(const Args& a, unsigned char* smem, int task) {
    unsigned char* ws = wsp(a); const int tid = TID, w = tid >> 6, l = tid & 63, h = l >> 4, c = l & 15, d = tid & 127, seg = tid >> 7;
    const int bh = task / NCH, ch = task % NCH;
    bf16* kT = (bf16*)smem; bf16* vT = kT + 128 * LDT; float* segs = (float*)(vT + 128 * LDT);
    const size_t tokb = (size_t)bh * SEQ + ch * 64;
    float f[16], bc[16], bend, bmid;
    const bf16* vs = (const bf16*)(ws + WS_HV) + tokb * 128;
    bf16 vraw[16];
#pragma unroll
    for (int i = 0; i < 16; ++i) vraw[i] = vs[(size_t)(16 * seg + i) * 128 + d];
    hg_cumsum((const float*)(ws + WS_HF) + tokb * 128, segs, d, seg, f, bc, bend, bmid);
    float kv[16];
#pragma unroll
    for (int i = 0; i < 16; ++i) kv[i] = (1.0f - f[i]) * fexp2(bend - bc[i]);
    hg_write16(kT + d * LDT + 16 * seg, kv);
#pragma unroll
    for (int i = 0; i < 16; ++i) kv[i] = bf2f(vraw[i]);
    hg_write16(vT + d * LDT + 16 * seg, kv);
    if (seg == 0) ((float*)(ws + WS_GD))[((size_t)bh * NCH + ch) * 128 + d] = fexp2(bend);
    SYNC();
    f32x4 acc[8];
#pragma unroll
    for (int et = 0; et < 8; ++et) acc[et] = f4zero();
#pragma unroll
    for (int ks = 0; ks < 2; ++ks) { const bf16x8 fa = *(const bf16x8*)(kT + (16 * w + c) * LDT + 32 * ks + 8 * h);
#pragma unroll
        for (int et = 0; et < 8; ++et) acc[et] = mfma16(fa, *(const bf16x8*)(vT + (16 * et + c) * LDT + 32 * ks + 8 * h), acc[et]); }
    float* ut = (float*)(ws + WS_UT) + ((size_t)bh * NCH + ch) * 16384;
#pragma unroll
    for (int et = 0; et < 8; ++et) *(f32x4*)(ut + (size_t)(16 * et + c) * 128 + 16 * w + 4 * h) = acc[et];
    SYNC();
}
DEV void hg_scan_task(const Args& a, int sc) {
    unsigned char* ws = wsp(a); const int bh = sc >> 3, q = (sc & 7) * 512 + TID, e = q >> 5, d0 = (q & 31) * 4;
    const float* ut = (const float*)(ws + WS_UT) + (size_t)bh * NCH * 16384 + (size_t)e * 128 + d0;
    const float* gd = (const float*)(ws + WS_GD) + (size_t)bh * NCH * 128 + d0;
    bf16* st = (bf16*)(ws + WS_ST) + (size_t)bh * NCH * 16384 + (size_t)e * 128 + d0;
    f32x4 S = f4zero();
#pragma unroll 4
    for (int ch = 0; ch < NCH; ++ch) { st_bf4(st + (size_t)ch * 16384, S);
        const f32x4 g = *(const f32x4*)(gd + (size_t)ch * 128), u = *(const f32x4*)(ut + (size_t)ch * 16384);
#pragma unroll
        for (int r = 0; r < 4; ++r) S[r] = g[r] * S[r] + u[r]; }
}
DEV void hg_h3_task(const Args& a, unsigned char* smem, int li, int task) {
    unsigned char* ws = wsp(a); const int tid = TID, w = tid >> 6, l = tid & 63, h = l >> 4, c = l & 15, d = tid & 127, seg = tid >> 7;
    const int bh = task / NCH, ch = task % NCH, b = bh >> 2, hh = bh & 3;
    bf16* At = (bf16*)smem; bf16* Bt = At + 64 * LDH; bf16* Qt = Bt + 64 * LDH; bf16* vT = Qt + 64 * LDH; float* segs = (float*)(vT + 128 * LDT); float* part = segs + 512;
    const size_t tokb = (size_t)bh * SEQ + ch * 64;
    float f[16], bc[16], bend, bmid;
    const bf16* qs = (const bf16*)(ws + WS_HQ) + tokb * 128; const bf16* vs = (const bf16*)(ws + WS_HV) + tokb * 128;
    const int tt = w & 3, eh = w >> 2;
    bf16 qraw[16], vraw[16];
#pragma unroll
    for (int i = 0; i < 16; ++i) { const int t = 16 * seg + i; qraw[i] = qs[(size_t)t * 128 + d]; vraw[i] = vs[(size_t)t * 128 + d]; }
    const bf16* stp = (const bf16*)(ws + WS_ST) + ((size_t)bh * NCH + ch) * 16384;
    bf16x8 stf[4][4];
#pragma unroll
    for (int ks = 0; ks < 4; ++ks)
#pragma unroll
        for (int et = 0; et < 4; ++et) stf[ks][et] = *(const bf16x8*)(stp + (size_t)(64 * eh + 16 * et + c) * 128 + 32 * ks + 8 * h);
    const int tok = b * SEQ + ch * 64 + 16 * tt + c;
    const bf16* hg = (const bf16*)(ws + WS_HGS) + (size_t)tok * 512 + hh * 128;
    u32x2 hgv[4];
#pragma unroll
    for (int et = 0; et < 4; ++et) hgv[et] = *(const u32x2*)(hg + 64 * eh + 16 * et + 4 * h);
    hg_cumsum((const float*)(ws + WS_HF) + tokb * 128, segs, d, seg, f, bc, bend, bmid);
    float vv[16];
#pragma unroll
    for (int i = 0; i < 16; ++i) { const int t = 16 * seg + i; const float q = bf2f(qraw[i]);
        At[t * LDH + d] = (bf16)f2bf(q * fexp2(bc[i] - bmid)); Bt[t * LDH + d] = (bf16)f2bf((1.0f - f[i]) * fexp2(bmid - bc[i])); Qt[t * LDH + d] = (bf16)f2bf(q * fexp2(bc[i]));
        vv[i] = bf2f(vraw[i]); }
    hg_write16(vT + d * LDT + 16 * seg, vv);
    SYNC();
    f32x4 O[4];
#pragma unroll
    for (int et = 0; et < 4; ++et) O[et] = f4zero();
#pragma unroll
    for (int sp = 0; sp < 2; ++sp) {
        if (32 * sp > 16 * tt + 15) continue;
        f32x4 st[2];
#pragma unroll
        for (int u = 0; u < 2; ++u) { st[u] = f4zero(); const int krow = 32 * sp + 8 * (c >> 2) + 4 * u + (c & 3);
#pragma unroll
            for (int ks = 0; ks < 4; ++ks) st[u] = mfma16(*(const bf16x8*)(Bt + krow * LDH + 32 * ks + 8 * h), *(const bf16x8*)(At + (16 * tt + c) * LDH + 32 * ks + 8 * h), st[u]);
#pragma unroll
            for (int r = 0; r < 4; ++r) { const int sk = 32 * sp + 8 * h + 4 * u + r; if (sk > 16 * tt + c) st[u][r] = 0.f; } }
        const bf16x8 pb = pack8(st[0], st[1]);
#pragma unroll
        for (int et = 0; et < 4; ++et) O[et] = mfma16(*(const bf16x8*)(vT + (64 * eh + 16 * et + c) * LDT + 32 * sp + 8 * h), pb, O[et]);
    }
#pragma unroll
    for (int ks = 0; ks < 4; ++ks) { const bf16x8 fq = *(const bf16x8*)(Qt + (16 * tt + c) * LDH + 32 * ks + 8 * h);
#pragma unroll
        for (int et = 0; et < 4; ++et) O[et] = mfma16(stf[ks][et], fq, O[et]); }
    float ss = 0.f;
#pragma unroll
    for (int et = 0; et < 4; ++et)
#pragma unroll
        for (int r = 0; r < 4; ++r) ss += O[et][r] * O[et][r];
    ss += shflx(ss, 16); ss += shflx(ss, 32);
    if (h == 0) part[eh * 64 + 16 * tt + c] = ss;
    SYNC();
    const float rs = frsq((part[16 * tt + c] + part[64 + 16 * tt + c]) * (1.0f / 128.0f) + EPS);
    const float* og = INP(a, I_OG) + li * 128;
    bf16* dst = (bf16*)(ws + WS_CAT) + (size_t)tok * 1024 + 512 + hh * 128;
#pragma unroll
    for (int et = 0; et < 4; ++et) { const int e = 64 * eh + 16 * et + 4 * h; f32x4 o; const f32x4 ogv = *(const f32x4*)(og + e);
        o[0] = O[et][0] * rs * ogv[0] * bf2f(hgv[et][0] & 0xffff); o[1] = O[et][1] * rs * ogv[1] * bf2f(hgv[et][0] >> 16);
        o[2] = O[et][2] * rs * ogv[2] * bf2f(hgv[et][1] & 0xffff); o[3] = O[et][3] * rs * ogv[3] * bf2f(hgv[et][1] >> 16);
        st_bf4(dst + e, o); }
    SYNC();
}

DEV void conv_task(const Args& a, unsigned char* smem, int li, int task) {
    unsigned char* ws = wsp(a); const int tid = TID, w = tid >> 6, lane = tid & 63;
    const bool act = tid < DM / 2; const int c0 = act ? 2 * tid : 0;
    const int t0 = task * 16, b = t0 / SEQ, s0 = t0 % SEQ;
    float* red = (float*)smem;
    const float* dw = INP(a, I_DW) + (size_t)li * 31 * DM + c0;
    float acc[16][2];
    const float b0 = INP(a, I_DWB)[li * DM + c0], b1 = INP(a, I_DWB)[li * DM + c0 + 1];
#pragma unroll
    for (int t = 0; t < 16; ++t) { acc[t][0] = b0; acc[t][1] = b1; }
    const bf16* glu = (const bf16*)(ws + WS_GLU) + (size_t)b * SEQ * DM + c0;
    unsigned uu[46];
    { const bf16* gp = glu + (size_t)(s0 - 30) * DM;
#pragma unroll
    for (int r = 0; r < 46; ++r) { const int si = s0 + r - 30; uu[r] = si >= 0 ? *(const unsigned*)gp : 0u; gp += DM; OPAQUE(gp); } }
    const float* dwp = dw;
#pragma unroll
    for (int j = 0; j < 31; ++j) { const float w0 = dwp[0], w1 = dwp[1]; dwp += DM; OPAQUE(dwp);
#pragma unroll
        for (int t = 0; t < 16; ++t) { const unsigned q = uu[t + j]; acc[t][0] += w0 * bf2f(q & 0xffff); acc[t][1] += w1 * bf2f(q >> 16); } }
    float mean[16], rstd[16];
    SYNC();
#pragma unroll
    for (int t = 0; t < 16; ++t) { float s = act ? acc[t][0] + acc[t][1] : 0.f;
#pragma unroll
        for (int o = 1; o < 64; o <<= 1) s += shflx(s, o);
        if (lane == 0) red[w * 16 + t] = s; }
    SYNC();
#pragma unroll
    for (int t = 0; t < 16; ++t) { float s = 0.f;
#pragma unroll
        for (int q = 0; q < 8; ++q) s += red[q * 16 + t];
        mean[t] = s * (1.0f / DM); }
    SYNC();
#pragma unroll
    for (int t = 0; t < 16; ++t) { const float d0 = acc[t][0] - mean[t], d1 = acc[t][1] - mean[t]; float s = act ? d0 * d0 + d1 * d1 : 0.f;
#pragma unroll
        for (int o = 1; o < 64; o <<= 1) s += shflx(s, o);
        if (lane == 0) red[w * 16 + t] = s; }
    SYNC();
#pragma unroll
    for (int t = 0; t < 16; ++t) { float s = 0.f;
#pragma unroll
        for (int q = 0; q < 8; ++q) s += red[q * 16 + t];
        rstd[t] = frsq(s * (1.0f / DM) + EPS); }
    if (act) {
        const float g0 = INP(a, I_LNG)[li * DM + c0], g1 = INP(a, I_LNG)[li * DM + c0 + 1], e0 = INP(a, I_LNB)[li * DM + c0], e1 = INP(a, I_LNB)[li * DM + c0 + 1];
        bf16* dst = (bf16*)(ws + WS_CAT) + (size_t)t0 * DM + c0;
#pragma unroll
        for (int t = 0; t < 16; ++t) { const float y0 = (acc[t][0] - mean[t]) * rstd[t] * g0 + e0, y1 = (acc[t][1] - mean[t]) * rstd[t] * g1 + e1;
            *(unsigned*)(dst + (size_t)t * DM) = pk2(siluf(y0), siluf(y1)); }
    }
}

constexpr int N_PHASES = 1 + 16 * (DEPTH / 2) + 1;
DEV void phase_decode(int ph, int& l, int& sub) {
    const int q = ph - 1, pair = q >> 4, r = q & 15;
    if (r < 9) { l = 2 * pair; sub = r; } else { l = 2 * pair + 1; const int rr = r - 9; sub = rr < 3 ? rr : rr + 2; }
}
constexpr int LDS_BYTES = 150 * 1024;

DEV void run_phase(const Args& a, unsigned char* smem, int ph) {
#ifndef ONLY
#define ONLY -1
#endif
#define EN(k) (ONLY < 0 || ONLY == (k))
    if (ph == 0) { if (EN(100)) p0_phase(a, smem); return; }
    if (ph == N_PHASES - 1) { if (EN(0)) norm_phase(a, smem, DEPTH); return; }
    int l, sub; phase_decode(ph, l, sub); const int li = l >> 1; const bool even = (l & 1) == 0;
    unsigned char* ws = wsp(a);
    switch (sub) {
    case 0: if (EN(0)) norm_phase(a, smem, l); break;
    case 1: if (even) { if (EN(1)) inproj_phase(a, smem, li); } else { if (EN(11)) pw1_phase(a, smem, li); } break;
    case 2:
        if (even) { constexpr int NCI = 8 * ((NCP + 255) / 256); constexpr int NH1 = 8 * NCH;
            if (NBLK > 2 * NCI) { const int bid = BID;
                if (bid < NCI) { if (EN(2)) cmp_phase_items(a, smem, li, bid); }
                else { for (int it = bid - NCI; it < NH1; it += NBLK - NCI) if (EN(12)) hg_h1_task(a, smem, it); } }
            else for (int it = BID; it < NCI + NH1; it += NBLK) { if (it < NCI) { if (EN(2)) cmp_phase_items(a, smem, li, it); } else { if (EN(12)) hg_h1_task(a, smem, it - NCI); } } }
        else { for (int it = BID; it < T / 16; it += NBLK) if (EN(13)) conv_task(a, smem, li, it); }
        break;
#ifdef EMU
    case 3:
        if (even) { constexpr int NA = 4 * (SEQ / 64); const int G = NBLK;
            for (int r = 0; r * G < NA; ++r) { const int it = r * G + ((r & 1) ? (G - 1 - BID) : BID); if (it < NA) { if (EN(3)) attn_task(a, smem, li, it); } }
            for (int it = BID; it < 64; it += NBLK) if (EN(14)) hg_scan_task(a, it); }
        break;
    case 4: if (even) { for (int it = BID; it < 8 * NCH; it += NBLK) if (EN(4)) hg_h3_task(a, smem, li, it); } break;
#else
    case 3:
        if (even) { constexpr int NA = 4 * (SEQ / 64); const int G = NBLK;
            typedef __attribute__((address_space(1))) unsigned gu32;
            gu32* cw = (gu32*)((unsigned*)(ws + WS_BAR) + P0_CTR_IDX + 1 + 2 * li);
            int nsc = 0;
            for (int it = BID; it < 64; it += NBLK) { hg_scan_task(a, it); ++nsc; }
            if (nsc > 0) { __builtin_amdgcn_fence(__ATOMIC_RELEASE, "agent"); asm volatile("s_waitcnt vmcnt(0)" ::: "memory"); SYNC(); if (TID == 0) (void)__hip_atomic_fetch_add(cw, (unsigned)nsc, __ATOMIC_RELAXED, __HIP_MEMORY_SCOPE_AGENT); }
            for (int r = 0; r * G < NA; ++r) { const int it = r * G + ((r & 1) ? (G - 1 - BID) : BID); if (it < NA) attn_task(a, smem, li, it); }
            if ((TID >> 6) == 0) { unsigned sp = 0u; gu32* tmo = (gu32*)((unsigned*)(ws + WS_BAR) + MOE_TMO_IDX);
                while ((unsigned)__builtin_amdgcn_readfirstlane((int)__hip_atomic_load(cw, __ATOMIC_RELAXED, __HIP_MEMORY_SCOPE_AGENT)) < 64u) {
                    __builtin_amdgcn_s_sleep(1);
                    if ((++sp & 255u) == 0u) { if (__hip_atomic_load(tmo, __ATOMIC_RELAXED, __HIP_MEMORY_SCOPE_AGENT)) break; if (sp > (1u << 22)) { (void)__hip_atomic_fetch_add(tmo, 1u, __ATOMIC_RELAXED, __HIP_MEMORY_SCOPE_AGENT); break; } } }
                __builtin_amdgcn_fence(__ATOMIC_ACQUIRE, "agent"); }
            int* nxl = (int*)(smem + LDS_BYTES - 64);
            int my_next = 0; if (TID == 0) my_next = (int)__hip_atomic_fetch_add(cw + 1, 1u, __ATOMIC_RELAXED, __HIP_MEMORY_SCOPE_AGENT);
            for (;;) { SYNC(); if (TID == 0) nxl[0] = my_next; SYNC(); const int it = nxl[0]; if (it >= 8 * NCH) break;
                if (TID == 0) my_next = (int)__hip_atomic_fetch_add(cw + 1, 1u, __ATOMIC_RELAXED, __HIP_MEMORY_SCOPE_AGENT);
                hg_h3_task(a, smem, li, it); } }
        break;
    case 4: break;
#endif
    case 5:
        if (!EN(5)) break;
        if (even) resid_gemm_phase(a, smem, (const bf16*)(ws + WS_CAT), 1024, (const bf16*)(ws + WS_WOUT) + (size_t)li * DM * 1024, l);
        else resid_gemm_phase(a, smem, (const bf16*)(ws + WS_CAT), DM, (const bf16*)(ws + WS_PW2) + (size_t)li * DM * DM, l);
        break;
    case 6: if (EN(6)) route_phase(a, smem, l); break;
#ifdef EMU
    case 7: if (EN(7)) moe_gemm_phase8(a, smem, l, 0); break;
    case 8: if (EN(8)) moe_gemm_phase8(a, smem, l, 1); break;
#else
    case 7: if (EN(7)) moe_fused_phase(a, smem, l); break;
    case 8: break;
#endif
    }
}

#ifndef EMU
#define LAS __attribute__((address_space(3)))
#define XB_TMO      128
static_assert(XB_TMO == MOE_TMO_IDX && P0_CTR_IDX > XB_TMO && P0_CTR_IDX + 1 + DEPTH < 256, "timeout word / free words");
#define XB_XCNT(j)  (256  + 64 * (j))
#define XB_XSUB(j)  (1280 + 64 * (j))
#define XB_XGEN(j)  (2304 + 64 * (j))
#define XB_TOP      3328
#define XB_TOPGEN   3392
#define XCD_BAR_WORDS 3456
#define XB_SPIN_CAP (1u << 22)
__device__ __forceinline__ unsigned xb_ld(unsigned* p)              { return __hip_atomic_load(p, __ATOMIC_RELAXED, __HIP_MEMORY_SCOPE_AGENT); }
__device__ __forceinline__ unsigned xb_add(unsigned* p, unsigned v) { return __hip_atomic_fetch_add(p, v, __ATOMIC_RELAXED, __HIP_MEMORY_SCOPE_AGENT); }
__device__ __forceinline__ unsigned xb_xcc_id() { return (unsigned)__builtin_amdgcn_s_getreg((3 << 11) | 20) & 0xFu; }
#define XB_SPIN(cond, bar) do { unsigned _sp = 0; while (cond) { __builtin_amdgcn_s_sleep(1); \
    if ((++_sp & 255u) == 0u) { if (xb_ld(&(bar)[XB_TMO])) break; if (_sp > XB_SPIN_CAP) { atomicAdd(&(bar)[XB_TMO], 1u); break; } } } } while (0)
struct XcdBarrier { unsigned* bar; unsigned x; volatile LAS unsigned* st; };
__device__ __forceinline__ XcdBarrier xcd_barrier_post(unsigned* bar, volatile LAS unsigned* st) {
    XcdBarrier b; b.bar = bar; b.x = xb_xcc_id(); b.st = st;
    if (threadIdx.x == 0) (void)xb_add(&bar[XB_XCNT(b.x)], 1u);
    return b;
}
__device__ __forceinline__ void xcd_barrier_complete(unsigned* bar, unsigned x, unsigned& nloc, unsigned& nx) {
    const unsigned G = gridDim.x * gridDim.y * gridDim.z;
    unsigned sum, cnt, mine, sp = 0u;
    for (;;) {
        sum = 0u; cnt = 0u; mine = 0u;
#pragma unroll
        for (unsigned j = 0; j < 16; ++j) { const unsigned c = xb_ld(&bar[XB_XCNT(j)]); sum += c; cnt += (c > 0u) ? 1u : 0u; mine = (j == x) ? c : mine; }
        if (sum == G) break;
        __builtin_amdgcn_s_sleep(1);
        if ((++sp & 255u) == 0u) { if (xb_ld(&bar[XB_TMO])) break; if (sp > XB_SPIN_CAP) { atomicAdd(&bar[XB_TMO], 1u); break; } }
    }
    nloc = mine > 0u ? mine : 1u; nx = cnt > 0u ? cnt : 1u;
}
__device__ __forceinline__ void xcd_barrier(const XcdBarrier& b) {
    asm volatile("s_waitcnt vmcnt(0)" ::: "memory");
    __syncthreads();
    if (threadIdx.x == 0) {
        unsigned* bar = b.bar;
        __builtin_amdgcn_s_waitcnt(0);
        unsigned nloc = b.st[0], nx = b.st[1];
        if (nloc == 0u) { xcd_barrier_complete(bar, b.x, nloc, nx); b.st[0] = nloc; b.st[1] = nx; }
        const unsigned old = xb_add(&bar[XB_XSUB(b.x)], 1u);
        const unsigned gen = old / nloc;
        if (old + 1u == (gen + 1u) * nloc) {
            __builtin_amdgcn_fence(__ATOMIC_RELEASE, "agent");
            asm volatile("s_waitcnt vmcnt(0)" ::: "memory");
            const unsigned og = xb_add(&bar[XB_TOP], 1u);
            const unsigned tg = og / nx;
            if (og + 1u == (tg + 1u) * nx) xb_add(&bar[XB_TOPGEN], 1u);
            else XB_SPIN(xb_ld(&bar[XB_TOPGEN]) == tg, bar);
            __builtin_amdgcn_fence(__ATOMIC_ACQUIRE, "agent");
            xb_add(&bar[XB_XGEN(b.x)], 1u);
            asm volatile("s_waitcnt vmcnt(0)" ::: "memory");
        } else {
            XB_SPIN(xb_ld(&bar[XB_XGEN(b.x)]) == gen, bar);
            __builtin_amdgcn_fence(__ATOMIC_ACQUIRE, "agent");
            asm volatile("s_waitcnt vmcnt(0)" ::: "memory");
        }
    }
    __syncthreads();
}

__global__ void __launch_bounds__(NT, 2) mega(Args a) {
    extern __shared__ __attribute__((aligned(16))) unsigned char lds[];
    volatile LAS unsigned* st = (volatile LAS unsigned*)(LAS unsigned char*)(lds + LDS_BYTES - 16);
    if (threadIdx.x < 4) st[threadIdx.x] = 0u;
    __syncthreads();
    unsigned* barw = (unsigned*)(a.ws + WS_BAR);
    XcdBarrier bar = xcd_barrier_post(barw, st);
#pragma unroll 1
    for (int ph = 0; ph < N_PHASES; ++ph) {
        if (ph > 0 && ph < N_PHASES - 1) { int l_, s_; phase_decode(ph, l_, s_); if (s_ == 8 || (s_ == 4 && (l_ & 1) == 0)) continue; }
        run_phase(a, lds, ph);
#ifdef DUP
        { int lyr = 0, sub = 100; if (ph > 0 && ph < N_PHASES - 1) phase_decode(ph, lyr, sub);
          if (sub == (DUP % 1000) && (ph == 0 || lyr == DUP / 1000) && ph < N_PHASES - 1) { xcd_barrier(bar); run_phase(a, lds, ph); } }
#endif
        if (ph + 1 < N_PHASES) xcd_barrier(bar);
    }
    if (xb_ld(&barw[XB_TMO]) != 0u) {
        const size_t gt = (size_t)blockIdx.x * NT + threadIdx.x, gs = (size_t)gridDim.x * NT;
        for (size_t i = gt; i < (size_t)T * DM; i += gs) a.out[i] = __builtin_nanf("");
    }
}

extern "C" void kernel_launch(void* const* d_in, const int* in_sizes, int n_in, void* d_out, int out_size,
                              void* d_ws, size_t ws_size, hipStream_t stream) {
    static int grid = 0;
    if (grid == 0) {
        int dev = 0, cus = 0;
        if (hipGetDevice(&dev) != hipSuccess || hipDeviceGetAttribute(&cus, hipDeviceAttributeMultiprocessorCount, dev) != hipSuccess) { grid = -1; return; }
        if (hipFuncSetAttribute((const void*)mega, hipFuncAttributeMaxDynamicSharedMemorySize, LDS_BYTES) != hipSuccess) { grid = -1; return; }
        (void)hipGetLastError();
        grid = cus;
        if (n_in != 26 || out_size != T * DM || ws_size < WS_END) { fprintf(stderr, "kernel_launch: unexpected sizes n_in %d out %d ws %zu (need %zu)\n", n_in, out_size, ws_size, (size_t)WS_END); grid = -1; return; }
    }
    if (grid < 0) return;
    (void)hipMemsetAsync((unsigned char*)d_ws + WS_BAR, 0, XCD_BAR_WORDS * 4, stream);
    Args a{};
    for (int i = 0; i < 26; ++i) a.in[i] = (const float*)d_in[i];
    a.out = (float*)d_out; a.ws = (unsigned char*)d_ws;
    hipLaunchKernelGGL(mega, dim3(grid), dim3(NT), LDS_BYTES, stream, a);
}
#endif
```

```cpp
#ifdef EMU
#include "emu.h"
#define DEV static inline
#define MDEV inline
#define OPAQUE(p)
#define OPAQUE2(a, b)
#define TID emu_tid()
#define BID (EB->bid)
#define NBLK (EB->nblk)
#define SYNC() emu_sync_block()
#define WSYNC() emu_sync_wave()
#define mfma16(a, b, c) emu_mfma16(a, b, c)
DEV float shflx(float v, int m) { return emu_shfl_f(v, (emu_tid() & 63) ^ m); }
DEV int shflxi(int v, int m) { return (int)emu_shfl_u((unsigned)v, (emu_tid() & 63) ^ m); }
DEV float shfl(float v, int s) { return emu_shfl_f(v, s); }
DEV float dpp_ror1(float v) { const int l = emu_tid() & 63; return emu_shfl_f(v, (l & 48) | ((l - 1) & 15)); }
DEV int atomic_add_i(int* p, int v) { return __atomic_fetch_add(p, v, __ATOMIC_RELAXED); }
typedef float f32x2v __attribute__((vector_size(8)));
DEV float fexp2(float x) { return exp2f(x); }
DEV float frcp(float x) { return 1.0f / x; }
DEV float frsq(float x) { return 1.0f / sqrtf(x); }
typedef short s16x4 __attribute__((vector_size(8)));
static inline s16x4 emu_tr4(const unsigned short* p) {
    EmuWave& w = EB->wave[emu_tid() >> 6]; int l = emu_tid() & 63;
    const unsigned short** tab = (const unsigned short**)w.a;
    tab[l] = p; emu_sync_wave();
    s16x4 r; int g = l & 48, i = l & 15;
    for (int q = 0; q < 4; ++q) r[q] = (short)tab[g + 4 * q + (i >> 2)][i & 3];
    emu_sync_wave(); return r;
}
#define tr4(p) emu_tr4(p)
#else
#include <hip/hip_runtime.h>
#include <cstdio>
#include <cstdint>
typedef short bf16x8 __attribute__((ext_vector_type(8)));
typedef float f32x4 __attribute__((ext_vector_type(4)));
typedef unsigned u32x4 __attribute__((ext_vector_type(4)));
typedef unsigned u32x2 __attribute__((ext_vector_type(2)));
#define DEV __device__ __forceinline__
#define MDEV __device__ __forceinline__
#define OPAQUE(p) asm volatile("" : "+v"(p))
#define OPAQUE2(a, b) asm volatile("" : "+v"(a), "+v"(b))
DEV int tid_opaque() { int t = (int)threadIdx.x; asm volatile("" : "+v"(t)); return t; }
#define TID tid_opaque()
DEV int bid_opaque() { int b = (int)blockIdx.x; asm volatile("" : "+s"(b)); return b; }
#define BID bid_opaque()
#define NBLK ((int)gridDim.x)
#define SYNC() __syncthreads()
#define WSYNC() __builtin_amdgcn_wave_barrier()
#define mfma16(a, b, c) __builtin_amdgcn_mfma_f32_16x16x32_bf16(a, b, c, 0, 0, 0)
DEV int shflxi(int x, int m) {
    if (m == 1) return __builtin_amdgcn_update_dpp(x, x, 0xB1, 0xf, 0xf, true);
    if (m == 2) return __builtin_amdgcn_update_dpp(x, x, 0x4E, 0xf, 0xf, true);
    if (m == 4) return __builtin_amdgcn_ds_swizzle(x, (4 << 10) | 0x1F);
    if (m == 8) return __builtin_amdgcn_ds_swizzle(x, (8 << 10) | 0x1F);
    if (m == 16) return __builtin_amdgcn_ds_swizzle(x, (16 << 10) | 0x1F);
    if (m == 32) { const auto r = __builtin_amdgcn_permlane32_swap((unsigned)x, (unsigned)x, false, false); return (int)((threadIdx.x & 32) ? r[0] : r[1]); }
    return __shfl_xor(x, m);
}
DEV float shflx(float v, int m) { return __builtin_bit_cast(float, shflxi(__builtin_bit_cast(int, v), m)); }
DEV float dpp_ror1(float v) { return __builtin_bit_cast(float, __builtin_amdgcn_update_dpp(0, __builtin_bit_cast(int, v), 0x121, 0xf, 0xf, false)); }
DEV float shfl(float v, int s) { return __shfl(v, s); }
DEV int atomic_add_i(int* p, int v) { return atomicAdd(p, v); }
DEV float fexp2(float x) { return __builtin_amdgcn_exp2f(x); }
DEV float frcp(float x) { return __builtin_amdgcn_rcpf(x); }
DEV float frsq(float x) { return __builtin_amdgcn_rsqf(x); }
typedef short s16x4 __attribute__((ext_vector_type(4)));
#define tr4(p) __builtin_amdgcn_ds_read_tr16_b64_v4i16((__attribute__((address_space(3))) s16x4*)(p))
#endif

typedef unsigned short bf16;

#ifndef DM
#define DM 1024
#endif
#ifndef SEQ
#define SEQ 8192
#endif
#ifndef FF
#define FF 512
#endif
constexpr int NBATCH = 2, T = NBATCH * SEQ, DEPTH = 4;
constexpr int NIN = 3352, NINP = 3456, NIN8 = 3584;
constexpr int NT = 512;
constexpr int NCH = SEQ / 64;
constexpr int NCP = SEQ / 16;
constexpr int NCMP = NCP - 1;
constexpr int MOE_ROWS = 2 * T + 32 * 256;
constexpr float EPS = 1e-6f, NEGV = -1e30f, FORCEV = 1e4f, LOG2E = 1.4426950408889634f;

constexpr size_t al(size_t x) { return (x + 255) & ~(size_t)255; }
constexpr int P0_CTR_IDX = 192;
constexpr size_t WS_BAR = 0;
constexpr size_t WS_CNT = 16384;
constexpr size_t WS_MOD = WS_CNT + (size_t)DEPTH * 32 * 256;
constexpr size_t WS_LB = al(WS_MOD + (size_t)DEPTH * 2 * 6 * DM * 4);
constexpr size_t WS_CB = al(WS_LB + 2 * 512 * 4);
constexpr size_t WS_CS = al(WS_CB + 2 * 2 * 8 * 64 * 4);
constexpr size_t WS_WIN = al(WS_CS + 64);
constexpr size_t WS_WOUT = al(WS_WIN + (size_t)2 * NIN8 * DM * 2);
constexpr size_t WS_PW1 = al(WS_WOUT + (size_t)2 * DM * 1024 * 2);
constexpr size_t WS_PW2 = al(WS_PW1 + (size_t)2 * 2 * DM * DM * 2);
constexpr size_t WS_WC = al(WS_PW2 + (size_t)2 * DM * DM * 2);
constexpr size_t WS_W13 = al(WS_WC + (size_t)2 * 2 * 64 * 2048 * 2);
constexpr size_t WS_W2 = al(WS_W13 + (size_t)DEPTH * 32 * 2 * FF * DM * 2);
constexpr size_t WS_H = al(WS_W2 + (size_t)DEPTH * 32 * DM * FF * 2);
constexpr size_t WS_QN = al(WS_H + (size_t)T * DM * 2);
constexpr size_t WS_KCG = al(WS_QN + (size_t)T * 512 * 2);
constexpr size_t WS_VCG = al(WS_KCG + (size_t)T * 128 * 2);
constexpr size_t WS_KS = al(WS_VCG + (size_t)T * 128 * 2);
constexpr size_t WS_KW = al(WS_KS + (size_t)T * 128 * 2);
constexpr size_t WS_VST = al(WS_KW + (size_t)T * 128 * 2);
constexpr size_t WS_VWT = al(WS_VST + (size_t)T * 128 * 2);
constexpr size_t WS_KC = al(WS_VWT + (size_t)T * 128 * 2);
constexpr size_t WS_VCT = al(WS_KC + (size_t)4 * NCP * 64 * 2);
constexpr size_t WS_GATE = al(WS_VCT + (size_t)4 * NCP * 64 * 2);
constexpr size_t WS_HQ = al(WS_GATE + (size_t)T * 24 * 4);
constexpr size_t WS_HF = al(WS_HQ + (size_t)T * 512 * 2);
constexpr size_t WS_HV = al(WS_HF + (size_t)T * 512 * 4);
constexpr size_t WS_HGS = al(WS_HV + (size_t)T * 512 * 2);
constexpr size_t WS_UT = al(WS_HGS + (size_t)T * 512 * 2);
constexpr size_t WS_ST = al(WS_UT + (size_t)8 * NCH * 128 * 128 * 4);
constexpr size_t WS_GD = al(WS_ST + (size_t)8 * NCH * 128 * 128 * 2);
constexpr size_t WS_CAT = al(WS_GD + (size_t)8 * NCH * 128 * 4);
constexpr size_t WS_GLU = al(WS_CAT + (size_t)T * 1024 * 2);
constexpr size_t WS_TIE = al(WS_GLU + (size_t)T * DM * 2);
constexpr size_t WS_TIW = al(WS_TIE + (size_t)T * 2 * 4);
constexpr size_t WS_LIST = al(WS_TIW + (size_t)T * 2 * 4);
constexpr size_t WS_ACT = al(WS_LIST + (size_t)32 * T * 4);
constexpr size_t WS_YK = al(WS_ACT + (size_t)MOE_ROWS * FF * 2);
constexpr size_t WS_WTH = al(WS_YK + (size_t)MOE_ROWS * DM * 2);
constexpr size_t WS_WTL = al(WS_WTH + (size_t)DEPTH * 48 * DM * 2);
constexpr size_t WS_AVEC = al(WS_WTL + (size_t)DEPTH * 48 * DM * 2);
constexpr size_t WS_RBIAS = al(WS_AVEC + (size_t)DEPTH * 2 * DM * 4);
constexpr size_t WS_FLG = al(WS_RBIAS + (size_t)DEPTH * 2 * 48 * 4);
constexpr size_t WS_END = al(WS_FLG + (size_t)DEPTH * 256 * 64);

struct Args { const float* in[26]; float* out; unsigned char* ws; };
enum { I_X = 0, I_C, I_ADAW, I_ADAB, I_NMIX, I_NFFN, I_WIN, I_WOUT, I_CWK, I_CWV, I_CPE, I_QG, I_KG, I_LBL, I_OG,
       I_PW1, I_DW, I_DWB, I_LNG, I_LNB, I_PW2, I_WG, I_WE, I_W1, I_W3, I_W2 };

#ifdef EMU
DEV unsigned char* wsp(const Args& a) { return a.ws; }
DEV float* outp(const Args& a) { return a.out; }
#else
DEV unsigned char* launder_ptr(const void* p) { unsigned long long v = (unsigned long long)p; unsigned lo = (unsigned)v, hi = (unsigned)(v >> 32);
    lo = (unsigned)__builtin_amdgcn_readfirstlane((int)lo); hi = (unsigned)__builtin_amdgcn_readfirstlane((int)hi); asm volatile("" : "+s"(lo), "+s"(hi)); typedef __attribute__((address_space(1))) unsigned char* gptr_t; return (unsigned char*)(gptr_t)(((unsigned long long)hi << 32) | lo); }
DEV unsigned char* wsp(const Args& a) { return launder_ptr(a.ws); }
DEV float* outp(const Args& a) { return (float*)launder_ptr(a.out); }
#endif

#ifdef EMU
#define INP(a, X) ((a).in[X])
#else
DEV int zero_opaque() { int z = 0; asm volatile("" : "+s"(z)); return z; }
#define INP(a, X) ((a).in[(X) + zero_opaque()])
#endif

DEV unsigned f2bf(float f) { unsigned u = __builtin_bit_cast(unsigned, f); return (u + 0x7fffu + ((u >> 16) & 1u)) >> 16; }
DEV float bf2f(unsigned h) { return __builtin_bit_cast(float, h << 16); }
#ifdef EMU
DEV unsigned pk2(float lo, float hi) { return f2bf(lo) | (f2bf(hi) << 16); }
#else
typedef float f32x2_t __attribute__((ext_vector_type(2)));
typedef float f32x2v __attribute__((ext_vector_type(2)));
typedef __bf16 bf16x2_t __attribute__((ext_vector_type(2)));
DEV unsigned pk2(float lo, float hi) { f32x2_t v = {lo, hi}; bf16x2_t b = __builtin_convertvector(v, bf16x2_t); return __builtin_bit_cast(unsigned, b); }
#endif
DEV float sigm(float x) { return frcp(1.0f + fexp2(-x * LOG2E)); }
DEV float siluf(float x) { return x * sigm(x); }
DEV f32x4 f4zero() { f32x4 z = {0.f, 0.f, 0.f, 0.f}; return z; }
DEV bf16x8 pack8(f32x4 a, f32x4 b) {
    u32x4 w; w[0] = pk2(a[0], a[1]); w[1] = pk2(a[2], a[3]); w[2] = pk2(b[0], b[1]); w[3] = pk2(b[2], b[3]);
    return __builtin_bit_cast(bf16x8, w);
}
DEV void st_bf8(bf16* p, f32x4 a, f32x4 b) { u32x4 w; w[0] = pk2(a[0], a[1]); w[1] = pk2(a[2], a[3]); w[2] = pk2(b[0], b[1]); w[3] = pk2(b[2], b[3]); *(u32x4*)p = w; }
DEV void st_bf4(bf16* p, f32x4 v) { u32x2 w; w[0] = pk2(v[0], v[1]); w[1] = pk2(v[2], v[3]); *(u32x2*)p = w; }


#ifdef EMU
namespace pg8 {
constexpr int BM = 256, BK = 64, HALF = 128, NXCD = 8, WGM = 8;
typedef unsigned short bf16_t;
struct Unit { int pm, pn; };
struct Gemm { const bf16_t* A; const bf16_t* Bt; int M, N, K; };
struct StaticOrder {
    int nM, nN, nwg, G, c;
    void init(int M, int N, int G_, int c_) { nM = M / BM; nN = N / BM; nwg = nM * nN; G = G_; c = c_; }
    bool next(int i, Unit& u) const {
        const long L = (long)i * G + c; if (L >= nwg) return false;
        int wgid = (int)L; { const int q = nwg / NXCD, r = nwg % NXCD, xcd = wgid % NXCD, off = wgid / NXCD; wgid = (xcd < r ? xcd * (q + 1) : r * (q + 1) + (xcd - r) * q) + off; }
        const int nig = WGM * nN, gid = wgid / nig, fm = gid * WGM, gsz = (nM - fm) < WGM ? (nM - fm) : WGM;
        u.pm = fm + ((wgid % nig) % gsz); u.pn = (wgid % nig) / gsz; return true;
    }
};
struct SelNone { static constexpr bool GATHER = false; struct Ctx {}; Ctx ctx(const Unit&) const { return Ctx(); } size_t boff(const Ctx&) const { return 0; } unsigned aoff(const Ctx&, int) const { return 0u; } };
template <class Epi, class Sched, bool ALIGN_EPI = false, bool SP2 = false, class Sel = SelNone>
static inline void gemm_phase(unsigned char*, const Gemm g, const Sched& S, const Epi& E, const Sel& X = Sel()) {
    const int tid = emu_tid(), wid = tid >> 6, lane = tid & 63, wr = wid >> 2, wc = wid & 3, fr = lane & 15, fq = lane >> 4;
    Unit u;
    for (int ui = 0; S.next(ui, u); ++ui) {
        f32x4 acc[2][2][4][2]; const auto cx = X.ctx(u);
        for (int ai = 0; ai < 2; ++ai) for (int bj = 0; bj < 2; ++bj) for (int m = 0; m < 4; ++m) for (int n = 0; n < 2; ++n) for (int r = 0; r < 4; ++r) {
            const int row = 256 * u.pm + 128 * ai + 64 * wr + 16 * m + fr, col = 256 * u.pn + 128 * bj + 32 * wc + (Epi::PERM ? 8 * fq + 4 * n + r : 16 * n + 4 * fq + r); float sum = 0.f;
            const bf16_t* ap = Sel::GATHER ? (const bf16_t*)((const char*)g.A + X.aoff(cx, row - 256 * u.pm)) : g.A + (size_t)row * g.K; const bf16_t* bp = (const bf16_t*)((const char*)g.Bt + X.boff(cx)) + (size_t)col * g.K;
            for (int k = 0; k < g.K; ++k) sum += bf2f(ap[k]) * bf2f(bp[k]);
            acc[ai][bj][m][n][r] = sum; }
        E(acc, u, wr, wc, fr, fq);
    }
    emu_sync_block();
}
}
#else
namespace pg8 {
#define PG8_LAS __attribute__((address_space(3)))
typedef unsigned short bf16_t;
typedef short bf16x8 __attribute__((ext_vector_type(8)));
typedef float f32x4 __attribute__((ext_vector_type(4)));
typedef unsigned u32x4 __attribute__((ext_vector_type(4)));
constexpr int BM = 256, BK = 64, HALF = 128, HTB = HALF * BK * 2  , STAGE_BYTES = 8 * HTB, NXCD = 8, WGM = 8;

__host__ __device__ __forceinline__ int lds_byte(int r, int c) { const int st = (r >> 4) * 2 + (c >> 5), rr = r & 15, cc = c & 31, ob = rr * 64 + cc * 2; return st * 1024 + (ob ^ (((ob >> 9) & 1) << 5)); }
__host__ __device__ __forceinline__ void stage_rc(int b, int& R, int& C) { const int st = b / 1024, sb = b % 1024, swz = sb ^ (((sb >> 9) & 1) << 5); R = (st >> 1) * 16 + swz / 64; C = (st & 1) * 32 + (swz % 64) / 2; }
__host__ __device__ __forceinline__ int perm32(int rho) { const int n = rho >> 4, i = rho & 15; return 8 * (i >> 2) + 4 * n + (i & 3); }

struct Unit { int pm, pn; };
struct Gemm { const bf16_t* A; const bf16_t* Bt; int M, N, K; };

struct StaticOrder {
    int nM, nN, nwg, G, c;
    __host__ __device__ void init(int M, int N, int G_, int c_) { nM = M / BM; nN = N / BM; nwg = nM * nN; G = G_; c = c_; }
    __host__ __device__ bool next(int i, Unit& u) const {
        const long L = (long)i * G + c; if (L >= nwg) return false;
        int wgid = (int)L; { const int q = nwg / NXCD, r = nwg % NXCD, xcd = wgid % NXCD, off = wgid / NXCD; wgid = (xcd < r ? xcd * (q + 1) : r * (q + 1) + (xcd - r) * q) + off; }
        const int nig = WGM * nN, gid = wgid / nig, fm = gid * WGM, gsz = (nM - fm) < WGM ? (nM - fm) : WGM;
        u.pm = fm + ((wgid % nig) % gsz); u.pn = (wgid % nig) / gsz; return true;
    }
    __device__ __forceinline__ void a_ready(const Unit&) const {}
    __device__ __forceinline__ void done(const Unit&) const {}
};

__device__ __forceinline__ unsigned cvt_pk_bf16(float lo, float hi) { unsigned r; asm volatile("v_cvt_pk_bf16_f32 %0, %1, %2" : "=v"(r) : "v"(lo), "v"(hi)); return r; }
struct SelNone { static constexpr bool GATHER = false; struct Ctx {}; __device__ __forceinline__ Ctx ctx(const Unit&) const { return Ctx(); } __device__ __forceinline__ size_t boff(const Ctx&) const { return 0; } __device__ __forceinline__ unsigned aoff(const Ctx&, int) const { return 0u; } };
template <class Epi, class Sched, bool ALIGN_EPI = false, bool SP2 = false, class Sel = SelNone>
__device__ __forceinline__ void gemm_phase(PG8_LAS unsigned char* lds, const Gemm g, const Sched& S, const Epi& E, const Sel& X = Sel()) {
    constexpr bool GA = Sel::GATHER;
    const int tid = TID, wid = __builtin_amdgcn_readfirstlane(tid >> 6), lane = tid & 63, wr = wid >> 2, wc = wid & 3, fr = lane & 15, fq = lane >> 4;
    const int K = g.K, nt = K / BK;
    unsigned voffA[2], voffB[2]; int Rl[2]; unsigned Cl2[2];
#pragma unroll
    for (int i = 0; i < 2; ++i) { int R, C; stage_rc(tid * 16 + i * 8192, R, C); const int Rb = Epi::PERM ? ((R & ~31) + perm32(R & 31)) : R;
        voffA[i] = (unsigned)(R * K + C) * 2u; voffB[i] = (unsigned)(Rb * K + C) * 2u; Rl[i] = R; Cl2[i] = (unsigned)C * 2u; }
    unsigned vA[2][2], vAn[2][2];
    const size_t kstep = (size_t)(BK * 2);
    const size_t hstep = (size_t)HALF * K * 2;
    const size_t tstep = 2 * hstep;
    const unsigned ldsw = (unsigned)wid * 1024u;
    const int aoff = lds_byte(wr * 64 + fr, fq * 8), boff = lds_byte(wc * 32 + fr, fq * 8);
#define PG8_SA(b, h) (((b) * 2 + (h)) * HTB)
#define PG8_SB(b, h) ((4 + (b) * 2 + (h)) * HTB)
#define PG8_STAGE(bufoff, gbase, voff) do { _Pragma("unroll") for (int _i = 0; _i < 2; ++_i) \
        __builtin_amdgcn_global_load_lds((const unsigned*)((const char*)(gbase) + (voff)[_i]), (PG8_LAS unsigned*)(lds + (bufoff) + ldsw + _i * 8192), 16, 0, 0); } while (0)
#define PG8_STAGE_A(bufoff, p, h, nx) do { if constexpr (GA) { unsigned _vo[2] = {(nx) ? vAn[h][0] : vA[h][0], (nx) ? vAn[h][1] : vA[h][1]}; PG8_STAGE(bufoff, p, _vo); } else { PG8_STAGE(bufoff, (p) + (h) * hstep, voffA); } } while (0)
#define PG8_GATH(cx, dst) do { _Pragma("unroll") for (int _h = 0; _h < 2; ++_h) _Pragma("unroll") for (int _i = 0; _i < 2; ++_i) dst[_h][_i] = X.aoff(cx, 128 * _h + Rl[_i]) + Cl2[_i]; } while (0)
#define PG8_LDA(dst, b, h) do { _Pragma("unroll") for (int m = 0; m < 4; ++m) _Pragma("unroll") for (int k = 0; k < 2; ++k) dst[m][k] = *(const PG8_LAS bf16x8*)(lds + PG8_SA(b, h) + aoff + m * 2048 + k * 1024); } while (0)
#define PG8_LDB(dst, b, h) do { _Pragma("unroll") for (int n = 0; n < 2; ++n) _Pragma("unroll") for (int k = 0; k < 2; ++k) dst[n][k] = *(const PG8_LAS bf16x8*)(lds + PG8_SB(b, h) + boff + n * 2048 + k * 1024); } while (0)
#define PG8_MMA(ai, bj, At, Bt) do { __builtin_amdgcn_s_setprio(1); _Pragma("unroll") for (int m = 0; m < 4; ++m) _Pragma("unroll") for (int n = 0; n < 2; ++n) _Pragma("unroll") for (int k = 0; k < 2; ++k) \
        acc[ai][bj][m][n] = __builtin_amdgcn_mfma_f32_16x16x32_bf16(Bt[n][k], At[m][k], acc[ai][bj][m][n], 0, 0, 0); __builtin_amdgcn_s_setprio(0); } while (0)
#define PG8_WAIT_V(n) asm volatile("s_waitcnt vmcnt(" #n ")" ::: "memory")
#define PG8_WAIT_L(n) asm volatile("s_waitcnt lgkmcnt(" #n ")" ::: "memory")
#define PG8_BAR __builtin_amdgcn_s_barrier()
#define PG8_SCHED __builtin_amdgcn_sched_barrier(0)
    Unit cur, nxt; int ui = 0;
    if (!S.next(0, cur)) return;
    f32x4 acc[2][2][4][2];
#pragma unroll
    for (int a = 0; a < 2; ++a)
#pragma unroll
        for (int b = 0; b < 2; ++b)
#pragma unroll
            for (int m = 0; m < 4; ++m)
#pragma unroll
                for (int n = 0; n < 2; ++n) acc[a][b][m][n] = (f32x4){0.f, 0.f, 0.f, 0.f};
    bf16x8 At[4][2], B0[2][2], B1[2][2];
    auto ccx = X.ctx(cur);
    const char* cA = GA ? (const char*)g.A : (const char*)g.A + (size_t)cur.pm * tstep; const char* cB = (const char*)g.Bt + X.boff(ccx) + (size_t)cur.pn * tstep;
    if constexpr (GA) { PG8_GATH(ccx, vA); }
    S.a_ready(cur);
    if constexpr (SP2) {
        PG8_STAGE(PG8_SB(0, 0), cB, voffB); PG8_STAGE(PG8_SB(0, 1), cB + hstep, voffB); PG8_STAGE_A(PG8_SA(0, 0), cA, 0, false); PG8_STAGE_A(PG8_SA(0, 1), cA, 1, false);
        if (wr == 1) PG8_BAR;
        PG8_WAIT_V(2); PG8_BAR;
        PG8_STAGE(PG8_SB(1, 0), cB + kstep, voffB); PG8_STAGE_A(PG8_SA(1, 0), cA + kstep, 0, false); PG8_STAGE(PG8_SB(1, 1), cB + hstep + kstep, voffB);
        PG8_WAIT_V(6); PG8_BAR;
    } else {
        PG8_STAGE(PG8_SB(0, 0), cB, voffB); PG8_STAGE_A(PG8_SA(0, 0), cA, 0, false); PG8_STAGE(PG8_SB(0, 1), cB + hstep, voffB); PG8_STAGE_A(PG8_SA(0, 1), cA, 1, false);
        if (wr == 1) PG8_BAR;
        PG8_WAIT_V(4); PG8_BAR;
        PG8_STAGE(PG8_SB(1, 0), cB + kstep, voffB); PG8_STAGE_A(PG8_SA(1, 0), cA + kstep, 0, false); PG8_STAGE(PG8_SB(1, 1), cB + hstep + kstep, voffB);
        PG8_WAIT_V(6); PG8_BAR;
    }
    for (;;) {
        const bool has_next = S.next(ui + 1, nxt);
        const char* nA = cA; const char* nB = cB;
        if (has_next) { const auto ncx = X.ctx(nxt); nA = GA ? (const char*)g.A : (const char*)g.A + (size_t)nxt.pm * tstep; nB = (const char*)g.Bt + X.boff(ncx) + (size_t)nxt.pn * tstep; if constexpr (GA) { PG8_GATH(ncx, vAn); } }
        else if constexpr (GA) {
#pragma unroll
            for (int _h = 0; _h < 2; ++_h) { vAn[_h][0] = vA[_h][0]; vAn[_h][1] = vA[_h][1]; } }
        for (int t = 0; t < nt; t += 2) {
            const bool last = (t == nt - 2);
            const char* a1 = cA + (size_t)(t + 1) * kstep;
            const char* a2 = last ? nA : cA + (size_t)(t + 2) * kstep; const char* b2 = last ? nB : cB + (size_t)(t + 2) * kstep;
            const char* a3 = a2 + kstep; const char* b3 = b2 + kstep;
            if (last && has_next) S.a_ready(nxt);
            if constexpr (SP2) {
            PG8_LDB(B0, 0, 0); PG8_LDB(B1, 0, 1); PG8_SCHED; PG8_LDA(At, 0, 0); PG8_STAGE_A(PG8_SA(1, 1), a1, 1, false);
            PG8_WAIT_V(8); PG8_WAIT_L(0); PG8_BAR; PG8_MMA(0, 0, At, B0); PG8_MMA(0, 1, At, B1); PG8_BAR; PG8_SCHED;
            PG8_LDA(At, 0, 1); PG8_STAGE(PG8_SB(0, 0), b2, voffB); PG8_STAGE(PG8_SB(0, 1), b2 + hstep, voffB); PG8_STAGE_A(PG8_SA(0, 0), a2, 0, last);
            PG8_WAIT_V(8); PG8_WAIT_L(0); PG8_BAR; PG8_MMA(1, 0, At, B0); PG8_MMA(1, 1, At, B1); PG8_BAR; PG8_SCHED;
            PG8_LDB(B0, 1, 0); PG8_LDB(B1, 1, 1); PG8_SCHED; PG8_LDA(At, 1, 0); PG8_STAGE_A(PG8_SA(0, 1), a2, 1, last);
            PG8_WAIT_V(8); PG8_WAIT_L(0); PG8_BAR; PG8_MMA(0, 0, At, B0); PG8_MMA(0, 1, At, B1); PG8_BAR; PG8_SCHED;
            PG8_LDA(At, 1, 1); PG8_STAGE(PG8_SB(1, 0), b3, voffB); PG8_STAGE(PG8_SB(1, 1), b3 + hstep, voffB); PG8_STAGE_A(PG8_SA(1, 0), a3, 0, last);
            PG8_WAIT_V(8); PG8_WAIT_L(0); PG8_BAR; PG8_MMA(1, 0, At, B0); PG8_MMA(1, 1, At, B1); PG8_BAR; PG8_SCHED;
            } else {
            PG8_LDB(B0, 0, 0); PG8_SCHED; PG8_LDA(At, 0, 0); PG8_STAGE_A(PG8_SA(1, 1), a1, 1, false);
            PG8_WAIT_L(8); PG8_BAR; PG8_WAIT_L(0); PG8_MMA(0, 0, At, B0); PG8_BAR; PG8_SCHED;
            PG8_LDB(B1, 0, 1); PG8_STAGE(PG8_SB(0, 0), b2, voffB);
            PG8_BAR; PG8_WAIT_L(0); PG8_MMA(0, 1, At, B1); PG8_BAR;
            PG8_LDA(At, 0, 1); PG8_STAGE_A(PG8_SA(0, 0), a2, 0, last);
            PG8_BAR; PG8_WAIT_L(0); PG8_MMA(1, 0, At, B0); PG8_BAR; PG8_SCHED;
            PG8_STAGE(PG8_SB(0, 1), b2 + hstep, voffB);
            PG8_WAIT_V(6); PG8_BAR; PG8_MMA(1, 1, At, B1); PG8_BAR;
            PG8_LDB(B0, 1, 0); PG8_SCHED; PG8_LDA(At, 1, 0); PG8_STAGE_A(PG8_SA(0, 1), a2, 1, last);
            PG8_WAIT_L(8); PG8_BAR; PG8_WAIT_L(0); PG8_MMA(0, 0, At, B0); PG8_BAR; PG8_SCHED;
            PG8_LDB(B1, 1, 1); PG8_STAGE(PG8_SB(1, 0), b3, voffB);
            PG8_BAR; PG8_WAIT_L(0); PG8_MMA(0, 1, At, B1); PG8_BAR;
            PG8_LDA(At, 1, 1); PG8_STAGE_A(PG8_SA(1, 0), a3, 0, last);
            PG8_BAR; PG8_WAIT_L(0); PG8_MMA(1, 0, At, B0); PG8_BAR; PG8_SCHED;
            PG8_STAGE(PG8_SB(1, 1), b3 + hstep, voffB);
            PG8_WAIT_V(6); PG8_BAR; PG8_MMA(1, 1, At, B1); PG8_BAR;
            }
        }
        if constexpr (ALIGN_EPI) { if (wr == 0) PG8_BAR; }
        if constexpr (!Epi::AFTER_DRAIN) { E(acc, cur, wr, wc, fr, fq); S.done(cur); }
        if (!has_next) break;
#pragma unroll
        for (int a = 0; a < 2; ++a)
#pragma unroll
            for (int b = 0; b < 2; ++b)
#pragma unroll
                for (int m = 0; m < 4; ++m)
#pragma unroll
                    for (int n = 0; n < 2; ++n) acc[a][b][m][n] = (f32x4){0.f, 0.f, 0.f, 0.f};
        cur = nxt; cA = nA; cB = nB; ++ui;
        if constexpr (GA) {
#pragma unroll
            for (int _h = 0; _h < 2; ++_h) { vA[_h][0] = vAn[_h][0]; vA[_h][1] = vAn[_h][1]; } }
        if constexpr (ALIGN_EPI) { if (wr == 1) PG8_BAR; }
    }
    PG8_WAIT_V(0);
    if constexpr (!ALIGN_EPI) { if (wr == 0) PG8_BAR; }
    PG8_BAR;
    if constexpr (Epi::AFTER_DRAIN) { E.fused(acc, cur, wr, wc, fr, fq, lds, wid, lane); S.done(cur); }
#undef PG8_SA
#undef PG8_SB
#undef PG8_STAGE
#undef PG8_STAGE_A
#undef PG8_GATH
#undef PG8_LDA
#undef PG8_LDB
#undef PG8_MMA
#undef PG8_WAIT_V
#undef PG8_WAIT_L
#undef PG8_BAR
#undef PG8_SCHED
}
}
#endif

constexpr int LDT = 72;
constexpr int GEMM_AS = 256 * LDT, GEMM_BS = 128 * LDT;
constexpr int GEMM_LDS = 2 * (GEMM_AS + GEMM_BS) * 2;

template <class AF, class EPI>
DEV void gemm_tile(unsigned char* smem, AF af, const bf16* Bt, int ldb, int nvalid, int K, EPI& epi) {
    const int tid = TID, w = tid >> 6, l = tid & 63, h = l >> 4, c = l & 15, wm = w >> 1, wn = w & 1;
    bf16* As = (bf16*)smem; bf16* Bs = As + 2 * GEMM_AS;
    const bf16* ap[4]; const bf16* bp[2];
    const int col8 = (tid & 7) * 8, r0 = tid >> 3;
#pragma unroll
    for (int i = 0; i < 4; ++i) ap[i] = af(r0 + 64 * i) + col8;
#pragma unroll
    for (int i = 0; i < 2; ++i) { int rn = r0 + 64 * i; if (rn >= nvalid) rn = nvalid - 1; bp[i] = Bt + (size_t)rn * ldb + col8; }
    f32x4 acc[4][4];
#pragma unroll
    for (int i = 0; i < 4; ++i)
#pragma unroll
        for (int j = 0; j < 4; ++j) acc[i][j] = f4zero();
    bf16x8 ra[4], rb[2];
#pragma unroll
    for (int i = 0; i < 4; ++i) ra[i] = *(const bf16x8*)(ap[i]);
#pragma unroll
    for (int i = 0; i < 2; ++i) rb[i] = *(const bf16x8*)(bp[i]);
    SYNC();
#pragma unroll
    for (int i = 0; i < 4; ++i) *(bf16x8*)(As + (r0 + 64 * i) * LDT + col8) = ra[i];
#pragma unroll
    for (int i = 0; i < 2; ++i) *(bf16x8*)(Bs + (r0 + 64 * i) * LDT + col8) = rb[i];
    SYNC();
    const int nk = K / 64;
    for (int kt = 0; kt < nk; ++kt) {
        const int cur = kt & 1;
        if (kt + 1 < nk) {
#pragma unroll
            for (int i = 0; i < 4; ++i) ra[i] = *(const bf16x8*)(ap[i] + (kt + 1) * 64);
#pragma unroll
            for (int i = 0; i < 2; ++i) rb[i] = *(const bf16x8*)(bp[i] + (kt + 1) * 64);
        }
        const bf16* Ac = As + cur * GEMM_AS + (wm * 64 + c) * LDT + 8 * h;
        const bf16* Bc = Bs + cur * GEMM_BS + (wn * 64 + c) * LDT + 8 * h;
#pragma unroll
        for (int kk = 0; kk < 2; ++kk) {
            bf16x8 fa[4], fb[4];
#pragma unroll
            for (int i = 0; i < 4; ++i) { fa[i] = *(const bf16x8*)(Ac + i * 16 * LDT + kk * 32); fb[i] = *(const bf16x8*)(Bc + i * 16 * LDT + kk * 32); }
#pragma unroll
            for (int ni = 0; ni < 4; ++ni)
#pragma unroll
                for (int mi = 0; mi < 4; ++mi) acc[ni][mi] = mfma16(fb[ni], fa[mi], acc[ni][mi]);
        }
        if (kt + 1 < nk) {
            const int nx = cur ^ 1;
#pragma unroll
            for (int i = 0; i < 4; ++i) *(bf16x8*)(As + nx * GEMM_AS + (r0 + 64 * i) * LDT + col8) = ra[i];
#pragma unroll
            for (int i = 0; i < 2; ++i) *(bf16x8*)(Bs + nx * GEMM_BS + (r0 + 64 * i) * LDT + col8) = rb[i];
        }
        SYNC();
    }
    epi(acc, wm * 64, wn * 64, h, c);
}

struct ARows { const bf16* base; size_t ld; MDEV const bf16* operator()(int r) const { return base + (size_t)r * ld; } MDEV unsigned off(int r) const { return (unsigned)r * (unsigned)ld; } };

constexpr int LDB = 144;
constexpr int GEMM_BS2 = 64 * LDB;
constexpr int GEMM2_LDS = (2 * GEMM_AS + 2 * GEMM_BS2) * 2;
DEV bf16x8 tr_read8(const bf16* p0, const bf16* p1) {
    const s16x4 x = tr4(p0), y = tr4(p1); bf16x8 r;
    r[0] = x[0]; r[1] = x[1]; r[2] = x[2]; r[3] = x[3]; r[4] = y[0]; r[5] = y[1]; r[6] = y[2]; r[7] = y[3]; return r;
}
DEV int bperm(int r) { return (r & ~12) | ((r & 4) << 1) | ((r & 8) >> 1); }
template <class AF, class BF, class EPI>
DEV void gemm_tile2(unsigned char* smem, AF af, BF bf, int ldb, int K, EPI& epi) {
    const int tid = TID, w = tid >> 6, l = tid & 63, h = l >> 4, c = l & 15, wm = w >> 1, wn = w & 1, grp = w >> 2;
    bf16* As = (bf16*)smem; bf16* Bs = As + 2 * GEMM_AS;
    const bf16* abase = af.base; unsigned ao[4];
    const int col8 = (tid & 7) * 8, r0 = tid >> 3;
#pragma unroll
    for (int i = 0; i < 4; ++i) ao[i] = af.off(r0 + 64 * i) + col8;
    const int bn4 = (tid & 31) * 4, bk = tid >> 5, bkp = bperm(bk);
    const float* bp = bf(bn4); const bool bok = bp != nullptr;
    if (bok) bp += (size_t)bk * ldb;
    const size_t bstep = (size_t)16 * ldb;
    f32x4 acc[4][4];
#pragma unroll
    for (int i = 0; i < 4; ++i)
#pragma unroll
        for (int j = 0; j < 4; ++j) acc[i][j] = f4zero();
    bf16x8 ra[4]; f32x4 rb[4];
    const int nk = K / 64;
#pragma unroll
    for (int i = 0; i < 4; ++i) { ra[i] = *(const bf16x8*)(abase + ao[i]); rb[i] = bok ? *(const f32x4*)(bp + i * bstep) : f4zero(); }
    SYNC();
#pragma unroll
    for (int i = 0; i < 4; ++i) { *(bf16x8*)(As + (r0 + 64 * i) * LDT + col8) = ra[i]; st_bf4(Bs + (bkp + 16 * i) * LDB + bn4, rb[i]); }
    if (nk > 1) {
#pragma unroll
        for (int i = 0; i < 4; ++i) { ra[i] = *(const bf16x8*)(abase + (ao[i] + 64)); rb[i] = bok ? *(const f32x4*)(bp + (size_t)64 * ldb + i * bstep) : f4zero(); } }
    SYNC();
    for (int kt = 0; kt < nk; ++kt) {
        const int cur = kt & 1;
#pragma unroll
        for (int p = 0; p < 2; ++p) {
            if (grp == p) {
                const bf16* Ac = As + cur * GEMM_AS + (wm * 64 + c) * LDT + 8 * h;
                const bf16* Bc = Bs + cur * GEMM_BS2 + bperm(8 * h + (c >> 2)) * LDB + wn * 64 + 4 * (c & 3);
#pragma unroll
                for (int kk = 0; kk < 2; ++kk) {
                    bf16x8 fa[4], fb[4];
#pragma unroll
                    for (int i = 0; i < 4; ++i) { fa[i] = *(const bf16x8*)(Ac + i * 16 * LDT + kk * 32); fb[i] = tr_read8(Bc + (32 * kk) * LDB + 16 * i, Bc + (32 * kk + 8) * LDB + 16 * i); }
#pragma unroll
                    for (int ni = 0; ni < 4; ++ni)
#pragma unroll
                        for (int mi = 0; mi < 4; ++mi) acc[ni][mi] = mfma16(fb[ni], fa[mi], acc[ni][mi]);
                }
            } else if (kt + 1 < nk) {
                const int nx = cur ^ 1;
#pragma unroll
                for (int i = 0; i < 4; ++i) { *(bf16x8*)(As + nx * GEMM_AS + (r0 + 64 * i) * LDT + col8) = ra[i]; st_bf4(Bs + nx * GEMM_BS2 + (bkp + 16 * i) * LDB + bn4, rb[i]); }
                if (kt + 2 < nk) {
#pragma unroll
                    for (int i = 0; i < 4; ++i) { ra[i] = *(const bf16x8*)(abase + (ao[i] + (kt + 2) * 64)); rb[i] = bok ? *(const f32x4*)(bp + (size_t)(kt + 2) * 64 * ldb + i * bstep) : f4zero(); } }
            }
            SYNC();
        }
    }
    epi(acc, wm * 64, wn * 64, h, c);
}
struct BPlain { const float* base; MDEV const float* operator()(int nt) const { return base + nt; } };
struct BInProjMap { const float* base; int n0; MDEV const float* operator()(int nt) const { const int n = n0 + nt; const int sc = n < 1280 ? n : (n < 3328 ? n + 24 : (n < 3352 ? 1280 + (n - 3328) : -1)); return sc < 0 ? nullptr : base + sc; } };
struct BInter { const float* s0; const float* s1; int n0; MDEV const float* operator()(int nt) const { const int n = n0 + nt, g = n >> 6, w = n & 63; return w < 32 ? s0 + g * 32 + w : s1 + g * 32 + w - 32; } };
struct BClamp64 { const float* base; MDEV const float* operator()(int nt) const { return base + (nt & 63); } };

struct EpiInProj {
    const Args* a; int m0, n0, li;
    MDEV void operator()(f32x4 (&acc)[4][4], int mw, int nw, int h, int c) const {
        unsigned char* ws = wsp(*a);
        const int nb = n0 + nw;
        const int tokb = m0 + mw + c;
        if (nb < 512 || (nb >= 768 && nb < 896) || (nb >= 1024 && nb < 1152)) {
            const float* gain; float mul = 1.f; bf16* dst; int kind;
            if (nb < 512) { gain = INP(*a, I_QG) + li * 64; mul = 0.125f * LOG2E; kind = 0; dst = (bf16*)(ws + WS_QN); }
            else if (nb < 896) { gain = INP(*a, I_KG) + (li * 3 + 1) * 64; kind = 1; dst = (bf16*)(ws + WS_KS); }
            else { gain = INP(*a, I_KG) + (li * 3 + 2) * 64; kind = 1; dst = (bf16*)(ws + WS_KW); }
            const int g = (nb >> 6) & 1;
#pragma unroll
            for (int mi = 0; mi < 4; ++mi) {
                float ss = 0.f;
#pragma unroll
                for (int ni = 0; ni < 4; ++ni) { f32x4 v = acc[ni][mi]; ss += v[0] * v[0] + v[1] * v[1] + v[2] * v[2] + v[3] * v[3]; }
                ss += shflx(ss, 16); ss += shflx(ss, 32);
                const float rs = frsq(ss * (1.0f / 64.0f) + EPS) * mul;
                const int tok = tokb + 16 * mi;
#pragma unroll
                for (int ni = 0; ni < 4; ++ni) {
                    const int d = 16 * ni + 4 * h; f32x4 v = acc[ni][mi], o;
#pragma unroll
                    for (int r = 0; r < 4; ++r) o[r] = v[r] * rs * gain[d + r];
                    if (kind == 0) st_bf4(dst + (size_t)tok * 512 + nb + d, o);
                    else { const int b = tok / SEQ, s = tok % SEQ; st_bf4(dst + ((size_t)(b * 2 + g) * SEQ + s) * 64 + d, o); }
                }
            }
        } else if (nb < 768) {
            bf16* dst = (bf16*)(ws + (nb < 640 ? WS_KCG : WS_VCG)); const int g = (nb >> 6) & 1;
#pragma unroll
            for (int mi = 0; mi < 4; ++mi) { const int tok = tokb + 16 * mi, b = tok / SEQ, s = tok % SEQ;
#pragma unroll
                for (int ni = 0; ni < 4; ++ni) st_bf4(dst + ((size_t)(b * 2 + g) * SEQ + s) * 64 + 16 * ni + 4 * h, acc[ni][mi]); }
        } else if (nb < 1280) {
            bf16* dst = (bf16*)(ws + (nb < 1024 ? WS_VST : WS_VWT)); const int g = (nb >> 6) & 1;
#pragma unroll
            for (int mi = 0; mi < 4; ++mi) { const int tok = tokb + 16 * mi, b = tok / SEQ, s = tok % SEQ;
                bf16* p = dst + ((size_t)(b * 2 + g) * NCH + (s >> 6)) * 4096 + (s & 63);
#pragma unroll
                for (int ni = 0; ni < 4; ++ni)
#pragma unroll
                    for (int r = 0; r < 4; ++r) p[(16 * ni + 4 * h + r) * 64] = (bf16)f2bf(acc[ni][mi][r]); }
        } else if (nb < 3328) {
            const int sec = (nb - 1280) >> 9, cc = (nb - 1280) & 511, hh = cc >> 7, d0 = cc & 127;
#pragma unroll
            for (int mi = 0; mi < 4; ++mi) { const int tok = tokb + 16 * mi, b = tok / SEQ, s = tok % SEQ;
                const size_t hrow = ((size_t)(b * 4 + hh) * SEQ + s) * 128 + d0;
#pragma unroll
                for (int ni = 0; ni < 4; ++ni) { const int d = 16 * ni + 4 * h; f32x4 v = acc[ni][mi], o;
                    if (sec == 0) { for (int r = 0; r < 4; ++r) o[r] = siluf(v[r]); st_bf4((bf16*)(ws + WS_HQ) + hrow + d, o); }
                    else if (sec == 1) { const float* lb = (const float*)(ws + WS_LB) + li * 512 + cc + d;
                        for (int r = 0; r < 4; ++r) o[r] = lb[r] + (1.0f - lb[r]) * sigm(v[r]);
                        *(f32x4*)((float*)(ws + WS_HF) + hrow + d) = o; }
                    else if (sec == 2) st_bf4((bf16*)(ws + WS_HV) + hrow + d, v);
                    else { for (int r = 0; r < 4; ++r) o[r] = siluf(v[r]); st_bf4((bf16*)(ws + WS_HGS) + (size_t)tok * 512 + cc + d, o); }
                } }
        } else if (nb == 3328) {
            float* dst = (float*)(ws + WS_GATE);
#pragma unroll
            for (int mi = 0; mi < 4; ++mi) { const int tok = tokb + 16 * mi;
#pragma unroll
                for (int ni = 0; ni < 2; ++ni)
#pragma unroll
                    for (int r = 0; r < 4; ++r) { const int n = 16 * ni + 4 * h + r; if (n < 24) dst[(size_t)tok * 24 + n] = sigm(acc[ni][mi][r]); } }
        }
    }
};

struct EpiResid {
    float* x; const float* gate; int m0, n0;
    MDEV void operator()(f32x4 (&acc)[4][4], int mw, int nw, int h, int c) const {
#pragma unroll
        for (int mi = 0; mi < 4; ++mi) { const int tok = m0 + mw + 16 * mi + c, b = tok / SEQ;
#pragma unroll
            for (int ni = 0; ni < 4; ++ni) { const int n = n0 + nw + 16 * ni + 4 * h;
                f32x4 g = *(const f32x4*)(gate + (size_t)b * 6 * DM + n); f32x4* p = (f32x4*)(x + (size_t)tok * DM + n); f32x4 v = *p;
#pragma unroll
                for (int r = 0; r < 4; ++r) v[r] += g[r] * acc[ni][mi][r];
                *p = v; } }
    }
};
template <int MODE> struct EpiGated {
    bf16* dst; size_t ld; int m0, n0, mvalid;
    MDEV void operator()(f32x4 (&acc)[4][4], int mw, int nw, int h, int c) const {
        const int cb = (n0 + nw) / 2;
#pragma unroll
        for (int mi = 0; mi < 4; ++mi) { const int m = mw + 16 * mi + c; if (m >= mvalid) continue;
#pragma unroll
            for (int ni = 0; ni < 2; ++ni) { f32x4 o;
#pragma unroll
                for (int r = 0; r < 4; ++r) { const float av = acc[ni][mi][r], bv = acc[ni + 2][mi][r]; o[r] = MODE == 0 ? av * sigm(bv) : siluf(av) * bv; }
                st_bf4(dst + (size_t)(m0 + m) * ld + cb + 16 * ni + 4 * h, o); } }
    }
};
struct EpiStoreBf {
    bf16* dst; size_t ld; int m0, n0, mvalid;
    MDEV void operator()(f32x4 (&acc)[4][4], int mw, int nw, int h, int c) const {
#pragma unroll
        for (int mi = 0; mi < 4; ++mi) { const int m = mw + 16 * mi + c; if (m >= mvalid) continue;
#pragma unroll
            for (int ni = 0; ni < 4; ++ni) st_bf4(dst + (size_t)(m0 + m) * ld + n0 + nw + 16 * ni + 4 * h, acc[ni][mi]); }
    }
};
struct EpiCmp {
    const Args* a; int kv, bg, m0, li;
    MDEV void operator()(f32x4 (&acc)[4][4], int mw, int nw, int h, int c) const {
        if (nw != 0) return;
        unsigned char* ws = wsp(*a);
        const float* bp8 = (const float*)(ws + WS_CB) + (li * 2 + kv) * 8 * 64;
        float bias[16];
#pragma unroll
        for (int q = 0; q < 16; ++q) { const int e = 16 * (q >> 2) + 4 * h + (q & 3); float v = 0.f;
#pragma unroll
            for (int kp = 0; kp < 8; ++kp) v += bp8[kp * 64 + e];
            bias[q] = v; }
        const float* gain = INP(*a, I_KG) + (li * 3 + 0) * 64;
#pragma unroll
        for (int mi = 0; mi < 4; ++mi) { const int n = m0 + mw + 16 * mi + c; const bool ok = n < NCMP;
            f32x4 v[4]; float ss = 0.f;
#pragma unroll
            for (int ni = 0; ni < 4; ++ni) { v[ni] = acc[ni][mi];
#pragma unroll
                for (int r = 0; r < 4; ++r) { v[ni][r] += bias[4 * ni + r]; ss += v[ni][r] * v[ni][r]; } }
            ss += shflx(ss, 16); ss += shflx(ss, 32);
            if (n >= NCP) continue;
            if (kv == 0) { const float rs = frsq(ss * (1.0f / 64.0f) + EPS); bf16* p = (bf16*)(ws + WS_KC) + ((size_t)bg * NCP + n) * 64;
#pragma unroll
                for (int ni = 0; ni < 4; ++ni) { f32x4 o;
#pragma unroll
                    for (int r = 0; r < 4; ++r) o[r] = ok ? v[ni][r] * rs * gain[16 * ni + 4 * h + r] : 0.f;
                    st_bf4(p + 16 * ni + 4 * h, o); }
            } else { bf16* p = (bf16*)(ws + WS_VCT) + ((size_t)bg * NCP + n) * 64;
#pragma unroll
                for (int ni = 0; ni < 4; ++ni) { f32x4 o;
#pragma unroll
                    for (int r = 0; r < 4; ++r) o[r] = ok ? v[ni][r] : 0.f;
                    st_bf4(p + 16 * ni + 4 * h, o); } }
        }
    }
};


struct EpiResid8 {
    static constexpr bool PERM = true, AFTER_DRAIN = false;
    float* x; const float* gate; const float* xin;
    MDEV void operator()(const f32x4 (&acc)[2][2][4][2], const pg8::Unit& u, int wr, int wc, int fr, int fq) const {
        OPAQUE2(fr, fq);
#pragma unroll
        for (int ai = 0; ai < 2; ++ai)
#pragma unroll
            for (int m = 0; m < 4; ++m) { const int row = 256 * u.pm + 128 * ai + 64 * wr + 16 * m + fr, b = row / SEQ;
#pragma unroll
                for (int bj = 0; bj < 2; ++bj)
#pragma unroll
                    for (int n = 0; n < 2; ++n) { const int col = 256 * u.pn + 128 * bj + 32 * wc + 8 * fq + 4 * n;
                        const f32x4 g = *(const f32x4*)(gate + (size_t)b * 6 * DM + col); f32x4* p = (f32x4*)(x + (size_t)row * DM + col); f32x4 v = *(const f32x4*)(xin + (size_t)row * DM + col);
#pragma unroll
                        for (int r = 0; r < 4; ++r) v[r] += g[r] * acc[ai][bj][m][n][r];
                        *p = v; } }
    }
};
struct EpiGlu8 {
    static constexpr bool PERM = true, AFTER_DRAIN = false;
    bf16* dst;
    MDEV void operator()(const f32x4 (&acc)[2][2][4][2], const pg8::Unit& u, int wr, int wc, int fr, int fq) const {
        OPAQUE2(fr, fq);
#pragma unroll
        for (int ai = 0; ai < 2; ++ai)
#pragma unroll
            for (int m = 0; m < 4; ++m) { const int row = 256 * u.pm + 128 * ai + 64 * wr + 16 * m + fr;
#pragma unroll
                for (int bj = 0; bj < 2; ++bj) { const int col = 128 * u.pn + 64 * bj + 16 * wc + 4 * fq; f32x4 o;
#pragma unroll
                    for (int r = 0; r < 4; ++r) o[r] = acc[ai][bj][m][0][r] * sigm(acc[ai][bj][m][1][r]);
                    st_bf4(dst + (size_t)row * DM + col, o); } }
    }
};
struct EpiMoe1_8 {
    static constexpr bool PERM = true, AFTER_DRAIN = false;
    bf16* dst;
    MDEV void operator()(const f32x4 (&acc)[2][2][4][2], const pg8::Unit& u, int wr, int wc, int fr, int fq) const {
        OPAQUE2(fr, fq);
#pragma unroll
        for (int ai = 0; ai < 2; ++ai)
#pragma unroll
            for (int m = 0; m < 4; ++m) { const int row = 256 * u.pm + 128 * ai + 64 * wr + 16 * m + fr;
#pragma unroll
                for (int bj = 0; bj < 2; ++bj) { const int col = 128 * u.pn + 64 * bj + 16 * wc + 4 * fq; f32x4 o;
#pragma unroll
                    for (int r = 0; r < 4; ++r) o[r] = siluf(acc[ai][bj][m][0][r]) * acc[ai][bj][m][1][r];
#ifdef EMU
                    st_bf4(dst + (size_t)row * FF + col, o); } }
#else
                    const unsigned long long pk = (unsigned long long)pk2(o[0], o[1]) | ((unsigned long long)pk2(o[2], o[3]) << 32);
                    __hip_atomic_store((__attribute__((address_space(1))) unsigned long long*)(dst + (size_t)row * FF + col), pk, __ATOMIC_RELAXED, __HIP_MEMORY_SCOPE_AGENT); } }
#endif
    }
};
struct EpiMoe2_8 {
    static constexpr bool PERM = true, AFTER_DRAIN = false;
    bf16* dst;
    MDEV void operator()(const f32x4 (&acc)[2][2][4][2], const pg8::Unit& u, int wr, int wc, int fr, int fq) const {
        OPAQUE2(fr, fq);
#pragma unroll
        for (int ai = 0; ai < 2; ++ai)
#pragma unroll
            for (int m = 0; m < 4; ++m) { const int row = 256 * u.pm + 128 * ai + 64 * wr + 16 * m + fr;
#pragma unroll
                for (int bj = 0; bj < 2; ++bj) { const int col = 256 * u.pn + 128 * bj + 32 * wc + 8 * fq;
                    st_bf8(dst + (size_t)row * DM + col, acc[ai][bj][m][0], acc[ai][bj][m][1]); } }
    }
};
DEV unsigned uni(unsigned x);
template <bool G> struct MoeSel {
    static constexpr bool GATHER = G;
    const int* rb; const int* cnt; const int* list; size_t bstride;
    struct Ctx { int e, rbase, c; };
    MDEV Ctx ctx(const pg8::Unit& u) const { int e = 0;
#pragma unroll 1
        for (int q = 1; q < 32; ++q) if ((rb[q] >> 8) <= u.pm) e = q;
        e = (int)uni((unsigned)e); Ctx x; x.e = e; x.rbase = (int)uni((unsigned)((u.pm << 8) - rb[e])); x.c = G ? (int)uni((unsigned)cnt[e * 64]) : 0; return x; }
    MDEV size_t boff(const Ctx& x) const { return (size_t)x.e * bstride; }
    MDEV unsigned aoff(const Ctx& x, int r) const { int p = x.rbase + r; if (p > x.c - 1) p = x.c - 1; return (unsigned)list[(size_t)x.e * T + p] * (unsigned)(DM * 2); }
};
struct EpiInProj8 {
    static constexpr bool PERM = true, AFTER_DRAIN = false;
    const Args* a; int li;
    MDEV void operator()(const f32x4 (&acc)[2][2][4][2], const pg8::Unit& u, int wr, int wc, int fr, int fq) const {
        OPAQUE2(fr, fq);
        unsigned char* ws = wsp(*a);
        const int nb = 256 * u.pn + 64 * wc;
        if (nb >= 3392) return;
        if (nb < 512 || (nb >= 768 && nb < 896) || (nb >= 1024 && nb < 1152)) {
            const float* gain; float mul = 1.f; int kind;
            if (nb < 512) { gain = INP(*a, I_QG) + li * 64; mul = 0.125f * LOG2E; kind = 0; }
            else if (nb < 896) { gain = INP(*a, I_KG) + (li * 3 + 1) * 64; kind = 1; }
            else { gain = INP(*a, I_KG) + (li * 3 + 2) * 64; kind = 2; }
            const int g = (nb >> 6) & 1;
            f32x4 gv[2][2];
#pragma unroll
            for (int bj = 0; bj < 2; ++bj)
#pragma unroll
                for (int n = 0; n < 2; ++n) gv[bj][n] = *(const f32x4*)(gain + 32 * bj + 8 * fq + 4 * n);
#pragma unroll
            for (int ai = 0; ai < 2; ++ai)
#pragma unroll
                for (int m = 0; m < 4; ++m) { const int tok = 256 * u.pm + 128 * ai + 64 * wr + 16 * m + fr;
                    float ss = 0.f;
#pragma unroll
                    for (int bj = 0; bj < 2; ++bj)
#pragma unroll
                        for (int n = 0; n < 2; ++n) { const f32x4 v = acc[ai][bj][m][n]; ss += v[0] * v[0] + v[1] * v[1] + v[2] * v[2] + v[3] * v[3]; }
                    ss += shflx(ss, 16); ss += shflx(ss, 32);
                    const float rs = frsq(ss * (1.0f / 64.0f) + EPS) * mul;
                    bf16* dst; if (kind == 0) dst = (bf16*)(ws + WS_QN) + (size_t)tok * 512 + nb; else { const int b = tok / SEQ, sq = tok % SEQ; dst = (bf16*)(ws + (kind == 1 ? WS_KS : WS_KW)) + ((size_t)(b * 2 + g) * SEQ + sq) * 64; }
#pragma unroll
                    for (int bj = 0; bj < 2; ++bj) { f32x4 o0, o1;
#pragma unroll
                        for (int r = 0; r < 4; ++r) { o0[r] = acc[ai][bj][m][0][r] * rs * gv[bj][0][r]; o1[r] = acc[ai][bj][m][1][r] * rs * gv[bj][1][r]; }
                        st_bf8(dst + 32 * bj + 8 * fq, o0, o1); } }
        } else if (nb < 768) {
            bf16* base = (bf16*)(ws + (nb < 640 ? WS_KCG : WS_VCG)); const int g = (nb >> 6) & 1;
#pragma unroll
            for (int ai = 0; ai < 2; ++ai)
#pragma unroll
                for (int m = 0; m < 4; ++m) { const int tok = 256 * u.pm + 128 * ai + 64 * wr + 16 * m + fr, b = tok / SEQ, sq = tok % SEQ;
#pragma unroll
                    for (int bj = 0; bj < 2; ++bj) st_bf8(base + ((size_t)(b * 2 + g) * SEQ + sq) * 64 + 32 * bj + 8 * fq, acc[ai][bj][m][0], acc[ai][bj][m][1]); }
        } else if (nb < 1280) {
            bf16* base = (bf16*)(ws + (nb < 1024 ? WS_VST : WS_VWT)); const int g = (nb >> 6) & 1;
#pragma unroll
            for (int ai = 0; ai < 2; ++ai)
#pragma unroll
                for (int m = 0; m < 4; ++m) { const int tok = 256 * u.pm + 128 * ai + 64 * wr + 16 * m + fr, b = tok / SEQ, sq = tok % SEQ;
#pragma unroll
                    for (int bj = 0; bj < 2; ++bj) st_bf8(base + ((size_t)(b * 2 + g) * SEQ + sq) * 64 + 32 * bj + 8 * fq, acc[ai][bj][m][0], acc[ai][bj][m][1]); }
        } else if (nb < 3328) {
            const int sec = (nb - 1280) >> 9, cc = (nb - 1280) & 511, hh = cc >> 7, d0 = cc & 127;
            f32x4 lbv[2][2];
            if (sec == 1) {
#pragma unroll
                for (int bj = 0; bj < 2; ++bj)
#pragma unroll
                    for (int n = 0; n < 2; ++n) lbv[bj][n] = *(const f32x4*)((const float*)(ws + WS_LB) + li * 512 + cc + 32 * bj + 8 * fq + 4 * n); }
#pragma unroll
            for (int ai = 0; ai < 2; ++ai)
#pragma unroll
                for (int m = 0; m < 4; ++m) { const int tok = 256 * u.pm + 128 * ai + 64 * wr + 16 * m + fr, b = tok / SEQ, sq = tok % SEQ;
                    const size_t hrow = ((size_t)(b * 4 + hh) * SEQ + sq) * 128 + d0;
#pragma unroll
                    for (int bj = 0; bj < 2; ++bj) { const int d = 32 * bj + 8 * fq; f32x4 o0, o1;
                        if (sec == 0) {
#pragma unroll
                            for (int r = 0; r < 4; ++r) { o0[r] = siluf(acc[ai][bj][m][0][r]); o1[r] = siluf(acc[ai][bj][m][1][r]); }
                            st_bf8((bf16*)(ws + WS_HQ) + hrow + d, o0, o1); }
                        else if (sec == 1) {
#pragma unroll
                            for (int r = 0; r < 4; ++r) { o0[r] = lbv[bj][0][r] + (1.0f - lbv[bj][0][r]) * sigm(acc[ai][bj][m][0][r]); o1[r] = lbv[bj][1][r] + (1.0f - lbv[bj][1][r]) * sigm(acc[ai][bj][m][1][r]); }
                            float* pf = (float*)(ws + WS_HF) + hrow + d; *(f32x4*)pf = o0; *(f32x4*)(pf + 4) = o1; }
                        else if (sec == 2) st_bf8((bf16*)(ws + WS_HV) + hrow + d, acc[ai][bj][m][0], acc[ai][bj][m][1]);
                        else {
#pragma unroll
                            for (int r = 0; r < 4; ++r) { o0[r] = siluf(acc[ai][bj][m][0][r]); o1[r] = siluf(acc[ai][bj][m][1][r]); }
                            st_bf8((bf16*)(ws + WS_HGS) + (size_t)tok * 512 + cc + d, o0, o1); } } }
        } else {
            float* dst = (float*)(ws + WS_GATE);
            if (fq < 3) {
#pragma unroll
                for (int ai = 0; ai < 2; ++ai)
#pragma unroll
                    for (int m = 0; m < 4; ++m) { const int tok = 256 * u.pm + 128 * ai + 64 * wr + 16 * m + fr; f32x4 o0, o1;
#pragma unroll
                        for (int r = 0; r < 4; ++r) { o0[r] = sigm(acc[ai][0][m][0][r]); o1[r] = sigm(acc[ai][0][m][1][r]); }
                        float* pf = dst + (size_t)tok * 24 + 8 * fq; *(f32x4*)pf = o0; *(f32x4*)(pf + 4) = o1; } }
        }
    }
};

DEV void tr_tile(unsigned char* smem, const float* src0, const float* src1, int ld, int K, int mode, bf16* dst, int n0, int k0) {
    bf16* tl = (bf16*)smem;
    const int tid = TID;
    SYNC();
#pragma unroll
    for (int i = 0; i < 8; ++i) {
        const int e = tid + 512 * i, kk = e >> 6, nn = e & 63, n = n0 + nn; float v = 0.f;
        if (mode == 0) v = src0[(size_t)(k0 + kk) * ld + n];
        else if (mode == 1) { int sc = n < 1280 ? n : (n < 3328 ? n + 24 : (n < 3352 ? 1280 + (n - 3328) : -1)); if (sc >= 0) v = src0[(size_t)(k0 + kk) * ld + sc]; }
        else { const int g = n >> 6, w = n & 63; v = (w < 32) ? src0[(size_t)(k0 + kk) * ld + g * 32 + w] : src1[(size_t)(k0 + kk) * ld + g * 32 + w - 32]; }
        tl[nn * LDT + kk] = (bf16)f2bf(v);
    }
    SYNC();
    const int nn = tid >> 3, k8 = (tid & 7) * 8;
    *(bf16x8*)(dst + (size_t)(n0 + nn) * K + k0 + k8) = *(const bf16x8*)(tl + nn * LDT + k8);
}

DEV int tr_col(int mode, int n) {
    if (mode == 0) return n;
    const int pn = n >> 8, ct = n & 255;
    if (mode == 5) { const int bj = ct >> 7, wc = (ct >> 5) & 3, j = ct & 31, L = 256 * pn + 64 * wc + 32 * bj + j; return L < 1280 ? L : (L < 3328 ? L + 24 : (L < 3352 ? 1280 + (L - 3328) : -1)); }
    { const int bj = ct >> 7, wc = (ct >> 5) & 3, j = ct & 31, nn = (j >> 2) & 1, Lc = 128 * pn + 64 * bj + 16 * wc + 4 * (j >> 3) + (j & 3); return nn == 0 ? Lc : (mode == 7 ? FF : DM) + Lc; }
}
DEV void tr_tile(unsigned char* smem, const float* src, int ld, int K, int mode, bf16* dst, int n0, int k0) {
    bf16* tl = (bf16*)smem;
    const int tid = TID, nq = tid & 31, kq = tid >> 5;
    const int sc = tr_col(mode, n0 + 4 * nq);
    f32x4 v[4];
#pragma unroll
    for (int i = 0; i < 4; ++i) v[i] = sc >= 0 ? *(const f32x4*)(src + (size_t)(k0 + 4 * kq + i) * ld + sc) : f4zero();
    SYNC();
#pragma unroll
    for (int j = 0; j < 4; ++j) { u32x2 w; w[0] = pk2(v[0][j], v[1][j]); w[1] = pk2(v[2][j], v[3][j]); *(u32x2*)(tl + (4 * nq + j) * LDT + 4 * kq) = w; }
    SYNC();
#pragma unroll
    for (int t = 0; t < 2; ++t) { const int id = tid + 512 * t, row = id >> 3, ch = id & 7;
        *(bf16x8*)(dst + (size_t)(n0 + row) * K + k0 + 8 * ch) = *(const bf16x8*)(tl + row * LDT + 8 * ch); }
}
constexpr int KSUP = FF >= 256 ? 256 : FF, NSUP = KSUP / 64;
DEV void tr_super(unsigned char* smem, const float* src0, const float* src1, int ld, int K, int mode, bf16* dst, int n0, int k0) {
    const int tid = TID, nq = tid & 31, kq = tid >> 5;
    int sc = n0 + 4 * nq; const float* src = src0;
    if (mode == 7) { const int cc = tr_col(7, sc); src = cc >= FF ? src1 : src0; sc = cc >= FF ? cc - FF : cc; }
    f32x4 v[NSUP][4];
#pragma unroll
    for (int sb = 0; sb < NSUP; ++sb)
#pragma unroll
        for (int i = 0; i < 4; ++i) v[sb][i] = *(const f32x4*)(src + (size_t)(k0 + 64 * sb + 4 * kq + i) * ld + sc);
    SYNC();
    const int fw = nq & (KSUP / 16 - 1);
#pragma unroll
    for (int j = 0; j < 4; ++j)
#pragma unroll
        for (int sb = 0; sb < NSUP; ++sb) { const int c16 = 8 * sb + (kq >> 1); u32x2 w; w[0] = pk2(v[sb][0][j], v[sb][1][j]); w[1] = pk2(v[sb][2][j], v[sb][3][j]);
            *(u32x2*)(smem + (4 * nq + j) * (KSUP * 2) + ((c16 ^ fw) << 4) + (kq & 1) * 8) = w; }
    SYNC();
#pragma unroll
    for (int t = 0; t < 128 * (KSUP / 8) / NT; ++t) { const int id = tid + NT * t, row = id / (KSUP / 8), ch = id % (KSUP / 8), f = (row >> 2) & (KSUP / 16 - 1);
        *(bf16x8*)(dst + (size_t)(n0 + row) * K + k0 + 8 * (ch ^ f)) = *(const bf16x8*)(smem + row * (KSUP * 2) + ch * 16); }
}
struct TrJob { const float* s; int ld, K, N, mode; bf16* dst; };
DEV void p0_phase(const Args& a, unsigned char* smem) {
    unsigned char* ws = wsp(a); const int tid = TID;
    { int item = BID, base = 0;
      for (int j = 0; j < 8; ++j) { TrJob J; const int i = j & 1;
        if (j < 2) J = {INP(a, I_WIN) + (size_t)i * DM * NIN, NIN, DM, NIN8, 5, (bf16*)(ws + WS_WIN) + (size_t)i * NIN8 * DM};
        else if (j < 4) J = {INP(a, I_WOUT) + (size_t)i * 1024 * DM, DM, 1024, DM, 0, (bf16*)(ws + WS_WOUT) + (size_t)i * DM * 1024};
        else if (j < 6) J = {INP(a, I_PW1) + (size_t)i * DM * 2 * DM, 2 * DM, DM, 2 * DM, 6, (bf16*)(ws + WS_PW1) + (size_t)i * 2 * DM * DM};
        else J = {INP(a, I_PW2) + (size_t)i * DM * DM, DM, DM, DM, 0, (bf16*)(ws + WS_PW2) + (size_t)i * DM * DM};
        const int tn = J.N / 128, tk = J.K / 64, nt = tn * tk;
        while (item < base + nt) { const int it = item - base; tr_tile(smem, J.s, J.ld, J.K, J.mode, J.dst, (it % tn) * 128, (it / tn) * 64); item += NBLK; }
        base += nt; }
      SYNC(); }
    {
        float* red = (float*)smem;
        constexpr int NG = 6 * DM / 128; const int ntask = DEPTH * NG;
        for (int t = BID; t < ntask; t += NBLK) {
            const int l = t / NG, j0 = (t % NG) * 128, cq = tid & 31, kr = tid >> 5;
            const float* w = INP(a, I_ADAW) + (size_t)l * DM * 6 * DM + j0 + 4 * cq; const float* cc = INP(a, I_C);
            f32x4 a0 = f4zero(), a1 = f4zero();
#pragma unroll 8
            for (int i = 0; i < DM / 16; ++i) { const int k = kr + 16 * i; const f32x4 wv = *(const f32x4*)(w + (size_t)k * 6 * DM); const float s0 = siluf(cc[k]), s1 = siluf(cc[DM + k]);
#pragma unroll
                for (int r = 0; r < 4; ++r) { a0[r] += s0 * wv[r]; a1[r] += s1 * wv[r]; } }
            SYNC();
            *(f32x4*)(red + (kr * 2 + 0) * 128 + 4 * cq) = a0; *(f32x4*)(red + (kr * 2 + 1) * 128 + 4 * cq) = a1;
            SYNC();
            if (tid < 256) { const int b = tid >> 7, col = tid & 127; float sum = INP(a, I_ADAB)[(size_t)l * 6 * DM + j0 + col];
#pragma unroll
                for (int q = 0; q < 16; ++q) sum += red[(q * 2 + b) * 128 + col];
                ((float*)(ws + WS_MOD))[((size_t)l * 2 + b) * 6 * DM + j0 + col] = sum; }
        }
    }
    for (int t = BID; t < 32; t += NBLK) {
        float* red = (float*)smem; const int ikv = t >> 3, kp = t & 7, i = ikv >> 1, kv = ikv & 1, e = tid & 63, ks = tid >> 6;
        const float* W = INP(a, kv ? I_CWV : I_CWK) + (size_t)i * 2048 * 64 + e; const float* pe = INP(a, I_CPE) + (size_t)i * 2048;
        float sum = 0.f;
#pragma unroll 8
        for (int q = 0; q < 32; ++q) { const int k = kp * 256 + ks * 32 + q; sum += pe[k] * W[(size_t)k * 64]; }
        SYNC(); red[ks * 64 + e] = sum; SYNC();
        if (tid < 64) { float v = 0.f; for (int q = 0; q < 8; ++q) v += red[q * 64 + tid]; ((float*)(ws + WS_CB))[(ikv * 8 + kp) * 64 + tid] = v; }
    }
    for (int i = BID * NT + tid; i < DEPTH * 48 * DM; i += NBLK * NT) { const int k = i % DM, n = (i / DM) % 48, ll = i / (48 * DM);
        const float wv = n < 4 ? INP(a, I_WG)[((size_t)ll * DM + k) * 4 + n] : (n < 36 ? INP(a, I_WE)[((size_t)ll * DM + k) * 32 + n - 4] : 0.f);
        const unsigned hi = f2bf(wv); ((bf16*)(ws + WS_WTH))[i] = (bf16)hi; ((bf16*)(ws + WS_WTL))[i] = (bf16)f2bf(wv - bf2f(hi)); }
    if (BID == 0) {
        for (int i = tid; i < DEPTH * 32; i += NT) ((int*)(ws + WS_CNT))[i * 64] = 0;
        for (int i = tid; i < DEPTH * 256; i += NT) ((unsigned*)(ws + WS_FLG))[i * 16] = 0u;
        for (int n = tid; n < 512; n += NT) { const float l0 = INP(a, I_LBL)[n], l1 = INP(a, I_LBL)[512 + n]; const float m = fmaxf(l0, l1);
            const float e0 = fexp2((l0 - m) * LOG2E), e1 = fexp2((l1 - m) * LOG2E);
            ((float*)(ws + WS_LB))[n] = 0.f; ((float*)(ws + WS_LB))[512 + n] = e1 / (e0 + e1); }
        if (tid < 2) { const int i = tid; float mq = 0.f; for (int d = 0; d < 64; ++d) mq = fmaxf(mq, fabsf(INP(a, I_QG)[i * 64 + d]));
            for (int br = 0; br < 3; ++br) { float mk = 0.f; for (int d = 0; d < 64; ++d) mk = fmaxf(mk, fabsf(INP(a, I_KG)[(i * 3 + br) * 64 + d]));
                ((float*)(ws + WS_CS))[i * 4 + br] = 8.0f * mq * mk * LOG2E; } }
    }
    SYNC();
    { constexpr int S13 = (2 * FF / 128) * (DM / KSUP), S2 = (DM / 128) * (FF / KSUP), SPE = S13 + S2, NIT = DEPTH * 32 * SPE;
#ifdef EMU
      for (int it = BID; it < NIT; it += NBLK) {
#else
      int* ctr = (int*)(ws + WS_BAR) + P0_CTR_IDX; int* nxl = (int*)(smem + 72 * 1024);
      int my_next = 0; if (tid == 0) my_next = atomic_add_i(ctr, 1);
      for (;;) { if (tid == 0) nxl[0] = my_next; SYNC(); const int it = nxl[0]; if (it >= NIT) break; if (tid == 0) my_next = atomic_add_i(ctr, 1);
#endif
        const int le = it / SPE, r = it % SPE;
        if (r < S13) { const int tn = r % (2 * FF / 128), tk = r / (2 * FF / 128);
            tr_super(smem, INP(a, I_W1) + (size_t)le * DM * FF, INP(a, I_W3) + (size_t)le * DM * FF, FF, DM, 7, (bf16*)(ws + WS_W13) + (size_t)le * 2 * FF * DM, tn * 128, tk * KSUP); }
        else { const int r2 = r - S13, tn = r2 % (DM / 128), tk = r2 / (DM / 128);
            tr_super(smem, INP(a, I_W2) + (size_t)le * FF * DM, INP(a, I_W2), DM, FF, 0, (bf16*)(ws + WS_W2) + (size_t)le * DM * FF, tn * 128, tk * KSUP); } }
      SYNC(); }
}

constexpr int NJV = DM / 256;
DEV void moe_bases(const int* cnt, int* rb  ) {
    if (TID == 0) { int acc = 0; for (int e = 0; e < 32; ++e) { rb[e] = acc; acc += ((cnt[e * 64] + 255) >> 8) << 8; } rb[32] = acc; }
    SYNC();
}
DEV void norm_phase(const Args& a, unsigned char* smem, int l) {
    unsigned char* ws = wsp(a); const int tid = TID, w = tid >> 6, lane = tid & 63;
    int* rb = (int*)smem;
    if (l > 0) moe_bases((const int*)(ws + WS_CNT) + (l - 1) * 32 * 64, rb);
    const float* mod = (const float*)(ws + WS_MOD);
    const bf16* yk = (const bf16*)(ws + WS_YK);
    if (l < DEPTH) {
        const int bid = BID % 76 == BID ? BID : -1;
        for (int job = BID; job < 76; job += NBLK) {
            if (job < 72) { const int b = job / 36, n = job % 36; float sum = 0.f;
                for (int k = tid; k < DM; k += NT) { const float wv = n < 4 ? INP(a, I_WG)[((size_t)l * DM + k) * 4 + n] : INP(a, I_WE)[((size_t)l * DM + k) * 32 + n - 4]; sum += mod[((size_t)l * 2 + b) * 6 * DM + 3 * DM + k] * wv; }
#pragma unroll
                for (int q = 1; q < 64; q <<= 1) sum += shflx(sum, q);
                float* red = (float*)(smem + 1024);
                SYNC(); if (lane == 0) red[w] = sum; SYNC();
                if (tid == 0) { float t = 0.f; for (int q = 0; q < 8; ++q) t += red[q]; ((float*)(ws + WS_RBIAS))[((size_t)l * 2 + b) * 48 + n] = t; }
            } else { const float* nf = INP(a, I_NFFN) + (size_t)l * DM; const int part = job - 72;
                for (int i = part * (2 * DM / 4) + tid; i < (part + 1) * (2 * DM / 4); i += NT) { const int b = i / DM, k = i % DM; ((float*)(ws + WS_AVEC))[((size_t)l * 2 + b) * DM + k] = nf[k] * (1.0f + mod[((size_t)l * 2 + b) * 6 * DM + 4 * DM + k]); } }
        }
        (void)bid;
    }
    const int rstride = NBLK * 8;
    for (int rowa = BID * 8 + w; rowa < T; rowa += 2 * rstride) {
        int row[2]; bool ok[2];
        row[0] = rowa; ok[0] = true; row[1] = rowa + rstride; ok[1] = row[1] < T; if (!ok[1]) row[1] = rowa;
        f32x4 v[2][NJV]; int e0[2], p0[2], e1[2], p1[2]; float w0[2], w1[2];
        const float* xin = (l == 0) ? INP(a, I_X) : outp(a);
#pragma unroll
        for (int q = 0; q < 2; ++q) {
#pragma unroll
            for (int j = 0; j < NJV; ++j) v[q][j] = *(const f32x4*)(xin + (size_t)row[q] * DM + 4 * lane + 256 * j);
            if (l > 0) { const int* tie = (const int*)(ws + WS_TIE) + (size_t)row[q] * 2; const float* tiw = (const float*)(ws + WS_TIW) + (size_t)row[q] * 2;
                e0[q] = tie[0] >> 14; p0[q] = tie[0] & 16383; e1[q] = tie[1] >> 14; p1[q] = tie[1] & 16383; w0[q] = tiw[0]; w1[q] = tiw[1]; } }
        if (l > 0) {
            u32x2 q0[2][NJV], q1[2][NJV];
#pragma unroll
            for (int q = 0; q < 2; ++q) { const bf16* y0 = yk + (size_t)(rb[e0[q]] + p0[q]) * DM; const bf16* y1 = yk + (size_t)(rb[e1[q]] + p1[q]) * DM;
#pragma unroll
                for (int j = 0; j < NJV; ++j) { const int cidx = 4 * lane + 256 * j; q0[q][j] = *(const u32x2*)(y0 + cidx); q1[q][j] = *(const u32x2*)(y1 + cidx); } }
#pragma unroll
            for (int q = 0; q < 2; ++q) { const int b = row[q] / SEQ; const float* gf = mod + ((size_t)(l - 1) * 2 + b) * 6 * DM + 5 * DM;
#pragma unroll
                for (int j = 0; j < NJV; ++j) { const int cidx = 4 * lane + 256 * j; const f32x4 g = *(const f32x4*)(gf + cidx);
                    v[q][j][0] += g[0] * (w0[q] * bf2f(q0[q][j][0] & 0xffff) + w1[q] * bf2f(q1[q][j][0] & 0xffff));
                    v[q][j][1] += g[1] * (w0[q] * bf2f(q0[q][j][0] >> 16) + w1[q] * bf2f(q1[q][j][0] >> 16));
                    v[q][j][2] += g[2] * (w0[q] * bf2f(q0[q][j][1] & 0xffff) + w1[q] * bf2f(q1[q][j][1] & 0xffff));
                    v[q][j][3] += g[3] * (w0[q] * bf2f(q0[q][j][1] >> 16) + w1[q] * bf2f(q1[q][j][1] >> 16)); } }
        }
        if (l > 0)
#pragma unroll
        for (int q = 0; q < 2; ++q) { if (!ok[q]) continue;
#pragma unroll
            for (int j = 0; j < NJV; ++j) *(f32x4*)(outp(a) + (size_t)row[q] * DM + 4 * lane + 256 * j) = v[q][j]; }
        if (l == DEPTH) continue;
        float ss[2];
#pragma unroll
        for (int q = 0; q < 2; ++q) { ss[q] = 0.f;
#pragma unroll
            for (int j = 0; j < NJV; ++j) ss[q] += v[q][j][0] * v[q][j][0] + v[q][j][1] * v[q][j][1] + v[q][j][2] * v[q][j][2] + v[q][j][3] * v[q][j][3]; }
#pragma unroll
        for (int o = 1; o < 64; o <<= 1) { ss[0] += shflx(ss[0], o); ss[1] += shflx(ss[1], o); }
        const float* nm = INP(a, I_NMIX) + (size_t)l * DM;
#pragma unroll
        for (int q = 0; q < 2; ++q) { if (!ok[q]) continue;
            const int b = row[q] / SEQ; const float rs = frsq(ss[q] * (1.0f / DM) + EPS);
            const float* mm = mod + ((size_t)l * 2 + b) * 6 * DM; bf16* hb = (bf16*)(ws + WS_H) + (size_t)row[q] * DM;
#pragma unroll
            for (int j = 0; j < NJV; ++j) { const int cidx = 4 * lane + 256 * j; f32x4 g = *(const f32x4*)(nm + cidx), sh = *(const f32x4*)(mm + cidx), sc = *(const f32x4*)(mm + DM + cidx), o;
#pragma unroll
                for (int r = 0; r < 4; ++r) o[r] = v[q][j][r] * rs * g[r] * (1.0f + sc[r]) + sh[r];
                st_bf4(hb + cidx, o); } }
    }
}

DEV void route_phase(const Args& a, unsigned char* smem, int l) {
    unsigned char* ws = wsp(a); const int tid = TID, w = tid >> 6, lane = tid & 63, h = lane >> 4, c = lane & 15, pi = w >> 1, kh = w & 1;
    constexpr int NCHK = 4, CH = DM / NCHK, WLD = CH + 8, NKS = CH / 2 / 32;
    constexpr int WTOT = 48 * (CH / 8), WMAX = (WTOT + NT - 1) / NT;
    bf16* WHl = (bf16*)smem; bf16* WLl = WHl + 48 * WLD;
    float* lg = (float*)(WLl + 48 * WLD);
    float* ssb = lg + 4 * 2 * 16 * 48;
    float* rsb = ssb + 4 * 2 * 16;
    int* lcnt = (int*)(rsb + 64); int* lbase = lcnt + 32; int* tinfo = lbase + 32;
    float* avl = (float*)(tinfo + 256); float* cvl = avl + 2 * DM;
    const float* mod = (const float*)(ws + WS_MOD);
    SYNC();
    if (tid < 32) lcnt[tid] = 0;
    for (int i = tid; i < 2 * DM; i += NT) { const int b = i / DM, k = i % DM; avl[i] = ((const float*)(ws + WS_AVEC))[((size_t)l * 2 + b) * DM + k]; cvl[i] = mod[((size_t)l * 2 + b) * 6 * DM + 3 * DM + k]; }
    const bf16* WH = (const bf16*)(ws + WS_WTH) + (size_t)l * 48 * DM; const bf16* WL = (const bf16*)(ws + WS_WTL) + (size_t)l * 48 * DM;
    int* cnt = (int*)(ws + WS_CNT) + l * 32 * 64;
    for (int pass0 = BID; pass0 < T / 16; pass0 += 4 * NBLK) {
        const int pass = pass0 + pi * NBLK; const bool valid = pass < T / 16;
        const int tok = valid ? pass * 16 + c : 0, b = tok / SEQ;
        const float* xrow = outp(a) + (size_t)tok * DM;
        f32x4 xv[2][NKS][2]; bf16x8 wh[WMAX], wl[WMAX];
#pragma unroll
        for (int ks = 0; ks < NKS; ++ks) { const float* xq = xrow + kh * (CH / 2) + 8 * h + 32 * ks; xv[0][ks][0] = *(const f32x4*)xq; xv[0][ks][1] = *(const f32x4*)(xq + 4); }
#pragma unroll
        for (int t = 0; t < WMAX; ++t) { const int i = tid + NT * t; if (i < WTOT) { const int n = i / (CH / 8), k8 = (i % (CH / 8)) * 8; wh[t] = *(const bf16x8*)(WH + (size_t)n * DM + k8); wl[t] = *(const bf16x8*)(WL + (size_t)n * DM + k8); } }
        f32x4 acc[3] = {f4zero(), f4zero(), f4zero()}; float ss = 0.f;
        bf16x8 uhk[NCHK * NKS];
#pragma unroll
        for (int chn = 0; chn < NCHK; ++chn) {
            SYNC();
#pragma unroll
            for (int t = 0; t < WMAX; ++t) { const int i = tid + NT * t; if (i < WTOT) { const int n = i / (CH / 8), k8 = (i % (CH / 8)) * 8; *(bf16x8*)(WHl + n * WLD + k8) = wh[t]; *(bf16x8*)(WLl + n * WLD + k8) = wl[t]; } }
            SYNC();
            if (chn + 1 < NCHK) {
#pragma unroll
                for (int ks = 0; ks < NKS; ++ks) { const float* xq = xrow + (chn + 1) * CH + kh * (CH / 2) + 8 * h + 32 * ks; xv[(chn + 1) & 1][ks][0] = *(const f32x4*)xq; xv[(chn + 1) & 1][ks][1] = *(const f32x4*)(xq + 4); }
#pragma unroll
                for (int t = 0; t < WMAX; ++t) { const int i = tid + NT * t; if (i < WTOT) { const int n = i / (CH / 8), k8 = (i % (CH / 8)) * 8; wh[t] = *(const bf16x8*)(WH + (size_t)n * DM + (chn + 1) * CH + k8); wl[t] = *(const bf16x8*)(WL + (size_t)n * DM + (chn + 1) * CH + k8); } }
            }
            if (valid) {
                const bf16* whp = WHl + c * WLD + kh * (CH / 2) + 8 * h; const bf16* wlp = WLl + c * WLD + kh * (CH / 2) + 8 * h;
                const float* ap = avl + b * DM + chn * CH + kh * (CH / 2) + 8 * h;
#pragma unroll
                for (int ks = 0; ks < NKS; ++ks) {
                    const f32x4 a0 = *(const f32x4*)(ap + 32 * ks), a1 = *(const f32x4*)(ap + 32 * ks + 4);
                    const f32x4 x0 = xv[chn & 1][ks][0], x1 = xv[chn & 1][ks][1];
                    f32x4 u0, u1, r0, r1;
#pragma unroll
                    for (int r = 0; r < 4; ++r) { u0[r] = x0[r] * a0[r]; u1[r] = x1[r] * a1[r]; ss += x0[r] * x0[r] + x1[r] * x1[r]; }
                    const bf16x8 uh = pack8(u0, u1); uhk[chn * NKS + ks] = uh;
#pragma unroll
                    for (int r = 0; r < 4; ++r) { r0[r] = u0[r] - bf2f((unsigned short)uh[r]); r1[r] = u1[r] - bf2f((unsigned short)uh[4 + r]); }
                    const bf16x8 ul = pack8(r0, r1);
#pragma unroll
                    for (int nt = 0; nt < 3; ++nt) { const bf16x8 whf = *(const bf16x8*)(whp + nt * 16 * WLD + 32 * ks), wlf = *(const bf16x8*)(wlp + nt * 16 * WLD + 32 * ks);
                        acc[nt] = mfma16(whf, uh, acc[nt]); acc[nt] = mfma16(wlf, uh, acc[nt]); acc[nt] = mfma16(whf, ul, acc[nt]); }
                }
            }
        }
        if (valid) {
            ss += shflx(ss, 16); ss += shflx(ss, 32);
            float* lgp = lg + ((pi * 2 + kh) * 16 + c) * 48 + 4 * h;
#pragma unroll
            for (int nt = 0; nt < 3; ++nt) *(f32x4*)(lgp + 16 * nt) = acc[nt];
            if (h == 0) ssb[(pi * 2 + kh) * 16 + c] = ss;
        }
        SYNC();
        if (tid < 64) { const int p2 = tid >> 4, tk = tid & 15, pass2 = pass0 + p2 * NBLK;
            if (pass2 < T / 16) { const int tok2 = pass2 * 16 + tk, b2 = tok2 / SEQ;
                const float rs = frsq((ssb[(p2 * 2 + 0) * 16 + tk] + ssb[(p2 * 2 + 1) * 16 + tk]) * (1.0f / DM) + EPS); rsb[p2 * 16 + tk] = rs;
                const float* l0 = lg + ((p2 * 2 + 0) * 16 + tk) * 48; const float* l1 = lg + ((p2 * 2 + 1) * 16 + tk) * 48; const float* rbp = (const float*)(ws + WS_RBIAS) + ((size_t)l * 2 + b2) * 48;
                float acc[36];
#pragma unroll
                for (int n = 0; n < 36; ++n) acc[n] = rs * (l0[n] + l1[n]) + rbp[n];
                int gs = 0; float gm = acc[0];
#pragma unroll
                for (int g = 1; g < 4; ++g) if (acc[g] > gm) { gm = acc[g]; gs = g; }
                float den = 0.f;
#pragma unroll
                for (int g = 0; g < 4; ++g) den += fexp2((acc[g] - gm) * LOG2E);
                const float ggate = 1.0f / den;
                float el[8];
#pragma unroll
                for (int j = 0; j < 8; ++j) { el[j] = acc[4 + j];
#pragma unroll
                    for (int g = 1; g < 4; ++g) if (gs == g) el[j] = acc[4 + 8 * g + j]; }
                int ia = 0; float va = el[0];
#pragma unroll
                for (int j = 1; j < 8; ++j) if (el[j] > va) { va = el[j]; ia = j; }
                int ib = -1; float vb = -3e38f;
#pragma unroll
                for (int j = 0; j < 8; ++j) if (j != ia && el[j] > vb) { vb = el[j]; ib = j; }
                const float wa = 1.0f / (1.0f + fexp2((vb - va) * LOG2E)), wb = 1.0f - wa;
                const int e0 = gs * 8 + ia, e1 = gs * 8 + ib;
                const int p0 = atomic_add_i(lcnt + e0, 1), p1 = atomic_add_i(lcnt + e1, 1);
                int* ti = tinfo + tid * 4;
                ti[0] = (e0 << 14) | p0; ti[1] = (e1 << 14) | p1; ti[2] = __builtin_bit_cast(int, ggate * wa); ti[3] = __builtin_bit_cast(int, ggate * wb);
            } }
        SYNC();
        int gbase = 0;
        if (tid < 32) { const int n = lcnt[tid]; gbase = n > 0 ? atomic_add_i(cnt + tid * 64, n) : 0; }
        if (valid) { const float rs = rsb[pi * 16 + c]; bf16* hb = (bf16*)(ws + WS_H) + (size_t)tok * DM + kh * (CH / 2) + 8 * h;
            const float* cp = cvl + b * DM + kh * (CH / 2) + 8 * h;
#pragma unroll
            for (int chn = 0; chn < NCHK; ++chn)
#pragma unroll
                for (int ks = 0; ks < NKS; ++ks) {
                    const bf16x8 uh = uhk[chn * NKS + ks]; const f32x4 c0 = *(const f32x4*)(cp + chn * CH + 32 * ks), c1 = *(const f32x4*)(cp + chn * CH + 32 * ks + 4);
                    f32x4 o0, o1;
#pragma unroll
                    for (int r = 0; r < 4; ++r) { o0[r] = bf2f((unsigned short)uh[r]) * rs + c0[r]; o1[r] = bf2f((unsigned short)uh[4 + r]) * rs + c1[r]; }
                    st_bf8(hb + chn * CH + 32 * ks, o0, o1); } }
        if (tid < 32) { lbase[tid] = gbase; lcnt[tid] = 0; }
        SYNC();
        if (tid < 64) { const int p2 = tid >> 4, pass2 = pass0 + p2 * NBLK;
            if (pass2 < T / 16) { const int tok2 = pass2 * 16 + (tid & 15); const int* ti = tinfo + tid * 4;
                const int e0 = ti[0] >> 14, e1 = ti[1] >> 14, p0 = lbase[e0] + (ti[0] & 16383), p1 = lbase[e1] + (ti[1] & 16383);
                int* list = (int*)(ws + WS_LIST); list[(size_t)e0 * T + p0] = tok2; list[(size_t)e1 * T + p1] = tok2;
                int* tie = (int*)(ws + WS_TIE) + (size_t)tok2 * 2; int* tiw = (int*)(ws + WS_TIW) + (size_t)tok2 * 2;
                tie[0] = (e0 << 14) | p0; tie[1] = (e1 << 14) | p1; tiw[0] = ti[2]; tiw[1] = ti[3]; } }
        SYNC();
    }
}

DEV int vbid() { const int g = NBLK; return (g % 8 == 0) ? (BID % 8) * (g / 8) + BID / 8 : BID; }
#ifdef EMU
#define PG8_LDS(p) (p)
#else
#define PG8_LDS(p) ((PG8_LAS unsigned char*)(p))
#endif
DEV void inproj_phase(const Args& a, unsigned char* smem, int li) {
    pg8::Gemm g{(const bf16*)(wsp(a) + WS_H), (const bf16*)(wsp(a) + WS_WIN) + (size_t)li * NIN8 * DM, T, NIN8, DM}; pg8::StaticOrder S; S.init(T, NIN8, NBLK, BID);
    EpiInProj8 E{&a, li};
    SYNC(); pg8::gemm_phase<EpiInProj8, pg8::StaticOrder, true, true>(PG8_LDS(smem), g, S, E); SYNC();
}
DEV void resid_gemm_phase(const Args& a, unsigned char* smem, const bf16* A, int K, const bf16* Bt, int l) {
    pg8::Gemm g{A, Bt, T, DM, K}; pg8::StaticOrder S; S.init(T, DM, NBLK, BID);
    EpiResid8 E{outp(a), (const float*)(wsp(a) + WS_MOD) + (size_t)l * 2 * 6 * DM + 2 * DM, l == 0 ? INP(a, I_X) : (const float*)outp(a)};
    SYNC(); pg8::gemm_phase<EpiResid8, pg8::StaticOrder, true, true>(PG8_LDS(smem), g, S, E); SYNC();
}
DEV void pw1_phase(const Args& a, unsigned char* smem, int li) {
    pg8::Gemm g{(const bf16*)(wsp(a) + WS_H), (const bf16*)(wsp(a) + WS_PW1) + (size_t)li * 2 * DM * DM, T, 2 * DM, DM}; pg8::StaticOrder S; S.init(T, 2 * DM, NBLK, BID);
    EpiGlu8 E{(bf16*)(wsp(a) + WS_GLU)};
    SYNC(); pg8::gemm_phase<EpiGlu8, pg8::StaticOrder, true, true>(PG8_LDS(smem), g, S, E); SYNC();
}
DEV void cmp_phase_items(const Args& a, unsigned char* smem, int li, int it) {
    constexpr int TMC = (NCP + 255) / 256;
    const int kv = it / (4 * TMC), bg = (it / TMC) % 4, tm = it % TMC;
    const bf16* src = (const bf16*)(wsp(a) + (kv ? WS_VCG : WS_KCG)) + (size_t)bg * SEQ * 64;
    struct AF { const bf16* base; int m0; MDEV unsigned off(int r) const { int n = m0 + r; if (n > NCMP - 1) n = NCMP - 1; return (unsigned)n * 1024u; } } af{src, tm * 256};
    EpiCmp E{&a, kv, bg, tm * 256, li};
    BClamp64 bf{INP(a, kv ? I_CWV : I_CWK) + (size_t)li * 2048 * 64};
    gemm_tile2(smem, af, bf, 64, 2048, E);
}
DEV void moe_gemm_phase8(const Args& a, unsigned char* smem, int l, int mode) {
    unsigned char* ws = wsp(a); const int* cnt = (const int*)(ws + WS_CNT) + l * 32 * 64;
    int* rb = (int*)(smem + 140 * 1024);
    moe_bases(cnt, rb);
    const int mrows = rb[32];
    if (mode == 0) {
        pg8::Gemm g{(const bf16*)(ws + WS_H), (const bf16*)(ws + WS_W13) + (size_t)l * 32 * 2 * FF * DM, mrows, 2 * FF, DM}; pg8::StaticOrder S; S.init(mrows, 2 * FF, NBLK, BID);
        EpiMoe1_8 E{(bf16*)(ws + WS_ACT)}; MoeSel<true> X{rb, cnt, (const int*)(ws + WS_LIST), (size_t)2 * FF * DM * 2};
        SYNC(); pg8::gemm_phase<EpiMoe1_8, pg8::StaticOrder, true, true, MoeSel<true>>(PG8_LDS(smem), g, S, E, X); SYNC();
    } else {
        pg8::Gemm g{(const bf16*)(ws + WS_ACT), (const bf16*)(ws + WS_W2) + (size_t)l * 32 * DM * FF, mrows, DM, FF}; pg8::StaticOrder S; S.init(mrows, DM, NBLK, BID);
        EpiMoe2_8 E{(bf16*)(ws + WS_YK)}; MoeSel<false> X{rb, cnt, (const int*)(ws + WS_LIST), (size_t)DM * FF * 2};
        SYNC(); pg8::gemm_phase<EpiMoe2_8, pg8::StaticOrder, true, true, MoeSel<false>>(PG8_LDS(smem), g, S, E, X); SYNC();
    }
}
#ifndef EMU
constexpr int MOE_TMO_IDX = 128;
struct MoeOrder { int nN, t0, nu, j, nper, nA; bool rev;
    __device__ __forceinline__ void init(int ntile, int nN_, int nblk, int bid, bool rev_) { nN = nN_; nper = nblk / 8; rev = rev_; const int x = bid % 8; j = bid / 8;
        t0 = x * ntile / 8; nu = ((x + 1) * ntile / 8 - t0) * nN; if (bid >= 8 * nper) nu = 0;
        nA = nu - 2 * nper; nA = nA < 0 ? 0 : (nA > nper / 2 ? nper / 2 : nA); }
    __device__ __forceinline__ bool next(int i, pg8::Unit& u) const { int p;
        if (!rev) p = i * nper + j;
        else if (j < nA) { if (i > 0) return false; p = nu - nA + j; }
        else { p = i * (nper - nA) + (j - nA); if (p >= nu - nA) return false; }
        if (p >= nu) return false; u.pm = t0 + p / nN; u.pn = p % nN; return true; }
    __device__ __forceinline__ void a_ready(const pg8::Unit&) const {}
    __device__ __forceinline__ void done(const pg8::Unit&) const {}
};
struct MoeProd : MoeOrder { unsigned* flg;
    __device__ __forceinline__ void done(const pg8::Unit& u) const {
        asm volatile("s_waitcnt vmcnt(0)" ::: "memory"); __builtin_amdgcn_s_barrier(); asm volatile("" ::: "memory");
        if (TID == 0) (void)__hip_atomic_fetch_add((__attribute__((address_space(1))) unsigned*)(flg + u.pm * 16), 1u, __ATOMIC_RELAXED, __HIP_MEMORY_SCOPE_AGENT); } };
struct MoeCons : MoeOrder { unsigned* flg; unsigned* tmo;
    __device__ __forceinline__ void a_ready(const pg8::Unit& u) const {
        if ((TID >> 6) == 0) { unsigned sp = 0u; __attribute__((address_space(1))) unsigned* f = (__attribute__((address_space(1))) unsigned*)(flg + u.pm * 16);
            while ((unsigned)__builtin_amdgcn_readfirstlane((int)__hip_atomic_load(f, __ATOMIC_RELAXED, __HIP_MEMORY_SCOPE_AGENT)) < (unsigned)(2 * FF / 256)) {
                __builtin_amdgcn_s_sleep(1);
                if ((++sp & 255u) == 0u) { if (__hip_atomic_load((__attribute__((address_space(1))) unsigned*)tmo, __ATOMIC_RELAXED, __HIP_MEMORY_SCOPE_AGENT)) break;
                    if (sp > (1u << 22)) { (void)__hip_atomic_fetch_add((__attribute__((address_space(1))) unsigned*)tmo, 1u, __ATOMIC_RELAXED, __HIP_MEMORY_SCOPE_AGENT); break; } } }
            __builtin_amdgcn_fence(__ATOMIC_ACQUIRE, "agent"); }
        asm volatile("" ::: "memory"); __builtin_amdgcn_s_barrier(); asm volatile("" ::: "memory"); } };
DEV void moe_fused_phase(const Args& a, unsigned char* smem, int l) {
    unsigned char* ws = wsp(a); const int* cnt = (const int*)(ws + WS_CNT) + l * 32 * 64;
    int* rb = (int*)(smem + 140 * 1024);
    moe_bases(cnt, rb);
    const int mrows = rb[32]; unsigned* flg = (unsigned*)(ws + WS_FLG) + (size_t)l * 256 * 16;
    { pg8::Gemm g{(const bf16*)(ws + WS_H), (const bf16*)(ws + WS_W13) + (size_t)l * 32 * 2 * FF * DM, mrows, 2 * FF, DM}; MoeProd S; S.init(mrows >> 8, 2 * FF / 256, NBLK, BID, false); S.flg = flg;
      EpiMoe1_8 E{(bf16*)(ws + WS_ACT)}; MoeSel<true> X{rb, cnt, (const int*)(ws + WS_LIST), (size_t)2 * FF * DM * 2};
      SYNC(); pg8::gemm_phase<EpiMoe1_8, MoeProd, true, true, MoeSel<true>>(PG8_LDS(smem), g, S, E, X); }
    { pg8::Gemm g{(const bf16*)(ws + WS_ACT), (const bf16*)(ws + WS_W2) + (size_t)l * 32 * DM * FF, mrows, DM, FF}; MoeCons S; S.init(mrows >> 8, DM / 256, NBLK, BID, true); S.flg = flg; S.tmo = (unsigned*)(ws + WS_BAR) + MOE_TMO_IDX;
      EpiMoe2_8 E{(bf16*)(ws + WS_YK)}; MoeSel<false> X{rb, cnt, (const int*)(ws + WS_LIST), (size_t)DM * FF * 2};
      SYNC(); pg8::gemm_phase<EpiMoe2_8, MoeCons, true, true, MoeSel<false>>(PG8_LDS(smem), g, S, E, X); SYNC(); }
}
#endif
DEV void moe_gemm_phase(const Args& a, unsigned char* smem, int l, int mode) {
    unsigned char* ws = wsp(a); const int* cnt = (const int*)(ws + WS_CNT) + l * 32 * 64;
    int* rb = (int*)(smem + GEMM2_LDS);
    moe_bases(cnt, rb);
    const int ntile = rb[32] >> 8;
    constexpr int TN1 = 2 * FF / 128, TN2 = DM / 128;
    const int TN = mode == 0 ? TN1 : TN2;
    const int* list = (const int*)(ws + WS_LIST);
    for (int it = vbid(); it < ntile * TN; it += NBLK) {
        const int rt = it / TN, tn = it % TN; int e = 0;
#pragma unroll 1
        for (int q = 1; q < 32; ++q) if ((rb[q] >> 8) <= rt) e = q;
        const int rloc = (rt << 8) - rb[e], ce = cnt[e * 64], nvalid = (ce - rloc) < 256 ? (ce - rloc) : 256;
        if (mode == 0) {
            struct AF { const bf16* base; const int* lst; int nv; MDEV unsigned off(int r) const { const int rr = r < nv ? r : nv - 1; return (unsigned)lst[rr] * (unsigned)DM; } }
                af{(const bf16*)(ws + WS_H), list + (size_t)e * T + rloc, nvalid};
            EpiGated<1> E{(bf16*)(ws + WS_ACT), (size_t)FF, rt << 8, tn * 128, nvalid};
            BInter bf{INP(a, I_W1) + (size_t)(l * 32 + e) * DM * FF, INP(a, I_W3) + (size_t)(l * 32 + e) * DM * FF, tn * 128};
            gemm_tile2(smem, af, bf, FF, DM, E);
        } else {
            ARows af{(const bf16*)(ws + WS_ACT) + (size_t)(rt << 8) * FF, (size_t)FF};
            EpiStoreBf E{(bf16*)(ws + WS_YK), (size_t)DM, rt << 8, tn * 128, nvalid};
            BPlain bf{INP(a, I_W2) + (size_t)(l * 32 + e) * FF * DM + tn * 128};
            gemm_tile2(smem, af, bf, DM, FF, E);
        }
    }
}

constexpr int LDV = 80;
constexpr int AT_K = 0, AT_V = 2 * 64 * LDT * 2, AT_IMP = AT_V + 2 * 64 * LDV * 2, AT_SEL = AT_IMP + 8 * 8 * 128 * 4, AT_GSEL = AT_SEL + 8 * 8 * 4 * 4, AT_OUT = AT_GSEL + 8 * 2 * 4 * 4, AT_END = AT_OUT + 8 * 32 * 64 * 4;
#ifdef EMU
DEV float rexp2(float x) { return exp2f(x); }
DEV unsigned uni(unsigned x) { return x; }
#else
DEV float rexp2(float x) { return __builtin_amdgcn_exp2f(x); }
DEV unsigned uni(unsigned x) { return (unsigned)__builtin_amdgcn_readfirstlane((int)x); }
#endif
DEV int krow_lds(int kappa) { return 16 * (2 * (kappa >> 5) + ((kappa >> 2) & 1)) + 4 * ((kappa >> 3) & 3) + (kappa & 3); }
template <int MASK, bool FULL, int GM>
DEV void attn_block(const bf16* Kp, const bf16* Vp, const bf16x8 (&qf)[2][2], int j, const int (&s)[2], const bool (&selbit)[2], float C2, int h, int c,
                    f32x4 (&O)[2][4], f32x4 (&Ol)[2]) {
    f32x4 st[2][2][2];
#pragma unroll
    for (int sp = 0; sp < 2; ++sp)
#pragma unroll
        for (int u = 0; u < 2; ++u) {
#pragma unroll
            for (int G = 0; G < 2; ++G) { st[G][sp][u][0] = -C2; st[G][sp][u][1] = -C2; st[G][sp][u][2] = -C2; st[G][sp][u][3] = -C2; }
#pragma unroll
            for (int ks = 0; ks < 2; ++ks) { const bf16x8 kf = *(const bf16x8*)(Kp + (16 * (2 * sp + u) + c) * LDT + 32 * ks + 8 * h);
#pragma unroll
                for (int G = 0; G < 2; ++G) if (GM & (1 << G)) st[G][sp][u] = mfma16(kf, qf[G][ks], st[G][sp][u]); } }
#pragma unroll
    for (int G = 0; G < 2; ++G) if (GM & (1 << G))
#pragma unroll
        for (int sp = 0; sp < 2; ++sp)
#pragma unroll
            for (int u = 0; u < 2; ++u)
#pragma unroll
                for (int r = 0; r < 4; ++r) { bool ok = selbit[G];
                    if (!FULL) { const int key = 64 * j + 32 * sp + 8 * h + 4 * u + r;
                        if (MASK == 0) ok = 16 * key + 31 <= s[G]; else if (MASK == 1) ok = selbit[G] && key <= s[G]; else ok = key <= s[G] && key > s[G] - 512; }
                    st[G][sp][u][r] = ok ? rexp2(st[G][sp][u][r]) : 0.f; }
    bf16x8 pb[2][2], ones;
#pragma unroll
    for (int q = 0; q < 8; ++q) ones[q] = (short)0x3F80;
#pragma unroll
    for (int G = 0; G < 2; ++G) if (GM & (1 << G))
#pragma unroll
        for (int sp = 0; sp < 2; ++sp) { pb[G][sp] = pack8(st[G][sp][0], st[G][sp][1]); Ol[G] = mfma16(ones, pb[G][sp], Ol[G]); }
    const bf16* Vb = Vp + bperm(8 * h + (c >> 2)) * LDV + 4 * (c & 3);
#pragma unroll
    for (int et = 0; et < 4; ++et)
#pragma unroll
        for (int sp = 0; sp < 2; ++sp) { const bf16x8 vf = tr_read8(Vb + (32 * sp) * LDV + 16 * et, Vb + (32 * sp + 8) * LDV + 16 * et);
#pragma unroll
            for (int G = 0; G < 2; ++G) if (GM & (1 << G)) O[G][et] = mfma16(vf, pb[G][sp], O[G][et]); }
}

struct ImpState { float invq[2][4]; float carry[2]; float* imps; int tl, hd, l, s0, qblk; };
DEV void imp_block(const bf16* Kp, const bf16x8 (&qf)[2][2], int j, int s0, int w, float C2, int h, int c, ImpState& im) {
#pragma unroll
    for (int kt = 0; kt < 4; ++kt) {
        const int row = krow_lds(16 * kt + c);
        const bf16x8 k0 = *(const bf16x8*)(Kp + row * LDT + 8 * h), k1 = *(const bf16x8*)(Kp + row * LDT + 32 + 8 * h);
        const int n = 64 * j + 16 * kt + c;
#pragma unroll
        for (int G = 0; G < 2; ++G) {
            f32x4 acc; acc[0] = -C2; acc[1] = -C2; acc[2] = -C2; acc[3] = -C2;
            acc = mfma16(qf[G][0], k0, acc); acc = mfma16(qf[G][1], k1, acc);
            const bool ok = 16 * n + 31 <= s0 + 8 * w + 4 * G + h;
            float imp = 0.f;
#pragma unroll
            for (int r = 0; r < 4; ++r) imp += ok ? rexp2(acc[r]) * im.invq[G][r] : 0.f;
            const float v = ((c & 3) == 3) ? imp : 2.0f * imp;
            float sq = v + shflx(v, 1); sq += shflx(sq, 2);
            const float rr = dpp_ror1(imp);
            const float prev = (c == 0) ? im.carry[G] : rr;
            im.carry[G] = rr;
            const int m = n >> 2;
            if ((c & 3) == 0 && m < 128) im.imps[(G * 4 + h) * 128 + m] = sq + prev;
        }
    }
}

template <int MODE>
DEV void attn_branch(bf16* Kl, bf16* Vl, const bf16* kbase, const bf16* vbase, int jlo, int jhi,
                     const bf16x8 (&qf)[2][2], const int (&s)[2], const unsigned* selm, const unsigned* gselm, float C2, int w, int h, int c, int srow, int scol,
                     f32x4 (&O)[2][4], f32x4 (&Ol)[2], ImpState& im) {
    constexpr bool PV = MODE != 1; constexpr int MASK = MODE <= 1 ? 0 : MODE - 1;
    const int krow = krow_lds(srow) * LDT + scol, vrow = bperm(srow) * LDV + scol;
    bf16x8 rk[3], rv[3];
    { const bf16x8 k0 = *(const bf16x8*)(kbase + (size_t)jlo * 4096); *(bf16x8*)(Kl + krow) = k0;
      if (PV) { const bf16x8 v0 = *(const bf16x8*)(vbase + (size_t)jlo * 4096); *(bf16x8*)(Vl + vrow) = v0; } }
#pragma unroll
    for (int u = 0; u < 3; ++u) { int jj = jlo + 1 + u; if (jj > jhi) jj = jhi; rk[(1 + u) % 3] = *(const bf16x8*)(kbase + (size_t)jj * 4096); if (PV) rv[(1 + u) % 3] = *(const bf16x8*)(vbase + (size_t)jj * 4096); }
    SYNC();
    for (int jb = jlo; jb <= jhi; jb += 3) {
#pragma unroll
        for (int u = 0; u < 3; ++u) { const int j = jb + u;
            if (j <= jhi) {
                const int cur = (j - jlo) & 1;
                const bf16* Kc = Kl + cur * 64 * LDT; const bf16* Vc = Vl + cur * 64 * LDV;
                if (MODE == 1) imp_block(Kc, qf, j, im.s0, w, C2, h, c, im);
                else {
                    bool sb[2] = {true, true}; unsigned gm = 3u;
                    if (MODE == 2) { gm = 0u;
#pragma unroll
                        for (int G = 0; G < 2; ++G) { const unsigned wq = uni(gselm[G * 4 + (j >> 5)]), mq = selm[(G * 4 + im.tl) * 4 + (j >> 5)];
                            gm |= ((wq >> (j & 31)) & 1u) << G; sb[G] = (mq >> (j & 31)) & 1u; } }
                    bool full;
                    if (MODE == 0) full = 1024 * j + 1039 <= im.s0; else if (MODE == 2) full = j < im.qblk; else full = (j < im.qblk) && (64 * j > im.s0 + 63 - 512);
                    if (MODE == 2) {
                        if (full) { if (gm == 3u) attn_block<MASK, true, 3>(Kc, Vc, qf, j, s, sb, C2, h, c, O, Ol); else if (gm == 1u) attn_block<MASK, true, 1>(Kc, Vc, qf, j, s, sb, C2, h, c, O, Ol); else if (gm == 2u) attn_block<MASK, true, 2>(Kc, Vc, qf, j, s, sb, C2, h, c, O, Ol); }
                        else { if (gm == 3u) attn_block<MASK, false, 3>(Kc, Vc, qf, j, s, sb, C2, h, c, O, Ol); else if (gm == 1u) attn_block<MASK, false, 1>(Kc, Vc, qf, j, s, sb, C2, h, c, O, Ol); else if (gm == 2u) attn_block<MASK, false, 2>(Kc, Vc, qf, j, s, sb, C2, h, c, O, Ol); }
                    } else { if (full) attn_block<MASK, true, 3>(Kc, Vc, qf, j, s, sb, C2, h, c, O, Ol); else attn_block<MASK, false, 3>(Kc, Vc, qf, j, s, sb, C2, h, c, O, Ol); }
                }
                if (j + 1 <= jhi) {
                    *(bf16x8*)(Kl + (cur ^ 1) * 64 * LDT + krow) = rk[(u + 1) % 3]; if (PV) *(bf16x8*)(Vl + (cur ^ 1) * 64 * LDV + vrow) = rv[(u + 1) % 3];
                    int jj = j + 4; if (jj > jhi) jj = jhi;
                    rk[(u + 1) % 3] = *(const bf16x8*)(kbase + (size_t)jj * 4096); if (PV) rv[(u + 1) % 3] = *(const bf16x8*)(vbase + (size_t)jj * 4096);
                }
                SYNC();
            }
        }
    }
}

DEV void attn_task(const Args& a, unsigned char* smem, int li, int item) {
    unsigned char* ws = wsp(a); const int tid = TID, w = tid >> 6, l = tid & 63, h = l >> 4, c = l & 15, tl = c >> 2, hd = c & 3;
    const int bg = item & 3, b = bg >> 1, g = bg & 1, tq = (SEQ / 64 - 1) - (item >> 2), s0 = tq * 64, qblk = tq;
    int s[2], row[2];
#pragma unroll
    for (int G = 0; G < 2; ++G) { s[G] = s0 + 8 * w + 4 * G + tl; row[G] = b * SEQ + s[G]; }
    bf16* Kl = (bf16*)(smem + AT_K); bf16* Vl = (bf16*)(smem + AT_V); float* imps = (float*)(smem + AT_IMP) + w * 1024; unsigned* selm = (unsigned*)(smem + AT_SEL) + w * 32;
    bf16x8 qf[2][2]; float gatec[2], gates[2], gatew[2];
#pragma unroll
    for (int G = 0; G < 2; ++G) { const bf16* qp = (const bf16*)(ws + WS_QN) + (size_t)row[G] * 512 + (g * 4 + hd) * 64 + 8 * h; qf[G][0] = *(const bf16x8*)qp; qf[G][1] = *(const bf16x8*)(qp + 32);
        const float* gp = (const float*)(ws + WS_GATE) + (size_t)row[G] * 24 + (g * 4 + hd) * 3; gatec[G] = gp[0]; gates[G] = gp[1]; gatew[G] = gp[2]; }
    const float* cs = (const float*)(ws + WS_CS) + li * 4;
    const int srow = tid >> 3, scol = (tid & 7) * 8;
    for (int i = l; i < 1024; i += 64) imps[i] = 0.f;
    SYNC();
    unsigned* gselm = (unsigned*)(smem + AT_GSEL) + w * 8; float* outl = (float*)(smem + AT_OUT) + w * 2048 + l;
    ImpState im{{{0.f, 0.f, 0.f, 0.f}, {0.f, 0.f, 0.f, 0.f}}, {0.f, 0.f}, imps, tl, hd, l, s0, qblk};
    {
        const int ncv = s0 / 16 + 3, ncb0 = (ncv + 63) >> 6, ncb = ncb0 > NCP / 64 ? NCP / 64 : ncb0;
        const bf16* kcb = (const bf16*)(ws + WS_KC) + (size_t)bg * NCP * 64 + tid * 8;
        const bf16* vcb = (const bf16*)(ws + WS_VCT) + (size_t)bg * NCP * 64 + tid * 8;
        f32x4 O[2][4], Ol[2] = {f4zero(), f4zero()};
#pragma unroll
        for (int G = 0; G < 2; ++G)
#pragma unroll
            for (int et = 0; et < 4; ++et) O[G][et] = f4zero();
        attn_branch<0>(Kl, Vl, kcb, vcb, 0, ncb - 1, qf, s, selm, gselm, cs[0], w, h, c, srow, scol, O, Ol, im);
#pragma unroll
        for (int G = 0; G < 2; ++G) { const float lsum = Ol[G][0]; const float invl = lsum > 0.f ? 1.0f / lsum : 0.f;
#pragma unroll
            for (int r = 0; r < 4; ++r) im.invq[G][r] = shfl(invl, 4 * h + r);
#pragma unroll
            for (int et = 0; et < 4; ++et)
#pragma unroll
                for (int r = 0; r < 4; ++r) outl[((G * 4 + et) * 4 + r) * 64] = gatec[G] * invl * O[G][et][r]; }
        f32x4 ld[2] = {f4zero(), f4zero()};
        attn_branch<1>(Kl, Vl, kcb, vcb, 0, ncb - 1, qf, s, selm, gselm, cs[0], w, h, c, srow, scol, O, ld, im);
    }
    WSYNC();
#pragma unroll 1
    for (int G = 0; G < 2; ++G) {
        const int tk = l >> 4, i = l & 15; float vals[8];
#pragma unroll
        for (int mm = 0; mm < 8; ++mm) { const int jj = i + 16 * mm; vals[mm] = jj > qblk ? NEGV : ((jj == 0 || jj == qblk || jj == qblk - 1) ? FORCEV : imps[(G * 4 + tk) * 128 + jj]); }
        unsigned mk[4] = {0u, 0u, 0u, 0u};
#pragma unroll 1
        for (int rnd = 0; rnd < 16; ++rnd) {
            float best = vals[0]; int bj = i;
#pragma unroll
            for (int mm = 1; mm < 8; ++mm) if (vals[mm] > best) { best = vals[mm]; bj = i + 16 * mm; }
#pragma unroll
            for (int o = 1; o < 16; o <<= 1) { const float ov = shflx(best, o); const int oj = shflxi(bj, o); if (ov > best || (ov == best && oj < bj)) { best = ov; bj = oj; } }
            if (best > NEGV * 0.5f) {
#pragma unroll
                for (int q = 0; q < 4; ++q) if ((bj >> 5) == q) mk[q] |= 1u << (bj & 31); }
            if ((bj & 15) == i) {
#pragma unroll
                for (int mm = 0; mm < 8; ++mm) if ((bj >> 4) == mm) vals[mm] = -3e38f; }
        }
        if (i == 0) {
#pragma unroll
            for (int q = 0; q < 4; ++q) selm[(G * 4 + tk) * 4 + q] = mk[q]; }
    }
    WSYNC();
    if (l < 8) { const int G = l >> 2, q = l & 3; gselm[l] = selm[(G * 4 + 0) * 4 + q] | selm[(G * 4 + 1) * 4 + q] | selm[(G * 4 + 2) * 4 + q] | selm[(G * 4 + 3) * 4 + q]; }
    WSYNC();
#pragma unroll
    for (int br = 0; br < 2; ++br) {
        const bf16* kb = (const bf16*)(ws + (br == 0 ? WS_KS : WS_KW)) + (size_t)bg * SEQ * 64 + tid * 8; const bf16* vb = (const bf16*)(ws + (br == 0 ? WS_VST : WS_VWT)) + (size_t)bg * SEQ * 64 + tid * 8;
        f32x4 O[2][4], Ol[2] = {f4zero(), f4zero()};
#pragma unroll
        for (int G = 0; G < 2; ++G)
#pragma unroll
            for (int et = 0; et < 4; ++et) O[G][et] = f4zero();
        if (br == 0) attn_branch<2>(Kl, Vl, kb, vb, 0, qblk, qf, s, selm, gselm, cs[1], w, h, c, srow, scol, O, Ol, im);
        else attn_branch<3>(Kl, Vl, kb, vb, s0 >= 511 ? (s0 - 511) >> 6 : 0, qblk, qf, s, selm, gselm, cs[2], w, h, c, srow, scol, O, Ol, im);
#pragma unroll
        for (int G = 0; G < 2; ++G) { const float lsum = Ol[G][0]; const float sc = (br == 0 ? gates[G] : gatew[G]) * (lsum > 0.f ? 1.0f / lsum : 0.f);
#pragma unroll
            for (int et = 0; et < 4; ++et)
#pragma unroll
                for (int r = 0; r < 4; ++r) outl[((G * 4 + et) * 4 + r) * 64] += sc * O[G][et][r]; }
    }
#pragma unroll
    for (int G = 0; G < 2; ++G) { bf16* dst = (bf16*)(ws + WS_CAT) + (size_t)row[G] * 1024 + (g * 4 + hd) * 64 + 4 * h;
#pragma unroll
        for (int et = 0; et < 4; ++et) { f32x4 o;
#pragma unroll
            for (int r = 0; r < 4; ++r) o[r] = outl[((G * 4 + et) * 4 + r) * 64];
            st_bf4(dst + 16 * et, o); } }
}

constexpr int LDH = 136;
DEV void hg_cumsum(const float* fsrc  , float* segs  , int d, int seg, float (&f)[16], float (&bc)[16], float& bend, float& bmid) {
    float run = 0.f;
#pragma unroll
    for (int i = 0; i < 16; ++i) { f[i] = fsrc[(size_t)(16 * seg + i) * 128 + d]; run += log2f(f[i]); bc[i] = run; }
    SYNC();
    segs[seg * 128 + d] = run;
    SYNC();
    const float s0 = segs[d], s1 = segs[128 + d], s2 = segs[256 + d], s3 = segs[384 + d];
    const float off = seg == 0 ? 0.f : (seg == 1 ? s0 : (seg == 2 ? s0 + s1 : s0 + s1 + s2));
#pragma unroll
    for (int i = 0; i < 16; ++i) bc[i] += off;
    bend = s0 + s1 + s2 + s3; bmid = s0 + s1;
}
DEV void hg_write16(bf16* dstrow  , const float (&v)[16]) {
    u32x4 w0, w1;
#pragma unroll
    for (int q = 0; q < 4; ++q) { w0[q] = pk2(v[2 * q], v[2 * q + 1]); w1[q] = pk2(v[8 + 2 * q], v[8 + 2 * q + 1]); }
    *(u32x4*)dstrow = w0; *(u32x4*)(dstrow + 8) = w1;
}
DEV void hg_h1_task(const Args& a, unsigned char* smem, int task) {
    unsigned char* ws = wsp(a); const int tid = TID, w = tid >> 6, l = tid & 63, h = l >> 4, c = l & 15, d = tid & 127, seg = tid >> 7;
    const int bh = task / NCH, ch = task % NCH;
    bf16* kT = (bf16*)smem; bf16* vT = kT + 128 * LDT; float* segs = (float*)(vT + 128 * LDT);
    const size_t tokb = (size_t)bh * SEQ + ch * 64;
    float f[16], bc[16], bend, bmid;
    const bf16* vs = (const bf16*)(ws + WS_HV) + tokb * 128;
    bf16 vraw[16];
#pragma unroll
    for (int i = 0; i < 16; ++i) vraw[i] = vs[(size_t)(16 * seg + i) * 128 + d];
    hg_cumsum((const float*)(ws + WS_HF) + tokb * 128, segs, d, seg, f, bc, bend, bmid);
    float kv[16];
#pragma unroll
    for (int i = 0; i < 16; ++i) kv[i] = (1.0f - f[i]) * fexp2(bend - bc[i]);
    hg_write16(kT + d * LDT + 16 * seg, kv);
#pragma unroll
    for (int i = 0; i < 16; ++i) kv[i] = bf2f(vraw[i]);
    hg_write16(vT + d * LDT + 16 * seg, kv);
    if (seg == 0) ((float*)(ws + WS_GD))[((size_t)bh * NCH + ch) * 128 + d] = fexp2(bend);
    SYNC();
    f32x4 acc[8];
#pragma unroll
    for (int et = 0; et < 8; ++et) acc[et] = f4zero();
#pragma unroll
    for (int ks = 0; ks < 2; ++ks) { const bf16x8 fa = *(const bf16x8*)(kT + (16 * w + c) * LDT + 32 * ks + 8 * h);
#pragma unroll
        for (int et = 0; et < 8; ++et) acc[et] = mfma16(fa, *(const bf16x8*)(vT + (16 * et + c) * LDT + 32 * ks + 8 * h), acc[et]); }
    float* ut = (float*)(ws + WS_UT) + ((size_t)bh * NCH + ch) * 16384;
#pragma unroll
    for (int et = 0; et < 8; ++et) *(f32x4*)(ut + (size_t)(16 * et + c) * 128 + 16 * w + 4 * h) = acc[et];
    SYNC();
}
DEV void hg_scan_task(const Args& a, int sc) {
    unsigned char* ws = wsp(a); const int bh = sc >> 3, q = (sc & 7) * 512 + TID, e = q >> 5, d0 = (q & 31) * 4;
    const float* ut = (const float*)(ws + WS_UT) + (size_t)bh * NCH * 16384 + (size_t)e * 128 + d0;
    const float* gd = (const float*)(ws + WS_GD) + (size_t)bh * NCH * 128 + d0;
    bf16* st = (bf16*)(ws + WS_ST) + (size_t)bh * NCH * 16384 + (size_t)e * 128 + d0;
    f32x4 S = f4zero();
#pragma unroll 4
    for (int ch = 0; ch < NCH; ++ch) { st_bf4(st + (size_t)ch * 16384, S);
        const f32x4 g = *(const f32x4*)(gd + (size_t)ch * 128), u = *(const f32x4*)(ut + (size_t)ch * 16384);
#pragma unroll
        for (int r = 0; r < 4; ++r) S[r] = g[r] * S[r] + u[r]; }
}
DEV void hg_h3_task(const Args& a, unsigned char* smem, int li, int task) {
    unsigned char* ws = wsp(a); const int tid = TID, w = tid >> 6, l = tid & 63, h = l >> 4, c = l & 15, d = tid & 127, seg = tid >> 7;
    const int bh = task / NCH, ch = task % NCH, b = bh >> 2, hh = bh & 3;
    bf16* At = (bf16*)smem; bf16* Bt = At + 64 * LDH; bf16* Qt = Bt + 64 * LDH; bf16* vT = Qt + 64 * LDH; float* segs = (float*)(vT + 128 * LDT); float* part = segs + 512;
    const size_t tokb = (size_t)bh * SEQ + ch * 64;
    float f[16], bc[16], bend, bmid;
    const bf16* qs = (const bf16*)(ws + WS_HQ) + tokb * 128; const bf16* vs = (const bf16*)(ws + WS_HV) + tokb * 128;
    const int tt = w & 3, eh = w >> 2;
    bf16 qraw[16], vraw[16];
#pragma unroll
    for (int i = 0; i < 16; ++i) { const int t = 16 * seg + i; qraw[i] = qs[(size_t)t * 128 + d]; vraw[i] = vs[(size_t)t * 128 + d]; }
    const bf16* stp = (const bf16*)(ws + WS_ST) + ((size_t)bh * NCH + ch) * 16384;
    bf16x8 stf[4][4];
#pragma unroll
    for (int ks = 0; ks < 4; ++ks)
#pragma unroll
        for (int et = 0; et < 4; ++et) stf[ks][et] = *(const bf16x8*)(stp + (size_t)(64 * eh + 16 * et + c) * 128 + 32 * ks + 8 * h);
    const int tok = b * SEQ + ch * 64 + 16 * tt + c;
    const bf16* hg = (const bf16*)(ws + WS_HGS) + (size_t)tok * 512 + hh * 128;
    u32x2 hgv[4];
#pragma unroll
    for (int et = 0; et < 4; ++et) hgv[et] = *(const u32x2*)(hg + 64 * eh + 16 * et + 4 * h);
    hg_cumsum((const float*)(ws + WS_HF) + tokb * 128, segs, d, seg, f, bc, bend, bmid);
    float vv[16];
#pragma unroll
    for (int i = 0; i < 16; ++i) { const int t = 16 * seg + i; const float q = bf2f(qraw[i]);
        At[t * LDH + d] = (bf16)f2bf(q * fexp2(bc[i] - bmid)); Bt[t * LDH + d] = (bf16)f2bf((1.0f - f[i]) * fexp2(bmid - bc[i])); Qt[t * LDH + d] = (bf16)f2bf(q * fexp2(bc[i]));
        vv[i] = bf2f(vraw[i]); }
    hg_write16(vT + d * LDT + 16 * seg, vv);
    SYNC();
    f32x4 O[4];
#pragma unroll
    for (int et = 0; et < 4; ++et) O[et] = f4zero();
#pragma unroll
    for (int sp = 0; sp < 2; ++sp) {
        if (32 * sp > 16 * tt + 15) continue;
        f32x4 st[2];
#pragma unroll
        for (int u = 0; u < 2; ++u) { st[u] = f4zero(); const int krow = 32 * sp + 8 * (c >> 2) + 4 * u + (c & 3);
#pragma unroll
            for (int ks = 0; ks < 4; ++ks) st[u] = mfma16(*(const bf16x8*)(Bt + krow * LDH + 32 * ks + 8 * h), *(const bf16x8*)(At + (16 * tt + c) * LDH + 32 * ks + 8 * h), st[u]);
#pragma unroll
            for (int r = 0; r < 4; ++r) { const int sk = 32 * sp + 8 * h + 4 * u + r; if (sk > 16 * tt + c) st[u][r] = 0.f; } }
        const bf16x8 pb = pack8(st[0], st[1]);
#pragma unroll
        for (int et = 0; et < 4; ++et) O[et] = mfma16(*(const bf16x8*)(vT + (64 * eh + 16 * et + c) * LDT + 32 * sp + 8 * h), pb, O[et]);
    }
#pragma unroll
    for (int ks = 0; ks < 4; ++ks) { const bf16x8 fq = *(const bf16x8*)(Qt + (16 * tt + c) * LDH + 32 * ks + 8 * h);
#pragma unroll
        for (int et = 0; et < 4; ++et) O[et] = mfma16(stf[ks][et], fq, O[et]); }
    float ss = 0.f;
#pragma unroll
    for (int et = 0; et < 4; ++et)
#pragma unroll
        for (int r = 0; r < 4; ++r) ss += O[et][r] * O[et][r];
    ss += shflx(ss, 16); ss += shflx(ss, 32);
    if (h == 0) part[eh * 64 + 16 * tt + c] = ss;
    SYNC();
    const float rs = frsq((part[16 * tt + c] + part[64 + 16 * tt + c]) * (1.0f / 128.0f) + EPS);
    const float* og = INP(a, I_OG) + li * 128;
    bf16* dst = (bf16*)(ws + WS_CAT) + (size_t)tok * 1024 + 512 + hh * 128;
#pragma unroll
    for (int et = 0; et < 4; ++et) { const int e = 64 * eh + 16 * et + 4 * h; f32x4 o; const f32x4 ogv = *(const f32x4*)(og + e);
        o[0] = O[et][0] * rs * ogv[0] * bf2f(hgv[et][0] & 0xffff); o[1] = O[et][1] * rs * ogv[1] * bf2f(hgv[et][0] >> 16);
        o[2] = O[et][2] * rs * ogv[2] * bf2f(hgv[et][1] & 0xffff); o[3] = O[et][3] * rs * ogv[3] * bf2f(hgv[et][1] >> 16);
        st_bf4(dst + e, o); }
    SYNC();
}

constexpr int CTS = 8;
DEV void conv_task(const Args& a, unsigned char* smem, int li, int task) {
    unsigned char* ws = wsp(a); const int tid = TID, w = tid >> 6, lane = tid & 63;
    const bool act = tid < DM / 2; const int c0 = act ? 2 * tid : 0;
    const int tb = task * 64, b = tb / SEQ, sb = tb % SEQ;
    float* red = (float*)smem;
    const float b0 = INP(a, I_DWB)[li * DM + c0], b1 = INP(a, I_DWB)[li * DM + c0 + 1];
    const float g0 = INP(a, I_LNG)[li * DM + c0], g1 = INP(a, I_LNG)[li * DM + c0 + 1], e0 = INP(a, I_LNB)[li * DM + c0], e1 = INP(a, I_LNB)[li * DM + c0 + 1];
    const bf16* glu = (const bf16*)(ws + WS_GLU) + (size_t)b * SEQ * DM + c0;
    float* lw = (float*)(smem + 1024);
    SYNC();
    for (int i = tid * 4; i < 31 * DM; i += NT * 4) *(f32x4*)(lw + i) = *(const f32x4*)(INP(a, I_DW) + (size_t)li * 31 * DM + i);
    SYNC();
    f32x2v uf[30 + CTS]; unsigned nx[CTS];
    { const bf16* gp = glu + (size_t)(sb - 30) * DM;
#pragma unroll
      for (int r = 0; r < 30; ++r) { const int si = sb + r - 30; const unsigned q = si >= 0 ? *(const unsigned*)gp : 0u; gp += DM; OPAQUE(gp); uf[r][0] = bf2f(q & 0xffff); uf[r][1] = bf2f(q >> 16); }
#pragma unroll
      for (int r = 0; r < CTS; ++r) { nx[r] = *(const unsigned*)gp; gp += DM; OPAQUE(gp); } }
#pragma unroll 1
    for (int step = 0; step < 64 / CTS; ++step) {
        const int s0 = sb + CTS * step, t0 = tb + CTS * step;
#pragma unroll
        for (int r = 0; r < CTS; ++r) { uf[30 + r][0] = bf2f(nx[r] & 0xffff); uf[30 + r][1] = bf2f(nx[r] >> 16); }
        float acc[CTS][2];
        { f32x2v ac2[CTS];
#pragma unroll
          for (int t = 0; t < CTS; ++t) { ac2[t][0] = b0; ac2[t][1] = b1; }
#pragma unroll
          for (int j = 0; j < 31; ++j) { const f32x2v w2 = *(const f32x2v*)(lw + j * DM + c0);
#ifndef EMU
              if ((j & 3) == 3) asm volatile("" ::: "memory");
#endif
#pragma unroll
              for (int t = 0; t < CTS; ++t) ac2[t] += w2 * uf[t + j]; }
#pragma unroll
          for (int t = 0; t < CTS; ++t) { acc[t][0] = ac2[t][0]; acc[t][1] = ac2[t][1]; } }
#pragma unroll
        for (int r = 0; r < 30; ++r) uf[r] = uf[r + CTS];
        if (step < 64 / CTS - 1) { const bf16* gp = glu + (size_t)(s0 + CTS) * DM;
#pragma unroll
            for (int r = 0; r < CTS; ++r) { nx[r] = *(const unsigned*)gp; gp += DM; OPAQUE(gp); } }
        SYNC();
#pragma unroll
        for (int t = 0; t < CTS; ++t) { float s = act ? acc[t][0] + acc[t][1] : 0.f;
#pragma unroll
            for (int o = 1; o < 64; o <<= 1) s += shflx(s, o);
            if (lane == 0) red[w * 16 + t] = s; }
        SYNC();
#pragma unroll
        for (int t = 0; t < CTS; ++t) { float s = 0.f;
#pragma unroll
            for (int q = 0; q < 8; ++q) s += red[q * 16 + t];
            const float mean = s * (1.0f / DM); acc[t][0] -= mean; acc[t][1] -= mean; }
        SYNC();
#pragma unroll
        for (int t = 0; t < CTS; ++t) { float s = act ? acc[t][0] * acc[t][0] + acc[t][1] * acc[t][1] : 0.f;
#pragma unroll
            for (int o = 1; o < 64; o <<= 1) s += shflx(s, o);
            if (lane == 0) red[w * 16 + t] = s; }
        SYNC();
        if (act) {
            bf16* dst = (bf16*)(ws + WS_CAT) + (size_t)t0 * DM + c0;
#pragma unroll
            for (int t = 0; t < CTS; ++t) { float s = 0.f;
#pragma unroll
                for (int q = 0; q < 8; ++q) s += red[q * 16 + t];
                const float rstd = frsq(s * (1.0f / DM) + EPS);
                const float y0 = acc[t][0] * rstd * g0 + e0, y1 = acc[t][1] * rstd * g1 + e1;
                *(unsigned*)(dst + (size_t)t * DM) = pk2(siluf(y0), siluf(y1)); }
        }
    }
}

constexpr int N_PHASES = 1 + 16 * (DEPTH / 2) + 1;
DEV void phase_decode(int ph, int& l, int& sub) {
    const int q = ph - 1, pair = q >> 4, r = q & 15;
    if (r < 9) { l = 2 * pair; sub = r; } else { l = 2 * pair + 1; const int rr = r - 9; sub = rr < 3 ? rr : rr + 2; }
}
constexpr int LDS_BYTES = 150 * 1024;

DEV void run_phase(const Args& a, unsigned char* smem, int ph) {
#ifndef ONLY
#define ONLY -1
#endif
#define EN(k) (ONLY < 0 || ONLY == (k))
    if (ph == 0) { if (EN(100)) p0_phase(a, smem); return; }
    if (ph == N_PHASES - 1) { if (EN(0)) norm_phase(a, smem, DEPTH); return; }
    int l, sub; phase_decode(ph, l, sub); const int li = l >> 1; const bool even = (l & 1) == 0;
    unsigned char* ws = wsp(a);
    switch (sub) {
    case 0: if (EN(0)) norm_phase(a, smem, l); break;
    case 1: if (even) { if (EN(1)) inproj_phase(a, smem, li); } else { if (EN(11)) pw1_phase(a, smem, li); } break;
    case 2:
        if (even) { constexpr int NCI = 8 * ((NCP + 255) / 256); constexpr int NH1 = 8 * NCH;
            if (NBLK > 2 * NCI) { const int bid = BID;
                if (bid < NCI) { if (EN(2)) cmp_phase_items(a, smem, li, bid); }
                else { for (int it = bid - NCI; it < NH1; it += NBLK - NCI) if (EN(12)) hg_h1_task(a, smem, it); } }
            else for (int it = BID; it < NCI + NH1; it += NBLK) { if (it < NCI) { if (EN(2)) cmp_phase_items(a, smem, li, it); } else { if (EN(12)) hg_h1_task(a, smem, it - NCI); } } }
        else { for (int it = BID; it < T / 64; it += NBLK) if (EN(13)) conv_task(a, smem, li, it); }
        break;
#ifdef EMU
    case 3:
        if (even) { constexpr int NA = 4 * (SEQ / 64); const int G = NBLK;
            for (int r = 0; r * G < NA; ++r) { const int it = r * G + ((r & 1) ? (G - 1 - BID) : BID); if (it < NA) { if (EN(3)) attn_task(a, smem, li, it); } }
            for (int it = BID; it < 64; it += NBLK) if (EN(14)) hg_scan_task(a, it); }
        break;
    case 4: if (even) { for (int it = BID; it < 8 * NCH; it += NBLK) if (EN(4)) hg_h3_task(a, smem, li, it); } break;
#else
    case 3:
        if (even) { constexpr int NA = 4 * (SEQ / 64); const int G = NBLK;
            typedef __attribute__((address_space(1))) unsigned gu32;
            gu32* cw = (gu32*)((unsigned*)(ws + WS_BAR) + P0_CTR_IDX + 1 + 2 * li);
            int nsc = 0;
            for (int it = BID; it < 64; it += NBLK) { hg_scan_task(a, it); ++nsc; }
            if (nsc > 0) { __builtin_amdgcn_fence(__ATOMIC_RELEASE, "agent"); asm volatile("s_waitcnt vmcnt(0)" ::: "memory"); SYNC(); if (TID == 0) (void)__hip_atomic_fetch_add(cw, (unsigned)nsc, __ATOMIC_RELAXED, __HIP_MEMORY_SCOPE_AGENT); }
            for (int r = 0; r * G < NA; ++r) { const int it = r * G + ((r & 1) ? (G - 1 - BID) : BID); if (it < NA) attn_task(a, smem, li, it); }
            if ((TID >> 6) == 0) { unsigned sp = 0u; gu32* tmo = (gu32*)((unsigned*)(ws + WS_BAR) + MOE_TMO_IDX);
                while ((unsigned)__builtin_amdgcn_readfirstlane((int)__hip_atomic_load(cw, __ATOMIC_RELAXED, __HIP_MEMORY_SCOPE_AGENT)) < 64u) {
                    __builtin_amdgcn_s_sleep(1);
                    if ((++sp & 255u) == 0u) { if (__hip_atomic_load(tmo, __ATOMIC_RELAXED, __HIP_MEMORY_SCOPE_AGENT)) break; if (sp > (1u << 22)) { (void)__hip_atomic_fetch_add(tmo, 1u, __ATOMIC_RELAXED, __HIP_MEMORY_SCOPE_AGENT); break; } } }
                __builtin_amdgcn_fence(__ATOMIC_ACQUIRE, "agent"); }
            int* nxl = (int*)(smem + LDS_BYTES - 64);
            int my_next = 0; if (TID == 0) my_next = (int)__hip_atomic_fetch_add(cw + 1, 1u, __ATOMIC_RELAXED, __HIP_MEMORY_SCOPE_AGENT);
            for (;;) { SYNC(); if (TID == 0) nxl[0] = my_next; SYNC(); const int it = nxl[0]; if (it >= 8 * NCH) break;
                if (TID == 0) my_next = (int)__hip_atomic_fetch_add(cw + 1, 1u, __ATOMIC_RELAXED, __HIP_MEMORY_SCOPE_AGENT);
                hg_h3_task(a, smem, li, it); } }
        break;
    case 4: break;
#endif
    case 5:
        if (!EN(5)) break;
        if (even) resid_gemm_phase(a, smem, (const bf16*)(ws + WS_CAT), 1024, (const bf16*)(ws + WS_WOUT) + (size_t)li * DM * 1024, l);
        else resid_gemm_phase(a, smem, (const bf16*)(ws + WS_CAT), DM, (const bf16*)(ws + WS_PW2) + (size_t)li * DM * DM, l);
        break;
    case 6: if (EN(6)) route_phase(a, smem, l); break;
#ifdef EMU
    case 7: if (EN(7)) moe_gemm_phase8(a, smem, l, 0); break;
    case 8: if (EN(8)) moe_gemm_phase8(a, smem, l, 1); break;
#else
    case 7: if (EN(7)) moe_fused_phase(a, smem, l); break;
    case 8: break;
#endif
    }
}

#ifndef EMU
#define LAS __attribute__((address_space(3)))
#define XB_TMO      128
static_assert(XB_TMO == MOE_TMO_IDX && P0_CTR_IDX > XB_TMO && P0_CTR_IDX + 1 + DEPTH < 256, "timeout word / free words");
#define XB_XCNT(j)  (256  + 64 * (j))
#define XB_XSUB(j)  (1280 + 64 * (j))
#define XB_XGEN(j)  (2304 + 64 * (j))
#define XB_TOP      3328
#define XB_TOPGEN   3392
#define XCD_BAR_WORDS 3456
#define XB_SPIN_CAP (1u << 22)
__device__ __forceinline__ unsigned xb_ld(unsigned* p)              { return __hip_atomic_load(p, __ATOMIC_RELAXED, __HIP_MEMORY_SCOPE_AGENT); }
__device__ __forceinline__ unsigned xb_add(unsigned* p, unsigned v) { return __hip_atomic_fetch_add(p, v, __ATOMIC_RELAXED, __HIP_MEMORY_SCOPE_AGENT); }
__device__ __forceinline__ unsigned xb_xcc_id() { return (unsigned)__builtin_amdgcn_s_getreg((3 << 11) | 20) & 0xFu; }
#define XB_SPIN(cond, bar) do { unsigned _sp = 0; while (cond) { __builtin_amdgcn_s_sleep(1); \
    if ((++_sp & 255u) == 0u) { if (xb_ld(&(bar)[XB_TMO])) break; if (_sp > XB_SPIN_CAP) { atomicAdd(&(bar)[XB_TMO], 1u); break; } } } } while (0)
struct XcdBarrier { unsigned* bar; unsigned x; volatile LAS unsigned* st; };
__device__ __forceinline__ XcdBarrier xcd_barrier_post(unsigned* bar, volatile LAS unsigned* st) {
    XcdBarrier b; b.bar = bar; b.x = xb_xcc_id(); b.st = st;
    if (threadIdx.x == 0) (void)xb_add(&bar[XB_XCNT(b.x)], 1u);
    return b;
}
__device__ __forceinline__ void xcd_barrier_complete(unsigned* bar, unsigned x, unsigned& nloc, unsigned& nx) {
    const unsigned G = gridDim.x * gridDim.y * gridDim.z;
    unsigned sum, cnt, mine, sp = 0u;
    for (;;) {
        sum = 0u; cnt = 0u; mine = 0u;
#pragma unroll
        for (unsigned j = 0; j < 16; ++j) { const unsigned c = xb_ld(&bar[XB_XCNT(j)]); sum += c; cnt += (c > 0u) ? 1u : 0u; mine = (j == x) ? c : mine; }
        if (sum == G) break;
        __builtin_amdgcn_s_sleep(1);
        if ((++sp & 255u) == 0u) { if (xb_ld(&bar[XB_TMO])) break; if (sp > XB_SPIN_CAP) { atomicAdd(&bar[XB_TMO], 1u); break; } }
    }
    nloc = mine > 0u ? mine : 1u; nx = cnt > 0u ? cnt : 1u;
}
__device__ __forceinline__ void xcd_barrier(const XcdBarrier& b) {
    asm volatile("s_waitcnt vmcnt(0)" ::: "memory");
    __syncthreads();
    if (threadIdx.x == 0) {
        unsigned* bar = b.bar;
        __builtin_amdgcn_s_waitcnt(0);
        unsigned nloc = b.st[0], nx = b.st[1];
        if (nloc == 0u) { xcd_barrier_complete(bar, b.x, nloc, nx); b.st[0] = nloc; b.st[1] = nx; }
        const unsigned old = xb_add(&bar[XB_XSUB(b.x)], 1u);
        const unsigned gen = old / nloc;
        if (old + 1u == (gen + 1u) * nloc) {
            __builtin_amdgcn_fence(__ATOMIC_RELEASE, "agent");
            asm volatile("s_waitcnt vmcnt(0)" ::: "memory");
            const unsigned og = xb_add(&bar[XB_TOP], 1u);
            const unsigned tg = og / nx;
            if (og + 1u == (tg + 1u) * nx) xb_add(&bar[XB_TOPGEN], 1u);
            else XB_SPIN(xb_ld(&bar[XB_TOPGEN]) == tg, bar);
            __builtin_amdgcn_fence(__ATOMIC_ACQUIRE, "agent");
            xb_add(&bar[XB_XGEN(b.x)], 1u);
            asm volatile("s_waitcnt vmcnt(0)" ::: "memory");
        } else {
            XB_SPIN(xb_ld(&bar[XB_XGEN(b.x)]) == gen, bar);
            __builtin_amdgcn_fence(__ATOMIC_ACQUIRE, "agent");
            asm volatile("s_waitcnt vmcnt(0)" ::: "memory");
        }
    }
    __syncthreads();
}

__global__ void __launch_bounds__(NT, 2) mega(Args a) {
    extern __shared__ __attribute__((aligned(16))) unsigned char lds[];
    volatile LAS unsigned* st = (volatile LAS unsigned*)(LAS unsigned char*)(lds + LDS_BYTES - 16);
    if (threadIdx.x < 4) st[threadIdx.x] = 0u;
    __syncthreads();
    unsigned* barw = (unsigned*)(a.ws + WS_BAR);
    XcdBarrier bar = xcd_barrier_post(barw, st);
#pragma unroll 1
    for (int ph = 0; ph < N_PHASES; ++ph) {
        if (ph > 0 && ph < N_PHASES - 1) { int l_, s_; phase_decode(ph, l_, s_); if (s_ == 8 || (s_ == 4 && (l_ & 1) == 0)) continue; }
        run_phase(a, lds, ph);
#ifdef DUP
        { int lyr = 0, sub = 100; if (ph > 0 && ph < N_PHASES - 1) phase_decode(ph, lyr, sub);
          if (sub == (DUP % 1000) && (ph == 0 || lyr == DUP / 1000) && ph < N_PHASES - 1) { xcd_barrier(bar); run_phase(a, lds, ph); } }
#endif
        if (ph + 1 < N_PHASES) xcd_barrier(bar);
    }
    if (xb_ld(&barw[XB_TMO]) != 0u) {
        const size_t gt = (size_t)blockIdx.x * NT + threadIdx.x, gs = (size_t)gridDim.x * NT;
        for (size_t i = gt; i < (size_t)T * DM; i += gs) a.out[i] = __builtin_nanf("");
    }
}

extern "C" void kernel_launch(void* const* d_in, const int* in_sizes, int n_in, void* d_out, int out_size,
                              void* d_ws, size_t ws_size, hipStream_t stream) {
    static int grid = 0;
    if (grid == 0) {
        int dev = 0, cus = 0;
        if (hipGetDevice(&dev) != hipSuccess || hipDeviceGetAttribute(&cus, hipDeviceAttributeMultiprocessorCount, dev) != hipSuccess) { grid = -1; return; }
        if (hipFuncSetAttribute((const void*)mega, hipFuncAttributeMaxDynamicSharedMemorySize, LDS_BYTES) != hipSuccess) { grid = -1; return; }
        (void)hipGetLastError();
        grid = cus;
        if (n_in != 26 || out_size != T * DM || ws_size < WS_END) { fprintf(stderr, "kernel_launch: unexpected sizes n_in %d out %d ws %zu (need %zu)\n", n_in, out_size, ws_size, (size_t)WS_END); grid = -1; return; }
    }
    if (grid < 0) return;
    (void)hipMemsetAsync((unsigned char*)d_ws + WS_BAR, 0, XCD_BAR_WORDS * 4, stream);
    Args a{};
    for (int i = 0; i < 26; ++i) a.in[i] = (const float*)d_in[i];
    a.out = (float*)d_out; a.ws = (unsigned char*)d_ws;
    hipLaunchKernelGGL(mega, dim3(grid), dim3(NT), LDS_BYTES, stream, a);
}
#endif
```

```cpp
#ifdef EMU
#include "emu.h"
#define DEV static inline
#define MDEV inline
#define OPAQUE(p)
#define OPAQUE2(a, b)
#define TID emu_tid()
#define BID (EB->bid)
#define NBLK (EB->nblk)
#define SYNC() emu_sync_block()
#define WSYNC() emu_sync_wave()
#define mfma16(a, b, c) emu_mfma16(a, b, c)
DEV float shflx(float v, int m) { return emu_shfl_f(v, (emu_tid() & 63) ^ m); }
DEV int shflxi(int v, int m) { return (int)emu_shfl_u((unsigned)v, (emu_tid() & 63) ^ m); }
DEV float shfl(float v, int s) { return emu_shfl_f(v, s); }
DEV float dpp_ror1(float v) { const int l = emu_tid() & 63; return emu_shfl_f(v, (l & 48) | ((l - 1) & 15)); }
DEV int atomic_add_i(int* p, int v) { return __atomic_fetch_add(p, v, __ATOMIC_RELAXED); }
typedef float f32x2v __attribute__((vector_size(8)));
DEV float fexp2(float x) { return exp2f(x); }
DEV float frcp(float x) { return 1.0f / x; }
DEV float frsq(float x) { return 1.0f / sqrtf(x); }
typedef short s16x4 __attribute__((vector_size(8)));
static inline s16x4 emu_tr4(const unsigned short* p) {
    EmuWave& w = EB->wave[emu_tid() >> 6]; int l = emu_tid() & 63;
    const unsigned short** tab = (const unsigned short**)w.a;
    tab[l] = p; emu_sync_wave();
    s16x4 r; int g = l & 48, i = l & 15;
    for (int q = 0; q < 4; ++q) r[q] = (short)tab[g + 4 * q + (i >> 2)][i & 3];
    emu_sync_wave(); return r;
}
#define tr4(p) emu_tr4(p)
#else
#include <hip/hip_runtime.h>
#include <cstdio>
#include <cstdint>
typedef short bf16x8 __attribute__((ext_vector_type(8)));
typedef float f32x4 __attribute__((ext_vector_type(4)));
typedef unsigned u32x4 __attribute__((ext_vector_type(4)));
typedef unsigned u32x2 __attribute__((ext_vector_type(2)));
#define DEV __device__ __forceinline__
#define MDEV __device__ __forceinline__
#define OPAQUE(p) asm volatile("" : "+v"(p))
#define OPAQUE2(a, b) asm volatile("" : "+v"(a), "+v"(b))
DEV int tid_opaque() { int t = (int)threadIdx.x; asm volatile("" : "+v"(t)); return t; }
#define TID tid_opaque()
DEV int bid_opaque() { int b = (int)blockIdx.x; asm volatile("" : "+s"(b)); return b; }
#define BID bid_opaque()
#define NBLK ((int)gridDim.x)
#define SYNC() __syncthreads()
#define WSYNC() __builtin_amdgcn_wave_barrier()
#define mfma16(a, b, c) __builtin_amdgcn_mfma_f32_16x16x32_bf16(a, b, c, 0, 0, 0)
DEV int shflxi(int x, int m) {
    if (m == 1) return __builtin_amdgcn_update_dpp(x, x, 0xB1, 0xf, 0xf, true);
    if (m == 2) return __builtin_amdgcn_update_dpp(x, x, 0x4E, 0xf, 0xf, true);
    if (m == 4) return __builtin_amdgcn_ds_swizzle(x, (4 << 10) | 0x1F);
    if (m == 8) return __builtin_amdgcn_ds_swizzle(x, (8 << 10) | 0x1F);
    if (m == 16) return __builtin_amdgcn_ds_swizzle(x, (16 << 10) | 0x1F);
    if (m == 32) { const auto r = __builtin_amdgcn_permlane32_swap((unsigned)x, (unsigned)x, false, false); return (int)((threadIdx.x & 32) ? r[0] : r[1]); }
    return __shfl_xor(x, m);
}
DEV float shflx(float v, int m) { return __builtin_bit_cast(float, shflxi(__builtin_bit_cast(int, v), m)); }
DEV float dpp_ror1(float v) { return __builtin_bit_cast(float, __builtin_amdgcn_update_dpp(0, __builtin_bit_cast(int, v), 0x121, 0xf, 0xf, false)); }
DEV float shfl(float v, int s) { return __shfl(v, s); }
DEV int atomic_add_i(int* p, int v) { return atomicAdd(p, v); }
DEV float fexp2(float x) { return __builtin_amdgcn_exp2f(x); }
DEV float frcp(float x) { return __builtin_amdgcn_rcpf(x); }
DEV float frsq(float x) { return __builtin_amdgcn_rsqf(x); }
typedef short s16x4 __attribute__((ext_vector_type(4)));
#define tr4(p) __builtin_amdgcn_ds_read_tr16_b64_v4i16((__attribute__((address_space(3))) s16x4*)(p))
#endif

typedef unsigned short bf16;

#ifndef DM
#define DM 1024
#endif
#ifndef SEQ
#define SEQ 8192
#endif
#ifndef FF
#define FF 512
#endif
constexpr int NBATCH = 2, T = NBATCH * SEQ, DEPTH = 4;
constexpr int NIN = 3352, NINP = 3456, NIN8 = 3584;
constexpr int NT = 512;
constexpr int NCH = SEQ / 64;
constexpr int NCP = SEQ / 16;
constexpr int NCMP = NCP - 1;
constexpr int MOE_ROWS = 2 * T + 32 * 256;
constexpr float EPS = 1e-6f, NEGV = -1e30f, FORCEV = 1e4f, LOG2E = 1.4426950408889634f;

constexpr size_t al(size_t x) { return (x + 255) & ~(size_t)255; }
constexpr int P0_CTR_IDX = 192;
constexpr size_t WS_BAR = 0;
constexpr size_t WS_CNT = 16384;
constexpr size_t WS_MOD = WS_CNT + (size_t)DEPTH * 32 * 256;
constexpr size_t WS_LB = al(WS_MOD + (size_t)DEPTH * 2 * 6 * DM * 4);
constexpr size_t WS_CB = al(WS_LB + 2 * 512 * 4);
constexpr size_t WS_CS = al(WS_CB + 2 * 2 * 8 * 64 * 4);
constexpr size_t WS_WIN = al(WS_CS + 64);
constexpr size_t WS_WOUT = al(WS_WIN + (size_t)2 * NIN8 * DM * 2);
constexpr size_t WS_PW1 = al(WS_WOUT + (size_t)2 * DM * 1024 * 2);
constexpr size_t WS_PW2 = al(WS_PW1 + (size_t)2 * 2 * DM * DM * 2);
constexpr size_t WS_WC = al(WS_PW2 + (size_t)2 * DM * DM * 2);
constexpr size_t WS_W13 = al(WS_WC + (size_t)2 * 2 * 64 * 2048 * 2);
constexpr size_t WS_W2 = al(WS_W13 + (size_t)DEPTH * 32 * 2 * FF * DM * 2);
constexpr size_t WS_H = al(WS_W2 + (size_t)DEPTH * 32 * DM * FF * 2);
constexpr size_t WS_QN = al(WS_H + (size_t)T * DM * 2);
constexpr size_t WS_KCG = al(WS_QN + (size_t)T * 512 * 2);
constexpr size_t WS_VCG = al(WS_KCG + (size_t)T * 128 * 2);
constexpr size_t WS_KS = al(WS_VCG + (size_t)T * 128 * 2);
constexpr size_t WS_KW = al(WS_KS + (size_t)T * 128 * 2);
constexpr size_t WS_VST = al(WS_KW + (size_t)T * 128 * 2);
constexpr size_t WS_VWT = al(WS_VST + (size_t)T * 128 * 2);
constexpr size_t WS_KC = al(WS_VWT + (size_t)T * 128 * 2);
constexpr size_t WS_VCT = al(WS_KC + (size_t)4 * NCP * 64 * 2);
constexpr size_t WS_GATE = al(WS_VCT + (size_t)4 * NCP * 64 * 2);
constexpr size_t WS_HQ = al(WS_GATE + (size_t)T * 24 * 4);
constexpr size_t WS_HF = al(WS_HQ + (size_t)T * 512 * 2);
constexpr size_t WS_HV = al(WS_HF + (size_t)T * 512 * 4);
constexpr size_t WS_HGS = al(WS_HV + (size_t)T * 512 * 2);
constexpr size_t WS_UT = al(WS_HGS + (size_t)T * 512 * 2);
constexpr size_t WS_ST = al(WS_UT + (size_t)8 * NCH * 128 * 128 * 4);
constexpr size_t WS_GD = al(WS_ST + (size_t)8 * NCH * 128 * 128 * 2);
constexpr size_t WS_CAT = al(WS_GD + (size_t)8 * NCH * 128 * 4);
constexpr size_t WS_GLU = al(WS_CAT + (size_t)T * 1024 * 2);
constexpr size_t WS_TIE = al(WS_GLU + (size_t)T * DM * 2);
constexpr size_t WS_TIW = al(WS_TIE + (size_t)T * 2 * 4);
constexpr size_t WS_LIST = al(WS_TIW + (size_t)T * 2 * 4);
constexpr size_t WS_ACT = al(WS_LIST + (size_t)32 * T * 4);
constexpr size_t WS_YK = al(WS_ACT + (size_t)MOE_ROWS * FF * 2);
constexpr size_t WS_WTH = al(WS_YK + (size_t)MOE_ROWS * DM * 2);
constexpr size_t WS_WTL = al(WS_WTH + (size_t)DEPTH * 48 * DM * 2);
constexpr size_t WS_AVEC = al(WS_WTL + (size_t)DEPTH * 48 * DM * 2);
constexpr size_t WS_RBIAS = al(WS_AVEC + (size_t)DEPTH * 2 * DM * 4);
constexpr size_t WS_FLG = al(WS_RBIAS + (size_t)DEPTH * 2 * 48 * 4);
constexpr size_t WS_END = al(WS_FLG + (size_t)DEPTH * 256 * 64);

struct Args { const float* in[26]; float* out; unsigned char* ws; };
enum { I_X = 0, I_C, I_ADAW, I_ADAB, I_NMIX, I_NFFN, I_WIN, I_WOUT, I_CWK, I_CWV, I_CPE, I_QG, I_KG, I_LBL, I_OG,
       I_PW1, I_DW, I_DWB, I_LNG, I_LNB, I_PW2, I_WG, I_WE, I_W1, I_W3, I_W2 };

#ifdef EMU
DEV unsigned char* wsp(const Args& a) { return a.ws; }
DEV float* outp(const Args& a) { return a.out; }
#else
DEV unsigned char* launder_ptr(const void* p) { unsigned long long v = (unsigned long long)p; unsigned lo = (unsigned)v, hi = (unsigned)(v >> 32);
    lo = (unsigned)__builtin_amdgcn_readfirstlane((int)lo); hi = (unsigned)__builtin_amdgcn_readfirstlane((int)hi); asm volatile("" : "+s"(lo), "+s"(hi)); typedef __attribute__((address_space(1))) unsigned char* gptr_t; return (unsigned char*)(gptr_t)(((unsigned long long)hi << 32) | lo); }
DEV unsigned char* wsp(const Args& a) { return launder_ptr(a.ws); }
DEV float* outp(const Args& a) { return (float*)launder_ptr(a.out); }
#endif

#ifdef EMU
#define INP(a, X) ((a).in[X])
#else
DEV int zero_opaque() { int z = 0; asm volatile("" : "+s"(z)); return z; }
#define INP(a, X) ((a).in[(X) + zero_opaque()])
#endif

DEV unsigned f2bf(float f) { unsigned u = __builtin_bit_cast(unsigned, f); return (u + 0x7fffu + ((u >> 16) & 1u)) >> 16; }
DEV float bf2f(unsigned h) { return __builtin_bit_cast(float, h << 16); }
#ifdef EMU
DEV unsigned pk2(float lo, float hi) { return f2bf(lo) | (f2bf(hi) << 16); }
#else
typedef float f32x2_t __attribute__((ext_vector_type(2)));
typedef float f32x2v __attribute__((ext_vector_type(2)));
typedef __bf16 bf16x2_t __attribute__((ext_vector_type(2)));
DEV unsigned pk2(float lo, float hi) { f32x2_t v = {lo, hi}; bf16x2_t b = __builtin_convertvector(v, bf16x2_t); return __builtin_bit_cast(unsigned, b); }
#endif
DEV float sigm(float x) { return frcp(1.0f + fexp2(-x * LOG2E)); }
DEV float siluf(float x) { return x * sigm(x); }
DEV f32x4 f4zero() { f32x4 z = {0.f, 0.f, 0.f, 0.f}; return z; }
DEV bf16x8 pack8(f32x4 a, f32x4 b) {
    u32x4 w; w[0] = pk2(a[0], a[1]); w[1] = pk2(a[2], a[3]); w[2] = pk2(b[0], b[1]); w[3] = pk2(b[2], b[3]);
    return __builtin_bit_cast(bf16x8, w);
}
DEV void st_bf8(bf16* p, f32x4 a, f32x4 b) { u32x4 w; w[0] = pk2(a[0], a[1]); w[1] = pk2(a[2], a[3]); w[2] = pk2(b[0], b[1]); w[3] = pk2(b[2], b[3]); *(u32x4*)p = w; }
DEV void st_bf4(bf16* p, f32x4 v) { u32x2 w; w[0] = pk2(v[0], v[1]); w[1] = pk2(v[2], v[3]); *(u32x2*)p = w; }


#ifdef EMU
namespace pg8 {
constexpr int BM = 256, BK = 64, HALF = 128, NXCD = 8, WGM = 8;
typedef unsigned short bf16_t;
struct Unit { int pm, pn; };
struct Gemm { const bf16_t* A; const bf16_t* Bt; int M, N, K; };
struct StaticOrder {
    int nM, nN, nwg, G, c;
    void init(int M, int N, int G_, int c_) { nM = M / BM; nN = N / BM; nwg = nM * nN; G = G_; c = c_; }
    bool next(int i, Unit& u) const {
        const long L = (long)i * G + c; if (L >= nwg) return false;
        int wgid = (int)L; { const int q = nwg / NXCD, r = nwg % NXCD, xcd = wgid % NXCD, off = wgid / NXCD; wgid = (xcd < r ? xcd * (q + 1) : r * (q + 1) + (xcd - r) * q) + off; }
        const int nig = WGM * nN, gid = wgid / nig, fm = gid * WGM, gsz = (nM - fm) < WGM ? (nM - fm) : WGM;
        u.pm = fm + ((wgid % nig) % gsz); u.pn = (wgid % nig) / gsz; return true;
    }
};
struct SelNone { static constexpr bool GATHER = false; struct Ctx {}; Ctx ctx(const Unit&) const { return Ctx(); } size_t boff(const Ctx&) const { return 0; } unsigned aoff(const Ctx&, int) const { return 0u; } };
template <class Epi, class Sched, bool ALIGN_EPI = false, bool SP2 = false, class Sel = SelNone>
static inline void gemm_phase(unsigned char*, const Gemm g, const Sched& S, const Epi& E, const Sel& X = Sel()) {
    const int tid = emu_tid(), wid = tid >> 6, lane = tid & 63, wr = wid >> 2, wc = wid & 3, fr = lane & 15, fq = lane >> 4;
    Unit u;
    for (int ui = 0; S.next(ui, u); ++ui) {
        f32x4 acc[2][2][4][2]; const auto cx = X.ctx(u);
        for (int ai = 0; ai < 2; ++ai) for (int bj = 0; bj < 2; ++bj) for (int m = 0; m < 4; ++m) for (int n = 0; n < 2; ++n) for (int r = 0; r < 4; ++r) {
            const int row = 256 * u.pm + 128 * ai + 64 * wr + 16 * m + fr, col = 256 * u.pn + 128 * bj + 32 * wc + (Epi::PERM ? 8 * fq + 4 * n + r : 16 * n + 4 * fq + r); float sum = 0.f;
            const bf16_t* ap = Sel::GATHER ? (const bf16_t*)((const char*)g.A + X.aoff(cx, row - 256 * u.pm)) : g.A + (size_t)row * g.K; const bf16_t* bp = (const bf16_t*)((const char*)g.Bt + X.boff(cx)) + (size_t)col * g.K;
            for (int k = 0; k < g.K; ++k) sum += bf2f(ap[k]) * bf2f(bp[k]);
            acc[ai][bj][m][n][r] = sum; }
        E(acc, u, wr, wc, fr, fq);
    }
    emu_sync_block();
}
}
#else
namespace pg8 {
#define PG8_LAS __attribute__((address_space(3)))
typedef unsigned short bf16_t;
typedef short bf16x8 __attribute__((ext_vector_type(8)));
typedef float f32x4 __attribute__((ext_vector_type(4)));
typedef unsigned u32x4 __attribute__((ext_vector_type(4)));
constexpr int BM = 256, BK = 64, HALF = 128, HTB = HALF * BK * 2  , STAGE_BYTES = 8 * HTB, NXCD = 8, WGM = 8;

__host__ __device__ __forceinline__ int lds_byte(int r, int c) { const int st = (r >> 4) * 2 + (c >> 5), rr = r & 15, cc = c & 31, ob = rr * 64 + cc * 2; return st * 1024 + (ob ^ (((ob >> 9) & 1) << 5)); }
__host__ __device__ __forceinline__ void stage_rc(int b, int& R, int& C) { const int st = b / 1024, sb = b % 1024, swz = sb ^ (((sb >> 9) & 1) << 5); R = (st >> 1) * 16 + swz / 64; C = (st & 1) * 32 + (swz % 64) / 2; }
__host__ __device__ __forceinline__ int perm32(int rho) { const int n = rho >> 4, i = rho & 15; return 8 * (i >> 2) + 4 * n + (i & 3); }

struct Unit { int pm, pn; };
struct Gemm { const bf16_t* A; const bf16_t* Bt; int M, N, K; };

struct StaticOrder {
    int nM, nN, nwg, G, c;
    __host__ __device__ void init(int M, int N, int G_, int c_) { nM = M / BM; nN = N / BM; nwg = nM * nN; G = G_; c = c_; }
    __host__ __device__ bool next(int i, Unit& u) const {
        const long L = (long)i * G + c; if (L >= nwg) return false;
        int wgid = (int)L; { const int q = nwg / NXCD, r = nwg % NXCD, xcd = wgid % NXCD, off = wgid / NXCD; wgid = (xcd < r ? xcd * (q + 1) : r * (q + 1) + (xcd - r) * q) + off; }
        const int nig = WGM * nN, gid = wgid / nig, fm = gid * WGM, gsz = (nM - fm) < WGM ? (nM - fm) : WGM;
        u.pm = fm + ((wgid % nig) % gsz); u.pn = (wgid % nig) / gsz; return true;
    }
    __device__ __forceinline__ void a_ready(const Unit&) const {}
    __device__ __forceinline__ void done(const Unit&) const {}
};

__device__ __forceinline__ unsigned cvt_pk_bf16(float lo, float hi) { unsigned r; asm volatile("v_cvt_pk_bf16_f32 %0, %1, %2" : "=v"(r) : "v"(lo), "v"(hi)); return r; }
struct SelNone { static constexpr bool GATHER = false; struct Ctx {}; __device__ __forceinline__ Ctx ctx(const Unit&) const { return Ctx(); } __device__ __forceinline__ size_t boff(const Ctx&) const { return 0; } __device__ __forceinline__ unsigned aoff(const Ctx&, int) const { return 0u; } };
template <class Epi, class Sched, bool ALIGN_EPI = false, bool SP2 = false, class Sel = SelNone>
__device__ __forceinline__ void gemm_phase(PG8_LAS unsigned char* lds, const Gemm g, const Sched& S, const Epi& E, const Sel& X = Sel()) {
    constexpr bool GA = Sel::GATHER;
    const int tid = TID, wid = __builtin_amdgcn_readfirstlane(tid >> 6), lane = tid & 63, wr = wid >> 2, wc = wid & 3, fr = lane & 15, fq = lane >> 4;
    const int K = g.K, nt = K / BK;
    unsigned voffA[2], voffB[2]; int Rl[2]; unsigned Cl2[2];
#pragma unroll
    for (int i = 0; i < 2; ++i) { int R, C; stage_rc(tid * 16 + i * 8192, R, C); const int Rb = Epi::PERM ? ((R & ~31) + perm32(R & 31)) : R;
        voffA[i] = (unsigned)(R * K + C) * 2u; voffB[i] = (unsigned)(Rb * K + C) * 2u; Rl[i] = R; Cl2[i] = (unsigned)C * 2u; }
    unsigned vA[2][2], vAn[2][2];
    const size_t kstep = (size_t)(BK * 2);
    const size_t hstep = (size_t)HALF * K * 2;
    const size_t tstep = 2 * hstep;
    const unsigned ldsw = (unsigned)wid * 1024u;
    const int aoff = lds_byte(wr * 64 + fr, fq * 8), boff = lds_byte(wc * 32 + fr, fq * 8);
#define PG8_SA(b, h) (((b) * 2 + (h)) * HTB)
#define PG8_SB(b, h) ((4 + (b) * 2 + (h)) * HTB)
#define PG8_STAGE(bufoff, gbase, voff) do { _Pragma("unroll") for (int _i = 0; _i < 2; ++_i) \
        __builtin_amdgcn_global_load_lds((const unsigned*)((const char*)(gbase) + (voff)[_i]), (PG8_LAS unsigned*)(lds + (bufoff) + ldsw + _i * 8192), 16, 0, 0); } while (0)
#define PG8_STAGE_A(bufoff, p, h, nx) do { if constexpr (GA) { unsigned _vo[2] = {(nx) ? vAn[h][0] : vA[h][0], (nx) ? vAn[h][1] : vA[h][1]}; PG8_STAGE(bufoff, p, _vo); } else { PG8_STAGE(bufoff, (p) + (h) * hstep, voffA); } } while (0)
#define PG8_GATH(cx, dst) do { _Pragma("unroll") for (int _h = 0; _h < 2; ++_h) _Pragma("unroll") for (int _i = 0; _i < 2; ++_i) dst[_h][_i] = X.aoff(cx, 128 * _h + Rl[_i]) + Cl2[_i]; } while (0)
#define PG8_LDA(dst, b, h) do { _Pragma("unroll") for (int m = 0; m < 4; ++m) _Pragma("unroll") for (int k = 0; k < 2; ++k) dst[m][k] = *(const PG8_LAS bf16x8*)(lds + PG8_SA(b, h) + aoff + m * 2048 + k * 1024); } while (0)
#define PG8_LDB(dst, b, h) do { _Pragma("unroll") for (int n = 0; n < 2; ++n) _Pragma("unroll") for (int k = 0; k < 2; ++k) dst[n][k] = *(const PG8_LAS bf16x8*)(lds + PG8_SB(b, h) + boff + n * 2048 + k * 1024); } while (0)
#define PG8_MMA(ai, bj, At, Bt) do { __builtin_amdgcn_s_setprio(1); _Pragma("unroll") for (int m = 0; m < 4; ++m) _Pragma("unroll") for (int n = 0; n < 2; ++n) _Pragma("unroll") for (int k = 0; k < 2; ++k) \
        acc[ai][bj][m][n] = __builtin_amdgcn_mfma_f32_16x16x32_bf16(Bt[n][k], At[m][k], acc[ai][bj][m][n], 0, 0, 0); __builtin_amdgcn_s_setprio(0); } while (0)
#define PG8_WAIT_V(n) asm volatile("s_waitcnt vmcnt(" #n ")" ::: "memory")
#define PG8_WAIT_L(n) asm volatile("s_waitcnt lgkmcnt(" #n ")" ::: "memory")
#define PG8_BAR __builtin_amdgcn_s_barrier()
#define PG8_SCHED __builtin_amdgcn_sched_barrier(0)
    Unit cur, nxt; int ui = 0;
    if (!S.next(0, cur)) return;
    f32x4 acc[2][2][4][2];
#pragma unroll
    for (int a = 0; a < 2; ++a)
#pragma unroll
        for (int b = 0; b < 2; ++b)
#pragma unroll
            for (int m = 0; m < 4; ++m)
#pragma unroll
                for (int n = 0; n < 2; ++n) acc[a][b][m][n] = (f32x4){0.f, 0.f, 0.f, 0.f};
    bf16x8 At[4][2], B0[2][2], B1[2][2];
    auto ccx = X.ctx(cur);
    const char* cA = GA ? (const char*)g.A : (const char*)g.A + (size_t)cur.pm * tstep; const char* cB = (const char*)g.Bt + X.boff(ccx) + (size_t)cur.pn * tstep;
    if constexpr (GA) { PG8_GATH(ccx, vA); }
    S.a_ready(cur);
    if constexpr (SP2) {
        PG8_STAGE(PG8_SB(0, 0), cB, voffB); PG8_STAGE(PG8_SB(0, 1), cB + hstep, voffB); PG8_STAGE_A(PG8_SA(0, 0), cA, 0, false); PG8_STAGE_A(PG8_SA(0, 1), cA, 1, false);
        if (wr == 1) PG8_BAR;
        PG8_WAIT_V(2); PG8_BAR;
        PG8_STAGE(PG8_SB(1, 0), cB + kstep, voffB); PG8_STAGE_A(PG8_SA(1, 0), cA + kstep, 0, false); PG8_STAGE(PG8_SB(1, 1), cB + hstep + kstep, voffB);
        PG8_WAIT_V(6); PG8_BAR;
    } else {
        PG8_STAGE(PG8_SB(0, 0), cB, voffB); PG8_STAGE_A(PG8_SA(0, 0), cA, 0, false); PG8_STAGE(PG8_SB(0, 1), cB + hstep, voffB); PG8_STAGE_A(PG8_SA(0, 1), cA, 1, false);
        if (wr == 1) PG8_BAR;
        PG8_WAIT_V(4); PG8_BAR;
        PG8_STAGE(PG8_SB(1, 0), cB + kstep, voffB); PG8_STAGE_A(PG8_SA(1, 0), cA + kstep, 0, false); PG8_STAGE(PG8_SB(1, 1), cB + hstep + kstep, voffB);
        PG8_WAIT_V(6); PG8_BAR;
    }
    for (;;) {
        const bool has_next = S.next(ui + 1, nxt);
        const char* nA = cA; const char* nB = cB;
        if (has_next) { const auto ncx = X.ctx(nxt); nA = GA ? (const char*)g.A : (const char*)g.A + (size_t)nxt.pm * tstep; nB = (const char*)g.Bt + X.boff(ncx) + (size_t)nxt.pn * tstep; if constexpr (GA) { PG8_GATH(ncx, vAn); } }
        else if constexpr (GA) {
#pragma unroll
            for (int _h = 0; _h < 2; ++_h) { vAn[_h][0] = vA[_h][0]; vAn[_h][1] = vA[_h][1]; } }
        for (int t = 0; t < nt; t += 2) {
            const bool last = (t == nt - 2);
            const char* a1 = cA + (size_t)(t + 1) * kstep;
            const char* a2 = last ? nA : cA + (size_t)(t + 2) * kstep; const char* b2 = last ? nB : cB + (size_t)(t + 2) * kstep;
            const char* a3 = a2 + kstep; const char* b3 = b2 + kstep;
            if (last && has_next) S.a_ready(nxt);
            if constexpr (SP2) {
            PG8_LDB(B0, 0, 0); PG8_LDB(B1, 0, 1); PG8_SCHED; PG8_LDA(At, 0, 0); PG8_STAGE_A(PG8_SA(1, 1), a1, 1, false);
            PG8_WAIT_V(8); PG8_WAIT_L(0); PG8_BAR; PG8_MMA(0, 0, At, B0); PG8_MMA(0, 1, At, B1); PG8_BAR; PG8_SCHED;
            PG8_LDA(At, 0, 1); PG8_STAGE(PG8_SB(0, 0), b2, voffB); PG8_STAGE(PG8_SB(0, 1), b2 + hstep, voffB); PG8_STAGE_A(PG8_SA(0, 0), a2, 0, last);
            PG8_WAIT_V(8); PG8_WAIT_L(0); PG8_BAR; PG8_MMA(1, 0, At, B0); PG8_MMA(1, 1, At, B1); PG8_BAR; PG8_SCHED;
            PG8_LDB(B0, 1, 0); PG8_LDB(B1, 1, 1); PG8_SCHED; PG8_LDA(At, 1, 0); PG8_STAGE_A(PG8_SA(0, 1), a2, 1, last);
            PG8_WAIT_V(8); PG8_WAIT_L(0); PG8_BAR; PG8_MMA(0, 0, At, B0); PG8_MMA(0, 1, At, B1); PG8_BAR; PG8_SCHED;
            PG8_LDA(At, 1, 1); PG8_STAGE(PG8_SB(1, 0), b3, voffB); PG8_STAGE(PG8_SB(1, 1), b3 + hstep, voffB); PG8_STAGE_A(PG8_SA(1, 0), a3, 0, last);
            PG8_WAIT_V(8); PG8_WAIT_L(0); PG8_BAR; PG8_MMA(1, 0, At, B0); PG8_MMA(1, 1, At, B1); PG8_BAR; PG8_SCHED;
            } else {
            PG8_LDB(B0, 0, 0); PG8_SCHED; PG8_LDA(At, 0, 0); PG8_STAGE_A(PG8_SA(1, 1), a1, 1, false);
            PG8_WAIT_L(8); PG8_BAR; PG8_WAIT_L(0); PG8_MMA(0, 0, At, B0); PG8_BAR; PG8_SCHED;
            PG8_LDB(B1, 0, 1); PG8_STAGE(PG8_SB(0, 0), b2, voffB);
            PG8_BAR; PG8_WAIT_L(0); PG8_MMA(0, 1, At, B1); PG8_BAR;
            PG8_LDA(At, 0, 1); PG8_STAGE_A(PG8_SA(0, 0), a2, 0, last);
            PG8_BAR; PG8_WAIT_L(0); PG8_MMA(1, 0, At, B0); PG8_BAR; PG8_SCHED;
            PG8_STAGE(PG8_SB(0, 1), b2 + hstep, voffB);
            PG8_WAIT_V(6); PG8_BAR; PG8_MMA(1, 1, At, B1); PG8_BAR;
            PG8_LDB(B0, 1, 0); PG8_SCHED; PG8_LDA(At, 1, 0); PG8_STAGE_A(PG8_SA(0, 1), a2, 1, last);
            PG8_WAIT_L(8); PG8_BAR; PG8_WAIT_L(0); PG8_MMA(0, 0, At, B0); PG8_BAR; PG8_SCHED;
            PG8_LDB(B1, 1, 1); PG8_STAGE(PG8_SB(1, 0), b3, voffB);
            PG8_BAR; PG8_WAIT_L(0); PG8_MMA(0, 1, At, B1); PG8_BAR;
            PG8_LDA(At, 1, 1); PG8_STAGE_A(PG8_SA(1, 0), a3, 0, last);
            PG8_BAR; PG8_WAIT_L(0); PG8_MMA(1, 0, At, B0); PG8_BAR; PG8_SCHED;
            PG8_STAGE(PG8_SB(1, 1), b3 + hstep, voffB);
            PG8_WAIT_V(6); PG8_BAR; PG8_MMA(1, 1, At, B1); PG8_BAR;
            }
        }
        if constexpr (ALIGN_EPI) { if (wr == 0) PG8_BAR; }
        if constexpr (!Epi::AFTER_DRAIN) { E(acc, cur, wr, wc, fr, fq); S.done(cur); }
        if (!has_next) break;
#pragma unroll
        for (int a = 0; a < 2; ++a)
#pragma unroll
            for (int b = 0; b < 2; ++b)
#pragma unroll
                for (int m = 0; m < 4; ++m)
#pragma unroll
                    for (int n = 0; n < 2; ++n) acc[a][b][m][n] = (f32x4){0.f, 0.f, 0.f, 0.f};
        cur = nxt; cA = nA; cB = nB; ++ui;
        if constexpr (GA) {
#pragma unroll
            for (int _h = 0; _h < 2; ++_h) { vA[_h][0] = vAn[_h][0]; vA[_h][1] = vAn[_h][1]; } }
        if constexpr (ALIGN_EPI) { if (wr == 1) PG8_BAR; }
    }
    PG8_WAIT_V(0);
    if constexpr (!ALIGN_EPI) { if (wr == 0) PG8_BAR; }
    PG8_BAR;
    if constexpr (Epi::AFTER_DRAIN) { E.fused(acc, cur, wr, wc, fr, fq, lds, wid, lane); S.done(cur); }
#undef PG8_SA
#undef PG8_SB
#undef PG8_STAGE
#undef PG8_STAGE_A
#undef PG8_GATH
#undef PG8_LDA
#undef PG8_LDB
#undef PG8_MMA
#undef PG8_WAIT_V
#undef PG8_WAIT_L
#undef PG8_BAR
#undef PG8_SCHED
}
}
#endif

constexpr int LDT = 72;
constexpr int GEMM_AS = 256 * LDT, GEMM_BS = 128 * LDT;
constexpr int GEMM_LDS = 2 * (GEMM_AS + GEMM_BS) * 2;

template <class AF, class EPI>
DEV void gemm_tile(unsigned char* smem, AF af, const bf16* Bt, int ldb, int nvalid, int K, EPI& epi) {
    const int tid = TID, w = tid >> 6, l = tid & 63, h = l >> 4, c = l & 15, wm = w >> 1, wn = w & 1;
    bf16* As = (bf16*)smem; bf16* Bs = As + 2 * GEMM_AS;
    const bf16* ap[4]; const bf16* bp[2];
    const int col8 = (tid & 7) * 8, r0 = tid >> 3;
#pragma unroll
    for (int i = 0; i < 4; ++i) ap[i] = af(r0 + 64 * i) + col8;
#pragma unroll
    for (int i = 0; i < 2; ++i) { int rn = r0 + 64 * i; if (rn >= nvalid) rn = nvalid - 1; bp[i] = Bt + (size_t)rn * ldb + col8; }
    f32x4 acc[4][4];
#pragma unroll
    for (int i = 0; i < 4; ++i)
#pragma unroll
        for (int j = 0; j < 4; ++j) acc[i][j] = f4zero();
    bf16x8 ra[4], rb[2];
#pragma unroll
    for (int i = 0; i < 4; ++i) ra[i] = *(const bf16x8*)(ap[i]);
#pragma unroll
    for (int i = 0; i < 2; ++i) rb[i] = *(const bf16x8*)(bp[i]);
    SYNC();
#pragma unroll
    for (int i = 0; i < 4; ++i) *(bf16x8*)(As + (r0 + 64 * i) * LDT + col8) = ra[i];
#pragma unroll
    for (int i = 0; i < 2; ++i) *(bf16x8*)(Bs + (r0 + 64 * i) * LDT + col8) = rb[i];
    SYNC();
    const int nk = K / 64;
    for (int kt = 0; kt < nk; ++kt) {
        const int cur = kt & 1;
        if (kt + 1 < nk) {
#pragma unroll
            for (int i = 0; i < 4; ++i) ra[i] = *(const bf16x8*)(ap[i] + (kt + 1) * 64);
#pragma unroll
            for (int i = 0; i < 2; ++i) rb[i] = *(const bf16x8*)(bp[i] + (kt + 1) * 64);
        }
        const bf16* Ac = As + cur * GEMM_AS + (wm * 64 + c) * LDT + 8 * h;
        const bf16* Bc = Bs + cur * GEMM_BS + (wn * 64 + c) * LDT + 8 * h;
#pragma unroll
        for (int kk = 0; kk < 2; ++kk) {
            bf16x8 fa[4], fb[4];
#pragma unroll
            for (int i = 0; i < 4; ++i) { fa[i] = *(const bf16x8*)(Ac + i * 16 * LDT + kk * 32); fb[i] = *(const bf16x8*)(Bc + i * 16 * LDT + kk * 32); }
#pragma unroll
            for (int ni = 0; ni < 4; ++ni)
#pragma unroll
                for (int mi = 0; mi < 4; ++mi) acc[ni][mi] = mfma16(fb[ni], fa[mi], acc[ni][mi]);
        }
        if (kt + 1 < nk) {
            const int nx = cur ^ 1;
#pragma unroll
            for (int i = 0; i < 4; ++i) *(bf16x8*)(As + nx * GEMM_AS + (r0 + 64 * i) * LDT + col8) = ra[i];
#pragma unroll
            for (int i = 0; i < 2; ++i) *(bf16x8*)(Bs + nx * GEMM_BS + (r0 + 64 * i) * LDT + col8) = rb[i];
        }
        SYNC();
    }
    epi(acc, wm * 64, wn * 64, h, c);
}

struct ARows { const bf16* base; size_t ld; MDEV const bf16* operator()(int r) const { return base + (size_t)r * ld; } MDEV unsigned off(int r) const { return (unsigned)r * (unsigned)ld; } };

constexpr int LDB = 144;
constexpr int GEMM_BS2 = 64 * LDB;
constexpr int GEMM2_LDS = (2 * GEMM_AS + 2 * GEMM_BS2) * 2;
DEV bf16x8 tr_read8(const bf16* p0, const bf16* p1) {
    const s16x4 x = tr4(p0), y = tr4(p1); bf16x8 r;
    r[0] = x[0]; r[1] = x[1]; r[2] = x[2]; r[3] = x[3]; r[4] = y[0]; r[5] = y[1]; r[6] = y[2]; r[7] = y[3]; return r;
}
DEV int bperm(int r) { return (r & ~12) | ((r & 4) << 1) | ((r & 8) >> 1); }
template <class AF, class BF, class EPI>
DEV void gemm_tile2(unsigned char* smem, AF af, BF bf, int ldb, int K, EPI& epi) {
    const int tid = TID, w = tid >> 6, l = tid & 63, h = l >> 4, c = l & 15, wm = w >> 1, wn = w & 1, grp = w >> 2;
    bf16* As = (bf16*)smem; bf16* Bs = As + 2 * GEMM_AS;
    const bf16* abase = af.base; unsigned ao[4];
    const int col8 = (tid & 7) * 8, r0 = tid >> 3;
#pragma unroll
    for (int i = 0; i < 4; ++i) ao[i] = af.off(r0 + 64 * i) + col8;
    const int bn4 = (tid & 31) * 4, bk = tid >> 5, bkp = bperm(bk);
    const float* bp = bf(bn4); const bool bok = bp != nullptr;
    if (bok) bp += (size_t)bk * ldb;
    const size_t bstep = (size_t)16 * ldb;
    f32x4 acc[4][4];
#pragma unroll
    for (int i = 0; i < 4; ++i)
#pragma unroll
        for (int j = 0; j < 4; ++j) acc[i][j] = f4zero();
    bf16x8 ra[4]; f32x4 rb[4];
    const int nk = K / 64;
#pragma unroll
    for (int i = 0; i < 4; ++i) { ra[i] = *(const bf16x8*)(abase + ao[i]); rb[i] = bok ? *(const f32x4*)(bp + i * bstep) : f4zero(); }
    SYNC();
#pragma unroll
    for (int i = 0; i < 4; ++i) { *(bf16x8*)(As + (r0 + 64 * i) * LDT + col8) = ra[i]; st_bf4(Bs + (bkp + 16 * i) * LDB + bn4, rb[i]); }
    if (nk > 1) {
#pragma unroll
        for (int i = 0; i < 4; ++i) { ra[i] = *(const bf16x8*)(abase + (ao[i] + 64)); rb[i] = bok ? *(const f32x4*)(bp + (size_t)64 * ldb + i * bstep) : f4zero(); } }
    SYNC();
    for (int kt = 0; kt < nk; ++kt) {
        const int cur = kt & 1;
#pragma unroll
        for (int p = 0; p < 2; ++p) {
            if (grp == p) {
                const bf16* Ac = As + cur * GEMM_AS + (wm * 64 + c) * LDT + 8 * h;
                const bf16* Bc = Bs + cur * GEMM_BS2 + bperm(8 * h + (c >> 2)) * LDB + wn * 64 + 4 * (c & 3);
#pragma unroll
                for (int kk = 0; kk < 2; ++kk) {
                    bf16x8 fa[4], fb[4];
#pragma unroll
                    for (int i = 0; i < 4; ++i) { fa[i] = *(const bf16x8*)(Ac + i * 16 * LDT + kk * 32); fb[i] = tr_read8(Bc + (32 * kk) * LDB + 16 * i, Bc + (32 * kk + 8) * LDB + 16 * i); }
#pragma unroll
                    for (int ni = 0; ni < 4; ++ni)
#pragma unroll
                        for (int mi = 0; mi < 4; ++mi) acc[ni][mi] = mfma16(fb[ni], fa[mi], acc[ni][mi]);
                }
            } else if (kt + 1 < nk) {
                const int nx = cur ^ 1;
#pragma unroll
                for (int i = 0; i < 4; ++i) { *(bf16x8*)(As + nx * GEMM_AS + (r0 + 64 * i) * LDT + col8) = ra[i]; st_bf4(Bs + nx * GEMM_BS2 + (bkp + 16 * i) * LDB + bn4, rb[i]); }
                if (kt + 2 < nk) {
#pragma unroll
                    for (int i = 0; i < 4; ++i) { ra[i] = *(const bf16x8*)(abase + (ao[i] + (kt + 2) * 64)); rb[i] = bok ? *(const f32x4*)(bp + (size_t)(kt + 2) * 64 * ldb + i * bstep) : f4zero(); } }
            }
            SYNC();
        }
    }
    epi(acc, wm * 64, wn * 64, h, c);
}
struct BPlain { const float* base; MDEV const float* operator()(int nt) const { return base + nt; } };
struct BInProjMap { const float* base; int n0; MDEV const float* operator()(int nt) const { const int n = n0 + nt; const int sc = n < 1280 ? n : (n < 3328 ? n + 24 : (n < 3352 ? 1280 + (n - 3328) : -1)); return sc < 0 ? nullptr : base + sc; } };
struct BInter { const float* s0; const float* s1; int n0; MDEV const float* operator()(int nt) const { const int n = n0 + nt, g = n >> 6, w = n & 63; return w < 32 ? s0 + g * 32 + w : s1 + g * 32 + w - 32; } };
struct BClamp64 { const float* base; MDEV const float* operator()(int nt) const { return base + (nt & 63); } };

struct EpiInProj {
    const Args* a; int m0, n0, li;
    MDEV void operator()(f32x4 (&acc)[4][4], int mw, int nw, int h, int c) const {
        unsigned char* ws = wsp(*a);
        const int nb = n0 + nw;
        const int tokb = m0 + mw + c;
        if (nb < 512 || (nb >= 768 && nb < 896) || (nb >= 1024 && nb < 1152)) {
            const float* gain; float mul = 1.f; bf16* dst; int kind;
            if (nb < 512) { gain = INP(*a, I_QG) + li * 64; mul = 0.125f * LOG2E; kind = 0; dst = (bf16*)(ws + WS_QN); }
            else if (nb < 896) { gain = INP(*a, I_KG) + (li * 3 + 1) * 64; kind = 1; dst = (bf16*)(ws + WS_KS); }
            else { gain = INP(*a, I_KG) + (li * 3 + 2) * 64; kind = 1; dst = (bf16*)(ws + WS_KW); }
            const int g = (nb >> 6) & 1;
#pragma unroll
            for (int mi = 0; mi < 4; ++mi) {
                float ss = 0.f;
#pragma unroll
                for (int ni = 0; ni < 4; ++ni) { f32x4 v = acc[ni][mi]; ss += v[0] * v[0] + v[1] * v[1] + v[2] * v[2] + v[3] * v[3]; }
                ss += shflx(ss, 16); ss += shflx(ss, 32);
                const float rs = frsq(ss * (1.0f / 64.0f) + EPS) * mul;
                const int tok = tokb + 16 * mi;
#pragma unroll
                for (int ni = 0; ni < 4; ++ni) {
                    const int d = 16 * ni + 4 * h; f32x4 v = acc[ni][mi], o;
#pragma unroll
                    for (int r = 0; r < 4; ++r) o[r] = v[r] * rs * gain[d + r];
                    if (kind == 0) st_bf4(dst + (size_t)tok * 512 + nb + d, o);
                    else { const int b = tok / SEQ, s = tok % SEQ; st_bf4(dst + ((size_t)(b * 2 + g) * SEQ + s) * 64 + d, o); }
                }
            }
        } else if (nb < 768) {
            bf16* dst = (bf16*)(ws + (nb < 640 ? WS_KCG : WS_VCG)); const int g = (nb >> 6) & 1;
#pragma unroll
            for (int mi = 0; mi < 4; ++mi) { const int tok = tokb + 16 * mi, b = tok / SEQ, s = tok % SEQ;
#pragma unroll
                for (int ni = 0; ni < 4; ++ni) st_bf4(dst + ((size_t)(b * 2 + g) * SEQ + s) * 64 + 16 * ni + 4 * h, acc[ni][mi]); }
        } else if (nb < 1280) {
            bf16* dst = (bf16*)(ws + (nb < 1024 ? WS_VST : WS_VWT)); const int g = (nb >> 6) & 1;
#pragma unroll
            for (int mi = 0; mi < 4; ++mi) { const int tok = tokb + 16 * mi, b = tok / SEQ, s = tok % SEQ;
                bf16* p = dst + ((size_t)(b * 2 + g) * NCH + (s >> 6)) * 4096 + (s & 63);
#pragma unroll
                for (int ni = 0; ni < 4; ++ni)
#pragma unroll
                    for (int r = 0; r < 4; ++r) p[(16 * ni + 4 * h + r) * 64] = (bf16)f2bf(acc[ni][mi][r]); }
        } else if (nb < 3328) {
            const int sec = (nb - 1280) >> 9, cc = (nb - 1280) & 511, hh = cc >> 7, d0 = cc & 127;
#pragma unroll
            for (int mi = 0; mi < 4; ++mi) { const int tok = tokb + 16 * mi, b = tok / SEQ, s = tok % SEQ;
                const size_t hrow = ((size_t)(b * 4 + hh) * SEQ + s) * 128 + d0;
#pragma unroll
                for (int ni = 0; ni < 4; ++ni) { const int d = 16 * ni + 4 * h; f32x4 v = acc[ni][mi], o;
                    if (sec == 0) { for (int r = 0; r < 4; ++r) o[r] = siluf(v[r]); st_bf4((bf16*)(ws + WS_HQ) + hrow + d, o); }
                    else if (sec == 1) { const float* lb = (const float*)(ws + WS_LB) + li * 512 + cc + d;
                        for (int r = 0; r < 4; ++r) o[r] = lb[r] + (1.0f - lb[r]) * sigm(v[r]);
                        *(f32x4*)((float*)(ws + WS_HF) + hrow + d) = o; }
                    else if (sec == 2) st_bf4((bf16*)(ws + WS_HV) + hrow + d, v);
                    else { for (int r = 0; r < 4; ++r) o[r] = siluf(v[r]); st_bf4((bf16*)(ws + WS_HGS) + (size_t)tok * 512 + cc + d, o); }
                } }
        } else if (nb == 3328) {
            float* dst = (float*)(ws + WS_GATE);
#pragma unroll
            for (int mi = 0; mi < 4; ++mi) { const int tok = tokb + 16 * mi;
#pragma unroll
                for (int ni = 0; ni < 2; ++ni)
#pragma unroll
                    for (int r = 0; r < 4; ++r) { const int n = 16 * ni + 4 * h + r; if (n < 24) dst[(size_t)tok * 24 + n] = sigm(acc[ni][mi][r]); } }
        }
    }
};

struct EpiResid {
    float* x; const float* gate; int m0, n0;
    MDEV void operator()(f32x4 (&acc)[4][4], int mw, int nw, int h, int c) const {
#pragma unroll
        for (int mi = 0; mi < 4; ++mi) { const int tok = m0 + mw + 16 * mi + c, b = tok / SEQ;
#pragma unroll
            for (int ni = 0; ni < 4; ++ni) { const int n = n0 + nw + 16 * ni + 4 * h;
                f32x4 g = *(const f32x4*)(gate + (size_t)b * 6 * DM + n); f32x4* p = (f32x4*)(x + (size_t)tok * DM + n); f32x4 v = *p;
#pragma unroll
                for (int r = 0; r < 4; ++r) v[r] += g[r] * acc[ni][mi][r];
                *p = v; } }
    }
};
template <int MODE> struct EpiGated {
    bf16* dst; size_t ld; int m0, n0, mvalid;
    MDEV void operator()(f32x4 (&acc)[4][4], int mw, int nw, int h, int c) const {
        const int cb = (n0 + nw) / 2;
#pragma unroll
        for (int mi = 0; mi < 4; ++mi) { const int m = mw + 16 * mi + c; if (m >= mvalid) continue;
#pragma unroll
            for (int ni = 0; ni < 2; ++ni) { f32x4 o;
#pragma unroll
                for (int r = 0; r < 4; ++r) { const float av = acc[ni][mi][r], bv = acc[ni + 2][mi][r]; o[r] = MODE == 0 ? av * sigm(bv) : siluf(av) * bv; }
                st_bf4(dst + (size_t)(m0 + m) * ld + cb + 16 * ni + 4 * h, o); } }
    }
};
struct EpiStoreBf {
    bf16* dst; size_t ld; int m0, n0, mvalid;
    MDEV void operator()(f32x4 (&acc)[4][4], int mw, int nw, int h, int c) const {
#pragma unroll
        for (int mi = 0; mi < 4; ++mi) { const int m = mw + 16 * mi + c; if (m >= mvalid) continue;
#pragma unroll
            for (int ni = 0; ni < 4; ++ni) st_bf4(dst + (size_t)(m0 + m) * ld + n0 + nw + 16 * ni + 4 * h, acc[ni][mi]); }
    }
};
struct EpiCmp {
    const Args* a; int kv, bg, m0, li;
    MDEV void operator()(f32x4 (&acc)[4][4], int mw, int nw, int h, int c) const {
        if (nw != 0) return;
        unsigned char* ws = wsp(*a);
        const float* bp8 = (const float*)(ws + WS_CB) + (li * 2 + kv) * 8 * 64;
        float bias[16];
#pragma unroll
        for (int q = 0; q < 16; ++q) { const int e = 16 * (q >> 2) + 4 * h + (q & 3); float v = 0.f;
#pragma unroll
            for (int kp = 0; kp < 8; ++kp) v += bp8[kp * 64 + e];
            bias[q] = v; }
        const float* gain = INP(*a, I_KG) + (li * 3 + 0) * 64;
#pragma unroll
        for (int mi = 0; mi < 4; ++mi) { const int n = m0 + mw + 16 * mi + c; const bool ok = n < NCMP;
            f32x4 v[4]; float ss = 0.f;
#pragma unroll
            for (int ni = 0; ni < 4; ++ni) { v[ni] = acc[ni][mi];
#pragma unroll
                for (int r = 0; r < 4; ++r) { v[ni][r] += bias[4 * ni + r]; ss += v[ni][r] * v[ni][r]; } }
            ss += shflx(ss, 16); ss += shflx(ss, 32);
            if (n >= NCP) continue;
            if (kv == 0) { const float rs = frsq(ss * (1.0f / 64.0f) + EPS); bf16* p = (bf16*)(ws + WS_KC) + ((size_t)bg * NCP + n) * 64;
#pragma unroll
                for (int ni = 0; ni < 4; ++ni) { f32x4 o;
#pragma unroll
                    for (int r = 0; r < 4; ++r) o[r] = ok ? v[ni][r] * rs * gain[16 * ni + 4 * h + r] : 0.f;
                    st_bf4(p + 16 * ni + 4 * h, o); }
            } else { bf16* p = (bf16*)(ws + WS_VCT) + ((size_t)bg * NCP + n) * 64;
#pragma unroll
                for (int ni = 0; ni < 4; ++ni) { f32x4 o;
#pragma unroll
                    for (int r = 0; r < 4; ++r) o[r] = ok ? v[ni][r] : 0.f;
                    st_bf4(p + 16 * ni + 4 * h, o); } }
        }
    }
};


struct EpiResid8 {
    static constexpr bool PERM = true, AFTER_DRAIN = false;
    float* x; const float* gate; const float* xin;
    MDEV void operator()(const f32x4 (&acc)[2][2][4][2], const pg8::Unit& u, int wr, int wc, int fr, int fq) const {
        OPAQUE2(fr, fq);
#pragma unroll
        for (int ai = 0; ai < 2; ++ai)
#pragma unroll
            for (int m = 0; m < 4; ++m) { const int row = 256 * u.pm + 128 * ai + 64 * wr + 16 * m + fr, b = row / SEQ;
#pragma unroll
                for (int bj = 0; bj < 2; ++bj)
#pragma unroll
                    for (int n = 0; n < 2; ++n) { const int col = 256 * u.pn + 128 * bj + 32 * wc + 8 * fq + 4 * n;
                        const f32x4 g = *(const f32x4*)(gate + (size_t)b * 6 * DM + col); f32x4* p = (f32x4*)(x + (size_t)row * DM + col); f32x4 v = *(const f32x4*)(xin + (size_t)row * DM + col);
#pragma unroll
                        for (int r = 0; r < 4; ++r) v[r] += g[r] * acc[ai][bj][m][n][r];
                        *p = v; } }
    }
};
struct EpiGlu8 {
    static constexpr bool PERM = true, AFTER_DRAIN = false;
    bf16* dst;
    MDEV void operator()(const f32x4 (&acc)[2][2][4][2], const pg8::Unit& u, int wr, int wc, int fr, int fq) const {
        OPAQUE2(fr, fq);
#pragma unroll
        for (int ai = 0; ai < 2; ++ai)
#pragma unroll
            for (int m = 0; m < 4; ++m) { const int row = 256 * u.pm + 128 * ai + 64 * wr + 16 * m + fr;
#pragma unroll
                for (int bj = 0; bj < 2; ++bj) { const int col = 128 * u.pn + 64 * bj + 16 * wc + 4 * fq; f32x4 o;
#pragma unroll
                    for (int r = 0; r < 4; ++r) o[r] = acc[ai][bj][m][0][r] * sigm(acc[ai][bj][m][1][r]);
                    st_bf4(dst + (size_t)row * DM + col, o); } }
    }
};
struct EpiMoe1_8 {
    static constexpr bool PERM = true, AFTER_DRAIN = false;
    bf16* dst;
    MDEV void operator()(const f32x4 (&acc)[2][2][4][2], const pg8::Unit& u, int wr, int wc, int fr, int fq) const {
        OPAQUE2(fr, fq);
#pragma unroll
        for (int ai = 0; ai < 2; ++ai)
#pragma unroll
            for (int m = 0; m < 4; ++m) { const int row = 256 * u.pm + 128 * ai + 64 * wr + 16 * m + fr;
#pragma unroll
                for (int bj = 0; bj < 2; ++bj) { const int col = 128 * u.pn + 64 * bj + 16 * wc + 4 * fq; f32x4 o;
#pragma unroll
                    for (int r = 0; r < 4; ++r) o[r] = siluf(acc[ai][bj][m][0][r]) * acc[ai][bj][m][1][r];
#ifdef EMU
                    st_bf4(dst + (size_t)row * FF + col, o); } }
#else
                    const unsigned long long pk = (unsigned long long)pk2(o[0], o[1]) | ((unsigned long long)pk2(o[2], o[3]) << 32);
                    __hip_atomic_store((__attribute__((address_space(1))) unsigned long long*)(dst + (size_t)row * FF + col), pk, __ATOMIC_RELAXED, __HIP_MEMORY_SCOPE_AGENT); } }
#endif
    }
};
struct EpiMoe2_8 {
    static constexpr bool PERM = true, AFTER_DRAIN = false;
    bf16* dst;
    MDEV void operator()(const f32x4 (&acc)[2][2][4][2], const pg8::Unit& u, int wr, int wc, int fr, int fq) const {
        OPAQUE2(fr, fq);
#pragma unroll
        for (int ai = 0; ai < 2; ++ai)
#pragma unroll
            for (int m = 0; m < 4; ++m) { const int row = 256 * u.pm + 128 * ai + 64 * wr + 16 * m + fr;
#pragma unroll
                for (int bj = 0; bj < 2; ++bj) { const int col = 256 * u.pn + 128 * bj + 32 * wc + 8 * fq;
                    st_bf8(dst + (size_t)row * DM + col, acc[ai][bj][m][0], acc[ai][bj][m][1]); } }
    }
};
DEV unsigned uni(unsigned x);
template <bool G> struct MoeSel {
    static constexpr bool GATHER = G;
    const int* rb; const int* cnt; const int* list; size_t bstride;
    struct Ctx { int e, rbase, c; };
    MDEV Ctx ctx(const pg8::Unit& u) const { int e = 0;
#pragma unroll 1
        for (int q = 1; q < 32; ++q) if ((rb[q] >> 8) <= u.pm) e = q;
        e = (int)uni((unsigned)e); Ctx x; x.e = e; x.rbase = (int)uni((unsigned)((u.pm << 8) - rb[e])); x.c = G ? (int)uni((unsigned)cnt[e * 64]) : 0; return x; }
    MDEV size_t boff(const Ctx& x) const { return (size_t)x.e * bstride; }
    MDEV unsigned aoff(const Ctx& x, int r) const { int p = x.rbase + r; if (p > x.c - 1) p = x.c - 1; return (unsigned)list[(size_t)x.e * T + p] * (unsigned)(DM * 2); }
};
struct EpiInProj8 {
    static constexpr bool PERM = true, AFTER_DRAIN = false;
    const Args* a; int li;
    MDEV void operator()(const f32x4 (&acc)[2][2][4][2], const pg8::Unit& u, int wr, int wc, int fr, int fq) const {
        OPAQUE2(fr, fq);
        unsigned char* ws = wsp(*a);
        const int nb = 256 * u.pn + 64 * wc;
        if (nb >= 3392) return;
        if (nb < 512 || (nb >= 768 && nb < 896) || (nb >= 1024 && nb < 1152)) {
            const float* gain; float mul = 1.f; int kind;
            if (nb < 512) { gain = INP(*a, I_QG) + li * 64; mul = 0.125f * LOG2E; kind = 0; }
            else if (nb < 896) { gain = INP(*a, I_KG) + (li * 3 + 1) * 64; kind = 1; }
            else { gain = INP(*a, I_KG) + (li * 3 + 2) * 64; kind = 2; }
            const int g = (nb >> 6) & 1;
            f32x4 gv[2][2];
#pragma unroll
            for (int bj = 0; bj < 2; ++bj)
#pragma unroll
                for (int n = 0; n < 2; ++n) gv[bj][n] = *(const f32x4*)(gain + 32 * bj + 8 * fq + 4 * n);
#pragma unroll
            for (int ai = 0; ai < 2; ++ai)
#pragma unroll
                for (int m = 0; m < 4; ++m) { const int tok = 256 * u.pm + 128 * ai + 64 * wr + 16 * m + fr;
                    float ss = 0.f;
#pragma unroll
                    for (int bj = 0; bj < 2; ++bj)
#pragma unroll
                        for (int n = 0; n < 2; ++n) { const f32x4 v = acc[ai][bj][m][n]; ss += v[0] * v[0] + v[1] * v[1] + v[2] * v[2] + v[3] * v[3]; }
                    ss += shflx(ss, 16); ss += shflx(ss, 32);
                    const float rs = frsq(ss * (1.0f / 64.0f) + EPS) * mul;
                    bf16* dst; if (kind == 0) dst = (bf16*)(ws + WS_QN) + (size_t)tok * 512 + nb; else { const int b = tok / SEQ, sq = tok % SEQ; dst = (bf16*)(ws + (kind == 1 ? WS_KS : WS_KW)) + ((size_t)(b * 2 + g) * SEQ + sq) * 64; }
#pragma unroll
                    for (int bj = 0; bj < 2; ++bj) { f32x4 o0, o1;
#pragma unroll
                        for (int r = 0; r < 4; ++r) { o0[r] = acc[ai][bj][m][0][r] * rs * gv[bj][0][r]; o1[r] = acc[ai][bj][m][1][r] * rs * gv[bj][1][r]; }
                        st_bf8(dst + 32 * bj + 8 * fq, o0, o1); } }
        } else if (nb < 768) {
            bf16* base = (bf16*)(ws + (nb < 640 ? WS_KCG : WS_VCG)); const int g = (nb >> 6) & 1;
#pragma unroll
            for (int ai = 0; ai < 2; ++ai)
#pragma unroll
                for (int m = 0; m < 4; ++m) { const int tok = 256 * u.pm + 128 * ai + 64 * wr + 16 * m + fr, b = tok / SEQ, sq = tok % SEQ;
#pragma unroll
                    for (int bj = 0; bj < 2; ++bj) st_bf8(base + ((size_t)(b * 2 + g) * SEQ + sq) * 64 + 32 * bj + 8 * fq, acc[ai][bj][m][0], acc[ai][bj][m][1]); }
        } else if (nb < 1280) {
            bf16* base = (bf16*)(ws + (nb < 1024 ? WS_VST : WS_VWT)); const int g = (nb >> 6) & 1;
#pragma unroll
            for (int ai = 0; ai < 2; ++ai)
#pragma unroll
                for (int m = 0; m < 4; ++m) { const int tok = 256 * u.pm + 128 * ai + 64 * wr + 16 * m + fr, b = tok / SEQ, sq = tok % SEQ;
#pragma unroll
                    for (int bj = 0; bj < 2; ++bj) st_bf8(base + ((size_t)(b * 2 + g) * SEQ + sq) * 64 + 32 * bj + 8 * fq, acc[ai][bj][m][0], acc[ai][bj][m][1]); }
        } else if (nb < 3328) {
            const int sec = (nb - 1280) >> 9, cc = (nb - 1280) & 511, hh = cc >> 7, d0 = cc & 127;
            f32x4 lbv[2][2];
            if (sec == 1) {
#pragma unroll
                for (int bj = 0; bj < 2; ++bj)
#pragma unroll
                    for (int n = 0; n < 2; ++n) lbv[bj][n] = *(const f32x4*)((const float*)(ws + WS_LB) + li * 512 + cc + 32 * bj + 8 * fq + 4 * n); }
#pragma unroll
            for (int ai = 0; ai < 2; ++ai)
#pragma unroll
                for (int m = 0; m < 4; ++m) { const int tok = 256 * u.pm + 128 * ai + 64 * wr + 16 * m + fr, b = tok / SEQ, sq = tok % SEQ;
                    const size_t hrow = ((size_t)(b * 4 + hh) * SEQ + sq) * 128 + d0;
#pragma unroll
                    for (int bj = 0; bj < 2; ++bj) { const int d = 32 * bj + 8 * fq; f32x4 o0, o1;
                        if (sec == 0) {
#pragma unroll
                            for (int r = 0; r < 4; ++r) { o0[r] = siluf(acc[ai][bj][m][0][r]); o1[r] = siluf(acc[ai][bj][m][1][r]); }
                            st_bf8((bf16*)(ws + WS_HQ) + hrow + d, o0, o1); }
                        else if (sec == 1) {
#pragma unroll
                            for (int r = 0; r < 4; ++r) { o0[r] = lbv[bj][0][r] + (1.0f - lbv[bj][0][r]) * sigm(acc[ai][bj][m][0][r]); o1[r] = lbv[bj][1][r] + (1.0f - lbv[bj][1][r]) * sigm(acc[ai][bj][m][1][r]); }
                            float* pf = (float*)(ws + WS_HF) + hrow + d; *(f32x4*)pf = o0; *(f32x4*)(pf + 4) = o1; }
                        else if (sec == 2) st_bf8((bf16*)(ws + WS_HV) + hrow + d, acc[ai][bj][m][0], acc[ai][bj][m][1]);
                        else {
#pragma unroll
                            for (int r = 0; r < 4; ++r) { o0[r] = siluf(acc[ai][bj][m][0][r]); o1[r] = siluf(acc[ai][bj][m][1][r]); }
                            st_bf8((bf16*)(ws + WS_HGS) + (size_t)tok * 512 + cc + d, o0, o1); } } }
        } else {
            float* dst = (float*)(ws + WS_GATE);
            if (fq < 3) {
#pragma unroll
                for (int ai = 0; ai < 2; ++ai)
#pragma unroll
                    for (int m = 0; m < 4; ++m) { const int tok = 256 * u.pm + 128 * ai + 64 * wr + 16 * m + fr; f32x4 o0, o1;
#pragma unroll
                        for (int r = 0; r < 4; ++r) { o0[r] = sigm(acc[ai][0][m][0][r]); o1[r] = sigm(acc[ai][0][m][1][r]); }
                        float* pf = dst + (size_t)tok * 24 + 8 * fq; *(f32x4*)pf = o0; *(f32x4*)(pf + 4) = o1; } }
        }
    }
};

DEV void tr_tile(unsigned char* smem, const float* src0, const float* src1, int ld, int K, int mode, bf16* dst, int n0, int k0) {
    bf16* tl = (bf16*)smem;
    const int tid = TID;
    SYNC();
#pragma unroll
    for (int i = 0; i < 8; ++i) {
        const int e = tid + 512 * i, kk = e >> 6, nn = e & 63, n = n0 + nn; float v = 0.f;
        if (mode == 0) v = src0[(size_t)(k0 + kk) * ld + n];
        else if (mode == 1) { int sc = n < 1280 ? n : (n < 3328 ? n + 24 : (n < 3352 ? 1280 + (n - 3328) : -1)); if (sc >= 0) v = src0[(size_t)(k0 + kk) * ld + sc]; }
        else { const int g = n >> 6, w = n & 63; v = (w < 32) ? src0[(size_t)(k0 + kk) * ld + g * 32 + w] : src1[(size_t)(k0 + kk) * ld + g * 32 + w - 32]; }
        tl[nn * LDT + kk] = (bf16)f2bf(v);
    }
    SYNC();
    const int nn = tid >> 3, k8 = (tid & 7) * 8;
    *(bf16x8*)(dst + (size_t)(n0 + nn) * K + k0 + k8) = *(const bf16x8*)(tl + nn * LDT + k8);
}

DEV int tr_col(int mode, int n) {
    if (mode == 0) return n;
    const int pn = n >> 8, ct = n & 255;
    if (mode == 5) { const int bj = ct >> 7, wc = (ct >> 5) & 3, j = ct & 31, L = 256 * pn + 64 * wc + 32 * bj + j; return L < 1280 ? L : (L < 3328 ? L + 24 : (L < 3352 ? 1280 + (L - 3328) : -1)); }
    { const int bj = ct >> 7, wc = (ct >> 5) & 3, j = ct & 31, nn = (j >> 2) & 1, Lc = 128 * pn + 64 * bj + 16 * wc + 4 * (j >> 3) + (j & 3); return nn == 0 ? Lc : (mode == 7 ? FF : DM) + Lc; }
}
DEV void tr_tile(unsigned char* smem, const float* src, int ld, int K, int mode, bf16* dst, int n0, int k0) {
    bf16* tl = (bf16*)smem;
    const int tid = TID, nq = tid & 31, kq = tid >> 5;
    const int sc = tr_col(mode, n0 + 4 * nq);
    f32x4 v[4];
#pragma unroll
    for (int i = 0; i < 4; ++i) v[i] = sc >= 0 ? *(const f32x4*)(src + (size_t)(k0 + 4 * kq + i) * ld + sc) : f4zero();
    SYNC();
#pragma unroll
    for (int j = 0; j < 4; ++j) { u32x2 w; w[0] = pk2(v[0][j], v[1][j]); w[1] = pk2(v[2][j], v[3][j]); *(u32x2*)(tl + (4 * nq + j) * LDT + 4 * kq) = w; }
    SYNC();
#pragma unroll
    for (int t = 0; t < 2; ++t) { const int id = tid + 512 * t, row = id >> 3, ch = id & 7;
        *(bf16x8*)(dst + (size_t)(n0 + row) * K + k0 + 8 * ch) = *(const bf16x8*)(tl + row * LDT + 8 * ch); }
}
constexpr int KSUP = FF >= 256 ? 256 : FF, NSUP = KSUP / 64;
DEV void tr_super(unsigned char* smem, const float* src0, const float* src1, int ld, int K, int mode, bf16* dst, int n0, int k0) {
    const int tid = TID, nq = tid & 31, kq = tid >> 5;
    int sc = n0 + 4 * nq; const float* src = src0;
    if (mode == 7) { const int cc = tr_col(7, sc); src = cc >= FF ? src1 : src0; sc = cc >= FF ? cc - FF : cc; }
    f32x4 v[NSUP][4];
#pragma unroll
    for (int sb = 0; sb < NSUP; ++sb)
#pragma unroll
        for (int i = 0; i < 4; ++i) v[sb][i] = *(const f32x4*)(src + (size_t)(k0 + 64 * sb + 4 * kq + i) * ld + sc);
    SYNC();
    const int fw = nq & (KSUP / 16 - 1);
#pragma unroll
    for (int j = 0; j < 4; ++j)
#pragma unroll
        for (int sb = 0; sb < NSUP; ++sb) { const int c16 = 8 * sb + (kq >> 1); u32x2 w; w[0] = pk2(v[sb][0][j], v[sb][1][j]); w[1] = pk2(v[sb][2][j], v[sb][3][j]);
            *(u32x2*)(smem + (4 * nq + j) * (KSUP * 2) + ((c16 ^ fw) << 4) + (kq & 1) * 8) = w; }
    SYNC();
#pragma unroll
    for (int t = 0; t < 128 * (KSUP / 8) / NT; ++t) { const int id = tid + NT * t, row = id / (KSUP / 8), ch = id % (KSUP / 8), f = (row >> 2) & (KSUP / 16 - 1);
        *(bf16x8*)(dst + (size_t)(n0 + row) * K + k0 + 8 * (ch ^ f)) = *(const bf16x8*)(smem + row * (KSUP * 2) + ch * 16); }
}
struct TrJob { const float* s; int ld, K, N, mode; bf16* dst; };
DEV void p0_phase(const Args& a, unsigned char* smem) {
    unsigned char* ws = wsp(a); const int tid = TID;
    { int item = BID, base = 0;
      for (int j = 0; j < 8; ++j) { TrJob J; const int i = j & 1;
        if (j < 2) J = {INP(a, I_WIN) + (size_t)i * DM * NIN, NIN, DM, NIN8, 5, (bf16*)(ws + WS_WIN) + (size_t)i * NIN8 * DM};
        else if (j < 4) J = {INP(a, I_WOUT) + (size_t)i * 1024 * DM, DM, 1024, DM, 0, (bf16*)(ws + WS_WOUT) + (size_t)i * DM * 1024};
        else if (j < 6) J = {INP(a, I_PW1) + (size_t)i * DM * 2 * DM, 2 * DM, DM, 2 * DM, 6, (bf16*)(ws + WS_PW1) + (size_t)i * 2 * DM * DM};
        else J = {INP(a, I_PW2) + (size_t)i * DM * DM, DM, DM, DM, 0, (bf16*)(ws + WS_PW2) + (size_t)i * DM * DM};
        const int tn = J.N / 128, tk = J.K / 64, nt = tn * tk;
        while (item < base + nt) { const int it = item - base; tr_tile(smem, J.s, J.ld, J.K, J.mode, J.dst, (it % tn) * 128, (it / tn) * 64); item += NBLK; }
        base += nt; }
      SYNC(); }
    {
        float* red = (float*)smem;
        constexpr int NG = 6 * DM / 128; const int ntask = DEPTH * NG;
        for (int t = BID; t < ntask; t += NBLK) {
            const int l = t / NG, j0 = (t % NG) * 128, cq = tid & 31, kr = tid >> 5;
            const float* w = INP(a, I_ADAW) + (size_t)l * DM * 6 * DM + j0 + 4 * cq; const float* cc = INP(a, I_C);
            f32x4 a0 = f4zero(), a1 = f4zero();
#pragma unroll 8
            for (int i = 0; i < DM / 16; ++i) { const int k = kr + 16 * i; const f32x4 wv = *(const f32x4*)(w + (size_t)k * 6 * DM); const float s0 = siluf(cc[k]), s1 = siluf(cc[DM + k]);
#pragma unroll
                for (int r = 0; r < 4; ++r) { a0[r] += s0 * wv[r]; a1[r] += s1 * wv[r]; } }
            SYNC();
            *(f32x4*)(red + (kr * 2 + 0) * 128 + 4 * cq) = a0; *(f32x4*)(red + (kr * 2 + 1) * 128 + 4 * cq) = a1;
            SYNC();
            if (tid < 256) { const int b = tid >> 7, col = tid & 127; float sum = INP(a, I_ADAB)[(size_t)l * 6 * DM + j0 + col];
#pragma unroll
                for (int q = 0; q < 16; ++q) sum += red[(q * 2 + b) * 128 + col];
                ((float*)(ws + WS_MOD))[((size_t)l * 2 + b) * 6 * DM + j0 + col] = sum; }
        }
    }
    for (int t = BID; t < 32; t += NBLK) {
        float* red = (float*)smem; const int ikv = t >> 3, kp = t & 7, i = ikv >> 1, kv = ikv & 1, e = tid & 63, ks = tid >> 6;
        const float* W = INP(a, kv ? I_CWV : I_CWK) + (size_t)i * 2048 * 64 + e; const float* pe = INP(a, I_CPE) + (size_t)i * 2048;
        float sum = 0.f;
#pragma unroll 8
        for (int q = 0; q < 32; ++q) { const int k = kp * 256 + ks * 32 + q; sum += pe[k] * W[(size_t)k * 64]; }
        SYNC(); red[ks * 64 + e] = sum; SYNC();
        if (tid < 64) { float v = 0.f; for (int q = 0; q < 8; ++q) v += red[q * 64 + tid]; ((float*)(ws + WS_CB))[(ikv * 8 + kp) * 64 + tid] = v; }
    }
    for (int i = BID * NT + tid; i < DEPTH * 48 * DM; i += NBLK * NT) { const int k = i % DM, n = (i / DM) % 48, ll = i / (48 * DM);
        const float wv = n < 4 ? INP(a, I_WG)[((size_t)ll * DM + k) * 4 + n] : (n < 36 ? INP(a, I_WE)[((size_t)ll * DM + k) * 32 + n - 4] : 0.f);
        const unsigned hi = f2bf(wv); ((bf16*)(ws + WS_WTH))[i] = (bf16)hi; ((bf16*)(ws + WS_WTL))[i] = (bf16)f2bf(wv - bf2f(hi)); }
    if (BID == 0) {
        for (int i = tid; i < DEPTH * 32; i += NT) ((int*)(ws + WS_CNT))[i * 64] = 0;
        for (int i = tid; i < DEPTH * 256; i += NT) ((unsigned*)(ws + WS_FLG))[i * 16] = 0u;
        for (int n = tid; n < 512; n += NT) { const float l0 = INP(a, I_LBL)[n], l1 = INP(a, I_LBL)[512 + n]; const float m = fmaxf(l0, l1);
            const float e0 = fexp2((l0 - m) * LOG2E), e1 = fexp2((l1 - m) * LOG2E);
            ((float*)(ws + WS_LB))[n] = 0.f; ((float*)(ws + WS_LB))[512 + n] = e1 / (e0 + e1); }
        if (tid < 2) { const int i = tid; float mq = 0.f; for (int d = 0; d < 64; ++d) mq = fmaxf(mq, fabsf(INP(a, I_QG)[i * 64 + d]));
            for (int br = 0; br < 3; ++br) { float mk = 0.f; for (int d = 0; d < 64; ++d) mk = fmaxf(mk, fabsf(INP(a, I_KG)[(i * 3 + br) * 64 + d]));
                ((float*)(ws + WS_CS))[i * 4 + br] = 8.0f * mq * mk * LOG2E; } }
    }
    SYNC();
    { constexpr int S13 = (2 * FF / 128) * (DM / KSUP), S2 = (DM / 128) * (FF / KSUP), SPE = S13 + S2, NIT = DEPTH * 32 * SPE;
#ifdef EMU
      for (int it = BID; it < NIT; it += NBLK) {
#else
      int* ctr = (int*)(ws + WS_BAR) + P0_CTR_IDX; int* nxl = (int*)(smem + 72 * 1024);
      int my_next = 0; if (tid == 0) my_next = atomic_add_i(ctr, 1);
      for (;;) { if (tid == 0) nxl[0] = my_next; SYNC(); const int it = nxl[0]; if (it >= NIT) break; if (tid == 0) my_next = atomic_add_i(ctr, 1);
#endif
        const int le = it / SPE, r = it % SPE;
        if (r < S13) { const int tn = r % (2 * FF / 128), tk = r / (2 * FF / 128);
            tr_super(smem, INP(a, I_W1) + (size_t)le * DM * FF, INP(a, I_W3) + (size_t)le * DM * FF, FF, DM, 7, (bf16*)(ws + WS_W13) + (size_t)le * 2 * FF * DM, tn * 128, tk * KSUP); }
        else { const int r2 = r - S13, tn = r2 % (DM / 128), tk = r2 / (DM / 128);
            tr_super(smem, INP(a, I_W2) + (size_t)le * FF * DM, INP(a, I_W2), DM, FF, 0, (bf16*)(ws + WS_W2) + (size_t)le * DM * FF, tn * 128, tk * KSUP); } }
      SYNC(); }
}

constexpr int NJV = DM / 256;
DEV void moe_bases(const int* cnt, int* rb  ) {
    if (TID == 0) { int acc = 0; for (int e = 0; e < 32; ++e) { rb[e] = acc; acc += ((cnt[e * 64] + 255) >> 8) << 8; } rb[32] = acc; }
    SYNC();
}
DEV void norm_phase(const Args& a, unsigned char* smem, int l) {
    unsigned char* ws = wsp(a); const int tid = TID, w = tid >> 6, lane = tid & 63;
    int* rb = (int*)smem;
    if (l > 0) moe_bases((const int*)(ws + WS_CNT) + (l - 1) * 32 * 64, rb);
    const float* mod = (const float*)(ws + WS_MOD);
    const bf16* yk = (const bf16*)(ws + WS_YK);
    if (l < DEPTH) {
        const int bid = BID % 76 == BID ? BID : -1;
        for (int job = BID; job < 76; job += NBLK) {
            if (job < 72) { const int b = job / 36, n = job % 36; float sum = 0.f;
                for (int k = tid; k < DM; k += NT) { const float wv = n < 4 ? INP(a, I_WG)[((size_t)l * DM + k) * 4 + n] : INP(a, I_WE)[((size_t)l * DM + k) * 32 + n - 4]; sum += mod[((size_t)l * 2 + b) * 6 * DM + 3 * DM + k] * wv; }
#pragma unroll
                for (int q = 1; q < 64; q <<= 1) sum += shflx(sum, q);
                float* red = (float*)(smem + 1024);
                SYNC(); if (lane == 0) red[w] = sum; SYNC();
                if (tid == 0) { float t = 0.f; for (int q = 0; q < 8; ++q) t += red[q]; ((float*)(ws + WS_RBIAS))[((size_t)l * 2 + b) * 48 + n] = t; }
            } else { const float* nf = INP(a, I_NFFN) + (size_t)l * DM; const int part = job - 72;
                for (int i = part * (2 * DM / 4) + tid; i < (part + 1) * (2 * DM / 4); i += NT) { const int b = i / DM, k = i % DM; ((float*)(ws + WS_AVEC))[((size_t)l * 2 + b) * DM + k] = nf[k] * (1.0f + mod[((size_t)l * 2 + b) * 6 * DM + 4 * DM + k]); } }
        }
        (void)bid;
    }
    const int rstride = NBLK * 8;
    for (int rowa = BID * 8 + w; rowa < T; rowa += 2 * rstride) {
        int row[2]; bool ok[2];
        row[0] = rowa; ok[0] = true; row[1] = rowa + rstride; ok[1] = row[1] < T; if (!ok[1]) row[1] = rowa;
        f32x4 v[2][NJV]; int e0[2], p0[2], e1[2], p1[2]; float w0[2], w1[2];
        const float* xin = (l == 0) ? INP(a, I_X) : outp(a);
#pragma unroll
        for (int q = 0; q < 2; ++q) {
#pragma unroll
            for (int j = 0; j < NJV; ++j) v[q][j] = *(const f32x4*)(xin + (size_t)row[q] * DM + 4 * lane + 256 * j);
            if (l > 0) { const int* tie = (const int*)(ws + WS_TIE) + (size_t)row[q] * 2; const float* tiw = (const float*)(ws + WS_TIW) + (size_t)row[q] * 2;
                e0[q] = tie[0] >> 14; p0[q] = tie[0] & 16383; e1[q] = tie[1] >> 14; p1[q] = tie[1] & 16383; w0[q] = tiw[0]; w1[q] = tiw[1]; } }
        if (l > 0) {
            u32x2 q0[2][NJV], q1[2][NJV];
#pragma unroll
            for (int q = 0; q < 2; ++q) { const bf16* y0 = yk + (size_t)(rb[e0[q]] + p0[q]) * DM; const bf16* y1 = yk + (size_t)(rb[e1[q]] + p1[q]) * DM;
#pragma unroll
                for (int j = 0; j < NJV; ++j) { const int cidx = 4 * lane + 256 * j; q0[q][j] = *(const u32x2*)(y0 + cidx); q1[q][j] = *(const u32x2*)(y1 + cidx); } }
#pragma unroll
            for (int q = 0; q < 2; ++q) { const int b = row[q] / SEQ; const float* gf = mod + ((size_t)(l - 1) * 2 + b) * 6 * DM + 5 * DM;
#pragma unroll
                for (int j = 0; j < NJV; ++j) { const int cidx = 4 * lane + 256 * j; const f32x4 g = *(const f32x4*)(gf + cidx);
                    v[q][j][0] += g[0] * (w0[q] * bf2f(q0[q][j][0] & 0xffff) + w1[q] * bf2f(q1[q][j][0] & 0xffff));
                    v[q][j][1] += g[1] * (w0[q] * bf2f(q0[q][j][0] >> 16) + w1[q] * bf2f(q1[q][j][0] >> 16));
                    v[q][j][2] += g[2] * (w0[q] * bf2f(q0[q][j][1] & 0xffff) + w1[q] * bf2f(q1[q][j][1] & 0xffff));
                    v[q][j][3] += g[3] * (w0[q] * bf2f(q0[q][j][1] >> 16) + w1[q] * bf2f(q1[q][j][1] >> 16)); } }
        }
        if (l > 0)
#pragma unroll
        for (int q = 0; q < 2; ++q) { if (!ok[q]) continue;
#pragma unroll
            for (int j = 0; j < NJV; ++j) *(f32x4*)(outp(a) + (size_t)row[q] * DM + 4 * lane + 256 * j) = v[q][j]; }
        if (l == DEPTH) continue;
        float ss[2];
#pragma unroll
        for (int q = 0; q < 2; ++q) { ss[q] = 0.f;
#pragma unroll
            for (int j = 0; j < NJV; ++j) ss[q] += v[q][j][0] * v[q][j][0] + v[q][j][1] * v[q][j][1] + v[q][j][2] * v[q][j][2] + v[q][j][3] * v[q][j][3]; }
#pragma unroll
        for (int o = 1; o < 64; o <<= 1) { ss[0] += shflx(ss[0], o); ss[1] += shflx(ss[1], o); }
        const float* nm = INP(a, I_NMIX) + (size_t)l * DM;
#pragma unroll
        for (int q = 0; q < 2; ++q) { if (!ok[q]) continue;
            const int b = row[q] / SEQ; const float rs = frsq(ss[q] * (1.0f / DM) + EPS);
            const float* mm = mod + ((size_t)l * 2 + b) * 6 * DM; bf16* hb = (bf16*)(ws + WS_H) + (size_t)row[q] * DM;
#pragma unroll
            for (int j = 0; j < NJV; ++j) { const int cidx = 4 * lane + 256 * j; f32x4 g = *(const f32x4*)(nm + cidx), sh = *(const f32x4*)(mm + cidx), sc = *(const f32x4*)(mm + DM + cidx), o;
#pragma unroll
                for (int r = 0; r < 4; ++r) o[r] = v[q][j][r] * rs * g[r] * (1.0f + sc[r]) + sh[r];
                st_bf4(hb + cidx, o); } }
    }
}

DEV void route_phase(const Args& a, unsigned char* smem, int l) {
    unsigned char* ws = wsp(a); const int tid = TID, w = tid >> 6, lane = tid & 63, h = lane >> 4, c = lane & 15, pi = w >> 1, kh = w & 1;
    constexpr int NCHK = 4, CH = DM / NCHK, WLD = CH + 8, NKS = CH / 2 / 32;
    constexpr int WTOT = 48 * (CH / 8), WMAX = (WTOT + NT - 1) / NT;
    bf16* WHl = (bf16*)smem; bf16* WLl = WHl + 48 * WLD;
    float* lg = (float*)(WLl + 48 * WLD);
    float* ssb = lg + 4 * 2 * 16 * 48;
    float* rsb = ssb + 4 * 2 * 16;
    int* lcnt = (int*)(rsb + 64); int* lbase = lcnt + 32; int* tinfo = lbase + 32;
    float* avl = (float*)(tinfo + 256); float* cvl = avl + 2 * DM;
    const float* mod = (const float*)(ws + WS_MOD);
    SYNC();
    if (tid < 32) lcnt[tid] = 0;
    for (int i = tid; i < 2 * DM; i += NT) { const int b = i / DM, k = i % DM; avl[i] = ((const float*)(ws + WS_AVEC))[((size_t)l * 2 + b) * DM + k]; cvl[i] = mod[((size_t)l * 2 + b) * 6 * DM + 3 * DM + k]; }
    const bf16* WH = (const bf16*)(ws + WS_WTH) + (size_t)l * 48 * DM; const bf16* WL = (const bf16*)(ws + WS_WTL) + (size_t)l * 48 * DM;
    int* cnt = (int*)(ws + WS_CNT) + l * 32 * 64;
    for (int pass0 = BID; pass0 < T / 16; pass0 += 4 * NBLK) {
        const int pass = pass0 + pi * NBLK; const bool valid = pass < T / 16;
        const int tok = valid ? pass * 16 + c : 0, b = tok / SEQ;
        const float* xrow = outp(a) + (size_t)tok * DM;
        f32x4 xv[2][NKS][2]; bf16x8 wh[WMAX], wl[WMAX];
#pragma unroll
        for (int ks = 0; ks < NKS; ++ks) { const float* xq = xrow + kh * (CH / 2) + 8 * h + 32 * ks; xv[0][ks][0] = *(const f32x4*)xq; xv[0][ks][1] = *(const f32x4*)(xq + 4); }
#pragma unroll
        for (int t = 0; t < WMAX; ++t) { const int i = tid + NT * t; if (i < WTOT) { const int n = i / (CH / 8), k8 = (i % (CH / 8)) * 8; wh[t] = *(const bf16x8*)(WH + (size_t)n * DM + k8); wl[t] = *(const bf16x8*)(WL + (size_t)n * DM + k8); } }
        f32x4 acc[3] = {f4zero(), f4zero(), f4zero()}; float ss = 0.f;
        bf16x8 uhk[NCHK * NKS];
#pragma unroll
        for (int chn = 0; chn < NCHK; ++chn) {
            SYNC();
#pragma unroll
            for (int t = 0; t < WMAX; ++t) { const int i = tid + NT * t; if (i < WTOT) { const int n = i / (CH / 8), k8 = (i % (CH / 8)) * 8; *(bf16x8*)(WHl + n * WLD + k8) = wh[t]; *(bf16x8*)(WLl + n * WLD + k8) = wl[t]; } }
            SYNC();
            if (chn + 1 < NCHK) {
#pragma unroll
                for (int ks = 0; ks < NKS; ++ks) { const float* xq = xrow + (chn + 1) * CH + kh * (CH / 2) + 8 * h + 32 * ks; xv[(chn + 1) & 1][ks][0] = *(const f32x4*)xq; xv[(chn + 1) & 1][ks][1] = *(const f32x4*)(xq + 4); }
#pragma unroll
                for (int t = 0; t < WMAX; ++t) { const int i = tid + NT * t; if (i < WTOT) { const int n = i / (CH / 8), k8 = (i % (CH / 8)) * 8; wh[t] = *(const bf16x8*)(WH + (size_t)n * DM + (chn + 1) * CH + k8); wl[t] = *(const bf16x8*)(WL + (size_t)n * DM + (chn + 1) * CH + k8); } }
            }
            if (valid) {
                const bf16* whp = WHl + c * WLD + kh * (CH / 2) + 8 * h; const bf16* wlp = WLl + c * WLD + kh * (CH / 2) + 8 * h;
                const float* ap = avl + b * DM + chn * CH + kh * (CH / 2) + 8 * h;
#pragma unroll
                for (int ks = 0; ks < NKS; ++ks) {
                    const f32x4 a0 = *(const f32x4*)(ap + 32 * ks), a1 = *(const f32x4*)(ap + 32 * ks + 4);
                    const f32x4 x0 = xv[chn & 1][ks][0], x1 = xv[chn & 1][ks][1];
                    f32x4 u0, u1, r0, r1;
#pragma unroll
                    for (int r = 0; r < 4; ++r) { u0[r] = x0[r] * a0[r]; u1[r] = x1[r] * a1[r]; ss += x0[r] * x0[r] + x1[r] * x1[r]; }
                    const bf16x8 uh = pack8(u0, u1); uhk[chn * NKS + ks] = uh;
#pragma unroll
                    for (int r = 0; r < 4; ++r) { r0[r] = u0[r] - bf2f((unsigned short)uh[r]); r1[r] = u1[r] - bf2f((unsigned short)uh[4 + r]); }
                    const bf16x8 ul = pack8(r0, r1);
#pragma unroll
                    for (int nt = 0; nt < 3; ++nt) { const bf16x8 whf = *(const bf16x8*)(whp + nt * 16 * WLD + 32 * ks), wlf = *(const bf16x8*)(wlp + nt * 16 * WLD + 32 * ks);
                        acc[nt] = mfma16(whf, uh, acc[nt]); acc[nt] = mfma16(wlf, uh, acc[nt]); acc[nt] = mfma16(whf, ul, acc[nt]); }
                }
            }
        }
        if (valid) {
            ss += shflx(ss, 16); ss += shflx(ss, 32);
            float* lgp = lg + ((pi * 2 + kh) * 16 + c) * 48 + 4 * h;
#pragma unroll
            for (int nt = 0; nt < 3; ++nt) *(f32x4*)(lgp + 16 * nt) = acc[nt];
            if (h == 0) ssb[(pi * 2 + kh) * 16 + c] = ss;
        }
        SYNC();
        if (tid < 64) { const int p2 = tid >> 4, tk = tid & 15, pass2 = pass0 + p2 * NBLK;
            if (pass2 < T / 16) { const int tok2 = pass2 * 16 + tk, b2 = tok2 / SEQ;
                const float rs = frsq((ssb[(p2 * 2 + 0) * 16 + tk] + ssb[(p2 * 2 + 1) * 16 + tk]) * (1.0f / DM) + EPS); rsb[p2 * 16 + tk] = rs;
                const float* l0 = lg + ((p2 * 2 + 0) * 16 + tk) * 48; const float* l1 = lg + ((p2 * 2 + 1) * 16 + tk) * 48; const float* rbp = (const float*)(ws + WS_RBIAS) + ((size_t)l * 2 + b2) * 48;
                float acc[36];
#pragma unroll
                for (int n = 0; n < 36; ++n) acc[n] = rs * (l0[n] + l1[n]) + rbp[n];
                int gs = 0; float gm = acc[0];
#pragma unroll
                for (int g = 1; g < 4; ++g) if (acc[g] > gm) { gm = acc[g]; gs = g; }
                float den = 0.f;
#pragma unroll
                for (int g = 0; g < 4; ++g) den += fexp2((acc[g] - gm) * LOG2E);
                const float ggate = 1.0f / den;
                float el[8];
#pragma unroll
                for (int j = 0; j < 8; ++j) { el[j] = acc[4 + j];
#pragma unroll
                    for (int g = 1; g < 4; ++g) if (gs == g) el[j] = acc[4 + 8 * g + j]; }
                int ia = 0; float va = el[0];
#pragma unroll
                for (int j = 1; j < 8; ++j) if (el[j] > va) { va = el[j]; ia = j; }
                int ib = -1; float vb = -3e38f;
#pragma unroll
                for (int j = 0; j < 8; ++j) if (j != ia && el[j] > vb) { vb = el[j]; ib = j; }
                const float wa = 1.0f / (1.0f + fexp2((vb - va) * LOG2E)), wb = 1.0f - wa;
                const int e0 = gs * 8 + ia, e1 = gs * 8 + ib;
                const int p0 = atomic_add_i(lcnt + e0, 1), p1 = atomic_add_i(lcnt + e1, 1);
                int* ti = tinfo + tid * 4;
                ti[0] = (e0 << 14) | p0; ti[1] = (e1 << 14) | p1; ti[2] = __builtin_bit_cast(int, ggate * wa); ti[3] = __builtin_bit_cast(int, ggate * wb);
            } }
        SYNC();
        int gbase = 0;
        if (tid < 32) { const int n = lcnt[tid]; gbase = n > 0 ? atomic_add_i(cnt + tid * 64, n) : 0; }
        if (valid) { const float rs = rsb[pi * 16 + c]; bf16* hb = (bf16*)(ws + WS_H) + (size_t)tok * DM + kh * (CH / 2) + 8 * h;
            const float* cp = cvl + b * DM + kh * (CH / 2) + 8 * h;
#pragma unroll
            for (int chn = 0; chn < NCHK; ++chn)
#pragma unroll
                for (int ks = 0; ks < NKS; ++ks) {
                    const bf16x8 uh = uhk[chn * NKS + ks]; const f32x4 c0 = *(const f32x4*)(cp + chn * CH + 32 * ks), c1 = *(const f32x4*)(cp + chn * CH + 32 * ks + 4);
                    f32x4 o0, o1;
#pragma unroll
                    for (int r = 0; r < 4; ++r) { o0[r] = bf2f((unsigned short)uh[r]) * rs + c0[r]; o1[r] = bf2f((unsigned short)uh[4 + r]) * rs + c1[r]; }
                    st_bf8(hb + chn * CH + 32 * ks, o0, o1); } }
        if (tid < 32) { lbase[tid] = gbase; lcnt[tid] = 0; }
        SYNC();
        if (tid < 64) { const int p2 = tid >> 4, pass2 = pass0 + p2 * NBLK;
            if (pass2 < T / 16) { const int tok2 = pass2 * 16 + (tid & 15); const int* ti = tinfo + tid * 4;
                const int e0 = ti[0] >> 14, e1 = ti[1] >> 14, p0 = lbase[e0] + (ti[0] & 16383), p1 = lbase[e1] + (ti[1] & 16383);
                int* list = (int*)(ws + WS_LIST); list[(size_t)e0 * T + p0] = tok2; list[(size_t)e1 * T + p1] = tok2;
                int* tie = (int*)(ws + WS_TIE) + (size_t)tok2 * 2; int* tiw = (int*)(ws + WS_TIW) + (size_t)tok2 * 2;
                tie[0] = (e0 << 14) | p0; tie[1] = (e1 << 14) | p1; tiw[0] = ti[2]; tiw[1] = ti[3]; } }
        SYNC();
    }
}

DEV int vbid() { const int g = NBLK; return (g % 8 == 0) ? (BID % 8) * (g / 8) + BID / 8 : BID; }
#ifdef EMU
#define PG8_LDS(p) (p)
#else
#define PG8_LDS(p) ((PG8_LAS unsigned char*)(p))
#endif
DEV void inproj_phase(const Args& a, unsigned char* smem, int li) {
    pg8::Gemm g{(const bf16*)(wsp(a) + WS_H), (const bf16*)(wsp(a) + WS_WIN) + (size_t)li * NIN8 * DM, T, NIN8, DM}; pg8::StaticOrder S; S.init(T, NIN8, NBLK, BID);
    EpiInProj8 E{&a, li};
    SYNC(); pg8::gemm_phase<EpiInProj8, pg8::StaticOrder, true, true>(PG8_LDS(smem), g, S, E); SYNC();
}
DEV void resid_gemm_phase(const Args& a, unsigned char* smem, const bf16* A, int K, const bf16* Bt, int l) {
    pg8::Gemm g{A, Bt, T, DM, K}; pg8::StaticOrder S; S.init(T, DM, NBLK, BID);
    EpiResid8 E{outp(a), (const float*)(wsp(a) + WS_MOD) + (size_t)l * 2 * 6 * DM + 2 * DM, l == 0 ? INP(a, I_X) : (const float*)outp(a)};
    SYNC(); pg8::gemm_phase<EpiResid8, pg8::StaticOrder, true, true>(PG8_LDS(smem), g, S, E); SYNC();
}
DEV void pw1_phase(const Args& a, unsigned char* smem, int li) {
    pg8::Gemm g{(const bf16*)(wsp(a) + WS_H), (const bf16*)(wsp(a) + WS_PW1) + (size_t)li * 2 * DM * DM, T, 2 * DM, DM}; pg8::StaticOrder S; S.init(T, 2 * DM, NBLK, BID);
    EpiGlu8 E{(bf16*)(wsp(a) + WS_GLU)};
    SYNC(); pg8::gemm_phase<EpiGlu8, pg8::StaticOrder, true, true>(PG8_LDS(smem), g, S, E); SYNC();
}
DEV void cmp_phase_items(const Args& a, unsigned char* smem, int li, int it) {
    constexpr int TMC = (NCP + 255) / 256;
    const int kv = it / (4 * TMC), bg = (it / TMC) % 4, tm = it % TMC;
    const bf16* src = (const bf16*)(wsp(a) + (kv ? WS_VCG : WS_KCG)) + (size_t)bg * SEQ * 64;
    struct AF { const bf16* base; int m0; MDEV unsigned off(int r) const { int n = m0 + r; if (n > NCMP - 1) n = NCMP - 1; return (unsigned)n * 1024u; } } af{src, tm * 256};
    EpiCmp E{&a, kv, bg, tm * 256, li};
    BClamp64 bf{INP(a, kv ? I_CWV : I_CWK) + (size_t)li * 2048 * 64};
    gemm_tile2(smem, af, bf, 64, 2048, E);
}
DEV void moe_gemm_phase8(const Args& a, unsigned char* smem, int l, int mode) {
    unsigned char* ws = wsp(a); const int* cnt = (const int*)(ws + WS_CNT) + l * 32 * 64;
    int* rb = (int*)(smem + 140 * 1024);
    moe_bases(cnt, rb);
    const int mrows = rb[32];
    if (mode == 0) {
        pg8::Gemm g{(const bf16*)(ws + WS_H), (const bf16*)(ws + WS_W13) + (size_t)l * 32 * 2 * FF * DM, mrows, 2 * FF, DM}; pg8::StaticOrder S; S.init(mrows, 2 * FF, NBLK, BID);
        EpiMoe1_8 E{(bf16*)(ws + WS_ACT)}; MoeSel<true> X{rb, cnt, (const int*)(ws + WS_LIST), (size_t)2 * FF * DM * 2};
        SYNC(); pg8::gemm_phase<EpiMoe1_8, pg8::StaticOrder, true, true, MoeSel<true>>(PG8_LDS(smem), g, S, E, X); SYNC();
    } else {
        pg8::Gemm g{(const bf16*)(ws + WS_ACT), (const bf16*)(ws + WS_W2) + (size_t)l * 32 * DM * FF, mrows, DM, FF}; pg8::StaticOrder S; S.init(mrows, DM, NBLK, BID);
        EpiMoe2_8 E{(bf16*)(ws + WS_YK)}; MoeSel<false> X{rb, cnt, (const int*)(ws + WS_LIST), (size_t)DM * FF * 2};
        SYNC(); pg8::gemm_phase<EpiMoe2_8, pg8::StaticOrder, true, true, MoeSel<false>>(PG8_LDS(smem), g, S, E, X); SYNC();
    }
}
#ifndef EMU
constexpr int MOE_TMO_IDX = 128;
struct MoeOrder { int nN, t0, nu, j, nper, nA; bool rev;
    __device__ __forceinline__ void init(int ntile, int nN_, int nblk, int bid, bool rev_) { nN = nN_; nper = nblk / 8; rev = rev_; const int x = bid % 8; j = bid / 8;
        t0 = x * ntile / 8; nu = ((x + 1) * ntile / 8 - t0) * nN; if (bid >= 8 * nper) nu = 0;
        nA = nu - 2 * nper; nA = nA < 0 ? 0 : (nA > nper / 2 ? nper / 2 : nA); }
    __device__ __forceinline__ bool next(int i, pg8::Unit& u) const { int p;
        if (!rev) p = i * nper + j;
        else if (j < nA) { if (i > 0) return false; p = nu - nA + j; }
        else { p = i * (nper - nA) + (j - nA); if (p >= nu - nA) return false; }
        if (p >= nu) return false; u.pm = t0 + p / nN; u.pn = p % nN; return true; }
    __device__ __forceinline__ void a_ready(const pg8::Unit&) const {}
    __device__ __forceinline__ void done(const pg8::Unit&) const {}
};
struct MoeProd : MoeOrder { unsigned* flg;
    __device__ __forceinline__ void done(const pg8::Unit& u) const {
        asm volatile("s_waitcnt vmcnt(0)" ::: "memory"); __builtin_amdgcn_s_barrier(); asm volatile("" ::: "memory");
        if (TID == 0) (void)__hip_atomic_fetch_add((__attribute__((address_space(1))) unsigned*)(flg + u.pm * 16), 1u, __ATOMIC_RELAXED, __HIP_MEMORY_SCOPE_AGENT); } };
struct MoeCons : MoeOrder { unsigned* flg; unsigned* tmo;
    __device__ __forceinline__ void a_ready(const pg8::Unit& u) const {
        if ((TID >> 6) == 0) { unsigned sp = 0u; __attribute__((address_space(1))) unsigned* f = (__attribute__((address_space(1))) unsigned*)(flg + u.pm * 16);
            while ((unsigned)__builtin_amdgcn_readfirstlane((int)__hip_atomic_load(f, __ATOMIC_RELAXED, __HIP_MEMORY_SCOPE_AGENT)) < (unsigned)(2 * FF / 256)) {
                __builtin_amdgcn_s_sleep(1);
                if ((++sp & 255u) == 0u) { if (__hip_atomic_load((__attribute__((address_space(1))) unsigned*)tmo, __ATOMIC_RELAXED, __HIP_MEMORY_SCOPE_AGENT)) break;
                    if (sp > (1u << 22)) { (void)__hip_atomic_fetch_add((__attribute__((address_space(1))) unsigned*)tmo, 1u, __ATOMIC_RELAXED, __HIP_MEMORY_SCOPE_AGENT); break; } } }
            __builtin_amdgcn_fence(__ATOMIC_ACQUIRE, "agent"); }
        asm volatile("" ::: "memory"); __builtin_amdgcn_s_barrier(); asm volatile("" ::: "memory"); } };
DEV void moe_fused_phase(const Args& a, unsigned char* smem, int l) {
    unsigned char* ws = wsp(a); const int* cnt = (const int*)(ws + WS_CNT) + l * 32 * 64;
    int* rb = (int*)(smem + 140 * 1024);
    moe_bases(cnt, rb);
    const int mrows = rb[32]; unsigned* flg = (unsigned*)(ws + WS_FLG) + (size_t)l * 256 * 16;
    { pg8::Gemm g{(const bf16*)(ws + WS_H), (const bf16*)(ws + WS_W13) + (size_t)l * 32 * 2 * FF * DM, mrows, 2 * FF, DM}; MoeProd S; S.init(mrows >> 8, 2 * FF / 256, NBLK, BID, false); S.flg = flg;
      EpiMoe1_8 E{(bf16*)(ws + WS_ACT)}; MoeSel<true> X{rb, cnt, (const int*)(ws + WS_LIST), (size_t)2 * FF * DM * 2};
      SYNC(); pg8::gemm_phase<EpiMoe1_8, MoeProd, true, true, MoeSel<true>>(PG8_LDS(smem), g, S, E, X); }
    { pg8::Gemm g{(const bf16*)(ws + WS_ACT), (const bf16*)(ws + WS_W2) + (size_t)l * 32 * DM * FF, mrows, DM, FF}; MoeCons S; S.init(mrows >> 8, DM / 256, NBLK, BID, true); S.flg = flg; S.tmo = (unsigned*)(ws + WS_BAR) + MOE_TMO_IDX;
      EpiMoe2_8 E{(bf16*)(ws + WS_YK)}; MoeSel<false> X{rb, cnt, (const int*)(ws + WS_LIST), (size_t)DM * FF * 2};
      SYNC(); pg8::gemm_phase<EpiMoe2_8, MoeCons, true, true, MoeSel<false>>(PG8_LDS(smem), g, S, E, X); SYNC(); }
}
#endif
DEV void moe_gemm_phase(const Args& a, unsigned char* smem, int l, int mode) {
    unsigned char* ws = wsp(a); const int* cnt = (const int*)(ws + WS_CNT) + l * 32 * 64;
    int* rb = (int*)(smem + GEMM2_LDS);
    moe_bases(cnt, rb);
    const int ntile = rb[32] >> 8;
    constexpr int TN1 = 2 * FF / 128, TN2 = DM / 128;
    const int TN = mode == 0 ? TN1 : TN2;
    const int* list = (const int*)(ws + WS_LIST);
    for (int it = vbid(); it < ntile * TN; it += NBLK) {
        const int rt = it / TN, tn = it % TN; int e = 0;
#pragma unroll 1
        for (int q = 1; q < 32; ++q) if ((rb[q] >> 8) <= rt) e = q;
        const int rloc = (rt << 8) - rb[e], ce = cnt[e * 64], nvalid = (ce - rloc) < 256 ? (ce - rloc) : 256;
        if (mode == 0) {
            struct AF { const bf16* base; const int* lst; int nv; MDEV unsigned off(int r) const { const int rr = r < nv ? r : nv - 1; return (unsigned)lst[rr] * (unsigned)DM; } }
                af{(const bf16*)(ws + WS_H), list + (size_t)e * T + rloc, nvalid};
            EpiGated<1> E{(bf16*)(ws + WS_ACT), (size_t)FF, rt << 8, tn * 128, nvalid};
            BInter bf{INP(a, I_W1) + (size_t)(l * 32 + e) * DM * FF, INP(a, I_W3) + (size_t)(l * 32 + e) * DM * FF, tn * 128};
            gemm_tile2(smem, af, bf, FF, DM, E);
        } else {
            ARows af{(const bf16*)(ws + WS_ACT) + (size_t)(rt << 8) * FF, (size_t)FF};
            EpiStoreBf E{(bf16*)(ws + WS_YK), (size_t)DM, rt << 8, tn * 128, nvalid};
            BPlain bf{INP(a, I_W2) + (size_t)(l * 32 + e) * FF * DM + tn * 128};
            gemm_tile2(smem, af, bf, DM, FF, E);
        }
    }
}

constexpr int LDV = 80;
constexpr int AT_K = 0, AT_V = 2 * 64 * LDT * 2, AT_IMP = AT_V + 2 * 64 * LDV * 2, AT_SEL = AT_IMP + 8 * 8 * 128 * 4, AT_GSEL = AT_SEL + 8 * 8 * 4 * 4, AT_OUT = AT_GSEL + 8 * 2 * 4 * 4, AT_END = AT_OUT + 8 * 32 * 64 * 4;
#ifdef EMU
DEV float rexp2(float x) { return exp2f(x); }
DEV unsigned uni(unsigned x) { return x; }
#else
DEV float rexp2(float x) { return __builtin_amdgcn_exp2f(x); }
DEV unsigned uni(unsigned x) { return (unsigned)__builtin_amdgcn_readfirstlane((int)x); }
#endif
DEV int krow_lds(int kappa) { return 16 * (2 * (kappa >> 5) + ((kappa >> 2) & 1)) + 4 * ((kappa >> 3) & 3) + (kappa & 3); }
template <int MASK, bool FULL, int GM>
DEV void attn_block(const bf16* Kp, const bf16* Vp, const bf16x8 (&qf)[2][2], int j, const int (&s)[2], const bool (&selbit)[2], float C2, int h, int c,
                    f32x4 (&O)[2][4], f32x4 (&Ol)[2]) {
    f32x4 st[2][2][2];
#pragma unroll
    for (int sp = 0; sp < 2; ++sp)
#pragma unroll
        for (int u = 0; u < 2; ++u) {
#pragma unroll
            for (int G = 0; G < 2; ++G) { st[G][sp][u][0] = -C2; st[G][sp][u][1] = -C2; st[G][sp][u][2] = -C2; st[G][sp][u][3] = -C2; }
#pragma unroll
            for (int ks = 0; ks < 2; ++ks) { const bf16x8 kf = *(const bf16x8*)(Kp + (16 * (2 * sp + u) + c) * LDT + 32 * ks + 8 * h);
#pragma unroll
                for (int G = 0; G < 2; ++G) if (GM & (1 << G)) st[G][sp][u] = mfma16(kf, qf[G][ks], st[G][sp][u]); } }
#pragma unroll
    for (int G = 0; G < 2; ++G) if (GM & (1 << G))
#pragma unroll
        for (int sp = 0; sp < 2; ++sp)
#pragma unroll
            for (int u = 0; u < 2; ++u)
#pragma unroll
                for (int r = 0; r < 4; ++r) { bool ok = selbit[G];
                    if (!FULL) { const int key = 64 * j + 32 * sp + 8 * h + 4 * u + r;
                        if (MASK == 0) ok = 16 * key + 31 <= s[G]; else if (MASK == 1) ok = selbit[G] && key <= s[G]; else ok = key <= s[G] && key > s[G] - 512; }
                    st[G][sp][u][r] = ok ? rexp2(st[G][sp][u][r]) : 0.f; }
    bf16x8 pb[2][2], ones;
#pragma unroll
    for (int q = 0; q < 8; ++q) ones[q] = (short)0x3F80;
#pragma unroll
    for (int G = 0; G < 2; ++G) if (GM & (1 << G))
#pragma unroll
        for (int sp = 0; sp < 2; ++sp) { pb[G][sp] = pack8(st[G][sp][0], st[G][sp][1]); Ol[G] = mfma16(ones, pb[G][sp], Ol[G]); }
    const bf16* Vb = Vp + bperm(8 * h + (c >> 2)) * LDV + 4 * (c & 3);
#pragma unroll
    for (int et = 0; et < 4; ++et)
#pragma unroll
        for (int sp = 0; sp < 2; ++sp) { const bf16x8 vf = tr_read8(Vb + (32 * sp) * LDV + 16 * et, Vb + (32 * sp + 8) * LDV + 16 * et);
#pragma unroll
            for (int G = 0; G < 2; ++G) if (GM & (1 << G)) O[G][et] = mfma16(vf, pb[G][sp], O[G][et]); }
}

struct ImpState { float invq[2][4]; float carry[2]; float* imps; int tl, hd, l, s0, qblk; };
DEV void imp_block(const bf16* Kp, const bf16x8 (&qf)[2][2], int j, int s0, int w, float C2, int h, int c, ImpState& im) {
#pragma unroll
    for (int kt = 0; kt < 4; ++kt) {
        const int row = krow_lds(16 * kt + c);
        const bf16x8 k0 = *(const bf16x8*)(Kp + row * LDT + 8 * h), k1 = *(const bf16x8*)(Kp + row * LDT + 32 + 8 * h);
        const int n = 64 * j + 16 * kt + c;
#pragma unroll
        for (int G = 0; G < 2; ++G) {
            f32x4 acc; acc[0] = -C2; acc[1] = -C2; acc[2] = -C2; acc[3] = -C2;
            acc = mfma16(qf[G][0], k0, acc); acc = mfma16(qf[G][1], k1, acc);
            const bool ok = 16 * n + 31 <= s0 + 8 * w + 4 * G + h;
            float imp = 0.f;
#pragma unroll
            for (int r = 0; r < 4; ++r) imp += ok ? rexp2(acc[r]) * im.invq[G][r] : 0.f;
            const float v = ((c & 3) == 3) ? imp : 2.0f * imp;
            float sq = v + shflx(v, 1); sq += shflx(sq, 2);
            const float rr = dpp_ror1(imp);
            const float prev = (c == 0) ? im.carry[G] : rr;
            im.carry[G] = rr;
            const int m = n >> 2;
            if ((c & 3) == 0 && m < 128) im.imps[(G * 4 + h) * 128 + m] = sq + prev;
        }
    }
}

template <int MODE>
DEV void attn_branch(bf16* Kl, bf16* Vl, const bf16* kbase, const bf16* vbase, int jlo, int jhi,
                     const bf16x8 (&qf)[2][2], const int (&s)[2], const unsigned* selm, const unsigned* gselm, float C2, int w, int h, int c, int srow, int scol,
                     f32x4 (&O)[2][4], f32x4 (&Ol)[2], ImpState& im) {
    constexpr bool PV = MODE != 1; constexpr int MASK = MODE <= 1 ? 0 : MODE - 1;
    const int krow = krow_lds(srow) * LDT + scol, vrow = bperm(srow) * LDV + scol;
    bf16x8 rk[3], rv[3];
    { const bf16x8 k0 = *(const bf16x8*)(kbase + (size_t)jlo * 4096); *(bf16x8*)(Kl + krow) = k0;
      if (PV) { const bf16x8 v0 = *(const bf16x8*)(vbase + (size_t)jlo * 4096); *(bf16x8*)(Vl + vrow) = v0; } }
#pragma unroll
    for (int u = 0; u < 3; ++u) { int jj = jlo + 1 + u; if (jj > jhi) jj = jhi; rk[(1 + u) % 3] = *(const bf16x8*)(kbase + (size_t)jj * 4096); if (PV) rv[(1 + u) % 3] = *(const bf16x8*)(vbase + (size_t)jj * 4096); }
    SYNC();
    for (int jb = jlo; jb <= jhi; jb += 3) {
#pragma unroll
        for (int u = 0; u < 3; ++u) { const int j = jb + u;
            if (j <= jhi) {
                const int cur = (j - jlo) & 1;
                const bf16* Kc = Kl + cur * 64 * LDT; const bf16* Vc = Vl + cur * 64 * LDV;
                if (MODE == 1) imp_block(Kc, qf, j, im.s0, w, C2, h, c, im);
                else {
                    bool sb[2] = {true, true}; unsigned gm = 3u;
                    if (MODE == 2) { gm = 0u;
#pragma unroll
                        for (int G = 0; G < 2; ++G) { const unsigned wq = uni(gselm[G * 4 + (j >> 5)]), mq = selm[(G * 4 + im.tl) * 4 + (j >> 5)];
                            gm |= ((wq >> (j & 31)) & 1u) << G; sb[G] = (mq >> (j & 31)) & 1u; } }
                    bool full;
                    if (MODE == 0) full = 1024 * j + 1039 <= im.s0; else if (MODE == 2) full = j < im.qblk; else full = (j < im.qblk) && (64 * j > im.s0 + 63 - 512);
                    if (MODE == 2) {
                        if (full) { if (gm == 3u) attn_block<MASK, true, 3>(Kc, Vc, qf, j, s, sb, C2, h, c, O, Ol); else if (gm == 1u) attn_block<MASK, true, 1>(Kc, Vc, qf, j, s, sb, C2, h, c, O, Ol); else if (gm == 2u) attn_block<MASK, true, 2>(Kc, Vc, qf, j, s, sb, C2, h, c, O, Ol); }
                        else { if (gm == 3u) attn_block<MASK, false, 3>(Kc, Vc, qf, j, s, sb, C2, h, c, O, Ol); else if (gm == 1u) attn_block<MASK, false, 1>(Kc, Vc, qf, j, s, sb, C2, h, c, O, Ol); else if (gm == 2u) attn_block<MASK, false, 2>(Kc, Vc, qf, j, s, sb, C2, h, c, O, Ol); }
                    } else { if (full) attn_block<MASK, true, 3>(Kc, Vc, qf, j, s, sb, C2, h, c, O, Ol); else attn_block<MASK, false, 3>(Kc, Vc, qf, j, s, sb, C2, h, c, O, Ol); }
                }
                if (j + 1 <= jhi) {
                    *(bf16x8*)(Kl + (cur ^ 1) * 64 * LDT + krow) = rk[(u + 1) % 3]; if (PV) *(bf16x8*)(Vl + (cur ^ 1) * 64 * LDV + vrow) = rv[(u + 1) % 3];
                    int jj = j + 4; if (jj > jhi) jj = jhi;
                    rk[(u + 1) % 3] = *(const bf16x8*)(kbase + (size_t)jj * 4096); if (PV) rv[(u + 1) % 3] = *(const bf16x8*)(vbase + (size_t)jj * 4096);
                }
                SYNC();
            }
        }
    }
}

DEV void attn_task(const Args& a, unsigned char* smem, int li, int item) {
    unsigned char* ws = wsp(a); const int tid = TID, w = tid >> 6, l = tid & 63, h = l >> 4, c = l & 15, tl = c >> 2, hd = c & 3;
    const int bg = item & 3, b = bg >> 1, g = bg & 1, tq = (SEQ / 64 - 1) - (item >> 2), s0 = tq * 64, qblk = tq;
    int s[2], row[2];
#pragma unroll
    for (int G = 0; G < 2; ++G) { s[G] = s0 + 8 * w + 4 * G + tl; row[G] = b * SEQ + s[G]; }
    bf16* Kl = (bf16*)(smem + AT_K); bf16* Vl = (bf16*)(smem + AT_V); float* imps = (float*)(smem + AT_IMP) + w * 1024; unsigned* selm = (unsigned*)(smem + AT_SEL) + w * 32;
    bf16x8 qf[2][2]; float gatec[2], gates[2], gatew[2];
#pragma unroll
    for (int G = 0; G < 2; ++G) { const bf16* qp = (const bf16*)(ws + WS_QN) + (size_t)row[G] * 512 + (g * 4 + hd) * 64 + 8 * h; qf[G][0] = *(const bf16x8*)qp; qf[G][1] = *(const bf16x8*)(qp + 32);
        const float* gp = (const float*)(ws + WS_GATE) + (size_t)row[G] * 24 + (g * 4 + hd) * 3; gatec[G] = gp[0]; gates[G] = gp[1]; gatew[G] = gp[2]; }
    const float* cs = (const float*)(ws + WS_CS) + li * 4;
    const int srow = tid >> 3, scol = (tid & 7) * 8;
    for (int i = l; i < 1024; i += 64) imps[i] = 0.f;
    SYNC();
    unsigned* gselm = (unsigned*)(smem + AT_GSEL) + w * 8; float* outl = (float*)(smem + AT_OUT) + w * 2048 + l;
    ImpState im{{{0.f, 0.f, 0.f, 0.f}, {0.f, 0.f, 0.f, 0.f}}, {0.f, 0.f}, imps, tl, hd, l, s0, qblk};
    {
        const int ncv = s0 / 16 + 3, ncb0 = (ncv + 63) >> 6, ncb = ncb0 > NCP / 64 ? NCP / 64 : ncb0;
        const bf16* kcb = (const bf16*)(ws + WS_KC) + (size_t)bg * NCP * 64 + tid * 8;
        const bf16* vcb = (const bf16*)(ws + WS_VCT) + (size_t)bg * NCP * 64 + tid * 8;
        f32x4 O[2][4], Ol[2] = {f4zero(), f4zero()};
#pragma unroll
        for (int G = 0; G < 2; ++G)
#pragma unroll
            for (int et = 0; et < 4; ++et) O[G][et] = f4zero();
        attn_branch<0>(Kl, Vl, kcb, vcb, 0, ncb - 1, qf, s, selm, gselm, cs[0], w, h, c, srow, scol, O, Ol, im);
#pragma unroll
        for (int G = 0; G < 2; ++G) { const float lsum = Ol[G][0]; const float invl = lsum > 0.f ? 1.0f / lsum : 0.f;
#pragma unroll
            for (int r = 0; r < 4; ++r) im.invq[G][r] = shfl(invl, 4 * h + r);
#pragma unroll
            for (int et = 0; et < 4; ++et)
#pragma unroll
                for (int r = 0; r < 4; ++r) outl[((G * 4 + et) * 4 + r) * 64] = gatec[G] * invl * O[G][et][r]; }
        f32x4 ld[2] = {f4zero(), f4zero()};
        attn_branch<1>(Kl, Vl, kcb, vcb, 0, ncb - 1, qf, s, selm, gselm, cs[0], w, h, c, srow, scol, O, ld, im);
    }
    WSYNC();
#pragma unroll 1
    for (int G = 0; G < 2; ++G) {
        const int tk = l >> 4, i = l & 15; float vals[8];
#pragma unroll
        for (int mm = 0; mm < 8; ++mm) { const int jj = i + 16 * mm; vals[mm] = jj > qblk ? NEGV : ((jj == 0 || jj == qblk || jj == qblk - 1) ? FORCEV : imps[(G * 4 + tk) * 128 + jj]); }
        unsigned mk[4] = {0u, 0u, 0u, 0u};
#pragma unroll 1
        for (int rnd = 0; rnd < 16; ++rnd) {
            float best = vals[0]; int bj = i;
#pragma unroll
            for (int mm = 1; mm < 8; ++mm) if (vals[mm] > best) { best = vals[mm]; bj = i + 16 * mm; }
#pragma unroll
            for (int o = 1; o < 16; o <<= 1) { const float ov = shflx(best, o); const int oj = shflxi(bj, o); if (ov > best || (ov == best && oj < bj)) { best = ov; bj = oj; } }
            if (best > NEGV * 0.5f) {
#pragma unroll
                for (int q = 0; q < 4; ++q) if ((bj >> 5) == q) mk[q] |= 1u << (bj & 31); }
            if ((bj & 15) == i) {
#pragma unroll
                for (int mm = 0; mm < 8; ++mm) if ((bj >> 4) == mm) vals[mm] = -3e38f; }
        }
        if (i == 0) {
#pragma unroll
            for (int q = 0; q < 4; ++q) selm[(G * 4 + tk) * 4 + q] = mk[q]; }
    }
    WSYNC();
    if (l < 8) { const int G = l >> 2, q = l & 3; gselm[l] = selm[(G * 4 + 0) * 4 + q] | selm[(G * 4 + 1) * 4 + q] | selm[(G * 4 + 2) * 4 + q] | selm[(G * 4 + 3) * 4 + q]; }
    WSYNC();
#pragma unroll
    for (int br = 0; br < 2; ++br) {
        const bf16* kb = (const bf16*)(ws + (br == 0 ? WS_KS : WS_KW)) + (size_t)bg * SEQ * 64 + tid * 8; const bf16* vb = (const bf16*)(ws + (br == 0 ? WS_VST : WS_VWT)) + (size_t)bg * SEQ * 64 + tid * 8;
        f32x4 O[2][4], Ol[2] = {f4zero(), f4zero()};
#pragma unroll
        for (int G = 0; G < 2; ++G)
#pragma unroll
            for (int et = 0; et < 4; ++et) O[G][et] = f4zero();
        if (br == 0) attn_branch<2>(Kl, Vl, kb, vb, 0, qblk, qf, s, selm, gselm, cs[1], w, h, c, srow, scol, O, Ol, im);
        else attn_branch<3>(Kl, Vl, kb, vb, s0 >= 511 ? (s0 - 511) >> 6 : 0, qblk, qf, s, selm, gselm, cs[2], w, h, c, srow, scol, O, Ol, im);
#pragma unroll
        for (int G = 0; G < 2; ++G) { const float lsum = Ol[G][0]; const float sc = (br == 0 ? gates[G] : gatew[G]) * (lsum > 0.f ? 1.0f / lsum : 0.f);
#pragma unroll
            for (int et = 0; et < 4; ++et)
#pragma unroll
                for (int r = 0; r < 4; ++r) outl[((G * 4 + et) * 4 + r) * 64] += sc * O[G][et][r]; }
    }
#pragma unroll
    for (int G = 0; G < 2; ++G) { bf16* dst = (bf16*)(ws + WS_CAT) + (size_t)row[G] * 1024 + (g * 4 + hd) * 64 + 4 * h;
#pragma unroll
        for (int et = 0; et < 4; ++et) { f32x4 o;
#pragma unroll
            for (int r = 0; r < 4; ++r) o[r] = outl[((G * 4 + et) * 4 + r) * 64];
            st_bf4(dst + 16 * et, o); } }
}

constexpr int LDH = 136;
DEV void hg_cumsum(const float* fsrc  , float* segs  , int d, int seg, float (&f)[16], float (&bc)[16], float& bend, float& bmid) {
    float run = 0.f;
#pragma unroll
    for (int i = 0; i < 16; ++i) { f[i] = fsrc[(size_t)(16 * seg + i) * 128 + d]; run += log2f(f[i]); bc[i] = run; }
    SYNC();
    segs[seg * 128 + d] = run;
    SYNC();
    const float s0 = segs[d], s1 = segs[128 + d], s2 = segs[256 + d], s3 = segs[384 + d];
    const float off = seg == 0 ? 0.f : (seg == 1 ? s0 : (seg == 2 ? s0 + s1 : s0 + s1 + s2));
#pragma unroll
    for (int i = 0; i < 16; ++i) bc[i] += off;
    bend = s0 + s1 + s2 + s3; bmid = s0 + s1;
}
DEV void hg_write16(bf16* dstrow  , const float (&v)[16]) {
    u32x4 w0, w1;
#pragma unroll
    for (int q = 0; q < 4; ++q) { w0[q] = pk2(v[2 * q], v[2 * q + 1]); w1[q] = pk2(v[8 + 2 * q], v[8 + 2 * q + 1]); }
    *(u32x4*)dstrow = w0; *(u32x4*)(dstrow + 8) = w1;
}
DEV void hg_h1_task(const Args& a, unsigned char* smem, int task) {
    unsigned char* ws = wsp(a); const int tid = TID, w = tid >> 6, l = tid & 63, h = l >> 4, c = l & 15, d = tid & 127, seg = tid >> 7;
    const int bh = task / NCH, ch = task % NCH;
    bf16* kT = (bf16*)smem; bf16* vT = kT + 128 * LDT; float* segs = (float*)(vT + 128 * LDT);
    const size_t tokb = (size_t)bh * SEQ + ch * 64;
    float f[16], bc[16], bend, bmid;
    const bf16* vs = (const bf16*)(ws + WS_HV) + tokb * 128;
    bf16 vraw[16];
#pragma unroll
    for (int i = 0; i < 16; ++i) vraw[i] = vs[(size_t)(16 * seg + i) * 128 + d];
    hg_cumsum((const float*)(ws + WS_HF) + tokb * 128, segs, d, seg, f, bc, bend, bmid);
    float kv[16];
#pragma unroll
    for (int i = 0; i < 16; ++i) kv[i] = (1.0f - f[i]) * fexp2(bend - bc[i]);
    hg_write16(kT + d * LDT + 16 * seg, kv);
#pragma unroll
    for (int i = 0; i < 16; ++i) kv[i] = bf2f(vraw[i]);
    hg_write16(vT + d * LDT + 16 * seg, kv);
    if (seg == 0) ((float*)(ws + WS_GD))[((size_t)bh * NCH + ch) * 128 + d] = fexp2(bend);
    SYNC();
    f32x4 acc[8];
#pragma unroll
    for (int et = 0; et < 8; ++et) acc[et] = f4zero();
#pragma unroll
    for (int ks = 0; ks < 2; ++ks) { const bf16x8 fa = *(const bf16x8*)(kT + (16 * w + c) * LDT + 32 * ks + 8 * h);
#pragma unroll
        for (int et = 0; et < 8; ++et) acc[et] = mfma16(fa, *(const bf16x8*)(vT + (16 * et + c) * LDT + 32 * ks + 8 * h), acc[et]); }
    float* ut = (float*)(ws + WS_UT) + ((size_t)bh * NCH + ch) * 16384;
#pragma unroll
    for (int et = 0; et < 8; ++et) *(f32x4*)(ut + (size_t)(16 * et + c) * 128 + 16 * w + 4 * h) = acc[et];
    SYNC();
}
DEV void hg_scan_task(const Args& a, int sc) {
    unsigned char* ws = wsp(a); const int bh = sc >> 3, q = (sc & 7) * 512 + TID, e = q >> 5, d0 = (q & 31) * 4;
    const float* ut = (const float*)(ws + WS_UT) + (size_t)bh * NCH * 16384 + (size_t)e * 128 + d0;
    const float* gd = (const float*)(ws + WS_GD) + (size_t)bh * NCH * 128 + d0;
    bf16* st = (bf16*)(ws + WS_ST) + (size_t)bh * NCH * 16384 + (size_t)e * 128 + d0;
    f32x4 S = f4zero();
#pragma unroll 4
    for (int ch = 0; ch < NCH; ++ch) { st_bf4(st + (size_t)ch * 16384, S);
        const f32x4 g = *(const f32x4*)(gd + (size_t)ch * 128), u = *(const f32x4*)(ut + (size_t)ch * 16384);
#pragma unroll
        for (int r = 0; r < 4; ++r) S[r] = g[r] * S[r] + u[r]; }
}
DEV void hg_h3_task(const Args& a, unsigned char* smem, int li, int task) {
    unsigned char* ws = wsp(a); const int tid = TID, w = tid >> 6, l = tid & 63, h = l >> 4, c = l & 15, d = tid & 127, seg = tid >> 7;
    const int bh = task / NCH, ch = task % NCH, b = bh >> 2, hh = bh & 3;
    bf16* At = (bf16*)smem; bf16* Bt = At + 64 * LDH; bf16* Qt = Bt + 64 * LDH; bf16* vT = Qt + 64 * LDH; float* segs = (float*)(vT + 128 * LDT); float* part = segs + 512;
    const size_t tokb = (size_t)bh * SEQ + ch * 64;
    float f[16], bc[16], bend, bmid;
    const bf16* qs = (const bf16*)(ws + WS_HQ) + tokb * 128; const bf16* vs = (const bf16*)(ws + WS_HV) + tokb * 128;
    const int tt = w & 3, eh = w >> 2;
    bf16 qraw[16], vraw[16];
#pragma unroll
    for (int i = 0; i < 16; ++i) { const int t = 16 * seg + i; qraw[i] = qs[(size_t)t * 128 + d]; vraw[i] = vs[(size_t)t * 128 + d]; }
    const bf16* stp = (const bf16*)(ws + WS_ST) + ((size_t)bh * NCH + ch) * 16384;
    bf16x8 stf[4][4];
#pragma unroll
    for (int ks = 0; ks < 4; ++ks)
#pragma unroll
        for (int et = 0; et < 4; ++et) stf[ks][et] = *(const bf16x8*)(stp + (size_t)(64 * eh + 16 * et + c) * 128 + 32 * ks + 8 * h);
    const int tok = b * SEQ + ch * 64 + 16 * tt + c;
    const bf16* hg = (const bf16*)(ws + WS_HGS) + (size_t)tok * 512 + hh * 128;
    u32x2 hgv[4];
#pragma unroll
    for (int et = 0; et < 4; ++et) hgv[et] = *(const u32x2*)(hg + 64 * eh + 16 * et + 4 * h);
    hg_cumsum((const float*)(ws + WS_HF) + tokb * 128, segs, d, seg, f, bc, bend, bmid);
    float vv[16];
#pragma unroll
    for (int i = 0; i < 16; ++i) { const int t = 16 * seg + i; const float q = bf2f(qraw[i]);
        At[t * LDH + d] = (bf16)f2bf(q * fexp2(bc[i] - bmid)); Bt[t * LDH + d] = (bf16)f2bf((1.0f - f[i]) * fexp2(bmid - bc[i])); Qt[t * LDH + d] = (bf16)f2bf(q * fexp2(bc[i]));
        vv[i] = bf2f(vraw[i]); }
    hg_write16(vT + d * LDT + 16 * seg, vv);
    SYNC();
    f32x4 O[4];
#pragma unroll
    for (int et = 0; et < 4; ++et) O[et] = f4zero();
#pragma unroll
    for (int sp = 0; sp < 2; ++sp) {
        if (32 * sp > 16 * tt + 15) continue;
        f32x4 st[2];
#pragma unroll
        for (int u = 0; u < 2; ++u) { st[u] = f4zero(); const int krow = 32 * sp + 8 * (c >> 2) + 4 * u + (c & 3);
#pragma unroll
            for (int ks = 0; ks < 4; ++ks) st[u] = mfma16(*(const bf16x8*)(Bt + krow * LDH + 32 * ks + 8 * h), *(const bf16x8*)(At + (16 * tt + c) * LDH + 32 * ks + 8 * h), st[u]);
#pragma unroll
            for (int r = 0; r < 4; ++r) { const int sk = 32 * sp + 8 * h + 4 * u + r; if (sk > 16 * tt + c) st[u][r] = 0.f; } }
        const bf16x8 pb = pack8(st[0], st[1]);
#pragma unroll
        for (int et = 0; et < 4; ++et) O[et] = mfma16(*(const bf16x8*)(vT + (64 * eh + 16 * et + c) * LDT + 32 * sp + 8 * h), pb, O[et]);
    }
#pragma unroll
    for (int ks = 0; ks < 4; ++ks) { const bf16x8 fq = *(const bf16x8*)(Qt + (16 * tt + c) * LDH + 32 * ks + 8 * h);
#pragma unroll
        for (int et = 0; et < 4; ++et) O[et] = mfma16(stf[ks][et], fq, O[et]); }
    float ss = 0.f;
#pragma unroll
    for (int et = 0; et < 4; ++et)
#pragma unroll
        for (int r = 0; r < 4; ++r) ss += O[et][r] * O[et][r];
    ss += shflx(ss, 16); ss += shflx(ss, 32);
    if (h == 0) part[eh * 64 + 16 * tt + c] = ss;
    SYNC();
    const float rs = frsq((part[16 * tt + c] + part[64 + 16 * tt + c]) * (1.0f / 128.0f) + EPS);
    const float* og = INP(a, I_OG) + li * 128;
    bf16* dst = (bf16*)(ws + WS_CAT) + (size_t)tok * 1024 + 512 + hh * 128;
#pragma unroll
    for (int et = 0; et < 4; ++et) { const int e = 64 * eh + 16 * et + 4 * h; f32x4 o; const f32x4 ogv = *(const f32x4*)(og + e);
        o[0] = O[et][0] * rs * ogv[0] * bf2f(hgv[et][0] & 0xffff); o[1] = O[et][1] * rs * ogv[1] * bf2f(hgv[et][0] >> 16);
        o[2] = O[et][2] * rs * ogv[2] * bf2f(hgv[et][1] & 0xffff); o[3] = O[et][3] * rs * ogv[3] * bf2f(hgv[et][1] >> 16);
        st_bf4(dst + e, o); }
    SYNC();
}

constexpr int CTS = 16;
DEV void conv_task(const Args& a, unsigned char* smem, int li, int task) {
    unsigned char* ws = wsp(a); const int tid = TID, w = tid >> 6, lane = tid & 63;
    const bool act = tid < DM / 2; const int c0 = act ? 2 * tid : 0;
    const int tb = task * 64, b = tb / SEQ, sb = tb % SEQ;
    float* red = (float*)smem;
    const float b0 = INP(a, I_DWB)[li * DM + c0], b1 = INP(a, I_DWB)[li * DM + c0 + 1];
    const float g0 = INP(a, I_LNG)[li * DM + c0], g1 = INP(a, I_LNG)[li * DM + c0 + 1], e0 = INP(a, I_LNB)[li * DM + c0], e1 = INP(a, I_LNB)[li * DM + c0 + 1];
    const bf16* glu = (const bf16*)(ws + WS_GLU) + (size_t)b * SEQ * DM + c0;
    float* lw = (float*)(smem + 4096);
    SYNC();
    for (int i = tid * 4; i < 31 * DM; i += NT * 4) *(f32x4*)(lw + i) = *(const f32x4*)(INP(a, I_DW) + (size_t)li * 31 * DM + i);
    SYNC();
    f32x2v uf[30 + CTS]; unsigned nx[CTS];
    { const bf16* gp = glu + (size_t)(sb - 30) * DM;
#pragma unroll
      for (int r = 0; r < 30; ++r) { const int si = sb + r - 30; const unsigned q = si >= 0 ? *(const unsigned*)gp : 0u; gp += DM; OPAQUE(gp); uf[r][0] = bf2f(q & 0xffff); uf[r][1] = bf2f(q >> 16); }
#pragma unroll
      for (int r = 0; r < CTS; ++r) { nx[r] = *(const unsigned*)gp; gp += DM; OPAQUE(gp); } }
#pragma unroll 1
    for (int step = 0; step < 64 / CTS; ++step) {
        const int s0 = sb + CTS * step, t0 = tb + CTS * step;
#pragma unroll
        for (int r = 0; r < CTS; ++r) { uf[30 + r][0] = bf2f(nx[r] & 0xffff); uf[30 + r][1] = bf2f(nx[r] >> 16); }
        float acc[CTS][2];
        { f32x2v ac2[CTS];
#pragma unroll
          for (int t = 0; t < CTS; ++t) { ac2[t][0] = b0; ac2[t][1] = b1; }
#pragma unroll
          for (int j = 0; j < 31; ++j) { const f32x2v w2 = *(const f32x2v*)(lw + j * DM + c0);
#ifndef EMU
              if ((j & 3) == 3) asm volatile("" ::: "memory");
#endif
#pragma unroll
              for (int t = 0; t < CTS; ++t) ac2[t] += w2 * uf[t + j]; }
#pragma unroll
          for (int t = 0; t < CTS; ++t) { acc[t][0] = ac2[t][0]; acc[t][1] = ac2[t][1]; } }
#pragma unroll
        for (int r = 0; r < 30; ++r) uf[r] = uf[r + CTS];
        if (step < 64 / CTS - 1) { const bf16* gp = glu + (size_t)(s0 + CTS) * DM;
#pragma unroll
            for (int r = 0; r < CTS; ++r) { nx[r] = *(const unsigned*)gp; gp += DM; OPAQUE(gp); } }
        { float* rb2 = red + (step & 1) * (8 * CTS * 2);
#pragma unroll
          for (int t = 0; t < CTS; ++t) { float s1 = act ? acc[t][0] + acc[t][1] : 0.f, s2 = act ? acc[t][0] * acc[t][0] + acc[t][1] * acc[t][1] : 0.f;
#pragma unroll
              for (int o = 1; o < 64; o <<= 1) { s1 += shflx(s1, o); s2 += shflx(s2, o); }
              if (lane == 0) { rb2[(w * CTS + t) * 2] = s1; rb2[(w * CTS + t) * 2 + 1] = s2; } }
          SYNC();
          if (act) {
              bf16* dst = (bf16*)(ws + WS_CAT) + (size_t)t0 * DM + c0;
#pragma unroll
              for (int t = 0; t < CTS; ++t) { float s1 = 0.f, s2 = 0.f;
#pragma unroll
                  for (int q = 0; q < 8; ++q) { s1 += rb2[(q * CTS + t) * 2]; s2 += rb2[(q * CTS + t) * 2 + 1]; }
                  const float mean = s1 * (1.0f / DM), var = fmaxf(s2 * (1.0f / DM) - mean * mean, 0.f), rstd = frsq(var + EPS);
                  const float y0 = (acc[t][0] - mean) * rstd * g0 + e0, y1 = (acc[t][1] - mean) * rstd * g1 + e1;
                  *(unsigned*)(dst + (size_t)t * DM) = pk2(siluf(y0), siluf(y1)); }
          } }
    }
}

constexpr int N_PHASES = 1 + 16 * (DEPTH / 2) + 1;
DEV void phase_decode(int ph, int& l, int& sub) {
    const int q = ph - 1, pair = q >> 4, r = q & 15;
    if (r < 9) { l = 2 * pair; sub = r; } else { l = 2 * pair + 1; const int rr = r - 9; sub = rr < 3 ? rr : rr + 2; }
}
constexpr int LDS_BYTES = 150 * 1024;

DEV void run_phase(const Args& a, unsigned char* smem, int ph) {
#ifndef ONLY
#define ONLY -1
#endif
#define EN(k) (ONLY < 0 || ONLY == (k))
    if (ph == 0) { if (EN(100)) p0_phase(a, smem); return; }
    if (ph == N_PHASES - 1) { if (EN(0)) norm_phase(a, smem, DEPTH); return; }
    int l, sub; phase_decode(ph, l, sub); const int li = l >> 1; const bool even = (l & 1) == 0;
    unsigned char* ws = wsp(a);
    switch (sub) {
    case 0: if (EN(0)) norm_phase(a, smem, l); break;
    case 1: if (even) { if (EN(1)) inproj_phase(a, smem, li); } else { if (EN(11)) pw1_phase(a, smem, li); } break;
    case 2:
        if (even) { constexpr int NCI = 8 * ((NCP + 255) / 256); constexpr int NH1 = 8 * NCH;
            if (NBLK > 2 * NCI) { const int bid = BID;
                if (bid < NCI) { if (EN(2)) cmp_phase_items(a, smem, li, bid); }
                else { for (int it = bid - NCI; it < NH1; it += NBLK - NCI) if (EN(12)) hg_h1_task(a, smem, it); } }
            else for (int it = BID; it < NCI + NH1; it += NBLK) { if (it < NCI) { if (EN(2)) cmp_phase_items(a, smem, li, it); } else { if (EN(12)) hg_h1_task(a, smem, it - NCI); } } }
        else { for (int it = BID; it < T / 64; it += NBLK) if (EN(13)) conv_task(a, smem, li, it); }
        break;
#ifdef EMU
    case 3:
        if (even) { constexpr int NA = 4 * (SEQ / 64); const int G = NBLK;
            for (int r = 0; r * G < NA; ++r) { const int it = r * G + ((r & 1) ? (G - 1 - BID) : BID); if (it < NA) { if (EN(3)) attn_task(a, smem, li, it); } }
            for (int it = BID; it < 64; it += NBLK) if (EN(14)) hg_scan_task(a, it); }
        break;
    case 4: if (even) { for (int it = BID; it < 8 * NCH; it += NBLK) if (EN(4)) hg_h3_task(a, smem, li, it); } break;
#else
    case 3:
        if (even) { constexpr int NA = 4 * (SEQ / 64); const int G = NBLK;
            typedef __attribute__((address_space(1))) unsigned gu32;
            gu32* cw = (gu32*)((unsigned*)(ws + WS_BAR) + P0_CTR_IDX + 1 + 2 * li);
            int nsc = 0;
            for (int it = BID; it < 64; it += NBLK) { hg_scan_task(a, it); ++nsc; }
            if (nsc > 0) { __builtin_amdgcn_fence(__ATOMIC_RELEASE, "agent"); asm volatile("s_waitcnt vmcnt(0)" ::: "memory"); SYNC(); if (TID == 0) (void)__hip_atomic_fetch_add(cw, (unsigned)nsc, __ATOMIC_RELAXED, __HIP_MEMORY_SCOPE_AGENT); }
            for (int r = 0; r * G < NA; ++r) { const int it = r * G + ((r & 1) ? (G - 1 - BID) : BID); if (it < NA) attn_task(a, smem, li, it); }
            if ((TID >> 6) == 0) { unsigned sp = 0u; gu32* tmo = (gu32*)((unsigned*)(ws + WS_BAR) + MOE_TMO_IDX);
                while ((unsigned)__builtin_amdgcn_readfirstlane((int)__hip_atomic_load(cw, __ATOMIC_RELAXED, __HIP_MEMORY_SCOPE_AGENT)) < 64u) {
                    __builtin_amdgcn_s_sleep(1);
                    if ((++sp & 255u) == 0u) { if (__hip_atomic_load(tmo, __ATOMIC_RELAXED, __HIP_MEMORY_SCOPE_AGENT)) break; if (sp > (1u << 22)) { (void)__hip_atomic_fetch_add(tmo, 1u, __ATOMIC_RELAXED, __HIP_MEMORY_SCOPE_AGENT); break; } } }
                __builtin_amdgcn_fence(__ATOMIC_ACQUIRE, "agent"); }
            int* nxl = (int*)(smem + LDS_BYTES - 64);
            int my_next = 0; if (TID == 0) my_next = (int)__hip_atomic_fetch_add(cw + 1, 1u, __ATOMIC_RELAXED, __HIP_MEMORY_SCOPE_AGENT);
            for (;;) { SYNC(); if (TID == 0) nxl[0] = my_next; SYNC(); const int it = nxl[0]; if (it >= 8 * NCH) break;
                if (TID == 0) my_next = (int)__hip_atomic_fetch_add(cw + 1, 1u, __ATOMIC_RELAXED, __HIP_MEMORY_SCOPE_AGENT);
                hg_h3_task(a, smem, li, it); } }
        break;
    case 4: break;
#endif
    case 5:
        if (!EN(5)) break;
        if (even) resid_gemm_phase(a, smem, (const bf16*)(ws + WS_CAT), 1024, (const bf16*)(ws + WS_WOUT) + (size_t)li * DM * 1024, l);
        else resid_gemm_phase(a, smem, (const bf16*)(ws + WS_CAT), DM, (const bf16*)(ws + WS_PW2) + (size_t)li * DM * DM, l);
        break;
    case 6: if (EN(6)) route_phase(a, smem, l); break;
#ifdef EMU
    case 7: if (EN(7)) moe_gemm_phase8(a, smem, l, 0); break;
    case 8: if (EN(8)) moe_gemm_phase8(a, smem, l, 1); break;
#else
    case 7: if (EN(7)) moe_fused_phase(a, smem, l); break;
    case 8: break;
#endif
    }
}

#ifndef EMU
#define LAS __attribute__((address_space(3)))
#define XB_TMO      128
static_assert(XB_TMO == MOE_TMO_IDX && P0_CTR_IDX > XB_TMO && P0_CTR_IDX + 1 + DEPTH < 256, "timeout word / free words");
#define XB_XCNT(j)  (256  + 64 * (j))
#define XB_XSUB(j)  (1280 + 64 * (j))
#define XB_XGEN(j)  (2304 + 64 * (j))
#define XB_TOP      3328
#define XB_TOPGEN   3392
#define XCD_BAR_WORDS 3456
#define XB_SPIN_CAP (1u << 22)
__device__ __forceinline__ unsigned xb_ld(unsigned* p)              { return __hip_atomic_load(p, __ATOMIC_RELAXED, __HIP_MEMORY_SCOPE_AGENT); }
__device__ __forceinline__ unsigned xb_add(unsigned* p, unsigned v) { return __hip_atomic_fetch_add(p, v, __ATOMIC_RELAXED, __HIP_MEMORY_SCOPE_AGENT); }
__device__ __forceinline__ unsigned xb_xcc_id() { return (unsigned)__builtin_amdgcn_s_getreg((3 << 11) | 20) & 0xFu; }
#define XB_SPIN(cond, bar) do { unsigned _sp = 0; while (cond) { __builtin_amdgcn_s_sleep(1); \
    if ((++_sp & 255u) == 0u) { if (xb_ld(&(bar)[XB_TMO])) break; if (_sp > XB_SPIN_CAP) { atomicAdd(&(bar)[XB_TMO], 1u); break; } } } } while (0)
struct XcdBarrier { unsigned* bar; unsigned x; volatile LAS unsigned* st; };
__device__ __forceinline__ XcdBarrier xcd_barrier_post(unsigned* bar, volatile LAS unsigned* st) {
    XcdBarrier b; b.bar = bar; b.x = xb_xcc_id(); b.st = st;
    if (threadIdx.x == 0) (void)xb_add(&bar[XB_XCNT(b.x)], 1u);
    return b;
}
__device__ __forceinline__ void xcd_barrier_complete(unsigned* bar, unsigned x, unsigned& nloc, unsigned& nx) {
    const unsigned G = gridDim.x * gridDim.y * gridDim.z;
    unsigned sum, cnt, mine, sp = 0u;
    for (;;) {
        sum = 0u; cnt = 0u; mine = 0u;
#pragma unroll
        for (unsigned j = 0; j < 16; ++j) { const unsigned c = xb_ld(&bar[XB_XCNT(j)]); sum += c; cnt += (c > 0u) ? 1u : 0u; mine = (j == x) ? c : mine; }
        if (sum == G) break;
        __builtin_amdgcn_s_sleep(1);
        if ((++sp & 255u) == 0u) { if (xb_ld(&bar[XB_TMO])) break; if (sp > XB_SPIN_CAP) { atomicAdd(&bar[XB_TMO], 1u); break; } }
    }
    nloc = mine > 0u ? mine : 1u; nx = cnt > 0u ? cnt : 1u;
}
__device__ __forceinline__ void xcd_barrier(const XcdBarrier& b) {
    asm volatile("s_waitcnt vmcnt(0)" ::: "memory");
    __syncthreads();
    if (threadIdx.x == 0) {
        unsigned* bar = b.bar;
        __builtin_amdgcn_s_waitcnt(0);
        unsigned nloc = b.st[0], nx = b.st[1];
        if (nloc == 0u) { xcd_barrier_complete(bar, b.x, nloc, nx); b.st[0] = nloc; b.st[1] = nx; }
        const unsigned old = xb_add(&bar[XB_XSUB(b.x)], 1u);
        const unsigned gen = old / nloc;
        if (old + 1u == (gen + 1u) * nloc) {
            __builtin_amdgcn_fence(__ATOMIC_RELEASE, "agent");
            asm volatile("s_waitcnt vmcnt(0)" ::: "memory");
            const unsigned og = xb_add(&bar[XB_TOP], 1u);
            const unsigned tg = og / nx;
            if (og + 1u == (tg + 1u) * nx) xb_add(&bar[XB_TOPGEN], 1u);
            else XB_SPIN(xb_ld(&bar[XB_TOPGEN]) == tg, bar);
            __builtin_amdgcn_fence(__ATOMIC_ACQUIRE, "agent");
            xb_add(&bar[XB_XGEN(b.x)], 1u);
            asm volatile("s_waitcnt vmcnt(0)" ::: "memory");
        } else {
            XB_SPIN(xb_ld(&bar[XB_XGEN(b.x)]) == gen, bar);
            __builtin_amdgcn_fence(__ATOMIC_ACQUIRE, "agent");
            asm volatile("s_waitcnt vmcnt(0)" ::: "memory");
        }
    }
    __syncthreads();
}

__global__ void __launch_bounds__(NT, 2) mega(Args a) {
    extern __shared__ __attribute__((aligned(16))) unsigned char lds[];
    volatile LAS unsigned* st = (volatile LAS unsigned*)(LAS unsigned char*)(lds + LDS_BYTES - 16);
    if (threadIdx.x < 4) st[threadIdx.x] = 0u;
    __syncthreads();
    unsigned* barw = (unsigned*)(a.ws + WS_BAR);
    XcdBarrier bar = xcd_barrier_post(barw, st);
#pragma unroll 1
    for (int ph = 0; ph < N_PHASES; ++ph) {
        if (ph > 0 && ph < N_PHASES - 1) { int l_, s_; phase_decode(ph, l_, s_); if (s_ == 8 || (s_ == 4 && (l_ & 1) == 0)) continue; }
        run_phase(a, lds, ph);
#ifdef DUP
        { int lyr = 0, sub = 100; if (ph > 0 && ph < N_PHASES - 1) phase_decode(ph, lyr, sub);
          if (sub == (DUP % 1000) && (ph == 0 || lyr == DUP / 1000) && ph < N_PHASES - 1) { xcd_barrier(bar); run_phase(a, lds, ph); } }
#endif
        if (ph + 1 < N_PHASES) xcd_barrier(bar);
    }
    if (xb_ld(&barw[XB_TMO]) != 0u) {
        const size_t gt = (size_t)blockIdx.x * NT + threadIdx.x, gs = (size_t)gridDim.x * NT;
        for (size_t i = gt; i < (size_t)T * DM; i += gs) a.out[i] = __builtin_nanf("");
    }
}

extern "C" void kernel_launch(void* const* d_in, const int* in_sizes, int n_in, void* d_out, int out_size,
                              void* d_ws, size_t ws_size, hipStream_t stream) {
    static int grid = 0;
    if (grid == 0) {
        int dev = 0, cus = 0;
        if (hipGetDevice(&dev) != hipSuccess || hipDeviceGetAttribute(&cus, hipDeviceAttributeMultiprocessorCount, dev) != hipSuccess) { grid = -1; return; }
        if (hipFuncSetAttribute((const void*)mega, hipFuncAttributeMaxDynamicSharedMemorySize, LDS_BYTES) != hipSuccess) { grid = -1; return; }
        (void)hipGetLastError();
        grid = cus;
        if (n_in != 26 || out_size != T * DM || ws_size < WS_END) { fprintf(stderr, "kernel_launch: unexpected sizes n_in %d out %d ws %zu (need %zu)\n", n_in, out_size, ws_size, (size_t)WS_END); grid = -1; return; }
    }
    if (grid < 0) return;
    (void)hipMemsetAsync((unsigned char*)d_ws + WS_BAR, 0, XCD_BAR_WORDS * 4, stream);
    Args a{};
    for (int i = 0; i < 26; ++i) a.in[i] = (const float*)d_in[i];
    a.out = (float*)d_out; a.ws = (unsigned char*)d_ws;
    hipLaunchKernelGGL(mega, dim3(grid), dim3(NT), LDS_BYTES, stream, a);
}
#endif
```

```cpp
#ifdef EMU
#include "emu.h"
#define DEV static inline
#define MDEV inline
#define OPAQUE(p)
#define OPAQUE2(a, b)
#define TID emu_tid()
#define BID (EB->bid)
#define NBLK (EB->nblk)
#define SYNC() emu_sync_block()
#define WSYNC() emu_sync_wave()
#define mfma16(a, b, c) emu_mfma16(a, b, c)
DEV float shflx(float v, int m) { return emu_shfl_f(v, (emu_tid() & 63) ^ m); }
DEV int shflxi(int v, int m) { return (int)emu_shfl_u((unsigned)v, (emu_tid() & 63) ^ m); }
DEV float shfl(float v, int s) { return emu_shfl_f(v, s); }
DEV float dpp_ror1(float v) { const int l = emu_tid() & 63; return emu_shfl_f(v, (l & 48) | ((l - 1) & 15)); }
DEV int atomic_add_i(int* p, int v) { return __atomic_fetch_add(p, v, __ATOMIC_RELAXED); }
typedef float f32x2v __attribute__((vector_size(8)));
DEV float fexp2(float x) { return exp2f(x); }
DEV float frcp(float x) { return 1.0f / x; }
DEV float frsq(float x) { return 1.0f / sqrtf(x); }
typedef short s16x4 __attribute__((vector_size(8)));
static inline s16x4 emu_tr4(const unsigned short* p) {
    EmuWave& w = EB->wave[emu_tid() >> 6]; int l = emu_tid() & 63;
    const unsigned short** tab = (const unsigned short**)w.a;
    tab[l] = p; emu_sync_wave();
    s16x4 r; int g = l & 48, i = l & 15;
    for (int q = 0; q < 4; ++q) r[q] = (short)tab[g + 4 * q + (i >> 2)][i & 3];
    emu_sync_wave(); return r;
}
#define tr4(p) emu_tr4(p)
#else
#include <hip/hip_runtime.h>
#include <cstdio>
#include <cstdint>
typedef short bf16x8 __attribute__((ext_vector_type(8)));
typedef float f32x4 __attribute__((ext_vector_type(4)));
typedef unsigned u32x4 __attribute__((ext_vector_type(4)));
typedef unsigned u32x2 __attribute__((ext_vector_type(2)));
#define DEV __device__ __forceinline__
#define MDEV __device__ __forceinline__
#define OPAQUE(p) asm volatile("" : "+v"(p))
#define OPAQUE2(a, b) asm volatile("" : "+v"(a), "+v"(b))
DEV int tid_opaque() { int t = (int)threadIdx.x; asm volatile("" : "+v"(t)); return t; }
#define TID tid_opaque()
DEV int bid_opaque() { int b = (int)blockIdx.x; asm volatile("" : "+s"(b)); return b; }
#define BID bid_opaque()
#define NBLK ((int)gridDim.x)
#define SYNC() __syncthreads()
#define WSYNC() __builtin_amdgcn_wave_barrier()
#define mfma16(a, b, c) __builtin_amdgcn_mfma_f32_16x16x32_bf16(a, b, c, 0, 0, 0)
DEV int shflxi(int x, int m) {
    if (m == 1) return __builtin_amdgcn_update_dpp(x, x, 0xB1, 0xf, 0xf, true);
    if (m == 2) return __builtin_amdgcn_update_dpp(x, x, 0x4E, 0xf, 0xf, true);
    if (m == 4) return __builtin_amdgcn_ds_swizzle(x, (4 << 10) | 0x1F);
    if (m == 8) return __builtin_amdgcn_ds_swizzle(x, (8 << 10) | 0x1F);
    if (m == 16) return __builtin_amdgcn_ds_swizzle(x, (16 << 10) | 0x1F);
    if (m == 32) { const auto r = __builtin_amdgcn_permlane32_swap((unsigned)x, (unsigned)x, false, false); return (int)((threadIdx.x & 32) ? r[0] : r[1]); }
    return __shfl_xor(x, m);
}
DEV float shflx(float v, int m) { return __builtin_bit_cast(float, shflxi(__builtin_bit_cast(int, v), m)); }
DEV float dpp_ror1(float v) { return __builtin_bit_cast(float, __builtin_amdgcn_update_dpp(0, __builtin_bit_cast(int, v), 0x121, 0xf, 0xf, false)); }
DEV float shfl(float v, int s) { return __shfl(v, s); }
DEV int atomic_add_i(int* p, int v) { return atomicAdd(p, v); }
DEV float fexp2(float x) { return __builtin_amdgcn_exp2f(x); }
DEV float frcp(float x) { return __builtin_amdgcn_rcpf(x); }
DEV float frsq(float x) { return __builtin_amdgcn_rsqf(x); }
typedef short s16x4 __attribute__((ext_vector_type(4)));
#define tr4(p) __builtin_amdgcn_ds_read_tr16_b64_v4i16((__attribute__((address_space(3))) s16x4*)(p))
#endif

typedef unsigned short bf16;

#ifndef DM
#define DM 1024
#endif
#ifndef SEQ
#define SEQ 8192
#endif
#ifndef FF
#define FF 512
#endif
constexpr int NBATCH = 2, T = NBATCH * SEQ, DEPTH = 4;
constexpr int NIN = 3352, NINP = 3456, NIN8 = 3584;
constexpr int NT = 512;
constexpr int NCH = SEQ / 64;
constexpr int NCP = SEQ / 16;
constexpr int NCMP = NCP - 1;
constexpr int MOE_ROWS = 2 * T + 32 * 256;
constexpr float EPS = 1e-6f, NEGV = -1e30f, FORCEV = 1e4f, LOG2E = 1.4426950408889634f;

constexpr size_t al(size_t x) { return (x + 255) & ~(size_t)255; }
constexpr int P0_CTR_IDX = 192;
constexpr size_t WS_BAR = 0;
constexpr size_t WS_CNT = 16384;
constexpr size_t WS_MOD = WS_CNT + (size_t)DEPTH * 32 * 256;
constexpr size_t WS_LB = al(WS_MOD + (size_t)DEPTH * 2 * 6 * DM * 4);
constexpr size_t WS_CB = al(WS_LB + 2 * 512 * 4);
constexpr size_t WS_CS = al(WS_CB + 2 * 2 * 8 * 64 * 4);
constexpr size_t WS_WIN = al(WS_CS + 64);
constexpr size_t WS_WOUT = al(WS_WIN + (size_t)2 * NIN8 * DM * 2);
constexpr size_t WS_PW1 = al(WS_WOUT + (size_t)2 * DM * 1024 * 2);
constexpr size_t WS_PW2 = al(WS_PW1 + (size_t)2 * 2 * DM * DM * 2);
constexpr size_t WS_WC = al(WS_PW2 + (size_t)2 * DM * DM * 2);
constexpr size_t WS_W13 = al(WS_WC + (size_t)2 * 2 * 64 * 2048 * 2);
constexpr size_t WS_W2 = al(WS_W13 + (size_t)DEPTH * 32 * 2 * FF * DM * 2);
constexpr size_t WS_H = al(WS_W2 + (size_t)DEPTH * 32 * DM * FF * 2);
constexpr size_t WS_QN = al(WS_H + (size_t)T * DM * 2);
constexpr size_t WS_KCG = al(WS_QN + (size_t)T * 512 * 2);
constexpr size_t WS_VCG = al(WS_KCG + (size_t)T * 128 * 2);
constexpr size_t WS_KS = al(WS_VCG + (size_t)T * 128 * 2);
constexpr size_t WS_KW = al(WS_KS + (size_t)T * 128 * 2);
constexpr size_t WS_VST = al(WS_KW + (size_t)T * 128 * 2);
constexpr size_t WS_VWT = al(WS_VST + (size_t)T * 128 * 2);
constexpr size_t WS_KC = al(WS_VWT + (size_t)T * 128 * 2);
constexpr size_t WS_VCT = al(WS_KC + (size_t)4 * NCP * 64 * 2);
constexpr size_t WS_GATE = al(WS_VCT + (size_t)4 * NCP * 64 * 2);
constexpr size_t WS_HQ = al(WS_GATE + (size_t)T * 24 * 4);
constexpr size_t WS_HF = al(WS_HQ + (size_t)T * 512 * 2);
constexpr size_t WS_HV = al(WS_HF + (size_t)T * 512 * 4);
constexpr size_t WS_HGS = al(WS_HV + (size_t)T * 512 * 2);
constexpr size_t WS_UT = al(WS_HGS + (size_t)T * 512 * 2);
constexpr size_t WS_ST = al(WS_UT + (size_t)8 * NCH * 128 * 128 * 4);
constexpr size_t WS_GD = al(WS_ST + (size_t)8 * NCH * 128 * 128 * 2);
constexpr size_t WS_CAT = al(WS_GD + (size_t)8 * NCH * 128 * 4);
constexpr size_t WS_GLU = al(WS_CAT + (size_t)T * 1024 * 2);
constexpr size_t WS_TIE = al(WS_GLU + (size_t)T * DM * 2);
constexpr size_t WS_TIW = al(WS_TIE + (size_t)T * 2 * 4);
constexpr size_t WS_LIST = al(WS_TIW + (size_t)T * 2 * 4);
constexpr size_t WS_ACT = al(WS_LIST + (size_t)32 * T * 4);
constexpr size_t WS_YK = al(WS_ACT + (size_t)MOE_ROWS * FF * 2);
constexpr size_t WS_WTH = al(WS_YK + (size_t)MOE_ROWS * DM * 2);
constexpr size_t WS_WTL = al(WS_WTH + (size_t)DEPTH * 48 * DM * 2);
constexpr size_t WS_AVEC = al(WS_WTL + (size_t)DEPTH * 48 * DM * 2);
constexpr size_t WS_RBIAS = al(WS_AVEC + (size_t)DEPTH * 2 * DM * 4);
constexpr size_t WS_FLG = al(WS_RBIAS + (size_t)DEPTH * 2 * 48 * 4);
constexpr size_t WS_END = al(WS_FLG + (size_t)DEPTH * 256 * 64);

struct Args { const float* in[26]; float* out; unsigned char* ws; };
enum { I_X = 0, I_C, I_ADAW, I_ADAB, I_NMIX, I_NFFN, I_WIN, I_WOUT, I_CWK, I_CWV, I_CPE, I_QG, I_KG, I_LBL, I_OG,
       I_PW1, I_DW, I_DWB, I_LNG, I_LNB, I_PW2, I_WG, I_WE, I_W1, I_W3, I_W2 };

#ifdef EMU
DEV unsigned char* wsp(const Args& a) { return a.ws; }
DEV float* outp(const Args& a) { return a.out; }
#else
DEV unsigned char* launder_ptr(const void* p) { unsigned long long v = (unsigned long long)p; unsigned lo = (unsigned)v, hi = (unsigned)(v >> 32);
    lo = (unsigned)__builtin_amdgcn_readfirstlane((int)lo); hi = (unsigned)__builtin_amdgcn_readfirstlane((int)hi); asm volatile("" : "+s"(lo), "+s"(hi)); typedef __attribute__((address_space(1))) unsigned char* gptr_t; return (unsigned char*)(gptr_t)(((unsigned long long)hi << 32) | lo); }
DEV unsigned char* wsp(const Args& a) { return launder_ptr(a.ws); }
DEV float* outp(const Args& a) { return (float*)launder_ptr(a.out); }
#endif

#ifdef EMU
#define INP(a, X) ((a).in[X])
#else
DEV int zero_opaque() { int z = 0; asm volatile("" : "+s"(z)); return z; }
#define INP(a, X) ((a).in[(X) + zero_opaque()])
#endif

DEV unsigned f2bf(float f) { unsigned u = __builtin_bit_cast(unsigned, f); return (u + 0x7fffu + ((u >> 16) & 1u)) >> 16; }
DEV float bf2f(unsigned h) { return __builtin_bit_cast(float, h << 16); }
#ifdef EMU
DEV unsigned pk2(float lo, float hi) { return f2bf(lo) | (f2bf(hi) << 16); }
#else
typedef float f32x2_t __attribute__((ext_vector_type(2)));
typedef float f32x2v __attribute__((ext_vector_type(2)));
typedef __bf16 bf16x2_t __attribute__((ext_vector_type(2)));
DEV unsigned pk2(float lo, float hi) { f32x2_t v = {lo, hi}; bf16x2_t b = __builtin_convertvector(v, bf16x2_t); return __builtin_bit_cast(unsigned, b); }
#endif
DEV float sigm(float x) { return frcp(1.0f + fexp2(-x * LOG2E)); }
DEV float siluf(float x) { return x * sigm(x); }
DEV f32x4 f4zero() { f32x4 z = {0.f, 0.f, 0.f, 0.f}; return z; }
DEV bf16x8 pack8(f32x4 a, f32x4 b) {
    u32x4 w; w[0] = pk2(a[0], a[1]); w[1] = pk2(a[2], a[3]); w[2] = pk2(b[0], b[1]); w[3] = pk2(b[2], b[3]);
    return __builtin_bit_cast(bf16x8, w);
}
DEV void st_bf8(bf16* p, f32x4 a, f32x4 b) { u32x4 w; w[0] = pk2(a[0], a[1]); w[1] = pk2(a[2], a[3]); w[2] = pk2(b[0], b[1]); w[3] = pk2(b[2], b[3]); *(u32x4*)p = w; }
DEV void st_bf4(bf16* p, f32x4 v) { u32x2 w; w[0] = pk2(v[0], v[1]); w[1] = pk2(v[2], v[3]); *(u32x2*)p = w; }


#ifdef EMU
namespace pg8 {
constexpr int BM = 256, BK = 64, HALF = 128, NXCD = 8, WGM = 8;
typedef unsigned short bf16_t;
struct Unit { int pm, pn; };
struct Gemm { const bf16_t* A; const bf16_t* Bt; int M, N, K; };
struct StaticOrder {
    int nM, nN, nwg, G, c;
    void init(int M, int N, int G_, int c_) { nM = M / BM; nN = N / BM; nwg = nM * nN; G = G_; c = c_; }
    bool next(int i, Unit& u) const {
        const long L = (long)i * G + c; if (L >= nwg) return false;
        int wgid = (int)L; { const int q = nwg / NXCD, r = nwg % NXCD, xcd = wgid % NXCD, off = wgid / NXCD; wgid = (xcd < r ? xcd * (q + 1) : r * (q + 1) + (xcd - r) * q) + off; }
        const int nig = WGM * nN, gid = wgid / nig, fm = gid * WGM, gsz = (nM - fm) < WGM ? (nM - fm) : WGM;
        u.pm = fm + ((wgid % nig) % gsz); u.pn = (wgid % nig) / gsz; return true;
    }
};
struct SelNone { static constexpr bool GATHER = false; struct Ctx {}; Ctx ctx(const Unit&) const { return Ctx(); } size_t boff(const Ctx&) const { return 0; } unsigned aoff(const Ctx&, int) const { return 0u; } };
template <class Epi, class Sched, bool ALIGN_EPI = false, bool SP2 = false, class Sel = SelNone>
static inline void gemm_phase(unsigned char*, const Gemm g, const Sched& S, const Epi& E, const Sel& X = Sel()) {
    const int tid = emu_tid(), wid = tid >> 6, lane = tid & 63, wr = wid >> 2, wc = wid & 3, fr = lane & 15, fq = lane >> 4;
    Unit u;
    for (int ui = 0; S.next(ui, u); ++ui) {
        f32x4 acc[2][2][4][2]; const auto cx = X.ctx(u);
        for (int ai = 0; ai < 2; ++ai) for (int bj = 0; bj < 2; ++bj) for (int m = 0; m < 4; ++m) for (int n = 0; n < 2; ++n) for (int r = 0; r < 4; ++r) {
            const int row = 256 * u.pm + 128 * ai + 64 * wr + 16 * m + fr, col = 256 * u.pn + 128 * bj + 32 * wc + (Epi::PERM ? 8 * fq + 4 * n + r : 16 * n + 4 * fq + r); float sum = 0.f;
            const bf16_t* ap = Sel::GATHER ? (const bf16_t*)((const char*)g.A + X.aoff(cx, row - 256 * u.pm)) : g.A + (size_t)row * g.K; const bf16_t* bp = (const bf16_t*)((const char*)g.Bt + X.boff(cx)) + (size_t)col * g.K;
            for (int k = 0; k < g.K; ++k) sum += bf2f(ap[k]) * bf2f(bp[k]);
            acc[ai][bj][m][n][r] = sum; }
        E(acc, u, wr, wc, fr, fq);
    }
    emu_sync_block();
}
}
#else
namespace pg8 {
#define PG8_LAS __attribute__((address_space(3)))
typedef unsigned short bf16_t;
typedef short bf16x8 __attribute__((ext_vector_type(8)));
typedef float f32x4 __attribute__((ext_vector_type(4)));
typedef unsigned u32x4 __attribute__((ext_vector_type(4)));
constexpr int BM = 256, BK = 64, HALF = 128, HTB = HALF * BK * 2  , STAGE_BYTES = 8 * HTB, NXCD = 8, WGM = 8;

__host__ __device__ __forceinline__ int lds_byte(int r, int c) { const int st = (r >> 4) * 2 + (c >> 5), rr = r & 15, cc = c & 31, ob = rr * 64 + cc * 2; return st * 1024 + (ob ^ (((ob >> 9) & 1) << 5)); }
__host__ __device__ __forceinline__ void stage_rc(int b, int& R, int& C) { const int st = b / 1024, sb = b % 1024, swz = sb ^ (((sb >> 9) & 1) << 5); R = (st >> 1) * 16 + swz / 64; C = (st & 1) * 32 + (swz % 64) / 2; }
__host__ __device__ __forceinline__ int perm32(int rho) { const int n = rho >> 4, i = rho & 15; return 8 * (i >> 2) + 4 * n + (i & 3); }

struct Unit { int pm, pn; };
struct Gemm { const bf16_t* A; const bf16_t* Bt; int M, N, K; };

struct StaticOrder {
    int nM, nN, nwg, G, c;
    __host__ __device__ void init(int M, int N, int G_, int c_) { nM = M / BM; nN = N / BM; nwg = nM * nN; G = G_; c = c_; }
    __host__ __device__ bool next(int i, Unit& u) const {
        const long L = (long)i * G + c; if (L >= nwg) return false;
        int wgid = (int)L; { const int q = nwg / NXCD, r = nwg % NXCD, xcd = wgid % NXCD, off = wgid / NXCD; wgid = (xcd < r ? xcd * (q + 1) : r * (q + 1) + (xcd - r) * q) + off; }
        const int nig = WGM * nN, gid = wgid / nig, fm = gid * WGM, gsz = (nM - fm) < WGM ? (nM - fm) : WGM;
        u.pm = fm + ((wgid % nig) % gsz); u.pn = (wgid % nig) / gsz; return true;
    }
    __device__ __forceinline__ void a_ready(const Unit&) const {}
    __device__ __forceinline__ void done(const Unit&) const {}
};

__device__ __forceinline__ unsigned cvt_pk_bf16(float lo, float hi) { unsigned r; asm volatile("v_cvt_pk_bf16_f32 %0, %1, %2" : "=v"(r) : "v"(lo), "v"(hi)); return r; }
struct SelNone { static constexpr bool GATHER = false; struct Ctx {}; __device__ __forceinline__ Ctx ctx(const Unit&) const { return Ctx(); } __device__ __forceinline__ size_t boff(const Ctx&) const { return 0; } __device__ __forceinline__ unsigned aoff(const Ctx&, int) const { return 0u; } };
template <class Epi, class Sched, bool ALIGN_EPI = false, bool SP2 = false, class Sel = SelNone>
__device__ __forceinline__ void gemm_phase(PG8_LAS unsigned char* lds, const Gemm g, const Sched& S, const Epi& E, const Sel& X = Sel()) {
    constexpr bool GA = Sel::GATHER;
    const int tid = TID, wid = __builtin_amdgcn_readfirstlane(tid >> 6), lane = tid & 63, wr = wid >> 2, wc = wid & 3, fr = lane & 15, fq = lane >> 4;
    const int K = g.K, nt = K / BK;
    unsigned voffA[2], voffB[2]; int Rl[2]; unsigned Cl2[2];
#pragma unroll
    for (int i = 0; i < 2; ++i) { int R, C; stage_rc(tid * 16 + i * 8192, R, C); const int Rb = Epi::PERM ? ((R & ~31) + perm32(R & 31)) : R;
        voffA[i] = (unsigned)(R * K + C) * 2u; voffB[i] = (unsigned)(Rb * K + C) * 2u; Rl[i] = R; Cl2[i] = (unsigned)C * 2u; }
    unsigned vA[2][2], vAn[2][2];
    const size_t kstep = (size_t)(BK * 2);
    const size_t hstep = (size_t)HALF * K * 2;
    const size_t tstep = 2 * hstep;
    const unsigned ldsw = (unsigned)wid * 1024u;
    const int aoff = lds_byte(wr * 64 + fr, fq * 8), boff = lds_byte(wc * 32 + fr, fq * 8);
#define PG8_SA(b, h) (((b) * 2 + (h)) * HTB)
#define PG8_SB(b, h) ((4 + (b) * 2 + (h)) * HTB)
#define PG8_STAGE(bufoff, gbase, voff) do { _Pragma("unroll") for (int _i = 0; _i < 2; ++_i) \
        __builtin_amdgcn_global_load_lds((const unsigned*)((const char*)(gbase) + (voff)[_i]), (PG8_LAS unsigned*)(lds + (bufoff) + ldsw + _i * 8192), 16, 0, 0); } while (0)
#define PG8_STAGE_A(bufoff, p, h, nx) do { if constexpr (GA) { unsigned _vo[2] = {(nx) ? vAn[h][0] : vA[h][0], (nx) ? vAn[h][1] : vA[h][1]}; PG8_STAGE(bufoff, p, _vo); } else { PG8_STAGE(bufoff, (p) + (h) * hstep, voffA); } } while (0)
#define PG8_GATH(cx, dst) do { _Pragma("unroll") for (int _h = 0; _h < 2; ++_h) _Pragma("unroll") for (int _i = 0; _i < 2; ++_i) dst[_h][_i] = X.aoff(cx, 128 * _h + Rl[_i]) + Cl2[_i]; } while (0)
#define PG8_LDA(dst, b, h) do { _Pragma("unroll") for (int m = 0; m < 4; ++m) _Pragma("unroll") for (int k = 0; k < 2; ++k) dst[m][k] = *(const PG8_LAS bf16x8*)(lds + PG8_SA(b, h) + aoff + m * 2048 + k * 1024); } while (0)
#define PG8_LDB(dst, b, h) do { _Pragma("unroll") for (int n = 0; n < 2; ++n) _Pragma("unroll") for (int k = 0; k < 2; ++k) dst[n][k] = *(const PG8_LAS bf16x8*)(lds + PG8_SB(b, h) + boff + n * 2048 + k * 1024); } while (0)
#define PG8_MMA(ai, bj, At, Bt) do { __builtin_amdgcn_s_setprio(1); _Pragma("unroll") for (int m = 0; m < 4; ++m) _Pragma("unroll") for (int n = 0; n < 2; ++n) _Pragma("unroll") for (int k = 0; k < 2; ++k) \
        acc[ai][bj][m][n] = __builtin_amdgcn_mfma_f32_16x16x32_bf16(Bt[n][k], At[m][k], acc[ai][bj][m][n], 0, 0, 0); __builtin_amdgcn_s_setprio(0); } while (0)
#define PG8_WAIT_V(n) asm volatile("s_waitcnt vmcnt(" #n ")" ::: "memory")
#define PG8_WAIT_L(n) asm volatile("s_waitcnt lgkmcnt(" #n ")" ::: "memory")
#define PG8_BAR __builtin_amdgcn_s_barrier()
#define PG8_SCHED __builtin_amdgcn_sched_barrier(0)
    Unit cur, nxt; int ui = 0;
    if (!S.next(0, cur)) return;
    f32x4 acc[2][2][4][2];
#pragma unroll
    for (int a = 0; a < 2; ++a)
#pragma unroll
        for (int b = 0; b < 2; ++b)
#pragma unroll
            for (int m = 0; m < 4; ++m)
#pragma unroll
                for (int n = 0; n < 2; ++n) acc[a][b][m][n] = (f32x4){0.f, 0.f, 0.f, 0.f};
    bf16x8 At[4][2], B0[2][2], B1[2][2];
    auto ccx = X.ctx(cur);
    const char* cA = GA ? (const char*)g.A : (const char*)g.A + (size_t)cur.pm * tstep; const char* cB = (const char*)g.Bt + X.boff(ccx) + (size_t)cur.pn * tstep;
    if constexpr (GA) { PG8_GATH(ccx, vA); }
    S.a_ready(cur);
    if constexpr (SP2) {
        PG8_STAGE(PG8_SB(0, 0), cB, voffB); PG8_STAGE(PG8_SB(0, 1), cB + hstep, voffB); PG8_STAGE_A(PG8_SA(0, 0), cA, 0, false); PG8_STAGE_A(PG8_SA(0, 1), cA, 1, false);
        if (wr == 1) PG8_BAR;
        PG8_WAIT_V(2); PG8_BAR;
        PG8_STAGE(PG8_SB(1, 0), cB + kstep, voffB); PG8_STAGE_A(PG8_SA(1, 0), cA + kstep, 0, false); PG8_STAGE(PG8_SB(1, 1), cB + hstep + kstep, voffB);
        PG8_WAIT_V(6); PG8_BAR;
    } else {
        PG8_STAGE(PG8_SB(0, 0), cB, voffB); PG8_STAGE_A(PG8_SA(0, 0), cA, 0, false); PG8_STAGE(PG8_SB(0, 1), cB + hstep, voffB); PG8_STAGE_A(PG8_SA(0, 1), cA, 1, false);
        if (wr == 1) PG8_BAR;
        PG8_WAIT_V(4); PG8_BAR;
        PG8_STAGE(PG8_SB(1, 0), cB + kstep, voffB); PG8_STAGE_A(PG8_SA(1, 0), cA + kstep, 0, false); PG8_STAGE(PG8_SB(1, 1), cB + hstep + kstep, voffB);
        PG8_WAIT_V(6); PG8_BAR;
    }
    for (;;) {
        const bool has_next = S.next(ui + 1, nxt);
        const char* nA = cA; const char* nB = cB;
        if (has_next) { const auto ncx = X.ctx(nxt); nA = GA ? (const char*)g.A : (const char*)g.A + (size_t)nxt.pm * tstep; nB = (const char*)g.Bt + X.boff(ncx) + (size_t)nxt.pn * tstep; if constexpr (GA) { PG8_GATH(ncx, vAn); } }
        else if constexpr (GA) {
#pragma unroll
            for (int _h = 0; _h < 2; ++_h) { vAn[_h][0] = vA[_h][0]; vAn[_h][1] = vA[_h][1]; } }
        for (int t = 0; t < nt; t += 2) {
            const bool last = (t == nt - 2);
            const char* a1 = cA + (size_t)(t + 1) * kstep;
            const char* a2 = last ? nA : cA + (size_t)(t + 2) * kstep; const char* b2 = last ? nB : cB + (size_t)(t + 2) * kstep;
            const char* a3 = a2 + kstep; const char* b3 = b2 + kstep;
            if (last && has_next) S.a_ready(nxt);
            if constexpr (SP2) {
            PG8_LDB(B0, 0, 0); PG8_LDB(B1, 0, 1); PG8_SCHED; PG8_LDA(At, 0, 0); PG8_STAGE_A(PG8_SA(1, 1), a1, 1, false);
            PG8_WAIT_V(8); PG8_WAIT_L(0); PG8_BAR; PG8_MMA(0, 0, At, B0); PG8_MMA(0, 1, At, B1); PG8_BAR; PG8_SCHED;
            PG8_LDA(At, 0, 1); PG8_STAGE(PG8_SB(0, 0), b2, voffB); PG8_STAGE(PG8_SB(0, 1), b2 + hstep, voffB); PG8_STAGE_A(PG8_SA(0, 0), a2, 0, last);
            PG8_WAIT_V(8); PG8_WAIT_L(0); PG8_BAR; PG8_MMA(1, 0, At, B0); PG8_MMA(1, 1, At, B1); PG8_BAR; PG8_SCHED;
            PG8_LDB(B0, 1, 0); PG8_LDB(B1, 1, 1); PG8_SCHED; PG8_LDA(At, 1, 0); PG8_STAGE_A(PG8_SA(0, 1), a2, 1, last);
            PG8_WAIT_V(8); PG8_WAIT_L(0); PG8_BAR; PG8_MMA(0, 0, At, B0); PG8_MMA(0, 1, At, B1); PG8_BAR; PG8_SCHED;
            PG8_LDA(At, 1, 1); PG8_STAGE(PG8_SB(1, 0), b3, voffB); PG8_STAGE(PG8_SB(1, 1), b3 + hstep, voffB); PG8_STAGE_A(PG8_SA(1, 0), a3, 0, last);
            PG8_WAIT_V(8); PG8_WAIT_L(0); PG8_BAR; PG8_MMA(1, 0, At, B0); PG8_MMA(1, 1, At, B1); PG8_BAR; PG8_SCHED;
            } else {
            PG8_LDB(B0, 0, 0); PG8_SCHED; PG8_LDA(At, 0, 0); PG8_STAGE_A(PG8_SA(1, 1), a1, 1, false);
            PG8_WAIT_L(8); PG8_BAR; PG8_WAIT_L(0); PG8_MMA(0, 0, At, B0); PG8_BAR; PG8_SCHED;
            PG8_LDB(B1, 0, 1); PG8_STAGE(PG8_SB(0, 0), b2, voffB);
            PG8_BAR; PG8_WAIT_L(0); PG8_MMA(0, 1, At, B1); PG8_BAR;
            PG8_LDA(At, 0, 1); PG8_STAGE_A(PG8_SA(0, 0), a2, 0, last);
            PG8_BAR; PG8_WAIT_L(0); PG8_MMA(1, 0, At, B0); PG8_BAR; PG8_SCHED;
            PG8_STAGE(PG8_SB(0, 1), b2 + hstep, voffB);
            PG8_WAIT_V(6); PG8_BAR; PG8_MMA(1, 1, At, B1); PG8_BAR;
            PG8_LDB(B0, 1, 0); PG8_SCHED; PG8_LDA(At, 1, 0); PG8_STAGE_A(PG8_SA(0, 1), a2, 1, last);
            PG8_WAIT_L(8); PG8_BAR; PG8_WAIT_L(0); PG8_MMA(0, 0, At, B0); PG8_BAR; PG8_SCHED;
            PG8_LDB(B1, 1, 1); PG8_STAGE(PG8_SB(1, 0), b3, voffB);
            PG8_BAR; PG8_WAIT_L(0); PG8_MMA(0, 1, At, B1); PG8_BAR;
            PG8_LDA(At, 1, 1); PG8_STAGE_A(PG8_SA(1, 0), a3, 0, last);
            PG8_BAR; PG8_WAIT_L(0); PG8_MMA(1, 0, At, B0); PG8_BAR; PG8_SCHED;
            PG8_STAGE(PG8_SB(1, 1), b3 + hstep, voffB);
            PG8_WAIT_V(6); PG8_BAR; PG8_MMA(1, 1, At, B1); PG8_BAR;
            }
        }
        if constexpr (ALIGN_EPI) { if (wr == 0) PG8_BAR; }
        if constexpr (!Epi::AFTER_DRAIN) { E(acc, cur, wr, wc, fr, fq); S.done(cur); }
        if (!has_next) break;
#pragma unroll
        for (int a = 0; a < 2; ++a)
#pragma unroll
            for (int b = 0; b < 2; ++b)
#pragma unroll
                for (int m = 0; m < 4; ++m)
#pragma unroll
                    for (int n = 0; n < 2; ++n) acc[a][b][m][n] = (f32x4){0.f, 0.f, 0.f, 0.f};
        cur = nxt; cA = nA; cB = nB; ++ui;
        if constexpr (GA) {
#pragma unroll
            for (int _h = 0; _h < 2; ++_h) { vA[_h][0] = vAn[_h][0]; vA[_h][1] = vAn[_h][1]; } }
        if constexpr (ALIGN_EPI) { if (wr == 1) PG8_BAR; }
    }
    PG8_WAIT_V(0);
    if constexpr (!ALIGN_EPI) { if (wr == 0) PG8_BAR; }
    PG8_BAR;
    if constexpr (Epi::AFTER_DRAIN) { E.fused(acc, cur, wr, wc, fr, fq, lds, wid, lane); S.done(cur); }
#undef PG8_SA
#undef PG8_SB
#undef PG8_STAGE
#undef PG8_STAGE_A
#undef PG8_GATH
#undef PG8_LDA
#undef PG8_LDB
#undef PG8_MMA
#undef PG8_WAIT_V
#undef PG8_WAIT_L
#undef PG8_BAR
#undef PG8_SCHED
}
}
#endif

constexpr int LDT = 72;
constexpr int GEMM_AS = 256 * LDT, GEMM_BS = 128 * LDT;
constexpr int GEMM_LDS = 2 * (GEMM_AS + GEMM_BS) * 2;

template <class AF, class EPI>
DEV void gemm_tile(unsigned char* smem, AF af, const bf16* Bt, int ldb, int nvalid, int K, EPI& epi) {
    const int tid = TID, w = tid >> 6, l = tid & 63, h = l >> 4, c = l & 15, wm = w >> 1, wn = w & 1;
    bf16* As = (bf16*)smem; bf16* Bs = As + 2 * GEMM_AS;
    const bf16* ap[4]; const bf16* bp[2];
    const int col8 = (tid & 7) * 8, r0 = tid >> 3;
#pragma unroll
    for (int i = 0; i < 4; ++i) ap[i] = af(r0 + 64 * i) + col8;
#pragma unroll
    for (int i = 0; i < 2; ++i) { int rn = r0 + 64 * i; if (rn >= nvalid) rn = nvalid - 1; bp[i] = Bt + (size_t)rn * ldb + col8; }
    f32x4 acc[4][4];
#pragma unroll
    for (int i = 0; i < 4; ++i)
#pragma unroll
        for (int j = 0; j < 4; ++j) acc[i][j] = f4zero();
    bf16x8 ra[4], rb[2];
#pragma unroll
    for (int i = 0; i < 4; ++i) ra[i] = *(const bf16x8*)(ap[i]);
#pragma unroll
    for (int i = 0; i < 2; ++i) rb[i] = *(const bf16x8*)(bp[i]);
    SYNC();
#pragma unroll
    for (int i = 0; i < 4; ++i) *(bf16x8*)(As + (r0 + 64 * i) * LDT + col8) = ra[i];
#pragma unroll
    for (int i = 0; i < 2; ++i) *(bf16x8*)(Bs + (r0 + 64 * i) * LDT + col8) = rb[i];
    SYNC();
    const int nk = K / 64;
    for (int kt = 0; kt < nk; ++kt) {
        const int cur = kt & 1;
        if (kt + 1 < nk) {
#pragma unroll
            for (int i = 0; i < 4; ++i) ra[i] = *(const bf16x8*)(ap[i] + (kt + 1) * 64);
#pragma unroll
            for (int i = 0; i < 2; ++i) rb[i] = *(const bf16x8*)(bp[i] + (kt + 1) * 64);
        }
        const bf16* Ac = As + cur * GEMM_AS + (wm * 64 + c) * LDT + 8 * h;
        const bf16* Bc = Bs + cur * GEMM_BS + (wn * 64 + c) * LDT + 8 * h;
#pragma unroll
        for (int kk = 0; kk < 2; ++kk) {
            bf16x8 fa[4], fb[4];
#pragma unroll
            for (int i = 0; i < 4; ++i) { fa[i] = *(const bf16x8*)(Ac + i * 16 * LDT + kk * 32); fb[i] = *(const bf16x8*)(Bc + i * 16 * LDT + kk * 32); }
#pragma unroll
            for (int ni = 0; ni < 4; ++ni)
#pragma unroll
                for (int mi = 0; mi < 4; ++mi) acc[ni][mi] = mfma16(fb[ni], fa[mi], acc[ni][mi]);
        }
        if (kt + 1 < nk) {
            const int nx = cur ^ 1;
#pragma unroll
            for (int i = 0; i < 4; ++i) *(bf16x8*)(As + nx * GEMM_AS + (r0 + 64 * i) * LDT + col8) = ra[i];
#pragma unroll
            for (int i = 0; i < 2; ++i) *(bf16x8*)(Bs + nx * GEMM_BS + (r0 + 64 * i) * LDT + col8) = rb[i];
        }
        SYNC();
    }
    epi(acc, wm * 64, wn * 64, h, c);
}

struct ARows { const bf16* base; size_t ld; MDEV const bf16* operator()(int r) const { return base + (size_t)r * ld; } MDEV unsigned off(int r) const { return (unsigned)r * (unsigned)ld; } };

constexpr int LDB = 144;
constexpr int GEMM_BS2 = 64 * LDB;
constexpr int GEMM2_LDS = (2 * GEMM_AS + 2 * GEMM_BS2) * 2;
DEV bf16x8 tr_read8(const bf16* p0, const bf16* p1) {
    const s16x4 x = tr4(p0), y = tr4(p1); bf16x8 r;
    r[0] = x[0]; r[1] = x[1]; r[2] = x[2]; r[3] = x[3]; r[4] = y[0]; r[5] = y[1]; r[6] = y[2]; r[7] = y[3]; return r;
}
DEV int bperm(int r) { return (r & ~12) | ((r & 4) << 1) | ((r & 8) >> 1); }
template <class AF, class BF, class EPI>
DEV void gemm_tile2(unsigned char* smem, AF af, BF bf, int ldb, int K, EPI& epi) {
    const int tid = TID, w = tid >> 6, l = tid & 63, h = l >> 4, c = l & 15, wm = w >> 1, wn = w & 1, grp = w >> 2;
    bf16* As = (bf16*)smem; bf16* Bs = As + 2 * GEMM_AS;
    const bf16* abase = af.base; unsigned ao[4];
    const int col8 = (tid & 7) * 8, r0 = tid >> 3;
#pragma unroll
    for (int i = 0; i < 4; ++i) ao[i] = af.off(r0 + 64 * i) + col8;
    const int bn4 = (tid & 31) * 4, bk = tid >> 5, bkp = bperm(bk);
    const float* bp = bf(bn4); const bool bok = bp != nullptr;
    if (bok) bp += (size_t)bk * ldb;
    const size_t bstep = (size_t)16 * ldb;
    f32x4 acc[4][4];
#pragma unroll
    for (int i = 0; i < 4; ++i)
#pragma unroll
        for (int j = 0; j < 4; ++j) acc[i][j] = f4zero();
    bf16x8 ra[4]; f32x4 rb[4];
    const int nk = K / 64;
#pragma unroll
    for (int i = 0; i < 4; ++i) { ra[i] = *(const bf16x8*)(abase + ao[i]); rb[i] = bok ? *(const f32x4*)(bp + i * bstep) : f4zero(); }
    SYNC();
#pragma unroll
    for (int i = 0; i < 4; ++i) { *(bf16x8*)(As + (r0 + 64 * i) * LDT + col8) = ra[i]; st_bf4(Bs + (bkp + 16 * i) * LDB + bn4, rb[i]); }
    if (nk > 1) {
#pragma unroll
        for (int i = 0; i < 4; ++i) { ra[i] = *(const bf16x8*)(abase + (ao[i] + 64)); rb[i] = bok ? *(const f32x4*)(bp + (size_t)64 * ldb + i * bstep) : f4zero(); } }
    SYNC();
    for (int kt = 0; kt < nk; ++kt) {
        const int cur = kt & 1;
#pragma unroll
        for (int p = 0; p < 2; ++p) {
            if (grp == p) {
                const bf16* Ac = As + cur * GEMM_AS + (wm * 64 + c) * LDT + 8 * h;
                const bf16* Bc = Bs + cur * GEMM_BS2 + bperm(8 * h + (c >> 2)) * LDB + wn * 64 + 4 * (c & 3);
#pragma unroll
                for (int kk = 0; kk < 2; ++kk) {
                    bf16x8 fa[4], fb[4];
#pragma unroll
                    for (int i = 0; i < 4; ++i) { fa[i] = *(const bf16x8*)(Ac + i * 16 * LDT + kk * 32); fb[i] = tr_read8(Bc + (32 * kk) * LDB + 16 * i, Bc + (32 * kk + 8) * LDB + 16 * i); }
#pragma unroll
                    for (int ni = 0; ni < 4; ++ni)
#pragma unroll
                        for (int mi = 0; mi < 4; ++mi) acc[ni][mi] = mfma16(fb[ni], fa[mi], acc[ni][mi]);
                }
            } else if (kt + 1 < nk) {
                const int nx = cur ^ 1;
#pragma unroll
                for (int i = 0; i < 4; ++i) { *(bf16x8*)(As + nx * GEMM_AS + (r0 + 64 * i) * LDT + col8) = ra[i]; st_bf4(Bs + nx * GEMM_BS2 + (bkp + 16 * i) * LDB + bn4, rb[i]); }
                if (kt + 2 < nk) {
#pragma unroll
                    for (int i = 0; i < 4; ++i) { ra[i] = *(const bf16x8*)(abase + (ao[i] + (kt + 2) * 64)); rb[i] = bok ? *(const f32x4*)(bp + (size_t)(kt + 2) * 64 * ldb + i * bstep) : f4zero(); } }
            }
            SYNC();
        }
    }
    epi(acc, wm * 64, wn * 64, h, c);
}
struct BPlain { const float* base; MDEV const float* operator()(int nt) const { return base + nt; } };
struct BInProjMap { const float* base; int n0; MDEV const float* operator()(int nt) const { const int n = n0 + nt; const int sc = n < 1280 ? n : (n < 3328 ? n + 24 : (n < 3352 ? 1280 + (n - 3328) : -1)); return sc < 0 ? nullptr : base + sc; } };
struct BInter { const float* s0; const float* s1; int n0; MDEV const float* operator()(int nt) const { const int n = n0 + nt, g = n >> 6, w = n & 63; return w < 32 ? s0 + g * 32 + w : s1 + g * 32 + w - 32; } };
struct BClamp64 { const float* base; MDEV const float* operator()(int nt) const { return base + (nt & 63); } };

struct EpiInProj {
    const Args* a; int m0, n0, li;
    MDEV void operator()(f32x4 (&acc)[4][4], int mw, int nw, int h, int c) const {
        unsigned char* ws = wsp(*a);
        const int nb = n0 + nw;
        const int tokb = m0 + mw + c;
        if (nb < 512 || (nb >= 768 && nb < 896) || (nb >= 1024 && nb < 1152)) {
            const float* gain; float mul = 1.f; bf16* dst; int kind;
            if (nb < 512) { gain = INP(*a, I_QG) + li * 64; mul = 0.125f * LOG2E; kind = 0; dst = (bf16*)(ws + WS_QN); }
            else if (nb < 896) { gain = INP(*a, I_KG) + (li * 3 + 1) * 64; kind = 1; dst = (bf16*)(ws + WS_KS); }
            else { gain = INP(*a, I_KG) + (li * 3 + 2) * 64; kind = 1; dst = (bf16*)(ws + WS_KW); }
            const int g = (nb >> 6) & 1;
#pragma unroll
            for (int mi = 0; mi < 4; ++mi) {
                float ss = 0.f;
#pragma unroll
                for (int ni = 0; ni < 4; ++ni) { f32x4 v = acc[ni][mi]; ss += v[0] * v[0] + v[1] * v[1] + v[2] * v[2] + v[3] * v[3]; }
                ss += shflx(ss, 16); ss += shflx(ss, 32);
                const float rs = frsq(ss * (1.0f / 64.0f) + EPS) * mul;
                const int tok = tokb + 16 * mi;
#pragma unroll
                for (int ni = 0; ni < 4; ++ni) {
                    const int d = 16 * ni + 4 * h; f32x4 v = acc[ni][mi], o;
#pragma unroll
                    for (int r = 0; r < 4; ++r) o[r] = v[r] * rs * gain[d + r];
                    if (kind == 0) st_bf4(dst + (size_t)tok * 512 + nb + d, o);
                    else { const int b = tok / SEQ, s = tok % SEQ; st_bf4(dst + ((size_t)(b * 2 + g) * SEQ + s) * 64 + d, o); }
                }
            }
        } else if (nb < 768) {
            bf16* dst = (bf16*)(ws + (nb < 640 ? WS_KCG : WS_VCG)); const int g = (nb >> 6) & 1;
#pragma unroll
            for (int mi = 0; mi < 4; ++mi) { const int tok = tokb + 16 * mi, b = tok / SEQ, s = tok % SEQ;
#pragma unroll
                for (int ni = 0; ni < 4; ++ni) st_bf4(dst + ((size_t)(b * 2 + g) * SEQ + s) * 64 + 16 * ni + 4 * h, acc[ni][mi]); }
        } else if (nb < 1280) {
            bf16* dst = (bf16*)(ws + (nb < 1024 ? WS_VST : WS_VWT)); const int g = (nb >> 6) & 1;
#pragma unroll
            for (int mi = 0; mi < 4; ++mi) { const int tok = tokb + 16 * mi, b = tok / SEQ, s = tok % SEQ;
                bf16* p = dst + ((size_t)(b * 2 + g) * NCH + (s >> 6)) * 4096 + (s & 63);
#pragma unroll
                for (int ni = 0; ni < 4; ++ni)
#pragma unroll
                    for (int r = 0; r < 4; ++r) p[(16 * ni + 4 * h + r) * 64] = (bf16)f2bf(acc[ni][mi][r]); }
        } else if (nb < 3328) {
            const int sec = (nb - 1280) >> 9, cc = (nb - 1280) & 511, hh = cc >> 7, d0 = cc & 127;
#pragma unroll
            for (int mi = 0; mi < 4; ++mi) { const int tok = tokb + 16 * mi, b = tok / SEQ, s = tok % SEQ;
                const size_t hrow = ((size_t)(b * 4 + hh) * SEQ + s) * 128 + d0;
#pragma unroll
                for (int ni = 0; ni < 4; ++ni) { const int d = 16 * ni + 4 * h; f32x4 v = acc[ni][mi], o;
                    if (sec == 0) { for (int r = 0; r < 4; ++r) o[r] = siluf(v[r]); st_bf4((bf16*)(ws + WS_HQ) + hrow + d, o); }
                    else if (sec == 1) { const float* lb = (const float*)(ws + WS_LB) + li * 512 + cc + d;
                        for (int r = 0; r < 4; ++r) o[r] = lb[r] + (1.0f - lb[r]) * sigm(v[r]);
                        *(f32x4*)((float*)(ws + WS_HF) + hrow + d) = o; }
                    else if (sec == 2) st_bf4((bf16*)(ws + WS_HV) + hrow + d, v);
                    else { for (int r = 0; r < 4; ++r) o[r] = siluf(v[r]); st_bf4((bf16*)(ws + WS_HGS) + (size_t)tok * 512 + cc + d, o); }
                } }
        } else if (nb == 3328) {
            float* dst = (float*)(ws + WS_GATE);
#pragma unroll
            for (int mi = 0; mi < 4; ++mi) { const int tok = tokb + 16 * mi;
#pragma unroll
                for (int ni = 0; ni < 2; ++ni)
#pragma unroll
                    for (int r = 0; r < 4; ++r) { const int n = 16 * ni + 4 * h + r; if (n < 24) dst[(size_t)tok * 24 + n] = sigm(acc[ni][mi][r]); } }
        }
    }
};

struct EpiResid {
    float* x; const float* gate; int m0, n0;
    MDEV void operator()(f32x4 (&acc)[4][4], int mw, int nw, int h, int c) const {
#pragma unroll
        for (int mi = 0; mi < 4; ++mi) { const int tok = m0 + mw + 16 * mi + c, b = tok / SEQ;
#pragma unroll
            for (int ni = 0; ni < 4; ++ni) { const int n = n0 + nw + 16 * ni + 4 * h;
                f32x4 g = *(const f32x4*)(gate + (size_t)b * 6 * DM + n); f32x4* p = (f32x4*)(x + (size_t)tok * DM + n); f32x4 v = *p;
#pragma unroll
                for (int r = 0; r < 4; ++r) v[r] += g[r] * acc[ni][mi][r];
                *p = v; } }
    }
};
template <int MODE> struct EpiGated {
    bf16* dst; size_t ld; int m0, n0, mvalid;
    MDEV void operator()(f32x4 (&acc)[4][4], int mw, int nw, int h, int c) const {
        const int cb = (n0 + nw) / 2;
#pragma unroll
        for (int mi = 0; mi < 4; ++mi) { const int m = mw + 16 * mi + c; if (m >= mvalid) continue;
#pragma unroll
            for (int ni = 0; ni < 2; ++ni) { f32x4 o;
#pragma unroll
                for (int r = 0; r < 4; ++r) { const float av = acc[ni][mi][r], bv = acc[ni + 2][mi][r]; o[r] = MODE == 0 ? av * sigm(bv) : siluf(av) * bv; }
                st_bf4(dst + (size_t)(m0 + m) * ld + cb + 16 * ni + 4 * h, o); } }
    }
};
struct EpiStoreBf {
    bf16* dst; size_t ld; int m0, n0, mvalid;
    MDEV void operator()(f32x4 (&acc)[4][4], int mw, int nw, int h, int c) const {
#pragma unroll
        for (int mi = 0; mi < 4; ++mi) { const int m = mw + 16 * mi + c; if (m >= mvalid) continue;
#pragma unroll
            for (int ni = 0; ni < 4; ++ni) st_bf4(dst + (size_t)(m0 + m) * ld + n0 + nw + 16 * ni + 4 * h, acc[ni][mi]); }
    }
};
struct EpiCmp {
    const Args* a; int kv, bg, m0, li;
    MDEV void operator()(f32x4 (&acc)[4][4], int mw, int nw, int h, int c) const {
        if (nw != 0) return;
        unsigned char* ws = wsp(*a);
        const float* bp8 = (const float*)(ws + WS_CB) + (li * 2 + kv) * 8 * 64;
        float bias[16];
#pragma unroll
        for (int q = 0; q < 16; ++q) { const int e = 16 * (q >> 2) + 4 * h + (q & 3); float v = 0.f;
#pragma unroll
            for (int kp = 0; kp < 8; ++kp) v += bp8[kp * 64 + e];
            bias[q] = v; }
        const float* gain = INP(*a, I_KG) + (li * 3 + 0) * 64;
#pragma unroll
        for (int mi = 0; mi < 4; ++mi) { const int n = m0 + mw + 16 * mi + c; const bool ok = n < NCMP;
            f32x4 v[4]; float ss = 0.f;
#pragma unroll
            for (int ni = 0; ni < 4; ++ni) { v[ni] = acc[ni][mi];
#pragma unroll
                for (int r = 0; r < 4; ++r) { v[ni][r] += bias[4 * ni + r]; ss += v[ni][r] * v[ni][r]; } }
            ss += shflx(ss, 16); ss += shflx(ss, 32);
            if (n >= NCP) continue;
            if (kv == 0) { const float rs = frsq(ss * (1.0f / 64.0f) + EPS); bf16* p = (bf16*)(ws + WS_KC) + ((size_t)bg * NCP + n) * 64;
#pragma unroll
                for (int ni = 0; ni < 4; ++ni) { f32x4 o;
#pragma unroll
                    for (int r = 0; r < 4; ++r) o[r] = ok ? v[ni][r] * rs * gain[16 * ni + 4 * h + r] : 0.f;
                    st_bf4(p + 16 * ni + 4 * h, o); }
            } else { bf16* p = (bf16*)(ws + WS_VCT) + ((size_t)bg * NCP + n) * 64;
#pragma unroll
                for (int ni = 0; ni < 4; ++ni) { f32x4 o;
#pragma unroll
                    for (int r = 0; r < 4; ++r) o[r] = ok ? v[ni][r] : 0.f;
                    st_bf4(p + 16 * ni + 4 * h, o); } }
        }
    }
};


struct EpiResid8 {
    static constexpr bool PERM = true, AFTER_DRAIN = false;
    float* x; const float* gate; const float* xin;
    MDEV void operator()(const f32x4 (&acc)[2][2][4][2], const pg8::Unit& u, int wr, int wc, int fr, int fq) const {
        OPAQUE2(fr, fq);
#pragma unroll
        for (int ai = 0; ai < 2; ++ai)
#pragma unroll
            for (int m = 0; m < 4; ++m) { const int row = 256 * u.pm + 128 * ai + 64 * wr + 16 * m + fr, b = row / SEQ;
#pragma unroll
                for (int bj = 0; bj < 2; ++bj)
#pragma unroll
                    for (int n = 0; n < 2; ++n) { const int col = 256 * u.pn + 128 * bj + 32 * wc + 8 * fq + 4 * n;
                        const f32x4 g = *(const f32x4*)(gate + (size_t)b * 6 * DM + col); f32x4* p = (f32x4*)(x + (size_t)row * DM + col); f32x4 v = *(const f32x4*)(xin + (size_t)row * DM + col);
#pragma unroll
                        for (int r = 0; r < 4; ++r) v[r] += g[r] * acc[ai][bj][m][n][r];
                        *p = v; } }
    }
};
struct EpiGlu8 {
    static constexpr bool PERM = true, AFTER_DRAIN = false;
    bf16* dst;
    MDEV void operator()(const f32x4 (&acc)[2][2][4][2], const pg8::Unit& u, int wr, int wc, int fr, int fq) const {
        OPAQUE2(fr, fq);
#pragma unroll
        for (int ai = 0; ai < 2; ++ai)
#pragma unroll
            for (int m = 0; m < 4; ++m) { const int row = 256 * u.pm + 128 * ai + 64 * wr + 16 * m + fr;
                { const int col = 128 * u.pn + 32 * wc + 8 * fq; f32x4 o0, o1;
#pragma unroll
                    for (int r = 0; r < 4; ++r) { o0[r] = acc[ai][0][m][0][r] * sigm(acc[ai][1][m][0][r]); o1[r] = acc[ai][0][m][1][r] * sigm(acc[ai][1][m][1][r]); }
                    st_bf8(dst + (size_t)row * DM + col, o0, o1); } }
    }
};
struct EpiMoe1_8 {
    static constexpr bool PERM = true, AFTER_DRAIN = false;
    bf16* dst;
    MDEV void operator()(const f32x4 (&acc)[2][2][4][2], const pg8::Unit& u, int wr, int wc, int fr, int fq) const {
        OPAQUE2(fr, fq);
#pragma unroll
        for (int ai = 0; ai < 2; ++ai)
#pragma unroll
            for (int m = 0; m < 4; ++m) { const int row = 256 * u.pm + 128 * ai + 64 * wr + 16 * m + fr;
                const int col = 128 * u.pn + 32 * wc + 8 * fq; f32x4 o0, o1;
#pragma unroll
                for (int r = 0; r < 4; ++r) { o0[r] = siluf(acc[ai][0][m][0][r]) * acc[ai][1][m][0][r]; o1[r] = siluf(acc[ai][0][m][1][r]) * acc[ai][1][m][1][r]; }
#ifdef EMU
                st_bf8(dst + (size_t)row * FF + col, o0, o1); }
#else
                u32x4 pk; pk[0] = pk2(o0[0], o0[1]); pk[1] = pk2(o0[2], o0[3]); pk[2] = pk2(o1[0], o1[1]); pk[3] = pk2(o1[2], o1[3]);
                asm volatile("global_store_dwordx4 %0, %1, off sc1\n\ts_nop 2" :: "v"((__attribute__((address_space(1))) bf16*)(dst + (size_t)row * FF + col)), "v"(pk) : "memory"); }
#endif
    }
};
struct EpiMoe2_8 {
    static constexpr bool PERM = true, AFTER_DRAIN = false;
    bf16* dst;
    MDEV void operator()(const f32x4 (&acc)[2][2][4][2], const pg8::Unit& u, int wr, int wc, int fr, int fq) const {
        OPAQUE2(fr, fq);
#pragma unroll
        for (int ai = 0; ai < 2; ++ai)
#pragma unroll
            for (int m = 0; m < 4; ++m) { const int row = 256 * u.pm + 128 * ai + 64 * wr + 16 * m + fr;
#pragma unroll
                for (int bj = 0; bj < 2; ++bj) { const int col = 256 * u.pn + 128 * bj + 32 * wc + 8 * fq;
                    st_bf8(dst + (size_t)row * DM + col, acc[ai][bj][m][0], acc[ai][bj][m][1]); } }
    }
};
DEV unsigned uni(unsigned x);
template <bool G> struct MoeSel {
    static constexpr bool GATHER = G;
    const int* rb; const int* cnt; const int* list; size_t bstride;
    struct Ctx { int e, rbase, c; };
    MDEV Ctx ctx(const pg8::Unit& u) const { int e = 0;
#pragma unroll 1
        for (int q = 1; q < 32; ++q) if ((rb[q] >> 8) <= u.pm) e = q;
        e = (int)uni((unsigned)e); Ctx x; x.e = e; x.rbase = (int)uni((unsigned)((u.pm << 8) - rb[e])); x.c = G ? (int)uni((unsigned)cnt[e * 64]) : 0; return x; }
    MDEV size_t boff(const Ctx& x) const { return (size_t)x.e * bstride; }
    MDEV unsigned aoff(const Ctx& x, int r) const { int p = x.rbase + r; if (p > x.c - 1) p = x.c - 1; return (unsigned)list[(size_t)x.e * T + p] * (unsigned)(DM * 2); }
};
struct EpiInProj8 {
    static constexpr bool PERM = true, AFTER_DRAIN = false;
    const Args* a; int li;
    MDEV void operator()(const f32x4 (&acc)[2][2][4][2], const pg8::Unit& u, int wr, int wc, int fr, int fq) const {
        OPAQUE2(fr, fq);
        unsigned char* ws = wsp(*a);
        const int nb = 256 * u.pn + 64 * wc;
        if (nb >= 3392) return;
        if (nb < 512 || (nb >= 768 && nb < 896) || (nb >= 1024 && nb < 1152)) {
            const float* gain; float mul = 1.f; int kind;
            if (nb < 512) { gain = INP(*a, I_QG) + li * 64; mul = 0.125f * LOG2E; kind = 0; }
            else if (nb < 896) { gain = INP(*a, I_KG) + (li * 3 + 1) * 64; kind = 1; }
            else { gain = INP(*a, I_KG) + (li * 3 + 2) * 64; kind = 2; }
            const int g = (nb >> 6) & 1;
            f32x4 gv[2][2];
#pragma unroll
            for (int bj = 0; bj < 2; ++bj)
#pragma unroll
                for (int n = 0; n < 2; ++n) gv[bj][n] = *(const f32x4*)(gain + 32 * bj + 8 * fq + 4 * n);
#pragma unroll
            for (int ai = 0; ai < 2; ++ai)
#pragma unroll
                for (int m = 0; m < 4; ++m) { const int tok = 256 * u.pm + 128 * ai + 64 * wr + 16 * m + fr;
                    float ss = 0.f;
#pragma unroll
                    for (int bj = 0; bj < 2; ++bj)
#pragma unroll
                        for (int n = 0; n < 2; ++n) { const f32x4 v = acc[ai][bj][m][n]; ss += v[0] * v[0] + v[1] * v[1] + v[2] * v[2] + v[3] * v[3]; }
                    ss += shflx(ss, 16); ss += shflx(ss, 32);
                    const float rs = frsq(ss * (1.0f / 64.0f) + EPS) * mul;
                    bf16* dst; if (kind == 0) dst = (bf16*)(ws + WS_QN) + (size_t)tok * 512 + nb; else { const int b = tok / SEQ, sq = tok % SEQ; dst = (bf16*)(ws + (kind == 1 ? WS_KS : WS_KW)) + ((size_t)(b * 2 + g) * SEQ + sq) * 64; }
#pragma unroll
                    for (int bj = 0; bj < 2; ++bj) { f32x4 o0, o1;
#pragma unroll
                        for (int r = 0; r < 4; ++r) { o0[r] = acc[ai][bj][m][0][r] * rs * gv[bj][0][r]; o1[r] = acc[ai][bj][m][1][r] * rs * gv[bj][1][r]; }
                        st_bf8(dst + 32 * bj + 8 * fq, o0, o1); } }
        } else if (nb < 768) {
            bf16* base = (bf16*)(ws + (nb < 640 ? WS_KCG : WS_VCG)); const int g = (nb >> 6) & 1;
#pragma unroll
            for (int ai = 0; ai < 2; ++ai)
#pragma unroll
                for (int m = 0; m < 4; ++m) { const int tok = 256 * u.pm + 128 * ai + 64 * wr + 16 * m + fr, b = tok / SEQ, sq = tok % SEQ;
#pragma unroll
                    for (int bj = 0; bj < 2; ++bj) st_bf8(base + ((size_t)(b * 2 + g) * SEQ + sq) * 64 + 32 * bj + 8 * fq, acc[ai][bj][m][0], acc[ai][bj][m][1]); }
        } else if (nb < 1280) {
            bf16* base = (bf16*)(ws + (nb < 1024 ? WS_VST : WS_VWT)); const int g = (nb >> 6) & 1;
#pragma unroll
            for (int ai = 0; ai < 2; ++ai)
#pragma unroll
                for (int m = 0; m < 4; ++m) { const int tok = 256 * u.pm + 128 * ai + 64 * wr + 16 * m + fr, b = tok / SEQ, sq = tok % SEQ;
#pragma unroll
                    for (int bj = 0; bj < 2; ++bj) st_bf8(base + ((size_t)(b * 2 + g) * SEQ + sq) * 64 + 32 * bj + 8 * fq, acc[ai][bj][m][0], acc[ai][bj][m][1]); }
        } else if (nb < 3328) {
            const int sec = (nb - 1280) >> 9, cc = (nb - 1280) & 511, hh = cc >> 7, d0 = cc & 127;
            f32x4 lbv[2][2];
            if (sec == 1) {
#pragma unroll
                for (int bj = 0; bj < 2; ++bj)
#pragma unroll
                    for (int n = 0; n < 2; ++n) lbv[bj][n] = *(const f32x4*)((const float*)(ws + WS_LB) + li * 512 + cc + 32 * bj + 8 * fq + 4 * n); }
#pragma unroll
            for (int ai = 0; ai < 2; ++ai)
#pragma unroll
                for (int m = 0; m < 4; ++m) { const int tok = 256 * u.pm + 128 * ai + 64 * wr + 16 * m + fr, b = tok / SEQ, sq = tok % SEQ;
                    const size_t hrow = ((size_t)(b * 4 + hh) * SEQ + sq) * 128 + d0;
#pragma unroll
                    for (int bj = 0; bj < 2; ++bj) { const int d = 32 * bj + 8 * fq; f32x4 o0, o1;
                        if (sec == 0) {
#pragma unroll
                            for (int r = 0; r < 4; ++r) { o0[r] = siluf(acc[ai][bj][m][0][r]); o1[r] = siluf(acc[ai][bj][m][1][r]); }
                            st_bf8((bf16*)(ws + WS_HQ) + hrow + d, o0, o1); }
                        else if (sec == 1) {
#pragma unroll
                            for (int r = 0; r < 4; ++r) { o0[r] = lbv[bj][0][r] + (1.0f - lbv[bj][0][r]) * sigm(acc[ai][bj][m][0][r]); o1[r] = lbv[bj][1][r] + (1.0f - lbv[bj][1][r]) * sigm(acc[ai][bj][m][1][r]); }
                            float* pf = (float*)(ws + WS_HF) + hrow + d; *(f32x4*)pf = o0; *(f32x4*)(pf + 4) = o1; }
                        else if (sec == 2) st_bf8((bf16*)(ws + WS_HV) + hrow + d, acc[ai][bj][m][0], acc[ai][bj][m][1]);
                        else {
#pragma unroll
                            for (int r = 0; r < 4; ++r) { o0[r] = siluf(acc[ai][bj][m][0][r]); o1[r] = siluf(acc[ai][bj][m][1][r]); }
                            st_bf8((bf16*)(ws + WS_HGS) + (size_t)tok * 512 + cc + d, o0, o1); } } }
        } else {
            float* dst = (float*)(ws + WS_GATE);
            if (fq < 3) {
#pragma unroll
                for (int ai = 0; ai < 2; ++ai)
#pragma unroll
                    for (int m = 0; m < 4; ++m) { const int tok = 256 * u.pm + 128 * ai + 64 * wr + 16 * m + fr; f32x4 o0, o1;
#pragma unroll
                        for (int r = 0; r < 4; ++r) { o0[r] = sigm(acc[ai][0][m][0][r]); o1[r] = sigm(acc[ai][0][m][1][r]); }
                        float* pf = dst + (size_t)tok * 24 + 8 * fq; *(f32x4*)pf = o0; *(f32x4*)(pf + 4) = o1; } }
        }
    }
};

DEV void tr_tile(unsigned char* smem, const float* src0, const float* src1, int ld, int K, int mode, bf16* dst, int n0, int k0) {
    bf16* tl = (bf16*)smem;
    const int tid = TID;
    SYNC();
#pragma unroll
    for (int i = 0; i < 8; ++i) {
        const int e = tid + 512 * i, kk = e >> 6, nn = e & 63, n = n0 + nn; float v = 0.f;
        if (mode == 0) v = src0[(size_t)(k0 + kk) * ld + n];
        else if (mode == 1) { int sc = n < 1280 ? n : (n < 3328 ? n + 24 : (n < 3352 ? 1280 + (n - 3328) : -1)); if (sc >= 0) v = src0[(size_t)(k0 + kk) * ld + sc]; }
        else { const int g = n >> 6, w = n & 63; v = (w < 32) ? src0[(size_t)(k0 + kk) * ld + g * 32 + w] : src1[(size_t)(k0 + kk) * ld + g * 32 + w - 32]; }
        tl[nn * LDT + kk] = (bf16)f2bf(v);
    }
    SYNC();
    const int nn = tid >> 3, k8 = (tid & 7) * 8;
    *(bf16x8*)(dst + (size_t)(n0 + nn) * K + k0 + k8) = *(const bf16x8*)(tl + nn * LDT + k8);
}

DEV int tr_col(int mode, int n) {
    if (mode == 0) return n;
    const int pn = n >> 8, ct = n & 255;
    if (mode == 5) { const int bj = ct >> 7, wc = (ct >> 5) & 3, j = ct & 31, L = 256 * pn + 64 * wc + 32 * bj + j; return L < 1280 ? L : (L < 3328 ? L + 24 : (L < 3352 ? 1280 + (L - 3328) : -1)); }
    { const int bj = ct >> 7, Lc = 128 * pn + (ct & 127); return bj == 0 ? Lc : (mode == 7 ? FF : DM) + Lc; }
}
DEV void tr_tile(unsigned char* smem, const float* src, int ld, int K, int mode, bf16* dst, int n0, int k0) {
    bf16* tl = (bf16*)smem;
    const int tid = TID, nq = tid & 31, kq = tid >> 5;
    const int sc = tr_col(mode, n0 + 4 * nq);
    f32x4 v[4];
#pragma unroll
    for (int i = 0; i < 4; ++i) v[i] = sc >= 0 ? *(const f32x4*)(src + (size_t)(k0 + 4 * kq + i) * ld + sc) : f4zero();
    SYNC();
#pragma unroll
    for (int j = 0; j < 4; ++j) { u32x2 w; w[0] = pk2(v[0][j], v[1][j]); w[1] = pk2(v[2][j], v[3][j]); *(u32x2*)(tl + (4 * nq + j) * LDT + 4 * kq) = w; }
    SYNC();
#pragma unroll
    for (int t = 0; t < 2; ++t) { const int id = tid + 512 * t, row = id >> 3, ch = id & 7;
        *(bf16x8*)(dst + (size_t)(n0 + row) * K + k0 + 8 * ch) = *(const bf16x8*)(tl + row * LDT + 8 * ch); }
}
constexpr int KSUP = FF >= 256 ? 256 : FF, NSUP = KSUP / 64;
DEV void tr_super(unsigned char* smem, const float* src0, const float* src1, int ld, int K, int mode, bf16* dst, int n0, int k0) {
    const int tid = TID, nq = tid & 31, kq = tid >> 5;
    int sc = n0 + 4 * nq; const float* src = src0;
    if (mode == 7) { const int cc = tr_col(7, sc); src = cc >= FF ? src1 : src0; sc = cc >= FF ? cc - FF : cc; }
    f32x4 v[NSUP][4];
#pragma unroll
    for (int sb = 0; sb < NSUP; ++sb)
#pragma unroll
        for (int i = 0; i < 4; ++i) v[sb][i] = *(const f32x4*)(src + (size_t)(k0 + 64 * sb + 4 * kq + i) * ld + sc);
    SYNC();
    const int fw = nq & (KSUP / 16 - 1);
#pragma unroll
    for (int j = 0; j < 4; ++j)
#pragma unroll
        for (int sb = 0; sb < NSUP; ++sb) { const int c16 = 8 * sb + (kq >> 1); u32x2 w; w[0] = pk2(v[sb][0][j], v[sb][1][j]); w[1] = pk2(v[sb][2][j], v[sb][3][j]);
            *(u32x2*)(smem + (4 * nq + j) * (KSUP * 2) + ((c16 ^ fw) << 4) + (kq & 1) * 8) = w; }
    SYNC();
#pragma unroll
    for (int t = 0; t < 128 * (KSUP / 8) / NT; ++t) { const int id = tid + NT * t, row = id / (KSUP / 8), ch = id % (KSUP / 8), f = (row >> 2) & (KSUP / 16 - 1);
        *(bf16x8*)(dst + (size_t)(n0 + row) * K + k0 + 8 * (ch ^ f)) = *(const bf16x8*)(smem + row * (KSUP * 2) + ch * 16); }
}
struct TrJob { const float* s; int ld, K, N, mode; bf16* dst; };
DEV void p0_phase(const Args& a, unsigned char* smem) {
    unsigned char* ws = wsp(a); const int tid = TID;
    { int item = BID, base = 0;
      for (int j = 0; j < 8; ++j) { TrJob J; const int i = j & 1;
        if (j < 2) J = {INP(a, I_WIN) + (size_t)i * DM * NIN, NIN, DM, NIN8, 5, (bf16*)(ws + WS_WIN) + (size_t)i * NIN8 * DM};
        else if (j < 4) J = {INP(a, I_WOUT) + (size_t)i * 1024 * DM, DM, 1024, DM, 0, (bf16*)(ws + WS_WOUT) + (size_t)i * DM * 1024};
        else if (j < 6) J = {INP(a, I_PW1) + (size_t)i * DM * 2 * DM, 2 * DM, DM, 2 * DM, 6, (bf16*)(ws + WS_PW1) + (size_t)i * 2 * DM * DM};
        else J = {INP(a, I_PW2) + (size_t)i * DM * DM, DM, DM, DM, 0, (bf16*)(ws + WS_PW2) + (size_t)i * DM * DM};
        const int tn = J.N / 128, tk = J.K / 64, nt = tn * tk;
        while (item < base + nt) { const int it = item - base; tr_tile(smem, J.s, J.ld, J.K, J.mode, J.dst, (it % tn) * 128, (it / tn) * 64); item += NBLK; }
        base += nt; }
      SYNC(); }
    {
        float* red = (float*)smem;
        constexpr int NG = 6 * DM / 128; const int ntask = DEPTH * NG;
        for (int t = BID; t < ntask; t += NBLK) {
            const int l = t / NG, j0 = (t % NG) * 128, cq = tid & 31, kr = tid >> 5;
            const float* w = INP(a, I_ADAW) + (size_t)l * DM * 6 * DM + j0 + 4 * cq; const float* cc = INP(a, I_C);
            f32x4 a0 = f4zero(), a1 = f4zero();
#pragma unroll 8
            for (int i = 0; i < DM / 16; ++i) { const int k = kr + 16 * i; const f32x4 wv = *(const f32x4*)(w + (size_t)k * 6 * DM); const float s0 = siluf(cc[k]), s1 = siluf(cc[DM + k]);
#pragma unroll
                for (int r = 0; r < 4; ++r) { a0[r] += s0 * wv[r]; a1[r] += s1 * wv[r]; } }
            SYNC();
            *(f32x4*)(red + (kr * 2 + 0) * 128 + 4 * cq) = a0; *(f32x4*)(red + (kr * 2 + 1) * 128 + 4 * cq) = a1;
            SYNC();
            if (tid < 256) { const int b = tid >> 7, col = tid & 127; float sum = INP(a, I_ADAB)[(size_t)l * 6 * DM + j0 + col];
#pragma unroll
                for (int q = 0; q < 16; ++q) sum += red[(q * 2 + b) * 128 + col];
                ((float*)(ws + WS_MOD))[((size_t)l * 2 + b) * 6 * DM + j0 + col] = sum; }
        }
    }
    for (int t = BID; t < 32; t += NBLK) {
        float* red = (float*)smem; const int ikv = t >> 3, kp = t & 7, i = ikv >> 1, kv = ikv & 1, e = tid & 63, ks = tid >> 6;
        const float* W = INP(a, kv ? I_CWV : I_CWK) + (size_t)i * 2048 * 64 + e; const float* pe = INP(a, I_CPE) + (size_t)i * 2048;
        float sum = 0.f;
#pragma unroll 8
        for (int q = 0; q < 32; ++q) { const int k = kp * 256 + ks * 32 + q; sum += pe[k] * W[(size_t)k * 64]; }
        SYNC(); red[ks * 64 + e] = sum; SYNC();
        if (tid < 64) { float v = 0.f; for (int q = 0; q < 8; ++q) v += red[q * 64 + tid]; ((float*)(ws + WS_CB))[(ikv * 8 + kp) * 64 + tid] = v; }
    }
    for (int i = BID * NT + tid; i < DEPTH * 48 * DM; i += NBLK * NT) { const int k = i % DM, n = (i / DM) % 48, ll = i / (48 * DM);
        const float wv = n < 4 ? INP(a, I_WG)[((size_t)ll * DM + k) * 4 + n] : (n < 36 ? INP(a, I_WE)[((size_t)ll * DM + k) * 32 + n - 4] : 0.f);
        const unsigned hi = f2bf(wv); ((bf16*)(ws + WS_WTH))[i] = (bf16)hi; ((bf16*)(ws + WS_WTL))[i] = (bf16)f2bf(wv - bf2f(hi)); }
    if (BID == 0) {
        for (int i = tid; i < DEPTH * 32; i += NT) ((int*)(ws + WS_CNT))[i * 64] = 0;
        for (int i = tid; i < DEPTH * 256; i += NT) ((unsigned*)(ws + WS_FLG))[i * 16] = 0u;
        for (int n = tid; n < 512; n += NT) { const float l0 = INP(a, I_LBL)[n], l1 = INP(a, I_LBL)[512 + n]; const float m = fmaxf(l0, l1);
            const float e0 = fexp2((l0 - m) * LOG2E), e1 = fexp2((l1 - m) * LOG2E);
            ((float*)(ws + WS_LB))[n] = 0.f; ((float*)(ws + WS_LB))[512 + n] = e1 / (e0 + e1); }
        if (tid < 2) { const int i = tid; float mq = 0.f; for (int d = 0; d < 64; ++d) mq = fmaxf(mq, fabsf(INP(a, I_QG)[i * 64 + d]));
            for (int br = 0; br < 3; ++br) { float mk = 0.f; for (int d = 0; d < 64; ++d) mk = fmaxf(mk, fabsf(INP(a, I_KG)[(i * 3 + br) * 64 + d]));
                ((float*)(ws + WS_CS))[i * 4 + br] = 8.0f * mq * mk * LOG2E; } }
    }
    SYNC();
    { constexpr int S13 = (2 * FF / 128) * (DM / KSUP), S2 = (DM / 128) * (FF / KSUP), SPE = S13 + S2, NIT = DEPTH * 32 * SPE;
#ifdef EMU
      for (int it = BID; it < NIT; it += NBLK) {
#else
      int* ctr = (int*)(ws + WS_BAR) + P0_CTR_IDX; int* nxl = (int*)(smem + 72 * 1024);
      int my_next = 0; if (tid == 0) my_next = atomic_add_i(ctr, 1);
      for (;;) { if (tid == 0) nxl[0] = my_next; SYNC(); const int it = nxl[0]; if (it >= NIT) break; if (tid == 0) my_next = atomic_add_i(ctr, 1);
#endif
        const int le = it / SPE, r = it % SPE;
        if (r < S13) { const int tn = r % (2 * FF / 128), tk = r / (2 * FF / 128);
            tr_super(smem, INP(a, I_W1) + (size_t)le * DM * FF, INP(a, I_W3) + (size_t)le * DM * FF, FF, DM, 7, (bf16*)(ws + WS_W13) + (size_t)le * 2 * FF * DM, tn * 128, tk * KSUP); }
        else { const int r2 = r - S13, tn = r2 % (DM / 128), tk = r2 / (DM / 128);
            tr_super(smem, INP(a, I_W2) + (size_t)le * FF * DM, INP(a, I_W2), DM, FF, 0, (bf16*)(ws + WS_W2) + (size_t)le * DM * FF, tn * 128, tk * KSUP); } }
      SYNC(); }
}

constexpr int NJV = DM / 256;
DEV void moe_bases(const int* cnt, int* rb  ) {
    if (TID == 0) { int acc = 0; for (int e = 0; e < 32; ++e) { rb[e] = acc; acc += ((cnt[e * 64] + 255) >> 8) << 8; } rb[32] = acc; }
    SYNC();
}
DEV void norm_phase(const Args& a, unsigned char* smem, int l) {
    unsigned char* ws = wsp(a); const int tid = TID, w = tid >> 6, lane = tid & 63;
    int* rb = (int*)smem;
    if (l > 0) moe_bases((const int*)(ws + WS_CNT) + (l - 1) * 32 * 64, rb);
    const float* mod = (const float*)(ws + WS_MOD);
    const bf16* yk = (const bf16*)(ws + WS_YK);
    if (l < DEPTH) {
        const int bid = BID % 76 == BID ? BID : -1;
        for (int job = BID; job < 76; job += NBLK) {
            if (job < 72) { const int b = job / 36, n = job % 36; float sum = 0.f;
                for (int k = tid; k < DM; k += NT) { const float wv = n < 4 ? INP(a, I_WG)[((size_t)l * DM + k) * 4 + n] : INP(a, I_WE)[((size_t)l * DM + k) * 32 + n - 4]; sum += mod[((size_t)l * 2 + b) * 6 * DM + 3 * DM + k] * wv; }
#pragma unroll
                for (int q = 1; q < 64; q <<= 1) sum += shflx(sum, q);
                float* red = (float*)(smem + 1024);
                SYNC(); if (lane == 0) red[w] = sum; SYNC();
                if (tid == 0) { float t = 0.f; for (int q = 0; q < 8; ++q) t += red[q]; ((float*)(ws + WS_RBIAS))[((size_t)l * 2 + b) * 48 + n] = t; }
            } else { const float* nf = INP(a, I_NFFN) + (size_t)l * DM; const int part = job - 72;
                for (int i = part * (2 * DM / 4) + tid; i < (part + 1) * (2 * DM / 4); i += NT) { const int b = i / DM, k = i % DM; ((float*)(ws + WS_AVEC))[((size_t)l * 2 + b) * DM + k] = nf[k] * (1.0f + mod[((size_t)l * 2 + b) * 6 * DM + 4 * DM + k]); } }
        }
        (void)bid;
    }
    const int rstride = NBLK * 8;
    for (int rowa = BID * 8 + w; rowa < T; rowa += 2 * rstride) {
        int row[2]; bool ok[2];
        row[0] = rowa; ok[0] = true; row[1] = rowa + rstride; ok[1] = row[1] < T; if (!ok[1]) row[1] = rowa;
        f32x4 v[2][NJV]; int e0[2], p0[2], e1[2], p1[2]; float w0[2], w1[2];
        const float* xin = (l == 0) ? INP(a, I_X) : outp(a);
#pragma unroll
        for (int q = 0; q < 2; ++q) {
#pragma unroll
            for (int j = 0; j < NJV; ++j) v[q][j] = *(const f32x4*)(xin + (size_t)row[q] * DM + 4 * lane + 256 * j);
            if (l > 0) { const int* tie = (const int*)(ws + WS_TIE) + (size_t)row[q] * 2; const float* tiw = (const float*)(ws + WS_TIW) + (size_t)row[q] * 2;
                e0[q] = tie[0] >> 14; p0[q] = tie[0] & 16383; e1[q] = tie[1] >> 14; p1[q] = tie[1] & 16383; w0[q] = tiw[0]; w1[q] = tiw[1]; } }
        if (l > 0) {
            u32x2 q0[2][NJV], q1[2][NJV];
#pragma unroll
            for (int q = 0; q < 2; ++q) { const bf16* y0 = yk + (size_t)(rb[e0[q]] + p0[q]) * DM; const bf16* y1 = yk + (size_t)(rb[e1[q]] + p1[q]) * DM;
#pragma unroll
                for (int j = 0; j < NJV; ++j) { const int cidx = 4 * lane + 256 * j; q0[q][j] = *(const u32x2*)(y0 + cidx); q1[q][j] = *(const u32x2*)(y1 + cidx); } }
#pragma unroll
            for (int q = 0; q < 2; ++q) { const int b = row[q] / SEQ; const float* gf = mod + ((size_t)(l - 1) * 2 + b) * 6 * DM + 5 * DM;
#pragma unroll
                for (int j = 0; j < NJV; ++j) { const int cidx = 4 * lane + 256 * j; const f32x4 g = *(const f32x4*)(gf + cidx);
                    v[q][j][0] += g[0] * (w0[q] * bf2f(q0[q][j][0] & 0xffff) + w1[q] * bf2f(q1[q][j][0] & 0xffff));
                    v[q][j][1] += g[1] * (w0[q] * bf2f(q0[q][j][0] >> 16) + w1[q] * bf2f(q1[q][j][0] >> 16));
                    v[q][j][2] += g[2] * (w0[q] * bf2f(q0[q][j][1] & 0xffff) + w1[q] * bf2f(q1[q][j][1] & 0xffff));
                    v[q][j][3] += g[3] * (w0[q] * bf2f(q0[q][j][1] >> 16) + w1[q] * bf2f(q1[q][j][1] >> 16)); } }
        }
        if (l > 0)
#pragma unroll
        for (int q = 0; q < 2; ++q) { if (!ok[q]) continue;
#pragma unroll
            for (int j = 0; j < NJV; ++j) *(f32x4*)(outp(a) + (size_t)row[q] * DM + 4 * lane + 256 * j) = v[q][j]; }
        if (l == DEPTH) continue;
        float ss[2];
#pragma unroll
        for (int q = 0; q < 2; ++q) { ss[q] = 0.f;
#pragma unroll
            for (int j = 0; j < NJV; ++j) ss[q] += v[q][j][0] * v[q][j][0] + v[q][j][1] * v[q][j][1] + v[q][j][2] * v[q][j][2] + v[q][j][3] * v[q][j][3]; }
#pragma unroll
        for (int o = 1; o < 64; o <<= 1) { ss[0] += shflx(ss[0], o); ss[1] += shflx(ss[1], o); }
        const float* nm = INP(a, I_NMIX) + (size_t)l * DM;
#pragma unroll
        for (int q = 0; q < 2; ++q) { if (!ok[q]) continue;
            const int b = row[q] / SEQ; const float rs = frsq(ss[q] * (1.0f / DM) + EPS);
            const float* mm = mod + ((size_t)l * 2 + b) * 6 * DM; bf16* hb = (bf16*)(ws + WS_H) + (size_t)row[q] * DM;
#pragma unroll
            for (int j = 0; j < NJV; ++j) { const int cidx = 4 * lane + 256 * j; f32x4 g = *(const f32x4*)(nm + cidx), sh = *(const f32x4*)(mm + cidx), sc = *(const f32x4*)(mm + DM + cidx), o;
#pragma unroll
                for (int r = 0; r < 4; ++r) o[r] = v[q][j][r] * rs * g[r] * (1.0f + sc[r]) + sh[r];
                st_bf4(hb + cidx, o); } }
    }
}

DEV void route_phase(const Args& a, unsigned char* smem, int l) {
    unsigned char* ws = wsp(a); const int tid = TID, w = tid >> 6, lane = tid & 63, h = lane >> 4, c = lane & 15, pi = w >> 1, kh = w & 1;
    constexpr int NCHK = 4, CH = DM / NCHK, WLD = CH + 8, NKS = CH / 2 / 32;
    constexpr int WTOT = 48 * (CH / 8), WMAX = (WTOT + NT - 1) / NT;
    bf16* WHl = (bf16*)smem; bf16* WLl = WHl + 48 * WLD;
    float* lg = (float*)(WLl + 48 * WLD);
    float* ssb = lg + 4 * 2 * 16 * 48;
    float* rsb = ssb + 4 * 2 * 16;
    int* lcnt = (int*)(rsb + 64); int* lbase = lcnt + 32; int* tinfo = lbase + 32;
    float* avl = (float*)(tinfo + 256); float* cvl = avl + 2 * DM;
    const float* mod = (const float*)(ws + WS_MOD);
    SYNC();
    if (tid < 32) lcnt[tid] = 0;
    for (int i = tid; i < 2 * DM; i += NT) { const int b = i / DM, k = i % DM; avl[i] = ((const float*)(ws + WS_AVEC))[((size_t)l * 2 + b) * DM + k]; cvl[i] = mod[((size_t)l * 2 + b) * 6 * DM + 3 * DM + k]; }
    const bf16* WH = (const bf16*)(ws + WS_WTH) + (size_t)l * 48 * DM; const bf16* WL = (const bf16*)(ws + WS_WTL) + (size_t)l * 48 * DM;
    int* cnt = (int*)(ws + WS_CNT) + l * 32 * 64;
    for (int pass0 = BID; pass0 < T / 16; pass0 += 4 * NBLK) {
        const int pass = pass0 + pi * NBLK; const bool valid = pass < T / 16;
        const int tok = valid ? pass * 16 + c : 0, b = tok / SEQ;
        const float* xrow = outp(a) + (size_t)tok * DM;
        f32x4 xv[2][NKS][2]; bf16x8 wh[WMAX], wl[WMAX];
#pragma unroll
        for (int ks = 0; ks < NKS; ++ks) { const float* xq = xrow + kh * (CH / 2) + 8 * h + 32 * ks; xv[0][ks][0] = *(const f32x4*)xq; xv[0][ks][1] = *(const f32x4*)(xq + 4); }
#pragma unroll
        for (int t = 0; t < WMAX; ++t) { const int i = tid + NT * t; if (i < WTOT) { const int n = i / (CH / 8), k8 = (i % (CH / 8)) * 8; wh[t] = *(const bf16x8*)(WH + (size_t)n * DM + k8); wl[t] = *(const bf16x8*)(WL + (size_t)n * DM + k8); } }
        f32x4 acc[3] = {f4zero(), f4zero(), f4zero()}; float ss = 0.f;
        bf16x8 uhk[NCHK * NKS];
#pragma unroll
        for (int chn = 0; chn < NCHK; ++chn) {
            SYNC();
#pragma unroll
            for (int t = 0; t < WMAX; ++t) { const int i = tid + NT * t; if (i < WTOT) { const int n = i / (CH / 8), k8 = (i % (CH / 8)) * 8; *(bf16x8*)(WHl + n * WLD + k8) = wh[t]; *(bf16x8*)(WLl + n * WLD + k8) = wl[t]; } }
            SYNC();
            if (chn + 1 < NCHK) {
#pragma unroll
                for (int ks = 0; ks < NKS; ++ks) { const float* xq = xrow + (chn + 1) * CH + kh * (CH / 2) + 8 * h + 32 * ks; xv[(chn + 1) & 1][ks][0] = *(const f32x4*)xq; xv[(chn + 1) & 1][ks][1] = *(const f32x4*)(xq + 4); }
#pragma unroll
                for (int t = 0; t < WMAX; ++t) { const int i = tid + NT * t; if (i < WTOT) { const int n = i / (CH / 8), k8 = (i % (CH / 8)) * 8; wh[t] = *(const bf16x8*)(WH + (size_t)n * DM + (chn + 1) * CH + k8); wl[t] = *(const bf16x8*)(WL + (size_t)n * DM + (chn + 1) * CH + k8); } }
            }
            if (valid) {
                const bf16* whp = WHl + c * WLD + kh * (CH / 2) + 8 * h; const bf16* wlp = WLl + c * WLD + kh * (CH / 2) + 8 * h;
                const float* ap = avl + b * DM + chn * CH + kh * (CH / 2) + 8 * h;
#pragma unroll
                for (int ks = 0; ks < NKS; ++ks) {
                    const f32x4 a0 = *(const f32x4*)(ap + 32 * ks), a1 = *(const f32x4*)(ap + 32 * ks + 4);
                    const f32x4 x0 = xv[chn & 1][ks][0], x1 = xv[chn & 1][ks][1];
                    f32x4 u0, u1, r0, r1;
#pragma unroll
                    for (int r = 0; r < 4; ++r) { u0[r] = x0[r] * a0[r]; u1[r] = x1[r] * a1[r]; ss += x0[r] * x0[r] + x1[r] * x1[r]; }
                    const bf16x8 uh = pack8(u0, u1); uhk[chn * NKS + ks] = uh;
#pragma unroll
                    for (int r = 0; r < 4; ++r) { r0[r] = u0[r] - bf2f((unsigned short)uh[r]); r1[r] = u1[r] - bf2f((unsigned short)uh[4 + r]); }
                    const bf16x8 ul = pack8(r0, r1);
#pragma unroll
                    for (int nt = 0; nt < 3; ++nt) { const bf16x8 whf = *(const bf16x8*)(whp + nt * 16 * WLD + 32 * ks), wlf = *(const bf16x8*)(wlp + nt * 16 * WLD + 32 * ks);
                        acc[nt] = mfma16(whf, uh, acc[nt]); acc[nt] = mfma16(wlf, uh, acc[nt]); acc[nt] = mfma16(whf, ul, acc[nt]); }
                }
            }
        }
        if (valid) {
            ss += shflx(ss, 16); ss += shflx(ss, 32);
            float* lgp = lg + ((pi * 2 + kh) * 16 + c) * 48 + 4 * h;
#pragma unroll
            for (int nt = 0; nt < 3; ++nt) *(f32x4*)(lgp + 16 * nt) = acc[nt];
            if (h == 0) ssb[(pi * 2 + kh) * 16 + c] = ss;
        }
        SYNC();
        if (tid < 64) { const int p2 = tid >> 4, tk = tid & 15, pass2 = pass0 + p2 * NBLK;
            if (pass2 < T / 16) { const int tok2 = pass2 * 16 + tk, b2 = tok2 / SEQ;
                const float rs = frsq((ssb[(p2 * 2 + 0) * 16 + tk] + ssb[(p2 * 2 + 1) * 16 + tk]) * (1.0f / DM) + EPS); rsb[p2 * 16 + tk] = rs;
                const float* l0 = lg + ((p2 * 2 + 0) * 16 + tk) * 48; const float* l1 = lg + ((p2 * 2 + 1) * 16 + tk) * 48; const float* rbp = (const float*)(ws + WS_RBIAS) + ((size_t)l * 2 + b2) * 48;
                float acc[36];
#pragma unroll
                for (int n = 0; n < 36; ++n) acc[n] = rs * (l0[n] + l1[n]) + rbp[n];
                int gs = 0; float gm = acc[0];
#pragma unroll
                for (int g = 1; g < 4; ++g) if (acc[g] > gm) { gm = acc[g]; gs = g; }
                float den = 0.f;
#pragma unroll
                for (int g = 0; g < 4; ++g) den += fexp2((acc[g] - gm) * LOG2E);
                const float ggate = 1.0f / den;
                float el[8];
#pragma unroll
                for (int j = 0; j < 8; ++j) { el[j] = acc[4 + j];
#pragma unroll
                    for (int g = 1; g < 4; ++g) if (gs == g) el[j] = acc[4 + 8 * g + j]; }
                int ia = 0; float va = el[0];
#pragma unroll
                for (int j = 1; j < 8; ++j) if (el[j] > va) { va = el[j]; ia = j; }
                int ib = -1; float vb = -3e38f;
#pragma unroll
                for (int j = 0; j < 8; ++j) if (j != ia && el[j] > vb) { vb = el[j]; ib = j; }
                const float wa = 1.0f / (1.0f + fexp2((vb - va) * LOG2E)), wb = 1.0f - wa;
                const int e0 = gs * 8 + ia, e1 = gs * 8 + ib;
                const int p0 = atomic_add_i(lcnt + e0, 1), p1 = atomic_add_i(lcnt + e1, 1);
                int* ti = tinfo + tid * 4;
                ti[0] = (e0 << 14) | p0; ti[1] = (e1 << 14) | p1; ti[2] = __builtin_bit_cast(int, ggate * wa); ti[3] = __builtin_bit_cast(int, ggate * wb);
            } }
        SYNC();
        int gbase = 0;
        if (tid < 32) { const int n = lcnt[tid]; gbase = n > 0 ? atomic_add_i(cnt + tid * 64, n) : 0; }
        if (valid) { const float rs = rsb[pi * 16 + c]; bf16* hb = (bf16*)(ws + WS_H) + (size_t)tok * DM + kh * (CH / 2) + 8 * h;
            const float* cp = cvl + b * DM + kh * (CH / 2) + 8 * h;
#pragma unroll
            for (int chn = 0; chn < NCHK; ++chn)
#pragma unroll
                for (int ks = 0; ks < NKS; ++ks) {
                    const bf16x8 uh = uhk[chn * NKS + ks]; const f32x4 c0 = *(const f32x4*)(cp + chn * CH + 32 * ks), c1 = *(const f32x4*)(cp + chn * CH + 32 * ks + 4);
                    f32x4 o0, o1;
#pragma unroll
                    for (int r = 0; r < 4; ++r) { o0[r] = bf2f((unsigned short)uh[r]) * rs + c0[r]; o1[r] = bf2f((unsigned short)uh[4 + r]) * rs + c1[r]; }
                    st_bf8(hb + chn * CH + 32 * ks, o0, o1); } }
        if (tid < 32) { lbase[tid] = gbase; lcnt[tid] = 0; }
        SYNC();
        if (tid < 64) { const int p2 = tid >> 4, pass2 = pass0 + p2 * NBLK;
            if (pass2 < T / 16) { const int tok2 = pass2 * 16 + (tid & 15); const int* ti = tinfo + tid * 4;
                const int e0 = ti[0] >> 14, e1 = ti[1] >> 14, p0 = lbase[e0] + (ti[0] & 16383), p1 = lbase[e1] + (ti[1] & 16383);
                int* list = (int*)(ws + WS_LIST); list[(size_t)e0 * T + p0] = tok2; list[(size_t)e1 * T + p1] = tok2;
                int* tie = (int*)(ws + WS_TIE) + (size_t)tok2 * 2; int* tiw = (int*)(ws + WS_TIW) + (size_t)tok2 * 2;
                tie[0] = (e0 << 14) | p0; tie[1] = (e1 << 14) | p1; tiw[0] = ti[2]; tiw[1] = ti[3]; } }
        SYNC();
    }
}

DEV int vbid() { const int g = NBLK; return (g % 8 == 0) ? (BID % 8) * (g / 8) + BID / 8 : BID; }
#ifdef EMU
#define PG8_LDS(p) (p)
#else
#define PG8_LDS(p) ((PG8_LAS unsigned char*)(p))
#endif
DEV void inproj_phase(const Args& a, unsigned char* smem, int li) {
    pg8::Gemm g{(const bf16*)(wsp(a) + WS_H), (const bf16*)(wsp(a) + WS_WIN) + (size_t)li * NIN8 * DM, T, NIN8, DM}; pg8::StaticOrder S; S.init(T, NIN8, NBLK, BID);
    EpiInProj8 E{&a, li};
    SYNC(); pg8::gemm_phase<EpiInProj8, pg8::StaticOrder, true, true>(PG8_LDS(smem), g, S, E); SYNC();
}
DEV void resid_gemm_phase(const Args& a, unsigned char* smem, const bf16* A, int K, const bf16* Bt, int l) {
    pg8::Gemm g{A, Bt, T, DM, K}; pg8::StaticOrder S; S.init(T, DM, NBLK, BID);
    EpiResid8 E{outp(a), (const float*)(wsp(a) + WS_MOD) + (size_t)l * 2 * 6 * DM + 2 * DM, l == 0 ? INP(a, I_X) : (const float*)outp(a)};
    SYNC(); pg8::gemm_phase<EpiResid8, pg8::StaticOrder, true, true>(PG8_LDS(smem), g, S, E); SYNC();
}
DEV void pw1_phase(const Args& a, unsigned char* smem, int li) {
    pg8::Gemm g{(const bf16*)(wsp(a) + WS_H), (const bf16*)(wsp(a) + WS_PW1) + (size_t)li * 2 * DM * DM, T, 2 * DM, DM}; pg8::StaticOrder S; S.init(T, 2 * DM, NBLK, BID);
    EpiGlu8 E{(bf16*)(wsp(a) + WS_GLU)};
    SYNC(); pg8::gemm_phase<EpiGlu8, pg8::StaticOrder, true, true>(PG8_LDS(smem), g, S, E); SYNC();
}
DEV void cmp_phase_items(const Args& a, unsigned char* smem, int li, int it) {
    constexpr int TMC = (NCP + 255) / 256;
    const int kv = it / (4 * TMC), bg = (it / TMC) % 4, tm = it % TMC;
    const bf16* src = (const bf16*)(wsp(a) + (kv ? WS_VCG : WS_KCG)) + (size_t)bg * SEQ * 64;
    struct AF { const bf16* base; int m0; MDEV unsigned off(int r) const { int n = m0 + r; if (n > NCMP - 1) n = NCMP - 1; return (unsigned)n * 1024u; } } af{src, tm * 256};
    EpiCmp E{&a, kv, bg, tm * 256, li};
    BClamp64 bf{INP(a, kv ? I_CWV : I_CWK) + (size_t)li * 2048 * 64};
    gemm_tile2(smem, af, bf, 64, 2048, E);
}
DEV void moe_gemm_phase8(const Args& a, unsigned char* smem, int l, int mode) {
    unsigned char* ws = wsp(a); const int* cnt = (const int*)(ws + WS_CNT) + l * 32 * 64;
    int* rb = (int*)(smem + 140 * 1024);
    moe_bases(cnt, rb);
    const int mrows = rb[32];
    if (mode == 0) {
        pg8::Gemm g{(const bf16*)(ws + WS_H), (const bf16*)(ws + WS_W13) + (size_t)l * 32 * 2 * FF * DM, mrows, 2 * FF, DM}; pg8::StaticOrder S; S.init(mrows, 2 * FF, NBLK, BID);
        EpiMoe1_8 E{(bf16*)(ws + WS_ACT)}; MoeSel<true> X{rb, cnt, (const int*)(ws + WS_LIST), (size_t)2 * FF * DM * 2};
        SYNC(); pg8::gemm_phase<EpiMoe1_8, pg8::StaticOrder, true, true, MoeSel<true>>(PG8_LDS(smem), g, S, E, X); SYNC();
    } else {
        pg8::Gemm g{(const bf16*)(ws + WS_ACT), (const bf16*)(ws + WS_W2) + (size_t)l * 32 * DM * FF, mrows, DM, FF}; pg8::StaticOrder S; S.init(mrows, DM, NBLK, BID);
        EpiMoe2_8 E{(bf16*)(ws + WS_YK)}; MoeSel<false> X{rb, cnt, (const int*)(ws + WS_LIST), (size_t)DM * FF * 2};
        SYNC(); pg8::gemm_phase<EpiMoe2_8, pg8::StaticOrder, true, true, MoeSel<false>>(PG8_LDS(smem), g, S, E, X); SYNC();
    }
}
#ifndef EMU
constexpr int MOE_TMO_IDX = 128;
struct MoeOrder { int nN, t0, nu, j, nper, nA; bool rev;
    __device__ __forceinline__ void init(int ntile, int nN_, int nblk, int bid, bool rev_) { nN = nN_; nper = nblk / 8; rev = rev_; const int x = bid % 8; j = bid / 8;
        t0 = x * ntile / 8; nu = ((x + 1) * ntile / 8 - t0) * nN; if (bid >= 8 * nper) nu = 0;
        nA = nu - 2 * nper; nA = nA < 0 ? 0 : (nA > nper / 2 ? nper / 2 : nA); }
    __device__ __forceinline__ bool next(int i, pg8::Unit& u) const { int p;
        if (!rev) p = i * nper + j;
        else if (j < nA) { if (i > 0) return false; p = nu - nA + j; }
        else { p = i * (nper - nA) + (j - nA); if (p >= nu - nA) return false; }
        if (p >= nu) return false; u.pm = t0 + p / nN; u.pn = p % nN; return true; }
    __device__ __forceinline__ void a_ready(const pg8::Unit&) const {}
    __device__ __forceinline__ void done(const pg8::Unit&) const {}
};
struct MoeProd : MoeOrder { unsigned* flg;
    __device__ __forceinline__ void done(const pg8::Unit& u) const {
        asm volatile("s_waitcnt vmcnt(0)" ::: "memory"); __builtin_amdgcn_s_barrier(); asm volatile("" ::: "memory");
        if (TID == 0) (void)__hip_atomic_fetch_add((__attribute__((address_space(1))) unsigned*)(flg + u.pm * 16), 1u, __ATOMIC_RELAXED, __HIP_MEMORY_SCOPE_AGENT); } };
struct MoeCons : MoeOrder { unsigned* flg; unsigned* tmo;
    __device__ __forceinline__ void a_ready(const pg8::Unit& u) const {
        if ((TID >> 6) == 0) { unsigned sp = 0u; __attribute__((address_space(1))) unsigned* f = (__attribute__((address_space(1))) unsigned*)(flg + u.pm * 16);
            while ((unsigned)__builtin_amdgcn_readfirstlane((int)__hip_atomic_load(f, __ATOMIC_RELAXED, __HIP_MEMORY_SCOPE_AGENT)) < (unsigned)(2 * FF / 256)) {
                __builtin_amdgcn_s_sleep(1);
                if ((++sp & 255u) == 0u) { if (__hip_atomic_load((__attribute__((address_space(1))) unsigned*)tmo, __ATOMIC_RELAXED, __HIP_MEMORY_SCOPE_AGENT)) break;
                    if (sp > (1u << 22)) { (void)__hip_atomic_fetch_add((__attribute__((address_space(1))) unsigned*)tmo, 1u, __ATOMIC_RELAXED, __HIP_MEMORY_SCOPE_AGENT); break; } } }
            __builtin_amdgcn_fence(__ATOMIC_ACQUIRE, "agent"); }
        asm volatile("" ::: "memory"); __builtin_amdgcn_s_barrier(); asm volatile("" ::: "memory"); } };
DEV void moe_fused_phase(const Args& a, unsigned char* smem, int l) {
    unsigned char* ws = wsp(a); const int* cnt = (const int*)(ws + WS_CNT) + l * 32 * 64;
    int* rb = (int*)(smem + 140 * 1024);
    moe_bases(cnt, rb);
    const int mrows = rb[32]; unsigned* flg = (unsigned*)(ws + WS_FLG) + (size_t)l * 256 * 16;
    { pg8::Gemm g{(const bf16*)(ws + WS_H), (const bf16*)(ws + WS_W13) + (size_t)l * 32 * 2 * FF * DM, mrows, 2 * FF, DM}; MoeProd S; S.init(mrows >> 8, 2 * FF / 256, NBLK, BID, false); S.flg = flg;
      EpiMoe1_8 E{(bf16*)(ws + WS_ACT)}; MoeSel<true> X{rb, cnt, (const int*)(ws + WS_LIST), (size_t)2 * FF * DM * 2};
      SYNC(); pg8::gemm_phase<EpiMoe1_8, MoeProd, true, true, MoeSel<true>>(PG8_LDS(smem), g, S, E, X); }
    { pg8::Gemm g{(const bf16*)(ws + WS_ACT), (const bf16*)(ws + WS_W2) + (size_t)l * 32 * DM * FF, mrows, DM, FF}; MoeCons S; S.init(mrows >> 8, DM / 256, NBLK, BID, true); S.flg = flg; S.tmo = (unsigned*)(ws + WS_BAR) + MOE_TMO_IDX;
      EpiMoe2_8 E{(bf16*)(ws + WS_YK)}; MoeSel<false> X{rb, cnt, (const int*)(ws + WS_LIST), (size_t)DM * FF * 2};
      SYNC(); pg8::gemm_phase<EpiMoe2_8, MoeCons, true, true, MoeSel<false>>(PG8_LDS(smem), g, S, E, X); SYNC(); }
}
#endif
DEV void moe_gemm_phase(const Args& a, unsigned char* smem, int l, int mode) {
    unsigned char* ws = wsp(a); const int* cnt = (const int*)(ws + WS_CNT) + l * 32 * 64;
    int* rb = (int*)(smem + GEMM2_LDS);
    moe_bases(cnt, rb);
    const int ntile = rb[32] >> 8;
    constexpr int TN1 = 2 * FF / 128, TN2 = DM / 128;
    const int TN = mode == 0 ? TN1 : TN2;
    const int* list = (const int*)(ws + WS_LIST);
    for (int it = vbid(); it < ntile * TN; it += NBLK) {
        const int rt = it / TN, tn = it % TN; int e = 0;
#pragma unroll 1
        for (int q = 1; q < 32; ++q) if ((rb[q] >> 8) <= rt) e = q;
        const int rloc = (rt << 8) - rb[e], ce = cnt[e * 64], nvalid = (ce - rloc) < 256 ? (ce - rloc) : 256;
        if (mode == 0) {
            struct AF { const bf16* base; const int* lst; int nv; MDEV unsigned off(int r) const { const int rr = r < nv ? r : nv - 1; return (unsigned)lst[rr] * (unsigned)DM; } }
                af{(const bf16*)(ws + WS_H), list + (size_t)e * T + rloc, nvalid};
            EpiGated<1> E{(bf16*)(ws + WS_ACT), (size_t)FF, rt << 8, tn * 128, nvalid};
            BInter bf{INP(a, I_W1) + (size_t)(l * 32 + e) * DM * FF, INP(a, I_W3) + (size_t)(l * 32 + e) * DM * FF, tn * 128};
            gemm_tile2(smem, af, bf, FF, DM, E);
        } else {
            ARows af{(const bf16*)(ws + WS_ACT) + (size_t)(rt << 8) * FF, (size_t)FF};
            EpiStoreBf E{(bf16*)(ws + WS_YK), (size_t)DM, rt << 8, tn * 128, nvalid};
            BPlain bf{INP(a, I_W2) + (size_t)(l * 32 + e) * FF * DM + tn * 128};
            gemm_tile2(smem, af, bf, DM, FF, E);
        }
    }
}

constexpr int LDV = 80;
constexpr int AT_K = 0, AT_V = 2 * 64 * LDT * 2, AT_IMP = AT_V + 2 * 64 * LDV * 2, AT_SEL = AT_IMP + 8 * 8 * 128 * 4, AT_GSEL = AT_SEL + 8 * 8 * 4 * 4, AT_OUT = AT_GSEL + 8 * 2 * 4 * 4, AT_END = AT_OUT + 8 * 32 * 64 * 4;
#ifdef EMU
DEV float rexp2(float x) { return exp2f(x); }
DEV unsigned uni(unsigned x) { return x; }
#else
DEV float rexp2(float x) { return __builtin_amdgcn_exp2f(x); }
DEV unsigned uni(unsigned x) { return (unsigned)__builtin_amdgcn_readfirstlane((int)x); }
#endif
DEV int krow_lds(int kappa) { return 16 * (2 * (kappa >> 5) + ((kappa >> 2) & 1)) + 4 * ((kappa >> 3) & 3) + (kappa & 3); }
template <int MASK, bool FULL, int GM>
DEV void attn_block(const bf16* Kp, const bf16* Vp, const bf16x8 (&qf)[2][2], int j, const int (&s)[2], const bool (&selbit)[2], float C2, int h, int c,
                    f32x4 (&O)[2][4], f32x4 (&Ol)[2]) {
    f32x4 st[2][2][2];
#pragma unroll
    for (int sp = 0; sp < 2; ++sp)
#pragma unroll
        for (int u = 0; u < 2; ++u) {
#pragma unroll
            for (int G = 0; G < 2; ++G) { st[G][sp][u][0] = -C2; st[G][sp][u][1] = -C2; st[G][sp][u][2] = -C2; st[G][sp][u][3] = -C2; }
#pragma unroll
            for (int ks = 0; ks < 2; ++ks) { const bf16x8 kf = *(const bf16x8*)(Kp + (16 * (2 * sp + u) + c) * LDT + 32 * ks + 8 * h);
#pragma unroll
                for (int G = 0; G < 2; ++G) if (GM & (1 << G)) st[G][sp][u] = mfma16(kf, qf[G][ks], st[G][sp][u]); } }
#pragma unroll
    for (int G = 0; G < 2; ++G) if (GM & (1 << G))
#pragma unroll
        for (int sp = 0; sp < 2; ++sp)
#pragma unroll
            for (int u = 0; u < 2; ++u)
#pragma unroll
                for (int r = 0; r < 4; ++r) { bool ok = selbit[G];
                    if (!FULL) { const int key = 64 * j + 32 * sp + 8 * h + 4 * u + r;
                        if (MASK == 0) ok = 16 * key + 31 <= s[G]; else if (MASK == 1) ok = selbit[G] && key <= s[G]; else ok = key <= s[G] && key > s[G] - 512; }
                    st[G][sp][u][r] = ok ? rexp2(st[G][sp][u][r]) : 0.f; }
    bf16x8 pb[2][2], ones;
#pragma unroll
    for (int q = 0; q < 8; ++q) ones[q] = (short)0x3F80;
#pragma unroll
    for (int G = 0; G < 2; ++G) if (GM & (1 << G))
#pragma unroll
        for (int sp = 0; sp < 2; ++sp) { pb[G][sp] = pack8(st[G][sp][0], st[G][sp][1]); Ol[G] = mfma16(ones, pb[G][sp], Ol[G]); }
    const bf16* Vb = Vp + bperm(8 * h + (c >> 2)) * LDV + 4 * (c & 3);
#pragma unroll
    for (int et = 0; et < 4; ++et)
#pragma unroll
        for (int sp = 0; sp < 2; ++sp) { const bf16x8 vf = tr_read8(Vb + (32 * sp) * LDV + 16 * et, Vb + (32 * sp + 8) * LDV + 16 * et);
#pragma unroll
            for (int G = 0; G < 2; ++G) if (GM & (1 << G)) O[G][et] = mfma16(vf, pb[G][sp], O[G][et]); }
}

struct ImpState { float invq[2][4]; float carry[2]; float* imps; int tl, hd, l, s0, qblk; };
DEV void imp_block(const bf16* Kp, const bf16x8 (&qf)[2][2], int j, int s0, int w, float C2, int h, int c, ImpState& im) {
#pragma unroll
    for (int kt = 0; kt < 4; ++kt) {
        const int row = krow_lds(16 * kt + c);
        const bf16x8 k0 = *(const bf16x8*)(Kp + row * LDT + 8 * h), k1 = *(const bf16x8*)(Kp + row * LDT + 32 + 8 * h);
        const int n = 64 * j + 16 * kt + c;
#pragma unroll
        for (int G = 0; G < 2; ++G) {
            f32x4 acc; acc[0] = -C2; acc[1] = -C2; acc[2] = -C2; acc[3] = -C2;
            acc = mfma16(qf[G][0], k0, acc); acc = mfma16(qf[G][1], k1, acc);
            const bool ok = 16 * n + 31 <= s0 + 8 * w + 4 * G + h;
            float imp = 0.f;
#pragma unroll
            for (int r = 0; r < 4; ++r) imp += ok ? rexp2(acc[r]) * im.invq[G][r] : 0.f;
            const float v = ((c & 3) == 3) ? imp : 2.0f * imp;
            float sq = v + shflx(v, 1); sq += shflx(sq, 2);
            const float rr = dpp_ror1(imp);
            const float prev = (c == 0) ? im.carry[G] : rr;
            im.carry[G] = rr;
            const int m = n >> 2;
            if ((c & 3) == 0 && m < 128) im.imps[(G * 4 + h) * 128 + m] = sq + prev;
        }
    }
}

template <int MODE>
DEV void attn_branch(bf16* Kl, bf16* Vl, const bf16* kbase, const bf16* vbase, int jlo, int jhi,
                     const bf16x8 (&qf)[2][2], const int (&s)[2], const unsigned* selm, const unsigned* gselm, float C2, int w, int h, int c, int srow, int scol,
                     f32x4 (&O)[2][4], f32x4 (&Ol)[2], ImpState& im) {
    constexpr bool PV = MODE != 1; constexpr int MASK = MODE <= 1 ? 0 : MODE - 1;
    const int krow = krow_lds(srow) * LDT + scol, vrow = bperm(srow) * LDV + scol;
    bf16x8 rk[3], rv[3];
    { const bf16x8 k0 = *(const bf16x8*)(kbase + (size_t)jlo * 4096); *(bf16x8*)(Kl + krow) = k0;
      if (PV) { const bf16x8 v0 = *(const bf16x8*)(vbase + (size_t)jlo * 4096); *(bf16x8*)(Vl + vrow) = v0; } }
#pragma unroll
    for (int u = 0; u < 3; ++u) { int jj = jlo + 1 + u; if (jj > jhi) jj = jhi; rk[(1 + u) % 3] = *(const bf16x8*)(kbase + (size_t)jj * 4096); if (PV) rv[(1 + u) % 3] = *(const bf16x8*)(vbase + (size_t)jj * 4096); }
    SYNC();
    for (int jb = jlo; jb <= jhi; jb += 3) {
#pragma unroll
        for (int u = 0; u < 3; ++u) { const int j = jb + u;
            if (j <= jhi) {
                const int cur = (j - jlo) & 1;
                const bf16* Kc = Kl + cur * 64 * LDT; const bf16* Vc = Vl + cur * 64 * LDV;
                if (MODE == 1) imp_block(Kc, qf, j, im.s0, w, C2, h, c, im);
                else {
                    bool sb[2] = {true, true}; unsigned gm = 3u;
                    if (MODE == 2) { gm = 0u;
#pragma unroll
                        for (int G = 0; G < 2; ++G) { const unsigned wq = uni(gselm[G * 4 + (j >> 5)]), mq = selm[(G * 4 + im.tl) * 4 + (j >> 5)];
                            gm |= ((wq >> (j & 31)) & 1u) << G; sb[G] = (mq >> (j & 31)) & 1u; } }
                    bool full;
                    if (MODE == 0) full = 1024 * j + 1039 <= im.s0; else if (MODE == 2) full = j < im.qblk; else full = (j < im.qblk) && (64 * j > im.s0 + 63 - 512);
                    if (MODE == 2) {
                        if (full) { if (gm == 3u) attn_block<MASK, true, 3>(Kc, Vc, qf, j, s, sb, C2, h, c, O, Ol); else if (gm == 1u) attn_block<MASK, true, 1>(Kc, Vc, qf, j, s, sb, C2, h, c, O, Ol); else if (gm == 2u) attn_block<MASK, true, 2>(Kc, Vc, qf, j, s, sb, C2, h, c, O, Ol); }
                        else { if (gm == 3u) attn_block<MASK, false, 3>(Kc, Vc, qf, j, s, sb, C2, h, c, O, Ol); else if (gm == 1u) attn_block<MASK, false, 1>(Kc, Vc, qf, j, s, sb, C2, h, c, O, Ol); else if (gm == 2u) attn_block<MASK, false, 2>(Kc, Vc, qf, j, s, sb, C2, h, c, O, Ol); }
                    } else { if (full) attn_block<MASK, true, 3>(Kc, Vc, qf, j, s, sb, C2, h, c, O, Ol); else attn_block<MASK, false, 3>(Kc, Vc, qf, j, s, sb, C2, h, c, O, Ol); }
                }
                if (j + 1 <= jhi) {
                    *(bf16x8*)(Kl + (cur ^ 1) * 64 * LDT + krow) = rk[(u + 1) % 3]; if (PV) *(bf16x8*)(Vl + (cur ^ 1) * 64 * LDV + vrow) = rv[(u + 1) % 3];
                    int jj = j + 4; if (jj > jhi) jj = jhi;
                    rk[(u + 1) % 3] = *(const bf16x8*)(kbase + (size_t)jj * 4096); if (PV) rv[(u + 1) % 3] = *(const bf16x8*)(vbase + (size_t)jj * 4096);
                }
                SYNC();
            }
        }
    }
}

DEV void attn_task(const Args& a, unsigned char* smem, int li, int item) {
    unsigned char* ws = wsp(a); const int tid = TID, w = tid >> 6, l = tid & 63, h = l >> 4, c = l & 15, tl = c >> 2, hd = c & 3;
    const int bg = item & 3, b = bg >> 1, g = bg & 1, tq = (SEQ / 64 - 1) - (item >> 2), s0 = tq * 64, qblk = tq;
    int s[2], row[2];
#pragma unroll
    for (int G = 0; G < 2; ++G) { s[G] = s0 + 8 * w + 4 * G + tl; row[G] = b * SEQ + s[G]; }
    bf16* Kl = (bf16*)(smem + AT_K); bf16* Vl = (bf16*)(smem + AT_V); float* imps = (float*)(smem + AT_IMP) + w * 1024; unsigned* selm = (unsigned*)(smem + AT_SEL) + w * 32;
    bf16x8 qf[2][2]; float gatec[2], gates[2], gatew[2];
#pragma unroll
    for (int G = 0; G < 2; ++G) { const bf16* qp = (const bf16*)(ws + WS_QN) + (size_t)row[G] * 512 + (g * 4 + hd) * 64 + 8 * h; qf[G][0] = *(const bf16x8*)qp; qf[G][1] = *(const bf16x8*)(qp + 32);
        const float* gp = (const float*)(ws + WS_GATE) + (size_t)row[G] * 24 + (g * 4 + hd) * 3; gatec[G] = gp[0]; gates[G] = gp[1]; gatew[G] = gp[2]; }
    const float* cs = (const float*)(ws + WS_CS) + li * 4;
    const int srow = tid >> 3, scol = (tid & 7) * 8;
    for (int i = l; i < 1024; i += 64) imps[i] = 0.f;
    SYNC();
    unsigned* gselm = (unsigned*)(smem + AT_GSEL) + w * 8; float* outl = (float*)(smem + AT_OUT) + w * 2048 + l;
    ImpState im{{{0.f, 0.f, 0.f, 0.f}, {0.f, 0.f, 0.f, 0.f}}, {0.f, 0.f}, imps, tl, hd, l, s0, qblk};
    {
        const int ncv = s0 / 16 + 3, ncb0 = (ncv + 63) >> 6, ncb = ncb0 > NCP / 64 ? NCP / 64 : ncb0;
        const bf16* kcb = (const bf16*)(ws + WS_KC) + (size_t)bg * NCP * 64 + tid * 8;
        const bf16* vcb = (const bf16*)(ws + WS_VCT) + (size_t)bg * NCP * 64 + tid * 8;
        f32x4 O[2][4], Ol[2] = {f4zero(), f4zero()};
#pragma unroll
        for (int G = 0; G < 2; ++G)
#pragma unroll
            for (int et = 0; et < 4; ++et) O[G][et] = f4zero();
        attn_branch<0>(Kl, Vl, kcb, vcb, 0, ncb - 1, qf, s, selm, gselm, cs[0], w, h, c, srow, scol, O, Ol, im);
#pragma unroll
        for (int G = 0; G < 2; ++G) { const float lsum = Ol[G][0]; const float invl = lsum > 0.f ? 1.0f / lsum : 0.f;
#pragma unroll
            for (int r = 0; r < 4; ++r) im.invq[G][r] = shfl(invl, 4 * h + r);
#pragma unroll
            for (int et = 0; et < 4; ++et)
#pragma unroll
                for (int r = 0; r < 4; ++r) outl[((G * 4 + et) * 4 + r) * 64] = gatec[G] * invl * O[G][et][r]; }
        f32x4 ld[2] = {f4zero(), f4zero()};
        attn_branch<1>(Kl, Vl, kcb, vcb, 0, ncb - 1, qf, s, selm, gselm, cs[0], w, h, c, srow, scol, O, ld, im);
    }
    WSYNC();
#pragma unroll 1
    for (int G = 0; G < 2; ++G) {
        const int tk = l >> 4, i = l & 15; float vals[8];
#pragma unroll
        for (int mm = 0; mm < 8; ++mm) { const int jj = i + 16 * mm; vals[mm] = jj > qblk ? NEGV : ((jj == 0 || jj == qblk || jj == qblk - 1) ? FORCEV : imps[(G * 4 + tk) * 128 + jj]); }
        unsigned mk[4] = {0u, 0u, 0u, 0u};
#pragma unroll 1
        for (int rnd = 0; rnd < 16; ++rnd) {
            float best = vals[0]; int bj = i;
#pragma unroll
            for (int mm = 1; mm < 8; ++mm) if (vals[mm] > best) { best = vals[mm]; bj = i + 16 * mm; }
#pragma unroll
            for (int o = 1; o < 16; o <<= 1) { const float ov = shflx(best, o); const int oj = shflxi(bj, o); if (ov > best || (ov == best && oj < bj)) { best = ov; bj = oj; } }
            if (best > NEGV * 0.5f) {
#pragma unroll
                for (int q = 0; q < 4; ++q) if ((bj >> 5) == q) mk[q] |= 1u << (bj & 31); }
            if ((bj & 15) == i) {
#pragma unroll
                for (int mm = 0; mm < 8; ++mm) if ((bj >> 4) == mm) vals[mm] = -3e38f; }
        }
        if (i == 0) {
#pragma unroll
            for (int q = 0; q < 4; ++q) selm[(G * 4 + tk) * 4 + q] = mk[q]; }
    }
    WSYNC();
    if (l < 8) { const int G = l >> 2, q = l & 3; gselm[l] = selm[(G * 4 + 0) * 4 + q] | selm[(G * 4 + 1) * 4 + q] | selm[(G * 4 + 2) * 4 + q] | selm[(G * 4 + 3) * 4 + q]; }
    WSYNC();
#pragma unroll
    for (int br = 0; br < 2; ++br) {
        const bf16* kb = (const bf16*)(ws + (br == 0 ? WS_KS : WS_KW)) + (size_t)bg * SEQ * 64 + tid * 8; const bf16* vb = (const bf16*)(ws + (br == 0 ? WS_VST : WS_VWT)) + (size_t)bg * SEQ * 64 + tid * 8;
        f32x4 O[2][4], Ol[2] = {f4zero(), f4zero()};
#pragma unroll
        for (int G = 0; G < 2; ++G)
#pragma unroll
            for (int et = 0; et < 4; ++et) O[G][et] = f4zero();
        if (br == 0) attn_branch<2>(Kl, Vl, kb, vb, 0, qblk, qf, s, selm, gselm, cs[1], w, h, c, srow, scol, O, Ol, im);
        else attn_branch<3>(Kl, Vl, kb, vb, s0 >= 511 ? (s0 - 511) >> 6 : 0, qblk, qf, s, selm, gselm, cs[2], w, h, c, srow, scol, O, Ol, im);
#pragma unroll
        for (int G = 0; G < 2; ++G) { const float lsum = Ol[G][0]; const float sc = (br == 0 ? gates[G] : gatew[G]) * (lsum > 0.f ? 1.0f / lsum : 0.f);
#pragma unroll
            for (int et = 0; et < 4; ++et)
#pragma unroll
                for (int r = 0; r < 4; ++r) outl[((G * 4 + et) * 4 + r) * 64] += sc * O[G][et][r]; }
    }
#pragma unroll
    for (int G = 0; G < 2; ++G) { bf16* dst = (bf16*)(ws + WS_CAT) + (size_t)row[G] * 1024 + (g * 4 + hd) * 64 + 4 * h;
#pragma unroll
        for (int et = 0; et < 4; ++et) { f32x4 o;
#pragma unroll
            for (int r = 0; r < 4; ++r) o[r] = outl[((G * 4 + et) * 4 + r) * 64];
            st_bf4(dst + 16 * et, o); } }
}

constexpr int LDH = 136;
DEV void hg_cumsum(const float* fsrc  , float* segs  , int d, int seg, float (&f)[16], float (&bc)[16], float& bend, float& bmid) {
    float run = 0.f;
#pragma unroll
    for (int i = 0; i < 16; ++i) { f[i] = fsrc[(size_t)(16 * seg + i) * 128 + d]; run += log2f(f[i]); bc[i] = run; }
    SYNC();
    segs[seg * 128 + d] = run;
    SYNC();
    const float s0 = segs[d], s1 = segs[128 + d], s2 = segs[256 + d], s3 = segs[384 + d];
    const float off = seg == 0 ? 0.f : (seg == 1 ? s0 : (seg == 2 ? s0 + s1 : s0 + s1 + s2));
#pragma unroll
    for (int i = 0; i < 16; ++i) bc[i] += off;
    bend = s0 + s1 + s2 + s3; bmid = s0 + s1;
}
DEV void hg_write16(bf16* dstrow  , const float (&v)[16]) {
    u32x4 w0, w1;
#pragma unroll
    for (int q = 0; q < 4; ++q) { w0[q] = pk2(v[2 * q], v[2 * q + 1]); w1[q] = pk2(v[8 + 2 * q], v[8 + 2 * q + 1]); }
    *(u32x4*)dstrow = w0; *(u32x4*)(dstrow + 8) = w1;
}
DEV void hg_h1_task(const Args& a, unsigned char* smem, int task) {
    unsigned char* ws = wsp(a); const int tid = TID, w = tid >> 6, l = tid & 63, h = l >> 4, c = l & 15, d = tid & 127, seg = tid >> 7;
    const int bh = task / NCH, ch = task % NCH;
    bf16* kT = (bf16*)smem; bf16* vT = kT + 128 * LDT; float* segs = (float*)(vT + 128 * LDT);
    const size_t tokb = (size_t)bh * SEQ + ch * 64;
    float f[16], bc[16], bend, bmid;
    const bf16* vs = (const bf16*)(ws + WS_HV) + tokb * 128;
    bf16 vraw[16];
#pragma unroll
    for (int i = 0; i < 16; ++i) vraw[i] = vs[(size_t)(16 * seg + i) * 128 + d];
    hg_cumsum((const float*)(ws + WS_HF) + tokb * 128, segs, d, seg, f, bc, bend, bmid);
    float kv[16];
#pragma unroll
    for (int i = 0; i < 16; ++i) kv[i] = (1.0f - f[i]) * fexp2(bend - bc[i]);
    hg_write16(kT + d * LDT + 16 * seg, kv);
#pragma unroll
    for (int i = 0; i < 16; ++i) kv[i] = bf2f(vraw[i]);
    hg_write16(vT + d * LDT + 16 * seg, kv);
    if (seg == 0) ((float*)(ws + WS_GD))[((size_t)bh * NCH + ch) * 128 + d] = fexp2(bend);
    SYNC();
    f32x4 acc[8];
#pragma unroll
    for (int et = 0; et < 8; ++et) acc[et] = f4zero();
#pragma unroll
    for (int ks = 0; ks < 2; ++ks) { const bf16x8 fa = *(const bf16x8*)(kT + (16 * w + c) * LDT + 32 * ks + 8 * h);
#pragma unroll
        for (int et = 0; et < 8; ++et) acc[et] = mfma16(fa, *(const bf16x8*)(vT + (16 * et + c) * LDT + 32 * ks + 8 * h), acc[et]); }
    float* ut = (float*)(ws + WS_UT) + ((size_t)bh * NCH + ch) * 16384;
#pragma unroll
    for (int et = 0; et < 8; ++et) *(f32x4*)(ut + (size_t)(16 * et + c) * 128 + 16 * w + 4 * h) = acc[et];
    SYNC();
}
DEV void hg_scan_task(const Args& a, int sc) {
    unsigned char* ws = wsp(a); const int bh = sc >> 3, q = (sc & 7) * 512 + TID, e = q >> 5, d0 = (q & 31) * 4;
    const float* ut = (const float*)(ws + WS_UT) + (size_t)bh * NCH * 16384 + (size_t)e * 128 + d0;
    const float* gd = (const float*)(ws + WS_GD) + (size_t)bh * NCH * 128 + d0;
    bf16* st = (bf16*)(ws + WS_ST) + (size_t)bh * NCH * 16384 + (size_t)e * 128 + d0;
    f32x4 S = f4zero();
#pragma unroll 4
    for (int ch = 0; ch < NCH; ++ch) { st_bf4(st + (size_t)ch * 16384, S);
        const f32x4 g = *(const f32x4*)(gd + (size_t)ch * 128), u = *(const f32x4*)(ut + (size_t)ch * 16384);
#pragma unroll
        for (int r = 0; r < 4; ++r) S[r] = g[r] * S[r] + u[r]; }
}
DEV void hg_h3_task(const Args& a, unsigned char* smem, int li, int task) {
    unsigned char* ws = wsp(a); const int tid = TID, w = tid >> 6, l = tid & 63, h = l >> 4, c = l & 15, d = tid & 127, seg = tid >> 7;
    const int bh = task / NCH, ch = task % NCH, b = bh >> 2, hh = bh & 3;
    bf16* At = (bf16*)smem; bf16* Bt = At + 64 * LDH; bf16* Qt = Bt + 64 * LDH; bf16* vT = Qt + 64 * LDH; float* segs = (float*)(vT + 128 * LDT); float* part = segs + 512;
    const size_t tokb = (size_t)bh * SEQ + ch * 64;
    float f[16], bc[16], bend, bmid;
    const bf16* qs = (const bf16*)(ws + WS_HQ) + tokb * 128; const bf16* vs = (const bf16*)(ws + WS_HV) + tokb * 128;
    const int tt = w & 3, eh = w >> 2;
    bf16 qraw[16], vraw[16];
#pragma unroll
    for (int i = 0; i < 16; ++i) { const int t = 16 * seg + i; qraw[i] = qs[(size_t)t * 128 + d]; vraw[i] = vs[(size_t)t * 128 + d]; }
    const bf16* stp = (const bf16*)(ws + WS_ST) + ((size_t)bh * NCH + ch) * 16384;
    bf16x8 stf[4][4];
#pragma unroll
    for (int ks = 0; ks < 4; ++ks)
#pragma unroll
        for (int et = 0; et < 4; ++et) stf[ks][et] = *(const bf16x8*)(stp + (size_t)(64 * eh + 16 * et + c) * 128 + 32 * ks + 8 * h);
    const int tok = b * SEQ + ch * 64 + 16 * tt + c;
    const bf16* hg = (const bf16*)(ws + WS_HGS) + (size_t)tok * 512 + hh * 128;
    u32x2 hgv[4];
#pragma unroll
    for (int et = 0; et < 4; ++et) hgv[et] = *(const u32x2*)(hg + 64 * eh + 16 * et + 4 * h);
    hg_cumsum((const float*)(ws + WS_HF) + tokb * 128, segs, d, seg, f, bc, bend, bmid);
    float vv[16];
#pragma unroll
    for (int i = 0; i < 16; ++i) { const int t = 16 * seg + i; const float q = bf2f(qraw[i]);
        At[t * LDH + d] = (bf16)f2bf(q * fexp2(bc[i] - bmid)); Bt[t * LDH + d] = (bf16)f2bf((1.0f - f[i]) * fexp2(bmid - bc[i])); Qt[t * LDH + d] = (bf16)f2bf(q * fexp2(bc[i]));
        vv[i] = bf2f(vraw[i]); }
    hg_write16(vT + d * LDT + 16 * seg, vv);
    SYNC();
    f32x4 O[4];
#pragma unroll
    for (int et = 0; et < 4; ++et) O[et] = f4zero();
#pragma unroll
    for (int sp = 0; sp < 2; ++sp) {
        if (32 * sp > 16 * tt + 15) continue;
        f32x4 st[2];
#pragma unroll
        for (int u = 0; u < 2; ++u) { st[u] = f4zero(); const int krow = 32 * sp + 8 * (c >> 2) + 4 * u + (c & 3);
#pragma unroll
            for (int ks = 0; ks < 4; ++ks) st[u] = mfma16(*(const bf16x8*)(Bt + krow * LDH + 32 * ks + 8 * h), *(const bf16x8*)(At + (16 * tt + c) * LDH + 32 * ks + 8 * h), st[u]);
#pragma unroll
            for (int r = 0; r < 4; ++r) { const int sk = 32 * sp + 8 * h + 4 * u + r; if (sk > 16 * tt + c) st[u][r] = 0.f; } }
        const bf16x8 pb = pack8(st[0], st[1]);
#pragma unroll
        for (int et = 0; et < 4; ++et) O[et] = mfma16(*(const bf16x8*)(vT + (64 * eh + 16 * et + c) * LDT + 32 * sp + 8 * h), pb, O[et]);
    }
#pragma unroll
    for (int ks = 0; ks < 4; ++ks) { const bf16x8 fq = *(const bf16x8*)(Qt + (16 * tt + c) * LDH + 32 * ks + 8 * h);
#pragma unroll
        for (int et = 0; et < 4; ++et) O[et] = mfma16(stf[ks][et], fq, O[et]); }
    float ss = 0.f;
#pragma unroll
    for (int et = 0; et < 4; ++et)
#pragma unroll
        for (int r = 0; r < 4; ++r) ss += O[et][r] * O[et][r];
    ss += shflx(ss, 16); ss += shflx(ss, 32);
    if (h == 0) part[eh * 64 + 16 * tt + c] = ss;
    SYNC();
    const float rs = frsq((part[16 * tt + c] + part[64 + 16 * tt + c]) * (1.0f / 128.0f) + EPS);
    const float* og = INP(a, I_OG) + li * 128;
    bf16* dst = (bf16*)(ws + WS_CAT) + (size_t)tok * 1024 + 512 + hh * 128;
#pragma unroll
    for (int et = 0; et < 4; ++et) { const int e = 64 * eh + 16 * et + 4 * h; f32x4 o; const f32x4 ogv = *(const f32x4*)(og + e);
        o[0] = O[et][0] * rs * ogv[0] * bf2f(hgv[et][0] & 0xffff); o[1] = O[et][1] * rs * ogv[1] * bf2f(hgv[et][0] >> 16);
        o[2] = O[et][2] * rs * ogv[2] * bf2f(hgv[et][1] & 0xffff); o[3] = O[et][3] * rs * ogv[3] * bf2f(hgv[et][1] >> 16);
        st_bf4(dst + e, o); }
    SYNC();
}

constexpr int CTS = 16;
DEV void conv_task(const Args& a, unsigned char* smem, int li, int task) {
    unsigned char* ws = wsp(a); const int tid = TID, w = tid >> 6, lane = tid & 63;
    const bool act = tid < DM / 2; const int c0 = act ? 2 * tid : 0;
    const int tb = task * 64, b = tb / SEQ, sb = tb % SEQ;
    float* red = (float*)smem;
    const float b0 = INP(a, I_DWB)[li * DM + c0], b1 = INP(a, I_DWB)[li * DM + c0 + 1];
    const float g0 = INP(a, I_LNG)[li * DM + c0], g1 = INP(a, I_LNG)[li * DM + c0 + 1], e0 = INP(a, I_LNB)[li * DM + c0], e1 = INP(a, I_LNB)[li * DM + c0 + 1];
    const bf16* glu = (const bf16*)(ws + WS_GLU) + (size_t)b * SEQ * DM + c0;
    float* lw = (float*)(smem + 4096);
    SYNC();
    for (int i = tid * 4; i < 31 * DM; i += NT * 4) *(f32x4*)(lw + i) = *(const f32x4*)(INP(a, I_DW) + (size_t)li * 31 * DM + i);
    SYNC();
    f32x2v uf[30 + CTS]; unsigned nx[CTS];
    { const bf16* gp = glu + (size_t)(sb - 30) * DM;
#pragma unroll
      for (int r = 0; r < 30; ++r) { const int si = sb + r - 30; const unsigned q = si >= 0 ? *(const unsigned*)gp : 0u; gp += DM; OPAQUE(gp); uf[r][0] = bf2f(q & 0xffff); uf[r][1] = bf2f(q >> 16); }
#pragma unroll
      for (int r = 0; r < CTS; ++r) { nx[r] = *(const unsigned*)gp; gp += DM; OPAQUE(gp); } }
#pragma unroll 1
    for (int step = 0; step < 64 / CTS; ++step) {
        const int s0 = sb + CTS * step, t0 = tb + CTS * step;
#pragma unroll
        for (int r = 0; r < CTS; ++r) { uf[30 + r][0] = bf2f(nx[r] & 0xffff); uf[30 + r][1] = bf2f(nx[r] >> 16); }
        float acc[CTS][2];
        { f32x2v ac2[CTS];
#pragma unroll
          for (int t = 0; t < CTS; ++t) { ac2[t][0] = b0; ac2[t][1] = b1; }
#pragma unroll
          for (int j = 0; j < 31; ++j) { const f32x2v w2 = *(const f32x2v*)(lw + j * DM + c0);
#ifndef EMU
              if ((j & 3) == 3) asm volatile("" ::: "memory");
#endif
#pragma unroll
              for (int t = 0; t < CTS; ++t) ac2[t] += w2 * uf[t + j]; }
#pragma unroll
          for (int t = 0; t < CTS; ++t) { acc[t][0] = ac2[t][0]; acc[t][1] = ac2[t][1]; } }
#pragma unroll
        for (int r = 0; r < 30; ++r) uf[r] = uf[r + CTS];
        if (step < 64 / CTS - 1) { const bf16* gp = glu + (size_t)(s0 + CTS) * DM;
#pragma unroll
            for (int r = 0; r < CTS; ++r) { nx[r] = *(const unsigned*)gp; gp += DM; OPAQUE(gp); } }
        { float* rb2 = red + (step & 1) * (8 * CTS * 2);
#pragma unroll
          for (int t = 0; t < CTS; ++t) { float s1 = act ? acc[t][0] + acc[t][1] : 0.f, s2 = act ? acc[t][0] * acc[t][0] + acc[t][1] * acc[t][1] : 0.f;
#pragma unroll
              for (int o = 1; o < 64; o <<= 1) { s1 += shflx(s1, o); s2 += shflx(s2, o); }
              if (lane == 0) { rb2[(w * CTS + t) * 2] = s1; rb2[(w * CTS + t) * 2 + 1] = s2; } }
          SYNC();
          if (act) {
              bf16* dst = (bf16*)(ws + WS_CAT) + (size_t)t0 * DM + c0;
#pragma unroll
              for (int t = 0; t < CTS; ++t) { float s1 = 0.f, s2 = 0.f;
#pragma unroll
                  for (int q = 0; q < 8; ++q) { s1 += rb2[(q * CTS + t) * 2]; s2 += rb2[(q * CTS + t) * 2 + 1]; }
                  const float mean = s1 * (1.0f / DM), var = fmaxf(s2 * (1.0f / DM) - mean * mean, 0.f), rstd = frsq(var + EPS);
                  const float y0 = (acc[t][0] - mean) * rstd * g0 + e0, y1 = (acc[t][1] - mean) * rstd * g1 + e1;
                  *(unsigned*)(dst + (size_t)t * DM) = pk2(siluf(y0), siluf(y1)); }
          } }
    }
}

constexpr int N_PHASES = 1 + 16 * (DEPTH / 2) + 1;
DEV void phase_decode(int ph, int& l, int& sub) {
    const int q = ph - 1, pair = q >> 4, r = q & 15;
    if (r < 9) { l = 2 * pair; sub = r; } else { l = 2 * pair + 1; const int rr = r - 9; sub = rr < 3 ? rr : rr + 2; }
}
constexpr int LDS_BYTES = 150 * 1024;

DEV void run_phase(const Args& a, unsigned char* smem, int ph) {
#ifndef ONLY
#define ONLY -1
#endif
#define EN(k) (ONLY < 0 || ONLY == (k))
    if (ph == 0) { if (EN(100)) p0_phase(a, smem); return; }
    if (ph == N_PHASES - 1) { if (EN(0)) norm_phase(a, smem, DEPTH); return; }
    int l, sub; phase_decode(ph, l, sub); const int li = l >> 1; const bool even = (l & 1) == 0;
    unsigned char* ws = wsp(a);
    switch (sub) {
    case 0: if (EN(0)) norm_phase(a, smem, l); break;
    case 1: if (even) { if (EN(1)) inproj_phase(a, smem, li); } else { if (EN(11)) pw1_phase(a, smem, li); } break;
    case 2:
        if (even) { constexpr int NCI = 8 * ((NCP + 255) / 256); constexpr int NH1 = 8 * NCH;
            if (NBLK > 2 * NCI) { const int bid = BID;
                if (bid < NCI) { if (EN(2)) cmp_phase_items(a, smem, li, bid); }
                else { for (int it = bid - NCI; it < NH1; it += NBLK - NCI) if (EN(12)) hg_h1_task(a, smem, it); } }
            else for (int it = BID; it < NCI + NH1; it += NBLK) { if (it < NCI) { if (EN(2)) cmp_phase_items(a, smem, li, it); } else { if (EN(12)) hg_h1_task(a, smem, it - NCI); } } }
        else { for (int it = BID; it < T / 64; it += NBLK) if (EN(13)) conv_task(a, smem, li, it); }
        break;
#ifdef EMU
    case 3:
        if (even) { constexpr int NA = 4 * (SEQ / 64); const int G = NBLK;
            for (int r = 0; r * G < NA; ++r) { const int it = r * G + ((r & 1) ? (G - 1 - BID) : BID); if (it < NA) { if (EN(3)) attn_task(a, smem, li, it); } }
            for (int it = BID; it < 64; it += NBLK) if (EN(14)) hg_scan_task(a, it); }
        break;
    case 4: if (even) { for (int it = BID; it < 8 * NCH; it += NBLK) if (EN(4)) hg_h3_task(a, smem, li, it); } break;
#else
    case 3:
        if (even) { constexpr int NA = 4 * (SEQ / 64); const int G = NBLK;
            typedef __attribute__((address_space(1))) unsigned gu32;
            gu32* cw = (gu32*)((unsigned*)(ws + WS_BAR) + P0_CTR_IDX + 1 + 2 * li);
            int nsc = 0;
            for (int it = BID; it < 64; it += NBLK) { hg_scan_task(a, it); ++nsc; }
            if (nsc > 0) { __builtin_amdgcn_fence(__ATOMIC_RELEASE, "agent"); asm volatile("s_waitcnt vmcnt(0)" ::: "memory"); SYNC(); if (TID == 0) (void)__hip_atomic_fetch_add(cw, (unsigned)nsc, __ATOMIC_RELAXED, __HIP_MEMORY_SCOPE_AGENT); }
            for (int r = 0; r * G < NA; ++r) { const int it = r * G + ((r & 1) ? (G - 1 - BID) : BID); if (it < NA) attn_task(a, smem, li, it); }
            if ((TID >> 6) == 0) { unsigned sp = 0u; gu32* tmo = (gu32*)((unsigned*)(ws + WS_BAR) + MOE_TMO_IDX);
                while ((unsigned)__builtin_amdgcn_readfirstlane((int)__hip_atomic_load(cw, __ATOMIC_RELAXED, __HIP_MEMORY_SCOPE_AGENT)) < 64u) {
                    __builtin_amdgcn_s_sleep(1);
                    if ((++sp & 255u) == 0u) { if (__hip_atomic_load(tmo, __ATOMIC_RELAXED, __HIP_MEMORY_SCOPE_AGENT)) break; if (sp > (1u << 22)) { (void)__hip_atomic_fetch_add(tmo, 1u, __ATOMIC_RELAXED, __HIP_MEMORY_SCOPE_AGENT); break; } } }
                __builtin_amdgcn_fence(__ATOMIC_ACQUIRE, "agent"); }
            int* nxl = (int*)(smem + LDS_BYTES - 64);
            int my_next = 0; if (TID == 0) my_next = (int)__hip_atomic_fetch_add(cw + 1, 1u, __ATOMIC_RELAXED, __HIP_MEMORY_SCOPE_AGENT);
            for (;;) { SYNC(); if (TID == 0) nxl[0] = my_next; SYNC(); const int it = nxl[0]; if (it >= 8 * NCH) break;
                if (TID == 0) my_next = (int)__hip_atomic_fetch_add(cw + 1, 1u, __ATOMIC_RELAXED, __HIP_MEMORY_SCOPE_AGENT);
                hg_h3_task(a, smem, li, it); } }
        break;
    case 4: break;
#endif
    case 5:
        if (!EN(5)) break;
        if (even) resid_gemm_phase(a, smem, (const bf16*)(ws + WS_CAT), 1024, (const bf16*)(ws + WS_WOUT) + (size_t)li * DM * 1024, l);
        else resid_gemm_phase(a, smem, (const bf16*)(ws + WS_CAT), DM, (const bf16*)(ws + WS_PW2) + (size_t)li * DM * DM, l);
        break;
    case 6: if (EN(6)) route_phase(a, smem, l); break;
#ifdef EMU
    case 7: if (EN(7)) moe_gemm_phase8(a, smem, l, 0); break;
    case 8: if (EN(8)) moe_gemm_phase8(a, smem, l, 1); break;
#else
    case 7: if (EN(7)) moe_fused_phase(a, smem, l); break;
    case 8: break;
#endif
    }
}

#ifndef EMU
#define LAS __attribute__((address_space(3)))
#define XB_TMO      128
static_assert(XB_TMO == MOE_TMO_IDX && P0_CTR_IDX > XB_TMO && P0_CTR_IDX + 1 + DEPTH < 256, "timeout word / free words");
#define XB_XCNT(j)  (256  + 64 * (j))
#define XB_XSUB(j)  (1280 + 64 * (j))
#define XB_XGEN(j)  (2304 + 64 * (j))
#define XB_TOP      3328
#define XB_TOPGEN   3392
#define XCD_BAR_WORDS 3456
#define XB_SPIN_CAP (1u << 22)
__device__ __forceinline__ unsigned xb_ld(unsigned* p)              { return __hip_atomic_load(p, __ATOMIC_RELAXED, __HIP_MEMORY_SCOPE_AGENT); }
__device__ __forceinline__ unsigned xb_add(unsigned* p, unsigned v) { return __hip_atomic_fetch_add(p, v, __ATOMIC_RELAXED, __HIP_MEMORY_SCOPE_AGENT); }
__device__ __forceinline__ unsigned xb_xcc_id() { return (unsigned)__builtin_amdgcn_s_getreg((3 << 11) | 20) & 0xFu; }
#define XB_SPIN(cond, bar) do { unsigned _sp = 0; while (cond) { __builtin_amdgcn_s_sleep(1); \
    if ((++_sp & 255u) == 0u) { if (xb_ld(&(bar)[XB_TMO])) break; if (_sp > XB_SPIN_CAP) { atomicAdd(&(bar)[XB_TMO], 1u); break; } } } } while (0)
struct XcdBarrier { unsigned* bar; unsigned x; volatile LAS unsigned* st; };
__device__ __forceinline__ XcdBarrier xcd_barrier_post(unsigned* bar, volatile LAS unsigned* st) {
    XcdBarrier b; b.bar = bar; b.x = xb_xcc_id(); b.st = st;
    if (threadIdx.x == 0) (void)xb_add(&bar[XB_XCNT(b.x)], 1u);
    return b;
}
__device__ __forceinline__ void xcd_barrier_complete(unsigned* bar, unsigned x, unsigned& nloc, unsigned& nx) {
    const unsigned G = gridDim.x * gridDim.y * gridDim.z;
    unsigned sum, cnt, mine, sp = 0u;
    for (;;) {
        sum = 0u; cnt = 0u; mine = 0u;
#pragma unroll
        for (unsigned j = 0; j < 16; ++j) { const unsigned c = xb_ld(&bar[XB_XCNT(j)]); sum += c; cnt += (c > 0u) ? 1u : 0u; mine = (j == x) ? c : mine; }
        if (sum == G) break;
        __builtin_amdgcn_s_sleep(1);
        if ((++sp & 255u) == 0u) { if (xb_ld(&bar[XB_TMO])) break; if (sp > XB_SPIN_CAP) { atomicAdd(&bar[XB_TMO], 1u); break; } }
    }
    nloc = mine > 0u ? mine : 1u; nx = cnt > 0u ? cnt : 1u;
}
__device__ __forceinline__ void xcd_barrier(const XcdBarrier& b) {
    asm volatile("s_waitcnt vmcnt(0)" ::: "memory");
    __syncthreads();
    if (threadIdx.x == 0) {
        unsigned* bar = b.bar;
        __builtin_amdgcn_s_waitcnt(0);
        unsigned nloc = b.st[0], nx = b.st[1];
        if (nloc == 0u) { xcd_barrier_complete(bar, b.x, nloc, nx); b.st[0] = nloc; b.st[1] = nx; }
        const unsigned old = xb_add(&bar[XB_XSUB(b.x)], 1u);
        const unsigned gen = old / nloc;
        if (old + 1u == (gen + 1u) * nloc) {
            __builtin_amdgcn_fence(__ATOMIC_RELEASE, "agent");
            asm volatile("s_waitcnt vmcnt(0)" ::: "memory");
            const unsigned og = xb_add(&bar[XB_TOP], 1u);
            const unsigned tg = og / nx;
            if (og + 1u == (tg + 1u) * nx) xb_add(&bar[XB_TOPGEN], 1u);
            else XB_SPIN(xb_ld(&bar[XB_TOPGEN]) == tg, bar);
            __builtin_amdgcn_fence(__ATOMIC_ACQUIRE, "agent");
            xb_add(&bar[XB_XGEN(b.x)], 1u);
            asm volatile("s_waitcnt vmcnt(0)" ::: "memory");
        } else {
            XB_SPIN(xb_ld(&bar[XB_XGEN(b.x)]) == gen, bar);
            __builtin_amdgcn_fence(__ATOMIC_ACQUIRE, "agent");
            asm volatile("s_waitcnt vmcnt(0)" ::: "memory");
        }
    }
    __syncthreads();
}

__global__ void __launch_bounds__(NT, 2) mega(Args a) {
    extern __shared__ __attribute__((aligned(16))) unsigned char lds[];
    volatile LAS unsigned* st = (volatile LAS unsigned*)(LAS unsigned char*)(lds + LDS_BYTES - 16);
    if (threadIdx.x < 4) st[threadIdx.x] = 0u;
    __syncthreads();
    unsigned* barw = (unsigned*)(a.ws + WS_BAR);
    XcdBarrier bar = xcd_barrier_post(barw, st);
#pragma unroll 1
    for (int ph = 0; ph < N_PHASES; ++ph) {
        if (ph > 0 && ph < N_PHASES - 1) { int l_, s_; phase_decode(ph, l_, s_); if (s_ == 8 || (s_ == 4 && (l_ & 1) == 0)) continue; }
        run_phase(a, lds, ph);
#ifdef DUP
        { int lyr = 0, sub = 100; if (ph > 0 && ph < N_PHASES - 1) phase_decode(ph, lyr, sub);
          if (sub == (DUP % 1000) && (ph == 0 || lyr == DUP / 1000) && ph < N_PHASES - 1) { xcd_barrier(bar); run_phase(a, lds, ph); } }
#endif
        if (ph + 1 < N_PHASES) xcd_barrier(bar);
    }
    if (xb_ld(&barw[XB_TMO]) != 0u) {
        const size_t gt = (size_t)blockIdx.x * NT + threadIdx.x, gs = (size_t)gridDim.x * NT;
        for (size_t i = gt; i < (size_t)T * DM; i += gs) a.out[i] = __builtin_nanf("");
    }
}

extern "C" void kernel_launch(void* const* d_in, const int* in_sizes, int n_in, void* d_out, int out_size,
                              void* d_ws, size_t ws_size, hipStream_t stream) {
    static int grid = 0;
    if (grid == 0) {
        int dev = 0, cus = 0;
        if (hipGetDevice(&dev) != hipSuccess || hipDeviceGetAttribute(&cus, hipDeviceAttributeMultiprocessorCount, dev) != hipSuccess) { grid = -1; return; }
        if (hipFuncSetAttribute((const void*)mega, hipFuncAttributeMaxDynamicSharedMemorySize, LDS_BYTES) != hipSuccess) { grid = -1; return; }
        (void)hipGetLastError();
        grid = cus;
        if (n_in != 26 || out_size != T * DM || ws_size < WS_END) { fprintf(stderr, "kernel_launch: unexpected sizes n_in %d out %d ws %zu (need %zu)\n", n_in, out_size, ws_size, (size_t)WS_END); grid = -1; return; }
    }
    if (grid < 0) return;
    (void)hipMemsetAsync((unsigned char*)d_ws + WS_BAR, 0, XCD_BAR_WORDS * 4, stream);
    Args a{};
    for (int i = 0; i < 26; ++i) a.in[i] = (const float*)d_in[i];
    a.out = (float*)d_out; a.ws = (unsigned char*)d_ws;
    hipLaunchKernelGGL(mega, dim3(grid), dim3(NT), LDS_BYTES, stream, a);
}
#endif
```

```cpp
#ifdef EMU
#include "emu.h"
#define DEV static inline
#define MDEV inline
#define OPAQUE(p)
#define OPAQUE2(a, b)
#define TID emu_tid()
#define BID (EB->bid)
#define NBLK (EB->nblk)
#define SYNC() emu_sync_block()
#define WSYNC() emu_sync_wave()
#define mfma16(a, b, c) emu_mfma16(a, b, c)
DEV float shflx(float v, int m) { return emu_shfl_f(v, (emu_tid() & 63) ^ m); }
DEV int shflxi(int v, int m) { return (int)emu_shfl_u((unsigned)v, (emu_tid() & 63) ^ m); }
DEV float shfl(float v, int s) { return emu_shfl_f(v, s); }
DEV float dpp_ror1(float v) { const int l = emu_tid() & 63; return emu_shfl_f(v, (l & 48) | ((l - 1) & 15)); }
DEV int atomic_add_i(int* p, int v) { return __atomic_fetch_add(p, v, __ATOMIC_RELAXED); }
typedef float f32x2v __attribute__((vector_size(8)));
DEV float fexp2(float x) { return exp2f(x); }
DEV float frcp(float x) { return 1.0f / x; }
DEV float frsq(float x) { return 1.0f / sqrtf(x); }
typedef short s16x4 __attribute__((vector_size(8)));
static inline s16x4 emu_tr4(const unsigned short* p) {
    EmuWave& w = EB->wave[emu_tid() >> 6]; int l = emu_tid() & 63;
    const unsigned short** tab = (const unsigned short**)w.a;
    tab[l] = p; emu_sync_wave();
    s16x4 r; int g = l & 48, i = l & 15;
    for (int q = 0; q < 4; ++q) r[q] = (short)tab[g + 4 * q + (i >> 2)][i & 3];
    emu_sync_wave(); return r;
}
#define tr4(p) emu_tr4(p)
#else
#include <hip/hip_runtime.h>
#include <cstdio>
#include <cstdint>
typedef short bf16x8 __attribute__((ext_vector_type(8)));
typedef float f32x4 __attribute__((ext_vector_type(4)));
typedef unsigned u32x4 __attribute__((ext_vector_type(4)));
typedef unsigned u32x2 __attribute__((ext_vector_type(2)));
#define DEV __device__ __forceinline__
#define MDEV __device__ __forceinline__
#define OPAQUE(p) asm volatile("" : "+v"(p))
#define OPAQUE2(a, b) asm volatile("" : "+v"(a), "+v"(b))
DEV int tid_opaque() { int t = (int)threadIdx.x; asm volatile("" : "+v"(t)); return t; }
#define TID tid_opaque()
DEV int bid_opaque() { int b = (int)blockIdx.x; asm volatile("" : "+s"(b)); return b; }
#define BID bid_opaque()
#define NBLK ((int)gridDim.x)
#define SYNC() __syncthreads()
#define WSYNC() __builtin_amdgcn_wave_barrier()
#define mfma16(a, b, c) __builtin_amdgcn_mfma_f32_16x16x32_bf16(a, b, c, 0, 0, 0)
DEV int shflxi(int x, int m) {
    if (m == 1) return __builtin_amdgcn_update_dpp(x, x, 0xB1, 0xf, 0xf, true);
    if (m == 2) return __builtin_amdgcn_update_dpp(x, x, 0x4E, 0xf, 0xf, true);
    if (m == 4) return __builtin_amdgcn_ds_swizzle(x, (4 << 10) | 0x1F);
    if (m == 8) return __builtin_amdgcn_ds_swizzle(x, (8 << 10) | 0x1F);
    if (m == 16) return __builtin_amdgcn_ds_swizzle(x, (16 << 10) | 0x1F);
    if (m == 32) { const auto r = __builtin_amdgcn_permlane32_swap((unsigned)x, (unsigned)x, false, false); return (int)((threadIdx.x & 32) ? r[0] : r[1]); }
    return __shfl_xor(x, m);
}
DEV float shflx(float v, int m) { return __builtin_bit_cast(float, shflxi(__builtin_bit_cast(int, v), m)); }
DEV float dpp_ror1(float v) { return __builtin_bit_cast(float, __builtin_amdgcn_update_dpp(0, __builtin_bit_cast(int, v), 0x121, 0xf, 0xf, false)); }
DEV float shfl(float v, int s) { return __shfl(v, s); }
DEV int atomic_add_i(int* p, int v) { return atomicAdd(p, v); }
DEV float fexp2(float x) { return __builtin_amdgcn_exp2f(x); }
DEV float frcp(float x) { return __builtin_amdgcn_rcpf(x); }
DEV float frsq(float x) { return __builtin_amdgcn_rsqf(x); }
typedef short s16x4 __attribute__((ext_vector_type(4)));
#define tr4(p) __builtin_amdgcn_ds_read_tr16_b64_v4i16((__attribute__((address_space(3))) s16x4*)(p))
#endif

typedef unsigned short bf16;

#ifndef DM
#define DM 1024
#endif
#ifndef SEQ
#define SEQ 8192
#endif
#ifndef FF
#define FF 512
#endif
constexpr int NBATCH = 2, T = NBATCH * SEQ, DEPTH = 4;
constexpr int NIN = 3352, NINP = 3456, NIN8 = 3584;
constexpr int NT = 512;
constexpr int NCH = SEQ / 64;
constexpr int NCP = SEQ / 16;
constexpr int NCMP = NCP - 1;
constexpr int MOE_ROWS = 2 * T + 32 * 256;
constexpr float EPS = 1e-6f, NEGV = -1e30f, FORCEV = 1e4f, LOG2E = 1.4426950408889634f;

constexpr size_t al(size_t x) { return (x + 255) & ~(size_t)255; }
constexpr int P0_CTR_IDX = 192;
constexpr size_t WS_BAR = 0;
constexpr size_t WS_CNT = 16384;
constexpr size_t WS_MOD = WS_CNT + (size_t)DEPTH * 32 * 256;
constexpr size_t WS_LB = al(WS_MOD + (size_t)DEPTH * 2 * 6 * DM * 4);
constexpr size_t WS_CB = al(WS_LB + 2 * 512 * 4);
constexpr size_t WS_CS = al(WS_CB + 2 * 2 * 8 * 64 * 4);
constexpr size_t WS_WIN = al(WS_CS + 64);
constexpr size_t WS_WOUT = al(WS_WIN + (size_t)2 * NIN8 * DM * 2);
constexpr size_t WS_PW1 = al(WS_WOUT + (size_t)2 * DM * 1024 * 2);
constexpr size_t WS_PW2 = al(WS_PW1 + (size_t)2 * 2 * DM * DM * 2);
constexpr size_t WS_WC = al(WS_PW2 + (size_t)2 * DM * DM * 2);
constexpr size_t WS_W13 = al(WS_WC + (size_t)2 * 2 * 64 * 2048 * 2);
constexpr size_t WS_W2 = al(WS_W13 + (size_t)DEPTH * 32 * 2 * FF * DM * 2);
constexpr size_t WS_H = al(WS_W2 + (size_t)DEPTH * 32 * DM * FF * 2);
constexpr size_t WS_QN = al(WS_H + (size_t)T * DM * 2);
constexpr size_t WS_KCG = al(WS_QN + (size_t)T * 512 * 2);
constexpr size_t WS_VCG = al(WS_KCG + (size_t)T * 128 * 2);
constexpr size_t WS_KS = al(WS_VCG + (size_t)T * 128 * 2);
constexpr size_t WS_KW = al(WS_KS + (size_t)T * 128 * 2);
constexpr size_t WS_VST = al(WS_KW + (size_t)T * 128 * 2);
constexpr size_t WS_VWT = al(WS_VST + (size_t)T * 128 * 2);
constexpr size_t WS_KC = al(WS_VWT + (size_t)T * 128 * 2);
constexpr size_t WS_VCT = al(WS_KC + (size_t)4 * NCP * 64 * 2);
constexpr size_t WS_GATE = al(WS_VCT + (size_t)4 * NCP * 64 * 2);
constexpr size_t WS_HQ = al(WS_GATE + (size_t)T * 24 * 4);
constexpr size_t WS_HF = al(WS_HQ + (size_t)T * 512 * 2);
constexpr size_t WS_HV = al(WS_HF + (size_t)T * 512 * 4);
constexpr size_t WS_HGS = al(WS_HV + (size_t)T * 512 * 2);
constexpr size_t WS_UT = al(WS_HGS + (size_t)T * 512 * 2);
constexpr size_t WS_ST = al(WS_UT + (size_t)8 * NCH * 128 * 128 * 4);
constexpr size_t WS_GD = al(WS_ST + (size_t)8 * NCH * 128 * 128 * 2);
constexpr size_t WS_CAT = al(WS_GD + (size_t)8 * NCH * 128 * 4);
constexpr size_t WS_GLU = al(WS_CAT + (size_t)T * 1024 * 2);
constexpr size_t WS_TIE = al(WS_GLU + (size_t)T * DM * 2);
constexpr size_t WS_TIW = al(WS_TIE + (size_t)T * 2 * 4);
constexpr size_t WS_LIST = al(WS_TIW + (size_t)T * 2 * 4);
constexpr size_t WS_ACT = al(WS_LIST + (size_t)32 * T * 4);
constexpr size_t WS_YK = al(WS_ACT + (size_t)MOE_ROWS * FF * 2);
constexpr size_t WS_WTH = al(WS_YK + (size_t)MOE_ROWS * DM * 2);
constexpr size_t WS_WTL = al(WS_WTH + (size_t)DEPTH * 48 * DM * 2);
constexpr size_t WS_AVEC = al(WS_WTL + (size_t)DEPTH * 48 * DM * 2);
constexpr size_t WS_RBIAS = al(WS_AVEC + (size_t)DEPTH * 2 * DM * 4);
constexpr size_t WS_FLG = al(WS_RBIAS + (size_t)DEPTH * 2 * 48 * 4);
constexpr size_t WS_END = al(WS_FLG + (size_t)DEPTH * 256 * 64);

struct Args { const float* in[26]; float* out; unsigned char* ws; };
enum { I_X = 0, I_C, I_ADAW, I_ADAB, I_NMIX, I_NFFN, I_WIN, I_WOUT, I_CWK, I_CWV, I_CPE, I_QG, I_KG, I_LBL, I_OG,
       I_PW1, I_DW, I_DWB, I_LNG, I_LNB, I_PW2, I_WG, I_WE, I_W1, I_W3, I_W2 };

#ifdef EMU
DEV unsigned char* wsp(const Args& a) { return a.ws; }
DEV float* outp(const Args& a) { return a.out; }
#else
DEV unsigned char* launder_ptr(const void* p) { unsigned long long v = (unsigned long long)p; unsigned lo = (unsigned)v, hi = (unsigned)(v >> 32);
    lo = (unsigned)__builtin_amdgcn_readfirstlane((int)lo); hi = (unsigned)__builtin_amdgcn_readfirstlane((int)hi); asm volatile("" : "+s"(lo), "+s"(hi)); typedef __attribute__((address_space(1))) unsigned char* gptr_t; return (unsigned char*)(gptr_t)(((unsigned long long)hi << 32) | lo); }
DEV unsigned char* wsp(const Args& a) { return launder_ptr(a.ws); }
DEV float* outp(const Args& a) { return (float*)launder_ptr(a.out); }
#endif

#ifdef EMU
#define INP(a, X) ((a).in[X])
#else
DEV int zero_opaque() { int z = 0; asm volatile("" : "+s"(z)); return z; }
#define INP(a, X) ((a).in[(X) + zero_opaque()])
#endif

DEV unsigned f2bf(float f) { unsigned u = __builtin_bit_cast(unsigned, f); return (u + 0x7fffu + ((u >> 16) & 1u)) >> 16; }
DEV float bf2f(unsigned h) { return __builtin_bit_cast(float, h << 16); }
#ifdef EMU
DEV unsigned pk2(float lo, float hi) { return f2bf(lo) | (f2bf(hi) << 16); }
#else
typedef float f32x2_t __attribute__((ext_vector_type(2)));
typedef float f32x2v __attribute__((ext_vector_type(2)));
typedef __bf16 bf16x2_t __attribute__((ext_vector_type(2)));
DEV unsigned pk2(float lo, float hi) { f32x2_t v = {lo, hi}; bf16x2_t b = __builtin_convertvector(v, bf16x2_t); return __builtin_bit_cast(unsigned, b); }
#endif
DEV float sigm(float x) { return frcp(1.0f + fexp2(-x * LOG2E)); }
DEV float siluf(float x) { return x * sigm(x); }
DEV f32x4 f4zero() { f32x4 z = {0.f, 0.f, 0.f, 0.f}; return z; }
DEV bf16x8 pack8(f32x4 a, f32x4 b) {
    u32x4 w; w[0] = pk2(a[0], a[1]); w[1] = pk2(a[2], a[3]); w[2] = pk2(b[0], b[1]); w[3] = pk2(b[2], b[3]);
    return __builtin_bit_cast(bf16x8, w);
}
DEV void st_bf8(bf16* p, f32x4 a, f32x4 b) { u32x4 w; w[0] = pk2(a[0], a[1]); w[1] = pk2(a[2], a[3]); w[2] = pk2(b[0], b[1]); w[3] = pk2(b[2], b[3]); *(u32x4*)p = w; }
DEV void st_bf4(bf16* p, f32x4 v) { u32x2 w; w[0] = pk2(v[0], v[1]); w[1] = pk2(v[2], v[3]); *(u32x2*)p = w; }


#ifdef EMU
namespace pg8 {
constexpr int BM = 256, BK = 64, HALF = 128, NXCD = 8, WGM = 8;
typedef unsigned short bf16_t;
struct Unit { int pm, pn; };
struct Gemm { const bf16_t* A; const bf16_t* Bt; int M, N, K; };
struct StaticOrder {
    int nM, nN, nwg, G, c;
    void init(int M, int N, int G_, int c_) { nM = M / BM; nN = N / BM; nwg = nM * nN; G = G_; c = c_; }
    bool next(int i, Unit& u) const {
        const long L = (long)i * G + c; if (L >= nwg) return false;
        int wgid = (int)L; { const int q = nwg / NXCD, r = nwg % NXCD, xcd = wgid % NXCD, off = wgid / NXCD; wgid = (xcd < r ? xcd * (q + 1) : r * (q + 1) + (xcd - r) * q) + off; }
        const int nig = WGM * nN, gid = wgid / nig, fm = gid * WGM, gsz = (nM - fm) < WGM ? (nM - fm) : WGM;
        u.pm = fm + ((wgid % nig) % gsz); u.pn = (wgid % nig) / gsz; return true;
    }
};
struct SelNone { static constexpr bool GATHER = false; struct Ctx {}; Ctx ctx(const Unit&) const { return Ctx(); } size_t boff(const Ctx&) const { return 0; } unsigned aoff(const Ctx&, int) const { return 0u; } };
template <class Epi, class Sched, bool ALIGN_EPI = false, bool SP2 = false, class Sel = SelNone>
static inline void gemm_phase(unsigned char*, const Gemm g, const Sched& S, const Epi& E, const Sel& X = Sel()) {
    const int tid = emu_tid(), wid = tid >> 6, lane = tid & 63, wr = wid >> 2, wc = wid & 3, fr = lane & 15, fq = lane >> 4;
    Unit u;
    for (int ui = 0; S.next(ui, u); ++ui) {
        f32x4 acc[2][2][4][2]; const auto cx = X.ctx(u);
        for (int ai = 0; ai < 2; ++ai) for (int bj = 0; bj < 2; ++bj) for (int m = 0; m < 4; ++m) for (int n = 0; n < 2; ++n) for (int r = 0; r < 4; ++r) {
            const int row = 256 * u.pm + 128 * ai + 64 * wr + 16 * m + fr, col = 256 * u.pn + 128 * bj + 32 * wc + (Epi::PERM ? 8 * fq + 4 * n + r : 16 * n + 4 * fq + r); float sum = 0.f;
            const bf16_t* ap = Sel::GATHER ? (const bf16_t*)((const char*)g.A + X.aoff(cx, row - 256 * u.pm)) : g.A + (size_t)row * g.K; const bf16_t* bp = (const bf16_t*)((const char*)g.Bt + X.boff(cx)) + (size_t)col * g.K;
            for (int k = 0; k < g.K; ++k) sum += bf2f(ap[k]) * bf2f(bp[k]);
            acc[ai][bj][m][n][r] = sum; }
        E(acc, u, wr, wc, fr, fq);
    }
    emu_sync_block();
}
}
#else
namespace pg8 {
#define PG8_LAS __attribute__((address_space(3)))
typedef unsigned short bf16_t;
typedef short bf16x8 __attribute__((ext_vector_type(8)));
typedef float f32x4 __attribute__((ext_vector_type(4)));
typedef unsigned u32x4 __attribute__((ext_vector_type(4)));
constexpr int BM = 256, BK = 64, HALF = 128, HTB = HALF * BK * 2  , STAGE_BYTES = 8 * HTB, NXCD = 8, WGM = 8;

__host__ __device__ __forceinline__ int lds_byte(int r, int c) { const int st = (r >> 4) * 2 + (c >> 5), rr = r & 15, cc = c & 31, ob = rr * 64 + cc * 2; return st * 1024 + (ob ^ (((ob >> 9) & 1) << 5)); }
__host__ __device__ __forceinline__ void stage_rc(int b, int& R, int& C) { const int st = b / 1024, sb = b % 1024, swz = sb ^ (((sb >> 9) & 1) << 5); R = (st >> 1) * 16 + swz / 64; C = (st & 1) * 32 + (swz % 64) / 2; }
__host__ __device__ __forceinline__ int perm32(int rho) { const int n = rho >> 4, i = rho & 15; return 8 * (i >> 2) + 4 * n + (i & 3); }

struct Unit { int pm, pn; };
struct Gemm { const bf16_t* A; const bf16_t* Bt; int M, N, K; };

struct StaticOrder {
    int nM, nN, nwg, G, c;
    __host__ __device__ void init(int M, int N, int G_, int c_) { nM = M / BM; nN = N / BM; nwg = nM * nN; G = G_; c = c_; }
    __host__ __device__ bool next(int i, Unit& u) const {
        const long L = (long)i * G + c; if (L >= nwg) return false;
        int wgid = (int)L; { const int q = nwg / NXCD, r = nwg % NXCD, xcd = wgid % NXCD, off = wgid / NXCD; wgid = (xcd < r ? xcd * (q + 1) : r * (q + 1) + (xcd - r) * q) + off; }
        const int nig = WGM * nN, gid = wgid / nig, fm = gid * WGM, gsz = (nM - fm) < WGM ? (nM - fm) : WGM;
        u.pm = fm + ((wgid % nig) % gsz); u.pn = (wgid % nig) / gsz; return true;
    }
    __device__ __forceinline__ void a_ready(const Unit&) const {}
    __device__ __forceinline__ void done(const Unit&) const {}
};

__device__ __forceinline__ unsigned cvt_pk_bf16(float lo, float hi) { unsigned r; asm volatile("v_cvt_pk_bf16_f32 %0, %1, %2" : "=v"(r) : "v"(lo), "v"(hi)); return r; }
struct SelNone { static constexpr bool GATHER = false; struct Ctx {}; __device__ __forceinline__ Ctx ctx(const Unit&) const { return Ctx(); } __device__ __forceinline__ size_t boff(const Ctx&) const { return 0; } __device__ __forceinline__ unsigned aoff(const Ctx&, int) const { return 0u; } };
template <class Epi, class Sched, bool ALIGN_EPI = false, bool SP2 = false, class Sel = SelNone>
__device__ __forceinline__ void gemm_phase(PG8_LAS unsigned char* lds, const Gemm g, const Sched& S, const Epi& E, const Sel& X = Sel()) {
    constexpr bool GA = Sel::GATHER;
    const int tid = TID, wid = __builtin_amdgcn_readfirstlane(tid >> 6), lane = tid & 63, wr = wid >> 2, wc = wid & 3, fr = lane & 15, fq = lane >> 4;
    const int K = g.K, nt = K / BK;
    unsigned voffA[2], voffB[2]; int Rl[2]; unsigned Cl2[2];
#pragma unroll
    for (int i = 0; i < 2; ++i) { int R, C; stage_rc(tid * 16 + i * 8192, R, C); const int Rb = Epi::PERM ? ((R & ~31) + perm32(R & 31)) : R;
        voffA[i] = (unsigned)(R * K + C) * 2u; voffB[i] = (unsigned)(Rb * K + C) * 2u; Rl[i] = R; Cl2[i] = (unsigned)C * 2u; }
    unsigned vA[2][2], vAn[2][2];
    const size_t kstep = (size_t)(BK * 2);
    const size_t hstep = (size_t)HALF * K * 2;
    const size_t tstep = 2 * hstep;
    const unsigned ldsw = (unsigned)wid * 1024u;
    const int aoff = lds_byte(wr * 64 + fr, fq * 8), boff = lds_byte(wc * 32 + fr, fq * 8);
#define PG8_SA(b, h) (((b) * 2 + (h)) * HTB)
#define PG8_SB(b, h) ((4 + (b) * 2 + (h)) * HTB)
#define PG8_STAGE(bufoff, gbase, voff) do { _Pragma("unroll") for (int _i = 0; _i < 2; ++_i) \
        __builtin_amdgcn_global_load_lds((const unsigned*)((const char*)(gbase) + (voff)[_i]), (PG8_LAS unsigned*)(lds + (bufoff) + ldsw + _i * 8192), 16, 0, 0); } while (0)
#define PG8_STAGE_A(bufoff, p, h, nx) do { if constexpr (GA) { unsigned _vo[2] = {(nx) ? vAn[h][0] : vA[h][0], (nx) ? vAn[h][1] : vA[h][1]}; PG8_STAGE(bufoff, p, _vo); } else { PG8_STAGE(bufoff, (p) + (h) * hstep, voffA); } } while (0)
#define PG8_GATH(cx, dst) do { _Pragma("unroll") for (int _h = 0; _h < 2; ++_h) _Pragma("unroll") for (int _i = 0; _i < 2; ++_i) dst[_h][_i] = X.aoff(cx, 128 * _h + Rl[_i]) + Cl2[_i]; } while (0)
#define PG8_LDA(dst, b, h) do { _Pragma("unroll") for (int m = 0; m < 4; ++m) _Pragma("unroll") for (int k = 0; k < 2; ++k) dst[m][k] = *(const PG8_LAS bf16x8*)(lds + PG8_SA(b, h) + aoff + m * 2048 + k * 1024); } while (0)
#define PG8_LDB(dst, b, h) do { _Pragma("unroll") for (int n = 0; n < 2; ++n) _Pragma("unroll") for (int k = 0; k < 2; ++k) dst[n][k] = *(const PG8_LAS bf16x8*)(lds + PG8_SB(b, h) + boff + n * 2048 + k * 1024); } while (0)
#define PG8_MMA(ai, bj, At, Bt) do { __builtin_amdgcn_s_setprio(1); _Pragma("unroll") for (int m = 0; m < 4; ++m) _Pragma("unroll") for (int n = 0; n < 2; ++n) _Pragma("unroll") for (int k = 0; k < 2; ++k) \
        acc[ai][bj][m][n] = __builtin_amdgcn_mfma_f32_16x16x32_bf16(Bt[n][k], At[m][k], acc[ai][bj][m][n], 0, 0, 0); __builtin_amdgcn_s_setprio(0); } while (0)
#define PG8_WAIT_V(n) asm volatile("s_waitcnt vmcnt(" #n ")" ::: "memory")
#define PG8_WAIT_L(n) asm volatile("s_waitcnt lgkmcnt(" #n ")" ::: "memory")
#define PG8_BAR __builtin_amdgcn_s_barrier()
#define PG8_SCHED __builtin_amdgcn_sched_barrier(0)
    Unit cur, nxt; int ui = 0;
    if (!S.next(0, cur)) return;
    f32x4 acc[2][2][4][2];
#pragma unroll
    for (int a = 0; a < 2; ++a)
#pragma unroll
        for (int b = 0; b < 2; ++b)
#pragma unroll
            for (int m = 0; m < 4; ++m)
#pragma unroll
                for (int n = 0; n < 2; ++n) acc[a][b][m][n] = (f32x4){0.f, 0.f, 0.f, 0.f};
    bf16x8 At[4][2], B0[2][2], B1[2][2];
    auto ccx = X.ctx(cur);
    const char* cA = GA ? (const char*)g.A : (const char*)g.A + (size_t)cur.pm * tstep; const char* cB = (const char*)g.Bt + X.boff(ccx) + (size_t)cur.pn * tstep;
    if constexpr (GA) { PG8_GATH(ccx, vA); }
    S.a_ready(cur);
    if constexpr (SP2) {
        PG8_STAGE(PG8_SB(0, 0), cB, voffB); PG8_STAGE(PG8_SB(0, 1), cB + hstep, voffB); PG8_STAGE_A(PG8_SA(0, 0), cA, 0, false); PG8_STAGE_A(PG8_SA(0, 1), cA, 1, false);
        if (wr == 1) PG8_BAR;
        PG8_WAIT_V(2); PG8_BAR;
        PG8_STAGE(PG8_SB(1, 0), cB + kstep, voffB); PG8_STAGE_A(PG8_SA(1, 0), cA + kstep, 0, false); PG8_STAGE(PG8_SB(1, 1), cB + hstep + kstep, voffB);
        PG8_WAIT_V(6); PG8_BAR;
    } else {
        PG8_STAGE(PG8_SB(0, 0), cB, voffB); PG8_STAGE_A(PG8_SA(0, 0), cA, 0, false); PG8_STAGE(PG8_SB(0, 1), cB + hstep, voffB); PG8_STAGE_A(PG8_SA(0, 1), cA, 1, false);
        if (wr == 1) PG8_BAR;
        PG8_WAIT_V(4); PG8_BAR;
        PG8_STAGE(PG8_SB(1, 0), cB + kstep, voffB); PG8_STAGE_A(PG8_SA(1, 0), cA + kstep, 0, false); PG8_STAGE(PG8_SB(1, 1), cB + hstep + kstep, voffB);
        PG8_WAIT_V(6); PG8_BAR;
    }
    for (;;) {
        const bool has_next = S.next(ui + 1, nxt);
        const char* nA = cA; const char* nB = cB;
        if (has_next) { const auto ncx = X.ctx(nxt); nA = GA ? (const char*)g.A : (const char*)g.A + (size_t)nxt.pm * tstep; nB = (const char*)g.Bt + X.boff(ncx) + (size_t)nxt.pn * tstep; if constexpr (GA) { PG8_GATH(ncx, vAn); } }
        else if constexpr (GA) {
#pragma unroll
            for (int _h = 0; _h < 2; ++_h) { vAn[_h][0] = vA[_h][0]; vAn[_h][1] = vA[_h][1]; } }
        for (int t = 0; t < nt; t += 2) {
            const bool last = (t == nt - 2);
            const char* a1 = cA + (size_t)(t + 1) * kstep;
            const char* a2 = last ? nA : cA + (size_t)(t + 2) * kstep; const char* b2 = last ? nB : cB + (size_t)(t + 2) * kstep;
            const char* a3 = a2 + kstep; const char* b3 = b2 + kstep;
            if (last && has_next) S.a_ready(nxt);
            if constexpr (SP2) {
            PG8_LDB(B0, 0, 0); PG8_LDB(B1, 0, 1); PG8_SCHED; PG8_LDA(At, 0, 0); PG8_STAGE_A(PG8_SA(1, 1), a1, 1, false);
            PG8_WAIT_V(8); PG8_WAIT_L(0); PG8_BAR; PG8_MMA(0, 0, At, B0); PG8_MMA(0, 1, At, B1); PG8_BAR; PG8_SCHED;
            PG8_LDA(At, 0, 1); PG8_STAGE(PG8_SB(0, 0), b2, voffB); PG8_STAGE(PG8_SB(0, 1), b2 + hstep, voffB); PG8_STAGE_A(PG8_SA(0, 0), a2, 0, last);
            PG8_WAIT_V(8); PG8_WAIT_L(0); PG8_BAR; PG8_MMA(1, 0, At, B0); PG8_MMA(1, 1, At, B1); PG8_BAR; PG8_SCHED;
            PG8_LDB(B0, 1, 0); PG8_LDB(B1, 1, 1); PG8_SCHED; PG8_LDA(At, 1, 0); PG8_STAGE_A(PG8_SA(0, 1), a2, 1, last);
            PG8_WAIT_V(8); PG8_WAIT_L(0); PG8_BAR; PG8_MMA(0, 0, At, B0); PG8_MMA(0, 1, At, B1); PG8_BAR; PG8_SCHED;
            PG8_LDA(At, 1, 1); PG8_STAGE(PG8_SB(1, 0), b3, voffB); PG8_STAGE(PG8_SB(1, 1), b3 + hstep, voffB); PG8_STAGE_A(PG8_SA(1, 0), a3, 0, last);
            PG8_WAIT_V(8); PG8_WAIT_L(0); PG8_BAR; PG8_MMA(1, 0, At, B0); PG8_MMA(1, 1, At, B1); PG8_BAR; PG8_SCHED;
            } else {
            PG8_LDB(B0, 0, 0); PG8_SCHED; PG8_LDA(At, 0, 0); PG8_STAGE_A(PG8_SA(1, 1), a1, 1, false);
            PG8_WAIT_L(8); PG8_BAR; PG8_WAIT_L(0); PG8_MMA(0, 0, At, B0); PG8_BAR; PG8_SCHED;
            PG8_LDB(B1, 0, 1); PG8_STAGE(PG8_SB(0, 0), b2, voffB);
            PG8_BAR; PG8_WAIT_L(0); PG8_MMA(0, 1, At, B1); PG8_BAR;
            PG8_LDA(At, 0, 1); PG8_STAGE_A(PG8_SA(0, 0), a2, 0, last);
            PG8_BAR; PG8_WAIT_L(0); PG8_MMA(1, 0, At, B0); PG8_BAR; PG8_SCHED;
            PG8_STAGE(PG8_SB(0, 1), b2 + hstep, voffB);
            PG8_WAIT_V(6); PG8_BAR; PG8_MMA(1, 1, At, B1); PG8_BAR;
            PG8_LDB(B0, 1, 0); PG8_SCHED; PG8_LDA(At, 1, 0); PG8_STAGE_A(PG8_SA(0, 1), a2, 1, last);
            PG8_WAIT_L(8); PG8_BAR; PG8_WAIT_L(0); PG8_MMA(0, 0, At, B0); PG8_BAR; PG8_SCHED;
            PG8_LDB(B1, 1, 1); PG8_STAGE(PG8_SB(1, 0), b3, voffB);
            PG8_BAR; PG8_WAIT_L(0); PG8_MMA(0, 1, At, B1); PG8_BAR;
            PG8_LDA(At, 1, 1); PG8_STAGE_A(PG8_SA(1, 0), a3, 0, last);
            PG8_BAR; PG8_WAIT_L(0); PG8_MMA(1, 0, At, B0); PG8_BAR; PG8_SCHED;
            PG8_STAGE(PG8_SB(1, 1), b3 + hstep, voffB);
            PG8_WAIT_V(6); PG8_BAR; PG8_MMA(1, 1, At, B1); PG8_BAR;
            }
        }
        if constexpr (ALIGN_EPI) { if (wr == 0) PG8_BAR; }
        if constexpr (!Epi::AFTER_DRAIN) { E(acc, cur, wr, wc, fr, fq); S.done(cur); }
        if (!has_next) break;
#pragma unroll
        for (int a = 0; a < 2; ++a)
#pragma unroll
            for (int b = 0; b < 2; ++b)
#pragma unroll
                for (int m = 0; m < 4; ++m)
#pragma unroll
                    for (int n = 0; n < 2; ++n) acc[a][b][m][n] = (f32x4){0.f, 0.f, 0.f, 0.f};
        cur = nxt; cA = nA; cB = nB; ++ui;
        if constexpr (GA) {
#pragma unroll
            for (int _h = 0; _h < 2; ++_h) { vA[_h][0] = vAn[_h][0]; vA[_h][1] = vAn[_h][1]; } }
        if constexpr (ALIGN_EPI) { if (wr == 1) PG8_BAR; }
    }
    PG8_WAIT_V(0);
    if constexpr (!ALIGN_EPI) { if (wr == 0) PG8_BAR; }
    PG8_BAR;
    if constexpr (Epi::AFTER_DRAIN) { E.fused(acc, cur, wr, wc, fr, fq, lds, wid, lane); S.done(cur); }
#undef PG8_SA
#undef PG8_SB
#undef PG8_STAGE
#undef PG8_STAGE_A
#undef PG8_GATH
#undef PG8_LDA
#undef PG8_LDB
#undef PG8_MMA
#undef PG8_WAIT_V
#undef PG8_WAIT_L
#undef PG8_BAR
#undef PG8_SCHED
}
}
#endif

constexpr int LDT = 72;
constexpr int GEMM_AS = 256 * LDT, GEMM_BS = 128 * LDT;
constexpr int GEMM_LDS = 2 * (GEMM_AS + GEMM_BS) * 2;

template <class AF, class EPI>
DEV void gemm_tile(unsigned char* smem, AF af, const bf16* Bt, int ldb, int nvalid, int K, EPI& epi) {
    const int tid = TID, w = tid >> 6, l = tid & 63, h = l >> 4, c = l & 15, wm = w >> 1, wn = w & 1;
    bf16* As = (bf16*)smem; bf16* Bs = As + 2 * GEMM_AS;
    const bf16* ap[4]; const bf16* bp[2];
    const int col8 = (tid & 7) * 8, r0 = tid >> 3;
#pragma unroll
    for (int i = 0; i < 4; ++i) ap[i] = af(r0 + 64 * i) + col8;
#pragma unroll
    for (int i = 0; i < 2; ++i) { int rn = r0 + 64 * i; if (rn >= nvalid) rn = nvalid - 1; bp[i] = Bt + (size_t)rn * ldb + col8; }
    f32x4 acc[4][4];
#pragma unroll
    for (int i = 0; i < 4; ++i)
#pragma unroll
        for (int j = 0; j < 4; ++j) acc[i][j] = f4zero();
    bf16x8 ra[4], rb[2];
#pragma unroll
    for (int i = 0; i < 4; ++i) ra[i] = *(const bf16x8*)(ap[i]);
#pragma unroll
    for (int i = 0; i < 2; ++i) rb[i] = *(const bf16x8*)(bp[i]);
    SYNC();
#pragma unroll
    for (int i = 0; i < 4; ++i) *(bf16x8*)(As + (r0 + 64 * i) * LDT + col8) = ra[i];
#pragma unroll
    for (int i = 0; i < 2; ++i) *(bf16x8*)(Bs + (r0 + 64 * i) * LDT + col8) = rb[i];
    SYNC();
    const int nk = K / 64;
    for (int kt = 0; kt < nk; ++kt) {
        const int cur = kt & 1;
        if (kt + 1 < nk) {
#pragma unroll
            for (int i = 0; i < 4; ++i) ra[i] = *(const bf16x8*)(ap[i] + (kt + 1) * 64);
#pragma unroll
            for (int i = 0; i < 2; ++i) rb[i] = *(const bf16x8*)(bp[i] + (kt + 1) * 64);
        }
        const bf16* Ac = As + cur * GEMM_AS + (wm * 64 + c) * LDT + 8 * h;
        const bf16* Bc = Bs + cur * GEMM_BS + (wn * 64 + c) * LDT + 8 * h;
#pragma unroll
        for (int kk = 0; kk < 2; ++kk) {
            bf16x8 fa[4], fb[4];
#pragma unroll
            for (int i = 0; i < 4; ++i) { fa[i] = *(const bf16x8*)(Ac + i * 16 * LDT + kk * 32); fb[i] = *(const bf16x8*)(Bc + i * 16 * LDT + kk * 32); }
#pragma unroll
            for (int ni = 0; ni < 4; ++ni)
#pragma unroll
                for (int mi = 0; mi < 4; ++mi) acc[ni][mi] = mfma16(fb[ni], fa[mi], acc[ni][mi]);
        }
        if (kt + 1 < nk) {
            const int nx = cur ^ 1;
#pragma unroll
            for (int i = 0; i < 4; ++i) *(bf16x8*)(As + nx * GEMM_AS + (r0 + 64 * i) * LDT + col8) = ra[i];
#pragma unroll
            for (int i = 0; i < 2; ++i) *(bf16x8*)(Bs + nx * GEMM_BS + (r0 + 64 * i) * LDT + col8) = rb[i];
        }
        SYNC();
    }
    epi(acc, wm * 64, wn * 64, h, c);
}

struct ARows { const bf16* base; size_t ld; MDEV const bf16* operator()(int r) const { return base + (size_t)r * ld; } MDEV unsigned off(int r) const { return (unsigned)r * (unsigned)ld; } };

constexpr int LDB = 144;
constexpr int GEMM_BS2 = 64 * LDB;
constexpr int GEMM2_LDS = (2 * GEMM_AS + 2 * GEMM_BS2) * 2;
DEV bf16x8 tr_read8(const bf16* p0, const bf16* p1) {
    const s16x4 x = tr4(p0), y = tr4(p1); bf16x8 r;
    r[0] = x[0]; r[1] = x[1]; r[2] = x[2]; r[3] = x[3]; r[4] = y[0]; r[5] = y[1]; r[6] = y[2]; r[7] = y[3]; return r;
}
DEV int bperm(int r) { return (r & ~12) | ((r & 4) << 1) | ((r & 8) >> 1); }
template <class AF, class BF, class EPI>
DEV void gemm_tile2(unsigned char* smem, AF af, BF bf, int ldb, int K, EPI& epi) {
    const int tid = TID, w = tid >> 6, l = tid & 63, h = l >> 4, c = l & 15, wm = w >> 1, wn = w & 1, grp = w >> 2;
    bf16* As = (bf16*)smem; bf16* Bs = As + 2 * GEMM_AS;
    const bf16* abase = af.base; unsigned ao[4];
    const int col8 = (tid & 7) * 8, r0 = tid >> 3;
#pragma unroll
    for (int i = 0; i < 4; ++i) ao[i] = af.off(r0 + 64 * i) + col8;
    const int bn4 = (tid & 31) * 4, bk = tid >> 5, bkp = bperm(bk);
    const float* bp = bf(bn4); const bool bok = bp != nullptr;
    if (bok) bp += (size_t)bk * ldb;
    const size_t bstep = (size_t)16 * ldb;
    f32x4 acc[4][4];
#pragma unroll
    for (int i = 0; i < 4; ++i)
#pragma unroll
        for (int j = 0; j < 4; ++j) acc[i][j] = f4zero();
    bf16x8 ra[4]; f32x4 rb[4];
    const int nk = K / 64;
#pragma unroll
    for (int i = 0; i < 4; ++i) { ra[i] = *(const bf16x8*)(abase + ao[i]); rb[i] = bok ? *(const f32x4*)(bp + i * bstep) : f4zero(); }
    SYNC();
#pragma unroll
    for (int i = 0; i < 4; ++i) { *(bf16x8*)(As + (r0 + 64 * i) * LDT + col8) = ra[i]; st_bf4(Bs + (bkp + 16 * i) * LDB + bn4, rb[i]); }
    if (nk > 1) {
#pragma unroll
        for (int i = 0; i < 4; ++i) { ra[i] = *(const bf16x8*)(abase + (ao[i] + 64)); rb[i] = bok ? *(const f32x4*)(bp + (size_t)64 * ldb + i * bstep) : f4zero(); } }
    SYNC();
    for (int kt = 0; kt < nk; ++kt) {
        const int cur = kt & 1;
#pragma unroll
        for (int p = 0; p < 2; ++p) {
            if (grp == p) {
                const bf16* Ac = As + cur * GEMM_AS + (wm * 64 + c) * LDT + 8 * h;
                const bf16* Bc = Bs + cur * GEMM_BS2 + bperm(8 * h + (c >> 2)) * LDB + wn * 64 + 4 * (c & 3);
#pragma unroll
                for (int kk = 0; kk < 2; ++kk) {
                    bf16x8 fa[4], fb[4];
#pragma unroll
                    for (int i = 0; i < 4; ++i) { fa[i] = *(const bf16x8*)(Ac + i * 16 * LDT + kk * 32); fb[i] = tr_read8(Bc + (32 * kk) * LDB + 16 * i, Bc + (32 * kk + 8) * LDB + 16 * i); }
#pragma unroll
                    for (int ni = 0; ni < 4; ++ni)
#pragma unroll
                        for (int mi = 0; mi < 4; ++mi) acc[ni][mi] = mfma16(fb[ni], fa[mi], acc[ni][mi]);
                }
            } else if (kt + 1 < nk) {
                const int nx = cur ^ 1;
#pragma unroll
                for (int i = 0; i < 4; ++i) { *(bf16x8*)(As + nx * GEMM_AS + (r0 + 64 * i) * LDT + col8) = ra[i]; st_bf4(Bs + nx * GEMM_BS2 + (bkp + 16 * i) * LDB + bn4, rb[i]); }
                if (kt + 2 < nk) {
#pragma unroll
                    for (int i = 0; i < 4; ++i) { ra[i] = *(const bf16x8*)(abase + (ao[i] + (kt + 2) * 64)); rb[i] = bok ? *(const f32x4*)(bp + (size_t)(kt + 2) * 64 * ldb + i * bstep) : f4zero(); } }
            }
            SYNC();
        }
    }
    epi(acc, wm * 64, wn * 64, h, c);
}
struct BPlain { const float* base; MDEV const float* operator()(int nt) const { return base + nt; } };
struct BInProjMap { const float* base; int n0; MDEV const float* operator()(int nt) const { const int n = n0 + nt; const int sc = n < 1280 ? n : (n < 3328 ? n + 24 : (n < 3352 ? 1280 + (n - 3328) : -1)); return sc < 0 ? nullptr : base + sc; } };
struct BInter { const float* s0; const float* s1; int n0; MDEV const float* operator()(int nt) const { const int n = n0 + nt, g = n >> 6, w = n & 63; return w < 32 ? s0 + g * 32 + w : s1 + g * 32 + w - 32; } };
struct BClamp64 { const float* base; MDEV const float* operator()(int nt) const { return base + (nt & 63); } };

struct EpiInProj {
    const Args* a; int m0, n0, li;
    MDEV void operator()(f32x4 (&acc)[4][4], int mw, int nw, int h, int c) const {
        unsigned char* ws = wsp(*a);
        const int nb = n0 + nw;
        const int tokb = m0 + mw + c;
        if (nb < 512 || (nb >= 768 && nb < 896) || (nb >= 1024 && nb < 1152)) {
            const float* gain; float mul = 1.f; bf16* dst; int kind;
            if (nb < 512) { gain = INP(*a, I_QG) + li * 64; mul = 0.125f * LOG2E; kind = 0; dst = (bf16*)(ws + WS_QN); }
            else if (nb < 896) { gain = INP(*a, I_KG) + (li * 3 + 1) * 64; kind = 1; dst = (bf16*)(ws + WS_KS); }
            else { gain = INP(*a, I_KG) + (li * 3 + 2) * 64; kind = 1; dst = (bf16*)(ws + WS_KW); }
            const int g = (nb >> 6) & 1;
#pragma unroll
            for (int mi = 0; mi < 4; ++mi) {
                float ss = 0.f;
#pragma unroll
                for (int ni = 0; ni < 4; ++ni) { f32x4 v = acc[ni][mi]; ss += v[0] * v[0] + v[1] * v[1] + v[2] * v[2] + v[3] * v[3]; }
                ss += shflx(ss, 16); ss += shflx(ss, 32);
                const float rs = frsq(ss * (1.0f / 64.0f) + EPS) * mul;
                const int tok = tokb + 16 * mi;
#pragma unroll
                for (int ni = 0; ni < 4; ++ni) {
                    const int d = 16 * ni + 4 * h; f32x4 v = acc[ni][mi], o;
#pragma unroll
                    for (int r = 0; r < 4; ++r) o[r] = v[r] * rs * gain[d + r];
                    if (kind == 0) st_bf4(dst + (size_t)tok * 512 + nb + d, o);
                    else { const int b = tok / SEQ, s = tok % SEQ; st_bf4(dst + ((size_t)(b * 2 + g) * SEQ + s) * 64 + d, o); }
                }
            }
        } else if (nb < 768) {
            bf16* dst = (bf16*)(ws + (nb < 640 ? WS_KCG : WS_VCG)); const int g = (nb >> 6) & 1;
#pragma unroll
            for (int mi = 0; mi < 4; ++mi) { const int tok = tokb + 16 * mi, b = tok / SEQ, s = tok % SEQ;
#pragma unroll
                for (int ni = 0; ni < 4; ++ni) st_bf4(dst + ((size_t)(b * 2 + g) * SEQ + s) * 64 + 16 * ni + 4 * h, acc[ni][mi]); }
        } else if (nb < 1280) {
            bf16* dst = (bf16*)(ws + (nb < 1024 ? WS_VST : WS_VWT)); const int g = (nb >> 6) & 1;
#pragma unroll
            for (int mi = 0; mi < 4; ++mi) { const int tok = tokb + 16 * mi, b = tok / SEQ, s = tok % SEQ;
                bf16* p = dst + ((size_t)(b * 2 + g) * NCH + (s >> 6)) * 4096 + (s & 63);
#pragma unroll
                for (int ni = 0; ni < 4; ++ni)
#pragma unroll
                    for (int r = 0; r < 4; ++r) p[(16 * ni + 4 * h + r) * 64] = (bf16)f2bf(acc[ni][mi][r]); }
        } else if (nb < 3328) {
            const int sec = (nb - 1280) >> 9, cc = (nb - 1280) & 511, hh = cc >> 7, d0 = cc & 127;
#pragma unroll
            for (int mi = 0; mi < 4; ++mi) { const int tok = tokb + 16 * mi, b = tok / SEQ, s = tok % SEQ;
                const size_t hrow = ((size_t)(b * 4 + hh) * SEQ + s) * 128 + d0;
#pragma unroll
                for (int ni = 0; ni < 4; ++ni) { const int d = 16 * ni + 4 * h; f32x4 v = acc[ni][mi], o;
                    if (sec == 0) { for (int r = 0; r < 4; ++r) o[r] = siluf(v[r]); st_bf4((bf16*)(ws + WS_HQ) + hrow + d, o); }
                    else if (sec == 1) { const float* lb = (const float*)(ws + WS_LB) + li * 512 + cc + d;
                        for (int r = 0; r < 4; ++r) o[r] = lb[r] + (1.0f - lb[r]) * sigm(v[r]);
                        *(f32x4*)((float*)(ws + WS_HF) + hrow + d) = o; }
                    else if (sec == 2) st_bf4((bf16*)(ws + WS_HV) + hrow + d, v);
                    else { for (int r = 0; r < 4; ++r) o[r] = siluf(v[r]); st_bf4((bf16*)(ws + WS_HGS) + (size_t)tok * 512 + cc + d, o); }
                } }
        } else if (nb == 3328) {
            float* dst = (float*)(ws + WS_GATE);
#pragma unroll
            for (int mi = 0; mi < 4; ++mi) { const int tok = tokb + 16 * mi;
#pragma unroll
                for (int ni = 0; ni < 2; ++ni)
#pragma unroll
                    for (int r = 0; r < 4; ++r) { const int n = 16 * ni + 4 * h + r; if (n < 24) dst[(size_t)tok * 24 + n] = sigm(acc[ni][mi][r]); } }
        }
    }
};

struct EpiResid {
    float* x; const float* gate; int m0, n0;
    MDEV void operator()(f32x4 (&acc)[4][4], int mw, int nw, int h, int c) const {
#pragma unroll
        for (int mi = 0; mi < 4; ++mi) { const int tok = m0 + mw + 16 * mi + c, b = tok / SEQ;
#pragma unroll
            for (int ni = 0; ni < 4; ++ni) { const int n = n0 + nw + 16 * ni + 4 * h;
                f32x4 g = *(const f32x4*)(gate + (size_t)b * 6 * DM + n); f32x4* p = (f32x4*)(x + (size_t)tok * DM + n); f32x4 v = *p;
#pragma unroll
                for (int r = 0; r < 4; ++r) v[r] += g[r] * acc[ni][mi][r];
                *p = v; } }
    }
};
template <int MODE> struct EpiGated {
    bf16* dst; size_t ld; int m0, n0, mvalid;
    MDEV void operator()(f32x4 (&acc)[4][4], int mw, int nw, int h, int c) const {
        const int cb = (n0 + nw) / 2;
#pragma unroll
        for (int mi = 0; mi < 4; ++mi) { const int m = mw + 16 * mi + c; if (m >= mvalid) continue;
#pragma unroll
            for (int ni = 0; ni < 2; ++ni) { f32x4 o;
#pragma unroll
                for (int r = 0; r < 4; ++r) { const float av = acc[ni][mi][r], bv = acc[ni + 2][mi][r]; o[r] = MODE == 0 ? av * sigm(bv) : siluf(av) * bv; }
                st_bf4(dst + (size_t)(m0 + m) * ld + cb + 16 * ni + 4 * h, o); } }
    }
};
struct EpiStoreBf {
    bf16* dst; size_t ld; int m0, n0, mvalid;
    MDEV void operator()(f32x4 (&acc)[4][4], int mw, int nw, int h, int c) const {
#pragma unroll
        for (int mi = 0; mi < 4; ++mi) { const int m = mw + 16 * mi + c; if (m >= mvalid) continue;
#pragma unroll
            for (int ni = 0; ni < 4; ++ni) st_bf4(dst + (size_t)(m0 + m) * ld + n0 + nw + 16 * ni + 4 * h, acc[ni][mi]); }
    }
};
struct EpiCmp {
    const Args* a; int kv, bg, m0, li;
    MDEV void operator()(f32x4 (&acc)[4][4], int mw, int nw, int h, int c) const {
        if (nw != 0) return;
        unsigned char* ws = wsp(*a);
        const float* bp8 = (const float*)(ws + WS_CB) + (li * 2 + kv) * 8 * 64;
        float bias[16];
#pragma unroll
        for (int q = 0; q < 16; ++q) { const int e = 16 * (q >> 2) + 4 * h + (q & 3); float v = 0.f;
#pragma unroll
            for (int kp = 0; kp < 8; ++kp) v += bp8[kp * 64 + e];
            bias[q] = v; }
        const float* gain = INP(*a, I_KG) + (li * 3 + 0) * 64;
#pragma unroll
        for (int mi = 0; mi < 4; ++mi) { const int n = m0 + mw + 16 * mi + c; const bool ok = n < NCMP;
            f32x4 v[4]; float ss = 0.f;
#pragma unroll
            for (int ni = 0; ni < 4; ++ni) { v[ni] = acc[ni][mi];
#pragma unroll
                for (int r = 0; r < 4; ++r) { v[ni][r] += bias[4 * ni + r]; ss += v[ni][r] * v[ni][r]; } }
            ss += shflx(ss, 16); ss += shflx(ss, 32);
            if (n >= NCP) continue;
            if (kv == 0) { const float rs = frsq(ss * (1.0f / 64.0f) + EPS); bf16* p = (bf16*)(ws + WS_KC) + ((size_t)bg * NCP + n) * 64;
#pragma unroll
                for (int ni = 0; ni < 4; ++ni) { f32x4 o;
#pragma unroll
                    for (int r = 0; r < 4; ++r) o[r] = ok ? v[ni][r] * rs * gain[16 * ni + 4 * h + r] : 0.f;
                    st_bf4(p + 16 * ni + 4 * h, o); }
            } else { bf16* p = (bf16*)(ws + WS_VCT) + ((size_t)bg * NCP + n) * 64;
#pragma unroll
                for (int ni = 0; ni < 4; ++ni) { f32x4 o;
#pragma unroll
                    for (int r = 0; r < 4; ++r) o[r] = ok ? v[ni][r] : 0.f;
                    st_bf4(p + 16 * ni + 4 * h, o); } }
        }
    }
};


struct EpiResid8 {
    static constexpr bool PERM = true, AFTER_DRAIN = false;
    float* x; const float* gate; const float* xin;
    MDEV void operator()(const f32x4 (&acc)[2][2][4][2], const pg8::Unit& u, int wr, int wc, int fr, int fq) const {
        OPAQUE2(fr, fq);
#pragma unroll
        for (int ai = 0; ai < 2; ++ai)
#pragma unroll
            for (int m = 0; m < 4; ++m) { const int row = 256 * u.pm + 128 * ai + 64 * wr + 16 * m + fr, b = row / SEQ;
#pragma unroll
                for (int bj = 0; bj < 2; ++bj)
#pragma unroll
                    for (int n = 0; n < 2; ++n) { const int col = 256 * u.pn + 128 * bj + 32 * wc + 8 * fq + 4 * n;
                        const f32x4 g = *(const f32x4*)(gate + (size_t)b * 6 * DM + col); f32x4* p = (f32x4*)(x + (size_t)row * DM + col); f32x4 v = *(const f32x4*)(xin + (size_t)row * DM + col);
#pragma unroll
                        for (int r = 0; r < 4; ++r) v[r] += g[r] * acc[ai][bj][m][n][r];
                        *p = v; } }
    }
};
struct EpiGlu8 {
    static constexpr bool PERM = true, AFTER_DRAIN = false;
    bf16* dst;
    MDEV void operator()(const f32x4 (&acc)[2][2][4][2], const pg8::Unit& u, int wr, int wc, int fr, int fq) const {
        OPAQUE2(fr, fq);
#pragma unroll
        for (int ai = 0; ai < 2; ++ai)
#pragma unroll
            for (int m = 0; m < 4; ++m) { const int row = 256 * u.pm + 128 * ai + 64 * wr + 16 * m + fr;
                { const int col = 128 * u.pn + 32 * wc + 8 * fq; f32x4 o0, o1;
#pragma unroll
                    for (int r = 0; r < 4; ++r) { o0[r] = acc[ai][0][m][0][r] * sigm(acc[ai][1][m][0][r]); o1[r] = acc[ai][0][m][1][r] * sigm(acc[ai][1][m][1][r]); }
                    st_bf8(dst + (size_t)row * DM + col, o0, o1); } }
    }
};
struct EpiMoe1_8 {
    static constexpr bool PERM = true, AFTER_DRAIN = false;
    bf16* dst;
    MDEV void operator()(const f32x4 (&acc)[2][2][4][2], const pg8::Unit& u, int wr, int wc, int fr, int fq) const {
        OPAQUE2(fr, fq);
#pragma unroll
        for (int ai = 0; ai < 2; ++ai)
#pragma unroll
            for (int m = 0; m < 4; ++m) { const int row = 256 * u.pm + 128 * ai + 64 * wr + 16 * m + fr;
                const int col = 128 * u.pn + 32 * wc + 8 * fq; f32x4 o0, o1;
#pragma unroll
                for (int r = 0; r < 4; ++r) { o0[r] = siluf(acc[ai][0][m][0][r]) * acc[ai][1][m][0][r]; o1[r] = siluf(acc[ai][0][m][1][r]) * acc[ai][1][m][1][r]; }
#ifdef EMU
                st_bf8(dst + (size_t)row * FF + col, o0, o1); }
#else
                u32x4 pk; pk[0] = pk2(o0[0], o0[1]); pk[1] = pk2(o0[2], o0[3]); pk[2] = pk2(o1[0], o1[1]); pk[3] = pk2(o1[2], o1[3]);
                asm volatile("global_store_dwordx4 %0, %1, off sc1\n\ts_nop 2" :: "v"((__attribute__((address_space(1))) bf16*)(dst + (size_t)row * FF + col)), "v"(pk) : "memory"); }
#endif
    }
};
struct EpiMoe2_8 {
    static constexpr bool PERM = true, AFTER_DRAIN = false;
    bf16* dst;
    MDEV void operator()(const f32x4 (&acc)[2][2][4][2], const pg8::Unit& u, int wr, int wc, int fr, int fq) const {
        OPAQUE2(fr, fq);
#pragma unroll
        for (int ai = 0; ai < 2; ++ai)
#pragma unroll
            for (int m = 0; m < 4; ++m) { const int row = 256 * u.pm + 128 * ai + 64 * wr + 16 * m + fr;
#pragma unroll
                for (int bj = 0; bj < 2; ++bj) { const int col = 256 * u.pn + 128 * bj + 32 * wc + 8 * fq;
                    st_bf8(dst + (size_t)row * DM + col, acc[ai][bj][m][0], acc[ai][bj][m][1]); } }
    }
};
DEV unsigned uni(unsigned x);
template <bool G> struct MoeSel {
    static constexpr bool GATHER = G;
    const int* rb; const int* cnt; const int* list; size_t bstride;
    struct Ctx { int e, rbase, c; };
    MDEV Ctx ctx(const pg8::Unit& u) const { int e = 0;
#pragma unroll 1
        for (int q = 1; q < 32; ++q) if ((rb[q] >> 8) <= u.pm) e = q;
        e = (int)uni((unsigned)e); Ctx x; x.e = e; x.rbase = (int)uni((unsigned)((u.pm << 8) - rb[e])); x.c = G ? (int)uni((unsigned)cnt[e * 64]) : 0; return x; }
    MDEV size_t boff(const Ctx& x) const { return (size_t)x.e * bstride; }
    MDEV unsigned aoff(const Ctx& x, int r) const { int p = x.rbase + r; if (p > x.c - 1) p = x.c - 1; return (unsigned)list[(size_t)x.e * T + p] * (unsigned)(DM * 2); }
};
struct EpiInProj8 {
    static constexpr bool PERM = true, AFTER_DRAIN = false;
    const Args* a; int li;
    MDEV void operator()(const f32x4 (&acc)[2][2][4][2], const pg8::Unit& u, int wr, int wc, int fr, int fq) const {
        OPAQUE2(fr, fq);
        unsigned char* ws = wsp(*a);
        const int nb = 256 * u.pn + 64 * wc;
        if (nb >= 3392) return;
        if (nb < 512 || (nb >= 768 && nb < 896) || (nb >= 1024 && nb < 1152)) {
            const float* gain; float mul = 1.f; int kind;
            if (nb < 512) { gain = INP(*a, I_QG) + li * 64; mul = 0.125f * LOG2E; kind = 0; }
            else if (nb < 896) { gain = INP(*a, I_KG) + (li * 3 + 1) * 64; kind = 1; }
            else { gain = INP(*a, I_KG) + (li * 3 + 2) * 64; kind = 2; }
            const int g = (nb >> 6) & 1;
            f32x4 gv[2][2];
#pragma unroll
            for (int bj = 0; bj < 2; ++bj)
#pragma unroll
                for (int n = 0; n < 2; ++n) gv[bj][n] = *(const f32x4*)(gain + 32 * bj + 8 * fq + 4 * n);
#pragma unroll
            for (int ai = 0; ai < 2; ++ai)
#pragma unroll
                for (int m = 0; m < 4; ++m) { const int tok = 256 * u.pm + 128 * ai + 64 * wr + 16 * m + fr;
                    float ss = 0.f;
#pragma unroll
                    for (int bj = 0; bj < 2; ++bj)
#pragma unroll
                        for (int n = 0; n < 2; ++n) { const f32x4 v = acc[ai][bj][m][n]; ss += v[0] * v[0] + v[1] * v[1] + v[2] * v[2] + v[3] * v[3]; }
                    ss += shflx(ss, 16); ss += shflx(ss, 32);
                    const float rs = frsq(ss * (1.0f / 64.0f) + EPS) * mul;
                    bf16* dst; if (kind == 0) dst = (bf16*)(ws + WS_QN) + (size_t)tok * 512 + nb; else { const int b = tok / SEQ, sq = tok % SEQ; dst = (bf16*)(ws + (kind == 1 ? WS_KS : WS_KW)) + ((size_t)(b * 2 + g) * SEQ + sq) * 64; }
#pragma unroll
                    for (int bj = 0; bj < 2; ++bj) { f32x4 o0, o1;
#pragma unroll
                        for (int r = 0; r < 4; ++r) { o0[r] = acc[ai][bj][m][0][r] * rs * gv[bj][0][r]; o1[r] = acc[ai][bj][m][1][r] * rs * gv[bj][1][r]; }
                        st_bf8(dst + 32 * bj + 8 * fq, o0, o1); } }
        } else if (nb < 768) {
            bf16* base = (bf16*)(ws + (nb < 640 ? WS_KCG : WS_VCG)); const int g = (nb >> 6) & 1;
#pragma unroll
            for (int ai = 0; ai < 2; ++ai)
#pragma unroll
                for (int m = 0; m < 4; ++m) { const int tok = 256 * u.pm + 128 * ai + 64 * wr + 16 * m + fr, b = tok / SEQ, sq = tok % SEQ;
#pragma unroll
                    for (int bj = 0; bj < 2; ++bj) st_bf8(base + ((size_t)(b * 2 + g) * SEQ + sq) * 64 + 32 * bj + 8 * fq, acc[ai][bj][m][0], acc[ai][bj][m][1]); }
        } else if (nb < 1280) {
            bf16* base = (bf16*)(ws + (nb < 1024 ? WS_VST : WS_VWT)); const int g = (nb >> 6) & 1;
#pragma unroll
            for (int ai = 0; ai < 2; ++ai)
#pragma unroll
                for (int m = 0; m < 4; ++m) { const int tok = 256 * u.pm + 128 * ai + 64 * wr + 16 * m + fr, b = tok / SEQ, sq = tok % SEQ;
#pragma unroll
                    for (int bj = 0; bj < 2; ++bj) st_bf8(base + ((size_t)(b * 2 + g) * SEQ + sq) * 64 + 32 * bj + 8 * fq, acc[ai][bj][m][0], acc[ai][bj][m][1]); }
        } else if (nb < 3328) {
            const int sec = (nb - 1280) >> 9, cc = (nb - 1280) & 511, hh = cc >> 7, d0 = cc & 127;
            f32x4 lbv[2][2];
            if (sec == 1) {
#pragma unroll
                for (int bj = 0; bj < 2; ++bj)
#pragma unroll
                    for (int n = 0; n < 2; ++n) lbv[bj][n] = *(const f32x4*)((const float*)(ws + WS_LB) + li * 512 + cc + 32 * bj + 8 * fq + 4 * n); }
#pragma unroll
            for (int ai = 0; ai < 2; ++ai)
#pragma unroll
                for (int m = 0; m < 4; ++m) { const int tok = 256 * u.pm + 128 * ai + 64 * wr + 16 * m + fr, b = tok / SEQ, sq = tok % SEQ;
                    const size_t hrow = ((size_t)(b * 4 + hh) * SEQ + sq) * 128 + d0;
#pragma unroll
                    for (int bj = 0; bj < 2; ++bj) { const int d = 32 * bj + 8 * fq; f32x4 o0, o1;
                        if (sec == 0) {
#pragma unroll
                            for (int r = 0; r < 4; ++r) { o0[r] = siluf(acc[ai][bj][m][0][r]); o1[r] = siluf(acc[ai][bj][m][1][r]); }
                            st_bf8((bf16*)(ws + WS_HQ) + hrow + d, o0, o1); }
                        else if (sec == 1) {
#pragma unroll
                            for (int r = 0; r < 4; ++r) { o0[r] = lbv[bj][0][r] + (1.0f - lbv[bj][0][r]) * sigm(acc[ai][bj][m][0][r]); o1[r] = lbv[bj][1][r] + (1.0f - lbv[bj][1][r]) * sigm(acc[ai][bj][m][1][r]); }
                            float* pf = (float*)(ws + WS_HF) + hrow + d; *(f32x4*)pf = o0; *(f32x4*)(pf + 4) = o1; }
                        else if (sec == 2) st_bf8((bf16*)(ws + WS_HV) + hrow + d, acc[ai][bj][m][0], acc[ai][bj][m][1]);
                        else {
#pragma unroll
                            for (int r = 0; r < 4; ++r) { o0[r] = siluf(acc[ai][bj][m][0][r]); o1[r] = siluf(acc[ai][bj][m][1][r]); }
                            st_bf8((bf16*)(ws + WS_HGS) + (size_t)tok * 512 + cc + d, o0, o1); } } }
        } else {
            float* dst = (float*)(ws + WS_GATE);
            if (fq < 3) {
#pragma unroll
                for (int ai = 0; ai < 2; ++ai)
#pragma unroll
                    for (int m = 0; m < 4; ++m) { const int tok = 256 * u.pm + 128 * ai + 64 * wr + 16 * m + fr; f32x4 o0, o1;
#pragma unroll
                        for (int r = 0; r < 4; ++r) { o0[r] = sigm(acc[ai][0][m][0][r]); o1[r] = sigm(acc[ai][0][m][1][r]); }
                        float* pf = dst + (size_t)tok * 24 + 8 * fq; *(f32x4*)pf = o0; *(f32x4*)(pf + 4) = o1; } }
        }
    }
};

DEV void tr_tile(unsigned char* smem, const float* src0, const float* src1, int ld, int K, int mode, bf16* dst, int n0, int k0) {
    bf16* tl = (bf16*)smem;
    const int tid = TID;
    SYNC();
#pragma unroll
    for (int i = 0; i < 8; ++i) {
        const int e = tid + 512 * i, kk = e >> 6, nn = e & 63, n = n0 + nn; float v = 0.f;
        if (mode == 0) v = src0[(size_t)(k0 + kk) * ld + n];
        else if (mode == 1) { int sc = n < 1280 ? n : (n < 3328 ? n + 24 : (n < 3352 ? 1280 + (n - 3328) : -1)); if (sc >= 0) v = src0[(size_t)(k0 + kk) * ld + sc]; }
        else { const int g = n >> 6, w = n & 63; v = (w < 32) ? src0[(size_t)(k0 + kk) * ld + g * 32 + w] : src1[(size_t)(k0 + kk) * ld + g * 32 + w - 32]; }
        tl[nn * LDT + kk] = (bf16)f2bf(v);
    }
    SYNC();
    const int nn = tid >> 3, k8 = (tid & 7) * 8;
    *(bf16x8*)(dst + (size_t)(n0 + nn) * K + k0 + k8) = *(const bf16x8*)(tl + nn * LDT + k8);
}

DEV int tr_col(int mode, int n) {
    if (mode == 0) return n;
    const int pn = n >> 8, ct = n & 255;
    if (mode == 5) { const int bj = ct >> 7, wc = (ct >> 5) & 3, j = ct & 31, L = 256 * pn + 64 * wc + 32 * bj + j; return L < 1280 ? L : (L < 3328 ? L + 24 : (L < 3352 ? 1280 + (L - 3328) : -1)); }
    { const int bj = ct >> 7, Lc = 128 * pn + (ct & 127); return bj == 0 ? Lc : (mode == 7 ? FF : DM) + Lc; }
}
DEV void tr_tile(unsigned char* smem, const float* src, int ld, int K, int mode, bf16* dst, int n0, int k0) {
    bf16* tl = (bf16*)smem;
    const int tid = TID, nq = tid & 31, kq = tid >> 5;
    const int sc = tr_col(mode, n0 + 4 * nq);
    f32x4 v[4];
#pragma unroll
    for (int i = 0; i < 4; ++i) v[i] = sc >= 0 ? *(const f32x4*)(src + (size_t)(k0 + 4 * kq + i) * ld + sc) : f4zero();
    SYNC();
#pragma unroll
    for (int j = 0; j < 4; ++j) { u32x2 w; w[0] = pk2(v[0][j], v[1][j]); w[1] = pk2(v[2][j], v[3][j]); *(u32x2*)(tl + (4 * nq + j) * LDT + 4 * kq) = w; }
    SYNC();
#pragma unroll
    for (int t = 0; t < 2; ++t) { const int id = tid + 512 * t, row = id >> 3, ch = id & 7;
        *(bf16x8*)(dst + (size_t)(n0 + row) * K + k0 + 8 * ch) = *(const bf16x8*)(tl + row * LDT + 8 * ch); }
}
constexpr int KSUP = FF >= 256 ? 256 : FF, NSUP = KSUP / 64;
DEV void tr_super(unsigned char* smem, const float* src0, const float* src1, int ld, int K, int mode, bf16* dst, int n0, int k0) {
    const int tid = TID, nq = tid & 31, kq = tid >> 5;
    int sc = n0 + 4 * nq; const float* src = src0;
    if (mode == 7) { const int cc = tr_col(7, sc); src = cc >= FF ? src1 : src0; sc = cc >= FF ? cc - FF : cc; }
    f32x4 v[NSUP][4];
#pragma unroll
    for (int sb = 0; sb < NSUP; ++sb)
#pragma unroll
        for (int i = 0; i < 4; ++i) v[sb][i] = *(const f32x4*)(src + (size_t)(k0 + 64 * sb + 4 * kq + i) * ld + sc);
    SYNC();
    const int fw = nq & (KSUP / 16 - 1);
#pragma unroll
    for (int j = 0; j < 4; ++j)
#pragma unroll
        for (int sb = 0; sb < NSUP; ++sb) { const int c16 = 8 * sb + (kq >> 1); u32x2 w; w[0] = pk2(v[sb][0][j], v[sb][1][j]); w[1] = pk2(v[sb][2][j], v[sb][3][j]);
            *(u32x2*)(smem + (4 * nq + j) * (KSUP * 2) + ((c16 ^ fw) << 4) + (kq & 1) * 8) = w; }
    SYNC();
#pragma unroll
    for (int t = 0; t < 128 * (KSUP / 8) / NT; ++t) { const int id = tid + NT * t, row = id / (KSUP / 8), ch = id % (KSUP / 8), f = (row >> 2) & (KSUP / 16 - 1);
        *(bf16x8*)(dst + (size_t)(n0 + row) * K + k0 + 8 * (ch ^ f)) = *(const bf16x8*)(smem + row * (KSUP * 2) + ch * 16); }
}
constexpr int MOE_S13 = (2 * FF / 128) * (DM / KSUP), MOE_S2 = (DM / 128) * (FF / KSUP), MOE_SPE = MOE_S13 + MOE_S2, MOE_NIT = DEPTH * 32 * MOE_SPE;
DEV void moe_conv_tile(const Args& a, unsigned char* smem, int it) {
    unsigned char* ws = wsp(a); const int le = it / MOE_SPE, r = it % MOE_SPE;
    if (r < MOE_S13) { const int tn = r % (2 * FF / 128), tk = r / (2 * FF / 128);
        tr_super(smem, INP(a, I_W1) + (size_t)le * DM * FF, INP(a, I_W3) + (size_t)le * DM * FF, FF, DM, 7, (bf16*)(ws + WS_W13) + (size_t)le * 2 * FF * DM, tn * 128, tk * KSUP); }
    else { const int r2 = r - MOE_S13, tn = r2 % (DM / 128), tk = r2 / (DM / 128);
        tr_super(smem, INP(a, I_W2) + (size_t)le * FF * DM, INP(a, I_W2), DM, FF, 0, (bf16*)(ws + WS_W2) + (size_t)le * DM * FF, tn * 128, tk * KSUP); }
}
#ifndef EMU
constexpr int MOE_TAIL_Q = 3;
constexpr int MOE_N0 = MOE_NIT - 2 * MOE_TAIL_Q * (128 + 240) > 2 * 32 * MOE_SPE ? MOE_NIT - 2 * MOE_TAIL_Q * (128 + 240) : 2 * 32 * MOE_SPE;
DEV int moe_conv_fetch(const Args& a, unsigned char* smem) {
    int* ctr = (int*)(wsp(a) + WS_BAR) + P0_CTR_IDX; int* nxl = (int*)(smem + 72 * 1024);
    SYNC(); if (TID == 0) nxl[0] = atomic_add_i(ctr, 1); SYNC(); return nxl[0];
}
DEV void moe_conv_pull(const Args& a, unsigned char* smem, int quota) {
    for (int q = 0; q < quota; ++q) { const int it = moe_conv_fetch(a, smem); if (it >= MOE_NIT) break; moe_conv_tile(a, smem, it); }
    SYNC();
}
DEV void moe_conv_drain(const Args& a, unsigned char* smem, int limit) {
    __attribute__((address_space(1))) unsigned* ctr = (__attribute__((address_space(1))) unsigned*)((unsigned*)(wsp(a) + WS_BAR) + P0_CTR_IDX);
    for (;;) { if ((int)__builtin_amdgcn_readfirstlane((int)__hip_atomic_load(ctr, __ATOMIC_RELAXED, __HIP_MEMORY_SCOPE_AGENT)) >= limit) break;
        const int it = moe_conv_fetch(a, smem); if (it >= MOE_NIT) break; moe_conv_tile(a, smem, it); }
    SYNC();
}
#endif
struct TrJob { const float* s; int ld, K, N, mode; bf16* dst; };
DEV void p0_phase(const Args& a, unsigned char* smem) {
    unsigned char* ws = wsp(a); const int tid = TID;
    { int item = BID, base = 0;
      for (int j = 0; j < 8; ++j) { TrJob J; const int i = j & 1;
        if (j < 2) J = {INP(a, I_WIN) + (size_t)i * DM * NIN, NIN, DM, NIN8, 5, (bf16*)(ws + WS_WIN) + (size_t)i * NIN8 * DM};
        else if (j < 4) J = {INP(a, I_WOUT) + (size_t)i * 1024 * DM, DM, 1024, DM, 0, (bf16*)(ws + WS_WOUT) + (size_t)i * DM * 1024};
        else if (j < 6) J = {INP(a, I_PW1) + (size_t)i * DM * 2 * DM, 2 * DM, DM, 2 * DM, 6, (bf16*)(ws + WS_PW1) + (size_t)i * 2 * DM * DM};
        else J = {INP(a, I_PW2) + (size_t)i * DM * DM, DM, DM, DM, 0, (bf16*)(ws + WS_PW2) + (size_t)i * DM * DM};
        const int tn = J.N / 128, tk = J.K / 64, nt = tn * tk;
        while (item < base + nt) { const int it = item - base; tr_tile(smem, J.s, J.ld, J.K, J.mode, J.dst, (it % tn) * 128, (it / tn) * 64); item += NBLK; }
        base += nt; }
      SYNC(); }
    {
        float* red = (float*)smem;
        constexpr int NG = 6 * DM / 128; const int ntask = DEPTH * NG;
        for (int t = BID; t < ntask; t += NBLK) {
            const int l = t / NG, j0 = (t % NG) * 128, cq = tid & 31, kr = tid >> 5;
            const float* w = INP(a, I_ADAW) + (size_t)l * DM * 6 * DM + j0 + 4 * cq; const float* cc = INP(a, I_C);
            f32x4 a0 = f4zero(), a1 = f4zero();
#pragma unroll 8
            for (int i = 0; i < DM / 16; ++i) { const int k = kr + 16 * i; const f32x4 wv = *(const f32x4*)(w + (size_t)k * 6 * DM); const float s0 = siluf(cc[k]), s1 = siluf(cc[DM + k]);
#pragma unroll
                for (int r = 0; r < 4; ++r) { a0[r] += s0 * wv[r]; a1[r] += s1 * wv[r]; } }
            SYNC();
            *(f32x4*)(red + (kr * 2 + 0) * 128 + 4 * cq) = a0; *(f32x4*)(red + (kr * 2 + 1) * 128 + 4 * cq) = a1;
            SYNC();
            if (tid < 256) { const int b = tid >> 7, col = tid & 127; float sum = INP(a, I_ADAB)[(size_t)l * 6 * DM + j0 + col];
#pragma unroll
                for (int q = 0; q < 16; ++q) sum += red[(q * 2 + b) * 128 + col];
                ((float*)(ws + WS_MOD))[((size_t)l * 2 + b) * 6 * DM + j0 + col] = sum; }
        }
    }
    for (int t = BID; t < 32; t += NBLK) {
        float* red = (float*)smem; const int ikv = t >> 3, kp = t & 7, i = ikv >> 1, kv = ikv & 1, e = tid & 63, ks = tid >> 6;
        const float* W = INP(a, kv ? I_CWV : I_CWK) + (size_t)i * 2048 * 64 + e; const float* pe = INP(a, I_CPE) + (size_t)i * 2048;
        float sum = 0.f;
#pragma unroll 8
        for (int q = 0; q < 32; ++q) { const int k = kp * 256 + ks * 32 + q; sum += pe[k] * W[(size_t)k * 64]; }
        SYNC(); red[ks * 64 + e] = sum; SYNC();
        if (tid < 64) { float v = 0.f; for (int q = 0; q < 8; ++q) v += red[q * 64 + tid]; ((float*)(ws + WS_CB))[(ikv * 8 + kp) * 64 + tid] = v; }
    }
    for (int i = BID * NT + tid; i < DEPTH * 48 * DM; i += NBLK * NT) { const int k = i % DM, n = (i / DM) % 48, ll = i / (48 * DM);
        const float wv = n < 4 ? INP(a, I_WG)[((size_t)ll * DM + k) * 4 + n] : (n < 36 ? INP(a, I_WE)[((size_t)ll * DM + k) * 32 + n - 4] : 0.f);
        const unsigned hi = f2bf(wv); ((bf16*)(ws + WS_WTH))[i] = (bf16)hi; ((bf16*)(ws + WS_WTL))[i] = (bf16)f2bf(wv - bf2f(hi)); }
    if (BID == 0) {
        for (int i = tid; i < DEPTH * 32; i += NT) ((int*)(ws + WS_CNT))[i * 64] = 0;
        for (int i = tid; i < DEPTH * 256; i += NT) ((unsigned*)(ws + WS_FLG))[i * 16] = 0u;
        for (int n = tid; n < 512; n += NT) { const float l0 = INP(a, I_LBL)[n], l1 = INP(a, I_LBL)[512 + n]; const float m = fmaxf(l0, l1);
            const float e0 = fexp2((l0 - m) * LOG2E), e1 = fexp2((l1 - m) * LOG2E);
            ((float*)(ws + WS_LB))[n] = 0.f; ((float*)(ws + WS_LB))[512 + n] = e1 / (e0 + e1); }
        if (tid < 2) { const int i = tid; float mq = 0.f; for (int d = 0; d < 64; ++d) mq = fmaxf(mq, fabsf(INP(a, I_QG)[i * 64 + d]));
            for (int br = 0; br < 3; ++br) { float mk = 0.f; for (int d = 0; d < 64; ++d) mk = fmaxf(mk, fabsf(INP(a, I_KG)[(i * 3 + br) * 64 + d]));
                ((float*)(ws + WS_CS))[i * 4 + br] = 8.0f * mq * mk * LOG2E; } }
    }
    SYNC();
    {
#ifdef EMU
      for (int it = BID; it < MOE_NIT; it += NBLK) moe_conv_tile(a, smem, it);
#else
      int* ctr = (int*)(ws + WS_BAR) + P0_CTR_IDX; int* nxl = (int*)(smem + 72 * 1024);
      int my_next = 0; if (tid == 0) my_next = atomic_add_i(ctr, 1);
      for (;;) { if (tid == 0) nxl[0] = my_next; SYNC(); const int it = nxl[0]; if (it >= MOE_NIT) break;
          const bool more = it < MOE_N0;
          if (more && tid == 0) my_next = atomic_add_i(ctr, 1);
          moe_conv_tile(a, smem, it);
          if (!more) break; }
#endif
      SYNC(); }
}

constexpr int NJV = DM / 256;
DEV void moe_bases(const int* cnt, int* rb  ) {
    if (TID == 0) { int acc = 0; for (int e = 0; e < 32; ++e) { rb[e] = acc; acc += ((cnt[e * 64] + 255) >> 8) << 8; } rb[32] = acc; }
    SYNC();
}
DEV void norm_phase(const Args& a, unsigned char* smem, int l) {
    unsigned char* ws = wsp(a); const int tid = TID, w = tid >> 6, lane = tid & 63;
    int* rb = (int*)smem;
    if (l > 0) moe_bases((const int*)(ws + WS_CNT) + (l - 1) * 32 * 64, rb);
    const float* mod = (const float*)(ws + WS_MOD);
    const bf16* yk = (const bf16*)(ws + WS_YK);
    if (l < DEPTH) {
        const int bid = BID % 76 == BID ? BID : -1;
        for (int job = BID; job < 76; job += NBLK) {
            if (job < 72) { const int b = job / 36, n = job % 36; float sum = 0.f;
                for (int k = tid; k < DM; k += NT) { const float wv = n < 4 ? INP(a, I_WG)[((size_t)l * DM + k) * 4 + n] : INP(a, I_WE)[((size_t)l * DM + k) * 32 + n - 4]; sum += mod[((size_t)l * 2 + b) * 6 * DM + 3 * DM + k] * wv; }
#pragma unroll
                for (int q = 1; q < 64; q <<= 1) sum += shflx(sum, q);
                float* red = (float*)(smem + 1024);
                SYNC(); if (lane == 0) red[w] = sum; SYNC();
                if (tid == 0) { float t = 0.f; for (int q = 0; q < 8; ++q) t += red[q]; ((float*)(ws + WS_RBIAS))[((size_t)l * 2 + b) * 48 + n] = t; }
            } else { const float* nf = INP(a, I_NFFN) + (size_t)l * DM; const int part = job - 72;
                for (int i = part * (2 * DM / 4) + tid; i < (part + 1) * (2 * DM / 4); i += NT) { const int b = i / DM, k = i % DM; ((float*)(ws + WS_AVEC))[((size_t)l * 2 + b) * DM + k] = nf[k] * (1.0f + mod[((size_t)l * 2 + b) * 6 * DM + 4 * DM + k]); } }
        }
        (void)bid;
    }
    const int rstride = NBLK * 8;
    for (int rowa = BID * 8 + w; rowa < T; rowa += 2 * rstride) {
        int row[2]; bool ok[2];
        row[0] = rowa; ok[0] = true; row[1] = rowa + rstride; ok[1] = row[1] < T; if (!ok[1]) row[1] = rowa;
        f32x4 v[2][NJV]; int e0[2], p0[2], e1[2], p1[2]; float w0[2], w1[2];
        const float* xin = (l == 0) ? INP(a, I_X) : outp(a);
#pragma unroll
        for (int q = 0; q < 2; ++q) {
#pragma unroll
            for (int j = 0; j < NJV; ++j) v[q][j] = *(const f32x4*)(xin + (size_t)row[q] * DM + 4 * lane + 256 * j);
            if (l > 0) { const int* tie = (const int*)(ws + WS_TIE) + (size_t)row[q] * 2; const float* tiw = (const float*)(ws + WS_TIW) + (size_t)row[q] * 2;
                e0[q] = tie[0] >> 14; p0[q] = tie[0] & 16383; e1[q] = tie[1] >> 14; p1[q] = tie[1] & 16383; w0[q] = tiw[0]; w1[q] = tiw[1]; } }
        if (l > 0) {
            u32x2 q0[2][NJV], q1[2][NJV];
#pragma unroll
            for (int q = 0; q < 2; ++q) { const bf16* y0 = yk + (size_t)(rb[e0[q]] + p0[q]) * DM; const bf16* y1 = yk + (size_t)(rb[e1[q]] + p1[q]) * DM;
#pragma unroll
                for (int j = 0; j < NJV; ++j) { const int cidx = 4 * lane + 256 * j; q0[q][j] = *(const u32x2*)(y0 + cidx); q1[q][j] = *(const u32x2*)(y1 + cidx); } }
#pragma unroll
            for (int q = 0; q < 2; ++q) { const int b = row[q] / SEQ; const float* gf = mod + ((size_t)(l - 1) * 2 + b) * 6 * DM + 5 * DM;
#pragma unroll
                for (int j = 0; j < NJV; ++j) { const int cidx = 4 * lane + 256 * j; const f32x4 g = *(const f32x4*)(gf + cidx);
                    v[q][j][0] += g[0] * (w0[q] * bf2f(q0[q][j][0] & 0xffff) + w1[q] * bf2f(q1[q][j][0] & 0xffff));
                    v[q][j][1] += g[1] * (w0[q] * bf2f(q0[q][j][0] >> 16) + w1[q] * bf2f(q1[q][j][0] >> 16));
                    v[q][j][2] += g[2] * (w0[q] * bf2f(q0[q][j][1] & 0xffff) + w1[q] * bf2f(q1[q][j][1] & 0xffff));
                    v[q][j][3] += g[3] * (w0[q] * bf2f(q0[q][j][1] >> 16) + w1[q] * bf2f(q1[q][j][1] >> 16)); } }
        }
        if (l > 0)
#pragma unroll
        for (int q = 0; q < 2; ++q) { if (!ok[q]) continue;
#pragma unroll
            for (int j = 0; j < NJV; ++j) *(f32x4*)(outp(a) + (size_t)row[q] * DM + 4 * lane + 256 * j) = v[q][j]; }
        if (l == DEPTH) continue;
        float ss[2];
#pragma unroll
        for (int q = 0; q < 2; ++q) { ss[q] = 0.f;
#pragma unroll
            for (int j = 0; j < NJV; ++j) ss[q] += v[q][j][0] * v[q][j][0] + v[q][j][1] * v[q][j][1] + v[q][j][2] * v[q][j][2] + v[q][j][3] * v[q][j][3]; }
#pragma unroll
        for (int o = 1; o < 64; o <<= 1) { ss[0] += shflx(ss[0], o); ss[1] += shflx(ss[1], o); }
        const float* nm = INP(a, I_NMIX) + (size_t)l * DM;
#pragma unroll
        for (int q = 0; q < 2; ++q) { if (!ok[q]) continue;
            const int b = row[q] / SEQ; const float rs = frsq(ss[q] * (1.0f / DM) + EPS);
            const float* mm = mod + ((size_t)l * 2 + b) * 6 * DM; bf16* hb = (bf16*)(ws + WS_H) + (size_t)row[q] * DM;
#pragma unroll
            for (int j = 0; j < NJV; ++j) { const int cidx = 4 * lane + 256 * j; f32x4 g = *(const f32x4*)(nm + cidx), sh = *(const f32x4*)(mm + cidx), sc = *(const f32x4*)(mm + DM + cidx), o;
#pragma unroll
                for (int r = 0; r < 4; ++r) o[r] = v[q][j][r] * rs * g[r] * (1.0f + sc[r]) + sh[r];
                st_bf4(hb + cidx, o); } }
    }
}

DEV void route_phase(const Args& a, unsigned char* smem, int l) {
    unsigned char* ws = wsp(a); const int tid = TID, w = tid >> 6, lane = tid & 63, h = lane >> 4, c = lane & 15, pi = w >> 1, kh = w & 1;
    constexpr int NCHK = 4, CH = DM / NCHK, WLD = CH + 8, NKS = CH / 2 / 32;
    constexpr int WTOT = 48 * (CH / 8), WMAX = (WTOT + NT - 1) / NT;
    bf16* WHl = (bf16*)smem; bf16* WLl = WHl + 48 * WLD;
    float* lg = (float*)(WLl + 48 * WLD);
    float* ssb = lg + 4 * 2 * 16 * 48;
    float* rsb = ssb + 4 * 2 * 16;
    int* lcnt = (int*)(rsb + 64); int* lbase = lcnt + 32; int* tinfo = lbase + 32;
    float* avl = (float*)(tinfo + 256); float* cvl = avl + 2 * DM;
    const float* mod = (const float*)(ws + WS_MOD);
    SYNC();
    if (tid < 32) lcnt[tid] = 0;
    for (int i = tid; i < 2 * DM; i += NT) { const int b = i / DM, k = i % DM; avl[i] = ((const float*)(ws + WS_AVEC))[((size_t)l * 2 + b) * DM + k]; cvl[i] = mod[((size_t)l * 2 + b) * 6 * DM + 3 * DM + k]; }
    const bf16* WH = (const bf16*)(ws + WS_WTH) + (size_t)l * 48 * DM; const bf16* WL = (const bf16*)(ws + WS_WTL) + (size_t)l * 48 * DM;
    int* cnt = (int*)(ws + WS_CNT) + l * 32 * 64;
    for (int pass0 = BID; pass0 < T / 16; pass0 += 4 * NBLK) {
        const int pass = pass0 + pi * NBLK; const bool valid = pass < T / 16;
        const int tok = valid ? pass * 16 + c : 0, b = tok / SEQ;
        const float* xrow = outp(a) + (size_t)tok * DM;
        f32x4 xv[2][NKS][2]; bf16x8 wh[WMAX], wl[WMAX];
#pragma unroll
        for (int ks = 0; ks < NKS; ++ks) { const float* xq = xrow + kh * (CH / 2) + 8 * h + 32 * ks; xv[0][ks][0] = *(const f32x4*)xq; xv[0][ks][1] = *(const f32x4*)(xq + 4); }
#pragma unroll
        for (int t = 0; t < WMAX; ++t) { const int i = tid + NT * t; if (i < WTOT) { const int n = i / (CH / 8), k8 = (i % (CH / 8)) * 8; wh[t] = *(const bf16x8*)(WH + (size_t)n * DM + k8); wl[t] = *(const bf16x8*)(WL + (size_t)n * DM + k8); } }
        f32x4 acc[3] = {f4zero(), f4zero(), f4zero()}; float ss = 0.f;
        bf16x8 uhk[NCHK * NKS];
#pragma unroll
        for (int chn = 0; chn < NCHK; ++chn) {
            SYNC();
#pragma unroll
            for (int t = 0; t < WMAX; ++t) { const int i = tid + NT * t; if (i < WTOT) { const int n = i / (CH / 8), k8 = (i % (CH / 8)) * 8; *(bf16x8*)(WHl + n * WLD + k8) = wh[t]; *(bf16x8*)(WLl + n * WLD + k8) = wl[t]; } }
            SYNC();
            if (chn + 1 < NCHK) {
#pragma unroll
                for (int ks = 0; ks < NKS; ++ks) { const float* xq = xrow + (chn + 1) * CH + kh * (CH / 2) + 8 * h + 32 * ks; xv[(chn + 1) & 1][ks][0] = *(const f32x4*)xq; xv[(chn + 1) & 1][ks][1] = *(const f32x4*)(xq + 4); }
#pragma unroll
                for (int t = 0; t < WMAX; ++t) { const int i = tid + NT * t; if (i < WTOT) { const int n = i / (CH / 8), k8 = (i % (CH / 8)) * 8; wh[t] = *(const bf16x8*)(WH + (size_t)n * DM + (chn + 1) * CH + k8); wl[t] = *(const bf16x8*)(WL + (size_t)n * DM + (chn + 1) * CH + k8); } }
            }
            if (valid) {
                const bf16* whp = WHl + c * WLD + kh * (CH / 2) + 8 * h; const bf16* wlp = WLl + c * WLD + kh * (CH / 2) + 8 * h;
                const float* ap = avl + b * DM + chn * CH + kh * (CH / 2) + 8 * h;
#pragma unroll
                for (int ks = 0; ks < NKS; ++ks) {
                    const f32x4 a0 = *(const f32x4*)(ap + 32 * ks), a1 = *(const f32x4*)(ap + 32 * ks + 4);
                    const f32x4 x0 = xv[chn & 1][ks][0], x1 = xv[chn & 1][ks][1];
                    f32x4 u0, u1, r0, r1;
#pragma unroll
                    for (int r = 0; r < 4; ++r) { u0[r] = x0[r] * a0[r]; u1[r] = x1[r] * a1[r]; ss += x0[r] * x0[r] + x1[r] * x1[r]; }
                    const bf16x8 uh = pack8(u0, u1); uhk[chn * NKS + ks] = uh;
#pragma unroll
                    for (int r = 0; r < 4; ++r) { r0[r] = u0[r] - bf2f((unsigned short)uh[r]); r1[r] = u1[r] - bf2f((unsigned short)uh[4 + r]); }
                    const bf16x8 ul = pack8(r0, r1);
#pragma unroll
                    for (int nt = 0; nt < 3; ++nt) { const bf16x8 whf = *(const bf16x8*)(whp + nt * 16 * WLD + 32 * ks), wlf = *(const bf16x8*)(wlp + nt * 16 * WLD + 32 * ks);
                        acc[nt] = mfma16(whf, uh, acc[nt]); acc[nt] = mfma16(wlf, uh, acc[nt]); acc[nt] = mfma16(whf, ul, acc[nt]); }
                }
            }
        }
        if (valid) {
            ss += shflx(ss, 16); ss += shflx(ss, 32);
            float* lgp = lg + ((pi * 2 + kh) * 16 + c) * 48 + 4 * h;
#pragma unroll
            for (int nt = 0; nt < 3; ++nt) *(f32x4*)(lgp + 16 * nt) = acc[nt];
            if (h == 0) ssb[(pi * 2 + kh) * 16 + c] = ss;
        }
        SYNC();
        if (tid < 64) { const int p2 = tid >> 4, tk = tid & 15, pass2 = pass0 + p2 * NBLK;
            if (pass2 < T / 16) { const int tok2 = pass2 * 16 + tk, b2 = tok2 / SEQ;
                const float rs = frsq((ssb[(p2 * 2 + 0) * 16 + tk] + ssb[(p2 * 2 + 1) * 16 + tk]) * (1.0f / DM) + EPS); rsb[p2 * 16 + tk] = rs;
                const float* l0 = lg + ((p2 * 2 + 0) * 16 + tk) * 48; const float* l1 = lg + ((p2 * 2 + 1) * 16 + tk) * 48; const float* rbp = (const float*)(ws + WS_RBIAS) + ((size_t)l * 2 + b2) * 48;
                float acc[36];
#pragma unroll
                for (int n = 0; n < 36; ++n) acc[n] = rs * (l0[n] + l1[n]) + rbp[n];
                int gs = 0; float gm = acc[0];
#pragma unroll
                for (int g = 1; g < 4; ++g) if (acc[g] > gm) { gm = acc[g]; gs = g; }
                float den = 0.f;
#pragma unroll
                for (int g = 0; g < 4; ++g) den += fexp2((acc[g] - gm) * LOG2E);
                const float ggate = 1.0f / den;
                float el[8];
#pragma unroll
                for (int j = 0; j < 8; ++j) { el[j] = acc[4 + j];
#pragma unroll
                    for (int g = 1; g < 4; ++g) if (gs == g) el[j] = acc[4 + 8 * g + j]; }
                int ia = 0; float va = el[0];
#pragma unroll
                for (int j = 1; j < 8; ++j) if (el[j] > va) { va = el[j]; ia = j; }
                int ib = -1; float vb = -3e38f;
#pragma unroll
                for (int j = 0; j < 8; ++j) if (j != ia && el[j] > vb) { vb = el[j]; ib = j; }
                const float wa = 1.0f / (1.0f + fexp2((vb - va) * LOG2E)), wb = 1.0f - wa;
                const int e0 = gs * 8 + ia, e1 = gs * 8 + ib;
                const int p0 = atomic_add_i(lcnt + e0, 1), p1 = atomic_add_i(lcnt + e1, 1);
                int* ti = tinfo + tid * 4;
                ti[0] = (e0 << 14) | p0; ti[1] = (e1 << 14) | p1; ti[2] = __builtin_bit_cast(int, ggate * wa); ti[3] = __builtin_bit_cast(int, ggate * wb);
            } }
        SYNC();
        int gbase = 0;
        if (tid < 32) { const int n = lcnt[tid]; gbase = n > 0 ? atomic_add_i(cnt + tid * 64, n) : 0; }
        if (valid) { const float rs = rsb[pi * 16 + c]; bf16* hb = (bf16*)(ws + WS_H) + (size_t)tok * DM + kh * (CH / 2) + 8 * h;
            const float* cp = cvl + b * DM + kh * (CH / 2) + 8 * h;
#pragma unroll
            for (int chn = 0; chn < NCHK; ++chn)
#pragma unroll
                for (int ks = 0; ks < NKS; ++ks) {
                    const bf16x8 uh = uhk[chn * NKS + ks]; const f32x4 c0 = *(const f32x4*)(cp + chn * CH + 32 * ks), c1 = *(const f32x4*)(cp + chn * CH + 32 * ks + 4);
                    f32x4 o0, o1;
#pragma unroll
                    for (int r = 0; r < 4; ++r) { o0[r] = bf2f((unsigned short)uh[r]) * rs + c0[r]; o1[r] = bf2f((unsigned short)uh[4 + r]) * rs + c1[r]; }
                    st_bf8(hb + chn * CH + 32 * ks, o0, o1); } }
        if (tid < 32) { lbase[tid] = gbase; lcnt[tid] = 0; }
        SYNC();
        if (tid < 64) { const int p2 = tid >> 4, pass2 = pass0 + p2 * NBLK;
            if (pass2 < T / 16) { const int tok2 = pass2 * 16 + (tid & 15); const int* ti = tinfo + tid * 4;
                const int e0 = ti[0] >> 14, e1 = ti[1] >> 14, p0 = lbase[e0] + (ti[0] & 16383), p1 = lbase[e1] + (ti[1] & 16383);
                int* list = (int*)(ws + WS_LIST); list[(size_t)e0 * T + p0] = tok2; list[(size_t)e1 * T + p1] = tok2;
                int* tie = (int*)(ws + WS_TIE) + (size_t)tok2 * 2; int* tiw = (int*)(ws + WS_TIW) + (size_t)tok2 * 2;
                tie[0] = (e0 << 14) | p0; tie[1] = (e1 << 14) | p1; tiw[0] = ti[2]; tiw[1] = ti[3]; } }
        SYNC();
    }
}

DEV int vbid() { const int g = NBLK; return (g % 8 == 0) ? (BID % 8) * (g / 8) + BID / 8 : BID; }
#ifdef EMU
#define PG8_LDS(p) (p)
#else
#define PG8_LDS(p) ((PG8_LAS unsigned char*)(p))
#endif
DEV void inproj_phase(const Args& a, unsigned char* smem, int li) {
    pg8::Gemm g{(const bf16*)(wsp(a) + WS_H), (const bf16*)(wsp(a) + WS_WIN) + (size_t)li * NIN8 * DM, T, NIN8, DM}; pg8::StaticOrder S; S.init(T, NIN8, NBLK, BID);
    EpiInProj8 E{&a, li};
    SYNC(); pg8::gemm_phase<EpiInProj8, pg8::StaticOrder, true, true>(PG8_LDS(smem), g, S, E); SYNC();
#ifndef EMU
    { pg8::Unit u; const int full = (T / 256) * (NIN8 / 256) / NBLK; if (!S.next(full, u)) moe_conv_pull(a, smem, MOE_TAIL_Q); }
#endif
}
DEV void resid_gemm_phase(const Args& a, unsigned char* smem, const bf16* A, int K, const bf16* Bt, int l) {
    pg8::Gemm g{A, Bt, T, DM, K}; pg8::StaticOrder S; S.init(T, DM, NBLK, BID);
    EpiResid8 E{outp(a), (const float*)(wsp(a) + WS_MOD) + (size_t)l * 2 * 6 * DM + 2 * DM, l == 0 ? INP(a, I_X) : (const float*)outp(a)};
    SYNC(); pg8::gemm_phase<EpiResid8, pg8::StaticOrder, true, true>(PG8_LDS(smem), g, S, E); SYNC();
}
DEV void pw1_phase(const Args& a, unsigned char* smem, int li) {
    pg8::Gemm g{(const bf16*)(wsp(a) + WS_H), (const bf16*)(wsp(a) + WS_PW1) + (size_t)li * 2 * DM * DM, T, 2 * DM, DM}; pg8::StaticOrder S; S.init(T, 2 * DM, NBLK, BID);
    EpiGlu8 E{(bf16*)(wsp(a) + WS_GLU)};
    SYNC(); pg8::gemm_phase<EpiGlu8, pg8::StaticOrder, true, true>(PG8_LDS(smem), g, S, E); SYNC();
}
DEV void cmp_phase_items(const Args& a, unsigned char* smem, int li, int it) {
    constexpr int TMC = (NCP + 255) / 256;
    const int kv = it / (4 * TMC), bg = (it / TMC) % 4, tm = it % TMC;
    const bf16* src = (const bf16*)(wsp(a) + (kv ? WS_VCG : WS_KCG)) + (size_t)bg * SEQ * 64;
    struct AF { const bf16* base; int m0; MDEV unsigned off(int r) const { int n = m0 + r; if (n > NCMP - 1) n = NCMP - 1; return (unsigned)n * 1024u; } } af{src, tm * 256};
    EpiCmp E{&a, kv, bg, tm * 256, li};
    BClamp64 bf{INP(a, kv ? I_CWV : I_CWK) + (size_t)li * 2048 * 64};
    gemm_tile2(smem, af, bf, 64, 2048, E);
}
DEV void moe_gemm_phase8(const Args& a, unsigned char* smem, int l, int mode) {
    unsigned char* ws = wsp(a); const int* cnt = (const int*)(ws + WS_CNT) + l * 32 * 64;
    int* rb = (int*)(smem + 140 * 1024);
    moe_bases(cnt, rb);
    const int mrows = rb[32];
    if (mode == 0) {
        pg8::Gemm g{(const bf16*)(ws + WS_H), (const bf16*)(ws + WS_W13) + (size_t)l * 32 * 2 * FF * DM, mrows, 2 * FF, DM}; pg8::StaticOrder S; S.init(mrows, 2 * FF, NBLK, BID);
        EpiMoe1_8 E{(bf16*)(ws + WS_ACT)}; MoeSel<true> X{rb, cnt, (const int*)(ws + WS_LIST), (size_t)2 * FF * DM * 2};
        SYNC(); pg8::gemm_phase<EpiMoe1_8, pg8::StaticOrder, true, true, MoeSel<true>>(PG8_LDS(smem), g, S, E, X); SYNC();
    } else {
        pg8::Gemm g{(const bf16*)(ws + WS_ACT), (const bf16*)(ws + WS_W2) + (size_t)l * 32 * DM * FF, mrows, DM, FF}; pg8::StaticOrder S; S.init(mrows, DM, NBLK, BID);
        EpiMoe2_8 E{(bf16*)(ws + WS_YK)}; MoeSel<false> X{rb, cnt, (const int*)(ws + WS_LIST), (size_t)DM * FF * 2};
        SYNC(); pg8::gemm_phase<EpiMoe2_8, pg8::StaticOrder, true, true, MoeSel<false>>(PG8_LDS(smem), g, S, E, X); SYNC();
    }
}
#ifndef EMU
constexpr int MOE_TMO_IDX = 128;
struct MoeOrder { int nN, t0, nu, j, nper, nA; bool rev;
    __device__ __forceinline__ void init(int ntile, int nN_, int nblk, int bid, bool rev_) { nN = nN_; nper = nblk / 8; rev = rev_; const int x = bid % 8; j = bid / 8;
        t0 = x * ntile / 8; nu = ((x + 1) * ntile / 8 - t0) * nN; if (bid >= 8 * nper) nu = 0;
        nA = nu - 2 * nper; nA = nA < 0 ? 0 : (nA > nper / 2 ? nper / 2 : nA); }
    __device__ __forceinline__ bool next(int i, pg8::Unit& u) const { int p;
        if (!rev) p = i * nper + j;
        else if (j < nA) { if (i > 0) return false; p = nu - nA + j; }
        else { p = i * (nper - nA) + (j - nA); if (p >= nu - nA) return false; }
        if (p >= nu) return false; u.pm = t0 + p / nN; u.pn = p % nN; return true; }
    __device__ __forceinline__ void a_ready(const pg8::Unit&) const {}
    __device__ __forceinline__ void done(const pg8::Unit&) const {}
};
struct MoeProd : MoeOrder { unsigned* flg;
    __device__ __forceinline__ void done(const pg8::Unit& u) const {
        asm volatile("s_waitcnt vmcnt(0)" ::: "memory"); __builtin_amdgcn_s_barrier(); asm volatile("" ::: "memory");
        if (TID == 0) (void)__hip_atomic_fetch_add((__attribute__((address_space(1))) unsigned*)(flg + u.pm * 16), 1u, __ATOMIC_RELAXED, __HIP_MEMORY_SCOPE_AGENT); } };
struct MoeCons : MoeOrder { unsigned* flg; unsigned* tmo;
    __device__ __forceinline__ void a_ready(const pg8::Unit& u) const {
        if ((TID >> 6) == 0) { unsigned sp = 0u; __attribute__((address_space(1))) unsigned* f = (__attribute__((address_space(1))) unsigned*)(flg + u.pm * 16);
            while ((unsigned)__builtin_amdgcn_readfirstlane((int)__hip_atomic_load(f, __ATOMIC_RELAXED, __HIP_MEMORY_SCOPE_AGENT)) < (unsigned)(2 * FF / 256)) {
                __builtin_amdgcn_s_sleep(1);
                if ((++sp & 255u) == 0u) { if (__hip_atomic_load((__attribute__((address_space(1))) unsigned*)tmo, __ATOMIC_RELAXED, __HIP_MEMORY_SCOPE_AGENT)) break;
                    if (sp > (1u << 22)) { (void)__hip_atomic_fetch_add((__attribute__((address_space(1))) unsigned*)tmo, 1u, __ATOMIC_RELAXED, __HIP_MEMORY_SCOPE_AGENT); break; } } }
            __builtin_amdgcn_fence(__ATOMIC_ACQUIRE, "agent"); }
        asm volatile("" ::: "memory"); __builtin_amdgcn_s_barrier(); asm volatile("" ::: "memory"); } };
DEV void moe_fused_phase(const Args& a, unsigned char* smem, int l) {
    unsigned char* ws = wsp(a); const int* cnt = (const int*)(ws + WS_CNT) + l * 32 * 64;
    int* rb = (int*)(smem + 140 * 1024);
    moe_bases(cnt, rb);
    const int mrows = rb[32]; unsigned* flg = (unsigned*)(ws + WS_FLG) + (size_t)l * 256 * 16;
    { pg8::Gemm g{(const bf16*)(ws + WS_H), (const bf16*)(ws + WS_W13) + (size_t)l * 32 * 2 * FF * DM, mrows, 2 * FF, DM}; MoeProd S; S.init(mrows >> 8, 2 * FF / 256, NBLK, BID, false); S.flg = flg;
      EpiMoe1_8 E{(bf16*)(ws + WS_ACT)}; MoeSel<true> X{rb, cnt, (const int*)(ws + WS_LIST), (size_t)2 * FF * DM * 2};
      SYNC(); pg8::gemm_phase<EpiMoe1_8, MoeProd, true, true, MoeSel<true>>(PG8_LDS(smem), g, S, E, X); }
    { pg8::Gemm g{(const bf16*)(ws + WS_ACT), (const bf16*)(ws + WS_W2) + (size_t)l * 32 * DM * FF, mrows, DM, FF}; MoeCons S; S.init(mrows >> 8, DM / 256, NBLK, BID, true); S.flg = flg; S.tmo = (unsigned*)(ws + WS_BAR) + MOE_TMO_IDX;
      EpiMoe2_8 E{(bf16*)(ws + WS_YK)}; MoeSel<false> X{rb, cnt, (const int*)(ws + WS_LIST), (size_t)DM * FF * 2};
      SYNC(); pg8::gemm_phase<EpiMoe2_8, MoeCons, true, true, MoeSel<false>>(PG8_LDS(smem), g, S, E, X); SYNC(); }
}
#endif
DEV void moe_gemm_phase(const Args& a, unsigned char* smem, int l, int mode) {
    unsigned char* ws = wsp(a); const int* cnt = (const int*)(ws + WS_CNT) + l * 32 * 64;
    int* rb = (int*)(smem + GEMM2_LDS);
    moe_bases(cnt, rb);
    const int ntile = rb[32] >> 8;
    constexpr int TN1 = 2 * FF / 128, TN2 = DM / 128;
    const int TN = mode == 0 ? TN1 : TN2;
    const int* list = (const int*)(ws + WS_LIST);
    for (int it = vbid(); it < ntile * TN; it += NBLK) {
        const int rt = it / TN, tn = it % TN; int e = 0;
#pragma unroll 1
        for (int q = 1; q < 32; ++q) if ((rb[q] >> 8) <= rt) e = q;
        const int rloc = (rt << 8) - rb[e], ce = cnt[e * 64], nvalid = (ce - rloc) < 256 ? (ce - rloc) : 256;
        if (mode == 0) {
            struct AF { const bf16* base; const int* lst; int nv; MDEV unsigned off(int r) const { const int rr = r < nv ? r : nv - 1; return (unsigned)lst[rr] * (unsigned)DM; } }
                af{(const bf16*)(ws + WS_H), list + (size_t)e * T + rloc, nvalid};
            EpiGated<1> E{(bf16*)(ws + WS_ACT), (size_t)FF, rt << 8, tn * 128, nvalid};
            BInter bf{INP(a, I_W1) + (size_t)(l * 32 + e) * DM * FF, INP(a, I_W3) + (size_t)(l * 32 + e) * DM * FF, tn * 128};
            gemm_tile2(smem, af, bf, FF, DM, E);
        } else {
            ARows af{(const bf16*)(ws + WS_ACT) + (size_t)(rt << 8) * FF, (size_t)FF};
            EpiStoreBf E{(bf16*)(ws + WS_YK), (size_t)DM, rt << 8, tn * 128, nvalid};
            BPlain bf{INP(a, I_W2) + (size_t)(l * 32 + e) * FF * DM + tn * 128};
            gemm_tile2(smem, af, bf, DM, FF, E);
        }
    }
}

constexpr int LDV = 80;
constexpr int AT_K = 0, AT_V = 2 * 64 * LDT * 2, AT_IMP = AT_V + 2 * 64 * LDV * 2, AT_SEL = AT_IMP + 8 * 8 * 128 * 4, AT_GSEL = AT_SEL + 8 * 8 * 4 * 4, AT_OUT = AT_GSEL + 8 * 2 * 4 * 4, AT_END = AT_OUT + 8 * 32 * 64 * 4;
#ifdef EMU
DEV float rexp2(float x) { return exp2f(x); }
DEV unsigned uni(unsigned x) { return x; }
#else
DEV float rexp2(float x) { return __builtin_amdgcn_exp2f(x); }
DEV unsigned uni(unsigned x) { return (unsigned)__builtin_amdgcn_readfirstlane((int)x); }
#endif
DEV int krow_lds(int kappa) { return 16 * (2 * (kappa >> 5) + ((kappa >> 2) & 1)) + 4 * ((kappa >> 3) & 3) + (kappa & 3); }
template <int MASK, bool FULL, int GM>
DEV void attn_block(const bf16* Kp, const bf16* Vp, const bf16x8 (&qf)[2][2], int j, const int (&s)[2], const bool (&selbit)[2], float C2, int h, int c,
                    f32x4 (&O)[2][4], f32x4 (&Ol)[2]) {
    f32x4 st[2][2][2];
#pragma unroll
    for (int sp = 0; sp < 2; ++sp)
#pragma unroll
        for (int u = 0; u < 2; ++u) {
#pragma unroll
            for (int G = 0; G < 2; ++G) { st[G][sp][u][0] = -C2; st[G][sp][u][1] = -C2; st[G][sp][u][2] = -C2; st[G][sp][u][3] = -C2; }
#pragma unroll
            for (int ks = 0; ks < 2; ++ks) { const bf16x8 kf = *(const bf16x8*)(Kp + (16 * (2 * sp + u) + c) * LDT + 32 * ks + 8 * h);
#pragma unroll
                for (int G = 0; G < 2; ++G) if (GM & (1 << G)) st[G][sp][u] = mfma16(kf, qf[G][ks], st[G][sp][u]); } }
#pragma unroll
    for (int G = 0; G < 2; ++G) if (GM & (1 << G))
#pragma unroll
        for (int sp = 0; sp < 2; ++sp)
#pragma unroll
            for (int u = 0; u < 2; ++u)
#pragma unroll
                for (int r = 0; r < 4; ++r) { bool ok = selbit[G];
                    if (!FULL) { const int key = 64 * j + 32 * sp + 8 * h + 4 * u + r;
                        if (MASK == 0) ok = 16 * key + 31 <= s[G]; else if (MASK == 1) ok = selbit[G] && key <= s[G]; else ok = key <= s[G] && key > s[G] - 512; }
                    st[G][sp][u][r] = ok ? rexp2(st[G][sp][u][r]) : 0.f; }
    bf16x8 pb[2][2], ones;
#pragma unroll
    for (int q = 0; q < 8; ++q) ones[q] = (short)0x3F80;
#pragma unroll
    for (int G = 0; G < 2; ++G) if (GM & (1 << G))
#pragma unroll
        for (int sp = 0; sp < 2; ++sp) { pb[G][sp] = pack8(st[G][sp][0], st[G][sp][1]); Ol[G] = mfma16(ones, pb[G][sp], Ol[G]); }
    const bf16* Vb = Vp + bperm(8 * h + (c >> 2)) * LDV + 4 * (c & 3);
#pragma unroll
    for (int et = 0; et < 4; ++et)
#pragma unroll
        for (int sp = 0; sp < 2; ++sp) { const bf16x8 vf = tr_read8(Vb + (32 * sp) * LDV + 16 * et, Vb + (32 * sp + 8) * LDV + 16 * et);
#pragma unroll
            for (int G = 0; G < 2; ++G) if (GM & (1 << G)) O[G][et] = mfma16(vf, pb[G][sp], O[G][et]); }
}

struct ImpState { float invq[2][4]; float carry[2]; float* imps; int tl, hd, l, s0, qblk; };
DEV void imp_block(const bf16* Kp, const bf16x8 (&qf)[2][2], int j, int s0, int w, float C2, int h, int c, ImpState& im) {
#pragma unroll
    for (int kt = 0; kt < 4; ++kt) {
        const int row = krow_lds(16 * kt + c);
        const bf16x8 k0 = *(const bf16x8*)(Kp + row * LDT + 8 * h), k1 = *(const bf16x8*)(Kp + row * LDT + 32 + 8 * h);
        const int n = 64 * j + 16 * kt + c;
#pragma unroll
        for (int G = 0; G < 2; ++G) {
            f32x4 acc; acc[0] = -C2; acc[1] = -C2; acc[2] = -C2; acc[3] = -C2;
            acc = mfma16(qf[G][0], k0, acc); acc = mfma16(qf[G][1], k1, acc);
            const bool ok = 16 * n + 31 <= s0 + 8 * w + 4 * G + h;
            float imp = 0.f;
#pragma unroll
            for (int r = 0; r < 4; ++r) imp += ok ? rexp2(acc[r]) * im.invq[G][r] : 0.f;
            const float v = ((c & 3) == 3) ? imp : 2.0f * imp;
            float sq = v + shflx(v, 1); sq += shflx(sq, 2);
            const float rr = dpp_ror1(imp);
            const float prev = (c == 0) ? im.carry[G] : rr;
            im.carry[G] = rr;
            const int m = n >> 2;
            if ((c & 3) == 0 && m < 128) im.imps[(G * 4 + h) * 128 + m] = sq + prev;
        }
    }
}

template <int MODE>
DEV void attn_branch(bf16* Kl, bf16* Vl, const bf16* kbase, const bf16* vbase, int jlo, int jhi,
                     const bf16x8 (&qf)[2][2], const int (&s)[2], const unsigned* selm, const unsigned* gselm, float C2, int w, int h, int c, int srow, int scol,
                     f32x4 (&O)[2][4], f32x4 (&Ol)[2], ImpState& im) {
    constexpr bool PV = MODE != 1; constexpr int MASK = MODE <= 1 ? 0 : MODE - 1;
    const int krow = krow_lds(srow) * LDT + scol, vrow = bperm(srow) * LDV + scol;
    bf16x8 rk[3], rv[3];
    { const bf16x8 k0 = *(const bf16x8*)(kbase + (size_t)jlo * 4096); *(bf16x8*)(Kl + krow) = k0;
      if (PV) { const bf16x8 v0 = *(const bf16x8*)(vbase + (size_t)jlo * 4096); *(bf16x8*)(Vl + vrow) = v0; } }
#pragma unroll
    for (int u = 0; u < 3; ++u) { int jj = jlo + 1 + u; if (jj > jhi) jj = jhi; rk[(1 + u) % 3] = *(const bf16x8*)(kbase + (size_t)jj * 4096); if (PV) rv[(1 + u) % 3] = *(const bf16x8*)(vbase + (size_t)jj * 4096); }
    SYNC();
    for (int jb = jlo; jb <= jhi; jb += 3) {
#pragma unroll
        for (int u = 0; u < 3; ++u) { const int j = jb + u;
            if (j <= jhi) {
                const int cur = (j - jlo) & 1;
                const bf16* Kc = Kl + cur * 64 * LDT; const bf16* Vc = Vl + cur * 64 * LDV;
                if (MODE == 1) imp_block(Kc, qf, j, im.s0, w, C2, h, c, im);
                else {
                    bool sb[2] = {true, true}; unsigned gm = 3u;
                    if (MODE == 2) { gm = 0u;
#pragma unroll
                        for (int G = 0; G < 2; ++G) { const unsigned wq = uni(gselm[G * 4 + (j >> 5)]), mq = selm[(G * 4 + im.tl) * 4 + (j >> 5)];
                            gm |= ((wq >> (j & 31)) & 1u) << G; sb[G] = (mq >> (j & 31)) & 1u; } }
                    bool full;
                    if (MODE == 0) full = 1024 * j + 1039 <= im.s0; else if (MODE == 2) full = j < im.qblk; else full = (j < im.qblk) && (64 * j > im.s0 + 63 - 512);
                    if (MODE == 2) {
                        if (full) { if (gm == 3u) attn_block<MASK, true, 3>(Kc, Vc, qf, j, s, sb, C2, h, c, O, Ol); else if (gm == 1u) attn_block<MASK, true, 1>(Kc, Vc, qf, j, s, sb, C2, h, c, O, Ol); else if (gm == 2u) attn_block<MASK, true, 2>(Kc, Vc, qf, j, s, sb, C2, h, c, O, Ol); }
                        else { if (gm == 3u) attn_block<MASK, false, 3>(Kc, Vc, qf, j, s, sb, C2, h, c, O, Ol); else if (gm == 1u) attn_block<MASK, false, 1>(Kc, Vc, qf, j, s, sb, C2, h, c, O, Ol); else if (gm == 2u) attn_block<MASK, false, 2>(Kc, Vc, qf, j, s, sb, C2, h, c, O, Ol); }
                    } else { if (full) attn_block<MASK, true, 3>(Kc, Vc, qf, j, s, sb, C2, h, c, O, Ol); else attn_block<MASK, false, 3>(Kc, Vc, qf, j, s, sb, C2, h, c, O, Ol); }
                }
                if (j + 1 <= jhi) {
                    *(bf16x8*)(Kl + (cur ^ 1) * 64 * LDT + krow) = rk[(u + 1) % 3]; if (PV) *(bf16x8*)(Vl + (cur ^ 1) * 64 * LDV + vrow) = rv[(u + 1) % 3];
                    int jj = j + 4; if (jj > jhi) jj = jhi;
                    rk[(u + 1) % 3] = *(const bf16x8*)(kbase + (size_t)jj * 4096); if (PV) rv[(u + 1) % 3] = *(const bf16x8*)(vbase + (size_t)jj * 4096);
                }
                SYNC();
            }
        }
    }
}

DEV void attn_task(const Args& a, unsigned char* smem, int li, int item) {
    unsigned char* ws = wsp(a); const int tid = TID, w = tid >> 6, l = tid & 63, h = l >> 4, c = l & 15, tl = c >> 2, hd = c & 3;
    const int bg = item & 3, b = bg >> 1, g = bg & 1, tq = (SEQ / 64 - 1) - (item >> 2), s0 = tq * 64, qblk = tq;
    int s[2], row[2];
#pragma unroll
    for (int G = 0; G < 2; ++G) { s[G] = s0 + 8 * w + 4 * G + tl; row[G] = b * SEQ + s[G]; }
    bf16* Kl = (bf16*)(smem + AT_K); bf16* Vl = (bf16*)(smem + AT_V); float* imps = (float*)(smem + AT_IMP) + w * 1024; unsigned* selm = (unsigned*)(smem + AT_SEL) + w * 32;
    bf16x8 qf[2][2]; float gatec[2], gates[2], gatew[2];
#pragma unroll
    for (int G = 0; G < 2; ++G) { const bf16* qp = (const bf16*)(ws + WS_QN) + (size_t)row[G] * 512 + (g * 4 + hd) * 64 + 8 * h; qf[G][0] = *(const bf16x8*)qp; qf[G][1] = *(const bf16x8*)(qp + 32);
        const float* gp = (const float*)(ws + WS_GATE) + (size_t)row[G] * 24 + (g * 4 + hd) * 3; gatec[G] = gp[0]; gates[G] = gp[1]; gatew[G] = gp[2]; }
    const float* cs = (const float*)(ws + WS_CS) + li * 4;
    const int srow = tid >> 3, scol = (tid & 7) * 8;
    for (int i = l; i < 1024; i += 64) imps[i] = 0.f;
    SYNC();
    unsigned* gselm = (unsigned*)(smem + AT_GSEL) + w * 8; float* outl = (float*)(smem + AT_OUT) + w * 2048 + l;
    ImpState im{{{0.f, 0.f, 0.f, 0.f}, {0.f, 0.f, 0.f, 0.f}}, {0.f, 0.f}, imps, tl, hd, l, s0, qblk};
    {
        const int ncv = s0 / 16 + 3, ncb0 = (ncv + 63) >> 6, ncb = ncb0 > NCP / 64 ? NCP / 64 : ncb0;
        const bf16* kcb = (const bf16*)(ws + WS_KC) + (size_t)bg * NCP * 64 + tid * 8;
        const bf16* vcb = (const bf16*)(ws + WS_VCT) + (size_t)bg * NCP * 64 + tid * 8;
        f32x4 O[2][4], Ol[2] = {f4zero(), f4zero()};
#pragma unroll
        for (int G = 0; G < 2; ++G)
#pragma unroll
            for (int et = 0; et < 4; ++et) O[G][et] = f4zero();
        attn_branch<0>(Kl, Vl, kcb, vcb, 0, ncb - 1, qf, s, selm, gselm, cs[0], w, h, c, srow, scol, O, Ol, im);
#pragma unroll
        for (int G = 0; G < 2; ++G) { const float lsum = Ol[G][0]; const float invl = lsum > 0.f ? 1.0f / lsum : 0.f;
#pragma unroll
            for (int r = 0; r < 4; ++r) im.invq[G][r] = shfl(invl, 4 * h + r);
#pragma unroll
            for (int et = 0; et < 4; ++et)
#pragma unroll
                for (int r = 0; r < 4; ++r) outl[((G * 4 + et) * 4 + r) * 64] = gatec[G] * invl * O[G][et][r]; }
        f32x4 ld[2] = {f4zero(), f4zero()};
        attn_branch<1>(Kl, Vl, kcb, vcb, 0, ncb - 1, qf, s, selm, gselm, cs[0], w, h, c, srow, scol, O, ld, im);
    }
    WSYNC();
#pragma unroll 1
    for (int G = 0; G < 2; ++G) {
        const int tk = l >> 4, i = l & 15; float vals[8];
#pragma unroll
        for (int mm = 0; mm < 8; ++mm) { const int jj = i + 16 * mm; vals[mm] = jj > qblk ? NEGV : ((jj == 0 || jj == qblk || jj == qblk - 1) ? FORCEV : imps[(G * 4 + tk) * 128 + jj]); }
        unsigned mk[4] = {0u, 0u, 0u, 0u};
#pragma unroll 1
        for (int rnd = 0; rnd < 16; ++rnd) {
            float best = vals[0]; int bj = i;
#pragma unroll
            for (int mm = 1; mm < 8; ++mm) if (vals[mm] > best) { best = vals[mm]; bj = i + 16 * mm; }
#pragma unroll
            for (int o = 1; o < 16; o <<= 1) { const float ov = shflx(best, o); const int oj = shflxi(bj, o); if (ov > best || (ov == best && oj < bj)) { best = ov; bj = oj; } }
            if (best > NEGV * 0.5f) {
#pragma unroll
                for (int q = 0; q < 4; ++q) if ((bj >> 5) == q) mk[q] |= 1u << (bj & 31); }
            if ((bj & 15) == i) {
#pragma unroll
                for (int mm = 0; mm < 8; ++mm) if ((bj >> 4) == mm) vals[mm] = -3e38f; }
        }
        if (i == 0) {
#pragma unroll
            for (int q = 0; q < 4; ++q) selm[(G * 4 + tk) * 4 + q] = mk[q]; }
    }
    WSYNC();
    if (l < 8) { const int G = l >> 2, q = l & 3; gselm[l] = selm[(G * 4 + 0) * 4 + q] | selm[(G * 4 + 1) * 4 + q] | selm[(G * 4 + 2) * 4 + q] | selm[(G * 4 + 3) * 4 + q]; }
    WSYNC();
#pragma unroll
    for (int br = 0; br < 2; ++br) {
        const bf16* kb = (const bf16*)(ws + (br == 0 ? WS_KS : WS_KW)) + (size_t)bg * SEQ * 64 + tid * 8; const bf16* vb = (const bf16*)(ws + (br == 0 ? WS_VST : WS_VWT)) + (size_t)bg * SEQ * 64 + tid * 8;
        f32x4 O[2][4], Ol[2] = {f4zero(), f4zero()};
#pragma unroll
        for (int G = 0; G < 2; ++G)
#pragma unroll
            for (int et = 0; et < 4; ++et) O[G][et] = f4zero();
        if (br == 0) attn_branch<2>(Kl, Vl, kb, vb, 0, qblk, qf, s, selm, gselm, cs[1], w, h, c, srow, scol, O, Ol, im);
        else attn_branch<3>(Kl, Vl, kb, vb, s0 >= 511 ? (s0 - 511) >> 6 : 0, qblk, qf, s, selm, gselm, cs[2], w, h, c, srow, scol, O, Ol, im);
#pragma unroll
        for (int G = 0; G < 2; ++G) { const float lsum = Ol[G][0]; const float sc = (br == 0 ? gates[G] : gatew[G]) * (lsum > 0.f ? 1.0f / lsum : 0.f);
#pragma unroll
            for (int et = 0; et < 4; ++et)
#pragma unroll
                for (int r = 0; r < 4; ++r) outl[((G * 4 + et) * 4 + r) * 64] += sc * O[G][et][r]; }
    }
#pragma unroll
    for (int G = 0; G < 2; ++G) { bf16* dst = (bf16*)(ws + WS_CAT) + (size_t)row[G] * 1024 + (g * 4 + hd) * 64 + 4 * h;
#pragma unroll
        for (int et = 0; et < 4; ++et) { f32x4 o;
#pragma unroll
            for (int r = 0; r < 4; ++r) o[r] = outl[((G * 4 + et) * 4 + r) * 64];
            st_bf4(dst + 16 * et, o); } }
}

constexpr int LDH = 136;
DEV void hg_cumsum(const float* fsrc  , float* segs  , int d, int seg, float (&f)[16], float (&bc)[16], float& bend, float& bmid) {
    float run = 0.f;
#pragma unroll
    for (int i = 0; i < 16; ++i) { f[i] = fsrc[(size_t)(16 * seg + i) * 128 + d]; run += log2f(f[i]); bc[i] = run; }
    SYNC();
    segs[seg * 128 + d] = run;
    SYNC();
    const float s0 = segs[d], s1 = segs[128 + d], s2 = segs[256 + d], s3 = segs[384 + d];
    const float off = seg == 0 ? 0.f : (seg == 1 ? s0 : (seg == 2 ? s0 + s1 : s0 + s1 + s2));
#pragma unroll
    for (int i = 0; i < 16; ++i) bc[i] += off;
    bend = s0 + s1 + s2 + s3; bmid = s0 + s1;
}
DEV void hg_write16(bf16* dstrow  , const float (&v)[16]) {
    u32x4 w0, w1;
#pragma unroll
    for (int q = 0; q < 4; ++q) { w0[q] = pk2(v[2 * q], v[2 * q + 1]); w1[q] = pk2(v[8 + 2 * q], v[8 + 2 * q + 1]); }
    *(u32x4*)dstrow = w0; *(u32x4*)(dstrow + 8) = w1;
}
DEV void hg_h1_task(const Args& a, unsigned char* smem, int task) {
    unsigned char* ws = wsp(a); const int tid = TID, w = tid >> 6, l = tid & 63, h = l >> 4, c = l & 15, d = tid & 127, seg = tid >> 7;
    const int bh = task / NCH, ch = task % NCH;
    bf16* kT = (bf16*)smem; bf16* vT = kT + 128 * LDT; float* segs = (float*)(vT + 128 * LDT);
    const size_t tokb = (size_t)bh * SEQ + ch * 64;
    float f[16], bc[16], bend, bmid;
    const bf16* vs = (const bf16*)(ws + WS_HV) + tokb * 128;
    bf16 vraw[16];
#pragma unroll
    for (int i = 0; i < 16; ++i) vraw[i] = vs[(size_t)(16 * seg + i) * 128 + d];
    hg_cumsum((const float*)(ws + WS_HF) + tokb * 128, segs, d, seg, f, bc, bend, bmid);
    float kv[16];
#pragma unroll
    for (int i = 0; i < 16; ++i) kv[i] = (1.0f - f[i]) * fexp2(bend - bc[i]);
    hg_write16(kT + d * LDT + 16 * seg, kv);
#pragma unroll
    for (int i = 0; i < 16; ++i) kv[i] = bf2f(vraw[i]);
    hg_write16(vT + d * LDT + 16 * seg, kv);
    if (seg == 0) ((float*)(ws + WS_GD))[((size_t)bh * NCH + ch) * 128 + d] = fexp2(bend);
    SYNC();
    f32x4 acc[8];
#pragma unroll
    for (int et = 0; et < 8; ++et) acc[et] = f4zero();
#pragma unroll
    for (int ks = 0; ks < 2; ++ks) { const bf16x8 fa = *(const bf16x8*)(kT + (16 * w + c) * LDT + 32 * ks + 8 * h);
#pragma unroll
        for (int et = 0; et < 8; ++et) acc[et] = mfma16(fa, *(const bf16x8*)(vT + (16 * et + c) * LDT + 32 * ks + 8 * h), acc[et]); }
    float* ut = (float*)(ws + WS_UT) + ((size_t)bh * NCH + ch) * 16384;
#pragma unroll
    for (int et = 0; et < 8; ++et) *(f32x4*)(ut + (size_t)(16 * et + c) * 128 + 16 * w + 4 * h) = acc[et];
    SYNC();
}
DEV void hg_scan_task(const Args& a, int sc) {
    unsigned char* ws = wsp(a); const int bh = sc >> 3, q = (sc & 7) * 512 + TID, e = q >> 5, d0 = (q & 31) * 4;
    const float* ut = (const float*)(ws + WS_UT) + (size_t)bh * NCH * 16384 + (size_t)e * 128 + d0;
    const float* gd = (const float*)(ws + WS_GD) + (size_t)bh * NCH * 128 + d0;
    bf16* st = (bf16*)(ws + WS_ST) + (size_t)bh * NCH * 16384 + (size_t)e * 128 + d0;
    f32x4 S = f4zero();
#pragma unroll 4
    for (int ch = 0; ch < NCH; ++ch) { st_bf4(st + (size_t)ch * 16384, S);
        const f32x4 g = *(const f32x4*)(gd + (size_t)ch * 128), u = *(const f32x4*)(ut + (size_t)ch * 16384);
#pragma unroll
        for (int r = 0; r < 4; ++r) S[r] = g[r] * S[r] + u[r]; }
}
DEV void hg_h3_task(const Args& a, unsigned char* smem, int li, int task) {
    unsigned char* ws = wsp(a); const int tid = TID, w = tid >> 6, l = tid & 63, h = l >> 4, c = l & 15, d = tid & 127, seg = tid >> 7;
    const int bh = task / NCH, ch = task % NCH, b = bh >> 2, hh = bh & 3;
    bf16* At = (bf16*)smem; bf16* Bt = At + 64 * LDH; bf16* Qt = Bt + 64 * LDH; bf16* vT = Qt + 64 * LDH; float* segs = (float*)(vT + 128 * LDT); float* part = segs + 512;
    const size_t tokb = (size_t)bh * SEQ + ch * 64;
    float f[16], bc[16], bend, bmid;
    const bf16* qs = (const bf16*)(ws + WS_HQ) + tokb * 128; const bf16* vs = (const bf16*)(ws + WS_HV) + tokb * 128;
    const int tt = w & 3, eh = w >> 2;
    bf16 qraw[16], vraw[16];
#pragma unroll
    for (int i = 0; i < 16; ++i) { const int t = 16 * seg + i; qraw[i] = qs[(size_t)t * 128 + d]; vraw[i] = vs[(size_t)t * 128 + d]; }
    const bf16* stp = (const bf16*)(ws + WS_ST) + ((size_t)bh * NCH + ch) * 16384;
    bf16x8 stf[4][4];
#pragma unroll
    for (int ks = 0; ks < 4; ++ks)
#pragma unroll
        for (int et = 0; et < 4; ++et) stf[ks][et] = *(const bf16x8*)(stp + (size_t)(64 * eh + 16 * et + c) * 128 + 32 * ks + 8 * h);
    const int tok = b * SEQ + ch * 64 + 16 * tt + c;
    const bf16* hg = (const bf16*)(ws + WS_HGS) + (size_t)tok * 512 + hh * 128;
    u32x2 hgv[4];
#pragma unroll
    for (int et = 0; et < 4; ++et) hgv[et] = *(const u32x2*)(hg + 64 * eh + 16 * et + 4 * h);
    hg_cumsum((const float*)(ws + WS_HF) + tokb * 128, segs, d, seg, f, bc, bend, bmid);
    float vv[16];
#pragma unroll
    for (int i = 0; i < 16; ++i) { const int t = 16 * seg + i; const float q = bf2f(qraw[i]);
        At[t * LDH + d] = (bf16)f2bf(q * fexp2(bc[i] - bmid)); Bt[t * LDH + d] = (bf16)f2bf((1.0f - f[i]) * fexp2(bmid - bc[i])); Qt[t * LDH + d] = (bf16)f2bf(q * fexp2(bc[i]));
        vv[i] = bf2f(vraw[i]); }
    hg_write16(vT + d * LDT + 16 * seg, vv);
    SYNC();
    f32x4 O[4];
#pragma unroll
    for (int et = 0; et < 4; ++et) O[et] = f4zero();
#pragma unroll
    for (int sp = 0; sp < 2; ++sp) {
        if (32 * sp > 16 * tt + 15) continue;
        f32x4 st[2];
#pragma unroll
        for (int u = 0; u < 2; ++u) { st[u] = f4zero(); const int krow = 32 * sp + 8 * (c >> 2) + 4 * u + (c & 3);
#pragma unroll
            for (int ks = 0; ks < 4; ++ks) st[u] = mfma16(*(const bf16x8*)(Bt + krow * LDH + 32 * ks + 8 * h), *(const bf16x8*)(At + (16 * tt + c) * LDH + 32 * ks + 8 * h), st[u]);
#pragma unroll
            for (int r = 0; r < 4; ++r) { const int sk = 32 * sp + 8 * h + 4 * u + r; if (sk > 16 * tt + c) st[u][r] = 0.f; } }
        const bf16x8 pb = pack8(st[0], st[1]);
#pragma unroll
        for (int et = 0; et < 4; ++et) O[et] = mfma16(*(const bf16x8*)(vT + (64 * eh + 16 * et + c) * LDT + 32 * sp + 8 * h), pb, O[et]);
    }
#pragma unroll
    for (int ks = 0; ks < 4; ++ks) { const bf16x8 fq = *(const bf16x8*)(Qt + (16 * tt + c) * LDH + 32 * ks + 8 * h);
#pragma unroll
        for (int et = 0; et < 4; ++et) O[et] = mfma16(stf[ks][et], fq, O[et]); }
    float ss = 0.f;
#pragma unroll
    for (int et = 0; et < 4; ++et)
#pragma unroll
        for (int r = 0; r < 4; ++r) ss += O[et][r] * O[et][r];
    ss += shflx(ss, 16); ss += shflx(ss, 32);
    if (h == 0) part[eh * 64 + 16 * tt + c] = ss;
    SYNC();
    const float rs = frsq((part[16 * tt + c] + part[64 + 16 * tt + c]) * (1.0f / 128.0f) + EPS);
    const float* og = INP(a, I_OG) + li * 128;
    bf16* dst = (bf16*)(ws + WS_CAT) + (size_t)tok * 1024 + 512 + hh * 128;
#pragma unroll
    for (int et = 0; et < 4; ++et) { const int e = 64 * eh + 16 * et + 4 * h; f32x4 o; const f32x4 ogv = *(const f32x4*)(og + e);
        o[0] = O[et][0] * rs * ogv[0] * bf2f(hgv[et][0] & 0xffff); o[1] = O[et][1] * rs * ogv[1] * bf2f(hgv[et][0] >> 16);
        o[2] = O[et][2] * rs * ogv[2] * bf2f(hgv[et][1] & 0xffff); o[3] = O[et][3] * rs * ogv[3] * bf2f(hgv[et][1] >> 16);
        st_bf4(dst + e, o); }
    SYNC();
}

constexpr int CTS = 16;
DEV void conv_task(const Args& a, unsigned char* smem, int li, int task) {
    unsigned char* ws = wsp(a); const int tid = TID, w = tid >> 6, lane = tid & 63;
    const bool act = tid < DM / 2; const int c0 = act ? 2 * tid : 0;
    const int tb = task * 64, b = tb / SEQ, sb = tb % SEQ;
    float* red = (float*)smem;
    const float b0 = INP(a, I_DWB)[li * DM + c0], b1 = INP(a, I_DWB)[li * DM + c0 + 1];
    const float g0 = INP(a, I_LNG)[li * DM + c0], g1 = INP(a, I_LNG)[li * DM + c0 + 1], e0 = INP(a, I_LNB)[li * DM + c0], e1 = INP(a, I_LNB)[li * DM + c0 + 1];
    const bf16* glu = (const bf16*)(ws + WS_GLU) + (size_t)b * SEQ * DM + c0;
    float* lw = (float*)(smem + 4096);
    SYNC();
    for (int i = tid * 4; i < 31 * DM; i += NT * 4) *(f32x4*)(lw + i) = *(const f32x4*)(INP(a, I_DW) + (size_t)li * 31 * DM + i);
    SYNC();
    f32x2v uf[30 + CTS]; unsigned nx[CTS];
    { const bf16* gp = glu + (size_t)(sb - 30) * DM;
#pragma unroll
      for (int r = 0; r < 30; ++r) { const int si = sb + r - 30; const unsigned q = si >= 0 ? *(const unsigned*)gp : 0u; gp += DM; OPAQUE(gp); uf[r][0] = bf2f(q & 0xffff); uf[r][1] = bf2f(q >> 16); }
#pragma unroll
      for (int r = 0; r < CTS; ++r) { nx[r] = *(const unsigned*)gp; gp += DM; OPAQUE(gp); } }
#pragma unroll 1
    for (int step = 0; step < 64 / CTS; ++step) {
        const int s0 = sb + CTS * step, t0 = tb + CTS * step;
#pragma unroll
        for (int r = 0; r < CTS; ++r) { uf[30 + r][0] = bf2f(nx[r] & 0xffff); uf[30 + r][1] = bf2f(nx[r] >> 16); }
        float acc[CTS][2];
        { f32x2v ac2[CTS];
#pragma unroll
          for (int t = 0; t < CTS; ++t) { ac2[t][0] = b0; ac2[t][1] = b1; }
#pragma unroll
          for (int j = 0; j < 31; ++j) { const f32x2v w2 = *(const f32x2v*)(lw + j * DM + c0);
#ifndef EMU
              if ((j & 3) == 3) asm volatile("" ::: "memory");
#endif
#pragma unroll
              for (int t = 0; t < CTS; ++t) ac2[t] += w2 * uf[t + j]; }
#pragma unroll
          for (int t = 0; t < CTS; ++t) { acc[t][0] = ac2[t][0]; acc[t][1] = ac2[t][1]; } }
#pragma unroll
        for (int r = 0; r < 30; ++r) uf[r] = uf[r + CTS];
        if (step < 64 / CTS - 1) { const bf16* gp = glu + (size_t)(s0 + CTS) * DM;
#pragma unroll
            for (int r = 0; r < CTS; ++r) { nx[r] = *(const unsigned*)gp; gp += DM; OPAQUE(gp); } }
        { float* rb2 = red + (step & 1) * (8 * CTS * 2);
#pragma unroll
          for (int t = 0; t < CTS; ++t) { float s1 = act ? acc[t][0] + acc[t][1] : 0.f, s2 = act ? acc[t][0] * acc[t][0] + acc[t][1] * acc[t][1] : 0.f;
#pragma unroll
              for (int o = 1; o < 64; o <<= 1) { s1 += shflx(s1, o); s2 += shflx(s2, o); }
              if (lane == 0) { rb2[(w * CTS + t) * 2] = s1; rb2[(w * CTS + t) * 2 + 1] = s2; } }
          SYNC();
          if (act) {
              bf16* dst = (bf16*)(ws + WS_CAT) + (size_t)t0 * DM + c0;
#pragma unroll
              for (int t = 0; t < CTS; ++t) { float s1 = 0.f, s2 = 0.f;
#pragma unroll
                  for (int q = 0; q < 8; ++q) { s1 += rb2[(q * CTS + t) * 2]; s2 += rb2[(q * CTS + t) * 2 + 1]; }
                  const float mean = s1 * (1.0f / DM), var = fmaxf(s2 * (1.0f / DM) - mean * mean, 0.f), rstd = frsq(var + EPS);
                  const float y0 = (acc[t][0] - mean) * rstd * g0 + e0, y1 = (acc[t][1] - mean) * rstd * g1 + e1;
                  *(unsigned*)(dst + (size_t)t * DM) = pk2(siluf(y0), siluf(y1)); }
          } }
    }
}

constexpr int N_PHASES = 1 + 16 * (DEPTH / 2) + 1;
DEV void phase_decode(int ph, int& l, int& sub) {
    const int q = ph - 1, pair = q >> 4, r = q & 15;
    if (r < 9) { l = 2 * pair; sub = r; } else { l = 2 * pair + 1; const int rr = r - 9; sub = rr < 3 ? rr : rr + 2; }
}
constexpr int LDS_BYTES = 150 * 1024;

DEV void run_phase(const Args& a, unsigned char* smem, int ph) {
#ifndef ONLY
#define ONLY -1
#endif
#define EN(k) (ONLY < 0 || ONLY == (k))
    if (ph == 0) { if (EN(100)) p0_phase(a, smem); return; }
    if (ph == N_PHASES - 1) { if (EN(0)) norm_phase(a, smem, DEPTH); return; }
    int l, sub; phase_decode(ph, l, sub); const int li = l >> 1; const bool even = (l & 1) == 0;
    unsigned char* ws = wsp(a);
    switch (sub) {
    case 0: if (EN(0)) norm_phase(a, smem, l); break;
    case 1: if (even) { if (EN(1)) inproj_phase(a, smem, li); } else { if (EN(11)) pw1_phase(a, smem, li); } break;
    case 2:
        if (even) { constexpr int NCI = 8 * ((NCP + 255) / 256); constexpr int NH1 = 8 * NCH;
            if (NBLK > 2 * NCI) { const int bid = BID;
                if (bid < NCI) { if (EN(2)) cmp_phase_items(a, smem, li, bid); }
                else { for (int it = bid - NCI; it < NH1; it += NBLK - NCI) if (EN(12)) hg_h1_task(a, smem, it);
#ifndef EMU
                    moe_conv_pull(a, smem, MOE_TAIL_Q);
#endif
                } }
            else for (int it = BID; it < NCI + NH1; it += NBLK) { if (it < NCI) { if (EN(2)) cmp_phase_items(a, smem, li, it); } else { if (EN(12)) hg_h1_task(a, smem, it - NCI); } } }
        else { for (int it = BID; it < T / 64; it += NBLK) if (EN(13)) conv_task(a, smem, li, it); }
        break;
#ifdef EMU
    case 3:
        if (even) { constexpr int NA = 4 * (SEQ / 64); const int G = NBLK;
            for (int r = 0; r * G < NA; ++r) { const int it = r * G + ((r & 1) ? (G - 1 - BID) : BID); if (it < NA) { if (EN(3)) attn_task(a, smem, li, it); } }
            for (int it = BID; it < 64; it += NBLK) if (EN(14)) hg_scan_task(a, it); }
        break;
    case 4: if (even) { for (int it = BID; it < 8 * NCH; it += NBLK) if (EN(4)) hg_h3_task(a, smem, li, it); } break;
#else
    case 3:
        if (even) { constexpr int NA = 4 * (SEQ / 64); const int G = NBLK;
            typedef __attribute__((address_space(1))) unsigned gu32;
            gu32* cw = (gu32*)((unsigned*)(ws + WS_BAR) + P0_CTR_IDX + 1 + 2 * li);
            int nsc = 0;
            for (int it = BID; it < 64; it += NBLK) { hg_scan_task(a, it); ++nsc; }
            if (nsc > 0) { __builtin_amdgcn_fence(__ATOMIC_RELEASE, "agent"); asm volatile("s_waitcnt vmcnt(0)" ::: "memory"); SYNC(); if (TID == 0) (void)__hip_atomic_fetch_add(cw, (unsigned)nsc, __ATOMIC_RELAXED, __HIP_MEMORY_SCOPE_AGENT); }
            for (int r = 0; r * G < NA; ++r) { const int it = r * G + ((r & 1) ? (G - 1 - BID) : BID); if (it < NA) attn_task(a, smem, li, it); }
            if ((TID >> 6) == 0) { unsigned sp = 0u; gu32* tmo = (gu32*)((unsigned*)(ws + WS_BAR) + MOE_TMO_IDX);
                while ((unsigned)__builtin_amdgcn_readfirstlane((int)__hip_atomic_load(cw, __ATOMIC_RELAXED, __HIP_MEMORY_SCOPE_AGENT)) < 64u) {
                    __builtin_amdgcn_s_sleep(1);
                    if ((++sp & 255u) == 0u) { if (__hip_atomic_load(tmo, __ATOMIC_RELAXED, __HIP_MEMORY_SCOPE_AGENT)) break; if (sp > (1u << 22)) { (void)__hip_atomic_fetch_add(tmo, 1u, __ATOMIC_RELAXED, __HIP_MEMORY_SCOPE_AGENT); break; } } }
                __builtin_amdgcn_fence(__ATOMIC_ACQUIRE, "agent"); }
            int* nxl = (int*)(smem + LDS_BYTES - 64);
            int my_next = 0; if (TID == 0) my_next = (int)__hip_atomic_fetch_add(cw + 1, 1u, __ATOMIC_RELAXED, __HIP_MEMORY_SCOPE_AGENT);
            for (;;) { SYNC(); if (TID == 0) nxl[0] = my_next; SYNC(); const int it = nxl[0]; if (it >= 8 * NCH) break;
                if (TID == 0) my_next = (int)__hip_atomic_fetch_add(cw + 1, 1u, __ATOMIC_RELAXED, __HIP_MEMORY_SCOPE_AGENT);
                hg_h3_task(a, smem, li, it); } }
        break;
    case 4: break;
#endif
    case 5:
        if (!EN(5)) break;
        if (even) resid_gemm_phase(a, smem, (const bf16*)(ws + WS_CAT), 1024, (const bf16*)(ws + WS_WOUT) + (size_t)li * DM * 1024, l);
        else resid_gemm_phase(a, smem, (const bf16*)(ws + WS_CAT), DM, (const bf16*)(ws + WS_PW2) + (size_t)li * DM * DM, l);
        break;
    case 6:
#ifndef EMU
        if (l >= 1) moe_conv_drain(a, smem, (l + 1) * 32 * MOE_SPE);
#endif
        if (EN(6)) route_phase(a, smem, l); break;
#ifdef EMU
    case 7: if (EN(7)) moe_gemm_phase8(a, smem, l, 0); break;
    case 8: if (EN(8)) moe_gemm_phase8(a, smem, l, 1); break;
#else
    case 7: if (EN(7)) moe_fused_phase(a, smem, l); break;
    case 8: break;
#endif
    }
}

#ifndef EMU
#define LAS __attribute__((address_space(3)))
#define XB_TMO      128
static_assert(MOE_N0 >= 2 * 32 * MOE_SPE && XB_TMO == MOE_TMO_IDX && P0_CTR_IDX > XB_TMO && P0_CTR_IDX + 1 + DEPTH < 256, "timeout word / free words");
#define XB_XCNT(j)  (256  + 64 * (j))
#define XB_XSUB(j)  (1280 + 64 * (j))
#define XB_XGEN(j)  (2304 + 64 * (j))
#define XB_TOP      3328
#define XB_TOPGEN   3392
#define XCD_BAR_WORDS 3456
#define XB_SPIN_CAP (1u << 22)
__device__ __forceinline__ unsigned xb_ld(unsigned* p)              { return __hip_atomic_load(p, __ATOMIC_RELAXED, __HIP_MEMORY_SCOPE_AGENT); }
__device__ __forceinline__ unsigned xb_add(unsigned* p, unsigned v) { return __hip_atomic_fetch_add(p, v, __ATOMIC_RELAXED, __HIP_MEMORY_SCOPE_AGENT); }
__device__ __forceinline__ unsigned xb_xcc_id() { return (unsigned)__builtin_amdgcn_s_getreg((3 << 11) | 20) & 0xFu; }
#define XB_SPIN(cond, bar) do { unsigned _sp = 0; while (cond) { __builtin_amdgcn_s_sleep(1); \
    if ((++_sp & 255u) == 0u) { if (xb_ld(&(bar)[XB_TMO])) break; if (_sp > XB_SPIN_CAP) { atomicAdd(&(bar)[XB_TMO], 1u); break; } } } } while (0)
struct XcdBarrier { unsigned* bar; unsigned x; volatile LAS unsigned* st; };
__device__ __forceinline__ XcdBarrier xcd_barrier_post(unsigned* bar, volatile LAS unsigned* st) {
    XcdBarrier b; b.bar = bar; b.x = xb_xcc_id(); b.st = st;
    if (threadIdx.x == 0) (void)xb_add(&bar[XB_XCNT(b.x)], 1u);
    return b;
}
__device__ __forceinline__ void xcd_barrier_complete(unsigned* bar, unsigned x, unsigned& nloc, unsigned& nx) {
    const unsigned G = gridDim.x * gridDim.y * gridDim.z;
    unsigned sum, cnt, mine, sp = 0u;
    for (;;) {
        sum = 0u; cnt = 0u; mine = 0u;
#pragma unroll
        for (unsigned j = 0; j < 16; ++j) { const unsigned c = xb_ld(&bar[XB_XCNT(j)]); sum += c; cnt += (c > 0u) ? 1u : 0u; mine = (j == x) ? c : mine; }
        if (sum == G) break;
        __builtin_amdgcn_s_sleep(1);
        if ((++sp & 255u) == 0u) { if (xb_ld(&bar[XB_TMO])) break; if (sp > XB_SPIN_CAP) { atomicAdd(&bar[XB_TMO], 1u); break; } }
    }
    nloc = mine > 0u ? mine : 1u; nx = cnt > 0u ? cnt : 1u;
}
__device__ __forceinline__ void xcd_barrier(const XcdBarrier& b) {
    asm volatile("s_waitcnt vmcnt(0)" ::: "memory");
    __syncthreads();
    if (threadIdx.x == 0) {
        unsigned* bar = b.bar;
        __builtin_amdgcn_s_waitcnt(0);
        unsigned nloc = b.st[0], nx = b.st[1];
        if (nloc == 0u) { xcd_barrier_complete(bar, b.x, nloc, nx); b.st[0] = nloc; b.st[1] = nx; }
        const unsigned old = xb_add(&bar[XB_XSUB(b.x)], 1u);
        const unsigned gen = old / nloc;
        if (old + 1u == (gen + 1u) * nloc) {
            __builtin_amdgcn_fence(__ATOMIC_RELEASE, "agent");
            asm volatile("s_waitcnt vmcnt(0)" ::: "memory");
            const unsigned og = xb_add(&bar[XB_TOP], 1u);
            const unsigned tg = og / nx;
            if (og + 1u == (tg + 1u) * nx) xb_add(&bar[XB_TOPGEN], 1u);
            else XB_SPIN(xb_ld(&bar[XB_TOPGEN]) == tg, bar);
            __builtin_amdgcn_fence(__ATOMIC_ACQUIRE, "agent");
            xb_add(&bar[XB_XGEN(b.x)], 1u);
            asm volatile("s_waitcnt vmcnt(0)" ::: "memory");
        } else {
            XB_SPIN(xb_ld(&bar[XB_XGEN(b.x)]) == gen, bar);
            __builtin_amdgcn_fence(__ATOMIC_ACQUIRE, "agent");
            asm volatile("s_waitcnt vmcnt(0)" ::: "memory");
        }
    }
    __syncthreads();
}

__global__ void __launch_bounds__(NT, 2) mega(Args a) {
    extern __shared__ __attribute__((aligned(16))) unsigned char lds[];
    volatile LAS unsigned* st = (volatile LAS unsigned*)(LAS unsigned char*)(lds + LDS_BYTES - 16);
    if (threadIdx.x < 4) st[threadIdx.x] = 0u;
    __syncthreads();
    unsigned* barw = (unsigned*)(a.ws + WS_BAR);
    XcdBarrier bar = xcd_barrier_post(barw, st);
#pragma unroll 1
    for (int ph = 0; ph < N_PHASES; ++ph) {
        if (ph > 0 && ph < N_PHASES - 1) { int l_, s_; phase_decode(ph, l_, s_); if (s_ == 8 || (s_ == 4 && (l_ & 1) == 0)) continue; }
        run_phase(a, lds, ph);
#ifdef DUP
        { int lyr = 0, sub = 100; if (ph > 0 && ph < N_PHASES - 1) phase_decode(ph, lyr, sub);
          if (sub == (DUP % 1000) && (ph == 0 || lyr == DUP / 1000) && ph < N_PHASES - 1) { xcd_barrier(bar); run_phase(a, lds, ph); } }
#endif
        if (ph + 1 < N_PHASES) xcd_barrier(bar);
    }
    if (xb_ld(&barw[XB_TMO]) != 0u) {
        const size_t gt = (size_t)blockIdx.x * NT + threadIdx.x, gs = (size_t)gridDim.x * NT;
        for (size_t i = gt; i < (size_t)T * DM; i += gs) a.out[i] = __builtin_nanf("");
    }
}

extern "C" void kernel_launch(void* const* d_in, const int* in_sizes, int n_in, void* d_out, int out_size,
                              void* d_ws, size_t ws_size, hipStream_t stream) {
    static int grid = 0;
    if (grid == 0) {
        int dev = 0, cus = 0;
        if (hipGetDevice(&dev) != hipSuccess || hipDeviceGetAttribute(&cus, hipDeviceAttributeMultiprocessorCount, dev) != hipSuccess) { grid = -1; return; }
        if (hipFuncSetAttribute((const void*)mega, hipFuncAttributeMaxDynamicSharedMemorySize, LDS_BYTES) != hipSuccess) { grid = -1; return; }
        (void)hipGetLastError();
        grid = cus;
        if (n_in != 26 || out_size != T * DM || ws_size < WS_END) { fprintf(stderr, "kernel_launch: unexpected sizes n_in %d out %d ws %zu (need %zu)\n", n_in, out_size, ws_size, (size_t)WS_END); grid = -1; return; }
    }
    if (grid < 0) return;
    (void)hipMemsetAsync((unsigned char*)d_ws + WS_BAR, 0, XCD_BAR_WORDS * 4, stream);
    Args a{};
    for (int i = 0; i < 26; ++i) a.in[i] = (const float*)d_in[i];
    a.out = (float*)d_out; a.ws = (unsigned char*)d_ws;
    hipLaunchKernelGGL(mega, dim3(grid), dim3(NT), LDS_BYTES, stream, a);
}
#endif
```

```cpp
#ifdef EMU
#include "emu.h"
#define DEV static inline
#define MDEV inline
#define OPAQUE(p)
#define OPAQUE2(a, b)
#define TID emu_tid()
#define BID (EB->bid)
#define NBLK (EB->nblk)
#define SYNC() emu_sync_block()
#define WSYNC() emu_sync_wave()
#define mfma16(a, b, c) emu_mfma16(a, b, c)
DEV float shflx(float v, int m) { return emu_shfl_f(v, (emu_tid() & 63) ^ m); }
DEV int shflxi(int v, int m) { return (int)emu_shfl_u((unsigned)v, (emu_tid() & 63) ^ m); }
DEV float shfl(float v, int s) { return emu_shfl_f(v, s); }
DEV float dpp_ror1(float v) { const int l = emu_tid() & 63; return emu_shfl_f(v, (l & 48) | ((l - 1) & 15)); }
DEV float wave_sum63(float v) { for (int o = 1; o < 64; o <<= 1) v += shflx(v, o); return v; }
DEV int atomic_add_i(int* p, int v) { return __atomic_fetch_add(p, v, __ATOMIC_RELAXED); }
typedef float f32x2v __attribute__((vector_size(8)));
DEV float fexp2(float x) { return exp2f(x); }
DEV float frcp(float x) { return 1.0f / x; }
DEV float frsq(float x) { return 1.0f / sqrtf(x); }
typedef short s16x4 __attribute__((vector_size(8)));
static inline s16x4 emu_tr4(const unsigned short* p) {
    EmuWave& w = EB->wave[emu_tid() >> 6]; int l = emu_tid() & 63;
    const unsigned short** tab = (const unsigned short**)w.a;
    tab[l] = p; emu_sync_wave();
    s16x4 r; int g = l & 48, i = l & 15;
    for (int q = 0; q < 4; ++q) r[q] = (short)tab[g + 4 * q + (i >> 2)][i & 3];
    emu_sync_wave(); return r;
}
#define tr4(p) emu_tr4(p)
#else
#include <hip/hip_runtime.h>
#include <cstdio>
#include <cstdint>
typedef short bf16x8 __attribute__((ext_vector_type(8)));
typedef float f32x4 __attribute__((ext_vector_type(4)));
typedef unsigned u32x4 __attribute__((ext_vector_type(4)));
typedef unsigned u32x2 __attribute__((ext_vector_type(2)));
#define DEV __device__ __forceinline__
#define MDEV __device__ __forceinline__
#define OPAQUE(p) asm volatile("" : "+v"(p))
#define OPAQUE2(a, b) asm volatile("" : "+v"(a), "+v"(b))
DEV int tid_opaque() { int t = (int)threadIdx.x; asm volatile("" : "+v"(t)); return t; }
#define TID tid_opaque()
DEV int bid_opaque() { int b = (int)blockIdx.x; asm volatile("" : "+s"(b)); return b; }
#define BID bid_opaque()
#define NBLK ((int)gridDim.x)
#define SYNC() __syncthreads()
#define WSYNC() __builtin_amdgcn_wave_barrier()
#define mfma16(a, b, c) __builtin_amdgcn_mfma_f32_16x16x32_bf16(a, b, c, 0, 0, 0)
DEV int shflxi(int x, int m) {
    if (m == 1) return __builtin_amdgcn_update_dpp(x, x, 0xB1, 0xf, 0xf, true);
    if (m == 2) return __builtin_amdgcn_update_dpp(x, x, 0x4E, 0xf, 0xf, true);
    if (m == 4) return __builtin_amdgcn_ds_swizzle(x, (4 << 10) | 0x1F);
    if (m == 8) return __builtin_amdgcn_ds_swizzle(x, (8 << 10) | 0x1F);
    if (m == 16) return __builtin_amdgcn_ds_swizzle(x, (16 << 10) | 0x1F);
    if (m == 32) { const auto r = __builtin_amdgcn_permlane32_swap((unsigned)x, (unsigned)x, false, false); return (int)((threadIdx.x & 32) ? r[0] : r[1]); }
    return __shfl_xor(x, m);
}
DEV float shflx(float v, int m) { return __builtin_bit_cast(float, shflxi(__builtin_bit_cast(int, v), m)); }
DEV float dpp_ror1(float v) { return __builtin_bit_cast(float, __builtin_amdgcn_update_dpp(0, __builtin_bit_cast(int, v), 0x121, 0xf, 0xf, false)); }
DEV float wave_sum63(float v) {
#define WS_DPP(ctrl, rm) __builtin_bit_cast(float, __builtin_amdgcn_update_dpp(0, __builtin_bit_cast(int, v), ctrl, rm, 0xf, false))
    v += WS_DPP(0xB1, 0xf); v += WS_DPP(0x4E, 0xf); v += WS_DPP(0x141, 0xf); v += WS_DPP(0x140, 0xf); v += WS_DPP(0x142, 0xa); v += WS_DPP(0x143, 0xc);
#undef WS_DPP
    return v;
}
DEV float shfl(float v, int s) { return __shfl(v, s); }
DEV int atomic_add_i(int* p, int v) { return atomicAdd(p, v); }
DEV float fexp2(float x) { return __builtin_amdgcn_exp2f(x); }
DEV float frcp(float x) { return __builtin_amdgcn_rcpf(x); }
DEV float frsq(float x) { return __builtin_amdgcn_rsqf(x); }
typedef short s16x4 __attribute__((ext_vector_type(4)));
#define tr4(p) __builtin_amdgcn_ds_read_tr16_b64_v4i16((__attribute__((address_space(3))) s16x4*)(p))
#endif

typedef unsigned short bf16;

#ifndef DM
#define DM 1024
#endif
#ifndef SEQ
#define SEQ 8192
#endif
#ifndef FF
#define FF 512
#endif
constexpr int NBATCH = 2, T = NBATCH * SEQ, DEPTH = 4;
constexpr int NIN = 3352, NINP = 3456, NIN8 = 3584;
constexpr int NT = 512;
constexpr int NCH = SEQ / 64;
constexpr int NCP = SEQ / 16;
constexpr int NCMP = NCP - 1;
constexpr int MOE_ROWS = 2 * T + 32 * 256;
constexpr float EPS = 1e-6f, NEGV = -1e30f, FORCEV = 1e4f, LOG2E = 1.4426950408889634f;

constexpr size_t al(size_t x) { return (x + 255) & ~(size_t)255; }
constexpr int P0_CTR_IDX = 192;
constexpr size_t WS_BAR = 0;
constexpr size_t WS_CNT = 16384;
constexpr size_t WS_MOD = WS_CNT + (size_t)DEPTH * 32 * 256;
constexpr size_t WS_LB = al(WS_MOD + (size_t)DEPTH * 2 * 6 * DM * 4);
constexpr size_t WS_CB = al(WS_LB + 2 * 512 * 4);
constexpr size_t WS_CS = al(WS_CB + 2 * 2 * 8 * 64 * 4);
constexpr size_t WS_WIN = al(WS_CS + 64);
constexpr size_t WS_WOUT = al(WS_WIN + (size_t)2 * NIN8 * DM * 2);
constexpr size_t WS_PW1 = al(WS_WOUT + (size_t)2 * DM * 1024 * 2);
constexpr size_t WS_PW2 = al(WS_PW1 + (size_t)2 * 2 * DM * DM * 2);
constexpr size_t WS_WC = al(WS_PW2 + (size_t)2 * DM * DM * 2);
constexpr size_t WS_W13 = al(WS_WC + (size_t)2 * 2 * 64 * 2048 * 2);
constexpr size_t WS_W2 = al(WS_W13 + (size_t)DEPTH * 32 * 2 * FF * DM * 2);
constexpr size_t WS_H = al(WS_W2 + (size_t)DEPTH * 32 * DM * FF * 2);
constexpr size_t WS_QN = al(WS_H + (size_t)T * DM * 2);
constexpr size_t WS_KCG = al(WS_QN + (size_t)T * 512 * 2);
constexpr size_t WS_VCG = al(WS_KCG + (size_t)T * 128 * 2);
constexpr size_t WS_KS = al(WS_VCG + (size_t)T * 128 * 2);
constexpr size_t WS_KW = al(WS_KS + (size_t)T * 128 * 2);
constexpr size_t WS_VST = al(WS_KW + (size_t)T * 128 * 2);
constexpr size_t WS_VWT = al(WS_VST + (size_t)T * 128 * 2);
constexpr size_t WS_KC = al(WS_VWT + (size_t)T * 128 * 2);
constexpr size_t WS_VCT = al(WS_KC + (size_t)4 * NCP * 64 * 2);
constexpr size_t WS_GATE = al(WS_VCT + (size_t)4 * NCP * 64 * 2);
constexpr size_t WS_HQ = al(WS_GATE + (size_t)T * 24 * 4);
constexpr size_t WS_HF = al(WS_HQ + (size_t)T * 512 * 2);
constexpr size_t WS_HV = al(WS_HF + (size_t)T * 512 * 4);
constexpr size_t WS_HGS = al(WS_HV + (size_t)T * 512 * 2);
constexpr size_t WS_UT = al(WS_HGS + (size_t)T * 512 * 2);
constexpr size_t WS_ST = al(WS_UT + (size_t)8 * NCH * 128 * 128 * 4);
constexpr size_t WS_GD = al(WS_ST + (size_t)8 * NCH * 128 * 128 * 2);
constexpr size_t WS_CAT = al(WS_GD + (size_t)8 * NCH * 128 * 4);
constexpr size_t WS_GLU = al(WS_CAT + (size_t)T * 1024 * 2);
constexpr size_t WS_TIE = al(WS_GLU + (size_t)T * DM * 2);
constexpr size_t WS_TIW = al(WS_TIE + (size_t)T * 2 * 4);
constexpr size_t WS_LIST = al(WS_TIW + (size_t)T * 2 * 4);
constexpr size_t WS_ACT = al(WS_LIST + (size_t)32 * T * 4);
constexpr size_t WS_YK = al(WS_ACT + (size_t)MOE_ROWS * FF * 2);
constexpr size_t WS_WTH = al(WS_YK + (size_t)MOE_ROWS * DM * 2);
constexpr size_t WS_WTL = al(WS_WTH + (size_t)DEPTH * 48 * DM * 2);
constexpr size_t WS_AVEC = al(WS_WTL + (size_t)DEPTH * 48 * DM * 2);
constexpr size_t WS_RBIAS = al(WS_AVEC + (size_t)DEPTH * 2 * DM * 4);
constexpr size_t WS_FLG = al(WS_RBIAS + (size_t)DEPTH * 2 * 48 * 4);
constexpr int LDS_BYTES = 150 * 1024;
constexpr int CMP_SPLIT = 2;
constexpr size_t WS_CMPP = al(WS_FLG + (size_t)DEPTH * 256 * 64);
constexpr size_t WS_END = al(WS_CMPP + (size_t)8 * ((NCP + 255) / 256) * CMP_SPLIT * 16 * 256 * 16);

struct Args { const float* in[26]; float* out; unsigned char* ws; };
enum { I_X = 0, I_C, I_ADAW, I_ADAB, I_NMIX, I_NFFN, I_WIN, I_WOUT, I_CWK, I_CWV, I_CPE, I_QG, I_KG, I_LBL, I_OG,
       I_PW1, I_DW, I_DWB, I_LNG, I_LNB, I_PW2, I_WG, I_WE, I_W1, I_W3, I_W2 };

#ifdef EMU
DEV unsigned char* wsp(const Args& a) { return a.ws; }
DEV float* outp(const Args& a) { return a.out; }
#else
DEV unsigned char* launder_ptr(const void* p) { unsigned long long v = (unsigned long long)p; unsigned lo = (unsigned)v, hi = (unsigned)(v >> 32);
    lo = (unsigned)__builtin_amdgcn_readfirstlane((int)lo); hi = (unsigned)__builtin_amdgcn_readfirstlane((int)hi); asm volatile("" : "+s"(lo), "+s"(hi)); typedef __attribute__((address_space(1))) unsigned char* gptr_t; return (unsigned char*)(gptr_t)(((unsigned long long)hi << 32) | lo); }
DEV unsigned char* wsp(const Args& a) { return launder_ptr(a.ws); }
DEV float* outp(const Args& a) { return (float*)launder_ptr(a.out); }
#endif

#ifdef EMU
#define INP(a, X) ((a).in[X])
#else
DEV int zero_opaque() { int z = 0; asm volatile("" : "+s"(z)); return z; }
#define INP(a, X) ((a).in[(X) + zero_opaque()])
#endif

DEV unsigned f2bf(float f) { unsigned u = __builtin_bit_cast(unsigned, f); return (u + 0x7fffu + ((u >> 16) & 1u)) >> 16; }
DEV float bf2f(unsigned h) { return __builtin_bit_cast(float, h << 16); }
#ifdef EMU
DEV unsigned pk2(float lo, float hi) { return f2bf(lo) | (f2bf(hi) << 16); }
#else
typedef float f32x2_t __attribute__((ext_vector_type(2)));
typedef float f32x2v __attribute__((ext_vector_type(2)));
typedef __bf16 bf16x2_t __attribute__((ext_vector_type(2)));
DEV unsigned pk2(float lo, float hi) { f32x2_t v = {lo, hi}; bf16x2_t b = __builtin_convertvector(v, bf16x2_t); return __builtin_bit_cast(unsigned, b); }
#endif
DEV float sigm(float x) { return frcp(1.0f + fexp2(-x * LOG2E)); }
DEV float siluf(float x) { return x * sigm(x); }
DEV f32x4 f4zero() { f32x4 z = {0.f, 0.f, 0.f, 0.f}; return z; }
DEV bf16x8 pack8(f32x4 a, f32x4 b) {
    u32x4 w; w[0] = pk2(a[0], a[1]); w[1] = pk2(a[2], a[3]); w[2] = pk2(b[0], b[1]); w[3] = pk2(b[2], b[3]);
    return __builtin_bit_cast(bf16x8, w);
}
DEV void st_bf8(bf16* p, f32x4 a, f32x4 b) { u32x4 w; w[0] = pk2(a[0], a[1]); w[1] = pk2(a[2], a[3]); w[2] = pk2(b[0], b[1]); w[3] = pk2(b[2], b[3]); *(u32x4*)p = w; }
DEV void st_bf4(bf16* p, f32x4 v) { u32x2 w; w[0] = pk2(v[0], v[1]); w[1] = pk2(v[2], v[3]); *(u32x2*)p = w; }


#ifdef EMU
namespace pg8 {
constexpr int BM = 256, BK = 64, HALF = 128, NXCD = 8, WGM = 8;
typedef unsigned short bf16_t;
struct Unit { int pm, pn; };
struct Gemm { const bf16_t* A; const bf16_t* Bt; int M, N, K; };
struct StaticOrder {
    int nM, nN, nwg, G, c;
    void init(int M, int N, int G_, int c_) { nM = M / BM; nN = N / BM; nwg = nM * nN; G = G_; c = c_; }
    bool next(int i, Unit& u) const {
        const long L = (long)i * G + c; if (L >= nwg) return false;
        int wgid = (int)L; { const int q = nwg / NXCD, r = nwg % NXCD, xcd = wgid % NXCD, off = wgid / NXCD; wgid = (xcd < r ? xcd * (q + 1) : r * (q + 1) + (xcd - r) * q) + off; }
        const int nig = WGM * nN, gid = wgid / nig, fm = gid * WGM, gsz = (nM - fm) < WGM ? (nM - fm) : WGM;
        u.pm = fm + ((wgid % nig) % gsz); u.pn = (wgid % nig) / gsz; return true;
    }
};
struct SelNone { static constexpr bool GATHER = false; struct Ctx {}; Ctx ctx(const Unit&) const { return Ctx(); } size_t boff(const Ctx&) const { return 0; } unsigned aoff(const Ctx&, int) const { return 0u; } };
template <class Epi, class Sched, bool ALIGN_EPI = false, bool SP2 = false, class Sel = SelNone>
static inline void gemm_phase(unsigned char*, const Gemm g, const Sched& S, const Epi& E, const Sel& X = Sel()) {
    const int tid = emu_tid(), wid = tid >> 6, lane = tid & 63, wr = wid >> 2, wc = wid & 3, fr = lane & 15, fq = lane >> 4;
    Unit u;
    for (int ui = 0; S.next(ui, u); ++ui) {
        f32x4 acc[2][2][4][2]; const auto cx = X.ctx(u);
        for (int ai = 0; ai < 2; ++ai) for (int bj = 0; bj < 2; ++bj) for (int m = 0; m < 4; ++m) for (int n = 0; n < 2; ++n) for (int r = 0; r < 4; ++r) {
            const int row = 256 * u.pm + 128 * ai + 64 * wr + 16 * m + fr, col = 256 * u.pn + 128 * bj + 32 * wc + (Epi::PERM ? 8 * fq + 4 * n + r : 16 * n + 4 * fq + r); float sum = 0.f;
            const bf16_t* ap = Sel::GATHER ? (const bf16_t*)((const char*)g.A + X.aoff(cx, row - 256 * u.pm)) : g.A + (size_t)row * g.K; const bf16_t* bp = (const bf16_t*)((const char*)g.Bt + X.boff(cx)) + (size_t)col * g.K;
            for (int k = 0; k < g.K; ++k) sum += bf2f(ap[k]) * bf2f(bp[k]);
            acc[ai][bj][m][n][r] = sum; }
        E(acc, u, wr, wc, fr, fq);
    }
    emu_sync_block();
}
}
#else
namespace pg8 {
#define PG8_LAS __attribute__((address_space(3)))
typedef unsigned short bf16_t;
typedef short bf16x8 __attribute__((ext_vector_type(8)));
typedef float f32x4 __attribute__((ext_vector_type(4)));
typedef unsigned u32x4 __attribute__((ext_vector_type(4)));
constexpr int BM = 256, BK = 64, HALF = 128, HTB = HALF * BK * 2  , STAGE_BYTES = 8 * HTB, NXCD = 8, WGM = 8;

__host__ __device__ __forceinline__ int lds_byte(int r, int c) { const int st = (r >> 4) * 2 + (c >> 5), rr = r & 15, cc = c & 31, ob = rr * 64 + cc * 2; return st * 1024 + (ob ^ (((ob >> 9) & 1) << 5)); }
__host__ __device__ __forceinline__ void stage_rc(int b, int& R, int& C) { const int st = b / 1024, sb = b % 1024, swz = sb ^ (((sb >> 9) & 1) << 5); R = (st >> 1) * 16 + swz / 64; C = (st & 1) * 32 + (swz % 64) / 2; }
__host__ __device__ __forceinline__ int perm32(int rho) { const int n = rho >> 4, i = rho & 15; return 8 * (i >> 2) + 4 * n + (i & 3); }

struct Unit { int pm, pn; };
struct Gemm { const bf16_t* A; const bf16_t* Bt; int M, N, K; };

struct StaticOrder {
    int nM, nN, nwg, G, c;
    __host__ __device__ void init(int M, int N, int G_, int c_) { nM = M / BM; nN = N / BM; nwg = nM * nN; G = G_; c = c_; }
    __host__ __device__ bool next(int i, Unit& u) const {
        const long L = (long)i * G + c; if (L >= nwg) return false;
        int wgid = (int)L; { const int q = nwg / NXCD, r = nwg % NXCD, xcd = wgid % NXCD, off = wgid / NXCD; wgid = (xcd < r ? xcd * (q + 1) : r * (q + 1) + (xcd - r) * q) + off; }
        const int nig = WGM * nN, gid = wgid / nig, fm = gid * WGM, gsz = (nM - fm) < WGM ? (nM - fm) : WGM;
        u.pm = fm + ((wgid % nig) % gsz); u.pn = (wgid % nig) / gsz; return true;
    }
    __device__ __forceinline__ void a_ready(const Unit&) const {}
    __device__ __forceinline__ void done(const Unit&) const {}
};

__device__ __forceinline__ unsigned cvt_pk_bf16(float lo, float hi) { unsigned r; asm volatile("v_cvt_pk_bf16_f32 %0, %1, %2" : "=v"(r) : "v"(lo), "v"(hi)); return r; }
struct SelNone { static constexpr bool GATHER = false; struct Ctx {}; __device__ __forceinline__ Ctx ctx(const Unit&) const { return Ctx(); } __device__ __forceinline__ size_t boff(const Ctx&) const { return 0; } __device__ __forceinline__ unsigned aoff(const Ctx&, int) const { return 0u; } };
template <class Epi, class Sched, bool ALIGN_EPI = false, bool SP2 = false, class Sel = SelNone>
__device__ __forceinline__ void gemm_phase(PG8_LAS unsigned char* lds, const Gemm g, const Sched& S, const Epi& E, const Sel& X = Sel()) {
    constexpr bool GA = Sel::GATHER;
    const int tid = TID, wid = __builtin_amdgcn_readfirstlane(tid >> 6), lane = tid & 63, wr = wid >> 2, wc = wid & 3, fr = lane & 15, fq = lane >> 4;
    const int K = g.K, nt = K / BK;
    unsigned voffA[2], voffB[2]; int Rl[2]; unsigned Cl2[2];
#pragma unroll
    for (int i = 0; i < 2; ++i) { int R, C; stage_rc(tid * 16 + i * 8192, R, C); const int Rb = Epi::PERM ? ((R & ~31) + perm32(R & 31)) : R;
        voffA[i] = (unsigned)(R * K + C) * 2u; voffB[i] = (unsigned)(Rb * K + C) * 2u; Rl[i] = R; Cl2[i] = (unsigned)C * 2u; }
    unsigned vA[2][2], vAn[2][2];
    const size_t kstep = (size_t)(BK * 2);
    const size_t hstep = (size_t)HALF * K * 2;
    const size_t tstep = 2 * hstep;
    const unsigned ldsw = (unsigned)wid * 1024u;
    const int aoff = lds_byte(wr * 64 + fr, fq * 8), boff = lds_byte(wc * 32 + fr, fq * 8);
#define PG8_SA(b, h) (((b) * 2 + (h)) * HTB)
#define PG8_SB(b, h) ((4 + (b) * 2 + (h)) * HTB)
#define PG8_STAGE(bufoff, gbase, voff) do { _Pragma("unroll") for (int _i = 0; _i < 2; ++_i) \
        __builtin_amdgcn_global_load_lds((const unsigned*)((const char*)(gbase) + (voff)[_i]), (PG8_LAS unsigned*)(lds + (bufoff) + ldsw + _i * 8192), 16, 0, 0); } while (0)
#define PG8_STAGE_A(bufoff, p, h, nx) do { if constexpr (GA) { unsigned _vo[2] = {(nx) ? vAn[h][0] : vA[h][0], (nx) ? vAn[h][1] : vA[h][1]}; PG8_STAGE(bufoff, p, _vo); } else { PG8_STAGE(bufoff, (p) + (h) * hstep, voffA); } } while (0)
#define PG8_GATH(cx, dst) do { _Pragma("unroll") for (int _h = 0; _h < 2; ++_h) _Pragma("unroll") for (int _i = 0; _i < 2; ++_i) dst[_h][_i] = X.aoff(cx, 128 * _h + Rl[_i]) + Cl2[_i]; } while (0)
#define PG8_LDA(dst, b, h) do { _Pragma("unroll") for (int m = 0; m < 4; ++m) _Pragma("unroll") for (int k = 0; k < 2; ++k) dst[m][k] = *(const PG8_LAS bf16x8*)(lds + PG8_SA(b, h) + aoff + m * 2048 + k * 1024); } while (0)
#define PG8_LDB(dst, b, h) do { _Pragma("unroll") for (int n = 0; n < 2; ++n) _Pragma("unroll") for (int k = 0; k < 2; ++k) dst[n][k] = *(const PG8_LAS bf16x8*)(lds + PG8_SB(b, h) + boff + n * 2048 + k * 1024); } while (0)
#define PG8_MMA(ai, bj, At, Bt) do { __builtin_amdgcn_s_setprio(1); _Pragma("unroll") for (int m = 0; m < 4; ++m) _Pragma("unroll") for (int n = 0; n < 2; ++n) _Pragma("unroll") for (int k = 0; k < 2; ++k) \
        acc[ai][bj][m][n] = __builtin_amdgcn_mfma_f32_16x16x32_bf16(Bt[n][k], At[m][k], acc[ai][bj][m][n], 0, 0, 0); __builtin_amdgcn_s_setprio(0); } while (0)
#define PG8_WAIT_V(n) asm volatile("s_waitcnt vmcnt(" #n ")" ::: "memory")
#define PG8_WAIT_L(n) asm volatile("s_waitcnt lgkmcnt(" #n ")" ::: "memory")
#define PG8_BAR __builtin_amdgcn_s_barrier()
#define PG8_SCHED __builtin_amdgcn_sched_barrier(0)
    Unit cur, nxt; int ui = 0;
    if (!S.next(0, cur)) return;
    f32x4 acc[2][2][4][2];
#pragma unroll
    for (int a = 0; a < 2; ++a)
#pragma unroll
        for (int b = 0; b < 2; ++b)
#pragma unroll
            for (int m = 0; m < 4; ++m)
#pragma unroll
                for (int n = 0; n < 2; ++n) acc[a][b][m][n] = (f32x4){0.f, 0.f, 0.f, 0.f};
    bf16x8 At[4][2], B0[2][2], B1[2][2];
    auto ccx = X.ctx(cur);
    const char* cA = GA ? (const char*)g.A : (const char*)g.A + (size_t)cur.pm * tstep; const char* cB = (const char*)g.Bt + X.boff(ccx) + (size_t)cur.pn * tstep;
    if constexpr (GA) { PG8_GATH(ccx, vA); }
    S.a_ready(cur);
    if constexpr (SP2) {
        PG8_STAGE(PG8_SB(0, 0), cB, voffB); PG8_STAGE(PG8_SB(0, 1), cB + hstep, voffB); PG8_STAGE_A(PG8_SA(0, 0), cA, 0, false); PG8_STAGE_A(PG8_SA(0, 1), cA, 1, false);
        if (wr == 1) PG8_BAR;
        PG8_WAIT_V(2); PG8_BAR;
        PG8_STAGE(PG8_SB(1, 0), cB + kstep, voffB); PG8_STAGE_A(PG8_SA(1, 0), cA + kstep, 0, false); PG8_STAGE(PG8_SB(1, 1), cB + hstep + kstep, voffB);
        PG8_WAIT_V(6); PG8_BAR;
    } else {
        PG8_STAGE(PG8_SB(0, 0), cB, voffB); PG8_STAGE_A(PG8_SA(0, 0), cA, 0, false); PG8_STAGE(PG8_SB(0, 1), cB + hstep, voffB); PG8_STAGE_A(PG8_SA(0, 1), cA, 1, false);
        if (wr == 1) PG8_BAR;
        PG8_WAIT_V(4); PG8_BAR;
        PG8_STAGE(PG8_SB(1, 0), cB + kstep, voffB); PG8_STAGE_A(PG8_SA(1, 0), cA + kstep, 0, false); PG8_STAGE(PG8_SB(1, 1), cB + hstep + kstep, voffB);
        PG8_WAIT_V(6); PG8_BAR;
    }
    for (;;) {
        const bool has_next = S.next(ui + 1, nxt);
        const char* nA = cA; const char* nB = cB;
        if (has_next) { const auto ncx = X.ctx(nxt); nA = GA ? (const char*)g.A : (const char*)g.A + (size_t)nxt.pm * tstep; nB = (const char*)g.Bt + X.boff(ncx) + (size_t)nxt.pn * tstep; if constexpr (GA) { PG8_GATH(ncx, vAn); } }
        else if constexpr (GA) {
#pragma unroll
            for (int _h = 0; _h < 2; ++_h) { vAn[_h][0] = vA[_h][0]; vAn[_h][1] = vA[_h][1]; } }
        for (int t = 0; t < nt; t += 2) {
            const bool last = (t == nt - 2);
            const char* a1 = cA + (size_t)(t + 1) * kstep;
            const char* a2 = last ? nA : cA + (size_t)(t + 2) * kstep; const char* b2 = last ? nB : cB + (size_t)(t + 2) * kstep;
            const char* a3 = a2 + kstep; const char* b3 = b2 + kstep;
            if (last && has_next) S.a_ready(nxt);
            if constexpr (SP2) {
            PG8_LDB(B0, 0, 0); PG8_LDB(B1, 0, 1); PG8_SCHED; PG8_LDA(At, 0, 0); PG8_STAGE_A(PG8_SA(1, 1), a1, 1, false);
            PG8_WAIT_V(8); PG8_WAIT_L(0); PG8_BAR; PG8_MMA(0, 0, At, B0); PG8_MMA(0, 1, At, B1); PG8_BAR; PG8_SCHED;
            PG8_LDA(At, 0, 1); PG8_STAGE(PG8_SB(0, 0), b2, voffB); PG8_STAGE(PG8_SB(0, 1), b2 + hstep, voffB); PG8_STAGE_A(PG8_SA(0, 0), a2, 0, last);
            PG8_WAIT_V(8); PG8_WAIT_L(0); PG8_BAR; PG8_MMA(1, 0, At, B0); PG8_MMA(1, 1, At, B1); PG8_BAR; PG8_SCHED;
            PG8_LDB(B0, 1, 0); PG8_LDB(B1, 1, 1); PG8_SCHED; PG8_LDA(At, 1, 0); PG8_STAGE_A(PG8_SA(0, 1), a2, 1, last);
            PG8_WAIT_V(8); PG8_WAIT_L(0); PG8_BAR; PG8_MMA(0, 0, At, B0); PG8_MMA(0, 1, At, B1); PG8_BAR; PG8_SCHED;
            PG8_LDA(At, 1, 1); PG8_STAGE(PG8_SB(1, 0), b3, voffB); PG8_STAGE(PG8_SB(1, 1), b3 + hstep, voffB); PG8_STAGE_A(PG8_SA(1, 0), a3, 0, last);
            PG8_WAIT_V(8); PG8_WAIT_L(0); PG8_BAR; PG8_MMA(1, 0, At, B0); PG8_MMA(1, 1, At, B1); PG8_BAR; PG8_SCHED;
            } else {
            PG8_LDB(B0, 0, 0); PG8_SCHED; PG8_LDA(At, 0, 0); PG8_STAGE_A(PG8_SA(1, 1), a1, 1, false);
            PG8_WAIT_L(8); PG8_BAR; PG8_WAIT_L(0); PG8_MMA(0, 0, At, B0); PG8_BAR; PG8_SCHED;
            PG8_LDB(B1, 0, 1); PG8_STAGE(PG8_SB(0, 0), b2, voffB);
            PG8_BAR; PG8_WAIT_L(0); PG8_MMA(0, 1, At, B1); PG8_BAR;
            PG8_LDA(At, 0, 1); PG8_STAGE_A(PG8_SA(0, 0), a2, 0, last);
            PG8_BAR; PG8_WAIT_L(0); PG8_MMA(1, 0, At, B0); PG8_BAR; PG8_SCHED;
            PG8_STAGE(PG8_SB(0, 1), b2 + hstep, voffB);
            PG8_WAIT_V(6); PG8_BAR; PG8_MMA(1, 1, At, B1); PG8_BAR;
            PG8_LDB(B0, 1, 0); PG8_SCHED; PG8_LDA(At, 1, 0); PG8_STAGE_A(PG8_SA(0, 1), a2, 1, last);
            PG8_WAIT_L(8); PG8_BAR; PG8_WAIT_L(0); PG8_MMA(0, 0, At, B0); PG8_BAR; PG8_SCHED;
            PG8_LDB(B1, 1, 1); PG8_STAGE(PG8_SB(1, 0), b3, voffB);
            PG8_BAR; PG8_WAIT_L(0); PG8_MMA(0, 1, At, B1); PG8_BAR;
            PG8_LDA(At, 1, 1); PG8_STAGE_A(PG8_SA(1, 0), a3, 0, last);
            PG8_BAR; PG8_WAIT_L(0); PG8_MMA(1, 0, At, B0); PG8_BAR; PG8_SCHED;
            PG8_STAGE(PG8_SB(1, 1), b3 + hstep, voffB);
            PG8_WAIT_V(6); PG8_BAR; PG8_MMA(1, 1, At, B1); PG8_BAR;
            }
        }
        if constexpr (ALIGN_EPI) { if (wr == 0) PG8_BAR; }
        if constexpr (!Epi::AFTER_DRAIN) { E(acc, cur, wr, wc, fr, fq); S.done(cur); }
        if (!has_next) break;
#pragma unroll
        for (int a = 0; a < 2; ++a)
#pragma unroll
            for (int b = 0; b < 2; ++b)
#pragma unroll
                for (int m = 0; m < 4; ++m)
#pragma unroll
                    for (int n = 0; n < 2; ++n) acc[a][b][m][n] = (f32x4){0.f, 0.f, 0.f, 0.f};
        cur = nxt; cA = nA; cB = nB; ++ui;
        if constexpr (GA) {
#pragma unroll
            for (int _h = 0; _h < 2; ++_h) { vA[_h][0] = vAn[_h][0]; vA[_h][1] = vAn[_h][1]; } }
        if constexpr (ALIGN_EPI) { if (wr == 1) PG8_BAR; }
    }
    PG8_WAIT_V(0);
    if constexpr (!ALIGN_EPI) { if (wr == 0) PG8_BAR; }
    PG8_BAR;
    if constexpr (Epi::AFTER_DRAIN) { E.fused(acc, cur, wr, wc, fr, fq, lds, wid, lane); S.done(cur); }
#undef PG8_SA
#undef PG8_SB
#undef PG8_STAGE
#undef PG8_STAGE_A
#undef PG8_GATH
#undef PG8_LDA
#undef PG8_LDB
#undef PG8_MMA
#undef PG8_WAIT_V
#undef PG8_WAIT_L
#undef PG8_BAR
#undef PG8_SCHED
}
}
#endif

constexpr int LDT = 72;
constexpr int GEMM_AS = 256 * LDT, GEMM_BS = 128 * LDT;
constexpr int GEMM_LDS = 2 * (GEMM_AS + GEMM_BS) * 2;

template <class AF, class EPI>
DEV void gemm_tile(unsigned char* smem, AF af, const bf16* Bt, int ldb, int nvalid, int K, EPI& epi) {
    const int tid = TID, w = tid >> 6, l = tid & 63, h = l >> 4, c = l & 15, wm = w >> 1, wn = w & 1;
    bf16* As = (bf16*)smem; bf16* Bs = As + 2 * GEMM_AS;
    const bf16* ap[4]; const bf16* bp[2];
    const int col8 = (tid & 7) * 8, r0 = tid >> 3;
#pragma unroll
    for (int i = 0; i < 4; ++i) ap[i] = af(r0 + 64 * i) + col8;
#pragma unroll
    for (int i = 0; i < 2; ++i) { int rn = r0 + 64 * i; if (rn >= nvalid) rn = nvalid - 1; bp[i] = Bt + (size_t)rn * ldb + col8; }
    f32x4 acc[4][4];
#pragma unroll
    for (int i = 0; i < 4; ++i)
#pragma unroll
        for (int j = 0; j < 4; ++j) acc[i][j] = f4zero();
    bf16x8 ra[4], rb[2];
#pragma unroll
    for (int i = 0; i < 4; ++i) ra[i] = *(const bf16x8*)(ap[i]);
#pragma unroll
    for (int i = 0; i < 2; ++i) rb[i] = *(const bf16x8*)(bp[i]);
    SYNC();
#pragma unroll
    for (int i = 0; i < 4; ++i) *(bf16x8*)(As + (r0 + 64 * i) * LDT + col8) = ra[i];
#pragma unroll
    for (int i = 0; i < 2; ++i) *(bf16x8*)(Bs + (r0 + 64 * i) * LDT + col8) = rb[i];
    SYNC();
    const int nk = K / 64;
    for (int kt = 0; kt < nk; ++kt) {
        const int cur = kt & 1;
        if (kt + 1 < nk) {
#pragma unroll
            for (int i = 0; i < 4; ++i) ra[i] = *(const bf16x8*)(ap[i] + (kt + 1) * 64);
#pragma unroll
            for (int i = 0; i < 2; ++i) rb[i] = *(const bf16x8*)(bp[i] + (kt + 1) * 64);
        }
        const bf16* Ac = As + cur * GEMM_AS + (wm * 64 + c) * LDT + 8 * h;
        const bf16* Bc = Bs + cur * GEMM_BS + (wn * 64 + c) * LDT + 8 * h;
#pragma unroll
        for (int kk = 0; kk < 2; ++kk) {
            bf16x8 fa[4], fb[4];
#pragma unroll
            for (int i = 0; i < 4; ++i) { fa[i] = *(const bf16x8*)(Ac + i * 16 * LDT + kk * 32); fb[i] = *(const bf16x8*)(Bc + i * 16 * LDT + kk * 32); }
#pragma unroll
            for (int ni = 0; ni < 4; ++ni)
#pragma unroll
                for (int mi = 0; mi < 4; ++mi) acc[ni][mi] = mfma16(fb[ni], fa[mi], acc[ni][mi]);
        }
        if (kt + 1 < nk) {
            const int nx = cur ^ 1;
#pragma unroll
            for (int i = 0; i < 4; ++i) *(bf16x8*)(As + nx * GEMM_AS + (r0 + 64 * i) * LDT + col8) = ra[i];
#pragma unroll
            for (int i = 0; i < 2; ++i) *(bf16x8*)(Bs + nx * GEMM_BS + (r0 + 64 * i) * LDT + col8) = rb[i];
        }
        SYNC();
    }
    epi(acc, wm * 64, wn * 64, h, c);
}

struct ARows { const bf16* base; size_t ld; MDEV const bf16* operator()(int r) const { return base + (size_t)r * ld; } MDEV unsigned off(int r) const { return (unsigned)r * (unsigned)ld; } };

constexpr int LDB = 144;
constexpr int GEMM_BS2 = 64 * LDB;
constexpr int GEMM2_LDS = (2 * GEMM_AS + 2 * GEMM_BS2) * 2;
DEV bf16x8 tr_read8(const bf16* p0, const bf16* p1) {
    const s16x4 x = tr4(p0), y = tr4(p1); bf16x8 r;
    r[0] = x[0]; r[1] = x[1]; r[2] = x[2]; r[3] = x[3]; r[4] = y[0]; r[5] = y[1]; r[6] = y[2]; r[7] = y[3]; return r;
}
DEV int bperm(int r) { return (r & ~12) | ((r & 4) << 1) | ((r & 8) >> 1); }
template <class AF, class BF, class EPI>
DEV void gemm_tile2(unsigned char* smem, AF af, BF bf, int ldb, int K, EPI& epi) {
    const int tid = TID, w = tid >> 6, l = tid & 63, h = l >> 4, c = l & 15, wm = w >> 1, wn = w & 1, grp = w >> 2;
    bf16* As = (bf16*)smem; bf16* Bs = As + 2 * GEMM_AS;
    const bf16* abase = af.base; unsigned ao[4];
    const int col8 = (tid & 7) * 8, r0 = tid >> 3;
#pragma unroll
    for (int i = 0; i < 4; ++i) ao[i] = af.off(r0 + 64 * i) + col8;
    const int bn4 = (tid & 31) * 4, bk = tid >> 5, bkp = bperm(bk);
    const float* bp = bf(bn4); const bool bok = bp != nullptr;
    if (bok) bp += (size_t)bk * ldb;
    const size_t bstep = (size_t)16 * ldb;
    f32x4 acc[4][4];
#pragma unroll
    for (int i = 0; i < 4; ++i)
#pragma unroll
        for (int j = 0; j < 4; ++j) acc[i][j] = f4zero();
    bf16x8 ra[4]; f32x4 rb[4];
    const int nk = K / 64;
#pragma unroll
    for (int i = 0; i < 4; ++i) { ra[i] = *(const bf16x8*)(abase + ao[i]); rb[i] = bok ? *(const f32x4*)(bp + i * bstep) : f4zero(); }
    SYNC();
#pragma unroll
    for (int i = 0; i < 4; ++i) { *(bf16x8*)(As + (r0 + 64 * i) * LDT + col8) = ra[i]; st_bf4(Bs + (bkp + 16 * i) * LDB + bn4, rb[i]); }
    if (nk > 1) {
#pragma unroll
        for (int i = 0; i < 4; ++i) { ra[i] = *(const bf16x8*)(abase + (ao[i] + 64)); rb[i] = bok ? *(const f32x4*)(bp + (size_t)64 * ldb + i * bstep) : f4zero(); } }
    SYNC();
    for (int kt = 0; kt < nk; ++kt) {
        const int cur = kt & 1;
#pragma unroll
        for (int p = 0; p < 2; ++p) {
            if (grp == p) {
                const bf16* Ac = As + cur * GEMM_AS + (wm * 64 + c) * LDT + 8 * h;
                const bf16* Bc = Bs + cur * GEMM_BS2 + bperm(8 * h + (c >> 2)) * LDB + wn * 64 + 4 * (c & 3);
#pragma unroll
                for (int kk = 0; kk < 2; ++kk) {
                    bf16x8 fa[4], fb[4];
#pragma unroll
                    for (int i = 0; i < 4; ++i) { fa[i] = *(const bf16x8*)(Ac + i * 16 * LDT + kk * 32); fb[i] = tr_read8(Bc + (32 * kk) * LDB + 16 * i, Bc + (32 * kk + 8) * LDB + 16 * i); }
#pragma unroll
                    for (int ni = 0; ni < 4; ++ni)
#pragma unroll
                        for (int mi = 0; mi < 4; ++mi) acc[ni][mi] = mfma16(fb[ni], fa[mi], acc[ni][mi]);
                }
            } else if (kt + 1 < nk) {
                const int nx = cur ^ 1;
#pragma unroll
                for (int i = 0; i < 4; ++i) { *(bf16x8*)(As + nx * GEMM_AS + (r0 + 64 * i) * LDT + col8) = ra[i]; st_bf4(Bs + nx * GEMM_BS2 + (bkp + 16 * i) * LDB + bn4, rb[i]); }
                if (kt + 2 < nk) {
#pragma unroll
                    for (int i = 0; i < 4; ++i) { ra[i] = *(const bf16x8*)(abase + (ao[i] + (kt + 2) * 64)); rb[i] = bok ? *(const f32x4*)(bp + (size_t)(kt + 2) * 64 * ldb + i * bstep) : f4zero(); } }
            }
            SYNC();
        }
    }
    epi(acc, wm * 64, wn * 64, h, c);
}
struct BPlain { const float* base; MDEV const float* operator()(int nt) const { return base + nt; } };
struct BInProjMap { const float* base; int n0; MDEV const float* operator()(int nt) const { const int n = n0 + nt; const int sc = n < 1280 ? n : (n < 3328 ? n + 24 : (n < 3352 ? 1280 + (n - 3328) : -1)); return sc < 0 ? nullptr : base + sc; } };
struct BInter { const float* s0; const float* s1; int n0; MDEV const float* operator()(int nt) const { const int n = n0 + nt, g = n >> 6, w = n & 63; return w < 32 ? s0 + g * 32 + w : s1 + g * 32 + w - 32; } };
struct BClamp64 { const float* base; MDEV const float* operator()(int nt) const { return base + (nt & 63); } };

struct EpiInProj {
    const Args* a; int m0, n0, li;
    MDEV void operator()(f32x4 (&acc)[4][4], int mw, int nw, int h, int c) const {
        unsigned char* ws = wsp(*a);
        const int nb = n0 + nw;
        const int tokb = m0 + mw + c;
        if (nb < 512 || (nb >= 768 && nb < 896) || (nb >= 1024 && nb < 1152)) {
            const float* gain; float mul = 1.f; bf16* dst; int kind;
            if (nb < 512) { gain = INP(*a, I_QG) + li * 64; mul = 0.125f * LOG2E; kind = 0; dst = (bf16*)(ws + WS_QN); }
            else if (nb < 896) { gain = INP(*a, I_KG) + (li * 3 + 1) * 64; kind = 1; dst = (bf16*)(ws + WS_KS); }
            else { gain = INP(*a, I_KG) + (li * 3 + 2) * 64; kind = 1; dst = (bf16*)(ws + WS_KW); }
            const int g = (nb >> 6) & 1;
#pragma unroll
            for (int mi = 0; mi < 4; ++mi) {
                float ss = 0.f;
#pragma unroll
                for (int ni = 0; ni < 4; ++ni) { f32x4 v = acc[ni][mi]; ss += v[0] * v[0] + v[1] * v[1] + v[2] * v[2] + v[3] * v[3]; }
                ss += shflx(ss, 16); ss += shflx(ss, 32);
                const float rs = frsq(ss * (1.0f / 64.0f) + EPS) * mul;
                const int tok = tokb + 16 * mi;
#pragma unroll
                for (int ni = 0; ni < 4; ++ni) {
                    const int d = 16 * ni + 4 * h; f32x4 v = acc[ni][mi], o;
#pragma unroll
                    for (int r = 0; r < 4; ++r) o[r] = v[r] * rs * gain[d + r];
                    if (kind == 0) st_bf4(dst + (size_t)tok * 512 + nb + d, o);
                    else { const int b = tok / SEQ, s = tok % SEQ; st_bf4(dst + ((size_t)(b * 2 + g) * SEQ + s) * 64 + d, o); }
                }
            }
        } else if (nb < 768) {
            bf16* dst = (bf16*)(ws + (nb < 640 ? WS_KCG : WS_VCG)); const int g = (nb >> 6) & 1;
#pragma unroll
            for (int mi = 0; mi < 4; ++mi) { const int tok = tokb + 16 * mi, b = tok / SEQ, s = tok % SEQ;
#pragma unroll
                for (int ni = 0; ni < 4; ++ni) st_bf4(dst + ((size_t)(b * 2 + g) * SEQ + s) * 64 + 16 * ni + 4 * h, acc[ni][mi]); }
        } else if (nb < 1280) {
            bf16* dst = (bf16*)(ws + (nb < 1024 ? WS_VST : WS_VWT)); const int g = (nb >> 6) & 1;
#pragma unroll
            for (int mi = 0; mi < 4; ++mi) { const int tok = tokb + 16 * mi, b = tok / SEQ, s = tok % SEQ;
                bf16* p = dst + ((size_t)(b * 2 + g) * NCH + (s >> 6)) * 4096 + (s & 63);
#pragma unroll
                for (int ni = 0; ni < 4; ++ni)
#pragma unroll
                    for (int r = 0; r < 4; ++r) p[(16 * ni + 4 * h + r) * 64] = (bf16)f2bf(acc[ni][mi][r]); }
        } else if (nb < 3328) {
            const int sec = (nb - 1280) >> 9, cc = (nb - 1280) & 511, hh = cc >> 7, d0 = cc & 127;
#pragma unroll
            for (int mi = 0; mi < 4; ++mi) { const int tok = tokb + 16 * mi, b = tok / SEQ, s = tok % SEQ;
                const size_t hrow = ((size_t)(b * 4 + hh) * SEQ + s) * 128 + d0;
#pragma unroll
                for (int ni = 0; ni < 4; ++ni) { const int d = 16 * ni + 4 * h; f32x4 v = acc[ni][mi], o;
                    if (sec == 0) { for (int r = 0; r < 4; ++r) o[r] = siluf(v[r]); st_bf4((bf16*)(ws + WS_HQ) + hrow + d, o); }
                    else if (sec == 1) { const float* lb = (const float*)(ws + WS_LB) + li * 512 + cc + d;
                        for (int r = 0; r < 4; ++r) o[r] = lb[r] + (1.0f - lb[r]) * sigm(v[r]);
                        *(f32x4*)((float*)(ws + WS_HF) + hrow + d) = o; }
                    else if (sec == 2) st_bf4((bf16*)(ws + WS_HV) + hrow + d, v);
                    else { for (int r = 0; r < 4; ++r) o[r] = siluf(v[r]); st_bf4((bf16*)(ws + WS_HGS) + (size_t)tok * 512 + cc + d, o); }
                } }
        } else if (nb == 3328) {
            float* dst = (float*)(ws + WS_GATE);
#pragma unroll
            for (int mi = 0; mi < 4; ++mi) { const int tok = tokb + 16 * mi;
#pragma unroll
                for (int ni = 0; ni < 2; ++ni)
#pragma unroll
                    for (int r = 0; r < 4; ++r) { const int n = 16 * ni + 4 * h + r; if (n < 24) dst[(size_t)tok * 24 + n] = sigm(acc[ni][mi][r]); } }
        }
    }
};

struct EpiResid {
    float* x; const float* gate; int m0, n0;
    MDEV void operator()(f32x4 (&acc)[4][4], int mw, int nw, int h, int c) const {
#pragma unroll
        for (int mi = 0; mi < 4; ++mi) { const int tok = m0 + mw + 16 * mi + c, b = tok / SEQ;
#pragma unroll
            for (int ni = 0; ni < 4; ++ni) { const int n = n0 + nw + 16 * ni + 4 * h;
                f32x4 g = *(const f32x4*)(gate + (size_t)b * 6 * DM + n); f32x4* p = (f32x4*)(x + (size_t)tok * DM + n); f32x4 v = *p;
#pragma unroll
                for (int r = 0; r < 4; ++r) v[r] += g[r] * acc[ni][mi][r];
                *p = v; } }
    }
};
template <int MODE> struct EpiGated {
    bf16* dst; size_t ld; int m0, n0, mvalid;
    MDEV void operator()(f32x4 (&acc)[4][4], int mw, int nw, int h, int c) const {
        const int cb = (n0 + nw) / 2;
#pragma unroll
        for (int mi = 0; mi < 4; ++mi) { const int m = mw + 16 * mi + c; if (m >= mvalid) continue;
#pragma unroll
            for (int ni = 0; ni < 2; ++ni) { f32x4 o;
#pragma unroll
                for (int r = 0; r < 4; ++r) { const float av = acc[ni][mi][r], bv = acc[ni + 2][mi][r]; o[r] = MODE == 0 ? av * sigm(bv) : siluf(av) * bv; }
                st_bf4(dst + (size_t)(m0 + m) * ld + cb + 16 * ni + 4 * h, o); } }
    }
};
struct EpiStoreBf {
    bf16* dst; size_t ld; int m0, n0, mvalid;
    MDEV void operator()(f32x4 (&acc)[4][4], int mw, int nw, int h, int c) const {
#pragma unroll
        for (int mi = 0; mi < 4; ++mi) { const int m = mw + 16 * mi + c; if (m >= mvalid) continue;
#pragma unroll
            for (int ni = 0; ni < 4; ++ni) st_bf4(dst + (size_t)(m0 + m) * ld + n0 + nw + 16 * ni + 4 * h, acc[ni][mi]); }
    }
};
struct EpiCmp {
    const Args* a; int kv, bg, m0, li;
    MDEV void operator()(f32x4 (&acc)[4][4], int mw, int nw, int h, int c) const {
        if (nw != 0) return;
        unsigned char* ws = wsp(*a);
        const float* bp8 = (const float*)(ws + WS_CB) + (li * 2 + kv) * 8 * 64;
        float bias[16];
#pragma unroll
        for (int q = 0; q < 16; ++q) { const int e = 16 * (q >> 2) + 4 * h + (q & 3); float v = 0.f;
#pragma unroll
            for (int kp = 0; kp < 8; ++kp) v += bp8[kp * 64 + e];
            bias[q] = v; }
        const float* gain = INP(*a, I_KG) + (li * 3 + 0) * 64;
#pragma unroll
        for (int mi = 0; mi < 4; ++mi) { const int n = m0 + mw + 16 * mi + c; const bool ok = n < NCMP;
            f32x4 v[4]; float ss = 0.f;
#pragma unroll
            for (int ni = 0; ni < 4; ++ni) { v[ni] = acc[ni][mi];
#pragma unroll
                for (int r = 0; r < 4; ++r) { v[ni][r] += bias[4 * ni + r]; ss += v[ni][r] * v[ni][r]; } }
            ss += shflx(ss, 16); ss += shflx(ss, 32);
            if (n >= NCP) continue;
            if (kv == 0) { const float rs = frsq(ss * (1.0f / 64.0f) + EPS); bf16* p = (bf16*)(ws + WS_KC) + ((size_t)bg * NCP + n) * 64;
#pragma unroll
                for (int ni = 0; ni < 4; ++ni) { f32x4 o;
#pragma unroll
                    for (int r = 0; r < 4; ++r) o[r] = ok ? v[ni][r] * rs * gain[16 * ni + 4 * h + r] : 0.f;
                    st_bf4(p + 16 * ni + 4 * h, o); }
            } else { bf16* p = (bf16*)(ws + WS_VCT) + ((size_t)bg * NCP + n) * 64;
#pragma unroll
                for (int ni = 0; ni < 4; ++ni) { f32x4 o;
#pragma unroll
                    for (int r = 0; r < 4; ++r) o[r] = ok ? v[ni][r] : 0.f;
                    st_bf4(p + 16 * ni + 4 * h, o); } }
        }
    }
};


struct EpiResid8 {
    static constexpr bool PERM = true, AFTER_DRAIN = false;
    float* x; const float* gate; const float* xin;
    MDEV void operator()(const f32x4 (&acc)[2][2][4][2], const pg8::Unit& u, int wr, int wc, int fr, int fq) const {
        OPAQUE2(fr, fq);
#pragma unroll
        for (int ai = 0; ai < 2; ++ai)
#pragma unroll
            for (int m = 0; m < 4; ++m) { const int row = 256 * u.pm + 128 * ai + 64 * wr + 16 * m + fr, b = row / SEQ;
#pragma unroll
                for (int bj = 0; bj < 2; ++bj)
#pragma unroll
                    for (int n = 0; n < 2; ++n) { const int col = 256 * u.pn + 128 * bj + 32 * wc + 8 * fq + 4 * n;
                        const f32x4 g = *(const f32x4*)(gate + (size_t)b * 6 * DM + col); f32x4* p = (f32x4*)(x + (size_t)row * DM + col); f32x4 v = *(const f32x4*)(xin + (size_t)row * DM + col);
#pragma unroll
                        for (int r = 0; r < 4; ++r) v[r] += g[r] * acc[ai][bj][m][n][r];
                        *p = v; } }
    }
};
struct EpiGlu8 {
    static constexpr bool PERM = true, AFTER_DRAIN = false;
    bf16* dst;
    MDEV void operator()(const f32x4 (&acc)[2][2][4][2], const pg8::Unit& u, int wr, int wc, int fr, int fq) const {
        OPAQUE2(fr, fq);
#pragma unroll
        for (int ai = 0; ai < 2; ++ai)
#pragma unroll
            for (int m = 0; m < 4; ++m) { const int row = 256 * u.pm + 128 * ai + 64 * wr + 16 * m + fr;
                { const int col = 128 * u.pn + 32 * wc + 8 * fq; f32x4 o0, o1;
#pragma unroll
                    for (int r = 0; r < 4; ++r) { o0[r] = acc[ai][0][m][0][r] * sigm(acc[ai][1][m][0][r]); o1[r] = acc[ai][0][m][1][r] * sigm(acc[ai][1][m][1][r]); }
                    st_bf8(dst + (size_t)row * DM + col, o0, o1); } }
    }
};
struct EpiMoe1_8 {
    static constexpr bool PERM = true, AFTER_DRAIN = false;
    bf16* dst;
    MDEV void operator()(const f32x4 (&acc)[2][2][4][2], const pg8::Unit& u, int wr, int wc, int fr, int fq) const {
        OPAQUE2(fr, fq);
#pragma unroll
        for (int ai = 0; ai < 2; ++ai)
#pragma unroll
            for (int m = 0; m < 4; ++m) { const int row = 256 * u.pm + 128 * ai + 64 * wr + 16 * m + fr;
                const int col = 128 * u.pn + 32 * wc + 8 * fq; f32x4 o0, o1;
#pragma unroll
                for (int r = 0; r < 4; ++r) { o0[r] = siluf(acc[ai][0][m][0][r]) * acc[ai][1][m][0][r]; o1[r] = siluf(acc[ai][0][m][1][r]) * acc[ai][1][m][1][r]; }
#ifdef EMU
                st_bf8(dst + (size_t)row * FF + col, o0, o1); }
#else
                u32x4 pk; pk[0] = pk2(o0[0], o0[1]); pk[1] = pk2(o0[2], o0[3]); pk[2] = pk2(o1[0], o1[1]); pk[3] = pk2(o1[2], o1[3]);
                asm volatile("global_store_dwordx4 %0, %1, off sc1\n\ts_nop 2" :: "v"((__attribute__((address_space(1))) bf16*)(dst + (size_t)row * FF + col)), "v"(pk) : "memory"); }
#endif
    }
};
struct EpiMoe2_8 {
    static constexpr bool PERM = true, AFTER_DRAIN = false;
    bf16* dst;
    MDEV void operator()(const f32x4 (&acc)[2][2][4][2], const pg8::Unit& u, int wr, int wc, int fr, int fq) const {
        OPAQUE2(fr, fq);
#pragma unroll
        for (int ai = 0; ai < 2; ++ai)
#pragma unroll
            for (int m = 0; m < 4; ++m) { const int row = 256 * u.pm + 128 * ai + 64 * wr + 16 * m + fr;
#pragma unroll
                for (int bj = 0; bj < 2; ++bj) { const int col = 256 * u.pn + 128 * bj + 32 * wc + 8 * fq;
                    st_bf8(dst + (size_t)row * DM + col, acc[ai][bj][m][0], acc[ai][bj][m][1]); } }
    }
};
DEV unsigned uni(unsigned x);
template <bool G> struct MoeSel {
    static constexpr bool GATHER = G;
    const int* rb; const int* cnt; const int* list; size_t bstride;
    struct Ctx { int e, rbase, c; };
    MDEV Ctx ctx(const pg8::Unit& u) const { int e = 0;
#pragma unroll 1
        for (int q = 1; q < 32; ++q) if ((rb[q] >> 8) <= u.pm) e = q;
        e = (int)uni((unsigned)e); Ctx x; x.e = e; x.rbase = (int)uni((unsigned)((u.pm << 8) - rb[e])); x.c = G ? (int)uni((unsigned)cnt[e * 64]) : 0; return x; }
    MDEV size_t boff(const Ctx& x) const { return (size_t)x.e * bstride; }
    MDEV unsigned aoff(const Ctx& x, int r) const { int p = x.rbase + r; if (p > x.c - 1) p = x.c - 1; return (unsigned)list[(size_t)x.e * T + p] * (unsigned)(DM * 2); }
};
struct EpiInProj8 {
    static constexpr bool PERM = true, AFTER_DRAIN = false;
    const Args* a; int li;
    MDEV void operator()(const f32x4 (&acc)[2][2][4][2], const pg8::Unit& u, int wr, int wc, int fr, int fq) const {
        OPAQUE2(fr, fq);
        unsigned char* ws = wsp(*a);
        const int nb = 256 * u.pn + 64 * wc;
        if (nb >= 3392) return;
        if (nb < 512 || (nb >= 768 && nb < 896) || (nb >= 1024 && nb < 1152)) {
            const float* gain; float mul = 1.f; int kind;
            if (nb < 512) { gain = INP(*a, I_QG) + li * 64; mul = 0.125f * LOG2E; kind = 0; }
            else if (nb < 896) { gain = INP(*a, I_KG) + (li * 3 + 1) * 64; kind = 1; }
            else { gain = INP(*a, I_KG) + (li * 3 + 2) * 64; kind = 2; }
            const int g = (nb >> 6) & 1;
            f32x4 gv[2][2];
#pragma unroll
            for (int bj = 0; bj < 2; ++bj)
#pragma unroll
                for (int n = 0; n < 2; ++n) gv[bj][n] = *(const f32x4*)(gain + 32 * bj + 8 * fq + 4 * n);
#pragma unroll
            for (int ai = 0; ai < 2; ++ai)
#pragma unroll
                for (int m = 0; m < 4; ++m) { const int tok = 256 * u.pm + 128 * ai + 64 * wr + 16 * m + fr;
                    float ss = 0.f;
#pragma unroll
                    for (int bj = 0; bj < 2; ++bj)
#pragma unroll
                        for (int n = 0; n < 2; ++n) { const f32x4 v = acc[ai][bj][m][n]; ss += v[0] * v[0] + v[1] * v[1] + v[2] * v[2] + v[3] * v[3]; }
                    ss += shflx(ss, 16); ss += shflx(ss, 32);
                    const float rs = frsq(ss * (1.0f / 64.0f) + EPS) * mul;
                    bf16* dst; if (kind == 0) dst = (bf16*)(ws + WS_QN) + (size_t)tok * 512 + nb; else { const int b = tok / SEQ, sq = tok % SEQ; dst = (bf16*)(ws + (kind == 1 ? WS_KS : WS_KW)) + ((size_t)(b * 2 + g) * SEQ + sq) * 64; }
#pragma unroll
                    for (int bj = 0; bj < 2; ++bj) { f32x4 o0, o1;
#pragma unroll
                        for (int r = 0; r < 4; ++r) { o0[r] = acc[ai][bj][m][0][r] * rs * gv[bj][0][r]; o1[r] = acc[ai][bj][m][1][r] * rs * gv[bj][1][r]; }
                        st_bf8(dst + 32 * bj + 8 * fq, o0, o1); } }
        } else if (nb < 768) {
            bf16* base = (bf16*)(ws + (nb < 640 ? WS_KCG : WS_VCG)); const int g = (nb >> 6) & 1;
#pragma unroll
            for (int ai = 0; ai < 2; ++ai)
#pragma unroll
                for (int m = 0; m < 4; ++m) { const int tok = 256 * u.pm + 128 * ai + 64 * wr + 16 * m + fr, b = tok / SEQ, sq = tok % SEQ;
#pragma unroll
                    for (int bj = 0; bj < 2; ++bj) st_bf8(base + ((size_t)(b * 2 + g) * SEQ + sq) * 64 + 32 * bj + 8 * fq, acc[ai][bj][m][0], acc[ai][bj][m][1]); }
        } else if (nb < 1280) {
            bf16* base = (bf16*)(ws + (nb < 1024 ? WS_VST : WS_VWT)); const int g = (nb >> 6) & 1;
#pragma unroll
            for (int ai = 0; ai < 2; ++ai)
#pragma unroll
                for (int m = 0; m < 4; ++m) { const int tok = 256 * u.pm + 128 * ai + 64 * wr + 16 * m + fr, b = tok / SEQ, sq = tok % SEQ;
#pragma unroll
                    for (int bj = 0; bj < 2; ++bj) st_bf8(base + ((size_t)(b * 2 + g) * SEQ + sq) * 64 + 32 * bj + 8 * fq, acc[ai][bj][m][0], acc[ai][bj][m][1]); }
        } else if (nb < 3328) {
            const int sec = (nb - 1280) >> 9, cc = (nb - 1280) & 511, hh = cc >> 7, d0 = cc & 127;
            f32x4 lbv[2][2];
            if (sec == 1) {
#pragma unroll
                for (int bj = 0; bj < 2; ++bj)
#pragma unroll
                    for (int n = 0; n < 2; ++n) lbv[bj][n] = *(const f32x4*)((const float*)(ws + WS_LB) + li * 512 + cc + 32 * bj + 8 * fq + 4 * n); }
#pragma unroll
            for (int ai = 0; ai < 2; ++ai)
#pragma unroll
                for (int m = 0; m < 4; ++m) { const int tok = 256 * u.pm + 128 * ai + 64 * wr + 16 * m + fr, b = tok / SEQ, sq = tok % SEQ;
                    const size_t hrow = ((size_t)(b * 4 + hh) * SEQ + sq) * 128 + d0;
#pragma unroll
                    for (int bj = 0; bj < 2; ++bj) { const int d = 32 * bj + 8 * fq; f32x4 o0, o1;
                        if (sec == 0) {
#pragma unroll
                            for (int r = 0; r < 4; ++r) { o0[r] = siluf(acc[ai][bj][m][0][r]); o1[r] = siluf(acc[ai][bj][m][1][r]); }
                            st_bf8((bf16*)(ws + WS_HQ) + hrow + d, o0, o1); }
                        else if (sec == 1) {
#pragma unroll
                            for (int r = 0; r < 4; ++r) { o0[r] = lbv[bj][0][r] + (1.0f - lbv[bj][0][r]) * sigm(acc[ai][bj][m][0][r]); o1[r] = lbv[bj][1][r] + (1.0f - lbv[bj][1][r]) * sigm(acc[ai][bj][m][1][r]); }
                            float* pf = (float*)(ws + WS_HF) + hrow + d; *(f32x4*)pf = o0; *(f32x4*)(pf + 4) = o1; }
                        else if (sec == 2) st_bf8((bf16*)(ws + WS_HV) + hrow + d, acc[ai][bj][m][0], acc[ai][bj][m][1]);
                        else {
#pragma unroll
                            for (int r = 0; r < 4; ++r) { o0[r] = siluf(acc[ai][bj][m][0][r]); o1[r] = siluf(acc[ai][bj][m][1][r]); }
                            st_bf8((bf16*)(ws + WS_HGS) + (size_t)tok * 512 + cc + d, o0, o1); } } }
        } else {
            float* dst = (float*)(ws + WS_GATE);
            if (fq < 3) {
#pragma unroll
                for (int ai = 0; ai < 2; ++ai)
#pragma unroll
                    for (int m = 0; m < 4; ++m) { const int tok = 256 * u.pm + 128 * ai + 64 * wr + 16 * m + fr; f32x4 o0, o1;
#pragma unroll
                        for (int r = 0; r < 4; ++r) { o0[r] = sigm(acc[ai][0][m][0][r]); o1[r] = sigm(acc[ai][0][m][1][r]); }
                        float* pf = dst + (size_t)tok * 24 + 8 * fq; *(f32x4*)pf = o0; *(f32x4*)(pf + 4) = o1; } }
        }
    }
};

DEV void tr_tile(unsigned char* smem, const float* src0, const float* src1, int ld, int K, int mode, bf16* dst, int n0, int k0) {
    bf16* tl = (bf16*)smem;
    const int tid = TID;
    SYNC();
#pragma unroll
    for (int i = 0; i < 8; ++i) {
        const int e = tid + 512 * i, kk = e >> 6, nn = e & 63, n = n0 + nn; float v = 0.f;
        if (mode == 0) v = src0[(size_t)(k0 + kk) * ld + n];
        else if (mode == 1) { int sc = n < 1280 ? n : (n < 3328 ? n + 24 : (n < 3352 ? 1280 + (n - 3328) : -1)); if (sc >= 0) v = src0[(size_t)(k0 + kk) * ld + sc]; }
        else { const int g = n >> 6, w = n & 63; v = (w < 32) ? src0[(size_t)(k0 + kk) * ld + g * 32 + w] : src1[(size_t)(k0 + kk) * ld + g * 32 + w - 32]; }
        tl[nn * LDT + kk] = (bf16)f2bf(v);
    }
    SYNC();
    const int nn = tid >> 3, k8 = (tid & 7) * 8;
    *(bf16x8*)(dst + (size_t)(n0 + nn) * K + k0 + k8) = *(const bf16x8*)(tl + nn * LDT + k8);
}

DEV int tr_col(int mode, int n) {
    if (mode == 0) return n;
    const int pn = n >> 8, ct = n & 255;
    if (mode == 5) { const int bj = ct >> 7, wc = (ct >> 5) & 3, j = ct & 31, L = 256 * pn + 64 * wc + 32 * bj + j; return L < 1280 ? L : (L < 3328 ? L + 24 : (L < 3352 ? 1280 + (L - 3328) : -1)); }
    { const int bj = ct >> 7, Lc = 128 * pn + (ct & 127); return bj == 0 ? Lc : (mode == 7 ? FF : DM) + Lc; }
}
DEV void tr_tile(unsigned char* smem, const float* src, int ld, int K, int mode, bf16* dst, int n0, int k0) {
    bf16* tl = (bf16*)smem;
    const int tid = TID, nq = tid & 31, kq = tid >> 5;
    const int sc = tr_col(mode, n0 + 4 * nq);
    f32x4 v[4];
#pragma unroll
    for (int i = 0; i < 4; ++i) v[i] = sc >= 0 ? *(const f32x4*)(src + (size_t)(k0 + 4 * kq + i) * ld + sc) : f4zero();
    SYNC();
#pragma unroll
    for (int j = 0; j < 4; ++j) { u32x2 w; w[0] = pk2(v[0][j], v[1][j]); w[1] = pk2(v[2][j], v[3][j]); *(u32x2*)(tl + (4 * nq + j) * LDT + 4 * kq) = w; }
    SYNC();
#pragma unroll
    for (int t = 0; t < 2; ++t) { const int id = tid + 512 * t, row = id >> 3, ch = id & 7;
        *(bf16x8*)(dst + (size_t)(n0 + row) * K + k0 + 8 * ch) = *(const bf16x8*)(tl + row * LDT + 8 * ch); }
}
constexpr int KSUP = FF >= 256 ? 256 : FF, NSUP = KSUP / 64;
DEV void tr_super(unsigned char* smem, const float* src0, const float* src1, int ld, int K, int mode, bf16* dst, int n0, int k0) {
    const int tid = TID, nq = tid & 31, kq = tid >> 5;
    int sc = n0 + 4 * nq; const float* src = src0;
    if (mode == 7) { const int cc = tr_col(7, sc); src = cc >= FF ? src1 : src0; sc = cc >= FF ? cc - FF : cc; }
    f32x4 v[NSUP][4];
#pragma unroll
    for (int sb = 0; sb < NSUP; ++sb)
#pragma unroll
        for (int i = 0; i < 4; ++i) v[sb][i] = *(const f32x4*)(src + (size_t)(k0 + 64 * sb + 4 * kq + i) * ld + sc);
    SYNC();
    const int fw = nq & (KSUP / 16 - 1);
#pragma unroll
    for (int j = 0; j < 4; ++j)
#pragma unroll
        for (int sb = 0; sb < NSUP; ++sb) { const int c16 = 8 * sb + (kq >> 1); u32x2 w; w[0] = pk2(v[sb][0][j], v[sb][1][j]); w[1] = pk2(v[sb][2][j], v[sb][3][j]);
            *(u32x2*)(smem + (4 * nq + j) * (KSUP * 2) + ((c16 ^ fw) << 4) + (kq & 1) * 8) = w; }
    SYNC();
#pragma unroll
    for (int t = 0; t < 128 * (KSUP / 8) / NT; ++t) { const int id = tid + NT * t, row = id / (KSUP / 8), ch = id % (KSUP / 8), f = (row >> 2) & (KSUP / 16 - 1);
        *(bf16x8*)(dst + (size_t)(n0 + row) * K + k0 + 8 * (ch ^ f)) = *(const bf16x8*)(smem + row * (KSUP * 2) + ch * 16); }
}
constexpr int MOE_S13 = (2 * FF / 128) * (DM / KSUP), MOE_S2 = (DM / 128) * (FF / KSUP), MOE_SPE = MOE_S13 + MOE_S2, MOE_NIT = DEPTH * 32 * MOE_SPE;
DEV void moe_conv_tile(const Args& a, unsigned char* smem, int it) {
    unsigned char* ws = wsp(a); const int le = it / MOE_SPE, r = it % MOE_SPE;
    if (r < MOE_S13) { const int tn = r % (2 * FF / 128), tk = r / (2 * FF / 128);
        tr_super(smem, INP(a, I_W1) + (size_t)le * DM * FF, INP(a, I_W3) + (size_t)le * DM * FF, FF, DM, 7, (bf16*)(ws + WS_W13) + (size_t)le * 2 * FF * DM, tn * 128, tk * KSUP); }
    else { const int r2 = r - MOE_S13, tn = r2 % (DM / 128), tk = r2 / (DM / 128);
        tr_super(smem, INP(a, I_W2) + (size_t)le * FF * DM, INP(a, I_W2), DM, FF, 0, (bf16*)(ws + WS_W2) + (size_t)le * DM * FF, tn * 128, tk * KSUP); }
}
#ifndef EMU
constexpr int MOE_TAIL_Q = 3;
constexpr int MOE_N0 = MOE_NIT - 2 * MOE_TAIL_Q * (128 + 224) > 2 * 32 * MOE_SPE ? MOE_NIT - 2 * MOE_TAIL_Q * (128 + 224) : 2 * 32 * MOE_SPE;
DEV int moe_conv_fetch(const Args& a, unsigned char* smem) {
    int* ctr = (int*)(wsp(a) + WS_BAR) + P0_CTR_IDX; int* nxl = (int*)(smem + 72 * 1024);
    SYNC(); if (TID == 0) nxl[0] = atomic_add_i(ctr, 1); SYNC(); return nxl[0];
}
DEV void moe_conv_pull(const Args& a, unsigned char* smem, int quota) {
    for (int q = 0; q < quota; ++q) { const int it = moe_conv_fetch(a, smem); if (it >= MOE_NIT) break; moe_conv_tile(a, smem, it); }
    SYNC();
}
DEV void moe_conv_drain(const Args& a, unsigned char* smem, int limit) {
    __attribute__((address_space(1))) unsigned* ctr = (__attribute__((address_space(1))) unsigned*)((unsigned*)(wsp(a) + WS_BAR) + P0_CTR_IDX);
    for (;;) { if ((int)__builtin_amdgcn_readfirstlane((int)__hip_atomic_load(ctr, __ATOMIC_RELAXED, __HIP_MEMORY_SCOPE_AGENT)) >= limit) break;
        const int it = moe_conv_fetch(a, smem); if (it >= MOE_NIT) break; moe_conv_tile(a, smem, it); }
    SYNC();
}
#endif
struct TrJob { const float* s; int ld, K, N, mode; bf16* dst; };
DEV void p0_phase(const Args& a, unsigned char* smem) {
    unsigned char* ws = wsp(a); const int tid = TID;
    { int item = BID, base = 0;
      for (int j = 0; j < 8; ++j) { TrJob J; const int i = j & 1;
        if (j < 2) J = {INP(a, I_WIN) + (size_t)i * DM * NIN, NIN, DM, NIN8, 5, (bf16*)(ws + WS_WIN) + (size_t)i * NIN8 * DM};
        else if (j < 4) J = {INP(a, I_WOUT) + (size_t)i * 1024 * DM, DM, 1024, DM, 0, (bf16*)(ws + WS_WOUT) + (size_t)i * DM * 1024};
        else if (j < 6) J = {INP(a, I_PW1) + (size_t)i * DM * 2 * DM, 2 * DM, DM, 2 * DM, 6, (bf16*)(ws + WS_PW1) + (size_t)i * 2 * DM * DM};
        else J = {INP(a, I_PW2) + (size_t)i * DM * DM, DM, DM, DM, 0, (bf16*)(ws + WS_PW2) + (size_t)i * DM * DM};
        const int tn = J.N / 128, tk = J.K / 64, nt = tn * tk;
        while (item < base + nt) { const int it = item - base; tr_tile(smem, J.s, J.ld, J.K, J.mode, J.dst, (it % tn) * 128, (it / tn) * 64); item += NBLK; }
        base += nt; }
      SYNC(); }
    {
        float* red = (float*)smem;
        constexpr int NG = 6 * DM / 128; const int ntask = DEPTH * NG;
        for (int t = BID; t < ntask; t += NBLK) {
            const int l = t / NG, j0 = (t % NG) * 128, cq = tid & 31, kr = tid >> 5;
            const float* w = INP(a, I_ADAW) + (size_t)l * DM * 6 * DM + j0 + 4 * cq; const float* cc = INP(a, I_C);
            f32x4 a0 = f4zero(), a1 = f4zero();
#pragma unroll 8
            for (int i = 0; i < DM / 16; ++i) { const int k = kr + 16 * i; const f32x4 wv = *(const f32x4*)(w + (size_t)k * 6 * DM); const float s0 = siluf(cc[k]), s1 = siluf(cc[DM + k]);
#pragma unroll
                for (int r = 0; r < 4; ++r) { a0[r] += s0 * wv[r]; a1[r] += s1 * wv[r]; } }
            SYNC();
            *(f32x4*)(red + (kr * 2 + 0) * 128 + 4 * cq) = a0; *(f32x4*)(red + (kr * 2 + 1) * 128 + 4 * cq) = a1;
            SYNC();
            if (tid < 256) { const int b = tid >> 7, col = tid & 127; float sum = INP(a, I_ADAB)[(size_t)l * 6 * DM + j0 + col];
#pragma unroll
                for (int q = 0; q < 16; ++q) sum += red[(q * 2 + b) * 128 + col];
                ((float*)(ws + WS_MOD))[((size_t)l * 2 + b) * 6 * DM + j0 + col] = sum; }
        }
    }
    for (int t = BID; t < 32; t += NBLK) {
        float* red = (float*)smem; const int ikv = t >> 3, kp = t & 7, i = ikv >> 1, kv = ikv & 1, e = tid & 63, ks = tid >> 6;
        const float* W = INP(a, kv ? I_CWV : I_CWK) + (size_t)i * 2048 * 64 + e; const float* pe = INP(a, I_CPE) + (size_t)i * 2048;
        float sum = 0.f;
#pragma unroll 8
        for (int q = 0; q < 32; ++q) { const int k = kp * 256 + ks * 32 + q; sum += pe[k] * W[(size_t)k * 64]; }
        SYNC(); red[ks * 64 + e] = sum; SYNC();
        if (tid < 64) { float v = 0.f; for (int q = 0; q < 8; ++q) v += red[q * 64 + tid]; ((float*)(ws + WS_CB))[(ikv * 8 + kp) * 64 + tid] = v; }
    }
    for (int i = BID * NT + tid; i < DEPTH * 48 * DM; i += NBLK * NT) { const int k = i % DM, n = (i / DM) % 48, ll = i / (48 * DM);
        const float wv = n < 4 ? INP(a, I_WG)[((size_t)ll * DM + k) * 4 + n] : (n < 36 ? INP(a, I_WE)[((size_t)ll * DM + k) * 32 + n - 4] : 0.f);
        const unsigned hi = f2bf(wv); ((bf16*)(ws + WS_WTH))[i] = (bf16)hi; ((bf16*)(ws + WS_WTL))[i] = (bf16)f2bf(wv - bf2f(hi)); }
    if (BID == 0) {
        for (int i = tid; i < DEPTH * 32; i += NT) ((int*)(ws + WS_CNT))[i * 64] = 0;
        for (int i = tid; i < DEPTH * 256; i += NT) ((unsigned*)(ws + WS_FLG))[i * 16] = 0u;
        for (int n = tid; n < 512; n += NT) { const float l0 = INP(a, I_LBL)[n], l1 = INP(a, I_LBL)[512 + n]; const float m = fmaxf(l0, l1);
            const float e0 = fexp2((l0 - m) * LOG2E), e1 = fexp2((l1 - m) * LOG2E);
            ((float*)(ws + WS_LB))[n] = 0.f; ((float*)(ws + WS_LB))[512 + n] = e1 / (e0 + e1); }
        if (tid < 2) { const int i = tid; float mq = 0.f; for (int d = 0; d < 64; ++d) mq = fmaxf(mq, fabsf(INP(a, I_QG)[i * 64 + d]));
            for (int br = 0; br < 3; ++br) { float mk = 0.f; for (int d = 0; d < 64; ++d) mk = fmaxf(mk, fabsf(INP(a, I_KG)[(i * 3 + br) * 64 + d]));
                ((float*)(ws + WS_CS))[i * 4 + br] = 8.0f * mq * mk * LOG2E; } }
    }
    SYNC();
    {
#ifdef EMU
      for (int it = BID; it < MOE_NIT; it += NBLK) moe_conv_tile(a, smem, it);
#else
      int* ctr = (int*)(ws + WS_BAR) + P0_CTR_IDX; int* nxl = (int*)(smem + 72 * 1024);
      int my_next = 0; if (tid == 0) my_next = atomic_add_i(ctr, 1);
      for (;;) { if (tid == 0) nxl[0] = my_next; SYNC(); const int it = nxl[0]; if (it >= MOE_NIT) break;
          const bool more = it < MOE_N0;
          if (more && tid == 0) my_next = atomic_add_i(ctr, 1);
          moe_conv_tile(a, smem, it);
          if (!more) break; }
#endif
      SYNC(); }
}

constexpr int NJV = DM / 256;
DEV void moe_bases(const int* cnt, int* rb  ) {
    if (TID == 0) { int acc = 0; for (int e = 0; e < 32; ++e) { rb[e] = acc; acc += ((cnt[e * 64] + 255) >> 8) << 8; } rb[32] = acc; }
    SYNC();
}
DEV void norm_phase(const Args& a, unsigned char* smem, int l) {
    unsigned char* ws = wsp(a); const int tid = TID, w = tid >> 6, lane = tid & 63;
    int* rb = (int*)smem;
    if (l > 0) moe_bases((const int*)(ws + WS_CNT) + (l - 1) * 32 * 64, rb);
    const float* mod = (const float*)(ws + WS_MOD);
    const bf16* yk = (const bf16*)(ws + WS_YK);
    if (l < DEPTH) {
        const int bid = BID % 76 == BID ? BID : -1;
        for (int job = BID; job < 76; job += NBLK) {
            if (job < 72) { const int b = job / 36, n = job % 36; float sum = 0.f;
                for (int k = tid; k < DM; k += NT) { const float wv = n < 4 ? INP(a, I_WG)[((size_t)l * DM + k) * 4 + n] : INP(a, I_WE)[((size_t)l * DM + k) * 32 + n - 4]; sum += mod[((size_t)l * 2 + b) * 6 * DM + 3 * DM + k] * wv; }
#pragma unroll
                for (int q = 1; q < 64; q <<= 1) sum += shflx(sum, q);
                float* red = (float*)(smem + 1024);
                SYNC(); if (lane == 0) red[w] = sum; SYNC();
                if (tid == 0) { float t = 0.f; for (int q = 0; q < 8; ++q) t += red[q]; ((float*)(ws + WS_RBIAS))[((size_t)l * 2 + b) * 48 + n] = t; }
            } else { const float* nf = INP(a, I_NFFN) + (size_t)l * DM; const int part = job - 72;
                for (int i = part * (2 * DM / 4) + tid; i < (part + 1) * (2 * DM / 4); i += NT) { const int b = i / DM, k = i % DM; ((float*)(ws + WS_AVEC))[((size_t)l * 2 + b) * DM + k] = nf[k] * (1.0f + mod[((size_t)l * 2 + b) * 6 * DM + 4 * DM + k]); } }
        }
        (void)bid;
    }
    const int rstride = NBLK * 8;
    for (int rowa = BID * 8 + w; rowa < T; rowa += 2 * rstride) {
        int row[2]; bool ok[2];
        row[0] = rowa; ok[0] = true; row[1] = rowa + rstride; ok[1] = row[1] < T; if (!ok[1]) row[1] = rowa;
        f32x4 v[2][NJV]; int e0[2], p0[2], e1[2], p1[2]; float w0[2], w1[2];
        const float* xin = (l == 0) ? INP(a, I_X) : outp(a);
#pragma unroll
        for (int q = 0; q < 2; ++q) {
#pragma unroll
            for (int j = 0; j < NJV; ++j) v[q][j] = *(const f32x4*)(xin + (size_t)row[q] * DM + 4 * lane + 256 * j);
            if (l > 0) { const int* tie = (const int*)(ws + WS_TIE) + (size_t)row[q] * 2; const float* tiw = (const float*)(ws + WS_TIW) + (size_t)row[q] * 2;
                e0[q] = tie[0] >> 14; p0[q] = tie[0] & 16383; e1[q] = tie[1] >> 14; p1[q] = tie[1] & 16383; w0[q] = tiw[0]; w1[q] = tiw[1]; } }
        if (l > 0) {
            u32x2 q0[2][NJV], q1[2][NJV];
#pragma unroll
            for (int q = 0; q < 2; ++q) { const bf16* y0 = yk + (size_t)(rb[e0[q]] + p0[q]) * DM; const bf16* y1 = yk + (size_t)(rb[e1[q]] + p1[q]) * DM;
#pragma unroll
                for (int j = 0; j < NJV; ++j) { const int cidx = 4 * lane + 256 * j; q0[q][j] = *(const u32x2*)(y0 + cidx); q1[q][j] = *(const u32x2*)(y1 + cidx); } }
#pragma unroll
            for (int q = 0; q < 2; ++q) { const int b = row[q] / SEQ; const float* gf = mod + ((size_t)(l - 1) * 2 + b) * 6 * DM + 5 * DM;
#pragma unroll
                for (int j = 0; j < NJV; ++j) { const int cidx = 4 * lane + 256 * j; const f32x4 g = *(const f32x4*)(gf + cidx);
                    v[q][j][0] += g[0] * (w0[q] * bf2f(q0[q][j][0] & 0xffff) + w1[q] * bf2f(q1[q][j][0] & 0xffff));
                    v[q][j][1] += g[1] * (w0[q] * bf2f(q0[q][j][0] >> 16) + w1[q] * bf2f(q1[q][j][0] >> 16));
                    v[q][j][2] += g[2] * (w0[q] * bf2f(q0[q][j][1] & 0xffff) + w1[q] * bf2f(q1[q][j][1] & 0xffff));
                    v[q][j][3] += g[3] * (w0[q] * bf2f(q0[q][j][1] >> 16) + w1[q] * bf2f(q1[q][j][1] >> 16)); } }
        }
        if (l > 0)
#pragma unroll
        for (int q = 0; q < 2; ++q) { if (!ok[q]) continue;
#pragma unroll
            for (int j = 0; j < NJV; ++j) *(f32x4*)(outp(a) + (size_t)row[q] * DM + 4 * lane + 256 * j) = v[q][j]; }
        if (l == DEPTH) continue;
        float ss[2];
#pragma unroll
        for (int q = 0; q < 2; ++q) { ss[q] = 0.f;
#pragma unroll
            for (int j = 0; j < NJV; ++j) ss[q] += v[q][j][0] * v[q][j][0] + v[q][j][1] * v[q][j][1] + v[q][j][2] * v[q][j][2] + v[q][j][3] * v[q][j][3]; }
#pragma unroll
        for (int o = 1; o < 64; o <<= 1) { ss[0] += shflx(ss[0], o); ss[1] += shflx(ss[1], o); }
        const float* nm = INP(a, I_NMIX) + (size_t)l * DM;
#pragma unroll
        for (int q = 0; q < 2; ++q) { if (!ok[q]) continue;
            const int b = row[q] / SEQ; const float rs = frsq(ss[q] * (1.0f / DM) + EPS);
            const float* mm = mod + ((size_t)l * 2 + b) * 6 * DM; bf16* hb = (bf16*)(ws + WS_H) + (size_t)row[q] * DM;
#pragma unroll
            for (int j = 0; j < NJV; ++j) { const int cidx = 4 * lane + 256 * j; f32x4 g = *(const f32x4*)(nm + cidx), sh = *(const f32x4*)(mm + cidx), sc = *(const f32x4*)(mm + DM + cidx), o;
#pragma unroll
                for (int r = 0; r < 4; ++r) o[r] = v[q][j][r] * rs * g[r] * (1.0f + sc[r]) + sh[r];
                st_bf4(hb + cidx, o); } }
    }
}

DEV void route_phase(const Args& a, unsigned char* smem, int l) {
    unsigned char* ws = wsp(a); const int tid = TID, w = tid >> 6, lane = tid & 63, h = lane >> 4, c = lane & 15, pi = w >> 1, kh = w & 1;
    constexpr int NCHK = 4, CH = DM / NCHK, WLD = CH + 8, NKS = CH / 2 / 32;
    constexpr int WTOT = 48 * (CH / 8), WMAX = (WTOT + NT - 1) / NT;
    bf16* WHl = (bf16*)smem; bf16* WLl = WHl + 48 * WLD;
    float* lg = (float*)(WLl + 48 * WLD);
    float* ssb = lg + 4 * 2 * 16 * 48;
    float* rsb = ssb + 4 * 2 * 16;
    int* lcnt = (int*)(rsb + 64); int* lbase = lcnt + 32; int* tinfo = lbase + 32;
    float* avl = (float*)(tinfo + 256); float* cvl = avl + 2 * DM;
    const float* mod = (const float*)(ws + WS_MOD);
    SYNC();
    if (tid < 32) lcnt[tid] = 0;
    for (int i = tid; i < 2 * DM; i += NT) { const int b = i / DM, k = i % DM; avl[i] = ((const float*)(ws + WS_AVEC))[((size_t)l * 2 + b) * DM + k]; cvl[i] = mod[((size_t)l * 2 + b) * 6 * DM + 3 * DM + k]; }
    const bf16* WH = (const bf16*)(ws + WS_WTH) + (size_t)l * 48 * DM; const bf16* WL = (const bf16*)(ws + WS_WTL) + (size_t)l * 48 * DM;
    int* cnt = (int*)(ws + WS_CNT) + l * 32 * 64;
    for (int pass0 = BID; pass0 < T / 16; pass0 += 4 * NBLK) {
        const int pass = pass0 + pi * NBLK; const bool valid = pass < T / 16;
        const int tok = valid ? pass * 16 + c : 0, b = tok / SEQ;
        const float* xrow = outp(a) + (size_t)tok * DM;
        f32x4 xv[2][NKS][2]; bf16x8 wh[WMAX], wl[WMAX];
#pragma unroll
        for (int ks = 0; ks < NKS; ++ks) { const float* xq = xrow + kh * (CH / 2) + 8 * h + 32 * ks; xv[0][ks][0] = *(const f32x4*)xq; xv[0][ks][1] = *(const f32x4*)(xq + 4); }
#pragma unroll
        for (int t = 0; t < WMAX; ++t) { const int i = tid + NT * t; if (i < WTOT) { const int n = i / (CH / 8), k8 = (i % (CH / 8)) * 8; wh[t] = *(const bf16x8*)(WH + (size_t)n * DM + k8); wl[t] = *(const bf16x8*)(WL + (size_t)n * DM + k8); } }
        f32x4 acc[3] = {f4zero(), f4zero(), f4zero()}; float ss = 0.f;
        bf16x8 uhk[NCHK * NKS];
#pragma unroll
        for (int chn = 0; chn < NCHK; ++chn) {
            SYNC();
#pragma unroll
            for (int t = 0; t < WMAX; ++t) { const int i = tid + NT * t; if (i < WTOT) { const int n = i / (CH / 8), k8 = (i % (CH / 8)) * 8; *(bf16x8*)(WHl + n * WLD + k8) = wh[t]; *(bf16x8*)(WLl + n * WLD + k8) = wl[t]; } }
            SYNC();
            if (chn + 1 < NCHK) {
#pragma unroll
                for (int ks = 0; ks < NKS; ++ks) { const float* xq = xrow + (chn + 1) * CH + kh * (CH / 2) + 8 * h + 32 * ks; xv[(chn + 1) & 1][ks][0] = *(const f32x4*)xq; xv[(chn + 1) & 1][ks][1] = *(const f32x4*)(xq + 4); }
#pragma unroll
                for (int t = 0; t < WMAX; ++t) { const int i = tid + NT * t; if (i < WTOT) { const int n = i / (CH / 8), k8 = (i % (CH / 8)) * 8; wh[t] = *(const bf16x8*)(WH + (size_t)n * DM + (chn + 1) * CH + k8); wl[t] = *(const bf16x8*)(WL + (size_t)n * DM + (chn + 1) * CH + k8); } }
            }
            if (valid) {
                const bf16* whp = WHl + c * WLD + kh * (CH / 2) + 8 * h; const bf16* wlp = WLl + c * WLD + kh * (CH / 2) + 8 * h;
                const float* ap = avl + b * DM + chn * CH + kh * (CH / 2) + 8 * h;
#pragma unroll
                for (int ks = 0; ks < NKS; ++ks) {
                    const f32x4 a0 = *(const f32x4*)(ap + 32 * ks), a1 = *(const f32x4*)(ap + 32 * ks + 4);
                    const f32x4 x0 = xv[chn & 1][ks][0], x1 = xv[chn & 1][ks][1];
                    f32x4 u0, u1, r0, r1;
#pragma unroll
                    for (int r = 0; r < 4; ++r) { u0[r] = x0[r] * a0[r]; u1[r] = x1[r] * a1[r]; ss += x0[r] * x0[r] + x1[r] * x1[r]; }
                    const bf16x8 uh = pack8(u0, u1); uhk[chn * NKS + ks] = uh;
#pragma unroll
                    for (int r = 0; r < 4; ++r) { r0[r] = u0[r] - bf2f((unsigned short)uh[r]); r1[r] = u1[r] - bf2f((unsigned short)uh[4 + r]); }
                    const bf16x8 ul = pack8(r0, r1);
#pragma unroll
                    for (int nt = 0; nt < 3; ++nt) { const bf16x8 whf = *(const bf16x8*)(whp + nt * 16 * WLD + 32 * ks), wlf = *(const bf16x8*)(wlp + nt * 16 * WLD + 32 * ks);
                        acc[nt] = mfma16(whf, uh, acc[nt]); acc[nt] = mfma16(wlf, uh, acc[nt]); acc[nt] = mfma16(whf, ul, acc[nt]); }
                }
            }
        }
        if (valid) {
            ss += shflx(ss, 16); ss += shflx(ss, 32);
            float* lgp = lg + ((pi * 2 + kh) * 16 + c) * 48 + 4 * h;
#pragma unroll
            for (int nt = 0; nt < 3; ++nt) *(f32x4*)(lgp + 16 * nt) = acc[nt];
            if (h == 0) ssb[(pi * 2 + kh) * 16 + c] = ss;
        }
        SYNC();
        if (tid < 64) { const int p2 = tid >> 4, tk = tid & 15, pass2 = pass0 + p2 * NBLK;
            if (pass2 < T / 16) { const int tok2 = pass2 * 16 + tk, b2 = tok2 / SEQ;
                const float rs = frsq((ssb[(p2 * 2 + 0) * 16 + tk] + ssb[(p2 * 2 + 1) * 16 + tk]) * (1.0f / DM) + EPS); rsb[p2 * 16 + tk] = rs;
                const float* l0 = lg + ((p2 * 2 + 0) * 16 + tk) * 48; const float* l1 = lg + ((p2 * 2 + 1) * 16 + tk) * 48; const float* rbp = (const float*)(ws + WS_RBIAS) + ((size_t)l * 2 + b2) * 48;
                float acc[36];
#pragma unroll
                for (int n = 0; n < 36; ++n) acc[n] = rs * (l0[n] + l1[n]) + rbp[n];
                int gs = 0; float gm = acc[0];
#pragma unroll
                for (int g = 1; g < 4; ++g) if (acc[g] > gm) { gm = acc[g]; gs = g; }
                float den = 0.f;
#pragma unroll
                for (int g = 0; g < 4; ++g) den += fexp2((acc[g] - gm) * LOG2E);
                const float ggate = 1.0f / den;
                float el[8];
#pragma unroll
                for (int j = 0; j < 8; ++j) { el[j] = acc[4 + j];
#pragma unroll
                    for (int g = 1; g < 4; ++g) if (gs == g) el[j] = acc[4 + 8 * g + j]; }
                int ia = 0; float va = el[0];
#pragma unroll
                for (int j = 1; j < 8; ++j) if (el[j] > va) { va = el[j]; ia = j; }
                int ib = -1; float vb = -3e38f;
#pragma unroll
                for (int j = 0; j < 8; ++j) if (j != ia && el[j] > vb) { vb = el[j]; ib = j; }
                const float wa = 1.0f / (1.0f + fexp2((vb - va) * LOG2E)), wb = 1.0f - wa;
                const int e0 = gs * 8 + ia, e1 = gs * 8 + ib;
                const int p0 = atomic_add_i(lcnt + e0, 1), p1 = atomic_add_i(lcnt + e1, 1);
                int* ti = tinfo + tid * 4;
                ti[0] = (e0 << 14) | p0; ti[1] = (e1 << 14) | p1; ti[2] = __builtin_bit_cast(int, ggate * wa); ti[3] = __builtin_bit_cast(int, ggate * wb);
            } }
        SYNC();
        int gbase = 0;
        if (tid < 32) { const int n = lcnt[tid]; gbase = n > 0 ? atomic_add_i(cnt + tid * 64, n) : 0; }
        if (valid) { const float rs = rsb[pi * 16 + c]; bf16* hb = (bf16*)(ws + WS_H) + (size_t)tok * DM + kh * (CH / 2) + 8 * h;
            const float* cp = cvl + b * DM + kh * (CH / 2) + 8 * h;
#pragma unroll
            for (int chn = 0; chn < NCHK; ++chn)
#pragma unroll
                for (int ks = 0; ks < NKS; ++ks) {
                    const bf16x8 uh = uhk[chn * NKS + ks]; const f32x4 c0 = *(const f32x4*)(cp + chn * CH + 32 * ks), c1 = *(const f32x4*)(cp + chn * CH + 32 * ks + 4);
                    f32x4 o0, o1;
#pragma unroll
                    for (int r = 0; r < 4; ++r) { o0[r] = bf2f((unsigned short)uh[r]) * rs + c0[r]; o1[r] = bf2f((unsigned short)uh[4 + r]) * rs + c1[r]; }
                    st_bf8(hb + chn * CH + 32 * ks, o0, o1); } }
        if (tid < 32) { lbase[tid] = gbase; lcnt[tid] = 0; }
        SYNC();
        if (tid < 64) { const int p2 = tid >> 4, pass2 = pass0 + p2 * NBLK;
            if (pass2 < T / 16) { const int tok2 = pass2 * 16 + (tid & 15); const int* ti = tinfo + tid * 4;
                const int e0 = ti[0] >> 14, e1 = ti[1] >> 14, p0 = lbase[e0] + (ti[0] & 16383), p1 = lbase[e1] + (ti[1] & 16383);
                int* list = (int*)(ws + WS_LIST); list[(size_t)e0 * T + p0] = tok2; list[(size_t)e1 * T + p1] = tok2;
                int* tie = (int*)(ws + WS_TIE) + (size_t)tok2 * 2; int* tiw = (int*)(ws + WS_TIW) + (size_t)tok2 * 2;
                tie[0] = (e0 << 14) | p0; tie[1] = (e1 << 14) | p1; tiw[0] = ti[2]; tiw[1] = ti[3]; } }
        SYNC();
    }
}

DEV int vbid() { const int g = NBLK; return (g % 8 == 0) ? (BID % 8) * (g / 8) + BID / 8 : BID; }
#ifdef EMU
#define PG8_LDS(p) (p)
#else
#define PG8_LDS(p) ((PG8_LAS unsigned char*)(p))
#endif
DEV void inproj_phase(const Args& a, unsigned char* smem, int li) {
    pg8::Gemm g{(const bf16*)(wsp(a) + WS_H), (const bf16*)(wsp(a) + WS_WIN) + (size_t)li * NIN8 * DM, T, NIN8, DM}; pg8::StaticOrder S; S.init(T, NIN8, NBLK, BID);
    EpiInProj8 E{&a, li};
    SYNC(); pg8::gemm_phase<EpiInProj8, pg8::StaticOrder, true, true>(PG8_LDS(smem), g, S, E); SYNC();
#ifndef EMU
    { pg8::Unit u; const int full = (T / 256) * (NIN8 / 256) / NBLK; if (!S.next(full, u)) moe_conv_pull(a, smem, MOE_TAIL_Q); }
#endif
}
DEV void resid_gemm_phase(const Args& a, unsigned char* smem, const bf16* A, int K, const bf16* Bt, int l) {
    pg8::Gemm g{A, Bt, T, DM, K}; pg8::StaticOrder S; S.init(T, DM, NBLK, BID);
    EpiResid8 E{outp(a), (const float*)(wsp(a) + WS_MOD) + (size_t)l * 2 * 6 * DM + 2 * DM, l == 0 ? INP(a, I_X) : (const float*)outp(a)};
    SYNC(); pg8::gemm_phase<EpiResid8, pg8::StaticOrder, true, true>(PG8_LDS(smem), g, S, E); SYNC();
}
DEV void pw1_phase(const Args& a, unsigned char* smem, int li) {
    pg8::Gemm g{(const bf16*)(wsp(a) + WS_H), (const bf16*)(wsp(a) + WS_PW1) + (size_t)li * 2 * DM * DM, T, 2 * DM, DM}; pg8::StaticOrder S; S.init(T, 2 * DM, NBLK, BID);
    EpiGlu8 E{(bf16*)(wsp(a) + WS_GLU)};
    SYNC(); pg8::gemm_phase<EpiGlu8, pg8::StaticOrder, true, true>(PG8_LDS(smem), g, S, E); SYNC();
}
DEV void cmp_phase_items(const Args& a, unsigned char* smem, int li, int it) {
    constexpr int TMC = (NCP + 255) / 256;
    const int kv = it / (4 * TMC), bg = (it / TMC) % 4, tm = it % TMC;
    const bf16* src = (const bf16*)(wsp(a) + (kv ? WS_VCG : WS_KCG)) + (size_t)bg * SEQ * 64;
    struct AF { const bf16* base; int m0; MDEV unsigned off(int r) const { int n = m0 + r; if (n > NCMP - 1) n = NCMP - 1; return (unsigned)n * 1024u; } } af{src, tm * 256};
    EpiCmp E{&a, kv, bg, tm * 256, li};
    BClamp64 bf{INP(a, kv ? I_CWV : I_CWK) + (size_t)li * 2048 * 64};
    gemm_tile2(smem, af, bf, 64, 2048, E);
}
#ifdef EMU
DEV void wt_store64(void* p, unsigned long long v) { *(unsigned long long*)p = v; }
DEV unsigned ctr_add(unsigned* p, unsigned v) { return __atomic_fetch_add(p, v, __ATOMIC_SEQ_CST); }
DEV void acq_fence() {}
DEV void drain_stores() {}
typedef unsigned* ctr_ptr;
#else
DEV void wt_store64(void* p, unsigned long long v) { __hip_atomic_store((__attribute__((address_space(1))) unsigned long long*)p, v, __ATOMIC_RELAXED, __HIP_MEMORY_SCOPE_AGENT); }
typedef __attribute__((address_space(1))) unsigned* ctr_ptr;
DEV unsigned ctr_add(ctr_ptr p, unsigned v) { return __hip_atomic_fetch_add(p, v, __ATOMIC_RELAXED, __HIP_MEMORY_SCOPE_AGENT); }
DEV void acq_fence() { __builtin_amdgcn_fence(__ATOMIC_ACQUIRE, "agent"); }
DEV void drain_stores() { asm volatile("s_waitcnt vmcnt(0)" ::: "memory"); }
#endif
struct EpiCmpPart { float* P;
    MDEV void operator()(f32x4 (&acc)[4][4], int mw, int nw, int h, int c) const {
        if (nw != 0) return;
        const int idx = mw + 16 * h + c;
#pragma unroll
        for (int ni = 0; ni < 4; ++ni)
#pragma unroll
            for (int mi = 0; mi < 4; ++mi) { float* p = P + ((size_t)(ni * 4 + mi) * 256 + idx) * 4;
                const u32x4 u = __builtin_bit_cast(u32x4, acc[ni][mi]);
                wt_store64(p, (unsigned long long)u[0] | ((unsigned long long)u[1] << 32));
                wt_store64(p + 2, (unsigned long long)u[2] | ((unsigned long long)u[3] << 32)); }
    }
};
DEV void cmp_split_item(const Args& a, unsigned char* smem, int li, int item, ctr_ptr tilec) {
    constexpr int TMC = (NCP + 255) / 256, S = CMP_SPLIT, KP = 2048 / S;
    unsigned char* ws = wsp(a);
    const int tile = item / S, sp = item % S;
    const int kv = tile / (4 * TMC), bg = (tile / TMC) % 4, tm = tile % TMC;
    const bf16* src = (const bf16*)(ws + (kv ? WS_VCG : WS_KCG)) + (size_t)bg * SEQ * 64;
    struct AF { const bf16* base; int m0; MDEV unsigned off(int r) const { int n = m0 + r; if (n > NCMP - 1) n = NCMP - 1; return (unsigned)n * 1024u; } } af{src + sp * KP, tm * 256};
    float* Pt = (float*)(ws + WS_CMPP) + (size_t)tile * S * 16 * 256 * 4;
    EpiCmpPart E{Pt + (size_t)sp * 16 * 256 * 4};
    BClamp64 bf{INP(a, kv ? I_CWV : I_CWK) + (size_t)li * 2048 * 64 + (size_t)sp * KP * 64};
    gemm_tile2(smem, af, bf, 64, KP, E);
    drain_stores(); SYNC();
    int* fl = (int*)(smem + LDS_BYTES - 128);
    if (TID == 0) fl[0] = (int)ctr_add(tilec + tile, 1u);
    SYNC();
    if (fl[0] == S - 1) {
        acq_fence();
        const int tid = TID, w = tid >> 6, l = tid & 63, h = l >> 4, c = l & 15, wm = w >> 1, wn = w & 1;
        f32x4 acc[4][4];
#pragma unroll
        for (int i = 0; i < 4; ++i)
#pragma unroll
            for (int j = 0; j < 4; ++j) acc[i][j] = f4zero();
        if (wn == 0) { const int idx = wm * 64 + l;
#pragma unroll 1
            for (int s2 = 0; s2 < S; ++s2) { const float* P = Pt + (size_t)s2 * 16 * 256 * 4;
#pragma unroll
                for (int q = 0; q < 16; ++q) { const f32x4 v = *(const f32x4*)(P + ((size_t)q * 256 + idx) * 4);
#pragma unroll
                    for (int r = 0; r < 4; ++r) acc[q >> 2][q & 3][r] += v[r]; } } }
        EpiCmp E2{&a, kv, bg, tm * 256, li};
        E2(acc, wm * 64, wn * 64, h, c);
    }
    SYNC();
}
DEV void moe_gemm_phase8(const Args& a, unsigned char* smem, int l, int mode) {
    unsigned char* ws = wsp(a); const int* cnt = (const int*)(ws + WS_CNT) + l * 32 * 64;
    int* rb = (int*)(smem + 140 * 1024);
    moe_bases(cnt, rb);
    const int mrows = rb[32];
    if (mode == 0) {
        pg8::Gemm g{(const bf16*)(ws + WS_H), (const bf16*)(ws + WS_W13) + (size_t)l * 32 * 2 * FF * DM, mrows, 2 * FF, DM}; pg8::StaticOrder S; S.init(mrows, 2 * FF, NBLK, BID);
        EpiMoe1_8 E{(bf16*)(ws + WS_ACT)}; MoeSel<true> X{rb, cnt, (const int*)(ws + WS_LIST), (size_t)2 * FF * DM * 2};
        SYNC(); pg8::gemm_phase<EpiMoe1_8, pg8::StaticOrder, true, true, MoeSel<true>>(PG8_LDS(smem), g, S, E, X); SYNC();
    } else {
        pg8::Gemm g{(const bf16*)(ws + WS_ACT), (const bf16*)(ws + WS_W2) + (size_t)l * 32 * DM * FF, mrows, DM, FF}; pg8::StaticOrder S; S.init(mrows, DM, NBLK, BID);
        EpiMoe2_8 E{(bf16*)(ws + WS_YK)}; MoeSel<false> X{rb, cnt, (const int*)(ws + WS_LIST), (size_t)DM * FF * 2};
        SYNC(); pg8::gemm_phase<EpiMoe2_8, pg8::StaticOrder, true, true, MoeSel<false>>(PG8_LDS(smem), g, S, E, X); SYNC();
    }
}
#ifndef EMU
constexpr int MOE_TMO_IDX = 128;
struct MoeOrder { int nN, t0, nu, j, nper, nA; bool rev;
    __device__ __forceinline__ void init(int ntile, int nN_, int nblk, int bid, bool rev_) { nN = nN_; nper = nblk / 8; rev = rev_; const int x = bid % 8; j = bid / 8;
        t0 = x * ntile / 8; nu = ((x + 1) * ntile / 8 - t0) * nN; if (bid >= 8 * nper) nu = 0;
        nA = nu - 2 * nper; nA = nA < 0 ? 0 : (nA > nper / 2 ? nper / 2 : nA); }
    __device__ __forceinline__ bool next(int i, pg8::Unit& u) const { int p;
        if (!rev) p = i * nper + j;
        else if (j < nA) { if (i > 0) return false; p = nu - nA + j; }
        else { p = i * (nper - nA) + (j - nA); if (p >= nu - nA) return false; }
        if (p >= nu) return false; u.pm = t0 + p / nN; u.pn = p % nN; return true; }
    __device__ __forceinline__ void a_ready(const pg8::Unit&) const {}
    __device__ __forceinline__ void done(const pg8::Unit&) const {}
};
struct MoeProd : MoeOrder { unsigned* flg;
    __device__ __forceinline__ void done(const pg8::Unit& u) const {
        asm volatile("s_waitcnt vmcnt(0)" ::: "memory"); __builtin_amdgcn_s_barrier(); asm volatile("" ::: "memory");
        if (TID == 0) (void)__hip_atomic_fetch_add((__attribute__((address_space(1))) unsigned*)(flg + u.pm * 16), 1u, __ATOMIC_RELAXED, __HIP_MEMORY_SCOPE_AGENT); } };
struct MoeCons : MoeOrder { unsigned* flg; unsigned* tmo;
    __device__ __forceinline__ void a_ready(const pg8::Unit& u) const {
        if ((TID >> 6) == 0) { unsigned sp = 0u; __attribute__((address_space(1))) unsigned* f = (__attribute__((address_space(1))) unsigned*)(flg + u.pm * 16);
            while ((unsigned)__builtin_amdgcn_readfirstlane((int)__hip_atomic_load(f, __ATOMIC_RELAXED, __HIP_MEMORY_SCOPE_AGENT)) < (unsigned)(2 * FF / 256)) {
                __builtin_amdgcn_s_sleep(1);
                if ((++sp & 255u) == 0u) { if (__hip_atomic_load((__attribute__((address_space(1))) unsigned*)tmo, __ATOMIC_RELAXED, __HIP_MEMORY_SCOPE_AGENT)) break;
                    if (sp > (1u << 22)) { (void)__hip_atomic_fetch_add((__attribute__((address_space(1))) unsigned*)tmo, 1u, __ATOMIC_RELAXED, __HIP_MEMORY_SCOPE_AGENT); break; } } }
            __builtin_amdgcn_fence(__ATOMIC_ACQUIRE, "agent"); }
        asm volatile("" ::: "memory"); __builtin_amdgcn_s_barrier(); asm volatile("" ::: "memory"); } };
DEV void moe_fused_phase(const Args& a, unsigned char* smem, int l) {
    unsigned char* ws = wsp(a); const int* cnt = (const int*)(ws + WS_CNT) + l * 32 * 64;
    int* rb = (int*)(smem + 140 * 1024);
    moe_bases(cnt, rb);
    const int mrows = rb[32]; unsigned* flg = (unsigned*)(ws + WS_FLG) + (size_t)l * 256 * 16;
    { pg8::Gemm g{(const bf16*)(ws + WS_H), (const bf16*)(ws + WS_W13) + (size_t)l * 32 * 2 * FF * DM, mrows, 2 * FF, DM}; MoeProd S; S.init(mrows >> 8, 2 * FF / 256, NBLK, BID, false); S.flg = flg;
      EpiMoe1_8 E{(bf16*)(ws + WS_ACT)}; MoeSel<true> X{rb, cnt, (const int*)(ws + WS_LIST), (size_t)2 * FF * DM * 2};
      SYNC(); pg8::gemm_phase<EpiMoe1_8, MoeProd, true, true, MoeSel<true>>(PG8_LDS(smem), g, S, E, X); }
    { pg8::Gemm g{(const bf16*)(ws + WS_ACT), (const bf16*)(ws + WS_W2) + (size_t)l * 32 * DM * FF, mrows, DM, FF}; MoeCons S; S.init(mrows >> 8, DM / 256, NBLK, BID, true); S.flg = flg; S.tmo = (unsigned*)(ws + WS_BAR) + MOE_TMO_IDX;
      EpiMoe2_8 E{(bf16*)(ws + WS_YK)}; MoeSel<false> X{rb, cnt, (const int*)(ws + WS_LIST), (size_t)DM * FF * 2};
      SYNC(); pg8::gemm_phase<EpiMoe2_8, MoeCons, true, true, MoeSel<false>>(PG8_LDS(smem), g, S, E, X); SYNC(); }
}
#endif
DEV void moe_gemm_phase(const Args& a, unsigned char* smem, int l, int mode) {
    unsigned char* ws = wsp(a); const int* cnt = (const int*)(ws + WS_CNT) + l * 32 * 64;
    int* rb = (int*)(smem + GEMM2_LDS);
    moe_bases(cnt, rb);
    const int ntile = rb[32] >> 8;
    constexpr int TN1 = 2 * FF / 128, TN2 = DM / 128;
    const int TN = mode == 0 ? TN1 : TN2;
    const int* list = (const int*)(ws + WS_LIST);
    for (int it = vbid(); it < ntile * TN; it += NBLK) {
        const int rt = it / TN, tn = it % TN; int e = 0;
#pragma unroll 1
        for (int q = 1; q < 32; ++q) if ((rb[q] >> 8) <= rt) e = q;
        const int rloc = (rt << 8) - rb[e], ce = cnt[e * 64], nvalid = (ce - rloc) < 256 ? (ce - rloc) : 256;
        if (mode == 0) {
            struct AF { const bf16* base; const int* lst; int nv; MDEV unsigned off(int r) const { const int rr = r < nv ? r : nv - 1; return (unsigned)lst[rr] * (unsigned)DM; } }
                af{(const bf16*)(ws + WS_H), list + (size_t)e * T + rloc, nvalid};
            EpiGated<1> E{(bf16*)(ws + WS_ACT), (size_t)FF, rt << 8, tn * 128, nvalid};
            BInter bf{INP(a, I_W1) + (size_t)(l * 32 + e) * DM * FF, INP(a, I_W3) + (size_t)(l * 32 + e) * DM * FF, tn * 128};
            gemm_tile2(smem, af, bf, FF, DM, E);
        } else {
            ARows af{(const bf16*)(ws + WS_ACT) + (size_t)(rt << 8) * FF, (size_t)FF};
            EpiStoreBf E{(bf16*)(ws + WS_YK), (size_t)DM, rt << 8, tn * 128, nvalid};
            BPlain bf{INP(a, I_W2) + (size_t)(l * 32 + e) * FF * DM + tn * 128};
            gemm_tile2(smem, af, bf, DM, FF, E);
        }
    }
}

constexpr int LDV = 80;
constexpr int AT_K = 0, AT_V = 2 * 64 * LDT * 2, AT_IMP = AT_V + 2 * 64 * LDV * 2, AT_SEL = AT_IMP + 8 * 8 * 128 * 4, AT_GSEL = AT_SEL + 8 * 8 * 4 * 4, AT_OUT = AT_GSEL + 8 * 2 * 4 * 4, AT_END = AT_OUT + 8 * 32 * 64 * 4;
#ifdef EMU
DEV float rexp2(float x) { return exp2f(x); }
DEV unsigned uni(unsigned x) { return x; }
#else
DEV float rexp2(float x) { return __builtin_amdgcn_exp2f(x); }
DEV unsigned uni(unsigned x) { return (unsigned)__builtin_amdgcn_readfirstlane((int)x); }
#endif
DEV int krow_lds(int kappa) { return 16 * (2 * (kappa >> 5) + ((kappa >> 2) & 1)) + 4 * ((kappa >> 3) & 3) + (kappa & 3); }
template <int MASK, bool FULL, int GM>
DEV void attn_block(const bf16* Kp, const bf16* Vp, const bf16x8 (&qf)[2][2], int j, const int (&s)[2], const bool (&selbit)[2], float C2, int h, int c,
                    f32x4 (&O)[2][4], f32x4 (&Ol)[2]) {
    f32x4 st[2][2][2];
#pragma unroll
    for (int sp = 0; sp < 2; ++sp)
#pragma unroll
        for (int u = 0; u < 2; ++u) {
#pragma unroll
            for (int G = 0; G < 2; ++G) { st[G][sp][u][0] = -C2; st[G][sp][u][1] = -C2; st[G][sp][u][2] = -C2; st[G][sp][u][3] = -C2; }
#pragma unroll
            for (int ks = 0; ks < 2; ++ks) { const bf16x8 kf = *(const bf16x8*)(Kp + (16 * (2 * sp + u) + c) * LDT + 32 * ks + 8 * h);
#pragma unroll
                for (int G = 0; G < 2; ++G) if (GM & (1 << G)) st[G][sp][u] = mfma16(kf, qf[G][ks], st[G][sp][u]); } }
#pragma unroll
    for (int G = 0; G < 2; ++G) if (GM & (1 << G))
#pragma unroll
        for (int sp = 0; sp < 2; ++sp)
#pragma unroll
            for (int u = 0; u < 2; ++u)
#pragma unroll
                for (int r = 0; r < 4; ++r) { bool ok = selbit[G];
                    if (!FULL) { const int key = 64 * j + 32 * sp + 8 * h + 4 * u + r;
                        if (MASK == 0) ok = 16 * key + 31 <= s[G]; else if (MASK == 1) ok = selbit[G] && key <= s[G]; else ok = key <= s[G] && key > s[G] - 512; }
                    st[G][sp][u][r] = ok ? rexp2(st[G][sp][u][r]) : 0.f; }
    bf16x8 pb[2][2], ones;
#pragma unroll
    for (int q = 0; q < 8; ++q) ones[q] = (short)0x3F80;
#pragma unroll
    for (int G = 0; G < 2; ++G) if (GM & (1 << G))
#pragma unroll
        for (int sp = 0; sp < 2; ++sp) { pb[G][sp] = pack8(st[G][sp][0], st[G][sp][1]); Ol[G] = mfma16(ones, pb[G][sp], Ol[G]); }
    const bf16* Vb = Vp + bperm(8 * h + (c >> 2)) * LDV + 4 * (c & 3);
#pragma unroll
    for (int et = 0; et < 4; ++et)
#pragma unroll
        for (int sp = 0; sp < 2; ++sp) { const bf16x8 vf = tr_read8(Vb + (32 * sp) * LDV + 16 * et, Vb + (32 * sp + 8) * LDV + 16 * et);
#pragma unroll
            for (int G = 0; G < 2; ++G) if (GM & (1 << G)) O[G][et] = mfma16(vf, pb[G][sp], O[G][et]); }
}

struct ImpState { float invq[2][4]; float carry[2]; float* imps; int tl, hd, l, s0, qblk; };
DEV void imp_block(const bf16* Kp, const bf16x8 (&qf)[2][2], int j, int s0, int w, float C2, int h, int c, ImpState& im) {
#pragma unroll
    for (int kt = 0; kt < 4; ++kt) {
        const int row = krow_lds(16 * kt + c);
        const bf16x8 k0 = *(const bf16x8*)(Kp + row * LDT + 8 * h), k1 = *(const bf16x8*)(Kp + row * LDT + 32 + 8 * h);
        const int n = 64 * j + 16 * kt + c;
#pragma unroll
        for (int G = 0; G < 2; ++G) {
            f32x4 acc; acc[0] = -C2; acc[1] = -C2; acc[2] = -C2; acc[3] = -C2;
            acc = mfma16(qf[G][0], k0, acc); acc = mfma16(qf[G][1], k1, acc);
            const bool ok = 16 * n + 31 <= s0 + 8 * w + 4 * G + h;
            float imp = 0.f;
#pragma unroll
            for (int r = 0; r < 4; ++r) imp += ok ? rexp2(acc[r]) * im.invq[G][r] : 0.f;
            const float v = ((c & 3) == 3) ? imp : 2.0f * imp;
            float sq = v + shflx(v, 1); sq += shflx(sq, 2);
            const float rr = dpp_ror1(imp);
            const float prev = (c == 0) ? im.carry[G] : rr;
            im.carry[G] = rr;
            const int m = n >> 2;
            if ((c & 3) == 0 && m < 128) im.imps[(G * 4 + h) * 128 + m] = sq + prev;
        }
    }
}

template <int MODE>
DEV void attn_branch(bf16* Kl, bf16* Vl, const bf16* kbase, const bf16* vbase, int jlo, int jhi,
                     const bf16x8 (&qf)[2][2], const int (&s)[2], const unsigned* selm, const unsigned* gselm, float C2, int w, int h, int c, int srow, int scol,
                     f32x4 (&O)[2][4], f32x4 (&Ol)[2], ImpState& im) {
    constexpr bool PV = MODE != 1; constexpr int MASK = MODE <= 1 ? 0 : MODE - 1;
    const int krow = krow_lds(srow) * LDT + scol, vrow = bperm(srow) * LDV + scol;
    bf16x8 rk[3], rv[3];
    { const bf16x8 k0 = *(const bf16x8*)(kbase + (size_t)jlo * 4096); *(bf16x8*)(Kl + krow) = k0;
      if (PV) { const bf16x8 v0 = *(const bf16x8*)(vbase + (size_t)jlo * 4096); *(bf16x8*)(Vl + vrow) = v0; } }
#pragma unroll
    for (int u = 0; u < 3; ++u) { int jj = jlo + 1 + u; if (jj > jhi) jj = jhi; rk[(1 + u) % 3] = *(const bf16x8*)(kbase + (size_t)jj * 4096); if (PV) rv[(1 + u) % 3] = *(const bf16x8*)(vbase + (size_t)jj * 4096); }
    SYNC();
    for (int jb = jlo; jb <= jhi; jb += 3) {
#pragma unroll
        for (int u = 0; u < 3; ++u) { const int j = jb + u;
            if (j <= jhi) {
                const int cur = (j - jlo) & 1;
                const bf16* Kc = Kl + cur * 64 * LDT; const bf16* Vc = Vl + cur * 64 * LDV;
                if (MODE == 1) imp_block(Kc, qf, j, im.s0, w, C2, h, c, im);
                else {
                    bool sb[2] = {true, true}; unsigned gm = 3u;
                    if (MODE == 2) { gm = 0u;
#pragma unroll
                        for (int G = 0; G < 2; ++G) { const unsigned wq = uni(gselm[G * 4 + (j >> 5)]), mq = selm[(G * 4 + im.tl) * 4 + (j >> 5)];
                            gm |= ((wq >> (j & 31)) & 1u) << G; sb[G] = (mq >> (j & 31)) & 1u; } }
                    bool full;
                    if (MODE == 0) full = 1024 * j + 1039 <= im.s0; else if (MODE == 2) full = j < im.qblk; else full = (j < im.qblk) && (64 * j > im.s0 + 63 - 512);
                    if (MODE == 2) {
                        if (full) { if (gm == 3u) attn_block<MASK, true, 3>(Kc, Vc, qf, j, s, sb, C2, h, c, O, Ol); else if (gm == 1u) attn_block<MASK, true, 1>(Kc, Vc, qf, j, s, sb, C2, h, c, O, Ol); else if (gm == 2u) attn_block<MASK, true, 2>(Kc, Vc, qf, j, s, sb, C2, h, c, O, Ol); }
                        else { if (gm == 3u) attn_block<MASK, false, 3>(Kc, Vc, qf, j, s, sb, C2, h, c, O, Ol); else if (gm == 1u) attn_block<MASK, false, 1>(Kc, Vc, qf, j, s, sb, C2, h, c, O, Ol); else if (gm == 2u) attn_block<MASK, false, 2>(Kc, Vc, qf, j, s, sb, C2, h, c, O, Ol); }
                    } else { if (full) attn_block<MASK, true, 3>(Kc, Vc, qf, j, s, sb, C2, h, c, O, Ol); else attn_block<MASK, false, 3>(Kc, Vc, qf, j, s, sb, C2, h, c, O, Ol); }
                }
                if (j + 1 <= jhi) {
                    *(bf16x8*)(Kl + (cur ^ 1) * 64 * LDT + krow) = rk[(u + 1) % 3]; if (PV) *(bf16x8*)(Vl + (cur ^ 1) * 64 * LDV + vrow) = rv[(u + 1) % 3];
                    int jj = j + 4; if (jj > jhi) jj = jhi;
                    rk[(u + 1) % 3] = *(const bf16x8*)(kbase + (size_t)jj * 4096); if (PV) rv[(u + 1) % 3] = *(const bf16x8*)(vbase + (size_t)jj * 4096);
                }
                SYNC();
            }
        }
    }
}

DEV void attn_task(const Args& a, unsigned char* smem, int li, int item) {
    unsigned char* ws = wsp(a); const int tid = TID, w = tid >> 6, l = tid & 63, h = l >> 4, c = l & 15, tl = c >> 2, hd = c & 3;
    const int bg = item & 3, b = bg >> 1, g = bg & 1, tq = (SEQ / 64 - 1) - (item >> 2), s0 = tq * 64, qblk = tq;
    int s[2], row[2];
#pragma unroll
    for (int G = 0; G < 2; ++G) { s[G] = s0 + 8 * w + 4 * G + tl; row[G] = b * SEQ + s[G]; }
    bf16* Kl = (bf16*)(smem + AT_K); bf16* Vl = (bf16*)(smem + AT_V); float* imps = (float*)(smem + AT_IMP) + w * 1024; unsigned* selm = (unsigned*)(smem + AT_SEL) + w * 32;
    bf16x8 qf[2][2]; float gatec[2], gates[2], gatew[2];
#pragma unroll
    for (int G = 0; G < 2; ++G) { const bf16* qp = (const bf16*)(ws + WS_QN) + (size_t)row[G] * 512 + (g * 4 + hd) * 64 + 8 * h; qf[G][0] = *(const bf16x8*)qp; qf[G][1] = *(const bf16x8*)(qp + 32);
        const float* gp = (const float*)(ws + WS_GATE) + (size_t)row[G] * 24 + (g * 4 + hd) * 3; gatec[G] = gp[0]; gates[G] = gp[1]; gatew[G] = gp[2]; }
    const float* cs = (const float*)(ws + WS_CS) + li * 4;
    const int srow = tid >> 3, scol = (tid & 7) * 8;
    for (int i = l; i < 1024; i += 64) imps[i] = 0.f;
    SYNC();
    unsigned* gselm = (unsigned*)(smem + AT_GSEL) + w * 8; float* outl = (float*)(smem + AT_OUT) + w * 2048 + l;
    ImpState im{{{0.f, 0.f, 0.f, 0.f}, {0.f, 0.f, 0.f, 0.f}}, {0.f, 0.f}, imps, tl, hd, l, s0, qblk};
    {
        const int ncv = s0 / 16 + 3, ncb0 = (ncv + 63) >> 6, ncb = ncb0 > NCP / 64 ? NCP / 64 : ncb0;
        const bf16* kcb = (const bf16*)(ws + WS_KC) + (size_t)bg * NCP * 64 + tid * 8;
        const bf16* vcb = (const bf16*)(ws + WS_VCT) + (size_t)bg * NCP * 64 + tid * 8;
        f32x4 O[2][4], Ol[2] = {f4zero(), f4zero()};
#pragma unroll
        for (int G = 0; G < 2; ++G)
#pragma unroll
            for (int et = 0; et < 4; ++et) O[G][et] = f4zero();
        attn_branch<0>(Kl, Vl, kcb, vcb, 0, ncb - 1, qf, s, selm, gselm, cs[0], w, h, c, srow, scol, O, Ol, im);
#pragma unroll
        for (int G = 0; G < 2; ++G) { const float lsum = Ol[G][0]; const float invl = lsum > 0.f ? 1.0f / lsum : 0.f;
#pragma unroll
            for (int r = 0; r < 4; ++r) im.invq[G][r] = shfl(invl, 4 * h + r);
#pragma unroll
            for (int et = 0; et < 4; ++et)
#pragma unroll
                for (int r = 0; r < 4; ++r) outl[((G * 4 + et) * 4 + r) * 64] = gatec[G] * invl * O[G][et][r]; }
        f32x4 ld[2] = {f4zero(), f4zero()};
        attn_branch<1>(Kl, Vl, kcb, vcb, 0, ncb - 1, qf, s, selm, gselm, cs[0], w, h, c, srow, scol, O, ld, im);
    }
    WSYNC();
#pragma unroll 1
    for (int G = 0; G < 2; ++G) {
        const int tk = l >> 4, i = l & 15; float vals[8];
#pragma unroll
        for (int mm = 0; mm < 8; ++mm) { const int jj = i + 16 * mm; vals[mm] = jj > qblk ? NEGV : ((jj == 0 || jj == qblk || jj == qblk - 1) ? FORCEV : imps[(G * 4 + tk) * 128 + jj]); }
        unsigned mk[4] = {0u, 0u, 0u, 0u};
#pragma unroll 1
        for (int rnd = 0; rnd < 16; ++rnd) {
            float best = vals[0]; int bj = i;
#pragma unroll
            for (int mm = 1; mm < 8; ++mm) if (vals[mm] > best) { best = vals[mm]; bj = i + 16 * mm; }
#pragma unroll
            for (int o = 1; o < 16; o <<= 1) { const float ov = shflx(best, o); const int oj = shflxi(bj, o); if (ov > best || (ov == best && oj < bj)) { best = ov; bj = oj; } }
            if (best > NEGV * 0.5f) {
#pragma unroll
                for (int q = 0; q < 4; ++q) if ((bj >> 5) == q) mk[q] |= 1u << (bj & 31); }
            if ((bj & 15) == i) {
#pragma unroll
                for (int mm = 0; mm < 8; ++mm) if ((bj >> 4) == mm) vals[mm] = -3e38f; }
        }
        if (i == 0) {
#pragma unroll
            for (int q = 0; q < 4; ++q) selm[(G * 4 + tk) * 4 + q] = mk[q]; }
    }
    WSYNC();
    if (l < 8) { const int G = l >> 2, q = l & 3; gselm[l] = selm[(G * 4 + 0) * 4 + q] | selm[(G * 4 + 1) * 4 + q] | selm[(G * 4 + 2) * 4 + q] | selm[(G * 4 + 3) * 4 + q]; }
    WSYNC();
#pragma unroll
    for (int br = 0; br < 2; ++br) {
        const bf16* kb = (const bf16*)(ws + (br == 0 ? WS_KS : WS_KW)) + (size_t)bg * SEQ * 64 + tid * 8; const bf16* vb = (const bf16*)(ws + (br == 0 ? WS_VST : WS_VWT)) + (size_t)bg * SEQ * 64 + tid * 8;
        f32x4 O[2][4], Ol[2] = {f4zero(), f4zero()};
#pragma unroll
        for (int G = 0; G < 2; ++G)
#pragma unroll
            for (int et = 0; et < 4; ++et) O[G][et] = f4zero();
        if (br == 0) attn_branch<2>(Kl, Vl, kb, vb, 0, qblk, qf, s, selm, gselm, cs[1], w, h, c, srow, scol, O, Ol, im);
        else attn_branch<3>(Kl, Vl, kb, vb, s0 >= 511 ? (s0 - 511) >> 6 : 0, qblk, qf, s, selm, gselm, cs[2], w, h, c, srow, scol, O, Ol, im);
#pragma unroll
        for (int G = 0; G < 2; ++G) { const float lsum = Ol[G][0]; const float sc = (br == 0 ? gates[G] : gatew[G]) * (lsum > 0.f ? 1.0f / lsum : 0.f);
#pragma unroll
            for (int et = 0; et < 4; ++et)
#pragma unroll
                for (int r = 0; r < 4; ++r) outl[((G * 4 + et) * 4 + r) * 64] += sc * O[G][et][r]; }
    }
#pragma unroll
    for (int G = 0; G < 2; ++G) { bf16* dst = (bf16*)(ws + WS_CAT) + (size_t)row[G] * 1024 + (g * 4 + hd) * 64 + 4 * h;
#pragma unroll
        for (int et = 0; et < 4; ++et) { f32x4 o;
#pragma unroll
            for (int r = 0; r < 4; ++r) o[r] = outl[((G * 4 + et) * 4 + r) * 64];
            st_bf4(dst + 16 * et, o); } }
}

constexpr int LDH = 136;
DEV void hg_cumsum(const float* fsrc  , float* segs  , int d, int seg, float (&f)[16], float (&bc)[16], float& bend, float& bmid) {
    float run = 0.f;
#pragma unroll
    for (int i = 0; i < 16; ++i) { f[i] = fsrc[(size_t)(16 * seg + i) * 128 + d]; run += log2f(f[i]); bc[i] = run; }
    SYNC();
    segs[seg * 128 + d] = run;
    SYNC();
    const float s0 = segs[d], s1 = segs[128 + d], s2 = segs[256 + d], s3 = segs[384 + d];
    const float off = seg == 0 ? 0.f : (seg == 1 ? s0 : (seg == 2 ? s0 + s1 : s0 + s1 + s2));
#pragma unroll
    for (int i = 0; i < 16; ++i) bc[i] += off;
    bend = s0 + s1 + s2 + s3; bmid = s0 + s1;
}
DEV void hg_write16(bf16* dstrow  , const float (&v)[16]) {
    u32x4 w0, w1;
#pragma unroll
    for (int q = 0; q < 4; ++q) { w0[q] = pk2(v[2 * q], v[2 * q + 1]); w1[q] = pk2(v[8 + 2 * q], v[8 + 2 * q + 1]); }
    *(u32x4*)dstrow = w0; *(u32x4*)(dstrow + 8) = w1;
}
DEV void hg_h1_task(const Args& a, unsigned char* smem, int task) {
    unsigned char* ws = wsp(a); const int tid = TID, w = tid >> 6, l = tid & 63, h = l >> 4, c = l & 15, d = tid & 127, seg = tid >> 7;
    const int bh = task / NCH, ch = task % NCH;
    bf16* kT = (bf16*)smem; bf16* vT = kT + 128 * LDT; float* segs = (float*)(vT + 128 * LDT);
    const size_t tokb = (size_t)bh * SEQ + ch * 64;
    float f[16], bc[16], bend, bmid;
    const bf16* vs = (const bf16*)(ws + WS_HV) + tokb * 128;
    bf16 vraw[16];
#pragma unroll
    for (int i = 0; i < 16; ++i) vraw[i] = vs[(size_t)(16 * seg + i) * 128 + d];
    hg_cumsum((const float*)(ws + WS_HF) + tokb * 128, segs, d, seg, f, bc, bend, bmid);
    float kv[16];
#pragma unroll
    for (int i = 0; i < 16; ++i) kv[i] = (1.0f - f[i]) * fexp2(bend - bc[i]);
    hg_write16(kT + d * LDT + 16 * seg, kv);
#pragma unroll
    for (int i = 0; i < 16; ++i) kv[i] = bf2f(vraw[i]);
    hg_write16(vT + d * LDT + 16 * seg, kv);
    if (seg == 0) ((float*)(ws + WS_GD))[((size_t)bh * NCH + ch) * 128 + d] = fexp2(bend);
    SYNC();
    f32x4 acc[8];
#pragma unroll
    for (int et = 0; et < 8; ++et) acc[et] = f4zero();
#pragma unroll
    for (int ks = 0; ks < 2; ++ks) { const bf16x8 fa = *(const bf16x8*)(kT + (16 * w + c) * LDT + 32 * ks + 8 * h);
#pragma unroll
        for (int et = 0; et < 8; ++et) acc[et] = mfma16(fa, *(const bf16x8*)(vT + (16 * et + c) * LDT + 32 * ks + 8 * h), acc[et]); }
    float* ut = (float*)(ws + WS_UT) + ((size_t)bh * NCH + ch) * 16384;
#pragma unroll
    for (int et = 0; et < 8; ++et) *(f32x4*)(ut + (size_t)(16 * et + c) * 128 + 16 * w + 4 * h) = acc[et];
    SYNC();
}
DEV void hg_scan_task(const Args& a, int sc) {
    unsigned char* ws = wsp(a); const int bh = sc >> 3, q = (sc & 7) * 512 + TID, e = q >> 5, d0 = (q & 31) * 4;
    const float* ut = (const float*)(ws + WS_UT) + (size_t)bh * NCH * 16384 + (size_t)e * 128 + d0;
    const float* gd = (const float*)(ws + WS_GD) + (size_t)bh * NCH * 128 + d0;
    bf16* st = (bf16*)(ws + WS_ST) + (size_t)bh * NCH * 16384 + (size_t)e * 128 + d0;
    f32x4 S = f4zero();
#pragma unroll 4
    for (int ch = 0; ch < NCH; ++ch) { st_bf4(st + (size_t)ch * 16384, S);
        const f32x4 g = *(const f32x4*)(gd + (size_t)ch * 128), u = *(const f32x4*)(ut + (size_t)ch * 16384);
#pragma unroll
        for (int r = 0; r < 4; ++r) S[r] = g[r] * S[r] + u[r]; }
}
DEV void hg_h3_task(const Args& a, unsigned char* smem, int li, int task) {
    unsigned char* ws = wsp(a); const int tid = TID, w = tid >> 6, l = tid & 63, h = l >> 4, c = l & 15, d = tid & 127, seg = tid >> 7;
    const int bh = task / NCH, ch = task % NCH, b = bh >> 2, hh = bh & 3;
    bf16* At = (bf16*)smem; bf16* Bt = At + 64 * LDH; bf16* Qt = Bt + 64 * LDH; bf16* vT = Qt + 64 * LDH; float* segs = (float*)(vT + 128 * LDT); float* part = segs + 512;
    const size_t tokb = (size_t)bh * SEQ + ch * 64;
    float f[16], bc[16], bend, bmid;
    const bf16* qs = (const bf16*)(ws + WS_HQ) + tokb * 128; const bf16* vs = (const bf16*)(ws + WS_HV) + tokb * 128;
    const int tt = w & 3, eh = w >> 2;
    bf16 qraw[16], vraw[16];
#pragma unroll
    for (int i = 0; i < 16; ++i) { const int t = 16 * seg + i; qraw[i] = qs[(size_t)t * 128 + d]; vraw[i] = vs[(size_t)t * 128 + d]; }
    const bf16* stp = (const bf16*)(ws + WS_ST) + ((size_t)bh * NCH + ch) * 16384;
    bf16x8 stf[4][4];
#pragma unroll
    for (int ks = 0; ks < 4; ++ks)
#pragma unroll
        for (int et = 0; et < 4; ++et) stf[ks][et] = *(const bf16x8*)(stp + (size_t)(64 * eh + 16 * et + c) * 128 + 32 * ks + 8 * h);
    const int tok = b * SEQ + ch * 64 + 16 * tt + c;
    const bf16* hg = (const bf16*)(ws + WS_HGS) + (size_t)tok * 512 + hh * 128;
    u32x2 hgv[4];
#pragma unroll
    for (int et = 0; et < 4; ++et) hgv[et] = *(const u32x2*)(hg + 64 * eh + 16 * et + 4 * h);
    hg_cumsum((const float*)(ws + WS_HF) + tokb * 128, segs, d, seg, f, bc, bend, bmid);
    float vv[16];
#pragma unroll
    for (int i = 0; i < 16; ++i) { const int t = 16 * seg + i; const float q = bf2f(qraw[i]);
        At[t * LDH + d] = (bf16)f2bf(q * fexp2(bc[i] - bmid)); Bt[t * LDH + d] = (bf16)f2bf((1.0f - f[i]) * fexp2(bmid - bc[i])); Qt[t * LDH + d] = (bf16)f2bf(q * fexp2(bc[i]));
        vv[i] = bf2f(vraw[i]); }
    hg_write16(vT + d * LDT + 16 * seg, vv);
    SYNC();
    f32x4 O[4];
#pragma unroll
    for (int et = 0; et < 4; ++et) O[et] = f4zero();
#pragma unroll
    for (int sp = 0; sp < 2; ++sp) {
        if (32 * sp > 16 * tt + 15) continue;
        f32x4 st[2];
#pragma unroll
        for (int u = 0; u < 2; ++u) { st[u] = f4zero(); const int krow = 32 * sp + 8 * (c >> 2) + 4 * u + (c & 3);
#pragma unroll
            for (int ks = 0; ks < 4; ++ks) st[u] = mfma16(*(const bf16x8*)(Bt + krow * LDH + 32 * ks + 8 * h), *(const bf16x8*)(At + (16 * tt + c) * LDH + 32 * ks + 8 * h), st[u]);
#pragma unroll
            for (int r = 0; r < 4; ++r) { const int sk = 32 * sp + 8 * h + 4 * u + r; if (sk > 16 * tt + c) st[u][r] = 0.f; } }
        const bf16x8 pb = pack8(st[0], st[1]);
#pragma unroll
        for (int et = 0; et < 4; ++et) O[et] = mfma16(*(const bf16x8*)(vT + (64 * eh + 16 * et + c) * LDT + 32 * sp + 8 * h), pb, O[et]);
    }
#pragma unroll
    for (int ks = 0; ks < 4; ++ks) { const bf16x8 fq = *(const bf16x8*)(Qt + (16 * tt + c) * LDH + 32 * ks + 8 * h);
#pragma unroll
        for (int et = 0; et < 4; ++et) O[et] = mfma16(stf[ks][et], fq, O[et]); }
    float ss = 0.f;
#pragma unroll
    for (int et = 0; et < 4; ++et)
#pragma unroll
        for (int r = 0; r < 4; ++r) ss += O[et][r] * O[et][r];
    ss += shflx(ss, 16); ss += shflx(ss, 32);
    if (h == 0) part[eh * 64 + 16 * tt + c] = ss;
    SYNC();
    const float rs = frsq((part[16 * tt + c] + part[64 + 16 * tt + c]) * (1.0f / 128.0f) + EPS);
    const float* og = INP(a, I_OG) + li * 128;
    bf16* dst = (bf16*)(ws + WS_CAT) + (size_t)tok * 1024 + 512 + hh * 128;
#pragma unroll
    for (int et = 0; et < 4; ++et) { const int e = 64 * eh + 16 * et + 4 * h; f32x4 o; const f32x4 ogv = *(const f32x4*)(og + e);
        o[0] = O[et][0] * rs * ogv[0] * bf2f(hgv[et][0] & 0xffff); o[1] = O[et][1] * rs * ogv[1] * bf2f(hgv[et][0] >> 16);
        o[2] = O[et][2] * rs * ogv[2] * bf2f(hgv[et][1] & 0xffff); o[3] = O[et][3] * rs * ogv[3] * bf2f(hgv[et][1] >> 16);
        st_bf4(dst + e, o); }
    SYNC();
}

constexpr int CTS = 16;
DEV void conv_task(const Args& a, unsigned char* smem, int li, int task) {
    unsigned char* ws = wsp(a); const int tid = TID, w = tid >> 6, lane = tid & 63;
    const bool act = tid < DM / 2; const int c0 = act ? 2 * tid : 0;
    const int tb = task * 64, b = tb / SEQ, sb = tb % SEQ;
    float* red = (float*)smem;
    const float b0 = INP(a, I_DWB)[li * DM + c0], b1 = INP(a, I_DWB)[li * DM + c0 + 1];
    const float g0 = INP(a, I_LNG)[li * DM + c0], g1 = INP(a, I_LNG)[li * DM + c0 + 1], e0 = INP(a, I_LNB)[li * DM + c0], e1 = INP(a, I_LNB)[li * DM + c0 + 1];
    const bf16* glu = (const bf16*)(ws + WS_GLU) + (size_t)b * SEQ * DM + c0;
    float* lw = (float*)(smem + 4096);
    f32x2v uf[30 + CTS]; unsigned nx[CTS];
    unsigned hq[30];
    { const bf16* gp = glu + (size_t)(sb - 30) * DM;
#pragma unroll
      for (int r = 0; r < 30; ++r) { const int si = sb + r - 30; hq[r] = si >= 0 ? *(const unsigned*)gp : 0u; gp += DM; OPAQUE(gp); } }
    SYNC();
    for (int i = tid * 4; i < 31 * DM; i += NT * 4) *(f32x4*)(lw + i) = *(const f32x4*)(INP(a, I_DW) + (size_t)li * 31 * DM + i);
    SYNC();
    { const bf16* gp = glu + (size_t)sb * DM;
#pragma unroll
      for (int r = 0; r < 30; ++r) { uf[r][0] = bf2f(hq[r] & 0xffff); uf[r][1] = bf2f(hq[r] >> 16); }
#pragma unroll
      for (int r = 0; r < CTS; ++r) { nx[r] = *(const unsigned*)gp; gp += DM; OPAQUE(gp); } }
#pragma unroll 1
    for (int step = 0; step < 64 / CTS; ++step) {
        const int s0 = sb + CTS * step, t0 = tb + CTS * step;
#pragma unroll
        for (int r = 0; r < CTS; ++r) { uf[30 + r][0] = bf2f(nx[r] & 0xffff); uf[30 + r][1] = bf2f(nx[r] >> 16); }
        float acc[CTS][2];
        { f32x2v ac2[CTS];
#pragma unroll
          for (int t = 0; t < CTS; ++t) { ac2[t][0] = b0; ac2[t][1] = b1; }
#pragma unroll
          for (int j = 0; j < 31; ++j) { const f32x2v w2 = *(const f32x2v*)(lw + j * DM + c0);
#ifndef EMU
              if ((j & 3) == 3) asm volatile("" ::: "memory");
#endif
#pragma unroll
              for (int t = 0; t < CTS; ++t) ac2[t] += w2 * uf[t + j]; }
#pragma unroll
          for (int t = 0; t < CTS; ++t) { acc[t][0] = ac2[t][0]; acc[t][1] = ac2[t][1]; } }
#pragma unroll
        for (int r = 0; r < 30; ++r) uf[r] = uf[r + CTS];
        if (step < 64 / CTS - 1) { const bf16* gp = glu + (size_t)(s0 + CTS) * DM;
#pragma unroll
            for (int r = 0; r < CTS; ++r) { nx[r] = *(const unsigned*)gp; gp += DM; OPAQUE(gp); } }
        { float* rb2 = red + (step & 1) * (8 * CTS * 2);
#pragma unroll
          for (int t = 0; t < CTS; ++t) { float s1 = act ? acc[t][0] + acc[t][1] : 0.f, s2 = act ? acc[t][0] * acc[t][0] + acc[t][1] * acc[t][1] : 0.f;
              s1 = wave_sum63(s1); s2 = wave_sum63(s2);
              if (lane == 63) { rb2[(w * CTS + t) * 2] = s1; rb2[(w * CTS + t) * 2 + 1] = s2; } }
          SYNC();
          if (act) {
              bf16* dst = (bf16*)(ws + WS_CAT) + (size_t)t0 * DM + c0;
#pragma unroll
              for (int t = 0; t < CTS; ++t) { float s1 = 0.f, s2 = 0.f;
#pragma unroll
                  for (int q = 0; q < 8; ++q) { s1 += rb2[(q * CTS + t) * 2]; s2 += rb2[(q * CTS + t) * 2 + 1]; }
                  const float mean = s1 * (1.0f / DM), var = fmaxf(s2 * (1.0f / DM) - mean * mean, 0.f), rstd = frsq(var + EPS);
                  const float y0 = (acc[t][0] - mean) * rstd * g0 + e0, y1 = (acc[t][1] - mean) * rstd * g1 + e1;
                  *(unsigned*)(dst + (size_t)t * DM) = pk2(siluf(y0), siluf(y1)); }
          } }
    }
}

constexpr int N_PHASES = 1 + 16 * (DEPTH / 2) + 1;
DEV void phase_decode(int ph, int& l, int& sub) {
    const int q = ph - 1, pair = q >> 4, r = q & 15;
    if (r < 9) { l = 2 * pair; sub = r; } else { l = 2 * pair + 1; const int rr = r - 9; sub = rr < 3 ? rr : rr + 2; }
}

DEV void run_phase(const Args& a, unsigned char* smem, int ph) {
#ifndef ONLY
#define ONLY -1
#endif
#define EN(k) (ONLY < 0 || ONLY == (k))
    if (ph == 0) { if (EN(100)) p0_phase(a, smem); return; }
    if (ph == N_PHASES - 1) { if (EN(0)) norm_phase(a, smem, DEPTH); return; }
    int l, sub; phase_decode(ph, l, sub); const int li = l >> 1; const bool even = (l & 1) == 0;
    unsigned char* ws = wsp(a);
    switch (sub) {
    case 0: if (EN(0)) norm_phase(a, smem, l); break;
    case 1: if (even) { if (EN(1)) inproj_phase(a, smem, li); } else { if (EN(11)) pw1_phase(a, smem, li); } break;
    case 2:
        if (even) { constexpr int NCI = 8 * ((NCP + 255) / 256); constexpr int NH1 = 8 * NCH;
#ifndef EMU
            if (NBLK > 2 * NCI * CMP_SPLIT) { const int bid = BID, NCS = NCI * CMP_SPLIT;
                if (bid < NCS) cmp_split_item(a, smem, li, bid, (ctr_ptr)((unsigned*)(ws + WS_BAR) + P0_CTR_IDX + 8 + 16 * li));
                else { for (int it = bid - NCS; it < NH1; it += NBLK - NCS) hg_h1_task(a, smem, it);
                    moe_conv_pull(a, smem, MOE_TAIL_Q); } }
#else
            if (NBLK > 2 * NCI) { const int bid = BID;
                if (bid < NCI) { if (EN(2)) cmp_phase_items(a, smem, li, bid); }
                else { for (int it = bid - NCI; it < NH1; it += NBLK - NCI) if (EN(12)) hg_h1_task(a, smem, it); } }
#endif
            else for (int it = BID; it < NCI + NH1; it += NBLK) { if (it < NCI) { if (EN(2)) cmp_phase_items(a, smem, li, it); } else { if (EN(12)) hg_h1_task(a, smem, it - NCI); } } }
        else { for (int it = BID; it < T / 64; it += NBLK) if (EN(13)) conv_task(a, smem, li, it); }
        break;
#ifdef EMU
    case 3:
        if (even) { constexpr int NA = 4 * (SEQ / 64); const int G = NBLK;
            for (int r = 0; r * G < NA; ++r) { const int it = r * G + ((r & 1) ? (G - 1 - BID) : BID); if (it < NA) { if (EN(3)) attn_task(a, smem, li, it); } }
            for (int it = BID; it < 64; it += NBLK) if (EN(14)) hg_scan_task(a, it); }
        break;
    case 4: if (even) { for (int it = BID; it < 8 * NCH; it += NBLK) if (EN(4)) hg_h3_task(a, smem, li, it); } break;
#else
    case 3:
        if (even) { constexpr int NA = 4 * (SEQ / 64); const int G = NBLK;
            typedef __attribute__((address_space(1))) unsigned gu32;
            gu32* cw = (gu32*)((unsigned*)(ws + WS_BAR) + P0_CTR_IDX + 1 + 2 * li);
            int nsc = 0;
            for (int it = BID; it < 64; it += NBLK) { hg_scan_task(a, it); ++nsc; }
            if (nsc > 0) { __builtin_amdgcn_fence(__ATOMIC_RELEASE, "agent"); asm volatile("s_waitcnt vmcnt(0)" ::: "memory"); SYNC(); if (TID == 0) (void)__hip_atomic_fetch_add(cw, (unsigned)nsc, __ATOMIC_RELAXED, __HIP_MEMORY_SCOPE_AGENT); }
            for (int r = 0; r * G < NA; ++r) { const int it = r * G + ((r & 1) ? (G - 1 - BID) : BID); if (it < NA) attn_task(a, smem, li, it); }
            if ((TID >> 6) == 0) { unsigned sp = 0u; gu32* tmo = (gu32*)((unsigned*)(ws + WS_BAR) + MOE_TMO_IDX);
                while ((unsigned)__builtin_amdgcn_readfirstlane((int)__hip_atomic_load(cw, __ATOMIC_RELAXED, __HIP_MEMORY_SCOPE_AGENT)) < 64u) {
                    __builtin_amdgcn_s_sleep(1);
                    if ((++sp & 255u) == 0u) { if (__hip_atomic_load(tmo, __ATOMIC_RELAXED, __HIP_MEMORY_SCOPE_AGENT)) break; if (sp > (1u << 22)) { (void)__hip_atomic_fetch_add(tmo, 1u, __ATOMIC_RELAXED, __HIP_MEMORY_SCOPE_AGENT); break; } } }
                __builtin_amdgcn_fence(__ATOMIC_ACQUIRE, "agent"); }
            int* nxl = (int*)(smem + LDS_BYTES - 64);
            int my_next = 0; if (TID == 0) my_next = (int)__hip_atomic_fetch_add(cw + 1, 1u, __ATOMIC_RELAXED, __HIP_MEMORY_SCOPE_AGENT);
            for (;;) { SYNC(); if (TID == 0) nxl[0] = my_next; SYNC(); const int it = nxl[0]; if (it >= 8 * NCH) break;
                if (TID == 0) my_next = (int)__hip_atomic_fetch_add(cw + 1, 1u, __ATOMIC_RELAXED, __HIP_MEMORY_SCOPE_AGENT);
                hg_h3_task(a, smem, li, it); } }
        break;
    case 4: break;
#endif
    case 5:
        if (!EN(5)) break;
        if (even) resid_gemm_phase(a, smem, (const bf16*)(ws + WS_CAT), 1024, (const bf16*)(ws + WS_WOUT) + (size_t)li * DM * 1024, l);
        else resid_gemm_phase(a, smem, (const bf16*)(ws + WS_CAT), DM, (const bf16*)(ws + WS_PW2) + (size_t)li * DM * DM, l);
        break;
    case 6:
#ifndef EMU
        if (l >= 1) moe_conv_drain(a, smem, (l + 1) * 32 * MOE_SPE);
#endif
        if (EN(6)) route_phase(a, smem, l); break;
#ifdef EMU
    case 7: if (EN(7)) moe_gemm_phase8(a, smem, l, 0); break;
    case 8: if (EN(8)) moe_gemm_phase8(a, smem, l, 1); break;
#else
    case 7: if (EN(7)) moe_fused_phase(a, smem, l); break;
    case 8: break;
#endif
    }
}

#ifndef EMU
#define LAS __attribute__((address_space(3)))
#define XB_TMO      128
static_assert(MOE_N0 >= 2 * 32 * MOE_SPE && XB_TMO == MOE_TMO_IDX && P0_CTR_IDX > XB_TMO && P0_CTR_IDX + 8 + 16 * (DEPTH / 2) <= 256 && 8 * ((NCP + 255) / 256) == 16, "timeout word / free words");
#define XB_XCNT(j)  (256  + 64 * (j))
#define XB_XSUB(j)  (1280 + 64 * (j))
#define XB_XGEN(j)  (2304 + 64 * (j))
#define XB_TOP      3328
#define XB_TOPGEN   3392
#define XCD_BAR_WORDS 3456
#define XB_SPIN_CAP (1u << 22)
__device__ __forceinline__ unsigned xb_ld(unsigned* p)              { return __hip_atomic_load(p, __ATOMIC_RELAXED, __HIP_MEMORY_SCOPE_AGENT); }
__device__ __forceinline__ unsigned xb_add(unsigned* p, unsigned v) { return __hip_atomic_fetch_add(p, v, __ATOMIC_RELAXED, __HIP_MEMORY_SCOPE_AGENT); }
__device__ __forceinline__ unsigned xb_xcc_id() { return (unsigned)__builtin_amdgcn_s_getreg((3 << 11) | 20) & 0xFu; }
#define XB_SPIN(cond, bar) do { unsigned _sp = 0; while (cond) { __builtin_amdgcn_s_sleep(1); \
    if ((++_sp & 255u) == 0u) { if (xb_ld(&(bar)[XB_TMO])) break; if (_sp > XB_SPIN_CAP) { atomicAdd(&(bar)[XB_TMO], 1u); break; } } } } while (0)
struct XcdBarrier { unsigned* bar; unsigned x; volatile LAS unsigned* st; };
__device__ __forceinline__ XcdBarrier xcd_barrier_post(unsigned* bar, volatile LAS unsigned* st) {
    XcdBarrier b; b.bar = bar; b.x = xb_xcc_id(); b.st = st;
    if (threadIdx.x == 0) (void)xb_add(&bar[XB_XCNT(b.x)], 1u);
    return b;
}
__device__ __forceinline__ void xcd_barrier_complete(unsigned* bar, unsigned x, unsigned& nloc, unsigned& nx) {
    const unsigned G = gridDim.x * gridDim.y * gridDim.z;
    unsigned sum, cnt, mine, sp = 0u;
    for (;;) {
        sum = 0u; cnt = 0u; mine = 0u;
#pragma unroll
        for (unsigned j = 0; j < 16; ++j) { const unsigned c = xb_ld(&bar[XB_XCNT(j)]); sum += c; cnt += (c > 0u) ? 1u : 0u; mine = (j == x) ? c : mine; }
        if (sum == G) break;
        __builtin_amdgcn_s_sleep(1);
        if ((++sp & 255u) == 0u) { if (xb_ld(&bar[XB_TMO])) break; if (sp > XB_SPIN_CAP) { atomicAdd(&bar[XB_TMO], 1u); break; } }
    }
    nloc = mine > 0u ? mine : 1u; nx = cnt > 0u ? cnt : 1u;
}
__device__ __forceinline__ void xcd_barrier(const XcdBarrier& b) {
    asm volatile("s_waitcnt vmcnt(0)" ::: "memory");
    __syncthreads();
    if (threadIdx.x == 0) {
        unsigned* bar = b.bar;
        __builtin_amdgcn_s_waitcnt(0);
        unsigned nloc = b.st[0], nx = b.st[1];
        if (nloc == 0u) { xcd_barrier_complete(bar, b.x, nloc, nx); b.st[0] = nloc; b.st[1] = nx; }
        const unsigned old = xb_add(&bar[XB_XSUB(b.x)], 1u);
        const unsigned gen = old / nloc;
        if (old + 1u == (gen + 1u) * nloc) {
            __builtin_amdgcn_fence(__ATOMIC_RELEASE, "agent");
            asm volatile("s_waitcnt vmcnt(0)" ::: "memory");
            const unsigned og = xb_add(&bar[XB_TOP], 1u);
            const unsigned tg = og / nx;
            if (og + 1u == (tg + 1u) * nx) xb_add(&bar[XB_TOPGEN], 1u);
            else XB_SPIN(xb_ld(&bar[XB_TOPGEN]) == tg, bar);
            __builtin_amdgcn_fence(__ATOMIC_ACQUIRE, "agent");
            xb_add(&bar[XB_XGEN(b.x)], 1u);
            asm volatile("s_waitcnt vmcnt(0)" ::: "memory");
        } else {
            XB_SPIN(xb_ld(&bar[XB_XGEN(b.x)]) == gen, bar);
            __builtin_amdgcn_fence(__ATOMIC_ACQUIRE, "agent");
            asm volatile("s_waitcnt vmcnt(0)" ::: "memory");
        }
    }
    __syncthreads();
}

__global__ void __launch_bounds__(NT, 2) mega(Args a) {
    extern __shared__ __attribute__((aligned(16))) unsigned char lds[];
    volatile LAS unsigned* st = (volatile LAS unsigned*)(LAS unsigned char*)(lds + LDS_BYTES - 16);
    if (threadIdx.x < 4) st[threadIdx.x] = 0u;
    __syncthreads();
    unsigned* barw = (unsigned*)(a.ws + WS_BAR);
    XcdBarrier bar = xcd_barrier_post(barw, st);
#pragma unroll 1
    for (int ph = 0; ph < N_PHASES; ++ph) {
        if (ph > 0 && ph < N_PHASES - 1) { int l_, s_; phase_decode(ph, l_, s_); if (s_ == 8 || (s_ == 4 && (l_ & 1) == 0)) continue; }
        run_phase(a, lds, ph);
#ifdef DUP
        { int lyr = 0, sub = 100; if (ph > 0 && ph < N_PHASES - 1) phase_decode(ph, lyr, sub);
          if (sub == (DUP % 1000) && (ph == 0 || lyr == DUP / 1000) && ph < N_PHASES - 1) { xcd_barrier(bar); run_phase(a, lds, ph); } }
#endif
        if (ph + 1 < N_PHASES) xcd_barrier(bar);
    }
    if (xb_ld(&barw[XB_TMO]) != 0u) {
        const size_t gt = (size_t)blockIdx.x * NT + threadIdx.x, gs = (size_t)gridDim.x * NT;
        for (size_t i = gt; i < (size_t)T * DM; i += gs) a.out[i] = __builtin_nanf("");
    }
}

extern "C" void kernel_launch(void* const* d_in, const int* in_sizes, int n_in, void* d_out, int out_size,
                              void* d_ws, size_t ws_size, hipStream_t stream) {
    static int grid = 0;
    if (grid == 0) {
        int dev = 0, cus = 0;
        if (hipGetDevice(&dev) != hipSuccess || hipDeviceGetAttribute(&cus, hipDeviceAttributeMultiprocessorCount, dev) != hipSuccess) { grid = -1; return; }
        if (hipFuncSetAttribute((const void*)mega, hipFuncAttributeMaxDynamicSharedMemorySize, LDS_BYTES) != hipSuccess) { grid = -1; return; }
        (void)hipGetLastError();
        grid = cus;
        if (n_in != 26 || out_size != T * DM || ws_size < WS_END) { fprintf(stderr, "kernel_launch: unexpected sizes n_in %d out %d ws %zu (need %zu)\n", n_in, out_size, ws_size, (size_t)WS_END); grid = -1; return; }
    }
    if (grid < 0) return;
    (void)hipMemsetAsync((unsigned char*)d_ws + WS_BAR, 0, XCD_BAR_WORDS * 4, stream);
    Args a{};
    for (int i = 0; i < 26; ++i) a.in[i] = (const float*)d_in[i];
    a.out = (float*)d_out; a.ws = (unsigned char*)d_ws;
    hipLaunchKernelGGL(mega, dim3(grid), dim3(NT), LDS_BYTES, stream, a);
}
#endif
```

```cpp
#ifdef EMU
#include "emu.h"
#define DEV static inline
#define MDEV inline
#define OPAQUE(p)
#define OPAQUE2(a, b)
#define TID emu_tid()
#define BID (EB->bid)
#define NBLK (EB->nblk)
#define SYNC() emu_sync_block()
#define WSYNC() emu_sync_wave()
#define mfma16(a, b, c) emu_mfma16(a, b, c)
DEV float shflx(float v, int m) { return emu_shfl_f(v, (emu_tid() & 63) ^ m); }
DEV int shflxi(int v, int m) { return (int)emu_shfl_u((unsigned)v, (emu_tid() & 63) ^ m); }
DEV float shfl(float v, int s) { return emu_shfl_f(v, s); }
DEV float dpp_ror1(float v) { const int l = emu_tid() & 63; return emu_shfl_f(v, (l & 48) | ((l - 1) & 15)); }
DEV float wave_sum63(float v) { for (int o = 1; o < 64; o <<= 1) v += shflx(v, o); return v; }
DEV int atomic_add_i(int* p, int v) { return __atomic_fetch_add(p, v, __ATOMIC_RELAXED); }
typedef float f32x2v __attribute__((vector_size(8)));
DEV float fexp2(float x) { return exp2f(x); }
DEV float frcp(float x) { return 1.0f / x; }
DEV float frsq(float x) { return 1.0f / sqrtf(x); }
typedef short s16x4 __attribute__((vector_size(8)));
static inline s16x4 emu_tr4(const unsigned short* p) {
    EmuWave& w = EB->wave[emu_tid() >> 6]; int l = emu_tid() & 63;
    const unsigned short** tab = (const unsigned short**)w.a;
    tab[l] = p; emu_sync_wave();
    s16x4 r; int g = l & 48, i = l & 15;
    for (int q = 0; q < 4; ++q) r[q] = (short)tab[g + 4 * q + (i >> 2)][i & 3];
    emu_sync_wave(); return r;
}
#define tr4(p) emu_tr4(p)
#else
#include <hip/hip_runtime.h>
#include <cstdio>
#include <cstdint>
typedef short bf16x8 __attribute__((ext_vector_type(8)));
typedef float f32x4 __attribute__((ext_vector_type(4)));
typedef unsigned u32x4 __attribute__((ext_vector_type(4)));
typedef unsigned u32x2 __attribute__((ext_vector_type(2)));
#define DEV __device__ __forceinline__
#define MDEV __device__ __forceinline__
#define OPAQUE(p) asm volatile("" : "+v"(p))
#define OPAQUE2(a, b) asm volatile("" : "+v"(a), "+v"(b))
DEV int tid_opaque() { int t = (int)threadIdx.x; asm volatile("" : "+v"(t)); return t; }
#define TID tid_opaque()
DEV int bid_opaque() { int b = (int)blockIdx.x; asm volatile("" : "+s"(b)); return b; }
#define BID bid_opaque()
#define NBLK ((int)gridDim.x)
#define SYNC() __syncthreads()
#define WSYNC() __builtin_amdgcn_wave_barrier()
#define mfma16(a, b, c) __builtin_amdgcn_mfma_f32_16x16x32_bf16(a, b, c, 0, 0, 0)
DEV int shflxi(int x, int m) {
    if (m == 1) return __builtin_amdgcn_update_dpp(x, x, 0xB1, 0xf, 0xf, true);
    if (m == 2) return __builtin_amdgcn_update_dpp(x, x, 0x4E, 0xf, 0xf, true);
    if (m == 4) return __builtin_amdgcn_ds_swizzle(x, (4 << 10) | 0x1F);
    if (m == 8) return __builtin_amdgcn_ds_swizzle(x, (8 << 10) | 0x1F);
    if (m == 16) return __builtin_amdgcn_ds_swizzle(x, (16 << 10) | 0x1F);
    if (m == 32) { const auto r = __builtin_amdgcn_permlane32_swap((unsigned)x, (unsigned)x, false, false); return (int)((threadIdx.x & 32) ? r[0] : r[1]); }
    return __shfl_xor(x, m);
}
DEV float shflx(float v, int m) { return __builtin_bit_cast(float, shflxi(__builtin_bit_cast(int, v), m)); }
DEV float dpp_ror1(float v) { return __builtin_bit_cast(float, __builtin_amdgcn_update_dpp(0, __builtin_bit_cast(int, v), 0x121, 0xf, 0xf, false)); }
DEV float wave_sum63(float v) {
#define WS_DPP(ctrl, rm) __builtin_bit_cast(float, __builtin_amdgcn_update_dpp(0, __builtin_bit_cast(int, v), ctrl, rm, 0xf, false))
    v += WS_DPP(0xB1, 0xf); v += WS_DPP(0x4E, 0xf); v += WS_DPP(0x141, 0xf); v += WS_DPP(0x140, 0xf); v += WS_DPP(0x142, 0xa); v += WS_DPP(0x143, 0xc);
#undef WS_DPP
    return v;
}
DEV float shfl(float v, int s) { return __shfl(v, s); }
DEV int atomic_add_i(int* p, int v) { return atomicAdd(p, v); }
DEV float fexp2(float x) { return __builtin_amdgcn_exp2f(x); }
DEV float frcp(float x) { return __builtin_amdgcn_rcpf(x); }
DEV float frsq(float x) { return __builtin_amdgcn_rsqf(x); }
typedef short s16x4 __attribute__((ext_vector_type(4)));
#define tr4(p) __builtin_amdgcn_ds_read_tr16_b64_v4i16((__attribute__((address_space(3))) s16x4*)(p))
#endif

typedef unsigned short bf16;

#ifndef DM
#define DM 1024
#endif
#ifndef SEQ
#define SEQ 8192
#endif
#ifndef FF
#define FF 512
#endif
constexpr int NBATCH = 2, T = NBATCH * SEQ, DEPTH = 4;
constexpr int NIN = 3352, NINP = 3456, NIN8 = 3584;
constexpr int NT = 512;
constexpr int NCH = SEQ / 64;
constexpr int NCP = SEQ / 16;
constexpr int NCMP = NCP - 1;
constexpr int MOE_ROWS = 2 * T + 32 * 256;
constexpr float EPS = 1e-6f, NEGV = -1e30f, FORCEV = 1e4f, LOG2E = 1.4426950408889634f;

constexpr size_t al(size_t x) { return (x + 255) & ~(size_t)255; }
constexpr int P0_CTR_IDX = 192;
constexpr size_t WS_BAR = 0;
constexpr size_t WS_CNT = 16384;
constexpr size_t WS_MOD = WS_CNT + (size_t)DEPTH * 32 * 256;
constexpr size_t WS_LB = al(WS_MOD + (size_t)DEPTH * 2 * 6 * DM * 4);
constexpr size_t WS_CB = al(WS_LB + 2 * 512 * 4);
constexpr size_t WS_CS = al(WS_CB + 2 * 2 * 8 * 64 * 4);
constexpr size_t WS_WIN = al(WS_CS + 64);
constexpr size_t WS_WOUT = al(WS_WIN + (size_t)2 * NIN8 * DM * 2);
constexpr size_t WS_PW1 = al(WS_WOUT + (size_t)2 * DM * 1024 * 2);
constexpr size_t WS_PW2 = al(WS_PW1 + (size_t)2 * 2 * DM * DM * 2);
constexpr size_t WS_WC = al(WS_PW2 + (size_t)2 * DM * DM * 2);
constexpr size_t WS_W13 = al(WS_WC + (size_t)2 * 2 * 64 * 2048 * 2);
constexpr size_t WS_W2 = al(WS_W13 + (size_t)DEPTH * 32 * 2 * FF * DM * 2);
constexpr size_t WS_H = al(WS_W2 + (size_t)DEPTH * 32 * DM * FF * 2);
constexpr size_t WS_QN = al(WS_H + (size_t)T * DM * 2);
constexpr size_t WS_KCG = al(WS_QN + (size_t)T * 512 * 2);
constexpr size_t WS_VCG = al(WS_KCG + (size_t)T * 128 * 2);
constexpr size_t WS_KS = al(WS_VCG + (size_t)T * 128 * 2);
constexpr size_t WS_KW = al(WS_KS + (size_t)T * 128 * 2);
constexpr size_t WS_VST = al(WS_KW + (size_t)T * 128 * 2);
constexpr size_t WS_VWT = al(WS_VST + (size_t)T * 128 * 2);
constexpr size_t WS_KC = al(WS_VWT + (size_t)T * 128 * 2);
constexpr size_t WS_VCT = al(WS_KC + (size_t)4 * NCP * 64 * 2);
constexpr size_t WS_GATE = al(WS_VCT + (size_t)4 * NCP * 64 * 2);
constexpr size_t WS_HQ = al(WS_GATE + (size_t)T * 24 * 4);
constexpr size_t WS_HF = al(WS_HQ + (size_t)T * 512 * 2);
constexpr size_t WS_HV = al(WS_HF + (size_t)T * 512 * 4);
constexpr size_t WS_HGS = al(WS_HV + (size_t)T * 512 * 2);
constexpr size_t WS_UT = al(WS_HGS + (size_t)T * 512 * 2);
constexpr size_t WS_ST = al(WS_UT + (size_t)8 * NCH * 128 * 128 * 4);
constexpr size_t WS_GD = al(WS_ST + (size_t)8 * NCH * 128 * 128 * 2);
constexpr size_t WS_CAT = al(WS_GD + (size_t)8 * NCH * 128 * 4);
constexpr size_t WS_GLU = al(WS_CAT + (size_t)T * 1024 * 2);
constexpr size_t WS_TIE = al(WS_GLU + (size_t)T * DM * 2);
constexpr size_t WS_TIW = al(WS_TIE + (size_t)T * 2 * 4);
constexpr size_t WS_LIST = al(WS_TIW + (size_t)T * 2 * 4);
constexpr size_t WS_ACT = al(WS_LIST + (size_t)32 * T * 4);
constexpr size_t WS_YK = al(WS_ACT + (size_t)MOE_ROWS * FF * 2);
constexpr size_t WS_WTH = al(WS_YK + (size_t)MOE_ROWS * DM * 2);
constexpr size_t WS_WTL = al(WS_WTH + (size_t)DEPTH * 48 * DM * 2);
constexpr size_t WS_AVEC = al(WS_WTL + (size_t)DEPTH * 48 * DM * 2);
constexpr size_t WS_RBIAS = al(WS_AVEC + (size_t)DEPTH * 2 * DM * 4);
constexpr size_t WS_FLG = al(WS_RBIAS + (size_t)DEPTH * 2 * 48 * 4);
constexpr int LDS_BYTES = 150 * 1024;
constexpr int CMP_SPLIT = 2;
constexpr size_t WS_CMPP = al(WS_FLG + (size_t)DEPTH * 256 * 64);
constexpr size_t WS_END = al(WS_CMPP + (size_t)8 * ((NCP + 255) / 256) * CMP_SPLIT * 16 * 256 * 16);

struct Args { const float* in[26]; float* out; unsigned char* ws; };
enum { I_X = 0, I_C, I_ADAW, I_ADAB, I_NMIX, I_NFFN, I_WIN, I_WOUT, I_CWK, I_CWV, I_CPE, I_QG, I_KG, I_LBL, I_OG,
       I_PW1, I_DW, I_DWB, I_LNG, I_LNB, I_PW2, I_WG, I_WE, I_W1, I_W3, I_W2 };

#ifdef EMU
DEV unsigned char* wsp(const Args& a) { return a.ws; }
DEV float* outp(const Args& a) { return a.out; }
#else
DEV unsigned char* launder_ptr(const void* p) { unsigned long long v = (unsigned long long)p; unsigned lo = (unsigned)v, hi = (unsigned)(v >> 32);
    lo = (unsigned)__builtin_amdgcn_readfirstlane((int)lo); hi = (unsigned)__builtin_amdgcn_readfirstlane((int)hi); asm volatile("" : "+s"(lo), "+s"(hi)); typedef __attribute__((address_space(1))) unsigned char* gptr_t; return (unsigned char*)(gptr_t)(((unsigned long long)hi << 32) | lo); }
DEV unsigned char* wsp(const Args& a) { return launder_ptr(a.ws); }
DEV float* outp(const Args& a) { return (float*)launder_ptr(a.out); }
#endif

#ifdef EMU
#define INP(a, X) ((a).in[X])
#else
DEV int zero_opaque() { int z = 0; asm volatile("" : "+s"(z)); return z; }
#define INP(a, X) ((a).in[(X) + zero_opaque()])
#endif

DEV unsigned f2bf(float f) { unsigned u = __builtin_bit_cast(unsigned, f); return (u + 0x7fffu + ((u >> 16) & 1u)) >> 16; }
DEV float bf2f(unsigned h) { return __builtin_bit_cast(float, h << 16); }
#ifdef EMU
DEV unsigned pk2(float lo, float hi) { return f2bf(lo) | (f2bf(hi) << 16); }
#else
typedef float f32x2_t __attribute__((ext_vector_type(2)));
typedef float f32x2v __attribute__((ext_vector_type(2)));
typedef __bf16 bf16x2_t __attribute__((ext_vector_type(2)));
DEV unsigned pk2(float lo, float hi) { f32x2_t v = {lo, hi}; bf16x2_t b = __builtin_convertvector(v, bf16x2_t); return __builtin_bit_cast(unsigned, b); }
#endif
DEV float sigm(float x) { return frcp(1.0f + fexp2(-x * LOG2E)); }
DEV float siluf(float x) { return x * sigm(x); }
DEV f32x4 f4zero() { f32x4 z = {0.f, 0.f, 0.f, 0.f}; return z; }
DEV bf16x8 pack8(f32x4 a, f32x4 b) {
    u32x4 w; w[0] = pk2(a[0], a[1]); w[1] = pk2(a[2], a[3]); w[2] = pk2(b[0], b[1]); w[3] = pk2(b[2], b[3]);
    return __builtin_bit_cast(bf16x8, w);
}
DEV void st_bf8(bf16* p, f32x4 a, f32x4 b) { u32x4 w; w[0] = pk2(a[0], a[1]); w[1] = pk2(a[2], a[3]); w[2] = pk2(b[0], b[1]); w[3] = pk2(b[2], b[3]); *(u32x4*)p = w; }
DEV void st_bf4(bf16* p, f32x4 v) { u32x2 w; w[0] = pk2(v[0], v[1]); w[1] = pk2(v[2], v[3]); *(u32x2*)p = w; }


#ifdef EMU
namespace pg8 {
constexpr int BM = 256, BK = 64, HALF = 128, NXCD = 8, WGM = 8;
typedef unsigned short bf16_t;
struct Unit { int pm, pn; };
struct Gemm { const bf16_t* A; const bf16_t* Bt; int M, N, K; };
struct StaticOrder {
    int nM, nN, nwg, G, c;
    void init(int M, int N, int G_, int c_) { nM = M / BM; nN = N / BM; nwg = nM * nN; G = G_; c = c_; }
    bool next(int i, Unit& u) const {
        const long L = (long)i * G + c; if (L >= nwg) return false;
        int wgid = (int)L; { const int q = nwg / NXCD, r = nwg % NXCD, xcd = wgid % NXCD, off = wgid / NXCD; wgid = (xcd < r ? xcd * (q + 1) : r * (q + 1) + (xcd - r) * q) + off; }
        const int nig = WGM * nN, gid = wgid / nig, fm = gid * WGM, gsz = (nM - fm) < WGM ? (nM - fm) : WGM;
        u.pm = fm + ((wgid % nig) % gsz); u.pn = (wgid % nig) / gsz; return true;
    }
};
struct SelNone { static constexpr bool GATHER = false; struct Ctx {}; Ctx ctx(const Unit&) const { return Ctx(); } size_t boff(const Ctx&) const { return 0; } unsigned aoff(const Ctx&, int) const { return 0u; } };
template <class Epi, class Sched, bool ALIGN_EPI = false, bool SP2 = false, class Sel = SelNone>
static inline void gemm_phase(unsigned char*, const Gemm g, const Sched& S, const Epi& E, const Sel& X = Sel()) {
    const int tid = emu_tid(), wid = tid >> 6, lane = tid & 63, wr = wid >> 2, wc = wid & 3, fr = lane & 15, fq = lane >> 4;
    Unit u;
    for (int ui = 0; S.next(ui, u); ++ui) {
        f32x4 acc[2][2][4][2]; const auto cx = X.ctx(u);
        for (int ai = 0; ai < 2; ++ai) for (int bj = 0; bj < 2; ++bj) for (int m = 0; m < 4; ++m) for (int n = 0; n < 2; ++n) for (int r = 0; r < 4; ++r) {
            const int row = 256 * u.pm + 128 * ai + 64 * wr + 16 * m + fr, col = 256 * u.pn + 128 * bj + 32 * wc + (Epi::PERM ? 8 * fq + 4 * n + r : 16 * n + 4 * fq + r); float sum = 0.f;
            const bf16_t* ap = Sel::GATHER ? (const bf16_t*)((const char*)g.A + X.aoff(cx, row - 256 * u.pm)) : g.A + (size_t)row * g.K; const bf16_t* bp = (const bf16_t*)((const char*)g.Bt + X.boff(cx)) + (size_t)col * g.K;
            for (int k = 0; k < g.K; ++k) sum += bf2f(ap[k]) * bf2f(bp[k]);
            acc[ai][bj][m][n][r] = sum; }
        E(acc, u, wr, wc, fr, fq);
    }
    emu_sync_block();
}
}
#else
namespace pg8 {
#define PG8_LAS __attribute__((address_space(3)))
typedef unsigned short bf16_t;
typedef short bf16x8 __attribute__((ext_vector_type(8)));
typedef float f32x4 __attribute__((ext_vector_type(4)));
typedef unsigned u32x4 __attribute__((ext_vector_type(4)));
constexpr int BM = 256, BK = 64, HALF = 128, HTB = HALF * BK * 2  , STAGE_BYTES = 8 * HTB, NXCD = 8, WGM = 8;

__host__ __device__ __forceinline__ int lds_byte(int r, int c) { const int st = (r >> 4) * 2 + (c >> 5), rr = r & 15, cc = c & 31, ob = rr * 64 + cc * 2; return st * 1024 + (ob ^ (((ob >> 9) & 1) << 5)); }
__host__ __device__ __forceinline__ void stage_rc(int b, int& R, int& C) { const int st = b / 1024, sb = b % 1024, swz = sb ^ (((sb >> 9) & 1) << 5); R = (st >> 1) * 16 + swz / 64; C = (st & 1) * 32 + (swz % 64) / 2; }
__host__ __device__ __forceinline__ int perm32(int rho) { const int n = rho >> 4, i = rho & 15; return 8 * (i >> 2) + 4 * n + (i & 3); }

struct Unit { int pm, pn; };
struct Gemm { const bf16_t* A; const bf16_t* Bt; int M, N, K; };

struct StaticOrder {
    int nM, nN, nwg, G, c;
    __host__ __device__ void init(int M, int N, int G_, int c_) { nM = M / BM; nN = N / BM; nwg = nM * nN; G = G_; c = c_; }
    __host__ __device__ bool next(int i, Unit& u) const {
        const long L = (long)i * G + c; if (L >= nwg) return false;
        int wgid = (int)L; { const int q = nwg / NXCD, r = nwg % NXCD, xcd = wgid % NXCD, off = wgid / NXCD; wgid = (xcd < r ? xcd * (q + 1) : r * (q + 1) + (xcd - r) * q) + off; }
        const int nig = WGM * nN, gid = wgid / nig, fm = gid * WGM, gsz = (nM - fm) < WGM ? (nM - fm) : WGM;
        u.pm = fm + ((wgid % nig) % gsz); u.pn = (wgid % nig) / gsz; return true;
    }
    __device__ __forceinline__ void a_ready(const Unit&) const {}
    __device__ __forceinline__ void done(const Unit&) const {}
};

__device__ __forceinline__ unsigned cvt_pk_bf16(float lo, float hi) { unsigned r; asm volatile("v_cvt_pk_bf16_f32 %0, %1, %2" : "=v"(r) : "v"(lo), "v"(hi)); return r; }
struct SelNone { static constexpr bool GATHER = false; struct Ctx {}; __device__ __forceinline__ Ctx ctx(const Unit&) const { return Ctx(); } __device__ __forceinline__ size_t boff(const Ctx&) const { return 0; } __device__ __forceinline__ unsigned aoff(const Ctx&, int) const { return 0u; } };
template <class Epi, class Sched, bool ALIGN_EPI = false, bool SP2 = false, class Sel = SelNone>
__device__ __forceinline__ void gemm_phase(PG8_LAS unsigned char* lds, const Gemm g, const Sched& S, const Epi& E, const Sel& X = Sel()) {
    constexpr bool GA = Sel::GATHER;
    const int tid = TID, wid = __builtin_amdgcn_readfirstlane(tid >> 6), lane = tid & 63, wr = wid >> 2, wc = wid & 3, fr = lane & 15, fq = lane >> 4;
    const int K = g.K, nt = K / BK;
    unsigned voffA[2], voffB[2]; int Rl[2]; unsigned Cl2[2];
#pragma unroll
    for (int i = 0; i < 2; ++i) { int R, C; stage_rc(tid * 16 + i * 8192, R, C); const int Rb = Epi::PERM ? ((R & ~31) + perm32(R & 31)) : R;
        voffA[i] = (unsigned)(R * K + C) * 2u; voffB[i] = (unsigned)(Rb * K + C) * 2u; Rl[i] = R; Cl2[i] = (unsigned)C * 2u; }
    unsigned vA[2][2], vAn[2][2];
    const size_t kstep = (size_t)(BK * 2);
    const size_t hstep = (size_t)HALF * K * 2;
    const size_t tstep = 2 * hstep;
    const unsigned ldsw = (unsigned)wid * 1024u;
    const int aoff = lds_byte(wr * 64 + fr, fq * 8), boff = lds_byte(wc * 32 + fr, fq * 8);
#define PG8_SA(b, h) (((b) * 2 + (h)) * HTB)
#define PG8_SB(b, h) ((4 + (b) * 2 + (h)) * HTB)
#define PG8_STAGE(bufoff, gbase, voff) do { _Pragma("unroll") for (int _i = 0; _i < 2; ++_i) \
        __builtin_amdgcn_global_load_lds((const unsigned*)((const char*)(gbase) + (voff)[_i]), (PG8_LAS unsigned*)(lds + (bufoff) + ldsw + _i * 8192), 16, 0, 0); } while (0)
#define PG8_STAGE_A(bufoff, p, h, nx) do { if constexpr (GA) { unsigned _vo[2] = {(nx) ? vAn[h][0] : vA[h][0], (nx) ? vAn[h][1] : vA[h][1]}; PG8_STAGE(bufoff, p, _vo); } else { PG8_STAGE(bufoff, (p) + (h) * hstep, voffA); } } while (0)
#define PG8_GATH(cx, dst) do { _Pragma("unroll") for (int _h = 0; _h < 2; ++_h) _Pragma("unroll") for (int _i = 0; _i < 2; ++_i) dst[_h][_i] = X.aoff(cx, 128 * _h + Rl[_i]) + Cl2[_i]; } while (0)
#define PG8_LDA(dst, b, h) do { _Pragma("unroll") for (int m = 0; m < 4; ++m) _Pragma("unroll") for (int k = 0; k < 2; ++k) dst[m][k] = *(const PG8_LAS bf16x8*)(lds + PG8_SA(b, h) + aoff + m * 2048 + k * 1024); } while (0)
#define PG8_LDB(dst, b, h) do { _Pragma("unroll") for (int n = 0; n < 2; ++n) _Pragma("unroll") for (int k = 0; k < 2; ++k) dst[n][k] = *(const PG8_LAS bf16x8*)(lds + PG8_SB(b, h) + boff + n * 2048 + k * 1024); } while (0)
#define PG8_MMA(ai, bj, At, Bt) do { __builtin_amdgcn_s_setprio(1); _Pragma("unroll") for (int m = 0; m < 4; ++m) _Pragma("unroll") for (int n = 0; n < 2; ++n) _Pragma("unroll") for (int k = 0; k < 2; ++k) \
        acc[ai][bj][m][n] = __builtin_amdgcn_mfma_f32_16x16x32_bf16(Bt[n][k], At[m][k], acc[ai][bj][m][n], 0, 0, 0); __builtin_amdgcn_s_setprio(0); } while (0)
#define PG8_WAIT_V(n) asm volatile("s_waitcnt vmcnt(" #n ")" ::: "memory")
#define PG8_WAIT_L(n) asm volatile("s_waitcnt lgkmcnt(" #n ")" ::: "memory")
#define PG8_BAR __builtin_amdgcn_s_barrier()
#define PG8_SCHED __builtin_amdgcn_sched_barrier(0)
    Unit cur, nxt; int ui = 0;
    if (!S.next(0, cur)) return;
    f32x4 acc[2][2][4][2];
#pragma unroll
    for (int a = 0; a < 2; ++a)
#pragma unroll
        for (int b = 0; b < 2; ++b)
#pragma unroll
            for (int m = 0; m < 4; ++m)
#pragma unroll
                for (int n = 0; n < 2; ++n) acc[a][b][m][n] = (f32x4){0.f, 0.f, 0.f, 0.f};
    bf16x8 At[4][2], B0[2][2], B1[2][2];
    auto ccx = X.ctx(cur);
    const char* cA = GA ? (const char*)g.A : (const char*)g.A + (size_t)cur.pm * tstep; const char* cB = (const char*)g.Bt + X.boff(ccx) + (size_t)cur.pn * tstep;
    if constexpr (GA) { PG8_GATH(ccx, vA); }
    S.a_ready(cur);
    if constexpr (SP2) {
        PG8_STAGE(PG8_SB(0, 0), cB, voffB); PG8_STAGE(PG8_SB(0, 1), cB + hstep, voffB); PG8_STAGE_A(PG8_SA(0, 0), cA, 0, false); PG8_STAGE_A(PG8_SA(0, 1), cA, 1, false);
        if (wr == 1) PG8_BAR;
        PG8_WAIT_V(2); PG8_BAR;
        PG8_STAGE(PG8_SB(1, 0), cB + kstep, voffB); PG8_STAGE_A(PG8_SA(1, 0), cA + kstep, 0, false); PG8_STAGE(PG8_SB(1, 1), cB + hstep + kstep, voffB);
        PG8_WAIT_V(6); PG8_BAR;
    } else {
        PG8_STAGE(PG8_SB(0, 0), cB, voffB); PG8_STAGE_A(PG8_SA(0, 0), cA, 0, false); PG8_STAGE(PG8_SB(0, 1), cB + hstep, voffB); PG8_STAGE_A(PG8_SA(0, 1), cA, 1, false);
        if (wr == 1) PG8_BAR;
        PG8_WAIT_V(4); PG8_BAR;
        PG8_STAGE(PG8_SB(1, 0), cB + kstep, voffB); PG8_STAGE_A(PG8_SA(1, 0), cA + kstep, 0, false); PG8_STAGE(PG8_SB(1, 1), cB + hstep + kstep, voffB);
        PG8_WAIT_V(6); PG8_BAR;
    }
    for (;;) {
        const bool has_next = S.next(ui + 1, nxt);
        const char* nA = cA; const char* nB = cB;
        if (has_next) { const auto ncx = X.ctx(nxt); nA = GA ? (const char*)g.A : (const char*)g.A + (size_t)nxt.pm * tstep; nB = (const char*)g.Bt + X.boff(ncx) + (size_t)nxt.pn * tstep; if constexpr (GA) { PG8_GATH(ncx, vAn); } }
        else if constexpr (GA) {
#pragma unroll
            for (int _h = 0; _h < 2; ++_h) { vAn[_h][0] = vA[_h][0]; vAn[_h][1] = vA[_h][1]; } }
        for (int t = 0; t < nt; t += 2) {
            const bool last = (t == nt - 2);
            const char* a1 = cA + (size_t)(t + 1) * kstep;
            const char* a2 = last ? nA : cA + (size_t)(t + 2) * kstep; const char* b2 = last ? nB : cB + (size_t)(t + 2) * kstep;
            const char* a3 = a2 + kstep; const char* b3 = b2 + kstep;
            if (last && has_next) S.a_ready(nxt);
            if constexpr (SP2) {
            PG8_LDB(B0, 0, 0); PG8_LDB(B1, 0, 1); PG8_SCHED; PG8_LDA(At, 0, 0); PG8_STAGE_A(PG8_SA(1, 1), a1, 1, false);
            PG8_WAIT_V(8); PG8_WAIT_L(0); PG8_BAR; PG8_MMA(0, 0, At, B0); PG8_MMA(0, 1, At, B1); PG8_BAR; PG8_SCHED;
            PG8_LDA(At, 0, 1); PG8_STAGE(PG8_SB(0, 0), b2, voffB); PG8_STAGE(PG8_SB(0, 1), b2 + hstep, voffB); PG8_STAGE_A(PG8_SA(0, 0), a2, 0, last);
            PG8_WAIT_V(8); PG8_WAIT_L(0); PG8_BAR; PG8_MMA(1, 0, At, B0); PG8_MMA(1, 1, At, B1); PG8_BAR; PG8_SCHED;
            PG8_LDB(B0, 1, 0); PG8_LDB(B1, 1, 1); PG8_SCHED; PG8_LDA(At, 1, 0); PG8_STAGE_A(PG8_SA(0, 1), a2, 1, last);
            PG8_WAIT_V(8); PG8_WAIT_L(0); PG8_BAR; PG8_MMA(0, 0, At, B0); PG8_MMA(0, 1, At, B1); PG8_BAR; PG8_SCHED;
            PG8_LDA(At, 1, 1); PG8_STAGE(PG8_SB(1, 0), b3, voffB); PG8_STAGE(PG8_SB(1, 1), b3 + hstep, voffB); PG8_STAGE_A(PG8_SA(1, 0), a3, 0, last);
            PG8_WAIT_V(8); PG8_WAIT_L(0); PG8_BAR; PG8_MMA(1, 0, At, B0); PG8_MMA(1, 1, At, B1); PG8_BAR; PG8_SCHED;
            } else {
            PG8_LDB(B0, 0, 0); PG8_SCHED; PG8_LDA(At, 0, 0); PG8_STAGE_A(PG8_SA(1, 1), a1, 1, false);
            PG8_WAIT_L(8); PG8_BAR; PG8_WAIT_L(0); PG8_MMA(0, 0, At, B0); PG8_BAR; PG8_SCHED;
            PG8_LDB(B1, 0, 1); PG8_STAGE(PG8_SB(0, 0), b2, voffB);
            PG8_BAR; PG8_WAIT_L(0); PG8_MMA(0, 1, At, B1); PG8_BAR;
            PG8_LDA(At, 0, 1); PG8_STAGE_A(PG8_SA(0, 0), a2, 0, last);
            PG8_BAR; PG8_WAIT_L(0); PG8_MMA(1, 0, At, B0); PG8_BAR; PG8_SCHED;
            PG8_STAGE(PG8_SB(0, 1), b2 + hstep, voffB);
            PG8_WAIT_V(6); PG8_BAR; PG8_MMA(1, 1, At, B1); PG8_BAR;
            PG8_LDB(B0, 1, 0); PG8_SCHED; PG8_LDA(At, 1, 0); PG8_STAGE_A(PG8_SA(0, 1), a2, 1, last);
            PG8_WAIT_L(8); PG8_BAR; PG8_WAIT_L(0); PG8_MMA(0, 0, At, B0); PG8_BAR; PG8_SCHED;
            PG8_LDB(B1, 1, 1); PG8_STAGE(PG8_SB(1, 0), b3, voffB);
            PG8_BAR; PG8_WAIT_L(0); PG8_MMA(0, 1, At, B1); PG8_BAR;
            PG8_LDA(At, 1, 1); PG8_STAGE_A(PG8_SA(1, 0), a3, 0, last);
            PG8_BAR; PG8_WAIT_L(0); PG8_MMA(1, 0, At, B0); PG8_BAR; PG8_SCHED;
            PG8_STAGE(PG8_SB(1, 1), b3 + hstep, voffB);
            PG8_WAIT_V(6); PG8_BAR; PG8_MMA(1, 1, At, B1); PG8_BAR;
            }
        }
        if constexpr (ALIGN_EPI) { if (wr == 0) PG8_BAR; }
        if constexpr (!Epi::AFTER_DRAIN) { E(acc, cur, wr, wc, fr, fq); S.done(cur); }
        if (!has_next) break;
#pragma unroll
        for (int a = 0; a < 2; ++a)
#pragma unroll
            for (int b = 0; b < 2; ++b)
#pragma unroll
                for (int m = 0; m < 4; ++m)
#pragma unroll
                    for (int n = 0; n < 2; ++n) acc[a][b][m][n] = (f32x4){0.f, 0.f, 0.f, 0.f};
        cur = nxt; cA = nA; cB = nB; ++ui;
        if constexpr (GA) {
#pragma unroll
            for (int _h = 0; _h < 2; ++_h) { vA[_h][0] = vAn[_h][0]; vA[_h][1] = vAn[_h][1]; } }
        if constexpr (ALIGN_EPI) { if (wr == 1) PG8_BAR; }
    }
    PG8_WAIT_V(0);
    if constexpr (!ALIGN_EPI) { if (wr == 0) PG8_BAR; }
    PG8_BAR;
    if constexpr (Epi::AFTER_DRAIN) { E.fused(acc, cur, wr, wc, fr, fq, lds, wid, lane); S.done(cur); }
#undef PG8_SA
#undef PG8_SB
#undef PG8_STAGE
#undef PG8_STAGE_A
#undef PG8_GATH
#undef PG8_LDA
#undef PG8_LDB
#undef PG8_MMA
#undef PG8_WAIT_V
#undef PG8_WAIT_L
#undef PG8_BAR
#undef PG8_SCHED
}
}
#endif

constexpr int LDT = 72;
constexpr int GEMM_AS = 256 * LDT, GEMM_BS = 128 * LDT;
constexpr int GEMM_LDS = 2 * (GEMM_AS + GEMM_BS) * 2;

template <class AF, class EPI>
DEV void gemm_tile(unsigned char* smem, AF af, const bf16* Bt, int ldb, int nvalid, int K, EPI& epi) {
    const int tid = TID, w = tid >> 6, l = tid & 63, h = l >> 4, c = l & 15, wm = w >> 1, wn = w & 1;
    bf16* As = (bf16*)smem; bf16* Bs = As + 2 * GEMM_AS;
    const bf16* ap[4]; const bf16* bp[2];
    const int col8 = (tid & 7) * 8, r0 = tid >> 3;
#pragma unroll
    for (int i = 0; i < 4; ++i) ap[i] = af(r0 + 64 * i) + col8;
#pragma unroll
    for (int i = 0; i < 2; ++i) { int rn = r0 + 64 * i; if (rn >= nvalid) rn = nvalid - 1; bp[i] = Bt + (size_t)rn * ldb + col8; }
    f32x4 acc[4][4];
#pragma unroll
    for (int i = 0; i < 4; ++i)
#pragma unroll
        for (int j = 0; j < 4; ++j) acc[i][j] = f4zero();
    bf16x8 ra[4], rb[2];
#pragma unroll
    for (int i = 0; i < 4; ++i) ra[i] = *(const bf16x8*)(ap[i]);
#pragma unroll
    for (int i = 0; i < 2; ++i) rb[i] = *(const bf16x8*)(bp[i]);
    SYNC();
#pragma unroll
    for (int i = 0; i < 4; ++i) *(bf16x8*)(As + (r0 + 64 * i) * LDT + col8) = ra[i];
#pragma unroll
    for (int i = 0; i < 2; ++i) *(bf16x8*)(Bs + (r0 + 64 * i) * LDT + col8) = rb[i];
    SYNC();
    const int nk = K / 64;
    for (int kt = 0; kt < nk; ++kt) {
        const int cur = kt & 1;
        if (kt + 1 < nk) {
#pragma unroll
            for (int i = 0; i < 4; ++i) ra[i] = *(const bf16x8*)(ap[i] + (kt + 1) * 64);
#pragma unroll
            for (int i = 0; i < 2; ++i) rb[i] = *(const bf16x8*)(bp[i] + (kt + 1) * 64);
        }
        const bf16* Ac = As + cur * GEMM_AS + (wm * 64 + c) * LDT + 8 * h;
        const bf16* Bc = Bs + cur * GEMM_BS + (wn * 64 + c) * LDT + 8 * h;
#pragma unroll
        for (int kk = 0; kk < 2; ++kk) {
            bf16x8 fa[4], fb[4];
#pragma unroll
            for (int i = 0; i < 4; ++i) { fa[i] = *(const bf16x8*)(Ac + i * 16 * LDT + kk * 32); fb[i] = *(const bf16x8*)(Bc + i * 16 * LDT + kk * 32); }
#pragma unroll
            for (int ni = 0; ni < 4; ++ni)
#pragma unroll
                for (int mi = 0; mi < 4; ++mi) acc[ni][mi] = mfma16(fb[ni], fa[mi], acc[ni][mi]);
        }
        if (kt + 1 < nk) {
            const int nx = cur ^ 1;
#pragma unroll
            for (int i = 0; i < 4; ++i) *(bf16x8*)(As + nx * GEMM_AS + (r0 + 64 * i) * LDT + col8) = ra[i];
#pragma unroll
            for (int i = 0; i < 2; ++i) *(bf16x8*)(Bs + nx * GEMM_BS + (r0 + 64 * i) * LDT + col8) = rb[i];
        }
        SYNC();
    }
    epi(acc, wm * 64, wn * 64, h, c);
}

struct ARows { const bf16* base; size_t ld; MDEV const bf16* operator()(int r) const { return base + (size_t)r * ld; } MDEV unsigned off(int r) const { return (unsigned)r * (unsigned)ld; } };

constexpr int LDB = 144;
constexpr int GEMM_BS2 = 64 * LDB;
constexpr int GEMM2_LDS = (2 * GEMM_AS + 2 * GEMM_BS2) * 2;
DEV bf16x8 tr_read8(const bf16* p0, const bf16* p1) {
    const s16x4 x = tr4(p0), y = tr4(p1); bf16x8 r;
    r[0] = x[0]; r[1] = x[1]; r[2] = x[2]; r[3] = x[3]; r[4] = y[0]; r[5] = y[1]; r[6] = y[2]; r[7] = y[3]; return r;
}
DEV int bperm(int r) { return (r & ~12) | ((r & 4) << 1) | ((r & 8) >> 1); }
template <class AF, class BF, class EPI>
DEV void gemm_tile2(unsigned char* smem, AF af, BF bf, int ldb, int K, EPI& epi) {
    const int tid = TID, w = tid >> 6, l = tid & 63, h = l >> 4, c = l & 15, wm = w >> 1, wn = w & 1, grp = w >> 2;
    bf16* As = (bf16*)smem; bf16* Bs = As + 2 * GEMM_AS;
    const bf16* abase = af.base; unsigned ao[4];
    const int col8 = (tid & 7) * 8, r0 = tid >> 3;
#pragma unroll
    for (int i = 0; i < 4; ++i) ao[i] = af.off(r0 + 64 * i) + col8;
    const int bn4 = (tid & 31) * 4, bk = tid >> 5, bkp = bperm(bk);
    const float* bp = bf(bn4); const bool bok = bp != nullptr;
    if (bok) bp += (size_t)bk * ldb;
    const size_t bstep = (size_t)16 * ldb;
    f32x4 acc[4][4];
#pragma unroll
    for (int i = 0; i < 4; ++i)
#pragma unroll
        for (int j = 0; j < 4; ++j) acc[i][j] = f4zero();
    bf16x8 ra[4]; f32x4 rb[4];
    const int nk = K / 64;
#pragma unroll
    for (int i = 0; i < 4; ++i) { ra[i] = *(const bf16x8*)(abase + ao[i]); rb[i] = bok ? *(const f32x4*)(bp + i * bstep) : f4zero(); }
    SYNC();
#pragma unroll
    for (int i = 0; i < 4; ++i) { *(bf16x8*)(As + (r0 + 64 * i) * LDT + col8) = ra[i]; st_bf4(Bs + (bkp + 16 * i) * LDB + bn4, rb[i]); }
    if (nk > 1) {
#pragma unroll
        for (int i = 0; i < 4; ++i) { ra[i] = *(const bf16x8*)(abase + (ao[i] + 64)); rb[i] = bok ? *(const f32x4*)(bp + (size_t)64 * ldb + i * bstep) : f4zero(); } }
    SYNC();
    for (int kt = 0; kt < nk; ++kt) {
        const int cur = kt & 1;
#pragma unroll
        for (int p = 0; p < 2; ++p) {
            if (grp == p) {
                const bf16* Ac = As + cur * GEMM_AS + (wm * 64 + c) * LDT + 8 * h;
                const bf16* Bc = Bs + cur * GEMM_BS2 + bperm(8 * h + (c >> 2)) * LDB + wn * 64 + 4 * (c & 3);
#pragma unroll
                for (int kk = 0; kk < 2; ++kk) {
                    bf16x8 fa[4], fb[4];
#pragma unroll
                    for (int i = 0; i < 4; ++i) { fa[i] = *(const bf16x8*)(Ac + i * 16 * LDT + kk * 32); fb[i] = tr_read8(Bc + (32 * kk) * LDB + 16 * i, Bc + (32 * kk + 8) * LDB + 16 * i); }
#pragma unroll
                    for (int ni = 0; ni < 4; ++ni)
#pragma unroll
                        for (int mi = 0; mi < 4; ++mi) acc[ni][mi] = mfma16(fb[ni], fa[mi], acc[ni][mi]);
                }
            } else if (kt + 1 < nk) {
                const int nx = cur ^ 1;
#pragma unroll
                for (int i = 0; i < 4; ++i) { *(bf16x8*)(As + nx * GEMM_AS + (r0 + 64 * i) * LDT + col8) = ra[i]; st_bf4(Bs + nx * GEMM_BS2 + (bkp + 16 * i) * LDB + bn4, rb[i]); }
                if (kt + 2 < nk) {
#pragma unroll
                    for (int i = 0; i < 4; ++i) { ra[i] = *(const bf16x8*)(abase + (ao[i] + (kt + 2) * 64)); rb[i] = bok ? *(const f32x4*)(bp + (size_t)(kt + 2) * 64 * ldb + i * bstep) : f4zero(); } }
            }
            SYNC();
        }
    }
    epi(acc, wm * 64, wn * 64, h, c);
}
struct BPlain { const float* base; MDEV const float* operator()(int nt) const { return base + nt; } };
struct BInProjMap { const float* base; int n0; MDEV const float* operator()(int nt) const { const int n = n0 + nt; const int sc = n < 1280 ? n : (n < 3328 ? n + 24 : (n < 3352 ? 1280 + (n - 3328) : -1)); return sc < 0 ? nullptr : base + sc; } };
struct BInter { const float* s0; const float* s1; int n0; MDEV const float* operator()(int nt) const { const int n = n0 + nt, g = n >> 6, w = n & 63; return w < 32 ? s0 + g * 32 + w : s1 + g * 32 + w - 32; } };
struct BClamp64 { const float* base; MDEV const float* operator()(int nt) const { return base + (nt & 63); } };

struct EpiInProj {
    const Args* a; int m0, n0, li;
    MDEV void operator()(f32x4 (&acc)[4][4], int mw, int nw, int h, int c) const {
        unsigned char* ws = wsp(*a);
        const int nb = n0 + nw;
        const int tokb = m0 + mw + c;
        if (nb < 512 || (nb >= 768 && nb < 896) || (nb >= 1024 && nb < 1152)) {
            const float* gain; float mul = 1.f; bf16* dst; int kind;
            if (nb < 512) { gain = INP(*a, I_QG) + li * 64; mul = 0.125f * LOG2E; kind = 0; dst = (bf16*)(ws + WS_QN); }
            else if (nb < 896) { gain = INP(*a, I_KG) + (li * 3 + 1) * 64; kind = 1; dst = (bf16*)(ws + WS_KS); }
            else { gain = INP(*a, I_KG) + (li * 3 + 2) * 64; kind = 1; dst = (bf16*)(ws + WS_KW); }
            const int g = (nb >> 6) & 1;
#pragma unroll
            for (int mi = 0; mi < 4; ++mi) {
                float ss = 0.f;
#pragma unroll
                for (int ni = 0; ni < 4; ++ni) { f32x4 v = acc[ni][mi]; ss += v[0] * v[0] + v[1] * v[1] + v[2] * v[2] + v[3] * v[3]; }
                ss += shflx(ss, 16); ss += shflx(ss, 32);
                const float rs = frsq(ss * (1.0f / 64.0f) + EPS) * mul;
                const int tok = tokb + 16 * mi;
#pragma unroll
                for (int ni = 0; ni < 4; ++ni) {
                    const int d = 16 * ni + 4 * h; f32x4 v = acc[ni][mi], o;
#pragma unroll
                    for (int r = 0; r < 4; ++r) o[r] = v[r] * rs * gain[d + r];
                    if (kind == 0) st_bf4(dst + (size_t)tok * 512 + nb + d, o);
                    else { const int b = tok / SEQ, s = tok % SEQ; st_bf4(dst + ((size_t)(b * 2 + g) * SEQ + s) * 64 + d, o); }
                }
            }
        } else if (nb < 768) {
            bf16* dst = (bf16*)(ws + (nb < 640 ? WS_KCG : WS_VCG)); const int g = (nb >> 6) & 1;
#pragma unroll
            for (int mi = 0; mi < 4; ++mi) { const int tok = tokb + 16 * mi, b = tok / SEQ, s = tok % SEQ;
#pragma unroll
                for (int ni = 0; ni < 4; ++ni) st_bf4(dst + ((size_t)(b * 2 + g) * SEQ + s) * 64 + 16 * ni + 4 * h, acc[ni][mi]); }
        } else if (nb < 1280) {
            bf16* dst = (bf16*)(ws + (nb < 1024 ? WS_VST : WS_VWT)); const int g = (nb >> 6) & 1;
#pragma unroll
            for (int mi = 0; mi < 4; ++mi) { const int tok = tokb + 16 * mi, b = tok / SEQ, s = tok % SEQ;
                bf16* p = dst + ((size_t)(b * 2 + g) * NCH + (s >> 6)) * 4096 + (s & 63);
#pragma unroll
                for (int ni = 0; ni < 4; ++ni)
#pragma unroll
                    for (int r = 0; r < 4; ++r) p[(16 * ni + 4 * h + r) * 64] = (bf16)f2bf(acc[ni][mi][r]); }
        } else if (nb < 3328) {
            const int sec = (nb - 1280) >> 9, cc = (nb - 1280) & 511, hh = cc >> 7, d0 = cc & 127;
#pragma unroll
            for (int mi = 0; mi < 4; ++mi) { const int tok = tokb + 16 * mi, b = tok / SEQ, s = tok % SEQ;
                const size_t hrow = ((size_t)(b * 4 + hh) * SEQ + s) * 128 + d0;
#pragma unroll
                for (int ni = 0; ni < 4; ++ni) { const int d = 16 * ni + 4 * h; f32x4 v = acc[ni][mi], o;
                    if (sec == 0) { for (int r = 0; r < 4; ++r) o[r] = siluf(v[r]); st_bf4((bf16*)(ws + WS_HQ) + hrow + d, o); }
                    else if (sec == 1) { const float* lb = (const float*)(ws + WS_LB) + li * 512 + cc + d;
                        for (int r = 0; r < 4; ++r) o[r] = lb[r] + (1.0f - lb[r]) * sigm(v[r]);
                        *(f32x4*)((float*)(ws + WS_HF) + hrow + d) = o; }
                    else if (sec == 2) st_bf4((bf16*)(ws + WS_HV) + hrow + d, v);
                    else { for (int r = 0; r < 4; ++r) o[r] = siluf(v[r]); st_bf4((bf16*)(ws + WS_HGS) + (size_t)tok * 512 + cc + d, o); }
                } }
        } else if (nb == 3328) {
            float* dst = (float*)(ws + WS_GATE);
#pragma unroll
            for (int mi = 0; mi < 4; ++mi) { const int tok = tokb + 16 * mi;
#pragma unroll
                for (int ni = 0; ni < 2; ++ni)
#pragma unroll
                    for (int r = 0; r < 4; ++r) { const int n = 16 * ni + 4 * h + r; if (n < 24) dst[(size_t)tok * 24 + n] = sigm(acc[ni][mi][r]); } }
        }
    }
};

struct EpiResid {
    float* x; const float* gate; int m0, n0;
    MDEV void operator()(f32x4 (&acc)[4][4], int mw, int nw, int h, int c) const {
#pragma unroll
        for (int mi = 0; mi < 4; ++mi) { const int tok = m0 + mw + 16 * mi + c, b = tok / SEQ;
#pragma unroll
            for (int ni = 0; ni < 4; ++ni) { const int n = n0 + nw + 16 * ni + 4 * h;
                f32x4 g = *(const f32x4*)(gate + (size_t)b * 6 * DM + n); f32x4* p = (f32x4*)(x + (size_t)tok * DM + n); f32x4 v = *p;
#pragma unroll
                for (int r = 0; r < 4; ++r) v[r] += g[r] * acc[ni][mi][r];
                *p = v; } }
    }
};
template <int MODE> struct EpiGated {
    bf16* dst; size_t ld; int m0, n0, mvalid;
    MDEV void operator()(f32x4 (&acc)[4][4], int mw, int nw, int h, int c) const {
        const int cb = (n0 + nw) / 2;
#pragma unroll
        for (int mi = 0; mi < 4; ++mi) { const int m = mw + 16 * mi + c; if (m >= mvalid) continue;
#pragma unroll
            for (int ni = 0; ni < 2; ++ni) { f32x4 o;
#pragma unroll
                for (int r = 0; r < 4; ++r) { const float av = acc[ni][mi][r], bv = acc[ni + 2][mi][r]; o[r] = MODE == 0 ? av * sigm(bv) : siluf(av) * bv; }
                st_bf4(dst + (size_t)(m0 + m) * ld + cb + 16 * ni + 4 * h, o); } }
    }
};
struct EpiStoreBf {
    bf16* dst; size_t ld; int m0, n0, mvalid;
    MDEV void operator()(f32x4 (&acc)[4][4], int mw, int nw, int h, int c) const {
#pragma unroll
        for (int mi = 0; mi < 4; ++mi) { const int m = mw + 16 * mi + c; if (m >= mvalid) continue;
#pragma unroll
            for (int ni = 0; ni < 4; ++ni) st_bf4(dst + (size_t)(m0 + m) * ld + n0 + nw + 16 * ni + 4 * h, acc[ni][mi]); }
    }
};
struct EpiCmp {
    const Args* a; int kv, bg, m0, li;
    MDEV void operator()(f32x4 (&acc)[4][4], int mw, int nw, int h, int c) const {
        if (nw != 0) return;
        unsigned char* ws = wsp(*a);
        const float* bp8 = (const float*)(ws + WS_CB) + (li * 2 + kv) * 8 * 64;
        float bias[16];
#pragma unroll
        for (int q = 0; q < 16; ++q) { const int e = 16 * (q >> 2) + 4 * h + (q & 3); float v = 0.f;
#pragma unroll
            for (int kp = 0; kp < 8; ++kp) v += bp8[kp * 64 + e];
            bias[q] = v; }
        const float* gain = INP(*a, I_KG) + (li * 3 + 0) * 64;
#pragma unroll
        for (int mi = 0; mi < 4; ++mi) { const int n = m0 + mw + 16 * mi + c; const bool ok = n < NCMP;
            f32x4 v[4]; float ss = 0.f;
#pragma unroll
            for (int ni = 0; ni < 4; ++ni) { v[ni] = acc[ni][mi];
#pragma unroll
                for (int r = 0; r < 4; ++r) { v[ni][r] += bias[4 * ni + r]; ss += v[ni][r] * v[ni][r]; } }
            ss += shflx(ss, 16); ss += shflx(ss, 32);
            if (n >= NCP) continue;
            if (kv == 0) { const float rs = frsq(ss * (1.0f / 64.0f) + EPS); bf16* p = (bf16*)(ws + WS_KC) + ((size_t)bg * NCP + n) * 64;
#pragma unroll
                for (int ni = 0; ni < 4; ++ni) { f32x4 o;
#pragma unroll
                    for (int r = 0; r < 4; ++r) o[r] = ok ? v[ni][r] * rs * gain[16 * ni + 4 * h + r] : 0.f;
                    st_bf4(p + 16 * ni + 4 * h, o); }
            } else { bf16* p = (bf16*)(ws + WS_VCT) + ((size_t)bg * NCP + n) * 64;
#pragma unroll
                for (int ni = 0; ni < 4; ++ni) { f32x4 o;
#pragma unroll
                    for (int r = 0; r < 4; ++r) o[r] = ok ? v[ni][r] : 0.f;
                    st_bf4(p + 16 * ni + 4 * h, o); } }
        }
    }
};


struct EpiResid8 {
    static constexpr bool PERM = true, AFTER_DRAIN = false;
    float* x; const float* gate; const float* xin;
    MDEV void operator()(const f32x4 (&acc)[2][2][4][2], const pg8::Unit& u, int wr, int wc, int fr, int fq) const {
        OPAQUE2(fr, fq);
#pragma unroll
        for (int ai = 0; ai < 2; ++ai)
#pragma unroll
            for (int m = 0; m < 4; ++m) { const int row = 256 * u.pm + 128 * ai + 64 * wr + 16 * m + fr, b = row / SEQ;
#pragma unroll
                for (int bj = 0; bj < 2; ++bj)
#pragma unroll
                    for (int n = 0; n < 2; ++n) { const int col = 256 * u.pn + 128 * bj + 32 * wc + 8 * fq + 4 * n;
                        const f32x4 g = *(const f32x4*)(gate + (size_t)b * 6 * DM + col); f32x4* p = (f32x4*)(x + (size_t)row * DM + col); f32x4 v = *(const f32x4*)(xin + (size_t)row * DM + col);
#pragma unroll
                        for (int r = 0; r < 4; ++r) v[r] += g[r] * acc[ai][bj][m][n][r];
                        *p = v; } }
    }
};
struct EpiGlu8 {
    static constexpr bool PERM = true, AFTER_DRAIN = false;
    bf16* dst;
    MDEV void operator()(const f32x4 (&acc)[2][2][4][2], const pg8::Unit& u, int wr, int wc, int fr, int fq) const {
        OPAQUE2(fr, fq);
#pragma unroll
        for (int ai = 0; ai < 2; ++ai)
#pragma unroll
            for (int m = 0; m < 4; ++m) { const int row = 256 * u.pm + 128 * ai + 64 * wr + 16 * m + fr;
                { const int col = 128 * u.pn + 32 * wc + 8 * fq; f32x4 o0, o1;
#pragma unroll
                    for (int r = 0; r < 4; ++r) { o0[r] = acc[ai][0][m][0][r] * sigm(acc[ai][1][m][0][r]); o1[r] = acc[ai][0][m][1][r] * sigm(acc[ai][1][m][1][r]); }
                    st_bf8(dst + (size_t)row * DM + col, o0, o1); } }
    }
};
struct EpiMoe1_8 {
    static constexpr bool PERM = true, AFTER_DRAIN = false;
    bf16* dst;
    MDEV void operator()(const f32x4 (&acc)[2][2][4][2], const pg8::Unit& u, int wr, int wc, int fr, int fq) const {
        OPAQUE2(fr, fq);
#pragma unroll
        for (int ai = 0; ai < 2; ++ai)
#pragma unroll
            for (int m = 0; m < 4; ++m) { const int row = 256 * u.pm + 128 * ai + 64 * wr + 16 * m + fr;
                const int col = 128 * u.pn + 32 * wc + 8 * fq; f32x4 o0, o1;
#pragma unroll
                for (int r = 0; r < 4; ++r) { o0[r] = siluf(acc[ai][0][m][0][r]) * acc[ai][1][m][0][r]; o1[r] = siluf(acc[ai][0][m][1][r]) * acc[ai][1][m][1][r]; }
#ifdef EMU
                st_bf8(dst + (size_t)row * FF + col, o0, o1); }
#else
                u32x4 pk; pk[0] = pk2(o0[0], o0[1]); pk[1] = pk2(o0[2], o0[3]); pk[2] = pk2(o1[0], o1[1]); pk[3] = pk2(o1[2], o1[3]);
                asm volatile("global_store_dwordx4 %0, %1, off sc1\n\ts_nop 2" :: "v"((__attribute__((address_space(1))) bf16*)(dst + (size_t)row * FF + col)), "v"(pk) : "memory"); }
#endif
    }
};
struct EpiMoe2_8 {
    static constexpr bool PERM = true, AFTER_DRAIN = false;
    bf16* dst;
    MDEV void operator()(const f32x4 (&acc)[2][2][4][2], const pg8::Unit& u, int wr, int wc, int fr, int fq) const {
        OPAQUE2(fr, fq);
#pragma unroll
        for (int ai = 0; ai < 2; ++ai)
#pragma unroll
            for (int m = 0; m < 4; ++m) { const int row = 256 * u.pm + 128 * ai + 64 * wr + 16 * m + fr;
#pragma unroll
                for (int bj = 0; bj < 2; ++bj) { const int col = 256 * u.pn + 128 * bj + 32 * wc + 8 * fq;
                    st_bf8(dst + (size_t)row * DM + col, acc[ai][bj][m][0], acc[ai][bj][m][1]); } }
    }
};
DEV unsigned uni(unsigned x);
template <bool G> struct MoeSel {
    static constexpr bool GATHER = G;
    const int* rb; const int* cnt; const int* list; size_t bstride;
    struct Ctx { int e, rbase, c; };
    MDEV Ctx ctx(const pg8::Unit& u) const { int e = 0;
#pragma unroll 1
        for (int q = 1; q < 32; ++q) if ((rb[q] >> 8) <= u.pm) e = q;
        e = (int)uni((unsigned)e); Ctx x; x.e = e; x.rbase = (int)uni((unsigned)((u.pm << 8) - rb[e])); x.c = G ? (int)uni((unsigned)cnt[e * 64]) : 0; return x; }
    MDEV size_t boff(const Ctx& x) const { return (size_t)x.e * bstride; }
    MDEV unsigned aoff(const Ctx& x, int r) const { int p = x.rbase + r; if (p > x.c - 1) p = x.c - 1; return (unsigned)list[(size_t)x.e * T + p] * (unsigned)(DM * 2); }
};
struct EpiInProj8 {
    static constexpr bool PERM = true, AFTER_DRAIN = false;
    const Args* a; int li;
    MDEV void operator()(const f32x4 (&acc)[2][2][4][2], const pg8::Unit& u, int wr, int wc, int fr, int fq) const {
        OPAQUE2(fr, fq);
        unsigned char* ws = wsp(*a);
        const int nb = 256 * u.pn + 64 * wc;
        if (nb >= 3392) return;
        if (nb < 512 || (nb >= 768 && nb < 896) || (nb >= 1024 && nb < 1152)) {
            const float* gain; float mul = 1.f; int kind;
            if (nb < 512) { gain = INP(*a, I_QG) + li * 64; mul = 0.125f * LOG2E; kind = 0; }
            else if (nb < 896) { gain = INP(*a, I_KG) + (li * 3 + 1) * 64; kind = 1; }
            else { gain = INP(*a, I_KG) + (li * 3 + 2) * 64; kind = 2; }
            const int g = (nb >> 6) & 1;
            f32x4 gv[2][2];
#pragma unroll
            for (int bj = 0; bj < 2; ++bj)
#pragma unroll
                for (int n = 0; n < 2; ++n) gv[bj][n] = *(const f32x4*)(gain + 32 * bj + 8 * fq + 4 * n);
#pragma unroll
            for (int ai = 0; ai < 2; ++ai)
#pragma unroll
                for (int m = 0; m < 4; ++m) { const int tok = 256 * u.pm + 128 * ai + 64 * wr + 16 * m + fr;
                    float ss = 0.f;
#pragma unroll
                    for (int bj = 0; bj < 2; ++bj)
#pragma unroll
                        for (int n = 0; n < 2; ++n) { const f32x4 v = acc[ai][bj][m][n]; ss += v[0] * v[0] + v[1] * v[1] + v[2] * v[2] + v[3] * v[3]; }
                    ss += shflx(ss, 16); ss += shflx(ss, 32);
                    const float rs = frsq(ss * (1.0f / 64.0f) + EPS) * mul;
                    bf16* dst; if (kind == 0) dst = (bf16*)(ws + WS_QN) + (size_t)tok * 512 + nb; else { const int b = tok / SEQ, sq = tok % SEQ; dst = (bf16*)(ws + (kind == 1 ? WS_KS : WS_KW)) + ((size_t)(b * 2 + g) * SEQ + sq) * 64; }
#pragma unroll
                    for (int bj = 0; bj < 2; ++bj) { f32x4 o0, o1;
#pragma unroll
                        for (int r = 0; r < 4; ++r) { o0[r] = acc[ai][bj][m][0][r] * rs * gv[bj][0][r]; o1[r] = acc[ai][bj][m][1][r] * rs * gv[bj][1][r]; }
                        st_bf8(dst + 32 * bj + 8 * fq, o0, o1); } }
        } else if (nb < 768) {
            bf16* base = (bf16*)(ws + (nb < 640 ? WS_KCG : WS_VCG)); const int g = (nb >> 6) & 1;
#pragma unroll
            for (int ai = 0; ai < 2; ++ai)
#pragma unroll
                for (int m = 0; m < 4; ++m) { const int tok = 256 * u.pm + 128 * ai + 64 * wr + 16 * m + fr, b = tok / SEQ, sq = tok % SEQ;
#pragma unroll
                    for (int bj = 0; bj < 2; ++bj) st_bf8(base + ((size_t)(b * 2 + g) * SEQ + sq) * 64 + 32 * bj + 8 * fq, acc[ai][bj][m][0], acc[ai][bj][m][1]); }
        } else if (nb < 1280) {
            bf16* base = (bf16*)(ws + (nb < 1024 ? WS_VST : WS_VWT)); const int g = (nb >> 6) & 1;
#pragma unroll
            for (int ai = 0; ai < 2; ++ai)
#pragma unroll
                for (int m = 0; m < 4; ++m) { const int tok = 256 * u.pm + 128 * ai + 64 * wr + 16 * m + fr, b = tok / SEQ, sq = tok % SEQ;
#pragma unroll
                    for (int bj = 0; bj < 2; ++bj) st_bf8(base + ((size_t)(b * 2 + g) * SEQ + sq) * 64 + 32 * bj + 8 * fq, acc[ai][bj][m][0], acc[ai][bj][m][1]); }
        } else if (nb < 3328) {
            const int sec = (nb - 1280) >> 9, cc = (nb - 1280) & 511, hh = cc >> 7, d0 = cc & 127;
            f32x4 lbv[2][2];
            if (sec == 1) {
#pragma unroll
                for (int bj = 0; bj < 2; ++bj)
#pragma unroll
                    for (int n = 0; n < 2; ++n) lbv[bj][n] = *(const f32x4*)((const float*)(ws + WS_LB) + li * 512 + cc + 32 * bj + 8 * fq + 4 * n); }
#pragma unroll
            for (int ai = 0; ai < 2; ++ai)
#pragma unroll
                for (int m = 0; m < 4; ++m) { const int tok = 256 * u.pm + 128 * ai + 64 * wr + 16 * m + fr, b = tok / SEQ, sq = tok % SEQ;
                    const size_t hrow = ((size_t)(b * 4 + hh) * SEQ + sq) * 128 + d0;
#pragma unroll
                    for (int bj = 0; bj < 2; ++bj) { const int d = 32 * bj + 8 * fq; f32x4 o0, o1;
                        if (sec == 0) {
#pragma unroll
                            for (int r = 0; r < 4; ++r) { o0[r] = siluf(acc[ai][bj][m][0][r]); o1[r] = siluf(acc[ai][bj][m][1][r]); }
                            st_bf8((bf16*)(ws + WS_HQ) + hrow + d, o0, o1); }
                        else if (sec == 1) {
#pragma unroll
                            for (int r = 0; r < 4; ++r) { o0[r] = lbv[bj][0][r] + (1.0f - lbv[bj][0][r]) * sigm(acc[ai][bj][m][0][r]); o1[r] = lbv[bj][1][r] + (1.0f - lbv[bj][1][r]) * sigm(acc[ai][bj][m][1][r]); }
                            float* pf = (float*)(ws + WS_HF) + hrow + d; *(f32x4*)pf = o0; *(f32x4*)(pf + 4) = o1; }
                        else if (sec == 2) st_bf8((bf16*)(ws + WS_HV) + hrow + d, acc[ai][bj][m][0], acc[ai][bj][m][1]);
                        else {
#pragma unroll
                            for (int r = 0; r < 4; ++r) { o0[r] = siluf(acc[ai][bj][m][0][r]); o1[r] = siluf(acc[ai][bj][m][1][r]); }
                            st_bf8((bf16*)(ws + WS_HGS) + (size_t)tok * 512 + cc + d, o0, o1); } } }
        } else {
            float* dst = (float*)(ws + WS_GATE);
            if (fq < 3) {
#pragma unroll
                for (int ai = 0; ai < 2; ++ai)
#pragma unroll
                    for (int m = 0; m < 4; ++m) { const int tok = 256 * u.pm + 128 * ai + 64 * wr + 16 * m + fr; f32x4 o0, o1;
#pragma unroll
                        for (int r = 0; r < 4; ++r) { o0[r] = sigm(acc[ai][0][m][0][r]); o1[r] = sigm(acc[ai][0][m][1][r]); }
                        float* pf = dst + (size_t)tok * 24 + 8 * fq; *(f32x4*)pf = o0; *(f32x4*)(pf + 4) = o1; } }
        }
    }
};

DEV void tr_tile(unsigned char* smem, const float* src0, const float* src1, int ld, int K, int mode, bf16* dst, int n0, int k0) {
    bf16* tl = (bf16*)smem;
    const int tid = TID;
    SYNC();
#pragma unroll
    for (int i = 0; i < 8; ++i) {
        const int e = tid + 512 * i, kk = e >> 6, nn = e & 63, n = n0 + nn; float v = 0.f;
        if (mode == 0) v = src0[(size_t)(k0 + kk) * ld + n];
        else if (mode == 1) { int sc = n < 1280 ? n : (n < 3328 ? n + 24 : (n < 3352 ? 1280 + (n - 3328) : -1)); if (sc >= 0) v = src0[(size_t)(k0 + kk) * ld + sc]; }
        else { const int g = n >> 6, w = n & 63; v = (w < 32) ? src0[(size_t)(k0 + kk) * ld + g * 32 + w] : src1[(size_t)(k0 + kk) * ld + g * 32 + w - 32]; }
        tl[nn * LDT + kk] = (bf16)f2bf(v);
    }
    SYNC();
    const int nn = tid >> 3, k8 = (tid & 7) * 8;
    *(bf16x8*)(dst + (size_t)(n0 + nn) * K + k0 + k8) = *(const bf16x8*)(tl + nn * LDT + k8);
}

DEV int tr_col(int mode, int n) {
    if (mode == 0) return n;
    const int pn = n >> 8, ct = n & 255;
    if (mode == 5) { const int bj = ct >> 7, wc = (ct >> 5) & 3, j = ct & 31, L = 256 * pn + 64 * wc + 32 * bj + j; return L < 1280 ? L : (L < 3328 ? L + 24 : (L < 3352 ? 1280 + (L - 3328) : -1)); }
    { const int bj = ct >> 7, Lc = 128 * pn + (ct & 127); return bj == 0 ? Lc : (mode == 7 ? FF : DM) + Lc; }
}
DEV void tr_tile(unsigned char* smem, const float* src, int ld, int K, int mode, bf16* dst, int n0, int k0) {
    bf16* tl = (bf16*)smem;
    const int tid = TID, nq = tid & 31, kq = tid >> 5;
    const int sc = tr_col(mode, n0 + 4 * nq);
    f32x4 v[4];
#pragma unroll
    for (int i = 0; i < 4; ++i) v[i] = sc >= 0 ? *(const f32x4*)(src + (size_t)(k0 + 4 * kq + i) * ld + sc) : f4zero();
    SYNC();
#pragma unroll
    for (int j = 0; j < 4; ++j) { u32x2 w; w[0] = pk2(v[0][j], v[1][j]); w[1] = pk2(v[2][j], v[3][j]); *(u32x2*)(tl + (4 * nq + j) * LDT + 4 * kq) = w; }
    SYNC();
#pragma unroll
    for (int t = 0; t < 2; ++t) { const int id = tid + 512 * t, row = id >> 3, ch = id & 7;
        *(bf16x8*)(dst + (size_t)(n0 + row) * K + k0 + 8 * ch) = *(const bf16x8*)(tl + row * LDT + 8 * ch); }
}
constexpr int KSUP = FF >= 256 ? 256 : FF, NSUP = KSUP / 64;
DEV void tr_super(unsigned char* smem, const float* src0, const float* src1, int ld, int K, int mode, bf16* dst, int n0, int k0) {
    const int tid = TID, nq = tid & 31, kq = tid >> 5;
    int sc = n0 + 4 * nq; const float* src = src0;
    if (mode == 7) { const int cc = tr_col(7, sc); src = cc >= FF ? src1 : src0; sc = cc >= FF ? cc - FF : cc; }
    f32x4 v[NSUP][4];
#pragma unroll
    for (int sb = 0; sb < NSUP; ++sb)
#pragma unroll
        for (int i = 0; i < 4; ++i) v[sb][i] = *(const f32x4*)(src + (size_t)(k0 + 64 * sb + 4 * kq + i) * ld + sc);
    SYNC();
    const int fw = nq & (KSUP / 16 - 1);
#pragma unroll
    for (int j = 0; j < 4; ++j)
#pragma unroll
        for (int sb = 0; sb < NSUP; ++sb) { const int c16 = 8 * sb + (kq >> 1); u32x2 w; w[0] = pk2(v[sb][0][j], v[sb][1][j]); w[1] = pk2(v[sb][2][j], v[sb][3][j]);
            *(u32x2*)(smem + (4 * nq + j) * (KSUP * 2) + ((c16 ^ fw) << 4) + (kq & 1) * 8) = w; }
    SYNC();
#pragma unroll
    for (int t = 0; t < 128 * (KSUP / 8) / NT; ++t) { const int id = tid + NT * t, row = id / (KSUP / 8), ch = id % (KSUP / 8), f = (row >> 2) & (KSUP / 16 - 1);
        *(bf16x8*)(dst + (size_t)(n0 + row) * K + k0 + 8 * (ch ^ f)) = *(const bf16x8*)(smem + row * (KSUP * 2) + ch * 16); }
}
constexpr int MOE_S13 = (2 * FF / 128) * (DM / KSUP), MOE_S2 = (DM / 128) * (FF / KSUP), MOE_SPE = MOE_S13 + MOE_S2, MOE_NIT = DEPTH * 32 * MOE_SPE;
DEV void moe_conv_tile(const Args& a, unsigned char* smem, int it) {
    unsigned char* ws = wsp(a); const int le = it / MOE_SPE, r = it % MOE_SPE;
    if (r < MOE_S13) { const int tn = r % (2 * FF / 128), tk = r / (2 * FF / 128);
        tr_super(smem, INP(a, I_W1) + (size_t)le * DM * FF, INP(a, I_W3) + (size_t)le * DM * FF, FF, DM, 7, (bf16*)(ws + WS_W13) + (size_t)le * 2 * FF * DM, tn * 128, tk * KSUP); }
    else { const int r2 = r - MOE_S13, tn = r2 % (DM / 128), tk = r2 / (DM / 128);
        tr_super(smem, INP(a, I_W2) + (size_t)le * FF * DM, INP(a, I_W2), DM, FF, 0, (bf16*)(ws + WS_W2) + (size_t)le * DM * FF, tn * 128, tk * KSUP); }
}
#ifndef EMU
constexpr int MOE_TAIL_Q = 3;
constexpr int MOE_N0 = MOE_NIT - 2 * MOE_TAIL_Q * (128 + 224) > 2 * 32 * MOE_SPE ? MOE_NIT - 2 * MOE_TAIL_Q * (128 + 224) : 2 * 32 * MOE_SPE;
DEV int moe_conv_fetch(const Args& a, unsigned char* smem) {
    int* ctr = (int*)(wsp(a) + WS_BAR) + P0_CTR_IDX; int* nxl = (int*)(smem + 72 * 1024);
    SYNC(); if (TID == 0) nxl[0] = atomic_add_i(ctr, 1); SYNC(); return nxl[0];
}
DEV void moe_conv_pull(const Args& a, unsigned char* smem, int quota) {
    for (int q = 0; q < quota; ++q) { const int it = moe_conv_fetch(a, smem); if (it >= MOE_NIT) break; moe_conv_tile(a, smem, it); }
    SYNC();
}
DEV void moe_conv_drain(const Args& a, unsigned char* smem, int limit) {
    __attribute__((address_space(1))) unsigned* ctr = (__attribute__((address_space(1))) unsigned*)((unsigned*)(wsp(a) + WS_BAR) + P0_CTR_IDX);
    for (;;) { if ((int)__builtin_amdgcn_readfirstlane((int)__hip_atomic_load(ctr, __ATOMIC_RELAXED, __HIP_MEMORY_SCOPE_AGENT)) >= limit) break;
        const int it = moe_conv_fetch(a, smem); if (it >= MOE_NIT) break; moe_conv_tile(a, smem, it); }
    SYNC();
}
#endif
struct TrJob { const float* s; int ld, K, N, mode; bf16* dst; };
DEV void p0_phase(const Args& a, unsigned char* smem) {
    unsigned char* ws = wsp(a); const int tid = TID;
    { int item = BID, base = 0;
      for (int j = 0; j < 8; ++j) { TrJob J; const int i = j & 1;
        if (j < 2) J = {INP(a, I_WIN) + (size_t)i * DM * NIN, NIN, DM, NIN8, 5, (bf16*)(ws + WS_WIN) + (size_t)i * NIN8 * DM};
        else if (j < 4) J = {INP(a, I_WOUT) + (size_t)i * 1024 * DM, DM, 1024, DM, 0, (bf16*)(ws + WS_WOUT) + (size_t)i * DM * 1024};
        else if (j < 6) J = {INP(a, I_PW1) + (size_t)i * DM * 2 * DM, 2 * DM, DM, 2 * DM, 6, (bf16*)(ws + WS_PW1) + (size_t)i * 2 * DM * DM};
        else J = {INP(a, I_PW2) + (size_t)i * DM * DM, DM, DM, DM, 0, (bf16*)(ws + WS_PW2) + (size_t)i * DM * DM};
        const int tn = J.N / 128, tk = J.K / 64, nt = tn * tk;
        while (item < base + nt) { const int it = item - base; tr_tile(smem, J.s, J.ld, J.K, J.mode, J.dst, (it % tn) * 128, (it / tn) * 64); item += NBLK; }
        base += nt; }
      SYNC(); }
    {
        float* red = (float*)smem;
        constexpr int NG = 6 * DM / 128; const int ntask = DEPTH * NG;
        for (int t = BID; t < ntask; t += NBLK) {
            const int l = t / NG, j0 = (t % NG) * 128, cq = tid & 31, kr = tid >> 5;
            const float* w = INP(a, I_ADAW) + (size_t)l * DM * 6 * DM + j0 + 4 * cq; const float* cc = INP(a, I_C);
            f32x4 a0 = f4zero(), a1 = f4zero();
#pragma unroll 8
            for (int i = 0; i < DM / 16; ++i) { const int k = kr + 16 * i; const f32x4 wv = *(const f32x4*)(w + (size_t)k * 6 * DM); const float s0 = siluf(cc[k]), s1 = siluf(cc[DM + k]);
#pragma unroll
                for (int r = 0; r < 4; ++r) { a0[r] += s0 * wv[r]; a1[r] += s1 * wv[r]; } }
            SYNC();
            *(f32x4*)(red + (kr * 2 + 0) * 128 + 4 * cq) = a0; *(f32x4*)(red + (kr * 2 + 1) * 128 + 4 * cq) = a1;
            SYNC();
            if (tid < 256) { const int b = tid >> 7, col = tid & 127; float sum = INP(a, I_ADAB)[(size_t)l * 6 * DM + j0 + col];
#pragma unroll
                for (int q = 0; q < 16; ++q) sum += red[(q * 2 + b) * 128 + col];
                ((float*)(ws + WS_MOD))[((size_t)l * 2 + b) * 6 * DM + j0 + col] = sum; }
        }
    }
    for (int t = BID; t < 32; t += NBLK) {
        float* red = (float*)smem; const int ikv = t >> 3, kp = t & 7, i = ikv >> 1, kv = ikv & 1, e = tid & 63, ks = tid >> 6;
        const float* W = INP(a, kv ? I_CWV : I_CWK) + (size_t)i * 2048 * 64 + e; const float* pe = INP(a, I_CPE) + (size_t)i * 2048;
        float sum = 0.f;
#pragma unroll 8
        for (int q = 0; q < 32; ++q) { const int k = kp * 256 + ks * 32 + q; sum += pe[k] * W[(size_t)k * 64]; }
        SYNC(); red[ks * 64 + e] = sum; SYNC();
        if (tid < 64) { float v = 0.f; for (int q = 0; q < 8; ++q) v += red[q * 64 + tid]; ((float*)(ws + WS_CB))[(ikv * 8 + kp) * 64 + tid] = v; }
    }
    for (int i = BID * NT + tid; i < DEPTH * 48 * DM; i += NBLK * NT) { const int k = i % DM, n = (i / DM) % 48, ll = i / (48 * DM);
        const float wv = n < 4 ? INP(a, I_WG)[((size_t)ll * DM + k) * 4 + n] : (n < 36 ? INP(a, I_WE)[((size_t)ll * DM + k) * 32 + n - 4] : 0.f);
        const unsigned hi = f2bf(wv); ((bf16*)(ws + WS_WTH))[i] = (bf16)hi; ((bf16*)(ws + WS_WTL))[i] = (bf16)f2bf(wv - bf2f(hi)); }
    if (BID == 0) {
        for (int i = tid; i < DEPTH * 32; i += NT) ((int*)(ws + WS_CNT))[i * 64] = 0;
        for (int i = tid; i < DEPTH * 256; i += NT) ((unsigned*)(ws + WS_FLG))[i * 16] = 0u;
        for (int n = tid; n < 512; n += NT) { const float l0 = INP(a, I_LBL)[n], l1 = INP(a, I_LBL)[512 + n]; const float m = fmaxf(l0, l1);
            const float e0 = fexp2((l0 - m) * LOG2E), e1 = fexp2((l1 - m) * LOG2E);
            ((float*)(ws + WS_LB))[n] = 0.f; ((float*)(ws + WS_LB))[512 + n] = e1 / (e0 + e1); }
        if (tid < 2) { const int i = tid; float mq = 0.f; for (int d = 0; d < 64; ++d) mq = fmaxf(mq, fabsf(INP(a, I_QG)[i * 64 + d]));
            for (int br = 0; br < 3; ++br) { float mk = 0.f; for (int d = 0; d < 64; ++d) mk = fmaxf(mk, fabsf(INP(a, I_KG)[(i * 3 + br) * 64 + d]));
                ((float*)(ws + WS_CS))[i * 4 + br] = 8.0f * mq * mk * LOG2E; } }
    }
    SYNC();
    {
#ifdef EMU
      for (int it = BID; it < MOE_NIT; it += NBLK) moe_conv_tile(a, smem, it);
#else
      int* ctr = (int*)(ws + WS_BAR) + P0_CTR_IDX; int* nxl = (int*)(smem + 72 * 1024);
      int my_next = 0; if (tid == 0) my_next = atomic_add_i(ctr, 1);
      for (;;) { if (tid == 0) nxl[0] = my_next; SYNC(); const int it = nxl[0]; if (it >= MOE_NIT) break;
          const bool more = it < MOE_N0;
          if (more && tid == 0) my_next = atomic_add_i(ctr, 1);
          moe_conv_tile(a, smem, it);
          if (!more) break; }
#endif
      SYNC(); }
}

constexpr int NJV = DM / 256;
DEV void moe_bases(const int* cnt, int* rb  ) {
    if (TID == 0) { int acc = 0; for (int e = 0; e < 32; ++e) { rb[e] = acc; acc += ((cnt[e * 64] + 255) >> 8) << 8; } rb[32] = acc; }
    SYNC();
}
DEV void norm_phase(const Args& a, unsigned char* smem, int l) {
    unsigned char* ws = wsp(a); const int tid = TID, w = tid >> 6, lane = tid & 63;
    int* rb = (int*)smem;
    if (l > 0) moe_bases((const int*)(ws + WS_CNT) + (l - 1) * 32 * 64, rb);
    const float* mod = (const float*)(ws + WS_MOD);
    const bf16* yk = (const bf16*)(ws + WS_YK);
    if (l < DEPTH) {
        const int bid = BID % 76 == BID ? BID : -1;
        for (int job = BID; job < 76; job += NBLK) {
            if (job < 72) { const int b = job / 36, n = job % 36; float sum = 0.f;
                for (int k = tid; k < DM; k += NT) { const float wv = n < 4 ? INP(a, I_WG)[((size_t)l * DM + k) * 4 + n] : INP(a, I_WE)[((size_t)l * DM + k) * 32 + n - 4]; sum += mod[((size_t)l * 2 + b) * 6 * DM + 3 * DM + k] * wv; }
#pragma unroll
                for (int q = 1; q < 64; q <<= 1) sum += shflx(sum, q);
                float* red = (float*)(smem + 1024);
                SYNC(); if (lane == 0) red[w] = sum; SYNC();
                if (tid == 0) { float t = 0.f; for (int q = 0; q < 8; ++q) t += red[q]; ((float*)(ws + WS_RBIAS))[((size_t)l * 2 + b) * 48 + n] = t; }
            } else { const float* nf = INP(a, I_NFFN) + (size_t)l * DM; const int part = job - 72;
                for (int i = part * (2 * DM / 4) + tid; i < (part + 1) * (2 * DM / 4); i += NT) { const int b = i / DM, k = i % DM; ((float*)(ws + WS_AVEC))[((size_t)l * 2 + b) * DM + k] = nf[k] * (1.0f + mod[((size_t)l * 2 + b) * 6 * DM + 4 * DM + k]); } }
        }
        (void)bid;
    }
    const int rstride = NBLK * 8;
    for (int rowa = BID * 8 + w; rowa < T; rowa += 2 * rstride) {
        int row[2]; bool ok[2];
        row[0] = rowa; ok[0] = true; row[1] = rowa + rstride; ok[1] = row[1] < T; if (!ok[1]) row[1] = rowa;
        f32x4 v[2][NJV]; int e0[2], p0[2], e1[2], p1[2]; float w0[2], w1[2];
        const float* xin = (l == 0) ? INP(a, I_X) : outp(a);
#pragma unroll
        for (int q = 0; q < 2; ++q) {
#pragma unroll
            for (int j = 0; j < NJV; ++j) v[q][j] = *(const f32x4*)(xin + (size_t)row[q] * DM + 4 * lane + 256 * j);
            if (l > 0) { const int* tie = (const int*)(ws + WS_TIE) + (size_t)row[q] * 2; const float* tiw = (const float*)(ws + WS_TIW) + (size_t)row[q] * 2;
                e0[q] = tie[0] >> 14; p0[q] = tie[0] & 16383; e1[q] = tie[1] >> 14; p1[q] = tie[1] & 16383; w0[q] = tiw[0]; w1[q] = tiw[1]; } }
        if (l > 0) {
            u32x2 q0[2][NJV], q1[2][NJV];
#pragma unroll
            for (int q = 0; q < 2; ++q) { const bf16* y0 = yk + (size_t)(rb[e0[q]] + p0[q]) * DM; const bf16* y1 = yk + (size_t)(rb[e1[q]] + p1[q]) * DM;
#pragma unroll
                for (int j = 0; j < NJV; ++j) { const int cidx = 4 * lane + 256 * j; q0[q][j] = *(const u32x2*)(y0 + cidx); q1[q][j] = *(const u32x2*)(y1 + cidx); } }
#pragma unroll
            for (int q = 0; q < 2; ++q) { const int b = row[q] / SEQ; const float* gf = mod + ((size_t)(l - 1) * 2 + b) * 6 * DM + 5 * DM;
#pragma unroll
                for (int j = 0; j < NJV; ++j) { const int cidx = 4 * lane + 256 * j; const f32x4 g = *(const f32x4*)(gf + cidx);
                    v[q][j][0] += g[0] * (w0[q] * bf2f(q0[q][j][0] & 0xffff) + w1[q] * bf2f(q1[q][j][0] & 0xffff));
                    v[q][j][1] += g[1] * (w0[q] * bf2f(q0[q][j][0] >> 16) + w1[q] * bf2f(q1[q][j][0] >> 16));
                    v[q][j][2] += g[2] * (w0[q] * bf2f(q0[q][j][1] & 0xffff) + w1[q] * bf2f(q1[q][j][1] & 0xffff));
                    v[q][j][3] += g[3] * (w0[q] * bf2f(q0[q][j][1] >> 16) + w1[q] * bf2f(q1[q][j][1] >> 16)); } }
        }
        if (l > 0)
#pragma unroll
        for (int q = 0; q < 2; ++q) { if (!ok[q]) continue;
#pragma unroll
            for (int j = 0; j < NJV; ++j) *(f32x4*)(outp(a) + (size_t)row[q] * DM + 4 * lane + 256 * j) = v[q][j]; }
        if (l == DEPTH) continue;
        float ss[2];
#pragma unroll
        for (int q = 0; q < 2; ++q) { ss[q] = 0.f;
#pragma unroll
            for (int j = 0; j < NJV; ++j) ss[q] += v[q][j][0] * v[q][j][0] + v[q][j][1] * v[q][j][1] + v[q][j][2] * v[q][j][2] + v[q][j][3] * v[q][j][3]; }
#pragma unroll
        for (int o = 1; o < 64; o <<= 1) { ss[0] += shflx(ss[0], o); ss[1] += shflx(ss[1], o); }
        const float* nm = INP(a, I_NMIX) + (size_t)l * DM;
#pragma unroll
        for (int q = 0; q < 2; ++q) { if (!ok[q]) continue;
            const int b = row[q] / SEQ; const float rs = frsq(ss[q] * (1.0f / DM) + EPS);
            const float* mm = mod + ((size_t)l * 2 + b) * 6 * DM; bf16* hb = (bf16*)(ws + WS_H) + (size_t)row[q] * DM;
#pragma unroll
            for (int j = 0; j < NJV; ++j) { const int cidx = 4 * lane + 256 * j; f32x4 g = *(const f32x4*)(nm + cidx), sh = *(const f32x4*)(mm + cidx), sc = *(const f32x4*)(mm + DM + cidx), o;
#pragma unroll
                for (int r = 0; r < 4; ++r) o[r] = v[q][j][r] * rs * g[r] * (1.0f + sc[r]) + sh[r];
                st_bf4(hb + cidx, o); } }
    }
}

DEV void route_phase(const Args& a, unsigned char* smem, int l) {
    unsigned char* ws = wsp(a); const int tid = TID, w = tid >> 6, lane = tid & 63, h = lane >> 4, c = lane & 15, pi = w >> 1, kh = w & 1;
    constexpr int NCHK = 4, CH = DM / NCHK, WLD = CH + 8, NKS = CH / 2 / 32;
    constexpr int WTOT = 48 * (CH / 8), WMAX = (WTOT + NT - 1) / NT;
    bf16* WHl = (bf16*)smem; bf16* WLl = WHl + 48 * WLD;
    float* lg = (float*)(WLl + 48 * WLD);
    float* ssb = lg + 4 * 2 * 16 * 48;
    float* rsb = ssb + 4 * 2 * 16;
    int* lcnt = (int*)(rsb + 64); int* lbase = lcnt + 32; int* tinfo = lbase + 32;
    float* avl = (float*)(tinfo + 256); float* cvl = avl + 2 * DM;
    const float* mod = (const float*)(ws + WS_MOD);
    SYNC();
    if (tid < 32) lcnt[tid] = 0;
    for (int i = tid; i < 2 * DM; i += NT) { const int b = i / DM, k = i % DM; avl[i] = ((const float*)(ws + WS_AVEC))[((size_t)l * 2 + b) * DM + k]; cvl[i] = mod[((size_t)l * 2 + b) * 6 * DM + 3 * DM + k]; }
    const bf16* WH = (const bf16*)(ws + WS_WTH) + (size_t)l * 48 * DM; const bf16* WL = (const bf16*)(ws + WS_WTL) + (size_t)l * 48 * DM;
    int* cnt = (int*)(ws + WS_CNT) + l * 32 * 64;
    for (int pass0 = BID; pass0 < T / 16; pass0 += 4 * NBLK) {
        const int pass = pass0 + pi * NBLK; const bool valid = pass < T / 16;
        const int tok = valid ? pass * 16 + c : 0, b = tok / SEQ;
        const float* xrow = outp(a) + (size_t)tok * DM;
        f32x4 xv[2][NKS][2]; bf16x8 wh[WMAX], wl[WMAX];
#pragma unroll
        for (int ks = 0; ks < NKS; ++ks) { const float* xq = xrow + kh * (CH / 2) + 8 * h + 32 * ks; xv[0][ks][0] = *(const f32x4*)xq; xv[0][ks][1] = *(const f32x4*)(xq + 4); }
#pragma unroll
        for (int t = 0; t < WMAX; ++t) { const int i = tid + NT * t; if (i < WTOT) { const int n = i / (CH / 8), k8 = (i % (CH / 8)) * 8; wh[t] = *(const bf16x8*)(WH + (size_t)n * DM + k8); wl[t] = *(const bf16x8*)(WL + (size_t)n * DM + k8); } }
        f32x4 acc[3] = {f4zero(), f4zero(), f4zero()}; float ss = 0.f;
        bf16x8 uhk[NCHK * NKS];
#pragma unroll
        for (int chn = 0; chn < NCHK; ++chn) {
            SYNC();
#pragma unroll
            for (int t = 0; t < WMAX; ++t) { const int i = tid + NT * t; if (i < WTOT) { const int n = i / (CH / 8), k8 = (i % (CH / 8)) * 8; *(bf16x8*)(WHl + n * WLD + k8) = wh[t]; *(bf16x8*)(WLl + n * WLD + k8) = wl[t]; } }
            SYNC();
            if (chn + 1 < NCHK) {
#pragma unroll
                for (int ks = 0; ks < NKS; ++ks) { const float* xq = xrow + (chn + 1) * CH + kh * (CH / 2) + 8 * h + 32 * ks; xv[(chn + 1) & 1][ks][0] = *(const f32x4*)xq; xv[(chn + 1) & 1][ks][1] = *(const f32x4*)(xq + 4); }
#pragma unroll
                for (int t = 0; t < WMAX; ++t) { const int i = tid + NT * t; if (i < WTOT) { const int n = i / (CH / 8), k8 = (i % (CH / 8)) * 8; wh[t] = *(const bf16x8*)(WH + (size_t)n * DM + (chn + 1) * CH + k8); wl[t] = *(const bf16x8*)(WL + (size_t)n * DM + (chn + 1) * CH + k8); } }
            }
            if (valid) {
                const bf16* whp = WHl + c * WLD + kh * (CH / 2) + 8 * h; const bf16* wlp = WLl + c * WLD + kh * (CH / 2) + 8 * h;
                const float* ap = avl + b * DM + chn * CH + kh * (CH / 2) + 8 * h;
#pragma unroll
                for (int ks = 0; ks < NKS; ++ks) {
                    const f32x4 a0 = *(const f32x4*)(ap + 32 * ks), a1 = *(const f32x4*)(ap + 32 * ks + 4);
                    const f32x4 x0 = xv[chn & 1][ks][0], x1 = xv[chn & 1][ks][1];
                    f32x4 u0, u1, r0, r1;
#pragma unroll
                    for (int r = 0; r < 4; ++r) { u0[r] = x0[r] * a0[r]; u1[r] = x1[r] * a1[r]; ss += x0[r] * x0[r] + x1[r] * x1[r]; }
                    const bf16x8 uh = pack8(u0, u1); uhk[chn * NKS + ks] = uh;
#pragma unroll
                    for (int r = 0; r < 4; ++r) { r0[r] = u0[r] - bf2f((unsigned short)uh[r]); r1[r] = u1[r] - bf2f((unsigned short)uh[4 + r]); }
                    const bf16x8 ul = pack8(r0, r1);
#pragma unroll
                    for (int nt = 0; nt < 3; ++nt) { const bf16x8 whf = *(const bf16x8*)(whp + nt * 16 * WLD + 32 * ks), wlf = *(const bf16x8*)(wlp + nt * 16 * WLD + 32 * ks);
                        acc[nt] = mfma16(whf, uh, acc[nt]); acc[nt] = mfma16(wlf, uh, acc[nt]); acc[nt] = mfma16(whf, ul, acc[nt]); }
                }
            }
        }
        if (valid) {
            ss += shflx(ss, 16); ss += shflx(ss, 32);
            float* lgp = lg + ((pi * 2 + kh) * 16 + c) * 48 + 4 * h;
#pragma unroll
            for (int nt = 0; nt < 3; ++nt) *(f32x4*)(lgp + 16 * nt) = acc[nt];
            if (h == 0) ssb[(pi * 2 + kh) * 16 + c] = ss;
        }
        SYNC();
        if (tid < 64) { const int p2 = tid >> 4, tk = tid & 15, pass2 = pass0 + p2 * NBLK;
            if (pass2 < T / 16) { const int tok2 = pass2 * 16 + tk, b2 = tok2 / SEQ;
                const float rs = frsq((ssb[(p2 * 2 + 0) * 16 + tk] + ssb[(p2 * 2 + 1) * 16 + tk]) * (1.0f / DM) + EPS); rsb[p2 * 16 + tk] = rs;
                const float* l0 = lg + ((p2 * 2 + 0) * 16 + tk) * 48; const float* l1 = lg + ((p2 * 2 + 1) * 16 + tk) * 48; const float* rbp = (const float*)(ws + WS_RBIAS) + ((size_t)l * 2 + b2) * 48;
                float acc[36];
#pragma unroll
                for (int n = 0; n < 36; ++n) acc[n] = rs * (l0[n] + l1[n]) + rbp[n];
                int gs = 0; float gm = acc[0];
#pragma unroll
                for (int g = 1; g < 4; ++g) if (acc[g] > gm) { gm = acc[g]; gs = g; }
                float den = 0.f;
#pragma unroll
                for (int g = 0; g < 4; ++g) den += fexp2((acc[g] - gm) * LOG2E);
                const float ggate = 1.0f / den;
                float el[8];
#pragma unroll
                for (int j = 0; j < 8; ++j) { el[j] = acc[4 + j];
#pragma unroll
                    for (int g = 1; g < 4; ++g) if (gs == g) el[j] = acc[4 + 8 * g + j]; }
                int ia = 0; float va = el[0];
#pragma unroll
                for (int j = 1; j < 8; ++j) if (el[j] > va) { va = el[j]; ia = j; }
                int ib = -1; float vb = -3e38f;
#pragma unroll
                for (int j = 0; j < 8; ++j) if (j != ia && el[j] > vb) { vb = el[j]; ib = j; }
                const float wa = 1.0f / (1.0f + fexp2((vb - va) * LOG2E)), wb = 1.0f - wa;
                const int e0 = gs * 8 + ia, e1 = gs * 8 + ib;
                const int p0 = atomic_add_i(lcnt + e0, 1), p1 = atomic_add_i(lcnt + e1, 1);
                int* ti = tinfo + tid * 4;
                ti[0] = (e0 << 14) | p0; ti[1] = (e1 << 14) | p1; ti[2] = __builtin_bit_cast(int, ggate * wa); ti[3] = __builtin_bit_cast(int, ggate * wb);
            } }
        SYNC();
        int gbase = 0;
        if (tid < 32) { const int n = lcnt[tid]; gbase = n > 0 ? atomic_add_i(cnt + tid * 64, n) : 0; }
        if (valid) { const float rs = rsb[pi * 16 + c]; bf16* hb = (bf16*)(ws + WS_H) + (size_t)tok * DM + kh * (CH / 2) + 8 * h;
            const float* cp = cvl + b * DM + kh * (CH / 2) + 8 * h;
#pragma unroll
            for (int chn = 0; chn < NCHK; ++chn)
#pragma unroll
                for (int ks = 0; ks < NKS; ++ks) {
                    const bf16x8 uh = uhk[chn * NKS + ks]; const f32x4 c0 = *(const f32x4*)(cp + chn * CH + 32 * ks), c1 = *(const f32x4*)(cp + chn * CH + 32 * ks + 4);
                    f32x4 o0, o1;
#pragma unroll
                    for (int r = 0; r < 4; ++r) { o0[r] = bf2f((unsigned short)uh[r]) * rs + c0[r]; o1[r] = bf2f((unsigned short)uh[4 + r]) * rs + c1[r]; }
                    st_bf8(hb + chn * CH + 32 * ks, o0, o1); } }
        if (tid < 32) { lbase[tid] = gbase; lcnt[tid] = 0; }
        SYNC();
        if (tid < 64) { const int p2 = tid >> 4, pass2 = pass0 + p2 * NBLK;
            if (pass2 < T / 16) { const int tok2 = pass2 * 16 + (tid & 15); const int* ti = tinfo + tid * 4;
                const int e0 = ti[0] >> 14, e1 = ti[1] >> 14, p0 = lbase[e0] + (ti[0] & 16383), p1 = lbase[e1] + (ti[1] & 16383);
                int* list = (int*)(ws + WS_LIST); list[(size_t)e0 * T + p0] = tok2; list[(size_t)e1 * T + p1] = tok2;
                int* tie = (int*)(ws + WS_TIE) + (size_t)tok2 * 2; int* tiw = (int*)(ws + WS_TIW) + (size_t)tok2 * 2;
                tie[0] = (e0 << 14) | p0; tie[1] = (e1 << 14) | p1; tiw[0] = ti[2]; tiw[1] = ti[3]; } }
        SYNC();
    }
}

DEV int vbid() { const int g = NBLK; return (g % 8 == 0) ? (BID % 8) * (g / 8) + BID / 8 : BID; }
#ifdef EMU
#define PG8_LDS(p) (p)
#else
#define PG8_LDS(p) ((PG8_LAS unsigned char*)(p))
#endif
DEV void inproj_phase(const Args& a, unsigned char* smem, int li) {
    pg8::Gemm g{(const bf16*)(wsp(a) + WS_H), (const bf16*)(wsp(a) + WS_WIN) + (size_t)li * NIN8 * DM, T, NIN8, DM}; pg8::StaticOrder S; S.init(T, NIN8, NBLK, BID);
    EpiInProj8 E{&a, li};
    SYNC(); pg8::gemm_phase<EpiInProj8, pg8::StaticOrder, true, true>(PG8_LDS(smem), g, S, E); SYNC();
#ifndef EMU
    { pg8::Unit u; const int full = (T / 256) * (NIN8 / 256) / NBLK; if (!S.next(full, u)) moe_conv_pull(a, smem, MOE_TAIL_Q); }
#endif
}
DEV void resid_gemm_phase(const Args& a, unsigned char* smem, const bf16* A, int K, const bf16* Bt, int l) {
    pg8::Gemm g{A, Bt, T, DM, K}; pg8::StaticOrder S; S.init(T, DM, NBLK, BID);
    EpiResid8 E{outp(a), (const float*)(wsp(a) + WS_MOD) + (size_t)l * 2 * 6 * DM + 2 * DM, l == 0 ? INP(a, I_X) : (const float*)outp(a)};
    SYNC(); pg8::gemm_phase<EpiResid8, pg8::StaticOrder, true, true>(PG8_LDS(smem), g, S, E); SYNC();
}
DEV void pw1_phase(const Args& a, unsigned char* smem, int li) {
    pg8::Gemm g{(const bf16*)(wsp(a) + WS_H), (const bf16*)(wsp(a) + WS_PW1) + (size_t)li * 2 * DM * DM, T, 2 * DM, DM}; pg8::StaticOrder S; S.init(T, 2 * DM, NBLK, BID);
    EpiGlu8 E{(bf16*)(wsp(a) + WS_GLU)};
    SYNC(); pg8::gemm_phase<EpiGlu8, pg8::StaticOrder, true, true>(PG8_LDS(smem), g, S, E); SYNC();
}
DEV void cmp_phase_items(const Args& a, unsigned char* smem, int li, int it) {
    constexpr int TMC = (NCP + 255) / 256;
    const int kv = it / (4 * TMC), bg = (it / TMC) % 4, tm = it % TMC;
    const bf16* src = (const bf16*)(wsp(a) + (kv ? WS_VCG : WS_KCG)) + (size_t)bg * SEQ * 64;
    struct AF { const bf16* base; int m0; MDEV unsigned off(int r) const { int n = m0 + r; if (n > NCMP - 1) n = NCMP - 1; return (unsigned)n * 1024u; } } af{src, tm * 256};
    EpiCmp E{&a, kv, bg, tm * 256, li};
    BClamp64 bf{INP(a, kv ? I_CWV : I_CWK) + (size_t)li * 2048 * 64};
    gemm_tile2(smem, af, bf, 64, 2048, E);
}
#ifdef EMU
DEV void wt_store64(void* p, unsigned long long v) { *(unsigned long long*)p = v; }
DEV unsigned ctr_add(unsigned* p, unsigned v) { return __atomic_fetch_add(p, v, __ATOMIC_SEQ_CST); }
DEV void acq_fence() {}
DEV void drain_stores() {}
typedef unsigned* ctr_ptr;
#else
DEV void wt_store64(void* p, unsigned long long v) { __hip_atomic_store((__attribute__((address_space(1))) unsigned long long*)p, v, __ATOMIC_RELAXED, __HIP_MEMORY_SCOPE_AGENT); }
typedef __attribute__((address_space(1))) unsigned* ctr_ptr;
DEV unsigned ctr_add(ctr_ptr p, unsigned v) { return __hip_atomic_fetch_add(p, v, __ATOMIC_RELAXED, __HIP_MEMORY_SCOPE_AGENT); }
DEV void acq_fence() { __builtin_amdgcn_fence(__ATOMIC_ACQUIRE, "agent"); }
DEV void drain_stores() { asm volatile("s_waitcnt vmcnt(0)" ::: "memory"); }
#endif
struct EpiCmpPart { float* P;
    MDEV void operator()(f32x4 (&acc)[4][4], int mw, int nw, int h, int c) const {
        if (nw != 0) return;
        const int idx = mw + 16 * h + c;
#pragma unroll
        for (int ni = 0; ni < 4; ++ni)
#pragma unroll
            for (int mi = 0; mi < 4; ++mi) { float* p = P + ((size_t)(ni * 4 + mi) * 256 + idx) * 4;
                const u32x4 u = __builtin_bit_cast(u32x4, acc[ni][mi]);
                wt_store64(p, (unsigned long long)u[0] | ((unsigned long long)u[1] << 32));
                wt_store64(p + 2, (unsigned long long)u[2] | ((unsigned long long)u[3] << 32)); }
    }
};
DEV void cmp_split_item(const Args& a, unsigned char* smem, int li, int item, ctr_ptr tilec) {
    constexpr int TMC = (NCP + 255) / 256, S = CMP_SPLIT, KP = 2048 / S;
    unsigned char* ws = wsp(a);
    const int tile = item / S, sp = item % S;
    const int kv = tile / (4 * TMC), bg = (tile / TMC) % 4, tm = tile % TMC;
    const bf16* src = (const bf16*)(ws + (kv ? WS_VCG : WS_KCG)) + (size_t)bg * SEQ * 64;
    struct AF { const bf16* base; int m0; MDEV unsigned off(int r) const { int n = m0 + r; if (n > NCMP - 1) n = NCMP - 1; return (unsigned)n * 1024u; } } af{src + sp * KP, tm * 256};
    float* Pt = (float*)(ws + WS_CMPP) + (size_t)tile * S * 16 * 256 * 4;
    EpiCmpPart E{Pt + (size_t)sp * 16 * 256 * 4};
    BClamp64 bf{INP(a, kv ? I_CWV : I_CWK) + (size_t)li * 2048 * 64 + (size_t)sp * KP * 64};
    gemm_tile2(smem, af, bf, 64, KP, E);
    drain_stores(); SYNC();
    int* fl = (int*)(smem + LDS_BYTES - 128);
    if (TID == 0) fl[0] = (int)ctr_add(tilec + tile, 1u);
    SYNC();
    if (fl[0] == S - 1) {
        acq_fence();
        const int tid = TID, w = tid >> 6, l = tid & 63, h = l >> 4, c = l & 15, wm = w >> 1, wn = w & 1;
        f32x4 acc[4][4];
#pragma unroll
        for (int i = 0; i < 4; ++i)
#pragma unroll
            for (int j = 0; j < 4; ++j) acc[i][j] = f4zero();
        if (wn == 0) { const int idx = wm * 64 + l;
#pragma unroll 1
            for (int s2 = 0; s2 < S; ++s2) { const float* P = Pt + (size_t)s2 * 16 * 256 * 4;
#pragma unroll
                for (int q = 0; q < 16; ++q) { const f32x4 v = *(const f32x4*)(P + ((size_t)q * 256 + idx) * 4);
#pragma unroll
                    for (int r = 0; r < 4; ++r) acc[q >> 2][q & 3][r] += v[r]; } } }
        EpiCmp E2{&a, kv, bg, tm * 256, li};
        E2(acc, wm * 64, wn * 64, h, c);
    }
    SYNC();
}
DEV void moe_gemm_phase8(const Args& a, unsigned char* smem, int l, int mode) {
    unsigned char* ws = wsp(a); const int* cnt = (const int*)(ws + WS_CNT) + l * 32 * 64;
    int* rb = (int*)(smem + 140 * 1024);
    moe_bases(cnt, rb);
    const int mrows = rb[32];
    if (mode == 0) {
        pg8::Gemm g{(const bf16*)(ws + WS_H), (const bf16*)(ws + WS_W13) + (size_t)l * 32 * 2 * FF * DM, mrows, 2 * FF, DM}; pg8::StaticOrder S; S.init(mrows, 2 * FF, NBLK, BID);
        EpiMoe1_8 E{(bf16*)(ws + WS_ACT)}; MoeSel<true> X{rb, cnt, (const int*)(ws + WS_LIST), (size_t)2 * FF * DM * 2};
        SYNC(); pg8::gemm_phase<EpiMoe1_8, pg8::StaticOrder, true, true, MoeSel<true>>(PG8_LDS(smem), g, S, E, X); SYNC();
    } else {
        pg8::Gemm g{(const bf16*)(ws + WS_ACT), (const bf16*)(ws + WS_W2) + (size_t)l * 32 * DM * FF, mrows, DM, FF}; pg8::StaticOrder S; S.init(mrows, DM, NBLK, BID);
        EpiMoe2_8 E{(bf16*)(ws + WS_YK)}; MoeSel<false> X{rb, cnt, (const int*)(ws + WS_LIST), (size_t)DM * FF * 2};
        SYNC(); pg8::gemm_phase<EpiMoe2_8, pg8::StaticOrder, true, true, MoeSel<false>>(PG8_LDS(smem), g, S, E, X); SYNC();
    }
}
#ifndef EMU
constexpr int MOE_TMO_IDX = 128;
struct MoeOrder { int nN, t0, nu, j, nper, nA; bool rev;
    __device__ __forceinline__ void init(int ntile, int nN_, int nblk, int bid, bool rev_) { nN = nN_; nper = nblk / 8; rev = rev_; const int x = bid % 8; j = bid / 8;
        t0 = x * ntile / 8; nu = ((x + 1) * ntile / 8 - t0) * nN; if (bid >= 8 * nper) nu = 0;
        nA = nu - 2 * nper; nA = nA < 0 ? 0 : (nA > nper / 2 ? nper / 2 : nA); }
    __device__ __forceinline__ bool next(int i, pg8::Unit& u) const { int p;
        if (!rev) p = i * nper + j;
        else if (j < nA) { if (i > 0) return false; p = nu - nA + j; }
        else { p = i * (nper - nA) + (j - nA); if (p >= nu - nA) return false; }
        if (p >= nu) return false; u.pm = t0 + p / nN; u.pn = p % nN; return true; }
    __device__ __forceinline__ void a_ready(const pg8::Unit&) const {}
    __device__ __forceinline__ void done(const pg8::Unit&) const {}
};
struct MoeProd : MoeOrder { unsigned* flg;
    __device__ __forceinline__ void done(const pg8::Unit& u) const {
        asm volatile("s_waitcnt vmcnt(0)" ::: "memory"); __builtin_amdgcn_s_barrier(); asm volatile("" ::: "memory");
        if (TID == 0) (void)__hip_atomic_fetch_add((__attribute__((address_space(1))) unsigned*)(flg + u.pm * 16), 1u, __ATOMIC_RELAXED, __HIP_MEMORY_SCOPE_AGENT); } };
struct MoeCons : MoeOrder { unsigned* flg; unsigned* tmo;
    __device__ __forceinline__ void a_ready(const pg8::Unit& u) const {
        if ((TID >> 6) == 0) { unsigned sp = 0u; __attribute__((address_space(1))) unsigned* f = (__attribute__((address_space(1))) unsigned*)(flg + u.pm * 16);
            while ((unsigned)__builtin_amdgcn_readfirstlane((int)__hip_atomic_load(f, __ATOMIC_RELAXED, __HIP_MEMORY_SCOPE_AGENT)) < (unsigned)(2 * FF / 256)) {
                __builtin_amdgcn_s_sleep(1);
                if ((++sp & 255u) == 0u) { if (__hip_atomic_load((__attribute__((address_space(1))) unsigned*)tmo, __ATOMIC_RELAXED, __HIP_MEMORY_SCOPE_AGENT)) break;
                    if (sp > (1u << 22)) { (void)__hip_atomic_fetch_add((__attribute__((address_space(1))) unsigned*)tmo, 1u, __ATOMIC_RELAXED, __HIP_MEMORY_SCOPE_AGENT); break; } } }
            __builtin_amdgcn_fence(__ATOMIC_ACQUIRE, "agent"); }
        asm volatile("" ::: "memory"); __builtin_amdgcn_s_barrier(); asm volatile("" ::: "memory"); } };
DEV void moe_fused_phase(const Args& a, unsigned char* smem, int l) {
    unsigned char* ws = wsp(a); const int* cnt = (const int*)(ws + WS_CNT) + l * 32 * 64;
    int* rb = (int*)(smem + 140 * 1024);
    moe_bases(cnt, rb);
    const int mrows = rb[32]; unsigned* flg = (unsigned*)(ws + WS_FLG) + (size_t)l * 256 * 16;
    { pg8::Gemm g{(const bf16*)(ws + WS_H), (const bf16*)(ws + WS_W13) + (size_t)l * 32 * 2 * FF * DM, mrows, 2 * FF, DM}; MoeProd S; S.init(mrows >> 8, 2 * FF / 256, NBLK, BID, false); S.flg = flg;
      EpiMoe1_8 E{(bf16*)(ws + WS_ACT)}; MoeSel<true> X{rb, cnt, (const int*)(ws + WS_LIST), (size_t)2 * FF * DM * 2};
      SYNC(); pg8::gemm_phase<EpiMoe1_8, MoeProd, true, true, MoeSel<true>>(PG8_LDS(smem), g, S, E, X); }
    { pg8::Gemm g{(const bf16*)(ws + WS_ACT), (const bf16*)(ws + WS_W2) + (size_t)l * 32 * DM * FF, mrows, DM, FF}; MoeCons S; S.init(mrows >> 8, DM / 256, NBLK, BID, true); S.flg = flg; S.tmo = (unsigned*)(ws + WS_BAR) + MOE_TMO_IDX;
      EpiMoe2_8 E{(bf16*)(ws + WS_YK)}; MoeSel<false> X{rb, cnt, (const int*)(ws + WS_LIST), (size_t)DM * FF * 2};
      SYNC(); pg8::gemm_phase<EpiMoe2_8, MoeCons, true, true, MoeSel<false>>(PG8_LDS(smem), g, S, E, X); SYNC(); }
}
#endif
DEV void moe_gemm_phase(const Args& a, unsigned char* smem, int l, int mode) {
    unsigned char* ws = wsp(a); const int* cnt = (const int*)(ws + WS_CNT) + l * 32 * 64;
    int* rb = (int*)(smem + GEMM2_LDS);
    moe_bases(cnt, rb);
    const int ntile = rb[32] >> 8;
    constexpr int TN1 = 2 * FF / 128, TN2 = DM / 128;
    const int TN = mode == 0 ? TN1 : TN2;
    const int* list = (const int*)(ws + WS_LIST);
    for (int it = vbid(); it < ntile * TN; it += NBLK) {
        const int rt = it / TN, tn = it % TN; int e = 0;
#pragma unroll 1
        for (int q = 1; q < 32; ++q) if ((rb[q] >> 8) <= rt) e = q;
        const int rloc = (rt << 8) - rb[e], ce = cnt[e * 64], nvalid = (ce - rloc) < 256 ? (ce - rloc) : 256;
        if (mode == 0) {
            struct AF { const bf16* base; const int* lst; int nv; MDEV unsigned off(int r) const { const int rr = r < nv ? r : nv - 1; return (unsigned)lst[rr] * (unsigned)DM; } }
                af{(const bf16*)(ws + WS_H), list + (size_t)e * T + rloc, nvalid};
            EpiGated<1> E{(bf16*)(ws + WS_ACT), (size_t)FF, rt << 8, tn * 128, nvalid};
            BInter bf{INP(a, I_W1) + (size_t)(l * 32 + e) * DM * FF, INP(a, I_W3) + (size_t)(l * 32 + e) * DM * FF, tn * 128};
            gemm_tile2(smem, af, bf, FF, DM, E);
        } else {
            ARows af{(const bf16*)(ws + WS_ACT) + (size_t)(rt << 8) * FF, (size_t)FF};
            EpiStoreBf E{(bf16*)(ws + WS_YK), (size_t)DM, rt << 8, tn * 128, nvalid};
            BPlain bf{INP(a, I_W2) + (size_t)(l * 32 + e) * FF * DM + tn * 128};
            gemm_tile2(smem, af, bf, DM, FF, E);
        }
    }
}

constexpr int LDV = 80;
constexpr int AT_K = 0, AT_V = 2 * 64 * LDT * 2, AT_IMP = AT_V + 2 * 64 * LDV * 2, AT_V4 = 4 * 64 * LDT * 2, AT_KV4_END = AT_V4 + 4 * 64 * LDV * 2,
              AT_SEL = (AT_IMP + 8 * 8 * 128 * 4 > AT_KV4_END ? AT_IMP + 8 * 8 * 128 * 4 : AT_KV4_END), AT_GSEL = AT_SEL + 8 * 8 * 4 * 4, AT_OUT = AT_GSEL + 8 * 2 * 4 * 4, AT_END = AT_OUT + 8 * 32 * 64 * 4;
#ifdef EMU
DEV float rexp2(float x) { return exp2f(x); }
DEV unsigned uni(unsigned x) { return x; }
#else
DEV float rexp2(float x) { return __builtin_amdgcn_exp2f(x); }
DEV unsigned uni(unsigned x) { return (unsigned)__builtin_amdgcn_readfirstlane((int)x); }
#endif
DEV int krow_lds(int kappa) { return 16 * (2 * (kappa >> 5) + ((kappa >> 2) & 1)) + 4 * ((kappa >> 3) & 3) + (kappa & 3); }
template <int MASK, bool FULL, int GM>
DEV void attn_block(const bf16* Kp, const bf16* Vp, const bf16x8 (&qf)[2][2], int j, const int (&s)[2], const bool (&selbit)[2], float C2, int h, int c,
                    f32x4 (&O)[2][4], f32x4 (&Ol)[2]) {
    f32x4 st[2][2][2];
#pragma unroll
    for (int sp = 0; sp < 2; ++sp)
#pragma unroll
        for (int u = 0; u < 2; ++u) {
#pragma unroll
            for (int G = 0; G < 2; ++G) { st[G][sp][u][0] = -C2; st[G][sp][u][1] = -C2; st[G][sp][u][2] = -C2; st[G][sp][u][3] = -C2; }
#pragma unroll
            for (int ks = 0; ks < 2; ++ks) { const bf16x8 kf = *(const bf16x8*)(Kp + (16 * (2 * sp + u) + c) * LDT + 32 * ks + 8 * h);
#pragma unroll
                for (int G = 0; G < 2; ++G) if (GM & (1 << G)) st[G][sp][u] = mfma16(kf, qf[G][ks], st[G][sp][u]); } }
#pragma unroll
    for (int G = 0; G < 2; ++G) if (GM & (1 << G))
#pragma unroll
        for (int sp = 0; sp < 2; ++sp)
#pragma unroll
            for (int u = 0; u < 2; ++u)
#pragma unroll
                for (int r = 0; r < 4; ++r) { bool ok = selbit[G];
                    if (!FULL) { const int key = 64 * j + 32 * sp + 8 * h + 4 * u + r;
                        if (MASK == 0) ok = 16 * key + 31 <= s[G]; else if (MASK == 1) ok = selbit[G] && key <= s[G]; else ok = key <= s[G] && key > s[G] - 512; }
                    st[G][sp][u][r] = ok ? rexp2(st[G][sp][u][r]) : 0.f; }
    bf16x8 pb[2][2], ones;
#pragma unroll
    for (int q = 0; q < 8; ++q) ones[q] = (short)0x3F80;
#pragma unroll
    for (int G = 0; G < 2; ++G) if (GM & (1 << G))
#pragma unroll
        for (int sp = 0; sp < 2; ++sp) { pb[G][sp] = pack8(st[G][sp][0], st[G][sp][1]); Ol[G] = mfma16(ones, pb[G][sp], Ol[G]); }
    const bf16* Vb = Vp + bperm(8 * h + (c >> 2)) * LDV + 4 * (c & 3);
#pragma unroll
    for (int et = 0; et < 4; ++et)
#pragma unroll
        for (int sp = 0; sp < 2; ++sp) { const bf16x8 vf = tr_read8(Vb + (32 * sp) * LDV + 16 * et, Vb + (32 * sp + 8) * LDV + 16 * et);
#pragma unroll
            for (int G = 0; G < 2; ++G) if (GM & (1 << G)) O[G][et] = mfma16(vf, pb[G][sp], O[G][et]); }
}

struct ImpState { float invq[2][4]; float carry[2]; float* imps; int tl, hd, l, s0, qblk; };
DEV void imp_block(const bf16* Kp, const bf16x8 (&qf)[2][2], int j, int s0, int w, float C2, int h, int c, ImpState& im) {
#pragma unroll
    for (int kt = 0; kt < 4; ++kt) {
        const int row = krow_lds(16 * kt + c);
        const bf16x8 k0 = *(const bf16x8*)(Kp + row * LDT + 8 * h), k1 = *(const bf16x8*)(Kp + row * LDT + 32 + 8 * h);
        const int n = 64 * j + 16 * kt + c;
#pragma unroll
        for (int G = 0; G < 2; ++G) {
            f32x4 acc; acc[0] = -C2; acc[1] = -C2; acc[2] = -C2; acc[3] = -C2;
            acc = mfma16(qf[G][0], k0, acc); acc = mfma16(qf[G][1], k1, acc);
            const bool ok = 16 * n + 31 <= s0 + 8 * w + 4 * G + h;
            float imp = 0.f;
#pragma unroll
            for (int r = 0; r < 4; ++r) imp += ok ? rexp2(acc[r]) * im.invq[G][r] : 0.f;
            const float v = ((c & 3) == 3) ? imp : 2.0f * imp;
            float sq = v + shflx(v, 1); sq += shflx(sq, 2);
            const float rr = dpp_ror1(imp);
            const float prev = (c == 0) ? im.carry[G] : rr;
            im.carry[G] = rr;
            const int m = n >> 2;
            if ((c & 3) == 0 && m < 128) im.imps[(G * 4 + h) * 128 + m] = sq + prev;
        }
    }
}

template <int MODE>
DEV void attn_branch(bf16* Kl, bf16* Vl, const bf16* kbase, const bf16* vbase, int jlo, int jhi,
                     const bf16x8 (&qf)[2][2], const int (&s)[2], const unsigned* selm, const unsigned* gselm, float C2, int w, int h, int c, int srow, int scol,
                     f32x4 (&O)[2][4], f32x4 (&Ol)[2], ImpState& im) {
    constexpr bool PV = MODE != 1; constexpr int MASK = MODE <= 1 ? 0 : MODE - 1;
    const int krow = krow_lds(srow) * LDT + scol, vrow = bperm(srow) * LDV + scol;
    bf16x8 rk[3], rv[3];
    { const bf16x8 k0 = *(const bf16x8*)(kbase + (size_t)jlo * 4096); *(bf16x8*)(Kl + krow) = k0;
      if (PV) { const bf16x8 v0 = *(const bf16x8*)(vbase + (size_t)jlo * 4096); *(bf16x8*)(Vl + vrow) = v0; } }
#pragma unroll
    for (int u = 0; u < 3; ++u) { int jj = jlo + 1 + u; if (jj > jhi) jj = jhi; rk[(1 + u) % 3] = *(const bf16x8*)(kbase + (size_t)jj * 4096); if (PV) rv[(1 + u) % 3] = *(const bf16x8*)(vbase + (size_t)jj * 4096); }
    SYNC();
    for (int jb = jlo; jb <= jhi; jb += 3) {
#pragma unroll
        for (int u = 0; u < 3; ++u) { const int j = jb + u;
            if (j <= jhi) {
                const int cur = (j - jlo) & 1;
                const bf16* Kc = Kl + cur * 64 * LDT; const bf16* Vc = Vl + cur * 64 * LDV;
                if (MODE == 1) imp_block(Kc, qf, j, im.s0, w, C2, h, c, im);
                else {
                    bool sb[2] = {true, true}; unsigned gm = 3u;
                    if (MODE == 2) { gm = 0u;
#pragma unroll
                        for (int G = 0; G < 2; ++G) { const unsigned wq = uni(gselm[G * 4 + (j >> 5)]), mq = selm[(G * 4 + im.tl) * 4 + (j >> 5)];
                            gm |= ((wq >> (j & 31)) & 1u) << G; sb[G] = (mq >> (j & 31)) & 1u; } }
                    bool full;
                    if (MODE == 0) full = 1024 * j + 1039 <= im.s0; else if (MODE == 2) full = j < im.qblk; else full = (j < im.qblk) && (64 * j > im.s0 + 63 - 512);
                    if (MODE == 2) {
                        if (full) { if (gm == 3u) attn_block<MASK, true, 3>(Kc, Vc, qf, j, s, sb, C2, h, c, O, Ol); else if (gm == 1u) attn_block<MASK, true, 1>(Kc, Vc, qf, j, s, sb, C2, h, c, O, Ol); else if (gm == 2u) attn_block<MASK, true, 2>(Kc, Vc, qf, j, s, sb, C2, h, c, O, Ol); }
                        else { if (gm == 3u) attn_block<MASK, false, 3>(Kc, Vc, qf, j, s, sb, C2, h, c, O, Ol); else if (gm == 1u) attn_block<MASK, false, 1>(Kc, Vc, qf, j, s, sb, C2, h, c, O, Ol); else if (gm == 2u) attn_block<MASK, false, 2>(Kc, Vc, qf, j, s, sb, C2, h, c, O, Ol); }
                    } else { if (full) attn_block<MASK, true, 3>(Kc, Vc, qf, j, s, sb, C2, h, c, O, Ol); else attn_block<MASK, false, 3>(Kc, Vc, qf, j, s, sb, C2, h, c, O, Ol); }
                }
                if (j + 1 <= jhi) {
                    *(bf16x8*)(Kl + (cur ^ 1) * 64 * LDT + krow) = rk[(u + 1) % 3]; if (PV) *(bf16x8*)(Vl + (cur ^ 1) * 64 * LDV + vrow) = rv[(u + 1) % 3];
                    int jj = j + 4; if (jj > jhi) jj = jhi;
                    rk[(u + 1) % 3] = *(const bf16x8*)(kbase + (size_t)jj * 4096); if (PV) rv[(u + 1) % 3] = *(const bf16x8*)(vbase + (size_t)jj * 4096);
                }
                SYNC();
            }
        }
    }
}

template <int MODE>
DEV void attn_branch2(bf16* Kp, bf16* Vp, const bf16* kbase, const bf16* vbase, int jlo, int jhi,
                      const bf16x8 (&qf)[2][2], const int (&s)[2], const unsigned* selm, const unsigned* gselm, float C2, int h, int c, int srow, int scol,
                      f32x4 (&O)[2][4], f32x4 (&Ol)[2], ImpState& im) {
    constexpr int MASK = MODE - 1;
    const int krow = krow_lds(srow) * LDT + scol, vrow = bperm(srow) * LDV + scol;
    const int np = (jhi - jlo + 2) >> 1;
    bf16x8 rk[2][2], rv[2][2];
#pragma unroll
    for (int u = 0; u < 2; ++u) { int j0 = jlo + u; if (j0 > jhi) j0 = jhi;
        const bf16x8 k0 = *(const bf16x8*)(kbase + (size_t)j0 * 4096), v0 = *(const bf16x8*)(vbase + (size_t)j0 * 4096);
        *(bf16x8*)(Kp + u * 64 * LDT + krow) = k0; *(bf16x8*)(Vp + u * 64 * LDV + vrow) = v0; }
#pragma unroll
    for (int q = 1; q <= 2; ++q)
#pragma unroll
        for (int u = 0; u < 2; ++u) { int jj = jlo + 2 * q + u; if (jj > jhi) jj = jhi; rk[q & 1][u] = *(const bf16x8*)(kbase + (size_t)jj * 4096); rv[q & 1][u] = *(const bf16x8*)(vbase + (size_t)jj * 4096); }
    SYNC();
    for (int pb = 0; pb < np; pb += 2) {
#pragma unroll
        for (int pq = 0; pq < 2; ++pq) { const int p = pb + pq;
            if (p < np) {
#pragma unroll
                for (int u = 0; u < 2; ++u) { const int j = jlo + 2 * p + u;
                    if (j <= jhi) {
                        const bf16* Kc = Kp + (2 * pq + u) * 64 * LDT; const bf16* Vc = Vp + (2 * pq + u) * 64 * LDV;
                        bool sb[2] = {true, true}; unsigned gm = 3u;
                        if (MODE == 2) { gm = 0u;
#pragma unroll
                            for (int G = 0; G < 2; ++G) { const unsigned wq = uni(gselm[G * 4 + (j >> 5)]), mq = selm[(G * 4 + im.tl) * 4 + (j >> 5)];
                                gm |= ((wq >> (j & 31)) & 1u) << G; sb[G] = (mq >> (j & 31)) & 1u; } }
                        bool full;
                        if (MODE == 2) full = j < im.qblk; else full = (j < im.qblk) && (64 * j > im.s0 + 63 - 512);
                        if (MODE == 2) {
                            if (full) { if (gm == 3u) attn_block<MASK, true, 3>(Kc, Vc, qf, j, s, sb, C2, h, c, O, Ol); else if (gm == 1u) attn_block<MASK, true, 1>(Kc, Vc, qf, j, s, sb, C2, h, c, O, Ol); else if (gm == 2u) attn_block<MASK, true, 2>(Kc, Vc, qf, j, s, sb, C2, h, c, O, Ol); }
                            else { if (gm == 3u) attn_block<MASK, false, 3>(Kc, Vc, qf, j, s, sb, C2, h, c, O, Ol); else if (gm == 1u) attn_block<MASK, false, 1>(Kc, Vc, qf, j, s, sb, C2, h, c, O, Ol); else if (gm == 2u) attn_block<MASK, false, 2>(Kc, Vc, qf, j, s, sb, C2, h, c, O, Ol); }
                        } else { if (full) attn_block<MASK, true, 3>(Kc, Vc, qf, j, s, sb, C2, h, c, O, Ol); else attn_block<MASK, false, 3>(Kc, Vc, qf, j, s, sb, C2, h, c, O, Ol); }
                    } }
                if (p + 1 < np) {
#pragma unroll
                    for (int u = 0; u < 2; ++u) {
                        *(bf16x8*)(Kp + (2 * (pq ^ 1) + u) * 64 * LDT + krow) = rk[pq ^ 1][u]; *(bf16x8*)(Vp + (2 * (pq ^ 1) + u) * 64 * LDV + vrow) = rv[pq ^ 1][u];
                        int jj = jlo + 2 * (p + 3) + u; if (jj > jhi) jj = jhi;
                        rk[pq ^ 1][u] = *(const bf16x8*)(kbase + (size_t)jj * 4096); rv[pq ^ 1][u] = *(const bf16x8*)(vbase + (size_t)jj * 4096); }
                }
                SYNC();
            }
        }
    }
}

DEV void attn_task(const Args& a, unsigned char* smem, int li, int item) {
    unsigned char* ws = wsp(a); const int tid = TID, w = tid >> 6, l = tid & 63, h = l >> 4, c = l & 15, tl = c >> 2, hd = c & 3;
    const int bg = item & 3, b = bg >> 1, g = bg & 1, tq = (SEQ / 64 - 1) - (item >> 2), s0 = tq * 64, qblk = tq;
    int s[2], row[2];
#pragma unroll
    for (int G = 0; G < 2; ++G) { s[G] = s0 + 8 * w + 4 * G + tl; row[G] = b * SEQ + s[G]; }
    bf16* Kl = (bf16*)(smem + AT_K); bf16* Vl = (bf16*)(smem + AT_V); float* imps = (float*)(smem + AT_IMP) + w * 1024; unsigned* selm = (unsigned*)(smem + AT_SEL) + w * 32;
    bf16x8 qf[2][2]; float gatec[2], gates[2], gatew[2];
#pragma unroll
    for (int G = 0; G < 2; ++G) { const bf16* qp = (const bf16*)(ws + WS_QN) + (size_t)row[G] * 512 + (g * 4 + hd) * 64 + 8 * h; qf[G][0] = *(const bf16x8*)qp; qf[G][1] = *(const bf16x8*)(qp + 32);
        const float* gp = (const float*)(ws + WS_GATE) + (size_t)row[G] * 24 + (g * 4 + hd) * 3; gatec[G] = gp[0]; gates[G] = gp[1]; gatew[G] = gp[2]; }
    const float* cs = (const float*)(ws + WS_CS) + li * 4;
    const int srow = tid >> 3, scol = (tid & 7) * 8;
    for (int i = l; i < 1024; i += 64) imps[i] = 0.f;
    SYNC();
    unsigned* gselm = (unsigned*)(smem + AT_GSEL) + w * 8; float* outl = (float*)(smem + AT_OUT) + w * 2048 + l;
    ImpState im{{{0.f, 0.f, 0.f, 0.f}, {0.f, 0.f, 0.f, 0.f}}, {0.f, 0.f}, imps, tl, hd, l, s0, qblk};
    {
        const int ncv = s0 / 16 + 3, ncb0 = (ncv + 63) >> 6, ncb = ncb0 > NCP / 64 ? NCP / 64 : ncb0;
        const bf16* kcb = (const bf16*)(ws + WS_KC) + (size_t)bg * NCP * 64 + tid * 8;
        const bf16* vcb = (const bf16*)(ws + WS_VCT) + (size_t)bg * NCP * 64 + tid * 8;
        f32x4 O[2][4], Ol[2] = {f4zero(), f4zero()};
#pragma unroll
        for (int G = 0; G < 2; ++G)
#pragma unroll
            for (int et = 0; et < 4; ++et) O[G][et] = f4zero();
        attn_branch<0>(Kl, Vl, kcb, vcb, 0, ncb - 1, qf, s, selm, gselm, cs[0], w, h, c, srow, scol, O, Ol, im);
#pragma unroll
        for (int G = 0; G < 2; ++G) { const float lsum = Ol[G][0]; const float invl = lsum > 0.f ? 1.0f / lsum : 0.f;
#pragma unroll
            for (int r = 0; r < 4; ++r) im.invq[G][r] = shfl(invl, 4 * h + r);
#pragma unroll
            for (int et = 0; et < 4; ++et)
#pragma unroll
                for (int r = 0; r < 4; ++r) outl[((G * 4 + et) * 4 + r) * 64] = gatec[G] * invl * O[G][et][r]; }
        f32x4 ld[2] = {f4zero(), f4zero()};
        attn_branch<1>(Kl, Vl, kcb, vcb, 0, ncb - 1, qf, s, selm, gselm, cs[0], w, h, c, srow, scol, O, ld, im);
    }
    WSYNC();
#pragma unroll 1
    for (int G = 0; G < 2; ++G) {
        const int tk = l >> 4, i = l & 15; float vals[8];
#pragma unroll
        for (int mm = 0; mm < 8; ++mm) { const int jj = i + 16 * mm; vals[mm] = jj > qblk ? NEGV : ((jj == 0 || jj == qblk || jj == qblk - 1) ? FORCEV : imps[(G * 4 + tk) * 128 + jj]); }
        unsigned mk[4] = {0u, 0u, 0u, 0u};
#pragma unroll 1
        for (int rnd = 0; rnd < 16; ++rnd) {
            float best = vals[0]; int bj = i;
#pragma unroll
            for (int mm = 1; mm < 8; ++mm) if (vals[mm] > best) { best = vals[mm]; bj = i + 16 * mm; }
#pragma unroll
            for (int o = 1; o < 16; o <<= 1) { const float ov = shflx(best, o); const int oj = shflxi(bj, o); if (ov > best || (ov == best && oj < bj)) { best = ov; bj = oj; } }
            if (best > NEGV * 0.5f) {
#pragma unroll
                for (int q = 0; q < 4; ++q) if ((bj >> 5) == q) mk[q] |= 1u << (bj & 31); }
            if ((bj & 15) == i) {
#pragma unroll
                for (int mm = 0; mm < 8; ++mm) if ((bj >> 4) == mm) vals[mm] = -3e38f; }
        }
        if (i == 0) {
#pragma unroll
            for (int q = 0; q < 4; ++q) selm[(G * 4 + tk) * 4 + q] = mk[q]; }
    }
    WSYNC();
    if (l < 8) { const int G = l >> 2, q = l & 3; gselm[l] = selm[(G * 4 + 0) * 4 + q] | selm[(G * 4 + 1) * 4 + q] | selm[(G * 4 + 2) * 4 + q] | selm[(G * 4 + 3) * 4 + q]; }
    WSYNC();
    SYNC();
#pragma unroll
    for (int br = 0; br < 2; ++br) {
        const bf16* kb = (const bf16*)(ws + (br == 0 ? WS_KS : WS_KW)) + (size_t)bg * SEQ * 64 + tid * 8; const bf16* vb = (const bf16*)(ws + (br == 0 ? WS_VST : WS_VWT)) + (size_t)bg * SEQ * 64 + tid * 8;
        f32x4 O[2][4], Ol[2] = {f4zero(), f4zero()};
#pragma unroll
        for (int G = 0; G < 2; ++G)
#pragma unroll
            for (int et = 0; et < 4; ++et) O[G][et] = f4zero();
        bf16* Kp = (bf16*)(smem + AT_K); bf16* Vp = (bf16*)(smem + AT_V4);
        if (br == 0) attn_branch2<2>(Kp, Vp, kb, vb, 0, qblk, qf, s, selm, gselm, cs[1], h, c, srow, scol, O, Ol, im);
        else attn_branch2<3>(Kp, Vp, kb, vb, s0 >= 511 ? (s0 - 511) >> 6 : 0, qblk, qf, s, selm, gselm, cs[2], h, c, srow, scol, O, Ol, im);
#pragma unroll
        for (int G = 0; G < 2; ++G) { const float lsum = Ol[G][0]; const float sc = (br == 0 ? gates[G] : gatew[G]) * (lsum > 0.f ? 1.0f / lsum : 0.f);
#pragma unroll
            for (int et = 0; et < 4; ++et)
#pragma unroll
                for (int r = 0; r < 4; ++r) outl[((G * 4 + et) * 4 + r) * 64] += sc * O[G][et][r]; }
    }
#pragma unroll
    for (int G = 0; G < 2; ++G) { bf16* dst = (bf16*)(ws + WS_CAT) + (size_t)row[G] * 1024 + (g * 4 + hd) * 64 + 4 * h;
#pragma unroll
        for (int et = 0; et < 4; ++et) { f32x4 o;
#pragma unroll
            for (int r = 0; r < 4; ++r) o[r] = outl[((G * 4 + et) * 4 + r) * 64];
            st_bf4(dst + 16 * et, o); } }
}

constexpr int LDH = 136;
DEV void hg_cumsum(const float* fsrc  , float* segs  , int d, int seg, float (&f)[16], float (&bc)[16], float& bend, float& bmid) {
    float run = 0.f;
#pragma unroll
    for (int i = 0; i < 16; ++i) { f[i] = fsrc[(size_t)(16 * seg + i) * 128 + d]; run += log2f(f[i]); bc[i] = run; }
    SYNC();
    segs[seg * 128 + d] = run;
    SYNC();
    const float s0 = segs[d], s1 = segs[128 + d], s2 = segs[256 + d], s3 = segs[384 + d];
    const float off = seg == 0 ? 0.f : (seg == 1 ? s0 : (seg == 2 ? s0 + s1 : s0 + s1 + s2));
#pragma unroll
    for (int i = 0; i < 16; ++i) bc[i] += off;
    bend = s0 + s1 + s2 + s3; bmid = s0 + s1;
}
DEV void hg_write16(bf16* dstrow  , const float (&v)[16]) {
    u32x4 w0, w1;
#pragma unroll
    for (int q = 0; q < 4; ++q) { w0[q] = pk2(v[2 * q], v[2 * q + 1]); w1[q] = pk2(v[8 + 2 * q], v[8 + 2 * q + 1]); }
    *(u32x4*)dstrow = w0; *(u32x4*)(dstrow + 8) = w1;
}
DEV void hg_h1_task(const Args& a, unsigned char* smem, int task) {
    unsigned char* ws = wsp(a); const int tid = TID, w = tid >> 6, l = tid & 63, h = l >> 4, c = l & 15, d = tid & 127, seg = tid >> 7;
    const int bh = task / NCH, ch = task % NCH;
    bf16* kT = (bf16*)smem; bf16* vT = kT + 128 * LDT; float* segs = (float*)(vT + 128 * LDT);
    const size_t tokb = (size_t)bh * SEQ + ch * 64;
    float f[16], bc[16], bend, bmid;
    const bf16* vs = (const bf16*)(ws + WS_HV) + tokb * 128;
    bf16 vraw[16];
#pragma unroll
    for (int i = 0; i < 16; ++i) vraw[i] = vs[(size_t)(16 * seg + i) * 128 + d];
    hg_cumsum((const float*)(ws + WS_HF) + tokb * 128, segs, d, seg, f, bc, bend, bmid);
    float kv[16];
#pragma unroll
    for (int i = 0; i < 16; ++i) kv[i] = (1.0f - f[i]) * fexp2(bend - bc[i]);
    hg_write16(kT + d * LDT + 16 * seg, kv);
#pragma unroll
    for (int i = 0; i < 16; ++i) kv[i] = bf2f(vraw[i]);
    hg_write16(vT + d * LDT + 16 * seg, kv);
    if (seg == 0) ((float*)(ws + WS_GD))[((size_t)bh * NCH + ch) * 128 + d] = fexp2(bend);
    SYNC();
    f32x4 acc[8];
#pragma unroll
    for (int et = 0; et < 8; ++et) acc[et] = f4zero();
#pragma unroll
    for (int ks = 0; ks < 2; ++ks) { const bf16x8 fa = *(const bf16x8*)(kT + (16 * w + c) * LDT + 32 * ks + 8 * h);
#pragma unroll
        for (int et = 0; et < 8; ++et) acc[et] = mfma16(fa, *(const bf16x8*)(vT + (16 * et + c) * LDT + 32 * ks + 8 * h), acc[et]); }
    float* ut = (float*)(ws + WS_UT) + ((size_t)bh * NCH + ch) * 16384;
#pragma unroll
    for (int et = 0; et < 8; ++et) *(f32x4*)(ut + (size_t)(16 * et + c) * 128 + 16 * w + 4 * h) = acc[et];
    SYNC();
}
DEV void hg_scan_task(const Args& a, int sc) {
    unsigned char* ws = wsp(a); const int bh = sc >> 3, q = (sc & 7) * 512 + TID, e = q >> 5, d0 = (q & 31) * 4;
    const float* ut = (const float*)(ws + WS_UT) + (size_t)bh * NCH * 16384 + (size_t)e * 128 + d0;
    const float* gd = (const float*)(ws + WS_GD) + (size_t)bh * NCH * 128 + d0;
    bf16* st = (bf16*)(ws + WS_ST) + (size_t)bh * NCH * 16384 + (size_t)e * 128 + d0;
    f32x4 S = f4zero();
#pragma unroll 4
    for (int ch = 0; ch < NCH; ++ch) { st_bf4(st + (size_t)ch * 16384, S);
        const f32x4 g = *(const f32x4*)(gd + (size_t)ch * 128), u = *(const f32x4*)(ut + (size_t)ch * 16384);
#pragma unroll
        for (int r = 0; r < 4; ++r) S[r] = g[r] * S[r] + u[r]; }
}
DEV void hg_h3_task(const Args& a, unsigned char* smem, int li, int task) {
    unsigned char* ws = wsp(a); const int tid = TID, w = tid >> 6, l = tid & 63, h = l >> 4, c = l & 15, d = tid & 127, seg = tid >> 7;
    const int bh = task / NCH, ch = task % NCH, b = bh >> 2, hh = bh & 3;
    bf16* At = (bf16*)smem; bf16* Bt = At + 64 * LDH; bf16* Qt = Bt + 64 * LDH; bf16* vT = Qt + 64 * LDH; float* segs = (float*)(vT + 128 * LDT); float* part = segs + 512;
    const size_t tokb = (size_t)bh * SEQ + ch * 64;
    float f[16], bc[16], bend, bmid;
    const bf16* qs = (const bf16*)(ws + WS_HQ) + tokb * 128; const bf16* vs = (const bf16*)(ws + WS_HV) + tokb * 128;
    const int tt = w & 3, eh = w >> 2;
    bf16 qraw[16], vraw[16];
#pragma unroll
    for (int i = 0; i < 16; ++i) { const int t = 16 * seg + i; qraw[i] = qs[(size_t)t * 128 + d]; vraw[i] = vs[(size_t)t * 128 + d]; }
    const bf16* stp = (const bf16*)(ws + WS_ST) + ((size_t)bh * NCH + ch) * 16384;
    bf16x8 stf[4][4];
#pragma unroll
    for (int ks = 0; ks < 4; ++ks)
#pragma unroll
        for (int et = 0; et < 4; ++et) stf[ks][et] = *(const bf16x8*)(stp + (size_t)(64 * eh + 16 * et + c) * 128 + 32 * ks + 8 * h);
    const int tok = b * SEQ + ch * 64 + 16 * tt + c;
    const bf16* hg = (const bf16*)(ws + WS_HGS) + (size_t)tok * 512 + hh * 128;
    u32x2 hgv[4];
#pragma unroll
    for (int et = 0; et < 4; ++et) hgv[et] = *(const u32x2*)(hg + 64 * eh + 16 * et + 4 * h);
    hg_cumsum((const float*)(ws + WS_HF) + tokb * 128, segs, d, seg, f, bc, bend, bmid);
    float vv[16];
#pragma unroll
    for (int i = 0; i < 16; ++i) { const int t = 16 * seg + i; const float q = bf2f(qraw[i]);
        At[t * LDH + d] = (bf16)f2bf(q * fexp2(bc[i] - bmid)); Bt[t * LDH + d] = (bf16)f2bf((1.0f - f[i]) * fexp2(bmid - bc[i])); Qt[t * LDH + d] = (bf16)f2bf(q * fexp2(bc[i]));
        vv[i] = bf2f(vraw[i]); }
    hg_write16(vT + d * LDT + 16 * seg, vv);
    SYNC();
    f32x4 O[4];
#pragma unroll
    for (int et = 0; et < 4; ++et) O[et] = f4zero();
#pragma unroll
    for (int sp = 0; sp < 2; ++sp) {
        if (32 * sp > 16 * tt + 15) continue;
        f32x4 st[2];
#pragma unroll
        for (int u = 0; u < 2; ++u) { st[u] = f4zero(); const int krow = 32 * sp + 8 * (c >> 2) + 4 * u + (c & 3);
#pragma unroll
            for (int ks = 0; ks < 4; ++ks) st[u] = mfma16(*(const bf16x8*)(Bt + krow * LDH + 32 * ks + 8 * h), *(const bf16x8*)(At + (16 * tt + c) * LDH + 32 * ks + 8 * h), st[u]);
#pragma unroll
            for (int r = 0; r < 4; ++r) { const int sk = 32 * sp + 8 * h + 4 * u + r; if (sk > 16 * tt + c) st[u][r] = 0.f; } }
        const bf16x8 pb = pack8(st[0], st[1]);
#pragma unroll
        for (int et = 0; et < 4; ++et) O[et] = mfma16(*(const bf16x8*)(vT + (64 * eh + 16 * et + c) * LDT + 32 * sp + 8 * h), pb, O[et]);
    }
#pragma unroll
    for (int ks = 0; ks < 4; ++ks) { const bf16x8 fq = *(const bf16x8*)(Qt + (16 * tt + c) * LDH + 32 * ks + 8 * h);
#pragma unroll
        for (int et = 0; et < 4; ++et) O[et] = mfma16(stf[ks][et], fq, O[et]); }
    float ss = 0.f;
#pragma unroll
    for (int et = 0; et < 4; ++et)
#pragma unroll
        for (int r = 0; r < 4; ++r) ss += O[et][r] * O[et][r];
    ss += shflx(ss, 16); ss += shflx(ss, 32);
    if (h == 0) part[eh * 64 + 16 * tt + c] = ss;
    SYNC();
    const float rs = frsq((part[16 * tt + c] + part[64 + 16 * tt + c]) * (1.0f / 128.0f) + EPS);
    const float* og = INP(a, I_OG) + li * 128;
    bf16* dst = (bf16*)(ws + WS_CAT) + (size_t)tok * 1024 + 512 + hh * 128;
#pragma unroll
    for (int et = 0; et < 4; ++et) { const int e = 64 * eh + 16 * et + 4 * h; f32x4 o; const f32x4 ogv = *(const f32x4*)(og + e);
        o[0] = O[et][0] * rs * ogv[0] * bf2f(hgv[et][0] & 0xffff); o[1] = O[et][1] * rs * ogv[1] * bf2f(hgv[et][0] >> 16);
        o[2] = O[et][2] * rs * ogv[2] * bf2f(hgv[et][1] & 0xffff); o[3] = O[et][3] * rs * ogv[3] * bf2f(hgv[et][1] >> 16);
        st_bf4(dst + e, o); }
    SYNC();
}

constexpr int CTS = 16;
DEV void conv_task(const Args& a, unsigned char* smem, int li, int task) {
    unsigned char* ws = wsp(a); const int tid = TID, w = tid >> 6, lane = tid & 63;
    const bool act = tid < DM / 2; const int c0 = act ? 2 * tid : 0;
    const int tb = task * 64, b = tb / SEQ, sb = tb % SEQ;
    float* red = (float*)smem;
    const float b0 = INP(a, I_DWB)[li * DM + c0], b1 = INP(a, I_DWB)[li * DM + c0 + 1];
    const float g0 = INP(a, I_LNG)[li * DM + c0], g1 = INP(a, I_LNG)[li * DM + c0 + 1], e0 = INP(a, I_LNB)[li * DM + c0], e1 = INP(a, I_LNB)[li * DM + c0 + 1];
    const bf16* glu = (const bf16*)(ws + WS_GLU) + (size_t)b * SEQ * DM + c0;
    float* lw = (float*)(smem + 4096);
    SYNC();
    for (int i = tid * 4; i < 31 * DM; i += NT * 4) *(f32x4*)(lw + i) = *(const f32x4*)(INP(a, I_DW) + (size_t)li * 31 * DM + i);
    SYNC();
    f32x2v uf[30 + CTS]; unsigned nx[CTS];
    { const bf16* gp = glu + (size_t)(sb - 30) * DM;
#pragma unroll
      for (int r = 0; r < 30; ++r) { const int si = sb + r - 30; const unsigned q = si >= 0 ? *(const unsigned*)gp : 0u; gp += DM; OPAQUE(gp); uf[r][0] = bf2f(q & 0xffff); uf[r][1] = bf2f(q >> 16); }
#pragma unroll
      for (int r = 0; r < CTS; ++r) { nx[r] = *(const unsigned*)gp; gp += DM; OPAQUE(gp); } }
#pragma unroll 1
    for (int step = 0; step < 64 / CTS; ++step) {
        const int s0 = sb + CTS * step, t0 = tb + CTS * step;
#pragma unroll
        for (int r = 0; r < CTS; ++r) { uf[30 + r][0] = bf2f(nx[r] & 0xffff); uf[30 + r][1] = bf2f(nx[r] >> 16); }
        float acc[CTS][2];
        { f32x2v ac2[CTS];
#pragma unroll
          for (int t = 0; t < CTS; ++t) { ac2[t][0] = b0; ac2[t][1] = b1; }
#pragma unroll
          for (int j = 0; j < 31; ++j) { const f32x2v w2 = *(const f32x2v*)(lw + j * DM + c0);
#ifndef EMU
              if ((j & 3) == 3) asm volatile("" ::: "memory");
#endif
#pragma unroll
              for (int t = 0; t < CTS; ++t) ac2[t] += w2 * uf[t + j]; }
#pragma unroll
          for (int t = 0; t < CTS; ++t) { acc[t][0] = ac2[t][0]; acc[t][1] = ac2[t][1]; } }
#pragma unroll
        for (int r = 0; r < 30; ++r) uf[r] = uf[r + CTS];
        if (step < 64 / CTS - 1) { const bf16* gp = glu + (size_t)(s0 + CTS) * DM;
#pragma unroll
            for (int r = 0; r < CTS; ++r) { nx[r] = *(const unsigned*)gp; gp += DM; OPAQUE(gp); } }
        { float* rb2 = red + (step & 1) * (8 * CTS * 2);
#pragma unroll
          for (int t = 0; t < CTS; ++t) { float s1 = act ? acc[t][0] + acc[t][1] : 0.f, s2 = act ? acc[t][0] * acc[t][0] + acc[t][1] * acc[t][1] : 0.f;
              s1 = wave_sum63(s1); s2 = wave_sum63(s2);
              if (lane == 63) { rb2[(w * CTS + t) * 2] = s1; rb2[(w * CTS + t) * 2 + 1] = s2; } }
          SYNC();
          if (act) {
              bf16* dst = (bf16*)(ws + WS_CAT) + (size_t)t0 * DM + c0;
#pragma unroll
              for (int t = 0; t < CTS; ++t) { float s1 = 0.f, s2 = 0.f;
#pragma unroll
                  for (int q = 0; q < 8; ++q) { s1 += rb2[(q * CTS + t) * 2]; s2 += rb2[(q * CTS + t) * 2 + 1]; }
                  const float mean = s1 * (1.0f / DM), var = fmaxf(s2 * (1.0f / DM) - mean * mean, 0.f), rstd = frsq(var + EPS);
                  const float y0 = (acc[t][0] - mean) * rstd * g0 + e0, y1 = (acc[t][1] - mean) * rstd * g1 + e1;
                  *(unsigned*)(dst + (size_t)t * DM) = pk2(siluf(y0), siluf(y1)); }
          } }
    }
}

constexpr int N_PHASES = 1 + 16 * (DEPTH / 2) + 1;
DEV void phase_decode(int ph, int& l, int& sub) {
    const int q = ph - 1, pair = q >> 4, r = q & 15;
    if (r < 9) { l = 2 * pair; sub = r; } else { l = 2 * pair + 1; const int rr = r - 9; sub = rr < 3 ? rr : rr + 2; }
}

DEV void run_phase(const Args& a, unsigned char* smem, int ph) {
#ifndef ONLY
#define ONLY -1
#endif
#define EN(k) (ONLY < 0 || ONLY == (k))
    if (ph == 0) { if (EN(100)) p0_phase(a, smem); return; }
    if (ph == N_PHASES - 1) { if (EN(0)) norm_phase(a, smem, DEPTH); return; }
    int l, sub; phase_decode(ph, l, sub); const int li = l >> 1; const bool even = (l & 1) == 0;
    unsigned char* ws = wsp(a);
    switch (sub) {
    case 0: if (EN(0)) norm_phase(a, smem, l); break;
    case 1: if (even) { if (EN(1)) inproj_phase(a, smem, li); } else { if (EN(11)) pw1_phase(a, smem, li); } break;
    case 2:
        if (even) { constexpr int NCI = 8 * ((NCP + 255) / 256); constexpr int NH1 = 8 * NCH;
#ifndef EMU
            if (NBLK > 2 * NCI * CMP_SPLIT) { const int bid = BID, NCS = NCI * CMP_SPLIT;
                if (bid < NCS) cmp_split_item(a, smem, li, bid, (ctr_ptr)((unsigned*)(ws + WS_BAR) + P0_CTR_IDX + 8 + 16 * li));
                else { for (int it = bid - NCS; it < NH1; it += NBLK - NCS) hg_h1_task(a, smem, it);
                    moe_conv_pull(a, smem, MOE_TAIL_Q); } }
#else
            if (NBLK > 2 * NCI) { const int bid = BID;
                if (bid < NCI) { if (EN(2)) cmp_phase_items(a, smem, li, bid); }
                else { for (int it = bid - NCI; it < NH1; it += NBLK - NCI) if (EN(12)) hg_h1_task(a, smem, it); } }
#endif
            else for (int it = BID; it < NCI + NH1; it += NBLK) { if (it < NCI) { if (EN(2)) cmp_phase_items(a, smem, li, it); } else { if (EN(12)) hg_h1_task(a, smem, it - NCI); } } }
        else { for (int it = BID; it < T / 64; it += NBLK) if (EN(13)) conv_task(a, smem, li, it); }
        break;
#ifdef EMU
    case 3:
        if (even) { constexpr int NA = 4 * (SEQ / 64); const int G = NBLK;
            for (int r = 0; r * G < NA; ++r) { const int it = r * G + ((r & 1) ? (G - 1 - BID) : BID); if (it < NA) { if (EN(3)) attn_task(a, smem, li, it); } }
            for (int it = BID; it < 64; it += NBLK) if (EN(14)) hg_scan_task(a, it); }
        break;
    case 4: if (even) { for (int it = BID; it < 8 * NCH; it += NBLK) if (EN(4)) hg_h3_task(a, smem, li, it); } break;
#else
    case 3:
        if (even) { constexpr int NA = 4 * (SEQ / 64); const int G = NBLK;
            typedef __attribute__((address_space(1))) unsigned gu32;
            gu32* cw = (gu32*)((unsigned*)(ws + WS_BAR) + P0_CTR_IDX + 1 + 2 * li);
            int nsc = 0;
            for (int it = BID; it < 64; it += NBLK) { hg_scan_task(a, it); ++nsc; }
            if (nsc > 0) { __builtin_amdgcn_fence(__ATOMIC_RELEASE, "agent"); asm volatile("s_waitcnt vmcnt(0)" ::: "memory"); SYNC(); if (TID == 0) (void)__hip_atomic_fetch_add(cw, (unsigned)nsc, __ATOMIC_RELAXED, __HIP_MEMORY_SCOPE_AGENT); }
            for (int r = 0; r * G < NA; ++r) { const int it = r * G + ((r & 1) ? (G - 1 - BID) : BID); if (it < NA) attn_task(a, smem, li, it); }
            if ((TID >> 6) == 0) { unsigned sp = 0u; gu32* tmo = (gu32*)((unsigned*)(ws + WS_BAR) + MOE_TMO_IDX);
                while ((unsigned)__builtin_amdgcn_readfirstlane((int)__hip_atomic_load(cw, __ATOMIC_RELAXED, __HIP_MEMORY_SCOPE_AGENT)) < 64u) {
                    __builtin_amdgcn_s_sleep(1);
                    if ((++sp & 255u) == 0u) { if (__hip_atomic_load(tmo, __ATOMIC_RELAXED, __HIP_MEMORY_SCOPE_AGENT)) break; if (sp > (1u << 22)) { (void)__hip_atomic_fetch_add(tmo, 1u, __ATOMIC_RELAXED, __HIP_MEMORY_SCOPE_AGENT); break; } } }
                __builtin_amdgcn_fence(__ATOMIC_ACQUIRE, "agent"); }
            int* nxl = (int*)(smem + LDS_BYTES - 64);
            int my_next = 0; if (TID == 0) my_next = (int)__hip_atomic_fetch_add(cw + 1, 1u, __ATOMIC_RELAXED, __HIP_MEMORY_SCOPE_AGENT);
            for (;;) { SYNC(); if (TID == 0) nxl[0] = my_next; SYNC(); const int it = nxl[0]; if (it >= 8 * NCH) break;
                if (TID == 0) my_next = (int)__hip_atomic_fetch_add(cw + 1, 1u, __ATOMIC_RELAXED, __HIP_MEMORY_SCOPE_AGENT);
                hg_h3_task(a, smem, li, it); } }
        break;
    case 4: break;
#endif
    case 5:
        if (!EN(5)) break;
        if (even) resid_gemm_phase(a, smem, (const bf16*)(ws + WS_CAT), 1024, (const bf16*)(ws + WS_WOUT) + (size_t)li * DM * 1024, l);
        else resid_gemm_phase(a, smem, (const bf16*)(ws + WS_CAT), DM, (const bf16*)(ws + WS_PW2) + (size_t)li * DM * DM, l);
        break;
    case 6:
#ifndef EMU
        if (l >= 1) moe_conv_drain(a, smem, (l + 1) * 32 * MOE_SPE);
#endif
        if (EN(6)) route_phase(a, smem, l); break;
#ifdef EMU
    case 7: if (EN(7)) moe_gemm_phase8(a, smem, l, 0); break;
    case 8: if (EN(8)) moe_gemm_phase8(a, smem, l, 1); break;
#else
    case 7: if (EN(7)) moe_fused_phase(a, smem, l); break;
    case 8: break;
#endif
    }
}

#ifndef EMU
#define LAS __attribute__((address_space(3)))
#define XB_TMO      128
static_assert(MOE_N0 >= 2 * 32 * MOE_SPE && XB_TMO == MOE_TMO_IDX && P0_CTR_IDX > XB_TMO && P0_CTR_IDX + 8 + 16 * (DEPTH / 2) <= 256 && 8 * ((NCP + 255) / 256) == 16, "timeout word / free words");
#define XB_XCNT(j)  (256  + 64 * (j))
#define XB_XSUB(j)  (1280 + 64 * (j))
#define XB_XGEN(j)  (2304 + 64 * (j))
#define XB_TOP      3328
#define XB_TOPGEN   3392
#define XCD_BAR_WORDS 3456
#define XB_SPIN_CAP (1u << 22)
__device__ __forceinline__ unsigned xb_ld(unsigned* p)              { return __hip_atomic_load(p, __ATOMIC_RELAXED, __HIP_MEMORY_SCOPE_AGENT); }
__device__ __forceinline__ unsigned xb_add(unsigned* p, unsigned v) { return __hip_atomic_fetch_add(p, v, __ATOMIC_RELAXED, __HIP_MEMORY_SCOPE_AGENT); }
__device__ __forceinline__ unsigned xb_xcc_id() { return (unsigned)__builtin_amdgcn_s_getreg((3 << 11) | 20) & 0xFu; }
#define XB_SPIN(cond, bar) do { unsigned _sp = 0; while (cond) { __builtin_amdgcn_s_sleep(1); \
    if ((++_sp & 255u) == 0u) { if (xb_ld(&(bar)[XB_TMO])) break; if (_sp > XB_SPIN_CAP) { atomicAdd(&(bar)[XB_TMO], 1u); break; } } } } while (0)
struct XcdBarrier { unsigned* bar; unsigned x; volatile LAS unsigned* st; };
__device__ __forceinline__ XcdBarrier xcd_barrier_post(unsigned* bar, volatile LAS unsigned* st) {
    XcdBarrier b; b.bar = bar; b.x = xb_xcc_id(); b.st = st;
    if (threadIdx.x == 0) (void)xb_add(&bar[XB_XCNT(b.x)], 1u);
    return b;
}
__device__ __forceinline__ void xcd_barrier_complete(unsigned* bar, unsigned x, unsigned& nloc, unsigned& nx) {
    const unsigned G = gridDim.x * gridDim.y * gridDim.z;
    unsigned sum, cnt, mine, sp = 0u;
    for (;;) {
        sum = 0u; cnt = 0u; mine = 0u;
#pragma unroll
        for (unsigned j = 0; j < 16; ++j) { const unsigned c = xb_ld(&bar[XB_XCNT(j)]); sum += c; cnt += (c > 0u) ? 1u : 0u; mine = (j == x) ? c : mine; }
        if (sum == G) break;
        __builtin_amdgcn_s_sleep(1);
        if ((++sp & 255u) == 0u) { if (xb_ld(&bar[XB_TMO])) break; if (sp > XB_SPIN_CAP) { atomicAdd(&bar[XB_TMO], 1u); break; } }
    }
    nloc = mine > 0u ? mine : 1u; nx = cnt > 0u ? cnt : 1u;
}
__device__ __forceinline__ void xcd_barrier(const XcdBarrier& b) {
    asm volatile("s_waitcnt vmcnt(0)" ::: "memory");
    __syncthreads();
    if (threadIdx.x == 0) {
        unsigned* bar = b.bar;
        __builtin_amdgcn_s_waitcnt(0);
        unsigned nloc = b.st[0], nx = b.st[1];
        if (nloc == 0u) { xcd_barrier_complete(bar, b.x, nloc, nx); b.st[0] = nloc; b.st[1] = nx; }
        const unsigned old = xb_add(&bar[XB_XSUB(b.x)], 1u);
        const unsigned gen = old / nloc;
        if (old + 1u == (gen + 1u) * nloc) {
            __builtin_amdgcn_fence(__ATOMIC_RELEASE, "agent");
            asm volatile("s_waitcnt vmcnt(0)" ::: "memory");
            const unsigned og = xb_add(&bar[XB_TOP], 1u);
            const unsigned tg = og / nx;
            if (og + 1u == (tg + 1u) * nx) xb_add(&bar[XB_TOPGEN], 1u);
            else XB_SPIN(xb_ld(&bar[XB_TOPGEN]) == tg, bar);
            __builtin_amdgcn_fence(__ATOMIC_ACQUIRE, "agent");
            xb_add(&bar[XB_XGEN(b.x)], 1u);
            asm volatile("s_waitcnt vmcnt(0)" ::: "memory");
        } else {
            XB_SPIN(xb_ld(&bar[XB_XGEN(b.x)]) == gen, bar);
            __builtin_amdgcn_fence(__ATOMIC_ACQUIRE, "agent");
            asm volatile("s_waitcnt vmcnt(0)" ::: "memory");
        }
    }
    __syncthreads();
}

__global__ void __launch_bounds__(NT, 2) mega(Args a) {
    extern __shared__ __attribute__((aligned(16))) unsigned char lds[];
    volatile LAS unsigned* st = (volatile LAS unsigned*)(LAS unsigned char*)(lds + LDS_BYTES - 16);
    if (threadIdx.x < 4) st[threadIdx.x] = 0u;
    __syncthreads();
    unsigned* barw = (unsigned*)(a.ws + WS_BAR);
    XcdBarrier bar = xcd_barrier_post(barw, st);
#pragma unroll 1
    for (int ph = 0; ph < N_PHASES; ++ph) {
        if (ph > 0 && ph < N_PHASES - 1) { int l_, s_; phase_decode(ph, l_, s_); if (s_ == 8 || (s_ == 4 && (l_ & 1) == 0)) continue; }
        run_phase(a, lds, ph);
#ifdef DUP
        { int lyr = 0, sub = 100; if (ph > 0 && ph < N_PHASES - 1) phase_decode(ph, lyr, sub);
          if (sub == (DUP % 1000) && (ph == 0 || lyr == DUP / 1000) && ph < N_PHASES - 1) { xcd_barrier(bar); run_phase(a, lds, ph); } }
#endif
        if (ph + 1 < N_PHASES) xcd_barrier(bar);
    }
    if (xb_ld(&barw[XB_TMO]) != 0u) {
        const size_t gt = (size_t)blockIdx.x * NT + threadIdx.x, gs = (size_t)gridDim.x * NT;
        for (size_t i = gt; i < (size_t)T * DM; i += gs) a.out[i] = __builtin_nanf("");
    }
}

extern "C" void kernel_launch(void* const* d_in, const int* in_sizes, int n_in, void* d_out, int out_size,
                              void* d_ws, size_t ws_size, hipStream_t stream) {
    static int grid = 0;
    if (grid == 0) {
        int dev = 0, cus = 0;
        if (hipGetDevice(&dev) != hipSuccess || hipDeviceGetAttribute(&cus, hipDeviceAttributeMultiprocessorCount, dev) != hipSuccess) { grid = -1; return; }
        if (hipFuncSetAttribute((const void*)mega, hipFuncAttributeMaxDynamicSharedMemorySize, LDS_BYTES) != hipSuccess) { grid = -1; return; }
        (void)hipGetLastError();
        grid = cus;
        if (n_in != 26 || out_size != T * DM || ws_size < WS_END) { fprintf(stderr, "kernel_launch: unexpected sizes n_in %d out %d ws %zu (need %zu)\n", n_in, out_size, ws_size, (size_t)WS_END); grid = -1; return; }
    }
    if (grid < 0) return;
    (void)hipMemsetAsync((unsigned char*)d_ws + WS_BAR, 0, XCD_BAR_WORDS * 4, stream);
    Args a{};
    for (int i = 0; i < 26; ++i) a.in[i] = (const float*)d_in[i];
    a.out = (float*)d_out; a.ws = (unsigned char*)d_ws;
    hipLaunchKernelGGL(mega, dim3(grid), dim3(NT), LDS_BYTES, stream, a);
}
#endif
```

```cpp
#ifdef EMU
#include "emu.h"
#define DEV static inline
#define MDEV inline
#define OPAQUE(p)
#define OPAQUE2(a, b)
#define TID emu_tid()
#define BID (EB->bid)
#define NBLK (EB->nblk)
#define SYNC() emu_sync_block()
#define WSYNC() emu_sync_wave()
#define mfma16(a, b, c) emu_mfma16(a, b, c)
DEV float shflx(float v, int m) { return emu_shfl_f(v, (emu_tid() & 63) ^ m); }
DEV int shflxi(int v, int m) { return (int)emu_shfl_u((unsigned)v, (emu_tid() & 63) ^ m); }
DEV float shfl(float v, int s) { return emu_shfl_f(v, s); }
DEV float dpp_ror1(float v) { const int l = emu_tid() & 63; return emu_shfl_f(v, (l & 48) | ((l - 1) & 15)); }
DEV float wave_sum63(float v) { for (int o = 1; o < 64; o <<= 1) v += shflx(v, o); return v; }
DEV int atomic_add_i(int* p, int v) { return __atomic_fetch_add(p, v, __ATOMIC_RELAXED); }
typedef float f32x2v __attribute__((vector_size(8)));
DEV float fexp2(float x) { return exp2f(x); }
DEV float frcp(float x) { return 1.0f / x; }
DEV float frsq(float x) { return 1.0f / sqrtf(x); }
typedef short s16x4 __attribute__((vector_size(8)));
static inline s16x4 emu_tr4(const unsigned short* p) {
    EmuWave& w = EB->wave[emu_tid() >> 6]; int l = emu_tid() & 63;
    const unsigned short** tab = (const unsigned short**)w.a;
    tab[l] = p; emu_sync_wave();
    s16x4 r; int g = l & 48, i = l & 15;
    for (int q = 0; q < 4; ++q) r[q] = (short)tab[g + 4 * q + (i >> 2)][i & 3];
    emu_sync_wave(); return r;
}
#define tr4(p) emu_tr4(p)
#else
#include <hip/hip_runtime.h>
#include <cstdio>
#include <cstdint>
typedef short bf16x8 __attribute__((ext_vector_type(8)));
typedef float f32x4 __attribute__((ext_vector_type(4)));
typedef unsigned u32x4 __attribute__((ext_vector_type(4)));
typedef unsigned u32x2 __attribute__((ext_vector_type(2)));
#define DEV __device__ __forceinline__
#define MDEV __device__ __forceinline__
#define OPAQUE(p) asm volatile("" : "+v"(p))
#define OPAQUE2(a, b) asm volatile("" : "+v"(a), "+v"(b))
DEV int tid_opaque() { int t = (int)threadIdx.x; asm volatile("" : "+v"(t)); return t; }
#define TID tid_opaque()
DEV int bid_opaque() { int b = (int)blockIdx.x; asm volatile("" : "+s"(b)); return b; }
#define BID bid_opaque()
#define NBLK ((int)gridDim.x)
#define SYNC() __syncthreads()
#define WSYNC() __builtin_amdgcn_wave_barrier()
#define mfma16(a, b, c) __builtin_amdgcn_mfma_f32_16x16x32_bf16(a, b, c, 0, 0, 0)
DEV int shflxi(int x, int m) {
    if (m == 1) return __builtin_amdgcn_update_dpp(x, x, 0xB1, 0xf, 0xf, true);
    if (m == 2) return __builtin_amdgcn_update_dpp(x, x, 0x4E, 0xf, 0xf, true);
    if (m == 4) return __builtin_amdgcn_ds_swizzle(x, (4 << 10) | 0x1F);
    if (m == 8) return __builtin_amdgcn_ds_swizzle(x, (8 << 10) | 0x1F);
    if (m == 16) return __builtin_amdgcn_ds_swizzle(x, (16 << 10) | 0x1F);
    if (m == 32) { const auto r = __builtin_amdgcn_permlane32_swap((unsigned)x, (unsigned)x, false, false); return (int)((threadIdx.x & 32) ? r[0] : r[1]); }
    return __shfl_xor(x, m);
}
DEV float shflx(float v, int m) { return __builtin_bit_cast(float, shflxi(__builtin_bit_cast(int, v), m)); }
DEV float dpp_ror1(float v) { return __builtin_bit_cast(float, __builtin_amdgcn_update_dpp(0, __builtin_bit_cast(int, v), 0x121, 0xf, 0xf, false)); }
DEV float wave_sum63(float v) {
#define WS_DPP(ctrl, rm) __builtin_bit_cast(float, __builtin_amdgcn_update_dpp(0, __builtin_bit_cast(int, v), ctrl, rm, 0xf, false))
    v += WS_DPP(0xB1, 0xf); v += WS_DPP(0x4E, 0xf); v += WS_DPP(0x141, 0xf); v += WS_DPP(0x140, 0xf); v += WS_DPP(0x142, 0xa); v += WS_DPP(0x143, 0xc);
#undef WS_DPP
    return v;
}
DEV float shfl(float v, int s) { return __shfl(v, s); }
DEV int atomic_add_i(int* p, int v) { return atomicAdd(p, v); }
DEV float fexp2(float x) { return __builtin_amdgcn_exp2f(x); }
DEV float frcp(float x) { return __builtin_amdgcn_rcpf(x); }
DEV float frsq(float x) { return __builtin_amdgcn_rsqf(x); }
typedef short s16x4 __attribute__((ext_vector_type(4)));
#define tr4(p) __builtin_amdgcn_ds_read_tr16_b64_v4i16((__attribute__((address_space(3))) s16x4*)(p))
#endif

typedef unsigned short bf16;

#ifndef DM
#define DM 1024
#endif
#ifndef SEQ
#define SEQ 8192
#endif
#ifndef FF
#define FF 512
#endif
constexpr int NBATCH = 2, T = NBATCH * SEQ, DEPTH = 4;
constexpr int NIN = 3352, NINP = 3456, NIN8 = 3584;
constexpr int NT = 512;
constexpr int NCH = SEQ / 64;
constexpr int NCP = SEQ / 16;
constexpr int NCMP = NCP - 1;
constexpr int MOE_ROWS = 2 * T + 32 * 256;
constexpr float EPS = 1e-6f, NEGV = -1e30f, FORCEV = 1e4f, LOG2E = 1.4426950408889634f;

constexpr size_t al(size_t x) { return (x + 255) & ~(size_t)255; }
constexpr int P0_CTR_IDX = 192;
constexpr size_t WS_BAR = 0;
constexpr size_t WS_CNT = 16384;
constexpr size_t WS_MOD = WS_CNT + (size_t)DEPTH * 32 * 256;
constexpr size_t WS_LB = al(WS_MOD + (size_t)DEPTH * 2 * 6 * DM * 4);
constexpr size_t WS_CB = al(WS_LB + 2 * 512 * 4);
constexpr size_t WS_CS = al(WS_CB + 2 * 2 * 8 * 64 * 4);
constexpr size_t WS_WIN = al(WS_CS + 64);
constexpr size_t WS_WOUT = al(WS_WIN + (size_t)2 * NIN8 * DM * 2);
constexpr size_t WS_PW1 = al(WS_WOUT + (size_t)2 * DM * 1024 * 2);
constexpr size_t WS_PW2 = al(WS_PW1 + (size_t)2 * 2 * DM * DM * 2);
constexpr size_t WS_WC = al(WS_PW2 + (size_t)2 * DM * DM * 2);
constexpr size_t WS_W13 = al(WS_WC + (size_t)2 * 2 * 64 * 2048 * 2);
constexpr size_t WS_W2 = al(WS_W13 + (size_t)DEPTH * 32 * 2 * FF * DM * 2);
constexpr size_t WS_H = al(WS_W2 + (size_t)DEPTH * 32 * DM * FF * 2);
constexpr size_t WS_QN = al(WS_H + (size_t)T * DM * 2);
constexpr size_t WS_KCG = al(WS_QN + (size_t)T * 512 * 2);
constexpr size_t WS_VCG = al(WS_KCG + (size_t)T * 128 * 2);
constexpr size_t WS_KS = al(WS_VCG + (size_t)T * 128 * 2);
constexpr size_t WS_KW = al(WS_KS + (size_t)T * 128 * 2);
constexpr size_t WS_VST = al(WS_KW + (size_t)T * 128 * 2);
constexpr size_t WS_VWT = al(WS_VST + (size_t)T * 128 * 2);
constexpr size_t WS_KC = al(WS_VWT + (size_t)T * 128 * 2);
constexpr size_t WS_VCT = al(WS_KC + (size_t)4 * NCP * 64 * 2);
constexpr size_t WS_GATE = al(WS_VCT + (size_t)4 * NCP * 64 * 2);
constexpr size_t WS_HQ = al(WS_GATE + (size_t)T * 24 * 4);
constexpr size_t WS_HF = al(WS_HQ + (size_t)T * 512 * 2);
constexpr size_t WS_HV = al(WS_HF + (size_t)T * 512 * 4);
constexpr size_t WS_HGS = al(WS_HV + (size_t)T * 512 * 2);
constexpr size_t WS_UT = al(WS_HGS + (size_t)T * 512 * 2);
constexpr size_t WS_ST = al(WS_UT + (size_t)8 * NCH * 128 * 128 * 4);
constexpr size_t WS_GD = al(WS_ST + (size_t)8 * NCH * 128 * 128 * 2);
constexpr size_t WS_CAT = al(WS_GD + (size_t)8 * NCH * 128 * 4);
constexpr size_t WS_GLU = al(WS_CAT + (size_t)T * 1024 * 2);
constexpr size_t WS_TIE = al(WS_GLU + (size_t)T * DM * 2);
constexpr size_t WS_TIW = al(WS_TIE + (size_t)T * 2 * 4);
constexpr size_t WS_LIST = al(WS_TIW + (size_t)T * 2 * 4);
constexpr size_t WS_ACT = al(WS_LIST + (size_t)32 * T * 4);
constexpr size_t WS_YK = al(WS_ACT + (size_t)MOE_ROWS * FF * 2);
constexpr size_t WS_WTH = al(WS_YK + (size_t)MOE_ROWS * DM * 2);
constexpr size_t WS_WTL = al(WS_WTH + (size_t)DEPTH * 48 * DM * 2);
constexpr size_t WS_AVEC = al(WS_WTL + (size_t)DEPTH * 48 * DM * 2);
constexpr size_t WS_RBIAS = al(WS_AVEC + (size_t)DEPTH * 2 * DM * 4);
constexpr size_t WS_FLG = al(WS_RBIAS + (size_t)DEPTH * 2 * 48 * 4);
constexpr int LDS_BYTES = 150 * 1024;
constexpr int CMP_SPLIT = 2;
constexpr size_t WS_CMPP = al(WS_FLG + (size_t)DEPTH * 256 * 64);
constexpr size_t WS_END = al(WS_CMPP + (size_t)8 * ((NCP + 255) / 256) * CMP_SPLIT * 16 * 256 * 16);

struct Args { const float* in[26]; float* out; unsigned char* ws; };
enum { I_X = 0, I_C, I_ADAW, I_ADAB, I_NMIX, I_NFFN, I_WIN, I_WOUT, I_CWK, I_CWV, I_CPE, I_QG, I_KG, I_LBL, I_OG,
       I_PW1, I_DW, I_DWB, I_LNG, I_LNB, I_PW2, I_WG, I_WE, I_W1, I_W3, I_W2 };

#ifdef EMU
DEV unsigned char* wsp(const Args& a) { return a.ws; }
DEV float* outp(const Args& a) { return a.out; }
#else
DEV unsigned char* launder_ptr(const void* p) { unsigned long long v = (unsigned long long)p; unsigned lo = (unsigned)v, hi = (unsigned)(v >> 32);
    lo = (unsigned)__builtin_amdgcn_readfirstlane((int)lo); hi = (unsigned)__builtin_amdgcn_readfirstlane((int)hi); asm volatile("" : "+s"(lo), "+s"(hi)); typedef __attribute__((address_space(1))) unsigned char* gptr_t; return (unsigned char*)(gptr_t)(((unsigned long long)hi << 32) | lo); }
DEV unsigned char* wsp(const Args& a) { return launder_ptr(a.ws); }
DEV float* outp(const Args& a) { return (float*)launder_ptr(a.out); }
#endif

#ifdef EMU
#define INP(a, X) ((a).in[X])
#else
DEV int zero_opaque() { int z = 0; asm volatile("" : "+s"(z)); return z; }
#define INP(a, X) ((a).in[(X) + zero_opaque()])
#endif

DEV unsigned f2bf(float f) { unsigned u = __builtin_bit_cast(unsigned, f); return (u + 0x7fffu + ((u >> 16) & 1u)) >> 16; }
DEV float bf2f(unsigned h) { return __builtin_bit_cast(float, h << 16); }
#ifdef EMU
DEV unsigned pk2(float lo, float hi) { return f2bf(lo) | (f2bf(hi) << 16); }
#else
typedef float f32x2_t __attribute__((ext_vector_type(2)));
typedef float f32x2v __attribute__((ext_vector_type(2)));
typedef __bf16 bf16x2_t __attribute__((ext_vector_type(2)));
DEV unsigned pk2(float lo, float hi) { f32x2_t v = {lo, hi}; bf16x2_t b = __builtin_convertvector(v, bf16x2_t); return __builtin_bit_cast(unsigned, b); }
#endif
DEV float sigm(float x) { return frcp(1.0f + fexp2(-x * LOG2E)); }
DEV float siluf(float x) { return x * sigm(x); }
DEV f32x4 f4zero() { f32x4 z = {0.f, 0.f, 0.f, 0.f}; return z; }
DEV bf16x8 pack8(f32x4 a, f32x4 b) {
    u32x4 w; w[0] = pk2(a[0], a[1]); w[1] = pk2(a[2], a[3]); w[2] = pk2(b[0], b[1]); w[3] = pk2(b[2], b[3]);
    return __builtin_bit_cast(bf16x8, w);
}
DEV void st_bf8(bf16* p, f32x4 a, f32x4 b) { u32x4 w; w[0] = pk2(a[0], a[1]); w[1] = pk2(a[2], a[3]); w[2] = pk2(b[0], b[1]); w[3] = pk2(b[2], b[3]); *(u32x4*)p = w; }
DEV void st_bf4(bf16* p, f32x4 v) { u32x2 w; w[0] = pk2(v[0], v[1]); w[1] = pk2(v[2], v[3]); *(u32x2*)p = w; }


#ifdef EMU
namespace pg8 {
constexpr int BM = 256, BK = 64, HALF = 128, NXCD = 8, WGM = 8;
typedef unsigned short bf16_t;
struct Unit { int pm, pn; };
struct Gemm { const bf16_t* A; const bf16_t* Bt; int M, N, K; };
struct StaticOrder {
    int nM, nN, nwg, G, c;
    void init(int M, int N, int G_, int c_) { nM = M / BM; nN = N / BM; nwg = nM * nN; G = G_; c = c_; }
    bool next(int i, Unit& u) const {
        const long L = (long)i * G + c; if (L >= nwg) return false;
        int wgid = (int)L; { const int q = nwg / NXCD, r = nwg % NXCD, xcd = wgid % NXCD, off = wgid / NXCD; wgid = (xcd < r ? xcd * (q + 1) : r * (q + 1) + (xcd - r) * q) + off; }
        const int nig = WGM * nN, gid = wgid / nig, fm = gid * WGM, gsz = (nM - fm) < WGM ? (nM - fm) : WGM;
        u.pm = fm + ((wgid % nig) % gsz); u.pn = (wgid % nig) / gsz; return true;
    }
};
struct SelNone { static constexpr bool GATHER = false; struct Ctx {}; Ctx ctx(const Unit&) const { return Ctx(); } size_t boff(const Ctx&) const { return 0; } unsigned aoff(const Ctx&, int) const { return 0u; } };
template <class Epi, class Sched, bool ALIGN_EPI = false, bool SP2 = false, class Sel = SelNone>
static inline void gemm_phase(unsigned char*, const Gemm g, const Sched& S, const Epi& E, const Sel& X = Sel()) {
    const int tid = emu_tid(), wid = tid >> 6, lane = tid & 63, wr = wid >> 2, wc = wid & 3, fr = lane & 15, fq = lane >> 4;
    Unit u;
    for (int ui = 0; S.next(ui, u); ++ui) {
        f32x4 acc[2][2][4][2]; const auto cx = X.ctx(u);
        for (int ai = 0; ai < 2; ++ai) for (int bj = 0; bj < 2; ++bj) for (int m = 0; m < 4; ++m) for (int n = 0; n < 2; ++n) for (int r = 0; r < 4; ++r) {
            const int row = 256 * u.pm + 128 * ai + 64 * wr + 16 * m + fr, col = 256 * u.pn + 128 * bj + 32 * wc + (Epi::PERM ? 8 * fq + 4 * n + r : 16 * n + 4 * fq + r); float sum = 0.f;
            const bf16_t* ap = Sel::GATHER ? (const bf16_t*)((const char*)g.A + X.aoff(cx, row - 256 * u.pm)) : g.A + (size_t)row * g.K; const bf16_t* bp = (const bf16_t*)((const char*)g.Bt + X.boff(cx)) + (size_t)col * g.K;
            for (int k = 0; k < g.K; ++k) sum += bf2f(ap[k]) * bf2f(bp[k]);
            acc[ai][bj][m][n][r] = sum; }
        E(acc, u, wr, wc, fr, fq);
    }
    emu_sync_block();
}
}
#else
namespace pg8 {
#define PG8_LAS __attribute__((address_space(3)))
typedef unsigned short bf16_t;
typedef short bf16x8 __attribute__((ext_vector_type(8)));
typedef float f32x4 __attribute__((ext_vector_type(4)));
typedef unsigned u32x4 __attribute__((ext_vector_type(4)));
constexpr int BM = 256, BK = 64, HALF = 128, HTB = HALF * BK * 2  , STAGE_BYTES = 8 * HTB, NXCD = 8, WGM = 8;

__host__ __device__ __forceinline__ int lds_byte(int r, int c) { const int st = (r >> 4) * 2 + (c >> 5), rr = r & 15, cc = c & 31, ob = rr * 64 + cc * 2; return st * 1024 + (ob ^ (((ob >> 9) & 1) << 5)); }
__host__ __device__ __forceinline__ void stage_rc(int b, int& R, int& C) { const int st = b / 1024, sb = b % 1024, swz = sb ^ (((sb >> 9) & 1) << 5); R = (st >> 1) * 16 + swz / 64; C = (st & 1) * 32 + (swz % 64) / 2; }
__host__ __device__ __forceinline__ int perm32(int rho) { const int n = rho >> 4, i = rho & 15; return 8 * (i >> 2) + 4 * n + (i & 3); }

struct Unit { int pm, pn; };
struct Gemm { const bf16_t* A; const bf16_t* Bt; int M, N, K; };

struct StaticOrder {
    int nM, nN, nwg, G, c;
    __host__ __device__ void init(int M, int N, int G_, int c_) { nM = M / BM; nN = N / BM; nwg = nM * nN; G = G_; c = c_; }
    __host__ __device__ bool next(int i, Unit& u) const {
        const long L = (long)i * G + c; if (L >= nwg) return false;
        int wgid = (int)L; { const int q = nwg / NXCD, r = nwg % NXCD, xcd = wgid % NXCD, off = wgid / NXCD; wgid = (xcd < r ? xcd * (q + 1) : r * (q + 1) + (xcd - r) * q) + off; }
        const int nig = WGM * nN, gid = wgid / nig, fm = gid * WGM, gsz = (nM - fm) < WGM ? (nM - fm) : WGM;
        u.pm = fm + ((wgid % nig) % gsz); u.pn = (wgid % nig) / gsz; return true;
    }
    __device__ __forceinline__ void a_ready(const Unit&) const {}
    __device__ __forceinline__ void done(const Unit&) const {}
};

__device__ __forceinline__ unsigned cvt_pk_bf16(float lo, float hi) { unsigned r; asm volatile("v_cvt_pk_bf16_f32 %0, %1, %2" : "=v"(r) : "v"(lo), "v"(hi)); return r; }
struct SelNone { static constexpr bool GATHER = false; struct Ctx {}; __device__ __forceinline__ Ctx ctx(const Unit&) const { return Ctx(); } __device__ __forceinline__ size_t boff(const Ctx&) const { return 0; } __device__ __forceinline__ unsigned aoff(const Ctx&, int) const { return 0u; } };
template <class Epi, class Sched, bool ALIGN_EPI = false, bool SP2 = false, class Sel = SelNone>
__device__ __forceinline__ void gemm_phase(PG8_LAS unsigned char* lds, const Gemm g, const Sched& S, const Epi& E, const Sel& X = Sel()) {
    constexpr bool GA = Sel::GATHER;
    const int tid = TID, wid = __builtin_amdgcn_readfirstlane(tid >> 6), lane = tid & 63, wr = wid >> 2, wc = wid & 3, fr = lane & 15, fq = lane >> 4;
    const int K = g.K, nt = K / BK;
    unsigned voffA[2], voffB[2]; int Rl[2]; unsigned Cl2[2];
#pragma unroll
    for (int i = 0; i < 2; ++i) { int R, C; stage_rc(tid * 16 + i * 8192, R, C); const int Rb = Epi::PERM ? ((R & ~31) + perm32(R & 31)) : R;
        voffA[i] = (unsigned)(R * K + C) * 2u; voffB[i] = (unsigned)(Rb * K + C) * 2u; Rl[i] = R; Cl2[i] = (unsigned)C * 2u; }
    unsigned vA[2][2], vAn[2][2];
    const size_t kstep = (size_t)(BK * 2);
    const size_t hstep = (size_t)HALF * K * 2;
    const size_t tstep = 2 * hstep;
    const unsigned ldsw = (unsigned)wid * 1024u;
    const int aoff = lds_byte(wr * 64 + fr, fq * 8), boff = lds_byte(wc * 32 + fr, fq * 8);
#define PG8_SA(b, h) (((b) * 2 + (h)) * HTB)
#define PG8_SB(b, h) ((4 + (b) * 2 + (h)) * HTB)
#define PG8_STAGE(bufoff, gbase, voff) do { _Pragma("unroll") for (int _i = 0; _i < 2; ++_i) \
        __builtin_amdgcn_global_load_lds((const unsigned*)((const char*)(gbase) + (voff)[_i]), (PG8_LAS unsigned*)(lds + (bufoff) + ldsw + _i * 8192), 16, 0, 0); } while (0)
#define PG8_STAGE_A(bufoff, p, h, nx) do { if constexpr (GA) { unsigned _vo[2] = {(nx) ? vAn[h][0] : vA[h][0], (nx) ? vAn[h][1] : vA[h][1]}; PG8_STAGE(bufoff, p, _vo); } else { PG8_STAGE(bufoff, (p) + (h) * hstep, voffA); } } while (0)
#define PG8_GATH(cx, dst) do { _Pragma("unroll") for (int _h = 0; _h < 2; ++_h) _Pragma("unroll") for (int _i = 0; _i < 2; ++_i) dst[_h][_i] = X.aoff(cx, 128 * _h + Rl[_i]) + Cl2[_i]; } while (0)
#define PG8_LDA(dst, b, h) do { _Pragma("unroll") for (int m = 0; m < 4; ++m) _Pragma("unroll") for (int k = 0; k < 2; ++k) dst[m][k] = *(const PG8_LAS bf16x8*)(lds + PG8_SA(b, h) + aoff + m * 2048 + k * 1024); } while (0)
#define PG8_LDB(dst, b, h) do { _Pragma("unroll") for (int n = 0; n < 2; ++n) _Pragma("unroll") for (int k = 0; k < 2; ++k) dst[n][k] = *(const PG8_LAS bf16x8*)(lds + PG8_SB(b, h) + boff + n * 2048 + k * 1024); } while (0)
#define PG8_MMA(ai, bj, At, Bt) do { __builtin_amdgcn_s_setprio(1); _Pragma("unroll") for (int m = 0; m < 4; ++m) _Pragma("unroll") for (int n = 0; n < 2; ++n) _Pragma("unroll") for (int k = 0; k < 2; ++k) \
        acc[ai][bj][m][n] = __builtin_amdgcn_mfma_f32_16x16x32_bf16(Bt[n][k], At[m][k], acc[ai][bj][m][n], 0, 0, 0); __builtin_amdgcn_s_setprio(0); } while (0)
#define PG8_WAIT_V(n) asm volatile("s_waitcnt vmcnt(" #n ")" ::: "memory")
#define PG8_WAIT_L(n) asm volatile("s_waitcnt lgkmcnt(" #n ")" ::: "memory")
#define PG8_BAR __builtin_amdgcn_s_barrier()
#define PG8_SCHED __builtin_amdgcn_sched_barrier(0)
    Unit cur, nxt; int ui = 0;
    if (!S.next(0, cur)) return;
    f32x4 acc[2][2][4][2];
#pragma unroll
    for (int a = 0; a < 2; ++a)
#pragma unroll
        for (int b = 0; b < 2; ++b)
#pragma unroll
            for (int m = 0; m < 4; ++m)
#pragma unroll
                for (int n = 0; n < 2; ++n) acc[a][b][m][n] = (f32x4){0.f, 0.f, 0.f, 0.f};
    bf16x8 At[4][2], B0[2][2], B1[2][2];
    auto ccx = X.ctx(cur);
    const char* cA = GA ? (const char*)g.A : (const char*)g.A + (size_t)cur.pm * tstep; const char* cB = (const char*)g.Bt + X.boff(ccx) + (size_t)cur.pn * tstep;
    if constexpr (GA) { PG8_GATH(ccx, vA); }
    S.a_ready(cur);
    if constexpr (SP2) {
        PG8_STAGE(PG8_SB(0, 0), cB, voffB); PG8_STAGE(PG8_SB(0, 1), cB + hstep, voffB); PG8_STAGE_A(PG8_SA(0, 0), cA, 0, false); PG8_STAGE_A(PG8_SA(0, 1), cA, 1, false);
        if (wr == 1) PG8_BAR;
        PG8_WAIT_V(2); PG8_BAR;
        PG8_STAGE(PG8_SB(1, 0), cB + kstep, voffB); PG8_STAGE_A(PG8_SA(1, 0), cA + kstep, 0, false); PG8_STAGE(PG8_SB(1, 1), cB + hstep + kstep, voffB);
        PG8_WAIT_V(6); PG8_BAR;
    } else {
        PG8_STAGE(PG8_SB(0, 0), cB, voffB); PG8_STAGE_A(PG8_SA(0, 0), cA, 0, false); PG8_STAGE(PG8_SB(0, 1), cB + hstep, voffB); PG8_STAGE_A(PG8_SA(0, 1), cA, 1, false);
        if (wr == 1) PG8_BAR;
        PG8_WAIT_V(4); PG8_BAR;
        PG8_STAGE(PG8_SB(1, 0), cB + kstep, voffB); PG8_STAGE_A(PG8_SA(1, 0), cA + kstep, 0, false); PG8_STAGE(PG8_SB(1, 1), cB + hstep + kstep, voffB);
        PG8_WAIT_V(6); PG8_BAR;
    }
    for (;;) {
        const bool has_next = S.next(ui + 1, nxt);
        const char* nA = cA; const char* nB = cB;
        if (has_next) { const auto ncx = X.ctx(nxt); nA = GA ? (const char*)g.A : (const char*)g.A + (size_t)nxt.pm * tstep; nB = (const char*)g.Bt + X.boff(ncx) + (size_t)nxt.pn * tstep; if constexpr (GA) { PG8_GATH(ncx, vAn); } }
        else if constexpr (GA) {
#pragma unroll
            for (int _h = 0; _h < 2; ++_h) { vAn[_h][0] = vA[_h][0]; vAn[_h][1] = vA[_h][1]; } }
        for (int t = 0; t < nt; t += 2) {
            const bool last = (t == nt - 2);
            const char* a1 = cA + (size_t)(t + 1) * kstep;
            const char* a2 = last ? nA : cA + (size_t)(t + 2) * kstep; const char* b2 = last ? nB : cB + (size_t)(t + 2) * kstep;
            const char* a3 = a2 + kstep; const char* b3 = b2 + kstep;
            if (last && has_next) S.a_ready(nxt);
            if constexpr (SP2) {
            PG8_LDB(B0, 0, 0); PG8_LDB(B1, 0, 1); PG8_SCHED; PG8_LDA(At, 0, 0); PG8_STAGE_A(PG8_SA(1, 1), a1, 1, false);
            PG8_WAIT_V(8); PG8_WAIT_L(0); PG8_BAR; PG8_MMA(0, 0, At, B0); PG8_MMA(0, 1, At, B1); PG8_BAR; PG8_SCHED;
            PG8_LDA(At, 0, 1); PG8_STAGE(PG8_SB(0, 0), b2, voffB); PG8_STAGE(PG8_SB(0, 1), b2 + hstep, voffB); PG8_STAGE_A(PG8_SA(0, 0), a2, 0, last);
            PG8_WAIT_V(8); PG8_WAIT_L(0); PG8_BAR; PG8_MMA(1, 0, At, B0); PG8_MMA(1, 1, At, B1); PG8_BAR; PG8_SCHED;
            PG8_LDB(B0, 1, 0); PG8_LDB(B1, 1, 1); PG8_SCHED; PG8_LDA(At, 1, 0); PG8_STAGE_A(PG8_SA(0, 1), a2, 1, last);
            PG8_WAIT_V(8); PG8_WAIT_L(0); PG8_BAR; PG8_MMA(0, 0, At, B0); PG8_MMA(0, 1, At, B1); PG8_BAR; PG8_SCHED;
            PG8_LDA(At, 1, 1); PG8_STAGE(PG8_SB(1, 0), b3, voffB); PG8_STAGE(PG8_SB(1, 1), b3 + hstep, voffB); PG8_STAGE_A(PG8_SA(1, 0), a3, 0, last);
            PG8_WAIT_V(8); PG8_WAIT_L(0); PG8_BAR; PG8_MMA(1, 0, At, B0); PG8_MMA(1, 1, At, B1); PG8_BAR; PG8_SCHED;
            } else {
            PG8_LDB(B0, 0, 0); PG8_SCHED; PG8_LDA(At, 0, 0); PG8_STAGE_A(PG8_SA(1, 1), a1, 1, false);
            PG8_WAIT_L(8); PG8_BAR; PG8_WAIT_L(0); PG8_MMA(0, 0, At, B0); PG8_BAR; PG8_SCHED;
            PG8_LDB(B1, 0, 1); PG8_STAGE(PG8_SB(0, 0), b2, voffB);
            PG8_BAR; PG8_WAIT_L(0); PG8_MMA(0, 1, At, B1); PG8_BAR;
            PG8_LDA(At, 0, 1); PG8_STAGE_A(PG8_SA(0, 0), a2, 0, last);
            PG8_BAR; PG8_WAIT_L(0); PG8_MMA(1, 0, At, B0); PG8_BAR; PG8_SCHED;
            PG8_STAGE(PG8_SB(0, 1), b2 + hstep, voffB);
            PG8_WAIT_V(6); PG8_BAR; PG8_MMA(1, 1, At, B1); PG8_BAR;
            PG8_LDB(B0, 1, 0); PG8_SCHED; PG8_LDA(At, 1, 0); PG8_STAGE_A(PG8_SA(0, 1), a2, 1, last);
            PG8_WAIT_L(8); PG8_BAR; PG8_WAIT_L(0); PG8_MMA(0, 0, At, B0); PG8_BAR; PG8_SCHED;
            PG8_LDB(B1, 1, 1); PG8_STAGE(PG8_SB(1, 0), b3, voffB);
            PG8_BAR; PG8_WAIT_L(0); PG8_MMA(0, 1, At, B1); PG8_BAR;
            PG8_LDA(At, 1, 1); PG8_STAGE_A(PG8_SA(1, 0), a3, 0, last);
            PG8_BAR; PG8_WAIT_L(0); PG8_MMA(1, 0, At, B0); PG8_BAR; PG8_SCHED;
            PG8_STAGE(PG8_SB(1, 1), b3 + hstep, voffB);
            PG8_WAIT_V(6); PG8_BAR; PG8_MMA(1, 1, At, B1); PG8_BAR;
            }
        }
        if constexpr (ALIGN_EPI) { if (wr == 0) PG8_BAR; }
        if constexpr (!Epi::AFTER_DRAIN) { E(acc, cur, wr, wc, fr, fq); S.done(cur); }
        if (!has_next) break;
#pragma unroll
        for (int a = 0; a < 2; ++a)
#pragma unroll
            for (int b = 0; b < 2; ++b)
#pragma unroll
                for (int m = 0; m < 4; ++m)
#pragma unroll
                    for (int n = 0; n < 2; ++n) acc[a][b][m][n] = (f32x4){0.f, 0.f, 0.f, 0.f};
        cur = nxt; cA = nA; cB = nB; ++ui;
        if constexpr (GA) {
#pragma unroll
            for (int _h = 0; _h < 2; ++_h) { vA[_h][0] = vAn[_h][0]; vA[_h][1] = vAn[_h][1]; } }
        if constexpr (ALIGN_EPI) { if (wr == 1) PG8_BAR; }
    }
    PG8_WAIT_V(0);
    if constexpr (!ALIGN_EPI) { if (wr == 0) PG8_BAR; }
    PG8_BAR;
    if constexpr (Epi::AFTER_DRAIN) { E.fused(acc, cur, wr, wc, fr, fq, lds, wid, lane); S.done(cur); }
#undef PG8_SA
#undef PG8_SB
#undef PG8_STAGE
#undef PG8_STAGE_A
#undef PG8_GATH
#undef PG8_LDA
#undef PG8_LDB
#undef PG8_MMA
#undef PG8_WAIT_V
#undef PG8_WAIT_L
#undef PG8_BAR
#undef PG8_SCHED
}
}
#endif

constexpr int LDT = 72;
constexpr int GEMM_AS = 256 * LDT, GEMM_BS = 128 * LDT;
constexpr int GEMM_LDS = 2 * (GEMM_AS + GEMM_BS) * 2;

template <class AF, class EPI>
DEV void gemm_tile(unsigned char* smem, AF af, const bf16* Bt, int ldb, int nvalid, int K, EPI& epi) {
    const int tid = TID, w = tid >> 6, l = tid & 63, h = l >> 4, c = l & 15, wm = w >> 1, wn = w & 1;
    bf16* As = (bf16*)smem; bf16* Bs = As + 2 * GEMM_AS;
    const bf16* ap[4]; const bf16* bp[2];
    const int col8 = (tid & 7) * 8, r0 = tid >> 3;
#pragma unroll
    for (int i = 0; i < 4; ++i) ap[i] = af(r0 + 64 * i) + col8;
#pragma unroll
    for (int i = 0; i < 2; ++i) { int rn = r0 + 64 * i; if (rn >= nvalid) rn = nvalid - 1; bp[i] = Bt + (size_t)rn * ldb + col8; }
    f32x4 acc[4][4];
#pragma unroll
    for (int i = 0; i < 4; ++i)
#pragma unroll
        for (int j = 0; j < 4; ++j) acc[i][j] = f4zero();
    bf16x8 ra[4], rb[2];
#pragma unroll
    for (int i = 0; i < 4; ++i) ra[i] = *(const bf16x8*)(ap[i]);
#pragma unroll
    for (int i = 0; i < 2; ++i) rb[i] = *(const bf16x8*)(bp[i]);
    SYNC();
#pragma unroll
    for (int i = 0; i < 4; ++i) *(bf16x8*)(As + (r0 + 64 * i) * LDT + col8) = ra[i];
#pragma unroll
    for (int i = 0; i < 2; ++i) *(bf16x8*)(Bs + (r0 + 64 * i) * LDT + col8) = rb[i];
    SYNC();
    const int nk = K / 64;
    for (int kt = 0; kt < nk; ++kt) {
        const int cur = kt & 1;
        if (kt + 1 < nk) {
#pragma unroll
            for (int i = 0; i < 4; ++i) ra[i] = *(const bf16x8*)(ap[i] + (kt + 1) * 64);
#pragma unroll
            for (int i = 0; i < 2; ++i) rb[i] = *(const bf16x8*)(bp[i] + (kt + 1) * 64);
        }
        const bf16* Ac = As + cur * GEMM_AS + (wm * 64 + c) * LDT + 8 * h;
        const bf16* Bc = Bs + cur * GEMM_BS + (wn * 64 + c) * LDT + 8 * h;
#pragma unroll
        for (int kk = 0; kk < 2; ++kk) {
            bf16x8 fa[4], fb[4];
#pragma unroll
            for (int i = 0; i < 4; ++i) { fa[i] = *(const bf16x8*)(Ac + i * 16 * LDT + kk * 32); fb[i] = *(const bf16x8*)(Bc + i * 16 * LDT + kk * 32); }
#pragma unroll
            for (int ni = 0; ni < 4; ++ni)
#pragma unroll
                for (int mi = 0; mi < 4; ++mi) acc[ni][mi] = mfma16(fb[ni], fa[mi], acc[ni][mi]);
        }
        if (kt + 1 < nk) {
            const int nx = cur ^ 1;
#pragma unroll
            for (int i = 0; i < 4; ++i) *(bf16x8*)(As + nx * GEMM_AS + (r0 + 64 * i) * LDT + col8) = ra[i];
#pragma unroll
            for (int i = 0; i < 2; ++i) *(bf16x8*)(Bs + nx * GEMM_BS + (r0 + 64 * i) * LDT + col8) = rb[i];
        }
        SYNC();
    }
    epi(acc, wm * 64, wn * 64, h, c);
}

struct ARows { const bf16* base; size_t ld; MDEV const bf16* operator()(int r) const { return base + (size_t)r * ld; } MDEV unsigned off(int r) const { return (unsigned)r * (unsigned)ld; } };

constexpr int LDB = 144;
constexpr int GEMM_BS2 = 64 * LDB;
constexpr int GEMM2_LDS = (2 * GEMM_AS + 2 * GEMM_BS2) * 2;
DEV bf16x8 tr_read8(const bf16* p0, const bf16* p1) {
    const s16x4 x = tr4(p0), y = tr4(p1); bf16x8 r;
    r[0] = x[0]; r[1] = x[1]; r[2] = x[2]; r[3] = x[3]; r[4] = y[0]; r[5] = y[1]; r[6] = y[2]; r[7] = y[3]; return r;
}
DEV int bperm(int r) { return (r & ~12) | ((r & 4) << 1) | ((r & 8) >> 1); }
template <class AF, class BF, class EPI>
DEV void gemm_tile2(unsigned char* smem, AF af, BF bf, int ldb, int K, EPI& epi) {
    const int tid = TID, w = tid >> 6, l = tid & 63, h = l >> 4, c = l & 15, wm = w >> 1, wn = w & 1, grp = w >> 2;
    bf16* As = (bf16*)smem; bf16* Bs = As + 2 * GEMM_AS;
    const bf16* abase = af.base; unsigned ao[4];
    const int col8 = (tid & 7) * 8, r0 = tid >> 3;
#pragma unroll
    for (int i = 0; i < 4; ++i) ao[i] = af.off(r0 + 64 * i) + col8;
    const int bn4 = (tid & 31) * 4, bk = tid >> 5, bkp = bperm(bk);
    const float* bp = bf(bn4); const bool bok = bp != nullptr;
    if (bok) bp += (size_t)bk * ldb;
    const size_t bstep = (size_t)16 * ldb;
    f32x4 acc[4][4];
#pragma unroll
    for (int i = 0; i < 4; ++i)
#pragma unroll
        for (int j = 0; j < 4; ++j) acc[i][j] = f4zero();
    bf16x8 ra[4]; f32x4 rb[4];
    const int nk = K / 64;
#pragma unroll
    for (int i = 0; i < 4; ++i) { ra[i] = *(const bf16x8*)(abase + ao[i]); rb[i] = bok ? *(const f32x4*)(bp + i * bstep) : f4zero(); }
    SYNC();
#pragma unroll
    for (int i = 0; i < 4; ++i) { *(bf16x8*)(As + (r0 + 64 * i) * LDT + col8) = ra[i]; st_bf4(Bs + (bkp + 16 * i) * LDB + bn4, rb[i]); }
    if (nk > 1) {
#pragma unroll
        for (int i = 0; i < 4; ++i) { ra[i] = *(const bf16x8*)(abase + (ao[i] + 64)); rb[i] = bok ? *(const f32x4*)(bp + (size_t)64 * ldb + i * bstep) : f4zero(); } }
    SYNC();
    for (int kt = 0; kt < nk; ++kt) {
        const int cur = kt & 1;
#pragma unroll
        for (int p = 0; p < 2; ++p) {
            if (grp == p) {
                const bf16* Ac = As + cur * GEMM_AS + (wm * 64 + c) * LDT + 8 * h;
                const bf16* Bc = Bs + cur * GEMM_BS2 + bperm(8 * h + (c >> 2)) * LDB + wn * 64 + 4 * (c & 3);
#pragma unroll
                for (int kk = 0; kk < 2; ++kk) {
                    bf16x8 fa[4], fb[4];
#pragma unroll
                    for (int i = 0; i < 4; ++i) { fa[i] = *(const bf16x8*)(Ac + i * 16 * LDT + kk * 32); fb[i] = tr_read8(Bc + (32 * kk) * LDB + 16 * i, Bc + (32 * kk + 8) * LDB + 16 * i); }
#pragma unroll
                    for (int ni = 0; ni < 4; ++ni)
#pragma unroll
                        for (int mi = 0; mi < 4; ++mi) acc[ni][mi] = mfma16(fb[ni], fa[mi], acc[ni][mi]);
                }
            } else if (kt + 1 < nk) {
                const int nx = cur ^ 1;
#pragma unroll
                for (int i = 0; i < 4; ++i) { *(bf16x8*)(As + nx * GEMM_AS + (r0 + 64 * i) * LDT + col8) = ra[i]; st_bf4(Bs + nx * GEMM_BS2 + (bkp + 16 * i) * LDB + bn4, rb[i]); }
                if (kt + 2 < nk) {
#pragma unroll
                    for (int i = 0; i < 4; ++i) { ra[i] = *(const bf16x8*)(abase + (ao[i] + (kt + 2) * 64)); rb[i] = bok ? *(const f32x4*)(bp + (size_t)(kt + 2) * 64 * ldb + i * bstep) : f4zero(); } }
            }
            SYNC();
        }
    }
    epi(acc, wm * 64, wn * 64, h, c);
}
struct BPlain { const float* base; MDEV const float* operator()(int nt) const { return base + nt; } };
struct BInProjMap { const float* base; int n0; MDEV const float* operator()(int nt) const { const int n = n0 + nt; const int sc = n < 1280 ? n : (n < 3328 ? n + 24 : (n < 3352 ? 1280 + (n - 3328) : -1)); return sc < 0 ? nullptr : base + sc; } };
struct BInter { const float* s0; const float* s1; int n0; MDEV const float* operator()(int nt) const { const int n = n0 + nt, g = n >> 6, w = n & 63; return w < 32 ? s0 + g * 32 + w : s1 + g * 32 + w - 32; } };
struct BClamp64 { const float* base; MDEV const float* operator()(int nt) const { return base + (nt & 63); } };

struct EpiInProj {
    const Args* a; int m0, n0, li;
    MDEV void operator()(f32x4 (&acc)[4][4], int mw, int nw, int h, int c) const {
        unsigned char* ws = wsp(*a);
        const int nb = n0 + nw;
        const int tokb = m0 + mw + c;
        if (nb < 512 || (nb >= 768 && nb < 896) || (nb >= 1024 && nb < 1152)) {
            const float* gain; float mul = 1.f; bf16* dst; int kind;
            if (nb < 512) { gain = INP(*a, I_QG) + li * 64; mul = 0.125f * LOG2E; kind = 0; dst = (bf16*)(ws + WS_QN); }
            else if (nb < 896) { gain = INP(*a, I_KG) + (li * 3 + 1) * 64; kind = 1; dst = (bf16*)(ws + WS_KS); }
            else { gain = INP(*a, I_KG) + (li * 3 + 2) * 64; kind = 1; dst = (bf16*)(ws + WS_KW); }
            const int g = (nb >> 6) & 1;
#pragma unroll
            for (int mi = 0; mi < 4; ++mi) {
                float ss = 0.f;
#pragma unroll
                for (int ni = 0; ni < 4; ++ni) { f32x4 v = acc[ni][mi]; ss += v[0] * v[0] + v[1] * v[1] + v[2] * v[2] + v[3] * v[3]; }
                ss += shflx(ss, 16); ss += shflx(ss, 32);
                const float rs = frsq(ss * (1.0f / 64.0f) + EPS) * mul;
                const int tok = tokb + 16 * mi;
#pragma unroll
                for (int ni = 0; ni < 4; ++ni) {
                    const int d = 16 * ni + 4 * h; f32x4 v = acc[ni][mi], o;
#pragma unroll
                    for (int r = 0; r < 4; ++r) o[r] = v[r] * rs * gain[d + r];
                    if (kind == 0) st_bf4(dst + (size_t)tok * 512 + nb + d, o);
                    else { const int b = tok / SEQ, s = tok % SEQ; st_bf4(dst + ((size_t)(b * 2 + g) * SEQ + s) * 64 + d, o); }
                }
            }
        } else if (nb < 768) {
            bf16* dst = (bf16*)(ws + (nb < 640 ? WS_KCG : WS_VCG)); const int g = (nb >> 6) & 1;
#pragma unroll
            for (int mi = 0; mi < 4; ++mi) { const int tok = tokb + 16 * mi, b = tok / SEQ, s = tok % SEQ;
#pragma unroll
                for (int ni = 0; ni < 4; ++ni) st_bf4(dst + ((size_t)(b * 2 + g) * SEQ + s) * 64 + 16 * ni + 4 * h, acc[ni][mi]); }
        } else if (nb < 1280) {
            bf16* dst = (bf16*)(ws + (nb < 1024 ? WS_VST : WS_VWT)); const int g = (nb >> 6) & 1;
#pragma unroll
            for (int mi = 0; mi < 4; ++mi) { const int tok = tokb + 16 * mi, b = tok / SEQ, s = tok % SEQ;
                bf16* p = dst + ((size_t)(b * 2 + g) * NCH + (s >> 6)) * 4096 + (s & 63);
#pragma unroll
                for (int ni = 0; ni < 4; ++ni)
#pragma unroll
                    for (int r = 0; r < 4; ++r) p[(16 * ni + 4 * h + r) * 64] = (bf16)f2bf(acc[ni][mi][r]); }
        } else if (nb < 3328) {
            const int sec = (nb - 1280) >> 9, cc = (nb - 1280) & 511, hh = cc >> 7, d0 = cc & 127;
#pragma unroll
            for (int mi = 0; mi < 4; ++mi) { const int tok = tokb + 16 * mi, b = tok / SEQ, s = tok % SEQ;
                const size_t hrow = ((size_t)(b * 4 + hh) * SEQ + s) * 128 + d0;
#pragma unroll
                for (int ni = 0; ni < 4; ++ni) { const int d = 16 * ni + 4 * h; f32x4 v = acc[ni][mi], o;
                    if (sec == 0) { for (int r = 0; r < 4; ++r) o[r] = siluf(v[r]); st_bf4((bf16*)(ws + WS_HQ) + hrow + d, o); }
                    else if (sec == 1) { const float* lb = (const float*)(ws + WS_LB) + li * 512 + cc + d;
                        for (int r = 0; r < 4; ++r) o[r] = lb[r] + (1.0f - lb[r]) * sigm(v[r]);
                        *(f32x4*)((float*)(ws + WS_HF) + hrow + d) = o; }
                    else if (sec == 2) st_bf4((bf16*)(ws + WS_HV) + hrow + d, v);
                    else { for (int r = 0; r < 4; ++r) o[r] = siluf(v[r]); st_bf4((bf16*)(ws + WS_HGS) + (size_t)tok * 512 + cc + d, o); }
                } }
        } else if (nb == 3328) {
            float* dst = (float*)(ws + WS_GATE);
#pragma unroll
            for (int mi = 0; mi < 4; ++mi) { const int tok = tokb + 16 * mi;
#pragma unroll
                for (int ni = 0; ni < 2; ++ni)
#pragma unroll
                    for (int r = 0; r < 4; ++r) { const int n = 16 * ni + 4 * h + r; if (n < 24) dst[(size_t)tok * 24 + n] = sigm(acc[ni][mi][r]); } }
        }
    }
};

struct EpiResid {
    float* x; const float* gate; int m0, n0;
    MDEV void operator()(f32x4 (&acc)[4][4], int mw, int nw, int h, int c) const {
#pragma unroll
        for (int mi = 0; mi < 4; ++mi) { const int tok = m0 + mw + 16 * mi + c, b = tok / SEQ;
#pragma unroll
            for (int ni = 0; ni < 4; ++ni) { const int n = n0 + nw + 16 * ni + 4 * h;
                f32x4 g = *(const f32x4*)(gate + (size_t)b * 6 * DM + n); f32x4* p = (f32x4*)(x + (size_t)tok * DM + n); f32x4 v = *p;
#pragma unroll
                for (int r = 0; r < 4; ++r) v[r] += g[r] * acc[ni][mi][r];
                *p = v; } }
    }
};
template <int MODE> struct EpiGated {
    bf16* dst; size_t ld; int m0, n0, mvalid;
    MDEV void operator()(f32x4 (&acc)[4][4], int mw, int nw, int h, int c) const {
        const int cb = (n0 + nw) / 2;
#pragma unroll
        for (int mi = 0; mi < 4; ++mi) { const int m = mw + 16 * mi + c; if (m >= mvalid) continue;
#pragma unroll
            for (int ni = 0; ni < 2; ++ni) { f32x4 o;
#pragma unroll
                for (int r = 0; r < 4; ++r) { const float av = acc[ni][mi][r], bv = acc[ni + 2][mi][r]; o[r] = MODE == 0 ? av * sigm(bv) : siluf(av) * bv; }
                st_bf4(dst + (size_t)(m0 + m) * ld + cb + 16 * ni + 4 * h, o); } }
    }
};
struct EpiStoreBf {
    bf16* dst; size_t ld; int m0, n0, mvalid;
    MDEV void operator()(f32x4 (&acc)[4][4], int mw, int nw, int h, int c) const {
#pragma unroll
        for (int mi = 0; mi < 4; ++mi) { const int m = mw + 16 * mi + c; if (m >= mvalid) continue;
#pragma unroll
            for (int ni = 0; ni < 4; ++ni) st_bf4(dst + (size_t)(m0 + m) * ld + n0 + nw + 16 * ni + 4 * h, acc[ni][mi]); }
    }
};
struct EpiCmp {
    const Args* a; int kv, bg, m0, li;
    MDEV void operator()(f32x4 (&acc)[4][4], int mw, int nw, int h, int c) const {
        if (nw != 0) return;
        unsigned char* ws = wsp(*a);
        const float* bp8 = (const float*)(ws + WS_CB) + (li * 2 + kv) * 8 * 64;
        float bias[16];
#pragma unroll
        for (int q = 0; q < 16; ++q) { const int e = 16 * (q >> 2) + 4 * h + (q & 3); float v = 0.f;
#pragma unroll
            for (int kp = 0; kp < 8; ++kp) v += bp8[kp * 64 + e];
            bias[q] = v; }
        const float* gain = INP(*a, I_KG) + (li * 3 + 0) * 64;
#pragma unroll
        for (int mi = 0; mi < 4; ++mi) { const int n = m0 + mw + 16 * mi + c; const bool ok = n < NCMP;
            f32x4 v[4]; float ss = 0.f;
#pragma unroll
            for (int ni = 0; ni < 4; ++ni) { v[ni] = acc[ni][mi];
#pragma unroll
                for (int r = 0; r < 4; ++r) { v[ni][r] += bias[4 * ni + r]; ss += v[ni][r] * v[ni][r]; } }
            ss += shflx(ss, 16); ss += shflx(ss, 32);
            if (n >= NCP) continue;
            if (kv == 0) { const float rs = frsq(ss * (1.0f / 64.0f) + EPS); bf16* p = (bf16*)(ws + WS_KC) + ((size_t)bg * NCP + n) * 64;
#pragma unroll
                for (int ni = 0; ni < 4; ++ni) { f32x4 o;
#pragma unroll
                    for (int r = 0; r < 4; ++r) o[r] = ok ? v[ni][r] * rs * gain[16 * ni + 4 * h + r] : 0.f;
                    st_bf4(p + 16 * ni + 4 * h, o); }
            } else { bf16* p = (bf16*)(ws + WS_VCT) + ((size_t)bg * NCP + n) * 64;
#pragma unroll
                for (int ni = 0; ni < 4; ++ni) { f32x4 o;
#pragma unroll
                    for (int r = 0; r < 4; ++r) o[r] = ok ? v[ni][r] : 0.f;
                    st_bf4(p + 16 * ni + 4 * h, o); } }
        }
    }
};


struct EpiResid8 {
    static constexpr bool PERM = true, AFTER_DRAIN = false;
    float* x; const float* gate; const float* xin;
    MDEV void operator()(const f32x4 (&acc)[2][2][4][2], const pg8::Unit& u, int wr, int wc, int fr, int fq) const {
        OPAQUE2(fr, fq);
#pragma unroll
        for (int ai = 0; ai < 2; ++ai)
#pragma unroll
            for (int m = 0; m < 4; ++m) { const int row = 256 * u.pm + 128 * ai + 64 * wr + 16 * m + fr, b = row / SEQ;
#pragma unroll
                for (int bj = 0; bj < 2; ++bj)
#pragma unroll
                    for (int n = 0; n < 2; ++n) { const int col = 256 * u.pn + 128 * bj + 32 * wc + 8 * fq + 4 * n;
                        const f32x4 g = *(const f32x4*)(gate + (size_t)b * 6 * DM + col); f32x4* p = (f32x4*)(x + (size_t)row * DM + col); f32x4 v = *(const f32x4*)(xin + (size_t)row * DM + col);
#pragma unroll
                        for (int r = 0; r < 4; ++r) v[r] += g[r] * acc[ai][bj][m][n][r];
                        *p = v; } }
    }
};
struct EpiGlu8 {
    static constexpr bool PERM = true, AFTER_DRAIN = false;
    bf16* dst;
    MDEV void operator()(const f32x4 (&acc)[2][2][4][2], const pg8::Unit& u, int wr, int wc, int fr, int fq) const {
        OPAQUE2(fr, fq);
#pragma unroll
        for (int ai = 0; ai < 2; ++ai)
#pragma unroll
            for (int m = 0; m < 4; ++m) { const int row = 256 * u.pm + 128 * ai + 64 * wr + 16 * m + fr;
                { const int col = 128 * u.pn + 32 * wc + 8 * fq; f32x4 o0, o1;
#pragma unroll
                    for (int r = 0; r < 4; ++r) { o0[r] = acc[ai][0][m][0][r] * sigm(acc[ai][1][m][0][r]); o1[r] = acc[ai][0][m][1][r] * sigm(acc[ai][1][m][1][r]); }
                    st_bf8(dst + (size_t)row * DM + col, o0, o1); } }
    }
};
struct EpiMoe1_8 {
    static constexpr bool PERM = true, AFTER_DRAIN = false;
    bf16* dst;
    MDEV void operator()(const f32x4 (&acc)[2][2][4][2], const pg8::Unit& u, int wr, int wc, int fr, int fq) const {
        OPAQUE2(fr, fq);
#pragma unroll
        for (int ai = 0; ai < 2; ++ai)
#pragma unroll
            for (int m = 0; m < 4; ++m) { const int row = 256 * u.pm + 128 * ai + 64 * wr + 16 * m + fr;
                const int col = 128 * u.pn + 32 * wc + 8 * fq; f32x4 o0, o1;
#pragma unroll
                for (int r = 0; r < 4; ++r) { o0[r] = siluf(acc[ai][0][m][0][r]) * acc[ai][1][m][0][r]; o1[r] = siluf(acc[ai][0][m][1][r]) * acc[ai][1][m][1][r]; }
#ifdef EMU
                st_bf8(dst + (size_t)row * FF + col, o0, o1); }
#else
                u32x4 pk; pk[0] = pk2(o0[0], o0[1]); pk[1] = pk2(o0[2], o0[3]); pk[2] = pk2(o1[0], o1[1]); pk[3] = pk2(o1[2], o1[3]);
                asm volatile("global_store_dwordx4 %0, %1, off sc1\n\ts_nop 2" :: "v"((__attribute__((address_space(1))) bf16*)(dst + (size_t)row * FF + col)), "v"(pk) : "memory"); }
#endif
    }
};
struct EpiMoe2_8 {
    static constexpr bool PERM = true, AFTER_DRAIN = false;
    bf16* dst;
    MDEV void operator()(const f32x4 (&acc)[2][2][4][2], const pg8::Unit& u, int wr, int wc, int fr, int fq) const {
        OPAQUE2(fr, fq);
#pragma unroll
        for (int ai = 0; ai < 2; ++ai)
#pragma unroll
            for (int m = 0; m < 4; ++m) { const int row = 256 * u.pm + 128 * ai + 64 * wr + 16 * m + fr;
#pragma unroll
                for (int bj = 0; bj < 2; ++bj) { const int col = 256 * u.pn + 128 * bj + 32 * wc + 8 * fq;
                    st_bf8(dst + (size_t)row * DM + col, acc[ai][bj][m][0], acc[ai][bj][m][1]); } }
    }
};
DEV unsigned uni(unsigned x);
template <bool G> struct MoeSel {
    static constexpr bool GATHER = G;
    const int* rb; const int* cnt; const int* list; size_t bstride;
    struct Ctx { int e, rbase, c; };
    MDEV Ctx ctx(const pg8::Unit& u) const { int e = 0;
#pragma unroll 1
        for (int q = 1; q < 32; ++q) if ((rb[q] >> 8) <= u.pm) e = q;
        e = (int)uni((unsigned)e); Ctx x; x.e = e; x.rbase = (int)uni((unsigned)((u.pm << 8) - rb[e])); x.c = G ? (int)uni((unsigned)cnt[e * 64]) : 0; return x; }
    MDEV size_t boff(const Ctx& x) const { return (size_t)x.e * bstride; }
    MDEV unsigned aoff(const Ctx& x, int r) const { int p = x.rbase + r; if (p > x.c - 1) p = x.c - 1; return (unsigned)list[(size_t)x.e * T + p] * (unsigned)(DM * 2); }
};
struct EpiInProj8 {
    static constexpr bool PERM = true, AFTER_DRAIN = false;
    const Args* a; int li;
    MDEV void operator()(const f32x4 (&acc)[2][2][4][2], const pg8::Unit& u, int wr, int wc, int fr, int fq) const {
        OPAQUE2(fr, fq);
        unsigned char* ws = wsp(*a);
        const int nb = 256 * u.pn + 64 * wc;
        if (nb >= 3392) return;
        if (nb < 512 || (nb >= 768 && nb < 896) || (nb >= 1024 && nb < 1152)) {
            const float* gain; float mul = 1.f; int kind;
            if (nb < 512) { gain = INP(*a, I_QG) + li * 64; mul = 0.125f * LOG2E; kind = 0; }
            else if (nb < 896) { gain = INP(*a, I_KG) + (li * 3 + 1) * 64; kind = 1; }
            else { gain = INP(*a, I_KG) + (li * 3 + 2) * 64; kind = 2; }
            const int g = (nb >> 6) & 1;
            f32x4 gv[2][2];
#pragma unroll
            for (int bj = 0; bj < 2; ++bj)
#pragma unroll
                for (int n = 0; n < 2; ++n) gv[bj][n] = *(const f32x4*)(gain + 32 * bj + 8 * fq + 4 * n);
#pragma unroll
            for (int ai = 0; ai < 2; ++ai)
#pragma unroll
                for (int m = 0; m < 4; ++m) { const int tok = 256 * u.pm + 128 * ai + 64 * wr + 16 * m + fr;
                    float ss = 0.f;
#pragma unroll
                    for (int bj = 0; bj < 2; ++bj)
#pragma unroll
                        for (int n = 0; n < 2; ++n) { const f32x4 v = acc[ai][bj][m][n]; ss += v[0] * v[0] + v[1] * v[1] + v[2] * v[2] + v[3] * v[3]; }
                    ss += shflx(ss, 16); ss += shflx(ss, 32);
                    const float rs = frsq(ss * (1.0f / 64.0f) + EPS) * mul;
                    bf16* dst; if (kind == 0) dst = (bf16*)(ws + WS_QN) + (size_t)tok * 512 + nb; else { const int b = tok / SEQ, sq = tok % SEQ; dst = (bf16*)(ws + (kind == 1 ? WS_KS : WS_KW)) + ((size_t)(b * 2 + g) * SEQ + sq) * 64; }
#pragma unroll
                    for (int bj = 0; bj < 2; ++bj) { f32x4 o0, o1;
#pragma unroll
                        for (int r = 0; r < 4; ++r) { o0[r] = acc[ai][bj][m][0][r] * rs * gv[bj][0][r]; o1[r] = acc[ai][bj][m][1][r] * rs * gv[bj][1][r]; }
                        st_bf8(dst + 32 * bj + 8 * fq, o0, o1); } }
        } else if (nb < 768) {
            bf16* base = (bf16*)(ws + (nb < 640 ? WS_KCG : WS_VCG)); const int g = (nb >> 6) & 1;
#pragma unroll
            for (int ai = 0; ai < 2; ++ai)
#pragma unroll
                for (int m = 0; m < 4; ++m) { const int tok = 256 * u.pm + 128 * ai + 64 * wr + 16 * m + fr, b = tok / SEQ, sq = tok % SEQ;
#pragma unroll
                    for (int bj = 0; bj < 2; ++bj) st_bf8(base + ((size_t)(b * 2 + g) * SEQ + sq) * 64 + 32 * bj + 8 * fq, acc[ai][bj][m][0], acc[ai][bj][m][1]); }
        } else if (nb < 1280) {
            bf16* base = (bf16*)(ws + (nb < 1024 ? WS_VST : WS_VWT)); const int g = (nb >> 6) & 1;
#pragma unroll
            for (int ai = 0; ai < 2; ++ai)
#pragma unroll
                for (int m = 0; m < 4; ++m) { const int tok = 256 * u.pm + 128 * ai + 64 * wr + 16 * m + fr, b = tok / SEQ, sq = tok % SEQ;
#pragma unroll
                    for (int bj = 0; bj < 2; ++bj) st_bf8(base + ((size_t)(b * 2 + g) * SEQ + sq) * 64 + 32 * bj + 8 * fq, acc[ai][bj][m][0], acc[ai][bj][m][1]); }
        } else if (nb < 3328) {
            const int sec = (nb - 1280) >> 9, cc = (nb - 1280) & 511, hh = cc >> 7, d0 = cc & 127;
            f32x4 lbv[2][2];
            if (sec == 1) {
#pragma unroll
                for (int bj = 0; bj < 2; ++bj)
#pragma unroll
                    for (int n = 0; n < 2; ++n) lbv[bj][n] = *(const f32x4*)((const float*)(ws + WS_LB) + li * 512 + cc + 32 * bj + 8 * fq + 4 * n); }
#pragma unroll
            for (int ai = 0; ai < 2; ++ai)
#pragma unroll
                for (int m = 0; m < 4; ++m) { const int tok = 256 * u.pm + 128 * ai + 64 * wr + 16 * m + fr, b = tok / SEQ, sq = tok % SEQ;
                    const size_t hrow = ((size_t)(b * 4 + hh) * SEQ + sq) * 128 + d0;
#pragma unroll
                    for (int bj = 0; bj < 2; ++bj) { const int d = 32 * bj + 8 * fq; f32x4 o0, o1;
                        if (sec == 0) {
#pragma unroll
                            for (int r = 0; r < 4; ++r) { o0[r] = siluf(acc[ai][bj][m][0][r]); o1[r] = siluf(acc[ai][bj][m][1][r]); }
                            st_bf8((bf16*)(ws + WS_HQ) + hrow + d, o0, o1); }
                        else if (sec == 1) {
#pragma unroll
                            for (int r = 0; r < 4; ++r) { o0[r] = lbv[bj][0][r] + (1.0f - lbv[bj][0][r]) * sigm(acc[ai][bj][m][0][r]); o1[r] = lbv[bj][1][r] + (1.0f - lbv[bj][1][r]) * sigm(acc[ai][bj][m][1][r]); }
                            float* pf = (float*)(ws + WS_HF) + hrow + d; *(f32x4*)pf = o0; *(f32x4*)(pf + 4) = o1; }
                        else if (sec == 2) st_bf8((bf16*)(ws + WS_HV) + hrow + d, acc[ai][bj][m][0], acc[ai][bj][m][1]);
                        else {
#pragma unroll
                            for (int r = 0; r < 4; ++r) { o0[r] = siluf(acc[ai][bj][m][0][r]); o1[r] = siluf(acc[ai][bj][m][1][r]); }
                            st_bf8((bf16*)(ws + WS_HGS) + (size_t)tok * 512 + cc + d, o0, o1); } } }
        } else {
            float* dst = (float*)(ws + WS_GATE);
            if (fq < 3) {
#pragma unroll
                for (int ai = 0; ai < 2; ++ai)
#pragma unroll
                    for (int m = 0; m < 4; ++m) { const int tok = 256 * u.pm + 128 * ai + 64 * wr + 16 * m + fr; f32x4 o0, o1;
#pragma unroll
                        for (int r = 0; r < 4; ++r) { o0[r] = sigm(acc[ai][0][m][0][r]); o1[r] = sigm(acc[ai][0][m][1][r]); }
                        float* pf = dst + (size_t)tok * 24 + 8 * fq; *(f32x4*)pf = o0; *(f32x4*)(pf + 4) = o1; } }
        }
    }
};

DEV void tr_tile(unsigned char* smem, const float* src0, const float* src1, int ld, int K, int mode, bf16* dst, int n0, int k0) {
    bf16* tl = (bf16*)smem;
    const int tid = TID;
    SYNC();
#pragma unroll
    for (int i = 0; i < 8; ++i) {
        const int e = tid + 512 * i, kk = e >> 6, nn = e & 63, n = n0 + nn; float v = 0.f;
        if (mode == 0) v = src0[(size_t)(k0 + kk) * ld + n];
        else if (mode == 1) { int sc = n < 1280 ? n : (n < 3328 ? n + 24 : (n < 3352 ? 1280 + (n - 3328) : -1)); if (sc >= 0) v = src0[(size_t)(k0 + kk) * ld + sc]; }
        else { const int g = n >> 6, w = n & 63; v = (w < 32) ? src0[(size_t)(k0 + kk) * ld + g * 32 + w] : src1[(size_t)(k0 + kk) * ld + g * 32 + w - 32]; }
        tl[nn * LDT + kk] = (bf16)f2bf(v);
    }
    SYNC();
    const int nn = tid >> 3, k8 = (tid & 7) * 8;
    *(bf16x8*)(dst + (size_t)(n0 + nn) * K + k0 + k8) = *(const bf16x8*)(tl + nn * LDT + k8);
}

DEV int tr_col(int mode, int n) {
    if (mode == 0) return n;
    const int pn = n >> 8, ct = n & 255;
    if (mode == 5) { const int bj = ct >> 7, wc = (ct >> 5) & 3, j = ct & 31, L = 256 * pn + 64 * wc + 32 * bj + j; return L < 1280 ? L : (L < 3328 ? L + 24 : (L < 3352 ? 1280 + (L - 3328) : -1)); }
    { const int bj = ct >> 7, Lc = 128 * pn + (ct & 127); return bj == 0 ? Lc : (mode == 7 ? FF : DM) + Lc; }
}
DEV void tr_tile(unsigned char* smem, const float* src, int ld, int K, int mode, bf16* dst, int n0, int k0) {
    bf16* tl = (bf16*)smem;
    const int tid = TID, nq = tid & 31, kq = tid >> 5;
    const int sc = tr_col(mode, n0 + 4 * nq);
    f32x4 v[4];
#pragma unroll
    for (int i = 0; i < 4; ++i) v[i] = sc >= 0 ? *(const f32x4*)(src + (size_t)(k0 + 4 * kq + i) * ld + sc) : f4zero();
    SYNC();
#pragma unroll
    for (int j = 0; j < 4; ++j) { u32x2 w; w[0] = pk2(v[0][j], v[1][j]); w[1] = pk2(v[2][j], v[3][j]); *(u32x2*)(tl + (4 * nq + j) * LDT + 4 * kq) = w; }
    SYNC();
#pragma unroll
    for (int t = 0; t < 2; ++t) { const int id = tid + 512 * t, row = id >> 3, ch = id & 7;
        *(bf16x8*)(dst + (size_t)(n0 + row) * K + k0 + 8 * ch) = *(const bf16x8*)(tl + row * LDT + 8 * ch); }
}
constexpr int KSUP = FF >= 256 ? 256 : FF, NSUP = KSUP / 64;
DEV void tr_super(unsigned char* smem, const float* src0, const float* src1, int ld, int K, int mode, bf16* dst, int n0, int k0) {
    const int tid = TID, nq = tid & 31, kq = tid >> 5;
    int sc = n0 + 4 * nq; const float* src = src0;
    if (mode == 7) { const int cc = tr_col(7, sc); src = cc >= FF ? src1 : src0; sc = cc >= FF ? cc - FF : cc; }
    else if (mode != 0) sc = tr_col(mode, sc);
    f32x4 v[NSUP][4];
#pragma unroll
    for (int sb = 0; sb < NSUP; ++sb)
#pragma unroll
        for (int i = 0; i < 4; ++i) v[sb][i] = sc >= 0 ? *(const f32x4*)(src + (size_t)(k0 + 64 * sb + 4 * kq + i) * ld + sc) : f4zero();
    SYNC();
    const int fw = nq & (KSUP / 16 - 1);
#pragma unroll
    for (int j = 0; j < 4; ++j)
#pragma unroll
        for (int sb = 0; sb < NSUP; ++sb) { const int c16 = 8 * sb + (kq >> 1); u32x2 w; w[0] = pk2(v[sb][0][j], v[sb][1][j]); w[1] = pk2(v[sb][2][j], v[sb][3][j]);
            *(u32x2*)(smem + (4 * nq + j) * (KSUP * 2) + ((c16 ^ fw) << 4) + (kq & 1) * 8) = w; }
    SYNC();
#pragma unroll
    for (int t = 0; t < 128 * (KSUP / 8) / NT; ++t) { const int id = tid + NT * t, row = id / (KSUP / 8), ch = id % (KSUP / 8), f = (row >> 2) & (KSUP / 16 - 1);
        *(bf16x8*)(dst + (size_t)(n0 + row) * K + k0 + 8 * (ch ^ f)) = *(const bf16x8*)(smem + row * (KSUP * 2) + ch * 16); }
}
constexpr int MOE_S13 = (2 * FF / 128) * (DM / KSUP), MOE_S2 = (DM / 128) * (FF / KSUP), MOE_SPE = MOE_S13 + MOE_S2, MOE_NIT = DEPTH * 32 * MOE_SPE;
DEV void moe_conv_tile(const Args& a, unsigned char* smem, int it) {
    unsigned char* ws = wsp(a); const int le = it / MOE_SPE, r = it % MOE_SPE;
    if (r < MOE_S13) { const int tn = r % (2 * FF / 128), tk = r / (2 * FF / 128);
        tr_super(smem, INP(a, I_W1) + (size_t)le * DM * FF, INP(a, I_W3) + (size_t)le * DM * FF, FF, DM, 7, (bf16*)(ws + WS_W13) + (size_t)le * 2 * FF * DM, tn * 128, tk * KSUP); }
    else { const int r2 = r - MOE_S13, tn = r2 % (DM / 128), tk = r2 / (DM / 128);
        tr_super(smem, INP(a, I_W2) + (size_t)le * FF * DM, INP(a, I_W2), DM, FF, 0, (bf16*)(ws + WS_W2) + (size_t)le * DM * FF, tn * 128, tk * KSUP); }
}
#ifndef EMU
constexpr int MOE_TAIL_Q = 3;
constexpr int MOE_N0 = MOE_NIT - 2 * MOE_TAIL_Q * (128 + 224) > 2 * 32 * MOE_SPE ? MOE_NIT - 2 * MOE_TAIL_Q * (128 + 224) : 2 * 32 * MOE_SPE;
DEV int moe_conv_fetch(const Args& a, unsigned char* smem) {
    int* ctr = (int*)(wsp(a) + WS_BAR) + P0_CTR_IDX; int* nxl = (int*)(smem + 72 * 1024);
    SYNC(); if (TID == 0) nxl[0] = atomic_add_i(ctr, 1); SYNC(); return nxl[0];
}
DEV void moe_conv_pull(const Args& a, unsigned char* smem, int quota) {
    for (int q = 0; q < quota; ++q) { const int it = moe_conv_fetch(a, smem); if (it >= MOE_NIT) break; moe_conv_tile(a, smem, it); }
    SYNC();
}
DEV void moe_conv_drain(const Args& a, unsigned char* smem, int limit) {
    __attribute__((address_space(1))) unsigned* ctr = (__attribute__((address_space(1))) unsigned*)((unsigned*)(wsp(a) + WS_BAR) + P0_CTR_IDX);
    for (;;) { if ((int)__builtin_amdgcn_readfirstlane((int)__hip_atomic_load(ctr, __ATOMIC_RELAXED, __HIP_MEMORY_SCOPE_AGENT)) >= limit) break;
        const int it = moe_conv_fetch(a, smem); if (it >= MOE_NIT) break; moe_conv_tile(a, smem, it); }
    SYNC();
}
#endif
struct TrJob { const float* s; int ld, K, N, mode; bf16* dst; };
DEV void p0_phase(const Args& a, unsigned char* smem) {
    unsigned char* ws = wsp(a); const int tid = TID;
    { int item = BID, base = 0;
      for (int j = 0; j < 8; ++j) { TrJob J; const int i = j & 1;
        if (j < 2) J = {INP(a, I_WIN) + (size_t)i * DM * NIN, NIN, DM, NIN8, 5, (bf16*)(ws + WS_WIN) + (size_t)i * NIN8 * DM};
        else if (j < 4) J = {INP(a, I_WOUT) + (size_t)i * 1024 * DM, DM, 1024, DM, 0, (bf16*)(ws + WS_WOUT) + (size_t)i * DM * 1024};
        else if (j < 6) J = {INP(a, I_PW1) + (size_t)i * DM * 2 * DM, 2 * DM, DM, 2 * DM, 6, (bf16*)(ws + WS_PW1) + (size_t)i * 2 * DM * DM};
        else J = {INP(a, I_PW2) + (size_t)i * DM * DM, DM, DM, DM, 0, (bf16*)(ws + WS_PW2) + (size_t)i * DM * DM};
        const int tn = J.N / 128, tk = J.K / KSUP, nt = tn * tk;
        while (item < base + nt) { const int it = item - base; tr_super(smem, J.s, J.s, J.ld, J.K, J.mode, J.dst, (it % tn) * 128, (it / tn) * KSUP); item += NBLK; }
        base += nt; }
      SYNC(); }
    {
        float* red = (float*)smem;
        constexpr int NG = 6 * DM / 128; const int ntask = DEPTH * NG;
        for (int t = BID; t < ntask; t += NBLK) {
            const int l = t / NG, j0 = (t % NG) * 128, cq = tid & 31, kr = tid >> 5;
            const float* w = INP(a, I_ADAW) + (size_t)l * DM * 6 * DM + j0 + 4 * cq; const float* cc = INP(a, I_C);
            f32x4 a0 = f4zero(), a1 = f4zero();
#pragma unroll 8
            for (int i = 0; i < DM / 16; ++i) { const int k = kr + 16 * i; const f32x4 wv = *(const f32x4*)(w + (size_t)k * 6 * DM); const float s0 = siluf(cc[k]), s1 = siluf(cc[DM + k]);
#pragma unroll
                for (int r = 0; r < 4; ++r) { a0[r] += s0 * wv[r]; a1[r] += s1 * wv[r]; } }
            SYNC();
            *(f32x4*)(red + (kr * 2 + 0) * 128 + 4 * cq) = a0; *(f32x4*)(red + (kr * 2 + 1) * 128 + 4 * cq) = a1;
            SYNC();
            if (tid < 256) { const int b = tid >> 7, col = tid & 127; float sum = INP(a, I_ADAB)[(size_t)l * 6 * DM + j0 + col];
#pragma unroll
                for (int q = 0; q < 16; ++q) sum += red[(q * 2 + b) * 128 + col];
                ((float*)(ws + WS_MOD))[((size_t)l * 2 + b) * 6 * DM + j0 + col] = sum; }
        }
    }
    for (int t = BID; t < 32; t += NBLK) {
        float* red = (float*)smem; const int ikv = t >> 3, kp = t & 7, i = ikv >> 1, kv = ikv & 1, e = tid & 63, ks = tid >> 6;
        const float* W = INP(a, kv ? I_CWV : I_CWK) + (size_t)i * 2048 * 64 + e; const float* pe = INP(a, I_CPE) + (size_t)i * 2048;
        float sum = 0.f;
#pragma unroll 8
        for (int q = 0; q < 32; ++q) { const int k = kp * 256 + ks * 32 + q; sum += pe[k] * W[(size_t)k * 64]; }
        SYNC(); red[ks * 64 + e] = sum; SYNC();
        if (tid < 64) { float v = 0.f; for (int q = 0; q < 8; ++q) v += red[q * 64 + tid]; ((float*)(ws + WS_CB))[(ikv * 8 + kp) * 64 + tid] = v; }
    }
    for (int i = BID * NT + tid; i < DEPTH * 48 * DM; i += NBLK * NT) { const int k = i % DM, n = (i / DM) % 48, ll = i / (48 * DM);
        const float wv = n < 4 ? INP(a, I_WG)[((size_t)ll * DM + k) * 4 + n] : (n < 36 ? INP(a, I_WE)[((size_t)ll * DM + k) * 32 + n - 4] : 0.f);
        const unsigned hi = f2bf(wv); ((bf16*)(ws + WS_WTH))[i] = (bf16)hi; ((bf16*)(ws + WS_WTL))[i] = (bf16)f2bf(wv - bf2f(hi)); }
    if (BID == 0) {
        for (int i = tid; i < DEPTH * 32; i += NT) ((int*)(ws + WS_CNT))[i * 64] = 0;
        for (int i = tid; i < DEPTH * 256; i += NT) ((unsigned*)(ws + WS_FLG))[i * 16] = 0u;
        for (int n = tid; n < 512; n += NT) { const float l0 = INP(a, I_LBL)[n], l1 = INP(a, I_LBL)[512 + n]; const float m = fmaxf(l0, l1);
            const float e0 = fexp2((l0 - m) * LOG2E), e1 = fexp2((l1 - m) * LOG2E);
            ((float*)(ws + WS_LB))[n] = 0.f; ((float*)(ws + WS_LB))[512 + n] = e1 / (e0 + e1); }
        if (tid < 2) { const int i = tid; float mq = 0.f; for (int d = 0; d < 64; ++d) mq = fmaxf(mq, fabsf(INP(a, I_QG)[i * 64 + d]));
            for (int br = 0; br < 3; ++br) { float mk = 0.f; for (int d = 0; d < 64; ++d) mk = fmaxf(mk, fabsf(INP(a, I_KG)[(i * 3 + br) * 64 + d]));
                ((float*)(ws + WS_CS))[i * 4 + br] = 8.0f * mq * mk * LOG2E; } }
    }
    SYNC();
    {
#ifdef EMU
      for (int it = BID; it < MOE_NIT; it += NBLK) moe_conv_tile(a, smem, it);
#else
      int* ctr = (int*)(ws + WS_BAR) + P0_CTR_IDX; int* nxl = (int*)(smem + 72 * 1024);
      int my_next = 0; if (tid == 0) my_next = atomic_add_i(ctr, 1);
      for (;;) { if (tid == 0) nxl[0] = my_next; SYNC(); const int it = nxl[0]; if (it >= MOE_NIT) break;
          const bool more = it < MOE_N0;
          if (more && tid == 0) my_next = atomic_add_i(ctr, 1);
          moe_conv_tile(a, smem, it);
          if (!more) break; }
#endif
      SYNC(); }
}

constexpr int NJV = DM / 256;
DEV void moe_bases(const int* cnt, int* rb  ) {
    if (TID == 0) { int acc = 0; for (int e = 0; e < 32; ++e) { rb[e] = acc; acc += ((cnt[e * 64] + 255) >> 8) << 8; } rb[32] = acc; }
    SYNC();
}
DEV void norm_phase(const Args& a, unsigned char* smem, int l) {
    unsigned char* ws = wsp(a); const int tid = TID, w = tid >> 6, lane = tid & 63;
    int* rb = (int*)smem;
    if (l > 0) moe_bases((const int*)(ws + WS_CNT) + (l - 1) * 32 * 64, rb);
    const float* mod = (const float*)(ws + WS_MOD);
    const bf16* yk = (const bf16*)(ws + WS_YK);
    if (l < DEPTH) {
        const int bid = BID % 76 == BID ? BID : -1;
        for (int job = BID; job < 76; job += NBLK) {
            if (job < 72) { const int b = job / 36, n = job % 36; float sum = 0.f;
                for (int k = tid; k < DM; k += NT) { const float wv = n < 4 ? INP(a, I_WG)[((size_t)l * DM + k) * 4 + n] : INP(a, I_WE)[((size_t)l * DM + k) * 32 + n - 4]; sum += mod[((size_t)l * 2 + b) * 6 * DM + 3 * DM + k] * wv; }
#pragma unroll
                for (int q = 1; q < 64; q <<= 1) sum += shflx(sum, q);
                float* red = (float*)(smem + 1024);
                SYNC(); if (lane == 0) red[w] = sum; SYNC();
                if (tid == 0) { float t = 0.f; for (int q = 0; q < 8; ++q) t += red[q]; ((float*)(ws + WS_RBIAS))[((size_t)l * 2 + b) * 48 + n] = t; }
            } else { const float* nf = INP(a, I_NFFN) + (size_t)l * DM; const int part = job - 72;
                for (int i = part * (2 * DM / 4) + tid; i < (part + 1) * (2 * DM / 4); i += NT) { const int b = i / DM, k = i % DM; ((float*)(ws + WS_AVEC))[((size_t)l * 2 + b) * DM + k] = nf[k] * (1.0f + mod[((size_t)l * 2 + b) * 6 * DM + 4 * DM + k]); } }
        }
        (void)bid;
    }
    const int rstride = NBLK * 8;
    for (int rowa = BID * 8 + w; rowa < T; rowa += 2 * rstride) {
        int row[2]; bool ok[2];
        row[0] = rowa; ok[0] = true; row[1] = rowa + rstride; ok[1] = row[1] < T; if (!ok[1]) row[1] = rowa;
        f32x4 v[2][NJV]; int e0[2], p0[2], e1[2], p1[2]; float w0[2], w1[2];
        const float* xin = (l == 0) ? INP(a, I_X) : outp(a);
#pragma unroll
        for (int q = 0; q < 2; ++q) {
#pragma unroll
            for (int j = 0; j < NJV; ++j) v[q][j] = *(const f32x4*)(xin + (size_t)row[q] * DM + 4 * lane + 256 * j);
            if (l > 0) { const int* tie = (const int*)(ws + WS_TIE) + (size_t)row[q] * 2; const float* tiw = (const float*)(ws + WS_TIW) + (size_t)row[q] * 2;
                e0[q] = tie[0] >> 14; p0[q] = tie[0] & 16383; e1[q] = tie[1] >> 14; p1[q] = tie[1] & 16383; w0[q] = tiw[0]; w1[q] = tiw[1]; } }
        if (l > 0) {
            u32x2 q0[2][NJV], q1[2][NJV];
#pragma unroll
            for (int q = 0; q < 2; ++q) { const bf16* y0 = yk + (size_t)(rb[e0[q]] + p0[q]) * DM; const bf16* y1 = yk + (size_t)(rb[e1[q]] + p1[q]) * DM;
#pragma unroll
                for (int j = 0; j < NJV; ++j) { const int cidx = 4 * lane + 256 * j; q0[q][j] = *(const u32x2*)(y0 + cidx); q1[q][j] = *(const u32x2*)(y1 + cidx); } }
#pragma unroll
            for (int q = 0; q < 2; ++q) { const int b = row[q] / SEQ; const float* gf = mod + ((size_t)(l - 1) * 2 + b) * 6 * DM + 5 * DM;
#pragma unroll
                for (int j = 0; j < NJV; ++j) { const int cidx = 4 * lane + 256 * j; const f32x4 g = *(const f32x4*)(gf + cidx);
                    v[q][j][0] += g[0] * (w0[q] * bf2f(q0[q][j][0] & 0xffff) + w1[q] * bf2f(q1[q][j][0] & 0xffff));
                    v[q][j][1] += g[1] * (w0[q] * bf2f(q0[q][j][0] >> 16) + w1[q] * bf2f(q1[q][j][0] >> 16));
                    v[q][j][2] += g[2] * (w0[q] * bf2f(q0[q][j][1] & 0xffff) + w1[q] * bf2f(q1[q][j][1] & 0xffff));
                    v[q][j][3] += g[3] * (w0[q] * bf2f(q0[q][j][1] >> 16) + w1[q] * bf2f(q1[q][j][1] >> 16)); } }
        }
        if (l > 0)
#pragma unroll
        for (int q = 0; q < 2; ++q) { if (!ok[q]) continue;
#pragma unroll
            for (int j = 0; j < NJV; ++j) *(f32x4*)(outp(a) + (size_t)row[q] * DM + 4 * lane + 256 * j) = v[q][j]; }
        if (l == DEPTH) continue;
        float ss[2];
#pragma unroll
        for (int q = 0; q < 2; ++q) { ss[q] = 0.f;
#pragma unroll
            for (int j = 0; j < NJV; ++j) ss[q] += v[q][j][0] * v[q][j][0] + v[q][j][1] * v[q][j][1] + v[q][j][2] * v[q][j][2] + v[q][j][3] * v[q][j][3]; }
#pragma unroll
        for (int o = 1; o < 64; o <<= 1) { ss[0] += shflx(ss[0], o); ss[1] += shflx(ss[1], o); }
        const float* nm = INP(a, I_NMIX) + (size_t)l * DM;
#pragma unroll
        for (int q = 0; q < 2; ++q) { if (!ok[q]) continue;
            const int b = row[q] / SEQ; const float rs = frsq(ss[q] * (1.0f / DM) + EPS);
            const float* mm = mod + ((size_t)l * 2 + b) * 6 * DM; bf16* hb = (bf16*)(ws + WS_H) + (size_t)row[q] * DM;
#pragma unroll
            for (int j = 0; j < NJV; ++j) { const int cidx = 4 * lane + 256 * j; f32x4 g = *(const f32x4*)(nm + cidx), sh = *(const f32x4*)(mm + cidx), sc = *(const f32x4*)(mm + DM + cidx), o;
#pragma unroll
                for (int r = 0; r < 4; ++r) o[r] = v[q][j][r] * rs * g[r] * (1.0f + sc[r]) + sh[r];
                st_bf4(hb + cidx, o); } }
    }
}

DEV void route_phase(const Args& a, unsigned char* smem, int l) {
    unsigned char* ws = wsp(a); const int tid = TID, w = tid >> 6, lane = tid & 63, h = lane >> 4, c = lane & 15, pi = w >> 1, kh = w & 1;
    constexpr int NCHK = 4, CH = DM / NCHK, WLD = CH + 8, NKS = CH / 2 / 32;
    constexpr int WTOT = 48 * (CH / 8), WMAX = (WTOT + NT - 1) / NT;
    bf16* WHl = (bf16*)smem; bf16* WLl = WHl + 48 * WLD;
    float* lg = (float*)(WLl + 48 * WLD);
    float* ssb = lg + 4 * 2 * 16 * 48;
    float* rsb = ssb + 4 * 2 * 16;
    int* lcnt = (int*)(rsb + 64); int* lbase = lcnt + 32; int* tinfo = lbase + 32;
    float* avl = (float*)(tinfo + 256); float* cvl = avl + 2 * DM;
    const float* mod = (const float*)(ws + WS_MOD);
    SYNC();
    if (tid < 32) lcnt[tid] = 0;
    for (int i = tid; i < 2 * DM; i += NT) { const int b = i / DM, k = i % DM; avl[i] = ((const float*)(ws + WS_AVEC))[((size_t)l * 2 + b) * DM + k]; cvl[i] = mod[((size_t)l * 2 + b) * 6 * DM + 3 * DM + k]; }
    const bf16* WH = (const bf16*)(ws + WS_WTH) + (size_t)l * 48 * DM; const bf16* WL = (const bf16*)(ws + WS_WTL) + (size_t)l * 48 * DM;
    int* cnt = (int*)(ws + WS_CNT) + l * 32 * 64;
    for (int pass0 = BID; pass0 < T / 16; pass0 += 4 * NBLK) {
        const int pass = pass0 + pi * NBLK; const bool valid = pass < T / 16;
        const int tok = valid ? pass * 16 + c : 0, b = tok / SEQ;
        const float* xrow = outp(a) + (size_t)tok * DM;
        f32x4 xv[2][NKS][2]; bf16x8 wh[WMAX], wl[WMAX];
#pragma unroll
        for (int ks = 0; ks < NKS; ++ks) { const float* xq = xrow + kh * (CH / 2) + 8 * h + 32 * ks; xv[0][ks][0] = *(const f32x4*)xq; xv[0][ks][1] = *(const f32x4*)(xq + 4); }
#pragma unroll
        for (int t = 0; t < WMAX; ++t) { const int i = tid + NT * t; if (i < WTOT) { const int n = i / (CH / 8), k8 = (i % (CH / 8)) * 8; wh[t] = *(const bf16x8*)(WH + (size_t)n * DM + k8); wl[t] = *(const bf16x8*)(WL + (size_t)n * DM + k8); } }
        f32x4 acc[3] = {f4zero(), f4zero(), f4zero()}; float ss = 0.f;
        bf16x8 uhk[NCHK * NKS];
#pragma unroll
        for (int chn = 0; chn < NCHK; ++chn) {
            SYNC();
#pragma unroll
            for (int t = 0; t < WMAX; ++t) { const int i = tid + NT * t; if (i < WTOT) { const int n = i / (CH / 8), k8 = (i % (CH / 8)) * 8; *(bf16x8*)(WHl + n * WLD + k8) = wh[t]; *(bf16x8*)(WLl + n * WLD + k8) = wl[t]; } }
            SYNC();
            if (chn + 1 < NCHK) {
#pragma unroll
                for (int ks = 0; ks < NKS; ++ks) { const float* xq = xrow + (chn + 1) * CH + kh * (CH / 2) + 8 * h + 32 * ks; xv[(chn + 1) & 1][ks][0] = *(const f32x4*)xq; xv[(chn + 1) & 1][ks][1] = *(const f32x4*)(xq + 4); }
#pragma unroll
                for (int t = 0; t < WMAX; ++t) { const int i = tid + NT * t; if (i < WTOT) { const int n = i / (CH / 8), k8 = (i % (CH / 8)) * 8; wh[t] = *(const bf16x8*)(WH + (size_t)n * DM + (chn + 1) * CH + k8); wl[t] = *(const bf16x8*)(WL + (size_t)n * DM + (chn + 1) * CH + k8); } }
            }
            if (valid) {
                const bf16* whp = WHl + c * WLD + kh * (CH / 2) + 8 * h; const bf16* wlp = WLl + c * WLD + kh * (CH / 2) + 8 * h;
                const float* ap = avl + b * DM + chn * CH + kh * (CH / 2) + 8 * h;
#pragma unroll
                for (int ks = 0; ks < NKS; ++ks) {
                    const f32x4 a0 = *(const f32x4*)(ap + 32 * ks), a1 = *(const f32x4*)(ap + 32 * ks + 4);
                    const f32x4 x0 = xv[chn & 1][ks][0], x1 = xv[chn & 1][ks][1];
                    f32x4 u0, u1, r0, r1;
#pragma unroll
                    for (int r = 0; r < 4; ++r) { u0[r] = x0[r] * a0[r]; u1[r] = x1[r] * a1[r]; ss += x0[r] * x0[r] + x1[r] * x1[r]; }
                    const bf16x8 uh = pack8(u0, u1); uhk[chn * NKS + ks] = uh;
#pragma unroll
                    for (int r = 0; r < 4; ++r) { r0[r] = u0[r] - bf2f((unsigned short)uh[r]); r1[r] = u1[r] - bf2f((unsigned short)uh[4 + r]); }
                    const bf16x8 ul = pack8(r0, r1);
#pragma unroll
                    for (int nt = 0; nt < 3; ++nt) { const bf16x8 whf = *(const bf16x8*)(whp + nt * 16 * WLD + 32 * ks), wlf = *(const bf16x8*)(wlp + nt * 16 * WLD + 32 * ks);
                        acc[nt] = mfma16(whf, uh, acc[nt]); acc[nt] = mfma16(wlf, uh, acc[nt]); acc[nt] = mfma16(whf, ul, acc[nt]); }
                }
            }
        }
        if (valid) {
            ss += shflx(ss, 16); ss += shflx(ss, 32);
            float* lgp = lg + ((pi * 2 + kh) * 16 + c) * 48 + 4 * h;
#pragma unroll
            for (int nt = 0; nt < 3; ++nt) *(f32x4*)(lgp + 16 * nt) = acc[nt];
            if (h == 0) ssb[(pi * 2 + kh) * 16 + c] = ss;
        }
        SYNC();
        if (tid < 64) { const int p2 = tid >> 4, tk = tid & 15, pass2 = pass0 + p2 * NBLK;
            if (pass2 < T / 16) { const int tok2 = pass2 * 16 + tk, b2 = tok2 / SEQ;
                const float rs = frsq((ssb[(p2 * 2 + 0) * 16 + tk] + ssb[(p2 * 2 + 1) * 16 + tk]) * (1.0f / DM) + EPS); rsb[p2 * 16 + tk] = rs;
                const float* l0 = lg + ((p2 * 2 + 0) * 16 + tk) * 48; const float* l1 = lg + ((p2 * 2 + 1) * 16 + tk) * 48; const float* rbp = (const float*)(ws + WS_RBIAS) + ((size_t)l * 2 + b2) * 48;
                float acc[36];
#pragma unroll
                for (int n = 0; n < 36; ++n) acc[n] = rs * (l0[n] + l1[n]) + rbp[n];
                int gs = 0; float gm = acc[0];
#pragma unroll
                for (int g = 1; g < 4; ++g) if (acc[g] > gm) { gm = acc[g]; gs = g; }
                float den = 0.f;
#pragma unroll
                for (int g = 0; g < 4; ++g) den += fexp2((acc[g] - gm) * LOG2E);
                const float ggate = 1.0f / den;
                float el[8];
#pragma unroll
                for (int j = 0; j < 8; ++j) { el[j] = acc[4 + j];
#pragma unroll
                    for (int g = 1; g < 4; ++g) if (gs == g) el[j] = acc[4 + 8 * g + j]; }
                int ia = 0; float va = el[0];
#pragma unroll
                for (int j = 1; j < 8; ++j) if (el[j] > va) { va = el[j]; ia = j; }
                int ib = -1; float vb = -3e38f;
#pragma unroll
                for (int j = 0; j < 8; ++j) if (j != ia && el[j] > vb) { vb = el[j]; ib = j; }
                const float wa = 1.0f / (1.0f + fexp2((vb - va) * LOG2E)), wb = 1.0f - wa;
                const int e0 = gs * 8 + ia, e1 = gs * 8 + ib;
                const int p0 = atomic_add_i(lcnt + e0, 1), p1 = atomic_add_i(lcnt + e1, 1);
                int* ti = tinfo + tid * 4;
                ti[0] = (e0 << 14) | p0; ti[1] = (e1 << 14) | p1; ti[2] = __builtin_bit_cast(int, ggate * wa); ti[3] = __builtin_bit_cast(int, ggate * wb);
            } }
        SYNC();
        int gbase = 0;
        if (tid < 32) { const int n = lcnt[tid]; gbase = n > 0 ? atomic_add_i(cnt + tid * 64, n) : 0; }
        if (valid) { const float rs = rsb[pi * 16 + c]; bf16* hb = (bf16*)(ws + WS_H) + (size_t)tok * DM + kh * (CH / 2) + 8 * h;
            const float* cp = cvl + b * DM + kh * (CH / 2) + 8 * h;
#pragma unroll
            for (int chn = 0; chn < NCHK; ++chn)
#pragma unroll
                for (int ks = 0; ks < NKS; ++ks) {
                    const bf16x8 uh = uhk[chn * NKS + ks]; const f32x4 c0 = *(const f32x4*)(cp + chn * CH + 32 * ks), c1 = *(const f32x4*)(cp + chn * CH + 32 * ks + 4);
                    f32x4 o0, o1;
#pragma unroll
                    for (int r = 0; r < 4; ++r) { o0[r] = bf2f((unsigned short)uh[r]) * rs + c0[r]; o1[r] = bf2f((unsigned short)uh[4 + r]) * rs + c1[r]; }
                    st_bf8(hb + chn * CH + 32 * ks, o0, o1); } }
        if (tid < 32) { lbase[tid] = gbase; lcnt[tid] = 0; }
        SYNC();
        if (tid < 64) { const int p2 = tid >> 4, pass2 = pass0 + p2 * NBLK;
            if (pass2 < T / 16) { const int tok2 = pass2 * 16 + (tid & 15); const int* ti = tinfo + tid * 4;
                const int e0 = ti[0] >> 14, e1 = ti[1] >> 14, p0 = lbase[e0] + (ti[0] & 16383), p1 = lbase[e1] + (ti[1] & 16383);
                int* list = (int*)(ws + WS_LIST); list[(size_t)e0 * T + p0] = tok2; list[(size_t)e1 * T + p1] = tok2;
                int* tie = (int*)(ws + WS_TIE) + (size_t)tok2 * 2; int* tiw = (int*)(ws + WS_TIW) + (size_t)tok2 * 2;
                tie[0] = (e0 << 14) | p0; tie[1] = (e1 << 14) | p1; tiw[0] = ti[2]; tiw[1] = ti[3]; } }
        SYNC();
    }
}

DEV int vbid() { const int g = NBLK; return (g % 8 == 0) ? (BID % 8) * (g / 8) + BID / 8 : BID; }
#ifdef EMU
#define PG8_LDS(p) (p)
#else
#define PG8_LDS(p) ((PG8_LAS unsigned char*)(p))
#endif
DEV void inproj_phase(const Args& a, unsigned char* smem, int li) {
    pg8::Gemm g{(const bf16*)(wsp(a) + WS_H), (const bf16*)(wsp(a) + WS_WIN) + (size_t)li * NIN8 * DM, T, NIN8, DM}; pg8::StaticOrder S; S.init(T, NIN8, NBLK, BID);
    EpiInProj8 E{&a, li};
    SYNC(); pg8::gemm_phase<EpiInProj8, pg8::StaticOrder, true, true>(PG8_LDS(smem), g, S, E); SYNC();
#ifndef EMU
    { pg8::Unit u; const int full = (T / 256) * (NIN8 / 256) / NBLK; if (!S.next(full, u)) moe_conv_pull(a, smem, MOE_TAIL_Q); }
#endif
}
DEV void resid_gemm_phase(const Args& a, unsigned char* smem, const bf16* A, int K, const bf16* Bt, int l) {
    pg8::Gemm g{A, Bt, T, DM, K}; pg8::StaticOrder S; S.init(T, DM, NBLK, BID);
    EpiResid8 E{outp(a), (const float*)(wsp(a) + WS_MOD) + (size_t)l * 2 * 6 * DM + 2 * DM, l == 0 ? INP(a, I_X) : (const float*)outp(a)};
    SYNC(); pg8::gemm_phase<EpiResid8, pg8::StaticOrder, true, true>(PG8_LDS(smem), g, S, E); SYNC();
}
DEV void pw1_phase(const Args& a, unsigned char* smem, int li) {
    pg8::Gemm g{(const bf16*)(wsp(a) + WS_H), (const bf16*)(wsp(a) + WS_PW1) + (size_t)li * 2 * DM * DM, T, 2 * DM, DM}; pg8::StaticOrder S; S.init(T, 2 * DM, NBLK, BID);
    EpiGlu8 E{(bf16*)(wsp(a) + WS_GLU)};
    SYNC(); pg8::gemm_phase<EpiGlu8, pg8::StaticOrder, true, true>(PG8_LDS(smem), g, S, E); SYNC();
}
DEV void cmp_phase_items(const Args& a, unsigned char* smem, int li, int it) {
    constexpr int TMC = (NCP + 255) / 256;
    const int kv = it / (4 * TMC), bg = (it / TMC) % 4, tm = it % TMC;
    const bf16* src = (const bf16*)(wsp(a) + (kv ? WS_VCG : WS_KCG)) + (size_t)bg * SEQ * 64;
    struct AF { const bf16* base; int m0; MDEV unsigned off(int r) const { int n = m0 + r; if (n > NCMP - 1) n = NCMP - 1; return (unsigned)n * 1024u; } } af{src, tm * 256};
    EpiCmp E{&a, kv, bg, tm * 256, li};
    BClamp64 bf{INP(a, kv ? I_CWV : I_CWK) + (size_t)li * 2048 * 64};
    gemm_tile2(smem, af, bf, 64, 2048, E);
}
#ifdef EMU
DEV void wt_store64(void* p, unsigned long long v) { *(unsigned long long*)p = v; }
DEV unsigned ctr_add(unsigned* p, unsigned v) { return __atomic_fetch_add(p, v, __ATOMIC_SEQ_CST); }
DEV void acq_fence() {}
DEV void drain_stores() {}
typedef unsigned* ctr_ptr;
#else
DEV void wt_store64(void* p, unsigned long long v) { __hip_atomic_store((__attribute__((address_space(1))) unsigned long long*)p, v, __ATOMIC_RELAXED, __HIP_MEMORY_SCOPE_AGENT); }
typedef __attribute__((address_space(1))) unsigned* ctr_ptr;
DEV unsigned ctr_add(ctr_ptr p, unsigned v) { return __hip_atomic_fetch_add(p, v, __ATOMIC_RELAXED, __HIP_MEMORY_SCOPE_AGENT); }
DEV void acq_fence() { __builtin_amdgcn_fence(__ATOMIC_ACQUIRE, "agent"); }
DEV void drain_stores() { asm volatile("s_waitcnt vmcnt(0)" ::: "memory"); }
#endif
struct EpiCmpPart { float* P;
    MDEV void operator()(f32x4 (&acc)[4][4], int mw, int nw, int h, int c) const {
        if (nw != 0) return;
        const int idx = mw + 16 * h + c;
#pragma unroll
        for (int ni = 0; ni < 4; ++ni)
#pragma unroll
            for (int mi = 0; mi < 4; ++mi) { float* p = P + ((size_t)(ni * 4 + mi) * 256 + idx) * 4;
                const u32x4 u = __builtin_bit_cast(u32x4, acc[ni][mi]);
                wt_store64(p, (unsigned long long)u[0] | ((unsigned long long)u[1] << 32));
                wt_store64(p + 2, (unsigned long long)u[2] | ((unsigned long long)u[3] << 32)); }
    }
};
DEV void cmp_split_item(const Args& a, unsigned char* smem, int li, int item, ctr_ptr tilec) {
    constexpr int TMC = (NCP + 255) / 256, S = CMP_SPLIT, KP = 2048 / S;
    unsigned char* ws = wsp(a);
    const int tile = item / S, sp = item % S;
    const int kv = tile / (4 * TMC), bg = (tile / TMC) % 4, tm = tile % TMC;
    const bf16* src = (const bf16*)(ws + (kv ? WS_VCG : WS_KCG)) + (size_t)bg * SEQ * 64;
    struct AF { const bf16* base; int m0; MDEV unsigned off(int r) const { int n = m0 + r; if (n > NCMP - 1) n = NCMP - 1; return (unsigned)n * 1024u; } } af{src + sp * KP, tm * 256};
    float* Pt = (float*)(ws + WS_CMPP) + (size_t)tile * S * 16 * 256 * 4;
    EpiCmpPart E{Pt + (size_t)sp * 16 * 256 * 4};
    BClamp64 bf{INP(a, kv ? I_CWV : I_CWK) + (size_t)li * 2048 * 64 + (size_t)sp * KP * 64};
    gemm_tile2(smem, af, bf, 64, KP, E);
    drain_stores(); SYNC();
    int* fl = (int*)(smem + LDS_BYTES - 128);
    if (TID == 0) fl[0] = (int)ctr_add(tilec + tile, 1u);
    SYNC();
    if (fl[0] == S - 1) {
        acq_fence();
        const int tid = TID, w = tid >> 6, l = tid & 63, h = l >> 4, c = l & 15, wm = w >> 1, wn = w & 1;
        f32x4 acc[4][4];
#pragma unroll
        for (int i = 0; i < 4; ++i)
#pragma unroll
            for (int j = 0; j < 4; ++j) acc[i][j] = f4zero();
        if (wn == 0) { const int idx = wm * 64 + l;
#pragma unroll 1
            for (int s2 = 0; s2 < S; ++s2) { const float* P = Pt + (size_t)s2 * 16 * 256 * 4;
#pragma unroll
                for (int q = 0; q < 16; ++q) { const f32x4 v = *(const f32x4*)(P + ((size_t)q * 256 + idx) * 4);
#pragma unroll
                    for (int r = 0; r < 4; ++r) acc[q >> 2][q & 3][r] += v[r]; } } }
        EpiCmp E2{&a, kv, bg, tm * 256, li};
        E2(acc, wm * 64, wn * 64, h, c);
    }
    SYNC();
}
DEV void moe_gemm_phase8(const Args& a, unsigned char* smem, int l, int mode) {
    unsigned char* ws = wsp(a); const int* cnt = (const int*)(ws + WS_CNT) + l * 32 * 64;
    int* rb = (int*)(smem + 140 * 1024);
    moe_bases(cnt, rb);
    const int mrows = rb[32];
    if (mode == 0) {
        pg8::Gemm g{(const bf16*)(ws + WS_H), (const bf16*)(ws + WS_W13) + (size_t)l * 32 * 2 * FF * DM, mrows, 2 * FF, DM}; pg8::StaticOrder S; S.init(mrows, 2 * FF, NBLK, BID);
        EpiMoe1_8 E{(bf16*)(ws + WS_ACT)}; MoeSel<true> X{rb, cnt, (const int*)(ws + WS_LIST), (size_t)2 * FF * DM * 2};
        SYNC(); pg8::gemm_phase<EpiMoe1_8, pg8::StaticOrder, true, true, MoeSel<true>>(PG8_LDS(smem), g, S, E, X); SYNC();
    } else {
        pg8::Gemm g{(const bf16*)(ws + WS_ACT), (const bf16*)(ws + WS_W2) + (size_t)l * 32 * DM * FF, mrows, DM, FF}; pg8::StaticOrder S; S.init(mrows, DM, NBLK, BID);
        EpiMoe2_8 E{(bf16*)(ws + WS_YK)}; MoeSel<false> X{rb, cnt, (const int*)(ws + WS_LIST), (size_t)DM * FF * 2};
        SYNC(); pg8::gemm_phase<EpiMoe2_8, pg8::StaticOrder, true, true, MoeSel<false>>(PG8_LDS(smem), g, S, E, X); SYNC();
    }
}
#ifndef EMU
constexpr int MOE_TMO_IDX = 128;
struct MoeOrder { int nN, t0, nu, j, nper, nA; bool rev;
    __device__ __forceinline__ void init(int ntile, int nN_, int nblk, int bid, bool rev_) { nN = nN_; nper = nblk / 8; rev = rev_; const int x = bid % 8; j = bid / 8;
        t0 = x * ntile / 8; nu = ((x + 1) * ntile / 8 - t0) * nN; if (bid >= 8 * nper) nu = 0;
        nA = nu - 2 * nper; nA = nA < 0 ? 0 : (nA > nper / 2 ? nper / 2 : nA); }
    __device__ __forceinline__ bool next(int i, pg8::Unit& u) const { int p;
        if (!rev) p = i * nper + j;
        else if (j < nA) { if (i > 0) return false; p = nu - nA + j; }
        else { p = i * (nper - nA) + (j - nA); if (p >= nu - nA) return false; }
        if (p >= nu) return false; u.pm = t0 + p / nN; u.pn = p % nN; return true; }
    __device__ __forceinline__ void a_ready(const pg8::Unit&) const {}
    __device__ __forceinline__ void done(const pg8::Unit&) const {}
};
struct MoeProd : MoeOrder { unsigned* flg;
    __device__ __forceinline__ void done(const pg8::Unit& u) const {
        asm volatile("s_waitcnt vmcnt(0)" ::: "memory"); __builtin_amdgcn_s_barrier(); asm volatile("" ::: "memory");
        if (TID == 0) (void)__hip_atomic_fetch_add((__attribute__((address_space(1))) unsigned*)(flg + u.pm * 16), 1u, __ATOMIC_RELAXED, __HIP_MEMORY_SCOPE_AGENT); } };
struct MoeCons : MoeOrder { unsigned* flg; unsigned* tmo;
    __device__ __forceinline__ void a_ready(const pg8::Unit& u) const {
        if ((TID >> 6) == 0) { unsigned sp = 0u; __attribute__((address_space(1))) unsigned* f = (__attribute__((address_space(1))) unsigned*)(flg + u.pm * 16);
            while ((unsigned)__builtin_amdgcn_readfirstlane((int)__hip_atomic_load(f, __ATOMIC_RELAXED, __HIP_MEMORY_SCOPE_AGENT)) < (unsigned)(2 * FF / 256)) {
                __builtin_amdgcn_s_sleep(1);
                if ((++sp & 255u) == 0u) { if (__hip_atomic_load((__attribute__((address_space(1))) unsigned*)tmo, __ATOMIC_RELAXED, __HIP_MEMORY_SCOPE_AGENT)) break;
                    if (sp > (1u << 22)) { (void)__hip_atomic_fetch_add((__attribute__((address_space(1))) unsigned*)tmo, 1u, __ATOMIC_RELAXED, __HIP_MEMORY_SCOPE_AGENT); break; } } }
            __builtin_amdgcn_fence(__ATOMIC_ACQUIRE, "agent"); }
        asm volatile("" ::: "memory"); __builtin_amdgcn_s_barrier(); asm volatile("" ::: "memory"); } };
DEV void moe_fused_phase(const Args& a, unsigned char* smem, int l) {
    unsigned char* ws = wsp(a); const int* cnt = (const int*)(ws + WS_CNT) + l * 32 * 64;
    int* rb = (int*)(smem + 140 * 1024);
    moe_bases(cnt, rb);
    const int mrows = rb[32]; unsigned* flg = (unsigned*)(ws + WS_FLG) + (size_t)l * 256 * 16;
    { pg8::Gemm g{(const bf16*)(ws + WS_H), (const bf16*)(ws + WS_W13) + (size_t)l * 32 * 2 * FF * DM, mrows, 2 * FF, DM}; MoeProd S; S.init(mrows >> 8, 2 * FF / 256, NBLK, BID, false); S.flg = flg;
      EpiMoe1_8 E{(bf16*)(ws + WS_ACT)}; MoeSel<true> X{rb, cnt, (const int*)(ws + WS_LIST), (size_t)2 * FF * DM * 2};
      SYNC(); pg8::gemm_phase<EpiMoe1_8, MoeProd, true, true, MoeSel<true>>(PG8_LDS(smem), g, S, E, X); }
    { pg8::Gemm g{(const bf16*)(ws + WS_ACT), (const bf16*)(ws + WS_W2) + (size_t)l * 32 * DM * FF, mrows, DM, FF}; MoeCons S; S.init(mrows >> 8, DM / 256, NBLK, BID, true); S.flg = flg; S.tmo = (unsigned*)(ws + WS_BAR) + MOE_TMO_IDX;
      EpiMoe2_8 E{(bf16*)(ws + WS_YK)}; MoeSel<false> X{rb, cnt, (const int*)(ws + WS_LIST), (size_t)DM * FF * 2};
      SYNC(); pg8::gemm_phase<EpiMoe2_8, MoeCons, true, true, MoeSel<false>>(PG8_LDS(smem), g, S, E, X); SYNC(); }
}
#endif
DEV void moe_gemm_phase(const Args& a, unsigned char* smem, int l, int mode) {
    unsigned char* ws = wsp(a); const int* cnt = (const int*)(ws + WS_CNT) + l * 32 * 64;
    int* rb = (int*)(smem + GEMM2_LDS);
    moe_bases(cnt, rb);
    const int ntile = rb[32] >> 8;
    constexpr int TN1 = 2 * FF / 128, TN2 = DM / 128;
    const int TN = mode == 0 ? TN1 : TN2;
    const int* list = (const int*)(ws + WS_LIST);
    for (int it = vbid(); it < ntile * TN; it += NBLK) {
        const int rt = it / TN, tn = it % TN; int e = 0;
#pragma unroll 1
        for (int q = 1; q < 32; ++q) if ((rb[q] >> 8) <= rt) e = q;
        const int rloc = (rt << 8) - rb[e], ce = cnt[e * 64], nvalid = (ce - rloc) < 256 ? (ce - rloc) : 256;
        if (mode == 0) {
            struct AF { const bf16* base; const int* lst; int nv; MDEV unsigned off(int r) const { const int rr = r < nv ? r : nv - 1; return (unsigned)lst[rr] * (unsigned)DM; } }
                af{(const bf16*)(ws + WS_H), list + (size_t)e * T + rloc, nvalid};
            EpiGated<1> E{(bf16*)(ws + WS_ACT), (size_t)FF, rt << 8, tn * 128, nvalid};
            BInter bf{INP(a, I_W1) + (size_t)(l * 32 + e) * DM * FF, INP(a, I_W3) + (size_t)(l * 32 + e) * DM * FF, tn * 128};
            gemm_tile2(smem, af, bf, FF, DM, E);
        } else {
            ARows af{(const bf16*)(ws + WS_ACT) + (size_t)(rt << 8) * FF, (size_t)FF};
            EpiStoreBf E{(bf16*)(ws + WS_YK), (size_t)DM, rt << 8, tn * 128, nvalid};
            BPlain bf{INP(a, I_W2) + (size_t)(l * 32 + e) * FF * DM + tn * 128};
            gemm_tile2(smem, af, bf, DM, FF, E);
        }
    }
}

constexpr int LDV = 80;
constexpr int AT_K = 0, AT_V = 2 * 64 * LDT * 2, AT_IMP = AT_V + 2 * 64 * LDV * 2, AT_SEL = AT_IMP + 8 * 8 * 128 * 4, AT_GSEL = AT_SEL + 8 * 8 * 4 * 4, AT_OUT = AT_GSEL + 8 * 2 * 4 * 4, AT_END = AT_OUT + 8 * 32 * 64 * 4;
#ifdef EMU
DEV float rexp2(float x) { return exp2f(x); }
DEV unsigned uni(unsigned x) { return x; }
#else
DEV float rexp2(float x) { return __builtin_amdgcn_exp2f(x); }
DEV unsigned uni(unsigned x) { return (unsigned)__builtin_amdgcn_readfirstlane((int)x); }
#endif
DEV int krow_lds(int kappa) { return 16 * (2 * (kappa >> 5) + ((kappa >> 2) & 1)) + 4 * ((kappa >> 3) & 3) + (kappa & 3); }
template <int MASK, bool FULL, int GM>
DEV void attn_block(const bf16* Kp, const bf16* Vp, const bf16x8 (&qf)[2][2], int j, const int (&s)[2], const bool (&selbit)[2], float C2, int h, int c,
                    f32x4 (&O)[2][4], f32x4 (&Ol)[2]) {
    f32x4 st[2][2][2];
#pragma unroll
    for (int sp = 0; sp < 2; ++sp)
#pragma unroll
        for (int u = 0; u < 2; ++u) {
#pragma unroll
            for (int G = 0; G < 2; ++G) { st[G][sp][u][0] = -C2; st[G][sp][u][1] = -C2; st[G][sp][u][2] = -C2; st[G][sp][u][3] = -C2; }
#pragma unroll
            for (int ks = 0; ks < 2; ++ks) { const bf16x8 kf = *(const bf16x8*)(Kp + (16 * (2 * sp + u) + c) * LDT + 32 * ks + 8 * h);
#pragma unroll
                for (int G = 0; G < 2; ++G) if (GM & (1 << G)) st[G][sp][u] = mfma16(kf, qf[G][ks], st[G][sp][u]); } }
#pragma unroll
    for (int G = 0; G < 2; ++G) if (GM & (1 << G))
#pragma unroll
        for (int sp = 0; sp < 2; ++sp)
#pragma unroll
            for (int u = 0; u < 2; ++u)
#pragma unroll
                for (int r = 0; r < 4; ++r) { bool ok = selbit[G];
                    if (!FULL) { const int key = 64 * j + 32 * sp + 8 * h + 4 * u + r;
                        if (MASK == 0) ok = 16 * key + 31 <= s[G]; else if (MASK == 1) ok = selbit[G] && key <= s[G]; else ok = key <= s[G] && key > s[G] - 512; }
                    st[G][sp][u][r] = ok ? rexp2(st[G][sp][u][r]) : 0.f; }
    bf16x8 pb[2][2], ones;
#pragma unroll
    for (int q = 0; q < 8; ++q) ones[q] = (short)0x3F80;
#pragma unroll
    for (int G = 0; G < 2; ++G) if (GM & (1 << G))
#pragma unroll
        for (int sp = 0; sp < 2; ++sp) { pb[G][sp] = pack8(st[G][sp][0], st[G][sp][1]); Ol[G] = mfma16(ones, pb[G][sp], Ol[G]); }
    const bf16* Vb = Vp + bperm(8 * h + (c >> 2)) * LDV + 4 * (c & 3);
#pragma unroll
    for (int et = 0; et < 4; ++et)
#pragma unroll
        for (int sp = 0; sp < 2; ++sp) { const bf16x8 vf = tr_read8(Vb + (32 * sp) * LDV + 16 * et, Vb + (32 * sp + 8) * LDV + 16 * et);
#pragma unroll
            for (int G = 0; G < 2; ++G) if (GM & (1 << G)) O[G][et] = mfma16(vf, pb[G][sp], O[G][et]); }
}

struct ImpState { float invq[2][4]; float carry[2]; float* imps; int tl, hd, l, s0, qblk; };
DEV void imp_block(const bf16* Kp, const bf16x8 (&qf)[2][2], int j, int s0, int w, float C2, int h, int c, ImpState& im) {
#pragma unroll
    for (int kt = 0; kt < 4; ++kt) {
        const int row = krow_lds(16 * kt + c);
        const bf16x8 k0 = *(const bf16x8*)(Kp + row * LDT + 8 * h), k1 = *(const bf16x8*)(Kp + row * LDT + 32 + 8 * h);
        const int n = 64 * j + 16 * kt + c;
#pragma unroll
        for (int G = 0; G < 2; ++G) {
            f32x4 acc; acc[0] = -C2; acc[1] = -C2; acc[2] = -C2; acc[3] = -C2;
            acc = mfma16(qf[G][0], k0, acc); acc = mfma16(qf[G][1], k1, acc);
            const bool ok = 16 * n + 31 <= s0 + 8 * w + 4 * G + h;
            float imp = 0.f;
#pragma unroll
            for (int r = 0; r < 4; ++r) imp += ok ? rexp2(acc[r]) * im.invq[G][r] : 0.f;
            const float v = ((c & 3) == 3) ? imp : 2.0f * imp;
            float sq = v + shflx(v, 1); sq += shflx(sq, 2);
            const float rr = dpp_ror1(imp);
            const float prev = (c == 0) ? im.carry[G] : rr;
            im.carry[G] = rr;
            const int m = n >> 2;
            if ((c & 3) == 0 && m < 128) im.imps[(G * 4 + h) * 128 + m] = sq + prev;
        }
    }
}

template <int MODE>
DEV void attn_branch(bf16* Kl, bf16* Vl, const bf16* kbase, const bf16* vbase, int jlo, int jhi,
                     const bf16x8 (&qf)[2][2], const int (&s)[2], const unsigned* selm, const unsigned* gselm, float C2, int w, int h, int c, int srow, int scol,
                     f32x4 (&O)[2][4], f32x4 (&Ol)[2], ImpState& im) {
    constexpr bool PV = MODE != 1; constexpr int MASK = MODE <= 1 ? 0 : MODE - 1;
    const int krow = krow_lds(srow) * LDT + scol, vrow = bperm(srow) * LDV + scol;
    bf16x8 rk[3], rv[3];
    { const bf16x8 k0 = *(const bf16x8*)(kbase + (size_t)jlo * 4096); *(bf16x8*)(Kl + krow) = k0;
      if (PV) { const bf16x8 v0 = *(const bf16x8*)(vbase + (size_t)jlo * 4096); *(bf16x8*)(Vl + vrow) = v0; } }
#pragma unroll
    for (int u = 0; u < 3; ++u) { int jj = jlo + 1 + u; if (jj > jhi) jj = jhi; rk[(1 + u) % 3] = *(const bf16x8*)(kbase + (size_t)jj * 4096); if (PV) rv[(1 + u) % 3] = *(const bf16x8*)(vbase + (size_t)jj * 4096); }
    SYNC();
    for (int jb = jlo; jb <= jhi; jb += 3) {
#pragma unroll
        for (int u = 0; u < 3; ++u) { const int j = jb + u;
            if (j <= jhi) {
                const int cur = (j - jlo) & 1;
                const bf16* Kc = Kl + cur * 64 * LDT; const bf16* Vc = Vl + cur * 64 * LDV;
                if (MODE == 1) imp_block(Kc, qf, j, im.s0, w, C2, h, c, im);
                else {
                    bool sb[2] = {true, true}; unsigned gm = 3u;
                    if (MODE == 2) { gm = 0u;
#pragma unroll
                        for (int G = 0; G < 2; ++G) { const unsigned wq = uni(gselm[G * 4 + (j >> 5)]), mq = selm[(G * 4 + im.tl) * 4 + (j >> 5)];
                            gm |= ((wq >> (j & 31)) & 1u) << G; sb[G] = (mq >> (j & 31)) & 1u; } }
                    bool full;
                    if (MODE == 0) full = 1024 * j + 1039 <= im.s0; else if (MODE == 2) full = j < im.qblk; else full = (j < im.qblk) && (64 * j > im.s0 + 63 - 512);
                    if (MODE == 2) {
                        if (full) { if (gm == 3u) attn_block<MASK, true, 3>(Kc, Vc, qf, j, s, sb, C2, h, c, O, Ol); else if (gm == 1u) attn_block<MASK, true, 1>(Kc, Vc, qf, j, s, sb, C2, h, c, O, Ol); else if (gm == 2u) attn_block<MASK, true, 2>(Kc, Vc, qf, j, s, sb, C2, h, c, O, Ol); }
                        else { if (gm == 3u) attn_block<MASK, false, 3>(Kc, Vc, qf, j, s, sb, C2, h, c, O, Ol); else if (gm == 1u) attn_block<MASK, false, 1>(Kc, Vc, qf, j, s, sb, C2, h, c, O, Ol); else if (gm == 2u) attn_block<MASK, false, 2>(Kc, Vc, qf, j, s, sb, C2, h, c, O, Ol); }
                    } else { if (full) attn_block<MASK, true, 3>(Kc, Vc, qf, j, s, sb, C2, h, c, O, Ol); else attn_block<MASK, false, 3>(Kc, Vc, qf, j, s, sb, C2, h, c, O, Ol); }
                }
                if (j + 1 <= jhi) {
                    *(bf16x8*)(Kl + (cur ^ 1) * 64 * LDT + krow) = rk[(u + 1) % 3]; if (PV) *(bf16x8*)(Vl + (cur ^ 1) * 64 * LDV + vrow) = rv[(u + 1) % 3];
                    int jj = j + 4; if (jj > jhi) jj = jhi;
                    rk[(u + 1) % 3] = *(const bf16x8*)(kbase + (size_t)jj * 4096); if (PV) rv[(u + 1) % 3] = *(const bf16x8*)(vbase + (size_t)jj * 4096);
                }
                SYNC();
            }
        }
    }
}

DEV void attn_task(const Args& a, unsigned char* smem, int li, int item) {
    unsigned char* ws = wsp(a); const int tid = TID, w = tid >> 6, l = tid & 63, h = l >> 4, c = l & 15, tl = c >> 2, hd = c & 3;
    const int bg = item & 3, b = bg >> 1, g = bg & 1, tq = (SEQ / 64 - 1) - (item >> 2), s0 = tq * 64, qblk = tq;
    int s[2], row[2];
#pragma unroll
    for (int G = 0; G < 2; ++G) { s[G] = s0 + 8 * w + 4 * G + tl; row[G] = b * SEQ + s[G]; }
    bf16* Kl = (bf16*)(smem + AT_K); bf16* Vl = (bf16*)(smem + AT_V); float* imps = (float*)(smem + AT_IMP) + w * 1024; unsigned* selm = (unsigned*)(smem + AT_SEL) + w * 32;
    bf16x8 qf[2][2]; float gatec[2], gates[2], gatew[2];
#pragma unroll
    for (int G = 0; G < 2; ++G) { const bf16* qp = (const bf16*)(ws + WS_QN) + (size_t)row[G] * 512 + (g * 4 + hd) * 64 + 8 * h; qf[G][0] = *(const bf16x8*)qp; qf[G][1] = *(const bf16x8*)(qp + 32);
        const float* gp = (const float*)(ws + WS_GATE) + (size_t)row[G] * 24 + (g * 4 + hd) * 3; gatec[G] = gp[0]; gates[G] = gp[1]; gatew[G] = gp[2]; }
    const float* cs = (const float*)(ws + WS_CS) + li * 4;
    const int srow = tid >> 3, scol = (tid & 7) * 8;
    for (int i = l; i < 1024; i += 64) imps[i] = 0.f;
    SYNC();
    unsigned* gselm = (unsigned*)(smem + AT_GSEL) + w * 8; float* outl = (float*)(smem + AT_OUT) + w * 2048 + l;
    ImpState im{{{0.f, 0.f, 0.f, 0.f}, {0.f, 0.f, 0.f, 0.f}}, {0.f, 0.f}, imps, tl, hd, l, s0, qblk};
    {
        const int ncv = s0 / 16 + 3, ncb0 = (ncv + 63) >> 6, ncb = ncb0 > NCP / 64 ? NCP / 64 : ncb0;
        const bf16* kcb = (const bf16*)(ws + WS_KC) + (size_t)bg * NCP * 64 + tid * 8;
        const bf16* vcb = (const bf16*)(ws + WS_VCT) + (size_t)bg * NCP * 64 + tid * 8;
        f32x4 O[2][4], Ol[2] = {f4zero(), f4zero()};
#pragma unroll
        for (int G = 0; G < 2; ++G)
#pragma unroll
            for (int et = 0; et < 4; ++et) O[G][et] = f4zero();
        attn_branch<0>(Kl, Vl, kcb, vcb, 0, ncb - 1, qf, s, selm, gselm, cs[0], w, h, c, srow, scol, O, Ol, im);
#pragma unroll
        for (int G = 0; G < 2; ++G) { const float lsum = Ol[G][0]; const float invl = lsum > 0.f ? 1.0f / lsum : 0.f;
#pragma unroll
            for (int r = 0; r < 4; ++r) im.invq[G][r] = shfl(invl, 4 * h + r);
#pragma unroll
            for (int et = 0; et < 4; ++et)
#pragma unroll
                for (int r = 0; r < 4; ++r) outl[((G * 4 + et) * 4 + r) * 64] = gatec[G] * invl * O[G][et][r]; }
        f32x4 ld[2] = {f4zero(), f4zero()};
        attn_branch<1>(Kl, Vl, kcb, vcb, 0, ncb - 1, qf, s, selm, gselm, cs[0], w, h, c, srow, scol, O, ld, im);
    }
    WSYNC();
#pragma unroll 1
    for (int G = 0; G < 2; ++G) {
        const int tk = l >> 4, i = l & 15; float vals[8];
#pragma unroll
        for (int mm = 0; mm < 8; ++mm) { const int jj = i + 16 * mm; vals[mm] = jj > qblk ? NEGV : ((jj == 0 || jj == qblk || jj == qblk - 1) ? FORCEV : imps[(G * 4 + tk) * 128 + jj]); }
        unsigned mk[4] = {0u, 0u, 0u, 0u};
#pragma unroll 1
        for (int rnd = 0; rnd < 16; ++rnd) {
            float best = vals[0]; int bj = i;
#pragma unroll
            for (int mm = 1; mm < 8; ++mm) if (vals[mm] > best) { best = vals[mm]; bj = i + 16 * mm; }
#pragma unroll
            for (int o = 1; o < 16; o <<= 1) { const float ov = shflx(best, o); const int oj = shflxi(bj, o); if (ov > best || (ov == best && oj < bj)) { best = ov; bj = oj; } }
            if (best > NEGV * 0.5f) {
#pragma unroll
                for (int q = 0; q < 4; ++q) if ((bj >> 5) == q) mk[q] |= 1u << (bj & 31); }
            if ((bj & 15) == i) {
#pragma unroll
                for (int mm = 0; mm < 8; ++mm) if ((bj >> 4) == mm) vals[mm] = -3e38f; }
        }
        if (i == 0) {
#pragma unroll
            for (int q = 0; q < 4; ++q) selm[(G * 4 + tk) * 4 + q] = mk[q]; }
    }
    WSYNC();
    if (l < 8) { const int G = l >> 2, q = l & 3; gselm[l] = selm[(G * 4 + 0) * 4 + q] | selm[(G * 4 + 1) * 4 + q] | selm[(G * 4 + 2) * 4 + q] | selm[(G * 4 + 3) * 4 + q]; }
    WSYNC();
#pragma unroll
    for (int br = 0; br < 2; ++br) {
        const bf16* kb = (const bf16*)(ws + (br == 0 ? WS_KS : WS_KW)) + (size_t)bg * SEQ * 64 + tid * 8; const bf16* vb = (const bf16*)(ws + (br == 0 ? WS_VST : WS_VWT)) + (size_t)bg * SEQ * 64 + tid * 8;
        f32x4 O[2][4], Ol[2] = {f4zero(), f4zero()};
#pragma unroll
        for (int G = 0; G < 2; ++G)
#pragma unroll
            for (int et = 0; et < 4; ++et) O[G][et] = f4zero();
        if (br == 0) attn_branch<2>(Kl, Vl, kb, vb, 0, qblk, qf, s, selm, gselm, cs[1], w, h, c, srow, scol, O, Ol, im);
        else attn_branch<3>(Kl, Vl, kb, vb, s0 >= 511 ? (s0 - 511) >> 6 : 0, qblk, qf, s, selm, gselm, cs[2], w, h, c, srow, scol, O, Ol, im);
#pragma unroll
        for (int G = 0; G < 2; ++G) { const float lsum = Ol[G][0]; const float sc = (br == 0 ? gates[G] : gatew[G]) * (lsum > 0.f ? 1.0f / lsum : 0.f);
#pragma unroll
            for (int et = 0; et < 4; ++et)
#pragma unroll
                for (int r = 0; r < 4; ++r) outl[((G * 4 + et) * 4 + r) * 64] += sc * O[G][et][r]; }
    }
#pragma unroll
    for (int G = 0; G < 2; ++G) { bf16* dst = (bf16*)(ws + WS_CAT) + (size_t)row[G] * 1024 + (g * 4 + hd) * 64 + 4 * h;
#pragma unroll
        for (int et = 0; et < 4; ++et) { f32x4 o;
#pragma unroll
            for (int r = 0; r < 4; ++r) o[r] = outl[((G * 4 + et) * 4 + r) * 64];
            st_bf4(dst + 16 * et, o); } }
}

constexpr int LDH = 136;
DEV void hg_cumsum(const float* fsrc  , float* segs  , int d, int seg, float (&f)[16], float (&bc)[16], float& bend, float& bmid) {
    float run = 0.f;
#pragma unroll
    for (int i = 0; i < 16; ++i) { f[i] = fsrc[(size_t)(16 * seg + i) * 128 + d]; run += log2f(f[i]); bc[i] = run; }
    SYNC();
    segs[seg * 128 + d] = run;
    SYNC();
    const float s0 = segs[d], s1 = segs[128 + d], s2 = segs[256 + d], s3 = segs[384 + d];
    const float off = seg == 0 ? 0.f : (seg == 1 ? s0 : (seg == 2 ? s0 + s1 : s0 + s1 + s2));
#pragma unroll
    for (int i = 0; i < 16; ++i) bc[i] += off;
    bend = s0 + s1 + s2 + s3; bmid = s0 + s1;
}
DEV void hg_write16(bf16* dstrow  , const float (&v)[16]) {
    u32x4 w0, w1;
#pragma unroll
    for (int q = 0; q < 4; ++q) { w0[q] = pk2(v[2 * q], v[2 * q + 1]); w1[q] = pk2(v[8 + 2 * q], v[8 + 2 * q + 1]); }
    *(u32x4*)dstrow = w0; *(u32x4*)(dstrow + 8) = w1;
}
DEV void hg_h1_task(const Args& a, unsigned char* smem, int task) {
    unsigned char* ws = wsp(a); const int tid = TID, w = tid >> 6, l = tid & 63, h = l >> 4, c = l & 15, d = tid & 127, seg = tid >> 7;
    const int bh = task / NCH, ch = task % NCH;
    bf16* kT = (bf16*)smem; bf16* vT = kT + 128 * LDT; float* segs = (float*)(vT + 128 * LDT);
    const size_t tokb = (size_t)bh * SEQ + ch * 64;
    float f[16], bc[16], bend, bmid;
    const bf16* vs = (const bf16*)(ws + WS_HV) + tokb * 128;
    bf16 vraw[16];
#pragma unroll
    for (int i = 0; i < 16; ++i) vraw[i] = vs[(size_t)(16 * seg + i) * 128 + d];
    hg_cumsum((const float*)(ws + WS_HF) + tokb * 128, segs, d, seg, f, bc, bend, bmid);
    float kv[16];
#pragma unroll
    for (int i = 0; i < 16; ++i) kv[i] = (1.0f - f[i]) * fexp2(bend - bc[i]);
    hg_write16(kT + d * LDT + 16 * seg, kv);
#pragma unroll
    for (int i = 0; i < 16; ++i) kv[i] = bf2f(vraw[i]);
    hg_write16(vT + d * LDT + 16 * seg, kv);
    if (seg == 0) ((float*)(ws + WS_GD))[((size_t)bh * NCH + ch) * 128 + d] = fexp2(bend);
    SYNC();
    f32x4 acc[8];
#pragma unroll
    for (int et = 0; et < 8; ++et) acc[et] = f4zero();
#pragma unroll
    for (int ks = 0; ks < 2; ++ks) { const bf16x8 fa = *(const bf16x8*)(kT + (16 * w + c) * LDT + 32 * ks + 8 * h);
#pragma unroll
        for (int et = 0; et < 8; ++et) acc[et] = mfma16(fa, *(const bf16x8*)(vT + (16 * et + c) * LDT + 32 * ks + 8 * h), acc[et]); }
    float* ut = (float*)(ws + WS_UT) + ((size_t)bh * NCH + ch) * 16384;
#pragma unroll
    for (int et = 0; et < 8; ++et) *(f32x4*)(ut + (size_t)(16 * et + c) * 128 + 16 * w + 4 * h) = acc[et];
    SYNC();
}
DEV void hg_scan_task(const Args& a, int sc) {
    unsigned char* ws = wsp(a); const int bh = sc >> 3, q = (sc & 7) * 512 + TID, e = q >> 5, d0 = (q & 31) * 4;
    const float* ut = (const float*)(ws + WS_UT) + (size_t)bh * NCH * 16384 + (size_t)e * 128 + d0;
    const float* gd = (const float*)(ws + WS_GD) + (size_t)bh * NCH * 128 + d0;
    bf16* st = (bf16*)(ws + WS_ST) + (size_t)bh * NCH * 16384 + (size_t)e * 128 + d0;
    f32x4 S = f4zero();
#pragma unroll 4
    for (int ch = 0; ch < NCH; ++ch) { st_bf4(st + (size_t)ch * 16384, S);
        const f32x4 g = *(const f32x4*)(gd + (size_t)ch * 128), u = *(const f32x4*)(ut + (size_t)ch * 16384);
#pragma unroll
        for (int r = 0; r < 4; ++r) S[r] = g[r] * S[r] + u[r]; }
}
DEV void hg_h3_task(const Args& a, unsigned char* smem, int li, int task) {
    unsigned char* ws = wsp(a); const int tid = TID, w = tid >> 6, l = tid & 63, h = l >> 4, c = l & 15, d = tid & 127, seg = tid >> 7;
    const int bh = task / NCH, ch = task % NCH, b = bh >> 2, hh = bh & 3;
    bf16* At = (bf16*)smem; bf16* Bt = At + 64 * LDH; bf16* Qt = Bt + 64 * LDH; bf16* vT = Qt + 64 * LDH; float* segs = (float*)(vT + 128 * LDT); float* part = segs + 512;
    const size_t tokb = (size_t)bh * SEQ + ch * 64;
    float f[16], bc[16], bend, bmid;
    const bf16* qs = (const bf16*)(ws + WS_HQ) + tokb * 128; const bf16* vs = (const bf16*)(ws + WS_HV) + tokb * 128;
    const int tt = w & 3, eh = w >> 2;
    bf16 qraw[16], vraw[16];
#pragma unroll
    for (int i = 0; i < 16; ++i) { const int t = 16 * seg + i; qraw[i] = qs[(size_t)t * 128 + d]; vraw[i] = vs[(size_t)t * 128 + d]; }
    const bf16* stp = (const bf16*)(ws + WS_ST) + ((size_t)bh * NCH + ch) * 16384;
    bf16x8 stf[4][4];
#pragma unroll
    for (int ks = 0; ks < 4; ++ks)
#pragma unroll
        for (int et = 0; et < 4; ++et) stf[ks][et] = *(const bf16x8*)(stp + (size_t)(64 * eh + 16 * et + c) * 128 + 32 * ks + 8 * h);
    const int tok = b * SEQ + ch * 64 + 16 * tt + c;
    const bf16* hg = (const bf16*)(ws + WS_HGS) + (size_t)tok * 512 + hh * 128;
    u32x2 hgv[4];
#pragma unroll
    for (int et = 0; et < 4; ++et) hgv[et] = *(const u32x2*)(hg + 64 * eh + 16 * et + 4 * h);
    hg_cumsum((const float*)(ws + WS_HF) + tokb * 128, segs, d, seg, f, bc, bend, bmid);
    float vv[16];
#pragma unroll
    for (int i = 0; i < 16; ++i) { const int t = 16 * seg + i; const float q = bf2f(qraw[i]);
        At[t * LDH + d] = (bf16)f2bf(q * fexp2(bc[i] - bmid)); Bt[t * LDH + d] = (bf16)f2bf((1.0f - f[i]) * fexp2(bmid - bc[i])); Qt[t * LDH + d] = (bf16)f2bf(q * fexp2(bc[i]));
        vv[i] = bf2f(vraw[i]); }
    hg_write16(vT + d * LDT + 16 * seg, vv);
    SYNC();
    f32x4 O[4];
#pragma unroll
    for (int et = 0; et < 4; ++et) O[et] = f4zero();
#pragma unroll
    for (int sp = 0; sp < 2; ++sp) {
        if (32 * sp > 16 * tt + 15) continue;
        f32x4 st[2];
#pragma unroll
        for (int u = 0; u < 2; ++u) { st[u] = f4zero(); const int krow = 32 * sp + 8 * (c >> 2) + 4 * u + (c & 3);
#pragma unroll
            for (int ks = 0; ks < 4; ++ks) st[u] = mfma16(*(const bf16x8*)(Bt + krow * LDH + 32 * ks + 8 * h), *(const bf16x8*)(At + (16 * tt + c) * LDH + 32 * ks + 8 * h), st[u]);
#pragma unroll
            for (int r = 0; r < 4; ++r) { const int sk = 32 * sp + 8 * h + 4 * u + r; if (sk > 16 * tt + c) st[u][r] = 0.f; } }
        const bf16x8 pb = pack8(st[0], st[1]);
#pragma unroll
        for (int et = 0; et < 4; ++et) O[et] = mfma16(*(const bf16x8*)(vT + (64 * eh + 16 * et + c) * LDT + 32 * sp + 8 * h), pb, O[et]);
    }
#pragma unroll
    for (int ks = 0; ks < 4; ++ks) { const bf16x8 fq = *(const bf16x8*)(Qt + (16 * tt + c) * LDH + 32 * ks + 8 * h);
#pragma unroll
        for (int et = 0; et < 4; ++et) O[et] = mfma16(stf[ks][et], fq, O[et]); }
    float ss = 0.f;
#pragma unroll
    for (int et = 0; et < 4; ++et)
#pragma unroll
        for (int r = 0; r < 4; ++r) ss += O[et][r] * O[et][r];
    ss += shflx(ss, 16); ss += shflx(ss, 32);
    if (h == 0) part[eh * 64 + 16 * tt + c] = ss;
    SYNC();
    const float rs = frsq((part[16 * tt + c] + part[64 + 16 * tt + c]) * (1.0f / 128.0f) + EPS);
    const float* og = INP(a, I_OG) + li * 128;
    bf16* dst = (bf16*)(ws + WS_CAT) + (size_t)tok * 1024 + 512 + hh * 128;
#pragma unroll
    for (int et = 0; et < 4; ++et) { const int e = 64 * eh + 16 * et + 4 * h; f32x4 o; const f32x4 ogv = *(const f32x4*)(og + e);
        o[0] = O[et][0] * rs * ogv[0] * bf2f(hgv[et][0] & 0xffff); o[1] = O[et][1] * rs * ogv[1] * bf2f(hgv[et][0] >> 16);
        o[2] = O[et][2] * rs * ogv[2] * bf2f(hgv[et][1] & 0xffff); o[3] = O[et][3] * rs * ogv[3] * bf2f(hgv[et][1] >> 16);
        st_bf4(dst + e, o); }
    SYNC();
}

constexpr int CTS = 16;
DEV void conv_task(const Args& a, unsigned char* smem, int li, int task) {
    unsigned char* ws = wsp(a); const int tid = TID, w = tid >> 6, lane = tid & 63;
    const bool act = tid < DM / 2; const int c0 = act ? 2 * tid : 0;
    const int tb = task * 64, b = tb / SEQ, sb = tb % SEQ;
    float* red = (float*)smem;
    const float b0 = INP(a, I_DWB)[li * DM + c0], b1 = INP(a, I_DWB)[li * DM + c0 + 1];
    const float g0 = INP(a, I_LNG)[li * DM + c0], g1 = INP(a, I_LNG)[li * DM + c0 + 1], e0 = INP(a, I_LNB)[li * DM + c0], e1 = INP(a, I_LNB)[li * DM + c0 + 1];
    const bf16* glu = (const bf16*)(ws + WS_GLU) + (size_t)b * SEQ * DM + c0;
    float* lw = (float*)(smem + 4096);
    SYNC();
    for (int i = tid * 4; i < 31 * DM; i += NT * 4) *(f32x4*)(lw + i) = *(const f32x4*)(INP(a, I_DW) + (size_t)li * 31 * DM + i);
    SYNC();
    f32x2v uf[30 + CTS]; unsigned nx[CTS];
    { const bf16* gp = glu + (size_t)(sb - 30) * DM;
#pragma unroll
      for (int r = 0; r < 30; ++r) { const int si = sb + r - 30; const unsigned q = si >= 0 ? *(const unsigned*)gp : 0u; gp += DM; OPAQUE(gp); uf[r][0] = bf2f(q & 0xffff); uf[r][1] = bf2f(q >> 16); }
#pragma unroll
      for (int r = 0; r < CTS; ++r) { nx[r] = *(const unsigned*)gp; gp += DM; OPAQUE(gp); } }
#pragma unroll 1
    for (int step = 0; step < 64 / CTS; ++step) {
        const int s0 = sb + CTS * step, t0 = tb + CTS * step;
#pragma unroll
        for (int r = 0; r < CTS; ++r) { uf[30 + r][0] = bf2f(nx[r] & 0xffff); uf[30 + r][1] = bf2f(nx[r] >> 16); }
        float acc[CTS][2];
        { f32x2v ac2[CTS];
#pragma unroll
          for (int t = 0; t < CTS; ++t) { ac2[t][0] = b0; ac2[t][1] = b1; }
#pragma unroll
          for (int j = 0; j < 31; ++j) { const f32x2v w2 = *(const f32x2v*)(lw + j * DM + c0);
#ifndef EMU
              if ((j & 3) == 3) asm volatile("" ::: "memory");
#endif
#pragma unroll
              for (int t = 0; t < CTS; ++t) ac2[t] += w2 * uf[t + j]; }
#pragma unroll
          for (int t = 0; t < CTS; ++t) { acc[t][0] = ac2[t][0]; acc[t][1] = ac2[t][1]; } }
#pragma unroll
        for (int r = 0; r < 30; ++r) uf[r] = uf[r + CTS];
        if (step < 64 / CTS - 1) { const bf16* gp = glu + (size_t)(s0 + CTS) * DM;
#pragma unroll
            for (int r = 0; r < CTS; ++r) { nx[r] = *(const unsigned*)gp; gp += DM; OPAQUE(gp); } }
        { float* rb2 = red + (step & 1) * (8 * CTS * 2);
#pragma unroll
          for (int t = 0; t < CTS; ++t) { float s1 = act ? acc[t][0] + acc[t][1] : 0.f, s2 = act ? acc[t][0] * acc[t][0] + acc[t][1] * acc[t][1] : 0.f;
              s1 = wave_sum63(s1); s2 = wave_sum63(s2);
              if (lane == 63) { rb2[(w * CTS + t) * 2] = s1; rb2[(w * CTS + t) * 2 + 1] = s2; } }
          SYNC();
          if (act) {
              bf16* dst = (bf16*)(ws + WS_CAT) + (size_t)t0 * DM + c0;
#pragma unroll
              for (int t = 0; t < CTS; ++t) { float s1 = 0.f, s2 = 0.f;
#pragma unroll
                  for (int q = 0; q < 8; ++q) { s1 += rb2[(q * CTS + t) * 2]; s2 += rb2[(q * CTS + t) * 2 + 1]; }
                  const float mean = s1 * (1.0f / DM), var = fmaxf(s2 * (1.0f / DM) - mean * mean, 0.f), rstd = frsq(var + EPS);
                  const float y0 = (acc[t][0] - mean) * rstd * g0 + e0, y1 = (acc[t][1] - mean) * rstd * g1 + e1;
                  *(unsigned*)(dst + (size_t)t * DM) = pk2(siluf(y0), siluf(y1)); }
          } }
    }
}

constexpr int N_PHASES = 1 + 16 * (DEPTH / 2) + 1;
DEV void phase_decode(int ph, int& l, int& sub) {
    const int q = ph - 1, pair = q >> 4, r = q & 15;
    if (r < 9) { l = 2 * pair; sub = r; } else { l = 2 * pair + 1; const int rr = r - 9; sub = rr < 3 ? rr : rr + 2; }
}

DEV void run_phase(const Args& a, unsigned char* smem, int ph) {
#ifndef ONLY
#define ONLY -1
#endif
#define EN(k) (ONLY < 0 || ONLY == (k))
    if (ph == 0) { if (EN(100)) p0_phase(a, smem); return; }
    if (ph == N_PHASES - 1) { if (EN(0)) norm_phase(a, smem, DEPTH); return; }
    int l, sub; phase_decode(ph, l, sub); const int li = l >> 1; const bool even = (l & 1) == 0;
    unsigned char* ws = wsp(a);
    switch (sub) {
    case 0: if (EN(0)) norm_phase(a, smem, l); break;
    case 1: if (even) { if (EN(1)) inproj_phase(a, smem, li); } else { if (EN(11)) pw1_phase(a, smem, li); } break;
    case 2:
        if (even) { constexpr int NCI = 8 * ((NCP + 255) / 256); constexpr int NH1 = 8 * NCH;
#ifndef EMU
            if (NBLK > 2 * NCI * CMP_SPLIT) { const int bid = BID, NCS = NCI * CMP_SPLIT;
                if (bid < NCS) cmp_split_item(a, smem, li, bid, (ctr_ptr)((unsigned*)(ws + WS_BAR) + P0_CTR_IDX + 8 + 16 * li));
                else { for (int it = bid - NCS; it < NH1; it += NBLK - NCS) hg_h1_task(a, smem, it);
                    moe_conv_pull(a, smem, MOE_TAIL_Q); } }
#else
            if (NBLK > 2 * NCI) { const int bid = BID;
                if (bid < NCI) { if (EN(2)) cmp_phase_items(a, smem, li, bid); }
                else { for (int it = bid - NCI; it < NH1; it += NBLK - NCI) if (EN(12)) hg_h1_task(a, smem, it); } }
#endif
            else for (int it = BID; it < NCI + NH1; it += NBLK) { if (it < NCI) { if (EN(2)) cmp_phase_items(a, smem, li, it); } else { if (EN(12)) hg_h1_task(a, smem, it - NCI); } } }
        else { for (int it = BID; it < T / 64; it += NBLK) if (EN(13)) conv_task(a, smem, li, it); }
        break;
#ifdef EMU
    case 3:
        if (even) { constexpr int NA = 4 * (SEQ / 64); const int G = NBLK;
            for (int r = 0; r * G < NA; ++r) { const int it = r * G + ((r & 1) ? (G - 1 - BID) : BID); if (it < NA) { if (EN(3)) attn_task(a, smem, li, it); } }
            for (int it = BID; it < 64; it += NBLK) if (EN(14)) hg_scan_task(a, it); }
        break;
    case 4: if (even) { for (int it = BID; it < 8 * NCH; it += NBLK) if (EN(4)) hg_h3_task(a, smem, li, it); } break;
#else
    case 3:
        if (even) { constexpr int NA = 4 * (SEQ / 64); const int G = NBLK;
            typedef __attribute__((address_space(1))) unsigned gu32;
            gu32* cw = (gu32*)((unsigned*)(ws + WS_BAR) + P0_CTR_IDX + 1 + 2 * li);
            int nsc = 0;
            for (int it = BID; it < 64; it += NBLK) { hg_scan_task(a, it); ++nsc; }
            if (nsc > 0) { __builtin_amdgcn_fence(__ATOMIC_RELEASE, "agent"); asm volatile("s_waitcnt vmcnt(0)" ::: "memory"); SYNC(); if (TID == 0) (void)__hip_atomic_fetch_add(cw, (unsigned)nsc, __ATOMIC_RELAXED, __HIP_MEMORY_SCOPE_AGENT); }
            for (int r = 0; r * G < NA; ++r) { const int it = r * G + ((r & 1) ? (G - 1 - BID) : BID); if (it < NA) attn_task(a, smem, li, it); }
            if ((TID >> 6) == 0) { unsigned sp = 0u; gu32* tmo = (gu32*)((unsigned*)(ws + WS_BAR) + MOE_TMO_IDX);
                while ((unsigned)__builtin_amdgcn_readfirstlane((int)__hip_atomic_load(cw, __ATOMIC_RELAXED, __HIP_MEMORY_SCOPE_AGENT)) < 64u) {
                    __builtin_amdgcn_s_sleep(1);
                    if ((++sp & 255u) == 0u) { if (__hip_atomic_load(tmo, __ATOMIC_RELAXED, __HIP_MEMORY_SCOPE_AGENT)) break; if (sp > (1u << 22)) { (void)__hip_atomic_fetch_add(tmo, 1u, __ATOMIC_RELAXED, __HIP_MEMORY_SCOPE_AGENT); break; } } }
                __builtin_amdgcn_fence(__ATOMIC_ACQUIRE, "agent"); }
            int* nxl = (int*)(smem + LDS_BYTES - 64);
            int my_next = 0; if (TID == 0) my_next = (int)__hip_atomic_fetch_add(cw + 1, 1u, __ATOMIC_RELAXED, __HIP_MEMORY_SCOPE_AGENT);
            for (;;) { SYNC(); if (TID == 0) nxl[0] = my_next; SYNC(); const int it = nxl[0]; if (it >= 8 * NCH) break;
                if (TID == 0) my_next = (int)__hip_atomic_fetch_add(cw + 1, 1u, __ATOMIC_RELAXED, __HIP_MEMORY_SCOPE_AGENT);
                hg_h3_task(a, smem, li, it); } }
        break;
    case 4: break;
#endif
    case 5:
        if (!EN(5)) break;
        if (even) resid_gemm_phase(a, smem, (const bf16*)(ws + WS_CAT), 1024, (const bf16*)(ws + WS_WOUT) + (size_t)li * DM * 1024, l);
        else resid_gemm_phase(a, smem, (const bf16*)(ws + WS_CAT), DM, (const bf16*)(ws + WS_PW2) + (size_t)li * DM * DM, l);
        break;
    case 6:
#ifndef EMU
        if (l >= 1) moe_conv_drain(a, smem, (l + 1) * 32 * MOE_SPE);
#endif
        if (EN(6)) route_phase(a, smem, l); break;
#ifdef EMU
    case 7: if (EN(7)) moe_gemm_phase8(a, smem, l, 0); break;
    case 8: if (EN(8)) moe_gemm_phase8(a, smem, l, 1); break;
#else
    case 7: if (EN(7)) moe_fused_phase(a, smem, l); break;
    case 8: break;
#endif
    }
}

#ifndef EMU
#define LAS __attribute__((address_space(3)))
#define XB_TMO      128
static_assert(MOE_N0 >= 2 * 32 * MOE_SPE && XB_TMO == MOE_TMO_IDX && P0_CTR_IDX > XB_TMO && P0_CTR_IDX + 8 + 16 * (DEPTH / 2) <= 256 && 8 * ((NCP + 255) / 256) == 16, "timeout word / free words");
#define XB_XCNT(j)  (256  + 64 * (j))
#define XB_XSUB(j)  (1280 + 64 * (j))
#define XB_XGEN(j)  (2304 + 64 * (j))
#define XB_TOP      3328
#define XB_TOPGEN   3392
#define XCD_BAR_WORDS 3456
#define XB_SPIN_CAP (1u << 22)
__device__ __forceinline__ unsigned xb_ld(unsigned* p)              { return __hip_atomic_load(p, __ATOMIC_RELAXED, __HIP_MEMORY_SCOPE_AGENT); }
__device__ __forceinline__ unsigned xb_add(unsigned* p, unsigned v) { return __hip_atomic_fetch_add(p, v, __ATOMIC_RELAXED, __HIP_MEMORY_SCOPE_AGENT); }
__device__ __forceinline__ unsigned xb_xcc_id() { return (unsigned)__builtin_amdgcn_s_getreg((3 << 11) | 20) & 0xFu; }
#define XB_SPIN(cond, bar) do { unsigned _sp = 0; while (cond) { __builtin_amdgcn_s_sleep(1); \
    if ((++_sp & 255u) == 0u) { if (xb_ld(&(bar)[XB_TMO])) break; if (_sp > XB_SPIN_CAP) { atomicAdd(&(bar)[XB_TMO], 1u); break; } } } } while (0)
struct XcdBarrier { unsigned* bar; unsigned x; volatile LAS unsigned* st; };
__device__ __forceinline__ XcdBarrier xcd_barrier_post(unsigned* bar, volatile LAS unsigned* st) {
    XcdBarrier b; b.bar = bar; b.x = xb_xcc_id(); b.st = st;
    if (threadIdx.x == 0) (void)xb_add(&bar[XB_XCNT(b.x)], 1u);
    return b;
}
__device__ __forceinline__ void xcd_barrier_complete(unsigned* bar, unsigned x, unsigned& nloc, unsigned& nx) {
    const unsigned G = gridDim.x * gridDim.y * gridDim.z;
    unsigned sum, cnt, mine, sp = 0u;
    for (;;) {
        sum = 0u; cnt = 0u; mine = 0u;
#pragma unroll
        for (unsigned j = 0; j < 16; ++j) { const unsigned c = xb_ld(&bar[XB_XCNT(j)]); sum += c; cnt += (c > 0u) ? 1u : 0u; mine = (j == x) ? c : mine; }
        if (sum == G) break;
        __builtin_amdgcn_s_sleep(1);
        if ((++sp & 255u) == 0u) { if (xb_ld(&bar[XB_TMO])) break; if (sp > XB_SPIN_CAP) { atomicAdd(&bar[XB_TMO], 1u); break; } }
    }
    nloc = mine > 0u ? mine : 1u; nx = cnt > 0u ? cnt : 1u;
}
__device__ __forceinline__ void xcd_barrier(const XcdBarrier& b) {
    asm volatile("s_waitcnt vmcnt(0)" ::: "memory");
    __syncthreads();
    if (threadIdx.x == 0) {
        unsigned* bar = b.bar;
        __builtin_amdgcn_s_waitcnt(0);
        unsigned nloc = b.st[0], nx = b.st[1];
        if (nloc == 0u) { xcd_barrier_complete(bar, b.x, nloc, nx); b.st[0] = nloc; b.st[1] = nx; }
        const unsigned old = xb_add(&bar[XB_XSUB(b.x)], 1u);
        const unsigned gen = old / nloc;
        if (old + 1u == (gen + 1u) * nloc) {
            __builtin_amdgcn_fence(__ATOMIC_RELEASE, "agent");
            asm volatile("s_waitcnt vmcnt(0)" ::: "memory");
            const unsigned og = xb_add(&bar[XB_TOP], 1u);
            const unsigned tg = og / nx;
            if (og + 1u == (tg + 1u) * nx) xb_add(&bar[XB_TOPGEN], 1u);
            else XB_SPIN(xb_ld(&bar[XB_TOPGEN]) == tg, bar);
            __builtin_amdgcn_fence(__ATOMIC_ACQUIRE, "agent");
            xb_add(&bar[XB_XGEN(b.x)], 1u);
            asm volatile("s_waitcnt vmcnt(0)" ::: "memory");
        } else {
            XB_SPIN(xb_ld(&bar[XB_XGEN(b.x)]) == gen, bar);
            __builtin_amdgcn_fence(__ATOMIC_ACQUIRE, "agent");
            asm volatile("s_waitcnt vmcnt(0)" ::: "memory");
        }
    }
    __syncthreads();
}

__global__ void __launch_bounds__(NT, 2) mega(Args a) {
    extern __shared__ __attribute__((aligned(16))) unsigned char lds[];
    volatile LAS unsigned* st = (volatile LAS unsigned*)(LAS unsigned char*)(lds + LDS_BYTES - 16);
    if (threadIdx.x < 4) st[threadIdx.x] = 0u;
    __syncthreads();
    unsigned* barw = (unsigned*)(a.ws + WS_BAR);
    XcdBarrier bar = xcd_barrier_post(barw, st);
#pragma unroll 1
    for (int ph = 0; ph < N_PHASES; ++ph) {
        if (ph > 0 && ph < N_PHASES - 1) { int l_, s_; phase_decode(ph, l_, s_); if (s_ == 8 || (s_ == 4 && (l_ & 1) == 0)) continue; }
        run_phase(a, lds, ph);
#ifdef DUP
        { int lyr = 0, sub = 100; if (ph > 0 && ph < N_PHASES - 1) phase_decode(ph, lyr, sub);
          if (sub == (DUP % 1000) && (ph == 0 || lyr == DUP / 1000) && ph < N_PHASES - 1) { xcd_barrier(bar); run_phase(a, lds, ph); } }
#endif
        if (ph + 1 < N_PHASES) xcd_barrier(bar);
    }
    if (xb_ld(&barw[XB_TMO]) != 0u) {
        const size_t gt = (size_t)blockIdx.x * NT + threadIdx.x, gs = (size_t)gridDim.x * NT;
        for (size_t i = gt; i < (size_t)T * DM; i += gs) a.out[i] = __builtin_nanf("");
    }
}

extern "C" void kernel_launch(void* const* d_in, const int* in_sizes, int n_in, void* d_out, int out_size,
                              void* d_ws, size_t ws_size, hipStream_t stream) {
    static int grid = 0;
    if (grid == 0) {
        int dev = 0, cus = 0;
        if (hipGetDevice(&dev) != hipSuccess || hipDeviceGetAttribute(&cus, hipDeviceAttributeMultiprocessorCount, dev) != hipSuccess) { grid = -1; return; }
        if (hipFuncSetAttribute((const void*)mega, hipFuncAttributeMaxDynamicSharedMemorySize, LDS_BYTES) != hipSuccess) { grid = -1; return; }
        (void)hipGetLastError();
        grid = cus;
        if (n_in != 26 || out_size != T * DM || ws_size < WS_END) { fprintf(stderr, "kernel_launch: unexpected sizes n_in %d out %d ws %zu (need %zu)\n", n_in, out_size, ws_size, (size_t)WS_END); grid = -1; return; }
    }
    if (grid < 0) return;
    (void)hipMemsetAsync((unsigned char*)d_ws + WS_BAR, 0, XCD_BAR_WORDS * 4, stream);
    Args a{};
    for (int i = 0; i < 26; ++i) a.in[i] = (const float*)d_in[i];
    a.out = (float*)d_out; a.ws = (unsigned char*)d_ws;
    hipLaunchKernelGGL(mega, dim3(grid), dim3(NT), LDS_BYTES, stream, a);
}
#endif
```

```cpp
#ifdef EMU
#include "emu.h"
#define DEV static inline
#define MDEV inline
#define OPAQUE(p)
#define OPAQUE2(a, b)
#define TID emu_tid()
#define BID (EB->bid)
#define NBLK (EB->nblk)
#define SYNC() emu_sync_block()
#define WSYNC() emu_sync_wave()
#define mfma16(a, b, c) emu_mfma16(a, b, c)
DEV float shflx(float v, int m) { return emu_shfl_f(v, (emu_tid() & 63) ^ m); }
DEV int shflxi(int v, int m) { return (int)emu_shfl_u((unsigned)v, (emu_tid() & 63) ^ m); }
DEV float shfl(float v, int s) { return emu_shfl_f(v, s); }
DEV float dpp_ror1(float v) { const int l = emu_tid() & 63; return emu_shfl_f(v, (l & 48) | ((l - 1) & 15)); }
DEV float wave_sum63(float v) { for (int o = 1; o < 64; o <<= 1) v += shflx(v, o); return v; }
DEV int atomic_add_i(int* p, int v) { return __atomic_fetch_add(p, v, __ATOMIC_RELAXED); }
typedef float f32x2v __attribute__((vector_size(8)));
DEV float fexp2(float x) { return exp2f(x); }
DEV float frcp(float x) { return 1.0f / x; }
DEV float frsq(float x) { return 1.0f / sqrtf(x); }
typedef short s16x4 __attribute__((vector_size(8)));
static inline s16x4 emu_tr4(const unsigned short* p) {
    EmuWave& w = EB->wave[emu_tid() >> 6]; int l = emu_tid() & 63;
    const unsigned short** tab = (const unsigned short**)w.a;
    tab[l] = p; emu_sync_wave();
    s16x4 r; int g = l & 48, i = l & 15;
    for (int q = 0; q < 4; ++q) r[q] = (short)tab[g + 4 * q + (i >> 2)][i & 3];
    emu_sync_wave(); return r;
}
#define tr4(p) emu_tr4(p)
#else
#include <hip/hip_runtime.h>
#include <cstdio>
#include <cstdint>
typedef short bf16x8 __attribute__((ext_vector_type(8)));
typedef float f32x4 __attribute__((ext_vector_type(4)));
typedef unsigned u32x4 __attribute__((ext_vector_type(4)));
typedef unsigned u32x2 __attribute__((ext_vector_type(2)));
#define DEV __device__ __forceinline__
#define MDEV __device__ __forceinline__
#define OPAQUE(p) asm volatile("" : "+v"(p))
#define OPAQUE2(a, b) asm volatile("" : "+v"(a), "+v"(b))
DEV int tid_opaque() { int t = (int)threadIdx.x; asm volatile("" : "+v"(t)); return t; }
#define TID tid_opaque()
DEV int bid_opaque() { int b = (int)blockIdx.x; asm volatile("" : "+s"(b)); return b; }
#define BID bid_opaque()
#define NBLK ((int)gridDim.x)
#define SYNC() __syncthreads()
#define WSYNC() __builtin_amdgcn_wave_barrier()
#define mfma16(a, b, c) __builtin_amdgcn_mfma_f32_16x16x32_bf16(a, b, c, 0, 0, 0)
DEV int shflxi(int x, int m) {
    if (m == 1) return __builtin_amdgcn_update_dpp(x, x, 0xB1, 0xf, 0xf, true);
    if (m == 2) return __builtin_amdgcn_update_dpp(x, x, 0x4E, 0xf, 0xf, true);
    if (m == 4) return __builtin_amdgcn_ds_swizzle(x, (4 << 10) | 0x1F);
    if (m == 8) return __builtin_amdgcn_ds_swizzle(x, (8 << 10) | 0x1F);
    if (m == 16) return __builtin_amdgcn_ds_swizzle(x, (16 << 10) | 0x1F);
    if (m == 32) { const auto r = __builtin_amdgcn_permlane32_swap((unsigned)x, (unsigned)x, false, false); return (int)((threadIdx.x & 32) ? r[0] : r[1]); }
    return __shfl_xor(x, m);
}
DEV float shflx(float v, int m) { return __builtin_bit_cast(float, shflxi(__builtin_bit_cast(int, v), m)); }
DEV float dpp_ror1(float v) { return __builtin_bit_cast(float, __builtin_amdgcn_update_dpp(0, __builtin_bit_cast(int, v), 0x121, 0xf, 0xf, false)); }
DEV float wave_sum63(float v) {
#define WS_DPP(ctrl, rm) __builtin_bit_cast(float, __builtin_amdgcn_update_dpp(0, __builtin_bit_cast(int, v), ctrl, rm, 0xf, false))
    v += WS_DPP(0xB1, 0xf); v += WS_DPP(0x4E, 0xf); v += WS_DPP(0x141, 0xf); v += WS_DPP(0x140, 0xf); v += WS_DPP(0x142, 0xa); v += WS_DPP(0x143, 0xc);
#undef WS_DPP
    return v;
}
DEV float shfl(float v, int s) { return __shfl(v, s); }
DEV int atomic_add_i(int* p, int v) { return atomicAdd(p, v); }
DEV float fexp2(float x) { return __builtin_amdgcn_exp2f(x); }
DEV float frcp(float x) { return __builtin_amdgcn_rcpf(x); }
DEV float frsq(float x) { return __builtin_amdgcn_rsqf(x); }
typedef short s16x4 __attribute__((ext_vector_type(4)));
#define tr4(p) __builtin_amdgcn_ds_read_tr16_b64_v4i16((__attribute__((address_space(3))) s16x4*)(p))
#endif

typedef unsigned short bf16;

#ifndef DM
#define DM 1024
#endif
#ifndef SEQ
#define SEQ 8192
#endif
#ifndef FF
#define FF 512
#endif
constexpr int NBATCH = 2, T = NBATCH * SEQ, DEPTH = 4;
constexpr int NIN = 3352, NINP = 3456, NIN8 = 3584;
constexpr int NT = 512;
constexpr int NCH = SEQ / 64;
constexpr int NCP = SEQ / 16;
constexpr int NCMP = NCP - 1;
constexpr int MOE_ROWS = 2 * T + 32 * 256;
constexpr float EPS = 1e-6f, NEGV = -1e30f, FORCEV = 1e4f, LOG2E = 1.4426950408889634f;

constexpr size_t al(size_t x) { return (x + 255) & ~(size_t)255; }
constexpr int P0_CTR_IDX = 192;
constexpr size_t WS_BAR = 0;
constexpr size_t WS_CNT = 16384;
constexpr size_t WS_MOD = WS_CNT + (size_t)DEPTH * 32 * 256;
constexpr size_t WS_LB = al(WS_MOD + (size_t)DEPTH * 2 * 6 * DM * 4);
constexpr size_t WS_CB = al(WS_LB + 2 * 512 * 4);
constexpr size_t WS_CS = al(WS_CB + 2 * 2 * 8 * 64 * 4);
constexpr size_t WS_WIN = al(WS_CS + 64);
constexpr size_t WS_WOUT = al(WS_WIN + (size_t)2 * NIN8 * DM * 2);
constexpr size_t WS_PW1 = al(WS_WOUT + (size_t)2 * DM * 1024 * 2);
constexpr size_t WS_PW2 = al(WS_PW1 + (size_t)2 * 2 * DM * DM * 2);
constexpr size_t WS_WC = al(WS_PW2 + (size_t)2 * DM * DM * 2);
constexpr size_t WS_W13 = al(WS_WC + (size_t)2 * 2 * 64 * 2048 * 2);
constexpr size_t WS_W2 = al(WS_W13 + (size_t)DEPTH * 32 * 2 * FF * DM * 2);
constexpr size_t WS_H = al(WS_W2 + (size_t)DEPTH * 32 * DM * FF * 2);
constexpr size_t WS_QN = al(WS_H + (size_t)T * DM * 2);
constexpr size_t WS_KCG = al(WS_QN + (size_t)T * 512 * 2);
constexpr size_t WS_VCG = al(WS_KCG + (size_t)T * 128 * 2);
constexpr size_t WS_KS = al(WS_VCG + (size_t)T * 128 * 2);
constexpr size_t WS_KW = al(WS_KS + (size_t)T * 128 * 2);
constexpr size_t WS_VST = al(WS_KW + (size_t)T * 128 * 2);
constexpr size_t WS_VWT = al(WS_VST + (size_t)T * 128 * 2);
constexpr size_t WS_KC = al(WS_VWT + (size_t)T * 128 * 2);
constexpr size_t WS_VCT = al(WS_KC + (size_t)4 * NCP * 64 * 2);
constexpr size_t WS_GATE = al(WS_VCT + (size_t)4 * NCP * 64 * 2);
constexpr size_t WS_HQ = al(WS_GATE + (size_t)T * 24 * 4);
constexpr size_t WS_HF = al(WS_HQ + (size_t)T * 512 * 2);
constexpr size_t WS_HV = al(WS_HF + (size_t)T * 512 * 4);
constexpr size_t WS_HGS = al(WS_HV + (size_t)T * 512 * 2);
constexpr size_t WS_UT = al(WS_HGS + (size_t)T * 512 * 2);
constexpr size_t WS_ST = al(WS_UT + (size_t)8 * NCH * 128 * 128 * 4);
constexpr size_t WS_GD = al(WS_ST + (size_t)8 * NCH * 128 * 128 * 2);
constexpr size_t WS_CAT = al(WS_GD + (size_t)8 * NCH * 128 * 4);
constexpr size_t WS_GLU = al(WS_CAT + (size_t)T * 1024 * 2);
constexpr size_t WS_TIE = al(WS_GLU + (size_t)T * DM * 2);
constexpr size_t WS_TIW = al(WS_TIE + (size_t)T * 2 * 4);
constexpr size_t WS_LIST = al(WS_TIW + (size_t)T * 2 * 4);
constexpr size_t WS_ACT = al(WS_LIST + (size_t)32 * T * 4);
constexpr size_t WS_YK = al(WS_ACT + (size_t)MOE_ROWS * FF * 2);
constexpr size_t WS_WTH = al(WS_YK + (size_t)MOE_ROWS * DM * 2);
constexpr size_t WS_WTL = al(WS_WTH + (size_t)DEPTH * 48 * DM * 2);
constexpr size_t WS_AVEC = al(WS_WTL + (size_t)DEPTH * 48 * DM * 2);
constexpr size_t WS_RBIAS = al(WS_AVEC + (size_t)DEPTH * 2 * DM * 4);
constexpr size_t WS_FLG = al(WS_RBIAS + (size_t)DEPTH * 2 * 48 * 4);
constexpr int LDS_BYTES = 150 * 1024;
constexpr int CMP_SPLIT = 2;
constexpr size_t WS_CMPP = al(WS_FLG + (size_t)DEPTH * 256 * 64);
constexpr size_t WS_END = al(WS_CMPP + (size_t)8 * ((NCP + 255) / 256) * CMP_SPLIT * 16 * 256 * 16);

struct Args { const float* in[26]; float* out; unsigned char* ws; };
enum { I_X = 0, I_C, I_ADAW, I_ADAB, I_NMIX, I_NFFN, I_WIN, I_WOUT, I_CWK, I_CWV, I_CPE, I_QG, I_KG, I_LBL, I_OG,
       I_PW1, I_DW, I_DWB, I_LNG, I_LNB, I_PW2, I_WG, I_WE, I_W1, I_W3, I_W2 };

#ifdef EMU
DEV unsigned char* wsp(const Args& a) { return a.ws; }
DEV float* outp(const Args& a) { return a.out; }
#else
DEV unsigned char* launder_ptr(const void* p) { unsigned long long v = (unsigned long long)p; unsigned lo = (unsigned)v, hi = (unsigned)(v >> 32);
    lo = (unsigned)__builtin_amdgcn_readfirstlane((int)lo); hi = (unsigned)__builtin_amdgcn_readfirstlane((int)hi); asm volatile("" : "+s"(lo), "+s"(hi)); typedef __attribute__((address_space(1))) unsigned char* gptr_t; return (unsigned char*)(gptr_t)(((unsigned long long)hi << 32) | lo); }
DEV unsigned char* wsp(const Args& a) { return launder_ptr(a.ws); }
DEV float* outp(const Args& a) { return (float*)launder_ptr(a.out); }
#endif

#ifdef EMU
#define INP(a, X) ((a).in[X])
#else
DEV int zero_opaque() { int z = 0; asm volatile("" : "+s"(z)); return z; }
#define INP(a, X) ((a).in[(X) + zero_opaque()])
#endif

DEV unsigned f2bf(float f) { unsigned u = __builtin_bit_cast(unsigned, f); return (u + 0x7fffu + ((u >> 16) & 1u)) >> 16; }
DEV float bf2f(unsigned h) { return __builtin_bit_cast(float, h << 16); }
#ifdef EMU
DEV unsigned pk2(float lo, float hi) { return f2bf(lo) | (f2bf(hi) << 16); }
#else
typedef float f32x2_t __attribute__((ext_vector_type(2)));
typedef float f32x2v __attribute__((ext_vector_type(2)));
typedef __bf16 bf16x2_t __attribute__((ext_vector_type(2)));
DEV unsigned pk2(float lo, float hi) { f32x2_t v = {lo, hi}; bf16x2_t b = __builtin_convertvector(v, bf16x2_t); return __builtin_bit_cast(unsigned, b); }
#endif
DEV float sigm(float x) { return frcp(1.0f + fexp2(-x * LOG2E)); }
DEV float siluf(float x) { return x * sigm(x); }
DEV f32x4 f4zero() { f32x4 z = {0.f, 0.f, 0.f, 0.f}; return z; }
DEV bf16x8 pack8(f32x4 a, f32x4 b) {
    u32x4 w; w[0] = pk2(a[0], a[1]); w[1] = pk2(a[2], a[3]); w[2] = pk2(b[0], b[1]); w[3] = pk2(b[2], b[3]);
    return __builtin_bit_cast(bf16x8, w);
}
DEV void st_bf8(bf16* p, f32x4 a, f32x4 b) { u32x4 w; w[0] = pk2(a[0], a[1]); w[1] = pk2(a[2], a[3]); w[2] = pk2(b[0], b[1]); w[3] = pk2(b[2], b[3]); *(u32x4*)p = w; }
DEV void st_bf4(bf16* p, f32x4 v) { u32x2 w; w[0] = pk2(v[0], v[1]); w[1] = pk2(v[2], v[3]); *(u32x2*)p = w; }


#ifdef EMU
namespace pg8 {
constexpr int BM = 256, BK = 64, HALF = 128, NXCD = 8, WGM = 8;
typedef unsigned short bf16_t;
struct Unit { int pm, pn; };
struct Gemm { const bf16_t* A; const bf16_t* Bt; int M, N, K; };
struct StaticOrder {
    int nM, nN, nwg, G, c;
    void init(int M, int N, int G_, int c_) { nM = M / BM; nN = N / BM; nwg = nM * nN; G = G_; c = c_; }
    bool next(int i, Unit& u) const {
        const long L = (long)i * G + c; if (L >= nwg) return false;
        int wgid = (int)L; { const int q = nwg / NXCD, r = nwg % NXCD, xcd = wgid % NXCD, off = wgid / NXCD; wgid = (xcd < r ? xcd * (q + 1) : r * (q + 1) + (xcd - r) * q) + off; }
        const int nig = WGM * nN, gid = wgid / nig, fm = gid * WGM, gsz = (nM - fm) < WGM ? (nM - fm) : WGM;
        u.pm = fm + ((wgid % nig) % gsz); u.pn = (wgid % nig) / gsz; return true;
    }
};
template <int NM, int NN> struct StaticOrderT : StaticOrder { void init(int G_, int c_) { StaticOrder::init(NM * BM, NN * BM, G_, c_); } };
struct SelNone { static constexpr bool GATHER = false; struct Ctx {}; Ctx ctx(const Unit&) const { return Ctx(); } size_t boff(const Ctx&) const { return 0; } unsigned aoff(const Ctx&, int) const { return 0u; } };
template <class Epi, class Sched, bool ALIGN_EPI = false, bool SP2 = false, class Sel = SelNone>
static inline void gemm_phase(unsigned char*, const Gemm g, const Sched& S, const Epi& E, const Sel& X = Sel()) {
    const int tid = emu_tid(), wid = tid >> 6, lane = tid & 63, wr = wid >> 2, wc = wid & 3, fr = lane & 15, fq = lane >> 4;
    Unit u;
    for (int ui = 0; S.next(ui, u); ++ui) {
        f32x4 acc[2][2][4][2]; const auto cx = X.ctx(u);
        for (int ai = 0; ai < 2; ++ai) for (int bj = 0; bj < 2; ++bj) for (int m = 0; m < 4; ++m) for (int n = 0; n < 2; ++n) for (int r = 0; r < 4; ++r) {
            const int row = 256 * u.pm + 128 * ai + 64 * wr + 16 * m + fr, col = 256 * u.pn + 128 * bj + 32 * wc + (Epi::PERM ? 8 * fq + 4 * n + r : 16 * n + 4 * fq + r); float sum = 0.f;
            const bf16_t* ap = Sel::GATHER ? (const bf16_t*)((const char*)g.A + X.aoff(cx, row - 256 * u.pm)) : g.A + (size_t)row * g.K; const bf16_t* bp = (const bf16_t*)((const char*)g.Bt + X.boff(cx)) + (size_t)col * g.K;
            for (int k = 0; k < g.K; ++k) sum += bf2f(ap[k]) * bf2f(bp[k]);
            acc[ai][bj][m][n][r] = sum; }
        E(acc, u, wr, wc, fr, fq);
    }
    emu_sync_block();
}
}
#else
namespace pg8 {
#define PG8_LAS __attribute__((address_space(3)))
typedef unsigned short bf16_t;
typedef short bf16x8 __attribute__((ext_vector_type(8)));
typedef float f32x4 __attribute__((ext_vector_type(4)));
typedef unsigned u32x4 __attribute__((ext_vector_type(4)));
constexpr int BM = 256, BK = 64, HALF = 128, HTB = HALF * BK * 2  , STAGE_BYTES = 8 * HTB, NXCD = 8, WGM = 8;

__host__ __device__ __forceinline__ int lds_byte(int r, int c) { const int st = (r >> 4) * 2 + (c >> 5), rr = r & 15, cc = c & 31, ob = rr * 64 + cc * 2; return st * 1024 + (ob ^ (((ob >> 9) & 1) << 5)); }
__host__ __device__ __forceinline__ void stage_rc(int b, int& R, int& C) { const int st = b / 1024, sb = b % 1024, swz = sb ^ (((sb >> 9) & 1) << 5); R = (st >> 1) * 16 + swz / 64; C = (st & 1) * 32 + (swz % 64) / 2; }
__host__ __device__ __forceinline__ int perm32(int rho) { const int n = rho >> 4, i = rho & 15; return 8 * (i >> 2) + 4 * n + (i & 3); }

struct Unit { int pm, pn; };
struct Gemm { const bf16_t* A; const bf16_t* Bt; int M, N, K; };

struct StaticOrder {
    int nM, nN, nwg, G, c;
    __host__ __device__ void init(int M, int N, int G_, int c_) { nM = M / BM; nN = N / BM; nwg = nM * nN; G = G_; c = c_; }
    __host__ __device__ bool next(int i, Unit& u) const {
        const long L = (long)i * G + c; if (L >= nwg) return false;
        int wgid = (int)L; { const int q = nwg / NXCD, r = nwg % NXCD, xcd = wgid % NXCD, off = wgid / NXCD; wgid = (xcd < r ? xcd * (q + 1) : r * (q + 1) + (xcd - r) * q) + off; }
        const int nig = WGM * nN, gid = wgid / nig, fm = gid * WGM, gsz = (nM - fm) < WGM ? (nM - fm) : WGM;
        u.pm = fm + ((wgid % nig) % gsz); u.pn = (wgid % nig) / gsz; return true;
    }
    __device__ __forceinline__ void a_ready(const Unit&) const {}
    __device__ __forceinline__ void done(const Unit&) const {}
};

template <int NM, int NN> struct StaticOrderT {
    int G, c;
    __host__ __device__ void init(int G_, int c_) { G = G_; c = c_; }
    __host__ __device__ bool next(int i, Unit& u) const {
        constexpr int nM = NM, nN = NN, nwg = nM * nN;
        const long L = (long)i * G + c; if (L >= nwg) return false;
        int wgid = (int)L; { constexpr int q = nwg / NXCD, r = nwg % NXCD; const int xcd = wgid % NXCD, off = wgid / NXCD; wgid = (xcd < r ? xcd * (q + 1) : r * (q + 1) + (xcd - r) * q) + off; }
        constexpr int nig = WGM * nN; const int gid = wgid / nig, fm = gid * WGM, gsz = (nM - fm) < WGM ? (nM - fm) : WGM;
        if (nM % WGM == 0) { u.pm = fm + ((wgid % nig) % WGM); u.pn = (wgid % nig) / WGM; } else { u.pm = fm + ((wgid % nig) % gsz); u.pn = (wgid % nig) / gsz; }
        return true;
    }
    __device__ __forceinline__ void a_ready(const Unit&) const {}
    __device__ __forceinline__ void done(const Unit&) const {}
};
__device__ __forceinline__ unsigned cvt_pk_bf16(float lo, float hi) { unsigned r; asm volatile("v_cvt_pk_bf16_f32 %0, %1, %2" : "=v"(r) : "v"(lo), "v"(hi)); return r; }
struct SelNone { static constexpr bool GATHER = false; struct Ctx {}; __device__ __forceinline__ Ctx ctx(const Unit&) const { return Ctx(); } __device__ __forceinline__ size_t boff(const Ctx&) const { return 0; } __device__ __forceinline__ unsigned aoff(const Ctx&, int) const { return 0u; } };
template <class Epi, class Sched, bool ALIGN_EPI = false, bool SP2 = false, class Sel = SelNone>
__device__ __forceinline__ void gemm_phase(PG8_LAS unsigned char* lds, const Gemm g, const Sched& S, const Epi& E, const Sel& X = Sel()) {
    constexpr bool GA = Sel::GATHER;
    const int tid = TID, wid = __builtin_amdgcn_readfirstlane(tid >> 6), lane = tid & 63, wr = wid >> 2, wc = wid & 3, fr = lane & 15, fq = lane >> 4;
    const int K = g.K, nt = K / BK;
    unsigned voffA[2], voffB[2]; int Rl[2]; unsigned Cl2[2];
#pragma unroll
    for (int i = 0; i < 2; ++i) { int R, C; stage_rc(tid * 16 + i * 8192, R, C); const int Rb = Epi::PERM ? ((R & ~31) + perm32(R & 31)) : R;
        voffA[i] = (unsigned)(R * K + C) * 2u; voffB[i] = (unsigned)(Rb * K + C) * 2u; Rl[i] = R; Cl2[i] = (unsigned)C * 2u; }
    unsigned vA[2][2], vAn[2][2];
    const size_t kstep = (size_t)(BK * 2);
    const size_t hstep = (size_t)HALF * K * 2;
    const size_t tstep = 2 * hstep;
    const unsigned ldsw = (unsigned)wid * 1024u;
    const int aoff = lds_byte(wr * 64 + fr, fq * 8), boff = lds_byte(wc * 32 + fr, fq * 8);
#define PG8_SA(b, h) (((b) * 2 + (h)) * HTB)
#define PG8_SB(b, h) ((4 + (b) * 2 + (h)) * HTB)
#define PG8_STAGE(bufoff, gbase, voff) do { _Pragma("unroll") for (int _i = 0; _i < 2; ++_i) \
        __builtin_amdgcn_global_load_lds((const unsigned*)((const char*)(gbase) + (voff)[_i]), (PG8_LAS unsigned*)(lds + (bufoff) + ldsw + _i * 8192), 16, 0, 0); } while (0)
#define PG8_STAGE_A(bufoff, p, h, nx) do { if constexpr (GA) { unsigned _vo[2] = {(nx) ? vAn[h][0] : vA[h][0], (nx) ? vAn[h][1] : vA[h][1]}; PG8_STAGE(bufoff, p, _vo); } else { PG8_STAGE(bufoff, (p) + (h) * hstep, voffA); } } while (0)
#define PG8_GATH(cx, dst) do { _Pragma("unroll") for (int _h = 0; _h < 2; ++_h) _Pragma("unroll") for (int _i = 0; _i < 2; ++_i) dst[_h][_i] = X.aoff(cx, 128 * _h + Rl[_i]) + Cl2[_i]; } while (0)
#define PG8_LDA(dst, b, h) do { _Pragma("unroll") for (int m = 0; m < 4; ++m) _Pragma("unroll") for (int k = 0; k < 2; ++k) dst[m][k] = *(const PG8_LAS bf16x8*)(lds + PG8_SA(b, h) + aoff + m * 2048 + k * 1024); } while (0)
#define PG8_LDB(dst, b, h) do { _Pragma("unroll") for (int n = 0; n < 2; ++n) _Pragma("unroll") for (int k = 0; k < 2; ++k) dst[n][k] = *(const PG8_LAS bf16x8*)(lds + PG8_SB(b, h) + boff + n * 2048 + k * 1024); } while (0)
#define PG8_MMA(ai, bj, At, Bt) do { __builtin_amdgcn_s_setprio(1); _Pragma("unroll") for (int m = 0; m < 4; ++m) _Pragma("unroll") for (int n = 0; n < 2; ++n) _Pragma("unroll") for (int k = 0; k < 2; ++k) \
        acc[ai][bj][m][n] = __builtin_amdgcn_mfma_f32_16x16x32_bf16(Bt[n][k], At[m][k], acc[ai][bj][m][n], 0, 0, 0); __builtin_amdgcn_s_setprio(0); } while (0)
#define PG8_WAIT_V(n) asm volatile("s_waitcnt vmcnt(" #n ")" ::: "memory")
#define PG8_WAIT_L(n) asm volatile("s_waitcnt lgkmcnt(" #n ")" ::: "memory")
#define PG8_BAR __builtin_amdgcn_s_barrier()
#define PG8_SCHED __builtin_amdgcn_sched_barrier(0)
    Unit cur, nxt; int ui = 0;
    if (!S.next(0, cur)) return;
    f32x4 acc[2][2][4][2];
#pragma unroll
    for (int a = 0; a < 2; ++a)
#pragma unroll
        for (int b = 0; b < 2; ++b)
#pragma unroll
            for (int m = 0; m < 4; ++m)
#pragma unroll
                for (int n = 0; n < 2; ++n) acc[a][b][m][n] = (f32x4){0.f, 0.f, 0.f, 0.f};
    bf16x8 At[4][2], B0[2][2], B1[2][2];
    auto ccx = X.ctx(cur);
    const char* cA = GA ? (const char*)g.A : (const char*)g.A + (size_t)cur.pm * tstep; const char* cB = (const char*)g.Bt + X.boff(ccx) + (size_t)cur.pn * tstep;
    if constexpr (GA) { PG8_GATH(ccx, vA); }
    S.a_ready(cur);
    if constexpr (SP2) {
        PG8_STAGE(PG8_SB(0, 0), cB, voffB); PG8_STAGE(PG8_SB(0, 1), cB + hstep, voffB); PG8_STAGE_A(PG8_SA(0, 0), cA, 0, false); PG8_STAGE_A(PG8_SA(0, 1), cA, 1, false);
        if (wr == 1) PG8_BAR;
        PG8_WAIT_V(2); PG8_BAR;
        PG8_STAGE(PG8_SB(1, 0), cB + kstep, voffB); PG8_STAGE_A(PG8_SA(1, 0), cA + kstep, 0, false); PG8_STAGE(PG8_SB(1, 1), cB + hstep + kstep, voffB);
        PG8_WAIT_V(6); PG8_BAR;
    } else {
        PG8_STAGE(PG8_SB(0, 0), cB, voffB); PG8_STAGE_A(PG8_SA(0, 0), cA, 0, false); PG8_STAGE(PG8_SB(0, 1), cB + hstep, voffB); PG8_STAGE_A(PG8_SA(0, 1), cA, 1, false);
        if (wr == 1) PG8_BAR;
        PG8_WAIT_V(4); PG8_BAR;
        PG8_STAGE(PG8_SB(1, 0), cB + kstep, voffB); PG8_STAGE_A(PG8_SA(1, 0), cA + kstep, 0, false); PG8_STAGE(PG8_SB(1, 1), cB + hstep + kstep, voffB);
        PG8_WAIT_V(6); PG8_BAR;
    }
    for (;;) {
        const bool has_next = S.next(ui + 1, nxt);
        const char* nA = cA; const char* nB = cB;
        if (has_next) { const auto ncx = X.ctx(nxt); nA = GA ? (const char*)g.A : (const char*)g.A + (size_t)nxt.pm * tstep; nB = (const char*)g.Bt + X.boff(ncx) + (size_t)nxt.pn * tstep; if constexpr (GA) { PG8_GATH(ncx, vAn); } }
        else if constexpr (GA) {
#pragma unroll
            for (int _h = 0; _h < 2; ++_h) { vAn[_h][0] = vA[_h][0]; vAn[_h][1] = vA[_h][1]; } }
        for (int t = 0; t < nt; t += 2) {
            const bool last = (t == nt - 2);
            const char* a1 = cA + (size_t)(t + 1) * kstep;
            const char* a2 = last ? nA : cA + (size_t)(t + 2) * kstep; const char* b2 = last ? nB : cB + (size_t)(t + 2) * kstep;
            const char* a3 = a2 + kstep; const char* b3 = b2 + kstep;
            if (last && has_next) S.a_ready(nxt);
            if constexpr (SP2) {
            PG8_LDB(B0, 0, 0); PG8_LDB(B1, 0, 1); PG8_SCHED; PG8_LDA(At, 0, 0); PG8_STAGE_A(PG8_SA(1, 1), a1, 1, false);
            PG8_WAIT_V(8); PG8_WAIT_L(0); PG8_BAR; PG8_MMA(0, 0, At, B0); PG8_MMA(0, 1, At, B1); PG8_BAR; PG8_SCHED;
            PG8_LDA(At, 0, 1); PG8_STAGE(PG8_SB(0, 0), b2, voffB); PG8_STAGE(PG8_SB(0, 1), b2 + hstep, voffB); PG8_STAGE_A(PG8_SA(0, 0), a2, 0, last);
            PG8_WAIT_V(8); PG8_WAIT_L(0); PG8_BAR; PG8_MMA(1, 0, At, B0); PG8_MMA(1, 1, At, B1); PG8_BAR; PG8_SCHED;
            PG8_LDB(B0, 1, 0); PG8_LDB(B1, 1, 1); PG8_SCHED; PG8_LDA(At, 1, 0); PG8_STAGE_A(PG8_SA(0, 1), a2, 1, last);
            PG8_WAIT_V(8); PG8_WAIT_L(0); PG8_BAR; PG8_MMA(0, 0, At, B0); PG8_MMA(0, 1, At, B1); PG8_BAR; PG8_SCHED;
            PG8_LDA(At, 1, 1); PG8_STAGE(PG8_SB(1, 0), b3, voffB); PG8_STAGE(PG8_SB(1, 1), b3 + hstep, voffB); PG8_STAGE_A(PG8_SA(1, 0), a3, 0, last);
            PG8_WAIT_V(8); PG8_WAIT_L(0); PG8_BAR; PG8_MMA(1, 0, At, B0); PG8_MMA(1, 1, At, B1); PG8_BAR; PG8_SCHED;
            } else {
            PG8_LDB(B0, 0, 0); PG8_SCHED; PG8_LDA(At, 0, 0); PG8_STAGE_A(PG8_SA(1, 1), a1, 1, false);
            PG8_WAIT_L(8); PG8_BAR; PG8_WAIT_L(0); PG8_MMA(0, 0, At, B0); PG8_BAR; PG8_SCHED;
            PG8_LDB(B1, 0, 1); PG8_STAGE(PG8_SB(0, 0), b2, voffB);
            PG8_BAR; PG8_WAIT_L(0); PG8_MMA(0, 1, At, B1); PG8_BAR;
            PG8_LDA(At, 0, 1); PG8_STAGE_A(PG8_SA(0, 0), a2, 0, last);
            PG8_BAR; PG8_WAIT_L(0); PG8_MMA(1, 0, At, B0); PG8_BAR; PG8_SCHED;
            PG8_STAGE(PG8_SB(0, 1), b2 + hstep, voffB);
            PG8_WAIT_V(6); PG8_BAR; PG8_MMA(1, 1, At, B1); PG8_BAR;
            PG8_LDB(B0, 1, 0); PG8_SCHED; PG8_LDA(At, 1, 0); PG8_STAGE_A(PG8_SA(0, 1), a2, 1, last);
            PG8_WAIT_L(8); PG8_BAR; PG8_WAIT_L(0); PG8_MMA(0, 0, At, B0); PG8_BAR; PG8_SCHED;
            PG8_LDB(B1, 1, 1); PG8_STAGE(PG8_SB(1, 0), b3, voffB);
            PG8_BAR; PG8_WAIT_L(0); PG8_MMA(0, 1, At, B1); PG8_BAR;
            PG8_LDA(At, 1, 1); PG8_STAGE_A(PG8_SA(1, 0), a3, 0, last);
            PG8_BAR; PG8_WAIT_L(0); PG8_MMA(1, 0, At, B0); PG8_BAR; PG8_SCHED;
            PG8_STAGE(PG8_SB(1, 1), b3 + hstep, voffB);
            PG8_WAIT_V(6); PG8_BAR; PG8_MMA(1, 1, At, B1); PG8_BAR;
            }
        }
        if constexpr (ALIGN_EPI) { if (wr == 0) PG8_BAR; }
        if constexpr (!Epi::AFTER_DRAIN) { E(acc, cur, wr, wc, fr, fq); S.done(cur); }
        if (!has_next) break;
#pragma unroll
        for (int a = 0; a < 2; ++a)
#pragma unroll
            for (int b = 0; b < 2; ++b)
#pragma unroll
                for (int m = 0; m < 4; ++m)
#pragma unroll
                    for (int n = 0; n < 2; ++n) acc[a][b][m][n] = (f32x4){0.f, 0.f, 0.f, 0.f};
        cur = nxt; cA = nA; cB = nB; ++ui;
        if constexpr (GA) {
#pragma unroll
            for (int _h = 0; _h < 2; ++_h) { vA[_h][0] = vAn[_h][0]; vA[_h][1] = vAn[_h][1]; } }
        if constexpr (ALIGN_EPI) { if (wr == 1) PG8_BAR; }
    }
    PG8_WAIT_V(0);
    if constexpr (!ALIGN_EPI) { if (wr == 0) PG8_BAR; }
    PG8_BAR;
    if constexpr (Epi::AFTER_DRAIN) { E.fused(acc, cur, wr, wc, fr, fq, lds, wid, lane); S.done(cur); }
#undef PG8_SA
#undef PG8_SB
#undef PG8_STAGE
#undef PG8_STAGE_A
#undef PG8_GATH
#undef PG8_LDA
#undef PG8_LDB
#undef PG8_MMA
#undef PG8_WAIT_V
#undef PG8_WAIT_L
#undef PG8_BAR
#undef PG8_SCHED
}
}
#endif

constexpr int LDT = 72;
constexpr int GEMM_AS = 256 * LDT, GEMM_BS = 128 * LDT;
constexpr int GEMM_LDS = 2 * (GEMM_AS + GEMM_BS) * 2;

template <class AF, class EPI>
DEV void gemm_tile(unsigned char* smem, AF af, const bf16* Bt, int ldb, int nvalid, int K, EPI& epi) {
    const int tid = TID, w = tid >> 6, l = tid & 63, h = l >> 4, c = l & 15, wm = w >> 1, wn = w & 1;
    bf16* As = (bf16*)smem; bf16* Bs = As + 2 * GEMM_AS;
    const bf16* ap[4]; const bf16* bp[2];
    const int col8 = (tid & 7) * 8, r0 = tid >> 3;
#pragma unroll
    for (int i = 0; i < 4; ++i) ap[i] = af(r0 + 64 * i) + col8;
#pragma unroll
    for (int i = 0; i < 2; ++i) { int rn = r0 + 64 * i; if (rn >= nvalid) rn = nvalid - 1; bp[i] = Bt + (size_t)rn * ldb + col8; }
    f32x4 acc[4][4];
#pragma unroll
    for (int i = 0; i < 4; ++i)
#pragma unroll
        for (int j = 0; j < 4; ++j) acc[i][j] = f4zero();
    bf16x8 ra[4], rb[2];
#pragma unroll
    for (int i = 0; i < 4; ++i) ra[i] = *(const bf16x8*)(ap[i]);
#pragma unroll
    for (int i = 0; i < 2; ++i) rb[i] = *(const bf16x8*)(bp[i]);
    SYNC();
#pragma unroll
    for (int i = 0; i < 4; ++i) *(bf16x8*)(As + (r0 + 64 * i) * LDT + col8) = ra[i];
#pragma unroll
    for (int i = 0; i < 2; ++i) *(bf16x8*)(Bs + (r0 + 64 * i) * LDT + col8) = rb[i];
    SYNC();
    const int nk = K / 64;
    for (int kt = 0; kt < nk; ++kt) {
        const int cur = kt & 1;
        if (kt + 1 < nk) {
#pragma unroll
            for (int i = 0; i < 4; ++i) ra[i] = *(const bf16x8*)(ap[i] + (kt + 1) * 64);
#pragma unroll
            for (int i = 0; i < 2; ++i) rb[i] = *(const bf16x8*)(bp[i] + (kt + 1) * 64);
        }
        const bf16* Ac = As + cur * GEMM_AS + (wm * 64 + c) * LDT + 8 * h;
        const bf16* Bc = Bs + cur * GEMM_BS + (wn * 64 + c) * LDT + 8 * h;
#pragma unroll
        for (int kk = 0; kk < 2; ++kk) {
            bf16x8 fa[4], fb[4];
#pragma unroll
            for (int i = 0; i < 4; ++i) { fa[i] = *(const bf16x8*)(Ac + i * 16 * LDT + kk * 32); fb[i] = *(const bf16x8*)(Bc + i * 16 * LDT + kk * 32); }
#pragma unroll
            for (int ni = 0; ni < 4; ++ni)
#pragma unroll
                for (int mi = 0; mi < 4; ++mi) acc[ni][mi] = mfma16(fb[ni], fa[mi], acc[ni][mi]);
        }
        if (kt + 1 < nk) {
            const int nx = cur ^ 1;
#pragma unroll
            for (int i = 0; i < 4; ++i) *(bf16x8*)(As + nx * GEMM_AS + (r0 + 64 * i) * LDT + col8) = ra[i];
#pragma unroll
            for (int i = 0; i < 2; ++i) *(bf16x8*)(Bs + nx * GEMM_BS + (r0 + 64 * i) * LDT + col8) = rb[i];
        }
        SYNC();
    }
    epi(acc, wm * 64, wn * 64, h, c);
}

struct ARows { const bf16* base; size_t ld; MDEV const bf16* operator()(int r) const { return base + (size_t)r * ld; } MDEV unsigned off(int r) const { return (unsigned)r * (unsigned)ld; } };

constexpr int LDB = 144;
constexpr int GEMM_BS2 = 64 * LDB;
constexpr int GEMM2_LDS = (2 * GEMM_AS + 2 * GEMM_BS2) * 2;
DEV bf16x8 tr_read8(const bf16* p0, const bf16* p1) {
    const s16x4 x = tr4(p0), y = tr4(p1); bf16x8 r;
    r[0] = x[0]; r[1] = x[1]; r[2] = x[2]; r[3] = x[3]; r[4] = y[0]; r[5] = y[1]; r[6] = y[2]; r[7] = y[3]; return r;
}
DEV int bperm(int r) { return (r & ~12) | ((r & 4) << 1) | ((r & 8) >> 1); }
template <class AF, class BF, class EPI>
DEV void gemm_tile2(unsigned char* smem, AF af, BF bf, int ldb, int K, EPI& epi) {
    const int tid = TID, w = tid >> 6, l = tid & 63, h = l >> 4, c = l & 15, wm = w >> 1, wn = w & 1, grp = w >> 2;
    bf16* As = (bf16*)smem; bf16* Bs = As + 2 * GEMM_AS;
    const bf16* abase = af.base; unsigned ao[4];
    const int col8 = (tid & 7) * 8, r0 = tid >> 3;
#pragma unroll
    for (int i = 0; i < 4; ++i) ao[i] = af.off(r0 + 64 * i) + col8;
    const int bn4 = (tid & 31) * 4, bk = tid >> 5, bkp = bperm(bk);
    const float* bp = bf(bn4); const bool bok = bp != nullptr;
    if (bok) bp += (size_t)bk * ldb;
    const size_t bstep = (size_t)16 * ldb;
    f32x4 acc[4][4];
#pragma unroll
    for (int i = 0; i < 4; ++i)
#pragma unroll
        for (int j = 0; j < 4; ++j) acc[i][j] = f4zero();
    bf16x8 ra[2][4]; f32x4 rb[2][4];
    const int nk = K / 64;
#pragma unroll
    for (int i = 0; i < 4; ++i) { ra[0][i] = *(const bf16x8*)(abase + ao[i]); rb[0][i] = bok ? *(const f32x4*)(bp + i * bstep) : f4zero(); }
    if (nk > 1) {
#pragma unroll
        for (int i = 0; i < 4; ++i) { ra[1][i] = *(const bf16x8*)(abase + (ao[i] + 64)); rb[1][i] = bok ? *(const f32x4*)(bp + (size_t)64 * ldb + i * bstep) : f4zero(); } }
    SYNC();
#pragma unroll
    for (int i = 0; i < 4; ++i) { *(bf16x8*)(As + (r0 + 64 * i) * LDT + col8) = ra[0][i]; st_bf4(Bs + (bkp + 16 * i) * LDB + bn4, rb[0][i]); }
    if (nk > 2) {
#pragma unroll
        for (int i = 0; i < 4; ++i) { ra[0][i] = *(const bf16x8*)(abase + (ao[i] + 128)); rb[0][i] = bok ? *(const f32x4*)(bp + (size_t)128 * ldb + i * bstep) : f4zero(); } }
    SYNC();
    for (int kt0 = 0; kt0 < nk; kt0 += 2) {
#pragma unroll
      for (int kq = 0; kq < 2; ++kq) { const int kt = kt0 + kq;
        if (kt < nk) {
        const int cur = kq;
#pragma unroll
        for (int p = 0; p < 2; ++p) {
            if (grp == p) {
                const bf16* Ac = As + cur * GEMM_AS + (wm * 64 + c) * LDT + 8 * h;
                const bf16* Bc = Bs + cur * GEMM_BS2 + bperm(8 * h + (c >> 2)) * LDB + wn * 64 + 4 * (c & 3);
#pragma unroll
                for (int kk = 0; kk < 2; ++kk) {
                    bf16x8 fa[4], fb[4];
#pragma unroll
                    for (int i = 0; i < 4; ++i) { fa[i] = *(const bf16x8*)(Ac + i * 16 * LDT + kk * 32); fb[i] = tr_read8(Bc + (32 * kk) * LDB + 16 * i, Bc + (32 * kk + 8) * LDB + 16 * i); }
#pragma unroll
                    for (int ni = 0; ni < 4; ++ni)
#pragma unroll
                        for (int mi = 0; mi < 4; ++mi) acc[ni][mi] = mfma16(fb[ni], fa[mi], acc[ni][mi]);
                }
            } else if (kt + 1 < nk) {
                const int nx = cur ^ 1; constexpr int dummy = 0; (void)dummy;
#pragma unroll
                for (int i = 0; i < 4; ++i) { *(bf16x8*)(As + nx * GEMM_AS + (r0 + 64 * i) * LDT + col8) = ra[kq ^ 1][i]; st_bf4(Bs + nx * GEMM_BS2 + (bkp + 16 * i) * LDB + bn4, rb[kq ^ 1][i]); }
                if (kt + 3 < nk) {
#pragma unroll
                    for (int i = 0; i < 4; ++i) { ra[kq ^ 1][i] = *(const bf16x8*)(abase + (ao[i] + (kt + 3) * 64)); rb[kq ^ 1][i] = bok ? *(const f32x4*)(bp + (size_t)(kt + 3) * 64 * ldb + i * bstep) : f4zero(); } }
            }
            SYNC();
        }
        } }
    }
    epi(acc, wm * 64, wn * 64, h, c);
}
struct BPlain { const float* base; MDEV const float* operator()(int nt) const { return base + nt; } };
struct BInProjMap { const float* base; int n0; MDEV const float* operator()(int nt) const { const int n = n0 + nt; const int sc = n < 1280 ? n : (n < 3328 ? n + 24 : (n < 3352 ? 1280 + (n - 3328) : -1)); return sc < 0 ? nullptr : base + sc; } };
struct BInter { const float* s0; const float* s1; int n0; MDEV const float* operator()(int nt) const { const int n = n0 + nt, g = n >> 6, w = n & 63; return w < 32 ? s0 + g * 32 + w : s1 + g * 32 + w - 32; } };
struct BClamp64 { const float* base; MDEV const float* operator()(int nt) const { return base + (nt & 63); } };

struct EpiInProj {
    const Args* a; int m0, n0, li;
    MDEV void operator()(f32x4 (&acc)[4][4], int mw, int nw, int h, int c) const {
        unsigned char* ws = wsp(*a);
        const int nb = n0 + nw;
        const int tokb = m0 + mw + c;
        if (nb < 512 || (nb >= 768 && nb < 896) || (nb >= 1024 && nb < 1152)) {
            const float* gain; float mul = 1.f; bf16* dst; int kind;
            if (nb < 512) { gain = INP(*a, I_QG) + li * 64; mul = 0.125f * LOG2E; kind = 0; dst = (bf16*)(ws + WS_QN); }
            else if (nb < 896) { gain = INP(*a, I_KG) + (li * 3 + 1) * 64; kind = 1; dst = (bf16*)(ws + WS_KS); }
            else { gain = INP(*a, I_KG) + (li * 3 + 2) * 64; kind = 1; dst = (bf16*)(ws + WS_KW); }
            const int g = (nb >> 6) & 1;
#pragma unroll
            for (int mi = 0; mi < 4; ++mi) {
                float ss = 0.f;
#pragma unroll
                for (int ni = 0; ni < 4; ++ni) { f32x4 v = acc[ni][mi]; ss += v[0] * v[0] + v[1] * v[1] + v[2] * v[2] + v[3] * v[3]; }
                ss += shflx(ss, 16); ss += shflx(ss, 32);
                const float rs = frsq(ss * (1.0f / 64.0f) + EPS) * mul;
                const int tok = tokb + 16 * mi;
#pragma unroll
                for (int ni = 0; ni < 4; ++ni) {
                    const int d = 16 * ni + 4 * h; f32x4 v = acc[ni][mi], o;
#pragma unroll
                    for (int r = 0; r < 4; ++r) o[r] = v[r] * rs * gain[d + r];
                    if (kind == 0) st_bf4(dst + (size_t)tok * 512 + nb + d, o);
                    else { const int b = tok / SEQ, s = tok % SEQ; st_bf4(dst + ((size_t)(b * 2 + g) * SEQ + s) * 64 + d, o); }
                }
            }
        } else if (nb < 768) {
            bf16* dst = (bf16*)(ws + (nb < 640 ? WS_KCG : WS_VCG)); const int g = (nb >> 6) & 1;
#pragma unroll
            for (int mi = 0; mi < 4; ++mi) { const int tok = tokb + 16 * mi, b = tok / SEQ, s = tok % SEQ;
#pragma unroll
                for (int ni = 0; ni < 4; ++ni) st_bf4(dst + ((size_t)(b * 2 + g) * SEQ + s) * 64 + 16 * ni + 4 * h, acc[ni][mi]); }
        } else if (nb < 1280) {
            bf16* dst = (bf16*)(ws + (nb < 1024 ? WS_VST : WS_VWT)); const int g = (nb >> 6) & 1;
#pragma unroll
            for (int mi = 0; mi < 4; ++mi) { const int tok = tokb + 16 * mi, b = tok / SEQ, s = tok % SEQ;
                bf16* p = dst + ((size_t)(b * 2 + g) * NCH + (s >> 6)) * 4096 + (s & 63);
#pragma unroll
                for (int ni = 0; ni < 4; ++ni)
#pragma unroll
                    for (int r = 0; r < 4; ++r) p[(16 * ni + 4 * h + r) * 64] = (bf16)f2bf(acc[ni][mi][r]); }
        } else if (nb < 3328) {
            const int sec = (nb - 1280) >> 9, cc = (nb - 1280) & 511, hh = cc >> 7, d0 = cc & 127;
#pragma unroll
            for (int mi = 0; mi < 4; ++mi) { const int tok = tokb + 16 * mi, b = tok / SEQ, s = tok % SEQ;
                const size_t hrow = ((size_t)(b * 4 + hh) * SEQ + s) * 128 + d0;
#pragma unroll
                for (int ni = 0; ni < 4; ++ni) { const int d = 16 * ni + 4 * h; f32x4 v = acc[ni][mi], o;
                    if (sec == 0) { for (int r = 0; r < 4; ++r) o[r] = siluf(v[r]); st_bf4((bf16*)(ws + WS_HQ) + hrow + d, o); }
                    else if (sec == 1) { const float* lb = (const float*)(ws + WS_LB) + li * 512 + cc + d;
                        for (int r = 0; r < 4; ++r) o[r] = lb[r] + (1.0f - lb[r]) * sigm(v[r]);
                        *(f32x4*)((float*)(ws + WS_HF) + hrow + d) = o; }
                    else if (sec == 2) st_bf4((bf16*)(ws + WS_HV) + hrow + d, v);
                    else { for (int r = 0; r < 4; ++r) o[r] = siluf(v[r]); st_bf4((bf16*)(ws + WS_HGS) + (size_t)tok * 512 + cc + d, o); }
                } }
        } else if (nb == 3328) {
            float* dst = (float*)(ws + WS_GATE);
#pragma unroll
            for (int mi = 0; mi < 4; ++mi) { const int tok = tokb + 16 * mi;
#pragma unroll
                for (int ni = 0; ni < 2; ++ni)
#pragma unroll
                    for (int r = 0; r < 4; ++r) { const int n = 16 * ni + 4 * h + r; if (n < 24) dst[(size_t)tok * 24 + n] = sigm(acc[ni][mi][r]); } }
        }
    }
};

struct EpiResid {
    float* x; const float* gate; int m0, n0;
    MDEV void operator()(f32x4 (&acc)[4][4], int mw, int nw, int h, int c) const {
#pragma unroll
        for (int mi = 0; mi < 4; ++mi) { const int tok = m0 + mw + 16 * mi + c, b = tok / SEQ;
#pragma unroll
            for (int ni = 0; ni < 4; ++ni) { const int n = n0 + nw + 16 * ni + 4 * h;
                f32x4 g = *(const f32x4*)(gate + (size_t)b * 6 * DM + n); f32x4* p = (f32x4*)(x + (size_t)tok * DM + n); f32x4 v = *p;
#pragma unroll
                for (int r = 0; r < 4; ++r) v[r] += g[r] * acc[ni][mi][r];
                *p = v; } }
    }
};
template <int MODE> struct EpiGated {
    bf16* dst; size_t ld; int m0, n0, mvalid;
    MDEV void operator()(f32x4 (&acc)[4][4], int mw, int nw, int h, int c) const {
        const int cb = (n0 + nw) / 2;
#pragma unroll
        for (int mi = 0; mi < 4; ++mi) { const int m = mw + 16 * mi + c; if (m >= mvalid) continue;
#pragma unroll
            for (int ni = 0; ni < 2; ++ni) { f32x4 o;
#pragma unroll
                for (int r = 0; r < 4; ++r) { const float av = acc[ni][mi][r], bv = acc[ni + 2][mi][r]; o[r] = MODE == 0 ? av * sigm(bv) : siluf(av) * bv; }
                st_bf4(dst + (size_t)(m0 + m) * ld + cb + 16 * ni + 4 * h, o); } }
    }
};
struct EpiStoreBf {
    bf16* dst; size_t ld; int m0, n0, mvalid;
    MDEV void operator()(f32x4 (&acc)[4][4], int mw, int nw, int h, int c) const {
#pragma unroll
        for (int mi = 0; mi < 4; ++mi) { const int m = mw + 16 * mi + c; if (m >= mvalid) continue;
#pragma unroll
            for (int ni = 0; ni < 4; ++ni) st_bf4(dst + (size_t)(m0 + m) * ld + n0 + nw + 16 * ni + 4 * h, acc[ni][mi]); }
    }
};
struct EpiCmp {
    const Args* a; int kv, bg, m0, li;
    MDEV void operator()(f32x4 (&acc)[4][4], int mw, int nw, int h, int c) const {
        if (nw != 0) return;
        unsigned char* ws = wsp(*a);
        const float* bp8 = (const float*)(ws + WS_CB) + (li * 2 + kv) * 8 * 64;
        float bias[16];
#pragma unroll
        for (int q = 0; q < 16; ++q) { const int e = 16 * (q >> 2) + 4 * h + (q & 3); float v = 0.f;
#pragma unroll
            for (int kp = 0; kp < 8; ++kp) v += bp8[kp * 64 + e];
            bias[q] = v; }
        const float* gain = INP(*a, I_KG) + (li * 3 + 0) * 64;
#pragma unroll
        for (int mi = 0; mi < 4; ++mi) { const int n = m0 + mw + 16 * mi + c; const bool ok = n < NCMP;
            f32x4 v[4]; float ss = 0.f;
#pragma unroll
            for (int ni = 0; ni < 4; ++ni) { v[ni] = acc[ni][mi];
#pragma unroll
                for (int r = 0; r < 4; ++r) { v[ni][r] += bias[4 * ni + r]; ss += v[ni][r] * v[ni][r]; } }
            ss += shflx(ss, 16); ss += shflx(ss, 32);
            if (n >= NCP) continue;
            if (kv == 0) { const float rs = frsq(ss * (1.0f / 64.0f) + EPS); bf16* p = (bf16*)(ws + WS_KC) + ((size_t)bg * NCP + n) * 64;
#pragma unroll
                for (int ni = 0; ni < 4; ++ni) { f32x4 o;
#pragma unroll
                    for (int r = 0; r < 4; ++r) o[r] = ok ? v[ni][r] * rs * gain[16 * ni + 4 * h + r] : 0.f;
                    st_bf4(p + 16 * ni + 4 * h, o); }
            } else { bf16* p = (bf16*)(ws + WS_VCT) + ((size_t)bg * NCP + n) * 64;
#pragma unroll
                for (int ni = 0; ni < 4; ++ni) { f32x4 o;
#pragma unroll
                    for (int r = 0; r < 4; ++r) o[r] = ok ? v[ni][r] : 0.f;
                    st_bf4(p + 16 * ni + 4 * h, o); } }
        }
    }
};


struct EpiResid8 {
    static constexpr bool PERM = true, AFTER_DRAIN = false;
    float* x; const float* gate; const float* xin;
    MDEV void operator()(const f32x4 (&acc)[2][2][4][2], const pg8::Unit& u, int wr, int wc, int fr, int fq) const {
        OPAQUE2(fr, fq);
        const int b = (256 * u.pm) / SEQ;
        f32x4 gv[2][2];
#pragma unroll
        for (int bj = 0; bj < 2; ++bj)
#pragma unroll
            for (int n = 0; n < 2; ++n) gv[bj][n] = *(const f32x4*)(gate + (size_t)b * 6 * DM + 256 * u.pn + 128 * bj + 32 * wc + 8 * fq + 4 * n);
#pragma unroll
        for (int ai = 0; ai < 2; ++ai)
#pragma unroll
            for (int m = 0; m < 4; ++m) { const int row = 256 * u.pm + 128 * ai + 64 * wr + 16 * m + fr;
#pragma unroll
                for (int bj = 0; bj < 2; ++bj)
#pragma unroll
                    for (int n = 0; n < 2; ++n) { const int col = 256 * u.pn + 128 * bj + 32 * wc + 8 * fq + 4 * n;
                        f32x4* p = (f32x4*)(x + (size_t)row * DM + col); f32x4 v = *(const f32x4*)(xin + (size_t)row * DM + col);
#pragma unroll
                        for (int r = 0; r < 4; ++r) v[r] += gv[bj][n][r] * acc[ai][bj][m][n][r];
                        *p = v; } }
    }
};
struct EpiGlu8 {
    static constexpr bool PERM = true, AFTER_DRAIN = false;
    bf16* dst;
    MDEV void operator()(const f32x4 (&acc)[2][2][4][2], const pg8::Unit& u, int wr, int wc, int fr, int fq) const {
        OPAQUE2(fr, fq);
#pragma unroll
        for (int ai = 0; ai < 2; ++ai)
#pragma unroll
            for (int m = 0; m < 4; ++m) { const int row = 256 * u.pm + 128 * ai + 64 * wr + 16 * m + fr;
                { const int col = 128 * u.pn + 32 * wc + 8 * fq; f32x4 o0, o1;
#pragma unroll
                    for (int r = 0; r < 4; ++r) { o0[r] = acc[ai][0][m][0][r] * sigm(acc[ai][1][m][0][r]); o1[r] = acc[ai][0][m][1][r] * sigm(acc[ai][1][m][1][r]); }
                    st_bf8(dst + (size_t)row * DM + col, o0, o1); } }
    }
};
struct EpiMoe1_8 {
    static constexpr bool PERM = true, AFTER_DRAIN = false;
    bf16* dst;
    MDEV void operator()(const f32x4 (&acc)[2][2][4][2], const pg8::Unit& u, int wr, int wc, int fr, int fq) const {
        OPAQUE2(fr, fq);
#pragma unroll
        for (int ai = 0; ai < 2; ++ai)
#pragma unroll
            for (int m = 0; m < 4; ++m) { const int row = 256 * u.pm + 128 * ai + 64 * wr + 16 * m + fr;
                const int col = 128 * u.pn + 32 * wc + 8 * fq; f32x4 o0, o1;
#pragma unroll
                for (int r = 0; r < 4; ++r) { o0[r] = siluf(acc[ai][0][m][0][r]) * acc[ai][1][m][0][r]; o1[r] = siluf(acc[ai][0][m][1][r]) * acc[ai][1][m][1][r]; }
#ifdef EMU
                st_bf8(dst + (size_t)row * FF + col, o0, o1); }
#else
                u32x4 pk; pk[0] = pk2(o0[0], o0[1]); pk[1] = pk2(o0[2], o0[3]); pk[2] = pk2(o1[0], o1[1]); pk[3] = pk2(o1[2], o1[3]);
                asm volatile("global_store_dwordx4 %0, %1, off sc1\n\ts_nop 2" :: "v"((__attribute__((address_space(1))) bf16*)(dst + (size_t)row * FF + col)), "v"(pk) : "memory"); }
#endif
    }
};
struct EpiMoe2_8 {
    static constexpr bool PERM = true, AFTER_DRAIN = false;
    bf16* dst;
    MDEV void operator()(const f32x4 (&acc)[2][2][4][2], const pg8::Unit& u, int wr, int wc, int fr, int fq) const {
        OPAQUE2(fr, fq);
#pragma unroll
        for (int ai = 0; ai < 2; ++ai)
#pragma unroll
            for (int m = 0; m < 4; ++m) { const int row = 256 * u.pm + 128 * ai + 64 * wr + 16 * m + fr;
#pragma unroll
                for (int bj = 0; bj < 2; ++bj) { const int col = 256 * u.pn + 128 * bj + 32 * wc + 8 * fq;
                    st_bf8(dst + (size_t)row * DM + col, acc[ai][bj][m][0], acc[ai][bj][m][1]); } }
    }
};
DEV unsigned uni(unsigned x);
template <bool G> struct MoeSel {
    static constexpr bool GATHER = G;
    const int* rb; const int* cnt; const int* list; size_t bstride;
    const int* te = nullptr;
    struct Ctx { int e, rbase, c; };
    MDEV Ctx ctx(const pg8::Unit& u) const { int e = 0;
        if (te) e = te[u.pm];
        else {
#pragma unroll 1
            for (int q = 1; q < 32; ++q) if ((rb[q] >> 8) <= u.pm) e = q; }
        e = (int)uni((unsigned)e); Ctx x; x.e = e; x.rbase = (int)uni((unsigned)((u.pm << 8) - rb[e])); x.c = G ? (int)uni((unsigned)cnt[e * 64]) : 0; return x; }
    MDEV size_t boff(const Ctx& x) const { return (size_t)x.e * bstride; }
    MDEV unsigned aoff(const Ctx& x, int r) const { int p = x.rbase + r; if (p > x.c - 1) p = x.c - 1; return (unsigned)list[(size_t)x.e * T + p] * (unsigned)(DM * 2); }
};
struct EpiInProj8 {
    static constexpr bool PERM = true, AFTER_DRAIN = false;
    const Args* a; int li;
    MDEV void operator()(const f32x4 (&acc)[2][2][4][2], const pg8::Unit& u, int wr, int wc, int fr, int fq) const {
        OPAQUE2(fr, fq);
        unsigned char* ws = wsp(*a);
        const int nb = 256 * u.pn + 64 * wc;
        if (nb >= 3392) return;
        if (nb < 512 || (nb >= 768 && nb < 896) || (nb >= 1024 && nb < 1152)) {
            const float* gain; float mul = 1.f; int kind;
            if (nb < 512) { gain = INP(*a, I_QG) + li * 64; mul = 0.125f * LOG2E; kind = 0; }
            else if (nb < 896) { gain = INP(*a, I_KG) + (li * 3 + 1) * 64; kind = 1; }
            else { gain = INP(*a, I_KG) + (li * 3 + 2) * 64; kind = 2; }
            const int g = (nb >> 6) & 1;
            f32x4 gv[2][2];
#pragma unroll
            for (int bj = 0; bj < 2; ++bj)
#pragma unroll
                for (int n = 0; n < 2; ++n) gv[bj][n] = *(const f32x4*)(gain + 32 * bj + 8 * fq + 4 * n);
#pragma unroll
            for (int ai = 0; ai < 2; ++ai)
#pragma unroll
                for (int m = 0; m < 4; ++m) { const int tok = 256 * u.pm + 128 * ai + 64 * wr + 16 * m + fr;
                    float ss = 0.f;
#pragma unroll
                    for (int bj = 0; bj < 2; ++bj)
#pragma unroll
                        for (int n = 0; n < 2; ++n) { const f32x4 v = acc[ai][bj][m][n]; ss += v[0] * v[0] + v[1] * v[1] + v[2] * v[2] + v[3] * v[3]; }
                    ss += shflx(ss, 16); ss += shflx(ss, 32);
                    const float rs = frsq(ss * (1.0f / 64.0f) + EPS) * mul;
                    bf16* dst; if (kind == 0) dst = (bf16*)(ws + WS_QN) + (size_t)tok * 512 + nb; else { const int b = tok / SEQ, sq = tok % SEQ; dst = (bf16*)(ws + (kind == 1 ? WS_KS : WS_KW)) + ((size_t)(b * 2 + g) * SEQ + sq) * 64; }
#pragma unroll
                    for (int bj = 0; bj < 2; ++bj) { f32x4 o0, o1;
#pragma unroll
                        for (int r = 0; r < 4; ++r) { o0[r] = acc[ai][bj][m][0][r] * rs * gv[bj][0][r]; o1[r] = acc[ai][bj][m][1][r] * rs * gv[bj][1][r]; }
                        st_bf8(dst + 32 * bj + 8 * fq, o0, o1); } }
        } else if (nb < 768) {
            bf16* base = (bf16*)(ws + (nb < 640 ? WS_KCG : WS_VCG)); const int g = (nb >> 6) & 1;
#pragma unroll
            for (int ai = 0; ai < 2; ++ai)
#pragma unroll
                for (int m = 0; m < 4; ++m) { const int tok = 256 * u.pm + 128 * ai + 64 * wr + 16 * m + fr, b = tok / SEQ, sq = tok % SEQ;
#pragma unroll
                    for (int bj = 0; bj < 2; ++bj) st_bf8(base + ((size_t)(b * 2 + g) * SEQ + sq) * 64 + 32 * bj + 8 * fq, acc[ai][bj][m][0], acc[ai][bj][m][1]); }
        } else if (nb < 1280) {
            bf16* base = (bf16*)(ws + (nb < 1024 ? WS_VST : WS_VWT)); const int g = (nb >> 6) & 1;
#pragma unroll
            for (int ai = 0; ai < 2; ++ai)
#pragma unroll
                for (int m = 0; m < 4; ++m) { const int tok = 256 * u.pm + 128 * ai + 64 * wr + 16 * m + fr, b = tok / SEQ, sq = tok % SEQ;
#pragma unroll
                    for (int bj = 0; bj < 2; ++bj) st_bf8(base + ((size_t)(b * 2 + g) * SEQ + sq) * 64 + 32 * bj + 8 * fq, acc[ai][bj][m][0], acc[ai][bj][m][1]); }
        } else if (nb < 3328) {
            const int sec = (nb - 1280) >> 9, cc = (nb - 1280) & 511, hh = cc >> 7, d0 = cc & 127;
            f32x4 lbv[2][2];
            if (sec == 1) {
#pragma unroll
                for (int bj = 0; bj < 2; ++bj)
#pragma unroll
                    for (int n = 0; n < 2; ++n) lbv[bj][n] = *(const f32x4*)((const float*)(ws + WS_LB) + li * 512 + cc + 32 * bj + 8 * fq + 4 * n); }
#pragma unroll
            for (int ai = 0; ai < 2; ++ai)
#pragma unroll
                for (int m = 0; m < 4; ++m) { const int tok = 256 * u.pm + 128 * ai + 64 * wr + 16 * m + fr, b = tok / SEQ, sq = tok % SEQ;
                    const size_t hrow = ((size_t)(b * 4 + hh) * SEQ + sq) * 128 + d0;
#pragma unroll
                    for (int bj = 0; bj < 2; ++bj) { const int d = 32 * bj + 8 * fq; f32x4 o0, o1;
                        if (sec == 0) {
#pragma unroll
                            for (int r = 0; r < 4; ++r) { o0[r] = siluf(acc[ai][bj][m][0][r]); o1[r] = siluf(acc[ai][bj][m][1][r]); }
                            st_bf8((bf16*)(ws + WS_HQ) + hrow + d, o0, o1); }
                        else if (sec == 1) {
#pragma unroll
                            for (int r = 0; r < 4; ++r) { o0[r] = lbv[bj][0][r] + (1.0f - lbv[bj][0][r]) * sigm(acc[ai][bj][m][0][r]); o1[r] = lbv[bj][1][r] + (1.0f - lbv[bj][1][r]) * sigm(acc[ai][bj][m][1][r]); }
                            float* pf = (float*)(ws + WS_HF) + hrow + d; *(f32x4*)pf = o0; *(f32x4*)(pf + 4) = o1; }
                        else if (sec == 2) st_bf8((bf16*)(ws + WS_HV) + hrow + d, acc[ai][bj][m][0], acc[ai][bj][m][1]);
                        else {
#pragma unroll
                            for (int r = 0; r < 4; ++r) { o0[r] = siluf(acc[ai][bj][m][0][r]); o1[r] = siluf(acc[ai][bj][m][1][r]); }
                            st_bf8((bf16*)(ws + WS_HGS) + (size_t)tok * 512 + cc + d, o0, o1); } } }
        } else {
            float* dst = (float*)(ws + WS_GATE);
            if (fq < 3) {
#pragma unroll
                for (int ai = 0; ai < 2; ++ai)
#pragma unroll
                    for (int m = 0; m < 4; ++m) { const int tok = 256 * u.pm + 128 * ai + 64 * wr + 16 * m + fr; f32x4 o0, o1;
#pragma unroll
                        for (int r = 0; r < 4; ++r) { o0[r] = sigm(acc[ai][0][m][0][r]); o1[r] = sigm(acc[ai][0][m][1][r]); }
                        float* pf = dst + (size_t)tok * 24 + 8 * fq; *(f32x4*)pf = o0; *(f32x4*)(pf + 4) = o1; } }
        }
    }
};

DEV void tr_tile(unsigned char* smem, const float* src0, const float* src1, int ld, int K, int mode, bf16* dst, int n0, int k0) {
    bf16* tl = (bf16*)smem;
    const int tid = TID;
    SYNC();
#pragma unroll
    for (int i = 0; i < 8; ++i) {
        const int e = tid + 512 * i, kk = e >> 6, nn = e & 63, n = n0 + nn; float v = 0.f;
        if (mode == 0) v = src0[(size_t)(k0 + kk) * ld + n];
        else if (mode == 1) { int sc = n < 1280 ? n : (n < 3328 ? n + 24 : (n < 3352 ? 1280 + (n - 3328) : -1)); if (sc >= 0) v = src0[(size_t)(k0 + kk) * ld + sc]; }
        else { const int g = n >> 6, w = n & 63; v = (w < 32) ? src0[(size_t)(k0 + kk) * ld + g * 32 + w] : src1[(size_t)(k0 + kk) * ld + g * 32 + w - 32]; }
        tl[nn * LDT + kk] = (bf16)f2bf(v);
    }
    SYNC();
    const int nn = tid >> 3, k8 = (tid & 7) * 8;
    *(bf16x8*)(dst + (size_t)(n0 + nn) * K + k0 + k8) = *(const bf16x8*)(tl + nn * LDT + k8);
}

DEV int tr_col(int mode, int n) {
    if (mode == 0) return n;
    const int pn = n >> 8, ct = n & 255;
    if (mode == 5) { const int bj = ct >> 7, wc = (ct >> 5) & 3, j = ct & 31, L = 256 * pn + 64 * wc + 32 * bj + j; return L < 1280 ? L : (L < 3328 ? L + 24 : (L < 3352 ? 1280 + (L - 3328) : -1)); }
    { const int bj = ct >> 7, Lc = 128 * pn + (ct & 127); return bj == 0 ? Lc : (mode == 7 ? FF : DM) + Lc; }
}
DEV void tr_tile(unsigned char* smem, const float* src, int ld, int K, int mode, bf16* dst, int n0, int k0) {
    bf16* tl = (bf16*)smem;
    const int tid = TID, nq = tid & 31, kq = tid >> 5;
    const int sc = tr_col(mode, n0 + 4 * nq);
    f32x4 v[4];
#pragma unroll
    for (int i = 0; i < 4; ++i) v[i] = sc >= 0 ? *(const f32x4*)(src + (size_t)(k0 + 4 * kq + i) * ld + sc) : f4zero();
    SYNC();
#pragma unroll
    for (int j = 0; j < 4; ++j) { u32x2 w; w[0] = pk2(v[0][j], v[1][j]); w[1] = pk2(v[2][j], v[3][j]); *(u32x2*)(tl + (4 * nq + j) * LDT + 4 * kq) = w; }
    SYNC();
#pragma unroll
    for (int t = 0; t < 2; ++t) { const int id = tid + 512 * t, row = id >> 3, ch = id & 7;
        *(bf16x8*)(dst + (size_t)(n0 + row) * K + k0 + 8 * ch) = *(const bf16x8*)(tl + row * LDT + 8 * ch); }
}
constexpr int KSUP = FF >= 256 ? 256 : FF, NSUP = KSUP / 64;
DEV void tr_super(unsigned char* smem, const float* src0, const float* src1, int ld, int K, int mode, bf16* dst, int n0, int k0) {
    const int tid = TID, nq = tid & 31, kq = tid >> 5;
    int sc = n0 + 4 * nq; const float* src = src0;
    if (mode == 7) { const int cc = tr_col(7, sc); src = cc >= FF ? src1 : src0; sc = cc >= FF ? cc - FF : cc; }
    else if (mode != 0) sc = tr_col(mode, sc);
    f32x4 v[NSUP][4];
#pragma unroll
    for (int sb = 0; sb < NSUP; ++sb)
#pragma unroll
        for (int i = 0; i < 4; ++i) v[sb][i] = sc >= 0 ? *(const f32x4*)(src + (size_t)(k0 + 64 * sb + 4 * kq + i) * ld + sc) : f4zero();
    SYNC();
    const int fw = nq & (KSUP / 16 - 1);
#pragma unroll
    for (int j = 0; j < 4; ++j)
#pragma unroll
        for (int sb = 0; sb < NSUP; ++sb) { const int c16 = 8 * sb + (kq >> 1); u32x2 w; w[0] = pk2(v[sb][0][j], v[sb][1][j]); w[1] = pk2(v[sb][2][j], v[sb][3][j]);
            *(u32x2*)(smem + (4 * nq + j) * (KSUP * 2) + ((c16 ^ fw) << 4) + (kq & 1) * 8) = w; }
    SYNC();
#pragma unroll
    for (int t = 0; t < 128 * (KSUP / 8) / NT; ++t) { const int id = tid + NT * t, row = id / (KSUP / 8), ch = id % (KSUP / 8), f = (row >> 2) & (KSUP / 16 - 1);
        *(bf16x8*)(dst + (size_t)(n0 + row) * K + k0 + 8 * (ch ^ f)) = *(const bf16x8*)(smem + row * (KSUP * 2) + ch * 16); }
}
constexpr int MOE_S13 = (2 * FF / 128) * (DM / KSUP), MOE_S2 = (DM / 128) * (FF / KSUP), MOE_SPE = MOE_S13 + MOE_S2, MOE_NIT = DEPTH * 32 * MOE_SPE;
DEV void moe_conv_tile(const Args& a, unsigned char* smem, int it) {
    unsigned char* ws = wsp(a); const int le = it / MOE_SPE, r = it % MOE_SPE;
    if (r < MOE_S13) { const int tn = r % (2 * FF / 128), tk = r / (2 * FF / 128);
        tr_super(smem, INP(a, I_W1) + (size_t)le * DM * FF, INP(a, I_W3) + (size_t)le * DM * FF, FF, DM, 7, (bf16*)(ws + WS_W13) + (size_t)le * 2 * FF * DM, tn * 128, tk * KSUP); }
    else { const int r2 = r - MOE_S13, tn = r2 % (DM / 128), tk = r2 / (DM / 128);
        tr_super(smem, INP(a, I_W2) + (size_t)le * FF * DM, INP(a, I_W2), DM, FF, 0, (bf16*)(ws + WS_W2) + (size_t)le * DM * FF, tn * 128, tk * KSUP); }
}
#ifndef EMU
constexpr int MOE_TAIL_Q = 3;
constexpr int MOE_N0 = MOE_NIT - 2 * MOE_TAIL_Q * (128 + 224) > 2 * 32 * MOE_SPE ? MOE_NIT - 2 * MOE_TAIL_Q * (128 + 224) : 2 * 32 * MOE_SPE;
DEV int moe_conv_fetch(const Args& a, unsigned char* smem) {
    int* ctr = (int*)(wsp(a) + WS_BAR) + P0_CTR_IDX; int* nxl = (int*)(smem + 72 * 1024);
    SYNC(); if (TID == 0) nxl[0] = atomic_add_i(ctr, 1); SYNC(); return nxl[0];
}
DEV void moe_conv_pull(const Args& a, unsigned char* smem, int quota) {
    for (int q = 0; q < quota; ++q) { const int it = moe_conv_fetch(a, smem); if (it >= MOE_NIT) break; moe_conv_tile(a, smem, it); }
    SYNC();
}
DEV void moe_conv_drain(const Args& a, unsigned char* smem, int limit) {
    __attribute__((address_space(1))) unsigned* ctr = (__attribute__((address_space(1))) unsigned*)((unsigned*)(wsp(a) + WS_BAR) + P0_CTR_IDX);
    for (;;) { if ((int)__builtin_amdgcn_readfirstlane((int)__hip_atomic_load(ctr, __ATOMIC_RELAXED, __HIP_MEMORY_SCOPE_AGENT)) >= limit) break;
        const int it = moe_conv_fetch(a, smem); if (it >= MOE_NIT) break; moe_conv_tile(a, smem, it); }
    SYNC();
}
#endif
struct TrJob { const float* s; int ld, K, N, mode; bf16* dst; };
DEV void p0_phase(const Args& a, unsigned char* smem) {
    unsigned char* ws = wsp(a); const int tid = TID;
    { int item = BID, base = 0;
      for (int j = 0; j < 8; ++j) { TrJob J; const int i = j & 1;
        if (j < 2) J = {INP(a, I_WIN) + (size_t)i * DM * NIN, NIN, DM, NIN8, 5, (bf16*)(ws + WS_WIN) + (size_t)i * NIN8 * DM};
        else if (j < 4) J = {INP(a, I_WOUT) + (size_t)i * 1024 * DM, DM, 1024, DM, 0, (bf16*)(ws + WS_WOUT) + (size_t)i * DM * 1024};
        else if (j < 6) J = {INP(a, I_PW1) + (size_t)i * DM * 2 * DM, 2 * DM, DM, 2 * DM, 6, (bf16*)(ws + WS_PW1) + (size_t)i * 2 * DM * DM};
        else J = {INP(a, I_PW2) + (size_t)i * DM * DM, DM, DM, DM, 0, (bf16*)(ws + WS_PW2) + (size_t)i * DM * DM};
        const int tn = J.N / 128, tk = J.K / KSUP, nt = tn * tk;
        while (item < base + nt) { const int it = item - base; tr_super(smem, J.s, J.s, J.ld, J.K, J.mode, J.dst, (it % tn) * 128, (it / tn) * KSUP); item += NBLK; }
        base += nt; }
      SYNC(); }
    {
        float* red = (float*)smem;
        constexpr int NG = 6 * DM / 128; const int ntask = DEPTH * NG;
        for (int t = BID; t < ntask; t += NBLK) {
            const int l = t / NG, j0 = (t % NG) * 128, cq = tid & 31, kr = tid >> 5;
            const float* w = INP(a, I_ADAW) + (size_t)l * DM * 6 * DM + j0 + 4 * cq; const float* cc = INP(a, I_C);
            f32x4 a0 = f4zero(), a1 = f4zero();
#pragma unroll 8
            for (int i = 0; i < DM / 16; ++i) { const int k = kr + 16 * i; const f32x4 wv = *(const f32x4*)(w + (size_t)k * 6 * DM); const float s0 = siluf(cc[k]), s1 = siluf(cc[DM + k]);
#pragma unroll
                for (int r = 0; r < 4; ++r) { a0[r] += s0 * wv[r]; a1[r] += s1 * wv[r]; } }
            SYNC();
            *(f32x4*)(red + (kr * 2 + 0) * 128 + 4 * cq) = a0; *(f32x4*)(red + (kr * 2 + 1) * 128 + 4 * cq) = a1;
            SYNC();
            if (tid < 256) { const int b = tid >> 7, col = tid & 127; float sum = INP(a, I_ADAB)[(size_t)l * 6 * DM + j0 + col];
#pragma unroll
                for (int q = 0; q < 16; ++q) sum += red[(q * 2 + b) * 128 + col];
                ((float*)(ws + WS_MOD))[((size_t)l * 2 + b) * 6 * DM + j0 + col] = sum; }
        }
    }
    for (int t = BID; t < 32; t += NBLK) {
        float* red = (float*)smem; const int ikv = t >> 3, kp = t & 7, i = ikv >> 1, kv = ikv & 1, e = tid & 63, ks = tid >> 6;
        const float* W = INP(a, kv ? I_CWV : I_CWK) + (size_t)i * 2048 * 64 + e; const float* pe = INP(a, I_CPE) + (size_t)i * 2048;
        float sum = 0.f;
#pragma unroll 8
        for (int q = 0; q < 32; ++q) { const int k = kp * 256 + ks * 32 + q; sum += pe[k] * W[(size_t)k * 64]; }
        SYNC(); red[ks * 64 + e] = sum; SYNC();
        if (tid < 64) { float v = 0.f; for (int q = 0; q < 8; ++q) v += red[q * 64 + tid]; ((float*)(ws + WS_CB))[(ikv * 8 + kp) * 64 + tid] = v; }
    }
    for (int i = BID * NT + tid; i < DEPTH * 48 * DM; i += NBLK * NT) { const int k = i % DM, n = (i / DM) % 48, ll = i / (48 * DM);
        const float wv = n < 4 ? INP(a, I_WG)[((size_t)ll * DM + k) * 4 + n] : (n < 36 ? INP(a, I_WE)[((size_t)ll * DM + k) * 32 + n - 4] : 0.f);
        const unsigned hi = f2bf(wv); ((bf16*)(ws + WS_WTH))[i] = (bf16)hi; ((bf16*)(ws + WS_WTL))[i] = (bf16)f2bf(wv - bf2f(hi)); }
    if (BID == 0) {
        for (int i = tid; i < DEPTH * 32; i += NT) ((int*)(ws + WS_CNT))[i * 64] = 0;
        for (int i = tid; i < DEPTH * 256; i += NT) ((unsigned*)(ws + WS_FLG))[i * 16] = 0u;
        for (int n = tid; n < 512; n += NT) { const float l0 = INP(a, I_LBL)[n], l1 = INP(a, I_LBL)[512 + n]; const float m = fmaxf(l0, l1);
            const float e0 = fexp2((l0 - m) * LOG2E), e1 = fexp2((l1 - m) * LOG2E);
            ((float*)(ws + WS_LB))[n] = 0.f; ((float*)(ws + WS_LB))[512 + n] = e1 / (e0 + e1); }
        if (tid < 2) { const int i = tid; float mq = 0.f; for (int d = 0; d < 64; ++d) mq = fmaxf(mq, fabsf(INP(a, I_QG)[i * 64 + d]));
            for (int br = 0; br < 3; ++br) { float mk = 0.f; for (int d = 0; d < 64; ++d) mk = fmaxf(mk, fabsf(INP(a, I_KG)[(i * 3 + br) * 64 + d]));
                ((float*)(ws + WS_CS))[i * 4 + br] = 8.0f * mq * mk * LOG2E; } }
    }
    SYNC();
    {
#ifdef EMU
      for (int it = BID; it < MOE_NIT; it += NBLK) moe_conv_tile(a, smem, it);
#else
      int* ctr = (int*)(ws + WS_BAR) + P0_CTR_IDX; int* nxl = (int*)(smem + 72 * 1024);
      int my_next = 0; if (tid == 0) my_next = atomic_add_i(ctr, 1);
      for (;;) { if (tid == 0) nxl[0] = my_next; SYNC(); const int it = nxl[0]; if (it >= MOE_NIT) break;
          const bool more = it < MOE_N0;
          if (more && tid == 0) my_next = atomic_add_i(ctr, 1);
          moe_conv_tile(a, smem, it);
          if (!more) break; }
#endif
      SYNC(); }
}

constexpr int NJV = DM / 256;
DEV void moe_bases(const int* cnt, int* rb  ) {
    if (TID == 0) { int acc = 0; for (int e = 0; e < 32; ++e) { rb[e] = acc; acc += ((cnt[e * 64] + 255) >> 8) << 8; } rb[32] = acc; }
    SYNC();
}
DEV void norm_phase(const Args& a, unsigned char* smem, int l) {
    unsigned char* ws = wsp(a); const int tid = TID, w = tid >> 6, lane = tid & 63;
    int* rb = (int*)smem;
    if (l > 0) moe_bases((const int*)(ws + WS_CNT) + (l - 1) * 32 * 64, rb);
    const float* mod = (const float*)(ws + WS_MOD);
    const bf16* yk = (const bf16*)(ws + WS_YK);
    if (l < DEPTH) {
        const int bid = BID % 76 == BID ? BID : -1;
        for (int job = BID; job < 76; job += NBLK) {
            if (job < 72) { const int b = job / 36, n = job % 36; float sum = 0.f;
                for (int k = tid; k < DM; k += NT) { const float wv = n < 4 ? INP(a, I_WG)[((size_t)l * DM + k) * 4 + n] : INP(a, I_WE)[((size_t)l * DM + k) * 32 + n - 4]; sum += mod[((size_t)l * 2 + b) * 6 * DM + 3 * DM + k] * wv; }
#pragma unroll
                for (int q = 1; q < 64; q <<= 1) sum += shflx(sum, q);
                float* red = (float*)(smem + 1024);
                SYNC(); if (lane == 0) red[w] = sum; SYNC();
                if (tid == 0) { float t = 0.f; for (int q = 0; q < 8; ++q) t += red[q]; ((float*)(ws + WS_RBIAS))[((size_t)l * 2 + b) * 48 + n] = t; }
            } else { const float* nf = INP(a, I_NFFN) + (size_t)l * DM; const int part = job - 72;
                for (int i = part * (2 * DM / 4) + tid; i < (part + 1) * (2 * DM / 4); i += NT) { const int b = i / DM, k = i % DM; ((float*)(ws + WS_AVEC))[((size_t)l * 2 + b) * DM + k] = nf[k] * (1.0f + mod[((size_t)l * 2 + b) * 6 * DM + 4 * DM + k]); } }
        }
        (void)bid;
    }
    const int rstride = NBLK * 8;
    for (int rowa = BID * 8 + w; rowa < T; rowa += 2 * rstride) {
        int row[2]; bool ok[2];
        row[0] = rowa; ok[0] = true; row[1] = rowa + rstride; ok[1] = row[1] < T; if (!ok[1]) row[1] = rowa;
        f32x4 v[2][NJV]; int e0[2], p0[2], e1[2], p1[2]; float w0[2], w1[2];
        const float* xin = (l == 0) ? INP(a, I_X) : outp(a);
#pragma unroll
        for (int q = 0; q < 2; ++q) {
#pragma unroll
            for (int j = 0; j < NJV; ++j) v[q][j] = *(const f32x4*)(xin + (size_t)row[q] * DM + 4 * lane + 256 * j);
            if (l > 0) { const int* tie = (const int*)(ws + WS_TIE) + (size_t)row[q] * 2; const float* tiw = (const float*)(ws + WS_TIW) + (size_t)row[q] * 2;
                e0[q] = tie[0] >> 14; p0[q] = tie[0] & 16383; e1[q] = tie[1] >> 14; p1[q] = tie[1] & 16383; w0[q] = tiw[0]; w1[q] = tiw[1]; } }
        if (l > 0) {
            u32x2 q0[2][NJV], q1[2][NJV];
#pragma unroll
            for (int q = 0; q < 2; ++q) { const bf16* y0 = yk + (size_t)(rb[e0[q]] + p0[q]) * DM; const bf16* y1 = yk + (size_t)(rb[e1[q]] + p1[q]) * DM;
#pragma unroll
                for (int j = 0; j < NJV; ++j) { const int cidx = 4 * lane + 256 * j; q0[q][j] = *(const u32x2*)(y0 + cidx); q1[q][j] = *(const u32x2*)(y1 + cidx); } }
#pragma unroll
            for (int q = 0; q < 2; ++q) { const int b = row[q] / SEQ; const float* gf = mod + ((size_t)(l - 1) * 2 + b) * 6 * DM + 5 * DM;
#pragma unroll
                for (int j = 0; j < NJV; ++j) { const int cidx = 4 * lane + 256 * j; const f32x4 g = *(const f32x4*)(gf + cidx);
                    v[q][j][0] += g[0] * (w0[q] * bf2f(q0[q][j][0] & 0xffff) + w1[q] * bf2f(q1[q][j][0] & 0xffff));
                    v[q][j][1] += g[1] * (w0[q] * bf2f(q0[q][j][0] >> 16) + w1[q] * bf2f(q1[q][j][0] >> 16));
                    v[q][j][2] += g[2] * (w0[q] * bf2f(q0[q][j][1] & 0xffff) + w1[q] * bf2f(q1[q][j][1] & 0xffff));
                    v[q][j][3] += g[3] * (w0[q] * bf2f(q0[q][j][1] >> 16) + w1[q] * bf2f(q1[q][j][1] >> 16)); } }
        }
        if (l > 0)
#pragma unroll
        for (int q = 0; q < 2; ++q) { if (!ok[q]) continue;
#pragma unroll
            for (int j = 0; j < NJV; ++j) *(f32x4*)(outp(a) + (size_t)row[q] * DM + 4 * lane + 256 * j) = v[q][j]; }
        if (l == DEPTH) continue;
        float ss[2];
#pragma unroll
        for (int q = 0; q < 2; ++q) { ss[q] = 0.f;
#pragma unroll
            for (int j = 0; j < NJV; ++j) ss[q] += v[q][j][0] * v[q][j][0] + v[q][j][1] * v[q][j][1] + v[q][j][2] * v[q][j][2] + v[q][j][3] * v[q][j][3]; }
#pragma unroll
        for (int o = 1; o < 64; o <<= 1) { ss[0] += shflx(ss[0], o); ss[1] += shflx(ss[1], o); }
        const float* nm = INP(a, I_NMIX) + (size_t)l * DM;
#pragma unroll
        for (int q = 0; q < 2; ++q) { if (!ok[q]) continue;
            const int b = row[q] / SEQ; const float rs = frsq(ss[q] * (1.0f / DM) + EPS);
            const float* mm = mod + ((size_t)l * 2 + b) * 6 * DM; bf16* hb = (bf16*)(ws + WS_H) + (size_t)row[q] * DM;
#pragma unroll
            for (int j = 0; j < NJV; ++j) { const int cidx = 4 * lane + 256 * j; f32x4 g = *(const f32x4*)(nm + cidx), sh = *(const f32x4*)(mm + cidx), sc = *(const f32x4*)(mm + DM + cidx), o;
#pragma unroll
                for (int r = 0; r < 4; ++r) o[r] = v[q][j][r] * rs * g[r] * (1.0f + sc[r]) + sh[r];
                st_bf4(hb + cidx, o); } }
    }
}

DEV void route_phase(const Args& a, unsigned char* smem, int l) {
    unsigned char* ws = wsp(a); const int tid = TID, w = tid >> 6, lane = tid & 63, h = lane >> 4, c = lane & 15, pi = w >> 1, kh = w & 1;
    constexpr int NCHK = 4, CH = DM / NCHK, WLD = CH + 8, NKS = CH / 2 / 32;
    constexpr int WTOT = 48 * (CH / 8), WMAX = (WTOT + NT - 1) / NT;
    bf16* WHl = (bf16*)smem; bf16* WLl = WHl + 48 * WLD;
    float* lg = (float*)(WLl + 48 * WLD);
    float* ssb = lg + 4 * 2 * 16 * 48;
    float* rsb = ssb + 4 * 2 * 16;
    int* lcnt = (int*)(rsb + 64); int* lbase = lcnt + 32; int* tinfo = lbase + 32;
    float* avl = (float*)(tinfo + 256); float* cvl = avl + 2 * DM;
    float* rbl = cvl + 2 * DM;
    const float* mod = (const float*)(ws + WS_MOD);
    SYNC();
    if (tid < 32) lcnt[tid] = 0;
    for (int i = tid; i < 2 * DM; i += NT) { const int b = i / DM, k = i % DM; avl[i] = ((const float*)(ws + WS_AVEC))[((size_t)l * 2 + b) * DM + k]; cvl[i] = mod[((size_t)l * 2 + b) * 6 * DM + 3 * DM + k]; }
    if (tid < 96) rbl[tid] = ((const float*)(ws + WS_RBIAS))[(size_t)l * 2 * 48 + tid];
    const bf16* WH = (const bf16*)(ws + WS_WTH) + (size_t)l * 48 * DM; const bf16* WL = (const bf16*)(ws + WS_WTL) + (size_t)l * 48 * DM;
    int* cnt = (int*)(ws + WS_CNT) + l * 32 * 64;
    for (int pass0 = BID; pass0 < T / 16; pass0 += 4 * NBLK) {
        const int pass = pass0 + pi * NBLK; const bool valid = pass < T / 16;
        const int tok = valid ? pass * 16 + c : 0, b = tok / SEQ;
        const float* xrow = outp(a) + (size_t)tok * DM;
        f32x4 xv[2][NKS][2]; bf16x8 wh[WMAX], wl[WMAX];
#pragma unroll
        for (int ks = 0; ks < NKS; ++ks) { const float* xq = xrow + kh * (CH / 2) + 8 * h + 32 * ks; xv[0][ks][0] = *(const f32x4*)xq; xv[0][ks][1] = *(const f32x4*)(xq + 4); }
#pragma unroll
        for (int t = 0; t < WMAX; ++t) { const int i = tid + NT * t; if (i < WTOT) { const int n = i / (CH / 8), k8 = (i % (CH / 8)) * 8; wh[t] = *(const bf16x8*)(WH + (size_t)n * DM + k8); wl[t] = *(const bf16x8*)(WL + (size_t)n * DM + k8); } }
        f32x4 acc[3] = {f4zero(), f4zero(), f4zero()}; float ss = 0.f;
        bf16x8 uhk[NCHK * NKS];
#pragma unroll
        for (int chn = 0; chn < NCHK; ++chn) {
            SYNC();
#pragma unroll
            for (int t = 0; t < WMAX; ++t) { const int i = tid + NT * t; if (i < WTOT) { const int n = i / (CH / 8), k8 = (i % (CH / 8)) * 8; *(bf16x8*)(WHl + n * WLD + k8) = wh[t]; *(bf16x8*)(WLl + n * WLD + k8) = wl[t]; } }
            SYNC();
            if (chn + 1 < NCHK) {
#pragma unroll
                for (int ks = 0; ks < NKS; ++ks) { const float* xq = xrow + (chn + 1) * CH + kh * (CH / 2) + 8 * h + 32 * ks; xv[(chn + 1) & 1][ks][0] = *(const f32x4*)xq; xv[(chn + 1) & 1][ks][1] = *(const f32x4*)(xq + 4); }
#pragma unroll
                for (int t = 0; t < WMAX; ++t) { const int i = tid + NT * t; if (i < WTOT) { const int n = i / (CH / 8), k8 = (i % (CH / 8)) * 8; wh[t] = *(const bf16x8*)(WH + (size_t)n * DM + (chn + 1) * CH + k8); wl[t] = *(const bf16x8*)(WL + (size_t)n * DM + (chn + 1) * CH + k8); } }
            }
            if (valid) {
                const bf16* whp = WHl + c * WLD + kh * (CH / 2) + 8 * h; const bf16* wlp = WLl + c * WLD + kh * (CH / 2) + 8 * h;
                const float* ap = avl + b * DM + chn * CH + kh * (CH / 2) + 8 * h;
#pragma unroll
                for (int ks = 0; ks < NKS; ++ks) {
                    const f32x4 a0 = *(const f32x4*)(ap + 32 * ks), a1 = *(const f32x4*)(ap + 32 * ks + 4);
                    const f32x4 x0 = xv[chn & 1][ks][0], x1 = xv[chn & 1][ks][1];
                    f32x4 u0, u1, r0, r1;
#pragma unroll
                    for (int r = 0; r < 4; ++r) { u0[r] = x0[r] * a0[r]; u1[r] = x1[r] * a1[r]; ss += x0[r] * x0[r] + x1[r] * x1[r]; }
                    const bf16x8 uh = pack8(u0, u1); uhk[chn * NKS + ks] = uh;
#pragma unroll
                    for (int r = 0; r < 4; ++r) { r0[r] = u0[r] - bf2f((unsigned short)uh[r]); r1[r] = u1[r] - bf2f((unsigned short)uh[4 + r]); }
                    const bf16x8 ul = pack8(r0, r1);
#pragma unroll
                    for (int nt = 0; nt < 3; ++nt) { const bf16x8 whf = *(const bf16x8*)(whp + nt * 16 * WLD + 32 * ks), wlf = *(const bf16x8*)(wlp + nt * 16 * WLD + 32 * ks);
                        acc[nt] = mfma16(whf, uh, acc[nt]); acc[nt] = mfma16(wlf, uh, acc[nt]); acc[nt] = mfma16(whf, ul, acc[nt]); }
                }
            }
        }
        if (valid) {
            ss += shflx(ss, 16); ss += shflx(ss, 32);
            float* lgp = lg + ((pi * 2 + kh) * 16 + c) * 48 + 4 * h;
#pragma unroll
            for (int nt = 0; nt < 3; ++nt) *(f32x4*)(lgp + 16 * nt) = acc[nt];
            if (h == 0) ssb[(pi * 2 + kh) * 16 + c] = ss;
        }
        SYNC();
        if (tid < 64) { const int p2 = tid >> 4, tk = tid & 15, pass2 = pass0 + p2 * NBLK;
            if (pass2 < T / 16) { const int tok2 = pass2 * 16 + tk, b2 = tok2 / SEQ;
                const float rs = frsq((ssb[(p2 * 2 + 0) * 16 + tk] + ssb[(p2 * 2 + 1) * 16 + tk]) * (1.0f / DM) + EPS); rsb[p2 * 16 + tk] = rs;
                const float* l0 = lg + ((p2 * 2 + 0) * 16 + tk) * 48; const float* l1 = lg + ((p2 * 2 + 1) * 16 + tk) * 48; const float* rbp = rbl + b2 * 48;
                float acc[36];
#pragma unroll
                for (int n = 0; n < 36; ++n) acc[n] = rs * (l0[n] + l1[n]) + rbp[n];
                int gs = 0; float gm = acc[0];
#pragma unroll
                for (int g = 1; g < 4; ++g) if (acc[g] > gm) { gm = acc[g]; gs = g; }
                float den = 0.f;
#pragma unroll
                for (int g = 0; g < 4; ++g) den += fexp2((acc[g] - gm) * LOG2E);
                const float ggate = 1.0f / den;
                float el[8];
#pragma unroll
                for (int j = 0; j < 8; ++j) { el[j] = acc[4 + j];
#pragma unroll
                    for (int g = 1; g < 4; ++g) if (gs == g) el[j] = acc[4 + 8 * g + j]; }
                int ia = 0; float va = el[0];
#pragma unroll
                for (int j = 1; j < 8; ++j) if (el[j] > va) { va = el[j]; ia = j; }
                int ib = -1; float vb = -3e38f;
#pragma unroll
                for (int j = 0; j < 8; ++j) if (j != ia && el[j] > vb) { vb = el[j]; ib = j; }
                const float wa = 1.0f / (1.0f + fexp2((vb - va) * LOG2E)), wb = 1.0f - wa;
                const int e0 = gs * 8 + ia, e1 = gs * 8 + ib;
                const int p0 = atomic_add_i(lcnt + e0, 1), p1 = atomic_add_i(lcnt + e1, 1);
                int* ti = tinfo + tid * 4;
                ti[0] = (e0 << 14) | p0; ti[1] = (e1 << 14) | p1; ti[2] = __builtin_bit_cast(int, ggate * wa); ti[3] = __builtin_bit_cast(int, ggate * wb);
            } }
        SYNC();
        int gbase = 0;
        if (tid < 32) { const int n = lcnt[tid]; gbase = n > 0 ? atomic_add_i(cnt + tid * 64, n) : 0; }
        if (valid) { const float rs = rsb[pi * 16 + c]; bf16* hb = (bf16*)(ws + WS_H) + (size_t)tok * DM + kh * (CH / 2) + 8 * h;
            const float* cp = cvl + b * DM + kh * (CH / 2) + 8 * h;
#pragma unroll
            for (int chn = 0; chn < NCHK; ++chn)
#pragma unroll
                for (int ks = 0; ks < NKS; ++ks) {
                    const bf16x8 uh = uhk[chn * NKS + ks]; const f32x4 c0 = *(const f32x4*)(cp + chn * CH + 32 * ks), c1 = *(const f32x4*)(cp + chn * CH + 32 * ks + 4);
                    f32x4 o0, o1;
#pragma unroll
                    for (int r = 0; r < 4; ++r) { o0[r] = bf2f((unsigned short)uh[r]) * rs + c0[r]; o1[r] = bf2f((unsigned short)uh[4 + r]) * rs + c1[r]; }
                    st_bf8(hb + chn * CH + 32 * ks, o0, o1); } }
        if (tid < 32) { lbase[tid] = gbase; lcnt[tid] = 0; }
        SYNC();
        if (tid < 64) { const int p2 = tid >> 4, pass2 = pass0 + p2 * NBLK;
            if (pass2 < T / 16) { const int tok2 = pass2 * 16 + (tid & 15); const int* ti = tinfo + tid * 4;
                const int e0 = ti[0] >> 14, e1 = ti[1] >> 14, p0 = lbase[e0] + (ti[0] & 16383), p1 = lbase[e1] + (ti[1] & 16383);
                int* list = (int*)(ws + WS_LIST); list[(size_t)e0 * T + p0] = tok2; list[(size_t)e1 * T + p1] = tok2;
                int* tie = (int*)(ws + WS_TIE) + (size_t)tok2 * 2; int* tiw = (int*)(ws + WS_TIW) + (size_t)tok2 * 2;
                tie[0] = (e0 << 14) | p0; tie[1] = (e1 << 14) | p1; tiw[0] = ti[2]; tiw[1] = ti[3]; } }
        SYNC();
    }
}

DEV int vbid() { const int g = NBLK; return (g % 8 == 0) ? (BID % 8) * (g / 8) + BID / 8 : BID; }
#ifdef EMU
#define PG8_LDS(p) (p)
#else
#define PG8_LDS(p) ((PG8_LAS unsigned char*)(p))
#endif
DEV void inproj_phase(const Args& a, unsigned char* smem, int li) {
    pg8::Gemm g{(const bf16*)(wsp(a) + WS_H), (const bf16*)(wsp(a) + WS_WIN) + (size_t)li * NIN8 * DM, T, NIN8, DM}; typedef pg8::StaticOrderT<T / 256, NIN8 / 256> SO; SO S; S.init(NBLK, BID);
    EpiInProj8 E{&a, li};
    SYNC(); pg8::gemm_phase<EpiInProj8, SO, true, true>(PG8_LDS(smem), g, S, E); SYNC();
#ifndef EMU
    { pg8::Unit u; const int full = (T / 256) * (NIN8 / 256) / NBLK; if (!S.next(full, u)) moe_conv_pull(a, smem, MOE_TAIL_Q); }
#endif
}
DEV void resid_gemm_phase(const Args& a, unsigned char* smem, const bf16* A, int K, const bf16* Bt, int l) {
    pg8::Gemm g{A, Bt, T, DM, K}; typedef pg8::StaticOrderT<T / 256, DM / 256> SO; SO S; S.init(NBLK, BID);
    EpiResid8 E{outp(a), (const float*)(wsp(a) + WS_MOD) + (size_t)l * 2 * 6 * DM + 2 * DM, l == 0 ? INP(a, I_X) : (const float*)outp(a)};
    SYNC(); pg8::gemm_phase<EpiResid8, SO, true, true>(PG8_LDS(smem), g, S, E); SYNC();
}
DEV void pw1_phase(const Args& a, unsigned char* smem, int li) {
    pg8::Gemm g{(const bf16*)(wsp(a) + WS_H), (const bf16*)(wsp(a) + WS_PW1) + (size_t)li * 2 * DM * DM, T, 2 * DM, DM}; typedef pg8::StaticOrderT<T / 256, 2 * DM / 256> SO; SO S; S.init(NBLK, BID);
    EpiGlu8 E{(bf16*)(wsp(a) + WS_GLU)};
    SYNC(); pg8::gemm_phase<EpiGlu8, SO, true, true>(PG8_LDS(smem), g, S, E); SYNC();
}
DEV void cmp_phase_items(const Args& a, unsigned char* smem, int li, int it) {
    constexpr int TMC = (NCP + 255) / 256;
    const int kv = it / (4 * TMC), bg = (it / TMC) % 4, tm = it % TMC;
    const bf16* src = (const bf16*)(wsp(a) + (kv ? WS_VCG : WS_KCG)) + (size_t)bg * SEQ * 64;
    struct AF { const bf16* base; int m0; MDEV unsigned off(int r) const { int n = m0 + r; if (n > NCMP - 1) n = NCMP - 1; return (unsigned)n * 1024u; } } af{src, tm * 256};
    EpiCmp E{&a, kv, bg, tm * 256, li};
    BClamp64 bf{INP(a, kv ? I_CWV : I_CWK) + (size_t)li * 2048 * 64};
    gemm_tile2(smem, af, bf, 64, 2048, E);
}
#ifdef EMU
DEV void wt_store64(void* p, unsigned long long v) { *(unsigned long long*)p = v; }
DEV unsigned ctr_add(unsigned* p, unsigned v) { return __atomic_fetch_add(p, v, __ATOMIC_SEQ_CST); }
DEV void acq_fence() {}
DEV void drain_stores() {}
typedef unsigned* ctr_ptr;
#else
DEV void wt_store64(void* p, unsigned long long v) { __hip_atomic_store((__attribute__((address_space(1))) unsigned long long*)p, v, __ATOMIC_RELAXED, __HIP_MEMORY_SCOPE_AGENT); }
typedef __attribute__((address_space(1))) unsigned* ctr_ptr;
DEV unsigned ctr_add(ctr_ptr p, unsigned v) { return __hip_atomic_fetch_add(p, v, __ATOMIC_RELAXED, __HIP_MEMORY_SCOPE_AGENT); }
DEV void acq_fence() { __builtin_amdgcn_fence(__ATOMIC_ACQUIRE, "agent"); }
DEV void drain_stores() { asm volatile("s_waitcnt vmcnt(0)" ::: "memory"); }
#endif
struct EpiCmpPart { float* P;
    MDEV void operator()(f32x4 (&acc)[4][4], int mw, int nw, int h, int c) const {
        if (nw != 0) return;
        const int idx = mw + 16 * h + c;
#pragma unroll
        for (int ni = 0; ni < 4; ++ni)
#pragma unroll
            for (int mi = 0; mi < 4; ++mi) { float* p = P + ((size_t)(ni * 4 + mi) * 256 + idx) * 4;
                const u32x4 u = __builtin_bit_cast(u32x4, acc[ni][mi]);
#ifdef EMU
                wt_store64(p, (unsigned long long)u[0] | ((unsigned long long)u[1] << 32));
                wt_store64(p + 2, (unsigned long long)u[2] | ((unsigned long long)u[3] << 32)); }
#else
                asm volatile("global_store_dwordx4 %0, %1, off sc1\n\ts_nop 2" :: "v"((__attribute__((address_space(1))) float*)p), "v"(u) : "memory"); }
#endif
    }
};
DEV void cmp_split_item(const Args& a, unsigned char* smem, int li, int item, ctr_ptr tilec) {
    constexpr int TMC = (NCP + 255) / 256, S = CMP_SPLIT, KP = 2048 / S;
    unsigned char* ws = wsp(a);
    const int tile = item / S, sp = item % S;
    const int kv = tile / (4 * TMC), bg = (tile / TMC) % 4, tm = tile % TMC;
    const bf16* src = (const bf16*)(ws + (kv ? WS_VCG : WS_KCG)) + (size_t)bg * SEQ * 64;
    struct AF { const bf16* base; int m0; MDEV unsigned off(int r) const { int n = m0 + r; if (n > NCMP - 1) n = NCMP - 1; return (unsigned)n * 1024u; } } af{src + sp * KP, tm * 256};
    float* Pt = (float*)(ws + WS_CMPP) + (size_t)tile * S * 16 * 256 * 4;
    EpiCmpPart E{Pt + (size_t)sp * 16 * 256 * 4};
    BClamp64 bf{INP(a, kv ? I_CWV : I_CWK) + (size_t)li * 2048 * 64 + (size_t)sp * KP * 64};
    gemm_tile2(smem, af, bf, 64, KP, E);
    drain_stores(); SYNC();
    int* fl = (int*)(smem + LDS_BYTES - 128);
    if (TID == 0) fl[0] = (int)ctr_add(tilec + tile, 1u);
    SYNC();
    if (fl[0] == S - 1) {
        acq_fence();
        const int tid = TID, w = tid >> 6, l = tid & 63, h = l >> 4, c = l & 15, wm = w >> 1, wn = w & 1;
        f32x4 acc[4][4];
#pragma unroll
        for (int i = 0; i < 4; ++i)
#pragma unroll
            for (int j = 0; j < 4; ++j) acc[i][j] = f4zero();
        if (wn == 0) { const int idx = wm * 64 + l;
#pragma unroll 1
            for (int s2 = 0; s2 < S; ++s2) { const float* P = Pt + (size_t)s2 * 16 * 256 * 4;
#pragma unroll
                for (int q = 0; q < 16; ++q) { const f32x4 v = *(const f32x4*)(P + ((size_t)q * 256 + idx) * 4);
#pragma unroll
                    for (int r = 0; r < 4; ++r) acc[q >> 2][q & 3][r] += v[r]; } } }
        EpiCmp E2{&a, kv, bg, tm * 256, li};
        E2(acc, wm * 64, wn * 64, h, c);
    }
    SYNC();
}
DEV void moe_gemm_phase8(const Args& a, unsigned char* smem, int l, int mode) {
    unsigned char* ws = wsp(a); const int* cnt = (const int*)(ws + WS_CNT) + l * 32 * 64;
    int* rb = (int*)(smem + 140 * 1024);
    moe_bases(cnt, rb);
    const int mrows = rb[32];
    if (mode == 0) {
        pg8::Gemm g{(const bf16*)(ws + WS_H), (const bf16*)(ws + WS_W13) + (size_t)l * 32 * 2 * FF * DM, mrows, 2 * FF, DM}; pg8::StaticOrder S; S.init(mrows, 2 * FF, NBLK, BID);
        EpiMoe1_8 E{(bf16*)(ws + WS_ACT)}; MoeSel<true> X{rb, cnt, (const int*)(ws + WS_LIST), (size_t)2 * FF * DM * 2};
        SYNC(); pg8::gemm_phase<EpiMoe1_8, pg8::StaticOrder, true, true, MoeSel<true>>(PG8_LDS(smem), g, S, E, X); SYNC();
    } else {
        pg8::Gemm g{(const bf16*)(ws + WS_ACT), (const bf16*)(ws + WS_W2) + (size_t)l * 32 * DM * FF, mrows, DM, FF}; pg8::StaticOrder S; S.init(mrows, DM, NBLK, BID);
        EpiMoe2_8 E{(bf16*)(ws + WS_YK)}; MoeSel<false> X{rb, cnt, (const int*)(ws + WS_LIST), (size_t)DM * FF * 2};
        SYNC(); pg8::gemm_phase<EpiMoe2_8, pg8::StaticOrder, true, true, MoeSel<false>>(PG8_LDS(smem), g, S, E, X); SYNC();
    }
}
#ifndef EMU
constexpr int MOE_TMO_IDX = 128;
struct MoeOrder { int nN, t0, nu, j, nper, nA; bool rev;
    __device__ __forceinline__ void init(int ntile, int nN_, int nblk, int bid, bool rev_) { nN = nN_; nper = nblk / 8; rev = rev_; const int x = bid % 8; j = bid / 8;
        t0 = x * ntile / 8; nu = ((x + 1) * ntile / 8 - t0) * nN; if (bid >= 8 * nper) nu = 0;
        nA = nu - 2 * nper; nA = nA < 0 ? 0 : (nA > nper / 2 ? nper / 2 : nA); }
    __device__ __forceinline__ bool next(int i, pg8::Unit& u) const { int p;
        if (!rev) p = i * nper + j;
        else if (j < nA) { if (i > 0) return false; p = nu - nA + j; }
        else { p = i * (nper - nA) + (j - nA); if (p >= nu - nA) return false; }
        if (p >= nu) return false; u.pm = t0 + p / nN; u.pn = p % nN; return true; }
    __device__ __forceinline__ void a_ready(const pg8::Unit&) const {}
    __device__ __forceinline__ void done(const pg8::Unit&) const {}
};
struct MoeProd : MoeOrder { unsigned* flg;
    __device__ __forceinline__ void done(const pg8::Unit& u) const {
        asm volatile("s_waitcnt vmcnt(0)" ::: "memory"); __builtin_amdgcn_s_barrier(); asm volatile("" ::: "memory");
        if (TID == 0) (void)__hip_atomic_fetch_add((__attribute__((address_space(1))) unsigned*)(flg + u.pm * 16), 1u, __ATOMIC_RELAXED, __HIP_MEMORY_SCOPE_AGENT); } };
struct MoeCons : MoeOrder { unsigned* flg; unsigned* tmo;
    __device__ __forceinline__ void a_ready(const pg8::Unit& u) const {
        if ((TID >> 6) == 0) { unsigned sp = 0u; __attribute__((address_space(1))) unsigned* f = (__attribute__((address_space(1))) unsigned*)(flg + u.pm * 16);
            while ((unsigned)__builtin_amdgcn_readfirstlane((int)__hip_atomic_load(f, __ATOMIC_RELAXED, __HIP_MEMORY_SCOPE_AGENT)) < (unsigned)(2 * FF / 256)) {
                __builtin_amdgcn_s_sleep(1);
                if ((++sp & 255u) == 0u) { if (__hip_atomic_load((__attribute__((address_space(1))) unsigned*)tmo, __ATOMIC_RELAXED, __HIP_MEMORY_SCOPE_AGENT)) break;
                    if (sp > (1u << 22)) { (void)__hip_atomic_fetch_add((__attribute__((address_space(1))) unsigned*)tmo, 1u, __ATOMIC_RELAXED, __HIP_MEMORY_SCOPE_AGENT); break; } } }
            __builtin_amdgcn_fence(__ATOMIC_ACQUIRE, "agent"); }
        asm volatile("" ::: "memory"); __builtin_amdgcn_s_barrier(); asm volatile("" ::: "memory"); } };
DEV void moe_fused_phase(const Args& a, unsigned char* smem, int l) {
    unsigned char* ws = wsp(a); const int* cnt = (const int*)(ws + WS_CNT) + l * 32 * 64;
    int* rb = (int*)(smem + 140 * 1024);
    moe_bases(cnt, rb);
    const int mrows = rb[32]; unsigned* flg = (unsigned*)(ws + WS_FLG) + (size_t)l * 256 * 16;
    int* te = rb + 64;
    for (int t = TID; t < (mrows >> 8); t += NT) { int e = 0;
#pragma unroll 1
        for (int q = 1; q < 32; ++q) if ((rb[q] >> 8) <= t) e = q;
        te[t] = e; }
    SYNC();
    { pg8::Gemm g{(const bf16*)(ws + WS_H), (const bf16*)(ws + WS_W13) + (size_t)l * 32 * 2 * FF * DM, mrows, 2 * FF, DM}; MoeProd S; S.init(mrows >> 8, 2 * FF / 256, NBLK, BID, false); S.flg = flg;
      EpiMoe1_8 E{(bf16*)(ws + WS_ACT)}; MoeSel<true> X{rb, cnt, (const int*)(ws + WS_LIST), (size_t)2 * FF * DM * 2, te};
      SYNC(); pg8::gemm_phase<EpiMoe1_8, MoeProd, true, true, MoeSel<true>>(PG8_LDS(smem), g, S, E, X); }
    { pg8::Gemm g{(const bf16*)(ws + WS_ACT), (const bf16*)(ws + WS_W2) + (size_t)l * 32 * DM * FF, mrows, DM, FF}; MoeCons S; S.init(mrows >> 8, DM / 256, NBLK, BID, true); S.flg = flg; S.tmo = (unsigned*)(ws + WS_BAR) + MOE_TMO_IDX;
      EpiMoe2_8 E{(bf16*)(ws + WS_YK)}; MoeSel<false> X{rb, cnt, (const int*)(ws + WS_LIST), (size_t)DM * FF * 2, te};
      SYNC(); pg8::gemm_phase<EpiMoe2_8, MoeCons, true, true, MoeSel<false>>(PG8_LDS(smem), g, S, E, X); SYNC(); }
}
#endif
DEV void moe_gemm_phase(const Args& a, unsigned char* smem, int l, int mode) {
    unsigned char* ws = wsp(a); const int* cnt = (const int*)(ws + WS_CNT) + l * 32 * 64;
    int* rb = (int*)(smem + GEMM2_LDS);
    moe_bases(cnt, rb);
    const int ntile = rb[32] >> 8;
    constexpr int TN1 = 2 * FF / 128, TN2 = DM / 128;
    const int TN = mode == 0 ? TN1 : TN2;
    const int* list = (const int*)(ws + WS_LIST);
    for (int it = vbid(); it < ntile * TN; it += NBLK) {
        const int rt = it / TN, tn = it % TN; int e = 0;
#pragma unroll 1
        for (int q = 1; q < 32; ++q) if ((rb[q] >> 8) <= rt) e = q;
        const int rloc = (rt << 8) - rb[e], ce = cnt[e * 64], nvalid = (ce - rloc) < 256 ? (ce - rloc) : 256;
        if (mode == 0) {
            struct AF { const bf16* base; const int* lst; int nv; MDEV unsigned off(int r) const { const int rr = r < nv ? r : nv - 1; return (unsigned)lst[rr] * (unsigned)DM; } }
                af{(const bf16*)(ws + WS_H), list + (size_t)e * T + rloc, nvalid};
            EpiGated<1> E{(bf16*)(ws + WS_ACT), (size_t)FF, rt << 8, tn * 128, nvalid};
            BInter bf{INP(a, I_W1) + (size_t)(l * 32 + e) * DM * FF, INP(a, I_W3) + (size_t)(l * 32 + e) * DM * FF, tn * 128};
            gemm_tile2(smem, af, bf, FF, DM, E);
        } else {
            ARows af{(const bf16*)(ws + WS_ACT) + (size_t)(rt << 8) * FF, (size_t)FF};
            EpiStoreBf E{(bf16*)(ws + WS_YK), (size_t)DM, rt << 8, tn * 128, nvalid};
            BPlain bf{INP(a, I_W2) + (size_t)(l * 32 + e) * FF * DM + tn * 128};
            gemm_tile2(smem, af, bf, DM, FF, E);
        }
    }
}

constexpr int LDV = 80;
constexpr int AT_K = 0, AT_V = 2 * 64 * LDT * 2, AT_IMP = AT_V + 2 * 64 * LDV * 2, AT_SEL = AT_IMP + 8 * 8 * 128 * 4, AT_GSEL = AT_SEL + 8 * 8 * 4 * 4, AT_OUT = AT_GSEL + 8 * 2 * 4 * 4, AT_END = AT_OUT + 8 * 32 * 64 * 4;
#ifdef EMU
DEV float rexp2(float x) { return exp2f(x); }
DEV unsigned uni(unsigned x) { return x; }
#else
DEV float rexp2(float x) { return __builtin_amdgcn_exp2f(x); }
DEV unsigned uni(unsigned x) { return (unsigned)__builtin_amdgcn_readfirstlane((int)x); }
#endif
DEV int krow_lds(int kappa) { return 16 * (2 * (kappa >> 5) + ((kappa >> 2) & 1)) + 4 * ((kappa >> 3) & 3) + (kappa & 3); }
template <int MASK, bool FULL, int GM>
DEV void attn_block(const bf16* Kp, const bf16* Vp, const bf16x8 (&qf)[2][2], int j, const int (&s)[2], const bool (&selbit)[2], float C2, int h, int c,
                    f32x4 (&O)[2][4], f32x4 (&Ol)[2]) {
    f32x4 st[2][2][2];
#pragma unroll
    for (int sp = 0; sp < 2; ++sp)
#pragma unroll
        for (int u = 0; u < 2; ++u) {
#pragma unroll
            for (int G = 0; G < 2; ++G) { st[G][sp][u][0] = -C2; st[G][sp][u][1] = -C2; st[G][sp][u][2] = -C2; st[G][sp][u][3] = -C2; }
#pragma unroll
            for (int ks = 0; ks < 2; ++ks) { const bf16x8 kf = *(const bf16x8*)(Kp + (16 * (2 * sp + u) + c) * LDT + 32 * ks + 8 * h);
#pragma unroll
                for (int G = 0; G < 2; ++G) if (GM & (1 << G)) st[G][sp][u] = mfma16(kf, qf[G][ks], st[G][sp][u]); } }
#pragma unroll
    for (int G = 0; G < 2; ++G) if (GM & (1 << G))
#pragma unroll
        for (int sp = 0; sp < 2; ++sp)
#pragma unroll
            for (int u = 0; u < 2; ++u)
#pragma unroll
                for (int r = 0; r < 4; ++r) { bool ok = selbit[G];
                    if (!FULL) { const int key = 64 * j + 32 * sp + 8 * h + 4 * u + r;
                        if (MASK == 0) ok = 16 * key + 31 <= s[G]; else if (MASK == 1) ok = selbit[G] && key <= s[G]; else ok = key <= s[G] && key > s[G] - 512; }
                    st[G][sp][u][r] = ok ? rexp2(st[G][sp][u][r]) : 0.f; }
    bf16x8 pb[2][2], ones;
#pragma unroll
    for (int q = 0; q < 8; ++q) ones[q] = (short)0x3F80;
#pragma unroll
    for (int G = 0; G < 2; ++G) if (GM & (1 << G))
#pragma unroll
        for (int sp = 0; sp < 2; ++sp) { pb[G][sp] = pack8(st[G][sp][0], st[G][sp][1]); Ol[G] = mfma16(ones, pb[G][sp], Ol[G]); }
    const bf16* Vb = Vp + bperm(8 * h + (c >> 2)) * LDV + 4 * (c & 3);
#pragma unroll
    for (int et = 0; et < 4; ++et)
#pragma unroll
        for (int sp = 0; sp < 2; ++sp) { const bf16x8 vf = tr_read8(Vb + (32 * sp) * LDV + 16 * et, Vb + (32 * sp + 8) * LDV + 16 * et);
#pragma unroll
            for (int G = 0; G < 2; ++G) if (GM & (1 << G)) O[G][et] = mfma16(vf, pb[G][sp], O[G][et]); }
}

struct ImpState { float invq[2][4]; float carry[2]; float* imps; int tl, hd, l, s0, qblk; };
DEV void imp_block(const bf16* Kp, const bf16x8 (&qf)[2][2], int j, int s0, int w, float C2, int h, int c, ImpState& im) {
#pragma unroll
    for (int kt = 0; kt < 4; ++kt) {
        const int row = krow_lds(16 * kt + c);
        const bf16x8 k0 = *(const bf16x8*)(Kp + row * LDT + 8 * h), k1 = *(const bf16x8*)(Kp + row * LDT + 32 + 8 * h);
        const int n = 64 * j + 16 * kt + c;
#pragma unroll
        for (int G = 0; G < 2; ++G) {
            f32x4 acc; acc[0] = -C2; acc[1] = -C2; acc[2] = -C2; acc[3] = -C2;
            acc = mfma16(qf[G][0], k0, acc); acc = mfma16(qf[G][1], k1, acc);
            const bool ok = 16 * n + 31 <= s0 + 8 * w + 4 * G + h;
            float imp = 0.f;
#pragma unroll
            for (int r = 0; r < 4; ++r) imp += ok ? rexp2(acc[r]) * im.invq[G][r] : 0.f;
            const float v = ((c & 3) == 3) ? imp : 2.0f * imp;
            float sq = v + shflx(v, 1); sq += shflx(sq, 2);
            const float rr = dpp_ror1(imp);
            const float prev = (c == 0) ? im.carry[G] : rr;
            im.carry[G] = rr;
            const int m = n >> 2;
            if ((c & 3) == 0 && m < 128) im.imps[(G * 4 + h) * 128 + m] = sq + prev;
        }
    }
}

template <int MODE>
DEV void attn_branch(bf16* Kl, bf16* Vl, const bf16* kbase, const bf16* vbase, int jlo, int jhi,
                     const bf16x8 (&qf)[2][2], const int (&s)[2], const unsigned* selm, const unsigned* gselm, float C2, int w, int h, int c, int srow, int scol,
                     f32x4 (&O)[2][4], f32x4 (&Ol)[2], ImpState& im) {
    constexpr bool PV = MODE != 1; constexpr int MASK = MODE <= 1 ? 0 : MODE - 1;
    const int krow = krow_lds(srow) * LDT + scol, vrow = bperm(srow) * LDV + scol;
    bf16x8 rk[3], rv[3];
    { const bf16x8 k0 = *(const bf16x8*)(kbase + (size_t)jlo * 4096); *(bf16x8*)(Kl + krow) = k0;
      if (PV) { const bf16x8 v0 = *(const bf16x8*)(vbase + (size_t)jlo * 4096); *(bf16x8*)(Vl + vrow) = v0; } }
#pragma unroll
    for (int u = 0; u < 3; ++u) { int jj = jlo + 1 + u; if (jj > jhi) jj = jhi; rk[(1 + u) % 3] = *(const bf16x8*)(kbase + (size_t)jj * 4096); if (PV) rv[(1 + u) % 3] = *(const bf16x8*)(vbase + (size_t)jj * 4096); }
    SYNC();
    for (int jb = jlo; jb <= jhi; jb += 3) {
#pragma unroll
        for (int u = 0; u < 3; ++u) { const int j = jb + u;
            if (j <= jhi) {
                const int cur = (j - jlo) & 1;
                const bf16* Kc = Kl + cur * 64 * LDT; const bf16* Vc = Vl + cur * 64 * LDV;
                if (MODE == 1) imp_block(Kc, qf, j, im.s0, w, C2, h, c, im);
                else {
                    bool sb[2] = {true, true}; unsigned gm = 3u;
                    if (MODE == 2) { gm = 0u;
#pragma unroll
                        for (int G = 0; G < 2; ++G) { const unsigned wq = uni(gselm[G * 4 + (j >> 5)]), mq = selm[(G * 4 + im.tl) * 4 + (j >> 5)];
                            gm |= ((wq >> (j & 31)) & 1u) << G; sb[G] = (mq >> (j & 31)) & 1u; } }
                    bool full;
                    if (MODE == 0) full = 1024 * j + 1039 <= im.s0; else if (MODE == 2) full = j < im.qblk; else full = (j < im.qblk) && (64 * j > im.s0 + 63 - 512);
                    if (MODE == 2) {
                        if (full) { if (gm == 3u) attn_block<MASK, true, 3>(Kc, Vc, qf, j, s, sb, C2, h, c, O, Ol); else if (gm == 1u) attn_block<MASK, true, 1>(Kc, Vc, qf, j, s, sb, C2, h, c, O, Ol); else if (gm == 2u) attn_block<MASK, true, 2>(Kc, Vc, qf, j, s, sb, C2, h, c, O, Ol); }
                        else { if (gm == 3u) attn_block<MASK, false, 3>(Kc, Vc, qf, j, s, sb, C2, h, c, O, Ol); else if (gm == 1u) attn_block<MASK, false, 1>(Kc, Vc, qf, j, s, sb, C2, h, c, O, Ol); else if (gm == 2u) attn_block<MASK, false, 2>(Kc, Vc, qf, j, s, sb, C2, h, c, O, Ol); }
                    } else { if (full) attn_block<MASK, true, 3>(Kc, Vc, qf, j, s, sb, C2, h, c, O, Ol); else attn_block<MASK, false, 3>(Kc, Vc, qf, j, s, sb, C2, h, c, O, Ol); }
                }
                if (j + 1 <= jhi) {
                    *(bf16x8*)(Kl + (cur ^ 1) * 64 * LDT + krow) = rk[(u + 1) % 3]; if (PV) *(bf16x8*)(Vl + (cur ^ 1) * 64 * LDV + vrow) = rv[(u + 1) % 3];
                    int jj = j + 4; if (jj > jhi) jj = jhi;
                    rk[(u + 1) % 3] = *(const bf16x8*)(kbase + (size_t)jj * 4096); if (PV) rv[(u + 1) % 3] = *(const bf16x8*)(vbase + (size_t)jj * 4096);
                }
                SYNC();
            }
        }
    }
}

DEV void attn_task(const Args& a, unsigned char* smem, int li, int item) {
    unsigned char* ws = wsp(a); const int tid = TID, w = tid >> 6, l = tid & 63, h = l >> 4, c = l & 15, tl = c >> 2, hd = c & 3;
    const int bg = item & 3, b = bg >> 1, g = bg & 1, tq = (SEQ / 64 - 1) - (item >> 2), s0 = tq * 64, qblk = tq;
    int s[2], row[2];
#pragma unroll
    for (int G = 0; G < 2; ++G) { s[G] = s0 + 8 * w + 4 * G + tl; row[G] = b * SEQ + s[G]; }
    bf16* Kl = (bf16*)(smem + AT_K); bf16* Vl = (bf16*)(smem + AT_V); float* imps = (float*)(smem + AT_IMP) + w * 1024; unsigned* selm = (unsigned*)(smem + AT_SEL) + w * 32;
    bf16x8 qf[2][2]; float gatec[2], gates[2], gatew[2];
#pragma unroll
    for (int G = 0; G < 2; ++G) { const bf16* qp = (const bf16*)(ws + WS_QN) + (size_t)row[G] * 512 + (g * 4 + hd) * 64 + 8 * h; qf[G][0] = *(const bf16x8*)qp; qf[G][1] = *(const bf16x8*)(qp + 32);
        const float* gp = (const float*)(ws + WS_GATE) + (size_t)row[G] * 24 + (g * 4 + hd) * 3; gatec[G] = gp[0]; gates[G] = gp[1]; gatew[G] = gp[2]; }
    const float* cs = (const float*)(ws + WS_CS) + li * 4;
    const int srow = tid >> 3, scol = (tid & 7) * 8;
    for (int i = l; i < 1024; i += 64) imps[i] = 0.f;
    SYNC();
    unsigned* gselm = (unsigned*)(smem + AT_GSEL) + w * 8; float* outl = (float*)(smem + AT_OUT) + w * 2048 + l;
    ImpState im{{{0.f, 0.f, 0.f, 0.f}, {0.f, 0.f, 0.f, 0.f}}, {0.f, 0.f}, imps, tl, hd, l, s0, qblk};
    {
        const int ncv = s0 / 16 + 3, ncb0 = (ncv + 63) >> 6, ncb = ncb0 > NCP / 64 ? NCP / 64 : ncb0;
        const bf16* kcb = (const bf16*)(ws + WS_KC) + (size_t)bg * NCP * 64 + tid * 8;
        const bf16* vcb = (const bf16*)(ws + WS_VCT) + (size_t)bg * NCP * 64 + tid * 8;
        f32x4 O[2][4], Ol[2] = {f4zero(), f4zero()};
#pragma unroll
        for (int G = 0; G < 2; ++G)
#pragma unroll
            for (int et = 0; et < 4; ++et) O[G][et] = f4zero();
        attn_branch<0>(Kl, Vl, kcb, vcb, 0, ncb - 1, qf, s, selm, gselm, cs[0], w, h, c, srow, scol, O, Ol, im);
#pragma unroll
        for (int G = 0; G < 2; ++G) { const float lsum = Ol[G][0]; const float invl = lsum > 0.f ? 1.0f / lsum : 0.f;
#pragma unroll
            for (int r = 0; r < 4; ++r) im.invq[G][r] = shfl(invl, 4 * h + r);
#pragma unroll
            for (int et = 0; et < 4; ++et)
#pragma unroll
                for (int r = 0; r < 4; ++r) outl[((G * 4 + et) * 4 + r) * 64] = gatec[G] * invl * O[G][et][r]; }
        f32x4 ld[2] = {f4zero(), f4zero()};
        attn_branch<1>(Kl, Vl, kcb, vcb, 0, ncb - 1, qf, s, selm, gselm, cs[0], w, h, c, srow, scol, O, ld, im);
    }
    WSYNC();
#pragma unroll 1
    for (int G = 0; G < 2; ++G) {
        const int tk = l >> 4, i = l & 15; float vals[8];
#pragma unroll
        for (int mm = 0; mm < 8; ++mm) { const int jj = i + 16 * mm; vals[mm] = jj > qblk ? NEGV : ((jj == 0 || jj == qblk || jj == qblk - 1) ? FORCEV : imps[(G * 4 + tk) * 128 + jj]); }
        unsigned mk[4] = {0u, 0u, 0u, 0u};
#pragma unroll 1
        for (int rnd = 0; rnd < 16; ++rnd) {
            float best = vals[0]; int bj = i;
#pragma unroll
            for (int mm = 1; mm < 8; ++mm) if (vals[mm] > best) { best = vals[mm]; bj = i + 16 * mm; }
#pragma unroll
            for (int o = 1; o < 16; o <<= 1) { const float ov = shflx(best, o); const int oj = shflxi(bj, o); if (ov > best || (ov == best && oj < bj)) { best = ov; bj = oj; } }
            if (best > NEGV * 0.5f) {
#pragma unroll
                for (int q = 0; q < 4; ++q) if ((bj >> 5) == q) mk[q] |= 1u << (bj & 31); }
            if ((bj & 15) == i) {
#pragma unroll
                for (int mm = 0; mm < 8; ++mm) if ((bj >> 4) == mm) vals[mm] = -3e38f; }
        }
        if (i == 0) {
#pragma unroll
            for (int q = 0; q < 4; ++q) selm[(G * 4 + tk) * 4 + q] = mk[q]; }
    }
    WSYNC();
    if (l < 8) { const int G = l >> 2, q = l & 3; gselm[l] = selm[(G * 4 + 0) * 4 + q] | selm[(G * 4 + 1) * 4 + q] | selm[(G * 4 + 2) * 4 + q] | selm[(G * 4 + 3) * 4 + q]; }
    WSYNC();
#pragma unroll
    for (int br = 0; br < 2; ++br) {
        const bf16* kb = (const bf16*)(ws + (br == 0 ? WS_KS : WS_KW)) + (size_t)bg * SEQ * 64 + tid * 8; const bf16* vb = (const bf16*)(ws + (br == 0 ? WS_VST : WS_VWT)) + (size_t)bg * SEQ * 64 + tid * 8;
        f32x4 O[2][4], Ol[2] = {f4zero(), f4zero()};
#pragma unroll
        for (int G = 0; G < 2; ++G)
#pragma unroll
            for (int et = 0; et < 4; ++et) O[G][et] = f4zero();
        if (br == 0) attn_branch<2>(Kl, Vl, kb, vb, 0, qblk, qf, s, selm, gselm, cs[1], w, h, c, srow, scol, O, Ol, im);
        else attn_branch<3>(Kl, Vl, kb, vb, s0 >= 511 ? (s0 - 511) >> 6 : 0, qblk, qf, s, selm, gselm, cs[2], w, h, c, srow, scol, O, Ol, im);
#pragma unroll
        for (int G = 0; G < 2; ++G) { const float lsum = Ol[G][0]; const float sc = (br == 0 ? gates[G] : gatew[G]) * (lsum > 0.f ? 1.0f / lsum : 0.f);
#pragma unroll
            for (int et = 0; et < 4; ++et)
#pragma unroll
                for (int r = 0; r < 4; ++r) outl[((G * 4 + et) * 4 + r) * 64] += sc * O[G][et][r]; }
    }
#pragma unroll
    for (int G = 0; G < 2; ++G) { bf16* dst = (bf16*)(ws + WS_CAT) + (size_t)row[G] * 1024 + (g * 4 + hd) * 64 + 4 * h;
#pragma unroll
        for (int et = 0; et < 4; ++et) { f32x4 o;
#pragma unroll
            for (int r = 0; r < 4; ++r) o[r] = outl[((G * 4 + et) * 4 + r) * 64];
            st_bf4(dst + 16 * et, o); } }
}

constexpr int LDH = 136;
DEV void hg_cumsum(const float* fsrc  , float* segs  , int d, int seg, float (&f)[16], float (&bc)[16], float& bend, float& bmid) {
    float run = 0.f;
#pragma unroll
    for (int i = 0; i < 16; ++i) { f[i] = fsrc[(size_t)(16 * seg + i) * 128 + d]; run += log2f(f[i]); bc[i] = run; }
    SYNC();
    segs[seg * 128 + d] = run;
    SYNC();
    const float s0 = segs[d], s1 = segs[128 + d], s2 = segs[256 + d], s3 = segs[384 + d];
    const float off = seg == 0 ? 0.f : (seg == 1 ? s0 : (seg == 2 ? s0 + s1 : s0 + s1 + s2));
#pragma unroll
    for (int i = 0; i < 16; ++i) bc[i] += off;
    bend = s0 + s1 + s2 + s3; bmid = s0 + s1;
}
DEV void hg_write16(bf16* dstrow  , const float (&v)[16]) {
    u32x4 w0, w1;
#pragma unroll
    for (int q = 0; q < 4; ++q) { w0[q] = pk2(v[2 * q], v[2 * q + 1]); w1[q] = pk2(v[8 + 2 * q], v[8 + 2 * q + 1]); }
    *(u32x4*)dstrow = w0; *(u32x4*)(dstrow + 8) = w1;
}
DEV void hg_h1_task(const Args& a, unsigned char* smem, int task) {
    unsigned char* ws = wsp(a); const int tid = TID, w = tid >> 6, l = tid & 63, h = l >> 4, c = l & 15, d = tid & 127, seg = tid >> 7;
    const int bh = task / NCH, ch = task % NCH;
    bf16* kT = (bf16*)smem; bf16* vT = kT + 128 * LDT; float* segs = (float*)(vT + 128 * LDT);
    const size_t tokb = (size_t)bh * SEQ + ch * 64;
    float f[16], bc[16], bend, bmid;
    const bf16* vs = (const bf16*)(ws + WS_HV) + tokb * 128;
    bf16 vraw[16];
#pragma unroll
    for (int i = 0; i < 16; ++i) vraw[i] = vs[(size_t)(16 * seg + i) * 128 + d];
    hg_cumsum((const float*)(ws + WS_HF) + tokb * 128, segs, d, seg, f, bc, bend, bmid);
    float kv[16];
#pragma unroll
    for (int i = 0; i < 16; ++i) kv[i] = (1.0f - f[i]) * fexp2(bend - bc[i]);
    hg_write16(kT + d * LDT + 16 * seg, kv);
#pragma unroll
    for (int i = 0; i < 16; ++i) kv[i] = bf2f(vraw[i]);
    hg_write16(vT + d * LDT + 16 * seg, kv);
    if (seg == 0) ((float*)(ws + WS_GD))[((size_t)bh * NCH + ch) * 128 + d] = fexp2(bend);
    SYNC();
    f32x4 acc[8];
#pragma unroll
    for (int et = 0; et < 8; ++et) acc[et] = f4zero();
#pragma unroll
    for (int ks = 0; ks < 2; ++ks) { const bf16x8 fa = *(const bf16x8*)(kT + (16 * w + c) * LDT + 32 * ks + 8 * h);
#pragma unroll
        for (int et = 0; et < 8; ++et) acc[et] = mfma16(fa, *(const bf16x8*)(vT + (16 * et + c) * LDT + 32 * ks + 8 * h), acc[et]); }
    float* ut = (float*)(ws + WS_UT) + ((size_t)bh * NCH + ch) * 16384;
#pragma unroll
    for (int et = 0; et < 8; ++et) *(f32x4*)(ut + (size_t)(16 * et + c) * 128 + 16 * w + 4 * h) = acc[et];
    SYNC();
}
DEV void hg_scan_task(const Args& a, int sc) {
    unsigned char* ws = wsp(a); const int bh = sc >> 3, q = (sc & 7) * 512 + TID, e = q >> 5, d0 = (q & 31) * 4;
    const float* ut = (const float*)(ws + WS_UT) + (size_t)bh * NCH * 16384 + (size_t)e * 128 + d0;
    const float* gd = (const float*)(ws + WS_GD) + (size_t)bh * NCH * 128 + d0;
    bf16* st = (bf16*)(ws + WS_ST) + (size_t)bh * NCH * 16384 + (size_t)e * 128 + d0;
    f32x4 S = f4zero();
    constexpr int SB = 8; static_assert(NCH % (2 * SB) == 0, "scan batches");
    f32x4 gb[2][SB], ub[2][SB];
#pragma unroll
    for (int i = 0; i < SB; ++i) { gb[0][i] = *(const f32x4*)(gd + (size_t)i * 128); ub[0][i] = *(const f32x4*)(ut + (size_t)i * 16384); }
#pragma unroll 1
    for (int cb = 0; cb < NCH; cb += 2 * SB) {
#pragma unroll
        for (int hb = 0; hb < 2; ++hb) { const int c0 = cb + hb * SB;
            if (c0 + SB < NCH) {
#pragma unroll
                for (int i = 0; i < SB; ++i) { gb[hb ^ 1][i] = *(const f32x4*)(gd + (size_t)(c0 + SB + i) * 128); ub[hb ^ 1][i] = *(const f32x4*)(ut + (size_t)(c0 + SB + i) * 16384); } }
#pragma unroll
            for (int i = 0; i < SB; ++i) { st_bf4(st + (size_t)(c0 + i) * 16384, S);
#pragma unroll
                for (int r = 0; r < 4; ++r) S[r] = gb[hb][i][r] * S[r] + ub[hb][i][r]; } }
    }
}
DEV void hg_h3_task(const Args& a, unsigned char* smem, int li, int task) {
    unsigned char* ws = wsp(a); const int tid = TID, w = tid >> 6, l = tid & 63, h = l >> 4, c = l & 15, d = tid & 127, seg = tid >> 7;
    const int bh = task / NCH, ch = task % NCH, b = bh >> 2, hh = bh & 3;
    bf16* At = (bf16*)smem; bf16* Bt = At + 64 * LDH; bf16* Qt = Bt + 64 * LDH; bf16* vT = Qt + 64 * LDH; float* segs = (float*)(vT + 128 * LDT); float* part = segs + 512;
    const size_t tokb = (size_t)bh * SEQ + ch * 64;
    float f[16], bc[16], bend, bmid;
    const bf16* qs = (const bf16*)(ws + WS_HQ) + tokb * 128; const bf16* vs = (const bf16*)(ws + WS_HV) + tokb * 128;
    const int tt = w & 3, eh = w >> 2;
    bf16 qraw[16], vraw[16];
#pragma unroll
    for (int i = 0; i < 16; ++i) { const int t = 16 * seg + i; qraw[i] = qs[(size_t)t * 128 + d]; vraw[i] = vs[(size_t)t * 128 + d]; }
    const bf16* stp = (const bf16*)(ws + WS_ST) + ((size_t)bh * NCH + ch) * 16384;
    bf16x8 stf[4][4];
#pragma unroll
    for (int ks = 0; ks < 4; ++ks)
#pragma unroll
        for (int et = 0; et < 4; ++et) stf[ks][et] = *(const bf16x8*)(stp + (size_t)(64 * eh + 16 * et + c) * 128 + 32 * ks + 8 * h);
    const int tok = b * SEQ + ch * 64 + 16 * tt + c;
    const bf16* hg = (const bf16*)(ws + WS_HGS) + (size_t)tok * 512 + hh * 128;
    u32x2 hgv[4];
#pragma unroll
    for (int et = 0; et < 4; ++et) hgv[et] = *(const u32x2*)(hg + 64 * eh + 16 * et + 4 * h);
    hg_cumsum((const float*)(ws + WS_HF) + tokb * 128, segs, d, seg, f, bc, bend, bmid);
    float vv[16];
#pragma unroll
    for (int i = 0; i < 16; ++i) { const int t = 16 * seg + i; const float q = bf2f(qraw[i]);
        At[t * LDH + d] = (bf16)f2bf(q * fexp2(bc[i] - bmid)); Bt[t * LDH + d] = (bf16)f2bf((1.0f - f[i]) * fexp2(bmid - bc[i])); Qt[t * LDH + d] = (bf16)f2bf(q * fexp2(bc[i]));
        vv[i] = bf2f(vraw[i]); }
    hg_write16(vT + d * LDT + 16 * seg, vv);
    SYNC();
    f32x4 O[4];
#pragma unroll
    for (int et = 0; et < 4; ++et) O[et] = f4zero();
#pragma unroll
    for (int sp = 0; sp < 2; ++sp) {
        if (32 * sp > 16 * tt + 15) continue;
        f32x4 st[2];
#pragma unroll
        for (int u = 0; u < 2; ++u) { st[u] = f4zero(); const int krow = 32 * sp + 8 * (c >> 2) + 4 * u + (c & 3);
#pragma unroll
            for (int ks = 0; ks < 4; ++ks) st[u] = mfma16(*(const bf16x8*)(Bt + krow * LDH + 32 * ks + 8 * h), *(const bf16x8*)(At + (16 * tt + c) * LDH + 32 * ks + 8 * h), st[u]);
#pragma unroll
            for (int r = 0; r < 4; ++r) { const int sk = 32 * sp + 8 * h + 4 * u + r; if (sk > 16 * tt + c) st[u][r] = 0.f; } }
        const bf16x8 pb = pack8(st[0], st[1]);
#pragma unroll
        for (int et = 0; et < 4; ++et) O[et] = mfma16(*(const bf16x8*)(vT + (64 * eh + 16 * et + c) * LDT + 32 * sp + 8 * h), pb, O[et]);
    }
#pragma unroll
    for (int ks = 0; ks < 4; ++ks) { const bf16x8 fq = *(const bf16x8*)(Qt + (16 * tt + c) * LDH + 32 * ks + 8 * h);
#pragma unroll
        for (int et = 0; et < 4; ++et) O[et] = mfma16(stf[ks][et], fq, O[et]); }
    float ss = 0.f;
#pragma unroll
    for (int et = 0; et < 4; ++et)
#pragma unroll
        for (int r = 0; r < 4; ++r) ss += O[et][r] * O[et][r];
    ss += shflx(ss, 16); ss += shflx(ss, 32);
    if (h == 0) part[eh * 64 + 16 * tt + c] = ss;
    SYNC();
    const float rs = frsq((part[16 * tt + c] + part[64 + 16 * tt + c]) * (1.0f / 128.0f) + EPS);
    const float* og = INP(a, I_OG) + li * 128;
    bf16* dst = (bf16*)(ws + WS_CAT) + (size_t)tok * 1024 + 512 + hh * 128;
#pragma unroll
    for (int et = 0; et < 4; ++et) { const int e = 64 * eh + 16 * et + 4 * h; f32x4 o; const f32x4 ogv = *(const f32x4*)(og + e);
        o[0] = O[et][0] * rs * ogv[0] * bf2f(hgv[et][0] & 0xffff); o[1] = O[et][1] * rs * ogv[1] * bf2f(hgv[et][0] >> 16);
        o[2] = O[et][2] * rs * ogv[2] * bf2f(hgv[et][1] & 0xffff); o[3] = O[et][3] * rs * ogv[3] * bf2f(hgv[et][1] >> 16);
        st_bf4(dst + e, o); }
    SYNC();
}

constexpr int CTS = 16;
DEV void conv_task(const Args& a, unsigned char* smem, int li, int task) {
    unsigned char* ws = wsp(a); const int tid = TID, w = tid >> 6, lane = tid & 63;
    const bool act = tid < DM / 2; const int c0 = act ? 2 * tid : 0;
    const int tb = task * 64, b = tb / SEQ, sb = tb % SEQ;
    float* red = (float*)smem;
    const float b0 = INP(a, I_DWB)[li * DM + c0], b1 = INP(a, I_DWB)[li * DM + c0 + 1];
    const float g0 = INP(a, I_LNG)[li * DM + c0], g1 = INP(a, I_LNG)[li * DM + c0 + 1], e0 = INP(a, I_LNB)[li * DM + c0], e1 = INP(a, I_LNB)[li * DM + c0 + 1];
    const bf16* glu = (const bf16*)(ws + WS_GLU) + (size_t)b * SEQ * DM + c0;
    float* lw = (float*)(smem + 4096);
    SYNC();
    for (int i = tid * 4; i < 31 * DM; i += NT * 4) *(f32x4*)(lw + i) = *(const f32x4*)(INP(a, I_DW) + (size_t)li * 31 * DM + i);
    SYNC();
    f32x2v uf[30 + CTS]; unsigned nx[CTS];
    { const bf16* gp = glu + (size_t)(sb - 30) * DM;
#pragma unroll
      for (int r = 0; r < 30; ++r) { const int si = sb + r - 30; const unsigned q = si >= 0 ? *(const unsigned*)gp : 0u; gp += DM; OPAQUE(gp); uf[r][0] = bf2f(q & 0xffff); uf[r][1] = bf2f(q >> 16); }
#pragma unroll
      for (int r = 0; r < CTS; ++r) { nx[r] = *(const unsigned*)gp; gp += DM; OPAQUE(gp); } }
#pragma unroll 1
    for (int step = 0; step < 64 / CTS; ++step) {
        const int s0 = sb + CTS * step, t0 = tb + CTS * step;
#pragma unroll
        for (int r = 0; r < CTS; ++r) { uf[30 + r][0] = bf2f(nx[r] & 0xffff); uf[30 + r][1] = bf2f(nx[r] >> 16); }
        float acc[CTS][2];
        { f32x2v ac2[CTS];
#pragma unroll
          for (int t = 0; t < CTS; ++t) { ac2[t][0] = b0; ac2[t][1] = b1; }
#pragma unroll
          for (int j = 0; j < 31; ++j) { const f32x2v w2 = *(const f32x2v*)(lw + j * DM + c0);
#ifndef EMU
              if ((j & 3) == 3) asm volatile("" ::: "memory");
#endif
#pragma unroll
              for (int t = 0; t < CTS; ++t) ac2[t] += w2 * uf[t + j]; }
#pragma unroll
          for (int t = 0; t < CTS; ++t) { acc[t][0] = ac2[t][0]; acc[t][1] = ac2[t][1]; } }
#pragma unroll
        for (int r = 0; r < 30; ++r) uf[r] = uf[r + CTS];
        if (step < 64 / CTS - 1) { const bf16* gp = glu + (size_t)(s0 + CTS) * DM;
#pragma unroll
            for (int r = 0; r < CTS; ++r) { nx[r] = *(const unsigned*)gp; gp += DM; OPAQUE(gp); } }
        { float* rb2 = red + (step & 1) * (8 * CTS * 2);
#pragma unroll
          for (int t = 0; t < CTS; ++t) { float s1 = act ? acc[t][0] + acc[t][1] : 0.f, s2 = act ? acc[t][0] * acc[t][0] + acc[t][1] * acc[t][1] : 0.f;
              s1 = wave_sum63(s1); s2 = wave_sum63(s2);
              if (lane == 63) { rb2[(w * CTS + t) * 2] = s1; rb2[(w * CTS + t) * 2 + 1] = s2; } }
          SYNC();
          if (act) {
              bf16* dst = (bf16*)(ws + WS_CAT) + (size_t)t0 * DM + c0;
#pragma unroll
              for (int t = 0; t < CTS; ++t) { float s1 = 0.f, s2 = 0.f;
#pragma unroll
                  for (int q = 0; q < 8; ++q) { s1 += rb2[(q * CTS + t) * 2]; s2 += rb2[(q * CTS + t) * 2 + 1]; }
                  const float mean = s1 * (1.0f / DM), var = fmaxf(s2 * (1.0f / DM) - mean * mean, 0.f), rstd = frsq(var + EPS);
                  const float y0 = (acc[t][0] - mean) * rstd * g0 + e0, y1 = (acc[t][1] - mean) * rstd * g1 + e1;
                  *(unsigned*)(dst + (size_t)t * DM) = pk2(siluf(y0), siluf(y1)); }
          } }
    }
}

constexpr int N_PHASES = 1 + 16 * (DEPTH / 2) + 1;
DEV void phase_decode(int ph, int& l, int& sub) {
    const int q = ph - 1, pair = q >> 4, r = q & 15;
    if (r < 9) { l = 2 * pair; sub = r; } else { l = 2 * pair + 1; const int rr = r - 9; sub = rr < 3 ? rr : rr + 2; }
}

DEV void run_phase(const Args& a, unsigned char* smem, int ph) {
#ifndef ONLY
#define ONLY -1
#endif
#define EN(k) (ONLY < 0 || ONLY == (k))
    if (ph == 0) { if (EN(100)) p0_phase(a, smem); return; }
    if (ph == N_PHASES - 1) { if (EN(0)) norm_phase(a, smem, DEPTH); return; }
    int l, sub; phase_decode(ph, l, sub); const int li = l >> 1; const bool even = (l & 1) == 0;
    unsigned char* ws = wsp(a);
    switch (sub) {
    case 0: if (EN(0)) norm_phase(a, smem, l); break;
    case 1: if (even) { if (EN(1)) inproj_phase(a, smem, li); } else { if (EN(11)) pw1_phase(a, smem, li); } break;
    case 2:
        if (even) { constexpr int NCI = 8 * ((NCP + 255) / 256); constexpr int NH1 = 8 * NCH;
#ifndef EMU
            if (NBLK > 2 * NCI * CMP_SPLIT) { const int bid = BID, NCS = NCI * CMP_SPLIT;
                if (bid < NCS) cmp_split_item(a, smem, li, bid, (ctr_ptr)((unsigned*)(ws + WS_BAR) + P0_CTR_IDX + 8 + 16 * li));
                else { for (int it = bid - NCS; it < NH1; it += NBLK - NCS) hg_h1_task(a, smem, it);
                    moe_conv_pull(a, smem, MOE_TAIL_Q); } }
#else
            if (NBLK > 2 * NCI) { const int bid = BID;
                if (bid < NCI) { if (EN(2)) cmp_phase_items(a, smem, li, bid); }
                else { for (int it = bid - NCI; it < NH1; it += NBLK - NCI) if (EN(12)) hg_h1_task(a, smem, it); } }
#endif
            else for (int it = BID; it < NCI + NH1; it += NBLK) { if (it < NCI) { if (EN(2)) cmp_phase_items(a, smem, li, it); } else { if (EN(12)) hg_h1_task(a, smem, it - NCI); } } }
        else { for (int it = BID; it < T / 64; it += NBLK) if (EN(13)) conv_task(a, smem, li, it); }
        break;
#ifdef EMU
    case 3:
        if (even) { constexpr int NA = 4 * (SEQ / 64); const int G = NBLK;
            for (int r = 0; r * G < NA; ++r) { const int it = r * G + ((r & 1) ? (G - 1 - BID) : BID); if (it < NA) { if (EN(3)) attn_task(a, smem, li, it); } }
            for (int it = BID; it < 64; it += NBLK) if (EN(14)) hg_scan_task(a, it); }
        break;
    case 4: if (even) { for (int it = BID; it < 8 * NCH; it += NBLK) if (EN(4)) hg_h3_task(a, smem, li, it); } break;
#else
    case 3:
        if (even) { constexpr int NA = 4 * (SEQ / 64); const int G = NBLK;
            typedef __attribute__((address_space(1))) unsigned gu32;
            gu32* cw = (gu32*)((unsigned*)(ws + WS_BAR) + P0_CTR_IDX + 1 + 2 * li);
            int nsc = 0;
            for (int it = BID; it < 64; it += NBLK) { hg_scan_task(a, it); ++nsc; }
            if (nsc > 0) { __builtin_amdgcn_fence(__ATOMIC_RELEASE, "agent"); asm volatile("s_waitcnt vmcnt(0)" ::: "memory"); SYNC(); if (TID == 0) (void)__hip_atomic_fetch_add(cw, (unsigned)nsc, __ATOMIC_RELAXED, __HIP_MEMORY_SCOPE_AGENT); }
            for (int r = 0; r * G < NA; ++r) { const int it = r * G + ((r & 1) ? (G - 1 - BID) : BID); if (it < NA) attn_task(a, smem, li, it); }
            if ((TID >> 6) == 0) { unsigned sp = 0u; gu32* tmo = (gu32*)((unsigned*)(ws + WS_BAR) + MOE_TMO_IDX);
                while ((unsigned)__builtin_amdgcn_readfirstlane((int)__hip_atomic_load(cw, __ATOMIC_RELAXED, __HIP_MEMORY_SCOPE_AGENT)) < 64u) {
                    __builtin_amdgcn_s_sleep(1);
                    if ((++sp & 255u) == 0u) { if (__hip_atomic_load(tmo, __ATOMIC_RELAXED, __HIP_MEMORY_SCOPE_AGENT)) break; if (sp > (1u << 22)) { (void)__hip_atomic_fetch_add(tmo, 1u, __ATOMIC_RELAXED, __HIP_MEMORY_SCOPE_AGENT); break; } } }
                __builtin_amdgcn_fence(__ATOMIC_ACQUIRE, "agent"); }
            int* nxl = (int*)(smem + LDS_BYTES - 64);
            int my_next = 0; if (TID == 0) my_next = (int)__hip_atomic_fetch_add(cw + 1, 1u, __ATOMIC_RELAXED, __HIP_MEMORY_SCOPE_AGENT);
            for (;;) { SYNC(); if (TID == 0) nxl[0] = my_next; SYNC(); const int it = nxl[0]; if (it >= 8 * NCH) break;
                if (TID == 0) my_next = (int)__hip_atomic_fetch_add(cw + 1, 1u, __ATOMIC_RELAXED, __HIP_MEMORY_SCOPE_AGENT);
                hg_h3_task(a, smem, li, it); } }
        break;
    case 4: break;
#endif
    case 5:
        if (!EN(5)) break;
        if (even) resid_gemm_phase(a, smem, (const bf16*)(ws + WS_CAT), 1024, (const bf16*)(ws + WS_WOUT) + (size_t)li * DM * 1024, l);
        else resid_gemm_phase(a, smem, (const bf16*)(ws + WS_CAT), DM, (const bf16*)(ws + WS_PW2) + (size_t)li * DM * DM, l);
        break;
    case 6:
#ifndef EMU
        if (l >= 1) moe_conv_drain(a, smem, (l + 1) * 32 * MOE_SPE);
#endif
        if (EN(6)) route_phase(a, smem, l); break;
#ifdef EMU
    case 7: if (EN(7)) moe_gemm_phase8(a, smem, l, 0); break;
    case 8: if (EN(8)) moe_gemm_phase8(a, smem, l, 1); break;
#else
    case 7: if (EN(7)) moe_fused_phase(a, smem, l); break;
    case 8: break;
#endif
    }
}

#ifndef EMU
#define LAS __attribute__((address_space(3)))
#define XB_TMO      128
static_assert(MOE_N0 >= 2 * 32 * MOE_SPE && XB_TMO == MOE_TMO_IDX && P0_CTR_IDX > XB_TMO && P0_CTR_IDX + 8 + 16 * (DEPTH / 2) <= 256 && 8 * ((NCP + 255) / 256) == 16, "timeout word / free words");
#define XB_XCNT(j)  (256  + 64 * (j))
#define XB_XSUB(j)  (1280 + 64 * (j))
#define XB_XGEN(j)  (2304 + 64 * (j))
#define XB_TOP      3328
#define XB_TOPGEN   3392
#define XCD_BAR_WORDS 3456
#define XB_SPIN_CAP (1u << 22)
__device__ __forceinline__ unsigned xb_ld(unsigned* p)              { return __hip_atomic_load(p, __ATOMIC_RELAXED, __HIP_MEMORY_SCOPE_AGENT); }
__device__ __forceinline__ unsigned xb_add(unsigned* p, unsigned v) { return __hip_atomic_fetch_add(p, v, __ATOMIC_RELAXED, __HIP_MEMORY_SCOPE_AGENT); }
__device__ __forceinline__ unsigned xb_xcc_id() { return (unsigned)__builtin_amdgcn_s_getreg((3 << 11) | 20) & 0xFu; }
#define XB_SPIN(cond, bar) do { unsigned _sp = 0; while (cond) { __builtin_amdgcn_s_sleep(1); \
    if ((++_sp & 255u) == 0u) { if (xb_ld(&(bar)[XB_TMO])) break; if (_sp > XB_SPIN_CAP) { atomicAdd(&(bar)[XB_TMO], 1u); break; } } } } while (0)
struct XcdBarrier { unsigned* bar; unsigned x; volatile LAS unsigned* st; };
__device__ __forceinline__ XcdBarrier xcd_barrier_post(unsigned* bar, volatile LAS unsigned* st) {
    XcdBarrier b; b.bar = bar; b.x = xb_xcc_id(); b.st = st;
    if (threadIdx.x == 0) (void)xb_add(&bar[XB_XCNT(b.x)], 1u);
    return b;
}
__device__ __forceinline__ void xcd_barrier_complete(unsigned* bar, unsigned x, unsigned& nloc, unsigned& nx) {
    const unsigned G = gridDim.x * gridDim.y * gridDim.z;
    unsigned sum, cnt, mine, sp = 0u;
    for (;;) {
        sum = 0u; cnt = 0u; mine = 0u;
#pragma unroll
        for (unsigned j = 0; j < 16; ++j) { const unsigned c = xb_ld(&bar[XB_XCNT(j)]); sum += c; cnt += (c > 0u) ? 1u : 0u; mine = (j == x) ? c : mine; }
        if (sum == G) break;
        __builtin_amdgcn_s_sleep(1);
        if ((++sp & 255u) == 0u) { if (xb_ld(&bar[XB_TMO])) break; if (sp > XB_SPIN_CAP) { atomicAdd(&bar[XB_TMO], 1u); break; } }
    }
    nloc = mine > 0u ? mine : 1u; nx = cnt > 0u ? cnt : 1u;
}
__device__ __forceinline__ void xcd_barrier(const XcdBarrier& b) {
    asm volatile("s_waitcnt vmcnt(0)" ::: "memory");
    __syncthreads();
    if (threadIdx.x == 0) {
        unsigned* bar = b.bar;
        __builtin_amdgcn_s_waitcnt(0);
        unsigned nloc = b.st[0], nx = b.st[1];
        if (nloc == 0u) { xcd_barrier_complete(bar, b.x, nloc, nx); b.st[0] = nloc; b.st[1] = nx; }
        const unsigned old = xb_add(&bar[XB_XSUB(b.x)], 1u);
        const unsigned gen = old / nloc;
        if (old + 1u == (gen + 1u) * nloc) {
            __builtin_amdgcn_fence(__ATOMIC_RELEASE, "agent");
            asm volatile("s_waitcnt vmcnt(0)" ::: "memory");
            const unsigned og = xb_add(&bar[XB_TOP], 1u);
            const unsigned tg = og / nx;
            if (og + 1u == (tg + 1u) * nx) xb_add(&bar[XB_TOPGEN], 1u);
            else XB_SPIN(xb_ld(&bar[XB_TOPGEN]) == tg, bar);
            __builtin_amdgcn_fence(__ATOMIC_ACQUIRE, "agent");
            xb_add(&bar[XB_XGEN(b.x)], 1u);
            asm volatile("s_waitcnt vmcnt(0)" ::: "memory");
        } else {
            XB_SPIN(xb_ld(&bar[XB_XGEN(b.x)]) == gen, bar);
            __builtin_amdgcn_fence(__ATOMIC_ACQUIRE, "agent");
            asm volatile("s_waitcnt vmcnt(0)" ::: "memory");
        }
    }
    __syncthreads();
}

__global__ void __launch_bounds__(NT, 2) mega(Args a) {
    extern __shared__ __attribute__((aligned(16))) unsigned char lds[];
    volatile LAS unsigned* st = (volatile LAS unsigned*)(LAS unsigned char*)(lds + LDS_BYTES - 16);
    if (threadIdx.x < 4) st[threadIdx.x] = 0u;
    __syncthreads();
    unsigned* barw = (unsigned*)(a.ws + WS_BAR);
    XcdBarrier bar = xcd_barrier_post(barw, st);
#pragma unroll 1
    for (int ph = 0; ph < N_PHASES; ++ph) {
        if (ph > 0 && ph < N_PHASES - 1) { int l_, s_; phase_decode(ph, l_, s_); if (s_ == 8 || (s_ == 4 && (l_ & 1) == 0)) continue; }
        run_phase(a, lds, ph);
#ifdef DUP
        { int lyr = 0, sub = 100; if (ph > 0 && ph < N_PHASES - 1) phase_decode(ph, lyr, sub);
          if (sub == (DUP % 1000) && (ph == 0 || lyr == DUP / 1000) && ph < N_PHASES - 1) { xcd_barrier(bar); run_phase(a, lds, ph); } }
#endif
        if (ph + 1 < N_PHASES) xcd_barrier(bar);
    }
    if (xb_ld(&barw[XB_TMO]) != 0u) {
        const size_t gt = (size_t)blockIdx.x * NT + threadIdx.x, gs = (size_t)gridDim.x * NT;
        for (size_t i = gt; i < (size_t)T * DM; i += gs) a.out[i] = __builtin_nanf("");
    }
}

extern "C" void kernel_launch(void* const* d_in, const int* in_sizes, int n_in, void* d_out, int out_size,
                              void* d_ws, size_t ws_size, hipStream_t stream) {
    static int grid = 0;
    if (grid == 0) {
        int dev = 0, cus = 0;
        if (hipGetDevice(&dev) != hipSuccess || hipDeviceGetAttribute(&cus, hipDeviceAttributeMultiprocessorCount, dev) != hipSuccess) { grid = -1; return; }
        if (hipFuncSetAttribute((const void*)mega, hipFuncAttributeMaxDynamicSharedMemorySize, LDS_BYTES) != hipSuccess) { grid = -1; return; }
        (void)hipGetLastError();
        grid = cus;
        if (n_in != 26 || out_size != T * DM || ws_size < WS_END) { fprintf(stderr, "kernel_launch: unexpected sizes n_in %d out %d ws %zu (need %zu)\n", n_in, out_size, ws_size, (size_t)WS_END); grid = -1; return; }
    }
    if (grid < 0) return;
    (void)hipMemsetAsync((unsigned char*)d_ws + WS_BAR, 0, XCD_BAR_WORDS * 4, stream);
    Args a{};
    for (int i = 0; i < 26; ++i) a.in[i] = (const float*)d_in[i];
    a.out = (float*)d_out; a.ws = (unsigned char*)d_ws;
    hipLaunchKernelGGL(mega, dim3(grid), dim3(NT), LDS_BYTES, stream, a);
}
#endif
```
